# Optimizing an MI355X kernel written in HIP

```python
import math
import jax, jax.numpy as jnp
from jax import lax
import numpy as np

D_MODEL = 2048
BATCH = 16
SEQ = 256
DEPTH = 4
DEC_BATCH = 8
DEC_SEQ = 1024
PAST_LEN = 256

GRID_W = 64
HEAD_DIM = 128
GROUP_WIDTH = D_MODEL // 4
NA_HEADS = GROUP_WIDTH // HEAD_DIM
NA_WIN_ROWS = 8
NA_WIN_COLS = 16
GLA_HEADS = 4
GLA_DV = GROUP_WIDTH // GLA_HEADS
GLA_DK = GLA_DV // 2
GLA_GATE_RANK = 16
GLA_TAU = 16.0
GQA_HEADS = GROUP_WIDTH // HEAD_DIM
GQA_KV_HEADS = GQA_HEADS // 2
GDN_HEADS = GROUP_WIDTH // HEAD_DIM
GDN_DK = HEAD_DIM
GDN_DV = HEAD_DIM
CONV_K = 5
CHUNK = 64
Q_BLOCK = 128
ROPE_THETA = 10000.0
FFN_DIM = ((8 * D_MODEL // 3 + 127) // 128) * 128
N_MOD = 9
EPS = 1e-6
NEG_INF = -1e30

IN_SPLITS = (
    ('na_q', NA_HEADS * HEAD_DIM), ('na_k', NA_HEADS * HEAD_DIM), ('na_v', NA_HEADS * HEAD_DIM),
    ('gla_q', GLA_HEADS * GLA_DK), ('gla_k', GLA_HEADS * GLA_DK), ('gla_v', GLA_HEADS * GLA_DV),
    ('gla_r', GLA_HEADS * GLA_DV), ('gla_gf', GLA_GATE_RANK), ('gla_gb', GLA_GATE_RANK),
    ('gqa_q', GQA_HEADS * HEAD_DIM), ('gqa_k', GQA_KV_HEADS * HEAD_DIM), ('gqa_v', GQA_KV_HEADS * HEAD_DIM),
    ('gdn_qkv', 3 * GDN_HEADS * HEAD_DIM), ('gdn_z', GDN_HEADS * GDN_DV),
    ('gdn_b', 2 * GDN_HEADS), ('gdn_a', 2 * GDN_HEADS),
)
IN_COLS = sum(width for _, width in IN_SPLITS)

kernel_name = 'hybrid_diffusion_parallel_heads_step'


def rms_norm(x, g):
    xf = x.astype(jnp.float32)
    y = xf * lax.rsqrt(jnp.mean(xf * xf, axis=-1, keepdims=True) + EPS)
    return (y * g.astype(jnp.float32)).astype(x.dtype)


def l2_norm(x):
    xf = x.astype(jnp.float32)
    return xf * lax.rsqrt(jnp.sum(xf * xf, axis=-1, keepdims=True) + EPS)


def split_cols(z):
    out, off = {}, 0
    for name, width in IN_SPLITS:
        out[name] = z[..., off:off + width]
        off += width
    return out


def to_heads(x, n):
    B, T, _ = x.shape
    return x.reshape(B, T, n, -1).transpose(0, 2, 1, 3)


def from_heads(x):
    B, n, T, d = x.shape
    return x.transpose(0, 2, 1, 3).reshape(B, T, n * d)


def flip_t(x):
    return x[:, :, ::-1]


def adaln(cond, w_mod, b_mod):
    m = jax.nn.silu(cond) @ w_mod + b_mod
    return jnp.split(m[:, None, :], N_MOD, axis=-1)


def swiglu(x, w_gu, w_down):
    g, u = jnp.split(x @ w_gu, 2, axis=-1)
    return (jax.nn.silu(g) * u) @ w_down


def axial_angles(T):
    t = jnp.arange(T)
    row = (t // GRID_W).astype(jnp.float32)
    col = (t % GRID_W).astype(jnp.float32)
    half = HEAD_DIM // 2
    inv = ROPE_THETA ** (-jnp.arange(0, half, 2, dtype=jnp.float32) / half)
    return row[:, None] * inv[None, :], col[:, None] * inv[None, :]


def rope_half(x, ang):
    x1, x2 = jnp.split(x, 2, axis=-1)
    cos, sin = jnp.cos(ang).astype(x.dtype), jnp.sin(ang).astype(x.dtype)
    return jnp.concatenate([x1 * cos - x2 * sin, x1 * sin + x2 * cos], axis=-1)


def apply_axial_rope(x, ang_r, ang_c):
    xr, xc = jnp.split(x, 2, axis=-1)
    return jnp.concatenate([rope_half(xr, ang_r), rope_half(xc, ang_c)], axis=-1)


def dense_attention(q, k, v):
    B, Hk, G, T, d = q.shape
    nb = T // Q_BLOCK
    qb = q.reshape(B, Hk, G, nb, Q_BLOCK, d).transpose(3, 0, 1, 2, 4, 5)
    scale = d ** -0.5

    def one_block(qi):
        s = jnp.einsum('bhgqd,bhkd->bhgqk', qi, k).astype(jnp.float32) * scale
        p = jax.nn.softmax(s, axis=-1).astype(v.dtype)
        return jnp.einsum('bhgqk,bhkd->bhgqd', p, v)

    o = lax.map(one_block, qb)
    return o.transpose(1, 2, 3, 0, 4, 5).reshape(B, Hk, G, T, d)


def neighbourhood_attention(q, k, v, ck, cv, rpb):
    B, H, T, d = q.shape
    rows = T // GRID_W
    wr = min(NA_WIN_ROWS, rows)
    r = jnp.arange(rows)
    krow = jnp.clip(r - wr // 2, 0, rows - wr)[:, None] + jnp.arange(wr)[None, :]
    col = jnp.arange(GRID_W)
    c0 = jnp.clip(col - NA_WIN_COLS // 2, 0, GRID_W - NA_WIN_COLS)
    in_win = (col[None, :] >= c0[:, None]) & (col[None, :] < c0[:, None] + NA_WIN_COLS)
    dr = krow - r[:, None] + (NA_WIN_ROWS - 1)
    dc = jnp.clip(col[None, :] - col[:, None] + (NA_WIN_COLS - 1), 0, 2 * NA_WIN_COLS - 2)
    bias = rpb[:, dr[:, None, :, None], dc[None, :, None, :]].astype(jnp.float32)
    qg = q.reshape(B, H, rows, GRID_W, d)
    kg = k.reshape(B, H, rows, GRID_W, d)[:, :, krow]
    vg = v.reshape(B, H, rows, GRID_W, d)[:, :, krow]
    scale = d ** -0.5
    s_loc = jnp.einsum('bhrqd,bhrjkd->bhrqjk', qg, kg).astype(jnp.float32) * scale + bias[None]
    s_loc = jnp.where(in_win[:, None, :], s_loc, NEG_INF)
    s_ctx = jnp.einsum('bhrqd,bhld->bhrql', qg, ck).astype(jnp.float32) * scale
    L = ck.shape[2]
    s = jnp.concatenate([s_ctx, s_loc.reshape(B, H, rows, GRID_W, wr * GRID_W)], axis=-1)
    p = jax.nn.softmax(s, axis=-1).astype(v.dtype)
    o = (jnp.einsum('bhrql,bhld->bhrqd', p[..., :L], cv)
         + jnp.einsum('bhrqjk,bhrjkd->bhrqd', p[..., L:].reshape(B, H, rows, GRID_W, wr, GRID_W), vg))
    return o.reshape(B, H, T, d)


def to_chunks(x):
    B, H, T = x.shape[:3]
    y = x.astype(jnp.float32).reshape((B, H, T // CHUNK, CHUNK) + x.shape[3:])
    return jnp.moveaxis(y, 2, 0)


def from_chunks(o):
    n, B, H, C, e = o.shape
    return jnp.moveaxis(o, 0, 2).reshape(B, H, n * C, e)


def gla_scan(q, k, v, log_a, s0):
    causal = jnp.tril(jnp.ones((CHUNK, CHUNK), bool))

    def step(S, inp):
        qi, ki, vi, gi = inp
        b = jnp.cumsum(gi, axis=2)
        diff = b[:, :, :, None, :] - b[:, :, None, :, :]
        decay = jnp.where(causal[:, :, None], jnp.exp(jnp.minimum(diff, 0.0)), 0.0)
        att = jnp.einsum('bhqd,bhkd,bhqkd->bhqk', qi, ki, decay)
        o = jnp.einsum('bhqd,bhde->bhqe', qi * jnp.exp(b), S) + jnp.einsum('bhqk,bhke->bhqe', att, vi)
        b_last = b[:, :, -1:, :]
        S = S * jnp.exp(b_last[:, :, 0, :, None]) + jnp.einsum('bhkd,bhke->bhde', ki * jnp.exp(b_last - b), vi)
        return S, o

    S, o = lax.scan(step, s0.astype(jnp.float32), (to_chunks(q), to_chunks(k), to_chunks(v), to_chunks(log_a)))
    return from_chunks(o), S


def gdn_scan(q, k, v, g, beta, s0):
    dv = v.shape[-1]
    causal = jnp.tril(jnp.ones((CHUNK, CHUNK), bool))
    strict = jnp.tril(jnp.ones((CHUNK, CHUNK), bool), -1)
    eye = jnp.eye(CHUNK, dtype=jnp.float32)

    def step(S, inp):
        qi, ki, vi, gi, bi = inp
        b = jnp.cumsum(gi, axis=-1)
        diff = b[..., :, None] - b[..., None, :]
        decay = jnp.where(causal, jnp.exp(jnp.minimum(diff, 0.0)), 0.0)
        kb = ki * bi[..., None]
        low = jnp.where(strict, jnp.einsum('bhqd,bhkd->bhqk', kb, ki) * decay, 0.0)
        rhs = jnp.concatenate([vi * bi[..., None], kb * jnp.exp(b)[..., None]], axis=-1)
        sol = lax.linalg.triangular_solve(low + eye, rhs, left_side=True, lower=True, unit_diagonal=True)
        u, w = sol[..., :dv], sol[..., dv:]
        v_new = u - w @ S
        att = jnp.einsum('bhqd,bhkd->bhqk', qi, ki) * decay
        o = (qi * jnp.exp(b)[..., None]) @ S + att @ v_new
        b_last = b[..., -1:]
        S = S * jnp.exp(b_last)[..., None] + jnp.einsum('bhkd,bhke->bhde', ki * jnp.exp(b_last - b)[..., None], v_new)
        return S, o

    xs = (to_chunks(q), to_chunks(k), to_chunks(v), to_chunks(g), to_chunks(beta))
    S, o = lax.scan(step, s0.astype(jnp.float32), xs)
    return from_chunks(o), S


def centred_depthwise_conv(x, w):
    C = x.shape[-1]
    pad = CONV_K // 2
    return lax.conv_general_dilated(x, w[:, None, :].astype(x.dtype), window_strides=(1,),
                                    padding=((pad, pad),), dimension_numbers=('NWC', 'WIO', 'NWC'),
                                    feature_group_count=C)


def token_mixing(h, P, l, ctx):
    B, T, _ = h.shape
    f32 = jnp.float32
    is_ctx = ctx is None
    z = split_cols(h @ P['w_in'][l])

    qn = rms_norm(to_heads(z['na_q'], NA_HEADS), P['na_qk_norm'][l, 0])
    kn = rms_norm(to_heads(z['na_k'], NA_HEADS), P['na_qk_norm'][l, 1])
    vn = to_heads(z['na_v'], NA_HEADS)
    if is_ctx:
        o_na = dense_attention(qn[:, :, None], kn, vn)[:, :, 0]
    else:
        o_na = neighbourhood_attention(qn, kn, vn, ctx['na_k'], ctx['na_v'], P['na_rpb'][l])

    qg = to_heads(z['gla_q'], GLA_HEADS) * (GLA_DK ** -0.5)
    kg = to_heads(z['gla_k'], GLA_HEADS)
    vg = to_heads(z['gla_v'], GLA_HEADS)
    la_f = to_heads(jax.nn.log_sigmoid((z['gla_gf'] @ P['gla_gate_up'][l, 0] + P['gla_gate_bias'][l, 0]).astype(f32)) / GLA_TAU, GLA_HEADS)
    la_b = to_heads(jax.nn.log_sigmoid((z['gla_gb'] @ P['gla_gate_up'][l, 1] + P['gla_gate_bias'][l, 1]).astype(f32)) / GLA_TAU, GLA_HEADS)
    if is_ctx:
        s0f = s0b = jnp.zeros((B, GLA_HEADS, GLA_DK, GLA_DV), f32)
    else:
        s0f, s0b = ctx['gla'][:, 0], ctx['gla'][:, 1]
    o_f, sf_gla = gla_scan(qg, kg, vg, la_f, s0f)
    o_b, sb_gla = gla_scan(flip_t(qg), flip_t(kg), flip_t(vg), flip_t(la_b), s0b)
    o_gla = from_heads(rms_norm(o_f + flip_t(o_b), P['gla_out_norm'][l])) * jax.nn.silu(z['gla_r'].astype(f32))

    qa = rms_norm(to_heads(z['gqa_q'], GQA_HEADS), P['gqa_qk_norm'][l, 0])
    ka = rms_norm(to_heads(z['gqa_k'], GQA_KV_HEADS), P['gqa_qk_norm'][l, 1])
    va = to_heads(z['gqa_v'], GQA_KV_HEADS)
    if is_ctx:
        keys, vals = ka, va
    else:
        ang_r, ang_c = axial_angles(T)
        qa = apply_axial_rope(qa, ang_r, ang_c)
        keys = jnp.concatenate([ctx['gqa_k'].astype(ka.dtype), apply_axial_rope(ka, ang_r, ang_c)], axis=2)
        vals = jnp.concatenate([ctx['gqa_v'].astype(va.dtype), va], axis=2)
    o_a = dense_attention(qa.reshape(B, GQA_KV_HEADS, GQA_HEADS // GQA_KV_HEADS, T, HEAD_DIM), keys, vals)
    o_gqa = from_heads(o_a.reshape(B, GQA_HEADS, T, HEAD_DIM))

    qkv = jax.nn.silu(centred_depthwise_conv(z['gdn_qkv'], P['gdn_conv'][l]))
    qd, kd, vd = jnp.split(qkv, 3, axis=-1)
    qd = l2_norm(to_heads(qd, GDN_HEADS)) * (GDN_DK ** -0.5)
    kd = l2_norm(to_heads(kd, GDN_HEADS))
    vd = to_heads(vd, GDN_HEADS)
    beta = jax.nn.sigmoid(z['gdn_b'].astype(f32)).reshape(B, T, 2, GDN_HEADS).transpose(2, 0, 3, 1)
    a_in = z['gdn_a'].astype(f32).reshape(B, T, 2, GDN_HEADS).transpose(2, 0, 3, 1)
    a_log = P['gdn_a_log'][l].astype(f32)
    dt_b = P['gdn_dt_bias'][l].astype(f32)
    g_f = -jnp.exp(a_log[0])[None, :, None] * jax.nn.softplus(a_in[0] + dt_b[0][None, :, None])
    g_b = -jnp.exp(a_log[1])[None, :, None] * jax.nn.softplus(a_in[1] + dt_b[1][None, :, None])
    if is_ctx:
        d0f = d0b = jnp.zeros((B, GDN_HEADS, GDN_DK, GDN_DV), f32)
    else:
        d0f, d0b = ctx['gdn'][:, 0], ctx['gdn'][:, 1]
    od_f, sf_gdn = gdn_scan(qd, kd, vd, g_f, beta[0], d0f)
    od_b, sb_gdn = gdn_scan(flip_t(qd), flip_t(kd), flip_t(vd), flip_t(g_b), flip_t(beta[1]), d0b)
    o_gdn = from_heads(rms_norm(od_f + flip_t(od_b), P['gdn_out_norm'][l])) * jax.nn.silu(z['gdn_z'].astype(f32))

    merged = jnp.concatenate([from_heads(o_na), o_gla.astype(h.dtype), o_gqa, o_gdn.astype(h.dtype)], axis=-1)
    out = merged @ P['w_out'][l]
    if is_ctx:
        return out, (kn, vn, ka, va, jnp.stack([sf_gla, sb_gla], axis=1), jnp.stack([sf_gdn, sb_gdn], axis=1))
    return out, None


def trunk_layer(x, cond, P, l, ctx):
    sh1, sc1, g1, sh2, sc2, g2, sh3, sc3, g3 = adaln(cond, P['w_mod'][l], P['b_mod'][l])
    h = rms_norm(x, P['norm_g'][l, 0]) * (1 + sc1) + sh1
    x = x + 0.5 * g1 * swiglu(h, P['ffn_gu'][l, 0], P['ffn_down'][l, 0])
    h = rms_norm(x, P['norm_g'][l, 1]) * (1 + sc2) + sh2
    m, cache = token_mixing(h, P, l, ctx)
    x = x + g2 * m
    h = rms_norm(x, P['norm_g'][l, 2]) * (1 + sc3) + sh3
    x = x + 0.5 * g3 * swiglu(h, P['ffn_gu'][l, 1], P['ffn_down'][l, 1])
    return x, cache


def setup_inputs(seed: int = 0) -> dict:
    key = jax.random.key(seed)
    ks = jax.random.split(key, 28)
    D = D_MODEL

    def nrm(k, shape, s):
        return jax.random.normal(k, shape, jnp.float32) * s

    dt = jnp.exp(jax.random.uniform(ks[25], (DEPTH, 2, GDN_HEADS), jnp.float32, math.log(1e-3), math.log(1e-1)))
    return {
        'x_prompt': nrm(ks[0], (BATCH, SEQ, D), 1.0),
        'x_sample': nrm(ks[1], (DEC_BATCH, DEC_SEQ, D), 1.0),
        'cache_na_k': nrm(ks[2], (DEC_BATCH, DEPTH, NA_HEADS, PAST_LEN, HEAD_DIM), 1.0),
        'cache_na_v': nrm(ks[3], (DEC_BATCH, DEPTH, NA_HEADS, PAST_LEN, HEAD_DIM), 1.0),
        'cache_gqa_k': nrm(ks[4], (DEC_BATCH, DEPTH, GQA_KV_HEADS, PAST_LEN, HEAD_DIM), 1.0),
        'cache_gqa_v': nrm(ks[5], (DEC_BATCH, DEPTH, GQA_KV_HEADS, PAST_LEN, HEAD_DIM), 1.0),
        'state_gla': nrm(ks[6], (DEC_BATCH, DEPTH, 2, GLA_HEADS, GLA_DK, GLA_DV), 0.5),
        'state_gdn': nrm(ks[7], (DEC_BATCH, DEPTH, 2, GDN_HEADS, GDN_DK, GDN_DV), 0.5),
        'c': nrm(ks[8], (DEC_BATCH, D), 1.0),
        'c_ctx': nrm(ks[9], (D,), 1.0),
        'norm_g': 1.0 + nrm(ks[10], (DEPTH, 3, D), 0.02),
        'w_mod': nrm(ks[11], (DEPTH, D, N_MOD * D), 0.5 * D ** -0.5),
        'b_mod': nrm(ks[12], (DEPTH, N_MOD * D), 0.02),
        'ffn_gu': nrm(ks[13], (DEPTH, 2, D, 2 * FFN_DIM), D ** -0.5),
        'ffn_down': nrm(ks[14], (DEPTH, 2, FFN_DIM, D), FFN_DIM ** -0.5),
        'w_in': nrm(ks[15], (DEPTH, D, IN_COLS), D ** -0.5),
        'w_out': nrm(ks[16], (DEPTH, 4 * GROUP_WIDTH, D), (4 * GROUP_WIDTH) ** -0.5),
        'na_qk_norm': 1.0 + nrm(ks[17], (DEPTH, 2, HEAD_DIM), 0.02),
        'na_rpb': nrm(ks[18], (DEPTH, NA_HEADS, 2 * NA_WIN_ROWS - 1, 2 * NA_WIN_COLS - 1), 0.1),
        'gla_gate_up': nrm(ks[19], (DEPTH, 2, GLA_GATE_RANK, GLA_HEADS * GLA_DK), GLA_GATE_RANK ** -0.5),
        'gla_gate_bias': nrm(ks[20], (DEPTH, 2, GLA_HEADS * GLA_DK), 0.1),
        'gla_out_norm': 1.0 + nrm(ks[21], (DEPTH, GLA_DV), 0.02),
        'gqa_qk_norm': 1.0 + nrm(ks[22], (DEPTH, 2, HEAD_DIM), 0.02),
        'gdn_conv': nrm(ks[23], (DEPTH, CONV_K, 3 * GDN_HEADS * HEAD_DIM), CONV_K ** -0.5),
        'gdn_a_log': jnp.log(jax.random.uniform(ks[24], (DEPTH, 2, GDN_HEADS), jnp.float32, 1.0, 16.0)),
        'gdn_dt_bias': dt + jnp.log(-jnp.expm1(-dt)),
        'gdn_out_norm': 1.0 + nrm(ks[26], (DEPTH, GDN_DV), 0.02),
    }


def reference(x_prompt, x_sample, cache_na_k, cache_na_v, cache_gqa_k, cache_gqa_v, state_gla, state_gdn,
              c, c_ctx, norm_g, w_mod, b_mod, ffn_gu, ffn_down, w_in, w_out, na_qk_norm, na_rpb,
              gla_gate_up, gla_gate_bias, gla_out_norm, gqa_qk_norm, gdn_conv, gdn_a_log, gdn_dt_bias,
              gdn_out_norm):
    P = dict(norm_g=norm_g, w_mod=w_mod, b_mod=b_mod, ffn_gu=ffn_gu, ffn_down=ffn_down, w_in=w_in,
             w_out=w_out, na_qk_norm=na_qk_norm, na_rpb=na_rpb, gla_gate_up=gla_gate_up,
             gla_gate_bias=gla_gate_bias, gla_out_norm=gla_out_norm, gqa_qk_norm=gqa_qk_norm,
             gdn_conv=gdn_conv, gdn_a_log=gdn_a_log, gdn_dt_bias=gdn_dt_bias, gdn_out_norm=gdn_out_norm)

    xp = x_prompt
    na_k_l, na_v_l, gqa_k_l, gqa_v_l, gla_l, gdn_l = [], [], [], [], [], []
    for l in range(DEPTH):
        xp, (nk, nv, gk, gv, sg, sd) = trunk_layer(xp, c_ctx[None, :], P, l, None)
        na_k_l.append(nk)
        na_v_l.append(nv)
        gqa_k_l.append(gk)
        gqa_v_l.append(gv)
        gla_l.append(sg)
        gdn_l.append(sd)
    new_na_k = jnp.stack(na_k_l, axis=1)
    new_na_v = jnp.stack(na_v_l, axis=1)
    new_gqa_k = jnp.stack(gqa_k_l, axis=1)
    new_gqa_v = jnp.stack(gqa_v_l, axis=1)
    new_state_gla = jnp.stack(gla_l, axis=1)
    new_state_gdn = jnp.stack(gdn_l, axis=1)

    xs = x_sample
    for l in range(DEPTH):
        ctx = dict(na_k=cache_na_k[:, l], na_v=cache_na_v[:, l], gqa_k=cache_gqa_k[:, l],
                   gqa_v=cache_gqa_v[:, l], gla=state_gla[:, l], gdn=state_gdn[:, l])
        xs, _ = trunk_layer(xs, c, P, l, ctx)

    return (xp, xs, new_na_k, new_na_v, new_gqa_k, new_gqa_v, new_state_gla, new_state_gdn)
```

```cpp
#include <hip/hip_runtime.h>
#include <cstdio>
#include <cstdint>

#ifndef CB_
#define CB_ 16
#endif
#ifndef LB_
#define LB_ 8
#endif
#ifndef DEPTH_
#define DEPTH_ 4
#endif
constexpr int DM = 2048, DEPTH = DEPTH_, CB = CB_, CT = 256, LB = LB_, LT = 1024;
constexpr int MC = CB * CT, ML = LB * LT, M = MC + ML;
constexpr int FF = 5504, NGU = 2 * FF, NIN = 6192, NINP = 6400, NMOD = 9 * DM, NCOND = 1 + LB;
constexpr float EPS = 1e-6f;
constexpr int Z_NAQ = 0, Z_NAK = 512, Z_NAV = 1024, Z_GLQ = 1536, Z_GLK = 1792, Z_GLV = 2048, Z_GLR = 2560, Z_GF = 3072, Z_GB = 3088,
              Z_GQQ = 3104, Z_GQK = 3616, Z_GQV = 3872, Z_DQKV = 4128, Z_DZ = 5664, Z_DB = 6176, Z_DA = 6184;
static_assert(Z_DA + 8 == NIN, "split");
enum { I_XP = 0, I_XS, I_CNAK, I_CNAV, I_CGK, I_CGV, I_SGLA, I_SGDN, I_C, I_CCTX, I_NORMG, I_WMOD, I_BMOD, I_GU, I_DOWN, I_WIN, I_WOUT, I_NAQKN, I_RPB,
       I_GUP, I_GBIAS, I_GLAON, I_GQAQKN, I_CONV, I_ALOG, I_DTB, I_GDNON, N_IN };
constexpr size_t O_YP = 0, O_YS = O_YP + (size_t)MC * DM, O_NAK = O_YS + (size_t)ML * DM, O_NAV = O_NAK + (size_t)CB * DEPTH * 4 * CT * 128,
                 O_GK = O_NAV + (size_t)CB * DEPTH * 4 * CT * 128, O_GV = O_GK + (size_t)CB * DEPTH * 2 * CT * 128,
                 O_SGLA = O_GV + (size_t)CB * DEPTH * 2 * CT * 128, O_SGDN = O_SGLA + (size_t)CB * DEPTH * 2 * 4 * 64 * 128,
                 O_END = O_SGDN + (size_t)CB * DEPTH * 2 * 4 * 128 * 128;
constexpr size_t al256(size_t x) { return (x + 255) & ~(size_t)255; }
constexpr size_t WS_CTL = 0, CTL_BYTES = 1u << 20;
constexpr size_t WS_WGU = CTL_BYTES;
constexpr size_t WS_WDN = WS_WGU + (size_t)DEPTH * 2 * NGU * DM * 2;
constexpr size_t WS_WIN = WS_WDN + (size_t)DEPTH * 2 * DM * FF * 2;
constexpr size_t WS_WOUT = WS_WIN + (size_t)DEPTH * NINP * DM * 2;
constexpr size_t WS_MODV = WS_WOUT + (size_t)DEPTH * DM * DM * 2;
constexpr size_t WS_ROPE = al256(WS_MODV + (size_t)DEPTH * NCOND * NMOD * 4);
constexpr size_t WS_X = al256(WS_ROPE + 2 * 64 * 32 * 4);
constexpr size_t WS_H = WS_X + (size_t)M * DM * 4;
constexpr size_t WS_ACT = WS_H + (size_t)M * DM * 2;
constexpr size_t WS_Z = WS_ACT + (size_t)M * FF * 2;
constexpr size_t WS_MRG = WS_Z + (size_t)M * NINP * 4;
constexpr size_t WS_NAQ = WS_MRG + (size_t)M * DM * 2;
constexpr size_t WS_NAK = WS_NAQ + (size_t)M * 512 * 2;
constexpr size_t WS_NAV = WS_NAK + (size_t)M * 512 * 2;
constexpr size_t WS_GQ = WS_NAV + (size_t)M * 512 * 2;
constexpr size_t WS_GK = WS_GQ + (size_t)M * 512 * 2;
constexpr size_t WS_GV = WS_GK + (size_t)M * 256 * 2;
constexpr size_t WS_CNAK = WS_GV + (size_t)M * 256 * 2;
constexpr size_t WS_CNAV = WS_CNAK + (size_t)LB * DEPTH * 256 * 512 * 2;
constexpr size_t WS_CGK = WS_CNAV + (size_t)LB * DEPTH * 256 * 512 * 2;
constexpr size_t WS_CGV = WS_CGK + (size_t)LB * DEPTH * 256 * 256 * 2;
constexpr size_t WS_AF = WS_CGV + (size_t)LB * DEPTH * 256 * 256 * 2;
constexpr size_t WS_AB = WS_AF + (size_t)M * 256 * 4;
constexpr size_t WS_DQ = WS_AB + (size_t)M * 256 * 4;
constexpr size_t WS_DK = WS_DQ + (size_t)M * 512 * 4;
constexpr size_t WS_DV = WS_DK + (size_t)M * 512 * 4;
constexpr size_t WS_DBA = WS_DV + (size_t)M * 512 * 4;
constexpr size_t WS_GOF = WS_DBA + (size_t)M * 16 * 4;
constexpr size_t WS_GOB = WS_GOF + (size_t)M * 512 * 4;
constexpr size_t WS_DOF = WS_GOB + (size_t)M * 512 * 4;
constexpr size_t WS_DOB = WS_DOF + (size_t)M * 512 * 4;
constexpr size_t WS_END = WS_DOB + (size_t)M * 512 * 4;

typedef unsigned short bf16_t;
struct Params { const float* in[N_IN]; float* out; unsigned char* ws; int ph_lo, ph_hi; };
static_assert(sizeof(Params) == N_IN * 8 + 8 + 8 + 8, "no padding");

#define WSP(T, off) ((T*)(p.ws + (off)))
__device__ __forceinline__ int opaque_tid() { int t = (int)threadIdx.x; asm volatile("" : "+v"(t)); return t; }
__device__ __forceinline__ Params opaque_params(const Params& p) { Params q = p; unsigned long long w = (unsigned long long)q.ws; asm volatile("" : "+s"(w)); q.ws = (unsigned char*)w; return q; }

__device__ __forceinline__ float wave_sum(float v) {
#pragma unroll
    for (int o = 32; o >= 1; o >>= 1) v += __shfl_xor(v, o);
    return v;
}
__device__ __forceinline__ bf16_t f2bf(float f) { unsigned u = __float_as_uint(f); u += 0x7FFFu + ((u >> 16) & 1u); return (bf16_t)(u >> 16); }
__device__ __forceinline__ unsigned pack2(float a, float b) { return (unsigned)f2bf(a) | ((unsigned)f2bf(b) << 16); }
__device__ __forceinline__ float silu_f(float x) { return x / (1.f + expf(-x)); }
__device__ __forceinline__ float softplus_f(float x) { return fmaxf(x, 0.f) + log1pf(expf(-fabsf(x))); }
__device__ __forceinline__ float logsigmoid_f(float x) { return fminf(x, 0.f) - log1pf(expf(-fabsf(x))); }
__device__ __forceinline__ int cond_of_row(int m) { return m < MC ? 0 : 1 + (m - MC) / LT; }
typedef float vf4 __attribute__((ext_vector_type(4)));
__device__ __forceinline__ void conv_tile(const float* __restrict__ src, int ld_src, int ncols_src, int k0, int c0, bf16_t* __restrict__ dst, int ld_dst, int n0, float* tile) {
    const int tid = opaque_tid();
    {
        const int r = tid >> 3, c = (tid & 7) * 8;
        float4 a = make_float4(0.f, 0.f, 0.f, 0.f), b = a;
        if (c0 + c + 8 <= ncols_src) {
            const float* s = src + (size_t)(k0 + r) * ld_src + c0 + c;
            a = *(const float4*)s; b = *(const float4*)(s + 4);
        }
        float* t = tile + r * 65 + c;
        t[0] = a.x; t[1] = a.y; t[2] = a.z; t[3] = a.w; t[4] = b.x; t[5] = b.y; t[6] = b.z; t[7] = b.w;
    }
    __syncthreads();
    {
        const int n = tid >> 3, ks = (tid & 7) * 8;
        const float* t = tile + ks * 65 + n;
        uint4 w;
        w.x = pack2(t[0 * 65], t[1 * 65]); w.y = pack2(t[2 * 65], t[3 * 65]); w.z = pack2(t[4 * 65], t[5 * 65]); w.w = pack2(t[6 * 65], t[7 * 65]);
        *(uint4*)(dst + (size_t)(n0 + n) * ld_dst + k0 + ks) = w;
    }
    __syncthreads();
}

constexpr int MOD_ITEMS = DEPTH * (NMOD / 128);
constexpr int TGU_KT = DM / 64, TGU_NT = NGU / 64, TDN_KT = FF / 64, TDN_NT = DM / 64, TIN_KT = DM / 64, TIN_NT = NINP / 64, TOUT_KT = DM / 64, TOUT_NT = DM / 64;
constexpr int T_GU = DEPTH * 2 * TGU_KT * TGU_NT, T_DN = DEPTH * 2 * TDN_KT * TDN_NT, T_IN = DEPTH * TIN_KT * TIN_NT, T_OUT = DEPTH * TOUT_KT * TOUT_NT;

__device__ __forceinline__ void phase_prologue(const Params& p, float* smem) {
    const int tid = opaque_tid(), nb = gridDim.x, bid = blockIdx.x;
    float* s_cond = smem;
    float* s_red = s_cond + NCOND * DM;
    float* s_tile = s_red + 3 * 128 * NCOND;
    for (int i = tid; i < NCOND * DM; i += 512) { const int ci = i / DM, k = i % DM; const float v = ci == 0 ? p.in[I_CCTX][k] : p.in[I_C][(size_t)(ci - 1) * DM + k]; s_cond[i] = silu_f(v); }
    __syncthreads();
    float* modv = WSP(float, WS_MODV);
    for (int it = bid; it < MOD_ITEMS; it += nb) {
        const int l = it / (NMOD / 128), jt = it % (NMOD / 128);
        const int cl = tid & 127, kq = tid >> 7, col = jt * 128 + cl;
        const float* w = p.in[I_WMOD] + (size_t)l * DM * NMOD + col;
        float acc[NCOND];
#pragma unroll
        for (int ci = 0; ci < NCOND; ++ci) acc[ci] = 0.f;
        for (int k = kq * 512; k < kq * 512 + 512; k += 8) {
            float wv[8];
#pragma unroll
            for (int j = 0; j < 8; ++j) wv[j] = w[(size_t)(k + j) * NMOD];
#pragma unroll
            for (int ci = 0; ci < NCOND; ++ci) {
                const float4 s0 = *(const float4*)&s_cond[ci * DM + k], s1 = *(const float4*)&s_cond[ci * DM + k + 4];
                acc[ci] += s0.x * wv[0] + s0.y * wv[1] + s0.z * wv[2] + s0.w * wv[3] + s1.x * wv[4] + s1.y * wv[5] + s1.z * wv[6] + s1.w * wv[7];
            }
        }
        if (kq > 0) {
#pragma unroll
            for (int ci = 0; ci < NCOND; ++ci) s_red[((kq - 1) * 128 + cl) * NCOND + ci] = acc[ci];
        }
        __syncthreads();
        if (kq == 0) {
            const float bm = p.in[I_BMOD][(size_t)l * NMOD + col];
#pragma unroll
            for (int ci = 0; ci < NCOND; ++ci)
                modv[((size_t)l * NCOND + ci) * NMOD + col] = acc[ci] + s_red[(0 * 128 + cl) * NCOND + ci] + s_red[(1 * 128 + cl) * NCOND + ci] + s_red[(2 * 128 + cl) * NCOND + ci] + bm;
        }
        __syncthreads();
    }
    for (int it = bid; it < T_GU + T_DN + T_IN + T_OUT; it += nb) {
        if (it < T_GU) {
            const int mat = it / (TGU_KT * TGU_NT), r = it % (TGU_KT * TGU_NT), kt = r / TGU_NT, nt = r % TGU_NT;
            const int n0 = nt * 64, t256 = n0 / 256, c = n0 % 256;
            const int c0 = c < 128 ? 128 * t256 + c : FF + 128 * t256 + (c - 128);
            conv_tile(p.in[I_GU] + (size_t)mat * DM * NGU, NGU, NGU, kt * 64, c0, WSP(bf16_t, WS_WGU) + (size_t)mat * NGU * DM, DM, n0, s_tile);
        } else if (it < T_GU + T_DN) {
            const int i2 = it - T_GU, mat = i2 / (TDN_KT * TDN_NT), r = i2 % (TDN_KT * TDN_NT), kt = r / TDN_NT, nt = r % TDN_NT;
            conv_tile(p.in[I_DOWN] + (size_t)mat * FF * DM, DM, DM, kt * 64, nt * 64, WSP(bf16_t, WS_WDN) + (size_t)mat * DM * FF, FF, nt * 64, s_tile);
        } else if (it < T_GU + T_DN + T_IN) {
            const int i2 = it - T_GU - T_DN, mat = i2 / (TIN_KT * TIN_NT), r = i2 % (TIN_KT * TIN_NT), kt = r / TIN_NT, nt = r % TIN_NT;
            conv_tile(p.in[I_WIN] + (size_t)mat * DM * NIN, NIN, NIN, kt * 64, nt * 64, WSP(bf16_t, WS_WIN) + (size_t)mat * NINP * DM, DM, nt * 64, s_tile);
        } else {
            const int i2 = it - T_GU - T_DN - T_IN, mat = i2 / (TOUT_KT * TOUT_NT), r = i2 % (TOUT_KT * TOUT_NT), kt = r / TOUT_NT, nt = r % TOUT_NT;
            conv_tile(p.in[I_WOUT] + (size_t)mat * DM * DM, DM, DM, kt * 64, nt * 64, WSP(bf16_t, WS_WOUT) + (size_t)mat * DM * DM, DM, nt * 64, s_tile);
        }
    }
    const size_t gtid = (size_t)bid * 512 + tid, gstride = (size_t)nb * 512;
    {
        float4* X = WSP(float4, WS_X);
        const float4* xp = (const float4*)p.in[I_XP]; const float4* xs = (const float4*)p.in[I_XS];
        const size_t nc = (size_t)MC * DM / 4, n = (size_t)M * DM / 4;
        for (size_t i = gtid; i < n; i += gstride) X[i] = i < nc ? xp[i] : xs[i - nc];
    }
    {
        const size_t n_na = (size_t)LB * DEPTH * 256 * 512 / 8;
        for (size_t i = gtid; i < 2 * n_na; i += gstride) {
            const bool isv = i >= n_na; const size_t j = isv ? i - n_na : i;
            const int d8 = (int)(j % 16), h = (int)((j / 16) % 4), t = (int)((j / 64) % 256); const size_t bl = j / (64 * 256);
            const float* s = p.in[isv ? I_CNAV : I_CNAK] + ((bl * 4 + h) * 256 + t) * 128 + d8 * 8;
            const float4 a = *(const float4*)s, b = *(const float4*)(s + 4);
            uint4 w; w.x = pack2(a.x, a.y); w.y = pack2(a.z, a.w); w.z = pack2(b.x, b.y); w.w = pack2(b.z, b.w);
            *(uint4*)(WSP(bf16_t, isv ? WS_CNAV : WS_CNAK) + (bl * 256 + t) * 512 + h * 128 + d8 * 8) = w;
        }
        const size_t n_g = (size_t)LB * DEPTH * 256 * 256 / 8;
        for (size_t i = gtid; i < 2 * n_g; i += gstride) {
            const bool isv = i >= n_g; const size_t j = isv ? i - n_g : i;
            const int d8 = (int)(j % 16), h = (int)((j / 16) % 2), t = (int)((j / 32) % 256); const size_t bl = j / (32 * 256);
            const float* s = p.in[isv ? I_CGV : I_CGK] + ((bl * 2 + h) * 256 + t) * 128 + d8 * 8;
            const float4 a = *(const float4*)s, b = *(const float4*)(s + 4);
            uint4 w; w.x = pack2(a.x, a.y); w.y = pack2(a.z, a.w); w.z = pack2(b.x, b.y); w.w = pack2(b.z, b.w);
            *(uint4*)(WSP(bf16_t, isv ? WS_CGV : WS_CGK) + (bl * 256 + t) * 256 + h * 128 + d8 * 8) = w;
        }
    }
    for (size_t i = gtid; i < 64 * 32; i += gstride) {
        const int pos = (int)(i / 32), k = (int)(i % 32);
        const float inv = powf(10000.0f, -(float)(2 * k) / 64.0f);
        const float ang = (float)pos * inv;
        WSP(float, WS_ROPE)[i] = cosf(ang); WSP(float, WS_ROPE)[64 * 32 + i] = sinf(ang);
    }
}

__device__ __forceinline__ void phase_norm(const Params& p, int l, int which  ) {
    const int tid = opaque_tid(), lane = tid & 63, wv = tid >> 6;
    const float* X = WSP(float, WS_X); bf16_t* H = WSP(bf16_t, WS_H);
    const float* g = p.in[I_NORMG] + ((size_t)l * 3 + which) * DM;
    for (int m = blockIdx.x * 8 + wv; m < M; m += gridDim.x * 8) {
        const int ci = cond_of_row(m);
        const float* mv = WSP(float, WS_MODV) + ((size_t)l * NCOND + ci) * NMOD + (size_t)which * 3 * DM;
        const float* x = X + (size_t)m * DM;
        vf4 v[8]; float ss = 0.f;
#pragma unroll
        for (int i = 0; i < 8; ++i) { v[i] = *(const vf4*)(x + (i * 64 + lane) * 4); ss += v[i].x * v[i].x + v[i].y * v[i].y + v[i].z * v[i].z + v[i].w * v[i].w; }
        ss = wave_sum(ss);
        const float r = 1.0f / sqrtf(ss * (1.0f / DM) + EPS);
#pragma unroll
        for (int i = 0; i < 8; ++i) {
            const int c = (i * 64 + lane) * 4;
            const float4 gg = *(const float4*)(g + c), sh = *(const float4*)(mv + c), sc = *(const float4*)(mv + DM + c);
            const float o0 = v[i].x * r * gg.x * (1.f + sc.x) + sh.x, o1 = v[i].y * r * gg.y * (1.f + sc.y) + sh.y;
            const float o2 = v[i].z * r * gg.z * (1.f + sc.z) + sh.z, o3 = v[i].w * r * gg.w * (1.f + sc.w) + sh.w;
            uint2 w; w.x = pack2(o0, o1); w.y = pack2(o2, o3);
            *(uint2*)(H + (size_t)m * DM + c) = w;
        }
    }
}

#define PREP_FENCE() asm volatile("" ::: "memory")
__device__ __forceinline__ void phase_prep(const Params& p, int l) {
    const int tid = opaque_tid(), lane = tid & 63, wv = tid >> 6;
    const float* Z = WSP(float, WS_Z);
    const float* ropec = WSP(float, WS_ROPE); const float* ropes = ropec + 64 * 32;
    for (int m = blockIdx.x * 8 + wv; m < M; m += gridDim.x * 8) {
        const float* z = Z + (size_t)m * NINP;
        const bool ctx = m < MC;
        const int b = ctx ? m / CT : (m - MC) / LT, t = ctx ? m % CT : (m - MC) % LT, T = ctx ? CT : LT;
        {
            const float* wq = p.in[I_NAQKN] + ((size_t)l * 2 + 0) * 128; const float* wk = wq + 128;
#pragma unroll 1
            for (int h = 0; h < 4; ++h) {
                float a = z[Z_NAQ + h * 128 + lane], c = z[Z_NAQ + h * 128 + 64 + lane];
                float r = 1.0f / sqrtf(wave_sum(a * a + c * c) * (1.0f / 128) + EPS);
                bf16_t* q = WSP(bf16_t, WS_NAQ) + (size_t)m * 512 + h * 128;
                q[lane] = f2bf(a * r * wq[lane]); q[64 + lane] = f2bf(c * r * wq[64 + lane]);
                a = z[Z_NAK + h * 128 + lane]; c = z[Z_NAK + h * 128 + 64 + lane];
                r = 1.0f / sqrtf(wave_sum(a * a + c * c) * (1.0f / 128) + EPS);
                const float k0 = a * r * wk[lane], k1 = c * r * wk[64 + lane];
                bf16_t* k = WSP(bf16_t, WS_NAK) + (size_t)m * 512 + h * 128;
                k[lane] = f2bf(k0); k[64 + lane] = f2bf(k1);
                const float v0 = z[Z_NAV + h * 128 + lane], v1 = z[Z_NAV + h * 128 + 64 + lane];
                bf16_t* v = WSP(bf16_t, WS_NAV) + (size_t)m * 512 + h * 128;
                v[lane] = f2bf(v0); v[64 + lane] = f2bf(v1);
                if (ctx) {
                    const size_t o = ((((size_t)b * DEPTH + l) * 4 + h) * CT + t) * 128;
                    p.out[O_NAK + o + lane] = k0; p.out[O_NAK + o + 64 + lane] = k1;
                    p.out[O_NAV + o + lane] = v0; p.out[O_NAV + o + 64 + lane] = v1;
                }
            }
        }
        PREP_FENCE();
        {
            const float* wq = p.in[I_GQAQKN] + ((size_t)l * 2 + 0) * 128; const float* wk = wq + 128;
            const int grow = t >> 6, gcol = t & 63, i32 = lane & 31;
            const float cr = ropec[grow * 32 + i32], sr = ropes[grow * 32 + i32], cc = ropec[gcol * 32 + i32], sc = ropes[gcol * 32 + i32];
#pragma unroll 1
            for (int h = 0; h < 6; ++h) {
                const int zo = h < 4 ? Z_GQQ + h * 128 : Z_GQK + (h - 4) * 128;
                float a = z[zo + lane], c = z[zo + 64 + lane];
                const float r = 1.0f / sqrtf(wave_sum(a * a + c * c) * (1.0f / 128) + EPS);
                const float* w = h < 4 ? wq : wk;
                a = a * r * w[lane]; c = c * r * w[64 + lane];
                if (!ctx) {
                    const float pa = __shfl_xor(a, 32), pc = __shfl_xor(c, 32);
                    a = lane < 32 ? a * cr - pa * sr : pa * sr + a * cr;
                    c = lane < 32 ? c * cc - pc * sc : pc * sc + c * cc;
                }
                if (h < 4) { bf16_t* q = WSP(bf16_t, WS_GQ) + (size_t)m * 512 + h * 128; q[lane] = f2bf(a); q[64 + lane] = f2bf(c); }
                else {
                    bf16_t* k = WSP(bf16_t, WS_GK) + (size_t)m * 256 + (h - 4) * 128; k[lane] = f2bf(a); k[64 + lane] = f2bf(c);
                    const float v0 = z[Z_GQV + (h - 4) * 128 + lane], v1 = z[Z_GQV + (h - 4) * 128 + 64 + lane];
                    bf16_t* v = WSP(bf16_t, WS_GV) + (size_t)m * 256 + (h - 4) * 128; v[lane] = f2bf(v0); v[64 + lane] = f2bf(v1);
                    if (ctx) {
                        const size_t o = ((((size_t)b * DEPTH + l) * 2 + (h - 4)) * CT + t) * 128;
                        p.out[O_GK + o + lane] = a; p.out[O_GK + o + 64 + lane] = c;
                        p.out[O_GV + o + lane] = v0; p.out[O_GV + o + 64 + lane] = v1;
                    }
                }
            }
        }
        PREP_FENCE();
        {
#pragma unroll 1
            for (int dir = 0; dir < 2; ++dir) {
                const float* up = p.in[I_GUP] + ((size_t)l * 2 + dir) * 16 * 256;
                const float* bias = p.in[I_GBIAS] + ((size_t)l * 2 + dir) * 256;
                const float gmine = z[(dir ? Z_GB : Z_GF) + (lane & 15)];
                float gsum[4];
#pragma unroll
                for (int i = 0; i < 4; ++i) gsum[i] = bias[lane + 64 * i];
#pragma unroll
                for (int r = 0; r < 16; ++r) {
                    const float gv = __shfl(gmine, r);
#pragma unroll
                    for (int i = 0; i < 4; ++i) gsum[i] += gv * up[r * 256 + lane + 64 * i];
                }
                float* A = WSP(float, dir ? WS_AB : WS_AF) + (size_t)m * 256;
#pragma unroll
                for (int i = 0; i < 4; ++i) A[lane + 64 * i] = expf(logsigmoid_f(gsum[i]) * (1.0f / 16.0f));
                PREP_FENCE();
            }
        }
        {
            const float* cw = p.in[I_CONV] + (size_t)l * 5 * 1536;
#pragma unroll 1
            for (int part = 0; part < 3; ++part) {
                float val[8];
#pragma unroll
                for (int i = 0; i < 8; ++i) val[i] = 0.f;
#pragma unroll 1
                for (int j = 0; j < 5; ++j) {
                    const int tt = t + j - 2;
                    if (tt >= 0 && tt < T) {
                        const float* zz = Z + (size_t)(m + j - 2) * NINP + Z_DQKV + part * 512;
                        const float* cj = cw + j * 1536 + part * 512;
#pragma unroll
                        for (int i = 0; i < 8; ++i) val[i] += cj[lane + 64 * i] * zz[lane + 64 * i];
                    }
                }
#pragma unroll
                for (int i = 0; i < 8; ++i) val[i] = silu_f(val[i]);
                float* dst = WSP(float, part == 0 ? WS_DQ : part == 1 ? WS_DK : WS_DV) + (size_t)m * 512;
#pragma unroll
                for (int h = 0; h < 4; ++h) {
                    float r = 1.0f;
                    if (part < 2) r = 1.0f / sqrtf(wave_sum(val[2 * h] * val[2 * h] + val[2 * h + 1] * val[2 * h + 1]) + EPS) * (part == 0 ? 0.08838834764831845f : 1.0f);
                    dst[h * 128 + lane] = val[2 * h] * r; dst[h * 128 + 64 + lane] = val[2 * h + 1] * r;
                }
                PREP_FENCE();
            }
            if (lane < 8) {
                const float beta = 1.0f / (1.0f + expf(-z[Z_DB + lane]));
                const float g = -expf(p.in[I_ALOG][(size_t)l * 8 + lane]) * softplus_f(z[Z_DA + lane] + p.in[I_DTB][(size_t)l * 8 + lane]);
                float* ba = WSP(float, WS_DBA) + (size_t)m * 16;
                ba[lane] = beta; ba[8 + lane] = expf(g);
            }
        }
        PREP_FENCE();
    }
}

__device__ __forceinline__ void gla_chain(const Params& p, int l, bool ctx, int b, int h, int dir, float* smem) {
    constexpr int TC = 64;
    const int tid = opaque_tid(), lane = tid & 63, wv = tid >> 6, e = wv * 16 + (lane >> 2), dg = lane & 3;
    const int T = ctx ? CT : LT; const size_t m0 = ctx ? (size_t)b * CT : (size_t)MC + (size_t)b * LT;
    const float* Z = WSP(float, WS_Z); const float* A = WSP(float, dir ? WS_AB : WS_AF);
    float* O = WSP(float, dir ? WS_GOB : WS_GOF);
    float* sq = smem; float* sk = sq + TC * 64; float* sa = sk + TC * 64; float* sv = sa + TC * 64;
    float S[16];
    if (ctx) {
#pragma unroll
        for (int i = 0; i < 16; ++i) S[i] = 0.f;
    } else {
        const float* s0 = p.in[I_SGLA] + (((((size_t)b * DEPTH + l) * 2 + dir) * 4 + h) * 64 + dg * 16) * 128 + e;
#pragma unroll
        for (int i = 0; i < 16; ++i) S[i] = s0[(size_t)i * 128];
    }
    vf4 pre[10];
    const int nch = T / TC;
#define GLA_LOAD(c) do { _Pragma("unroll") for (int i = 0; i < 10; ++i) { const int f = tid + 512 * i, s = f / 80, c4 = f % 80; \
        const int ti = (c) * TC + s, tt = dir ? T - 1 - ti : ti; const size_t m = m0 + tt; \
        const float* src = c4 < 16 ? Z + m * NINP + Z_GLQ + h * 64 + 4 * c4 : c4 < 32 ? Z + m * NINP + Z_GLK + h * 64 + 4 * (c4 - 16) \
                         : c4 < 48 ? A + m * 256 + h * 64 + 4 * (c4 - 32) : Z + m * NINP + Z_GLV + h * 128 + 4 * (c4 - 48); \
        pre[i] = *(const vf4*)src; } } while (0)
#define GLA_WRITE() do { _Pragma("unroll") for (int i = 0; i < 10; ++i) { const int f = tid + 512 * i, s = f / 80, c4 = f % 80; \
        vf4 v = pre[i]; if (c4 < 16) v *= 0.125f; \
        float* dst = c4 < 16 ? sq + s * 64 + 4 * c4 : c4 < 32 ? sk + s * 64 + 4 * (c4 - 16) : c4 < 48 ? sa + s * 64 + 4 * (c4 - 32) : sv + s * 128 + 4 * (c4 - 48); \
        *(vf4*)dst = v; } } while (0)
    __syncthreads();
    GLA_LOAD(0); GLA_WRITE(); __syncthreads();
    for (int c = 0; c < nch; ++c) {
        if (c + 1 < nch) GLA_LOAD(c + 1);
        for (int s = 0; s < TC; ++s) {
            const float ve = sv[s * 128 + e];
            float po = 0.f;
#pragma unroll
            for (int i4 = 0; i4 < 4; ++i4) {
                const vf4 q4 = *(const vf4*)(sq + s * 64 + dg * 16 + 4 * i4), k4 = *(const vf4*)(sk + s * 64 + dg * 16 + 4 * i4), a4 = *(const vf4*)(sa + s * 64 + dg * 16 + 4 * i4);
                S[4 * i4 + 0] = a4.x * S[4 * i4 + 0] + k4.x * ve; po += q4.x * S[4 * i4 + 0];
                S[4 * i4 + 1] = a4.y * S[4 * i4 + 1] + k4.y * ve; po += q4.y * S[4 * i4 + 1];
                S[4 * i4 + 2] = a4.z * S[4 * i4 + 2] + k4.z * ve; po += q4.z * S[4 * i4 + 2];
                S[4 * i4 + 3] = a4.w * S[4 * i4 + 3] + k4.w * ve; po += q4.w * S[4 * i4 + 3];
            }
            po += __shfl_xor(po, 1); po += __shfl_xor(po, 2);
            if (dg == 0) { const int ti = c * TC + s, tt = dir ? T - 1 - ti : ti; O[(m0 + tt) * 512 + h * 128 + e] = po; }
        }
        __syncthreads();
        if (c + 1 < nch) GLA_WRITE();
        __syncthreads();
    }
#undef GLA_LOAD
#undef GLA_WRITE
    if (ctx) {
        float* so = p.out + O_SGLA + (((((size_t)b * DEPTH + l) * 2 + dir) * 4 + h) * 64 + dg * 16) * 128 + e;
#pragma unroll
        for (int i = 0; i < 16; ++i) so[(size_t)i * 128] = S[i];
    }
}

__device__ __forceinline__ void gdn_chain(const Params& p, int l, bool ctx, int b, int h, int dir, float* smem) {
    constexpr int TC = 32;
    const int tid = opaque_tid(), lane = tid & 63, wv = tid >> 6, e = wv * 16 + (lane >> 2), dg = lane & 3;
    const int T = ctx ? CT : LT; const size_t m0 = ctx ? (size_t)b * CT : (size_t)MC + (size_t)b * LT;
    const float* DQ = WSP(float, WS_DQ); const float* DK = WSP(float, WS_DK); const float* DV = WSP(float, WS_DV); const float* DBA = WSP(float, WS_DBA);
    float* O = WSP(float, dir ? WS_DOB : WS_DOF);
    float* sq = smem; float* sk = sq + TC * 128; float* sv = sk + TC * 128; float* sba = sv + TC * 128;
    float S[32];
    if (ctx) {
#pragma unroll
        for (int i = 0; i < 32; ++i) S[i] = 0.f;
    } else {
        const float* s0 = p.in[I_SGDN] + (((((size_t)b * DEPTH + l) * 2 + dir) * 4 + h) * 128 + dg * 32) * 128 + e;
#pragma unroll
        for (int i = 0; i < 32; ++i) S[i] = s0[(size_t)i * 128];
    }
    vf4 pre[6]; float pre_s = 0.f;
    const int nch = T / TC;
#define GDN_LOAD(c) do { _Pragma("unroll") for (int i = 0; i < 6; ++i) { const int f = tid + 512 * i, s = f / 96, c4 = f % 96; \
        const int ti = (c) * TC + s, tt = dir ? T - 1 - ti : ti; const size_t m = m0 + tt; \
        const float* src = c4 < 32 ? DQ + m * 512 + h * 128 + 4 * c4 : c4 < 64 ? DK + m * 512 + h * 128 + 4 * (c4 - 32) : DV + m * 512 + h * 128 + 4 * (c4 - 64); \
        pre[i] = *(const vf4*)src; } \
        if (tid < 2 * TC) { const int s = tid >> 1, ti = (c) * TC + s, tt = dir ? T - 1 - ti : ti; pre_s = DBA[(m0 + tt) * 16 + (tid & 1) * 8 + dir * 4 + h]; } } while (0)
#define GDN_WRITE() do { _Pragma("unroll") for (int i = 0; i < 6; ++i) { const int f = tid + 512 * i, s = f / 96, c4 = f % 96; \
        float* dst = c4 < 32 ? sq + s * 128 + 4 * c4 : c4 < 64 ? sk + s * 128 + 4 * (c4 - 32) : sv + s * 128 + 4 * (c4 - 64); \
        *(vf4*)dst = pre[i]; } if (tid < 2 * TC) sba[tid] = pre_s; } while (0)
    __syncthreads();
    GDN_LOAD(0); GDN_WRITE(); __syncthreads();
    for (int c = 0; c < nch; ++c) {
        if (c + 1 < nch) GDN_LOAD(c + 1);
        for (int s = 0; s < TC; ++s) {
            const float be = sba[2 * s], a = sba[2 * s + 1], ve = sv[s * 128 + e];
            vf4 k4[8];
            float pk = 0.f;
#pragma unroll
            for (int i4 = 0; i4 < 8; ++i4) {
                k4[i4] = *(const vf4*)(sk + s * 128 + dg * 32 + 4 * i4);
                pk += k4[i4].x * S[4 * i4 + 0] + k4[i4].y * S[4 * i4 + 1] + k4[i4].z * S[4 * i4 + 2] + k4[i4].w * S[4 * i4 + 3];
            }
            pk += __shfl_xor(pk, 1); pk += __shfl_xor(pk, 2);
            const float vn = be * (ve - a * pk);
            float po = 0.f;
#pragma unroll
            for (int i4 = 0; i4 < 8; ++i4) {
                const vf4 q4 = *(const vf4*)(sq + s * 128 + dg * 32 + 4 * i4);
                S[4 * i4 + 0] = a * S[4 * i4 + 0] + k4[i4].x * vn; po += q4.x * S[4 * i4 + 0];
                S[4 * i4 + 1] = a * S[4 * i4 + 1] + k4[i4].y * vn; po += q4.y * S[4 * i4 + 1];
                S[4 * i4 + 2] = a * S[4 * i4 + 2] + k4[i4].z * vn; po += q4.z * S[4 * i4 + 2];
                S[4 * i4 + 3] = a * S[4 * i4 + 3] + k4[i4].w * vn; po += q4.w * S[4 * i4 + 3];
            }
            po += __shfl_xor(po, 1); po += __shfl_xor(po, 2);
            if (dg == 0) { const int ti = c * TC + s, tt = dir ? T - 1 - ti : ti; O[(m0 + tt) * 512 + h * 128 + e] = po; }
        }
        __syncthreads();
        if (c + 1 < nch) GDN_WRITE();
        __syncthreads();
    }
#undef GDN_LOAD
#undef GDN_WRITE
    if (ctx) {
        float* so = p.out + O_SGDN + (((((size_t)b * DEPTH + l) * 2 + dir) * 4 + h) * 128 + dg * 32) * 128 + e;
#pragma unroll
        for (int i = 0; i < 32; ++i) so[(size_t)i * 128] = S[i];
    }
}

__device__ __forceinline__ void phase_post(const Params& p, int l) {
    const int tid = opaque_tid(), lane = tid & 63, wv = tid >> 6;
    const float* Z = WSP(float, WS_Z); bf16_t* MRG = WSP(bf16_t, WS_MRG);
    const float* wg = p.in[I_GLAON] + (size_t)l * 128; const float* wd = p.in[I_GDNON] + (size_t)l * 128;
    for (int m = blockIdx.x * 8 + wv; m < M; m += gridDim.x * 8) {
        const float* z = Z + (size_t)m * NINP;
#pragma unroll
        for (int g = 0; g < 2; ++g) {
            const float* of = WSP(float, g ? WS_DOF : WS_GOF) + (size_t)m * 512; const float* ob = WSP(float, g ? WS_DOB : WS_GOB) + (size_t)m * 512;
            const float* w = g ? wd : wg; const int zg = g ? Z_DZ : Z_GLR, mc = g ? 1536 : 512;
#pragma unroll
            for (int h = 0; h < 4; ++h) {
                const float a = of[h * 128 + lane] + ob[h * 128 + lane], c = of[h * 128 + 64 + lane] + ob[h * 128 + 64 + lane];
                const float r = 1.0f / sqrtf(wave_sum(a * a + c * c) * (1.0f / 128) + EPS);
                bf16_t* o = MRG + (size_t)m * DM + mc + h * 128;
                o[lane] = f2bf(a * r * w[lane] * silu_f(z[zg + h * 128 + lane]));
                o[64 + lane] = f2bf(c * r * w[64 + lane] * silu_f(z[zg + h * 128 + 64 + lane]));
            }
        }
    }
}
#define XB_TMO      128
#define XB_XCNT(j)  (256  + 64 * (j))
#define XB_XSUB(j)  (1280 + 64 * (j))
#define XB_XGEN(j)  (2304 + 64 * (j))
#define XB_TOP      3328
#define XB_TOPGEN   3392
#define XCD_BAR_WORDS 3456
#define XB_SPIN_CAP (1u << 22)
#define LAS __attribute__((address_space(3)))

__device__ __forceinline__ unsigned xb_ld(unsigned* p)              { return __hip_atomic_load(p, __ATOMIC_RELAXED, __HIP_MEMORY_SCOPE_AGENT); }
__device__ __forceinline__ unsigned xb_add(unsigned* p, unsigned v) { return __hip_atomic_fetch_add(p, v, __ATOMIC_RELAXED, __HIP_MEMORY_SCOPE_AGENT); }
__device__ __forceinline__ unsigned xb_xcc_id() { return (unsigned)__builtin_amdgcn_s_getreg((3 << 11) | 20) & 0xFu; }
#define XB_SPIN(cond, bar) do { unsigned _sp = 0; while (cond) { __builtin_amdgcn_s_sleep(1); \
    if ((++_sp & 255u) == 0u) { if (xb_ld(&(bar)[XB_TMO])) break; if (_sp > XB_SPIN_CAP) { atomicAdd(&(bar)[XB_TMO], 1u); break; } } } } while (0)

struct XcdBarrier {
    unsigned* bar; unsigned x;
    volatile LAS unsigned* st;
};

__device__ __forceinline__ XcdBarrier xcd_barrier_post(unsigned* bar, volatile LAS unsigned* st) {
    XcdBarrier b; b.bar = bar; b.x = xb_xcc_id(); b.st = st;
    if (threadIdx.x == 0) (void)xb_add(&bar[XB_XCNT(b.x)], 1u);
    return b;
}
__device__ __forceinline__ void xcd_barrier_complete(unsigned* bar, unsigned x, unsigned& nloc, unsigned& nx) {
    const unsigned G = gridDim.x * gridDim.y * gridDim.z;
    unsigned sum, cnt, mine, sp = 0u;
    for (;;) {
        sum = 0u; cnt = 0u; mine = 0u;
#pragma unroll
        for (unsigned j = 0; j < 16; ++j) { const unsigned c = xb_ld(&bar[XB_XCNT(j)]); sum += c; cnt += (c > 0u) ? 1u : 0u; mine = (j == x) ? c : mine; }
        if (sum == G) break;
        __builtin_amdgcn_s_sleep(1);
        if ((++sp & 255u) == 0u) { if (xb_ld(&bar[XB_TMO])) break; if (sp > XB_SPIN_CAP) { atomicAdd(&bar[XB_TMO], 1u); break; } }
    }
    nloc = mine > 0u ? mine : 1u; nx = cnt > 0u ? cnt : 1u;
}

__device__ __forceinline__ void xcd_barrier(const XcdBarrier& b) {
    asm volatile("s_waitcnt vmcnt(0)" ::: "memory");
    __syncthreads();
    if (threadIdx.x == 0) {
        unsigned* bar = b.bar;
        __builtin_amdgcn_s_waitcnt(0);
        unsigned nloc = b.st[0], nx = b.st[1];
        if (nloc == 0u) { xcd_barrier_complete(bar, b.x, nloc, nx); b.st[0] = nloc; b.st[1] = nx; }
        const unsigned old = xb_add(&bar[XB_XSUB(b.x)], 1u);
        const unsigned gen = old / nloc;
        if (old + 1u == (gen + 1u) * nloc) {
            __builtin_amdgcn_fence(__ATOMIC_RELEASE, "agent");
            asm volatile("s_waitcnt vmcnt(0)" ::: "memory");
            const unsigned og = xb_add(&bar[XB_TOP], 1u);
            const unsigned tg = og / nx;
            if (og + 1u == (tg + 1u) * nx) xb_add(&bar[XB_TOPGEN], 1u);
            else XB_SPIN(xb_ld(&bar[XB_TOPGEN]) == tg, bar);
            __builtin_amdgcn_fence(__ATOMIC_ACQUIRE, "agent");
            xb_add(&bar[XB_XGEN(b.x)], 1u);
            asm volatile("s_waitcnt vmcnt(0)" ::: "memory");
        } else {
            XB_SPIN(xb_ld(&bar[XB_XGEN(b.x)]) == gen, bar);
            __builtin_amdgcn_fence(__ATOMIC_ACQUIRE, "agent");
            asm volatile("s_waitcnt vmcnt(0)" ::: "memory");
        }
    }
    __syncthreads();
}

namespace pg8 {
#define PG8_LAS __attribute__((address_space(3)))
typedef unsigned short bf16_t;
typedef short bf16x8 __attribute__((ext_vector_type(8)));
typedef float f32x4 __attribute__((ext_vector_type(4)));
typedef unsigned u32x4 __attribute__((ext_vector_type(4)));
constexpr int BM = 256, BK = 64, HALF = 128, HTB = HALF * BK * 2  , STAGE_BYTES = 8 * HTB, NXCD = 8, WGM = 8;

__host__ __device__ __forceinline__ int lds_byte(int r, int c) { const int st = (r >> 4) * 2 + (c >> 5), rr = r & 15, cc = c & 31, ob = rr * 64 + cc * 2; return st * 1024 + (ob ^ (((ob >> 9) & 1) << 5)); }
__host__ __device__ __forceinline__ void stage_rc(int b, int& R, int& C) { const int st = b / 1024, sb = b % 1024, swz = sb ^ (((sb >> 9) & 1) << 5); R = (st >> 1) * 16 + swz / 64; C = (st & 1) * 32 + (swz % 64) / 2; }
__host__ __device__ __forceinline__ int perm32(int rho) { const int n = rho >> 4, i = rho & 15; return 8 * (i >> 2) + 4 * n + (i & 3); }

struct Unit { int pm, pn; };
struct Gemm { const bf16_t* A; const bf16_t* Bt; int M, N, K; };

struct StaticOrder {
    int nM, nN, nwg, G, c;
    __host__ __device__ void init(int M, int N, int G_, int c_) { nM = M / BM; nN = N / BM; nwg = nM * nN; G = G_; c = c_; }
    __host__ __device__ bool next(int i, Unit& u) const {
        const long L = (long)i * G + c; if (L >= nwg) return false;
        int wgid = (int)L; { const int q = nwg / NXCD, r = nwg % NXCD, xcd = wgid % NXCD, off = wgid / NXCD; wgid = (xcd < r ? xcd * (q + 1) : r * (q + 1) + (xcd - r) * q) + off; }
        const int nig = WGM * nN, gid = wgid / nig, fm = gid * WGM, gsz = (nM - fm) < WGM ? (nM - fm) : WGM;
        u.pm = fm + ((wgid % nig) % gsz); u.pn = (wgid % nig) / gsz; return true;
    }
    __device__ __forceinline__ void a_ready(const Unit&) const {}
    __device__ __forceinline__ void done(const Unit&) const {}
};
__device__ __forceinline__ unsigned cvt_pk_bf16(float lo, float hi) { unsigned r; asm volatile("v_cvt_pk_bf16_f32 %0, %1, %2" : "=v"(r) : "v"(lo), "v"(hi)); return r; }
struct EpiF32 {
    static constexpr bool PERM = false, AFTER_DRAIN = false;
    float* C; int ldc; const float* bias;
    __device__ __forceinline__ void operator()(const f32x4 (&acc)[2][2][4][2], const Unit& u, int wr, int wc, int fr, int fq) const {
        const int row0 = u.pm * BM + wr * 64 + fr, col0 = u.pn * BM + wc * 32 + 4 * fq;
        f32x4 bv[2][2];
#pragma unroll
        for (int bj = 0; bj < 2; ++bj)
#pragma unroll
            for (int n = 0; n < 2; ++n) bv[bj][n] = bias ? *(const f32x4*)(bias + col0 + bj * HALF + n * 16) : (f32x4){0.f, 0.f, 0.f, 0.f};
#pragma unroll
        for (int ai = 0; ai < 2; ++ai)
#pragma unroll
            for (int m = 0; m < 4; ++m) { float* rowp = C + (size_t)(row0 + ai * HALF + m * 16) * ldc + col0;
#pragma unroll
                for (int bj = 0; bj < 2; ++bj)
#pragma unroll
                    for (int n = 0; n < 2; ++n) *(f32x4*)(rowp + bj * HALF + n * 16) = acc[ai][bj][m][n] + bv[bj][n]; }
    }
};

struct EpiSwiGLU {
    static constexpr bool PERM = true, AFTER_DRAIN = false;
    bf16_t* O; int ldc;
    __device__ __forceinline__ void operator()(const f32x4 (&acc)[2][2][4][2], const Unit& u, int wr, int wc, int fr, int fq) const {
        const int row0 = u.pm * BM + wr * 64 + fr, col0 = u.pn * 128 + wc * 32 + 8 * fq;
#pragma unroll
        for (int ai = 0; ai < 2; ++ai)
#pragma unroll
            for (int m = 0; m < 4; ++m) { bf16_t* rowp = O + (size_t)(row0 + ai * HALF + m * 16) * ldc + col0;
                const f32x4 g0 = acc[ai][0][m][0], g1 = acc[ai][0][m][1], u0 = acc[ai][1][m][0], u1 = acc[ai][1][m][1];
                float r[8];
#pragma unroll
                for (int j = 0; j < 4; ++j) {
                    r[j]     = g0[j] * __builtin_amdgcn_rcpf(1.0f + __builtin_amdgcn_exp2f(-1.4426950408889634f * g0[j])) * u0[j];
                    r[4 + j] = g1[j] * __builtin_amdgcn_rcpf(1.0f + __builtin_amdgcn_exp2f(-1.4426950408889634f * g1[j])) * u1[j]; }
                u32x4 w; w.x = cvt_pk_bf16(r[0], r[1]); w.y = cvt_pk_bf16(r[2], r[3]); w.z = cvt_pk_bf16(r[4], r[5]); w.w = cvt_pk_bf16(r[6], r[7]);
                *(u32x4*)rowp = w; }
    }
};
struct EpiResid {
    static constexpr bool PERM = false, AFTER_DRAIN = false;
    const float* res; float* out; int ldc; const float* gate0; float coef;
    __device__ __forceinline__ void operator()(const f32x4 (&acc)[2][2][4][2], const Unit& u, int wr, int wc, int fr, int fq) const {
        const int row0 = u.pm * BM + wr * 64 + fr, col0 = u.pn * BM + wc * 32 + 4 * fq;
        const float* gate = gate0 + (size_t)cond_of_row(u.pm * BM) * NMOD;
        f32x4 gv[2][2];
#pragma unroll
        for (int bj = 0; bj < 2; ++bj)
#pragma unroll
            for (int n = 0; n < 2; ++n) gv[bj][n] = *(const f32x4*)(gate + col0 + bj * HALF + n * 16) * coef;
#pragma unroll
        for (int ai = 0; ai < 2; ++ai)
#pragma unroll
            for (int m = 0; m < 4; ++m) { const size_t off = (size_t)(row0 + ai * HALF + m * 16) * ldc + col0;
#pragma unroll
                for (int bj = 0; bj < 2; ++bj)
#pragma unroll
                    for (int n = 0; n < 2; ++n) { const f32x4 bs = *(const f32x4*)(res + off + bj * HALF + n * 16); *(f32x4*)(out + off + bj * HALF + n * 16) = bs + gv[bj][n] * acc[ai][bj][m][n]; }
                asm volatile("" ::: "memory"); }
    }
};
template <class Epi, class Sched, bool STAMP = false>
__device__ __forceinline__ void gemm_phase(PG8_LAS unsigned char* lds, const Gemm g, const Sched& S, const Epi& E, unsigned long long* stamps) {
    const int tid = opaque_tid(), wid = __builtin_amdgcn_readfirstlane(tid >> 6), lane = tid & 63, wr = wid >> 2, wc = wid & 3, fr = lane & 15, fq = lane >> 4;
    const int K = g.K, nt = K / BK;
    int ts_lo = 0, ts_hi = 0, nts = 0; const unsigned long long rt_entry = STAMP ? (unsigned long long)wall_clock64() : 0ull;
#define PG8_STAMP() do { if (STAMP && wid == 0 && nts < 64) { const unsigned long long _c = (unsigned long long)clock64(); \
        ts_lo = (lane == nts) ? (int)(unsigned)_c : ts_lo; ts_hi = (lane == nts) ? (int)(unsigned)(_c >> 32) : ts_hi; ++nts; } } while (0)
    PG8_STAMP();
    unsigned voffA[2], voffB[2];
#pragma unroll
    for (int i = 0; i < 2; ++i) { int R, C; stage_rc(tid * 16 + i * 8192, R, C); const int Rb = Epi::PERM ? ((R & ~31) + perm32(R & 31)) : R;
        voffA[i] = (unsigned)(R * K + C) * 2u; voffB[i] = (unsigned)(Rb * K + C) * 2u; }
    const size_t kstep = (size_t)(BK * 2);
    const size_t hstep = (size_t)HALF * K * 2;
    const size_t tstep = 2 * hstep;
    const unsigned ldsw = (unsigned)wid * 1024u;
    const int aoff = lds_byte(wr * 64 + fr, fq * 8), boff = lds_byte(wc * 32 + fr, fq * 8);
#define PG8_SA(b, h) (((b) * 2 + (h)) * HTB)
#define PG8_SB(b, h) ((4 + (b) * 2 + (h)) * HTB)
#define PG8_STAGE(bufoff, gbase, voff) do { _Pragma("unroll") for (int _i = 0; _i < 2; ++_i) \
        __builtin_amdgcn_global_load_lds((const unsigned*)((const char*)(gbase) + (voff)[_i]), (PG8_LAS unsigned*)(lds + (bufoff) + ldsw + _i * 8192), 16, 0, 0); } while (0)
#define PG8_LDA(dst, b, h) do { _Pragma("unroll") for (int m = 0; m < 4; ++m) _Pragma("unroll") for (int k = 0; k < 2; ++k) dst[m][k] = *(const PG8_LAS bf16x8*)(lds + PG8_SA(b, h) + aoff + m * 2048 + k * 1024); } while (0)
#define PG8_LDB(dst, b, h) do { _Pragma("unroll") for (int n = 0; n < 2; ++n) _Pragma("unroll") for (int k = 0; k < 2; ++k) dst[n][k] = *(const PG8_LAS bf16x8*)(lds + PG8_SB(b, h) + boff + n * 2048 + k * 1024); } while (0)
#define PG8_MMA(ai, bj, At, Bt) do { __builtin_amdgcn_s_setprio(1); _Pragma("unroll") for (int m = 0; m < 4; ++m) _Pragma("unroll") for (int n = 0; n < 2; ++n) _Pragma("unroll") for (int k = 0; k < 2; ++k) \
        acc[ai][bj][m][n] = __builtin_amdgcn_mfma_f32_16x16x32_bf16(Bt[n][k], At[m][k], acc[ai][bj][m][n], 0, 0, 0); __builtin_amdgcn_s_setprio(0); } while (0)
#define PG8_WAIT_V(n) asm volatile("s_waitcnt vmcnt(" #n ")" ::: "memory")
#define PG8_WAIT_L(n) asm volatile("s_waitcnt lgkmcnt(" #n ")" ::: "memory")
#define PG8_BAR __builtin_amdgcn_s_barrier()
#define PG8_SCHED __builtin_amdgcn_sched_barrier(0)
    Unit cur, nxt; int ui = 0;
    if (!S.next(0, cur)) return;
    f32x4 acc[2][2][4][2];
#pragma unroll
    for (int a = 0; a < 2; ++a)
#pragma unroll
        for (int b = 0; b < 2; ++b)
#pragma unroll
            for (int m = 0; m < 4; ++m)
#pragma unroll
                for (int n = 0; n < 2; ++n) acc[a][b][m][n] = (f32x4){0.f, 0.f, 0.f, 0.f};
    bf16x8 At[4][2], B0[2][2], B1[2][2];
    const char* cA = (const char*)g.A + (size_t)cur.pm * tstep; const char* cB = (const char*)g.Bt + (size_t)cur.pn * tstep;
    S.a_ready(cur);
    PG8_STAGE(PG8_SB(0, 0), cB, voffB); PG8_STAGE(PG8_SA(0, 0), cA, voffA); PG8_STAGE(PG8_SB(0, 1), cB + hstep, voffB); PG8_STAGE(PG8_SA(0, 1), cA + hstep, voffA);
    if (wr == 1) PG8_BAR;
    PG8_WAIT_V(4); PG8_BAR;
    PG8_STAGE(PG8_SB(1, 0), cB + kstep, voffB); PG8_STAGE(PG8_SA(1, 0), cA + kstep, voffA); PG8_STAGE(PG8_SB(1, 1), cB + hstep + kstep, voffB);
    PG8_WAIT_V(6); PG8_BAR;
    PG8_STAMP();
    for (;;) {
        const bool has_next = S.next(ui + 1, nxt);
        const char* nA = has_next ? (const char*)g.A + (size_t)nxt.pm * tstep : cA; const char* nB = has_next ? (const char*)g.Bt + (size_t)nxt.pn * tstep : cB;
        for (int t = 0; t < nt; t += 2) {
            const bool last = (t == nt - 2);
            const char* a1 = cA + (size_t)(t + 1) * kstep;
            const char* a2 = last ? nA : cA + (size_t)(t + 2) * kstep; const char* b2 = last ? nB : cB + (size_t)(t + 2) * kstep;
            const char* a3 = a2 + kstep; const char* b3 = b2 + kstep;
            if (last && has_next) S.a_ready(nxt);
            PG8_LDB(B0, 0, 0); PG8_SCHED; PG8_LDA(At, 0, 0); PG8_STAGE(PG8_SA(1, 1), a1 + hstep, voffA);
            PG8_WAIT_L(8); PG8_BAR; PG8_WAIT_L(0); PG8_MMA(0, 0, At, B0); PG8_BAR; PG8_SCHED;
            PG8_LDB(B1, 0, 1); PG8_STAGE(PG8_SB(0, 0), b2, voffB);
            PG8_BAR; PG8_WAIT_L(0); PG8_MMA(0, 1, At, B1); PG8_BAR;
            PG8_LDA(At, 0, 1); PG8_STAGE(PG8_SA(0, 0), a2, voffA);
            PG8_BAR; PG8_WAIT_L(0); PG8_MMA(1, 0, At, B0); PG8_BAR; PG8_SCHED;
            PG8_STAGE(PG8_SB(0, 1), b2 + hstep, voffB);
            PG8_WAIT_V(6); PG8_BAR; PG8_MMA(1, 1, At, B1); PG8_BAR;
            PG8_LDB(B0, 1, 0); PG8_SCHED; PG8_LDA(At, 1, 0); PG8_STAGE(PG8_SA(0, 1), a2 + hstep, voffA);
            PG8_WAIT_L(8); PG8_BAR; PG8_WAIT_L(0); PG8_MMA(0, 0, At, B0); PG8_BAR; PG8_SCHED;
            PG8_LDB(B1, 1, 1); PG8_STAGE(PG8_SB(1, 0), b3, voffB);
            PG8_BAR; PG8_WAIT_L(0); PG8_MMA(0, 1, At, B1); PG8_BAR;
            PG8_LDA(At, 1, 1); PG8_STAGE(PG8_SA(1, 0), a3, voffA);
            PG8_BAR; PG8_WAIT_L(0); PG8_MMA(1, 0, At, B0); PG8_BAR; PG8_SCHED;
            PG8_STAGE(PG8_SB(1, 1), b3 + hstep, voffB);
            PG8_WAIT_V(6); PG8_BAR; PG8_MMA(1, 1, At, B1); PG8_BAR;
        }
        PG8_STAMP();
        if constexpr (!Epi::AFTER_DRAIN) { E(acc, cur, wr, wc, fr, fq); S.done(cur); }
        PG8_STAMP();
        if (!has_next) break;
#pragma unroll
        for (int a = 0; a < 2; ++a)
#pragma unroll
            for (int b = 0; b < 2; ++b)
#pragma unroll
                for (int m = 0; m < 4; ++m)
#pragma unroll
                    for (int n = 0; n < 2; ++n) acc[a][b][m][n] = (f32x4){0.f, 0.f, 0.f, 0.f};
        cur = nxt; cA = nA; cB = nB; ++ui;
    }
    PG8_WAIT_V(0);
    if (wr == 0) PG8_BAR;
    PG8_BAR;
    if constexpr (Epi::AFTER_DRAIN) { E.fused(acc, cur, wr, wc, fr, fq, lds, wid, lane); S.done(cur); }
    PG8_STAMP();
    if (STAMP && wid == 0) { stamps[lane] = lane < nts ? (((unsigned long long)(unsigned)ts_hi << 32) | (unsigned)ts_lo) : 0ull;
        if (lane == 62) stamps[62] = rt_entry; if (lane == 63) stamps[63] = (unsigned long long)wall_clock64(); }
#undef PG8_STAMP
#undef PG8_SA
#undef PG8_SB
#undef PG8_STAGE
#undef PG8_LDA
#undef PG8_LDB
#undef PG8_MMA
#undef PG8_WAIT_V
#undef PG8_WAIT_L
#undef PG8_BAR
#undef PG8_SCHED
}
}
#ifndef ATT_INLINE
#define ATT_INLINE __forceinline__
#endif
namespace att {
constexpr int D = 128, NW = 8, QBLK = 32, KVBLK = 64, LDQ = 512, LDO = DM;
constexpr float SCALE = 0.088388347648318440f;
constexpr float THR = 8.f;
constexpr size_t SHM_V = KVBLK * D * 2, SHM_K = KVBLK * D * 2, SHM_Q = 256 * D * 2, SHM_ATTN = 2 * SHM_V + 2 * SHM_K + NW * 64 * 4 + SHM_Q;
using bf16x8 = __attribute__((ext_vector_type(8))) short;
using s16x4  = __attribute__((ext_vector_type(4))) short;
using f32x16 = __attribute__((ext_vector_type(16))) float;
using u32x4  = __attribute__((ext_vector_type(4))) unsigned;
#define KSWZ(row, colB) ((row) * 256 + ((colB) ^ (((row) & 7) << 4)))
#define SBAR() __builtin_amdgcn_sched_barrier(0)
__device__ __forceinline__ int crow(int r, int hi) { return (r & 3) + 8 * (r >> 2) + 4 * hi; }
__device__ __forceinline__ unsigned cvtpk(float lo, float hi) { unsigned r; asm volatile("v_cvt_pk_bf16_f32 %0, %1, %2" : "=v"(r) : "v"(lo), "v"(hi)); return r; }

__device__ __forceinline__ void partialSM(f32x16& p0, f32x16& p1, float& m_reg, float& mn, float& alpha) {
  constexpr float C = SCALE * 1.4426950408889634f;
  float pmax = p0[0]; for (int r = 1; r < 16; ++r) pmax = fmaxf(pmax, p0[r]); for (int r = 0; r < 16; ++r) pmax = fmaxf(pmax, p1[r]);
  { auto rr = __builtin_amdgcn_permlane32_swap(__float_as_uint(pmax), __float_as_uint(pmax), false, false);
    pmax = fmaxf(__uint_as_float(rr[0]), __uint_as_float(rr[1])); }
  if (__builtin_expect(__all(pmax - m_reg <= THR / SCALE), 1)) { mn = m_reg; alpha = 1.f; }
  else { mn = fmaxf(m_reg, pmax); alpha = __builtin_amdgcn_exp2f((m_reg - mn) * C); m_reg = mn; }
  float mnC = -mn * C;
  for (int r = 0; r < 16; ++r) p0[r] = fmaf(p0[r], C, mnC); for (int r = 0; r < 16; ++r) p1[r] = fmaf(p1[r], C, mnC);
  for (int r = 0; r < 16; ++r) p0[r] = __builtin_amdgcn_exp2f(p0[r]);
}
__device__ __forceinline__ void finishSM(f32x16& p0, f32x16& p1, float alpha, float& l_reg, bf16x8& pa0, bf16x8& pa1, bf16x8& pa2, bf16x8& pa3) {
  for (int r = 0; r < 16; ++r) p1[r] = __builtin_amdgcn_exp2f(p1[r]);
  float ps = 0; for (int r = 0; r < 16; ++r) ps += p0[r]; for (int r = 0; r < 16; ++r) ps += p1[r];
  { auto rr = __builtin_amdgcn_permlane32_swap(__float_as_uint(ps), __float_as_uint(ps), false, false);
    ps = __uint_as_float(rr[0]) + __uint_as_float(rr[1]); }
  l_reg = l_reg * alpha + ps;
#define PK4(P, BASE, OUT) do { unsigned a0 = cvtpk(P[BASE + 0], P[BASE + 1]), a1 = cvtpk(P[BASE + 2], P[BASE + 3]);   \
    unsigned b0 = cvtpk(P[BASE + 4], P[BASE + 5]), b1 = cvtpk(P[BASE + 6], P[BASE + 7]);                              \
    auto r0 = __builtin_amdgcn_permlane32_swap(a0, b0, false, false); auto r1 = __builtin_amdgcn_permlane32_swap(a1, b1, false, false); \
    u32x4 w = {r0[0], r1[0], r0[1], r1[1]}; OUT = *reinterpret_cast<bf16x8*>(&w); } while (0)
  PK4(p0, 0, pa0); PK4(p0, 8, pa1); PK4(p1, 0, pa2); PK4(p1, 8, pa3);
#undef PK4
}
__device__ __forceinline__ void qkt(f32x16& p0, f32x16& p1, const bf16_t* Ks, const bf16_t* Qs, int qrow, int r32, int hi) {
  p0 = f32x16{}; p1 = f32x16{};
#pragma unroll
  for (int d0 = 0; d0 < 8; ++d0) { int cb = (d0 * 16 + hi * 8) * 2;
    bf16x8 q = *reinterpret_cast<const bf16x8*>((const char*)Qs + KSWZ(qrow, cb));
    bf16x8 b0 = *reinterpret_cast<const bf16x8*>((const char*)Ks + KSWZ(r32, cb));
    bf16x8 b1 = *reinterpret_cast<const bf16x8*>((const char*)Ks + KSWZ(32 + r32, cb));
    p0 = __builtin_amdgcn_mfma_f32_32x32x16_bf16(b0, q, p0, 0, 0, 0);
    p1 = __builtin_amdgcn_mfma_f32_32x32x16_bf16(b1, q, p1, 0, 0, 0); }
}
__device__ __forceinline__ int v_st(int k, int c) { const int kk = (k & ~0xC) | ((k & 4) << 1) | ((k & 8) >> 1); return ((kk >> 3) * 4 + (c >> 5)) * 512 + ((kk & 7) * 32 + (c & 31)) * 2; }
__device__ __forceinline__ int v_rd_base(int lane) { return ((lane & 3) << 3) | (((lane >> 2) & 3) << 6) | (((lane >> 4) & 1) << 5) | (((lane >> 5) & 1) << 8); }
constexpr int v_rd_off(int d0, int ks, int half) { return d0 * 512 + ks * 4096 + half * 2048; }
template <int OFF> __device__ __forceinline__ s16x4 tr_read(int vb) {
  s16x4 r; asm volatile("ds_read_b64_tr_b16 %0, %1 offset:%2" : "=&v"(r) : "v"(vb), "i"(OFF) : "memory"); return r;
}
template <int D0> __device__ __forceinline__ void pv_one(f32x16& od, int vb, bf16x8 pa0, bf16x8 pa1, bf16x8 pa2, bf16x8 pa3) {
  const s16x4 l0 = tr_read<v_rd_off(D0, 0, 0)>(vb), h0 = tr_read<v_rd_off(D0, 0, 1)>(vb), l1 = tr_read<v_rd_off(D0, 1, 0)>(vb), h1 = tr_read<v_rd_off(D0, 1, 1)>(vb);
  const s16x4 l2 = tr_read<v_rd_off(D0, 2, 0)>(vb), h2 = tr_read<v_rd_off(D0, 2, 1)>(vb), l3 = tr_read<v_rd_off(D0, 3, 0)>(vb), h3 = tr_read<v_rd_off(D0, 3, 1)>(vb);
  asm volatile("s_waitcnt lgkmcnt(0)" ::: "memory"); SBAR();
#define PK(L, H) (bf16x8){L[0], L[1], L[2], L[3], H[0], H[1], H[2], H[3]}
  od = __builtin_amdgcn_mfma_f32_32x32x16_bf16(pa0, PK(l0, h0), od, 0, 0, 0);
  od = __builtin_amdgcn_mfma_f32_32x32x16_bf16(pa1, PK(l1, h1), od, 0, 0, 0);
  od = __builtin_amdgcn_mfma_f32_32x32x16_bf16(pa2, PK(l2, h2), od, 0, 0, 0);
  od = __builtin_amdgcn_mfma_f32_32x32x16_bf16(pa3, PK(l3, h3), od, 0, 0, 0);
#undef PK
}
__device__ __forceinline__ void pv_d0(f32x16* o, int vb, bf16x8 pa0, bf16x8 pa1, bf16x8 pa2, bf16x8 pa3) {
  pv_one<0>(o[0], vb, pa0, pa1, pa2, pa3); pv_one<1>(o[1], vb, pa0, pa1, pa2, pa3); pv_one<2>(o[2], vb, pa0, pa1, pa2, pa3); pv_one<3>(o[3], vb, pa0, pa1, pa2, pa3);
}

struct SrcOne { const bf16_t* k0; const bf16_t* v0; int ldk;
  __device__ __forceinline__ const bf16_t* k(int j) const { return k0 + (size_t)j * 64 * ldk; }
  __device__ __forceinline__ const bf16_t* v(int j) const { return v0 + (size_t)j * 64 * ldk; } };
struct SrcTwo { const bf16_t* ck; const bf16_t* cv; const bf16_t* k1; const bf16_t* v1; int ldk;
  __device__ __forceinline__ const bf16_t* k(int j) const { return j < 4 ? ck + (size_t)j * 64 * ldk : k1 + (size_t)(j - 4) * 64 * ldk; }
  __device__ __forceinline__ const bf16_t* v(int j) const { return j < 4 ? cv + (size_t)j * 64 * ldk : v1 + (size_t)(j - 4) * 64 * ldk; } };
struct NoBias { __device__ __forceinline__ void operator()(f32x16&, f32x16&, int, int, int, int) const {} };
struct NaBias { const float* tab; int i0, kr0;
  __device__ __forceinline__ void operator()(f32x16& p0, f32x16& p1, int jt, int wid, int r32, int hi) const {
    if (jt < 4) return;
    const int qi = i0 + wid * QBLK + r32, r = qi >> 6, qc = qi & 63, kr = kr0 + jt - 4;
    int lo = r - 4; lo = lo < 0 ? 0 : (lo > 8 ? 8 : lo);
    const bool rowok = (kr >= lo) && (kr < lo + 8);
    if (!rowok) {
#pragma unroll
      for (int rr = 0; rr < 16; ++rr) { p0[rr] = -1e30f; p1[rr] = -1e30f; }
      return;
    }
    int c0 = qc - 8; c0 = c0 < 0 ? 0 : (c0 > 48 ? 48 : c0);
    const int dr = kr - r + 7;
    const float* tb = tab + dr * 31 + (4 * hi - qc + 15);
    const int w0 = 4 * hi - c0;
#pragma unroll
    for (int g = 0; g < 4; ++g) {
#pragma unroll
      for (int q = 0; q < 4; ++q) {
        const int rr = 4 * g + q, kc0 = q + 8 * g;
        const float t0 = tb[kc0], t1 = tb[kc0 + 32];
        p0[rr] = ((unsigned)(kc0 + w0) < 16u) ? p0[rr] + t0 : -1e30f;
        p1[rr] = ((unsigned)(kc0 + 32 + w0) < 16u) ? p1[rr] + t1 : -1e30f;
      }
      SBAR();
    }
  } };

template <class Src, class Bias>
__device__ ATT_INLINE void attn_body(const bf16_t* __restrict__ Qb, const Src src, bf16_t* __restrict__ Ob, const int NT, char* lds, const Bias bias) {
  const int tid = opaque_tid(), wid = tid >> 6, lane = tid & 63, r32 = lane & 31, hi = lane >> 5;
  const int LDK = src.ldk;
  bf16_t* V_lds = (bf16_t*)lds; bf16_t* K_lds = (bf16_t*)(lds + 2 * SHM_V);
  float* ws = (float*)(lds + 2 * SHM_V + 2 * SHM_K) + wid * 64; float* li_l = ws; float* al_l = ws + 32;
  float m_reg = -1e30f, l_reg = 0; f32x16 o[4] = {};
  bf16_t* Q_lds = (bf16_t*)(lds + 2 * SHM_V + 2 * SHM_K + NW * 64 * 4);
  const int qrow = wid * QBLK + r32;
  {
#pragma unroll
    for (int i = 0; i < 8; ++i) { const int f = tid + 512 * i, row = f >> 4, c8 = (f & 15) * 8;
      *(bf16x8*)((char*)Q_lds + KSWZ(row, c8 * 2)) = *reinterpret_cast<const bf16x8*>(Qb + (long)row * LDQ + c8); }
  }
  const int sr = tid >> 4, sc = (tid & 15) * 8, vst0 = v_st(sr, sc), vst1 = v_st(32 + sr, sc);
  const int vb0 = (int)(uintptr_t)V_lds + v_rd_base(lane);
  struct { bf16x8 vs0, vs1, ks0, ks1; } sr_[2];
#define SLOAD(i, jt) do { const bf16_t* kt_ = src.k(jt); const bf16_t* vt_ = src.v(jt); \
    sr_[i].vs0 = *reinterpret_cast<const bf16x8*>(&vt_[(long)sr * LDK + sc]); sr_[i].vs1 = *reinterpret_cast<const bf16x8*>(&vt_[(long)(32 + sr) * LDK + sc]); \
    sr_[i].ks0 = *reinterpret_cast<const bf16x8*>(&kt_[(long)sr * LDK + sc]); sr_[i].ks1 = *reinterpret_cast<const bf16x8*>(&kt_[(long)(32 + sr) * LDK + sc]); } while (0)
#define SWRITE(b, i) do { *(bf16x8*)((char*)V_lds + (b) * SHM_V + vst0) = sr_[i].vs0;          \
    *(bf16x8*)((char*)V_lds + (b) * SHM_V + vst1) = sr_[i].vs1; int kc = sc * 2;               \
    *(bf16x8*)((char*)K_lds + (b) * SHM_K + KSWZ(sr, kc)) = sr_[i].ks0;                       \
    *(bf16x8*)((char*)K_lds + (b) * SHM_K + KSWZ(32 + sr, kc)) = sr_[i].ks1; } while (0)
#define SWAIT() asm volatile("s_waitcnt vmcnt(4)" ::: "memory")
#define RESC(a) do { if (__any((a) < 1.f)) { if (hi == 0) al_l[r32] = (a); asm volatile("s_waitcnt lgkmcnt(0)" ::: "memory"); \
    for (int d = 0; d < 4; ++d) for (int r = 0; r < 16; ++r) o[d][r] *= al_l[crow(r, hi)]; } } while (0)
  f32x16 pA0, pA1, pB0, pB1; float mnA, mnB, alA, alB; bf16x8 pa0, pa1, pa2, pa3;
  constexpr int SE = 0, SO = 1;
  SLOAD(SE, 0); asm volatile("s_waitcnt vmcnt(0)" ::: "memory"); SWRITE(0, SE); __syncthreads();
  qkt(pA0, pA1, K_lds, Q_lds, qrow, r32, hi); bias(pA0, pA1, 0, wid, r32, hi); partialSM(pA0, pA1, m_reg, mnA, alA);
  SLOAD(SO, 1); if (2 < NT) SLOAD(SE, 2);
  SWAIT(); SWRITE(1, SO); __syncthreads();
  for (int j = 1; j + 1 < NT; j += 2) {
    SBAR(); qkt(pB0, pB1, (bf16_t*)((char*)K_lds + SHM_K), Q_lds, qrow, r32, hi); bias(pB0, pB1, j, wid, r32, hi);
    finishSM(pA0, pA1, alA, l_reg, pa0, pa1, pa2, pa3); SBAR();
    SLOAD(SO, j + 2); SBAR();
    pv_d0(o, vb0, pa0, pa1, pa2, pa3); partialSM(pB0, pB1, m_reg, mnB, alB);
    __syncthreads(); SWAIT(); SWRITE(0, SE);
    RESC(alB); __syncthreads();
    SBAR(); qkt(pA0, pA1, K_lds, Q_lds, qrow, r32, hi); bias(pA0, pA1, j + 1, wid, r32, hi);
    finishSM(pB0, pB1, alB, l_reg, pa0, pa1, pa2, pa3); SBAR();
    if (j + 3 < NT) SLOAD(SE, j + 3); SBAR();
    pv_d0(o, vb0 + (int)SHM_V, pa0, pa1, pa2, pa3); partialSM(pA0, pA1, m_reg, mnA, alA);
    __syncthreads(); SWAIT(); SWRITE(1, SO);
    RESC(alA); __syncthreads();
  }
  SBAR(); qkt(pB0, pB1, (bf16_t*)((char*)K_lds + SHM_K), Q_lds, qrow, r32, hi); bias(pB0, pB1, NT - 1, wid, r32, hi);
  finishSM(pA0, pA1, alA, l_reg, pa0, pa1, pa2, pa3); SBAR();
  pv_d0(o, vb0, pa0, pa1, pa2, pa3); partialSM(pB0, pB1, m_reg, mnB, alB);
  __syncthreads(); RESC(alB);
  finishSM(pB0, pB1, alB, l_reg, pa0, pa1, pa2, pa3); SBAR();
  pv_d0(o, vb0 + (int)SHM_V, pa0, pa1, pa2, pa3);
  if (hi == 0) li_l[r32] = l_reg; asm volatile("s_waitcnt lgkmcnt(0)" ::: "memory");
  float rli[16];
#pragma unroll
  for (int r = 0; r < 16; ++r) rli[r] = __builtin_amdgcn_rcpf(li_l[crow(r, hi)]);
  bf16_t* Ow = Ob + (long)(wid * QBLK) * LDO;
#pragma unroll
  for (int r = 0; r < 16; ++r) { int orow = crow(r, hi);
    for (int d0 = 0; d0 < 4; ++d0) Ow[(long)orow * LDO + d0 * 32 + r32] = f2bf(o[d0][r] * rli[r]); }
#undef SLOAD
#undef SWRITE
#undef SWAIT
#undef RESC
}
}
#define LAS __attribute__((address_space(3)))
constexpr int LDS_BYTES = 147456, XBW_OFF = LDS_BYTES - 64;
constexpr int NPH = 1 + DEPTH * 12;
#ifndef DBG_NLAYERS
#define DBG_NLAYERS DEPTH
#endif

#ifndef MIXMASK
#define MIXMASK 0xFF
#endif
#define FOR_ITEMS(it, n, o, w) for (int bo_ = (o) * (int)gridDim.x / 256, bw_ = ((w) * (int)gridDim.x / 256) > 0 ? ((w) * (int)gridDim.x / 256) : 1, \
                                    it = ((int)blockIdx.x >= bo_ && (int)blockIdx.x < bo_ + bw_) ? (int)blockIdx.x - bo_ : (n); it < (n); it += bw_)

__device__ __forceinline__ void phase_mix(const Params& p, int l, unsigned char* lds) {
    const int tid = opaque_tid();
    float* smem = (float*)lds;
    const bf16_t* NAQ = WSP(bf16_t, WS_NAQ); const bf16_t* NAK = WSP(bf16_t, WS_NAK); const bf16_t* NAV = WSP(bf16_t, WS_NAV);
    const bf16_t* GQ = WSP(bf16_t, WS_GQ); const bf16_t* GK = WSP(bf16_t, WS_GK); const bf16_t* GV = WSP(bf16_t, WS_GV);
    bf16_t* MRG = WSP(bf16_t, WS_MRG);
    if ((MIXMASK >> 0) & 1) FOR_ITEMS(it, LB * 8, 0, 64) gdn_chain(p, l, false, it / 8, (it / 2) % 4, it % 2, smem);
    if ((MIXMASK >> 1) & 1) FOR_ITEMS(it, LB * 8, 64, 64) gla_chain(p, l, false, it / 8, (it / 2) % 4, it % 2, smem);
    if ((MIXMASK >> 2) & 1) FOR_ITEMS(it, LB * 16, 128, 128) {
        const int b = it / 16, qh = (it / 4) % 4, qb = it % 4, kvh = qh >> 1;
        const size_t r0 = (size_t)MC + (size_t)b * LT;
        att::SrcTwo src{WSP(bf16_t, WS_CGK) + ((size_t)b * DEPTH + l) * 256 * 256 + kvh * 128, WSP(bf16_t, WS_CGV) + ((size_t)b * DEPTH + l) * 256 * 256 + kvh * 128,
                        GK + r0 * 256 + kvh * 128, GV + r0 * 256 + kvh * 128, 256};
        __syncthreads();
        att::attn_body(GQ + (r0 + qb * 256) * 512 + qh * 128, src, MRG + (r0 + qb * 256) * DM + 1024 + qh * 128, 4 + LT / 64, (char*)lds, att::NoBias{});
    }
    if ((MIXMASK >> 3) & 1) FOR_ITEMS(it, LB * 16, 128, 128) {
        const int b = it / 16, h = (it / 4) % 4, qb = it % 4;
        const int kr0 = qb == 0 ? 0 : qb == 1 ? 0 : qb == 2 ? 4 : 8, nrows = (qb == 0 || qb == 3) ? 8 : 12;
        const size_t r0 = (size_t)MC + (size_t)b * LT;
        float* tab = (float*)(lds + att::SHM_ATTN);
        __syncthreads();
        if (tid < 15 * 31) tab[tid] = p.in[I_RPB][((size_t)l * 4 + h) * 15 * 31 + tid] * (1.0f / att::SCALE);
        att::SrcTwo src{WSP(bf16_t, WS_CNAK) + ((size_t)b * DEPTH + l) * 256 * 512 + h * 128, WSP(bf16_t, WS_CNAV) + ((size_t)b * DEPTH + l) * 256 * 512 + h * 128,
                        NAK + (r0 + kr0 * 64) * 512 + h * 128, NAV + (r0 + kr0 * 64) * 512 + h * 128, 512};
        att::attn_body(NAQ + (r0 + qb * 256) * 512 + h * 128, src, MRG + (r0 + qb * 256) * DM + 0 + h * 128, 4 + nrows, (char*)lds, att::NaBias{tab, qb * 256, kr0});
    }
    if ((MIXMASK >> 4) & 1) FOR_ITEMS(it, CB * 8, 64, 64) gdn_chain(p, l, true, it / 8, (it / 2) % 4, it % 2, smem);
    if ((MIXMASK >> 5) & 1) FOR_ITEMS(it, CB * 8, 128, 128) gla_chain(p, l, true, it / 8, (it / 2) % 4, it % 2, smem);
    if ((MIXMASK >> 6) & 1) FOR_ITEMS(it, CB * 4, 128, 64) {
        const int b = it / 4, h = it % 4; const size_t r0 = (size_t)b * CT;
        att::SrcOne src{NAK + r0 * 512 + h * 128, NAV + r0 * 512 + h * 128, 512};
        __syncthreads();
        att::attn_body(NAQ + r0 * 512 + h * 128, src, MRG + r0 * DM + 0 + h * 128, CT / 64, (char*)lds, att::NoBias{});
    }
    if ((MIXMASK >> 7) & 1) FOR_ITEMS(it, CB * 4, 192, 64) {
        const int b = it / 4, qh = it % 4, kvh = qh >> 1; const size_t r0 = (size_t)b * CT;
        att::SrcOne src{GK + r0 * 256 + kvh * 128, GV + r0 * 256 + kvh * 128, 256};
        __syncthreads();
        att::attn_body(GQ + r0 * 512 + qh * 128, src, MRG + r0 * DM + 1024 + qh * 128, CT / 64, (char*)lds, att::NoBias{});
    }
}

static_assert(att::SHM_ATTN + 15 * 31 * 4 + 2048 <= (size_t)XBW_OFF, "LDS map");
constexpr int BAR_WORD0 = 4096;
static_assert((BAR_WORD0 + XCD_BAR_WORDS) * 4 <= (int)CTL_BYTES, "ctl");

__global__ void __launch_bounds__(512, 2) fwd(Params p) {
    extern __shared__ __attribute__((aligned(16))) unsigned char lds[];
    const int tid = threadIdx.x;
    volatile LAS unsigned* xbw = (volatile LAS unsigned*)((LAS unsigned char*)lds + XBW_OFF);
    if (tid < 4) xbw[tid] = 0u;
    __syncthreads();
    XcdBarrier bar; bar.bar = WSP(unsigned, WS_CTL) + BAR_WORD0; bar.x = 0; bar.st = xbw;
    if (p.ph_hi - p.ph_lo > 1) bar = xcd_barrier_post(WSP(unsigned, WS_CTL) + BAR_WORD0, xbw);
#ifndef PHMASK
#define PHMASK 0x1FFF
#endif
#define IN(k) (p.ph_lo <= (k) && (k) < p.ph_hi)
#define INL(j) (((PHMASK >> ((j) + 1)) & 1) && IN(pb + (j)))
#define SEAM(k) do { if (IN(k) && IN((k) + 1)) xcd_barrier(bar); } while (0)
    LAS unsigned char* ldsl = (LAS unsigned char*)lds;
    bf16_t* H = WSP(bf16_t, WS_H); bf16_t* ACT = WSP(bf16_t, WS_ACT); float* X = WSP(float, WS_X); float* Z = WSP(float, WS_Z); bf16_t* MRG = WSP(bf16_t, WS_MRG);

    if ((PHMASK & 1) && IN(0)) { const Params q = opaque_params(p); phase_prologue(q, (float*)lds); }
    SEAM(0);
    for (int l = 0; l < DBG_NLAYERS; ++l) {
        const int pb = 1 + l * 12;
        const float* modl = WSP(float, WS_MODV) + (size_t)l * NCOND * NMOD;
        if (INL(0)) { const Params q = opaque_params(p); phase_norm(q, l, 0); }
        SEAM(pb + 0);
        if (INL(1)) {
            pg8::Gemm g{H, WSP(bf16_t, WS_WGU) + ((size_t)l * 2 + 0) * NGU * DM, M, NGU, DM}; pg8::StaticOrder S; S.init(M, NGU, (int)gridDim.x, (int)blockIdx.x);
            pg8::EpiSwiGLU E{ACT, FF};
            pg8::gemm_phase<pg8::EpiSwiGLU, pg8::StaticOrder, false>(ldsl, g, S, E, nullptr);
        }
        SEAM(pb + 1);
        if (INL(2)) {
            pg8::Gemm g{ACT, WSP(bf16_t, WS_WDN) + ((size_t)l * 2 + 0) * DM * FF, M, DM, FF}; pg8::StaticOrder S; S.init(M, DM, (int)gridDim.x, (int)blockIdx.x);
            pg8::EpiResid E{X, X, DM, modl + 2 * DM, 0.5f};
            pg8::gemm_phase<pg8::EpiResid, pg8::StaticOrder, false>(ldsl, g, S, E, nullptr);
        }
        SEAM(pb + 2);
        if (INL(3)) { const Params q = opaque_params(p); phase_norm(q, l, 1); }
        SEAM(pb + 3);
        if (INL(4)) {
            pg8::Gemm g{H, WSP(bf16_t, WS_WIN) + (size_t)l * NINP * DM, M, NINP, DM}; pg8::StaticOrder S; S.init(M, NINP, (int)gridDim.x, (int)blockIdx.x);
            pg8::EpiF32 E{Z, NINP, nullptr};
            pg8::gemm_phase<pg8::EpiF32, pg8::StaticOrder, false>(ldsl, g, S, E, nullptr);
        }
        SEAM(pb + 4);
        if (INL(5)) { const Params q = opaque_params(p); phase_prep(q, l); }
        SEAM(pb + 5);
        if (INL(6)) { const Params q = opaque_params(p); phase_mix(q, l, lds); }
        SEAM(pb + 6);
        if (INL(7)) { const Params q = opaque_params(p); phase_post(q, l); }
        SEAM(pb + 7);
        if (INL(8)) {
            pg8::Gemm g{MRG, WSP(bf16_t, WS_WOUT) + (size_t)l * DM * DM, M, DM, DM}; pg8::StaticOrder S; S.init(M, DM, (int)gridDim.x, (int)blockIdx.x);
            pg8::EpiResid E{X, X, DM, modl + 5 * DM, 1.0f};
            pg8::gemm_phase<pg8::EpiResid, pg8::StaticOrder, false>(ldsl, g, S, E, nullptr);
        }
        SEAM(pb + 8);
        if (INL(9)) { const Params q = opaque_params(p); phase_norm(q, l, 2); }
        SEAM(pb + 9);
        if (INL(10)) {
            pg8::Gemm g{H, WSP(bf16_t, WS_WGU) + ((size_t)l * 2 + 1) * NGU * DM, M, NGU, DM}; pg8::StaticOrder S; S.init(M, NGU, (int)gridDim.x, (int)blockIdx.x);
            pg8::EpiSwiGLU E{ACT, FF};
            pg8::gemm_phase<pg8::EpiSwiGLU, pg8::StaticOrder, false>(ldsl, g, S, E, nullptr);
        }
        SEAM(pb + 10);
        if (INL(11)) {
            pg8::Gemm g{ACT, WSP(bf16_t, WS_WDN) + ((size_t)l * 2 + 1) * DM * FF, M, DM, FF}; pg8::StaticOrder S; S.init(M, DM, (int)gridDim.x, (int)blockIdx.x);
            pg8::EpiResid E{X, (l == DEPTH - 1) ? p.out : X, DM, modl + 8 * DM, 0.5f};
            pg8::gemm_phase<pg8::EpiResid, pg8::StaticOrder, false>(ldsl, g, S, E, nullptr);
        }
        SEAM(pb + 11);
    }
#undef IN
#undef SEAM
}

#ifndef MULTI_LAUNCH
#define MULTI_LAUNCH 1
#endif
extern "C" void kernel_launch(void* const* d_in, const int* in_sizes, int n_in, void* d_out, int out_size, void* d_ws, size_t ws_size, hipStream_t stream) {
    static int grid = 0;
    if (grid == 0) {
        if (n_in != N_IN || (size_t)out_size != O_END || ws_size < WS_END) { fprintf(stderr, "kernel_launch: shape mismatch n_in %d out %d ws %zu (need %zu)\n", n_in, out_size, ws_size, (size_t)WS_END); grid = -1; return; }
        int dev = 0, cus = 0, per_cu = 0;
        if (hipGetDevice(&dev) != hipSuccess || hipDeviceGetAttribute(&cus, hipDeviceAttributeMultiprocessorCount, dev) != hipSuccess) { grid = -1; return; }
        if (hipFuncSetAttribute((const void*)fwd, hipFuncAttributeMaxDynamicSharedMemorySize, LDS_BYTES) != hipSuccess) { fprintf(stderr, "kernel_launch: hipFuncSetAttribute failed\n"); grid = -1; return; }
        if (hipOccupancyMaxActiveBlocksPerMultiprocessor(&per_cu, (const void*)fwd, 512, LDS_BYTES) != hipSuccess || per_cu < 1) { fprintf(stderr, "kernel_launch: occupancy query says %d\n", per_cu); (void)hipGetLastError(); }
        grid = cus;
    }
    if (grid < 0) return;
    (void)hipMemsetAsync((char*)d_ws + WS_CTL, 0, CTL_BYTES, stream);
    Params p{};
    for (int i = 0; i < N_IN; ++i) p.in[i] = (const float*)d_in[i];
    p.out = (float*)d_out; p.ws = (unsigned char*)d_ws;
#if MULTI_LAUNCH
    for (int ph = 0; ph < 1 + DBG_NLAYERS * 12; ++ph) { p.ph_lo = ph; p.ph_hi = ph + 1; hipLaunchKernelGGL(fwd, dim3(grid), dim3(512), LDS_BYTES, stream, p); }
#else
    p.ph_lo = 0; p.ph_hi = NPH; hipLaunchKernelGGL(fwd, dim3(grid), dim3(512), LDS_BYTES, stream, p);
#endif
    const hipError_t le = hipPeekAtLastError();
    if (le != hipSuccess) fprintf(stderr, "kernel_launch: launch failed: %s\n", hipGetErrorName(le));
}
```

```cpp
#include <hip/hip_runtime.h>
#include <cstdio>
#include <cstdint>

#ifndef CB_
#define CB_ 16
#endif
#ifndef LB_
#define LB_ 8
#endif
#ifndef DEPTH_
#define DEPTH_ 4
#endif
constexpr int DM = 2048, DEPTH = DEPTH_, CB = CB_, CT = 256, LB = LB_, LT = 1024;
constexpr int MC = CB * CT, ML = LB * LT, M = MC + ML;
constexpr int FF = 5504, NGU = 2 * FF, NIN = 6192, NINP = 6400, NMOD = 9 * DM, NCOND = 1 + LB;
constexpr float EPS = 1e-6f;
constexpr int Z_NAQ = 0, Z_NAK = 512, Z_NAV = 1024, Z_GLQ = 1536, Z_GLK = 1792, Z_GLV = 2048, Z_GLR = 2560, Z_GF = 3072, Z_GB = 3088,
              Z_GQQ = 3104, Z_GQK = 3616, Z_GQV = 3872, Z_DQKV = 4128, Z_DZ = 5664, Z_DB = 6176, Z_DA = 6184;
static_assert(Z_DA + 8 == NIN, "split");
enum { I_XP = 0, I_XS, I_CNAK, I_CNAV, I_CGK, I_CGV, I_SGLA, I_SGDN, I_C, I_CCTX, I_NORMG, I_WMOD, I_BMOD, I_GU, I_DOWN, I_WIN, I_WOUT, I_NAQKN, I_RPB,
       I_GUP, I_GBIAS, I_GLAON, I_GQAQKN, I_CONV, I_ALOG, I_DTB, I_GDNON, N_IN };
constexpr size_t O_YP = 0, O_YS = O_YP + (size_t)MC * DM, O_NAK = O_YS + (size_t)ML * DM, O_NAV = O_NAK + (size_t)CB * DEPTH * 4 * CT * 128,
                 O_GK = O_NAV + (size_t)CB * DEPTH * 4 * CT * 128, O_GV = O_GK + (size_t)CB * DEPTH * 2 * CT * 128,
                 O_SGLA = O_GV + (size_t)CB * DEPTH * 2 * CT * 128, O_SGDN = O_SGLA + (size_t)CB * DEPTH * 2 * 4 * 64 * 128,
                 O_END = O_SGDN + (size_t)CB * DEPTH * 2 * 4 * 128 * 128;
constexpr size_t al256(size_t x) { return (x + 255) & ~(size_t)255; }
constexpr size_t WS_CTL = 0, CTL_BYTES = 1u << 20;
constexpr size_t WS_WGU = CTL_BYTES;
constexpr size_t WS_WDN = WS_WGU + (size_t)DEPTH * 2 * NGU * DM * 2;
constexpr size_t WS_WIN = WS_WDN + (size_t)DEPTH * 2 * DM * FF * 2;
constexpr size_t WS_WOUT = WS_WIN + (size_t)DEPTH * NINP * DM * 2;
constexpr size_t WS_MODV = WS_WOUT + (size_t)DEPTH * DM * DM * 2;
constexpr size_t WS_ROPE = al256(WS_MODV + (size_t)DEPTH * NCOND * NMOD * 4);
constexpr size_t WS_X = al256(WS_ROPE + 2 * 64 * 32 * 4);
constexpr size_t WS_H = WS_X + (size_t)M * DM * 4;
constexpr size_t WS_ACT = WS_H + (size_t)M * DM * 2;
constexpr size_t WS_Z = WS_ACT + (size_t)M * FF * 2;
constexpr size_t WS_MRG = WS_Z + (size_t)M * NINP * 4;
constexpr size_t WS_NAQ = WS_MRG + (size_t)M * DM * 2;
constexpr size_t WS_NAK = WS_NAQ + (size_t)M * 512 * 2;
constexpr size_t WS_NAV = WS_NAK + (size_t)M * 512 * 2;
constexpr size_t WS_GQ = WS_NAV + (size_t)M * 512 * 2;
constexpr size_t WS_GK = WS_GQ + (size_t)M * 512 * 2;
constexpr size_t WS_GV = WS_GK + (size_t)M * 256 * 2;
constexpr size_t WS_CNAK = WS_GV + (size_t)M * 256 * 2;
constexpr size_t WS_CNAV = WS_CNAK + (size_t)LB * DEPTH * 256 * 512 * 2;
constexpr size_t WS_CGK = WS_CNAV + (size_t)LB * DEPTH * 256 * 512 * 2;
constexpr size_t WS_CGV = WS_CGK + (size_t)LB * DEPTH * 256 * 256 * 2;
constexpr size_t WS_AF = WS_CGV + (size_t)LB * DEPTH * 256 * 256 * 2;
constexpr size_t WS_AB = WS_AF + (size_t)M * 256 * 4;
constexpr size_t WS_DQ = WS_AB + (size_t)M * 256 * 4;
constexpr size_t WS_DK = WS_DQ + (size_t)M * 512 * 4;
constexpr size_t WS_DV = WS_DK + (size_t)M * 512 * 4;
constexpr size_t WS_DBA = WS_DV + (size_t)M * 512 * 4;
constexpr size_t WS_GOF = WS_DBA + (size_t)M * 16 * 4;
constexpr size_t WS_GOB = WS_GOF + (size_t)M * 512 * 4;
constexpr size_t WS_DOF = WS_GOB + (size_t)M * 512 * 4;
constexpr size_t WS_DOB = WS_DOF + (size_t)M * 512 * 4;
constexpr size_t WS_END = WS_DOB + (size_t)M * 512 * 4;

typedef unsigned short bf16_t;
struct Params { const float* in[N_IN]; float* out; unsigned char* ws; int ph_lo, ph_hi; };
static_assert(sizeof(Params) == N_IN * 8 + 8 + 8 + 8, "no padding");

#define WSP(T, off) ((T*)(p.ws + (off)))
__device__ __forceinline__ int opaque_tid() { int t = (int)threadIdx.x; asm volatile("" : "+v"(t)); return t; }
__device__ __forceinline__ Params opaque_params(const Params& p) { Params q = p; unsigned long long w = (unsigned long long)q.ws; asm volatile("" : "+s"(w)); q.ws = (unsigned char*)w; return q; }

__device__ __forceinline__ float wave_sum(float v) {
#pragma unroll
    for (int o = 32; o >= 1; o >>= 1) v += __shfl_xor(v, o);
    return v;
}
__device__ __forceinline__ bf16_t f2bf(float f) { unsigned u = __float_as_uint(f); u += 0x7FFFu + ((u >> 16) & 1u); return (bf16_t)(u >> 16); }
__device__ __forceinline__ unsigned pack2(float a, float b) { return (unsigned)f2bf(a) | ((unsigned)f2bf(b) << 16); }
__device__ __forceinline__ float silu_f(float x) { return x / (1.f + expf(-x)); }
__device__ __forceinline__ float softplus_f(float x) { return fmaxf(x, 0.f) + log1pf(expf(-fabsf(x))); }
__device__ __forceinline__ float logsigmoid_f(float x) { return fminf(x, 0.f) - log1pf(expf(-fabsf(x))); }
__device__ __forceinline__ int cond_of_row(int m) { return m < MC ? 0 : 1 + (m - MC) / LT; }
typedef float vf4 __attribute__((ext_vector_type(4)));
__device__ __forceinline__ void conv_tile(const float* __restrict__ src, int ld_src, int ncols_src, int k0, int c0, bf16_t* __restrict__ dst, int ld_dst, int n0, float* tile) {
    const int tid = opaque_tid();
    {
        const int r = tid >> 3, c = (tid & 7) * 8;
        float4 a = make_float4(0.f, 0.f, 0.f, 0.f), b = a;
        if (c0 + c + 8 <= ncols_src) {
            const float* s = src + (size_t)(k0 + r) * ld_src + c0 + c;
            a = *(const float4*)s; b = *(const float4*)(s + 4);
        }
        float* t = tile + r * 65 + c;
        t[0] = a.x; t[1] = a.y; t[2] = a.z; t[3] = a.w; t[4] = b.x; t[5] = b.y; t[6] = b.z; t[7] = b.w;
    }
    __syncthreads();
    {
        const int n = tid >> 3, ks = (tid & 7) * 8;
        const float* t = tile + ks * 65 + n;
        uint4 w;
        w.x = pack2(t[0 * 65], t[1 * 65]); w.y = pack2(t[2 * 65], t[3 * 65]); w.z = pack2(t[4 * 65], t[5 * 65]); w.w = pack2(t[6 * 65], t[7 * 65]);
        *(uint4*)(dst + (size_t)(n0 + n) * ld_dst + k0 + ks) = w;
    }
    __syncthreads();
}

constexpr int MOD_ITEMS = DEPTH * (NMOD / 128);
constexpr int TGU_KT = DM / 64, TGU_NT = NGU / 64, TDN_KT = FF / 64, TDN_NT = DM / 64, TIN_KT = DM / 64, TIN_NT = NINP / 64, TOUT_KT = DM / 64, TOUT_NT = DM / 64;
constexpr int T_GU = DEPTH * 2 * TGU_KT * TGU_NT, T_DN = DEPTH * 2 * TDN_KT * TDN_NT, T_IN = DEPTH * TIN_KT * TIN_NT, T_OUT = DEPTH * TOUT_KT * TOUT_NT;

__device__ __forceinline__ void phase_prologue(const Params& p, float* smem) {
    const int tid = opaque_tid(), nb = gridDim.x, bid = blockIdx.x;
    float* s_cond = smem;
    float* s_red = s_cond + NCOND * DM;
    float* s_tile = s_red + 3 * 128 * NCOND;
    for (int i = tid; i < NCOND * DM; i += 512) { const int ci = i / DM, k = i % DM; const float v = ci == 0 ? p.in[I_CCTX][k] : p.in[I_C][(size_t)(ci - 1) * DM + k]; s_cond[i] = silu_f(v); }
    __syncthreads();
    float* modv = WSP(float, WS_MODV);
    for (int it = bid; it < MOD_ITEMS; it += nb) {
        const int l = it / (NMOD / 128), jt = it % (NMOD / 128);
        const int cl = tid & 127, kq = tid >> 7, col = jt * 128 + cl;
        const float* w = p.in[I_WMOD] + (size_t)l * DM * NMOD + col;
        float acc[NCOND];
#pragma unroll
        for (int ci = 0; ci < NCOND; ++ci) acc[ci] = 0.f;
        for (int k = kq * 512; k < kq * 512 + 512; k += 8) {
            float wv[8];
#pragma unroll
            for (int j = 0; j < 8; ++j) wv[j] = w[(size_t)(k + j) * NMOD];
#pragma unroll
            for (int ci = 0; ci < NCOND; ++ci) {
                const float4 s0 = *(const float4*)&s_cond[ci * DM + k], s1 = *(const float4*)&s_cond[ci * DM + k + 4];
                acc[ci] += s0.x * wv[0] + s0.y * wv[1] + s0.z * wv[2] + s0.w * wv[3] + s1.x * wv[4] + s1.y * wv[5] + s1.z * wv[6] + s1.w * wv[7];
            }
        }
        if (kq > 0) {
#pragma unroll
            for (int ci = 0; ci < NCOND; ++ci) s_red[((kq - 1) * 128 + cl) * NCOND + ci] = acc[ci];
        }
        __syncthreads();
        if (kq == 0) {
            const float bm = p.in[I_BMOD][(size_t)l * NMOD + col];
#pragma unroll
            for (int ci = 0; ci < NCOND; ++ci)
                modv[((size_t)l * NCOND + ci) * NMOD + col] = acc[ci] + s_red[(0 * 128 + cl) * NCOND + ci] + s_red[(1 * 128 + cl) * NCOND + ci] + s_red[(2 * 128 + cl) * NCOND + ci] + bm;
        }
        __syncthreads();
    }
    for (int it = bid; it < T_GU + T_DN + T_IN + T_OUT; it += nb) {
        if (it < T_GU) {
            const int mat = it / (TGU_KT * TGU_NT), r = it % (TGU_KT * TGU_NT), kt = r / TGU_NT, nt = r % TGU_NT;
            const int n0 = nt * 64, t256 = n0 / 256, c = n0 % 256;
            const int c0 = c < 128 ? 128 * t256 + c : FF + 128 * t256 + (c - 128);
            conv_tile(p.in[I_GU] + (size_t)mat * DM * NGU, NGU, NGU, kt * 64, c0, WSP(bf16_t, WS_WGU) + (size_t)mat * NGU * DM, DM, n0, s_tile);
        } else if (it < T_GU + T_DN) {
            const int i2 = it - T_GU, mat = i2 / (TDN_KT * TDN_NT), r = i2 % (TDN_KT * TDN_NT), kt = r / TDN_NT, nt = r % TDN_NT;
            conv_tile(p.in[I_DOWN] + (size_t)mat * FF * DM, DM, DM, kt * 64, nt * 64, WSP(bf16_t, WS_WDN) + (size_t)mat * DM * FF, FF, nt * 64, s_tile);
        } else if (it < T_GU + T_DN + T_IN) {
            const int i2 = it - T_GU - T_DN, mat = i2 / (TIN_KT * TIN_NT), r = i2 % (TIN_KT * TIN_NT), kt = r / TIN_NT, nt = r % TIN_NT;
            conv_tile(p.in[I_WIN] + (size_t)mat * DM * NIN, NIN, NIN, kt * 64, nt * 64, WSP(bf16_t, WS_WIN) + (size_t)mat * NINP * DM, DM, nt * 64, s_tile);
        } else {
            const int i2 = it - T_GU - T_DN - T_IN, mat = i2 / (TOUT_KT * TOUT_NT), r = i2 % (TOUT_KT * TOUT_NT), kt = r / TOUT_NT, nt = r % TOUT_NT;
            conv_tile(p.in[I_WOUT] + (size_t)mat * DM * DM, DM, DM, kt * 64, nt * 64, WSP(bf16_t, WS_WOUT) + (size_t)mat * DM * DM, DM, nt * 64, s_tile);
        }
    }
    const size_t gtid = (size_t)bid * 512 + tid, gstride = (size_t)nb * 512;
    {
        float4* X = WSP(float4, WS_X);
        const float4* xp = (const float4*)p.in[I_XP]; const float4* xs = (const float4*)p.in[I_XS];
        const size_t nc = (size_t)MC * DM / 4, n = (size_t)M * DM / 4;
        for (size_t i = gtid; i < n; i += gstride) X[i] = i < nc ? xp[i] : xs[i - nc];
    }
    {
        const size_t n_na = (size_t)LB * DEPTH * 256 * 512 / 8;
        for (size_t i = gtid; i < 2 * n_na; i += gstride) {
            const bool isv = i >= n_na; const size_t j = isv ? i - n_na : i;
            const int d8 = (int)(j % 16), h = (int)((j / 16) % 4), t = (int)((j / 64) % 256); const size_t bl = j / (64 * 256);
            const float* s = p.in[isv ? I_CNAV : I_CNAK] + ((bl * 4 + h) * 256 + t) * 128 + d8 * 8;
            const float4 a = *(const float4*)s, b = *(const float4*)(s + 4);
            uint4 w; w.x = pack2(a.x, a.y); w.y = pack2(a.z, a.w); w.z = pack2(b.x, b.y); w.w = pack2(b.z, b.w);
            *(uint4*)(WSP(bf16_t, isv ? WS_CNAV : WS_CNAK) + (bl * 256 + t) * 512 + h * 128 + d8 * 8) = w;
        }
        const size_t n_g = (size_t)LB * DEPTH * 256 * 256 / 8;
        for (size_t i = gtid; i < 2 * n_g; i += gstride) {
            const bool isv = i >= n_g; const size_t j = isv ? i - n_g : i;
            const int d8 = (int)(j % 16), h = (int)((j / 16) % 2), t = (int)((j / 32) % 256); const size_t bl = j / (32 * 256);
            const float* s = p.in[isv ? I_CGV : I_CGK] + ((bl * 2 + h) * 256 + t) * 128 + d8 * 8;
            const float4 a = *(const float4*)s, b = *(const float4*)(s + 4);
            uint4 w; w.x = pack2(a.x, a.y); w.y = pack2(a.z, a.w); w.z = pack2(b.x, b.y); w.w = pack2(b.z, b.w);
            *(uint4*)(WSP(bf16_t, isv ? WS_CGV : WS_CGK) + (bl * 256 + t) * 256 + h * 128 + d8 * 8) = w;
        }
    }
    for (size_t i = gtid; i < 64 * 32; i += gstride) {
        const int pos = (int)(i / 32), k = (int)(i % 32);
        const float inv = powf(10000.0f, -(float)(2 * k) / 64.0f);
        const float ang = (float)pos * inv;
        WSP(float, WS_ROPE)[i] = cosf(ang); WSP(float, WS_ROPE)[64 * 32 + i] = sinf(ang);
    }
}

__device__ __forceinline__ void phase_norm(const Params& p, int l, int which  ) {
    const int tid = opaque_tid(), lane = tid & 63, wv = tid >> 6;
    const float* X = WSP(float, WS_X); bf16_t* H = WSP(bf16_t, WS_H);
    const float* g = p.in[I_NORMG] + ((size_t)l * 3 + which) * DM;
    for (int m = blockIdx.x * 8 + wv; m < M; m += gridDim.x * 8) {
        const int ci = cond_of_row(m);
        const float* mv = WSP(float, WS_MODV) + ((size_t)l * NCOND + ci) * NMOD + (size_t)which * 3 * DM;
        const float* x = X + (size_t)m * DM;
        vf4 v[8]; float ss = 0.f;
#pragma unroll
        for (int i = 0; i < 8; ++i) { v[i] = *(const vf4*)(x + (i * 64 + lane) * 4); ss += v[i].x * v[i].x + v[i].y * v[i].y + v[i].z * v[i].z + v[i].w * v[i].w; }
        ss = wave_sum(ss);
        const float r = 1.0f / sqrtf(ss * (1.0f / DM) + EPS);
#pragma unroll
        for (int i = 0; i < 8; ++i) {
            const int c = (i * 64 + lane) * 4;
            const float4 gg = *(const float4*)(g + c), sh = *(const float4*)(mv + c), sc = *(const float4*)(mv + DM + c);
            const float o0 = v[i].x * r * gg.x * (1.f + sc.x) + sh.x, o1 = v[i].y * r * gg.y * (1.f + sc.y) + sh.y;
            const float o2 = v[i].z * r * gg.z * (1.f + sc.z) + sh.z, o3 = v[i].w * r * gg.w * (1.f + sc.w) + sh.w;
            uint2 w; w.x = pack2(o0, o1); w.y = pack2(o2, o3);
            *(uint2*)(H + (size_t)m * DM + c) = w;
        }
    }
}

#define PREP_FENCE() asm volatile("" ::: "memory")
__device__ __forceinline__ void phase_prep(const Params& p, int l) {
    const int tid = opaque_tid(), lane = tid & 63, wv = tid >> 6;
    const float* Z = WSP(float, WS_Z);
    const float* ropec = WSP(float, WS_ROPE); const float* ropes = ropec + 64 * 32;
    for (int m = blockIdx.x * 8 + wv; m < M; m += gridDim.x * 8) {
        const float* z = Z + (size_t)m * NINP;
        const bool ctx = m < MC;
        const int b = ctx ? m / CT : (m - MC) / LT, t = ctx ? m % CT : (m - MC) % LT, T = ctx ? CT : LT;
        {
            const float* wq = p.in[I_NAQKN] + ((size_t)l * 2 + 0) * 128; const float* wk = wq + 128;
#pragma unroll 1
            for (int h = 0; h < 4; ++h) {
                float a = z[Z_NAQ + h * 128 + lane], c = z[Z_NAQ + h * 128 + 64 + lane];
                float r = 1.0f / sqrtf(wave_sum(a * a + c * c) * (1.0f / 128) + EPS);
                bf16_t* q = WSP(bf16_t, WS_NAQ) + (size_t)m * 512 + h * 128;
                q[lane] = f2bf(a * r * wq[lane]); q[64 + lane] = f2bf(c * r * wq[64 + lane]);
                a = z[Z_NAK + h * 128 + lane]; c = z[Z_NAK + h * 128 + 64 + lane];
                r = 1.0f / sqrtf(wave_sum(a * a + c * c) * (1.0f / 128) + EPS);
                const float k0 = a * r * wk[lane], k1 = c * r * wk[64 + lane];
                bf16_t* k = WSP(bf16_t, WS_NAK) + (size_t)m * 512 + h * 128;
                k[lane] = f2bf(k0); k[64 + lane] = f2bf(k1);
                const float v0 = z[Z_NAV + h * 128 + lane], v1 = z[Z_NAV + h * 128 + 64 + lane];
                bf16_t* v = WSP(bf16_t, WS_NAV) + (size_t)m * 512 + h * 128;
                v[lane] = f2bf(v0); v[64 + lane] = f2bf(v1);
                if (ctx) {
                    const size_t o = ((((size_t)b * DEPTH + l) * 4 + h) * CT + t) * 128;
                    p.out[O_NAK + o + lane] = k0; p.out[O_NAK + o + 64 + lane] = k1;
                    p.out[O_NAV + o + lane] = v0; p.out[O_NAV + o + 64 + lane] = v1;
                }
            }
        }
        PREP_FENCE();
        {
            const float* wq = p.in[I_GQAQKN] + ((size_t)l * 2 + 0) * 128; const float* wk = wq + 128;
            const int grow = t >> 6, gcol = t & 63, i32 = lane & 31;
            const float cr = ropec[grow * 32 + i32], sr = ropes[grow * 32 + i32], cc = ropec[gcol * 32 + i32], sc = ropes[gcol * 32 + i32];
#pragma unroll 1
            for (int h = 0; h < 6; ++h) {
                const int zo = h < 4 ? Z_GQQ + h * 128 : Z_GQK + (h - 4) * 128;
                float a = z[zo + lane], c = z[zo + 64 + lane];
                const float r = 1.0f / sqrtf(wave_sum(a * a + c * c) * (1.0f / 128) + EPS);
                const float* w = h < 4 ? wq : wk;
                a = a * r * w[lane]; c = c * r * w[64 + lane];
                if (!ctx) {
                    const float pa = __shfl_xor(a, 32), pc = __shfl_xor(c, 32);
                    a = lane < 32 ? a * cr - pa * sr : pa * sr + a * cr;
                    c = lane < 32 ? c * cc - pc * sc : pc * sc + c * cc;
                }
                if (h < 4) { bf16_t* q = WSP(bf16_t, WS_GQ) + (size_t)m * 512 + h * 128; q[lane] = f2bf(a); q[64 + lane] = f2bf(c); }
                else {
                    bf16_t* k = WSP(bf16_t, WS_GK) + (size_t)m * 256 + (h - 4) * 128; k[lane] = f2bf(a); k[64 + lane] = f2bf(c);
                    const float v0 = z[Z_GQV + (h - 4) * 128 + lane], v1 = z[Z_GQV + (h - 4) * 128 + 64 + lane];
                    bf16_t* v = WSP(bf16_t, WS_GV) + (size_t)m * 256 + (h - 4) * 128; v[lane] = f2bf(v0); v[64 + lane] = f2bf(v1);
                    if (ctx) {
                        const size_t o = ((((size_t)b * DEPTH + l) * 2 + (h - 4)) * CT + t) * 128;
                        p.out[O_GK + o + lane] = a; p.out[O_GK + o + 64 + lane] = c;
                        p.out[O_GV + o + lane] = v0; p.out[O_GV + o + 64 + lane] = v1;
                    }
                }
            }
        }
        PREP_FENCE();
        {
#pragma unroll 1
            for (int dir = 0; dir < 2; ++dir) {
                const float* up = p.in[I_GUP] + ((size_t)l * 2 + dir) * 16 * 256;
                const float* bias = p.in[I_GBIAS] + ((size_t)l * 2 + dir) * 256;
                const float gmine = z[(dir ? Z_GB : Z_GF) + (lane & 15)];
                float gsum[4];
#pragma unroll
                for (int i = 0; i < 4; ++i) gsum[i] = bias[lane + 64 * i];
#pragma unroll
                for (int r = 0; r < 16; ++r) {
                    const float gv = __shfl(gmine, r);
#pragma unroll
                    for (int i = 0; i < 4; ++i) gsum[i] += gv * up[r * 256 + lane + 64 * i];
                }
                float* A = WSP(float, dir ? WS_AB : WS_AF) + (size_t)m * 256;
#pragma unroll
                for (int i = 0; i < 4; ++i) A[lane + 64 * i] = expf(logsigmoid_f(gsum[i]) * (1.0f / 16.0f));
                PREP_FENCE();
            }
        }
        {
            const float* cw = p.in[I_CONV] + (size_t)l * 5 * 1536;
#pragma unroll 1
            for (int part = 0; part < 3; ++part) {
                float val[8];
#pragma unroll
                for (int i = 0; i < 8; ++i) val[i] = 0.f;
#pragma unroll 1
                for (int j = 0; j < 5; ++j) {
                    const int tt = t + j - 2;
                    if (tt >= 0 && tt < T) {
                        const float* zz = Z + (size_t)(m + j - 2) * NINP + Z_DQKV + part * 512;
                        const float* cj = cw + j * 1536 + part * 512;
#pragma unroll
                        for (int i = 0; i < 8; ++i) val[i] += cj[lane + 64 * i] * zz[lane + 64 * i];
                    }
                }
#pragma unroll
                for (int i = 0; i < 8; ++i) val[i] = silu_f(val[i]);
                float* dst = WSP(float, part == 0 ? WS_DQ : part == 1 ? WS_DK : WS_DV) + (size_t)m * 512;
#pragma unroll
                for (int h = 0; h < 4; ++h) {
                    float r = 1.0f;
                    if (part < 2) r = 1.0f / sqrtf(wave_sum(val[2 * h] * val[2 * h] + val[2 * h + 1] * val[2 * h + 1]) + EPS) * (part == 0 ? 0.08838834764831845f : 1.0f);
                    dst[h * 128 + lane] = val[2 * h] * r; dst[h * 128 + 64 + lane] = val[2 * h + 1] * r;
                }
                PREP_FENCE();
            }
            if (lane < 8) {
                const float beta = 1.0f / (1.0f + expf(-z[Z_DB + lane]));
                const float g = -expf(p.in[I_ALOG][(size_t)l * 8 + lane]) * softplus_f(z[Z_DA + lane] + p.in[I_DTB][(size_t)l * 8 + lane]);
                float* ba = WSP(float, WS_DBA) + (size_t)m * 16;
                ba[lane] = beta; ba[8 + lane] = expf(g);
            }
        }
        PREP_FENCE();
    }
}

__device__ __forceinline__ void gla_chain(const Params& p, int l, bool ctx, int b, int h, int dir, float* smem) {
    constexpr int TC = 64;
    const int tid = opaque_tid(), lane = tid & 63, wv = tid >> 6, e = wv * 16 + (lane >> 2), dg = lane & 3;
    const int T = ctx ? CT : LT; const size_t m0 = ctx ? (size_t)b * CT : (size_t)MC + (size_t)b * LT;
    const float* Z = WSP(float, WS_Z); const float* A = WSP(float, dir ? WS_AB : WS_AF);
    float* O = WSP(float, dir ? WS_GOB : WS_GOF);
    float* sq = smem; float* sk = sq + TC * 64; float* sa = sk + TC * 64; float* sv = sa + TC * 64;
    float S[16];
    if (ctx) {
#pragma unroll
        for (int i = 0; i < 16; ++i) S[i] = 0.f;
    } else {
        const float* s0 = p.in[I_SGLA] + (((((size_t)b * DEPTH + l) * 2 + dir) * 4 + h) * 64 + dg * 16) * 128 + e;
#pragma unroll
        for (int i = 0; i < 16; ++i) S[i] = s0[(size_t)i * 128];
    }
    vf4 pre[10];
    const int nch = T / TC;
#define GLA_LOAD(c) do { _Pragma("unroll") for (int i = 0; i < 10; ++i) { const int f = tid + 512 * i, s = f / 80, c4 = f % 80; \
        const int ti = (c) * TC + s, tt = dir ? T - 1 - ti : ti; const size_t m = m0 + tt; \
        const float* src = c4 < 16 ? Z + m * NINP + Z_GLQ + h * 64 + 4 * c4 : c4 < 32 ? Z + m * NINP + Z_GLK + h * 64 + 4 * (c4 - 16) \
                         : c4 < 48 ? A + m * 256 + h * 64 + 4 * (c4 - 32) : Z + m * NINP + Z_GLV + h * 128 + 4 * (c4 - 48); \
        pre[i] = *(const vf4*)src; } } while (0)
#define GLA_WRITE() do { _Pragma("unroll") for (int i = 0; i < 10; ++i) { const int f = tid + 512 * i, s = f / 80, c4 = f % 80; \
        vf4 v = pre[i]; if (c4 < 16) v *= 0.125f; \
        float* dst = c4 < 16 ? sq + s * 64 + 4 * c4 : c4 < 32 ? sk + s * 64 + 4 * (c4 - 16) : c4 < 48 ? sa + s * 64 + 4 * (c4 - 32) : sv + s * 128 + 4 * (c4 - 48); \
        *(vf4*)dst = v; } } while (0)
    __syncthreads();
    GLA_LOAD(0); GLA_WRITE(); __syncthreads();
    for (int c = 0; c < nch; ++c) {
        if (c + 1 < nch) GLA_LOAD(c + 1);
        for (int s = 0; s < TC; ++s) {
            const float ve = sv[s * 128 + e];
            float po = 0.f;
#pragma unroll
            for (int i4 = 0; i4 < 4; ++i4) {
                const vf4 q4 = *(const vf4*)(sq + s * 64 + dg * 16 + 4 * i4), k4 = *(const vf4*)(sk + s * 64 + dg * 16 + 4 * i4), a4 = *(const vf4*)(sa + s * 64 + dg * 16 + 4 * i4);
                S[4 * i4 + 0] = a4.x * S[4 * i4 + 0] + k4.x * ve; po += q4.x * S[4 * i4 + 0];
                S[4 * i4 + 1] = a4.y * S[4 * i4 + 1] + k4.y * ve; po += q4.y * S[4 * i4 + 1];
                S[4 * i4 + 2] = a4.z * S[4 * i4 + 2] + k4.z * ve; po += q4.z * S[4 * i4 + 2];
                S[4 * i4 + 3] = a4.w * S[4 * i4 + 3] + k4.w * ve; po += q4.w * S[4 * i4 + 3];
            }
            po += __shfl_xor(po, 1); po += __shfl_xor(po, 2);
            if (dg == 0) { const int ti = c * TC + s, tt = dir ? T - 1 - ti : ti; O[(m0 + tt) * 512 + h * 128 + e] = po; }
        }
        __syncthreads();
        if (c + 1 < nch) GLA_WRITE();
        __syncthreads();
    }
#undef GLA_LOAD
#undef GLA_WRITE
    if (ctx) {
        float* so = p.out + O_SGLA + (((((size_t)b * DEPTH + l) * 2 + dir) * 4 + h) * 64 + dg * 16) * 128 + e;
#pragma unroll
        for (int i = 0; i < 16; ++i) so[(size_t)i * 128] = S[i];
    }
}

__device__ __forceinline__ void gdn_chain(const Params& p, int l, bool ctx, int b, int h, int dir, float* smem) {
    constexpr int TC = 32;
    const int tid = opaque_tid(), lane = tid & 63, wv = tid >> 6, e = wv * 16 + (lane >> 2), dg = lane & 3;
    const int T = ctx ? CT : LT; const size_t m0 = ctx ? (size_t)b * CT : (size_t)MC + (size_t)b * LT;
    const float* DQ = WSP(float, WS_DQ); const float* DK = WSP(float, WS_DK); const float* DV = WSP(float, WS_DV); const float* DBA = WSP(float, WS_DBA);
    float* O = WSP(float, dir ? WS_DOB : WS_DOF);
    float* sq = smem; float* sk = sq + TC * 128; float* sv = sk + TC * 128; float* sba = sv + TC * 128;
    float S[32];
    if (ctx) {
#pragma unroll
        for (int i = 0; i < 32; ++i) S[i] = 0.f;
    } else {
        const float* s0 = p.in[I_SGDN] + (((((size_t)b * DEPTH + l) * 2 + dir) * 4 + h) * 128 + dg * 32) * 128 + e;
#pragma unroll
        for (int i = 0; i < 32; ++i) S[i] = s0[(size_t)i * 128];
    }
    vf4 pre[6]; float pre_s = 0.f;
    const int nch = T / TC;
#define GDN_LOAD(c) do { _Pragma("unroll") for (int i = 0; i < 6; ++i) { const int f = tid + 512 * i, s = f / 96, c4 = f % 96; \
        const int ti = (c) * TC + s, tt = dir ? T - 1 - ti : ti; const size_t m = m0 + tt; \
        const float* src = c4 < 32 ? DQ + m * 512 + h * 128 + 4 * c4 : c4 < 64 ? DK + m * 512 + h * 128 + 4 * (c4 - 32) : DV + m * 512 + h * 128 + 4 * (c4 - 64); \
        pre[i] = *(const vf4*)src; } \
        if (tid < 2 * TC) { const int s = tid >> 1, ti = (c) * TC + s, tt = dir ? T - 1 - ti : ti; pre_s = DBA[(m0 + tt) * 16 + (tid & 1) * 8 + dir * 4 + h]; } } while (0)
#define GDN_WRITE() do { _Pragma("unroll") for (int i = 0; i < 6; ++i) { const int f = tid + 512 * i, s = f / 96, c4 = f % 96; \
        float* dst = c4 < 32 ? sq + s * 128 + 4 * c4 : c4 < 64 ? sk + s * 128 + 4 * (c4 - 32) : sv + s * 128 + 4 * (c4 - 64); \
        *(vf4*)dst = pre[i]; } if (tid < 2 * TC) sba[tid] = pre_s; } while (0)
    __syncthreads();
    GDN_LOAD(0); GDN_WRITE(); __syncthreads();
    for (int c = 0; c < nch; ++c) {
        if (c + 1 < nch) GDN_LOAD(c + 1);
        for (int s = 0; s < TC; ++s) {
            const float be = sba[2 * s], a = sba[2 * s + 1], ve = sv[s * 128 + e];
            vf4 k4[8];
            float pk = 0.f;
#pragma unroll
            for (int i4 = 0; i4 < 8; ++i4) {
                k4[i4] = *(const vf4*)(sk + s * 128 + dg * 32 + 4 * i4);
                pk += k4[i4].x * S[4 * i4 + 0] + k4[i4].y * S[4 * i4 + 1] + k4[i4].z * S[4 * i4 + 2] + k4[i4].w * S[4 * i4 + 3];
            }
            pk += __shfl_xor(pk, 1); pk += __shfl_xor(pk, 2);
            const float vn = be * (ve - a * pk);
            float po = 0.f;
#pragma unroll
            for (int i4 = 0; i4 < 8; ++i4) {
                const vf4 q4 = *(const vf4*)(sq + s * 128 + dg * 32 + 4 * i4);
                S[4 * i4 + 0] = a * S[4 * i4 + 0] + k4[i4].x * vn; po += q4.x * S[4 * i4 + 0];
                S[4 * i4 + 1] = a * S[4 * i4 + 1] + k4[i4].y * vn; po += q4.y * S[4 * i4 + 1];
                S[4 * i4 + 2] = a * S[4 * i4 + 2] + k4[i4].z * vn; po += q4.z * S[4 * i4 + 2];
                S[4 * i4 + 3] = a * S[4 * i4 + 3] + k4[i4].w * vn; po += q4.w * S[4 * i4 + 3];
            }
            po += __shfl_xor(po, 1); po += __shfl_xor(po, 2);
            if (dg == 0) { const int ti = c * TC + s, tt = dir ? T - 1 - ti : ti; O[(m0 + tt) * 512 + h * 128 + e] = po; }
        }
        __syncthreads();
        if (c + 1 < nch) GDN_WRITE();
        __syncthreads();
    }
#undef GDN_LOAD
#undef GDN_WRITE
    if (ctx) {
        float* so = p.out + O_SGDN + (((((size_t)b * DEPTH + l) * 2 + dir) * 4 + h) * 128 + dg * 32) * 128 + e;
#pragma unroll
        for (int i = 0; i < 32; ++i) so[(size_t)i * 128] = S[i];
    }
}

__device__ __forceinline__ void phase_post(const Params& p, int l) {
    const int tid = opaque_tid(), lane = tid & 63, wv = tid >> 6;
    const float* Z = WSP(float, WS_Z); bf16_t* MRG = WSP(bf16_t, WS_MRG);
    const float* wg = p.in[I_GLAON] + (size_t)l * 128; const float* wd = p.in[I_GDNON] + (size_t)l * 128;
    for (int m = blockIdx.x * 8 + wv; m < M; m += gridDim.x * 8) {
        const float* z = Z + (size_t)m * NINP;
#pragma unroll
        for (int g = 0; g < 2; ++g) {
            const float* of = WSP(float, g ? WS_DOF : WS_GOF) + (size_t)m * 512; const float* ob = WSP(float, g ? WS_DOB : WS_GOB) + (size_t)m * 512;
            const float* w = g ? wd : wg; const int zg = g ? Z_DZ : Z_GLR, mc = g ? 1536 : 512;
#pragma unroll
            for (int h = 0; h < 4; ++h) {
                const float a = of[h * 128 + lane] + ob[h * 128 + lane], c = of[h * 128 + 64 + lane] + ob[h * 128 + 64 + lane];
                const float r = 1.0f / sqrtf(wave_sum(a * a + c * c) * (1.0f / 128) + EPS);
                bf16_t* o = MRG + (size_t)m * DM + mc + h * 128;
                o[lane] = f2bf(a * r * w[lane] * silu_f(z[zg + h * 128 + lane]));
                o[64 + lane] = f2bf(c * r * w[64 + lane] * silu_f(z[zg + h * 128 + 64 + lane]));
            }
        }
    }
}
#define XB_TMO      128
#define XB_XCNT(j)  (256  + 64 * (j))
#define XB_XSUB(j)  (1280 + 64 * (j))
#define XB_XGEN(j)  (2304 + 64 * (j))
#define XB_TOP      3328
#define XB_TOPGEN   3392
#define XCD_BAR_WORDS 3456
#define XB_SPIN_CAP (1u << 22)
#define LAS __attribute__((address_space(3)))

__device__ __forceinline__ unsigned xb_ld(unsigned* p)              { return __hip_atomic_load(p, __ATOMIC_RELAXED, __HIP_MEMORY_SCOPE_AGENT); }
__device__ __forceinline__ unsigned xb_add(unsigned* p, unsigned v) { return __hip_atomic_fetch_add(p, v, __ATOMIC_RELAXED, __HIP_MEMORY_SCOPE_AGENT); }
__device__ __forceinline__ unsigned xb_xcc_id() { return (unsigned)__builtin_amdgcn_s_getreg((3 << 11) | 20) & 0xFu; }
#define XB_SPIN(cond, bar) do { unsigned _sp = 0; while (cond) { __builtin_amdgcn_s_sleep(1); \
    if ((++_sp & 255u) == 0u) { if (xb_ld(&(bar)[XB_TMO])) break; if (_sp > XB_SPIN_CAP) { atomicAdd(&(bar)[XB_TMO], 1u); break; } } } } while (0)

struct XcdBarrier {
    unsigned* bar; unsigned x;
    volatile LAS unsigned* st;
};

__device__ __forceinline__ XcdBarrier xcd_barrier_post(unsigned* bar, volatile LAS unsigned* st) {
    XcdBarrier b; b.bar = bar; b.x = xb_xcc_id(); b.st = st;
    if (threadIdx.x == 0) (void)xb_add(&bar[XB_XCNT(b.x)], 1u);
    return b;
}
__device__ __forceinline__ void xcd_barrier_complete(unsigned* bar, unsigned x, unsigned& nloc, unsigned& nx) {
    const unsigned G = gridDim.x * gridDim.y * gridDim.z;
    unsigned sum, cnt, mine, sp = 0u;
    for (;;) {
        sum = 0u; cnt = 0u; mine = 0u;
#pragma unroll
        for (unsigned j = 0; j < 16; ++j) { const unsigned c = xb_ld(&bar[XB_XCNT(j)]); sum += c; cnt += (c > 0u) ? 1u : 0u; mine = (j == x) ? c : mine; }
        if (sum == G) break;
        __builtin_amdgcn_s_sleep(1);
        if ((++sp & 255u) == 0u) { if (xb_ld(&bar[XB_TMO])) break; if (sp > XB_SPIN_CAP) { atomicAdd(&bar[XB_TMO], 1u); break; } }
    }
    nloc = mine > 0u ? mine : 1u; nx = cnt > 0u ? cnt : 1u;
}

__device__ __forceinline__ void xcd_barrier(const XcdBarrier& b) {
    asm volatile("s_waitcnt vmcnt(0)" ::: "memory");
    __syncthreads();
    if (threadIdx.x == 0) {
        unsigned* bar = b.bar;
        __builtin_amdgcn_s_waitcnt(0);
        unsigned nloc = b.st[0], nx = b.st[1];
        if (nloc == 0u) { xcd_barrier_complete(bar, b.x, nloc, nx); b.st[0] = nloc; b.st[1] = nx; }
        const unsigned old = xb_add(&bar[XB_XSUB(b.x)], 1u);
        const unsigned gen = old / nloc;
        if (old + 1u == (gen + 1u) * nloc) {
            __builtin_amdgcn_fence(__ATOMIC_RELEASE, "agent");
            asm volatile("s_waitcnt vmcnt(0)" ::: "memory");
            const unsigned og = xb_add(&bar[XB_TOP], 1u);
            const unsigned tg = og / nx;
            if (og + 1u == (tg + 1u) * nx) xb_add(&bar[XB_TOPGEN], 1u);
            else XB_SPIN(xb_ld(&bar[XB_TOPGEN]) == tg, bar);
            __builtin_amdgcn_fence(__ATOMIC_ACQUIRE, "agent");
            xb_add(&bar[XB_XGEN(b.x)], 1u);
            asm volatile("s_waitcnt vmcnt(0)" ::: "memory");
        } else {
            XB_SPIN(xb_ld(&bar[XB_XGEN(b.x)]) == gen, bar);
            __builtin_amdgcn_fence(__ATOMIC_ACQUIRE, "agent");
            asm volatile("s_waitcnt vmcnt(0)" ::: "memory");
        }
    }
    __syncthreads();
}

namespace pg8 {
#define PG8_LAS __attribute__((address_space(3)))
typedef unsigned short bf16_t;
typedef short bf16x8 __attribute__((ext_vector_type(8)));
typedef float f32x4 __attribute__((ext_vector_type(4)));
typedef unsigned u32x4 __attribute__((ext_vector_type(4)));
constexpr int BM = 256, BK = 64, HALF = 128, HTB = HALF * BK * 2  , STAGE_BYTES = 8 * HTB, NXCD = 8, WGM = 8;

__host__ __device__ __forceinline__ int lds_byte(int r, int c) { const int st = (r >> 4) * 2 + (c >> 5), rr = r & 15, cc = c & 31, ob = rr * 64 + cc * 2; return st * 1024 + (ob ^ (((ob >> 9) & 1) << 5)); }
__host__ __device__ __forceinline__ void stage_rc(int b, int& R, int& C) { const int st = b / 1024, sb = b % 1024, swz = sb ^ (((sb >> 9) & 1) << 5); R = (st >> 1) * 16 + swz / 64; C = (st & 1) * 32 + (swz % 64) / 2; }
__host__ __device__ __forceinline__ int perm32(int rho) { const int n = rho >> 4, i = rho & 15; return 8 * (i >> 2) + 4 * n + (i & 3); }

struct Unit { int pm, pn; };
struct Gemm { const bf16_t* A; const bf16_t* Bt; int M, N, K; };

struct StaticOrder {
    int nM, nN, nwg, G, c;
    __host__ __device__ void init(int M, int N, int G_, int c_) { nM = M / BM; nN = N / BM; nwg = nM * nN; G = G_; c = c_; }
    __host__ __device__ bool next(int i, Unit& u) const {
        const long L = (long)i * G + c; if (L >= nwg) return false;
        int wgid = (int)L; { const int q = nwg / NXCD, r = nwg % NXCD, xcd = wgid % NXCD, off = wgid / NXCD; wgid = (xcd < r ? xcd * (q + 1) : r * (q + 1) + (xcd - r) * q) + off; }
        const int nig = WGM * nN, gid = wgid / nig, fm = gid * WGM, gsz = (nM - fm) < WGM ? (nM - fm) : WGM;
        u.pm = fm + ((wgid % nig) % gsz); u.pn = (wgid % nig) / gsz; return true;
    }
    __device__ __forceinline__ void a_ready(const Unit&) const {}
    __device__ __forceinline__ void done(const Unit&) const {}
};
__device__ __forceinline__ unsigned cvt_pk_bf16(float lo, float hi) { unsigned r; asm volatile("v_cvt_pk_bf16_f32 %0, %1, %2" : "=v"(r) : "v"(lo), "v"(hi)); return r; }
struct EpiF32 {
    static constexpr bool PERM = false, AFTER_DRAIN = false;
    float* C; int ldc; const float* bias;
    __device__ __forceinline__ void operator()(const f32x4 (&acc)[2][2][4][2], const Unit& u, int wr, int wc, int fr, int fq) const {
        const int row0 = u.pm * BM + wr * 64 + fr, col0 = u.pn * BM + wc * 32 + 4 * fq;
        f32x4 bv[2][2];
#pragma unroll
        for (int bj = 0; bj < 2; ++bj)
#pragma unroll
            for (int n = 0; n < 2; ++n) bv[bj][n] = bias ? *(const f32x4*)(bias + col0 + bj * HALF + n * 16) : (f32x4){0.f, 0.f, 0.f, 0.f};
#pragma unroll
        for (int ai = 0; ai < 2; ++ai)
#pragma unroll
            for (int m = 0; m < 4; ++m) { float* rowp = C + (size_t)(row0 + ai * HALF + m * 16) * ldc + col0;
#pragma unroll
                for (int bj = 0; bj < 2; ++bj)
#pragma unroll
                    for (int n = 0; n < 2; ++n) *(f32x4*)(rowp + bj * HALF + n * 16) = acc[ai][bj][m][n] + bv[bj][n]; }
    }
};

struct EpiSwiGLU {
    static constexpr bool PERM = true, AFTER_DRAIN = false;
    bf16_t* O; int ldc;
    __device__ __forceinline__ void operator()(const f32x4 (&acc)[2][2][4][2], const Unit& u, int wr, int wc, int fr, int fq) const {
        const int row0 = u.pm * BM + wr * 64 + fr, col0 = u.pn * 128 + wc * 32 + 8 * fq;
#pragma unroll
        for (int ai = 0; ai < 2; ++ai)
#pragma unroll
            for (int m = 0; m < 4; ++m) { bf16_t* rowp = O + (size_t)(row0 + ai * HALF + m * 16) * ldc + col0;
                const f32x4 g0 = acc[ai][0][m][0], g1 = acc[ai][0][m][1], u0 = acc[ai][1][m][0], u1 = acc[ai][1][m][1];
                float r[8];
#pragma unroll
                for (int j = 0; j < 4; ++j) {
                    r[j]     = g0[j] * __builtin_amdgcn_rcpf(1.0f + __builtin_amdgcn_exp2f(-1.4426950408889634f * g0[j])) * u0[j];
                    r[4 + j] = g1[j] * __builtin_amdgcn_rcpf(1.0f + __builtin_amdgcn_exp2f(-1.4426950408889634f * g1[j])) * u1[j]; }
                u32x4 w; w.x = cvt_pk_bf16(r[0], r[1]); w.y = cvt_pk_bf16(r[2], r[3]); w.z = cvt_pk_bf16(r[4], r[5]); w.w = cvt_pk_bf16(r[6], r[7]);
                *(u32x4*)rowp = w; }
    }
};
struct EpiResid {
    static constexpr bool PERM = false, AFTER_DRAIN = false;
    const float* res; float* out; int ldc; const float* gate0; float coef;
    __device__ __forceinline__ void operator()(const f32x4 (&acc)[2][2][4][2], const Unit& u, int wr, int wc, int fr, int fq) const {
        const int row0 = u.pm * BM + wr * 64 + fr, col0 = u.pn * BM + wc * 32 + 4 * fq;
        const float* gate = gate0 + (size_t)cond_of_row(u.pm * BM) * NMOD;
        f32x4 gv[2][2];
#pragma unroll
        for (int bj = 0; bj < 2; ++bj)
#pragma unroll
            for (int n = 0; n < 2; ++n) gv[bj][n] = *(const f32x4*)(gate + col0 + bj * HALF + n * 16) * coef;
#pragma unroll
        for (int ai = 0; ai < 2; ++ai)
#pragma unroll
            for (int m = 0; m < 4; ++m) { const size_t off = (size_t)(row0 + ai * HALF + m * 16) * ldc + col0;
#pragma unroll
                for (int bj = 0; bj < 2; ++bj)
#pragma unroll
                    for (int n = 0; n < 2; ++n) { const f32x4 bs = *(const f32x4*)(res + off + bj * HALF + n * 16); *(f32x4*)(out + off + bj * HALF + n * 16) = bs + gv[bj][n] * acc[ai][bj][m][n]; }
                asm volatile("" ::: "memory"); }
    }
};
template <class Epi, class Sched, bool STAMP = false>
__device__ __forceinline__ void gemm_phase(PG8_LAS unsigned char* lds, const Gemm g, const Sched& S, const Epi& E, unsigned long long* stamps) {
    const int tid = opaque_tid(), wid = __builtin_amdgcn_readfirstlane(tid >> 6), lane = tid & 63, wr = wid >> 2, wc = wid & 3, fr = lane & 15, fq = lane >> 4;
    const int K = g.K, nt = K / BK;
    int ts_lo = 0, ts_hi = 0, nts = 0; const unsigned long long rt_entry = STAMP ? (unsigned long long)wall_clock64() : 0ull;
#define PG8_STAMP() do { if (STAMP && wid == 0 && nts < 64) { const unsigned long long _c = (unsigned long long)clock64(); \
        ts_lo = (lane == nts) ? (int)(unsigned)_c : ts_lo; ts_hi = (lane == nts) ? (int)(unsigned)(_c >> 32) : ts_hi; ++nts; } } while (0)
    PG8_STAMP();
    unsigned voffA[2], voffB[2];
#pragma unroll
    for (int i = 0; i < 2; ++i) { int R, C; stage_rc(tid * 16 + i * 8192, R, C); const int Rb = Epi::PERM ? ((R & ~31) + perm32(R & 31)) : R;
        voffA[i] = (unsigned)(R * K + C) * 2u; voffB[i] = (unsigned)(Rb * K + C) * 2u; }
    const size_t kstep = (size_t)(BK * 2);
    const size_t hstep = (size_t)HALF * K * 2;
    const size_t tstep = 2 * hstep;
    const unsigned ldsw = (unsigned)wid * 1024u;
    const int aoff = lds_byte(wr * 64 + fr, fq * 8), boff = lds_byte(wc * 32 + fr, fq * 8);
#define PG8_SA(b, h) (((b) * 2 + (h)) * HTB)
#define PG8_SB(b, h) ((4 + (b) * 2 + (h)) * HTB)
#define PG8_STAGE(bufoff, gbase, voff) do { _Pragma("unroll") for (int _i = 0; _i < 2; ++_i) \
        __builtin_amdgcn_global_load_lds((const unsigned*)((const char*)(gbase) + (voff)[_i]), (PG8_LAS unsigned*)(lds + (bufoff) + ldsw + _i * 8192), 16, 0, 0); } while (0)
#define PG8_LDA(dst, b, h) do { _Pragma("unroll") for (int m = 0; m < 4; ++m) _Pragma("unroll") for (int k = 0; k < 2; ++k) dst[m][k] = *(const PG8_LAS bf16x8*)(lds + PG8_SA(b, h) + aoff + m * 2048 + k * 1024); } while (0)
#define PG8_LDB(dst, b, h) do { _Pragma("unroll") for (int n = 0; n < 2; ++n) _Pragma("unroll") for (int k = 0; k < 2; ++k) dst[n][k] = *(const PG8_LAS bf16x8*)(lds + PG8_SB(b, h) + boff + n * 2048 + k * 1024); } while (0)
#define PG8_MMA(ai, bj, At, Bt) do { __builtin_amdgcn_s_setprio(1); _Pragma("unroll") for (int m = 0; m < 4; ++m) _Pragma("unroll") for (int n = 0; n < 2; ++n) _Pragma("unroll") for (int k = 0; k < 2; ++k) \
        acc[ai][bj][m][n] = __builtin_amdgcn_mfma_f32_16x16x32_bf16(Bt[n][k], At[m][k], acc[ai][bj][m][n], 0, 0, 0); __builtin_amdgcn_s_setprio(0); } while (0)
#define PG8_WAIT_V(n) asm volatile("s_waitcnt vmcnt(" #n ")" ::: "memory")
#define PG8_WAIT_L(n) asm volatile("s_waitcnt lgkmcnt(" #n ")" ::: "memory")
#define PG8_BAR __builtin_amdgcn_s_barrier()
#define PG8_SCHED __builtin_amdgcn_sched_barrier(0)
    Unit cur, nxt; int ui = 0;
    if (!S.next(0, cur)) return;
    f32x4 acc[2][2][4][2];
#pragma unroll
    for (int a = 0; a < 2; ++a)
#pragma unroll
        for (int b = 0; b < 2; ++b)
#pragma unroll
            for (int m = 0; m < 4; ++m)
#pragma unroll
                for (int n = 0; n < 2; ++n) acc[a][b][m][n] = (f32x4){0.f, 0.f, 0.f, 0.f};
    bf16x8 At[4][2], B0[2][2], B1[2][2];
    const char* cA = (const char*)g.A + (size_t)cur.pm * tstep; const char* cB = (const char*)g.Bt + (size_t)cur.pn * tstep;
    S.a_ready(cur);
    PG8_STAGE(PG8_SB(0, 0), cB, voffB); PG8_STAGE(PG8_SA(0, 0), cA, voffA); PG8_STAGE(PG8_SB(0, 1), cB + hstep, voffB); PG8_STAGE(PG8_SA(0, 1), cA + hstep, voffA);
    if (wr == 1) PG8_BAR;
    PG8_WAIT_V(4); PG8_BAR;
    PG8_STAGE(PG8_SB(1, 0), cB + kstep, voffB); PG8_STAGE(PG8_SA(1, 0), cA + kstep, voffA); PG8_STAGE(PG8_SB(1, 1), cB + hstep + kstep, voffB);
    PG8_WAIT_V(6); PG8_BAR;
    PG8_STAMP();
    for (;;) {
        const bool has_next = S.next(ui + 1, nxt);
        const char* nA = has_next ? (const char*)g.A + (size_t)nxt.pm * tstep : cA; const char* nB = has_next ? (const char*)g.Bt + (size_t)nxt.pn * tstep : cB;
        for (int t = 0; t < nt; t += 2) {
            const bool last = (t == nt - 2);
            const char* a1 = cA + (size_t)(t + 1) * kstep;
            const char* a2 = last ? nA : cA + (size_t)(t + 2) * kstep; const char* b2 = last ? nB : cB + (size_t)(t + 2) * kstep;
            const char* a3 = a2 + kstep; const char* b3 = b2 + kstep;
            if (last && has_next) S.a_ready(nxt);
            PG8_LDB(B0, 0, 0); PG8_SCHED; PG8_LDA(At, 0, 0); PG8_STAGE(PG8_SA(1, 1), a1 + hstep, voffA);
            PG8_WAIT_L(8); PG8_BAR; PG8_WAIT_L(0); PG8_MMA(0, 0, At, B0); PG8_BAR; PG8_SCHED;
            PG8_LDB(B1, 0, 1); PG8_STAGE(PG8_SB(0, 0), b2, voffB);
            PG8_BAR; PG8_WAIT_L(0); PG8_MMA(0, 1, At, B1); PG8_BAR;
            PG8_LDA(At, 0, 1); PG8_STAGE(PG8_SA(0, 0), a2, voffA);
            PG8_BAR; PG8_WAIT_L(0); PG8_MMA(1, 0, At, B0); PG8_BAR; PG8_SCHED;
            PG8_STAGE(PG8_SB(0, 1), b2 + hstep, voffB);
            PG8_WAIT_V(6); PG8_BAR; PG8_MMA(1, 1, At, B1); PG8_BAR;
            PG8_LDB(B0, 1, 0); PG8_SCHED; PG8_LDA(At, 1, 0); PG8_STAGE(PG8_SA(0, 1), a2 + hstep, voffA);
            PG8_WAIT_L(8); PG8_BAR; PG8_WAIT_L(0); PG8_MMA(0, 0, At, B0); PG8_BAR; PG8_SCHED;
            PG8_LDB(B1, 1, 1); PG8_STAGE(PG8_SB(1, 0), b3, voffB);
            PG8_BAR; PG8_WAIT_L(0); PG8_MMA(0, 1, At, B1); PG8_BAR;
            PG8_LDA(At, 1, 1); PG8_STAGE(PG8_SA(1, 0), a3, voffA);
            PG8_BAR; PG8_WAIT_L(0); PG8_MMA(1, 0, At, B0); PG8_BAR; PG8_SCHED;
            PG8_STAGE(PG8_SB(1, 1), b3 + hstep, voffB);
            PG8_WAIT_V(6); PG8_BAR; PG8_MMA(1, 1, At, B1); PG8_BAR;
        }
        PG8_STAMP();
        if constexpr (!Epi::AFTER_DRAIN) { E(acc, cur, wr, wc, fr, fq); S.done(cur); }
        PG8_STAMP();
        if (!has_next) break;
#pragma unroll
        for (int a = 0; a < 2; ++a)
#pragma unroll
            for (int b = 0; b < 2; ++b)
#pragma unroll
                for (int m = 0; m < 4; ++m)
#pragma unroll
                    for (int n = 0; n < 2; ++n) acc[a][b][m][n] = (f32x4){0.f, 0.f, 0.f, 0.f};
        cur = nxt; cA = nA; cB = nB; ++ui;
    }
    PG8_WAIT_V(0);
    if (wr == 0) PG8_BAR;
    PG8_BAR;
    if constexpr (Epi::AFTER_DRAIN) { E.fused(acc, cur, wr, wc, fr, fq, lds, wid, lane); S.done(cur); }
    PG8_STAMP();
    if (STAMP && wid == 0) { stamps[lane] = lane < nts ? (((unsigned long long)(unsigned)ts_hi << 32) | (unsigned)ts_lo) : 0ull;
        if (lane == 62) stamps[62] = rt_entry; if (lane == 63) stamps[63] = (unsigned long long)wall_clock64(); }
#undef PG8_STAMP
#undef PG8_SA
#undef PG8_SB
#undef PG8_STAGE
#undef PG8_LDA
#undef PG8_LDB
#undef PG8_MMA
#undef PG8_WAIT_V
#undef PG8_WAIT_L
#undef PG8_BAR
#undef PG8_SCHED
}
}
#ifndef ATT_INLINE
#define ATT_INLINE __forceinline__
#endif
namespace att {
constexpr int D = 128, NW = 8, QBLK = 32, KVBLK = 64, LDQ = 512, LDO = DM;
constexpr float SCALE = 0.088388347648318440f;
constexpr float THR = 8.f;
constexpr size_t SHM_V = KVBLK * D * 2, SHM_K = KVBLK * D * 2, SHM_Q = 256 * D * 2, SHM_ATTN = 2 * SHM_V + 2 * SHM_K + NW * 64 * 4 + SHM_Q;
using bf16x8 = __attribute__((ext_vector_type(8))) short;
using s16x4  = __attribute__((ext_vector_type(4))) short;
using f32x16 = __attribute__((ext_vector_type(16))) float;
using u32x4  = __attribute__((ext_vector_type(4))) unsigned;
#define KSWZ(row, colB) ((row) * 256 + ((colB) ^ (((row) & 7) << 4)))
#define SBAR() __builtin_amdgcn_sched_barrier(0)
__device__ __forceinline__ int crow(int r, int hi) { return (r & 3) + 8 * (r >> 2) + 4 * hi; }
__device__ __forceinline__ unsigned cvtpk(float lo, float hi) { unsigned r; asm volatile("v_cvt_pk_bf16_f32 %0, %1, %2" : "=v"(r) : "v"(lo), "v"(hi)); return r; }

__device__ __forceinline__ void partialSM(f32x16& p0, f32x16& p1, float& m_reg, float& mn, float& alpha) {
  constexpr float C = SCALE * 1.4426950408889634f;
  float pmax = p0[0]; for (int r = 1; r < 16; ++r) pmax = fmaxf(pmax, p0[r]); for (int r = 0; r < 16; ++r) pmax = fmaxf(pmax, p1[r]);
  { auto rr = __builtin_amdgcn_permlane32_swap(__float_as_uint(pmax), __float_as_uint(pmax), false, false);
    pmax = fmaxf(__uint_as_float(rr[0]), __uint_as_float(rr[1])); }
  if (__builtin_expect(__all(pmax - m_reg <= THR / SCALE), 1)) { mn = m_reg; alpha = 1.f; }
  else { mn = fmaxf(m_reg, pmax); alpha = __builtin_amdgcn_exp2f((m_reg - mn) * C); m_reg = mn; }
  float mnC = -mn * C;
  for (int r = 0; r < 16; ++r) p0[r] = fmaf(p0[r], C, mnC); for (int r = 0; r < 16; ++r) p1[r] = fmaf(p1[r], C, mnC);
  for (int r = 0; r < 16; ++r) p0[r] = __builtin_amdgcn_exp2f(p0[r]);
}
__device__ __forceinline__ void finishSM(f32x16& p0, f32x16& p1, float alpha, float& l_reg, bf16x8& pa0, bf16x8& pa1, bf16x8& pa2, bf16x8& pa3) {
  for (int r = 0; r < 16; ++r) p1[r] = __builtin_amdgcn_exp2f(p1[r]);
  float ps = 0; for (int r = 0; r < 16; ++r) ps += p0[r]; for (int r = 0; r < 16; ++r) ps += p1[r];
  { auto rr = __builtin_amdgcn_permlane32_swap(__float_as_uint(ps), __float_as_uint(ps), false, false);
    ps = __uint_as_float(rr[0]) + __uint_as_float(rr[1]); }
  l_reg = l_reg * alpha + ps;
#define PK4(P, BASE, OUT) do { unsigned a0 = cvtpk(P[BASE + 0], P[BASE + 1]), a1 = cvtpk(P[BASE + 2], P[BASE + 3]);   \
    unsigned b0 = cvtpk(P[BASE + 4], P[BASE + 5]), b1 = cvtpk(P[BASE + 6], P[BASE + 7]);                              \
    auto r0 = __builtin_amdgcn_permlane32_swap(a0, b0, false, false); auto r1 = __builtin_amdgcn_permlane32_swap(a1, b1, false, false); \
    u32x4 w = {r0[0], r1[0], r0[1], r1[1]}; OUT = *reinterpret_cast<bf16x8*>(&w); } while (0)
  PK4(p0, 0, pa0); PK4(p0, 8, pa1); PK4(p1, 0, pa2); PK4(p1, 8, pa3);
#undef PK4
}
__device__ __forceinline__ void qkt(f32x16& p0, f32x16& p1, const bf16_t* Ks, const bf16_t* Qs, int qrow, int r32, int hi) {
  p0 = f32x16{}; p1 = f32x16{};
#pragma unroll
  for (int d0 = 0; d0 < 8; ++d0) { int cb = (d0 * 16 + hi * 8) * 2;
    bf16x8 q = *reinterpret_cast<const bf16x8*>((const char*)Qs + KSWZ(qrow, cb));
    bf16x8 b0 = *reinterpret_cast<const bf16x8*>((const char*)Ks + KSWZ(r32, cb));
    bf16x8 b1 = *reinterpret_cast<const bf16x8*>((const char*)Ks + KSWZ(32 + r32, cb));
    p0 = __builtin_amdgcn_mfma_f32_32x32x16_bf16(b0, q, p0, 0, 0, 0);
    p1 = __builtin_amdgcn_mfma_f32_32x32x16_bf16(b1, q, p1, 0, 0, 0); }
}
__device__ __forceinline__ int v_st(int k, int c) { const int kk = (k & ~0xC) | ((k & 4) << 1) | ((k & 8) >> 1); return ((kk >> 3) * 4 + (c >> 5)) * 512 + ((kk & 7) * 32 + (c & 31)) * 2; }
__device__ __forceinline__ int v_rd_base(int lane) { return ((lane & 3) << 3) | (((lane >> 2) & 3) << 6) | (((lane >> 4) & 1) << 5) | (((lane >> 5) & 1) << 8); }
constexpr int v_rd_off(int d0, int ks, int half) { return d0 * 512 + ks * 4096 + half * 2048; }
template <int OFF> __device__ __forceinline__ s16x4 tr_read(int vb) {
  s16x4 r; asm volatile("ds_read_b64_tr_b16 %0, %1 offset:%2" : "=&v"(r) : "v"(vb), "i"(OFF) : "memory"); return r;
}
template <int D0> __device__ __forceinline__ void pv_one(f32x16& od, int vb, bf16x8 pa0, bf16x8 pa1, bf16x8 pa2, bf16x8 pa3) {
  const s16x4 l0 = tr_read<v_rd_off(D0, 0, 0)>(vb), h0 = tr_read<v_rd_off(D0, 0, 1)>(vb), l1 = tr_read<v_rd_off(D0, 1, 0)>(vb), h1 = tr_read<v_rd_off(D0, 1, 1)>(vb);
  const s16x4 l2 = tr_read<v_rd_off(D0, 2, 0)>(vb), h2 = tr_read<v_rd_off(D0, 2, 1)>(vb), l3 = tr_read<v_rd_off(D0, 3, 0)>(vb), h3 = tr_read<v_rd_off(D0, 3, 1)>(vb);
  asm volatile("s_waitcnt lgkmcnt(0)" ::: "memory"); SBAR();
#define PK(L, H) (bf16x8){L[0], L[1], L[2], L[3], H[0], H[1], H[2], H[3]}
  od = __builtin_amdgcn_mfma_f32_32x32x16_bf16(pa0, PK(l0, h0), od, 0, 0, 0);
  od = __builtin_amdgcn_mfma_f32_32x32x16_bf16(pa1, PK(l1, h1), od, 0, 0, 0);
  od = __builtin_amdgcn_mfma_f32_32x32x16_bf16(pa2, PK(l2, h2), od, 0, 0, 0);
  od = __builtin_amdgcn_mfma_f32_32x32x16_bf16(pa3, PK(l3, h3), od, 0, 0, 0);
#undef PK
}
__device__ __forceinline__ void pv_d0(f32x16* o, int vb, bf16x8 pa0, bf16x8 pa1, bf16x8 pa2, bf16x8 pa3) {
  pv_one<0>(o[0], vb, pa0, pa1, pa2, pa3); pv_one<1>(o[1], vb, pa0, pa1, pa2, pa3); pv_one<2>(o[2], vb, pa0, pa1, pa2, pa3); pv_one<3>(o[3], vb, pa0, pa1, pa2, pa3);
}

struct SrcOne { const bf16_t* k0; const bf16_t* v0; int ldk;
  __device__ __forceinline__ const bf16_t* k(int j) const { return k0 + (size_t)j * 64 * ldk; }
  __device__ __forceinline__ const bf16_t* v(int j) const { return v0 + (size_t)j * 64 * ldk; } };
struct SrcTwo { const bf16_t* ck; const bf16_t* cv; const bf16_t* k1; const bf16_t* v1; int ldk;
  __device__ __forceinline__ const bf16_t* k(int j) const { return j < 4 ? ck + (size_t)j * 64 * ldk : k1 + (size_t)(j - 4) * 64 * ldk; }
  __device__ __forceinline__ const bf16_t* v(int j) const { return j < 4 ? cv + (size_t)j * 64 * ldk : v1 + (size_t)(j - 4) * 64 * ldk; } };
struct NoBias { __device__ __forceinline__ void operator()(f32x16&, f32x16&, int, int, int, int) const {} };
struct NaBias { const float* tab; int i0, kr0;
  __device__ __forceinline__ void operator()(f32x16& p0, f32x16& p1, int jt, int wid, int r32, int hi) const {
    if (jt < 4) return;
    const int qi = i0 + wid * QBLK + r32, r = qi >> 6, qc = qi & 63, kr = kr0 + jt - 4;
    int lo = r - 4; lo = lo < 0 ? 0 : (lo > 8 ? 8 : lo);
    const bool rowok = (kr >= lo) && (kr < lo + 8);
    if (!rowok) {
#pragma unroll
      for (int rr = 0; rr < 16; ++rr) { p0[rr] = -1e30f; p1[rr] = -1e30f; }
      return;
    }
    int c0 = qc - 8; c0 = c0 < 0 ? 0 : (c0 > 48 ? 48 : c0);
    const int dr = kr - r + 7;
    const float* tb = tab + dr * 31 + (4 * hi - qc + 15);
    const int w0 = 4 * hi - c0;
#pragma unroll
    for (int g = 0; g < 4; ++g) {
#pragma unroll
      for (int q = 0; q < 4; ++q) {
        const int rr = 4 * g + q, kc0 = q + 8 * g;
        const float t0 = tb[kc0], t1 = tb[kc0 + 32];
        p0[rr] = ((unsigned)(kc0 + w0) < 16u) ? p0[rr] + t0 : -1e30f;
        p1[rr] = ((unsigned)(kc0 + 32 + w0) < 16u) ? p1[rr] + t1 : -1e30f;
      }
      SBAR();
    }
  } };

template <class Src, class Bias>
__device__ ATT_INLINE void attn_body(const bf16_t* __restrict__ Qb, const Src src, bf16_t* __restrict__ Ob, const int NT, char* lds, const Bias bias) {
  const int tid = opaque_tid(), wid = tid >> 6, lane = tid & 63, r32 = lane & 31, hi = lane >> 5;
  const int LDK = src.ldk;
  bf16_t* V_lds = (bf16_t*)lds; bf16_t* K_lds = (bf16_t*)(lds + 2 * SHM_V);
  float* ws = (float*)(lds + 2 * SHM_V + 2 * SHM_K) + wid * 64; float* li_l = ws; float* al_l = ws + 32;
  float m_reg = -1e30f, l_reg = 0; f32x16 o[4] = {};
  bf16_t* Q_lds = (bf16_t*)(lds + 2 * SHM_V + 2 * SHM_K + NW * 64 * 4);
  const int qrow = wid * QBLK + r32;
  {
#pragma unroll
    for (int i = 0; i < 8; ++i) { const int f = tid + 512 * i, row = f >> 4, c8 = (f & 15) * 8;
      *(bf16x8*)((char*)Q_lds + KSWZ(row, c8 * 2)) = *reinterpret_cast<const bf16x8*>(Qb + (long)row * LDQ + c8); }
  }
  const int sr = tid >> 4, sc = (tid & 15) * 8, vst0 = v_st(sr, sc), vst1 = v_st(32 + sr, sc);
  const int vb0 = (int)(uintptr_t)V_lds + v_rd_base(lane);
  struct { bf16x8 vs0, vs1, ks0, ks1; } sr_[2];
#define SLOAD(i, jt) do { const bf16_t* kt_ = src.k(jt); const bf16_t* vt_ = src.v(jt); \
    sr_[i].vs0 = *reinterpret_cast<const bf16x8*>(&vt_[(long)sr * LDK + sc]); sr_[i].vs1 = *reinterpret_cast<const bf16x8*>(&vt_[(long)(32 + sr) * LDK + sc]); \
    sr_[i].ks0 = *reinterpret_cast<const bf16x8*>(&kt_[(long)sr * LDK + sc]); sr_[i].ks1 = *reinterpret_cast<const bf16x8*>(&kt_[(long)(32 + sr) * LDK + sc]); } while (0)
#define SWRITE(b, i) do { *(bf16x8*)((char*)V_lds + (b) * SHM_V + vst0) = sr_[i].vs0;          \
    *(bf16x8*)((char*)V_lds + (b) * SHM_V + vst1) = sr_[i].vs1; int kc = sc * 2;               \
    *(bf16x8*)((char*)K_lds + (b) * SHM_K + KSWZ(sr, kc)) = sr_[i].ks0;                       \
    *(bf16x8*)((char*)K_lds + (b) * SHM_K + KSWZ(32 + sr, kc)) = sr_[i].ks1; } while (0)
#define SWAIT() asm volatile("s_waitcnt vmcnt(4)" ::: "memory")
#define RESC(a) do { if (__any((a) < 1.f)) { if (hi == 0) al_l[r32] = (a); asm volatile("s_waitcnt lgkmcnt(0)" ::: "memory"); \
    for (int d = 0; d < 4; ++d) for (int r = 0; r < 16; ++r) o[d][r] *= al_l[crow(r, hi)]; } } while (0)
  f32x16 pA0, pA1, pB0, pB1; float mnA, mnB, alA, alB; bf16x8 pa0, pa1, pa2, pa3;
  constexpr int SE = 0, SO = 1;
  SLOAD(SE, 0); asm volatile("s_waitcnt vmcnt(0)" ::: "memory"); SWRITE(0, SE); __syncthreads();
  qkt(pA0, pA1, K_lds, Q_lds, qrow, r32, hi); bias(pA0, pA1, 0, wid, r32, hi); partialSM(pA0, pA1, m_reg, mnA, alA);
  SLOAD(SO, 1); if (2 < NT) SLOAD(SE, 2);
  SWAIT(); SWRITE(1, SO); __syncthreads();
  for (int j = 1; j + 1 < NT; j += 2) {
    SBAR(); qkt(pB0, pB1, (bf16_t*)((char*)K_lds + SHM_K), Q_lds, qrow, r32, hi); bias(pB0, pB1, j, wid, r32, hi);
    finishSM(pA0, pA1, alA, l_reg, pa0, pa1, pa2, pa3); SBAR();
    SLOAD(SO, j + 2); SBAR();
    pv_d0(o, vb0, pa0, pa1, pa2, pa3); partialSM(pB0, pB1, m_reg, mnB, alB);
    __syncthreads(); SWAIT(); SWRITE(0, SE);
    RESC(alB); __syncthreads();
    SBAR(); qkt(pA0, pA1, K_lds, Q_lds, qrow, r32, hi); bias(pA0, pA1, j + 1, wid, r32, hi);
    finishSM(pB0, pB1, alB, l_reg, pa0, pa1, pa2, pa3); SBAR();
    if (j + 3 < NT) SLOAD(SE, j + 3); SBAR();
    pv_d0(o, vb0 + (int)SHM_V, pa0, pa1, pa2, pa3); partialSM(pA0, pA1, m_reg, mnA, alA);
    __syncthreads(); SWAIT(); SWRITE(1, SO);
    RESC(alA); __syncthreads();
  }
  SBAR(); qkt(pB0, pB1, (bf16_t*)((char*)K_lds + SHM_K), Q_lds, qrow, r32, hi); bias(pB0, pB1, NT - 1, wid, r32, hi);
  finishSM(pA0, pA1, alA, l_reg, pa0, pa1, pa2, pa3); SBAR();
  pv_d0(o, vb0, pa0, pa1, pa2, pa3); partialSM(pB0, pB1, m_reg, mnB, alB);
  __syncthreads(); RESC(alB);
  finishSM(pB0, pB1, alB, l_reg, pa0, pa1, pa2, pa3); SBAR();
  pv_d0(o, vb0 + (int)SHM_V, pa0, pa1, pa2, pa3);
  if (hi == 0) li_l[r32] = l_reg; asm volatile("s_waitcnt lgkmcnt(0)" ::: "memory");
  float rli[16];
#pragma unroll
  for (int r = 0; r < 16; ++r) rli[r] = __builtin_amdgcn_rcpf(li_l[crow(r, hi)]);
  bf16_t* Ow = Ob + (long)(wid * QBLK) * LDO;
#pragma unroll
  for (int r = 0; r < 16; ++r) { int orow = crow(r, hi);
    for (int d0 = 0; d0 < 4; ++d0) Ow[(long)orow * LDO + d0 * 32 + r32] = f2bf(o[d0][r] * rli[r]); }
#undef SLOAD
#undef SWRITE
#undef SWAIT
#undef RESC
}
}
#define LAS __attribute__((address_space(3)))
constexpr int LDS_BYTES = 147456, XBW_OFF = LDS_BYTES - 64;
constexpr int NPH = 1 + DEPTH * 12;
#ifndef DBG_NLAYERS
#define DBG_NLAYERS DEPTH
#endif

#ifndef MIXMASK
#define MIXMASK 0xFF
#endif
#define FOR_ITEMS(it, n, o, w) for (int bo_ = (o) * (int)gridDim.x / 256, bw_ = ((w) * (int)gridDim.x / 256) > 0 ? ((w) * (int)gridDim.x / 256) : 1, \
                                    it = ((int)blockIdx.x >= bo_ && (int)blockIdx.x < bo_ + bw_) ? (int)blockIdx.x - bo_ : (n); it < (n); it += bw_)

__device__ __forceinline__ void phase_mix(const Params& p, int l, unsigned char* lds) {
    const int tid = opaque_tid();
    float* smem = (float*)lds;
    const bf16_t* NAQ = WSP(bf16_t, WS_NAQ); const bf16_t* NAK = WSP(bf16_t, WS_NAK); const bf16_t* NAV = WSP(bf16_t, WS_NAV);
    const bf16_t* GQ = WSP(bf16_t, WS_GQ); const bf16_t* GK = WSP(bf16_t, WS_GK); const bf16_t* GV = WSP(bf16_t, WS_GV);
    bf16_t* MRG = WSP(bf16_t, WS_MRG);
    if ((MIXMASK >> 0) & 1) FOR_ITEMS(it, LB * 8, 0, 64) gdn_chain(p, l, false, it / 8, (it / 2) % 4, it % 2, smem);
    if ((MIXMASK >> 1) & 1) FOR_ITEMS(it, LB * 8, 64, 64) gla_chain(p, l, false, it / 8, (it / 2) % 4, it % 2, smem);
    if ((MIXMASK >> 2) & 1) FOR_ITEMS(it, LB * 16, 128, 128) {
        const int b = it / 16, qh = (it / 4) % 4, qb = it % 4, kvh = qh >> 1;
        const size_t r0 = (size_t)MC + (size_t)b * LT;
        att::SrcTwo src{WSP(bf16_t, WS_CGK) + ((size_t)b * DEPTH + l) * 256 * 256 + kvh * 128, WSP(bf16_t, WS_CGV) + ((size_t)b * DEPTH + l) * 256 * 256 + kvh * 128,
                        GK + r0 * 256 + kvh * 128, GV + r0 * 256 + kvh * 128, 256};
        __syncthreads();
        att::attn_body(GQ + (r0 + qb * 256) * 512 + qh * 128, src, MRG + (r0 + qb * 256) * DM + 1024 + qh * 128, 4 + LT / 64, (char*)lds, att::NoBias{});
    }
    if ((MIXMASK >> 3) & 1) FOR_ITEMS(it, LB * 16, 128, 128) {
        const int b = it / 16, h = (it / 4) % 4, qb = it % 4;
        const int kr0 = qb == 0 ? 0 : qb == 1 ? 0 : qb == 2 ? 4 : 8, nrows = (qb == 0 || qb == 3) ? 8 : 12;
        const size_t r0 = (size_t)MC + (size_t)b * LT;
        float* tab = (float*)(lds + att::SHM_ATTN);
        __syncthreads();
        if (tid < 15 * 31) tab[tid] = p.in[I_RPB][((size_t)l * 4 + h) * 15 * 31 + tid] * (1.0f / att::SCALE);
        att::SrcTwo src{WSP(bf16_t, WS_CNAK) + ((size_t)b * DEPTH + l) * 256 * 512 + h * 128, WSP(bf16_t, WS_CNAV) + ((size_t)b * DEPTH + l) * 256 * 512 + h * 128,
                        NAK + (r0 + kr0 * 64) * 512 + h * 128, NAV + (r0 + kr0 * 64) * 512 + h * 128, 512};
        att::attn_body(NAQ + (r0 + qb * 256) * 512 + h * 128, src, MRG + (r0 + qb * 256) * DM + 0 + h * 128, 4 + nrows, (char*)lds, att::NaBias{tab, qb * 256, kr0});
    }
    if ((MIXMASK >> 4) & 1) FOR_ITEMS(it, CB * 8, 64, 64) gdn_chain(p, l, true, it / 8, (it / 2) % 4, it % 2, smem);
    if ((MIXMASK >> 5) & 1) FOR_ITEMS(it, CB * 8, 128, 128) gla_chain(p, l, true, it / 8, (it / 2) % 4, it % 2, smem);
    if ((MIXMASK >> 6) & 1) FOR_ITEMS(it, CB * 4, 128, 64) {
        const int b = it / 4, h = it % 4; const size_t r0 = (size_t)b * CT;
        att::SrcOne src{NAK + r0 * 512 + h * 128, NAV + r0 * 512 + h * 128, 512};
        __syncthreads();
        att::attn_body(NAQ + r0 * 512 + h * 128, src, MRG + r0 * DM + 0 + h * 128, CT / 64, (char*)lds, att::NoBias{});
    }
    if ((MIXMASK >> 7) & 1) FOR_ITEMS(it, CB * 4, 192, 64) {
        const int b = it / 4, qh = it % 4, kvh = qh >> 1; const size_t r0 = (size_t)b * CT;
        att::SrcOne src{GK + r0 * 256 + kvh * 128, GV + r0 * 256 + kvh * 128, 256};
        __syncthreads();
        att::attn_body(GQ + r0 * 512 + qh * 128, src, MRG + r0 * DM + 1024 + qh * 128, CT / 64, (char*)lds, att::NoBias{});
    }
}

static_assert(att::SHM_ATTN + 15 * 31 * 4 + 2048 <= (size_t)XBW_OFF, "LDS map");
constexpr int BAR_WORD0 = 4096;
static_assert((BAR_WORD0 + XCD_BAR_WORDS) * 4 <= (int)CTL_BYTES, "ctl");

__global__ void __launch_bounds__(512, 2) fwd(Params p) {
    extern __shared__ __attribute__((aligned(16))) unsigned char lds[];
    const int tid = threadIdx.x;
    volatile LAS unsigned* xbw = (volatile LAS unsigned*)((LAS unsigned char*)lds + XBW_OFF);
    if (tid < 4) xbw[tid] = 0u;
    __syncthreads();
    XcdBarrier bar; bar.bar = WSP(unsigned, WS_CTL) + BAR_WORD0; bar.x = 0; bar.st = xbw;
    if (p.ph_hi - p.ph_lo > 1) bar = xcd_barrier_post(WSP(unsigned, WS_CTL) + BAR_WORD0, xbw);
#ifndef PHMASK
#define PHMASK 0x1FFF
#endif
#define IN(k) (p.ph_lo <= (k) && (k) < p.ph_hi)
#define INL(j) (((PHMASK >> ((j) + 1)) & 1) && IN(pb + (j)))
#define SEAM(k) do { if (IN(k) && IN((k) + 1)) xcd_barrier(bar); } while (0)
    LAS unsigned char* ldsl = (LAS unsigned char*)lds;
    bf16_t* H = WSP(bf16_t, WS_H); bf16_t* ACT = WSP(bf16_t, WS_ACT); float* X = WSP(float, WS_X); float* Z = WSP(float, WS_Z); bf16_t* MRG = WSP(bf16_t, WS_MRG);

    if ((PHMASK & 1) && IN(0)) { const Params q = opaque_params(p); phase_prologue(q, (float*)lds); }
    SEAM(0);
    for (int l = 0; l < DBG_NLAYERS; ++l) {
        const int pb = 1 + l * 12;
        const float* modl = WSP(float, WS_MODV) + (size_t)l * NCOND * NMOD;
        if (INL(0)) { const Params q = opaque_params(p); phase_norm(q, l, 0); }
        SEAM(pb + 0);
        if (INL(1)) {
            pg8::Gemm g{H, WSP(bf16_t, WS_WGU) + ((size_t)l * 2 + 0) * NGU * DM, M, NGU, DM}; pg8::StaticOrder S; S.init(M, NGU, (int)gridDim.x, (int)blockIdx.x);
            pg8::EpiSwiGLU E{ACT, FF};
            pg8::gemm_phase<pg8::EpiSwiGLU, pg8::StaticOrder, false>(ldsl, g, S, E, nullptr);
        }
        SEAM(pb + 1);
        if (INL(2)) {
            pg8::Gemm g{ACT, WSP(bf16_t, WS_WDN) + ((size_t)l * 2 + 0) * DM * FF, M, DM, FF}; pg8::StaticOrder S; S.init(M, DM, (int)gridDim.x, (int)blockIdx.x);
            pg8::EpiResid E{X, X, DM, modl + 2 * DM, 0.5f};
            pg8::gemm_phase<pg8::EpiResid, pg8::StaticOrder, false>(ldsl, g, S, E, nullptr);
        }
        SEAM(pb + 2);
        if (INL(3)) { const Params q = opaque_params(p); phase_norm(q, l, 1); }
        SEAM(pb + 3);
        if (INL(4)) {
            pg8::Gemm g{H, WSP(bf16_t, WS_WIN) + (size_t)l * NINP * DM, M, NINP, DM}; pg8::StaticOrder S; S.init(M, NINP, (int)gridDim.x, (int)blockIdx.x);
            pg8::EpiF32 E{Z, NINP, nullptr};
            pg8::gemm_phase<pg8::EpiF32, pg8::StaticOrder, false>(ldsl, g, S, E, nullptr);
        }
        SEAM(pb + 4);
        if (INL(5)) { const Params q = opaque_params(p); phase_prep(q, l); }
        SEAM(pb + 5);
        if (INL(6)) { const Params q = opaque_params(p); phase_mix(q, l, lds); }
        SEAM(pb + 6);
        if (INL(7)) { const Params q = opaque_params(p); phase_post(q, l); }
        SEAM(pb + 7);
        if (INL(8)) {
            pg8::Gemm g{MRG, WSP(bf16_t, WS_WOUT) + (size_t)l * DM * DM, M, DM, DM}; pg8::StaticOrder S; S.init(M, DM, (int)gridDim.x, (int)blockIdx.x);
            pg8::EpiResid E{X, X, DM, modl + 5 * DM, 1.0f};
            pg8::gemm_phase<pg8::EpiResid, pg8::StaticOrder, false>(ldsl, g, S, E, nullptr);
        }
        SEAM(pb + 8);
        if (INL(9)) { const Params q = opaque_params(p); phase_norm(q, l, 2); }
        SEAM(pb + 9);
        if (INL(10)) {
            pg8::Gemm g{H, WSP(bf16_t, WS_WGU) + ((size_t)l * 2 + 1) * NGU * DM, M, NGU, DM}; pg8::StaticOrder S; S.init(M, NGU, (int)gridDim.x, (int)blockIdx.x);
            pg8::EpiSwiGLU E{ACT, FF};
            pg8::gemm_phase<pg8::EpiSwiGLU, pg8::StaticOrder, false>(ldsl, g, S, E, nullptr);
        }
        SEAM(pb + 10);
        if (INL(11)) {
            pg8::Gemm g{ACT, WSP(bf16_t, WS_WDN) + ((size_t)l * 2 + 1) * DM * FF, M, DM, FF}; pg8::StaticOrder S; S.init(M, DM, (int)gridDim.x, (int)blockIdx.x);
            pg8::EpiResid E{X, (l == DEPTH - 1) ? p.out : X, DM, modl + 8 * DM, 0.5f};
            pg8::gemm_phase<pg8::EpiResid, pg8::StaticOrder, false>(ldsl, g, S, E, nullptr);
        }
        SEAM(pb + 11);
    }
#undef IN
#undef SEAM
}

#ifndef MULTI_LAUNCH
#define MULTI_LAUNCH 0
#endif
extern "C" void kernel_launch(void* const* d_in, const int* in_sizes, int n_in, void* d_out, int out_size, void* d_ws, size_t ws_size, hipStream_t stream) {
    static int grid = 0;
    if (grid == 0) {
        if (n_in != N_IN || (size_t)out_size != O_END || ws_size < WS_END) { fprintf(stderr, "kernel_launch: shape mismatch n_in %d out %d ws %zu (need %zu)\n", n_in, out_size, ws_size, (size_t)WS_END); grid = -1; return; }
        int dev = 0, cus = 0, per_cu = 0;
        if (hipGetDevice(&dev) != hipSuccess || hipDeviceGetAttribute(&cus, hipDeviceAttributeMultiprocessorCount, dev) != hipSuccess) { grid = -1; return; }
        if (hipFuncSetAttribute((const void*)fwd, hipFuncAttributeMaxDynamicSharedMemorySize, LDS_BYTES) != hipSuccess) { fprintf(stderr, "kernel_launch: hipFuncSetAttribute failed\n"); grid = -1; return; }
        if (hipOccupancyMaxActiveBlocksPerMultiprocessor(&per_cu, (const void*)fwd, 512, LDS_BYTES) != hipSuccess || per_cu < 1) { fprintf(stderr, "kernel_launch: occupancy query says %d\n", per_cu); (void)hipGetLastError(); }
        grid = cus;
    }
    if (grid < 0) return;
    (void)hipMemsetAsync((char*)d_ws + WS_CTL, 0, CTL_BYTES, stream);
    Params p{};
    for (int i = 0; i < N_IN; ++i) p.in[i] = (const float*)d_in[i];
    p.out = (float*)d_out; p.ws = (unsigned char*)d_ws;
#if MULTI_LAUNCH
    for (int ph = 0; ph < 1 + DBG_NLAYERS * 12; ++ph) { p.ph_lo = ph; p.ph_hi = ph + 1; hipLaunchKernelGGL(fwd, dim3(grid), dim3(512), LDS_BYTES, stream, p); }
#else
    p.ph_lo = 0; p.ph_hi = NPH; hipLaunchKernelGGL(fwd, dim3(grid), dim3(512), LDS_BYTES, stream, p);
#endif
    const hipError_t le = hipPeekAtLastError();
    if (le != hipSuccess) fprintf(stderr, "kernel_launch: launch failed: %s\n", hipGetErrorName(le));
}
```

```cpp
#include <hip/hip_runtime.h>
#include <cstdio>
#include <cstdint>

#ifndef CB_
#define CB_ 16
#endif
#ifndef LB_
#define LB_ 8
#endif
#ifndef DEPTH_
#define DEPTH_ 4
#endif
constexpr int DM = 2048, DEPTH = DEPTH_, CB = CB_, CT = 256, LB = LB_, LT = 1024;
constexpr int MC = CB * CT, ML = LB * LT, M = MC + ML;
constexpr int FF = 5504, NGU = 2 * FF, NIN = 6192, NINP = 6400, NMOD = 9 * DM, NCOND = 1 + LB;
constexpr float EPS = 1e-6f;
constexpr int Z_NAQ = 0, Z_NAK = 512, Z_NAV = 1024, Z_GLQ = 1536, Z_GLK = 1792, Z_GLV = 2048, Z_GLR = 2560, Z_GF = 3072, Z_GB = 3088,
              Z_GQQ = 3104, Z_GQK = 3616, Z_GQV = 3872, Z_DQKV = 4128, Z_DZ = 5664, Z_DB = 6176, Z_DA = 6184;
static_assert(Z_DA + 8 == NIN, "split");
enum { I_XP = 0, I_XS, I_CNAK, I_CNAV, I_CGK, I_CGV, I_SGLA, I_SGDN, I_C, I_CCTX, I_NORMG, I_WMOD, I_BMOD, I_GU, I_DOWN, I_WIN, I_WOUT, I_NAQKN, I_RPB,
       I_GUP, I_GBIAS, I_GLAON, I_GQAQKN, I_CONV, I_ALOG, I_DTB, I_GDNON, N_IN };
constexpr size_t O_YP = 0, O_YS = O_YP + (size_t)MC * DM, O_NAK = O_YS + (size_t)ML * DM, O_NAV = O_NAK + (size_t)CB * DEPTH * 4 * CT * 128,
                 O_GK = O_NAV + (size_t)CB * DEPTH * 4 * CT * 128, O_GV = O_GK + (size_t)CB * DEPTH * 2 * CT * 128,
                 O_SGLA = O_GV + (size_t)CB * DEPTH * 2 * CT * 128, O_SGDN = O_SGLA + (size_t)CB * DEPTH * 2 * 4 * 64 * 128,
                 O_END = O_SGDN + (size_t)CB * DEPTH * 2 * 4 * 128 * 128;
constexpr size_t al256(size_t x) { return (x + 255) & ~(size_t)255; }
constexpr size_t WS_CTL = 0, CTL_BYTES = 1u << 20;
constexpr size_t WS_WGU = CTL_BYTES;
constexpr size_t WS_WDN = WS_WGU + (size_t)DEPTH * 2 * NGU * DM * 2;
constexpr size_t WS_WIN = WS_WDN + (size_t)DEPTH * 2 * DM * FF * 2;
constexpr size_t WS_WOUT = WS_WIN + (size_t)DEPTH * NINP * DM * 2;
constexpr size_t WS_MODV = WS_WOUT + (size_t)DEPTH * DM * DM * 2;
constexpr size_t WS_ROPE = al256(WS_MODV + (size_t)DEPTH * NCOND * NMOD * 4);
constexpr size_t WS_X = al256(WS_ROPE + 2 * 64 * 32 * 4);
constexpr size_t WS_H = WS_X + (size_t)M * DM * 4;
constexpr size_t WS_ACT = WS_H + (size_t)M * DM * 2;
constexpr size_t WS_Z = WS_ACT + (size_t)M * FF * 2;
constexpr size_t WS_MRG = WS_Z + (size_t)M * NINP * 4;
constexpr size_t WS_NAQ = WS_MRG + (size_t)M * DM * 2;
constexpr size_t WS_NAK = WS_NAQ + (size_t)M * 512 * 2;
constexpr size_t WS_NAV = WS_NAK + (size_t)M * 512 * 2;
constexpr size_t WS_GQ = WS_NAV + (size_t)M * 512 * 2;
constexpr size_t WS_GK = WS_GQ + (size_t)M * 512 * 2;
constexpr size_t WS_GV = WS_GK + (size_t)M * 256 * 2;
constexpr size_t WS_CNAK = WS_GV + (size_t)M * 256 * 2;
constexpr size_t WS_CNAV = WS_CNAK + (size_t)LB * DEPTH * 256 * 512 * 2;
constexpr size_t WS_CGK = WS_CNAV + (size_t)LB * DEPTH * 256 * 512 * 2;
constexpr size_t WS_CGV = WS_CGK + (size_t)LB * DEPTH * 256 * 256 * 2;
constexpr size_t WS_AF = WS_CGV + (size_t)LB * DEPTH * 256 * 256 * 2;
constexpr size_t WS_AB = WS_AF + (size_t)M * 256 * 4;
constexpr size_t WS_DQ = WS_AB + (size_t)M * 256 * 4;
constexpr size_t WS_DK = WS_DQ + (size_t)M * 512 * 4;
constexpr size_t WS_DV = WS_DK + (size_t)M * 512 * 4;
constexpr size_t WS_DBA = WS_DV + (size_t)M * 512 * 4;
constexpr size_t WS_GOF = WS_DBA + (size_t)M * 16 * 4;
constexpr size_t WS_GOB = WS_GOF + (size_t)M * 512 * 4;
constexpr size_t WS_DOF = WS_GOB + (size_t)M * 512 * 4;
constexpr size_t WS_DOB = WS_DOF + (size_t)M * 512 * 4;
constexpr size_t WS_END = WS_DOB + (size_t)M * 512 * 4;

typedef unsigned short bf16_t;
struct Params { const float* in[N_IN]; float* out; unsigned char* ws; int ph_lo, ph_hi; };
static_assert(sizeof(Params) == N_IN * 8 + 8 + 8 + 8, "no padding");

#define WSP(T, off) ((T*)(p.ws + (off)))
__device__ __forceinline__ int opaque_tid() { int t = (int)threadIdx.x; asm volatile("" : "+v"(t)); return t; }
__device__ __forceinline__ Params opaque_params(const Params& p) { Params q = p; unsigned long long w = (unsigned long long)q.ws; asm volatile("" : "+s"(w)); q.ws = (unsigned char*)w; return q; }

__device__ __forceinline__ float wave_sum(float v) {
#pragma unroll
    for (int o = 32; o >= 1; o >>= 1) v += __shfl_xor(v, o);
    return v;
}
__device__ __forceinline__ bf16_t f2bf(float f) { unsigned u = __float_as_uint(f); u += 0x7FFFu + ((u >> 16) & 1u); return (bf16_t)(u >> 16); }
__device__ __forceinline__ unsigned pack2(float a, float b) { return (unsigned)f2bf(a) | ((unsigned)f2bf(b) << 16); }
__device__ __forceinline__ float silu_f(float x) { return x / (1.f + expf(-x)); }
__device__ __forceinline__ float softplus_f(float x) { return fmaxf(x, 0.f) + log1pf(expf(-fabsf(x))); }
__device__ __forceinline__ float logsigmoid_f(float x) { return fminf(x, 0.f) - log1pf(expf(-fabsf(x))); }
__device__ __forceinline__ int cond_of_row(int m) { return m < MC ? 0 : 1 + (m - MC) / LT; }
typedef float vf4 __attribute__((ext_vector_type(4)));
__device__ __forceinline__ void conv_tile(const float* __restrict__ src, int ld_src, int ncols_src, int k0, int c0, bf16_t* __restrict__ dst, int ld_dst, int n0, float* tile) {
    const int tid = opaque_tid();
    {
        const int r = tid >> 3, c = (tid & 7) * 8;
        float4 a = make_float4(0.f, 0.f, 0.f, 0.f), b = a;
        if (c0 + c + 8 <= ncols_src) {
            const float* s = src + (size_t)(k0 + r) * ld_src + c0 + c;
            a = *(const float4*)s; b = *(const float4*)(s + 4);
        }
        float* t = tile + r * 65 + c;
        t[0] = a.x; t[1] = a.y; t[2] = a.z; t[3] = a.w; t[4] = b.x; t[5] = b.y; t[6] = b.z; t[7] = b.w;
    }
    __syncthreads();
    {
        const int n = tid >> 3, ks = (tid & 7) * 8;
        const float* t = tile + ks * 65 + n;
        uint4 w;
        w.x = pack2(t[0 * 65], t[1 * 65]); w.y = pack2(t[2 * 65], t[3 * 65]); w.z = pack2(t[4 * 65], t[5 * 65]); w.w = pack2(t[6 * 65], t[7 * 65]);
        *(uint4*)(dst + (size_t)(n0 + n) * ld_dst + k0 + ks) = w;
    }
    __syncthreads();
}

constexpr int MOD_ITEMS = DEPTH * (NMOD / 128);
constexpr int TGU_KT = DM / 64, TGU_NT = NGU / 64, TDN_KT = FF / 64, TDN_NT = DM / 64, TIN_KT = DM / 64, TIN_NT = NINP / 64, TOUT_KT = DM / 64, TOUT_NT = DM / 64;
constexpr int T_GU = DEPTH * 2 * TGU_KT * TGU_NT, T_DN = DEPTH * 2 * TDN_KT * TDN_NT, T_IN = DEPTH * TIN_KT * TIN_NT, T_OUT = DEPTH * TOUT_KT * TOUT_NT;

__device__ __forceinline__ void phase_prologue(const Params& p, float* smem) {
    const int tid = opaque_tid(), nb = gridDim.x, bid = blockIdx.x;
    float* s_cond = smem;
    float* s_red = s_cond + NCOND * DM;
    float* s_tile = s_red + 3 * 128 * NCOND;
    for (int i = tid; i < NCOND * DM; i += 512) { const int ci = i / DM, k = i % DM; const float v = ci == 0 ? p.in[I_CCTX][k] : p.in[I_C][(size_t)(ci - 1) * DM + k]; s_cond[i] = silu_f(v); }
    __syncthreads();
    float* modv = WSP(float, WS_MODV);
    for (int it = bid; it < MOD_ITEMS; it += nb) {
        const int l = it / (NMOD / 128), jt = it % (NMOD / 128);
        const int cl = tid & 127, kq = tid >> 7, col = jt * 128 + cl;
        const float* w = p.in[I_WMOD] + (size_t)l * DM * NMOD + col;
        float acc[NCOND];
#pragma unroll
        for (int ci = 0; ci < NCOND; ++ci) acc[ci] = 0.f;
        for (int k = kq * 512; k < kq * 512 + 512; k += 8) {
            float wv[8];
#pragma unroll
            for (int j = 0; j < 8; ++j) wv[j] = w[(size_t)(k + j) * NMOD];
#pragma unroll
            for (int ci = 0; ci < NCOND; ++ci) {
                const float4 s0 = *(const float4*)&s_cond[ci * DM + k], s1 = *(const float4*)&s_cond[ci * DM + k + 4];
                acc[ci] += s0.x * wv[0] + s0.y * wv[1] + s0.z * wv[2] + s0.w * wv[3] + s1.x * wv[4] + s1.y * wv[5] + s1.z * wv[6] + s1.w * wv[7];
            }
        }
        if (kq > 0) {
#pragma unroll
            for (int ci = 0; ci < NCOND; ++ci) s_red[((kq - 1) * 128 + cl) * NCOND + ci] = acc[ci];
        }
        __syncthreads();
        if (kq == 0) {
            const float bm = p.in[I_BMOD][(size_t)l * NMOD + col];
#pragma unroll
            for (int ci = 0; ci < NCOND; ++ci)
                modv[((size_t)l * NCOND + ci) * NMOD + col] = acc[ci] + s_red[(0 * 128 + cl) * NCOND + ci] + s_red[(1 * 128 + cl) * NCOND + ci] + s_red[(2 * 128 + cl) * NCOND + ci] + bm;
        }
        __syncthreads();
    }
    for (int it = bid; it < T_GU + T_DN + T_IN + T_OUT; it += nb) {
        if (it < T_GU) {
            const int mat = it / (TGU_KT * TGU_NT), r = it % (TGU_KT * TGU_NT), kt = r / TGU_NT, nt = r % TGU_NT;
            const int n0 = nt * 64, t256 = n0 / 256, c = n0 % 256;
            const int c0 = c < 128 ? 128 * t256 + c : FF + 128 * t256 + (c - 128);
            conv_tile(p.in[I_GU] + (size_t)mat * DM * NGU, NGU, NGU, kt * 64, c0, WSP(bf16_t, WS_WGU) + (size_t)mat * NGU * DM, DM, n0, s_tile);
        } else if (it < T_GU + T_DN) {
            const int i2 = it - T_GU, mat = i2 / (TDN_KT * TDN_NT), r = i2 % (TDN_KT * TDN_NT), kt = r / TDN_NT, nt = r % TDN_NT;
            conv_tile(p.in[I_DOWN] + (size_t)mat * FF * DM, DM, DM, kt * 64, nt * 64, WSP(bf16_t, WS_WDN) + (size_t)mat * DM * FF, FF, nt * 64, s_tile);
        } else if (it < T_GU + T_DN + T_IN) {
            const int i2 = it - T_GU - T_DN, mat = i2 / (TIN_KT * TIN_NT), r = i2 % (TIN_KT * TIN_NT), kt = r / TIN_NT, nt = r % TIN_NT;
            conv_tile(p.in[I_WIN] + (size_t)mat * DM * NIN, NIN, NIN, kt * 64, nt * 64, WSP(bf16_t, WS_WIN) + (size_t)mat * NINP * DM, DM, nt * 64, s_tile);
        } else {
            const int i2 = it - T_GU - T_DN - T_IN, mat = i2 / (TOUT_KT * TOUT_NT), r = i2 % (TOUT_KT * TOUT_NT), kt = r / TOUT_NT, nt = r % TOUT_NT;
            conv_tile(p.in[I_WOUT] + (size_t)mat * DM * DM, DM, DM, kt * 64, nt * 64, WSP(bf16_t, WS_WOUT) + (size_t)mat * DM * DM, DM, nt * 64, s_tile);
        }
    }
    const size_t gtid = (size_t)bid * 512 + tid, gstride = (size_t)nb * 512;
    {
        float4* X = WSP(float4, WS_X);
        const float4* xp = (const float4*)p.in[I_XP]; const float4* xs = (const float4*)p.in[I_XS];
        const size_t nc = (size_t)MC * DM / 4, n = (size_t)M * DM / 4;
        for (size_t i = gtid; i < n; i += gstride) X[i] = i < nc ? xp[i] : xs[i - nc];
    }
    {
        const size_t n_na = (size_t)LB * DEPTH * 256 * 512 / 8;
        for (size_t i = gtid; i < 2 * n_na; i += gstride) {
            const bool isv = i >= n_na; const size_t j = isv ? i - n_na : i;
            const int d8 = (int)(j % 16), h = (int)((j / 16) % 4), t = (int)((j / 64) % 256); const size_t bl = j / (64 * 256);
            const float* s = p.in[isv ? I_CNAV : I_CNAK] + ((bl * 4 + h) * 256 + t) * 128 + d8 * 8;
            const float4 a = *(const float4*)s, b = *(const float4*)(s + 4);
            uint4 w; w.x = pack2(a.x, a.y); w.y = pack2(a.z, a.w); w.z = pack2(b.x, b.y); w.w = pack2(b.z, b.w);
            *(uint4*)(WSP(bf16_t, isv ? WS_CNAV : WS_CNAK) + (bl * 256 + t) * 512 + h * 128 + d8 * 8) = w;
        }
        const size_t n_g = (size_t)LB * DEPTH * 256 * 256 / 8;
        for (size_t i = gtid; i < 2 * n_g; i += gstride) {
            const bool isv = i >= n_g; const size_t j = isv ? i - n_g : i;
            const int d8 = (int)(j % 16), h = (int)((j / 16) % 2), t = (int)((j / 32) % 256); const size_t bl = j / (32 * 256);
            const float* s = p.in[isv ? I_CGV : I_CGK] + ((bl * 2 + h) * 256 + t) * 128 + d8 * 8;
            const float4 a = *(const float4*)s, b = *(const float4*)(s + 4);
            uint4 w; w.x = pack2(a.x, a.y); w.y = pack2(a.z, a.w); w.z = pack2(b.x, b.y); w.w = pack2(b.z, b.w);
            *(uint4*)(WSP(bf16_t, isv ? WS_CGV : WS_CGK) + (bl * 256 + t) * 256 + h * 128 + d8 * 8) = w;
        }
    }
    for (size_t i = gtid; i < 64 * 32; i += gstride) {
        const int pos = (int)(i / 32), k = (int)(i % 32);
        const float inv = powf(10000.0f, -(float)(2 * k) / 64.0f);
        const float ang = (float)pos * inv;
        WSP(float, WS_ROPE)[i] = cosf(ang); WSP(float, WS_ROPE)[64 * 32 + i] = sinf(ang);
    }
}

__device__ __forceinline__ void phase_norm(const Params& p, int l, int which  ) {
    const int tid = opaque_tid(), lane = tid & 63, wv = tid >> 6;
    const float* X = WSP(float, WS_X); bf16_t* H = WSP(bf16_t, WS_H);
    const float* g = p.in[I_NORMG] + ((size_t)l * 3 + which) * DM;
    for (int m = blockIdx.x * 8 + wv; m < M; m += gridDim.x * 8) {
        const int ci = cond_of_row(m);
        const float* mv = WSP(float, WS_MODV) + ((size_t)l * NCOND + ci) * NMOD + (size_t)which * 3 * DM;
        const float* x = X + (size_t)m * DM;
        vf4 v[8]; float ss = 0.f;
#pragma unroll
        for (int i = 0; i < 8; ++i) { v[i] = *(const vf4*)(x + (i * 64 + lane) * 4); ss += v[i].x * v[i].x + v[i].y * v[i].y + v[i].z * v[i].z + v[i].w * v[i].w; }
        ss = wave_sum(ss);
        const float r = 1.0f / sqrtf(ss * (1.0f / DM) + EPS);
#pragma unroll
        for (int i = 0; i < 8; ++i) {
            const int c = (i * 64 + lane) * 4;
            const float4 gg = *(const float4*)(g + c), sh = *(const float4*)(mv + c), sc = *(const float4*)(mv + DM + c);
            const float o0 = v[i].x * r * gg.x * (1.f + sc.x) + sh.x, o1 = v[i].y * r * gg.y * (1.f + sc.y) + sh.y;
            const float o2 = v[i].z * r * gg.z * (1.f + sc.z) + sh.z, o3 = v[i].w * r * gg.w * (1.f + sc.w) + sh.w;
            uint2 w; w.x = pack2(o0, o1); w.y = pack2(o2, o3);
            *(uint2*)(H + (size_t)m * DM + c) = w;
        }
    }
}

#define PREP_FENCE() asm volatile("" ::: "memory")
__device__ __forceinline__ void phase_prep(const Params& p, int l) {
    const int tid = opaque_tid(), lane = tid & 63, wv = tid >> 6;
    const float* Z = WSP(float, WS_Z);
    const float* ropec = WSP(float, WS_ROPE); const float* ropes = ropec + 64 * 32;
    for (int m = blockIdx.x * 8 + wv; m < M; m += gridDim.x * 8) {
        const float* z = Z + (size_t)m * NINP;
        const bool ctx = m < MC;
        const int b = ctx ? m / CT : (m - MC) / LT, t = ctx ? m % CT : (m - MC) % LT, T = ctx ? CT : LT;
        {
            const float* wq = p.in[I_NAQKN] + ((size_t)l * 2 + 0) * 128; const float* wk = wq + 128;
#pragma unroll 1
            for (int h = 0; h < 4; ++h) {
                float a = z[Z_NAQ + h * 128 + lane], c = z[Z_NAQ + h * 128 + 64 + lane];
                float r = 1.0f / sqrtf(wave_sum(a * a + c * c) * (1.0f / 128) + EPS);
                bf16_t* q = WSP(bf16_t, WS_NAQ) + (size_t)m * 512 + h * 128;
                q[lane] = f2bf(a * r * wq[lane]); q[64 + lane] = f2bf(c * r * wq[64 + lane]);
                a = z[Z_NAK + h * 128 + lane]; c = z[Z_NAK + h * 128 + 64 + lane];
                r = 1.0f / sqrtf(wave_sum(a * a + c * c) * (1.0f / 128) + EPS);
                const float k0 = a * r * wk[lane], k1 = c * r * wk[64 + lane];
                bf16_t* k = WSP(bf16_t, WS_NAK) + (size_t)m * 512 + h * 128;
                k[lane] = f2bf(k0); k[64 + lane] = f2bf(k1);
                const float v0 = z[Z_NAV + h * 128 + lane], v1 = z[Z_NAV + h * 128 + 64 + lane];
                bf16_t* v = WSP(bf16_t, WS_NAV) + (size_t)m * 512 + h * 128;
                v[lane] = f2bf(v0); v[64 + lane] = f2bf(v1);
                if (ctx) {
                    const size_t o = ((((size_t)b * DEPTH + l) * 4 + h) * CT + t) * 128;
                    p.out[O_NAK + o + lane] = k0; p.out[O_NAK + o + 64 + lane] = k1;
                    p.out[O_NAV + o + lane] = v0; p.out[O_NAV + o + 64 + lane] = v1;
                }
            }
        }
        PREP_FENCE();
        {
            const float* wq = p.in[I_GQAQKN] + ((size_t)l * 2 + 0) * 128; const float* wk = wq + 128;
            const int grow = t >> 6, gcol = t & 63, i32 = lane & 31;
            const float cr = ropec[grow * 32 + i32], sr = ropes[grow * 32 + i32], cc = ropec[gcol * 32 + i32], sc = ropes[gcol * 32 + i32];
#pragma unroll 1
            for (int h = 0; h < 6; ++h) {
                const int zo = h < 4 ? Z_GQQ + h * 128 : Z_GQK + (h - 4) * 128;
                float a = z[zo + lane], c = z[zo + 64 + lane];
                const float r = 1.0f / sqrtf(wave_sum(a * a + c * c) * (1.0f / 128) + EPS);
                const float* w = h < 4 ? wq : wk;
                a = a * r * w[lane]; c = c * r * w[64 + lane];
                if (!ctx) {
                    const float pa = __shfl_xor(a, 32), pc = __shfl_xor(c, 32);
                    a = lane < 32 ? a * cr - pa * sr : pa * sr + a * cr;
                    c = lane < 32 ? c * cc - pc * sc : pc * sc + c * cc;
                }
                if (h < 4) { bf16_t* q = WSP(bf16_t, WS_GQ) + (size_t)m * 512 + h * 128; q[lane] = f2bf(a); q[64 + lane] = f2bf(c); }
                else {
                    bf16_t* k = WSP(bf16_t, WS_GK) + (size_t)m * 256 + (h - 4) * 128; k[lane] = f2bf(a); k[64 + lane] = f2bf(c);
                    const float v0 = z[Z_GQV + (h - 4) * 128 + lane], v1 = z[Z_GQV + (h - 4) * 128 + 64 + lane];
                    bf16_t* v = WSP(bf16_t, WS_GV) + (size_t)m * 256 + (h - 4) * 128; v[lane] = f2bf(v0); v[64 + lane] = f2bf(v1);
                    if (ctx) {
                        const size_t o = ((((size_t)b * DEPTH + l) * 2 + (h - 4)) * CT + t) * 128;
                        p.out[O_GK + o + lane] = a; p.out[O_GK + o + 64 + lane] = c;
                        p.out[O_GV + o + lane] = v0; p.out[O_GV + o + 64 + lane] = v1;
                    }
                }
            }
        }
        PREP_FENCE();
        {
#pragma unroll 1
            for (int dir = 0; dir < 2; ++dir) {
                const float* up = p.in[I_GUP] + ((size_t)l * 2 + dir) * 16 * 256;
                const float* bias = p.in[I_GBIAS] + ((size_t)l * 2 + dir) * 256;
                const float gmine = z[(dir ? Z_GB : Z_GF) + (lane & 15)];
                float gsum[4];
#pragma unroll
                for (int i = 0; i < 4; ++i) gsum[i] = bias[lane + 64 * i];
#pragma unroll
                for (int r = 0; r < 16; ++r) {
                    const float gv = __shfl(gmine, r);
#pragma unroll
                    for (int i = 0; i < 4; ++i) gsum[i] += gv * up[r * 256 + lane + 64 * i];
                }
                float* A = WSP(float, dir ? WS_AB : WS_AF) + (size_t)m * 256;
#pragma unroll
                for (int i = 0; i < 4; ++i) A[lane + 64 * i] = expf(logsigmoid_f(gsum[i]) * (1.0f / 16.0f));
                PREP_FENCE();
            }
        }
        {
            const float* cw = p.in[I_CONV] + (size_t)l * 5 * 1536;
#pragma unroll 1
            for (int part = 0; part < 3; ++part) {
                float val[8];
#pragma unroll
                for (int i = 0; i < 8; ++i) val[i] = 0.f;
#pragma unroll 1
                for (int j = 0; j < 5; ++j) {
                    const int tt = t + j - 2;
                    if (tt >= 0 && tt < T) {
                        const float* zz = Z + (size_t)(m + j - 2) * NINP + Z_DQKV + part * 512;
                        const float* cj = cw + j * 1536 + part * 512;
#pragma unroll
                        for (int i = 0; i < 8; ++i) val[i] += cj[lane + 64 * i] * zz[lane + 64 * i];
                    }
                }
#pragma unroll
                for (int i = 0; i < 8; ++i) val[i] = silu_f(val[i]);
                float* dst = WSP(float, part == 0 ? WS_DQ : part == 1 ? WS_DK : WS_DV) + (size_t)m * 512;
#pragma unroll
                for (int h = 0; h < 4; ++h) {
                    float r = 1.0f;
                    if (part < 2) r = 1.0f / sqrtf(wave_sum(val[2 * h] * val[2 * h] + val[2 * h + 1] * val[2 * h + 1]) + EPS) * (part == 0 ? 0.08838834764831845f : 1.0f);
                    dst[h * 128 + lane] = val[2 * h] * r; dst[h * 128 + 64 + lane] = val[2 * h + 1] * r;
                }
                PREP_FENCE();
            }
            if (lane < 8) {
                const float beta = 1.0f / (1.0f + expf(-z[Z_DB + lane]));
                const float g = -expf(p.in[I_ALOG][(size_t)l * 8 + lane]) * softplus_f(z[Z_DA + lane] + p.in[I_DTB][(size_t)l * 8 + lane]);
                float* ba = WSP(float, WS_DBA) + (size_t)m * 16;
                ba[lane] = beta; ba[8 + lane] = expf(g);
            }
        }
        PREP_FENCE();
    }
}

typedef float vf2 __attribute__((ext_vector_type(2)));
__device__ __forceinline__ float dpp_f(float v, const int ctrl) { return v; }
#define DPPF(v, ctrl) __int_as_float(__builtin_amdgcn_mov_dpp(__float_as_int(v), (ctrl), 0xF, 0xF, true))
__device__ __forceinline__ float red8(float v) { v += DPPF(v, 0xB1); v += DPPF(v, 0x4E); v += DPPF(v, 0x141); return v; }
__device__ __forceinline__ float red16(float v) { v = red8(v); v += DPPF(v, 0x140); return v; }

__device__ __forceinline__ void gla_chain(const Params& p, int l, bool ctx, int b, int h, int dir, int es, float* smem) {
    constexpr int TC = 32;
    const int tid = opaque_tid(), el = tid >> 3, dg = tid & 7;
    const int T = ctx ? CT : LT; const size_t m0 = ctx ? (size_t)b * CT : (size_t)MC + (size_t)b * LT;
    const float* Z = WSP(float, WS_Z); const float* A = WSP(float, dir ? WS_AB : WS_AF);
    float* O = WSP(float, dir ? WS_GOB : WS_GOF);
    float* sq = smem; float* sk = sq + TC * 64; float* sa = sk + TC * 64; float* sv = sa + TC * 64; float* so = sv + TC * 64;
    vf2 S[4];
    {
        const int e = es * 64 + el;
        if (ctx) {
#pragma unroll
            for (int i = 0; i < 4; ++i) S[i] = (vf2){0.f, 0.f};
        } else {
            const float* s0 = p.in[I_SGLA] + (((((size_t)b * DEPTH + l) * 2 + dir) * 4 + h) * 64 + dg * 8) * 128 + e;
#pragma unroll
            for (int i = 0; i < 4; ++i) S[i] = (vf2){s0[(size_t)(2 * i) * 128], s0[(size_t)(2 * i + 1) * 128]};
        }
    }
    vf4 pre[4];
    const int nch = T / TC;
    const int ls = tid >> 4, lc = (tid & 15) * 4;
#define GLA_LOAD(c) do { const int ti = (c) * TC + ls, tt = dir ? T - 1 - ti : ti; const size_t m = m0 + tt; \
        pre[0] = *(const vf4*)(Z + m * NINP + Z_GLQ + h * 64 + lc); pre[1] = *(const vf4*)(Z + m * NINP + Z_GLK + h * 64 + lc); \
        pre[2] = *(const vf4*)(A + m * 256 + h * 64 + lc);           pre[3] = *(const vf4*)(Z + m * NINP + Z_GLV + h * 128 + es * 64 + lc); } while (0)
#define GLA_WRITE() do { *(vf4*)(sq + ls * 64 + lc) = pre[0] * 0.125f; *(vf4*)(sk + ls * 64 + lc) = pre[1]; *(vf4*)(sa + ls * 64 + lc) = pre[2]; *(vf4*)(sv + ls * 64 + lc) = pre[3]; } while (0)
    __syncthreads();
    GLA_LOAD(0); GLA_WRITE(); __syncthreads();
    for (int c = 0; c < nch; ++c) {
        if (c + 1 < nch) GLA_LOAD(c + 1);
        vf4 q0 = *(const vf4*)(sq + dg * 8), q1 = *(const vf4*)(sq + dg * 8 + 4), k0 = *(const vf4*)(sk + dg * 8), k1 = *(const vf4*)(sk + dg * 8 + 4);
        vf4 a0 = *(const vf4*)(sa + dg * 8), a1 = *(const vf4*)(sa + dg * 8 + 4); float ve = sv[el];
#pragma unroll 2
        for (int s = 0; s < TC; ++s) {
            const int sn = (s + 1) & (TC - 1);
            const vf4 nq0 = *(const vf4*)(sq + sn * 64 + dg * 8), nq1 = *(const vf4*)(sq + sn * 64 + dg * 8 + 4), nk0 = *(const vf4*)(sk + sn * 64 + dg * 8), nk1 = *(const vf4*)(sk + sn * 64 + dg * 8 + 4);
            const vf4 na0 = *(const vf4*)(sa + sn * 64 + dg * 8), na1 = *(const vf4*)(sa + sn * 64 + dg * 8 + 4); const float nve = sv[sn * 64 + el];
            const vf2 v2 = (vf2){ve, ve};
            S[0] = a0.xy * S[0] + k0.xy * v2; S[1] = a0.zw * S[1] + k0.zw * v2; S[2] = a1.xy * S[2] + k1.xy * v2; S[3] = a1.zw * S[3] + k1.zw * v2;
            vf2 acc0 = q0.xy * S[0], acc1 = q0.zw * S[1]; acc0 += q1.xy * S[2]; acc1 += q1.zw * S[3];
            acc0 += acc1;
            const float po = red8(acc0.x + acc0.y);
            if (dg == 0) so[s * 64 + el] = po;
            q0 = nq0; q1 = nq1; k0 = nk0; k1 = nk1; a0 = na0; a1 = na1; ve = nve;
        }
        __syncthreads();
        { const int ti = c * TC + ls, tt = dir ? T - 1 - ti : ti; *(vf4*)(O + (m0 + tt) * 512 + h * 128 + es * 64 + lc) = *(const vf4*)(so + ls * 64 + lc); }
        if (c + 1 < nch) GLA_WRITE();
        __syncthreads();
    }
#undef GLA_LOAD
#undef GLA_WRITE
    if (ctx) {
        float* so_ = p.out + O_SGLA + (((((size_t)b * DEPTH + l) * 2 + dir) * 4 + h) * 64 + dg * 8) * 128 + es * 64 + el;
#pragma unroll
        for (int i = 0; i < 4; ++i) { so_[(size_t)(2 * i) * 128] = S[i].x; so_[(size_t)(2 * i + 1) * 128] = S[i].y; }
    }
}

__device__ __forceinline__ void gdn_chain(const Params& p, int l, bool ctx, int b, int h, int dir, int es, float* smem) {
    constexpr int TC = 32;
    const int tid = opaque_tid(), el = tid >> 3, dg = tid & 7;
    const int T = ctx ? CT : LT; const size_t m0 = ctx ? (size_t)b * CT : (size_t)MC + (size_t)b * LT;
    const float* DQ = WSP(float, WS_DQ); const float* DK = WSP(float, WS_DK); const float* DV = WSP(float, WS_DV); const float* DBA = WSP(float, WS_DBA);
    float* O = WSP(float, dir ? WS_DOB : WS_DOF);
    float* sq = smem; float* sk = sq + TC * 128; float* sv = sk + TC * 128; float* so = sv + TC * 64; float* sba = so + TC * 64; float* sqk = sba + TC * 2;
    vf2 S[8];
    {
        const int e = es * 64 + el;
        if (ctx) {
#pragma unroll
            for (int i = 0; i < 8; ++i) S[i] = (vf2){0.f, 0.f};
        } else {
            const float* s0 = p.in[I_SGDN] + (((((size_t)b * DEPTH + l) * 2 + dir) * 4 + h) * 128 + dg * 16) * 128 + e;
#pragma unroll
            for (int i = 0; i < 8; ++i) S[i] = (vf2){s0[(size_t)(2 * i) * 128], s0[(size_t)(2 * i + 1) * 128]};
        }
    }
    vf4 pre[5]; float pre_s = 0.f;
    const int nch = T / TC;
    const int ls = tid >> 5, lc = (tid & 31) * 4, vs = tid >> 4, vc = (tid & 15) * 4;
#define TOK(c, s_) (m0 + (dir ? T - 1 - ((c) * TC + (s_)) : (c) * TC + (s_)))
#define GDN_LOAD(c) do { const size_t ma = TOK(c, ls), mb = TOK(c, ls + 16), mv = TOK(c, vs); \
        pre[0] = *(const vf4*)(DQ + ma * 512 + h * 128 + lc); pre[1] = *(const vf4*)(DQ + mb * 512 + h * 128 + lc); \
        pre[2] = *(const vf4*)(DK + ma * 512 + h * 128 + lc); pre[3] = *(const vf4*)(DK + mb * 512 + h * 128 + lc); \
        pre[4] = *(const vf4*)(DV + mv * 512 + h * 128 + es * 64 + vc); \
        if (tid < 2 * TC) pre_s = DBA[TOK(c, tid >> 1) * 16 + (tid & 1) * 8 + dir * 4 + h]; } while (0)
#define GDN_WRITE() do { *(vf4*)(sq + ls * 128 + lc) = pre[0]; *(vf4*)(sq + (ls + 16) * 128 + lc) = pre[1]; *(vf4*)(sk + ls * 128 + lc) = pre[2]; *(vf4*)(sk + (ls + 16) * 128 + lc) = pre[3]; \
        *(vf4*)(sv + vs * 64 + vc) = pre[4]; if (tid < 2 * TC) sba[tid] = pre_s; } while (0)
    __syncthreads();
    GDN_LOAD(0); GDN_WRITE(); __syncthreads();
    for (int c = 0; c < nch; ++c) {
        if (c + 1 < nch) GDN_LOAD(c + 1);
        {
            const int s = tid >> 4, part = tid & 15;
            const vf4 x0 = *(const vf4*)(sq + s * 128 + part * 8), x1 = *(const vf4*)(sq + s * 128 + part * 8 + 4), y0 = *(const vf4*)(sk + s * 128 + part * 8), y1 = *(const vf4*)(sk + s * 128 + part * 8 + 4);
            const vf4 pr = x0 * y0 + x1 * y1;
            const float d = red16((pr.x + pr.y) + (pr.z + pr.w));
            if (part == 0) sqk[s] = d;
        }
        __syncthreads();
        vf4 kk[4], qq[4]; float ve, be, a, qk;
#pragma unroll
        for (int i = 0; i < 4; ++i) { kk[i] = *(const vf4*)(sk + dg * 16 + 4 * i); qq[i] = *(const vf4*)(sq + dg * 16 + 4 * i); }
        ve = sv[el]; be = sba[0]; a = sba[1]; qk = sqk[0];
#pragma unroll 2
        for (int s = 0; s < TC; ++s) {
            const int sn = (s + 1) & (TC - 1);
            vf4 nk[4], nq[4];
#pragma unroll
            for (int i = 0; i < 4; ++i) { nk[i] = *(const vf4*)(sk + sn * 128 + dg * 16 + 4 * i); nq[i] = *(const vf4*)(sq + sn * 128 + dg * 16 + 4 * i); }
            const float nve = sv[sn * 64 + el], nbe = sba[2 * sn], na = sba[2 * sn + 1], nqk = sqk[sn];
            vf2 ak0 = kk[0].xy * S[0], ak1 = kk[0].zw * S[1], aq0 = qq[0].xy * S[0], aq1 = qq[0].zw * S[1];
#pragma unroll
            for (int i = 1; i < 4; ++i) { ak0 += kk[i].xy * S[2 * i]; ak1 += kk[i].zw * S[2 * i + 1]; aq0 += qq[i].xy * S[2 * i]; aq1 += qq[i].zw * S[2 * i + 1]; }
            ak0 += ak1; aq0 += aq1;
            const float uk = red8(ak0.x + ak0.y), uq = red8(aq0.x + aq0.y);
            const float vn = be * (ve - a * uk);
            const float po = a * uq + qk * vn;
            const vf2 a2 = (vf2){a, a}, vn2 = (vf2){vn, vn};
#pragma unroll
            for (int i = 0; i < 4; ++i) { S[2 * i] = a2 * S[2 * i] + kk[i].xy * vn2; S[2 * i + 1] = a2 * S[2 * i + 1] + kk[i].zw * vn2; }
            if (dg == 0) so[s * 64 + el] = po;
#pragma unroll
            for (int i = 0; i < 4; ++i) { kk[i] = nk[i]; qq[i] = nq[i]; }
            ve = nve; be = nbe; a = na; qk = nqk;
        }
        __syncthreads();
        *(vf4*)(O + TOK(c, vs) * 512 + h * 128 + es * 64 + vc) = *(const vf4*)(so + vs * 64 + vc);
        if (c + 1 < nch) GDN_WRITE();
        __syncthreads();
    }
#undef GDN_LOAD
#undef GDN_WRITE
#undef TOK
    if (ctx) {
        float* so_ = p.out + O_SGDN + (((((size_t)b * DEPTH + l) * 2 + dir) * 4 + h) * 128 + dg * 16) * 128 + es * 64 + el;
#pragma unroll
        for (int i = 0; i < 8; ++i) { so_[(size_t)(2 * i) * 128] = S[i].x; so_[(size_t)(2 * i + 1) * 128] = S[i].y; }
    }
}

__device__ __forceinline__ void phase_post(const Params& p, int l) {
    const int tid = opaque_tid(), lane = tid & 63, wv = tid >> 6;
    const float* Z = WSP(float, WS_Z); bf16_t* MRG = WSP(bf16_t, WS_MRG);
    const float* wg = p.in[I_GLAON] + (size_t)l * 128; const float* wd = p.in[I_GDNON] + (size_t)l * 128;
    for (int m = blockIdx.x * 8 + wv; m < M; m += gridDim.x * 8) {
        const float* z = Z + (size_t)m * NINP;
#pragma unroll
        for (int g = 0; g < 2; ++g) {
            const float* of = WSP(float, g ? WS_DOF : WS_GOF) + (size_t)m * 512; const float* ob = WSP(float, g ? WS_DOB : WS_GOB) + (size_t)m * 512;
            const float* w = g ? wd : wg; const int zg = g ? Z_DZ : Z_GLR, mc = g ? 1536 : 512;
#pragma unroll
            for (int h = 0; h < 4; ++h) {
                const float a = of[h * 128 + lane] + ob[h * 128 + lane], c = of[h * 128 + 64 + lane] + ob[h * 128 + 64 + lane];
                const float r = 1.0f / sqrtf(wave_sum(a * a + c * c) * (1.0f / 128) + EPS);
                bf16_t* o = MRG + (size_t)m * DM + mc + h * 128;
                o[lane] = f2bf(a * r * w[lane] * silu_f(z[zg + h * 128 + lane]));
                o[64 + lane] = f2bf(c * r * w[64 + lane] * silu_f(z[zg + h * 128 + 64 + lane]));
            }
        }
    }
}
#define XB_TMO      128
#define XB_XCNT(j)  (256  + 64 * (j))
#define XB_XSUB(j)  (1280 + 64 * (j))
#define XB_XGEN(j)  (2304 + 64 * (j))
#define XB_TOP      3328
#define XB_TOPGEN   3392
#define XCD_BAR_WORDS 3456
#define XB_SPIN_CAP (1u << 22)
#define LAS __attribute__((address_space(3)))

__device__ __forceinline__ unsigned xb_ld(unsigned* p)              { return __hip_atomic_load(p, __ATOMIC_RELAXED, __HIP_MEMORY_SCOPE_AGENT); }
__device__ __forceinline__ unsigned xb_add(unsigned* p, unsigned v) { return __hip_atomic_fetch_add(p, v, __ATOMIC_RELAXED, __HIP_MEMORY_SCOPE_AGENT); }
__device__ __forceinline__ unsigned xb_xcc_id() { return (unsigned)__builtin_amdgcn_s_getreg((3 << 11) | 20) & 0xFu; }
#define XB_SPIN(cond, bar) do { unsigned _sp = 0; while (cond) { __builtin_amdgcn_s_sleep(1); \
    if ((++_sp & 255u) == 0u) { if (xb_ld(&(bar)[XB_TMO])) break; if (_sp > XB_SPIN_CAP) { atomicAdd(&(bar)[XB_TMO], 1u); break; } } } } while (0)

struct XcdBarrier {
    unsigned* bar; unsigned x;
    volatile LAS unsigned* st;
};

__device__ __forceinline__ XcdBarrier xcd_barrier_post(unsigned* bar, volatile LAS unsigned* st) {
    XcdBarrier b; b.bar = bar; b.x = xb_xcc_id(); b.st = st;
    if (threadIdx.x == 0) (void)xb_add(&bar[XB_XCNT(b.x)], 1u);
    return b;
}
__device__ __forceinline__ void xcd_barrier_complete(unsigned* bar, unsigned x, unsigned& nloc, unsigned& nx) {
    const unsigned G = gridDim.x * gridDim.y * gridDim.z;
    unsigned sum, cnt, mine, sp = 0u;
    for (;;) {
        sum = 0u; cnt = 0u; mine = 0u;
#pragma unroll
        for (unsigned j = 0; j < 16; ++j) { const unsigned c = xb_ld(&bar[XB_XCNT(j)]); sum += c; cnt += (c > 0u) ? 1u : 0u; mine = (j == x) ? c : mine; }
        if (sum == G) break;
        __builtin_amdgcn_s_sleep(1);
        if ((++sp & 255u) == 0u) { if (xb_ld(&bar[XB_TMO])) break; if (sp > XB_SPIN_CAP) { atomicAdd(&bar[XB_TMO], 1u); break; } }
    }
    nloc = mine > 0u ? mine : 1u; nx = cnt > 0u ? cnt : 1u;
}

__device__ __forceinline__ void xcd_barrier(const XcdBarrier& b) {
    asm volatile("s_waitcnt vmcnt(0)" ::: "memory");
    __syncthreads();
    if (threadIdx.x == 0) {
        unsigned* bar = b.bar;
        __builtin_amdgcn_s_waitcnt(0);
        unsigned nloc = b.st[0], nx = b.st[1];
        if (nloc == 0u) { xcd_barrier_complete(bar, b.x, nloc, nx); b.st[0] = nloc; b.st[1] = nx; }
        const unsigned old = xb_add(&bar[XB_XSUB(b.x)], 1u);
        const unsigned gen = old / nloc;
        if (old + 1u == (gen + 1u) * nloc) {
            __builtin_amdgcn_fence(__ATOMIC_RELEASE, "agent");
            asm volatile("s_waitcnt vmcnt(0)" ::: "memory");
            const unsigned og = xb_add(&bar[XB_TOP], 1u);
            const unsigned tg = og / nx;
            if (og + 1u == (tg + 1u) * nx) xb_add(&bar[XB_TOPGEN], 1u);
            else XB_SPIN(xb_ld(&bar[XB_TOPGEN]) == tg, bar);
            __builtin_amdgcn_fence(__ATOMIC_ACQUIRE, "agent");
            xb_add(&bar[XB_XGEN(b.x)], 1u);
            asm volatile("s_waitcnt vmcnt(0)" ::: "memory");
        } else {
            XB_SPIN(xb_ld(&bar[XB_XGEN(b.x)]) == gen, bar);
            __builtin_amdgcn_fence(__ATOMIC_ACQUIRE, "agent");
            asm volatile("s_waitcnt vmcnt(0)" ::: "memory");
        }
    }
    __syncthreads();
}

namespace pg8 {
#define PG8_LAS __attribute__((address_space(3)))
typedef unsigned short bf16_t;
typedef short bf16x8 __attribute__((ext_vector_type(8)));
typedef float f32x4 __attribute__((ext_vector_type(4)));
typedef unsigned u32x4 __attribute__((ext_vector_type(4)));
constexpr int BM = 256, BK = 64, HALF = 128, HTB = HALF * BK * 2  , STAGE_BYTES = 8 * HTB, NXCD = 8, WGM = 8;

__host__ __device__ __forceinline__ int lds_byte(int r, int c) { const int st = (r >> 4) * 2 + (c >> 5), rr = r & 15, cc = c & 31, ob = rr * 64 + cc * 2; return st * 1024 + (ob ^ (((ob >> 9) & 1) << 5)); }
__host__ __device__ __forceinline__ void stage_rc(int b, int& R, int& C) { const int st = b / 1024, sb = b % 1024, swz = sb ^ (((sb >> 9) & 1) << 5); R = (st >> 1) * 16 + swz / 64; C = (st & 1) * 32 + (swz % 64) / 2; }
__host__ __device__ __forceinline__ int perm32(int rho) { const int n = rho >> 4, i = rho & 15; return 8 * (i >> 2) + 4 * n + (i & 3); }

struct Unit { int pm, pn; };
struct Gemm { const bf16_t* A; const bf16_t* Bt; int M, N, K; };

struct StaticOrder {
    int nM, nN, nwg, G, c;
    __host__ __device__ void init(int M, int N, int G_, int c_) { nM = M / BM; nN = N / BM; nwg = nM * nN; G = G_; c = c_; }
    __host__ __device__ bool next(int i, Unit& u) const {
        const long L = (long)i * G + c; if (L >= nwg) return false;
        int wgid = (int)L; { const int q = nwg / NXCD, r = nwg % NXCD, xcd = wgid % NXCD, off = wgid / NXCD; wgid = (xcd < r ? xcd * (q + 1) : r * (q + 1) + (xcd - r) * q) + off; }
        const int nig = WGM * nN, gid = wgid / nig, fm = gid * WGM, gsz = (nM - fm) < WGM ? (nM - fm) : WGM;
        u.pm = fm + ((wgid % nig) % gsz); u.pn = (wgid % nig) / gsz; return true;
    }
    __device__ __forceinline__ void a_ready(const Unit&) const {}
    __device__ __forceinline__ void done(const Unit&) const {}
};
__device__ __forceinline__ unsigned cvt_pk_bf16(float lo, float hi) { unsigned r; asm volatile("v_cvt_pk_bf16_f32 %0, %1, %2" : "=v"(r) : "v"(lo), "v"(hi)); return r; }
struct EpiF32 {
    static constexpr bool PERM = false, AFTER_DRAIN = false;
    float* C; int ldc; const float* bias;
    __device__ __forceinline__ void operator()(const f32x4 (&acc)[2][2][4][2], const Unit& u, int wr, int wc, int fr, int fq) const {
        const int row0 = u.pm * BM + wr * 64 + fr, col0 = u.pn * BM + wc * 32 + 4 * fq;
        f32x4 bv[2][2];
#pragma unroll
        for (int bj = 0; bj < 2; ++bj)
#pragma unroll
            for (int n = 0; n < 2; ++n) bv[bj][n] = bias ? *(const f32x4*)(bias + col0 + bj * HALF + n * 16) : (f32x4){0.f, 0.f, 0.f, 0.f};
#pragma unroll
        for (int ai = 0; ai < 2; ++ai)
#pragma unroll
            for (int m = 0; m < 4; ++m) { float* rowp = C + (size_t)(row0 + ai * HALF + m * 16) * ldc + col0;
#pragma unroll
                for (int bj = 0; bj < 2; ++bj)
#pragma unroll
                    for (int n = 0; n < 2; ++n) *(f32x4*)(rowp + bj * HALF + n * 16) = acc[ai][bj][m][n] + bv[bj][n]; }
    }
};

struct EpiSwiGLU {
    static constexpr bool PERM = true, AFTER_DRAIN = false;
    bf16_t* O; int ldc;
    __device__ __forceinline__ void operator()(const f32x4 (&acc)[2][2][4][2], const Unit& u, int wr, int wc, int fr, int fq) const {
        const int row0 = u.pm * BM + wr * 64 + fr, col0 = u.pn * 128 + wc * 32 + 8 * fq;
#pragma unroll
        for (int ai = 0; ai < 2; ++ai)
#pragma unroll
            for (int m = 0; m < 4; ++m) { bf16_t* rowp = O + (size_t)(row0 + ai * HALF + m * 16) * ldc + col0;
                const f32x4 g0 = acc[ai][0][m][0], g1 = acc[ai][0][m][1], u0 = acc[ai][1][m][0], u1 = acc[ai][1][m][1];
                float r[8];
#pragma unroll
                for (int j = 0; j < 4; ++j) {
                    r[j]     = g0[j] * __builtin_amdgcn_rcpf(1.0f + __builtin_amdgcn_exp2f(-1.4426950408889634f * g0[j])) * u0[j];
                    r[4 + j] = g1[j] * __builtin_amdgcn_rcpf(1.0f + __builtin_amdgcn_exp2f(-1.4426950408889634f * g1[j])) * u1[j]; }
                u32x4 w; w.x = cvt_pk_bf16(r[0], r[1]); w.y = cvt_pk_bf16(r[2], r[3]); w.z = cvt_pk_bf16(r[4], r[5]); w.w = cvt_pk_bf16(r[6], r[7]);
                *(u32x4*)rowp = w; }
    }
};
struct EpiResid {
    static constexpr bool PERM = false, AFTER_DRAIN = false;
    const float* res; float* out; int ldc; const float* gate0; float coef;
    __device__ __forceinline__ void operator()(const f32x4 (&acc)[2][2][4][2], const Unit& u, int wr, int wc, int fr, int fq) const {
        const int row0 = u.pm * BM + wr * 64 + fr, col0 = u.pn * BM + wc * 32 + 4 * fq;
        const float* gate = gate0 + (size_t)cond_of_row(u.pm * BM) * NMOD;
        f32x4 gv[2][2];
#pragma unroll
        for (int bj = 0; bj < 2; ++bj)
#pragma unroll
            for (int n = 0; n < 2; ++n) gv[bj][n] = *(const f32x4*)(gate + col0 + bj * HALF + n * 16) * coef;
#pragma unroll
        for (int ai = 0; ai < 2; ++ai)
#pragma unroll
            for (int m = 0; m < 4; ++m) { const size_t off = (size_t)(row0 + ai * HALF + m * 16) * ldc + col0;
#pragma unroll
                for (int bj = 0; bj < 2; ++bj)
#pragma unroll
                    for (int n = 0; n < 2; ++n) { const f32x4 bs = *(const f32x4*)(res + off + bj * HALF + n * 16); *(f32x4*)(out + off + bj * HALF + n * 16) = bs + gv[bj][n] * acc[ai][bj][m][n]; }
                asm volatile("" ::: "memory"); }
    }
};
template <class Epi, class Sched, bool STAMP = false>
__device__ __forceinline__ void gemm_phase(PG8_LAS unsigned char* lds, const Gemm g, const Sched& S, const Epi& E, unsigned long long* stamps) {
    const int tid = opaque_tid(), wid = __builtin_amdgcn_readfirstlane(tid >> 6), lane = tid & 63, wr = wid >> 2, wc = wid & 3, fr = lane & 15, fq = lane >> 4;
    const int K = g.K, nt = K / BK;
    int ts_lo = 0, ts_hi = 0, nts = 0; const unsigned long long rt_entry = STAMP ? (unsigned long long)wall_clock64() : 0ull;
#define PG8_STAMP() do { if (STAMP && wid == 0 && nts < 64) { const unsigned long long _c = (unsigned long long)clock64(); \
        ts_lo = (lane == nts) ? (int)(unsigned)_c : ts_lo; ts_hi = (lane == nts) ? (int)(unsigned)(_c >> 32) : ts_hi; ++nts; } } while (0)
    PG8_STAMP();
    unsigned voffA[2], voffB[2];
#pragma unroll
    for (int i = 0; i < 2; ++i) { int R, C; stage_rc(tid * 16 + i * 8192, R, C); const int Rb = Epi::PERM ? ((R & ~31) + perm32(R & 31)) : R;
        voffA[i] = (unsigned)(R * K + C) * 2u; voffB[i] = (unsigned)(Rb * K + C) * 2u; }
    const size_t kstep = (size_t)(BK * 2);
    const size_t hstep = (size_t)HALF * K * 2;
    const size_t tstep = 2 * hstep;
    const unsigned ldsw = (unsigned)wid * 1024u;
    const int aoff = lds_byte(wr * 64 + fr, fq * 8), boff = lds_byte(wc * 32 + fr, fq * 8);
#define PG8_SA(b, h) (((b) * 2 + (h)) * HTB)
#define PG8_SB(b, h) ((4 + (b) * 2 + (h)) * HTB)
#define PG8_STAGE(bufoff, gbase, voff) do { _Pragma("unroll") for (int _i = 0; _i < 2; ++_i) \
        __builtin_amdgcn_global_load_lds((const unsigned*)((const char*)(gbase) + (voff)[_i]), (PG8_LAS unsigned*)(lds + (bufoff) + ldsw + _i * 8192), 16, 0, 0); } while (0)
#define PG8_LDA(dst, b, h) do { _Pragma("unroll") for (int m = 0; m < 4; ++m) _Pragma("unroll") for (int k = 0; k < 2; ++k) dst[m][k] = *(const PG8_LAS bf16x8*)(lds + PG8_SA(b, h) + aoff + m * 2048 + k * 1024); } while (0)
#define PG8_LDB(dst, b, h) do { _Pragma("unroll") for (int n = 0; n < 2; ++n) _Pragma("unroll") for (int k = 0; k < 2; ++k) dst[n][k] = *(const PG8_LAS bf16x8*)(lds + PG8_SB(b, h) + boff + n * 2048 + k * 1024); } while (0)
#define PG8_MMA(ai, bj, At, Bt) do { __builtin_amdgcn_s_setprio(1); _Pragma("unroll") for (int m = 0; m < 4; ++m) _Pragma("unroll") for (int n = 0; n < 2; ++n) _Pragma("unroll") for (int k = 0; k < 2; ++k) \
        acc[ai][bj][m][n] = __builtin_amdgcn_mfma_f32_16x16x32_bf16(Bt[n][k], At[m][k], acc[ai][bj][m][n], 0, 0, 0); __builtin_amdgcn_s_setprio(0); } while (0)
#define PG8_WAIT_V(n) asm volatile("s_waitcnt vmcnt(" #n ")" ::: "memory")
#define PG8_WAIT_L(n) asm volatile("s_waitcnt lgkmcnt(" #n ")" ::: "memory")
#define PG8_BAR __builtin_amdgcn_s_barrier()
#define PG8_SCHED __builtin_amdgcn_sched_barrier(0)
    Unit cur, nxt; int ui = 0;
    if (!S.next(0, cur)) return;
    f32x4 acc[2][2][4][2];
#pragma unroll
    for (int a = 0; a < 2; ++a)
#pragma unroll
        for (int b = 0; b < 2; ++b)
#pragma unroll
            for (int m = 0; m < 4; ++m)
#pragma unroll
                for (int n = 0; n < 2; ++n) acc[a][b][m][n] = (f32x4){0.f, 0.f, 0.f, 0.f};
    bf16x8 At[4][2], B0[2][2], B1[2][2];
    const char* cA = (const char*)g.A + (size_t)cur.pm * tstep; const char* cB = (const char*)g.Bt + (size_t)cur.pn * tstep;
    S.a_ready(cur);
    PG8_STAGE(PG8_SB(0, 0), cB, voffB); PG8_STAGE(PG8_SA(0, 0), cA, voffA); PG8_STAGE(PG8_SB(0, 1), cB + hstep, voffB); PG8_STAGE(PG8_SA(0, 1), cA + hstep, voffA);
    if (wr == 1) PG8_BAR;
    PG8_WAIT_V(4); PG8_BAR;
    PG8_STAGE(PG8_SB(1, 0), cB + kstep, voffB); PG8_STAGE(PG8_SA(1, 0), cA + kstep, voffA); PG8_STAGE(PG8_SB(1, 1), cB + hstep + kstep, voffB);
    PG8_WAIT_V(6); PG8_BAR;
    PG8_STAMP();
    for (;;) {
        const bool has_next = S.next(ui + 1, nxt);
        const char* nA = has_next ? (const char*)g.A + (size_t)nxt.pm * tstep : cA; const char* nB = has_next ? (const char*)g.Bt + (size_t)nxt.pn * tstep : cB;
        for (int t = 0; t < nt; t += 2) {
            const bool last = (t == nt - 2);
            const char* a1 = cA + (size_t)(t + 1) * kstep;
            const char* a2 = last ? nA : cA + (size_t)(t + 2) * kstep; const char* b2 = last ? nB : cB + (size_t)(t + 2) * kstep;
            const char* a3 = a2 + kstep; const char* b3 = b2 + kstep;
            if (last && has_next) S.a_ready(nxt);
            PG8_LDB(B0, 0, 0); PG8_SCHED; PG8_LDA(At, 0, 0); PG8_STAGE(PG8_SA(1, 1), a1 + hstep, voffA);
            PG8_WAIT_L(8); PG8_BAR; PG8_WAIT_L(0); PG8_MMA(0, 0, At, B0); PG8_BAR; PG8_SCHED;
            PG8_LDB(B1, 0, 1); PG8_STAGE(PG8_SB(0, 0), b2, voffB);
            PG8_BAR; PG8_WAIT_L(0); PG8_MMA(0, 1, At, B1); PG8_BAR;
            PG8_LDA(At, 0, 1); PG8_STAGE(PG8_SA(0, 0), a2, voffA);
            PG8_BAR; PG8_WAIT_L(0); PG8_MMA(1, 0, At, B0); PG8_BAR; PG8_SCHED;
            PG8_STAGE(PG8_SB(0, 1), b2 + hstep, voffB);
            PG8_WAIT_V(6); PG8_BAR; PG8_MMA(1, 1, At, B1); PG8_BAR;
            PG8_LDB(B0, 1, 0); PG8_SCHED; PG8_LDA(At, 1, 0); PG8_STAGE(PG8_SA(0, 1), a2 + hstep, voffA);
            PG8_WAIT_L(8); PG8_BAR; PG8_WAIT_L(0); PG8_MMA(0, 0, At, B0); PG8_BAR; PG8_SCHED;
            PG8_LDB(B1, 1, 1); PG8_STAGE(PG8_SB(1, 0), b3, voffB);
            PG8_BAR; PG8_WAIT_L(0); PG8_MMA(0, 1, At, B1); PG8_BAR;
            PG8_LDA(At, 1, 1); PG8_STAGE(PG8_SA(1, 0), a3, voffA);
            PG8_BAR; PG8_WAIT_L(0); PG8_MMA(1, 0, At, B0); PG8_BAR; PG8_SCHED;
            PG8_STAGE(PG8_SB(1, 1), b3 + hstep, voffB);
            PG8_WAIT_V(6); PG8_BAR; PG8_MMA(1, 1, At, B1); PG8_BAR;
        }
        PG8_STAMP();
        if constexpr (!Epi::AFTER_DRAIN) { E(acc, cur, wr, wc, fr, fq); S.done(cur); }
        PG8_STAMP();
        if (!has_next) break;
#pragma unroll
        for (int a = 0; a < 2; ++a)
#pragma unroll
            for (int b = 0; b < 2; ++b)
#pragma unroll
                for (int m = 0; m < 4; ++m)
#pragma unroll
                    for (int n = 0; n < 2; ++n) acc[a][b][m][n] = (f32x4){0.f, 0.f, 0.f, 0.f};
        cur = nxt; cA = nA; cB = nB; ++ui;
    }
    PG8_WAIT_V(0);
    if (wr == 0) PG8_BAR;
    PG8_BAR;
    if constexpr (Epi::AFTER_DRAIN) { E.fused(acc, cur, wr, wc, fr, fq, lds, wid, lane); S.done(cur); }
    PG8_STAMP();
    if (STAMP && wid == 0) { stamps[lane] = lane < nts ? (((unsigned long long)(unsigned)ts_hi << 32) | (unsigned)ts_lo) : 0ull;
        if (lane == 62) stamps[62] = rt_entry; if (lane == 63) stamps[63] = (unsigned long long)wall_clock64(); }
#undef PG8_STAMP
#undef PG8_SA
#undef PG8_SB
#undef PG8_STAGE
#undef PG8_LDA
#undef PG8_LDB
#undef PG8_MMA
#undef PG8_WAIT_V
#undef PG8_WAIT_L
#undef PG8_BAR
#undef PG8_SCHED
}
}
#ifndef ATT_INLINE
#define ATT_INLINE __forceinline__
#endif
namespace att {
constexpr int D = 128, NW = 8, QBLK = 32, KVBLK = 64, LDQ = 512, LDO = DM;
constexpr float SCALE = 0.088388347648318440f;
constexpr float THR = 8.f;
constexpr size_t SHM_V = KVBLK * D * 2, SHM_K = KVBLK * D * 2, SHM_Q = 256 * D * 2, SHM_ATTN = 2 * SHM_V + 2 * SHM_K + NW * 64 * 4 + SHM_Q;
using bf16x8 = __attribute__((ext_vector_type(8))) short;
using s16x4  = __attribute__((ext_vector_type(4))) short;
using f32x16 = __attribute__((ext_vector_type(16))) float;
using u32x4  = __attribute__((ext_vector_type(4))) unsigned;
#define KSWZ(row, colB) ((row) * 256 + ((colB) ^ (((row) & 7) << 4)))
#define SBAR() __builtin_amdgcn_sched_barrier(0)
__device__ __forceinline__ int crow(int r, int hi) { return (r & 3) + 8 * (r >> 2) + 4 * hi; }
__device__ __forceinline__ unsigned cvtpk(float lo, float hi) { unsigned r; asm volatile("v_cvt_pk_bf16_f32 %0, %1, %2" : "=v"(r) : "v"(lo), "v"(hi)); return r; }

__device__ __forceinline__ void partialSM(f32x16& p0, f32x16& p1, float& m_reg, float& mn, float& alpha) {
  constexpr float C = SCALE * 1.4426950408889634f;
  float pmax = p0[0]; for (int r = 1; r < 16; ++r) pmax = fmaxf(pmax, p0[r]); for (int r = 0; r < 16; ++r) pmax = fmaxf(pmax, p1[r]);
  { auto rr = __builtin_amdgcn_permlane32_swap(__float_as_uint(pmax), __float_as_uint(pmax), false, false);
    pmax = fmaxf(__uint_as_float(rr[0]), __uint_as_float(rr[1])); }
  if (__builtin_expect(__all(pmax - m_reg <= THR / SCALE), 1)) { mn = m_reg; alpha = 1.f; }
  else { mn = fmaxf(m_reg, pmax); alpha = __builtin_amdgcn_exp2f((m_reg - mn) * C); m_reg = mn; }
  float mnC = -mn * C;
  for (int r = 0; r < 16; ++r) p0[r] = fmaf(p0[r], C, mnC); for (int r = 0; r < 16; ++r) p1[r] = fmaf(p1[r], C, mnC);
  for (int r = 0; r < 16; ++r) p0[r] = __builtin_amdgcn_exp2f(p0[r]);
}
__device__ __forceinline__ void finishSM(f32x16& p0, f32x16& p1, float alpha, float& l_reg, bf16x8& pa0, bf16x8& pa1, bf16x8& pa2, bf16x8& pa3) {
  for (int r = 0; r < 16; ++r) p1[r] = __builtin_amdgcn_exp2f(p1[r]);
  float ps = 0; for (int r = 0; r < 16; ++r) ps += p0[r]; for (int r = 0; r < 16; ++r) ps += p1[r];
  { auto rr = __builtin_amdgcn_permlane32_swap(__float_as_uint(ps), __float_as_uint(ps), false, false);
    ps = __uint_as_float(rr[0]) + __uint_as_float(rr[1]); }
  l_reg = l_reg * alpha + ps;
#define PK4(P, BASE, OUT) do { unsigned a0 = cvtpk(P[BASE + 0], P[BASE + 1]), a1 = cvtpk(P[BASE + 2], P[BASE + 3]);   \
    unsigned b0 = cvtpk(P[BASE + 4], P[BASE + 5]), b1 = cvtpk(P[BASE + 6], P[BASE + 7]);                              \
    auto r0 = __builtin_amdgcn_permlane32_swap(a0, b0, false, false); auto r1 = __builtin_amdgcn_permlane32_swap(a1, b1, false, false); \
    u32x4 w = {r0[0], r1[0], r0[1], r1[1]}; OUT = *reinterpret_cast<bf16x8*>(&w); } while (0)
  PK4(p0, 0, pa0); PK4(p0, 8, pa1); PK4(p1, 0, pa2); PK4(p1, 8, pa3);
#undef PK4
}
__device__ __forceinline__ void qkt(f32x16& p0, f32x16& p1, const bf16_t* Ks, const bf16_t* Qs, int qrow, int r32, int hi) {
  p0 = f32x16{}; p1 = f32x16{};
#pragma unroll
  for (int d0 = 0; d0 < 8; ++d0) { int cb = (d0 * 16 + hi * 8) * 2;
    bf16x8 q = *reinterpret_cast<const bf16x8*>((const char*)Qs + KSWZ(qrow, cb));
    bf16x8 b0 = *reinterpret_cast<const bf16x8*>((const char*)Ks + KSWZ(r32, cb));
    bf16x8 b1 = *reinterpret_cast<const bf16x8*>((const char*)Ks + KSWZ(32 + r32, cb));
    p0 = __builtin_amdgcn_mfma_f32_32x32x16_bf16(b0, q, p0, 0, 0, 0);
    p1 = __builtin_amdgcn_mfma_f32_32x32x16_bf16(b1, q, p1, 0, 0, 0); }
}
__device__ __forceinline__ int v_st(int k, int c) { const int kk = (k & ~0xC) | ((k & 4) << 1) | ((k & 8) >> 1); return ((kk >> 3) * 4 + (c >> 5)) * 512 + ((kk & 7) * 32 + (c & 31)) * 2; }
__device__ __forceinline__ int v_rd_base(int lane) { return ((lane & 3) << 3) | (((lane >> 2) & 3) << 6) | (((lane >> 4) & 1) << 5) | (((lane >> 5) & 1) << 8); }
constexpr int v_rd_off(int d0, int ks, int half) { return d0 * 512 + ks * 4096 + half * 2048; }
template <int OFF> __device__ __forceinline__ s16x4 tr_read(int vb) {
  s16x4 r; asm volatile("ds_read_b64_tr_b16 %0, %1 offset:%2" : "=&v"(r) : "v"(vb), "i"(OFF) : "memory"); return r;
}
template <int D0> __device__ __forceinline__ void pv_one(f32x16& od, int vb, bf16x8 pa0, bf16x8 pa1, bf16x8 pa2, bf16x8 pa3) {
  const s16x4 l0 = tr_read<v_rd_off(D0, 0, 0)>(vb), h0 = tr_read<v_rd_off(D0, 0, 1)>(vb), l1 = tr_read<v_rd_off(D0, 1, 0)>(vb), h1 = tr_read<v_rd_off(D0, 1, 1)>(vb);
  const s16x4 l2 = tr_read<v_rd_off(D0, 2, 0)>(vb), h2 = tr_read<v_rd_off(D0, 2, 1)>(vb), l3 = tr_read<v_rd_off(D0, 3, 0)>(vb), h3 = tr_read<v_rd_off(D0, 3, 1)>(vb);
  asm volatile("s_waitcnt lgkmcnt(0)" ::: "memory"); SBAR();
#define PK(L, H) (bf16x8){L[0], L[1], L[2], L[3], H[0], H[1], H[2], H[3]}
  od = __builtin_amdgcn_mfma_f32_32x32x16_bf16(pa0, PK(l0, h0), od, 0, 0, 0);
  od = __builtin_amdgcn_mfma_f32_32x32x16_bf16(pa1, PK(l1, h1), od, 0, 0, 0);
  od = __builtin_amdgcn_mfma_f32_32x32x16_bf16(pa2, PK(l2, h2), od, 0, 0, 0);
  od = __builtin_amdgcn_mfma_f32_32x32x16_bf16(pa3, PK(l3, h3), od, 0, 0, 0);
#undef PK
}
__device__ __forceinline__ void pv_d0(f32x16* o, int vb, bf16x8 pa0, bf16x8 pa1, bf16x8 pa2, bf16x8 pa3) {
  pv_one<0>(o[0], vb, pa0, pa1, pa2, pa3); pv_one<1>(o[1], vb, pa0, pa1, pa2, pa3); pv_one<2>(o[2], vb, pa0, pa1, pa2, pa3); pv_one<3>(o[3], vb, pa0, pa1, pa2, pa3);
}

struct SrcOne { const bf16_t* k0; const bf16_t* v0; int ldk;
  __device__ __forceinline__ const bf16_t* k(int j) const { return k0 + (size_t)j * 64 * ldk; }
  __device__ __forceinline__ const bf16_t* v(int j) const { return v0 + (size_t)j * 64 * ldk; } };
struct SrcTwo { const bf16_t* ck; const bf16_t* cv; const bf16_t* k1; const bf16_t* v1; int ldk;
  __device__ __forceinline__ const bf16_t* k(int j) const { return j < 4 ? ck + (size_t)j * 64 * ldk : k1 + (size_t)(j - 4) * 64 * ldk; }
  __device__ __forceinline__ const bf16_t* v(int j) const { return j < 4 ? cv + (size_t)j * 64 * ldk : v1 + (size_t)(j - 4) * 64 * ldk; } };
struct NoBias { __device__ __forceinline__ void operator()(f32x16&, f32x16&, int, int, int, int) const {} };
struct NaBias { const float* tab; int i0, kr0;
  __device__ __forceinline__ void operator()(f32x16& p0, f32x16& p1, int jt, int wid, int r32, int hi) const {
    if (jt < 4) return;
    const int qi = i0 + wid * QBLK + r32, r = qi >> 6, qc = qi & 63, kr = kr0 + jt - 4;
    int lo = r - 4; lo = lo < 0 ? 0 : (lo > 8 ? 8 : lo);
    const bool rowok = (kr >= lo) && (kr < lo + 8);
    if (!rowok) {
#pragma unroll
      for (int rr = 0; rr < 16; ++rr) { p0[rr] = -1e30f; p1[rr] = -1e30f; }
      return;
    }
    int c0 = qc - 8; c0 = c0 < 0 ? 0 : (c0 > 48 ? 48 : c0);
    const int dr = kr - r + 7;
    const float* tb = tab + dr * 31 + (4 * hi - qc + 15);
    const int w0 = 4 * hi - c0;
#pragma unroll
    for (int g = 0; g < 4; ++g) {
#pragma unroll
      for (int q = 0; q < 4; ++q) {
        const int rr = 4 * g + q, kc0 = q + 8 * g;
        const float t0 = tb[kc0], t1 = tb[kc0 + 32];
        p0[rr] = ((unsigned)(kc0 + w0) < 16u) ? p0[rr] + t0 : -1e30f;
        p1[rr] = ((unsigned)(kc0 + 32 + w0) < 16u) ? p1[rr] + t1 : -1e30f;
      }
      SBAR();
    }
  } };

template <class Src, class Bias>
__device__ ATT_INLINE void attn_body(const bf16_t* __restrict__ Qb, const Src src, bf16_t* __restrict__ Ob, const int NT, char* lds, const Bias bias) {
  const int tid = opaque_tid(), wid = tid >> 6, lane = tid & 63, r32 = lane & 31, hi = lane >> 5;
  const int LDK = src.ldk;
  bf16_t* V_lds = (bf16_t*)lds; bf16_t* K_lds = (bf16_t*)(lds + 2 * SHM_V);
  float* ws = (float*)(lds + 2 * SHM_V + 2 * SHM_K) + wid * 64; float* li_l = ws; float* al_l = ws + 32;
  float m_reg = -1e30f, l_reg = 0; f32x16 o[4] = {};
  bf16_t* Q_lds = (bf16_t*)(lds + 2 * SHM_V + 2 * SHM_K + NW * 64 * 4);
  const int qrow = wid * QBLK + r32;
  {
#pragma unroll
    for (int i = 0; i < 8; ++i) { const int f = tid + 512 * i, row = f >> 4, c8 = (f & 15) * 8;
      *(bf16x8*)((char*)Q_lds + KSWZ(row, c8 * 2)) = *reinterpret_cast<const bf16x8*>(Qb + (long)row * LDQ + c8); }
  }
  const int sr = tid >> 4, sc = (tid & 15) * 8, vst0 = v_st(sr, sc), vst1 = v_st(32 + sr, sc);
  const int vb0 = (int)(uintptr_t)V_lds + v_rd_base(lane);
  struct { bf16x8 vs0, vs1, ks0, ks1; } sr_[2];
#define SLOAD(i, jt) do { const bf16_t* kt_ = src.k(jt); const bf16_t* vt_ = src.v(jt); \
    sr_[i].vs0 = *reinterpret_cast<const bf16x8*>(&vt_[(long)sr * LDK + sc]); sr_[i].vs1 = *reinterpret_cast<const bf16x8*>(&vt_[(long)(32 + sr) * LDK + sc]); \
    sr_[i].ks0 = *reinterpret_cast<const bf16x8*>(&kt_[(long)sr * LDK + sc]); sr_[i].ks1 = *reinterpret_cast<const bf16x8*>(&kt_[(long)(32 + sr) * LDK + sc]); } while (0)
#define SWRITE(b, i) do { *(bf16x8*)((char*)V_lds + (b) * SHM_V + vst0) = sr_[i].vs0;          \
    *(bf16x8*)((char*)V_lds + (b) * SHM_V + vst1) = sr_[i].vs1; int kc = sc * 2;               \
    *(bf16x8*)((char*)K_lds + (b) * SHM_K + KSWZ(sr, kc)) = sr_[i].ks0;                       \
    *(bf16x8*)((char*)K_lds + (b) * SHM_K + KSWZ(32 + sr, kc)) = sr_[i].ks1; } while (0)
#define SWAIT() asm volatile("s_waitcnt vmcnt(4)" ::: "memory")
#define RESC(a) do { if (__any((a) < 1.f)) { if (hi == 0) al_l[r32] = (a); asm volatile("s_waitcnt lgkmcnt(0)" ::: "memory"); \
    for (int d = 0; d < 4; ++d) for (int r = 0; r < 16; ++r) o[d][r] *= al_l[crow(r, hi)]; } } while (0)
  f32x16 pA0, pA1, pB0, pB1; float mnA, mnB, alA, alB; bf16x8 pa0, pa1, pa2, pa3;
  constexpr int SE = 0, SO = 1;
  SLOAD(SE, 0); asm volatile("s_waitcnt vmcnt(0)" ::: "memory"); SWRITE(0, SE); __syncthreads();
  qkt(pA0, pA1, K_lds, Q_lds, qrow, r32, hi); bias(pA0, pA1, 0, wid, r32, hi); partialSM(pA0, pA1, m_reg, mnA, alA);
  SLOAD(SO, 1); if (2 < NT) SLOAD(SE, 2);
  SWAIT(); SWRITE(1, SO); __syncthreads();
  for (int j = 1; j + 1 < NT; j += 2) {
    SBAR(); qkt(pB0, pB1, (bf16_t*)((char*)K_lds + SHM_K), Q_lds, qrow, r32, hi); bias(pB0, pB1, j, wid, r32, hi);
    finishSM(pA0, pA1, alA, l_reg, pa0, pa1, pa2, pa3); SBAR();
    SLOAD(SO, j + 2); SBAR();
    pv_d0(o, vb0, pa0, pa1, pa2, pa3); partialSM(pB0, pB1, m_reg, mnB, alB);
    __syncthreads(); SWAIT(); SWRITE(0, SE);
    RESC(alB); __syncthreads();
    SBAR(); qkt(pA0, pA1, K_lds, Q_lds, qrow, r32, hi); bias(pA0, pA1, j + 1, wid, r32, hi);
    finishSM(pB0, pB1, alB, l_reg, pa0, pa1, pa2, pa3); SBAR();
    if (j + 3 < NT) SLOAD(SE, j + 3); SBAR();
    pv_d0(o, vb0 + (int)SHM_V, pa0, pa1, pa2, pa3); partialSM(pA0, pA1, m_reg, mnA, alA);
    __syncthreads(); SWAIT(); SWRITE(1, SO);
    RESC(alA); __syncthreads();
  }
  SBAR(); qkt(pB0, pB1, (bf16_t*)((char*)K_lds + SHM_K), Q_lds, qrow, r32, hi); bias(pB0, pB1, NT - 1, wid, r32, hi);
  finishSM(pA0, pA1, alA, l_reg, pa0, pa1, pa2, pa3); SBAR();
  pv_d0(o, vb0, pa0, pa1, pa2, pa3); partialSM(pB0, pB1, m_reg, mnB, alB);
  __syncthreads(); RESC(alB);
  finishSM(pB0, pB1, alB, l_reg, pa0, pa1, pa2, pa3); SBAR();
  pv_d0(o, vb0 + (int)SHM_V, pa0, pa1, pa2, pa3);
  if (hi == 0) li_l[r32] = l_reg; asm volatile("s_waitcnt lgkmcnt(0)" ::: "memory");
  float rli[16];
#pragma unroll
  for (int r = 0; r < 16; ++r) rli[r] = __builtin_amdgcn_rcpf(li_l[crow(r, hi)]);
  bf16_t* Ow = Ob + (long)(wid * QBLK) * LDO;
#pragma unroll
  for (int r = 0; r < 16; ++r) { int orow = crow(r, hi);
    for (int d0 = 0; d0 < 4; ++d0) Ow[(long)orow * LDO + d0 * 32 + r32] = f2bf(o[d0][r] * rli[r]); }
#undef SLOAD
#undef SWRITE
#undef SWAIT
#undef RESC
}
}
#define LAS __attribute__((address_space(3)))
constexpr int LDS_BYTES = 147456, XBW_OFF = LDS_BYTES - 64;
constexpr int NPH = 1 + DEPTH * 12;
#ifndef DBG_NLAYERS
#define DBG_NLAYERS DEPTH
#endif

#ifndef MIXMASK
#define MIXMASK 0xFF
#endif
#define FOR_ITEMS(it, n, o, w) for (int bo_ = (o) * (int)gridDim.x / 256, bw_ = ((w) * (int)gridDim.x / 256) > 0 ? ((w) * (int)gridDim.x / 256) : 1, \
                                    it = ((int)blockIdx.x >= bo_ && (int)blockIdx.x < bo_ + bw_) ? (int)blockIdx.x - bo_ : (n); it < (n); it += bw_)

__device__ __forceinline__ void phase_mix(const Params& p, int l, unsigned char* lds) {
    const int tid = opaque_tid();
    float* smem = (float*)lds;
    const bf16_t* NAQ = WSP(bf16_t, WS_NAQ); const bf16_t* NAK = WSP(bf16_t, WS_NAK); const bf16_t* NAV = WSP(bf16_t, WS_NAV);
    const bf16_t* GQ = WSP(bf16_t, WS_GQ); const bf16_t* GK = WSP(bf16_t, WS_GK); const bf16_t* GV = WSP(bf16_t, WS_GV);
    bf16_t* MRG = WSP(bf16_t, WS_MRG);
    if ((MIXMASK >> 0) & 1) FOR_ITEMS(it, LB * 16, 0, 128) gdn_chain(p, l, false, it / 16, (it / 4) % 4, (it / 2) % 2, it % 2, smem);
    if ((MIXMASK >> 1) & 1) FOR_ITEMS(it, LB * 16, 128, 128) gla_chain(p, l, false, it / 16, (it / 4) % 4, (it / 2) % 2, it % 2, smem);
    if ((MIXMASK >> 2) & 1) FOR_ITEMS(it, LB * 16, 128, 128) {
        const int b = it / 16, qh = (it / 4) % 4, qb = it % 4, kvh = qh >> 1;
        const size_t r0 = (size_t)MC + (size_t)b * LT;
        att::SrcTwo src{WSP(bf16_t, WS_CGK) + ((size_t)b * DEPTH + l) * 256 * 256 + kvh * 128, WSP(bf16_t, WS_CGV) + ((size_t)b * DEPTH + l) * 256 * 256 + kvh * 128,
                        GK + r0 * 256 + kvh * 128, GV + r0 * 256 + kvh * 128, 256};
        __syncthreads();
        att::attn_body(GQ + (r0 + qb * 256) * 512 + qh * 128, src, MRG + (r0 + qb * 256) * DM + 1024 + qh * 128, 4 + LT / 64, (char*)lds, att::NoBias{});
    }
    if ((MIXMASK >> 3) & 1) FOR_ITEMS(it, LB * 16, 128, 128) {
        const int b = it / 16, h = (it / 4) % 4, qb = it % 4;
        const int kr0 = qb == 0 ? 0 : qb == 1 ? 0 : qb == 2 ? 4 : 8, nrows = (qb == 0 || qb == 3) ? 8 : 12;
        const size_t r0 = (size_t)MC + (size_t)b * LT;
        float* tab = (float*)(lds + att::SHM_ATTN);
        __syncthreads();
        if (tid < 15 * 31) tab[tid] = p.in[I_RPB][((size_t)l * 4 + h) * 15 * 31 + tid] * (1.0f / att::SCALE);
        att::SrcTwo src{WSP(bf16_t, WS_CNAK) + ((size_t)b * DEPTH + l) * 256 * 512 + h * 128, WSP(bf16_t, WS_CNAV) + ((size_t)b * DEPTH + l) * 256 * 512 + h * 128,
                        NAK + (r0 + kr0 * 64) * 512 + h * 128, NAV + (r0 + kr0 * 64) * 512 + h * 128, 512};
        att::attn_body(NAQ + (r0 + qb * 256) * 512 + h * 128, src, MRG + (r0 + qb * 256) * DM + 0 + h * 128, 4 + nrows, (char*)lds, att::NaBias{tab, qb * 256, kr0});
    }
    if ((MIXMASK >> 4) & 1) FOR_ITEMS(it, CB * 16, 128, 128) gdn_chain(p, l, true, it / 16, (it / 4) % 4, (it / 2) % 2, it % 2, smem);
    if ((MIXMASK >> 5) & 1) FOR_ITEMS(it, CB * 16, 0, 128) gla_chain(p, l, true, it / 16, (it / 4) % 4, (it / 2) % 2, it % 2, smem);
    if ((MIXMASK >> 6) & 1) FOR_ITEMS(it, CB * 4, 0, 64) {
        const int b = it / 4, h = it % 4; const size_t r0 = (size_t)b * CT;
        att::SrcOne src{NAK + r0 * 512 + h * 128, NAV + r0 * 512 + h * 128, 512};
        __syncthreads();
        att::attn_body(NAQ + r0 * 512 + h * 128, src, MRG + r0 * DM + 0 + h * 128, CT / 64, (char*)lds, att::NoBias{});
    }
    if ((MIXMASK >> 7) & 1) FOR_ITEMS(it, CB * 4, 64, 64) {
        const int b = it / 4, qh = it % 4, kvh = qh >> 1; const size_t r0 = (size_t)b * CT;
        att::SrcOne src{GK + r0 * 256 + kvh * 128, GV + r0 * 256 + kvh * 128, 256};
        __syncthreads();
        att::attn_body(GQ + r0 * 512 + qh * 128, src, MRG + r0 * DM + 1024 + qh * 128, CT / 64, (char*)lds, att::NoBias{});
    }
}

static_assert(att::SHM_ATTN + 15 * 31 * 4 + 2048 <= (size_t)XBW_OFF, "LDS map");
constexpr int BAR_WORD0 = 4096;
static_assert((BAR_WORD0 + XCD_BAR_WORDS) * 4 <= (int)CTL_BYTES, "ctl");

__global__ void __launch_bounds__(512, 2) fwd(Params p) {
    extern __shared__ __attribute__((aligned(16))) unsigned char lds[];
    const int tid = threadIdx.x;
    volatile LAS unsigned* xbw = (volatile LAS unsigned*)((LAS unsigned char*)lds + XBW_OFF);
    if (tid < 4) xbw[tid] = 0u;
    __syncthreads();
    XcdBarrier bar; bar.bar = WSP(unsigned, WS_CTL) + BAR_WORD0; bar.x = 0; bar.st = xbw;
    if (p.ph_hi - p.ph_lo > 1) bar = xcd_barrier_post(WSP(unsigned, WS_CTL) + BAR_WORD0, xbw);
#ifndef PHMASK
#define PHMASK 0x1FFF
#endif
#define IN(k) (p.ph_lo <= (k) && (k) < p.ph_hi)
#define INL(j) (((PHMASK >> ((j) + 1)) & 1) && IN(pb + (j)))
#ifndef DUPMASK
#define DUPMASK 0
#endif
#define DUP(j) ((DUPMASK >> ((j) + 1)) & 1)
#define SEAM(k) do { if (IN(k) && IN((k) + 1)) xcd_barrier(bar); } while (0)
    LAS unsigned char* ldsl = (LAS unsigned char*)lds;
    bf16_t* H = WSP(bf16_t, WS_H); bf16_t* ACT = WSP(bf16_t, WS_ACT); float* X = WSP(float, WS_X); float* Z = WSP(float, WS_Z); bf16_t* MRG = WSP(bf16_t, WS_MRG);

    if ((PHMASK & 1) && IN(0)) { int reps_ = 1 + (DUPMASK & 1); asm volatile("" : "+s"(reps_)); for (int rep_ = 0; rep_ < reps_; ++rep_) { const Params q = opaque_params(p); phase_prologue(q, (float*)lds); __syncthreads(); } }
    SEAM(0);
    for (int l = 0; l < DBG_NLAYERS; ++l) {
        const int pb = 1 + l * 12;
        const float* modl = WSP(float, WS_MODV) + (size_t)l * NCOND * NMOD;
        if (INL(0)) { int reps_ = 1 + DUP(0); asm volatile("" : "+s"(reps_)); for (int rep_ = 0; rep_ < reps_; ++rep_) { const Params q = opaque_params(p); phase_norm(q, l, 0); __syncthreads(); } }
        SEAM(pb + 0);
        if (INL(1)) {
            pg8::Gemm g{H, WSP(bf16_t, WS_WGU) + ((size_t)l * 2 + 0) * NGU * DM, M, NGU, DM}; pg8::StaticOrder S; S.init(M, NGU, (int)gridDim.x, (int)blockIdx.x);
            pg8::EpiSwiGLU E{ACT, FF};
            pg8::gemm_phase<pg8::EpiSwiGLU, pg8::StaticOrder, false>(ldsl, g, S, E, nullptr);
        }
        SEAM(pb + 1);
        if (INL(2)) {
            pg8::Gemm g{ACT, WSP(bf16_t, WS_WDN) + ((size_t)l * 2 + 0) * DM * FF, M, DM, FF}; pg8::StaticOrder S; S.init(M, DM, (int)gridDim.x, (int)blockIdx.x);
            pg8::EpiResid E{X, X, DM, modl + 2 * DM, 0.5f};
            pg8::gemm_phase<pg8::EpiResid, pg8::StaticOrder, false>(ldsl, g, S, E, nullptr);
        }
        SEAM(pb + 2);
        if (INL(3)) { int reps_ = 1 + DUP(3); asm volatile("" : "+s"(reps_)); for (int rep_ = 0; rep_ < reps_; ++rep_) { const Params q = opaque_params(p); phase_norm(q, l, 1); __syncthreads(); } }
        SEAM(pb + 3);
        if (INL(4)) {
            pg8::Gemm g{H, WSP(bf16_t, WS_WIN) + (size_t)l * NINP * DM, M, NINP, DM}; pg8::StaticOrder S; S.init(M, NINP, (int)gridDim.x, (int)blockIdx.x);
            pg8::EpiF32 E{Z, NINP, nullptr};
            pg8::gemm_phase<pg8::EpiF32, pg8::StaticOrder, false>(ldsl, g, S, E, nullptr);
        }
        SEAM(pb + 4);
        if (INL(5)) { int reps_ = 1 + DUP(5); asm volatile("" : "+s"(reps_)); for (int rep_ = 0; rep_ < reps_; ++rep_) { const Params q = opaque_params(p); phase_prep(q, l); __syncthreads(); } }
        SEAM(pb + 5);
        if (INL(6)) { int reps_ = 1 + DUP(6); asm volatile("" : "+s"(reps_)); for (int rep_ = 0; rep_ < reps_; ++rep_) { const Params q = opaque_params(p); phase_mix(q, l, lds); __syncthreads(); } }
        SEAM(pb + 6);
        if (INL(7)) { int reps_ = 1 + DUP(7); asm volatile("" : "+s"(reps_)); for (int rep_ = 0; rep_ < reps_; ++rep_) { const Params q = opaque_params(p); phase_post(q, l); __syncthreads(); } }
        SEAM(pb + 7);
        if (INL(8)) {
            pg8::Gemm g{MRG, WSP(bf16_t, WS_WOUT) + (size_t)l * DM * DM, M, DM, DM}; pg8::StaticOrder S; S.init(M, DM, (int)gridDim.x, (int)blockIdx.x);
            pg8::EpiResid E{X, X, DM, modl + 5 * DM, 1.0f};
            pg8::gemm_phase<pg8::EpiResid, pg8::StaticOrder, false>(ldsl, g, S, E, nullptr);
        }
        SEAM(pb + 8);
        if (INL(9)) { int reps_ = 1 + DUP(9); asm volatile("" : "+s"(reps_)); for (int rep_ = 0; rep_ < reps_; ++rep_) { const Params q = opaque_params(p); phase_norm(q, l, 2); __syncthreads(); } }
        SEAM(pb + 9);
        if (INL(10)) {
            pg8::Gemm g{H, WSP(bf16_t, WS_WGU) + ((size_t)l * 2 + 1) * NGU * DM, M, NGU, DM}; pg8::StaticOrder S; S.init(M, NGU, (int)gridDim.x, (int)blockIdx.x);
            pg8::EpiSwiGLU E{ACT, FF};
            pg8::gemm_phase<pg8::EpiSwiGLU, pg8::StaticOrder, false>(ldsl, g, S, E, nullptr);
        }
        SEAM(pb + 10);
        if (INL(11)) {
            pg8::Gemm g{ACT, WSP(bf16_t, WS_WDN) + ((size_t)l * 2 + 1) * DM * FF, M, DM, FF}; pg8::StaticOrder S; S.init(M, DM, (int)gridDim.x, (int)blockIdx.x);
            pg8::EpiResid E{X, (l == DEPTH - 1) ? p.out : X, DM, modl + 8 * DM, 0.5f};
            pg8::gemm_phase<pg8::EpiResid, pg8::StaticOrder, false>(ldsl, g, S, E, nullptr);
        }
        SEAM(pb + 11);
    }
#undef IN
#undef SEAM
}

#ifndef MULTI_LAUNCH
#define MULTI_LAUNCH 0
#endif
extern "C" void kernel_launch(void* const* d_in, const int* in_sizes, int n_in, void* d_out, int out_size, void* d_ws, size_t ws_size, hipStream_t stream) {
    static int grid = 0;
    if (grid == 0) {
        if (n_in != N_IN || (size_t)out_size != O_END || ws_size < WS_END) { fprintf(stderr, "kernel_launch: shape mismatch n_in %d out %d ws %zu (need %zu)\n", n_in, out_size, ws_size, (size_t)WS_END); grid = -1; return; }
        int dev = 0, cus = 0, per_cu = 0;
        if (hipGetDevice(&dev) != hipSuccess || hipDeviceGetAttribute(&cus, hipDeviceAttributeMultiprocessorCount, dev) != hipSuccess) { grid = -1; return; }
        if (hipFuncSetAttribute((const void*)fwd, hipFuncAttributeMaxDynamicSharedMemorySize, LDS_BYTES) != hipSuccess) { fprintf(stderr, "kernel_launch: hipFuncSetAttribute failed\n"); grid = -1; return; }
        if (hipOccupancyMaxActiveBlocksPerMultiprocessor(&per_cu, (const void*)fwd, 512, LDS_BYTES) != hipSuccess || per_cu < 1) { fprintf(stderr, "kernel_launch: occupancy query says %d\n", per_cu); (void)hipGetLastError(); }
        grid = cus;
    }
    if (grid < 0) return;
    (void)hipMemsetAsync((char*)d_ws + WS_CTL, 0, CTL_BYTES, stream);
    Params p{};
    for (int i = 0; i < N_IN; ++i) p.in[i] = (const float*)d_in[i];
    p.out = (float*)d_out; p.ws = (unsigned char*)d_ws;
#if MULTI_LAUNCH
    for (int ph = 0; ph < 1 + DBG_NLAYERS * 12; ++ph) { p.ph_lo = ph; p.ph_hi = ph + 1; hipLaunchKernelGGL(fwd, dim3(grid), dim3(512), LDS_BYTES, stream, p); }
#else
    p.ph_lo = 0; p.ph_hi = NPH; hipLaunchKernelGGL(fwd, dim3(grid), dim3(512), LDS_BYTES, stream, p);
#endif
    const hipError_t le = hipPeekAtLastError();
    if (le != hipSuccess) fprintf(stderr, "kernel_launch: launch failed: %s\n", hipGetErrorName(le));
}
```

```cpp
#include <hip/hip_runtime.h>
#include <cstdio>
#include <cstdint>

#ifndef CB_
#define CB_ 16
#endif
#ifndef LB_
#define LB_ 8
#endif
#ifndef DEPTH_
#define DEPTH_ 4
#endif
constexpr int DM = 2048, DEPTH = DEPTH_, CB = CB_, CT = 256, LB = LB_, LT = 1024;
constexpr int MC = CB * CT, ML = LB * LT, M = MC + ML;
constexpr int FF = 5504, NGU = 2 * FF, NIN = 6192, NINP = 6400, NMOD = 9 * DM, NCOND = 1 + LB;
constexpr float EPS = 1e-6f;
constexpr int Z_NAQ = 0, Z_NAK = 512, Z_NAV = 1024, Z_GLQ = 1536, Z_GLK = 1792, Z_GLV = 2048, Z_GLR = 2560, Z_GF = 3072, Z_GB = 3088,
              Z_GQQ = 3104, Z_GQK = 3616, Z_GQV = 3872, Z_DQKV = 4128, Z_DZ = 5664, Z_DB = 6176, Z_DA = 6184;
static_assert(Z_DA + 8 == NIN, "split");
enum { I_XP = 0, I_XS, I_CNAK, I_CNAV, I_CGK, I_CGV, I_SGLA, I_SGDN, I_C, I_CCTX, I_NORMG, I_WMOD, I_BMOD, I_GU, I_DOWN, I_WIN, I_WOUT, I_NAQKN, I_RPB,
       I_GUP, I_GBIAS, I_GLAON, I_GQAQKN, I_CONV, I_ALOG, I_DTB, I_GDNON, N_IN };
constexpr size_t O_YP = 0, O_YS = O_YP + (size_t)MC * DM, O_NAK = O_YS + (size_t)ML * DM, O_NAV = O_NAK + (size_t)CB * DEPTH * 4 * CT * 128,
                 O_GK = O_NAV + (size_t)CB * DEPTH * 4 * CT * 128, O_GV = O_GK + (size_t)CB * DEPTH * 2 * CT * 128,
                 O_SGLA = O_GV + (size_t)CB * DEPTH * 2 * CT * 128, O_SGDN = O_SGLA + (size_t)CB * DEPTH * 2 * 4 * 64 * 128,
                 O_END = O_SGDN + (size_t)CB * DEPTH * 2 * 4 * 128 * 128;
constexpr size_t al256(size_t x) { return (x + 255) & ~(size_t)255; }
constexpr size_t WS_CTL = 0, CTL_BYTES = 1u << 20;
constexpr size_t WS_WGU = CTL_BYTES;
constexpr size_t WS_WDN = WS_WGU + (size_t)DEPTH * 2 * NGU * DM * 2;
constexpr size_t WS_WIN = WS_WDN + (size_t)DEPTH * 2 * DM * FF * 2;
constexpr size_t WS_WOUT = WS_WIN + (size_t)DEPTH * NINP * DM * 2;
constexpr size_t WS_MODV = WS_WOUT + (size_t)DEPTH * DM * DM * 2;
constexpr size_t WS_ROPE = al256(WS_MODV + (size_t)DEPTH * NCOND * NMOD * 4);
constexpr size_t WS_X = al256(WS_ROPE + 2 * 64 * 32 * 4);
constexpr size_t WS_H = WS_X + (size_t)M * DM * 4;
constexpr size_t WS_ACT = WS_H + (size_t)M * DM * 2;
constexpr size_t WS_Z = WS_ACT + (size_t)M * FF * 2;
constexpr size_t WS_MRG = WS_Z + (size_t)M * NINP * 4;
constexpr size_t WS_NAQ = WS_MRG + (size_t)M * DM * 2;
constexpr size_t WS_NAK = WS_NAQ + (size_t)M * 512 * 2;
constexpr size_t WS_NAV = WS_NAK + (size_t)M * 512 * 2;
constexpr size_t WS_GQ = WS_NAV + (size_t)M * 512 * 2;
constexpr size_t WS_GK = WS_GQ + (size_t)M * 512 * 2;
constexpr size_t WS_GV = WS_GK + (size_t)M * 256 * 2;
constexpr size_t WS_CNAK = WS_GV + (size_t)M * 256 * 2;
constexpr size_t WS_CNAV = WS_CNAK + (size_t)LB * DEPTH * 256 * 512 * 2;
constexpr size_t WS_CGK = WS_CNAV + (size_t)LB * DEPTH * 256 * 512 * 2;
constexpr size_t WS_CGV = WS_CGK + (size_t)LB * DEPTH * 256 * 256 * 2;
constexpr size_t WS_AF = WS_CGV + (size_t)LB * DEPTH * 256 * 256 * 2;
constexpr size_t WS_AB = WS_AF + (size_t)M * 256 * 4;
constexpr size_t WS_DQ = WS_AB + (size_t)M * 256 * 4;
constexpr size_t WS_DK = WS_DQ + (size_t)M * 512 * 4;
constexpr size_t WS_DV = WS_DK + (size_t)M * 512 * 4;
constexpr size_t WS_DBA = WS_DV + (size_t)M * 512 * 4;
constexpr size_t WS_GOF = WS_DBA + (size_t)M * 16 * 4;
constexpr size_t WS_GOB = WS_GOF + (size_t)M * 512 * 4;
constexpr size_t WS_DOF = WS_GOB + (size_t)M * 512 * 4;
constexpr size_t WS_DOB = WS_DOF + (size_t)M * 512 * 4;
constexpr size_t WS_END = WS_DOB + (size_t)M * 512 * 4;

typedef unsigned short bf16_t;
struct Params { const float* in[N_IN]; float* out; unsigned char* ws; int ph_lo, ph_hi; };
static_assert(sizeof(Params) == N_IN * 8 + 8 + 8 + 8, "no padding");

#define WSP(T, off) ((T*)(p.ws + (off)))
__device__ __forceinline__ int opaque_tid() { int t = (int)threadIdx.x; asm volatile("" : "+v"(t)); return t; }
__device__ __forceinline__ Params opaque_params(const Params& p) { Params q = p; unsigned long long w = (unsigned long long)q.ws; asm volatile("" : "+s"(w)); q.ws = (unsigned char*)w; return q; }

__device__ __forceinline__ float wave_sum(float v) {
#pragma unroll
    for (int o = 32; o >= 1; o >>= 1) v += __shfl_xor(v, o);
    return v;
}
__device__ __forceinline__ bf16_t f2bf(float f) { unsigned u = __float_as_uint(f); u += 0x7FFFu + ((u >> 16) & 1u); return (bf16_t)(u >> 16); }
__device__ __forceinline__ unsigned pack2(float a, float b) { return (unsigned)f2bf(a) | ((unsigned)f2bf(b) << 16); }
__device__ __forceinline__ float silu_f(float x) { return x / (1.f + expf(-x)); }
__device__ __forceinline__ float softplus_f(float x) { return fmaxf(x, 0.f) + log1pf(expf(-fabsf(x))); }
__device__ __forceinline__ float logsigmoid_f(float x) { return fminf(x, 0.f) - log1pf(expf(-fabsf(x))); }
__device__ __forceinline__ int cond_of_row(int m) { return m < MC ? 0 : 1 + (m - MC) / LT; }
typedef float vf4 __attribute__((ext_vector_type(4)));
__device__ __forceinline__ void conv_tile(const float* __restrict__ src, int ld_src, int ncols_src, int k0, int c0, bf16_t* __restrict__ dst, int ld_dst, int n0, float* tile) {
    const int tid = opaque_tid();
    {
        const int r = tid >> 3, c = (tid & 7) * 8;
        float4 a = make_float4(0.f, 0.f, 0.f, 0.f), b = a;
        if (c0 + c + 8 <= ncols_src) {
            const float* s = src + (size_t)(k0 + r) * ld_src + c0 + c;
            a = *(const float4*)s; b = *(const float4*)(s + 4);
        }
        float* t = tile + r * 65 + c;
        t[0] = a.x; t[1] = a.y; t[2] = a.z; t[3] = a.w; t[4] = b.x; t[5] = b.y; t[6] = b.z; t[7] = b.w;
    }
    __syncthreads();
    {
        const int n = tid >> 3, ks = (tid & 7) * 8;
        const float* t = tile + ks * 65 + n;
        uint4 w;
        w.x = pack2(t[0 * 65], t[1 * 65]); w.y = pack2(t[2 * 65], t[3 * 65]); w.z = pack2(t[4 * 65], t[5 * 65]); w.w = pack2(t[6 * 65], t[7 * 65]);
        *(uint4*)(dst + (size_t)(n0 + n) * ld_dst + k0 + ks) = w;
    }
    __syncthreads();
}

constexpr int MOD_ITEMS = DEPTH * (NMOD / 128);
constexpr int TGU_KT = DM / 64, TGU_NT = NGU / 64, TDN_KT = FF / 64, TDN_NT = DM / 64, TIN_KT = DM / 64, TIN_NT = NINP / 64, TOUT_KT = DM / 64, TOUT_NT = DM / 64;
constexpr int T_GU = DEPTH * 2 * TGU_KT * TGU_NT, T_DN = DEPTH * 2 * TDN_KT * TDN_NT, T_IN = DEPTH * TIN_KT * TIN_NT, T_OUT = DEPTH * TOUT_KT * TOUT_NT;

__device__ __forceinline__ void phase_prologue(const Params& p, float* smem) {
    const int tid = opaque_tid(), nb = gridDim.x, bid = blockIdx.x;
    float* s_cond = smem;
    float* s_red = s_cond + NCOND * DM;
    float* s_tile = s_red + 3 * 128 * NCOND;
    for (int i = tid; i < NCOND * DM; i += 512) { const int ci = i / DM, k = i % DM; const float v = ci == 0 ? p.in[I_CCTX][k] : p.in[I_C][(size_t)(ci - 1) * DM + k]; s_cond[i] = silu_f(v); }
    __syncthreads();
    float* modv = WSP(float, WS_MODV);
    for (int it = bid; it < MOD_ITEMS; it += nb) {
        const int l = it / (NMOD / 128), jt = it % (NMOD / 128);
        const int cl = tid & 127, kq = tid >> 7, col = jt * 128 + cl;
        const float* w = p.in[I_WMOD] + (size_t)l * DM * NMOD + col;
        float acc[NCOND];
#pragma unroll
        for (int ci = 0; ci < NCOND; ++ci) acc[ci] = 0.f;
        for (int k = kq * 512; k < kq * 512 + 512; k += 8) {
            float wv[8];
#pragma unroll
            for (int j = 0; j < 8; ++j) wv[j] = w[(size_t)(k + j) * NMOD];
#pragma unroll
            for (int ci = 0; ci < NCOND; ++ci) {
                const float4 s0 = *(const float4*)&s_cond[ci * DM + k], s1 = *(const float4*)&s_cond[ci * DM + k + 4];
                acc[ci] += s0.x * wv[0] + s0.y * wv[1] + s0.z * wv[2] + s0.w * wv[3] + s1.x * wv[4] + s1.y * wv[5] + s1.z * wv[6] + s1.w * wv[7];
            }
        }
        if (kq > 0) {
#pragma unroll
            for (int ci = 0; ci < NCOND; ++ci) s_red[((kq - 1) * 128 + cl) * NCOND + ci] = acc[ci];
        }
        __syncthreads();
        if (kq == 0) {
            const float bm = p.in[I_BMOD][(size_t)l * NMOD + col];
#pragma unroll
            for (int ci = 0; ci < NCOND; ++ci)
                modv[((size_t)l * NCOND + ci) * NMOD + col] = acc[ci] + s_red[(0 * 128 + cl) * NCOND + ci] + s_red[(1 * 128 + cl) * NCOND + ci] + s_red[(2 * 128 + cl) * NCOND + ci] + bm;
        }
        __syncthreads();
    }
    for (int it = bid; it < T_GU + T_DN + T_IN + T_OUT; it += nb) {
        if (it < T_GU) {
            const int mat = it / (TGU_KT * TGU_NT), r = it % (TGU_KT * TGU_NT), kt = r / TGU_NT, nt = r % TGU_NT;
            const int n0 = nt * 64, t256 = n0 / 256, c = n0 % 256;
            const int c0 = c < 128 ? 128 * t256 + c : FF + 128 * t256 + (c - 128);
            conv_tile(p.in[I_GU] + (size_t)mat * DM * NGU, NGU, NGU, kt * 64, c0, WSP(bf16_t, WS_WGU) + (size_t)mat * NGU * DM, DM, n0, s_tile);
        } else if (it < T_GU + T_DN) {
            const int i2 = it - T_GU, mat = i2 / (TDN_KT * TDN_NT), r = i2 % (TDN_KT * TDN_NT), kt = r / TDN_NT, nt = r % TDN_NT;
            conv_tile(p.in[I_DOWN] + (size_t)mat * FF * DM, DM, DM, kt * 64, nt * 64, WSP(bf16_t, WS_WDN) + (size_t)mat * DM * FF, FF, nt * 64, s_tile);
        } else if (it < T_GU + T_DN + T_IN) {
            const int i2 = it - T_GU - T_DN, mat = i2 / (TIN_KT * TIN_NT), r = i2 % (TIN_KT * TIN_NT), kt = r / TIN_NT, nt = r % TIN_NT;
            conv_tile(p.in[I_WIN] + (size_t)mat * DM * NIN, NIN, NIN, kt * 64, nt * 64, WSP(bf16_t, WS_WIN) + (size_t)mat * NINP * DM, DM, nt * 64, s_tile);
        } else {
            const int i2 = it - T_GU - T_DN - T_IN, mat = i2 / (TOUT_KT * TOUT_NT), r = i2 % (TOUT_KT * TOUT_NT), kt = r / TOUT_NT, nt = r % TOUT_NT;
            conv_tile(p.in[I_WOUT] + (size_t)mat * DM * DM, DM, DM, kt * 64, nt * 64, WSP(bf16_t, WS_WOUT) + (size_t)mat * DM * DM, DM, nt * 64, s_tile);
        }
    }
    const size_t gtid = (size_t)bid * 512 + tid, gstride = (size_t)nb * 512;
    {
        float4* X = WSP(float4, WS_X);
        const float4* xp = (const float4*)p.in[I_XP]; const float4* xs = (const float4*)p.in[I_XS];
        const size_t nc = (size_t)MC * DM / 4, n = (size_t)M * DM / 4;
        for (size_t i = gtid; i < n; i += gstride) X[i] = i < nc ? xp[i] : xs[i - nc];
    }
    {
        const size_t n_na = (size_t)LB * DEPTH * 256 * 512 / 8;
        for (size_t i = gtid; i < 2 * n_na; i += gstride) {
            const bool isv = i >= n_na; const size_t j = isv ? i - n_na : i;
            const int d8 = (int)(j % 16), h = (int)((j / 16) % 4), t = (int)((j / 64) % 256); const size_t bl = j / (64 * 256);
            const float* s = p.in[isv ? I_CNAV : I_CNAK] + ((bl * 4 + h) * 256 + t) * 128 + d8 * 8;
            const float4 a = *(const float4*)s, b = *(const float4*)(s + 4);
            uint4 w; w.x = pack2(a.x, a.y); w.y = pack2(a.z, a.w); w.z = pack2(b.x, b.y); w.w = pack2(b.z, b.w);
            *(uint4*)(WSP(bf16_t, isv ? WS_CNAV : WS_CNAK) + (bl * 256 + t) * 512 + h * 128 + d8 * 8) = w;
        }
        const size_t n_g = (size_t)LB * DEPTH * 256 * 256 / 8;
        for (size_t i = gtid; i < 2 * n_g; i += gstride) {
            const bool isv = i >= n_g; const size_t j = isv ? i - n_g : i;
            const int d8 = (int)(j % 16), h = (int)((j / 16) % 2), t = (int)((j / 32) % 256); const size_t bl = j / (32 * 256);
            const float* s = p.in[isv ? I_CGV : I_CGK] + ((bl * 2 + h) * 256 + t) * 128 + d8 * 8;
            const float4 a = *(const float4*)s, b = *(const float4*)(s + 4);
            uint4 w; w.x = pack2(a.x, a.y); w.y = pack2(a.z, a.w); w.z = pack2(b.x, b.y); w.w = pack2(b.z, b.w);
            *(uint4*)(WSP(bf16_t, isv ? WS_CGV : WS_CGK) + (bl * 256 + t) * 256 + h * 128 + d8 * 8) = w;
        }
    }
    for (size_t i = gtid; i < 64 * 32; i += gstride) {
        const int pos = (int)(i / 32), k = (int)(i % 32);
        const float inv = powf(10000.0f, -(float)(2 * k) / 64.0f);
        const float ang = (float)pos * inv;
        WSP(float, WS_ROPE)[i] = cosf(ang); WSP(float, WS_ROPE)[64 * 32 + i] = sinf(ang);
    }
}

__device__ __forceinline__ void phase_norm(const Params& p, int l, int which  ) {
    const int tid = opaque_tid(), lane = tid & 63, wv = tid >> 6;
    const float* X = WSP(float, WS_X); bf16_t* H = WSP(bf16_t, WS_H);
    const float* g = p.in[I_NORMG] + ((size_t)l * 3 + which) * DM;
    for (int m = blockIdx.x * 8 + wv; m < M; m += gridDim.x * 8) {
        const int ci = cond_of_row(m);
        const float* mv = WSP(float, WS_MODV) + ((size_t)l * NCOND + ci) * NMOD + (size_t)which * 3 * DM;
        const float* x = X + (size_t)m * DM;
        vf4 v[8]; float ss = 0.f;
#pragma unroll
        for (int i = 0; i < 8; ++i) { v[i] = *(const vf4*)(x + (i * 64 + lane) * 4); ss += v[i].x * v[i].x + v[i].y * v[i].y + v[i].z * v[i].z + v[i].w * v[i].w; }
        ss = wave_sum(ss);
        const float r = 1.0f / sqrtf(ss * (1.0f / DM) + EPS);
#pragma unroll
        for (int i = 0; i < 8; ++i) {
            const int c = (i * 64 + lane) * 4;
            const float4 gg = *(const float4*)(g + c), sh = *(const float4*)(mv + c), sc = *(const float4*)(mv + DM + c);
            const float o0 = v[i].x * r * gg.x * (1.f + sc.x) + sh.x, o1 = v[i].y * r * gg.y * (1.f + sc.y) + sh.y;
            const float o2 = v[i].z * r * gg.z * (1.f + sc.z) + sh.z, o3 = v[i].w * r * gg.w * (1.f + sc.w) + sh.w;
            uint2 w; w.x = pack2(o0, o1); w.y = pack2(o2, o3);
            *(uint2*)(H + (size_t)m * DM + c) = w;
        }
    }
}

#define PREP_FENCE() asm volatile("" ::: "memory")
__device__ __forceinline__ void phase_prep(const Params& p, int l) {
    const int tid = opaque_tid(), lane = tid & 63, wv = tid >> 6;
    const float* Z = WSP(float, WS_Z);
    const float* ropec = WSP(float, WS_ROPE); const float* ropes = ropec + 64 * 32;
    for (int m = blockIdx.x * 8 + wv; m < M; m += gridDim.x * 8) {
        const float* z = Z + (size_t)m * NINP;
        const bool ctx = m < MC;
        const int b = ctx ? m / CT : (m - MC) / LT, t = ctx ? m % CT : (m - MC) % LT, T = ctx ? CT : LT;
        {
            const float* wq = p.in[I_NAQKN] + ((size_t)l * 2 + 0) * 128; const float* wk = wq + 128;
#pragma unroll 1
            for (int h = 0; h < 4; ++h) {
                float a = z[Z_NAQ + h * 128 + lane], c = z[Z_NAQ + h * 128 + 64 + lane];
                float r = 1.0f / sqrtf(wave_sum(a * a + c * c) * (1.0f / 128) + EPS);
                bf16_t* q = WSP(bf16_t, WS_NAQ) + (size_t)m * 512 + h * 128;
                q[lane] = f2bf(a * r * wq[lane]); q[64 + lane] = f2bf(c * r * wq[64 + lane]);
                a = z[Z_NAK + h * 128 + lane]; c = z[Z_NAK + h * 128 + 64 + lane];
                r = 1.0f / sqrtf(wave_sum(a * a + c * c) * (1.0f / 128) + EPS);
                const float k0 = a * r * wk[lane], k1 = c * r * wk[64 + lane];
                bf16_t* k = WSP(bf16_t, WS_NAK) + (size_t)m * 512 + h * 128;
                k[lane] = f2bf(k0); k[64 + lane] = f2bf(k1);
                const float v0 = z[Z_NAV + h * 128 + lane], v1 = z[Z_NAV + h * 128 + 64 + lane];
                bf16_t* v = WSP(bf16_t, WS_NAV) + (size_t)m * 512 + h * 128;
                v[lane] = f2bf(v0); v[64 + lane] = f2bf(v1);
                if (ctx) {
                    const size_t o = ((((size_t)b * DEPTH + l) * 4 + h) * CT + t) * 128;
                    p.out[O_NAK + o + lane] = k0; p.out[O_NAK + o + 64 + lane] = k1;
                    p.out[O_NAV + o + lane] = v0; p.out[O_NAV + o + 64 + lane] = v1;
                }
            }
        }
        PREP_FENCE();
        {
            const float* wq = p.in[I_GQAQKN] + ((size_t)l * 2 + 0) * 128; const float* wk = wq + 128;
            const int grow = t >> 6, gcol = t & 63, i32 = lane & 31;
            const float cr = ropec[grow * 32 + i32], sr = ropes[grow * 32 + i32], cc = ropec[gcol * 32 + i32], sc = ropes[gcol * 32 + i32];
#pragma unroll 1
            for (int h = 0; h < 6; ++h) {
                const int zo = h < 4 ? Z_GQQ + h * 128 : Z_GQK + (h - 4) * 128;
                float a = z[zo + lane], c = z[zo + 64 + lane];
                const float r = 1.0f / sqrtf(wave_sum(a * a + c * c) * (1.0f / 128) + EPS);
                const float* w = h < 4 ? wq : wk;
                a = a * r * w[lane]; c = c * r * w[64 + lane];
                if (!ctx) {
                    const float pa = __shfl_xor(a, 32), pc = __shfl_xor(c, 32);
                    a = lane < 32 ? a * cr - pa * sr : pa * sr + a * cr;
                    c = lane < 32 ? c * cc - pc * sc : pc * sc + c * cc;
                }
                if (h < 4) { bf16_t* q = WSP(bf16_t, WS_GQ) + (size_t)m * 512 + h * 128; q[lane] = f2bf(a); q[64 + lane] = f2bf(c); }
                else {
                    bf16_t* k = WSP(bf16_t, WS_GK) + (size_t)m * 256 + (h - 4) * 128; k[lane] = f2bf(a); k[64 + lane] = f2bf(c);
                    const float v0 = z[Z_GQV + (h - 4) * 128 + lane], v1 = z[Z_GQV + (h - 4) * 128 + 64 + lane];
                    bf16_t* v = WSP(bf16_t, WS_GV) + (size_t)m * 256 + (h - 4) * 128; v[lane] = f2bf(v0); v[64 + lane] = f2bf(v1);
                    if (ctx) {
                        const size_t o = ((((size_t)b * DEPTH + l) * 2 + (h - 4)) * CT + t) * 128;
                        p.out[O_GK + o + lane] = a; p.out[O_GK + o + 64 + lane] = c;
                        p.out[O_GV + o + lane] = v0; p.out[O_GV + o + 64 + lane] = v1;
                    }
                }
            }
        }
        PREP_FENCE();
        {
#pragma unroll 1
            for (int dir = 0; dir < 2; ++dir) {
                const float* up = p.in[I_GUP] + ((size_t)l * 2 + dir) * 16 * 256;
                const float* bias = p.in[I_GBIAS] + ((size_t)l * 2 + dir) * 256;
                const float gmine = z[(dir ? Z_GB : Z_GF) + (lane & 15)];
                float gsum[4];
#pragma unroll
                for (int i = 0; i < 4; ++i) gsum[i] = bias[lane + 64 * i];
#pragma unroll
                for (int r = 0; r < 16; ++r) {
                    const float gv = __shfl(gmine, r);
#pragma unroll
                    for (int i = 0; i < 4; ++i) gsum[i] += gv * up[r * 256 + lane + 64 * i];
                }
                float* A = WSP(float, dir ? WS_AB : WS_AF) + (size_t)m * 256;
#pragma unroll
                for (int i = 0; i < 4; ++i) A[lane + 64 * i] = expf(logsigmoid_f(gsum[i]) * (1.0f / 16.0f));
                PREP_FENCE();
            }
        }
        {
            const float* cw = p.in[I_CONV] + (size_t)l * 5 * 1536;
#pragma unroll 1
            for (int part = 0; part < 3; ++part) {
                float val[8];
#pragma unroll
                for (int i = 0; i < 8; ++i) val[i] = 0.f;
#pragma unroll 1
                for (int j = 0; j < 5; ++j) {
                    const int tt = t + j - 2;
                    if (tt >= 0 && tt < T) {
                        const float* zz = Z + (size_t)(m + j - 2) * NINP + Z_DQKV + part * 512;
                        const float* cj = cw + j * 1536 + part * 512;
#pragma unroll
                        for (int i = 0; i < 8; ++i) val[i] += cj[lane + 64 * i] * zz[lane + 64 * i];
                    }
                }
#pragma unroll
                for (int i = 0; i < 8; ++i) val[i] = silu_f(val[i]);
                float* dst = WSP(float, part == 0 ? WS_DQ : part == 1 ? WS_DK : WS_DV) + (size_t)m * 512;
#pragma unroll
                for (int h = 0; h < 4; ++h) {
                    float r = 1.0f;
                    if (part < 2) r = 1.0f / sqrtf(wave_sum(val[2 * h] * val[2 * h] + val[2 * h + 1] * val[2 * h + 1]) + EPS) * (part == 0 ? 0.08838834764831845f : 1.0f);
                    dst[h * 128 + lane] = val[2 * h] * r; dst[h * 128 + 64 + lane] = val[2 * h + 1] * r;
                }
                PREP_FENCE();
            }
            if (lane < 8) {
                const float beta = 1.0f / (1.0f + expf(-z[Z_DB + lane]));
                const float g = -expf(p.in[I_ALOG][(size_t)l * 8 + lane]) * softplus_f(z[Z_DA + lane] + p.in[I_DTB][(size_t)l * 8 + lane]);
                float* ba = WSP(float, WS_DBA) + (size_t)m * 16;
                ba[lane] = beta; ba[8 + lane] = expf(g);
            }
        }
        PREP_FENCE();
    }
}

typedef float vf2 __attribute__((ext_vector_type(2)));
__device__ __forceinline__ float dpp_f(float v, const int ctrl) { return v; }
#define DPPF(v, ctrl) __int_as_float(__builtin_amdgcn_mov_dpp(__float_as_int(v), (ctrl), 0xF, 0xF, true))
__device__ __forceinline__ float red8(float v) { v += DPPF(v, 0xB1); v += DPPF(v, 0x4E); v += DPPF(v, 0x141); return v; }
__device__ __forceinline__ float red16(float v) { v = red8(v); v += DPPF(v, 0x140); return v; }

__device__ __forceinline__ void gla_chain(const Params& p, int l, bool ctx, int b, int h, int dir, int es, float* smem) {
    constexpr int TC = 32;
    const int tid = opaque_tid(), el = tid >> 3, dg = tid & 7;
    const int T = ctx ? CT : LT; const size_t m0 = ctx ? (size_t)b * CT : (size_t)MC + (size_t)b * LT;
    const float* Z = WSP(float, WS_Z); const float* A = WSP(float, dir ? WS_AB : WS_AF);
    float* O = WSP(float, dir ? WS_GOB : WS_GOF);
    float* sq = smem; float* sk = sq + TC * 64; float* sa = sk + TC * 64; float* sv = sa + TC * 64; float* so = sv + TC * 64;
    vf2 S[4];
    {
        const int e = es * 64 + el;
        if (ctx) {
#pragma unroll
            for (int i = 0; i < 4; ++i) S[i] = (vf2){0.f, 0.f};
        } else {
            const float* s0 = p.in[I_SGLA] + (((((size_t)b * DEPTH + l) * 2 + dir) * 4 + h) * 64 + dg * 8) * 128 + e;
#pragma unroll
            for (int i = 0; i < 4; ++i) S[i] = (vf2){s0[(size_t)(2 * i) * 128], s0[(size_t)(2 * i + 1) * 128]};
        }
    }
    vf4 pre[4];
    const int nch = T / TC;
    const int ls = tid >> 4, lc = (tid & 15) * 4;
#define GLA_LOAD(c) do { const int ti = (c) * TC + ls, tt = dir ? T - 1 - ti : ti; const size_t m = m0 + tt; \
        pre[0] = *(const vf4*)(Z + m * NINP + Z_GLQ + h * 64 + lc); pre[1] = *(const vf4*)(Z + m * NINP + Z_GLK + h * 64 + lc); \
        pre[2] = *(const vf4*)(A + m * 256 + h * 64 + lc);           pre[3] = *(const vf4*)(Z + m * NINP + Z_GLV + h * 128 + es * 64 + lc); } while (0)
#define GLA_WRITE() do { *(vf4*)(sq + ls * 64 + lc) = pre[0] * 0.125f; *(vf4*)(sk + ls * 64 + lc) = pre[1]; *(vf4*)(sa + ls * 64 + lc) = pre[2]; *(vf4*)(sv + ls * 64 + lc) = pre[3]; } while (0)
    __syncthreads();
    GLA_LOAD(0); GLA_WRITE(); __syncthreads();
    for (int c = 0; c < nch; ++c) {
        if (c + 1 < nch) GLA_LOAD(c + 1);
        vf4 q0 = *(const vf4*)(sq + dg * 8), q1 = *(const vf4*)(sq + dg * 8 + 4), k0 = *(const vf4*)(sk + dg * 8), k1 = *(const vf4*)(sk + dg * 8 + 4);
        vf4 a0 = *(const vf4*)(sa + dg * 8), a1 = *(const vf4*)(sa + dg * 8 + 4); float ve = sv[el];
#pragma unroll 2
        for (int s = 0; s < TC; ++s) {
            const int sn = (s + 1) & (TC - 1);
            const vf4 nq0 = *(const vf4*)(sq + sn * 64 + dg * 8), nq1 = *(const vf4*)(sq + sn * 64 + dg * 8 + 4), nk0 = *(const vf4*)(sk + sn * 64 + dg * 8), nk1 = *(const vf4*)(sk + sn * 64 + dg * 8 + 4);
            const vf4 na0 = *(const vf4*)(sa + sn * 64 + dg * 8), na1 = *(const vf4*)(sa + sn * 64 + dg * 8 + 4); const float nve = sv[sn * 64 + el];
            const vf2 v2 = (vf2){ve, ve};
            S[0] = a0.xy * S[0] + k0.xy * v2; S[1] = a0.zw * S[1] + k0.zw * v2; S[2] = a1.xy * S[2] + k1.xy * v2; S[3] = a1.zw * S[3] + k1.zw * v2;
            vf2 acc0 = q0.xy * S[0], acc1 = q0.zw * S[1]; acc0 += q1.xy * S[2]; acc1 += q1.zw * S[3];
            acc0 += acc1;
            const float po = red8(acc0.x + acc0.y);
            if (dg == 0) so[s * 64 + el] = po;
            q0 = nq0; q1 = nq1; k0 = nk0; k1 = nk1; a0 = na0; a1 = na1; ve = nve;
        }
        __syncthreads();
        { const int ti = c * TC + ls, tt = dir ? T - 1 - ti : ti; *(vf4*)(O + (m0 + tt) * 512 + h * 128 + es * 64 + lc) = *(const vf4*)(so + ls * 64 + lc); }
        if (c + 1 < nch) GLA_WRITE();
        __syncthreads();
    }
#undef GLA_LOAD
#undef GLA_WRITE
    if (ctx) {
        float* so_ = p.out + O_SGLA + (((((size_t)b * DEPTH + l) * 2 + dir) * 4 + h) * 64 + dg * 8) * 128 + es * 64 + el;
#pragma unroll
        for (int i = 0; i < 4; ++i) { so_[(size_t)(2 * i) * 128] = S[i].x; so_[(size_t)(2 * i + 1) * 128] = S[i].y; }
    }
}

__device__ __forceinline__ void gdn_chain(const Params& p, int l, bool ctx, int b, int h, int dir, int es, float* smem) {
    constexpr int TC = 32;
    const int tid = opaque_tid(), el = tid >> 3, dg = tid & 7;
    const int T = ctx ? CT : LT; const size_t m0 = ctx ? (size_t)b * CT : (size_t)MC + (size_t)b * LT;
    const float* DQ = WSP(float, WS_DQ); const float* DK = WSP(float, WS_DK); const float* DV = WSP(float, WS_DV); const float* DBA = WSP(float, WS_DBA);
    float* O = WSP(float, dir ? WS_DOB : WS_DOF);
    float* sq = smem; float* sk = sq + TC * 128; float* sv = sk + TC * 128; float* so = sv + TC * 64; float* sba = so + TC * 64; float* sqk = sba + TC * 2;
    vf2 S[8];
    {
        const int e = es * 64 + el;
        if (ctx) {
#pragma unroll
            for (int i = 0; i < 8; ++i) S[i] = (vf2){0.f, 0.f};
        } else {
            const float* s0 = p.in[I_SGDN] + (((((size_t)b * DEPTH + l) * 2 + dir) * 4 + h) * 128 + dg * 16) * 128 + e;
#pragma unroll
            for (int i = 0; i < 8; ++i) S[i] = (vf2){s0[(size_t)(2 * i) * 128], s0[(size_t)(2 * i + 1) * 128]};
        }
    }
    vf4 pre[5]; float pre_s = 0.f;
    const int nch = T / TC;
    const int ls = tid >> 5, lc = (tid & 31) * 4, vs = tid >> 4, vc = (tid & 15) * 4;
#define TOK(c, s_) (m0 + (dir ? T - 1 - ((c) * TC + (s_)) : (c) * TC + (s_)))
#define GDN_LOAD(c) do { const size_t ma = TOK(c, ls), mb = TOK(c, ls + 16), mv = TOK(c, vs); \
        pre[0] = *(const vf4*)(DQ + ma * 512 + h * 128 + lc); pre[1] = *(const vf4*)(DQ + mb * 512 + h * 128 + lc); \
        pre[2] = *(const vf4*)(DK + ma * 512 + h * 128 + lc); pre[3] = *(const vf4*)(DK + mb * 512 + h * 128 + lc); \
        pre[4] = *(const vf4*)(DV + mv * 512 + h * 128 + es * 64 + vc); \
        if (tid < 2 * TC) pre_s = DBA[TOK(c, tid >> 1) * 16 + (tid & 1) * 8 + dir * 4 + h]; } while (0)
#define GDN_WRITE() do { *(vf4*)(sq + ls * 128 + lc) = pre[0]; *(vf4*)(sq + (ls + 16) * 128 + lc) = pre[1]; *(vf4*)(sk + ls * 128 + lc) = pre[2]; *(vf4*)(sk + (ls + 16) * 128 + lc) = pre[3]; \
        *(vf4*)(sv + vs * 64 + vc) = pre[4]; if (tid < 2 * TC) sba[tid] = pre_s; } while (0)
    __syncthreads();
    GDN_LOAD(0); GDN_WRITE(); __syncthreads();
    for (int c = 0; c < nch; ++c) {
        if (c + 1 < nch) GDN_LOAD(c + 1);
        {
            const int s = tid >> 4, part = tid & 15;
            const vf4 x0 = *(const vf4*)(sq + s * 128 + part * 8), x1 = *(const vf4*)(sq + s * 128 + part * 8 + 4), y0 = *(const vf4*)(sk + s * 128 + part * 8), y1 = *(const vf4*)(sk + s * 128 + part * 8 + 4);
            const vf4 pr = x0 * y0 + x1 * y1;
            const float d = red16((pr.x + pr.y) + (pr.z + pr.w));
            if (part == 0) sqk[s] = d;
        }
        __syncthreads();
        vf4 kk[4], qq[4]; float ve, be, a, qk;
#pragma unroll
        for (int i = 0; i < 4; ++i) { kk[i] = *(const vf4*)(sk + dg * 16 + 4 * i); qq[i] = *(const vf4*)(sq + dg * 16 + 4 * i); }
        ve = sv[el]; be = sba[0]; a = sba[1]; qk = sqk[0];
#pragma unroll 2
        for (int s = 0; s < TC; ++s) {
            const int sn = (s + 1) & (TC - 1);
            vf4 nk[4], nq[4];
#pragma unroll
            for (int i = 0; i < 4; ++i) { nk[i] = *(const vf4*)(sk + sn * 128 + dg * 16 + 4 * i); nq[i] = *(const vf4*)(sq + sn * 128 + dg * 16 + 4 * i); }
            const float nve = sv[sn * 64 + el], nbe = sba[2 * sn], na = sba[2 * sn + 1], nqk = sqk[sn];
            vf2 ak0 = kk[0].xy * S[0], ak1 = kk[0].zw * S[1], aq0 = qq[0].xy * S[0], aq1 = qq[0].zw * S[1];
#pragma unroll
            for (int i = 1; i < 4; ++i) { ak0 += kk[i].xy * S[2 * i]; ak1 += kk[i].zw * S[2 * i + 1]; aq0 += qq[i].xy * S[2 * i]; aq1 += qq[i].zw * S[2 * i + 1]; }
            ak0 += ak1; aq0 += aq1;
            const float uk = red8(ak0.x + ak0.y), uq = red8(aq0.x + aq0.y);
            const float vn = be * (ve - a * uk);
            const float po = a * uq + qk * vn;
            const vf2 a2 = (vf2){a, a}, vn2 = (vf2){vn, vn};
#pragma unroll
            for (int i = 0; i < 4; ++i) { S[2 * i] = a2 * S[2 * i] + kk[i].xy * vn2; S[2 * i + 1] = a2 * S[2 * i + 1] + kk[i].zw * vn2; }
            if (dg == 0) so[s * 64 + el] = po;
#pragma unroll
            for (int i = 0; i < 4; ++i) { kk[i] = nk[i]; qq[i] = nq[i]; }
            ve = nve; be = nbe; a = na; qk = nqk;
        }
        __syncthreads();
        *(vf4*)(O + TOK(c, vs) * 512 + h * 128 + es * 64 + vc) = *(const vf4*)(so + vs * 64 + vc);
        if (c + 1 < nch) GDN_WRITE();
        __syncthreads();
    }
#undef GDN_LOAD
#undef GDN_WRITE
#undef TOK
    if (ctx) {
        float* so_ = p.out + O_SGDN + (((((size_t)b * DEPTH + l) * 2 + dir) * 4 + h) * 128 + dg * 16) * 128 + es * 64 + el;
#pragma unroll
        for (int i = 0; i < 8; ++i) { so_[(size_t)(2 * i) * 128] = S[i].x; so_[(size_t)(2 * i + 1) * 128] = S[i].y; }
    }
}

__device__ __forceinline__ void phase_post(const Params& p, int l) {
    const int tid = opaque_tid(), lane = tid & 63, wv = tid >> 6;
    const float* Z = WSP(float, WS_Z); bf16_t* MRG = WSP(bf16_t, WS_MRG);
    const float* wg = p.in[I_GLAON] + (size_t)l * 128; const float* wd = p.in[I_GDNON] + (size_t)l * 128;
    for (int m = blockIdx.x * 8 + wv; m < M; m += gridDim.x * 8) {
        const float* z = Z + (size_t)m * NINP;
#pragma unroll
        for (int g = 0; g < 2; ++g) {
            const float* of = WSP(float, g ? WS_DOF : WS_GOF) + (size_t)m * 512; const float* ob = WSP(float, g ? WS_DOB : WS_GOB) + (size_t)m * 512;
            const float* w = g ? wd : wg; const int zg = g ? Z_DZ : Z_GLR, mc = g ? 1536 : 512;
#pragma unroll
            for (int h = 0; h < 4; ++h) {
                const float a = of[h * 128 + lane] + ob[h * 128 + lane], c = of[h * 128 + 64 + lane] + ob[h * 128 + 64 + lane];
                const float r = 1.0f / sqrtf(wave_sum(a * a + c * c) * (1.0f / 128) + EPS);
                bf16_t* o = MRG + (size_t)m * DM + mc + h * 128;
                o[lane] = f2bf(a * r * w[lane] * silu_f(z[zg + h * 128 + lane]));
                o[64 + lane] = f2bf(c * r * w[64 + lane] * silu_f(z[zg + h * 128 + 64 + lane]));
            }
        }
    }
}
#define XB_TMO      128
#define XB_XCNT(j)  (256  + 64 * (j))
#define XB_XSUB(j)  (1280 + 64 * (j))
#define XB_XGEN(j)  (2304 + 64 * (j))
#define XB_TOP      3328
#define XB_TOPGEN   3392
#define XCD_BAR_WORDS 3456
#define XB_SPIN_CAP (1u << 22)
#define LAS __attribute__((address_space(3)))

__device__ __forceinline__ unsigned xb_ld(unsigned* p)              { return __hip_atomic_load(p, __ATOMIC_RELAXED, __HIP_MEMORY_SCOPE_AGENT); }
__device__ __forceinline__ unsigned xb_add(unsigned* p, unsigned v) { return __hip_atomic_fetch_add(p, v, __ATOMIC_RELAXED, __HIP_MEMORY_SCOPE_AGENT); }
__device__ __forceinline__ unsigned xb_xcc_id() { return (unsigned)__builtin_amdgcn_s_getreg((3 << 11) | 20) & 0xFu; }
#define XB_SPIN(cond, bar) do { unsigned _sp = 0; while (cond) { __builtin_amdgcn_s_sleep(1); \
    if ((++_sp & 255u) == 0u) { if (xb_ld(&(bar)[XB_TMO])) break; if (_sp > XB_SPIN_CAP) { atomicAdd(&(bar)[XB_TMO], 1u); break; } } } } while (0)

struct XcdBarrier {
    unsigned* bar; unsigned x;
    volatile LAS unsigned* st;
};

__device__ __forceinline__ XcdBarrier xcd_barrier_post(unsigned* bar, volatile LAS unsigned* st) {
    XcdBarrier b; b.bar = bar; b.x = xb_xcc_id(); b.st = st;
    if (threadIdx.x == 0) (void)xb_add(&bar[XB_XCNT(b.x)], 1u);
    return b;
}
__device__ __forceinline__ void xcd_barrier_complete(unsigned* bar, unsigned x, unsigned& nloc, unsigned& nx) {
    const unsigned G = gridDim.x * gridDim.y * gridDim.z;
    unsigned sum, cnt, mine, sp = 0u;
    for (;;) {
        sum = 0u; cnt = 0u; mine = 0u;
#pragma unroll
        for (unsigned j = 0; j < 16; ++j) { const unsigned c = xb_ld(&bar[XB_XCNT(j)]); sum += c; cnt += (c > 0u) ? 1u : 0u; mine = (j == x) ? c : mine; }
        if (sum == G) break;
        __builtin_amdgcn_s_sleep(1);
        if ((++sp & 255u) == 0u) { if (xb_ld(&bar[XB_TMO])) break; if (sp > XB_SPIN_CAP) { atomicAdd(&bar[XB_TMO], 1u); break; } }
    }
    nloc = mine > 0u ? mine : 1u; nx = cnt > 0u ? cnt : 1u;
}

__device__ __forceinline__ void xcd_barrier(const XcdBarrier& b) {
    asm volatile("s_waitcnt vmcnt(0)" ::: "memory");
    __syncthreads();
    if (threadIdx.x == 0) {
        unsigned* bar = b.bar;
        __builtin_amdgcn_s_waitcnt(0);
        unsigned nloc = b.st[0], nx = b.st[1];
        if (nloc == 0u) { xcd_barrier_complete(bar, b.x, nloc, nx); b.st[0] = nloc; b.st[1] = nx; }
        const unsigned old = xb_add(&bar[XB_XSUB(b.x)], 1u);
        const unsigned gen = old / nloc;
        if (old + 1u == (gen + 1u) * nloc) {
            __builtin_amdgcn_fence(__ATOMIC_RELEASE, "agent");
            asm volatile("s_waitcnt vmcnt(0)" ::: "memory");
            const unsigned og = xb_add(&bar[XB_TOP], 1u);
            const unsigned tg = og / nx;
            if (og + 1u == (tg + 1u) * nx) xb_add(&bar[XB_TOPGEN], 1u);
            else XB_SPIN(xb_ld(&bar[XB_TOPGEN]) == tg, bar);
            __builtin_amdgcn_fence(__ATOMIC_ACQUIRE, "agent");
            xb_add(&bar[XB_XGEN(b.x)], 1u);
            asm volatile("s_waitcnt vmcnt(0)" ::: "memory");
        } else {
            XB_SPIN(xb_ld(&bar[XB_XGEN(b.x)]) == gen, bar);
            __builtin_amdgcn_fence(__ATOMIC_ACQUIRE, "agent");
            asm volatile("s_waitcnt vmcnt(0)" ::: "memory");
        }
    }
    __syncthreads();
}

namespace pg8 {
#define PG8_LAS __attribute__((address_space(3)))
typedef unsigned short bf16_t;
typedef short bf16x8 __attribute__((ext_vector_type(8)));
typedef float f32x4 __attribute__((ext_vector_type(4)));
typedef unsigned u32x4 __attribute__((ext_vector_type(4)));
constexpr int BM = 256, BK = 64, HALF = 128, HTB = HALF * BK * 2  , STAGE_BYTES = 8 * HTB, NXCD = 8, WGM = 8;

__host__ __device__ __forceinline__ int lds_byte(int r, int c) { const int st = (r >> 4) * 2 + (c >> 5), rr = r & 15, cc = c & 31, ob = rr * 64 + cc * 2; return st * 1024 + (ob ^ (((ob >> 9) & 1) << 5)); }
__host__ __device__ __forceinline__ void stage_rc(int b, int& R, int& C) { const int st = b / 1024, sb = b % 1024, swz = sb ^ (((sb >> 9) & 1) << 5); R = (st >> 1) * 16 + swz / 64; C = (st & 1) * 32 + (swz % 64) / 2; }
__host__ __device__ __forceinline__ int perm32(int rho) { const int n = rho >> 4, i = rho & 15; return 8 * (i >> 2) + 4 * n + (i & 3); }

struct Unit { int pm, pn; };
struct Gemm { const bf16_t* A; const bf16_t* Bt; int M, N, K; };

struct StaticOrder {
    int nM, nN, nwg, G, c;
    __host__ __device__ void init(int M, int N, int G_, int c_) { nM = M / BM; nN = N / BM; nwg = nM * nN; G = G_; c = c_; }
    __host__ __device__ bool next(int i, Unit& u) const {
        const long L = (long)i * G + c; if (L >= nwg) return false;
        int wgid = (int)L; { const int q = nwg / NXCD, r = nwg % NXCD, xcd = wgid % NXCD, off = wgid / NXCD; wgid = (xcd < r ? xcd * (q + 1) : r * (q + 1) + (xcd - r) * q) + off; }
        const int nig = WGM * nN, gid = wgid / nig, fm = gid * WGM, gsz = (nM - fm) < WGM ? (nM - fm) : WGM;
        u.pm = fm + ((wgid % nig) % gsz); u.pn = (wgid % nig) / gsz; return true;
    }
    __device__ __forceinline__ void a_ready(const Unit&) const {}
    __device__ __forceinline__ void done(const Unit&) const {}
};
__device__ __forceinline__ unsigned cvt_pk_bf16(float lo, float hi) { unsigned r; asm volatile("v_cvt_pk_bf16_f32 %0, %1, %2" : "=v"(r) : "v"(lo), "v"(hi)); return r; }
struct EpiF32 {
    static constexpr bool PERM = false, AFTER_DRAIN = false;
    float* C; int ldc; const float* bias;
    __device__ __forceinline__ void operator()(const f32x4 (&acc)[2][2][4][2], const Unit& u, int wr, int wc, int fr, int fq) const {
        const int row0 = u.pm * BM + wr * 64 + fr, col0 = u.pn * BM + wc * 32 + 4 * fq;
        f32x4 bv[2][2];
#pragma unroll
        for (int bj = 0; bj < 2; ++bj)
#pragma unroll
            for (int n = 0; n < 2; ++n) bv[bj][n] = bias ? *(const f32x4*)(bias + col0 + bj * HALF + n * 16) : (f32x4){0.f, 0.f, 0.f, 0.f};
#pragma unroll
        for (int ai = 0; ai < 2; ++ai)
#pragma unroll
            for (int m = 0; m < 4; ++m) { float* rowp = C + (size_t)(row0 + ai * HALF + m * 16) * ldc + col0;
#pragma unroll
                for (int bj = 0; bj < 2; ++bj)
#pragma unroll
                    for (int n = 0; n < 2; ++n) *(f32x4*)(rowp + bj * HALF + n * 16) = acc[ai][bj][m][n] + bv[bj][n]; }
    }
};

struct EpiSwiGLU {
    static constexpr bool PERM = true, AFTER_DRAIN = false;
    bf16_t* O; int ldc;
    __device__ __forceinline__ void operator()(const f32x4 (&acc)[2][2][4][2], const Unit& u, int wr, int wc, int fr, int fq) const {
        const int row0 = u.pm * BM + wr * 64 + fr, col0 = u.pn * 128 + wc * 32 + 8 * fq;
#pragma unroll
        for (int ai = 0; ai < 2; ++ai)
#pragma unroll
            for (int m = 0; m < 4; ++m) { bf16_t* rowp = O + (size_t)(row0 + ai * HALF + m * 16) * ldc + col0;
                const f32x4 g0 = acc[ai][0][m][0], g1 = acc[ai][0][m][1], u0 = acc[ai][1][m][0], u1 = acc[ai][1][m][1];
                float r[8];
#pragma unroll
                for (int j = 0; j < 4; ++j) {
                    r[j]     = g0[j] * __builtin_amdgcn_rcpf(1.0f + __builtin_amdgcn_exp2f(-1.4426950408889634f * g0[j])) * u0[j];
                    r[4 + j] = g1[j] * __builtin_amdgcn_rcpf(1.0f + __builtin_amdgcn_exp2f(-1.4426950408889634f * g1[j])) * u1[j]; }
                u32x4 w; w.x = cvt_pk_bf16(r[0], r[1]); w.y = cvt_pk_bf16(r[2], r[3]); w.z = cvt_pk_bf16(r[4], r[5]); w.w = cvt_pk_bf16(r[6], r[7]);
                *(u32x4*)rowp = w; }
    }
};
struct EpiResid {
    static constexpr bool PERM = false, AFTER_DRAIN = false;
    const float* res; float* out; int ldc; const float* gate0; float coef;
    __device__ __forceinline__ void operator()(const f32x4 (&acc)[2][2][4][2], const Unit& u, int wr, int wc, int fr, int fq) const {
        const int row0 = u.pm * BM + wr * 64 + fr, col0 = u.pn * BM + wc * 32 + 4 * fq;
        const float* gate = gate0 + (size_t)cond_of_row(u.pm * BM) * NMOD;
        f32x4 gv[2][2];
#pragma unroll
        for (int bj = 0; bj < 2; ++bj)
#pragma unroll
            for (int n = 0; n < 2; ++n) gv[bj][n] = *(const f32x4*)(gate + col0 + bj * HALF + n * 16) * coef;
#pragma unroll
        for (int ai = 0; ai < 2; ++ai)
#pragma unroll
            for (int m = 0; m < 4; ++m) { const size_t off = (size_t)(row0 + ai * HALF + m * 16) * ldc + col0;
#pragma unroll
                for (int bj = 0; bj < 2; ++bj)
#pragma unroll
                    for (int n = 0; n < 2; ++n) { const f32x4 bs = *(const f32x4*)(res + off + bj * HALF + n * 16); *(f32x4*)(out + off + bj * HALF + n * 16) = bs + gv[bj][n] * acc[ai][bj][m][n]; }
                asm volatile("" ::: "memory"); }
    }
};
template <class Epi, class Sched, bool STAMP = false>
__device__ __forceinline__ void gemm_phase(PG8_LAS unsigned char* lds, const Gemm g, const Sched& S, const Epi& E, unsigned long long* stamps) {
    const int tid = opaque_tid(), wid = __builtin_amdgcn_readfirstlane(tid >> 6), lane = tid & 63, wr = wid >> 2, wc = wid & 3, fr = lane & 15, fq = lane >> 4;
    const int K = g.K, nt = K / BK;
    int ts_lo = 0, ts_hi = 0, nts = 0; const unsigned long long rt_entry = STAMP ? (unsigned long long)wall_clock64() : 0ull;
#define PG8_STAMP() do { if (STAMP && wid == 0 && nts < 64) { const unsigned long long _c = (unsigned long long)clock64(); \
        ts_lo = (lane == nts) ? (int)(unsigned)_c : ts_lo; ts_hi = (lane == nts) ? (int)(unsigned)(_c >> 32) : ts_hi; ++nts; } } while (0)
    PG8_STAMP();
    unsigned voffA[2], voffB[2];
#pragma unroll
    for (int i = 0; i < 2; ++i) { int R, C; stage_rc(tid * 16 + i * 8192, R, C); const int Rb = Epi::PERM ? ((R & ~31) + perm32(R & 31)) : R;
        voffA[i] = (unsigned)(R * K + C) * 2u; voffB[i] = (unsigned)(Rb * K + C) * 2u; }
    const size_t kstep = (size_t)(BK * 2);
    const size_t hstep = (size_t)HALF * K * 2;
    const size_t tstep = 2 * hstep;
    const unsigned ldsw = (unsigned)wid * 1024u;
    const int aoff = lds_byte(wr * 64 + fr, fq * 8), boff = lds_byte(wc * 32 + fr, fq * 8);
#define PG8_SA(b, h) (((b) * 2 + (h)) * HTB)
#define PG8_SB(b, h) ((4 + (b) * 2 + (h)) * HTB)
#define PG8_STAGE(bufoff, gbase, voff) do { _Pragma("unroll") for (int _i = 0; _i < 2; ++_i) \
        __builtin_amdgcn_global_load_lds((const unsigned*)((const char*)(gbase) + (voff)[_i]), (PG8_LAS unsigned*)(lds + (bufoff) + ldsw + _i * 8192), 16, 0, 0); } while (0)
#define PG8_LDA(dst, b, h) do { _Pragma("unroll") for (int m = 0; m < 4; ++m) _Pragma("unroll") for (int k = 0; k < 2; ++k) dst[m][k] = *(const PG8_LAS bf16x8*)(lds + PG8_SA(b, h) + aoff + m * 2048 + k * 1024); } while (0)
#define PG8_LDB(dst, b, h) do { _Pragma("unroll") for (int n = 0; n < 2; ++n) _Pragma("unroll") for (int k = 0; k < 2; ++k) dst[n][k] = *(const PG8_LAS bf16x8*)(lds + PG8_SB(b, h) + boff + n * 2048 + k * 1024); } while (0)
#define PG8_MMA(ai, bj, At, Bt) do { __builtin_amdgcn_s_setprio(1); _Pragma("unroll") for (int m = 0; m < 4; ++m) _Pragma("unroll") for (int n = 0; n < 2; ++n) _Pragma("unroll") for (int k = 0; k < 2; ++k) \
        acc[ai][bj][m][n] = __builtin_amdgcn_mfma_f32_16x16x32_bf16(Bt[n][k], At[m][k], acc[ai][bj][m][n], 0, 0, 0); __builtin_amdgcn_s_setprio(0); } while (0)
#define PG8_WAIT_V(n) asm volatile("s_waitcnt vmcnt(" #n ")" ::: "memory")
#define PG8_WAIT_L(n) asm volatile("s_waitcnt lgkmcnt(" #n ")" ::: "memory")
#define PG8_BAR __builtin_amdgcn_s_barrier()
#define PG8_SCHED __builtin_amdgcn_sched_barrier(0)
    Unit cur, nxt; int ui = 0;
    if (!S.next(0, cur)) return;
    f32x4 acc[2][2][4][2];
#pragma unroll
    for (int a = 0; a < 2; ++a)
#pragma unroll
        for (int b = 0; b < 2; ++b)
#pragma unroll
            for (int m = 0; m < 4; ++m)
#pragma unroll
                for (int n = 0; n < 2; ++n) acc[a][b][m][n] = (f32x4){0.f, 0.f, 0.f, 0.f};
    bf16x8 At[4][2], B0[2][2], B1[2][2];
    const char* cA = (const char*)g.A + (size_t)cur.pm * tstep; const char* cB = (const char*)g.Bt + (size_t)cur.pn * tstep;
    S.a_ready(cur);
    PG8_STAGE(PG8_SB(0, 0), cB, voffB); PG8_STAGE(PG8_SA(0, 0), cA, voffA); PG8_STAGE(PG8_SB(0, 1), cB + hstep, voffB); PG8_STAGE(PG8_SA(0, 1), cA + hstep, voffA);
    if (wr == 1) PG8_BAR;
    PG8_WAIT_V(4); PG8_BAR;
    PG8_STAGE(PG8_SB(1, 0), cB + kstep, voffB); PG8_STAGE(PG8_SA(1, 0), cA + kstep, voffA); PG8_STAGE(PG8_SB(1, 1), cB + hstep + kstep, voffB);
    PG8_WAIT_V(6); PG8_BAR;
    PG8_STAMP();
    for (;;) {
        const bool has_next = S.next(ui + 1, nxt);
        const char* nA = has_next ? (const char*)g.A + (size_t)nxt.pm * tstep : cA; const char* nB = has_next ? (const char*)g.Bt + (size_t)nxt.pn * tstep : cB;
        for (int t = 0; t < nt; t += 2) {
            const bool last = (t == nt - 2);
            const char* a1 = cA + (size_t)(t + 1) * kstep;
            const char* a2 = last ? nA : cA + (size_t)(t + 2) * kstep; const char* b2 = last ? nB : cB + (size_t)(t + 2) * kstep;
            const char* a3 = a2 + kstep; const char* b3 = b2 + kstep;
            if (last && has_next) S.a_ready(nxt);
            PG8_LDB(B0, 0, 0); PG8_SCHED; PG8_LDA(At, 0, 0); PG8_STAGE(PG8_SA(1, 1), a1 + hstep, voffA);
            PG8_WAIT_L(8); PG8_BAR; PG8_WAIT_L(0); PG8_MMA(0, 0, At, B0); PG8_BAR; PG8_SCHED;
            PG8_LDB(B1, 0, 1); PG8_STAGE(PG8_SB(0, 0), b2, voffB);
            PG8_BAR; PG8_WAIT_L(0); PG8_MMA(0, 1, At, B1); PG8_BAR;
            PG8_LDA(At, 0, 1); PG8_STAGE(PG8_SA(0, 0), a2, voffA);
            PG8_BAR; PG8_WAIT_L(0); PG8_MMA(1, 0, At, B0); PG8_BAR; PG8_SCHED;
            PG8_STAGE(PG8_SB(0, 1), b2 + hstep, voffB);
            PG8_WAIT_V(6); PG8_BAR; PG8_MMA(1, 1, At, B1); PG8_BAR;
            PG8_LDB(B0, 1, 0); PG8_SCHED; PG8_LDA(At, 1, 0); PG8_STAGE(PG8_SA(0, 1), a2 + hstep, voffA);
            PG8_WAIT_L(8); PG8_BAR; PG8_WAIT_L(0); PG8_MMA(0, 0, At, B0); PG8_BAR; PG8_SCHED;
            PG8_LDB(B1, 1, 1); PG8_STAGE(PG8_SB(1, 0), b3, voffB);
            PG8_BAR; PG8_WAIT_L(0); PG8_MMA(0, 1, At, B1); PG8_BAR;
            PG8_LDA(At, 1, 1); PG8_STAGE(PG8_SA(1, 0), a3, voffA);
            PG8_BAR; PG8_WAIT_L(0); PG8_MMA(1, 0, At, B0); PG8_BAR; PG8_SCHED;
            PG8_STAGE(PG8_SB(1, 1), b3 + hstep, voffB);
            PG8_WAIT_V(6); PG8_BAR; PG8_MMA(1, 1, At, B1); PG8_BAR;
        }
        PG8_STAMP();
        if constexpr (!Epi::AFTER_DRAIN) { E(acc, cur, wr, wc, fr, fq); S.done(cur); }
        PG8_STAMP();
        if (!has_next) break;
#pragma unroll
        for (int a = 0; a < 2; ++a)
#pragma unroll
            for (int b = 0; b < 2; ++b)
#pragma unroll
                for (int m = 0; m < 4; ++m)
#pragma unroll
                    for (int n = 0; n < 2; ++n) acc[a][b][m][n] = (f32x4){0.f, 0.f, 0.f, 0.f};
        cur = nxt; cA = nA; cB = nB; ++ui;
    }
    PG8_WAIT_V(0);
    if (wr == 0) PG8_BAR;
    PG8_BAR;
    if constexpr (Epi::AFTER_DRAIN) { E.fused(acc, cur, wr, wc, fr, fq, lds, wid, lane); S.done(cur); }
    PG8_STAMP();
    if (STAMP && wid == 0) { stamps[lane] = lane < nts ? (((unsigned long long)(unsigned)ts_hi << 32) | (unsigned)ts_lo) : 0ull;
        if (lane == 62) stamps[62] = rt_entry; if (lane == 63) stamps[63] = (unsigned long long)wall_clock64(); }
#undef PG8_STAMP
#undef PG8_SA
#undef PG8_SB
#undef PG8_STAGE
#undef PG8_LDA
#undef PG8_LDB
#undef PG8_MMA
#undef PG8_WAIT_V
#undef PG8_WAIT_L
#undef PG8_BAR
#undef PG8_SCHED
}
}
#ifndef ATT_INLINE
#define ATT_INLINE __forceinline__
#endif
namespace att {
constexpr int D = 128, NW = 8, QBLK = 32, KVBLK = 64, LDQ = 512, LDO = DM;
constexpr float SCALE = 0.088388347648318440f;
constexpr float THR = 8.f;
constexpr size_t SHM_V = KVBLK * D * 2, SHM_K = KVBLK * D * 2, SHM_Q = 256 * D * 2, SHM_ATTN = 2 * SHM_V + 2 * SHM_K + NW * 64 * 4 + SHM_Q;
using bf16x8 = __attribute__((ext_vector_type(8))) short;
using s16x4  = __attribute__((ext_vector_type(4))) short;
using f32x16 = __attribute__((ext_vector_type(16))) float;
using u32x4  = __attribute__((ext_vector_type(4))) unsigned;
#define KSWZ(row, colB) ((row) * 256 + ((colB) ^ (((row) & 7) << 4)))
#define SBAR() __builtin_amdgcn_sched_barrier(0)
__device__ __forceinline__ int crow(int r, int hi) { return (r & 3) + 8 * (r >> 2) + 4 * hi; }
__device__ __forceinline__ unsigned cvtpk(float lo, float hi) { unsigned r; asm volatile("v_cvt_pk_bf16_f32 %0, %1, %2" : "=v"(r) : "v"(lo), "v"(hi)); return r; }

__device__ __forceinline__ void partialSM(f32x16& p0, f32x16& p1, float& m_reg, float& mn, float& alpha) {
  constexpr float C = SCALE * 1.4426950408889634f;
  float pmax = p0[0]; for (int r = 1; r < 16; ++r) pmax = fmaxf(pmax, p0[r]); for (int r = 0; r < 16; ++r) pmax = fmaxf(pmax, p1[r]);
  { auto rr = __builtin_amdgcn_permlane32_swap(__float_as_uint(pmax), __float_as_uint(pmax), false, false);
    pmax = fmaxf(__uint_as_float(rr[0]), __uint_as_float(rr[1])); }
  if (__builtin_expect(__all(pmax - m_reg <= THR / SCALE), 1)) { mn = m_reg; alpha = 1.f; }
  else { mn = fmaxf(m_reg, pmax); alpha = __builtin_amdgcn_exp2f((m_reg - mn) * C); m_reg = mn; }
  float mnC = -mn * C;
  for (int r = 0; r < 16; ++r) p0[r] = fmaf(p0[r], C, mnC); for (int r = 0; r < 16; ++r) p1[r] = fmaf(p1[r], C, mnC);
  for (int r = 0; r < 16; ++r) p0[r] = __builtin_amdgcn_exp2f(p0[r]);
}
__device__ __forceinline__ void finishSM(f32x16& p0, f32x16& p1, float alpha, float& l_reg, bf16x8& pa0, bf16x8& pa1, bf16x8& pa2, bf16x8& pa3) {
  for (int r = 0; r < 16; ++r) p1[r] = __builtin_amdgcn_exp2f(p1[r]);
  float ps = 0; for (int r = 0; r < 16; ++r) ps += p0[r]; for (int r = 0; r < 16; ++r) ps += p1[r];
  { auto rr = __builtin_amdgcn_permlane32_swap(__float_as_uint(ps), __float_as_uint(ps), false, false);
    ps = __uint_as_float(rr[0]) + __uint_as_float(rr[1]); }
  l_reg = l_reg * alpha + ps;
#define PK4(P, BASE, OUT) do { unsigned a0 = cvtpk(P[BASE + 0], P[BASE + 1]), a1 = cvtpk(P[BASE + 2], P[BASE + 3]);   \
    unsigned b0 = cvtpk(P[BASE + 4], P[BASE + 5]), b1 = cvtpk(P[BASE + 6], P[BASE + 7]);                              \
    auto r0 = __builtin_amdgcn_permlane32_swap(a0, b0, false, false); auto r1 = __builtin_amdgcn_permlane32_swap(a1, b1, false, false); \
    u32x4 w = {r0[0], r1[0], r0[1], r1[1]}; OUT = *reinterpret_cast<bf16x8*>(&w); } while (0)
  PK4(p0, 0, pa0); PK4(p0, 8, pa1); PK4(p1, 0, pa2); PK4(p1, 8, pa3);
#undef PK4
}
__device__ __forceinline__ void qkt(f32x16& p0, f32x16& p1, const bf16_t* Ks, const bf16_t* Qs, int qrow, int r32, int hi) {
  p0 = f32x16{}; p1 = f32x16{};
#pragma unroll
  for (int d0 = 0; d0 < 8; ++d0) { int cb = (d0 * 16 + hi * 8) * 2;
    bf16x8 q = *reinterpret_cast<const bf16x8*>((const char*)Qs + KSWZ(qrow, cb));
    bf16x8 b0 = *reinterpret_cast<const bf16x8*>((const char*)Ks + KSWZ(r32, cb));
    bf16x8 b1 = *reinterpret_cast<const bf16x8*>((const char*)Ks + KSWZ(32 + r32, cb));
    p0 = __builtin_amdgcn_mfma_f32_32x32x16_bf16(b0, q, p0, 0, 0, 0);
    p1 = __builtin_amdgcn_mfma_f32_32x32x16_bf16(b1, q, p1, 0, 0, 0); }
}
__device__ __forceinline__ int v_st(int k, int c) { const int kk = (k & ~0xC) | ((k & 4) << 1) | ((k & 8) >> 1); return ((kk >> 3) * 4 + (c >> 5)) * 512 + ((kk & 7) * 32 + (c & 31)) * 2; }
__device__ __forceinline__ int v_rd_base(int lane) { return ((lane & 3) << 3) | (((lane >> 2) & 3) << 6) | (((lane >> 4) & 1) << 5) | (((lane >> 5) & 1) << 8); }
constexpr int v_rd_off(int d0, int ks, int half) { return d0 * 512 + ks * 4096 + half * 2048; }
template <int OFF> __device__ __forceinline__ s16x4 tr_read(int vb) {
  s16x4 r; asm volatile("ds_read_b64_tr_b16 %0, %1 offset:%2" : "=&v"(r) : "v"(vb), "i"(OFF) : "memory"); return r;
}
template <int D0> __device__ __forceinline__ void pv_one(f32x16& od, int vb, bf16x8 pa0, bf16x8 pa1, bf16x8 pa2, bf16x8 pa3) {
  const s16x4 l0 = tr_read<v_rd_off(D0, 0, 0)>(vb), h0 = tr_read<v_rd_off(D0, 0, 1)>(vb), l1 = tr_read<v_rd_off(D0, 1, 0)>(vb), h1 = tr_read<v_rd_off(D0, 1, 1)>(vb);
  const s16x4 l2 = tr_read<v_rd_off(D0, 2, 0)>(vb), h2 = tr_read<v_rd_off(D0, 2, 1)>(vb), l3 = tr_read<v_rd_off(D0, 3, 0)>(vb), h3 = tr_read<v_rd_off(D0, 3, 1)>(vb);
  asm volatile("s_waitcnt lgkmcnt(0)" ::: "memory"); SBAR();
#define PK(L, H) (bf16x8){L[0], L[1], L[2], L[3], H[0], H[1], H[2], H[3]}
  od = __builtin_amdgcn_mfma_f32_32x32x16_bf16(pa0, PK(l0, h0), od, 0, 0, 0);
  od = __builtin_amdgcn_mfma_f32_32x32x16_bf16(pa1, PK(l1, h1), od, 0, 0, 0);
  od = __builtin_amdgcn_mfma_f32_32x32x16_bf16(pa2, PK(l2, h2), od, 0, 0, 0);
  od = __builtin_amdgcn_mfma_f32_32x32x16_bf16(pa3, PK(l3, h3), od, 0, 0, 0);
#undef PK
}
__device__ __forceinline__ void pv_d0(f32x16* o, int vb, bf16x8 pa0, bf16x8 pa1, bf16x8 pa2, bf16x8 pa3) {
  pv_one<0>(o[0], vb, pa0, pa1, pa2, pa3); pv_one<1>(o[1], vb, pa0, pa1, pa2, pa3); pv_one<2>(o[2], vb, pa0, pa1, pa2, pa3); pv_one<3>(o[3], vb, pa0, pa1, pa2, pa3);
}

struct SrcOne { const bf16_t* k0; const bf16_t* v0; int ldk;
  __device__ __forceinline__ const bf16_t* k(int j) const { return k0 + (size_t)j * 64 * ldk; }
  __device__ __forceinline__ const bf16_t* v(int j) const { return v0 + (size_t)j * 64 * ldk; } };
struct SrcTwo { const bf16_t* ck; const bf16_t* cv; const bf16_t* k1; const bf16_t* v1; int ldk;
  __device__ __forceinline__ const bf16_t* k(int j) const { return j < 4 ? ck + (size_t)j * 64 * ldk : k1 + (size_t)(j - 4) * 64 * ldk; }
  __device__ __forceinline__ const bf16_t* v(int j) const { return j < 4 ? cv + (size_t)j * 64 * ldk : v1 + (size_t)(j - 4) * 64 * ldk; } };
struct NoBias { __device__ __forceinline__ void operator()(f32x16&, f32x16&, int, int, int, int) const {} };
struct NaBias { const float* tab; int i0, kr0;
  __device__ __forceinline__ void operator()(f32x16& p0, f32x16& p1, int jt, int wid, int r32, int hi) const {
    if (jt < 4) return;
    const int qi = i0 + wid * QBLK + r32, r = qi >> 6, qc = qi & 63, kr = kr0 + jt - 4;
    int lo = r - 4; lo = lo < 0 ? 0 : (lo > 8 ? 8 : lo);
    const bool rowok = (kr >= lo) && (kr < lo + 8);
    if (!rowok) {
#pragma unroll
      for (int rr = 0; rr < 16; ++rr) { p0[rr] = -1e30f; p1[rr] = -1e30f; }
      return;
    }
    int c0 = qc - 8; c0 = c0 < 0 ? 0 : (c0 > 48 ? 48 : c0);
    const int dr = kr - r + 7;
    const float* tb = tab + dr * 31 + (4 * hi - qc + 15);
    const int w0 = 4 * hi - c0;
#pragma unroll
    for (int g = 0; g < 4; ++g) {
#pragma unroll
      for (int q = 0; q < 4; ++q) {
        const int rr = 4 * g + q, kc0 = q + 8 * g;
        const float t0 = tb[kc0], t1 = tb[kc0 + 32];
        p0[rr] = ((unsigned)(kc0 + w0) < 16u) ? p0[rr] + t0 : -1e30f;
        p1[rr] = ((unsigned)(kc0 + 32 + w0) < 16u) ? p1[rr] + t1 : -1e30f;
      }
      SBAR();
    }
  } };

template <int SD, class Src, class Bias>
__device__ ATT_INLINE void attn_body(const bf16_t* __restrict__ Qb, const Src src, bf16_t* __restrict__ Ob, const int NT, char* lds, const Bias bias) {
  const int tid = opaque_tid(), wid = tid >> 6, lane = tid & 63, r32 = lane & 31, hi = lane >> 5;
  const int LDK = src.ldk;
  bf16_t* V_lds = (bf16_t*)lds; bf16_t* K_lds = (bf16_t*)(lds + 2 * SHM_V);
  float* ws = (float*)(lds + 2 * SHM_V + 2 * SHM_K) + wid * 64; float* li_l = ws; float* al_l = ws + 32;
  float m_reg = -1e30f, l_reg = 0; f32x16 o[4] = {};
  bf16_t* Q_lds = (bf16_t*)(lds + 2 * SHM_V + 2 * SHM_K + NW * 64 * 4);
  const int qrow = wid * QBLK + r32;
  {
#pragma unroll
    for (int i = 0; i < 8; ++i) { const int f = tid + 512 * i, row = f >> 4, c8 = (f & 15) * 8;
      *(bf16x8*)((char*)Q_lds + KSWZ(row, c8 * 2)) = *reinterpret_cast<const bf16x8*>(Qb + (long)row * LDQ + c8); }
  }
  const int sr = tid >> 4, sc = (tid & 15) * 8, vst0 = v_st(sr, sc), vst1 = v_st(32 + sr, sc);
  const int vb0 = (int)(uintptr_t)V_lds + v_rd_base(lane);
  struct { bf16x8 vs0, vs1, ks0, ks1; } sr_[SD];
#define SLOAD(i, jt) do { const bf16_t* kt_ = src.k(jt); const bf16_t* vt_ = src.v(jt); \
    sr_[i].vs0 = *reinterpret_cast<const bf16x8*>(&vt_[(long)sr * LDK + sc]); sr_[i].vs1 = *reinterpret_cast<const bf16x8*>(&vt_[(long)(32 + sr) * LDK + sc]); \
    sr_[i].ks0 = *reinterpret_cast<const bf16x8*>(&kt_[(long)sr * LDK + sc]); sr_[i].ks1 = *reinterpret_cast<const bf16x8*>(&kt_[(long)(32 + sr) * LDK + sc]); } while (0)
#define SWRITE(b, i) do { *(bf16x8*)((char*)V_lds + (b) * SHM_V + vst0) = sr_[i].vs0;          \
    *(bf16x8*)((char*)V_lds + (b) * SHM_V + vst1) = sr_[i].vs1; int kc = sc * 2;               \
    *(bf16x8*)((char*)K_lds + (b) * SHM_K + KSWZ(sr, kc)) = sr_[i].ks0;                       \
    *(bf16x8*)((char*)K_lds + (b) * SHM_K + KSWZ(32 + sr, kc)) = sr_[i].ks1; } while (0)
#define SWAIT() do { if constexpr (SD == 2) asm volatile("s_waitcnt vmcnt(4)" ::: "memory"); else asm volatile("s_waitcnt vmcnt(0)" ::: "memory"); } while (0)
#define RESC(a) do { if (__any((a) < 1.f)) { if (hi == 0) al_l[r32] = (a); asm volatile("s_waitcnt lgkmcnt(0)" ::: "memory"); \
    for (int d = 0; d < 4; ++d) for (int r = 0; r < 16; ++r) o[d][r] *= al_l[crow(r, hi)]; } } while (0)
  f32x16 pA0, pA1, pB0, pB1; float mnA, mnB, alA, alB; bf16x8 pa0, pa1, pa2, pa3;
  constexpr int SE = 0, SO = SD - 1;
  SLOAD(SE, 0); asm volatile("s_waitcnt vmcnt(0)" ::: "memory"); SWRITE(0, SE); __syncthreads();
  qkt(pA0, pA1, K_lds, Q_lds, qrow, r32, hi); bias(pA0, pA1, 0, wid, r32, hi); partialSM(pA0, pA1, m_reg, mnA, alA);
  SLOAD(SO, 1); if constexpr (SD == 2) { if (2 < NT) SLOAD(SE, 2); }
  SWAIT(); SWRITE(1, SO); __syncthreads();
  for (int j = 1; j + 1 < NT; j += 2) {
    SBAR(); qkt(pB0, pB1, (bf16_t*)((char*)K_lds + SHM_K), Q_lds, qrow, r32, hi); bias(pB0, pB1, j, wid, r32, hi);
    finishSM(pA0, pA1, alA, l_reg, pa0, pa1, pa2, pa3); SBAR();
    SLOAD(SO, j + SD); SBAR();
    pv_d0(o, vb0, pa0, pa1, pa2, pa3); partialSM(pB0, pB1, m_reg, mnB, alB);
    __syncthreads(); SWAIT(); SWRITE(0, SE);
    RESC(alB); __syncthreads();
    SBAR(); qkt(pA0, pA1, K_lds, Q_lds, qrow, r32, hi); bias(pA0, pA1, j + 1, wid, r32, hi);
    finishSM(pB0, pB1, alB, l_reg, pa0, pa1, pa2, pa3); SBAR();
    if (SD == 1 || j + 3 < NT) SLOAD(SE, j + 1 + SD); SBAR();
    pv_d0(o, vb0 + (int)SHM_V, pa0, pa1, pa2, pa3); partialSM(pA0, pA1, m_reg, mnA, alA);
    __syncthreads(); SWAIT(); SWRITE(1, SO);
    RESC(alA); __syncthreads();
  }
  SBAR(); qkt(pB0, pB1, (bf16_t*)((char*)K_lds + SHM_K), Q_lds, qrow, r32, hi); bias(pB0, pB1, NT - 1, wid, r32, hi);
  finishSM(pA0, pA1, alA, l_reg, pa0, pa1, pa2, pa3); SBAR();
  pv_d0(o, vb0, pa0, pa1, pa2, pa3); partialSM(pB0, pB1, m_reg, mnB, alB);
  __syncthreads(); RESC(alB);
  finishSM(pB0, pB1, alB, l_reg, pa0, pa1, pa2, pa3); SBAR();
  pv_d0(o, vb0 + (int)SHM_V, pa0, pa1, pa2, pa3);
  if (hi == 0) li_l[r32] = l_reg; asm volatile("s_waitcnt lgkmcnt(0)" ::: "memory");
  float rli[16];
#pragma unroll
  for (int r = 0; r < 16; ++r) rli[r] = __builtin_amdgcn_rcpf(li_l[crow(r, hi)]);
  bf16_t* Ow = Ob + (long)(wid * QBLK) * LDO;
#pragma unroll
  for (int r = 0; r < 16; ++r) { int orow = crow(r, hi);
    for (int d0 = 0; d0 < 4; ++d0) Ow[(long)orow * LDO + d0 * 32 + r32] = f2bf(o[d0][r] * rli[r]); }
#undef SLOAD
#undef SWRITE
#undef SWAIT
#undef RESC
}
}
#define LAS __attribute__((address_space(3)))
constexpr int LDS_BYTES = 147456, XBW_OFF = LDS_BYTES - 64;
constexpr int NPH = 1 + DEPTH * 12;
#ifndef DBG_NLAYERS
#define DBG_NLAYERS DEPTH
#endif

#ifndef DUPKIND
#define DUPKIND 0
#endif
__device__ __forceinline__ int opaque_int(int v) { asm volatile("" : "+s"(v)); return v; }
#ifndef MIXMASK
#define MIXMASK 0xFF
#endif
#define FOR_ITEMS(it, n, o, w) for (int bo_ = (o) * (int)gridDim.x / 256, bw_ = ((w) * (int)gridDim.x / 256) > 0 ? ((w) * (int)gridDim.x / 256) : 1, \
                                    it = ((int)blockIdx.x >= bo_ && (int)blockIdx.x < bo_ + bw_) ? (int)blockIdx.x - bo_ : (n); it < (n); it += bw_)

constexpr int QCTR_WORD0 = 1024;
constexpr int NI_GDNL = LB * 16, NI_GLAL = LB * 16, NI_GDNC = CB * 16, NI_GQAL = LB * 16, NI_NAL = LB * 16, NI_GLAC = CB * 16, NI_NAC = CB * 4, NI_GQAC = CB * 4;
constexpr int Q0 = NI_GDNL, Q1 = Q0 + NI_GLAL, Q2 = Q1 + NI_GDNC, Q3 = Q2 + NI_GQAL, Q4 = Q3 + NI_NAL, Q5 = Q4 + NI_GLAC, Q6 = Q5 + NI_NAC, Q7 = Q6 + NI_GQAC;
__device__ __forceinline__ void phase_mix(const Params& p, int l, unsigned char* lds) {
    const int tid = opaque_tid();
    float* smem = (float*)lds;
    const bf16_t* NAQ = WSP(bf16_t, WS_NAQ); const bf16_t* NAK = WSP(bf16_t, WS_NAK); const bf16_t* NAV = WSP(bf16_t, WS_NAV);
    const bf16_t* GQ = WSP(bf16_t, WS_GQ); const bf16_t* GK = WSP(bf16_t, WS_GK); const bf16_t* GV = WSP(bf16_t, WS_GV);
    bf16_t* MRG = WSP(bf16_t, WS_MRG);
    unsigned* qctr = WSP(unsigned, WS_CTL) + QCTR_WORD0 + 64 * l;
    volatile int* qslot = (volatile int*)(lds + XBW_OFF + 16);
    for (;;) {
        __syncthreads();
        if (tid == 0) *qslot = (int)__hip_atomic_fetch_add(qctr, 1u, __ATOMIC_RELAXED, __HIP_MEMORY_SCOPE_AGENT);
        __syncthreads();
        const int q = __builtin_amdgcn_readfirstlane(*qslot);
        if (q >= Q7) break;
        if (q < Q0) { const int it = q; gdn_chain(p, l, false, it / 16, (it / 4) % 4, (it / 2) % 2, it % 2, smem); }
        else if (q < Q1) { const int it = q - Q0; gla_chain(p, l, false, it / 16, (it / 4) % 4, (it / 2) % 2, it % 2, smem); }
        else if (q < Q2) { const int it = q - Q1; gdn_chain(p, l, true, it / 16, (it / 4) % 4, (it / 2) % 2, it % 2, smem); }
        else if (q < Q3) {
            const int it = q - Q2, b = it / 16, qh = (it / 4) % 4, qb = it % 4, kvh = qh >> 1;
            const size_t r0 = (size_t)MC + (size_t)b * LT;
            att::SrcTwo src{WSP(bf16_t, WS_CGK) + ((size_t)b * DEPTH + l) * 256 * 256 + kvh * 128, WSP(bf16_t, WS_CGV) + ((size_t)b * DEPTH + l) * 256 * 256 + kvh * 128,
                            GK + r0 * 256 + kvh * 128, GV + r0 * 256 + kvh * 128, 256};
            att::attn_body<2>(GQ + (r0 + qb * 256) * 512 + qh * 128, src, MRG + (r0 + qb * 256) * DM + 1024 + qh * 128, 4 + LT / 64, (char*)lds, att::NoBias{});
        }
        else if (q < Q4) {
            const int it = q - Q3, b = it / 16, h = (it / 4) % 4, qb = it % 4;
            const int kr0 = qb == 0 ? 0 : qb == 1 ? 0 : qb == 2 ? 4 : 8, nrows = (qb == 0 || qb == 3) ? 8 : 12;
            const size_t r0 = (size_t)MC + (size_t)b * LT;
            float* tab = (float*)(lds + att::SHM_ATTN);
            if (tid < 15 * 31) tab[tid] = p.in[I_RPB][((size_t)l * 4 + h) * 15 * 31 + tid] * (1.0f / att::SCALE);
            att::SrcTwo src{WSP(bf16_t, WS_CNAK) + ((size_t)b * DEPTH + l) * 256 * 512 + h * 128, WSP(bf16_t, WS_CNAV) + ((size_t)b * DEPTH + l) * 256 * 512 + h * 128,
                            NAK + (r0 + kr0 * 64) * 512 + h * 128, NAV + (r0 + kr0 * 64) * 512 + h * 128, 512};
            att::attn_body<1>(NAQ + (r0 + qb * 256) * 512 + h * 128, src, MRG + (r0 + qb * 256) * DM + 0 + h * 128, 4 + nrows, (char*)lds, att::NaBias{tab, qb * 256, kr0});
        }
        else if (q < Q5) { const int it = q - Q4; gla_chain(p, l, true, it / 16, (it / 4) % 4, (it / 2) % 2, it % 2, smem); }
        else if (q < Q6) {
            const int it = q - Q5, b = it / 4, h = it % 4; const size_t r0 = (size_t)b * CT;
            att::SrcOne src{NAK + r0 * 512 + h * 128, NAV + r0 * 512 + h * 128, 512};
            att::attn_body<2>(NAQ + r0 * 512 + h * 128, src, MRG + r0 * DM + 0 + h * 128, CT / 64, (char*)lds, att::NoBias{});
        }
        else {
            const int it = q - Q6, b = it / 4, qh = it % 4, kvh = qh >> 1; const size_t r0 = (size_t)b * CT;
            att::SrcOne src{GK + r0 * 256 + kvh * 128, GV + r0 * 256 + kvh * 128, 256};
            att::attn_body<2>(GQ + r0 * 512 + qh * 128, src, MRG + r0 * DM + 1024 + qh * 128, CT / 64, (char*)lds, att::NoBias{});
        }
    }
}

static_assert(att::SHM_ATTN + 15 * 31 * 4 + 2048 <= (size_t)XBW_OFF, "LDS map");
static_assert((QCTR_WORD0 + 64 * DEPTH) < 4096, "ctl");
constexpr int BAR_WORD0 = 4096;
static_assert((BAR_WORD0 + XCD_BAR_WORDS) * 4 <= (int)CTL_BYTES, "ctl");

__global__ void __launch_bounds__(512, 2) fwd(Params p) {
    extern __shared__ __attribute__((aligned(16))) unsigned char lds[];
    const int tid = threadIdx.x;
    volatile LAS unsigned* xbw = (volatile LAS unsigned*)((LAS unsigned char*)lds + XBW_OFF);
    if (tid < 4) xbw[tid] = 0u;
    __syncthreads();
    XcdBarrier bar; bar.bar = WSP(unsigned, WS_CTL) + BAR_WORD0; bar.x = 0; bar.st = xbw;
    if (p.ph_hi - p.ph_lo > 1) bar = xcd_barrier_post(WSP(unsigned, WS_CTL) + BAR_WORD0, xbw);
#ifndef PHMASK
#define PHMASK 0x1FFF
#endif
#define IN(k) (p.ph_lo <= (k) && (k) < p.ph_hi)
#define INL(j) (((PHMASK >> ((j) + 1)) & 1) && IN(pb + (j)))
#ifndef DUPMASK
#define DUPMASK 0
#endif
#define DUP(j) ((DUPMASK >> ((j) + 1)) & 1)
#define SEAM(k) do { if (IN(k) && IN((k) + 1)) xcd_barrier(bar); } while (0)
    LAS unsigned char* ldsl = (LAS unsigned char*)lds;
    bf16_t* H = WSP(bf16_t, WS_H); bf16_t* ACT = WSP(bf16_t, WS_ACT); float* X = WSP(float, WS_X); float* Z = WSP(float, WS_Z); bf16_t* MRG = WSP(bf16_t, WS_MRG);

    if ((PHMASK & 1) && IN(0)) { int reps_ = 1 + (DUPMASK & 1); asm volatile("" : "+s"(reps_)); for (int rep_ = 0; rep_ < reps_; ++rep_) { const Params q = opaque_params(p); phase_prologue(q, (float*)lds); __syncthreads(); } }
    SEAM(0);
    for (int l = 0; l < DBG_NLAYERS; ++l) {
        const int pb = 1 + l * 12;
        const float* modl = WSP(float, WS_MODV) + (size_t)l * NCOND * NMOD;
        if (INL(0)) { int reps_ = 1 + DUP(0); asm volatile("" : "+s"(reps_)); for (int rep_ = 0; rep_ < reps_; ++rep_) { const Params q = opaque_params(p); phase_norm(q, l, 0); __syncthreads(); } }
        SEAM(pb + 0);
        if (INL(1)) {
            pg8::Gemm g{H, WSP(bf16_t, WS_WGU) + ((size_t)l * 2 + 0) * NGU * DM, M, NGU, DM}; pg8::StaticOrder S; S.init(M, NGU, (int)gridDim.x, (int)blockIdx.x);
            pg8::EpiSwiGLU E{ACT, FF};
            for (int r_ = 0, n_ = opaque_int(1 + DUP(1)); r_ < n_; ++r_) pg8::gemm_phase<pg8::EpiSwiGLU, pg8::StaticOrder, false>(ldsl, g, S, E, nullptr);
        }
        SEAM(pb + 1);
        if (INL(2)) {
            pg8::Gemm g{ACT, WSP(bf16_t, WS_WDN) + ((size_t)l * 2 + 0) * DM * FF, M, DM, FF}; pg8::StaticOrder S; S.init(M, DM, (int)gridDim.x, (int)blockIdx.x);
            pg8::EpiResid E{X, X, DM, modl + 2 * DM, 0.5f};
            pg8::gemm_phase<pg8::EpiResid, pg8::StaticOrder, false>(ldsl, g, S, E, nullptr);
        }
        SEAM(pb + 2);
        if (INL(3)) { int reps_ = 1 + DUP(3); asm volatile("" : "+s"(reps_)); for (int rep_ = 0; rep_ < reps_; ++rep_) { const Params q = opaque_params(p); phase_norm(q, l, 1); __syncthreads(); } }
        SEAM(pb + 3);
        if (INL(4)) {
            pg8::Gemm g{H, WSP(bf16_t, WS_WIN) + (size_t)l * NINP * DM, M, NINP, DM}; pg8::StaticOrder S; S.init(M, NINP, (int)gridDim.x, (int)blockIdx.x);
            pg8::EpiF32 E{Z, NINP, nullptr};
            for (int r_ = 0, n_ = opaque_int(1 + DUP(4)); r_ < n_; ++r_) pg8::gemm_phase<pg8::EpiF32, pg8::StaticOrder, false>(ldsl, g, S, E, nullptr);
        }
        SEAM(pb + 4);
        if (INL(5)) { int reps_ = 1 + DUP(5); asm volatile("" : "+s"(reps_)); for (int rep_ = 0; rep_ < reps_; ++rep_) { const Params q = opaque_params(p); phase_prep(q, l); __syncthreads(); } }
        SEAM(pb + 5);
        if (INL(6)) { int reps_ = 1 + DUP(6); asm volatile("" : "+s"(reps_)); for (int rep_ = 0; rep_ < reps_; ++rep_) { const Params q = opaque_params(p); phase_mix(q, l, lds); __syncthreads(); } }
        SEAM(pb + 6);
        if (INL(7)) { int reps_ = 1 + DUP(7); asm volatile("" : "+s"(reps_)); for (int rep_ = 0; rep_ < reps_; ++rep_) { const Params q = opaque_params(p); phase_post(q, l); __syncthreads(); } }
        SEAM(pb + 7);
        if (INL(8)) {
            pg8::Gemm g{MRG, WSP(bf16_t, WS_WOUT) + (size_t)l * DM * DM, M, DM, DM}; pg8::StaticOrder S; S.init(M, DM, (int)gridDim.x, (int)blockIdx.x);
            pg8::EpiResid E{X, X, DM, modl + 5 * DM, 1.0f};
            pg8::gemm_phase<pg8::EpiResid, pg8::StaticOrder, false>(ldsl, g, S, E, nullptr);
        }
        SEAM(pb + 8);
        if (INL(9)) { int reps_ = 1 + DUP(9); asm volatile("" : "+s"(reps_)); for (int rep_ = 0; rep_ < reps_; ++rep_) { const Params q = opaque_params(p); phase_norm(q, l, 2); __syncthreads(); } }
        SEAM(pb + 9);
        if (INL(10)) {
            pg8::Gemm g{H, WSP(bf16_t, WS_WGU) + ((size_t)l * 2 + 1) * NGU * DM, M, NGU, DM}; pg8::StaticOrder S; S.init(M, NGU, (int)gridDim.x, (int)blockIdx.x);
            pg8::EpiSwiGLU E{ACT, FF};
            pg8::gemm_phase<pg8::EpiSwiGLU, pg8::StaticOrder, false>(ldsl, g, S, E, nullptr);
        }
        SEAM(pb + 10);
        if (INL(11)) {
            pg8::Gemm g{ACT, WSP(bf16_t, WS_WDN) + ((size_t)l * 2 + 1) * DM * FF, M, DM, FF}; pg8::StaticOrder S; S.init(M, DM, (int)gridDim.x, (int)blockIdx.x);
            pg8::EpiResid E{X, (l == DEPTH - 1) ? p.out : X, DM, modl + 8 * DM, 0.5f};
            pg8::gemm_phase<pg8::EpiResid, pg8::StaticOrder, false>(ldsl, g, S, E, nullptr);
        }
        SEAM(pb + 11);
    }
#undef IN
#undef SEAM
}

#ifndef MULTI_LAUNCH
#define MULTI_LAUNCH 0
#endif
extern "C" void kernel_launch(void* const* d_in, const int* in_sizes, int n_in, void* d_out, int out_size, void* d_ws, size_t ws_size, hipStream_t stream) {
    static int grid = 0;
    if (grid == 0) {
        if (n_in != N_IN || (size_t)out_size != O_END || ws_size < WS_END) { fprintf(stderr, "kernel_launch: shape mismatch n_in %d out %d ws %zu (need %zu)\n", n_in, out_size, ws_size, (size_t)WS_END); grid = -1; return; }
        int dev = 0, cus = 0, per_cu = 0;
        if (hipGetDevice(&dev) != hipSuccess || hipDeviceGetAttribute(&cus, hipDeviceAttributeMultiprocessorCount, dev) != hipSuccess) { grid = -1; return; }
        if (hipFuncSetAttribute((const void*)fwd, hipFuncAttributeMaxDynamicSharedMemorySize, LDS_BYTES) != hipSuccess) { fprintf(stderr, "kernel_launch: hipFuncSetAttribute failed\n"); grid = -1; return; }
        if (hipOccupancyMaxActiveBlocksPerMultiprocessor(&per_cu, (const void*)fwd, 512, LDS_BYTES) != hipSuccess || per_cu < 1) { fprintf(stderr, "kernel_launch: occupancy query says %d\n", per_cu); (void)hipGetLastError(); }
        grid = cus;
    }
    if (grid < 0) return;
    (void)hipMemsetAsync((char*)d_ws + WS_CTL, 0, CTL_BYTES, stream);
    Params p{};
    for (int i = 0; i < N_IN; ++i) p.in[i] = (const float*)d_in[i];
    p.out = (float*)d_out; p.ws = (unsigned char*)d_ws;
#if MULTI_LAUNCH
    for (int ph = 0; ph < 1 + DBG_NLAYERS * 12; ++ph) { p.ph_lo = ph; p.ph_hi = ph + 1; hipLaunchKernelGGL(fwd, dim3(grid), dim3(512), LDS_BYTES, stream, p); }
#else
    p.ph_lo = 0; p.ph_hi = NPH; hipLaunchKernelGGL(fwd, dim3(grid), dim3(512), LDS_BYTES, stream, p);
#endif
    const hipError_t le = hipPeekAtLastError();
    if (le != hipSuccess) fprintf(stderr, "kernel_launch: launch failed: %s\n", hipGetErrorName(le));
}
```

```cpp
#include <hip/hip_runtime.h>
#include <cstdio>
#include <cstdint>

#ifndef CB_
#define CB_ 16
#endif
#ifndef LB_
#define LB_ 8
#endif
#ifndef DEPTH_
#define DEPTH_ 4
#endif
constexpr int DM = 2048, DEPTH = DEPTH_, CB = CB_, CT = 256, LB = LB_, LT = 1024;
constexpr int MC = CB * CT, ML = LB * LT, M = MC + ML;
constexpr int FF = 5504, NGU = 2 * FF, NIN = 6192, NINP = 6400, NMOD = 9 * DM, NCOND = 1 + LB;
constexpr float EPS = 1e-6f;
constexpr int Z_NAQ = 0, Z_NAK = 512, Z_NAV = 1024, Z_GLQ = 1536, Z_GLK = 1792, Z_GLV = 2048, Z_GLR = 2560, Z_GF = 3072, Z_GB = 3088,
              Z_GQQ = 3104, Z_GQK = 3616, Z_GQV = 3872, Z_DQKV = 4128, Z_DZ = 5664, Z_DB = 6176, Z_DA = 6184;
static_assert(Z_DA + 8 == NIN, "split");
enum { I_XP = 0, I_XS, I_CNAK, I_CNAV, I_CGK, I_CGV, I_SGLA, I_SGDN, I_C, I_CCTX, I_NORMG, I_WMOD, I_BMOD, I_GU, I_DOWN, I_WIN, I_WOUT, I_NAQKN, I_RPB,
       I_GUP, I_GBIAS, I_GLAON, I_GQAQKN, I_CONV, I_ALOG, I_DTB, I_GDNON, N_IN };
constexpr size_t O_YP = 0, O_YS = O_YP + (size_t)MC * DM, O_NAK = O_YS + (size_t)ML * DM, O_NAV = O_NAK + (size_t)CB * DEPTH * 4 * CT * 128,
                 O_GK = O_NAV + (size_t)CB * DEPTH * 4 * CT * 128, O_GV = O_GK + (size_t)CB * DEPTH * 2 * CT * 128,
                 O_SGLA = O_GV + (size_t)CB * DEPTH * 2 * CT * 128, O_SGDN = O_SGLA + (size_t)CB * DEPTH * 2 * 4 * 64 * 128,
                 O_END = O_SGDN + (size_t)CB * DEPTH * 2 * 4 * 128 * 128;
constexpr size_t al256(size_t x) { return (x + 255) & ~(size_t)255; }
constexpr size_t WS_CTL = 0, CTL_BYTES = 1u << 20;
constexpr size_t WS_WGU = CTL_BYTES;
constexpr size_t WS_WDN = WS_WGU + (size_t)DEPTH * 2 * NGU * DM * 2;
constexpr size_t WS_WIN = WS_WDN + (size_t)DEPTH * 2 * DM * FF * 2;
constexpr size_t WS_WOUT = WS_WIN + (size_t)DEPTH * NINP * DM * 2;
constexpr size_t WS_MODV = WS_WOUT + (size_t)DEPTH * DM * DM * 2;
constexpr size_t WS_ROPE = al256(WS_MODV + (size_t)DEPTH * NCOND * NMOD * 4);
constexpr size_t WS_X = al256(WS_ROPE + 2 * 64 * 32 * 4);
constexpr size_t WS_H = WS_X + (size_t)M * DM * 4;
constexpr size_t WS_ACT = WS_H + (size_t)M * DM * 2;
constexpr size_t WS_Z = WS_ACT + (size_t)M * FF * 2;
constexpr size_t WS_MRG = WS_Z + (size_t)M * NINP * 4;
constexpr size_t WS_NAQ = WS_MRG + (size_t)M * DM * 2;
constexpr size_t WS_NAK = WS_NAQ + (size_t)M * 512 * 2;
constexpr size_t WS_NAV = WS_NAK + (size_t)M * 512 * 2;
constexpr size_t WS_GQ = WS_NAV + (size_t)M * 512 * 2;
constexpr size_t WS_GK = WS_GQ + (size_t)M * 512 * 2;
constexpr size_t WS_GV = WS_GK + (size_t)M * 256 * 2;
constexpr size_t WS_CNAK = WS_GV + (size_t)M * 256 * 2;
constexpr size_t WS_CNAV = WS_CNAK + (size_t)LB * DEPTH * 256 * 512 * 2;
constexpr size_t WS_CGK = WS_CNAV + (size_t)LB * DEPTH * 256 * 512 * 2;
constexpr size_t WS_CGV = WS_CGK + (size_t)LB * DEPTH * 256 * 256 * 2;
constexpr size_t WS_AF = WS_CGV + (size_t)LB * DEPTH * 256 * 256 * 2;
constexpr size_t WS_AB = WS_AF + (size_t)M * 256 * 4;
constexpr size_t WS_DQ = WS_AB + (size_t)M * 256 * 4;
constexpr size_t WS_DK = WS_DQ + (size_t)M * 512 * 4;
constexpr size_t WS_DV = WS_DK + (size_t)M * 512 * 4;
constexpr size_t WS_DBA = WS_DV + (size_t)M * 512 * 4;
constexpr size_t WS_GOF = WS_DBA + (size_t)M * 16 * 4;
constexpr size_t WS_GOB = WS_GOF + (size_t)M * 512 * 4;
constexpr size_t WS_DOF = WS_GOB + (size_t)M * 512 * 4;
constexpr size_t WS_DOB = WS_DOF + (size_t)M * 512 * 4;
constexpr size_t WS_END = WS_DOB + (size_t)M * 512 * 4;

typedef unsigned short bf16_t;
struct Params { const float* in[N_IN]; float* out; unsigned char* ws; int ph_lo, ph_hi; };
static_assert(sizeof(Params) == N_IN * 8 + 8 + 8 + 8, "no padding");

#define WSP(T, off) ((T*)(p.ws + (off)))
__device__ __forceinline__ int opaque_tid() { int t = (int)threadIdx.x; asm volatile("" : "+v"(t)); return t; }
__device__ __forceinline__ Params opaque_params(const Params& p) { Params q = p; unsigned long long w = (unsigned long long)q.ws; asm volatile("" : "+s"(w)); q.ws = (unsigned char*)w; return q; }

__device__ __forceinline__ float wave_sum(float v) {
#pragma unroll
    for (int o = 32; o >= 1; o >>= 1) v += __shfl_xor(v, o);
    return v;
}
__device__ __forceinline__ bf16_t f2bf(float f) { unsigned u = __float_as_uint(f); u += 0x7FFFu + ((u >> 16) & 1u); return (bf16_t)(u >> 16); }
__device__ __forceinline__ unsigned pack2(float a, float b) { return (unsigned)f2bf(a) | ((unsigned)f2bf(b) << 16); }
__device__ __forceinline__ float silu_f(float x) { return x / (1.f + expf(-x)); }
__device__ __forceinline__ float softplus_f(float x) { return fmaxf(x, 0.f) + log1pf(expf(-fabsf(x))); }
__device__ __forceinline__ float logsigmoid_f(float x) { return fminf(x, 0.f) - log1pf(expf(-fabsf(x))); }
__device__ __forceinline__ int cond_of_row(int m) { return m < MC ? 0 : 1 + (m - MC) / LT; }
typedef float vf4 __attribute__((ext_vector_type(4)));
__device__ __forceinline__ void conv_tile(const float* __restrict__ src, int ld_src, int ncols_src, int k0, int c0, bf16_t* __restrict__ dst, int ld_dst, int n0, float* tile) {
    const int tid = opaque_tid();
    {
        const int r = tid >> 3, c = (tid & 7) * 8;
        float4 a = make_float4(0.f, 0.f, 0.f, 0.f), b = a;
        if (c0 + c + 8 <= ncols_src) {
            const float* s = src + (size_t)(k0 + r) * ld_src + c0 + c;
            a = *(const float4*)s; b = *(const float4*)(s + 4);
        }
        float* t = tile + r * 65 + c;
        t[0] = a.x; t[1] = a.y; t[2] = a.z; t[3] = a.w; t[4] = b.x; t[5] = b.y; t[6] = b.z; t[7] = b.w;
    }
    __syncthreads();
    {
        const int n = tid >> 3, ks = (tid & 7) * 8;
        const float* t = tile + ks * 65 + n;
        uint4 w;
        w.x = pack2(t[0 * 65], t[1 * 65]); w.y = pack2(t[2 * 65], t[3 * 65]); w.z = pack2(t[4 * 65], t[5 * 65]); w.w = pack2(t[6 * 65], t[7 * 65]);
        *(uint4*)(dst + (size_t)(n0 + n) * ld_dst + k0 + ks) = w;
    }
    __syncthreads();
}

constexpr int MOD_ITEMS = DEPTH * (NMOD / 128);
constexpr int TGU_KT = DM / 64, TGU_NT = NGU / 64, TDN_KT = FF / 64, TDN_NT = DM / 64, TIN_KT = DM / 64, TIN_NT = NINP / 64, TOUT_KT = DM / 64, TOUT_NT = DM / 64;
constexpr int T_GU = DEPTH * 2 * TGU_KT * TGU_NT, T_DN = DEPTH * 2 * TDN_KT * TDN_NT, T_IN = DEPTH * TIN_KT * TIN_NT, T_OUT = DEPTH * TOUT_KT * TOUT_NT;

__device__ __forceinline__ void phase_prologue(const Params& p, float* smem) {
    const int tid = opaque_tid(), nb = gridDim.x, bid = blockIdx.x;
    float* s_cond = smem;
    float* s_red = s_cond + NCOND * DM;
    float* s_tile = s_red + 3 * 128 * NCOND;
    for (int i = tid; i < NCOND * DM; i += 512) { const int ci = i / DM, k = i % DM; const float v = ci == 0 ? p.in[I_CCTX][k] : p.in[I_C][(size_t)(ci - 1) * DM + k]; s_cond[i] = silu_f(v); }
    __syncthreads();
    float* modv = WSP(float, WS_MODV);
    for (int it = bid; it < MOD_ITEMS; it += nb) {
        const int l = it / (NMOD / 128), jt = it % (NMOD / 128);
        const int cl = tid & 127, kq = tid >> 7, col = jt * 128 + cl;
        const float* w = p.in[I_WMOD] + (size_t)l * DM * NMOD + col;
        float acc[NCOND];
#pragma unroll
        for (int ci = 0; ci < NCOND; ++ci) acc[ci] = 0.f;
        for (int k = kq * 512; k < kq * 512 + 512; k += 8) {
            float wv[8];
#pragma unroll
            for (int j = 0; j < 8; ++j) wv[j] = w[(size_t)(k + j) * NMOD];
#pragma unroll
            for (int ci = 0; ci < NCOND; ++ci) {
                const float4 s0 = *(const float4*)&s_cond[ci * DM + k], s1 = *(const float4*)&s_cond[ci * DM + k + 4];
                acc[ci] += s0.x * wv[0] + s0.y * wv[1] + s0.z * wv[2] + s0.w * wv[3] + s1.x * wv[4] + s1.y * wv[5] + s1.z * wv[6] + s1.w * wv[7];
            }
        }
        if (kq > 0) {
#pragma unroll
            for (int ci = 0; ci < NCOND; ++ci) s_red[((kq - 1) * 128 + cl) * NCOND + ci] = acc[ci];
        }
        __syncthreads();
        if (kq == 0) {
            const float bm = p.in[I_BMOD][(size_t)l * NMOD + col];
#pragma unroll
            for (int ci = 0; ci < NCOND; ++ci)
                modv[((size_t)l * NCOND + ci) * NMOD + col] = acc[ci] + s_red[(0 * 128 + cl) * NCOND + ci] + s_red[(1 * 128 + cl) * NCOND + ci] + s_red[(2 * 128 + cl) * NCOND + ci] + bm;
        }
        __syncthreads();
    }
    for (int it = bid; it < T_GU + T_DN + T_IN + T_OUT; it += nb) {
        if (it < T_GU) {
            const int mat = it / (TGU_KT * TGU_NT), r = it % (TGU_KT * TGU_NT), kt = r / TGU_NT, nt = r % TGU_NT;
            const int n0 = nt * 64, t256 = n0 / 256, c = n0 % 256;
            const int c0 = c < 128 ? 128 * t256 + c : FF + 128 * t256 + (c - 128);
            conv_tile(p.in[I_GU] + (size_t)mat * DM * NGU, NGU, NGU, kt * 64, c0, WSP(bf16_t, WS_WGU) + (size_t)mat * NGU * DM, DM, n0, s_tile);
        } else if (it < T_GU + T_DN) {
            const int i2 = it - T_GU, mat = i2 / (TDN_KT * TDN_NT), r = i2 % (TDN_KT * TDN_NT), kt = r / TDN_NT, nt = r % TDN_NT;
            conv_tile(p.in[I_DOWN] + (size_t)mat * FF * DM, DM, DM, kt * 64, nt * 64, WSP(bf16_t, WS_WDN) + (size_t)mat * DM * FF, FF, nt * 64, s_tile);
        } else if (it < T_GU + T_DN + T_IN) {
            const int i2 = it - T_GU - T_DN, mat = i2 / (TIN_KT * TIN_NT), r = i2 % (TIN_KT * TIN_NT), kt = r / TIN_NT, nt = r % TIN_NT;
            conv_tile(p.in[I_WIN] + (size_t)mat * DM * NIN, NIN, NIN, kt * 64, nt * 64, WSP(bf16_t, WS_WIN) + (size_t)mat * NINP * DM, DM, nt * 64, s_tile);
        } else {
            const int i2 = it - T_GU - T_DN - T_IN, mat = i2 / (TOUT_KT * TOUT_NT), r = i2 % (TOUT_KT * TOUT_NT), kt = r / TOUT_NT, nt = r % TOUT_NT;
            conv_tile(p.in[I_WOUT] + (size_t)mat * DM * DM, DM, DM, kt * 64, nt * 64, WSP(bf16_t, WS_WOUT) + (size_t)mat * DM * DM, DM, nt * 64, s_tile);
        }
    }
    const size_t gtid = (size_t)bid * 512 + tid, gstride = (size_t)nb * 512;
    {
        float4* X = WSP(float4, WS_X);
        const float4* xp = (const float4*)p.in[I_XP]; const float4* xs = (const float4*)p.in[I_XS];
        const size_t nc = (size_t)MC * DM / 4, n = (size_t)M * DM / 4;
        for (size_t i = gtid; i < n; i += gstride) X[i] = i < nc ? xp[i] : xs[i - nc];
    }
    {
        const size_t n_na = (size_t)LB * DEPTH * 256 * 512 / 8;
        for (size_t i = gtid; i < 2 * n_na; i += gstride) {
            const bool isv = i >= n_na; const size_t j = isv ? i - n_na : i;
            const int d8 = (int)(j % 16), h = (int)((j / 16) % 4), t = (int)((j / 64) % 256); const size_t bl = j / (64 * 256);
            const float* s = p.in[isv ? I_CNAV : I_CNAK] + ((bl * 4 + h) * 256 + t) * 128 + d8 * 8;
            const float4 a = *(const float4*)s, b = *(const float4*)(s + 4);
            uint4 w; w.x = pack2(a.x, a.y); w.y = pack2(a.z, a.w); w.z = pack2(b.x, b.y); w.w = pack2(b.z, b.w);
            *(uint4*)(WSP(bf16_t, isv ? WS_CNAV : WS_CNAK) + (bl * 256 + t) * 512 + h * 128 + d8 * 8) = w;
        }
        const size_t n_g = (size_t)LB * DEPTH * 256 * 256 / 8;
        for (size_t i = gtid; i < 2 * n_g; i += gstride) {
            const bool isv = i >= n_g; const size_t j = isv ? i - n_g : i;
            const int d8 = (int)(j % 16), h = (int)((j / 16) % 2), t = (int)((j / 32) % 256); const size_t bl = j / (32 * 256);
            const float* s = p.in[isv ? I_CGV : I_CGK] + ((bl * 2 + h) * 256 + t) * 128 + d8 * 8;
            const float4 a = *(const float4*)s, b = *(const float4*)(s + 4);
            uint4 w; w.x = pack2(a.x, a.y); w.y = pack2(a.z, a.w); w.z = pack2(b.x, b.y); w.w = pack2(b.z, b.w);
            *(uint4*)(WSP(bf16_t, isv ? WS_CGV : WS_CGK) + (bl * 256 + t) * 256 + h * 128 + d8 * 8) = w;
        }
    }
    for (size_t i = gtid; i < 64 * 32; i += gstride) {
        const int pos = (int)(i / 32), k = (int)(i % 32);
        const float inv = powf(10000.0f, -(float)(2 * k) / 64.0f);
        const float ang = (float)pos * inv;
        WSP(float, WS_ROPE)[i] = cosf(ang); WSP(float, WS_ROPE)[64 * 32 + i] = sinf(ang);
    }
}

__device__ __forceinline__ void phase_norm(const Params& p, int l, int which  ) {
    const int tid = opaque_tid(), lane = tid & 63, wv = tid >> 6;
    const float* X = WSP(float, WS_X); bf16_t* H = WSP(bf16_t, WS_H);
    const float* g = p.in[I_NORMG] + ((size_t)l * 3 + which) * DM;
    for (int m = blockIdx.x * 8 + wv; m < M; m += gridDim.x * 8) {
        const int ci = cond_of_row(m);
        const float* mv = WSP(float, WS_MODV) + ((size_t)l * NCOND + ci) * NMOD + (size_t)which * 3 * DM;
        const float* x = X + (size_t)m * DM;
        vf4 v[8]; float ss = 0.f;
#pragma unroll
        for (int i = 0; i < 8; ++i) { v[i] = *(const vf4*)(x + (i * 64 + lane) * 4); ss += v[i].x * v[i].x + v[i].y * v[i].y + v[i].z * v[i].z + v[i].w * v[i].w; }
        ss = wave_sum(ss);
        const float r = 1.0f / sqrtf(ss * (1.0f / DM) + EPS);
#pragma unroll
        for (int i = 0; i < 8; ++i) {
            const int c = (i * 64 + lane) * 4;
            const float4 gg = *(const float4*)(g + c), sh = *(const float4*)(mv + c), sc = *(const float4*)(mv + DM + c);
            const float o0 = v[i].x * r * gg.x * (1.f + sc.x) + sh.x, o1 = v[i].y * r * gg.y * (1.f + sc.y) + sh.y;
            const float o2 = v[i].z * r * gg.z * (1.f + sc.z) + sh.z, o3 = v[i].w * r * gg.w * (1.f + sc.w) + sh.w;
            uint2 w; w.x = pack2(o0, o1); w.y = pack2(o2, o3);
            *(uint2*)(H + (size_t)m * DM + c) = w;
        }
    }
}

__device__ __forceinline__ float red16(float v);
__device__ __forceinline__ float ssq8(vf4 a, vf4 b) { const vf4 s = a * a + b * b; return (s.x + s.y) + (s.z + s.w); }
__device__ __forceinline__ uint4 pack8(vf4 a, vf4 b) { uint4 w; w.x = pack2(a.x, a.y); w.y = pack2(a.z, a.w); w.z = pack2(b.x, b.y); w.w = pack2(b.z, b.w); return w; }
__device__ __forceinline__ void phase_prep(const Params& p, int l) {
    const int tid = opaque_tid(), lane = tid & 63, wv = tid >> 6, rg = lane >> 4, sub = lane & 15, c8 = sub * 8;
    const float* Z = WSP(float, WS_Z);
    const float* ropec = WSP(float, WS_ROPE); const float* ropes = ropec + 64 * 32;
    const float* wnq = p.in[I_NAQKN] + ((size_t)l * 2 + 0) * 128 + c8; const float* wnk = wnq + 128;
    const float* wgq = p.in[I_GQAQKN] + ((size_t)l * 2 + 0) * 128 + c8; const float* wgk = wgq + 128;
    const float* cw = p.in[I_CONV] + (size_t)l * 5 * 1536 + rg * 128 + c8;
    for (int m = blockIdx.x * 8 + wv; m < M; m += gridDim.x * 8) {
        const float* z = Z + (size_t)m * NINP;
        const bool ctx = m < MC;
        const int b = ctx ? m / CT : (m - MC) / LT, t = ctx ? m % CT : (m - MC) % LT, T = ctx ? CT : LT;
        {
            const int ho = rg * 128 + c8;
            const float* zkv = z + (rg < 2 ? Z_GQK + rg * 128 : Z_GQV + (rg - 2) * 128) + c8;
            vf4 q0 = *(const vf4*)(z + Z_NAQ + ho), q1 = *(const vf4*)(z + Z_NAQ + ho + 4), k0 = *(const vf4*)(z + Z_NAK + ho), k1 = *(const vf4*)(z + Z_NAK + ho + 4);
            const vf4 v0 = *(const vf4*)(z + Z_NAV + ho), v1 = *(const vf4*)(z + Z_NAV + ho + 4);
            vf4 g0 = *(const vf4*)(z + Z_GQQ + ho), g1 = *(const vf4*)(z + Z_GQQ + ho + 4), x0 = *(const vf4*)zkv, x1 = *(const vf4*)(zkv + 4);
            float r = 1.0f / sqrtf(red16(ssq8(q0, q1)) * (1.0f / 128) + EPS);
            q0 = q0 * r * *(const vf4*)wnq; q1 = q1 * r * *(const vf4*)(wnq + 4);
            *(uint4*)(WSP(bf16_t, WS_NAQ) + (size_t)m * 512 + ho) = pack8(q0, q1);
            r = 1.0f / sqrtf(red16(ssq8(k0, k1)) * (1.0f / 128) + EPS);
            k0 = k0 * r * *(const vf4*)wnk; k1 = k1 * r * *(const vf4*)(wnk + 4);
            *(uint4*)(WSP(bf16_t, WS_NAK) + (size_t)m * 512 + ho) = pack8(k0, k1);
            *(uint4*)(WSP(bf16_t, WS_NAV) + (size_t)m * 512 + ho) = pack8(v0, v1);
            if (ctx) {
                const size_t o = ((((size_t)b * DEPTH + l) * 4 + rg) * CT + t) * 128 + c8;
                *(vf4*)(p.out + O_NAK + o) = k0; *(vf4*)(p.out + O_NAK + o + 4) = k1; *(vf4*)(p.out + O_NAV + o) = v0; *(vf4*)(p.out + O_NAV + o + 4) = v1;
            }
            r = 1.0f / sqrtf(red16(ssq8(g0, g1)) * (1.0f / 128) + EPS);
            g0 = g0 * r * *(const vf4*)wgq; g1 = g1 * r * *(const vf4*)(wgq + 4);
            const float rk = 1.0f / sqrtf(red16(ssq8(x0, x1)) * (1.0f / 128) + EPS);
            if (rg < 2) { x0 = x0 * rk * *(const vf4*)wgk; x1 = x1 * rk * *(const vf4*)(wgk + 4); }
            if (!ctx) {
                const int pos = sub < 8 ? (t >> 6) : (t & 63), ai = pos * 32 + (c8 & 31);
                const vf4 c0 = *(const vf4*)(ropec + ai), c1 = *(const vf4*)(ropec + ai + 4), s0 = *(const vf4*)(ropes + ai), s1 = *(const vf4*)(ropes + ai + 4);
                const bool hi = (sub & 4) != 0;
                vf4 pg0, pg1, px0, px1;
#pragma unroll
                for (int j = 0; j < 4; ++j) { pg0[j] = __shfl_xor(g0[j], 4); pg1[j] = __shfl_xor(g1[j], 4); px0[j] = __shfl_xor(x0[j], 4); px1[j] = __shfl_xor(x1[j], 4); }
                g0 = hi ? pg0 * s0 + g0 * c0 : g0 * c0 - pg0 * s0; g1 = hi ? pg1 * s1 + g1 * c1 : g1 * c1 - pg1 * s1;
                if (rg < 2) { x0 = hi ? px0 * s0 + x0 * c0 : x0 * c0 - px0 * s0; x1 = hi ? px1 * s1 + x1 * c1 : x1 * c1 - px1 * s1; }
            }
            *(uint4*)(WSP(bf16_t, WS_GQ) + (size_t)m * 512 + ho) = pack8(g0, g1);
            *(uint4*)(WSP(bf16_t, rg < 2 ? WS_GK : WS_GV) + (size_t)m * 256 + (rg & 1) * 128 + c8) = pack8(x0, x1);
            if (ctx) {
                const size_t o = ((((size_t)b * DEPTH + l) * 2 + (rg & 1)) * CT + t) * 128 + c8;
                float* dst = p.out + (rg < 2 ? O_GK : O_GV) + o;
                *(vf4*)dst = x0; *(vf4*)(dst + 4) = x1;
            }
        }
        {
#pragma unroll
            for (int dir = 0; dir < 2; ++dir) {
                const float* up = p.in[I_GUP] + ((size_t)l * 2 + dir) * 16 * 256 + 4 * lane;
                vf4 acc = *(const vf4*)(p.in[I_GBIAS] + ((size_t)l * 2 + dir) * 256 + 4 * lane);
                const float* gz = z + (dir ? Z_GB : Z_GF);
#pragma unroll
                for (int r4 = 0; r4 < 4; ++r4) {
                    const vf4 gv = *(const vf4*)(gz + 4 * r4);
                    acc += gv.x * *(const vf4*)(up + (4 * r4 + 0) * 256) + gv.y * *(const vf4*)(up + (4 * r4 + 1) * 256) + gv.z * *(const vf4*)(up + (4 * r4 + 2) * 256) + gv.w * *(const vf4*)(up + (4 * r4 + 3) * 256);
                }
                vf4 o;
#pragma unroll
                for (int j = 0; j < 4; ++j) o[j] = expf(logsigmoid_f(acc[j]) * (1.0f / 16.0f));
                *(vf4*)(WSP(float, dir ? WS_AB : WS_AF) + (size_t)m * 256 + 4 * lane) = o;
            }
        }
        {
#pragma unroll
            for (int part = 0; part < 3; ++part) {
                vf4 a0 = (vf4){0.f, 0.f, 0.f, 0.f}, a1 = a0;
#pragma unroll
                for (int j = 0; j < 5; ++j) {
                    const int tt = t + j - 2;
                    if (tt >= 0 && tt < T) {
                        const float* zz = Z + (size_t)(m + j - 2) * NINP + Z_DQKV + part * 512 + rg * 128 + c8;
                        const float* cj = cw + j * 1536 + part * 512;
                        a0 += *(const vf4*)cj * *(const vf4*)zz; a1 += *(const vf4*)(cj + 4) * *(const vf4*)(zz + 4);
                    }
                }
#pragma unroll
                for (int j = 0; j < 4; ++j) { a0[j] = silu_f(a0[j]); a1[j] = silu_f(a1[j]); }
                if (part < 2) { const float r = 1.0f / sqrtf(red16(ssq8(a0, a1)) + EPS) * (part == 0 ? 0.08838834764831845f : 1.0f); a0 *= r; a1 *= r; }
                float* dst = WSP(float, part == 0 ? WS_DQ : part == 1 ? WS_DK : WS_DV) + (size_t)m * 512 + rg * 128 + c8;
                *(vf4*)dst = a0; *(vf4*)(dst + 4) = a1;
            }
            if (lane < 8) {
                const float beta = 1.0f / (1.0f + expf(-z[Z_DB + lane]));
                const float g = -expf(p.in[I_ALOG][(size_t)l * 8 + lane]) * softplus_f(z[Z_DA + lane] + p.in[I_DTB][(size_t)l * 8 + lane]);
                float* ba = WSP(float, WS_DBA) + (size_t)m * 16;
                ba[lane] = beta; ba[8 + lane] = expf(g);
            }
        }
    }
}

typedef float vf2 __attribute__((ext_vector_type(2)));
__device__ __forceinline__ float dpp_f(float v, const int ctrl) { return v; }
#define DPPF(v, ctrl) __int_as_float(__builtin_amdgcn_mov_dpp(__float_as_int(v), (ctrl), 0xF, 0xF, true))
__device__ __forceinline__ float red8(float v) { v += DPPF(v, 0xB1); v += DPPF(v, 0x4E); v += DPPF(v, 0x141); return v; }
__device__ __forceinline__ float red16(float v) { v = red8(v); v += DPPF(v, 0x140); return v; }

__device__ __forceinline__ void gla_chain(const Params& p, int l, bool ctx, int b, int h, int dir, int es, float* smem) {
    constexpr int TC = 32;
    const int tid = opaque_tid(), el = tid >> 3, dg = tid & 7;
    const int T = ctx ? CT : LT; const size_t m0 = ctx ? (size_t)b * CT : (size_t)MC + (size_t)b * LT;
    const float* Z = WSP(float, WS_Z); const float* A = WSP(float, dir ? WS_AB : WS_AF);
    float* O = WSP(float, dir ? WS_GOB : WS_GOF);
    float* sq = smem; float* sk = sq + TC * 64; float* sa = sk + TC * 64; float* sv = sa + TC * 64; float* so = sv + TC * 64;
    vf2 S[4];
    {
        const int e = es * 64 + el;
        if (ctx) {
#pragma unroll
            for (int i = 0; i < 4; ++i) S[i] = (vf2){0.f, 0.f};
        } else {
            const float* s0 = p.in[I_SGLA] + (((((size_t)b * DEPTH + l) * 2 + dir) * 4 + h) * 64 + dg * 8) * 128 + e;
#pragma unroll
            for (int i = 0; i < 4; ++i) S[i] = (vf2){s0[(size_t)(2 * i) * 128], s0[(size_t)(2 * i + 1) * 128]};
        }
    }
    vf4 pre[4];
    const int nch = T / TC;
    const int ls = tid >> 4, lc = (tid & 15) * 4;
#define GLA_LOAD(c) do { const int ti = (c) * TC + ls, tt = dir ? T - 1 - ti : ti; const size_t m = m0 + tt; \
        pre[0] = *(const vf4*)(Z + m * NINP + Z_GLQ + h * 64 + lc); pre[1] = *(const vf4*)(Z + m * NINP + Z_GLK + h * 64 + lc); \
        pre[2] = *(const vf4*)(A + m * 256 + h * 64 + lc);           pre[3] = *(const vf4*)(Z + m * NINP + Z_GLV + h * 128 + es * 64 + lc); } while (0)
#define GLA_WRITE() do { *(vf4*)(sq + ls * 64 + lc) = pre[0] * 0.125f; *(vf4*)(sk + ls * 64 + lc) = pre[1]; *(vf4*)(sa + ls * 64 + lc) = pre[2]; *(vf4*)(sv + ls * 64 + lc) = pre[3]; } while (0)
    __syncthreads();
    GLA_LOAD(0); GLA_WRITE(); __syncthreads();
    for (int c = 0; c < nch; ++c) {
        if (c + 1 < nch) GLA_LOAD(c + 1);
        vf4 q0 = *(const vf4*)(sq + dg * 8), q1 = *(const vf4*)(sq + dg * 8 + 4), k0 = *(const vf4*)(sk + dg * 8), k1 = *(const vf4*)(sk + dg * 8 + 4);
        vf4 a0 = *(const vf4*)(sa + dg * 8), a1 = *(const vf4*)(sa + dg * 8 + 4); float ve = sv[el];
#pragma unroll 2
        for (int s = 0; s < TC; ++s) {
            const int sn = (s + 1) & (TC - 1);
            const vf4 nq0 = *(const vf4*)(sq + sn * 64 + dg * 8), nq1 = *(const vf4*)(sq + sn * 64 + dg * 8 + 4), nk0 = *(const vf4*)(sk + sn * 64 + dg * 8), nk1 = *(const vf4*)(sk + sn * 64 + dg * 8 + 4);
            const vf4 na0 = *(const vf4*)(sa + sn * 64 + dg * 8), na1 = *(const vf4*)(sa + sn * 64 + dg * 8 + 4); const float nve = sv[sn * 64 + el];
            const vf2 v2 = (vf2){ve, ve};
            S[0] = a0.xy * S[0] + k0.xy * v2; S[1] = a0.zw * S[1] + k0.zw * v2; S[2] = a1.xy * S[2] + k1.xy * v2; S[3] = a1.zw * S[3] + k1.zw * v2;
            vf2 acc0 = q0.xy * S[0], acc1 = q0.zw * S[1]; acc0 += q1.xy * S[2]; acc1 += q1.zw * S[3];
            acc0 += acc1;
            const float po = red8(acc0.x + acc0.y);
            if (dg == 0) so[s * 64 + el] = po;
            q0 = nq0; q1 = nq1; k0 = nk0; k1 = nk1; a0 = na0; a1 = na1; ve = nve;
        }
        __syncthreads();
        { const int ti = c * TC + ls, tt = dir ? T - 1 - ti : ti; *(vf4*)(O + (m0 + tt) * 512 + h * 128 + es * 64 + lc) = *(const vf4*)(so + ls * 64 + lc); }
        if (c + 1 < nch) GLA_WRITE();
        __syncthreads();
    }
#undef GLA_LOAD
#undef GLA_WRITE
    if (ctx) {
        float* so_ = p.out + O_SGLA + (((((size_t)b * DEPTH + l) * 2 + dir) * 4 + h) * 64 + dg * 8) * 128 + es * 64 + el;
#pragma unroll
        for (int i = 0; i < 4; ++i) { so_[(size_t)(2 * i) * 128] = S[i].x; so_[(size_t)(2 * i + 1) * 128] = S[i].y; }
    }
}

__device__ __forceinline__ void gdn_chain(const Params& p, int l, bool ctx, int b, int h, int dir, int es, float* smem) {
    constexpr int TC = 32;
    const int tid = opaque_tid(), el = tid >> 3, dg = tid & 7;
    const int T = ctx ? CT : LT; const size_t m0 = ctx ? (size_t)b * CT : (size_t)MC + (size_t)b * LT;
    const float* DQ = WSP(float, WS_DQ); const float* DK = WSP(float, WS_DK); const float* DV = WSP(float, WS_DV); const float* DBA = WSP(float, WS_DBA);
    float* O = WSP(float, dir ? WS_DOB : WS_DOF);
    float* sq = smem; float* sk = sq + TC * 128; float* sv = sk + TC * 128; float* so = sv + TC * 64; float* sba = so + TC * 64; float* sqk = sba + TC * 2;
    vf2 S[8];
    {
        const int e = es * 64 + el;
        if (ctx) {
#pragma unroll
            for (int i = 0; i < 8; ++i) S[i] = (vf2){0.f, 0.f};
        } else {
            const float* s0 = p.in[I_SGDN] + (((((size_t)b * DEPTH + l) * 2 + dir) * 4 + h) * 128 + dg * 16) * 128 + e;
#pragma unroll
            for (int i = 0; i < 8; ++i) S[i] = (vf2){s0[(size_t)(2 * i) * 128], s0[(size_t)(2 * i + 1) * 128]};
        }
    }
    vf4 pre[5]; float pre_s = 0.f;
    const int nch = T / TC;
    const int ls = tid >> 5, lc = (tid & 31) * 4, vs = tid >> 4, vc = (tid & 15) * 4;
#define TOK(c, s_) (m0 + (dir ? T - 1 - ((c) * TC + (s_)) : (c) * TC + (s_)))
#define GDN_LOAD(c) do { const size_t ma = TOK(c, ls), mb = TOK(c, ls + 16), mv = TOK(c, vs); \
        pre[0] = *(const vf4*)(DQ + ma * 512 + h * 128 + lc); pre[1] = *(const vf4*)(DQ + mb * 512 + h * 128 + lc); \
        pre[2] = *(const vf4*)(DK + ma * 512 + h * 128 + lc); pre[3] = *(const vf4*)(DK + mb * 512 + h * 128 + lc); \
        pre[4] = *(const vf4*)(DV + mv * 512 + h * 128 + es * 64 + vc); \
        if (tid < 2 * TC) pre_s = DBA[TOK(c, tid >> 1) * 16 + (tid & 1) * 8 + dir * 4 + h]; } while (0)
#define GDN_WRITE() do { *(vf4*)(sq + ls * 128 + lc) = pre[0]; *(vf4*)(sq + (ls + 16) * 128 + lc) = pre[1]; *(vf4*)(sk + ls * 128 + lc) = pre[2]; *(vf4*)(sk + (ls + 16) * 128 + lc) = pre[3]; \
        *(vf4*)(sv + vs * 64 + vc) = pre[4]; if (tid < 2 * TC) sba[tid] = pre_s; } while (0)
    __syncthreads();
    GDN_LOAD(0); GDN_WRITE(); __syncthreads();
    for (int c = 0; c < nch; ++c) {
        if (c + 1 < nch) GDN_LOAD(c + 1);
        {
            const int s = tid >> 4, part = tid & 15;
            const vf4 x0 = *(const vf4*)(sq + s * 128 + part * 8), x1 = *(const vf4*)(sq + s * 128 + part * 8 + 4), y0 = *(const vf4*)(sk + s * 128 + part * 8), y1 = *(const vf4*)(sk + s * 128 + part * 8 + 4);
            const vf4 pr = x0 * y0 + x1 * y1;
            const float d = red16((pr.x + pr.y) + (pr.z + pr.w));
            if (part == 0) sqk[s] = d;
        }
        __syncthreads();
        vf4 kk[4], qq[4]; float ve, be, a, qk;
#pragma unroll
        for (int i = 0; i < 4; ++i) { kk[i] = *(const vf4*)(sk + dg * 16 + 4 * i); qq[i] = *(const vf4*)(sq + dg * 16 + 4 * i); }
        ve = sv[el]; be = sba[0]; a = sba[1]; qk = sqk[0];
#pragma unroll 2
        for (int s = 0; s < TC; ++s) {
            const int sn = (s + 1) & (TC - 1);
            vf4 nk[4], nq[4];
#pragma unroll
            for (int i = 0; i < 4; ++i) { nk[i] = *(const vf4*)(sk + sn * 128 + dg * 16 + 4 * i); nq[i] = *(const vf4*)(sq + sn * 128 + dg * 16 + 4 * i); }
            const float nve = sv[sn * 64 + el], nbe = sba[2 * sn], na = sba[2 * sn + 1], nqk = sqk[sn];
            vf2 ak0 = kk[0].xy * S[0], ak1 = kk[0].zw * S[1], aq0 = qq[0].xy * S[0], aq1 = qq[0].zw * S[1];
#pragma unroll
            for (int i = 1; i < 4; ++i) { ak0 += kk[i].xy * S[2 * i]; ak1 += kk[i].zw * S[2 * i + 1]; aq0 += qq[i].xy * S[2 * i]; aq1 += qq[i].zw * S[2 * i + 1]; }
            ak0 += ak1; aq0 += aq1;
            const float uk = red8(ak0.x + ak0.y), uq = red8(aq0.x + aq0.y);
            const float vn = be * (ve - a * uk);
            const float po = a * uq + qk * vn;
            const vf2 a2 = (vf2){a, a}, vn2 = (vf2){vn, vn};
#pragma unroll
            for (int i = 0; i < 4; ++i) { S[2 * i] = a2 * S[2 * i] + kk[i].xy * vn2; S[2 * i + 1] = a2 * S[2 * i + 1] + kk[i].zw * vn2; }
            if (dg == 0) so[s * 64 + el] = po;
#pragma unroll
            for (int i = 0; i < 4; ++i) { kk[i] = nk[i]; qq[i] = nq[i]; }
            ve = nve; be = nbe; a = na; qk = nqk;
        }
        __syncthreads();
        *(vf4*)(O + TOK(c, vs) * 512 + h * 128 + es * 64 + vc) = *(const vf4*)(so + vs * 64 + vc);
        if (c + 1 < nch) GDN_WRITE();
        __syncthreads();
    }
#undef GDN_LOAD
#undef GDN_WRITE
#undef TOK
    if (ctx) {
        float* so_ = p.out + O_SGDN + (((((size_t)b * DEPTH + l) * 2 + dir) * 4 + h) * 128 + dg * 16) * 128 + es * 64 + el;
#pragma unroll
        for (int i = 0; i < 8; ++i) { so_[(size_t)(2 * i) * 128] = S[i].x; so_[(size_t)(2 * i + 1) * 128] = S[i].y; }
    }
}

__device__ __forceinline__ void phase_post(const Params& p, int l) {
    const int tid = opaque_tid(), lane = tid & 63, wv = tid >> 6;
    const float* Z = WSP(float, WS_Z); bf16_t* MRG = WSP(bf16_t, WS_MRG);
    const float* wg = p.in[I_GLAON] + (size_t)l * 128; const float* wd = p.in[I_GDNON] + (size_t)l * 128;
    for (int m = blockIdx.x * 8 + wv; m < M; m += gridDim.x * 8) {
        const float* z = Z + (size_t)m * NINP;
#pragma unroll
        for (int g = 0; g < 2; ++g) {
            const float* of = WSP(float, g ? WS_DOF : WS_GOF) + (size_t)m * 512; const float* ob = WSP(float, g ? WS_DOB : WS_GOB) + (size_t)m * 512;
            const float* w = g ? wd : wg; const int zg = g ? Z_DZ : Z_GLR, mc = g ? 1536 : 512;
#pragma unroll
            for (int h = 0; h < 4; ++h) {
                const float a = of[h * 128 + lane] + ob[h * 128 + lane], c = of[h * 128 + 64 + lane] + ob[h * 128 + 64 + lane];
                const float r = 1.0f / sqrtf(wave_sum(a * a + c * c) * (1.0f / 128) + EPS);
                bf16_t* o = MRG + (size_t)m * DM + mc + h * 128;
                o[lane] = f2bf(a * r * w[lane] * silu_f(z[zg + h * 128 + lane]));
                o[64 + lane] = f2bf(c * r * w[64 + lane] * silu_f(z[zg + h * 128 + 64 + lane]));
            }
        }
    }
}
#define XB_TMO      128
#define XB_XCNT(j)  (256  + 64 * (j))
#define XB_XSUB(j)  (1280 + 64 * (j))
#define XB_XGEN(j)  (2304 + 64 * (j))
#define XB_TOP      3328
#define XB_TOPGEN   3392
#define XCD_BAR_WORDS 3456
#define XB_SPIN_CAP (1u << 22)
#define LAS __attribute__((address_space(3)))

__device__ __forceinline__ unsigned xb_ld(unsigned* p)              { return __hip_atomic_load(p, __ATOMIC_RELAXED, __HIP_MEMORY_SCOPE_AGENT); }
__device__ __forceinline__ unsigned xb_add(unsigned* p, unsigned v) { return __hip_atomic_fetch_add(p, v, __ATOMIC_RELAXED, __HIP_MEMORY_SCOPE_AGENT); }
__device__ __forceinline__ unsigned xb_xcc_id() { return (unsigned)__builtin_amdgcn_s_getreg((3 << 11) | 20) & 0xFu; }
#define XB_SPIN(cond, bar) do { unsigned _sp = 0; while (cond) { __builtin_amdgcn_s_sleep(1); \
    if ((++_sp & 255u) == 0u) { if (xb_ld(&(bar)[XB_TMO])) break; if (_sp > XB_SPIN_CAP) { atomicAdd(&(bar)[XB_TMO], 1u); break; } } } } while (0)

struct XcdBarrier {
    unsigned* bar; unsigned x;
    volatile LAS unsigned* st;
};

__device__ __forceinline__ XcdBarrier xcd_barrier_post(unsigned* bar, volatile LAS unsigned* st) {
    XcdBarrier b; b.bar = bar; b.x = xb_xcc_id(); b.st = st;
    if (threadIdx.x == 0) (void)xb_add(&bar[XB_XCNT(b.x)], 1u);
    return b;
}
__device__ __forceinline__ void xcd_barrier_complete(unsigned* bar, unsigned x, unsigned& nloc, unsigned& nx) {
    const unsigned G = gridDim.x * gridDim.y * gridDim.z;
    unsigned sum, cnt, mine, sp = 0u;
    for (;;) {
        sum = 0u; cnt = 0u; mine = 0u;
#pragma unroll
        for (unsigned j = 0; j < 16; ++j) { const unsigned c = xb_ld(&bar[XB_XCNT(j)]); sum += c; cnt += (c > 0u) ? 1u : 0u; mine = (j == x) ? c : mine; }
        if (sum == G) break;
        __builtin_amdgcn_s_sleep(1);
        if ((++sp & 255u) == 0u) { if (xb_ld(&bar[XB_TMO])) break; if (sp > XB_SPIN_CAP) { atomicAdd(&bar[XB_TMO], 1u); break; } }
    }
    nloc = mine > 0u ? mine : 1u; nx = cnt > 0u ? cnt : 1u;
}

__device__ __forceinline__ void xcd_barrier(const XcdBarrier& b) {
    asm volatile("s_waitcnt vmcnt(0)" ::: "memory");
    __syncthreads();
    if (threadIdx.x == 0) {
        unsigned* bar = b.bar;
        __builtin_amdgcn_s_waitcnt(0);
        unsigned nloc = b.st[0], nx = b.st[1];
        if (nloc == 0u) { xcd_barrier_complete(bar, b.x, nloc, nx); b.st[0] = nloc; b.st[1] = nx; }
        const unsigned old = xb_add(&bar[XB_XSUB(b.x)], 1u);
        const unsigned gen = old / nloc;
        if (old + 1u == (gen + 1u) * nloc) {
            __builtin_amdgcn_fence(__ATOMIC_RELEASE, "agent");
            asm volatile("s_waitcnt vmcnt(0)" ::: "memory");
            const unsigned og = xb_add(&bar[XB_TOP], 1u);
            const unsigned tg = og / nx;
            if (og + 1u == (tg + 1u) * nx) xb_add(&bar[XB_TOPGEN], 1u);
            else XB_SPIN(xb_ld(&bar[XB_TOPGEN]) == tg, bar);
            __builtin_amdgcn_fence(__ATOMIC_ACQUIRE, "agent");
            xb_add(&bar[XB_XGEN(b.x)], 1u);
            asm volatile("s_waitcnt vmcnt(0)" ::: "memory");
        } else {
            XB_SPIN(xb_ld(&bar[XB_XGEN(b.x)]) == gen, bar);
            __builtin_amdgcn_fence(__ATOMIC_ACQUIRE, "agent");
            asm volatile("s_waitcnt vmcnt(0)" ::: "memory");
        }
    }
    __syncthreads();
}

namespace pg8 {
#define PG8_LAS __attribute__((address_space(3)))
typedef unsigned short bf16_t;
typedef short bf16x8 __attribute__((ext_vector_type(8)));
typedef float f32x4 __attribute__((ext_vector_type(4)));
typedef unsigned u32x4 __attribute__((ext_vector_type(4)));
constexpr int BM = 256, BK = 64, HALF = 128, HTB = HALF * BK * 2  , STAGE_BYTES = 8 * HTB, NXCD = 8, WGM = 8;

__host__ __device__ __forceinline__ int lds_byte(int r, int c) { const int st = (r >> 4) * 2 + (c >> 5), rr = r & 15, cc = c & 31, ob = rr * 64 + cc * 2; return st * 1024 + (ob ^ (((ob >> 9) & 1) << 5)); }
__host__ __device__ __forceinline__ void stage_rc(int b, int& R, int& C) { const int st = b / 1024, sb = b % 1024, swz = sb ^ (((sb >> 9) & 1) << 5); R = (st >> 1) * 16 + swz / 64; C = (st & 1) * 32 + (swz % 64) / 2; }
__host__ __device__ __forceinline__ int perm32(int rho) { const int n = rho >> 4, i = rho & 15; return 8 * (i >> 2) + 4 * n + (i & 3); }

struct Unit { int pm, pn; };
struct Gemm { const bf16_t* A; const bf16_t* Bt; int M, N, K; };

struct StaticOrder {
    int nM, nN, nwg, G, c;
    __host__ __device__ void init(int M, int N, int G_, int c_) { nM = M / BM; nN = N / BM; nwg = nM * nN; G = G_; c = c_; }
    __host__ __device__ bool next(int i, Unit& u) const {
        const long L = (long)i * G + c; if (L >= nwg) return false;
        int wgid = (int)L; { const int q = nwg / NXCD, r = nwg % NXCD, xcd = wgid % NXCD, off = wgid / NXCD; wgid = (xcd < r ? xcd * (q + 1) : r * (q + 1) + (xcd - r) * q) + off; }
        const int nig = WGM * nN, gid = wgid / nig, fm = gid * WGM, gsz = (nM - fm) < WGM ? (nM - fm) : WGM;
        u.pm = fm + ((wgid % nig) % gsz); u.pn = (wgid % nig) / gsz; return true;
    }
    __device__ __forceinline__ void a_ready(const Unit&) const {}
    __device__ __forceinline__ void done(const Unit&) const {}
};
__device__ __forceinline__ unsigned cvt_pk_bf16(float lo, float hi) { unsigned r; asm volatile("v_cvt_pk_bf16_f32 %0, %1, %2" : "=v"(r) : "v"(lo), "v"(hi)); return r; }
struct EpiF32 {
    static constexpr bool PERM = false, AFTER_DRAIN = false;
    float* C; int ldc; const float* bias;
    __device__ __forceinline__ void operator()(const f32x4 (&acc)[2][2][4][2], const Unit& u, int wr, int wc, int fr, int fq) const {
        const int row0 = u.pm * BM + wr * 64 + fr, col0 = u.pn * BM + wc * 32 + 4 * fq;
        f32x4 bv[2][2];
#pragma unroll
        for (int bj = 0; bj < 2; ++bj)
#pragma unroll
            for (int n = 0; n < 2; ++n) bv[bj][n] = bias ? *(const f32x4*)(bias + col0 + bj * HALF + n * 16) : (f32x4){0.f, 0.f, 0.f, 0.f};
#pragma unroll
        for (int ai = 0; ai < 2; ++ai)
#pragma unroll
            for (int m = 0; m < 4; ++m) { float* rowp = C + (size_t)(row0 + ai * HALF + m * 16) * ldc + col0;
#pragma unroll
                for (int bj = 0; bj < 2; ++bj)
#pragma unroll
                    for (int n = 0; n < 2; ++n) *(f32x4*)(rowp + bj * HALF + n * 16) = acc[ai][bj][m][n] + bv[bj][n]; }
    }
};

struct EpiSwiGLU {
    static constexpr bool PERM = true, AFTER_DRAIN = false;
    bf16_t* O; int ldc;
    __device__ __forceinline__ void operator()(const f32x4 (&acc)[2][2][4][2], const Unit& u, int wr, int wc, int fr, int fq) const {
        const int row0 = u.pm * BM + wr * 64 + fr, col0 = u.pn * 128 + wc * 32 + 8 * fq;
#pragma unroll
        for (int ai = 0; ai < 2; ++ai)
#pragma unroll
            for (int m = 0; m < 4; ++m) { bf16_t* rowp = O + (size_t)(row0 + ai * HALF + m * 16) * ldc + col0;
                const f32x4 g0 = acc[ai][0][m][0], g1 = acc[ai][0][m][1], u0 = acc[ai][1][m][0], u1 = acc[ai][1][m][1];
                float r[8];
#pragma unroll
                for (int j = 0; j < 4; ++j) {
                    r[j]     = g0[j] * __builtin_amdgcn_rcpf(1.0f + __builtin_amdgcn_exp2f(-1.4426950408889634f * g0[j])) * u0[j];
                    r[4 + j] = g1[j] * __builtin_amdgcn_rcpf(1.0f + __builtin_amdgcn_exp2f(-1.4426950408889634f * g1[j])) * u1[j]; }
                u32x4 w; w.x = cvt_pk_bf16(r[0], r[1]); w.y = cvt_pk_bf16(r[2], r[3]); w.z = cvt_pk_bf16(r[4], r[5]); w.w = cvt_pk_bf16(r[6], r[7]);
                *(u32x4*)rowp = w; }
    }
};
struct EpiResid {
    static constexpr bool PERM = false, AFTER_DRAIN = false;
    const float* res; float* out; int ldc; const float* gate0; float coef;
    __device__ __forceinline__ void operator()(const f32x4 (&acc)[2][2][4][2], const Unit& u, int wr, int wc, int fr, int fq) const {
        const int row0 = u.pm * BM + wr * 64 + fr, col0 = u.pn * BM + wc * 32 + 4 * fq;
        const float* gate = gate0 + (size_t)cond_of_row(u.pm * BM) * NMOD;
        f32x4 gv[2][2];
#pragma unroll
        for (int bj = 0; bj < 2; ++bj)
#pragma unroll
            for (int n = 0; n < 2; ++n) gv[bj][n] = *(const f32x4*)(gate + col0 + bj * HALF + n * 16) * coef;
#pragma unroll
        for (int ai = 0; ai < 2; ++ai)
#pragma unroll
            for (int m = 0; m < 4; ++m) { const size_t off = (size_t)(row0 + ai * HALF + m * 16) * ldc + col0;
#pragma unroll
                for (int bj = 0; bj < 2; ++bj)
#pragma unroll
                    for (int n = 0; n < 2; ++n) { const f32x4 bs = *(const f32x4*)(res + off + bj * HALF + n * 16); *(f32x4*)(out + off + bj * HALF + n * 16) = bs + gv[bj][n] * acc[ai][bj][m][n]; }
                asm volatile("" ::: "memory"); }
    }
};
template <class Epi, class Sched, bool STAMP = false>
__device__ __forceinline__ void gemm_phase(PG8_LAS unsigned char* lds, const Gemm g, const Sched& S, const Epi& E, unsigned long long* stamps) {
    const int tid = opaque_tid(), wid = __builtin_amdgcn_readfirstlane(tid >> 6), lane = tid & 63, wr = wid >> 2, wc = wid & 3, fr = lane & 15, fq = lane >> 4;
    const int K = g.K, nt = K / BK;
    int ts_lo = 0, ts_hi = 0, nts = 0; const unsigned long long rt_entry = STAMP ? (unsigned long long)wall_clock64() : 0ull;
#define PG8_STAMP() do { if (STAMP && wid == 0 && nts < 64) { const unsigned long long _c = (unsigned long long)clock64(); \
        ts_lo = (lane == nts) ? (int)(unsigned)_c : ts_lo; ts_hi = (lane == nts) ? (int)(unsigned)(_c >> 32) : ts_hi; ++nts; } } while (0)
    PG8_STAMP();
    unsigned voffA[2], voffB[2];
#pragma unroll
    for (int i = 0; i < 2; ++i) { int R, C; stage_rc(tid * 16 + i * 8192, R, C); const int Rb = Epi::PERM ? ((R & ~31) + perm32(R & 31)) : R;
        voffA[i] = (unsigned)(R * K + C) * 2u; voffB[i] = (unsigned)(Rb * K + C) * 2u; }
    const size_t kstep = (size_t)(BK * 2);
    const size_t hstep = (size_t)HALF * K * 2;
    const size_t tstep = 2 * hstep;
    const unsigned ldsw = (unsigned)wid * 1024u;
    const int aoff = lds_byte(wr * 64 + fr, fq * 8), boff = lds_byte(wc * 32 + fr, fq * 8);
#define PG8_SA(b, h) (((b) * 2 + (h)) * HTB)
#define PG8_SB(b, h) ((4 + (b) * 2 + (h)) * HTB)
#define PG8_STAGE(bufoff, gbase, voff) do { _Pragma("unroll") for (int _i = 0; _i < 2; ++_i) \
        __builtin_amdgcn_global_load_lds((const unsigned*)((const char*)(gbase) + (voff)[_i]), (PG8_LAS unsigned*)(lds + (bufoff) + ldsw + _i * 8192), 16, 0, 0); } while (0)
#define PG8_LDA(dst, b, h) do { _Pragma("unroll") for (int m = 0; m < 4; ++m) _Pragma("unroll") for (int k = 0; k < 2; ++k) dst[m][k] = *(const PG8_LAS bf16x8*)(lds + PG8_SA(b, h) + aoff + m * 2048 + k * 1024); } while (0)
#define PG8_LDB(dst, b, h) do { _Pragma("unroll") for (int n = 0; n < 2; ++n) _Pragma("unroll") for (int k = 0; k < 2; ++k) dst[n][k] = *(const PG8_LAS bf16x8*)(lds + PG8_SB(b, h) + boff + n * 2048 + k * 1024); } while (0)
#define PG8_MMA(ai, bj, At, Bt) do { __builtin_amdgcn_s_setprio(1); _Pragma("unroll") for (int m = 0; m < 4; ++m) _Pragma("unroll") for (int n = 0; n < 2; ++n) _Pragma("unroll") for (int k = 0; k < 2; ++k) \
        acc[ai][bj][m][n] = __builtin_amdgcn_mfma_f32_16x16x32_bf16(Bt[n][k], At[m][k], acc[ai][bj][m][n], 0, 0, 0); __builtin_amdgcn_s_setprio(0); } while (0)
#define PG8_WAIT_V(n) asm volatile("s_waitcnt vmcnt(" #n ")" ::: "memory")
#define PG8_WAIT_L(n) asm volatile("s_waitcnt lgkmcnt(" #n ")" ::: "memory")
#define PG8_BAR __builtin_amdgcn_s_barrier()
#define PG8_SCHED __builtin_amdgcn_sched_barrier(0)
    Unit cur, nxt; int ui = 0;
    if (!S.next(0, cur)) return;
    f32x4 acc[2][2][4][2];
#pragma unroll
    for (int a = 0; a < 2; ++a)
#pragma unroll
        for (int b = 0; b < 2; ++b)
#pragma unroll
            for (int m = 0; m < 4; ++m)
#pragma unroll
                for (int n = 0; n < 2; ++n) acc[a][b][m][n] = (f32x4){0.f, 0.f, 0.f, 0.f};
    bf16x8 At[4][2], B0[2][2], B1[2][2];
    const char* cA = (const char*)g.A + (size_t)cur.pm * tstep; const char* cB = (const char*)g.Bt + (size_t)cur.pn * tstep;
    S.a_ready(cur);
    PG8_STAGE(PG8_SB(0, 0), cB, voffB); PG8_STAGE(PG8_SA(0, 0), cA, voffA); PG8_STAGE(PG8_SB(0, 1), cB + hstep, voffB); PG8_STAGE(PG8_SA(0, 1), cA + hstep, voffA);
    if (wr == 1) PG8_BAR;
    PG8_WAIT_V(4); PG8_BAR;
    PG8_STAGE(PG8_SB(1, 0), cB + kstep, voffB); PG8_STAGE(PG8_SA(1, 0), cA + kstep, voffA); PG8_STAGE(PG8_SB(1, 1), cB + hstep + kstep, voffB);
    PG8_WAIT_V(6); PG8_BAR;
    PG8_STAMP();
    for (;;) {
        const bool has_next = S.next(ui + 1, nxt);
        const char* nA = has_next ? (const char*)g.A + (size_t)nxt.pm * tstep : cA; const char* nB = has_next ? (const char*)g.Bt + (size_t)nxt.pn * tstep : cB;
        for (int t = 0; t < nt; t += 2) {
            const bool last = (t == nt - 2);
            const char* a1 = cA + (size_t)(t + 1) * kstep;
            const char* a2 = last ? nA : cA + (size_t)(t + 2) * kstep; const char* b2 = last ? nB : cB + (size_t)(t + 2) * kstep;
            const char* a3 = a2 + kstep; const char* b3 = b2 + kstep;
            if (last && has_next) S.a_ready(nxt);
            PG8_LDB(B0, 0, 0); PG8_SCHED; PG8_LDA(At, 0, 0); PG8_STAGE(PG8_SA(1, 1), a1 + hstep, voffA);
            PG8_WAIT_L(8); PG8_BAR; PG8_WAIT_L(0); PG8_MMA(0, 0, At, B0); PG8_BAR; PG8_SCHED;
            PG8_LDB(B1, 0, 1); PG8_STAGE(PG8_SB(0, 0), b2, voffB);
            PG8_BAR; PG8_WAIT_L(0); PG8_MMA(0, 1, At, B1); PG8_BAR;
            PG8_LDA(At, 0, 1); PG8_STAGE(PG8_SA(0, 0), a2, voffA);
            PG8_BAR; PG8_WAIT_L(0); PG8_MMA(1, 0, At, B0); PG8_BAR; PG8_SCHED;
            PG8_STAGE(PG8_SB(0, 1), b2 + hstep, voffB);
            PG8_WAIT_V(6); PG8_BAR; PG8_MMA(1, 1, At, B1); PG8_BAR;
            PG8_LDB(B0, 1, 0); PG8_SCHED; PG8_LDA(At, 1, 0); PG8_STAGE(PG8_SA(0, 1), a2 + hstep, voffA);
            PG8_WAIT_L(8); PG8_BAR; PG8_WAIT_L(0); PG8_MMA(0, 0, At, B0); PG8_BAR; PG8_SCHED;
            PG8_LDB(B1, 1, 1); PG8_STAGE(PG8_SB(1, 0), b3, voffB);
            PG8_BAR; PG8_WAIT_L(0); PG8_MMA(0, 1, At, B1); PG8_BAR;
            PG8_LDA(At, 1, 1); PG8_STAGE(PG8_SA(1, 0), a3, voffA);
            PG8_BAR; PG8_WAIT_L(0); PG8_MMA(1, 0, At, B0); PG8_BAR; PG8_SCHED;
            PG8_STAGE(PG8_SB(1, 1), b3 + hstep, voffB);
            PG8_WAIT_V(6); PG8_BAR; PG8_MMA(1, 1, At, B1); PG8_BAR;
        }
        PG8_STAMP();
        if constexpr (!Epi::AFTER_DRAIN) { E(acc, cur, wr, wc, fr, fq); S.done(cur); }
        PG8_STAMP();
        if (!has_next) break;
#pragma unroll
        for (int a = 0; a < 2; ++a)
#pragma unroll
            for (int b = 0; b < 2; ++b)
#pragma unroll
                for (int m = 0; m < 4; ++m)
#pragma unroll
                    for (int n = 0; n < 2; ++n) acc[a][b][m][n] = (f32x4){0.f, 0.f, 0.f, 0.f};
        cur = nxt; cA = nA; cB = nB; ++ui;
    }
    PG8_WAIT_V(0);
    if (wr == 0) PG8_BAR;
    PG8_BAR;
    if constexpr (Epi::AFTER_DRAIN) { E.fused(acc, cur, wr, wc, fr, fq, lds, wid, lane); S.done(cur); }
    PG8_STAMP();
    if (STAMP && wid == 0) { stamps[lane] = lane < nts ? (((unsigned long long)(unsigned)ts_hi << 32) | (unsigned)ts_lo) : 0ull;
        if (lane == 62) stamps[62] = rt_entry; if (lane == 63) stamps[63] = (unsigned long long)wall_clock64(); }
#undef PG8_STAMP
#undef PG8_SA
#undef PG8_SB
#undef PG8_STAGE
#undef PG8_LDA
#undef PG8_LDB
#undef PG8_MMA
#undef PG8_WAIT_V
#undef PG8_WAIT_L
#undef PG8_BAR
#undef PG8_SCHED
}
}
#ifndef ATT_INLINE
#define ATT_INLINE __forceinline__
#endif
namespace att {
constexpr int D = 128, NW = 8, QBLK = 32, KVBLK = 64, LDQ = 512, LDO = DM;
constexpr float SCALE = 0.088388347648318440f;
constexpr float THR = 8.f;
constexpr size_t SHM_V = KVBLK * D * 2, SHM_K = KVBLK * D * 2, SHM_Q = 256 * D * 2, SHM_ATTN = 2 * SHM_V + 2 * SHM_K + NW * 64 * 4 + SHM_Q;
using bf16x8 = __attribute__((ext_vector_type(8))) short;
using s16x4  = __attribute__((ext_vector_type(4))) short;
using f32x16 = __attribute__((ext_vector_type(16))) float;
using u32x4  = __attribute__((ext_vector_type(4))) unsigned;
#define KSWZ(row, colB) ((row) * 256 + ((colB) ^ (((row) & 7) << 4)))
#define SBAR() __builtin_amdgcn_sched_barrier(0)
__device__ __forceinline__ int crow(int r, int hi) { return (r & 3) + 8 * (r >> 2) + 4 * hi; }
__device__ __forceinline__ unsigned cvtpk(float lo, float hi) { unsigned r; asm volatile("v_cvt_pk_bf16_f32 %0, %1, %2" : "=v"(r) : "v"(lo), "v"(hi)); return r; }

__device__ __forceinline__ void partialSM(f32x16& p0, f32x16& p1, float& m_reg, float& mn, float& alpha) {
  constexpr float C = SCALE * 1.4426950408889634f;
  float pmax = p0[0]; for (int r = 1; r < 16; ++r) pmax = fmaxf(pmax, p0[r]); for (int r = 0; r < 16; ++r) pmax = fmaxf(pmax, p1[r]);
  { auto rr = __builtin_amdgcn_permlane32_swap(__float_as_uint(pmax), __float_as_uint(pmax), false, false);
    pmax = fmaxf(__uint_as_float(rr[0]), __uint_as_float(rr[1])); }
  if (__builtin_expect(__all(pmax - m_reg <= THR / SCALE), 1)) { mn = m_reg; alpha = 1.f; }
  else { mn = fmaxf(m_reg, pmax); alpha = __builtin_amdgcn_exp2f((m_reg - mn) * C); m_reg = mn; }
  float mnC = -mn * C;
  for (int r = 0; r < 16; ++r) p0[r] = fmaf(p0[r], C, mnC); for (int r = 0; r < 16; ++r) p1[r] = fmaf(p1[r], C, mnC);
  for (int r = 0; r < 16; ++r) p0[r] = __builtin_amdgcn_exp2f(p0[r]);
}
__device__ __forceinline__ void finishSM(f32x16& p0, f32x16& p1, float alpha, float& l_reg, bf16x8& pa0, bf16x8& pa1, bf16x8& pa2, bf16x8& pa3) {
  for (int r = 0; r < 16; ++r) p1[r] = __builtin_amdgcn_exp2f(p1[r]);
  float ps = 0; for (int r = 0; r < 16; ++r) ps += p0[r]; for (int r = 0; r < 16; ++r) ps += p1[r];
  { auto rr = __builtin_amdgcn_permlane32_swap(__float_as_uint(ps), __float_as_uint(ps), false, false);
    ps = __uint_as_float(rr[0]) + __uint_as_float(rr[1]); }
  l_reg = l_reg * alpha + ps;
#define PK4(P, BASE, OUT) do { unsigned a0 = cvtpk(P[BASE + 0], P[BASE + 1]), a1 = cvtpk(P[BASE + 2], P[BASE + 3]);   \
    unsigned b0 = cvtpk(P[BASE + 4], P[BASE + 5]), b1 = cvtpk(P[BASE + 6], P[BASE + 7]);                              \
    auto r0 = __builtin_amdgcn_permlane32_swap(a0, b0, false, false); auto r1 = __builtin_amdgcn_permlane32_swap(a1, b1, false, false); \
    u32x4 w = {r0[0], r1[0], r0[1], r1[1]}; OUT = *reinterpret_cast<bf16x8*>(&w); } while (0)
  PK4(p0, 0, pa0); PK4(p0, 8, pa1); PK4(p1, 0, pa2); PK4(p1, 8, pa3);
#undef PK4
}
__device__ __forceinline__ void qkt(f32x16& p0, f32x16& p1, const bf16_t* Ks, const bf16_t* Qs, int qrow, int r32, int hi) {
  p0 = f32x16{}; p1 = f32x16{};
#pragma unroll
  for (int d0 = 0; d0 < 8; ++d0) { int cb = (d0 * 16 + hi * 8) * 2;
    bf16x8 q = *reinterpret_cast<const bf16x8*>((const char*)Qs + KSWZ(qrow, cb));
    bf16x8 b0 = *reinterpret_cast<const bf16x8*>((const char*)Ks + KSWZ(r32, cb));
    bf16x8 b1 = *reinterpret_cast<const bf16x8*>((const char*)Ks + KSWZ(32 + r32, cb));
    p0 = __builtin_amdgcn_mfma_f32_32x32x16_bf16(b0, q, p0, 0, 0, 0);
    p1 = __builtin_amdgcn_mfma_f32_32x32x16_bf16(b1, q, p1, 0, 0, 0); }
}
__device__ __forceinline__ int v_st(int k, int c) { const int kk = (k & ~0xC) | ((k & 4) << 1) | ((k & 8) >> 1); return ((kk >> 3) * 4 + (c >> 5)) * 512 + ((kk & 7) * 32 + (c & 31)) * 2; }
__device__ __forceinline__ int v_rd_base(int lane) { return ((lane & 3) << 3) | (((lane >> 2) & 3) << 6) | (((lane >> 4) & 1) << 5) | (((lane >> 5) & 1) << 8); }
constexpr int v_rd_off(int d0, int ks, int half) { return d0 * 512 + ks * 4096 + half * 2048; }
template <int OFF> __device__ __forceinline__ s16x4 tr_read(int vb) {
  s16x4 r; asm volatile("ds_read_b64_tr_b16 %0, %1 offset:%2" : "=&v"(r) : "v"(vb), "i"(OFF) : "memory"); return r;
}
template <int D0> __device__ __forceinline__ void pv_one(f32x16& od, int vb, bf16x8 pa0, bf16x8 pa1, bf16x8 pa2, bf16x8 pa3) {
  const s16x4 l0 = tr_read<v_rd_off(D0, 0, 0)>(vb), h0 = tr_read<v_rd_off(D0, 0, 1)>(vb), l1 = tr_read<v_rd_off(D0, 1, 0)>(vb), h1 = tr_read<v_rd_off(D0, 1, 1)>(vb);
  const s16x4 l2 = tr_read<v_rd_off(D0, 2, 0)>(vb), h2 = tr_read<v_rd_off(D0, 2, 1)>(vb), l3 = tr_read<v_rd_off(D0, 3, 0)>(vb), h3 = tr_read<v_rd_off(D0, 3, 1)>(vb);
  asm volatile("s_waitcnt lgkmcnt(0)" ::: "memory"); SBAR();
#define PK(L, H) (bf16x8){L[0], L[1], L[2], L[3], H[0], H[1], H[2], H[3]}
  od = __builtin_amdgcn_mfma_f32_32x32x16_bf16(pa0, PK(l0, h0), od, 0, 0, 0);
  od = __builtin_amdgcn_mfma_f32_32x32x16_bf16(pa1, PK(l1, h1), od, 0, 0, 0);
  od = __builtin_amdgcn_mfma_f32_32x32x16_bf16(pa2, PK(l2, h2), od, 0, 0, 0);
  od = __builtin_amdgcn_mfma_f32_32x32x16_bf16(pa3, PK(l3, h3), od, 0, 0, 0);
#undef PK
}
__device__ __forceinline__ void pv_d0(f32x16* o, int vb, bf16x8 pa0, bf16x8 pa1, bf16x8 pa2, bf16x8 pa3) {
  pv_one<0>(o[0], vb, pa0, pa1, pa2, pa3); pv_one<1>(o[1], vb, pa0, pa1, pa2, pa3); pv_one<2>(o[2], vb, pa0, pa1, pa2, pa3); pv_one<3>(o[3], vb, pa0, pa1, pa2, pa3);
}

struct SrcOne { const bf16_t* k0; const bf16_t* v0; int ldk;
  __device__ __forceinline__ const bf16_t* k(int j) const { return k0 + (size_t)j * 64 * ldk; }
  __device__ __forceinline__ const bf16_t* v(int j) const { return v0 + (size_t)j * 64 * ldk; } };
struct SrcTwo { const bf16_t* ck; const bf16_t* cv; const bf16_t* k1; const bf16_t* v1; int ldk;
  __device__ __forceinline__ const bf16_t* k(int j) const { return j < 4 ? ck + (size_t)j * 64 * ldk : k1 + (size_t)(j - 4) * 64 * ldk; }
  __device__ __forceinline__ const bf16_t* v(int j) const { return j < 4 ? cv + (size_t)j * 64 * ldk : v1 + (size_t)(j - 4) * 64 * ldk; } };
struct NoBias { __device__ __forceinline__ void operator()(f32x16&, f32x16&, int, int, int, int) const {} };
struct NaBias { const float* tab; int i0, kr0;
  __device__ __forceinline__ void operator()(f32x16& p0, f32x16& p1, int jt, int wid, int r32, int hi) const {
    if (jt < 4) return;
    const int qi = i0 + wid * QBLK + r32, r = qi >> 6, qc = qi & 63, kr = kr0 + jt - 4;
    int lo = r - 4; lo = lo < 0 ? 0 : (lo > 8 ? 8 : lo);
    const bool rowok = (kr >= lo) && (kr < lo + 8);
    if (!rowok) {
#pragma unroll
      for (int rr = 0; rr < 16; ++rr) { p0[rr] = -1e30f; p1[rr] = -1e30f; }
      return;
    }
    int c0 = qc - 8; c0 = c0 < 0 ? 0 : (c0 > 48 ? 48 : c0);
    const int dr = kr - r + 7;
    const float* tb = tab + dr * 31 + (4 * hi - qc + 15);
    const int w0 = 4 * hi - c0;
#pragma unroll
    for (int g = 0; g < 4; ++g) {
#pragma unroll
      for (int q = 0; q < 4; ++q) {
        const int rr = 4 * g + q, kc0 = q + 8 * g;
        const float t0 = tb[kc0], t1 = tb[kc0 + 32];
        p0[rr] = ((unsigned)(kc0 + w0) < 16u) ? p0[rr] + t0 : -1e30f;
        p1[rr] = ((unsigned)(kc0 + 32 + w0) < 16u) ? p1[rr] + t1 : -1e30f;
      }
      SBAR();
    }
  } };

template <int SD, class Src, class Bias>
__device__ ATT_INLINE void attn_body(const bf16_t* __restrict__ Qb, const Src src, bf16_t* __restrict__ Ob, const int NT, char* lds, const Bias bias) {
  const int tid = opaque_tid(), wid = tid >> 6, lane = tid & 63, r32 = lane & 31, hi = lane >> 5;
  const int LDK = src.ldk;
  bf16_t* V_lds = (bf16_t*)lds; bf16_t* K_lds = (bf16_t*)(lds + 2 * SHM_V);
  float* ws = (float*)(lds + 2 * SHM_V + 2 * SHM_K) + wid * 64; float* li_l = ws; float* al_l = ws + 32;
  float m_reg = -1e30f, l_reg = 0; f32x16 o[4] = {};
  bf16_t* Q_lds = (bf16_t*)(lds + 2 * SHM_V + 2 * SHM_K + NW * 64 * 4);
  const int qrow = wid * QBLK + r32;
  {
#pragma unroll
    for (int i = 0; i < 8; ++i) { const int f = tid + 512 * i, row = f >> 4, c8 = (f & 15) * 8;
      *(bf16x8*)((char*)Q_lds + KSWZ(row, c8 * 2)) = *reinterpret_cast<const bf16x8*>(Qb + (long)row * LDQ + c8); }
  }
  const int sr = tid >> 4, sc = (tid & 15) * 8, vst0 = v_st(sr, sc), vst1 = v_st(32 + sr, sc);
  const int vb0 = (int)(uintptr_t)V_lds + v_rd_base(lane);
  struct { bf16x8 vs0, vs1, ks0, ks1; } sr_[SD];
#define SLOAD(i, jt) do { const bf16_t* kt_ = src.k(jt); const bf16_t* vt_ = src.v(jt); \
    sr_[i].vs0 = *reinterpret_cast<const bf16x8*>(&vt_[(long)sr * LDK + sc]); sr_[i].vs1 = *reinterpret_cast<const bf16x8*>(&vt_[(long)(32 + sr) * LDK + sc]); \
    sr_[i].ks0 = *reinterpret_cast<const bf16x8*>(&kt_[(long)sr * LDK + sc]); sr_[i].ks1 = *reinterpret_cast<const bf16x8*>(&kt_[(long)(32 + sr) * LDK + sc]); } while (0)
#define SWRITE(b, i) do { *(bf16x8*)((char*)V_lds + (b) * SHM_V + vst0) = sr_[i].vs0;          \
    *(bf16x8*)((char*)V_lds + (b) * SHM_V + vst1) = sr_[i].vs1; int kc = sc * 2;               \
    *(bf16x8*)((char*)K_lds + (b) * SHM_K + KSWZ(sr, kc)) = sr_[i].ks0;                       \
    *(bf16x8*)((char*)K_lds + (b) * SHM_K + KSWZ(32 + sr, kc)) = sr_[i].ks1; } while (0)
#define SWAIT() do { if constexpr (SD == 2) asm volatile("s_waitcnt vmcnt(4)" ::: "memory"); else asm volatile("s_waitcnt vmcnt(0)" ::: "memory"); } while (0)
#define RESC(a) do { if (__any((a) < 1.f)) { if (hi == 0) al_l[r32] = (a); asm volatile("s_waitcnt lgkmcnt(0)" ::: "memory"); \
    for (int d = 0; d < 4; ++d) for (int r = 0; r < 16; ++r) o[d][r] *= al_l[crow(r, hi)]; } } while (0)
  f32x16 pA0, pA1, pB0, pB1; float mnA, mnB, alA, alB; bf16x8 pa0, pa1, pa2, pa3;
  constexpr int SE = 0, SO = SD - 1;
  SLOAD(SE, 0); asm volatile("s_waitcnt vmcnt(0)" ::: "memory"); SWRITE(0, SE); __syncthreads();
  qkt(pA0, pA1, K_lds, Q_lds, qrow, r32, hi); bias(pA0, pA1, 0, wid, r32, hi); partialSM(pA0, pA1, m_reg, mnA, alA);
  SLOAD(SO, 1); if constexpr (SD == 2) { if (2 < NT) SLOAD(SE, 2); }
  SWAIT(); SWRITE(1, SO); __syncthreads();
  for (int j = 1; j + 1 < NT; j += 2) {
    SBAR(); qkt(pB0, pB1, (bf16_t*)((char*)K_lds + SHM_K), Q_lds, qrow, r32, hi); bias(pB0, pB1, j, wid, r32, hi);
    finishSM(pA0, pA1, alA, l_reg, pa0, pa1, pa2, pa3); SBAR();
    SLOAD(SO, j + SD); SBAR();
    pv_d0(o, vb0, pa0, pa1, pa2, pa3); partialSM(pB0, pB1, m_reg, mnB, alB);
    __syncthreads(); SWAIT(); SWRITE(0, SE);
    RESC(alB); __syncthreads();
    SBAR(); qkt(pA0, pA1, K_lds, Q_lds, qrow, r32, hi); bias(pA0, pA1, j + 1, wid, r32, hi);
    finishSM(pB0, pB1, alB, l_reg, pa0, pa1, pa2, pa3); SBAR();
    if (SD == 1 || j + 3 < NT) SLOAD(SE, j + 1 + SD); SBAR();
    pv_d0(o, vb0 + (int)SHM_V, pa0, pa1, pa2, pa3); partialSM(pA0, pA1, m_reg, mnA, alA);
    __syncthreads(); SWAIT(); SWRITE(1, SO);
    RESC(alA); __syncthreads();
  }
  SBAR(); qkt(pB0, pB1, (bf16_t*)((char*)K_lds + SHM_K), Q_lds, qrow, r32, hi); bias(pB0, pB1, NT - 1, wid, r32, hi);
  finishSM(pA0, pA1, alA, l_reg, pa0, pa1, pa2, pa3); SBAR();
  pv_d0(o, vb0, pa0, pa1, pa2, pa3); partialSM(pB0, pB1, m_reg, mnB, alB);
  __syncthreads(); RESC(alB);
  finishSM(pB0, pB1, alB, l_reg, pa0, pa1, pa2, pa3); SBAR();
  pv_d0(o, vb0 + (int)SHM_V, pa0, pa1, pa2, pa3);
  if (hi == 0) li_l[r32] = l_reg; asm volatile("s_waitcnt lgkmcnt(0)" ::: "memory");
  float rli[16];
#pragma unroll
  for (int r = 0; r < 16; ++r) rli[r] = __builtin_amdgcn_rcpf(li_l[crow(r, hi)]);
  bf16_t* Ow = Ob + (long)(wid * QBLK) * LDO;
#pragma unroll
  for (int r = 0; r < 16; ++r) { int orow = crow(r, hi);
    for (int d0 = 0; d0 < 4; ++d0) Ow[(long)orow * LDO + d0 * 32 + r32] = f2bf(o[d0][r] * rli[r]); }
#undef SLOAD
#undef SWRITE
#undef SWAIT
#undef RESC
}
}
#define LAS __attribute__((address_space(3)))
constexpr int LDS_BYTES = 147456, XBW_OFF = LDS_BYTES - 64;
constexpr int NPH = 1 + DEPTH * 12;
#ifndef DBG_NLAYERS
#define DBG_NLAYERS DEPTH
#endif

#ifndef DUPKIND
#define DUPKIND 0
#endif
__device__ __forceinline__ int opaque_int(int v) { asm volatile("" : "+s"(v)); return v; }
#ifndef MIXMASK
#define MIXMASK 0xFF
#endif
#define FOR_ITEMS(it, n, o, w) for (int bo_ = (o) * (int)gridDim.x / 256, bw_ = ((w) * (int)gridDim.x / 256) > 0 ? ((w) * (int)gridDim.x / 256) : 1, \
                                    it = ((int)blockIdx.x >= bo_ && (int)blockIdx.x < bo_ + bw_) ? (int)blockIdx.x - bo_ : (n); it < (n); it += bw_)

constexpr int QCTR_WORD0 = 1024;
constexpr int NI_GDNL = LB * 16, NI_GLAL = LB * 16, NI_GDNC = CB * 16, NI_GQAL = LB * 16, NI_NAL = LB * 16, NI_GLAC = CB * 16, NI_NAC = CB * 4, NI_GQAC = CB * 4;
constexpr int Q0 = NI_GDNL, Q1 = Q0 + NI_GLAL, Q2 = Q1 + NI_GDNC, Q3 = Q2 + NI_GQAL, Q4 = Q3 + NI_NAL, Q5 = Q4 + NI_GLAC, Q6 = Q5 + NI_NAC, Q7 = Q6 + NI_GQAC;
__device__ __forceinline__ void phase_mix(const Params& p, int l, unsigned char* lds) {
    const int tid = opaque_tid();
    float* smem = (float*)lds;
    const bf16_t* NAQ = WSP(bf16_t, WS_NAQ); const bf16_t* NAK = WSP(bf16_t, WS_NAK); const bf16_t* NAV = WSP(bf16_t, WS_NAV);
    const bf16_t* GQ = WSP(bf16_t, WS_GQ); const bf16_t* GK = WSP(bf16_t, WS_GK); const bf16_t* GV = WSP(bf16_t, WS_GV);
    bf16_t* MRG = WSP(bf16_t, WS_MRG);
    unsigned* qctr = WSP(unsigned, WS_CTL) + QCTR_WORD0 + 64 * l;
    volatile int* qslot = (volatile int*)(lds + XBW_OFF + 16);
    for (;;) {
        __syncthreads();
        if (tid == 0) *qslot = (int)__hip_atomic_fetch_add(qctr, 1u, __ATOMIC_RELAXED, __HIP_MEMORY_SCOPE_AGENT);
        __syncthreads();
        const int q = __builtin_amdgcn_readfirstlane(*qslot);
        if (q >= Q7) break;
        if (q < Q0) { const int it = q; gdn_chain(p, l, false, it / 16, (it / 4) % 4, (it / 2) % 2, it % 2, smem); }
        else if (q < Q1) { const int it = q - Q0; gla_chain(p, l, false, it / 16, (it / 4) % 4, (it / 2) % 2, it % 2, smem); }
        else if (q < Q2) { const int it = q - Q1; gdn_chain(p, l, true, it / 16, (it / 4) % 4, (it / 2) % 2, it % 2, smem); }
        else if (q < Q3) {
            const int it = q - Q2, b = it / 16, qh = (it / 4) % 4, qb = it % 4, kvh = qh >> 1;
            const size_t r0 = (size_t)MC + (size_t)b * LT;
            att::SrcTwo src{WSP(bf16_t, WS_CGK) + ((size_t)b * DEPTH + l) * 256 * 256 + kvh * 128, WSP(bf16_t, WS_CGV) + ((size_t)b * DEPTH + l) * 256 * 256 + kvh * 128,
                            GK + r0 * 256 + kvh * 128, GV + r0 * 256 + kvh * 128, 256};
            att::attn_body<2>(GQ + (r0 + qb * 256) * 512 + qh * 128, src, MRG + (r0 + qb * 256) * DM + 1024 + qh * 128, 4 + LT / 64, (char*)lds, att::NoBias{});
        }
        else if (q < Q4) {
            const int it = q - Q3, b = it / 16, h = (it / 4) % 4, qb = it % 4;
            const int kr0 = qb == 0 ? 0 : qb == 1 ? 0 : qb == 2 ? 4 : 8, nrows = (qb == 0 || qb == 3) ? 8 : 12;
            const size_t r0 = (size_t)MC + (size_t)b * LT;
            float* tab = (float*)(lds + att::SHM_ATTN);
            if (tid < 15 * 31) tab[tid] = p.in[I_RPB][((size_t)l * 4 + h) * 15 * 31 + tid] * (1.0f / att::SCALE);
            att::SrcTwo src{WSP(bf16_t, WS_CNAK) + ((size_t)b * DEPTH + l) * 256 * 512 + h * 128, WSP(bf16_t, WS_CNAV) + ((size_t)b * DEPTH + l) * 256 * 512 + h * 128,
                            NAK + (r0 + kr0 * 64) * 512 + h * 128, NAV + (r0 + kr0 * 64) * 512 + h * 128, 512};
            att::attn_body<1>(NAQ + (r0 + qb * 256) * 512 + h * 128, src, MRG + (r0 + qb * 256) * DM + 0 + h * 128, 4 + nrows, (char*)lds, att::NaBias{tab, qb * 256, kr0});
        }
        else if (q < Q5) { const int it = q - Q4; gla_chain(p, l, true, it / 16, (it / 4) % 4, (it / 2) % 2, it % 2, smem); }
        else if (q < Q6) {
            const int it = q - Q5, b = it / 4, h = it % 4; const size_t r0 = (size_t)b * CT;
            att::SrcOne src{NAK + r0 * 512 + h * 128, NAV + r0 * 512 + h * 128, 512};
            att::attn_body<2>(NAQ + r0 * 512 + h * 128, src, MRG + r0 * DM + 0 + h * 128, CT / 64, (char*)lds, att::NoBias{});
        }
        else {
            const int it = q - Q6, b = it / 4, qh = it % 4, kvh = qh >> 1; const size_t r0 = (size_t)b * CT;
            att::SrcOne src{GK + r0 * 256 + kvh * 128, GV + r0 * 256 + kvh * 128, 256};
            att::attn_body<2>(GQ + r0 * 512 + qh * 128, src, MRG + r0 * DM + 1024 + qh * 128, CT / 64, (char*)lds, att::NoBias{});
        }
    }
}

static_assert(att::SHM_ATTN + 15 * 31 * 4 + 2048 <= (size_t)XBW_OFF, "LDS map");
static_assert((QCTR_WORD0 + 64 * DEPTH) < 4096, "ctl");
constexpr int BAR_WORD0 = 4096;
static_assert((BAR_WORD0 + XCD_BAR_WORDS) * 4 <= (int)CTL_BYTES, "ctl");

__global__ void __launch_bounds__(512, 2) fwd(Params p) {
    extern __shared__ __attribute__((aligned(16))) unsigned char lds[];
    const int tid = threadIdx.x;
    volatile LAS unsigned* xbw = (volatile LAS unsigned*)((LAS unsigned char*)lds + XBW_OFF);
    if (tid < 4) xbw[tid] = 0u;
    __syncthreads();
    XcdBarrier bar; bar.bar = WSP(unsigned, WS_CTL) + BAR_WORD0; bar.x = 0; bar.st = xbw;
    if (p.ph_hi - p.ph_lo > 1) bar = xcd_barrier_post(WSP(unsigned, WS_CTL) + BAR_WORD0, xbw);
#ifndef PHMASK
#define PHMASK 0x1FFF
#endif
#define IN(k) (p.ph_lo <= (k) && (k) < p.ph_hi)
#define INL(j) (((PHMASK >> ((j) + 1)) & 1) && IN(pb + (j)))
#ifndef DUPMASK
#define DUPMASK 0
#endif
#define DUP(j) ((DUPMASK >> ((j) + 1)) & 1)
#define SEAM(k) do { if (IN(k) && IN((k) + 1)) xcd_barrier(bar); } while (0)
    LAS unsigned char* ldsl = (LAS unsigned char*)lds;
    bf16_t* H = WSP(bf16_t, WS_H); bf16_t* ACT = WSP(bf16_t, WS_ACT); float* X = WSP(float, WS_X); float* Z = WSP(float, WS_Z); bf16_t* MRG = WSP(bf16_t, WS_MRG);

    if ((PHMASK & 1) && IN(0)) { int reps_ = 1 + (DUPMASK & 1); asm volatile("" : "+s"(reps_)); for (int rep_ = 0; rep_ < reps_; ++rep_) { const Params q = opaque_params(p); phase_prologue(q, (float*)lds); __syncthreads(); } }
    SEAM(0);
    for (int l = 0; l < DBG_NLAYERS; ++l) {
        const int pb = 1 + l * 12;
        const float* modl = WSP(float, WS_MODV) + (size_t)l * NCOND * NMOD;
        if (INL(0)) { int reps_ = 1 + DUP(0); asm volatile("" : "+s"(reps_)); for (int rep_ = 0; rep_ < reps_; ++rep_) { const Params q = opaque_params(p); phase_norm(q, l, 0); __syncthreads(); } }
        SEAM(pb + 0);
        if (INL(1)) {
            pg8::Gemm g{H, WSP(bf16_t, WS_WGU) + ((size_t)l * 2 + 0) * NGU * DM, M, NGU, DM}; pg8::StaticOrder S; S.init(M, NGU, (int)gridDim.x, (int)blockIdx.x);
            pg8::EpiSwiGLU E{ACT, FF};
            for (int r_ = 0, n_ = opaque_int(1 + DUP(1)); r_ < n_; ++r_) pg8::gemm_phase<pg8::EpiSwiGLU, pg8::StaticOrder, false>(ldsl, g, S, E, nullptr);
        }
        SEAM(pb + 1);
        if (INL(2)) {
            pg8::Gemm g{ACT, WSP(bf16_t, WS_WDN) + ((size_t)l * 2 + 0) * DM * FF, M, DM, FF}; pg8::StaticOrder S; S.init(M, DM, (int)gridDim.x, (int)blockIdx.x);
            pg8::EpiResid E{X, X, DM, modl + 2 * DM, 0.5f};
            pg8::gemm_phase<pg8::EpiResid, pg8::StaticOrder, false>(ldsl, g, S, E, nullptr);
        }
        SEAM(pb + 2);
        if (INL(3)) { int reps_ = 1 + DUP(3); asm volatile("" : "+s"(reps_)); for (int rep_ = 0; rep_ < reps_; ++rep_) { const Params q = opaque_params(p); phase_norm(q, l, 1); __syncthreads(); } }
        SEAM(pb + 3);
        if (INL(4)) {
            pg8::Gemm g{H, WSP(bf16_t, WS_WIN) + (size_t)l * NINP * DM, M, NINP, DM}; pg8::StaticOrder S; S.init(M, NINP, (int)gridDim.x, (int)blockIdx.x);
            pg8::EpiF32 E{Z, NINP, nullptr};
            for (int r_ = 0, n_ = opaque_int(1 + DUP(4)); r_ < n_; ++r_) pg8::gemm_phase<pg8::EpiF32, pg8::StaticOrder, false>(ldsl, g, S, E, nullptr);
        }
        SEAM(pb + 4);
        if (INL(5)) { int reps_ = 1 + DUP(5); asm volatile("" : "+s"(reps_)); for (int rep_ = 0; rep_ < reps_; ++rep_) { const Params q = opaque_params(p); phase_prep(q, l); __syncthreads(); } }
        SEAM(pb + 5);
        if (INL(6)) { int reps_ = 1 + DUP(6); asm volatile("" : "+s"(reps_)); for (int rep_ = 0; rep_ < reps_; ++rep_) { const Params q = opaque_params(p); phase_mix(q, l, lds); __syncthreads(); } }
        SEAM(pb + 6);
        if (INL(7)) { int reps_ = 1 + DUP(7); asm volatile("" : "+s"(reps_)); for (int rep_ = 0; rep_ < reps_; ++rep_) { const Params q = opaque_params(p); phase_post(q, l); __syncthreads(); } }
        SEAM(pb + 7);
        if (INL(8)) {
            pg8::Gemm g{MRG, WSP(bf16_t, WS_WOUT) + (size_t)l * DM * DM, M, DM, DM}; pg8::StaticOrder S; S.init(M, DM, (int)gridDim.x, (int)blockIdx.x);
            pg8::EpiResid E{X, X, DM, modl + 5 * DM, 1.0f};
            pg8::gemm_phase<pg8::EpiResid, pg8::StaticOrder, false>(ldsl, g, S, E, nullptr);
        }
        SEAM(pb + 8);
        if (INL(9)) { int reps_ = 1 + DUP(9); asm volatile("" : "+s"(reps_)); for (int rep_ = 0; rep_ < reps_; ++rep_) { const Params q = opaque_params(p); phase_norm(q, l, 2); __syncthreads(); } }
        SEAM(pb + 9);
        if (INL(10)) {
            pg8::Gemm g{H, WSP(bf16_t, WS_WGU) + ((size_t)l * 2 + 1) * NGU * DM, M, NGU, DM}; pg8::StaticOrder S; S.init(M, NGU, (int)gridDim.x, (int)blockIdx.x);
            pg8::EpiSwiGLU E{ACT, FF};
            pg8::gemm_phase<pg8::EpiSwiGLU, pg8::StaticOrder, false>(ldsl, g, S, E, nullptr);
        }
        SEAM(pb + 10);
        if (INL(11)) {
            pg8::Gemm g{ACT, WSP(bf16_t, WS_WDN) + ((size_t)l * 2 + 1) * DM * FF, M, DM, FF}; pg8::StaticOrder S; S.init(M, DM, (int)gridDim.x, (int)blockIdx.x);
            pg8::EpiResid E{X, (l == DEPTH - 1) ? p.out : X, DM, modl + 8 * DM, 0.5f};
            pg8::gemm_phase<pg8::EpiResid, pg8::StaticOrder, false>(ldsl, g, S, E, nullptr);
        }
        SEAM(pb + 11);
    }
#undef IN
#undef SEAM
}

#ifndef MULTI_LAUNCH
#define MULTI_LAUNCH 0
#endif
extern "C" void kernel_launch(void* const* d_in, const int* in_sizes, int n_in, void* d_out, int out_size, void* d_ws, size_t ws_size, hipStream_t stream) {
    static int grid = 0;
    if (grid == 0) {
        if (n_in != N_IN || (size_t)out_size != O_END || ws_size < WS_END) { fprintf(stderr, "kernel_launch: shape mismatch n_in %d out %d ws %zu (need %zu)\n", n_in, out_size, ws_size, (size_t)WS_END); grid = -1; return; }
        int dev = 0, cus = 0, per_cu = 0;
        if (hipGetDevice(&dev) != hipSuccess || hipDeviceGetAttribute(&cus, hipDeviceAttributeMultiprocessorCount, dev) != hipSuccess) { grid = -1; return; }
        if (hipFuncSetAttribute((const void*)fwd, hipFuncAttributeMaxDynamicSharedMemorySize, LDS_BYTES) != hipSuccess) { fprintf(stderr, "kernel_launch: hipFuncSetAttribute failed\n"); grid = -1; return; }
        if (hipOccupancyMaxActiveBlocksPerMultiprocessor(&per_cu, (const void*)fwd, 512, LDS_BYTES) != hipSuccess || per_cu < 1) { fprintf(stderr, "kernel_launch: occupancy query says %d\n", per_cu); (void)hipGetLastError(); }
        grid = cus;
    }
    if (grid < 0) return;
    (void)hipMemsetAsync((char*)d_ws + WS_CTL, 0, CTL_BYTES, stream);
    Params p{};
    for (int i = 0; i < N_IN; ++i) p.in[i] = (const float*)d_in[i];
    p.out = (float*)d_out; p.ws = (unsigned char*)d_ws;
#if MULTI_LAUNCH
    for (int ph = 0; ph < 1 + DBG_NLAYERS * 12; ++ph) { p.ph_lo = ph; p.ph_hi = ph + 1; hipLaunchKernelGGL(fwd, dim3(grid), dim3(512), LDS_BYTES, stream, p); }
#else
    p.ph_lo = 0; p.ph_hi = NPH; hipLaunchKernelGGL(fwd, dim3(grid), dim3(512), LDS_BYTES, stream, p);
#endif
    const hipError_t le = hipPeekAtLastError();
    if (le != hipSuccess) fprintf(stderr, "kernel_launch: launch failed: %s\n", hipGetErrorName(le));
}
```

```cpp
#include <hip/hip_runtime.h>
#include <cstdio>
#include <cstdint>

#ifndef CB_
#define CB_ 16
#endif
#ifndef LB_
#define LB_ 8
#endif
#ifndef DEPTH_
#define DEPTH_ 4
#endif
constexpr int DM = 2048, DEPTH = DEPTH_, CB = CB_, CT = 256, LB = LB_, LT = 1024;
constexpr int MC = CB * CT, ML = LB * LT, M = MC + ML;
constexpr int FF = 5504, NGU = 2 * FF, NIN = 6192, NINP = 6400, NMOD = 9 * DM, NCOND = 1 + LB;
constexpr float EPS = 1e-6f;
constexpr int Z_NAQ = 0, Z_NAK = 512, Z_NAV = 1024, Z_GLQ = 1536, Z_GLK = 1792, Z_GLV = 2048, Z_GLR = 2560, Z_GF = 3072, Z_GB = 3088,
              Z_GQQ = 3104, Z_GQK = 3616, Z_GQV = 3872, Z_DQKV = 4128, Z_DZ = 5664, Z_DB = 6176, Z_DA = 6184;
static_assert(Z_DA + 8 == NIN, "split");
enum { I_XP = 0, I_XS, I_CNAK, I_CNAV, I_CGK, I_CGV, I_SGLA, I_SGDN, I_C, I_CCTX, I_NORMG, I_WMOD, I_BMOD, I_GU, I_DOWN, I_WIN, I_WOUT, I_NAQKN, I_RPB,
       I_GUP, I_GBIAS, I_GLAON, I_GQAQKN, I_CONV, I_ALOG, I_DTB, I_GDNON, N_IN };
constexpr size_t O_YP = 0, O_YS = O_YP + (size_t)MC * DM, O_NAK = O_YS + (size_t)ML * DM, O_NAV = O_NAK + (size_t)CB * DEPTH * 4 * CT * 128,
                 O_GK = O_NAV + (size_t)CB * DEPTH * 4 * CT * 128, O_GV = O_GK + (size_t)CB * DEPTH * 2 * CT * 128,
                 O_SGLA = O_GV + (size_t)CB * DEPTH * 2 * CT * 128, O_SGDN = O_SGLA + (size_t)CB * DEPTH * 2 * 4 * 64 * 128,
                 O_END = O_SGDN + (size_t)CB * DEPTH * 2 * 4 * 128 * 128;
constexpr size_t al256(size_t x) { return (x + 255) & ~(size_t)255; }
constexpr size_t WS_CTL = 0, CTL_BYTES = 1u << 20;
constexpr size_t WS_WGU = CTL_BYTES;
constexpr size_t WS_WDN = WS_WGU + (size_t)DEPTH * 2 * NGU * DM * 2;
constexpr size_t WS_WIN = WS_WDN + (size_t)DEPTH * 2 * DM * FF * 2;
constexpr size_t WS_WOUT = WS_WIN + (size_t)DEPTH * NINP * DM * 2;
constexpr size_t WS_MODV = WS_WOUT + (size_t)DEPTH * DM * DM * 2;
constexpr size_t WS_ROPE = al256(WS_MODV + (size_t)DEPTH * NCOND * NMOD * 4);
constexpr size_t WS_X = al256(WS_ROPE + 2 * 64 * 32 * 4);
constexpr size_t WS_H = WS_X + (size_t)M * DM * 4;
constexpr size_t WS_ACT = WS_H + (size_t)M * DM * 2;
constexpr size_t WS_Z = WS_ACT + (size_t)M * FF * 2;
constexpr size_t WS_MRG = WS_Z + (size_t)M * NINP * 4;
constexpr size_t WS_NAQ = WS_MRG + (size_t)M * DM * 2;
constexpr size_t WS_NAK = WS_NAQ + (size_t)M * 512 * 2;
constexpr size_t WS_NAV = WS_NAK + (size_t)M * 512 * 2;
constexpr size_t WS_GQ = WS_NAV + (size_t)M * 512 * 2;
constexpr size_t WS_GK = WS_GQ + (size_t)M * 512 * 2;
constexpr size_t WS_GV = WS_GK + (size_t)M * 256 * 2;
constexpr size_t WS_CNAK = WS_GV + (size_t)M * 256 * 2;
constexpr size_t WS_CNAV = WS_CNAK + (size_t)LB * DEPTH * 256 * 512 * 2;
constexpr size_t WS_CGK = WS_CNAV + (size_t)LB * DEPTH * 256 * 512 * 2;
constexpr size_t WS_CGV = WS_CGK + (size_t)LB * DEPTH * 256 * 256 * 2;
constexpr size_t WS_AF = WS_CGV + (size_t)LB * DEPTH * 256 * 256 * 2;
constexpr size_t WS_AB = WS_AF + (size_t)M * 256 * 4;
constexpr size_t WS_DQ = WS_AB + (size_t)M * 256 * 4;
constexpr size_t WS_DK = WS_DQ + (size_t)M * 512 * 4;
constexpr size_t WS_DV = WS_DK + (size_t)M * 512 * 4;
constexpr size_t WS_DBA = WS_DV + (size_t)M * 512 * 4;
constexpr size_t WS_GOF = WS_DBA + (size_t)M * 16 * 4;
constexpr size_t WS_GOB = WS_GOF + (size_t)M * 512 * 4;
constexpr size_t WS_DOF = WS_GOB + (size_t)M * 512 * 4;
constexpr size_t WS_DOB = WS_DOF + (size_t)M * 512 * 4;
constexpr size_t WS_END = WS_DOB + (size_t)M * 512 * 4;

typedef unsigned short bf16_t;
struct Params { const float* in[N_IN]; float* out; unsigned char* ws; int ph_lo, ph_hi; };
static_assert(sizeof(Params) == N_IN * 8 + 8 + 8 + 8, "no padding");

#define WSP(T, off) ((T*)(p.ws + (off)))
__device__ __forceinline__ int opaque_tid() { int t = (int)threadIdx.x; asm volatile("" : "+v"(t)); return t; }
__device__ __forceinline__ Params opaque_params(const Params& p) { Params q = p; unsigned long long w = (unsigned long long)q.ws; asm volatile("" : "+s"(w)); q.ws = (unsigned char*)w; return q; }

__device__ __forceinline__ float wave_sum(float v) {
#pragma unroll
    for (int o = 32; o >= 1; o >>= 1) v += __shfl_xor(v, o);
    return v;
}
__device__ __forceinline__ bf16_t f2bf(float f) { unsigned u = __float_as_uint(f); u += 0x7FFFu + ((u >> 16) & 1u); return (bf16_t)(u >> 16); }
__device__ __forceinline__ unsigned pack2(float a, float b) { return (unsigned)f2bf(a) | ((unsigned)f2bf(b) << 16); }
__device__ __forceinline__ float silu_f(float x) { return x / (1.f + expf(-x)); }
__device__ __forceinline__ float softplus_f(float x) { return fmaxf(x, 0.f) + log1pf(expf(-fabsf(x))); }
__device__ __forceinline__ float logsigmoid_f(float x) { return fminf(x, 0.f) - log1pf(expf(-fabsf(x))); }
__device__ __forceinline__ int cond_of_row(int m) { return m < MC ? 0 : 1 + (m - MC) / LT; }
typedef float vf4 __attribute__((ext_vector_type(4)));
__device__ __forceinline__ void conv_tile(const float* __restrict__ src, int ld_src, int ncols_src, int k0, int c0, bf16_t* __restrict__ dst, int ld_dst, int n0, float* tile) {
    const int tid = opaque_tid();
    {
        const int r = tid >> 3, c = (tid & 7) * 8;
        float4 a = make_float4(0.f, 0.f, 0.f, 0.f), b = a;
        if (c0 + c + 8 <= ncols_src) {
            const float* s = src + (size_t)(k0 + r) * ld_src + c0 + c;
            a = *(const float4*)s; b = *(const float4*)(s + 4);
        }
        float* t = tile + r * 65 + c;
        t[0] = a.x; t[1] = a.y; t[2] = a.z; t[3] = a.w; t[4] = b.x; t[5] = b.y; t[6] = b.z; t[7] = b.w;
    }
    __syncthreads();
    {
        const int n = tid >> 3, ks = (tid & 7) * 8;
        const float* t = tile + ks * 65 + n;
        uint4 w;
        w.x = pack2(t[0 * 65], t[1 * 65]); w.y = pack2(t[2 * 65], t[3 * 65]); w.z = pack2(t[4 * 65], t[5 * 65]); w.w = pack2(t[6 * 65], t[7 * 65]);
        *(uint4*)(dst + (size_t)(n0 + n) * ld_dst + k0 + ks) = w;
    }
    __syncthreads();
}

constexpr int MOD_ITEMS = DEPTH * (NMOD / 128);
constexpr int TGU_KT = DM / 64, TGU_NT = NGU / 64, TDN_KT = FF / 64, TDN_NT = DM / 64, TIN_KT = DM / 64, TIN_NT = NINP / 64, TOUT_KT = DM / 64, TOUT_NT = DM / 64;
constexpr int T_GU = DEPTH * 2 * TGU_KT * TGU_NT, T_DN = DEPTH * 2 * TDN_KT * TDN_NT, T_IN = DEPTH * TIN_KT * TIN_NT, T_OUT = DEPTH * TOUT_KT * TOUT_NT;

__device__ __forceinline__ void phase_prologue(const Params& p, float* smem) {
    const int tid = opaque_tid(), nb = gridDim.x, bid = blockIdx.x;
    float* s_cond = smem;
    float* s_red = s_cond + NCOND * DM;
    float* s_tile = s_red + 3 * 128 * NCOND;
    for (int i = tid; i < NCOND * DM; i += 512) { const int ci = i / DM, k = i % DM; const float v = ci == 0 ? p.in[I_CCTX][k] : p.in[I_C][(size_t)(ci - 1) * DM + k]; s_cond[i] = silu_f(v); }
    __syncthreads();
    float* modv = WSP(float, WS_MODV);
    for (int it = bid; it < MOD_ITEMS; it += nb) {
        const int l = it / (NMOD / 128), jt = it % (NMOD / 128);
        const int cl = tid & 127, kq = tid >> 7, col = jt * 128 + cl;
        const float* w = p.in[I_WMOD] + (size_t)l * DM * NMOD + col;
        float acc[NCOND];
#pragma unroll
        for (int ci = 0; ci < NCOND; ++ci) acc[ci] = 0.f;
        for (int k = kq * 512; k < kq * 512 + 512; k += 8) {
            float wv[8];
#pragma unroll
            for (int j = 0; j < 8; ++j) wv[j] = w[(size_t)(k + j) * NMOD];
#pragma unroll
            for (int ci = 0; ci < NCOND; ++ci) {
                const float4 s0 = *(const float4*)&s_cond[ci * DM + k], s1 = *(const float4*)&s_cond[ci * DM + k + 4];
                acc[ci] += s0.x * wv[0] + s0.y * wv[1] + s0.z * wv[2] + s0.w * wv[3] + s1.x * wv[4] + s1.y * wv[5] + s1.z * wv[6] + s1.w * wv[7];
            }
        }
        if (kq > 0) {
#pragma unroll
            for (int ci = 0; ci < NCOND; ++ci) s_red[((kq - 1) * 128 + cl) * NCOND + ci] = acc[ci];
        }
        __syncthreads();
        if (kq == 0) {
            const float bm = p.in[I_BMOD][(size_t)l * NMOD + col];
#pragma unroll
            for (int ci = 0; ci < NCOND; ++ci)
                modv[((size_t)l * NCOND + ci) * NMOD + col] = acc[ci] + s_red[(0 * 128 + cl) * NCOND + ci] + s_red[(1 * 128 + cl) * NCOND + ci] + s_red[(2 * 128 + cl) * NCOND + ci] + bm;
        }
        __syncthreads();
    }
    for (int it = bid; it < T_GU + T_DN + T_IN + T_OUT; it += nb) {
        if (it < T_GU) {
            const int mat = it / (TGU_KT * TGU_NT), r = it % (TGU_KT * TGU_NT), kt = r / TGU_NT, nt = r % TGU_NT;
            const int n0 = nt * 64, t256 = n0 / 256, c = n0 % 256;
            const int c0 = c < 128 ? 128 * t256 + c : FF + 128 * t256 + (c - 128);
            conv_tile(p.in[I_GU] + (size_t)mat * DM * NGU, NGU, NGU, kt * 64, c0, WSP(bf16_t, WS_WGU) + (size_t)mat * NGU * DM, DM, n0, s_tile);
        } else if (it < T_GU + T_DN) {
            const int i2 = it - T_GU, mat = i2 / (TDN_KT * TDN_NT), r = i2 % (TDN_KT * TDN_NT), kt = r / TDN_NT, nt = r % TDN_NT;
            conv_tile(p.in[I_DOWN] + (size_t)mat * FF * DM, DM, DM, kt * 64, nt * 64, WSP(bf16_t, WS_WDN) + (size_t)mat * DM * FF, FF, nt * 64, s_tile);
        } else if (it < T_GU + T_DN + T_IN) {
            const int i2 = it - T_GU - T_DN, mat = i2 / (TIN_KT * TIN_NT), r = i2 % (TIN_KT * TIN_NT), kt = r / TIN_NT, nt = r % TIN_NT;
            conv_tile(p.in[I_WIN] + (size_t)mat * DM * NIN, NIN, NIN, kt * 64, nt * 64, WSP(bf16_t, WS_WIN) + (size_t)mat * NINP * DM, DM, nt * 64, s_tile);
        } else {
            const int i2 = it - T_GU - T_DN - T_IN, mat = i2 / (TOUT_KT * TOUT_NT), r = i2 % (TOUT_KT * TOUT_NT), kt = r / TOUT_NT, nt = r % TOUT_NT;
            conv_tile(p.in[I_WOUT] + (size_t)mat * DM * DM, DM, DM, kt * 64, nt * 64, WSP(bf16_t, WS_WOUT) + (size_t)mat * DM * DM, DM, nt * 64, s_tile);
        }
    }
    const size_t gtid = (size_t)bid * 512 + tid, gstride = (size_t)nb * 512;
    {
        float4* X = WSP(float4, WS_X);
        const float4* xp = (const float4*)p.in[I_XP]; const float4* xs = (const float4*)p.in[I_XS];
        const size_t nc = (size_t)MC * DM / 4, n = (size_t)M * DM / 4;
        for (size_t i = gtid; i < n; i += gstride) X[i] = i < nc ? xp[i] : xs[i - nc];
    }
    {
        const size_t n_na = (size_t)LB * DEPTH * 256 * 512 / 8;
        for (size_t i = gtid; i < 2 * n_na; i += gstride) {
            const bool isv = i >= n_na; const size_t j = isv ? i - n_na : i;
            const int d8 = (int)(j % 16), h = (int)((j / 16) % 4), t = (int)((j / 64) % 256); const size_t bl = j / (64 * 256);
            const float* s = p.in[isv ? I_CNAV : I_CNAK] + ((bl * 4 + h) * 256 + t) * 128 + d8 * 8;
            const float4 a = *(const float4*)s, b = *(const float4*)(s + 4);
            uint4 w; w.x = pack2(a.x, a.y); w.y = pack2(a.z, a.w); w.z = pack2(b.x, b.y); w.w = pack2(b.z, b.w);
            *(uint4*)(WSP(bf16_t, isv ? WS_CNAV : WS_CNAK) + (bl * 256 + t) * 512 + h * 128 + d8 * 8) = w;
        }
        const size_t n_g = (size_t)LB * DEPTH * 256 * 256 / 8;
        for (size_t i = gtid; i < 2 * n_g; i += gstride) {
            const bool isv = i >= n_g; const size_t j = isv ? i - n_g : i;
            const int d8 = (int)(j % 16), h = (int)((j / 16) % 2), t = (int)((j / 32) % 256); const size_t bl = j / (32 * 256);
            const float* s = p.in[isv ? I_CGV : I_CGK] + ((bl * 2 + h) * 256 + t) * 128 + d8 * 8;
            const float4 a = *(const float4*)s, b = *(const float4*)(s + 4);
            uint4 w; w.x = pack2(a.x, a.y); w.y = pack2(a.z, a.w); w.z = pack2(b.x, b.y); w.w = pack2(b.z, b.w);
            *(uint4*)(WSP(bf16_t, isv ? WS_CGV : WS_CGK) + (bl * 256 + t) * 256 + h * 128 + d8 * 8) = w;
        }
    }
    for (size_t i = gtid; i < 64 * 32; i += gstride) {
        const int pos = (int)(i / 32), k = (int)(i % 32);
        const float inv = powf(10000.0f, -(float)(2 * k) / 64.0f);
        const float ang = (float)pos * inv;
        WSP(float, WS_ROPE)[i] = cosf(ang); WSP(float, WS_ROPE)[64 * 32 + i] = sinf(ang);
    }
}

__device__ __forceinline__ void phase_norm(const Params& p, int l, int which  ) {
    const int tid = opaque_tid(), lane = tid & 63, wv = tid >> 6;
    const float* X = WSP(float, WS_X); bf16_t* H = WSP(bf16_t, WS_H);
    const float* g = p.in[I_NORMG] + ((size_t)l * 3 + which) * DM;
    for (int m = blockIdx.x * 8 + wv; m < M; m += gridDim.x * 8) {
        const int ci = cond_of_row(m);
        const float* mv = WSP(float, WS_MODV) + ((size_t)l * NCOND + ci) * NMOD + (size_t)which * 3 * DM;
        const float* x = X + (size_t)m * DM;
        vf4 v[8]; float ss = 0.f;
#pragma unroll
        for (int i = 0; i < 8; ++i) { v[i] = *(const vf4*)(x + (i * 64 + lane) * 4); ss += v[i].x * v[i].x + v[i].y * v[i].y + v[i].z * v[i].z + v[i].w * v[i].w; }
        ss = wave_sum(ss);
        const float r = 1.0f / sqrtf(ss * (1.0f / DM) + EPS);
#pragma unroll
        for (int i = 0; i < 8; ++i) {
            const int c = (i * 64 + lane) * 4;
            const float4 gg = *(const float4*)(g + c), sh = *(const float4*)(mv + c), sc = *(const float4*)(mv + DM + c);
            const float o0 = v[i].x * r * gg.x * (1.f + sc.x) + sh.x, o1 = v[i].y * r * gg.y * (1.f + sc.y) + sh.y;
            const float o2 = v[i].z * r * gg.z * (1.f + sc.z) + sh.z, o3 = v[i].w * r * gg.w * (1.f + sc.w) + sh.w;
            uint2 w; w.x = pack2(o0, o1); w.y = pack2(o2, o3);
            *(uint2*)(H + (size_t)m * DM + c) = w;
        }
    }
}

__device__ __forceinline__ float red16(float v);
__device__ __forceinline__ float ssq8(vf4 a, vf4 b) { const vf4 s = a * a + b * b; return (s.x + s.y) + (s.z + s.w); }
__device__ __forceinline__ uint4 pack8(vf4 a, vf4 b) { uint4 w; w.x = pack2(a.x, a.y); w.y = pack2(a.z, a.w); w.z = pack2(b.x, b.y); w.w = pack2(b.z, b.w); return w; }
__device__ __forceinline__ void phase_prep(const Params& p, int l) {
    const int tid = opaque_tid(), lane = tid & 63, wv = tid >> 6, rg = lane >> 4, sub = lane & 15, c8 = sub * 8;
    const float* Z = WSP(float, WS_Z);
    const float* ropec = WSP(float, WS_ROPE); const float* ropes = ropec + 64 * 32;
    const float* wnq = p.in[I_NAQKN] + ((size_t)l * 2 + 0) * 128 + c8; const float* wnk = wnq + 128;
    const float* wgq = p.in[I_GQAQKN] + ((size_t)l * 2 + 0) * 128 + c8; const float* wgk = wgq + 128;
    const float* cw = p.in[I_CONV] + (size_t)l * 5 * 1536 + rg * 128 + c8;
    for (int m = blockIdx.x * 8 + wv; m < M; m += gridDim.x * 8) {
        const float* z = Z + (size_t)m * NINP;
        const bool ctx = m < MC;
        const int b = ctx ? m / CT : (m - MC) / LT, t = ctx ? m % CT : (m - MC) % LT, T = ctx ? CT : LT;
        {
            const int ho = rg * 128 + c8;
            const float* zkv = z + (rg < 2 ? Z_GQK + rg * 128 : Z_GQV + (rg - 2) * 128) + c8;
            vf4 q0 = *(const vf4*)(z + Z_NAQ + ho), q1 = *(const vf4*)(z + Z_NAQ + ho + 4), k0 = *(const vf4*)(z + Z_NAK + ho), k1 = *(const vf4*)(z + Z_NAK + ho + 4);
            const vf4 v0 = *(const vf4*)(z + Z_NAV + ho), v1 = *(const vf4*)(z + Z_NAV + ho + 4);
            vf4 g0 = *(const vf4*)(z + Z_GQQ + ho), g1 = *(const vf4*)(z + Z_GQQ + ho + 4), x0 = *(const vf4*)zkv, x1 = *(const vf4*)(zkv + 4);
            float r = 1.0f / sqrtf(red16(ssq8(q0, q1)) * (1.0f / 128) + EPS);
            q0 = q0 * r * *(const vf4*)wnq; q1 = q1 * r * *(const vf4*)(wnq + 4);
            *(uint4*)(WSP(bf16_t, WS_NAQ) + (size_t)m * 512 + ho) = pack8(q0, q1);
            r = 1.0f / sqrtf(red16(ssq8(k0, k1)) * (1.0f / 128) + EPS);
            k0 = k0 * r * *(const vf4*)wnk; k1 = k1 * r * *(const vf4*)(wnk + 4);
            *(uint4*)(WSP(bf16_t, WS_NAK) + (size_t)m * 512 + ho) = pack8(k0, k1);
            *(uint4*)(WSP(bf16_t, WS_NAV) + (size_t)m * 512 + ho) = pack8(v0, v1);
            if (ctx) {
                const size_t o = ((((size_t)b * DEPTH + l) * 4 + rg) * CT + t) * 128 + c8;
                *(vf4*)(p.out + O_NAK + o) = k0; *(vf4*)(p.out + O_NAK + o + 4) = k1; *(vf4*)(p.out + O_NAV + o) = v0; *(vf4*)(p.out + O_NAV + o + 4) = v1;
            }
            r = 1.0f / sqrtf(red16(ssq8(g0, g1)) * (1.0f / 128) + EPS);
            g0 = g0 * r * *(const vf4*)wgq; g1 = g1 * r * *(const vf4*)(wgq + 4);
            const float rk = 1.0f / sqrtf(red16(ssq8(x0, x1)) * (1.0f / 128) + EPS);
            if (rg < 2) { x0 = x0 * rk * *(const vf4*)wgk; x1 = x1 * rk * *(const vf4*)(wgk + 4); }
            if (!ctx) {
                const int pos = sub < 8 ? (t >> 6) : (t & 63), ai = pos * 32 + (c8 & 31);
                const vf4 c0 = *(const vf4*)(ropec + ai), c1 = *(const vf4*)(ropec + ai + 4), s0 = *(const vf4*)(ropes + ai), s1 = *(const vf4*)(ropes + ai + 4);
                const bool hi = (sub & 4) != 0;
                vf4 pg0, pg1, px0, px1;
#pragma unroll
                for (int j = 0; j < 4; ++j) { pg0[j] = __shfl_xor(g0[j], 4); pg1[j] = __shfl_xor(g1[j], 4); px0[j] = __shfl_xor(x0[j], 4); px1[j] = __shfl_xor(x1[j], 4); }
                g0 = hi ? pg0 * s0 + g0 * c0 : g0 * c0 - pg0 * s0; g1 = hi ? pg1 * s1 + g1 * c1 : g1 * c1 - pg1 * s1;
                if (rg < 2) { x0 = hi ? px0 * s0 + x0 * c0 : x0 * c0 - px0 * s0; x1 = hi ? px1 * s1 + x1 * c1 : x1 * c1 - px1 * s1; }
            }
            *(uint4*)(WSP(bf16_t, WS_GQ) + (size_t)m * 512 + ho) = pack8(g0, g1);
            *(uint4*)(WSP(bf16_t, rg < 2 ? WS_GK : WS_GV) + (size_t)m * 256 + (rg & 1) * 128 + c8) = pack8(x0, x1);
            if (ctx) {
                const size_t o = ((((size_t)b * DEPTH + l) * 2 + (rg & 1)) * CT + t) * 128 + c8;
                float* dst = p.out + (rg < 2 ? O_GK : O_GV) + o;
                *(vf4*)dst = x0; *(vf4*)(dst + 4) = x1;
            }
        }
        {
#pragma unroll
            for (int dir = 0; dir < 2; ++dir) {
                const float* up = p.in[I_GUP] + ((size_t)l * 2 + dir) * 16 * 256 + 4 * lane;
                vf4 acc = *(const vf4*)(p.in[I_GBIAS] + ((size_t)l * 2 + dir) * 256 + 4 * lane);
                const float* gz = z + (dir ? Z_GB : Z_GF);
#pragma unroll
                for (int r4 = 0; r4 < 4; ++r4) {
                    const vf4 gv = *(const vf4*)(gz + 4 * r4);
                    acc += gv.x * *(const vf4*)(up + (4 * r4 + 0) * 256) + gv.y * *(const vf4*)(up + (4 * r4 + 1) * 256) + gv.z * *(const vf4*)(up + (4 * r4 + 2) * 256) + gv.w * *(const vf4*)(up + (4 * r4 + 3) * 256);
                }
                vf4 o;
#pragma unroll
                for (int j = 0; j < 4; ++j) o[j] = expf(logsigmoid_f(acc[j]) * (1.0f / 16.0f));
                *(vf4*)(WSP(float, dir ? WS_AB : WS_AF) + (size_t)m * 256 + 4 * lane) = o;
            }
        }
        {
#pragma unroll
            for (int part = 0; part < 3; ++part) {
                vf4 a0 = (vf4){0.f, 0.f, 0.f, 0.f}, a1 = a0;
#pragma unroll
                for (int j = 0; j < 5; ++j) {
                    const int tt = t + j - 2;
                    if (tt >= 0 && tt < T) {
                        const float* zz = Z + (size_t)(m + j - 2) * NINP + Z_DQKV + part * 512 + rg * 128 + c8;
                        const float* cj = cw + j * 1536 + part * 512;
                        a0 += *(const vf4*)cj * *(const vf4*)zz; a1 += *(const vf4*)(cj + 4) * *(const vf4*)(zz + 4);
                    }
                }
#pragma unroll
                for (int j = 0; j < 4; ++j) { a0[j] = silu_f(a0[j]); a1[j] = silu_f(a1[j]); }
                if (part < 2) { const float r = 1.0f / sqrtf(red16(ssq8(a0, a1)) + EPS) * (part == 0 ? 0.08838834764831845f : 1.0f); a0 *= r; a1 *= r; }
                float* dst = WSP(float, part == 0 ? WS_DQ : part == 1 ? WS_DK : WS_DV) + (size_t)m * 512 + rg * 128 + c8;
                *(vf4*)dst = a0; *(vf4*)(dst + 4) = a1;
            }
            if (lane < 8) {
                const float beta = 1.0f / (1.0f + expf(-z[Z_DB + lane]));
                const float g = -expf(p.in[I_ALOG][(size_t)l * 8 + lane]) * softplus_f(z[Z_DA + lane] + p.in[I_DTB][(size_t)l * 8 + lane]);
                float* ba = WSP(float, WS_DBA) + (size_t)m * 16;
                ba[lane] = beta; ba[8 + lane] = g;
            }
        }
    }
}

typedef float vf2 __attribute__((ext_vector_type(2)));
__device__ __forceinline__ float dpp_f(float v, const int ctrl) { return v; }
#define DPPF(v, ctrl) __int_as_float(__builtin_amdgcn_mov_dpp(__float_as_int(v), (ctrl), 0xF, 0xF, true))
__device__ __forceinline__ float red8(float v) { v += DPPF(v, 0xB1); v += DPPF(v, 0x4E); v += DPPF(v, 0x141); return v; }
__device__ __forceinline__ float red16(float v) { v = red8(v); v += DPPF(v, 0x140); return v; }

__device__ __forceinline__ void gla_chain(const Params& p, int l, bool ctx, int b, int h, int dir, int es, float* smem) {
    constexpr int TC = 32;
    const int tid = opaque_tid(), el = tid >> 3, dg = tid & 7;
    const int T = ctx ? CT : LT; const size_t m0 = ctx ? (size_t)b * CT : (size_t)MC + (size_t)b * LT;
    const float* Z = WSP(float, WS_Z); const float* A = WSP(float, dir ? WS_AB : WS_AF);
    float* O = WSP(float, dir ? WS_GOB : WS_GOF);
    float* sq = smem; float* sk = sq + TC * 64; float* sa = sk + TC * 64; float* sv = sa + TC * 64; float* so = sv + TC * 64;
    vf2 S[4];
    {
        const int e = es * 64 + el;
        if (ctx) {
#pragma unroll
            for (int i = 0; i < 4; ++i) S[i] = (vf2){0.f, 0.f};
        } else {
            const float* s0 = p.in[I_SGLA] + (((((size_t)b * DEPTH + l) * 2 + dir) * 4 + h) * 64 + dg * 8) * 128 + e;
#pragma unroll
            for (int i = 0; i < 4; ++i) S[i] = (vf2){s0[(size_t)(2 * i) * 128], s0[(size_t)(2 * i + 1) * 128]};
        }
    }
    vf4 pre[4];
    const int nch = T / TC;
    const int ls = tid >> 4, lc = (tid & 15) * 4;
#define GLA_LOAD(c) do { const int ti = (c) * TC + ls, tt = dir ? T - 1 - ti : ti; const size_t m = m0 + tt; \
        pre[0] = *(const vf4*)(Z + m * NINP + Z_GLQ + h * 64 + lc); pre[1] = *(const vf4*)(Z + m * NINP + Z_GLK + h * 64 + lc); \
        pre[2] = *(const vf4*)(A + m * 256 + h * 64 + lc);           pre[3] = *(const vf4*)(Z + m * NINP + Z_GLV + h * 128 + es * 64 + lc); } while (0)
#define GLA_WRITE() do { *(vf4*)(sq + ls * 64 + lc) = pre[0] * 0.125f; *(vf4*)(sk + ls * 64 + lc) = pre[1]; *(vf4*)(sa + ls * 64 + lc) = pre[2]; *(vf4*)(sv + ls * 64 + lc) = pre[3]; } while (0)
    __syncthreads();
    GLA_LOAD(0); GLA_WRITE(); __syncthreads();
    for (int c = 0; c < nch; ++c) {
        if (c + 1 < nch) GLA_LOAD(c + 1);
        vf4 q0 = *(const vf4*)(sq + dg * 8), q1 = *(const vf4*)(sq + dg * 8 + 4), k0 = *(const vf4*)(sk + dg * 8), k1 = *(const vf4*)(sk + dg * 8 + 4);
        vf4 a0 = *(const vf4*)(sa + dg * 8), a1 = *(const vf4*)(sa + dg * 8 + 4); float ve = sv[el];
#pragma unroll 2
        for (int s = 0; s < TC; ++s) {
            const int sn = (s + 1) & (TC - 1);
            const vf4 nq0 = *(const vf4*)(sq + sn * 64 + dg * 8), nq1 = *(const vf4*)(sq + sn * 64 + dg * 8 + 4), nk0 = *(const vf4*)(sk + sn * 64 + dg * 8), nk1 = *(const vf4*)(sk + sn * 64 + dg * 8 + 4);
            const vf4 na0 = *(const vf4*)(sa + sn * 64 + dg * 8), na1 = *(const vf4*)(sa + sn * 64 + dg * 8 + 4); const float nve = sv[sn * 64 + el];
            const vf2 v2 = (vf2){ve, ve};
            S[0] = a0.xy * S[0] + k0.xy * v2; S[1] = a0.zw * S[1] + k0.zw * v2; S[2] = a1.xy * S[2] + k1.xy * v2; S[3] = a1.zw * S[3] + k1.zw * v2;
            vf2 acc0 = q0.xy * S[0], acc1 = q0.zw * S[1]; acc0 += q1.xy * S[2]; acc1 += q1.zw * S[3];
            acc0 += acc1;
            const float po = red8(acc0.x + acc0.y);
            if (dg == 0) so[s * 64 + el] = po;
            q0 = nq0; q1 = nq1; k0 = nk0; k1 = nk1; a0 = na0; a1 = na1; ve = nve;
        }
        __syncthreads();
        { const int ti = c * TC + ls, tt = dir ? T - 1 - ti : ti; *(vf4*)(O + (m0 + tt) * 512 + h * 128 + es * 64 + lc) = *(const vf4*)(so + ls * 64 + lc); }
        if (c + 1 < nch) GLA_WRITE();
        __syncthreads();
    }
#undef GLA_LOAD
#undef GLA_WRITE
    if (ctx) {
        float* so_ = p.out + O_SGLA + (((((size_t)b * DEPTH + l) * 2 + dir) * 4 + h) * 64 + dg * 8) * 128 + es * 64 + el;
#pragma unroll
        for (int i = 0; i < 4; ++i) { so_[(size_t)(2 * i) * 128] = S[i].x; so_[(size_t)(2 * i + 1) * 128] = S[i].y; }
    }
}

__device__ __forceinline__ void gdn_chain(const Params& p, int l, bool ctx, int b, int h, int dir, int es, float* smem) {
    constexpr int TC = 32;
    const int tid = opaque_tid(), el = tid >> 3, dg = tid & 7;
    const int T = ctx ? CT : LT; const size_t m0 = ctx ? (size_t)b * CT : (size_t)MC + (size_t)b * LT;
    const float* DQ = WSP(float, WS_DQ); const float* DK = WSP(float, WS_DK); const float* DV = WSP(float, WS_DV); const float* DBA = WSP(float, WS_DBA);
    float* O = WSP(float, dir ? WS_DOB : WS_DOF);
    float* sq = smem; float* sk = sq + TC * 128; float* sv = sk + TC * 128; float* so = sv + TC * 64; float* sba = so + TC * 64; float* sqk = sba + TC * 2;
    vf2 S[8];
    {
        const int e = es * 64 + el;
        if (ctx) {
#pragma unroll
            for (int i = 0; i < 8; ++i) S[i] = (vf2){0.f, 0.f};
        } else {
            const float* s0 = p.in[I_SGDN] + (((((size_t)b * DEPTH + l) * 2 + dir) * 4 + h) * 128 + dg * 16) * 128 + e;
#pragma unroll
            for (int i = 0; i < 8; ++i) S[i] = (vf2){s0[(size_t)(2 * i) * 128], s0[(size_t)(2 * i + 1) * 128]};
        }
    }
    vf4 pre[5]; float pre_s = 0.f;
    const int nch = T / TC;
    const int ls = tid >> 5, lc = (tid & 31) * 4, vs = tid >> 4, vc = (tid & 15) * 4;
#define TOK(c, s_) (m0 + (dir ? T - 1 - ((c) * TC + (s_)) : (c) * TC + (s_)))
#define GDN_LOAD(c) do { const size_t ma = TOK(c, ls), mb = TOK(c, ls + 16), mv = TOK(c, vs); \
        pre[0] = *(const vf4*)(DQ + ma * 512 + h * 128 + lc); pre[1] = *(const vf4*)(DQ + mb * 512 + h * 128 + lc); \
        pre[2] = *(const vf4*)(DK + ma * 512 + h * 128 + lc); pre[3] = *(const vf4*)(DK + mb * 512 + h * 128 + lc); \
        pre[4] = *(const vf4*)(DV + mv * 512 + h * 128 + es * 64 + vc); \
        if (tid < 2 * TC) { pre_s = DBA[TOK(c, tid >> 1) * 16 + (tid & 1) * 8 + dir * 4 + h]; if (tid & 1) pre_s = expf(pre_s); } } while (0)
#define GDN_WRITE() do { *(vf4*)(sq + ls * 128 + lc) = pre[0]; *(vf4*)(sq + (ls + 16) * 128 + lc) = pre[1]; *(vf4*)(sk + ls * 128 + lc) = pre[2]; *(vf4*)(sk + (ls + 16) * 128 + lc) = pre[3]; \
        *(vf4*)(sv + vs * 64 + vc) = pre[4]; if (tid < 2 * TC) sba[tid] = pre_s; } while (0)
    __syncthreads();
    GDN_LOAD(0); GDN_WRITE(); __syncthreads();
    for (int c = 0; c < nch; ++c) {
        if (c + 1 < nch) GDN_LOAD(c + 1);
        {
            const int s = tid >> 4, part = tid & 15;
            const vf4 x0 = *(const vf4*)(sq + s * 128 + part * 8), x1 = *(const vf4*)(sq + s * 128 + part * 8 + 4), y0 = *(const vf4*)(sk + s * 128 + part * 8), y1 = *(const vf4*)(sk + s * 128 + part * 8 + 4);
            const vf4 pr = x0 * y0 + x1 * y1;
            const float d = red16((pr.x + pr.y) + (pr.z + pr.w));
            if (part == 0) sqk[s] = d;
        }
        __syncthreads();
        vf4 kk[4], qq[4]; float ve, be, a, qk;
#pragma unroll
        for (int i = 0; i < 4; ++i) { kk[i] = *(const vf4*)(sk + dg * 16 + 4 * i); qq[i] = *(const vf4*)(sq + dg * 16 + 4 * i); }
        ve = sv[el]; be = sba[0]; a = sba[1]; qk = sqk[0];
#pragma unroll 2
        for (int s = 0; s < TC; ++s) {
            const int sn = (s + 1) & (TC - 1);
            vf4 nk[4], nq[4];
#pragma unroll
            for (int i = 0; i < 4; ++i) { nk[i] = *(const vf4*)(sk + sn * 128 + dg * 16 + 4 * i); nq[i] = *(const vf4*)(sq + sn * 128 + dg * 16 + 4 * i); }
            const float nve = sv[sn * 64 + el], nbe = sba[2 * sn], na = sba[2 * sn + 1], nqk = sqk[sn];
            vf2 ak0 = kk[0].xy * S[0], ak1 = kk[0].zw * S[1], aq0 = qq[0].xy * S[0], aq1 = qq[0].zw * S[1];
#pragma unroll
            for (int i = 1; i < 4; ++i) { ak0 += kk[i].xy * S[2 * i]; ak1 += kk[i].zw * S[2 * i + 1]; aq0 += qq[i].xy * S[2 * i]; aq1 += qq[i].zw * S[2 * i + 1]; }
            ak0 += ak1; aq0 += aq1;
            const float uk = red8(ak0.x + ak0.y), uq = red8(aq0.x + aq0.y);
            const float vn = be * (ve - a * uk);
            const float po = a * uq + qk * vn;
            const vf2 a2 = (vf2){a, a}, vn2 = (vf2){vn, vn};
#pragma unroll
            for (int i = 0; i < 4; ++i) { S[2 * i] = a2 * S[2 * i] + kk[i].xy * vn2; S[2 * i + 1] = a2 * S[2 * i + 1] + kk[i].zw * vn2; }
            if (dg == 0) so[s * 64 + el] = po;
#pragma unroll
            for (int i = 0; i < 4; ++i) { kk[i] = nk[i]; qq[i] = nq[i]; }
            ve = nve; be = nbe; a = na; qk = nqk;
        }
        __syncthreads();
        *(vf4*)(O + TOK(c, vs) * 512 + h * 128 + es * 64 + vc) = *(const vf4*)(so + vs * 64 + vc);
        if (c + 1 < nch) GDN_WRITE();
        __syncthreads();
    }
#undef GDN_LOAD
#undef GDN_WRITE
#undef TOK
    if (ctx) {
        float* so_ = p.out + O_SGDN + (((((size_t)b * DEPTH + l) * 2 + dir) * 4 + h) * 128 + dg * 16) * 128 + es * 64 + el;
#pragma unroll
        for (int i = 0; i < 8; ++i) { so_[(size_t)(2 * i) * 128] = S[i].x; so_[(size_t)(2 * i + 1) * 128] = S[i].y; }
    }
}

__device__ __forceinline__ void phase_post(const Params& p, int l) {
    const int tid = opaque_tid(), lane = tid & 63, wv = tid >> 6;
    const float* Z = WSP(float, WS_Z); bf16_t* MRG = WSP(bf16_t, WS_MRG);
    const float* wg = p.in[I_GLAON] + (size_t)l * 128; const float* wd = p.in[I_GDNON] + (size_t)l * 128;
    for (int m = blockIdx.x * 8 + wv; m < M; m += gridDim.x * 8) {
        const float* z = Z + (size_t)m * NINP;
#pragma unroll
        for (int g = 0; g < 2; ++g) {
            const float* of = WSP(float, g ? WS_DOF : WS_GOF) + (size_t)m * 512; const float* ob = WSP(float, g ? WS_DOB : WS_GOB) + (size_t)m * 512;
            const float* w = g ? wd : wg; const int zg = g ? Z_DZ : Z_GLR, mc = g ? 1536 : 512;
#pragma unroll
            for (int h = 0; h < 4; ++h) {
                const float a = of[h * 128 + lane] + ob[h * 128 + lane], c = of[h * 128 + 64 + lane] + ob[h * 128 + 64 + lane];
                const float r = 1.0f / sqrtf(wave_sum(a * a + c * c) * (1.0f / 128) + EPS);
                bf16_t* o = MRG + (size_t)m * DM + mc + h * 128;
                o[lane] = f2bf(a * r * w[lane] * silu_f(z[zg + h * 128 + lane]));
                o[64 + lane] = f2bf(c * r * w[64 + lane] * silu_f(z[zg + h * 128 + 64 + lane]));
            }
        }
    }
}
#define XB_TMO      128
#define XB_XCNT(j)  (256  + 64 * (j))
#define XB_XSUB(j)  (1280 + 64 * (j))
#define XB_XGEN(j)  (2304 + 64 * (j))
#define XB_TOP      3328
#define XB_TOPGEN   3392
#define XCD_BAR_WORDS 3456
#define XB_SPIN_CAP (1u << 22)
#define LAS __attribute__((address_space(3)))

__device__ __forceinline__ unsigned xb_ld(unsigned* p)              { return __hip_atomic_load(p, __ATOMIC_RELAXED, __HIP_MEMORY_SCOPE_AGENT); }
__device__ __forceinline__ unsigned xb_add(unsigned* p, unsigned v) { return __hip_atomic_fetch_add(p, v, __ATOMIC_RELAXED, __HIP_MEMORY_SCOPE_AGENT); }
__device__ __forceinline__ unsigned xb_xcc_id() { return (unsigned)__builtin_amdgcn_s_getreg((3 << 11) | 20) & 0xFu; }
#define XB_SPIN(cond, bar) do { unsigned _sp = 0; while (cond) { __builtin_amdgcn_s_sleep(1); \
    if ((++_sp & 255u) == 0u) { if (xb_ld(&(bar)[XB_TMO])) break; if (_sp > XB_SPIN_CAP) { atomicAdd(&(bar)[XB_TMO], 1u); break; } } } } while (0)

struct XcdBarrier {
    unsigned* bar; unsigned x;
    volatile LAS unsigned* st;
};

__device__ __forceinline__ XcdBarrier xcd_barrier_post(unsigned* bar, volatile LAS unsigned* st) {
    XcdBarrier b; b.bar = bar; b.x = xb_xcc_id(); b.st = st;
    if (threadIdx.x == 0) (void)xb_add(&bar[XB_XCNT(b.x)], 1u);
    return b;
}
__device__ __forceinline__ void xcd_barrier_complete(unsigned* bar, unsigned x, unsigned& nloc, unsigned& nx) {
    const unsigned G = gridDim.x * gridDim.y * gridDim.z;
    unsigned sum, cnt, mine, sp = 0u;
    for (;;) {
        sum = 0u; cnt = 0u; mine = 0u;
#pragma unroll
        for (unsigned j = 0; j < 16; ++j) { const unsigned c = xb_ld(&bar[XB_XCNT(j)]); sum += c; cnt += (c > 0u) ? 1u : 0u; mine = (j == x) ? c : mine; }
        if (sum == G) break;
        __builtin_amdgcn_s_sleep(1);
        if ((++sp & 255u) == 0u) { if (xb_ld(&bar[XB_TMO])) break; if (sp > XB_SPIN_CAP) { atomicAdd(&bar[XB_TMO], 1u); break; } }
    }
    nloc = mine > 0u ? mine : 1u; nx = cnt > 0u ? cnt : 1u;
}

__device__ __forceinline__ void xcd_barrier(const XcdBarrier& b) {
    asm volatile("s_waitcnt vmcnt(0)" ::: "memory");
    __syncthreads();
    if (threadIdx.x == 0) {
        unsigned* bar = b.bar;
        __builtin_amdgcn_s_waitcnt(0);
        unsigned nloc = b.st[0], nx = b.st[1];
        if (nloc == 0u) { xcd_barrier_complete(bar, b.x, nloc, nx); b.st[0] = nloc; b.st[1] = nx; }
        const unsigned old = xb_add(&bar[XB_XSUB(b.x)], 1u);
        const unsigned gen = old / nloc;
        if (old + 1u == (gen + 1u) * nloc) {
            __builtin_amdgcn_fence(__ATOMIC_RELEASE, "agent");
            asm volatile("s_waitcnt vmcnt(0)" ::: "memory");
            const unsigned og = xb_add(&bar[XB_TOP], 1u);
            const unsigned tg = og / nx;
            if (og + 1u == (tg + 1u) * nx) xb_add(&bar[XB_TOPGEN], 1u);
            else XB_SPIN(xb_ld(&bar[XB_TOPGEN]) == tg, bar);
            __builtin_amdgcn_fence(__ATOMIC_ACQUIRE, "agent");
            xb_add(&bar[XB_XGEN(b.x)], 1u);
            asm volatile("s_waitcnt vmcnt(0)" ::: "memory");
        } else {
            XB_SPIN(xb_ld(&bar[XB_XGEN(b.x)]) == gen, bar);
            __builtin_amdgcn_fence(__ATOMIC_ACQUIRE, "agent");
            asm volatile("s_waitcnt vmcnt(0)" ::: "memory");
        }
    }
    __syncthreads();
}

namespace pg8 {
#define PG8_LAS __attribute__((address_space(3)))
typedef unsigned short bf16_t;
typedef short bf16x8 __attribute__((ext_vector_type(8)));
typedef float f32x4 __attribute__((ext_vector_type(4)));
typedef unsigned u32x4 __attribute__((ext_vector_type(4)));
constexpr int BM = 256, BK = 64, HALF = 128, HTB = HALF * BK * 2  , STAGE_BYTES = 8 * HTB, NXCD = 8, WGM = 8;

__host__ __device__ __forceinline__ int lds_byte(int r, int c) { const int st = (r >> 4) * 2 + (c >> 5), rr = r & 15, cc = c & 31, ob = rr * 64 + cc * 2; return st * 1024 + (ob ^ (((ob >> 9) & 1) << 5)); }
__host__ __device__ __forceinline__ void stage_rc(int b, int& R, int& C) { const int st = b / 1024, sb = b % 1024, swz = sb ^ (((sb >> 9) & 1) << 5); R = (st >> 1) * 16 + swz / 64; C = (st & 1) * 32 + (swz % 64) / 2; }
__host__ __device__ __forceinline__ int perm32(int rho) { const int n = rho >> 4, i = rho & 15; return 8 * (i >> 2) + 4 * n + (i & 3); }

struct Unit { int pm, pn, k0, nt, at; };
struct Gemm { const bf16_t* A; const bf16_t* Bt; int M, N, K; };

struct StaticOrder {
    int nM, nN, nwg, G, c, ntk, split;
    __host__ __device__ void init(int M, int N, int K, int G_, int c_, int split_ = 0) { nM = M / BM; nN = N / BM; nwg = nM * nN; G = G_; c = c_; ntk = K / BK; const int rem = nwg % G_; split = (split_ && rem > 0 && 2 * rem == G_ && (ntk % 4) != 1 && ntk >= 8) ? 1 : 0; }
    __host__ __device__ bool next(int i, Unit& u) const {
        long L = (long)i * G + c; u.k0 = 0; u.nt = ntk; u.at = 0;
        if (split && i == nwg / G) { const int rem = nwg % G, sl = c / rem, h0 = ((ntk / 2) + 1) & ~1; L = (long)i * G + (c % rem); u.k0 = sl ? h0 * BK : 0; u.nt = sl ? ntk - h0 : h0; u.at = 1; }
        if (L >= nwg) return false;
        int wgid = (int)L; { const int q = nwg / NXCD, r = nwg % NXCD, xcd = wgid % NXCD, off = wgid / NXCD; wgid = (xcd < r ? xcd * (q + 1) : r * (q + 1) + (xcd - r) * q) + off; }
        const int nig = WGM * nN, gid = wgid / nig, fm = gid * WGM, gsz = (nM - fm) < WGM ? (nM - fm) : WGM;
        u.pm = fm + ((wgid % nig) % gsz); u.pn = (wgid % nig) / gsz; return true;
    }
    __device__ __forceinline__ void a_ready(const Unit&) const {}
    __device__ __forceinline__ void done(const Unit&) const {}
};
__device__ __forceinline__ unsigned cvt_pk_bf16(float lo, float hi) { unsigned r; asm volatile("v_cvt_pk_bf16_f32 %0, %1, %2" : "=v"(r) : "v"(lo), "v"(hi)); return r; }
struct EpiF32 {
    static constexpr bool PERM = false, AFTER_DRAIN = false;
    float* C; int ldc; const float* bias;
    __device__ __forceinline__ void operator()(const f32x4 (&acc)[2][2][4][2], const Unit& u, int wr, int wc, int fr, int fq) const {
        const int row0 = u.pm * BM + wr * 64 + fr, col0 = u.pn * BM + wc * 32 + 4 * fq;
        f32x4 bv[2][2];
#pragma unroll
        for (int bj = 0; bj < 2; ++bj)
#pragma unroll
            for (int n = 0; n < 2; ++n) bv[bj][n] = bias ? *(const f32x4*)(bias + col0 + bj * HALF + n * 16) : (f32x4){0.f, 0.f, 0.f, 0.f};
#pragma unroll
        for (int ai = 0; ai < 2; ++ai)
#pragma unroll
            for (int m = 0; m < 4; ++m) { float* rowp = C + (size_t)(row0 + ai * HALF + m * 16) * ldc + col0;
#pragma unroll
                for (int bj = 0; bj < 2; ++bj)
#pragma unroll
                    for (int n = 0; n < 2; ++n) *(f32x4*)(rowp + bj * HALF + n * 16) = acc[ai][bj][m][n] + bv[bj][n]; }
    }
};

struct EpiSwiGLU {
    static constexpr bool PERM = true, AFTER_DRAIN = false;
    bf16_t* O; int ldc;
    __device__ __forceinline__ void operator()(const f32x4 (&acc)[2][2][4][2], const Unit& u, int wr, int wc, int fr, int fq) const {
        const int row0 = u.pm * BM + wr * 64 + fr, col0 = u.pn * 128 + wc * 32 + 8 * fq;
#pragma unroll
        for (int ai = 0; ai < 2; ++ai)
#pragma unroll
            for (int m = 0; m < 4; ++m) { bf16_t* rowp = O + (size_t)(row0 + ai * HALF + m * 16) * ldc + col0;
                const f32x4 g0 = acc[ai][0][m][0], g1 = acc[ai][0][m][1], u0 = acc[ai][1][m][0], u1 = acc[ai][1][m][1];
                float r[8];
#pragma unroll
                for (int j = 0; j < 4; ++j) {
                    r[j]     = g0[j] * __builtin_amdgcn_rcpf(1.0f + __builtin_amdgcn_exp2f(-1.4426950408889634f * g0[j])) * u0[j];
                    r[4 + j] = g1[j] * __builtin_amdgcn_rcpf(1.0f + __builtin_amdgcn_exp2f(-1.4426950408889634f * g1[j])) * u1[j]; }
                u32x4 w; w.x = cvt_pk_bf16(r[0], r[1]); w.y = cvt_pk_bf16(r[2], r[3]); w.z = cvt_pk_bf16(r[4], r[5]); w.w = cvt_pk_bf16(r[6], r[7]);
                *(u32x4*)rowp = w; }
    }
};
struct EpiResid {
    static constexpr bool PERM = false, AFTER_DRAIN = false;
    const float* res; float* out; int ldc; const float* gate0; float coef;
    __device__ __forceinline__ void operator()(const f32x4 (&acc)[2][2][4][2], const Unit& u, int wr, int wc, int fr, int fq) const {
        const int row0 = u.pm * BM + wr * 64 + fr, col0 = u.pn * BM + wc * 32 + 4 * fq;
        const float* gate = gate0 + (size_t)cond_of_row(u.pm * BM) * NMOD;
        f32x4 gv[2][2];
#pragma unroll
        for (int bj = 0; bj < 2; ++bj)
#pragma unroll
            for (int n = 0; n < 2; ++n) gv[bj][n] = *(const f32x4*)(gate + col0 + bj * HALF + n * 16) * coef;
#pragma unroll
        for (int ai = 0; ai < 2; ++ai)
#pragma unroll
            for (int m = 0; m < 4; ++m) { const size_t off = (size_t)(row0 + ai * HALF + m * 16) * ldc + col0;
#pragma unroll
                for (int bj = 0; bj < 2; ++bj)
#pragma unroll
                    for (int n = 0; n < 2; ++n) {
                        if (u.at) { const f32x4 v = gv[bj][n] * acc[ai][bj][m][n]; float* o = out + off + bj * HALF + n * 16;
                            unsafeAtomicAdd(o + 0, v[0]); unsafeAtomicAdd(o + 1, v[1]); unsafeAtomicAdd(o + 2, v[2]); unsafeAtomicAdd(o + 3, v[3]); }
                        else { const f32x4 bs = *(const f32x4*)(res + off + bj * HALF + n * 16); *(f32x4*)(out + off + bj * HALF + n * 16) = bs + gv[bj][n] * acc[ai][bj][m][n]; } }
                asm volatile("" ::: "memory"); }
    }
};
template <class Epi, class Sched, bool STAMP = false>
__device__ __forceinline__ void gemm_phase(PG8_LAS unsigned char* lds, const Gemm g, const Sched& S, const Epi& E, unsigned long long* stamps) {
    const int tid = opaque_tid(), wid = __builtin_amdgcn_readfirstlane(tid >> 6), lane = tid & 63, wr = wid >> 2, wc = wid & 3, fr = lane & 15, fq = lane >> 4;
    const int K = g.K;
    int ts_lo = 0, ts_hi = 0, nts = 0; const unsigned long long rt_entry = STAMP ? (unsigned long long)wall_clock64() : 0ull;
#define PG8_STAMP() do { if (STAMP && wid == 0 && nts < 64) { const unsigned long long _c = (unsigned long long)clock64(); \
        ts_lo = (lane == nts) ? (int)(unsigned)_c : ts_lo; ts_hi = (lane == nts) ? (int)(unsigned)(_c >> 32) : ts_hi; ++nts; } } while (0)
    PG8_STAMP();
    unsigned voffA[2], voffB[2];
#pragma unroll
    for (int i = 0; i < 2; ++i) { int R, C; stage_rc(tid * 16 + i * 8192, R, C); const int Rb = Epi::PERM ? ((R & ~31) + perm32(R & 31)) : R;
        voffA[i] = (unsigned)(R * K + C) * 2u; voffB[i] = (unsigned)(Rb * K + C) * 2u; }
    const size_t kstep = (size_t)(BK * 2);
    const size_t hstep = (size_t)HALF * K * 2;
    const size_t tstep = 2 * hstep;
    const unsigned ldsw = (unsigned)wid * 1024u;
    const int aoff = lds_byte(wr * 64 + fr, fq * 8), boff = lds_byte(wc * 32 + fr, fq * 8);
#define PG8_SA(b, h) (((b) * 2 + (h)) * HTB)
#define PG8_SB(b, h) ((4 + (b) * 2 + (h)) * HTB)
#define PG8_STAGE(bufoff, gbase, voff) do { _Pragma("unroll") for (int _i = 0; _i < 2; ++_i) \
        __builtin_amdgcn_global_load_lds((const unsigned*)((const char*)(gbase) + (voff)[_i]), (PG8_LAS unsigned*)(lds + (bufoff) + ldsw + _i * 8192), 16, 0, 0); } while (0)
#define PG8_LDA(dst, b, h) do { _Pragma("unroll") for (int m = 0; m < 4; ++m) _Pragma("unroll") for (int k = 0; k < 2; ++k) dst[m][k] = *(const PG8_LAS bf16x8*)(lds + PG8_SA(b, h) + aoff + m * 2048 + k * 1024); } while (0)
#define PG8_LDB(dst, b, h) do { _Pragma("unroll") for (int n = 0; n < 2; ++n) _Pragma("unroll") for (int k = 0; k < 2; ++k) dst[n][k] = *(const PG8_LAS bf16x8*)(lds + PG8_SB(b, h) + boff + n * 2048 + k * 1024); } while (0)
#define PG8_MMA(ai, bj, At, Bt) do { __builtin_amdgcn_s_setprio(1); _Pragma("unroll") for (int m = 0; m < 4; ++m) _Pragma("unroll") for (int n = 0; n < 2; ++n) _Pragma("unroll") for (int k = 0; k < 2; ++k) \
        acc[ai][bj][m][n] = __builtin_amdgcn_mfma_f32_16x16x32_bf16(Bt[n][k], At[m][k], acc[ai][bj][m][n], 0, 0, 0); __builtin_amdgcn_s_setprio(0); } while (0)
#define PG8_WAIT_V(n) asm volatile("s_waitcnt vmcnt(" #n ")" ::: "memory")
#define PG8_WAIT_L(n) asm volatile("s_waitcnt lgkmcnt(" #n ")" ::: "memory")
#define PG8_BAR __builtin_amdgcn_s_barrier()
#define PG8_SCHED __builtin_amdgcn_sched_barrier(0)
    Unit cur, nxt; int ui = 0;
    if (!S.next(0, cur)) return;
    f32x4 acc[2][2][4][2];
#pragma unroll
    for (int a = 0; a < 2; ++a)
#pragma unroll
        for (int b = 0; b < 2; ++b)
#pragma unroll
            for (int m = 0; m < 4; ++m)
#pragma unroll
                for (int n = 0; n < 2; ++n) acc[a][b][m][n] = (f32x4){0.f, 0.f, 0.f, 0.f};
    bf16x8 At[4][2], B0[2][2], B1[2][2];
    const char* cA = (const char*)g.A + (size_t)cur.pm * tstep + (size_t)cur.k0 * 2; const char* cB = (const char*)g.Bt + (size_t)cur.pn * tstep + (size_t)cur.k0 * 2;
    S.a_ready(cur);
    PG8_STAGE(PG8_SB(0, 0), cB, voffB); PG8_STAGE(PG8_SA(0, 0), cA, voffA); PG8_STAGE(PG8_SB(0, 1), cB + hstep, voffB); PG8_STAGE(PG8_SA(0, 1), cA + hstep, voffA);
    if (wr == 1) PG8_BAR;
    PG8_WAIT_V(4); PG8_BAR;
    PG8_STAGE(PG8_SB(1, 0), cB + kstep, voffB); PG8_STAGE(PG8_SA(1, 0), cA + kstep, voffA); PG8_STAGE(PG8_SB(1, 1), cB + hstep + kstep, voffB);
    PG8_WAIT_V(6); PG8_BAR;
    PG8_STAMP();
    for (;;) {
        const bool has_next = S.next(ui + 1, nxt);
        const char* nA = has_next ? (const char*)g.A + (size_t)nxt.pm * tstep + (size_t)nxt.k0 * 2 : cA; const char* nB = has_next ? (const char*)g.Bt + (size_t)nxt.pn * tstep + (size_t)nxt.k0 * 2 : cB;
        const int nt = cur.nt;
        for (int t = 0; t < nt; t += 2) {
            const bool last = (t == nt - 2);
            const char* a1 = cA + (size_t)(t + 1) * kstep;
            const char* a2 = last ? nA : cA + (size_t)(t + 2) * kstep; const char* b2 = last ? nB : cB + (size_t)(t + 2) * kstep;
            const char* a3 = a2 + kstep; const char* b3 = b2 + kstep;
            if (last && has_next) S.a_ready(nxt);
            PG8_LDB(B0, 0, 0); PG8_SCHED; PG8_LDA(At, 0, 0); PG8_STAGE(PG8_SA(1, 1), a1 + hstep, voffA);
            PG8_WAIT_L(8); PG8_BAR; PG8_WAIT_L(0); PG8_MMA(0, 0, At, B0); PG8_BAR; PG8_SCHED;
            PG8_LDB(B1, 0, 1); PG8_STAGE(PG8_SB(0, 0), b2, voffB);
            PG8_BAR; PG8_WAIT_L(0); PG8_MMA(0, 1, At, B1); PG8_BAR;
            PG8_LDA(At, 0, 1); PG8_STAGE(PG8_SA(0, 0), a2, voffA);
            PG8_BAR; PG8_WAIT_L(0); PG8_MMA(1, 0, At, B0); PG8_BAR; PG8_SCHED;
            PG8_STAGE(PG8_SB(0, 1), b2 + hstep, voffB);
            PG8_WAIT_V(6); PG8_BAR; PG8_MMA(1, 1, At, B1); PG8_BAR;
            PG8_LDB(B0, 1, 0); PG8_SCHED; PG8_LDA(At, 1, 0); PG8_STAGE(PG8_SA(0, 1), a2 + hstep, voffA);
            PG8_WAIT_L(8); PG8_BAR; PG8_WAIT_L(0); PG8_MMA(0, 0, At, B0); PG8_BAR; PG8_SCHED;
            PG8_LDB(B1, 1, 1); PG8_STAGE(PG8_SB(1, 0), b3, voffB);
            PG8_BAR; PG8_WAIT_L(0); PG8_MMA(0, 1, At, B1); PG8_BAR;
            PG8_LDA(At, 1, 1); PG8_STAGE(PG8_SA(1, 0), a3, voffA);
            PG8_BAR; PG8_WAIT_L(0); PG8_MMA(1, 0, At, B0); PG8_BAR; PG8_SCHED;
            PG8_STAGE(PG8_SB(1, 1), b3 + hstep, voffB);
            PG8_WAIT_V(6); PG8_BAR; PG8_MMA(1, 1, At, B1); PG8_BAR;
        }
        PG8_STAMP();
        if constexpr (!Epi::AFTER_DRAIN) { E(acc, cur, wr, wc, fr, fq); S.done(cur); }
        PG8_STAMP();
        if (!has_next) break;
#pragma unroll
        for (int a = 0; a < 2; ++a)
#pragma unroll
            for (int b = 0; b < 2; ++b)
#pragma unroll
                for (int m = 0; m < 4; ++m)
#pragma unroll
                    for (int n = 0; n < 2; ++n) acc[a][b][m][n] = (f32x4){0.f, 0.f, 0.f, 0.f};
        cur = nxt; cA = nA; cB = nB; ++ui;
    }
    PG8_WAIT_V(0);
    if (wr == 0) PG8_BAR;
    PG8_BAR;
    if constexpr (Epi::AFTER_DRAIN) { E.fused(acc, cur, wr, wc, fr, fq, lds, wid, lane); S.done(cur); }
    PG8_STAMP();
    if (STAMP && wid == 0) { stamps[lane] = lane < nts ? (((unsigned long long)(unsigned)ts_hi << 32) | (unsigned)ts_lo) : 0ull;
        if (lane == 62) stamps[62] = rt_entry; if (lane == 63) stamps[63] = (unsigned long long)wall_clock64(); }
#undef PG8_STAMP
#undef PG8_SA
#undef PG8_SB
#undef PG8_STAGE
#undef PG8_LDA
#undef PG8_LDB
#undef PG8_MMA
#undef PG8_WAIT_V
#undef PG8_WAIT_L
#undef PG8_BAR
#undef PG8_SCHED
}
}
#ifndef ATT_INLINE
#define ATT_INLINE __forceinline__
#endif
namespace att {
constexpr int D = 128, NW = 8, QBLK = 32, KVBLK = 64, LDQ = 512, LDO = DM;
constexpr float SCALE = 0.088388347648318440f;
constexpr float THR = 8.f;
constexpr size_t SHM_V = KVBLK * D * 2, SHM_K = KVBLK * D * 2, SHM_Q = 256 * D * 2, SHM_ATTN = 2 * SHM_V + 2 * SHM_K + NW * 64 * 4 + SHM_Q;
using bf16x8 = __attribute__((ext_vector_type(8))) short;
using s16x4  = __attribute__((ext_vector_type(4))) short;
using f32x16 = __attribute__((ext_vector_type(16))) float;
using u32x4  = __attribute__((ext_vector_type(4))) unsigned;
#define KSWZ(row, colB) ((row) * 256 + ((colB) ^ (((row) & 7) << 4)))
#define SBAR() __builtin_amdgcn_sched_barrier(0)
__device__ __forceinline__ int crow(int r, int hi) { return (r & 3) + 8 * (r >> 2) + 4 * hi; }
__device__ __forceinline__ unsigned cvtpk(float lo, float hi) { unsigned r; asm volatile("v_cvt_pk_bf16_f32 %0, %1, %2" : "=v"(r) : "v"(lo), "v"(hi)); return r; }

__device__ __forceinline__ void partialSM(f32x16& p0, f32x16& p1, float& m_reg, float& mn, float& alpha) {
  constexpr float C = SCALE * 1.4426950408889634f;
  float pmax = p0[0]; for (int r = 1; r < 16; ++r) pmax = fmaxf(pmax, p0[r]); for (int r = 0; r < 16; ++r) pmax = fmaxf(pmax, p1[r]);
  { auto rr = __builtin_amdgcn_permlane32_swap(__float_as_uint(pmax), __float_as_uint(pmax), false, false);
    pmax = fmaxf(__uint_as_float(rr[0]), __uint_as_float(rr[1])); }
  if (__builtin_expect(__all(pmax - m_reg <= THR / SCALE), 1)) { mn = m_reg; alpha = 1.f; }
  else { mn = fmaxf(m_reg, pmax); alpha = __builtin_amdgcn_exp2f((m_reg - mn) * C); m_reg = mn; }
  float mnC = -mn * C;
  for (int r = 0; r < 16; ++r) p0[r] = fmaf(p0[r], C, mnC); for (int r = 0; r < 16; ++r) p1[r] = fmaf(p1[r], C, mnC);
  for (int r = 0; r < 16; ++r) p0[r] = __builtin_amdgcn_exp2f(p0[r]);
}
__device__ __forceinline__ void finishSM(f32x16& p0, f32x16& p1, float alpha, float& l_reg, bf16x8& pa0, bf16x8& pa1, bf16x8& pa2, bf16x8& pa3) {
  for (int r = 0; r < 16; ++r) p1[r] = __builtin_amdgcn_exp2f(p1[r]);
  float ps = 0; for (int r = 0; r < 16; ++r) ps += p0[r]; for (int r = 0; r < 16; ++r) ps += p1[r];
  { auto rr = __builtin_amdgcn_permlane32_swap(__float_as_uint(ps), __float_as_uint(ps), false, false);
    ps = __uint_as_float(rr[0]) + __uint_as_float(rr[1]); }
  l_reg = l_reg * alpha + ps;
#define PK4(P, BASE, OUT) do { unsigned a0 = cvtpk(P[BASE + 0], P[BASE + 1]), a1 = cvtpk(P[BASE + 2], P[BASE + 3]);   \
    unsigned b0 = cvtpk(P[BASE + 4], P[BASE + 5]), b1 = cvtpk(P[BASE + 6], P[BASE + 7]);                              \
    auto r0 = __builtin_amdgcn_permlane32_swap(a0, b0, false, false); auto r1 = __builtin_amdgcn_permlane32_swap(a1, b1, false, false); \
    u32x4 w = {r0[0], r1[0], r0[1], r1[1]}; OUT = *reinterpret_cast<bf16x8*>(&w); } while (0)
  PK4(p0, 0, pa0); PK4(p0, 8, pa1); PK4(p1, 0, pa2); PK4(p1, 8, pa3);
#undef PK4
}
__device__ __forceinline__ void qkt(f32x16& p0, f32x16& p1, const bf16_t* Ks, const bf16_t* Qs, int qrow, int r32, int hi) {
  p0 = f32x16{}; p1 = f32x16{};
#pragma unroll
  for (int d0 = 0; d0 < 8; ++d0) { int cb = (d0 * 16 + hi * 8) * 2;
    bf16x8 q = *reinterpret_cast<const bf16x8*>((const char*)Qs + KSWZ(qrow, cb));
    bf16x8 b0 = *reinterpret_cast<const bf16x8*>((const char*)Ks + KSWZ(r32, cb));
    bf16x8 b1 = *reinterpret_cast<const bf16x8*>((const char*)Ks + KSWZ(32 + r32, cb));
    p0 = __builtin_amdgcn_mfma_f32_32x32x16_bf16(b0, q, p0, 0, 0, 0);
    p1 = __builtin_amdgcn_mfma_f32_32x32x16_bf16(b1, q, p1, 0, 0, 0); }
}
__device__ __forceinline__ int v_st(int k, int c) { const int kk = (k & ~0xC) | ((k & 4) << 1) | ((k & 8) >> 1); return ((kk >> 3) * 4 + (c >> 5)) * 512 + ((kk & 7) * 32 + (c & 31)) * 2; }
__device__ __forceinline__ int v_rd_base(int lane) { return ((lane & 3) << 3) | (((lane >> 2) & 3) << 6) | (((lane >> 4) & 1) << 5) | (((lane >> 5) & 1) << 8); }
constexpr int v_rd_off(int d0, int ks, int half) { return d0 * 512 + ks * 4096 + half * 2048; }
template <int OFF> __device__ __forceinline__ s16x4 tr_read(int vb) {
  s16x4 r; asm volatile("ds_read_b64_tr_b16 %0, %1 offset:%2" : "=&v"(r) : "v"(vb), "i"(OFF) : "memory"); return r;
}
template <int D0> __device__ __forceinline__ void pv_one(f32x16& od, int vb, bf16x8 pa0, bf16x8 pa1, bf16x8 pa2, bf16x8 pa3) {
  const s16x4 l0 = tr_read<v_rd_off(D0, 0, 0)>(vb), h0 = tr_read<v_rd_off(D0, 0, 1)>(vb), l1 = tr_read<v_rd_off(D0, 1, 0)>(vb), h1 = tr_read<v_rd_off(D0, 1, 1)>(vb);
  const s16x4 l2 = tr_read<v_rd_off(D0, 2, 0)>(vb), h2 = tr_read<v_rd_off(D0, 2, 1)>(vb), l3 = tr_read<v_rd_off(D0, 3, 0)>(vb), h3 = tr_read<v_rd_off(D0, 3, 1)>(vb);
  asm volatile("s_waitcnt lgkmcnt(0)" ::: "memory"); SBAR();
#define PK(L, H) (bf16x8){L[0], L[1], L[2], L[3], H[0], H[1], H[2], H[3]}
  od = __builtin_amdgcn_mfma_f32_32x32x16_bf16(pa0, PK(l0, h0), od, 0, 0, 0);
  od = __builtin_amdgcn_mfma_f32_32x32x16_bf16(pa1, PK(l1, h1), od, 0, 0, 0);
  od = __builtin_amdgcn_mfma_f32_32x32x16_bf16(pa2, PK(l2, h2), od, 0, 0, 0);
  od = __builtin_amdgcn_mfma_f32_32x32x16_bf16(pa3, PK(l3, h3), od, 0, 0, 0);
#undef PK
}
__device__ __forceinline__ void pv_d0(f32x16* o, int vb, bf16x8 pa0, bf16x8 pa1, bf16x8 pa2, bf16x8 pa3) {
  pv_one<0>(o[0], vb, pa0, pa1, pa2, pa3); pv_one<1>(o[1], vb, pa0, pa1, pa2, pa3); pv_one<2>(o[2], vb, pa0, pa1, pa2, pa3); pv_one<3>(o[3], vb, pa0, pa1, pa2, pa3);
}

struct SrcOne { const bf16_t* k0; const bf16_t* v0; int ldk;
  __device__ __forceinline__ const bf16_t* k(int j) const { return k0 + (size_t)j * 64 * ldk; }
  __device__ __forceinline__ const bf16_t* v(int j) const { return v0 + (size_t)j * 64 * ldk; } };
struct SrcTwo { const bf16_t* ck; const bf16_t* cv; const bf16_t* k1; const bf16_t* v1; int ldk;
  __device__ __forceinline__ const bf16_t* k(int j) const { return j < 4 ? ck + (size_t)j * 64 * ldk : k1 + (size_t)(j - 4) * 64 * ldk; }
  __device__ __forceinline__ const bf16_t* v(int j) const { return j < 4 ? cv + (size_t)j * 64 * ldk : v1 + (size_t)(j - 4) * 64 * ldk; } };
struct NoBias { __device__ __forceinline__ void operator()(f32x16&, f32x16&, int, int, int, int) const {} };
struct NaBias { const float* tab; int i0, kr0;
  __device__ __forceinline__ void operator()(f32x16& p0, f32x16& p1, int jt, int wid, int r32, int hi) const {
    if (jt < 4) return;
    const int qi = i0 + wid * QBLK + r32, r = qi >> 6, qc = qi & 63, kr = kr0 + jt - 4;
    int lo = r - 4; lo = lo < 0 ? 0 : (lo > 8 ? 8 : lo);
    const bool rowok = (kr >= lo) && (kr < lo + 8);
    if (!rowok) {
#pragma unroll
      for (int rr = 0; rr < 16; ++rr) { p0[rr] = -1e30f; p1[rr] = -1e30f; }
      return;
    }
    int c0 = qc - 8; c0 = c0 < 0 ? 0 : (c0 > 48 ? 48 : c0);
    const int dr = kr - r + 7;
    const float* tb = tab + dr * 31 + (4 * hi - qc + 15);
    const int w0 = 4 * hi - c0;
#pragma unroll
    for (int g = 0; g < 4; ++g) {
#pragma unroll
      for (int q = 0; q < 4; ++q) {
        const int rr = 4 * g + q, kc0 = q + 8 * g;
        const float t0 = tb[kc0], t1 = tb[kc0 + 32];
        p0[rr] = ((unsigned)(kc0 + w0) < 16u) ? p0[rr] + t0 : -1e30f;
        p1[rr] = ((unsigned)(kc0 + 32 + w0) < 16u) ? p1[rr] + t1 : -1e30f;
      }
      SBAR();
    }
  } };

template <int SD, class Src, class Bias>
__device__ ATT_INLINE void attn_body(const bf16_t* __restrict__ Qb, const Src src, bf16_t* __restrict__ Ob, const int NT, char* lds, const Bias bias) {
  const int tid = opaque_tid(), wid = tid >> 6, lane = tid & 63, r32 = lane & 31, hi = lane >> 5;
  const int LDK = src.ldk;
  bf16_t* V_lds = (bf16_t*)lds; bf16_t* K_lds = (bf16_t*)(lds + 2 * SHM_V);
  float* ws = (float*)(lds + 2 * SHM_V + 2 * SHM_K) + wid * 64; float* li_l = ws; float* al_l = ws + 32;
  float m_reg = -1e30f, l_reg = 0; f32x16 o[4] = {};
  bf16_t* Q_lds = (bf16_t*)(lds + 2 * SHM_V + 2 * SHM_K + NW * 64 * 4);
  const int qrow = wid * QBLK + r32;
  {
#pragma unroll
    for (int i = 0; i < 8; ++i) { const int f = tid + 512 * i, row = f >> 4, c8 = (f & 15) * 8;
      *(bf16x8*)((char*)Q_lds + KSWZ(row, c8 * 2)) = *reinterpret_cast<const bf16x8*>(Qb + (long)row * LDQ + c8); }
  }
  const int sr = tid >> 4, sc = (tid & 15) * 8, vst0 = v_st(sr, sc), vst1 = v_st(32 + sr, sc);
  const int vb0 = (int)(uintptr_t)V_lds + v_rd_base(lane);
  struct { bf16x8 vs0, vs1, ks0, ks1; } sr_[SD];
#define SLOAD(i, jt) do { const bf16_t* kt_ = src.k(jt); const bf16_t* vt_ = src.v(jt); \
    sr_[i].vs0 = *reinterpret_cast<const bf16x8*>(&vt_[(long)sr * LDK + sc]); sr_[i].vs1 = *reinterpret_cast<const bf16x8*>(&vt_[(long)(32 + sr) * LDK + sc]); \
    sr_[i].ks0 = *reinterpret_cast<const bf16x8*>(&kt_[(long)sr * LDK + sc]); sr_[i].ks1 = *reinterpret_cast<const bf16x8*>(&kt_[(long)(32 + sr) * LDK + sc]); } while (0)
#define SWRITE(b, i) do { *(bf16x8*)((char*)V_lds + (b) * SHM_V + vst0) = sr_[i].vs0;          \
    *(bf16x8*)((char*)V_lds + (b) * SHM_V + vst1) = sr_[i].vs1; int kc = sc * 2;               \
    *(bf16x8*)((char*)K_lds + (b) * SHM_K + KSWZ(sr, kc)) = sr_[i].ks0;                       \
    *(bf16x8*)((char*)K_lds + (b) * SHM_K + KSWZ(32 + sr, kc)) = sr_[i].ks1; } while (0)
#define SWAIT() do { if constexpr (SD == 2) asm volatile("s_waitcnt vmcnt(4)" ::: "memory"); else asm volatile("s_waitcnt vmcnt(0)" ::: "memory"); } while (0)
#define RESC(a) do { if (__any((a) < 1.f)) { if (hi == 0) al_l[r32] = (a); asm volatile("s_waitcnt lgkmcnt(0)" ::: "memory"); \
    for (int d = 0; d < 4; ++d) for (int r = 0; r < 16; ++r) o[d][r] *= al_l[crow(r, hi)]; } } while (0)
  f32x16 pA0, pA1, pB0, pB1; float mnA, mnB, alA, alB; bf16x8 pa0, pa1, pa2, pa3;
  constexpr int SE = 0, SO = SD - 1;
  SLOAD(SE, 0); asm volatile("s_waitcnt vmcnt(0)" ::: "memory"); SWRITE(0, SE); __syncthreads();
  qkt(pA0, pA1, K_lds, Q_lds, qrow, r32, hi); bias(pA0, pA1, 0, wid, r32, hi); partialSM(pA0, pA1, m_reg, mnA, alA);
  SLOAD(SO, 1); if constexpr (SD == 2) { if (2 < NT) SLOAD(SE, 2); }
  SWAIT(); SWRITE(1, SO); __syncthreads();
  for (int j = 1; j + 1 < NT; j += 2) {
    SBAR(); qkt(pB0, pB1, (bf16_t*)((char*)K_lds + SHM_K), Q_lds, qrow, r32, hi); bias(pB0, pB1, j, wid, r32, hi);
    finishSM(pA0, pA1, alA, l_reg, pa0, pa1, pa2, pa3); SBAR();
    SLOAD(SO, j + SD); SBAR();
    pv_d0(o, vb0, pa0, pa1, pa2, pa3); partialSM(pB0, pB1, m_reg, mnB, alB);
    __syncthreads(); SWAIT(); SWRITE(0, SE);
    RESC(alB); __syncthreads();
    SBAR(); qkt(pA0, pA1, K_lds, Q_lds, qrow, r32, hi); bias(pA0, pA1, j + 1, wid, r32, hi);
    finishSM(pB0, pB1, alB, l_reg, pa0, pa1, pa2, pa3); SBAR();
    if (SD == 1 || j + 3 < NT) SLOAD(SE, j + 1 + SD); SBAR();
    pv_d0(o, vb0 + (int)SHM_V, pa0, pa1, pa2, pa3); partialSM(pA0, pA1, m_reg, mnA, alA);
    __syncthreads(); SWAIT(); SWRITE(1, SO);
    RESC(alA); __syncthreads();
  }
  SBAR(); qkt(pB0, pB1, (bf16_t*)((char*)K_lds + SHM_K), Q_lds, qrow, r32, hi); bias(pB0, pB1, NT - 1, wid, r32, hi);
  finishSM(pA0, pA1, alA, l_reg, pa0, pa1, pa2, pa3); SBAR();
  pv_d0(o, vb0, pa0, pa1, pa2, pa3); partialSM(pB0, pB1, m_reg, mnB, alB);
  __syncthreads(); RESC(alB);
  finishSM(pB0, pB1, alB, l_reg, pa0, pa1, pa2, pa3); SBAR();
  pv_d0(o, vb0 + (int)SHM_V, pa0, pa1, pa2, pa3);
  if (hi == 0) li_l[r32] = l_reg; asm volatile("s_waitcnt lgkmcnt(0)" ::: "memory");
  float rli[16];
#pragma unroll
  for (int r = 0; r < 16; ++r) rli[r] = __builtin_amdgcn_rcpf(li_l[crow(r, hi)]);
  bf16_t* Ow = Ob + (long)(wid * QBLK) * LDO;
#pragma unroll
  for (int r = 0; r < 16; ++r) { int orow = crow(r, hi);
    for (int d0 = 0; d0 < 4; ++d0) Ow[(long)orow * LDO + d0 * 32 + r32] = f2bf(o[d0][r] * rli[r]); }
#undef SLOAD
#undef SWRITE
#undef SWAIT
#undef RESC
}
}
namespace gdn {
using att::bf16x8; using att::f32x16; using att::crow;
constexpr int C = 32, SK = 136, SS = 40;
constexpr int OFF_KT = 0, OFF_QT = OFF_KT + C * SK * 2, OFF_W = OFF_QT + C * SK * 2, OFF_KTT = OFF_W + C * SK * 2, OFF_VTT = OFF_KTT + 128 * SS * 2,
              OFF_VN = OFF_VTT + 128 * SS * 2, OFF_VNS = OFF_VN + 128 * SS * 2, OFF_ST = OFF_VNS + 128 * SS * 2, OFF_TB = OFF_ST + 128 * SK * 2,
              OFF_TBE = OFF_TB + C * SS * 2, OFF_ATT = OFF_TBE + C * SS * 2, OFF_L = OFF_ATT + C * SS * 2, OFF_SC = OFF_L + C * C * 4, GDN_LDS = OFF_SC + 1024;
template <int K>
__device__ __forceinline__ f32x16 mm(const bf16_t* A, int lda, const bf16_t* Bt, int ldb, int l32, int hi, f32x16 acc) {
#pragma unroll
    for (int k0 = 0; k0 < K; k0 += 16) {
        const bf16x8 a = *reinterpret_cast<const bf16x8*>(A + l32 * lda + k0 + 8 * hi);
        const bf16x8 b = *reinterpret_cast<const bf16x8*>(Bt + l32 * ldb + k0 + 8 * hi);
        acc = __builtin_amdgcn_mfma_f32_32x32x16_bf16(a, b, acc, 0, 0, 0);
    }
    return acc;
}
__device__ __forceinline__ uint2 pk4(float a, float b, float c, float d) { uint2 w; w.x = pack2(a, b); w.y = pack2(c, d); return w; }

__device__ __forceinline__ void gdn_chunked(const Params& p, int l, bool ctx, int b, int h, int dir, unsigned char* lds) {
    const int tid = opaque_tid(), wid = tid >> 6, lane = tid & 63, l32 = lane & 31, hi = lane >> 5;
    const int T = ctx ? CT : ::LT; const size_t m0 = ctx ? (size_t)b * CT : (size_t)MC + (size_t)b * ::LT;
    const float* DQ = WSP(float, WS_DQ); const float* DK = WSP(float, WS_DK); const float* DV = WSP(float, WS_DV); const float* DBA = WSP(float, WS_DBA);
    float* O = WSP(float, dir ? WS_DOB : WS_DOF);
    bf16_t* Kt = (bf16_t*)(lds + OFF_KT); bf16_t* Qt = (bf16_t*)(lds + OFF_QT); bf16_t* W = (bf16_t*)(lds + OFF_W); bf16_t* KT = (bf16_t*)(lds + OFF_KTT); bf16_t* VT = (bf16_t*)(lds + OFF_VTT);
    bf16_t* VN = (bf16_t*)(lds + OFF_VN); bf16_t* VNS = (bf16_t*)(lds + OFF_VNS); bf16_t* ST = (bf16_t*)(lds + OFF_ST); bf16_t* TB = (bf16_t*)(lds + OFF_TB); bf16_t* TBE = (bf16_t*)(lds + OFF_TBE);
    bf16_t* ATT = (bf16_t*)(lds + OFF_ATT); float* Lm = (float*)(lds + OFF_L); float* sc = (float*)(lds + OFF_SC);
    const int nch = T / C;
#define TOK(c, s_) (m0 + (dir ? T - 1 - ((c) * C + (s_)) : (c) * C + (s_)))
    f32x16 S[2];
#pragma unroll
    for (int bi = 0; bi < 2; ++bi) {
        const int blk = wid * 2 + bi, d0 = 32 * (blk >> 2), e0 = 32 * (blk & 3);
        if (ctx) { S[bi] = f32x16{}; }
        else {
            const float* s0 = p.in[I_SGDN] + ((((size_t)b * DEPTH + l) * 2 + dir) * 4 + h) * 128 * 128 + e0 + l32;
#pragma unroll
            for (int r = 0; r < 16; ++r) S[bi][r] = s0[(size_t)(d0 + crow(r, hi)) * 128];
        }
    }
    const int ls = tid >> 5, lc = (tid & 31) * 4;
    vf4 pq0, pq1, pk0, pk1, pv0, pv1; float pbeta = 0.f, pg = 0.f;
#define GLOAD(c) do { const size_t ma = TOK(c, ls), mb = TOK(c, ls + 16); \
        pq0 = *(const vf4*)(DQ + ma * 512 + h * 128 + lc); pq1 = *(const vf4*)(DQ + mb * 512 + h * 128 + lc); \
        pk0 = *(const vf4*)(DK + ma * 512 + h * 128 + lc); pk1 = *(const vf4*)(DK + mb * 512 + h * 128 + lc); \
        pv0 = *(const vf4*)(DV + ma * 512 + h * 128 + lc); pv1 = *(const vf4*)(DV + mb * 512 + h * 128 + lc); \
        if (tid < C) { const size_t mt = TOK(c, tid); pbeta = DBA[mt * 16 + dir * 4 + h]; pg = DBA[mt * 16 + 8 + dir * 4 + h]; } } while (0)
#define GSTAGE() do { \
        *(uint2*)(Kt + ls * SK + lc) = pk4(pk0.x, pk0.y, pk0.z, pk0.w); *(uint2*)(Kt + (ls + 16) * SK + lc) = pk4(pk1.x, pk1.y, pk1.z, pk1.w); \
        *(uint2*)(Qt + ls * SK + lc) = pk4(pq0.x, pq0.y, pq0.z, pq0.w); *(uint2*)(Qt + (ls + 16) * SK + lc) = pk4(pq1.x, pq1.y, pq1.z, pq1.w); \
        _Pragma("unroll") for (int j = 0; j < 4; ++j) { KT[(lc + j) * SS + ls] = f2bf(pk0[j]); KT[(lc + j) * SS + ls + 16] = f2bf(pk1[j]); \
                                                        VT[(lc + j) * SS + ls] = f2bf(pv0[j]); VT[(lc + j) * SS + ls + 16] = f2bf(pv1[j]); } \
        if (wid == 0) { float x = pg; _Pragma("unroll") for (int o_ = 1; o_ < 32; o_ <<= 1) { const float y = __shfl_up(x, o_); if (lane >= o_) x += y; } \
            const float Bt_ = __shfl(x, 31); if (lane < C) { sc[lane] = pbeta; sc[32 + lane] = x; sc[64 + lane] = __expf(x); sc[96 + lane] = __expf(Bt_ - x); if (lane == 0) sc[128] = __expf(Bt_); } } } while (0)
    __syncthreads();
    GLOAD(0);
#pragma unroll
    for (int bi = 0; bi < 2; ++bi) {
        const int blk = wid * 2 + bi, d0 = 32 * (blk >> 2), e0 = 32 * (blk & 3);
#pragma unroll
        for (int g = 0; g < 4; ++g) *(uint2*)(ST + (e0 + l32) * SK + d0 + 8 * g + 4 * hi) = pk4(S[bi][4 * g], S[bi][4 * g + 1], S[bi][4 * g + 2], S[bi][4 * g + 3]);
    }
    GSTAGE();
    __syncthreads();
    for (int c = 0; c < nch; ++c) {
        if (c + 1 < nch) GLOAD(c + 1);
        f32x16 acc1 = f32x16{};
        if (wid == 0) {
            const f32x16 kk = mm<128>(Kt, SK, Kt, SK, l32, hi, f32x16{});
            const float bi_ = sc[32 + l32], be = sc[l32];
#pragma unroll
            for (int r = 0; r < 16; ++r) { const int j = crow(r, hi); const float v = (l32 > j) ? be * kk[r] * __expf(bi_ - sc[32 + j]) : 0.f;
                Lm[l32 * 32 + ((r & 3) + 4 * hi) * 4 + (r >> 2)] = v; }
        } else if (wid == 1) {
            const f32x16 kq = mm<128>(Kt, SK, Qt, SK, l32, hi, f32x16{});
            const float bi_ = sc[32 + l32];
            float a[16];
#pragma unroll
            for (int r = 0; r < 16; ++r) { const int j = crow(r, hi); a[r] = (l32 >= j) ? kq[r] * __expf(bi_ - sc[32 + j]) : 0.f; }
#pragma unroll
            for (int g = 0; g < 4; ++g) *(uint2*)(ATT + l32 * SS + 8 * g + 4 * hi) = pk4(a[4 * g], a[4 * g + 1], a[4 * g + 2], a[4 * g + 3]);
        } else if (wid >= 4) {
            acc1 = mm<128>(Qt, SK, ST + (32 * (wid - 4)) * SK, SK, l32, hi, f32x16{});
#pragma unroll
            for (int r = 0; r < 16; ++r) acc1[r] *= sc[64 + crow(r, hi)];
        }
        __syncthreads();
        if (tid < 256) {
            const int cc = tid >> 3, part = tid & 7;
            float Tr[4] = {0.f, 0.f, 0.f, 0.f};
            const float* Lp = Lm + part * 4;
#pragma unroll
            for (int i = 0; i < 32; ++i) {
                const vf4 lv = *(const vf4*)(Lp + i * 32);
                float s = lv.x * Tr[0] + lv.y * Tr[1] + lv.z * Tr[2] + lv.w * Tr[3];
                s = red8(s);
                const float t = (i == cc ? 1.f : 0.f) - s;
                if (part == (i & 7)) Tr[i >> 3] = t;
            }
            const float bc = sc[cc], bec = bc * sc[64 + cc];
#pragma unroll
            for (int jj = 0; jj < 4; ++jj) { TB[(part + 8 * jj) * SS + cc] = f2bf(Tr[jj] * bc); TBE[(part + 8 * jj) * SS + cc] = f2bf(Tr[jj] * bec); }
        }
        __syncthreads();
        if (wid < 4) {
            acc1 = mm<32>(TB, SS, VT + (32 * wid) * SS, SS, l32, hi, f32x16{});
        } else {
            const int d0 = 32 * (wid - 4);
            const f32x16 wt = mm<32>(KT + d0 * SS, SS, TBE, SS, l32, hi, f32x16{});
#pragma unroll
            for (int g = 0; g < 4; ++g) *(uint2*)(W + l32 * SK + d0 + 8 * g + 4 * hi) = pk4(wt[4 * g], wt[4 * g + 1], wt[4 * g + 2], wt[4 * g + 3]);
        }
        __syncthreads();
        if (wid < 4) {
            const int e0 = 32 * wid;
            const f32x16 ws = mm<128>(W, SK, ST + e0 * SK, SK, l32, hi, f32x16{});
            float vn[16], vs[16];
#pragma unroll
            for (int r = 0; r < 16; ++r) { vn[r] = acc1[r] - ws[r]; vs[r] = vn[r] * sc[96 + crow(r, hi)]; }
#pragma unroll
            for (int g = 0; g < 4; ++g) { *(uint2*)(VN + (e0 + l32) * SS + 8 * g + 4 * hi) = pk4(vn[4 * g], vn[4 * g + 1], vn[4 * g + 2], vn[4 * g + 3]);
                                          *(uint2*)(VNS + (e0 + l32) * SS + 8 * g + 4 * hi) = pk4(vs[4 * g], vs[4 * g + 1], vs[4 * g + 2], vs[4 * g + 3]); }
        }
        __syncthreads();
        if (wid >= 4) {
            const int e0 = 32 * (wid - 4);
            acc1 = mm<32>(ATT, SS, VN + e0 * SS, SS, l32, hi, acc1);
#pragma unroll
            for (int r = 0; r < 16; ++r) O[TOK(c, crow(r, hi)) * 512 + h * 128 + e0 + l32] = acc1[r];
        }
        {
            const float eB = sc[128];
#pragma unroll
            for (int bi = 0; bi < 2; ++bi) {
                const int blk = wid * 2 + bi, d0 = 32 * (blk >> 2), e0 = 32 * (blk & 3);
#pragma unroll
                for (int r = 0; r < 16; ++r) S[bi][r] *= eB;
                S[bi] = mm<32>(KT + d0 * SS, SS, VNS + e0 * SS, SS, l32, hi, S[bi]);
            }
        }
        __syncthreads();
#pragma unroll
        for (int bi = 0; bi < 2; ++bi) {
            const int blk = wid * 2 + bi, d0 = 32 * (blk >> 2), e0 = 32 * (blk & 3);
#pragma unroll
            for (int g = 0; g < 4; ++g) *(uint2*)(ST + (e0 + l32) * SK + d0 + 8 * g + 4 * hi) = pk4(S[bi][4 * g], S[bi][4 * g + 1], S[bi][4 * g + 2], S[bi][4 * g + 3]);
        }
        if (c + 1 < nch) GSTAGE();
        __syncthreads();
    }
#undef GLOAD
#undef GSTAGE
#undef TOK
    if (ctx) {
#pragma unroll
        for (int bi = 0; bi < 2; ++bi) {
            const int blk = wid * 2 + bi, d0 = 32 * (blk >> 2), e0 = 32 * (blk & 3);
            float* so = p.out + O_SGDN + ((((size_t)b * DEPTH + l) * 2 + dir) * 4 + h) * 128 * 128 + e0 + l32;
#pragma unroll
            for (int r = 0; r < 16; ++r) so[(size_t)(d0 + crow(r, hi)) * 128] = S[bi][r];
        }
    }
}
}
#define LAS __attribute__((address_space(3)))
constexpr int LDS_BYTES = 147456, XBW_OFF = LDS_BYTES - 64;
constexpr int NPH = 1 + DEPTH * 12;
#ifndef DBG_NLAYERS
#define DBG_NLAYERS DEPTH
#endif

#ifndef DUPKIND
#define DUPKIND 0
#endif
__device__ __forceinline__ int opaque_int(int v) { asm volatile("" : "+s"(v)); return v; }
#ifndef MIXMASK
#define MIXMASK 0xFF
#endif
#define FOR_ITEMS(it, n, o, w) for (int bo_ = (o) * (int)gridDim.x / 256, bw_ = ((w) * (int)gridDim.x / 256) > 0 ? ((w) * (int)gridDim.x / 256) : 1, \
                                    it = ((int)blockIdx.x >= bo_ && (int)blockIdx.x < bo_ + bw_) ? (int)blockIdx.x - bo_ : (n); it < (n); it += bw_)

constexpr int QCTR_WORD0 = 1024;
constexpr int NI_GDNL = LB * 8, NI_GLAL = LB * 16, NI_GDNC = CB * 8, NI_GQAL = LB * 16, NI_NAL = LB * 16, NI_GLAC = CB * 16, NI_NAC = CB * 4, NI_GQAC = CB * 4;
constexpr int Q0 = NI_GDNL, Q1 = Q0 + NI_GLAL, Q2 = Q1 + NI_GDNC, Q3 = Q2 + NI_GQAL, Q4 = Q3 + NI_NAL, Q5 = Q4 + NI_GLAC, Q6 = Q5 + NI_NAC, Q7 = Q6 + NI_GQAC;
__device__ __forceinline__ void phase_mix(const Params& p, int l, unsigned char* lds) {
    const int tid = opaque_tid();
    float* smem = (float*)lds;
    const bf16_t* NAQ = WSP(bf16_t, WS_NAQ); const bf16_t* NAK = WSP(bf16_t, WS_NAK); const bf16_t* NAV = WSP(bf16_t, WS_NAV);
    const bf16_t* GQ = WSP(bf16_t, WS_GQ); const bf16_t* GK = WSP(bf16_t, WS_GK); const bf16_t* GV = WSP(bf16_t, WS_GV);
    bf16_t* MRG = WSP(bf16_t, WS_MRG);
    unsigned* qctr = WSP(unsigned, WS_CTL) + QCTR_WORD0 + 64 * l;
    volatile int* qslot = (volatile int*)(lds + XBW_OFF + 16);
    for (;;) {
        __syncthreads();
        if (tid == 0) *qslot = (int)__hip_atomic_fetch_add(qctr, 1u, __ATOMIC_RELAXED, __HIP_MEMORY_SCOPE_AGENT);
        __syncthreads();
        const int q = __builtin_amdgcn_readfirstlane(*qslot);
        if (q >= Q7) break;
        if (q < Q0) { const int it = q; gdn::gdn_chunked(p, l, false, it / 8, (it / 2) % 4, it % 2, lds); }
        else if (q < Q1) { const int it = q - Q0; gla_chain(p, l, false, it / 16, (it / 4) % 4, (it / 2) % 2, it % 2, smem); }
        else if (q < Q2) { const int it = q - Q1; gdn::gdn_chunked(p, l, true, it / 8, (it / 2) % 4, it % 2, lds); }
        else if (q < Q3) {
            const int it = q - Q2, b = it / 16, qh = (it / 4) % 4, qb = it % 4, kvh = qh >> 1;
            const size_t r0 = (size_t)MC + (size_t)b * LT;
            att::SrcTwo src{WSP(bf16_t, WS_CGK) + ((size_t)b * DEPTH + l) * 256 * 256 + kvh * 128, WSP(bf16_t, WS_CGV) + ((size_t)b * DEPTH + l) * 256 * 256 + kvh * 128,
                            GK + r0 * 256 + kvh * 128, GV + r0 * 256 + kvh * 128, 256};
            att::attn_body<2>(GQ + (r0 + qb * 256) * 512 + qh * 128, src, MRG + (r0 + qb * 256) * DM + 1024 + qh * 128, 4 + LT / 64, (char*)lds, att::NoBias{});
        }
        else if (q < Q4) {
            const int it = q - Q3, b = it / 16, h = (it / 4) % 4, qb = it % 4;
            const int kr0 = qb == 0 ? 0 : qb == 1 ? 0 : qb == 2 ? 4 : 8, nrows = (qb == 0 || qb == 3) ? 8 : 12;
            const size_t r0 = (size_t)MC + (size_t)b * LT;
            float* tab = (float*)(lds + att::SHM_ATTN);
            if (tid < 15 * 31) tab[tid] = p.in[I_RPB][((size_t)l * 4 + h) * 15 * 31 + tid] * (1.0f / att::SCALE);
            att::SrcTwo src{WSP(bf16_t, WS_CNAK) + ((size_t)b * DEPTH + l) * 256 * 512 + h * 128, WSP(bf16_t, WS_CNAV) + ((size_t)b * DEPTH + l) * 256 * 512 + h * 128,
                            NAK + (r0 + kr0 * 64) * 512 + h * 128, NAV + (r0 + kr0 * 64) * 512 + h * 128, 512};
            att::attn_body<1>(NAQ + (r0 + qb * 256) * 512 + h * 128, src, MRG + (r0 + qb * 256) * DM + 0 + h * 128, 4 + nrows, (char*)lds, att::NaBias{tab, qb * 256, kr0});
        }
        else if (q < Q5) { const int it = q - Q4; gla_chain(p, l, true, it / 16, (it / 4) % 4, (it / 2) % 2, it % 2, smem); }
        else if (q < Q6) {
            const int it = q - Q5, b = it / 4, h = it % 4; const size_t r0 = (size_t)b * CT;
            att::SrcOne src{NAK + r0 * 512 + h * 128, NAV + r0 * 512 + h * 128, 512};
            att::attn_body<2>(NAQ + r0 * 512 + h * 128, src, MRG + r0 * DM + 0 + h * 128, CT / 64, (char*)lds, att::NoBias{});
        }
        else {
            const int it = q - Q6, b = it / 4, qh = it % 4, kvh = qh >> 1; const size_t r0 = (size_t)b * CT;
            att::SrcOne src{GK + r0 * 256 + kvh * 128, GV + r0 * 256 + kvh * 128, 256};
            att::attn_body<2>(GQ + r0 * 512 + qh * 128, src, MRG + r0 * DM + 1024 + qh * 128, CT / 64, (char*)lds, att::NoBias{});
        }
    }
}

static_assert(att::SHM_ATTN + 15 * 31 * 4 + 2048 <= (size_t)XBW_OFF, "LDS map");
static_assert((QCTR_WORD0 + 64 * DEPTH) < 4096, "ctl");
constexpr int BAR_WORD0 = 4096;
static_assert((BAR_WORD0 + XCD_BAR_WORDS) * 4 <= (int)CTL_BYTES, "ctl");

__global__ void __launch_bounds__(512, 2) fwd(Params p) {
    extern __shared__ __attribute__((aligned(16))) unsigned char lds[];
    const int tid = threadIdx.x;
    volatile LAS unsigned* xbw = (volatile LAS unsigned*)((LAS unsigned char*)lds + XBW_OFF);
    if (tid < 4) xbw[tid] = 0u;
    __syncthreads();
    XcdBarrier bar; bar.bar = WSP(unsigned, WS_CTL) + BAR_WORD0; bar.x = 0; bar.st = xbw;
    if (p.ph_hi - p.ph_lo > 1) bar = xcd_barrier_post(WSP(unsigned, WS_CTL) + BAR_WORD0, xbw);
#ifndef PHMASK
#define PHMASK 0x1FFF
#endif
#define IN(k) (p.ph_lo <= (k) && (k) < p.ph_hi)
#define INL(j) (((PHMASK >> ((j) + 1)) & 1) && IN(pb + (j)))
#ifndef DUPMASK
#define DUPMASK 0
#endif
#define DUP(j) ((DUPMASK >> ((j) + 1)) & 1)
#define SEAM(k) do { if (IN(k) && IN((k) + 1)) xcd_barrier(bar); } while (0)
    LAS unsigned char* ldsl = (LAS unsigned char*)lds;
    bf16_t* H = WSP(bf16_t, WS_H); bf16_t* ACT = WSP(bf16_t, WS_ACT); float* X = WSP(float, WS_X); float* Z = WSP(float, WS_Z); bf16_t* MRG = WSP(bf16_t, WS_MRG);

    if ((PHMASK & 1) && IN(0)) { int reps_ = 1 + (DUPMASK & 1); asm volatile("" : "+s"(reps_)); for (int rep_ = 0; rep_ < reps_; ++rep_) { const Params q = opaque_params(p); phase_prologue(q, (float*)lds); __syncthreads(); } }
    SEAM(0);
    for (int l = 0; l < DBG_NLAYERS; ++l) {
        const int pb = 1 + l * 12;
        const float* modl = WSP(float, WS_MODV) + (size_t)l * NCOND * NMOD;
        if (INL(0)) { int reps_ = 1 + DUP(0); asm volatile("" : "+s"(reps_)); for (int rep_ = 0; rep_ < reps_; ++rep_) { const Params q = opaque_params(p); phase_norm(q, l, 0); __syncthreads(); } }
        SEAM(pb + 0);
        if (INL(1)) {
            pg8::Gemm g{H, WSP(bf16_t, WS_WGU) + ((size_t)l * 2 + 0) * NGU * DM, M, NGU, DM}; pg8::StaticOrder S; S.init(M, NGU, DM, (int)gridDim.x, (int)blockIdx.x);
            pg8::EpiSwiGLU E{ACT, FF};
            for (int r_ = 0, n_ = opaque_int(1 + DUP(1)); r_ < n_; ++r_) pg8::gemm_phase<pg8::EpiSwiGLU, pg8::StaticOrder, false>(ldsl, g, S, E, nullptr);
        }
        SEAM(pb + 1);
        if (INL(2)) {
            pg8::Gemm g{ACT, WSP(bf16_t, WS_WDN) + ((size_t)l * 2 + 0) * DM * FF, M, DM, FF}; pg8::StaticOrder S; S.init(M, DM, FF, (int)gridDim.x, (int)blockIdx.x, 0);
            pg8::EpiResid E{X, X, DM, modl + 2 * DM, 0.5f};
            pg8::gemm_phase<pg8::EpiResid, pg8::StaticOrder, false>(ldsl, g, S, E, nullptr);
        }
        SEAM(pb + 2);
        if (INL(3)) { int reps_ = 1 + DUP(3); asm volatile("" : "+s"(reps_)); for (int rep_ = 0; rep_ < reps_; ++rep_) { const Params q = opaque_params(p); phase_norm(q, l, 1); __syncthreads(); } }
        SEAM(pb + 3);
        if (INL(4)) {
            pg8::Gemm g{H, WSP(bf16_t, WS_WIN) + (size_t)l * NINP * DM, M, NINP, DM}; pg8::StaticOrder S; S.init(M, NINP, DM, (int)gridDim.x, (int)blockIdx.x);
            pg8::EpiF32 E{Z, NINP, nullptr};
            for (int r_ = 0, n_ = opaque_int(1 + DUP(4)); r_ < n_; ++r_) pg8::gemm_phase<pg8::EpiF32, pg8::StaticOrder, false>(ldsl, g, S, E, nullptr);
        }
        SEAM(pb + 4);
        if (INL(5)) { int reps_ = 1 + DUP(5); asm volatile("" : "+s"(reps_)); for (int rep_ = 0; rep_ < reps_; ++rep_) { const Params q = opaque_params(p); phase_prep(q, l); __syncthreads(); } }
        SEAM(pb + 5);
        if (INL(6)) { int reps_ = 1 + DUP(6); asm volatile("" : "+s"(reps_)); for (int rep_ = 0; rep_ < reps_; ++rep_) { const Params q = opaque_params(p); phase_mix(q, l, lds); __syncthreads(); } }
        SEAM(pb + 6);
        if (INL(7)) { int reps_ = 1 + DUP(7); asm volatile("" : "+s"(reps_)); for (int rep_ = 0; rep_ < reps_; ++rep_) { const Params q = opaque_params(p); phase_post(q, l); __syncthreads(); } }
        SEAM(pb + 7);
        if (INL(8)) {
            pg8::Gemm g{MRG, WSP(bf16_t, WS_WOUT) + (size_t)l * DM * DM, M, DM, DM}; pg8::StaticOrder S; S.init(M, DM, DM, (int)gridDim.x, (int)blockIdx.x, 0);
            pg8::EpiResid E{X, X, DM, modl + 5 * DM, 1.0f};
            pg8::gemm_phase<pg8::EpiResid, pg8::StaticOrder, false>(ldsl, g, S, E, nullptr);
        }
        SEAM(pb + 8);
        if (INL(9)) { int reps_ = 1 + DUP(9); asm volatile("" : "+s"(reps_)); for (int rep_ = 0; rep_ < reps_; ++rep_) { const Params q = opaque_params(p); phase_norm(q, l, 2); __syncthreads(); } }
        SEAM(pb + 9);
        if (INL(10)) {
            pg8::Gemm g{H, WSP(bf16_t, WS_WGU) + ((size_t)l * 2 + 1) * NGU * DM, M, NGU, DM}; pg8::StaticOrder S; S.init(M, NGU, DM, (int)gridDim.x, (int)blockIdx.x);
            pg8::EpiSwiGLU E{ACT, FF};
            pg8::gemm_phase<pg8::EpiSwiGLU, pg8::StaticOrder, false>(ldsl, g, S, E, nullptr);
        }
        SEAM(pb + 10);
        if (INL(11)) {
            pg8::Gemm g{ACT, WSP(bf16_t, WS_WDN) + ((size_t)l * 2 + 1) * DM * FF, M, DM, FF}; pg8::StaticOrder S; S.init(M, DM, FF, (int)gridDim.x, (int)blockIdx.x, 0);
            pg8::EpiResid E{X, (l == DEPTH - 1) ? p.out : X, DM, modl + 8 * DM, 0.5f};
            pg8::gemm_phase<pg8::EpiResid, pg8::StaticOrder, false>(ldsl, g, S, E, nullptr);
        }
        SEAM(pb + 11);
    }
#undef IN
#undef SEAM
}

#ifndef MULTI_LAUNCH
#define MULTI_LAUNCH 0
#endif
extern "C" void kernel_launch(void* const* d_in, const int* in_sizes, int n_in, void* d_out, int out_size, void* d_ws, size_t ws_size, hipStream_t stream) {
    static int grid = 0;
    if (grid == 0) {
        if (n_in != N_IN || (size_t)out_size != O_END || ws_size < WS_END) { fprintf(stderr, "kernel_launch: shape mismatch n_in %d out %d ws %zu (need %zu)\n", n_in, out_size, ws_size, (size_t)WS_END); grid = -1; return; }
        int dev = 0, cus = 0, per_cu = 0;
        if (hipGetDevice(&dev) != hipSuccess || hipDeviceGetAttribute(&cus, hipDeviceAttributeMultiprocessorCount, dev) != hipSuccess) { grid = -1; return; }
        if (hipFuncSetAttribute((const void*)fwd, hipFuncAttributeMaxDynamicSharedMemorySize, LDS_BYTES) != hipSuccess) { fprintf(stderr, "kernel_launch: hipFuncSetAttribute failed\n"); grid = -1; return; }
        if (hipOccupancyMaxActiveBlocksPerMultiprocessor(&per_cu, (const void*)fwd, 512, LDS_BYTES) != hipSuccess || per_cu < 1) { fprintf(stderr, "kernel_launch: occupancy query says %d\n", per_cu); (void)hipGetLastError(); }
        grid = cus;
    }
    if (grid < 0) return;
    (void)hipMemsetAsync((char*)d_ws + WS_CTL, 0, CTL_BYTES, stream);
    Params p{};
    for (int i = 0; i < N_IN; ++i) p.in[i] = (const float*)d_in[i];
    p.out = (float*)d_out; p.ws = (unsigned char*)d_ws;
#if MULTI_LAUNCH
    for (int ph = 0; ph < 1 + DBG_NLAYERS * 12; ++ph) { p.ph_lo = ph; p.ph_hi = ph + 1; hipLaunchKernelGGL(fwd, dim3(grid), dim3(512), LDS_BYTES, stream, p); }
#else
    p.ph_lo = 0; p.ph_hi = NPH; hipLaunchKernelGGL(fwd, dim3(grid), dim3(512), LDS_BYTES, stream, p);
#endif
    const hipError_t le = hipPeekAtLastError();
    if (le != hipSuccess) fprintf(stderr, "kernel_launch: launch failed: %s\n", hipGetErrorName(le));
}
```

```cpp
#include <hip/hip_runtime.h>
#include <cstdio>
#include <cstdint>

#ifndef CB_
#define CB_ 16
#endif
#ifndef LB_
#define LB_ 8
#endif
#ifndef DEPTH_
#define DEPTH_ 4
#endif
constexpr int DM = 2048, DEPTH = DEPTH_, CB = CB_, CT = 256, LB = LB_, LT = 1024;
constexpr int MC = CB * CT, ML = LB * LT, M = MC + ML;
constexpr int FF = 5504, NGU = 2 * FF, NIN = 6192, NINP = 6400, NMOD = 9 * DM, NCOND = 1 + LB;
constexpr float EPS = 1e-6f;
constexpr int Z_NAQ = 0, Z_NAK = 512, Z_NAV = 1024, Z_GLQ = 1536, Z_GLK = 1792, Z_GLV = 2048, Z_GLR = 2560, Z_GF = 3072, Z_GB = 3088,
              Z_GQQ = 3104, Z_GQK = 3616, Z_GQV = 3872, Z_DQKV = 4128, Z_DZ = 5664, Z_DB = 6176, Z_DA = 6184;
static_assert(Z_DA + 8 == NIN, "split");
enum { I_XP = 0, I_XS, I_CNAK, I_CNAV, I_CGK, I_CGV, I_SGLA, I_SGDN, I_C, I_CCTX, I_NORMG, I_WMOD, I_BMOD, I_GU, I_DOWN, I_WIN, I_WOUT, I_NAQKN, I_RPB,
       I_GUP, I_GBIAS, I_GLAON, I_GQAQKN, I_CONV, I_ALOG, I_DTB, I_GDNON, N_IN };
constexpr size_t O_YP = 0, O_YS = O_YP + (size_t)MC * DM, O_NAK = O_YS + (size_t)ML * DM, O_NAV = O_NAK + (size_t)CB * DEPTH * 4 * CT * 128,
                 O_GK = O_NAV + (size_t)CB * DEPTH * 4 * CT * 128, O_GV = O_GK + (size_t)CB * DEPTH * 2 * CT * 128,
                 O_SGLA = O_GV + (size_t)CB * DEPTH * 2 * CT * 128, O_SGDN = O_SGLA + (size_t)CB * DEPTH * 2 * 4 * 64 * 128,
                 O_END = O_SGDN + (size_t)CB * DEPTH * 2 * 4 * 128 * 128;
constexpr size_t al256(size_t x) { return (x + 255) & ~(size_t)255; }
constexpr size_t WS_CTL = 0, CTL_BYTES = 1u << 20;
constexpr size_t WS_WGU = CTL_BYTES;
constexpr size_t WS_WDN = WS_WGU + (size_t)DEPTH * 2 * NGU * DM * 2;
constexpr size_t WS_WIN = WS_WDN + (size_t)DEPTH * 2 * DM * FF * 2;
constexpr size_t WS_WOUT = WS_WIN + (size_t)DEPTH * NINP * DM * 2;
constexpr size_t WS_MODV = WS_WOUT + (size_t)DEPTH * DM * DM * 2;
constexpr size_t WS_ROPE = al256(WS_MODV + (size_t)DEPTH * NCOND * NMOD * 4);
constexpr size_t WS_X = al256(WS_ROPE + 2 * 64 * 32 * 4);
constexpr size_t WS_H = WS_X + (size_t)M * DM * 4;
constexpr size_t WS_ACT = WS_H + (size_t)M * DM * 2;
constexpr size_t WS_Z = WS_ACT + (size_t)M * FF * 2;
constexpr size_t WS_MRG = WS_Z + (size_t)M * NINP * 4;
constexpr size_t WS_NAQ = WS_MRG + (size_t)M * DM * 2;
constexpr size_t WS_NAK = WS_NAQ + (size_t)M * 512 * 2;
constexpr size_t WS_NAV = WS_NAK + (size_t)M * 512 * 2;
constexpr size_t WS_GQ = WS_NAV + (size_t)M * 512 * 2;
constexpr size_t WS_GK = WS_GQ + (size_t)M * 512 * 2;
constexpr size_t WS_GV = WS_GK + (size_t)M * 256 * 2;
constexpr size_t WS_CNAK = WS_GV + (size_t)M * 256 * 2;
constexpr size_t WS_CNAV = WS_CNAK + (size_t)LB * DEPTH * 256 * 512 * 2;
constexpr size_t WS_CGK = WS_CNAV + (size_t)LB * DEPTH * 256 * 512 * 2;
constexpr size_t WS_CGV = WS_CGK + (size_t)LB * DEPTH * 256 * 256 * 2;
constexpr size_t WS_AF = WS_CGV + (size_t)LB * DEPTH * 256 * 256 * 2;
constexpr size_t WS_AB = WS_AF + (size_t)M * 256 * 4;
constexpr size_t WS_DQ = WS_AB + (size_t)M * 256 * 4;
constexpr size_t WS_DK = WS_DQ + (size_t)M * 512 * 4;
constexpr size_t WS_DV = WS_DK + (size_t)M * 512 * 4;
constexpr size_t WS_DBA = WS_DV + (size_t)M * 512 * 4;
constexpr size_t WS_GOF = WS_DBA + (size_t)M * 16 * 4;
constexpr size_t WS_GOB = WS_GOF + (size_t)M * 512 * 4;
constexpr size_t WS_DOF = WS_GOB + (size_t)M * 512 * 4;
constexpr size_t WS_DOB = WS_DOF + (size_t)M * 512 * 4;
constexpr size_t WS_END = WS_DOB + (size_t)M * 512 * 4;

typedef unsigned short bf16_t;
struct Params { const float* in[N_IN]; float* out; unsigned char* ws; int ph_lo, ph_hi; };
static_assert(sizeof(Params) == N_IN * 8 + 8 + 8 + 8, "no padding");

#define WSP(T, off) ((T*)(p.ws + (off)))
__device__ __forceinline__ int opaque_tid() { int t = (int)threadIdx.x; asm volatile("" : "+v"(t)); return t; }
__device__ __forceinline__ Params opaque_params(const Params& p) { Params q = p; unsigned long long w = (unsigned long long)q.ws; asm volatile("" : "+s"(w)); q.ws = (unsigned char*)w; return q; }

__device__ __forceinline__ float wave_sum(float v) {
#pragma unroll
    for (int o = 32; o >= 1; o >>= 1) v += __shfl_xor(v, o);
    return v;
}
__device__ __forceinline__ bf16_t f2bf(float f) { unsigned u = __float_as_uint(f); u += 0x7FFFu + ((u >> 16) & 1u); return (bf16_t)(u >> 16); }
__device__ __forceinline__ unsigned pack2(float a, float b) { return (unsigned)f2bf(a) | ((unsigned)f2bf(b) << 16); }
__device__ __forceinline__ float silu_f(float x) { return x / (1.f + expf(-x)); }
__device__ __forceinline__ float softplus_f(float x) { return fmaxf(x, 0.f) + log1pf(expf(-fabsf(x))); }
__device__ __forceinline__ float logsigmoid_f(float x) { return fminf(x, 0.f) - log1pf(expf(-fabsf(x))); }
__device__ __forceinline__ int cond_of_row(int m) { return m < MC ? 0 : 1 + (m - MC) / LT; }
typedef float vf4 __attribute__((ext_vector_type(4)));
__device__ __forceinline__ void conv_tile(const float* __restrict__ src, int ld_src, int ncols_src, int k0, int c0, bf16_t* __restrict__ dst, int ld_dst, int n0, float* tile) {
    const int tid = opaque_tid();
    {
        const int r = tid >> 3, c = (tid & 7) * 8;
        float4 a = make_float4(0.f, 0.f, 0.f, 0.f), b = a;
        if (c0 + c + 8 <= ncols_src) {
            const float* s = src + (size_t)(k0 + r) * ld_src + c0 + c;
            a = *(const float4*)s; b = *(const float4*)(s + 4);
        }
        float* t = tile + r * 65 + c;
        t[0] = a.x; t[1] = a.y; t[2] = a.z; t[3] = a.w; t[4] = b.x; t[5] = b.y; t[6] = b.z; t[7] = b.w;
    }
    __syncthreads();
    {
        const int n = tid >> 3, ks = (tid & 7) * 8;
        const float* t = tile + ks * 65 + n;
        uint4 w;
        w.x = pack2(t[0 * 65], t[1 * 65]); w.y = pack2(t[2 * 65], t[3 * 65]); w.z = pack2(t[4 * 65], t[5 * 65]); w.w = pack2(t[6 * 65], t[7 * 65]);
        *(uint4*)(dst + (size_t)(n0 + n) * ld_dst + k0 + ks) = w;
    }
    __syncthreads();
}

constexpr int MOD_ITEMS = DEPTH * (NMOD / 128);
constexpr int TGU_KT = DM / 64, TGU_NT = NGU / 64, TDN_KT = FF / 64, TDN_NT = DM / 64, TIN_KT = DM / 64, TIN_NT = NINP / 64, TOUT_KT = DM / 64, TOUT_NT = DM / 64;
constexpr int T_GU = DEPTH * 2 * TGU_KT * TGU_NT, T_DN = DEPTH * 2 * TDN_KT * TDN_NT, T_IN = DEPTH * TIN_KT * TIN_NT, T_OUT = DEPTH * TOUT_KT * TOUT_NT;

__device__ __forceinline__ void phase_prologue(const Params& p, float* smem) {
    const int tid = opaque_tid(), nb = gridDim.x, bid = blockIdx.x;
    float* s_cond = smem;
    float* s_red = s_cond + NCOND * DM;
    float* s_tile = s_red + 3 * 128 * NCOND;
    for (int i = tid; i < NCOND * DM; i += 512) { const int ci = i / DM, k = i % DM; const float v = ci == 0 ? p.in[I_CCTX][k] : p.in[I_C][(size_t)(ci - 1) * DM + k]; s_cond[i] = silu_f(v); }
    __syncthreads();
    float* modv = WSP(float, WS_MODV);
    for (int it = bid; it < MOD_ITEMS; it += nb) {
        const int l = it / (NMOD / 128), jt = it % (NMOD / 128);
        const int cl = tid & 127, kq = tid >> 7, col = jt * 128 + cl;
        const float* w = p.in[I_WMOD] + (size_t)l * DM * NMOD + col;
        float acc[NCOND];
#pragma unroll
        for (int ci = 0; ci < NCOND; ++ci) acc[ci] = 0.f;
        for (int k = kq * 512; k < kq * 512 + 512; k += 8) {
            float wv[8];
#pragma unroll
            for (int j = 0; j < 8; ++j) wv[j] = w[(size_t)(k + j) * NMOD];
#pragma unroll
            for (int ci = 0; ci < NCOND; ++ci) {
                const float4 s0 = *(const float4*)&s_cond[ci * DM + k], s1 = *(const float4*)&s_cond[ci * DM + k + 4];
                acc[ci] += s0.x * wv[0] + s0.y * wv[1] + s0.z * wv[2] + s0.w * wv[3] + s1.x * wv[4] + s1.y * wv[5] + s1.z * wv[6] + s1.w * wv[7];
            }
        }
        if (kq > 0) {
#pragma unroll
            for (int ci = 0; ci < NCOND; ++ci) s_red[((kq - 1) * 128 + cl) * NCOND + ci] = acc[ci];
        }
        __syncthreads();
        if (kq == 0) {
            const float bm = p.in[I_BMOD][(size_t)l * NMOD + col];
#pragma unroll
            for (int ci = 0; ci < NCOND; ++ci)
                modv[((size_t)l * NCOND + ci) * NMOD + col] = acc[ci] + s_red[(0 * 128 + cl) * NCOND + ci] + s_red[(1 * 128 + cl) * NCOND + ci] + s_red[(2 * 128 + cl) * NCOND + ci] + bm;
        }
        __syncthreads();
    }
    for (int it = bid; it < T_GU + T_DN + T_IN + T_OUT; it += nb) {
        if (it < T_GU) {
            const int mat = it / (TGU_KT * TGU_NT), r = it % (TGU_KT * TGU_NT), kt = r / TGU_NT, nt = r % TGU_NT;
            const int n0 = nt * 64, t256 = n0 / 256, c = n0 % 256;
            const int c0 = c < 128 ? 128 * t256 + c : FF + 128 * t256 + (c - 128);
            conv_tile(p.in[I_GU] + (size_t)mat * DM * NGU, NGU, NGU, kt * 64, c0, WSP(bf16_t, WS_WGU) + (size_t)mat * NGU * DM, DM, n0, s_tile);
        } else if (it < T_GU + T_DN) {
            const int i2 = it - T_GU, mat = i2 / (TDN_KT * TDN_NT), r = i2 % (TDN_KT * TDN_NT), kt = r / TDN_NT, nt = r % TDN_NT;
            conv_tile(p.in[I_DOWN] + (size_t)mat * FF * DM, DM, DM, kt * 64, nt * 64, WSP(bf16_t, WS_WDN) + (size_t)mat * DM * FF, FF, nt * 64, s_tile);
        } else if (it < T_GU + T_DN + T_IN) {
            const int i2 = it - T_GU - T_DN, mat = i2 / (TIN_KT * TIN_NT), r = i2 % (TIN_KT * TIN_NT), kt = r / TIN_NT, nt = r % TIN_NT;
            conv_tile(p.in[I_WIN] + (size_t)mat * DM * NIN, NIN, NIN, kt * 64, nt * 64, WSP(bf16_t, WS_WIN) + (size_t)mat * NINP * DM, DM, nt * 64, s_tile);
        } else {
            const int i2 = it - T_GU - T_DN - T_IN, mat = i2 / (TOUT_KT * TOUT_NT), r = i2 % (TOUT_KT * TOUT_NT), kt = r / TOUT_NT, nt = r % TOUT_NT;
            conv_tile(p.in[I_WOUT] + (size_t)mat * DM * DM, DM, DM, kt * 64, nt * 64, WSP(bf16_t, WS_WOUT) + (size_t)mat * DM * DM, DM, nt * 64, s_tile);
        }
    }
    const size_t gtid = (size_t)bid * 512 + tid, gstride = (size_t)nb * 512;
    {
        float4* X = WSP(float4, WS_X);
        const float4* xp = (const float4*)p.in[I_XP]; const float4* xs = (const float4*)p.in[I_XS];
        const size_t nc = (size_t)MC * DM / 4, n = (size_t)M * DM / 4;
        for (size_t i = gtid; i < n; i += gstride) X[i] = i < nc ? xp[i] : xs[i - nc];
    }
    {
        const size_t n_na = (size_t)LB * DEPTH * 256 * 512 / 8;
        for (size_t i = gtid; i < 2 * n_na; i += gstride) {
            const bool isv = i >= n_na; const size_t j = isv ? i - n_na : i;
            const int d8 = (int)(j % 16), h = (int)((j / 16) % 4), t = (int)((j / 64) % 256); const size_t bl = j / (64 * 256);
            const float* s = p.in[isv ? I_CNAV : I_CNAK] + ((bl * 4 + h) * 256 + t) * 128 + d8 * 8;
            const float4 a = *(const float4*)s, b = *(const float4*)(s + 4);
            uint4 w; w.x = pack2(a.x, a.y); w.y = pack2(a.z, a.w); w.z = pack2(b.x, b.y); w.w = pack2(b.z, b.w);
            *(uint4*)(WSP(bf16_t, isv ? WS_CNAV : WS_CNAK) + (bl * 256 + t) * 512 + h * 128 + d8 * 8) = w;
        }
        const size_t n_g = (size_t)LB * DEPTH * 256 * 256 / 8;
        for (size_t i = gtid; i < 2 * n_g; i += gstride) {
            const bool isv = i >= n_g; const size_t j = isv ? i - n_g : i;
            const int d8 = (int)(j % 16), h = (int)((j / 16) % 2), t = (int)((j / 32) % 256); const size_t bl = j / (32 * 256);
            const float* s = p.in[isv ? I_CGV : I_CGK] + ((bl * 2 + h) * 256 + t) * 128 + d8 * 8;
            const float4 a = *(const float4*)s, b = *(const float4*)(s + 4);
            uint4 w; w.x = pack2(a.x, a.y); w.y = pack2(a.z, a.w); w.z = pack2(b.x, b.y); w.w = pack2(b.z, b.w);
            *(uint4*)(WSP(bf16_t, isv ? WS_CGV : WS_CGK) + (bl * 256 + t) * 256 + h * 128 + d8 * 8) = w;
        }
    }
    for (size_t i = gtid; i < 64 * 32; i += gstride) {
        const int pos = (int)(i / 32), k = (int)(i % 32);
        const float inv = powf(10000.0f, -(float)(2 * k) / 64.0f);
        const float ang = (float)pos * inv;
        WSP(float, WS_ROPE)[i] = cosf(ang); WSP(float, WS_ROPE)[64 * 32 + i] = sinf(ang);
    }
}

__device__ __forceinline__ void phase_norm(const Params& p, int l, int which  ) {
    const int tid = opaque_tid(), lane = tid & 63, wv = tid >> 6;
    const float* X = WSP(float, WS_X); bf16_t* H = WSP(bf16_t, WS_H);
    const float* g = p.in[I_NORMG] + ((size_t)l * 3 + which) * DM;
    for (int m = blockIdx.x * 8 + wv; m < M; m += gridDim.x * 8) {
        const int ci = cond_of_row(m);
        const float* mv = WSP(float, WS_MODV) + ((size_t)l * NCOND + ci) * NMOD + (size_t)which * 3 * DM;
        const float* x = X + (size_t)m * DM;
        vf4 v[8]; float ss = 0.f;
#pragma unroll
        for (int i = 0; i < 8; ++i) { v[i] = *(const vf4*)(x + (i * 64 + lane) * 4); ss += v[i].x * v[i].x + v[i].y * v[i].y + v[i].z * v[i].z + v[i].w * v[i].w; }
        ss = wave_sum(ss);
        const float r = 1.0f / sqrtf(ss * (1.0f / DM) + EPS);
#pragma unroll
        for (int i = 0; i < 8; ++i) {
            const int c = (i * 64 + lane) * 4;
            const float4 gg = *(const float4*)(g + c), sh = *(const float4*)(mv + c), sc = *(const float4*)(mv + DM + c);
            const float o0 = v[i].x * r * gg.x * (1.f + sc.x) + sh.x, o1 = v[i].y * r * gg.y * (1.f + sc.y) + sh.y;
            const float o2 = v[i].z * r * gg.z * (1.f + sc.z) + sh.z, o3 = v[i].w * r * gg.w * (1.f + sc.w) + sh.w;
            uint2 w; w.x = pack2(o0, o1); w.y = pack2(o2, o3);
            *(uint2*)(H + (size_t)m * DM + c) = w;
        }
    }
}

__device__ __forceinline__ float red16(float v);
__device__ __forceinline__ float ssq8(vf4 a, vf4 b) { const vf4 s = a * a + b * b; return (s.x + s.y) + (s.z + s.w); }
__device__ __forceinline__ uint4 pack8(vf4 a, vf4 b) { uint4 w; w.x = pack2(a.x, a.y); w.y = pack2(a.z, a.w); w.z = pack2(b.x, b.y); w.w = pack2(b.z, b.w); return w; }
__device__ __forceinline__ void phase_prep(const Params& p, int l) {
    const int tid = opaque_tid(), lane = tid & 63, wv = tid >> 6, rg = lane >> 4, sub = lane & 15, c8 = sub * 8;
    const float* Z = WSP(float, WS_Z);
    const float* ropec = WSP(float, WS_ROPE); const float* ropes = ropec + 64 * 32;
    const float* wnq = p.in[I_NAQKN] + ((size_t)l * 2 + 0) * 128 + c8; const float* wnk = wnq + 128;
    const float* wgq = p.in[I_GQAQKN] + ((size_t)l * 2 + 0) * 128 + c8; const float* wgk = wgq + 128;
    const float* cw = p.in[I_CONV] + (size_t)l * 5 * 1536 + rg * 128 + c8;
    for (int m = blockIdx.x * 8 + wv; m < M; m += gridDim.x * 8) {
        const float* z = Z + (size_t)m * NINP;
        const bool ctx = m < MC;
        const int b = ctx ? m / CT : (m - MC) / LT, t = ctx ? m % CT : (m - MC) % LT, T = ctx ? CT : LT;
        {
            const int ho = rg * 128 + c8;
            const float* zkv = z + (rg < 2 ? Z_GQK + rg * 128 : Z_GQV + (rg - 2) * 128) + c8;
            vf4 q0 = *(const vf4*)(z + Z_NAQ + ho), q1 = *(const vf4*)(z + Z_NAQ + ho + 4), k0 = *(const vf4*)(z + Z_NAK + ho), k1 = *(const vf4*)(z + Z_NAK + ho + 4);
            const vf4 v0 = *(const vf4*)(z + Z_NAV + ho), v1 = *(const vf4*)(z + Z_NAV + ho + 4);
            vf4 g0 = *(const vf4*)(z + Z_GQQ + ho), g1 = *(const vf4*)(z + Z_GQQ + ho + 4), x0 = *(const vf4*)zkv, x1 = *(const vf4*)(zkv + 4);
            float r = 1.0f / sqrtf(red16(ssq8(q0, q1)) * (1.0f / 128) + EPS);
            q0 = q0 * r * *(const vf4*)wnq; q1 = q1 * r * *(const vf4*)(wnq + 4);
            *(uint4*)(WSP(bf16_t, WS_NAQ) + (size_t)m * 512 + ho) = pack8(q0, q1);
            r = 1.0f / sqrtf(red16(ssq8(k0, k1)) * (1.0f / 128) + EPS);
            k0 = k0 * r * *(const vf4*)wnk; k1 = k1 * r * *(const vf4*)(wnk + 4);
            *(uint4*)(WSP(bf16_t, WS_NAK) + (size_t)m * 512 + ho) = pack8(k0, k1);
            *(uint4*)(WSP(bf16_t, WS_NAV) + (size_t)m * 512 + ho) = pack8(v0, v1);
            if (ctx) {
                const size_t o = ((((size_t)b * DEPTH + l) * 4 + rg) * CT + t) * 128 + c8;
                *(vf4*)(p.out + O_NAK + o) = k0; *(vf4*)(p.out + O_NAK + o + 4) = k1; *(vf4*)(p.out + O_NAV + o) = v0; *(vf4*)(p.out + O_NAV + o + 4) = v1;
            }
            r = 1.0f / sqrtf(red16(ssq8(g0, g1)) * (1.0f / 128) + EPS);
            g0 = g0 * r * *(const vf4*)wgq; g1 = g1 * r * *(const vf4*)(wgq + 4);
            const float rk = 1.0f / sqrtf(red16(ssq8(x0, x1)) * (1.0f / 128) + EPS);
            if (rg < 2) { x0 = x0 * rk * *(const vf4*)wgk; x1 = x1 * rk * *(const vf4*)(wgk + 4); }
            if (!ctx) {
                const int pos = sub < 8 ? (t >> 6) : (t & 63), ai = pos * 32 + (c8 & 31);
                const vf4 c0 = *(const vf4*)(ropec + ai), c1 = *(const vf4*)(ropec + ai + 4), s0 = *(const vf4*)(ropes + ai), s1 = *(const vf4*)(ropes + ai + 4);
                const bool hi = (sub & 4) != 0;
                vf4 pg0, pg1, px0, px1;
#pragma unroll
                for (int j = 0; j < 4; ++j) { pg0[j] = __shfl_xor(g0[j], 4); pg1[j] = __shfl_xor(g1[j], 4); px0[j] = __shfl_xor(x0[j], 4); px1[j] = __shfl_xor(x1[j], 4); }
                g0 = hi ? pg0 * s0 + g0 * c0 : g0 * c0 - pg0 * s0; g1 = hi ? pg1 * s1 + g1 * c1 : g1 * c1 - pg1 * s1;
                if (rg < 2) { x0 = hi ? px0 * s0 + x0 * c0 : x0 * c0 - px0 * s0; x1 = hi ? px1 * s1 + x1 * c1 : x1 * c1 - px1 * s1; }
            }
            *(uint4*)(WSP(bf16_t, WS_GQ) + (size_t)m * 512 + ho) = pack8(g0, g1);
            *(uint4*)(WSP(bf16_t, rg < 2 ? WS_GK : WS_GV) + (size_t)m * 256 + (rg & 1) * 128 + c8) = pack8(x0, x1);
            if (ctx) {
                const size_t o = ((((size_t)b * DEPTH + l) * 2 + (rg & 1)) * CT + t) * 128 + c8;
                float* dst = p.out + (rg < 2 ? O_GK : O_GV) + o;
                *(vf4*)dst = x0; *(vf4*)(dst + 4) = x1;
            }
        }
        {
#pragma unroll
            for (int dir = 0; dir < 2; ++dir) {
                const float* up = p.in[I_GUP] + ((size_t)l * 2 + dir) * 16 * 256 + 4 * lane;
                vf4 acc = *(const vf4*)(p.in[I_GBIAS] + ((size_t)l * 2 + dir) * 256 + 4 * lane);
                const float* gz = z + (dir ? Z_GB : Z_GF);
#pragma unroll
                for (int r4 = 0; r4 < 4; ++r4) {
                    const vf4 gv = *(const vf4*)(gz + 4 * r4);
                    acc += gv.x * *(const vf4*)(up + (4 * r4 + 0) * 256) + gv.y * *(const vf4*)(up + (4 * r4 + 1) * 256) + gv.z * *(const vf4*)(up + (4 * r4 + 2) * 256) + gv.w * *(const vf4*)(up + (4 * r4 + 3) * 256);
                }
                vf4 o;
#pragma unroll
                for (int j = 0; j < 4; ++j) o[j] = logsigmoid_f(acc[j]) * (1.0f / 16.0f);
                *(vf4*)(WSP(float, dir ? WS_AB : WS_AF) + (size_t)m * 256 + 4 * lane) = o;
            }
        }
        {
#pragma unroll
            for (int part = 0; part < 3; ++part) {
                vf4 a0 = (vf4){0.f, 0.f, 0.f, 0.f}, a1 = a0;
#pragma unroll
                for (int j = 0; j < 5; ++j) {
                    const int tt = t + j - 2;
                    if (tt >= 0 && tt < T) {
                        const float* zz = Z + (size_t)(m + j - 2) * NINP + Z_DQKV + part * 512 + rg * 128 + c8;
                        const float* cj = cw + j * 1536 + part * 512;
                        a0 += *(const vf4*)cj * *(const vf4*)zz; a1 += *(const vf4*)(cj + 4) * *(const vf4*)(zz + 4);
                    }
                }
#pragma unroll
                for (int j = 0; j < 4; ++j) { a0[j] = silu_f(a0[j]); a1[j] = silu_f(a1[j]); }
                if (part < 2) { const float r = 1.0f / sqrtf(red16(ssq8(a0, a1)) + EPS) * (part == 0 ? 0.08838834764831845f : 1.0f); a0 *= r; a1 *= r; }
                float* dst = WSP(float, part == 0 ? WS_DQ : part == 1 ? WS_DK : WS_DV) + (size_t)m * 512 + rg * 128 + c8;
                *(vf4*)dst = a0; *(vf4*)(dst + 4) = a1;
            }
            if (lane < 8) {
                const float beta = 1.0f / (1.0f + expf(-z[Z_DB + lane]));
                const float g = -expf(p.in[I_ALOG][(size_t)l * 8 + lane]) * softplus_f(z[Z_DA + lane] + p.in[I_DTB][(size_t)l * 8 + lane]);
                float* ba = WSP(float, WS_DBA) + (size_t)m * 16;
                ba[lane] = beta; ba[8 + lane] = g;
            }
        }
    }
}

typedef float vf2 __attribute__((ext_vector_type(2)));
__device__ __forceinline__ float dpp_f(float v, const int ctrl) { return v; }
#define DPPF(v, ctrl) __int_as_float(__builtin_amdgcn_mov_dpp(__float_as_int(v), (ctrl), 0xF, 0xF, true))
__device__ __forceinline__ float red8(float v) { v += DPPF(v, 0xB1); v += DPPF(v, 0x4E); v += DPPF(v, 0x141); return v; }
__device__ __forceinline__ float red16(float v) { v = red8(v); v += DPPF(v, 0x140); return v; }

__device__ __forceinline__ void gla_chain(const Params& p, int l, bool ctx, int b, int h, int dir, int es, float* smem) {
    constexpr int TC = 32;
    const int tid = opaque_tid(), el = tid >> 3, dg = tid & 7;
    const int T = ctx ? CT : LT; const size_t m0 = ctx ? (size_t)b * CT : (size_t)MC + (size_t)b * LT;
    const float* Z = WSP(float, WS_Z); const float* A = WSP(float, dir ? WS_AB : WS_AF);
    float* O = WSP(float, dir ? WS_GOB : WS_GOF);
    float* sq = smem; float* sk = sq + TC * 64; float* sa = sk + TC * 64; float* sv = sa + TC * 64; float* so = sv + TC * 64;
    vf2 S[4];
    {
        const int e = es * 64 + el;
        if (ctx) {
#pragma unroll
            for (int i = 0; i < 4; ++i) S[i] = (vf2){0.f, 0.f};
        } else {
            const float* s0 = p.in[I_SGLA] + (((((size_t)b * DEPTH + l) * 2 + dir) * 4 + h) * 64 + dg * 8) * 128 + e;
#pragma unroll
            for (int i = 0; i < 4; ++i) S[i] = (vf2){s0[(size_t)(2 * i) * 128], s0[(size_t)(2 * i + 1) * 128]};
        }
    }
    vf4 pre[4];
    const int nch = T / TC;
    const int ls = tid >> 4, lc = (tid & 15) * 4;
#define GLA_LOAD(c) do { const int ti = (c) * TC + ls, tt = dir ? T - 1 - ti : ti; const size_t m = m0 + tt; \
        pre[0] = *(const vf4*)(Z + m * NINP + Z_GLQ + h * 64 + lc); pre[1] = *(const vf4*)(Z + m * NINP + Z_GLK + h * 64 + lc); \
        pre[2] = *(const vf4*)(A + m * 256 + h * 64 + lc);           pre[3] = *(const vf4*)(Z + m * NINP + Z_GLV + h * 128 + es * 64 + lc); } while (0)
#define GLA_WRITE() do { *(vf4*)(sq + ls * 64 + lc) = pre[0] * 0.125f; *(vf4*)(sk + ls * 64 + lc) = pre[1]; { vf4 e_; e_.x = expf(pre[2].x); e_.y = expf(pre[2].y); e_.z = expf(pre[2].z); e_.w = expf(pre[2].w); *(vf4*)(sa + ls * 64 + lc) = e_; } *(vf4*)(sv + ls * 64 + lc) = pre[3]; } while (0)
    __syncthreads();
    GLA_LOAD(0); GLA_WRITE(); __syncthreads();
    for (int c = 0; c < nch; ++c) {
        if (c + 1 < nch) GLA_LOAD(c + 1);
        vf4 q0 = *(const vf4*)(sq + dg * 8), q1 = *(const vf4*)(sq + dg * 8 + 4), k0 = *(const vf4*)(sk + dg * 8), k1 = *(const vf4*)(sk + dg * 8 + 4);
        vf4 a0 = *(const vf4*)(sa + dg * 8), a1 = *(const vf4*)(sa + dg * 8 + 4); float ve = sv[el];
#pragma unroll 2
        for (int s = 0; s < TC; ++s) {
            const int sn = (s + 1) & (TC - 1);
            const vf4 nq0 = *(const vf4*)(sq + sn * 64 + dg * 8), nq1 = *(const vf4*)(sq + sn * 64 + dg * 8 + 4), nk0 = *(const vf4*)(sk + sn * 64 + dg * 8), nk1 = *(const vf4*)(sk + sn * 64 + dg * 8 + 4);
            const vf4 na0 = *(const vf4*)(sa + sn * 64 + dg * 8), na1 = *(const vf4*)(sa + sn * 64 + dg * 8 + 4); const float nve = sv[sn * 64 + el];
            const vf2 v2 = (vf2){ve, ve};
            S[0] = a0.xy * S[0] + k0.xy * v2; S[1] = a0.zw * S[1] + k0.zw * v2; S[2] = a1.xy * S[2] + k1.xy * v2; S[3] = a1.zw * S[3] + k1.zw * v2;
            vf2 acc0 = q0.xy * S[0], acc1 = q0.zw * S[1]; acc0 += q1.xy * S[2]; acc1 += q1.zw * S[3];
            acc0 += acc1;
            const float po = red8(acc0.x + acc0.y);
            if (dg == 0) so[s * 64 + el] = po;
            q0 = nq0; q1 = nq1; k0 = nk0; k1 = nk1; a0 = na0; a1 = na1; ve = nve;
        }
        __syncthreads();
        { const int ti = c * TC + ls, tt = dir ? T - 1 - ti : ti; *(vf4*)(O + (m0 + tt) * 512 + h * 128 + es * 64 + lc) = *(const vf4*)(so + ls * 64 + lc); }
        if (c + 1 < nch) GLA_WRITE();
        __syncthreads();
    }
#undef GLA_LOAD
#undef GLA_WRITE
    if (ctx) {
        float* so_ = p.out + O_SGLA + (((((size_t)b * DEPTH + l) * 2 + dir) * 4 + h) * 64 + dg * 8) * 128 + es * 64 + el;
#pragma unroll
        for (int i = 0; i < 4; ++i) { so_[(size_t)(2 * i) * 128] = S[i].x; so_[(size_t)(2 * i + 1) * 128] = S[i].y; }
    }
}

__device__ __forceinline__ void gdn_chain(const Params& p, int l, bool ctx, int b, int h, int dir, int es, float* smem) {
    constexpr int TC = 32;
    const int tid = opaque_tid(), el = tid >> 3, dg = tid & 7;
    const int T = ctx ? CT : LT; const size_t m0 = ctx ? (size_t)b * CT : (size_t)MC + (size_t)b * LT;
    const float* DQ = WSP(float, WS_DQ); const float* DK = WSP(float, WS_DK); const float* DV = WSP(float, WS_DV); const float* DBA = WSP(float, WS_DBA);
    float* O = WSP(float, dir ? WS_DOB : WS_DOF);
    float* sq = smem; float* sk = sq + TC * 128; float* sv = sk + TC * 128; float* so = sv + TC * 64; float* sba = so + TC * 64; float* sqk = sba + TC * 2;
    vf2 S[8];
    {
        const int e = es * 64 + el;
        if (ctx) {
#pragma unroll
            for (int i = 0; i < 8; ++i) S[i] = (vf2){0.f, 0.f};
        } else {
            const float* s0 = p.in[I_SGDN] + (((((size_t)b * DEPTH + l) * 2 + dir) * 4 + h) * 128 + dg * 16) * 128 + e;
#pragma unroll
            for (int i = 0; i < 8; ++i) S[i] = (vf2){s0[(size_t)(2 * i) * 128], s0[(size_t)(2 * i + 1) * 128]};
        }
    }
    vf4 pre[5]; float pre_s = 0.f;
    const int nch = T / TC;
    const int ls = tid >> 5, lc = (tid & 31) * 4, vs = tid >> 4, vc = (tid & 15) * 4;
#define TOK(c, s_) (m0 + (dir ? T - 1 - ((c) * TC + (s_)) : (c) * TC + (s_)))
#define GDN_LOAD(c) do { const size_t ma = TOK(c, ls), mb = TOK(c, ls + 16), mv = TOK(c, vs); \
        pre[0] = *(const vf4*)(DQ + ma * 512 + h * 128 + lc); pre[1] = *(const vf4*)(DQ + mb * 512 + h * 128 + lc); \
        pre[2] = *(const vf4*)(DK + ma * 512 + h * 128 + lc); pre[3] = *(const vf4*)(DK + mb * 512 + h * 128 + lc); \
        pre[4] = *(const vf4*)(DV + mv * 512 + h * 128 + es * 64 + vc); \
        if (tid < 2 * TC) { pre_s = DBA[TOK(c, tid >> 1) * 16 + (tid & 1) * 8 + dir * 4 + h]; if (tid & 1) pre_s = expf(pre_s); } } while (0)
#define GDN_WRITE() do { *(vf4*)(sq + ls * 128 + lc) = pre[0]; *(vf4*)(sq + (ls + 16) * 128 + lc) = pre[1]; *(vf4*)(sk + ls * 128 + lc) = pre[2]; *(vf4*)(sk + (ls + 16) * 128 + lc) = pre[3]; \
        *(vf4*)(sv + vs * 64 + vc) = pre[4]; if (tid < 2 * TC) sba[tid] = pre_s; } while (0)
    __syncthreads();
    GDN_LOAD(0); GDN_WRITE(); __syncthreads();
    for (int c = 0; c < nch; ++c) {
        if (c + 1 < nch) GDN_LOAD(c + 1);
        {
            const int s = tid >> 4, part = tid & 15;
            const vf4 x0 = *(const vf4*)(sq + s * 128 + part * 8), x1 = *(const vf4*)(sq + s * 128 + part * 8 + 4), y0 = *(const vf4*)(sk + s * 128 + part * 8), y1 = *(const vf4*)(sk + s * 128 + part * 8 + 4);
            const vf4 pr = x0 * y0 + x1 * y1;
            const float d = red16((pr.x + pr.y) + (pr.z + pr.w));
            if (part == 0) sqk[s] = d;
        }
        __syncthreads();
        vf4 kk[4], qq[4]; float ve, be, a, qk;
#pragma unroll
        for (int i = 0; i < 4; ++i) { kk[i] = *(const vf4*)(sk + dg * 16 + 4 * i); qq[i] = *(const vf4*)(sq + dg * 16 + 4 * i); }
        ve = sv[el]; be = sba[0]; a = sba[1]; qk = sqk[0];
#pragma unroll 2
        for (int s = 0; s < TC; ++s) {
            const int sn = (s + 1) & (TC - 1);
            vf4 nk[4], nq[4];
#pragma unroll
            for (int i = 0; i < 4; ++i) { nk[i] = *(const vf4*)(sk + sn * 128 + dg * 16 + 4 * i); nq[i] = *(const vf4*)(sq + sn * 128 + dg * 16 + 4 * i); }
            const float nve = sv[sn * 64 + el], nbe = sba[2 * sn], na = sba[2 * sn + 1], nqk = sqk[sn];
            vf2 ak0 = kk[0].xy * S[0], ak1 = kk[0].zw * S[1], aq0 = qq[0].xy * S[0], aq1 = qq[0].zw * S[1];
#pragma unroll
            for (int i = 1; i < 4; ++i) { ak0 += kk[i].xy * S[2 * i]; ak1 += kk[i].zw * S[2 * i + 1]; aq0 += qq[i].xy * S[2 * i]; aq1 += qq[i].zw * S[2 * i + 1]; }
            ak0 += ak1; aq0 += aq1;
            const float uk = red8(ak0.x + ak0.y), uq = red8(aq0.x + aq0.y);
            const float vn = be * (ve - a * uk);
            const float po = a * uq + qk * vn;
            const vf2 a2 = (vf2){a, a}, vn2 = (vf2){vn, vn};
#pragma unroll
            for (int i = 0; i < 4; ++i) { S[2 * i] = a2 * S[2 * i] + kk[i].xy * vn2; S[2 * i + 1] = a2 * S[2 * i + 1] + kk[i].zw * vn2; }
            if (dg == 0) so[s * 64 + el] = po;
#pragma unroll
            for (int i = 0; i < 4; ++i) { kk[i] = nk[i]; qq[i] = nq[i]; }
            ve = nve; be = nbe; a = na; qk = nqk;
        }
        __syncthreads();
        *(vf4*)(O + TOK(c, vs) * 512 + h * 128 + es * 64 + vc) = *(const vf4*)(so + vs * 64 + vc);
        if (c + 1 < nch) GDN_WRITE();
        __syncthreads();
    }
#undef GDN_LOAD
#undef GDN_WRITE
#undef TOK
    if (ctx) {
        float* so_ = p.out + O_SGDN + (((((size_t)b * DEPTH + l) * 2 + dir) * 4 + h) * 128 + dg * 16) * 128 + es * 64 + el;
#pragma unroll
        for (int i = 0; i < 8; ++i) { so_[(size_t)(2 * i) * 128] = S[i].x; so_[(size_t)(2 * i + 1) * 128] = S[i].y; }
    }
}

__device__ __forceinline__ void phase_post(const Params& p, int l) {
    const int tid = opaque_tid(), lane = tid & 63, wv = tid >> 6;
    const float* Z = WSP(float, WS_Z); bf16_t* MRG = WSP(bf16_t, WS_MRG);
    const float* wg = p.in[I_GLAON] + (size_t)l * 128; const float* wd = p.in[I_GDNON] + (size_t)l * 128;
    for (int m = blockIdx.x * 8 + wv; m < M; m += gridDim.x * 8) {
        const float* z = Z + (size_t)m * NINP;
#pragma unroll
        for (int g = 0; g < 2; ++g) {
            const float* of = WSP(float, g ? WS_DOF : WS_GOF) + (size_t)m * 512; const float* ob = WSP(float, g ? WS_DOB : WS_GOB) + (size_t)m * 512;
            const float* w = g ? wd : wg; const int zg = g ? Z_DZ : Z_GLR, mc = g ? 1536 : 512;
#pragma unroll
            for (int h = 0; h < 4; ++h) {
                const float a = of[h * 128 + lane] + ob[h * 128 + lane], c = of[h * 128 + 64 + lane] + ob[h * 128 + 64 + lane];
                const float r = 1.0f / sqrtf(wave_sum(a * a + c * c) * (1.0f / 128) + EPS);
                bf16_t* o = MRG + (size_t)m * DM + mc + h * 128;
                o[lane] = f2bf(a * r * w[lane] * silu_f(z[zg + h * 128 + lane]));
                o[64 + lane] = f2bf(c * r * w[64 + lane] * silu_f(z[zg + h * 128 + 64 + lane]));
            }
        }
    }
}
#define XB_TMO      128
#define XB_XCNT(j)  (256  + 64 * (j))
#define XB_XSUB(j)  (1280 + 64 * (j))
#define XB_XGEN(j)  (2304 + 64 * (j))
#define XB_TOP      3328
#define XB_TOPGEN   3392
#define XCD_BAR_WORDS 3456
#define XB_SPIN_CAP (1u << 22)
#define LAS __attribute__((address_space(3)))

__device__ __forceinline__ unsigned xb_ld(unsigned* p)              { return __hip_atomic_load(p, __ATOMIC_RELAXED, __HIP_MEMORY_SCOPE_AGENT); }
__device__ __forceinline__ unsigned xb_add(unsigned* p, unsigned v) { return __hip_atomic_fetch_add(p, v, __ATOMIC_RELAXED, __HIP_MEMORY_SCOPE_AGENT); }
__device__ __forceinline__ unsigned xb_xcc_id() { return (unsigned)__builtin_amdgcn_s_getreg((3 << 11) | 20) & 0xFu; }
#define XB_SPIN(cond, bar) do { unsigned _sp = 0; while (cond) { __builtin_amdgcn_s_sleep(1); \
    if ((++_sp & 255u) == 0u) { if (xb_ld(&(bar)[XB_TMO])) break; if (_sp > XB_SPIN_CAP) { atomicAdd(&(bar)[XB_TMO], 1u); break; } } } } while (0)

struct XcdBarrier {
    unsigned* bar; unsigned x;
    volatile LAS unsigned* st;
};

__device__ __forceinline__ XcdBarrier xcd_barrier_post(unsigned* bar, volatile LAS unsigned* st) {
    XcdBarrier b; b.bar = bar; b.x = xb_xcc_id(); b.st = st;
    if (threadIdx.x == 0) (void)xb_add(&bar[XB_XCNT(b.x)], 1u);
    return b;
}
__device__ __forceinline__ void xcd_barrier_complete(unsigned* bar, unsigned x, unsigned& nloc, unsigned& nx) {
    const unsigned G = gridDim.x * gridDim.y * gridDim.z;
    unsigned sum, cnt, mine, sp = 0u;
    for (;;) {
        sum = 0u; cnt = 0u; mine = 0u;
#pragma unroll
        for (unsigned j = 0; j < 16; ++j) { const unsigned c = xb_ld(&bar[XB_XCNT(j)]); sum += c; cnt += (c > 0u) ? 1u : 0u; mine = (j == x) ? c : mine; }
        if (sum == G) break;
        __builtin_amdgcn_s_sleep(1);
        if ((++sp & 255u) == 0u) { if (xb_ld(&bar[XB_TMO])) break; if (sp > XB_SPIN_CAP) { atomicAdd(&bar[XB_TMO], 1u); break; } }
    }
    nloc = mine > 0u ? mine : 1u; nx = cnt > 0u ? cnt : 1u;
}

__device__ __forceinline__ void xcd_barrier(const XcdBarrier& b) {
    asm volatile("s_waitcnt vmcnt(0)" ::: "memory");
    __syncthreads();
    if (threadIdx.x == 0) {
        unsigned* bar = b.bar;
        __builtin_amdgcn_s_waitcnt(0);
        unsigned nloc = b.st[0], nx = b.st[1];
        if (nloc == 0u) { xcd_barrier_complete(bar, b.x, nloc, nx); b.st[0] = nloc; b.st[1] = nx; }
        const unsigned old = xb_add(&bar[XB_XSUB(b.x)], 1u);
        const unsigned gen = old / nloc;
        if (old + 1u == (gen + 1u) * nloc) {
            __builtin_amdgcn_fence(__ATOMIC_RELEASE, "agent");
            asm volatile("s_waitcnt vmcnt(0)" ::: "memory");
            const unsigned og = xb_add(&bar[XB_TOP], 1u);
            const unsigned tg = og / nx;
            if (og + 1u == (tg + 1u) * nx) xb_add(&bar[XB_TOPGEN], 1u);
            else XB_SPIN(xb_ld(&bar[XB_TOPGEN]) == tg, bar);
            __builtin_amdgcn_fence(__ATOMIC_ACQUIRE, "agent");
            xb_add(&bar[XB_XGEN(b.x)], 1u);
            asm volatile("s_waitcnt vmcnt(0)" ::: "memory");
        } else {
            XB_SPIN(xb_ld(&bar[XB_XGEN(b.x)]) == gen, bar);
            __builtin_amdgcn_fence(__ATOMIC_ACQUIRE, "agent");
            asm volatile("s_waitcnt vmcnt(0)" ::: "memory");
        }
    }
    __syncthreads();
}

namespace pg8 {
#define PG8_LAS __attribute__((address_space(3)))
typedef unsigned short bf16_t;
typedef short bf16x8 __attribute__((ext_vector_type(8)));
typedef float f32x4 __attribute__((ext_vector_type(4)));
typedef unsigned u32x4 __attribute__((ext_vector_type(4)));
constexpr int BM = 256, BK = 64, HALF = 128, HTB = HALF * BK * 2  , STAGE_BYTES = 8 * HTB, NXCD = 8, WGM = 8;

__host__ __device__ __forceinline__ int lds_byte(int r, int c) { const int st = (r >> 4) * 2 + (c >> 5), rr = r & 15, cc = c & 31, ob = rr * 64 + cc * 2; return st * 1024 + (ob ^ (((ob >> 9) & 1) << 5)); }
__host__ __device__ __forceinline__ void stage_rc(int b, int& R, int& C) { const int st = b / 1024, sb = b % 1024, swz = sb ^ (((sb >> 9) & 1) << 5); R = (st >> 1) * 16 + swz / 64; C = (st & 1) * 32 + (swz % 64) / 2; }
__host__ __device__ __forceinline__ int perm32(int rho) { const int n = rho >> 4, i = rho & 15; return 8 * (i >> 2) + 4 * n + (i & 3); }

struct Unit { int pm, pn, k0, nt, at; };
struct Gemm { const bf16_t* A; const bf16_t* Bt; int M, N, K; };

struct StaticOrder {
    int nM, nN, nwg, G, c, ntk, split;
    __host__ __device__ void init(int M, int N, int K, int G_, int c_, int split_ = 0) { nM = M / BM; nN = N / BM; nwg = nM * nN; G = G_; c = c_; ntk = K / BK; const int rem = nwg % G_; split = (split_ && rem > 0 && 2 * rem == G_ && (ntk % 4) != 1 && ntk >= 8) ? 1 : 0; }
    __host__ __device__ bool next(int i, Unit& u) const {
        long L = (long)i * G + c; u.k0 = 0; u.nt = ntk; u.at = 0;
        if (split && i == nwg / G) { const int rem = nwg % G, sl = c / rem, h0 = ((ntk / 2) + 1) & ~1; L = (long)i * G + (c % rem); u.k0 = sl ? h0 * BK : 0; u.nt = sl ? ntk - h0 : h0; u.at = 1; }
        if (L >= nwg) return false;
        int wgid = (int)L; { const int q = nwg / NXCD, r = nwg % NXCD, xcd = wgid % NXCD, off = wgid / NXCD; wgid = (xcd < r ? xcd * (q + 1) : r * (q + 1) + (xcd - r) * q) + off; }
        const int nig = WGM * nN, gid = wgid / nig, fm = gid * WGM, gsz = (nM - fm) < WGM ? (nM - fm) : WGM;
        u.pm = fm + ((wgid % nig) % gsz); u.pn = (wgid % nig) / gsz; return true;
    }
    __device__ __forceinline__ void a_ready(const Unit&) const {}
    __device__ __forceinline__ void done(const Unit&) const {}
};
__device__ __forceinline__ unsigned cvt_pk_bf16(float lo, float hi) { unsigned r; asm volatile("v_cvt_pk_bf16_f32 %0, %1, %2" : "=v"(r) : "v"(lo), "v"(hi)); return r; }
struct EpiF32 {
    static constexpr bool PERM = false, AFTER_DRAIN = false;
    float* C; int ldc; const float* bias;
    __device__ __forceinline__ void operator()(const f32x4 (&acc)[2][2][4][2], const Unit& u, int wr, int wc, int fr, int fq) const {
        const int row0 = u.pm * BM + wr * 64 + fr, col0 = u.pn * BM + wc * 32 + 4 * fq;
        f32x4 bv[2][2];
#pragma unroll
        for (int bj = 0; bj < 2; ++bj)
#pragma unroll
            for (int n = 0; n < 2; ++n) bv[bj][n] = bias ? *(const f32x4*)(bias + col0 + bj * HALF + n * 16) : (f32x4){0.f, 0.f, 0.f, 0.f};
#pragma unroll
        for (int ai = 0; ai < 2; ++ai)
#pragma unroll
            for (int m = 0; m < 4; ++m) { float* rowp = C + (size_t)(row0 + ai * HALF + m * 16) * ldc + col0;
#pragma unroll
                for (int bj = 0; bj < 2; ++bj)
#pragma unroll
                    for (int n = 0; n < 2; ++n) *(f32x4*)(rowp + bj * HALF + n * 16) = acc[ai][bj][m][n] + bv[bj][n]; }
    }
};

struct EpiSwiGLU {
    static constexpr bool PERM = true, AFTER_DRAIN = false;
    bf16_t* O; int ldc;
    __device__ __forceinline__ void operator()(const f32x4 (&acc)[2][2][4][2], const Unit& u, int wr, int wc, int fr, int fq) const {
        const int row0 = u.pm * BM + wr * 64 + fr, col0 = u.pn * 128 + wc * 32 + 8 * fq;
#pragma unroll
        for (int ai = 0; ai < 2; ++ai)
#pragma unroll
            for (int m = 0; m < 4; ++m) { bf16_t* rowp = O + (size_t)(row0 + ai * HALF + m * 16) * ldc + col0;
                const f32x4 g0 = acc[ai][0][m][0], g1 = acc[ai][0][m][1], u0 = acc[ai][1][m][0], u1 = acc[ai][1][m][1];
                float r[8];
#pragma unroll
                for (int j = 0; j < 4; ++j) {
                    r[j]     = g0[j] * __builtin_amdgcn_rcpf(1.0f + __builtin_amdgcn_exp2f(-1.4426950408889634f * g0[j])) * u0[j];
                    r[4 + j] = g1[j] * __builtin_amdgcn_rcpf(1.0f + __builtin_amdgcn_exp2f(-1.4426950408889634f * g1[j])) * u1[j]; }
                u32x4 w; w.x = cvt_pk_bf16(r[0], r[1]); w.y = cvt_pk_bf16(r[2], r[3]); w.z = cvt_pk_bf16(r[4], r[5]); w.w = cvt_pk_bf16(r[6], r[7]);
                *(u32x4*)rowp = w; }
    }
};
struct EpiResid {
    static constexpr bool PERM = false, AFTER_DRAIN = false;
    const float* res; float* out; int ldc; const float* gate0; float coef;
    __device__ __forceinline__ void operator()(const f32x4 (&acc)[2][2][4][2], const Unit& u, int wr, int wc, int fr, int fq) const {
        const int row0 = u.pm * BM + wr * 64 + fr, col0 = u.pn * BM + wc * 32 + 4 * fq;
        const float* gate = gate0 + (size_t)cond_of_row(u.pm * BM) * NMOD;
        f32x4 gv[2][2];
#pragma unroll
        for (int bj = 0; bj < 2; ++bj)
#pragma unroll
            for (int n = 0; n < 2; ++n) gv[bj][n] = *(const f32x4*)(gate + col0 + bj * HALF + n * 16) * coef;
#pragma unroll
        for (int ai = 0; ai < 2; ++ai)
#pragma unroll
            for (int m = 0; m < 4; ++m) { const size_t off = (size_t)(row0 + ai * HALF + m * 16) * ldc + col0;
#pragma unroll
                for (int bj = 0; bj < 2; ++bj)
#pragma unroll
                    for (int n = 0; n < 2; ++n) {
                        if (u.at) { const f32x4 v = gv[bj][n] * acc[ai][bj][m][n]; float* o = out + off + bj * HALF + n * 16;
                            unsafeAtomicAdd(o + 0, v[0]); unsafeAtomicAdd(o + 1, v[1]); unsafeAtomicAdd(o + 2, v[2]); unsafeAtomicAdd(o + 3, v[3]); }
                        else { const f32x4 bs = *(const f32x4*)(res + off + bj * HALF + n * 16); *(f32x4*)(out + off + bj * HALF + n * 16) = bs + gv[bj][n] * acc[ai][bj][m][n]; } }
                asm volatile("" ::: "memory"); }
    }
};
template <class Epi, class Sched, bool STAMP = false>
__device__ __forceinline__ void gemm_phase(PG8_LAS unsigned char* lds, const Gemm g, const Sched& S, const Epi& E, unsigned long long* stamps) {
    const int tid = opaque_tid(), wid = __builtin_amdgcn_readfirstlane(tid >> 6), lane = tid & 63, wr = wid >> 2, wc = wid & 3, fr = lane & 15, fq = lane >> 4;
    const int K = g.K;
    int ts_lo = 0, ts_hi = 0, nts = 0; const unsigned long long rt_entry = STAMP ? (unsigned long long)wall_clock64() : 0ull;
#define PG8_STAMP() do { if (STAMP && wid == 0 && nts < 64) { const unsigned long long _c = (unsigned long long)clock64(); \
        ts_lo = (lane == nts) ? (int)(unsigned)_c : ts_lo; ts_hi = (lane == nts) ? (int)(unsigned)(_c >> 32) : ts_hi; ++nts; } } while (0)
    PG8_STAMP();
    unsigned voffA[2], voffB[2];
#pragma unroll
    for (int i = 0; i < 2; ++i) { int R, C; stage_rc(tid * 16 + i * 8192, R, C); const int Rb = Epi::PERM ? ((R & ~31) + perm32(R & 31)) : R;
        voffA[i] = (unsigned)(R * K + C) * 2u; voffB[i] = (unsigned)(Rb * K + C) * 2u; }
    const size_t kstep = (size_t)(BK * 2);
    const size_t hstep = (size_t)HALF * K * 2;
    const size_t tstep = 2 * hstep;
    const unsigned ldsw = (unsigned)wid * 1024u;
    const int aoff = lds_byte(wr * 64 + fr, fq * 8), boff = lds_byte(wc * 32 + fr, fq * 8);
#define PG8_SA(b, h) (((b) * 2 + (h)) * HTB)
#define PG8_SB(b, h) ((4 + (b) * 2 + (h)) * HTB)
#define PG8_STAGE(bufoff, gbase, voff) do { _Pragma("unroll") for (int _i = 0; _i < 2; ++_i) \
        __builtin_amdgcn_global_load_lds((const unsigned*)((const char*)(gbase) + (voff)[_i]), (PG8_LAS unsigned*)(lds + (bufoff) + ldsw + _i * 8192), 16, 0, 0); } while (0)
#define PG8_LDA(dst, b, h) do { _Pragma("unroll") for (int m = 0; m < 4; ++m) _Pragma("unroll") for (int k = 0; k < 2; ++k) dst[m][k] = *(const PG8_LAS bf16x8*)(lds + PG8_SA(b, h) + aoff + m * 2048 + k * 1024); } while (0)
#define PG8_LDB(dst, b, h) do { _Pragma("unroll") for (int n = 0; n < 2; ++n) _Pragma("unroll") for (int k = 0; k < 2; ++k) dst[n][k] = *(const PG8_LAS bf16x8*)(lds + PG8_SB(b, h) + boff + n * 2048 + k * 1024); } while (0)
#define PG8_MMA(ai, bj, At, Bt) do { __builtin_amdgcn_s_setprio(1); _Pragma("unroll") for (int m = 0; m < 4; ++m) _Pragma("unroll") for (int n = 0; n < 2; ++n) _Pragma("unroll") for (int k = 0; k < 2; ++k) \
        acc[ai][bj][m][n] = __builtin_amdgcn_mfma_f32_16x16x32_bf16(Bt[n][k], At[m][k], acc[ai][bj][m][n], 0, 0, 0); __builtin_amdgcn_s_setprio(0); } while (0)
#define PG8_WAIT_V(n) asm volatile("s_waitcnt vmcnt(" #n ")" ::: "memory")
#define PG8_WAIT_L(n) asm volatile("s_waitcnt lgkmcnt(" #n ")" ::: "memory")
#define PG8_BAR __builtin_amdgcn_s_barrier()
#define PG8_SCHED __builtin_amdgcn_sched_barrier(0)
    Unit cur, nxt; int ui = 0;
    if (!S.next(0, cur)) return;
    f32x4 acc[2][2][4][2];
#pragma unroll
    for (int a = 0; a < 2; ++a)
#pragma unroll
        for (int b = 0; b < 2; ++b)
#pragma unroll
            for (int m = 0; m < 4; ++m)
#pragma unroll
                for (int n = 0; n < 2; ++n) acc[a][b][m][n] = (f32x4){0.f, 0.f, 0.f, 0.f};
    bf16x8 At[4][2], B0[2][2], B1[2][2];
    const char* cA = (const char*)g.A + (size_t)cur.pm * tstep + (size_t)cur.k0 * 2; const char* cB = (const char*)g.Bt + (size_t)cur.pn * tstep + (size_t)cur.k0 * 2;
    S.a_ready(cur);
    PG8_STAGE(PG8_SB(0, 0), cB, voffB); PG8_STAGE(PG8_SA(0, 0), cA, voffA); PG8_STAGE(PG8_SB(0, 1), cB + hstep, voffB); PG8_STAGE(PG8_SA(0, 1), cA + hstep, voffA);
    if (wr == 1) PG8_BAR;
    PG8_WAIT_V(4); PG8_BAR;
    PG8_STAGE(PG8_SB(1, 0), cB + kstep, voffB); PG8_STAGE(PG8_SA(1, 0), cA + kstep, voffA); PG8_STAGE(PG8_SB(1, 1), cB + hstep + kstep, voffB);
    PG8_WAIT_V(6); PG8_BAR;
    PG8_STAMP();
    for (;;) {
        const bool has_next = S.next(ui + 1, nxt);
        const char* nA = has_next ? (const char*)g.A + (size_t)nxt.pm * tstep + (size_t)nxt.k0 * 2 : cA; const char* nB = has_next ? (const char*)g.Bt + (size_t)nxt.pn * tstep + (size_t)nxt.k0 * 2 : cB;
        const int nt = cur.nt;
        for (int t = 0; t < nt; t += 2) {
            const bool last = (t == nt - 2);
            const char* a1 = cA + (size_t)(t + 1) * kstep;
            const char* a2 = last ? nA : cA + (size_t)(t + 2) * kstep; const char* b2 = last ? nB : cB + (size_t)(t + 2) * kstep;
            const char* a3 = a2 + kstep; const char* b3 = b2 + kstep;
            if (last && has_next) S.a_ready(nxt);
            PG8_LDB(B0, 0, 0); PG8_SCHED; PG8_LDA(At, 0, 0); PG8_STAGE(PG8_SA(1, 1), a1 + hstep, voffA);
            PG8_WAIT_L(8); PG8_BAR; PG8_WAIT_L(0); PG8_MMA(0, 0, At, B0); PG8_BAR; PG8_SCHED;
            PG8_LDB(B1, 0, 1); PG8_STAGE(PG8_SB(0, 0), b2, voffB);
            PG8_BAR; PG8_WAIT_L(0); PG8_MMA(0, 1, At, B1); PG8_BAR;
            PG8_LDA(At, 0, 1); PG8_STAGE(PG8_SA(0, 0), a2, voffA);
            PG8_BAR; PG8_WAIT_L(0); PG8_MMA(1, 0, At, B0); PG8_BAR; PG8_SCHED;
            PG8_STAGE(PG8_SB(0, 1), b2 + hstep, voffB);
            PG8_WAIT_V(6); PG8_BAR; PG8_MMA(1, 1, At, B1); PG8_BAR;
            PG8_LDB(B0, 1, 0); PG8_SCHED; PG8_LDA(At, 1, 0); PG8_STAGE(PG8_SA(0, 1), a2 + hstep, voffA);
            PG8_WAIT_L(8); PG8_BAR; PG8_WAIT_L(0); PG8_MMA(0, 0, At, B0); PG8_BAR; PG8_SCHED;
            PG8_LDB(B1, 1, 1); PG8_STAGE(PG8_SB(1, 0), b3, voffB);
            PG8_BAR; PG8_WAIT_L(0); PG8_MMA(0, 1, At, B1); PG8_BAR;
            PG8_LDA(At, 1, 1); PG8_STAGE(PG8_SA(1, 0), a3, voffA);
            PG8_BAR; PG8_WAIT_L(0); PG8_MMA(1, 0, At, B0); PG8_BAR; PG8_SCHED;
            PG8_STAGE(PG8_SB(1, 1), b3 + hstep, voffB);
            PG8_WAIT_V(6); PG8_BAR; PG8_MMA(1, 1, At, B1); PG8_BAR;
        }
        PG8_STAMP();
        if constexpr (!Epi::AFTER_DRAIN) { E(acc, cur, wr, wc, fr, fq); S.done(cur); }
        PG8_STAMP();
        if (!has_next) break;
#pragma unroll
        for (int a = 0; a < 2; ++a)
#pragma unroll
            for (int b = 0; b < 2; ++b)
#pragma unroll
                for (int m = 0; m < 4; ++m)
#pragma unroll
                    for (int n = 0; n < 2; ++n) acc[a][b][m][n] = (f32x4){0.f, 0.f, 0.f, 0.f};
        cur = nxt; cA = nA; cB = nB; ++ui;
    }
    PG8_WAIT_V(0);
    if (wr == 0) PG8_BAR;
    PG8_BAR;
    if constexpr (Epi::AFTER_DRAIN) { E.fused(acc, cur, wr, wc, fr, fq, lds, wid, lane); S.done(cur); }
    PG8_STAMP();
    if (STAMP && wid == 0) { stamps[lane] = lane < nts ? (((unsigned long long)(unsigned)ts_hi << 32) | (unsigned)ts_lo) : 0ull;
        if (lane == 62) stamps[62] = rt_entry; if (lane == 63) stamps[63] = (unsigned long long)wall_clock64(); }
#undef PG8_STAMP
#undef PG8_SA
#undef PG8_SB
#undef PG8_STAGE
#undef PG8_LDA
#undef PG8_LDB
#undef PG8_MMA
#undef PG8_WAIT_V
#undef PG8_WAIT_L
#undef PG8_BAR
#undef PG8_SCHED
}
}
#ifndef ATT_INLINE
#define ATT_INLINE __forceinline__
#endif
namespace att {
constexpr int D = 128, NW = 8, QBLK = 32, KVBLK = 64, LDQ = 512, LDO = DM;
constexpr float SCALE = 0.088388347648318440f;
constexpr float THR = 8.f;
constexpr size_t SHM_V = KVBLK * D * 2, SHM_K = KVBLK * D * 2, SHM_Q = 256 * D * 2, SHM_ATTN = 2 * SHM_V + 2 * SHM_K + NW * 64 * 4 + SHM_Q;
using bf16x8 = __attribute__((ext_vector_type(8))) short;
using s16x4  = __attribute__((ext_vector_type(4))) short;
using f32x16 = __attribute__((ext_vector_type(16))) float;
using u32x4  = __attribute__((ext_vector_type(4))) unsigned;
#define KSWZ(row, colB) ((row) * 256 + ((colB) ^ (((row) & 7) << 4)))
#define SBAR() __builtin_amdgcn_sched_barrier(0)
__device__ __forceinline__ int crow(int r, int hi) { return (r & 3) + 8 * (r >> 2) + 4 * hi; }
__device__ __forceinline__ unsigned cvtpk(float lo, float hi) { unsigned r; asm volatile("v_cvt_pk_bf16_f32 %0, %1, %2" : "=v"(r) : "v"(lo), "v"(hi)); return r; }

__device__ __forceinline__ void partialSM(f32x16& p0, f32x16& p1, float& m_reg, float& mn, float& alpha) {
  constexpr float C = SCALE * 1.4426950408889634f;
  float pmax = p0[0]; for (int r = 1; r < 16; ++r) pmax = fmaxf(pmax, p0[r]); for (int r = 0; r < 16; ++r) pmax = fmaxf(pmax, p1[r]);
  { auto rr = __builtin_amdgcn_permlane32_swap(__float_as_uint(pmax), __float_as_uint(pmax), false, false);
    pmax = fmaxf(__uint_as_float(rr[0]), __uint_as_float(rr[1])); }
  if (__builtin_expect(__all(pmax - m_reg <= THR / SCALE), 1)) { mn = m_reg; alpha = 1.f; }
  else { mn = fmaxf(m_reg, pmax); alpha = __builtin_amdgcn_exp2f((m_reg - mn) * C); m_reg = mn; }
  float mnC = -mn * C;
  for (int r = 0; r < 16; ++r) p0[r] = fmaf(p0[r], C, mnC); for (int r = 0; r < 16; ++r) p1[r] = fmaf(p1[r], C, mnC);
  for (int r = 0; r < 16; ++r) p0[r] = __builtin_amdgcn_exp2f(p0[r]);
}
__device__ __forceinline__ void finishSM(f32x16& p0, f32x16& p1, float alpha, float& l_reg, bf16x8& pa0, bf16x8& pa1, bf16x8& pa2, bf16x8& pa3) {
  for (int r = 0; r < 16; ++r) p1[r] = __builtin_amdgcn_exp2f(p1[r]);
  float ps = 0; for (int r = 0; r < 16; ++r) ps += p0[r]; for (int r = 0; r < 16; ++r) ps += p1[r];
  { auto rr = __builtin_amdgcn_permlane32_swap(__float_as_uint(ps), __float_as_uint(ps), false, false);
    ps = __uint_as_float(rr[0]) + __uint_as_float(rr[1]); }
  l_reg = l_reg * alpha + ps;
#define PK4(P, BASE, OUT) do { unsigned a0 = cvtpk(P[BASE + 0], P[BASE + 1]), a1 = cvtpk(P[BASE + 2], P[BASE + 3]);   \
    unsigned b0 = cvtpk(P[BASE + 4], P[BASE + 5]), b1 = cvtpk(P[BASE + 6], P[BASE + 7]);                              \
    auto r0 = __builtin_amdgcn_permlane32_swap(a0, b0, false, false); auto r1 = __builtin_amdgcn_permlane32_swap(a1, b1, false, false); \
    u32x4 w = {r0[0], r1[0], r0[1], r1[1]}; OUT = *reinterpret_cast<bf16x8*>(&w); } while (0)
  PK4(p0, 0, pa0); PK4(p0, 8, pa1); PK4(p1, 0, pa2); PK4(p1, 8, pa3);
#undef PK4
}
__device__ __forceinline__ void qkt(f32x16& p0, f32x16& p1, const bf16_t* Ks, const bf16_t* Qs, int qrow, int r32, int hi) {
  p0 = f32x16{}; p1 = f32x16{};
#pragma unroll
  for (int d0 = 0; d0 < 8; ++d0) { int cb = (d0 * 16 + hi * 8) * 2;
    bf16x8 q = *reinterpret_cast<const bf16x8*>((const char*)Qs + KSWZ(qrow, cb));
    bf16x8 b0 = *reinterpret_cast<const bf16x8*>((const char*)Ks + KSWZ(r32, cb));
    bf16x8 b1 = *reinterpret_cast<const bf16x8*>((const char*)Ks + KSWZ(32 + r32, cb));
    p0 = __builtin_amdgcn_mfma_f32_32x32x16_bf16(b0, q, p0, 0, 0, 0);
    p1 = __builtin_amdgcn_mfma_f32_32x32x16_bf16(b1, q, p1, 0, 0, 0); }
}
__device__ __forceinline__ int v_st(int k, int c) { const int kk = (k & ~0xC) | ((k & 4) << 1) | ((k & 8) >> 1); return ((kk >> 3) * 4 + (c >> 5)) * 512 + ((kk & 7) * 32 + (c & 31)) * 2; }
__device__ __forceinline__ int v_rd_base(int lane) { return ((lane & 3) << 3) | (((lane >> 2) & 3) << 6) | (((lane >> 4) & 1) << 5) | (((lane >> 5) & 1) << 8); }
constexpr int v_rd_off(int d0, int ks, int half) { return d0 * 512 + ks * 4096 + half * 2048; }
template <int OFF> __device__ __forceinline__ s16x4 tr_read(int vb) {
  s16x4 r; asm volatile("ds_read_b64_tr_b16 %0, %1 offset:%2" : "=&v"(r) : "v"(vb), "i"(OFF) : "memory"); return r;
}
template <int D0> __device__ __forceinline__ void pv_one(f32x16& od, int vb, bf16x8 pa0, bf16x8 pa1, bf16x8 pa2, bf16x8 pa3) {
  const s16x4 l0 = tr_read<v_rd_off(D0, 0, 0)>(vb), h0 = tr_read<v_rd_off(D0, 0, 1)>(vb), l1 = tr_read<v_rd_off(D0, 1, 0)>(vb), h1 = tr_read<v_rd_off(D0, 1, 1)>(vb);
  const s16x4 l2 = tr_read<v_rd_off(D0, 2, 0)>(vb), h2 = tr_read<v_rd_off(D0, 2, 1)>(vb), l3 = tr_read<v_rd_off(D0, 3, 0)>(vb), h3 = tr_read<v_rd_off(D0, 3, 1)>(vb);
  asm volatile("s_waitcnt lgkmcnt(0)" ::: "memory"); SBAR();
#define PK(L, H) (bf16x8){L[0], L[1], L[2], L[3], H[0], H[1], H[2], H[3]}
  od = __builtin_amdgcn_mfma_f32_32x32x16_bf16(pa0, PK(l0, h0), od, 0, 0, 0);
  od = __builtin_amdgcn_mfma_f32_32x32x16_bf16(pa1, PK(l1, h1), od, 0, 0, 0);
  od = __builtin_amdgcn_mfma_f32_32x32x16_bf16(pa2, PK(l2, h2), od, 0, 0, 0);
  od = __builtin_amdgcn_mfma_f32_32x32x16_bf16(pa3, PK(l3, h3), od, 0, 0, 0);
#undef PK
}
__device__ __forceinline__ void pv_d0(f32x16* o, int vb, bf16x8 pa0, bf16x8 pa1, bf16x8 pa2, bf16x8 pa3) {
  pv_one<0>(o[0], vb, pa0, pa1, pa2, pa3); pv_one<1>(o[1], vb, pa0, pa1, pa2, pa3); pv_one<2>(o[2], vb, pa0, pa1, pa2, pa3); pv_one<3>(o[3], vb, pa0, pa1, pa2, pa3);
}

struct SrcOne { const bf16_t* k0; const bf16_t* v0; int ldk;
  __device__ __forceinline__ const bf16_t* k(int j) const { return k0 + (size_t)j * 64 * ldk; }
  __device__ __forceinline__ const bf16_t* v(int j) const { return v0 + (size_t)j * 64 * ldk; } };
struct SrcTwo { const bf16_t* ck; const bf16_t* cv; const bf16_t* k1; const bf16_t* v1; int ldk;
  __device__ __forceinline__ const bf16_t* k(int j) const { return j < 4 ? ck + (size_t)j * 64 * ldk : k1 + (size_t)(j - 4) * 64 * ldk; }
  __device__ __forceinline__ const bf16_t* v(int j) const { return j < 4 ? cv + (size_t)j * 64 * ldk : v1 + (size_t)(j - 4) * 64 * ldk; } };
struct NoBias { __device__ __forceinline__ void operator()(f32x16&, f32x16&, int, int, int, int) const {} };
struct NaBias { const float* tab; int i0, kr0;
  __device__ __forceinline__ void operator()(f32x16& p0, f32x16& p1, int jt, int wid, int r32, int hi) const {
    if (jt < 4) return;
    const int qi = i0 + wid * QBLK + r32, r = qi >> 6, qc = qi & 63, kr = kr0 + jt - 4;
    int lo = r - 4; lo = lo < 0 ? 0 : (lo > 8 ? 8 : lo);
    const bool rowok = (kr >= lo) && (kr < lo + 8);
    if (!rowok) {
#pragma unroll
      for (int rr = 0; rr < 16; ++rr) { p0[rr] = -1e30f; p1[rr] = -1e30f; }
      return;
    }
    int c0 = qc - 8; c0 = c0 < 0 ? 0 : (c0 > 48 ? 48 : c0);
    const int dr = kr - r + 7;
    const float* tb = tab + dr * 31 + (4 * hi - qc + 15);
    const int w0 = 4 * hi - c0;
#pragma unroll
    for (int g = 0; g < 4; ++g) {
#pragma unroll
      for (int q = 0; q < 4; ++q) {
        const int rr = 4 * g + q, kc0 = q + 8 * g;
        const float t0 = tb[kc0], t1 = tb[kc0 + 32];
        p0[rr] = ((unsigned)(kc0 + w0) < 16u) ? p0[rr] + t0 : -1e30f;
        p1[rr] = ((unsigned)(kc0 + 32 + w0) < 16u) ? p1[rr] + t1 : -1e30f;
      }
      SBAR();
    }
  } };

template <int SD, class Src, class Bias>
__device__ ATT_INLINE void attn_body(const bf16_t* __restrict__ Qb, const Src src, bf16_t* __restrict__ Ob, const int NT, char* lds, const Bias bias) {
  const int tid = opaque_tid(), wid = tid >> 6, lane = tid & 63, r32 = lane & 31, hi = lane >> 5;
  const int LDK = src.ldk;
  bf16_t* V_lds = (bf16_t*)lds; bf16_t* K_lds = (bf16_t*)(lds + 2 * SHM_V);
  float* ws = (float*)(lds + 2 * SHM_V + 2 * SHM_K) + wid * 64; float* li_l = ws; float* al_l = ws + 32;
  float m_reg = -1e30f, l_reg = 0; f32x16 o[4] = {};
  bf16_t* Q_lds = (bf16_t*)(lds + 2 * SHM_V + 2 * SHM_K + NW * 64 * 4);
  const int qrow = wid * QBLK + r32;
  {
#pragma unroll
    for (int i = 0; i < 8; ++i) { const int f = tid + 512 * i, row = f >> 4, c8 = (f & 15) * 8;
      *(bf16x8*)((char*)Q_lds + KSWZ(row, c8 * 2)) = *reinterpret_cast<const bf16x8*>(Qb + (long)row * LDQ + c8); }
  }
  const int sr = tid >> 4, sc = (tid & 15) * 8, vst0 = v_st(sr, sc), vst1 = v_st(32 + sr, sc);
  const int vb0 = (int)(uintptr_t)V_lds + v_rd_base(lane);
  struct { bf16x8 vs0, vs1, ks0, ks1; } sr_[SD];
#define SLOAD(i, jt) do { const bf16_t* kt_ = src.k(jt); const bf16_t* vt_ = src.v(jt); \
    sr_[i].vs0 = *reinterpret_cast<const bf16x8*>(&vt_[(long)sr * LDK + sc]); sr_[i].vs1 = *reinterpret_cast<const bf16x8*>(&vt_[(long)(32 + sr) * LDK + sc]); \
    sr_[i].ks0 = *reinterpret_cast<const bf16x8*>(&kt_[(long)sr * LDK + sc]); sr_[i].ks1 = *reinterpret_cast<const bf16x8*>(&kt_[(long)(32 + sr) * LDK + sc]); } while (0)
#define SWRITE(b, i) do { *(bf16x8*)((char*)V_lds + (b) * SHM_V + vst0) = sr_[i].vs0;          \
    *(bf16x8*)((char*)V_lds + (b) * SHM_V + vst1) = sr_[i].vs1; int kc = sc * 2;               \
    *(bf16x8*)((char*)K_lds + (b) * SHM_K + KSWZ(sr, kc)) = sr_[i].ks0;                       \
    *(bf16x8*)((char*)K_lds + (b) * SHM_K + KSWZ(32 + sr, kc)) = sr_[i].ks1; } while (0)
#define SWAIT() do { if constexpr (SD == 2) asm volatile("s_waitcnt vmcnt(4)" ::: "memory"); else asm volatile("s_waitcnt vmcnt(0)" ::: "memory"); } while (0)
#define RESC(a) do { if (__any((a) < 1.f)) { if (hi == 0) al_l[r32] = (a); asm volatile("s_waitcnt lgkmcnt(0)" ::: "memory"); \
    for (int d = 0; d < 4; ++d) for (int r = 0; r < 16; ++r) o[d][r] *= al_l[crow(r, hi)]; } } while (0)
  f32x16 pA0, pA1, pB0, pB1; float mnA, mnB, alA, alB; bf16x8 pa0, pa1, pa2, pa3;
  constexpr int SE = 0, SO = SD - 1;
  SLOAD(SE, 0); asm volatile("s_waitcnt vmcnt(0)" ::: "memory"); SWRITE(0, SE); __syncthreads();
  qkt(pA0, pA1, K_lds, Q_lds, qrow, r32, hi); bias(pA0, pA1, 0, wid, r32, hi); partialSM(pA0, pA1, m_reg, mnA, alA);
  SLOAD(SO, 1); if constexpr (SD == 2) { if (2 < NT) SLOAD(SE, 2); }
  SWAIT(); SWRITE(1, SO); __syncthreads();
  for (int j = 1; j + 1 < NT; j += 2) {
    SBAR(); qkt(pB0, pB1, (bf16_t*)((char*)K_lds + SHM_K), Q_lds, qrow, r32, hi); bias(pB0, pB1, j, wid, r32, hi);
    finishSM(pA0, pA1, alA, l_reg, pa0, pa1, pa2, pa3); SBAR();
    SLOAD(SO, j + SD); SBAR();
    pv_d0(o, vb0, pa0, pa1, pa2, pa3); partialSM(pB0, pB1, m_reg, mnB, alB);
    __syncthreads(); SWAIT(); SWRITE(0, SE);
    RESC(alB); __syncthreads();
    SBAR(); qkt(pA0, pA1, K_lds, Q_lds, qrow, r32, hi); bias(pA0, pA1, j + 1, wid, r32, hi);
    finishSM(pB0, pB1, alB, l_reg, pa0, pa1, pa2, pa3); SBAR();
    if (SD == 1 || j + 3 < NT) SLOAD(SE, j + 1 + SD); SBAR();
    pv_d0(o, vb0 + (int)SHM_V, pa0, pa1, pa2, pa3); partialSM(pA0, pA1, m_reg, mnA, alA);
    __syncthreads(); SWAIT(); SWRITE(1, SO);
    RESC(alA); __syncthreads();
  }
  SBAR(); qkt(pB0, pB1, (bf16_t*)((char*)K_lds + SHM_K), Q_lds, qrow, r32, hi); bias(pB0, pB1, NT - 1, wid, r32, hi);
  finishSM(pA0, pA1, alA, l_reg, pa0, pa1, pa2, pa3); SBAR();
  pv_d0(o, vb0, pa0, pa1, pa2, pa3); partialSM(pB0, pB1, m_reg, mnB, alB);
  __syncthreads(); RESC(alB);
  finishSM(pB0, pB1, alB, l_reg, pa0, pa1, pa2, pa3); SBAR();
  pv_d0(o, vb0 + (int)SHM_V, pa0, pa1, pa2, pa3);
  if (hi == 0) li_l[r32] = l_reg; asm volatile("s_waitcnt lgkmcnt(0)" ::: "memory");
  float rli[16];
#pragma unroll
  for (int r = 0; r < 16; ++r) rli[r] = __builtin_amdgcn_rcpf(li_l[crow(r, hi)]);
  bf16_t* Ow = Ob + (long)(wid * QBLK) * LDO;
#pragma unroll
  for (int r = 0; r < 16; ++r) { int orow = crow(r, hi);
    for (int d0 = 0; d0 < 4; ++d0) Ow[(long)orow * LDO + d0 * 32 + r32] = f2bf(o[d0][r] * rli[r]); }
#undef SLOAD
#undef SWRITE
#undef SWAIT
#undef RESC
}
}
namespace gdn {
using att::bf16x8; using att::f32x16; using att::crow;
constexpr int C = 32, SK = 136, SS = 40;
constexpr int OFF_KT = 0, OFF_QT = OFF_KT + C * SK * 2, OFF_W = OFF_QT + C * SK * 2, OFF_KTT = OFF_W + C * SK * 2, OFF_VTT = OFF_KTT + 128 * SS * 2,
              OFF_VN = OFF_VTT + 128 * SS * 2, OFF_VNS = OFF_VN + 128 * SS * 2, OFF_ST = OFF_VNS + 128 * SS * 2, OFF_TB = OFF_ST + 128 * SK * 2,
              OFF_TBE = OFF_TB + C * SS * 2, OFF_ATT = OFF_TBE + C * SS * 2, OFF_L = OFF_ATT + C * SS * 2, OFF_SC = OFF_L + C * C * 4, GDN_LDS = OFF_SC + 1024;
template <int K>
__device__ __forceinline__ f32x16 mm(const bf16_t* A, int lda, const bf16_t* Bt, int ldb, int l32, int hi, f32x16 acc) {
#pragma unroll
    for (int k0 = 0; k0 < K; k0 += 16) {
        const bf16x8 a = *reinterpret_cast<const bf16x8*>(A + l32 * lda + k0 + 8 * hi);
        const bf16x8 b = *reinterpret_cast<const bf16x8*>(Bt + l32 * ldb + k0 + 8 * hi);
        acc = __builtin_amdgcn_mfma_f32_32x32x16_bf16(a, b, acc, 0, 0, 0);
    }
    return acc;
}
__device__ __forceinline__ uint2 pk4(float a, float b, float c, float d) { uint2 w; w.x = pack2(a, b); w.y = pack2(c, d); return w; }

__device__ __forceinline__ void gdn_chunked(const Params& p, int l, bool ctx, int b, int h, int dir, unsigned char* lds) {
    const int tid = opaque_tid(), wid = tid >> 6, lane = tid & 63, l32 = lane & 31, hi = lane >> 5;
    const int T = ctx ? CT : ::LT; const size_t m0 = ctx ? (size_t)b * CT : (size_t)MC + (size_t)b * ::LT;
    const float* DQ = WSP(float, WS_DQ); const float* DK = WSP(float, WS_DK); const float* DV = WSP(float, WS_DV); const float* DBA = WSP(float, WS_DBA);
    float* O = WSP(float, dir ? WS_DOB : WS_DOF);
    bf16_t* Kt = (bf16_t*)(lds + OFF_KT); bf16_t* Qt = (bf16_t*)(lds + OFF_QT); bf16_t* W = (bf16_t*)(lds + OFF_W); bf16_t* KT = (bf16_t*)(lds + OFF_KTT); bf16_t* VT = (bf16_t*)(lds + OFF_VTT);
    bf16_t* VN = (bf16_t*)(lds + OFF_VN); bf16_t* VNS = (bf16_t*)(lds + OFF_VNS); bf16_t* ST = (bf16_t*)(lds + OFF_ST); bf16_t* TB = (bf16_t*)(lds + OFF_TB); bf16_t* TBE = (bf16_t*)(lds + OFF_TBE);
    bf16_t* ATT = (bf16_t*)(lds + OFF_ATT); float* Lm = (float*)(lds + OFF_L); float* sc = (float*)(lds + OFF_SC);
    const int nch = T / C;
#define TOK(c, s_) (m0 + (dir ? T - 1 - ((c) * C + (s_)) : (c) * C + (s_)))
    f32x16 S[2];
#pragma unroll
    for (int bi = 0; bi < 2; ++bi) {
        const int blk = wid * 2 + bi, d0 = 32 * (blk >> 2), e0 = 32 * (blk & 3);
        if (ctx) { S[bi] = f32x16{}; }
        else {
            const float* s0 = p.in[I_SGDN] + ((((size_t)b * DEPTH + l) * 2 + dir) * 4 + h) * 128 * 128 + e0 + l32;
#pragma unroll
            for (int r = 0; r < 16; ++r) S[bi][r] = s0[(size_t)(d0 + crow(r, hi)) * 128];
        }
    }
    const int ls = tid >> 5, lc = (tid & 31) * 4;
    vf4 pq0, pq1, pk0, pk1, pv0, pv1; float pbeta = 0.f, pg = 0.f;
#define GLOAD(c) do { const size_t ma = TOK(c, ls), mb = TOK(c, ls + 16); \
        pq0 = *(const vf4*)(DQ + ma * 512 + h * 128 + lc); pq1 = *(const vf4*)(DQ + mb * 512 + h * 128 + lc); \
        pk0 = *(const vf4*)(DK + ma * 512 + h * 128 + lc); pk1 = *(const vf4*)(DK + mb * 512 + h * 128 + lc); \
        pv0 = *(const vf4*)(DV + ma * 512 + h * 128 + lc); pv1 = *(const vf4*)(DV + mb * 512 + h * 128 + lc); \
        if (tid < C) { const size_t mt = TOK(c, tid); pbeta = DBA[mt * 16 + dir * 4 + h]; pg = DBA[mt * 16 + 8 + dir * 4 + h]; } } while (0)
#define GSTAGE() do { \
        *(uint2*)(Kt + ls * SK + lc) = pk4(pk0.x, pk0.y, pk0.z, pk0.w); *(uint2*)(Kt + (ls + 16) * SK + lc) = pk4(pk1.x, pk1.y, pk1.z, pk1.w); \
        *(uint2*)(Qt + ls * SK + lc) = pk4(pq0.x, pq0.y, pq0.z, pq0.w); *(uint2*)(Qt + (ls + 16) * SK + lc) = pk4(pq1.x, pq1.y, pq1.z, pq1.w); \
        _Pragma("unroll") for (int j = 0; j < 4; ++j) { KT[(lc + j) * SS + ls] = f2bf(pk0[j]); KT[(lc + j) * SS + ls + 16] = f2bf(pk1[j]); \
                                                        VT[(lc + j) * SS + ls] = f2bf(pv0[j]); VT[(lc + j) * SS + ls + 16] = f2bf(pv1[j]); } \
        if (wid == 0) { float x = pg; _Pragma("unroll") for (int o_ = 1; o_ < 32; o_ <<= 1) { const float y = __shfl_up(x, o_); if (lane >= o_) x += y; } \
            const float Bt_ = __shfl(x, 31); if (lane < C) { sc[lane] = pbeta; sc[32 + lane] = x; sc[64 + lane] = __expf(x); sc[96 + lane] = __expf(Bt_ - x); if (lane == 0) sc[128] = __expf(Bt_); } } } while (0)
    __syncthreads();
    GLOAD(0);
#pragma unroll
    for (int bi = 0; bi < 2; ++bi) {
        const int blk = wid * 2 + bi, d0 = 32 * (blk >> 2), e0 = 32 * (blk & 3);
#pragma unroll
        for (int g = 0; g < 4; ++g) *(uint2*)(ST + (e0 + l32) * SK + d0 + 8 * g + 4 * hi) = pk4(S[bi][4 * g], S[bi][4 * g + 1], S[bi][4 * g + 2], S[bi][4 * g + 3]);
    }
    GSTAGE();
    __syncthreads();
    for (int c = 0; c < nch; ++c) {
        if (c + 1 < nch) GLOAD(c + 1);
        f32x16 acc1 = f32x16{};
        if (wid == 0) {
            const f32x16 kk = mm<128>(Kt, SK, Kt, SK, l32, hi, f32x16{});
            const float bi_ = sc[32 + l32], be = sc[l32];
#pragma unroll
            for (int r = 0; r < 16; ++r) { const int j = crow(r, hi); const float v = (l32 > j) ? be * kk[r] * __expf(bi_ - sc[32 + j]) : 0.f;
                Lm[l32 * 32 + ((r & 3) + 4 * hi) * 4 + (r >> 2)] = v; }
        } else if (wid == 1) {
            const f32x16 kq = mm<128>(Kt, SK, Qt, SK, l32, hi, f32x16{});
            const float bi_ = sc[32 + l32];
            float a[16];
#pragma unroll
            for (int r = 0; r < 16; ++r) { const int j = crow(r, hi); a[r] = (l32 >= j) ? kq[r] * __expf(bi_ - sc[32 + j]) : 0.f; }
#pragma unroll
            for (int g = 0; g < 4; ++g) *(uint2*)(ATT + l32 * SS + 8 * g + 4 * hi) = pk4(a[4 * g], a[4 * g + 1], a[4 * g + 2], a[4 * g + 3]);
        } else if (wid >= 4) {
            acc1 = mm<128>(Qt, SK, ST + (32 * (wid - 4)) * SK, SK, l32, hi, f32x16{});
#pragma unroll
            for (int r = 0; r < 16; ++r) acc1[r] *= sc[64 + crow(r, hi)];
        }
        __syncthreads();
        if (tid < 256) {
            const int cc = tid >> 3, part = tid & 7;
            float Tr[4] = {0.f, 0.f, 0.f, 0.f};
            const float* Lp = Lm + part * 4;
#pragma unroll
            for (int i = 0; i < 32; ++i) {
                const vf4 lv = *(const vf4*)(Lp + i * 32);
                float s = lv.x * Tr[0] + lv.y * Tr[1] + lv.z * Tr[2] + lv.w * Tr[3];
                s = red8(s);
                const float t = (i == cc ? 1.f : 0.f) - s;
                if (part == (i & 7)) Tr[i >> 3] = t;
            }
            const float bc = sc[cc], bec = bc * sc[64 + cc];
#pragma unroll
            for (int jj = 0; jj < 4; ++jj) { TB[(part + 8 * jj) * SS + cc] = f2bf(Tr[jj] * bc); TBE[(part + 8 * jj) * SS + cc] = f2bf(Tr[jj] * bec); }
        }
        __syncthreads();
        if (wid < 4) {
            acc1 = mm<32>(TB, SS, VT + (32 * wid) * SS, SS, l32, hi, f32x16{});
        } else {
            const int d0 = 32 * (wid - 4);
            const f32x16 wt = mm<32>(KT + d0 * SS, SS, TBE, SS, l32, hi, f32x16{});
#pragma unroll
            for (int g = 0; g < 4; ++g) *(uint2*)(W + l32 * SK + d0 + 8 * g + 4 * hi) = pk4(wt[4 * g], wt[4 * g + 1], wt[4 * g + 2], wt[4 * g + 3]);
        }
        __syncthreads();
        if (wid < 4) {
            const int e0 = 32 * wid;
            const f32x16 ws = mm<128>(W, SK, ST + e0 * SK, SK, l32, hi, f32x16{});
            float vn[16], vs[16];
#pragma unroll
            for (int r = 0; r < 16; ++r) { vn[r] = acc1[r] - ws[r]; vs[r] = vn[r] * sc[96 + crow(r, hi)]; }
#pragma unroll
            for (int g = 0; g < 4; ++g) { *(uint2*)(VN + (e0 + l32) * SS + 8 * g + 4 * hi) = pk4(vn[4 * g], vn[4 * g + 1], vn[4 * g + 2], vn[4 * g + 3]);
                                          *(uint2*)(VNS + (e0 + l32) * SS + 8 * g + 4 * hi) = pk4(vs[4 * g], vs[4 * g + 1], vs[4 * g + 2], vs[4 * g + 3]); }
        }
        __syncthreads();
        if (wid >= 4) {
            const int e0 = 32 * (wid - 4);
            acc1 = mm<32>(ATT, SS, VN + e0 * SS, SS, l32, hi, acc1);
#pragma unroll
            for (int r = 0; r < 16; ++r) O[TOK(c, crow(r, hi)) * 512 + h * 128 + e0 + l32] = acc1[r];
        }
        {
            const float eB = sc[128];
#pragma unroll
            for (int bi = 0; bi < 2; ++bi) {
                const int blk = wid * 2 + bi, d0 = 32 * (blk >> 2), e0 = 32 * (blk & 3);
#pragma unroll
                for (int r = 0; r < 16; ++r) S[bi][r] *= eB;
                S[bi] = mm<32>(KT + d0 * SS, SS, VNS + e0 * SS, SS, l32, hi, S[bi]);
            }
        }
        __syncthreads();
#pragma unroll
        for (int bi = 0; bi < 2; ++bi) {
            const int blk = wid * 2 + bi, d0 = 32 * (blk >> 2), e0 = 32 * (blk & 3);
#pragma unroll
            for (int g = 0; g < 4; ++g) *(uint2*)(ST + (e0 + l32) * SK + d0 + 8 * g + 4 * hi) = pk4(S[bi][4 * g], S[bi][4 * g + 1], S[bi][4 * g + 2], S[bi][4 * g + 3]);
        }
        if (c + 1 < nch) GSTAGE();
        __syncthreads();
    }
#undef GLOAD
#undef GSTAGE
#undef TOK
    if (ctx) {
#pragma unroll
        for (int bi = 0; bi < 2; ++bi) {
            const int blk = wid * 2 + bi, d0 = 32 * (blk >> 2), e0 = 32 * (blk & 3);
            float* so = p.out + O_SGDN + ((((size_t)b * DEPTH + l) * 2 + dir) * 4 + h) * 128 * 128 + e0 + l32;
#pragma unroll
            for (int r = 0; r < 16; ++r) so[(size_t)(d0 + crow(r, hi)) * 128] = S[bi][r];
        }
    }
}
}

namespace gla {
using att::bf16x8; using att::f32x16; using att::crow; using gdn::mm; using gdn::pk4;
constexpr int C = 32, SQ = 72, SS = 40;
constexpr int OFF_QE = 0, OFF_KN = OFF_QE + C * SQ * 2, OFF_KET = OFF_KN + C * SQ * 2, OFF_VT = OFF_KET + 64 * SS * 2, OFF_ATT = OFF_VT + 128 * SS * 2, OFF_ST = OFF_ATT + C * SS * 2,
              OFF_LA = OFF_ST + 128 * SQ * 2, OFF_EB = OFF_LA + C * 64 * 4, GLA_LDS = OFF_EB + 256;
__device__ __forceinline__ void gla_chunked(const Params& p, int l, bool ctx, int b, int h, int dir, unsigned char* lds) {
    const int tid = opaque_tid(), wid = tid >> 6, lane = tid & 63, l32 = lane & 31, hi = lane >> 5;
    const int T = ctx ? CT : ::LT; const size_t m0 = ctx ? (size_t)b * CT : (size_t)MC + (size_t)b * ::LT;
    const float* Z = WSP(float, WS_Z); const float* LA = WSP(float, dir ? WS_AB : WS_AF);
    float* O = WSP(float, dir ? WS_GOB : WS_GOF);
    bf16_t* Qe = (bf16_t*)(lds + OFF_QE); bf16_t* Kn = (bf16_t*)(lds + OFF_KN); bf16_t* KeT = (bf16_t*)(lds + OFF_KET); bf16_t* VT = (bf16_t*)(lds + OFF_VT);
    bf16_t* ATT = (bf16_t*)(lds + OFF_ATT); bf16_t* ST = (bf16_t*)(lds + OFF_ST); float* la = (float*)(lds + OFF_LA); float* eB = (float*)(lds + OFF_EB);
    const int nch = T / C;
#define TOK(c, s_) (m0 + (dir ? T - 1 - ((c) * C + (s_)) : (c) * C + (s_)))
    const int d0 = 32 * (wid >> 2), e0 = 32 * (wid & 3);
    f32x16 S;
    if (ctx) S = f32x16{};
    else {
        const float* s0 = p.in[I_SGLA] + ((((size_t)b * DEPTH + l) * 2 + dir) * 4 + h) * 64 * 128 + e0 + l32;
#pragma unroll
        for (int r = 0; r < 16; ++r) S[r] = s0[(size_t)(d0 + crow(r, hi)) * 128];
    }
    const int ts = tid >> 4, dc = (tid & 15) * 4, vs = tid >> 5, vc = (tid & 31) * 4;
    vf4 pq, pk, pl, pv0, pv1;
#define GLOAD(c) do { const size_t mt = TOK(c, ts), ma = TOK(c, vs), mb = TOK(c, vs + 16); \
        pq = *(const vf4*)(Z + mt * NINP + Z_GLQ + h * 64 + dc); pk = *(const vf4*)(Z + mt * NINP + Z_GLK + h * 64 + dc); pl = *(const vf4*)(LA + mt * 256 + h * 64 + dc); \
        pv0 = *(const vf4*)(Z + ma * NINP + Z_GLV + h * 128 + vc); pv1 = *(const vf4*)(Z + mb * NINP + Z_GLV + h * 128 + vc); } while (0)
#define WRITE_ST() do { _Pragma("unroll") for (int g = 0; g < 4; ++g) *(uint2*)(ST + (e0 + l32) * SQ + d0 + 8 * g + 4 * hi) = pk4(S[4 * g], S[4 * g + 1], S[4 * g + 2], S[4 * g + 3]); } while (0)
#define GIMAGES() do { vf4 pre = (vf4){0.f, 0.f, 0.f, 0.f}, tot = pre; \
        _Pragma("unroll 8") for (int t_ = 0; t_ < C; ++t_) { const vf4 v_ = *(const vf4*)(la + t_ * 64 + dc); tot += v_; if (t_ <= ts) pre += v_; } \
        float qe[4], kn[4]; \
        _Pragma("unroll") for (int j = 0; j < 4; ++j) { qe[j] = pq[j] * 0.125f * __expf(pre[j]); kn[j] = pk[j] * __expf(fminf(-pre[j], 80.f)); \
            KeT[(dc + j) * SS + ts] = f2bf(pk[j] * __expf(tot[j] - pre[j])); } \
        *(uint2*)(Qe + ts * SQ + dc) = pk4(qe[0], qe[1], qe[2], qe[3]); *(uint2*)(Kn + ts * SQ + dc) = pk4(kn[0], kn[1], kn[2], kn[3]); \
        if (ts == 0) { _Pragma("unroll") for (int j = 0; j < 4; ++j) eB[dc + j] = __expf(tot[j]); } \
        _Pragma("unroll") for (int j = 0; j < 4; ++j) { VT[(vc + j) * SS + vs] = f2bf(pv0[j]); VT[(vc + j) * SS + vs + 16] = f2bf(pv1[j]); } } while (0)
    __syncthreads();
    GLOAD(0);
    WRITE_ST();
    *(vf4*)(la + ts * 64 + dc) = pl;
    __syncthreads();
    GIMAGES();
    __syncthreads();
    for (int c = 0; c < nch; ++c) {
        if (c + 1 < nch) GLOAD(c + 1);
        f32x16 o1 = f32x16{};
        if (wid == 0) {
            const f32x16 kq = mm<64>(Kn, SQ, Qe, SQ, l32, hi, f32x16{});
            float a[16];
#pragma unroll
            for (int r = 0; r < 16; ++r) a[r] = (l32 >= crow(r, hi)) ? kq[r] : 0.f;
#pragma unroll
            for (int g = 0; g < 4; ++g) *(uint2*)(ATT + l32 * SS + 8 * g + 4 * hi) = pk4(a[4 * g], a[4 * g + 1], a[4 * g + 2], a[4 * g + 3]);
        } else if (wid >= 4) {
            o1 = mm<64>(Qe, SQ, ST + (32 * (wid - 4)) * SQ, SQ, l32, hi, f32x16{});
        }
        __syncthreads();
        if (wid >= 4) {
            const int eo = 32 * (wid - 4);
            o1 = mm<32>(ATT, SS, VT + eo * SS, SS, l32, hi, o1);
#pragma unroll
            for (int r = 0; r < 16; ++r) O[TOK(c, crow(r, hi)) * 512 + h * 128 + eo + l32] = o1[r];
        }
#pragma unroll
        for (int r = 0; r < 16; ++r) S[r] *= eB[d0 + crow(r, hi)];
        S = mm<32>(KeT + d0 * SS, SS, VT + e0 * SS, SS, l32, hi, S);
        __syncthreads();
        WRITE_ST();
        if (c + 1 < nch) *(vf4*)(la + ts * 64 + dc) = pl;
        __syncthreads();
        if (c + 1 < nch) GIMAGES();
        __syncthreads();
    }
#undef GLOAD
#undef WRITE_ST
#undef GIMAGES
#undef TOK
    if (ctx) {
        float* so = p.out + O_SGLA + ((((size_t)b * DEPTH + l) * 2 + dir) * 4 + h) * 64 * 128 + e0 + l32;
#pragma unroll
        for (int r = 0; r < 16; ++r) so[(size_t)(d0 + crow(r, hi)) * 128] = S[r];
    }
}
}
#define LAS __attribute__((address_space(3)))
constexpr int LDS_BYTES = 147456, XBW_OFF = LDS_BYTES - 64;
constexpr int NPH = 1 + DEPTH * 12;
#ifndef DBG_NLAYERS
#define DBG_NLAYERS DEPTH
#endif

#ifndef DUPKIND
#define DUPKIND 0
#endif
__device__ __forceinline__ int opaque_int(int v) { asm volatile("" : "+s"(v)); return v; }
#ifndef MIXMASK
#define MIXMASK 0xFF
#endif
#define FOR_ITEMS(it, n, o, w) for (int bo_ = (o) * (int)gridDim.x / 256, bw_ = ((w) * (int)gridDim.x / 256) > 0 ? ((w) * (int)gridDim.x / 256) : 1, \
                                    it = ((int)blockIdx.x >= bo_ && (int)blockIdx.x < bo_ + bw_) ? (int)blockIdx.x - bo_ : (n); it < (n); it += bw_)

constexpr int QCTR_WORD0 = 1024;
constexpr int NI_GDNL = LB * 8, NI_GLAL = LB * 8, NI_GDNC = CB * 8, NI_GQAL = LB * 16, NI_NAL = LB * 16, NI_GLAC = CB * 8, NI_NAC = CB * 4, NI_GQAC = CB * 4;
#define KM(k) (1 + ((DUPKIND >> (k)) & 1))
constexpr int Q0 = NI_GDNL * KM(0), Q1 = Q0 + NI_GLAL * KM(1), Q2 = Q1 + NI_GDNC * KM(2), Q3 = Q2 + NI_GQAL * KM(3), Q4 = Q3 + NI_NAL * KM(4), Q5 = Q4 + NI_GLAC * KM(5), Q6 = Q5 + NI_NAC * KM(6), Q7 = Q6 + NI_GQAC * KM(7);
__device__ __forceinline__ void phase_mix(const Params& p, int l, unsigned char* lds) {
    const int tid = opaque_tid();
    float* smem = (float*)lds;
    const bf16_t* NAQ = WSP(bf16_t, WS_NAQ); const bf16_t* NAK = WSP(bf16_t, WS_NAK); const bf16_t* NAV = WSP(bf16_t, WS_NAV);
    const bf16_t* GQ = WSP(bf16_t, WS_GQ); const bf16_t* GK = WSP(bf16_t, WS_GK); const bf16_t* GV = WSP(bf16_t, WS_GV);
    bf16_t* MRG = WSP(bf16_t, WS_MRG);
    unsigned* qctr = WSP(unsigned, WS_CTL) + QCTR_WORD0 + 64 * l;
    volatile int* qslot = (volatile int*)(lds + XBW_OFF + 16);
    for (;;) {
        __syncthreads();
        if (tid == 0) *qslot = (int)__hip_atomic_fetch_add(qctr, 1u, __ATOMIC_RELAXED, __HIP_MEMORY_SCOPE_AGENT);
        __syncthreads();
        const int q = __builtin_amdgcn_readfirstlane(*qslot);
        if (q >= Q7) break;
        if (q < Q0) { const int it = q % NI_GDNL; gdn::gdn_chunked(p, l, false, it / 8, (it / 2) % 4, it % 2, lds); }
        else if (q < Q1) { const int it = (q - Q0) % NI_GLAL; gla::gla_chunked(p, l, false, it / 8, (it / 2) % 4, it % 2, lds); }
        else if (q < Q2) { const int it = (q - Q1) % NI_GDNC; gdn::gdn_chunked(p, l, true, it / 8, (it / 2) % 4, it % 2, lds); }
        else if (q < Q3) {
            const int it = (q - Q2) % NI_GQAL, b = it / 16, qh = (it / 4) % 4, qb = it % 4, kvh = qh >> 1;
            const size_t r0 = (size_t)MC + (size_t)b * LT;
            att::SrcTwo src{WSP(bf16_t, WS_CGK) + ((size_t)b * DEPTH + l) * 256 * 256 + kvh * 128, WSP(bf16_t, WS_CGV) + ((size_t)b * DEPTH + l) * 256 * 256 + kvh * 128,
                            GK + r0 * 256 + kvh * 128, GV + r0 * 256 + kvh * 128, 256};
            att::attn_body<2>(GQ + (r0 + qb * 256) * 512 + qh * 128, src, MRG + (r0 + qb * 256) * DM + 1024 + qh * 128, 4 + LT / 64, (char*)lds, att::NoBias{});
        }
        else if (q < Q4) {
            const int it = (q - Q3) % NI_NAL, b = it / 16, h = (it / 4) % 4, qb = it % 4;
            const int kr0 = qb == 0 ? 0 : qb == 1 ? 0 : qb == 2 ? 4 : 8, nrows = (qb == 0 || qb == 3) ? 8 : 12;
            const size_t r0 = (size_t)MC + (size_t)b * LT;
            float* tab = (float*)(lds + att::SHM_ATTN);
            if (tid < 15 * 31) tab[tid] = p.in[I_RPB][((size_t)l * 4 + h) * 15 * 31 + tid] * (1.0f / att::SCALE);
            att::SrcTwo src{WSP(bf16_t, WS_CNAK) + ((size_t)b * DEPTH + l) * 256 * 512 + h * 128, WSP(bf16_t, WS_CNAV) + ((size_t)b * DEPTH + l) * 256 * 512 + h * 128,
                            NAK + (r0 + kr0 * 64) * 512 + h * 128, NAV + (r0 + kr0 * 64) * 512 + h * 128, 512};
            att::attn_body<1>(NAQ + (r0 + qb * 256) * 512 + h * 128, src, MRG + (r0 + qb * 256) * DM + 0 + h * 128, 4 + nrows, (char*)lds, att::NaBias{tab, qb * 256, kr0});
        }
        else if (q < Q5) { const int it = (q - Q4) % NI_GLAC; gla::gla_chunked(p, l, true, it / 8, (it / 2) % 4, it % 2, lds); }
        else if (q < Q6) {
            const int it = (q - Q5) % NI_NAC, b = it / 4, h = it % 4; const size_t r0 = (size_t)b * CT;
            att::SrcOne src{NAK + r0 * 512 + h * 128, NAV + r0 * 512 + h * 128, 512};
            att::attn_body<2>(NAQ + r0 * 512 + h * 128, src, MRG + r0 * DM + 0 + h * 128, CT / 64, (char*)lds, att::NoBias{});
        }
        else {
            const int it = (q - Q6) % NI_GQAC, b = it / 4, qh = it % 4, kvh = qh >> 1; const size_t r0 = (size_t)b * CT;
            att::SrcOne src{GK + r0 * 256 + kvh * 128, GV + r0 * 256 + kvh * 128, 256};
            att::attn_body<2>(GQ + r0 * 512 + qh * 128, src, MRG + r0 * DM + 1024 + qh * 128, CT / 64, (char*)lds, att::NoBias{});
        }
    }
}

static_assert(att::SHM_ATTN + 15 * 31 * 4 + 2048 <= (size_t)XBW_OFF, "LDS map");
static_assert((QCTR_WORD0 + 64 * DEPTH) < 4096, "ctl");
constexpr int BAR_WORD0 = 4096;
static_assert((BAR_WORD0 + XCD_BAR_WORDS) * 4 <= (int)CTL_BYTES, "ctl");

__global__ void __launch_bounds__(512, 2) fwd(Params p) {
    extern __shared__ __attribute__((aligned(16))) unsigned char lds[];
    const int tid = threadIdx.x;
    volatile LAS unsigned* xbw = (volatile LAS unsigned*)((LAS unsigned char*)lds + XBW_OFF);
    if (tid < 4) xbw[tid] = 0u;
    __syncthreads();
    XcdBarrier bar; bar.bar = WSP(unsigned, WS_CTL) + BAR_WORD0; bar.x = 0; bar.st = xbw;
    if (p.ph_hi - p.ph_lo > 1) bar = xcd_barrier_post(WSP(unsigned, WS_CTL) + BAR_WORD0, xbw);
#ifndef PHMASK
#define PHMASK 0x1FFF
#endif
#define IN(k) (p.ph_lo <= (k) && (k) < p.ph_hi)
#define INL(j) (((PHMASK >> ((j) + 1)) & 1) && IN(pb + (j)))
#ifndef DUPMASK
#define DUPMASK 0
#endif
#define DUP(j) ((DUPMASK >> ((j) + 1)) & 1)
#define SEAM(k) do { if (IN(k) && IN((k) + 1)) xcd_barrier(bar); } while (0)
    LAS unsigned char* ldsl = (LAS unsigned char*)lds;
    bf16_t* H = WSP(bf16_t, WS_H); bf16_t* ACT = WSP(bf16_t, WS_ACT); float* X = WSP(float, WS_X); float* Z = WSP(float, WS_Z); bf16_t* MRG = WSP(bf16_t, WS_MRG);

    if ((PHMASK & 1) && IN(0)) { int reps_ = 1 + (DUPMASK & 1); asm volatile("" : "+s"(reps_)); for (int rep_ = 0; rep_ < reps_; ++rep_) { const Params q = opaque_params(p); phase_prologue(q, (float*)lds); __syncthreads(); } }
    SEAM(0);
    for (int l = 0; l < DBG_NLAYERS; ++l) {
        const int pb = 1 + l * 12;
        const float* modl = WSP(float, WS_MODV) + (size_t)l * NCOND * NMOD;
        if (INL(0)) { int reps_ = 1 + DUP(0); asm volatile("" : "+s"(reps_)); for (int rep_ = 0; rep_ < reps_; ++rep_) { const Params q = opaque_params(p); phase_norm(q, l, 0); __syncthreads(); } }
        SEAM(pb + 0);
        if (INL(1)) {
            pg8::Gemm g{H, WSP(bf16_t, WS_WGU) + ((size_t)l * 2 + 0) * NGU * DM, M, NGU, DM}; pg8::StaticOrder S; S.init(M, NGU, DM, (int)gridDim.x, (int)blockIdx.x);
            pg8::EpiSwiGLU E{ACT, FF};
            for (int r_ = 0, n_ = opaque_int(1 + DUP(1)); r_ < n_; ++r_) pg8::gemm_phase<pg8::EpiSwiGLU, pg8::StaticOrder, false>(ldsl, g, S, E, nullptr);
        }
        SEAM(pb + 1);
        if (INL(2)) {
            pg8::Gemm g{ACT, WSP(bf16_t, WS_WDN) + ((size_t)l * 2 + 0) * DM * FF, M, DM, FF}; pg8::StaticOrder S; S.init(M, DM, FF, (int)gridDim.x, (int)blockIdx.x, 0);
            pg8::EpiResid E{X, X, DM, modl + 2 * DM, 0.5f};
            pg8::gemm_phase<pg8::EpiResid, pg8::StaticOrder, false>(ldsl, g, S, E, nullptr);
        }
        SEAM(pb + 2);
        if (INL(3)) { int reps_ = 1 + DUP(3); asm volatile("" : "+s"(reps_)); for (int rep_ = 0; rep_ < reps_; ++rep_) { const Params q = opaque_params(p); phase_norm(q, l, 1); __syncthreads(); } }
        SEAM(pb + 3);
        if (INL(4)) {
            pg8::Gemm g{H, WSP(bf16_t, WS_WIN) + (size_t)l * NINP * DM, M, NINP, DM}; pg8::StaticOrder S; S.init(M, NINP, DM, (int)gridDim.x, (int)blockIdx.x);
            pg8::EpiF32 E{Z, NINP, nullptr};
            for (int r_ = 0, n_ = opaque_int(1 + DUP(4)); r_ < n_; ++r_) pg8::gemm_phase<pg8::EpiF32, pg8::StaticOrder, false>(ldsl, g, S, E, nullptr);
        }
        SEAM(pb + 4);
        if (INL(5)) { int reps_ = 1 + DUP(5); asm volatile("" : "+s"(reps_)); for (int rep_ = 0; rep_ < reps_; ++rep_) { const Params q = opaque_params(p); phase_prep(q, l); __syncthreads(); } }
        SEAM(pb + 5);
        if (INL(6)) { int reps_ = 1 + DUP(6); asm volatile("" : "+s"(reps_)); for (int rep_ = 0; rep_ < reps_; ++rep_) { const Params q = opaque_params(p); phase_mix(q, l, lds); __syncthreads(); } }
        SEAM(pb + 6);
        if (INL(7)) { int reps_ = 1 + DUP(7); asm volatile("" : "+s"(reps_)); for (int rep_ = 0; rep_ < reps_; ++rep_) { const Params q = opaque_params(p); phase_post(q, l); __syncthreads(); } }
        SEAM(pb + 7);
        if (INL(8)) {
            pg8::Gemm g{MRG, WSP(bf16_t, WS_WOUT) + (size_t)l * DM * DM, M, DM, DM}; pg8::StaticOrder S; S.init(M, DM, DM, (int)gridDim.x, (int)blockIdx.x, 0);
            pg8::EpiResid E{X, X, DM, modl + 5 * DM, 1.0f};
            pg8::gemm_phase<pg8::EpiResid, pg8::StaticOrder, false>(ldsl, g, S, E, nullptr);
        }
        SEAM(pb + 8);
        if (INL(9)) { int reps_ = 1 + DUP(9); asm volatile("" : "+s"(reps_)); for (int rep_ = 0; rep_ < reps_; ++rep_) { const Params q = opaque_params(p); phase_norm(q, l, 2); __syncthreads(); } }
        SEAM(pb + 9);
        if (INL(10)) {
            pg8::Gemm g{H, WSP(bf16_t, WS_WGU) + ((size_t)l * 2 + 1) * NGU * DM, M, NGU, DM}; pg8::StaticOrder S; S.init(M, NGU, DM, (int)gridDim.x, (int)blockIdx.x);
            pg8::EpiSwiGLU E{ACT, FF};
            pg8::gemm_phase<pg8::EpiSwiGLU, pg8::StaticOrder, false>(ldsl, g, S, E, nullptr);
        }
        SEAM(pb + 10);
        if (INL(11)) {
            pg8::Gemm g{ACT, WSP(bf16_t, WS_WDN) + ((size_t)l * 2 + 1) * DM * FF, M, DM, FF}; pg8::StaticOrder S; S.init(M, DM, FF, (int)gridDim.x, (int)blockIdx.x, 0);
            pg8::EpiResid E{X, (l == DEPTH - 1) ? p.out : X, DM, modl + 8 * DM, 0.5f};
            pg8::gemm_phase<pg8::EpiResid, pg8::StaticOrder, false>(ldsl, g, S, E, nullptr);
        }
        SEAM(pb + 11);
    }
#undef IN
#undef SEAM
}

#ifndef MULTI_LAUNCH
#define MULTI_LAUNCH 0
#endif
extern "C" void kernel_launch(void* const* d_in, const int* in_sizes, int n_in, void* d_out, int out_size, void* d_ws, size_t ws_size, hipStream_t stream) {
    static int grid = 0;
    if (grid == 0) {
        if (n_in != N_IN || (size_t)out_size != O_END || ws_size < WS_END) { fprintf(stderr, "kernel_launch: shape mismatch n_in %d out %d ws %zu (need %zu)\n", n_in, out_size, ws_size, (size_t)WS_END); grid = -1; return; }
        int dev = 0, cus = 0, per_cu = 0;
        if (hipGetDevice(&dev) != hipSuccess || hipDeviceGetAttribute(&cus, hipDeviceAttributeMultiprocessorCount, dev) != hipSuccess) { grid = -1; return; }
        if (hipFuncSetAttribute((const void*)fwd, hipFuncAttributeMaxDynamicSharedMemorySize, LDS_BYTES) != hipSuccess) { fprintf(stderr, "kernel_launch: hipFuncSetAttribute failed\n"); grid = -1; return; }
        if (hipOccupancyMaxActiveBlocksPerMultiprocessor(&per_cu, (const void*)fwd, 512, LDS_BYTES) != hipSuccess || per_cu < 1) { fprintf(stderr, "kernel_launch: occupancy query says %d\n", per_cu); (void)hipGetLastError(); }
        grid = cus;
    }
    if (grid < 0) return;
    (void)hipMemsetAsync((char*)d_ws + WS_CTL, 0, CTL_BYTES, stream);
    Params p{};
    for (int i = 0; i < N_IN; ++i) p.in[i] = (const float*)d_in[i];
    p.out = (float*)d_out; p.ws = (unsigned char*)d_ws;
#if MULTI_LAUNCH
    for (int ph = 0; ph < 1 + DBG_NLAYERS * 12; ++ph) { p.ph_lo = ph; p.ph_hi = ph + 1; hipLaunchKernelGGL(fwd, dim3(grid), dim3(512), LDS_BYTES, stream, p); }
#else
    p.ph_lo = 0; p.ph_hi = NPH; hipLaunchKernelGGL(fwd, dim3(grid), dim3(512), LDS_BYTES, stream, p);
#endif
    const hipError_t le = hipPeekAtLastError();
    if (le != hipSuccess) fprintf(stderr, "kernel_launch: launch failed: %s\n", hipGetErrorName(le));
}
```

```cpp
#include <hip/hip_runtime.h>
#include <cstdio>
#include <cstdint>

#ifndef CB_
#define CB_ 16
#endif
#ifndef LB_
#define LB_ 8
#endif
#ifndef DEPTH_
#define DEPTH_ 4
#endif
constexpr int DM = 2048, DEPTH = DEPTH_, CB = CB_, CT = 256, LB = LB_, LT = 1024;
constexpr int MC = CB * CT, ML = LB * LT, M = MC + ML;
constexpr int FF = 5504, NGU = 2 * FF, NIN = 6192, NINP = 6400, NMOD = 9 * DM, NCOND = 1 + LB;
constexpr float EPS = 1e-6f;
constexpr int Z_NAQ = 0, Z_NAK = 512, Z_NAV = 1024, Z_GLQ = 1536, Z_GLK = 1792, Z_GLV = 2048, Z_GLR = 2560, Z_GF = 3072, Z_GB = 3088,
              Z_GQQ = 3104, Z_GQK = 3616, Z_GQV = 3872, Z_DQKV = 4128, Z_DZ = 5664, Z_DB = 6176, Z_DA = 6184;
static_assert(Z_DA + 8 == NIN, "split");
enum { I_XP = 0, I_XS, I_CNAK, I_CNAV, I_CGK, I_CGV, I_SGLA, I_SGDN, I_C, I_CCTX, I_NORMG, I_WMOD, I_BMOD, I_GU, I_DOWN, I_WIN, I_WOUT, I_NAQKN, I_RPB,
       I_GUP, I_GBIAS, I_GLAON, I_GQAQKN, I_CONV, I_ALOG, I_DTB, I_GDNON, N_IN };
constexpr size_t O_YP = 0, O_YS = O_YP + (size_t)MC * DM, O_NAK = O_YS + (size_t)ML * DM, O_NAV = O_NAK + (size_t)CB * DEPTH * 4 * CT * 128,
                 O_GK = O_NAV + (size_t)CB * DEPTH * 4 * CT * 128, O_GV = O_GK + (size_t)CB * DEPTH * 2 * CT * 128,
                 O_SGLA = O_GV + (size_t)CB * DEPTH * 2 * CT * 128, O_SGDN = O_SGLA + (size_t)CB * DEPTH * 2 * 4 * 64 * 128,
                 O_END = O_SGDN + (size_t)CB * DEPTH * 2 * 4 * 128 * 128;
constexpr size_t al256(size_t x) { return (x + 255) & ~(size_t)255; }
constexpr size_t WS_CTL = 0, CTL_BYTES = 1u << 20;
constexpr size_t WS_WGU = CTL_BYTES;
constexpr size_t WS_WDN = WS_WGU + (size_t)DEPTH * 2 * NGU * DM * 2;
constexpr size_t WS_WIN = WS_WDN + (size_t)DEPTH * 2 * DM * FF * 2;
constexpr size_t WS_WOUT = WS_WIN + (size_t)DEPTH * NINP * DM * 2;
constexpr size_t WS_MODV = WS_WOUT + (size_t)DEPTH * DM * DM * 2;
constexpr size_t WS_ROPE = al256(WS_MODV + (size_t)DEPTH * NCOND * NMOD * 4);
constexpr size_t WS_X = al256(WS_ROPE + 2 * 64 * 32 * 4);
constexpr size_t WS_H = WS_X + (size_t)M * DM * 4;
constexpr size_t WS_ACT = WS_H + (size_t)M * DM * 2;
constexpr size_t WS_Z = WS_ACT + (size_t)M * FF * 2;
constexpr size_t WS_MRG = WS_Z + (size_t)M * NINP * 4;
constexpr size_t WS_NAQ = WS_MRG + (size_t)M * DM * 2;
constexpr size_t WS_NAK = WS_NAQ + (size_t)M * 512 * 2;
constexpr size_t WS_NAV = WS_NAK + (size_t)M * 512 * 2;
constexpr size_t WS_GQ = WS_NAV + (size_t)M * 512 * 2;
constexpr size_t WS_GK = WS_GQ + (size_t)M * 512 * 2;
constexpr size_t WS_GV = WS_GK + (size_t)M * 256 * 2;
constexpr size_t WS_CNAK = WS_GV + (size_t)M * 256 * 2;
constexpr size_t WS_CNAV = WS_CNAK + (size_t)LB * DEPTH * 256 * 512 * 2;
constexpr size_t WS_CGK = WS_CNAV + (size_t)LB * DEPTH * 256 * 512 * 2;
constexpr size_t WS_CGV = WS_CGK + (size_t)LB * DEPTH * 256 * 256 * 2;
constexpr size_t WS_AF = WS_CGV + (size_t)LB * DEPTH * 256 * 256 * 2;
constexpr size_t WS_AB = WS_AF + (size_t)M * 256 * 4;
constexpr size_t WS_DQ = WS_AB + (size_t)M * 256 * 4;
constexpr size_t WS_DK = WS_DQ + (size_t)M * 512 * 4;
constexpr size_t WS_DV = WS_DK + (size_t)M * 512 * 4;
constexpr size_t WS_DBA = WS_DV + (size_t)M * 512 * 4;
constexpr size_t WS_GOF = WS_DBA + (size_t)M * 16 * 4;
constexpr size_t WS_GOB = WS_GOF + (size_t)M * 512 * 4;
constexpr size_t WS_DOF = WS_GOB + (size_t)M * 512 * 4;
constexpr size_t WS_DOB = WS_DOF + (size_t)M * 512 * 4;
constexpr size_t WS_END = WS_DOB + (size_t)M * 512 * 4;

typedef unsigned short bf16_t;
struct Params { const float* in[N_IN]; float* out; unsigned char* ws; int ph_lo, ph_hi; };
static_assert(sizeof(Params) == N_IN * 8 + 8 + 8 + 8, "no padding");

#define WSP(T, off) ((T*)(p.ws + (off)))
__device__ __forceinline__ int opaque_tid() { int t = (int)threadIdx.x; asm volatile("" : "+v"(t)); return t; }
__device__ __forceinline__ Params opaque_params(const Params& p) { Params q = p; unsigned long long w = (unsigned long long)q.ws; asm volatile("" : "+s"(w)); q.ws = (unsigned char*)w; return q; }

__device__ __forceinline__ float wave_sum(float v) {
#pragma unroll
    for (int o = 32; o >= 1; o >>= 1) v += __shfl_xor(v, o);
    return v;
}
__device__ __forceinline__ bf16_t f2bf(float f) { unsigned u = __float_as_uint(f); u += 0x7FFFu + ((u >> 16) & 1u); return (bf16_t)(u >> 16); }
__device__ __forceinline__ unsigned pack2(float a, float b) { return (unsigned)f2bf(a) | ((unsigned)f2bf(b) << 16); }
__device__ __forceinline__ float silu_f(float x) { return x / (1.f + expf(-x)); }
__device__ __forceinline__ float softplus_f(float x) { return fmaxf(x, 0.f) + log1pf(expf(-fabsf(x))); }
__device__ __forceinline__ float logsigmoid_f(float x) { return fminf(x, 0.f) - log1pf(expf(-fabsf(x))); }
__device__ __forceinline__ int cond_of_row(int m) { return m < MC ? 0 : 1 + (m - MC) / LT; }
typedef float vf4 __attribute__((ext_vector_type(4)));
__device__ __forceinline__ void conv_tile(const float* __restrict__ src, int ld_src, int ncols_src, int k0, int c0, bf16_t* __restrict__ dst, int ld_dst, int n0, float* tile) {
    const int tid = opaque_tid();
    {
        const int r = tid >> 3, c = (tid & 7) * 8;
        float4 a = make_float4(0.f, 0.f, 0.f, 0.f), b = a;
        if (c0 + c + 8 <= ncols_src) {
            const float* s = src + (size_t)(k0 + r) * ld_src + c0 + c;
            a = *(const float4*)s; b = *(const float4*)(s + 4);
        }
        float* t = tile + r * 65 + c;
        t[0] = a.x; t[1] = a.y; t[2] = a.z; t[3] = a.w; t[4] = b.x; t[5] = b.y; t[6] = b.z; t[7] = b.w;
    }
    __syncthreads();
    {
        const int n = tid >> 3, ks = (tid & 7) * 8;
        const float* t = tile + ks * 65 + n;
        uint4 w;
        w.x = pack2(t[0 * 65], t[1 * 65]); w.y = pack2(t[2 * 65], t[3 * 65]); w.z = pack2(t[4 * 65], t[5 * 65]); w.w = pack2(t[6 * 65], t[7 * 65]);
        *(uint4*)(dst + (size_t)(n0 + n) * ld_dst + k0 + ks) = w;
    }
    __syncthreads();
}

constexpr int MOD_ITEMS = DEPTH * (NMOD / 128);
constexpr int TGU_KT = DM / 64, TGU_NT = NGU / 64, TDN_KT = FF / 64, TDN_NT = DM / 64, TIN_KT = DM / 64, TIN_NT = NINP / 64, TOUT_KT = DM / 64, TOUT_NT = DM / 64;
constexpr int T_GU = DEPTH * 2 * TGU_KT * TGU_NT, T_DN = DEPTH * 2 * TDN_KT * TDN_NT, T_IN = DEPTH * TIN_KT * TIN_NT, T_OUT = DEPTH * TOUT_KT * TOUT_NT;

__device__ __forceinline__ void phase_prologue(const Params& p, float* smem) {
    const int tid = opaque_tid(), nb = gridDim.x, bid = blockIdx.x;
    float* s_cond = smem;
    float* s_red = s_cond + NCOND * DM;
    float* s_tile = s_red + 3 * 128 * NCOND;
    for (int i = tid; i < NCOND * DM; i += 512) { const int ci = i / DM, k = i % DM; const float v = ci == 0 ? p.in[I_CCTX][k] : p.in[I_C][(size_t)(ci - 1) * DM + k]; s_cond[i] = silu_f(v); }
    __syncthreads();
    float* modv = WSP(float, WS_MODV);
    for (int it = bid; it < MOD_ITEMS; it += nb) {
        const int l = it / (NMOD / 128), jt = it % (NMOD / 128);
        const int cl = tid & 127, kq = tid >> 7, col = jt * 128 + cl;
        const float* w = p.in[I_WMOD] + (size_t)l * DM * NMOD + col;
        float acc[NCOND];
#pragma unroll
        for (int ci = 0; ci < NCOND; ++ci) acc[ci] = 0.f;
        for (int k = kq * 512; k < kq * 512 + 512; k += 8) {
            float wv[8];
#pragma unroll
            for (int j = 0; j < 8; ++j) wv[j] = w[(size_t)(k + j) * NMOD];
#pragma unroll
            for (int ci = 0; ci < NCOND; ++ci) {
                const float4 s0 = *(const float4*)&s_cond[ci * DM + k], s1 = *(const float4*)&s_cond[ci * DM + k + 4];
                acc[ci] += s0.x * wv[0] + s0.y * wv[1] + s0.z * wv[2] + s0.w * wv[3] + s1.x * wv[4] + s1.y * wv[5] + s1.z * wv[6] + s1.w * wv[7];
            }
        }
        if (kq > 0) {
#pragma unroll
            for (int ci = 0; ci < NCOND; ++ci) s_red[((kq - 1) * 128 + cl) * NCOND + ci] = acc[ci];
        }
        __syncthreads();
        if (kq == 0) {
            const float bm = p.in[I_BMOD][(size_t)l * NMOD + col];
#pragma unroll
            for (int ci = 0; ci < NCOND; ++ci)
                modv[((size_t)l * NCOND + ci) * NMOD + col] = acc[ci] + s_red[(0 * 128 + cl) * NCOND + ci] + s_red[(1 * 128 + cl) * NCOND + ci] + s_red[(2 * 128 + cl) * NCOND + ci] + bm;
        }
        __syncthreads();
    }
    for (int it = bid; it < T_GU + T_DN + T_IN + T_OUT; it += nb) {
        if (it < T_GU) {
            const int mat = it / (TGU_KT * TGU_NT), r = it % (TGU_KT * TGU_NT), kt = r / TGU_NT, nt = r % TGU_NT;
            const int n0 = nt * 64, t256 = n0 / 256, c = n0 % 256;
            const int c0 = c < 128 ? 128 * t256 + c : FF + 128 * t256 + (c - 128);
            conv_tile(p.in[I_GU] + (size_t)mat * DM * NGU, NGU, NGU, kt * 64, c0, WSP(bf16_t, WS_WGU) + (size_t)mat * NGU * DM, DM, n0, s_tile);
        } else if (it < T_GU + T_DN) {
            const int i2 = it - T_GU, mat = i2 / (TDN_KT * TDN_NT), r = i2 % (TDN_KT * TDN_NT), kt = r / TDN_NT, nt = r % TDN_NT;
            conv_tile(p.in[I_DOWN] + (size_t)mat * FF * DM, DM, DM, kt * 64, nt * 64, WSP(bf16_t, WS_WDN) + (size_t)mat * DM * FF, FF, nt * 64, s_tile);
        } else if (it < T_GU + T_DN + T_IN) {
            const int i2 = it - T_GU - T_DN, mat = i2 / (TIN_KT * TIN_NT), r = i2 % (TIN_KT * TIN_NT), kt = r / TIN_NT, nt = r % TIN_NT;
            conv_tile(p.in[I_WIN] + (size_t)mat * DM * NIN, NIN, NIN, kt * 64, nt * 64, WSP(bf16_t, WS_WIN) + (size_t)mat * NINP * DM, DM, nt * 64, s_tile);
        } else {
            const int i2 = it - T_GU - T_DN - T_IN, mat = i2 / (TOUT_KT * TOUT_NT), r = i2 % (TOUT_KT * TOUT_NT), kt = r / TOUT_NT, nt = r % TOUT_NT;
            conv_tile(p.in[I_WOUT] + (size_t)mat * DM * DM, DM, DM, kt * 64, nt * 64, WSP(bf16_t, WS_WOUT) + (size_t)mat * DM * DM, DM, nt * 64, s_tile);
        }
    }
    const size_t gtid = (size_t)bid * 512 + tid, gstride = (size_t)nb * 512;
    {
        float4* X = WSP(float4, WS_X);
        const float4* xp = (const float4*)p.in[I_XP]; const float4* xs = (const float4*)p.in[I_XS];
        const size_t nc = (size_t)MC * DM / 4, n = (size_t)M * DM / 4;
        for (size_t i = gtid; i < n; i += gstride) X[i] = i < nc ? xp[i] : xs[i - nc];
    }
    {
        const size_t n_na = (size_t)LB * DEPTH * 256 * 512 / 8;
        for (size_t i = gtid; i < 2 * n_na; i += gstride) {
            const bool isv = i >= n_na; const size_t j = isv ? i - n_na : i;
            const int d8 = (int)(j % 16), h = (int)((j / 16) % 4), t = (int)((j / 64) % 256); const size_t bl = j / (64 * 256);
            const float* s = p.in[isv ? I_CNAV : I_CNAK] + ((bl * 4 + h) * 256 + t) * 128 + d8 * 8;
            const float4 a = *(const float4*)s, b = *(const float4*)(s + 4);
            uint4 w; w.x = pack2(a.x, a.y); w.y = pack2(a.z, a.w); w.z = pack2(b.x, b.y); w.w = pack2(b.z, b.w);
            *(uint4*)(WSP(bf16_t, isv ? WS_CNAV : WS_CNAK) + (bl * 256 + t) * 512 + h * 128 + d8 * 8) = w;
        }
        const size_t n_g = (size_t)LB * DEPTH * 256 * 256 / 8;
        for (size_t i = gtid; i < 2 * n_g; i += gstride) {
            const bool isv = i >= n_g; const size_t j = isv ? i - n_g : i;
            const int d8 = (int)(j % 16), h = (int)((j / 16) % 2), t = (int)((j / 32) % 256); const size_t bl = j / (32 * 256);
            const float* s = p.in[isv ? I_CGV : I_CGK] + ((bl * 2 + h) * 256 + t) * 128 + d8 * 8;
            const float4 a = *(const float4*)s, b = *(const float4*)(s + 4);
            uint4 w; w.x = pack2(a.x, a.y); w.y = pack2(a.z, a.w); w.z = pack2(b.x, b.y); w.w = pack2(b.z, b.w);
            *(uint4*)(WSP(bf16_t, isv ? WS_CGV : WS_CGK) + (bl * 256 + t) * 256 + h * 128 + d8 * 8) = w;
        }
    }
    for (size_t i = gtid; i < 64 * 32; i += gstride) {
        const int pos = (int)(i / 32), k = (int)(i % 32);
        const float inv = powf(10000.0f, -(float)(2 * k) / 64.0f);
        const float ang = (float)pos * inv;
        WSP(float, WS_ROPE)[i] = cosf(ang); WSP(float, WS_ROPE)[64 * 32 + i] = sinf(ang);
    }
}

__device__ __forceinline__ void phase_norm(const Params& p, int l, int which  ) {
    const int tid = opaque_tid(), lane = tid & 63, wv = tid >> 6;
    const float* X = WSP(float, WS_X); bf16_t* H = WSP(bf16_t, WS_H);
    const float* g = p.in[I_NORMG] + ((size_t)l * 3 + which) * DM;
    for (int m = blockIdx.x * 8 + wv; m < M; m += gridDim.x * 8) {
        const int ci = cond_of_row(m);
        const float* mv = WSP(float, WS_MODV) + ((size_t)l * NCOND + ci) * NMOD + (size_t)which * 3 * DM;
        const float* x = X + (size_t)m * DM;
        vf4 v[8]; float ss = 0.f;
#pragma unroll
        for (int i = 0; i < 8; ++i) { v[i] = *(const vf4*)(x + (i * 64 + lane) * 4); ss += v[i].x * v[i].x + v[i].y * v[i].y + v[i].z * v[i].z + v[i].w * v[i].w; }
        ss = wave_sum(ss);
        const float r = 1.0f / sqrtf(ss * (1.0f / DM) + EPS);
#pragma unroll
        for (int i = 0; i < 8; ++i) {
            const int c = (i * 64 + lane) * 4;
            const float4 gg = *(const float4*)(g + c), sh = *(const float4*)(mv + c), sc = *(const float4*)(mv + DM + c);
            const float o0 = v[i].x * r * gg.x * (1.f + sc.x) + sh.x, o1 = v[i].y * r * gg.y * (1.f + sc.y) + sh.y;
            const float o2 = v[i].z * r * gg.z * (1.f + sc.z) + sh.z, o3 = v[i].w * r * gg.w * (1.f + sc.w) + sh.w;
            uint2 w; w.x = pack2(o0, o1); w.y = pack2(o2, o3);
            *(uint2*)(H + (size_t)m * DM + c) = w;
        }
    }
}

__device__ __forceinline__ float red16(float v);
__device__ __forceinline__ float ssq8(vf4 a, vf4 b) { const vf4 s = a * a + b * b; return (s.x + s.y) + (s.z + s.w); }
__device__ __forceinline__ uint4 pack8(vf4 a, vf4 b) { uint4 w; w.x = pack2(a.x, a.y); w.y = pack2(a.z, a.w); w.z = pack2(b.x, b.y); w.w = pack2(b.z, b.w); return w; }
__device__ __forceinline__ void phase_prep(const Params& p, int l) {
    const int tid = opaque_tid(), lane = tid & 63, wv = tid >> 6, rg = lane >> 4, sub = lane & 15, c8 = sub * 8;
    const float* Z = WSP(float, WS_Z);
    const float* ropec = WSP(float, WS_ROPE); const float* ropes = ropec + 64 * 32;
    const float* wnq = p.in[I_NAQKN] + ((size_t)l * 2 + 0) * 128 + c8; const float* wnk = wnq + 128;
    const float* wgq = p.in[I_GQAQKN] + ((size_t)l * 2 + 0) * 128 + c8; const float* wgk = wgq + 128;
    const float* cw = p.in[I_CONV] + (size_t)l * 5 * 1536 + rg * 128 + c8;
    for (int m = blockIdx.x * 8 + wv; m < M; m += gridDim.x * 8) {
        const float* z = Z + (size_t)m * NINP;
        const bool ctx = m < MC;
        const int b = ctx ? m / CT : (m - MC) / LT, t = ctx ? m % CT : (m - MC) % LT, T = ctx ? CT : LT;
        {
            const int ho = rg * 128 + c8;
            const float* zkv = z + (rg < 2 ? Z_GQK + rg * 128 : Z_GQV + (rg - 2) * 128) + c8;
            vf4 q0 = *(const vf4*)(z + Z_NAQ + ho), q1 = *(const vf4*)(z + Z_NAQ + ho + 4), k0 = *(const vf4*)(z + Z_NAK + ho), k1 = *(const vf4*)(z + Z_NAK + ho + 4);
            const vf4 v0 = *(const vf4*)(z + Z_NAV + ho), v1 = *(const vf4*)(z + Z_NAV + ho + 4);
            vf4 g0 = *(const vf4*)(z + Z_GQQ + ho), g1 = *(const vf4*)(z + Z_GQQ + ho + 4), x0 = *(const vf4*)zkv, x1 = *(const vf4*)(zkv + 4);
            float r = 1.0f / sqrtf(red16(ssq8(q0, q1)) * (1.0f / 128) + EPS);
            q0 = q0 * r * *(const vf4*)wnq; q1 = q1 * r * *(const vf4*)(wnq + 4);
            *(uint4*)(WSP(bf16_t, WS_NAQ) + (size_t)m * 512 + ho) = pack8(q0, q1);
            r = 1.0f / sqrtf(red16(ssq8(k0, k1)) * (1.0f / 128) + EPS);
            k0 = k0 * r * *(const vf4*)wnk; k1 = k1 * r * *(const vf4*)(wnk + 4);
            *(uint4*)(WSP(bf16_t, WS_NAK) + (size_t)m * 512 + ho) = pack8(k0, k1);
            *(uint4*)(WSP(bf16_t, WS_NAV) + (size_t)m * 512 + ho) = pack8(v0, v1);
            if (ctx) {
                const size_t o = ((((size_t)b * DEPTH + l) * 4 + rg) * CT + t) * 128 + c8;
                *(vf4*)(p.out + O_NAK + o) = k0; *(vf4*)(p.out + O_NAK + o + 4) = k1; *(vf4*)(p.out + O_NAV + o) = v0; *(vf4*)(p.out + O_NAV + o + 4) = v1;
            }
            r = 1.0f / sqrtf(red16(ssq8(g0, g1)) * (1.0f / 128) + EPS);
            g0 = g0 * r * *(const vf4*)wgq; g1 = g1 * r * *(const vf4*)(wgq + 4);
            const float rk = 1.0f / sqrtf(red16(ssq8(x0, x1)) * (1.0f / 128) + EPS);
            if (rg < 2) { x0 = x0 * rk * *(const vf4*)wgk; x1 = x1 * rk * *(const vf4*)(wgk + 4); }
            if (!ctx) {
                const int pos = sub < 8 ? (t >> 6) : (t & 63), ai = pos * 32 + (c8 & 31);
                const vf4 c0 = *(const vf4*)(ropec + ai), c1 = *(const vf4*)(ropec + ai + 4), s0 = *(const vf4*)(ropes + ai), s1 = *(const vf4*)(ropes + ai + 4);
                const bool hi = (sub & 4) != 0;
                vf4 pg0, pg1, px0, px1;
#pragma unroll
                for (int j = 0; j < 4; ++j) { pg0[j] = __shfl_xor(g0[j], 4); pg1[j] = __shfl_xor(g1[j], 4); px0[j] = __shfl_xor(x0[j], 4); px1[j] = __shfl_xor(x1[j], 4); }
                g0 = hi ? pg0 * s0 + g0 * c0 : g0 * c0 - pg0 * s0; g1 = hi ? pg1 * s1 + g1 * c1 : g1 * c1 - pg1 * s1;
                if (rg < 2) { x0 = hi ? px0 * s0 + x0 * c0 : x0 * c0 - px0 * s0; x1 = hi ? px1 * s1 + x1 * c1 : x1 * c1 - px1 * s1; }
            }
            *(uint4*)(WSP(bf16_t, WS_GQ) + (size_t)m * 512 + ho) = pack8(g0, g1);
            *(uint4*)(WSP(bf16_t, rg < 2 ? WS_GK : WS_GV) + (size_t)m * 256 + (rg & 1) * 128 + c8) = pack8(x0, x1);
            if (ctx) {
                const size_t o = ((((size_t)b * DEPTH + l) * 2 + (rg & 1)) * CT + t) * 128 + c8;
                float* dst = p.out + (rg < 2 ? O_GK : O_GV) + o;
                *(vf4*)dst = x0; *(vf4*)(dst + 4) = x1;
            }
        }
        {
#pragma unroll
            for (int dir = 0; dir < 2; ++dir) {
                const float* up = p.in[I_GUP] + ((size_t)l * 2 + dir) * 16 * 256 + 4 * lane;
                vf4 acc = *(const vf4*)(p.in[I_GBIAS] + ((size_t)l * 2 + dir) * 256 + 4 * lane);
                const float* gz = z + (dir ? Z_GB : Z_GF);
#pragma unroll
                for (int r4 = 0; r4 < 4; ++r4) {
                    const vf4 gv = *(const vf4*)(gz + 4 * r4);
                    acc += gv.x * *(const vf4*)(up + (4 * r4 + 0) * 256) + gv.y * *(const vf4*)(up + (4 * r4 + 1) * 256) + gv.z * *(const vf4*)(up + (4 * r4 + 2) * 256) + gv.w * *(const vf4*)(up + (4 * r4 + 3) * 256);
                }
                vf4 o;
#pragma unroll
                for (int j = 0; j < 4; ++j) o[j] = logsigmoid_f(acc[j]) * (1.0f / 16.0f);
                *(vf4*)(WSP(float, dir ? WS_AB : WS_AF) + (size_t)m * 256 + 4 * lane) = o;
            }
        }
        {
#pragma unroll
            for (int part = 0; part < 3; ++part) {
                vf4 a0 = (vf4){0.f, 0.f, 0.f, 0.f}, a1 = a0;
#pragma unroll
                for (int j = 0; j < 5; ++j) {
                    const int tt = t + j - 2;
                    if (tt >= 0 && tt < T) {
                        const float* zz = Z + (size_t)(m + j - 2) * NINP + Z_DQKV + part * 512 + rg * 128 + c8;
                        const float* cj = cw + j * 1536 + part * 512;
                        a0 += *(const vf4*)cj * *(const vf4*)zz; a1 += *(const vf4*)(cj + 4) * *(const vf4*)(zz + 4);
                    }
                }
#pragma unroll
                for (int j = 0; j < 4; ++j) { a0[j] = silu_f(a0[j]); a1[j] = silu_f(a1[j]); }
                if (part < 2) { const float r = 1.0f / sqrtf(red16(ssq8(a0, a1)) + EPS) * (part == 0 ? 0.08838834764831845f : 1.0f); a0 *= r; a1 *= r; }
                float* dst = WSP(float, part == 0 ? WS_DQ : part == 1 ? WS_DK : WS_DV) + (size_t)m * 512 + rg * 128 + c8;
                *(vf4*)dst = a0; *(vf4*)(dst + 4) = a1;
            }
            if (lane < 8) {
                const float beta = 1.0f / (1.0f + expf(-z[Z_DB + lane]));
                const float g = -expf(p.in[I_ALOG][(size_t)l * 8 + lane]) * softplus_f(z[Z_DA + lane] + p.in[I_DTB][(size_t)l * 8 + lane]);
                float* ba = WSP(float, WS_DBA) + (size_t)m * 16;
                ba[lane] = beta; ba[8 + lane] = g;
            }
        }
    }
}

typedef float vf2 __attribute__((ext_vector_type(2)));
__device__ __forceinline__ float dpp_f(float v, const int ctrl) { return v; }
#define DPPF(v, ctrl) __int_as_float(__builtin_amdgcn_mov_dpp(__float_as_int(v), (ctrl), 0xF, 0xF, true))
__device__ __forceinline__ float red8(float v) { v += DPPF(v, 0xB1); v += DPPF(v, 0x4E); v += DPPF(v, 0x141); return v; }
__device__ __forceinline__ float red16(float v) { v = red8(v); v += DPPF(v, 0x140); return v; }

__device__ __forceinline__ void gla_chain(const Params& p, int l, bool ctx, int b, int h, int dir, int es, float* smem) {
    constexpr int TC = 32;
    const int tid = opaque_tid(), el = tid >> 3, dg = tid & 7;
    const int T = ctx ? CT : LT; const size_t m0 = ctx ? (size_t)b * CT : (size_t)MC + (size_t)b * LT;
    const float* Z = WSP(float, WS_Z); const float* A = WSP(float, dir ? WS_AB : WS_AF);
    float* O = WSP(float, dir ? WS_GOB : WS_GOF);
    float* sq = smem; float* sk = sq + TC * 64; float* sa = sk + TC * 64; float* sv = sa + TC * 64; float* so = sv + TC * 64;
    vf2 S[4];
    {
        const int e = es * 64 + el;
        if (ctx) {
#pragma unroll
            for (int i = 0; i < 4; ++i) S[i] = (vf2){0.f, 0.f};
        } else {
            const float* s0 = p.in[I_SGLA] + (((((size_t)b * DEPTH + l) * 2 + dir) * 4 + h) * 64 + dg * 8) * 128 + e;
#pragma unroll
            for (int i = 0; i < 4; ++i) S[i] = (vf2){s0[(size_t)(2 * i) * 128], s0[(size_t)(2 * i + 1) * 128]};
        }
    }
    vf4 pre[4];
    const int nch = T / TC;
    const int ls = tid >> 4, lc = (tid & 15) * 4;
#define GLA_LOAD(c) do { const int ti = (c) * TC + ls, tt = dir ? T - 1 - ti : ti; const size_t m = m0 + tt; \
        pre[0] = *(const vf4*)(Z + m * NINP + Z_GLQ + h * 64 + lc); pre[1] = *(const vf4*)(Z + m * NINP + Z_GLK + h * 64 + lc); \
        pre[2] = *(const vf4*)(A + m * 256 + h * 64 + lc);           pre[3] = *(const vf4*)(Z + m * NINP + Z_GLV + h * 128 + es * 64 + lc); } while (0)
#define GLA_WRITE() do { *(vf4*)(sq + ls * 64 + lc) = pre[0] * 0.125f; *(vf4*)(sk + ls * 64 + lc) = pre[1]; { vf4 e_; e_.x = expf(pre[2].x); e_.y = expf(pre[2].y); e_.z = expf(pre[2].z); e_.w = expf(pre[2].w); *(vf4*)(sa + ls * 64 + lc) = e_; } *(vf4*)(sv + ls * 64 + lc) = pre[3]; } while (0)
    __syncthreads();
    GLA_LOAD(0); GLA_WRITE(); __syncthreads();
    for (int c = 0; c < nch; ++c) {
        if (c + 1 < nch) GLA_LOAD(c + 1);
        vf4 q0 = *(const vf4*)(sq + dg * 8), q1 = *(const vf4*)(sq + dg * 8 + 4), k0 = *(const vf4*)(sk + dg * 8), k1 = *(const vf4*)(sk + dg * 8 + 4);
        vf4 a0 = *(const vf4*)(sa + dg * 8), a1 = *(const vf4*)(sa + dg * 8 + 4); float ve = sv[el];
#pragma unroll 2
        for (int s = 0; s < TC; ++s) {
            const int sn = (s + 1) & (TC - 1);
            const vf4 nq0 = *(const vf4*)(sq + sn * 64 + dg * 8), nq1 = *(const vf4*)(sq + sn * 64 + dg * 8 + 4), nk0 = *(const vf4*)(sk + sn * 64 + dg * 8), nk1 = *(const vf4*)(sk + sn * 64 + dg * 8 + 4);
            const vf4 na0 = *(const vf4*)(sa + sn * 64 + dg * 8), na1 = *(const vf4*)(sa + sn * 64 + dg * 8 + 4); const float nve = sv[sn * 64 + el];
            const vf2 v2 = (vf2){ve, ve};
            S[0] = a0.xy * S[0] + k0.xy * v2; S[1] = a0.zw * S[1] + k0.zw * v2; S[2] = a1.xy * S[2] + k1.xy * v2; S[3] = a1.zw * S[3] + k1.zw * v2;
            vf2 acc0 = q0.xy * S[0], acc1 = q0.zw * S[1]; acc0 += q1.xy * S[2]; acc1 += q1.zw * S[3];
            acc0 += acc1;
            const float po = red8(acc0.x + acc0.y);
            if (dg == 0) so[s * 64 + el] = po;
            q0 = nq0; q1 = nq1; k0 = nk0; k1 = nk1; a0 = na0; a1 = na1; ve = nve;
        }
        __syncthreads();
        { const int ti = c * TC + ls, tt = dir ? T - 1 - ti : ti; *(vf4*)(O + (m0 + tt) * 512 + h * 128 + es * 64 + lc) = *(const vf4*)(so + ls * 64 + lc); }
        if (c + 1 < nch) GLA_WRITE();
        __syncthreads();
    }
#undef GLA_LOAD
#undef GLA_WRITE
    if (ctx) {
        float* so_ = p.out + O_SGLA + (((((size_t)b * DEPTH + l) * 2 + dir) * 4 + h) * 64 + dg * 8) * 128 + es * 64 + el;
#pragma unroll
        for (int i = 0; i < 4; ++i) { so_[(size_t)(2 * i) * 128] = S[i].x; so_[(size_t)(2 * i + 1) * 128] = S[i].y; }
    }
}

__device__ __forceinline__ void gdn_chain(const Params& p, int l, bool ctx, int b, int h, int dir, int es, float* smem) {
    constexpr int TC = 32;
    const int tid = opaque_tid(), el = tid >> 3, dg = tid & 7;
    const int T = ctx ? CT : LT; const size_t m0 = ctx ? (size_t)b * CT : (size_t)MC + (size_t)b * LT;
    const float* DQ = WSP(float, WS_DQ); const float* DK = WSP(float, WS_DK); const float* DV = WSP(float, WS_DV); const float* DBA = WSP(float, WS_DBA);
    float* O = WSP(float, dir ? WS_DOB : WS_DOF);
    float* sq = smem; float* sk = sq + TC * 128; float* sv = sk + TC * 128; float* so = sv + TC * 64; float* sba = so + TC * 64; float* sqk = sba + TC * 2;
    vf2 S[8];
    {
        const int e = es * 64 + el;
        if (ctx) {
#pragma unroll
            for (int i = 0; i < 8; ++i) S[i] = (vf2){0.f, 0.f};
        } else {
            const float* s0 = p.in[I_SGDN] + (((((size_t)b * DEPTH + l) * 2 + dir) * 4 + h) * 128 + dg * 16) * 128 + e;
#pragma unroll
            for (int i = 0; i < 8; ++i) S[i] = (vf2){s0[(size_t)(2 * i) * 128], s0[(size_t)(2 * i + 1) * 128]};
        }
    }
    vf4 pre[5]; float pre_s = 0.f;
    const int nch = T / TC;
    const int ls = tid >> 5, lc = (tid & 31) * 4, vs = tid >> 4, vc = (tid & 15) * 4;
#define TOK(c, s_) (m0 + (dir ? T - 1 - ((c) * TC + (s_)) : (c) * TC + (s_)))
#define GDN_LOAD(c) do { const size_t ma = TOK(c, ls), mb = TOK(c, ls + 16), mv = TOK(c, vs); \
        pre[0] = *(const vf4*)(DQ + ma * 512 + h * 128 + lc); pre[1] = *(const vf4*)(DQ + mb * 512 + h * 128 + lc); \
        pre[2] = *(const vf4*)(DK + ma * 512 + h * 128 + lc); pre[3] = *(const vf4*)(DK + mb * 512 + h * 128 + lc); \
        pre[4] = *(const vf4*)(DV + mv * 512 + h * 128 + es * 64 + vc); \
        if (tid < 2 * TC) { pre_s = DBA[TOK(c, tid >> 1) * 16 + (tid & 1) * 8 + dir * 4 + h]; if (tid & 1) pre_s = expf(pre_s); } } while (0)
#define GDN_WRITE() do { *(vf4*)(sq + ls * 128 + lc) = pre[0]; *(vf4*)(sq + (ls + 16) * 128 + lc) = pre[1]; *(vf4*)(sk + ls * 128 + lc) = pre[2]; *(vf4*)(sk + (ls + 16) * 128 + lc) = pre[3]; \
        *(vf4*)(sv + vs * 64 + vc) = pre[4]; if (tid < 2 * TC) sba[tid] = pre_s; } while (0)
    __syncthreads();
    GDN_LOAD(0); GDN_WRITE(); __syncthreads();
    for (int c = 0; c < nch; ++c) {
        if (c + 1 < nch) GDN_LOAD(c + 1);
        {
            const int s = tid >> 4, part = tid & 15;
            const vf4 x0 = *(const vf4*)(sq + s * 128 + part * 8), x1 = *(const vf4*)(sq + s * 128 + part * 8 + 4), y0 = *(const vf4*)(sk + s * 128 + part * 8), y1 = *(const vf4*)(sk + s * 128 + part * 8 + 4);
            const vf4 pr = x0 * y0 + x1 * y1;
            const float d = red16((pr.x + pr.y) + (pr.z + pr.w));
            if (part == 0) sqk[s] = d;
        }
        __syncthreads();
        vf4 kk[4], qq[4]; float ve, be, a, qk;
#pragma unroll
        for (int i = 0; i < 4; ++i) { kk[i] = *(const vf4*)(sk + dg * 16 + 4 * i); qq[i] = *(const vf4*)(sq + dg * 16 + 4 * i); }
        ve = sv[el]; be = sba[0]; a = sba[1]; qk = sqk[0];
#pragma unroll 2
        for (int s = 0; s < TC; ++s) {
            const int sn = (s + 1) & (TC - 1);
            vf4 nk[4], nq[4];
#pragma unroll
            for (int i = 0; i < 4; ++i) { nk[i] = *(const vf4*)(sk + sn * 128 + dg * 16 + 4 * i); nq[i] = *(const vf4*)(sq + sn * 128 + dg * 16 + 4 * i); }
            const float nve = sv[sn * 64 + el], nbe = sba[2 * sn], na = sba[2 * sn + 1], nqk = sqk[sn];
            vf2 ak0 = kk[0].xy * S[0], ak1 = kk[0].zw * S[1], aq0 = qq[0].xy * S[0], aq1 = qq[0].zw * S[1];
#pragma unroll
            for (int i = 1; i < 4; ++i) { ak0 += kk[i].xy * S[2 * i]; ak1 += kk[i].zw * S[2 * i + 1]; aq0 += qq[i].xy * S[2 * i]; aq1 += qq[i].zw * S[2 * i + 1]; }
            ak0 += ak1; aq0 += aq1;
            const float uk = red8(ak0.x + ak0.y), uq = red8(aq0.x + aq0.y);
            const float vn = be * (ve - a * uk);
            const float po = a * uq + qk * vn;
            const vf2 a2 = (vf2){a, a}, vn2 = (vf2){vn, vn};
#pragma unroll
            for (int i = 0; i < 4; ++i) { S[2 * i] = a2 * S[2 * i] + kk[i].xy * vn2; S[2 * i + 1] = a2 * S[2 * i + 1] + kk[i].zw * vn2; }
            if (dg == 0) so[s * 64 + el] = po;
#pragma unroll
            for (int i = 0; i < 4; ++i) { kk[i] = nk[i]; qq[i] = nq[i]; }
            ve = nve; be = nbe; a = na; qk = nqk;
        }
        __syncthreads();
        *(vf4*)(O + TOK(c, vs) * 512 + h * 128 + es * 64 + vc) = *(const vf4*)(so + vs * 64 + vc);
        if (c + 1 < nch) GDN_WRITE();
        __syncthreads();
    }
#undef GDN_LOAD
#undef GDN_WRITE
#undef TOK
    if (ctx) {
        float* so_ = p.out + O_SGDN + (((((size_t)b * DEPTH + l) * 2 + dir) * 4 + h) * 128 + dg * 16) * 128 + es * 64 + el;
#pragma unroll
        for (int i = 0; i < 8; ++i) { so_[(size_t)(2 * i) * 128] = S[i].x; so_[(size_t)(2 * i + 1) * 128] = S[i].y; }
    }
}

__device__ __forceinline__ void phase_post(const Params& p, int l) {
    const int tid = opaque_tid(), lane = tid & 63, wv = tid >> 6, rg = lane >> 4, c8 = (lane & 15) * 8;
    const float* Z = WSP(float, WS_Z); bf16_t* MRG = WSP(bf16_t, WS_MRG);
    const float* wg = p.in[I_GLAON] + (size_t)l * 128 + c8; const float* wd = p.in[I_GDNON] + (size_t)l * 128 + c8;
    for (int m = blockIdx.x * 8 + wv; m < M; m += gridDim.x * 8) {
        const float* z = Z + (size_t)m * NINP;
        const int ho = rg * 128 + c8;
#pragma unroll
        for (int g = 0; g < 2; ++g) {
            const float* of = WSP(float, g ? WS_DOF : WS_GOF) + (size_t)m * 512 + ho; const float* ob = WSP(float, g ? WS_DOB : WS_GOB) + (size_t)m * 512 + ho;
            const float* w = g ? wd : wg; const float* zg = z + (g ? Z_DZ : Z_GLR) + ho;
            vf4 a0 = *(const vf4*)of + *(const vf4*)ob, a1 = *(const vf4*)(of + 4) + *(const vf4*)(ob + 4);
            const vf4 g0 = *(const vf4*)zg, g1 = *(const vf4*)(zg + 4);
            const float r = 1.0f / sqrtf(red16(ssq8(a0, a1)) * (1.0f / 128) + EPS);
            a0 = a0 * r * *(const vf4*)w; a1 = a1 * r * *(const vf4*)(w + 4);
#pragma unroll
            for (int j = 0; j < 4; ++j) { a0[j] *= silu_f(g0[j]); a1[j] *= silu_f(g1[j]); }
            *(uint4*)(MRG + (size_t)m * DM + (g ? 1536 : 512) + ho) = pack8(a0, a1);
        }
    }
}
#define XB_TMO      128
#define XB_XCNT(j)  (256  + 64 * (j))
#define XB_XSUB(j)  (1280 + 64 * (j))
#define XB_XGEN(j)  (2304 + 64 * (j))
#define XB_TOP      3328
#define XB_TOPGEN   3392
#define XCD_BAR_WORDS 3456
#define XB_SPIN_CAP (1u << 22)
#define LAS __attribute__((address_space(3)))

__device__ __forceinline__ unsigned xb_ld(unsigned* p)              { return __hip_atomic_load(p, __ATOMIC_RELAXED, __HIP_MEMORY_SCOPE_AGENT); }
__device__ __forceinline__ unsigned xb_add(unsigned* p, unsigned v) { return __hip_atomic_fetch_add(p, v, __ATOMIC_RELAXED, __HIP_MEMORY_SCOPE_AGENT); }
__device__ __forceinline__ unsigned xb_xcc_id() { return (unsigned)__builtin_amdgcn_s_getreg((3 << 11) | 20) & 0xFu; }
#define XB_SPIN(cond, bar) do { unsigned _sp = 0; while (cond) { __builtin_amdgcn_s_sleep(1); \
    if ((++_sp & 255u) == 0u) { if (xb_ld(&(bar)[XB_TMO])) break; if (_sp > XB_SPIN_CAP) { atomicAdd(&(bar)[XB_TMO], 1u); break; } } } } while (0)

struct XcdBarrier {
    unsigned* bar; unsigned x;
    volatile LAS unsigned* st;
};

__device__ __forceinline__ XcdBarrier xcd_barrier_post(unsigned* bar, volatile LAS unsigned* st) {
    XcdBarrier b; b.bar = bar; b.x = xb_xcc_id(); b.st = st;
    if (threadIdx.x == 0) (void)xb_add(&bar[XB_XCNT(b.x)], 1u);
    return b;
}
__device__ __forceinline__ void xcd_barrier_complete(unsigned* bar, unsigned x, unsigned& nloc, unsigned& nx) {
    const unsigned G = gridDim.x * gridDim.y * gridDim.z;
    unsigned sum, cnt, mine, sp = 0u;
    for (;;) {
        sum = 0u; cnt = 0u; mine = 0u;
#pragma unroll
        for (unsigned j = 0; j < 16; ++j) { const unsigned c = xb_ld(&bar[XB_XCNT(j)]); sum += c; cnt += (c > 0u) ? 1u : 0u; mine = (j == x) ? c : mine; }
        if (sum == G) break;
        __builtin_amdgcn_s_sleep(1);
        if ((++sp & 255u) == 0u) { if (xb_ld(&bar[XB_TMO])) break; if (sp > XB_SPIN_CAP) { atomicAdd(&bar[XB_TMO], 1u); break; } }
    }
    nloc = mine > 0u ? mine : 1u; nx = cnt > 0u ? cnt : 1u;
}

__device__ __forceinline__ void xcd_barrier(const XcdBarrier& b) {
    asm volatile("s_waitcnt vmcnt(0)" ::: "memory");
    __syncthreads();
    if (threadIdx.x == 0) {
        unsigned* bar = b.bar;
        __builtin_amdgcn_s_waitcnt(0);
        unsigned nloc = b.st[0], nx = b.st[1];
        if (nloc == 0u) { xcd_barrier_complete(bar, b.x, nloc, nx); b.st[0] = nloc; b.st[1] = nx; }
        const unsigned old = xb_add(&bar[XB_XSUB(b.x)], 1u);
        const unsigned gen = old / nloc;
        if (old + 1u == (gen + 1u) * nloc) {
            __builtin_amdgcn_fence(__ATOMIC_RELEASE, "agent");
            asm volatile("s_waitcnt vmcnt(0)" ::: "memory");
            const unsigned og = xb_add(&bar[XB_TOP], 1u);
            const unsigned tg = og / nx;
            if (og + 1u == (tg + 1u) * nx) xb_add(&bar[XB_TOPGEN], 1u);
            else XB_SPIN(xb_ld(&bar[XB_TOPGEN]) == tg, bar);
            __builtin_amdgcn_fence(__ATOMIC_ACQUIRE, "agent");
            xb_add(&bar[XB_XGEN(b.x)], 1u);
            asm volatile("s_waitcnt vmcnt(0)" ::: "memory");
        } else {
            XB_SPIN(xb_ld(&bar[XB_XGEN(b.x)]) == gen, bar);
            __builtin_amdgcn_fence(__ATOMIC_ACQUIRE, "agent");
            asm volatile("s_waitcnt vmcnt(0)" ::: "memory");
        }
    }
    __syncthreads();
}

namespace pg8 {
#define PG8_LAS __attribute__((address_space(3)))
typedef unsigned short bf16_t;
typedef short bf16x8 __attribute__((ext_vector_type(8)));
typedef float f32x4 __attribute__((ext_vector_type(4)));
typedef unsigned u32x4 __attribute__((ext_vector_type(4)));
constexpr int BM = 256, BK = 64, HALF = 128, HTB = HALF * BK * 2  , STAGE_BYTES = 8 * HTB, NXCD = 8, WGM = 8;

__host__ __device__ __forceinline__ int lds_byte(int r, int c) { const int st = (r >> 4) * 2 + (c >> 5), rr = r & 15, cc = c & 31, ob = rr * 64 + cc * 2; return st * 1024 + (ob ^ (((ob >> 9) & 1) << 5)); }
__host__ __device__ __forceinline__ void stage_rc(int b, int& R, int& C) { const int st = b / 1024, sb = b % 1024, swz = sb ^ (((sb >> 9) & 1) << 5); R = (st >> 1) * 16 + swz / 64; C = (st & 1) * 32 + (swz % 64) / 2; }
__host__ __device__ __forceinline__ int perm32(int rho) { const int n = rho >> 4, i = rho & 15; return 8 * (i >> 2) + 4 * n + (i & 3); }

struct Unit { int pm, pn, k0, nt, at, slot; };
struct Gemm { const bf16_t* A; const bf16_t* Bt; int M, N, K; };

struct StaticOrder {
    int nM, nN, nwg, G, c, ntk, split;
    __host__ __device__ void init(int M, int N, int K, int G_, int c_, int split_ = 0) { nM = M / BM; nN = N / BM; nwg = nM * nN; G = G_; c = c_; ntk = K / BK; const int rem = nwg % G_; split = (split_ && rem > 0 && 2 * rem == G_ && (ntk % 4) != 1 && ntk >= 8) ? 1 : 0; }
    __host__ __device__ bool next(int i, Unit& u) const {
        long L = (long)i * G + c; u.k0 = 0; u.nt = ntk; u.at = 0; u.slot = 0;
        if (split && i == nwg / G) { const int rem = nwg % G, sl = c / rem, h0 = ((ntk / 2) + 1) & ~1; L = (long)i * G + (c % rem); u.k0 = sl ? h0 * BK : 0; u.nt = sl ? ntk - h0 : h0; u.at = sl ? 1 : 2; u.slot = c % rem; }
        if (L >= nwg) return false;
        int wgid = (int)L; { const int q = nwg / NXCD, r = nwg % NXCD, xcd = wgid % NXCD, off = wgid / NXCD; wgid = (xcd < r ? xcd * (q + 1) : r * (q + 1) + (xcd - r) * q) + off; }
        const int nig = WGM * nN, gid = wgid / nig, fm = gid * WGM, gsz = (nM - fm) < WGM ? (nM - fm) : WGM;
        u.pm = fm + ((wgid % nig) % gsz); u.pn = (wgid % nig) / gsz; return true;
    }
    __device__ __forceinline__ void a_ready(const Unit&) const {}
    __device__ __forceinline__ void done(const Unit&) const {}
};
__device__ __forceinline__ unsigned cvt_pk_bf16(float lo, float hi) { unsigned r; asm volatile("v_cvt_pk_bf16_f32 %0, %1, %2" : "=v"(r) : "v"(lo), "v"(hi)); return r; }
struct EpiF32 {
    static constexpr bool PERM = false, AFTER_DRAIN = false;
    float* C; int ldc; const float* bias;
    __device__ __forceinline__ void operator()(const f32x4 (&acc)[2][2][4][2], const Unit& u, int wr, int wc, int fr, int fq) const {
        const int row0 = u.pm * BM + wr * 64 + fr, col0 = u.pn * BM + wc * 32 + 4 * fq;
        f32x4 bv[2][2];
#pragma unroll
        for (int bj = 0; bj < 2; ++bj)
#pragma unroll
            for (int n = 0; n < 2; ++n) bv[bj][n] = bias ? *(const f32x4*)(bias + col0 + bj * HALF + n * 16) : (f32x4){0.f, 0.f, 0.f, 0.f};
#pragma unroll
        for (int ai = 0; ai < 2; ++ai)
#pragma unroll
            for (int m = 0; m < 4; ++m) { float* rowp = C + (size_t)(row0 + ai * HALF + m * 16) * ldc + col0;
#pragma unroll
                for (int bj = 0; bj < 2; ++bj)
#pragma unroll
                    for (int n = 0; n < 2; ++n) *(f32x4*)(rowp + bj * HALF + n * 16) = acc[ai][bj][m][n] + bv[bj][n]; }
    }
};

struct EpiSwiGLU {
    static constexpr bool PERM = true, AFTER_DRAIN = false;
    bf16_t* O; int ldc;
    __device__ __forceinline__ void operator()(const f32x4 (&acc)[2][2][4][2], const Unit& u, int wr, int wc, int fr, int fq) const {
        const int row0 = u.pm * BM + wr * 64 + fr, col0 = u.pn * 128 + wc * 32 + 8 * fq;
#pragma unroll
        for (int ai = 0; ai < 2; ++ai)
#pragma unroll
            for (int m = 0; m < 4; ++m) { bf16_t* rowp = O + (size_t)(row0 + ai * HALF + m * 16) * ldc + col0;
                const f32x4 g0 = acc[ai][0][m][0], g1 = acc[ai][0][m][1], u0 = acc[ai][1][m][0], u1 = acc[ai][1][m][1];
                float r[8];
#pragma unroll
                for (int j = 0; j < 4; ++j) {
                    r[j]     = g0[j] * __builtin_amdgcn_rcpf(1.0f + __builtin_amdgcn_exp2f(-1.4426950408889634f * g0[j])) * u0[j];
                    r[4 + j] = g1[j] * __builtin_amdgcn_rcpf(1.0f + __builtin_amdgcn_exp2f(-1.4426950408889634f * g1[j])) * u1[j]; }
                u32x4 w; w.x = cvt_pk_bf16(r[0], r[1]); w.y = cvt_pk_bf16(r[2], r[3]); w.z = cvt_pk_bf16(r[4], r[5]); w.w = cvt_pk_bf16(r[6], r[7]);
                *(u32x4*)rowp = w; }
    }
};
struct EpiResid {
    static constexpr bool PERM = false, AFTER_DRAIN = false;
    const float* res; float* out; int ldc; const float* gate0; float coef;
    float* slab; unsigned* flags; unsigned target;
    __device__ __forceinline__ void operator()(const f32x4 (&acc)[2][2][4][2], const Unit& u, int wr, int wc, int fr, int fq) const {
        const int tidx = ((wr * 4 + wc) * 4 + fq) * 16 + fr;
        if (u.at == 1) {
            const __amdgpu_buffer_rsrc_t rs = __builtin_amdgcn_make_buffer_rsrc((void*)slab, 0, 0x7FFFFFF0, 0x00020000);
            const unsigned base = ((unsigned)u.slot * 32u * 512u + (unsigned)tidx) * 16u;
#pragma unroll
            for (int ai = 0; ai < 2; ++ai)
#pragma unroll
                for (int bj = 0; bj < 2; ++bj)
#pragma unroll
                    for (int m = 0; m < 4; ++m)
#pragma unroll
                        for (int n = 0; n < 2; ++n) { const f32x4 v = acc[ai][bj][m][n]; u32x4 w; w.x = __float_as_uint(v[0]); w.y = __float_as_uint(v[1]); w.z = __float_as_uint(v[2]); w.w = __float_as_uint(v[3]);
                            __builtin_amdgcn_raw_buffer_store_b128(w, rs, base + (unsigned)((((ai * 2 + bj) * 4 + m) * 2 + n) * 512 * 16), 0, 16); }
            asm volatile("s_waitcnt vmcnt(0)" ::: "memory");
            if ((tidx & 63) == 0) __hip_atomic_fetch_add(flags + 64 * u.slot, 1u, __ATOMIC_RELAXED, __HIP_MEMORY_SCOPE_AGENT);
            return;
        }
        const float* part = nullptr;
        if (u.at == 2) {
            unsigned spins = 0;
            while (__hip_atomic_load(flags + 64 * u.slot, __ATOMIC_RELAXED, __HIP_MEMORY_SCOPE_AGENT) < target) { __builtin_amdgcn_s_sleep(2); if (++spins > (1u << 22)) break; }
            __builtin_amdgcn_fence(__ATOMIC_ACQUIRE, "agent");
            asm volatile("s_waitcnt vmcnt(0)" ::: "memory");
            part = slab + ((size_t)u.slot * 32 * 512 + tidx) * 4;
        }
        const int row0 = u.pm * BM + wr * 64 + fr, col0 = u.pn * BM + wc * 32 + 4 * fq;
        const float* gate = gate0 + (size_t)cond_of_row(u.pm * BM) * NMOD;
        f32x4 gv[2][2];
#pragma unroll
        for (int bj = 0; bj < 2; ++bj)
#pragma unroll
            for (int n = 0; n < 2; ++n) gv[bj][n] = *(const f32x4*)(gate + col0 + bj * HALF + n * 16) * coef;
#pragma unroll
        for (int ai = 0; ai < 2; ++ai)
#pragma unroll
            for (int m = 0; m < 4; ++m) { const size_t off = (size_t)(row0 + ai * HALF + m * 16) * ldc + col0;
#pragma unroll
                for (int bj = 0; bj < 2; ++bj)
#pragma unroll
                    for (int n = 0; n < 2; ++n) {
                        f32x4 a = acc[ai][bj][m][n];
                        if (part) a += *(const f32x4*)(part + (size_t)((((ai * 2 + bj) * 4 + m) * 2 + n) * 512 * 4));
                        const f32x4 bs = *(const f32x4*)(res + off + bj * HALF + n * 16); *(f32x4*)(out + off + bj * HALF + n * 16) = bs + gv[bj][n] * a; }
                asm volatile("" ::: "memory"); }
    }
};
template <class Epi, class Sched, bool STAMP = false>
__device__ __forceinline__ void gemm_phase(PG8_LAS unsigned char* lds, const Gemm g, const Sched& S, const Epi& E, unsigned long long* stamps) {
    const int tid = opaque_tid(), wid = __builtin_amdgcn_readfirstlane(tid >> 6), lane = tid & 63, wr = wid >> 2, wc = wid & 3, fr = lane & 15, fq = lane >> 4;
    const int K = g.K;
    int ts_lo = 0, ts_hi = 0, nts = 0; const unsigned long long rt_entry = STAMP ? (unsigned long long)wall_clock64() : 0ull;
#define PG8_STAMP() do { if (STAMP && wid == 0 && nts < 64) { const unsigned long long _c = (unsigned long long)clock64(); \
        ts_lo = (lane == nts) ? (int)(unsigned)_c : ts_lo; ts_hi = (lane == nts) ? (int)(unsigned)(_c >> 32) : ts_hi; ++nts; } } while (0)
    PG8_STAMP();
    unsigned voffA[2], voffB[2];
#pragma unroll
    for (int i = 0; i < 2; ++i) { int R, C; stage_rc(tid * 16 + i * 8192, R, C); const int Rb = Epi::PERM ? ((R & ~31) + perm32(R & 31)) : R;
        voffA[i] = (unsigned)(R * K + C) * 2u; voffB[i] = (unsigned)(Rb * K + C) * 2u; }
    const size_t kstep = (size_t)(BK * 2);
    const size_t hstep = (size_t)HALF * K * 2;
    const size_t tstep = 2 * hstep;
    const unsigned ldsw = (unsigned)wid * 1024u;
    const int aoff = lds_byte(wr * 64 + fr, fq * 8), boff = lds_byte(wc * 32 + fr, fq * 8);
#define PG8_SA(b, h) (((b) * 2 + (h)) * HTB)
#define PG8_SB(b, h) ((4 + (b) * 2 + (h)) * HTB)
#define PG8_STAGE(bufoff, gbase, voff) do { _Pragma("unroll") for (int _i = 0; _i < 2; ++_i) \
        __builtin_amdgcn_global_load_lds((const unsigned*)((const char*)(gbase) + (voff)[_i]), (PG8_LAS unsigned*)(lds + (bufoff) + ldsw + _i * 8192), 16, 0, 0); } while (0)
#define PG8_LDA(dst, b, h) do { _Pragma("unroll") for (int m = 0; m < 4; ++m) _Pragma("unroll") for (int k = 0; k < 2; ++k) dst[m][k] = *(const PG8_LAS bf16x8*)(lds + PG8_SA(b, h) + aoff + m * 2048 + k * 1024); } while (0)
#define PG8_LDB(dst, b, h) do { _Pragma("unroll") for (int n = 0; n < 2; ++n) _Pragma("unroll") for (int k = 0; k < 2; ++k) dst[n][k] = *(const PG8_LAS bf16x8*)(lds + PG8_SB(b, h) + boff + n * 2048 + k * 1024); } while (0)
#define PG8_MMA(ai, bj, At, Bt) do { __builtin_amdgcn_s_setprio(1); _Pragma("unroll") for (int m = 0; m < 4; ++m) _Pragma("unroll") for (int n = 0; n < 2; ++n) _Pragma("unroll") for (int k = 0; k < 2; ++k) \
        acc[ai][bj][m][n] = __builtin_amdgcn_mfma_f32_16x16x32_bf16(Bt[n][k], At[m][k], acc[ai][bj][m][n], 0, 0, 0); __builtin_amdgcn_s_setprio(0); } while (0)
#define PG8_WAIT_V(n) asm volatile("s_waitcnt vmcnt(" #n ")" ::: "memory")
#define PG8_WAIT_L(n) asm volatile("s_waitcnt lgkmcnt(" #n ")" ::: "memory")
#define PG8_BAR __builtin_amdgcn_s_barrier()
#define PG8_SCHED __builtin_amdgcn_sched_barrier(0)
    Unit cur, nxt; int ui = 0;
    if (!S.next(0, cur)) return;
    f32x4 acc[2][2][4][2];
#pragma unroll
    for (int a = 0; a < 2; ++a)
#pragma unroll
        for (int b = 0; b < 2; ++b)
#pragma unroll
            for (int m = 0; m < 4; ++m)
#pragma unroll
                for (int n = 0; n < 2; ++n) acc[a][b][m][n] = (f32x4){0.f, 0.f, 0.f, 0.f};
    bf16x8 At[4][2], B0[2][2], B1[2][2];
    const char* cA = (const char*)g.A + (size_t)cur.pm * tstep + (size_t)cur.k0 * 2; const char* cB = (const char*)g.Bt + (size_t)cur.pn * tstep + (size_t)cur.k0 * 2;
    S.a_ready(cur);
    PG8_STAGE(PG8_SB(0, 0), cB, voffB); PG8_STAGE(PG8_SA(0, 0), cA, voffA); PG8_STAGE(PG8_SB(0, 1), cB + hstep, voffB); PG8_STAGE(PG8_SA(0, 1), cA + hstep, voffA);
    if (wr == 1) PG8_BAR;
    PG8_WAIT_V(4); PG8_BAR;
    PG8_STAGE(PG8_SB(1, 0), cB + kstep, voffB); PG8_STAGE(PG8_SA(1, 0), cA + kstep, voffA); PG8_STAGE(PG8_SB(1, 1), cB + hstep + kstep, voffB);
    PG8_WAIT_V(6); PG8_BAR;
    PG8_STAMP();
    for (;;) {
        const bool has_next = S.next(ui + 1, nxt);
        const char* nA = has_next ? (const char*)g.A + (size_t)nxt.pm * tstep + (size_t)nxt.k0 * 2 : cA; const char* nB = has_next ? (const char*)g.Bt + (size_t)nxt.pn * tstep + (size_t)nxt.k0 * 2 : cB;
        const int nt = cur.nt;
        for (int t = 0; t < nt; t += 2) {
            const bool last = (t == nt - 2);
            const char* a1 = cA + (size_t)(t + 1) * kstep;
            const char* a2 = last ? nA : cA + (size_t)(t + 2) * kstep; const char* b2 = last ? nB : cB + (size_t)(t + 2) * kstep;
            const char* a3 = a2 + kstep; const char* b3 = b2 + kstep;
            if (last && has_next) S.a_ready(nxt);
            PG8_LDB(B0, 0, 0); PG8_SCHED; PG8_LDA(At, 0, 0); PG8_STAGE(PG8_SA(1, 1), a1 + hstep, voffA);
            PG8_WAIT_L(8); PG8_BAR; PG8_WAIT_L(0); PG8_MMA(0, 0, At, B0); PG8_BAR; PG8_SCHED;
            PG8_LDB(B1, 0, 1); PG8_STAGE(PG8_SB(0, 0), b2, voffB);
            PG8_BAR; PG8_WAIT_L(0); PG8_MMA(0, 1, At, B1); PG8_BAR;
            PG8_LDA(At, 0, 1); PG8_STAGE(PG8_SA(0, 0), a2, voffA);
            PG8_BAR; PG8_WAIT_L(0); PG8_MMA(1, 0, At, B0); PG8_BAR; PG8_SCHED;
            PG8_STAGE(PG8_SB(0, 1), b2 + hstep, voffB);
            PG8_WAIT_V(6); PG8_BAR; PG8_MMA(1, 1, At, B1); PG8_BAR;
            PG8_LDB(B0, 1, 0); PG8_SCHED; PG8_LDA(At, 1, 0); PG8_STAGE(PG8_SA(0, 1), a2 + hstep, voffA);
            PG8_WAIT_L(8); PG8_BAR; PG8_WAIT_L(0); PG8_MMA(0, 0, At, B0); PG8_BAR; PG8_SCHED;
            PG8_LDB(B1, 1, 1); PG8_STAGE(PG8_SB(1, 0), b3, voffB);
            PG8_BAR; PG8_WAIT_L(0); PG8_MMA(0, 1, At, B1); PG8_BAR;
            PG8_LDA(At, 1, 1); PG8_STAGE(PG8_SA(1, 0), a3, voffA);
            PG8_BAR; PG8_WAIT_L(0); PG8_MMA(1, 0, At, B0); PG8_BAR; PG8_SCHED;
            PG8_STAGE(PG8_SB(1, 1), b3 + hstep, voffB);
            PG8_WAIT_V(6); PG8_BAR; PG8_MMA(1, 1, At, B1); PG8_BAR;
        }
        PG8_STAMP();
        if constexpr (!Epi::AFTER_DRAIN) { E(acc, cur, wr, wc, fr, fq); S.done(cur); }
        PG8_STAMP();
        if (!has_next) break;
#pragma unroll
        for (int a = 0; a < 2; ++a)
#pragma unroll
            for (int b = 0; b < 2; ++b)
#pragma unroll
                for (int m = 0; m < 4; ++m)
#pragma unroll
                    for (int n = 0; n < 2; ++n) acc[a][b][m][n] = (f32x4){0.f, 0.f, 0.f, 0.f};
        cur = nxt; cA = nA; cB = nB; ++ui;
    }
    PG8_WAIT_V(0);
    if (wr == 0) PG8_BAR;
    PG8_BAR;
    if constexpr (Epi::AFTER_DRAIN) { E.fused(acc, cur, wr, wc, fr, fq, lds, wid, lane); S.done(cur); }
    PG8_STAMP();
    if (STAMP && wid == 0) { stamps[lane] = lane < nts ? (((unsigned long long)(unsigned)ts_hi << 32) | (unsigned)ts_lo) : 0ull;
        if (lane == 62) stamps[62] = rt_entry; if (lane == 63) stamps[63] = (unsigned long long)wall_clock64(); }
#undef PG8_STAMP
#undef PG8_SA
#undef PG8_SB
#undef PG8_STAGE
#undef PG8_LDA
#undef PG8_LDB
#undef PG8_MMA
#undef PG8_WAIT_V
#undef PG8_WAIT_L
#undef PG8_BAR
#undef PG8_SCHED
}
}
#ifndef ATT_INLINE
#define ATT_INLINE __forceinline__
#endif
namespace att {
constexpr int D = 128, NW = 8, QBLK = 32, KVBLK = 64, LDQ = 512, LDO = DM;
constexpr float SCALE = 0.088388347648318440f;
constexpr float THR = 8.f;
constexpr size_t SHM_V = KVBLK * D * 2, SHM_K = KVBLK * D * 2, SHM_Q = 256 * D * 2, SHM_ATTN = 2 * SHM_V + 2 * SHM_K + NW * 64 * 4 + SHM_Q;
using bf16x8 = __attribute__((ext_vector_type(8))) short;
using s16x4  = __attribute__((ext_vector_type(4))) short;
using f32x16 = __attribute__((ext_vector_type(16))) float;
using u32x4  = __attribute__((ext_vector_type(4))) unsigned;
#define KSWZ(row, colB) ((row) * 256 + ((colB) ^ (((row) & 7) << 4)))
#define SBAR() __builtin_amdgcn_sched_barrier(0)
__device__ __forceinline__ int crow(int r, int hi) { return (r & 3) + 8 * (r >> 2) + 4 * hi; }
__device__ __forceinline__ unsigned cvtpk(float lo, float hi) { unsigned r; asm volatile("v_cvt_pk_bf16_f32 %0, %1, %2" : "=v"(r) : "v"(lo), "v"(hi)); return r; }

__device__ __forceinline__ void partialSM(f32x16& p0, f32x16& p1, float& m_reg, float& mn, float& alpha) {
  constexpr float C = SCALE * 1.4426950408889634f;
  float pmax = p0[0]; for (int r = 1; r < 16; ++r) pmax = fmaxf(pmax, p0[r]); for (int r = 0; r < 16; ++r) pmax = fmaxf(pmax, p1[r]);
  { auto rr = __builtin_amdgcn_permlane32_swap(__float_as_uint(pmax), __float_as_uint(pmax), false, false);
    pmax = fmaxf(__uint_as_float(rr[0]), __uint_as_float(rr[1])); }
  if (__builtin_expect(__all(pmax - m_reg <= THR / SCALE), 1)) { mn = m_reg; alpha = 1.f; }
  else { mn = fmaxf(m_reg, pmax); alpha = __builtin_amdgcn_exp2f((m_reg - mn) * C); m_reg = mn; }
  float mnC = -mn * C;
  for (int r = 0; r < 16; ++r) p0[r] = fmaf(p0[r], C, mnC); for (int r = 0; r < 16; ++r) p1[r] = fmaf(p1[r], C, mnC);
  for (int r = 0; r < 16; ++r) p0[r] = __builtin_amdgcn_exp2f(p0[r]);
}
__device__ __forceinline__ void finishSM(f32x16& p0, f32x16& p1, float alpha, float& l_reg, bf16x8& pa0, bf16x8& pa1, bf16x8& pa2, bf16x8& pa3) {
  for (int r = 0; r < 16; ++r) p1[r] = __builtin_amdgcn_exp2f(p1[r]);
  float ps = 0; for (int r = 0; r < 16; ++r) ps += p0[r]; for (int r = 0; r < 16; ++r) ps += p1[r];
  { auto rr = __builtin_amdgcn_permlane32_swap(__float_as_uint(ps), __float_as_uint(ps), false, false);
    ps = __uint_as_float(rr[0]) + __uint_as_float(rr[1]); }
  l_reg = l_reg * alpha + ps;
#define PK4(P, BASE, OUT) do { unsigned a0 = cvtpk(P[BASE + 0], P[BASE + 1]), a1 = cvtpk(P[BASE + 2], P[BASE + 3]);   \
    unsigned b0 = cvtpk(P[BASE + 4], P[BASE + 5]), b1 = cvtpk(P[BASE + 6], P[BASE + 7]);                              \
    auto r0 = __builtin_amdgcn_permlane32_swap(a0, b0, false, false); auto r1 = __builtin_amdgcn_permlane32_swap(a1, b1, false, false); \
    u32x4 w = {r0[0], r1[0], r0[1], r1[1]}; OUT = *reinterpret_cast<bf16x8*>(&w); } while (0)
  PK4(p0, 0, pa0); PK4(p0, 8, pa1); PK4(p1, 0, pa2); PK4(p1, 8, pa3);
#undef PK4
}
__device__ __forceinline__ void qkt(f32x16& p0, f32x16& p1, const bf16_t* Ks, const bf16_t* Qs, int qrow, int r32, int hi) {
  p0 = f32x16{}; p1 = f32x16{};
#pragma unroll
  for (int d0 = 0; d0 < 8; ++d0) { int cb = (d0 * 16 + hi * 8) * 2;
    bf16x8 q = *reinterpret_cast<const bf16x8*>((const char*)Qs + KSWZ(qrow, cb));
    bf16x8 b0 = *reinterpret_cast<const bf16x8*>((const char*)Ks + KSWZ(r32, cb));
    bf16x8 b1 = *reinterpret_cast<const bf16x8*>((const char*)Ks + KSWZ(32 + r32, cb));
    p0 = __builtin_amdgcn_mfma_f32_32x32x16_bf16(b0, q, p0, 0, 0, 0);
    p1 = __builtin_amdgcn_mfma_f32_32x32x16_bf16(b1, q, p1, 0, 0, 0); }
}
__device__ __forceinline__ int v_st(int k, int c) { const int kk = (k & ~0xC) | ((k & 4) << 1) | ((k & 8) >> 1); return ((kk >> 3) * 4 + (c >> 5)) * 512 + ((kk & 7) * 32 + (c & 31)) * 2; }
__device__ __forceinline__ int v_rd_base(int lane) { return ((lane & 3) << 3) | (((lane >> 2) & 3) << 6) | (((lane >> 4) & 1) << 5) | (((lane >> 5) & 1) << 8); }
constexpr int v_rd_off(int d0, int ks, int half) { return d0 * 512 + ks * 4096 + half * 2048; }
template <int OFF> __device__ __forceinline__ s16x4 tr_read(int vb) {
  s16x4 r; asm volatile("ds_read_b64_tr_b16 %0, %1 offset:%2" : "=&v"(r) : "v"(vb), "i"(OFF) : "memory"); return r;
}
template <int D0> __device__ __forceinline__ void pv_one(f32x16& od, int vb, bf16x8 pa0, bf16x8 pa1, bf16x8 pa2, bf16x8 pa3) {
  const s16x4 l0 = tr_read<v_rd_off(D0, 0, 0)>(vb), h0 = tr_read<v_rd_off(D0, 0, 1)>(vb), l1 = tr_read<v_rd_off(D0, 1, 0)>(vb), h1 = tr_read<v_rd_off(D0, 1, 1)>(vb);
  const s16x4 l2 = tr_read<v_rd_off(D0, 2, 0)>(vb), h2 = tr_read<v_rd_off(D0, 2, 1)>(vb), l3 = tr_read<v_rd_off(D0, 3, 0)>(vb), h3 = tr_read<v_rd_off(D0, 3, 1)>(vb);
  asm volatile("s_waitcnt lgkmcnt(0)" ::: "memory"); SBAR();
#define PK(L, H) (bf16x8){L[0], L[1], L[2], L[3], H[0], H[1], H[2], H[3]}
  od = __builtin_amdgcn_mfma_f32_32x32x16_bf16(pa0, PK(l0, h0), od, 0, 0, 0);
  od = __builtin_amdgcn_mfma_f32_32x32x16_bf16(pa1, PK(l1, h1), od, 0, 0, 0);
  od = __builtin_amdgcn_mfma_f32_32x32x16_bf16(pa2, PK(l2, h2), od, 0, 0, 0);
  od = __builtin_amdgcn_mfma_f32_32x32x16_bf16(pa3, PK(l3, h3), od, 0, 0, 0);
#undef PK
}
__device__ __forceinline__ void pv_d0(f32x16* o, int vb, bf16x8 pa0, bf16x8 pa1, bf16x8 pa2, bf16x8 pa3) {
  pv_one<0>(o[0], vb, pa0, pa1, pa2, pa3); pv_one<1>(o[1], vb, pa0, pa1, pa2, pa3); pv_one<2>(o[2], vb, pa0, pa1, pa2, pa3); pv_one<3>(o[3], vb, pa0, pa1, pa2, pa3);
}

struct SrcOne { const bf16_t* k0; const bf16_t* v0; int ldk;
  __device__ __forceinline__ const bf16_t* k(int j) const { return k0 + (size_t)j * 64 * ldk; }
  __device__ __forceinline__ const bf16_t* v(int j) const { return v0 + (size_t)j * 64 * ldk; } };
struct SrcTwo { const bf16_t* ck; const bf16_t* cv; const bf16_t* k1; const bf16_t* v1; int ldk;
  __device__ __forceinline__ const bf16_t* k(int j) const { return j < 4 ? ck + (size_t)j * 64 * ldk : k1 + (size_t)(j - 4) * 64 * ldk; }
  __device__ __forceinline__ const bf16_t* v(int j) const { return j < 4 ? cv + (size_t)j * 64 * ldk : v1 + (size_t)(j - 4) * 64 * ldk; } };
struct NoBias { __device__ __forceinline__ void operator()(f32x16&, f32x16&, int, int, int, int) const {} };
struct NaBias { const float* tab; int i0, kr0;
  __device__ __forceinline__ void operator()(f32x16& p0, f32x16& p1, int jt, int wid, int r32, int hi) const {
    if (jt < 4) return;
    const int qi = i0 + wid * QBLK + r32, r = qi >> 6, qc = qi & 63, kr = kr0 + jt - 4;
    int lo = r - 4; lo = lo < 0 ? 0 : (lo > 8 ? 8 : lo);
    const bool rowok = (kr >= lo) && (kr < lo + 8);
    if (!rowok) {
#pragma unroll
      for (int rr = 0; rr < 16; ++rr) { p0[rr] = -1e30f; p1[rr] = -1e30f; }
      return;
    }
    int c0 = qc - 8; c0 = c0 < 0 ? 0 : (c0 > 48 ? 48 : c0);
    const int dr = kr - r + 7;
    const float* tb = tab + dr * 31 + (4 * hi - qc + 15);
    const int w0 = 4 * hi - c0;
#pragma unroll
    for (int g = 0; g < 4; ++g) {
#pragma unroll
      for (int q = 0; q < 4; ++q) {
        const int rr = 4 * g + q, kc0 = q + 8 * g;
        const float t0 = tb[kc0], t1 = tb[kc0 + 32];
        p0[rr] = ((unsigned)(kc0 + w0) < 16u) ? p0[rr] + t0 : -1e30f;
        p1[rr] = ((unsigned)(kc0 + 32 + w0) < 16u) ? p1[rr] + t1 : -1e30f;
      }
      SBAR();
    }
  } };

template <int SD, class Src, class Bias>
__device__ ATT_INLINE void attn_body(const bf16_t* __restrict__ Qb, const Src src, bf16_t* __restrict__ Ob, const int NT, char* lds, const Bias bias) {
  const int tid = opaque_tid(), wid = tid >> 6, lane = tid & 63, r32 = lane & 31, hi = lane >> 5;
  const int LDK = src.ldk;
  bf16_t* V_lds = (bf16_t*)lds; bf16_t* K_lds = (bf16_t*)(lds + 2 * SHM_V);
  float* ws = (float*)(lds + 2 * SHM_V + 2 * SHM_K) + wid * 64; float* li_l = ws; float* al_l = ws + 32;
  float m_reg = -1e30f, l_reg = 0; f32x16 o[4] = {};
  bf16_t* Q_lds = (bf16_t*)(lds + 2 * SHM_V + 2 * SHM_K + NW * 64 * 4);
  const int qrow = wid * QBLK + r32;
  {
#pragma unroll
    for (int i = 0; i < 8; ++i) { const int f = tid + 512 * i, row = f >> 4, c8 = (f & 15) * 8;
      *(bf16x8*)((char*)Q_lds + KSWZ(row, c8 * 2)) = *reinterpret_cast<const bf16x8*>(Qb + (long)row * LDQ + c8); }
  }
  const int sr = tid >> 4, sc = (tid & 15) * 8, vst0 = v_st(sr, sc), vst1 = v_st(32 + sr, sc);
  const int vb0 = (int)(uintptr_t)V_lds + v_rd_base(lane);
  struct { bf16x8 vs0, vs1, ks0, ks1; } sr_[SD];
#define SLOAD(i, jt) do { const bf16_t* kt_ = src.k(jt); const bf16_t* vt_ = src.v(jt); \
    sr_[i].vs0 = *reinterpret_cast<const bf16x8*>(&vt_[(long)sr * LDK + sc]); sr_[i].vs1 = *reinterpret_cast<const bf16x8*>(&vt_[(long)(32 + sr) * LDK + sc]); \
    sr_[i].ks0 = *reinterpret_cast<const bf16x8*>(&kt_[(long)sr * LDK + sc]); sr_[i].ks1 = *reinterpret_cast<const bf16x8*>(&kt_[(long)(32 + sr) * LDK + sc]); } while (0)
#define SWRITE(b, i) do { *(bf16x8*)((char*)V_lds + (b) * SHM_V + vst0) = sr_[i].vs0;          \
    *(bf16x8*)((char*)V_lds + (b) * SHM_V + vst1) = sr_[i].vs1; int kc = sc * 2;               \
    *(bf16x8*)((char*)K_lds + (b) * SHM_K + KSWZ(sr, kc)) = sr_[i].ks0;                       \
    *(bf16x8*)((char*)K_lds + (b) * SHM_K + KSWZ(32 + sr, kc)) = sr_[i].ks1; } while (0)
#define SWAIT() do { if constexpr (SD == 2) asm volatile("s_waitcnt vmcnt(4)" ::: "memory"); else asm volatile("s_waitcnt vmcnt(0)" ::: "memory"); } while (0)
#define RESC(a) do { if (__any((a) < 1.f)) { if (hi == 0) al_l[r32] = (a); asm volatile("s_waitcnt lgkmcnt(0)" ::: "memory"); \
    for (int d = 0; d < 4; ++d) for (int r = 0; r < 16; ++r) o[d][r] *= al_l[crow(r, hi)]; } } while (0)
  f32x16 pA0, pA1, pB0, pB1; float mnA, mnB, alA, alB; bf16x8 pa0, pa1, pa2, pa3;
  constexpr int SE = 0, SO = SD - 1;
  SLOAD(SE, 0); asm volatile("s_waitcnt vmcnt(0)" ::: "memory"); SWRITE(0, SE); __syncthreads();
  qkt(pA0, pA1, K_lds, Q_lds, qrow, r32, hi); bias(pA0, pA1, 0, wid, r32, hi); partialSM(pA0, pA1, m_reg, mnA, alA);
  SLOAD(SO, 1); if constexpr (SD == 2) { if (2 < NT) SLOAD(SE, 2); }
  SWAIT(); SWRITE(1, SO); __syncthreads();
  for (int j = 1; j + 1 < NT; j += 2) {
    SBAR(); qkt(pB0, pB1, (bf16_t*)((char*)K_lds + SHM_K), Q_lds, qrow, r32, hi); bias(pB0, pB1, j, wid, r32, hi);
    finishSM(pA0, pA1, alA, l_reg, pa0, pa1, pa2, pa3); SBAR();
    SLOAD(SO, j + SD); SBAR();
    pv_d0(o, vb0, pa0, pa1, pa2, pa3); partialSM(pB0, pB1, m_reg, mnB, alB);
    __syncthreads(); SWAIT(); SWRITE(0, SE);
    RESC(alB); __syncthreads();
    SBAR(); qkt(pA0, pA1, K_lds, Q_lds, qrow, r32, hi); bias(pA0, pA1, j + 1, wid, r32, hi);
    finishSM(pB0, pB1, alB, l_reg, pa0, pa1, pa2, pa3); SBAR();
    if (SD == 1 || j + 3 < NT) SLOAD(SE, j + 1 + SD); SBAR();
    pv_d0(o, vb0 + (int)SHM_V, pa0, pa1, pa2, pa3); partialSM(pA0, pA1, m_reg, mnA, alA);
    __syncthreads(); SWAIT(); SWRITE(1, SO);
    RESC(alA); __syncthreads();
  }
  SBAR(); qkt(pB0, pB1, (bf16_t*)((char*)K_lds + SHM_K), Q_lds, qrow, r32, hi); bias(pB0, pB1, NT - 1, wid, r32, hi);
  finishSM(pA0, pA1, alA, l_reg, pa0, pa1, pa2, pa3); SBAR();
  pv_d0(o, vb0, pa0, pa1, pa2, pa3); partialSM(pB0, pB1, m_reg, mnB, alB);
  __syncthreads(); RESC(alB);
  finishSM(pB0, pB1, alB, l_reg, pa0, pa1, pa2, pa3); SBAR();
  pv_d0(o, vb0 + (int)SHM_V, pa0, pa1, pa2, pa3);
  if (hi == 0) li_l[r32] = l_reg; asm volatile("s_waitcnt lgkmcnt(0)" ::: "memory");
  float rli[16];
#pragma unroll
  for (int r = 0; r < 16; ++r) rli[r] = __builtin_amdgcn_rcpf(li_l[crow(r, hi)]);
  bf16_t* Ow = Ob + (long)(wid * QBLK) * LDO;
#pragma unroll
  for (int r = 0; r < 16; ++r) { int orow = crow(r, hi);
    for (int d0 = 0; d0 < 4; ++d0) Ow[(long)orow * LDO + d0 * 32 + r32] = f2bf(o[d0][r] * rli[r]); }
#undef SLOAD
#undef SWRITE
#undef SWAIT
#undef RESC
}
}
namespace gdn {
using att::bf16x8; using att::f32x16; using att::crow;
constexpr int C = 32, SK = 136, SS = 40;
constexpr int OFF_KT = 0, OFF_QT = OFF_KT + C * SK * 2, OFF_W = OFF_QT + C * SK * 2, OFF_KTT = OFF_W + C * SK * 2, OFF_VTT = OFF_KTT + 128 * SS * 2,
              OFF_VN = OFF_VTT + 128 * SS * 2, OFF_VNS = OFF_VN + 128 * SS * 2, OFF_ST = OFF_VNS + 128 * SS * 2, OFF_TB = OFF_ST + 128 * SK * 2,
              OFF_TBE = OFF_TB + C * SS * 2, OFF_ATT = OFF_TBE + C * SS * 2, OFF_L = OFF_ATT + C * SS * 2, OFF_SC = OFF_L + C * C * 4, GDN_LDS = OFF_SC + 1024;
template <int K>
__device__ __forceinline__ f32x16 mm(const bf16_t* A, int lda, const bf16_t* Bt, int ldb, int l32, int hi, f32x16 acc) {
#pragma unroll
    for (int k0 = 0; k0 < K; k0 += 16) {
        const bf16x8 a = *reinterpret_cast<const bf16x8*>(A + l32 * lda + k0 + 8 * hi);
        const bf16x8 b = *reinterpret_cast<const bf16x8*>(Bt + l32 * ldb + k0 + 8 * hi);
        acc = __builtin_amdgcn_mfma_f32_32x32x16_bf16(a, b, acc, 0, 0, 0);
    }
    return acc;
}
__device__ __forceinline__ uint2 pk4(float a, float b, float c, float d) { uint2 w; w.x = pack2(a, b); w.y = pack2(c, d); return w; }

__device__ __forceinline__ void gdn_chunked(const Params& p, int l, bool ctx, int b, int h, int dir, unsigned char* lds) {
    const int tid = opaque_tid(), wid = tid >> 6, lane = tid & 63, l32 = lane & 31, hi = lane >> 5;
    const int T = ctx ? CT : ::LT; const size_t m0 = ctx ? (size_t)b * CT : (size_t)MC + (size_t)b * ::LT;
    const float* DQ = WSP(float, WS_DQ); const float* DK = WSP(float, WS_DK); const float* DV = WSP(float, WS_DV); const float* DBA = WSP(float, WS_DBA);
    float* O = WSP(float, dir ? WS_DOB : WS_DOF);
    bf16_t* Kt = (bf16_t*)(lds + OFF_KT); bf16_t* Qt = (bf16_t*)(lds + OFF_QT); bf16_t* W = (bf16_t*)(lds + OFF_W); bf16_t* KT = (bf16_t*)(lds + OFF_KTT); bf16_t* VT = (bf16_t*)(lds + OFF_VTT);
    bf16_t* VN = (bf16_t*)(lds + OFF_VN); bf16_t* VNS = (bf16_t*)(lds + OFF_VNS); bf16_t* ST = (bf16_t*)(lds + OFF_ST); bf16_t* TB = (bf16_t*)(lds + OFF_TB); bf16_t* TBE = (bf16_t*)(lds + OFF_TBE);
    bf16_t* ATT = (bf16_t*)(lds + OFF_ATT); float* Lm = (float*)(lds + OFF_L); float* sc = (float*)(lds + OFF_SC);
    const int nch = T / C;
#define TOK(c, s_) (m0 + (dir ? T - 1 - ((c) * C + (s_)) : (c) * C + (s_)))
    f32x16 S[2];
#pragma unroll
    for (int bi = 0; bi < 2; ++bi) {
        const int blk = wid * 2 + bi, d0 = 32 * (blk >> 2), e0 = 32 * (blk & 3);
        if (ctx) { S[bi] = f32x16{}; }
        else {
            const float* s0 = p.in[I_SGDN] + ((((size_t)b * DEPTH + l) * 2 + dir) * 4 + h) * 128 * 128 + e0 + l32;
#pragma unroll
            for (int r = 0; r < 16; ++r) S[bi][r] = s0[(size_t)(d0 + crow(r, hi)) * 128];
        }
    }
    const int ls = tid >> 5, lc = (tid & 31) * 4;
    vf4 pq0, pq1, pk0, pk1, pv0, pv1; float pbeta = 0.f, pg = 0.f;
#define GLOAD(c) do { const size_t ma = TOK(c, ls), mb = TOK(c, ls + 16); \
        pq0 = *(const vf4*)(DQ + ma * 512 + h * 128 + lc); pq1 = *(const vf4*)(DQ + mb * 512 + h * 128 + lc); \
        pk0 = *(const vf4*)(DK + ma * 512 + h * 128 + lc); pk1 = *(const vf4*)(DK + mb * 512 + h * 128 + lc); \
        pv0 = *(const vf4*)(DV + ma * 512 + h * 128 + lc); pv1 = *(const vf4*)(DV + mb * 512 + h * 128 + lc); \
        if (tid < C) { const size_t mt = TOK(c, tid); pbeta = DBA[mt * 16 + dir * 4 + h]; pg = DBA[mt * 16 + 8 + dir * 4 + h]; } } while (0)
#define GSTAGE() do { \
        *(uint2*)(Kt + ls * SK + lc) = pk4(pk0.x, pk0.y, pk0.z, pk0.w); *(uint2*)(Kt + (ls + 16) * SK + lc) = pk4(pk1.x, pk1.y, pk1.z, pk1.w); \
        *(uint2*)(Qt + ls * SK + lc) = pk4(pq0.x, pq0.y, pq0.z, pq0.w); *(uint2*)(Qt + (ls + 16) * SK + lc) = pk4(pq1.x, pq1.y, pq1.z, pq1.w); \
        _Pragma("unroll") for (int j = 0; j < 4; ++j) { KT[(lc + j) * SS + ls] = f2bf(pk0[j]); KT[(lc + j) * SS + ls + 16] = f2bf(pk1[j]); \
                                                        VT[(lc + j) * SS + ls] = f2bf(pv0[j]); VT[(lc + j) * SS + ls + 16] = f2bf(pv1[j]); } \
        if (wid == 0) { float x = pg; _Pragma("unroll") for (int o_ = 1; o_ < 32; o_ <<= 1) { const float y = __shfl_up(x, o_); if (lane >= o_) x += y; } \
            const float Bt_ = __shfl(x, 31); if (lane < C) { sc[lane] = pbeta; sc[32 + lane] = x; sc[64 + lane] = __expf(x); sc[96 + lane] = __expf(Bt_ - x); if (lane == 0) sc[128] = __expf(Bt_); } } } while (0)
    __syncthreads();
    GLOAD(0);
#pragma unroll
    for (int bi = 0; bi < 2; ++bi) {
        const int blk = wid * 2 + bi, d0 = 32 * (blk >> 2), e0 = 32 * (blk & 3);
#pragma unroll
        for (int g = 0; g < 4; ++g) *(uint2*)(ST + (e0 + l32) * SK + d0 + 8 * g + 4 * hi) = pk4(S[bi][4 * g], S[bi][4 * g + 1], S[bi][4 * g + 2], S[bi][4 * g + 3]);
    }
    GSTAGE();
    __syncthreads();
    for (int c = 0; c < nch; ++c) {
        if (c + 1 < nch) GLOAD(c + 1);
        f32x16 acc1 = f32x16{};
        if (wid == 0) {
            const f32x16 kk = mm<128>(Kt, SK, Kt, SK, l32, hi, f32x16{});
            const float bi_ = sc[32 + l32], be = sc[l32];
#pragma unroll
            for (int r = 0; r < 16; ++r) { const int j = crow(r, hi); const float v = (l32 > j) ? be * kk[r] * __expf(bi_ - sc[32 + j]) : 0.f;
                Lm[l32 * 32 + ((r & 3) + 4 * hi) * 4 + (r >> 2)] = v; }
        } else if (wid == 1) {
            const f32x16 kq = mm<128>(Kt, SK, Qt, SK, l32, hi, f32x16{});
            const float bi_ = sc[32 + l32];
            float a[16];
#pragma unroll
            for (int r = 0; r < 16; ++r) { const int j = crow(r, hi); a[r] = (l32 >= j) ? kq[r] * __expf(bi_ - sc[32 + j]) : 0.f; }
#pragma unroll
            for (int g = 0; g < 4; ++g) *(uint2*)(ATT + l32 * SS + 8 * g + 4 * hi) = pk4(a[4 * g], a[4 * g + 1], a[4 * g + 2], a[4 * g + 3]);
        } else if (wid >= 4) {
            acc1 = mm<128>(Qt, SK, ST + (32 * (wid - 4)) * SK, SK, l32, hi, f32x16{});
#pragma unroll
            for (int r = 0; r < 16; ++r) acc1[r] *= sc[64 + crow(r, hi)];
        }
        __syncthreads();
        if (tid < 256) {
            const int cc = tid >> 3, part = tid & 7;
            float Tr[4] = {0.f, 0.f, 0.f, 0.f};
            const float* Lp = Lm + part * 4;
#pragma unroll
            for (int i = 0; i < 32; ++i) {
                const vf4 lv = *(const vf4*)(Lp + i * 32);
                float s = lv.x * Tr[0] + lv.y * Tr[1] + lv.z * Tr[2] + lv.w * Tr[3];
                s = red8(s);
                const float t = (i == cc ? 1.f : 0.f) - s;
                if (part == (i & 7)) Tr[i >> 3] = t;
            }
            const float bc = sc[cc], bec = bc * sc[64 + cc];
#pragma unroll
            for (int jj = 0; jj < 4; ++jj) { TB[(part + 8 * jj) * SS + cc] = f2bf(Tr[jj] * bc); TBE[(part + 8 * jj) * SS + cc] = f2bf(Tr[jj] * bec); }
        }
        __syncthreads();
        if (wid < 4) {
            acc1 = mm<32>(TB, SS, VT + (32 * wid) * SS, SS, l32, hi, f32x16{});
        } else {
            const int d0 = 32 * (wid - 4);
            const f32x16 wt = mm<32>(KT + d0 * SS, SS, TBE, SS, l32, hi, f32x16{});
#pragma unroll
            for (int g = 0; g < 4; ++g) *(uint2*)(W + l32 * SK + d0 + 8 * g + 4 * hi) = pk4(wt[4 * g], wt[4 * g + 1], wt[4 * g + 2], wt[4 * g + 3]);
        }
        __syncthreads();
        if (wid < 4) {
            const int e0 = 32 * wid;
            const f32x16 ws = mm<128>(W, SK, ST + e0 * SK, SK, l32, hi, f32x16{});
            float vn[16], vs[16];
#pragma unroll
            for (int r = 0; r < 16; ++r) { vn[r] = acc1[r] - ws[r]; vs[r] = vn[r] * sc[96 + crow(r, hi)]; }
#pragma unroll
            for (int g = 0; g < 4; ++g) { *(uint2*)(VN + (e0 + l32) * SS + 8 * g + 4 * hi) = pk4(vn[4 * g], vn[4 * g + 1], vn[4 * g + 2], vn[4 * g + 3]);
                                          *(uint2*)(VNS + (e0 + l32) * SS + 8 * g + 4 * hi) = pk4(vs[4 * g], vs[4 * g + 1], vs[4 * g + 2], vs[4 * g + 3]); }
        }
        __syncthreads();
        if (wid >= 4) {
            const int e0 = 32 * (wid - 4);
            acc1 = mm<32>(ATT, SS, VN + e0 * SS, SS, l32, hi, acc1);
#pragma unroll
            for (int r = 0; r < 16; ++r) O[TOK(c, crow(r, hi)) * 512 + h * 128 + e0 + l32] = acc1[r];
        }
        {
            const float eB = sc[128];
#pragma unroll
            for (int bi = 0; bi < 2; ++bi) {
                const int blk = wid * 2 + bi, d0 = 32 * (blk >> 2), e0 = 32 * (blk & 3);
#pragma unroll
                for (int r = 0; r < 16; ++r) S[bi][r] *= eB;
                S[bi] = mm<32>(KT + d0 * SS, SS, VNS + e0 * SS, SS, l32, hi, S[bi]);
            }
        }
        __syncthreads();
#pragma unroll
        for (int bi = 0; bi < 2; ++bi) {
            const int blk = wid * 2 + bi, d0 = 32 * (blk >> 2), e0 = 32 * (blk & 3);
#pragma unroll
            for (int g = 0; g < 4; ++g) *(uint2*)(ST + (e0 + l32) * SK + d0 + 8 * g + 4 * hi) = pk4(S[bi][4 * g], S[bi][4 * g + 1], S[bi][4 * g + 2], S[bi][4 * g + 3]);
        }
        if (c + 1 < nch) GSTAGE();
        __syncthreads();
    }
#undef GLOAD
#undef GSTAGE
#undef TOK
    if (ctx) {
#pragma unroll
        for (int bi = 0; bi < 2; ++bi) {
            const int blk = wid * 2 + bi, d0 = 32 * (blk >> 2), e0 = 32 * (blk & 3);
            float* so = p.out + O_SGDN + ((((size_t)b * DEPTH + l) * 2 + dir) * 4 + h) * 128 * 128 + e0 + l32;
#pragma unroll
            for (int r = 0; r < 16; ++r) so[(size_t)(d0 + crow(r, hi)) * 128] = S[bi][r];
        }
    }
}
}

namespace gla {
using att::bf16x8; using att::f32x16; using att::crow; using gdn::mm; using gdn::pk4;
constexpr int C = 32, SQ = 72, SS = 40;
constexpr int OFF_QE = 0, OFF_KN = OFF_QE + C * SQ * 2, OFF_KET = OFF_KN + C * SQ * 2, OFF_VT = OFF_KET + 64 * SS * 2, OFF_ATT = OFF_VT + 128 * SS * 2, OFF_ST = OFF_ATT + C * SS * 2,
              OFF_LA = OFF_ST + 128 * SQ * 2, OFF_EB = OFF_LA + C * 64 * 4, GLA_LDS = OFF_EB + 256;
__device__ __forceinline__ void gla_chunked(const Params& p, int l, bool ctx, int b, int h, int dir, unsigned char* lds) {
    const int tid = opaque_tid(), wid = tid >> 6, lane = tid & 63, l32 = lane & 31, hi = lane >> 5;
    const int T = ctx ? CT : ::LT; const size_t m0 = ctx ? (size_t)b * CT : (size_t)MC + (size_t)b * ::LT;
    const float* Z = WSP(float, WS_Z); const float* LA = WSP(float, dir ? WS_AB : WS_AF);
    float* O = WSP(float, dir ? WS_GOB : WS_GOF);
    bf16_t* Qe = (bf16_t*)(lds + OFF_QE); bf16_t* Kn = (bf16_t*)(lds + OFF_KN); bf16_t* KeT = (bf16_t*)(lds + OFF_KET); bf16_t* VT = (bf16_t*)(lds + OFF_VT);
    bf16_t* ATT = (bf16_t*)(lds + OFF_ATT); bf16_t* ST = (bf16_t*)(lds + OFF_ST); float* la = (float*)(lds + OFF_LA); float* eB = (float*)(lds + OFF_EB);
    const int nch = T / C;
#define TOK(c, s_) (m0 + (dir ? T - 1 - ((c) * C + (s_)) : (c) * C + (s_)))
    const int d0 = 32 * (wid >> 2), e0 = 32 * (wid & 3);
    f32x16 S;
    if (ctx) S = f32x16{};
    else {
        const float* s0 = p.in[I_SGLA] + ((((size_t)b * DEPTH + l) * 2 + dir) * 4 + h) * 64 * 128 + e0 + l32;
#pragma unroll
        for (int r = 0; r < 16; ++r) S[r] = s0[(size_t)(d0 + crow(r, hi)) * 128];
    }
    const int ts = tid >> 4, dc = (tid & 15) * 4, vs = tid >> 5, vc = (tid & 31) * 4;
    vf4 pq, pk, pl, pv0, pv1;
#define GLOAD(c) do { const size_t mt = TOK(c, ts), ma = TOK(c, vs), mb = TOK(c, vs + 16); \
        pq = *(const vf4*)(Z + mt * NINP + Z_GLQ + h * 64 + dc); pk = *(const vf4*)(Z + mt * NINP + Z_GLK + h * 64 + dc); pl = *(const vf4*)(LA + mt * 256 + h * 64 + dc); \
        pv0 = *(const vf4*)(Z + ma * NINP + Z_GLV + h * 128 + vc); pv1 = *(const vf4*)(Z + mb * NINP + Z_GLV + h * 128 + vc); } while (0)
#define WRITE_ST() do { _Pragma("unroll") for (int g = 0; g < 4; ++g) *(uint2*)(ST + (e0 + l32) * SQ + d0 + 8 * g + 4 * hi) = pk4(S[4 * g], S[4 * g + 1], S[4 * g + 2], S[4 * g + 3]); } while (0)
#define GIMAGES() do { vf4 pre = (vf4){0.f, 0.f, 0.f, 0.f}, tot = pre; \
        _Pragma("unroll 8") for (int t_ = 0; t_ < C; ++t_) { const vf4 v_ = *(const vf4*)(la + t_ * 64 + dc); tot += v_; if (t_ <= ts) pre += v_; } \
        float qe[4], kn[4]; \
        _Pragma("unroll") for (int j = 0; j < 4; ++j) { qe[j] = pq[j] * 0.125f * __expf(pre[j]); kn[j] = pk[j] * __expf(fminf(-pre[j], 80.f)); \
            KeT[(dc + j) * SS + ts] = f2bf(pk[j] * __expf(tot[j] - pre[j])); } \
        *(uint2*)(Qe + ts * SQ + dc) = pk4(qe[0], qe[1], qe[2], qe[3]); *(uint2*)(Kn + ts * SQ + dc) = pk4(kn[0], kn[1], kn[2], kn[3]); \
        if (ts == 0) { _Pragma("unroll") for (int j = 0; j < 4; ++j) eB[dc + j] = __expf(tot[j]); } \
        _Pragma("unroll") for (int j = 0; j < 4; ++j) { VT[(vc + j) * SS + vs] = f2bf(pv0[j]); VT[(vc + j) * SS + vs + 16] = f2bf(pv1[j]); } } while (0)
    __syncthreads();
    GLOAD(0);
    WRITE_ST();
    *(vf4*)(la + ts * 64 + dc) = pl;
    __syncthreads();
    GIMAGES();
    __syncthreads();
    for (int c = 0; c < nch; ++c) {
        if (c + 1 < nch) GLOAD(c + 1);
        f32x16 o1 = f32x16{};
        if (wid == 0) {
            const f32x16 kq = mm<64>(Kn, SQ, Qe, SQ, l32, hi, f32x16{});
            float a[16];
#pragma unroll
            for (int r = 0; r < 16; ++r) a[r] = (l32 >= crow(r, hi)) ? kq[r] : 0.f;
#pragma unroll
            for (int g = 0; g < 4; ++g) *(uint2*)(ATT + l32 * SS + 8 * g + 4 * hi) = pk4(a[4 * g], a[4 * g + 1], a[4 * g + 2], a[4 * g + 3]);
        } else if (wid >= 4) {
            o1 = mm<64>(Qe, SQ, ST + (32 * (wid - 4)) * SQ, SQ, l32, hi, f32x16{});
        }
        __syncthreads();
        if (wid >= 4) {
            const int eo = 32 * (wid - 4);
            o1 = mm<32>(ATT, SS, VT + eo * SS, SS, l32, hi, o1);
#pragma unroll
            for (int r = 0; r < 16; ++r) O[TOK(c, crow(r, hi)) * 512 + h * 128 + eo + l32] = o1[r];
        }
#pragma unroll
        for (int r = 0; r < 16; ++r) S[r] *= eB[d0 + crow(r, hi)];
        S = mm<32>(KeT + d0 * SS, SS, VT + e0 * SS, SS, l32, hi, S);
        __syncthreads();
        WRITE_ST();
        if (c + 1 < nch) *(vf4*)(la + ts * 64 + dc) = pl;
        __syncthreads();
        if (c + 1 < nch) GIMAGES();
        __syncthreads();
    }
#undef GLOAD
#undef WRITE_ST
#undef GIMAGES
#undef TOK
    if (ctx) {
        float* so = p.out + O_SGLA + ((((size_t)b * DEPTH + l) * 2 + dir) * 4 + h) * 64 * 128 + e0 + l32;
#pragma unroll
        for (int r = 0; r < 16; ++r) so[(size_t)(d0 + crow(r, hi)) * 128] = S[r];
    }
}
}
#define LAS __attribute__((address_space(3)))
constexpr int LDS_BYTES = 147456, XBW_OFF = LDS_BYTES - 64;
constexpr int NPH = 1 + DEPTH * 12;
#ifndef DBG_NLAYERS
#define DBG_NLAYERS DEPTH
#endif

#ifndef DUPKIND
#define DUPKIND 0
#endif
__device__ __forceinline__ int opaque_int(int v) { asm volatile("" : "+s"(v)); return v; }
#ifndef MIXMASK
#define MIXMASK 0xFF
#endif
#define FOR_ITEMS(it, n, o, w) for (int bo_ = (o) * (int)gridDim.x / 256, bw_ = ((w) * (int)gridDim.x / 256) > 0 ? ((w) * (int)gridDim.x / 256) : 1, \
                                    it = ((int)blockIdx.x >= bo_ && (int)blockIdx.x < bo_ + bw_) ? (int)blockIdx.x - bo_ : (n); it < (n); it += bw_)

#ifndef SPLITK
#define SPLITK 0
#endif
constexpr int FLAG_WORD0 = 8192;
constexpr int QCTR_WORD0 = 1024;
constexpr int NI_GDNL = LB * 8, NI_GLAL = LB * 8, NI_GDNC = CB * 8, NI_GQAL = LB * 16, NI_NAL = LB * 16, NI_GLAC = CB * 8, NI_NAC = CB * 4, NI_GQAC = CB * 4;
#define KM(k) (1 + ((DUPKIND >> (k)) & 1))
constexpr int Q0 = NI_GDNL * KM(0), Q1 = Q0 + NI_GLAL * KM(1), Q2 = Q1 + NI_GDNC * KM(2), Q3 = Q2 + NI_GQAL * KM(3), Q4 = Q3 + NI_NAL * KM(4), Q5 = Q4 + NI_GLAC * KM(5), Q6 = Q5 + NI_NAC * KM(6), Q7 = Q6 + NI_GQAC * KM(7);
__device__ __forceinline__ void phase_mix(const Params& p, int l, unsigned char* lds, int rep) {
    const int tid = opaque_tid();
    float* smem = (float*)lds;
    const bf16_t* NAQ = WSP(bf16_t, WS_NAQ); const bf16_t* NAK = WSP(bf16_t, WS_NAK); const bf16_t* NAV = WSP(bf16_t, WS_NAV);
    const bf16_t* GQ = WSP(bf16_t, WS_GQ); const bf16_t* GK = WSP(bf16_t, WS_GK); const bf16_t* GV = WSP(bf16_t, WS_GV);
    bf16_t* MRG = WSP(bf16_t, WS_MRG);
    unsigned* qctr = WSP(unsigned, WS_CTL) + QCTR_WORD0 + 64 * l + 16 * rep;
    volatile int* qslot = (volatile int*)(lds + XBW_OFF + 16);
    for (;;) {
        __syncthreads();
        if (tid == 0) *qslot = (int)__hip_atomic_fetch_add(qctr, 1u, __ATOMIC_RELAXED, __HIP_MEMORY_SCOPE_AGENT);
        __syncthreads();
        const int q = __builtin_amdgcn_readfirstlane(*qslot);
        if (q >= Q7) break;
        if (q < Q0) { const int it = q % NI_GDNL; gdn::gdn_chunked(p, l, false, it / 8, (it / 2) % 4, it % 2, lds); }
        else if (q < Q1) { const int it = (q - Q0) % NI_GLAL; gla::gla_chunked(p, l, false, it / 8, (it / 2) % 4, it % 2, lds); }
        else if (q < Q2) { const int it = (q - Q1) % NI_GDNC; gdn::gdn_chunked(p, l, true, it / 8, (it / 2) % 4, it % 2, lds); }
        else if (q < Q3) {
            const int it = (q - Q2) % NI_GQAL, b = it / 16, qh = (it / 4) % 4, qb = it % 4, kvh = qh >> 1;
            const size_t r0 = (size_t)MC + (size_t)b * LT;
            att::SrcTwo src{WSP(bf16_t, WS_CGK) + ((size_t)b * DEPTH + l) * 256 * 256 + kvh * 128, WSP(bf16_t, WS_CGV) + ((size_t)b * DEPTH + l) * 256 * 256 + kvh * 128,
                            GK + r0 * 256 + kvh * 128, GV + r0 * 256 + kvh * 128, 256};
            att::attn_body<2>(GQ + (r0 + qb * 256) * 512 + qh * 128, src, MRG + (r0 + qb * 256) * DM + 1024 + qh * 128, 4 + LT / 64, (char*)lds, att::NoBias{});
        }
        else if (q < Q4) {
            const int it = (q - Q3) % NI_NAL, b = it / 16, h = (it / 4) % 4, qb = it % 4;
            const int kr0 = qb == 0 ? 0 : qb == 1 ? 0 : qb == 2 ? 4 : 8, nrows = (qb == 0 || qb == 3) ? 8 : 12;
            const size_t r0 = (size_t)MC + (size_t)b * LT;
            float* tab = (float*)(lds + att::SHM_ATTN);
            if (tid < 15 * 31) tab[tid] = p.in[I_RPB][((size_t)l * 4 + h) * 15 * 31 + tid] * (1.0f / att::SCALE);
            att::SrcTwo src{WSP(bf16_t, WS_CNAK) + ((size_t)b * DEPTH + l) * 256 * 512 + h * 128, WSP(bf16_t, WS_CNAV) + ((size_t)b * DEPTH + l) * 256 * 512 + h * 128,
                            NAK + (r0 + kr0 * 64) * 512 + h * 128, NAV + (r0 + kr0 * 64) * 512 + h * 128, 512};
            att::attn_body<1>(NAQ + (r0 + qb * 256) * 512 + h * 128, src, MRG + (r0 + qb * 256) * DM + 0 + h * 128, 4 + nrows, (char*)lds, att::NaBias{tab, qb * 256, kr0});
        }
        else if (q < Q5) { const int it = (q - Q4) % NI_GLAC; gla::gla_chunked(p, l, true, it / 8, (it / 2) % 4, it % 2, lds); }
        else if (q < Q6) {
            const int it = (q - Q5) % NI_NAC, b = it / 4, h = it % 4; const size_t r0 = (size_t)b * CT;
            att::SrcOne src{NAK + r0 * 512 + h * 128, NAV + r0 * 512 + h * 128, 512};
            att::attn_body<2>(NAQ + r0 * 512 + h * 128, src, MRG + r0 * DM + 0 + h * 128, CT / 64, (char*)lds, att::NoBias{});
        }
        else {
            const int it = (q - Q6) % NI_GQAC, b = it / 4, qh = it % 4, kvh = qh >> 1; const size_t r0 = (size_t)b * CT;
            att::SrcOne src{GK + r0 * 256 + kvh * 128, GV + r0 * 256 + kvh * 128, 256};
            att::attn_body<2>(GQ + r0 * 512 + qh * 128, src, MRG + r0 * DM + 1024 + qh * 128, CT / 64, (char*)lds, att::NoBias{});
        }
    }
}

static_assert(att::SHM_ATTN + 15 * 31 * 4 + 2048 <= (size_t)XBW_OFF, "LDS map");
static_assert((QCTR_WORD0 + 64 * DEPTH) < 4096, "ctl");
constexpr int BAR_WORD0 = 4096;
static_assert((BAR_WORD0 + XCD_BAR_WORDS) * 4 <= (int)CTL_BYTES, "ctl");

__global__ void __launch_bounds__(512, 2) fwd(Params p) {
    extern __shared__ __attribute__((aligned(16))) unsigned char lds[];
    const int tid = threadIdx.x;
    volatile LAS unsigned* xbw = (volatile LAS unsigned*)((LAS unsigned char*)lds + XBW_OFF);
    if (tid < 4) xbw[tid] = 0u;
    __syncthreads();
    XcdBarrier bar; bar.bar = WSP(unsigned, WS_CTL) + BAR_WORD0; bar.x = 0; bar.st = xbw;
    if (p.ph_hi - p.ph_lo > 1) bar = xcd_barrier_post(WSP(unsigned, WS_CTL) + BAR_WORD0, xbw);
#ifndef PHMASK
#define PHMASK 0x1FFF
#endif
#define IN(k) (p.ph_lo <= (k) && (k) < p.ph_hi)
#define INL(j) (((PHMASK >> ((j) + 1)) & 1) && IN(pb + (j)))
#ifndef DUPMASK
#define DUPMASK 0
#endif
#define DUP(j) ((DUPMASK >> ((j) + 1)) & 1)
#define SEAM(k) do { if (IN(k) && IN((k) + 1)) xcd_barrier(bar); } while (0)
    LAS unsigned char* ldsl = (LAS unsigned char*)lds;
    bf16_t* H = WSP(bf16_t, WS_H); bf16_t* ACT = WSP(bf16_t, WS_ACT); float* X = WSP(float, WS_X); float* Z = WSP(float, WS_Z); bf16_t* MRG = WSP(bf16_t, WS_MRG);

    if ((PHMASK & 1) && IN(0)) { int reps_ = 1 + (DUPMASK & 1); asm volatile("" : "+s"(reps_)); for (int rep_ = 0; rep_ < reps_; ++rep_) { const Params q = opaque_params(p); phase_prologue(q, (float*)lds); __syncthreads(); } }
    SEAM(0);
    for (int l = 0; l < DBG_NLAYERS; ++l) {
        const int pb = 1 + l * 12;
        const float* modl = WSP(float, WS_MODV) + (size_t)l * NCOND * NMOD;
        if (INL(0)) { int reps_ = 1 + DUP(0); asm volatile("" : "+s"(reps_)); for (int rep_ = 0; rep_ < reps_; ++rep_) { const Params q = opaque_params(p); phase_norm(q, l, 0); __syncthreads(); } }
        SEAM(pb + 0);
        if (INL(1)) {
            pg8::Gemm g{H, WSP(bf16_t, WS_WGU) + ((size_t)l * 2 + 0) * NGU * DM, M, NGU, DM}; pg8::StaticOrder S; S.init(M, NGU, DM, (int)gridDim.x, (int)blockIdx.x);
            pg8::EpiSwiGLU E{ACT, FF};
            for (int r_ = 0, n_ = opaque_int(1 + DUP(1)); r_ < n_; ++r_) pg8::gemm_phase<pg8::EpiSwiGLU, pg8::StaticOrder, false>(ldsl, g, S, E, nullptr);
        }
        SEAM(pb + 1);
        if (INL(2)) {
            pg8::Gemm g{ACT, WSP(bf16_t, WS_WDN) + ((size_t)l * 2 + 0) * DM * FF, M, DM, FF}; pg8::StaticOrder S; S.init(M, DM, FF, (int)gridDim.x, (int)blockIdx.x, SPLITK);
            pg8::EpiResid E{X, X, DM, modl + 2 * DM, 0.5f, Z, WSP(unsigned, WS_CTL) + FLAG_WORD0, 8u * (unsigned)(l * 3 + 1)};
            pg8::gemm_phase<pg8::EpiResid, pg8::StaticOrder, false>(ldsl, g, S, E, nullptr);
            if (opaque_int(DUP(2))) { pg8::EpiResid E2{X, Z, DM, modl + 2 * DM, 0.5f, Z, WSP(unsigned, WS_CTL) + FLAG_WORD0, 0u}; pg8::gemm_phase<pg8::EpiResid, pg8::StaticOrder, false>(ldsl, g, S, E2, nullptr); }
        }
        SEAM(pb + 2);
        if (INL(3)) { int reps_ = 1 + DUP(3); asm volatile("" : "+s"(reps_)); for (int rep_ = 0; rep_ < reps_; ++rep_) { const Params q = opaque_params(p); phase_norm(q, l, 1); __syncthreads(); } }
        SEAM(pb + 3);
        if (INL(4)) {
            pg8::Gemm g{H, WSP(bf16_t, WS_WIN) + (size_t)l * NINP * DM, M, NINP, DM}; pg8::StaticOrder S; S.init(M, NINP, DM, (int)gridDim.x, (int)blockIdx.x);
            pg8::EpiF32 E{Z, NINP, nullptr};
            for (int r_ = 0, n_ = opaque_int(1 + DUP(4)); r_ < n_; ++r_) pg8::gemm_phase<pg8::EpiF32, pg8::StaticOrder, false>(ldsl, g, S, E, nullptr);
        }
        SEAM(pb + 4);
        if (INL(5)) { int reps_ = 1 + DUP(5); asm volatile("" : "+s"(reps_)); for (int rep_ = 0; rep_ < reps_; ++rep_) { const Params q = opaque_params(p); phase_prep(q, l); __syncthreads(); } }
        SEAM(pb + 5);
        if (INL(6)) { int reps_ = 1 + DUP(6); asm volatile("" : "+s"(reps_)); for (int rep_ = 0; rep_ < reps_; ++rep_) { const Params q = opaque_params(p); phase_mix(q, l, lds, rep_); __syncthreads(); } }
        SEAM(pb + 6);
        if (INL(7)) { int reps_ = 1 + DUP(7); asm volatile("" : "+s"(reps_)); for (int rep_ = 0; rep_ < reps_; ++rep_) { const Params q = opaque_params(p); phase_post(q, l); __syncthreads(); } }
        SEAM(pb + 7);
        if (INL(8)) {
            pg8::Gemm g{MRG, WSP(bf16_t, WS_WOUT) + (size_t)l * DM * DM, M, DM, DM}; pg8::StaticOrder S; S.init(M, DM, DM, (int)gridDim.x, (int)blockIdx.x, SPLITK);
            pg8::EpiResid E{X, X, DM, modl + 5 * DM, 1.0f, Z, WSP(unsigned, WS_CTL) + FLAG_WORD0, 8u * (unsigned)(l * 3 + 2)};
            pg8::gemm_phase<pg8::EpiResid, pg8::StaticOrder, false>(ldsl, g, S, E, nullptr);
            if (opaque_int(DUP(8))) { pg8::EpiResid E2{X, Z, DM, modl + 5 * DM, 1.0f, Z, WSP(unsigned, WS_CTL) + FLAG_WORD0, 0u}; pg8::gemm_phase<pg8::EpiResid, pg8::StaticOrder, false>(ldsl, g, S, E2, nullptr); }
        }
        SEAM(pb + 8);
        if (INL(9)) { int reps_ = 1 + DUP(9); asm volatile("" : "+s"(reps_)); for (int rep_ = 0; rep_ < reps_; ++rep_) { const Params q = opaque_params(p); phase_norm(q, l, 2); __syncthreads(); } }
        SEAM(pb + 9);
        if (INL(10)) {
            pg8::Gemm g{H, WSP(bf16_t, WS_WGU) + ((size_t)l * 2 + 1) * NGU * DM, M, NGU, DM}; pg8::StaticOrder S; S.init(M, NGU, DM, (int)gridDim.x, (int)blockIdx.x);
            pg8::EpiSwiGLU E{ACT, FF};
            pg8::gemm_phase<pg8::EpiSwiGLU, pg8::StaticOrder, false>(ldsl, g, S, E, nullptr);
        }
        SEAM(pb + 10);
        if (INL(11)) {
            pg8::Gemm g{ACT, WSP(bf16_t, WS_WDN) + ((size_t)l * 2 + 1) * DM * FF, M, DM, FF}; pg8::StaticOrder S; S.init(M, DM, FF, (int)gridDim.x, (int)blockIdx.x, SPLITK);
            pg8::EpiResid E{X, (l == DEPTH - 1) ? p.out : X, DM, modl + 8 * DM, 0.5f, Z, WSP(unsigned, WS_CTL) + FLAG_WORD0, 8u * (unsigned)(l * 3 + 3)};
            pg8::gemm_phase<pg8::EpiResid, pg8::StaticOrder, false>(ldsl, g, S, E, nullptr);
        }
        SEAM(pb + 11);
    }
#undef IN
#undef SEAM
}

#ifndef MULTI_LAUNCH
#define MULTI_LAUNCH 0
#endif
extern "C" void kernel_launch(void* const* d_in, const int* in_sizes, int n_in, void* d_out, int out_size, void* d_ws, size_t ws_size, hipStream_t stream) {
    static int grid = 0;
    if (grid == 0) {
        if (n_in != N_IN || (size_t)out_size != O_END || ws_size < WS_END) { fprintf(stderr, "kernel_launch: shape mismatch n_in %d out %d ws %zu (need %zu)\n", n_in, out_size, ws_size, (size_t)WS_END); grid = -1; return; }
        int dev = 0, cus = 0, per_cu = 0;
        if (hipGetDevice(&dev) != hipSuccess || hipDeviceGetAttribute(&cus, hipDeviceAttributeMultiprocessorCount, dev) != hipSuccess) { grid = -1; return; }
        if (hipFuncSetAttribute((const void*)fwd, hipFuncAttributeMaxDynamicSharedMemorySize, LDS_BYTES) != hipSuccess) { fprintf(stderr, "kernel_launch: hipFuncSetAttribute failed\n"); grid = -1; return; }
        if (hipOccupancyMaxActiveBlocksPerMultiprocessor(&per_cu, (const void*)fwd, 512, LDS_BYTES) != hipSuccess || per_cu < 1) { fprintf(stderr, "kernel_launch: occupancy query says %d\n", per_cu); (void)hipGetLastError(); }
        grid = cus;
    }
    if (grid < 0) return;
    (void)hipMemsetAsync((char*)d_ws + WS_CTL, 0, CTL_BYTES, stream);
    Params p{};
    for (int i = 0; i < N_IN; ++i) p.in[i] = (const float*)d_in[i];
    p.out = (float*)d_out; p.ws = (unsigned char*)d_ws;
#if MULTI_LAUNCH
    for (int ph = 0; ph < 1 + DBG_NLAYERS * 12; ++ph) { p.ph_lo = ph; p.ph_hi = ph + 1; hipLaunchKernelGGL(fwd, dim3(grid), dim3(512), LDS_BYTES, stream, p); }
#else
    p.ph_lo = 0; p.ph_hi = NPH; hipLaunchKernelGGL(fwd, dim3(grid), dim3(512), LDS_BYTES, stream, p);
#endif
    const hipError_t le = hipPeekAtLastError();
    if (le != hipSuccess) fprintf(stderr, "kernel_launch: launch failed: %s\n", hipGetErrorName(le));
}
```

```cpp
#include <hip/hip_runtime.h>
#include <cstdio>
#include <cstdint>

#ifndef CB_
#define CB_ 16
#endif
#ifndef LB_
#define LB_ 8
#endif
#ifndef DEPTH_
#define DEPTH_ 4
#endif
constexpr int DM = 2048, DEPTH = DEPTH_, CB = CB_, CT = 256, LB = LB_, LT = 1024;
constexpr int MC = CB * CT, ML = LB * LT, M = MC + ML;
constexpr int FF = 5504, NGU = 2 * FF, NIN = 6192, NINP = 6400, NMOD = 9 * DM, NCOND = 1 + LB;
constexpr float EPS = 1e-6f;
constexpr int Z_NAQ = 0, Z_NAK = 512, Z_NAV = 1024, Z_GLQ = 1536, Z_GLK = 1792, Z_GLV = 2048, Z_GLR = 2560, Z_GF = 3072, Z_GB = 3088,
              Z_GQQ = 3104, Z_GQK = 3616, Z_GQV = 3872, Z_DQKV = 4128, Z_DZ = 5664, Z_DB = 6176, Z_DA = 6184;
static_assert(Z_DA + 8 == NIN, "split");
enum { I_XP = 0, I_XS, I_CNAK, I_CNAV, I_CGK, I_CGV, I_SGLA, I_SGDN, I_C, I_CCTX, I_NORMG, I_WMOD, I_BMOD, I_GU, I_DOWN, I_WIN, I_WOUT, I_NAQKN, I_RPB,
       I_GUP, I_GBIAS, I_GLAON, I_GQAQKN, I_CONV, I_ALOG, I_DTB, I_GDNON, N_IN };
constexpr size_t O_YP = 0, O_YS = O_YP + (size_t)MC * DM, O_NAK = O_YS + (size_t)ML * DM, O_NAV = O_NAK + (size_t)CB * DEPTH * 4 * CT * 128,
                 O_GK = O_NAV + (size_t)CB * DEPTH * 4 * CT * 128, O_GV = O_GK + (size_t)CB * DEPTH * 2 * CT * 128,
                 O_SGLA = O_GV + (size_t)CB * DEPTH * 2 * CT * 128, O_SGDN = O_SGLA + (size_t)CB * DEPTH * 2 * 4 * 64 * 128,
                 O_END = O_SGDN + (size_t)CB * DEPTH * 2 * 4 * 128 * 128;
constexpr size_t al256(size_t x) { return (x + 255) & ~(size_t)255; }
constexpr size_t WS_CTL = 0, CTL_BYTES = 1u << 20;
constexpr size_t WS_WGU = CTL_BYTES;
constexpr size_t WS_WDN = WS_WGU + (size_t)DEPTH * 2 * NGU * DM * 2;
constexpr size_t WS_WIN = WS_WDN + (size_t)DEPTH * 2 * DM * FF * 2;
constexpr size_t WS_WOUT = WS_WIN + (size_t)DEPTH * NINP * DM * 2;
constexpr size_t WS_MODV = WS_WOUT + (size_t)DEPTH * DM * DM * 2;
constexpr size_t WS_ROPE = al256(WS_MODV + (size_t)DEPTH * NCOND * NMOD * 4);
constexpr size_t WS_X = al256(WS_ROPE + 2 * 64 * 32 * 4);
constexpr size_t WS_H = WS_X + (size_t)M * DM * 4;
constexpr size_t WS_ACT = WS_H + (size_t)M * DM * 2;
constexpr size_t WS_Z = WS_ACT + (size_t)M * FF * 2;
constexpr size_t WS_MRG = WS_Z + (size_t)M * NINP * 4;
constexpr size_t WS_NAQ = WS_MRG + (size_t)M * DM * 2;
constexpr size_t WS_NAK = WS_NAQ + (size_t)M * 512 * 2;
constexpr size_t WS_NAV = WS_NAK + (size_t)M * 512 * 2;
constexpr size_t WS_GQ = WS_NAV + (size_t)M * 512 * 2;
constexpr size_t WS_GK = WS_GQ + (size_t)M * 512 * 2;
constexpr size_t WS_GV = WS_GK + (size_t)M * 256 * 2;
constexpr size_t WS_CNAK = WS_GV + (size_t)M * 256 * 2;
constexpr size_t WS_CNAV = WS_CNAK + (size_t)LB * DEPTH * 256 * 512 * 2;
constexpr size_t WS_CGK = WS_CNAV + (size_t)LB * DEPTH * 256 * 512 * 2;
constexpr size_t WS_CGV = WS_CGK + (size_t)LB * DEPTH * 256 * 256 * 2;
constexpr size_t WS_AF = WS_CGV + (size_t)LB * DEPTH * 256 * 256 * 2;
constexpr size_t WS_AB = WS_AF + (size_t)M * 256 * 4;
constexpr size_t WS_DQ = WS_AB + (size_t)M * 256 * 4;
constexpr size_t WS_DK = WS_DQ + (size_t)M * 512 * 4;
constexpr size_t WS_DV = WS_DK + (size_t)M * 512 * 4;
constexpr size_t WS_DBA = WS_DV + (size_t)M * 512 * 4;
constexpr size_t WS_GOF = WS_DBA + (size_t)M * 16 * 4;
constexpr size_t WS_GOB = WS_GOF + (size_t)M * 512 * 4;
constexpr size_t WS_DOF = WS_GOB + (size_t)M * 512 * 4;
constexpr size_t WS_DOB = WS_DOF + (size_t)M * 512 * 4;
constexpr size_t WS_END = WS_DOB + (size_t)M * 512 * 4;

typedef unsigned short bf16_t;
struct Params { const float* in[N_IN]; float* out; unsigned char* ws; int ph_lo, ph_hi; };
static_assert(sizeof(Params) == N_IN * 8 + 8 + 8 + 8, "no padding");

#define WSP(T, off) ((T*)(p.ws + (off)))
__device__ __forceinline__ int opaque_tid() { int t = (int)threadIdx.x; asm volatile("" : "+v"(t)); return t; }
__device__ __forceinline__ Params opaque_params(const Params& p) { Params q = p; unsigned long long w = (unsigned long long)q.ws; asm volatile("" : "+s"(w)); q.ws = (unsigned char*)w; return q; }

__device__ __forceinline__ float wave_sum(float v) {
#pragma unroll
    for (int o = 32; o >= 1; o >>= 1) v += __shfl_xor(v, o);
    return v;
}
__device__ __forceinline__ bf16_t f2bf(float f) { unsigned u = __float_as_uint(f); u += 0x7FFFu + ((u >> 16) & 1u); return (bf16_t)(u >> 16); }
__device__ __forceinline__ unsigned pack2(float a, float b) { return (unsigned)f2bf(a) | ((unsigned)f2bf(b) << 16); }
__device__ __forceinline__ float silu_f(float x) { return x / (1.f + expf(-x)); }
__device__ __forceinline__ float softplus_f(float x) { return fmaxf(x, 0.f) + log1pf(expf(-fabsf(x))); }
__device__ __forceinline__ float logsigmoid_f(float x) { return fminf(x, 0.f) - log1pf(expf(-fabsf(x))); }
__device__ __forceinline__ int cond_of_row(int m) { return m < MC ? 0 : 1 + (m - MC) / LT; }
typedef float vf4 __attribute__((ext_vector_type(4)));
#ifndef CONV_FILLER
#define CONV_FILLER 1
#endif
__device__ __forceinline__ void conv_tile(const float* __restrict__ src, int ld_src, int ncols_src, int k0, int c0, bf16_t* __restrict__ dst, int ld_dst, int n0, float* tile) {
    const int tid = opaque_tid();
    {
        const int r = tid >> 3, c = (tid & 7) * 8;
        float4 a = make_float4(0.f, 0.f, 0.f, 0.f), b = a;
        if (c0 + c + 8 <= ncols_src) {
            const float* s = src + (size_t)(k0 + r) * ld_src + c0 + c;
            a = *(const float4*)s; b = *(const float4*)(s + 4);
        }
        float* t = tile + r * 65 + c;
        t[0] = a.x; t[1] = a.y; t[2] = a.z; t[3] = a.w; t[4] = b.x; t[5] = b.y; t[6] = b.z; t[7] = b.w;
    }
    __syncthreads();
    {
        const int n = tid >> 3, ks = (tid & 7) * 8;
        const float* t = tile + ks * 65 + n;
        uint4 w;
        w.x = pack2(t[0 * 65], t[1 * 65]); w.y = pack2(t[2 * 65], t[3 * 65]); w.z = pack2(t[4 * 65], t[5 * 65]); w.w = pack2(t[6 * 65], t[7 * 65]);
        *(uint4*)(dst + (size_t)(n0 + n) * ld_dst + k0 + ks) = w;
    }
    __syncthreads();
}

constexpr int MOD_ITEMS = DEPTH * (NMOD / 128);
constexpr int TGU_KT = DM / 64, TGU_NT = NGU / 64, TDN_KT = FF / 64, TDN_NT = DM / 64, TIN_KT = DM / 64, TIN_NT = NINP / 64, TOUT_KT = DM / 64, TOUT_NT = DM / 64;
constexpr int TL_GU = 2 * TGU_KT * TGU_NT, TL_DN = 2 * TDN_KT * TDN_NT, TL_IN = TIN_KT * TIN_NT, TL_OUT = TOUT_KT * TOUT_NT, NT_L = TL_GU + TL_DN + TL_IN + TL_OUT;
__device__ __forceinline__ void conv_layer_tiles(const Params& p, int l, int t_begin, int t_end, int first, int stride, float* s_tile) {
    for (int it = t_begin + first; it < t_end; it += stride) {
        if (it < TL_GU) {
            const int mat = l * 2 + it / (TGU_KT * TGU_NT), r = it % (TGU_KT * TGU_NT), kt = r / TGU_NT, nt = r % TGU_NT;
            const int n0 = nt * 64, t256 = n0 / 256, c = n0 % 256;
            const int c0 = c < 128 ? 128 * t256 + c : FF + 128 * t256 + (c - 128);
            conv_tile(p.in[I_GU] + (size_t)mat * DM * NGU, NGU, NGU, kt * 64, c0, WSP(bf16_t, WS_WGU) + (size_t)mat * NGU * DM, DM, n0, s_tile);
        } else if (it < TL_GU + TL_DN) {
            const int i2 = it - TL_GU, mat = l * 2 + i2 / (TDN_KT * TDN_NT), r = i2 % (TDN_KT * TDN_NT), kt = r / TDN_NT, nt = r % TDN_NT;
            conv_tile(p.in[I_DOWN] + (size_t)mat * FF * DM, DM, DM, kt * 64, nt * 64, WSP(bf16_t, WS_WDN) + (size_t)mat * DM * FF, FF, nt * 64, s_tile);
        } else if (it < TL_GU + TL_DN + TL_IN) {
            const int i2 = it - TL_GU - TL_DN, kt = i2 / TIN_NT, nt = i2 % TIN_NT;
            conv_tile(p.in[I_WIN] + (size_t)l * DM * NIN, NIN, NIN, kt * 64, nt * 64, WSP(bf16_t, WS_WIN) + (size_t)l * NINP * DM, DM, nt * 64, s_tile);
        } else {
            const int i2 = it - TL_GU - TL_DN - TL_IN, kt = i2 / TOUT_NT, nt = i2 % TOUT_NT;
            conv_tile(p.in[I_WOUT] + (size_t)l * DM * DM, DM, DM, kt * 64, nt * 64, WSP(bf16_t, WS_WOUT) + (size_t)l * DM * DM, DM, nt * 64, s_tile);
        }
    }
}

__device__ __forceinline__ void phase_prologue(const Params& p, float* smem) {
    const int tid = opaque_tid(), nb = gridDim.x, bid = blockIdx.x;
    float* s_cond = smem;
    float* s_red = s_cond + NCOND * DM;
    float* s_tile = s_red + 3 * 128 * NCOND;
    for (int i = tid; i < NCOND * DM; i += 512) { const int ci = i / DM, k = i % DM; const float v = ci == 0 ? p.in[I_CCTX][k] : p.in[I_C][(size_t)(ci - 1) * DM + k]; s_cond[i] = silu_f(v); }
    __syncthreads();
    float* modv = WSP(float, WS_MODV);
    for (int it = bid; it < MOD_ITEMS; it += nb) {
        const int l = it / (NMOD / 128), jt = it % (NMOD / 128);
        const int cl = tid & 127, kq = tid >> 7, col = jt * 128 + cl;
        const float* w = p.in[I_WMOD] + (size_t)l * DM * NMOD + col;
        float acc[NCOND];
#pragma unroll
        for (int ci = 0; ci < NCOND; ++ci) acc[ci] = 0.f;
        for (int k = kq * 512; k < kq * 512 + 512; k += 8) {
            float wv[8];
#pragma unroll
            for (int j = 0; j < 8; ++j) wv[j] = w[(size_t)(k + j) * NMOD];
#pragma unroll
            for (int ci = 0; ci < NCOND; ++ci) {
                const float4 s0 = *(const float4*)&s_cond[ci * DM + k], s1 = *(const float4*)&s_cond[ci * DM + k + 4];
                acc[ci] += s0.x * wv[0] + s0.y * wv[1] + s0.z * wv[2] + s0.w * wv[3] + s1.x * wv[4] + s1.y * wv[5] + s1.z * wv[6] + s1.w * wv[7];
            }
        }
        if (kq > 0) {
#pragma unroll
            for (int ci = 0; ci < NCOND; ++ci) s_red[((kq - 1) * 128 + cl) * NCOND + ci] = acc[ci];
        }
        __syncthreads();
        if (kq == 0) {
            const float bm = p.in[I_BMOD][(size_t)l * NMOD + col];
#pragma unroll
            for (int ci = 0; ci < NCOND; ++ci)
                modv[((size_t)l * NCOND + ci) * NMOD + col] = acc[ci] + s_red[(0 * 128 + cl) * NCOND + ci] + s_red[(1 * 128 + cl) * NCOND + ci] + s_red[(2 * 128 + cl) * NCOND + ci] + bm;
        }
        __syncthreads();
    }
    conv_layer_tiles(p, 0, 0, NT_L, bid, nb, s_tile);
#if !CONV_FILLER
    for (int l2 = 1; l2 < DEPTH; ++l2) conv_layer_tiles(p, l2, 0, NT_L, bid, nb, s_tile);
#endif
    const size_t gtid = (size_t)bid * 512 + tid, gstride = (size_t)nb * 512;
    {
        float4* X = WSP(float4, WS_X);
        const float4* xp = (const float4*)p.in[I_XP]; const float4* xs = (const float4*)p.in[I_XS];
        const size_t nc = (size_t)MC * DM / 4, n = (size_t)M * DM / 4;
        for (size_t i = gtid; i < n; i += gstride) X[i] = i < nc ? xp[i] : xs[i - nc];
    }
    {
        const size_t n_na = (size_t)LB * DEPTH * 256 * 512 / 8;
        for (size_t i = gtid; i < 2 * n_na; i += gstride) {
            const bool isv = i >= n_na; const size_t j = isv ? i - n_na : i;
            const int d8 = (int)(j % 16), h = (int)((j / 16) % 4), t = (int)((j / 64) % 256); const size_t bl = j / (64 * 256);
            const float* s = p.in[isv ? I_CNAV : I_CNAK] + ((bl * 4 + h) * 256 + t) * 128 + d8 * 8;
            const float4 a = *(const float4*)s, b = *(const float4*)(s + 4);
            uint4 w; w.x = pack2(a.x, a.y); w.y = pack2(a.z, a.w); w.z = pack2(b.x, b.y); w.w = pack2(b.z, b.w);
            *(uint4*)(WSP(bf16_t, isv ? WS_CNAV : WS_CNAK) + (bl * 256 + t) * 512 + h * 128 + d8 * 8) = w;
        }
        const size_t n_g = (size_t)LB * DEPTH * 256 * 256 / 8;
        for (size_t i = gtid; i < 2 * n_g; i += gstride) {
            const bool isv = i >= n_g; const size_t j = isv ? i - n_g : i;
            const int d8 = (int)(j % 16), h = (int)((j / 16) % 2), t = (int)((j / 32) % 256); const size_t bl = j / (32 * 256);
            const float* s = p.in[isv ? I_CGV : I_CGK] + ((bl * 2 + h) * 256 + t) * 128 + d8 * 8;
            const float4 a = *(const float4*)s, b = *(const float4*)(s + 4);
            uint4 w; w.x = pack2(a.x, a.y); w.y = pack2(a.z, a.w); w.z = pack2(b.x, b.y); w.w = pack2(b.z, b.w);
            *(uint4*)(WSP(bf16_t, isv ? WS_CGV : WS_CGK) + (bl * 256 + t) * 256 + h * 128 + d8 * 8) = w;
        }
    }
    for (size_t i = gtid; i < 64 * 32; i += gstride) {
        const int pos = (int)(i / 32), k = (int)(i % 32);
        const float inv = powf(10000.0f, -(float)(2 * k) / 64.0f);
        const float ang = (float)pos * inv;
        WSP(float, WS_ROPE)[i] = cosf(ang); WSP(float, WS_ROPE)[64 * 32 + i] = sinf(ang);
    }
}

__device__ __forceinline__ void phase_norm(const Params& p, int l, int which  ) {
    const int tid = opaque_tid(), lane = tid & 63, wv = tid >> 6;
    const float* X = WSP(float, WS_X); bf16_t* H = WSP(bf16_t, WS_H);
    const float* g = p.in[I_NORMG] + ((size_t)l * 3 + which) * DM;
    for (int m = blockIdx.x * 8 + wv; m < M; m += gridDim.x * 8) {
        const int ci = cond_of_row(m);
        const float* mv = WSP(float, WS_MODV) + ((size_t)l * NCOND + ci) * NMOD + (size_t)which * 3 * DM;
        const float* x = X + (size_t)m * DM;
        vf4 v[8]; float ss = 0.f;
#pragma unroll
        for (int i = 0; i < 8; ++i) { v[i] = *(const vf4*)(x + (i * 64 + lane) * 4); ss += v[i].x * v[i].x + v[i].y * v[i].y + v[i].z * v[i].z + v[i].w * v[i].w; }
        ss = wave_sum(ss);
        const float r = 1.0f / sqrtf(ss * (1.0f / DM) + EPS);
#pragma unroll
        for (int i = 0; i < 8; ++i) {
            const int c = (i * 64 + lane) * 4;
            const float4 gg = *(const float4*)(g + c), sh = *(const float4*)(mv + c), sc = *(const float4*)(mv + DM + c);
            const float o0 = v[i].x * r * gg.x * (1.f + sc.x) + sh.x, o1 = v[i].y * r * gg.y * (1.f + sc.y) + sh.y;
            const float o2 = v[i].z * r * gg.z * (1.f + sc.z) + sh.z, o3 = v[i].w * r * gg.w * (1.f + sc.w) + sh.w;
            uint2 w; w.x = pack2(o0, o1); w.y = pack2(o2, o3);
            *(uint2*)(H + (size_t)m * DM + c) = w;
        }
    }
}

__device__ __forceinline__ float red16(float v);
__device__ __forceinline__ float ssq8(vf4 a, vf4 b) { const vf4 s = a * a + b * b; return (s.x + s.y) + (s.z + s.w); }
__device__ __forceinline__ uint4 pack8(vf4 a, vf4 b) { uint4 w; w.x = pack2(a.x, a.y); w.y = pack2(a.z, a.w); w.z = pack2(b.x, b.y); w.w = pack2(b.z, b.w); return w; }
__device__ __forceinline__ void phase_prep(const Params& p, int l) {
    const int tid = opaque_tid(), lane = tid & 63, wv = tid >> 6, rg = lane >> 4, sub = lane & 15, c8 = sub * 8;
    const float* Z = WSP(float, WS_Z);
    const float* ropec = WSP(float, WS_ROPE); const float* ropes = ropec + 64 * 32;
    const float* wnq = p.in[I_NAQKN] + ((size_t)l * 2 + 0) * 128 + c8; const float* wnk = wnq + 128;
    const float* wgq = p.in[I_GQAQKN] + ((size_t)l * 2 + 0) * 128 + c8; const float* wgk = wgq + 128;
    const float* cw = p.in[I_CONV] + (size_t)l * 5 * 1536 + rg * 128 + c8;
    for (int m = blockIdx.x * 8 + wv; m < M; m += gridDim.x * 8) {
        const float* z = Z + (size_t)m * NINP;
        const bool ctx = m < MC;
        const int b = ctx ? m / CT : (m - MC) / LT, t = ctx ? m % CT : (m - MC) % LT, T = ctx ? CT : LT;
        {
            const int ho = rg * 128 + c8;
            const float* zkv = z + (rg < 2 ? Z_GQK + rg * 128 : Z_GQV + (rg - 2) * 128) + c8;
            vf4 q0 = *(const vf4*)(z + Z_NAQ + ho), q1 = *(const vf4*)(z + Z_NAQ + ho + 4), k0 = *(const vf4*)(z + Z_NAK + ho), k1 = *(const vf4*)(z + Z_NAK + ho + 4);
            const vf4 v0 = *(const vf4*)(z + Z_NAV + ho), v1 = *(const vf4*)(z + Z_NAV + ho + 4);
            vf4 g0 = *(const vf4*)(z + Z_GQQ + ho), g1 = *(const vf4*)(z + Z_GQQ + ho + 4), x0 = *(const vf4*)zkv, x1 = *(const vf4*)(zkv + 4);
            float r = 1.0f / sqrtf(red16(ssq8(q0, q1)) * (1.0f / 128) + EPS);
            q0 = q0 * r * *(const vf4*)wnq; q1 = q1 * r * *(const vf4*)(wnq + 4);
            *(uint4*)(WSP(bf16_t, WS_NAQ) + (size_t)m * 512 + ho) = pack8(q0, q1);
            r = 1.0f / sqrtf(red16(ssq8(k0, k1)) * (1.0f / 128) + EPS);
            k0 = k0 * r * *(const vf4*)wnk; k1 = k1 * r * *(const vf4*)(wnk + 4);
            *(uint4*)(WSP(bf16_t, WS_NAK) + (size_t)m * 512 + ho) = pack8(k0, k1);
            *(uint4*)(WSP(bf16_t, WS_NAV) + (size_t)m * 512 + ho) = pack8(v0, v1);
            if (ctx) {
                const size_t o = ((((size_t)b * DEPTH + l) * 4 + rg) * CT + t) * 128 + c8;
                *(vf4*)(p.out + O_NAK + o) = k0; *(vf4*)(p.out + O_NAK + o + 4) = k1; *(vf4*)(p.out + O_NAV + o) = v0; *(vf4*)(p.out + O_NAV + o + 4) = v1;
            }
            r = 1.0f / sqrtf(red16(ssq8(g0, g1)) * (1.0f / 128) + EPS);
            g0 = g0 * r * *(const vf4*)wgq; g1 = g1 * r * *(const vf4*)(wgq + 4);
            const float rk = 1.0f / sqrtf(red16(ssq8(x0, x1)) * (1.0f / 128) + EPS);
            if (rg < 2) { x0 = x0 * rk * *(const vf4*)wgk; x1 = x1 * rk * *(const vf4*)(wgk + 4); }
            if (!ctx) {
                const int pos = sub < 8 ? (t >> 6) : (t & 63), ai = pos * 32 + (c8 & 31);
                const vf4 c0 = *(const vf4*)(ropec + ai), c1 = *(const vf4*)(ropec + ai + 4), s0 = *(const vf4*)(ropes + ai), s1 = *(const vf4*)(ropes + ai + 4);
                const bool hi = (sub & 4) != 0;
                vf4 pg0, pg1, px0, px1;
#pragma unroll
                for (int j = 0; j < 4; ++j) { pg0[j] = __shfl_xor(g0[j], 4); pg1[j] = __shfl_xor(g1[j], 4); px0[j] = __shfl_xor(x0[j], 4); px1[j] = __shfl_xor(x1[j], 4); }
                g0 = hi ? pg0 * s0 + g0 * c0 : g0 * c0 - pg0 * s0; g1 = hi ? pg1 * s1 + g1 * c1 : g1 * c1 - pg1 * s1;
                if (rg < 2) { x0 = hi ? px0 * s0 + x0 * c0 : x0 * c0 - px0 * s0; x1 = hi ? px1 * s1 + x1 * c1 : x1 * c1 - px1 * s1; }
            }
            *(uint4*)(WSP(bf16_t, WS_GQ) + (size_t)m * 512 + ho) = pack8(g0, g1);
            *(uint4*)(WSP(bf16_t, rg < 2 ? WS_GK : WS_GV) + (size_t)m * 256 + (rg & 1) * 128 + c8) = pack8(x0, x1);
            if (ctx) {
                const size_t o = ((((size_t)b * DEPTH + l) * 2 + (rg & 1)) * CT + t) * 128 + c8;
                float* dst = p.out + (rg < 2 ? O_GK : O_GV) + o;
                *(vf4*)dst = x0; *(vf4*)(dst + 4) = x1;
            }
        }
        {
#pragma unroll
            for (int dir = 0; dir < 2; ++dir) {
                const float* up = p.in[I_GUP] + ((size_t)l * 2 + dir) * 16 * 256 + 4 * lane;
                vf4 acc = *(const vf4*)(p.in[I_GBIAS] + ((size_t)l * 2 + dir) * 256 + 4 * lane);
                const float* gz = z + (dir ? Z_GB : Z_GF);
#pragma unroll
                for (int r4 = 0; r4 < 4; ++r4) {
                    const vf4 gv = *(const vf4*)(gz + 4 * r4);
                    acc += gv.x * *(const vf4*)(up + (4 * r4 + 0) * 256) + gv.y * *(const vf4*)(up + (4 * r4 + 1) * 256) + gv.z * *(const vf4*)(up + (4 * r4 + 2) * 256) + gv.w * *(const vf4*)(up + (4 * r4 + 3) * 256);
                }
                vf4 o;
#pragma unroll
                for (int j = 0; j < 4; ++j) o[j] = logsigmoid_f(acc[j]) * (1.0f / 16.0f);
                *(vf4*)(WSP(float, dir ? WS_AB : WS_AF) + (size_t)m * 256 + 4 * lane) = o;
            }
        }
        {
#pragma unroll
            for (int part = 0; part < 3; ++part) {
                vf4 a0 = (vf4){0.f, 0.f, 0.f, 0.f}, a1 = a0;
#pragma unroll
                for (int j = 0; j < 5; ++j) {
                    const int tt = t + j - 2;
                    if (tt >= 0 && tt < T) {
                        const float* zz = Z + (size_t)(m + j - 2) * NINP + Z_DQKV + part * 512 + rg * 128 + c8;
                        const float* cj = cw + j * 1536 + part * 512;
                        a0 += *(const vf4*)cj * *(const vf4*)zz; a1 += *(const vf4*)(cj + 4) * *(const vf4*)(zz + 4);
                    }
                }
#pragma unroll
                for (int j = 0; j < 4; ++j) { a0[j] = silu_f(a0[j]); a1[j] = silu_f(a1[j]); }
                if (part < 2) { const float r = 1.0f / sqrtf(red16(ssq8(a0, a1)) + EPS) * (part == 0 ? 0.08838834764831845f : 1.0f); a0 *= r; a1 *= r; }
                float* dst = WSP(float, part == 0 ? WS_DQ : part == 1 ? WS_DK : WS_DV) + (size_t)m * 512 + rg * 128 + c8;
                *(vf4*)dst = a0; *(vf4*)(dst + 4) = a1;
            }
            if (lane < 8) {
                const float beta = 1.0f / (1.0f + expf(-z[Z_DB + lane]));
                const float g = -expf(p.in[I_ALOG][(size_t)l * 8 + lane]) * softplus_f(z[Z_DA + lane] + p.in[I_DTB][(size_t)l * 8 + lane]);
                float* ba = WSP(float, WS_DBA) + (size_t)m * 16;
                ba[lane] = beta; ba[8 + lane] = g;
            }
        }
    }
}

typedef float vf2 __attribute__((ext_vector_type(2)));
__device__ __forceinline__ float dpp_f(float v, const int ctrl) { return v; }
#define DPPF(v, ctrl) __int_as_float(__builtin_amdgcn_mov_dpp(__float_as_int(v), (ctrl), 0xF, 0xF, true))
__device__ __forceinline__ float red8(float v) { v += DPPF(v, 0xB1); v += DPPF(v, 0x4E); v += DPPF(v, 0x141); return v; }
__device__ __forceinline__ float red16(float v) { v = red8(v); v += DPPF(v, 0x140); return v; }

__device__ __forceinline__ void gla_chain(const Params& p, int l, bool ctx, int b, int h, int dir, int es, float* smem) {
    constexpr int TC = 32;
    const int tid = opaque_tid(), el = tid >> 3, dg = tid & 7;
    const int T = ctx ? CT : LT; const size_t m0 = ctx ? (size_t)b * CT : (size_t)MC + (size_t)b * LT;
    const float* Z = WSP(float, WS_Z); const float* A = WSP(float, dir ? WS_AB : WS_AF);
    float* O = WSP(float, dir ? WS_GOB : WS_GOF);
    float* sq = smem; float* sk = sq + TC * 64; float* sa = sk + TC * 64; float* sv = sa + TC * 64; float* so = sv + TC * 64;
    vf2 S[4];
    {
        const int e = es * 64 + el;
        if (ctx) {
#pragma unroll
            for (int i = 0; i < 4; ++i) S[i] = (vf2){0.f, 0.f};
        } else {
            const float* s0 = p.in[I_SGLA] + (((((size_t)b * DEPTH + l) * 2 + dir) * 4 + h) * 64 + dg * 8) * 128 + e;
#pragma unroll
            for (int i = 0; i < 4; ++i) S[i] = (vf2){s0[(size_t)(2 * i) * 128], s0[(size_t)(2 * i + 1) * 128]};
        }
    }
    vf4 pre[4];
    const int nch = T / TC;
    const int ls = tid >> 4, lc = (tid & 15) * 4;
#define GLA_LOAD(c) do { const int ti = (c) * TC + ls, tt = dir ? T - 1 - ti : ti; const size_t m = m0 + tt; \
        pre[0] = *(const vf4*)(Z + m * NINP + Z_GLQ + h * 64 + lc); pre[1] = *(const vf4*)(Z + m * NINP + Z_GLK + h * 64 + lc); \
        pre[2] = *(const vf4*)(A + m * 256 + h * 64 + lc);           pre[3] = *(const vf4*)(Z + m * NINP + Z_GLV + h * 128 + es * 64 + lc); } while (0)
#define GLA_WRITE() do { *(vf4*)(sq + ls * 64 + lc) = pre[0] * 0.125f; *(vf4*)(sk + ls * 64 + lc) = pre[1]; { vf4 e_; e_.x = expf(pre[2].x); e_.y = expf(pre[2].y); e_.z = expf(pre[2].z); e_.w = expf(pre[2].w); *(vf4*)(sa + ls * 64 + lc) = e_; } *(vf4*)(sv + ls * 64 + lc) = pre[3]; } while (0)
    __syncthreads();
    GLA_LOAD(0); GLA_WRITE(); __syncthreads();
    for (int c = 0; c < nch; ++c) {
        if (c + 1 < nch) GLA_LOAD(c + 1);
        vf4 q0 = *(const vf4*)(sq + dg * 8), q1 = *(const vf4*)(sq + dg * 8 + 4), k0 = *(const vf4*)(sk + dg * 8), k1 = *(const vf4*)(sk + dg * 8 + 4);
        vf4 a0 = *(const vf4*)(sa + dg * 8), a1 = *(const vf4*)(sa + dg * 8 + 4); float ve = sv[el];
#pragma unroll 2
        for (int s = 0; s < TC; ++s) {
            const int sn = (s + 1) & (TC - 1);
            const vf4 nq0 = *(const vf4*)(sq + sn * 64 + dg * 8), nq1 = *(const vf4*)(sq + sn * 64 + dg * 8 + 4), nk0 = *(const vf4*)(sk + sn * 64 + dg * 8), nk1 = *(const vf4*)(sk + sn * 64 + dg * 8 + 4);
            const vf4 na0 = *(const vf4*)(sa + sn * 64 + dg * 8), na1 = *(const vf4*)(sa + sn * 64 + dg * 8 + 4); const float nve = sv[sn * 64 + el];
            const vf2 v2 = (vf2){ve, ve};
            S[0] = a0.xy * S[0] + k0.xy * v2; S[1] = a0.zw * S[1] + k0.zw * v2; S[2] = a1.xy * S[2] + k1.xy * v2; S[3] = a1.zw * S[3] + k1.zw * v2;
            vf2 acc0 = q0.xy * S[0], acc1 = q0.zw * S[1]; acc0 += q1.xy * S[2]; acc1 += q1.zw * S[3];
            acc0 += acc1;
            const float po = red8(acc0.x + acc0.y);
            if (dg == 0) so[s * 64 + el] = po;
            q0 = nq0; q1 = nq1; k0 = nk0; k1 = nk1; a0 = na0; a1 = na1; ve = nve;
        }
        __syncthreads();
        { const int ti = c * TC + ls, tt = dir ? T - 1 - ti : ti; *(vf4*)(O + (m0 + tt) * 512 + h * 128 + es * 64 + lc) = *(const vf4*)(so + ls * 64 + lc); }
        if (c + 1 < nch) GLA_WRITE();
        __syncthreads();
    }
#undef GLA_LOAD
#undef GLA_WRITE
    if (ctx) {
        float* so_ = p.out + O_SGLA + (((((size_t)b * DEPTH + l) * 2 + dir) * 4 + h) * 64 + dg * 8) * 128 + es * 64 + el;
#pragma unroll
        for (int i = 0; i < 4; ++i) { so_[(size_t)(2 * i) * 128] = S[i].x; so_[(size_t)(2 * i + 1) * 128] = S[i].y; }
    }
}

__device__ __forceinline__ void gdn_chain(const Params& p, int l, bool ctx, int b, int h, int dir, int es, float* smem) {
    constexpr int TC = 32;
    const int tid = opaque_tid(), el = tid >> 3, dg = tid & 7;
    const int T = ctx ? CT : LT; const size_t m0 = ctx ? (size_t)b * CT : (size_t)MC + (size_t)b * LT;
    const float* DQ = WSP(float, WS_DQ); const float* DK = WSP(float, WS_DK); const float* DV = WSP(float, WS_DV); const float* DBA = WSP(float, WS_DBA);
    float* O = WSP(float, dir ? WS_DOB : WS_DOF);
    float* sq = smem; float* sk = sq + TC * 128; float* sv = sk + TC * 128; float* so = sv + TC * 64; float* sba = so + TC * 64; float* sqk = sba + TC * 2;
    vf2 S[8];
    {
        const int e = es * 64 + el;
        if (ctx) {
#pragma unroll
            for (int i = 0; i < 8; ++i) S[i] = (vf2){0.f, 0.f};
        } else {
            const float* s0 = p.in[I_SGDN] + (((((size_t)b * DEPTH + l) * 2 + dir) * 4 + h) * 128 + dg * 16) * 128 + e;
#pragma unroll
            for (int i = 0; i < 8; ++i) S[i] = (vf2){s0[(size_t)(2 * i) * 128], s0[(size_t)(2 * i + 1) * 128]};
        }
    }
    vf4 pre[5]; float pre_s = 0.f;
    const int nch = T / TC;
    const int ls = tid >> 5, lc = (tid & 31) * 4, vs = tid >> 4, vc = (tid & 15) * 4;
#define TOK(c, s_) (m0 + (dir ? T - 1 - ((c) * TC + (s_)) : (c) * TC + (s_)))
#define GDN_LOAD(c) do { const size_t ma = TOK(c, ls), mb = TOK(c, ls + 16), mv = TOK(c, vs); \
        pre[0] = *(const vf4*)(DQ + ma * 512 + h * 128 + lc); pre[1] = *(const vf4*)(DQ + mb * 512 + h * 128 + lc); \
        pre[2] = *(const vf4*)(DK + ma * 512 + h * 128 + lc); pre[3] = *(const vf4*)(DK + mb * 512 + h * 128 + lc); \
        pre[4] = *(const vf4*)(DV + mv * 512 + h * 128 + es * 64 + vc); \
        if (tid < 2 * TC) { pre_s = DBA[TOK(c, tid >> 1) * 16 + (tid & 1) * 8 + dir * 4 + h]; if (tid & 1) pre_s = expf(pre_s); } } while (0)
#define GDN_WRITE() do { *(vf4*)(sq + ls * 128 + lc) = pre[0]; *(vf4*)(sq + (ls + 16) * 128 + lc) = pre[1]; *(vf4*)(sk + ls * 128 + lc) = pre[2]; *(vf4*)(sk + (ls + 16) * 128 + lc) = pre[3]; \
        *(vf4*)(sv + vs * 64 + vc) = pre[4]; if (tid < 2 * TC) sba[tid] = pre_s; } while (0)
    __syncthreads();
    GDN_LOAD(0); GDN_WRITE(); __syncthreads();
    for (int c = 0; c < nch; ++c) {
        if (c + 1 < nch) GDN_LOAD(c + 1);
        {
            const int s = tid >> 4, part = tid & 15;
            const vf4 x0 = *(const vf4*)(sq + s * 128 + part * 8), x1 = *(const vf4*)(sq + s * 128 + part * 8 + 4), y0 = *(const vf4*)(sk + s * 128 + part * 8), y1 = *(const vf4*)(sk + s * 128 + part * 8 + 4);
            const vf4 pr = x0 * y0 + x1 * y1;
            const float d = red16((pr.x + pr.y) + (pr.z + pr.w));
            if (part == 0) sqk[s] = d;
        }
        __syncthreads();
        vf4 kk[4], qq[4]; float ve, be, a, qk;
#pragma unroll
        for (int i = 0; i < 4; ++i) { kk[i] = *(const vf4*)(sk + dg * 16 + 4 * i); qq[i] = *(const vf4*)(sq + dg * 16 + 4 * i); }
        ve = sv[el]; be = sba[0]; a = sba[1]; qk = sqk[0];
#pragma unroll 2
        for (int s = 0; s < TC; ++s) {
            const int sn = (s + 1) & (TC - 1);
            vf4 nk[4], nq[4];
#pragma unroll
            for (int i = 0; i < 4; ++i) { nk[i] = *(const vf4*)(sk + sn * 128 + dg * 16 + 4 * i); nq[i] = *(const vf4*)(sq + sn * 128 + dg * 16 + 4 * i); }
            const float nve = sv[sn * 64 + el], nbe = sba[2 * sn], na = sba[2 * sn + 1], nqk = sqk[sn];
            vf2 ak0 = kk[0].xy * S[0], ak1 = kk[0].zw * S[1], aq0 = qq[0].xy * S[0], aq1 = qq[0].zw * S[1];
#pragma unroll
            for (int i = 1; i < 4; ++i) { ak0 += kk[i].xy * S[2 * i]; ak1 += kk[i].zw * S[2 * i + 1]; aq0 += qq[i].xy * S[2 * i]; aq1 += qq[i].zw * S[2 * i + 1]; }
            ak0 += ak1; aq0 += aq1;
            const float uk = red8(ak0.x + ak0.y), uq = red8(aq0.x + aq0.y);
            const float vn = be * (ve - a * uk);
            const float po = a * uq + qk * vn;
            const vf2 a2 = (vf2){a, a}, vn2 = (vf2){vn, vn};
#pragma unroll
            for (int i = 0; i < 4; ++i) { S[2 * i] = a2 * S[2 * i] + kk[i].xy * vn2; S[2 * i + 1] = a2 * S[2 * i + 1] + kk[i].zw * vn2; }
            if (dg == 0) so[s * 64 + el] = po;
#pragma unroll
            for (int i = 0; i < 4; ++i) { kk[i] = nk[i]; qq[i] = nq[i]; }
            ve = nve; be = nbe; a = na; qk = nqk;
        }
        __syncthreads();
        *(vf4*)(O + TOK(c, vs) * 512 + h * 128 + es * 64 + vc) = *(const vf4*)(so + vs * 64 + vc);
        if (c + 1 < nch) GDN_WRITE();
        __syncthreads();
    }
#undef GDN_LOAD
#undef GDN_WRITE
#undef TOK
    if (ctx) {
        float* so_ = p.out + O_SGDN + (((((size_t)b * DEPTH + l) * 2 + dir) * 4 + h) * 128 + dg * 16) * 128 + es * 64 + el;
#pragma unroll
        for (int i = 0; i < 8; ++i) { so_[(size_t)(2 * i) * 128] = S[i].x; so_[(size_t)(2 * i + 1) * 128] = S[i].y; }
    }
}

__device__ __forceinline__ void phase_post(const Params& p, int l) {
    const int tid = opaque_tid(), lane = tid & 63, wv = tid >> 6, rg = lane >> 4, c8 = (lane & 15) * 8;
    const float* Z = WSP(float, WS_Z); bf16_t* MRG = WSP(bf16_t, WS_MRG);
    const float* wg = p.in[I_GLAON] + (size_t)l * 128 + c8; const float* wd = p.in[I_GDNON] + (size_t)l * 128 + c8;
    for (int m = blockIdx.x * 8 + wv; m < M; m += gridDim.x * 8) {
        const float* z = Z + (size_t)m * NINP;
        const int ho = rg * 128 + c8;
#pragma unroll
        for (int g = 0; g < 2; ++g) {
            const float* of = WSP(float, g ? WS_DOF : WS_GOF) + (size_t)m * 512 + ho; const float* ob = WSP(float, g ? WS_DOB : WS_GOB) + (size_t)m * 512 + ho;
            const float* w = g ? wd : wg; const float* zg = z + (g ? Z_DZ : Z_GLR) + ho;
            vf4 a0 = *(const vf4*)of + *(const vf4*)ob, a1 = *(const vf4*)(of + 4) + *(const vf4*)(ob + 4);
            const vf4 g0 = *(const vf4*)zg, g1 = *(const vf4*)(zg + 4);
            const float r = 1.0f / sqrtf(red16(ssq8(a0, a1)) * (1.0f / 128) + EPS);
            a0 = a0 * r * *(const vf4*)w; a1 = a1 * r * *(const vf4*)(w + 4);
#pragma unroll
            for (int j = 0; j < 4; ++j) { a0[j] *= silu_f(g0[j]); a1[j] *= silu_f(g1[j]); }
            *(uint4*)(MRG + (size_t)m * DM + (g ? 1536 : 512) + ho) = pack8(a0, a1);
        }
    }
}
#define XB_TMO      128
#define XB_XCNT(j)  (256  + 64 * (j))
#define XB_XSUB(j)  (1280 + 64 * (j))
#define XB_XGEN(j)  (2304 + 64 * (j))
#define XB_TOP      3328
#define XB_TOPGEN   3392
#define XCD_BAR_WORDS 3456
#define XB_SPIN_CAP (1u << 22)
#define LAS __attribute__((address_space(3)))

__device__ __forceinline__ unsigned xb_ld(unsigned* p)              { return __hip_atomic_load(p, __ATOMIC_RELAXED, __HIP_MEMORY_SCOPE_AGENT); }
__device__ __forceinline__ unsigned xb_add(unsigned* p, unsigned v) { return __hip_atomic_fetch_add(p, v, __ATOMIC_RELAXED, __HIP_MEMORY_SCOPE_AGENT); }
__device__ __forceinline__ unsigned xb_xcc_id() { return (unsigned)__builtin_amdgcn_s_getreg((3 << 11) | 20) & 0xFu; }
#define XB_SPIN(cond, bar) do { unsigned _sp = 0; while (cond) { __builtin_amdgcn_s_sleep(1); \
    if ((++_sp & 255u) == 0u) { if (xb_ld(&(bar)[XB_TMO])) break; if (_sp > XB_SPIN_CAP) { atomicAdd(&(bar)[XB_TMO], 1u); break; } } } } while (0)

struct XcdBarrier {
    unsigned* bar; unsigned x;
    volatile LAS unsigned* st;
};

__device__ __forceinline__ XcdBarrier xcd_barrier_post(unsigned* bar, volatile LAS unsigned* st) {
    XcdBarrier b; b.bar = bar; b.x = xb_xcc_id(); b.st = st;
    if (threadIdx.x == 0) (void)xb_add(&bar[XB_XCNT(b.x)], 1u);
    return b;
}
__device__ __forceinline__ void xcd_barrier_complete(unsigned* bar, unsigned x, unsigned& nloc, unsigned& nx) {
    const unsigned G = gridDim.x * gridDim.y * gridDim.z;
    unsigned sum, cnt, mine, sp = 0u;
    for (;;) {
        sum = 0u; cnt = 0u; mine = 0u;
#pragma unroll
        for (unsigned j = 0; j < 16; ++j) { const unsigned c = xb_ld(&bar[XB_XCNT(j)]); sum += c; cnt += (c > 0u) ? 1u : 0u; mine = (j == x) ? c : mine; }
        if (sum == G) break;
        __builtin_amdgcn_s_sleep(1);
        if ((++sp & 255u) == 0u) { if (xb_ld(&bar[XB_TMO])) break; if (sp > XB_SPIN_CAP) { atomicAdd(&bar[XB_TMO], 1u); break; } }
    }
    nloc = mine > 0u ? mine : 1u; nx = cnt > 0u ? cnt : 1u;
}

__device__ __forceinline__ void xcd_barrier(const XcdBarrier& b) {
    asm volatile("s_waitcnt vmcnt(0)" ::: "memory");
    __syncthreads();
    if (threadIdx.x == 0) {
        unsigned* bar = b.bar;
        __builtin_amdgcn_s_waitcnt(0);
        unsigned nloc = b.st[0], nx = b.st[1];
        if (nloc == 0u) { xcd_barrier_complete(bar, b.x, nloc, nx); b.st[0] = nloc; b.st[1] = nx; }
        const unsigned old = xb_add(&bar[XB_XSUB(b.x)], 1u);
        const unsigned gen = old / nloc;
        if (old + 1u == (gen + 1u) * nloc) {
            __builtin_amdgcn_fence(__ATOMIC_RELEASE, "agent");
            asm volatile("s_waitcnt vmcnt(0)" ::: "memory");
            const unsigned og = xb_add(&bar[XB_TOP], 1u);
            const unsigned tg = og / nx;
            if (og + 1u == (tg + 1u) * nx) xb_add(&bar[XB_TOPGEN], 1u);
            else XB_SPIN(xb_ld(&bar[XB_TOPGEN]) == tg, bar);
            __builtin_amdgcn_fence(__ATOMIC_ACQUIRE, "agent");
            xb_add(&bar[XB_XGEN(b.x)], 1u);
            asm volatile("s_waitcnt vmcnt(0)" ::: "memory");
        } else {
            XB_SPIN(xb_ld(&bar[XB_XGEN(b.x)]) == gen, bar);
            __builtin_amdgcn_fence(__ATOMIC_ACQUIRE, "agent");
            asm volatile("s_waitcnt vmcnt(0)" ::: "memory");
        }
    }
    __syncthreads();
}

namespace pg8 {
#define PG8_LAS __attribute__((address_space(3)))
typedef unsigned short bf16_t;
typedef short bf16x8 __attribute__((ext_vector_type(8)));
typedef float f32x4 __attribute__((ext_vector_type(4)));
typedef unsigned u32x4 __attribute__((ext_vector_type(4)));
constexpr int BM = 256, BK = 64, HALF = 128, HTB = HALF * BK * 2  , STAGE_BYTES = 8 * HTB, NXCD = 8, WGM = 8;

__host__ __device__ __forceinline__ int lds_byte(int r, int c) { const int st = (r >> 4) * 2 + (c >> 5), rr = r & 15, cc = c & 31, ob = rr * 64 + cc * 2; return st * 1024 + (ob ^ (((ob >> 9) & 1) << 5)); }
__host__ __device__ __forceinline__ void stage_rc(int b, int& R, int& C) { const int st = b / 1024, sb = b % 1024, swz = sb ^ (((sb >> 9) & 1) << 5); R = (st >> 1) * 16 + swz / 64; C = (st & 1) * 32 + (swz % 64) / 2; }
__host__ __device__ __forceinline__ int perm32(int rho) { const int n = rho >> 4, i = rho & 15; return 8 * (i >> 2) + 4 * n + (i & 3); }

struct Unit { int pm, pn, k0, nt, at, slot; };
struct Gemm { const bf16_t* A; const bf16_t* Bt; int M, N, K; };

struct StaticOrder {
    int nM, nN, nwg, G, c, ntk, split;
    __host__ __device__ void init(int M, int N, int K, int G_, int c_, int split_ = 0) { nM = M / BM; nN = N / BM; nwg = nM * nN; G = G_; c = c_; ntk = K / BK; const int rem = nwg % G_; split = (split_ && rem > 0 && 2 * rem == G_ && (ntk % 4) != 1 && ntk >= 8) ? 1 : 0; }
    __host__ __device__ bool next(int i, Unit& u) const {
        long L = (long)i * G + c; u.k0 = 0; u.nt = ntk; u.at = 0; u.slot = 0;
        if (split && i == nwg / G) { const int rem = nwg % G, sl = c / rem, h0 = ((ntk / 2) + 1) & ~1; L = (long)i * G + (c % rem); u.k0 = sl ? h0 * BK : 0; u.nt = sl ? ntk - h0 : h0; u.at = sl ? 1 : 2; u.slot = c % rem; }
        if (L >= nwg) return false;
        int wgid = (int)L; { const int q = nwg / NXCD, r = nwg % NXCD, xcd = wgid % NXCD, off = wgid / NXCD; wgid = (xcd < r ? xcd * (q + 1) : r * (q + 1) + (xcd - r) * q) + off; }
        const int nig = WGM * nN, gid = wgid / nig, fm = gid * WGM, gsz = (nM - fm) < WGM ? (nM - fm) : WGM;
        u.pm = fm + ((wgid % nig) % gsz); u.pn = (wgid % nig) / gsz; return true;
    }
    __device__ __forceinline__ void a_ready(const Unit&) const {}
    __device__ __forceinline__ void done(const Unit&) const {}
};
__device__ __forceinline__ unsigned cvt_pk_bf16(float lo, float hi) { unsigned r; asm volatile("v_cvt_pk_bf16_f32 %0, %1, %2" : "=v"(r) : "v"(lo), "v"(hi)); return r; }
struct EpiF32 {
    static constexpr bool PERM = false, AFTER_DRAIN = false;
    float* C; int ldc; const float* bias;
    __device__ __forceinline__ void operator()(const f32x4 (&acc)[2][2][4][2], const Unit& u, int wr, int wc, int fr, int fq) const {
        const int row0 = u.pm * BM + wr * 64 + fr, col0 = u.pn * BM + wc * 32 + 4 * fq;
        f32x4 bv[2][2];
#pragma unroll
        for (int bj = 0; bj < 2; ++bj)
#pragma unroll
            for (int n = 0; n < 2; ++n) bv[bj][n] = bias ? *(const f32x4*)(bias + col0 + bj * HALF + n * 16) : (f32x4){0.f, 0.f, 0.f, 0.f};
#pragma unroll
        for (int ai = 0; ai < 2; ++ai)
#pragma unroll
            for (int m = 0; m < 4; ++m) { float* rowp = C + (size_t)(row0 + ai * HALF + m * 16) * ldc + col0;
#pragma unroll
                for (int bj = 0; bj < 2; ++bj)
#pragma unroll
                    for (int n = 0; n < 2; ++n) *(f32x4*)(rowp + bj * HALF + n * 16) = acc[ai][bj][m][n] + bv[bj][n]; }
    }
};

struct EpiSwiGLU {
    static constexpr bool PERM = true, AFTER_DRAIN = false;
    bf16_t* O; int ldc;
    __device__ __forceinline__ void operator()(const f32x4 (&acc)[2][2][4][2], const Unit& u, int wr, int wc, int fr, int fq) const {
        const int row0 = u.pm * BM + wr * 64 + fr, col0 = u.pn * 128 + wc * 32 + 8 * fq;
#pragma unroll
        for (int ai = 0; ai < 2; ++ai)
#pragma unroll
            for (int m = 0; m < 4; ++m) { bf16_t* rowp = O + (size_t)(row0 + ai * HALF + m * 16) * ldc + col0;
                const f32x4 g0 = acc[ai][0][m][0], g1 = acc[ai][0][m][1], u0 = acc[ai][1][m][0], u1 = acc[ai][1][m][1];
                float r[8];
#pragma unroll
                for (int j = 0; j < 4; ++j) {
                    r[j]     = g0[j] * __builtin_amdgcn_rcpf(1.0f + __builtin_amdgcn_exp2f(-1.4426950408889634f * g0[j])) * u0[j];
                    r[4 + j] = g1[j] * __builtin_amdgcn_rcpf(1.0f + __builtin_amdgcn_exp2f(-1.4426950408889634f * g1[j])) * u1[j]; }
                u32x4 w; w.x = cvt_pk_bf16(r[0], r[1]); w.y = cvt_pk_bf16(r[2], r[3]); w.z = cvt_pk_bf16(r[4], r[5]); w.w = cvt_pk_bf16(r[6], r[7]);
                *(u32x4*)rowp = w; }
    }
};
struct EpiResid {
    static constexpr bool PERM = false, AFTER_DRAIN = false;
    const float* res; float* out; int ldc; const float* gate0; float coef;
    float* slab; unsigned* flags; unsigned target;
    __device__ __forceinline__ void operator()(const f32x4 (&acc)[2][2][4][2], const Unit& u, int wr, int wc, int fr, int fq) const {
        const int tidx = ((wr * 4 + wc) * 4 + fq) * 16 + fr;
        if (u.at == 1) {
            const __amdgpu_buffer_rsrc_t rs = __builtin_amdgcn_make_buffer_rsrc((void*)slab, 0, 0x7FFFFFF0, 0x00020000);
            const unsigned base = ((unsigned)u.slot * 32u * 512u + (unsigned)tidx) * 16u;
#pragma unroll
            for (int ai = 0; ai < 2; ++ai)
#pragma unroll
                for (int bj = 0; bj < 2; ++bj)
#pragma unroll
                    for (int m = 0; m < 4; ++m)
#pragma unroll
                        for (int n = 0; n < 2; ++n) { const f32x4 v = acc[ai][bj][m][n]; u32x4 w; w.x = __float_as_uint(v[0]); w.y = __float_as_uint(v[1]); w.z = __float_as_uint(v[2]); w.w = __float_as_uint(v[3]);
                            __builtin_amdgcn_raw_buffer_store_b128(w, rs, base + (unsigned)((((ai * 2 + bj) * 4 + m) * 2 + n) * 512 * 16), 0, 16); }
            asm volatile("s_waitcnt vmcnt(0)" ::: "memory");
            if ((tidx & 63) == 0) __hip_atomic_fetch_add(flags + 64 * u.slot, 1u, __ATOMIC_RELAXED, __HIP_MEMORY_SCOPE_AGENT);
            return;
        }
        const float* part = nullptr;
        if (u.at == 2) {
            unsigned spins = 0;
            while (__hip_atomic_load(flags + 64 * u.slot, __ATOMIC_RELAXED, __HIP_MEMORY_SCOPE_AGENT) < target) { __builtin_amdgcn_s_sleep(2); if (++spins > (1u << 22)) break; }
            __builtin_amdgcn_fence(__ATOMIC_ACQUIRE, "agent");
            asm volatile("s_waitcnt vmcnt(0)" ::: "memory");
            part = slab + ((size_t)u.slot * 32 * 512 + tidx) * 4;
        }
        const int row0 = u.pm * BM + wr * 64 + fr, col0 = u.pn * BM + wc * 32 + 4 * fq;
        const float* gate = gate0 + (size_t)cond_of_row(u.pm * BM) * NMOD;
        f32x4 gv[2][2];
#pragma unroll
        for (int bj = 0; bj < 2; ++bj)
#pragma unroll
            for (int n = 0; n < 2; ++n) gv[bj][n] = *(const f32x4*)(gate + col0 + bj * HALF + n * 16) * coef;
#pragma unroll
        for (int ai = 0; ai < 2; ++ai)
#pragma unroll
            for (int m = 0; m < 4; ++m) { const size_t off = (size_t)(row0 + ai * HALF + m * 16) * ldc + col0;
#pragma unroll
                for (int bj = 0; bj < 2; ++bj)
#pragma unroll
                    for (int n = 0; n < 2; ++n) {
                        f32x4 a = acc[ai][bj][m][n];
                        if (part) a += *(const f32x4*)(part + (size_t)((((ai * 2 + bj) * 4 + m) * 2 + n) * 512 * 4));
                        const f32x4 bs = *(const f32x4*)(res + off + bj * HALF + n * 16); *(f32x4*)(out + off + bj * HALF + n * 16) = bs + gv[bj][n] * a; }
                asm volatile("" ::: "memory"); }
    }
};
template <class Epi, class Sched, bool STAMP = false>
__device__ __forceinline__ void gemm_phase(PG8_LAS unsigned char* lds, const Gemm g, const Sched& S, const Epi& E, unsigned long long* stamps) {
    const int tid = opaque_tid(), wid = __builtin_amdgcn_readfirstlane(tid >> 6), lane = tid & 63, wr = wid >> 2, wc = wid & 3, fr = lane & 15, fq = lane >> 4;
    const int K = g.K;
    int ts_lo = 0, ts_hi = 0, nts = 0; const unsigned long long rt_entry = STAMP ? (unsigned long long)wall_clock64() : 0ull;
#define PG8_STAMP() do { if (STAMP && wid == 0 && nts < 64) { const unsigned long long _c = (unsigned long long)clock64(); \
        ts_lo = (lane == nts) ? (int)(unsigned)_c : ts_lo; ts_hi = (lane == nts) ? (int)(unsigned)(_c >> 32) : ts_hi; ++nts; } } while (0)
    PG8_STAMP();
    unsigned voffA[2], voffB[2];
#pragma unroll
    for (int i = 0; i < 2; ++i) { int R, C; stage_rc(tid * 16 + i * 8192, R, C); const int Rb = Epi::PERM ? ((R & ~31) + perm32(R & 31)) : R;
        voffA[i] = (unsigned)(R * K + C) * 2u; voffB[i] = (unsigned)(Rb * K + C) * 2u; }
    const size_t kstep = (size_t)(BK * 2);
    const size_t hstep = (size_t)HALF * K * 2;
    const size_t tstep = 2 * hstep;
    const unsigned ldsw = (unsigned)wid * 1024u;
    const int aoff = lds_byte(wr * 64 + fr, fq * 8), boff = lds_byte(wc * 32 + fr, fq * 8);
#define PG8_SA(b, h) (((b) * 2 + (h)) * HTB)
#define PG8_SB(b, h) ((4 + (b) * 2 + (h)) * HTB)
#define PG8_STAGE(bufoff, gbase, voff) do { _Pragma("unroll") for (int _i = 0; _i < 2; ++_i) \
        __builtin_amdgcn_global_load_lds((const unsigned*)((const char*)(gbase) + (voff)[_i]), (PG8_LAS unsigned*)(lds + (bufoff) + ldsw + _i * 8192), 16, 0, 0); } while (0)
#define PG8_LDA(dst, b, h) do { _Pragma("unroll") for (int m = 0; m < 4; ++m) _Pragma("unroll") for (int k = 0; k < 2; ++k) dst[m][k] = *(const PG8_LAS bf16x8*)(lds + PG8_SA(b, h) + aoff + m * 2048 + k * 1024); } while (0)
#define PG8_LDB(dst, b, h) do { _Pragma("unroll") for (int n = 0; n < 2; ++n) _Pragma("unroll") for (int k = 0; k < 2; ++k) dst[n][k] = *(const PG8_LAS bf16x8*)(lds + PG8_SB(b, h) + boff + n * 2048 + k * 1024); } while (0)
#define PG8_MMA(ai, bj, At, Bt) do { __builtin_amdgcn_s_setprio(1); _Pragma("unroll") for (int m = 0; m < 4; ++m) _Pragma("unroll") for (int n = 0; n < 2; ++n) _Pragma("unroll") for (int k = 0; k < 2; ++k) \
        acc[ai][bj][m][n] = __builtin_amdgcn_mfma_f32_16x16x32_bf16(Bt[n][k], At[m][k], acc[ai][bj][m][n], 0, 0, 0); __builtin_amdgcn_s_setprio(0); } while (0)
#define PG8_WAIT_V(n) asm volatile("s_waitcnt vmcnt(" #n ")" ::: "memory")
#define PG8_WAIT_L(n) asm volatile("s_waitcnt lgkmcnt(" #n ")" ::: "memory")
#define PG8_BAR __builtin_amdgcn_s_barrier()
#define PG8_SCHED __builtin_amdgcn_sched_barrier(0)
    Unit cur, nxt; int ui = 0;
    if (!S.next(0, cur)) return;
    f32x4 acc[2][2][4][2];
#pragma unroll
    for (int a = 0; a < 2; ++a)
#pragma unroll
        for (int b = 0; b < 2; ++b)
#pragma unroll
            for (int m = 0; m < 4; ++m)
#pragma unroll
                for (int n = 0; n < 2; ++n) acc[a][b][m][n] = (f32x4){0.f, 0.f, 0.f, 0.f};
    bf16x8 At[4][2], B0[2][2], B1[2][2];
    const char* cA = (const char*)g.A + (size_t)cur.pm * tstep + (size_t)cur.k0 * 2; const char* cB = (const char*)g.Bt + (size_t)cur.pn * tstep + (size_t)cur.k0 * 2;
    S.a_ready(cur);
    PG8_STAGE(PG8_SB(0, 0), cB, voffB); PG8_STAGE(PG8_SA(0, 0), cA, voffA); PG8_STAGE(PG8_SB(0, 1), cB + hstep, voffB); PG8_STAGE(PG8_SA(0, 1), cA + hstep, voffA);
    if (wr == 1) PG8_BAR;
    PG8_WAIT_V(4); PG8_BAR;
    PG8_STAGE(PG8_SB(1, 0), cB + kstep, voffB); PG8_STAGE(PG8_SA(1, 0), cA + kstep, voffA); PG8_STAGE(PG8_SB(1, 1), cB + hstep + kstep, voffB);
    PG8_WAIT_V(6); PG8_BAR;
    PG8_STAMP();
    for (;;) {
        const bool has_next = S.next(ui + 1, nxt);
        const char* nA = has_next ? (const char*)g.A + (size_t)nxt.pm * tstep + (size_t)nxt.k0 * 2 : cA; const char* nB = has_next ? (const char*)g.Bt + (size_t)nxt.pn * tstep + (size_t)nxt.k0 * 2 : cB;
        const int nt = cur.nt;
        for (int t = 0; t < nt; t += 2) {
            const bool last = (t == nt - 2);
            const char* a1 = cA + (size_t)(t + 1) * kstep;
            const char* a2 = last ? nA : cA + (size_t)(t + 2) * kstep; const char* b2 = last ? nB : cB + (size_t)(t + 2) * kstep;
            const char* a3 = a2 + kstep; const char* b3 = b2 + kstep;
            if (last && has_next) S.a_ready(nxt);
            PG8_LDB(B0, 0, 0); PG8_SCHED; PG8_LDA(At, 0, 0); PG8_STAGE(PG8_SA(1, 1), a1 + hstep, voffA);
            PG8_WAIT_L(8); PG8_BAR; PG8_WAIT_L(0); PG8_MMA(0, 0, At, B0); PG8_BAR; PG8_SCHED;
            PG8_LDB(B1, 0, 1); PG8_STAGE(PG8_SB(0, 0), b2, voffB);
            PG8_BAR; PG8_WAIT_L(0); PG8_MMA(0, 1, At, B1); PG8_BAR;
            PG8_LDA(At, 0, 1); PG8_STAGE(PG8_SA(0, 0), a2, voffA);
            PG8_BAR; PG8_WAIT_L(0); PG8_MMA(1, 0, At, B0); PG8_BAR; PG8_SCHED;
            PG8_STAGE(PG8_SB(0, 1), b2 + hstep, voffB);
            PG8_WAIT_V(6); PG8_BAR; PG8_MMA(1, 1, At, B1); PG8_BAR;
            PG8_LDB(B0, 1, 0); PG8_SCHED; PG8_LDA(At, 1, 0); PG8_STAGE(PG8_SA(0, 1), a2 + hstep, voffA);
            PG8_WAIT_L(8); PG8_BAR; PG8_WAIT_L(0); PG8_MMA(0, 0, At, B0); PG8_BAR; PG8_SCHED;
            PG8_LDB(B1, 1, 1); PG8_STAGE(PG8_SB(1, 0), b3, voffB);
            PG8_BAR; PG8_WAIT_L(0); PG8_MMA(0, 1, At, B1); PG8_BAR;
            PG8_LDA(At, 1, 1); PG8_STAGE(PG8_SA(1, 0), a3, voffA);
            PG8_BAR; PG8_WAIT_L(0); PG8_MMA(1, 0, At, B0); PG8_BAR; PG8_SCHED;
            PG8_STAGE(PG8_SB(1, 1), b3 + hstep, voffB);
            PG8_WAIT_V(6); PG8_BAR; PG8_MMA(1, 1, At, B1); PG8_BAR;
        }
        PG8_STAMP();
        if constexpr (!Epi::AFTER_DRAIN) { E(acc, cur, wr, wc, fr, fq); S.done(cur); }
        PG8_STAMP();
        if (!has_next) break;
#pragma unroll
        for (int a = 0; a < 2; ++a)
#pragma unroll
            for (int b = 0; b < 2; ++b)
#pragma unroll
                for (int m = 0; m < 4; ++m)
#pragma unroll
                    for (int n = 0; n < 2; ++n) acc[a][b][m][n] = (f32x4){0.f, 0.f, 0.f, 0.f};
        cur = nxt; cA = nA; cB = nB; ++ui;
    }
    PG8_WAIT_V(0);
    if (wr == 0) PG8_BAR;
    PG8_BAR;
    if constexpr (Epi::AFTER_DRAIN) { E.fused(acc, cur, wr, wc, fr, fq, lds, wid, lane); S.done(cur); }
    PG8_STAMP();
    if (STAMP && wid == 0) { stamps[lane] = lane < nts ? (((unsigned long long)(unsigned)ts_hi << 32) | (unsigned)ts_lo) : 0ull;
        if (lane == 62) stamps[62] = rt_entry; if (lane == 63) stamps[63] = (unsigned long long)wall_clock64(); }
#undef PG8_STAMP
#undef PG8_SA
#undef PG8_SB
#undef PG8_STAGE
#undef PG8_LDA
#undef PG8_LDB
#undef PG8_MMA
#undef PG8_WAIT_V
#undef PG8_WAIT_L
#undef PG8_BAR
#undef PG8_SCHED
}
}
#ifndef ATT_INLINE
#define ATT_INLINE __forceinline__
#endif
namespace att {
constexpr int D = 128, NW = 8, QBLK = 32, KVBLK = 64, LDQ = 512, LDO = DM;
constexpr float SCALE = 0.088388347648318440f;
constexpr float THR = 8.f;
constexpr size_t SHM_V = KVBLK * D * 2, SHM_K = KVBLK * D * 2, SHM_Q = 256 * D * 2, SHM_ATTN = 2 * SHM_V + 2 * SHM_K + NW * 64 * 4 + SHM_Q;
using bf16x8 = __attribute__((ext_vector_type(8))) short;
using s16x4  = __attribute__((ext_vector_type(4))) short;
using f32x16 = __attribute__((ext_vector_type(16))) float;
using u32x4  = __attribute__((ext_vector_type(4))) unsigned;
#define KSWZ(row, colB) ((row) * 256 + ((colB) ^ (((row) & 7) << 4)))
#define SBAR() __builtin_amdgcn_sched_barrier(0)
__device__ __forceinline__ int crow(int r, int hi) { return (r & 3) + 8 * (r >> 2) + 4 * hi; }
__device__ __forceinline__ unsigned cvtpk(float lo, float hi) { unsigned r; asm volatile("v_cvt_pk_bf16_f32 %0, %1, %2" : "=v"(r) : "v"(lo), "v"(hi)); return r; }

__device__ __forceinline__ void partialSM(f32x16& p0, f32x16& p1, float& m_reg, float& mn, float& alpha) {
  constexpr float C = SCALE * 1.4426950408889634f;
  float pmax = p0[0]; for (int r = 1; r < 16; ++r) pmax = fmaxf(pmax, p0[r]); for (int r = 0; r < 16; ++r) pmax = fmaxf(pmax, p1[r]);
  { auto rr = __builtin_amdgcn_permlane32_swap(__float_as_uint(pmax), __float_as_uint(pmax), false, false);
    pmax = fmaxf(__uint_as_float(rr[0]), __uint_as_float(rr[1])); }
  if (__builtin_expect(__all(pmax - m_reg <= THR / SCALE), 1)) { mn = m_reg; alpha = 1.f; }
  else { mn = fmaxf(m_reg, pmax); alpha = __builtin_amdgcn_exp2f((m_reg - mn) * C); m_reg = mn; }
  float mnC = -mn * C;
  for (int r = 0; r < 16; ++r) p0[r] = fmaf(p0[r], C, mnC); for (int r = 0; r < 16; ++r) p1[r] = fmaf(p1[r], C, mnC);
  for (int r = 0; r < 16; ++r) p0[r] = __builtin_amdgcn_exp2f(p0[r]);
}
__device__ __forceinline__ void finishSM(f32x16& p0, f32x16& p1, float alpha, float& l_reg, bf16x8& pa0, bf16x8& pa1, bf16x8& pa2, bf16x8& pa3) {
  for (int r = 0; r < 16; ++r) p1[r] = __builtin_amdgcn_exp2f(p1[r]);
  float ps = 0; for (int r = 0; r < 16; ++r) ps += p0[r]; for (int r = 0; r < 16; ++r) ps += p1[r];
  { auto rr = __builtin_amdgcn_permlane32_swap(__float_as_uint(ps), __float_as_uint(ps), false, false);
    ps = __uint_as_float(rr[0]) + __uint_as_float(rr[1]); }
  l_reg = l_reg * alpha + ps;
#define PK4(P, BASE, OUT) do { unsigned a0 = cvtpk(P[BASE + 0], P[BASE + 1]), a1 = cvtpk(P[BASE + 2], P[BASE + 3]);   \
    unsigned b0 = cvtpk(P[BASE + 4], P[BASE + 5]), b1 = cvtpk(P[BASE + 6], P[BASE + 7]);                              \
    auto r0 = __builtin_amdgcn_permlane32_swap(a0, b0, false, false); auto r1 = __builtin_amdgcn_permlane32_swap(a1, b1, false, false); \
    u32x4 w = {r0[0], r1[0], r0[1], r1[1]}; OUT = *reinterpret_cast<bf16x8*>(&w); } while (0)
  PK4(p0, 0, pa0); PK4(p0, 8, pa1); PK4(p1, 0, pa2); PK4(p1, 8, pa3);
#undef PK4
}
__device__ __forceinline__ void qkt(f32x16& p0, f32x16& p1, const bf16_t* Ks, const bf16_t* Qs, int qrow, int r32, int hi) {
  p0 = f32x16{}; p1 = f32x16{};
#pragma unroll
  for (int d0 = 0; d0 < 8; ++d0) { int cb = (d0 * 16 + hi * 8) * 2;
    bf16x8 q = *reinterpret_cast<const bf16x8*>((const char*)Qs + KSWZ(qrow, cb));
    bf16x8 b0 = *reinterpret_cast<const bf16x8*>((const char*)Ks + KSWZ(r32, cb));
    bf16x8 b1 = *reinterpret_cast<const bf16x8*>((const char*)Ks + KSWZ(32 + r32, cb));
    p0 = __builtin_amdgcn_mfma_f32_32x32x16_bf16(b0, q, p0, 0, 0, 0);
    p1 = __builtin_amdgcn_mfma_f32_32x32x16_bf16(b1, q, p1, 0, 0, 0); }
}
__device__ __forceinline__ int v_st(int k, int c) { const int kk = (k & ~0xC) | ((k & 4) << 1) | ((k & 8) >> 1); return ((kk >> 3) * 4 + (c >> 5)) * 512 + ((kk & 7) * 32 + (c & 31)) * 2; }
__device__ __forceinline__ int v_rd_base(int lane) { return ((lane & 3) << 3) | (((lane >> 2) & 3) << 6) | (((lane >> 4) & 1) << 5) | (((lane >> 5) & 1) << 8); }
constexpr int v_rd_off(int d0, int ks, int half) { return d0 * 512 + ks * 4096 + half * 2048; }
template <int OFF> __device__ __forceinline__ s16x4 tr_read(int vb) {
  s16x4 r; asm volatile("ds_read_b64_tr_b16 %0, %1 offset:%2" : "=&v"(r) : "v"(vb), "i"(OFF) : "memory"); return r;
}
template <int D0> __device__ __forceinline__ void pv_one(f32x16& od, int vb, bf16x8 pa0, bf16x8 pa1, bf16x8 pa2, bf16x8 pa3) {
  const s16x4 l0 = tr_read<v_rd_off(D0, 0, 0)>(vb), h0 = tr_read<v_rd_off(D0, 0, 1)>(vb), l1 = tr_read<v_rd_off(D0, 1, 0)>(vb), h1 = tr_read<v_rd_off(D0, 1, 1)>(vb);
  const s16x4 l2 = tr_read<v_rd_off(D0, 2, 0)>(vb), h2 = tr_read<v_rd_off(D0, 2, 1)>(vb), l3 = tr_read<v_rd_off(D0, 3, 0)>(vb), h3 = tr_read<v_rd_off(D0, 3, 1)>(vb);
  asm volatile("s_waitcnt lgkmcnt(0)" ::: "memory"); SBAR();
#define PK(L, H) (bf16x8){L[0], L[1], L[2], L[3], H[0], H[1], H[2], H[3]}
  od = __builtin_amdgcn_mfma_f32_32x32x16_bf16(pa0, PK(l0, h0), od, 0, 0, 0);
  od = __builtin_amdgcn_mfma_f32_32x32x16_bf16(pa1, PK(l1, h1), od, 0, 0, 0);
  od = __builtin_amdgcn_mfma_f32_32x32x16_bf16(pa2, PK(l2, h2), od, 0, 0, 0);
  od = __builtin_amdgcn_mfma_f32_32x32x16_bf16(pa3, PK(l3, h3), od, 0, 0, 0);
#undef PK
}
__device__ __forceinline__ void pv_d0(f32x16* o, int vb, bf16x8 pa0, bf16x8 pa1, bf16x8 pa2, bf16x8 pa3) {
  pv_one<0>(o[0], vb, pa0, pa1, pa2, pa3); pv_one<1>(o[1], vb, pa0, pa1, pa2, pa3); pv_one<2>(o[2], vb, pa0, pa1, pa2, pa3); pv_one<3>(o[3], vb, pa0, pa1, pa2, pa3);
}

struct SrcOne { const bf16_t* k0; const bf16_t* v0; int ldk;
  __device__ __forceinline__ const bf16_t* k(int j) const { return k0 + (size_t)j * 64 * ldk; }
  __device__ __forceinline__ const bf16_t* v(int j) const { return v0 + (size_t)j * 64 * ldk; } };
struct SrcTwo { const bf16_t* ck; const bf16_t* cv; const bf16_t* k1; const bf16_t* v1; int ldk;
  __device__ __forceinline__ const bf16_t* k(int j) const { return j < 4 ? ck + (size_t)j * 64 * ldk : k1 + (size_t)(j - 4) * 64 * ldk; }
  __device__ __forceinline__ const bf16_t* v(int j) const { return j < 4 ? cv + (size_t)j * 64 * ldk : v1 + (size_t)(j - 4) * 64 * ldk; } };
struct NoBias { __device__ __forceinline__ void operator()(f32x16&, f32x16&, int, int, int, int) const {} };
struct NaBias { const float* tab; int i0, kr0;
  __device__ __forceinline__ void operator()(f32x16& p0, f32x16& p1, int jt, int wid, int r32, int hi) const {
    if (jt < 4) return;
    const int qi = i0 + wid * QBLK + r32, r = qi >> 6, qc = qi & 63, kr = kr0 + jt - 4;
    int lo = r - 4; lo = lo < 0 ? 0 : (lo > 8 ? 8 : lo);
    const bool rowok = (kr >= lo) && (kr < lo + 8);
    if (!rowok) {
#pragma unroll
      for (int rr = 0; rr < 16; ++rr) { p0[rr] = -1e30f; p1[rr] = -1e30f; }
      return;
    }
    int c0 = qc - 8; c0 = c0 < 0 ? 0 : (c0 > 48 ? 48 : c0);
    const int dr = kr - r + 7;
    const float* tb = tab + dr * 31 + (4 * hi - qc + 15);
    const int w0 = 4 * hi - c0;
#pragma unroll
    for (int g = 0; g < 4; ++g) {
#pragma unroll
      for (int q = 0; q < 4; ++q) {
        const int rr = 4 * g + q, kc0 = q + 8 * g;
        const float t0 = tb[kc0], t1 = tb[kc0 + 32];
        p0[rr] = ((unsigned)(kc0 + w0) < 16u) ? p0[rr] + t0 : -1e30f;
        p1[rr] = ((unsigned)(kc0 + 32 + w0) < 16u) ? p1[rr] + t1 : -1e30f;
      }
      SBAR();
    }
  } };

template <int SD, class Src, class Bias>
__device__ ATT_INLINE void attn_body(const bf16_t* __restrict__ Qb, const Src src, bf16_t* __restrict__ Ob, const int NT, char* lds, const Bias bias) {
  const int tid = opaque_tid(), wid = tid >> 6, lane = tid & 63, r32 = lane & 31, hi = lane >> 5;
  const int LDK = src.ldk;
  bf16_t* V_lds = (bf16_t*)lds; bf16_t* K_lds = (bf16_t*)(lds + 2 * SHM_V);
  float* ws = (float*)(lds + 2 * SHM_V + 2 * SHM_K) + wid * 64; float* li_l = ws; float* al_l = ws + 32;
  float m_reg = -1e30f, l_reg = 0; f32x16 o[4] = {};
  bf16_t* Q_lds = (bf16_t*)(lds + 2 * SHM_V + 2 * SHM_K + NW * 64 * 4);
  const int qrow = wid * QBLK + r32;
  {
#pragma unroll
    for (int i = 0; i < 8; ++i) { const int f = tid + 512 * i, row = f >> 4, c8 = (f & 15) * 8;
      *(bf16x8*)((char*)Q_lds + KSWZ(row, c8 * 2)) = *reinterpret_cast<const bf16x8*>(Qb + (long)row * LDQ + c8); }
  }
  const int sr = tid >> 4, sc = (tid & 15) * 8, vst0 = v_st(sr, sc), vst1 = v_st(32 + sr, sc);
  const int vb0 = (int)(uintptr_t)V_lds + v_rd_base(lane);
  struct { bf16x8 vs0, vs1, ks0, ks1; } sr_[SD];
#define SLOAD(i, jt) do { const bf16_t* kt_ = src.k(jt); const bf16_t* vt_ = src.v(jt); \
    sr_[i].vs0 = *reinterpret_cast<const bf16x8*>(&vt_[(long)sr * LDK + sc]); sr_[i].vs1 = *reinterpret_cast<const bf16x8*>(&vt_[(long)(32 + sr) * LDK + sc]); \
    sr_[i].ks0 = *reinterpret_cast<const bf16x8*>(&kt_[(long)sr * LDK + sc]); sr_[i].ks1 = *reinterpret_cast<const bf16x8*>(&kt_[(long)(32 + sr) * LDK + sc]); } while (0)
#define SWRITE(b, i) do { *(bf16x8*)((char*)V_lds + (b) * SHM_V + vst0) = sr_[i].vs0;          \
    *(bf16x8*)((char*)V_lds + (b) * SHM_V + vst1) = sr_[i].vs1; int kc = sc * 2;               \
    *(bf16x8*)((char*)K_lds + (b) * SHM_K + KSWZ(sr, kc)) = sr_[i].ks0;                       \
    *(bf16x8*)((char*)K_lds + (b) * SHM_K + KSWZ(32 + sr, kc)) = sr_[i].ks1; } while (0)
#define SWAIT() do { if constexpr (SD == 2) asm volatile("s_waitcnt vmcnt(4)" ::: "memory"); else asm volatile("s_waitcnt vmcnt(0)" ::: "memory"); } while (0)
#define RESC(a) do { if (__any((a) < 1.f)) { if (hi == 0) al_l[r32] = (a); asm volatile("s_waitcnt lgkmcnt(0)" ::: "memory"); \
    for (int d = 0; d < 4; ++d) for (int r = 0; r < 16; ++r) o[d][r] *= al_l[crow(r, hi)]; } } while (0)
  f32x16 pA0, pA1, pB0, pB1; float mnA, mnB, alA, alB; bf16x8 pa0, pa1, pa2, pa3;
  constexpr int SE = 0, SO = SD - 1;
  SLOAD(SE, 0); asm volatile("s_waitcnt vmcnt(0)" ::: "memory"); SWRITE(0, SE); __syncthreads();
  qkt(pA0, pA1, K_lds, Q_lds, qrow, r32, hi); bias(pA0, pA1, 0, wid, r32, hi); partialSM(pA0, pA1, m_reg, mnA, alA);
  SLOAD(SO, 1); if constexpr (SD == 2) { if (2 < NT) SLOAD(SE, 2); }
  SWAIT(); SWRITE(1, SO); __syncthreads();
  for (int j = 1; j + 1 < NT; j += 2) {
    SBAR(); qkt(pB0, pB1, (bf16_t*)((char*)K_lds + SHM_K), Q_lds, qrow, r32, hi); bias(pB0, pB1, j, wid, r32, hi);
    finishSM(pA0, pA1, alA, l_reg, pa0, pa1, pa2, pa3); SBAR();
    SLOAD(SO, j + SD); SBAR();
    pv_d0(o, vb0, pa0, pa1, pa2, pa3); partialSM(pB0, pB1, m_reg, mnB, alB);
    __syncthreads(); SWAIT(); SWRITE(0, SE);
    RESC(alB); __syncthreads();
    SBAR(); qkt(pA0, pA1, K_lds, Q_lds, qrow, r32, hi); bias(pA0, pA1, j + 1, wid, r32, hi);
    finishSM(pB0, pB1, alB, l_reg, pa0, pa1, pa2, pa3); SBAR();
    if (SD == 1 || j + 3 < NT) SLOAD(SE, j + 1 + SD); SBAR();
    pv_d0(o, vb0 + (int)SHM_V, pa0, pa1, pa2, pa3); partialSM(pA0, pA1, m_reg, mnA, alA);
    __syncthreads(); SWAIT(); SWRITE(1, SO);
    RESC(alA); __syncthreads();
  }
  SBAR(); qkt(pB0, pB1, (bf16_t*)((char*)K_lds + SHM_K), Q_lds, qrow, r32, hi); bias(pB0, pB1, NT - 1, wid, r32, hi);
  finishSM(pA0, pA1, alA, l_reg, pa0, pa1, pa2, pa3); SBAR();
  pv_d0(o, vb0, pa0, pa1, pa2, pa3); partialSM(pB0, pB1, m_reg, mnB, alB);
  __syncthreads(); RESC(alB);
  finishSM(pB0, pB1, alB, l_reg, pa0, pa1, pa2, pa3); SBAR();
  pv_d0(o, vb0 + (int)SHM_V, pa0, pa1, pa2, pa3);
  if (hi == 0) li_l[r32] = l_reg; asm volatile("s_waitcnt lgkmcnt(0)" ::: "memory");
  float rli[16];
#pragma unroll
  for (int r = 0; r < 16; ++r) rli[r] = __builtin_amdgcn_rcpf(li_l[crow(r, hi)]);
  bf16_t* Ow = Ob + (long)(wid * QBLK) * LDO;
#pragma unroll
  for (int r = 0; r < 16; ++r) { int orow = crow(r, hi);
    for (int d0 = 0; d0 < 4; ++d0) Ow[(long)orow * LDO + d0 * 32 + r32] = f2bf(o[d0][r] * rli[r]); }
#undef SLOAD
#undef SWRITE
#undef SWAIT
#undef RESC
}
}
namespace gdn {
using att::bf16x8; using att::f32x16; using att::crow;
constexpr int C = 32, SK = 136, SS = 40;
constexpr int OFF_KT = 0, OFF_QT = OFF_KT + C * SK * 2, OFF_W = OFF_QT + C * SK * 2, OFF_KTT = OFF_W + C * SK * 2, OFF_VTT = OFF_KTT + 128 * SS * 2,
              OFF_VN = OFF_VTT + 128 * SS * 2, OFF_VNS = OFF_VN + 128 * SS * 2, OFF_ST = OFF_VNS + 128 * SS * 2, OFF_TB = OFF_ST + 128 * SK * 2,
              OFF_TBE = OFF_TB + C * SS * 2, OFF_ATT = OFF_TBE + C * SS * 2, OFF_L = OFF_ATT + C * SS * 2, OFF_SC = OFF_L + C * C * 4, GDN_LDS = OFF_SC + 1024;
template <int K>
__device__ __forceinline__ f32x16 mm(const bf16_t* A, int lda, const bf16_t* Bt, int ldb, int l32, int hi, f32x16 acc) {
#pragma unroll
    for (int k0 = 0; k0 < K; k0 += 16) {
        const bf16x8 a = *reinterpret_cast<const bf16x8*>(A + l32 * lda + k0 + 8 * hi);
        const bf16x8 b = *reinterpret_cast<const bf16x8*>(Bt + l32 * ldb + k0 + 8 * hi);
        acc = __builtin_amdgcn_mfma_f32_32x32x16_bf16(a, b, acc, 0, 0, 0);
    }
    return acc;
}
__device__ __forceinline__ uint2 pk4(float a, float b, float c, float d) { uint2 w; w.x = pack2(a, b); w.y = pack2(c, d); return w; }

__device__ __forceinline__ void gdn_chunked(const Params& p, int l, bool ctx, int b, int h, int dir, unsigned char* lds) {
    const int tid = opaque_tid(), wid = tid >> 6, lane = tid & 63, l32 = lane & 31, hi = lane >> 5;
    const int T = ctx ? CT : ::LT; const size_t m0 = ctx ? (size_t)b * CT : (size_t)MC + (size_t)b * ::LT;
    const float* DQ = WSP(float, WS_DQ); const float* DK = WSP(float, WS_DK); const float* DV = WSP(float, WS_DV); const float* DBA = WSP(float, WS_DBA);
    float* O = WSP(float, dir ? WS_DOB : WS_DOF);
    bf16_t* Kt = (bf16_t*)(lds + OFF_KT); bf16_t* Qt = (bf16_t*)(lds + OFF_QT); bf16_t* W = (bf16_t*)(lds + OFF_W); bf16_t* KT = (bf16_t*)(lds + OFF_KTT); bf16_t* VT = (bf16_t*)(lds + OFF_VTT);
    bf16_t* VN = (bf16_t*)(lds + OFF_VN); bf16_t* VNS = (bf16_t*)(lds + OFF_VNS); bf16_t* ST = (bf16_t*)(lds + OFF_ST); bf16_t* TB = (bf16_t*)(lds + OFF_TB); bf16_t* TBE = (bf16_t*)(lds + OFF_TBE);
    bf16_t* ATT = (bf16_t*)(lds + OFF_ATT); float* Lm = (float*)(lds + OFF_L); float* sc = (float*)(lds + OFF_SC);
    const int nch = T / C;
#define TOK(c, s_) (m0 + (dir ? T - 1 - ((c) * C + (s_)) : (c) * C + (s_)))
    f32x16 S[2];
#pragma unroll
    for (int bi = 0; bi < 2; ++bi) {
        const int blk = wid * 2 + bi, d0 = 32 * (blk >> 2), e0 = 32 * (blk & 3);
        if (ctx) { S[bi] = f32x16{}; }
        else {
            const float* s0 = p.in[I_SGDN] + ((((size_t)b * DEPTH + l) * 2 + dir) * 4 + h) * 128 * 128 + e0 + l32;
#pragma unroll
            for (int r = 0; r < 16; ++r) S[bi][r] = s0[(size_t)(d0 + crow(r, hi)) * 128];
        }
    }
    const int ls = tid >> 5, lc = (tid & 31) * 4;
    vf4 pq0, pq1, pk0, pk1, pv0, pv1; float pbeta = 0.f, pg = 0.f;
#define GLOAD(c) do { const size_t ma = TOK(c, ls), mb = TOK(c, ls + 16); \
        pq0 = *(const vf4*)(DQ + ma * 512 + h * 128 + lc); pq1 = *(const vf4*)(DQ + mb * 512 + h * 128 + lc); \
        pk0 = *(const vf4*)(DK + ma * 512 + h * 128 + lc); pk1 = *(const vf4*)(DK + mb * 512 + h * 128 + lc); \
        pv0 = *(const vf4*)(DV + ma * 512 + h * 128 + lc); pv1 = *(const vf4*)(DV + mb * 512 + h * 128 + lc); \
        if (tid < C) { const size_t mt = TOK(c, tid); pbeta = DBA[mt * 16 + dir * 4 + h]; pg = DBA[mt * 16 + 8 + dir * 4 + h]; } } while (0)
#define GSTAGE() do { \
        *(uint2*)(Kt + ls * SK + lc) = pk4(pk0.x, pk0.y, pk0.z, pk0.w); *(uint2*)(Kt + (ls + 16) * SK + lc) = pk4(pk1.x, pk1.y, pk1.z, pk1.w); \
        *(uint2*)(Qt + ls * SK + lc) = pk4(pq0.x, pq0.y, pq0.z, pq0.w); *(uint2*)(Qt + (ls + 16) * SK + lc) = pk4(pq1.x, pq1.y, pq1.z, pq1.w); \
        _Pragma("unroll") for (int j = 0; j < 4; ++j) { KT[(lc + j) * SS + ls] = f2bf(pk0[j]); KT[(lc + j) * SS + ls + 16] = f2bf(pk1[j]); \
                                                        VT[(lc + j) * SS + ls] = f2bf(pv0[j]); VT[(lc + j) * SS + ls + 16] = f2bf(pv1[j]); } \
        if (wid == 0) { float x = pg; _Pragma("unroll") for (int o_ = 1; o_ < 32; o_ <<= 1) { const float y = __shfl_up(x, o_); if (lane >= o_) x += y; } \
            const float Bt_ = __shfl(x, 31); if (lane < C) { sc[lane] = pbeta; sc[32 + lane] = x; sc[64 + lane] = __expf(x); sc[96 + lane] = __expf(Bt_ - x); if (lane == 0) sc[128] = __expf(Bt_); } } } while (0)
    __syncthreads();
    GLOAD(0);
#pragma unroll
    for (int bi = 0; bi < 2; ++bi) {
        const int blk = wid * 2 + bi, d0 = 32 * (blk >> 2), e0 = 32 * (blk & 3);
#pragma unroll
        for (int g = 0; g < 4; ++g) *(uint2*)(ST + (e0 + l32) * SK + d0 + 8 * g + 4 * hi) = pk4(S[bi][4 * g], S[bi][4 * g + 1], S[bi][4 * g + 2], S[bi][4 * g + 3]);
    }
    GSTAGE();
    __syncthreads();
    for (int c = 0; c < nch; ++c) {
        if (c + 1 < nch) GLOAD(c + 1);
        f32x16 acc1 = f32x16{};
        if (wid == 0) {
            const f32x16 kk = mm<128>(Kt, SK, Kt, SK, l32, hi, f32x16{});
            const float bi_ = sc[32 + l32], be = sc[l32];
#pragma unroll
            for (int r = 0; r < 16; ++r) { const int j = crow(r, hi); const float v = (l32 > j) ? be * kk[r] * __expf(bi_ - sc[32 + j]) : 0.f;
                Lm[l32 * 32 + ((r & 3) + 4 * hi) * 4 + (r >> 2)] = v; }
        } else if (wid == 1) {
            const f32x16 kq = mm<128>(Kt, SK, Qt, SK, l32, hi, f32x16{});
            const float bi_ = sc[32 + l32];
            float a[16];
#pragma unroll
            for (int r = 0; r < 16; ++r) { const int j = crow(r, hi); a[r] = (l32 >= j) ? kq[r] * __expf(bi_ - sc[32 + j]) : 0.f; }
#pragma unroll
            for (int g = 0; g < 4; ++g) *(uint2*)(ATT + l32 * SS + 8 * g + 4 * hi) = pk4(a[4 * g], a[4 * g + 1], a[4 * g + 2], a[4 * g + 3]);
        } else if (wid >= 4) {
            acc1 = mm<128>(Qt, SK, ST + (32 * (wid - 4)) * SK, SK, l32, hi, f32x16{});
#pragma unroll
            for (int r = 0; r < 16; ++r) acc1[r] *= sc[64 + crow(r, hi)];
        }
        __syncthreads();
        if (tid < 256) {
            const int cc = tid >> 3, part = tid & 7;
            float Tr[4] = {0.f, 0.f, 0.f, 0.f};
            const float* Lp = Lm + part * 4;
#pragma unroll
            for (int i = 0; i < 32; ++i) {
                const vf4 lv = *(const vf4*)(Lp + i * 32);
                float s = lv.x * Tr[0] + lv.y * Tr[1] + lv.z * Tr[2] + lv.w * Tr[3];
                s = red8(s);
                const float t = (i == cc ? 1.f : 0.f) - s;
                if (part == (i & 7)) Tr[i >> 3] = t;
            }
            const float bc = sc[cc], bec = bc * sc[64 + cc];
#pragma unroll
            for (int jj = 0; jj < 4; ++jj) { TB[(part + 8 * jj) * SS + cc] = f2bf(Tr[jj] * bc); TBE[(part + 8 * jj) * SS + cc] = f2bf(Tr[jj] * bec); }
        }
        __syncthreads();
        if (wid < 4) {
            acc1 = mm<32>(TB, SS, VT + (32 * wid) * SS, SS, l32, hi, f32x16{});
        } else {
            const int d0 = 32 * (wid - 4);
            const f32x16 wt = mm<32>(KT + d0 * SS, SS, TBE, SS, l32, hi, f32x16{});
#pragma unroll
            for (int g = 0; g < 4; ++g) *(uint2*)(W + l32 * SK + d0 + 8 * g + 4 * hi) = pk4(wt[4 * g], wt[4 * g + 1], wt[4 * g + 2], wt[4 * g + 3]);
        }
        __syncthreads();
        if (wid < 4) {
            const int e0 = 32 * wid;
            const f32x16 ws = mm<128>(W, SK, ST + e0 * SK, SK, l32, hi, f32x16{});
            float vn[16], vs[16];
#pragma unroll
            for (int r = 0; r < 16; ++r) { vn[r] = acc1[r] - ws[r]; vs[r] = vn[r] * sc[96 + crow(r, hi)]; }
#pragma unroll
            for (int g = 0; g < 4; ++g) { *(uint2*)(VN + (e0 + l32) * SS + 8 * g + 4 * hi) = pk4(vn[4 * g], vn[4 * g + 1], vn[4 * g + 2], vn[4 * g + 3]);
                                          *(uint2*)(VNS + (e0 + l32) * SS + 8 * g + 4 * hi) = pk4(vs[4 * g], vs[4 * g + 1], vs[4 * g + 2], vs[4 * g + 3]); }
        }
        __syncthreads();
        if (wid >= 4) {
            const int e0 = 32 * (wid - 4);
            acc1 = mm<32>(ATT, SS, VN + e0 * SS, SS, l32, hi, acc1);
#pragma unroll
            for (int r = 0; r < 16; ++r) O[TOK(c, crow(r, hi)) * 512 + h * 128 + e0 + l32] = acc1[r];
        }
        {
            const float eB = sc[128];
#pragma unroll
            for (int bi = 0; bi < 2; ++bi) {
                const int blk = wid * 2 + bi, d0 = 32 * (blk >> 2), e0 = 32 * (blk & 3);
#pragma unroll
                for (int r = 0; r < 16; ++r) S[bi][r] *= eB;
                S[bi] = mm<32>(KT + d0 * SS, SS, VNS + e0 * SS, SS, l32, hi, S[bi]);
            }
        }
        __syncthreads();
#pragma unroll
        for (int bi = 0; bi < 2; ++bi) {
            const int blk = wid * 2 + bi, d0 = 32 * (blk >> 2), e0 = 32 * (blk & 3);
#pragma unroll
            for (int g = 0; g < 4; ++g) *(uint2*)(ST + (e0 + l32) * SK + d0 + 8 * g + 4 * hi) = pk4(S[bi][4 * g], S[bi][4 * g + 1], S[bi][4 * g + 2], S[bi][4 * g + 3]);
        }
        if (c + 1 < nch) GSTAGE();
        __syncthreads();
    }
#undef GLOAD
#undef GSTAGE
#undef TOK
    if (ctx) {
#pragma unroll
        for (int bi = 0; bi < 2; ++bi) {
            const int blk = wid * 2 + bi, d0 = 32 * (blk >> 2), e0 = 32 * (blk & 3);
            float* so = p.out + O_SGDN + ((((size_t)b * DEPTH + l) * 2 + dir) * 4 + h) * 128 * 128 + e0 + l32;
#pragma unroll
            for (int r = 0; r < 16; ++r) so[(size_t)(d0 + crow(r, hi)) * 128] = S[bi][r];
        }
    }
}
}

namespace gla {
using att::bf16x8; using att::f32x16; using att::crow; using gdn::mm; using gdn::pk4;
constexpr int C = 32, SQ = 72, SS = 40;
constexpr int OFF_QE = 0, OFF_KN = OFF_QE + C * SQ * 2, OFF_KET = OFF_KN + C * SQ * 2, OFF_VT = OFF_KET + 64 * SS * 2, OFF_ATT = OFF_VT + 128 * SS * 2, OFF_ST = OFF_ATT + C * SS * 2,
              OFF_LA = OFF_ST + 128 * SQ * 2, OFF_EB = OFF_LA + C * 64 * 4, GLA_LDS = OFF_EB + 256;
__device__ __forceinline__ void gla_chunked(const Params& p, int l, bool ctx, int b, int h, int dir, unsigned char* lds) {
    const int tid = opaque_tid(), wid = tid >> 6, lane = tid & 63, l32 = lane & 31, hi = lane >> 5;
    const int T = ctx ? CT : ::LT; const size_t m0 = ctx ? (size_t)b * CT : (size_t)MC + (size_t)b * ::LT;
    const float* Z = WSP(float, WS_Z); const float* LA = WSP(float, dir ? WS_AB : WS_AF);
    float* O = WSP(float, dir ? WS_GOB : WS_GOF);
    bf16_t* Qe = (bf16_t*)(lds + OFF_QE); bf16_t* Kn = (bf16_t*)(lds + OFF_KN); bf16_t* KeT = (bf16_t*)(lds + OFF_KET); bf16_t* VT = (bf16_t*)(lds + OFF_VT);
    bf16_t* ATT = (bf16_t*)(lds + OFF_ATT); bf16_t* ST = (bf16_t*)(lds + OFF_ST); float* la = (float*)(lds + OFF_LA); float* eB = (float*)(lds + OFF_EB);
    const int nch = T / C;
#define TOK(c, s_) (m0 + (dir ? T - 1 - ((c) * C + (s_)) : (c) * C + (s_)))
    const int d0 = 32 * (wid >> 2), e0 = 32 * (wid & 3);
    f32x16 S;
    if (ctx) S = f32x16{};
    else {
        const float* s0 = p.in[I_SGLA] + ((((size_t)b * DEPTH + l) * 2 + dir) * 4 + h) * 64 * 128 + e0 + l32;
#pragma unroll
        for (int r = 0; r < 16; ++r) S[r] = s0[(size_t)(d0 + crow(r, hi)) * 128];
    }
    const int ts = tid >> 4, dc = (tid & 15) * 4, vs = tid >> 5, vc = (tid & 31) * 4;
    vf4 pq, pk, pl, pv0, pv1;
#define GLOAD(c) do { const size_t mt = TOK(c, ts), ma = TOK(c, vs), mb = TOK(c, vs + 16); \
        pq = *(const vf4*)(Z + mt * NINP + Z_GLQ + h * 64 + dc); pk = *(const vf4*)(Z + mt * NINP + Z_GLK + h * 64 + dc); pl = *(const vf4*)(LA + mt * 256 + h * 64 + dc); \
        pv0 = *(const vf4*)(Z + ma * NINP + Z_GLV + h * 128 + vc); pv1 = *(const vf4*)(Z + mb * NINP + Z_GLV + h * 128 + vc); } while (0)
#define WRITE_ST() do { _Pragma("unroll") for (int g = 0; g < 4; ++g) *(uint2*)(ST + (e0 + l32) * SQ + d0 + 8 * g + 4 * hi) = pk4(S[4 * g], S[4 * g + 1], S[4 * g + 2], S[4 * g + 3]); } while (0)
#define GIMAGES() do { vf4 pre = (vf4){0.f, 0.f, 0.f, 0.f}, tot = pre; \
        _Pragma("unroll 8") for (int t_ = 0; t_ < C; ++t_) { const vf4 v_ = *(const vf4*)(la + t_ * 64 + dc); tot += v_; if (t_ <= ts) pre += v_; } \
        float qe[4], kn[4]; \
        _Pragma("unroll") for (int j = 0; j < 4; ++j) { qe[j] = pq[j] * 0.125f * __expf(pre[j]); kn[j] = pk[j] * __expf(fminf(-pre[j], 80.f)); \
            KeT[(dc + j) * SS + ts] = f2bf(pk[j] * __expf(tot[j] - pre[j])); } \
        *(uint2*)(Qe + ts * SQ + dc) = pk4(qe[0], qe[1], qe[2], qe[3]); *(uint2*)(Kn + ts * SQ + dc) = pk4(kn[0], kn[1], kn[2], kn[3]); \
        if (ts == 0) { _Pragma("unroll") for (int j = 0; j < 4; ++j) eB[dc + j] = __expf(tot[j]); } \
        _Pragma("unroll") for (int j = 0; j < 4; ++j) { VT[(vc + j) * SS + vs] = f2bf(pv0[j]); VT[(vc + j) * SS + vs + 16] = f2bf(pv1[j]); } } while (0)
    __syncthreads();
    GLOAD(0);
    WRITE_ST();
    *(vf4*)(la + ts * 64 + dc) = pl;
    __syncthreads();
    GIMAGES();
    __syncthreads();
    for (int c = 0; c < nch; ++c) {
        if (c + 1 < nch) GLOAD(c + 1);
        f32x16 o1 = f32x16{};
        if (wid == 0) {
            const f32x16 kq = mm<64>(Kn, SQ, Qe, SQ, l32, hi, f32x16{});
            float a[16];
#pragma unroll
            for (int r = 0; r < 16; ++r) a[r] = (l32 >= crow(r, hi)) ? kq[r] : 0.f;
#pragma unroll
            for (int g = 0; g < 4; ++g) *(uint2*)(ATT + l32 * SS + 8 * g + 4 * hi) = pk4(a[4 * g], a[4 * g + 1], a[4 * g + 2], a[4 * g + 3]);
        } else if (wid >= 4) {
            o1 = mm<64>(Qe, SQ, ST + (32 * (wid - 4)) * SQ, SQ, l32, hi, f32x16{});
        }
        __syncthreads();
        if (wid >= 4) {
            const int eo = 32 * (wid - 4);
            o1 = mm<32>(ATT, SS, VT + eo * SS, SS, l32, hi, o1);
#pragma unroll
            for (int r = 0; r < 16; ++r) O[TOK(c, crow(r, hi)) * 512 + h * 128 + eo + l32] = o1[r];
        }
#pragma unroll
        for (int r = 0; r < 16; ++r) S[r] *= eB[d0 + crow(r, hi)];
        S = mm<32>(KeT + d0 * SS, SS, VT + e0 * SS, SS, l32, hi, S);
        __syncthreads();
        WRITE_ST();
        if (c + 1 < nch) *(vf4*)(la + ts * 64 + dc) = pl;
        __syncthreads();
        if (c + 1 < nch) GIMAGES();
        __syncthreads();
    }
#undef GLOAD
#undef WRITE_ST
#undef GIMAGES
#undef TOK
    if (ctx) {
        float* so = p.out + O_SGLA + ((((size_t)b * DEPTH + l) * 2 + dir) * 4 + h) * 64 * 128 + e0 + l32;
#pragma unroll
        for (int r = 0; r < 16; ++r) so[(size_t)(d0 + crow(r, hi)) * 128] = S[r];
    }
}
}
#define LAS __attribute__((address_space(3)))
constexpr int LDS_BYTES = 147456, XBW_OFF = LDS_BYTES - 64;
constexpr int NPH = 1 + DEPTH * 12;
#ifndef DBG_NLAYERS
#define DBG_NLAYERS DEPTH
#endif

#ifndef DUPKIND
#define DUPKIND 0
#endif
__device__ __forceinline__ int opaque_int(int v) { asm volatile("" : "+s"(v)); return v; }
#ifndef MIXMASK
#define MIXMASK 0xFF
#endif
#define FOR_ITEMS(it, n, o, w) for (int bo_ = (o) * (int)gridDim.x / 256, bw_ = ((w) * (int)gridDim.x / 256) > 0 ? ((w) * (int)gridDim.x / 256) : 1, \
                                    it = ((int)blockIdx.x >= bo_ && (int)blockIdx.x < bo_ + bw_) ? (int)blockIdx.x - bo_ : (n); it < (n); it += bw_)

#ifndef SPLITK
#define SPLITK 0
#endif
constexpr int FLAG_WORD0 = 8192;
constexpr int QCTR_WORD0 = 1024;
constexpr int NI_GDNL = LB * 8, NI_GLAL = LB * 8, NI_GDNC = CB * 8, NI_GQAL = LB * 16, NI_NAL = LB * 16, NI_GLAC = CB * 8, NI_NAC = CB * 4, NI_GQAC = CB * 4;
#define KM(k) (1 + ((DUPKIND >> (k)) & 1))
constexpr int Q0 = NI_GDNL * KM(0), Q1 = Q0 + NI_GLAL * KM(1), Q2 = Q1 + NI_GDNC * KM(2), Q3 = Q2 + NI_GQAL * KM(3), Q4 = Q3 + NI_NAL * KM(4), Q5 = Q4 + NI_GLAC * KM(5), Q6 = Q5 + NI_NAC * KM(6), Q7 = Q6 + NI_GQAC * KM(7);
__device__ __forceinline__ void phase_mix(const Params& p, int l, unsigned char* lds, int rep) {
    const int tid = opaque_tid();
    float* smem = (float*)lds;
    const bf16_t* NAQ = WSP(bf16_t, WS_NAQ); const bf16_t* NAK = WSP(bf16_t, WS_NAK); const bf16_t* NAV = WSP(bf16_t, WS_NAV);
    const bf16_t* GQ = WSP(bf16_t, WS_GQ); const bf16_t* GK = WSP(bf16_t, WS_GK); const bf16_t* GV = WSP(bf16_t, WS_GV);
    bf16_t* MRG = WSP(bf16_t, WS_MRG);
    unsigned* qctr = WSP(unsigned, WS_CTL) + QCTR_WORD0 + 64 * l + 16 * rep;
    volatile int* qslot = (volatile int*)(lds + XBW_OFF + 16);
    for (;;) {
        __syncthreads();
        if (tid == 0) *qslot = (int)__hip_atomic_fetch_add(qctr, 1u, __ATOMIC_RELAXED, __HIP_MEMORY_SCOPE_AGENT);
        __syncthreads();
        const int q = __builtin_amdgcn_readfirstlane(*qslot);
        if (q >= Q7) break;
        if (q < Q0) { const int it = q % NI_GDNL; gdn::gdn_chunked(p, l, false, it / 8, (it / 2) % 4, it % 2, lds); }
        else if (q < Q1) { const int it = (q - Q0) % NI_GLAL; gla::gla_chunked(p, l, false, it / 8, (it / 2) % 4, it % 2, lds); }
        else if (q < Q2) { const int it = (q - Q1) % NI_GDNC; gdn::gdn_chunked(p, l, true, it / 8, (it / 2) % 4, it % 2, lds); }
        else if (q < Q3) {
            const int it = (q - Q2) % NI_GQAL, b = it / 16, qh = (it / 4) % 4, qb = it % 4, kvh = qh >> 1;
            const size_t r0 = (size_t)MC + (size_t)b * LT;
            att::SrcTwo src{WSP(bf16_t, WS_CGK) + ((size_t)b * DEPTH + l) * 256 * 256 + kvh * 128, WSP(bf16_t, WS_CGV) + ((size_t)b * DEPTH + l) * 256 * 256 + kvh * 128,
                            GK + r0 * 256 + kvh * 128, GV + r0 * 256 + kvh * 128, 256};
            att::attn_body<2>(GQ + (r0 + qb * 256) * 512 + qh * 128, src, MRG + (r0 + qb * 256) * DM + 1024 + qh * 128, 4 + LT / 64, (char*)lds, att::NoBias{});
        }
        else if (q < Q4) {
            const int it = (q - Q3) % NI_NAL, b = it / 16, h = (it / 4) % 4, qb = it % 4;
            const int kr0 = qb == 0 ? 0 : qb == 1 ? 0 : qb == 2 ? 4 : 8, nrows = (qb == 0 || qb == 3) ? 8 : 12;
            const size_t r0 = (size_t)MC + (size_t)b * LT;
            float* tab = (float*)(lds + att::SHM_ATTN);
            if (tid < 15 * 31) tab[tid] = p.in[I_RPB][((size_t)l * 4 + h) * 15 * 31 + tid] * (1.0f / att::SCALE);
            att::SrcTwo src{WSP(bf16_t, WS_CNAK) + ((size_t)b * DEPTH + l) * 256 * 512 + h * 128, WSP(bf16_t, WS_CNAV) + ((size_t)b * DEPTH + l) * 256 * 512 + h * 128,
                            NAK + (r0 + kr0 * 64) * 512 + h * 128, NAV + (r0 + kr0 * 64) * 512 + h * 128, 512};
            att::attn_body<1>(NAQ + (r0 + qb * 256) * 512 + h * 128, src, MRG + (r0 + qb * 256) * DM + 0 + h * 128, 4 + nrows, (char*)lds, att::NaBias{tab, qb * 256, kr0});
        }
        else if (q < Q5) { const int it = (q - Q4) % NI_GLAC; gla::gla_chunked(p, l, true, it / 8, (it / 2) % 4, it % 2, lds); }
        else if (q < Q6) {
            const int it = (q - Q5) % NI_NAC, b = it / 4, h = it % 4; const size_t r0 = (size_t)b * CT;
            att::SrcOne src{NAK + r0 * 512 + h * 128, NAV + r0 * 512 + h * 128, 512};
            att::attn_body<2>(NAQ + r0 * 512 + h * 128, src, MRG + r0 * DM + 0 + h * 128, CT / 64, (char*)lds, att::NoBias{});
        }
        else {
            const int it = (q - Q6) % NI_GQAC, b = it / 4, qh = it % 4, kvh = qh >> 1; const size_t r0 = (size_t)b * CT;
            att::SrcOne src{GK + r0 * 256 + kvh * 128, GV + r0 * 256 + kvh * 128, 256};
            att::attn_body<2>(GQ + r0 * 512 + qh * 128, src, MRG + r0 * DM + 1024 + qh * 128, CT / 64, (char*)lds, att::NoBias{});
        }
    }
}

static_assert(att::SHM_ATTN + 15 * 31 * 4 + 2048 <= (size_t)XBW_OFF, "LDS map");
static_assert((QCTR_WORD0 + 64 * DEPTH) < 4096, "ctl");
constexpr int BAR_WORD0 = 4096;
static_assert((BAR_WORD0 + XCD_BAR_WORDS) * 4 <= (int)CTL_BYTES, "ctl");

__global__ void __launch_bounds__(512, 2) fwd(Params p) {
    extern __shared__ __attribute__((aligned(16))) unsigned char lds[];
    const int tid = threadIdx.x;
    volatile LAS unsigned* xbw = (volatile LAS unsigned*)((LAS unsigned char*)lds + XBW_OFF);
    if (tid < 4) xbw[tid] = 0u;
    __syncthreads();
    XcdBarrier bar; bar.bar = WSP(unsigned, WS_CTL) + BAR_WORD0; bar.x = 0; bar.st = xbw;
    if (p.ph_hi - p.ph_lo > 1) bar = xcd_barrier_post(WSP(unsigned, WS_CTL) + BAR_WORD0, xbw);
#ifndef PHMASK
#define PHMASK 0x1FFF
#endif
#define IN(k) (p.ph_lo <= (k) && (k) < p.ph_hi)
#define INL(j) (((PHMASK >> ((j) + 1)) & 1) && IN(pb + (j)))
#ifndef DUPMASK
#define DUPMASK 0
#endif
#define DUP(j) ((DUPMASK >> ((j) + 1)) & 1)
#define SEAM(k) do { if (IN(k) && IN((k) + 1)) xcd_barrier(bar); } while (0)
    LAS unsigned char* ldsl = (LAS unsigned char*)lds;
    bf16_t* H = WSP(bf16_t, WS_H); bf16_t* ACT = WSP(bf16_t, WS_ACT); float* X = WSP(float, WS_X); float* Z = WSP(float, WS_Z); bf16_t* MRG = WSP(bf16_t, WS_MRG);

    if ((PHMASK & 1) && IN(0)) { int reps_ = 1 + (DUPMASK & 1); asm volatile("" : "+s"(reps_)); for (int rep_ = 0; rep_ < reps_; ++rep_) { const Params q = opaque_params(p); phase_prologue(q, (float*)lds); __syncthreads(); } }
    SEAM(0);
    for (int l = 0; l < DBG_NLAYERS; ++l) {
        const int pb = 1 + l * 12;
        const float* modl = WSP(float, WS_MODV) + (size_t)l * NCOND * NMOD;
        if (INL(0)) { int reps_ = 1 + DUP(0); asm volatile("" : "+s"(reps_)); for (int rep_ = 0; rep_ < reps_; ++rep_) { const Params q = opaque_params(p); phase_norm(q, l, 0); __syncthreads(); } }
        SEAM(pb + 0);
        if (INL(1)) {
            pg8::Gemm g{H, WSP(bf16_t, WS_WGU) + ((size_t)l * 2 + 0) * NGU * DM, M, NGU, DM}; pg8::StaticOrder S; S.init(M, NGU, DM, (int)gridDim.x, (int)blockIdx.x);
            pg8::EpiSwiGLU E{ACT, FF};
            for (int r_ = 0, n_ = opaque_int(1 + DUP(1)); r_ < n_; ++r_) pg8::gemm_phase<pg8::EpiSwiGLU, pg8::StaticOrder, false>(ldsl, g, S, E, nullptr);
        }
        SEAM(pb + 1);
        if (INL(2)) {
            pg8::Gemm g{ACT, WSP(bf16_t, WS_WDN) + ((size_t)l * 2 + 0) * DM * FF, M, DM, FF}; pg8::StaticOrder S; S.init(M, DM, FF, (int)gridDim.x, (int)blockIdx.x, SPLITK);
            pg8::EpiResid E{X, X, DM, modl + 2 * DM, 0.5f, Z, WSP(unsigned, WS_CTL) + FLAG_WORD0, 8u * (unsigned)(l * 3 + 1)};
            pg8::gemm_phase<pg8::EpiResid, pg8::StaticOrder, false>(ldsl, g, S, E, nullptr);
#if CONV_FILLER
            if (l + 1 < DBG_NLAYERS) {
                const int nw_ = (M / 256) * (DM / 256), G_ = (int)gridDim.x; int f0_ = nw_ - G_; if (f0_ < 0 || f0_ >= G_) f0_ = 0;
                if ((int)blockIdx.x >= f0_) { const Params q = opaque_params(p); conv_layer_tiles(q, l + 1, 0, (NT_L * 2 / 5), (int)blockIdx.x - f0_, G_ - f0_, (float*)lds); }
            }
#endif
            if (opaque_int(DUP(2))) { pg8::EpiResid E2{X, Z, DM, modl + 2 * DM, 0.5f, Z, WSP(unsigned, WS_CTL) + FLAG_WORD0, 0u}; pg8::gemm_phase<pg8::EpiResid, pg8::StaticOrder, false>(ldsl, g, S, E2, nullptr); }
        }
        SEAM(pb + 2);
        if (INL(3)) { int reps_ = 1 + DUP(3); asm volatile("" : "+s"(reps_)); for (int rep_ = 0; rep_ < reps_; ++rep_) { const Params q = opaque_params(p); phase_norm(q, l, 1); __syncthreads(); } }
        SEAM(pb + 3);
        if (INL(4)) {
            pg8::Gemm g{H, WSP(bf16_t, WS_WIN) + (size_t)l * NINP * DM, M, NINP, DM}; pg8::StaticOrder S; S.init(M, NINP, DM, (int)gridDim.x, (int)blockIdx.x);
            pg8::EpiF32 E{Z, NINP, nullptr};
            for (int r_ = 0, n_ = opaque_int(1 + DUP(4)); r_ < n_; ++r_) pg8::gemm_phase<pg8::EpiF32, pg8::StaticOrder, false>(ldsl, g, S, E, nullptr);
        }
        SEAM(pb + 4);
        if (INL(5)) { int reps_ = 1 + DUP(5); asm volatile("" : "+s"(reps_)); for (int rep_ = 0; rep_ < reps_; ++rep_) { const Params q = opaque_params(p); phase_prep(q, l); __syncthreads(); } }
        SEAM(pb + 5);
        if (INL(6)) { int reps_ = 1 + DUP(6); asm volatile("" : "+s"(reps_)); for (int rep_ = 0; rep_ < reps_; ++rep_) { const Params q = opaque_params(p); phase_mix(q, l, lds, rep_); __syncthreads(); } }
        SEAM(pb + 6);
        if (INL(7)) { int reps_ = 1 + DUP(7); asm volatile("" : "+s"(reps_)); for (int rep_ = 0; rep_ < reps_; ++rep_) { const Params q = opaque_params(p); phase_post(q, l); __syncthreads(); } }
        SEAM(pb + 7);
        if (INL(8)) {
            pg8::Gemm g{MRG, WSP(bf16_t, WS_WOUT) + (size_t)l * DM * DM, M, DM, DM}; pg8::StaticOrder S; S.init(M, DM, DM, (int)gridDim.x, (int)blockIdx.x, SPLITK);
            pg8::EpiResid E{X, X, DM, modl + 5 * DM, 1.0f, Z, WSP(unsigned, WS_CTL) + FLAG_WORD0, 8u * (unsigned)(l * 3 + 2)};
            pg8::gemm_phase<pg8::EpiResid, pg8::StaticOrder, false>(ldsl, g, S, E, nullptr);
#if CONV_FILLER
            if (l + 1 < DBG_NLAYERS) {
                const int nw_ = (M / 256) * (DM / 256), G_ = (int)gridDim.x; int f0_ = nw_ - G_; if (f0_ < 0 || f0_ >= G_) f0_ = 0;
                if ((int)blockIdx.x >= f0_) { const Params q = opaque_params(p); conv_layer_tiles(q, l + 1, (NT_L * 2 / 5), (NT_L * 3 / 5), (int)blockIdx.x - f0_, G_ - f0_, (float*)lds); }
            }
#endif
            if (opaque_int(DUP(8))) { pg8::EpiResid E2{X, Z, DM, modl + 5 * DM, 1.0f, Z, WSP(unsigned, WS_CTL) + FLAG_WORD0, 0u}; pg8::gemm_phase<pg8::EpiResid, pg8::StaticOrder, false>(ldsl, g, S, E2, nullptr); }
        }
        SEAM(pb + 8);
        if (INL(9)) { int reps_ = 1 + DUP(9); asm volatile("" : "+s"(reps_)); for (int rep_ = 0; rep_ < reps_; ++rep_) { const Params q = opaque_params(p); phase_norm(q, l, 2); __syncthreads(); } }
        SEAM(pb + 9);
        if (INL(10)) {
            pg8::Gemm g{H, WSP(bf16_t, WS_WGU) + ((size_t)l * 2 + 1) * NGU * DM, M, NGU, DM}; pg8::StaticOrder S; S.init(M, NGU, DM, (int)gridDim.x, (int)blockIdx.x);
            pg8::EpiSwiGLU E{ACT, FF};
            pg8::gemm_phase<pg8::EpiSwiGLU, pg8::StaticOrder, false>(ldsl, g, S, E, nullptr);
        }
        SEAM(pb + 10);
        if (INL(11)) {
            pg8::Gemm g{ACT, WSP(bf16_t, WS_WDN) + ((size_t)l * 2 + 1) * DM * FF, M, DM, FF}; pg8::StaticOrder S; S.init(M, DM, FF, (int)gridDim.x, (int)blockIdx.x, SPLITK);
            pg8::EpiResid E{X, (l == DEPTH - 1) ? p.out : X, DM, modl + 8 * DM, 0.5f, Z, WSP(unsigned, WS_CTL) + FLAG_WORD0, 8u * (unsigned)(l * 3 + 3)};
            pg8::gemm_phase<pg8::EpiResid, pg8::StaticOrder, false>(ldsl, g, S, E, nullptr);
#if CONV_FILLER
            if (l + 1 < DBG_NLAYERS) {
                const int nw_ = (M / 256) * (DM / 256), G_ = (int)gridDim.x; int f0_ = nw_ - G_; if (f0_ < 0 || f0_ >= G_) f0_ = 0;
                if ((int)blockIdx.x >= f0_) { const Params q = opaque_params(p); conv_layer_tiles(q, l + 1, (NT_L * 3 / 5), NT_L, (int)blockIdx.x - f0_, G_ - f0_, (float*)lds); }
            }
#endif
        }
        SEAM(pb + 11);
    }
#undef IN
#undef SEAM
}

#ifndef MULTI_LAUNCH
#define MULTI_LAUNCH 0
#endif
extern "C" void kernel_launch(void* const* d_in, const int* in_sizes, int n_in, void* d_out, int out_size, void* d_ws, size_t ws_size, hipStream_t stream) {
    static int grid = 0;
    if (grid == 0) {
        if (n_in != N_IN || (size_t)out_size != O_END || ws_size < WS_END) { fprintf(stderr, "kernel_launch: shape mismatch n_in %d out %d ws %zu (need %zu)\n", n_in, out_size, ws_size, (size_t)WS_END); grid = -1; return; }
        int dev = 0, cus = 0, per_cu = 0;
        if (hipGetDevice(&dev) != hipSuccess || hipDeviceGetAttribute(&cus, hipDeviceAttributeMultiprocessorCount, dev) != hipSuccess) { grid = -1; return; }
        if (hipFuncSetAttribute((const void*)fwd, hipFuncAttributeMaxDynamicSharedMemorySize, LDS_BYTES) != hipSuccess) { fprintf(stderr, "kernel_launch: hipFuncSetAttribute failed\n"); grid = -1; return; }
        if (hipOccupancyMaxActiveBlocksPerMultiprocessor(&per_cu, (const void*)fwd, 512, LDS_BYTES) != hipSuccess || per_cu < 1) { fprintf(stderr, "kernel_launch: occupancy query says %d\n", per_cu); (void)hipGetLastError(); }
        grid = cus;
    }
    if (grid < 0) return;
    (void)hipMemsetAsync((char*)d_ws + WS_CTL, 0, CTL_BYTES, stream);
    Params p{};
    for (int i = 0; i < N_IN; ++i) p.in[i] = (const float*)d_in[i];
    p.out = (float*)d_out; p.ws = (unsigned char*)d_ws;
#if MULTI_LAUNCH
    for (int ph = 0; ph < 1 + DBG_NLAYERS * 12; ++ph) { p.ph_lo = ph; p.ph_hi = ph + 1; hipLaunchKernelGGL(fwd, dim3(grid), dim3(512), LDS_BYTES, stream, p); }
#else
    p.ph_lo = 0; p.ph_hi = NPH; hipLaunchKernelGGL(fwd, dim3(grid), dim3(512), LDS_BYTES, stream, p);
#endif
    const hipError_t le = hipPeekAtLastError();
    if (le != hipSuccess) fprintf(stderr, "kernel_launch: launch failed: %s\n", hipGetErrorName(le));
}
```

```cpp
#include <hip/hip_runtime.h>
#include <cstdio>
#include <cstdint>

#ifndef CB_
#define CB_ 16
#endif
#ifndef LB_
#define LB_ 8
#endif
#ifndef DEPTH_
#define DEPTH_ 4
#endif
constexpr int DM = 2048, DEPTH = DEPTH_, CB = CB_, CT = 256, LB = LB_, LT = 1024;
constexpr int MC = CB * CT, ML = LB * LT, M = MC + ML;
constexpr int FF = 5504, NGU = 2 * FF, NIN = 6192, NINP = 6400, NMOD = 9 * DM, NCOND = 1 + LB;
constexpr float EPS = 1e-6f;
constexpr int Z_NAQ = 0, Z_NAK = 512, Z_NAV = 1024, Z_GLQ = 1536, Z_GLK = 1792, Z_GLV = 2048, Z_GLR = 2560, Z_GF = 3072, Z_GB = 3088,
              Z_GQQ = 3104, Z_GQK = 3616, Z_GQV = 3872, Z_DQKV = 4128, Z_DZ = 5664, Z_DB = 6176, Z_DA = 6184;
static_assert(Z_DA + 8 == NIN, "split");
enum { I_XP = 0, I_XS, I_CNAK, I_CNAV, I_CGK, I_CGV, I_SGLA, I_SGDN, I_C, I_CCTX, I_NORMG, I_WMOD, I_BMOD, I_GU, I_DOWN, I_WIN, I_WOUT, I_NAQKN, I_RPB,
       I_GUP, I_GBIAS, I_GLAON, I_GQAQKN, I_CONV, I_ALOG, I_DTB, I_GDNON, N_IN };
constexpr size_t O_YP = 0, O_YS = O_YP + (size_t)MC * DM, O_NAK = O_YS + (size_t)ML * DM, O_NAV = O_NAK + (size_t)CB * DEPTH * 4 * CT * 128,
                 O_GK = O_NAV + (size_t)CB * DEPTH * 4 * CT * 128, O_GV = O_GK + (size_t)CB * DEPTH * 2 * CT * 128,
                 O_SGLA = O_GV + (size_t)CB * DEPTH * 2 * CT * 128, O_SGDN = O_SGLA + (size_t)CB * DEPTH * 2 * 4 * 64 * 128,
                 O_END = O_SGDN + (size_t)CB * DEPTH * 2 * 4 * 128 * 128;
constexpr size_t al256(size_t x) { return (x + 255) & ~(size_t)255; }
constexpr size_t WS_CTL = 0, CTL_BYTES = 1u << 20;
constexpr size_t WS_WGU = CTL_BYTES;
constexpr size_t WS_WDN = WS_WGU + (size_t)DEPTH * 2 * NGU * DM * 2;
constexpr size_t WS_WIN = WS_WDN + (size_t)DEPTH * 2 * DM * FF * 2;
constexpr size_t WS_WOUT = WS_WIN + (size_t)DEPTH * NINP * DM * 2;
constexpr size_t WS_MODV = WS_WOUT + (size_t)DEPTH * DM * DM * 2;
constexpr size_t WS_ROPE = al256(WS_MODV + (size_t)DEPTH * NCOND * NMOD * 4);
constexpr size_t WS_X = al256(WS_ROPE + 2 * 64 * 32 * 4);
constexpr size_t WS_H = WS_X + (size_t)M * DM * 4;
constexpr size_t WS_ACT = WS_H + (size_t)M * DM * 2;
constexpr size_t WS_Z = WS_ACT + (size_t)M * FF * 2;
constexpr size_t WS_MRG = WS_Z + (size_t)M * NINP * 4;
constexpr size_t WS_NAQ = WS_MRG + (size_t)M * DM * 2;
constexpr size_t WS_NAK = WS_NAQ + (size_t)M * 512 * 2;
constexpr size_t WS_NAV = WS_NAK + (size_t)M * 512 * 2;
constexpr size_t WS_GQ = WS_NAV + (size_t)M * 512 * 2;
constexpr size_t WS_GK = WS_GQ + (size_t)M * 512 * 2;
constexpr size_t WS_GV = WS_GK + (size_t)M * 256 * 2;
constexpr size_t WS_CNAK = WS_GV + (size_t)M * 256 * 2;
constexpr size_t WS_CNAV = WS_CNAK + (size_t)LB * DEPTH * 256 * 512 * 2;
constexpr size_t WS_CGK = WS_CNAV + (size_t)LB * DEPTH * 256 * 512 * 2;
constexpr size_t WS_CGV = WS_CGK + (size_t)LB * DEPTH * 256 * 256 * 2;
constexpr size_t WS_AF = WS_CGV + (size_t)LB * DEPTH * 256 * 256 * 2;
constexpr size_t WS_AB = WS_AF + (size_t)M * 256 * 4;
constexpr size_t WS_DQ = WS_AB + (size_t)M * 256 * 4;
constexpr size_t WS_DK = WS_DQ + (size_t)M * 512 * 4;
constexpr size_t WS_DV = WS_DK + (size_t)M * 512 * 4;
constexpr size_t WS_DBA = WS_DV + (size_t)M * 512 * 4;
constexpr size_t WS_GOF = WS_DBA + (size_t)M * 16 * 4;
constexpr size_t WS_GOB = WS_GOF + (size_t)M * 512 * 4;
constexpr size_t WS_DOF = WS_GOB + (size_t)M * 512 * 4;
constexpr size_t WS_DOB = WS_DOF + (size_t)M * 512 * 4;
constexpr size_t WS_END = WS_DOB + (size_t)M * 512 * 4;

typedef unsigned short bf16_t;
struct Params { const float* in[N_IN]; float* out; unsigned char* ws; int ph_lo, ph_hi; };
static_assert(sizeof(Params) == N_IN * 8 + 8 + 8 + 8, "no padding");

#define WSP(T, off) ((T*)(p.ws + (off)))
__device__ __forceinline__ int opaque_tid() { int t = (int)threadIdx.x; asm volatile("" : "+v"(t)); return t; }
__device__ __forceinline__ Params opaque_params(const Params& p) { Params q = p; unsigned long long w = (unsigned long long)q.ws; asm volatile("" : "+s"(w)); q.ws = (unsigned char*)w; return q; }

typedef float vf4 __attribute__((ext_vector_type(4)));
__device__ __forceinline__ float bf2f(unsigned short v) { return __uint_as_float((unsigned)v << 16); }
__device__ __forceinline__ vf4 ld4bf(const unsigned short* p) { const uint2 w = *(const uint2*)p; vf4 r; r.x = __uint_as_float(w.x << 16); r.y = __uint_as_float(w.x & 0xFFFF0000u); r.z = __uint_as_float(w.y << 16); r.w = __uint_as_float(w.y & 0xFFFF0000u); return r; }
__device__ __forceinline__ void ld8bf(const unsigned short* p, vf4& a, vf4& b) { const uint4 w = *(const uint4*)p;
    a.x = __uint_as_float(w.x << 16); a.y = __uint_as_float(w.x & 0xFFFF0000u); a.z = __uint_as_float(w.y << 16); a.w = __uint_as_float(w.y & 0xFFFF0000u);
    b.x = __uint_as_float(w.z << 16); b.y = __uint_as_float(w.z & 0xFFFF0000u); b.z = __uint_as_float(w.w << 16); b.w = __uint_as_float(w.w & 0xFFFF0000u); }
__device__ __forceinline__ float wave_sum(float v) {
#pragma unroll
    for (int o = 32; o >= 1; o >>= 1) v += __shfl_xor(v, o);
    return v;
}
__device__ __forceinline__ bf16_t f2bf(float f) { unsigned u = __float_as_uint(f); u += 0x7FFFu + ((u >> 16) & 1u); return (bf16_t)(u >> 16); }
__device__ __forceinline__ unsigned pack2(float a, float b) { return (unsigned)f2bf(a) | ((unsigned)f2bf(b) << 16); }
__device__ __forceinline__ float silu_f(float x) { return x / (1.f + expf(-x)); }
__device__ __forceinline__ float softplus_f(float x) { return fmaxf(x, 0.f) + log1pf(expf(-fabsf(x))); }
__device__ __forceinline__ float logsigmoid_f(float x) { return fminf(x, 0.f) - log1pf(expf(-fabsf(x))); }
__device__ __forceinline__ int cond_of_row(int m) { return m < MC ? 0 : 1 + (m - MC) / LT; }
#ifndef CONV_FILLER
#define CONV_FILLER 1
#endif
__device__ __forceinline__ void conv_tile(const float* __restrict__ src, int ld_src, int ncols_src, int k0, int c0, bf16_t* __restrict__ dst, int ld_dst, int n0, float* tile) {
    const int tid = opaque_tid();
    {
        const int r = tid >> 3, c = (tid & 7) * 8;
        float4 a = make_float4(0.f, 0.f, 0.f, 0.f), b = a;
        if (c0 + c + 8 <= ncols_src) {
            const float* s = src + (size_t)(k0 + r) * ld_src + c0 + c;
            a = *(const float4*)s; b = *(const float4*)(s + 4);
        }
        float* t = tile + r * 65 + c;
        t[0] = a.x; t[1] = a.y; t[2] = a.z; t[3] = a.w; t[4] = b.x; t[5] = b.y; t[6] = b.z; t[7] = b.w;
    }
    __syncthreads();
    {
        const int n = tid >> 3, ks = (tid & 7) * 8;
        const float* t = tile + ks * 65 + n;
        uint4 w;
        w.x = pack2(t[0 * 65], t[1 * 65]); w.y = pack2(t[2 * 65], t[3 * 65]); w.z = pack2(t[4 * 65], t[5 * 65]); w.w = pack2(t[6 * 65], t[7 * 65]);
        *(uint4*)(dst + (size_t)(n0 + n) * ld_dst + k0 + ks) = w;
    }
    __syncthreads();
}

constexpr int MOD_ITEMS = DEPTH * (NMOD / 128);
constexpr int TGU_KT = DM / 64, TGU_NT = NGU / 64, TDN_KT = FF / 64, TDN_NT = DM / 64, TIN_KT = DM / 64, TIN_NT = NINP / 64, TOUT_KT = DM / 64, TOUT_NT = DM / 64;
constexpr int TL_GU = 2 * TGU_KT * TGU_NT, TL_DN = 2 * TDN_KT * TDN_NT, TL_IN = TIN_KT * TIN_NT, TL_OUT = TOUT_KT * TOUT_NT, NT_L = TL_GU + TL_DN + TL_IN + TL_OUT;
__device__ __forceinline__ void conv_layer_tiles(const Params& p, int l, int t_begin, int t_end, int first, int stride, float* s_tile) {
    for (int it = t_begin + first; it < t_end; it += stride) {
        if (it < TL_GU) {
            const int mat = l * 2 + it / (TGU_KT * TGU_NT), r = it % (TGU_KT * TGU_NT), kt = r / TGU_NT, nt = r % TGU_NT;
            const int n0 = nt * 64, t256 = n0 / 256, c = n0 % 256;
            const int c0 = c < 128 ? 128 * t256 + c : FF + 128 * t256 + (c - 128);
            conv_tile(p.in[I_GU] + (size_t)mat * DM * NGU, NGU, NGU, kt * 64, c0, WSP(bf16_t, WS_WGU) + (size_t)mat * NGU * DM, DM, n0, s_tile);
        } else if (it < TL_GU + TL_DN) {
            const int i2 = it - TL_GU, mat = l * 2 + i2 / (TDN_KT * TDN_NT), r = i2 % (TDN_KT * TDN_NT), kt = r / TDN_NT, nt = r % TDN_NT;
            conv_tile(p.in[I_DOWN] + (size_t)mat * FF * DM, DM, DM, kt * 64, nt * 64, WSP(bf16_t, WS_WDN) + (size_t)mat * DM * FF, FF, nt * 64, s_tile);
        } else if (it < TL_GU + TL_DN + TL_IN) {
            const int i2 = it - TL_GU - TL_DN, kt = i2 / TIN_NT, nt = i2 % TIN_NT;
            conv_tile(p.in[I_WIN] + (size_t)l * DM * NIN, NIN, NIN, kt * 64, nt * 64, WSP(bf16_t, WS_WIN) + (size_t)l * NINP * DM, DM, nt * 64, s_tile);
        } else {
            const int i2 = it - TL_GU - TL_DN - TL_IN, kt = i2 / TOUT_NT, nt = i2 % TOUT_NT;
            conv_tile(p.in[I_WOUT] + (size_t)l * DM * DM, DM, DM, kt * 64, nt * 64, WSP(bf16_t, WS_WOUT) + (size_t)l * DM * DM, DM, nt * 64, s_tile);
        }
    }
}

__device__ __forceinline__ void phase_prologue(const Params& p, float* smem) {
    const int tid = opaque_tid(), nb = gridDim.x, bid = blockIdx.x;
    float* s_cond = smem;
    float* s_red = s_cond + NCOND * DM;
    float* s_tile = s_red + 3 * 128 * NCOND;
    for (int i = tid; i < NCOND * DM; i += 512) { const int ci = i / DM, k = i % DM; const float v = ci == 0 ? p.in[I_CCTX][k] : p.in[I_C][(size_t)(ci - 1) * DM + k]; s_cond[i] = silu_f(v); }
    __syncthreads();
    float* modv = WSP(float, WS_MODV);
    for (int it = bid; it < MOD_ITEMS; it += nb) {
        const int l = it / (NMOD / 128), jt = it % (NMOD / 128);
        const int cl = tid & 127, kq = tid >> 7, col = jt * 128 + cl;
        const float* w = p.in[I_WMOD] + (size_t)l * DM * NMOD + col;
        float acc[NCOND];
#pragma unroll
        for (int ci = 0; ci < NCOND; ++ci) acc[ci] = 0.f;
        for (int k = kq * 512; k < kq * 512 + 512; k += 8) {
            float wv[8];
#pragma unroll
            for (int j = 0; j < 8; ++j) wv[j] = w[(size_t)(k + j) * NMOD];
#pragma unroll
            for (int ci = 0; ci < NCOND; ++ci) {
                const float4 s0 = *(const float4*)&s_cond[ci * DM + k], s1 = *(const float4*)&s_cond[ci * DM + k + 4];
                acc[ci] += s0.x * wv[0] + s0.y * wv[1] + s0.z * wv[2] + s0.w * wv[3] + s1.x * wv[4] + s1.y * wv[5] + s1.z * wv[6] + s1.w * wv[7];
            }
        }
        if (kq > 0) {
#pragma unroll
            for (int ci = 0; ci < NCOND; ++ci) s_red[((kq - 1) * 128 + cl) * NCOND + ci] = acc[ci];
        }
        __syncthreads();
        if (kq == 0) {
            const float bm = p.in[I_BMOD][(size_t)l * NMOD + col];
#pragma unroll
            for (int ci = 0; ci < NCOND; ++ci)
                modv[((size_t)l * NCOND + ci) * NMOD + col] = acc[ci] + s_red[(0 * 128 + cl) * NCOND + ci] + s_red[(1 * 128 + cl) * NCOND + ci] + s_red[(2 * 128 + cl) * NCOND + ci] + bm;
        }
        __syncthreads();
    }
    conv_layer_tiles(p, 0, 0, NT_L, bid, nb, s_tile);
#if !CONV_FILLER
    for (int l2 = 1; l2 < DEPTH; ++l2) conv_layer_tiles(p, l2, 0, NT_L, bid, nb, s_tile);
#endif
    const size_t gtid = (size_t)bid * 512 + tid, gstride = (size_t)nb * 512;
    {
        float4* X = WSP(float4, WS_X);
        const float4* xp = (const float4*)p.in[I_XP]; const float4* xs = (const float4*)p.in[I_XS];
        const size_t nc = (size_t)MC * DM / 4, n = (size_t)M * DM / 4;
        for (size_t i = gtid; i < n; i += gstride) X[i] = i < nc ? xp[i] : xs[i - nc];
    }
    {
        const size_t n_na = (size_t)LB * DEPTH * 256 * 512 / 8;
        for (size_t i = gtid; i < 2 * n_na; i += gstride) {
            const bool isv = i >= n_na; const size_t j = isv ? i - n_na : i;
            const int d8 = (int)(j % 16), h = (int)((j / 16) % 4), t = (int)((j / 64) % 256); const size_t bl = j / (64 * 256);
            const float* s = p.in[isv ? I_CNAV : I_CNAK] + ((bl * 4 + h) * 256 + t) * 128 + d8 * 8;
            const float4 a = *(const float4*)s, b = *(const float4*)(s + 4);
            uint4 w; w.x = pack2(a.x, a.y); w.y = pack2(a.z, a.w); w.z = pack2(b.x, b.y); w.w = pack2(b.z, b.w);
            *(uint4*)(WSP(bf16_t, isv ? WS_CNAV : WS_CNAK) + (bl * 256 + t) * 512 + h * 128 + d8 * 8) = w;
        }
        const size_t n_g = (size_t)LB * DEPTH * 256 * 256 / 8;
        for (size_t i = gtid; i < 2 * n_g; i += gstride) {
            const bool isv = i >= n_g; const size_t j = isv ? i - n_g : i;
            const int d8 = (int)(j % 16), h = (int)((j / 16) % 2), t = (int)((j / 32) % 256); const size_t bl = j / (32 * 256);
            const float* s = p.in[isv ? I_CGV : I_CGK] + ((bl * 2 + h) * 256 + t) * 128 + d8 * 8;
            const float4 a = *(const float4*)s, b = *(const float4*)(s + 4);
            uint4 w; w.x = pack2(a.x, a.y); w.y = pack2(a.z, a.w); w.z = pack2(b.x, b.y); w.w = pack2(b.z, b.w);
            *(uint4*)(WSP(bf16_t, isv ? WS_CGV : WS_CGK) + (bl * 256 + t) * 256 + h * 128 + d8 * 8) = w;
        }
    }
    for (size_t i = gtid; i < 64 * 32; i += gstride) {
        const int pos = (int)(i / 32), k = (int)(i % 32);
        const float inv = powf(10000.0f, -(float)(2 * k) / 64.0f);
        const float ang = (float)pos * inv;
        WSP(float, WS_ROPE)[i] = cosf(ang); WSP(float, WS_ROPE)[64 * 32 + i] = sinf(ang);
    }
}

__device__ __forceinline__ void phase_norm(const Params& p, int l, int which  ) {
    const int tid = opaque_tid(), lane = tid & 63, wv = tid >> 6;
    const float* X = WSP(float, WS_X); bf16_t* H = WSP(bf16_t, WS_H);
    const float* g = p.in[I_NORMG] + ((size_t)l * 3 + which) * DM;
    for (int m = blockIdx.x * 8 + wv; m < M; m += gridDim.x * 8) {
        const int ci = cond_of_row(m);
        const float* mv = WSP(float, WS_MODV) + ((size_t)l * NCOND + ci) * NMOD + (size_t)which * 3 * DM;
        const float* x = X + (size_t)m * DM;
        vf4 v[8]; float ss = 0.f;
#pragma unroll
        for (int i = 0; i < 8; ++i) { v[i] = *(const vf4*)(x + (i * 64 + lane) * 4); ss += v[i].x * v[i].x + v[i].y * v[i].y + v[i].z * v[i].z + v[i].w * v[i].w; }
        ss = wave_sum(ss);
        const float r = 1.0f / sqrtf(ss * (1.0f / DM) + EPS);
#pragma unroll
        for (int i = 0; i < 8; ++i) {
            const int c = (i * 64 + lane) * 4;
            const float4 gg = *(const float4*)(g + c), sh = *(const float4*)(mv + c), sc = *(const float4*)(mv + DM + c);
            const float o0 = v[i].x * r * gg.x * (1.f + sc.x) + sh.x, o1 = v[i].y * r * gg.y * (1.f + sc.y) + sh.y;
            const float o2 = v[i].z * r * gg.z * (1.f + sc.z) + sh.z, o3 = v[i].w * r * gg.w * (1.f + sc.w) + sh.w;
            uint2 w; w.x = pack2(o0, o1); w.y = pack2(o2, o3);
            *(uint2*)(H + (size_t)m * DM + c) = w;
        }
    }
}

__device__ __forceinline__ float red16(float v);
__device__ __forceinline__ float ssq8(vf4 a, vf4 b) { const vf4 s = a * a + b * b; return (s.x + s.y) + (s.z + s.w); }
__device__ __forceinline__ uint4 pack8(vf4 a, vf4 b) { uint4 w; w.x = pack2(a.x, a.y); w.y = pack2(a.z, a.w); w.z = pack2(b.x, b.y); w.w = pack2(b.z, b.w); return w; }
__device__ __forceinline__ void phase_prep(const Params& p, int l) {
    const int tid = opaque_tid(), lane = tid & 63, wv = tid >> 6, rg = lane >> 4, sub = lane & 15, c8 = sub * 8;
    const bf16_t* Z = WSP(bf16_t, WS_Z);
    const float* ropec = WSP(float, WS_ROPE); const float* ropes = ropec + 64 * 32;
    const float* wnq = p.in[I_NAQKN] + ((size_t)l * 2 + 0) * 128 + c8; const float* wnk = wnq + 128;
    const float* wgq = p.in[I_GQAQKN] + ((size_t)l * 2 + 0) * 128 + c8; const float* wgk = wgq + 128;
    const float* cw = p.in[I_CONV] + (size_t)l * 5 * 1536 + rg * 128 + c8;
    for (int m = blockIdx.x * 8 + wv; m < M; m += gridDim.x * 8) {
        const bf16_t* z = Z + (size_t)m * NINP;
        const bool ctx = m < MC;
        const int b = ctx ? m / CT : (m - MC) / LT, t = ctx ? m % CT : (m - MC) % LT, T = ctx ? CT : LT;
        {
            const int ho = rg * 128 + c8;
            const bf16_t* zkv = z + (rg < 2 ? Z_GQK + rg * 128 : Z_GQV + (rg - 2) * 128) + c8;
            vf4 q0, q1, k0, k1, v0, v1, g0, g1, x0, x1;
            ld8bf(z + Z_NAQ + ho, q0, q1); ld8bf(z + Z_NAK + ho, k0, k1); ld8bf(z + Z_NAV + ho, v0, v1); ld8bf(z + Z_GQQ + ho, g0, g1); ld8bf(zkv, x0, x1);
            float r = 1.0f / sqrtf(red16(ssq8(q0, q1)) * (1.0f / 128) + EPS);
            q0 = q0 * r * *(const vf4*)wnq; q1 = q1 * r * *(const vf4*)(wnq + 4);
            *(uint4*)(WSP(bf16_t, WS_NAQ) + (size_t)m * 512 + ho) = pack8(q0, q1);
            r = 1.0f / sqrtf(red16(ssq8(k0, k1)) * (1.0f / 128) + EPS);
            k0 = k0 * r * *(const vf4*)wnk; k1 = k1 * r * *(const vf4*)(wnk + 4);
            *(uint4*)(WSP(bf16_t, WS_NAK) + (size_t)m * 512 + ho) = pack8(k0, k1);
            *(uint4*)(WSP(bf16_t, WS_NAV) + (size_t)m * 512 + ho) = pack8(v0, v1);
            if (ctx) {
                const size_t o = ((((size_t)b * DEPTH + l) * 4 + rg) * CT + t) * 128 + c8;
                *(vf4*)(p.out + O_NAK + o) = k0; *(vf4*)(p.out + O_NAK + o + 4) = k1; *(vf4*)(p.out + O_NAV + o) = v0; *(vf4*)(p.out + O_NAV + o + 4) = v1;
            }
            r = 1.0f / sqrtf(red16(ssq8(g0, g1)) * (1.0f / 128) + EPS);
            g0 = g0 * r * *(const vf4*)wgq; g1 = g1 * r * *(const vf4*)(wgq + 4);
            const float rk = 1.0f / sqrtf(red16(ssq8(x0, x1)) * (1.0f / 128) + EPS);
            if (rg < 2) { x0 = x0 * rk * *(const vf4*)wgk; x1 = x1 * rk * *(const vf4*)(wgk + 4); }
            if (!ctx) {
                const int pos = sub < 8 ? (t >> 6) : (t & 63), ai = pos * 32 + (c8 & 31);
                const vf4 c0 = *(const vf4*)(ropec + ai), c1 = *(const vf4*)(ropec + ai + 4), s0 = *(const vf4*)(ropes + ai), s1 = *(const vf4*)(ropes + ai + 4);
                const bool hi = (sub & 4) != 0;
                vf4 pg0, pg1, px0, px1;
#pragma unroll
                for (int j = 0; j < 4; ++j) { pg0[j] = __shfl_xor(g0[j], 4); pg1[j] = __shfl_xor(g1[j], 4); px0[j] = __shfl_xor(x0[j], 4); px1[j] = __shfl_xor(x1[j], 4); }
                g0 = hi ? pg0 * s0 + g0 * c0 : g0 * c0 - pg0 * s0; g1 = hi ? pg1 * s1 + g1 * c1 : g1 * c1 - pg1 * s1;
                if (rg < 2) { x0 = hi ? px0 * s0 + x0 * c0 : x0 * c0 - px0 * s0; x1 = hi ? px1 * s1 + x1 * c1 : x1 * c1 - px1 * s1; }
            }
            *(uint4*)(WSP(bf16_t, WS_GQ) + (size_t)m * 512 + ho) = pack8(g0, g1);
            *(uint4*)(WSP(bf16_t, rg < 2 ? WS_GK : WS_GV) + (size_t)m * 256 + (rg & 1) * 128 + c8) = pack8(x0, x1);
            if (ctx) {
                const size_t o = ((((size_t)b * DEPTH + l) * 2 + (rg & 1)) * CT + t) * 128 + c8;
                float* dst = p.out + (rg < 2 ? O_GK : O_GV) + o;
                *(vf4*)dst = x0; *(vf4*)(dst + 4) = x1;
            }
        }
        {
#pragma unroll
            for (int dir = 0; dir < 2; ++dir) {
                const float* up = p.in[I_GUP] + ((size_t)l * 2 + dir) * 16 * 256 + 4 * lane;
                vf4 acc = *(const vf4*)(p.in[I_GBIAS] + ((size_t)l * 2 + dir) * 256 + 4 * lane);
                const bf16_t* gz = z + (dir ? Z_GB : Z_GF);
#pragma unroll
                for (int r4 = 0; r4 < 4; ++r4) {
                    const vf4 gv = ld4bf(gz + 4 * r4);
                    acc += gv.x * *(const vf4*)(up + (4 * r4 + 0) * 256) + gv.y * *(const vf4*)(up + (4 * r4 + 1) * 256) + gv.z * *(const vf4*)(up + (4 * r4 + 2) * 256) + gv.w * *(const vf4*)(up + (4 * r4 + 3) * 256);
                }
                vf4 o;
#pragma unroll
                for (int j = 0; j < 4; ++j) o[j] = logsigmoid_f(acc[j]) * (1.0f / 16.0f);
                *(vf4*)(WSP(float, dir ? WS_AB : WS_AF) + (size_t)m * 256 + 4 * lane) = o;
            }
        }
        {
#pragma unroll
            for (int part = 0; part < 3; ++part) {
                vf4 a0 = (vf4){0.f, 0.f, 0.f, 0.f}, a1 = a0;
#pragma unroll
                for (int j = 0; j < 5; ++j) {
                    const int tt = t + j - 2;
                    if (tt >= 0 && tt < T) {
                        const bf16_t* zz = Z + (size_t)(m + j - 2) * NINP + Z_DQKV + part * 512 + rg * 128 + c8;
                        const float* cj = cw + j * 1536 + part * 512;
                        vf4 z0, z1; ld8bf(zz, z0, z1);
                        a0 += *(const vf4*)cj * z0; a1 += *(const vf4*)(cj + 4) * z1;
                    }
                }
#pragma unroll
                for (int j = 0; j < 4; ++j) { a0[j] = silu_f(a0[j]); a1[j] = silu_f(a1[j]); }
                if (part < 2) { const float r = 1.0f / sqrtf(red16(ssq8(a0, a1)) + EPS) * (part == 0 ? 0.08838834764831845f : 1.0f); a0 *= r; a1 *= r; }
                *(uint4*)(WSP(bf16_t, part == 0 ? WS_DQ : part == 1 ? WS_DK : WS_DV) + (size_t)m * 512 + rg * 128 + c8) = pack8(a0, a1);
            }
            if (lane < 8) {
                const float beta = 1.0f / (1.0f + expf(-bf2f(z[Z_DB + lane])));
                const float g = -expf(p.in[I_ALOG][(size_t)l * 8 + lane]) * softplus_f(bf2f(z[Z_DA + lane]) + p.in[I_DTB][(size_t)l * 8 + lane]);
                float* ba = WSP(float, WS_DBA) + (size_t)m * 16;
                ba[lane] = beta; ba[8 + lane] = g;
            }
        }
    }
}

typedef float vf2 __attribute__((ext_vector_type(2)));
__device__ __forceinline__ float dpp_f(float v, const int ctrl) { return v; }
#define DPPF(v, ctrl) __int_as_float(__builtin_amdgcn_mov_dpp(__float_as_int(v), (ctrl), 0xF, 0xF, true))
__device__ __forceinline__ float red8(float v) { v += DPPF(v, 0xB1); v += DPPF(v, 0x4E); v += DPPF(v, 0x141); return v; }
__device__ __forceinline__ float red16(float v) { v = red8(v); v += DPPF(v, 0x140); return v; }

__device__ __forceinline__ void phase_post(const Params& p, int l) {
    const int tid = opaque_tid(), lane = tid & 63, wv = tid >> 6, rg = lane >> 4, c8 = (lane & 15) * 8;
    const bf16_t* Z = WSP(bf16_t, WS_Z); bf16_t* MRG = WSP(bf16_t, WS_MRG);
    const float* wg = p.in[I_GLAON] + (size_t)l * 128 + c8; const float* wd = p.in[I_GDNON] + (size_t)l * 128 + c8;
    for (int m = blockIdx.x * 8 + wv; m < M; m += gridDim.x * 8) {
        const bf16_t* z = Z + (size_t)m * NINP;
        const int ho = rg * 128 + c8;
#pragma unroll
        for (int g = 0; g < 2; ++g) {
            const float* of = WSP(float, g ? WS_DOF : WS_GOF) + (size_t)m * 512 + ho; const float* ob = WSP(float, g ? WS_DOB : WS_GOB) + (size_t)m * 512 + ho;
            const float* w = g ? wd : wg; const bf16_t* zg = z + (g ? Z_DZ : Z_GLR) + ho;
            vf4 a0 = *(const vf4*)of + *(const vf4*)ob, a1 = *(const vf4*)(of + 4) + *(const vf4*)(ob + 4);
            vf4 g0, g1; ld8bf(zg, g0, g1);
            const float r = 1.0f / sqrtf(red16(ssq8(a0, a1)) * (1.0f / 128) + EPS);
            a0 = a0 * r * *(const vf4*)w; a1 = a1 * r * *(const vf4*)(w + 4);
#pragma unroll
            for (int j = 0; j < 4; ++j) { a0[j] *= silu_f(g0[j]); a1[j] *= silu_f(g1[j]); }
            *(uint4*)(MRG + (size_t)m * DM + (g ? 1536 : 512) + ho) = pack8(a0, a1);
        }
    }
}
#define XB_TMO      128
#define XB_XCNT(j)  (256  + 64 * (j))
#define XB_XSUB(j)  (1280 + 64 * (j))
#define XB_XGEN(j)  (2304 + 64 * (j))
#define XB_TOP      3328
#define XB_TOPGEN   3392
#define XCD_BAR_WORDS 3456
#define XB_SPIN_CAP (1u << 22)
#define LAS __attribute__((address_space(3)))

__device__ __forceinline__ unsigned xb_ld(unsigned* p)              { return __hip_atomic_load(p, __ATOMIC_RELAXED, __HIP_MEMORY_SCOPE_AGENT); }
__device__ __forceinline__ unsigned xb_add(unsigned* p, unsigned v) { return __hip_atomic_fetch_add(p, v, __ATOMIC_RELAXED, __HIP_MEMORY_SCOPE_AGENT); }
__device__ __forceinline__ unsigned xb_xcc_id() { return (unsigned)__builtin_amdgcn_s_getreg((3 << 11) | 20) & 0xFu; }
#define XB_SPIN(cond, bar) do { unsigned _sp = 0; while (cond) { __builtin_amdgcn_s_sleep(1); \
    if ((++_sp & 255u) == 0u) { if (xb_ld(&(bar)[XB_TMO])) break; if (_sp > XB_SPIN_CAP) { atomicAdd(&(bar)[XB_TMO], 1u); break; } } } } while (0)

struct XcdBarrier {
    unsigned* bar; unsigned x;
    volatile LAS unsigned* st;
};

__device__ __forceinline__ XcdBarrier xcd_barrier_post(unsigned* bar, volatile LAS unsigned* st) {
    XcdBarrier b; b.bar = bar; b.x = xb_xcc_id(); b.st = st;
    if (threadIdx.x == 0) (void)xb_add(&bar[XB_XCNT(b.x)], 1u);
    return b;
}
__device__ __forceinline__ void xcd_barrier_complete(unsigned* bar, unsigned x, unsigned& nloc, unsigned& nx) {
    const unsigned G = gridDim.x * gridDim.y * gridDim.z;
    unsigned sum, cnt, mine, sp = 0u;
    for (;;) {
        sum = 0u; cnt = 0u; mine = 0u;
#pragma unroll
        for (unsigned j = 0; j < 16; ++j) { const unsigned c = xb_ld(&bar[XB_XCNT(j)]); sum += c; cnt += (c > 0u) ? 1u : 0u; mine = (j == x) ? c : mine; }
        if (sum == G) break;
        __builtin_amdgcn_s_sleep(1);
        if ((++sp & 255u) == 0u) { if (xb_ld(&bar[XB_TMO])) break; if (sp > XB_SPIN_CAP) { atomicAdd(&bar[XB_TMO], 1u); break; } }
    }
    nloc = mine > 0u ? mine : 1u; nx = cnt > 0u ? cnt : 1u;
}

__device__ __forceinline__ void xcd_barrier(const XcdBarrier& b) {
    asm volatile("s_waitcnt vmcnt(0)" ::: "memory");
    __syncthreads();
    if (threadIdx.x == 0) {
        unsigned* bar = b.bar;
        __builtin_amdgcn_s_waitcnt(0);
        unsigned nloc = b.st[0], nx = b.st[1];
        if (nloc == 0u) { xcd_barrier_complete(bar, b.x, nloc, nx); b.st[0] = nloc; b.st[1] = nx; }
        const unsigned old = xb_add(&bar[XB_XSUB(b.x)], 1u);
        const unsigned gen = old / nloc;
        if (old + 1u == (gen + 1u) * nloc) {
            __builtin_amdgcn_fence(__ATOMIC_RELEASE, "agent");
            asm volatile("s_waitcnt vmcnt(0)" ::: "memory");
            const unsigned og = xb_add(&bar[XB_TOP], 1u);
            const unsigned tg = og / nx;
            if (og + 1u == (tg + 1u) * nx) xb_add(&bar[XB_TOPGEN], 1u);
            else XB_SPIN(xb_ld(&bar[XB_TOPGEN]) == tg, bar);
            __builtin_amdgcn_fence(__ATOMIC_ACQUIRE, "agent");
            xb_add(&bar[XB_XGEN(b.x)], 1u);
            asm volatile("s_waitcnt vmcnt(0)" ::: "memory");
        } else {
            XB_SPIN(xb_ld(&bar[XB_XGEN(b.x)]) == gen, bar);
            __builtin_amdgcn_fence(__ATOMIC_ACQUIRE, "agent");
            asm volatile("s_waitcnt vmcnt(0)" ::: "memory");
        }
    }
    __syncthreads();
}

namespace pg8 {
#define PG8_LAS __attribute__((address_space(3)))
typedef unsigned short bf16_t;
typedef short bf16x8 __attribute__((ext_vector_type(8)));
typedef float f32x4 __attribute__((ext_vector_type(4)));
typedef unsigned u32x4 __attribute__((ext_vector_type(4)));
constexpr int BM = 256, BK = 64, HALF = 128, HTB = HALF * BK * 2  , STAGE_BYTES = 8 * HTB, NXCD = 8, WGM = 8;

__host__ __device__ __forceinline__ int lds_byte(int r, int c) { const int st = (r >> 4) * 2 + (c >> 5), rr = r & 15, cc = c & 31, ob = rr * 64 + cc * 2; return st * 1024 + (ob ^ (((ob >> 9) & 1) << 5)); }
__host__ __device__ __forceinline__ void stage_rc(int b, int& R, int& C) { const int st = b / 1024, sb = b % 1024, swz = sb ^ (((sb >> 9) & 1) << 5); R = (st >> 1) * 16 + swz / 64; C = (st & 1) * 32 + (swz % 64) / 2; }
__host__ __device__ __forceinline__ int perm32(int rho) { const int n = rho >> 4, i = rho & 15; return 8 * (i >> 2) + 4 * n + (i & 3); }

struct Unit { int pm, pn, k0, nt, at, slot; };
struct Gemm { const bf16_t* A; const bf16_t* Bt; int M, N, K; };

struct StaticOrder {
    int nM, nN, nwg, G, c, ntk, split;
    __host__ __device__ void init(int M, int N, int K, int G_, int c_, int split_ = 0) { nM = M / BM; nN = N / BM; nwg = nM * nN; G = G_; c = c_; ntk = K / BK; const int rem = nwg % G_; split = (split_ && rem > 0 && 2 * rem == G_ && (ntk % 4) != 1 && ntk >= 8) ? 1 : 0; }
    __host__ __device__ bool next(int i, Unit& u) const {
        long L = (long)i * G + c; u.k0 = 0; u.nt = ntk; u.at = 0; u.slot = 0;
        if (split && i == nwg / G) { const int rem = nwg % G, sl = c / rem, h0 = ((ntk / 2) + 1) & ~1; L = (long)i * G + (c % rem); u.k0 = sl ? h0 * BK : 0; u.nt = sl ? ntk - h0 : h0; u.at = sl ? 1 : 2; u.slot = c % rem; }
        if (L >= nwg) return false;
        int wgid = (int)L; { const int q = nwg / NXCD, r = nwg % NXCD, xcd = wgid % NXCD, off = wgid / NXCD; wgid = (xcd < r ? xcd * (q + 1) : r * (q + 1) + (xcd - r) * q) + off; }
        const int nig = WGM * nN, gid = wgid / nig, fm = gid * WGM, gsz = (nM - fm) < WGM ? (nM - fm) : WGM;
        u.pm = fm + ((wgid % nig) % gsz); u.pn = (wgid % nig) / gsz; return true;
    }
    __device__ __forceinline__ void a_ready(const Unit&) const {}
    __device__ __forceinline__ void done(const Unit&) const {}
};
__device__ __forceinline__ unsigned cvt_pk_bf16(float lo, float hi) { unsigned r; asm volatile("v_cvt_pk_bf16_f32 %0, %1, %2" : "=v"(r) : "v"(lo), "v"(hi)); return r; }
struct EpiF32 {
    static constexpr bool PERM = false, AFTER_DRAIN = false;
    float* C; int ldc; const float* bias;
    __device__ __forceinline__ void operator()(const f32x4 (&acc)[2][2][4][2], const Unit& u, int wr, int wc, int fr, int fq) const {
        const int row0 = u.pm * BM + wr * 64 + fr, col0 = u.pn * BM + wc * 32 + 4 * fq;
        f32x4 bv[2][2];
#pragma unroll
        for (int bj = 0; bj < 2; ++bj)
#pragma unroll
            for (int n = 0; n < 2; ++n) bv[bj][n] = bias ? *(const f32x4*)(bias + col0 + bj * HALF + n * 16) : (f32x4){0.f, 0.f, 0.f, 0.f};
#pragma unroll
        for (int ai = 0; ai < 2; ++ai)
#pragma unroll
            for (int m = 0; m < 4; ++m) { float* rowp = C + (size_t)(row0 + ai * HALF + m * 16) * ldc + col0;
#pragma unroll
                for (int bj = 0; bj < 2; ++bj)
#pragma unroll
                    for (int n = 0; n < 2; ++n) *(f32x4*)(rowp + bj * HALF + n * 16) = acc[ai][bj][m][n] + bv[bj][n]; }
    }
};

struct EpiSwiGLU {
    static constexpr bool PERM = true, AFTER_DRAIN = false;
    bf16_t* O; int ldc;
    __device__ __forceinline__ void operator()(const f32x4 (&acc)[2][2][4][2], const Unit& u, int wr, int wc, int fr, int fq) const {
        const int row0 = u.pm * BM + wr * 64 + fr, col0 = u.pn * 128 + wc * 32 + 8 * fq;
#pragma unroll
        for (int ai = 0; ai < 2; ++ai)
#pragma unroll
            for (int m = 0; m < 4; ++m) { bf16_t* rowp = O + (size_t)(row0 + ai * HALF + m * 16) * ldc + col0;
                const f32x4 g0 = acc[ai][0][m][0], g1 = acc[ai][0][m][1], u0 = acc[ai][1][m][0], u1 = acc[ai][1][m][1];
                float r[8];
#pragma unroll
                for (int j = 0; j < 4; ++j) {
                    r[j]     = g0[j] * __builtin_amdgcn_rcpf(1.0f + __builtin_amdgcn_exp2f(-1.4426950408889634f * g0[j])) * u0[j];
                    r[4 + j] = g1[j] * __builtin_amdgcn_rcpf(1.0f + __builtin_amdgcn_exp2f(-1.4426950408889634f * g1[j])) * u1[j]; }
                u32x4 w; w.x = cvt_pk_bf16(r[0], r[1]); w.y = cvt_pk_bf16(r[2], r[3]); w.z = cvt_pk_bf16(r[4], r[5]); w.w = cvt_pk_bf16(r[6], r[7]);
                *(u32x4*)rowp = w; }
    }
};
struct EpiBf16Plain {
    static constexpr bool PERM = true, AFTER_DRAIN = false;
    bf16_t* O; int ldc;
    __device__ __forceinline__ void operator()(const f32x4 (&acc)[2][2][4][2], const Unit& u, int wr, int wc, int fr, int fq) const {
        const int row0 = u.pm * BM + wr * 64 + fr, col0 = u.pn * BM + wc * 32 + 8 * fq;
#pragma unroll
        for (int ai = 0; ai < 2; ++ai)
#pragma unroll
            for (int m = 0; m < 4; ++m) { bf16_t* rowp = O + (size_t)(row0 + ai * HALF + m * 16) * ldc + col0;
#pragma unroll
                for (int bj = 0; bj < 2; ++bj) { const f32x4 v0 = acc[ai][bj][m][0], v1 = acc[ai][bj][m][1];
                    u32x4 w; w.x = cvt_pk_bf16(v0[0], v0[1]); w.y = cvt_pk_bf16(v0[2], v0[3]); w.z = cvt_pk_bf16(v1[0], v1[1]); w.w = cvt_pk_bf16(v1[2], v1[3]);
                    *(u32x4*)(rowp + bj * HALF) = w; } }
    }
};
struct EpiResid {
    static constexpr bool PERM = false, AFTER_DRAIN = false;
    const float* res; float* out; int ldc; const float* gate0; float coef;
    float* slab; unsigned* flags; unsigned target;
    __device__ __forceinline__ void operator()(const f32x4 (&acc)[2][2][4][2], const Unit& u, int wr, int wc, int fr, int fq) const {
        const int tidx = ((wr * 4 + wc) * 4 + fq) * 16 + fr;
        if (u.at == 1) {
            const __amdgpu_buffer_rsrc_t rs = __builtin_amdgcn_make_buffer_rsrc((void*)slab, 0, 0x7FFFFFF0, 0x00020000);
            const unsigned base = ((unsigned)u.slot * 32u * 512u + (unsigned)tidx) * 16u;
#pragma unroll
            for (int ai = 0; ai < 2; ++ai)
#pragma unroll
                for (int bj = 0; bj < 2; ++bj)
#pragma unroll
                    for (int m = 0; m < 4; ++m)
#pragma unroll
                        for (int n = 0; n < 2; ++n) { const f32x4 v = acc[ai][bj][m][n]; u32x4 w; w.x = __float_as_uint(v[0]); w.y = __float_as_uint(v[1]); w.z = __float_as_uint(v[2]); w.w = __float_as_uint(v[3]);
                            __builtin_amdgcn_raw_buffer_store_b128(w, rs, base + (unsigned)((((ai * 2 + bj) * 4 + m) * 2 + n) * 512 * 16), 0, 16); }
            asm volatile("s_waitcnt vmcnt(0)" ::: "memory");
            if ((tidx & 63) == 0) __hip_atomic_fetch_add(flags + 64 * u.slot, 1u, __ATOMIC_RELAXED, __HIP_MEMORY_SCOPE_AGENT);
            return;
        }
        const float* part = nullptr;
        if (u.at == 2) {
            unsigned spins = 0;
            while (__hip_atomic_load(flags + 64 * u.slot, __ATOMIC_RELAXED, __HIP_MEMORY_SCOPE_AGENT) < target) { __builtin_amdgcn_s_sleep(2); if (++spins > (1u << 22)) break; }
            __builtin_amdgcn_fence(__ATOMIC_ACQUIRE, "agent");
            asm volatile("s_waitcnt vmcnt(0)" ::: "memory");
            part = slab + ((size_t)u.slot * 32 * 512 + tidx) * 4;
        }
        const int row0 = u.pm * BM + wr * 64 + fr, col0 = u.pn * BM + wc * 32 + 4 * fq;
        const float* gate = gate0 + (size_t)cond_of_row(u.pm * BM) * NMOD;
        f32x4 gv[2][2];
#pragma unroll
        for (int bj = 0; bj < 2; ++bj)
#pragma unroll
            for (int n = 0; n < 2; ++n) gv[bj][n] = *(const f32x4*)(gate + col0 + bj * HALF + n * 16) * coef;
#pragma unroll
        for (int ai = 0; ai < 2; ++ai)
#pragma unroll
            for (int m = 0; m < 4; ++m) { const size_t off = (size_t)(row0 + ai * HALF + m * 16) * ldc + col0;
#pragma unroll
                for (int bj = 0; bj < 2; ++bj)
#pragma unroll
                    for (int n = 0; n < 2; ++n) {
                        f32x4 a = acc[ai][bj][m][n];
                        if (part) a += *(const f32x4*)(part + (size_t)((((ai * 2 + bj) * 4 + m) * 2 + n) * 512 * 4));
                        const f32x4 bs = *(const f32x4*)(res + off + bj * HALF + n * 16); *(f32x4*)(out + off + bj * HALF + n * 16) = bs + gv[bj][n] * a; }
                asm volatile("" ::: "memory"); }
    }
};
template <class Epi, class Sched, bool STAMP = false>
__device__ __forceinline__ void gemm_phase(PG8_LAS unsigned char* lds, const Gemm g, const Sched& S, const Epi& E, unsigned long long* stamps) {
    const int tid = opaque_tid(), wid = __builtin_amdgcn_readfirstlane(tid >> 6), lane = tid & 63, wr = wid >> 2, wc = wid & 3, fr = lane & 15, fq = lane >> 4;
    const int K = g.K;
    int ts_lo = 0, ts_hi = 0, nts = 0; const unsigned long long rt_entry = STAMP ? (unsigned long long)wall_clock64() : 0ull;
#define PG8_STAMP() do { if (STAMP && wid == 0 && nts < 64) { const unsigned long long _c = (unsigned long long)clock64(); \
        ts_lo = (lane == nts) ? (int)(unsigned)_c : ts_lo; ts_hi = (lane == nts) ? (int)(unsigned)(_c >> 32) : ts_hi; ++nts; } } while (0)
    PG8_STAMP();
    unsigned voffA[2], voffB[2];
#pragma unroll
    for (int i = 0; i < 2; ++i) { int R, C; stage_rc(tid * 16 + i * 8192, R, C); const int Rb = Epi::PERM ? ((R & ~31) + perm32(R & 31)) : R;
        voffA[i] = (unsigned)(R * K + C) * 2u; voffB[i] = (unsigned)(Rb * K + C) * 2u; }
    const size_t kstep = (size_t)(BK * 2);
    const size_t hstep = (size_t)HALF * K * 2;
    const size_t tstep = 2 * hstep;
    const unsigned ldsw = (unsigned)wid * 1024u;
    const int aoff = lds_byte(wr * 64 + fr, fq * 8), boff = lds_byte(wc * 32 + fr, fq * 8);
#define PG8_SA(b, h) (((b) * 2 + (h)) * HTB)
#define PG8_SB(b, h) ((4 + (b) * 2 + (h)) * HTB)
#define PG8_STAGE(bufoff, gbase, voff) do { _Pragma("unroll") for (int _i = 0; _i < 2; ++_i) \
        __builtin_amdgcn_global_load_lds((const unsigned*)((const char*)(gbase) + (voff)[_i]), (PG8_LAS unsigned*)(lds + (bufoff) + ldsw + _i * 8192), 16, 0, 0); } while (0)
#define PG8_LDA(dst, b, h) do { _Pragma("unroll") for (int m = 0; m < 4; ++m) _Pragma("unroll") for (int k = 0; k < 2; ++k) dst[m][k] = *(const PG8_LAS bf16x8*)(lds + PG8_SA(b, h) + aoff + m * 2048 + k * 1024); } while (0)
#define PG8_LDB(dst, b, h) do { _Pragma("unroll") for (int n = 0; n < 2; ++n) _Pragma("unroll") for (int k = 0; k < 2; ++k) dst[n][k] = *(const PG8_LAS bf16x8*)(lds + PG8_SB(b, h) + boff + n * 2048 + k * 1024); } while (0)
#define PG8_MMA(ai, bj, At, Bt) do { __builtin_amdgcn_s_setprio(1); _Pragma("unroll") for (int m = 0; m < 4; ++m) _Pragma("unroll") for (int n = 0; n < 2; ++n) _Pragma("unroll") for (int k = 0; k < 2; ++k) \
        acc[ai][bj][m][n] = __builtin_amdgcn_mfma_f32_16x16x32_bf16(Bt[n][k], At[m][k], acc[ai][bj][m][n], 0, 0, 0); __builtin_amdgcn_s_setprio(0); } while (0)
#define PG8_WAIT_V(n) asm volatile("s_waitcnt vmcnt(" #n ")" ::: "memory")
#define PG8_WAIT_L(n) asm volatile("s_waitcnt lgkmcnt(" #n ")" ::: "memory")
#define PG8_BAR __builtin_amdgcn_s_barrier()
#define PG8_SCHED __builtin_amdgcn_sched_barrier(0)
    Unit cur, nxt; int ui = 0;
    if (!S.next(0, cur)) return;
    f32x4 acc[2][2][4][2];
#pragma unroll
    for (int a = 0; a < 2; ++a)
#pragma unroll
        for (int b = 0; b < 2; ++b)
#pragma unroll
            for (int m = 0; m < 4; ++m)
#pragma unroll
                for (int n = 0; n < 2; ++n) acc[a][b][m][n] = (f32x4){0.f, 0.f, 0.f, 0.f};
    bf16x8 At[4][2], B0[2][2], B1[2][2];
    const char* cA = (const char*)g.A + (size_t)cur.pm * tstep + (size_t)cur.k0 * 2; const char* cB = (const char*)g.Bt + (size_t)cur.pn * tstep + (size_t)cur.k0 * 2;
    S.a_ready(cur);
    PG8_STAGE(PG8_SB(0, 0), cB, voffB); PG8_STAGE(PG8_SA(0, 0), cA, voffA); PG8_STAGE(PG8_SB(0, 1), cB + hstep, voffB); PG8_STAGE(PG8_SA(0, 1), cA + hstep, voffA);
    if (wr == 1) PG8_BAR;
    PG8_WAIT_V(4); PG8_BAR;
    PG8_STAGE(PG8_SB(1, 0), cB + kstep, voffB); PG8_STAGE(PG8_SA(1, 0), cA + kstep, voffA); PG8_STAGE(PG8_SB(1, 1), cB + hstep + kstep, voffB);
    PG8_WAIT_V(6); PG8_BAR;
    PG8_STAMP();
    for (;;) {
        const bool has_next = S.next(ui + 1, nxt);
        const char* nA = has_next ? (const char*)g.A + (size_t)nxt.pm * tstep + (size_t)nxt.k0 * 2 : cA; const char* nB = has_next ? (const char*)g.Bt + (size_t)nxt.pn * tstep + (size_t)nxt.k0 * 2 : cB;
        const int nt = cur.nt;
        for (int t = 0; t < nt; t += 2) {
            const bool last = (t == nt - 2);
            const char* a1 = cA + (size_t)(t + 1) * kstep;
            const char* a2 = last ? nA : cA + (size_t)(t + 2) * kstep; const char* b2 = last ? nB : cB + (size_t)(t + 2) * kstep;
            const char* a3 = a2 + kstep; const char* b3 = b2 + kstep;
            if (last && has_next) S.a_ready(nxt);
            PG8_LDB(B0, 0, 0); PG8_SCHED; PG8_LDA(At, 0, 0); PG8_STAGE(PG8_SA(1, 1), a1 + hstep, voffA);
            PG8_WAIT_L(8); PG8_BAR; PG8_WAIT_L(0); PG8_MMA(0, 0, At, B0); PG8_BAR; PG8_SCHED;
            PG8_LDB(B1, 0, 1); PG8_STAGE(PG8_SB(0, 0), b2, voffB);
            PG8_BAR; PG8_WAIT_L(0); PG8_MMA(0, 1, At, B1); PG8_BAR;
            PG8_LDA(At, 0, 1); PG8_STAGE(PG8_SA(0, 0), a2, voffA);
            PG8_BAR; PG8_WAIT_L(0); PG8_MMA(1, 0, At, B0); PG8_BAR; PG8_SCHED;
            PG8_STAGE(PG8_SB(0, 1), b2 + hstep, voffB);
            PG8_WAIT_V(6); PG8_BAR; PG8_MMA(1, 1, At, B1); PG8_BAR;
            PG8_LDB(B0, 1, 0); PG8_SCHED; PG8_LDA(At, 1, 0); PG8_STAGE(PG8_SA(0, 1), a2 + hstep, voffA);
            PG8_WAIT_L(8); PG8_BAR; PG8_WAIT_L(0); PG8_MMA(0, 0, At, B0); PG8_BAR; PG8_SCHED;
            PG8_LDB(B1, 1, 1); PG8_STAGE(PG8_SB(1, 0), b3, voffB);
            PG8_BAR; PG8_WAIT_L(0); PG8_MMA(0, 1, At, B1); PG8_BAR;
            PG8_LDA(At, 1, 1); PG8_STAGE(PG8_SA(1, 0), a3, voffA);
            PG8_BAR; PG8_WAIT_L(0); PG8_MMA(1, 0, At, B0); PG8_BAR; PG8_SCHED;
            PG8_STAGE(PG8_SB(1, 1), b3 + hstep, voffB);
            PG8_WAIT_V(6); PG8_BAR; PG8_MMA(1, 1, At, B1); PG8_BAR;
        }
        PG8_STAMP();
        if constexpr (!Epi::AFTER_DRAIN) { E(acc, cur, wr, wc, fr, fq); S.done(cur); }
        PG8_STAMP();
        if (!has_next) break;
#pragma unroll
        for (int a = 0; a < 2; ++a)
#pragma unroll
            for (int b = 0; b < 2; ++b)
#pragma unroll
                for (int m = 0; m < 4; ++m)
#pragma unroll
                    for (int n = 0; n < 2; ++n) acc[a][b][m][n] = (f32x4){0.f, 0.f, 0.f, 0.f};
        cur = nxt; cA = nA; cB = nB; ++ui;
    }
    PG8_WAIT_V(0);
    if (wr == 0) PG8_BAR;
    PG8_BAR;
    if constexpr (Epi::AFTER_DRAIN) { E.fused(acc, cur, wr, wc, fr, fq, lds, wid, lane); S.done(cur); }
    PG8_STAMP();
    if (STAMP && wid == 0) { stamps[lane] = lane < nts ? (((unsigned long long)(unsigned)ts_hi << 32) | (unsigned)ts_lo) : 0ull;
        if (lane == 62) stamps[62] = rt_entry; if (lane == 63) stamps[63] = (unsigned long long)wall_clock64(); }
#undef PG8_STAMP
#undef PG8_SA
#undef PG8_SB
#undef PG8_STAGE
#undef PG8_LDA
#undef PG8_LDB
#undef PG8_MMA
#undef PG8_WAIT_V
#undef PG8_WAIT_L
#undef PG8_BAR
#undef PG8_SCHED
}
}
#ifndef ATT_INLINE
#define ATT_INLINE __forceinline__
#endif
namespace att {
constexpr int D = 128, NW = 8, QBLK = 32, KVBLK = 64, LDQ = 512, LDO = DM;
constexpr float SCALE = 0.088388347648318440f;
constexpr float THR = 8.f;
constexpr size_t SHM_V = KVBLK * D * 2, SHM_K = KVBLK * D * 2, SHM_Q = 256 * D * 2, SHM_ATTN = 2 * SHM_V + 2 * SHM_K + NW * 64 * 4 + SHM_Q;
using bf16x8 = __attribute__((ext_vector_type(8))) short;
using s16x4  = __attribute__((ext_vector_type(4))) short;
using f32x16 = __attribute__((ext_vector_type(16))) float;
using u32x4  = __attribute__((ext_vector_type(4))) unsigned;
#define KSWZ(row, colB) ((row) * 256 + ((colB) ^ (((row) & 7) << 4)))
#define SBAR() __builtin_amdgcn_sched_barrier(0)
__device__ __forceinline__ int crow(int r, int hi) { return (r & 3) + 8 * (r >> 2) + 4 * hi; }
__device__ __forceinline__ unsigned cvtpk(float lo, float hi) { unsigned r; asm volatile("v_cvt_pk_bf16_f32 %0, %1, %2" : "=v"(r) : "v"(lo), "v"(hi)); return r; }

__device__ __forceinline__ void partialSM(f32x16& p0, f32x16& p1, float& m_reg, float& mn, float& alpha) {
  constexpr float C = SCALE * 1.4426950408889634f;
  float pmax = p0[0]; for (int r = 1; r < 16; ++r) pmax = fmaxf(pmax, p0[r]); for (int r = 0; r < 16; ++r) pmax = fmaxf(pmax, p1[r]);
  { auto rr = __builtin_amdgcn_permlane32_swap(__float_as_uint(pmax), __float_as_uint(pmax), false, false);
    pmax = fmaxf(__uint_as_float(rr[0]), __uint_as_float(rr[1])); }
  if (__builtin_expect(__all(pmax - m_reg <= THR / SCALE), 1)) { mn = m_reg; alpha = 1.f; }
  else { mn = fmaxf(m_reg, pmax); alpha = __builtin_amdgcn_exp2f((m_reg - mn) * C); m_reg = mn; }
  float mnC = -mn * C;
  for (int r = 0; r < 16; ++r) p0[r] = fmaf(p0[r], C, mnC); for (int r = 0; r < 16; ++r) p1[r] = fmaf(p1[r], C, mnC);
  for (int r = 0; r < 16; ++r) p0[r] = __builtin_amdgcn_exp2f(p0[r]);
}
__device__ __forceinline__ void finishSM(f32x16& p0, f32x16& p1, float alpha, float& l_reg, bf16x8& pa0, bf16x8& pa1, bf16x8& pa2, bf16x8& pa3) {
  for (int r = 0; r < 16; ++r) p1[r] = __builtin_amdgcn_exp2f(p1[r]);
  float ps = 0; for (int r = 0; r < 16; ++r) ps += p0[r]; for (int r = 0; r < 16; ++r) ps += p1[r];
  { auto rr = __builtin_amdgcn_permlane32_swap(__float_as_uint(ps), __float_as_uint(ps), false, false);
    ps = __uint_as_float(rr[0]) + __uint_as_float(rr[1]); }
  l_reg = l_reg * alpha + ps;
#define PK4(P, BASE, OUT) do { unsigned a0 = cvtpk(P[BASE + 0], P[BASE + 1]), a1 = cvtpk(P[BASE + 2], P[BASE + 3]);   \
    unsigned b0 = cvtpk(P[BASE + 4], P[BASE + 5]), b1 = cvtpk(P[BASE + 6], P[BASE + 7]);                              \
    auto r0 = __builtin_amdgcn_permlane32_swap(a0, b0, false, false); auto r1 = __builtin_amdgcn_permlane32_swap(a1, b1, false, false); \
    u32x4 w = {r0[0], r1[0], r0[1], r1[1]}; OUT = *reinterpret_cast<bf16x8*>(&w); } while (0)
  PK4(p0, 0, pa0); PK4(p0, 8, pa1); PK4(p1, 0, pa2); PK4(p1, 8, pa3);
#undef PK4
}
__device__ __forceinline__ void qkt(f32x16& p0, f32x16& p1, const bf16_t* Ks, const bf16_t* Qs, int qrow, int r32, int hi) {
  p0 = f32x16{}; p1 = f32x16{};
#pragma unroll
  for (int d0 = 0; d0 < 8; ++d0) { int cb = (d0 * 16 + hi * 8) * 2;
    bf16x8 q = *reinterpret_cast<const bf16x8*>((const char*)Qs + KSWZ(qrow, cb));
    bf16x8 b0 = *reinterpret_cast<const bf16x8*>((const char*)Ks + KSWZ(r32, cb));
    bf16x8 b1 = *reinterpret_cast<const bf16x8*>((const char*)Ks + KSWZ(32 + r32, cb));
    p0 = __builtin_amdgcn_mfma_f32_32x32x16_bf16(b0, q, p0, 0, 0, 0);
    p1 = __builtin_amdgcn_mfma_f32_32x32x16_bf16(b1, q, p1, 0, 0, 0); }
}
__device__ __forceinline__ int v_st(int k, int c) { const int kk = (k & ~0xC) | ((k & 4) << 1) | ((k & 8) >> 1); return ((kk >> 3) * 4 + (c >> 5)) * 512 + ((kk & 7) * 32 + (c & 31)) * 2; }
__device__ __forceinline__ int v_rd_base(int lane) { return ((lane & 3) << 3) | (((lane >> 2) & 3) << 6) | (((lane >> 4) & 1) << 5) | (((lane >> 5) & 1) << 8); }
constexpr int v_rd_off(int d0, int ks, int half) { return d0 * 512 + ks * 4096 + half * 2048; }
template <int OFF> __device__ __forceinline__ s16x4 tr_read(int vb) {
  s16x4 r; asm volatile("ds_read_b64_tr_b16 %0, %1 offset:%2" : "=&v"(r) : "v"(vb), "i"(OFF) : "memory"); return r;
}
template <int D0> __device__ __forceinline__ void pv_one(f32x16& od, int vb, bf16x8 pa0, bf16x8 pa1, bf16x8 pa2, bf16x8 pa3) {
  const s16x4 l0 = tr_read<v_rd_off(D0, 0, 0)>(vb), h0 = tr_read<v_rd_off(D0, 0, 1)>(vb), l1 = tr_read<v_rd_off(D0, 1, 0)>(vb), h1 = tr_read<v_rd_off(D0, 1, 1)>(vb);
  const s16x4 l2 = tr_read<v_rd_off(D0, 2, 0)>(vb), h2 = tr_read<v_rd_off(D0, 2, 1)>(vb), l3 = tr_read<v_rd_off(D0, 3, 0)>(vb), h3 = tr_read<v_rd_off(D0, 3, 1)>(vb);
  asm volatile("s_waitcnt lgkmcnt(0)" ::: "memory"); SBAR();
#define PK(L, H) (bf16x8){L[0], L[1], L[2], L[3], H[0], H[1], H[2], H[3]}
  od = __builtin_amdgcn_mfma_f32_32x32x16_bf16(pa0, PK(l0, h0), od, 0, 0, 0);
  od = __builtin_amdgcn_mfma_f32_32x32x16_bf16(pa1, PK(l1, h1), od, 0, 0, 0);
  od = __builtin_amdgcn_mfma_f32_32x32x16_bf16(pa2, PK(l2, h2), od, 0, 0, 0);
  od = __builtin_amdgcn_mfma_f32_32x32x16_bf16(pa3, PK(l3, h3), od, 0, 0, 0);
#undef PK
}
__device__ __forceinline__ void pv_d0(f32x16* o, int vb, bf16x8 pa0, bf16x8 pa1, bf16x8 pa2, bf16x8 pa3) {
  pv_one<0>(o[0], vb, pa0, pa1, pa2, pa3); pv_one<1>(o[1], vb, pa0, pa1, pa2, pa3); pv_one<2>(o[2], vb, pa0, pa1, pa2, pa3); pv_one<3>(o[3], vb, pa0, pa1, pa2, pa3);
}

struct SrcOne { const bf16_t* k0; const bf16_t* v0; int ldk;
  __device__ __forceinline__ const bf16_t* k(int j) const { return k0 + (size_t)j * 64 * ldk; }
  __device__ __forceinline__ const bf16_t* v(int j) const { return v0 + (size_t)j * 64 * ldk; } };
struct SrcTwo { const bf16_t* ck; const bf16_t* cv; const bf16_t* k1; const bf16_t* v1; int ldk;
  __device__ __forceinline__ const bf16_t* k(int j) const { return j < 4 ? ck + (size_t)j * 64 * ldk : k1 + (size_t)(j - 4) * 64 * ldk; }
  __device__ __forceinline__ const bf16_t* v(int j) const { return j < 4 ? cv + (size_t)j * 64 * ldk : v1 + (size_t)(j - 4) * 64 * ldk; } };
struct NoBias { __device__ __forceinline__ void operator()(f32x16&, f32x16&, int, int, int, int) const {} };
struct NaBias { const float* tab; int i0, kr0;
  __device__ __forceinline__ void operator()(f32x16& p0, f32x16& p1, int jt, int wid, int r32, int hi) const {
    if (jt < 4) return;
    const int qi = i0 + wid * QBLK + r32, r = qi >> 6, qc = qi & 63, kr = kr0 + jt - 4;
    int lo = r - 4; lo = lo < 0 ? 0 : (lo > 8 ? 8 : lo);
    const bool rowok = (kr >= lo) && (kr < lo + 8);
    if (!rowok) {
#pragma unroll
      for (int rr = 0; rr < 16; ++rr) { p0[rr] = -1e30f; p1[rr] = -1e30f; }
      return;
    }
    int c0 = qc - 8; c0 = c0 < 0 ? 0 : (c0 > 48 ? 48 : c0);
    const int dr = kr - r + 7;
    const float* tb = tab + dr * 31 + (4 * hi - qc + 15);
    const int w0 = 4 * hi - c0;
#pragma unroll
    for (int g = 0; g < 4; ++g) {
#pragma unroll
      for (int q = 0; q < 4; ++q) {
        const int rr = 4 * g + q, kc0 = q + 8 * g;
        const float t0 = tb[kc0], t1 = tb[kc0 + 32];
        p0[rr] = ((unsigned)(kc0 + w0) < 16u) ? p0[rr] + t0 : -1e30f;
        p1[rr] = ((unsigned)(kc0 + 32 + w0) < 16u) ? p1[rr] + t1 : -1e30f;
      }
      SBAR();
    }
  } };

template <int SD, class Src, class Bias>
__device__ ATT_INLINE void attn_body(const bf16_t* __restrict__ Qb, const Src src, bf16_t* __restrict__ Ob, const int NT, char* lds, const Bias bias) {
  const int tid = opaque_tid(), wid = tid >> 6, lane = tid & 63, r32 = lane & 31, hi = lane >> 5;
  const int LDK = src.ldk;
  bf16_t* V_lds = (bf16_t*)lds; bf16_t* K_lds = (bf16_t*)(lds + 2 * SHM_V);
  float* ws = (float*)(lds + 2 * SHM_V + 2 * SHM_K) + wid * 64; float* li_l = ws; float* al_l = ws + 32;
  float m_reg = -1e30f, l_reg = 0; f32x16 o[4] = {};
  bf16_t* Q_lds = (bf16_t*)(lds + 2 * SHM_V + 2 * SHM_K + NW * 64 * 4);
  const int qrow = wid * QBLK + r32;
  {
#pragma unroll
    for (int i = 0; i < 8; ++i) { const int f = tid + 512 * i, row = f >> 4, c8 = (f & 15) * 8;
      *(bf16x8*)((char*)Q_lds + KSWZ(row, c8 * 2)) = *reinterpret_cast<const bf16x8*>(Qb + (long)row * LDQ + c8); }
  }
  const int sr = tid >> 4, sc = (tid & 15) * 8, vst0 = v_st(sr, sc), vst1 = v_st(32 + sr, sc);
  const int vb0 = (int)(uintptr_t)V_lds + v_rd_base(lane);
  struct { bf16x8 vs0, vs1, ks0, ks1; } sr_[SD];
#define SLOAD(i, jt) do { const bf16_t* kt_ = src.k(jt); const bf16_t* vt_ = src.v(jt); \
    sr_[i].vs0 = *reinterpret_cast<const bf16x8*>(&vt_[(long)sr * LDK + sc]); sr_[i].vs1 = *reinterpret_cast<const bf16x8*>(&vt_[(long)(32 + sr) * LDK + sc]); \
    sr_[i].ks0 = *reinterpret_cast<const bf16x8*>(&kt_[(long)sr * LDK + sc]); sr_[i].ks1 = *reinterpret_cast<const bf16x8*>(&kt_[(long)(32 + sr) * LDK + sc]); } while (0)
#define SWRITE(b, i) do { *(bf16x8*)((char*)V_lds + (b) * SHM_V + vst0) = sr_[i].vs0;          \
    *(bf16x8*)((char*)V_lds + (b) * SHM_V + vst1) = sr_[i].vs1; int kc = sc * 2;               \
    *(bf16x8*)((char*)K_lds + (b) * SHM_K + KSWZ(sr, kc)) = sr_[i].ks0;                       \
    *(bf16x8*)((char*)K_lds + (b) * SHM_K + KSWZ(32 + sr, kc)) = sr_[i].ks1; } while (0)
#define SWAIT() do { if constexpr (SD == 2) asm volatile("s_waitcnt vmcnt(4)" ::: "memory"); else asm volatile("s_waitcnt vmcnt(0)" ::: "memory"); } while (0)
#define RESC(a) do { if (__any((a) < 1.f)) { if (hi == 0) al_l[r32] = (a); asm volatile("s_waitcnt lgkmcnt(0)" ::: "memory"); \
    for (int d = 0; d < 4; ++d) for (int r = 0; r < 16; ++r) o[d][r] *= al_l[crow(r, hi)]; } } while (0)
  f32x16 pA0, pA1, pB0, pB1; float mnA, mnB, alA, alB; bf16x8 pa0, pa1, pa2, pa3;
  constexpr int SE = 0, SO = SD - 1;
  SLOAD(SE, 0); asm volatile("s_waitcnt vmcnt(0)" ::: "memory"); SWRITE(0, SE); __syncthreads();
  qkt(pA0, pA1, K_lds, Q_lds, qrow, r32, hi); bias(pA0, pA1, 0, wid, r32, hi); partialSM(pA0, pA1, m_reg, mnA, alA);
  SLOAD(SO, 1); if constexpr (SD == 2) { if (2 < NT) SLOAD(SE, 2); }
  SWAIT(); SWRITE(1, SO); __syncthreads();
  for (int j = 1; j + 1 < NT; j += 2) {
    SBAR(); qkt(pB0, pB1, (bf16_t*)((char*)K_lds + SHM_K), Q_lds, qrow, r32, hi); bias(pB0, pB1, j, wid, r32, hi);
    finishSM(pA0, pA1, alA, l_reg, pa0, pa1, pa2, pa3); SBAR();
    SLOAD(SO, j + SD); SBAR();
    pv_d0(o, vb0, pa0, pa1, pa2, pa3); partialSM(pB0, pB1, m_reg, mnB, alB);
    __syncthreads(); SWAIT(); SWRITE(0, SE);
    RESC(alB); __syncthreads();
    SBAR(); qkt(pA0, pA1, K_lds, Q_lds, qrow, r32, hi); bias(pA0, pA1, j + 1, wid, r32, hi);
    finishSM(pB0, pB1, alB, l_reg, pa0, pa1, pa2, pa3); SBAR();
    if (SD == 1 || j + 3 < NT) SLOAD(SE, j + 1 + SD); SBAR();
    pv_d0(o, vb0 + (int)SHM_V, pa0, pa1, pa2, pa3); partialSM(pA0, pA1, m_reg, mnA, alA);
    __syncthreads(); SWAIT(); SWRITE(1, SO);
    RESC(alA); __syncthreads();
  }
  SBAR(); qkt(pB0, pB1, (bf16_t*)((char*)K_lds + SHM_K), Q_lds, qrow, r32, hi); bias(pB0, pB1, NT - 1, wid, r32, hi);
  finishSM(pA0, pA1, alA, l_reg, pa0, pa1, pa2, pa3); SBAR();
  pv_d0(o, vb0, pa0, pa1, pa2, pa3); partialSM(pB0, pB1, m_reg, mnB, alB);
  __syncthreads(); RESC(alB);
  finishSM(pB0, pB1, alB, l_reg, pa0, pa1, pa2, pa3); SBAR();
  pv_d0(o, vb0 + (int)SHM_V, pa0, pa1, pa2, pa3);
  if (hi == 0) li_l[r32] = l_reg; asm volatile("s_waitcnt lgkmcnt(0)" ::: "memory");
  float rli[16];
#pragma unroll
  for (int r = 0; r < 16; ++r) rli[r] = __builtin_amdgcn_rcpf(li_l[crow(r, hi)]);
  bf16_t* Ow = Ob + (long)(wid * QBLK) * LDO;
#pragma unroll
  for (int r = 0; r < 16; ++r) { int orow = crow(r, hi);
    for (int d0 = 0; d0 < 4; ++d0) Ow[(long)orow * LDO + d0 * 32 + r32] = f2bf(o[d0][r] * rli[r]); }
#undef SLOAD
#undef SWRITE
#undef SWAIT
#undef RESC
}
}
namespace gdn {
using att::bf16x8; using att::f32x16; using att::crow;
constexpr int C = 32, SK = 136, SS = 40;
constexpr int OFF_KT = 0, OFF_QT = OFF_KT + C * SK * 2, OFF_W = OFF_QT + C * SK * 2, OFF_KTT = OFF_W + C * SK * 2, OFF_VTT = OFF_KTT + 128 * SS * 2,
              OFF_VN = OFF_VTT + 128 * SS * 2, OFF_VNS = OFF_VN + 128 * SS * 2, OFF_ST = OFF_VNS + 128 * SS * 2, OFF_TB = OFF_ST + 128 * SK * 2,
              OFF_TBE = OFF_TB + C * SS * 2, OFF_ATT = OFF_TBE + C * SS * 2, OFF_L = OFF_ATT + C * SS * 2, OFF_SC = OFF_L + C * C * 4, GDN_LDS = OFF_SC + 1024;
template <int K>
__device__ __forceinline__ f32x16 mm(const bf16_t* A, int lda, const bf16_t* Bt, int ldb, int l32, int hi, f32x16 acc) {
#pragma unroll
    for (int k0 = 0; k0 < K; k0 += 16) {
        const bf16x8 a = *reinterpret_cast<const bf16x8*>(A + l32 * lda + k0 + 8 * hi);
        const bf16x8 b = *reinterpret_cast<const bf16x8*>(Bt + l32 * ldb + k0 + 8 * hi);
        acc = __builtin_amdgcn_mfma_f32_32x32x16_bf16(a, b, acc, 0, 0, 0);
    }
    return acc;
}
__device__ __forceinline__ uint2 pk4(float a, float b, float c, float d) { uint2 w; w.x = pack2(a, b); w.y = pack2(c, d); return w; }

__device__ __forceinline__ void gdn_chunked(const Params& p, int l, bool ctx, int b, int h, int dir, unsigned char* lds) {
    const int tid = opaque_tid(), wid = tid >> 6, lane = tid & 63, l32 = lane & 31, hi = lane >> 5;
    const int T = ctx ? CT : ::LT; const size_t m0 = ctx ? (size_t)b * CT : (size_t)MC + (size_t)b * ::LT;
    const bf16_t* DQ = WSP(bf16_t, WS_DQ); const bf16_t* DK = WSP(bf16_t, WS_DK); const bf16_t* DV = WSP(bf16_t, WS_DV); const float* DBA = WSP(float, WS_DBA);
    float* O = WSP(float, dir ? WS_DOB : WS_DOF);
    bf16_t* Kt = (bf16_t*)(lds + OFF_KT); bf16_t* Qt = (bf16_t*)(lds + OFF_QT); bf16_t* W = (bf16_t*)(lds + OFF_W); bf16_t* KT = (bf16_t*)(lds + OFF_KTT); bf16_t* VT = (bf16_t*)(lds + OFF_VTT);
    bf16_t* VN = (bf16_t*)(lds + OFF_VN); bf16_t* VNS = (bf16_t*)(lds + OFF_VNS); bf16_t* ST = (bf16_t*)(lds + OFF_ST); bf16_t* TB = (bf16_t*)(lds + OFF_TB); bf16_t* TBE = (bf16_t*)(lds + OFF_TBE);
    bf16_t* ATT = (bf16_t*)(lds + OFF_ATT); float* Lm = (float*)(lds + OFF_L); float* sc = (float*)(lds + OFF_SC);
    const int nch = T / C;
#define TOK(c, s_) (m0 + (dir ? T - 1 - ((c) * C + (s_)) : (c) * C + (s_)))
    f32x16 S[2];
#pragma unroll
    for (int bi = 0; bi < 2; ++bi) {
        const int blk = wid * 2 + bi, d0 = 32 * (blk >> 2), e0 = 32 * (blk & 3);
        if (ctx) { S[bi] = f32x16{}; }
        else {
            const float* s0 = p.in[I_SGDN] + ((((size_t)b * DEPTH + l) * 2 + dir) * 4 + h) * 128 * 128 + e0 + l32;
#pragma unroll
            for (int r = 0; r < 16; ++r) S[bi][r] = s0[(size_t)(d0 + crow(r, hi)) * 128];
        }
    }
    const int ls = tid >> 5, lc = (tid & 31) * 4;
    vf4 pq0, pq1, pk0, pk1, pv0, pv1; float pbeta = 0.f, pg = 0.f;
#define GLOAD(c) do { const size_t ma = TOK(c, ls), mb = TOK(c, ls + 16); \
        pq0 = ld4bf(DQ + ma * 512 + h * 128 + lc); pq1 = ld4bf(DQ + mb * 512 + h * 128 + lc); \
        pk0 = ld4bf(DK + ma * 512 + h * 128 + lc); pk1 = ld4bf(DK + mb * 512 + h * 128 + lc); \
        pv0 = ld4bf(DV + ma * 512 + h * 128 + lc); pv1 = ld4bf(DV + mb * 512 + h * 128 + lc); \
        if (tid < C) { const size_t mt = TOK(c, tid); pbeta = DBA[mt * 16 + dir * 4 + h]; pg = DBA[mt * 16 + 8 + dir * 4 + h]; } } while (0)
#define GSTAGE() do { \
        *(uint2*)(Kt + ls * SK + lc) = pk4(pk0.x, pk0.y, pk0.z, pk0.w); *(uint2*)(Kt + (ls + 16) * SK + lc) = pk4(pk1.x, pk1.y, pk1.z, pk1.w); \
        *(uint2*)(Qt + ls * SK + lc) = pk4(pq0.x, pq0.y, pq0.z, pq0.w); *(uint2*)(Qt + (ls + 16) * SK + lc) = pk4(pq1.x, pq1.y, pq1.z, pq1.w); \
        _Pragma("unroll") for (int j = 0; j < 4; ++j) { KT[(lc + j) * SS + ls] = f2bf(pk0[j]); KT[(lc + j) * SS + ls + 16] = f2bf(pk1[j]); \
                                                        VT[(lc + j) * SS + ls] = f2bf(pv0[j]); VT[(lc + j) * SS + ls + 16] = f2bf(pv1[j]); } \
        if (wid == 0) { float x = pg; _Pragma("unroll") for (int o_ = 1; o_ < 32; o_ <<= 1) { const float y = __shfl_up(x, o_); if (lane >= o_) x += y; } \
            const float Bt_ = __shfl(x, 31); if (lane < C) { sc[lane] = pbeta; sc[32 + lane] = x; sc[64 + lane] = __expf(x); sc[96 + lane] = __expf(Bt_ - x); if (lane == 0) sc[128] = __expf(Bt_); } } } while (0)
    __syncthreads();
    GLOAD(0);
#pragma unroll
    for (int bi = 0; bi < 2; ++bi) {
        const int blk = wid * 2 + bi, d0 = 32 * (blk >> 2), e0 = 32 * (blk & 3);
#pragma unroll
        for (int g = 0; g < 4; ++g) *(uint2*)(ST + (e0 + l32) * SK + d0 + 8 * g + 4 * hi) = pk4(S[bi][4 * g], S[bi][4 * g + 1], S[bi][4 * g + 2], S[bi][4 * g + 3]);
    }
    GSTAGE();
    __syncthreads();
    for (int c = 0; c < nch; ++c) {
        if (c + 1 < nch) GLOAD(c + 1);
        f32x16 acc1 = f32x16{};
        if (wid == 0) {
            const f32x16 kk = mm<128>(Kt, SK, Kt, SK, l32, hi, f32x16{});
            const float bi_ = sc[32 + l32], be = sc[l32];
#pragma unroll
            for (int r = 0; r < 16; ++r) { const int j = crow(r, hi); const float v = (l32 > j) ? be * kk[r] * __expf(bi_ - sc[32 + j]) : 0.f;
                Lm[l32 * 32 + ((r & 3) + 4 * hi) * 4 + (r >> 2)] = v; }
        } else if (wid == 1) {
            const f32x16 kq = mm<128>(Kt, SK, Qt, SK, l32, hi, f32x16{});
            const float bi_ = sc[32 + l32];
            float a[16];
#pragma unroll
            for (int r = 0; r < 16; ++r) { const int j = crow(r, hi); a[r] = (l32 >= j) ? kq[r] * __expf(bi_ - sc[32 + j]) : 0.f; }
#pragma unroll
            for (int g = 0; g < 4; ++g) *(uint2*)(ATT + l32 * SS + 8 * g + 4 * hi) = pk4(a[4 * g], a[4 * g + 1], a[4 * g + 2], a[4 * g + 3]);
        } else if (wid >= 4) {
            acc1 = mm<128>(Qt, SK, ST + (32 * (wid - 4)) * SK, SK, l32, hi, f32x16{});
#pragma unroll
            for (int r = 0; r < 16; ++r) acc1[r] *= sc[64 + crow(r, hi)];
        }
        __syncthreads();
        if (tid < 256) {
            const int cc = tid >> 3, part = tid & 7;
            float Tr[4] = {0.f, 0.f, 0.f, 0.f};
            const float* Lp = Lm + part * 4;
#pragma unroll
            for (int i = 0; i < 32; ++i) {
                const vf4 lv = *(const vf4*)(Lp + i * 32);
                float s = lv.x * Tr[0] + lv.y * Tr[1] + lv.z * Tr[2] + lv.w * Tr[3];
                s = red8(s);
                const float t = (i == cc ? 1.f : 0.f) - s;
                if (part == (i & 7)) Tr[i >> 3] = t;
            }
            const float bc = sc[cc], bec = bc * sc[64 + cc];
#pragma unroll
            for (int jj = 0; jj < 4; ++jj) { TB[(part + 8 * jj) * SS + cc] = f2bf(Tr[jj] * bc); TBE[(part + 8 * jj) * SS + cc] = f2bf(Tr[jj] * bec); }
        }
        __syncthreads();
        if (wid < 4) {
            acc1 = mm<32>(TB, SS, VT + (32 * wid) * SS, SS, l32, hi, f32x16{});
        } else {
            const int d0 = 32 * (wid - 4);
            const f32x16 wt = mm<32>(KT + d0 * SS, SS, TBE, SS, l32, hi, f32x16{});
#pragma unroll
            for (int g = 0; g < 4; ++g) *(uint2*)(W + l32 * SK + d0 + 8 * g + 4 * hi) = pk4(wt[4 * g], wt[4 * g + 1], wt[4 * g + 2], wt[4 * g + 3]);
        }
        __syncthreads();
        if (wid < 4) {
            const int e0 = 32 * wid;
            const f32x16 ws = mm<128>(W, SK, ST + e0 * SK, SK, l32, hi, f32x16{});
            float vn[16], vs[16];
#pragma unroll
            for (int r = 0; r < 16; ++r) { vn[r] = acc1[r] - ws[r]; vs[r] = vn[r] * sc[96 + crow(r, hi)]; }
#pragma unroll
            for (int g = 0; g < 4; ++g) { *(uint2*)(VN + (e0 + l32) * SS + 8 * g + 4 * hi) = pk4(vn[4 * g], vn[4 * g + 1], vn[4 * g + 2], vn[4 * g + 3]);
                                          *(uint2*)(VNS + (e0 + l32) * SS + 8 * g + 4 * hi) = pk4(vs[4 * g], vs[4 * g + 1], vs[4 * g + 2], vs[4 * g + 3]); }
        }
        __syncthreads();
        if (wid >= 4) {
            const int e0 = 32 * (wid - 4);
            acc1 = mm<32>(ATT, SS, VN + e0 * SS, SS, l32, hi, acc1);
#pragma unroll
            for (int r = 0; r < 16; ++r) O[TOK(c, crow(r, hi)) * 512 + h * 128 + e0 + l32] = acc1[r];
        }
        {
            const float eB = sc[128];
#pragma unroll
            for (int bi = 0; bi < 2; ++bi) {
                const int blk = wid * 2 + bi, d0 = 32 * (blk >> 2), e0 = 32 * (blk & 3);
#pragma unroll
                for (int r = 0; r < 16; ++r) S[bi][r] *= eB;
                S[bi] = mm<32>(KT + d0 * SS, SS, VNS + e0 * SS, SS, l32, hi, S[bi]);
            }
        }
        __syncthreads();
#pragma unroll
        for (int bi = 0; bi < 2; ++bi) {
            const int blk = wid * 2 + bi, d0 = 32 * (blk >> 2), e0 = 32 * (blk & 3);
#pragma unroll
            for (int g = 0; g < 4; ++g) *(uint2*)(ST + (e0 + l32) * SK + d0 + 8 * g + 4 * hi) = pk4(S[bi][4 * g], S[bi][4 * g + 1], S[bi][4 * g + 2], S[bi][4 * g + 3]);
        }
        if (c + 1 < nch) GSTAGE();
        __syncthreads();
    }
#undef GLOAD
#undef GSTAGE
#undef TOK
    if (ctx) {
#pragma unroll
        for (int bi = 0; bi < 2; ++bi) {
            const int blk = wid * 2 + bi, d0 = 32 * (blk >> 2), e0 = 32 * (blk & 3);
            float* so = p.out + O_SGDN + ((((size_t)b * DEPTH + l) * 2 + dir) * 4 + h) * 128 * 128 + e0 + l32;
#pragma unroll
            for (int r = 0; r < 16; ++r) so[(size_t)(d0 + crow(r, hi)) * 128] = S[bi][r];
        }
    }
}
}

namespace gla {
using att::bf16x8; using att::f32x16; using att::crow; using gdn::mm; using gdn::pk4;
constexpr int C = 32, SQ = 72, SS = 40;
constexpr int OFF_QE = 0, OFF_KN = OFF_QE + C * SQ * 2, OFF_KET = OFF_KN + C * SQ * 2, OFF_VT = OFF_KET + 64 * SS * 2, OFF_ATT = OFF_VT + 128 * SS * 2, OFF_ST = OFF_ATT + C * SS * 2,
              OFF_LA = OFF_ST + 128 * SQ * 2, OFF_EB = OFF_LA + C * 64 * 4, GLA_LDS = OFF_EB + 256;
__device__ __forceinline__ void gla_chunked(const Params& p, int l, bool ctx, int b, int h, int dir, unsigned char* lds) {
    const int tid = opaque_tid(), wid = tid >> 6, lane = tid & 63, l32 = lane & 31, hi = lane >> 5;
    const int T = ctx ? CT : ::LT; const size_t m0 = ctx ? (size_t)b * CT : (size_t)MC + (size_t)b * ::LT;
    const bf16_t* Z = WSP(bf16_t, WS_Z); const float* LA = WSP(float, dir ? WS_AB : WS_AF);
    float* O = WSP(float, dir ? WS_GOB : WS_GOF);
    bf16_t* Qe = (bf16_t*)(lds + OFF_QE); bf16_t* Kn = (bf16_t*)(lds + OFF_KN); bf16_t* KeT = (bf16_t*)(lds + OFF_KET); bf16_t* VT = (bf16_t*)(lds + OFF_VT);
    bf16_t* ATT = (bf16_t*)(lds + OFF_ATT); bf16_t* ST = (bf16_t*)(lds + OFF_ST); float* la = (float*)(lds + OFF_LA); float* eB = (float*)(lds + OFF_EB);
    const int nch = T / C;
#define TOK(c, s_) (m0 + (dir ? T - 1 - ((c) * C + (s_)) : (c) * C + (s_)))
    const int d0 = 32 * (wid >> 2), e0 = 32 * (wid & 3);
    f32x16 S;
    if (ctx) S = f32x16{};
    else {
        const float* s0 = p.in[I_SGLA] + ((((size_t)b * DEPTH + l) * 2 + dir) * 4 + h) * 64 * 128 + e0 + l32;
#pragma unroll
        for (int r = 0; r < 16; ++r) S[r] = s0[(size_t)(d0 + crow(r, hi)) * 128];
    }
    const int ts = tid >> 4, dc = (tid & 15) * 4, vs = tid >> 5, vc = (tid & 31) * 4;
    vf4 pq, pk, pl, pv0, pv1;
#define GLOAD(c) do { const size_t mt = TOK(c, ts), ma = TOK(c, vs), mb = TOK(c, vs + 16); \
        pq = ld4bf(Z + mt * NINP + Z_GLQ + h * 64 + dc); pk = ld4bf(Z + mt * NINP + Z_GLK + h * 64 + dc); pl = *(const vf4*)(LA + mt * 256 + h * 64 + dc); \
        pv0 = ld4bf(Z + ma * NINP + Z_GLV + h * 128 + vc); pv1 = ld4bf(Z + mb * NINP + Z_GLV + h * 128 + vc); } while (0)
#define WRITE_ST() do { _Pragma("unroll") for (int g = 0; g < 4; ++g) *(uint2*)(ST + (e0 + l32) * SQ + d0 + 8 * g + 4 * hi) = pk4(S[4 * g], S[4 * g + 1], S[4 * g + 2], S[4 * g + 3]); } while (0)
#define GIMAGES() do { vf4 pre = (vf4){0.f, 0.f, 0.f, 0.f}, tot = pre; \
        _Pragma("unroll 8") for (int t_ = 0; t_ < C; ++t_) { const vf4 v_ = *(const vf4*)(la + t_ * 64 + dc); tot += v_; if (t_ <= ts) pre += v_; } \
        float qe[4], kn[4]; \
        _Pragma("unroll") for (int j = 0; j < 4; ++j) { qe[j] = pq[j] * 0.125f * __expf(pre[j]); kn[j] = pk[j] * __expf(fminf(-pre[j], 80.f)); \
            KeT[(dc + j) * SS + ts] = f2bf(pk[j] * __expf(tot[j] - pre[j])); } \
        *(uint2*)(Qe + ts * SQ + dc) = pk4(qe[0], qe[1], qe[2], qe[3]); *(uint2*)(Kn + ts * SQ + dc) = pk4(kn[0], kn[1], kn[2], kn[3]); \
        if (ts == 0) { _Pragma("unroll") for (int j = 0; j < 4; ++j) eB[dc + j] = __expf(tot[j]); } \
        _Pragma("unroll") for (int j = 0; j < 4; ++j) { VT[(vc + j) * SS + vs] = f2bf(pv0[j]); VT[(vc + j) * SS + vs + 16] = f2bf(pv1[j]); } } while (0)
    __syncthreads();
    GLOAD(0);
    WRITE_ST();
    *(vf4*)(la + ts * 64 + dc) = pl;
    __syncthreads();
    GIMAGES();
    __syncthreads();
    for (int c = 0; c < nch; ++c) {
        if (c + 1 < nch) GLOAD(c + 1);
        f32x16 o1 = f32x16{};
        if (wid == 0) {
            const f32x16 kq = mm<64>(Kn, SQ, Qe, SQ, l32, hi, f32x16{});
            float a[16];
#pragma unroll
            for (int r = 0; r < 16; ++r) a[r] = (l32 >= crow(r, hi)) ? kq[r] : 0.f;
#pragma unroll
            for (int g = 0; g < 4; ++g) *(uint2*)(ATT + l32 * SS + 8 * g + 4 * hi) = pk4(a[4 * g], a[4 * g + 1], a[4 * g + 2], a[4 * g + 3]);
        } else if (wid >= 4) {
            o1 = mm<64>(Qe, SQ, ST + (32 * (wid - 4)) * SQ, SQ, l32, hi, f32x16{});
        }
        __syncthreads();
        if (wid >= 4) {
            const int eo = 32 * (wid - 4);
            o1 = mm<32>(ATT, SS, VT + eo * SS, SS, l32, hi, o1);
#pragma unroll
            for (int r = 0; r < 16; ++r) O[TOK(c, crow(r, hi)) * 512 + h * 128 + eo + l32] = o1[r];
        }
#pragma unroll
        for (int r = 0; r < 16; ++r) S[r] *= eB[d0 + crow(r, hi)];
        S = mm<32>(KeT + d0 * SS, SS, VT + e0 * SS, SS, l32, hi, S);
        __syncthreads();
        WRITE_ST();
        if (c + 1 < nch) *(vf4*)(la + ts * 64 + dc) = pl;
        __syncthreads();
        if (c + 1 < nch) GIMAGES();
        __syncthreads();
    }
#undef GLOAD
#undef WRITE_ST
#undef GIMAGES
#undef TOK
    if (ctx) {
        float* so = p.out + O_SGLA + ((((size_t)b * DEPTH + l) * 2 + dir) * 4 + h) * 64 * 128 + e0 + l32;
#pragma unroll
        for (int r = 0; r < 16; ++r) so[(size_t)(d0 + crow(r, hi)) * 128] = S[r];
    }
}
}
#define LAS __attribute__((address_space(3)))
constexpr int LDS_BYTES = 147456, XBW_OFF = LDS_BYTES - 64;
constexpr int NPH = 1 + DEPTH * 12;
#ifndef DBG_NLAYERS
#define DBG_NLAYERS DEPTH
#endif

#ifndef DUPKIND
#define DUPKIND 0
#endif
__device__ __forceinline__ int opaque_int(int v) { asm volatile("" : "+s"(v)); return v; }
#ifndef MIXMASK
#define MIXMASK 0xFF
#endif
#define FOR_ITEMS(it, n, o, w) for (int bo_ = (o) * (int)gridDim.x / 256, bw_ = ((w) * (int)gridDim.x / 256) > 0 ? ((w) * (int)gridDim.x / 256) : 1, \
                                    it = ((int)blockIdx.x >= bo_ && (int)blockIdx.x < bo_ + bw_) ? (int)blockIdx.x - bo_ : (n); it < (n); it += bw_)

#ifndef SPLITK
#define SPLITK 0
#endif
constexpr int FLAG_WORD0 = 8192;
constexpr int QCTR_WORD0 = 1024;
constexpr int NI_GDNL = LB * 8, NI_GLAL = LB * 8, NI_GDNC = CB * 8, NI_GQAL = LB * 16, NI_NAL = LB * 16, NI_GLAC = CB * 8, NI_NAC = CB * 4, NI_GQAC = CB * 4;
#define KM(k) (1 + ((DUPKIND >> (k)) & 1))
constexpr int Q0 = NI_GDNL * KM(0), Q1 = Q0 + NI_GLAL * KM(1), Q2 = Q1 + NI_GDNC * KM(2), Q3 = Q2 + NI_GQAL * KM(3), Q4 = Q3 + NI_NAL * KM(4), Q5 = Q4 + NI_GLAC * KM(5), Q6 = Q5 + NI_NAC * KM(6), Q7 = Q6 + NI_GQAC * KM(7);
__device__ __forceinline__ void phase_mix(const Params& p, int l, unsigned char* lds, int rep) {
    const int tid = opaque_tid();
    float* smem = (float*)lds;
    const bf16_t* NAQ = WSP(bf16_t, WS_NAQ); const bf16_t* NAK = WSP(bf16_t, WS_NAK); const bf16_t* NAV = WSP(bf16_t, WS_NAV);
    const bf16_t* GQ = WSP(bf16_t, WS_GQ); const bf16_t* GK = WSP(bf16_t, WS_GK); const bf16_t* GV = WSP(bf16_t, WS_GV);
    bf16_t* MRG = WSP(bf16_t, WS_MRG);
    unsigned* qctr = WSP(unsigned, WS_CTL) + QCTR_WORD0 + 64 * l + 16 * rep;
    volatile int* qslot = (volatile int*)(lds + XBW_OFF + 16);
    for (;;) {
        __syncthreads();
        if (tid == 0) *qslot = (int)__hip_atomic_fetch_add(qctr, 1u, __ATOMIC_RELAXED, __HIP_MEMORY_SCOPE_AGENT);
        __syncthreads();
        const int q = __builtin_amdgcn_readfirstlane(*qslot);
        if (q >= Q7) break;
        if (q < Q0) { const int it = q % NI_GDNL; gdn::gdn_chunked(p, l, false, it / 8, (it / 2) % 4, it % 2, lds); }
        else if (q < Q1) { const int it = (q - Q0) % NI_GLAL; gla::gla_chunked(p, l, false, it / 8, (it / 2) % 4, it % 2, lds); }
        else if (q < Q2) { const int it = (q - Q1) % NI_GDNC; gdn::gdn_chunked(p, l, true, it / 8, (it / 2) % 4, it % 2, lds); }
        else if (q < Q3) {
            const int it = (q - Q2) % NI_GQAL, b = it / 16, qh = (it / 4) % 4, qb = it % 4, kvh = qh >> 1;
            const size_t r0 = (size_t)MC + (size_t)b * LT;
            att::SrcTwo src{WSP(bf16_t, WS_CGK) + ((size_t)b * DEPTH + l) * 256 * 256 + kvh * 128, WSP(bf16_t, WS_CGV) + ((size_t)b * DEPTH + l) * 256 * 256 + kvh * 128,
                            GK + r0 * 256 + kvh * 128, GV + r0 * 256 + kvh * 128, 256};
            att::attn_body<2>(GQ + (r0 + qb * 256) * 512 + qh * 128, src, MRG + (r0 + qb * 256) * DM + 1024 + qh * 128, 4 + LT / 64, (char*)lds, att::NoBias{});
        }
        else if (q < Q4) {
            const int it = (q - Q3) % NI_NAL, b = it / 16, h = (it / 4) % 4, qb = it % 4;
            const int kr0 = qb == 0 ? 0 : qb == 1 ? 0 : qb == 2 ? 4 : 8, nrows = (qb == 0 || qb == 3) ? 8 : 12;
            const size_t r0 = (size_t)MC + (size_t)b * LT;
            float* tab = (float*)(lds + att::SHM_ATTN);
            if (tid < 15 * 31) tab[tid] = p.in[I_RPB][((size_t)l * 4 + h) * 15 * 31 + tid] * (1.0f / att::SCALE);
            att::SrcTwo src{WSP(bf16_t, WS_CNAK) + ((size_t)b * DEPTH + l) * 256 * 512 + h * 128, WSP(bf16_t, WS_CNAV) + ((size_t)b * DEPTH + l) * 256 * 512 + h * 128,
                            NAK + (r0 + kr0 * 64) * 512 + h * 128, NAV + (r0 + kr0 * 64) * 512 + h * 128, 512};
            att::attn_body<1>(NAQ + (r0 + qb * 256) * 512 + h * 128, src, MRG + (r0 + qb * 256) * DM + 0 + h * 128, 4 + nrows, (char*)lds, att::NaBias{tab, qb * 256, kr0});
        }
        else if (q < Q5) { const int it = (q - Q4) % NI_GLAC; gla::gla_chunked(p, l, true, it / 8, (it / 2) % 4, it % 2, lds); }
        else if (q < Q6) {
            const int it = (q - Q5) % NI_NAC, b = it / 4, h = it % 4; const size_t r0 = (size_t)b * CT;
            att::SrcOne src{NAK + r0 * 512 + h * 128, NAV + r0 * 512 + h * 128, 512};
            att::attn_body<2>(NAQ + r0 * 512 + h * 128, src, MRG + r0 * DM + 0 + h * 128, CT / 64, (char*)lds, att::NoBias{});
        }
        else {
            const int it = (q - Q6) % NI_GQAC, b = it / 4, qh = it % 4, kvh = qh >> 1; const size_t r0 = (size_t)b * CT;
            att::SrcOne src{GK + r0 * 256 + kvh * 128, GV + r0 * 256 + kvh * 128, 256};
            att::attn_body<2>(GQ + r0 * 512 + qh * 128, src, MRG + r0 * DM + 1024 + qh * 128, CT / 64, (char*)lds, att::NoBias{});
        }
    }
}

static_assert(att::SHM_ATTN + 15 * 31 * 4 + 2048 <= (size_t)XBW_OFF, "LDS map");
static_assert((QCTR_WORD0 + 64 * DEPTH) < 4096, "ctl");
constexpr int BAR_WORD0 = 4096;
static_assert((BAR_WORD0 + XCD_BAR_WORDS) * 4 <= (int)CTL_BYTES, "ctl");

__global__ void __launch_bounds__(512, 2) fwd(Params p) {
    extern __shared__ __attribute__((aligned(16))) unsigned char lds[];
    const int tid = threadIdx.x;
    volatile LAS unsigned* xbw = (volatile LAS unsigned*)((LAS unsigned char*)lds + XBW_OFF);
    if (tid < 4) xbw[tid] = 0u;
    __syncthreads();
    XcdBarrier bar; bar.bar = WSP(unsigned, WS_CTL) + BAR_WORD0; bar.x = 0; bar.st = xbw;
    if (p.ph_hi - p.ph_lo > 1) bar = xcd_barrier_post(WSP(unsigned, WS_CTL) + BAR_WORD0, xbw);
#ifndef PHMASK
#define PHMASK 0x1FFF
#endif
#define IN(k) (p.ph_lo <= (k) && (k) < p.ph_hi)
#define INL(j) (((PHMASK >> ((j) + 1)) & 1) && IN(pb + (j)))
#ifndef DUPMASK
#define DUPMASK 0
#endif
#define DUP(j) ((DUPMASK >> ((j) + 1)) & 1)
#define SEAM(k) do { if (IN(k) && IN((k) + 1)) xcd_barrier(bar); } while (0)
    LAS unsigned char* ldsl = (LAS unsigned char*)lds;
    bf16_t* H = WSP(bf16_t, WS_H); bf16_t* ACT = WSP(bf16_t, WS_ACT); float* X = WSP(float, WS_X); float* Z = WSP(float, WS_Z); bf16_t* MRG = WSP(bf16_t, WS_MRG);

    if ((PHMASK & 1) && IN(0)) { int reps_ = 1 + (DUPMASK & 1); asm volatile("" : "+s"(reps_)); for (int rep_ = 0; rep_ < reps_; ++rep_) { const Params q = opaque_params(p); phase_prologue(q, (float*)lds); __syncthreads(); } }
    SEAM(0);
    for (int l = 0; l < DBG_NLAYERS; ++l) {
        const int pb = 1 + l * 12;
        const float* modl = WSP(float, WS_MODV) + (size_t)l * NCOND * NMOD;
        if (INL(0)) { int reps_ = 1 + DUP(0); asm volatile("" : "+s"(reps_)); for (int rep_ = 0; rep_ < reps_; ++rep_) { const Params q = opaque_params(p); phase_norm(q, l, 0); __syncthreads(); } }
        SEAM(pb + 0);
        if (INL(1)) {
            pg8::Gemm g{H, WSP(bf16_t, WS_WGU) + ((size_t)l * 2 + 0) * NGU * DM, M, NGU, DM}; pg8::StaticOrder S; S.init(M, NGU, DM, (int)gridDim.x, (int)blockIdx.x);
            pg8::EpiSwiGLU E{ACT, FF};
            for (int r_ = 0, n_ = opaque_int(1 + DUP(1)); r_ < n_; ++r_) pg8::gemm_phase<pg8::EpiSwiGLU, pg8::StaticOrder, false>(ldsl, g, S, E, nullptr);
        }
        SEAM(pb + 1);
        if (INL(2)) {
            pg8::Gemm g{ACT, WSP(bf16_t, WS_WDN) + ((size_t)l * 2 + 0) * DM * FF, M, DM, FF}; pg8::StaticOrder S; S.init(M, DM, FF, (int)gridDim.x, (int)blockIdx.x, SPLITK);
            pg8::EpiResid E{X, X, DM, modl + 2 * DM, 0.5f, Z, WSP(unsigned, WS_CTL) + FLAG_WORD0, 8u * (unsigned)(l * 3 + 1)};
            pg8::gemm_phase<pg8::EpiResid, pg8::StaticOrder, false>(ldsl, g, S, E, nullptr);
#if CONV_FILLER
            if (l + 1 < DBG_NLAYERS) {
                const int nw_ = (M / 256) * (DM / 256), G_ = (int)gridDim.x; int f0_ = nw_ - G_; if (f0_ < 0 || f0_ >= G_) f0_ = 0;
                if ((int)blockIdx.x >= f0_) { const Params q = opaque_params(p); conv_layer_tiles(q, l + 1, 0, (NT_L * 2 / 5), (int)blockIdx.x - f0_, G_ - f0_, (float*)lds); }
            }
#endif
            if (opaque_int(DUP(2))) { pg8::EpiResid E2{X, Z, DM, modl + 2 * DM, 0.5f, Z, WSP(unsigned, WS_CTL) + FLAG_WORD0, 0u}; pg8::gemm_phase<pg8::EpiResid, pg8::StaticOrder, false>(ldsl, g, S, E2, nullptr); }
        }
        SEAM(pb + 2);
        if (INL(3)) { int reps_ = 1 + DUP(3); asm volatile("" : "+s"(reps_)); for (int rep_ = 0; rep_ < reps_; ++rep_) { const Params q = opaque_params(p); phase_norm(q, l, 1); __syncthreads(); } }
        SEAM(pb + 3);
        if (INL(4)) {
            pg8::Gemm g{H, WSP(bf16_t, WS_WIN) + (size_t)l * NINP * DM, M, NINP, DM}; pg8::StaticOrder S; S.init(M, NINP, DM, (int)gridDim.x, (int)blockIdx.x);
            pg8::EpiBf16Plain E{WSP(bf16_t, WS_Z), NINP};
            for (int r_ = 0, n_ = opaque_int(1 + DUP(4)); r_ < n_; ++r_) pg8::gemm_phase<pg8::EpiBf16Plain, pg8::StaticOrder, false>(ldsl, g, S, E, nullptr);
        }
        SEAM(pb + 4);
        if (INL(5)) { int reps_ = 1 + DUP(5); asm volatile("" : "+s"(reps_)); for (int rep_ = 0; rep_ < reps_; ++rep_) { const Params q = opaque_params(p); phase_prep(q, l); __syncthreads(); } }
        SEAM(pb + 5);
        if (INL(6)) { int reps_ = 1 + DUP(6); asm volatile("" : "+s"(reps_)); for (int rep_ = 0; rep_ < reps_; ++rep_) { const Params q = opaque_params(p); phase_mix(q, l, lds, rep_); __syncthreads(); } }
        SEAM(pb + 6);
        if (INL(7)) { int reps_ = 1 + DUP(7); asm volatile("" : "+s"(reps_)); for (int rep_ = 0; rep_ < reps_; ++rep_) { const Params q = opaque_params(p); phase_post(q, l); __syncthreads(); } }
        SEAM(pb + 7);
        if (INL(8)) {
            pg8::Gemm g{MRG, WSP(bf16_t, WS_WOUT) + (size_t)l * DM * DM, M, DM, DM}; pg8::StaticOrder S; S.init(M, DM, DM, (int)gridDim.x, (int)blockIdx.x, SPLITK);
            pg8::EpiResid E{X, X, DM, modl + 5 * DM, 1.0f, Z, WSP(unsigned, WS_CTL) + FLAG_WORD0, 8u * (unsigned)(l * 3 + 2)};
            pg8::gemm_phase<pg8::EpiResid, pg8::StaticOrder, false>(ldsl, g, S, E, nullptr);
#if CONV_FILLER
            if (l + 1 < DBG_NLAYERS) {
                const int nw_ = (M / 256) * (DM / 256), G_ = (int)gridDim.x; int f0_ = nw_ - G_; if (f0_ < 0 || f0_ >= G_) f0_ = 0;
                if ((int)blockIdx.x >= f0_) { const Params q = opaque_params(p); conv_layer_tiles(q, l + 1, (NT_L * 2 / 5), (NT_L * 3 / 5), (int)blockIdx.x - f0_, G_ - f0_, (float*)lds); }
            }
#endif
            if (opaque_int(DUP(8))) { pg8::EpiResid E2{X, Z, DM, modl + 5 * DM, 1.0f, Z, WSP(unsigned, WS_CTL) + FLAG_WORD0, 0u}; pg8::gemm_phase<pg8::EpiResid, pg8::StaticOrder, false>(ldsl, g, S, E2, nullptr); }
        }
        SEAM(pb + 8);
        if (INL(9)) { int reps_ = 1 + DUP(9); asm volatile("" : "+s"(reps_)); for (int rep_ = 0; rep_ < reps_; ++rep_) { const Params q = opaque_params(p); phase_norm(q, l, 2); __syncthreads(); } }
        SEAM(pb + 9);
        if (INL(10)) {
            pg8::Gemm g{H, WSP(bf16_t, WS_WGU) + ((size_t)l * 2 + 1) * NGU * DM, M, NGU, DM}; pg8::StaticOrder S; S.init(M, NGU, DM, (int)gridDim.x, (int)blockIdx.x);
            pg8::EpiSwiGLU E{ACT, FF};
            pg8::gemm_phase<pg8::EpiSwiGLU, pg8::StaticOrder, false>(ldsl, g, S, E, nullptr);
        }
        SEAM(pb + 10);
        if (INL(11)) {
            pg8::Gemm g{ACT, WSP(bf16_t, WS_WDN) + ((size_t)l * 2 + 1) * DM * FF, M, DM, FF}; pg8::StaticOrder S; S.init(M, DM, FF, (int)gridDim.x, (int)blockIdx.x, SPLITK);
            pg8::EpiResid E{X, (l == DEPTH - 1) ? p.out : X, DM, modl + 8 * DM, 0.5f, Z, WSP(unsigned, WS_CTL) + FLAG_WORD0, 8u * (unsigned)(l * 3 + 3)};
            pg8::gemm_phase<pg8::EpiResid, pg8::StaticOrder, false>(ldsl, g, S, E, nullptr);
#if CONV_FILLER
            if (l + 1 < DBG_NLAYERS) {
                const int nw_ = (M / 256) * (DM / 256), G_ = (int)gridDim.x; int f0_ = nw_ - G_; if (f0_ < 0 || f0_ >= G_) f0_ = 0;
                if ((int)blockIdx.x >= f0_) { const Params q = opaque_params(p); conv_layer_tiles(q, l + 1, (NT_L * 3 / 5), NT_L, (int)blockIdx.x - f0_, G_ - f0_, (float*)lds); }
            }
#endif
        }
        SEAM(pb + 11);
    }
#undef IN
#undef SEAM
}

#ifndef MULTI_LAUNCH
#define MULTI_LAUNCH 0
#endif
extern "C" void kernel_launch(void* const* d_in, const int* in_sizes, int n_in, void* d_out, int out_size, void* d_ws, size_t ws_size, hipStream_t stream) {
    static int grid = 0;
    if (grid == 0) {
        if (n_in != N_IN || (size_t)out_size != O_END || ws_size < WS_END) { fprintf(stderr, "kernel_launch: shape mismatch n_in %d out %d ws %zu (need %zu)\n", n_in, out_size, ws_size, (size_t)WS_END); grid = -1; return; }
        int dev = 0, cus = 0, per_cu = 0;
        if (hipGetDevice(&dev) != hipSuccess || hipDeviceGetAttribute(&cus, hipDeviceAttributeMultiprocessorCount, dev) != hipSuccess) { grid = -1; return; }
        if (hipFuncSetAttribute((const void*)fwd, hipFuncAttributeMaxDynamicSharedMemorySize, LDS_BYTES) != hipSuccess) { fprintf(stderr, "kernel_launch: hipFuncSetAttribute failed\n"); grid = -1; return; }
        if (hipOccupancyMaxActiveBlocksPerMultiprocessor(&per_cu, (const void*)fwd, 512, LDS_BYTES) != hipSuccess || per_cu < 1) { fprintf(stderr, "kernel_launch: occupancy query says %d\n", per_cu); (void)hipGetLastError(); }
        grid = cus;
    }
    if (grid < 0) return;
    (void)hipMemsetAsync((char*)d_ws + WS_CTL, 0, CTL_BYTES, stream);
    Params p{};
    for (int i = 0; i < N_IN; ++i) p.in[i] = (const float*)d_in[i];
    p.out = (float*)d_out; p.ws = (unsigned char*)d_ws;
#if MULTI_LAUNCH
    for (int ph = 0; ph < 1 + DBG_NLAYERS * 12; ++ph) { p.ph_lo = ph; p.ph_hi = ph + 1; hipLaunchKernelGGL(fwd, dim3(grid), dim3(512), LDS_BYTES, stream, p); }
#else
    p.ph_lo = 0; p.ph_hi = NPH; hipLaunchKernelGGL(fwd, dim3(grid), dim3(512), LDS_BYTES, stream, p);
#endif
    const hipError_t le = hipPeekAtLastError();
    if (le != hipSuccess) fprintf(stderr, "kernel_launch: launch failed: %s\n", hipGetErrorName(le));
}
```

```cpp
#include <hip/hip_runtime.h>
#include <cstdio>
#include <cstdint>

#ifndef CB_
#define CB_ 16
#endif
#ifndef LB_
#define LB_ 8
#endif
#ifndef DEPTH_
#define DEPTH_ 4
#endif
constexpr int DM = 2048, DEPTH = DEPTH_, CB = CB_, CT = 256, LB = LB_, LT = 1024;
constexpr int MC = CB * CT, ML = LB * LT, M = MC + ML;
constexpr int FF = 5504, NGU = 2 * FF, NIN = 6192, NINP = 6400, NMOD = 9 * DM, NCOND = 1 + LB;
constexpr float EPS = 1e-6f;
constexpr int Z_NAQ = 0, Z_NAK = 512, Z_NAV = 1024, Z_GLQ = 1536, Z_GLK = 1792, Z_GLV = 2048, Z_GLR = 2560, Z_GF = 3072, Z_GB = 3088,
              Z_GQQ = 3104, Z_GQK = 3616, Z_GQV = 3872, Z_DQKV = 4128, Z_DZ = 5664, Z_DB = 6176, Z_DA = 6184;
static_assert(Z_DA + 8 == NIN, "split");
enum { I_XP = 0, I_XS, I_CNAK, I_CNAV, I_CGK, I_CGV, I_SGLA, I_SGDN, I_C, I_CCTX, I_NORMG, I_WMOD, I_BMOD, I_GU, I_DOWN, I_WIN, I_WOUT, I_NAQKN, I_RPB,
       I_GUP, I_GBIAS, I_GLAON, I_GQAQKN, I_CONV, I_ALOG, I_DTB, I_GDNON, N_IN };
constexpr size_t O_YP = 0, O_YS = O_YP + (size_t)MC * DM, O_NAK = O_YS + (size_t)ML * DM, O_NAV = O_NAK + (size_t)CB * DEPTH * 4 * CT * 128,
                 O_GK = O_NAV + (size_t)CB * DEPTH * 4 * CT * 128, O_GV = O_GK + (size_t)CB * DEPTH * 2 * CT * 128,
                 O_SGLA = O_GV + (size_t)CB * DEPTH * 2 * CT * 128, O_SGDN = O_SGLA + (size_t)CB * DEPTH * 2 * 4 * 64 * 128,
                 O_END = O_SGDN + (size_t)CB * DEPTH * 2 * 4 * 128 * 128;
constexpr size_t al256(size_t x) { return (x + 255) & ~(size_t)255; }
constexpr size_t WS_CTL = 0, CTL_BYTES = 1u << 20;
constexpr size_t WS_WGU = CTL_BYTES;
constexpr size_t WS_WDN = WS_WGU + (size_t)DEPTH * 2 * NGU * DM * 2;
constexpr size_t WS_WIN = WS_WDN + (size_t)DEPTH * 2 * DM * FF * 2;
constexpr size_t WS_WOUT = WS_WIN + (size_t)DEPTH * NINP * DM * 2;
constexpr size_t WS_MODV = WS_WOUT + (size_t)DEPTH * DM * DM * 2;
constexpr size_t WS_ROPE = al256(WS_MODV + (size_t)DEPTH * NCOND * NMOD * 4);
constexpr size_t WS_X = al256(WS_ROPE + 2 * 64 * 32 * 4);
constexpr size_t WS_H = WS_X + (size_t)M * DM * 4;
constexpr size_t WS_ACT = WS_H + (size_t)M * DM * 2;
constexpr size_t WS_Z = WS_ACT + (size_t)M * FF * 2;
constexpr size_t WS_MRG = WS_Z + (size_t)M * NINP * 4;
constexpr size_t WS_NAQ = WS_MRG + (size_t)M * DM * 2;
constexpr size_t WS_NAK = WS_NAQ + (size_t)M * 512 * 2;
constexpr size_t WS_NAV = WS_NAK + (size_t)M * 512 * 2;
constexpr size_t WS_GQ = WS_NAV + (size_t)M * 512 * 2;
constexpr size_t WS_GK = WS_GQ + (size_t)M * 512 * 2;
constexpr size_t WS_GV = WS_GK + (size_t)M * 256 * 2;
constexpr size_t WS_CNAK = WS_GV + (size_t)M * 256 * 2;
constexpr size_t WS_CNAV = WS_CNAK + (size_t)LB * DEPTH * 256 * 512 * 2;
constexpr size_t WS_CGK = WS_CNAV + (size_t)LB * DEPTH * 256 * 512 * 2;
constexpr size_t WS_CGV = WS_CGK + (size_t)LB * DEPTH * 256 * 256 * 2;
constexpr size_t WS_AF = WS_CGV + (size_t)LB * DEPTH * 256 * 256 * 2;
constexpr size_t WS_AB = WS_AF + (size_t)M * 256 * 4;
constexpr size_t WS_DQ = WS_AB + (size_t)M * 256 * 4;
constexpr size_t WS_DK = WS_DQ + (size_t)M * 512 * 4;
constexpr size_t WS_DV = WS_DK + (size_t)M * 512 * 4;
constexpr size_t WS_DBA = WS_DV + (size_t)M * 512 * 4;
constexpr size_t WS_GOF = WS_DBA + (size_t)M * 16 * 4;
constexpr size_t WS_GOB = WS_GOF + (size_t)M * 512 * 4;
constexpr size_t WS_DOF = WS_GOB + (size_t)M * 512 * 4;
constexpr size_t WS_DOB = WS_DOF + (size_t)M * 512 * 4;
constexpr size_t WS_END = WS_DOB + (size_t)M * 512 * 4;

typedef unsigned short bf16_t;
struct Params { const float* in[N_IN]; float* out; unsigned char* ws; int ph_lo, ph_hi; };
static_assert(sizeof(Params) == N_IN * 8 + 8 + 8 + 8, "no padding");

#define WSP(T, off) ((T*)(p.ws + (off)))
__device__ __forceinline__ int opaque_tid() { int t = (int)threadIdx.x; asm volatile("" : "+v"(t)); return t; }
__device__ __forceinline__ Params opaque_params(const Params& p) { Params q = p; unsigned long long w = (unsigned long long)q.ws; asm volatile("" : "+s"(w)); q.ws = (unsigned char*)w; return q; }

typedef float vf4 __attribute__((ext_vector_type(4)));
__device__ __forceinline__ float bf2f(unsigned short v) { return __uint_as_float((unsigned)v << 16); }
__device__ __forceinline__ vf4 ld4bf(const unsigned short* p) { const uint2 w = *(const uint2*)p; vf4 r; r.x = __uint_as_float(w.x << 16); r.y = __uint_as_float(w.x & 0xFFFF0000u); r.z = __uint_as_float(w.y << 16); r.w = __uint_as_float(w.y & 0xFFFF0000u); return r; }
__device__ __forceinline__ void ld8bf(const unsigned short* p, vf4& a, vf4& b) { const uint4 w = *(const uint4*)p;
    a.x = __uint_as_float(w.x << 16); a.y = __uint_as_float(w.x & 0xFFFF0000u); a.z = __uint_as_float(w.y << 16); a.w = __uint_as_float(w.y & 0xFFFF0000u);
    b.x = __uint_as_float(w.z << 16); b.y = __uint_as_float(w.z & 0xFFFF0000u); b.z = __uint_as_float(w.w << 16); b.w = __uint_as_float(w.w & 0xFFFF0000u); }
__device__ __forceinline__ float wave_sum(float v) {
#pragma unroll
    for (int o = 32; o >= 1; o >>= 1) v += __shfl_xor(v, o);
    return v;
}
__device__ __forceinline__ bf16_t f2bf(float f) { unsigned u = __float_as_uint(f); u += 0x7FFFu + ((u >> 16) & 1u); return (bf16_t)(u >> 16); }
__device__ __forceinline__ unsigned pack2(float a, float b) { return (unsigned)f2bf(a) | ((unsigned)f2bf(b) << 16); }
__device__ __forceinline__ float silu_f(float x) { return x / (1.f + expf(-x)); }
__device__ __forceinline__ float softplus_f(float x) { return fmaxf(x, 0.f) + log1pf(expf(-fabsf(x))); }
__device__ __forceinline__ float logsigmoid_f(float x) { return fminf(x, 0.f) - log1pf(expf(-fabsf(x))); }
__device__ __forceinline__ int cond_of_row(int m) { return m < MC ? 0 : 1 + (m - MC) / LT; }
#ifndef CONV_FILLER
#define CONV_FILLER 1
#endif
__device__ __forceinline__ void conv_tile(const float* __restrict__ src, int ld_src, int ncols_src, int k0, int c0, bf16_t* __restrict__ dst, int ld_dst, int n0, float* tile) {
    const int tid = opaque_tid();
    {
        const int r = tid >> 3, c = (tid & 7) * 8;
        float4 a = make_float4(0.f, 0.f, 0.f, 0.f), b = a;
        if (c0 + c + 8 <= ncols_src) {
            const float* s = src + (size_t)(k0 + r) * ld_src + c0 + c;
            a = *(const float4*)s; b = *(const float4*)(s + 4);
        }
        float* t = tile + r * 65 + c;
        t[0] = a.x; t[1] = a.y; t[2] = a.z; t[3] = a.w; t[4] = b.x; t[5] = b.y; t[6] = b.z; t[7] = b.w;
    }
    __syncthreads();
    {
        const int n = tid >> 3, ks = (tid & 7) * 8;
        const float* t = tile + ks * 65 + n;
        uint4 w;
        w.x = pack2(t[0 * 65], t[1 * 65]); w.y = pack2(t[2 * 65], t[3 * 65]); w.z = pack2(t[4 * 65], t[5 * 65]); w.w = pack2(t[6 * 65], t[7 * 65]);
        *(uint4*)(dst + (size_t)(n0 + n) * ld_dst + k0 + ks) = w;
    }
    __syncthreads();
}

constexpr int MOD_ITEMS = DEPTH * (NMOD / 128);
constexpr int TGU_KT = DM / 64, TGU_NT = NGU / 64, TDN_KT = FF / 64, TDN_NT = DM / 64, TIN_KT = DM / 64, TIN_NT = NINP / 64, TOUT_KT = DM / 64, TOUT_NT = DM / 64;
constexpr int TL_GU = 2 * TGU_KT * TGU_NT, TL_DN = 2 * TDN_KT * TDN_NT, TL_IN = TIN_KT * TIN_NT, TL_OUT = TOUT_KT * TOUT_NT, NT_L = TL_GU + TL_DN + TL_IN + TL_OUT;
__device__ __forceinline__ void conv_layer_tiles(const Params& p, int l, int t_begin, int t_end, int first, int stride, float* s_tile) {
    for (int it = t_begin + first; it < t_end; it += stride) {
        if (it < TL_GU) {
            const int mat = l * 2 + it / (TGU_KT * TGU_NT), r = it % (TGU_KT * TGU_NT), kt = r / TGU_NT, nt = r % TGU_NT;
            const int n0 = nt * 64, t256 = n0 / 256, c = n0 % 256;
            const int c0 = c < 128 ? 128 * t256 + c : FF + 128 * t256 + (c - 128);
            conv_tile(p.in[I_GU] + (size_t)mat * DM * NGU, NGU, NGU, kt * 64, c0, WSP(bf16_t, WS_WGU) + (size_t)mat * NGU * DM, DM, n0, s_tile);
        } else if (it < TL_GU + TL_DN) {
            const int i2 = it - TL_GU, mat = l * 2 + i2 / (TDN_KT * TDN_NT), r = i2 % (TDN_KT * TDN_NT), kt = r / TDN_NT, nt = r % TDN_NT;
            conv_tile(p.in[I_DOWN] + (size_t)mat * FF * DM, DM, DM, kt * 64, nt * 64, WSP(bf16_t, WS_WDN) + (size_t)mat * DM * FF, FF, nt * 64, s_tile);
        } else if (it < TL_GU + TL_DN + TL_IN) {
            const int i2 = it - TL_GU - TL_DN, kt = i2 / TIN_NT, nt = i2 % TIN_NT;
            conv_tile(p.in[I_WIN] + (size_t)l * DM * NIN, NIN, NIN, kt * 64, nt * 64, WSP(bf16_t, WS_WIN) + (size_t)l * NINP * DM, DM, nt * 64, s_tile);
        } else {
            const int i2 = it - TL_GU - TL_DN - TL_IN, kt = i2 / TOUT_NT, nt = i2 % TOUT_NT;
            conv_tile(p.in[I_WOUT] + (size_t)l * DM * DM, DM, DM, kt * 64, nt * 64, WSP(bf16_t, WS_WOUT) + (size_t)l * DM * DM, DM, nt * 64, s_tile);
        }
    }
}

__device__ __forceinline__ void mod_layer(const Params& p, int l, int first, int stride, float* smem) {
    const int tid = opaque_tid();
    float* s_cond = smem;
    float* s_red = s_cond + NCOND * DM;
    __syncthreads();
    for (int i = tid; i < NCOND * DM; i += 512) { const int ci = i / DM, k = i % DM; const float v = ci == 0 ? p.in[I_CCTX][k] : p.in[I_C][(size_t)(ci - 1) * DM + k]; s_cond[i] = silu_f(v); }
    __syncthreads();
    float* modv = WSP(float, WS_MODV);
    for (int jt = first; jt < NMOD / 128; jt += stride) {
        const int cl = tid & 127, kq = tid >> 7, col = jt * 128 + cl;
        const float* w = p.in[I_WMOD] + (size_t)l * DM * NMOD + col;
        float acc[NCOND];
#pragma unroll
        for (int ci = 0; ci < NCOND; ++ci) acc[ci] = 0.f;
        for (int k = kq * 512; k < kq * 512 + 512; k += 8) {
            float wv[8];
#pragma unroll
            for (int j = 0; j < 8; ++j) wv[j] = w[(size_t)(k + j) * NMOD];
#pragma unroll
            for (int ci = 0; ci < NCOND; ++ci) {
                const float4 s0 = *(const float4*)&s_cond[ci * DM + k], s1 = *(const float4*)&s_cond[ci * DM + k + 4];
                acc[ci] += s0.x * wv[0] + s0.y * wv[1] + s0.z * wv[2] + s0.w * wv[3] + s1.x * wv[4] + s1.y * wv[5] + s1.z * wv[6] + s1.w * wv[7];
            }
        }
        if (kq > 0) {
#pragma unroll
            for (int ci = 0; ci < NCOND; ++ci) s_red[((kq - 1) * 128 + cl) * NCOND + ci] = acc[ci];
        }
        __syncthreads();
        if (kq == 0) {
            const float bm = p.in[I_BMOD][(size_t)l * NMOD + col];
#pragma unroll
            for (int ci = 0; ci < NCOND; ++ci)
                modv[((size_t)l * NCOND + ci) * NMOD + col] = acc[ci] + s_red[(0 * 128 + cl) * NCOND + ci] + s_red[(1 * 128 + cl) * NCOND + ci] + s_red[(2 * 128 + cl) * NCOND + ci] + bm;
        }
        __syncthreads();
    }
}

__device__ __forceinline__ void phase_prologue(const Params& p, float* smem) {
    const int tid = threadIdx.x, nb = gridDim.x, bid = blockIdx.x;
    float* s_tile = smem + NCOND * DM + 3 * 128 * NCOND;
#if CONV_FILLER
    mod_layer(p, 0, bid, nb, smem);
#else
    for (int l2 = 0; l2 < DEPTH; ++l2) mod_layer(p, l2, bid, nb, smem);
#endif
    conv_layer_tiles(p, 0, 0, NT_L, bid, nb, s_tile);
#if !CONV_FILLER
    for (int l2 = 1; l2 < DEPTH; ++l2) conv_layer_tiles(p, l2, 0, NT_L, bid, nb, s_tile);
#endif
    const size_t gtid = (size_t)bid * 512 + tid, gstride = (size_t)nb * 512;
    {
        float4* X = WSP(float4, WS_X);
        const float4* xp = (const float4*)p.in[I_XP]; const float4* xs = (const float4*)p.in[I_XS];
        const size_t nc = (size_t)MC * DM / 4, n = (size_t)M * DM / 4;
        for (size_t i = gtid; i < n; i += gstride) X[i] = i < nc ? xp[i] : xs[i - nc];
    }
    {
        const size_t n_na = (size_t)LB * DEPTH * 256 * 512 / 8;
        for (size_t i = gtid; i < 2 * n_na; i += gstride) {
            const bool isv = i >= n_na; const size_t j = isv ? i - n_na : i;
            const int d8 = (int)(j % 16), h = (int)((j / 16) % 4), t = (int)((j / 64) % 256); const size_t bl = j / (64 * 256);
            const float* s = p.in[isv ? I_CNAV : I_CNAK] + ((bl * 4 + h) * 256 + t) * 128 + d8 * 8;
            const float4 a = *(const float4*)s, b = *(const float4*)(s + 4);
            uint4 w; w.x = pack2(a.x, a.y); w.y = pack2(a.z, a.w); w.z = pack2(b.x, b.y); w.w = pack2(b.z, b.w);
            *(uint4*)(WSP(bf16_t, isv ? WS_CNAV : WS_CNAK) + (bl * 256 + t) * 512 + h * 128 + d8 * 8) = w;
        }
        const size_t n_g = (size_t)LB * DEPTH * 256 * 256 / 8;
        for (size_t i = gtid; i < 2 * n_g; i += gstride) {
            const bool isv = i >= n_g; const size_t j = isv ? i - n_g : i;
            const int d8 = (int)(j % 16), h = (int)((j / 16) % 2), t = (int)((j / 32) % 256); const size_t bl = j / (32 * 256);
            const float* s = p.in[isv ? I_CGV : I_CGK] + ((bl * 2 + h) * 256 + t) * 128 + d8 * 8;
            const float4 a = *(const float4*)s, b = *(const float4*)(s + 4);
            uint4 w; w.x = pack2(a.x, a.y); w.y = pack2(a.z, a.w); w.z = pack2(b.x, b.y); w.w = pack2(b.z, b.w);
            *(uint4*)(WSP(bf16_t, isv ? WS_CGV : WS_CGK) + (bl * 256 + t) * 256 + h * 128 + d8 * 8) = w;
        }
    }
    for (size_t i = gtid; i < 64 * 32; i += gstride) {
        const int pos = (int)(i / 32), k = (int)(i % 32);
        const float inv = powf(10000.0f, -(float)(2 * k) / 64.0f);
        const float ang = (float)pos * inv;
        WSP(float, WS_ROPE)[i] = cosf(ang); WSP(float, WS_ROPE)[64 * 32 + i] = sinf(ang);
    }
}

__device__ __forceinline__ void phase_norm(const Params& p, int l, int which  ) {
    const int tid = opaque_tid(), lane = tid & 63, wv = tid >> 6;
    const float* X = WSP(float, WS_X); bf16_t* H = WSP(bf16_t, WS_H);
    const float* g = p.in[I_NORMG] + ((size_t)l * 3 + which) * DM;
    for (int m = blockIdx.x * 8 + wv; m < M; m += gridDim.x * 8) {
        const int ci = cond_of_row(m);
        const float* mv = WSP(float, WS_MODV) + ((size_t)l * NCOND + ci) * NMOD + (size_t)which * 3 * DM;
        const float* x = X + (size_t)m * DM;
        vf4 v[8]; float ss = 0.f;
#pragma unroll
        for (int i = 0; i < 8; ++i) { v[i] = *(const vf4*)(x + (i * 64 + lane) * 4); ss += v[i].x * v[i].x + v[i].y * v[i].y + v[i].z * v[i].z + v[i].w * v[i].w; }
        ss = wave_sum(ss);
        const float r = 1.0f / sqrtf(ss * (1.0f / DM) + EPS);
#pragma unroll
        for (int i = 0; i < 8; ++i) {
            const int c = (i * 64 + lane) * 4;
            const float4 gg = *(const float4*)(g + c), sh = *(const float4*)(mv + c), sc = *(const float4*)(mv + DM + c);
            const float o0 = v[i].x * r * gg.x * (1.f + sc.x) + sh.x, o1 = v[i].y * r * gg.y * (1.f + sc.y) + sh.y;
            const float o2 = v[i].z * r * gg.z * (1.f + sc.z) + sh.z, o3 = v[i].w * r * gg.w * (1.f + sc.w) + sh.w;
            uint2 w; w.x = pack2(o0, o1); w.y = pack2(o2, o3);
            *(uint2*)(H + (size_t)m * DM + c) = w;
        }
    }
}

__device__ __forceinline__ float red16(float v);
__device__ __forceinline__ float ssq8(vf4 a, vf4 b) { const vf4 s = a * a + b * b; return (s.x + s.y) + (s.z + s.w); }
__device__ __forceinline__ uint4 pack8(vf4 a, vf4 b) { uint4 w; w.x = pack2(a.x, a.y); w.y = pack2(a.z, a.w); w.z = pack2(b.x, b.y); w.w = pack2(b.z, b.w); return w; }
__device__ __forceinline__ void phase_prep(const Params& p, int l) {
    const int tid = opaque_tid(), lane = tid & 63, wv = tid >> 6, rg = lane >> 4, sub = lane & 15, c8 = sub * 8;
    const bf16_t* Z = WSP(bf16_t, WS_Z);
    const float* ropec = WSP(float, WS_ROPE); const float* ropes = ropec + 64 * 32;
    const float* wnq = p.in[I_NAQKN] + ((size_t)l * 2 + 0) * 128 + c8; const float* wnk = wnq + 128;
    const float* wgq = p.in[I_GQAQKN] + ((size_t)l * 2 + 0) * 128 + c8; const float* wgk = wgq + 128;
    const float* cw = p.in[I_CONV] + (size_t)l * 5 * 1536 + rg * 128 + c8;
    for (int m = blockIdx.x * 8 + wv; m < M; m += gridDim.x * 8) {
        const bf16_t* z = Z + (size_t)m * NINP;
        const bool ctx = m < MC;
        const int b = ctx ? m / CT : (m - MC) / LT, t = ctx ? m % CT : (m - MC) % LT, T = ctx ? CT : LT;
        {
            const int ho = rg * 128 + c8;
            const bf16_t* zkv = z + (rg < 2 ? Z_GQK + rg * 128 : Z_GQV + (rg - 2) * 128) + c8;
            vf4 q0, q1, k0, k1, v0, v1, g0, g1, x0, x1;
            ld8bf(z + Z_NAQ + ho, q0, q1); ld8bf(z + Z_NAK + ho, k0, k1); ld8bf(z + Z_NAV + ho, v0, v1); ld8bf(z + Z_GQQ + ho, g0, g1); ld8bf(zkv, x0, x1);
            float r = 1.0f / sqrtf(red16(ssq8(q0, q1)) * (1.0f / 128) + EPS);
            q0 = q0 * r * *(const vf4*)wnq; q1 = q1 * r * *(const vf4*)(wnq + 4);
            *(uint4*)(WSP(bf16_t, WS_NAQ) + (size_t)m * 512 + ho) = pack8(q0, q1);
            r = 1.0f / sqrtf(red16(ssq8(k0, k1)) * (1.0f / 128) + EPS);
            k0 = k0 * r * *(const vf4*)wnk; k1 = k1 * r * *(const vf4*)(wnk + 4);
            *(uint4*)(WSP(bf16_t, WS_NAK) + (size_t)m * 512 + ho) = pack8(k0, k1);
            *(uint4*)(WSP(bf16_t, WS_NAV) + (size_t)m * 512 + ho) = pack8(v0, v1);
            if (ctx) {
                const size_t o = ((((size_t)b * DEPTH + l) * 4 + rg) * CT + t) * 128 + c8;
                *(vf4*)(p.out + O_NAK + o) = k0; *(vf4*)(p.out + O_NAK + o + 4) = k1; *(vf4*)(p.out + O_NAV + o) = v0; *(vf4*)(p.out + O_NAV + o + 4) = v1;
            }
            r = 1.0f / sqrtf(red16(ssq8(g0, g1)) * (1.0f / 128) + EPS);
            g0 = g0 * r * *(const vf4*)wgq; g1 = g1 * r * *(const vf4*)(wgq + 4);
            const float rk = 1.0f / sqrtf(red16(ssq8(x0, x1)) * (1.0f / 128) + EPS);
            if (rg < 2) { x0 = x0 * rk * *(const vf4*)wgk; x1 = x1 * rk * *(const vf4*)(wgk + 4); }
            if (!ctx) {
                const int pos = sub < 8 ? (t >> 6) : (t & 63), ai = pos * 32 + (c8 & 31);
                const vf4 c0 = *(const vf4*)(ropec + ai), c1 = *(const vf4*)(ropec + ai + 4), s0 = *(const vf4*)(ropes + ai), s1 = *(const vf4*)(ropes + ai + 4);
                const bool hi = (sub & 4) != 0;
                vf4 pg0, pg1, px0, px1;
#pragma unroll
                for (int j = 0; j < 4; ++j) { pg0[j] = __shfl_xor(g0[j], 4); pg1[j] = __shfl_xor(g1[j], 4); px0[j] = __shfl_xor(x0[j], 4); px1[j] = __shfl_xor(x1[j], 4); }
                g0 = hi ? pg0 * s0 + g0 * c0 : g0 * c0 - pg0 * s0; g1 = hi ? pg1 * s1 + g1 * c1 : g1 * c1 - pg1 * s1;
                if (rg < 2) { x0 = hi ? px0 * s0 + x0 * c0 : x0 * c0 - px0 * s0; x1 = hi ? px1 * s1 + x1 * c1 : x1 * c1 - px1 * s1; }
            }
            *(uint4*)(WSP(bf16_t, WS_GQ) + (size_t)m * 512 + ho) = pack8(g0, g1);
            *(uint4*)(WSP(bf16_t, rg < 2 ? WS_GK : WS_GV) + (size_t)m * 256 + (rg & 1) * 128 + c8) = pack8(x0, x1);
            if (ctx) {
                const size_t o = ((((size_t)b * DEPTH + l) * 2 + (rg & 1)) * CT + t) * 128 + c8;
                float* dst = p.out + (rg < 2 ? O_GK : O_GV) + o;
                *(vf4*)dst = x0; *(vf4*)(dst + 4) = x1;
            }
        }
        {
#pragma unroll
            for (int dir = 0; dir < 2; ++dir) {
                const float* up = p.in[I_GUP] + ((size_t)l * 2 + dir) * 16 * 256 + 4 * lane;
                vf4 acc = *(const vf4*)(p.in[I_GBIAS] + ((size_t)l * 2 + dir) * 256 + 4 * lane);
                const bf16_t* gz = z + (dir ? Z_GB : Z_GF);
#pragma unroll
                for (int r4 = 0; r4 < 4; ++r4) {
                    const vf4 gv = ld4bf(gz + 4 * r4);
                    acc += gv.x * *(const vf4*)(up + (4 * r4 + 0) * 256) + gv.y * *(const vf4*)(up + (4 * r4 + 1) * 256) + gv.z * *(const vf4*)(up + (4 * r4 + 2) * 256) + gv.w * *(const vf4*)(up + (4 * r4 + 3) * 256);
                }
                vf4 o;
#pragma unroll
                for (int j = 0; j < 4; ++j) o[j] = logsigmoid_f(acc[j]) * (1.0f / 16.0f);
                *(vf4*)(WSP(float, dir ? WS_AB : WS_AF) + (size_t)m * 256 + 4 * lane) = o;
            }
        }
        {
#pragma unroll
            for (int part = 0; part < 3; ++part) {
                vf4 a0 = (vf4){0.f, 0.f, 0.f, 0.f}, a1 = a0;
#pragma unroll
                for (int j = 0; j < 5; ++j) {
                    const int tt = t + j - 2;
                    if (tt >= 0 && tt < T) {
                        const bf16_t* zz = Z + (size_t)(m + j - 2) * NINP + Z_DQKV + part * 512 + rg * 128 + c8;
                        const float* cj = cw + j * 1536 + part * 512;
                        vf4 z0, z1; ld8bf(zz, z0, z1);
                        a0 += *(const vf4*)cj * z0; a1 += *(const vf4*)(cj + 4) * z1;
                    }
                }
#pragma unroll
                for (int j = 0; j < 4; ++j) { a0[j] = silu_f(a0[j]); a1[j] = silu_f(a1[j]); }
                if (part < 2) { const float r = 1.0f / sqrtf(red16(ssq8(a0, a1)) + EPS) * (part == 0 ? 0.08838834764831845f : 1.0f); a0 *= r; a1 *= r; }
                *(uint4*)(WSP(bf16_t, part == 0 ? WS_DQ : part == 1 ? WS_DK : WS_DV) + (size_t)m * 512 + rg * 128 + c8) = pack8(a0, a1);
            }
            if (lane < 8) {
                const float beta = 1.0f / (1.0f + expf(-bf2f(z[Z_DB + lane])));
                const float g = -expf(p.in[I_ALOG][(size_t)l * 8 + lane]) * softplus_f(bf2f(z[Z_DA + lane]) + p.in[I_DTB][(size_t)l * 8 + lane]);
                float* ba = WSP(float, WS_DBA) + (size_t)m * 16;
                ba[lane] = beta; ba[8 + lane] = g;
            }
        }
    }
}

typedef float vf2 __attribute__((ext_vector_type(2)));
__device__ __forceinline__ float dpp_f(float v, const int ctrl) { return v; }
#define DPPF(v, ctrl) __int_as_float(__builtin_amdgcn_mov_dpp(__float_as_int(v), (ctrl), 0xF, 0xF, true))
__device__ __forceinline__ float red8(float v) { v += DPPF(v, 0xB1); v += DPPF(v, 0x4E); v += DPPF(v, 0x141); return v; }
__device__ __forceinline__ float red16(float v) { v = red8(v); v += DPPF(v, 0x140); return v; }

__device__ __forceinline__ void phase_post(const Params& p, int l) {
    const int tid = opaque_tid(), lane = tid & 63, wv = tid >> 6, rg = lane >> 4, c8 = (lane & 15) * 8;
    const bf16_t* Z = WSP(bf16_t, WS_Z); bf16_t* MRG = WSP(bf16_t, WS_MRG);
    const float* wg = p.in[I_GLAON] + (size_t)l * 128 + c8; const float* wd = p.in[I_GDNON] + (size_t)l * 128 + c8;
    for (int m = blockIdx.x * 8 + wv; m < M; m += gridDim.x * 8) {
        const bf16_t* z = Z + (size_t)m * NINP;
        const int ho = rg * 128 + c8;
#pragma unroll
        for (int g = 0; g < 2; ++g) {
            const float* of = WSP(float, g ? WS_DOF : WS_GOF) + (size_t)m * 512 + ho; const float* ob = WSP(float, g ? WS_DOB : WS_GOB) + (size_t)m * 512 + ho;
            const float* w = g ? wd : wg; const bf16_t* zg = z + (g ? Z_DZ : Z_GLR) + ho;
            vf4 a0 = *(const vf4*)of + *(const vf4*)ob, a1 = *(const vf4*)(of + 4) + *(const vf4*)(ob + 4);
            vf4 g0, g1; ld8bf(zg, g0, g1);
            const float r = 1.0f / sqrtf(red16(ssq8(a0, a1)) * (1.0f / 128) + EPS);
            a0 = a0 * r * *(const vf4*)w; a1 = a1 * r * *(const vf4*)(w + 4);
#pragma unroll
            for (int j = 0; j < 4; ++j) { a0[j] *= silu_f(g0[j]); a1[j] *= silu_f(g1[j]); }
            *(uint4*)(MRG + (size_t)m * DM + (g ? 1536 : 512) + ho) = pack8(a0, a1);
        }
    }
}
#define XB_TMO      128
#define XB_XCNT(j)  (256  + 64 * (j))
#define XB_XSUB(j)  (1280 + 64 * (j))
#define XB_XGEN(j)  (2304 + 64 * (j))
#define XB_TOP      3328
#define XB_TOPGEN   3392
#define XCD_BAR_WORDS 3456
#define XB_SPIN_CAP (1u << 22)
#define LAS __attribute__((address_space(3)))

__device__ __forceinline__ unsigned xb_ld(unsigned* p)              { return __hip_atomic_load(p, __ATOMIC_RELAXED, __HIP_MEMORY_SCOPE_AGENT); }
__device__ __forceinline__ unsigned xb_add(unsigned* p, unsigned v) { return __hip_atomic_fetch_add(p, v, __ATOMIC_RELAXED, __HIP_MEMORY_SCOPE_AGENT); }
__device__ __forceinline__ unsigned xb_xcc_id() { return (unsigned)__builtin_amdgcn_s_getreg((3 << 11) | 20) & 0xFu; }
#define XB_SPIN(cond, bar) do { unsigned _sp = 0; while (cond) { __builtin_amdgcn_s_sleep(1); \
    if ((++_sp & 255u) == 0u) { if (xb_ld(&(bar)[XB_TMO])) break; if (_sp > XB_SPIN_CAP) { atomicAdd(&(bar)[XB_TMO], 1u); break; } } } } while (0)

struct XcdBarrier {
    unsigned* bar; unsigned x;
    volatile LAS unsigned* st;
};

__device__ __forceinline__ XcdBarrier xcd_barrier_post(unsigned* bar, volatile LAS unsigned* st) {
    XcdBarrier b; b.bar = bar; b.x = xb_xcc_id(); b.st = st;
    if (threadIdx.x == 0) (void)xb_add(&bar[XB_XCNT(b.x)], 1u);
    return b;
}
__device__ __forceinline__ void xcd_barrier_complete(unsigned* bar, unsigned x, unsigned& nloc, unsigned& nx) {
    const unsigned G = gridDim.x * gridDim.y * gridDim.z;
    unsigned sum, cnt, mine, sp = 0u;
    for (;;) {
        sum = 0u; cnt = 0u; mine = 0u;
#pragma unroll
        for (unsigned j = 0; j < 16; ++j) { const unsigned c = xb_ld(&bar[XB_XCNT(j)]); sum += c; cnt += (c > 0u) ? 1u : 0u; mine = (j == x) ? c : mine; }
        if (sum == G) break;
        __builtin_amdgcn_s_sleep(1);
        if ((++sp & 255u) == 0u) { if (xb_ld(&bar[XB_TMO])) break; if (sp > XB_SPIN_CAP) { atomicAdd(&bar[XB_TMO], 1u); break; } }
    }
    nloc = mine > 0u ? mine : 1u; nx = cnt > 0u ? cnt : 1u;
}

__device__ __forceinline__ void xcd_barrier(const XcdBarrier& b) {
    asm volatile("s_waitcnt vmcnt(0)" ::: "memory");
    __syncthreads();
    if (threadIdx.x == 0) {
        unsigned* bar = b.bar;
        __builtin_amdgcn_s_waitcnt(0);
        unsigned nloc = b.st[0], nx = b.st[1];
        if (nloc == 0u) { xcd_barrier_complete(bar, b.x, nloc, nx); b.st[0] = nloc; b.st[1] = nx; }
        const unsigned old = xb_add(&bar[XB_XSUB(b.x)], 1u);
        const unsigned gen = old / nloc;
        if (old + 1u == (gen + 1u) * nloc) {
            __builtin_amdgcn_fence(__ATOMIC_RELEASE, "agent");
            asm volatile("s_waitcnt vmcnt(0)" ::: "memory");
            const unsigned og = xb_add(&bar[XB_TOP], 1u);
            const unsigned tg = og / nx;
            if (og + 1u == (tg + 1u) * nx) xb_add(&bar[XB_TOPGEN], 1u);
            else XB_SPIN(xb_ld(&bar[XB_TOPGEN]) == tg, bar);
            __builtin_amdgcn_fence(__ATOMIC_ACQUIRE, "agent");
            xb_add(&bar[XB_XGEN(b.x)], 1u);
            asm volatile("s_waitcnt vmcnt(0)" ::: "memory");
        } else {
            XB_SPIN(xb_ld(&bar[XB_XGEN(b.x)]) == gen, bar);
            __builtin_amdgcn_fence(__ATOMIC_ACQUIRE, "agent");
            asm volatile("s_waitcnt vmcnt(0)" ::: "memory");
        }
    }
    __syncthreads();
}

namespace pg8 {
#define PG8_LAS __attribute__((address_space(3)))
typedef unsigned short bf16_t;
typedef short bf16x8 __attribute__((ext_vector_type(8)));
typedef float f32x4 __attribute__((ext_vector_type(4)));
typedef unsigned u32x4 __attribute__((ext_vector_type(4)));
constexpr int BM = 256, BK = 64, HALF = 128, HTB = HALF * BK * 2  , STAGE_BYTES = 8 * HTB, NXCD = 8, WGM = 8;

__host__ __device__ __forceinline__ int lds_byte(int r, int c) { const int st = (r >> 4) * 2 + (c >> 5), rr = r & 15, cc = c & 31, ob = rr * 64 + cc * 2; return st * 1024 + (ob ^ (((ob >> 9) & 1) << 5)); }
__host__ __device__ __forceinline__ void stage_rc(int b, int& R, int& C) { const int st = b / 1024, sb = b % 1024, swz = sb ^ (((sb >> 9) & 1) << 5); R = (st >> 1) * 16 + swz / 64; C = (st & 1) * 32 + (swz % 64) / 2; }
__host__ __device__ __forceinline__ int perm32(int rho) { const int n = rho >> 4, i = rho & 15; return 8 * (i >> 2) + 4 * n + (i & 3); }

struct Unit { int pm, pn, k0, nt, at, slot; };
struct Gemm { const bf16_t* A; const bf16_t* Bt; int M, N, K; };

struct StaticOrder {
    int nM, nN, nwg, G, c, ntk, split;
    __host__ __device__ void init(int M, int N, int K, int G_, int c_, int split_ = 0) { nM = M / BM; nN = N / BM; nwg = nM * nN; G = G_; c = c_; ntk = K / BK; const int rem = nwg % G_; split = (split_ && rem > 0 && 2 * rem == G_ && (ntk % 4) != 1 && ntk >= 8) ? 1 : 0; }
    __host__ __device__ bool next(int i, Unit& u) const {
        long L = (long)i * G + c; u.k0 = 0; u.nt = ntk; u.at = 0; u.slot = 0;
        if (split && i == nwg / G) { const int rem = nwg % G, sl = c / rem, h0 = ((ntk / 2) + 1) & ~1; L = (long)i * G + (c % rem); u.k0 = sl ? h0 * BK : 0; u.nt = sl ? ntk - h0 : h0; u.at = sl ? 1 : 2; u.slot = c % rem; }
        if (L >= nwg) return false;
        int wgid = (int)L; { const int q = nwg / NXCD, r = nwg % NXCD, xcd = wgid % NXCD, off = wgid / NXCD; wgid = (xcd < r ? xcd * (q + 1) : r * (q + 1) + (xcd - r) * q) + off; }
        const int nig = WGM * nN, gid = wgid / nig, fm = gid * WGM, gsz = (nM - fm) < WGM ? (nM - fm) : WGM;
        u.pm = fm + ((wgid % nig) % gsz); u.pn = (wgid % nig) / gsz; return true;
    }
    __device__ __forceinline__ void a_ready(const Unit&) const {}
    __device__ __forceinline__ void done(const Unit&) const {}
};
__device__ __forceinline__ unsigned cvt_pk_bf16(float lo, float hi) { unsigned r; asm volatile("v_cvt_pk_bf16_f32 %0, %1, %2" : "=v"(r) : "v"(lo), "v"(hi)); return r; }
struct EpiF32 {
    static constexpr bool PERM = false, AFTER_DRAIN = false;
    float* C; int ldc; const float* bias;
    __device__ __forceinline__ void operator()(const f32x4 (&acc)[2][2][4][2], const Unit& u, int wr, int wc, int fr, int fq) const {
        const int row0 = u.pm * BM + wr * 64 + fr, col0 = u.pn * BM + wc * 32 + 4 * fq;
        f32x4 bv[2][2];
#pragma unroll
        for (int bj = 0; bj < 2; ++bj)
#pragma unroll
            for (int n = 0; n < 2; ++n) bv[bj][n] = bias ? *(const f32x4*)(bias + col0 + bj * HALF + n * 16) : (f32x4){0.f, 0.f, 0.f, 0.f};
#pragma unroll
        for (int ai = 0; ai < 2; ++ai)
#pragma unroll
            for (int m = 0; m < 4; ++m) { float* rowp = C + (size_t)(row0 + ai * HALF + m * 16) * ldc + col0;
#pragma unroll
                for (int bj = 0; bj < 2; ++bj)
#pragma unroll
                    for (int n = 0; n < 2; ++n) *(f32x4*)(rowp + bj * HALF + n * 16) = acc[ai][bj][m][n] + bv[bj][n]; }
    }
};

struct EpiSwiGLU {
    static constexpr bool PERM = true, AFTER_DRAIN = false;
    bf16_t* O; int ldc;
    __device__ __forceinline__ void operator()(const f32x4 (&acc)[2][2][4][2], const Unit& u, int wr, int wc, int fr, int fq) const {
        const int row0 = u.pm * BM + wr * 64 + fr, col0 = u.pn * 128 + wc * 32 + 8 * fq;
#pragma unroll
        for (int ai = 0; ai < 2; ++ai)
#pragma unroll
            for (int m = 0; m < 4; ++m) { bf16_t* rowp = O + (size_t)(row0 + ai * HALF + m * 16) * ldc + col0;
                const f32x4 g0 = acc[ai][0][m][0], g1 = acc[ai][0][m][1], u0 = acc[ai][1][m][0], u1 = acc[ai][1][m][1];
                float r[8];
#pragma unroll
                for (int j = 0; j < 4; ++j) {
                    r[j]     = g0[j] * __builtin_amdgcn_rcpf(1.0f + __builtin_amdgcn_exp2f(-1.4426950408889634f * g0[j])) * u0[j];
                    r[4 + j] = g1[j] * __builtin_amdgcn_rcpf(1.0f + __builtin_amdgcn_exp2f(-1.4426950408889634f * g1[j])) * u1[j]; }
                u32x4 w; w.x = cvt_pk_bf16(r[0], r[1]); w.y = cvt_pk_bf16(r[2], r[3]); w.z = cvt_pk_bf16(r[4], r[5]); w.w = cvt_pk_bf16(r[6], r[7]);
                *(u32x4*)rowp = w; }
    }
};
struct EpiBf16Plain {
    static constexpr bool PERM = true, AFTER_DRAIN = false;
    bf16_t* O; int ldc;
    __device__ __forceinline__ void operator()(const f32x4 (&acc)[2][2][4][2], const Unit& u, int wr, int wc, int fr, int fq) const {
        const int row0 = u.pm * BM + wr * 64 + fr, col0 = u.pn * BM + wc * 32 + 8 * fq;
#pragma unroll
        for (int ai = 0; ai < 2; ++ai)
#pragma unroll
            for (int m = 0; m < 4; ++m) { bf16_t* rowp = O + (size_t)(row0 + ai * HALF + m * 16) * ldc + col0;
#pragma unroll
                for (int bj = 0; bj < 2; ++bj) { const f32x4 v0 = acc[ai][bj][m][0], v1 = acc[ai][bj][m][1];
                    u32x4 w; w.x = cvt_pk_bf16(v0[0], v0[1]); w.y = cvt_pk_bf16(v0[2], v0[3]); w.z = cvt_pk_bf16(v1[0], v1[1]); w.w = cvt_pk_bf16(v1[2], v1[3]);
                    *(u32x4*)(rowp + bj * HALF) = w; } }
    }
};
struct EpiResid {
    static constexpr bool PERM = false, AFTER_DRAIN = false;
    const float* res; float* out; int ldc; const float* gate0; float coef;
    float* slab; unsigned* flags; unsigned target;
    __device__ __forceinline__ void operator()(const f32x4 (&acc)[2][2][4][2], const Unit& u, int wr, int wc, int fr, int fq) const {
        const int tidx = ((wr * 4 + wc) * 4 + fq) * 16 + fr;
        if (u.at == 1) {
            const __amdgpu_buffer_rsrc_t rs = __builtin_amdgcn_make_buffer_rsrc((void*)slab, 0, 0x7FFFFFF0, 0x00020000);
            const unsigned base = ((unsigned)u.slot * 32u * 512u + (unsigned)tidx) * 16u;
#pragma unroll
            for (int ai = 0; ai < 2; ++ai)
#pragma unroll
                for (int bj = 0; bj < 2; ++bj)
#pragma unroll
                    for (int m = 0; m < 4; ++m)
#pragma unroll
                        for (int n = 0; n < 2; ++n) { const f32x4 v = acc[ai][bj][m][n]; u32x4 w; w.x = __float_as_uint(v[0]); w.y = __float_as_uint(v[1]); w.z = __float_as_uint(v[2]); w.w = __float_as_uint(v[3]);
                            __builtin_amdgcn_raw_buffer_store_b128(w, rs, base + (unsigned)((((ai * 2 + bj) * 4 + m) * 2 + n) * 512 * 16), 0, 16); }
            asm volatile("s_waitcnt vmcnt(0)" ::: "memory");
            if ((tidx & 63) == 0) __hip_atomic_fetch_add(flags + 64 * u.slot, 1u, __ATOMIC_RELAXED, __HIP_MEMORY_SCOPE_AGENT);
            return;
        }
        const float* part = nullptr;
        if (u.at == 2) {
            unsigned spins = 0;
            while (__hip_atomic_load(flags + 64 * u.slot, __ATOMIC_RELAXED, __HIP_MEMORY_SCOPE_AGENT) < target) { __builtin_amdgcn_s_sleep(2); if (++spins > (1u << 22)) break; }
            __builtin_amdgcn_fence(__ATOMIC_ACQUIRE, "agent");
            asm volatile("s_waitcnt vmcnt(0)" ::: "memory");
            part = slab + ((size_t)u.slot * 32 * 512 + tidx) * 4;
        }
        const int row0 = u.pm * BM + wr * 64 + fr, col0 = u.pn * BM + wc * 32 + 4 * fq;
        const float* gate = gate0 + (size_t)cond_of_row(u.pm * BM) * NMOD;
        f32x4 gv[2][2];
#pragma unroll
        for (int bj = 0; bj < 2; ++bj)
#pragma unroll
            for (int n = 0; n < 2; ++n) gv[bj][n] = *(const f32x4*)(gate + col0 + bj * HALF + n * 16) * coef;
#pragma unroll
        for (int ai = 0; ai < 2; ++ai)
#pragma unroll
            for (int m = 0; m < 4; ++m) { const size_t off = (size_t)(row0 + ai * HALF + m * 16) * ldc + col0;
#pragma unroll
                for (int bj = 0; bj < 2; ++bj)
#pragma unroll
                    for (int n = 0; n < 2; ++n) {
                        f32x4 a = acc[ai][bj][m][n];
                        if (part) a += *(const f32x4*)(part + (size_t)((((ai * 2 + bj) * 4 + m) * 2 + n) * 512 * 4));
                        const f32x4 bs = *(const f32x4*)(res + off + bj * HALF + n * 16); *(f32x4*)(out + off + bj * HALF + n * 16) = bs + gv[bj][n] * a; }
                asm volatile("" ::: "memory"); }
    }
};
template <class Epi, class Sched, bool STAMP = false>
__device__ __forceinline__ void gemm_phase(PG8_LAS unsigned char* lds, const Gemm g, const Sched& S, const Epi& E, unsigned long long* stamps) {
    const int tid = opaque_tid(), wid = __builtin_amdgcn_readfirstlane(tid >> 6), lane = tid & 63, wr = wid >> 2, wc = wid & 3, fr = lane & 15, fq = lane >> 4;
    const int K = g.K;
    int ts_lo = 0, ts_hi = 0, nts = 0; const unsigned long long rt_entry = STAMP ? (unsigned long long)wall_clock64() : 0ull;
#define PG8_STAMP() do { if (STAMP && wid == 0 && nts < 64) { const unsigned long long _c = (unsigned long long)clock64(); \
        ts_lo = (lane == nts) ? (int)(unsigned)_c : ts_lo; ts_hi = (lane == nts) ? (int)(unsigned)(_c >> 32) : ts_hi; ++nts; } } while (0)
    PG8_STAMP();
    unsigned voffA[2], voffB[2];
#pragma unroll
    for (int i = 0; i < 2; ++i) { int R, C; stage_rc(tid * 16 + i * 8192, R, C); const int Rb = Epi::PERM ? ((R & ~31) + perm32(R & 31)) : R;
        voffA[i] = (unsigned)(R * K + C) * 2u; voffB[i] = (unsigned)(Rb * K + C) * 2u; }
    const size_t kstep = (size_t)(BK * 2);
    const size_t hstep = (size_t)HALF * K * 2;
    const size_t tstep = 2 * hstep;
    const unsigned ldsw = (unsigned)wid * 1024u;
    const int aoff = lds_byte(wr * 64 + fr, fq * 8), boff = lds_byte(wc * 32 + fr, fq * 8);
#define PG8_SA(b, h) (((b) * 2 + (h)) * HTB)
#define PG8_SB(b, h) ((4 + (b) * 2 + (h)) * HTB)
#define PG8_STAGE(bufoff, gbase, voff) do { _Pragma("unroll") for (int _i = 0; _i < 2; ++_i) \
        __builtin_amdgcn_global_load_lds((const unsigned*)((const char*)(gbase) + (voff)[_i]), (PG8_LAS unsigned*)(lds + (bufoff) + ldsw + _i * 8192), 16, 0, 0); } while (0)
#define PG8_LDA(dst, b, h) do { _Pragma("unroll") for (int m = 0; m < 4; ++m) _Pragma("unroll") for (int k = 0; k < 2; ++k) dst[m][k] = *(const PG8_LAS bf16x8*)(lds + PG8_SA(b, h) + aoff + m * 2048 + k * 1024); } while (0)
#define PG8_LDB(dst, b, h) do { _Pragma("unroll") for (int n = 0; n < 2; ++n) _Pragma("unroll") for (int k = 0; k < 2; ++k) dst[n][k] = *(const PG8_LAS bf16x8*)(lds + PG8_SB(b, h) + boff + n * 2048 + k * 1024); } while (0)
#define PG8_MMA(ai, bj, At, Bt) do { __builtin_amdgcn_s_setprio(1); _Pragma("unroll") for (int m = 0; m < 4; ++m) _Pragma("unroll") for (int n = 0; n < 2; ++n) _Pragma("unroll") for (int k = 0; k < 2; ++k) \
        acc[ai][bj][m][n] = __builtin_amdgcn_mfma_f32_16x16x32_bf16(Bt[n][k], At[m][k], acc[ai][bj][m][n], 0, 0, 0); __builtin_amdgcn_s_setprio(0); } while (0)
#define PG8_WAIT_V(n) asm volatile("s_waitcnt vmcnt(" #n ")" ::: "memory")
#define PG8_WAIT_L(n) asm volatile("s_waitcnt lgkmcnt(" #n ")" ::: "memory")
#define PG8_BAR __builtin_amdgcn_s_barrier()
#define PG8_SCHED __builtin_amdgcn_sched_barrier(0)
    Unit cur, nxt; int ui = 0;
    if (!S.next(0, cur)) return;
    f32x4 acc[2][2][4][2];
#pragma unroll
    for (int a = 0; a < 2; ++a)
#pragma unroll
        for (int b = 0; b < 2; ++b)
#pragma unroll
            for (int m = 0; m < 4; ++m)
#pragma unroll
                for (int n = 0; n < 2; ++n) acc[a][b][m][n] = (f32x4){0.f, 0.f, 0.f, 0.f};
    bf16x8 At[4][2], B0[2][2], B1[2][2];
    const char* cA = (const char*)g.A + (size_t)cur.pm * tstep + (size_t)cur.k0 * 2; const char* cB = (const char*)g.Bt + (size_t)cur.pn * tstep + (size_t)cur.k0 * 2;
    S.a_ready(cur);
    PG8_STAGE(PG8_SB(0, 0), cB, voffB); PG8_STAGE(PG8_SA(0, 0), cA, voffA); PG8_STAGE(PG8_SB(0, 1), cB + hstep, voffB); PG8_STAGE(PG8_SA(0, 1), cA + hstep, voffA);
    if (wr == 1) PG8_BAR;
    PG8_WAIT_V(4); PG8_BAR;
    PG8_STAGE(PG8_SB(1, 0), cB + kstep, voffB); PG8_STAGE(PG8_SA(1, 0), cA + kstep, voffA); PG8_STAGE(PG8_SB(1, 1), cB + hstep + kstep, voffB);
    PG8_WAIT_V(6); PG8_BAR;
    PG8_STAMP();
    for (;;) {
        const bool has_next = S.next(ui + 1, nxt);
        const char* nA = has_next ? (const char*)g.A + (size_t)nxt.pm * tstep + (size_t)nxt.k0 * 2 : cA; const char* nB = has_next ? (const char*)g.Bt + (size_t)nxt.pn * tstep + (size_t)nxt.k0 * 2 : cB;
        const int nt = cur.nt;
        for (int t = 0; t < nt; t += 2) {
            const bool last = (t == nt - 2);
            const char* a1 = cA + (size_t)(t + 1) * kstep;
            const char* a2 = last ? nA : cA + (size_t)(t + 2) * kstep; const char* b2 = last ? nB : cB + (size_t)(t + 2) * kstep;
            const char* a3 = a2 + kstep; const char* b3 = b2 + kstep;
            if (last && has_next) S.a_ready(nxt);
            PG8_LDB(B0, 0, 0); PG8_SCHED; PG8_LDA(At, 0, 0); PG8_STAGE(PG8_SA(1, 1), a1 + hstep, voffA);
            PG8_WAIT_L(8); PG8_BAR; PG8_WAIT_L(0); PG8_MMA(0, 0, At, B0); PG8_BAR; PG8_SCHED;
            PG8_LDB(B1, 0, 1); PG8_STAGE(PG8_SB(0, 0), b2, voffB);
            PG8_BAR; PG8_WAIT_L(0); PG8_MMA(0, 1, At, B1); PG8_BAR;
            PG8_LDA(At, 0, 1); PG8_STAGE(PG8_SA(0, 0), a2, voffA);
            PG8_BAR; PG8_WAIT_L(0); PG8_MMA(1, 0, At, B0); PG8_BAR; PG8_SCHED;
            PG8_STAGE(PG8_SB(0, 1), b2 + hstep, voffB);
            PG8_WAIT_V(6); PG8_BAR; PG8_MMA(1, 1, At, B1); PG8_BAR;
            PG8_LDB(B0, 1, 0); PG8_SCHED; PG8_LDA(At, 1, 0); PG8_STAGE(PG8_SA(0, 1), a2 + hstep, voffA);
            PG8_WAIT_L(8); PG8_BAR; PG8_WAIT_L(0); PG8_MMA(0, 0, At, B0); PG8_BAR; PG8_SCHED;
            PG8_LDB(B1, 1, 1); PG8_STAGE(PG8_SB(1, 0), b3, voffB);
            PG8_BAR; PG8_WAIT_L(0); PG8_MMA(0, 1, At, B1); PG8_BAR;
            PG8_LDA(At, 1, 1); PG8_STAGE(PG8_SA(1, 0), a3, voffA);
            PG8_BAR; PG8_WAIT_L(0); PG8_MMA(1, 0, At, B0); PG8_BAR; PG8_SCHED;
            PG8_STAGE(PG8_SB(1, 1), b3 + hstep, voffB);
            PG8_WAIT_V(6); PG8_BAR; PG8_MMA(1, 1, At, B1); PG8_BAR;
        }
        PG8_STAMP();
        if constexpr (!Epi::AFTER_DRAIN) { E(acc, cur, wr, wc, fr, fq); S.done(cur); }
        PG8_STAMP();
        if (!has_next) break;
#pragma unroll
        for (int a = 0; a < 2; ++a)
#pragma unroll
            for (int b = 0; b < 2; ++b)
#pragma unroll
                for (int m = 0; m < 4; ++m)
#pragma unroll
                    for (int n = 0; n < 2; ++n) acc[a][b][m][n] = (f32x4){0.f, 0.f, 0.f, 0.f};
        cur = nxt; cA = nA; cB = nB; ++ui;
    }
    PG8_WAIT_V(0);
    if (wr == 0) PG8_BAR;
    PG8_BAR;
    if constexpr (Epi::AFTER_DRAIN) { E.fused(acc, cur, wr, wc, fr, fq, lds, wid, lane); S.done(cur); }
    PG8_STAMP();
    if (STAMP && wid == 0) { stamps[lane] = lane < nts ? (((unsigned long long)(unsigned)ts_hi << 32) | (unsigned)ts_lo) : 0ull;
        if (lane == 62) stamps[62] = rt_entry; if (lane == 63) stamps[63] = (unsigned long long)wall_clock64(); }
#undef PG8_STAMP
#undef PG8_SA
#undef PG8_SB
#undef PG8_STAGE
#undef PG8_LDA
#undef PG8_LDB
#undef PG8_MMA
#undef PG8_WAIT_V
#undef PG8_WAIT_L
#undef PG8_BAR
#undef PG8_SCHED
}
}
#ifndef ATT_INLINE
#define ATT_INLINE __forceinline__
#endif
namespace att {
constexpr int D = 128, NW = 8, QBLK = 32, KVBLK = 64, LDQ = 512, LDO = DM;
constexpr float SCALE = 0.088388347648318440f;
constexpr float THR = 8.f;
constexpr size_t SHM_V = KVBLK * D * 2, SHM_K = KVBLK * D * 2, SHM_Q = 256 * D * 2, SHM_ATTN = 2 * SHM_V + 2 * SHM_K + NW * 64 * 4 + SHM_Q;
using bf16x8 = __attribute__((ext_vector_type(8))) short;
using s16x4  = __attribute__((ext_vector_type(4))) short;
using f32x16 = __attribute__((ext_vector_type(16))) float;
using u32x4  = __attribute__((ext_vector_type(4))) unsigned;
#define KSWZ(row, colB) ((row) * 256 + ((colB) ^ (((row) & 7) << 4)))
#define SBAR() __builtin_amdgcn_sched_barrier(0)
__device__ __forceinline__ int crow(int r, int hi) { return (r & 3) + 8 * (r >> 2) + 4 * hi; }
__device__ __forceinline__ unsigned cvtpk(float lo, float hi) { unsigned r; asm volatile("v_cvt_pk_bf16_f32 %0, %1, %2" : "=v"(r) : "v"(lo), "v"(hi)); return r; }

__device__ __forceinline__ void partialSM(f32x16& p0, f32x16& p1, float& m_reg, float& mn, float& alpha) {
  constexpr float C = SCALE * 1.4426950408889634f;
  float pmax = p0[0]; for (int r = 1; r < 16; ++r) pmax = fmaxf(pmax, p0[r]); for (int r = 0; r < 16; ++r) pmax = fmaxf(pmax, p1[r]);
  { auto rr = __builtin_amdgcn_permlane32_swap(__float_as_uint(pmax), __float_as_uint(pmax), false, false);
    pmax = fmaxf(__uint_as_float(rr[0]), __uint_as_float(rr[1])); }
  if (__builtin_expect(__all(pmax - m_reg <= THR / SCALE), 1)) { mn = m_reg; alpha = 1.f; }
  else { mn = fmaxf(m_reg, pmax); alpha = __builtin_amdgcn_exp2f((m_reg - mn) * C); m_reg = mn; }
  float mnC = -mn * C;
  for (int r = 0; r < 16; ++r) p0[r] = fmaf(p0[r], C, mnC); for (int r = 0; r < 16; ++r) p1[r] = fmaf(p1[r], C, mnC);
  for (int r = 0; r < 16; ++r) p0[r] = __builtin_amdgcn_exp2f(p0[r]);
}
__device__ __forceinline__ void finishSM(f32x16& p0, f32x16& p1, float alpha, float& l_reg, bf16x8& pa0, bf16x8& pa1, bf16x8& pa2, bf16x8& pa3) {
  for (int r = 0; r < 16; ++r) p1[r] = __builtin_amdgcn_exp2f(p1[r]);
  float ps = 0; for (int r = 0; r < 16; ++r) ps += p0[r]; for (int r = 0; r < 16; ++r) ps += p1[r];
  { auto rr = __builtin_amdgcn_permlane32_swap(__float_as_uint(ps), __float_as_uint(ps), false, false);
    ps = __uint_as_float(rr[0]) + __uint_as_float(rr[1]); }
  l_reg = l_reg * alpha + ps;
#define PK4(P, BASE, OUT) do { unsigned a0 = cvtpk(P[BASE + 0], P[BASE + 1]), a1 = cvtpk(P[BASE + 2], P[BASE + 3]);   \
    unsigned b0 = cvtpk(P[BASE + 4], P[BASE + 5]), b1 = cvtpk(P[BASE + 6], P[BASE + 7]);                              \
    auto r0 = __builtin_amdgcn_permlane32_swap(a0, b0, false, false); auto r1 = __builtin_amdgcn_permlane32_swap(a1, b1, false, false); \
    u32x4 w = {r0[0], r1[0], r0[1], r1[1]}; OUT = *reinterpret_cast<bf16x8*>(&w); } while (0)
  PK4(p0, 0, pa0); PK4(p0, 8, pa1); PK4(p1, 0, pa2); PK4(p1, 8, pa3);
#undef PK4
}
__device__ __forceinline__ void qkt(f32x16& p0, f32x16& p1, const bf16_t* Ks, const bf16_t* Qs, int qrow, int r32, int hi) {
  p0 = f32x16{}; p1 = f32x16{};
#pragma unroll
  for (int d0 = 0; d0 < 8; ++d0) { int cb = (d0 * 16 + hi * 8) * 2;
    bf16x8 q = *reinterpret_cast<const bf16x8*>((const char*)Qs + KSWZ(qrow, cb));
    bf16x8 b0 = *reinterpret_cast<const bf16x8*>((const char*)Ks + KSWZ(r32, cb));
    bf16x8 b1 = *reinterpret_cast<const bf16x8*>((const char*)Ks + KSWZ(32 + r32, cb));
    p0 = __builtin_amdgcn_mfma_f32_32x32x16_bf16(b0, q, p0, 0, 0, 0);
    p1 = __builtin_amdgcn_mfma_f32_32x32x16_bf16(b1, q, p1, 0, 0, 0); }
}
__device__ __forceinline__ int v_st(int k, int c) { const int kk = (k & ~0xC) | ((k & 4) << 1) | ((k & 8) >> 1); return ((kk >> 3) * 4 + (c >> 5)) * 512 + ((kk & 7) * 32 + (c & 31)) * 2; }
__device__ __forceinline__ int v_rd_base(int lane) { return ((lane & 3) << 3) | (((lane >> 2) & 3) << 6) | (((lane >> 4) & 1) << 5) | (((lane >> 5) & 1) << 8); }
constexpr int v_rd_off(int d0, int ks, int half) { return d0 * 512 + ks * 4096 + half * 2048; }
template <int OFF> __device__ __forceinline__ s16x4 tr_read(int vb) {
  s16x4 r; asm volatile("ds_read_b64_tr_b16 %0, %1 offset:%2" : "=&v"(r) : "v"(vb), "i"(OFF) : "memory"); return r;
}
template <int D0> __device__ __forceinline__ void pv_one(f32x16& od, int vb, bf16x8 pa0, bf16x8 pa1, bf16x8 pa2, bf16x8 pa3) {
  const s16x4 l0 = tr_read<v_rd_off(D0, 0, 0)>(vb), h0 = tr_read<v_rd_off(D0, 0, 1)>(vb), l1 = tr_read<v_rd_off(D0, 1, 0)>(vb), h1 = tr_read<v_rd_off(D0, 1, 1)>(vb);
  const s16x4 l2 = tr_read<v_rd_off(D0, 2, 0)>(vb), h2 = tr_read<v_rd_off(D0, 2, 1)>(vb), l3 = tr_read<v_rd_off(D0, 3, 0)>(vb), h3 = tr_read<v_rd_off(D0, 3, 1)>(vb);
  asm volatile("s_waitcnt lgkmcnt(0)" ::: "memory"); SBAR();
#define PK(L, H) (bf16x8){L[0], L[1], L[2], L[3], H[0], H[1], H[2], H[3]}
  od = __builtin_amdgcn_mfma_f32_32x32x16_bf16(pa0, PK(l0, h0), od, 0, 0, 0);
  od = __builtin_amdgcn_mfma_f32_32x32x16_bf16(pa1, PK(l1, h1), od, 0, 0, 0);
  od = __builtin_amdgcn_mfma_f32_32x32x16_bf16(pa2, PK(l2, h2), od, 0, 0, 0);
  od = __builtin_amdgcn_mfma_f32_32x32x16_bf16(pa3, PK(l3, h3), od, 0, 0, 0);
#undef PK
}
__device__ __forceinline__ void pv_d0(f32x16* o, int vb, bf16x8 pa0, bf16x8 pa1, bf16x8 pa2, bf16x8 pa3) {
  pv_one<0>(o[0], vb, pa0, pa1, pa2, pa3); pv_one<1>(o[1], vb, pa0, pa1, pa2, pa3); pv_one<2>(o[2], vb, pa0, pa1, pa2, pa3); pv_one<3>(o[3], vb, pa0, pa1, pa2, pa3);
}

struct SrcOne { const bf16_t* k0; const bf16_t* v0; int ldk;
  __device__ __forceinline__ const bf16_t* k(int j) const { return k0 + (size_t)j * 64 * ldk; }
  __device__ __forceinline__ const bf16_t* v(int j) const { return v0 + (size_t)j * 64 * ldk; } };
struct SrcTwo { const bf16_t* ck; const bf16_t* cv; const bf16_t* k1; const bf16_t* v1; int ldk;
  __device__ __forceinline__ const bf16_t* k(int j) const { return j < 4 ? ck + (size_t)j * 64 * ldk : k1 + (size_t)(j - 4) * 64 * ldk; }
  __device__ __forceinline__ const bf16_t* v(int j) const { return j < 4 ? cv + (size_t)j * 64 * ldk : v1 + (size_t)(j - 4) * 64 * ldk; } };
struct NoBias { __device__ __forceinline__ void operator()(f32x16&, f32x16&, int, int, int, int) const {} };
struct NaBias { const float* tab; int i0, kr0;
  __device__ __forceinline__ void operator()(f32x16& p0, f32x16& p1, int jt, int wid, int r32, int hi) const {
    if (jt < 4) return;
    const int qi = i0 + wid * QBLK + r32, r = qi >> 6, qc = qi & 63, kr = kr0 + jt - 4;
    int lo = r - 4; lo = lo < 0 ? 0 : (lo > 8 ? 8 : lo);
    const bool rowok = (kr >= lo) && (kr < lo + 8);
    if (!rowok) {
#pragma unroll
      for (int rr = 0; rr < 16; ++rr) { p0[rr] = -1e30f; p1[rr] = -1e30f; }
      return;
    }
    int c0 = qc - 8; c0 = c0 < 0 ? 0 : (c0 > 48 ? 48 : c0);
    const int dr = kr - r + 7;
    const float* tb = tab + dr * 31 + (4 * hi - qc + 15);
    const int w0 = 4 * hi - c0;
#pragma unroll
    for (int g = 0; g < 4; ++g) {
#pragma unroll
      for (int q = 0; q < 4; ++q) {
        const int rr = 4 * g + q, kc0 = q + 8 * g;
        const float t0 = tb[kc0], t1 = tb[kc0 + 32];
        p0[rr] = ((unsigned)(kc0 + w0) < 16u) ? p0[rr] + t0 : -1e30f;
        p1[rr] = ((unsigned)(kc0 + 32 + w0) < 16u) ? p1[rr] + t1 : -1e30f;
      }
      SBAR();
    }
  } };

template <int SD, class Src, class Bias>
__device__ ATT_INLINE void attn_body(const bf16_t* __restrict__ Qb, const Src src, bf16_t* __restrict__ Ob, const int NT, char* lds, const Bias bias) {
  const int tid = opaque_tid(), wid = tid >> 6, lane = tid & 63, r32 = lane & 31, hi = lane >> 5;
  const int LDK = src.ldk;
  bf16_t* V_lds = (bf16_t*)lds; bf16_t* K_lds = (bf16_t*)(lds + 2 * SHM_V);
  float* ws = (float*)(lds + 2 * SHM_V + 2 * SHM_K) + wid * 64; float* li_l = ws; float* al_l = ws + 32;
  float m_reg = -1e30f, l_reg = 0; f32x16 o[4] = {};
  bf16_t* Q_lds = (bf16_t*)(lds + 2 * SHM_V + 2 * SHM_K + NW * 64 * 4);
  const int qrow = wid * QBLK + r32;
  {
#pragma unroll
    for (int i = 0; i < 8; ++i) { const int f = tid + 512 * i, row = f >> 4, c8 = (f & 15) * 8;
      *(bf16x8*)((char*)Q_lds + KSWZ(row, c8 * 2)) = *reinterpret_cast<const bf16x8*>(Qb + (long)row * LDQ + c8); }
  }
  const int sr = tid >> 4, sc = (tid & 15) * 8, vst0 = v_st(sr, sc), vst1 = v_st(32 + sr, sc);
  const int vb0 = (int)(uintptr_t)V_lds + v_rd_base(lane);
  struct { bf16x8 vs0, vs1, ks0, ks1; } sr_[SD];
#define SLOAD(i, jt) do { const bf16_t* kt_ = src.k(jt); const bf16_t* vt_ = src.v(jt); \
    sr_[i].vs0 = *reinterpret_cast<const bf16x8*>(&vt_[(long)sr * LDK + sc]); sr_[i].vs1 = *reinterpret_cast<const bf16x8*>(&vt_[(long)(32 + sr) * LDK + sc]); \
    sr_[i].ks0 = *reinterpret_cast<const bf16x8*>(&kt_[(long)sr * LDK + sc]); sr_[i].ks1 = *reinterpret_cast<const bf16x8*>(&kt_[(long)(32 + sr) * LDK + sc]); } while (0)
#define SWRITE(b, i) do { *(bf16x8*)((char*)V_lds + (b) * SHM_V + vst0) = sr_[i].vs0;          \
    *(bf16x8*)((char*)V_lds + (b) * SHM_V + vst1) = sr_[i].vs1; int kc = sc * 2;               \
    *(bf16x8*)((char*)K_lds + (b) * SHM_K + KSWZ(sr, kc)) = sr_[i].ks0;                       \
    *(bf16x8*)((char*)K_lds + (b) * SHM_K + KSWZ(32 + sr, kc)) = sr_[i].ks1; } while (0)
#define SWAIT() do { if constexpr (SD == 2) asm volatile("s_waitcnt vmcnt(4)" ::: "memory"); else asm volatile("s_waitcnt vmcnt(0)" ::: "memory"); } while (0)
#define RESC(a) do { if (__any((a) < 1.f)) { if (hi == 0) al_l[r32] = (a); asm volatile("s_waitcnt lgkmcnt(0)" ::: "memory"); \
    for (int d = 0; d < 4; ++d) for (int r = 0; r < 16; ++r) o[d][r] *= al_l[crow(r, hi)]; } } while (0)
  f32x16 pA0, pA1, pB0, pB1; float mnA, mnB, alA, alB; bf16x8 pa0, pa1, pa2, pa3;
  constexpr int SE = 0, SO = SD - 1;
  SLOAD(SE, 0); asm volatile("s_waitcnt vmcnt(0)" ::: "memory"); SWRITE(0, SE); __syncthreads();
  qkt(pA0, pA1, K_lds, Q_lds, qrow, r32, hi); bias(pA0, pA1, 0, wid, r32, hi); partialSM(pA0, pA1, m_reg, mnA, alA);
  SLOAD(SO, 1); if constexpr (SD == 2) { if (2 < NT) SLOAD(SE, 2); }
  SWAIT(); SWRITE(1, SO); __syncthreads();
  for (int j = 1; j + 1 < NT; j += 2) {
    SBAR(); qkt(pB0, pB1, (bf16_t*)((char*)K_lds + SHM_K), Q_lds, qrow, r32, hi); bias(pB0, pB1, j, wid, r32, hi);
    finishSM(pA0, pA1, alA, l_reg, pa0, pa1, pa2, pa3); SBAR();
    SLOAD(SO, j + SD); SBAR();
    pv_d0(o, vb0, pa0, pa1, pa2, pa3); partialSM(pB0, pB1, m_reg, mnB, alB);
    __syncthreads(); SWAIT(); SWRITE(0, SE);
    RESC(alB); __syncthreads();
    SBAR(); qkt(pA0, pA1, K_lds, Q_lds, qrow, r32, hi); bias(pA0, pA1, j + 1, wid, r32, hi);
    finishSM(pB0, pB1, alB, l_reg, pa0, pa1, pa2, pa3); SBAR();
    if (SD == 1 || j + 3 < NT) SLOAD(SE, j + 1 + SD); SBAR();
    pv_d0(o, vb0 + (int)SHM_V, pa0, pa1, pa2, pa3); partialSM(pA0, pA1, m_reg, mnA, alA);
    __syncthreads(); SWAIT(); SWRITE(1, SO);
    RESC(alA); __syncthreads();
  }
  SBAR(); qkt(pB0, pB1, (bf16_t*)((char*)K_lds + SHM_K), Q_lds, qrow, r32, hi); bias(pB0, pB1, NT - 1, wid, r32, hi);
  finishSM(pA0, pA1, alA, l_reg, pa0, pa1, pa2, pa3); SBAR();
  pv_d0(o, vb0, pa0, pa1, pa2, pa3); partialSM(pB0, pB1, m_reg, mnB, alB);
  __syncthreads(); RESC(alB);
  finishSM(pB0, pB1, alB, l_reg, pa0, pa1, pa2, pa3); SBAR();
  pv_d0(o, vb0 + (int)SHM_V, pa0, pa1, pa2, pa3);
  if (hi == 0) li_l[r32] = l_reg; asm volatile("s_waitcnt lgkmcnt(0)" ::: "memory");
  float rli[16];
#pragma unroll
  for (int r = 0; r < 16; ++r) rli[r] = __builtin_amdgcn_rcpf(li_l[crow(r, hi)]);
  bf16_t* Ow = Ob + (long)(wid * QBLK) * LDO;
#pragma unroll
  for (int r = 0; r < 16; ++r) { int orow = crow(r, hi);
    for (int d0 = 0; d0 < 4; ++d0) Ow[(long)orow * LDO + d0 * 32 + r32] = f2bf(o[d0][r] * rli[r]); }
#undef SLOAD
#undef SWRITE
#undef SWAIT
#undef RESC
}
}
namespace gdn {
using att::bf16x8; using att::f32x16; using att::crow;
constexpr int C = 32, SK = 136, SS = 40;
constexpr int OFF_KT = 0, OFF_QT = OFF_KT + C * SK * 2, OFF_W = OFF_QT + C * SK * 2, OFF_KTT = OFF_W + C * SK * 2, OFF_VTT = OFF_KTT + 128 * SS * 2,
              OFF_VN = OFF_VTT + 128 * SS * 2, OFF_VNS = OFF_VN + 128 * SS * 2, OFF_ST = OFF_VNS + 128 * SS * 2, OFF_TB = OFF_ST + 128 * SK * 2,
              OFF_TBE = OFF_TB + C * SS * 2, OFF_ATT = OFF_TBE + C * SS * 2, OFF_L = OFF_ATT + C * SS * 2, OFF_SC = OFF_L + C * C * 4, GDN_LDS = OFF_SC + 1024;
template <int K>
__device__ __forceinline__ f32x16 mm(const bf16_t* A, int lda, const bf16_t* Bt, int ldb, int l32, int hi, f32x16 acc) {
#pragma unroll
    for (int k0 = 0; k0 < K; k0 += 16) {
        const bf16x8 a = *reinterpret_cast<const bf16x8*>(A + l32 * lda + k0 + 8 * hi);
        const bf16x8 b = *reinterpret_cast<const bf16x8*>(Bt + l32 * ldb + k0 + 8 * hi);
        acc = __builtin_amdgcn_mfma_f32_32x32x16_bf16(a, b, acc, 0, 0, 0);
    }
    return acc;
}
__device__ __forceinline__ uint2 pk4(float a, float b, float c, float d) { uint2 w; w.x = pack2(a, b); w.y = pack2(c, d); return w; }

__device__ __forceinline__ void gdn_chunked(const Params& p, int l, bool ctx, int b, int h, int dir, unsigned char* lds) {
    const int tid = opaque_tid(), wid = tid >> 6, lane = tid & 63, l32 = lane & 31, hi = lane >> 5;
    const int T = ctx ? CT : ::LT; const size_t m0 = ctx ? (size_t)b * CT : (size_t)MC + (size_t)b * ::LT;
    const bf16_t* DQ = WSP(bf16_t, WS_DQ); const bf16_t* DK = WSP(bf16_t, WS_DK); const bf16_t* DV = WSP(bf16_t, WS_DV); const float* DBA = WSP(float, WS_DBA);
    float* O = WSP(float, dir ? WS_DOB : WS_DOF);
    bf16_t* Kt = (bf16_t*)(lds + OFF_KT); bf16_t* Qt = (bf16_t*)(lds + OFF_QT); bf16_t* W = (bf16_t*)(lds + OFF_W); bf16_t* KT = (bf16_t*)(lds + OFF_KTT); bf16_t* VT = (bf16_t*)(lds + OFF_VTT);
    bf16_t* VN = (bf16_t*)(lds + OFF_VN); bf16_t* VNS = (bf16_t*)(lds + OFF_VNS); bf16_t* ST = (bf16_t*)(lds + OFF_ST); bf16_t* TB = (bf16_t*)(lds + OFF_TB); bf16_t* TBE = (bf16_t*)(lds + OFF_TBE);
    bf16_t* ATT = (bf16_t*)(lds + OFF_ATT); float* Lm = (float*)(lds + OFF_L); float* sc = (float*)(lds + OFF_SC);
    const int nch = T / C;
#define TOK(c, s_) (m0 + (dir ? T - 1 - ((c) * C + (s_)) : (c) * C + (s_)))
    f32x16 S[2];
#pragma unroll
    for (int bi = 0; bi < 2; ++bi) {
        const int blk = wid * 2 + bi, d0 = 32 * (blk >> 2), e0 = 32 * (blk & 3);
        if (ctx) { S[bi] = f32x16{}; }
        else {
            const float* s0 = p.in[I_SGDN] + ((((size_t)b * DEPTH + l) * 2 + dir) * 4 + h) * 128 * 128 + e0 + l32;
#pragma unroll
            for (int r = 0; r < 16; ++r) S[bi][r] = s0[(size_t)(d0 + crow(r, hi)) * 128];
        }
    }
    const int ls = tid >> 5, lc = (tid & 31) * 4;
    vf4 pq0, pq1, pk0, pk1, pv0, pv1; float pbeta = 0.f, pg = 0.f;
#define GLOAD(c) do { const size_t ma = TOK(c, ls), mb = TOK(c, ls + 16); \
        pq0 = ld4bf(DQ + ma * 512 + h * 128 + lc); pq1 = ld4bf(DQ + mb * 512 + h * 128 + lc); \
        pk0 = ld4bf(DK + ma * 512 + h * 128 + lc); pk1 = ld4bf(DK + mb * 512 + h * 128 + lc); \
        pv0 = ld4bf(DV + ma * 512 + h * 128 + lc); pv1 = ld4bf(DV + mb * 512 + h * 128 + lc); \
        if (tid < C) { const size_t mt = TOK(c, tid); pbeta = DBA[mt * 16 + dir * 4 + h]; pg = DBA[mt * 16 + 8 + dir * 4 + h]; } } while (0)
#define GSTAGE() do { \
        *(uint2*)(Kt + ls * SK + lc) = pk4(pk0.x, pk0.y, pk0.z, pk0.w); *(uint2*)(Kt + (ls + 16) * SK + lc) = pk4(pk1.x, pk1.y, pk1.z, pk1.w); \
        *(uint2*)(Qt + ls * SK + lc) = pk4(pq0.x, pq0.y, pq0.z, pq0.w); *(uint2*)(Qt + (ls + 16) * SK + lc) = pk4(pq1.x, pq1.y, pq1.z, pq1.w); \
        _Pragma("unroll") for (int j = 0; j < 4; ++j) { KT[(lc + j) * SS + ls] = f2bf(pk0[j]); KT[(lc + j) * SS + ls + 16] = f2bf(pk1[j]); \
                                                        VT[(lc + j) * SS + ls] = f2bf(pv0[j]); VT[(lc + j) * SS + ls + 16] = f2bf(pv1[j]); } \
        if (wid == 0) { float x = pg; _Pragma("unroll") for (int o_ = 1; o_ < 32; o_ <<= 1) { const float y = __shfl_up(x, o_); if (lane >= o_) x += y; } \
            const float Bt_ = __shfl(x, 31); if (lane < C) { sc[lane] = pbeta; sc[32 + lane] = x; sc[64 + lane] = __expf(x); sc[96 + lane] = __expf(Bt_ - x); if (lane == 0) sc[128] = __expf(Bt_); } } } while (0)
    __syncthreads();
    GLOAD(0);
#pragma unroll
    for (int bi = 0; bi < 2; ++bi) {
        const int blk = wid * 2 + bi, d0 = 32 * (blk >> 2), e0 = 32 * (blk & 3);
#pragma unroll
        for (int g = 0; g < 4; ++g) *(uint2*)(ST + (e0 + l32) * SK + d0 + 8 * g + 4 * hi) = pk4(S[bi][4 * g], S[bi][4 * g + 1], S[bi][4 * g + 2], S[bi][4 * g + 3]);
    }
    GSTAGE();
    __syncthreads();
    for (int c = 0; c < nch; ++c) {
        if (c + 1 < nch) GLOAD(c + 1);
        f32x16 acc1 = f32x16{};
        if (wid == 0) {
            const f32x16 kk = mm<128>(Kt, SK, Kt, SK, l32, hi, f32x16{});
            const float bi_ = sc[32 + l32], be = sc[l32];
#pragma unroll
            for (int r = 0; r < 16; ++r) { const int j = crow(r, hi); const float v = (l32 > j) ? be * kk[r] * __expf(bi_ - sc[32 + j]) : 0.f;
                Lm[l32 * 32 + ((r & 3) + 4 * hi) * 4 + (r >> 2)] = v; }
        } else if (wid == 1) {
            const f32x16 kq = mm<128>(Kt, SK, Qt, SK, l32, hi, f32x16{});
            const float bi_ = sc[32 + l32];
            float a[16];
#pragma unroll
            for (int r = 0; r < 16; ++r) { const int j = crow(r, hi); a[r] = (l32 >= j) ? kq[r] * __expf(bi_ - sc[32 + j]) : 0.f; }
#pragma unroll
            for (int g = 0; g < 4; ++g) *(uint2*)(ATT + l32 * SS + 8 * g + 4 * hi) = pk4(a[4 * g], a[4 * g + 1], a[4 * g + 2], a[4 * g + 3]);
        } else if (wid >= 4) {
            acc1 = mm<128>(Qt, SK, ST + (32 * (wid - 4)) * SK, SK, l32, hi, f32x16{});
#pragma unroll
            for (int r = 0; r < 16; ++r) acc1[r] *= sc[64 + crow(r, hi)];
        }
        __syncthreads();
        if (tid < 256) {
            const int cc = tid >> 3, part = tid & 7;
            float Tr[4] = {0.f, 0.f, 0.f, 0.f};
            const float* Lp = Lm + part * 4;
#pragma unroll
            for (int i = 0; i < 32; ++i) {
                const vf4 lv = *(const vf4*)(Lp + i * 32);
                float s = lv.x * Tr[0] + lv.y * Tr[1] + lv.z * Tr[2] + lv.w * Tr[3];
                s = red8(s);
                const float t = (i == cc ? 1.f : 0.f) - s;
                if (part == (i & 7)) Tr[i >> 3] = t;
            }
            const float bc = sc[cc], bec = bc * sc[64 + cc];
#pragma unroll
            for (int jj = 0; jj < 4; ++jj) { TB[(part + 8 * jj) * SS + cc] = f2bf(Tr[jj] * bc); TBE[(part + 8 * jj) * SS + cc] = f2bf(Tr[jj] * bec); }
        }
        __syncthreads();
        if (wid < 4) {
            acc1 = mm<32>(TB, SS, VT + (32 * wid) * SS, SS, l32, hi, f32x16{});
        } else {
            const int d0 = 32 * (wid - 4);
            const f32x16 wt = mm<32>(KT + d0 * SS, SS, TBE, SS, l32, hi, f32x16{});
#pragma unroll
            for (int g = 0; g < 4; ++g) *(uint2*)(W + l32 * SK + d0 + 8 * g + 4 * hi) = pk4(wt[4 * g], wt[4 * g + 1], wt[4 * g + 2], wt[4 * g + 3]);
        }
        __syncthreads();
        if (wid < 4) {
            const int e0 = 32 * wid;
            const f32x16 ws = mm<128>(W, SK, ST + e0 * SK, SK, l32, hi, f32x16{});
            float vn[16], vs[16];
#pragma unroll
            for (int r = 0; r < 16; ++r) { vn[r] = acc1[r] - ws[r]; vs[r] = vn[r] * sc[96 + crow(r, hi)]; }
#pragma unroll
            for (int g = 0; g < 4; ++g) { *(uint2*)(VN + (e0 + l32) * SS + 8 * g + 4 * hi) = pk4(vn[4 * g], vn[4 * g + 1], vn[4 * g + 2], vn[4 * g + 3]);
                                          *(uint2*)(VNS + (e0 + l32) * SS + 8 * g + 4 * hi) = pk4(vs[4 * g], vs[4 * g + 1], vs[4 * g + 2], vs[4 * g + 3]); }
        }
        __syncthreads();
        if (wid >= 4) {
            const int e0 = 32 * (wid - 4);
            acc1 = mm<32>(ATT, SS, VN + e0 * SS, SS, l32, hi, acc1);
#pragma unroll
            for (int r = 0; r < 16; ++r) O[TOK(c, crow(r, hi)) * 512 + h * 128 + e0 + l32] = acc1[r];
        }
        {
            const float eB = sc[128];
#pragma unroll
            for (int bi = 0; bi < 2; ++bi) {
                const int blk = wid * 2 + bi, d0 = 32 * (blk >> 2), e0 = 32 * (blk & 3);
#pragma unroll
                for (int r = 0; r < 16; ++r) S[bi][r] *= eB;
                S[bi] = mm<32>(KT + d0 * SS, SS, VNS + e0 * SS, SS, l32, hi, S[bi]);
            }
        }
        __syncthreads();
#pragma unroll
        for (int bi = 0; bi < 2; ++bi) {
            const int blk = wid * 2 + bi, d0 = 32 * (blk >> 2), e0 = 32 * (blk & 3);
#pragma unroll
            for (int g = 0; g < 4; ++g) *(uint2*)(ST + (e0 + l32) * SK + d0 + 8 * g + 4 * hi) = pk4(S[bi][4 * g], S[bi][4 * g + 1], S[bi][4 * g + 2], S[bi][4 * g + 3]);
        }
        if (c + 1 < nch) GSTAGE();
        __syncthreads();
    }
#undef GLOAD
#undef GSTAGE
#undef TOK
    if (ctx) {
#pragma unroll
        for (int bi = 0; bi < 2; ++bi) {
            const int blk = wid * 2 + bi, d0 = 32 * (blk >> 2), e0 = 32 * (blk & 3);
            float* so = p.out + O_SGDN + ((((size_t)b * DEPTH + l) * 2 + dir) * 4 + h) * 128 * 128 + e0 + l32;
#pragma unroll
            for (int r = 0; r < 16; ++r) so[(size_t)(d0 + crow(r, hi)) * 128] = S[bi][r];
        }
    }
}
}

namespace gla {
using att::bf16x8; using att::f32x16; using att::crow; using gdn::mm; using gdn::pk4;
constexpr int C = 32, SQ = 72, SS = 40;
constexpr int OFF_QE = 0, OFF_KN = OFF_QE + C * SQ * 2, OFF_KET = OFF_KN + C * SQ * 2, OFF_VT = OFF_KET + 64 * SS * 2, OFF_ATT = OFF_VT + 128 * SS * 2, OFF_ST = OFF_ATT + C * SS * 2,
              OFF_LA = OFF_ST + 128 * SQ * 2, OFF_EB = OFF_LA + C * 64 * 4, GLA_LDS = OFF_EB + 256;
__device__ __forceinline__ void gla_chunked(const Params& p, int l, bool ctx, int b, int h, int dir, unsigned char* lds) {
    const int tid = opaque_tid(), wid = tid >> 6, lane = tid & 63, l32 = lane & 31, hi = lane >> 5;
    const int T = ctx ? CT : ::LT; const size_t m0 = ctx ? (size_t)b * CT : (size_t)MC + (size_t)b * ::LT;
    const bf16_t* Z = WSP(bf16_t, WS_Z); const float* LA = WSP(float, dir ? WS_AB : WS_AF);
    float* O = WSP(float, dir ? WS_GOB : WS_GOF);
    bf16_t* Qe = (bf16_t*)(lds + OFF_QE); bf16_t* Kn = (bf16_t*)(lds + OFF_KN); bf16_t* KeT = (bf16_t*)(lds + OFF_KET); bf16_t* VT = (bf16_t*)(lds + OFF_VT);
    bf16_t* ATT = (bf16_t*)(lds + OFF_ATT); bf16_t* ST = (bf16_t*)(lds + OFF_ST); float* la = (float*)(lds + OFF_LA); float* eB = (float*)(lds + OFF_EB);
    const int nch = T / C;
#define TOK(c, s_) (m0 + (dir ? T - 1 - ((c) * C + (s_)) : (c) * C + (s_)))
    const int d0 = 32 * (wid >> 2), e0 = 32 * (wid & 3);
    f32x16 S;
    if (ctx) S = f32x16{};
    else {
        const float* s0 = p.in[I_SGLA] + ((((size_t)b * DEPTH + l) * 2 + dir) * 4 + h) * 64 * 128 + e0 + l32;
#pragma unroll
        for (int r = 0; r < 16; ++r) S[r] = s0[(size_t)(d0 + crow(r, hi)) * 128];
    }
    const int ts = tid >> 4, dc = (tid & 15) * 4, vs = tid >> 5, vc = (tid & 31) * 4;
    vf4 pq, pk, pl, pv0, pv1;
#define GLOAD(c) do { const size_t mt = TOK(c, ts), ma = TOK(c, vs), mb = TOK(c, vs + 16); \
        pq = ld4bf(Z + mt * NINP + Z_GLQ + h * 64 + dc); pk = ld4bf(Z + mt * NINP + Z_GLK + h * 64 + dc); pl = *(const vf4*)(LA + mt * 256 + h * 64 + dc); \
        pv0 = ld4bf(Z + ma * NINP + Z_GLV + h * 128 + vc); pv1 = ld4bf(Z + mb * NINP + Z_GLV + h * 128 + vc); } while (0)
#define WRITE_ST() do { _Pragma("unroll") for (int g = 0; g < 4; ++g) *(uint2*)(ST + (e0 + l32) * SQ + d0 + 8 * g + 4 * hi) = pk4(S[4 * g], S[4 * g + 1], S[4 * g + 2], S[4 * g + 3]); } while (0)
#define GIMAGES() do { vf4 pre = (vf4){0.f, 0.f, 0.f, 0.f}, tot = pre; \
        _Pragma("unroll 8") for (int t_ = 0; t_ < C; ++t_) { const vf4 v_ = *(const vf4*)(la + t_ * 64 + dc); tot += v_; if (t_ <= ts) pre += v_; } \
        float qe[4], kn[4]; \
        _Pragma("unroll") for (int j = 0; j < 4; ++j) { qe[j] = pq[j] * 0.125f * __expf(pre[j]); kn[j] = pk[j] * __expf(fminf(-pre[j], 80.f)); \
            KeT[(dc + j) * SS + ts] = f2bf(pk[j] * __expf(tot[j] - pre[j])); } \
        *(uint2*)(Qe + ts * SQ + dc) = pk4(qe[0], qe[1], qe[2], qe[3]); *(uint2*)(Kn + ts * SQ + dc) = pk4(kn[0], kn[1], kn[2], kn[3]); \
        if (ts == 0) { _Pragma("unroll") for (int j = 0; j < 4; ++j) eB[dc + j] = __expf(tot[j]); } \
        _Pragma("unroll") for (int j = 0; j < 4; ++j) { VT[(vc + j) * SS + vs] = f2bf(pv0[j]); VT[(vc + j) * SS + vs + 16] = f2bf(pv1[j]); } } while (0)
    __syncthreads();
    GLOAD(0);
    WRITE_ST();
    *(vf4*)(la + ts * 64 + dc) = pl;
    __syncthreads();
    GIMAGES();
    __syncthreads();
    for (int c = 0; c < nch; ++c) {
        if (c + 1 < nch) GLOAD(c + 1);
        f32x16 o1 = f32x16{};
        if (wid == 0) {
            const f32x16 kq = mm<64>(Kn, SQ, Qe, SQ, l32, hi, f32x16{});
            float a[16];
#pragma unroll
            for (int r = 0; r < 16; ++r) a[r] = (l32 >= crow(r, hi)) ? kq[r] : 0.f;
#pragma unroll
            for (int g = 0; g < 4; ++g) *(uint2*)(ATT + l32 * SS + 8 * g + 4 * hi) = pk4(a[4 * g], a[4 * g + 1], a[4 * g + 2], a[4 * g + 3]);
        } else if (wid >= 4) {
            o1 = mm<64>(Qe, SQ, ST + (32 * (wid - 4)) * SQ, SQ, l32, hi, f32x16{});
        }
        __syncthreads();
        if (wid >= 4) {
            const int eo = 32 * (wid - 4);
            o1 = mm<32>(ATT, SS, VT + eo * SS, SS, l32, hi, o1);
#pragma unroll
            for (int r = 0; r < 16; ++r) O[TOK(c, crow(r, hi)) * 512 + h * 128 + eo + l32] = o1[r];
        }
#pragma unroll
        for (int r = 0; r < 16; ++r) S[r] *= eB[d0 + crow(r, hi)];
        S = mm<32>(KeT + d0 * SS, SS, VT + e0 * SS, SS, l32, hi, S);
        __syncthreads();
        WRITE_ST();
        if (c + 1 < nch) *(vf4*)(la + ts * 64 + dc) = pl;
        __syncthreads();
        if (c + 1 < nch) GIMAGES();
        __syncthreads();
    }
#undef GLOAD
#undef WRITE_ST
#undef GIMAGES
#undef TOK
    if (ctx) {
        float* so = p.out + O_SGLA + ((((size_t)b * DEPTH + l) * 2 + dir) * 4 + h) * 64 * 128 + e0 + l32;
#pragma unroll
        for (int r = 0; r < 16; ++r) so[(size_t)(d0 + crow(r, hi)) * 128] = S[r];
    }
}
}
#define LAS __attribute__((address_space(3)))
constexpr int LDS_BYTES = 147456, XBW_OFF = LDS_BYTES - 64;
constexpr int NPH = 1 + DEPTH * 12;
#ifndef DBG_NLAYERS
#define DBG_NLAYERS DEPTH
#endif

#ifndef DUPKIND
#define DUPKIND 0
#endif
__device__ __forceinline__ int opaque_int(int v) { asm volatile("" : "+s"(v)); return v; }
#ifndef MIXMASK
#define MIXMASK 0xFF
#endif
#define FOR_ITEMS(it, n, o, w) for (int bo_ = (o) * (int)gridDim.x / 256, bw_ = ((w) * (int)gridDim.x / 256) > 0 ? ((w) * (int)gridDim.x / 256) : 1, \
                                    it = ((int)blockIdx.x >= bo_ && (int)blockIdx.x < bo_ + bw_) ? (int)blockIdx.x - bo_ : (n); it < (n); it += bw_)

#ifndef SPLITK
#define SPLITK 0
#endif
constexpr int FLAG_WORD0 = 8192;
constexpr int QCTR_WORD0 = 1024;
constexpr int NI_GDNL = LB * 8, NI_GLAL = LB * 8, NI_GDNC = CB * 8, NI_GQAL = LB * 16, NI_NAL = LB * 16, NI_GLAC = CB * 8, NI_NAC = CB * 4, NI_GQAC = CB * 4;
#define KM(k) (1 + ((DUPKIND >> (k)) & 1))
constexpr int Q0 = NI_GDNL * KM(0), Q1 = Q0 + NI_GLAL * KM(1), Q2 = Q1 + NI_GDNC * KM(2), Q3 = Q2 + NI_GQAL * KM(3), Q4 = Q3 + NI_NAL * KM(4), Q5 = Q4 + NI_GLAC * KM(5), Q6 = Q5 + NI_NAC * KM(6), Q7 = Q6 + NI_GQAC * KM(7);
__device__ __forceinline__ void phase_mix(const Params& p, int l, unsigned char* lds, int rep) {
    const int tid = opaque_tid();
    float* smem = (float*)lds;
    const bf16_t* NAQ = WSP(bf16_t, WS_NAQ); const bf16_t* NAK = WSP(bf16_t, WS_NAK); const bf16_t* NAV = WSP(bf16_t, WS_NAV);
    const bf16_t* GQ = WSP(bf16_t, WS_GQ); const bf16_t* GK = WSP(bf16_t, WS_GK); const bf16_t* GV = WSP(bf16_t, WS_GV);
    bf16_t* MRG = WSP(bf16_t, WS_MRG);
    unsigned* qctr = WSP(unsigned, WS_CTL) + QCTR_WORD0 + 64 * l + 16 * rep;
    volatile int* qslot = (volatile int*)(lds + XBW_OFF + 16);
    for (;;) {
        __syncthreads();
        if (tid == 0) *qslot = (int)__hip_atomic_fetch_add(qctr, 1u, __ATOMIC_RELAXED, __HIP_MEMORY_SCOPE_AGENT);
        __syncthreads();
        const int q = __builtin_amdgcn_readfirstlane(*qslot);
        if (q >= Q7) break;
        if (q < Q0) { const int it = q % NI_GDNL; gdn::gdn_chunked(p, l, false, it / 8, (it / 2) % 4, it % 2, lds); }
        else if (q < Q1) { const int it = (q - Q0) % NI_GLAL; gla::gla_chunked(p, l, false, it / 8, (it / 2) % 4, it % 2, lds); }
        else if (q < Q2) { const int it = (q - Q1) % NI_GDNC; gdn::gdn_chunked(p, l, true, it / 8, (it / 2) % 4, it % 2, lds); }
        else if (q < Q3) {
            const int it = (q - Q2) % NI_GQAL, b = it / 16, qh = (it / 4) % 4, qb = it % 4, kvh = qh >> 1;
            const size_t r0 = (size_t)MC + (size_t)b * LT;
            att::SrcTwo src{WSP(bf16_t, WS_CGK) + ((size_t)b * DEPTH + l) * 256 * 256 + kvh * 128, WSP(bf16_t, WS_CGV) + ((size_t)b * DEPTH + l) * 256 * 256 + kvh * 128,
                            GK + r0 * 256 + kvh * 128, GV + r0 * 256 + kvh * 128, 256};
            att::attn_body<2>(GQ + (r0 + qb * 256) * 512 + qh * 128, src, MRG + (r0 + qb * 256) * DM + 1024 + qh * 128, 4 + LT / 64, (char*)lds, att::NoBias{});
        }
        else if (q < Q4) {
            const int it = (q - Q3) % NI_NAL, b = it / 16, h = (it / 4) % 4, qb = it % 4;
            const int kr0 = qb == 0 ? 0 : qb == 1 ? 0 : qb == 2 ? 4 : 8, nrows = (qb == 0 || qb == 3) ? 8 : 12;
            const size_t r0 = (size_t)MC + (size_t)b * LT;
            float* tab = (float*)(lds + att::SHM_ATTN);
            if (tid < 15 * 31) tab[tid] = p.in[I_RPB][((size_t)l * 4 + h) * 15 * 31 + tid] * (1.0f / att::SCALE);
            att::SrcTwo src{WSP(bf16_t, WS_CNAK) + ((size_t)b * DEPTH + l) * 256 * 512 + h * 128, WSP(bf16_t, WS_CNAV) + ((size_t)b * DEPTH + l) * 256 * 512 + h * 128,
                            NAK + (r0 + kr0 * 64) * 512 + h * 128, NAV + (r0 + kr0 * 64) * 512 + h * 128, 512};
            att::attn_body<1>(NAQ + (r0 + qb * 256) * 512 + h * 128, src, MRG + (r0 + qb * 256) * DM + 0 + h * 128, 4 + nrows, (char*)lds, att::NaBias{tab, qb * 256, kr0});
        }
        else if (q < Q5) { const int it = (q - Q4) % NI_GLAC; gla::gla_chunked(p, l, true, it / 8, (it / 2) % 4, it % 2, lds); }
        else if (q < Q6) {
            const int it = (q - Q5) % NI_NAC, b = it / 4, h = it % 4; const size_t r0 = (size_t)b * CT;
            att::SrcOne src{NAK + r0 * 512 + h * 128, NAV + r0 * 512 + h * 128, 512};
            att::attn_body<2>(NAQ + r0 * 512 + h * 128, src, MRG + r0 * DM + 0 + h * 128, CT / 64, (char*)lds, att::NoBias{});
        }
        else {
            const int it = (q - Q6) % NI_GQAC, b = it / 4, qh = it % 4, kvh = qh >> 1; const size_t r0 = (size_t)b * CT;
            att::SrcOne src{GK + r0 * 256 + kvh * 128, GV + r0 * 256 + kvh * 128, 256};
            att::attn_body<2>(GQ + r0 * 512 + qh * 128, src, MRG + r0 * DM + 1024 + qh * 128, CT / 64, (char*)lds, att::NoBias{});
        }
    }
}

static_assert(att::SHM_ATTN + 15 * 31 * 4 + 2048 <= (size_t)XBW_OFF, "LDS map");
static_assert((QCTR_WORD0 + 64 * DEPTH) < 4096, "ctl");
constexpr int BAR_WORD0 = 4096;
static_assert((BAR_WORD0 + XCD_BAR_WORDS) * 4 <= (int)CTL_BYTES, "ctl");

__global__ void __launch_bounds__(512, 2) fwd(Params p) {
    extern __shared__ __attribute__((aligned(16))) unsigned char lds[];
    const int tid = threadIdx.x;
    volatile LAS unsigned* xbw = (volatile LAS unsigned*)((LAS unsigned char*)lds + XBW_OFF);
    if (tid < 4) xbw[tid] = 0u;
    __syncthreads();
    XcdBarrier bar; bar.bar = WSP(unsigned, WS_CTL) + BAR_WORD0; bar.x = 0; bar.st = xbw;
    if (p.ph_hi - p.ph_lo > 1) bar = xcd_barrier_post(WSP(unsigned, WS_CTL) + BAR_WORD0, xbw);
#ifndef PHMASK
#define PHMASK 0x1FFF
#endif
#define IN(k) (p.ph_lo <= (k) && (k) < p.ph_hi)
#define INL(j) (((PHMASK >> ((j) + 1)) & 1) && IN(pb + (j)))
#ifndef DUPMASK
#define DUPMASK 0
#endif
#define DUP(j) ((DUPMASK >> ((j) + 1)) & 1)
#define SEAM(k) do { if (IN(k) && IN((k) + 1)) xcd_barrier(bar); } while (0)
    LAS unsigned char* ldsl = (LAS unsigned char*)lds;
    bf16_t* H = WSP(bf16_t, WS_H); bf16_t* ACT = WSP(bf16_t, WS_ACT); float* X = WSP(float, WS_X); float* Z = WSP(float, WS_Z); bf16_t* MRG = WSP(bf16_t, WS_MRG);

    if ((PHMASK & 1) && IN(0)) { int reps_ = 1 + (DUPMASK & 1); asm volatile("" : "+s"(reps_)); for (int rep_ = 0; rep_ < reps_; ++rep_) { const Params q = opaque_params(p); phase_prologue(q, (float*)lds); __syncthreads(); } }
    SEAM(0);
    for (int l = 0; l < DBG_NLAYERS; ++l) {
        const int pb = 1 + l * 12;
        const float* modl = WSP(float, WS_MODV) + (size_t)l * NCOND * NMOD;
        if (INL(0)) { int reps_ = 1 + DUP(0); asm volatile("" : "+s"(reps_)); for (int rep_ = 0; rep_ < reps_; ++rep_) { const Params q = opaque_params(p); phase_norm(q, l, 0); __syncthreads(); } }
        SEAM(pb + 0);
        if (INL(1)) {
            pg8::Gemm g{H, WSP(bf16_t, WS_WGU) + ((size_t)l * 2 + 0) * NGU * DM, M, NGU, DM}; pg8::StaticOrder S; S.init(M, NGU, DM, (int)gridDim.x, (int)blockIdx.x);
            pg8::EpiSwiGLU E{ACT, FF};
            for (int r_ = 0, n_ = opaque_int(1 + DUP(1)); r_ < n_; ++r_) pg8::gemm_phase<pg8::EpiSwiGLU, pg8::StaticOrder, false>(ldsl, g, S, E, nullptr);
#if CONV_FILLER
            if (l + 1 < DBG_NLAYERS) {
                const int nw_ = (M / 256) * (NGU / 256), G_ = (int)gridDim.x; int f0_ = nw_ % G_; if (nw_ < G_) f0_ = 0;
                if ((int)blockIdx.x >= f0_) { const Params q = opaque_params(p); mod_layer(q, l + 1, (int)blockIdx.x - f0_, G_ - f0_, (float*)lds); }
            }
#endif
        }
        SEAM(pb + 1);
        if (INL(2)) {
            pg8::Gemm g{ACT, WSP(bf16_t, WS_WDN) + ((size_t)l * 2 + 0) * DM * FF, M, DM, FF}; pg8::StaticOrder S; S.init(M, DM, FF, (int)gridDim.x, (int)blockIdx.x, SPLITK);
            pg8::EpiResid E{X, X, DM, modl + 2 * DM, 0.5f, Z, WSP(unsigned, WS_CTL) + FLAG_WORD0, 8u * (unsigned)(l * 3 + 1)};
            pg8::gemm_phase<pg8::EpiResid, pg8::StaticOrder, false>(ldsl, g, S, E, nullptr);
#if CONV_FILLER
            if (l + 1 < DBG_NLAYERS) {
                const int nw_ = (M / 256) * (DM / 256), G_ = (int)gridDim.x; int f0_ = nw_ - G_; if (f0_ < 0 || f0_ >= G_) f0_ = 0;
                if ((int)blockIdx.x >= f0_) { const Params q = opaque_params(p); conv_layer_tiles(q, l + 1, 0, (NT_L * 2 / 5), (int)blockIdx.x - f0_, G_ - f0_, (float*)lds); }
            }
#endif
            if (opaque_int(DUP(2))) { pg8::EpiResid E2{X, Z, DM, modl + 2 * DM, 0.5f, Z, WSP(unsigned, WS_CTL) + FLAG_WORD0, 0u}; pg8::gemm_phase<pg8::EpiResid, pg8::StaticOrder, false>(ldsl, g, S, E2, nullptr); }
        }
        SEAM(pb + 2);
        if (INL(3)) { int reps_ = 1 + DUP(3); asm volatile("" : "+s"(reps_)); for (int rep_ = 0; rep_ < reps_; ++rep_) { const Params q = opaque_params(p); phase_norm(q, l, 1); __syncthreads(); } }
        SEAM(pb + 3);
        if (INL(4)) {
            pg8::Gemm g{H, WSP(bf16_t, WS_WIN) + (size_t)l * NINP * DM, M, NINP, DM}; pg8::StaticOrder S; S.init(M, NINP, DM, (int)gridDim.x, (int)blockIdx.x);
            pg8::EpiBf16Plain E{WSP(bf16_t, WS_Z), NINP};
            for (int r_ = 0, n_ = opaque_int(1 + DUP(4)); r_ < n_; ++r_) pg8::gemm_phase<pg8::EpiBf16Plain, pg8::StaticOrder, false>(ldsl, g, S, E, nullptr);
        }
        SEAM(pb + 4);
        if (INL(5)) { int reps_ = 1 + DUP(5); asm volatile("" : "+s"(reps_)); for (int rep_ = 0; rep_ < reps_; ++rep_) { const Params q = opaque_params(p); phase_prep(q, l); __syncthreads(); } }
        SEAM(pb + 5);
        if (INL(6)) { int reps_ = 1 + DUP(6); asm volatile("" : "+s"(reps_)); for (int rep_ = 0; rep_ < reps_; ++rep_) { const Params q = opaque_params(p); phase_mix(q, l, lds, rep_); __syncthreads(); } }
        SEAM(pb + 6);
        if (INL(7)) { int reps_ = 1 + DUP(7); asm volatile("" : "+s"(reps_)); for (int rep_ = 0; rep_ < reps_; ++rep_) { const Params q = opaque_params(p); phase_post(q, l); __syncthreads(); } }
        SEAM(pb + 7);
        if (INL(8)) {
            pg8::Gemm g{MRG, WSP(bf16_t, WS_WOUT) + (size_t)l * DM * DM, M, DM, DM}; pg8::StaticOrder S; S.init(M, DM, DM, (int)gridDim.x, (int)blockIdx.x, SPLITK);
            pg8::EpiResid E{X, X, DM, modl + 5 * DM, 1.0f, Z, WSP(unsigned, WS_CTL) + FLAG_WORD0, 8u * (unsigned)(l * 3 + 2)};
            pg8::gemm_phase<pg8::EpiResid, pg8::StaticOrder, false>(ldsl, g, S, E, nullptr);
#if CONV_FILLER
            if (l + 1 < DBG_NLAYERS) {
                const int nw_ = (M / 256) * (DM / 256), G_ = (int)gridDim.x; int f0_ = nw_ - G_; if (f0_ < 0 || f0_ >= G_) f0_ = 0;
                if ((int)blockIdx.x >= f0_) { const Params q = opaque_params(p); conv_layer_tiles(q, l + 1, (NT_L * 2 / 5), (NT_L * 3 / 5), (int)blockIdx.x - f0_, G_ - f0_, (float*)lds); }
            }
#endif
            if (opaque_int(DUP(8))) { pg8::EpiResid E2{X, Z, DM, modl + 5 * DM, 1.0f, Z, WSP(unsigned, WS_CTL) + FLAG_WORD0, 0u}; pg8::gemm_phase<pg8::EpiResid, pg8::StaticOrder, false>(ldsl, g, S, E2, nullptr); }
        }
        SEAM(pb + 8);
        if (INL(9)) { int reps_ = 1 + DUP(9); asm volatile("" : "+s"(reps_)); for (int rep_ = 0; rep_ < reps_; ++rep_) { const Params q = opaque_params(p); phase_norm(q, l, 2); __syncthreads(); } }
        SEAM(pb + 9);
        if (INL(10)) {
            pg8::Gemm g{H, WSP(bf16_t, WS_WGU) + ((size_t)l * 2 + 1) * NGU * DM, M, NGU, DM}; pg8::StaticOrder S; S.init(M, NGU, DM, (int)gridDim.x, (int)blockIdx.x);
            pg8::EpiSwiGLU E{ACT, FF};
            pg8::gemm_phase<pg8::EpiSwiGLU, pg8::StaticOrder, false>(ldsl, g, S, E, nullptr);
        }
        SEAM(pb + 10);
        if (INL(11)) {
            pg8::Gemm g{ACT, WSP(bf16_t, WS_WDN) + ((size_t)l * 2 + 1) * DM * FF, M, DM, FF}; pg8::StaticOrder S; S.init(M, DM, FF, (int)gridDim.x, (int)blockIdx.x, SPLITK);
            pg8::EpiResid E{X, (l == DEPTH - 1) ? p.out : X, DM, modl + 8 * DM, 0.5f, Z, WSP(unsigned, WS_CTL) + FLAG_WORD0, 8u * (unsigned)(l * 3 + 3)};
            pg8::gemm_phase<pg8::EpiResid, pg8::StaticOrder, false>(ldsl, g, S, E, nullptr);
#if CONV_FILLER
            if (l + 1 < DBG_NLAYERS) {
                const int nw_ = (M / 256) * (DM / 256), G_ = (int)gridDim.x; int f0_ = nw_ - G_; if (f0_ < 0 || f0_ >= G_) f0_ = 0;
                if ((int)blockIdx.x >= f0_) { const Params q = opaque_params(p); conv_layer_tiles(q, l + 1, (NT_L * 3 / 5), NT_L, (int)blockIdx.x - f0_, G_ - f0_, (float*)lds); }
            }
#endif
        }
        SEAM(pb + 11);
    }
#undef IN
#undef SEAM
}

#ifndef MULTI_LAUNCH
#define MULTI_LAUNCH 0
#endif
extern "C" void kernel_launch(void* const* d_in, const int* in_sizes, int n_in, void* d_out, int out_size, void* d_ws, size_t ws_size, hipStream_t stream) {
    static int grid = 0;
    if (grid == 0) {
        if (n_in != N_IN || (size_t)out_size != O_END || ws_size < WS_END) { fprintf(stderr, "kernel_launch: shape mismatch n_in %d out %d ws %zu (need %zu)\n", n_in, out_size, ws_size, (size_t)WS_END); grid = -1; return; }
        int dev = 0, cus = 0, per_cu = 0;
        if (hipGetDevice(&dev) != hipSuccess || hipDeviceGetAttribute(&cus, hipDeviceAttributeMultiprocessorCount, dev) != hipSuccess) { grid = -1; return; }
        if (hipFuncSetAttribute((const void*)fwd, hipFuncAttributeMaxDynamicSharedMemorySize, LDS_BYTES) != hipSuccess) { fprintf(stderr, "kernel_launch: hipFuncSetAttribute failed\n"); grid = -1; return; }
        if (hipOccupancyMaxActiveBlocksPerMultiprocessor(&per_cu, (const void*)fwd, 512, LDS_BYTES) != hipSuccess || per_cu < 1) { fprintf(stderr, "kernel_launch: occupancy query says %d\n", per_cu); (void)hipGetLastError(); }
        grid = cus;
    }
    if (grid < 0) return;
    (void)hipMemsetAsync((char*)d_ws + WS_CTL, 0, CTL_BYTES, stream);
    Params p{};
    for (int i = 0; i < N_IN; ++i) p.in[i] = (const float*)d_in[i];
    p.out = (float*)d_out; p.ws = (unsigned char*)d_ws;
#if MULTI_LAUNCH
    for (int ph = 0; ph < 1 + DBG_NLAYERS * 12; ++ph) { p.ph_lo = ph; p.ph_hi = ph + 1; hipLaunchKernelGGL(fwd, dim3(grid), dim3(512), LDS_BYTES, stream, p); }
#else
    p.ph_lo = 0; p.ph_hi = NPH; hipLaunchKernelGGL(fwd, dim3(grid), dim3(512), LDS_BYTES, stream, p);
#endif
    const hipError_t le = hipPeekAtLastError();
    if (le != hipSuccess) fprintf(stderr, "kernel_launch: launch failed: %s\n", hipGetErrorName(le));
}
```

```cpp
#include <hip/hip_runtime.h>
#include <cstdio>
#include <cstdint>

#ifndef CB_
#define CB_ 16
#endif
#ifndef LB_
#define LB_ 8
#endif
#ifndef DEPTH_
#define DEPTH_ 4
#endif
constexpr int DM = 2048, DEPTH = DEPTH_, CB = CB_, CT = 256, LB = LB_, LT = 1024;
constexpr int MC = CB * CT, ML = LB * LT, M = MC + ML;
constexpr int FF = 5504, NGU = 2 * FF, NIN = 6192, NINP = 6400, NMOD = 9 * DM, NCOND = 1 + LB;
constexpr float EPS = 1e-6f;
constexpr int Z_NAQ = 0, Z_NAK = 512, Z_NAV = 1024, Z_GLQ = 1536, Z_GLK = 1792, Z_GLV = 2048, Z_GLR = 2560, Z_GF = 3072, Z_GB = 3088,
              Z_GQQ = 3104, Z_GQK = 3616, Z_GQV = 3872, Z_DQKV = 4128, Z_DZ = 5664, Z_DB = 6176, Z_DA = 6184;
static_assert(Z_DA + 8 == NIN, "split");
enum { I_XP = 0, I_XS, I_CNAK, I_CNAV, I_CGK, I_CGV, I_SGLA, I_SGDN, I_C, I_CCTX, I_NORMG, I_WMOD, I_BMOD, I_GU, I_DOWN, I_WIN, I_WOUT, I_NAQKN, I_RPB,
       I_GUP, I_GBIAS, I_GLAON, I_GQAQKN, I_CONV, I_ALOG, I_DTB, I_GDNON, N_IN };
constexpr size_t O_YP = 0, O_YS = O_YP + (size_t)MC * DM, O_NAK = O_YS + (size_t)ML * DM, O_NAV = O_NAK + (size_t)CB * DEPTH * 4 * CT * 128,
                 O_GK = O_NAV + (size_t)CB * DEPTH * 4 * CT * 128, O_GV = O_GK + (size_t)CB * DEPTH * 2 * CT * 128,
                 O_SGLA = O_GV + (size_t)CB * DEPTH * 2 * CT * 128, O_SGDN = O_SGLA + (size_t)CB * DEPTH * 2 * 4 * 64 * 128,
                 O_END = O_SGDN + (size_t)CB * DEPTH * 2 * 4 * 128 * 128;
constexpr size_t al256(size_t x) { return (x + 255) & ~(size_t)255; }
constexpr size_t WS_CTL = 0, CTL_BYTES = 1u << 20;
constexpr size_t WS_WGU = CTL_BYTES;
constexpr size_t WS_WDN = WS_WGU + (size_t)DEPTH * 2 * NGU * DM * 2;
constexpr size_t WS_WIN = WS_WDN + (size_t)DEPTH * 2 * DM * FF * 2;
constexpr size_t WS_WOUT = WS_WIN + (size_t)DEPTH * NINP * DM * 2;
constexpr size_t WS_MODV = WS_WOUT + (size_t)DEPTH * DM * DM * 2;
constexpr size_t WS_ROPE = al256(WS_MODV + (size_t)DEPTH * NCOND * NMOD * 4);
constexpr size_t WS_X = al256(WS_ROPE + 2 * 64 * 32 * 4);
constexpr size_t WS_H = WS_X + (size_t)M * DM * 4;
constexpr size_t WS_ACT = WS_H + (size_t)M * DM * 2;
constexpr size_t WS_Z = WS_ACT + (size_t)M * FF * 2;
constexpr size_t WS_MRG = WS_Z + (size_t)M * NINP * 4;
constexpr size_t WS_NAQ = WS_MRG + (size_t)M * DM * 2;
constexpr size_t WS_NAK = WS_NAQ + (size_t)M * 512 * 2;
constexpr size_t WS_NAV = WS_NAK + (size_t)M * 512 * 2;
constexpr size_t WS_GQ = WS_NAV + (size_t)M * 512 * 2;
constexpr size_t WS_GK = WS_GQ + (size_t)M * 512 * 2;
constexpr size_t WS_GV = WS_GK + (size_t)M * 256 * 2;
constexpr size_t WS_CNAK = WS_GV + (size_t)M * 256 * 2;
constexpr size_t WS_CNAV = WS_CNAK + (size_t)LB * DEPTH * 256 * 512 * 2;
constexpr size_t WS_CGK = WS_CNAV + (size_t)LB * DEPTH * 256 * 512 * 2;
constexpr size_t WS_CGV = WS_CGK + (size_t)LB * DEPTH * 256 * 256 * 2;
constexpr size_t WS_AF = WS_CGV + (size_t)LB * DEPTH * 256 * 256 * 2;
constexpr size_t WS_AB = WS_AF + (size_t)M * 256 * 4;
constexpr size_t WS_DQ = WS_AB + (size_t)M * 256 * 4;
constexpr size_t WS_DK = WS_DQ + (size_t)M * 512 * 4;
constexpr size_t WS_DV = WS_DK + (size_t)M * 512 * 4;
constexpr size_t WS_DBA = WS_DV + (size_t)M * 512 * 4;
constexpr size_t WS_GOF = WS_DBA + (size_t)M * 16 * 4;
constexpr size_t WS_GOB = WS_GOF + (size_t)M * 512 * 4;
constexpr size_t WS_DOF = WS_GOB + (size_t)M * 512 * 4;
constexpr size_t WS_DOB = WS_DOF + (size_t)M * 512 * 4;
constexpr size_t WS_END = WS_DOB + (size_t)M * 512 * 4;

typedef unsigned short bf16_t;
struct Params { const float* in[N_IN]; float* out; unsigned char* ws; int ph_lo, ph_hi; };
static_assert(sizeof(Params) == N_IN * 8 + 8 + 8 + 8, "no padding");

#define WSP(T, off) ((T*)(p.ws + (off)))
__device__ __forceinline__ int opaque_tid() { int t = (int)threadIdx.x; asm volatile("" : "+v"(t)); return t; }
__device__ __forceinline__ Params opaque_params(const Params& p) { Params q = p; unsigned long long w = (unsigned long long)q.ws; asm volatile("" : "+s"(w)); q.ws = (unsigned char*)w; return q; }

typedef float vf4 __attribute__((ext_vector_type(4)));
__device__ __forceinline__ float bf2f(unsigned short v) { return __uint_as_float((unsigned)v << 16); }
__device__ __forceinline__ vf4 ld4bf(const unsigned short* p) { const uint2 w = *(const uint2*)p; vf4 r; r.x = __uint_as_float(w.x << 16); r.y = __uint_as_float(w.x & 0xFFFF0000u); r.z = __uint_as_float(w.y << 16); r.w = __uint_as_float(w.y & 0xFFFF0000u); return r; }
__device__ __forceinline__ void ld8bf(const unsigned short* p, vf4& a, vf4& b) { const uint4 w = *(const uint4*)p;
    a.x = __uint_as_float(w.x << 16); a.y = __uint_as_float(w.x & 0xFFFF0000u); a.z = __uint_as_float(w.y << 16); a.w = __uint_as_float(w.y & 0xFFFF0000u);
    b.x = __uint_as_float(w.z << 16); b.y = __uint_as_float(w.z & 0xFFFF0000u); b.z = __uint_as_float(w.w << 16); b.w = __uint_as_float(w.w & 0xFFFF0000u); }
__device__ __forceinline__ float wave_sum(float v) {
#pragma unroll
    for (int o = 32; o >= 1; o >>= 1) v += __shfl_xor(v, o);
    return v;
}
__device__ __forceinline__ bf16_t f2bf(float f) { unsigned u = __float_as_uint(f); u += 0x7FFFu + ((u >> 16) & 1u); return (bf16_t)(u >> 16); }
__device__ __forceinline__ unsigned pack2(float a, float b) { return (unsigned)f2bf(a) | ((unsigned)f2bf(b) << 16); }
__device__ __forceinline__ float silu_f(float x) { return x / (1.f + expf(-x)); }
__device__ __forceinline__ float softplus_f(float x) { return fmaxf(x, 0.f) + log1pf(expf(-fabsf(x))); }
__device__ __forceinline__ float logsigmoid_f(float x) { return fminf(x, 0.f) - log1pf(expf(-fabsf(x))); }
__device__ __forceinline__ int cond_of_row(int m) { return m < MC ? 0 : 1 + (m - MC) / LT; }
#ifndef CONV_FILLER
#define CONV_FILLER 1
#endif
__device__ __forceinline__ void conv_tile(const float* __restrict__ src, int ld_src, int ncols_src, int k0, int c0, bf16_t* __restrict__ dst, int ld_dst, int n0, float* tile) {
    const int tid = opaque_tid();
    {
        const int r = tid >> 3, c = (tid & 7) * 8;
        float4 a = make_float4(0.f, 0.f, 0.f, 0.f), b = a;
        if (c0 + c + 8 <= ncols_src) {
            const float* s = src + (size_t)(k0 + r) * ld_src + c0 + c;
            a = *(const float4*)s; b = *(const float4*)(s + 4);
        }
        float* t = tile + r * 65 + c;
        t[0] = a.x; t[1] = a.y; t[2] = a.z; t[3] = a.w; t[4] = b.x; t[5] = b.y; t[6] = b.z; t[7] = b.w;
    }
    __syncthreads();
    {
        const int n = tid >> 3, ks = (tid & 7) * 8;
        const float* t = tile + ks * 65 + n;
        uint4 w;
        w.x = pack2(t[0 * 65], t[1 * 65]); w.y = pack2(t[2 * 65], t[3 * 65]); w.z = pack2(t[4 * 65], t[5 * 65]); w.w = pack2(t[6 * 65], t[7 * 65]);
        *(uint4*)(dst + (size_t)(n0 + n) * ld_dst + k0 + ks) = w;
    }
    __syncthreads();
}

constexpr int MOD_ITEMS = DEPTH * (NMOD / 128);
constexpr int TGU_KT = DM / 64, TGU_NT = NGU / 64, TDN_KT = FF / 64, TDN_NT = DM / 64, TIN_KT = DM / 64, TIN_NT = NINP / 64, TOUT_KT = DM / 64, TOUT_NT = DM / 64;
constexpr int TL_GU = 2 * TGU_KT * TGU_NT, TL_DN = 2 * TDN_KT * TDN_NT, TL_IN = TIN_KT * TIN_NT, TL_OUT = TOUT_KT * TOUT_NT, NT_L = TL_GU + TL_DN + TL_IN + TL_OUT;
__device__ __forceinline__ void conv_layer_tiles(const Params& p, int l, int t_begin, int t_end, int first, int stride, float* s_tile) {
    for (int it = t_begin + first; it < t_end; it += stride) {
        if (it < TL_GU) {
            const int mat = l * 2 + it / (TGU_KT * TGU_NT), r = it % (TGU_KT * TGU_NT), kt = r / TGU_NT, nt = r % TGU_NT;
            const int n0 = nt * 64, t256 = n0 / 256, c = n0 % 256;
            const int c0 = c < 128 ? 128 * t256 + c : FF + 128 * t256 + (c - 128);
            conv_tile(p.in[I_GU] + (size_t)mat * DM * NGU, NGU, NGU, kt * 64, c0, WSP(bf16_t, WS_WGU) + (size_t)mat * NGU * DM, DM, n0, s_tile);
        } else if (it < TL_GU + TL_DN) {
            const int i2 = it - TL_GU, mat = l * 2 + i2 / (TDN_KT * TDN_NT), r = i2 % (TDN_KT * TDN_NT), kt = r / TDN_NT, nt = r % TDN_NT;
            conv_tile(p.in[I_DOWN] + (size_t)mat * FF * DM, DM, DM, kt * 64, nt * 64, WSP(bf16_t, WS_WDN) + (size_t)mat * DM * FF, FF, nt * 64, s_tile);
        } else if (it < TL_GU + TL_DN + TL_IN) {
            const int i2 = it - TL_GU - TL_DN, kt = i2 / TIN_NT, nt = i2 % TIN_NT;
            conv_tile(p.in[I_WIN] + (size_t)l * DM * NIN, NIN, NIN, kt * 64, nt * 64, WSP(bf16_t, WS_WIN) + (size_t)l * NINP * DM, DM, nt * 64, s_tile);
        } else {
            const int i2 = it - TL_GU - TL_DN - TL_IN, kt = i2 / TOUT_NT, nt = i2 % TOUT_NT;
            conv_tile(p.in[I_WOUT] + (size_t)l * DM * DM, DM, DM, kt * 64, nt * 64, WSP(bf16_t, WS_WOUT) + (size_t)l * DM * DM, DM, nt * 64, s_tile);
        }
    }
}

__device__ __forceinline__ void mod_layer(const Params& p, int l, int first, int stride, float* smem) {
    const int tid = opaque_tid();
    float* s_cond = smem;
    float* s_red = s_cond + NCOND * DM;
    __syncthreads();
    for (int i = tid; i < NCOND * DM; i += 512) { const int ci = i / DM, k = i % DM; const float v = ci == 0 ? p.in[I_CCTX][k] : p.in[I_C][(size_t)(ci - 1) * DM + k]; s_cond[i] = silu_f(v); }
    __syncthreads();
    float* modv = WSP(float, WS_MODV);
    for (int jt = first; jt < NMOD / 128; jt += stride) {
        const int cl = tid & 127, kq = tid >> 7, col = jt * 128 + cl;
        const float* w = p.in[I_WMOD] + (size_t)l * DM * NMOD + col;
        float acc[NCOND];
#pragma unroll
        for (int ci = 0; ci < NCOND; ++ci) acc[ci] = 0.f;
        for (int k = kq * 512; k < kq * 512 + 512; k += 8) {
            float wv[8];
#pragma unroll
            for (int j = 0; j < 8; ++j) wv[j] = w[(size_t)(k + j) * NMOD];
#pragma unroll
            for (int ci = 0; ci < NCOND; ++ci) {
                const float4 s0 = *(const float4*)&s_cond[ci * DM + k], s1 = *(const float4*)&s_cond[ci * DM + k + 4];
                acc[ci] += s0.x * wv[0] + s0.y * wv[1] + s0.z * wv[2] + s0.w * wv[3] + s1.x * wv[4] + s1.y * wv[5] + s1.z * wv[6] + s1.w * wv[7];
            }
        }
        if (kq > 0) {
#pragma unroll
            for (int ci = 0; ci < NCOND; ++ci) s_red[((kq - 1) * 128 + cl) * NCOND + ci] = acc[ci];
        }
        __syncthreads();
        if (kq == 0) {
            const float bm = p.in[I_BMOD][(size_t)l * NMOD + col];
#pragma unroll
            for (int ci = 0; ci < NCOND; ++ci)
                modv[((size_t)l * NCOND + ci) * NMOD + col] = acc[ci] + s_red[(0 * 128 + cl) * NCOND + ci] + s_red[(1 * 128 + cl) * NCOND + ci] + s_red[(2 * 128 + cl) * NCOND + ci] + bm;
        }
        __syncthreads();
    }
}

__device__ __forceinline__ void phase_prologue(const Params& p, float* smem) {
    const int tid = threadIdx.x, nb = gridDim.x, bid = blockIdx.x;
    float* s_tile = smem + NCOND * DM + 3 * 128 * NCOND;
#if CONV_FILLER
    mod_layer(p, 0, bid, nb, smem);
#else
    for (int l2 = 0; l2 < DEPTH; ++l2) mod_layer(p, l2, bid, nb, smem);
#endif
    conv_layer_tiles(p, 0, 0, NT_L, bid, nb, s_tile);
#if !CONV_FILLER
    for (int l2 = 1; l2 < DEPTH; ++l2) conv_layer_tiles(p, l2, 0, NT_L, bid, nb, s_tile);
#endif
    const size_t gtid = (size_t)bid * 512 + tid, gstride = (size_t)nb * 512;
    {
        const size_t n_na = (size_t)LB * DEPTH * 256 * 512 / 8;
        for (size_t i = gtid; i < 2 * n_na; i += gstride) {
            const bool isv = i >= n_na; const size_t j = isv ? i - n_na : i;
            const int d8 = (int)(j % 16), h = (int)((j / 16) % 4), t = (int)((j / 64) % 256); const size_t bl = j / (64 * 256);
            const float* s = p.in[isv ? I_CNAV : I_CNAK] + ((bl * 4 + h) * 256 + t) * 128 + d8 * 8;
            const float4 a = *(const float4*)s, b = *(const float4*)(s + 4);
            uint4 w; w.x = pack2(a.x, a.y); w.y = pack2(a.z, a.w); w.z = pack2(b.x, b.y); w.w = pack2(b.z, b.w);
            *(uint4*)(WSP(bf16_t, isv ? WS_CNAV : WS_CNAK) + (bl * 256 + t) * 512 + h * 128 + d8 * 8) = w;
        }
        const size_t n_g = (size_t)LB * DEPTH * 256 * 256 / 8;
        for (size_t i = gtid; i < 2 * n_g; i += gstride) {
            const bool isv = i >= n_g; const size_t j = isv ? i - n_g : i;
            const int d8 = (int)(j % 16), h = (int)((j / 16) % 2), t = (int)((j / 32) % 256); const size_t bl = j / (32 * 256);
            const float* s = p.in[isv ? I_CGV : I_CGK] + ((bl * 2 + h) * 256 + t) * 128 + d8 * 8;
            const float4 a = *(const float4*)s, b = *(const float4*)(s + 4);
            uint4 w; w.x = pack2(a.x, a.y); w.y = pack2(a.z, a.w); w.z = pack2(b.x, b.y); w.w = pack2(b.z, b.w);
            *(uint4*)(WSP(bf16_t, isv ? WS_CGV : WS_CGK) + (bl * 256 + t) * 256 + h * 128 + d8 * 8) = w;
        }
    }
    for (size_t i = gtid; i < 64 * 32; i += gstride) {
        const int pos = (int)(i / 32), k = (int)(i % 32);
        const float inv = powf(10000.0f, -(float)(2 * k) / 64.0f);
        const float ang = (float)pos * inv;
        WSP(float, WS_ROPE)[i] = cosf(ang); WSP(float, WS_ROPE)[64 * 32 + i] = sinf(ang);
    }
}

__device__ __forceinline__ void phase_norm(const Params& p, int l, int which  ) {
    const int tid = opaque_tid(), lane = tid & 63, wv = tid >> 6;
    const float* X = WSP(float, WS_X); bf16_t* H = WSP(bf16_t, WS_H);
    const bool from_in = (l == 0 && which == 0);
    const float* g = p.in[I_NORMG] + ((size_t)l * 3 + which) * DM;
    for (int m = blockIdx.x * 8 + wv; m < M; m += gridDim.x * 8) {
        const int ci = cond_of_row(m);
        const float* mv = WSP(float, WS_MODV) + ((size_t)l * NCOND + ci) * NMOD + (size_t)which * 3 * DM;
        const float* x = from_in ? (m < MC ? p.in[I_XP] + (size_t)m * DM : p.in[I_XS] + (size_t)(m - MC) * DM) : X + (size_t)m * DM;
        vf4 v[8]; float ss = 0.f;
#pragma unroll
        for (int i = 0; i < 8; ++i) { v[i] = *(const vf4*)(x + (i * 64 + lane) * 4); ss += v[i].x * v[i].x + v[i].y * v[i].y + v[i].z * v[i].z + v[i].w * v[i].w; }
        ss = wave_sum(ss);
        const float r = 1.0f / sqrtf(ss * (1.0f / DM) + EPS);
#pragma unroll
        for (int i = 0; i < 8; ++i) {
            const int c = (i * 64 + lane) * 4;
            const float4 gg = *(const float4*)(g + c), sh = *(const float4*)(mv + c), sc = *(const float4*)(mv + DM + c);
            const float o0 = v[i].x * r * gg.x * (1.f + sc.x) + sh.x, o1 = v[i].y * r * gg.y * (1.f + sc.y) + sh.y;
            const float o2 = v[i].z * r * gg.z * (1.f + sc.z) + sh.z, o3 = v[i].w * r * gg.w * (1.f + sc.w) + sh.w;
            uint2 w; w.x = pack2(o0, o1); w.y = pack2(o2, o3);
            *(uint2*)(H + (size_t)m * DM + c) = w;
        }
    }
}

__device__ __forceinline__ float red16(float v);
__device__ __forceinline__ float ssq8(vf4 a, vf4 b) { const vf4 s = a * a + b * b; return (s.x + s.y) + (s.z + s.w); }
__device__ __forceinline__ uint4 pack8(vf4 a, vf4 b) { uint4 w; w.x = pack2(a.x, a.y); w.y = pack2(a.z, a.w); w.z = pack2(b.x, b.y); w.w = pack2(b.z, b.w); return w; }
__device__ __forceinline__ void phase_prep(const Params& p, int l) {
    const int tid = opaque_tid(), lane = tid & 63, wv = tid >> 6, rg = lane >> 4, sub = lane & 15, c8 = sub * 8;
    const bf16_t* Z = WSP(bf16_t, WS_Z);
    const float* ropec = WSP(float, WS_ROPE); const float* ropes = ropec + 64 * 32;
    const float* wnq = p.in[I_NAQKN] + ((size_t)l * 2 + 0) * 128 + c8; const float* wnk = wnq + 128;
    const float* wgq = p.in[I_GQAQKN] + ((size_t)l * 2 + 0) * 128 + c8; const float* wgk = wgq + 128;
    const float* cw = p.in[I_CONV] + (size_t)l * 5 * 1536 + rg * 128 + c8;
    const int rpw = (M + (int)gridDim.x * 8 - 1) / ((int)gridDim.x * 8);
    for (int m = ((int)blockIdx.x * 8 + wv) * rpw, mend = (m + rpw < M ? m + rpw : M); m < mend; ++m) {
        const bf16_t* z = Z + (size_t)m * NINP;
        const bool ctx = m < MC;
        const int b = ctx ? m / CT : (m - MC) / LT, t = ctx ? m % CT : (m - MC) % LT, T = ctx ? CT : LT;
        {
            const int ho = rg * 128 + c8;
            const bf16_t* zkv = z + (rg < 2 ? Z_GQK + rg * 128 : Z_GQV + (rg - 2) * 128) + c8;
            vf4 q0, q1, k0, k1, v0, v1, g0, g1, x0, x1;
            ld8bf(z + Z_NAQ + ho, q0, q1); ld8bf(z + Z_NAK + ho, k0, k1); ld8bf(z + Z_NAV + ho, v0, v1); ld8bf(z + Z_GQQ + ho, g0, g1); ld8bf(zkv, x0, x1);
            float r = 1.0f / sqrtf(red16(ssq8(q0, q1)) * (1.0f / 128) + EPS);
            q0 = q0 * r * *(const vf4*)wnq; q1 = q1 * r * *(const vf4*)(wnq + 4);
            *(uint4*)(WSP(bf16_t, WS_NAQ) + (size_t)m * 512 + ho) = pack8(q0, q1);
            r = 1.0f / sqrtf(red16(ssq8(k0, k1)) * (1.0f / 128) + EPS);
            k0 = k0 * r * *(const vf4*)wnk; k1 = k1 * r * *(const vf4*)(wnk + 4);
            *(uint4*)(WSP(bf16_t, WS_NAK) + (size_t)m * 512 + ho) = pack8(k0, k1);
            *(uint4*)(WSP(bf16_t, WS_NAV) + (size_t)m * 512 + ho) = pack8(v0, v1);
            if (ctx) {
                const size_t o = ((((size_t)b * DEPTH + l) * 4 + rg) * CT + t) * 128 + c8;
                *(vf4*)(p.out + O_NAK + o) = k0; *(vf4*)(p.out + O_NAK + o + 4) = k1; *(vf4*)(p.out + O_NAV + o) = v0; *(vf4*)(p.out + O_NAV + o + 4) = v1;
            }
            r = 1.0f / sqrtf(red16(ssq8(g0, g1)) * (1.0f / 128) + EPS);
            g0 = g0 * r * *(const vf4*)wgq; g1 = g1 * r * *(const vf4*)(wgq + 4);
            const float rk = 1.0f / sqrtf(red16(ssq8(x0, x1)) * (1.0f / 128) + EPS);
            if (rg < 2) { x0 = x0 * rk * *(const vf4*)wgk; x1 = x1 * rk * *(const vf4*)(wgk + 4); }
            if (!ctx) {
                const int pos = sub < 8 ? (t >> 6) : (t & 63), ai = pos * 32 + (c8 & 31);
                const vf4 c0 = *(const vf4*)(ropec + ai), c1 = *(const vf4*)(ropec + ai + 4), s0 = *(const vf4*)(ropes + ai), s1 = *(const vf4*)(ropes + ai + 4);
                const bool hi = (sub & 4) != 0;
                vf4 pg0, pg1, px0, px1;
#pragma unroll
                for (int j = 0; j < 4; ++j) { pg0[j] = __shfl_xor(g0[j], 4); pg1[j] = __shfl_xor(g1[j], 4); px0[j] = __shfl_xor(x0[j], 4); px1[j] = __shfl_xor(x1[j], 4); }
                g0 = hi ? pg0 * s0 + g0 * c0 : g0 * c0 - pg0 * s0; g1 = hi ? pg1 * s1 + g1 * c1 : g1 * c1 - pg1 * s1;
                if (rg < 2) { x0 = hi ? px0 * s0 + x0 * c0 : x0 * c0 - px0 * s0; x1 = hi ? px1 * s1 + x1 * c1 : x1 * c1 - px1 * s1; }
            }
            *(uint4*)(WSP(bf16_t, WS_GQ) + (size_t)m * 512 + ho) = pack8(g0, g1);
            *(uint4*)(WSP(bf16_t, rg < 2 ? WS_GK : WS_GV) + (size_t)m * 256 + (rg & 1) * 128 + c8) = pack8(x0, x1);
            if (ctx) {
                const size_t o = ((((size_t)b * DEPTH + l) * 2 + (rg & 1)) * CT + t) * 128 + c8;
                float* dst = p.out + (rg < 2 ? O_GK : O_GV) + o;
                *(vf4*)dst = x0; *(vf4*)(dst + 4) = x1;
            }
        }
        {
#pragma unroll
            for (int dir = 0; dir < 2; ++dir) {
                const float* up = p.in[I_GUP] + ((size_t)l * 2 + dir) * 16 * 256 + 4 * lane;
                vf4 acc = *(const vf4*)(p.in[I_GBIAS] + ((size_t)l * 2 + dir) * 256 + 4 * lane);
                const bf16_t* gz = z + (dir ? Z_GB : Z_GF);
#pragma unroll
                for (int r4 = 0; r4 < 4; ++r4) {
                    const vf4 gv = ld4bf(gz + 4 * r4);
                    acc += gv.x * *(const vf4*)(up + (4 * r4 + 0) * 256) + gv.y * *(const vf4*)(up + (4 * r4 + 1) * 256) + gv.z * *(const vf4*)(up + (4 * r4 + 2) * 256) + gv.w * *(const vf4*)(up + (4 * r4 + 3) * 256);
                }
                vf4 o;
#pragma unroll
                for (int j = 0; j < 4; ++j) o[j] = logsigmoid_f(acc[j]) * (1.0f / 16.0f);
                *(vf4*)(WSP(float, dir ? WS_AB : WS_AF) + (size_t)m * 256 + 4 * lane) = o;
            }
        }
        {
#pragma unroll
            for (int part = 0; part < 3; ++part) {
                vf4 a0 = (vf4){0.f, 0.f, 0.f, 0.f}, a1 = a0;
#pragma unroll
                for (int j = 0; j < 5; ++j) {
                    const int tt = t + j - 2;
                    if (tt >= 0 && tt < T) {
                        const bf16_t* zz = Z + (size_t)(m + j - 2) * NINP + Z_DQKV + part * 512 + rg * 128 + c8;
                        const float* cj = cw + j * 1536 + part * 512;
                        vf4 z0, z1; ld8bf(zz, z0, z1);
                        a0 += *(const vf4*)cj * z0; a1 += *(const vf4*)(cj + 4) * z1;
                    }
                }
#pragma unroll
                for (int j = 0; j < 4; ++j) { a0[j] = silu_f(a0[j]); a1[j] = silu_f(a1[j]); }
                if (part < 2) { const float r = 1.0f / sqrtf(red16(ssq8(a0, a1)) + EPS) * (part == 0 ? 0.08838834764831845f : 1.0f); a0 *= r; a1 *= r; }
                *(uint4*)(WSP(bf16_t, part == 0 ? WS_DQ : part == 1 ? WS_DK : WS_DV) + (size_t)m * 512 + rg * 128 + c8) = pack8(a0, a1);
            }
            if (lane < 8) {
                const float beta = 1.0f / (1.0f + expf(-bf2f(z[Z_DB + lane])));
                const float g = -expf(p.in[I_ALOG][(size_t)l * 8 + lane]) * softplus_f(bf2f(z[Z_DA + lane]) + p.in[I_DTB][(size_t)l * 8 + lane]);
                float* ba = WSP(float, WS_DBA) + (size_t)m * 16;
                ba[lane] = beta; ba[8 + lane] = g;
            }
        }
    }
}

typedef float vf2 __attribute__((ext_vector_type(2)));
__device__ __forceinline__ float dpp_f(float v, const int ctrl) { return v; }
#define DPPF(v, ctrl) __int_as_float(__builtin_amdgcn_mov_dpp(__float_as_int(v), (ctrl), 0xF, 0xF, true))
__device__ __forceinline__ float red8(float v) { v += DPPF(v, 0xB1); v += DPPF(v, 0x4E); v += DPPF(v, 0x141); return v; }
__device__ __forceinline__ float red16(float v) { v = red8(v); v += DPPF(v, 0x140); return v; }

__device__ __forceinline__ void phase_post(const Params& p, int l) {
    const int tid = opaque_tid(), lane = tid & 63, wv = tid >> 6, rg = lane >> 4, c8 = (lane & 15) * 8;
    const bf16_t* Z = WSP(bf16_t, WS_Z); bf16_t* MRG = WSP(bf16_t, WS_MRG);
    const float* wg = p.in[I_GLAON] + (size_t)l * 128 + c8; const float* wd = p.in[I_GDNON] + (size_t)l * 128 + c8;
    for (int m = blockIdx.x * 8 + wv; m < M; m += gridDim.x * 8) {
        const bf16_t* z = Z + (size_t)m * NINP;
        const int ho = rg * 128 + c8;
#pragma unroll
        for (int g = 0; g < 2; ++g) {
            const float* of = WSP(float, g ? WS_DOF : WS_GOF) + (size_t)m * 512 + ho; const float* ob = WSP(float, g ? WS_DOB : WS_GOB) + (size_t)m * 512 + ho;
            const float* w = g ? wd : wg; const bf16_t* zg = z + (g ? Z_DZ : Z_GLR) + ho;
            vf4 a0 = *(const vf4*)of + *(const vf4*)ob, a1 = *(const vf4*)(of + 4) + *(const vf4*)(ob + 4);
            vf4 g0, g1; ld8bf(zg, g0, g1);
            const float r = 1.0f / sqrtf(red16(ssq8(a0, a1)) * (1.0f / 128) + EPS);
            a0 = a0 * r * *(const vf4*)w; a1 = a1 * r * *(const vf4*)(w + 4);
#pragma unroll
            for (int j = 0; j < 4; ++j) { a0[j] *= silu_f(g0[j]); a1[j] *= silu_f(g1[j]); }
            *(uint4*)(MRG + (size_t)m * DM + (g ? 1536 : 512) + ho) = pack8(a0, a1);
        }
    }
}
#define XB_TMO      128
#define XB_XCNT(j)  (256  + 64 * (j))
#define XB_XSUB(j)  (1280 + 64 * (j))
#define XB_XGEN(j)  (2304 + 64 * (j))
#define XB_TOP      3328
#define XB_TOPGEN   3392
#define XCD_BAR_WORDS 3456
#define XB_SPIN_CAP (1u << 22)
#define LAS __attribute__((address_space(3)))

__device__ __forceinline__ unsigned xb_ld(unsigned* p)              { return __hip_atomic_load(p, __ATOMIC_RELAXED, __HIP_MEMORY_SCOPE_AGENT); }
__device__ __forceinline__ unsigned xb_add(unsigned* p, unsigned v) { return __hip_atomic_fetch_add(p, v, __ATOMIC_RELAXED, __HIP_MEMORY_SCOPE_AGENT); }
__device__ __forceinline__ unsigned xb_xcc_id() { return (unsigned)__builtin_amdgcn_s_getreg((3 << 11) | 20) & 0xFu; }
#define XB_SPIN(cond, bar) do { unsigned _sp = 0; while (cond) { __builtin_amdgcn_s_sleep(1); \
    if ((++_sp & 255u) == 0u) { if (xb_ld(&(bar)[XB_TMO])) break; if (_sp > XB_SPIN_CAP) { atomicAdd(&(bar)[XB_TMO], 1u); break; } } } } while (0)

struct XcdBarrier {
    unsigned* bar; unsigned x;
    volatile LAS unsigned* st;
};

__device__ __forceinline__ XcdBarrier xcd_barrier_post(unsigned* bar, volatile LAS unsigned* st) {
    XcdBarrier b; b.bar = bar; b.x = xb_xcc_id(); b.st = st;
    if (threadIdx.x == 0) (void)xb_add(&bar[XB_XCNT(b.x)], 1u);
    return b;
}
__device__ __forceinline__ void xcd_barrier_complete(unsigned* bar, unsigned x, unsigned& nloc, unsigned& nx) {
    const unsigned G = gridDim.x * gridDim.y * gridDim.z;
    unsigned sum, cnt, mine, sp = 0u;
    for (;;) {
        sum = 0u; cnt = 0u; mine = 0u;
#pragma unroll
        for (unsigned j = 0; j < 16; ++j) { const unsigned c = xb_ld(&bar[XB_XCNT(j)]); sum += c; cnt += (c > 0u) ? 1u : 0u; mine = (j == x) ? c : mine; }
        if (sum == G) break;
        __builtin_amdgcn_s_sleep(1);
        if ((++sp & 255u) == 0u) { if (xb_ld(&bar[XB_TMO])) break; if (sp > XB_SPIN_CAP) { atomicAdd(&bar[XB_TMO], 1u); break; } }
    }
    nloc = mine > 0u ? mine : 1u; nx = cnt > 0u ? cnt : 1u;
}

__device__ __forceinline__ void xcd_barrier(const XcdBarrier& b) {
    asm volatile("s_waitcnt vmcnt(0)" ::: "memory");
    __syncthreads();
    if (threadIdx.x == 0) {
        unsigned* bar = b.bar;
        __builtin_amdgcn_s_waitcnt(0);
        unsigned nloc = b.st[0], nx = b.st[1];
        if (nloc == 0u) { xcd_barrier_complete(bar, b.x, nloc, nx); b.st[0] = nloc; b.st[1] = nx; }
        const unsigned old = xb_add(&bar[XB_XSUB(b.x)], 1u);
        const unsigned gen = old / nloc;
        if (old + 1u == (gen + 1u) * nloc) {
            __builtin_amdgcn_fence(__ATOMIC_RELEASE, "agent");
            asm volatile("s_waitcnt vmcnt(0)" ::: "memory");
            const unsigned og = xb_add(&bar[XB_TOP], 1u);
            const unsigned tg = og / nx;
            if (og + 1u == (tg + 1u) * nx) xb_add(&bar[XB_TOPGEN], 1u);
            else XB_SPIN(xb_ld(&bar[XB_TOPGEN]) == tg, bar);
            __builtin_amdgcn_fence(__ATOMIC_ACQUIRE, "agent");
            xb_add(&bar[XB_XGEN(b.x)], 1u);
            asm volatile("s_waitcnt vmcnt(0)" ::: "memory");
        } else {
            XB_SPIN(xb_ld(&bar[XB_XGEN(b.x)]) == gen, bar);
            __builtin_amdgcn_fence(__ATOMIC_ACQUIRE, "agent");
            asm volatile("s_waitcnt vmcnt(0)" ::: "memory");
        }
    }
    __syncthreads();
}

namespace pg8 {
#define PG8_LAS __attribute__((address_space(3)))
typedef unsigned short bf16_t;
typedef short bf16x8 __attribute__((ext_vector_type(8)));
typedef float f32x4 __attribute__((ext_vector_type(4)));
typedef unsigned u32x4 __attribute__((ext_vector_type(4)));
constexpr int BM = 256, BK = 64, HALF = 128, HTB = HALF * BK * 2  , STAGE_BYTES = 8 * HTB, NXCD = 8, WGM = 8;

__host__ __device__ __forceinline__ int lds_byte(int r, int c) { const int st = (r >> 4) * 2 + (c >> 5), rr = r & 15, cc = c & 31, ob = rr * 64 + cc * 2; return st * 1024 + (ob ^ (((ob >> 9) & 1) << 5)); }
__host__ __device__ __forceinline__ void stage_rc(int b, int& R, int& C) { const int st = b / 1024, sb = b % 1024, swz = sb ^ (((sb >> 9) & 1) << 5); R = (st >> 1) * 16 + swz / 64; C = (st & 1) * 32 + (swz % 64) / 2; }
__host__ __device__ __forceinline__ int perm32(int rho) { const int n = rho >> 4, i = rho & 15; return 8 * (i >> 2) + 4 * n + (i & 3); }

struct Unit { int pm, pn, k0, nt, at, slot; };
struct Gemm { const bf16_t* A; const bf16_t* Bt; int M, N, K; };

struct StaticOrder {
    int nM, nN, nwg, G, c, ntk, split;
    __host__ __device__ void init(int M, int N, int K, int G_, int c_, int split_ = 0) { nM = M / BM; nN = N / BM; nwg = nM * nN; G = G_; c = c_; ntk = K / BK; const int rem = nwg % G_; split = (split_ && rem > 0 && 2 * rem == G_ && (ntk % 4) != 1 && ntk >= 8) ? 1 : 0; }
    __host__ __device__ bool next(int i, Unit& u) const {
        long L = (long)i * G + c; u.k0 = 0; u.nt = ntk; u.at = 0; u.slot = 0;
        if (split && i == nwg / G) { const int rem = nwg % G, sl = c / rem, h0 = ((ntk / 2) + 1) & ~1; L = (long)i * G + (c % rem); u.k0 = sl ? h0 * BK : 0; u.nt = sl ? ntk - h0 : h0; u.at = sl ? 1 : 2; u.slot = c % rem; }
        if (L >= nwg) return false;
        int wgid = (int)L; { const int q = nwg / NXCD, r = nwg % NXCD, xcd = wgid % NXCD, off = wgid / NXCD; wgid = (xcd < r ? xcd * (q + 1) : r * (q + 1) + (xcd - r) * q) + off; }
        const int nig = WGM * nN, gid = wgid / nig, fm = gid * WGM, gsz = (nM - fm) < WGM ? (nM - fm) : WGM;
        u.pm = fm + ((wgid % nig) % gsz); u.pn = (wgid % nig) / gsz; return true;
    }
    __device__ __forceinline__ void a_ready(const Unit&) const {}
    __device__ __forceinline__ void done(const Unit&) const {}
};
__device__ __forceinline__ unsigned cvt_pk_bf16(float lo, float hi) { unsigned r; asm volatile("v_cvt_pk_bf16_f32 %0, %1, %2" : "=v"(r) : "v"(lo), "v"(hi)); return r; }
struct EpiF32 {
    static constexpr bool PERM = false, AFTER_DRAIN = false;
    float* C; int ldc; const float* bias;
    __device__ __forceinline__ void operator()(const f32x4 (&acc)[2][2][4][2], const Unit& u, int wr, int wc, int fr, int fq) const {
        const int row0 = u.pm * BM + wr * 64 + fr, col0 = u.pn * BM + wc * 32 + 4 * fq;
        f32x4 bv[2][2];
#pragma unroll
        for (int bj = 0; bj < 2; ++bj)
#pragma unroll
            for (int n = 0; n < 2; ++n) bv[bj][n] = bias ? *(const f32x4*)(bias + col0 + bj * HALF + n * 16) : (f32x4){0.f, 0.f, 0.f, 0.f};
#pragma unroll
        for (int ai = 0; ai < 2; ++ai)
#pragma unroll
            for (int m = 0; m < 4; ++m) { float* rowp = C + (size_t)(row0 + ai * HALF + m * 16) * ldc + col0;
#pragma unroll
                for (int bj = 0; bj < 2; ++bj)
#pragma unroll
                    for (int n = 0; n < 2; ++n) *(f32x4*)(rowp + bj * HALF + n * 16) = acc[ai][bj][m][n] + bv[bj][n]; }
    }
};

struct EpiSwiGLU {
    static constexpr bool PERM = true, AFTER_DRAIN = false;
    bf16_t* O; int ldc;
    __device__ __forceinline__ void operator()(const f32x4 (&acc)[2][2][4][2], const Unit& u, int wr, int wc, int fr, int fq) const {
        const int row0 = u.pm * BM + wr * 64 + fr, col0 = u.pn * 128 + wc * 32 + 8 * fq;
#pragma unroll
        for (int ai = 0; ai < 2; ++ai)
#pragma unroll
            for (int m = 0; m < 4; ++m) { bf16_t* rowp = O + (size_t)(row0 + ai * HALF + m * 16) * ldc + col0;
                const f32x4 g0 = acc[ai][0][m][0], g1 = acc[ai][0][m][1], u0 = acc[ai][1][m][0], u1 = acc[ai][1][m][1];
                float r[8];
#pragma unroll
                for (int j = 0; j < 4; ++j) {
                    r[j]     = g0[j] * __builtin_amdgcn_rcpf(1.0f + __builtin_amdgcn_exp2f(-1.4426950408889634f * g0[j])) * u0[j];
                    r[4 + j] = g1[j] * __builtin_amdgcn_rcpf(1.0f + __builtin_amdgcn_exp2f(-1.4426950408889634f * g1[j])) * u1[j]; }
                u32x4 w; w.x = cvt_pk_bf16(r[0], r[1]); w.y = cvt_pk_bf16(r[2], r[3]); w.z = cvt_pk_bf16(r[4], r[5]); w.w = cvt_pk_bf16(r[6], r[7]);
                *(u32x4*)rowp = w; }
    }
};
struct EpiBf16Plain {
    static constexpr bool PERM = true, AFTER_DRAIN = false;
    bf16_t* O; int ldc;
    __device__ __forceinline__ void operator()(const f32x4 (&acc)[2][2][4][2], const Unit& u, int wr, int wc, int fr, int fq) const {
        const int row0 = u.pm * BM + wr * 64 + fr, col0 = u.pn * BM + wc * 32 + 8 * fq;
#pragma unroll
        for (int ai = 0; ai < 2; ++ai)
#pragma unroll
            for (int m = 0; m < 4; ++m) { bf16_t* rowp = O + (size_t)(row0 + ai * HALF + m * 16) * ldc + col0;
#pragma unroll
                for (int bj = 0; bj < 2; ++bj) { const f32x4 v0 = acc[ai][bj][m][0], v1 = acc[ai][bj][m][1];
                    u32x4 w; w.x = cvt_pk_bf16(v0[0], v0[1]); w.y = cvt_pk_bf16(v0[2], v0[3]); w.z = cvt_pk_bf16(v1[0], v1[1]); w.w = cvt_pk_bf16(v1[2], v1[3]);
                    *(u32x4*)(rowp + bj * HALF) = w; } }
    }
};
struct EpiResid {
    static constexpr bool PERM = false, AFTER_DRAIN = false;
    const float* res; float* out; int ldc; const float* gate0; float coef;
    float* slab; unsigned* flags; unsigned target;
    const float* res_hi; int row_hi;
    __device__ __forceinline__ void operator()(const f32x4 (&acc)[2][2][4][2], const Unit& u, int wr, int wc, int fr, int fq) const {
        const int tidx = ((wr * 4 + wc) * 4 + fq) * 16 + fr;
        if (u.at == 1) {
            const __amdgpu_buffer_rsrc_t rs = __builtin_amdgcn_make_buffer_rsrc((void*)slab, 0, 0x7FFFFFF0, 0x00020000);
            const unsigned base = ((unsigned)u.slot * 32u * 512u + (unsigned)tidx) * 16u;
#pragma unroll
            for (int ai = 0; ai < 2; ++ai)
#pragma unroll
                for (int bj = 0; bj < 2; ++bj)
#pragma unroll
                    for (int m = 0; m < 4; ++m)
#pragma unroll
                        for (int n = 0; n < 2; ++n) { const f32x4 v = acc[ai][bj][m][n]; u32x4 w; w.x = __float_as_uint(v[0]); w.y = __float_as_uint(v[1]); w.z = __float_as_uint(v[2]); w.w = __float_as_uint(v[3]);
                            __builtin_amdgcn_raw_buffer_store_b128(w, rs, base + (unsigned)((((ai * 2 + bj) * 4 + m) * 2 + n) * 512 * 16), 0, 16); }
            asm volatile("s_waitcnt vmcnt(0)" ::: "memory");
            if ((tidx & 63) == 0) __hip_atomic_fetch_add(flags + 64 * u.slot, 1u, __ATOMIC_RELAXED, __HIP_MEMORY_SCOPE_AGENT);
            return;
        }
        const float* part = nullptr;
        if (u.at == 2) {
            unsigned spins = 0;
            while (__hip_atomic_load(flags + 64 * u.slot, __ATOMIC_RELAXED, __HIP_MEMORY_SCOPE_AGENT) < target) { __builtin_amdgcn_s_sleep(2); if (++spins > (1u << 22)) break; }
            __builtin_amdgcn_fence(__ATOMIC_ACQUIRE, "agent");
            asm volatile("s_waitcnt vmcnt(0)" ::: "memory");
            part = slab + ((size_t)u.slot * 32 * 512 + tidx) * 4;
        }
        const int row0 = u.pm * BM + wr * 64 + fr, col0 = u.pn * BM + wc * 32 + 4 * fq;
        const float* gate = gate0 + (size_t)cond_of_row(u.pm * BM) * NMOD;
        const float* rbase = (u.pm * BM >= row_hi) ? res_hi - (size_t)row_hi * ldc : res;
        f32x4 gv[2][2];
#pragma unroll
        for (int bj = 0; bj < 2; ++bj)
#pragma unroll
            for (int n = 0; n < 2; ++n) gv[bj][n] = *(const f32x4*)(gate + col0 + bj * HALF + n * 16) * coef;
#pragma unroll
        for (int ai = 0; ai < 2; ++ai)
#pragma unroll
            for (int m = 0; m < 4; ++m) { const size_t off = (size_t)(row0 + ai * HALF + m * 16) * ldc + col0;
#pragma unroll
                for (int bj = 0; bj < 2; ++bj)
#pragma unroll
                    for (int n = 0; n < 2; ++n) {
                        f32x4 a = acc[ai][bj][m][n];
                        if (part) a += *(const f32x4*)(part + (size_t)((((ai * 2 + bj) * 4 + m) * 2 + n) * 512 * 4));
                        const f32x4 bs = *(const f32x4*)(rbase + off + bj * HALF + n * 16); *(f32x4*)(out + off + bj * HALF + n * 16) = bs + gv[bj][n] * a; }
                asm volatile("" ::: "memory"); }
    }
};
template <class Epi, class Sched, bool STAMP = false>
__device__ __forceinline__ void gemm_phase(PG8_LAS unsigned char* lds, const Gemm g, const Sched& S, const Epi& E, unsigned long long* stamps) {
    const int tid = opaque_tid(), wid = __builtin_amdgcn_readfirstlane(tid >> 6), lane = tid & 63, wr = wid >> 2, wc = wid & 3, fr = lane & 15, fq = lane >> 4;
    const int K = g.K;
    int ts_lo = 0, ts_hi = 0, nts = 0; const unsigned long long rt_entry = STAMP ? (unsigned long long)wall_clock64() : 0ull;
#define PG8_STAMP() do { if (STAMP && wid == 0 && nts < 64) { const unsigned long long _c = (unsigned long long)clock64(); \
        ts_lo = (lane == nts) ? (int)(unsigned)_c : ts_lo; ts_hi = (lane == nts) ? (int)(unsigned)(_c >> 32) : ts_hi; ++nts; } } while (0)
    PG8_STAMP();
    unsigned voffA[2], voffB[2];
#pragma unroll
    for (int i = 0; i < 2; ++i) { int R, C; stage_rc(tid * 16 + i * 8192, R, C); const int Rb = Epi::PERM ? ((R & ~31) + perm32(R & 31)) : R;
        voffA[i] = (unsigned)(R * K + C) * 2u; voffB[i] = (unsigned)(Rb * K + C) * 2u; }
    const size_t kstep = (size_t)(BK * 2);
    const size_t hstep = (size_t)HALF * K * 2;
    const size_t tstep = 2 * hstep;
    const unsigned ldsw = (unsigned)wid * 1024u;
    const int aoff = lds_byte(wr * 64 + fr, fq * 8), boff = lds_byte(wc * 32 + fr, fq * 8);
#define PG8_SA(b, h) (((b) * 2 + (h)) * HTB)
#define PG8_SB(b, h) ((4 + (b) * 2 + (h)) * HTB)
#define PG8_STAGE(bufoff, gbase, voff) do { _Pragma("unroll") for (int _i = 0; _i < 2; ++_i) \
        __builtin_amdgcn_global_load_lds((const unsigned*)((const char*)(gbase) + (voff)[_i]), (PG8_LAS unsigned*)(lds + (bufoff) + ldsw + _i * 8192), 16, 0, 0); } while (0)
#define PG8_LDA(dst, b, h) do { _Pragma("unroll") for (int m = 0; m < 4; ++m) _Pragma("unroll") for (int k = 0; k < 2; ++k) dst[m][k] = *(const PG8_LAS bf16x8*)(lds + PG8_SA(b, h) + aoff + m * 2048 + k * 1024); } while (0)
#define PG8_LDB(dst, b, h) do { _Pragma("unroll") for (int n = 0; n < 2; ++n) _Pragma("unroll") for (int k = 0; k < 2; ++k) dst[n][k] = *(const PG8_LAS bf16x8*)(lds + PG8_SB(b, h) + boff + n * 2048 + k * 1024); } while (0)
#define PG8_MMA(ai, bj, At, Bt) do { __builtin_amdgcn_s_setprio(1); _Pragma("unroll") for (int m = 0; m < 4; ++m) _Pragma("unroll") for (int n = 0; n < 2; ++n) _Pragma("unroll") for (int k = 0; k < 2; ++k) \
        acc[ai][bj][m][n] = __builtin_amdgcn_mfma_f32_16x16x32_bf16(Bt[n][k], At[m][k], acc[ai][bj][m][n], 0, 0, 0); __builtin_amdgcn_s_setprio(0); } while (0)
#define PG8_WAIT_V(n) asm volatile("s_waitcnt vmcnt(" #n ")" ::: "memory")
#define PG8_WAIT_L(n) asm volatile("s_waitcnt lgkmcnt(" #n ")" ::: "memory")
#define PG8_BAR __builtin_amdgcn_s_barrier()
#define PG8_SCHED __builtin_amdgcn_sched_barrier(0)
    Unit cur, nxt; int ui = 0;
    if (!S.next(0, cur)) return;
    f32x4 acc[2][2][4][2];
#pragma unroll
    for (int a = 0; a < 2; ++a)
#pragma unroll
        for (int b = 0; b < 2; ++b)
#pragma unroll
            for (int m = 0; m < 4; ++m)
#pragma unroll
                for (int n = 0; n < 2; ++n) acc[a][b][m][n] = (f32x4){0.f, 0.f, 0.f, 0.f};
    bf16x8 At[4][2], B0[2][2], B1[2][2];
    const char* cA = (const char*)g.A + (size_t)cur.pm * tstep + (size_t)cur.k0 * 2; const char* cB = (const char*)g.Bt + (size_t)cur.pn * tstep + (size_t)cur.k0 * 2;
    S.a_ready(cur);
    PG8_STAGE(PG8_SB(0, 0), cB, voffB); PG8_STAGE(PG8_SA(0, 0), cA, voffA); PG8_STAGE(PG8_SB(0, 1), cB + hstep, voffB); PG8_STAGE(PG8_SA(0, 1), cA + hstep, voffA);
    if (wr == 1) PG8_BAR;
    PG8_WAIT_V(4); PG8_BAR;
    PG8_STAGE(PG8_SB(1, 0), cB + kstep, voffB); PG8_STAGE(PG8_SA(1, 0), cA + kstep, voffA); PG8_STAGE(PG8_SB(1, 1), cB + hstep + kstep, voffB);
    PG8_WAIT_V(6); PG8_BAR;
    PG8_STAMP();
    for (;;) {
        const bool has_next = S.next(ui + 1, nxt);
        const char* nA = has_next ? (const char*)g.A + (size_t)nxt.pm * tstep + (size_t)nxt.k0 * 2 : cA; const char* nB = has_next ? (const char*)g.Bt + (size_t)nxt.pn * tstep + (size_t)nxt.k0 * 2 : cB;
        const int nt = cur.nt;
        for (int t = 0; t < nt; t += 2) {
            const bool last = (t == nt - 2);
            const char* a1 = cA + (size_t)(t + 1) * kstep;
            const char* a2 = last ? nA : cA + (size_t)(t + 2) * kstep; const char* b2 = last ? nB : cB + (size_t)(t + 2) * kstep;
            const char* a3 = a2 + kstep; const char* b3 = b2 + kstep;
            if (last && has_next) S.a_ready(nxt);
            PG8_LDB(B0, 0, 0); PG8_SCHED; PG8_LDA(At, 0, 0); PG8_STAGE(PG8_SA(1, 1), a1 + hstep, voffA);
            PG8_WAIT_L(8); PG8_BAR; PG8_WAIT_L(0); PG8_MMA(0, 0, At, B0); PG8_BAR; PG8_SCHED;
            PG8_LDB(B1, 0, 1); PG8_STAGE(PG8_SB(0, 0), b2, voffB);
            PG8_BAR; PG8_WAIT_L(0); PG8_MMA(0, 1, At, B1); PG8_BAR;
            PG8_LDA(At, 0, 1); PG8_STAGE(PG8_SA(0, 0), a2, voffA);
            PG8_BAR; PG8_WAIT_L(0); PG8_MMA(1, 0, At, B0); PG8_BAR; PG8_SCHED;
            PG8_STAGE(PG8_SB(0, 1), b2 + hstep, voffB);
            PG8_WAIT_V(6); PG8_BAR; PG8_MMA(1, 1, At, B1); PG8_BAR;
            PG8_LDB(B0, 1, 0); PG8_SCHED; PG8_LDA(At, 1, 0); PG8_STAGE(PG8_SA(0, 1), a2 + hstep, voffA);
            PG8_WAIT_L(8); PG8_BAR; PG8_WAIT_L(0); PG8_MMA(0, 0, At, B0); PG8_BAR; PG8_SCHED;
            PG8_LDB(B1, 1, 1); PG8_STAGE(PG8_SB(1, 0), b3, voffB);
            PG8_BAR; PG8_WAIT_L(0); PG8_MMA(0, 1, At, B1); PG8_BAR;
            PG8_LDA(At, 1, 1); PG8_STAGE(PG8_SA(1, 0), a3, voffA);
            PG8_BAR; PG8_WAIT_L(0); PG8_MMA(1, 0, At, B0); PG8_BAR; PG8_SCHED;
            PG8_STAGE(PG8_SB(1, 1), b3 + hstep, voffB);
            PG8_WAIT_V(6); PG8_BAR; PG8_MMA(1, 1, At, B1); PG8_BAR;
        }
        PG8_STAMP();
        if constexpr (!Epi::AFTER_DRAIN) { E(acc, cur, wr, wc, fr, fq); S.done(cur); }
        PG8_STAMP();
        if (!has_next) break;
#pragma unroll
        for (int a = 0; a < 2; ++a)
#pragma unroll
            for (int b = 0; b < 2; ++b)
#pragma unroll
                for (int m = 0; m < 4; ++m)
#pragma unroll
                    for (int n = 0; n < 2; ++n) acc[a][b][m][n] = (f32x4){0.f, 0.f, 0.f, 0.f};
        cur = nxt; cA = nA; cB = nB; ++ui;
    }
    PG8_WAIT_V(0);
    if (wr == 0) PG8_BAR;
    PG8_BAR;
    if constexpr (Epi::AFTER_DRAIN) { E.fused(acc, cur, wr, wc, fr, fq, lds, wid, lane); S.done(cur); }
    PG8_STAMP();
    if (STAMP && wid == 0) { stamps[lane] = lane < nts ? (((unsigned long long)(unsigned)ts_hi << 32) | (unsigned)ts_lo) : 0ull;
        if (lane == 62) stamps[62] = rt_entry; if (lane == 63) stamps[63] = (unsigned long long)wall_clock64(); }
#undef PG8_STAMP
#undef PG8_SA
#undef PG8_SB
#undef PG8_STAGE
#undef PG8_LDA
#undef PG8_LDB
#undef PG8_MMA
#undef PG8_WAIT_V
#undef PG8_WAIT_L
#undef PG8_BAR
#undef PG8_SCHED
}
}
#ifndef ATT_INLINE
#define ATT_INLINE __forceinline__
#endif
namespace att {
constexpr int D = 128, NW = 8, QBLK = 32, KVBLK = 64, LDQ = 512, LDO = DM;
constexpr float SCALE = 0.088388347648318440f;
constexpr float THR = 8.f;
constexpr size_t SHM_V = KVBLK * D * 2, SHM_K = KVBLK * D * 2, SHM_Q = 256 * D * 2, SHM_ATTN = 2 * SHM_V + 2 * SHM_K + NW * 64 * 4 + SHM_Q;
using bf16x8 = __attribute__((ext_vector_type(8))) short;
using s16x4  = __attribute__((ext_vector_type(4))) short;
using f32x16 = __attribute__((ext_vector_type(16))) float;
using u32x4  = __attribute__((ext_vector_type(4))) unsigned;
#define KSWZ(row, colB) ((row) * 256 + ((colB) ^ (((row) & 7) << 4)))
#define SBAR() __builtin_amdgcn_sched_barrier(0)
__device__ __forceinline__ int crow(int r, int hi) { return (r & 3) + 8 * (r >> 2) + 4 * hi; }
__device__ __forceinline__ unsigned cvtpk(float lo, float hi) { unsigned r; asm volatile("v_cvt_pk_bf16_f32 %0, %1, %2" : "=v"(r) : "v"(lo), "v"(hi)); return r; }

__device__ __forceinline__ void partialSM(f32x16& p0, f32x16& p1, float& m_reg, float& mn, float& alpha) {
  constexpr float C = SCALE * 1.4426950408889634f;
  float pmax = p0[0]; for (int r = 1; r < 16; ++r) pmax = fmaxf(pmax, p0[r]); for (int r = 0; r < 16; ++r) pmax = fmaxf(pmax, p1[r]);
  { auto rr = __builtin_amdgcn_permlane32_swap(__float_as_uint(pmax), __float_as_uint(pmax), false, false);
    pmax = fmaxf(__uint_as_float(rr[0]), __uint_as_float(rr[1])); }
  if (__builtin_expect(__all(pmax - m_reg <= THR / SCALE), 1)) { mn = m_reg; alpha = 1.f; }
  else { mn = fmaxf(m_reg, pmax); alpha = __builtin_amdgcn_exp2f((m_reg - mn) * C); m_reg = mn; }
  float mnC = -mn * C;
  for (int r = 0; r < 16; ++r) p0[r] = fmaf(p0[r], C, mnC); for (int r = 0; r < 16; ++r) p1[r] = fmaf(p1[r], C, mnC);
  for (int r = 0; r < 16; ++r) p0[r] = __builtin_amdgcn_exp2f(p0[r]);
}
__device__ __forceinline__ void finishSM(f32x16& p0, f32x16& p1, float alpha, float& l_reg, bf16x8& pa0, bf16x8& pa1, bf16x8& pa2, bf16x8& pa3) {
  for (int r = 0; r < 16; ++r) p1[r] = __builtin_amdgcn_exp2f(p1[r]);
  float ps = 0; for (int r = 0; r < 16; ++r) ps += p0[r]; for (int r = 0; r < 16; ++r) ps += p1[r];
  { auto rr = __builtin_amdgcn_permlane32_swap(__float_as_uint(ps), __float_as_uint(ps), false, false);
    ps = __uint_as_float(rr[0]) + __uint_as_float(rr[1]); }
  l_reg = l_reg * alpha + ps;
#define PK4(P, BASE, OUT) do { unsigned a0 = cvtpk(P[BASE + 0], P[BASE + 1]), a1 = cvtpk(P[BASE + 2], P[BASE + 3]);   \
    unsigned b0 = cvtpk(P[BASE + 4], P[BASE + 5]), b1 = cvtpk(P[BASE + 6], P[BASE + 7]);                              \
    auto r0 = __builtin_amdgcn_permlane32_swap(a0, b0, false, false); auto r1 = __builtin_amdgcn_permlane32_swap(a1, b1, false, false); \
    u32x4 w = {r0[0], r1[0], r0[1], r1[1]}; OUT = *reinterpret_cast<bf16x8*>(&w); } while (0)
  PK4(p0, 0, pa0); PK4(p0, 8, pa1); PK4(p1, 0, pa2); PK4(p1, 8, pa3);
#undef PK4
}
__device__ __forceinline__ void qkt(f32x16& p0, f32x16& p1, const bf16_t* Ks, const bf16_t* Qs, int qrow, int r32, int hi) {
  p0 = f32x16{}; p1 = f32x16{};
#pragma unroll
  for (int d0 = 0; d0 < 8; ++d0) { int cb = (d0 * 16 + hi * 8) * 2;
    bf16x8 q = *reinterpret_cast<const bf16x8*>((const char*)Qs + KSWZ(qrow, cb));
    bf16x8 b0 = *reinterpret_cast<const bf16x8*>((const char*)Ks + KSWZ(r32, cb));
    bf16x8 b1 = *reinterpret_cast<const bf16x8*>((const char*)Ks + KSWZ(32 + r32, cb));
    p0 = __builtin_amdgcn_mfma_f32_32x32x16_bf16(b0, q, p0, 0, 0, 0);
    p1 = __builtin_amdgcn_mfma_f32_32x32x16_bf16(b1, q, p1, 0, 0, 0); }
}
__device__ __forceinline__ int v_st(int k, int c) { const int kk = (k & ~0xC) | ((k & 4) << 1) | ((k & 8) >> 1); return ((kk >> 3) * 4 + (c >> 5)) * 512 + ((kk & 7) * 32 + (c & 31)) * 2; }
__device__ __forceinline__ int v_rd_base(int lane) { return ((lane & 3) << 3) | (((lane >> 2) & 3) << 6) | (((lane >> 4) & 1) << 5) | (((lane >> 5) & 1) << 8); }
constexpr int v_rd_off(int d0, int ks, int half) { return d0 * 512 + ks * 4096 + half * 2048; }
template <int OFF> __device__ __forceinline__ s16x4 tr_read(int vb) {
  s16x4 r; asm volatile("ds_read_b64_tr_b16 %0, %1 offset:%2" : "=&v"(r) : "v"(vb), "i"(OFF) : "memory"); return r;
}
template <int D0> __device__ __forceinline__ void pv_one(f32x16& od, int vb, bf16x8 pa0, bf16x8 pa1, bf16x8 pa2, bf16x8 pa3) {
  const s16x4 l0 = tr_read<v_rd_off(D0, 0, 0)>(vb), h0 = tr_read<v_rd_off(D0, 0, 1)>(vb), l1 = tr_read<v_rd_off(D0, 1, 0)>(vb), h1 = tr_read<v_rd_off(D0, 1, 1)>(vb);
  const s16x4 l2 = tr_read<v_rd_off(D0, 2, 0)>(vb), h2 = tr_read<v_rd_off(D0, 2, 1)>(vb), l3 = tr_read<v_rd_off(D0, 3, 0)>(vb), h3 = tr_read<v_rd_off(D0, 3, 1)>(vb);
  asm volatile("s_waitcnt lgkmcnt(0)" ::: "memory"); SBAR();
#define PK(L, H) (bf16x8){L[0], L[1], L[2], L[3], H[0], H[1], H[2], H[3]}
  od = __builtin_amdgcn_mfma_f32_32x32x16_bf16(pa0, PK(l0, h0), od, 0, 0, 0);
  od = __builtin_amdgcn_mfma_f32_32x32x16_bf16(pa1, PK(l1, h1), od, 0, 0, 0);
  od = __builtin_amdgcn_mfma_f32_32x32x16_bf16(pa2, PK(l2, h2), od, 0, 0, 0);
  od = __builtin_amdgcn_mfma_f32_32x32x16_bf16(pa3, PK(l3, h3), od, 0, 0, 0);
#undef PK
}
__device__ __forceinline__ void pv_d0(f32x16* o, int vb, bf16x8 pa0, bf16x8 pa1, bf16x8 pa2, bf16x8 pa3) {
  pv_one<0>(o[0], vb, pa0, pa1, pa2, pa3); pv_one<1>(o[1], vb, pa0, pa1, pa2, pa3); pv_one<2>(o[2], vb, pa0, pa1, pa2, pa3); pv_one<3>(o[3], vb, pa0, pa1, pa2, pa3);
}

struct SrcOne { const bf16_t* k0; const bf16_t* v0; int ldk;
  __device__ __forceinline__ const bf16_t* k(int j) const { return k0 + (size_t)j * 64 * ldk; }
  __device__ __forceinline__ const bf16_t* v(int j) const { return v0 + (size_t)j * 64 * ldk; } };
struct SrcTwo { const bf16_t* ck; const bf16_t* cv; const bf16_t* k1; const bf16_t* v1; int ldk;
  __device__ __forceinline__ const bf16_t* k(int j) const { return j < 4 ? ck + (size_t)j * 64 * ldk : k1 + (size_t)(j - 4) * 64 * ldk; }
  __device__ __forceinline__ const bf16_t* v(int j) const { return j < 4 ? cv + (size_t)j * 64 * ldk : v1 + (size_t)(j - 4) * 64 * ldk; } };
struct NoBias { __device__ __forceinline__ void operator()(f32x16&, f32x16&, int, int, int, int) const {} };
struct NaBias { const float* tab; int i0, kr0;
  __device__ __forceinline__ void operator()(f32x16& p0, f32x16& p1, int jt, int wid, int r32, int hi) const {
    if (jt < 4) return;
    const int qi = i0 + wid * QBLK + r32, r = qi >> 6, qc = qi & 63, kr = kr0 + jt - 4;
    int lo = r - 4; lo = lo < 0 ? 0 : (lo > 8 ? 8 : lo);
    const bool rowok = (kr >= lo) && (kr < lo + 8);
    if (!rowok) {
#pragma unroll
      for (int rr = 0; rr < 16; ++rr) { p0[rr] = -1e30f; p1[rr] = -1e30f; }
      return;
    }
    int c0 = qc - 8; c0 = c0 < 0 ? 0 : (c0 > 48 ? 48 : c0);
    const int dr = kr - r + 7;
    const float* tb = tab + dr * 31 + (4 * hi - qc + 15);
    const int w0 = 4 * hi - c0;
#pragma unroll
    for (int g = 0; g < 4; ++g) {
#pragma unroll
      for (int q = 0; q < 4; ++q) {
        const int rr = 4 * g + q, kc0 = q + 8 * g;
        const float t0 = tb[kc0], t1 = tb[kc0 + 32];
        p0[rr] = ((unsigned)(kc0 + w0) < 16u) ? p0[rr] + t0 : -1e30f;
        p1[rr] = ((unsigned)(kc0 + 32 + w0) < 16u) ? p1[rr] + t1 : -1e30f;
      }
      SBAR();
    }
  } };

template <int SD, class Src, class Bias>
__device__ ATT_INLINE void attn_body(const bf16_t* __restrict__ Qb, const Src src, bf16_t* __restrict__ Ob, const int NT, char* lds, const Bias bias) {
  const int tid = opaque_tid(), wid = tid >> 6, lane = tid & 63, r32 = lane & 31, hi = lane >> 5;
  const int LDK = src.ldk;
  bf16_t* V_lds = (bf16_t*)lds; bf16_t* K_lds = (bf16_t*)(lds + 2 * SHM_V);
  float* ws = (float*)(lds + 2 * SHM_V + 2 * SHM_K) + wid * 64; float* li_l = ws; float* al_l = ws + 32;
  float m_reg = -1e30f, l_reg = 0; f32x16 o[4] = {};
  bf16_t* Q_lds = (bf16_t*)(lds + 2 * SHM_V + 2 * SHM_K + NW * 64 * 4);
  const int qrow = wid * QBLK + r32;
  {
#pragma unroll
    for (int i = 0; i < 8; ++i) { const int f = tid + 512 * i, row = f >> 4, c8 = (f & 15) * 8;
      *(bf16x8*)((char*)Q_lds + KSWZ(row, c8 * 2)) = *reinterpret_cast<const bf16x8*>(Qb + (long)row * LDQ + c8); }
  }
  const int sr = tid >> 4, sc = (tid & 15) * 8, vst0 = v_st(sr, sc), vst1 = v_st(32 + sr, sc);
  const int vb0 = (int)(uintptr_t)V_lds + v_rd_base(lane);
  struct { bf16x8 vs0, vs1, ks0, ks1; } sr_[SD];
#define SLOAD(i, jt) do { const bf16_t* kt_ = src.k(jt); const bf16_t* vt_ = src.v(jt); \
    sr_[i].vs0 = *reinterpret_cast<const bf16x8*>(&vt_[(long)sr * LDK + sc]); sr_[i].vs1 = *reinterpret_cast<const bf16x8*>(&vt_[(long)(32 + sr) * LDK + sc]); \
    sr_[i].ks0 = *reinterpret_cast<const bf16x8*>(&kt_[(long)sr * LDK + sc]); sr_[i].ks1 = *reinterpret_cast<const bf16x8*>(&kt_[(long)(32 + sr) * LDK + sc]); } while (0)
#define SWRITE(b, i) do { *(bf16x8*)((char*)V_lds + (b) * SHM_V + vst0) = sr_[i].vs0;          \
    *(bf16x8*)((char*)V_lds + (b) * SHM_V + vst1) = sr_[i].vs1; int kc = sc * 2;               \
    *(bf16x8*)((char*)K_lds + (b) * SHM_K + KSWZ(sr, kc)) = sr_[i].ks0;                       \
    *(bf16x8*)((char*)K_lds + (b) * SHM_K + KSWZ(32 + sr, kc)) = sr_[i].ks1; } while (0)
#define SWAIT() do { if constexpr (SD == 2) asm volatile("s_waitcnt vmcnt(4)" ::: "memory"); else asm volatile("s_waitcnt vmcnt(0)" ::: "memory"); } while (0)
#define RESC(a) do { if (__any((a) < 1.f)) { if (hi == 0) al_l[r32] = (a); asm volatile("s_waitcnt lgkmcnt(0)" ::: "memory"); \
    for (int d = 0; d < 4; ++d) for (int r = 0; r < 16; ++r) o[d][r] *= al_l[crow(r, hi)]; } } while (0)
  f32x16 pA0, pA1, pB0, pB1; float mnA, mnB, alA, alB; bf16x8 pa0, pa1, pa2, pa3;
  constexpr int SE = 0, SO = SD - 1;
  SLOAD(SE, 0); asm volatile("s_waitcnt vmcnt(0)" ::: "memory"); SWRITE(0, SE); __syncthreads();
  qkt(pA0, pA1, K_lds, Q_lds, qrow, r32, hi); bias(pA0, pA1, 0, wid, r32, hi); partialSM(pA0, pA1, m_reg, mnA, alA);
  SLOAD(SO, 1); if constexpr (SD == 2) { if (2 < NT) SLOAD(SE, 2); }
  SWAIT(); SWRITE(1, SO); __syncthreads();
  for (int j = 1; j + 1 < NT; j += 2) {
    SBAR(); qkt(pB0, pB1, (bf16_t*)((char*)K_lds + SHM_K), Q_lds, qrow, r32, hi); bias(pB0, pB1, j, wid, r32, hi);
    finishSM(pA0, pA1, alA, l_reg, pa0, pa1, pa2, pa3); SBAR();
    SLOAD(SO, j + SD); SBAR();
    pv_d0(o, vb0, pa0, pa1, pa2, pa3); partialSM(pB0, pB1, m_reg, mnB, alB);
    __syncthreads(); SWAIT(); SWRITE(0, SE);
    RESC(alB); __syncthreads();
    SBAR(); qkt(pA0, pA1, K_lds, Q_lds, qrow, r32, hi); bias(pA0, pA1, j + 1, wid, r32, hi);
    finishSM(pB0, pB1, alB, l_reg, pa0, pa1, pa2, pa3); SBAR();
    if (SD == 1 || j + 3 < NT) SLOAD(SE, j + 1 + SD); SBAR();
    pv_d0(o, vb0 + (int)SHM_V, pa0, pa1, pa2, pa3); partialSM(pA0, pA1, m_reg, mnA, alA);
    __syncthreads(); SWAIT(); SWRITE(1, SO);
    RESC(alA); __syncthreads();
  }
  SBAR(); qkt(pB0, pB1, (bf16_t*)((char*)K_lds + SHM_K), Q_lds, qrow, r32, hi); bias(pB0, pB1, NT - 1, wid, r32, hi);
  finishSM(pA0, pA1, alA, l_reg, pa0, pa1, pa2, pa3); SBAR();
  pv_d0(o, vb0, pa0, pa1, pa2, pa3); partialSM(pB0, pB1, m_reg, mnB, alB);
  __syncthreads(); RESC(alB);
  finishSM(pB0, pB1, alB, l_reg, pa0, pa1, pa2, pa3); SBAR();
  pv_d0(o, vb0 + (int)SHM_V, pa0, pa1, pa2, pa3);
  if (hi == 0) li_l[r32] = l_reg; asm volatile("s_waitcnt lgkmcnt(0)" ::: "memory");
  float rli[16];
#pragma unroll
  for (int r = 0; r < 16; ++r) rli[r] = __builtin_amdgcn_rcpf(li_l[crow(r, hi)]);
  bf16_t* Ow = Ob + (long)(wid * QBLK) * LDO;
#pragma unroll
  for (int r = 0; r < 16; ++r) { int orow = crow(r, hi);
    for (int d0 = 0; d0 < 4; ++d0) Ow[(long)orow * LDO + d0 * 32 + r32] = f2bf(o[d0][r] * rli[r]); }
#undef SLOAD
#undef SWRITE
#undef SWAIT
#undef RESC
}
}
namespace gdn {
using att::bf16x8; using att::f32x16; using att::crow;
constexpr int C = 32, SK = 136, SS = 40;
constexpr int OFF_KT = 0, OFF_QT = OFF_KT + C * SK * 2, OFF_W = OFF_QT + C * SK * 2, OFF_KTT = OFF_W + C * SK * 2, OFF_VTT = OFF_KTT + 128 * SS * 2,
              OFF_VN = OFF_VTT + 128 * SS * 2, OFF_VNS = OFF_VN + 128 * SS * 2, OFF_ST = OFF_VNS + 128 * SS * 2, OFF_TB = OFF_ST + 128 * SK * 2,
              OFF_TBE = OFF_TB + C * SS * 2, OFF_ATT = OFF_TBE + C * SS * 2, OFF_L = OFF_ATT + C * SS * 2, OFF_SC = OFF_L + C * C * 4, GDN_LDS = OFF_SC + 1024;
template <int K>
__device__ __forceinline__ f32x16 mm(const bf16_t* A, int lda, const bf16_t* Bt, int ldb, int l32, int hi, f32x16 acc) {
#pragma unroll
    for (int k0 = 0; k0 < K; k0 += 16) {
        const bf16x8 a = *reinterpret_cast<const bf16x8*>(A + l32 * lda + k0 + 8 * hi);
        const bf16x8 b = *reinterpret_cast<const bf16x8*>(Bt + l32 * ldb + k0 + 8 * hi);
        acc = __builtin_amdgcn_mfma_f32_32x32x16_bf16(a, b, acc, 0, 0, 0);
    }
    return acc;
}
__device__ __forceinline__ uint2 pk4(float a, float b, float c, float d) { uint2 w; w.x = pack2(a, b); w.y = pack2(c, d); return w; }

__device__ __forceinline__ void gdn_chunked(const Params& p, int l, bool ctx, int b, int h, int dir, unsigned char* lds) {
    const int tid = opaque_tid(), wid = tid >> 6, lane = tid & 63, l32 = lane & 31, hi = lane >> 5;
    const int T = ctx ? CT : ::LT; const size_t m0 = ctx ? (size_t)b * CT : (size_t)MC + (size_t)b * ::LT;
    const bf16_t* DQ = WSP(bf16_t, WS_DQ); const bf16_t* DK = WSP(bf16_t, WS_DK); const bf16_t* DV = WSP(bf16_t, WS_DV); const float* DBA = WSP(float, WS_DBA);
    float* O = WSP(float, dir ? WS_DOB : WS_DOF);
    bf16_t* Kt = (bf16_t*)(lds + OFF_KT); bf16_t* Qt = (bf16_t*)(lds + OFF_QT); bf16_t* W = (bf16_t*)(lds + OFF_W); bf16_t* KT = (bf16_t*)(lds + OFF_KTT); bf16_t* VT = (bf16_t*)(lds + OFF_VTT);
    bf16_t* VN = (bf16_t*)(lds + OFF_VN); bf16_t* VNS = (bf16_t*)(lds + OFF_VNS); bf16_t* ST = (bf16_t*)(lds + OFF_ST); bf16_t* TB = (bf16_t*)(lds + OFF_TB); bf16_t* TBE = (bf16_t*)(lds + OFF_TBE);
    bf16_t* ATT = (bf16_t*)(lds + OFF_ATT); float* Lm = (float*)(lds + OFF_L); float* sc = (float*)(lds + OFF_SC);
    const int nch = T / C;
#define TOK(c, s_) (m0 + (dir ? T - 1 - ((c) * C + (s_)) : (c) * C + (s_)))
    f32x16 S[2];
#pragma unroll
    for (int bi = 0; bi < 2; ++bi) {
        const int blk = wid * 2 + bi, d0 = 32 * (blk >> 2), e0 = 32 * (blk & 3);
        if (ctx) { S[bi] = f32x16{}; }
        else {
            const float* s0 = p.in[I_SGDN] + ((((size_t)b * DEPTH + l) * 2 + dir) * 4 + h) * 128 * 128 + e0 + l32;
#pragma unroll
            for (int r = 0; r < 16; ++r) S[bi][r] = s0[(size_t)(d0 + crow(r, hi)) * 128];
        }
    }
    const int ls = tid >> 5, lc = (tid & 31) * 4;
    vf4 pq0, pq1, pk0, pk1, pv0, pv1; float pbeta = 0.f, pg = 0.f;
#define GLOAD(c) do { const size_t ma = TOK(c, ls), mb = TOK(c, ls + 16); \
        pq0 = ld4bf(DQ + ma * 512 + h * 128 + lc); pq1 = ld4bf(DQ + mb * 512 + h * 128 + lc); \
        pk0 = ld4bf(DK + ma * 512 + h * 128 + lc); pk1 = ld4bf(DK + mb * 512 + h * 128 + lc); \
        pv0 = ld4bf(DV + ma * 512 + h * 128 + lc); pv1 = ld4bf(DV + mb * 512 + h * 128 + lc); \
        if (tid < C) { const size_t mt = TOK(c, tid); pbeta = DBA[mt * 16 + dir * 4 + h]; pg = DBA[mt * 16 + 8 + dir * 4 + h]; } } while (0)
#define GSTAGE() do { \
        *(uint2*)(Kt + ls * SK + lc) = pk4(pk0.x, pk0.y, pk0.z, pk0.w); *(uint2*)(Kt + (ls + 16) * SK + lc) = pk4(pk1.x, pk1.y, pk1.z, pk1.w); \
        *(uint2*)(Qt + ls * SK + lc) = pk4(pq0.x, pq0.y, pq0.z, pq0.w); *(uint2*)(Qt + (ls + 16) * SK + lc) = pk4(pq1.x, pq1.y, pq1.z, pq1.w); \
        _Pragma("unroll") for (int j = 0; j < 4; ++j) { KT[(lc + j) * SS + ls] = f2bf(pk0[j]); KT[(lc + j) * SS + ls + 16] = f2bf(pk1[j]); \
                                                        VT[(lc + j) * SS + ls] = f2bf(pv0[j]); VT[(lc + j) * SS + ls + 16] = f2bf(pv1[j]); } \
        if (wid == 0) { float x = pg; _Pragma("unroll") for (int o_ = 1; o_ < 32; o_ <<= 1) { const float y = __shfl_up(x, o_); if (lane >= o_) x += y; } \
            const float Bt_ = __shfl(x, 31); if (lane < C) { sc[lane] = pbeta; sc[32 + lane] = x; sc[64 + lane] = __expf(x); sc[96 + lane] = __expf(Bt_ - x); if (lane == 0) sc[128] = __expf(Bt_); } } } while (0)
    __syncthreads();
    GLOAD(0);
#pragma unroll
    for (int bi = 0; bi < 2; ++bi) {
        const int blk = wid * 2 + bi, d0 = 32 * (blk >> 2), e0 = 32 * (blk & 3);
#pragma unroll
        for (int g = 0; g < 4; ++g) *(uint2*)(ST + (e0 + l32) * SK + d0 + 8 * g + 4 * hi) = pk4(S[bi][4 * g], S[bi][4 * g + 1], S[bi][4 * g + 2], S[bi][4 * g + 3]);
    }
    GSTAGE();
    __syncthreads();
    for (int c = 0; c < nch; ++c) {
        if (c + 1 < nch) GLOAD(c + 1);
        f32x16 acc1 = f32x16{};
        if (wid == 0) {
            const f32x16 kk = mm<128>(Kt, SK, Kt, SK, l32, hi, f32x16{});
            const float bi_ = sc[32 + l32], be = sc[l32];
#pragma unroll
            for (int r = 0; r < 16; ++r) { const int j = crow(r, hi); const float v = (l32 > j) ? be * kk[r] * __expf(bi_ - sc[32 + j]) : 0.f;
                Lm[l32 * 32 + ((r & 3) + 4 * hi) * 4 + (r >> 2)] = v; }
        } else if (wid == 1) {
            const f32x16 kq = mm<128>(Kt, SK, Qt, SK, l32, hi, f32x16{});
            const float bi_ = sc[32 + l32];
            float a[16];
#pragma unroll
            for (int r = 0; r < 16; ++r) { const int j = crow(r, hi); a[r] = (l32 >= j) ? kq[r] * __expf(bi_ - sc[32 + j]) : 0.f; }
#pragma unroll
            for (int g = 0; g < 4; ++g) *(uint2*)(ATT + l32 * SS + 8 * g + 4 * hi) = pk4(a[4 * g], a[4 * g + 1], a[4 * g + 2], a[4 * g + 3]);
        } else if (wid >= 4) {
            acc1 = mm<128>(Qt, SK, ST + (32 * (wid - 4)) * SK, SK, l32, hi, f32x16{});
#pragma unroll
            for (int r = 0; r < 16; ++r) acc1[r] *= sc[64 + crow(r, hi)];
        }
        __syncthreads();
        if (tid < 256) {
            const int cc = tid >> 3, part = tid & 7;
            float Tr[4] = {0.f, 0.f, 0.f, 0.f};
            const float* Lp = Lm + part * 4;
#pragma unroll
            for (int i = 0; i < 32; ++i) {
                const vf4 lv = *(const vf4*)(Lp + i * 32);
                float s = lv.x * Tr[0] + lv.y * Tr[1] + lv.z * Tr[2] + lv.w * Tr[3];
                s = red8(s);
                const float t = (i == cc ? 1.f : 0.f) - s;
                if (part == (i & 7)) Tr[i >> 3] = t;
            }
            const float bc = sc[cc], bec = bc * sc[64 + cc];
#pragma unroll
            for (int jj = 0; jj < 4; ++jj) { TB[(part + 8 * jj) * SS + cc] = f2bf(Tr[jj] * bc); TBE[(part + 8 * jj) * SS + cc] = f2bf(Tr[jj] * bec); }
        }
        __syncthreads();
        if (wid < 4) {
            acc1 = mm<32>(TB, SS, VT + (32 * wid) * SS, SS, l32, hi, f32x16{});
        } else {
            const int d0 = 32 * (wid - 4);
            const f32x16 wt = mm<32>(KT + d0 * SS, SS, TBE, SS, l32, hi, f32x16{});
#pragma unroll
            for (int g = 0; g < 4; ++g) *(uint2*)(W + l32 * SK + d0 + 8 * g + 4 * hi) = pk4(wt[4 * g], wt[4 * g + 1], wt[4 * g + 2], wt[4 * g + 3]);
        }
        __syncthreads();
        if (wid < 4) {
            const int e0 = 32 * wid;
            const f32x16 ws = mm<128>(W, SK, ST + e0 * SK, SK, l32, hi, f32x16{});
            float vn[16], vs[16];
#pragma unroll
            for (int r = 0; r < 16; ++r) { vn[r] = acc1[r] - ws[r]; vs[r] = vn[r] * sc[96 + crow(r, hi)]; }
#pragma unroll
            for (int g = 0; g < 4; ++g) { *(uint2*)(VN + (e0 + l32) * SS + 8 * g + 4 * hi) = pk4(vn[4 * g], vn[4 * g + 1], vn[4 * g + 2], vn[4 * g + 3]);
                                          *(uint2*)(VNS + (e0 + l32) * SS + 8 * g + 4 * hi) = pk4(vs[4 * g], vs[4 * g + 1], vs[4 * g + 2], vs[4 * g + 3]); }
        }
        __syncthreads();
        if (wid >= 4) {
            const int e0 = 32 * (wid - 4);
            acc1 = mm<32>(ATT, SS, VN + e0 * SS, SS, l32, hi, acc1);
#pragma unroll
            for (int r = 0; r < 16; ++r) O[TOK(c, crow(r, hi)) * 512 + h * 128 + e0 + l32] = acc1[r];
        }
        {
            const float eB = sc[128];
#pragma unroll
            for (int bi = 0; bi < 2; ++bi) {
                const int blk = wid * 2 + bi, d0 = 32 * (blk >> 2), e0 = 32 * (blk & 3);
#pragma unroll
                for (int r = 0; r < 16; ++r) S[bi][r] *= eB;
                S[bi] = mm<32>(KT + d0 * SS, SS, VNS + e0 * SS, SS, l32, hi, S[bi]);
            }
        }
        __syncthreads();
#pragma unroll
        for (int bi = 0; bi < 2; ++bi) {
            const int blk = wid * 2 + bi, d0 = 32 * (blk >> 2), e0 = 32 * (blk & 3);
#pragma unroll
            for (int g = 0; g < 4; ++g) *(uint2*)(ST + (e0 + l32) * SK + d0 + 8 * g + 4 * hi) = pk4(S[bi][4 * g], S[bi][4 * g + 1], S[bi][4 * g + 2], S[bi][4 * g + 3]);
        }
        if (c + 1 < nch) GSTAGE();
        __syncthreads();
    }
#undef GLOAD
#undef GSTAGE
#undef TOK
    if (ctx) {
#pragma unroll
        for (int bi = 0; bi < 2; ++bi) {
            const int blk = wid * 2 + bi, d0 = 32 * (blk >> 2), e0 = 32 * (blk & 3);
            float* so = p.out + O_SGDN + ((((size_t)b * DEPTH + l) * 2 + dir) * 4 + h) * 128 * 128 + e0 + l32;
#pragma unroll
            for (int r = 0; r < 16; ++r) so[(size_t)(d0 + crow(r, hi)) * 128] = S[bi][r];
        }
    }
}
}

namespace gla {
using att::bf16x8; using att::f32x16; using att::crow; using gdn::mm; using gdn::pk4;
constexpr int C = 32, SQ = 72, SS = 40;
constexpr int OFF_QE = 0, OFF_KN = OFF_QE + C * SQ * 2, OFF_KET = OFF_KN + C * SQ * 2, OFF_VT = OFF_KET + 64 * SS * 2, OFF_ATT = OFF_VT + 128 * SS * 2, OFF_ST = OFF_ATT + C * SS * 2,
              OFF_LA = OFF_ST + 128 * SQ * 2, OFF_EB = OFF_LA + C * 64 * 4, GLA_LDS = OFF_EB + 256;
__device__ __forceinline__ void gla_chunked(const Params& p, int l, bool ctx, int b, int h, int dir, unsigned char* lds) {
    const int tid = opaque_tid(), wid = tid >> 6, lane = tid & 63, l32 = lane & 31, hi = lane >> 5;
    const int T = ctx ? CT : ::LT; const size_t m0 = ctx ? (size_t)b * CT : (size_t)MC + (size_t)b * ::LT;
    const bf16_t* Z = WSP(bf16_t, WS_Z); const float* LA = WSP(float, dir ? WS_AB : WS_AF);
    float* O = WSP(float, dir ? WS_GOB : WS_GOF);
    bf16_t* Qe = (bf16_t*)(lds + OFF_QE); bf16_t* Kn = (bf16_t*)(lds + OFF_KN); bf16_t* KeT = (bf16_t*)(lds + OFF_KET); bf16_t* VT = (bf16_t*)(lds + OFF_VT);
    bf16_t* ATT = (bf16_t*)(lds + OFF_ATT); bf16_t* ST = (bf16_t*)(lds + OFF_ST); float* la = (float*)(lds + OFF_LA); float* eB = (float*)(lds + OFF_EB);
    const int nch = T / C;
#define TOK(c, s_) (m0 + (dir ? T - 1 - ((c) * C + (s_)) : (c) * C + (s_)))
    const int d0 = 32 * (wid >> 2), e0 = 32 * (wid & 3);
    f32x16 S;
    if (ctx) S = f32x16{};
    else {
        const float* s0 = p.in[I_SGLA] + ((((size_t)b * DEPTH + l) * 2 + dir) * 4 + h) * 64 * 128 + e0 + l32;
#pragma unroll
        for (int r = 0; r < 16; ++r) S[r] = s0[(size_t)(d0 + crow(r, hi)) * 128];
    }
    const int ts = tid >> 4, dc = (tid & 15) * 4, vs = tid >> 5, vc = (tid & 31) * 4;
    vf4 pq, pk, pl, pv0, pv1;
#define GLOAD(c) do { const size_t mt = TOK(c, ts), ma = TOK(c, vs), mb = TOK(c, vs + 16); \
        pq = ld4bf(Z + mt * NINP + Z_GLQ + h * 64 + dc); pk = ld4bf(Z + mt * NINP + Z_GLK + h * 64 + dc); pl = *(const vf4*)(LA + mt * 256 + h * 64 + dc); \
        pv0 = ld4bf(Z + ma * NINP + Z_GLV + h * 128 + vc); pv1 = ld4bf(Z + mb * NINP + Z_GLV + h * 128 + vc); } while (0)
#define WRITE_ST() do { _Pragma("unroll") for (int g = 0; g < 4; ++g) *(uint2*)(ST + (e0 + l32) * SQ + d0 + 8 * g + 4 * hi) = pk4(S[4 * g], S[4 * g + 1], S[4 * g + 2], S[4 * g + 3]); } while (0)
#define GIMAGES() do { vf4 pre = (vf4){0.f, 0.f, 0.f, 0.f}, tot = pre; \
        _Pragma("unroll 8") for (int t_ = 0; t_ < C; ++t_) { const vf4 v_ = *(const vf4*)(la + t_ * 64 + dc); tot += v_; if (t_ <= ts) pre += v_; } \
        float qe[4], kn[4]; \
        _Pragma("unroll") for (int j = 0; j < 4; ++j) { qe[j] = pq[j] * 0.125f * __expf(pre[j]); kn[j] = pk[j] * __expf(fminf(-pre[j], 80.f)); \
            KeT[(dc + j) * SS + ts] = f2bf(pk[j] * __expf(tot[j] - pre[j])); } \
        *(uint2*)(Qe + ts * SQ + dc) = pk4(qe[0], qe[1], qe[2], qe[3]); *(uint2*)(Kn + ts * SQ + dc) = pk4(kn[0], kn[1], kn[2], kn[3]); \
        if (ts == 0) { _Pragma("unroll") for (int j = 0; j < 4; ++j) eB[dc + j] = __expf(tot[j]); } \
        _Pragma("unroll") for (int j = 0; j < 4; ++j) { VT[(vc + j) * SS + vs] = f2bf(pv0[j]); VT[(vc + j) * SS + vs + 16] = f2bf(pv1[j]); } } while (0)
    __syncthreads();
    GLOAD(0);
    WRITE_ST();
    *(vf4*)(la + ts * 64 + dc) = pl;
    __syncthreads();
    GIMAGES();
    __syncthreads();
    for (int c = 0; c < nch; ++c) {
        if (c + 1 < nch) GLOAD(c + 1);
        f32x16 o1 = f32x16{};
        if (wid == 0) {
            const f32x16 kq = mm<64>(Kn, SQ, Qe, SQ, l32, hi, f32x16{});
            float a[16];
#pragma unroll
            for (int r = 0; r < 16; ++r) a[r] = (l32 >= crow(r, hi)) ? kq[r] : 0.f;
#pragma unroll
            for (int g = 0; g < 4; ++g) *(uint2*)(ATT + l32 * SS + 8 * g + 4 * hi) = pk4(a[4 * g], a[4 * g + 1], a[4 * g + 2], a[4 * g + 3]);
        } else if (wid >= 4) {
            o1 = mm<64>(Qe, SQ, ST + (32 * (wid - 4)) * SQ, SQ, l32, hi, f32x16{});
        }
        __syncthreads();
        if (wid >= 4) {
            const int eo = 32 * (wid - 4);
            o1 = mm<32>(ATT, SS, VT + eo * SS, SS, l32, hi, o1);
#pragma unroll
            for (int r = 0; r < 16; ++r) O[TOK(c, crow(r, hi)) * 512 + h * 128 + eo + l32] = o1[r];
        }
#pragma unroll
        for (int r = 0; r < 16; ++r) S[r] *= eB[d0 + crow(r, hi)];
        S = mm<32>(KeT + d0 * SS, SS, VT + e0 * SS, SS, l32, hi, S);
        __syncthreads();
        WRITE_ST();
        if (c + 1 < nch) *(vf4*)(la + ts * 64 + dc) = pl;
        __syncthreads();
        if (c + 1 < nch) GIMAGES();
        __syncthreads();
    }
#undef GLOAD
#undef WRITE_ST
#undef GIMAGES
#undef TOK
    if (ctx) {
        float* so = p.out + O_SGLA + ((((size_t)b * DEPTH + l) * 2 + dir) * 4 + h) * 64 * 128 + e0 + l32;
#pragma unroll
        for (int r = 0; r < 16; ++r) so[(size_t)(d0 + crow(r, hi)) * 128] = S[r];
    }
}
}
#define LAS __attribute__((address_space(3)))
constexpr int LDS_BYTES = 147456, XBW_OFF = LDS_BYTES - 64;
constexpr int NPH = 1 + DEPTH * 12;
#ifndef DBG_NLAYERS
#define DBG_NLAYERS DEPTH
#endif

#ifndef DUPKIND
#define DUPKIND 0
#endif
__device__ __forceinline__ int opaque_int(int v) { asm volatile("" : "+s"(v)); return v; }
#ifndef MIXMASK
#define MIXMASK 0xFF
#endif
#define FOR_ITEMS(it, n, o, w) for (int bo_ = (o) * (int)gridDim.x / 256, bw_ = ((w) * (int)gridDim.x / 256) > 0 ? ((w) * (int)gridDim.x / 256) : 1, \
                                    it = ((int)blockIdx.x >= bo_ && (int)blockIdx.x < bo_ + bw_) ? (int)blockIdx.x - bo_ : (n); it < (n); it += bw_)

#ifndef SPLITK
#define SPLITK 0
#endif
constexpr int FLAG_WORD0 = 8192;
constexpr int QCTR_WORD0 = 1024;
constexpr int NI_GDNL = LB * 8, NI_GLAL = LB * 8, NI_GDNC = CB * 8, NI_GQAL = LB * 16, NI_NAL = LB * 16, NI_GLAC = CB * 8, NI_NAC = CB * 4, NI_GQAC = CB * 4;
#define KM(k) (1 + ((DUPKIND >> (k)) & 1))
constexpr int Q0 = NI_GDNL * KM(0), Q1 = Q0 + NI_GQAL * KM(1), Q2 = Q1 + NI_NAL * KM(2), Q3 = Q2 + NI_GLAL * KM(3), Q4 = Q3 + NI_GDNC * KM(4), Q5 = Q4 + NI_NAC * KM(5), Q6 = Q5 + NI_GQAC * KM(6), Q7 = Q6 + NI_GLAC * KM(7);
__device__ __forceinline__ void phase_mix(const Params& p, int l, unsigned char* lds, int rep) {
    const int tid = opaque_tid();
    float* smem = (float*)lds;
    const bf16_t* NAQ = WSP(bf16_t, WS_NAQ); const bf16_t* NAK = WSP(bf16_t, WS_NAK); const bf16_t* NAV = WSP(bf16_t, WS_NAV);
    const bf16_t* GQ = WSP(bf16_t, WS_GQ); const bf16_t* GK = WSP(bf16_t, WS_GK); const bf16_t* GV = WSP(bf16_t, WS_GV);
    bf16_t* MRG = WSP(bf16_t, WS_MRG);
    unsigned* qctr = WSP(unsigned, WS_CTL) + QCTR_WORD0 + 64 * l + 16 * rep;
    volatile int* qslot = (volatile int*)(lds + XBW_OFF + 16);
    for (;;) {
        __syncthreads();
        if (tid == 0) *qslot = (int)__hip_atomic_fetch_add(qctr, 1u, __ATOMIC_RELAXED, __HIP_MEMORY_SCOPE_AGENT);
        __syncthreads();
        const int q = __builtin_amdgcn_readfirstlane(*qslot);
        if (q >= Q7) break;
        if (q < Q0) { const int it = q % NI_GDNL; gdn::gdn_chunked(p, l, false, it / 8, (it / 2) % 4, it % 2, lds); }
        else if (q < Q1) {
            const int it = (q - Q0) % NI_GQAL, b = it / 16, qh = (it / 4) % 4, qb = it % 4, kvh = qh >> 1;
            const size_t r0 = (size_t)MC + (size_t)b * LT;
            att::SrcTwo src{WSP(bf16_t, WS_CGK) + ((size_t)b * DEPTH + l) * 256 * 256 + kvh * 128, WSP(bf16_t, WS_CGV) + ((size_t)b * DEPTH + l) * 256 * 256 + kvh * 128,
                            GK + r0 * 256 + kvh * 128, GV + r0 * 256 + kvh * 128, 256};
            att::attn_body<2>(GQ + (r0 + qb * 256) * 512 + qh * 128, src, MRG + (r0 + qb * 256) * DM + 1024 + qh * 128, 4 + LT / 64, (char*)lds, att::NoBias{});
        }
        else if (q < Q2) {
            const int it = (q - Q1) % NI_NAL, b = it / 16, h = (it / 4) % 4, qb = it % 4;
            const int kr0 = qb == 0 ? 0 : qb == 1 ? 0 : qb == 2 ? 4 : 8, nrows = (qb == 0 || qb == 3) ? 8 : 12;
            const size_t r0 = (size_t)MC + (size_t)b * LT;
            float* tab = (float*)(lds + att::SHM_ATTN);
            if (tid < 15 * 31) tab[tid] = p.in[I_RPB][((size_t)l * 4 + h) * 15 * 31 + tid] * (1.0f / att::SCALE);
            att::SrcTwo src{WSP(bf16_t, WS_CNAK) + ((size_t)b * DEPTH + l) * 256 * 512 + h * 128, WSP(bf16_t, WS_CNAV) + ((size_t)b * DEPTH + l) * 256 * 512 + h * 128,
                            NAK + (r0 + kr0 * 64) * 512 + h * 128, NAV + (r0 + kr0 * 64) * 512 + h * 128, 512};
            att::attn_body<1>(NAQ + (r0 + qb * 256) * 512 + h * 128, src, MRG + (r0 + qb * 256) * DM + 0 + h * 128, 4 + nrows, (char*)lds, att::NaBias{tab, qb * 256, kr0});
        }
        else if (q < Q3) { const int it = (q - Q2) % NI_GLAL; gla::gla_chunked(p, l, false, it / 8, (it / 2) % 4, it % 2, lds); }
        else if (q < Q4) { const int it = (q - Q3) % NI_GDNC; gdn::gdn_chunked(p, l, true, it / 8, (it / 2) % 4, it % 2, lds); }
        else if (q < Q5) {
            const int it = (q - Q4) % NI_NAC, b = it / 4, h = it % 4; const size_t r0 = (size_t)b * CT;
            att::SrcOne src{NAK + r0 * 512 + h * 128, NAV + r0 * 512 + h * 128, 512};
            att::attn_body<2>(NAQ + r0 * 512 + h * 128, src, MRG + r0 * DM + 0 + h * 128, CT / 64, (char*)lds, att::NoBias{});
        }
        else if (q < Q6) {
            const int it = (q - Q5) % NI_GQAC, b = it / 4, qh = it % 4, kvh = qh >> 1; const size_t r0 = (size_t)b * CT;
            att::SrcOne src{GK + r0 * 256 + kvh * 128, GV + r0 * 256 + kvh * 128, 256};
            att::attn_body<2>(GQ + r0 * 512 + qh * 128, src, MRG + r0 * DM + 1024 + qh * 128, CT / 64, (char*)lds, att::NoBias{});
        }
        else { const int it = (q - Q6) % NI_GLAC; gla::gla_chunked(p, l, true, it / 8, (it / 2) % 4, it % 2, lds); }
    }
}

static_assert(att::SHM_ATTN + 15 * 31 * 4 + 2048 <= (size_t)XBW_OFF, "LDS map");
static_assert((QCTR_WORD0 + 64 * DEPTH) < 4096, "ctl");
constexpr int BAR_WORD0 = 4096;
static_assert((BAR_WORD0 + XCD_BAR_WORDS) * 4 <= (int)CTL_BYTES, "ctl");

__global__ void __launch_bounds__(512, 2) fwd(Params p) {
    extern __shared__ __attribute__((aligned(16))) unsigned char lds[];
    const int tid = threadIdx.x;
    volatile LAS unsigned* xbw = (volatile LAS unsigned*)((LAS unsigned char*)lds + XBW_OFF);
    if (tid < 4) xbw[tid] = 0u;
    __syncthreads();
    XcdBarrier bar; bar.bar = WSP(unsigned, WS_CTL) + BAR_WORD0; bar.x = 0; bar.st = xbw;
    if (p.ph_hi - p.ph_lo > 1) bar = xcd_barrier_post(WSP(unsigned, WS_CTL) + BAR_WORD0, xbw);
#ifndef PHMASK
#define PHMASK 0x1FFF
#endif
#define IN(k) (p.ph_lo <= (k) && (k) < p.ph_hi)
#define INL(j) (((PHMASK >> ((j) + 1)) & 1) && IN(pb + (j)))
#ifndef DUPMASK
#define DUPMASK 0
#endif
#define DUP(j) ((DUPMASK >> ((j) + 1)) & 1)
#if DUPMASK
#define REPS(j) opaque_int(1 + DUP(j))
#else
#define REPS(j) 1
#endif
#define SEAM(k) do { if (IN(k) && IN((k) + 1)) xcd_barrier(bar); } while (0)
    LAS unsigned char* ldsl = (LAS unsigned char*)lds;
    bf16_t* H = WSP(bf16_t, WS_H); bf16_t* ACT = WSP(bf16_t, WS_ACT); float* X = WSP(float, WS_X); float* Z = WSP(float, WS_Z); bf16_t* MRG = WSP(bf16_t, WS_MRG);

    if ((PHMASK & 1) && IN(0)) { const int reps_ = (DUPMASK & 1) ? opaque_int(2) : 1; for (int rep_ = 0; rep_ < reps_; ++rep_) { const Params q = opaque_params(p); phase_prologue(q, (float*)lds); __syncthreads(); } }
    SEAM(0);
    for (int l = 0; l < DBG_NLAYERS; ++l) {
        const int pb = 1 + l * 12;
        const float* modl = WSP(float, WS_MODV) + (size_t)l * NCOND * NMOD;
        if (INL(0)) { const int reps_ = REPS(0); for (int rep_ = 0; rep_ < reps_; ++rep_) { const Params q = opaque_params(p); phase_norm(q, l, 0); __syncthreads(); } }
        SEAM(pb + 0);
        if (INL(1)) {
            pg8::Gemm g{H, WSP(bf16_t, WS_WGU) + ((size_t)l * 2 + 0) * NGU * DM, M, NGU, DM}; pg8::StaticOrder S; S.init(M, NGU, DM, (int)gridDim.x, (int)blockIdx.x);
            pg8::EpiSwiGLU E{ACT, FF};
            for (int r_ = 0, n_ = REPS(1); r_ < n_; ++r_) pg8::gemm_phase<pg8::EpiSwiGLU, pg8::StaticOrder, false>(ldsl, g, S, E, nullptr);
#if CONV_FILLER
            if (l + 1 < DBG_NLAYERS) {
                const int nw_ = (M / 256) * (NGU / 256), G_ = (int)gridDim.x; int f0_ = nw_ % G_; if (nw_ < G_) f0_ = 0;
                if ((int)blockIdx.x >= f0_) { const Params q = opaque_params(p); mod_layer(q, l + 1, (int)blockIdx.x - f0_, G_ - f0_, (float*)lds); }
            }
#endif
        }
        SEAM(pb + 1);
        if (INL(2)) {
            pg8::Gemm g{ACT, WSP(bf16_t, WS_WDN) + ((size_t)l * 2 + 0) * DM * FF, M, DM, FF}; pg8::StaticOrder S; S.init(M, DM, FF, (int)gridDim.x, (int)blockIdx.x, SPLITK);
            pg8::EpiResid E{l == 0 ? p.in[I_XP] : X, X, DM, modl + 2 * DM, 0.5f, Z, WSP(unsigned, WS_CTL) + FLAG_WORD0, 8u * (unsigned)(l * 3 + 1), l == 0 ? p.in[I_XS] : X, l == 0 ? MC : 0x7FFFFFFF};
            pg8::gemm_phase<pg8::EpiResid, pg8::StaticOrder, false>(ldsl, g, S, E, nullptr);
#if CONV_FILLER
            if (l + 1 < DBG_NLAYERS) {
                const int nw_ = (M / 256) * (DM / 256), G_ = (int)gridDim.x; int f0_ = nw_ - G_; if (f0_ < 0 || f0_ >= G_) f0_ = 0;
                if ((int)blockIdx.x >= f0_) { const Params q = opaque_params(p); conv_layer_tiles(q, l + 1, 0, (NT_L * 2 / 5), (int)blockIdx.x - f0_, G_ - f0_, (float*)lds); }
            }
#endif
#if DUPMASK
            if (opaque_int(DUP(2))) { pg8::EpiResid E2{X, Z, DM, modl + 2 * DM, 0.5f, Z, WSP(unsigned, WS_CTL) + FLAG_WORD0, 0u, X, 0x7FFFFFFF}; pg8::gemm_phase<pg8::EpiResid, pg8::StaticOrder, false>(ldsl, g, S, E2, nullptr); }
#endif
        }
        SEAM(pb + 2);
        if (INL(3)) { const int reps_ = REPS(3); for (int rep_ = 0; rep_ < reps_; ++rep_) { const Params q = opaque_params(p); phase_norm(q, l, 1); __syncthreads(); } }
        SEAM(pb + 3);
        if (INL(4)) {
            pg8::Gemm g{H, WSP(bf16_t, WS_WIN) + (size_t)l * NINP * DM, M, NINP, DM}; pg8::StaticOrder S; S.init(M, NINP, DM, (int)gridDim.x, (int)blockIdx.x);
            pg8::EpiBf16Plain E{WSP(bf16_t, WS_Z), NINP};
            for (int r_ = 0, n_ = REPS(4); r_ < n_; ++r_) pg8::gemm_phase<pg8::EpiBf16Plain, pg8::StaticOrder, false>(ldsl, g, S, E, nullptr);
        }
        SEAM(pb + 4);
        if (INL(5)) { const int reps_ = REPS(5); for (int rep_ = 0; rep_ < reps_; ++rep_) { const Params q = opaque_params(p); phase_prep(q, l); __syncthreads(); } }
        SEAM(pb + 5);
        if (INL(6)) { const int reps_ = REPS(6); for (int rep_ = 0; rep_ < reps_; ++rep_) { const Params q = opaque_params(p); phase_mix(q, l, lds, rep_); __syncthreads(); } }
        SEAM(pb + 6);
        if (INL(7)) { const int reps_ = REPS(7); for (int rep_ = 0; rep_ < reps_; ++rep_) { const Params q = opaque_params(p); phase_post(q, l); __syncthreads(); } }
        SEAM(pb + 7);
        if (INL(8)) {
            pg8::Gemm g{MRG, WSP(bf16_t, WS_WOUT) + (size_t)l * DM * DM, M, DM, DM}; pg8::StaticOrder S; S.init(M, DM, DM, (int)gridDim.x, (int)blockIdx.x, SPLITK);
            pg8::EpiResid E{X, X, DM, modl + 5 * DM, 1.0f, Z, WSP(unsigned, WS_CTL) + FLAG_WORD0, 8u * (unsigned)(l * 3 + 2), X, 0x7FFFFFFF};
            pg8::gemm_phase<pg8::EpiResid, pg8::StaticOrder, false>(ldsl, g, S, E, nullptr);
#if CONV_FILLER
            if (l + 1 < DBG_NLAYERS) {
                const int nw_ = (M / 256) * (DM / 256), G_ = (int)gridDim.x; int f0_ = nw_ - G_; if (f0_ < 0 || f0_ >= G_) f0_ = 0;
                if ((int)blockIdx.x >= f0_) { const Params q = opaque_params(p); conv_layer_tiles(q, l + 1, (NT_L * 2 / 5), (NT_L * 3 / 5), (int)blockIdx.x - f0_, G_ - f0_, (float*)lds); }
            }
#endif
#if DUPMASK
            if (opaque_int(DUP(8))) { pg8::EpiResid E2{X, Z, DM, modl + 5 * DM, 1.0f, Z, WSP(unsigned, WS_CTL) + FLAG_WORD0, 0u, X, 0x7FFFFFFF}; pg8::gemm_phase<pg8::EpiResid, pg8::StaticOrder, false>(ldsl, g, S, E2, nullptr); }
#endif
        }
        SEAM(pb + 8);
        if (INL(9)) { const int reps_ = REPS(9); for (int rep_ = 0; rep_ < reps_; ++rep_) { const Params q = opaque_params(p); phase_norm(q, l, 2); __syncthreads(); } }
        SEAM(pb + 9);
        if (INL(10)) {
            pg8::Gemm g{H, WSP(bf16_t, WS_WGU) + ((size_t)l * 2 + 1) * NGU * DM, M, NGU, DM}; pg8::StaticOrder S; S.init(M, NGU, DM, (int)gridDim.x, (int)blockIdx.x);
            pg8::EpiSwiGLU E{ACT, FF};
            pg8::gemm_phase<pg8::EpiSwiGLU, pg8::StaticOrder, false>(ldsl, g, S, E, nullptr);
        }
        SEAM(pb + 10);
        if (INL(11)) {
            pg8::Gemm g{ACT, WSP(bf16_t, WS_WDN) + ((size_t)l * 2 + 1) * DM * FF, M, DM, FF}; pg8::StaticOrder S; S.init(M, DM, FF, (int)gridDim.x, (int)blockIdx.x, SPLITK);
            pg8::EpiResid E{X, (l == DEPTH - 1) ? p.out : X, DM, modl + 8 * DM, 0.5f, Z, WSP(unsigned, WS_CTL) + FLAG_WORD0, 8u * (unsigned)(l * 3 + 3), X, 0x7FFFFFFF};
            pg8::gemm_phase<pg8::EpiResid, pg8::StaticOrder, false>(ldsl, g, S, E, nullptr);
#if CONV_FILLER
            if (l + 1 < DBG_NLAYERS) {
                const int nw_ = (M / 256) * (DM / 256), G_ = (int)gridDim.x; int f0_ = nw_ - G_; if (f0_ < 0 || f0_ >= G_) f0_ = 0;
                if ((int)blockIdx.x >= f0_) { const Params q = opaque_params(p); conv_layer_tiles(q, l + 1, (NT_L * 3 / 5), NT_L, (int)blockIdx.x - f0_, G_ - f0_, (float*)lds); }
            }
#endif
        }
        SEAM(pb + 11);
    }
#undef IN
#undef SEAM
}

#ifndef MULTI_LAUNCH
#define MULTI_LAUNCH 0
#endif
extern "C" void kernel_launch(void* const* d_in, const int* in_sizes, int n_in, void* d_out, int out_size, void* d_ws, size_t ws_size, hipStream_t stream) {
    static int grid = 0;
    if (grid == 0) {
        if (n_in != N_IN || (size_t)out_size != O_END || ws_size < WS_END) { fprintf(stderr, "kernel_launch: shape mismatch n_in %d out %d ws %zu (need %zu)\n", n_in, out_size, ws_size, (size_t)WS_END); grid = -1; return; }
        int dev = 0, cus = 0, per_cu = 0;
        if (hipGetDevice(&dev) != hipSuccess || hipDeviceGetAttribute(&cus, hipDeviceAttributeMultiprocessorCount, dev) != hipSuccess) { grid = -1; return; }
        if (hipFuncSetAttribute((const void*)fwd, hipFuncAttributeMaxDynamicSharedMemorySize, LDS_BYTES) != hipSuccess) { fprintf(stderr, "kernel_launch: hipFuncSetAttribute failed\n"); grid = -1; return; }
        if (hipOccupancyMaxActiveBlocksPerMultiprocessor(&per_cu, (const void*)fwd, 512, LDS_BYTES) != hipSuccess || per_cu < 1) { fprintf(stderr, "kernel_launch: occupancy query says %d\n", per_cu); (void)hipGetLastError(); }
        grid = cus;
    }
    if (grid < 0) return;
    (void)hipMemsetAsync((char*)d_ws + WS_CTL, 0, CTL_BYTES, stream);
    Params p{};
    for (int i = 0; i < N_IN; ++i) p.in[i] = (const float*)d_in[i];
    p.out = (float*)d_out; p.ws = (unsigned char*)d_ws;
#if MULTI_LAUNCH
    for (int ph = 0; ph < 1 + DBG_NLAYERS * 12; ++ph) { p.ph_lo = ph; p.ph_hi = ph + 1; hipLaunchKernelGGL(fwd, dim3(grid), dim3(512), LDS_BYTES, stream, p); }
#else
    p.ph_lo = 0; p.ph_hi = NPH; hipLaunchKernelGGL(fwd, dim3(grid), dim3(512), LDS_BYTES, stream, p);
#endif
    const hipError_t le = hipPeekAtLastError();
    if (le != hipSuccess) fprintf(stderr, "kernel_launch: launch failed: %s\n", hipGetErrorName(le));
}
```

```cpp
#include <hip/hip_runtime.h>
#include <cstdio>
#include <cstdint>

#ifndef CB_
#define CB_ 16
#endif
#ifndef LB_
#define LB_ 8
#endif
#ifndef DEPTH_
#define DEPTH_ 4
#endif
constexpr int DM = 2048, DEPTH = DEPTH_, CB = CB_, CT = 256, LB = LB_, LT = 1024;
constexpr int MC = CB * CT, ML = LB * LT, M = MC + ML;
constexpr int FF = 5504, NGU = 2 * FF, NIN = 6192, NINP = 6400, NMOD = 9 * DM, NCOND = 1 + LB;
constexpr float EPS = 1e-6f;
constexpr int Z_NAQ = 0, Z_NAK = 512, Z_NAV = 1024, Z_GLQ = 1536, Z_GLK = 1792, Z_GLV = 2048, Z_GLR = 2560, Z_GF = 3072, Z_GB = 3088,
              Z_GQQ = 3104, Z_GQK = 3616, Z_GQV = 3872, Z_DQKV = 4128, Z_DZ = 5664, Z_DB = 6176, Z_DA = 6184;
static_assert(Z_DA + 8 == NIN, "split");
enum { I_XP = 0, I_XS, I_CNAK, I_CNAV, I_CGK, I_CGV, I_SGLA, I_SGDN, I_C, I_CCTX, I_NORMG, I_WMOD, I_BMOD, I_GU, I_DOWN, I_WIN, I_WOUT, I_NAQKN, I_RPB,
       I_GUP, I_GBIAS, I_GLAON, I_GQAQKN, I_CONV, I_ALOG, I_DTB, I_GDNON, N_IN };
constexpr size_t O_YP = 0, O_YS = O_YP + (size_t)MC * DM, O_NAK = O_YS + (size_t)ML * DM, O_NAV = O_NAK + (size_t)CB * DEPTH * 4 * CT * 128,
                 O_GK = O_NAV + (size_t)CB * DEPTH * 4 * CT * 128, O_GV = O_GK + (size_t)CB * DEPTH * 2 * CT * 128,
                 O_SGLA = O_GV + (size_t)CB * DEPTH * 2 * CT * 128, O_SGDN = O_SGLA + (size_t)CB * DEPTH * 2 * 4 * 64 * 128,
                 O_END = O_SGDN + (size_t)CB * DEPTH * 2 * 4 * 128 * 128;
constexpr size_t al256(size_t x) { return (x + 255) & ~(size_t)255; }
constexpr size_t WS_CTL = 0, CTL_BYTES = 1u << 20;
constexpr size_t WS_WGU = CTL_BYTES;
constexpr size_t WS_WDN = WS_WGU + (size_t)DEPTH * 2 * NGU * DM * 2;
constexpr size_t WS_WIN = WS_WDN + (size_t)DEPTH * 2 * DM * FF * 2;
constexpr size_t WS_WOUT = WS_WIN + (size_t)DEPTH * NINP * DM * 2;
constexpr size_t WS_MODV = WS_WOUT + (size_t)DEPTH * DM * DM * 2;
constexpr size_t WS_ROPE = al256(WS_MODV + (size_t)DEPTH * NCOND * NMOD * 4);
constexpr size_t WS_X = al256(WS_ROPE + 2 * 64 * 32 * 4);
constexpr size_t WS_H = WS_X + (size_t)M * DM * 4;
constexpr size_t WS_ACT = WS_H + (size_t)M * DM * 2;
constexpr size_t WS_Z = WS_ACT + (size_t)M * FF * 2;
constexpr size_t WS_MRG = WS_Z + (size_t)M * NINP * 4;
constexpr size_t WS_NAQ = WS_MRG + (size_t)M * DM * 2;
constexpr size_t WS_NAK = WS_NAQ + (size_t)M * 512 * 2;
constexpr size_t WS_NAV = WS_NAK + (size_t)M * 512 * 2;
constexpr size_t WS_GQ = WS_NAV + (size_t)M * 512 * 2;
constexpr size_t WS_GK = WS_GQ + (size_t)M * 512 * 2;
constexpr size_t WS_GV = WS_GK + (size_t)M * 256 * 2;
constexpr size_t WS_CNAK = WS_GV + (size_t)M * 256 * 2;
constexpr size_t WS_CNAV = WS_CNAK + (size_t)LB * DEPTH * 256 * 512 * 2;
constexpr size_t WS_CGK = WS_CNAV + (size_t)LB * DEPTH * 256 * 512 * 2;
constexpr size_t WS_CGV = WS_CGK + (size_t)LB * DEPTH * 256 * 256 * 2;
constexpr size_t WS_AF = WS_CGV + (size_t)LB * DEPTH * 256 * 256 * 2;
constexpr size_t WS_AB = WS_AF + (size_t)M * 256 * 4;
constexpr size_t WS_DQ = WS_AB + (size_t)M * 256 * 4;
constexpr size_t WS_DK = WS_DQ + (size_t)M * 512 * 4;
constexpr size_t WS_DV = WS_DK + (size_t)M * 512 * 4;
constexpr size_t WS_DBA = WS_DV + (size_t)M * 512 * 4;
constexpr size_t WS_GOF = WS_DBA + (size_t)M * 16 * 4;
constexpr size_t WS_GOB = WS_GOF + (size_t)M * 512 * 4;
constexpr size_t WS_DOF = WS_GOB + (size_t)M * 512 * 4;
constexpr size_t WS_DOB = WS_DOF + (size_t)M * 512 * 4;
constexpr size_t WS_END = WS_DOB + (size_t)M * 512 * 4;

typedef unsigned short bf16_t;
struct Params { const float* in[N_IN]; float* out; unsigned char* ws; int ph_lo, ph_hi; };
static_assert(sizeof(Params) == N_IN * 8 + 8 + 8 + 8, "no padding");

#define WSP(T, off) ((T*)(p.ws + (off)))
__device__ __forceinline__ int opaque_tid() { int t = (int)threadIdx.x; asm volatile("" : "+v"(t)); return t; }
__device__ __forceinline__ Params opaque_params(const Params& p) { Params q = p; unsigned long long w = (unsigned long long)q.ws; asm volatile("" : "+s"(w)); q.ws = (unsigned char*)w; return q; }

typedef float vf4 __attribute__((ext_vector_type(4)));
__device__ __forceinline__ float bf2f(unsigned short v) { return __uint_as_float((unsigned)v << 16); }
__device__ __forceinline__ vf4 ld4bf(const unsigned short* p) { const uint2 w = *(const uint2*)p; vf4 r; r.x = __uint_as_float(w.x << 16); r.y = __uint_as_float(w.x & 0xFFFF0000u); r.z = __uint_as_float(w.y << 16); r.w = __uint_as_float(w.y & 0xFFFF0000u); return r; }
__device__ __forceinline__ void ld8bf(const unsigned short* p, vf4& a, vf4& b) { const uint4 w = *(const uint4*)p;
    a.x = __uint_as_float(w.x << 16); a.y = __uint_as_float(w.x & 0xFFFF0000u); a.z = __uint_as_float(w.y << 16); a.w = __uint_as_float(w.y & 0xFFFF0000u);
    b.x = __uint_as_float(w.z << 16); b.y = __uint_as_float(w.z & 0xFFFF0000u); b.z = __uint_as_float(w.w << 16); b.w = __uint_as_float(w.w & 0xFFFF0000u); }
__device__ __forceinline__ float wave_sum(float v) {
#pragma unroll
    for (int o = 32; o >= 1; o >>= 1) v += __shfl_xor(v, o);
    return v;
}
__device__ __forceinline__ bf16_t f2bf(float f) { unsigned u = __float_as_uint(f); u += 0x7FFFu + ((u >> 16) & 1u); return (bf16_t)(u >> 16); }
__device__ __forceinline__ unsigned pack2(float a, float b) { return (unsigned)f2bf(a) | ((unsigned)f2bf(b) << 16); }
__device__ __forceinline__ float silu_f(float x) { return x / (1.f + expf(-x)); }
__device__ __forceinline__ float softplus_f(float x) { return fmaxf(x, 0.f) + log1pf(expf(-fabsf(x))); }
__device__ __forceinline__ float logsigmoid_f(float x) { return fminf(x, 0.f) - log1pf(expf(-fabsf(x))); }
__device__ __forceinline__ int cond_of_row(int m) { return m < MC ? 0 : 1 + (m - MC) / LT; }
#ifndef CONV_FILLER
#define CONV_FILLER 1
#endif
__device__ __forceinline__ void conv_tile(const float* __restrict__ src, int ld_src, int ncols_src, int k0, int c0, bf16_t* __restrict__ dst, int ld_dst, int n0, float* tile) {
    const int tid = opaque_tid();
    {
        const int r = tid >> 3, c = (tid & 7) * 8;
        float4 a = make_float4(0.f, 0.f, 0.f, 0.f), b = a;
        if (c0 + c + 8 <= ncols_src) {
            const float* s = src + (size_t)(k0 + r) * ld_src + c0 + c;
            a = *(const float4*)s; b = *(const float4*)(s + 4);
        }
        float* t = tile + r * 65 + c;
        t[0] = a.x; t[1] = a.y; t[2] = a.z; t[3] = a.w; t[4] = b.x; t[5] = b.y; t[6] = b.z; t[7] = b.w;
    }
    __syncthreads();
    {
        const int n = tid >> 3, ks = (tid & 7) * 8;
        const float* t = tile + ks * 65 + n;
        uint4 w;
        w.x = pack2(t[0 * 65], t[1 * 65]); w.y = pack2(t[2 * 65], t[3 * 65]); w.z = pack2(t[4 * 65], t[5 * 65]); w.w = pack2(t[6 * 65], t[7 * 65]);
        *(uint4*)(dst + (size_t)(n0 + n) * ld_dst + k0 + ks) = w;
    }
    __syncthreads();
}

constexpr int MOD_ITEMS = DEPTH * (NMOD / 128);
constexpr int TGU_KT = DM / 64, TGU_NT = NGU / 64, TDN_KT = FF / 64, TDN_NT = DM / 64, TIN_KT = DM / 64, TIN_NT = NINP / 64, TOUT_KT = DM / 64, TOUT_NT = DM / 64;
constexpr int TL_GU = 2 * TGU_KT * TGU_NT, TL_DN = 2 * TDN_KT * TDN_NT, TL_IN = TIN_KT * TIN_NT, TL_OUT = TOUT_KT * TOUT_NT, NT_L = TL_GU + TL_DN + TL_IN + TL_OUT;
__device__ __forceinline__ void conv_layer_tiles(const Params& p, int l, int t_begin, int t_end, int first, int stride, float* s_tile) {
    for (int it = t_begin + first; it < t_end; it += stride) {
        if (it < TL_GU) {
            const int mat = l * 2 + it / (TGU_KT * TGU_NT), r = it % (TGU_KT * TGU_NT), kt = r / TGU_NT, nt = r % TGU_NT;
            const int n0 = nt * 64, t256 = n0 / 256, c = n0 % 256;
            const int c0 = c < 128 ? 128 * t256 + c : FF + 128 * t256 + (c - 128);
            conv_tile(p.in[I_GU] + (size_t)mat * DM * NGU, NGU, NGU, kt * 64, c0, WSP(bf16_t, WS_WGU) + (size_t)mat * NGU * DM, DM, n0, s_tile);
        } else if (it < TL_GU + TL_DN) {
            const int i2 = it - TL_GU, mat = l * 2 + i2 / (TDN_KT * TDN_NT), r = i2 % (TDN_KT * TDN_NT), kt = r / TDN_NT, nt = r % TDN_NT;
            conv_tile(p.in[I_DOWN] + (size_t)mat * FF * DM, DM, DM, kt * 64, nt * 64, WSP(bf16_t, WS_WDN) + (size_t)mat * DM * FF, FF, nt * 64, s_tile);
        } else if (it < TL_GU + TL_DN + TL_IN) {
            const int i2 = it - TL_GU - TL_DN, kt = i2 / TIN_NT, nt = i2 % TIN_NT;
            conv_tile(p.in[I_WIN] + (size_t)l * DM * NIN, NIN, NIN, kt * 64, nt * 64, WSP(bf16_t, WS_WIN) + (size_t)l * NINP * DM, DM, nt * 64, s_tile);
        } else {
            const int i2 = it - TL_GU - TL_DN - TL_IN, kt = i2 / TOUT_NT, nt = i2 % TOUT_NT;
            conv_tile(p.in[I_WOUT] + (size_t)l * DM * DM, DM, DM, kt * 64, nt * 64, WSP(bf16_t, WS_WOUT) + (size_t)l * DM * DM, DM, nt * 64, s_tile);
        }
    }
}

__device__ __forceinline__ void mod_layer(const Params& p, int l, int first, int stride, float* smem) {
    const int tid = opaque_tid();
    float* s_cond = smem;
    float* s_red = s_cond + NCOND * DM;
    __syncthreads();
    for (int i = tid; i < NCOND * DM; i += 512) { const int ci = i / DM, k = i % DM; const float v = ci == 0 ? p.in[I_CCTX][k] : p.in[I_C][(size_t)(ci - 1) * DM + k]; s_cond[i] = silu_f(v); }
    __syncthreads();
    float* modv = WSP(float, WS_MODV);
    for (int jt = first; jt < NMOD / 128; jt += stride) {
        const int cl = tid & 127, kq = tid >> 7, col = jt * 128 + cl;
        const float* w = p.in[I_WMOD] + (size_t)l * DM * NMOD + col;
        float acc[NCOND];
#pragma unroll
        for (int ci = 0; ci < NCOND; ++ci) acc[ci] = 0.f;
        for (int k = kq * 512; k < kq * 512 + 512; k += 8) {
            float wv[8];
#pragma unroll
            for (int j = 0; j < 8; ++j) wv[j] = w[(size_t)(k + j) * NMOD];
#pragma unroll
            for (int ci = 0; ci < NCOND; ++ci) {
                const float4 s0 = *(const float4*)&s_cond[ci * DM + k], s1 = *(const float4*)&s_cond[ci * DM + k + 4];
                acc[ci] += s0.x * wv[0] + s0.y * wv[1] + s0.z * wv[2] + s0.w * wv[3] + s1.x * wv[4] + s1.y * wv[5] + s1.z * wv[6] + s1.w * wv[7];
            }
        }
        if (kq > 0) {
#pragma unroll
            for (int ci = 0; ci < NCOND; ++ci) s_red[((kq - 1) * 128 + cl) * NCOND + ci] = acc[ci];
        }
        __syncthreads();
        if (kq == 0) {
            const float bm = p.in[I_BMOD][(size_t)l * NMOD + col];
#pragma unroll
            for (int ci = 0; ci < NCOND; ++ci)
                modv[((size_t)l * NCOND + ci) * NMOD + col] = acc[ci] + s_red[(0 * 128 + cl) * NCOND + ci] + s_red[(1 * 128 + cl) * NCOND + ci] + s_red[(2 * 128 + cl) * NCOND + ci] + bm;
        }
        __syncthreads();
    }
}

__device__ __forceinline__ void phase_prologue(const Params& p, float* smem) {
    const int tid = threadIdx.x, nb = gridDim.x, bid = blockIdx.x;
    float* s_tile = smem + NCOND * DM + 3 * 128 * NCOND;
#if CONV_FILLER
    mod_layer(p, 0, bid, nb, smem);
#else
    for (int l2 = 0; l2 < DEPTH; ++l2) mod_layer(p, l2, bid, nb, smem);
#endif
    conv_layer_tiles(p, 0, 0, NT_L, bid, nb, s_tile);
#if !CONV_FILLER
    for (int l2 = 1; l2 < DEPTH; ++l2) conv_layer_tiles(p, l2, 0, NT_L, bid, nb, s_tile);
#endif
    const size_t gtid = (size_t)bid * 512 + tid, gstride = (size_t)nb * 512;
    {
        const size_t n_na = (size_t)LB * DEPTH * 256 * 512 / 8;
        for (size_t i = gtid; i < 2 * n_na; i += gstride) {
            const bool isv = i >= n_na; const size_t j = isv ? i - n_na : i;
            const int d8 = (int)(j % 16), h = (int)((j / 16) % 4), t = (int)((j / 64) % 256); const size_t bl = j / (64 * 256);
            const float* s = p.in[isv ? I_CNAV : I_CNAK] + ((bl * 4 + h) * 256 + t) * 128 + d8 * 8;
            const float4 a = *(const float4*)s, b = *(const float4*)(s + 4);
            uint4 w; w.x = pack2(a.x, a.y); w.y = pack2(a.z, a.w); w.z = pack2(b.x, b.y); w.w = pack2(b.z, b.w);
            *(uint4*)(WSP(bf16_t, isv ? WS_CNAV : WS_CNAK) + (bl * 256 + t) * 512 + h * 128 + d8 * 8) = w;
        }
        const size_t n_g = (size_t)LB * DEPTH * 256 * 256 / 8;
        for (size_t i = gtid; i < 2 * n_g; i += gstride) {
            const bool isv = i >= n_g; const size_t j = isv ? i - n_g : i;
            const int d8 = (int)(j % 16), h = (int)((j / 16) % 2), t = (int)((j / 32) % 256); const size_t bl = j / (32 * 256);
            const float* s = p.in[isv ? I_CGV : I_CGK] + ((bl * 2 + h) * 256 + t) * 128 + d8 * 8;
            const float4 a = *(const float4*)s, b = *(const float4*)(s + 4);
            uint4 w; w.x = pack2(a.x, a.y); w.y = pack2(a.z, a.w); w.z = pack2(b.x, b.y); w.w = pack2(b.z, b.w);
            *(uint4*)(WSP(bf16_t, isv ? WS_CGV : WS_CGK) + (bl * 256 + t) * 256 + h * 128 + d8 * 8) = w;
        }
    }
    for (size_t i = gtid; i < 64 * 32; i += gstride) {
        const int pos = (int)(i / 32), k = (int)(i % 32);
        const float inv = powf(10000.0f, -(float)(2 * k) / 64.0f);
        const float ang = (float)pos * inv;
        WSP(float, WS_ROPE)[i] = cosf(ang); WSP(float, WS_ROPE)[64 * 32 + i] = sinf(ang);
    }
}

__device__ __forceinline__ void phase_norm(const Params& p, int l, int which  ) {
    const int tid = opaque_tid(), lane = tid & 63, wv = tid >> 6;
    const float* X = WSP(float, WS_X); bf16_t* H = WSP(bf16_t, WS_H);
    const bool from_in = (l == 0 && which == 0);
    const float* g = p.in[I_NORMG] + ((size_t)l * 3 + which) * DM;
    const int nw = (int)gridDim.x * 8;
    for (int m0 = blockIdx.x * 8 + wv; m0 < M; m0 += 2 * nw) {
        const int m1 = m0 + nw; const bool has1 = m1 < M;
        const int mm[2] = {m0, has1 ? m1 : m0};
        vf4 v[2][8]; float ss[2] = {0.f, 0.f};
#pragma unroll
        for (int k = 0; k < 2; ++k) {
            const int m = mm[k];
            const float* x = from_in ? (m < MC ? p.in[I_XP] + (size_t)m * DM : p.in[I_XS] + (size_t)(m - MC) * DM) : X + (size_t)m * DM;
#pragma unroll
            for (int i = 0; i < 8; ++i) v[k][i] = *(const vf4*)(x + (i * 64 + lane) * 4);
        }
#pragma unroll
        for (int k = 0; k < 2; ++k) {
#pragma unroll
            for (int i = 0; i < 8; ++i) ss[k] += v[k][i].x * v[k][i].x + v[k][i].y * v[k][i].y + v[k][i].z * v[k][i].z + v[k][i].w * v[k][i].w;
            ss[k] = wave_sum(ss[k]);
        }
#pragma unroll
        for (int k = 0; k < 2; ++k) {
            if (k == 1 && !has1) break;
            const int m = mm[k];
            const float* mv = WSP(float, WS_MODV) + ((size_t)l * NCOND + cond_of_row(m)) * NMOD + (size_t)which * 3 * DM;
            const float r = 1.0f / sqrtf(ss[k] * (1.0f / DM) + EPS);
#pragma unroll
            for (int i = 0; i < 8; ++i) {
                const int c = (i * 64 + lane) * 4;
                const float4 gg = *(const float4*)(g + c), sh = *(const float4*)(mv + c), sc = *(const float4*)(mv + DM + c);
                const float o0 = v[k][i].x * r * gg.x * (1.f + sc.x) + sh.x, o1 = v[k][i].y * r * gg.y * (1.f + sc.y) + sh.y;
                const float o2 = v[k][i].z * r * gg.z * (1.f + sc.z) + sh.z, o3 = v[k][i].w * r * gg.w * (1.f + sc.w) + sh.w;
                uint2 w; w.x = pack2(o0, o1); w.y = pack2(o2, o3);
                *(uint2*)(H + (size_t)m * DM + c) = w;
            }
        }
    }
}

__device__ __forceinline__ float red16(float v);
__device__ __forceinline__ float ssq8(vf4 a, vf4 b) { const vf4 s = a * a + b * b; return (s.x + s.y) + (s.z + s.w); }
__device__ __forceinline__ uint4 pack8(vf4 a, vf4 b) { uint4 w; w.x = pack2(a.x, a.y); w.y = pack2(a.z, a.w); w.z = pack2(b.x, b.y); w.w = pack2(b.z, b.w); return w; }
__device__ __forceinline__ void phase_prep(const Params& p, int l) {
    const int tid = opaque_tid(), lane = tid & 63, wv = tid >> 6, rg = lane >> 4, sub = lane & 15, c8 = sub * 8;
    const bf16_t* Z = WSP(bf16_t, WS_Z);
    const float* ropec = WSP(float, WS_ROPE); const float* ropes = ropec + 64 * 32;
    const float* wnq = p.in[I_NAQKN] + ((size_t)l * 2 + 0) * 128 + c8; const float* wnk = wnq + 128;
    const float* wgq = p.in[I_GQAQKN] + ((size_t)l * 2 + 0) * 128 + c8; const float* wgk = wgq + 128;
    const float* cw = p.in[I_CONV] + (size_t)l * 5 * 1536 + rg * 128 + c8;
    const int rpw = (M + (int)gridDim.x * 8 - 1) / ((int)gridDim.x * 8);
    for (int m = ((int)blockIdx.x * 8 + wv) * rpw, mend = (m + rpw < M ? m + rpw : M); m < mend; ++m) {
        const bf16_t* z = Z + (size_t)m * NINP;
        const bool ctx = m < MC;
        const int b = ctx ? m / CT : (m - MC) / LT, t = ctx ? m % CT : (m - MC) % LT, T = ctx ? CT : LT;
        {
            const int ho = rg * 128 + c8;
            const bf16_t* zkv = z + (rg < 2 ? Z_GQK + rg * 128 : Z_GQV + (rg - 2) * 128) + c8;
            vf4 q0, q1, k0, k1, v0, v1, g0, g1, x0, x1;
            ld8bf(z + Z_NAQ + ho, q0, q1); ld8bf(z + Z_NAK + ho, k0, k1); ld8bf(z + Z_NAV + ho, v0, v1); ld8bf(z + Z_GQQ + ho, g0, g1); ld8bf(zkv, x0, x1);
            float r = 1.0f / sqrtf(red16(ssq8(q0, q1)) * (1.0f / 128) + EPS);
            q0 = q0 * r * *(const vf4*)wnq; q1 = q1 * r * *(const vf4*)(wnq + 4);
            *(uint4*)(WSP(bf16_t, WS_NAQ) + (size_t)m * 512 + ho) = pack8(q0, q1);
            r = 1.0f / sqrtf(red16(ssq8(k0, k1)) * (1.0f / 128) + EPS);
            k0 = k0 * r * *(const vf4*)wnk; k1 = k1 * r * *(const vf4*)(wnk + 4);
            *(uint4*)(WSP(bf16_t, WS_NAK) + (size_t)m * 512 + ho) = pack8(k0, k1);
            *(uint4*)(WSP(bf16_t, WS_NAV) + (size_t)m * 512 + ho) = pack8(v0, v1);
            if (ctx) {
                const size_t o = ((((size_t)b * DEPTH + l) * 4 + rg) * CT + t) * 128 + c8;
                *(vf4*)(p.out + O_NAK + o) = k0; *(vf4*)(p.out + O_NAK + o + 4) = k1; *(vf4*)(p.out + O_NAV + o) = v0; *(vf4*)(p.out + O_NAV + o + 4) = v1;
            }
            r = 1.0f / sqrtf(red16(ssq8(g0, g1)) * (1.0f / 128) + EPS);
            g0 = g0 * r * *(const vf4*)wgq; g1 = g1 * r * *(const vf4*)(wgq + 4);
            const float rk = 1.0f / sqrtf(red16(ssq8(x0, x1)) * (1.0f / 128) + EPS);
            if (rg < 2) { x0 = x0 * rk * *(const vf4*)wgk; x1 = x1 * rk * *(const vf4*)(wgk + 4); }
            if (!ctx) {
                const int pos = sub < 8 ? (t >> 6) : (t & 63), ai = pos * 32 + (c8 & 31);
                const vf4 c0 = *(const vf4*)(ropec + ai), c1 = *(const vf4*)(ropec + ai + 4), s0 = *(const vf4*)(ropes + ai), s1 = *(const vf4*)(ropes + ai + 4);
                const bool hi = (sub & 4) != 0;
                vf4 pg0, pg1, px0, px1;
#pragma unroll
                for (int j = 0; j < 4; ++j) { pg0[j] = __shfl_xor(g0[j], 4); pg1[j] = __shfl_xor(g1[j], 4); px0[j] = __shfl_xor(x0[j], 4); px1[j] = __shfl_xor(x1[j], 4); }
                g0 = hi ? pg0 * s0 + g0 * c0 : g0 * c0 - pg0 * s0; g1 = hi ? pg1 * s1 + g1 * c1 : g1 * c1 - pg1 * s1;
                if (rg < 2) { x0 = hi ? px0 * s0 + x0 * c0 : x0 * c0 - px0 * s0; x1 = hi ? px1 * s1 + x1 * c1 : x1 * c1 - px1 * s1; }
            }
            *(uint4*)(WSP(bf16_t, WS_GQ) + (size_t)m * 512 + ho) = pack8(g0, g1);
            *(uint4*)(WSP(bf16_t, rg < 2 ? WS_GK : WS_GV) + (size_t)m * 256 + (rg & 1) * 128 + c8) = pack8(x0, x1);
            if (ctx) {
                const size_t o = ((((size_t)b * DEPTH + l) * 2 + (rg & 1)) * CT + t) * 128 + c8;
                float* dst = p.out + (rg < 2 ? O_GK : O_GV) + o;
                *(vf4*)dst = x0; *(vf4*)(dst + 4) = x1;
            }
        }
        {
#pragma unroll
            for (int dir = 0; dir < 2; ++dir) {
                const float* up = p.in[I_GUP] + ((size_t)l * 2 + dir) * 16 * 256 + 4 * lane;
                vf4 acc = *(const vf4*)(p.in[I_GBIAS] + ((size_t)l * 2 + dir) * 256 + 4 * lane);
                const bf16_t* gz = z + (dir ? Z_GB : Z_GF);
#pragma unroll
                for (int r4 = 0; r4 < 4; ++r4) {
                    const vf4 gv = ld4bf(gz + 4 * r4);
                    acc += gv.x * *(const vf4*)(up + (4 * r4 + 0) * 256) + gv.y * *(const vf4*)(up + (4 * r4 + 1) * 256) + gv.z * *(const vf4*)(up + (4 * r4 + 2) * 256) + gv.w * *(const vf4*)(up + (4 * r4 + 3) * 256);
                }
                vf4 o;
#pragma unroll
                for (int j = 0; j < 4; ++j) o[j] = logsigmoid_f(acc[j]) * (1.0f / 16.0f);
                *(vf4*)(WSP(float, dir ? WS_AB : WS_AF) + (size_t)m * 256 + 4 * lane) = o;
            }
        }
        {
#pragma unroll
            for (int part = 0; part < 3; ++part) {
                vf4 a0 = (vf4){0.f, 0.f, 0.f, 0.f}, a1 = a0;
#pragma unroll
                for (int j = 0; j < 5; ++j) {
                    const int tt = t + j - 2;
                    if (tt >= 0 && tt < T) {
                        const bf16_t* zz = Z + (size_t)(m + j - 2) * NINP + Z_DQKV + part * 512 + rg * 128 + c8;
                        const float* cj = cw + j * 1536 + part * 512;
                        vf4 z0, z1; ld8bf(zz, z0, z1);
                        a0 += *(const vf4*)cj * z0; a1 += *(const vf4*)(cj + 4) * z1;
                    }
                }
#pragma unroll
                for (int j = 0; j < 4; ++j) { a0[j] = silu_f(a0[j]); a1[j] = silu_f(a1[j]); }
                if (part < 2) { const float r = 1.0f / sqrtf(red16(ssq8(a0, a1)) + EPS) * (part == 0 ? 0.08838834764831845f : 1.0f); a0 *= r; a1 *= r; }
                *(uint4*)(WSP(bf16_t, part == 0 ? WS_DQ : part == 1 ? WS_DK : WS_DV) + (size_t)m * 512 + rg * 128 + c8) = pack8(a0, a1);
            }
            if (lane < 8) {
                const float beta = 1.0f / (1.0f + expf(-bf2f(z[Z_DB + lane])));
                const float g = -expf(p.in[I_ALOG][(size_t)l * 8 + lane]) * softplus_f(bf2f(z[Z_DA + lane]) + p.in[I_DTB][(size_t)l * 8 + lane]);
                float* ba = WSP(float, WS_DBA) + (size_t)m * 16;
                ba[lane] = beta; ba[8 + lane] = g;
            }
        }
    }
}

typedef float vf2 __attribute__((ext_vector_type(2)));
__device__ __forceinline__ float dpp_f(float v, const int ctrl) { return v; }
#define DPPF(v, ctrl) __int_as_float(__builtin_amdgcn_mov_dpp(__float_as_int(v), (ctrl), 0xF, 0xF, true))
__device__ __forceinline__ float red8(float v) { v += DPPF(v, 0xB1); v += DPPF(v, 0x4E); v += DPPF(v, 0x141); return v; }
__device__ __forceinline__ float red16(float v) { v = red8(v); v += DPPF(v, 0x140); return v; }

__device__ __forceinline__ void phase_post(const Params& p, int l) {
    const int tid = opaque_tid(), lane = tid & 63, wv = tid >> 6, rg = lane >> 4, c8 = (lane & 15) * 8;
    const bf16_t* Z = WSP(bf16_t, WS_Z); bf16_t* MRG = WSP(bf16_t, WS_MRG);
    const float* wg = p.in[I_GLAON] + (size_t)l * 128 + c8; const float* wd = p.in[I_GDNON] + (size_t)l * 128 + c8;
    for (int m = blockIdx.x * 8 + wv; m < M; m += gridDim.x * 8) {
        const bf16_t* z = Z + (size_t)m * NINP;
        const int ho = rg * 128 + c8;
#pragma unroll
        for (int g = 0; g < 2; ++g) {
            const float* of = WSP(float, g ? WS_DOF : WS_GOF) + (size_t)m * 512 + ho; const float* ob = WSP(float, g ? WS_DOB : WS_GOB) + (size_t)m * 512 + ho;
            const float* w = g ? wd : wg; const bf16_t* zg = z + (g ? Z_DZ : Z_GLR) + ho;
            vf4 a0 = *(const vf4*)of + *(const vf4*)ob, a1 = *(const vf4*)(of + 4) + *(const vf4*)(ob + 4);
            vf4 g0, g1; ld8bf(zg, g0, g1);
            const float r = 1.0f / sqrtf(red16(ssq8(a0, a1)) * (1.0f / 128) + EPS);
            a0 = a0 * r * *(const vf4*)w; a1 = a1 * r * *(const vf4*)(w + 4);
#pragma unroll
            for (int j = 0; j < 4; ++j) { a0[j] *= silu_f(g0[j]); a1[j] *= silu_f(g1[j]); }
            *(uint4*)(MRG + (size_t)m * DM + (g ? 1536 : 512) + ho) = pack8(a0, a1);
        }
    }
}
#define XB_TMO      128
#define XB_XCNT(j)  (256  + 64 * (j))
#define XB_XSUB(j)  (1280 + 64 * (j))
#define XB_XGEN(j)  (2304 + 64 * (j))
#define XB_TOP      3328
#define XB_TOPGEN   3392
#define XCD_BAR_WORDS 3456
#define XB_SPIN_CAP (1u << 22)
#define LAS __attribute__((address_space(3)))

__device__ __forceinline__ unsigned xb_ld(unsigned* p)              { return __hip_atomic_load(p, __ATOMIC_RELAXED, __HIP_MEMORY_SCOPE_AGENT); }
__device__ __forceinline__ unsigned xb_add(unsigned* p, unsigned v) { return __hip_atomic_fetch_add(p, v, __ATOMIC_RELAXED, __HIP_MEMORY_SCOPE_AGENT); }
__device__ __forceinline__ unsigned xb_xcc_id() { return (unsigned)__builtin_amdgcn_s_getreg((3 << 11) | 20) & 0xFu; }
#define XB_SPIN(cond, bar) do { unsigned _sp = 0; while (cond) { __builtin_amdgcn_s_sleep(1); \
    if ((++_sp & 255u) == 0u) { if (xb_ld(&(bar)[XB_TMO])) break; if (_sp > XB_SPIN_CAP) { atomicAdd(&(bar)[XB_TMO], 1u); break; } } } } while (0)

struct XcdBarrier {
    unsigned* bar; unsigned x;
    volatile LAS unsigned* st;
};

__device__ __forceinline__ XcdBarrier xcd_barrier_post(unsigned* bar, volatile LAS unsigned* st) {
    XcdBarrier b; b.bar = bar; b.x = xb_xcc_id(); b.st = st;
    if (threadIdx.x == 0) (void)xb_add(&bar[XB_XCNT(b.x)], 1u);
    return b;
}
__device__ __forceinline__ void xcd_barrier_complete(unsigned* bar, unsigned x, unsigned& nloc, unsigned& nx) {
    const unsigned G = gridDim.x * gridDim.y * gridDim.z;
    unsigned sum, cnt, mine, sp = 0u;
    for (;;) {
        sum = 0u; cnt = 0u; mine = 0u;
#pragma unroll
        for (unsigned j = 0; j < 16; ++j) { const unsigned c = xb_ld(&bar[XB_XCNT(j)]); sum += c; cnt += (c > 0u) ? 1u : 0u; mine = (j == x) ? c : mine; }
        if (sum == G) break;
        __builtin_amdgcn_s_sleep(1);
        if ((++sp & 255u) == 0u) { if (xb_ld(&bar[XB_TMO])) break; if (sp > XB_SPIN_CAP) { atomicAdd(&bar[XB_TMO], 1u); break; } }
    }
    nloc = mine > 0u ? mine : 1u; nx = cnt > 0u ? cnt : 1u;
}

__device__ __forceinline__ void xcd_barrier(const XcdBarrier& b) {
    asm volatile("s_waitcnt vmcnt(0)" ::: "memory");
    __syncthreads();
    if (threadIdx.x == 0) {
        unsigned* bar = b.bar;
        __builtin_amdgcn_s_waitcnt(0);
        unsigned nloc = b.st[0], nx = b.st[1];
        if (nloc == 0u) { xcd_barrier_complete(bar, b.x, nloc, nx); b.st[0] = nloc; b.st[1] = nx; }
        const unsigned old = xb_add(&bar[XB_XSUB(b.x)], 1u);
        const unsigned gen = old / nloc;
        if (old + 1u == (gen + 1u) * nloc) {
            __builtin_amdgcn_fence(__ATOMIC_RELEASE, "agent");
            asm volatile("s_waitcnt vmcnt(0)" ::: "memory");
            const unsigned og = xb_add(&bar[XB_TOP], 1u);
            const unsigned tg = og / nx;
            if (og + 1u == (tg + 1u) * nx) xb_add(&bar[XB_TOPGEN], 1u);
            else XB_SPIN(xb_ld(&bar[XB_TOPGEN]) == tg, bar);
            __builtin_amdgcn_fence(__ATOMIC_ACQUIRE, "agent");
            xb_add(&bar[XB_XGEN(b.x)], 1u);
            asm volatile("s_waitcnt vmcnt(0)" ::: "memory");
        } else {
            XB_SPIN(xb_ld(&bar[XB_XGEN(b.x)]) == gen, bar);
            __builtin_amdgcn_fence(__ATOMIC_ACQUIRE, "agent");
            asm volatile("s_waitcnt vmcnt(0)" ::: "memory");
        }
    }
    __syncthreads();
}

namespace pg8 {
#define PG8_LAS __attribute__((address_space(3)))
typedef unsigned short bf16_t;
typedef short bf16x8 __attribute__((ext_vector_type(8)));
typedef float f32x4 __attribute__((ext_vector_type(4)));
typedef unsigned u32x4 __attribute__((ext_vector_type(4)));
constexpr int BM = 256, BK = 64, HALF = 128, HTB = HALF * BK * 2  , STAGE_BYTES = 8 * HTB, NXCD = 8, WGM = 8;

__host__ __device__ __forceinline__ int lds_byte(int r, int c) { const int st = (r >> 4) * 2 + (c >> 5), rr = r & 15, cc = c & 31, ob = rr * 64 + cc * 2; return st * 1024 + (ob ^ (((ob >> 9) & 1) << 5)); }
__host__ __device__ __forceinline__ void stage_rc(int b, int& R, int& C) { const int st = b / 1024, sb = b % 1024, swz = sb ^ (((sb >> 9) & 1) << 5); R = (st >> 1) * 16 + swz / 64; C = (st & 1) * 32 + (swz % 64) / 2; }
__host__ __device__ __forceinline__ int perm32(int rho) { const int n = rho >> 4, i = rho & 15; return 8 * (i >> 2) + 4 * n + (i & 3); }

struct Unit { int pm, pn, k0, nt, at, slot; };
struct Gemm { const bf16_t* A; const bf16_t* Bt; int M, N, K; };

struct StaticOrder {
    int nM, nN, nwg, G, c, ntk, split;
    __host__ __device__ void init(int M, int N, int K, int G_, int c_, int split_ = 0) { nM = M / BM; nN = N / BM; nwg = nM * nN; G = G_; c = c_; ntk = K / BK; const int rem = nwg % G_; split = (split_ && rem > 0 && 2 * rem == G_ && (ntk % 4) != 1 && ntk >= 8) ? 1 : 0; }
    __host__ __device__ bool next(int i, Unit& u) const {
        long L = (long)i * G + c; u.k0 = 0; u.nt = ntk; u.at = 0; u.slot = 0;
        if (split && i == nwg / G) { const int rem = nwg % G, sl = c / rem, h0 = ((ntk / 2) + 1) & ~1; L = (long)i * G + (c % rem); u.k0 = sl ? h0 * BK : 0; u.nt = sl ? ntk - h0 : h0; u.at = sl ? 1 : 2; u.slot = c % rem; }
        if (L >= nwg) return false;
        int wgid = (int)L; { const int q = nwg / NXCD, r = nwg % NXCD, xcd = wgid % NXCD, off = wgid / NXCD; wgid = (xcd < r ? xcd * (q + 1) : r * (q + 1) + (xcd - r) * q) + off; }
        const int nig = WGM * nN, gid = wgid / nig, fm = gid * WGM, gsz = (nM - fm) < WGM ? (nM - fm) : WGM;
        u.pm = fm + ((wgid % nig) % gsz); u.pn = (wgid % nig) / gsz; return true;
    }
    __device__ __forceinline__ void a_ready(const Unit&) const {}
    __device__ __forceinline__ void done(const Unit&) const {}
};
__device__ __forceinline__ unsigned cvt_pk_bf16(float lo, float hi) { unsigned r; asm volatile("v_cvt_pk_bf16_f32 %0, %1, %2" : "=v"(r) : "v"(lo), "v"(hi)); return r; }
struct EpiF32 {
    static constexpr bool PERM = false, AFTER_DRAIN = false;
    float* C; int ldc; const float* bias;
    __device__ __forceinline__ void operator()(const f32x4 (&acc)[2][2][4][2], const Unit& u, int wr, int wc, int fr, int fq) const {
        const int row0 = u.pm * BM + wr * 64 + fr, col0 = u.pn * BM + wc * 32 + 4 * fq;
        f32x4 bv[2][2];
#pragma unroll
        for (int bj = 0; bj < 2; ++bj)
#pragma unroll
            for (int n = 0; n < 2; ++n) bv[bj][n] = bias ? *(const f32x4*)(bias + col0 + bj * HALF + n * 16) : (f32x4){0.f, 0.f, 0.f, 0.f};
#pragma unroll
        for (int ai = 0; ai < 2; ++ai)
#pragma unroll
            for (int m = 0; m < 4; ++m) { float* rowp = C + (size_t)(row0 + ai * HALF + m * 16) * ldc + col0;
#pragma unroll
                for (int bj = 0; bj < 2; ++bj)
#pragma unroll
                    for (int n = 0; n < 2; ++n) *(f32x4*)(rowp + bj * HALF + n * 16) = acc[ai][bj][m][n] + bv[bj][n]; }
    }
};

struct EpiSwiGLU {
    static constexpr bool PERM = true, AFTER_DRAIN = false;
    bf16_t* O; int ldc;
    __device__ __forceinline__ void operator()(const f32x4 (&acc)[2][2][4][2], const Unit& u, int wr, int wc, int fr, int fq) const {
        const int row0 = u.pm * BM + wr * 64 + fr, col0 = u.pn * 128 + wc * 32 + 8 * fq;
#pragma unroll
        for (int ai = 0; ai < 2; ++ai)
#pragma unroll
            for (int m = 0; m < 4; ++m) { bf16_t* rowp = O + (size_t)(row0 + ai * HALF + m * 16) * ldc + col0;
                const f32x4 g0 = acc[ai][0][m][0], g1 = acc[ai][0][m][1], u0 = acc[ai][1][m][0], u1 = acc[ai][1][m][1];
                float r[8];
#pragma unroll
                for (int j = 0; j < 4; ++j) {
                    r[j]     = g0[j] * __builtin_amdgcn_rcpf(1.0f + __builtin_amdgcn_exp2f(-1.4426950408889634f * g0[j])) * u0[j];
                    r[4 + j] = g1[j] * __builtin_amdgcn_rcpf(1.0f + __builtin_amdgcn_exp2f(-1.4426950408889634f * g1[j])) * u1[j]; }
                u32x4 w; w.x = cvt_pk_bf16(r[0], r[1]); w.y = cvt_pk_bf16(r[2], r[3]); w.z = cvt_pk_bf16(r[4], r[5]); w.w = cvt_pk_bf16(r[6], r[7]);
                *(u32x4*)rowp = w; }
    }
};
struct EpiBf16Plain {
    static constexpr bool PERM = true, AFTER_DRAIN = false;
    bf16_t* O; int ldc;
    __device__ __forceinline__ void operator()(const f32x4 (&acc)[2][2][4][2], const Unit& u, int wr, int wc, int fr, int fq) const {
        const int row0 = u.pm * BM + wr * 64 + fr, col0 = u.pn * BM + wc * 32 + 8 * fq;
#pragma unroll
        for (int ai = 0; ai < 2; ++ai)
#pragma unroll
            for (int m = 0; m < 4; ++m) { bf16_t* rowp = O + (size_t)(row0 + ai * HALF + m * 16) * ldc + col0;
#pragma unroll
                for (int bj = 0; bj < 2; ++bj) { const f32x4 v0 = acc[ai][bj][m][0], v1 = acc[ai][bj][m][1];
                    u32x4 w; w.x = cvt_pk_bf16(v0[0], v0[1]); w.y = cvt_pk_bf16(v0[2], v0[3]); w.z = cvt_pk_bf16(v1[0], v1[1]); w.w = cvt_pk_bf16(v1[2], v1[3]);
                    *(u32x4*)(rowp + bj * HALF) = w; } }
    }
};
struct EpiResid {
    static constexpr bool PERM = false, AFTER_DRAIN = false;
    const float* res; float* out; int ldc; const float* gate0; float coef;
    float* slab; unsigned* flags; unsigned target;
    const float* res_hi; int row_hi;
    __device__ __forceinline__ void operator()(const f32x4 (&acc)[2][2][4][2], const Unit& u, int wr, int wc, int fr, int fq) const {
        const int tidx = ((wr * 4 + wc) * 4 + fq) * 16 + fr;
        if (u.at == 1) {
            const __amdgpu_buffer_rsrc_t rs = __builtin_amdgcn_make_buffer_rsrc((void*)slab, 0, 0x7FFFFFF0, 0x00020000);
            const unsigned base = ((unsigned)u.slot * 32u * 512u + (unsigned)tidx) * 16u;
#pragma unroll
            for (int ai = 0; ai < 2; ++ai)
#pragma unroll
                for (int bj = 0; bj < 2; ++bj)
#pragma unroll
                    for (int m = 0; m < 4; ++m)
#pragma unroll
                        for (int n = 0; n < 2; ++n) { const f32x4 v = acc[ai][bj][m][n]; u32x4 w; w.x = __float_as_uint(v[0]); w.y = __float_as_uint(v[1]); w.z = __float_as_uint(v[2]); w.w = __float_as_uint(v[3]);
                            __builtin_amdgcn_raw_buffer_store_b128(w, rs, base + (unsigned)((((ai * 2 + bj) * 4 + m) * 2 + n) * 512 * 16), 0, 16); }
            asm volatile("s_waitcnt vmcnt(0)" ::: "memory");
            if ((tidx & 63) == 0) __hip_atomic_fetch_add(flags + 64 * u.slot, 1u, __ATOMIC_RELAXED, __HIP_MEMORY_SCOPE_AGENT);
            return;
        }
        const float* part = nullptr;
        if (u.at == 2) {
            unsigned spins = 0;
            while (__hip_atomic_load(flags + 64 * u.slot, __ATOMIC_RELAXED, __HIP_MEMORY_SCOPE_AGENT) < target) { __builtin_amdgcn_s_sleep(2); if (++spins > (1u << 22)) break; }
            __builtin_amdgcn_fence(__ATOMIC_ACQUIRE, "agent");
            asm volatile("s_waitcnt vmcnt(0)" ::: "memory");
            part = slab + ((size_t)u.slot * 32 * 512 + tidx) * 4;
        }
        const int row0 = u.pm * BM + wr * 64 + fr, col0 = u.pn * BM + wc * 32 + 4 * fq;
        const float* gate = gate0 + (size_t)cond_of_row(u.pm * BM) * NMOD;
        const float* rbase = (u.pm * BM >= row_hi) ? res_hi - (size_t)row_hi * ldc : res;
        f32x4 gv[2][2];
#pragma unroll
        for (int bj = 0; bj < 2; ++bj)
#pragma unroll
            for (int n = 0; n < 2; ++n) gv[bj][n] = *(const f32x4*)(gate + col0 + bj * HALF + n * 16) * coef;
#pragma unroll
        for (int ai = 0; ai < 2; ++ai)
#pragma unroll
            for (int m = 0; m < 4; ++m) { const size_t off = (size_t)(row0 + ai * HALF + m * 16) * ldc + col0;
#pragma unroll
                for (int bj = 0; bj < 2; ++bj)
#pragma unroll
                    for (int n = 0; n < 2; ++n) {
                        f32x4 a = acc[ai][bj][m][n];
                        if (part) a += *(const f32x4*)(part + (size_t)((((ai * 2 + bj) * 4 + m) * 2 + n) * 512 * 4));
                        const f32x4 bs = *(const f32x4*)(rbase + off + bj * HALF + n * 16); *(f32x4*)(out + off + bj * HALF + n * 16) = bs + gv[bj][n] * a; }
                asm volatile("" ::: "memory"); }
    }
};
template <class Epi, class Sched, bool STAMP = false>
__device__ __forceinline__ void gemm_phase(PG8_LAS unsigned char* lds, const Gemm g, const Sched& S, const Epi& E, unsigned long long* stamps) {
    const int tid = opaque_tid(), wid = __builtin_amdgcn_readfirstlane(tid >> 6), lane = tid & 63, wr = wid >> 2, wc = wid & 3, fr = lane & 15, fq = lane >> 4;
    const int K = g.K;
    int ts_lo = 0, ts_hi = 0, nts = 0; const unsigned long long rt_entry = STAMP ? (unsigned long long)wall_clock64() : 0ull;
#define PG8_STAMP() do { if (STAMP && wid == 0 && nts < 64) { const unsigned long long _c = (unsigned long long)clock64(); \
        ts_lo = (lane == nts) ? (int)(unsigned)_c : ts_lo; ts_hi = (lane == nts) ? (int)(unsigned)(_c >> 32) : ts_hi; ++nts; } } while (0)
    PG8_STAMP();
    unsigned voffA[2], voffB[2];
#pragma unroll
    for (int i = 0; i < 2; ++i) { int R, C; stage_rc(tid * 16 + i * 8192, R, C); const int Rb = Epi::PERM ? ((R & ~31) + perm32(R & 31)) : R;
        voffA[i] = (unsigned)(R * K + C) * 2u; voffB[i] = (unsigned)(Rb * K + C) * 2u; }
    const size_t kstep = (size_t)(BK * 2);
    const size_t hstep = (size_t)HALF * K * 2;
    const size_t tstep = 2 * hstep;
    const unsigned ldsw = (unsigned)wid * 1024u;
    const int aoff = lds_byte(wr * 64 + fr, fq * 8), boff = lds_byte(wc * 32 + fr, fq * 8);
#define PG8_SA(b, h) (((b) * 2 + (h)) * HTB)
#define PG8_SB(b, h) ((4 + (b) * 2 + (h)) * HTB)
#define PG8_STAGE(bufoff, gbase, voff) do { _Pragma("unroll") for (int _i = 0; _i < 2; ++_i) \
        __builtin_amdgcn_global_load_lds((const unsigned*)((const char*)(gbase) + (voff)[_i]), (PG8_LAS unsigned*)(lds + (bufoff) + ldsw + _i * 8192), 16, 0, 0); } while (0)
#define PG8_LDA(dst, b, h) do { _Pragma("unroll") for (int m = 0; m < 4; ++m) _Pragma("unroll") for (int k = 0; k < 2; ++k) dst[m][k] = *(const PG8_LAS bf16x8*)(lds + PG8_SA(b, h) + aoff + m * 2048 + k * 1024); } while (0)
#define PG8_LDB(dst, b, h) do { _Pragma("unroll") for (int n = 0; n < 2; ++n) _Pragma("unroll") for (int k = 0; k < 2; ++k) dst[n][k] = *(const PG8_LAS bf16x8*)(lds + PG8_SB(b, h) + boff + n * 2048 + k * 1024); } while (0)
#define PG8_MMA(ai, bj, At, Bt) do { __builtin_amdgcn_s_setprio(1); _Pragma("unroll") for (int m = 0; m < 4; ++m) _Pragma("unroll") for (int n = 0; n < 2; ++n) _Pragma("unroll") for (int k = 0; k < 2; ++k) \
        acc[ai][bj][m][n] = __builtin_amdgcn_mfma_f32_16x16x32_bf16(Bt[n][k], At[m][k], acc[ai][bj][m][n], 0, 0, 0); __builtin_amdgcn_s_setprio(0); } while (0)
#define PG8_WAIT_V(n) asm volatile("s_waitcnt vmcnt(" #n ")" ::: "memory")
#define PG8_WAIT_L(n) asm volatile("s_waitcnt lgkmcnt(" #n ")" ::: "memory")
#define PG8_BAR __builtin_amdgcn_s_barrier()
#define PG8_SCHED __builtin_amdgcn_sched_barrier(0)
    Unit cur, nxt; int ui = 0;
    if (!S.next(0, cur)) return;
    f32x4 acc[2][2][4][2];
#pragma unroll
    for (int a = 0; a < 2; ++a)
#pragma unroll
        for (int b = 0; b < 2; ++b)
#pragma unroll
            for (int m = 0; m < 4; ++m)
#pragma unroll
                for (int n = 0; n < 2; ++n) acc[a][b][m][n] = (f32x4){0.f, 0.f, 0.f, 0.f};
    bf16x8 At[4][2], B0[2][2], B1[2][2];
    const char* cA = (const char*)g.A + (size_t)cur.pm * tstep + (size_t)cur.k0 * 2; const char* cB = (const char*)g.Bt + (size_t)cur.pn * tstep + (size_t)cur.k0 * 2;
    S.a_ready(cur);
    PG8_STAGE(PG8_SB(0, 0), cB, voffB); PG8_STAGE(PG8_SA(0, 0), cA, voffA); PG8_STAGE(PG8_SB(0, 1), cB + hstep, voffB); PG8_STAGE(PG8_SA(0, 1), cA + hstep, voffA);
    if (wr == 1) PG8_BAR;
    PG8_WAIT_V(4); PG8_BAR;
    PG8_STAGE(PG8_SB(1, 0), cB + kstep, voffB); PG8_STAGE(PG8_SA(1, 0), cA + kstep, voffA); PG8_STAGE(PG8_SB(1, 1), cB + hstep + kstep, voffB);
    PG8_WAIT_V(6); PG8_BAR;
    PG8_STAMP();
    for (;;) {
        const bool has_next = S.next(ui + 1, nxt);
        const char* nA = has_next ? (const char*)g.A + (size_t)nxt.pm * tstep + (size_t)nxt.k0 * 2 : cA; const char* nB = has_next ? (const char*)g.Bt + (size_t)nxt.pn * tstep + (size_t)nxt.k0 * 2 : cB;
        const int nt = cur.nt;
        for (int t = 0; t < nt; t += 2) {
            const bool last = (t == nt - 2);
            const char* a1 = cA + (size_t)(t + 1) * kstep;
            const char* a2 = last ? nA : cA + (size_t)(t + 2) * kstep; const char* b2 = last ? nB : cB + (size_t)(t + 2) * kstep;
            const char* a3 = a2 + kstep; const char* b3 = b2 + kstep;
            if (last && has_next) S.a_ready(nxt);
            PG8_LDB(B0, 0, 0); PG8_SCHED; PG8_LDA(At, 0, 0); PG8_STAGE(PG8_SA(1, 1), a1 + hstep, voffA);
            PG8_WAIT_L(8); PG8_BAR; PG8_WAIT_L(0); PG8_MMA(0, 0, At, B0); PG8_BAR; PG8_SCHED;
            PG8_LDB(B1, 0, 1); PG8_STAGE(PG8_SB(0, 0), b2, voffB);
            PG8_BAR; PG8_WAIT_L(0); PG8_MMA(0, 1, At, B1); PG8_BAR;
            PG8_LDA(At, 0, 1); PG8_STAGE(PG8_SA(0, 0), a2, voffA);
            PG8_BAR; PG8_WAIT_L(0); PG8_MMA(1, 0, At, B0); PG8_BAR; PG8_SCHED;
            PG8_STAGE(PG8_SB(0, 1), b2 + hstep, voffB);
            PG8_WAIT_V(6); PG8_BAR; PG8_MMA(1, 1, At, B1); PG8_BAR;
            PG8_LDB(B0, 1, 0); PG8_SCHED; PG8_LDA(At, 1, 0); PG8_STAGE(PG8_SA(0, 1), a2 + hstep, voffA);
            PG8_WAIT_L(8); PG8_BAR; PG8_WAIT_L(0); PG8_MMA(0, 0, At, B0); PG8_BAR; PG8_SCHED;
            PG8_LDB(B1, 1, 1); PG8_STAGE(PG8_SB(1, 0), b3, voffB);
            PG8_BAR; PG8_WAIT_L(0); PG8_MMA(0, 1, At, B1); PG8_BAR;
            PG8_LDA(At, 1, 1); PG8_STAGE(PG8_SA(1, 0), a3, voffA);
            PG8_BAR; PG8_WAIT_L(0); PG8_MMA(1, 0, At, B0); PG8_BAR; PG8_SCHED;
            PG8_STAGE(PG8_SB(1, 1), b3 + hstep, voffB);
            PG8_WAIT_V(6); PG8_BAR; PG8_MMA(1, 1, At, B1); PG8_BAR;
        }
        PG8_STAMP();
        if constexpr (!Epi::AFTER_DRAIN) { E(acc, cur, wr, wc, fr, fq); S.done(cur); }
        PG8_STAMP();
        if (!has_next) break;
#pragma unroll
        for (int a = 0; a < 2; ++a)
#pragma unroll
            for (int b = 0; b < 2; ++b)
#pragma unroll
                for (int m = 0; m < 4; ++m)
#pragma unroll
                    for (int n = 0; n < 2; ++n) acc[a][b][m][n] = (f32x4){0.f, 0.f, 0.f, 0.f};
        cur = nxt; cA = nA; cB = nB; ++ui;
    }
    PG8_WAIT_V(0);
    if (wr == 0) PG8_BAR;
    PG8_BAR;
    if constexpr (Epi::AFTER_DRAIN) { E.fused(acc, cur, wr, wc, fr, fq, lds, wid, lane); S.done(cur); }
    PG8_STAMP();
    if (STAMP && wid == 0) { stamps[lane] = lane < nts ? (((unsigned long long)(unsigned)ts_hi << 32) | (unsigned)ts_lo) : 0ull;
        if (lane == 62) stamps[62] = rt_entry; if (lane == 63) stamps[63] = (unsigned long long)wall_clock64(); }
#undef PG8_STAMP
#undef PG8_SA
#undef PG8_SB
#undef PG8_STAGE
#undef PG8_LDA
#undef PG8_LDB
#undef PG8_MMA
#undef PG8_WAIT_V
#undef PG8_WAIT_L
#undef PG8_BAR
#undef PG8_SCHED
}
}
#ifndef ATT_INLINE
#define ATT_INLINE __forceinline__
#endif
namespace att {
constexpr int D = 128, NW = 8, QBLK = 32, KVBLK = 64, LDQ = 512, LDO = DM;
constexpr float SCALE = 0.088388347648318440f;
constexpr float THR = 8.f;
constexpr size_t SHM_V = KVBLK * D * 2, SHM_K = KVBLK * D * 2, SHM_Q = 256 * D * 2, SHM_ATTN = 2 * SHM_V + 2 * SHM_K + NW * 64 * 4 + SHM_Q;
using bf16x8 = __attribute__((ext_vector_type(8))) short;
using s16x4  = __attribute__((ext_vector_type(4))) short;
using f32x16 = __attribute__((ext_vector_type(16))) float;
using u32x4  = __attribute__((ext_vector_type(4))) unsigned;
#define KSWZ(row, colB) ((row) * 256 + ((colB) ^ (((row) & 7) << 4)))
#define SBAR() __builtin_amdgcn_sched_barrier(0)
__device__ __forceinline__ int crow(int r, int hi) { return (r & 3) + 8 * (r >> 2) + 4 * hi; }
__device__ __forceinline__ unsigned cvtpk(float lo, float hi) { unsigned r; asm volatile("v_cvt_pk_bf16_f32 %0, %1, %2" : "=v"(r) : "v"(lo), "v"(hi)); return r; }

__device__ __forceinline__ void partialSM(f32x16& p0, f32x16& p1, float& m_reg, float& mn, float& alpha) {
  constexpr float C = SCALE * 1.4426950408889634f;
  float pmax = p0[0]; for (int r = 1; r < 16; ++r) pmax = fmaxf(pmax, p0[r]); for (int r = 0; r < 16; ++r) pmax = fmaxf(pmax, p1[r]);
  { auto rr = __builtin_amdgcn_permlane32_swap(__float_as_uint(pmax), __float_as_uint(pmax), false, false);
    pmax = fmaxf(__uint_as_float(rr[0]), __uint_as_float(rr[1])); }
  if (__builtin_expect(__all(pmax - m_reg <= THR / SCALE), 1)) { mn = m_reg; alpha = 1.f; }
  else { mn = fmaxf(m_reg, pmax); alpha = __builtin_amdgcn_exp2f((m_reg - mn) * C); m_reg = mn; }
  float mnC = -mn * C;
  for (int r = 0; r < 16; ++r) p0[r] = fmaf(p0[r], C, mnC); for (int r = 0; r < 16; ++r) p1[r] = fmaf(p1[r], C, mnC);
  for (int r = 0; r < 16; ++r) p0[r] = __builtin_amdgcn_exp2f(p0[r]);
}
__device__ __forceinline__ void finishSM(f32x16& p0, f32x16& p1, float alpha, float& l_reg, bf16x8& pa0, bf16x8& pa1, bf16x8& pa2, bf16x8& pa3) {
  for (int r = 0; r < 16; ++r) p1[r] = __builtin_amdgcn_exp2f(p1[r]);
  float ps = 0; for (int r = 0; r < 16; ++r) ps += p0[r]; for (int r = 0; r < 16; ++r) ps += p1[r];
  { auto rr = __builtin_amdgcn_permlane32_swap(__float_as_uint(ps), __float_as_uint(ps), false, false);
    ps = __uint_as_float(rr[0]) + __uint_as_float(rr[1]); }
  l_reg = l_reg * alpha + ps;
#define PK4(P, BASE, OUT) do { unsigned a0 = cvtpk(P[BASE + 0], P[BASE + 1]), a1 = cvtpk(P[BASE + 2], P[BASE + 3]);   \
    unsigned b0 = cvtpk(P[BASE + 4], P[BASE + 5]), b1 = cvtpk(P[BASE + 6], P[BASE + 7]);                              \
    auto r0 = __builtin_amdgcn_permlane32_swap(a0, b0, false, false); auto r1 = __builtin_amdgcn_permlane32_swap(a1, b1, false, false); \
    u32x4 w = {r0[0], r1[0], r0[1], r1[1]}; OUT = *reinterpret_cast<bf16x8*>(&w); } while (0)
  PK4(p0, 0, pa0); PK4(p0, 8, pa1); PK4(p1, 0, pa2); PK4(p1, 8, pa3);
#undef PK4
}
__device__ __forceinline__ void qkt(f32x16& p0, f32x16& p1, const bf16_t* Ks, const bf16_t* Qs, int qrow, int r32, int hi) {
  p0 = f32x16{}; p1 = f32x16{};
#pragma unroll
  for (int d0 = 0; d0 < 8; ++d0) { int cb = (d0 * 16 + hi * 8) * 2;
    bf16x8 q = *reinterpret_cast<const bf16x8*>((const char*)Qs + KSWZ(qrow, cb));
    bf16x8 b0 = *reinterpret_cast<const bf16x8*>((const char*)Ks + KSWZ(r32, cb));
    bf16x8 b1 = *reinterpret_cast<const bf16x8*>((const char*)Ks + KSWZ(32 + r32, cb));
    p0 = __builtin_amdgcn_mfma_f32_32x32x16_bf16(b0, q, p0, 0, 0, 0);
    p1 = __builtin_amdgcn_mfma_f32_32x32x16_bf16(b1, q, p1, 0, 0, 0); }
}
__device__ __forceinline__ int v_st(int k, int c) { const int kk = (k & ~0xC) | ((k & 4) << 1) | ((k & 8) >> 1); return ((kk >> 3) * 4 + (c >> 5)) * 512 + ((kk & 7) * 32 + (c & 31)) * 2; }
__device__ __forceinline__ int v_rd_base(int lane) { return ((lane & 3) << 3) | (((lane >> 2) & 3) << 6) | (((lane >> 4) & 1) << 5) | (((lane >> 5) & 1) << 8); }
constexpr int v_rd_off(int d0, int ks, int half) { return d0 * 512 + ks * 4096 + half * 2048; }
template <int OFF> __device__ __forceinline__ s16x4 tr_read(int vb) {
  s16x4 r; asm volatile("ds_read_b64_tr_b16 %0, %1 offset:%2" : "=&v"(r) : "v"(vb), "i"(OFF) : "memory"); return r;
}
template <int D0> __device__ __forceinline__ void pv_one(f32x16& od, int vb, bf16x8 pa0, bf16x8 pa1, bf16x8 pa2, bf16x8 pa3) {
  const s16x4 l0 = tr_read<v_rd_off(D0, 0, 0)>(vb), h0 = tr_read<v_rd_off(D0, 0, 1)>(vb), l1 = tr_read<v_rd_off(D0, 1, 0)>(vb), h1 = tr_read<v_rd_off(D0, 1, 1)>(vb);
  const s16x4 l2 = tr_read<v_rd_off(D0, 2, 0)>(vb), h2 = tr_read<v_rd_off(D0, 2, 1)>(vb), l3 = tr_read<v_rd_off(D0, 3, 0)>(vb), h3 = tr_read<v_rd_off(D0, 3, 1)>(vb);
  asm volatile("s_waitcnt lgkmcnt(0)" ::: "memory"); SBAR();
#define PK(L, H) (bf16x8){L[0], L[1], L[2], L[3], H[0], H[1], H[2], H[3]}
  od = __builtin_amdgcn_mfma_f32_32x32x16_bf16(pa0, PK(l0, h0), od, 0, 0, 0);
  od = __builtin_amdgcn_mfma_f32_32x32x16_bf16(pa1, PK(l1, h1), od, 0, 0, 0);
  od = __builtin_amdgcn_mfma_f32_32x32x16_bf16(pa2, PK(l2, h2), od, 0, 0, 0);
  od = __builtin_amdgcn_mfma_f32_32x32x16_bf16(pa3, PK(l3, h3), od, 0, 0, 0);
#undef PK
}
__device__ __forceinline__ void pv_d0(f32x16* o, int vb, bf16x8 pa0, bf16x8 pa1, bf16x8 pa2, bf16x8 pa3) {
  pv_one<0>(o[0], vb, pa0, pa1, pa2, pa3); pv_one<1>(o[1], vb, pa0, pa1, pa2, pa3); pv_one<2>(o[2], vb, pa0, pa1, pa2, pa3); pv_one<3>(o[3], vb, pa0, pa1, pa2, pa3);
}

struct SrcOne { const bf16_t* k0; const bf16_t* v0; int ldk;
  __device__ __forceinline__ const bf16_t* k(int j) const { return k0 + (size_t)j * 64 * ldk; }
  __device__ __forceinline__ const bf16_t* v(int j) const { return v0 + (size_t)j * 64 * ldk; } };
struct SrcTwo { const bf16_t* ck; const bf16_t* cv; const bf16_t* k1; const bf16_t* v1; int ldk;
  __device__ __forceinline__ const bf16_t* k(int j) const { return j < 4 ? ck + (size_t)j * 64 * ldk : k1 + (size_t)(j - 4) * 64 * ldk; }
  __device__ __forceinline__ const bf16_t* v(int j) const { return j < 4 ? cv + (size_t)j * 64 * ldk : v1 + (size_t)(j - 4) * 64 * ldk; } };
struct NoBias { __device__ __forceinline__ void operator()(f32x16&, f32x16&, int, int, int, int) const {} };
struct NaBias { const float* tab; int i0, kr0;
  __device__ __forceinline__ void operator()(f32x16& p0, f32x16& p1, int jt, int wid, int r32, int hi) const {
    if (jt < 4) return;
    const int qi = i0 + wid * QBLK + r32, r = qi >> 6, qc = qi & 63, kr = kr0 + jt - 4;
    int lo = r - 4; lo = lo < 0 ? 0 : (lo > 8 ? 8 : lo);
    const bool rowok = (kr >= lo) && (kr < lo + 8);
    if (!rowok) {
#pragma unroll
      for (int rr = 0; rr < 16; ++rr) { p0[rr] = -1e30f; p1[rr] = -1e30f; }
      return;
    }
    int c0 = qc - 8; c0 = c0 < 0 ? 0 : (c0 > 48 ? 48 : c0);
    const int dr = kr - r + 7;
    const float* tb = tab + dr * 31 + (4 * hi - qc + 15);
    const int w0 = 4 * hi - c0;
#pragma unroll
    for (int g = 0; g < 4; ++g) {
#pragma unroll
      for (int q = 0; q < 4; ++q) {
        const int rr = 4 * g + q, kc0 = q + 8 * g;
        const float t0 = tb[kc0], t1 = tb[kc0 + 32];
        p0[rr] = ((unsigned)(kc0 + w0) < 16u) ? p0[rr] + t0 : -1e30f;
        p1[rr] = ((unsigned)(kc0 + 32 + w0) < 16u) ? p1[rr] + t1 : -1e30f;
      }
      SBAR();
    }
  } };

template <int SD, class Src, class Bias>
__device__ ATT_INLINE void attn_body(const bf16_t* __restrict__ Qb, const Src src, bf16_t* __restrict__ Ob, const int NT, char* lds, const Bias bias) {
  const int tid = opaque_tid(), wid = tid >> 6, lane = tid & 63, r32 = lane & 31, hi = lane >> 5;
  const int LDK = src.ldk;
  bf16_t* V_lds = (bf16_t*)lds; bf16_t* K_lds = (bf16_t*)(lds + 2 * SHM_V);
  float* ws = (float*)(lds + 2 * SHM_V + 2 * SHM_K) + wid * 64; float* li_l = ws; float* al_l = ws + 32;
  float m_reg = -1e30f, l_reg = 0; f32x16 o[4] = {};
  bf16_t* Q_lds = (bf16_t*)(lds + 2 * SHM_V + 2 * SHM_K + NW * 64 * 4);
  const int qrow = wid * QBLK + r32;
  {
#pragma unroll
    for (int i = 0; i < 8; ++i) { const int f = tid + 512 * i, row = f >> 4, c8 = (f & 15) * 8;
      *(bf16x8*)((char*)Q_lds + KSWZ(row, c8 * 2)) = *reinterpret_cast<const bf16x8*>(Qb + (long)row * LDQ + c8); }
  }
  const int sr = tid >> 4, sc = (tid & 15) * 8, vst0 = v_st(sr, sc), vst1 = v_st(32 + sr, sc);
  const int vb0 = (int)(uintptr_t)V_lds + v_rd_base(lane);
  struct { bf16x8 vs0, vs1, ks0, ks1; } sr_[SD];
#define SLOAD(i, jt) do { const bf16_t* kt_ = src.k(jt); const bf16_t* vt_ = src.v(jt); \
    sr_[i].vs0 = *reinterpret_cast<const bf16x8*>(&vt_[(long)sr * LDK + sc]); sr_[i].vs1 = *reinterpret_cast<const bf16x8*>(&vt_[(long)(32 + sr) * LDK + sc]); \
    sr_[i].ks0 = *reinterpret_cast<const bf16x8*>(&kt_[(long)sr * LDK + sc]); sr_[i].ks1 = *reinterpret_cast<const bf16x8*>(&kt_[(long)(32 + sr) * LDK + sc]); } while (0)
#define SWRITE(b, i) do { *(bf16x8*)((char*)V_lds + (b) * SHM_V + vst0) = sr_[i].vs0;          \
    *(bf16x8*)((char*)V_lds + (b) * SHM_V + vst1) = sr_[i].vs1; int kc = sc * 2;               \
    *(bf16x8*)((char*)K_lds + (b) * SHM_K + KSWZ(sr, kc)) = sr_[i].ks0;                       \
    *(bf16x8*)((char*)K_lds + (b) * SHM_K + KSWZ(32 + sr, kc)) = sr_[i].ks1; } while (0)
#define SWAIT() do { if constexpr (SD == 2) asm volatile("s_waitcnt vmcnt(4)" ::: "memory"); else asm volatile("s_waitcnt vmcnt(0)" ::: "memory"); } while (0)
#define RESC(a) do { if (__any((a) < 1.f)) { if (hi == 0) al_l[r32] = (a); asm volatile("s_waitcnt lgkmcnt(0)" ::: "memory"); \
    for (int d = 0; d < 4; ++d) for (int r = 0; r < 16; ++r) o[d][r] *= al_l[crow(r, hi)]; } } while (0)
  f32x16 pA0, pA1, pB0, pB1; float mnA, mnB, alA, alB; bf16x8 pa0, pa1, pa2, pa3;
  constexpr int SE = 0, SO = SD - 1;
  SLOAD(SE, 0); asm volatile("s_waitcnt vmcnt(0)" ::: "memory"); SWRITE(0, SE); __syncthreads();
  qkt(pA0, pA1, K_lds, Q_lds, qrow, r32, hi); bias(pA0, pA1, 0, wid, r32, hi); partialSM(pA0, pA1, m_reg, mnA, alA);
  SLOAD(SO, 1); if constexpr (SD == 2) { if (2 < NT) SLOAD(SE, 2); }
  SWAIT(); SWRITE(1, SO); __syncthreads();
  for (int j = 1; j + 1 < NT; j += 2) {
    SBAR(); qkt(pB0, pB1, (bf16_t*)((char*)K_lds + SHM_K), Q_lds, qrow, r32, hi); bias(pB0, pB1, j, wid, r32, hi);
    finishSM(pA0, pA1, alA, l_reg, pa0, pa1, pa2, pa3); SBAR();
    SLOAD(SO, j + SD); SBAR();
    pv_d0(o, vb0, pa0, pa1, pa2, pa3); partialSM(pB0, pB1, m_reg, mnB, alB);
    __syncthreads(); SWAIT(); SWRITE(0, SE);
    RESC(alB); __syncthreads();
    SBAR(); qkt(pA0, pA1, K_lds, Q_lds, qrow, r32, hi); bias(pA0, pA1, j + 1, wid, r32, hi);
    finishSM(pB0, pB1, alB, l_reg, pa0, pa1, pa2, pa3); SBAR();
    if (SD == 1 || j + 3 < NT) SLOAD(SE, j + 1 + SD); SBAR();
    pv_d0(o, vb0 + (int)SHM_V, pa0, pa1, pa2, pa3); partialSM(pA0, pA1, m_reg, mnA, alA);
    __syncthreads(); SWAIT(); SWRITE(1, SO);
    RESC(alA); __syncthreads();
  }
  SBAR(); qkt(pB0, pB1, (bf16_t*)((char*)K_lds + SHM_K), Q_lds, qrow, r32, hi); bias(pB0, pB1, NT - 1, wid, r32, hi);
  finishSM(pA0, pA1, alA, l_reg, pa0, pa1, pa2, pa3); SBAR();
  pv_d0(o, vb0, pa0, pa1, pa2, pa3); partialSM(pB0, pB1, m_reg, mnB, alB);
  __syncthreads(); RESC(alB);
  finishSM(pB0, pB1, alB, l_reg, pa0, pa1, pa2, pa3); SBAR();
  pv_d0(o, vb0 + (int)SHM_V, pa0, pa1, pa2, pa3);
  if (hi == 0) li_l[r32] = l_reg; asm volatile("s_waitcnt lgkmcnt(0)" ::: "memory");
  float rli[16];
#pragma unroll
  for (int r = 0; r < 16; ++r) rli[r] = __builtin_amdgcn_rcpf(li_l[crow(r, hi)]);
  bf16_t* Ow = Ob + (long)(wid * QBLK) * LDO;
#pragma unroll
  for (int r = 0; r < 16; ++r) { int orow = crow(r, hi);
    for (int d0 = 0; d0 < 4; ++d0) Ow[(long)orow * LDO + d0 * 32 + r32] = f2bf(o[d0][r] * rli[r]); }
#undef SLOAD
#undef SWRITE
#undef SWAIT
#undef RESC
}
}
namespace gdn {
using att::bf16x8; using att::f32x16; using att::crow;
constexpr int C = 32, SK = 136, SS = 40;
constexpr int OFF_KT = 0, OFF_QT = OFF_KT + C * SK * 2, OFF_W = OFF_QT + C * SK * 2, OFF_KTT = OFF_W + C * SK * 2, OFF_VTT = OFF_KTT + 128 * SS * 2,
              OFF_VN = OFF_VTT + 128 * SS * 2, OFF_VNS = OFF_VN + 128 * SS * 2, OFF_ST = OFF_VNS + 128 * SS * 2, OFF_TB = OFF_ST + 128 * SK * 2,
              OFF_TBE = OFF_TB + C * SS * 2, OFF_ATT = OFF_TBE + C * SS * 2, OFF_L = OFF_ATT + C * SS * 2, OFF_SC = OFF_L + C * C * 4, GDN_LDS = OFF_SC + 1024;
template <int K>
__device__ __forceinline__ f32x16 mm(const bf16_t* A, int lda, const bf16_t* Bt, int ldb, int l32, int hi, f32x16 acc) {
#pragma unroll
    for (int k0 = 0; k0 < K; k0 += 16) {
        const bf16x8 a = *reinterpret_cast<const bf16x8*>(A + l32 * lda + k0 + 8 * hi);
        const bf16x8 b = *reinterpret_cast<const bf16x8*>(Bt + l32 * ldb + k0 + 8 * hi);
        acc = __builtin_amdgcn_mfma_f32_32x32x16_bf16(a, b, acc, 0, 0, 0);
    }
    return acc;
}
__device__ __forceinline__ uint2 pk4(float a, float b, float c, float d) { uint2 w; w.x = pack2(a, b); w.y = pack2(c, d); return w; }

__device__ __forceinline__ void gdn_chunked(const Params& p, int l, bool ctx, int b, int h, int dir, unsigned char* lds) {
    const int tid = opaque_tid(), wid = tid >> 6, lane = tid & 63, l32 = lane & 31, hi = lane >> 5;
    const int T = ctx ? CT : ::LT; const size_t m0 = ctx ? (size_t)b * CT : (size_t)MC + (size_t)b * ::LT;
    const bf16_t* DQ = WSP(bf16_t, WS_DQ); const bf16_t* DK = WSP(bf16_t, WS_DK); const bf16_t* DV = WSP(bf16_t, WS_DV); const float* DBA = WSP(float, WS_DBA);
    float* O = WSP(float, dir ? WS_DOB : WS_DOF);
    bf16_t* Kt = (bf16_t*)(lds + OFF_KT); bf16_t* Qt = (bf16_t*)(lds + OFF_QT); bf16_t* W = (bf16_t*)(lds + OFF_W); bf16_t* KT = (bf16_t*)(lds + OFF_KTT); bf16_t* VT = (bf16_t*)(lds + OFF_VTT);
    bf16_t* VN = (bf16_t*)(lds + OFF_VN); bf16_t* VNS = (bf16_t*)(lds + OFF_VNS); bf16_t* ST = (bf16_t*)(lds + OFF_ST); bf16_t* TB = (bf16_t*)(lds + OFF_TB); bf16_t* TBE = (bf16_t*)(lds + OFF_TBE);
    bf16_t* ATT = (bf16_t*)(lds + OFF_ATT); float* Lm = (float*)(lds + OFF_L); float* sc = (float*)(lds + OFF_SC);
    const int nch = T / C;
#define TOK(c, s_) (m0 + (dir ? T - 1 - ((c) * C + (s_)) : (c) * C + (s_)))
    f32x16 S[2];
#pragma unroll
    for (int bi = 0; bi < 2; ++bi) {
        const int blk = wid * 2 + bi, d0 = 32 * (blk >> 2), e0 = 32 * (blk & 3);
        if (ctx) { S[bi] = f32x16{}; }
        else {
            const float* s0 = p.in[I_SGDN] + ((((size_t)b * DEPTH + l) * 2 + dir) * 4 + h) * 128 * 128 + e0 + l32;
#pragma unroll
            for (int r = 0; r < 16; ++r) S[bi][r] = s0[(size_t)(d0 + crow(r, hi)) * 128];
        }
    }
    const int ls = tid >> 5, lc = (tid & 31) * 4;
    vf4 pq0, pq1, pk0, pk1, pv0, pv1; float pbeta = 0.f, pg = 0.f;
#define GLOAD(c) do { const size_t ma = TOK(c, ls), mb = TOK(c, ls + 16); \
        pq0 = ld4bf(DQ + ma * 512 + h * 128 + lc); pq1 = ld4bf(DQ + mb * 512 + h * 128 + lc); \
        pk0 = ld4bf(DK + ma * 512 + h * 128 + lc); pk1 = ld4bf(DK + mb * 512 + h * 128 + lc); \
        pv0 = ld4bf(DV + ma * 512 + h * 128 + lc); pv1 = ld4bf(DV + mb * 512 + h * 128 + lc); \
        if (tid < C) { const size_t mt = TOK(c, tid); pbeta = DBA[mt * 16 + dir * 4 + h]; pg = DBA[mt * 16 + 8 + dir * 4 + h]; } } while (0)
#define GSTAGE() do { \
        *(uint2*)(Kt + ls * SK + lc) = pk4(pk0.x, pk0.y, pk0.z, pk0.w); *(uint2*)(Kt + (ls + 16) * SK + lc) = pk4(pk1.x, pk1.y, pk1.z, pk1.w); \
        *(uint2*)(Qt + ls * SK + lc) = pk4(pq0.x, pq0.y, pq0.z, pq0.w); *(uint2*)(Qt + (ls + 16) * SK + lc) = pk4(pq1.x, pq1.y, pq1.z, pq1.w); \
        _Pragma("unroll") for (int j = 0; j < 4; ++j) { KT[(lc + j) * SS + ls] = f2bf(pk0[j]); KT[(lc + j) * SS + ls + 16] = f2bf(pk1[j]); \
                                                        VT[(lc + j) * SS + ls] = f2bf(pv0[j]); VT[(lc + j) * SS + ls + 16] = f2bf(pv1[j]); } \
        if (wid == 0) { float x = pg; _Pragma("unroll") for (int o_ = 1; o_ < 32; o_ <<= 1) { const float y = __shfl_up(x, o_); if (lane >= o_) x += y; } \
            const float Bt_ = __shfl(x, 31); if (lane < C) { sc[lane] = pbeta; sc[32 + lane] = x; sc[64 + lane] = __expf(x); sc[96 + lane] = __expf(Bt_ - x); if (lane == 0) sc[128] = __expf(Bt_); } } } while (0)
    __syncthreads();
    GLOAD(0);
#pragma unroll
    for (int bi = 0; bi < 2; ++bi) {
        const int blk = wid * 2 + bi, d0 = 32 * (blk >> 2), e0 = 32 * (blk & 3);
#pragma unroll
        for (int g = 0; g < 4; ++g) *(uint2*)(ST + (e0 + l32) * SK + d0 + 8 * g + 4 * hi) = pk4(S[bi][4 * g], S[bi][4 * g + 1], S[bi][4 * g + 2], S[bi][4 * g + 3]);
    }
    GSTAGE();
    __syncthreads();
    for (int c = 0; c < nch; ++c) {
        if (c + 1 < nch) GLOAD(c + 1);
        f32x16 acc1 = f32x16{};
        if (wid == 0) {
            const f32x16 kk = mm<128>(Kt, SK, Kt, SK, l32, hi, f32x16{});
            const float bi_ = sc[32 + l32], be = sc[l32];
#pragma unroll
            for (int r = 0; r < 16; ++r) { const int j = crow(r, hi); const float v = (l32 > j) ? be * kk[r] * __expf(bi_ - sc[32 + j]) : 0.f;
                Lm[l32 * 32 + ((r & 3) + 4 * hi) * 4 + (r >> 2)] = v; }
        } else if (wid == 1) {
            const f32x16 kq = mm<128>(Kt, SK, Qt, SK, l32, hi, f32x16{});
            const float bi_ = sc[32 + l32];
            float a[16];
#pragma unroll
            for (int r = 0; r < 16; ++r) { const int j = crow(r, hi); a[r] = (l32 >= j) ? kq[r] * __expf(bi_ - sc[32 + j]) : 0.f; }
#pragma unroll
            for (int g = 0; g < 4; ++g) *(uint2*)(ATT + l32 * SS + 8 * g + 4 * hi) = pk4(a[4 * g], a[4 * g + 1], a[4 * g + 2], a[4 * g + 3]);
        } else if (wid >= 4) {
            acc1 = mm<128>(Qt, SK, ST + (32 * (wid - 4)) * SK, SK, l32, hi, f32x16{});
#pragma unroll
            for (int r = 0; r < 16; ++r) acc1[r] *= sc[64 + crow(r, hi)];
        }
        __syncthreads();
        if (tid < 256) {
            const int cc = tid >> 3, part = tid & 7;
            float Tr[4] = {0.f, 0.f, 0.f, 0.f};
            const float* Lp = Lm + part * 4;
#pragma unroll
            for (int i = 0; i < 32; ++i) {
                const vf4 lv = *(const vf4*)(Lp + i * 32);
                float s = lv.x * Tr[0] + lv.y * Tr[1] + lv.z * Tr[2] + lv.w * Tr[3];
                s = red8(s);
                const float t = (i == cc ? 1.f : 0.f) - s;
                if (part == (i & 7)) Tr[i >> 3] = t;
            }
            const float bc = sc[cc], bec = bc * sc[64 + cc];
#pragma unroll
            for (int jj = 0; jj < 4; ++jj) { TB[(part + 8 * jj) * SS + cc] = f2bf(Tr[jj] * bc); TBE[(part + 8 * jj) * SS + cc] = f2bf(Tr[jj] * bec); }
        }
        __syncthreads();
        if (wid < 4) {
            acc1 = mm<32>(TB, SS, VT + (32 * wid) * SS, SS, l32, hi, f32x16{});
        } else {
            const int d0 = 32 * (wid - 4);
            const f32x16 wt = mm<32>(KT + d0 * SS, SS, TBE, SS, l32, hi, f32x16{});
#pragma unroll
            for (int g = 0; g < 4; ++g) *(uint2*)(W + l32 * SK + d0 + 8 * g + 4 * hi) = pk4(wt[4 * g], wt[4 * g + 1], wt[4 * g + 2], wt[4 * g + 3]);
        }
        __syncthreads();
        if (wid < 4) {
            const int e0 = 32 * wid;
            const f32x16 ws = mm<128>(W, SK, ST + e0 * SK, SK, l32, hi, f32x16{});
            float vn[16], vs[16];
#pragma unroll
            for (int r = 0; r < 16; ++r) { vn[r] = acc1[r] - ws[r]; vs[r] = vn[r] * sc[96 + crow(r, hi)]; }
#pragma unroll
            for (int g = 0; g < 4; ++g) { *(uint2*)(VN + (e0 + l32) * SS + 8 * g + 4 * hi) = pk4(vn[4 * g], vn[4 * g + 1], vn[4 * g + 2], vn[4 * g + 3]);
                                          *(uint2*)(VNS + (e0 + l32) * SS + 8 * g + 4 * hi) = pk4(vs[4 * g], vs[4 * g + 1], vs[4 * g + 2], vs[4 * g + 3]); }
        }
        __syncthreads();
        if (wid >= 4) {
            const int e0 = 32 * (wid - 4);
            acc1 = mm<32>(ATT, SS, VN + e0 * SS, SS, l32, hi, acc1);
#pragma unroll
            for (int r = 0; r < 16; ++r) O[TOK(c, crow(r, hi)) * 512 + h * 128 + e0 + l32] = acc1[r];
        }
        {
            const float eB = sc[128];
#pragma unroll
            for (int bi = 0; bi < 2; ++bi) {
                const int blk = wid * 2 + bi, d0 = 32 * (blk >> 2), e0 = 32 * (blk & 3);
#pragma unroll
                for (int r = 0; r < 16; ++r) S[bi][r] *= eB;
                S[bi] = mm<32>(KT + d0 * SS, SS, VNS + e0 * SS, SS, l32, hi, S[bi]);
            }
        }
        __syncthreads();
#pragma unroll
        for (int bi = 0; bi < 2; ++bi) {
            const int blk = wid * 2 + bi, d0 = 32 * (blk >> 2), e0 = 32 * (blk & 3);
#pragma unroll
            for (int g = 0; g < 4; ++g) *(uint2*)(ST + (e0 + l32) * SK + d0 + 8 * g + 4 * hi) = pk4(S[bi][4 * g], S[bi][4 * g + 1], S[bi][4 * g + 2], S[bi][4 * g + 3]);
        }
        if (c + 1 < nch) GSTAGE();
        __syncthreads();
    }
#undef GLOAD
#undef GSTAGE
#undef TOK
    if (ctx) {
#pragma unroll
        for (int bi = 0; bi < 2; ++bi) {
            const int blk = wid * 2 + bi, d0 = 32 * (blk >> 2), e0 = 32 * (blk & 3);
            float* so = p.out + O_SGDN + ((((size_t)b * DEPTH + l) * 2 + dir) * 4 + h) * 128 * 128 + e0 + l32;
#pragma unroll
            for (int r = 0; r < 16; ++r) so[(size_t)(d0 + crow(r, hi)) * 128] = S[bi][r];
        }
    }
}
}

namespace gla {
using att::bf16x8; using att::f32x16; using att::crow; using gdn::mm; using gdn::pk4;
constexpr int C = 32, SQ = 72, SS = 40;
constexpr int OFF_QE = 0, OFF_KN = OFF_QE + C * SQ * 2, OFF_KET = OFF_KN + C * SQ * 2, OFF_VT = OFF_KET + 64 * SS * 2, OFF_ATT = OFF_VT + 128 * SS * 2, OFF_ST = OFF_ATT + C * SS * 2,
              OFF_LA = OFF_ST + 128 * SQ * 2, OFF_EB = OFF_LA + C * 64 * 4, GLA_LDS = OFF_EB + 256;
__device__ __forceinline__ void gla_chunked(const Params& p, int l, bool ctx, int b, int h, int dir, unsigned char* lds) {
    const int tid = opaque_tid(), wid = tid >> 6, lane = tid & 63, l32 = lane & 31, hi = lane >> 5;
    const int T = ctx ? CT : ::LT; const size_t m0 = ctx ? (size_t)b * CT : (size_t)MC + (size_t)b * ::LT;
    const bf16_t* Z = WSP(bf16_t, WS_Z); const float* LA = WSP(float, dir ? WS_AB : WS_AF);
    float* O = WSP(float, dir ? WS_GOB : WS_GOF);
    bf16_t* Qe = (bf16_t*)(lds + OFF_QE); bf16_t* Kn = (bf16_t*)(lds + OFF_KN); bf16_t* KeT = (bf16_t*)(lds + OFF_KET); bf16_t* VT = (bf16_t*)(lds + OFF_VT);
    bf16_t* ATT = (bf16_t*)(lds + OFF_ATT); bf16_t* ST = (bf16_t*)(lds + OFF_ST); float* la = (float*)(lds + OFF_LA); float* eB = (float*)(lds + OFF_EB);
    const int nch = T / C;
#define TOK(c, s_) (m0 + (dir ? T - 1 - ((c) * C + (s_)) : (c) * C + (s_)))
    const int d0 = 32 * (wid >> 2), e0 = 32 * (wid & 3);
    f32x16 S;
    if (ctx) S = f32x16{};
    else {
        const float* s0 = p.in[I_SGLA] + ((((size_t)b * DEPTH + l) * 2 + dir) * 4 + h) * 64 * 128 + e0 + l32;
#pragma unroll
        for (int r = 0; r < 16; ++r) S[r] = s0[(size_t)(d0 + crow(r, hi)) * 128];
    }
    const int ts = tid >> 4, dc = (tid & 15) * 4, vs = tid >> 5, vc = (tid & 31) * 4;
    vf4 pq, pk, pl, pv0, pv1;
#define GLOAD(c) do { const size_t mt = TOK(c, ts), ma = TOK(c, vs), mb = TOK(c, vs + 16); \
        pq = ld4bf(Z + mt * NINP + Z_GLQ + h * 64 + dc); pk = ld4bf(Z + mt * NINP + Z_GLK + h * 64 + dc); pl = *(const vf4*)(LA + mt * 256 + h * 64 + dc); \
        pv0 = ld4bf(Z + ma * NINP + Z_GLV + h * 128 + vc); pv1 = ld4bf(Z + mb * NINP + Z_GLV + h * 128 + vc); } while (0)
#define WRITE_ST() do { _Pragma("unroll") for (int g = 0; g < 4; ++g) *(uint2*)(ST + (e0 + l32) * SQ + d0 + 8 * g + 4 * hi) = pk4(S[4 * g], S[4 * g + 1], S[4 * g + 2], S[4 * g + 3]); } while (0)
#define GIMAGES() do { vf4 pre = (vf4){0.f, 0.f, 0.f, 0.f}, tot = pre; \
        _Pragma("unroll 8") for (int t_ = 0; t_ < C; ++t_) { const vf4 v_ = *(const vf4*)(la + t_ * 64 + dc); tot += v_; if (t_ <= ts) pre += v_; } \
        float qe[4], kn[4]; \
        _Pragma("unroll") for (int j = 0; j < 4; ++j) { qe[j] = pq[j] * 0.125f * __expf(pre[j]); kn[j] = pk[j] * __expf(fminf(-pre[j], 80.f)); \
            KeT[(dc + j) * SS + ts] = f2bf(pk[j] * __expf(tot[j] - pre[j])); } \
        *(uint2*)(Qe + ts * SQ + dc) = pk4(qe[0], qe[1], qe[2], qe[3]); *(uint2*)(Kn + ts * SQ + dc) = pk4(kn[0], kn[1], kn[2], kn[3]); \
        if (ts == 0) { _Pragma("unroll") for (int j = 0; j < 4; ++j) eB[dc + j] = __expf(tot[j]); } \
        _Pragma("unroll") for (int j = 0; j < 4; ++j) { VT[(vc + j) * SS + vs] = f2bf(pv0[j]); VT[(vc + j) * SS + vs + 16] = f2bf(pv1[j]); } } while (0)
    __syncthreads();
    GLOAD(0);
    WRITE_ST();
    *(vf4*)(la + ts * 64 + dc) = pl;
    __syncthreads();
    GIMAGES();
    __syncthreads();
    for (int c = 0; c < nch; ++c) {
        if (c + 1 < nch) GLOAD(c + 1);
        f32x16 o1 = f32x16{};
        if (wid == 0) {
            const f32x16 kq = mm<64>(Kn, SQ, Qe, SQ, l32, hi, f32x16{});
            float a[16];
#pragma unroll
            for (int r = 0; r < 16; ++r) a[r] = (l32 >= crow(r, hi)) ? kq[r] : 0.f;
#pragma unroll
            for (int g = 0; g < 4; ++g) *(uint2*)(ATT + l32 * SS + 8 * g + 4 * hi) = pk4(a[4 * g], a[4 * g + 1], a[4 * g + 2], a[4 * g + 3]);
        } else if (wid >= 4) {
            o1 = mm<64>(Qe, SQ, ST + (32 * (wid - 4)) * SQ, SQ, l32, hi, f32x16{});
        }
        __syncthreads();
        if (wid >= 4) {
            const int eo = 32 * (wid - 4);
            o1 = mm<32>(ATT, SS, VT + eo * SS, SS, l32, hi, o1);
#pragma unroll
            for (int r = 0; r < 16; ++r) O[TOK(c, crow(r, hi)) * 512 + h * 128 + eo + l32] = o1[r];
        }
#pragma unroll
        for (int r = 0; r < 16; ++r) S[r] *= eB[d0 + crow(r, hi)];
        S = mm<32>(KeT + d0 * SS, SS, VT + e0 * SS, SS, l32, hi, S);
        __syncthreads();
        WRITE_ST();
        if (c + 1 < nch) *(vf4*)(la + ts * 64 + dc) = pl;
        __syncthreads();
        if (c + 1 < nch) GIMAGES();
        __syncthreads();
    }
#undef GLOAD
#undef WRITE_ST
#undef GIMAGES
#undef TOK
    if (ctx) {
        float* so = p.out + O_SGLA + ((((size_t)b * DEPTH + l) * 2 + dir) * 4 + h) * 64 * 128 + e0 + l32;
#pragma unroll
        for (int r = 0; r < 16; ++r) so[(size_t)(d0 + crow(r, hi)) * 128] = S[r];
    }
}
}
#define LAS __attribute__((address_space(3)))
constexpr int LDS_BYTES = 147456, XBW_OFF = LDS_BYTES - 64;
constexpr int NPH = 1 + DEPTH * 12;
#ifndef DBG_NLAYERS
#define DBG_NLAYERS DEPTH
#endif

#ifndef DUPKIND
#define DUPKIND 0
#endif
__device__ __forceinline__ int opaque_int(int v) { asm volatile("" : "+s"(v)); return v; }
#ifndef MIXMASK
#define MIXMASK 0xFF
#endif
#define FOR_ITEMS(it, n, o, w) for (int bo_ = (o) * (int)gridDim.x / 256, bw_ = ((w) * (int)gridDim.x / 256) > 0 ? ((w) * (int)gridDim.x / 256) : 1, \
                                    it = ((int)blockIdx.x >= bo_ && (int)blockIdx.x < bo_ + bw_) ? (int)blockIdx.x - bo_ : (n); it < (n); it += bw_)

#ifndef SPLITK
#define SPLITK 0
#endif
constexpr int FLAG_WORD0 = 8192;
constexpr int QCTR_WORD0 = 1024;
constexpr int NI_GDNL = LB * 8, NI_GLAL = LB * 8, NI_GDNC = CB * 8, NI_GQAL = LB * 16, NI_NAL = LB * 16, NI_GLAC = CB * 8, NI_NAC = CB * 4, NI_GQAC = CB * 4;
#define KM(k) (1 + ((DUPKIND >> (k)) & 1))
constexpr int Q0 = NI_GDNL * KM(0), Q1 = Q0 + NI_GQAL * KM(1), Q2 = Q1 + NI_NAL * KM(2), Q3 = Q2 + NI_GLAL * KM(3), Q4 = Q3 + NI_GDNC * KM(4), Q5 = Q4 + NI_NAC * KM(5), Q6 = Q5 + NI_GQAC * KM(6), Q7 = Q6 + NI_GLAC * KM(7);
__device__ __forceinline__ void phase_mix(const Params& p, int l, unsigned char* lds, int rep) {
    const int tid = opaque_tid();
    float* smem = (float*)lds;
    const bf16_t* NAQ = WSP(bf16_t, WS_NAQ); const bf16_t* NAK = WSP(bf16_t, WS_NAK); const bf16_t* NAV = WSP(bf16_t, WS_NAV);
    const bf16_t* GQ = WSP(bf16_t, WS_GQ); const bf16_t* GK = WSP(bf16_t, WS_GK); const bf16_t* GV = WSP(bf16_t, WS_GV);
    bf16_t* MRG = WSP(bf16_t, WS_MRG);
    unsigned* qctr = WSP(unsigned, WS_CTL) + QCTR_WORD0 + 64 * l + 16 * rep;
    volatile int* qslot = (volatile int*)(lds + XBW_OFF + 16);
    for (;;) {
        __syncthreads();
        if (tid == 0) *qslot = (int)__hip_atomic_fetch_add(qctr, 1u, __ATOMIC_RELAXED, __HIP_MEMORY_SCOPE_AGENT);
        __syncthreads();
        const int q = __builtin_amdgcn_readfirstlane(*qslot);
        if (q >= Q7) break;
        if (q < Q0) { const int it = q % NI_GDNL; gdn::gdn_chunked(p, l, false, it / 8, (it / 2) % 4, it % 2, lds); }
        else if (q < Q1) {
            const int it = (q - Q0) % NI_GQAL, b = it / 16, qh = (it / 4) % 4, qb = it % 4, kvh = qh >> 1;
            const size_t r0 = (size_t)MC + (size_t)b * LT;
            att::SrcTwo src{WSP(bf16_t, WS_CGK) + ((size_t)b * DEPTH + l) * 256 * 256 + kvh * 128, WSP(bf16_t, WS_CGV) + ((size_t)b * DEPTH + l) * 256 * 256 + kvh * 128,
                            GK + r0 * 256 + kvh * 128, GV + r0 * 256 + kvh * 128, 256};
            att::attn_body<2>(GQ + (r0 + qb * 256) * 512 + qh * 128, src, MRG + (r0 + qb * 256) * DM + 1024 + qh * 128, 4 + LT / 64, (char*)lds, att::NoBias{});
        }
        else if (q < Q2) {
            const int it = (q - Q1) % NI_NAL, b = it / 16, h = (it / 4) % 4, qb = it % 4;
            const int kr0 = qb == 0 ? 0 : qb == 1 ? 0 : qb == 2 ? 4 : 8, nrows = (qb == 0 || qb == 3) ? 8 : 12;
            const size_t r0 = (size_t)MC + (size_t)b * LT;
            float* tab = (float*)(lds + att::SHM_ATTN);
            if (tid < 15 * 31) tab[tid] = p.in[I_RPB][((size_t)l * 4 + h) * 15 * 31 + tid] * (1.0f / att::SCALE);
            att::SrcTwo src{WSP(bf16_t, WS_CNAK) + ((size_t)b * DEPTH + l) * 256 * 512 + h * 128, WSP(bf16_t, WS_CNAV) + ((size_t)b * DEPTH + l) * 256 * 512 + h * 128,
                            NAK + (r0 + kr0 * 64) * 512 + h * 128, NAV + (r0 + kr0 * 64) * 512 + h * 128, 512};
            att::attn_body<1>(NAQ + (r0 + qb * 256) * 512 + h * 128, src, MRG + (r0 + qb * 256) * DM + 0 + h * 128, 4 + nrows, (char*)lds, att::NaBias{tab, qb * 256, kr0});
        }
        else if (q < Q3) { const int it = (q - Q2) % NI_GLAL; gla::gla_chunked(p, l, false, it / 8, (it / 2) % 4, it % 2, lds); }
        else if (q < Q4) { const int it = (q - Q3) % NI_GDNC; gdn::gdn_chunked(p, l, true, it / 8, (it / 2) % 4, it % 2, lds); }
        else if (q < Q5) {
            const int it = (q - Q4) % NI_NAC, b = it / 4, h = it % 4; const size_t r0 = (size_t)b * CT;
            att::SrcOne src{NAK + r0 * 512 + h * 128, NAV + r0 * 512 + h * 128, 512};
            att::attn_body<2>(NAQ + r0 * 512 + h * 128, src, MRG + r0 * DM + 0 + h * 128, CT / 64, (char*)lds, att::NoBias{});
        }
        else if (q < Q6) {
            const int it = (q - Q5) % NI_GQAC, b = it / 4, qh = it % 4, kvh = qh >> 1; const size_t r0 = (size_t)b * CT;
            att::SrcOne src{GK + r0 * 256 + kvh * 128, GV + r0 * 256 + kvh * 128, 256};
            att::attn_body<2>(GQ + r0 * 512 + qh * 128, src, MRG + r0 * DM + 1024 + qh * 128, CT / 64, (char*)lds, att::NoBias{});
        }
        else { const int it = (q - Q6) % NI_GLAC; gla::gla_chunked(p, l, true, it / 8, (it / 2) % 4, it % 2, lds); }
    }
}

static_assert(att::SHM_ATTN + 15 * 31 * 4 + 2048 <= (size_t)XBW_OFF, "LDS map");
static_assert((QCTR_WORD0 + 64 * DEPTH) < 4096, "ctl");
constexpr int BAR_WORD0 = 4096;
static_assert((BAR_WORD0 + XCD_BAR_WORDS) * 4 <= (int)CTL_BYTES, "ctl");

__global__ void __launch_bounds__(512, 2) fwd(Params p) {
    extern __shared__ __attribute__((aligned(16))) unsigned char lds[];
    const int tid = threadIdx.x;
    volatile LAS unsigned* xbw = (volatile LAS unsigned*)((LAS unsigned char*)lds + XBW_OFF);
    if (tid < 4) xbw[tid] = 0u;
    __syncthreads();
    XcdBarrier bar; bar.bar = WSP(unsigned, WS_CTL) + BAR_WORD0; bar.x = 0; bar.st = xbw;
    if (p.ph_hi - p.ph_lo > 1) bar = xcd_barrier_post(WSP(unsigned, WS_CTL) + BAR_WORD0, xbw);
#ifndef PHMASK
#define PHMASK 0x1FFF
#endif
#define IN(k) (p.ph_lo <= (k) && (k) < p.ph_hi)
#define INL(j) (((PHMASK >> ((j) + 1)) & 1) && IN(pb + (j)))
#ifndef DUPMASK
#define DUPMASK 0
#endif
#define DUP(j) ((DUPMASK >> ((j) + 1)) & 1)
#if DUPMASK
#define REPS(j) opaque_int(1 + DUP(j))
#else
#define REPS(j) 1
#endif
#define SEAM(k) do { if (IN(k) && IN((k) + 1)) xcd_barrier(bar); } while (0)
    LAS unsigned char* ldsl = (LAS unsigned char*)lds;
    bf16_t* H = WSP(bf16_t, WS_H); bf16_t* ACT = WSP(bf16_t, WS_ACT); float* X = WSP(float, WS_X); float* Z = WSP(float, WS_Z); bf16_t* MRG = WSP(bf16_t, WS_MRG);

    if ((PHMASK & 1) && IN(0)) { const int reps_ = (DUPMASK & 1) ? opaque_int(2) : 1; for (int rep_ = 0; rep_ < reps_; ++rep_) { const Params q = opaque_params(p); phase_prologue(q, (float*)lds); __syncthreads(); } }
    SEAM(0);
    for (int l = 0; l < DBG_NLAYERS; ++l) {
        const int pb = 1 + l * 12;
        const float* modl = WSP(float, WS_MODV) + (size_t)l * NCOND * NMOD;
        if (INL(0)) { const int reps_ = REPS(0); for (int rep_ = 0; rep_ < reps_; ++rep_) { const Params q = opaque_params(p); phase_norm(q, l, 0); __syncthreads(); } }
        SEAM(pb + 0);
        if (INL(1)) {
            pg8::Gemm g{H, WSP(bf16_t, WS_WGU) + ((size_t)l * 2 + 0) * NGU * DM, M, NGU, DM}; pg8::StaticOrder S; S.init(M, NGU, DM, (int)gridDim.x, (int)blockIdx.x);
            pg8::EpiSwiGLU E{ACT, FF};
            for (int r_ = 0, n_ = REPS(1); r_ < n_; ++r_) pg8::gemm_phase<pg8::EpiSwiGLU, pg8::StaticOrder, false>(ldsl, g, S, E, nullptr);
#if CONV_FILLER
            if (l + 1 < DBG_NLAYERS) {
                const int nw_ = (M / 256) * (NGU / 256), G_ = (int)gridDim.x; int f0_ = nw_ % G_; if (nw_ < G_) f0_ = 0;
                if ((int)blockIdx.x >= f0_) { const Params q = opaque_params(p); mod_layer(q, l + 1, (int)blockIdx.x - f0_, G_ - f0_, (float*)lds); }
            }
#endif
        }
        SEAM(pb + 1);
        if (INL(2)) {
            pg8::Gemm g{ACT, WSP(bf16_t, WS_WDN) + ((size_t)l * 2 + 0) * DM * FF, M, DM, FF}; pg8::StaticOrder S; S.init(M, DM, FF, (int)gridDim.x, (int)blockIdx.x, SPLITK);
            pg8::EpiResid E{l == 0 ? p.in[I_XP] : X, X, DM, modl + 2 * DM, 0.5f, Z, WSP(unsigned, WS_CTL) + FLAG_WORD0, 8u * (unsigned)(l * 3 + 1), l == 0 ? p.in[I_XS] : X, l == 0 ? MC : 0x7FFFFFFF};
            pg8::gemm_phase<pg8::EpiResid, pg8::StaticOrder, false>(ldsl, g, S, E, nullptr);
#if CONV_FILLER
            if (l + 1 < DBG_NLAYERS) {
                const int nw_ = (M / 256) * (DM / 256), G_ = (int)gridDim.x; int f0_ = nw_ - G_; if (f0_ < 0 || f0_ >= G_) f0_ = 0;
                if ((int)blockIdx.x >= f0_) { const Params q = opaque_params(p); conv_layer_tiles(q, l + 1, 0, (NT_L * 2 / 5), (int)blockIdx.x - f0_, G_ - f0_, (float*)lds); }
            }
#endif
#if DUPMASK
            if (opaque_int(DUP(2))) { pg8::EpiResid E2{X, Z, DM, modl + 2 * DM, 0.5f, Z, WSP(unsigned, WS_CTL) + FLAG_WORD0, 0u, X, 0x7FFFFFFF}; pg8::gemm_phase<pg8::EpiResid, pg8::StaticOrder, false>(ldsl, g, S, E2, nullptr); }
#endif
        }
        SEAM(pb + 2);
        if (INL(3)) { const int reps_ = REPS(3); for (int rep_ = 0; rep_ < reps_; ++rep_) { const Params q = opaque_params(p); phase_norm(q, l, 1); __syncthreads(); } }
        SEAM(pb + 3);
        if (INL(4)) {
            pg8::Gemm g{H, WSP(bf16_t, WS_WIN) + (size_t)l * NINP * DM, M, NINP, DM}; pg8::StaticOrder S; S.init(M, NINP, DM, (int)gridDim.x, (int)blockIdx.x);
            pg8::EpiBf16Plain E{WSP(bf16_t, WS_Z), NINP};
            for (int r_ = 0, n_ = REPS(4); r_ < n_; ++r_) pg8::gemm_phase<pg8::EpiBf16Plain, pg8::StaticOrder, false>(ldsl, g, S, E, nullptr);
        }
        SEAM(pb + 4);
        if (INL(5)) { const int reps_ = REPS(5); for (int rep_ = 0; rep_ < reps_; ++rep_) { const Params q = opaque_params(p); phase_prep(q, l); __syncthreads(); } }
        SEAM(pb + 5);
        if (INL(6)) { const int reps_ = REPS(6); for (int rep_ = 0; rep_ < reps_; ++rep_) { const Params q = opaque_params(p); phase_mix(q, l, lds, rep_); __syncthreads(); } }
        SEAM(pb + 6);
        if (INL(7)) { const int reps_ = REPS(7); for (int rep_ = 0; rep_ < reps_; ++rep_) { const Params q = opaque_params(p); phase_post(q, l); __syncthreads(); } }
        SEAM(pb + 7);
        if (INL(8)) {
            pg8::Gemm g{MRG, WSP(bf16_t, WS_WOUT) + (size_t)l * DM * DM, M, DM, DM}; pg8::StaticOrder S; S.init(M, DM, DM, (int)gridDim.x, (int)blockIdx.x, SPLITK);
            pg8::EpiResid E{X, X, DM, modl + 5 * DM, 1.0f, Z, WSP(unsigned, WS_CTL) + FLAG_WORD0, 8u * (unsigned)(l * 3 + 2), X, 0x7FFFFFFF};
            pg8::gemm_phase<pg8::EpiResid, pg8::StaticOrder, false>(ldsl, g, S, E, nullptr);
#if CONV_FILLER
            if (l + 1 < DBG_NLAYERS) {
                const int nw_ = (M / 256) * (DM / 256), G_ = (int)gridDim.x; int f0_ = nw_ - G_; if (f0_ < 0 || f0_ >= G_) f0_ = 0;
                if ((int)blockIdx.x >= f0_) { const Params q = opaque_params(p); conv_layer_tiles(q, l + 1, (NT_L * 2 / 5), (NT_L * 3 / 5), (int)blockIdx.x - f0_, G_ - f0_, (float*)lds); }
            }
#endif
#if DUPMASK
            if (opaque_int(DUP(8))) { pg8::EpiResid E2{X, Z, DM, modl + 5 * DM, 1.0f, Z, WSP(unsigned, WS_CTL) + FLAG_WORD0, 0u, X, 0x7FFFFFFF}; pg8::gemm_phase<pg8::EpiResid, pg8::StaticOrder, false>(ldsl, g, S, E2, nullptr); }
#endif
        }
        SEAM(pb + 8);
        if (INL(9)) { const int reps_ = REPS(9); for (int rep_ = 0; rep_ < reps_; ++rep_) { const Params q = opaque_params(p); phase_norm(q, l, 2); __syncthreads(); } }
        SEAM(pb + 9);
        if (INL(10)) {
            pg8::Gemm g{H, WSP(bf16_t, WS_WGU) + ((size_t)l * 2 + 1) * NGU * DM, M, NGU, DM}; pg8::StaticOrder S; S.init(M, NGU, DM, (int)gridDim.x, (int)blockIdx.x);
            pg8::EpiSwiGLU E{ACT, FF};
            pg8::gemm_phase<pg8::EpiSwiGLU, pg8::StaticOrder, false>(ldsl, g, S, E, nullptr);
        }
        SEAM(pb + 10);
        if (INL(11)) {
            pg8::Gemm g{ACT, WSP(bf16_t, WS_WDN) + ((size_t)l * 2 + 1) * DM * FF, M, DM, FF}; pg8::StaticOrder S; S.init(M, DM, FF, (int)gridDim.x, (int)blockIdx.x, SPLITK);
            pg8::EpiResid E{X, (l == DEPTH - 1) ? p.out : X, DM, modl + 8 * DM, 0.5f, Z, WSP(unsigned, WS_CTL) + FLAG_WORD0, 8u * (unsigned)(l * 3 + 3), X, 0x7FFFFFFF};
            pg8::gemm_phase<pg8::EpiResid, pg8::StaticOrder, false>(ldsl, g, S, E, nullptr);
#if CONV_FILLER
            if (l + 1 < DBG_NLAYERS) {
                const int nw_ = (M / 256) * (DM / 256), G_ = (int)gridDim.x; int f0_ = nw_ - G_; if (f0_ < 0 || f0_ >= G_) f0_ = 0;
                if ((int)blockIdx.x >= f0_) { const Params q = opaque_params(p); conv_layer_tiles(q, l + 1, (NT_L * 3 / 5), NT_L, (int)blockIdx.x - f0_, G_ - f0_, (float*)lds); }
            }
#endif
        }
        SEAM(pb + 11);
    }
#undef IN
#undef SEAM
}

#ifndef MULTI_LAUNCH
#define MULTI_LAUNCH 0
#endif
extern "C" void kernel_launch(void* const* d_in, const int* in_sizes, int n_in, void* d_out, int out_size, void* d_ws, size_t ws_size, hipStream_t stream) {
    static int grid = 0;
    if (grid == 0) {
        if (n_in != N_IN || (size_t)out_size != O_END || ws_size < WS_END) { fprintf(stderr, "kernel_launch: shape mismatch n_in %d out %d ws %zu (need %zu)\n", n_in, out_size, ws_size, (size_t)WS_END); grid = -1; return; }
        int dev = 0, cus = 0, per_cu = 0;
        if (hipGetDevice(&dev) != hipSuccess || hipDeviceGetAttribute(&cus, hipDeviceAttributeMultiprocessorCount, dev) != hipSuccess) { grid = -1; return; }
        if (hipFuncSetAttribute((const void*)fwd, hipFuncAttributeMaxDynamicSharedMemorySize, LDS_BYTES) != hipSuccess) { fprintf(stderr, "kernel_launch: hipFuncSetAttribute failed\n"); grid = -1; return; }
        if (hipOccupancyMaxActiveBlocksPerMultiprocessor(&per_cu, (const void*)fwd, 512, LDS_BYTES) != hipSuccess || per_cu < 1) { fprintf(stderr, "kernel_launch: occupancy query says %d\n", per_cu); (void)hipGetLastError(); }
        grid = cus;
    }
    if (grid < 0) return;
    (void)hipMemsetAsync((char*)d_ws + WS_CTL, 0, CTL_BYTES, stream);
    Params p{};
    for (int i = 0; i < N_IN; ++i) p.in[i] = (const float*)d_in[i];
    p.out = (float*)d_out; p.ws = (unsigned char*)d_ws;
#if MULTI_LAUNCH
    for (int ph = 0; ph < 1 + DBG_NLAYERS * 12; ++ph) { p.ph_lo = ph; p.ph_hi = ph + 1; hipLaunchKernelGGL(fwd, dim3(grid), dim3(512), LDS_BYTES, stream, p); }
#else
    p.ph_lo = 0; p.ph_hi = NPH; hipLaunchKernelGGL(fwd, dim3(grid), dim3(512), LDS_BYTES, stream, p);
#endif
    const hipError_t le = hipPeekAtLastError();
    if (le != hipSuccess) fprintf(stderr, "kernel_launch: launch failed: %s\n", hipGetErrorName(le));
}
```

```cpp
#include <hip/hip_runtime.h>
#include <cstdio>
#include <cstdint>

#ifndef CB_
#define CB_ 16
#endif
#ifndef LB_
#define LB_ 8
#endif
#ifndef DEPTH_
#define DEPTH_ 4
#endif
constexpr int DM = 2048, DEPTH = DEPTH_, CB = CB_, CT = 256, LB = LB_, LT = 1024;
constexpr int MC = CB * CT, ML = LB * LT, M = MC + ML;
constexpr int FF = 5504, NGU = 2 * FF, NIN = 6192, NINP = 6400, NMOD = 9 * DM, NCOND = 1 + LB;
constexpr float EPS = 1e-6f;
constexpr int Z_NAQ = 0, Z_NAK = 512, Z_NAV = 1024, Z_GLQ = 1536, Z_GLK = 1792, Z_GLV = 2048, Z_GLR = 2560, Z_GF = 3072, Z_GB = 3088,
              Z_GQQ = 3104, Z_GQK = 3616, Z_GQV = 3872, Z_DQKV = 4128, Z_DZ = 5664, Z_DB = 6176, Z_DA = 6184;
static_assert(Z_DA + 8 == NIN, "split");
enum { I_XP = 0, I_XS, I_CNAK, I_CNAV, I_CGK, I_CGV, I_SGLA, I_SGDN, I_C, I_CCTX, I_NORMG, I_WMOD, I_BMOD, I_GU, I_DOWN, I_WIN, I_WOUT, I_NAQKN, I_RPB,
       I_GUP, I_GBIAS, I_GLAON, I_GQAQKN, I_CONV, I_ALOG, I_DTB, I_GDNON, N_IN };
constexpr size_t O_YP = 0, O_YS = O_YP + (size_t)MC * DM, O_NAK = O_YS + (size_t)ML * DM, O_NAV = O_NAK + (size_t)CB * DEPTH * 4 * CT * 128,
                 O_GK = O_NAV + (size_t)CB * DEPTH * 4 * CT * 128, O_GV = O_GK + (size_t)CB * DEPTH * 2 * CT * 128,
                 O_SGLA = O_GV + (size_t)CB * DEPTH * 2 * CT * 128, O_SGDN = O_SGLA + (size_t)CB * DEPTH * 2 * 4 * 64 * 128,
                 O_END = O_SGDN + (size_t)CB * DEPTH * 2 * 4 * 128 * 128;
constexpr size_t al256(size_t x) { return (x + 255) & ~(size_t)255; }
constexpr size_t WS_CTL = 0, CTL_BYTES = 1u << 20;
constexpr size_t WS_WGU = CTL_BYTES;
constexpr size_t WS_WDN = WS_WGU + (size_t)DEPTH * 2 * NGU * DM * 2;
constexpr size_t WS_WIN = WS_WDN + (size_t)DEPTH * 2 * DM * FF * 2;
constexpr size_t WS_WOUT = WS_WIN + (size_t)DEPTH * NINP * DM * 2;
constexpr size_t WS_MODV = WS_WOUT + (size_t)DEPTH * DM * DM * 2;
constexpr size_t WS_ROPE = al256(WS_MODV + (size_t)DEPTH * NCOND * NMOD * 4);
constexpr size_t WS_X = al256(WS_ROPE + 2 * 64 * 32 * 4);
constexpr size_t WS_H = WS_X + (size_t)M * DM * 4;
constexpr size_t WS_ACT = WS_H + (size_t)M * DM * 2;
constexpr size_t WS_Z = WS_ACT + (size_t)M * FF * 2;
constexpr size_t WS_MRG = WS_Z + (size_t)M * NINP * 4;
constexpr size_t WS_NAQ = WS_MRG + (size_t)M * DM * 2;
constexpr size_t WS_NAK = WS_NAQ + (size_t)M * 512 * 2;
constexpr size_t WS_NAV = WS_NAK + (size_t)M * 512 * 2;
constexpr size_t WS_GQ = WS_NAV + (size_t)M * 512 * 2;
constexpr size_t WS_GK = WS_GQ + (size_t)M * 512 * 2;
constexpr size_t WS_GV = WS_GK + (size_t)M * 256 * 2;
constexpr size_t WS_CNAK = WS_GV + (size_t)M * 256 * 2;
constexpr size_t WS_CNAV = WS_CNAK + (size_t)LB * DEPTH * 256 * 512 * 2;
constexpr size_t WS_CGK = WS_CNAV + (size_t)LB * DEPTH * 256 * 512 * 2;
constexpr size_t WS_CGV = WS_CGK + (size_t)LB * DEPTH * 256 * 256 * 2;
constexpr size_t WS_AF = WS_CGV + (size_t)LB * DEPTH * 256 * 256 * 2;
constexpr size_t WS_AB = WS_AF + (size_t)M * 256 * 4;
constexpr size_t WS_DQ = WS_AB + (size_t)M * 256 * 4;
constexpr size_t WS_DK = WS_DQ + (size_t)M * 512 * 4;
constexpr size_t WS_DV = WS_DK + (size_t)M * 512 * 4;
constexpr size_t WS_DBA = WS_DV + (size_t)M * 512 * 4;
constexpr size_t WS_GOF = WS_DBA + (size_t)M * 16 * 4;
constexpr size_t WS_GOB = WS_GOF + (size_t)M * 512 * 4;
constexpr size_t WS_DOF = WS_GOB + (size_t)M * 512 * 4;
constexpr size_t WS_DOB = WS_DOF + (size_t)M * 512 * 4;
constexpr size_t WS_END = WS_DOB + (size_t)M * 512 * 4;

typedef unsigned short bf16_t;
struct Params { const float* in[N_IN]; float* out; unsigned char* ws; int ph_lo, ph_hi; };
static_assert(sizeof(Params) == N_IN * 8 + 8 + 8 + 8, "no padding");

#define WSP(T, off) ((T*)(p.ws + (off)))
__device__ __forceinline__ int opaque_tid() { int t = (int)threadIdx.x; asm volatile("" : "+v"(t)); return t; }
__device__ __forceinline__ Params opaque_params(const Params& p) { Params q = p; unsigned long long w = (unsigned long long)q.ws; asm volatile("" : "+s"(w)); q.ws = (unsigned char*)w; return q; }

typedef float vf4 __attribute__((ext_vector_type(4)));
__device__ __forceinline__ float bf2f(unsigned short v) { return __uint_as_float((unsigned)v << 16); }
__device__ __forceinline__ vf4 ld4bf(const unsigned short* p) { const uint2 w = *(const uint2*)p; vf4 r; r.x = __uint_as_float(w.x << 16); r.y = __uint_as_float(w.x & 0xFFFF0000u); r.z = __uint_as_float(w.y << 16); r.w = __uint_as_float(w.y & 0xFFFF0000u); return r; }
__device__ __forceinline__ void ld8bf(const unsigned short* p, vf4& a, vf4& b) { const uint4 w = *(const uint4*)p;
    a.x = __uint_as_float(w.x << 16); a.y = __uint_as_float(w.x & 0xFFFF0000u); a.z = __uint_as_float(w.y << 16); a.w = __uint_as_float(w.y & 0xFFFF0000u);
    b.x = __uint_as_float(w.z << 16); b.y = __uint_as_float(w.z & 0xFFFF0000u); b.z = __uint_as_float(w.w << 16); b.w = __uint_as_float(w.w & 0xFFFF0000u); }
__device__ __forceinline__ float wave_sum(float v) {
#pragma unroll
    for (int o = 32; o >= 1; o >>= 1) v += __shfl_xor(v, o);
    return v;
}
__device__ __forceinline__ bf16_t f2bf(float f) { unsigned u = __float_as_uint(f); u += 0x7FFFu + ((u >> 16) & 1u); return (bf16_t)(u >> 16); }
__device__ __forceinline__ unsigned pack2(float a, float b) { return (unsigned)f2bf(a) | ((unsigned)f2bf(b) << 16); }
__device__ __forceinline__ float silu_f(float x) { return x / (1.f + expf(-x)); }
__device__ __forceinline__ float softplus_f(float x) { return fmaxf(x, 0.f) + log1pf(expf(-fabsf(x))); }
__device__ __forceinline__ float logsigmoid_f(float x) { return fminf(x, 0.f) - log1pf(expf(-fabsf(x))); }
__device__ __forceinline__ int cond_of_row(int m) { return m < MC ? 0 : 1 + (m - MC) / LT; }
#ifndef CONV_FILLER
#define CONV_FILLER 1
#endif
__device__ __forceinline__ void conv_tile(const float* __restrict__ src, int ld_src, int ncols_src, int k0, int c0, bf16_t* __restrict__ dst, int ld_dst, int n0, float* tile) {
    const int tid = opaque_tid();
    {
        const int r = tid >> 3, c = (tid & 7) * 8;
        float4 a = make_float4(0.f, 0.f, 0.f, 0.f), b = a;
        if (c0 + c + 8 <= ncols_src) {
            const float* s = src + (size_t)(k0 + r) * ld_src + c0 + c;
            a = *(const float4*)s; b = *(const float4*)(s + 4);
        }
        float* t = tile + r * 65 + c;
        t[0] = a.x; t[1] = a.y; t[2] = a.z; t[3] = a.w; t[4] = b.x; t[5] = b.y; t[6] = b.z; t[7] = b.w;
    }
    __syncthreads();
    {
        const int n = tid >> 3, ks = (tid & 7) * 8;
        const float* t = tile + ks * 65 + n;
        uint4 w;
        w.x = pack2(t[0 * 65], t[1 * 65]); w.y = pack2(t[2 * 65], t[3 * 65]); w.z = pack2(t[4 * 65], t[5 * 65]); w.w = pack2(t[6 * 65], t[7 * 65]);
        *(uint4*)(dst + (size_t)(n0 + n) * ld_dst + k0 + ks) = w;
    }
    __syncthreads();
}

constexpr int MOD_ITEMS = DEPTH * (NMOD / 128);
constexpr int TGU_KT = DM / 64, TGU_NT = NGU / 64, TDN_KT = FF / 64, TDN_NT = DM / 64, TIN_KT = DM / 64, TIN_NT = NINP / 64, TOUT_KT = DM / 64, TOUT_NT = DM / 64;
constexpr int TL_GU = 2 * TGU_KT * TGU_NT, TL_DN = 2 * TDN_KT * TDN_NT, TL_IN = TIN_KT * TIN_NT, TL_OUT = TOUT_KT * TOUT_NT, NT_L = TL_GU + TL_DN + TL_IN + TL_OUT;
__device__ __forceinline__ void conv_layer_tiles(const Params& p, int l, int t_begin, int t_end, int first, int stride, float* s_tile) {
    for (int it = t_begin + first; it < t_end; it += stride) {
        if (it < TL_GU) {
            const int mat = l * 2 + it / (TGU_KT * TGU_NT), r = it % (TGU_KT * TGU_NT), kt = r / TGU_NT, nt = r % TGU_NT;
            const int n0 = nt * 64, t256 = n0 / 256, c = n0 % 256;
            const int c0 = c < 128 ? 128 * t256 + c : FF + 128 * t256 + (c - 128);
            conv_tile(p.in[I_GU] + (size_t)mat * DM * NGU, NGU, NGU, kt * 64, c0, WSP(bf16_t, WS_WGU) + (size_t)mat * NGU * DM, DM, n0, s_tile);
        } else if (it < TL_GU + TL_DN) {
            const int i2 = it - TL_GU, mat = l * 2 + i2 / (TDN_KT * TDN_NT), r = i2 % (TDN_KT * TDN_NT), kt = r / TDN_NT, nt = r % TDN_NT;
            conv_tile(p.in[I_DOWN] + (size_t)mat * FF * DM, DM, DM, kt * 64, nt * 64, WSP(bf16_t, WS_WDN) + (size_t)mat * DM * FF, FF, nt * 64, s_tile);
        } else if (it < TL_GU + TL_DN + TL_IN) {
            const int i2 = it - TL_GU - TL_DN, kt = i2 / TIN_NT, nt = i2 % TIN_NT;
            conv_tile(p.in[I_WIN] + (size_t)l * DM * NIN, NIN, NIN, kt * 64, nt * 64, WSP(bf16_t, WS_WIN) + (size_t)l * NINP * DM, DM, nt * 64, s_tile);
        } else {
            const int i2 = it - TL_GU - TL_DN - TL_IN, kt = i2 / TOUT_NT, nt = i2 % TOUT_NT;
            conv_tile(p.in[I_WOUT] + (size_t)l * DM * DM, DM, DM, kt * 64, nt * 64, WSP(bf16_t, WS_WOUT) + (size_t)l * DM * DM, DM, nt * 64, s_tile);
        }
    }
}

__device__ __forceinline__ void mod_layer(const Params& p, int l, int first, int stride, float* smem) {
    const int tid = opaque_tid();
    float* s_cond = smem;
    float* s_red = s_cond + NCOND * DM;
    __syncthreads();
    for (int i = tid; i < NCOND * DM; i += 512) { const int ci = i / DM, k = i % DM; const float v = ci == 0 ? p.in[I_CCTX][k] : p.in[I_C][(size_t)(ci - 1) * DM + k]; s_cond[i] = silu_f(v); }
    __syncthreads();
    float* modv = WSP(float, WS_MODV);
    for (int jt = first; jt < NMOD / 128; jt += stride) {
        const int cl = tid & 127, kq = tid >> 7, col = jt * 128 + cl;
        const float* w = p.in[I_WMOD] + (size_t)l * DM * NMOD + col;
        float acc[NCOND];
#pragma unroll
        for (int ci = 0; ci < NCOND; ++ci) acc[ci] = 0.f;
        for (int k = kq * 512; k < kq * 512 + 512; k += 8) {
            float wv[8];
#pragma unroll
            for (int j = 0; j < 8; ++j) wv[j] = w[(size_t)(k + j) * NMOD];
#pragma unroll
            for (int ci = 0; ci < NCOND; ++ci) {
                const float4 s0 = *(const float4*)&s_cond[ci * DM + k], s1 = *(const float4*)&s_cond[ci * DM + k + 4];
                acc[ci] += s0.x * wv[0] + s0.y * wv[1] + s0.z * wv[2] + s0.w * wv[3] + s1.x * wv[4] + s1.y * wv[5] + s1.z * wv[6] + s1.w * wv[7];
            }
        }
        if (kq > 0) {
#pragma unroll
            for (int ci = 0; ci < NCOND; ++ci) s_red[((kq - 1) * 128 + cl) * NCOND + ci] = acc[ci];
        }
        __syncthreads();
        if (kq == 0) {
            const float bm = p.in[I_BMOD][(size_t)l * NMOD + col];
#pragma unroll
            for (int ci = 0; ci < NCOND; ++ci)
                modv[((size_t)l * NCOND + ci) * NMOD + col] = acc[ci] + s_red[(0 * 128 + cl) * NCOND + ci] + s_red[(1 * 128 + cl) * NCOND + ci] + s_red[(2 * 128 + cl) * NCOND + ci] + bm;
        }
        __syncthreads();
    }
}

__device__ __forceinline__ void phase_prologue(const Params& p, float* smem) {
    const int tid = threadIdx.x, nb = gridDim.x, bid = blockIdx.x;
    float* s_tile = smem + NCOND * DM + 3 * 128 * NCOND;
#if CONV_FILLER
    mod_layer(p, 0, bid, nb, smem);
#else
    for (int l2 = 0; l2 < DEPTH; ++l2) mod_layer(p, l2, bid, nb, smem);
#endif
    conv_layer_tiles(p, 0, 0, NT_L, bid, nb, s_tile);
#if !CONV_FILLER
    for (int l2 = 1; l2 < DEPTH; ++l2) conv_layer_tiles(p, l2, 0, NT_L, bid, nb, s_tile);
#endif
    const size_t gtid = (size_t)bid * 512 + tid, gstride = (size_t)nb * 512;
    {
        const size_t n_na = (size_t)LB * DEPTH * 256 * 512 / 8;
        for (size_t i = gtid; i < 2 * n_na; i += gstride) {
            const bool isv = i >= n_na; const size_t j = isv ? i - n_na : i;
            const int d8 = (int)(j % 16), h = (int)((j / 16) % 4), t = (int)((j / 64) % 256); const size_t bl = j / (64 * 256);
            const float* s = p.in[isv ? I_CNAV : I_CNAK] + ((bl * 4 + h) * 256 + t) * 128 + d8 * 8;
            const float4 a = *(const float4*)s, b = *(const float4*)(s + 4);
            uint4 w; w.x = pack2(a.x, a.y); w.y = pack2(a.z, a.w); w.z = pack2(b.x, b.y); w.w = pack2(b.z, b.w);
            *(uint4*)(WSP(bf16_t, isv ? WS_CNAV : WS_CNAK) + (bl * 256 + t) * 512 + h * 128 + d8 * 8) = w;
        }
        const size_t n_g = (size_t)LB * DEPTH * 256 * 256 / 8;
        for (size_t i = gtid; i < 2 * n_g; i += gstride) {
            const bool isv = i >= n_g; const size_t j = isv ? i - n_g : i;
            const int d8 = (int)(j % 16), h = (int)((j / 16) % 2), t = (int)((j / 32) % 256); const size_t bl = j / (32 * 256);
            const float* s = p.in[isv ? I_CGV : I_CGK] + ((bl * 2 + h) * 256 + t) * 128 + d8 * 8;
            const float4 a = *(const float4*)s, b = *(const float4*)(s + 4);
            uint4 w; w.x = pack2(a.x, a.y); w.y = pack2(a.z, a.w); w.z = pack2(b.x, b.y); w.w = pack2(b.z, b.w);
            *(uint4*)(WSP(bf16_t, isv ? WS_CGV : WS_CGK) + (bl * 256 + t) * 256 + h * 128 + d8 * 8) = w;
        }
    }
    for (size_t i = gtid; i < 64 * 32; i += gstride) {
        const int pos = (int)(i / 32), k = (int)(i % 32);
        const float inv = powf(10000.0f, -(float)(2 * k) / 64.0f);
        const float ang = (float)pos * inv;
        WSP(float, WS_ROPE)[i] = cosf(ang); WSP(float, WS_ROPE)[64 * 32 + i] = sinf(ang);
    }
}

__device__ __forceinline__ void phase_norm(const Params& p, int l, int which  ) {
    const int tid = opaque_tid(), lane = tid & 63, wv = tid >> 6;
    const float* X = WSP(float, WS_X); bf16_t* H = WSP(bf16_t, WS_H);
    const bool from_in = (l == 0 && which == 0);
    const float* g = p.in[I_NORMG] + ((size_t)l * 3 + which) * DM;
    const int nw = (int)gridDim.x * 8;
    for (int m0 = blockIdx.x * 8 + wv; m0 < M; m0 += 2 * nw) {
        const int m1 = m0 + nw; const bool has1 = m1 < M;
        const int mm[2] = {m0, has1 ? m1 : m0};
        vf4 v[2][8]; float ss[2] = {0.f, 0.f};
#pragma unroll
        for (int k = 0; k < 2; ++k) {
            const int m = mm[k];
            const float* x = from_in ? (m < MC ? p.in[I_XP] + (size_t)m * DM : p.in[I_XS] + (size_t)(m - MC) * DM) : X + (size_t)m * DM;
#pragma unroll
            for (int i = 0; i < 8; ++i) v[k][i] = *(const vf4*)(x + (i * 64 + lane) * 4);
        }
#pragma unroll
        for (int k = 0; k < 2; ++k) {
#pragma unroll
            for (int i = 0; i < 8; ++i) ss[k] += v[k][i].x * v[k][i].x + v[k][i].y * v[k][i].y + v[k][i].z * v[k][i].z + v[k][i].w * v[k][i].w;
            ss[k] = wave_sum(ss[k]);
        }
#pragma unroll
        for (int k = 0; k < 2; ++k) {
            if (k == 1 && !has1) break;
            const int m = mm[k];
            const float* mv = WSP(float, WS_MODV) + ((size_t)l * NCOND + cond_of_row(m)) * NMOD + (size_t)which * 3 * DM;
            const float r = 1.0f / sqrtf(ss[k] * (1.0f / DM) + EPS);
#pragma unroll
            for (int i = 0; i < 8; ++i) {
                const int c = (i * 64 + lane) * 4;
                const float4 gg = *(const float4*)(g + c), sh = *(const float4*)(mv + c), sc = *(const float4*)(mv + DM + c);
                const float o0 = v[k][i].x * r * gg.x * (1.f + sc.x) + sh.x, o1 = v[k][i].y * r * gg.y * (1.f + sc.y) + sh.y;
                const float o2 = v[k][i].z * r * gg.z * (1.f + sc.z) + sh.z, o3 = v[k][i].w * r * gg.w * (1.f + sc.w) + sh.w;
                uint2 w; w.x = pack2(o0, o1); w.y = pack2(o2, o3);
                *(uint2*)(H + (size_t)m * DM + c) = w;
            }
        }
    }
}

__device__ __forceinline__ float red16(float v);
__device__ __forceinline__ float ssq8(vf4 a, vf4 b) { const vf4 s = a * a + b * b; return (s.x + s.y) + (s.z + s.w); }
__device__ __forceinline__ uint4 pack8(vf4 a, vf4 b) { uint4 w; w.x = pack2(a.x, a.y); w.y = pack2(a.z, a.w); w.z = pack2(b.x, b.y); w.w = pack2(b.z, b.w); return w; }
__device__ __forceinline__ void phase_prep(const Params& p, int l) {
    const int tid = opaque_tid(), lane = tid & 63, wv = tid >> 6, rg = lane >> 4, sub = lane & 15, c8 = sub * 8;
    const bf16_t* Z = WSP(bf16_t, WS_Z);
    const float* ropec = WSP(float, WS_ROPE); const float* ropes = ropec + 64 * 32;
    const float* wnq = p.in[I_NAQKN] + ((size_t)l * 2 + 0) * 128 + c8; const float* wnk = wnq + 128;
    const float* wgq = p.in[I_GQAQKN] + ((size_t)l * 2 + 0) * 128 + c8; const float* wgk = wgq + 128;
    const float* cw = p.in[I_CONV] + (size_t)l * 5 * 1536 + rg * 128 + c8;
    const int rpw = (M + (int)gridDim.x * 8 - 1) / ((int)gridDim.x * 8);
    for (int m = ((int)blockIdx.x * 8 + wv) * rpw, mend = (m + rpw < M ? m + rpw : M); m < mend; ++m) {
        const bf16_t* z = Z + (size_t)m * NINP;
        const bool ctx = m < MC;
        const int b = ctx ? m / CT : (m - MC) / LT, t = ctx ? m % CT : (m - MC) % LT, T = ctx ? CT : LT;
        {
            const int ho = rg * 128 + c8;
            const bf16_t* zkv = z + (rg < 2 ? Z_GQK + rg * 128 : Z_GQV + (rg - 2) * 128) + c8;
            vf4 q0, q1, k0, k1, v0, v1, g0, g1, x0, x1;
            ld8bf(z + Z_NAQ + ho, q0, q1); ld8bf(z + Z_NAK + ho, k0, k1); ld8bf(z + Z_NAV + ho, v0, v1); ld8bf(z + Z_GQQ + ho, g0, g1); ld8bf(zkv, x0, x1);
            float r = 1.0f / sqrtf(red16(ssq8(q0, q1)) * (1.0f / 128) + EPS);
            q0 = q0 * r * *(const vf4*)wnq; q1 = q1 * r * *(const vf4*)(wnq + 4);
            *(uint4*)(WSP(bf16_t, WS_NAQ) + (size_t)m * 512 + ho) = pack8(q0, q1);
            r = 1.0f / sqrtf(red16(ssq8(k0, k1)) * (1.0f / 128) + EPS);
            k0 = k0 * r * *(const vf4*)wnk; k1 = k1 * r * *(const vf4*)(wnk + 4);
            *(uint4*)(WSP(bf16_t, WS_NAK) + (size_t)m * 512 + ho) = pack8(k0, k1);
            *(uint4*)(WSP(bf16_t, WS_NAV) + (size_t)m * 512 + ho) = pack8(v0, v1);
            if (ctx) {
                const size_t o = ((((size_t)b * DEPTH + l) * 4 + rg) * CT + t) * 128 + c8;
                *(vf4*)(p.out + O_NAK + o) = k0; *(vf4*)(p.out + O_NAK + o + 4) = k1; *(vf4*)(p.out + O_NAV + o) = v0; *(vf4*)(p.out + O_NAV + o + 4) = v1;
            }
            r = 1.0f / sqrtf(red16(ssq8(g0, g1)) * (1.0f / 128) + EPS);
            g0 = g0 * r * *(const vf4*)wgq; g1 = g1 * r * *(const vf4*)(wgq + 4);
            const float rk = 1.0f / sqrtf(red16(ssq8(x0, x1)) * (1.0f / 128) + EPS);
            if (rg < 2) { x0 = x0 * rk * *(const vf4*)wgk; x1 = x1 * rk * *(const vf4*)(wgk + 4); }
            if (!ctx) {
                const int pos = sub < 8 ? (t >> 6) : (t & 63), ai = pos * 32 + (c8 & 31);
                const vf4 c0 = *(const vf4*)(ropec + ai), c1 = *(const vf4*)(ropec + ai + 4), s0 = *(const vf4*)(ropes + ai), s1 = *(const vf4*)(ropes + ai + 4);
                const bool hi = (sub & 4) != 0;
                vf4 pg0, pg1, px0, px1;
#pragma unroll
                for (int j = 0; j < 4; ++j) { pg0[j] = __shfl_xor(g0[j], 4); pg1[j] = __shfl_xor(g1[j], 4); px0[j] = __shfl_xor(x0[j], 4); px1[j] = __shfl_xor(x1[j], 4); }
                g0 = hi ? pg0 * s0 + g0 * c0 : g0 * c0 - pg0 * s0; g1 = hi ? pg1 * s1 + g1 * c1 : g1 * c1 - pg1 * s1;
                if (rg < 2) { x0 = hi ? px0 * s0 + x0 * c0 : x0 * c0 - px0 * s0; x1 = hi ? px1 * s1 + x1 * c1 : x1 * c1 - px1 * s1; }
            }
            *(uint4*)(WSP(bf16_t, WS_GQ) + (size_t)m * 512 + ho) = pack8(g0, g1);
            *(uint4*)(WSP(bf16_t, rg < 2 ? WS_GK : WS_GV) + (size_t)m * 256 + (rg & 1) * 128 + c8) = pack8(x0, x1);
            if (ctx) {
                const size_t o = ((((size_t)b * DEPTH + l) * 2 + (rg & 1)) * CT + t) * 128 + c8;
                float* dst = p.out + (rg < 2 ? O_GK : O_GV) + o;
                *(vf4*)dst = x0; *(vf4*)(dst + 4) = x1;
            }
        }
        {
#pragma unroll
            for (int dir = 0; dir < 2; ++dir) {
                const float* up = p.in[I_GUP] + ((size_t)l * 2 + dir) * 16 * 256 + 4 * lane;
                vf4 acc = *(const vf4*)(p.in[I_GBIAS] + ((size_t)l * 2 + dir) * 256 + 4 * lane);
                const bf16_t* gz = z + (dir ? Z_GB : Z_GF);
#pragma unroll
                for (int r4 = 0; r4 < 4; ++r4) {
                    const vf4 gv = ld4bf(gz + 4 * r4);
                    acc += gv.x * *(const vf4*)(up + (4 * r4 + 0) * 256) + gv.y * *(const vf4*)(up + (4 * r4 + 1) * 256) + gv.z * *(const vf4*)(up + (4 * r4 + 2) * 256) + gv.w * *(const vf4*)(up + (4 * r4 + 3) * 256);
                }
                vf4 o;
#pragma unroll
                for (int j = 0; j < 4; ++j) o[j] = logsigmoid_f(acc[j]) * (1.0f / 16.0f);
                *(vf4*)(WSP(float, dir ? WS_AB : WS_AF) + (size_t)m * 256 + 4 * lane) = o;
            }
        }
        {
#pragma unroll
            for (int part = 0; part < 3; ++part) {
                vf4 a0 = (vf4){0.f, 0.f, 0.f, 0.f}, a1 = a0;
#pragma unroll
                for (int j = 0; j < 5; ++j) {
                    const int tt = t + j - 2;
                    if (tt >= 0 && tt < T) {
                        const bf16_t* zz = Z + (size_t)(m + j - 2) * NINP + Z_DQKV + part * 512 + rg * 128 + c8;
                        const float* cj = cw + j * 1536 + part * 512;
                        vf4 z0, z1; ld8bf(zz, z0, z1);
                        a0 += *(const vf4*)cj * z0; a1 += *(const vf4*)(cj + 4) * z1;
                    }
                }
#pragma unroll
                for (int j = 0; j < 4; ++j) { a0[j] = silu_f(a0[j]); a1[j] = silu_f(a1[j]); }
                if (part < 2) { const float r = 1.0f / sqrtf(red16(ssq8(a0, a1)) + EPS) * (part == 0 ? 0.08838834764831845f : 1.0f); a0 *= r; a1 *= r; }
                *(uint4*)(WSP(bf16_t, part == 0 ? WS_DQ : part == 1 ? WS_DK : WS_DV) + (size_t)m * 512 + rg * 128 + c8) = pack8(a0, a1);
            }
            if (lane < 8) {
                const float beta = 1.0f / (1.0f + expf(-bf2f(z[Z_DB + lane])));
                const float g = -expf(p.in[I_ALOG][(size_t)l * 8 + lane]) * softplus_f(bf2f(z[Z_DA + lane]) + p.in[I_DTB][(size_t)l * 8 + lane]);
                float* ba = WSP(float, WS_DBA) + (size_t)m * 16;
                ba[lane] = beta; ba[8 + lane] = g;
            }
        }
    }
}

typedef float vf2 __attribute__((ext_vector_type(2)));
__device__ __forceinline__ float dpp_f(float v, const int ctrl) { return v; }
#define DPPF(v, ctrl) __int_as_float(__builtin_amdgcn_mov_dpp(__float_as_int(v), (ctrl), 0xF, 0xF, true))
__device__ __forceinline__ float red8(float v) { v += DPPF(v, 0xB1); v += DPPF(v, 0x4E); v += DPPF(v, 0x141); return v; }
__device__ __forceinline__ float red16(float v) { v = red8(v); v += DPPF(v, 0x140); return v; }

__device__ __forceinline__ void phase_post(const Params& p, int l) {
    const int tid = opaque_tid(), lane = tid & 63, wv = tid >> 6, rg = lane >> 4, c8 = (lane & 15) * 8;
    const bf16_t* Z = WSP(bf16_t, WS_Z); bf16_t* MRG = WSP(bf16_t, WS_MRG);
    const float* wg = p.in[I_GLAON] + (size_t)l * 128 + c8; const float* wd = p.in[I_GDNON] + (size_t)l * 128 + c8;
    for (int m = blockIdx.x * 8 + wv; m < M; m += gridDim.x * 8) {
        const bf16_t* z = Z + (size_t)m * NINP;
        const int ho = rg * 128 + c8;
#pragma unroll
        for (int g = 0; g < 2; ++g) {
            const float* of = WSP(float, g ? WS_DOF : WS_GOF) + (size_t)m * 512 + ho; const float* ob = WSP(float, g ? WS_DOB : WS_GOB) + (size_t)m * 512 + ho;
            const float* w = g ? wd : wg; const bf16_t* zg = z + (g ? Z_DZ : Z_GLR) + ho;
            vf4 a0 = *(const vf4*)of + *(const vf4*)ob, a1 = *(const vf4*)(of + 4) + *(const vf4*)(ob + 4);
            vf4 g0, g1; ld8bf(zg, g0, g1);
            const float r = 1.0f / sqrtf(red16(ssq8(a0, a1)) * (1.0f / 128) + EPS);
            a0 = a0 * r * *(const vf4*)w; a1 = a1 * r * *(const vf4*)(w + 4);
#pragma unroll
            for (int j = 0; j < 4; ++j) { a0[j] *= silu_f(g0[j]); a1[j] *= silu_f(g1[j]); }
            *(uint4*)(MRG + (size_t)m * DM + (g ? 1536 : 512) + ho) = pack8(a0, a1);
        }
    }
}
#define XB_TMO      128
#define XB_XCNT(j)  (256  + 64 * (j))
#define XB_XSUB(j)  (1280 + 64 * (j))
#define XB_XGEN(j)  (2304 + 64 * (j))
#define XB_TOP      3328
#define XB_TOPGEN   3392
#define XCD_BAR_WORDS 3456
#define XB_SPIN_CAP (1u << 22)
#define LAS __attribute__((address_space(3)))

__device__ __forceinline__ unsigned xb_ld(unsigned* p)              { return __hip_atomic_load(p, __ATOMIC_RELAXED, __HIP_MEMORY_SCOPE_AGENT); }
__device__ __forceinline__ unsigned xb_add(unsigned* p, unsigned v) { return __hip_atomic_fetch_add(p, v, __ATOMIC_RELAXED, __HIP_MEMORY_SCOPE_AGENT); }
__device__ __forceinline__ unsigned xb_xcc_id() { return (unsigned)__builtin_amdgcn_s_getreg((3 << 11) | 20) & 0xFu; }
#define XB_SPIN(cond, bar) do { unsigned _sp = 0; while (cond) { __builtin_amdgcn_s_sleep(1); \
    if ((++_sp & 255u) == 0u) { if (xb_ld(&(bar)[XB_TMO])) break; if (_sp > XB_SPIN_CAP) { atomicAdd(&(bar)[XB_TMO], 1u); break; } } } } while (0)

struct XcdBarrier {
    unsigned* bar; unsigned x;
    volatile LAS unsigned* st;
};

__device__ __forceinline__ XcdBarrier xcd_barrier_post(unsigned* bar, volatile LAS unsigned* st) {
    XcdBarrier b; b.bar = bar; b.x = xb_xcc_id(); b.st = st;
    if (threadIdx.x == 0) (void)xb_add(&bar[XB_XCNT(b.x)], 1u);
    return b;
}
__device__ __forceinline__ void xcd_barrier_complete(unsigned* bar, unsigned x, unsigned& nloc, unsigned& nx) {
    const unsigned G = gridDim.x * gridDim.y * gridDim.z;
    unsigned sum, cnt, mine, sp = 0u;
    for (;;) {
        sum = 0u; cnt = 0u; mine = 0u;
#pragma unroll
        for (unsigned j = 0; j < 16; ++j) { const unsigned c = xb_ld(&bar[XB_XCNT(j)]); sum += c; cnt += (c > 0u) ? 1u : 0u; mine = (j == x) ? c : mine; }
        if (sum == G) break;
        __builtin_amdgcn_s_sleep(1);
        if ((++sp & 255u) == 0u) { if (xb_ld(&bar[XB_TMO])) break; if (sp > XB_SPIN_CAP) { atomicAdd(&bar[XB_TMO], 1u); break; } }
    }
    nloc = mine > 0u ? mine : 1u; nx = cnt > 0u ? cnt : 1u;
}

__device__ __forceinline__ void xcd_barrier(const XcdBarrier& b) {
    asm volatile("s_waitcnt vmcnt(0)" ::: "memory");
    __syncthreads();
    if (threadIdx.x == 0) {
        unsigned* bar = b.bar;
        __builtin_amdgcn_s_waitcnt(0);
        unsigned nloc = b.st[0], nx = b.st[1];
        if (nloc == 0u) { xcd_barrier_complete(bar, b.x, nloc, nx); b.st[0] = nloc; b.st[1] = nx; }
        const unsigned old = xb_add(&bar[XB_XSUB(b.x)], 1u);
        const unsigned gen = old / nloc;
        if (old + 1u == (gen + 1u) * nloc) {
            __builtin_amdgcn_fence(__ATOMIC_RELEASE, "agent");
            asm volatile("s_waitcnt vmcnt(0)" ::: "memory");
            const unsigned og = xb_add(&bar[XB_TOP], 1u);
            const unsigned tg = og / nx;
            if (og + 1u == (tg + 1u) * nx) xb_add(&bar[XB_TOPGEN], 1u);
            else XB_SPIN(xb_ld(&bar[XB_TOPGEN]) == tg, bar);
            __builtin_amdgcn_fence(__ATOMIC_ACQUIRE, "agent");
            xb_add(&bar[XB_XGEN(b.x)], 1u);
            asm volatile("s_waitcnt vmcnt(0)" ::: "memory");
        } else {
            XB_SPIN(xb_ld(&bar[XB_XGEN(b.x)]) == gen, bar);
            __builtin_amdgcn_fence(__ATOMIC_ACQUIRE, "agent");
            asm volatile("s_waitcnt vmcnt(0)" ::: "memory");
        }
    }
    __syncthreads();
}

namespace pg8 {
#define PG8_LAS __attribute__((address_space(3)))
typedef unsigned short bf16_t;
typedef short bf16x8 __attribute__((ext_vector_type(8)));
typedef float f32x4 __attribute__((ext_vector_type(4)));
typedef unsigned u32x4 __attribute__((ext_vector_type(4)));
constexpr int BM = 256, BK = 64, HALF = 128, HTB = HALF * BK * 2  , STAGE_BYTES = 8 * HTB, NXCD = 8, WGM = 8;

__host__ __device__ __forceinline__ int lds_byte(int r, int c) { const int st = (r >> 4) * 2 + (c >> 5), rr = r & 15, cc = c & 31, ob = rr * 64 + cc * 2; return st * 1024 + (ob ^ (((ob >> 9) & 1) << 5)); }
__host__ __device__ __forceinline__ void stage_rc(int b, int& R, int& C) { const int st = b / 1024, sb = b % 1024, swz = sb ^ (((sb >> 9) & 1) << 5); R = (st >> 1) * 16 + swz / 64; C = (st & 1) * 32 + (swz % 64) / 2; }
__host__ __device__ __forceinline__ int perm32(int rho) { const int n = rho >> 4, i = rho & 15; return 8 * (i >> 2) + 4 * n + (i & 3); }

struct Unit { int pm, pn, k0, nt, at, slot, msk; };
struct Gemm { const bf16_t* A; const bf16_t* Bt; int M, N, K; };

struct StaticOrder {
    int nM, nN, nwg, G, c, ntk, split, msplit;
    __host__ __device__ void init(int M, int N, int K, int G_, int c_, int split_ = 0) { nM = M / BM; nN = N / BM; nwg = nM * nN; G = G_; c = c_; ntk = K / BK; const int rem = nwg % G_; split = (split_ == 1 && rem > 0 && 2 * rem == G_ && ntk >= 8) ? 1 : 0; msplit = (split_ == 2 && rem > 0 && 2 * rem <= G_) ? 1 : 0; }
    __host__ __device__ bool next(int i, Unit& u) const {
        long L = (long)i * G + c; u.k0 = 0; u.nt = ntk; u.at = 0; u.slot = 0; u.msk = 3;
        if (msplit && i == nwg / G) { const int rem = nwg % G; if (c >= 2 * rem) return false; L = (long)i * G + (c % rem); u.msk = (c / rem) ? 2 : 1; }
        if (split && i == nwg / G) { const int rem = nwg % G, sl = c / rem, h0 = ((ntk / 2) + 1) & ~1; L = (long)i * G + (c % rem); u.k0 = sl ? h0 * BK : 0; u.nt = sl ? ntk - h0 : h0; u.at = sl ? 1 : 2; u.slot = c % rem; }
        if (L >= nwg) return false;
        int wgid = (int)L; { const int q = nwg / NXCD, r = nwg % NXCD, xcd = wgid % NXCD, off = wgid / NXCD; wgid = (xcd < r ? xcd * (q + 1) : r * (q + 1) + (xcd - r) * q) + off; }
        const int nig = WGM * nN, gid = wgid / nig, fm = gid * WGM, gsz = (nM - fm) < WGM ? (nM - fm) : WGM;
        u.pm = fm + ((wgid % nig) % gsz); u.pn = (wgid % nig) / gsz; return true;
    }
    __device__ __forceinline__ void a_ready(const Unit&) const {}
    __device__ __forceinline__ void done(const Unit&) const {}
};
__device__ __forceinline__ unsigned cvt_pk_bf16(float lo, float hi) { unsigned r; asm volatile("v_cvt_pk_bf16_f32 %0, %1, %2" : "=v"(r) : "v"(lo), "v"(hi)); return r; }
struct EpiF32 {
    static constexpr bool PERM = false, AFTER_DRAIN = false;
    float* C; int ldc; const float* bias;
    __device__ __forceinline__ void operator()(const f32x4 (&acc)[2][2][4][2], const Unit& u, int wr, int wc, int fr, int fq) const {
        const int row0 = u.pm * BM + wr * 64 + fr, col0 = u.pn * BM + wc * 32 + 4 * fq;
        f32x4 bv[2][2];
#pragma unroll
        for (int bj = 0; bj < 2; ++bj)
#pragma unroll
            for (int n = 0; n < 2; ++n) bv[bj][n] = bias ? *(const f32x4*)(bias + col0 + bj * HALF + n * 16) : (f32x4){0.f, 0.f, 0.f, 0.f};
#pragma unroll
        for (int ai = 0; ai < 2; ++ai)
#pragma unroll
            for (int m = 0; m < 4; ++m) { float* rowp = C + (size_t)(row0 + ai * HALF + m * 16) * ldc + col0;
#pragma unroll
                for (int bj = 0; bj < 2; ++bj)
#pragma unroll
                    for (int n = 0; n < 2; ++n) *(f32x4*)(rowp + bj * HALF + n * 16) = acc[ai][bj][m][n] + bv[bj][n]; }
    }
};

struct EpiSwiGLU {
    static constexpr bool PERM = true, AFTER_DRAIN = false;
    bf16_t* O; int ldc;
    __device__ __forceinline__ void operator()(const f32x4 (&acc)[2][2][4][2], const Unit& u, int wr, int wc, int fr, int fq) const {
        const int row0 = u.pm * BM + wr * 64 + fr, col0 = u.pn * 128 + wc * 32 + 8 * fq;
#pragma unroll
        for (int ai = 0; ai < 2; ++ai) if ((u.msk >> ai) & 1)
#pragma unroll
            for (int m = 0; m < 4; ++m) { bf16_t* rowp = O + (size_t)(row0 + ai * HALF + m * 16) * ldc + col0;
                const f32x4 g0 = acc[ai][0][m][0], g1 = acc[ai][0][m][1], u0 = acc[ai][1][m][0], u1 = acc[ai][1][m][1];
                float r[8];
#pragma unroll
                for (int j = 0; j < 4; ++j) {
                    r[j]     = g0[j] * __builtin_amdgcn_rcpf(1.0f + __builtin_amdgcn_exp2f(-1.4426950408889634f * g0[j])) * u0[j];
                    r[4 + j] = g1[j] * __builtin_amdgcn_rcpf(1.0f + __builtin_amdgcn_exp2f(-1.4426950408889634f * g1[j])) * u1[j]; }
                u32x4 w; w.x = cvt_pk_bf16(r[0], r[1]); w.y = cvt_pk_bf16(r[2], r[3]); w.z = cvt_pk_bf16(r[4], r[5]); w.w = cvt_pk_bf16(r[6], r[7]);
                *(u32x4*)rowp = w; }
    }
};
struct EpiBf16Plain {
    static constexpr bool PERM = true, AFTER_DRAIN = false;
    bf16_t* O; int ldc;
    __device__ __forceinline__ void operator()(const f32x4 (&acc)[2][2][4][2], const Unit& u, int wr, int wc, int fr, int fq) const {
        const int row0 = u.pm * BM + wr * 64 + fr, col0 = u.pn * BM + wc * 32 + 8 * fq;
#pragma unroll
        for (int ai = 0; ai < 2; ++ai) if ((u.msk >> ai) & 1)
#pragma unroll
            for (int m = 0; m < 4; ++m) { bf16_t* rowp = O + (size_t)(row0 + ai * HALF + m * 16) * ldc + col0;
#pragma unroll
                for (int bj = 0; bj < 2; ++bj) { const f32x4 v0 = acc[ai][bj][m][0], v1 = acc[ai][bj][m][1];
                    u32x4 w; w.x = cvt_pk_bf16(v0[0], v0[1]); w.y = cvt_pk_bf16(v0[2], v0[3]); w.z = cvt_pk_bf16(v1[0], v1[1]); w.w = cvt_pk_bf16(v1[2], v1[3]);
                    *(u32x4*)(rowp + bj * HALF) = w; } }
    }
};
struct EpiResid {
    static constexpr bool PERM = false, AFTER_DRAIN = false;
    const float* res; float* out; int ldc; const float* gate0; float coef;
    float* slab; unsigned* flags; unsigned target;
    const float* res_hi; int row_hi;
    __device__ __forceinline__ void operator()(const f32x4 (&acc)[2][2][4][2], const Unit& u, int wr, int wc, int fr, int fq) const {
        const int tidx = ((wr * 4 + wc) * 4 + fq) * 16 + fr;
        if (u.at == 1) {
            const __amdgpu_buffer_rsrc_t rs = __builtin_amdgcn_make_buffer_rsrc((void*)slab, 0, 0x7FFFFFF0, 0x00020000);
            const unsigned base = ((unsigned)u.slot * 32u * 512u + (unsigned)tidx) * 16u;
#pragma unroll
            for (int ai = 0; ai < 2; ++ai)
#pragma unroll
                for (int bj = 0; bj < 2; ++bj)
#pragma unroll
                    for (int m = 0; m < 4; ++m)
#pragma unroll
                        for (int n = 0; n < 2; ++n) { const f32x4 v = acc[ai][bj][m][n]; u32x4 w; w.x = __float_as_uint(v[0]); w.y = __float_as_uint(v[1]); w.z = __float_as_uint(v[2]); w.w = __float_as_uint(v[3]);
                            __builtin_amdgcn_raw_buffer_store_b128(w, rs, base + (unsigned)((((ai * 2 + bj) * 4 + m) * 2 + n) * 512 * 16), 0, 16); }
            asm volatile("s_waitcnt vmcnt(0)" ::: "memory");
            if ((tidx & 63) == 0) __hip_atomic_fetch_add(flags + 64 * u.slot, 1u, __ATOMIC_RELAXED, __HIP_MEMORY_SCOPE_AGENT);
            return;
        }
        const float* part = nullptr;
        if (u.at == 2) {
            unsigned spins = 0;
            while (__hip_atomic_load(flags + 64 * u.slot, __ATOMIC_RELAXED, __HIP_MEMORY_SCOPE_AGENT) < target) { __builtin_amdgcn_s_sleep(2); if (++spins > (1u << 22)) break; }
            __builtin_amdgcn_fence(__ATOMIC_ACQUIRE, "agent");
            asm volatile("s_waitcnt vmcnt(0)" ::: "memory");
            part = slab + ((size_t)u.slot * 32 * 512 + tidx) * 4;
        }
        const int row0 = u.pm * BM + wr * 64 + fr, col0 = u.pn * BM + wc * 32 + 4 * fq;
        const float* gate = gate0 + (size_t)cond_of_row(u.pm * BM) * NMOD;
        const float* rbase = (u.pm * BM >= row_hi) ? res_hi - (size_t)row_hi * ldc : res;
        f32x4 gv[2][2];
#pragma unroll
        for (int bj = 0; bj < 2; ++bj)
#pragma unroll
            for (int n = 0; n < 2; ++n) gv[bj][n] = *(const f32x4*)(gate + col0 + bj * HALF + n * 16) * coef;
#pragma unroll
        for (int ai = 0; ai < 2; ++ai) if ((u.msk >> ai) & 1)
#pragma unroll
            for (int m = 0; m < 4; ++m) { const size_t off = (size_t)(row0 + ai * HALF + m * 16) * ldc + col0;
#pragma unroll
                for (int bj = 0; bj < 2; ++bj)
#pragma unroll
                    for (int n = 0; n < 2; ++n) {
                        f32x4 a = acc[ai][bj][m][n];
                        if (part) a += *(const f32x4*)(part + (size_t)((((ai * 2 + bj) * 4 + m) * 2 + n) * 512 * 4));
                        const f32x4 bs = *(const f32x4*)(rbase + off + bj * HALF + n * 16); *(f32x4*)(out + off + bj * HALF + n * 16) = bs + gv[bj][n] * a; }
                asm volatile("" ::: "memory"); }
    }
};
template <class Epi, class Sched, bool STAMP = false>
__device__ __forceinline__ void gemm_phase(PG8_LAS unsigned char* lds, const Gemm g, const Sched& S, const Epi& E, unsigned long long* stamps) {
    const int tid = opaque_tid(), wid = __builtin_amdgcn_readfirstlane(tid >> 6), lane = tid & 63, wr = wid >> 2, wc = wid & 3, fr = lane & 15, fq = lane >> 4;
    const int K = g.K;
    int ts_lo = 0, ts_hi = 0, nts = 0; const unsigned long long rt_entry = STAMP ? (unsigned long long)wall_clock64() : 0ull;
#define PG8_STAMP() do { if (STAMP && wid == 0 && nts < 64) { const unsigned long long _c = (unsigned long long)clock64(); \
        ts_lo = (lane == nts) ? (int)(unsigned)_c : ts_lo; ts_hi = (lane == nts) ? (int)(unsigned)(_c >> 32) : ts_hi; ++nts; } } while (0)
    PG8_STAMP();
    unsigned voffA[2], voffB[2];
#pragma unroll
    for (int i = 0; i < 2; ++i) { int R, C; stage_rc(tid * 16 + i * 8192, R, C); const int Rb = Epi::PERM ? ((R & ~31) + perm32(R & 31)) : R;
        voffA[i] = (unsigned)(R * K + C) * 2u; voffB[i] = (unsigned)(Rb * K + C) * 2u; }
    const size_t kstep = (size_t)(BK * 2);
    const size_t hstep = (size_t)HALF * K * 2;
    const size_t tstep = 2 * hstep;
    const unsigned ldsw = (unsigned)wid * 1024u;
    const int aoff = lds_byte(wr * 64 + fr, fq * 8), boff = lds_byte(wc * 32 + fr, fq * 8);
#define PG8_SA(b, h) (((b) * 2 + (h)) * HTB)
#define PG8_SB(b, h) ((4 + (b) * 2 + (h)) * HTB)
#define PG8_STAGE(bufoff, gbase, voff) do { _Pragma("unroll") for (int _i = 0; _i < 2; ++_i) \
        __builtin_amdgcn_global_load_lds((const unsigned*)((const char*)(gbase) + (voff)[_i]), (PG8_LAS unsigned*)(lds + (bufoff) + ldsw + _i * 8192), 16, 0, 0); } while (0)
#define PG8_LDA(dst, b, h) do { _Pragma("unroll") for (int m = 0; m < 4; ++m) _Pragma("unroll") for (int k = 0; k < 2; ++k) dst[m][k] = *(const PG8_LAS bf16x8*)(lds + PG8_SA(b, h) + aoff + m * 2048 + k * 1024); } while (0)
#define PG8_LDB(dst, b, h) do { _Pragma("unroll") for (int n = 0; n < 2; ++n) _Pragma("unroll") for (int k = 0; k < 2; ++k) dst[n][k] = *(const PG8_LAS bf16x8*)(lds + PG8_SB(b, h) + boff + n * 2048 + k * 1024); } while (0)
#define PG8_MMA(ai, bj, At, Bt) do { __builtin_amdgcn_s_setprio(1); _Pragma("unroll") for (int m = 0; m < 4; ++m) _Pragma("unroll") for (int n = 0; n < 2; ++n) _Pragma("unroll") for (int k = 0; k < 2; ++k) \
        acc[ai][bj][m][n] = __builtin_amdgcn_mfma_f32_16x16x32_bf16(Bt[n][k], At[m][k], acc[ai][bj][m][n], 0, 0, 0); __builtin_amdgcn_s_setprio(0); } while (0)
#define PG8_MMAG(ai, bj, At, Bt) do { if (mrow & (1 << (ai))) PG8_MMA(ai, bj, At, Bt); } while (0)
#define PG8_WAIT_V(n) asm volatile("s_waitcnt vmcnt(" #n ")" ::: "memory")
#define PG8_WAIT_L(n) asm volatile("s_waitcnt lgkmcnt(" #n ")" ::: "memory")
#define PG8_BAR __builtin_amdgcn_s_barrier()
#define PG8_SCHED __builtin_amdgcn_sched_barrier(0)
    Unit cur, nxt; int ui = 0;
    if (!S.next(0, cur)) return;
    f32x4 acc[2][2][4][2];
#pragma unroll
    for (int a = 0; a < 2; ++a)
#pragma unroll
        for (int b = 0; b < 2; ++b)
#pragma unroll
            for (int m = 0; m < 4; ++m)
#pragma unroll
                for (int n = 0; n < 2; ++n) acc[a][b][m][n] = (f32x4){0.f, 0.f, 0.f, 0.f};
    bf16x8 At[4][2], B0[2][2], B1[2][2];
    const char* cA = (const char*)g.A + (size_t)cur.pm * tstep + (size_t)cur.k0 * 2; const char* cB = (const char*)g.Bt + (size_t)cur.pn * tstep + (size_t)cur.k0 * 2;
    S.a_ready(cur);
    PG8_STAGE(PG8_SB(0, 0), cB, voffB); PG8_STAGE(PG8_SA(0, 0), cA, voffA); PG8_STAGE(PG8_SB(0, 1), cB + hstep, voffB); PG8_STAGE(PG8_SA(0, 1), cA + hstep, voffA);
    if (wr == 1) PG8_BAR;
    PG8_WAIT_V(4); PG8_BAR;
    PG8_STAGE(PG8_SB(1, 0), cB + kstep, voffB); PG8_STAGE(PG8_SA(1, 0), cA + kstep, voffA); PG8_STAGE(PG8_SB(1, 1), cB + hstep + kstep, voffB);
    PG8_WAIT_V(6); PG8_BAR;
    PG8_STAMP();
    for (;;) {
        const bool has_next = S.next(ui + 1, nxt);
        const char* nA = has_next ? (const char*)g.A + (size_t)nxt.pm * tstep + (size_t)nxt.k0 * 2 : cA; const char* nB = has_next ? (const char*)g.Bt + (size_t)nxt.pn * tstep + (size_t)nxt.k0 * 2 : cB;
        const int nt = cur.nt, mrow = cur.msk;
        for (int t = 0; t < nt; t += 2) {
            const bool last = (t == nt - 2);
            const char* a1 = cA + (size_t)(t + 1) * kstep;
            const char* a2 = last ? nA : cA + (size_t)(t + 2) * kstep; const char* b2 = last ? nB : cB + (size_t)(t + 2) * kstep;
            const char* a3 = a2 + kstep; const char* b3 = b2 + kstep;
            if (last && has_next) S.a_ready(nxt);
            PG8_LDB(B0, 0, 0); PG8_SCHED; PG8_LDA(At, 0, 0); PG8_STAGE(PG8_SA(1, 1), a1 + hstep, voffA);
            PG8_WAIT_L(8); PG8_BAR; PG8_WAIT_L(0); PG8_MMAG(0, 0, At, B0); PG8_BAR; PG8_SCHED;
            PG8_LDB(B1, 0, 1); PG8_STAGE(PG8_SB(0, 0), b2, voffB);
            PG8_BAR; PG8_WAIT_L(0); PG8_MMAG(0, 1, At, B1); PG8_BAR;
            PG8_LDA(At, 0, 1); PG8_STAGE(PG8_SA(0, 0), a2, voffA);
            PG8_BAR; PG8_WAIT_L(0); PG8_MMAG(1, 0, At, B0); PG8_BAR; PG8_SCHED;
            PG8_STAGE(PG8_SB(0, 1), b2 + hstep, voffB);
            PG8_WAIT_V(6); PG8_BAR; PG8_MMAG(1, 1, At, B1); PG8_BAR;
            PG8_LDB(B0, 1, 0); PG8_SCHED; PG8_LDA(At, 1, 0); PG8_STAGE(PG8_SA(0, 1), a2 + hstep, voffA);
            PG8_WAIT_L(8); PG8_BAR; PG8_WAIT_L(0); PG8_MMAG(0, 0, At, B0); PG8_BAR; PG8_SCHED;
            PG8_LDB(B1, 1, 1); PG8_STAGE(PG8_SB(1, 0), b3, voffB);
            PG8_BAR; PG8_WAIT_L(0); PG8_MMAG(0, 1, At, B1); PG8_BAR;
            PG8_LDA(At, 1, 1); PG8_STAGE(PG8_SA(1, 0), a3, voffA);
            PG8_BAR; PG8_WAIT_L(0); PG8_MMAG(1, 0, At, B0); PG8_BAR; PG8_SCHED;
            PG8_STAGE(PG8_SB(1, 1), b3 + hstep, voffB);
            PG8_WAIT_V(6); PG8_BAR; PG8_MMAG(1, 1, At, B1); PG8_BAR;
        }
        PG8_STAMP();
        if constexpr (!Epi::AFTER_DRAIN) { E(acc, cur, wr, wc, fr, fq); S.done(cur); }
        PG8_STAMP();
        if (!has_next) break;
#pragma unroll
        for (int a = 0; a < 2; ++a)
#pragma unroll
            for (int b = 0; b < 2; ++b)
#pragma unroll
                for (int m = 0; m < 4; ++m)
#pragma unroll
                    for (int n = 0; n < 2; ++n) acc[a][b][m][n] = (f32x4){0.f, 0.f, 0.f, 0.f};
        cur = nxt; cA = nA; cB = nB; ++ui;
    }
    PG8_WAIT_V(0);
    if (wr == 0) PG8_BAR;
    PG8_BAR;
    if constexpr (Epi::AFTER_DRAIN) { E.fused(acc, cur, wr, wc, fr, fq, lds, wid, lane); S.done(cur); }
    PG8_STAMP();
    if (STAMP && wid == 0) { stamps[lane] = lane < nts ? (((unsigned long long)(unsigned)ts_hi << 32) | (unsigned)ts_lo) : 0ull;
        if (lane == 62) stamps[62] = rt_entry; if (lane == 63) stamps[63] = (unsigned long long)wall_clock64(); }
#undef PG8_STAMP
#undef PG8_SA
#undef PG8_SB
#undef PG8_STAGE
#undef PG8_LDA
#undef PG8_LDB
#undef PG8_MMA
#undef PG8_MMAG
#undef PG8_WAIT_V
#undef PG8_WAIT_L
#undef PG8_BAR
#undef PG8_SCHED
}
}
#ifndef ATT_INLINE
#define ATT_INLINE __forceinline__
#endif
namespace att {
constexpr int D = 128, NW = 8, QBLK = 32, KVBLK = 64, LDQ = 512, LDO = DM;
constexpr float SCALE = 0.088388347648318440f;
constexpr float THR = 8.f;
constexpr size_t SHM_V = KVBLK * D * 2, SHM_K = KVBLK * D * 2, SHM_Q = 256 * D * 2, SHM_ATTN = 2 * SHM_V + 2 * SHM_K + NW * 64 * 4 + SHM_Q;
using bf16x8 = __attribute__((ext_vector_type(8))) short;
using s16x4  = __attribute__((ext_vector_type(4))) short;
using f32x16 = __attribute__((ext_vector_type(16))) float;
using u32x4  = __attribute__((ext_vector_type(4))) unsigned;
#define KSWZ(row, colB) ((row) * 256 + ((colB) ^ (((row) & 7) << 4)))
#define SBAR() __builtin_amdgcn_sched_barrier(0)
__device__ __forceinline__ int crow(int r, int hi) { return (r & 3) + 8 * (r >> 2) + 4 * hi; }
__device__ __forceinline__ unsigned cvtpk(float lo, float hi) { unsigned r; asm volatile("v_cvt_pk_bf16_f32 %0, %1, %2" : "=v"(r) : "v"(lo), "v"(hi)); return r; }

__device__ __forceinline__ void partialSM(f32x16& p0, f32x16& p1, float& m_reg, float& mn, float& alpha) {
  constexpr float C = SCALE * 1.4426950408889634f;
  float pmax = p0[0]; for (int r = 1; r < 16; ++r) pmax = fmaxf(pmax, p0[r]); for (int r = 0; r < 16; ++r) pmax = fmaxf(pmax, p1[r]);
  { auto rr = __builtin_amdgcn_permlane32_swap(__float_as_uint(pmax), __float_as_uint(pmax), false, false);
    pmax = fmaxf(__uint_as_float(rr[0]), __uint_as_float(rr[1])); }
  if (__builtin_expect(__all(pmax - m_reg <= THR / SCALE), 1)) { mn = m_reg; alpha = 1.f; }
  else { mn = fmaxf(m_reg, pmax); alpha = __builtin_amdgcn_exp2f((m_reg - mn) * C); m_reg = mn; }
  float mnC = -mn * C;
  for (int r = 0; r < 16; ++r) p0[r] = fmaf(p0[r], C, mnC); for (int r = 0; r < 16; ++r) p1[r] = fmaf(p1[r], C, mnC);
  for (int r = 0; r < 16; ++r) p0[r] = __builtin_amdgcn_exp2f(p0[r]);
}
__device__ __forceinline__ void finishSM(f32x16& p0, f32x16& p1, float alpha, float& l_reg, bf16x8& pa0, bf16x8& pa1, bf16x8& pa2, bf16x8& pa3) {
  for (int r = 0; r < 16; ++r) p1[r] = __builtin_amdgcn_exp2f(p1[r]);
  float ps = 0; for (int r = 0; r < 16; ++r) ps += p0[r]; for (int r = 0; r < 16; ++r) ps += p1[r];
  { auto rr = __builtin_amdgcn_permlane32_swap(__float_as_uint(ps), __float_as_uint(ps), false, false);
    ps = __uint_as_float(rr[0]) + __uint_as_float(rr[1]); }
  l_reg = l_reg * alpha + ps;
#define PK4(P, BASE, OUT) do { unsigned a0 = cvtpk(P[BASE + 0], P[BASE + 1]), a1 = cvtpk(P[BASE + 2], P[BASE + 3]);   \
    unsigned b0 = cvtpk(P[BASE + 4], P[BASE + 5]), b1 = cvtpk(P[BASE + 6], P[BASE + 7]);                              \
    auto r0 = __builtin_amdgcn_permlane32_swap(a0, b0, false, false); auto r1 = __builtin_amdgcn_permlane32_swap(a1, b1, false, false); \
    u32x4 w = {r0[0], r1[0], r0[1], r1[1]}; OUT = *reinterpret_cast<bf16x8*>(&w); } while (0)
  PK4(p0, 0, pa0); PK4(p0, 8, pa1); PK4(p1, 0, pa2); PK4(p1, 8, pa3);
#undef PK4
}
__device__ __forceinline__ void qkt(f32x16& p0, f32x16& p1, const bf16_t* Ks, const bf16_t* Qs, int qrow, int r32, int hi) {
  p0 = f32x16{}; p1 = f32x16{};
#pragma unroll
  for (int d0 = 0; d0 < 8; ++d0) { int cb = (d0 * 16 + hi * 8) * 2;
    bf16x8 q = *reinterpret_cast<const bf16x8*>((const char*)Qs + KSWZ(qrow, cb));
    bf16x8 b0 = *reinterpret_cast<const bf16x8*>((const char*)Ks + KSWZ(r32, cb));
    bf16x8 b1 = *reinterpret_cast<const bf16x8*>((const char*)Ks + KSWZ(32 + r32, cb));
    p0 = __builtin_amdgcn_mfma_f32_32x32x16_bf16(b0, q, p0, 0, 0, 0);
    p1 = __builtin_amdgcn_mfma_f32_32x32x16_bf16(b1, q, p1, 0, 0, 0); }
}
__device__ __forceinline__ int v_st(int k, int c) { const int kk = (k & ~0xC) | ((k & 4) << 1) | ((k & 8) >> 1); return ((kk >> 3) * 4 + (c >> 5)) * 512 + ((kk & 7) * 32 + (c & 31)) * 2; }
__device__ __forceinline__ int v_rd_base(int lane) { return ((lane & 3) << 3) | (((lane >> 2) & 3) << 6) | (((lane >> 4) & 1) << 5) | (((lane >> 5) & 1) << 8); }
constexpr int v_rd_off(int d0, int ks, int half) { return d0 * 512 + ks * 4096 + half * 2048; }
template <int OFF> __device__ __forceinline__ s16x4 tr_read(int vb) {
  s16x4 r; asm volatile("ds_read_b64_tr_b16 %0, %1 offset:%2" : "=&v"(r) : "v"(vb), "i"(OFF) : "memory"); return r;
}
template <int D0> __device__ __forceinline__ void pv_one(f32x16& od, int vb, bf16x8 pa0, bf16x8 pa1, bf16x8 pa2, bf16x8 pa3) {
  const s16x4 l0 = tr_read<v_rd_off(D0, 0, 0)>(vb), h0 = tr_read<v_rd_off(D0, 0, 1)>(vb), l1 = tr_read<v_rd_off(D0, 1, 0)>(vb), h1 = tr_read<v_rd_off(D0, 1, 1)>(vb);
  const s16x4 l2 = tr_read<v_rd_off(D0, 2, 0)>(vb), h2 = tr_read<v_rd_off(D0, 2, 1)>(vb), l3 = tr_read<v_rd_off(D0, 3, 0)>(vb), h3 = tr_read<v_rd_off(D0, 3, 1)>(vb);
  asm volatile("s_waitcnt lgkmcnt(0)" ::: "memory"); SBAR();
#define PK(L, H) (bf16x8){L[0], L[1], L[2], L[3], H[0], H[1], H[2], H[3]}
  od = __builtin_amdgcn_mfma_f32_32x32x16_bf16(pa0, PK(l0, h0), od, 0, 0, 0);
  od = __builtin_amdgcn_mfma_f32_32x32x16_bf16(pa1, PK(l1, h1), od, 0, 0, 0);
  od = __builtin_amdgcn_mfma_f32_32x32x16_bf16(pa2, PK(l2, h2), od, 0, 0, 0);
  od = __builtin_amdgcn_mfma_f32_32x32x16_bf16(pa3, PK(l3, h3), od, 0, 0, 0);
#undef PK
}
__device__ __forceinline__ void pv_d0(f32x16* o, int vb, bf16x8 pa0, bf16x8 pa1, bf16x8 pa2, bf16x8 pa3) {
  pv_one<0>(o[0], vb, pa0, pa1, pa2, pa3); pv_one<1>(o[1], vb, pa0, pa1, pa2, pa3); pv_one<2>(o[2], vb, pa0, pa1, pa2, pa3); pv_one<3>(o[3], vb, pa0, pa1, pa2, pa3);
}

struct SrcOne { const bf16_t* k0; const bf16_t* v0; int ldk;
  __device__ __forceinline__ const bf16_t* k(int j) const { return k0 + (size_t)j * 64 * ldk; }
  __device__ __forceinline__ const bf16_t* v(int j) const { return v0 + (size_t)j * 64 * ldk; } };
struct SrcTwo { const bf16_t* ck; const bf16_t* cv; const bf16_t* k1; const bf16_t* v1; int ldk;
  __device__ __forceinline__ const bf16_t* k(int j) const { return j < 4 ? ck + (size_t)j * 64 * ldk : k1 + (size_t)(j - 4) * 64 * ldk; }
  __device__ __forceinline__ const bf16_t* v(int j) const { return j < 4 ? cv + (size_t)j * 64 * ldk : v1 + (size_t)(j - 4) * 64 * ldk; } };
struct NoBias { __device__ __forceinline__ void operator()(f32x16&, f32x16&, int, int, int, int) const {} };
struct NaBias { const float* tab; int i0, kr0;
  __device__ __forceinline__ void operator()(f32x16& p0, f32x16& p1, int jt, int wid, int r32, int hi) const {
    if (jt < 4) return;
    const int qi = i0 + wid * QBLK + r32, r = qi >> 6, qc = qi & 63, kr = kr0 + jt - 4;
    int lo = r - 4; lo = lo < 0 ? 0 : (lo > 8 ? 8 : lo);
    const bool rowok = (kr >= lo) && (kr < lo + 8);
    if (!rowok) {
#pragma unroll
      for (int rr = 0; rr < 16; ++rr) { p0[rr] = -1e30f; p1[rr] = -1e30f; }
      return;
    }
    int c0 = qc - 8; c0 = c0 < 0 ? 0 : (c0 > 48 ? 48 : c0);
    const int dr = kr - r + 7;
    const float* tb = tab + dr * 31 + (4 * hi - qc + 15);
    const int w0 = 4 * hi - c0;
#pragma unroll
    for (int g = 0; g < 4; ++g) {
#pragma unroll
      for (int q = 0; q < 4; ++q) {
        const int rr = 4 * g + q, kc0 = q + 8 * g;
        const float t0 = tb[kc0], t1 = tb[kc0 + 32];
        p0[rr] = ((unsigned)(kc0 + w0) < 16u) ? p0[rr] + t0 : -1e30f;
        p1[rr] = ((unsigned)(kc0 + 32 + w0) < 16u) ? p1[rr] + t1 : -1e30f;
      }
      SBAR();
    }
  } };

template <int SD, class Src, class Bias>
__device__ ATT_INLINE void attn_body(const bf16_t* __restrict__ Qb, const Src src, bf16_t* __restrict__ Ob, const int NT, char* lds, const Bias bias) {
  const int tid = opaque_tid(), wid = tid >> 6, lane = tid & 63, r32 = lane & 31, hi = lane >> 5;
  const int LDK = src.ldk;
  bf16_t* V_lds = (bf16_t*)lds; bf16_t* K_lds = (bf16_t*)(lds + 2 * SHM_V);
  float* ws = (float*)(lds + 2 * SHM_V + 2 * SHM_K) + wid * 64; float* li_l = ws; float* al_l = ws + 32;
  float m_reg = -1e30f, l_reg = 0; f32x16 o[4] = {};
  bf16_t* Q_lds = (bf16_t*)(lds + 2 * SHM_V + 2 * SHM_K + NW * 64 * 4);
  const int qrow = wid * QBLK + r32;
  {
#pragma unroll
    for (int i = 0; i < 8; ++i) { const int f = tid + 512 * i, row = f >> 4, c8 = (f & 15) * 8;
      *(bf16x8*)((char*)Q_lds + KSWZ(row, c8 * 2)) = *reinterpret_cast<const bf16x8*>(Qb + (long)row * LDQ + c8); }
  }
  const int sr = tid >> 4, sc = (tid & 15) * 8, vst0 = v_st(sr, sc), vst1 = v_st(32 + sr, sc);
  const int vb0 = (int)(uintptr_t)V_lds + v_rd_base(lane);
  struct { bf16x8 vs0, vs1, ks0, ks1; } sr_[SD];
#define SLOAD(i, jt) do { const bf16_t* kt_ = src.k(jt); const bf16_t* vt_ = src.v(jt); \
    sr_[i].vs0 = *reinterpret_cast<const bf16x8*>(&vt_[(long)sr * LDK + sc]); sr_[i].vs1 = *reinterpret_cast<const bf16x8*>(&vt_[(long)(32 + sr) * LDK + sc]); \
    sr_[i].ks0 = *reinterpret_cast<const bf16x8*>(&kt_[(long)sr * LDK + sc]); sr_[i].ks1 = *reinterpret_cast<const bf16x8*>(&kt_[(long)(32 + sr) * LDK + sc]); } while (0)
#define SWRITE(b, i) do { *(bf16x8*)((char*)V_lds + (b) * SHM_V + vst0) = sr_[i].vs0;          \
    *(bf16x8*)((char*)V_lds + (b) * SHM_V + vst1) = sr_[i].vs1; int kc = sc * 2;               \
    *(bf16x8*)((char*)K_lds + (b) * SHM_K + KSWZ(sr, kc)) = sr_[i].ks0;                       \
    *(bf16x8*)((char*)K_lds + (b) * SHM_K + KSWZ(32 + sr, kc)) = sr_[i].ks1; } while (0)
#define SWAIT() do { if constexpr (SD == 2) asm volatile("s_waitcnt vmcnt(4)" ::: "memory"); else asm volatile("s_waitcnt vmcnt(0)" ::: "memory"); } while (0)
#define RESC(a) do { if (__any((a) < 1.f)) { if (hi == 0) al_l[r32] = (a); asm volatile("s_waitcnt lgkmcnt(0)" ::: "memory"); \
    for (int d = 0; d < 4; ++d) for (int r = 0; r < 16; ++r) o[d][r] *= al_l[crow(r, hi)]; } } while (0)
  f32x16 pA0, pA1, pB0, pB1; float mnA, mnB, alA, alB; bf16x8 pa0, pa1, pa2, pa3;
  constexpr int SE = 0, SO = SD - 1;
  SLOAD(SE, 0); asm volatile("s_waitcnt vmcnt(0)" ::: "memory"); SWRITE(0, SE); __syncthreads();
  qkt(pA0, pA1, K_lds, Q_lds, qrow, r32, hi); bias(pA0, pA1, 0, wid, r32, hi); partialSM(pA0, pA1, m_reg, mnA, alA);
  SLOAD(SO, 1); if constexpr (SD == 2) { if (2 < NT) SLOAD(SE, 2); }
  SWAIT(); SWRITE(1, SO); __syncthreads();
  for (int j = 1; j + 1 < NT; j += 2) {
    SBAR(); qkt(pB0, pB1, (bf16_t*)((char*)K_lds + SHM_K), Q_lds, qrow, r32, hi); bias(pB0, pB1, j, wid, r32, hi);
    finishSM(pA0, pA1, alA, l_reg, pa0, pa1, pa2, pa3); SBAR();
    SLOAD(SO, j + SD); SBAR();
    pv_d0(o, vb0, pa0, pa1, pa2, pa3); partialSM(pB0, pB1, m_reg, mnB, alB);
    __syncthreads(); SWAIT(); SWRITE(0, SE);
    RESC(alB); __syncthreads();
    SBAR(); qkt(pA0, pA1, K_lds, Q_lds, qrow, r32, hi); bias(pA0, pA1, j + 1, wid, r32, hi);
    finishSM(pB0, pB1, alB, l_reg, pa0, pa1, pa2, pa3); SBAR();
    if (SD == 1 || j + 3 < NT) SLOAD(SE, j + 1 + SD); SBAR();
    pv_d0(o, vb0 + (int)SHM_V, pa0, pa1, pa2, pa3); partialSM(pA0, pA1, m_reg, mnA, alA);
    __syncthreads(); SWAIT(); SWRITE(1, SO);
    RESC(alA); __syncthreads();
  }
  SBAR(); qkt(pB0, pB1, (bf16_t*)((char*)K_lds + SHM_K), Q_lds, qrow, r32, hi); bias(pB0, pB1, NT - 1, wid, r32, hi);
  finishSM(pA0, pA1, alA, l_reg, pa0, pa1, pa2, pa3); SBAR();
  pv_d0(o, vb0, pa0, pa1, pa2, pa3); partialSM(pB0, pB1, m_reg, mnB, alB);
  __syncthreads(); RESC(alB);
  finishSM(pB0, pB1, alB, l_reg, pa0, pa1, pa2, pa3); SBAR();
  pv_d0(o, vb0 + (int)SHM_V, pa0, pa1, pa2, pa3);
  if (hi == 0) li_l[r32] = l_reg; asm volatile("s_waitcnt lgkmcnt(0)" ::: "memory");
  float rli[16];
#pragma unroll
  for (int r = 0; r < 16; ++r) rli[r] = __builtin_amdgcn_rcpf(li_l[crow(r, hi)]);
  bf16_t* Ow = Ob + (long)(wid * QBLK) * LDO;
#pragma unroll
  for (int r = 0; r < 16; ++r) { int orow = crow(r, hi);
    for (int d0 = 0; d0 < 4; ++d0) Ow[(long)orow * LDO + d0 * 32 + r32] = f2bf(o[d0][r] * rli[r]); }
#undef SLOAD
#undef SWRITE
#undef SWAIT
#undef RESC
}
}
namespace gdn {
using att::bf16x8; using att::f32x16; using att::crow;
constexpr int C = 32, SK = 136, SS = 40;
constexpr int OFF_KT = 0, OFF_QT = OFF_KT + C * SK * 2, OFF_W = OFF_QT + C * SK * 2, OFF_KTT = OFF_W + C * SK * 2, OFF_VTT = OFF_KTT + 128 * SS * 2,
              OFF_VN = OFF_VTT + 128 * SS * 2, OFF_VNS = OFF_VN + 128 * SS * 2, OFF_ST = OFF_VNS + 128 * SS * 2, OFF_TB = OFF_ST + 128 * SK * 2,
              OFF_TBE = OFF_TB + C * SS * 2, OFF_ATT = OFF_TBE + C * SS * 2, OFF_L = OFF_ATT + C * SS * 2, OFF_SC = OFF_L + C * C * 4, GDN_LDS = OFF_SC + 1024;
template <int K>
__device__ __forceinline__ f32x16 mm(const bf16_t* A, int lda, const bf16_t* Bt, int ldb, int l32, int hi, f32x16 acc) {
#pragma unroll
    for (int k0 = 0; k0 < K; k0 += 16) {
        const bf16x8 a = *reinterpret_cast<const bf16x8*>(A + l32 * lda + k0 + 8 * hi);
        const bf16x8 b = *reinterpret_cast<const bf16x8*>(Bt + l32 * ldb + k0 + 8 * hi);
        acc = __builtin_amdgcn_mfma_f32_32x32x16_bf16(a, b, acc, 0, 0, 0);
    }
    return acc;
}
__device__ __forceinline__ uint2 pk4(float a, float b, float c, float d) { uint2 w; w.x = pack2(a, b); w.y = pack2(c, d); return w; }

__device__ __forceinline__ void gdn_chunked(const Params& p, int l, bool ctx, int b, int h, int dir, unsigned char* lds) {
    const int tid = opaque_tid(), wid = tid >> 6, lane = tid & 63, l32 = lane & 31, hi = lane >> 5;
    const int T = ctx ? CT : ::LT; const size_t m0 = ctx ? (size_t)b * CT : (size_t)MC + (size_t)b * ::LT;
    const bf16_t* DQ = WSP(bf16_t, WS_DQ); const bf16_t* DK = WSP(bf16_t, WS_DK); const bf16_t* DV = WSP(bf16_t, WS_DV); const float* DBA = WSP(float, WS_DBA);
    float* O = WSP(float, dir ? WS_DOB : WS_DOF);
    bf16_t* Kt = (bf16_t*)(lds + OFF_KT); bf16_t* Qt = (bf16_t*)(lds + OFF_QT); bf16_t* W = (bf16_t*)(lds + OFF_W); bf16_t* KT = (bf16_t*)(lds + OFF_KTT); bf16_t* VT = (bf16_t*)(lds + OFF_VTT);
    bf16_t* VN = (bf16_t*)(lds + OFF_VN); bf16_t* VNS = (bf16_t*)(lds + OFF_VNS); bf16_t* ST = (bf16_t*)(lds + OFF_ST); bf16_t* TB = (bf16_t*)(lds + OFF_TB); bf16_t* TBE = (bf16_t*)(lds + OFF_TBE);
    bf16_t* ATT = (bf16_t*)(lds + OFF_ATT); float* Lm = (float*)(lds + OFF_L); float* sc = (float*)(lds + OFF_SC);
    const int nch = T / C;
#define TOK(c, s_) (m0 + (dir ? T - 1 - ((c) * C + (s_)) : (c) * C + (s_)))
    f32x16 S[2];
#pragma unroll
    for (int bi = 0; bi < 2; ++bi) {
        const int blk = wid * 2 + bi, d0 = 32 * (blk >> 2), e0 = 32 * (blk & 3);
        if (ctx) { S[bi] = f32x16{}; }
        else {
            const float* s0 = p.in[I_SGDN] + ((((size_t)b * DEPTH + l) * 2 + dir) * 4 + h) * 128 * 128 + e0 + l32;
#pragma unroll
            for (int r = 0; r < 16; ++r) S[bi][r] = s0[(size_t)(d0 + crow(r, hi)) * 128];
        }
    }
    const int ls = tid >> 5, lc = (tid & 31) * 4;
    vf4 pq0, pq1, pk0, pk1, pv0, pv1; float pbeta = 0.f, pg = 0.f;
#define GLOAD(c) do { const size_t ma = TOK(c, ls), mb = TOK(c, ls + 16); \
        pq0 = ld4bf(DQ + ma * 512 + h * 128 + lc); pq1 = ld4bf(DQ + mb * 512 + h * 128 + lc); \
        pk0 = ld4bf(DK + ma * 512 + h * 128 + lc); pk1 = ld4bf(DK + mb * 512 + h * 128 + lc); \
        pv0 = ld4bf(DV + ma * 512 + h * 128 + lc); pv1 = ld4bf(DV + mb * 512 + h * 128 + lc); \
        if (tid < C) { const size_t mt = TOK(c, tid); pbeta = DBA[mt * 16 + dir * 4 + h]; pg = DBA[mt * 16 + 8 + dir * 4 + h]; } } while (0)
#define GSTAGE() do { \
        *(uint2*)(Kt + ls * SK + lc) = pk4(pk0.x, pk0.y, pk0.z, pk0.w); *(uint2*)(Kt + (ls + 16) * SK + lc) = pk4(pk1.x, pk1.y, pk1.z, pk1.w); \
        *(uint2*)(Qt + ls * SK + lc) = pk4(pq0.x, pq0.y, pq0.z, pq0.w); *(uint2*)(Qt + (ls + 16) * SK + lc) = pk4(pq1.x, pq1.y, pq1.z, pq1.w); \
        _Pragma("unroll") for (int j = 0; j < 4; ++j) { KT[(lc + j) * SS + ls] = f2bf(pk0[j]); KT[(lc + j) * SS + ls + 16] = f2bf(pk1[j]); \
                                                        VT[(lc + j) * SS + ls] = f2bf(pv0[j]); VT[(lc + j) * SS + ls + 16] = f2bf(pv1[j]); } \
        if (wid == 0) { float x = pg; _Pragma("unroll") for (int o_ = 1; o_ < 32; o_ <<= 1) { const float y = __shfl_up(x, o_); if (lane >= o_) x += y; } \
            const float Bt_ = __shfl(x, 31); if (lane < C) { sc[lane] = pbeta; sc[32 + lane] = x; sc[64 + lane] = __expf(x); sc[96 + lane] = __expf(Bt_ - x); if (lane == 0) sc[128] = __expf(Bt_); } } } while (0)
    __syncthreads();
    GLOAD(0);
#pragma unroll
    for (int bi = 0; bi < 2; ++bi) {
        const int blk = wid * 2 + bi, d0 = 32 * (blk >> 2), e0 = 32 * (blk & 3);
#pragma unroll
        for (int g = 0; g < 4; ++g) *(uint2*)(ST + (e0 + l32) * SK + d0 + 8 * g + 4 * hi) = pk4(S[bi][4 * g], S[bi][4 * g + 1], S[bi][4 * g + 2], S[bi][4 * g + 3]);
    }
    GSTAGE();
    __syncthreads();
    for (int c = 0; c < nch; ++c) {
        if (c + 1 < nch) GLOAD(c + 1);
        f32x16 acc1 = f32x16{};
        if (wid == 0) {
            const f32x16 kk = mm<128>(Kt, SK, Kt, SK, l32, hi, f32x16{});
            const float bi_ = sc[32 + l32], be = sc[l32];
#pragma unroll
            for (int r = 0; r < 16; ++r) { const int j = crow(r, hi); const float v = (l32 > j) ? be * kk[r] * __expf(bi_ - sc[32 + j]) : 0.f;
                Lm[l32 * 32 + ((r & 3) + 4 * hi) * 4 + (r >> 2)] = v; }
        } else if (wid == 1) {
            const f32x16 kq = mm<128>(Kt, SK, Qt, SK, l32, hi, f32x16{});
            const float bi_ = sc[32 + l32];
            float a[16];
#pragma unroll
            for (int r = 0; r < 16; ++r) { const int j = crow(r, hi); a[r] = (l32 >= j) ? kq[r] * __expf(bi_ - sc[32 + j]) : 0.f; }
#pragma unroll
            for (int g = 0; g < 4; ++g) *(uint2*)(ATT + l32 * SS + 8 * g + 4 * hi) = pk4(a[4 * g], a[4 * g + 1], a[4 * g + 2], a[4 * g + 3]);
        } else if (wid >= 4) {
            acc1 = mm<128>(Qt, SK, ST + (32 * (wid - 4)) * SK, SK, l32, hi, f32x16{});
#pragma unroll
            for (int r = 0; r < 16; ++r) acc1[r] *= sc[64 + crow(r, hi)];
        }
        __syncthreads();
        if (tid < 256) {
            const int cc = tid >> 3, part = tid & 7;
            float Tr[4] = {0.f, 0.f, 0.f, 0.f};
            const float* Lp = Lm + part * 4;
#pragma unroll
            for (int i = 0; i < 32; ++i) {
                const vf4 lv = *(const vf4*)(Lp + i * 32);
                float s = lv.x * Tr[0] + lv.y * Tr[1] + lv.z * Tr[2] + lv.w * Tr[3];
                s = red8(s);
                const float t = (i == cc ? 1.f : 0.f) - s;
                if (part == (i & 7)) Tr[i >> 3] = t;
            }
            const float bc = sc[cc], bec = bc * sc[64 + cc];
#pragma unroll
            for (int jj = 0; jj < 4; ++jj) { TB[(part + 8 * jj) * SS + cc] = f2bf(Tr[jj] * bc); TBE[(part + 8 * jj) * SS + cc] = f2bf(Tr[jj] * bec); }
        }
        __syncthreads();
        if (wid < 4) {
            acc1 = mm<32>(TB, SS, VT + (32 * wid) * SS, SS, l32, hi, f32x16{});
        } else {
            const int d0 = 32 * (wid - 4);
            const f32x16 wt = mm<32>(KT + d0 * SS, SS, TBE, SS, l32, hi, f32x16{});
#pragma unroll
            for (int g = 0; g < 4; ++g) *(uint2*)(W + l32 * SK + d0 + 8 * g + 4 * hi) = pk4(wt[4 * g], wt[4 * g + 1], wt[4 * g + 2], wt[4 * g + 3]);
        }
        __syncthreads();
        if (wid < 4) {
            const int e0 = 32 * wid;
            const f32x16 ws = mm<128>(W, SK, ST + e0 * SK, SK, l32, hi, f32x16{});
            float vn[16], vs[16];
#pragma unroll
            for (int r = 0; r < 16; ++r) { vn[r] = acc1[r] - ws[r]; vs[r] = vn[r] * sc[96 + crow(r, hi)]; }
#pragma unroll
            for (int g = 0; g < 4; ++g) { *(uint2*)(VN + (e0 + l32) * SS + 8 * g + 4 * hi) = pk4(vn[4 * g], vn[4 * g + 1], vn[4 * g + 2], vn[4 * g + 3]);
                                          *(uint2*)(VNS + (e0 + l32) * SS + 8 * g + 4 * hi) = pk4(vs[4 * g], vs[4 * g + 1], vs[4 * g + 2], vs[4 * g + 3]); }
        }
        __syncthreads();
        if (wid >= 4) {
            const int e0 = 32 * (wid - 4);
            acc1 = mm<32>(ATT, SS, VN + e0 * SS, SS, l32, hi, acc1);
#pragma unroll
            for (int r = 0; r < 16; ++r) O[TOK(c, crow(r, hi)) * 512 + h * 128 + e0 + l32] = acc1[r];
        }
        {
            const float eB = sc[128];
#pragma unroll
            for (int bi = 0; bi < 2; ++bi) {
                const int blk = wid * 2 + bi, d0 = 32 * (blk >> 2), e0 = 32 * (blk & 3);
#pragma unroll
                for (int r = 0; r < 16; ++r) S[bi][r] *= eB;
                S[bi] = mm<32>(KT + d0 * SS, SS, VNS + e0 * SS, SS, l32, hi, S[bi]);
            }
        }
        __syncthreads();
#pragma unroll
        for (int bi = 0; bi < 2; ++bi) {
            const int blk = wid * 2 + bi, d0 = 32 * (blk >> 2), e0 = 32 * (blk & 3);
#pragma unroll
            for (int g = 0; g < 4; ++g) *(uint2*)(ST + (e0 + l32) * SK + d0 + 8 * g + 4 * hi) = pk4(S[bi][4 * g], S[bi][4 * g + 1], S[bi][4 * g + 2], S[bi][4 * g + 3]);
        }
        if (c + 1 < nch) GSTAGE();
        __syncthreads();
    }
#undef GLOAD
#undef GSTAGE
#undef TOK
    if (ctx) {
#pragma unroll
        for (int bi = 0; bi < 2; ++bi) {
            const int blk = wid * 2 + bi, d0 = 32 * (blk >> 2), e0 = 32 * (blk & 3);
            float* so = p.out + O_SGDN + ((((size_t)b * DEPTH + l) * 2 + dir) * 4 + h) * 128 * 128 + e0 + l32;
#pragma unroll
            for (int r = 0; r < 16; ++r) so[(size_t)(d0 + crow(r, hi)) * 128] = S[bi][r];
        }
    }
}
}

namespace gla {
using att::bf16x8; using att::f32x16; using att::crow; using gdn::mm; using gdn::pk4;
constexpr int C = 32, SQ = 72, SS = 40;
constexpr int OFF_QE = 0, OFF_KN = OFF_QE + C * SQ * 2, OFF_KET = OFF_KN + C * SQ * 2, OFF_VT = OFF_KET + 64 * SS * 2, OFF_ATT = OFF_VT + 128 * SS * 2, OFF_ST = OFF_ATT + C * SS * 2,
              OFF_LA = OFF_ST + 128 * SQ * 2, OFF_EB = OFF_LA + C * 64 * 4, GLA_LDS = OFF_EB + 256;
__device__ __forceinline__ void gla_chunked(const Params& p, int l, bool ctx, int b, int h, int dir, unsigned char* lds) {
    const int tid = opaque_tid(), wid = tid >> 6, lane = tid & 63, l32 = lane & 31, hi = lane >> 5;
    const int T = ctx ? CT : ::LT; const size_t m0 = ctx ? (size_t)b * CT : (size_t)MC + (size_t)b * ::LT;
    const bf16_t* Z = WSP(bf16_t, WS_Z); const float* LA = WSP(float, dir ? WS_AB : WS_AF);
    float* O = WSP(float, dir ? WS_GOB : WS_GOF);
    bf16_t* Qe = (bf16_t*)(lds + OFF_QE); bf16_t* Kn = (bf16_t*)(lds + OFF_KN); bf16_t* KeT = (bf16_t*)(lds + OFF_KET); bf16_t* VT = (bf16_t*)(lds + OFF_VT);
    bf16_t* ATT = (bf16_t*)(lds + OFF_ATT); bf16_t* ST = (bf16_t*)(lds + OFF_ST); float* la = (float*)(lds + OFF_LA); float* eB = (float*)(lds + OFF_EB);
    const int nch = T / C;
#define TOK(c, s_) (m0 + (dir ? T - 1 - ((c) * C + (s_)) : (c) * C + (s_)))
    const int d0 = 32 * (wid >> 2), e0 = 32 * (wid & 3);
    f32x16 S;
    if (ctx) S = f32x16{};
    else {
        const float* s0 = p.in[I_SGLA] + ((((size_t)b * DEPTH + l) * 2 + dir) * 4 + h) * 64 * 128 + e0 + l32;
#pragma unroll
        for (int r = 0; r < 16; ++r) S[r] = s0[(size_t)(d0 + crow(r, hi)) * 128];
    }
    const int ts = tid >> 4, dc = (tid & 15) * 4, vs = tid >> 5, vc = (tid & 31) * 4;
    vf4 pq, pk, pl, pv0, pv1;
#define GLOAD(c) do { const size_t mt = TOK(c, ts), ma = TOK(c, vs), mb = TOK(c, vs + 16); \
        pq = ld4bf(Z + mt * NINP + Z_GLQ + h * 64 + dc); pk = ld4bf(Z + mt * NINP + Z_GLK + h * 64 + dc); pl = *(const vf4*)(LA + mt * 256 + h * 64 + dc); \
        pv0 = ld4bf(Z + ma * NINP + Z_GLV + h * 128 + vc); pv1 = ld4bf(Z + mb * NINP + Z_GLV + h * 128 + vc); } while (0)
#define WRITE_ST() do { _Pragma("unroll") for (int g = 0; g < 4; ++g) *(uint2*)(ST + (e0 + l32) * SQ + d0 + 8 * g + 4 * hi) = pk4(S[4 * g], S[4 * g + 1], S[4 * g + 2], S[4 * g + 3]); } while (0)
#define GIMAGES() do { vf4 pre = (vf4){0.f, 0.f, 0.f, 0.f}, tot = pre; \
        _Pragma("unroll 8") for (int t_ = 0; t_ < C; ++t_) { const vf4 v_ = *(const vf4*)(la + t_ * 64 + dc); tot += v_; if (t_ <= ts) pre += v_; } \
        float qe[4], kn[4]; \
        _Pragma("unroll") for (int j = 0; j < 4; ++j) { qe[j] = pq[j] * 0.125f * __expf(pre[j]); kn[j] = pk[j] * __expf(fminf(-pre[j], 80.f)); \
            KeT[(dc + j) * SS + ts] = f2bf(pk[j] * __expf(tot[j] - pre[j])); } \
        *(uint2*)(Qe + ts * SQ + dc) = pk4(qe[0], qe[1], qe[2], qe[3]); *(uint2*)(Kn + ts * SQ + dc) = pk4(kn[0], kn[1], kn[2], kn[3]); \
        if (ts == 0) { _Pragma("unroll") for (int j = 0; j < 4; ++j) eB[dc + j] = __expf(tot[j]); } \
        _Pragma("unroll") for (int j = 0; j < 4; ++j) { VT[(vc + j) * SS + vs] = f2bf(pv0[j]); VT[(vc + j) * SS + vs + 16] = f2bf(pv1[j]); } } while (0)
    __syncthreads();
    GLOAD(0);
    WRITE_ST();
    *(vf4*)(la + ts * 64 + dc) = pl;
    __syncthreads();
    GIMAGES();
    __syncthreads();
    for (int c = 0; c < nch; ++c) {
        if (c + 1 < nch) GLOAD(c + 1);
        f32x16 o1 = f32x16{};
        if (wid == 0) {
            const f32x16 kq = mm<64>(Kn, SQ, Qe, SQ, l32, hi, f32x16{});
            float a[16];
#pragma unroll
            for (int r = 0; r < 16; ++r) a[r] = (l32 >= crow(r, hi)) ? kq[r] : 0.f;
#pragma unroll
            for (int g = 0; g < 4; ++g) *(uint2*)(ATT + l32 * SS + 8 * g + 4 * hi) = pk4(a[4 * g], a[4 * g + 1], a[4 * g + 2], a[4 * g + 3]);
        } else if (wid >= 4) {
            o1 = mm<64>(Qe, SQ, ST + (32 * (wid - 4)) * SQ, SQ, l32, hi, f32x16{});
        }
        __syncthreads();
        if (wid >= 4) {
            const int eo = 32 * (wid - 4);
            o1 = mm<32>(ATT, SS, VT + eo * SS, SS, l32, hi, o1);
#pragma unroll
            for (int r = 0; r < 16; ++r) O[TOK(c, crow(r, hi)) * 512 + h * 128 + eo + l32] = o1[r];
        }
#pragma unroll
        for (int r = 0; r < 16; ++r) S[r] *= eB[d0 + crow(r, hi)];
        S = mm<32>(KeT + d0 * SS, SS, VT + e0 * SS, SS, l32, hi, S);
        __syncthreads();
        WRITE_ST();
        if (c + 1 < nch) *(vf4*)(la + ts * 64 + dc) = pl;
        __syncthreads();
        if (c + 1 < nch) GIMAGES();
        __syncthreads();
    }
#undef GLOAD
#undef WRITE_ST
#undef GIMAGES
#undef TOK
    if (ctx) {
        float* so = p.out + O_SGLA + ((((size_t)b * DEPTH + l) * 2 + dir) * 4 + h) * 64 * 128 + e0 + l32;
#pragma unroll
        for (int r = 0; r < 16; ++r) so[(size_t)(d0 + crow(r, hi)) * 128] = S[r];
    }
}
}
#define LAS __attribute__((address_space(3)))
constexpr int LDS_BYTES = 147456, XBW_OFF = LDS_BYTES - 64;
constexpr int NPH = 1 + DEPTH * 12;
#ifndef DBG_NLAYERS
#define DBG_NLAYERS DEPTH
#endif

#ifndef DUPKIND
#define DUPKIND 0
#endif
__device__ __forceinline__ int opaque_int(int v) { asm volatile("" : "+s"(v)); return v; }
#ifndef MIXMASK
#define MIXMASK 0xFF
#endif
#define FOR_ITEMS(it, n, o, w) for (int bo_ = (o) * (int)gridDim.x / 256, bw_ = ((w) * (int)gridDim.x / 256) > 0 ? ((w) * (int)gridDim.x / 256) : 1, \
                                    it = ((int)blockIdx.x >= bo_ && (int)blockIdx.x < bo_ + bw_) ? (int)blockIdx.x - bo_ : (n); it < (n); it += bw_)

#ifndef SPLITK
#define SPLITK 0
#endif
#ifndef SPLITK_G4
#define SPLITK_G4 0
#endif
constexpr int FLAG_WORD0 = 8192;
constexpr int QCTR_WORD0 = 1024;
constexpr int NI_GDNL = LB * 8, NI_GLAL = LB * 8, NI_GDNC = CB * 8, NI_GQAL = LB * 16, NI_NAL = LB * 16, NI_GLAC = CB * 8, NI_NAC = CB * 4, NI_GQAC = CB * 4;
#define KM(k) (1 + ((DUPKIND >> (k)) & 1))
constexpr int Q0 = NI_GDNL * KM(0), Q1 = Q0 + NI_GQAL * KM(1), Q2 = Q1 + NI_NAL * KM(2), Q3 = Q2 + NI_GLAL * KM(3), Q4 = Q3 + NI_GDNC * KM(4), Q5 = Q4 + NI_NAC * KM(5), Q6 = Q5 + NI_GQAC * KM(6), Q7 = Q6 + NI_GLAC * KM(7);
__device__ __forceinline__ void phase_mix(const Params& p, int l, unsigned char* lds, int rep) {
    const int tid = opaque_tid();
    float* smem = (float*)lds;
    const bf16_t* NAQ = WSP(bf16_t, WS_NAQ); const bf16_t* NAK = WSP(bf16_t, WS_NAK); const bf16_t* NAV = WSP(bf16_t, WS_NAV);
    const bf16_t* GQ = WSP(bf16_t, WS_GQ); const bf16_t* GK = WSP(bf16_t, WS_GK); const bf16_t* GV = WSP(bf16_t, WS_GV);
    bf16_t* MRG = WSP(bf16_t, WS_MRG);
    unsigned* qctr = WSP(unsigned, WS_CTL) + QCTR_WORD0 + 64 * l + 16 * rep;
    volatile int* qslot = (volatile int*)(lds + XBW_OFF + 16);
    for (;;) {
        __syncthreads();
        if (tid == 0) *qslot = (int)__hip_atomic_fetch_add(qctr, 1u, __ATOMIC_RELAXED, __HIP_MEMORY_SCOPE_AGENT);
        __syncthreads();
        const int q = __builtin_amdgcn_readfirstlane(*qslot);
        if (q >= Q7) break;
        if (q < Q0) { const int it = q % NI_GDNL; gdn::gdn_chunked(p, l, false, it / 8, (it / 2) % 4, it % 2, lds); }
        else if (q < Q1) {
            const int it = (q - Q0) % NI_GQAL, b = it / 16, qh = (it / 4) % 4, qb = it % 4, kvh = qh >> 1;
            const size_t r0 = (size_t)MC + (size_t)b * LT;
            att::SrcTwo src{WSP(bf16_t, WS_CGK) + ((size_t)b * DEPTH + l) * 256 * 256 + kvh * 128, WSP(bf16_t, WS_CGV) + ((size_t)b * DEPTH + l) * 256 * 256 + kvh * 128,
                            GK + r0 * 256 + kvh * 128, GV + r0 * 256 + kvh * 128, 256};
            att::attn_body<2>(GQ + (r0 + qb * 256) * 512 + qh * 128, src, MRG + (r0 + qb * 256) * DM + 1024 + qh * 128, 4 + LT / 64, (char*)lds, att::NoBias{});
        }
        else if (q < Q2) {
            const int it = (q - Q1) % NI_NAL, b = it / 16, h = (it / 4) % 4, qb = it % 4;
            const int kr0 = qb == 0 ? 0 : qb == 1 ? 0 : qb == 2 ? 4 : 8, nrows = (qb == 0 || qb == 3) ? 8 : 12;
            const size_t r0 = (size_t)MC + (size_t)b * LT;
            float* tab = (float*)(lds + att::SHM_ATTN);
            if (tid < 15 * 31) tab[tid] = p.in[I_RPB][((size_t)l * 4 + h) * 15 * 31 + tid] * (1.0f / att::SCALE);
            att::SrcTwo src{WSP(bf16_t, WS_CNAK) + ((size_t)b * DEPTH + l) * 256 * 512 + h * 128, WSP(bf16_t, WS_CNAV) + ((size_t)b * DEPTH + l) * 256 * 512 + h * 128,
                            NAK + (r0 + kr0 * 64) * 512 + h * 128, NAV + (r0 + kr0 * 64) * 512 + h * 128, 512};
            att::attn_body<1>(NAQ + (r0 + qb * 256) * 512 + h * 128, src, MRG + (r0 + qb * 256) * DM + 0 + h * 128, 4 + nrows, (char*)lds, att::NaBias{tab, qb * 256, kr0});
        }
        else if (q < Q3) { const int it = (q - Q2) % NI_GLAL; gla::gla_chunked(p, l, false, it / 8, (it / 2) % 4, it % 2, lds); }
        else if (q < Q4) { const int it = (q - Q3) % NI_GDNC; gdn::gdn_chunked(p, l, true, it / 8, (it / 2) % 4, it % 2, lds); }
        else if (q < Q5) {
            const int it = (q - Q4) % NI_NAC, b = it / 4, h = it % 4; const size_t r0 = (size_t)b * CT;
            att::SrcOne src{NAK + r0 * 512 + h * 128, NAV + r0 * 512 + h * 128, 512};
            att::attn_body<2>(NAQ + r0 * 512 + h * 128, src, MRG + r0 * DM + 0 + h * 128, CT / 64, (char*)lds, att::NoBias{});
        }
        else if (q < Q6) {
            const int it = (q - Q5) % NI_GQAC, b = it / 4, qh = it % 4, kvh = qh >> 1; const size_t r0 = (size_t)b * CT;
            att::SrcOne src{GK + r0 * 256 + kvh * 128, GV + r0 * 256 + kvh * 128, 256};
            att::attn_body<2>(GQ + r0 * 512 + qh * 128, src, MRG + r0 * DM + 1024 + qh * 128, CT / 64, (char*)lds, att::NoBias{});
        }
        else { const int it = (q - Q6) % NI_GLAC; gla::gla_chunked(p, l, true, it / 8, (it / 2) % 4, it % 2, lds); }
    }
}

#define CONV_FILL(nunits, t0, t1, skip) do { if (l + 1 < DBG_NLAYERS) { const int G_ = (int)gridDim.x; int f0_ = ((nunits) % G_) + (skip); if (f0_ >= G_) f0_ = 0; \
        if ((int)blockIdx.x >= f0_) { const Params q = opaque_params(p); conv_layer_tiles(q, l + 1, (t0), (t1), (int)blockIdx.x - f0_, G_ - f0_, (float*)lds); } } } while (0)
#ifndef MSPLIT
#define MSPLIT 2
#endif
constexpr int TF0 = NT_L / 10, TF1 = NT_L / 4, TF2 = NT_L * 11 / 20;
static_assert(att::SHM_ATTN + 15 * 31 * 4 + 2048 <= (size_t)XBW_OFF, "LDS map");
static_assert((QCTR_WORD0 + 64 * DEPTH) < 4096, "ctl");
constexpr int BAR_WORD0 = 4096;
static_assert((BAR_WORD0 + XCD_BAR_WORDS) * 4 <= (int)CTL_BYTES, "ctl");

__global__ void __launch_bounds__(512, 2) fwd(Params p) {
    extern __shared__ __attribute__((aligned(16))) unsigned char lds[];
    const int tid = threadIdx.x;
    volatile LAS unsigned* xbw = (volatile LAS unsigned*)((LAS unsigned char*)lds + XBW_OFF);
    if (tid < 4) xbw[tid] = 0u;
    __syncthreads();
    XcdBarrier bar; bar.bar = WSP(unsigned, WS_CTL) + BAR_WORD0; bar.x = 0; bar.st = xbw;
    if (p.ph_hi - p.ph_lo > 1) bar = xcd_barrier_post(WSP(unsigned, WS_CTL) + BAR_WORD0, xbw);
#ifndef PHMASK
#define PHMASK 0x1FFF
#endif
#define IN(k) (p.ph_lo <= (k) && (k) < p.ph_hi)
#define INL(j) (((PHMASK >> ((j) + 1)) & 1) && IN(pb + (j)))
#ifndef DUPMASK
#define DUPMASK 0
#endif
#define DUP(j) ((DUPMASK >> ((j) + 1)) & 1)
#if DUPMASK
#define REPS(j) opaque_int(1 + DUP(j))
#else
#define REPS(j) 1
#endif
#define SEAM(k) do { if (IN(k) && IN((k) + 1)) xcd_barrier(bar); } while (0)
    LAS unsigned char* ldsl = (LAS unsigned char*)lds;
    bf16_t* H = WSP(bf16_t, WS_H); bf16_t* ACT = WSP(bf16_t, WS_ACT); float* X = WSP(float, WS_X); float* Z = WSP(float, WS_Z); bf16_t* MRG = WSP(bf16_t, WS_MRG);

    if ((PHMASK & 1) && IN(0)) { const int reps_ = (DUPMASK & 1) ? opaque_int(2) : 1; for (int rep_ = 0; rep_ < reps_; ++rep_) { const Params q = opaque_params(p); phase_prologue(q, (float*)lds); __syncthreads(); } }
    SEAM(0);
    for (int l = 0; l < DBG_NLAYERS; ++l) {
        const int pb = 1 + l * 12;
        const float* modl = WSP(float, WS_MODV) + (size_t)l * NCOND * NMOD;
        if (INL(0)) { const int reps_ = REPS(0); for (int rep_ = 0; rep_ < reps_; ++rep_) { const Params q = opaque_params(p); phase_norm(q, l, 0); __syncthreads(); } }
        SEAM(pb + 0);
        if (INL(1)) {
            pg8::Gemm g{H, WSP(bf16_t, WS_WGU) + ((size_t)l * 2 + 0) * NGU * DM, M, NGU, DM}; pg8::StaticOrder S; S.init(M, NGU, DM, (int)gridDim.x, (int)blockIdx.x);
            pg8::EpiSwiGLU E{ACT, FF};
            for (int r_ = 0, n_ = REPS(1); r_ < n_; ++r_) pg8::gemm_phase<pg8::EpiSwiGLU, pg8::StaticOrder, false>(ldsl, g, S, E, nullptr);
#if CONV_FILLER
            if (l + 1 < DBG_NLAYERS) {
                const int nw_ = (M / 256) * (NGU / 256), G_ = (int)gridDim.x; int f0_ = nw_ % G_; if (nw_ < G_) f0_ = 0;
                const int nmb_ = (G_ - f0_ < NMOD / 128) ? (G_ - f0_) : NMOD / 128;
                if ((int)blockIdx.x >= f0_ && (int)blockIdx.x < f0_ + nmb_) { const Params q = opaque_params(p); mod_layer(q, l + 1, (int)blockIdx.x - f0_, nmb_, (float*)lds); }
            }
            CONV_FILL((M / 256) * (NGU / 256), 0, TF0, NMOD / 128);
#endif
        }
        SEAM(pb + 1);
        if (INL(2)) {
            pg8::Gemm g{ACT, WSP(bf16_t, WS_WDN) + ((size_t)l * 2 + 0) * DM * FF, M, DM, FF}; pg8::StaticOrder S; S.init(M, DM, FF, (int)gridDim.x, (int)blockIdx.x, SPLITK ? 1 : MSPLIT);
            pg8::EpiResid E{l == 0 ? p.in[I_XP] : X, X, DM, modl + 2 * DM, 0.5f, Z, WSP(unsigned, WS_CTL) + FLAG_WORD0, 8u * (unsigned)(l * (2 * SPLITK + SPLITK_G4) + SPLITK), l == 0 ? p.in[I_XS] : X, l == 0 ? MC : 0x7FFFFFFF};
            pg8::gemm_phase<pg8::EpiResid, pg8::StaticOrder, false>(ldsl, g, S, E, nullptr);
#if DUPMASK
            if (opaque_int(DUP(2))) { pg8::EpiResid E2{X, Z, DM, modl + 2 * DM, 0.5f, Z, WSP(unsigned, WS_CTL) + FLAG_WORD0, 0u, X, 0x7FFFFFFF}; pg8::gemm_phase<pg8::EpiResid, pg8::StaticOrder, false>(ldsl, g, S, E2, nullptr); }
#endif
        }
        SEAM(pb + 2);
        if (INL(3)) { const int reps_ = REPS(3); for (int rep_ = 0; rep_ < reps_; ++rep_) { const Params q = opaque_params(p); phase_norm(q, l, 1); __syncthreads(); } }
        SEAM(pb + 3);
        if (INL(4)) {
            pg8::Gemm g{H, WSP(bf16_t, WS_WIN) + (size_t)l * NINP * DM, M, NINP, DM}; pg8::StaticOrder S; S.init(M, NINP, DM, (int)gridDim.x, (int)blockIdx.x);
            pg8::EpiBf16Plain E{WSP(bf16_t, WS_Z), NINP};
            for (int r_ = 0, n_ = REPS(4); r_ < n_; ++r_) pg8::gemm_phase<pg8::EpiBf16Plain, pg8::StaticOrder, false>(ldsl, g, S, E, nullptr);
#if CONV_FILLER
            CONV_FILL((M / 256) * (NINP / 256), TF0, TF1, 0);
#endif
        }
        SEAM(pb + 4);
        if (INL(5)) { const int reps_ = REPS(5); for (int rep_ = 0; rep_ < reps_; ++rep_) { const Params q = opaque_params(p); phase_prep(q, l); __syncthreads(); } }
        SEAM(pb + 5);
        if (INL(6)) { const int reps_ = REPS(6); for (int rep_ = 0; rep_ < reps_; ++rep_) { const Params q = opaque_params(p); phase_mix(q, l, lds, rep_); __syncthreads(); } }
        SEAM(pb + 6);
        if (INL(7)) { const int reps_ = REPS(7); for (int rep_ = 0; rep_ < reps_; ++rep_) { const Params q = opaque_params(p); phase_post(q, l); __syncthreads(); } }
        SEAM(pb + 7);
        if (INL(8)) {
            pg8::Gemm g{MRG, WSP(bf16_t, WS_WOUT) + (size_t)l * DM * DM, M, DM, DM}; pg8::StaticOrder S; S.init(M, DM, DM, (int)gridDim.x, (int)blockIdx.x, SPLITK_G4);
            pg8::EpiResid E{X, X, DM, modl + 5 * DM, 1.0f, Z, WSP(unsigned, WS_CTL) + FLAG_WORD0, 8u * (unsigned)(l * (2 * SPLITK + SPLITK_G4) + SPLITK + SPLITK_G4), X, 0x7FFFFFFF};
            pg8::gemm_phase<pg8::EpiResid, pg8::StaticOrder, false>(ldsl, g, S, E, nullptr);
#if CONV_FILLER
            CONV_FILL((M / 256) * (DM / 256), TF1, TF2, 0);
#endif
#if DUPMASK
            if (opaque_int(DUP(8))) { pg8::EpiResid E2{X, Z, DM, modl + 5 * DM, 1.0f, Z, WSP(unsigned, WS_CTL) + FLAG_WORD0, 0u, X, 0x7FFFFFFF}; pg8::gemm_phase<pg8::EpiResid, pg8::StaticOrder, false>(ldsl, g, S, E2, nullptr); }
#endif
        }
        SEAM(pb + 8);
        if (INL(9)) { const int reps_ = REPS(9); for (int rep_ = 0; rep_ < reps_; ++rep_) { const Params q = opaque_params(p); phase_norm(q, l, 2); __syncthreads(); } }
        SEAM(pb + 9);
        if (INL(10)) {
            pg8::Gemm g{H, WSP(bf16_t, WS_WGU) + ((size_t)l * 2 + 1) * NGU * DM, M, NGU, DM}; pg8::StaticOrder S; S.init(M, NGU, DM, (int)gridDim.x, (int)blockIdx.x);
            pg8::EpiSwiGLU E{ACT, FF};
            pg8::gemm_phase<pg8::EpiSwiGLU, pg8::StaticOrder, false>(ldsl, g, S, E, nullptr);
#if CONV_FILLER
            CONV_FILL((M / 256) * (NGU / 256), TF2, NT_L, 0);
#endif
        }
        SEAM(pb + 10);
        if (INL(11)) {
            pg8::Gemm g{ACT, WSP(bf16_t, WS_WDN) + ((size_t)l * 2 + 1) * DM * FF, M, DM, FF}; pg8::StaticOrder S; S.init(M, DM, FF, (int)gridDim.x, (int)blockIdx.x, SPLITK ? 1 : MSPLIT);
            pg8::EpiResid E{X, (l == DEPTH - 1) ? p.out : X, DM, modl + 8 * DM, 0.5f, Z, WSP(unsigned, WS_CTL) + FLAG_WORD0, 8u * (unsigned)(l * (2 * SPLITK + SPLITK_G4) + 2 * SPLITK + SPLITK_G4), X, 0x7FFFFFFF};
            pg8::gemm_phase<pg8::EpiResid, pg8::StaticOrder, false>(ldsl, g, S, E, nullptr);
        }
        SEAM(pb + 11);
    }
#undef IN
#undef SEAM
}

#ifndef MULTI_LAUNCH
#define MULTI_LAUNCH 0
#endif
extern "C" void kernel_launch(void* const* d_in, const int* in_sizes, int n_in, void* d_out, int out_size, void* d_ws, size_t ws_size, hipStream_t stream) {
    static int grid = 0;
    if (grid == 0) {
        if (n_in != N_IN || (size_t)out_size != O_END || ws_size < WS_END) { fprintf(stderr, "kernel_launch: shape mismatch n_in %d out %d ws %zu (need %zu)\n", n_in, out_size, ws_size, (size_t)WS_END); grid = -1; return; }
        int dev = 0, cus = 0, per_cu = 0;
        if (hipGetDevice(&dev) != hipSuccess || hipDeviceGetAttribute(&cus, hipDeviceAttributeMultiprocessorCount, dev) != hipSuccess) { grid = -1; return; }
        if (hipFuncSetAttribute((const void*)fwd, hipFuncAttributeMaxDynamicSharedMemorySize, LDS_BYTES) != hipSuccess) { fprintf(stderr, "kernel_launch: hipFuncSetAttribute failed\n"); grid = -1; return; }
        if (hipOccupancyMaxActiveBlocksPerMultiprocessor(&per_cu, (const void*)fwd, 512, LDS_BYTES) != hipSuccess || per_cu < 1) { fprintf(stderr, "kernel_launch: occupancy query says %d\n", per_cu); (void)hipGetLastError(); }
        grid = cus;
    }
    if (grid < 0) return;
    (void)hipMemsetAsync((char*)d_ws + WS_CTL, 0, CTL_BYTES, stream);
    Params p{};
    for (int i = 0; i < N_IN; ++i) p.in[i] = (const float*)d_in[i];
    p.out = (float*)d_out; p.ws = (unsigned char*)d_ws;
#if MULTI_LAUNCH
    for (int ph = 0; ph < 1 + DBG_NLAYERS * 12; ++ph) { p.ph_lo = ph; p.ph_hi = ph + 1; hipLaunchKernelGGL(fwd, dim3(grid), dim3(512), LDS_BYTES, stream, p); }
#else
    p.ph_lo = 0; p.ph_hi = NPH; hipLaunchKernelGGL(fwd, dim3(grid), dim3(512), LDS_BYTES, stream, p);
#endif
    const hipError_t le = hipPeekAtLastError();
    if (le != hipSuccess) fprintf(stderr, "kernel_launch: launch failed: %s\n", hipGetErrorName(le));
}
```

```cpp
#include <hip/hip_runtime.h>
#include <cstdio>
#include <cstdint>

#ifndef CB_
#define CB_ 16
#endif
#ifndef LB_
#define LB_ 8
#endif
#ifndef DEPTH_
#define DEPTH_ 4
#endif
#ifndef G1_FP8_MODE
#define G1_FP8_MODE 0
#endif
#ifndef G2_FP8
#define G2_FP8 1
#endif
#ifndef FFN_FP8
#define FFN_FP8 (G1_FP8_MODE != 0 || G2_FP8 != 0)
#endif
constexpr int DM = 2048, DEPTH = DEPTH_, CB = CB_, CT = 256, LB = LB_, LT = 1024;
constexpr int MC = CB * CT, ML = LB * LT, M = MC + ML;
constexpr int FF = 5504, NGU = 2 * FF, NIN = 6192, NINP = 6400, NMOD = 9 * DM, NCOND = 1 + LB;
constexpr float EPS = 1e-6f;
constexpr int FFP = 5632;
constexpr float WGU_SCALE = 32.0f, WDN_SCALE = 64.0f;
constexpr int Z_NAQ = 0, Z_NAK = 512, Z_NAV = 1024, Z_GLQ = 1536, Z_GLK = 1792, Z_GLV = 2048, Z_GLR = 2560, Z_GF = 3072, Z_GB = 3088,
              Z_GQQ = 3104, Z_GQK = 3616, Z_GQV = 3872, Z_DQKV = 4128, Z_DZ = 5664, Z_DB = 6176, Z_DA = 6184;
static_assert(Z_DA + 8 == NIN, "split");
enum { I_XP = 0, I_XS, I_CNAK, I_CNAV, I_CGK, I_CGV, I_SGLA, I_SGDN, I_C, I_CCTX, I_NORMG, I_WMOD, I_BMOD, I_GU, I_DOWN, I_WIN, I_WOUT, I_NAQKN, I_RPB,
       I_GUP, I_GBIAS, I_GLAON, I_GQAQKN, I_CONV, I_ALOG, I_DTB, I_GDNON, N_IN };
constexpr size_t O_YP = 0, O_YS = O_YP + (size_t)MC * DM, O_NAK = O_YS + (size_t)ML * DM, O_NAV = O_NAK + (size_t)CB * DEPTH * 4 * CT * 128,
                 O_GK = O_NAV + (size_t)CB * DEPTH * 4 * CT * 128, O_GV = O_GK + (size_t)CB * DEPTH * 2 * CT * 128,
                 O_SGLA = O_GV + (size_t)CB * DEPTH * 2 * CT * 128, O_SGDN = O_SGLA + (size_t)CB * DEPTH * 2 * 4 * 64 * 128,
                 O_END = O_SGDN + (size_t)CB * DEPTH * 2 * 4 * 128 * 128;
constexpr size_t al256(size_t x) { return (x + 255) & ~(size_t)255; }
constexpr size_t WS_CTL = 0, CTL_BYTES = 1u << 20;
constexpr size_t WS_WGU = CTL_BYTES;
constexpr size_t WS_WDN = WS_WGU + (size_t)DEPTH * 2 * NGU * DM * 2;
constexpr size_t WS_WIN = WS_WDN + (size_t)DEPTH * 2 * DM * FF * 2;
constexpr size_t WS_WOUT = WS_WIN + (size_t)DEPTH * NINP * DM * 2;
constexpr size_t WS_MODV = WS_WOUT + (size_t)DEPTH * DM * DM * 2;
constexpr size_t WS_ROPE = al256(WS_MODV + (size_t)DEPTH * NCOND * NMOD * 4);
constexpr size_t WS_X = al256(WS_ROPE + 2 * 64 * 32 * 4);
constexpr size_t WS_H = WS_X + (size_t)M * DM * 4;
constexpr size_t WS_ACT = WS_H + (size_t)M * DM * 2;
constexpr size_t WS_Z = WS_ACT + (size_t)M * FF * 2;
constexpr size_t WS_MRG = WS_Z + (size_t)M * NINP * 4;
constexpr size_t WS_NAQ = WS_MRG + (size_t)M * DM * 2;
constexpr size_t WS_NAK = WS_NAQ + (size_t)M * 512 * 2;
constexpr size_t WS_NAV = WS_NAK + (size_t)M * 512 * 2;
constexpr size_t WS_GQ = WS_NAV + (size_t)M * 512 * 2;
constexpr size_t WS_GK = WS_GQ + (size_t)M * 512 * 2;
constexpr size_t WS_GV = WS_GK + (size_t)M * 256 * 2;
constexpr size_t WS_CNAK = WS_GV + (size_t)M * 256 * 2;
constexpr size_t WS_CNAV = WS_CNAK + (size_t)LB * DEPTH * 256 * 512 * 2;
constexpr size_t WS_CGK = WS_CNAV + (size_t)LB * DEPTH * 256 * 512 * 2;
constexpr size_t WS_CGV = WS_CGK + (size_t)LB * DEPTH * 256 * 256 * 2;
constexpr size_t WS_AF = WS_CGV + (size_t)LB * DEPTH * 256 * 256 * 2;
constexpr size_t WS_AB = WS_AF + (size_t)M * 256 * 4;
constexpr size_t WS_DQ = WS_AB + (size_t)M * 256 * 4;
constexpr size_t WS_DK = WS_DQ + (size_t)M * 512 * 4;
constexpr size_t WS_DV = WS_DK + (size_t)M * 512 * 4;
constexpr size_t WS_DBA = WS_DV + (size_t)M * 512 * 4;
constexpr size_t WS_GOF = WS_DBA + (size_t)M * 16 * 4;
constexpr size_t WS_GOB = WS_GOF + (size_t)M * 512 * 4;
constexpr size_t WS_DOF = WS_GOB + (size_t)M * 512 * 4;
constexpr size_t WS_DOB = WS_DOF + (size_t)M * 512 * 4;
constexpr size_t WS_END = WS_DOB + (size_t)M * 512 * 4;

typedef unsigned short bf16_t;
struct Params { const float* in[N_IN]; float* out; unsigned char* ws; int ph_lo, ph_hi; };
static_assert(sizeof(Params) == N_IN * 8 + 8 + 8 + 8, "no padding");

#define WSP(T, off) ((T*)(p.ws + (off)))
__device__ __forceinline__ int opaque_tid() { int t = (int)threadIdx.x; asm volatile("" : "+v"(t)); return t; }
__device__ __forceinline__ Params opaque_params(const Params& p) { Params q = p; unsigned long long w = (unsigned long long)q.ws; asm volatile("" : "+s"(w)); q.ws = (unsigned char*)w; return q; }

typedef float vf4 __attribute__((ext_vector_type(4)));
__device__ __forceinline__ unsigned pack4_fp8(float a, float b, float c, float d) { int w = 0; w = __builtin_amdgcn_cvt_pk_fp8_f32(a, b, w, false); w = __builtin_amdgcn_cvt_pk_fp8_f32(c, d, w, true); return (unsigned)w; }
__device__ __forceinline__ float bf2f(unsigned short v) { return __uint_as_float((unsigned)v << 16); }
__device__ __forceinline__ vf4 ld4bf(const unsigned short* p) { const uint2 w = *(const uint2*)p; vf4 r; r.x = __uint_as_float(w.x << 16); r.y = __uint_as_float(w.x & 0xFFFF0000u); r.z = __uint_as_float(w.y << 16); r.w = __uint_as_float(w.y & 0xFFFF0000u); return r; }
__device__ __forceinline__ vf4 unp4bf(uint2 w) { vf4 r; r.x = __uint_as_float(w.x << 16); r.y = __uint_as_float(w.x & 0xFFFF0000u); r.z = __uint_as_float(w.y << 16); r.w = __uint_as_float(w.y & 0xFFFF0000u); return r; }
__device__ __forceinline__ void unp8bf(uint4 w, vf4& a, vf4& b) {
    a.x = __uint_as_float(w.x << 16); a.y = __uint_as_float(w.x & 0xFFFF0000u); a.z = __uint_as_float(w.y << 16); a.w = __uint_as_float(w.y & 0xFFFF0000u);
    b.x = __uint_as_float(w.z << 16); b.y = __uint_as_float(w.z & 0xFFFF0000u); b.z = __uint_as_float(w.w << 16); b.w = __uint_as_float(w.w & 0xFFFF0000u); }
__device__ __forceinline__ void ld8bf(const unsigned short* p, vf4& a, vf4& b) { const uint4 w = *(const uint4*)p;
    a.x = __uint_as_float(w.x << 16); a.y = __uint_as_float(w.x & 0xFFFF0000u); a.z = __uint_as_float(w.y << 16); a.w = __uint_as_float(w.y & 0xFFFF0000u);
    b.x = __uint_as_float(w.z << 16); b.y = __uint_as_float(w.z & 0xFFFF0000u); b.z = __uint_as_float(w.w << 16); b.w = __uint_as_float(w.w & 0xFFFF0000u); }
__device__ __forceinline__ float wave_sum(float v) {
#pragma unroll
    for (int o = 32; o >= 1; o >>= 1) v += __shfl_xor(v, o);
    return v;
}
__device__ __forceinline__ bf16_t f2bf(float f) { unsigned u = __float_as_uint(f); u += 0x7FFFu + ((u >> 16) & 1u); return (bf16_t)(u >> 16); }
__device__ __forceinline__ unsigned pack2(float a, float b) { return (unsigned)f2bf(a) | ((unsigned)f2bf(b) << 16); }
__device__ __forceinline__ float silu_f(float x) { return x / (1.f + expf(-x)); }
__device__ __forceinline__ float softplus_f(float x) { return fmaxf(x, 0.f) + log1pf(expf(-fabsf(x))); }
__device__ __forceinline__ float logsigmoid_f(float x) { return fminf(x, 0.f) - log1pf(expf(-fabsf(x))); }
__device__ __forceinline__ int cond_of_row(int m) { return m < MC ? 0 : 1 + (m - MC) / LT; }
#ifndef CONV_FILLER
#define CONV_FILLER 1
#endif
__device__ __forceinline__ void conv_tile(const float* __restrict__ src, int ld_src, int ncols_src, int k0, int c0, bf16_t* __restrict__ dst, int ld_dst, int n0, float* tile) {
    const int tid = opaque_tid();
    {
        const int r = tid >> 3, c = (tid & 7) * 8;
        float4 a = make_float4(0.f, 0.f, 0.f, 0.f), b = a;
        if (c0 + c + 8 <= ncols_src) {
            const float* s = src + (size_t)(k0 + r) * ld_src + c0 + c;
            a = *(const float4*)s; b = *(const float4*)(s + 4);
        }
        float* t = tile + r * 65 + c;
        t[0] = a.x; t[1] = a.y; t[2] = a.z; t[3] = a.w; t[4] = b.x; t[5] = b.y; t[6] = b.z; t[7] = b.w;
    }
    __syncthreads();
    {
        const int n = tid >> 3, ks = (tid & 7) * 8;
        const float* t = tile + ks * 65 + n;
        uint4 w;
        w.x = pack2(t[0 * 65], t[1 * 65]); w.y = pack2(t[2 * 65], t[3 * 65]); w.z = pack2(t[4 * 65], t[5 * 65]); w.w = pack2(t[6 * 65], t[7 * 65]);
        *(uint4*)(dst + (size_t)(n0 + n) * ld_dst + k0 + ks) = w;
    }
    __syncthreads();
}

__device__ __forceinline__ void conv_tile8(const float* __restrict__ src, int ld_src, int nrows_src, int k0, int c0, unsigned char* __restrict__ dst, int ld_dst, int n0, float scale, float* tile) {
    const int tid = opaque_tid();
    {
        const int r = tid >> 3, c = (tid & 7) * 8;
        float4 a = make_float4(0.f, 0.f, 0.f, 0.f), b = a;
        if (k0 + r < nrows_src) { const float* s = src + (size_t)(k0 + r) * ld_src + c0 + c; a = *(const float4*)s; b = *(const float4*)(s + 4); }
        float* t = tile + r * 65 + c;
        t[0] = a.x * scale; t[1] = a.y * scale; t[2] = a.z * scale; t[3] = a.w * scale; t[4] = b.x * scale; t[5] = b.y * scale; t[6] = b.z * scale; t[7] = b.w * scale;
    }
    __syncthreads();
    {
        const int n = tid >> 3, ks = (tid & 7) * 8;
        const float* t = tile + ks * 65 + n;
        uint2 w; w.x = pack4_fp8(t[0 * 65], t[1 * 65], t[2 * 65], t[3 * 65]); w.y = pack4_fp8(t[4 * 65], t[5 * 65], t[6 * 65], t[7 * 65]);
        *(uint2*)(dst + (size_t)(n0 + n) * ld_dst + k0 + ks) = w;
    }
    __syncthreads();
}
constexpr int MOD_ITEMS = DEPTH * (NMOD / 128);
constexpr int TGU_KT = DM / 64, TGU_NT = NGU / 64, TDN_KT = (G2_FP8 ? FFP : FF) / 64, TDN_NT = DM / 64, TIN_KT = DM / 64, TIN_NT = NINP / 64, TOUT_KT = DM / 64, TOUT_NT = DM / 64;
constexpr int TL_GU = 2 * TGU_KT * TGU_NT, TL_DN = 2 * TDN_KT * TDN_NT, TL_IN = TIN_KT * TIN_NT, TL_OUT = TOUT_KT * TOUT_NT, NT_L = TL_GU + TL_DN + TL_IN + TL_OUT;
__device__ __forceinline__ void conv_layer_tiles(const Params& p, int l, int t_begin, int t_end, int first, int stride, float* s_tile) {
    for (int it = t_begin + first; it < t_end; it += stride) {
        if (it < TL_GU) {
            const int mat = l * 2 + it / (TGU_KT * TGU_NT), r = it % (TGU_KT * TGU_NT), kt = r / TGU_NT, nt = r % TGU_NT;
            const int n0 = nt * 64, t256 = n0 / 256, c = n0 % 256;
            const int c0 = c < 128 ? 128 * t256 + c : FF + 128 * t256 + (c - 128);
#if G1_FP8_MODE
            conv_tile8(p.in[I_GU] + (size_t)mat * DM * NGU, NGU, DM, kt * 64, c0, WSP(unsigned char, WS_WGU) + (size_t)mat * NGU * DM, DM, n0, WGU_SCALE, s_tile);
#else
            conv_tile(p.in[I_GU] + (size_t)mat * DM * NGU, NGU, NGU, kt * 64, c0, WSP(bf16_t, WS_WGU) + (size_t)mat * NGU * DM, DM, n0, s_tile);
#endif
        } else if (it < TL_GU + TL_DN) {
            const int i2 = it - TL_GU, mat = l * 2 + i2 / (TDN_KT * TDN_NT), r = i2 % (TDN_KT * TDN_NT), kt = r / TDN_NT, nt = r % TDN_NT;
#if G2_FP8
            conv_tile8(p.in[I_DOWN] + (size_t)mat * FF * DM, DM, FF, kt * 64, nt * 64, WSP(unsigned char, WS_WDN) + (size_t)mat * DM * FFP, FFP, nt * 64, WDN_SCALE, s_tile);
#else
            conv_tile(p.in[I_DOWN] + (size_t)mat * FF * DM, DM, DM, kt * 64, nt * 64, WSP(bf16_t, WS_WDN) + (size_t)mat * DM * FF, FF, nt * 64, s_tile);
#endif
        } else if (it < TL_GU + TL_DN + TL_IN) {
            const int i2 = it - TL_GU - TL_DN, kt = i2 / TIN_NT, nt = i2 % TIN_NT;
            conv_tile(p.in[I_WIN] + (size_t)l * DM * NIN, NIN, NIN, kt * 64, nt * 64, WSP(bf16_t, WS_WIN) + (size_t)l * NINP * DM, DM, nt * 64, s_tile);
        } else {
            const int i2 = it - TL_GU - TL_DN - TL_IN, kt = i2 / TOUT_NT, nt = i2 % TOUT_NT;
            conv_tile(p.in[I_WOUT] + (size_t)l * DM * DM, DM, DM, kt * 64, nt * 64, WSP(bf16_t, WS_WOUT) + (size_t)l * DM * DM, DM, nt * 64, s_tile);
        }
    }
}

__device__ __forceinline__ void mod_layer(const Params& p, int l, int first, int stride, float* smem) {
    const int tid = opaque_tid();
    float* s_cond = smem;
    float* s_red = s_cond + NCOND * DM;
    __syncthreads();
    for (int i = tid; i < NCOND * DM; i += 512) { const int ci = i / DM, k = i % DM; const float v = ci == 0 ? p.in[I_CCTX][k] : p.in[I_C][(size_t)(ci - 1) * DM + k]; s_cond[i] = silu_f(v); }
    __syncthreads();
    float* modv = WSP(float, WS_MODV);
    for (int jt = first; jt < NMOD / 128; jt += stride) {
        const int cl = tid & 127, kq = tid >> 7, col = jt * 128 + cl;
        const float* w = p.in[I_WMOD] + (size_t)l * DM * NMOD + col;
        float acc[NCOND];
#pragma unroll
        for (int ci = 0; ci < NCOND; ++ci) acc[ci] = 0.f;
        for (int k = kq * 512; k < kq * 512 + 512; k += 8) {
            float wv[8];
#pragma unroll
            for (int j = 0; j < 8; ++j) wv[j] = w[(size_t)(k + j) * NMOD];
#pragma unroll
            for (int ci = 0; ci < NCOND; ++ci) {
                const float4 s0 = *(const float4*)&s_cond[ci * DM + k], s1 = *(const float4*)&s_cond[ci * DM + k + 4];
                acc[ci] += s0.x * wv[0] + s0.y * wv[1] + s0.z * wv[2] + s0.w * wv[3] + s1.x * wv[4] + s1.y * wv[5] + s1.z * wv[6] + s1.w * wv[7];
            }
        }
        if (kq > 0) {
#pragma unroll
            for (int ci = 0; ci < NCOND; ++ci) s_red[((kq - 1) * 128 + cl) * NCOND + ci] = acc[ci];
        }
        __syncthreads();
        if (kq == 0) {
            const float bm = p.in[I_BMOD][(size_t)l * NMOD + col];
#pragma unroll
            for (int ci = 0; ci < NCOND; ++ci)
                modv[((size_t)l * NCOND + ci) * NMOD + col] = acc[ci] + s_red[(0 * 128 + cl) * NCOND + ci] + s_red[(1 * 128 + cl) * NCOND + ci] + s_red[(2 * 128 + cl) * NCOND + ci] + bm;
        }
        __syncthreads();
    }
}

__device__ __forceinline__ void phase_prologue(const Params& p, float* smem) {
    const int tid = threadIdx.x, nb = gridDim.x, bid = blockIdx.x;
    float* s_tile = smem + NCOND * DM + 3 * 128 * NCOND;
#if CONV_FILLER
    mod_layer(p, 0, bid, nb, smem);
#else
    for (int l2 = 0; l2 < DEPTH; ++l2) mod_layer(p, l2, bid, nb, smem);
#endif
    conv_layer_tiles(p, 0, 0, NT_L, bid, nb, s_tile);
#if !CONV_FILLER
    for (int l2 = 1; l2 < DEPTH; ++l2) conv_layer_tiles(p, l2, 0, NT_L, bid, nb, s_tile);
#endif
    const size_t gtid = (size_t)bid * 512 + tid, gstride = (size_t)nb * 512;
    {
        const size_t n_na = (size_t)LB * DEPTH * 256 * 512 / 8;
        for (size_t i = gtid; i < 2 * n_na; i += gstride) {
            const bool isv = i >= n_na; const size_t j = isv ? i - n_na : i;
            const int d8 = (int)(j % 16), h = (int)((j / 16) % 4), t = (int)((j / 64) % 256); const size_t bl = j / (64 * 256);
            const float* s = p.in[isv ? I_CNAV : I_CNAK] + ((bl * 4 + h) * 256 + t) * 128 + d8 * 8;
            const float4 a = *(const float4*)s, b = *(const float4*)(s + 4);
            uint4 w; w.x = pack2(a.x, a.y); w.y = pack2(a.z, a.w); w.z = pack2(b.x, b.y); w.w = pack2(b.z, b.w);
            *(uint4*)(WSP(bf16_t, isv ? WS_CNAV : WS_CNAK) + (bl * 256 + t) * 512 + h * 128 + d8 * 8) = w;
        }
        const size_t n_g = (size_t)LB * DEPTH * 256 * 256 / 8;
        for (size_t i = gtid; i < 2 * n_g; i += gstride) {
            const bool isv = i >= n_g; const size_t j = isv ? i - n_g : i;
            const int d8 = (int)(j % 16), h = (int)((j / 16) % 2), t = (int)((j / 32) % 256); const size_t bl = j / (32 * 256);
            const float* s = p.in[isv ? I_CGV : I_CGK] + ((bl * 2 + h) * 256 + t) * 128 + d8 * 8;
            const float4 a = *(const float4*)s, b = *(const float4*)(s + 4);
            uint4 w; w.x = pack2(a.x, a.y); w.y = pack2(a.z, a.w); w.z = pack2(b.x, b.y); w.w = pack2(b.z, b.w);
            *(uint4*)(WSP(bf16_t, isv ? WS_CGV : WS_CGK) + (bl * 256 + t) * 256 + h * 128 + d8 * 8) = w;
        }
    }
    for (size_t i = gtid; i < 64 * 32; i += gstride) {
        const int pos = (int)(i / 32), k = (int)(i % 32);
        const float inv = powf(10000.0f, -(float)(2 * k) / 64.0f);
        const float ang = (float)pos * inv;
        WSP(float, WS_ROPE)[i] = cosf(ang); WSP(float, WS_ROPE)[64 * 32 + i] = sinf(ang);
    }
}

__device__ __forceinline__ void phase_norm(const Params& p, int l, int which  ) {
    const int tid = opaque_tid(), lane = tid & 63, wv = tid >> 6;
    const float* X = WSP(float, WS_X); bf16_t* H = WSP(bf16_t, WS_H);
    const bool from_in = (l == 0 && which == 0);
    const float* g = p.in[I_NORMG] + ((size_t)l * 3 + which) * DM;
    const int nw = (int)gridDim.x * 8;
    for (int m0 = blockIdx.x * 8 + wv; m0 < M; m0 += 2 * nw) {
        const int m1 = m0 + nw; const bool has1 = m1 < M;
        const int mm[2] = {m0, has1 ? m1 : m0};
        vf4 v[2][8]; float ss[2] = {0.f, 0.f};
#pragma unroll
        for (int k = 0; k < 2; ++k) {
            const int m = mm[k];
            const float* x = from_in ? (m < MC ? p.in[I_XP] + (size_t)m * DM : p.in[I_XS] + (size_t)(m - MC) * DM) : X + (size_t)m * DM;
#pragma unroll
            for (int i = 0; i < 8; ++i) v[k][i] = *(const vf4*)(x + (i * 64 + lane) * 4);
        }
#pragma unroll
        for (int k = 0; k < 2; ++k) {
#pragma unroll
            for (int i = 0; i < 8; ++i) ss[k] += v[k][i].x * v[k][i].x + v[k][i].y * v[k][i].y + v[k][i].z * v[k][i].z + v[k][i].w * v[k][i].w;
            ss[k] = wave_sum(ss[k]);
        }
#pragma unroll
        for (int k = 0; k < 2; ++k) {
            if (k == 1 && !has1) break;
            const int m = mm[k];
            const float* mv = WSP(float, WS_MODV) + ((size_t)l * NCOND + cond_of_row(m)) * NMOD + (size_t)which * 3 * DM;
            const float r = 1.0f / sqrtf(ss[k] * (1.0f / DM) + EPS);
#pragma unroll
            for (int i = 0; i < 8; ++i) {
                const int c = (i * 64 + lane) * 4;
                const float4 gg = *(const float4*)(g + c), sh = *(const float4*)(mv + c), sc = *(const float4*)(mv + DM + c);
                const float o0 = v[k][i].x * r * gg.x * (1.f + sc.x) + sh.x, o1 = v[k][i].y * r * gg.y * (1.f + sc.y) + sh.y;
                const float o2 = v[k][i].z * r * gg.z * (1.f + sc.z) + sh.z, o3 = v[k][i].w * r * gg.w * (1.f + sc.w) + sh.w;
                if (G1_FP8_MODE && which != 1) *(unsigned*)((unsigned char*)H + (size_t)m * DM + c) = pack4_fp8(o0, o1, o2, o3);
                else { uint2 w; w.x = pack2(o0, o1); w.y = pack2(o2, o3); *(uint2*)(H + (size_t)m * DM + c) = w; }
            }
            if (G2_FP8 && which != 1 && lane < (FFP - FF) / 4) *(unsigned*)(WSP(unsigned char, WS_ACT) + (size_t)m * FFP + FF + 4 * lane) = 0u;
        }
    }
}

__device__ __forceinline__ float red16(float v);
__device__ __forceinline__ float ssq8(vf4 a, vf4 b) { const vf4 s = a * a + b * b; return (s.x + s.y) + (s.z + s.w); }
__device__ __forceinline__ uint4 pack8(vf4 a, vf4 b) { uint4 w; w.x = pack2(a.x, a.y); w.y = pack2(a.z, a.w); w.z = pack2(b.x, b.y); w.w = pack2(b.z, b.w); return w; }
__device__ __forceinline__ void phase_prep(const Params& p, int l) {
    const int tid = opaque_tid(), lane = tid & 63, wv = tid >> 6, rg = lane >> 4, sub = lane & 15, c8 = sub * 8;
    const bf16_t* Z = WSP(bf16_t, WS_Z);
    const float* ropec = WSP(float, WS_ROPE); const float* ropes = ropec + 64 * 32;
    const float* wnq = p.in[I_NAQKN] + ((size_t)l * 2 + 0) * 128 + c8; const float* wnk = wnq + 128;
    const float* wgq = p.in[I_GQAQKN] + ((size_t)l * 2 + 0) * 128 + c8; const float* wgk = wgq + 128;
    const float* cw = p.in[I_CONV] + (size_t)l * 5 * 1536 + rg * 128 + c8;
    const int rpw = (M + (int)gridDim.x * 8 - 1) / ((int)gridDim.x * 8);
    for (int m = ((int)blockIdx.x * 8 + wv) * rpw, mend = (m + rpw < M ? m + rpw : M); m < mend; ++m) {
        const bf16_t* z = Z + (size_t)m * NINP;
        const bool ctx = m < MC;
        const int b = ctx ? m / CT : (m - MC) / LT, t = ctx ? m % CT : (m - MC) % LT, T = ctx ? CT : LT;
        const int ho = rg * 128 + c8;
        uint4 rz[5]; uint2 rgz[2][4];
        {
            const bf16_t* zkv = z + (rg < 2 ? Z_GQK + rg * 128 : Z_GQV + (rg - 2) * 128) + c8;
            rz[0] = *(const uint4*)(z + Z_NAQ + ho); rz[1] = *(const uint4*)(z + Z_NAK + ho); rz[2] = *(const uint4*)(z + Z_NAV + ho); rz[3] = *(const uint4*)(z + Z_GQQ + ho); rz[4] = *(const uint4*)zkv;
#pragma unroll
            for (int dir = 0; dir < 2; ++dir)
#pragma unroll
                for (int r4 = 0; r4 < 4; ++r4) rgz[dir][r4] = *(const uint2*)(z + (dir ? Z_GB : Z_GF) + 4 * r4);
        }
        asm volatile("" ::: "memory");
        {
            vf4 q0, q1, k0, k1, v0, v1, g0, g1, x0, x1;
            unp8bf(rz[0], q0, q1); unp8bf(rz[1], k0, k1); unp8bf(rz[2], v0, v1); unp8bf(rz[3], g0, g1); unp8bf(rz[4], x0, x1);
            float r = 1.0f / sqrtf(red16(ssq8(q0, q1)) * (1.0f / 128) + EPS);
            q0 = q0 * r * *(const vf4*)wnq; q1 = q1 * r * *(const vf4*)(wnq + 4);
            *(uint4*)(WSP(bf16_t, WS_NAQ) + (size_t)m * 512 + ho) = pack8(q0, q1);
            r = 1.0f / sqrtf(red16(ssq8(k0, k1)) * (1.0f / 128) + EPS);
            k0 = k0 * r * *(const vf4*)wnk; k1 = k1 * r * *(const vf4*)(wnk + 4);
            *(uint4*)(WSP(bf16_t, WS_NAK) + (size_t)m * 512 + ho) = pack8(k0, k1);
            *(uint4*)(WSP(bf16_t, WS_NAV) + (size_t)m * 512 + ho) = pack8(v0, v1);
            if (ctx) {
                const size_t o = ((((size_t)b * DEPTH + l) * 4 + rg) * CT + t) * 128 + c8;
                *(vf4*)(p.out + O_NAK + o) = k0; *(vf4*)(p.out + O_NAK + o + 4) = k1; *(vf4*)(p.out + O_NAV + o) = v0; *(vf4*)(p.out + O_NAV + o + 4) = v1;
            }
            r = 1.0f / sqrtf(red16(ssq8(g0, g1)) * (1.0f / 128) + EPS);
            g0 = g0 * r * *(const vf4*)wgq; g1 = g1 * r * *(const vf4*)(wgq + 4);
            const float rk = 1.0f / sqrtf(red16(ssq8(x0, x1)) * (1.0f / 128) + EPS);
            if (rg < 2) { x0 = x0 * rk * *(const vf4*)wgk; x1 = x1 * rk * *(const vf4*)(wgk + 4); }
            if (!ctx) {
                const int pos = sub < 8 ? (t >> 6) : (t & 63), ai = pos * 32 + (c8 & 31);
                const vf4 c0 = *(const vf4*)(ropec + ai), c1 = *(const vf4*)(ropec + ai + 4), s0 = *(const vf4*)(ropes + ai), s1 = *(const vf4*)(ropes + ai + 4);
                const bool hi = (sub & 4) != 0;
                vf4 pg0, pg1, px0, px1;
#pragma unroll
                for (int j = 0; j < 4; ++j) { pg0[j] = __shfl_xor(g0[j], 4); pg1[j] = __shfl_xor(g1[j], 4); px0[j] = __shfl_xor(x0[j], 4); px1[j] = __shfl_xor(x1[j], 4); }
                g0 = hi ? pg0 * s0 + g0 * c0 : g0 * c0 - pg0 * s0; g1 = hi ? pg1 * s1 + g1 * c1 : g1 * c1 - pg1 * s1;
                if (rg < 2) { x0 = hi ? px0 * s0 + x0 * c0 : x0 * c0 - px0 * s0; x1 = hi ? px1 * s1 + x1 * c1 : x1 * c1 - px1 * s1; }
            }
            *(uint4*)(WSP(bf16_t, WS_GQ) + (size_t)m * 512 + ho) = pack8(g0, g1);
            *(uint4*)(WSP(bf16_t, rg < 2 ? WS_GK : WS_GV) + (size_t)m * 256 + (rg & 1) * 128 + c8) = pack8(x0, x1);
            if (ctx) {
                const size_t o = ((((size_t)b * DEPTH + l) * 2 + (rg & 1)) * CT + t) * 128 + c8;
                float* dst = p.out + (rg < 2 ? O_GK : O_GV) + o;
                *(vf4*)dst = x0; *(vf4*)(dst + 4) = x1;
            }
        }
        asm volatile("" ::: "memory");
        {
#pragma unroll
            for (int dir = 0; dir < 2; ++dir) {
                const float* up = p.in[I_GUP] + ((size_t)l * 2 + dir) * 16 * 256 + 4 * lane;
                vf4 acc = *(const vf4*)(p.in[I_GBIAS] + ((size_t)l * 2 + dir) * 256 + 4 * lane);
#pragma unroll
                for (int r4 = 0; r4 < 4; ++r4) {
                    const vf4 gv = unp4bf(rgz[dir][r4]);
                    acc += gv.x * *(const vf4*)(up + (4 * r4 + 0) * 256) + gv.y * *(const vf4*)(up + (4 * r4 + 1) * 256) + gv.z * *(const vf4*)(up + (4 * r4 + 2) * 256) + gv.w * *(const vf4*)(up + (4 * r4 + 3) * 256);
                }
                vf4 o;
#pragma unroll
                for (int j = 0; j < 4; ++j) o[j] = logsigmoid_f(acc[j]) * (1.0f / 16.0f);
                *(vf4*)(WSP(float, dir ? WS_AB : WS_AF) + (size_t)m * 256 + 4 * lane) = o;
            }
        }
        asm volatile("" ::: "memory");
        {
            uint4 rcz[3][5];
#pragma unroll
            for (int part = 0; part < 3; ++part)
#pragma unroll
                for (int j = 0; j < 5; ++j) { const int tt = t + j - 2;
                    rcz[part][j] = (tt >= 0 && tt < T) ? *(const uint4*)(Z + (size_t)(m + j - 2) * NINP + Z_DQKV + part * 512 + rg * 128 + c8) : make_uint4(0u, 0u, 0u, 0u); }
            asm volatile("" ::: "memory");
#pragma unroll
            for (int part = 0; part < 3; ++part) {
                vf4 a0 = (vf4){0.f, 0.f, 0.f, 0.f}, a1 = a0;
#pragma unroll
                for (int j = 0; j < 5; ++j) {
                    const float* cj = cw + j * 1536 + part * 512;
                    vf4 z0, z1; unp8bf(rcz[part][j], z0, z1);
                    a0 += *(const vf4*)cj * z0; a1 += *(const vf4*)(cj + 4) * z1;
                }
#pragma unroll
                for (int j = 0; j < 4; ++j) { a0[j] = silu_f(a0[j]); a1[j] = silu_f(a1[j]); }
                if (part < 2) { const float r = 1.0f / sqrtf(red16(ssq8(a0, a1)) + EPS) * (part == 0 ? 0.08838834764831845f : 1.0f); a0 *= r; a1 *= r; }
                *(uint4*)(WSP(bf16_t, part == 0 ? WS_DQ : part == 1 ? WS_DK : WS_DV) + (size_t)m * 512 + rg * 128 + c8) = pack8(a0, a1);
                asm volatile("" ::: "memory");
            }
            if (lane < 8) {
                const float beta = 1.0f / (1.0f + expf(-bf2f(z[Z_DB + lane])));
                const float g = -expf(p.in[I_ALOG][(size_t)l * 8 + lane]) * softplus_f(bf2f(z[Z_DA + lane]) + p.in[I_DTB][(size_t)l * 8 + lane]);
                float* ba = WSP(float, WS_DBA) + (size_t)m * 16;
                ba[lane] = beta; ba[8 + lane] = g;
            }
        }
    }
}

typedef float vf2 __attribute__((ext_vector_type(2)));
__device__ __forceinline__ float dpp_f(float v, const int ctrl) { return v; }
#define DPPF(v, ctrl) __int_as_float(__builtin_amdgcn_mov_dpp(__float_as_int(v), (ctrl), 0xF, 0xF, true))
__device__ __forceinline__ float red8(float v) { v += DPPF(v, 0xB1); v += DPPF(v, 0x4E); v += DPPF(v, 0x141); return v; }
__device__ __forceinline__ float red16(float v) { v = red8(v); v += DPPF(v, 0x140); return v; }

__device__ __forceinline__ void phase_post(const Params& p, int l) {
    const int tid = opaque_tid(), lane = tid & 63, wv = tid >> 6, rg = lane >> 4, c8 = (lane & 15) * 8;
    const bf16_t* Z = WSP(bf16_t, WS_Z); bf16_t* MRG = WSP(bf16_t, WS_MRG);
    const float* wg = p.in[I_GLAON] + (size_t)l * 128 + c8; const float* wd = p.in[I_GDNON] + (size_t)l * 128 + c8;
    for (int m = blockIdx.x * 8 + wv; m < M; m += gridDim.x * 8) {
        const bf16_t* z = Z + (size_t)m * NINP;
        const int ho = rg * 128 + c8;
#pragma unroll
        for (int g = 0; g < 2; ++g) {
            const float* of = WSP(float, g ? WS_DOF : WS_GOF) + (size_t)m * 512 + ho; const float* ob = WSP(float, g ? WS_DOB : WS_GOB) + (size_t)m * 512 + ho;
            const float* w = g ? wd : wg; const bf16_t* zg = z + (g ? Z_DZ : Z_GLR) + ho;
            vf4 a0 = *(const vf4*)of + *(const vf4*)ob, a1 = *(const vf4*)(of + 4) + *(const vf4*)(ob + 4);
            vf4 g0, g1; ld8bf(zg, g0, g1);
            const float r = 1.0f / sqrtf(red16(ssq8(a0, a1)) * (1.0f / 128) + EPS);
            a0 = a0 * r * *(const vf4*)w; a1 = a1 * r * *(const vf4*)(w + 4);
#pragma unroll
            for (int j = 0; j < 4; ++j) { a0[j] *= silu_f(g0[j]); a1[j] *= silu_f(g1[j]); }
            *(uint4*)(MRG + (size_t)m * DM + (g ? 1536 : 512) + ho) = pack8(a0, a1);
        }
    }
}
#define XB_TMO      128
#define XB_XCNT(j)  (256  + 64 * (j))
#define XB_XSUB(j)  (1280 + 64 * (j))
#define XB_XGEN(j)  (2304 + 64 * (j))
#define XB_TOP      3328
#define XB_TOPGEN   3392
#define XCD_BAR_WORDS 3456
#define XB_SPIN_CAP (1u << 22)
#define LAS __attribute__((address_space(3)))

__device__ __forceinline__ unsigned xb_ld(unsigned* p)              { return __hip_atomic_load(p, __ATOMIC_RELAXED, __HIP_MEMORY_SCOPE_AGENT); }
__device__ __forceinline__ unsigned xb_add(unsigned* p, unsigned v) { return __hip_atomic_fetch_add(p, v, __ATOMIC_RELAXED, __HIP_MEMORY_SCOPE_AGENT); }
__device__ __forceinline__ unsigned xb_xcc_id() { return (unsigned)__builtin_amdgcn_s_getreg((3 << 11) | 20) & 0xFu; }
#define XB_SPIN(cond, bar) do { unsigned _sp = 0; while (cond) { __builtin_amdgcn_s_sleep(1); \
    if ((++_sp & 255u) == 0u) { if (xb_ld(&(bar)[XB_TMO])) break; if (_sp > XB_SPIN_CAP) { atomicAdd(&(bar)[XB_TMO], 1u); break; } } } } while (0)

struct XcdBarrier {
    unsigned* bar; unsigned x;
    volatile LAS unsigned* st;
};

__device__ __forceinline__ XcdBarrier xcd_barrier_post(unsigned* bar, volatile LAS unsigned* st) {
    XcdBarrier b; b.bar = bar; b.x = xb_xcc_id(); b.st = st;
    if (threadIdx.x == 0) (void)xb_add(&bar[XB_XCNT(b.x)], 1u);
    return b;
}
__device__ __forceinline__ void xcd_barrier_complete(unsigned* bar, unsigned x, unsigned& nloc, unsigned& nx) {
    const unsigned G = gridDim.x * gridDim.y * gridDim.z;
    unsigned sum, cnt, mine, sp = 0u;
    for (;;) {
        sum = 0u; cnt = 0u; mine = 0u;
#pragma unroll
        for (unsigned j = 0; j < 16; ++j) { const unsigned c = xb_ld(&bar[XB_XCNT(j)]); sum += c; cnt += (c > 0u) ? 1u : 0u; mine = (j == x) ? c : mine; }
        if (sum == G) break;
        __builtin_amdgcn_s_sleep(1);
        if ((++sp & 255u) == 0u) { if (xb_ld(&bar[XB_TMO])) break; if (sp > XB_SPIN_CAP) { atomicAdd(&bar[XB_TMO], 1u); break; } }
    }
    nloc = mine > 0u ? mine : 1u; nx = cnt > 0u ? cnt : 1u;
}

__device__ __forceinline__ void xcd_barrier(const XcdBarrier& b) {
    asm volatile("s_waitcnt vmcnt(0)" ::: "memory");
    __syncthreads();
    if (threadIdx.x == 0) {
        unsigned* bar = b.bar;
        __builtin_amdgcn_s_waitcnt(0);
        unsigned nloc = b.st[0], nx = b.st[1];
        if (nloc == 0u) { xcd_barrier_complete(bar, b.x, nloc, nx); b.st[0] = nloc; b.st[1] = nx; }
        const unsigned old = xb_add(&bar[XB_XSUB(b.x)], 1u);
        const unsigned gen = old / nloc;
        if (old + 1u == (gen + 1u) * nloc) {
            __builtin_amdgcn_fence(__ATOMIC_RELEASE, "agent");
            asm volatile("s_waitcnt vmcnt(0)" ::: "memory");
            const unsigned og = xb_add(&bar[XB_TOP], 1u);
            const unsigned tg = og / nx;
            if (og + 1u == (tg + 1u) * nx) xb_add(&bar[XB_TOPGEN], 1u);
            else XB_SPIN(xb_ld(&bar[XB_TOPGEN]) == tg, bar);
            __builtin_amdgcn_fence(__ATOMIC_ACQUIRE, "agent");
            xb_add(&bar[XB_XGEN(b.x)], 1u);
            asm volatile("s_waitcnt vmcnt(0)" ::: "memory");
        } else {
            XB_SPIN(xb_ld(&bar[XB_XGEN(b.x)]) == gen, bar);
            __builtin_amdgcn_fence(__ATOMIC_ACQUIRE, "agent");
            asm volatile("s_waitcnt vmcnt(0)" ::: "memory");
        }
    }
    __syncthreads();
}

#ifndef NT_STORES
#define NT_STORES 0
#endif
namespace pg8 {
#define PG8_LAS __attribute__((address_space(3)))
typedef unsigned short bf16_t;
typedef short bf16x8 __attribute__((ext_vector_type(8)));
typedef float f32x4 __attribute__((ext_vector_type(4)));
typedef unsigned u32x4 __attribute__((ext_vector_type(4)));
typedef int v4i32 __attribute__((ext_vector_type(4)));
typedef int v8i32 __attribute__((ext_vector_type(8)));
constexpr int BM = 256, BK = 64, HALF = 128, HTB = HALF * BK * 2  , STAGE_BYTES = 8 * HTB, NXCD = 8, WGM = 8;

__host__ __device__ __forceinline__ int lds_byte(int r, int c) { const int st = (r >> 4) * 2 + (c >> 5), rr = r & 15, cc = c & 31, ob = rr * 64 + cc * 2; return st * 1024 + (ob ^ (((ob >> 9) & 1) << 5)); }
__host__ __device__ __forceinline__ void stage_rc(int b, int& R, int& C) { const int st = b / 1024, sb = b % 1024, swz = sb ^ (((sb >> 9) & 1) << 5); R = (st >> 1) * 16 + swz / 64; C = (st & 1) * 32 + (swz % 64) / 2; }
__host__ __device__ __forceinline__ int perm32(int rho) { const int n = rho >> 4, i = rho & 15; return 8 * (i >> 2) + 4 * n + (i & 3); }

struct Unit { int pm, pn, k0, nt, at, slot, msk; };
struct Gemm { const bf16_t* A; const bf16_t* Bt; int M, N, K; };

struct StaticOrder {
    int nM, nN, nwg, G, c, ntk, split, msplit;
    __host__ __device__ void init(int M, int N, int K, int G_, int c_, int split_ = 0) { nM = M / BM; nN = N / BM; nwg = nM * nN; G = G_; c = c_; ntk = K / BK; const int rem = nwg % G_; split = (split_ == 1 && rem > 0 && 2 * rem == G_ && ntk >= 8) ? 1 : 0; msplit = (split_ == 2 && rem > 0 && 2 * rem <= G_) ? 1 : 0; }
    __host__ __device__ bool next(int i, Unit& u) const {
        long L = (long)i * G + c; u.k0 = 0; u.nt = ntk; u.at = 0; u.slot = 0; u.msk = 3;
        if (msplit && i == nwg / G) { const int rem = nwg % G; if (c >= 2 * rem) return false; L = (long)i * G + (c % rem); u.msk = (c / rem) ? 2 : 1; }
        if (split && i == nwg / G) { const int rem = nwg % G, sl = c / rem, h0 = ((ntk / 2) + 1) & ~1; L = (long)i * G + (c % rem); u.k0 = sl ? h0 * BK : 0; u.nt = sl ? ntk - h0 : h0; u.at = sl ? 1 : 2; u.slot = c % rem; }
        if (L >= nwg) return false;
        int wgid = (int)L; { const int q = nwg / NXCD, r = nwg % NXCD, xcd = wgid % NXCD, off = wgid / NXCD; wgid = (xcd < r ? xcd * (q + 1) : r * (q + 1) + (xcd - r) * q) + off; }
        const int nig = WGM * nN, gid = wgid / nig, fm = gid * WGM, gsz = (nM - fm) < WGM ? (nM - fm) : WGM;
        u.pm = fm + ((wgid % nig) % gsz); u.pn = (wgid % nig) / gsz; return true;
    }
    __device__ __forceinline__ void a_ready(const Unit&) const {}
    __device__ __forceinline__ void done(const Unit&) const {}
};
__device__ __forceinline__ unsigned cvt_pk_bf16(float lo, float hi) { unsigned r; asm volatile("v_cvt_pk_bf16_f32 %0, %1, %2" : "=v"(r) : "v"(lo), "v"(hi)); return r; }
struct EpiF32 {
    static constexpr bool PERM = false, AFTER_DRAIN = false;
    float* C; int ldc; const float* bias;
    __device__ __forceinline__ void operator()(const f32x4 (&acc)[2][2][4][2], const Unit& u, int wr, int wc, int fr, int fq) const {
        const int row0 = u.pm * BM + wr * 64 + fr, col0 = u.pn * BM + wc * 32 + 4 * fq;
        f32x4 bv[2][2];
#pragma unroll
        for (int bj = 0; bj < 2; ++bj)
#pragma unroll
            for (int n = 0; n < 2; ++n) bv[bj][n] = bias ? *(const f32x4*)(bias + col0 + bj * HALF + n * 16) : (f32x4){0.f, 0.f, 0.f, 0.f};
#pragma unroll
        for (int ai = 0; ai < 2; ++ai)
#pragma unroll
            for (int m = 0; m < 4; ++m) { float* rowp = C + (size_t)(row0 + ai * HALF + m * 16) * ldc + col0;
#pragma unroll
                for (int bj = 0; bj < 2; ++bj)
#pragma unroll
                    for (int n = 0; n < 2; ++n) *(f32x4*)(rowp + bj * HALF + n * 16) = acc[ai][bj][m][n] + bv[bj][n]; }
    }
};

struct EpiSwiGLU {
    static constexpr bool PERM = true, AFTER_DRAIN = false;
    bf16_t* O; int ldc;
    __device__ __forceinline__ void operator()(const f32x4 (&acc)[2][2][4][2], const Unit& u, int wr, int wc, int fr, int fq) const {
        const int row0 = u.pm * BM + wr * 64 + fr, col0 = u.pn * 128 + wc * 32 + 8 * fq;
#pragma unroll
        for (int ai = 0; ai < 2; ++ai) if ((u.msk >> ai) & 1)
#pragma unroll
            for (int m = 0; m < 4; ++m) { bf16_t* rowp = O + (size_t)(row0 + ai * HALF + m * 16) * ldc + col0;
                const f32x4 g0 = acc[ai][0][m][0], g1 = acc[ai][0][m][1], u0 = acc[ai][1][m][0], u1 = acc[ai][1][m][1];
                float r[8];
#pragma unroll
                for (int j = 0; j < 4; ++j) {
                    r[j]     = g0[j] * __builtin_amdgcn_rcpf(1.0f + __builtin_amdgcn_exp2f(-1.4426950408889634f * g0[j])) * u0[j];
                    r[4 + j] = g1[j] * __builtin_amdgcn_rcpf(1.0f + __builtin_amdgcn_exp2f(-1.4426950408889634f * g1[j])) * u1[j]; }
                u32x4 w; w.x = cvt_pk_bf16(r[0], r[1]); w.y = cvt_pk_bf16(r[2], r[3]); w.z = cvt_pk_bf16(r[4], r[5]); w.w = cvt_pk_bf16(r[6], r[7]);
#if NT_STORES
                __builtin_nontemporal_store(w, (u32x4*)rowp);
#else
                *(u32x4*)rowp = w;
#endif
                }
    }
};
struct EpiSwiGLU8 {
    static constexpr bool PERM = true, AFTER_DRAIN = false;
    unsigned char* O; int ldc; float wscale;
    __device__ __forceinline__ void operator()(const f32x4 (&acc)[2][2][4][2], const Unit& u, int wr, int wc, int fr, int fq) const {
        const int row0 = u.pm * BM + wr * 64 + fr, col0 = u.pn * 128 + wc * 32 + 8 * fq;
#pragma unroll
        for (int ai = 0; ai < 2; ++ai) if ((u.msk >> ai) & 1)
#pragma unroll
            for (int m = 0; m < 4; ++m) { unsigned char* rowp = O + (size_t)(row0 + ai * HALF + m * 16) * ldc + col0;
                const f32x4 g0 = acc[ai][0][m][0] * wscale, g1 = acc[ai][0][m][1] * wscale, u0 = acc[ai][1][m][0] * wscale, u1 = acc[ai][1][m][1] * wscale;
                float r[8];
#pragma unroll
                for (int j = 0; j < 4; ++j) {
                    r[j]     = g0[j] * __builtin_amdgcn_rcpf(1.0f + __builtin_amdgcn_exp2f(-1.4426950408889634f * g0[j])) * u0[j];
                    r[4 + j] = g1[j] * __builtin_amdgcn_rcpf(1.0f + __builtin_amdgcn_exp2f(-1.4426950408889634f * g1[j])) * u1[j]; }
                uint2 w; w.x = pack4_fp8(r[0], r[1], r[2], r[3]); w.y = pack4_fp8(r[4], r[5], r[6], r[7]);
                *(uint2*)rowp = w; asm volatile("" ::: "memory"); }
    }
};
struct EpiBf16Plain {
    static constexpr bool PERM = true, AFTER_DRAIN = false;
    bf16_t* O; int ldc;
    __device__ __forceinline__ void operator()(const f32x4 (&acc)[2][2][4][2], const Unit& u, int wr, int wc, int fr, int fq) const {
        const int row0 = u.pm * BM + wr * 64 + fr, col0 = u.pn * BM + wc * 32 + 8 * fq;
#pragma unroll
        for (int ai = 0; ai < 2; ++ai) if ((u.msk >> ai) & 1)
#pragma unroll
            for (int m = 0; m < 4; ++m) { bf16_t* rowp = O + (size_t)(row0 + ai * HALF + m * 16) * ldc + col0;
#pragma unroll
                for (int bj = 0; bj < 2; ++bj) { const f32x4 v0 = acc[ai][bj][m][0], v1 = acc[ai][bj][m][1];
                    u32x4 w; w.x = cvt_pk_bf16(v0[0], v0[1]); w.y = cvt_pk_bf16(v0[2], v0[3]); w.z = cvt_pk_bf16(v1[0], v1[1]); w.w = cvt_pk_bf16(v1[2], v1[3]);
                    *(u32x4*)(rowp + bj * HALF) = w; } }
    }
};
struct EpiResid {
    static constexpr bool PERM = false, AFTER_DRAIN = false;
    const float* res; float* out; int ldc; const float* gate0; float coef;
    float* slab; unsigned* flags; unsigned target;
    const float* res_hi; int row_hi;
    __device__ __forceinline__ void operator()(const f32x4 (&acc)[2][2][4][2], const Unit& u, int wr, int wc, int fr, int fq) const {
        const int tidx = ((wr * 4 + wc) * 4 + fq) * 16 + fr;
        if (u.at == 1) {
            const __amdgpu_buffer_rsrc_t rs = __builtin_amdgcn_make_buffer_rsrc((void*)slab, 0, 0x7FFFFFF0, 0x00020000);
            const unsigned base = ((unsigned)u.slot * 32u * 512u + (unsigned)tidx) * 16u;
#pragma unroll
            for (int ai = 0; ai < 2; ++ai)
#pragma unroll
                for (int bj = 0; bj < 2; ++bj)
#pragma unroll
                    for (int m = 0; m < 4; ++m)
#pragma unroll
                        for (int n = 0; n < 2; ++n) { const f32x4 v = acc[ai][bj][m][n]; u32x4 w; w.x = __float_as_uint(v[0]); w.y = __float_as_uint(v[1]); w.z = __float_as_uint(v[2]); w.w = __float_as_uint(v[3]);
                            __builtin_amdgcn_raw_buffer_store_b128(w, rs, base + (unsigned)((((ai * 2 + bj) * 4 + m) * 2 + n) * 512 * 16), 0, 16); }
            asm volatile("s_waitcnt vmcnt(0)" ::: "memory");
            if ((tidx & 63) == 0) __hip_atomic_fetch_add(flags + 64 * u.slot, 1u, __ATOMIC_RELAXED, __HIP_MEMORY_SCOPE_AGENT);
            return;
        }
        const float* part = nullptr;
        if (u.at == 2) {
            unsigned spins = 0;
            while (__hip_atomic_load(flags + 64 * u.slot, __ATOMIC_RELAXED, __HIP_MEMORY_SCOPE_AGENT) < target) { __builtin_amdgcn_s_sleep(2); if (++spins > (1u << 22)) break; }
            __builtin_amdgcn_fence(__ATOMIC_ACQUIRE, "agent");
            asm volatile("s_waitcnt vmcnt(0)" ::: "memory");
            part = slab + ((size_t)u.slot * 32 * 512 + tidx) * 4;
        }
        const int row0 = u.pm * BM + wr * 64 + fr, col0 = u.pn * BM + wc * 32 + 4 * fq;
        const float* gate = gate0 + (size_t)cond_of_row(u.pm * BM) * NMOD;
        const float* rbase = (u.pm * BM >= row_hi) ? res_hi - (size_t)row_hi * ldc : res;
        f32x4 gv[2][2];
#pragma unroll
        for (int bj = 0; bj < 2; ++bj)
#pragma unroll
            for (int n = 0; n < 2; ++n) gv[bj][n] = *(const f32x4*)(gate + col0 + bj * HALF + n * 16) * coef;
#pragma unroll
        for (int ai = 0; ai < 2; ++ai) if ((u.msk >> ai) & 1)
#pragma unroll
            for (int m = 0; m < 4; ++m) { const size_t off = (size_t)(row0 + ai * HALF + m * 16) * ldc + col0;
#pragma unroll
                for (int bj = 0; bj < 2; ++bj)
#pragma unroll
                    for (int n = 0; n < 2; ++n) {
                        f32x4 a = acc[ai][bj][m][n];
                        if (part) a += *(const f32x4*)(part + (size_t)((((ai * 2 + bj) * 4 + m) * 2 + n) * 512 * 4));
                        const f32x4 bs = *(const f32x4*)(rbase + off + bj * HALF + n * 16); *(f32x4*)(out + off + bj * HALF + n * 16) = bs + gv[bj][n] * a; }
                asm volatile("" ::: "memory"); }
    }
};
template <class Epi, class Sched, bool STAMP = false, int FP8 = 0>
__device__ __forceinline__ void gemm_phase(PG8_LAS unsigned char* lds, const Gemm g, const Sched& S, const Epi& E, unsigned long long* stamps) {
    const int tid = opaque_tid(), wid = __builtin_amdgcn_readfirstlane(tid >> 6), lane = tid & 63, wr = wid >> 2, wc = wid & 3, fr = lane & 15, fq = lane >> 4;
    const int K = g.K;
    int ts_lo = 0, ts_hi = 0, nts = 0; const unsigned long long rt_entry = STAMP ? (unsigned long long)wall_clock64() : 0ull;
#define PG8_STAMP() do { if (STAMP && wid == 0 && nts < 64) { const unsigned long long _c = (unsigned long long)clock64(); \
        ts_lo = (lane == nts) ? (int)(unsigned)_c : ts_lo; ts_hi = (lane == nts) ? (int)(unsigned)(_c >> 32) : ts_hi; ++nts; } } while (0)
    PG8_STAMP();
    unsigned voffA[2], voffB[2];
#pragma unroll
    for (int i = 0; i < 2; ++i) { int R, C; stage_rc(tid * 16 + i * 8192, R, C); const int Rb = Epi::PERM ? ((R & ~31) + perm32(R & 31)) : R;
        voffA[i] = (unsigned)(R * K + C) * 2u; voffB[i] = (unsigned)(Rb * K + C) * 2u; }
    const size_t kstep = (size_t)(BK * 2);
    const size_t hstep = (size_t)HALF * K * 2;
    const size_t tstep = 2 * hstep;
    const unsigned ldsw = (unsigned)wid * 1024u;
    const int aoff = lds_byte(wr * 64 + fr, fq * 8), boff = lds_byte(wc * 32 + fr, fq * 8);
#define PG8_SA(b, h) (((b) * 2 + (h)) * HTB)
#define PG8_SB(b, h) ((4 + (b) * 2 + (h)) * HTB)
#define PG8_STAGE(bufoff, gbase, voff) do { _Pragma("unroll") for (int _i = 0; _i < 2; ++_i) \
        __builtin_amdgcn_global_load_lds((const unsigned*)((const char*)(gbase) + (voff)[_i]), (PG8_LAS unsigned*)(lds + (bufoff) + ldsw + _i * 8192), 16, 0, 0); } while (0)
#define PG8_LDA(dst, b, h) do { _Pragma("unroll") for (int m = 0; m < 4; ++m) dst[m] = __builtin_shufflevector(*(const PG8_LAS v4i32*)(lds + PG8_SA(b, h) + aoff + m * 2048), *(const PG8_LAS v4i32*)(lds + PG8_SA(b, h) + aoff + m * 2048 + 1024), 0, 1, 2, 3, 4, 5, 6, 7); } while (0)
#define PG8_LDB(dst, b, h) do { _Pragma("unroll") for (int n = 0; n < 2; ++n) dst[n] = __builtin_shufflevector(*(const PG8_LAS v4i32*)(lds + PG8_SB(b, h) + boff + n * 2048), *(const PG8_LAS v4i32*)(lds + PG8_SB(b, h) + boff + n * 2048 + 1024), 0, 1, 2, 3, 4, 5, 6, 7); } while (0)
#define PG8_HALF(v, k) __builtin_bit_cast(bf16x8, __builtin_shufflevector(v, v, 4 * (k), 4 * (k) + 1, 4 * (k) + 2, 4 * (k) + 3))
#define PG8_MMA(ai, bj, At, Bt) do { __builtin_amdgcn_s_setprio(1); _Pragma("unroll") for (int m = 0; m < 4; ++m) _Pragma("unroll") for (int n = 0; n < 2; ++n) { \
        acc[ai][bj][m][n] = __builtin_amdgcn_mfma_f32_16x16x32_bf16(PG8_HALF(Bt[n], 0), PG8_HALF(At[m], 0), acc[ai][bj][m][n], 0, 0, 0); \
        acc[ai][bj][m][n] = __builtin_amdgcn_mfma_f32_16x16x32_bf16(PG8_HALF(Bt[n], 1), PG8_HALF(At[m], 1), acc[ai][bj][m][n], 0, 0, 0); } __builtin_amdgcn_s_setprio(0); } while (0)
#define PG8_MMA8(ai, bj, At, Bt) do { __builtin_amdgcn_s_setprio(1); _Pragma("unroll") for (int m = 0; m < 4; ++m) _Pragma("unroll") for (int n = 0; n < 2; ++n) \
        acc[ai][bj][m][n] = __builtin_amdgcn_mfma_scale_f32_16x16x128_f8f6f4(Bt[n], At[m], acc[ai][bj][m][n], 0, 0, 0, 127, 0, 127); __builtin_amdgcn_s_setprio(0); } while (0)
#define PG8_Q64(v, q) __builtin_bit_cast(long, __builtin_shufflevector(v, v, 2 * (q), 2 * (q) + 1))
#define PG8_M8L1(ai, bj, m, n, q) acc[ai][bj][m][n] = __builtin_amdgcn_mfma_f32_16x16x32_fp8_fp8(PG8_Q64(Bt_[n], q), PG8_Q64(At_[m], q), acc[ai][bj][m][n], 0, 0, 0)
#define PG8_MMA8L(ai, bj, At, Bt) do { auto& At_ = At; auto& Bt_ = Bt; __builtin_amdgcn_s_setprio(1); _Pragma("unroll") for (int m = 0; m < 4; ++m) _Pragma("unroll") for (int n = 0; n < 2; ++n) { \
        PG8_M8L1(ai, bj, m, n, 0); PG8_M8L1(ai, bj, m, n, 1); PG8_M8L1(ai, bj, m, n, 2); PG8_M8L1(ai, bj, m, n, 3); } __builtin_amdgcn_s_setprio(0); } while (0)
#define PG8_MMAG(ai, bj, At, Bt) do { if (mrow & (1 << (ai))) { if constexpr (FP8 == 1) PG8_MMA8(ai, bj, At, Bt); else if constexpr (FP8 == 2) PG8_MMA8L(ai, bj, At, Bt); else PG8_MMA(ai, bj, At, Bt); } } while (0)
#define PG8_WAIT_V(n) asm volatile("s_waitcnt vmcnt(" #n ")" ::: "memory")
#define PG8_WAIT_L(n) asm volatile("s_waitcnt lgkmcnt(" #n ")" ::: "memory")
#define PG8_BAR __builtin_amdgcn_s_barrier()
#define PG8_SCHED __builtin_amdgcn_sched_barrier(0)
    Unit cur, nxt; int ui = 0;
    if (!S.next(0, cur)) return;
    f32x4 acc[2][2][4][2];
#pragma unroll
    for (int a = 0; a < 2; ++a)
#pragma unroll
        for (int b = 0; b < 2; ++b)
#pragma unroll
            for (int m = 0; m < 4; ++m)
#pragma unroll
                for (int n = 0; n < 2; ++n) acc[a][b][m][n] = (f32x4){0.f, 0.f, 0.f, 0.f};
    v8i32 At[4], B0[2], B1[2];
    const char* cA = (const char*)g.A + (size_t)cur.pm * tstep + (size_t)cur.k0 * 2; const char* cB = (const char*)g.Bt + (size_t)cur.pn * tstep + (size_t)cur.k0 * 2;
    S.a_ready(cur);
    PG8_STAGE(PG8_SB(0, 0), cB, voffB); PG8_STAGE(PG8_SA(0, 0), cA, voffA); PG8_STAGE(PG8_SB(0, 1), cB + hstep, voffB); PG8_STAGE(PG8_SA(0, 1), cA + hstep, voffA);
    if (wr == 1) PG8_BAR;
    PG8_WAIT_V(4); PG8_BAR;
    PG8_STAGE(PG8_SB(1, 0), cB + kstep, voffB); PG8_STAGE(PG8_SA(1, 0), cA + kstep, voffA); PG8_STAGE(PG8_SB(1, 1), cB + hstep + kstep, voffB);
    PG8_WAIT_V(6); PG8_BAR;
    PG8_STAMP();
    for (;;) {
        const bool has_next = S.next(ui + 1, nxt);
        const char* nA = has_next ? (const char*)g.A + (size_t)nxt.pm * tstep + (size_t)nxt.k0 * 2 : cA; const char* nB = has_next ? (const char*)g.Bt + (size_t)nxt.pn * tstep + (size_t)nxt.k0 * 2 : cB;
        const int nt = cur.nt, mrow = cur.msk;
        for (int t = 0; t < nt; t += 2) {
            const bool last = (t == nt - 2);
            const char* a1 = cA + (size_t)(t + 1) * kstep;
            const char* a2 = last ? nA : cA + (size_t)(t + 2) * kstep; const char* b2 = last ? nB : cB + (size_t)(t + 2) * kstep;
            const char* a3 = a2 + kstep; const char* b3 = b2 + kstep;
            if (last && has_next) S.a_ready(nxt);
            PG8_LDB(B0, 0, 0); PG8_SCHED; PG8_LDA(At, 0, 0); PG8_STAGE(PG8_SA(1, 1), a1 + hstep, voffA);
            PG8_WAIT_L(8); PG8_BAR; PG8_WAIT_L(0); PG8_MMAG(0, 0, At, B0); PG8_BAR; PG8_SCHED;
            PG8_LDB(B1, 0, 1); PG8_STAGE(PG8_SB(0, 0), b2, voffB);
            PG8_BAR; PG8_WAIT_L(0); PG8_MMAG(0, 1, At, B1); PG8_BAR;
            PG8_LDA(At, 0, 1); PG8_STAGE(PG8_SA(0, 0), a2, voffA);
            PG8_BAR; PG8_WAIT_L(0); PG8_MMAG(1, 0, At, B0); PG8_BAR; PG8_SCHED;
            PG8_STAGE(PG8_SB(0, 1), b2 + hstep, voffB);
            PG8_WAIT_V(6); PG8_BAR; PG8_MMAG(1, 1, At, B1); PG8_BAR;
            PG8_LDB(B0, 1, 0); PG8_SCHED; PG8_LDA(At, 1, 0); PG8_STAGE(PG8_SA(0, 1), a2 + hstep, voffA);
            PG8_WAIT_L(8); PG8_BAR; PG8_WAIT_L(0); PG8_MMAG(0, 0, At, B0); PG8_BAR; PG8_SCHED;
            PG8_LDB(B1, 1, 1); PG8_STAGE(PG8_SB(1, 0), b3, voffB);
            PG8_BAR; PG8_WAIT_L(0); PG8_MMAG(0, 1, At, B1); PG8_BAR;
            PG8_LDA(At, 1, 1); PG8_STAGE(PG8_SA(1, 0), a3, voffA);
            PG8_BAR; PG8_WAIT_L(0); PG8_MMAG(1, 0, At, B0); PG8_BAR; PG8_SCHED;
            PG8_STAGE(PG8_SB(1, 1), b3 + hstep, voffB);
            PG8_WAIT_V(6); PG8_BAR; PG8_MMAG(1, 1, At, B1); PG8_BAR;
        }
        PG8_STAMP();
        if constexpr (!Epi::AFTER_DRAIN) { E(acc, cur, wr, wc, fr, fq); S.done(cur); }
        PG8_STAMP();
        if (!has_next) break;
#pragma unroll
        for (int a = 0; a < 2; ++a)
#pragma unroll
            for (int b = 0; b < 2; ++b)
#pragma unroll
                for (int m = 0; m < 4; ++m)
#pragma unroll
                    for (int n = 0; n < 2; ++n) acc[a][b][m][n] = (f32x4){0.f, 0.f, 0.f, 0.f};
        cur = nxt; cA = nA; cB = nB; ++ui;
    }
    PG8_WAIT_V(0);
    if (wr == 0) PG8_BAR;
    PG8_BAR;
    if constexpr (Epi::AFTER_DRAIN) { E.fused(acc, cur, wr, wc, fr, fq, lds, wid, lane); S.done(cur); }
    PG8_STAMP();
    if (STAMP && wid == 0) { stamps[lane] = lane < nts ? (((unsigned long long)(unsigned)ts_hi << 32) | (unsigned)ts_lo) : 0ull;
        if (lane == 62) stamps[62] = rt_entry; if (lane == 63) stamps[63] = (unsigned long long)wall_clock64(); }
#undef PG8_STAMP
#undef PG8_SA
#undef PG8_SB
#undef PG8_STAGE
#undef PG8_LDA
#undef PG8_LDB
#undef PG8_HALF
#undef PG8_MMA
#undef PG8_MMA8
#undef PG8_MMA8L
#undef PG8_M8L1
#undef PG8_Q64
#undef PG8_MMAG
#undef PG8_WAIT_V
#undef PG8_WAIT_L
#undef PG8_BAR
#undef PG8_SCHED
}
}
#ifndef ATT_INLINE
#define ATT_INLINE __forceinline__
#endif
namespace att {
constexpr int D = 128, NW = 8, QBLK = 32, KVBLK = 64, LDQ = 512, LDO = DM;
constexpr float SCALE = 0.088388347648318440f;
constexpr float THR = 8.f;
constexpr size_t SHM_V = KVBLK * D * 2, SHM_K = KVBLK * D * 2, SHM_Q = 256 * D * 2, SHM_ATTN = 2 * SHM_V + 2 * SHM_K + NW * 64 * 4 + SHM_Q;
using bf16x8 = __attribute__((ext_vector_type(8))) short;
using s16x4  = __attribute__((ext_vector_type(4))) short;
using f32x16 = __attribute__((ext_vector_type(16))) float;
using u32x4  = __attribute__((ext_vector_type(4))) unsigned;
#define KSWZ(row, colB) ((row) * 256 + ((colB) ^ (((row) & 7) << 4)))
#define SBAR() __builtin_amdgcn_sched_barrier(0)
__device__ __forceinline__ int crow(int r, int hi) { return (r & 3) + 8 * (r >> 2) + 4 * hi; }
__device__ __forceinline__ unsigned cvtpk(float lo, float hi) { unsigned r; asm volatile("v_cvt_pk_bf16_f32 %0, %1, %2" : "=v"(r) : "v"(lo), "v"(hi)); return r; }

__device__ __forceinline__ void partialSM(f32x16& p0, f32x16& p1, float& m_reg, float& mn, float& alpha) {
  constexpr float C = SCALE * 1.4426950408889634f;
  float pmax = p0[0]; for (int r = 1; r < 16; ++r) pmax = fmaxf(pmax, p0[r]); for (int r = 0; r < 16; ++r) pmax = fmaxf(pmax, p1[r]);
  { auto rr = __builtin_amdgcn_permlane32_swap(__float_as_uint(pmax), __float_as_uint(pmax), false, false);
    pmax = fmaxf(__uint_as_float(rr[0]), __uint_as_float(rr[1])); }
  if (__builtin_expect(__all(pmax - m_reg <= THR / SCALE), 1)) { mn = m_reg; alpha = 1.f; }
  else { mn = fmaxf(m_reg, pmax); alpha = __builtin_amdgcn_exp2f((m_reg - mn) * C); m_reg = mn; }
  float mnC = -mn * C;
  for (int r = 0; r < 16; ++r) p0[r] = fmaf(p0[r], C, mnC); for (int r = 0; r < 16; ++r) p1[r] = fmaf(p1[r], C, mnC);
  for (int r = 0; r < 16; ++r) p0[r] = __builtin_amdgcn_exp2f(p0[r]);
}
__device__ __forceinline__ void finishSM(f32x16& p0, f32x16& p1, float alpha, float& l_reg, bf16x8& pa0, bf16x8& pa1, bf16x8& pa2, bf16x8& pa3) {
  for (int r = 0; r < 16; ++r) p1[r] = __builtin_amdgcn_exp2f(p1[r]);
  float ps = 0; for (int r = 0; r < 16; ++r) ps += p0[r]; for (int r = 0; r < 16; ++r) ps += p1[r];
  { auto rr = __builtin_amdgcn_permlane32_swap(__float_as_uint(ps), __float_as_uint(ps), false, false);
    ps = __uint_as_float(rr[0]) + __uint_as_float(rr[1]); }
  l_reg = l_reg * alpha + ps;
#define PK4(P, BASE, OUT) do { unsigned a0 = cvtpk(P[BASE + 0], P[BASE + 1]), a1 = cvtpk(P[BASE + 2], P[BASE + 3]);   \
    unsigned b0 = cvtpk(P[BASE + 4], P[BASE + 5]), b1 = cvtpk(P[BASE + 6], P[BASE + 7]);                              \
    auto r0 = __builtin_amdgcn_permlane32_swap(a0, b0, false, false); auto r1 = __builtin_amdgcn_permlane32_swap(a1, b1, false, false); \
    u32x4 w = {r0[0], r1[0], r0[1], r1[1]}; OUT = *reinterpret_cast<bf16x8*>(&w); } while (0)
  PK4(p0, 0, pa0); PK4(p0, 8, pa1); PK4(p1, 0, pa2); PK4(p1, 8, pa3);
#undef PK4
}
__device__ __forceinline__ void qkt(f32x16& p0, f32x16& p1, const bf16_t* Ks, const bf16_t* Qs, int qrow, int r32, int hi) {
  p0 = f32x16{}; p1 = f32x16{};
#pragma unroll
  for (int d0 = 0; d0 < 8; ++d0) { int cb = (d0 * 16 + hi * 8) * 2;
    bf16x8 q = *reinterpret_cast<const bf16x8*>((const char*)Qs + KSWZ(qrow, cb));
    bf16x8 b0 = *reinterpret_cast<const bf16x8*>((const char*)Ks + KSWZ(r32, cb));
    bf16x8 b1 = *reinterpret_cast<const bf16x8*>((const char*)Ks + KSWZ(32 + r32, cb));
    p0 = __builtin_amdgcn_mfma_f32_32x32x16_bf16(b0, q, p0, 0, 0, 0);
    p1 = __builtin_amdgcn_mfma_f32_32x32x16_bf16(b1, q, p1, 0, 0, 0); }
}
__device__ __forceinline__ int v_st(int k, int c) { const int kk = (k & ~0xC) | ((k & 4) << 1) | ((k & 8) >> 1); return ((kk >> 3) * 4 + (c >> 5)) * 512 + ((kk & 7) * 32 + (c & 31)) * 2; }
__device__ __forceinline__ int v_rd_base(int lane) { return ((lane & 3) << 3) | (((lane >> 2) & 3) << 6) | (((lane >> 4) & 1) << 5) | (((lane >> 5) & 1) << 8); }
constexpr int v_rd_off(int d0, int ks, int half) { return d0 * 512 + ks * 4096 + half * 2048; }
template <int OFF> __device__ __forceinline__ s16x4 tr_read(int vb) {
  s16x4 r; asm volatile("ds_read_b64_tr_b16 %0, %1 offset:%2" : "=&v"(r) : "v"(vb), "i"(OFF) : "memory"); return r;
}
template <int D0> __device__ __forceinline__ void pv_one(f32x16& od, int vb, bf16x8 pa0, bf16x8 pa1, bf16x8 pa2, bf16x8 pa3) {
  const s16x4 l0 = tr_read<v_rd_off(D0, 0, 0)>(vb), h0 = tr_read<v_rd_off(D0, 0, 1)>(vb), l1 = tr_read<v_rd_off(D0, 1, 0)>(vb), h1 = tr_read<v_rd_off(D0, 1, 1)>(vb);
  const s16x4 l2 = tr_read<v_rd_off(D0, 2, 0)>(vb), h2 = tr_read<v_rd_off(D0, 2, 1)>(vb), l3 = tr_read<v_rd_off(D0, 3, 0)>(vb), h3 = tr_read<v_rd_off(D0, 3, 1)>(vb);
  asm volatile("s_waitcnt lgkmcnt(0)" ::: "memory"); SBAR();
#define PK(L, H) (bf16x8){L[0], L[1], L[2], L[3], H[0], H[1], H[2], H[3]}
  od = __builtin_amdgcn_mfma_f32_32x32x16_bf16(pa0, PK(l0, h0), od, 0, 0, 0);
  od = __builtin_amdgcn_mfma_f32_32x32x16_bf16(pa1, PK(l1, h1), od, 0, 0, 0);
  od = __builtin_amdgcn_mfma_f32_32x32x16_bf16(pa2, PK(l2, h2), od, 0, 0, 0);
  od = __builtin_amdgcn_mfma_f32_32x32x16_bf16(pa3, PK(l3, h3), od, 0, 0, 0);
#undef PK
}
__device__ __forceinline__ void pv_d0(f32x16* o, int vb, bf16x8 pa0, bf16x8 pa1, bf16x8 pa2, bf16x8 pa3) {
  pv_one<0>(o[0], vb, pa0, pa1, pa2, pa3); pv_one<1>(o[1], vb, pa0, pa1, pa2, pa3); pv_one<2>(o[2], vb, pa0, pa1, pa2, pa3); pv_one<3>(o[3], vb, pa0, pa1, pa2, pa3);
}

struct SrcOne { const bf16_t* k0; const bf16_t* v0; int ldk;
  __device__ __forceinline__ const bf16_t* k(int j) const { return k0 + (size_t)j * 64 * ldk; }
  __device__ __forceinline__ const bf16_t* v(int j) const { return v0 + (size_t)j * 64 * ldk; } };
struct SrcTwo { const bf16_t* ck; const bf16_t* cv; const bf16_t* k1; const bf16_t* v1; int ldk;
  __device__ __forceinline__ const bf16_t* k(int j) const { return j < 4 ? ck + (size_t)j * 64 * ldk : k1 + (size_t)(j - 4) * 64 * ldk; }
  __device__ __forceinline__ const bf16_t* v(int j) const { return j < 4 ? cv + (size_t)j * 64 * ldk : v1 + (size_t)(j - 4) * 64 * ldk; } };
struct NoBias { __device__ __forceinline__ void operator()(f32x16&, f32x16&, int, int, int, int) const {} };
struct NaBias { const float* tab; int i0, kr0;
  __device__ __forceinline__ void operator()(f32x16& p0, f32x16& p1, int jt, int wid, int r32, int hi) const {
    if (jt < 4) return;
    const int qi = i0 + wid * QBLK + r32, r = qi >> 6, qc = qi & 63, kr = kr0 + jt - 4;
    int lo = r - 4; lo = lo < 0 ? 0 : (lo > 8 ? 8 : lo);
    const bool rowok = (kr >= lo) && (kr < lo + 8);
    if (!rowok) {
#pragma unroll
      for (int rr = 0; rr < 16; ++rr) { p0[rr] = -1e30f; p1[rr] = -1e30f; }
      return;
    }
    int c0 = qc - 8; c0 = c0 < 0 ? 0 : (c0 > 48 ? 48 : c0);
    const int dr = kr - r + 7;
    const float* tb = tab + dr * 31 + (4 * hi - qc + 15);
    const int w0 = 4 * hi - c0;
#pragma unroll
    for (int g = 0; g < 4; ++g) {
#pragma unroll
      for (int q = 0; q < 4; ++q) {
        const int rr = 4 * g + q, kc0 = q + 8 * g;
        const float t0 = tb[kc0], t1 = tb[kc0 + 32];
        p0[rr] = ((unsigned)(kc0 + w0) < 16u) ? p0[rr] + t0 : -1e30f;
        p1[rr] = ((unsigned)(kc0 + 32 + w0) < 16u) ? p1[rr] + t1 : -1e30f;
      }
      SBAR();
    }
  } };

template <int SD, class Src, class Bias>
__device__ ATT_INLINE void attn_body(const bf16_t* __restrict__ Qb, const Src src, bf16_t* __restrict__ Ob, const int NT, char* lds, const Bias bias) {
  const int tid = opaque_tid(), wid = tid >> 6, lane = tid & 63, r32 = lane & 31, hi = lane >> 5;
  const int LDK = src.ldk;
  bf16_t* V_lds = (bf16_t*)lds; bf16_t* K_lds = (bf16_t*)(lds + 2 * SHM_V);
  float* ws = (float*)(lds + 2 * SHM_V + 2 * SHM_K) + wid * 64; float* li_l = ws; float* al_l = ws + 32;
  float m_reg = -1e30f, l_reg = 0; f32x16 o[4] = {};
  bf16_t* Q_lds = (bf16_t*)(lds + 2 * SHM_V + 2 * SHM_K + NW * 64 * 4);
  const int qrow = wid * QBLK + r32;
  {
#pragma unroll
    for (int i = 0; i < 8; ++i) { const int f = tid + 512 * i, row = f >> 4, c8 = (f & 15) * 8;
      *(bf16x8*)((char*)Q_lds + KSWZ(row, c8 * 2)) = *reinterpret_cast<const bf16x8*>(Qb + (long)row * LDQ + c8); }
  }
  const int sr = tid >> 4, sc = (tid & 15) * 8, vst0 = v_st(sr, sc), vst1 = v_st(32 + sr, sc);
  const int vb0 = (int)(uintptr_t)V_lds + v_rd_base(lane);
  struct { bf16x8 vs0, vs1, ks0, ks1; } sr_[SD];
#define SLOAD(i, jt) do { const bf16_t* kt_ = src.k(jt); const bf16_t* vt_ = src.v(jt); \
    sr_[i].vs0 = *reinterpret_cast<const bf16x8*>(&vt_[(long)sr * LDK + sc]); sr_[i].vs1 = *reinterpret_cast<const bf16x8*>(&vt_[(long)(32 + sr) * LDK + sc]); \
    sr_[i].ks0 = *reinterpret_cast<const bf16x8*>(&kt_[(long)sr * LDK + sc]); sr_[i].ks1 = *reinterpret_cast<const bf16x8*>(&kt_[(long)(32 + sr) * LDK + sc]); } while (0)
#define SWRITE(b, i) do { *(bf16x8*)((char*)V_lds + (b) * SHM_V + vst0) = sr_[i].vs0;          \
    *(bf16x8*)((char*)V_lds + (b) * SHM_V + vst1) = sr_[i].vs1; int kc = sc * 2;               \
    *(bf16x8*)((char*)K_lds + (b) * SHM_K + KSWZ(sr, kc)) = sr_[i].ks0;                       \
    *(bf16x8*)((char*)K_lds + (b) * SHM_K + KSWZ(32 + sr, kc)) = sr_[i].ks1; } while (0)
#define SWAIT() do { if constexpr (SD == 2) asm volatile("s_waitcnt vmcnt(4)" ::: "memory"); else asm volatile("s_waitcnt vmcnt(0)" ::: "memory"); } while (0)
#define RESC(a) do { if (__any((a) < 1.f)) { if (hi == 0) al_l[r32] = (a); asm volatile("s_waitcnt lgkmcnt(0)" ::: "memory"); \
    for (int d = 0; d < 4; ++d) for (int r = 0; r < 16; ++r) o[d][r] *= al_l[crow(r, hi)]; } } while (0)
  f32x16 pA0, pA1, pB0, pB1; float mnA, mnB, alA, alB; bf16x8 pa0, pa1, pa2, pa3;
  constexpr int SE = 0, SO = SD - 1;
  SLOAD(SE, 0); asm volatile("s_waitcnt vmcnt(0)" ::: "memory"); SWRITE(0, SE); __syncthreads();
  qkt(pA0, pA1, K_lds, Q_lds, qrow, r32, hi); bias(pA0, pA1, 0, wid, r32, hi); partialSM(pA0, pA1, m_reg, mnA, alA);
  SLOAD(SO, 1); if constexpr (SD == 2) { if (2 < NT) SLOAD(SE, 2); }
  SWAIT(); SWRITE(1, SO); __syncthreads();
  for (int j = 1; j + 1 < NT; j += 2) {
    SBAR(); qkt(pB0, pB1, (bf16_t*)((char*)K_lds + SHM_K), Q_lds, qrow, r32, hi); bias(pB0, pB1, j, wid, r32, hi);
    finishSM(pA0, pA1, alA, l_reg, pa0, pa1, pa2, pa3); SBAR();
    SLOAD(SO, j + SD); SBAR();
    pv_d0(o, vb0, pa0, pa1, pa2, pa3); partialSM(pB0, pB1, m_reg, mnB, alB);
    __syncthreads(); SWAIT(); SWRITE(0, SE);
    RESC(alB); __syncthreads();
    SBAR(); qkt(pA0, pA1, K_lds, Q_lds, qrow, r32, hi); bias(pA0, pA1, j + 1, wid, r32, hi);
    finishSM(pB0, pB1, alB, l_reg, pa0, pa1, pa2, pa3); SBAR();
    if (SD == 1 || j + 3 < NT) SLOAD(SE, j + 1 + SD); SBAR();
    pv_d0(o, vb0 + (int)SHM_V, pa0, pa1, pa2, pa3); partialSM(pA0, pA1, m_reg, mnA, alA);
    __syncthreads(); SWAIT(); SWRITE(1, SO);
    RESC(alA); __syncthreads();
  }
  SBAR(); qkt(pB0, pB1, (bf16_t*)((char*)K_lds + SHM_K), Q_lds, qrow, r32, hi); bias(pB0, pB1, NT - 1, wid, r32, hi);
  finishSM(pA0, pA1, alA, l_reg, pa0, pa1, pa2, pa3); SBAR();
  pv_d0(o, vb0, pa0, pa1, pa2, pa3); partialSM(pB0, pB1, m_reg, mnB, alB);
  __syncthreads(); RESC(alB);
  finishSM(pB0, pB1, alB, l_reg, pa0, pa1, pa2, pa3); SBAR();
  pv_d0(o, vb0 + (int)SHM_V, pa0, pa1, pa2, pa3);
  if (hi == 0) li_l[r32] = l_reg; asm volatile("s_waitcnt lgkmcnt(0)" ::: "memory");
  float rli[16];
#pragma unroll
  for (int r = 0; r < 16; ++r) rli[r] = __builtin_amdgcn_rcpf(li_l[crow(r, hi)]);
  bf16_t* Ow = Ob + (long)(wid * QBLK) * LDO;
#pragma unroll
  for (int r = 0; r < 16; ++r) { int orow = crow(r, hi);
    for (int d0 = 0; d0 < 4; ++d0) Ow[(long)orow * LDO + d0 * 32 + r32] = f2bf(o[d0][r] * rli[r]); }
#undef SLOAD
#undef SWRITE
#undef SWAIT
#undef RESC
}
}
namespace gdn {
using att::bf16x8; using att::f32x16; using att::crow;
constexpr int C = 32, SK = 136, SS = 40;
constexpr int OFF_KT = 0, OFF_QT = OFF_KT + C * SK * 2, OFF_W = OFF_QT + C * SK * 2, OFF_KTT = OFF_W + C * SK * 2, OFF_VTT = OFF_KTT + 128 * SS * 2,
              OFF_VN = OFF_VTT + 128 * SS * 2, OFF_VNS = OFF_VN + 128 * SS * 2, OFF_ST = OFF_VNS + 128 * SS * 2, OFF_TB = OFF_ST + 128 * SK * 2,
              OFF_TBE = OFF_TB + C * SS * 2, OFF_ATT = OFF_TBE + C * SS * 2, OFF_L = OFF_ATT + C * SS * 2, OFF_SC = OFF_L + C * C * 4, GDN_LDS = OFF_SC + 1024;
template <int K>
__device__ __forceinline__ f32x16 mm(const bf16_t* A, int lda, const bf16_t* Bt, int ldb, int l32, int hi, f32x16 acc) {
#pragma unroll
    for (int k0 = 0; k0 < K; k0 += 16) {
        const bf16x8 a = *reinterpret_cast<const bf16x8*>(A + l32 * lda + k0 + 8 * hi);
        const bf16x8 b = *reinterpret_cast<const bf16x8*>(Bt + l32 * ldb + k0 + 8 * hi);
        acc = __builtin_amdgcn_mfma_f32_32x32x16_bf16(a, b, acc, 0, 0, 0);
    }
    return acc;
}
__device__ __forceinline__ uint2 pk4(float a, float b, float c, float d) { uint2 w; w.x = pack2(a, b); w.y = pack2(c, d); return w; }

__device__ __forceinline__ void gdn_chunked(const Params& p, int l, bool ctx, int b, int h, int dir, unsigned char* lds) {
    const int tid = opaque_tid(), wid = tid >> 6, lane = tid & 63, l32 = lane & 31, hi = lane >> 5;
    const int T = ctx ? CT : ::LT; const size_t m0 = ctx ? (size_t)b * CT : (size_t)MC + (size_t)b * ::LT;
    const bf16_t* DQ = WSP(bf16_t, WS_DQ); const bf16_t* DK = WSP(bf16_t, WS_DK); const bf16_t* DV = WSP(bf16_t, WS_DV); const float* DBA = WSP(float, WS_DBA);
    float* O = WSP(float, dir ? WS_DOB : WS_DOF);
    bf16_t* Kt = (bf16_t*)(lds + OFF_KT); bf16_t* Qt = (bf16_t*)(lds + OFF_QT); bf16_t* W = (bf16_t*)(lds + OFF_W); bf16_t* KT = (bf16_t*)(lds + OFF_KTT); bf16_t* VT = (bf16_t*)(lds + OFF_VTT);
    bf16_t* VN = (bf16_t*)(lds + OFF_VN); bf16_t* VNS = (bf16_t*)(lds + OFF_VNS); bf16_t* ST = (bf16_t*)(lds + OFF_ST); bf16_t* TB = (bf16_t*)(lds + OFF_TB); bf16_t* TBE = (bf16_t*)(lds + OFF_TBE);
    bf16_t* ATT = (bf16_t*)(lds + OFF_ATT); float* Lm = (float*)(lds + OFF_L); float* sc = (float*)(lds + OFF_SC);
    const int nch = T / C;
#define TOK(c, s_) (m0 + (dir ? T - 1 - ((c) * C + (s_)) : (c) * C + (s_)))
    f32x16 S[2];
#pragma unroll
    for (int bi = 0; bi < 2; ++bi) {
        const int blk = wid * 2 + bi, d0 = 32 * (blk >> 2), e0 = 32 * (blk & 3);
        if (ctx) { S[bi] = f32x16{}; }
        else {
            const float* s0 = p.in[I_SGDN] + ((((size_t)b * DEPTH + l) * 2 + dir) * 4 + h) * 128 * 128 + e0 + l32;
#pragma unroll
            for (int r = 0; r < 16; ++r) S[bi][r] = s0[(size_t)(d0 + crow(r, hi)) * 128];
        }
    }
    const int ls = tid >> 5, lc = (tid & 31) * 4;
    vf4 pq0, pq1, pk0, pk1, pv0, pv1; float pbeta = 0.f, pg = 0.f;
#define GLOAD(c) do { const size_t ma = TOK(c, ls), mb = TOK(c, ls + 16); \
        pq0 = ld4bf(DQ + ma * 512 + h * 128 + lc); pq1 = ld4bf(DQ + mb * 512 + h * 128 + lc); \
        pk0 = ld4bf(DK + ma * 512 + h * 128 + lc); pk1 = ld4bf(DK + mb * 512 + h * 128 + lc); \
        pv0 = ld4bf(DV + ma * 512 + h * 128 + lc); pv1 = ld4bf(DV + mb * 512 + h * 128 + lc); \
        if (tid < C) { const size_t mt = TOK(c, tid); pbeta = DBA[mt * 16 + dir * 4 + h]; pg = DBA[mt * 16 + 8 + dir * 4 + h]; } } while (0)
#define GSTAGE() do { \
        *(uint2*)(Kt + ls * SK + lc) = pk4(pk0.x, pk0.y, pk0.z, pk0.w); *(uint2*)(Kt + (ls + 16) * SK + lc) = pk4(pk1.x, pk1.y, pk1.z, pk1.w); \
        *(uint2*)(Qt + ls * SK + lc) = pk4(pq0.x, pq0.y, pq0.z, pq0.w); *(uint2*)(Qt + (ls + 16) * SK + lc) = pk4(pq1.x, pq1.y, pq1.z, pq1.w); \
        _Pragma("unroll") for (int j = 0; j < 4; ++j) { KT[(lc + j) * SS + ls] = f2bf(pk0[j]); KT[(lc + j) * SS + ls + 16] = f2bf(pk1[j]); \
                                                        VT[(lc + j) * SS + ls] = f2bf(pv0[j]); VT[(lc + j) * SS + ls + 16] = f2bf(pv1[j]); } \
        if (wid == 0) { float x = pg; _Pragma("unroll") for (int o_ = 1; o_ < 32; o_ <<= 1) { const float y = __shfl_up(x, o_); if (lane >= o_) x += y; } \
            const float Bt_ = __shfl(x, 31); if (lane < C) { sc[lane] = pbeta; sc[32 + lane] = x; sc[64 + lane] = __expf(x); sc[96 + lane] = __expf(Bt_ - x); if (lane == 0) sc[128] = __expf(Bt_); } } } while (0)
    __syncthreads();
    GLOAD(0);
#pragma unroll
    for (int bi = 0; bi < 2; ++bi) {
        const int blk = wid * 2 + bi, d0 = 32 * (blk >> 2), e0 = 32 * (blk & 3);
#pragma unroll
        for (int g = 0; g < 4; ++g) *(uint2*)(ST + (e0 + l32) * SK + d0 + 8 * g + 4 * hi) = pk4(S[bi][4 * g], S[bi][4 * g + 1], S[bi][4 * g + 2], S[bi][4 * g + 3]);
    }
    GSTAGE();
    __syncthreads();
    for (int c = 0; c < nch; ++c) {
        if (c + 1 < nch) GLOAD(c + 1);
        f32x16 acc1 = f32x16{};
        if (wid == 0) {
            const f32x16 kk = mm<128>(Kt, SK, Kt, SK, l32, hi, f32x16{});
            const float bi_ = sc[32 + l32], be = sc[l32];
#pragma unroll
            for (int r = 0; r < 16; ++r) { const int j = crow(r, hi); const float v = (l32 > j) ? be * kk[r] * __expf(bi_ - sc[32 + j]) : 0.f;
                Lm[l32 * 32 + ((r & 3) + 4 * hi) * 4 + (r >> 2)] = v; }
        } else if (wid == 1) {
            const f32x16 kq = mm<128>(Kt, SK, Qt, SK, l32, hi, f32x16{});
            const float bi_ = sc[32 + l32];
            float a[16];
#pragma unroll
            for (int r = 0; r < 16; ++r) { const int j = crow(r, hi); a[r] = (l32 >= j) ? kq[r] * __expf(bi_ - sc[32 + j]) : 0.f; }
#pragma unroll
            for (int g = 0; g < 4; ++g) *(uint2*)(ATT + l32 * SS + 8 * g + 4 * hi) = pk4(a[4 * g], a[4 * g + 1], a[4 * g + 2], a[4 * g + 3]);
        } else if (wid >= 4) {
            acc1 = mm<128>(Qt, SK, ST + (32 * (wid - 4)) * SK, SK, l32, hi, f32x16{});
#pragma unroll
            for (int r = 0; r < 16; ++r) acc1[r] *= sc[64 + crow(r, hi)];
        }
        __syncthreads();
        if (tid < 256) {
            const int cc = tid >> 3, part = tid & 7;
            float Tr[4] = {0.f, 0.f, 0.f, 0.f};
            const float* Lp = Lm + part * 4;
#pragma unroll
            for (int i = 0; i < 32; ++i) {
                const vf4 lv = *(const vf4*)(Lp + i * 32);
                float s = lv.x * Tr[0] + lv.y * Tr[1] + lv.z * Tr[2] + lv.w * Tr[3];
                s = red8(s);
                const float t = (i == cc ? 1.f : 0.f) - s;
                if (part == (i & 7)) Tr[i >> 3] = t;
            }
            const float bc = sc[cc], bec = bc * sc[64 + cc];
#pragma unroll
            for (int jj = 0; jj < 4; ++jj) { TB[(part + 8 * jj) * SS + cc] = f2bf(Tr[jj] * bc); TBE[(part + 8 * jj) * SS + cc] = f2bf(Tr[jj] * bec); }
        }
        __syncthreads();
        if (wid < 4) {
            acc1 = mm<32>(TB, SS, VT + (32 * wid) * SS, SS, l32, hi, f32x16{});
        } else {
            const int d0 = 32 * (wid - 4);
            const f32x16 wt = mm<32>(KT + d0 * SS, SS, TBE, SS, l32, hi, f32x16{});
#pragma unroll
            for (int g = 0; g < 4; ++g) *(uint2*)(W + l32 * SK + d0 + 8 * g + 4 * hi) = pk4(wt[4 * g], wt[4 * g + 1], wt[4 * g + 2], wt[4 * g + 3]);
        }
        __syncthreads();
        if (wid < 4) {
            const int e0 = 32 * wid;
            const f32x16 ws = mm<128>(W, SK, ST + e0 * SK, SK, l32, hi, f32x16{});
            float vn[16], vs[16];
#pragma unroll
            for (int r = 0; r < 16; ++r) { vn[r] = acc1[r] - ws[r]; vs[r] = vn[r] * sc[96 + crow(r, hi)]; }
#pragma unroll
            for (int g = 0; g < 4; ++g) { *(uint2*)(VN + (e0 + l32) * SS + 8 * g + 4 * hi) = pk4(vn[4 * g], vn[4 * g + 1], vn[4 * g + 2], vn[4 * g + 3]);
                                          *(uint2*)(VNS + (e0 + l32) * SS + 8 * g + 4 * hi) = pk4(vs[4 * g], vs[4 * g + 1], vs[4 * g + 2], vs[4 * g + 3]); }
        }
        __syncthreads();
        if (wid >= 4) {
            const int e0 = 32 * (wid - 4);
            acc1 = mm<32>(ATT, SS, VN + e0 * SS, SS, l32, hi, acc1);
#pragma unroll
            for (int r = 0; r < 16; ++r) O[TOK(c, crow(r, hi)) * 512 + h * 128 + e0 + l32] = acc1[r];
        }
        {
            const float eB = sc[128];
#pragma unroll
            for (int bi = 0; bi < 2; ++bi) {
                const int blk = wid * 2 + bi, d0 = 32 * (blk >> 2), e0 = 32 * (blk & 3);
#pragma unroll
                for (int r = 0; r < 16; ++r) S[bi][r] *= eB;
                S[bi] = mm<32>(KT + d0 * SS, SS, VNS + e0 * SS, SS, l32, hi, S[bi]);
            }
        }
        __syncthreads();
#pragma unroll
        for (int bi = 0; bi < 2; ++bi) {
            const int blk = wid * 2 + bi, d0 = 32 * (blk >> 2), e0 = 32 * (blk & 3);
#pragma unroll
            for (int g = 0; g < 4; ++g) *(uint2*)(ST + (e0 + l32) * SK + d0 + 8 * g + 4 * hi) = pk4(S[bi][4 * g], S[bi][4 * g + 1], S[bi][4 * g + 2], S[bi][4 * g + 3]);
        }
        if (c + 1 < nch) GSTAGE();
        __syncthreads();
    }
#undef GLOAD
#undef GSTAGE
#undef TOK
    if (ctx) {
#pragma unroll
        for (int bi = 0; bi < 2; ++bi) {
            const int blk = wid * 2 + bi, d0 = 32 * (blk >> 2), e0 = 32 * (blk & 3);
            float* so = p.out + O_SGDN + ((((size_t)b * DEPTH + l) * 2 + dir) * 4 + h) * 128 * 128 + e0 + l32;
#pragma unroll
            for (int r = 0; r < 16; ++r) so[(size_t)(d0 + crow(r, hi)) * 128] = S[bi][r];
        }
    }
}
}

namespace gla {
using att::bf16x8; using att::f32x16; using att::crow; using gdn::mm; using gdn::pk4;
constexpr int C = 32, SQ = 72, SS = 40;
constexpr int OFF_QE = 0, OFF_KN = OFF_QE + C * SQ * 2, OFF_KET = OFF_KN + C * SQ * 2, OFF_VT = OFF_KET + 64 * SS * 2, OFF_ATT = OFF_VT + 128 * SS * 2, OFF_ST = OFF_ATT + C * SS * 2,
              OFF_LA = OFF_ST + 128 * SQ * 2, OFF_EB = OFF_LA + C * 64 * 4, GLA_LDS = OFF_EB + 256;
__device__ __forceinline__ void gla_chunked(const Params& p, int l, bool ctx, int b, int h, int dir, unsigned char* lds) {
    const int tid = opaque_tid(), wid = tid >> 6, lane = tid & 63, l32 = lane & 31, hi = lane >> 5;
    const int T = ctx ? CT : ::LT; const size_t m0 = ctx ? (size_t)b * CT : (size_t)MC + (size_t)b * ::LT;
    const bf16_t* Z = WSP(bf16_t, WS_Z); const float* LA = WSP(float, dir ? WS_AB : WS_AF);
    float* O = WSP(float, dir ? WS_GOB : WS_GOF);
    bf16_t* Qe = (bf16_t*)(lds + OFF_QE); bf16_t* Kn = (bf16_t*)(lds + OFF_KN); bf16_t* KeT = (bf16_t*)(lds + OFF_KET); bf16_t* VT = (bf16_t*)(lds + OFF_VT);
    bf16_t* ATT = (bf16_t*)(lds + OFF_ATT); bf16_t* ST = (bf16_t*)(lds + OFF_ST); float* la = (float*)(lds + OFF_LA); float* eB = (float*)(lds + OFF_EB);
    const int nch = T / C;
#define TOK(c, s_) (m0 + (dir ? T - 1 - ((c) * C + (s_)) : (c) * C + (s_)))
    const int d0 = 32 * (wid >> 2), e0 = 32 * (wid & 3);
    f32x16 S;
    if (ctx) S = f32x16{};
    else {
        const float* s0 = p.in[I_SGLA] + ((((size_t)b * DEPTH + l) * 2 + dir) * 4 + h) * 64 * 128 + e0 + l32;
#pragma unroll
        for (int r = 0; r < 16; ++r) S[r] = s0[(size_t)(d0 + crow(r, hi)) * 128];
    }
    const int ts = tid >> 4, dc = (tid & 15) * 4, vs = tid >> 5, vc = (tid & 31) * 4;
    vf4 pq, pk, pl, pv0, pv1;
#define GLOAD(c) do { const size_t mt = TOK(c, ts), ma = TOK(c, vs), mb = TOK(c, vs + 16); \
        pq = ld4bf(Z + mt * NINP + Z_GLQ + h * 64 + dc); pk = ld4bf(Z + mt * NINP + Z_GLK + h * 64 + dc); pl = *(const vf4*)(LA + mt * 256 + h * 64 + dc); \
        pv0 = ld4bf(Z + ma * NINP + Z_GLV + h * 128 + vc); pv1 = ld4bf(Z + mb * NINP + Z_GLV + h * 128 + vc); } while (0)
#define WRITE_ST() do { _Pragma("unroll") for (int g = 0; g < 4; ++g) *(uint2*)(ST + (e0 + l32) * SQ + d0 + 8 * g + 4 * hi) = pk4(S[4 * g], S[4 * g + 1], S[4 * g + 2], S[4 * g + 3]); } while (0)
#define GIMAGES() do { vf4 pre = (vf4){0.f, 0.f, 0.f, 0.f}, tot = pre; \
        _Pragma("unroll 8") for (int t_ = 0; t_ < C; ++t_) { const vf4 v_ = *(const vf4*)(la + t_ * 64 + dc); tot += v_; if (t_ <= ts) pre += v_; } \
        float qe[4], kn[4]; \
        _Pragma("unroll") for (int j = 0; j < 4; ++j) { qe[j] = pq[j] * 0.125f * __expf(pre[j]); kn[j] = pk[j] * __expf(fminf(-pre[j], 80.f)); \
            KeT[(dc + j) * SS + ts] = f2bf(pk[j] * __expf(tot[j] - pre[j])); } \
        *(uint2*)(Qe + ts * SQ + dc) = pk4(qe[0], qe[1], qe[2], qe[3]); *(uint2*)(Kn + ts * SQ + dc) = pk4(kn[0], kn[1], kn[2], kn[3]); \
        if (ts == 0) { _Pragma("unroll") for (int j = 0; j < 4; ++j) eB[dc + j] = __expf(tot[j]); } \
        _Pragma("unroll") for (int j = 0; j < 4; ++j) { VT[(vc + j) * SS + vs] = f2bf(pv0[j]); VT[(vc + j) * SS + vs + 16] = f2bf(pv1[j]); } } while (0)
    __syncthreads();
    GLOAD(0);
    WRITE_ST();
    *(vf4*)(la + ts * 64 + dc) = pl;
    __syncthreads();
    GIMAGES();
    __syncthreads();
    for (int c = 0; c < nch; ++c) {
        if (c + 1 < nch) GLOAD(c + 1);
        f32x16 o1 = f32x16{};
        if (wid == 0) {
            const f32x16 kq = mm<64>(Kn, SQ, Qe, SQ, l32, hi, f32x16{});
            float a[16];
#pragma unroll
            for (int r = 0; r < 16; ++r) a[r] = (l32 >= crow(r, hi)) ? kq[r] : 0.f;
#pragma unroll
            for (int g = 0; g < 4; ++g) *(uint2*)(ATT + l32 * SS + 8 * g + 4 * hi) = pk4(a[4 * g], a[4 * g + 1], a[4 * g + 2], a[4 * g + 3]);
        } else if (wid >= 4) {
            o1 = mm<64>(Qe, SQ, ST + (32 * (wid - 4)) * SQ, SQ, l32, hi, f32x16{});
        }
        __syncthreads();
        if (wid >= 4) {
            const int eo = 32 * (wid - 4);
            o1 = mm<32>(ATT, SS, VT + eo * SS, SS, l32, hi, o1);
#pragma unroll
            for (int r = 0; r < 16; ++r) O[TOK(c, crow(r, hi)) * 512 + h * 128 + eo + l32] = o1[r];
        }
#pragma unroll
        for (int r = 0; r < 16; ++r) S[r] *= eB[d0 + crow(r, hi)];
        S = mm<32>(KeT + d0 * SS, SS, VT + e0 * SS, SS, l32, hi, S);
        __syncthreads();
        WRITE_ST();
        if (c + 1 < nch) *(vf4*)(la + ts * 64 + dc) = pl;
        __syncthreads();
        if (c + 1 < nch) GIMAGES();
        __syncthreads();
    }
#undef GLOAD
#undef WRITE_ST
#undef GIMAGES
#undef TOK
    if (ctx) {
        float* so = p.out + O_SGLA + ((((size_t)b * DEPTH + l) * 2 + dir) * 4 + h) * 64 * 128 + e0 + l32;
#pragma unroll
        for (int r = 0; r < 16; ++r) so[(size_t)(d0 + crow(r, hi)) * 128] = S[r];
    }
}
}
#define LAS __attribute__((address_space(3)))
constexpr int LDS_BYTES = 147456, XBW_OFF = LDS_BYTES - 64;
constexpr int NPH = 1 + DEPTH * 12;
#ifndef DBG_NLAYERS
#define DBG_NLAYERS DEPTH
#endif

#ifndef DUPKIND
#define DUPKIND 0
#endif
__device__ __forceinline__ int opaque_int(int v) { asm volatile("" : "+s"(v)); return v; }
#ifndef MIXMASK
#define MIXMASK 0xFF
#endif
#define FOR_ITEMS(it, n, o, w) for (int bo_ = (o) * (int)gridDim.x / 256, bw_ = ((w) * (int)gridDim.x / 256) > 0 ? ((w) * (int)gridDim.x / 256) : 1, \
                                    it = ((int)blockIdx.x >= bo_ && (int)blockIdx.x < bo_ + bw_) ? (int)blockIdx.x - bo_ : (n); it < (n); it += bw_)

#ifndef SPLITK
#define SPLITK 0
#endif
#ifndef SPLITK_G4
#define SPLITK_G4 0
#endif
constexpr int FLAG_WORD0 = 8192;
constexpr int QCTR_WORD0 = 1024;
constexpr int NI_GDNL = LB * 8, NI_GLAL = LB * 8, NI_GDNC = CB * 8, NI_GQAL = LB * 16, NI_NAL = LB * 16, NI_GLAC = CB * 8, NI_NAC = CB * 4, NI_GQAC = CB * 4;
#define KM(k) (1 + ((DUPKIND >> (k)) & 1))
constexpr int Q0 = NI_GDNL * KM(0), Q1 = Q0 + NI_GQAL * KM(1), Q2 = Q1 + NI_NAL * KM(2), Q3 = Q2 + NI_GLAL * KM(3), Q4 = Q3 + NI_GDNC * KM(4), Q5 = Q4 + NI_NAC * KM(5), Q6 = Q5 + NI_GQAC * KM(6), Q7 = Q6 + NI_GLAC * KM(7);
__device__ __forceinline__ void phase_mix(const Params& p, int l, unsigned char* lds, int rep) {
    const int tid = opaque_tid();
    float* smem = (float*)lds;
    const bf16_t* NAQ = WSP(bf16_t, WS_NAQ); const bf16_t* NAK = WSP(bf16_t, WS_NAK); const bf16_t* NAV = WSP(bf16_t, WS_NAV);
    const bf16_t* GQ = WSP(bf16_t, WS_GQ); const bf16_t* GK = WSP(bf16_t, WS_GK); const bf16_t* GV = WSP(bf16_t, WS_GV);
    bf16_t* MRG = WSP(bf16_t, WS_MRG);
    unsigned* qctr = WSP(unsigned, WS_CTL) + QCTR_WORD0 + 64 * l + 16 * rep;
    volatile int* qslot = (volatile int*)(lds + XBW_OFF + 16);
    for (;;) {
        __syncthreads();
        if (tid == 0) *qslot = (int)__hip_atomic_fetch_add(qctr, 1u, __ATOMIC_RELAXED, __HIP_MEMORY_SCOPE_AGENT);
        __syncthreads();
        const int q = __builtin_amdgcn_readfirstlane(*qslot);
        if (q >= Q7) break;
        if (q < Q0) { const int it = q % NI_GDNL; gdn::gdn_chunked(p, l, false, it / 8, (it / 2) % 4, it % 2, lds); }
        else if (q < Q1) {
            const int it = (q - Q0) % NI_GQAL, b = it / 16, qh = (it / 4) % 4, qb = it % 4, kvh = qh >> 1;
            const size_t r0 = (size_t)MC + (size_t)b * LT;
            att::SrcTwo src{WSP(bf16_t, WS_CGK) + ((size_t)b * DEPTH + l) * 256 * 256 + kvh * 128, WSP(bf16_t, WS_CGV) + ((size_t)b * DEPTH + l) * 256 * 256 + kvh * 128,
                            GK + r0 * 256 + kvh * 128, GV + r0 * 256 + kvh * 128, 256};
            att::attn_body<2>(GQ + (r0 + qb * 256) * 512 + qh * 128, src, MRG + (r0 + qb * 256) * DM + 1024 + qh * 128, 4 + LT / 64, (char*)lds, att::NoBias{});
        }
        else if (q < Q2) {
            const int it = (q - Q1) % NI_NAL, b = it / 16, h = (it / 4) % 4, qb = it % 4;
            const int kr0 = qb == 0 ? 0 : qb == 1 ? 0 : qb == 2 ? 4 : 8, nrows = (qb == 0 || qb == 3) ? 8 : 12;
            const size_t r0 = (size_t)MC + (size_t)b * LT;
            float* tab = (float*)(lds + att::SHM_ATTN);
            if (tid < 15 * 31) tab[tid] = p.in[I_RPB][((size_t)l * 4 + h) * 15 * 31 + tid] * (1.0f / att::SCALE);
            att::SrcTwo src{WSP(bf16_t, WS_CNAK) + ((size_t)b * DEPTH + l) * 256 * 512 + h * 128, WSP(bf16_t, WS_CNAV) + ((size_t)b * DEPTH + l) * 256 * 512 + h * 128,
                            NAK + (r0 + kr0 * 64) * 512 + h * 128, NAV + (r0 + kr0 * 64) * 512 + h * 128, 512};
            att::attn_body<1>(NAQ + (r0 + qb * 256) * 512 + h * 128, src, MRG + (r0 + qb * 256) * DM + 0 + h * 128, 4 + nrows, (char*)lds, att::NaBias{tab, qb * 256, kr0});
        }
        else if (q < Q3) { const int it = (q - Q2) % NI_GLAL; gla::gla_chunked(p, l, false, it / 8, (it / 2) % 4, it % 2, lds); }
        else if (q < Q4) { const int it = (q - Q3) % NI_GDNC; gdn::gdn_chunked(p, l, true, it / 8, (it / 2) % 4, it % 2, lds); }
        else if (q < Q5) {
            const int it = (q - Q4) % NI_NAC, b = it / 4, h = it % 4; const size_t r0 = (size_t)b * CT;
            att::SrcOne src{NAK + r0 * 512 + h * 128, NAV + r0 * 512 + h * 128, 512};
            att::attn_body<2>(NAQ + r0 * 512 + h * 128, src, MRG + r0 * DM + 0 + h * 128, CT / 64, (char*)lds, att::NoBias{});
        }
        else if (q < Q6) {
            const int it = (q - Q5) % NI_GQAC, b = it / 4, qh = it % 4, kvh = qh >> 1; const size_t r0 = (size_t)b * CT;
            att::SrcOne src{GK + r0 * 256 + kvh * 128, GV + r0 * 256 + kvh * 128, 256};
            att::attn_body<2>(GQ + r0 * 512 + qh * 128, src, MRG + r0 * DM + 1024 + qh * 128, CT / 64, (char*)lds, att::NoBias{});
        }
        else { const int it = (q - Q6) % NI_GLAC; gla::gla_chunked(p, l, true, it / 8, (it / 2) % 4, it % 2, lds); }
    }
}

#define CONV_FILL(nunits, t0, t1, skip) do { if (l + 1 < DBG_NLAYERS) { const int G_ = (int)gridDim.x; int f0_ = ((nunits) % G_) + (skip); if (f0_ >= G_) f0_ = 0; \
        if ((int)blockIdx.x >= f0_) { const Params q = opaque_params(p); conv_layer_tiles(q, l + 1, (t0), (t1), (int)blockIdx.x - f0_, G_ - f0_, (float*)lds); } } } while (0)
#ifndef MSPLIT
#define MSPLIT 2
#endif
constexpr int TF0 = NT_L / 10, TF1 = NT_L / 4, TF2 = NT_L * 11 / 20;
static_assert(att::SHM_ATTN + 15 * 31 * 4 + 2048 <= (size_t)XBW_OFF, "LDS map");
static_assert((QCTR_WORD0 + 64 * DEPTH) < 4096, "ctl");
constexpr int BAR_WORD0 = 4096;
static_assert((BAR_WORD0 + XCD_BAR_WORDS) * 4 <= (int)CTL_BYTES, "ctl");

__global__ void __launch_bounds__(512, 2) fwd(Params p) {
    extern __shared__ __attribute__((aligned(16))) unsigned char lds[];
    const int tid = threadIdx.x;
    volatile LAS unsigned* xbw = (volatile LAS unsigned*)((LAS unsigned char*)lds + XBW_OFF);
    if (tid < 4) xbw[tid] = 0u;
    __syncthreads();
    XcdBarrier bar; bar.bar = WSP(unsigned, WS_CTL) + BAR_WORD0; bar.x = 0; bar.st = xbw;
    if (p.ph_hi - p.ph_lo > 1) bar = xcd_barrier_post(WSP(unsigned, WS_CTL) + BAR_WORD0, xbw);
#ifndef PHMASK
#define PHMASK 0x1FFF
#endif
#define IN(k) (p.ph_lo <= (k) && (k) < p.ph_hi)
#define INL(j) (((PHMASK >> ((j) + 1)) & 1) && IN(pb + (j)))
#ifndef DUPMASK
#define DUPMASK 0
#endif
#define DUP(j) ((DUPMASK >> ((j) + 1)) & 1)
#if DUPMASK
#define REPS(j) opaque_int(1 + DUP(j))
#else
#define REPS(j) 1
#endif
#ifndef DBLBAR
#define DBLBAR 0
#endif
#define SEAM(k) do { if (IN(k) && IN((k) + 1)) { xcd_barrier(bar); if (DBLBAR) xcd_barrier(bar); } } while (0)
    LAS unsigned char* ldsl = (LAS unsigned char*)lds;
    bf16_t* H = WSP(bf16_t, WS_H); bf16_t* ACT = WSP(bf16_t, WS_ACT); float* X = WSP(float, WS_X); float* Z = WSP(float, WS_Z); bf16_t* MRG = WSP(bf16_t, WS_MRG);

    if ((PHMASK & 1) && IN(0)) { const int reps_ = (DUPMASK & 1) ? opaque_int(2) : 1; for (int rep_ = 0; rep_ < reps_; ++rep_) { const Params q = opaque_params(p); phase_prologue(q, (float*)lds); __syncthreads(); } }
    SEAM(0);
    for (int l = 0; l < DBG_NLAYERS; ++l) {
        const int pb = 1 + l * 12;
        const float* modl = WSP(float, WS_MODV) + (size_t)l * NCOND * NMOD;
        if (INL(0)) { const int reps_ = REPS(0); for (int rep_ = 0; rep_ < reps_; ++rep_) { const Params q = opaque_params(p); phase_norm(q, l, 0); __syncthreads(); } }
        SEAM(pb + 0);
        if (INL(1)) {
            {
#if G1_FP8_MODE
                pg8::Gemm g{H, (const bf16_t*)(WSP(unsigned char, WS_WGU) + ((size_t)l * 2 + 0) * NGU * DM), M, NGU, DM / 2}; pg8::StaticOrder S; S.init(M, NGU, DM / 2, (int)gridDim.x, (int)blockIdx.x);
                constexpr float ws_ = 1.0f / WGU_SCALE;
#else
                pg8::Gemm g{H, WSP(bf16_t, WS_WGU) + ((size_t)l * 2 + 0) * NGU * DM, M, NGU, DM}; pg8::StaticOrder S; S.init(M, NGU, DM, (int)gridDim.x, (int)blockIdx.x);
                constexpr float ws_ = 1.0f;
#endif
#if G2_FP8
                pg8::EpiSwiGLU8 E{WSP(unsigned char, WS_ACT), FFP, ws_};
                for (int r_ = 0, n_ = REPS(1); r_ < n_; ++r_) pg8::gemm_phase<pg8::EpiSwiGLU8, pg8::StaticOrder, false, G1_FP8_MODE>(ldsl, g, S, E, nullptr);
#else
                pg8::EpiSwiGLU E{ACT, FF};
                for (int r_ = 0, n_ = REPS(1); r_ < n_; ++r_) pg8::gemm_phase<pg8::EpiSwiGLU, pg8::StaticOrder, false, G1_FP8_MODE>(ldsl, g, S, E, nullptr);
#endif
            }
#if CONV_FILLER
            if (l + 1 < DBG_NLAYERS) {
                const int nw_ = (M / 256) * (NGU / 256), G_ = (int)gridDim.x; int f0_ = nw_ % G_; if (nw_ < G_) f0_ = 0;
                const int nmb_ = (G_ - f0_ < NMOD / 128) ? (G_ - f0_) : NMOD / 128;
                if ((int)blockIdx.x >= f0_ && (int)blockIdx.x < f0_ + nmb_) { const Params q = opaque_params(p); mod_layer(q, l + 1, (int)blockIdx.x - f0_, nmb_, (float*)lds); }
            }
            CONV_FILL((M / 256) * (NGU / 256), 0, TF0, NMOD / 128);
#endif
        }
        SEAM(pb + 1);
        if (INL(2)) {
            pg8::Gemm g{ACT, G2_FP8 ? (const bf16_t*)(WSP(unsigned char, WS_WDN) + ((size_t)l * 2 + 0) * DM * FFP) : WSP(bf16_t, WS_WDN) + ((size_t)l * 2 + 0) * DM * FF, M, DM, G2_FP8 ? FFP / 2 : FF}; pg8::StaticOrder S; S.init(M, DM, G2_FP8 ? FFP / 2 : FF, (int)gridDim.x, (int)blockIdx.x, SPLITK ? 1 : MSPLIT);
            pg8::EpiResid E{l == 0 ? p.in[I_XP] : X, X, DM, modl + 2 * DM, G2_FP8 ? 0.5f / WDN_SCALE : 0.5f, Z, WSP(unsigned, WS_CTL) + FLAG_WORD0, 8u * (unsigned)(l * (2 * SPLITK + SPLITK_G4) + SPLITK), l == 0 ? p.in[I_XS] : X, l == 0 ? MC : 0x7FFFFFFF};
            pg8::gemm_phase<pg8::EpiResid, pg8::StaticOrder, false, (G2_FP8 ? 1 : 0)>(ldsl, g, S, E, nullptr);
#if DUPMASK
            if (opaque_int(DUP(2))) { pg8::EpiResid E2{X, Z, DM, modl + 2 * DM, 0.5f, Z, WSP(unsigned, WS_CTL) + FLAG_WORD0, 0u, X, 0x7FFFFFFF}; pg8::gemm_phase<pg8::EpiResid, pg8::StaticOrder, false>(ldsl, g, S, E2, nullptr); }
#endif
        }
        SEAM(pb + 2);
        if (INL(3)) { const int reps_ = REPS(3); for (int rep_ = 0; rep_ < reps_; ++rep_) { const Params q = opaque_params(p); phase_norm(q, l, 1); __syncthreads(); } }
        SEAM(pb + 3);
        if (INL(4)) {
            pg8::Gemm g{H, WSP(bf16_t, WS_WIN) + (size_t)l * NINP * DM, M, NINP, DM}; pg8::StaticOrder S; S.init(M, NINP, DM, (int)gridDim.x, (int)blockIdx.x);
            pg8::EpiBf16Plain E{WSP(bf16_t, WS_Z), NINP};
            for (int r_ = 0, n_ = REPS(4); r_ < n_; ++r_) pg8::gemm_phase<pg8::EpiBf16Plain, pg8::StaticOrder, false>(ldsl, g, S, E, nullptr);
#if CONV_FILLER
            CONV_FILL((M / 256) * (NINP / 256), TF0, TF1, 0);
#endif
        }
        SEAM(pb + 4);
        if (INL(5)) { const int reps_ = REPS(5); for (int rep_ = 0; rep_ < reps_; ++rep_) { const Params q = opaque_params(p); phase_prep(q, l); __syncthreads(); } }
        SEAM(pb + 5);
        if (INL(6)) { const int reps_ = REPS(6); for (int rep_ = 0; rep_ < reps_; ++rep_) { const Params q = opaque_params(p); phase_mix(q, l, lds, rep_); __syncthreads(); } }
        SEAM(pb + 6);
        if (INL(7)) { const int reps_ = REPS(7); for (int rep_ = 0; rep_ < reps_; ++rep_) { const Params q = opaque_params(p); phase_post(q, l); __syncthreads(); } }
        SEAM(pb + 7);
        if (INL(8)) {
            pg8::Gemm g{MRG, WSP(bf16_t, WS_WOUT) + (size_t)l * DM * DM, M, DM, DM}; pg8::StaticOrder S; S.init(M, DM, DM, (int)gridDim.x, (int)blockIdx.x, SPLITK_G4);
            pg8::EpiResid E{X, X, DM, modl + 5 * DM, 1.0f, Z, WSP(unsigned, WS_CTL) + FLAG_WORD0, 8u * (unsigned)(l * (2 * SPLITK + SPLITK_G4) + SPLITK + SPLITK_G4), X, 0x7FFFFFFF};
            pg8::gemm_phase<pg8::EpiResid, pg8::StaticOrder, false>(ldsl, g, S, E, nullptr);
#if CONV_FILLER
            CONV_FILL((M / 256) * (DM / 256), TF1, TF2, 0);
#endif
#if DUPMASK
            if (opaque_int(DUP(8))) { pg8::EpiResid E2{X, Z, DM, modl + 5 * DM, 1.0f, Z, WSP(unsigned, WS_CTL) + FLAG_WORD0, 0u, X, 0x7FFFFFFF}; pg8::gemm_phase<pg8::EpiResid, pg8::StaticOrder, false>(ldsl, g, S, E2, nullptr); }
#endif
        }
        SEAM(pb + 8);
        if (INL(9)) { const int reps_ = REPS(9); for (int rep_ = 0; rep_ < reps_; ++rep_) { const Params q = opaque_params(p); phase_norm(q, l, 2); __syncthreads(); } }
        SEAM(pb + 9);
        if (INL(10)) {
            {
#if G1_FP8_MODE
                pg8::Gemm g{H, (const bf16_t*)(WSP(unsigned char, WS_WGU) + ((size_t)l * 2 + 1) * NGU * DM), M, NGU, DM / 2}; pg8::StaticOrder S; S.init(M, NGU, DM / 2, (int)gridDim.x, (int)blockIdx.x);
                constexpr float ws_ = 1.0f / WGU_SCALE;
#else
                pg8::Gemm g{H, WSP(bf16_t, WS_WGU) + ((size_t)l * 2 + 1) * NGU * DM, M, NGU, DM}; pg8::StaticOrder S; S.init(M, NGU, DM, (int)gridDim.x, (int)blockIdx.x);
                constexpr float ws_ = 1.0f;
#endif
#if G2_FP8
                pg8::EpiSwiGLU8 E{WSP(unsigned char, WS_ACT), FFP, ws_};
                pg8::gemm_phase<pg8::EpiSwiGLU8, pg8::StaticOrder, false, G1_FP8_MODE>(ldsl, g, S, E, nullptr);
#else
                pg8::EpiSwiGLU E{ACT, FF};
                pg8::gemm_phase<pg8::EpiSwiGLU, pg8::StaticOrder, false, G1_FP8_MODE>(ldsl, g, S, E, nullptr);
#endif
            }
#if CONV_FILLER
            CONV_FILL((M / 256) * (NGU / 256), TF2, NT_L, 0);
#endif
        }
        SEAM(pb + 10);
        if (INL(11)) {
            pg8::Gemm g{ACT, G2_FP8 ? (const bf16_t*)(WSP(unsigned char, WS_WDN) + ((size_t)l * 2 + 1) * DM * FFP) : WSP(bf16_t, WS_WDN) + ((size_t)l * 2 + 1) * DM * FF, M, DM, G2_FP8 ? FFP / 2 : FF}; pg8::StaticOrder S; S.init(M, DM, G2_FP8 ? FFP / 2 : FF, (int)gridDim.x, (int)blockIdx.x, SPLITK ? 1 : MSPLIT);
            pg8::EpiResid E{X, (l == DEPTH - 1) ? p.out : X, DM, modl + 8 * DM, G2_FP8 ? 0.5f / WDN_SCALE : 0.5f, Z, WSP(unsigned, WS_CTL) + FLAG_WORD0, 8u * (unsigned)(l * (2 * SPLITK + SPLITK_G4) + 2 * SPLITK + SPLITK_G4), X, 0x7FFFFFFF};
            pg8::gemm_phase<pg8::EpiResid, pg8::StaticOrder, false, (G2_FP8 ? 1 : 0)>(ldsl, g, S, E, nullptr);
        }
        SEAM(pb + 11);
    }
#undef IN
#undef SEAM
}

#ifndef MULTI_LAUNCH
#define MULTI_LAUNCH 0
#endif
extern "C" void kernel_launch(void* const* d_in, const int* in_sizes, int n_in, void* d_out, int out_size, void* d_ws, size_t ws_size, hipStream_t stream) {
    static int grid = 0;
    if (grid == 0) {
        if (n_in != N_IN || (size_t)out_size != O_END || ws_size < WS_END) { fprintf(stderr, "kernel_launch: shape mismatch n_in %d out %d ws %zu (need %zu)\n", n_in, out_size, ws_size, (size_t)WS_END); grid = -1; return; }
        int dev = 0, cus = 0, per_cu = 0;
        if (hipGetDevice(&dev) != hipSuccess || hipDeviceGetAttribute(&cus, hipDeviceAttributeMultiprocessorCount, dev) != hipSuccess) { grid = -1; return; }
        if (hipFuncSetAttribute((const void*)fwd, hipFuncAttributeMaxDynamicSharedMemorySize, LDS_BYTES) != hipSuccess) { fprintf(stderr, "kernel_launch: hipFuncSetAttribute failed\n"); grid = -1; return; }
        if (hipOccupancyMaxActiveBlocksPerMultiprocessor(&per_cu, (const void*)fwd, 512, LDS_BYTES) != hipSuccess || per_cu < 1) { fprintf(stderr, "kernel_launch: occupancy query says %d\n", per_cu); (void)hipGetLastError(); }
        grid = cus;
    }
    if (grid < 0) return;
    (void)hipMemsetAsync((char*)d_ws + WS_CTL, 0, CTL_BYTES, stream);
    Params p{};
    for (int i = 0; i < N_IN; ++i) p.in[i] = (const float*)d_in[i];
    p.out = (float*)d_out; p.ws = (unsigned char*)d_ws;
#if MULTI_LAUNCH
    for (int ph = 0; ph < 1 + DBG_NLAYERS * 12; ++ph) { p.ph_lo = ph; p.ph_hi = ph + 1; hipLaunchKernelGGL(fwd, dim3(grid), dim3(512), LDS_BYTES, stream, p); }
#else
    p.ph_lo = 0; p.ph_hi = NPH; hipLaunchKernelGGL(fwd, dim3(grid), dim3(512), LDS_BYTES, stream, p);
#endif
    const hipError_t le = hipPeekAtLastError();
    if (le != hipSuccess) fprintf(stderr, "kernel_launch: launch failed: %s\n", hipGetErrorName(le));
}
```

```cpp
#include <hip/hip_runtime.h>
#include <cstdio>
#include <cstdint>

#ifndef CB_
#define CB_ 16
#endif
#ifndef LB_
#define LB_ 8
#endif
#ifndef DEPTH_
#define DEPTH_ 4
#endif
#ifndef G1A_MODE
#define G1A_MODE 0
#endif
#ifndef G1B_MODE
#define G1B_MODE 1
#endif
#ifndef G2_FP8
#define G2_FP8 1
#endif
#ifndef FFN_FP8
#define FFN_FP8 (G1A_MODE != 0 || G1B_MODE != 0 || G2_FP8 != 0)
#endif
constexpr int DM = 2048, DEPTH = DEPTH_, CB = CB_, CT = 256, LB = LB_, LT = 1024;
constexpr int MC = CB * CT, ML = LB * LT, M = MC + ML;
constexpr int FF = 5504, NGU = 2 * FF, NIN = 6192, NINP = 6400, NMOD = 9 * DM, NCOND = 1 + LB;
constexpr float EPS = 1e-6f;
constexpr int FFP = 5632;
constexpr float WGU_SCALE = 32.0f, WDN_SCALE = 64.0f;
constexpr int Z_NAQ = 0, Z_NAK = 512, Z_NAV = 1024, Z_GLQ = 1536, Z_GLK = 1792, Z_GLV = 2048, Z_GLR = 2560, Z_GF = 3072, Z_GB = 3088,
              Z_GQQ = 3104, Z_GQK = 3616, Z_GQV = 3872, Z_DQKV = 4128, Z_DZ = 5664, Z_DB = 6176, Z_DA = 6184;
static_assert(Z_DA + 8 == NIN, "split");
enum { I_XP = 0, I_XS, I_CNAK, I_CNAV, I_CGK, I_CGV, I_SGLA, I_SGDN, I_C, I_CCTX, I_NORMG, I_WMOD, I_BMOD, I_GU, I_DOWN, I_WIN, I_WOUT, I_NAQKN, I_RPB,
       I_GUP, I_GBIAS, I_GLAON, I_GQAQKN, I_CONV, I_ALOG, I_DTB, I_GDNON, N_IN };
constexpr size_t O_YP = 0, O_YS = O_YP + (size_t)MC * DM, O_NAK = O_YS + (size_t)ML * DM, O_NAV = O_NAK + (size_t)CB * DEPTH * 4 * CT * 128,
                 O_GK = O_NAV + (size_t)CB * DEPTH * 4 * CT * 128, O_GV = O_GK + (size_t)CB * DEPTH * 2 * CT * 128,
                 O_SGLA = O_GV + (size_t)CB * DEPTH * 2 * CT * 128, O_SGDN = O_SGLA + (size_t)CB * DEPTH * 2 * 4 * 64 * 128,
                 O_END = O_SGDN + (size_t)CB * DEPTH * 2 * 4 * 128 * 128;
constexpr size_t al256(size_t x) { return (x + 255) & ~(size_t)255; }
constexpr size_t WS_CTL = 0, CTL_BYTES = 1u << 20;
constexpr size_t WS_WGU = CTL_BYTES;
constexpr size_t WS_WDN = WS_WGU + (size_t)DEPTH * 2 * NGU * DM * 2;
constexpr size_t WS_WIN = WS_WDN + (size_t)DEPTH * 2 * DM * FF * 2;
constexpr size_t WS_WOUT = WS_WIN + (size_t)DEPTH * NINP * DM * 2;
constexpr size_t WS_MODV = WS_WOUT + (size_t)DEPTH * DM * DM * 2;
constexpr size_t WS_ROPE = al256(WS_MODV + (size_t)DEPTH * NCOND * NMOD * 4);
constexpr size_t WS_X = al256(WS_ROPE + 2 * 64 * 32 * 4);
constexpr size_t WS_H = WS_X + (size_t)M * DM * 4;
constexpr size_t WS_ACT = WS_H + (size_t)M * DM * 2;
constexpr size_t WS_Z = WS_ACT + (size_t)M * FF * 2;
constexpr size_t WS_MRG = WS_Z + (size_t)M * NINP * 4;
constexpr size_t WS_NAQ = WS_MRG + (size_t)M * DM * 2;
constexpr size_t WS_NAK = WS_NAQ + (size_t)M * 512 * 2;
constexpr size_t WS_NAV = WS_NAK + (size_t)M * 512 * 2;
constexpr size_t WS_GQ = WS_NAV + (size_t)M * 512 * 2;
constexpr size_t WS_GK = WS_GQ + (size_t)M * 512 * 2;
constexpr size_t WS_GV = WS_GK + (size_t)M * 256 * 2;
constexpr size_t WS_CNAK = WS_GV + (size_t)M * 256 * 2;
constexpr size_t WS_CNAV = WS_CNAK + (size_t)LB * DEPTH * 256 * 512 * 2;
constexpr size_t WS_CGK = WS_CNAV + (size_t)LB * DEPTH * 256 * 512 * 2;
constexpr size_t WS_CGV = WS_CGK + (size_t)LB * DEPTH * 256 * 256 * 2;
constexpr size_t WS_AF = WS_CGV + (size_t)LB * DEPTH * 256 * 256 * 2;
constexpr size_t WS_AB = WS_AF + (size_t)M * 256 * 4;
constexpr size_t WS_DQ = WS_AB + (size_t)M * 256 * 4;
constexpr size_t WS_DK = WS_DQ + (size_t)M * 512 * 4;
constexpr size_t WS_DV = WS_DK + (size_t)M * 512 * 4;
constexpr size_t WS_DBA = WS_DV + (size_t)M * 512 * 4;
constexpr size_t WS_GOF = WS_DBA + (size_t)M * 16 * 4;
constexpr size_t WS_GOB = WS_GOF + (size_t)M * 512 * 4;
constexpr size_t WS_DOF = WS_GOB + (size_t)M * 512 * 4;
constexpr size_t WS_DOB = WS_DOF + (size_t)M * 512 * 4;
constexpr size_t WS_END = WS_DOB + (size_t)M * 512 * 4;

typedef unsigned short bf16_t;
struct Params { const float* in[N_IN]; float* out; unsigned char* ws; int ph_lo, ph_hi; };
static_assert(sizeof(Params) == N_IN * 8 + 8 + 8 + 8, "no padding");

#define WSP(T, off) ((T*)(p.ws + (off)))
__device__ __forceinline__ int opaque_tid() { int t = (int)threadIdx.x; asm volatile("" : "+v"(t)); return t; }
__device__ __forceinline__ Params opaque_params(const Params& p) { Params q = p; unsigned long long w = (unsigned long long)q.ws; asm volatile("" : "+s"(w)); q.ws = (unsigned char*)w; return q; }

typedef float vf4 __attribute__((ext_vector_type(4)));
__device__ __forceinline__ unsigned pack4_fp8(float a, float b, float c, float d) { int w = 0; w = __builtin_amdgcn_cvt_pk_fp8_f32(a, b, w, false); w = __builtin_amdgcn_cvt_pk_fp8_f32(c, d, w, true); return (unsigned)w; }
__device__ __forceinline__ float bf2f(unsigned short v) { return __uint_as_float((unsigned)v << 16); }
__device__ __forceinline__ vf4 ld4bf(const unsigned short* p) { const uint2 w = *(const uint2*)p; vf4 r; r.x = __uint_as_float(w.x << 16); r.y = __uint_as_float(w.x & 0xFFFF0000u); r.z = __uint_as_float(w.y << 16); r.w = __uint_as_float(w.y & 0xFFFF0000u); return r; }
__device__ __forceinline__ vf4 unp4bf(uint2 w) { vf4 r; r.x = __uint_as_float(w.x << 16); r.y = __uint_as_float(w.x & 0xFFFF0000u); r.z = __uint_as_float(w.y << 16); r.w = __uint_as_float(w.y & 0xFFFF0000u); return r; }
__device__ __forceinline__ void unp8bf(uint4 w, vf4& a, vf4& b) {
    a.x = __uint_as_float(w.x << 16); a.y = __uint_as_float(w.x & 0xFFFF0000u); a.z = __uint_as_float(w.y << 16); a.w = __uint_as_float(w.y & 0xFFFF0000u);
    b.x = __uint_as_float(w.z << 16); b.y = __uint_as_float(w.z & 0xFFFF0000u); b.z = __uint_as_float(w.w << 16); b.w = __uint_as_float(w.w & 0xFFFF0000u); }
__device__ __forceinline__ void ld8bf(const unsigned short* p, vf4& a, vf4& b) { const uint4 w = *(const uint4*)p;
    a.x = __uint_as_float(w.x << 16); a.y = __uint_as_float(w.x & 0xFFFF0000u); a.z = __uint_as_float(w.y << 16); a.w = __uint_as_float(w.y & 0xFFFF0000u);
    b.x = __uint_as_float(w.z << 16); b.y = __uint_as_float(w.z & 0xFFFF0000u); b.z = __uint_as_float(w.w << 16); b.w = __uint_as_float(w.w & 0xFFFF0000u); }
__device__ __forceinline__ float wave_sum(float v) {
#pragma unroll
    for (int o = 32; o >= 1; o >>= 1) v += __shfl_xor(v, o);
    return v;
}
__device__ __forceinline__ bf16_t f2bf(float f) { unsigned u = __float_as_uint(f); u += 0x7FFFu + ((u >> 16) & 1u); return (bf16_t)(u >> 16); }
__device__ __forceinline__ unsigned pack2(float a, float b) { return (unsigned)f2bf(a) | ((unsigned)f2bf(b) << 16); }
__device__ __forceinline__ float silu_f(float x) { return x / (1.f + expf(-x)); }
__device__ __forceinline__ float softplus_f(float x) { return fmaxf(x, 0.f) + log1pf(expf(-fabsf(x))); }
__device__ __forceinline__ float logsigmoid_f(float x) { return fminf(x, 0.f) - log1pf(expf(-fabsf(x))); }
__device__ __forceinline__ int cond_of_row(int m) { return m < MC ? 0 : 1 + (m - MC) / LT; }
#ifndef CONV_FILLER
#define CONV_FILLER 1
#endif
__device__ __forceinline__ void conv_tile(const float* __restrict__ src, int ld_src, int ncols_src, int k0, int c0, bf16_t* __restrict__ dst, int ld_dst, int n0, float* tile) {
    const int tid = opaque_tid();
    {
        const int r = tid >> 3, c = (tid & 7) * 8;
        float4 a = make_float4(0.f, 0.f, 0.f, 0.f), b = a;
        if (c0 + c + 8 <= ncols_src) {
            const float* s = src + (size_t)(k0 + r) * ld_src + c0 + c;
            a = *(const float4*)s; b = *(const float4*)(s + 4);
        }
        float* t = tile + r * 65 + c;
        t[0] = a.x; t[1] = a.y; t[2] = a.z; t[3] = a.w; t[4] = b.x; t[5] = b.y; t[6] = b.z; t[7] = b.w;
    }
    __syncthreads();
    {
        const int n = tid >> 3, ks = (tid & 7) * 8;
        const float* t = tile + ks * 65 + n;
        uint4 w;
        w.x = pack2(t[0 * 65], t[1 * 65]); w.y = pack2(t[2 * 65], t[3 * 65]); w.z = pack2(t[4 * 65], t[5 * 65]); w.w = pack2(t[6 * 65], t[7 * 65]);
        *(uint4*)(dst + (size_t)(n0 + n) * ld_dst + k0 + ks) = w;
    }
    __syncthreads();
}

__device__ __forceinline__ void conv_tile8(const float* __restrict__ src, int ld_src, int nrows_src, int k0, int c0, unsigned char* __restrict__ dst, int ld_dst, int n0, float scale, float* tile) {
    const int tid = opaque_tid();
    {
        const int r = tid >> 3, c = (tid & 7) * 8;
        float4 a = make_float4(0.f, 0.f, 0.f, 0.f), b = a;
        if (k0 + r < nrows_src) { const float* s = src + (size_t)(k0 + r) * ld_src + c0 + c; a = *(const float4*)s; b = *(const float4*)(s + 4); }
        float* t = tile + r * 65 + c;
        t[0] = a.x * scale; t[1] = a.y * scale; t[2] = a.z * scale; t[3] = a.w * scale; t[4] = b.x * scale; t[5] = b.y * scale; t[6] = b.z * scale; t[7] = b.w * scale;
    }
    __syncthreads();
    {
        const int n = tid >> 3, ks = (tid & 7) * 8;
        const float* t = tile + ks * 65 + n;
        uint2 w; w.x = pack4_fp8(t[0 * 65], t[1 * 65], t[2 * 65], t[3 * 65]); w.y = pack4_fp8(t[4 * 65], t[5 * 65], t[6 * 65], t[7 * 65]);
        *(uint2*)(dst + (size_t)(n0 + n) * ld_dst + k0 + ks) = w;
    }
    __syncthreads();
}
constexpr int MOD_ITEMS = DEPTH * (NMOD / 128);
constexpr int TGU_KT = DM / 64, TGU_NT = NGU / 64, TDN_KT = (G2_FP8 ? FFP : FF) / 64, TDN_NT = DM / 64, TIN_KT = DM / 64, TIN_NT = NINP / 64, TOUT_KT = DM / 64, TOUT_NT = DM / 64;
constexpr int TL_GU = 2 * TGU_KT * TGU_NT, TL_DN = 2 * TDN_KT * TDN_NT, TL_IN = TIN_KT * TIN_NT, TL_OUT = TOUT_KT * TOUT_NT, NT_L = TL_GU + TL_DN + TL_IN + TL_OUT;
__device__ __forceinline__ void conv_layer_tiles(const Params& p, int l, int t_begin, int t_end, int first, int stride, float* s_tile) {
    for (int it = t_begin + first; it < t_end; it += stride) {
        if (it < TL_GU) {
            const int mat = l * 2 + it / (TGU_KT * TGU_NT), r = it % (TGU_KT * TGU_NT), kt = r / TGU_NT, nt = r % TGU_NT;
            const int n0 = nt * 64, t256 = n0 / 256, c = n0 % 256;
            const int c0 = c < 128 ? 128 * t256 + c : FF + 128 * t256 + (c - 128);
            if ((mat & 1) ? (G1B_MODE != 0) : (G1A_MODE != 0))
                conv_tile8(p.in[I_GU] + (size_t)mat * DM * NGU, NGU, DM, kt * 64, c0, WSP(unsigned char, WS_WGU) + (size_t)mat * NGU * DM * 2, DM, n0, WGU_SCALE, s_tile);
            else
                conv_tile(p.in[I_GU] + (size_t)mat * DM * NGU, NGU, NGU, kt * 64, c0, WSP(bf16_t, WS_WGU) + (size_t)mat * NGU * DM, DM, n0, s_tile);
        } else if (it < TL_GU + TL_DN) {
            const int i2 = it - TL_GU, mat = l * 2 + i2 / (TDN_KT * TDN_NT), r = i2 % (TDN_KT * TDN_NT), kt = r / TDN_NT, nt = r % TDN_NT;
#if G2_FP8
            conv_tile8(p.in[I_DOWN] + (size_t)mat * FF * DM, DM, FF, kt * 64, nt * 64, WSP(unsigned char, WS_WDN) + (size_t)mat * DM * FFP, FFP, nt * 64, WDN_SCALE, s_tile);
#else
            conv_tile(p.in[I_DOWN] + (size_t)mat * FF * DM, DM, DM, kt * 64, nt * 64, WSP(bf16_t, WS_WDN) + (size_t)mat * DM * FF, FF, nt * 64, s_tile);
#endif
        } else if (it < TL_GU + TL_DN + TL_IN) {
            const int i2 = it - TL_GU - TL_DN, kt = i2 / TIN_NT, nt = i2 % TIN_NT;
            conv_tile(p.in[I_WIN] + (size_t)l * DM * NIN, NIN, NIN, kt * 64, nt * 64, WSP(bf16_t, WS_WIN) + (size_t)l * NINP * DM, DM, nt * 64, s_tile);
        } else {
            const int i2 = it - TL_GU - TL_DN - TL_IN, kt = i2 / TOUT_NT, nt = i2 % TOUT_NT;
            conv_tile(p.in[I_WOUT] + (size_t)l * DM * DM, DM, DM, kt * 64, nt * 64, WSP(bf16_t, WS_WOUT) + (size_t)l * DM * DM, DM, nt * 64, s_tile);
        }
    }
}

__device__ __forceinline__ void mod_layer(const Params& p, int l, int first, int stride, float* smem) {
    const int tid = opaque_tid();
    float* s_cond = smem;
    float* s_red = s_cond + NCOND * DM;
    __syncthreads();
    for (int i = tid; i < NCOND * DM; i += 512) { const int ci = i / DM, k = i % DM; const float v = ci == 0 ? p.in[I_CCTX][k] : p.in[I_C][(size_t)(ci - 1) * DM + k]; s_cond[i] = silu_f(v); }
    __syncthreads();
    float* modv = WSP(float, WS_MODV);
    for (int jt = first; jt < NMOD / 128; jt += stride) {
        const int cl = tid & 127, kq = tid >> 7, col = jt * 128 + cl;
        const float* w = p.in[I_WMOD] + (size_t)l * DM * NMOD + col;
        float acc[NCOND];
#pragma unroll
        for (int ci = 0; ci < NCOND; ++ci) acc[ci] = 0.f;
        for (int k = kq * 512; k < kq * 512 + 512; k += 8) {
            float wv[8];
#pragma unroll
            for (int j = 0; j < 8; ++j) wv[j] = w[(size_t)(k + j) * NMOD];
#pragma unroll
            for (int ci = 0; ci < NCOND; ++ci) {
                const float4 s0 = *(const float4*)&s_cond[ci * DM + k], s1 = *(const float4*)&s_cond[ci * DM + k + 4];
                acc[ci] += s0.x * wv[0] + s0.y * wv[1] + s0.z * wv[2] + s0.w * wv[3] + s1.x * wv[4] + s1.y * wv[5] + s1.z * wv[6] + s1.w * wv[7];
            }
        }
        if (kq > 0) {
#pragma unroll
            for (int ci = 0; ci < NCOND; ++ci) s_red[((kq - 1) * 128 + cl) * NCOND + ci] = acc[ci];
        }
        __syncthreads();
        if (kq == 0) {
            const float bm = p.in[I_BMOD][(size_t)l * NMOD + col];
#pragma unroll
            for (int ci = 0; ci < NCOND; ++ci)
                modv[((size_t)l * NCOND + ci) * NMOD + col] = acc[ci] + s_red[(0 * 128 + cl) * NCOND + ci] + s_red[(1 * 128 + cl) * NCOND + ci] + s_red[(2 * 128 + cl) * NCOND + ci] + bm;
        }
        __syncthreads();
    }
}

__device__ __forceinline__ void phase_prologue(const Params& p, float* smem) {
    const int tid = threadIdx.x, nb = gridDim.x, bid = blockIdx.x;
    float* s_tile = smem + NCOND * DM + 3 * 128 * NCOND;
#if CONV_FILLER
    mod_layer(p, 0, bid, nb, smem);
#else
    for (int l2 = 0; l2 < DEPTH; ++l2) mod_layer(p, l2, bid, nb, smem);
#endif
    conv_layer_tiles(p, 0, 0, NT_L, bid, nb, s_tile);
#if !CONV_FILLER
    for (int l2 = 1; l2 < DEPTH; ++l2) conv_layer_tiles(p, l2, 0, NT_L, bid, nb, s_tile);
#endif
    const size_t gtid = (size_t)bid * 512 + tid, gstride = (size_t)nb * 512;
    {
        const size_t n_na = (size_t)LB * DEPTH * 256 * 512 / 8;
        for (size_t i = gtid; i < 2 * n_na; i += gstride) {
            const bool isv = i >= n_na; const size_t j = isv ? i - n_na : i;
            const int d8 = (int)(j % 16), h = (int)((j / 16) % 4), t = (int)((j / 64) % 256); const size_t bl = j / (64 * 256);
            const float* s = p.in[isv ? I_CNAV : I_CNAK] + ((bl * 4 + h) * 256 + t) * 128 + d8 * 8;
            const float4 a = *(const float4*)s, b = *(const float4*)(s + 4);
            uint4 w; w.x = pack2(a.x, a.y); w.y = pack2(a.z, a.w); w.z = pack2(b.x, b.y); w.w = pack2(b.z, b.w);
            *(uint4*)(WSP(bf16_t, isv ? WS_CNAV : WS_CNAK) + (bl * 256 + t) * 512 + h * 128 + d8 * 8) = w;
        }
        const size_t n_g = (size_t)LB * DEPTH * 256 * 256 / 8;
        for (size_t i = gtid; i < 2 * n_g; i += gstride) {
            const bool isv = i >= n_g; const size_t j = isv ? i - n_g : i;
            const int d8 = (int)(j % 16), h = (int)((j / 16) % 2), t = (int)((j / 32) % 256); const size_t bl = j / (32 * 256);
            const float* s = p.in[isv ? I_CGV : I_CGK] + ((bl * 2 + h) * 256 + t) * 128 + d8 * 8;
            const float4 a = *(const float4*)s, b = *(const float4*)(s + 4);
            uint4 w; w.x = pack2(a.x, a.y); w.y = pack2(a.z, a.w); w.z = pack2(b.x, b.y); w.w = pack2(b.z, b.w);
            *(uint4*)(WSP(bf16_t, isv ? WS_CGV : WS_CGK) + (bl * 256 + t) * 256 + h * 128 + d8 * 8) = w;
        }
    }
    for (size_t i = gtid; i < 64 * 32; i += gstride) {
        const int pos = (int)(i / 32), k = (int)(i % 32);
        const float inv = powf(10000.0f, -(float)(2 * k) / 64.0f);
        const float ang = (float)pos * inv;
        WSP(float, WS_ROPE)[i] = cosf(ang); WSP(float, WS_ROPE)[64 * 32 + i] = sinf(ang);
    }
}

__device__ __forceinline__ void phase_norm(const Params& p, int l, int which  ) {
    const int tid = opaque_tid(), lane = tid & 63, wv = tid >> 6;
    const float* X = WSP(float, WS_X); bf16_t* H = WSP(bf16_t, WS_H);
    const bool from_in = (l == 0 && which == 0);
    const float* g = p.in[I_NORMG] + ((size_t)l * 3 + which) * DM;
    const int nw = (int)gridDim.x * 8;
    for (int m0 = blockIdx.x * 8 + wv; m0 < M; m0 += 2 * nw) {
        const int m1 = m0 + nw; const bool has1 = m1 < M;
        const int mm[2] = {m0, has1 ? m1 : m0};
        vf4 v[2][8]; float ss[2] = {0.f, 0.f};
#pragma unroll
        for (int k = 0; k < 2; ++k) {
            const int m = mm[k];
            const float* x = from_in ? (m < MC ? p.in[I_XP] + (size_t)m * DM : p.in[I_XS] + (size_t)(m - MC) * DM) : X + (size_t)m * DM;
#pragma unroll
            for (int i = 0; i < 8; ++i) v[k][i] = *(const vf4*)(x + (i * 64 + lane) * 4);
        }
#pragma unroll
        for (int k = 0; k < 2; ++k) {
#pragma unroll
            for (int i = 0; i < 8; ++i) ss[k] += v[k][i].x * v[k][i].x + v[k][i].y * v[k][i].y + v[k][i].z * v[k][i].z + v[k][i].w * v[k][i].w;
            ss[k] = wave_sum(ss[k]);
        }
#pragma unroll
        for (int k = 0; k < 2; ++k) {
            if (k == 1 && !has1) break;
            const int m = mm[k];
            const float* mv = WSP(float, WS_MODV) + ((size_t)l * NCOND + cond_of_row(m)) * NMOD + (size_t)which * 3 * DM;
            const float r = 1.0f / sqrtf(ss[k] * (1.0f / DM) + EPS);
#pragma unroll
            for (int i = 0; i < 8; ++i) {
                const int c = (i * 64 + lane) * 4;
                const float4 gg = *(const float4*)(g + c), sh = *(const float4*)(mv + c), sc = *(const float4*)(mv + DM + c);
                const float o0 = v[k][i].x * r * gg.x * (1.f + sc.x) + sh.x, o1 = v[k][i].y * r * gg.y * (1.f + sc.y) + sh.y;
                const float o2 = v[k][i].z * r * gg.z * (1.f + sc.z) + sh.z, o3 = v[k][i].w * r * gg.w * (1.f + sc.w) + sh.w;
                if ((which == 0 ? G1A_MODE : which == 2 ? G1B_MODE : 0) != 0) *(unsigned*)((unsigned char*)H + (size_t)m * DM + c) = pack4_fp8(o0, o1, o2, o3);
                else { uint2 w; w.x = pack2(o0, o1); w.y = pack2(o2, o3); *(uint2*)(H + (size_t)m * DM + c) = w; }
            }
            if (G2_FP8 && which != 1 && lane < (FFP - FF) / 4) *(unsigned*)(WSP(unsigned char, WS_ACT) + (size_t)m * FFP + FF + 4 * lane) = 0u;
        }
    }
}

__device__ __forceinline__ float red16(float v);
__device__ __forceinline__ float ssq8(vf4 a, vf4 b) { const vf4 s = a * a + b * b; return (s.x + s.y) + (s.z + s.w); }
__device__ __forceinline__ uint4 pack8(vf4 a, vf4 b) { uint4 w; w.x = pack2(a.x, a.y); w.y = pack2(a.z, a.w); w.z = pack2(b.x, b.y); w.w = pack2(b.z, b.w); return w; }
__device__ __forceinline__ void phase_prep(const Params& p, int l) {
    const int tid = opaque_tid(), lane = tid & 63, wv = tid >> 6, rg = lane >> 4, sub = lane & 15, c8 = sub * 8;
    const bf16_t* Z = WSP(bf16_t, WS_Z);
    const float* ropec = WSP(float, WS_ROPE); const float* ropes = ropec + 64 * 32;
    const float* wnq = p.in[I_NAQKN] + ((size_t)l * 2 + 0) * 128 + c8; const float* wnk = wnq + 128;
    const float* wgq = p.in[I_GQAQKN] + ((size_t)l * 2 + 0) * 128 + c8; const float* wgk = wgq + 128;
    const float* cw = p.in[I_CONV] + (size_t)l * 5 * 1536 + rg * 128 + c8;
    const int rpw = (M + (int)gridDim.x * 8 - 1) / ((int)gridDim.x * 8);
    for (int m = ((int)blockIdx.x * 8 + wv) * rpw, mend = (m + rpw < M ? m + rpw : M); m < mend; ++m) {
        const bf16_t* z = Z + (size_t)m * NINP;
        const bool ctx = m < MC;
        const int b = ctx ? m / CT : (m - MC) / LT, t = ctx ? m % CT : (m - MC) % LT, T = ctx ? CT : LT;
        const int ho = rg * 128 + c8;
        uint4 rz[5]; uint2 rgz[2][4];
        {
            const bf16_t* zkv = z + (rg < 2 ? Z_GQK + rg * 128 : Z_GQV + (rg - 2) * 128) + c8;
            rz[0] = *(const uint4*)(z + Z_NAQ + ho); rz[1] = *(const uint4*)(z + Z_NAK + ho); rz[2] = *(const uint4*)(z + Z_NAV + ho); rz[3] = *(const uint4*)(z + Z_GQQ + ho); rz[4] = *(const uint4*)zkv;
#pragma unroll
            for (int dir = 0; dir < 2; ++dir)
#pragma unroll
                for (int r4 = 0; r4 < 4; ++r4) rgz[dir][r4] = *(const uint2*)(z + (dir ? Z_GB : Z_GF) + 4 * r4);
        }
        asm volatile("" ::: "memory");
        {
            vf4 q0, q1, k0, k1, v0, v1, g0, g1, x0, x1;
            unp8bf(rz[0], q0, q1); unp8bf(rz[1], k0, k1); unp8bf(rz[2], v0, v1); unp8bf(rz[3], g0, g1); unp8bf(rz[4], x0, x1);
            float r = 1.0f / sqrtf(red16(ssq8(q0, q1)) * (1.0f / 128) + EPS);
            q0 = q0 * r * *(const vf4*)wnq; q1 = q1 * r * *(const vf4*)(wnq + 4);
            *(uint4*)(WSP(bf16_t, WS_NAQ) + (size_t)m * 512 + ho) = pack8(q0, q1);
            r = 1.0f / sqrtf(red16(ssq8(k0, k1)) * (1.0f / 128) + EPS);
            k0 = k0 * r * *(const vf4*)wnk; k1 = k1 * r * *(const vf4*)(wnk + 4);
            *(uint4*)(WSP(bf16_t, WS_NAK) + (size_t)m * 512 + ho) = pack8(k0, k1);
            *(uint4*)(WSP(bf16_t, WS_NAV) + (size_t)m * 512 + ho) = pack8(v0, v1);
            if (ctx) {
                const size_t o = ((((size_t)b * DEPTH + l) * 4 + rg) * CT + t) * 128 + c8;
                *(vf4*)(p.out + O_NAK + o) = k0; *(vf4*)(p.out + O_NAK + o + 4) = k1; *(vf4*)(p.out + O_NAV + o) = v0; *(vf4*)(p.out + O_NAV + o + 4) = v1;
            }
            r = 1.0f / sqrtf(red16(ssq8(g0, g1)) * (1.0f / 128) + EPS);
            g0 = g0 * r * *(const vf4*)wgq; g1 = g1 * r * *(const vf4*)(wgq + 4);
            const float rk = 1.0f / sqrtf(red16(ssq8(x0, x1)) * (1.0f / 128) + EPS);
            if (rg < 2) { x0 = x0 * rk * *(const vf4*)wgk; x1 = x1 * rk * *(const vf4*)(wgk + 4); }
            if (!ctx) {
                const int pos = sub < 8 ? (t >> 6) : (t & 63), ai = pos * 32 + (c8 & 31);
                const vf4 c0 = *(const vf4*)(ropec + ai), c1 = *(const vf4*)(ropec + ai + 4), s0 = *(const vf4*)(ropes + ai), s1 = *(const vf4*)(ropes + ai + 4);
                const bool hi = (sub & 4) != 0;
                vf4 pg0, pg1, px0, px1;
#pragma unroll
                for (int j = 0; j < 4; ++j) { pg0[j] = __shfl_xor(g0[j], 4); pg1[j] = __shfl_xor(g1[j], 4); px0[j] = __shfl_xor(x0[j], 4); px1[j] = __shfl_xor(x1[j], 4); }
                g0 = hi ? pg0 * s0 + g0 * c0 : g0 * c0 - pg0 * s0; g1 = hi ? pg1 * s1 + g1 * c1 : g1 * c1 - pg1 * s1;
                if (rg < 2) { x0 = hi ? px0 * s0 + x0 * c0 : x0 * c0 - px0 * s0; x1 = hi ? px1 * s1 + x1 * c1 : x1 * c1 - px1 * s1; }
            }
            *(uint4*)(WSP(bf16_t, WS_GQ) + (size_t)m * 512 + ho) = pack8(g0, g1);
            *(uint4*)(WSP(bf16_t, rg < 2 ? WS_GK : WS_GV) + (size_t)m * 256 + (rg & 1) * 128 + c8) = pack8(x0, x1);
            if (ctx) {
                const size_t o = ((((size_t)b * DEPTH + l) * 2 + (rg & 1)) * CT + t) * 128 + c8;
                float* dst = p.out + (rg < 2 ? O_GK : O_GV) + o;
                *(vf4*)dst = x0; *(vf4*)(dst + 4) = x1;
            }
        }
        asm volatile("" ::: "memory");
        {
#pragma unroll
            for (int dir = 0; dir < 2; ++dir) {
                const float* up = p.in[I_GUP] + ((size_t)l * 2 + dir) * 16 * 256 + 4 * lane;
                vf4 acc = *(const vf4*)(p.in[I_GBIAS] + ((size_t)l * 2 + dir) * 256 + 4 * lane);
#pragma unroll
                for (int r4 = 0; r4 < 4; ++r4) {
                    const vf4 gv = unp4bf(rgz[dir][r4]);
                    acc += gv.x * *(const vf4*)(up + (4 * r4 + 0) * 256) + gv.y * *(const vf4*)(up + (4 * r4 + 1) * 256) + gv.z * *(const vf4*)(up + (4 * r4 + 2) * 256) + gv.w * *(const vf4*)(up + (4 * r4 + 3) * 256);
                }
                vf4 o;
#pragma unroll
                for (int j = 0; j < 4; ++j) o[j] = logsigmoid_f(acc[j]) * (1.0f / 16.0f);
                *(vf4*)(WSP(float, dir ? WS_AB : WS_AF) + (size_t)m * 256 + 4 * lane) = o;
            }
        }
        asm volatile("" ::: "memory");
        {
            uint4 rcz[3][5];
#pragma unroll
            for (int part = 0; part < 3; ++part)
#pragma unroll
                for (int j = 0; j < 5; ++j) { const int tt = t + j - 2;
                    rcz[part][j] = (tt >= 0 && tt < T) ? *(const uint4*)(Z + (size_t)(m + j - 2) * NINP + Z_DQKV + part * 512 + rg * 128 + c8) : make_uint4(0u, 0u, 0u, 0u); }
            asm volatile("" ::: "memory");
#pragma unroll
            for (int part = 0; part < 3; ++part) {
                vf4 a0 = (vf4){0.f, 0.f, 0.f, 0.f}, a1 = a0;
#pragma unroll
                for (int j = 0; j < 5; ++j) {
                    const float* cj = cw + j * 1536 + part * 512;
                    vf4 z0, z1; unp8bf(rcz[part][j], z0, z1);
                    a0 += *(const vf4*)cj * z0; a1 += *(const vf4*)(cj + 4) * z1;
                }
#pragma unroll
                for (int j = 0; j < 4; ++j) { a0[j] = silu_f(a0[j]); a1[j] = silu_f(a1[j]); }
                if (part < 2) { const float r = 1.0f / sqrtf(red16(ssq8(a0, a1)) + EPS) * (part == 0 ? 0.08838834764831845f : 1.0f); a0 *= r; a1 *= r; }
                *(uint4*)(WSP(bf16_t, part == 0 ? WS_DQ : part == 1 ? WS_DK : WS_DV) + (size_t)m * 512 + rg * 128 + c8) = pack8(a0, a1);
                asm volatile("" ::: "memory");
            }
            if (lane < 8) {
                const float beta = 1.0f / (1.0f + expf(-bf2f(z[Z_DB + lane])));
                const float g = -expf(p.in[I_ALOG][(size_t)l * 8 + lane]) * softplus_f(bf2f(z[Z_DA + lane]) + p.in[I_DTB][(size_t)l * 8 + lane]);
                float* ba = WSP(float, WS_DBA) + (size_t)m * 16;
                ba[lane] = beta; ba[8 + lane] = g;
            }
        }
    }
}

typedef float vf2 __attribute__((ext_vector_type(2)));
__device__ __forceinline__ float dpp_f(float v, const int ctrl) { return v; }
#define DPPF(v, ctrl) __int_as_float(__builtin_amdgcn_mov_dpp(__float_as_int(v), (ctrl), 0xF, 0xF, true))
__device__ __forceinline__ float red8(float v) { v += DPPF(v, 0xB1); v += DPPF(v, 0x4E); v += DPPF(v, 0x141); return v; }
__device__ __forceinline__ float red16(float v) { v = red8(v); v += DPPF(v, 0x140); return v; }

__device__ __forceinline__ void phase_post(const Params& p, int l) {
    const int tid = opaque_tid(), lane = tid & 63, wv = tid >> 6, rg = lane >> 4, c8 = (lane & 15) * 8;
    const bf16_t* Z = WSP(bf16_t, WS_Z); bf16_t* MRG = WSP(bf16_t, WS_MRG);
    const float* wg = p.in[I_GLAON] + (size_t)l * 128 + c8; const float* wd = p.in[I_GDNON] + (size_t)l * 128 + c8;
    for (int m = blockIdx.x * 8 + wv; m < M; m += gridDim.x * 8) {
        const bf16_t* z = Z + (size_t)m * NINP;
        const int ho = rg * 128 + c8;
#pragma unroll
        for (int g = 0; g < 2; ++g) {
            const float* of = WSP(float, g ? WS_DOF : WS_GOF) + (size_t)m * 512 + ho; const float* ob = WSP(float, g ? WS_DOB : WS_GOB) + (size_t)m * 512 + ho;
            const float* w = g ? wd : wg; const bf16_t* zg = z + (g ? Z_DZ : Z_GLR) + ho;
            vf4 a0 = *(const vf4*)of + *(const vf4*)ob, a1 = *(const vf4*)(of + 4) + *(const vf4*)(ob + 4);
            vf4 g0, g1; ld8bf(zg, g0, g1);
            const float r = 1.0f / sqrtf(red16(ssq8(a0, a1)) * (1.0f / 128) + EPS);
            a0 = a0 * r * *(const vf4*)w; a1 = a1 * r * *(const vf4*)(w + 4);
#pragma unroll
            for (int j = 0; j < 4; ++j) { a0[j] *= silu_f(g0[j]); a1[j] *= silu_f(g1[j]); }
            *(uint4*)(MRG + (size_t)m * DM + (g ? 1536 : 512) + ho) = pack8(a0, a1);
        }
    }
}
#define XB_TMO      128
#define XB_XCNT(j)  (256  + 64 * (j))
#define XB_XSUB(j)  (1280 + 64 * (j))
#define XB_XGEN(j)  (2304 + 64 * (j))
#define XB_TOP      3328
#define XB_TOPGEN   3392
#define XCD_BAR_WORDS 3456
#define XB_SPIN_CAP (1u << 22)
#define LAS __attribute__((address_space(3)))

__device__ __forceinline__ unsigned xb_ld(unsigned* p)              { return __hip_atomic_load(p, __ATOMIC_RELAXED, __HIP_MEMORY_SCOPE_AGENT); }
__device__ __forceinline__ unsigned xb_add(unsigned* p, unsigned v) { return __hip_atomic_fetch_add(p, v, __ATOMIC_RELAXED, __HIP_MEMORY_SCOPE_AGENT); }
__device__ __forceinline__ unsigned xb_xcc_id() { return (unsigned)__builtin_amdgcn_s_getreg((3 << 11) | 20) & 0xFu; }
#define XB_SPIN(cond, bar) do { unsigned _sp = 0; while (cond) { __builtin_amdgcn_s_sleep(1); \
    if ((++_sp & 255u) == 0u) { if (xb_ld(&(bar)[XB_TMO])) break; if (_sp > XB_SPIN_CAP) { atomicAdd(&(bar)[XB_TMO], 1u); break; } } } } while (0)

struct XcdBarrier {
    unsigned* bar; unsigned x;
    volatile LAS unsigned* st;
};

__device__ __forceinline__ XcdBarrier xcd_barrier_post(unsigned* bar, volatile LAS unsigned* st) {
    XcdBarrier b; b.bar = bar; b.x = xb_xcc_id(); b.st = st;
    if (threadIdx.x == 0) (void)xb_add(&bar[XB_XCNT(b.x)], 1u);
    return b;
}
__device__ __forceinline__ void xcd_barrier_complete(unsigned* bar, unsigned x, unsigned& nloc, unsigned& nx) {
    const unsigned G = gridDim.x * gridDim.y * gridDim.z;
    unsigned sum, cnt, mine, sp = 0u;
    for (;;) {
        sum = 0u; cnt = 0u; mine = 0u;
#pragma unroll
        for (unsigned j = 0; j < 16; ++j) { const unsigned c = xb_ld(&bar[XB_XCNT(j)]); sum += c; cnt += (c > 0u) ? 1u : 0u; mine = (j == x) ? c : mine; }
        if (sum == G) break;
        __builtin_amdgcn_s_sleep(1);
        if ((++sp & 255u) == 0u) { if (xb_ld(&bar[XB_TMO])) break; if (sp > XB_SPIN_CAP) { atomicAdd(&bar[XB_TMO], 1u); break; } }
    }
    nloc = mine > 0u ? mine : 1u; nx = cnt > 0u ? cnt : 1u;
}

__device__ __forceinline__ void xcd_barrier(const XcdBarrier& b) {
    asm volatile("s_waitcnt vmcnt(0)" ::: "memory");
    __syncthreads();
    if (threadIdx.x == 0) {
        unsigned* bar = b.bar;
        __builtin_amdgcn_s_waitcnt(0);
        unsigned nloc = b.st[0], nx = b.st[1];
        if (nloc == 0u) { xcd_barrier_complete(bar, b.x, nloc, nx); b.st[0] = nloc; b.st[1] = nx; }
        const unsigned old = xb_add(&bar[XB_XSUB(b.x)], 1u);
        const unsigned gen = old / nloc;
        if (old + 1u == (gen + 1u) * nloc) {
            __builtin_amdgcn_fence(__ATOMIC_RELEASE, "agent");
            asm volatile("s_waitcnt vmcnt(0)" ::: "memory");
            const unsigned og = xb_add(&bar[XB_TOP], 1u);
            const unsigned tg = og / nx;
            if (og + 1u == (tg + 1u) * nx) xb_add(&bar[XB_TOPGEN], 1u);
            else XB_SPIN(xb_ld(&bar[XB_TOPGEN]) == tg, bar);
            __builtin_amdgcn_fence(__ATOMIC_ACQUIRE, "agent");
            xb_add(&bar[XB_XGEN(b.x)], 1u);
            asm volatile("s_waitcnt vmcnt(0)" ::: "memory");
        } else {
            XB_SPIN(xb_ld(&bar[XB_XGEN(b.x)]) == gen, bar);
            __builtin_amdgcn_fence(__ATOMIC_ACQUIRE, "agent");
            asm volatile("s_waitcnt vmcnt(0)" ::: "memory");
        }
    }
    __syncthreads();
}

#ifndef NT_STORES
#define NT_STORES 0
#endif
namespace pg8 {
#define PG8_LAS __attribute__((address_space(3)))
typedef unsigned short bf16_t;
typedef short bf16x8 __attribute__((ext_vector_type(8)));
typedef float f32x4 __attribute__((ext_vector_type(4)));
typedef unsigned u32x4 __attribute__((ext_vector_type(4)));
typedef int v4i32 __attribute__((ext_vector_type(4)));
typedef int v8i32 __attribute__((ext_vector_type(8)));
constexpr int BM = 256, BK = 64, HALF = 128, HTB = HALF * BK * 2  , STAGE_BYTES = 8 * HTB, NXCD = 8, WGM = 8;

__host__ __device__ __forceinline__ int lds_byte(int r, int c) { const int st = (r >> 4) * 2 + (c >> 5), rr = r & 15, cc = c & 31, ob = rr * 64 + cc * 2; return st * 1024 + (ob ^ (((ob >> 9) & 1) << 5)); }
__host__ __device__ __forceinline__ void stage_rc(int b, int& R, int& C) { const int st = b / 1024, sb = b % 1024, swz = sb ^ (((sb >> 9) & 1) << 5); R = (st >> 1) * 16 + swz / 64; C = (st & 1) * 32 + (swz % 64) / 2; }
__host__ __device__ __forceinline__ int perm32(int rho) { const int n = rho >> 4, i = rho & 15; return 8 * (i >> 2) + 4 * n + (i & 3); }

struct Unit { int pm, pn, k0, nt, at, slot, msk; };
struct Gemm { const bf16_t* A; const bf16_t* Bt; int M, N, K; };

struct StaticOrder {
    int nM, nN, nwg, G, c, ntk, split, msplit;
    __host__ __device__ void init(int M, int N, int K, int G_, int c_, int split_ = 0) { nM = M / BM; nN = N / BM; nwg = nM * nN; G = G_; c = c_; ntk = K / BK; const int rem = nwg % G_; split = (split_ == 1 && rem > 0 && 2 * rem == G_ && ntk >= 8) ? 1 : 0; msplit = (split_ == 2 && rem > 0 && 2 * rem <= G_) ? 1 : 0; }
    __host__ __device__ bool next(int i, Unit& u) const {
        long L = (long)i * G + c; u.k0 = 0; u.nt = ntk; u.at = 0; u.slot = 0; u.msk = 3;
        if (msplit && i == nwg / G) { const int rem = nwg % G; if (c >= 2 * rem) return false; L = (long)i * G + (c % rem); u.msk = (c / rem) ? 2 : 1; }
        if (split && i == nwg / G) { const int rem = nwg % G, sl = c / rem, h0 = ((ntk / 2) + 1) & ~1; L = (long)i * G + (c % rem); u.k0 = sl ? h0 * BK : 0; u.nt = sl ? ntk - h0 : h0; u.at = sl ? 1 : 2; u.slot = c % rem; }
        if (L >= nwg) return false;
        int wgid = (int)L; { const int q = nwg / NXCD, r = nwg % NXCD, xcd = wgid % NXCD, off = wgid / NXCD; wgid = (xcd < r ? xcd * (q + 1) : r * (q + 1) + (xcd - r) * q) + off; }
        const int nig = WGM * nN, gid = wgid / nig, fm = gid * WGM, gsz = (nM - fm) < WGM ? (nM - fm) : WGM;
        u.pm = fm + ((wgid % nig) % gsz); u.pn = (wgid % nig) / gsz; return true;
    }
    __device__ __forceinline__ void a_ready(const Unit&) const {}
    __device__ __forceinline__ void done(const Unit&) const {}
};
__device__ __forceinline__ unsigned cvt_pk_bf16(float lo, float hi) { unsigned r; asm volatile("v_cvt_pk_bf16_f32 %0, %1, %2" : "=v"(r) : "v"(lo), "v"(hi)); return r; }
struct EpiF32 {
    static constexpr bool PERM = false, AFTER_DRAIN = false;
    float* C; int ldc; const float* bias;
    __device__ __forceinline__ void operator()(const f32x4 (&acc)[2][2][4][2], const Unit& u, int wr, int wc, int fr, int fq) const {
        const int row0 = u.pm * BM + wr * 64 + fr, col0 = u.pn * BM + wc * 32 + 4 * fq;
        f32x4 bv[2][2];
#pragma unroll
        for (int bj = 0; bj < 2; ++bj)
#pragma unroll
            for (int n = 0; n < 2; ++n) bv[bj][n] = bias ? *(const f32x4*)(bias + col0 + bj * HALF + n * 16) : (f32x4){0.f, 0.f, 0.f, 0.f};
#pragma unroll
        for (int ai = 0; ai < 2; ++ai)
#pragma unroll
            for (int m = 0; m < 4; ++m) { float* rowp = C + (size_t)(row0 + ai * HALF + m * 16) * ldc + col0;
#pragma unroll
                for (int bj = 0; bj < 2; ++bj)
#pragma unroll
                    for (int n = 0; n < 2; ++n) *(f32x4*)(rowp + bj * HALF + n * 16) = acc[ai][bj][m][n] + bv[bj][n]; }
    }
};

struct EpiSwiGLU {
    static constexpr bool PERM = true, AFTER_DRAIN = false;
    bf16_t* O; int ldc;
    __device__ __forceinline__ void operator()(const f32x4 (&acc)[2][2][4][2], const Unit& u, int wr, int wc, int fr, int fq) const {
        const int row0 = u.pm * BM + wr * 64 + fr, col0 = u.pn * 128 + wc * 32 + 8 * fq;
#pragma unroll
        for (int ai = 0; ai < 2; ++ai) if ((u.msk >> ai) & 1)
#pragma unroll
            for (int m = 0; m < 4; ++m) { bf16_t* rowp = O + (size_t)(row0 + ai * HALF + m * 16) * ldc + col0;
                const f32x4 g0 = acc[ai][0][m][0], g1 = acc[ai][0][m][1], u0 = acc[ai][1][m][0], u1 = acc[ai][1][m][1];
                float r[8];
#pragma unroll
                for (int j = 0; j < 4; ++j) {
                    r[j]     = g0[j] * __builtin_amdgcn_rcpf(1.0f + __builtin_amdgcn_exp2f(-1.4426950408889634f * g0[j])) * u0[j];
                    r[4 + j] = g1[j] * __builtin_amdgcn_rcpf(1.0f + __builtin_amdgcn_exp2f(-1.4426950408889634f * g1[j])) * u1[j]; }
                u32x4 w; w.x = cvt_pk_bf16(r[0], r[1]); w.y = cvt_pk_bf16(r[2], r[3]); w.z = cvt_pk_bf16(r[4], r[5]); w.w = cvt_pk_bf16(r[6], r[7]);
#if NT_STORES
                __builtin_nontemporal_store(w, (u32x4*)rowp);
#else
                *(u32x4*)rowp = w;
#endif
                }
    }
};
struct EpiSwiGLU8 {
    static constexpr bool PERM = true, AFTER_DRAIN = false;
    unsigned char* O; int ldc; float wscale;
    __device__ __forceinline__ void operator()(const f32x4 (&acc)[2][2][4][2], const Unit& u, int wr, int wc, int fr, int fq) const {
        const int row0 = u.pm * BM + wr * 64 + fr, col0 = u.pn * 128 + wc * 32 + 8 * fq;
#pragma unroll
        for (int ai = 0; ai < 2; ++ai) if ((u.msk >> ai) & 1)
#pragma unroll
            for (int m = 0; m < 4; ++m) { unsigned char* rowp = O + (size_t)(row0 + ai * HALF + m * 16) * ldc + col0;
                f32x4 g0 = acc[ai][0][m][0], g1 = acc[ai][0][m][1], u0 = acc[ai][1][m][0], u1 = acc[ai][1][m][1];
                asm volatile("" : "+v"(g0), "+v"(g1), "+v"(u0), "+v"(u1));
                g0 *= wscale; g1 *= wscale; u0 *= wscale; u1 *= wscale;
                float r[8];
#pragma unroll
                for (int j = 0; j < 4; ++j) {
                    r[j]     = g0[j] * __builtin_amdgcn_rcpf(1.0f + __builtin_amdgcn_exp2f(-1.4426950408889634f * g0[j])) * u0[j];
                    r[4 + j] = g1[j] * __builtin_amdgcn_rcpf(1.0f + __builtin_amdgcn_exp2f(-1.4426950408889634f * g1[j])) * u1[j]; }
                uint2 w; w.x = pack4_fp8(r[0], r[1], r[2], r[3]); w.y = pack4_fp8(r[4], r[5], r[6], r[7]);
                *(uint2*)rowp = w; asm volatile("" ::: "memory"); }
    }
};
struct EpiBf16Plain {
    static constexpr bool PERM = true, AFTER_DRAIN = false;
    bf16_t* O; int ldc;
    __device__ __forceinline__ void operator()(const f32x4 (&acc)[2][2][4][2], const Unit& u, int wr, int wc, int fr, int fq) const {
        const int row0 = u.pm * BM + wr * 64 + fr, col0 = u.pn * BM + wc * 32 + 8 * fq;
#pragma unroll
        for (int ai = 0; ai < 2; ++ai) if ((u.msk >> ai) & 1)
#pragma unroll
            for (int m = 0; m < 4; ++m) { bf16_t* rowp = O + (size_t)(row0 + ai * HALF + m * 16) * ldc + col0;
#pragma unroll
                for (int bj = 0; bj < 2; ++bj) { const f32x4 v0 = acc[ai][bj][m][0], v1 = acc[ai][bj][m][1];
                    u32x4 w; w.x = cvt_pk_bf16(v0[0], v0[1]); w.y = cvt_pk_bf16(v0[2], v0[3]); w.z = cvt_pk_bf16(v1[0], v1[1]); w.w = cvt_pk_bf16(v1[2], v1[3]);
                    *(u32x4*)(rowp + bj * HALF) = w; } }
    }
};
struct EpiResid {
    static constexpr bool PERM = false, AFTER_DRAIN = false;
    const float* res; float* out; int ldc; const float* gate0; float coef;
    float* slab; unsigned* flags; unsigned target;
    const float* res_hi; int row_hi;
    __device__ __forceinline__ void operator()(const f32x4 (&acc)[2][2][4][2], const Unit& u, int wr, int wc, int fr, int fq) const {
        const int tidx = ((wr * 4 + wc) * 4 + fq) * 16 + fr;
        if (u.at == 1) {
            const __amdgpu_buffer_rsrc_t rs = __builtin_amdgcn_make_buffer_rsrc((void*)slab, 0, 0x7FFFFFF0, 0x00020000);
            const unsigned base = ((unsigned)u.slot * 32u * 512u + (unsigned)tidx) * 16u;
#pragma unroll
            for (int ai = 0; ai < 2; ++ai)
#pragma unroll
                for (int bj = 0; bj < 2; ++bj)
#pragma unroll
                    for (int m = 0; m < 4; ++m)
#pragma unroll
                        for (int n = 0; n < 2; ++n) { const f32x4 v = acc[ai][bj][m][n]; u32x4 w; w.x = __float_as_uint(v[0]); w.y = __float_as_uint(v[1]); w.z = __float_as_uint(v[2]); w.w = __float_as_uint(v[3]);
                            __builtin_amdgcn_raw_buffer_store_b128(w, rs, base + (unsigned)((((ai * 2 + bj) * 4 + m) * 2 + n) * 512 * 16), 0, 16); }
            asm volatile("s_waitcnt vmcnt(0)" ::: "memory");
            if ((tidx & 63) == 0) __hip_atomic_fetch_add(flags + 64 * u.slot, 1u, __ATOMIC_RELAXED, __HIP_MEMORY_SCOPE_AGENT);
            return;
        }
        const float* part = nullptr;
        if (u.at == 2) {
            unsigned spins = 0;
            while (__hip_atomic_load(flags + 64 * u.slot, __ATOMIC_RELAXED, __HIP_MEMORY_SCOPE_AGENT) < target) { __builtin_amdgcn_s_sleep(2); if (++spins > (1u << 22)) break; }
            __builtin_amdgcn_fence(__ATOMIC_ACQUIRE, "agent");
            asm volatile("s_waitcnt vmcnt(0)" ::: "memory");
            part = slab + ((size_t)u.slot * 32 * 512 + tidx) * 4;
        }
        const int row0 = u.pm * BM + wr * 64 + fr, col0 = u.pn * BM + wc * 32 + 4 * fq;
        const float* gate = gate0 + (size_t)cond_of_row(u.pm * BM) * NMOD;
        const float* rbase = (u.pm * BM >= row_hi) ? res_hi - (size_t)row_hi * ldc : res;
        f32x4 gv[2][2];
#pragma unroll
        for (int bj = 0; bj < 2; ++bj)
#pragma unroll
            for (int n = 0; n < 2; ++n) gv[bj][n] = *(const f32x4*)(gate + col0 + bj * HALF + n * 16) * coef;
#pragma unroll
        for (int ai = 0; ai < 2; ++ai) if ((u.msk >> ai) & 1)
#pragma unroll
            for (int m = 0; m < 4; ++m) { const size_t off = (size_t)(row0 + ai * HALF + m * 16) * ldc + col0;
#pragma unroll
                for (int bj = 0; bj < 2; ++bj)
#pragma unroll
                    for (int n = 0; n < 2; ++n) {
                        f32x4 a = acc[ai][bj][m][n];
                        if (part) a += *(const f32x4*)(part + (size_t)((((ai * 2 + bj) * 4 + m) * 2 + n) * 512 * 4));
                        const f32x4 bs = *(const f32x4*)(rbase + off + bj * HALF + n * 16); *(f32x4*)(out + off + bj * HALF + n * 16) = bs + gv[bj][n] * a; }
                asm volatile("" ::: "memory"); }
    }
};
template <class Epi, class Sched, bool STAMP = false, int FP8 = 0>
__device__ __forceinline__ void gemm_phase(PG8_LAS unsigned char* lds, const Gemm g, const Sched& S, const Epi& E, unsigned long long* stamps) {
    const int tid = opaque_tid(), wid = __builtin_amdgcn_readfirstlane(tid >> 6), lane = tid & 63, wr = wid >> 2, wc = wid & 3, fr = lane & 15, fq = lane >> 4;
    const int K = g.K;
    int ts_lo = 0, ts_hi = 0, nts = 0; const unsigned long long rt_entry = STAMP ? (unsigned long long)wall_clock64() : 0ull;
#define PG8_STAMP() do { if (STAMP && wid == 0 && nts < 64) { const unsigned long long _c = (unsigned long long)clock64(); \
        ts_lo = (lane == nts) ? (int)(unsigned)_c : ts_lo; ts_hi = (lane == nts) ? (int)(unsigned)(_c >> 32) : ts_hi; ++nts; } } while (0)
    PG8_STAMP();
    unsigned voffA[2], voffB[2];
#pragma unroll
    for (int i = 0; i < 2; ++i) { int R, C; stage_rc(tid * 16 + i * 8192, R, C); const int Rb = Epi::PERM ? ((R & ~31) + perm32(R & 31)) : R;
        voffA[i] = (unsigned)(R * K + C) * 2u; voffB[i] = (unsigned)(Rb * K + C) * 2u; }
    const size_t kstep = (size_t)(BK * 2);
    const size_t hstep = (size_t)HALF * K * 2;
    const size_t tstep = 2 * hstep;
    const unsigned ldsw = (unsigned)wid * 1024u;
    const int aoff = lds_byte(wr * 64 + fr, fq * 8), boff = lds_byte(wc * 32 + fr, fq * 8);
#define PG8_SA(b, h) (((b) * 2 + (h)) * HTB)
#define PG8_SB(b, h) ((4 + (b) * 2 + (h)) * HTB)
#define PG8_STAGE(bufoff, gbase, voff) do { _Pragma("unroll") for (int _i = 0; _i < 2; ++_i) \
        __builtin_amdgcn_global_load_lds((const unsigned*)((const char*)(gbase) + (voff)[_i]), (PG8_LAS unsigned*)(lds + (bufoff) + ldsw + _i * 8192), 16, 0, 0); } while (0)
#define PG8_LDA(dst, b, h) do { _Pragma("unroll") for (int m = 0; m < 4; ++m) dst[m] = __builtin_shufflevector(*(const PG8_LAS v4i32*)(lds + PG8_SA(b, h) + aoff + m * 2048), *(const PG8_LAS v4i32*)(lds + PG8_SA(b, h) + aoff + m * 2048 + 1024), 0, 1, 2, 3, 4, 5, 6, 7); } while (0)
#define PG8_LDB(dst, b, h) do { _Pragma("unroll") for (int n = 0; n < 2; ++n) dst[n] = __builtin_shufflevector(*(const PG8_LAS v4i32*)(lds + PG8_SB(b, h) + boff + n * 2048), *(const PG8_LAS v4i32*)(lds + PG8_SB(b, h) + boff + n * 2048 + 1024), 0, 1, 2, 3, 4, 5, 6, 7); } while (0)
#define PG8_HALF(v, k) __builtin_bit_cast(bf16x8, __builtin_shufflevector(v, v, 4 * (k), 4 * (k) + 1, 4 * (k) + 2, 4 * (k) + 3))
#define PG8_MMA(ai, bj, At, Bt) do { __builtin_amdgcn_s_setprio(1); _Pragma("unroll") for (int m = 0; m < 4; ++m) _Pragma("unroll") for (int n = 0; n < 2; ++n) { \
        acc[ai][bj][m][n] = __builtin_amdgcn_mfma_f32_16x16x32_bf16(PG8_HALF(Bt[n], 0), PG8_HALF(At[m], 0), acc[ai][bj][m][n], 0, 0, 0); \
        acc[ai][bj][m][n] = __builtin_amdgcn_mfma_f32_16x16x32_bf16(PG8_HALF(Bt[n], 1), PG8_HALF(At[m], 1), acc[ai][bj][m][n], 0, 0, 0); } __builtin_amdgcn_s_setprio(0); } while (0)
#define PG8_MMA8(ai, bj, At, Bt) do { __builtin_amdgcn_s_setprio(1); _Pragma("unroll") for (int m = 0; m < 4; ++m) _Pragma("unroll") for (int n = 0; n < 2; ++n) \
        acc[ai][bj][m][n] = __builtin_amdgcn_mfma_scale_f32_16x16x128_f8f6f4(Bt[n], At[m], acc[ai][bj][m][n], 0, 0, 0, 127, 0, 127); __builtin_amdgcn_s_setprio(0); } while (0)
#define PG8_Q64(v, q) __builtin_bit_cast(long, __builtin_shufflevector(v, v, 2 * (q), 2 * (q) + 1))
#define PG8_M8L1(ai, bj, m, n, q) acc[ai][bj][m][n] = __builtin_amdgcn_mfma_f32_16x16x32_fp8_fp8(PG8_Q64(Bt_[n], q), PG8_Q64(At_[m], q), acc[ai][bj][m][n], 0, 0, 0)
#define PG8_MMA8L(ai, bj, At, Bt) do { auto& At_ = At; auto& Bt_ = Bt; __builtin_amdgcn_s_setprio(1); _Pragma("unroll") for (int m = 0; m < 4; ++m) _Pragma("unroll") for (int n = 0; n < 2; ++n) { \
        PG8_M8L1(ai, bj, m, n, 0); PG8_M8L1(ai, bj, m, n, 1); PG8_M8L1(ai, bj, m, n, 2); PG8_M8L1(ai, bj, m, n, 3); } __builtin_amdgcn_s_setprio(0); } while (0)
#define PG8_MMAG(ai, bj, At, Bt) do { if (mrow & (1 << (ai))) { if constexpr (FP8 == 1) PG8_MMA8(ai, bj, At, Bt); else if constexpr (FP8 == 2) PG8_MMA8L(ai, bj, At, Bt); else PG8_MMA(ai, bj, At, Bt); } } while (0)
#define PG8_WAIT_V(n) asm volatile("s_waitcnt vmcnt(" #n ")" ::: "memory")
#define PG8_WAIT_L(n) asm volatile("s_waitcnt lgkmcnt(" #n ")" ::: "memory")
#define PG8_BAR __builtin_amdgcn_s_barrier()
#define PG8_SCHED __builtin_amdgcn_sched_barrier(0)
    Unit cur, nxt; int ui = 0;
    if (!S.next(0, cur)) return;
    f32x4 acc[2][2][4][2];
#pragma unroll
    for (int a = 0; a < 2; ++a)
#pragma unroll
        for (int b = 0; b < 2; ++b)
#pragma unroll
            for (int m = 0; m < 4; ++m)
#pragma unroll
                for (int n = 0; n < 2; ++n) acc[a][b][m][n] = (f32x4){0.f, 0.f, 0.f, 0.f};
    v8i32 At[4], B0[2], B1[2];
    const char* cA = (const char*)g.A + (size_t)cur.pm * tstep + (size_t)cur.k0 * 2; const char* cB = (const char*)g.Bt + (size_t)cur.pn * tstep + (size_t)cur.k0 * 2;
    S.a_ready(cur);
    PG8_STAGE(PG8_SB(0, 0), cB, voffB); PG8_STAGE(PG8_SA(0, 0), cA, voffA); PG8_STAGE(PG8_SB(0, 1), cB + hstep, voffB); PG8_STAGE(PG8_SA(0, 1), cA + hstep, voffA);
    if (wr == 1) PG8_BAR;
    PG8_WAIT_V(4); PG8_BAR;
    PG8_STAGE(PG8_SB(1, 0), cB + kstep, voffB); PG8_STAGE(PG8_SA(1, 0), cA + kstep, voffA); PG8_STAGE(PG8_SB(1, 1), cB + hstep + kstep, voffB);
    PG8_WAIT_V(6); PG8_BAR;
    PG8_STAMP();
    for (;;) {
        const bool has_next = S.next(ui + 1, nxt);
        const char* nA = has_next ? (const char*)g.A + (size_t)nxt.pm * tstep + (size_t)nxt.k0 * 2 : cA; const char* nB = has_next ? (const char*)g.Bt + (size_t)nxt.pn * tstep + (size_t)nxt.k0 * 2 : cB;
        const int nt = cur.nt, mrow = cur.msk;
        for (int t = 0; t < nt; t += 2) {
            const bool last = (t == nt - 2);
            const char* a1 = cA + (size_t)(t + 1) * kstep;
            const char* a2 = last ? nA : cA + (size_t)(t + 2) * kstep; const char* b2 = last ? nB : cB + (size_t)(t + 2) * kstep;
            const char* a3 = a2 + kstep; const char* b3 = b2 + kstep;
            if (last && has_next) S.a_ready(nxt);
            PG8_LDB(B0, 0, 0); PG8_SCHED; PG8_LDA(At, 0, 0); PG8_STAGE(PG8_SA(1, 1), a1 + hstep, voffA);
            PG8_WAIT_L(8); PG8_BAR; PG8_WAIT_L(0); PG8_MMAG(0, 0, At, B0); PG8_BAR; PG8_SCHED;
            PG8_LDB(B1, 0, 1); PG8_STAGE(PG8_SB(0, 0), b2, voffB);
            PG8_BAR; PG8_WAIT_L(0); PG8_MMAG(0, 1, At, B1); PG8_BAR;
            PG8_LDA(At, 0, 1); PG8_STAGE(PG8_SA(0, 0), a2, voffA);
            PG8_BAR; PG8_WAIT_L(0); PG8_MMAG(1, 0, At, B0); PG8_BAR; PG8_SCHED;
            PG8_STAGE(PG8_SB(0, 1), b2 + hstep, voffB);
            PG8_WAIT_V(6); PG8_BAR; PG8_MMAG(1, 1, At, B1); PG8_BAR;
            PG8_LDB(B0, 1, 0); PG8_SCHED; PG8_LDA(At, 1, 0); PG8_STAGE(PG8_SA(0, 1), a2 + hstep, voffA);
            PG8_WAIT_L(8); PG8_BAR; PG8_WAIT_L(0); PG8_MMAG(0, 0, At, B0); PG8_BAR; PG8_SCHED;
            PG8_LDB(B1, 1, 1); PG8_STAGE(PG8_SB(1, 0), b3, voffB);
            PG8_BAR; PG8_WAIT_L(0); PG8_MMAG(0, 1, At, B1); PG8_BAR;
            PG8_LDA(At, 1, 1); PG8_STAGE(PG8_SA(1, 0), a3, voffA);
            PG8_BAR; PG8_WAIT_L(0); PG8_MMAG(1, 0, At, B0); PG8_BAR; PG8_SCHED;
            PG8_STAGE(PG8_SB(1, 1), b3 + hstep, voffB);
            PG8_WAIT_V(6); PG8_BAR; PG8_MMAG(1, 1, At, B1); PG8_BAR;
        }
        PG8_STAMP();
        if constexpr (!Epi::AFTER_DRAIN) { E(acc, cur, wr, wc, fr, fq); S.done(cur); }
        PG8_STAMP();
        if (!has_next) break;
#pragma unroll
        for (int a = 0; a < 2; ++a)
#pragma unroll
            for (int b = 0; b < 2; ++b)
#pragma unroll
                for (int m = 0; m < 4; ++m)
#pragma unroll
                    for (int n = 0; n < 2; ++n) acc[a][b][m][n] = (f32x4){0.f, 0.f, 0.f, 0.f};
        cur = nxt; cA = nA; cB = nB; ++ui;
    }
    PG8_WAIT_V(0);
    if (wr == 0) PG8_BAR;
    PG8_BAR;
    if constexpr (Epi::AFTER_DRAIN) { E.fused(acc, cur, wr, wc, fr, fq, lds, wid, lane); S.done(cur); }
    PG8_STAMP();
    if (STAMP && wid == 0) { stamps[lane] = lane < nts ? (((unsigned long long)(unsigned)ts_hi << 32) | (unsigned)ts_lo) : 0ull;
        if (lane == 62) stamps[62] = rt_entry; if (lane == 63) stamps[63] = (unsigned long long)wall_clock64(); }
#undef PG8_STAMP
#undef PG8_SA
#undef PG8_SB
#undef PG8_STAGE
#undef PG8_LDA
#undef PG8_LDB
#undef PG8_HALF
#undef PG8_MMA
#undef PG8_MMA8
#undef PG8_MMA8L
#undef PG8_M8L1
#undef PG8_Q64
#undef PG8_MMAG
#undef PG8_WAIT_V
#undef PG8_WAIT_L
#undef PG8_BAR
#undef PG8_SCHED
}
}
#ifndef ATT_INLINE
#define ATT_INLINE __forceinline__
#endif
namespace att {
constexpr int D = 128, NW = 8, QBLK = 32, KVBLK = 64, LDQ = 512, LDO = DM;
constexpr float SCALE = 0.088388347648318440f;
constexpr float THR = 8.f;
constexpr size_t SHM_V = KVBLK * D * 2, SHM_K = KVBLK * D * 2, SHM_Q = 256 * D * 2, SHM_ATTN = 2 * SHM_V + 2 * SHM_K + NW * 64 * 4 + SHM_Q;
using bf16x8 = __attribute__((ext_vector_type(8))) short;
using s16x4  = __attribute__((ext_vector_type(4))) short;
using f32x16 = __attribute__((ext_vector_type(16))) float;
using u32x4  = __attribute__((ext_vector_type(4))) unsigned;
#define KSWZ(row, colB) ((row) * 256 + ((colB) ^ (((row) & 7) << 4)))
#define SBAR() __builtin_amdgcn_sched_barrier(0)
__device__ __forceinline__ int crow(int r, int hi) { return (r & 3) + 8 * (r >> 2) + 4 * hi; }
__device__ __forceinline__ unsigned cvtpk(float lo, float hi) { unsigned r; asm volatile("v_cvt_pk_bf16_f32 %0, %1, %2" : "=v"(r) : "v"(lo), "v"(hi)); return r; }

__device__ __forceinline__ void partialSM(f32x16& p0, f32x16& p1, float& m_reg, float& mn, float& alpha) {
  constexpr float C = SCALE * 1.4426950408889634f;
  float pmax = p0[0]; for (int r = 1; r < 16; ++r) pmax = fmaxf(pmax, p0[r]); for (int r = 0; r < 16; ++r) pmax = fmaxf(pmax, p1[r]);
  { auto rr = __builtin_amdgcn_permlane32_swap(__float_as_uint(pmax), __float_as_uint(pmax), false, false);
    pmax = fmaxf(__uint_as_float(rr[0]), __uint_as_float(rr[1])); }
  if (__builtin_expect(__all(pmax - m_reg <= THR / SCALE), 1)) { mn = m_reg; alpha = 1.f; }
  else { mn = fmaxf(m_reg, pmax); alpha = __builtin_amdgcn_exp2f((m_reg - mn) * C); m_reg = mn; }
  float mnC = -mn * C;
  for (int r = 0; r < 16; ++r) p0[r] = fmaf(p0[r], C, mnC); for (int r = 0; r < 16; ++r) p1[r] = fmaf(p1[r], C, mnC);
  for (int r = 0; r < 16; ++r) p0[r] = __builtin_amdgcn_exp2f(p0[r]);
}
__device__ __forceinline__ void finishSM(f32x16& p0, f32x16& p1, float alpha, float& l_reg, bf16x8& pa0, bf16x8& pa1, bf16x8& pa2, bf16x8& pa3) {
  for (int r = 0; r < 16; ++r) p1[r] = __builtin_amdgcn_exp2f(p1[r]);
  float ps = 0; for (int r = 0; r < 16; ++r) ps += p0[r]; for (int r = 0; r < 16; ++r) ps += p1[r];
  { auto rr = __builtin_amdgcn_permlane32_swap(__float_as_uint(ps), __float_as_uint(ps), false, false);
    ps = __uint_as_float(rr[0]) + __uint_as_float(rr[1]); }
  l_reg = l_reg * alpha + ps;
#define PK4(P, BASE, OUT) do { unsigned a0 = cvtpk(P[BASE + 0], P[BASE + 1]), a1 = cvtpk(P[BASE + 2], P[BASE + 3]);   \
    unsigned b0 = cvtpk(P[BASE + 4], P[BASE + 5]), b1 = cvtpk(P[BASE + 6], P[BASE + 7]);                              \
    auto r0 = __builtin_amdgcn_permlane32_swap(a0, b0, false, false); auto r1 = __builtin_amdgcn_permlane32_swap(a1, b1, false, false); \
    u32x4 w = {r0[0], r1[0], r0[1], r1[1]}; OUT = *reinterpret_cast<bf16x8*>(&w); } while (0)
  PK4(p0, 0, pa0); PK4(p0, 8, pa1); PK4(p1, 0, pa2); PK4(p1, 8, pa3);
#undef PK4
}
__device__ __forceinline__ void qkt(f32x16& p0, f32x16& p1, const bf16_t* Ks, const bf16_t* Qs, int qrow, int r32, int hi) {
  p0 = f32x16{}; p1 = f32x16{};
#pragma unroll
  for (int d0 = 0; d0 < 8; ++d0) { int cb = (d0 * 16 + hi * 8) * 2;
    bf16x8 q = *reinterpret_cast<const bf16x8*>((const char*)Qs + KSWZ(qrow, cb));
    bf16x8 b0 = *reinterpret_cast<const bf16x8*>((const char*)Ks + KSWZ(r32, cb));
    bf16x8 b1 = *reinterpret_cast<const bf16x8*>((const char*)Ks + KSWZ(32 + r32, cb));
    p0 = __builtin_amdgcn_mfma_f32_32x32x16_bf16(b0, q, p0, 0, 0, 0);
    p1 = __builtin_amdgcn_mfma_f32_32x32x16_bf16(b1, q, p1, 0, 0, 0); }
}
__device__ __forceinline__ int v_st(int k, int c) { const int kk = (k & ~0xC) | ((k & 4) << 1) | ((k & 8) >> 1); return ((kk >> 3) * 4 + (c >> 5)) * 512 + ((kk & 7) * 32 + (c & 31)) * 2; }
__device__ __forceinline__ int v_rd_base(int lane) { return ((lane & 3) << 3) | (((lane >> 2) & 3) << 6) | (((lane >> 4) & 1) << 5) | (((lane >> 5) & 1) << 8); }
constexpr int v_rd_off(int d0, int ks, int half) { return d0 * 512 + ks * 4096 + half * 2048; }
template <int OFF> __device__ __forceinline__ s16x4 tr_read(int vb) {
  s16x4 r; asm volatile("ds_read_b64_tr_b16 %0, %1 offset:%2" : "=&v"(r) : "v"(vb), "i"(OFF) : "memory"); return r;
}
template <int D0> __device__ __forceinline__ void pv_one(f32x16& od, int vb, bf16x8 pa0, bf16x8 pa1, bf16x8 pa2, bf16x8 pa3) {
  const s16x4 l0 = tr_read<v_rd_off(D0, 0, 0)>(vb), h0 = tr_read<v_rd_off(D0, 0, 1)>(vb), l1 = tr_read<v_rd_off(D0, 1, 0)>(vb), h1 = tr_read<v_rd_off(D0, 1, 1)>(vb);
  const s16x4 l2 = tr_read<v_rd_off(D0, 2, 0)>(vb), h2 = tr_read<v_rd_off(D0, 2, 1)>(vb), l3 = tr_read<v_rd_off(D0, 3, 0)>(vb), h3 = tr_read<v_rd_off(D0, 3, 1)>(vb);
  asm volatile("s_waitcnt lgkmcnt(0)" ::: "memory"); SBAR();
#define PK(L, H) (bf16x8){L[0], L[1], L[2], L[3], H[0], H[1], H[2], H[3]}
  od = __builtin_amdgcn_mfma_f32_32x32x16_bf16(pa0, PK(l0, h0), od, 0, 0, 0);
  od = __builtin_amdgcn_mfma_f32_32x32x16_bf16(pa1, PK(l1, h1), od, 0, 0, 0);
  od = __builtin_amdgcn_mfma_f32_32x32x16_bf16(pa2, PK(l2, h2), od, 0, 0, 0);
  od = __builtin_amdgcn_mfma_f32_32x32x16_bf16(pa3, PK(l3, h3), od, 0, 0, 0);
#undef PK
}
__device__ __forceinline__ void pv_d0(f32x16* o, int vb, bf16x8 pa0, bf16x8 pa1, bf16x8 pa2, bf16x8 pa3) {
  pv_one<0>(o[0], vb, pa0, pa1, pa2, pa3); pv_one<1>(o[1], vb, pa0, pa1, pa2, pa3); pv_one<2>(o[2], vb, pa0, pa1, pa2, pa3); pv_one<3>(o[3], vb, pa0, pa1, pa2, pa3);
}

struct SrcOne { const bf16_t* k0; const bf16_t* v0; int ldk;
  __device__ __forceinline__ const bf16_t* k(int j) const { return k0 + (size_t)j * 64 * ldk; }
  __device__ __forceinline__ const bf16_t* v(int j) const { return v0 + (size_t)j * 64 * ldk; } };
struct SrcTwo { const bf16_t* ck; const bf16_t* cv; const bf16_t* k1; const bf16_t* v1; int ldk;
  __device__ __forceinline__ const bf16_t* k(int j) const { return j < 4 ? ck + (size_t)j * 64 * ldk : k1 + (size_t)(j - 4) * 64 * ldk; }
  __device__ __forceinline__ const bf16_t* v(int j) const { return j < 4 ? cv + (size_t)j * 64 * ldk : v1 + (size_t)(j - 4) * 64 * ldk; } };
struct NoBias { __device__ __forceinline__ void operator()(f32x16&, f32x16&, int, int, int, int) const {} };
struct NaBias { const float* tab; int i0, kr0;
  __device__ __forceinline__ void operator()(f32x16& p0, f32x16& p1, int jt, int wid, int r32, int hi) const {
    if (jt < 4) return;
    const int qi = i0 + wid * QBLK + r32, r = qi >> 6, qc = qi & 63, kr = kr0 + jt - 4;
    int lo = r - 4; lo = lo < 0 ? 0 : (lo > 8 ? 8 : lo);
    const bool rowok = (kr >= lo) && (kr < lo + 8);
    if (!rowok) {
#pragma unroll
      for (int rr = 0; rr < 16; ++rr) { p0[rr] = -1e30f; p1[rr] = -1e30f; }
      return;
    }
    int c0 = qc - 8; c0 = c0 < 0 ? 0 : (c0 > 48 ? 48 : c0);
    const int dr = kr - r + 7;
    const float* tb = tab + dr * 31 + (4 * hi - qc + 15);
    const int w0 = 4 * hi - c0;
#pragma unroll
    for (int g = 0; g < 4; ++g) {
#pragma unroll
      for (int q = 0; q < 4; ++q) {
        const int rr = 4 * g + q, kc0 = q + 8 * g;
        const float t0 = tb[kc0], t1 = tb[kc0 + 32];
        p0[rr] = ((unsigned)(kc0 + w0) < 16u) ? p0[rr] + t0 : -1e30f;
        p1[rr] = ((unsigned)(kc0 + 32 + w0) < 16u) ? p1[rr] + t1 : -1e30f;
      }
      SBAR();
    }
  } };

template <int SD, class Src, class Bias>
__device__ ATT_INLINE void attn_body(const bf16_t* __restrict__ Qb, const Src src, bf16_t* __restrict__ Ob, const int NT, char* lds, const Bias bias) {
  const int tid = opaque_tid(), wid = tid >> 6, lane = tid & 63, r32 = lane & 31, hi = lane >> 5;
  const int LDK = src.ldk;
  bf16_t* V_lds = (bf16_t*)lds; bf16_t* K_lds = (bf16_t*)(lds + 2 * SHM_V);
  float* ws = (float*)(lds + 2 * SHM_V + 2 * SHM_K) + wid * 64; float* li_l = ws; float* al_l = ws + 32;
  float m_reg = -1e30f, l_reg = 0; f32x16 o[4] = {};
  bf16_t* Q_lds = (bf16_t*)(lds + 2 * SHM_V + 2 * SHM_K + NW * 64 * 4);
  const int qrow = wid * QBLK + r32;
  {
#pragma unroll
    for (int i = 0; i < 8; ++i) { const int f = tid + 512 * i, row = f >> 4, c8 = (f & 15) * 8;
      *(bf16x8*)((char*)Q_lds + KSWZ(row, c8 * 2)) = *reinterpret_cast<const bf16x8*>(Qb + (long)row * LDQ + c8); }
  }
  const int sr = tid >> 4, sc = (tid & 15) * 8, vst0 = v_st(sr, sc), vst1 = v_st(32 + sr, sc);
  const int vb0 = (int)(uintptr_t)V_lds + v_rd_base(lane);
  struct { bf16x8 vs0, vs1, ks0, ks1; } sr_[SD];
#define SLOAD(i, jt) do { const bf16_t* kt_ = src.k(jt); const bf16_t* vt_ = src.v(jt); \
    sr_[i].vs0 = *reinterpret_cast<const bf16x8*>(&vt_[(long)sr * LDK + sc]); sr_[i].vs1 = *reinterpret_cast<const bf16x8*>(&vt_[(long)(32 + sr) * LDK + sc]); \
    sr_[i].ks0 = *reinterpret_cast<const bf16x8*>(&kt_[(long)sr * LDK + sc]); sr_[i].ks1 = *reinterpret_cast<const bf16x8*>(&kt_[(long)(32 + sr) * LDK + sc]); } while (0)
#define SWRITE(b, i) do { *(bf16x8*)((char*)V_lds + (b) * SHM_V + vst0) = sr_[i].vs0;          \
    *(bf16x8*)((char*)V_lds + (b) * SHM_V + vst1) = sr_[i].vs1; int kc = sc * 2;               \
    *(bf16x8*)((char*)K_lds + (b) * SHM_K + KSWZ(sr, kc)) = sr_[i].ks0;                       \
    *(bf16x8*)((char*)K_lds + (b) * SHM_K + KSWZ(32 + sr, kc)) = sr_[i].ks1; } while (0)
#define SWAIT() do { if constexpr (SD == 2) asm volatile("s_waitcnt vmcnt(4)" ::: "memory"); else asm volatile("s_waitcnt vmcnt(0)" ::: "memory"); } while (0)
#define RESC(a) do { if (__any((a) < 1.f)) { if (hi == 0) al_l[r32] = (a); asm volatile("s_waitcnt lgkmcnt(0)" ::: "memory"); \
    for (int d = 0; d < 4; ++d) for (int r = 0; r < 16; ++r) o[d][r] *= al_l[crow(r, hi)]; } } while (0)
  f32x16 pA0, pA1, pB0, pB1; float mnA, mnB, alA, alB; bf16x8 pa0, pa1, pa2, pa3;
  constexpr int SE = 0, SO = SD - 1;
  SLOAD(SE, 0); asm volatile("s_waitcnt vmcnt(0)" ::: "memory"); SWRITE(0, SE); __syncthreads();
  qkt(pA0, pA1, K_lds, Q_lds, qrow, r32, hi); bias(pA0, pA1, 0, wid, r32, hi); partialSM(pA0, pA1, m_reg, mnA, alA);
  SLOAD(SO, 1); if constexpr (SD == 2) { if (2 < NT) SLOAD(SE, 2); }
  SWAIT(); SWRITE(1, SO); __syncthreads();
  for (int j = 1; j + 1 < NT; j += 2) {
    SBAR(); qkt(pB0, pB1, (bf16_t*)((char*)K_lds + SHM_K), Q_lds, qrow, r32, hi); bias(pB0, pB1, j, wid, r32, hi);
    finishSM(pA0, pA1, alA, l_reg, pa0, pa1, pa2, pa3); SBAR();
    SLOAD(SO, j + SD); SBAR();
    pv_d0(o, vb0, pa0, pa1, pa2, pa3); partialSM(pB0, pB1, m_reg, mnB, alB);
    __syncthreads(); SWAIT(); SWRITE(0, SE);
    RESC(alB); __syncthreads();
    SBAR(); qkt(pA0, pA1, K_lds, Q_lds, qrow, r32, hi); bias(pA0, pA1, j + 1, wid, r32, hi);
    finishSM(pB0, pB1, alB, l_reg, pa0, pa1, pa2, pa3); SBAR();
    if (SD == 1 || j + 3 < NT) SLOAD(SE, j + 1 + SD); SBAR();
    pv_d0(o, vb0 + (int)SHM_V, pa0, pa1, pa2, pa3); partialSM(pA0, pA1, m_reg, mnA, alA);
    __syncthreads(); SWAIT(); SWRITE(1, SO);
    RESC(alA); __syncthreads();
  }
  SBAR(); qkt(pB0, pB1, (bf16_t*)((char*)K_lds + SHM_K), Q_lds, qrow, r32, hi); bias(pB0, pB1, NT - 1, wid, r32, hi);
  finishSM(pA0, pA1, alA, l_reg, pa0, pa1, pa2, pa3); SBAR();
  pv_d0(o, vb0, pa0, pa1, pa2, pa3); partialSM(pB0, pB1, m_reg, mnB, alB);
  __syncthreads(); RESC(alB);
  finishSM(pB0, pB1, alB, l_reg, pa0, pa1, pa2, pa3); SBAR();
  pv_d0(o, vb0 + (int)SHM_V, pa0, pa1, pa2, pa3);
  if (hi == 0) li_l[r32] = l_reg; asm volatile("s_waitcnt lgkmcnt(0)" ::: "memory");
  float rli[16];
#pragma unroll
  for (int r = 0; r < 16; ++r) rli[r] = __builtin_amdgcn_rcpf(li_l[crow(r, hi)]);
  bf16_t* Ow = Ob + (long)(wid * QBLK) * LDO;
#pragma unroll
  for (int r = 0; r < 16; ++r) { int orow = crow(r, hi);
    for (int d0 = 0; d0 < 4; ++d0) Ow[(long)orow * LDO + d0 * 32 + r32] = f2bf(o[d0][r] * rli[r]); }
#undef SLOAD
#undef SWRITE
#undef SWAIT
#undef RESC
}
}
namespace gdn {
using att::bf16x8; using att::f32x16; using att::crow;
constexpr int C = 32, SK = 136, SS = 40;
constexpr int OFF_KT = 0, OFF_QT = OFF_KT + C * SK * 2, OFF_W = OFF_QT + C * SK * 2, OFF_KTT = OFF_W + C * SK * 2, OFF_VTT = OFF_KTT + 128 * SS * 2,
              OFF_VN = OFF_VTT + 128 * SS * 2, OFF_VNS = OFF_VN + 128 * SS * 2, OFF_ST = OFF_VNS + 128 * SS * 2, OFF_TB = OFF_ST + 128 * SK * 2,
              OFF_TBE = OFF_TB + C * SS * 2, OFF_ATT = OFF_TBE + C * SS * 2, OFF_L = OFF_ATT + C * SS * 2, OFF_SC = OFF_L + C * C * 4, GDN_LDS = OFF_SC + 1024;
template <int K>
__device__ __forceinline__ f32x16 mm(const bf16_t* A, int lda, const bf16_t* Bt, int ldb, int l32, int hi, f32x16 acc) {
#pragma unroll
    for (int k0 = 0; k0 < K; k0 += 16) {
        const bf16x8 a = *reinterpret_cast<const bf16x8*>(A + l32 * lda + k0 + 8 * hi);
        const bf16x8 b = *reinterpret_cast<const bf16x8*>(Bt + l32 * ldb + k0 + 8 * hi);
        acc = __builtin_amdgcn_mfma_f32_32x32x16_bf16(a, b, acc, 0, 0, 0);
    }
    return acc;
}
__device__ __forceinline__ uint2 pk4(float a, float b, float c, float d) { uint2 w; w.x = pack2(a, b); w.y = pack2(c, d); return w; }

__device__ __forceinline__ void gdn_chunked(const Params& p, int l, bool ctx, int b, int h, int dir, unsigned char* lds) {
    const int tid = opaque_tid(), wid = tid >> 6, lane = tid & 63, l32 = lane & 31, hi = lane >> 5;
    const int T = ctx ? CT : ::LT; const size_t m0 = ctx ? (size_t)b * CT : (size_t)MC + (size_t)b * ::LT;
    const bf16_t* DQ = WSP(bf16_t, WS_DQ); const bf16_t* DK = WSP(bf16_t, WS_DK); const bf16_t* DV = WSP(bf16_t, WS_DV); const float* DBA = WSP(float, WS_DBA);
    float* O = WSP(float, dir ? WS_DOB : WS_DOF);
    bf16_t* Kt = (bf16_t*)(lds + OFF_KT); bf16_t* Qt = (bf16_t*)(lds + OFF_QT); bf16_t* W = (bf16_t*)(lds + OFF_W); bf16_t* KT = (bf16_t*)(lds + OFF_KTT); bf16_t* VT = (bf16_t*)(lds + OFF_VTT);
    bf16_t* VN = (bf16_t*)(lds + OFF_VN); bf16_t* VNS = (bf16_t*)(lds + OFF_VNS); bf16_t* ST = (bf16_t*)(lds + OFF_ST); bf16_t* TB = (bf16_t*)(lds + OFF_TB); bf16_t* TBE = (bf16_t*)(lds + OFF_TBE);
    bf16_t* ATT = (bf16_t*)(lds + OFF_ATT); float* Lm = (float*)(lds + OFF_L); float* sc = (float*)(lds + OFF_SC);
    const int nch = T / C;
#define TOK(c, s_) (m0 + (dir ? T - 1 - ((c) * C + (s_)) : (c) * C + (s_)))
    f32x16 S[2];
#pragma unroll
    for (int bi = 0; bi < 2; ++bi) {
        const int blk = wid * 2 + bi, d0 = 32 * (blk >> 2), e0 = 32 * (blk & 3);
        if (ctx) { S[bi] = f32x16{}; }
        else {
            const float* s0 = p.in[I_SGDN] + ((((size_t)b * DEPTH + l) * 2 + dir) * 4 + h) * 128 * 128 + e0 + l32;
#pragma unroll
            for (int r = 0; r < 16; ++r) S[bi][r] = s0[(size_t)(d0 + crow(r, hi)) * 128];
        }
    }
    const int ls = tid >> 5, lc = (tid & 31) * 4;
    vf4 pq0, pq1, pk0, pk1, pv0, pv1; float pbeta = 0.f, pg = 0.f;
#define GLOAD(c) do { const size_t ma = TOK(c, ls), mb = TOK(c, ls + 16); \
        pq0 = ld4bf(DQ + ma * 512 + h * 128 + lc); pq1 = ld4bf(DQ + mb * 512 + h * 128 + lc); \
        pk0 = ld4bf(DK + ma * 512 + h * 128 + lc); pk1 = ld4bf(DK + mb * 512 + h * 128 + lc); \
        pv0 = ld4bf(DV + ma * 512 + h * 128 + lc); pv1 = ld4bf(DV + mb * 512 + h * 128 + lc); \
        if (tid < C) { const size_t mt = TOK(c, tid); pbeta = DBA[mt * 16 + dir * 4 + h]; pg = DBA[mt * 16 + 8 + dir * 4 + h]; } } while (0)
#define GSTAGE() do { \
        *(uint2*)(Kt + ls * SK + lc) = pk4(pk0.x, pk0.y, pk0.z, pk0.w); *(uint2*)(Kt + (ls + 16) * SK + lc) = pk4(pk1.x, pk1.y, pk1.z, pk1.w); \
        *(uint2*)(Qt + ls * SK + lc) = pk4(pq0.x, pq0.y, pq0.z, pq0.w); *(uint2*)(Qt + (ls + 16) * SK + lc) = pk4(pq1.x, pq1.y, pq1.z, pq1.w); \
        _Pragma("unroll") for (int j = 0; j < 4; ++j) { KT[(lc + j) * SS + ls] = f2bf(pk0[j]); KT[(lc + j) * SS + ls + 16] = f2bf(pk1[j]); \
                                                        VT[(lc + j) * SS + ls] = f2bf(pv0[j]); VT[(lc + j) * SS + ls + 16] = f2bf(pv1[j]); } \
        if (wid == 0) { float x = pg; _Pragma("unroll") for (int o_ = 1; o_ < 32; o_ <<= 1) { const float y = __shfl_up(x, o_); if (lane >= o_) x += y; } \
            const float Bt_ = __shfl(x, 31); if (lane < C) { sc[lane] = pbeta; sc[32 + lane] = x; sc[64 + lane] = __expf(x); sc[96 + lane] = __expf(Bt_ - x); if (lane == 0) sc[128] = __expf(Bt_); } } } while (0)
    __syncthreads();
    GLOAD(0);
#pragma unroll
    for (int bi = 0; bi < 2; ++bi) {
        const int blk = wid * 2 + bi, d0 = 32 * (blk >> 2), e0 = 32 * (blk & 3);
#pragma unroll
        for (int g = 0; g < 4; ++g) *(uint2*)(ST + (e0 + l32) * SK + d0 + 8 * g + 4 * hi) = pk4(S[bi][4 * g], S[bi][4 * g + 1], S[bi][4 * g + 2], S[bi][4 * g + 3]);
    }
    GSTAGE();
    __syncthreads();
    for (int c = 0; c < nch; ++c) {
        if (c + 1 < nch) GLOAD(c + 1);
        f32x16 acc1 = f32x16{};
        if (wid == 0) {
            const f32x16 kk = mm<128>(Kt, SK, Kt, SK, l32, hi, f32x16{});
            const float bi_ = sc[32 + l32], be = sc[l32];
#pragma unroll
            for (int r = 0; r < 16; ++r) { const int j = crow(r, hi); const float v = (l32 > j) ? be * kk[r] * __expf(bi_ - sc[32 + j]) : 0.f;
                Lm[l32 * 32 + ((r & 3) + 4 * hi) * 4 + (r >> 2)] = v; }
        } else if (wid == 1) {
            const f32x16 kq = mm<128>(Kt, SK, Qt, SK, l32, hi, f32x16{});
            const float bi_ = sc[32 + l32];
            float a[16];
#pragma unroll
            for (int r = 0; r < 16; ++r) { const int j = crow(r, hi); a[r] = (l32 >= j) ? kq[r] * __expf(bi_ - sc[32 + j]) : 0.f; }
#pragma unroll
            for (int g = 0; g < 4; ++g) *(uint2*)(ATT + l32 * SS + 8 * g + 4 * hi) = pk4(a[4 * g], a[4 * g + 1], a[4 * g + 2], a[4 * g + 3]);
        } else if (wid >= 4) {
            acc1 = mm<128>(Qt, SK, ST + (32 * (wid - 4)) * SK, SK, l32, hi, f32x16{});
#pragma unroll
            for (int r = 0; r < 16; ++r) acc1[r] *= sc[64 + crow(r, hi)];
        }
        __syncthreads();
        if (tid < 256) {
            const int cc = tid >> 3, part = tid & 7;
            float Tr[4] = {0.f, 0.f, 0.f, 0.f};
            const float* Lp = Lm + part * 4;
#pragma unroll
            for (int i = 0; i < 32; ++i) {
                const vf4 lv = *(const vf4*)(Lp + i * 32);
                float s = lv.x * Tr[0] + lv.y * Tr[1] + lv.z * Tr[2] + lv.w * Tr[3];
                s = red8(s);
                const float t = (i == cc ? 1.f : 0.f) - s;
                if (part == (i & 7)) Tr[i >> 3] = t;
            }
            const float bc = sc[cc], bec = bc * sc[64 + cc];
#pragma unroll
            for (int jj = 0; jj < 4; ++jj) { TB[(part + 8 * jj) * SS + cc] = f2bf(Tr[jj] * bc); TBE[(part + 8 * jj) * SS + cc] = f2bf(Tr[jj] * bec); }
        }
        __syncthreads();
        if (wid < 4) {
            acc1 = mm<32>(TB, SS, VT + (32 * wid) * SS, SS, l32, hi, f32x16{});
        } else {
            const int d0 = 32 * (wid - 4);
            const f32x16 wt = mm<32>(KT + d0 * SS, SS, TBE, SS, l32, hi, f32x16{});
#pragma unroll
            for (int g = 0; g < 4; ++g) *(uint2*)(W + l32 * SK + d0 + 8 * g + 4 * hi) = pk4(wt[4 * g], wt[4 * g + 1], wt[4 * g + 2], wt[4 * g + 3]);
        }
        __syncthreads();
        if (wid < 4) {
            const int e0 = 32 * wid;
            const f32x16 ws = mm<128>(W, SK, ST + e0 * SK, SK, l32, hi, f32x16{});
            float vn[16], vs[16];
#pragma unroll
            for (int r = 0; r < 16; ++r) { vn[r] = acc1[r] - ws[r]; vs[r] = vn[r] * sc[96 + crow(r, hi)]; }
#pragma unroll
            for (int g = 0; g < 4; ++g) { *(uint2*)(VN + (e0 + l32) * SS + 8 * g + 4 * hi) = pk4(vn[4 * g], vn[4 * g + 1], vn[4 * g + 2], vn[4 * g + 3]);
                                          *(uint2*)(VNS + (e0 + l32) * SS + 8 * g + 4 * hi) = pk4(vs[4 * g], vs[4 * g + 1], vs[4 * g + 2], vs[4 * g + 3]); }
        }
        __syncthreads();
        if (wid >= 4) {
            const int e0 = 32 * (wid - 4);
            acc1 = mm<32>(ATT, SS, VN + e0 * SS, SS, l32, hi, acc1);
#pragma unroll
            for (int r = 0; r < 16; ++r) O[TOK(c, crow(r, hi)) * 512 + h * 128 + e0 + l32] = acc1[r];
        }
        {
            const float eB = sc[128];
#pragma unroll
            for (int bi = 0; bi < 2; ++bi) {
                const int blk = wid * 2 + bi, d0 = 32 * (blk >> 2), e0 = 32 * (blk & 3);
#pragma unroll
                for (int r = 0; r < 16; ++r) S[bi][r] *= eB;
                S[bi] = mm<32>(KT + d0 * SS, SS, VNS + e0 * SS, SS, l32, hi, S[bi]);
            }
        }
        __syncthreads();
#pragma unroll
        for (int bi = 0; bi < 2; ++bi) {
            const int blk = wid * 2 + bi, d0 = 32 * (blk >> 2), e0 = 32 * (blk & 3);
#pragma unroll
            for (int g = 0; g < 4; ++g) *(uint2*)(ST + (e0 + l32) * SK + d0 + 8 * g + 4 * hi) = pk4(S[bi][4 * g], S[bi][4 * g + 1], S[bi][4 * g + 2], S[bi][4 * g + 3]);
        }
        if (c + 1 < nch) GSTAGE();
        __syncthreads();
    }
#undef GLOAD
#undef GSTAGE
#undef TOK
    if (ctx) {
#pragma unroll
        for (int bi = 0; bi < 2; ++bi) {
            const int blk = wid * 2 + bi, d0 = 32 * (blk >> 2), e0 = 32 * (blk & 3);
            float* so = p.out + O_SGDN + ((((size_t)b * DEPTH + l) * 2 + dir) * 4 + h) * 128 * 128 + e0 + l32;
#pragma unroll
            for (int r = 0; r < 16; ++r) so[(size_t)(d0 + crow(r, hi)) * 128] = S[bi][r];
        }
    }
}
}

namespace gla {
using att::bf16x8; using att::f32x16; using att::crow; using gdn::mm; using gdn::pk4;
constexpr int C = 32, SQ = 72, SS = 40;
constexpr int OFF_QE = 0, OFF_KN = OFF_QE + C * SQ * 2, OFF_KET = OFF_KN + C * SQ * 2, OFF_VT = OFF_KET + 64 * SS * 2, OFF_ATT = OFF_VT + 128 * SS * 2, OFF_ST = OFF_ATT + C * SS * 2,
              OFF_LA = OFF_ST + 128 * SQ * 2, OFF_EB = OFF_LA + C * 64 * 4, GLA_LDS = OFF_EB + 256;
__device__ __forceinline__ void gla_chunked(const Params& p, int l, bool ctx, int b, int h, int dir, unsigned char* lds) {
    const int tid = opaque_tid(), wid = tid >> 6, lane = tid & 63, l32 = lane & 31, hi = lane >> 5;
    const int T = ctx ? CT : ::LT; const size_t m0 = ctx ? (size_t)b * CT : (size_t)MC + (size_t)b * ::LT;
    const bf16_t* Z = WSP(bf16_t, WS_Z); const float* LA = WSP(float, dir ? WS_AB : WS_AF);
    float* O = WSP(float, dir ? WS_GOB : WS_GOF);
    bf16_t* Qe = (bf16_t*)(lds + OFF_QE); bf16_t* Kn = (bf16_t*)(lds + OFF_KN); bf16_t* KeT = (bf16_t*)(lds + OFF_KET); bf16_t* VT = (bf16_t*)(lds + OFF_VT);
    bf16_t* ATT = (bf16_t*)(lds + OFF_ATT); bf16_t* ST = (bf16_t*)(lds + OFF_ST); float* la = (float*)(lds + OFF_LA); float* eB = (float*)(lds + OFF_EB);
    const int nch = T / C;
#define TOK(c, s_) (m0 + (dir ? T - 1 - ((c) * C + (s_)) : (c) * C + (s_)))
    const int d0 = 32 * (wid >> 2), e0 = 32 * (wid & 3);
    f32x16 S;
    if (ctx) S = f32x16{};
    else {
        const float* s0 = p.in[I_SGLA] + ((((size_t)b * DEPTH + l) * 2 + dir) * 4 + h) * 64 * 128 + e0 + l32;
#pragma unroll
        for (int r = 0; r < 16; ++r) S[r] = s0[(size_t)(d0 + crow(r, hi)) * 128];
    }
    const int ts = tid >> 4, dc = (tid & 15) * 4, vs = tid >> 5, vc = (tid & 31) * 4;
    vf4 pq, pk, pl, pv0, pv1;
#define GLOAD(c) do { const size_t mt = TOK(c, ts), ma = TOK(c, vs), mb = TOK(c, vs + 16); \
        pq = ld4bf(Z + mt * NINP + Z_GLQ + h * 64 + dc); pk = ld4bf(Z + mt * NINP + Z_GLK + h * 64 + dc); pl = *(const vf4*)(LA + mt * 256 + h * 64 + dc); \
        pv0 = ld4bf(Z + ma * NINP + Z_GLV + h * 128 + vc); pv1 = ld4bf(Z + mb * NINP + Z_GLV + h * 128 + vc); } while (0)
#define WRITE_ST() do { _Pragma("unroll") for (int g = 0; g < 4; ++g) *(uint2*)(ST + (e0 + l32) * SQ + d0 + 8 * g + 4 * hi) = pk4(S[4 * g], S[4 * g + 1], S[4 * g + 2], S[4 * g + 3]); } while (0)
#define GIMAGES() do { vf4 pre = (vf4){0.f, 0.f, 0.f, 0.f}, tot = pre; \
        _Pragma("unroll 8") for (int t_ = 0; t_ < C; ++t_) { const vf4 v_ = *(const vf4*)(la + t_ * 64 + dc); tot += v_; if (t_ <= ts) pre += v_; } \
        float qe[4], kn[4]; \
        _Pragma("unroll") for (int j = 0; j < 4; ++j) { qe[j] = pq[j] * 0.125f * __expf(pre[j]); kn[j] = pk[j] * __expf(fminf(-pre[j], 80.f)); \
            KeT[(dc + j) * SS + ts] = f2bf(pk[j] * __expf(tot[j] - pre[j])); } \
        *(uint2*)(Qe + ts * SQ + dc) = pk4(qe[0], qe[1], qe[2], qe[3]); *(uint2*)(Kn + ts * SQ + dc) = pk4(kn[0], kn[1], kn[2], kn[3]); \
        if (ts == 0) { _Pragma("unroll") for (int j = 0; j < 4; ++j) eB[dc + j] = __expf(tot[j]); } \
        _Pragma("unroll") for (int j = 0; j < 4; ++j) { VT[(vc + j) * SS + vs] = f2bf(pv0[j]); VT[(vc + j) * SS + vs + 16] = f2bf(pv1[j]); } } while (0)
    __syncthreads();
    GLOAD(0);
    WRITE_ST();
    *(vf4*)(la + ts * 64 + dc) = pl;
    __syncthreads();
    GIMAGES();
    __syncthreads();
    for (int c = 0; c < nch; ++c) {
        if (c + 1 < nch) GLOAD(c + 1);
        f32x16 o1 = f32x16{};
        if (wid == 0) {
            const f32x16 kq = mm<64>(Kn, SQ, Qe, SQ, l32, hi, f32x16{});
            float a[16];
#pragma unroll
            for (int r = 0; r < 16; ++r) a[r] = (l32 >= crow(r, hi)) ? kq[r] : 0.f;
#pragma unroll
            for (int g = 0; g < 4; ++g) *(uint2*)(ATT + l32 * SS + 8 * g + 4 * hi) = pk4(a[4 * g], a[4 * g + 1], a[4 * g + 2], a[4 * g + 3]);
        } else if (wid >= 4) {
            o1 = mm<64>(Qe, SQ, ST + (32 * (wid - 4)) * SQ, SQ, l32, hi, f32x16{});
        }
        __syncthreads();
        if (wid >= 4) {
            const int eo = 32 * (wid - 4);
            o1 = mm<32>(ATT, SS, VT + eo * SS, SS, l32, hi, o1);
#pragma unroll
            for (int r = 0; r < 16; ++r) O[TOK(c, crow(r, hi)) * 512 + h * 128 + eo + l32] = o1[r];
        }
#pragma unroll
        for (int r = 0; r < 16; ++r) S[r] *= eB[d0 + crow(r, hi)];
        S = mm<32>(KeT + d0 * SS, SS, VT + e0 * SS, SS, l32, hi, S);
        __syncthreads();
        WRITE_ST();
        if (c + 1 < nch) *(vf4*)(la + ts * 64 + dc) = pl;
        __syncthreads();
        if (c + 1 < nch) GIMAGES();
        __syncthreads();
    }
#undef GLOAD
#undef WRITE_ST
#undef GIMAGES
#undef TOK
    if (ctx) {
        float* so = p.out + O_SGLA + ((((size_t)b * DEPTH + l) * 2 + dir) * 4 + h) * 64 * 128 + e0 + l32;
#pragma unroll
        for (int r = 0; r < 16; ++r) so[(size_t)(d0 + crow(r, hi)) * 128] = S[r];
    }
}
}
#define LAS __attribute__((address_space(3)))
constexpr int LDS_BYTES = 147456, XBW_OFF = LDS_BYTES - 64;
constexpr int NPH = 1 + DEPTH * 12;
#ifndef DBG_NLAYERS
#define DBG_NLAYERS DEPTH
#endif

#ifndef DUPKIND
#define DUPKIND 0
#endif
__device__ __forceinline__ int opaque_int(int v) { asm volatile("" : "+s"(v)); return v; }
#ifndef MIXMASK
#define MIXMASK 0xFF
#endif
#define FOR_ITEMS(it, n, o, w) for (int bo_ = (o) * (int)gridDim.x / 256, bw_ = ((w) * (int)gridDim.x / 256) > 0 ? ((w) * (int)gridDim.x / 256) : 1, \
                                    it = ((int)blockIdx.x >= bo_ && (int)blockIdx.x < bo_ + bw_) ? (int)blockIdx.x - bo_ : (n); it < (n); it += bw_)

#ifndef SPLITK
#define SPLITK 0
#endif
#ifndef SPLITK_G4
#define SPLITK_G4 0
#endif
constexpr int FLAG_WORD0 = 8192;
constexpr int QCTR_WORD0 = 1024;
constexpr int NI_GDNL = LB * 8, NI_GLAL = LB * 8, NI_GDNC = CB * 8, NI_GQAL = LB * 16, NI_NAL = LB * 16, NI_GLAC = CB * 8, NI_NAC = CB * 4, NI_GQAC = CB * 4;
#define KM(k) (1 + ((DUPKIND >> (k)) & 1))
constexpr int Q0 = NI_GDNL * KM(0), Q1 = Q0 + NI_GQAL * KM(1), Q2 = Q1 + NI_NAL * KM(2), Q3 = Q2 + NI_GLAL * KM(3), Q4 = Q3 + NI_GDNC * KM(4), Q5 = Q4 + NI_NAC * KM(5), Q6 = Q5 + NI_GQAC * KM(6), Q7 = Q6 + NI_GLAC * KM(7);
__device__ __forceinline__ void phase_mix(const Params& p, int l, unsigned char* lds, int rep) {
    const int tid = opaque_tid();
    float* smem = (float*)lds;
    const bf16_t* NAQ = WSP(bf16_t, WS_NAQ); const bf16_t* NAK = WSP(bf16_t, WS_NAK); const bf16_t* NAV = WSP(bf16_t, WS_NAV);
    const bf16_t* GQ = WSP(bf16_t, WS_GQ); const bf16_t* GK = WSP(bf16_t, WS_GK); const bf16_t* GV = WSP(bf16_t, WS_GV);
    bf16_t* MRG = WSP(bf16_t, WS_MRG);
    unsigned* qctr = WSP(unsigned, WS_CTL) + QCTR_WORD0 + 64 * l + 16 * rep;
    volatile int* qslot = (volatile int*)(lds + XBW_OFF + 16);
    for (;;) {
        __syncthreads();
        if (tid == 0) *qslot = (int)__hip_atomic_fetch_add(qctr, 1u, __ATOMIC_RELAXED, __HIP_MEMORY_SCOPE_AGENT);
        __syncthreads();
        const int q = __builtin_amdgcn_readfirstlane(*qslot);
        if (q >= Q7) break;
        if (q < Q0) { const int it = q % NI_GDNL; gdn::gdn_chunked(p, l, false, it / 8, (it / 2) % 4, it % 2, lds); }
        else if (q < Q1) {
            const int it = (q - Q0) % NI_GQAL, b = it / 16, qh = (it / 4) % 4, qb = it % 4, kvh = qh >> 1;
            const size_t r0 = (size_t)MC + (size_t)b * LT;
            att::SrcTwo src{WSP(bf16_t, WS_CGK) + ((size_t)b * DEPTH + l) * 256 * 256 + kvh * 128, WSP(bf16_t, WS_CGV) + ((size_t)b * DEPTH + l) * 256 * 256 + kvh * 128,
                            GK + r0 * 256 + kvh * 128, GV + r0 * 256 + kvh * 128, 256};
            att::attn_body<2>(GQ + (r0 + qb * 256) * 512 + qh * 128, src, MRG + (r0 + qb * 256) * DM + 1024 + qh * 128, 4 + LT / 64, (char*)lds, att::NoBias{});
        }
        else if (q < Q2) {
            const int it = (q - Q1) % NI_NAL, b = it / 16, h = (it / 4) % 4, qb = it % 4;
            const int kr0 = qb == 0 ? 0 : qb == 1 ? 0 : qb == 2 ? 4 : 8, nrows = (qb == 0 || qb == 3) ? 8 : 12;
            const size_t r0 = (size_t)MC + (size_t)b * LT;
            float* tab = (float*)(lds + att::SHM_ATTN);
            if (tid < 15 * 31) tab[tid] = p.in[I_RPB][((size_t)l * 4 + h) * 15 * 31 + tid] * (1.0f / att::SCALE);
            att::SrcTwo src{WSP(bf16_t, WS_CNAK) + ((size_t)b * DEPTH + l) * 256 * 512 + h * 128, WSP(bf16_t, WS_CNAV) + ((size_t)b * DEPTH + l) * 256 * 512 + h * 128,
                            NAK + (r0 + kr0 * 64) * 512 + h * 128, NAV + (r0 + kr0 * 64) * 512 + h * 128, 512};
            att::attn_body<1>(NAQ + (r0 + qb * 256) * 512 + h * 128, src, MRG + (r0 + qb * 256) * DM + 0 + h * 128, 4 + nrows, (char*)lds, att::NaBias{tab, qb * 256, kr0});
        }
        else if (q < Q3) { const int it = (q - Q2) % NI_GLAL; gla::gla_chunked(p, l, false, it / 8, (it / 2) % 4, it % 2, lds); }
        else if (q < Q4) { const int it = (q - Q3) % NI_GDNC; gdn::gdn_chunked(p, l, true, it / 8, (it / 2) % 4, it % 2, lds); }
        else if (q < Q5) {
            const int it = (q - Q4) % NI_NAC, b = it / 4, h = it % 4; const size_t r0 = (size_t)b * CT;
            att::SrcOne src{NAK + r0 * 512 + h * 128, NAV + r0 * 512 + h * 128, 512};
            att::attn_body<2>(NAQ + r0 * 512 + h * 128, src, MRG + r0 * DM + 0 + h * 128, CT / 64, (char*)lds, att::NoBias{});
        }
        else if (q < Q6) {
            const int it = (q - Q5) % NI_GQAC, b = it / 4, qh = it % 4, kvh = qh >> 1; const size_t r0 = (size_t)b * CT;
            att::SrcOne src{GK + r0 * 256 + kvh * 128, GV + r0 * 256 + kvh * 128, 256};
            att::attn_body<2>(GQ + r0 * 512 + qh * 128, src, MRG + r0 * DM + 1024 + qh * 128, CT / 64, (char*)lds, att::NoBias{});
        }
        else { const int it = (q - Q6) % NI_GLAC; gla::gla_chunked(p, l, true, it / 8, (it / 2) % 4, it % 2, lds); }
    }
}

#define CONV_FILL(nunits, t0, t1, skip) do { if (l + 1 < DBG_NLAYERS) { const int G_ = (int)gridDim.x; int f0_ = ((nunits) % G_) + (skip); if (f0_ >= G_) f0_ = 0; \
        if ((int)blockIdx.x >= f0_) { const Params q = opaque_params(p); conv_layer_tiles(q, l + 1, (t0), (t1), (int)blockIdx.x - f0_, G_ - f0_, (float*)lds); } } } while (0)
#define G1A_MSPLIT (G1A_MODE == 1 ? 2 : 0)
#define G1B_MSPLIT (G1B_MODE == 1 ? 2 : 0)
#ifndef MSPLIT
#define MSPLIT 2
#endif
constexpr int TF0 = NT_L / 10, TF1 = NT_L / 4, TF2 = NT_L * 11 / 20;
static_assert(att::SHM_ATTN + 15 * 31 * 4 + 2048 <= (size_t)XBW_OFF, "LDS map");
static_assert((QCTR_WORD0 + 64 * DEPTH) < 4096, "ctl");
constexpr int BAR_WORD0 = 4096;
static_assert((BAR_WORD0 + XCD_BAR_WORDS) * 4 <= (int)CTL_BYTES, "ctl");

__global__ void __launch_bounds__(512, 2) fwd(Params p) {
    extern __shared__ __attribute__((aligned(16))) unsigned char lds[];
    const int tid = threadIdx.x;
    volatile LAS unsigned* xbw = (volatile LAS unsigned*)((LAS unsigned char*)lds + XBW_OFF);
    if (tid < 4) xbw[tid] = 0u;
    __syncthreads();
    XcdBarrier bar; bar.bar = WSP(unsigned, WS_CTL) + BAR_WORD0; bar.x = 0; bar.st = xbw;
    if (p.ph_hi - p.ph_lo > 1) bar = xcd_barrier_post(WSP(unsigned, WS_CTL) + BAR_WORD0, xbw);
#ifndef PHMASK
#define PHMASK 0x1FFF
#endif
#define IN(k) (p.ph_lo <= (k) && (k) < p.ph_hi)
#define INL(j) (((PHMASK >> ((j) + 1)) & 1) && IN(pb + (j)))
#ifndef DUPMASK
#define DUPMASK 0
#endif
#define DUP(j) ((DUPMASK >> ((j) + 1)) & 1)
#if DUPMASK
#define REPS(j) opaque_int(1 + DUP(j))
#else
#define REPS(j) 1
#endif
#ifndef DBLBAR
#define DBLBAR 0
#endif
#define SEAM(k) do { if (IN(k) && IN((k) + 1)) { xcd_barrier(bar); if (DBLBAR) xcd_barrier(bar); } } while (0)
    LAS unsigned char* ldsl = (LAS unsigned char*)lds;
    bf16_t* H = WSP(bf16_t, WS_H); bf16_t* ACT = WSP(bf16_t, WS_ACT); float* X = WSP(float, WS_X); float* Z = WSP(float, WS_Z); bf16_t* MRG = WSP(bf16_t, WS_MRG);

    if ((PHMASK & 1) && IN(0)) { const int reps_ = (DUPMASK & 1) ? opaque_int(2) : 1; for (int rep_ = 0; rep_ < reps_; ++rep_) { const Params q = opaque_params(p); phase_prologue(q, (float*)lds); __syncthreads(); } }
    SEAM(0);
    for (int l = 0; l < DBG_NLAYERS; ++l) {
        const int pb = 1 + l * 12;
        const float* modl = WSP(float, WS_MODV) + (size_t)l * NCOND * NMOD;
        if (INL(0)) { const int reps_ = REPS(0); for (int rep_ = 0; rep_ < reps_; ++rep_) { const Params q = opaque_params(p); phase_norm(q, l, 0); __syncthreads(); } }
        SEAM(pb + 0);
        if (INL(1)) {
            {
#if G1A_MODE
                pg8::Gemm g{H, (const bf16_t*)(WSP(unsigned char, WS_WGU) + ((size_t)l * 2 + 0) * NGU * DM * 2), M, NGU, DM / 2}; pg8::StaticOrder S; S.init(M, NGU, DM / 2, (int)gridDim.x, (int)blockIdx.x, G1A_MSPLIT);
                constexpr float ws_ = 1.0f / WGU_SCALE;
#else
                pg8::Gemm g{H, WSP(bf16_t, WS_WGU) + ((size_t)l * 2 + 0) * NGU * DM, M, NGU, DM}; pg8::StaticOrder S; S.init(M, NGU, DM, (int)gridDim.x, (int)blockIdx.x, G1A_MSPLIT);
                constexpr float ws_ = 1.0f;
#endif
#if G2_FP8
                pg8::EpiSwiGLU8 E{WSP(unsigned char, WS_ACT), FFP, ws_};
                for (int r_ = 0, n_ = REPS(1); r_ < n_; ++r_) pg8::gemm_phase<pg8::EpiSwiGLU8, pg8::StaticOrder, false, G1A_MODE>(ldsl, g, S, E, nullptr);
#else
                pg8::EpiSwiGLU E{ACT, FF};
                for (int r_ = 0, n_ = REPS(1); r_ < n_; ++r_) pg8::gemm_phase<pg8::EpiSwiGLU, pg8::StaticOrder, false, G1A_MODE>(ldsl, g, S, E, nullptr);
#endif
            }
#if CONV_FILLER
            if (l + 1 < DBG_NLAYERS) {
                const int nw_ = (M / 256) * (NGU / 256), G_ = (int)gridDim.x; int f0_ = nw_ % G_; if (nw_ < G_) f0_ = 0;
                const int nmb_ = (G_ - f0_ < NMOD / 128) ? (G_ - f0_) : NMOD / 128;
                if ((int)blockIdx.x >= f0_ && (int)blockIdx.x < f0_ + nmb_) { const Params q = opaque_params(p); mod_layer(q, l + 1, (int)blockIdx.x - f0_, nmb_, (float*)lds); }
            }
            CONV_FILL((M / 256) * (NGU / 256), 0, TF0, NMOD / 128 + (G1A_MSPLIT ? ((M / 256) * (NGU / 256)) % (int)gridDim.x : 0));
#endif
        }
        SEAM(pb + 1);
        if (INL(2)) {
            pg8::Gemm g{ACT, G2_FP8 ? (const bf16_t*)(WSP(unsigned char, WS_WDN) + ((size_t)l * 2 + 0) * DM * FFP) : WSP(bf16_t, WS_WDN) + ((size_t)l * 2 + 0) * DM * FF, M, DM, G2_FP8 ? FFP / 2 : FF}; pg8::StaticOrder S; S.init(M, DM, G2_FP8 ? FFP / 2 : FF, (int)gridDim.x, (int)blockIdx.x, SPLITK ? 1 : MSPLIT);
            pg8::EpiResid E{l == 0 ? p.in[I_XP] : X, X, DM, modl + 2 * DM, G2_FP8 ? 0.5f / WDN_SCALE : 0.5f, Z, WSP(unsigned, WS_CTL) + FLAG_WORD0, 8u * (unsigned)(l * (2 * SPLITK + SPLITK_G4) + SPLITK), l == 0 ? p.in[I_XS] : X, l == 0 ? MC : 0x7FFFFFFF};
            pg8::gemm_phase<pg8::EpiResid, pg8::StaticOrder, false, (G2_FP8 ? 1 : 0)>(ldsl, g, S, E, nullptr);
#if DUPMASK
            if (opaque_int(DUP(2))) { pg8::EpiResid E2{X, Z, DM, modl + 2 * DM, 0.5f, Z, WSP(unsigned, WS_CTL) + FLAG_WORD0, 0u, X, 0x7FFFFFFF}; pg8::gemm_phase<pg8::EpiResid, pg8::StaticOrder, false>(ldsl, g, S, E2, nullptr); }
#endif
        }
        SEAM(pb + 2);
        if (INL(3)) { const int reps_ = REPS(3); for (int rep_ = 0; rep_ < reps_; ++rep_) { const Params q = opaque_params(p); phase_norm(q, l, 1); __syncthreads(); } }
        SEAM(pb + 3);
        if (INL(4)) {
            pg8::Gemm g{H, WSP(bf16_t, WS_WIN) + (size_t)l * NINP * DM, M, NINP, DM}; pg8::StaticOrder S; S.init(M, NINP, DM, (int)gridDim.x, (int)blockIdx.x);
            pg8::EpiBf16Plain E{WSP(bf16_t, WS_Z), NINP};
            for (int r_ = 0, n_ = REPS(4); r_ < n_; ++r_) pg8::gemm_phase<pg8::EpiBf16Plain, pg8::StaticOrder, false>(ldsl, g, S, E, nullptr);
#if CONV_FILLER
            CONV_FILL((M / 256) * (NINP / 256), TF0, TF1, 0);
#endif
        }
        SEAM(pb + 4);
        if (INL(5)) { const int reps_ = REPS(5); for (int rep_ = 0; rep_ < reps_; ++rep_) { const Params q = opaque_params(p); phase_prep(q, l); __syncthreads(); } }
        SEAM(pb + 5);
        if (INL(6)) { const int reps_ = REPS(6); for (int rep_ = 0; rep_ < reps_; ++rep_) { const Params q = opaque_params(p); phase_mix(q, l, lds, rep_); __syncthreads(); } }
        SEAM(pb + 6);
        if (INL(7)) { const int reps_ = REPS(7); for (int rep_ = 0; rep_ < reps_; ++rep_) { const Params q = opaque_params(p); phase_post(q, l); __syncthreads(); } }
        SEAM(pb + 7);
        if (INL(8)) {
            pg8::Gemm g{MRG, WSP(bf16_t, WS_WOUT) + (size_t)l * DM * DM, M, DM, DM}; pg8::StaticOrder S; S.init(M, DM, DM, (int)gridDim.x, (int)blockIdx.x, SPLITK_G4);
            pg8::EpiResid E{X, X, DM, modl + 5 * DM, 1.0f, Z, WSP(unsigned, WS_CTL) + FLAG_WORD0, 8u * (unsigned)(l * (2 * SPLITK + SPLITK_G4) + SPLITK + SPLITK_G4), X, 0x7FFFFFFF};
            pg8::gemm_phase<pg8::EpiResid, pg8::StaticOrder, false>(ldsl, g, S, E, nullptr);
#if CONV_FILLER
            CONV_FILL((M / 256) * (DM / 256), TF1, TF2, 0);
#endif
#if DUPMASK
            if (opaque_int(DUP(8))) { pg8::EpiResid E2{X, Z, DM, modl + 5 * DM, 1.0f, Z, WSP(unsigned, WS_CTL) + FLAG_WORD0, 0u, X, 0x7FFFFFFF}; pg8::gemm_phase<pg8::EpiResid, pg8::StaticOrder, false>(ldsl, g, S, E2, nullptr); }
#endif
        }
        SEAM(pb + 8);
        if (INL(9)) { const int reps_ = REPS(9); for (int rep_ = 0; rep_ < reps_; ++rep_) { const Params q = opaque_params(p); phase_norm(q, l, 2); __syncthreads(); } }
        SEAM(pb + 9);
        if (INL(10)) {
            {
#if G1B_MODE
                pg8::Gemm g{H, (const bf16_t*)(WSP(unsigned char, WS_WGU) + ((size_t)l * 2 + 1) * NGU * DM * 2), M, NGU, DM / 2}; pg8::StaticOrder S; S.init(M, NGU, DM / 2, (int)gridDim.x, (int)blockIdx.x, G1B_MSPLIT);
                constexpr float ws_ = 1.0f / WGU_SCALE;
#else
                pg8::Gemm g{H, WSP(bf16_t, WS_WGU) + ((size_t)l * 2 + 1) * NGU * DM, M, NGU, DM}; pg8::StaticOrder S; S.init(M, NGU, DM, (int)gridDim.x, (int)blockIdx.x, G1B_MSPLIT);
                constexpr float ws_ = 1.0f;
#endif
#if G2_FP8
                pg8::EpiSwiGLU8 E{WSP(unsigned char, WS_ACT), FFP, ws_};
                pg8::gemm_phase<pg8::EpiSwiGLU8, pg8::StaticOrder, false, G1B_MODE>(ldsl, g, S, E, nullptr);
#else
                pg8::EpiSwiGLU E{ACT, FF};
                pg8::gemm_phase<pg8::EpiSwiGLU, pg8::StaticOrder, false, G1B_MODE>(ldsl, g, S, E, nullptr);
#endif
            }
#if CONV_FILLER
            CONV_FILL((M / 256) * (NGU / 256), TF2, NT_L, (G1B_MSPLIT ? ((M / 256) * (NGU / 256)) % (int)gridDim.x : 0));
#endif
        }
        SEAM(pb + 10);
        if (INL(11)) {
            pg8::Gemm g{ACT, G2_FP8 ? (const bf16_t*)(WSP(unsigned char, WS_WDN) + ((size_t)l * 2 + 1) * DM * FFP) : WSP(bf16_t, WS_WDN) + ((size_t)l * 2 + 1) * DM * FF, M, DM, G2_FP8 ? FFP / 2 : FF}; pg8::StaticOrder S; S.init(M, DM, G2_FP8 ? FFP / 2 : FF, (int)gridDim.x, (int)blockIdx.x, SPLITK ? 1 : MSPLIT);
            pg8::EpiResid E{X, (l == DEPTH - 1) ? p.out : X, DM, modl + 8 * DM, G2_FP8 ? 0.5f / WDN_SCALE : 0.5f, Z, WSP(unsigned, WS_CTL) + FLAG_WORD0, 8u * (unsigned)(l * (2 * SPLITK + SPLITK_G4) + 2 * SPLITK + SPLITK_G4), X, 0x7FFFFFFF};
            pg8::gemm_phase<pg8::EpiResid, pg8::StaticOrder, false, (G2_FP8 ? 1 : 0)>(ldsl, g, S, E, nullptr);
        }
        SEAM(pb + 11);
    }
#undef IN
#undef SEAM
}

#ifndef MULTI_LAUNCH
#define MULTI_LAUNCH 0
#endif
extern "C" void kernel_launch(void* const* d_in, const int* in_sizes, int n_in, void* d_out, int out_size, void* d_ws, size_t ws_size, hipStream_t stream) {
    static int grid = 0;
    if (grid == 0) {
        if (n_in != N_IN || (size_t)out_size != O_END || ws_size < WS_END) { fprintf(stderr, "kernel_launch: shape mismatch n_in %d out %d ws %zu (need %zu)\n", n_in, out_size, ws_size, (size_t)WS_END); grid = -1; return; }
        int dev = 0, cus = 0, per_cu = 0;
        if (hipGetDevice(&dev) != hipSuccess || hipDeviceGetAttribute(&cus, hipDeviceAttributeMultiprocessorCount, dev) != hipSuccess) { grid = -1; return; }
        if (hipFuncSetAttribute((const void*)fwd, hipFuncAttributeMaxDynamicSharedMemorySize, LDS_BYTES) != hipSuccess) { fprintf(stderr, "kernel_launch: hipFuncSetAttribute failed\n"); grid = -1; return; }
        if (hipOccupancyMaxActiveBlocksPerMultiprocessor(&per_cu, (const void*)fwd, 512, LDS_BYTES) != hipSuccess || per_cu < 1) { fprintf(stderr, "kernel_launch: occupancy query says %d\n", per_cu); (void)hipGetLastError(); }
        grid = cus;
    }
    if (grid < 0) return;
    (void)hipMemsetAsync((char*)d_ws + WS_CTL, 0, CTL_BYTES, stream);
    Params p{};
    for (int i = 0; i < N_IN; ++i) p.in[i] = (const float*)d_in[i];
    p.out = (float*)d_out; p.ws = (unsigned char*)d_ws;
#if MULTI_LAUNCH
    for (int ph = 0; ph < 1 + DBG_NLAYERS * 12; ++ph) { p.ph_lo = ph; p.ph_hi = ph + 1; hipLaunchKernelGGL(fwd, dim3(grid), dim3(512), LDS_BYTES, stream, p); }
#else
    p.ph_lo = 0; p.ph_hi = NPH; hipLaunchKernelGGL(fwd, dim3(grid), dim3(512), LDS_BYTES, stream, p);
#endif
    const hipError_t le = hipPeekAtLastError();
    if (le != hipSuccess) fprintf(stderr, "kernel_launch: launch failed: %s\n", hipGetErrorName(le));
}
```

```cpp
#include <hip/hip_runtime.h>
#include <cstdio>
#include <cstdint>

#ifndef CB_
#define CB_ 16
#endif
#ifndef LB_
#define LB_ 8
#endif
#ifndef DEPTH_
#define DEPTH_ 4
#endif
#ifndef G1A_LAYERS
#define G1A_LAYERS 0xC
#endif
#ifndef G1A_MODE
#define G1A_MODE 0
#endif
#ifndef G1B_MODE
#define G1B_MODE 1
#endif
#ifndef G2_FP8
#define G2_FP8 1
#endif
#ifndef FFN_FP8
#define FFN_FP8 (G1A_MODE != 0 || G1B_MODE != 0 || G2_FP8 != 0)
#endif
constexpr int DM = 2048, DEPTH = DEPTH_, CB = CB_, CT = 256, LB = LB_, LT = 1024;
constexpr int MC = CB * CT, ML = LB * LT, M = MC + ML;
constexpr int FF = 5504, NGU = 2 * FF, NIN = 6192, NINP = 6400, NMOD = 9 * DM, NCOND = 1 + LB;
constexpr float EPS = 1e-6f;
constexpr int FFP = 5632;
constexpr float WGU_SCALE = 32.0f, WDN_SCALE = 64.0f;
constexpr int Z_NAQ = 0, Z_NAK = 512, Z_NAV = 1024, Z_GLQ = 1536, Z_GLK = 1792, Z_GLV = 2048, Z_GLR = 2560, Z_GF = 3072, Z_GB = 3088,
              Z_GQQ = 3104, Z_GQK = 3616, Z_GQV = 3872, Z_DQKV = 4128, Z_DZ = 5664, Z_DB = 6176, Z_DA = 6184;
static_assert(Z_DA + 8 == NIN, "split");
enum { I_XP = 0, I_XS, I_CNAK, I_CNAV, I_CGK, I_CGV, I_SGLA, I_SGDN, I_C, I_CCTX, I_NORMG, I_WMOD, I_BMOD, I_GU, I_DOWN, I_WIN, I_WOUT, I_NAQKN, I_RPB,
       I_GUP, I_GBIAS, I_GLAON, I_GQAQKN, I_CONV, I_ALOG, I_DTB, I_GDNON, N_IN };
constexpr size_t O_YP = 0, O_YS = O_YP + (size_t)MC * DM, O_NAK = O_YS + (size_t)ML * DM, O_NAV = O_NAK + (size_t)CB * DEPTH * 4 * CT * 128,
                 O_GK = O_NAV + (size_t)CB * DEPTH * 4 * CT * 128, O_GV = O_GK + (size_t)CB * DEPTH * 2 * CT * 128,
                 O_SGLA = O_GV + (size_t)CB * DEPTH * 2 * CT * 128, O_SGDN = O_SGLA + (size_t)CB * DEPTH * 2 * 4 * 64 * 128,
                 O_END = O_SGDN + (size_t)CB * DEPTH * 2 * 4 * 128 * 128;
constexpr size_t al256(size_t x) { return (x + 255) & ~(size_t)255; }
constexpr size_t WS_CTL = 0, CTL_BYTES = 1u << 20;
constexpr size_t WS_WGU = CTL_BYTES;
constexpr size_t WS_WDN = WS_WGU + (size_t)DEPTH * 2 * NGU * DM * 2;
constexpr size_t WS_WIN = WS_WDN + (size_t)DEPTH * 2 * DM * FF * 2;
constexpr size_t WS_WOUT = WS_WIN + (size_t)DEPTH * NINP * DM * 2;
constexpr size_t WS_MODV = WS_WOUT + (size_t)DEPTH * DM * DM * 2;
constexpr size_t WS_ROPE = al256(WS_MODV + (size_t)DEPTH * NCOND * NMOD * 4);
constexpr size_t WS_X = al256(WS_ROPE + 2 * 64 * 32 * 4);
constexpr size_t WS_H = WS_X + (size_t)M * DM * 4;
constexpr size_t WS_ACT = WS_H + (size_t)M * DM * 2;
constexpr size_t WS_Z = WS_ACT + (size_t)M * FF * 2;
constexpr size_t WS_MRG = WS_Z + (size_t)M * NINP * 4;
constexpr size_t WS_NAQ = WS_MRG + (size_t)M * DM * 2;
constexpr size_t WS_NAK = WS_NAQ + (size_t)M * 512 * 2;
constexpr size_t WS_NAV = WS_NAK + (size_t)M * 512 * 2;
constexpr size_t WS_GQ = WS_NAV + (size_t)M * 512 * 2;
constexpr size_t WS_GK = WS_GQ + (size_t)M * 512 * 2;
constexpr size_t WS_GV = WS_GK + (size_t)M * 256 * 2;
constexpr size_t WS_CNAK = WS_GV + (size_t)M * 256 * 2;
constexpr size_t WS_CNAV = WS_CNAK + (size_t)LB * DEPTH * 256 * 512 * 2;
constexpr size_t WS_CGK = WS_CNAV + (size_t)LB * DEPTH * 256 * 512 * 2;
constexpr size_t WS_CGV = WS_CGK + (size_t)LB * DEPTH * 256 * 256 * 2;
constexpr size_t WS_AF = WS_CGV + (size_t)LB * DEPTH * 256 * 256 * 2;
constexpr size_t WS_AB = WS_AF + (size_t)M * 256 * 4;
constexpr size_t WS_DQ = WS_AB + (size_t)M * 256 * 4;
constexpr size_t WS_DK = WS_DQ + (size_t)M * 512 * 4;
constexpr size_t WS_DV = WS_DK + (size_t)M * 512 * 4;
constexpr size_t WS_DBA = WS_DV + (size_t)M * 512 * 4;
constexpr size_t WS_GOF = WS_DBA + (size_t)M * 16 * 4;
constexpr size_t WS_GOB = WS_GOF + (size_t)M * 512 * 4;
constexpr size_t WS_DOF = WS_GOB + (size_t)M * 512 * 4;
constexpr size_t WS_DOB = WS_DOF + (size_t)M * 512 * 4;
constexpr size_t WS_END = WS_DOB + (size_t)M * 512 * 4;

typedef unsigned short bf16_t;
struct Params { const float* in[N_IN]; float* out; unsigned char* ws; int ph_lo, ph_hi; };
static_assert(sizeof(Params) == N_IN * 8 + 8 + 8 + 8, "no padding");

#define WSP(T, off) ((T*)(p.ws + (off)))
__device__ __forceinline__ int opaque_tid() { int t = (int)threadIdx.x; asm volatile("" : "+v"(t)); return t; }
__device__ __forceinline__ Params opaque_params(const Params& p) { Params q = p; unsigned long long w = (unsigned long long)q.ws; asm volatile("" : "+s"(w)); q.ws = (unsigned char*)w; return q; }

typedef float vf4 __attribute__((ext_vector_type(4)));
__device__ __forceinline__ unsigned pack4_fp8(float a, float b, float c, float d) { int w = 0; w = __builtin_amdgcn_cvt_pk_fp8_f32(a, b, w, false); w = __builtin_amdgcn_cvt_pk_fp8_f32(c, d, w, true); return (unsigned)w; }
__device__ __forceinline__ float bf2f(unsigned short v) { return __uint_as_float((unsigned)v << 16); }
__device__ __forceinline__ vf4 ld4bf(const unsigned short* p) { const uint2 w = *(const uint2*)p; vf4 r; r.x = __uint_as_float(w.x << 16); r.y = __uint_as_float(w.x & 0xFFFF0000u); r.z = __uint_as_float(w.y << 16); r.w = __uint_as_float(w.y & 0xFFFF0000u); return r; }
__device__ __forceinline__ vf4 unp4bf(uint2 w) { vf4 r; r.x = __uint_as_float(w.x << 16); r.y = __uint_as_float(w.x & 0xFFFF0000u); r.z = __uint_as_float(w.y << 16); r.w = __uint_as_float(w.y & 0xFFFF0000u); return r; }
__device__ __forceinline__ void unp8bf(uint4 w, vf4& a, vf4& b) {
    a.x = __uint_as_float(w.x << 16); a.y = __uint_as_float(w.x & 0xFFFF0000u); a.z = __uint_as_float(w.y << 16); a.w = __uint_as_float(w.y & 0xFFFF0000u);
    b.x = __uint_as_float(w.z << 16); b.y = __uint_as_float(w.z & 0xFFFF0000u); b.z = __uint_as_float(w.w << 16); b.w = __uint_as_float(w.w & 0xFFFF0000u); }
__device__ __forceinline__ void ld8bf(const unsigned short* p, vf4& a, vf4& b) { const uint4 w = *(const uint4*)p;
    a.x = __uint_as_float(w.x << 16); a.y = __uint_as_float(w.x & 0xFFFF0000u); a.z = __uint_as_float(w.y << 16); a.w = __uint_as_float(w.y & 0xFFFF0000u);
    b.x = __uint_as_float(w.z << 16); b.y = __uint_as_float(w.z & 0xFFFF0000u); b.z = __uint_as_float(w.w << 16); b.w = __uint_as_float(w.w & 0xFFFF0000u); }
__device__ __forceinline__ float wave_sum(float v) {
#pragma unroll
    for (int o = 32; o >= 1; o >>= 1) v += __shfl_xor(v, o);
    return v;
}
__device__ __forceinline__ bf16_t f2bf(float f) { unsigned u = __float_as_uint(f); u += 0x7FFFu + ((u >> 16) & 1u); return (bf16_t)(u >> 16); }
__device__ __forceinline__ unsigned pack2(float a, float b) { return (unsigned)f2bf(a) | ((unsigned)f2bf(b) << 16); }
__device__ __forceinline__ float silu_f(float x) { return x / (1.f + expf(-x)); }
__device__ __forceinline__ float softplus_f(float x) { return fmaxf(x, 0.f) + log1pf(expf(-fabsf(x))); }
__device__ __forceinline__ float logsigmoid_f(float x) { return fminf(x, 0.f) - log1pf(expf(-fabsf(x))); }
__device__ __forceinline__ bool g1_fp8(int l, int f) { return f ? (G1B_MODE != 0) : (G1A_MODE != 0 || ((G1A_LAYERS >> l) & 1)); }
__device__ __forceinline__ int cond_of_row(int m) { return m < MC ? 0 : 1 + (m - MC) / LT; }
#ifndef CONV_FILLER
#define CONV_FILLER 1
#endif
__device__ __forceinline__ void conv_tile(const float* __restrict__ src, int ld_src, int ncols_src, int k0, int c0, bf16_t* __restrict__ dst, int ld_dst, int n0, float* tile) {
    const int tid = opaque_tid();
    {
        const int r = tid >> 3, c = (tid & 7) * 8;
        float4 a = make_float4(0.f, 0.f, 0.f, 0.f), b = a;
        if (c0 + c + 8 <= ncols_src) {
            const float* s = src + (size_t)(k0 + r) * ld_src + c0 + c;
            a = *(const float4*)s; b = *(const float4*)(s + 4);
        }
        float* t = tile + r * 65 + c;
        t[0] = a.x; t[1] = a.y; t[2] = a.z; t[3] = a.w; t[4] = b.x; t[5] = b.y; t[6] = b.z; t[7] = b.w;
    }
    __syncthreads();
    {
        const int n = tid >> 3, ks = (tid & 7) * 8;
        const float* t = tile + ks * 65 + n;
        uint4 w;
        w.x = pack2(t[0 * 65], t[1 * 65]); w.y = pack2(t[2 * 65], t[3 * 65]); w.z = pack2(t[4 * 65], t[5 * 65]); w.w = pack2(t[6 * 65], t[7 * 65]);
        *(uint4*)(dst + (size_t)(n0 + n) * ld_dst + k0 + ks) = w;
    }
    __syncthreads();
}

__device__ __forceinline__ void conv_tile8(const float* __restrict__ src, int ld_src, int nrows_src, int k0, int c0, unsigned char* __restrict__ dst, int ld_dst, int n0, float scale, float* tile) {
    const int tid = opaque_tid();
    {
        const int r = tid >> 3, c = (tid & 7) * 8;
        float4 a = make_float4(0.f, 0.f, 0.f, 0.f), b = a;
        if (k0 + r < nrows_src) { const float* s = src + (size_t)(k0 + r) * ld_src + c0 + c; a = *(const float4*)s; b = *(const float4*)(s + 4); }
        float* t = tile + r * 65 + c;
        t[0] = a.x * scale; t[1] = a.y * scale; t[2] = a.z * scale; t[3] = a.w * scale; t[4] = b.x * scale; t[5] = b.y * scale; t[6] = b.z * scale; t[7] = b.w * scale;
    }
    __syncthreads();
    {
        const int n = tid >> 3, ks = (tid & 7) * 8;
        const float* t = tile + ks * 65 + n;
        uint2 w; w.x = pack4_fp8(t[0 * 65], t[1 * 65], t[2 * 65], t[3 * 65]); w.y = pack4_fp8(t[4 * 65], t[5 * 65], t[6 * 65], t[7 * 65]);
        *(uint2*)(dst + (size_t)(n0 + n) * ld_dst + k0 + ks) = w;
    }
    __syncthreads();
}
constexpr int MOD_ITEMS = DEPTH * (NMOD / 128);
constexpr int TGU_KT = DM / 64, TGU_NT = NGU / 64, TDN_KT = (G2_FP8 ? FFP : FF) / 64, TDN_NT = DM / 64, TIN_KT = DM / 64, TIN_NT = NINP / 64, TOUT_KT = DM / 64, TOUT_NT = DM / 64;
constexpr int TL_GU = 2 * TGU_KT * TGU_NT, TL_DN = 2 * TDN_KT * TDN_NT, TL_IN = TIN_KT * TIN_NT, TL_OUT = TOUT_KT * TOUT_NT, NT_L = TL_GU + TL_DN + TL_IN + TL_OUT;
__device__ __forceinline__ void conv_layer_tiles(const Params& p, int l, int t_begin, int t_end, int first, int stride, float* s_tile) {
    for (int it = t_begin + first; it < t_end; it += stride) {
        if (it < TL_GU) {
            const int mat = l * 2 + it / (TGU_KT * TGU_NT), r = it % (TGU_KT * TGU_NT), kt = r / TGU_NT, nt = r % TGU_NT;
            const int n0 = nt * 64, t256 = n0 / 256, c = n0 % 256;
            const int c0 = c < 128 ? 128 * t256 + c : FF + 128 * t256 + (c - 128);
            if (g1_fp8(mat >> 1, mat & 1))
                conv_tile8(p.in[I_GU] + (size_t)mat * DM * NGU, NGU, DM, kt * 64, c0, WSP(unsigned char, WS_WGU) + (size_t)mat * NGU * DM * 2, DM, n0, WGU_SCALE, s_tile);
            else
                conv_tile(p.in[I_GU] + (size_t)mat * DM * NGU, NGU, NGU, kt * 64, c0, WSP(bf16_t, WS_WGU) + (size_t)mat * NGU * DM, DM, n0, s_tile);
        } else if (it < TL_GU + TL_DN) {
            const int i2 = it - TL_GU, mat = l * 2 + i2 / (TDN_KT * TDN_NT), r = i2 % (TDN_KT * TDN_NT), kt = r / TDN_NT, nt = r % TDN_NT;
#if G2_FP8
            conv_tile8(p.in[I_DOWN] + (size_t)mat * FF * DM, DM, FF, kt * 64, nt * 64, WSP(unsigned char, WS_WDN) + (size_t)mat * DM * FFP, FFP, nt * 64, WDN_SCALE, s_tile);
#else
            conv_tile(p.in[I_DOWN] + (size_t)mat * FF * DM, DM, DM, kt * 64, nt * 64, WSP(bf16_t, WS_WDN) + (size_t)mat * DM * FF, FF, nt * 64, s_tile);
#endif
        } else if (it < TL_GU + TL_DN + TL_IN) {
            const int i2 = it - TL_GU - TL_DN, kt = i2 / TIN_NT, nt = i2 % TIN_NT;
            conv_tile(p.in[I_WIN] + (size_t)l * DM * NIN, NIN, NIN, kt * 64, nt * 64, WSP(bf16_t, WS_WIN) + (size_t)l * NINP * DM, DM, nt * 64, s_tile);
        } else {
            const int i2 = it - TL_GU - TL_DN - TL_IN, kt = i2 / TOUT_NT, nt = i2 % TOUT_NT;
            conv_tile(p.in[I_WOUT] + (size_t)l * DM * DM, DM, DM, kt * 64, nt * 64, WSP(bf16_t, WS_WOUT) + (size_t)l * DM * DM, DM, nt * 64, s_tile);
        }
    }
}

__device__ __forceinline__ void mod_layer(const Params& p, int l, int first, int stride, float* smem) {
    const int tid = opaque_tid();
    float* s_cond = smem;
    float* s_red = s_cond + NCOND * DM;
    __syncthreads();
    for (int i = tid; i < NCOND * DM; i += 512) { const int ci = i / DM, k = i % DM; const float v = ci == 0 ? p.in[I_CCTX][k] : p.in[I_C][(size_t)(ci - 1) * DM + k]; s_cond[i] = silu_f(v); }
    __syncthreads();
    float* modv = WSP(float, WS_MODV);
    for (int jt = first; jt < NMOD / 128; jt += stride) {
        const int cl = tid & 127, kq = tid >> 7, col = jt * 128 + cl;
        const float* w = p.in[I_WMOD] + (size_t)l * DM * NMOD + col;
        float acc[NCOND];
#pragma unroll
        for (int ci = 0; ci < NCOND; ++ci) acc[ci] = 0.f;
        for (int k = kq * 512; k < kq * 512 + 512; k += 8) {
            float wv[8];
#pragma unroll
            for (int j = 0; j < 8; ++j) wv[j] = w[(size_t)(k + j) * NMOD];
#pragma unroll
            for (int ci = 0; ci < NCOND; ++ci) {
                const float4 s0 = *(const float4*)&s_cond[ci * DM + k], s1 = *(const float4*)&s_cond[ci * DM + k + 4];
                acc[ci] += s0.x * wv[0] + s0.y * wv[1] + s0.z * wv[2] + s0.w * wv[3] + s1.x * wv[4] + s1.y * wv[5] + s1.z * wv[6] + s1.w * wv[7];
            }
        }
        if (kq > 0) {
#pragma unroll
            for (int ci = 0; ci < NCOND; ++ci) s_red[((kq - 1) * 128 + cl) * NCOND + ci] = acc[ci];
        }
        __syncthreads();
        if (kq == 0) {
            const float bm = p.in[I_BMOD][(size_t)l * NMOD + col];
#pragma unroll
            for (int ci = 0; ci < NCOND; ++ci)
                modv[((size_t)l * NCOND + ci) * NMOD + col] = acc[ci] + s_red[(0 * 128 + cl) * NCOND + ci] + s_red[(1 * 128 + cl) * NCOND + ci] + s_red[(2 * 128 + cl) * NCOND + ci] + bm;
        }
        __syncthreads();
    }
}

__device__ __forceinline__ void phase_prologue(const Params& p, float* smem) {
    const int tid = threadIdx.x, nb = gridDim.x, bid = blockIdx.x;
    float* s_tile = smem + NCOND * DM + 3 * 128 * NCOND;
#if CONV_FILLER
    mod_layer(p, 0, bid, nb, smem);
#else
    for (int l2 = 0; l2 < DEPTH; ++l2) mod_layer(p, l2, bid, nb, smem);
#endif
    conv_layer_tiles(p, 0, 0, NT_L, bid, nb, s_tile);
#if !CONV_FILLER
    for (int l2 = 1; l2 < DEPTH; ++l2) conv_layer_tiles(p, l2, 0, NT_L, bid, nb, s_tile);
#endif
    const size_t gtid = (size_t)bid * 512 + tid, gstride = (size_t)nb * 512;
    {
        const size_t n_na = (size_t)LB * DEPTH * 256 * 512 / 8;
        for (size_t i = gtid; i < 2 * n_na; i += gstride) {
            const bool isv = i >= n_na; const size_t j = isv ? i - n_na : i;
            const int d8 = (int)(j % 16), h = (int)((j / 16) % 4), t = (int)((j / 64) % 256); const size_t bl = j / (64 * 256);
            const float* s = p.in[isv ? I_CNAV : I_CNAK] + ((bl * 4 + h) * 256 + t) * 128 + d8 * 8;
            const float4 a = *(const float4*)s, b = *(const float4*)(s + 4);
            uint4 w; w.x = pack2(a.x, a.y); w.y = pack2(a.z, a.w); w.z = pack2(b.x, b.y); w.w = pack2(b.z, b.w);
            *(uint4*)(WSP(bf16_t, isv ? WS_CNAV : WS_CNAK) + (bl * 256 + t) * 512 + h * 128 + d8 * 8) = w;
        }
        const size_t n_g = (size_t)LB * DEPTH * 256 * 256 / 8;
        for (size_t i = gtid; i < 2 * n_g; i += gstride) {
            const bool isv = i >= n_g; const size_t j = isv ? i - n_g : i;
            const int d8 = (int)(j % 16), h = (int)((j / 16) % 2), t = (int)((j / 32) % 256); const size_t bl = j / (32 * 256);
            const float* s = p.in[isv ? I_CGV : I_CGK] + ((bl * 2 + h) * 256 + t) * 128 + d8 * 8;
            const float4 a = *(const float4*)s, b = *(const float4*)(s + 4);
            uint4 w; w.x = pack2(a.x, a.y); w.y = pack2(a.z, a.w); w.z = pack2(b.x, b.y); w.w = pack2(b.z, b.w);
            *(uint4*)(WSP(bf16_t, isv ? WS_CGV : WS_CGK) + (bl * 256 + t) * 256 + h * 128 + d8 * 8) = w;
        }
    }
    for (size_t i = gtid; i < 64 * 32; i += gstride) {
        const int pos = (int)(i / 32), k = (int)(i % 32);
        const float inv = powf(10000.0f, -(float)(2 * k) / 64.0f);
        const float ang = (float)pos * inv;
        WSP(float, WS_ROPE)[i] = cosf(ang); WSP(float, WS_ROPE)[64 * 32 + i] = sinf(ang);
    }
}

__device__ __forceinline__ void phase_norm(const Params& p, int l, int which  ) {
    const int tid = opaque_tid(), lane = tid & 63, wv = tid >> 6;
    const float* X = WSP(float, WS_X); bf16_t* H = WSP(bf16_t, WS_H);
    const bool from_in = (l == 0 && which == 0);
    const float* g = p.in[I_NORMG] + ((size_t)l * 3 + which) * DM;
    const int nw = (int)gridDim.x * 8;
    for (int m0 = blockIdx.x * 8 + wv; m0 < M; m0 += 2 * nw) {
        const int m1 = m0 + nw; const bool has1 = m1 < M;
        const int mm[2] = {m0, has1 ? m1 : m0};
        vf4 v[2][8]; float ss[2] = {0.f, 0.f};
#pragma unroll
        for (int k = 0; k < 2; ++k) {
            const int m = mm[k];
            const float* x = from_in ? (m < MC ? p.in[I_XP] + (size_t)m * DM : p.in[I_XS] + (size_t)(m - MC) * DM) : X + (size_t)m * DM;
#pragma unroll
            for (int i = 0; i < 8; ++i) v[k][i] = *(const vf4*)(x + (i * 64 + lane) * 4);
        }
#pragma unroll
        for (int k = 0; k < 2; ++k) {
#pragma unroll
            for (int i = 0; i < 8; ++i) ss[k] += v[k][i].x * v[k][i].x + v[k][i].y * v[k][i].y + v[k][i].z * v[k][i].z + v[k][i].w * v[k][i].w;
            ss[k] = wave_sum(ss[k]);
        }
#pragma unroll
        for (int k = 0; k < 2; ++k) {
            if (k == 1 && !has1) break;
            const int m = mm[k];
            const float* mv = WSP(float, WS_MODV) + ((size_t)l * NCOND + cond_of_row(m)) * NMOD + (size_t)which * 3 * DM;
            const float r = 1.0f / sqrtf(ss[k] * (1.0f / DM) + EPS);
#pragma unroll
            for (int i = 0; i < 8; ++i) {
                const int c = (i * 64 + lane) * 4;
                const float4 gg = *(const float4*)(g + c), sh = *(const float4*)(mv + c), sc = *(const float4*)(mv + DM + c);
                const float o0 = v[k][i].x * r * gg.x * (1.f + sc.x) + sh.x, o1 = v[k][i].y * r * gg.y * (1.f + sc.y) + sh.y;
                const float o2 = v[k][i].z * r * gg.z * (1.f + sc.z) + sh.z, o3 = v[k][i].w * r * gg.w * (1.f + sc.w) + sh.w;
                if (which != 1 && g1_fp8(l, which >> 1)) *(unsigned*)((unsigned char*)H + (size_t)m * DM + c) = pack4_fp8(o0, o1, o2, o3);
                else { uint2 w; w.x = pack2(o0, o1); w.y = pack2(o2, o3); *(uint2*)(H + (size_t)m * DM + c) = w; }
            }
            if (G2_FP8 && which != 1 && lane < (FFP - FF) / 4) *(unsigned*)(WSP(unsigned char, WS_ACT) + (size_t)m * FFP + FF + 4 * lane) = 0u;
        }
    }
}

__device__ __forceinline__ float red16(float v);
__device__ __forceinline__ float ssq8(vf4 a, vf4 b) { const vf4 s = a * a + b * b; return (s.x + s.y) + (s.z + s.w); }
__device__ __forceinline__ uint4 pack8(vf4 a, vf4 b) { uint4 w; w.x = pack2(a.x, a.y); w.y = pack2(a.z, a.w); w.z = pack2(b.x, b.y); w.w = pack2(b.z, b.w); return w; }
__device__ __forceinline__ void phase_prep(const Params& p, int l) {
    const int tid = opaque_tid(), lane = tid & 63, wv = tid >> 6, rg = lane >> 4, sub = lane & 15, c8 = sub * 8;
    const bf16_t* Z = WSP(bf16_t, WS_Z);
    const float* ropec = WSP(float, WS_ROPE); const float* ropes = ropec + 64 * 32;
    const float* wnq = p.in[I_NAQKN] + ((size_t)l * 2 + 0) * 128 + c8; const float* wnk = wnq + 128;
    const float* wgq = p.in[I_GQAQKN] + ((size_t)l * 2 + 0) * 128 + c8; const float* wgk = wgq + 128;
    const float* cw = p.in[I_CONV] + (size_t)l * 5 * 1536 + rg * 128 + c8;
    const int rpw = (M + (int)gridDim.x * 8 - 1) / ((int)gridDim.x * 8);
    for (int m = ((int)blockIdx.x * 8 + wv) * rpw, mend = (m + rpw < M ? m + rpw : M); m < mend; ++m) {
        const bf16_t* z = Z + (size_t)m * NINP;
        const bool ctx = m < MC;
        const int b = ctx ? m / CT : (m - MC) / LT, t = ctx ? m % CT : (m - MC) % LT, T = ctx ? CT : LT;
        const int ho = rg * 128 + c8;
        uint4 rz[5]; uint2 rgz[2][4];
        {
            const bf16_t* zkv = z + (rg < 2 ? Z_GQK + rg * 128 : Z_GQV + (rg - 2) * 128) + c8;
            rz[0] = *(const uint4*)(z + Z_NAQ + ho); rz[1] = *(const uint4*)(z + Z_NAK + ho); rz[2] = *(const uint4*)(z + Z_NAV + ho); rz[3] = *(const uint4*)(z + Z_GQQ + ho); rz[4] = *(const uint4*)zkv;
#pragma unroll
            for (int dir = 0; dir < 2; ++dir)
#pragma unroll
                for (int r4 = 0; r4 < 4; ++r4) rgz[dir][r4] = *(const uint2*)(z + (dir ? Z_GB : Z_GF) + 4 * r4);
        }
        asm volatile("" ::: "memory");
        {
            vf4 q0, q1, k0, k1, v0, v1, g0, g1, x0, x1;
            unp8bf(rz[0], q0, q1); unp8bf(rz[1], k0, k1); unp8bf(rz[2], v0, v1); unp8bf(rz[3], g0, g1); unp8bf(rz[4], x0, x1);
            float r = 1.0f / sqrtf(red16(ssq8(q0, q1)) * (1.0f / 128) + EPS);
            q0 = q0 * r * *(const vf4*)wnq; q1 = q1 * r * *(const vf4*)(wnq + 4);
            *(uint4*)(WSP(bf16_t, WS_NAQ) + (size_t)m * 512 + ho) = pack8(q0, q1);
            r = 1.0f / sqrtf(red16(ssq8(k0, k1)) * (1.0f / 128) + EPS);
            k0 = k0 * r * *(const vf4*)wnk; k1 = k1 * r * *(const vf4*)(wnk + 4);
            *(uint4*)(WSP(bf16_t, WS_NAK) + (size_t)m * 512 + ho) = pack8(k0, k1);
            *(uint4*)(WSP(bf16_t, WS_NAV) + (size_t)m * 512 + ho) = pack8(v0, v1);
            if (ctx) {
                const size_t o = ((((size_t)b * DEPTH + l) * 4 + rg) * CT + t) * 128 + c8;
                *(vf4*)(p.out + O_NAK + o) = k0; *(vf4*)(p.out + O_NAK + o + 4) = k1; *(vf4*)(p.out + O_NAV + o) = v0; *(vf4*)(p.out + O_NAV + o + 4) = v1;
            }
            r = 1.0f / sqrtf(red16(ssq8(g0, g1)) * (1.0f / 128) + EPS);
            g0 = g0 * r * *(const vf4*)wgq; g1 = g1 * r * *(const vf4*)(wgq + 4);
            const float rk = 1.0f / sqrtf(red16(ssq8(x0, x1)) * (1.0f / 128) + EPS);
            if (rg < 2) { x0 = x0 * rk * *(const vf4*)wgk; x1 = x1 * rk * *(const vf4*)(wgk + 4); }
            if (!ctx) {
                const int pos = sub < 8 ? (t >> 6) : (t & 63), ai = pos * 32 + (c8 & 31);
                const vf4 c0 = *(const vf4*)(ropec + ai), c1 = *(const vf4*)(ropec + ai + 4), s0 = *(const vf4*)(ropes + ai), s1 = *(const vf4*)(ropes + ai + 4);
                const bool hi = (sub & 4) != 0;
                vf4 pg0, pg1, px0, px1;
#pragma unroll
                for (int j = 0; j < 4; ++j) { pg0[j] = __shfl_xor(g0[j], 4); pg1[j] = __shfl_xor(g1[j], 4); px0[j] = __shfl_xor(x0[j], 4); px1[j] = __shfl_xor(x1[j], 4); }
                g0 = hi ? pg0 * s0 + g0 * c0 : g0 * c0 - pg0 * s0; g1 = hi ? pg1 * s1 + g1 * c1 : g1 * c1 - pg1 * s1;
                if (rg < 2) { x0 = hi ? px0 * s0 + x0 * c0 : x0 * c0 - px0 * s0; x1 = hi ? px1 * s1 + x1 * c1 : x1 * c1 - px1 * s1; }
            }
            *(uint4*)(WSP(bf16_t, WS_GQ) + (size_t)m * 512 + ho) = pack8(g0, g1);
            *(uint4*)(WSP(bf16_t, rg < 2 ? WS_GK : WS_GV) + (size_t)m * 256 + (rg & 1) * 128 + c8) = pack8(x0, x1);
            if (ctx) {
                const size_t o = ((((size_t)b * DEPTH + l) * 2 + (rg & 1)) * CT + t) * 128 + c8;
                float* dst = p.out + (rg < 2 ? O_GK : O_GV) + o;
                *(vf4*)dst = x0; *(vf4*)(dst + 4) = x1;
            }
        }
        asm volatile("" ::: "memory");
        {
#pragma unroll
            for (int dir = 0; dir < 2; ++dir) {
                const float* up = p.in[I_GUP] + ((size_t)l * 2 + dir) * 16 * 256 + 4 * lane;
                vf4 acc = *(const vf4*)(p.in[I_GBIAS] + ((size_t)l * 2 + dir) * 256 + 4 * lane);
#pragma unroll
                for (int r4 = 0; r4 < 4; ++r4) {
                    const vf4 gv = unp4bf(rgz[dir][r4]);
                    acc += gv.x * *(const vf4*)(up + (4 * r4 + 0) * 256) + gv.y * *(const vf4*)(up + (4 * r4 + 1) * 256) + gv.z * *(const vf4*)(up + (4 * r4 + 2) * 256) + gv.w * *(const vf4*)(up + (4 * r4 + 3) * 256);
                }
                vf4 o;
#pragma unroll
                for (int j = 0; j < 4; ++j) o[j] = logsigmoid_f(acc[j]) * (1.0f / 16.0f);
                *(vf4*)(WSP(float, dir ? WS_AB : WS_AF) + (size_t)m * 256 + 4 * lane) = o;
            }
        }
        asm volatile("" ::: "memory");
        {
            uint4 rcz[3][5];
#pragma unroll
            for (int part = 0; part < 3; ++part)
#pragma unroll
                for (int j = 0; j < 5; ++j) { const int tt = t + j - 2;
                    rcz[part][j] = (tt >= 0 && tt < T) ? *(const uint4*)(Z + (size_t)(m + j - 2) * NINP + Z_DQKV + part * 512 + rg * 128 + c8) : make_uint4(0u, 0u, 0u, 0u); }
            asm volatile("" ::: "memory");
#pragma unroll
            for (int part = 0; part < 3; ++part) {
                vf4 a0 = (vf4){0.f, 0.f, 0.f, 0.f}, a1 = a0;
#pragma unroll
                for (int j = 0; j < 5; ++j) {
                    const float* cj = cw + j * 1536 + part * 512;
                    vf4 z0, z1; unp8bf(rcz[part][j], z0, z1);
                    a0 += *(const vf4*)cj * z0; a1 += *(const vf4*)(cj + 4) * z1;
                }
#pragma unroll
                for (int j = 0; j < 4; ++j) { a0[j] = silu_f(a0[j]); a1[j] = silu_f(a1[j]); }
                if (part < 2) { const float r = 1.0f / sqrtf(red16(ssq8(a0, a1)) + EPS) * (part == 0 ? 0.08838834764831845f : 1.0f); a0 *= r; a1 *= r; }
                *(uint4*)(WSP(bf16_t, part == 0 ? WS_DQ : part == 1 ? WS_DK : WS_DV) + (size_t)m * 512 + rg * 128 + c8) = pack8(a0, a1);
                asm volatile("" ::: "memory");
            }
            if (lane < 8) {
                const float beta = 1.0f / (1.0f + expf(-bf2f(z[Z_DB + lane])));
                const float g = -expf(p.in[I_ALOG][(size_t)l * 8 + lane]) * softplus_f(bf2f(z[Z_DA + lane]) + p.in[I_DTB][(size_t)l * 8 + lane]);
                float* ba = WSP(float, WS_DBA) + (size_t)m * 16;
                ba[lane] = beta; ba[8 + lane] = g;
            }
        }
    }
}

typedef float vf2 __attribute__((ext_vector_type(2)));
__device__ __forceinline__ float dpp_f(float v, const int ctrl) { return v; }
#define DPPF(v, ctrl) __int_as_float(__builtin_amdgcn_mov_dpp(__float_as_int(v), (ctrl), 0xF, 0xF, true))
__device__ __forceinline__ float red8(float v) { v += DPPF(v, 0xB1); v += DPPF(v, 0x4E); v += DPPF(v, 0x141); return v; }
__device__ __forceinline__ float red16(float v) { v = red8(v); v += DPPF(v, 0x140); return v; }

__device__ __forceinline__ void phase_post(const Params& p, int l) {
    const int tid = opaque_tid(), lane = tid & 63, wv = tid >> 6, rg = lane >> 4, c8 = (lane & 15) * 8;
    const bf16_t* Z = WSP(bf16_t, WS_Z); bf16_t* MRG = WSP(bf16_t, WS_MRG);
    const float* wg = p.in[I_GLAON] + (size_t)l * 128 + c8; const float* wd = p.in[I_GDNON] + (size_t)l * 128 + c8;
    for (int m = blockIdx.x * 8 + wv; m < M; m += gridDim.x * 8) {
        const bf16_t* z = Z + (size_t)m * NINP;
        const int ho = rg * 128 + c8;
#pragma unroll
        for (int g = 0; g < 2; ++g) {
            const float* of = WSP(float, g ? WS_DOF : WS_GOF) + (size_t)m * 512 + ho; const float* ob = WSP(float, g ? WS_DOB : WS_GOB) + (size_t)m * 512 + ho;
            const float* w = g ? wd : wg; const bf16_t* zg = z + (g ? Z_DZ : Z_GLR) + ho;
            vf4 a0 = *(const vf4*)of + *(const vf4*)ob, a1 = *(const vf4*)(of + 4) + *(const vf4*)(ob + 4);
            vf4 g0, g1; ld8bf(zg, g0, g1);
            const float r = 1.0f / sqrtf(red16(ssq8(a0, a1)) * (1.0f / 128) + EPS);
            a0 = a0 * r * *(const vf4*)w; a1 = a1 * r * *(const vf4*)(w + 4);
#pragma unroll
            for (int j = 0; j < 4; ++j) { a0[j] *= silu_f(g0[j]); a1[j] *= silu_f(g1[j]); }
            *(uint4*)(MRG + (size_t)m * DM + (g ? 1536 : 512) + ho) = pack8(a0, a1);
        }
    }
}
#define XB_TMO      128
#define XB_XCNT(j)  (256  + 64 * (j))
#define XB_XSUB(j)  (1280 + 64 * (j))
#define XB_XGEN(j)  (2304 + 64 * (j))
#define XB_TOP      3328
#define XB_TOPGEN   3392
#define XCD_BAR_WORDS 3456
#define XB_SPIN_CAP (1u << 22)
#define LAS __attribute__((address_space(3)))

__device__ __forceinline__ unsigned xb_ld(unsigned* p)              { return __hip_atomic_load(p, __ATOMIC_RELAXED, __HIP_MEMORY_SCOPE_AGENT); }
__device__ __forceinline__ unsigned xb_add(unsigned* p, unsigned v) { return __hip_atomic_fetch_add(p, v, __ATOMIC_RELAXED, __HIP_MEMORY_SCOPE_AGENT); }
__device__ __forceinline__ unsigned xb_xcc_id() { return (unsigned)__builtin_amdgcn_s_getreg((3 << 11) | 20) & 0xFu; }
#define XB_SPIN(cond, bar) do { unsigned _sp = 0; while (cond) { __builtin_amdgcn_s_sleep(1); \
    if ((++_sp & 255u) == 0u) { if (xb_ld(&(bar)[XB_TMO])) break; if (_sp > XB_SPIN_CAP) { atomicAdd(&(bar)[XB_TMO], 1u); break; } } } } while (0)

struct XcdBarrier {
    unsigned* bar; unsigned x;
    volatile LAS unsigned* st;
};

__device__ __forceinline__ XcdBarrier xcd_barrier_post(unsigned* bar, volatile LAS unsigned* st) {
    XcdBarrier b; b.bar = bar; b.x = xb_xcc_id(); b.st = st;
    if (threadIdx.x == 0) (void)xb_add(&bar[XB_XCNT(b.x)], 1u);
    return b;
}
__device__ __forceinline__ void xcd_barrier_complete(unsigned* bar, unsigned x, unsigned& nloc, unsigned& nx) {
    const unsigned G = gridDim.x * gridDim.y * gridDim.z;
    unsigned sum, cnt, mine, sp = 0u;
    for (;;) {
        sum = 0u; cnt = 0u; mine = 0u;
#pragma unroll
        for (unsigned j = 0; j < 16; ++j) { const unsigned c = xb_ld(&bar[XB_XCNT(j)]); sum += c; cnt += (c > 0u) ? 1u : 0u; mine = (j == x) ? c : mine; }
        if (sum == G) break;
        __builtin_amdgcn_s_sleep(1);
        if ((++sp & 255u) == 0u) { if (xb_ld(&bar[XB_TMO])) break; if (sp > XB_SPIN_CAP) { atomicAdd(&bar[XB_TMO], 1u); break; } }
    }
    nloc = mine > 0u ? mine : 1u; nx = cnt > 0u ? cnt : 1u;
}

__device__ __forceinline__ void xcd_barrier(const XcdBarrier& b) {
    asm volatile("s_waitcnt vmcnt(0)" ::: "memory");
    __syncthreads();
    if (threadIdx.x == 0) {
        unsigned* bar = b.bar;
        __builtin_amdgcn_s_waitcnt(0);
        unsigned nloc = b.st[0], nx = b.st[1];
        if (nloc == 0u) { xcd_barrier_complete(bar, b.x, nloc, nx); b.st[0] = nloc; b.st[1] = nx; }
        const unsigned old = xb_add(&bar[XB_XSUB(b.x)], 1u);
        const unsigned gen = old / nloc;
        if (old + 1u == (gen + 1u) * nloc) {
            __builtin_amdgcn_fence(__ATOMIC_RELEASE, "agent");
            asm volatile("s_waitcnt vmcnt(0)" ::: "memory");
            const unsigned og = xb_add(&bar[XB_TOP], 1u);
            const unsigned tg = og / nx;
            if (og + 1u == (tg + 1u) * nx) xb_add(&bar[XB_TOPGEN], 1u);
            else XB_SPIN(xb_ld(&bar[XB_TOPGEN]) == tg, bar);
            __builtin_amdgcn_fence(__ATOMIC_ACQUIRE, "agent");
            xb_add(&bar[XB_XGEN(b.x)], 1u);
            asm volatile("s_waitcnt vmcnt(0)" ::: "memory");
        } else {
            XB_SPIN(xb_ld(&bar[XB_XGEN(b.x)]) == gen, bar);
            __builtin_amdgcn_fence(__ATOMIC_ACQUIRE, "agent");
            asm volatile("s_waitcnt vmcnt(0)" ::: "memory");
        }
    }
    __syncthreads();
}

#ifndef NT_STORES
#define NT_STORES 0
#endif
namespace pg8 {
#define PG8_LAS __attribute__((address_space(3)))
typedef unsigned short bf16_t;
typedef short bf16x8 __attribute__((ext_vector_type(8)));
typedef float f32x4 __attribute__((ext_vector_type(4)));
typedef unsigned u32x4 __attribute__((ext_vector_type(4)));
typedef int v4i32 __attribute__((ext_vector_type(4)));
typedef int v8i32 __attribute__((ext_vector_type(8)));
constexpr int BM = 256, BK = 64, HALF = 128, HTB = HALF * BK * 2  , STAGE_BYTES = 8 * HTB, NXCD = 8, WGM = 8;

__host__ __device__ __forceinline__ int lds_byte(int r, int c) { const int st = (r >> 4) * 2 + (c >> 5), rr = r & 15, cc = c & 31, ob = rr * 64 + cc * 2; return st * 1024 + (ob ^ (((ob >> 9) & 1) << 5)); }
__host__ __device__ __forceinline__ void stage_rc(int b, int& R, int& C) { const int st = b / 1024, sb = b % 1024, swz = sb ^ (((sb >> 9) & 1) << 5); R = (st >> 1) * 16 + swz / 64; C = (st & 1) * 32 + (swz % 64) / 2; }
__host__ __device__ __forceinline__ int perm32(int rho) { const int n = rho >> 4, i = rho & 15; return 8 * (i >> 2) + 4 * n + (i & 3); }

struct Unit { int pm, pn, k0, nt, at, slot, msk; };
struct Gemm { const bf16_t* A; const bf16_t* Bt; int M, N, K; };

struct StaticOrder {
    int nM, nN, nwg, G, c, ntk, split, msplit;
    __host__ __device__ void init(int M, int N, int K, int G_, int c_, int split_ = 0) { nM = M / BM; nN = N / BM; nwg = nM * nN; G = G_; c = c_; ntk = K / BK; const int rem = nwg % G_; split = (split_ == 1 && rem > 0 && 2 * rem == G_ && ntk >= 8) ? 1 : 0; msplit = (split_ == 2 && rem > 0 && 2 * rem <= G_) ? 1 : 0; }
    __host__ __device__ bool next(int i, Unit& u) const {
        long L = (long)i * G + c; u.k0 = 0; u.nt = ntk; u.at = 0; u.slot = 0; u.msk = 3;
        if (msplit && i == nwg / G) { const int rem = nwg % G; if (c >= 2 * rem) return false; L = (long)i * G + (c % rem); u.msk = (c / rem) ? 2 : 1; }
        if (split && i == nwg / G) { const int rem = nwg % G, sl = c / rem, h0 = ((ntk / 2) + 1) & ~1; L = (long)i * G + (c % rem); u.k0 = sl ? h0 * BK : 0; u.nt = sl ? ntk - h0 : h0; u.at = sl ? 1 : 2; u.slot = c % rem; }
        if (L >= nwg) return false;
        int wgid = (int)L; { const int q = nwg / NXCD, r = nwg % NXCD, xcd = wgid % NXCD, off = wgid / NXCD; wgid = (xcd < r ? xcd * (q + 1) : r * (q + 1) + (xcd - r) * q) + off; }
        const int nig = WGM * nN, gid = wgid / nig, fm = gid * WGM, gsz = (nM - fm) < WGM ? (nM - fm) : WGM;
        u.pm = fm + ((wgid % nig) % gsz); u.pn = (wgid % nig) / gsz; return true;
    }
    __device__ __forceinline__ void a_ready(const Unit&) const {}
    __device__ __forceinline__ void done(const Unit&) const {}
};
__device__ __forceinline__ unsigned cvt_pk_bf16(float lo, float hi) { unsigned r; asm volatile("v_cvt_pk_bf16_f32 %0, %1, %2" : "=v"(r) : "v"(lo), "v"(hi)); return r; }
struct EpiF32 {
    static constexpr bool PERM = false, AFTER_DRAIN = false;
    float* C; int ldc; const float* bias;
    __device__ __forceinline__ void operator()(const f32x4 (&acc)[2][2][4][2], const Unit& u, int wr, int wc, int fr, int fq) const {
        const int row0 = u.pm * BM + wr * 64 + fr, col0 = u.pn * BM + wc * 32 + 4 * fq;
        f32x4 bv[2][2];
#pragma unroll
        for (int bj = 0; bj < 2; ++bj)
#pragma unroll
            for (int n = 0; n < 2; ++n) bv[bj][n] = bias ? *(const f32x4*)(bias + col0 + bj * HALF + n * 16) : (f32x4){0.f, 0.f, 0.f, 0.f};
#pragma unroll
        for (int ai = 0; ai < 2; ++ai)
#pragma unroll
            for (int m = 0; m < 4; ++m) { float* rowp = C + (size_t)(row0 + ai * HALF + m * 16) * ldc + col0;
#pragma unroll
                for (int bj = 0; bj < 2; ++bj)
#pragma unroll
                    for (int n = 0; n < 2; ++n) *(f32x4*)(rowp + bj * HALF + n * 16) = acc[ai][bj][m][n] + bv[bj][n]; }
    }
};

struct EpiSwiGLU {
    static constexpr bool PERM = true, AFTER_DRAIN = false;
    bf16_t* O; int ldc;
    __device__ __forceinline__ void operator()(const f32x4 (&acc)[2][2][4][2], const Unit& u, int wr, int wc, int fr, int fq) const {
        const int row0 = u.pm * BM + wr * 64 + fr, col0 = u.pn * 128 + wc * 32 + 8 * fq;
#pragma unroll
        for (int ai = 0; ai < 2; ++ai) if ((u.msk >> ai) & 1)
#pragma unroll
            for (int m = 0; m < 4; ++m) { bf16_t* rowp = O + (size_t)(row0 + ai * HALF + m * 16) * ldc + col0;
                const f32x4 g0 = acc[ai][0][m][0], g1 = acc[ai][0][m][1], u0 = acc[ai][1][m][0], u1 = acc[ai][1][m][1];
                float r[8];
#pragma unroll
                for (int j = 0; j < 4; ++j) {
                    r[j]     = g0[j] * __builtin_amdgcn_rcpf(1.0f + __builtin_amdgcn_exp2f(-1.4426950408889634f * g0[j])) * u0[j];
                    r[4 + j] = g1[j] * __builtin_amdgcn_rcpf(1.0f + __builtin_amdgcn_exp2f(-1.4426950408889634f * g1[j])) * u1[j]; }
                u32x4 w; w.x = cvt_pk_bf16(r[0], r[1]); w.y = cvt_pk_bf16(r[2], r[3]); w.z = cvt_pk_bf16(r[4], r[5]); w.w = cvt_pk_bf16(r[6], r[7]);
#if NT_STORES
                __builtin_nontemporal_store(w, (u32x4*)rowp);
#else
                *(u32x4*)rowp = w;
#endif
                }
    }
};
struct EpiSwiGLU8 {
    static constexpr bool PERM = true, AFTER_DRAIN = false;
    unsigned char* O; int ldc; float wscale;
    __device__ __forceinline__ void operator()(const f32x4 (&acc)[2][2][4][2], const Unit& u, int wr, int wc, int fr, int fq) const {
        const int row0 = u.pm * BM + wr * 64 + fr, col0 = u.pn * 128 + wc * 32 + 8 * fq;
#pragma unroll
        for (int ai = 0; ai < 2; ++ai) if ((u.msk >> ai) & 1)
#pragma unroll
            for (int m = 0; m < 4; ++m) { unsigned char* rowp = O + (size_t)(row0 + ai * HALF + m * 16) * ldc + col0;
                f32x4 g0 = acc[ai][0][m][0], g1 = acc[ai][0][m][1], u0 = acc[ai][1][m][0], u1 = acc[ai][1][m][1];
                asm volatile("" : "+v"(g0), "+v"(g1), "+v"(u0), "+v"(u1));
                g0 *= wscale; g1 *= wscale; u0 *= wscale; u1 *= wscale;
                float r[8];
#pragma unroll
                for (int j = 0; j < 4; ++j) {
                    r[j]     = g0[j] * __builtin_amdgcn_rcpf(1.0f + __builtin_amdgcn_exp2f(-1.4426950408889634f * g0[j])) * u0[j];
                    r[4 + j] = g1[j] * __builtin_amdgcn_rcpf(1.0f + __builtin_amdgcn_exp2f(-1.4426950408889634f * g1[j])) * u1[j]; }
                uint2 w; w.x = pack4_fp8(r[0], r[1], r[2], r[3]); w.y = pack4_fp8(r[4], r[5], r[6], r[7]);
                *(uint2*)rowp = w; asm volatile("" ::: "memory"); }
    }
};
struct EpiBf16Plain {
    static constexpr bool PERM = true, AFTER_DRAIN = false;
    bf16_t* O; int ldc;
    __device__ __forceinline__ void operator()(const f32x4 (&acc)[2][2][4][2], const Unit& u, int wr, int wc, int fr, int fq) const {
        const int row0 = u.pm * BM + wr * 64 + fr, col0 = u.pn * BM + wc * 32 + 8 * fq;
#pragma unroll
        for (int ai = 0; ai < 2; ++ai) if ((u.msk >> ai) & 1)
#pragma unroll
            for (int m = 0; m < 4; ++m) { bf16_t* rowp = O + (size_t)(row0 + ai * HALF + m * 16) * ldc + col0;
#pragma unroll
                for (int bj = 0; bj < 2; ++bj) { const f32x4 v0 = acc[ai][bj][m][0], v1 = acc[ai][bj][m][1];
                    u32x4 w; w.x = cvt_pk_bf16(v0[0], v0[1]); w.y = cvt_pk_bf16(v0[2], v0[3]); w.z = cvt_pk_bf16(v1[0], v1[1]); w.w = cvt_pk_bf16(v1[2], v1[3]);
                    *(u32x4*)(rowp + bj * HALF) = w; } }
    }
};
struct EpiResid {
    static constexpr bool PERM = false, AFTER_DRAIN = false;
    const float* res; float* out; int ldc; const float* gate0; float coef;
    float* slab; unsigned* flags; unsigned target;
    const float* res_hi; int row_hi;
    __device__ __forceinline__ void operator()(const f32x4 (&acc)[2][2][4][2], const Unit& u, int wr, int wc, int fr, int fq) const {
        const int tidx = ((wr * 4 + wc) * 4 + fq) * 16 + fr;
        if (u.at == 1) {
            const __amdgpu_buffer_rsrc_t rs = __builtin_amdgcn_make_buffer_rsrc((void*)slab, 0, 0x7FFFFFF0, 0x00020000);
            const unsigned base = ((unsigned)u.slot * 32u * 512u + (unsigned)tidx) * 16u;
#pragma unroll
            for (int ai = 0; ai < 2; ++ai)
#pragma unroll
                for (int bj = 0; bj < 2; ++bj)
#pragma unroll
                    for (int m = 0; m < 4; ++m)
#pragma unroll
                        for (int n = 0; n < 2; ++n) { const f32x4 v = acc[ai][bj][m][n]; u32x4 w; w.x = __float_as_uint(v[0]); w.y = __float_as_uint(v[1]); w.z = __float_as_uint(v[2]); w.w = __float_as_uint(v[3]);
                            __builtin_amdgcn_raw_buffer_store_b128(w, rs, base + (unsigned)((((ai * 2 + bj) * 4 + m) * 2 + n) * 512 * 16), 0, 16); }
            asm volatile("s_waitcnt vmcnt(0)" ::: "memory");
            if ((tidx & 63) == 0) __hip_atomic_fetch_add(flags + 64 * u.slot, 1u, __ATOMIC_RELAXED, __HIP_MEMORY_SCOPE_AGENT);
            return;
        }
        const float* part = nullptr;
        if (u.at == 2) {
            unsigned spins = 0;
            while (__hip_atomic_load(flags + 64 * u.slot, __ATOMIC_RELAXED, __HIP_MEMORY_SCOPE_AGENT) < target) { __builtin_amdgcn_s_sleep(2); if (++spins > (1u << 22)) break; }
            __builtin_amdgcn_fence(__ATOMIC_ACQUIRE, "agent");
            asm volatile("s_waitcnt vmcnt(0)" ::: "memory");
            part = slab + ((size_t)u.slot * 32 * 512 + tidx) * 4;
        }
        const int row0 = u.pm * BM + wr * 64 + fr, col0 = u.pn * BM + wc * 32 + 4 * fq;
        const float* gate = gate0 + (size_t)cond_of_row(u.pm * BM) * NMOD;
        const float* rbase = (u.pm * BM >= row_hi) ? res_hi - (size_t)row_hi * ldc : res;
        f32x4 gv[2][2];
#pragma unroll
        for (int bj = 0; bj < 2; ++bj)
#pragma unroll
            for (int n = 0; n < 2; ++n) gv[bj][n] = *(const f32x4*)(gate + col0 + bj * HALF + n * 16) * coef;
#pragma unroll
        for (int ai = 0; ai < 2; ++ai) if ((u.msk >> ai) & 1)
#pragma unroll
            for (int m = 0; m < 4; ++m) { const size_t off = (size_t)(row0 + ai * HALF + m * 16) * ldc + col0;
#pragma unroll
                for (int bj = 0; bj < 2; ++bj)
#pragma unroll
                    for (int n = 0; n < 2; ++n) {
                        f32x4 a = acc[ai][bj][m][n];
                        if (part) a += *(const f32x4*)(part + (size_t)((((ai * 2 + bj) * 4 + m) * 2 + n) * 512 * 4));
                        const f32x4 bs = *(const f32x4*)(rbase + off + bj * HALF + n * 16); *(f32x4*)(out + off + bj * HALF + n * 16) = bs + gv[bj][n] * a; }
                asm volatile("" ::: "memory"); }
    }
};
template <class Epi, class Sched, bool STAMP = false, int FP8 = 0>
__device__ __forceinline__ void gemm_phase(PG8_LAS unsigned char* lds, const Gemm g, const Sched& S, const Epi& E, unsigned long long* stamps) {
    const int tid = opaque_tid(), wid = __builtin_amdgcn_readfirstlane(tid >> 6), lane = tid & 63, wr = wid >> 2, wc = wid & 3, fr = lane & 15, fq = lane >> 4;
    const int K = g.K;
    int ts_lo = 0, ts_hi = 0, nts = 0; const unsigned long long rt_entry = STAMP ? (unsigned long long)wall_clock64() : 0ull;
#define PG8_STAMP() do { if (STAMP && wid == 0 && nts < 64) { const unsigned long long _c = (unsigned long long)clock64(); \
        ts_lo = (lane == nts) ? (int)(unsigned)_c : ts_lo; ts_hi = (lane == nts) ? (int)(unsigned)(_c >> 32) : ts_hi; ++nts; } } while (0)
    PG8_STAMP();
    unsigned voffA[2], voffB[2];
#pragma unroll
    for (int i = 0; i < 2; ++i) { int R, C; stage_rc(tid * 16 + i * 8192, R, C); const int Rb = Epi::PERM ? ((R & ~31) + perm32(R & 31)) : R;
        voffA[i] = (unsigned)(R * K + C) * 2u; voffB[i] = (unsigned)(Rb * K + C) * 2u; }
    const size_t kstep = (size_t)(BK * 2);
    const size_t hstep = (size_t)HALF * K * 2;
    const size_t tstep = 2 * hstep;
    const unsigned ldsw = (unsigned)wid * 1024u;
    const int aoff = lds_byte(wr * 64 + fr, fq * 8), boff = lds_byte(wc * 32 + fr, fq * 8);
#define PG8_SA(b, h) (((b) * 2 + (h)) * HTB)
#define PG8_SB(b, h) ((4 + (b) * 2 + (h)) * HTB)
#define PG8_STAGE(bufoff, gbase, voff) do { _Pragma("unroll") for (int _i = 0; _i < 2; ++_i) \
        __builtin_amdgcn_global_load_lds((const unsigned*)((const char*)(gbase) + (voff)[_i]), (PG8_LAS unsigned*)(lds + (bufoff) + ldsw + _i * 8192), 16, 0, 0); } while (0)
#define PG8_LDA(dst, b, h) do { _Pragma("unroll") for (int m = 0; m < 4; ++m) dst[m] = __builtin_shufflevector(*(const PG8_LAS v4i32*)(lds + PG8_SA(b, h) + aoff + m * 2048), *(const PG8_LAS v4i32*)(lds + PG8_SA(b, h) + aoff + m * 2048 + 1024), 0, 1, 2, 3, 4, 5, 6, 7); } while (0)
#define PG8_LDB(dst, b, h) do { _Pragma("unroll") for (int n = 0; n < 2; ++n) dst[n] = __builtin_shufflevector(*(const PG8_LAS v4i32*)(lds + PG8_SB(b, h) + boff + n * 2048), *(const PG8_LAS v4i32*)(lds + PG8_SB(b, h) + boff + n * 2048 + 1024), 0, 1, 2, 3, 4, 5, 6, 7); } while (0)
#define PG8_HALF(v, k) __builtin_bit_cast(bf16x8, __builtin_shufflevector(v, v, 4 * (k), 4 * (k) + 1, 4 * (k) + 2, 4 * (k) + 3))
#define PG8_MMA(ai, bj, At, Bt) do { __builtin_amdgcn_s_setprio(1); _Pragma("unroll") for (int m = 0; m < 4; ++m) _Pragma("unroll") for (int n = 0; n < 2; ++n) { \
        acc[ai][bj][m][n] = __builtin_amdgcn_mfma_f32_16x16x32_bf16(PG8_HALF(Bt[n], 0), PG8_HALF(At[m], 0), acc[ai][bj][m][n], 0, 0, 0); \
        acc[ai][bj][m][n] = __builtin_amdgcn_mfma_f32_16x16x32_bf16(PG8_HALF(Bt[n], 1), PG8_HALF(At[m], 1), acc[ai][bj][m][n], 0, 0, 0); } __builtin_amdgcn_s_setprio(0); } while (0)
#define PG8_MMA8(ai, bj, At, Bt) do { __builtin_amdgcn_s_setprio(1); _Pragma("unroll") for (int m = 0; m < 4; ++m) _Pragma("unroll") for (int n = 0; n < 2; ++n) \
        acc[ai][bj][m][n] = __builtin_amdgcn_mfma_scale_f32_16x16x128_f8f6f4(Bt[n], At[m], acc[ai][bj][m][n], 0, 0, 0, 127, 0, 127); __builtin_amdgcn_s_setprio(0); } while (0)
#define PG8_Q64(v, q) __builtin_bit_cast(long, __builtin_shufflevector(v, v, 2 * (q), 2 * (q) + 1))
#define PG8_M8L1(ai, bj, m, n, q) acc[ai][bj][m][n] = __builtin_amdgcn_mfma_f32_16x16x32_fp8_fp8(PG8_Q64(Bt_[n], q), PG8_Q64(At_[m], q), acc[ai][bj][m][n], 0, 0, 0)
#define PG8_MMA8L(ai, bj, At, Bt) do { auto& At_ = At; auto& Bt_ = Bt; __builtin_amdgcn_s_setprio(1); _Pragma("unroll") for (int m = 0; m < 4; ++m) _Pragma("unroll") for (int n = 0; n < 2; ++n) { \
        PG8_M8L1(ai, bj, m, n, 0); PG8_M8L1(ai, bj, m, n, 1); PG8_M8L1(ai, bj, m, n, 2); PG8_M8L1(ai, bj, m, n, 3); } __builtin_amdgcn_s_setprio(0); } while (0)
#define PG8_MMAG(ai, bj, At, Bt) do { if (mrow & (1 << (ai))) { if constexpr (FP8 == 1) PG8_MMA8(ai, bj, At, Bt); else if constexpr (FP8 == 2) PG8_MMA8L(ai, bj, At, Bt); else PG8_MMA(ai, bj, At, Bt); } } while (0)
#define PG8_WAIT_V(n) asm volatile("s_waitcnt vmcnt(" #n ")" ::: "memory")
#define PG8_WAIT_L(n) asm volatile("s_waitcnt lgkmcnt(" #n ")" ::: "memory")
#define PG8_BAR __builtin_amdgcn_s_barrier()
#define PG8_SCHED __builtin_amdgcn_sched_barrier(0)
    Unit cur, nxt; int ui = 0;
    if (!S.next(0, cur)) return;
    f32x4 acc[2][2][4][2];
#pragma unroll
    for (int a = 0; a < 2; ++a)
#pragma unroll
        for (int b = 0; b < 2; ++b)
#pragma unroll
            for (int m = 0; m < 4; ++m)
#pragma unroll
                for (int n = 0; n < 2; ++n) acc[a][b][m][n] = (f32x4){0.f, 0.f, 0.f, 0.f};
    v8i32 At[4], B0[2], B1[2];
    const char* cA = (const char*)g.A + (size_t)cur.pm * tstep + (size_t)cur.k0 * 2; const char* cB = (const char*)g.Bt + (size_t)cur.pn * tstep + (size_t)cur.k0 * 2;
    S.a_ready(cur);
    PG8_STAGE(PG8_SB(0, 0), cB, voffB); PG8_STAGE(PG8_SA(0, 0), cA, voffA); PG8_STAGE(PG8_SB(0, 1), cB + hstep, voffB); PG8_STAGE(PG8_SA(0, 1), cA + hstep, voffA);
    if (wr == 1) PG8_BAR;
    PG8_WAIT_V(4); PG8_BAR;
    PG8_STAGE(PG8_SB(1, 0), cB + kstep, voffB); PG8_STAGE(PG8_SA(1, 0), cA + kstep, voffA); PG8_STAGE(PG8_SB(1, 1), cB + hstep + kstep, voffB);
    PG8_WAIT_V(6); PG8_BAR;
    PG8_STAMP();
    for (;;) {
        const bool has_next = S.next(ui + 1, nxt);
        const char* nA = has_next ? (const char*)g.A + (size_t)nxt.pm * tstep + (size_t)nxt.k0 * 2 : cA; const char* nB = has_next ? (const char*)g.Bt + (size_t)nxt.pn * tstep + (size_t)nxt.k0 * 2 : cB;
        const int nt = cur.nt, mrow = cur.msk;
        for (int t = 0; t < nt; t += 2) {
            const bool last = (t == nt - 2);
            const char* a1 = cA + (size_t)(t + 1) * kstep;
            const char* a2 = last ? nA : cA + (size_t)(t + 2) * kstep; const char* b2 = last ? nB : cB + (size_t)(t + 2) * kstep;
            const char* a3 = a2 + kstep; const char* b3 = b2 + kstep;
            if (last && has_next) S.a_ready(nxt);
            PG8_LDB(B0, 0, 0); PG8_SCHED; PG8_LDA(At, 0, 0); PG8_STAGE(PG8_SA(1, 1), a1 + hstep, voffA);
            PG8_WAIT_L(8); PG8_BAR; PG8_WAIT_L(0); PG8_MMAG(0, 0, At, B0); PG8_BAR; PG8_SCHED;
            PG8_LDB(B1, 0, 1); PG8_STAGE(PG8_SB(0, 0), b2, voffB);
            PG8_BAR; PG8_WAIT_L(0); PG8_MMAG(0, 1, At, B1); PG8_BAR;
            PG8_LDA(At, 0, 1); PG8_STAGE(PG8_SA(0, 0), a2, voffA);
            PG8_BAR; PG8_WAIT_L(0); PG8_MMAG(1, 0, At, B0); PG8_BAR; PG8_SCHED;
            PG8_STAGE(PG8_SB(0, 1), b2 + hstep, voffB);
            PG8_WAIT_V(6); PG8_BAR; PG8_MMAG(1, 1, At, B1); PG8_BAR;
            PG8_LDB(B0, 1, 0); PG8_SCHED; PG8_LDA(At, 1, 0); PG8_STAGE(PG8_SA(0, 1), a2 + hstep, voffA);
            PG8_WAIT_L(8); PG8_BAR; PG8_WAIT_L(0); PG8_MMAG(0, 0, At, B0); PG8_BAR; PG8_SCHED;
            PG8_LDB(B1, 1, 1); PG8_STAGE(PG8_SB(1, 0), b3, voffB);
            PG8_BAR; PG8_WAIT_L(0); PG8_MMAG(0, 1, At, B1); PG8_BAR;
            PG8_LDA(At, 1, 1); PG8_STAGE(PG8_SA(1, 0), a3, voffA);
            PG8_BAR; PG8_WAIT_L(0); PG8_MMAG(1, 0, At, B0); PG8_BAR; PG8_SCHED;
            PG8_STAGE(PG8_SB(1, 1), b3 + hstep, voffB);
            PG8_WAIT_V(6); PG8_BAR; PG8_MMAG(1, 1, At, B1); PG8_BAR;
        }
        PG8_STAMP();
        if constexpr (!Epi::AFTER_DRAIN) { E(acc, cur, wr, wc, fr, fq); S.done(cur); }
        PG8_STAMP();
        if (!has_next) break;
#pragma unroll
        for (int a = 0; a < 2; ++a)
#pragma unroll
            for (int b = 0; b < 2; ++b)
#pragma unroll
                for (int m = 0; m < 4; ++m)
#pragma unroll
                    for (int n = 0; n < 2; ++n) acc[a][b][m][n] = (f32x4){0.f, 0.f, 0.f, 0.f};
        cur = nxt; cA = nA; cB = nB; ++ui;
    }
    PG8_WAIT_V(0);
    if (wr == 0) PG8_BAR;
    PG8_BAR;
    if constexpr (Epi::AFTER_DRAIN) { E.fused(acc, cur, wr, wc, fr, fq, lds, wid, lane); S.done(cur); }
    PG8_STAMP();
    if (STAMP && wid == 0) { stamps[lane] = lane < nts ? (((unsigned long long)(unsigned)ts_hi << 32) | (unsigned)ts_lo) : 0ull;
        if (lane == 62) stamps[62] = rt_entry; if (lane == 63) stamps[63] = (unsigned long long)wall_clock64(); }
#undef PG8_STAMP
#undef PG8_SA
#undef PG8_SB
#undef PG8_STAGE
#undef PG8_LDA
#undef PG8_LDB
#undef PG8_HALF
#undef PG8_MMA
#undef PG8_MMA8
#undef PG8_MMA8L
#undef PG8_M8L1
#undef PG8_Q64
#undef PG8_MMAG
#undef PG8_WAIT_V
#undef PG8_WAIT_L
#undef PG8_BAR
#undef PG8_SCHED
}
}
#ifndef ATT_INLINE
#define ATT_INLINE __forceinline__
#endif
namespace att {
constexpr int D = 128, NW = 8, QBLK = 32, KVBLK = 64, LDQ = 512, LDO = DM;
constexpr float SCALE = 0.088388347648318440f;
constexpr float THR = 8.f;
constexpr size_t SHM_V = KVBLK * D * 2, SHM_K = KVBLK * D * 2, SHM_Q = 256 * D * 2, SHM_ATTN = 2 * SHM_V + 2 * SHM_K + NW * 64 * 4 + SHM_Q;
using bf16x8 = __attribute__((ext_vector_type(8))) short;
using s16x4  = __attribute__((ext_vector_type(4))) short;
using f32x16 = __attribute__((ext_vector_type(16))) float;
using u32x4  = __attribute__((ext_vector_type(4))) unsigned;
#define KSWZ(row, colB) ((row) * 256 + ((colB) ^ (((row) & 7) << 4)))
#define SBAR() __builtin_amdgcn_sched_barrier(0)
__device__ __forceinline__ int crow(int r, int hi) { return (r & 3) + 8 * (r >> 2) + 4 * hi; }
__device__ __forceinline__ unsigned cvtpk(float lo, float hi) { unsigned r; asm volatile("v_cvt_pk_bf16_f32 %0, %1, %2" : "=v"(r) : "v"(lo), "v"(hi)); return r; }

__device__ __forceinline__ void partialSM(f32x16& p0, f32x16& p1, float& m_reg, float& mn, float& alpha) {
  constexpr float C = SCALE * 1.4426950408889634f;
  float pmax = p0[0]; for (int r = 1; r < 16; ++r) pmax = fmaxf(pmax, p0[r]); for (int r = 0; r < 16; ++r) pmax = fmaxf(pmax, p1[r]);
  { auto rr = __builtin_amdgcn_permlane32_swap(__float_as_uint(pmax), __float_as_uint(pmax), false, false);
    pmax = fmaxf(__uint_as_float(rr[0]), __uint_as_float(rr[1])); }
  if (__builtin_expect(__all(pmax - m_reg <= THR / SCALE), 1)) { mn = m_reg; alpha = 1.f; }
  else { mn = fmaxf(m_reg, pmax); alpha = __builtin_amdgcn_exp2f((m_reg - mn) * C); m_reg = mn; }
  float mnC = -mn * C;
  for (int r = 0; r < 16; ++r) p0[r] = fmaf(p0[r], C, mnC); for (int r = 0; r < 16; ++r) p1[r] = fmaf(p1[r], C, mnC);
  for (int r = 0; r < 16; ++r) p0[r] = __builtin_amdgcn_exp2f(p0[r]);
}
__device__ __forceinline__ void finishSM(f32x16& p0, f32x16& p1, float alpha, float& l_reg, bf16x8& pa0, bf16x8& pa1, bf16x8& pa2, bf16x8& pa3) {
  for (int r = 0; r < 16; ++r) p1[r] = __builtin_amdgcn_exp2f(p1[r]);
  float ps = 0; for (int r = 0; r < 16; ++r) ps += p0[r]; for (int r = 0; r < 16; ++r) ps += p1[r];
  { auto rr = __builtin_amdgcn_permlane32_swap(__float_as_uint(ps), __float_as_uint(ps), false, false);
    ps = __uint_as_float(rr[0]) + __uint_as_float(rr[1]); }
  l_reg = l_reg * alpha + ps;
#define PK4(P, BASE, OUT) do { unsigned a0 = cvtpk(P[BASE + 0], P[BASE + 1]), a1 = cvtpk(P[BASE + 2], P[BASE + 3]);   \
    unsigned b0 = cvtpk(P[BASE + 4], P[BASE + 5]), b1 = cvtpk(P[BASE + 6], P[BASE + 7]);                              \
    auto r0 = __builtin_amdgcn_permlane32_swap(a0, b0, false, false); auto r1 = __builtin_amdgcn_permlane32_swap(a1, b1, false, false); \
    u32x4 w = {r0[0], r1[0], r0[1], r1[1]}; OUT = *reinterpret_cast<bf16x8*>(&w); } while (0)
  PK4(p0, 0, pa0); PK4(p0, 8, pa1); PK4(p1, 0, pa2); PK4(p1, 8, pa3);
#undef PK4
}
__device__ __forceinline__ void qkt(f32x16& p0, f32x16& p1, const bf16_t* Ks, const bf16_t* Qs, int qrow, int r32, int hi) {
  p0 = f32x16{}; p1 = f32x16{};
#pragma unroll
  for (int d0 = 0; d0 < 8; ++d0) { int cb = (d0 * 16 + hi * 8) * 2;
    bf16x8 q = *reinterpret_cast<const bf16x8*>((const char*)Qs + KSWZ(qrow, cb));
    bf16x8 b0 = *reinterpret_cast<const bf16x8*>((const char*)Ks + KSWZ(r32, cb));
    bf16x8 b1 = *reinterpret_cast<const bf16x8*>((const char*)Ks + KSWZ(32 + r32, cb));
    p0 = __builtin_amdgcn_mfma_f32_32x32x16_bf16(b0, q, p0, 0, 0, 0);
    p1 = __builtin_amdgcn_mfma_f32_32x32x16_bf16(b1, q, p1, 0, 0, 0); }
}
__device__ __forceinline__ int v_st(int k, int c) { const int kk = (k & ~0xC) | ((k & 4) << 1) | ((k & 8) >> 1); return ((kk >> 3) * 4 + (c >> 5)) * 512 + ((kk & 7) * 32 + (c & 31)) * 2; }
__device__ __forceinline__ int v_rd_base(int lane) { return ((lane & 3) << 3) | (((lane >> 2) & 3) << 6) | (((lane >> 4) & 1) << 5) | (((lane >> 5) & 1) << 8); }
constexpr int v_rd_off(int d0, int ks, int half) { return d0 * 512 + ks * 4096 + half * 2048; }
template <int OFF> __device__ __forceinline__ s16x4 tr_read(int vb) {
  s16x4 r; asm volatile("ds_read_b64_tr_b16 %0, %1 offset:%2" : "=&v"(r) : "v"(vb), "i"(OFF) : "memory"); return r;
}
template <int D0> __device__ __forceinline__ void pv_one(f32x16& od, int vb, bf16x8 pa0, bf16x8 pa1, bf16x8 pa2, bf16x8 pa3) {
  const s16x4 l0 = tr_read<v_rd_off(D0, 0, 0)>(vb), h0 = tr_read<v_rd_off(D0, 0, 1)>(vb), l1 = tr_read<v_rd_off(D0, 1, 0)>(vb), h1 = tr_read<v_rd_off(D0, 1, 1)>(vb);
  const s16x4 l2 = tr_read<v_rd_off(D0, 2, 0)>(vb), h2 = tr_read<v_rd_off(D0, 2, 1)>(vb), l3 = tr_read<v_rd_off(D0, 3, 0)>(vb), h3 = tr_read<v_rd_off(D0, 3, 1)>(vb);
  asm volatile("s_waitcnt lgkmcnt(0)" ::: "memory"); SBAR();
#define PK(L, H) (bf16x8){L[0], L[1], L[2], L[3], H[0], H[1], H[2], H[3]}
  od = __builtin_amdgcn_mfma_f32_32x32x16_bf16(pa0, PK(l0, h0), od, 0, 0, 0);
  od = __builtin_amdgcn_mfma_f32_32x32x16_bf16(pa1, PK(l1, h1), od, 0, 0, 0);
  od = __builtin_amdgcn_mfma_f32_32x32x16_bf16(pa2, PK(l2, h2), od, 0, 0, 0);
  od = __builtin_amdgcn_mfma_f32_32x32x16_bf16(pa3, PK(l3, h3), od, 0, 0, 0);
#undef PK
}
__device__ __forceinline__ void pv_d0(f32x16* o, int vb, bf16x8 pa0, bf16x8 pa1, bf16x8 pa2, bf16x8 pa3) {
  pv_one<0>(o[0], vb, pa0, pa1, pa2, pa3); pv_one<1>(o[1], vb, pa0, pa1, pa2, pa3); pv_one<2>(o[2], vb, pa0, pa1, pa2, pa3); pv_one<3>(o[3], vb, pa0, pa1, pa2, pa3);
}

struct SrcOne { const bf16_t* k0; const bf16_t* v0; int ldk;
  __device__ __forceinline__ const bf16_t* k(int j) const { return k0 + (size_t)j * 64 * ldk; }
  __device__ __forceinline__ const bf16_t* v(int j) const { return v0 + (size_t)j * 64 * ldk; } };
struct SrcTwo { const bf16_t* ck; const bf16_t* cv; const bf16_t* k1; const bf16_t* v1; int ldk;
  __device__ __forceinline__ const bf16_t* k(int j) const { return j < 4 ? ck + (size_t)j * 64 * ldk : k1 + (size_t)(j - 4) * 64 * ldk; }
  __device__ __forceinline__ const bf16_t* v(int j) const { return j < 4 ? cv + (size_t)j * 64 * ldk : v1 + (size_t)(j - 4) * 64 * ldk; } };
struct NoBias { __device__ __forceinline__ void operator()(f32x16&, f32x16&, int, int, int, int) const {} };
struct NaBias { const float* tab; int i0, kr0;
  __device__ __forceinline__ void operator()(f32x16& p0, f32x16& p1, int jt, int wid, int r32, int hi) const {
    if (jt < 4) return;
    const int qi = i0 + wid * QBLK + r32, r = qi >> 6, qc = qi & 63, kr = kr0 + jt - 4;
    int lo = r - 4; lo = lo < 0 ? 0 : (lo > 8 ? 8 : lo);
    const bool rowok = (kr >= lo) && (kr < lo + 8);
    if (!rowok) {
#pragma unroll
      for (int rr = 0; rr < 16; ++rr) { p0[rr] = -1e30f; p1[rr] = -1e30f; }
      return;
    }
    int c0 = qc - 8; c0 = c0 < 0 ? 0 : (c0 > 48 ? 48 : c0);
    const int dr = kr - r + 7;
    const float* tb = tab + dr * 31 + (4 * hi - qc + 15);
    const int w0 = 4 * hi - c0;
#pragma unroll
    for (int g = 0; g < 4; ++g) {
#pragma unroll
      for (int q = 0; q < 4; ++q) {
        const int rr = 4 * g + q, kc0 = q + 8 * g;
        const float t0 = tb[kc0], t1 = tb[kc0 + 32];
        p0[rr] = ((unsigned)(kc0 + w0) < 16u) ? p0[rr] + t0 : -1e30f;
        p1[rr] = ((unsigned)(kc0 + 32 + w0) < 16u) ? p1[rr] + t1 : -1e30f;
      }
      SBAR();
    }
  } };

template <int SD, class Src, class Bias>
__device__ ATT_INLINE void attn_body(const bf16_t* __restrict__ Qb, const Src src, bf16_t* __restrict__ Ob, const int NT, char* lds, const Bias bias) {
  const int tid = opaque_tid(), wid = tid >> 6, lane = tid & 63, r32 = lane & 31, hi = lane >> 5;
  const int LDK = src.ldk;
  bf16_t* V_lds = (bf16_t*)lds; bf16_t* K_lds = (bf16_t*)(lds + 2 * SHM_V);
  float* ws = (float*)(lds + 2 * SHM_V + 2 * SHM_K) + wid * 64; float* li_l = ws; float* al_l = ws + 32;
  float m_reg = -1e30f, l_reg = 0; f32x16 o[4] = {};
  bf16_t* Q_lds = (bf16_t*)(lds + 2 * SHM_V + 2 * SHM_K + NW * 64 * 4);
  const int qrow = wid * QBLK + r32;
  {
#pragma unroll
    for (int i = 0; i < 8; ++i) { const int f = tid + 512 * i, row = f >> 4, c8 = (f & 15) * 8;
      *(bf16x8*)((char*)Q_lds + KSWZ(row, c8 * 2)) = *reinterpret_cast<const bf16x8*>(Qb + (long)row * LDQ + c8); }
  }
  const int sr = tid >> 4, sc = (tid & 15) * 8, vst0 = v_st(sr, sc), vst1 = v_st(32 + sr, sc);
  const int vb0 = (int)(uintptr_t)V_lds + v_rd_base(lane);
  struct { bf16x8 vs0, vs1, ks0, ks1; } sr_[SD];
#define SLOAD(i, jt) do { const bf16_t* kt_ = src.k(jt); const bf16_t* vt_ = src.v(jt); \
    sr_[i].vs0 = *reinterpret_cast<const bf16x8*>(&vt_[(long)sr * LDK + sc]); sr_[i].vs1 = *reinterpret_cast<const bf16x8*>(&vt_[(long)(32 + sr) * LDK + sc]); \
    sr_[i].ks0 = *reinterpret_cast<const bf16x8*>(&kt_[(long)sr * LDK + sc]); sr_[i].ks1 = *reinterpret_cast<const bf16x8*>(&kt_[(long)(32 + sr) * LDK + sc]); } while (0)
#define SWRITE(b, i) do { *(bf16x8*)((char*)V_lds + (b) * SHM_V + vst0) = sr_[i].vs0;          \
    *(bf16x8*)((char*)V_lds + (b) * SHM_V + vst1) = sr_[i].vs1; int kc = sc * 2;               \
    *(bf16x8*)((char*)K_lds + (b) * SHM_K + KSWZ(sr, kc)) = sr_[i].ks0;                       \
    *(bf16x8*)((char*)K_lds + (b) * SHM_K + KSWZ(32 + sr, kc)) = sr_[i].ks1; } while (0)
#define SWAIT() do { if constexpr (SD == 2) asm volatile("s_waitcnt vmcnt(4)" ::: "memory"); else asm volatile("s_waitcnt vmcnt(0)" ::: "memory"); } while (0)
#define RESC(a) do { if (__any((a) < 1.f)) { if (hi == 0) al_l[r32] = (a); asm volatile("s_waitcnt lgkmcnt(0)" ::: "memory"); \
    for (int d = 0; d < 4; ++d) for (int r = 0; r < 16; ++r) o[d][r] *= al_l[crow(r, hi)]; } } while (0)
  f32x16 pA0, pA1, pB0, pB1; float mnA, mnB, alA, alB; bf16x8 pa0, pa1, pa2, pa3;
  constexpr int SE = 0, SO = SD - 1;
  SLOAD(SE, 0); asm volatile("s_waitcnt vmcnt(0)" ::: "memory"); SWRITE(0, SE); __syncthreads();
  qkt(pA0, pA1, K_lds, Q_lds, qrow, r32, hi); bias(pA0, pA1, 0, wid, r32, hi); partialSM(pA0, pA1, m_reg, mnA, alA);
  SLOAD(SO, 1); if constexpr (SD == 2) { if (2 < NT) SLOAD(SE, 2); }
  SWAIT(); SWRITE(1, SO); __syncthreads();
  for (int j = 1; j + 1 < NT; j += 2) {
    SBAR(); qkt(pB0, pB1, (bf16_t*)((char*)K_lds + SHM_K), Q_lds, qrow, r32, hi); bias(pB0, pB1, j, wid, r32, hi);
    finishSM(pA0, pA1, alA, l_reg, pa0, pa1, pa2, pa3); SBAR();
    SLOAD(SO, j + SD); SBAR();
    pv_d0(o, vb0, pa0, pa1, pa2, pa3); partialSM(pB0, pB1, m_reg, mnB, alB);
    __syncthreads(); SWAIT(); SWRITE(0, SE);
    RESC(alB); __syncthreads();
    SBAR(); qkt(pA0, pA1, K_lds, Q_lds, qrow, r32, hi); bias(pA0, pA1, j + 1, wid, r32, hi);
    finishSM(pB0, pB1, alB, l_reg, pa0, pa1, pa2, pa3); SBAR();
    if (SD == 1 || j + 3 < NT) SLOAD(SE, j + 1 + SD); SBAR();
    pv_d0(o, vb0 + (int)SHM_V, pa0, pa1, pa2, pa3); partialSM(pA0, pA1, m_reg, mnA, alA);
    __syncthreads(); SWAIT(); SWRITE(1, SO);
    RESC(alA); __syncthreads();
  }
  SBAR(); qkt(pB0, pB1, (bf16_t*)((char*)K_lds + SHM_K), Q_lds, qrow, r32, hi); bias(pB0, pB1, NT - 1, wid, r32, hi);
  finishSM(pA0, pA1, alA, l_reg, pa0, pa1, pa2, pa3); SBAR();
  pv_d0(o, vb0, pa0, pa1, pa2, pa3); partialSM(pB0, pB1, m_reg, mnB, alB);
  __syncthreads(); RESC(alB);
  finishSM(pB0, pB1, alB, l_reg, pa0, pa1, pa2, pa3); SBAR();
  pv_d0(o, vb0 + (int)SHM_V, pa0, pa1, pa2, pa3);
  if (hi == 0) li_l[r32] = l_reg; asm volatile("s_waitcnt lgkmcnt(0)" ::: "memory");
  float rli[16];
#pragma unroll
  for (int r = 0; r < 16; ++r) rli[r] = __builtin_amdgcn_rcpf(li_l[crow(r, hi)]);
  bf16_t* Ow = Ob + (long)(wid * QBLK) * LDO;
#pragma unroll
  for (int r = 0; r < 16; ++r) { int orow = crow(r, hi);
    for (int d0 = 0; d0 < 4; ++d0) Ow[(long)orow * LDO + d0 * 32 + r32] = f2bf(o[d0][r] * rli[r]); }
#undef SLOAD
#undef SWRITE
#undef SWAIT
#undef RESC
}
}
namespace gdn {
using att::bf16x8; using att::f32x16; using att::crow;
constexpr int C = 32, SK = 136, SS = 40;
constexpr int OFF_KT = 0, OFF_QT = OFF_KT + C * SK * 2, OFF_W = OFF_QT + C * SK * 2, OFF_KTT = OFF_W + C * SK * 2, OFF_VTT = OFF_KTT + 128 * SS * 2,
              OFF_VN = OFF_VTT + 128 * SS * 2, OFF_VNS = OFF_VN + 128 * SS * 2, OFF_ST = OFF_VNS + 128 * SS * 2, OFF_TB = OFF_ST + 128 * SK * 2,
              OFF_TBE = OFF_TB + C * SS * 2, OFF_ATT = OFF_TBE + C * SS * 2, OFF_L = OFF_ATT + C * SS * 2, OFF_SC = OFF_L + C * C * 4, GDN_LDS = OFF_SC + 1024;
template <int K>
__device__ __forceinline__ f32x16 mm(const bf16_t* A, int lda, const bf16_t* Bt, int ldb, int l32, int hi, f32x16 acc) {
#pragma unroll
    for (int k0 = 0; k0 < K; k0 += 16) {
        const bf16x8 a = *reinterpret_cast<const bf16x8*>(A + l32 * lda + k0 + 8 * hi);
        const bf16x8 b = *reinterpret_cast<const bf16x8*>(Bt + l32 * ldb + k0 + 8 * hi);
        acc = __builtin_amdgcn_mfma_f32_32x32x16_bf16(a, b, acc, 0, 0, 0);
    }
    return acc;
}
__device__ __forceinline__ uint2 pk4(float a, float b, float c, float d) { uint2 w; w.x = pack2(a, b); w.y = pack2(c, d); return w; }

__device__ __forceinline__ void gdn_chunked(const Params& p, int l, bool ctx, int b, int h, int dir, unsigned char* lds) {
    const int tid = opaque_tid(), wid = tid >> 6, lane = tid & 63, l32 = lane & 31, hi = lane >> 5;
    const int T = ctx ? CT : ::LT; const size_t m0 = ctx ? (size_t)b * CT : (size_t)MC + (size_t)b * ::LT;
    const bf16_t* DQ = WSP(bf16_t, WS_DQ); const bf16_t* DK = WSP(bf16_t, WS_DK); const bf16_t* DV = WSP(bf16_t, WS_DV); const float* DBA = WSP(float, WS_DBA);
    float* O = WSP(float, dir ? WS_DOB : WS_DOF);
    bf16_t* Kt = (bf16_t*)(lds + OFF_KT); bf16_t* Qt = (bf16_t*)(lds + OFF_QT); bf16_t* W = (bf16_t*)(lds + OFF_W); bf16_t* KT = (bf16_t*)(lds + OFF_KTT); bf16_t* VT = (bf16_t*)(lds + OFF_VTT);
    bf16_t* VN = (bf16_t*)(lds + OFF_VN); bf16_t* VNS = (bf16_t*)(lds + OFF_VNS); bf16_t* ST = (bf16_t*)(lds + OFF_ST); bf16_t* TB = (bf16_t*)(lds + OFF_TB); bf16_t* TBE = (bf16_t*)(lds + OFF_TBE);
    bf16_t* ATT = (bf16_t*)(lds + OFF_ATT); float* Lm = (float*)(lds + OFF_L); float* sc = (float*)(lds + OFF_SC);
    const int nch = T / C;
#define TOK(c, s_) (m0 + (dir ? T - 1 - ((c) * C + (s_)) : (c) * C + (s_)))
    f32x16 S[2];
#pragma unroll
    for (int bi = 0; bi < 2; ++bi) {
        const int blk = wid * 2 + bi, d0 = 32 * (blk >> 2), e0 = 32 * (blk & 3);
        if (ctx) { S[bi] = f32x16{}; }
        else {
            const float* s0 = p.in[I_SGDN] + ((((size_t)b * DEPTH + l) * 2 + dir) * 4 + h) * 128 * 128 + e0 + l32;
#pragma unroll
            for (int r = 0; r < 16; ++r) S[bi][r] = s0[(size_t)(d0 + crow(r, hi)) * 128];
        }
    }
    const int ls = tid >> 5, lc = (tid & 31) * 4;
    vf4 pq0, pq1, pk0, pk1, pv0, pv1; float pbeta = 0.f, pg = 0.f;
#define GLOAD(c) do { const size_t ma = TOK(c, ls), mb = TOK(c, ls + 16); \
        pq0 = ld4bf(DQ + ma * 512 + h * 128 + lc); pq1 = ld4bf(DQ + mb * 512 + h * 128 + lc); \
        pk0 = ld4bf(DK + ma * 512 + h * 128 + lc); pk1 = ld4bf(DK + mb * 512 + h * 128 + lc); \
        pv0 = ld4bf(DV + ma * 512 + h * 128 + lc); pv1 = ld4bf(DV + mb * 512 + h * 128 + lc); \
        if (tid < C) { const size_t mt = TOK(c, tid); pbeta = DBA[mt * 16 + dir * 4 + h]; pg = DBA[mt * 16 + 8 + dir * 4 + h]; } } while (0)
#define GSTAGE() do { \
        *(uint2*)(Kt + ls * SK + lc) = pk4(pk0.x, pk0.y, pk0.z, pk0.w); *(uint2*)(Kt + (ls + 16) * SK + lc) = pk4(pk1.x, pk1.y, pk1.z, pk1.w); \
        *(uint2*)(Qt + ls * SK + lc) = pk4(pq0.x, pq0.y, pq0.z, pq0.w); *(uint2*)(Qt + (ls + 16) * SK + lc) = pk4(pq1.x, pq1.y, pq1.z, pq1.w); \
        _Pragma("unroll") for (int j = 0; j < 4; ++j) { KT[(lc + j) * SS + ls] = f2bf(pk0[j]); KT[(lc + j) * SS + ls + 16] = f2bf(pk1[j]); \
                                                        VT[(lc + j) * SS + ls] = f2bf(pv0[j]); VT[(lc + j) * SS + ls + 16] = f2bf(pv1[j]); } \
        if (wid == 0) { float x = pg; _Pragma("unroll") for (int o_ = 1; o_ < 32; o_ <<= 1) { const float y = __shfl_up(x, o_); if (lane >= o_) x += y; } \
            const float Bt_ = __shfl(x, 31); if (lane < C) { sc[lane] = pbeta; sc[32 + lane] = x; sc[64 + lane] = __expf(x); sc[96 + lane] = __expf(Bt_ - x); if (lane == 0) sc[128] = __expf(Bt_); } } } while (0)
    __syncthreads();
    GLOAD(0);
#pragma unroll
    for (int bi = 0; bi < 2; ++bi) {
        const int blk = wid * 2 + bi, d0 = 32 * (blk >> 2), e0 = 32 * (blk & 3);
#pragma unroll
        for (int g = 0; g < 4; ++g) *(uint2*)(ST + (e0 + l32) * SK + d0 + 8 * g + 4 * hi) = pk4(S[bi][4 * g], S[bi][4 * g + 1], S[bi][4 * g + 2], S[bi][4 * g + 3]);
    }
    GSTAGE();
    __syncthreads();
    for (int c = 0; c < nch; ++c) {
        if (c + 1 < nch) GLOAD(c + 1);
        f32x16 acc1 = f32x16{};
        if (wid == 0) {
            const f32x16 kk = mm<128>(Kt, SK, Kt, SK, l32, hi, f32x16{});
            const float bi_ = sc[32 + l32], be = sc[l32];
#pragma unroll
            for (int r = 0; r < 16; ++r) { const int j = crow(r, hi); const float v = (l32 > j) ? be * kk[r] * __expf(bi_ - sc[32 + j]) : 0.f;
                Lm[l32 * 32 + ((r & 3) + 4 * hi) * 4 + (r >> 2)] = v; }
        } else if (wid == 1) {
            const f32x16 kq = mm<128>(Kt, SK, Qt, SK, l32, hi, f32x16{});
            const float bi_ = sc[32 + l32];
            float a[16];
#pragma unroll
            for (int r = 0; r < 16; ++r) { const int j = crow(r, hi); a[r] = (l32 >= j) ? kq[r] * __expf(bi_ - sc[32 + j]) : 0.f; }
#pragma unroll
            for (int g = 0; g < 4; ++g) *(uint2*)(ATT + l32 * SS + 8 * g + 4 * hi) = pk4(a[4 * g], a[4 * g + 1], a[4 * g + 2], a[4 * g + 3]);
        } else if (wid >= 4) {
            acc1 = mm<128>(Qt, SK, ST + (32 * (wid - 4)) * SK, SK, l32, hi, f32x16{});
#pragma unroll
            for (int r = 0; r < 16; ++r) acc1[r] *= sc[64 + crow(r, hi)];
        }
        __syncthreads();
        if (tid < 256) {
            const int cc = tid >> 3, part = tid & 7;
            float Tr[4] = {0.f, 0.f, 0.f, 0.f};
            const float* Lp = Lm + part * 4;
#pragma unroll
            for (int i = 0; i < 32; ++i) {
                const vf4 lv = *(const vf4*)(Lp + i * 32);
                float s = lv.x * Tr[0] + lv.y * Tr[1] + lv.z * Tr[2] + lv.w * Tr[3];
                s = red8(s);
                const float t = (i == cc ? 1.f : 0.f) - s;
                if (part == (i & 7)) Tr[i >> 3] = t;
            }
            const float bc = sc[cc], bec = bc * sc[64 + cc];
#pragma unroll
            for (int jj = 0; jj < 4; ++jj) { TB[(part + 8 * jj) * SS + cc] = f2bf(Tr[jj] * bc); TBE[(part + 8 * jj) * SS + cc] = f2bf(Tr[jj] * bec); }
        }
        __syncthreads();
        if (wid < 4) {
            acc1 = mm<32>(TB, SS, VT + (32 * wid) * SS, SS, l32, hi, f32x16{});
        } else {
            const int d0 = 32 * (wid - 4);
            const f32x16 wt = mm<32>(KT + d0 * SS, SS, TBE, SS, l32, hi, f32x16{});
#pragma unroll
            for (int g = 0; g < 4; ++g) *(uint2*)(W + l32 * SK + d0 + 8 * g + 4 * hi) = pk4(wt[4 * g], wt[4 * g + 1], wt[4 * g + 2], wt[4 * g + 3]);
        }
        __syncthreads();
        if (wid < 4) {
            const int e0 = 32 * wid;
            const f32x16 ws = mm<128>(W, SK, ST + e0 * SK, SK, l32, hi, f32x16{});
            float vn[16], vs[16];
#pragma unroll
            for (int r = 0; r < 16; ++r) { vn[r] = acc1[r] - ws[r]; vs[r] = vn[r] * sc[96 + crow(r, hi)]; }
#pragma unroll
            for (int g = 0; g < 4; ++g) { *(uint2*)(VN + (e0 + l32) * SS + 8 * g + 4 * hi) = pk4(vn[4 * g], vn[4 * g + 1], vn[4 * g + 2], vn[4 * g + 3]);
                                          *(uint2*)(VNS + (e0 + l32) * SS + 8 * g + 4 * hi) = pk4(vs[4 * g], vs[4 * g + 1], vs[4 * g + 2], vs[4 * g + 3]); }
        }
        __syncthreads();
        if (wid >= 4) {
            const int e0 = 32 * (wid - 4);
            acc1 = mm<32>(ATT, SS, VN + e0 * SS, SS, l32, hi, acc1);
#pragma unroll
            for (int r = 0; r < 16; ++r) O[TOK(c, crow(r, hi)) * 512 + h * 128 + e0 + l32] = acc1[r];
        }
        {
            const float eB = sc[128];
#pragma unroll
            for (int bi = 0; bi < 2; ++bi) {
                const int blk = wid * 2 + bi, d0 = 32 * (blk >> 2), e0 = 32 * (blk & 3);
#pragma unroll
                for (int r = 0; r < 16; ++r) S[bi][r] *= eB;
                S[bi] = mm<32>(KT + d0 * SS, SS, VNS + e0 * SS, SS, l32, hi, S[bi]);
            }
        }
        __syncthreads();
#pragma unroll
        for (int bi = 0; bi < 2; ++bi) {
            const int blk = wid * 2 + bi, d0 = 32 * (blk >> 2), e0 = 32 * (blk & 3);
#pragma unroll
            for (int g = 0; g < 4; ++g) *(uint2*)(ST + (e0 + l32) * SK + d0 + 8 * g + 4 * hi) = pk4(S[bi][4 * g], S[bi][4 * g + 1], S[bi][4 * g + 2], S[bi][4 * g + 3]);
        }
        if (c + 1 < nch) GSTAGE();
        __syncthreads();
    }
#undef GLOAD
#undef GSTAGE
#undef TOK
    if (ctx) {
#pragma unroll
        for (int bi = 0; bi < 2; ++bi) {
            const int blk = wid * 2 + bi, d0 = 32 * (blk >> 2), e0 = 32 * (blk & 3);
            float* so = p.out + O_SGDN + ((((size_t)b * DEPTH + l) * 2 + dir) * 4 + h) * 128 * 128 + e0 + l32;
#pragma unroll
            for (int r = 0; r < 16; ++r) so[(size_t)(d0 + crow(r, hi)) * 128] = S[bi][r];
        }
    }
}
}

namespace gla {
using att::bf16x8; using att::f32x16; using att::crow; using gdn::mm; using gdn::pk4;
constexpr int C = 32, SQ = 72, SS = 40;
constexpr int OFF_QE = 0, OFF_KN = OFF_QE + C * SQ * 2, OFF_KET = OFF_KN + C * SQ * 2, OFF_VT = OFF_KET + 64 * SS * 2, OFF_ATT = OFF_VT + 128 * SS * 2, OFF_ST = OFF_ATT + C * SS * 2,
              OFF_LA = OFF_ST + 128 * SQ * 2, OFF_EB = OFF_LA + C * 64 * 4, GLA_LDS = OFF_EB + 256;
__device__ __forceinline__ void gla_chunked(const Params& p, int l, bool ctx, int b, int h, int dir, unsigned char* lds) {
    const int tid = opaque_tid(), wid = tid >> 6, lane = tid & 63, l32 = lane & 31, hi = lane >> 5;
    const int T = ctx ? CT : ::LT; const size_t m0 = ctx ? (size_t)b * CT : (size_t)MC + (size_t)b * ::LT;
    const bf16_t* Z = WSP(bf16_t, WS_Z); const float* LA = WSP(float, dir ? WS_AB : WS_AF);
    float* O = WSP(float, dir ? WS_GOB : WS_GOF);
    bf16_t* Qe = (bf16_t*)(lds + OFF_QE); bf16_t* Kn = (bf16_t*)(lds + OFF_KN); bf16_t* KeT = (bf16_t*)(lds + OFF_KET); bf16_t* VT = (bf16_t*)(lds + OFF_VT);
    bf16_t* ATT = (bf16_t*)(lds + OFF_ATT); bf16_t* ST = (bf16_t*)(lds + OFF_ST); float* la = (float*)(lds + OFF_LA); float* eB = (float*)(lds + OFF_EB);
    const int nch = T / C;
#define TOK(c, s_) (m0 + (dir ? T - 1 - ((c) * C + (s_)) : (c) * C + (s_)))
    const int d0 = 32 * (wid >> 2), e0 = 32 * (wid & 3);
    f32x16 S;
    if (ctx) S = f32x16{};
    else {
        const float* s0 = p.in[I_SGLA] + ((((size_t)b * DEPTH + l) * 2 + dir) * 4 + h) * 64 * 128 + e0 + l32;
#pragma unroll
        for (int r = 0; r < 16; ++r) S[r] = s0[(size_t)(d0 + crow(r, hi)) * 128];
    }
    const int ts = tid >> 4, dc = (tid & 15) * 4, vs = tid >> 5, vc = (tid & 31) * 4;
    vf4 pq, pk, pl, pv0, pv1;
#define GLOAD(c) do { const size_t mt = TOK(c, ts), ma = TOK(c, vs), mb = TOK(c, vs + 16); \
        pq = ld4bf(Z + mt * NINP + Z_GLQ + h * 64 + dc); pk = ld4bf(Z + mt * NINP + Z_GLK + h * 64 + dc); pl = *(const vf4*)(LA + mt * 256 + h * 64 + dc); \
        pv0 = ld4bf(Z + ma * NINP + Z_GLV + h * 128 + vc); pv1 = ld4bf(Z + mb * NINP + Z_GLV + h * 128 + vc); } while (0)
#define WRITE_ST() do { _Pragma("unroll") for (int g = 0; g < 4; ++g) *(uint2*)(ST + (e0 + l32) * SQ + d0 + 8 * g + 4 * hi) = pk4(S[4 * g], S[4 * g + 1], S[4 * g + 2], S[4 * g + 3]); } while (0)
#define GIMAGES() do { vf4 pre = (vf4){0.f, 0.f, 0.f, 0.f}, tot = pre; \
        _Pragma("unroll 8") for (int t_ = 0; t_ < C; ++t_) { const vf4 v_ = *(const vf4*)(la + t_ * 64 + dc); tot += v_; if (t_ <= ts) pre += v_; } \
        float qe[4], kn[4]; \
        _Pragma("unroll") for (int j = 0; j < 4; ++j) { qe[j] = pq[j] * 0.125f * __expf(pre[j]); kn[j] = pk[j] * __expf(fminf(-pre[j], 80.f)); \
            KeT[(dc + j) * SS + ts] = f2bf(pk[j] * __expf(tot[j] - pre[j])); } \
        *(uint2*)(Qe + ts * SQ + dc) = pk4(qe[0], qe[1], qe[2], qe[3]); *(uint2*)(Kn + ts * SQ + dc) = pk4(kn[0], kn[1], kn[2], kn[3]); \
        if (ts == 0) { _Pragma("unroll") for (int j = 0; j < 4; ++j) eB[dc + j] = __expf(tot[j]); } \
        _Pragma("unroll") for (int j = 0; j < 4; ++j) { VT[(vc + j) * SS + vs] = f2bf(pv0[j]); VT[(vc + j) * SS + vs + 16] = f2bf(pv1[j]); } } while (0)
    __syncthreads();
    GLOAD(0);
    WRITE_ST();
    *(vf4*)(la + ts * 64 + dc) = pl;
    __syncthreads();
    GIMAGES();
    __syncthreads();
    for (int c = 0; c < nch; ++c) {
        if (c + 1 < nch) GLOAD(c + 1);
        f32x16 o1 = f32x16{};
        if (wid == 0) {
            const f32x16 kq = mm<64>(Kn, SQ, Qe, SQ, l32, hi, f32x16{});
            float a[16];
#pragma unroll
            for (int r = 0; r < 16; ++r) a[r] = (l32 >= crow(r, hi)) ? kq[r] : 0.f;
#pragma unroll
            for (int g = 0; g < 4; ++g) *(uint2*)(ATT + l32 * SS + 8 * g + 4 * hi) = pk4(a[4 * g], a[4 * g + 1], a[4 * g + 2], a[4 * g + 3]);
        } else if (wid >= 4) {
            o1 = mm<64>(Qe, SQ, ST + (32 * (wid - 4)) * SQ, SQ, l32, hi, f32x16{});
        }
        __syncthreads();
        if (wid >= 4) {
            const int eo = 32 * (wid - 4);
            o1 = mm<32>(ATT, SS, VT + eo * SS, SS, l32, hi, o1);
#pragma unroll
            for (int r = 0; r < 16; ++r) O[TOK(c, crow(r, hi)) * 512 + h * 128 + eo + l32] = o1[r];
        }
#pragma unroll
        for (int r = 0; r < 16; ++r) S[r] *= eB[d0 + crow(r, hi)];
        S = mm<32>(KeT + d0 * SS, SS, VT + e0 * SS, SS, l32, hi, S);
        __syncthreads();
        WRITE_ST();
        if (c + 1 < nch) *(vf4*)(la + ts * 64 + dc) = pl;
        __syncthreads();
        if (c + 1 < nch) GIMAGES();
        __syncthreads();
    }
#undef GLOAD
#undef WRITE_ST
#undef GIMAGES
#undef TOK
    if (ctx) {
        float* so = p.out + O_SGLA + ((((size_t)b * DEPTH + l) * 2 + dir) * 4 + h) * 64 * 128 + e0 + l32;
#pragma unroll
        for (int r = 0; r < 16; ++r) so[(size_t)(d0 + crow(r, hi)) * 128] = S[r];
    }
}
}
#define LAS __attribute__((address_space(3)))
constexpr int LDS_BYTES = 147456, XBW_OFF = LDS_BYTES - 64;
constexpr int NPH = 1 + DEPTH * 12;
#ifndef DBG_NLAYERS
#define DBG_NLAYERS DEPTH
#endif

#ifndef DUPKIND
#define DUPKIND 0
#endif
__device__ __forceinline__ int opaque_int(int v) { asm volatile("" : "+s"(v)); return v; }
#ifndef MIXMASK
#define MIXMASK 0xFF
#endif
#define FOR_ITEMS(it, n, o, w) for (int bo_ = (o) * (int)gridDim.x / 256, bw_ = ((w) * (int)gridDim.x / 256) > 0 ? ((w) * (int)gridDim.x / 256) : 1, \
                                    it = ((int)blockIdx.x >= bo_ && (int)blockIdx.x < bo_ + bw_) ? (int)blockIdx.x - bo_ : (n); it < (n); it += bw_)

#ifndef SPLITK
#define SPLITK 0
#endif
#ifndef SPLITK_G4
#define SPLITK_G4 0
#endif
constexpr int FLAG_WORD0 = 8192;
constexpr int QCTR_WORD0 = 1024;
constexpr int NI_GDNL = LB * 8, NI_GLAL = LB * 8, NI_GDNC = CB * 8, NI_GQAL = LB * 16, NI_NAL = LB * 16, NI_GLAC = CB * 8, NI_NAC = CB * 4, NI_GQAC = CB * 4;
#define KM(k) (1 + ((DUPKIND >> (k)) & 1))
constexpr int Q0 = NI_GDNL * KM(0), Q1 = Q0 + NI_GQAL * KM(1), Q2 = Q1 + NI_NAL * KM(2), Q3 = Q2 + NI_GLAL * KM(3), Q4 = Q3 + NI_GDNC * KM(4), Q5 = Q4 + NI_NAC * KM(5), Q6 = Q5 + NI_GQAC * KM(6), Q7 = Q6 + NI_GLAC * KM(7);
__device__ __forceinline__ void phase_mix(const Params& p, int l, unsigned char* lds, int rep) {
    const int tid = opaque_tid();
    float* smem = (float*)lds;
    const bf16_t* NAQ = WSP(bf16_t, WS_NAQ); const bf16_t* NAK = WSP(bf16_t, WS_NAK); const bf16_t* NAV = WSP(bf16_t, WS_NAV);
    const bf16_t* GQ = WSP(bf16_t, WS_GQ); const bf16_t* GK = WSP(bf16_t, WS_GK); const bf16_t* GV = WSP(bf16_t, WS_GV);
    bf16_t* MRG = WSP(bf16_t, WS_MRG);
    unsigned* qctr = WSP(unsigned, WS_CTL) + QCTR_WORD0 + 64 * l + 16 * rep;
    volatile int* qslot = (volatile int*)(lds + XBW_OFF + 16);
    for (;;) {
        __syncthreads();
        if (tid == 0) *qslot = (int)__hip_atomic_fetch_add(qctr, 1u, __ATOMIC_RELAXED, __HIP_MEMORY_SCOPE_AGENT);
        __syncthreads();
        const int q = __builtin_amdgcn_readfirstlane(*qslot);
        if (q >= Q7) break;
        if (q < Q0) { const int it = q % NI_GDNL; gdn::gdn_chunked(p, l, false, it / 8, (it / 2) % 4, it % 2, lds); }
        else if (q < Q1) {
            const int it = (q - Q0) % NI_GQAL, b = it / 16, qh = (it / 4) % 4, qb = it % 4, kvh = qh >> 1;
            const size_t r0 = (size_t)MC + (size_t)b * LT;
            att::SrcTwo src{WSP(bf16_t, WS_CGK) + ((size_t)b * DEPTH + l) * 256 * 256 + kvh * 128, WSP(bf16_t, WS_CGV) + ((size_t)b * DEPTH + l) * 256 * 256 + kvh * 128,
                            GK + r0 * 256 + kvh * 128, GV + r0 * 256 + kvh * 128, 256};
            att::attn_body<2>(GQ + (r0 + qb * 256) * 512 + qh * 128, src, MRG + (r0 + qb * 256) * DM + 1024 + qh * 128, 4 + LT / 64, (char*)lds, att::NoBias{});
        }
        else if (q < Q2) {
            const int it = (q - Q1) % NI_NAL, b = it / 16, h = (it / 4) % 4, qb = it % 4;
            const int kr0 = qb == 0 ? 0 : qb == 1 ? 0 : qb == 2 ? 4 : 8, nrows = (qb == 0 || qb == 3) ? 8 : 12;
            const size_t r0 = (size_t)MC + (size_t)b * LT;
            float* tab = (float*)(lds + att::SHM_ATTN);
            if (tid < 15 * 31) tab[tid] = p.in[I_RPB][((size_t)l * 4 + h) * 15 * 31 + tid] * (1.0f / att::SCALE);
            att::SrcTwo src{WSP(bf16_t, WS_CNAK) + ((size_t)b * DEPTH + l) * 256 * 512 + h * 128, WSP(bf16_t, WS_CNAV) + ((size_t)b * DEPTH + l) * 256 * 512 + h * 128,
                            NAK + (r0 + kr0 * 64) * 512 + h * 128, NAV + (r0 + kr0 * 64) * 512 + h * 128, 512};
            att::attn_body<1>(NAQ + (r0 + qb * 256) * 512 + h * 128, src, MRG + (r0 + qb * 256) * DM + 0 + h * 128, 4 + nrows, (char*)lds, att::NaBias{tab, qb * 256, kr0});
        }
        else if (q < Q3) { const int it = (q - Q2) % NI_GLAL; gla::gla_chunked(p, l, false, it / 8, (it / 2) % 4, it % 2, lds); }
        else if (q < Q4) { const int it = (q - Q3) % NI_GDNC; gdn::gdn_chunked(p, l, true, it / 8, (it / 2) % 4, it % 2, lds); }
        else if (q < Q5) {
            const int it = (q - Q4) % NI_NAC, b = it / 4, h = it % 4; const size_t r0 = (size_t)b * CT;
            att::SrcOne src{NAK + r0 * 512 + h * 128, NAV + r0 * 512 + h * 128, 512};
            att::attn_body<2>(NAQ + r0 * 512 + h * 128, src, MRG + r0 * DM + 0 + h * 128, CT / 64, (char*)lds, att::NoBias{});
        }
        else if (q < Q6) {
            const int it = (q - Q5) % NI_GQAC, b = it / 4, qh = it % 4, kvh = qh >> 1; const size_t r0 = (size_t)b * CT;
            att::SrcOne src{GK + r0 * 256 + kvh * 128, GV + r0 * 256 + kvh * 128, 256};
            att::attn_body<2>(GQ + r0 * 512 + qh * 128, src, MRG + r0 * DM + 1024 + qh * 128, CT / 64, (char*)lds, att::NoBias{});
        }
        else { const int it = (q - Q6) % NI_GLAC; gla::gla_chunked(p, l, true, it / 8, (it / 2) % 4, it % 2, lds); }
    }
}

#define CONV_FILL(nunits, t0, t1, skip) do { if (l + 1 < DBG_NLAYERS) { const int G_ = (int)gridDim.x; int f0_ = ((nunits) % G_) + (skip); if (f0_ >= G_) f0_ = 0; \
        if ((int)blockIdx.x >= f0_) { const Params q = opaque_params(p); conv_layer_tiles(q, l + 1, (t0), (t1), (int)blockIdx.x - f0_, G_ - f0_, (float*)lds); } } } while (0)
#define G1A_MSPLIT (G1A_MODE == 1 ? 2 : 0)
#define G1B_MSPLIT (G1B_MODE == 1 ? 2 : 0)
#ifndef MSPLIT
#define MSPLIT 2
#endif
constexpr int TF0 = NT_L / 10, TF1 = NT_L / 4, TF2 = NT_L * 11 / 20;
static_assert(att::SHM_ATTN + 15 * 31 * 4 + 2048 <= (size_t)XBW_OFF, "LDS map");
static_assert((QCTR_WORD0 + 64 * DEPTH) < 4096, "ctl");
constexpr int BAR_WORD0 = 4096;
static_assert((BAR_WORD0 + XCD_BAR_WORDS) * 4 <= (int)CTL_BYTES, "ctl");

__global__ void __launch_bounds__(512, 2) fwd(Params p) {
    extern __shared__ __attribute__((aligned(16))) unsigned char lds[];
    const int tid = threadIdx.x;
    volatile LAS unsigned* xbw = (volatile LAS unsigned*)((LAS unsigned char*)lds + XBW_OFF);
    if (tid < 4) xbw[tid] = 0u;
    __syncthreads();
    XcdBarrier bar; bar.bar = WSP(unsigned, WS_CTL) + BAR_WORD0; bar.x = 0; bar.st = xbw;
    if (p.ph_hi - p.ph_lo > 1) bar = xcd_barrier_post(WSP(unsigned, WS_CTL) + BAR_WORD0, xbw);
#ifndef PHMASK
#define PHMASK 0x1FFF
#endif
#define IN(k) (p.ph_lo <= (k) && (k) < p.ph_hi)
#define INL(j) (((PHMASK >> ((j) + 1)) & 1) && IN(pb + (j)))
#ifndef DUPMASK
#define DUPMASK 0
#endif
#define DUP(j) ((DUPMASK >> ((j) + 1)) & 1)
#if DUPMASK
#define REPS(j) opaque_int(1 + DUP(j))
#else
#define REPS(j) 1
#endif
#ifndef DBLBAR
#define DBLBAR 0
#endif
#define SEAM(k) do { if (IN(k) && IN((k) + 1)) { xcd_barrier(bar); if (DBLBAR) xcd_barrier(bar); } } while (0)
    LAS unsigned char* ldsl = (LAS unsigned char*)lds;
    bf16_t* H = WSP(bf16_t, WS_H); bf16_t* ACT = WSP(bf16_t, WS_ACT); float* X = WSP(float, WS_X); float* Z = WSP(float, WS_Z); bf16_t* MRG = WSP(bf16_t, WS_MRG);

    if ((PHMASK & 1) && IN(0)) { const int reps_ = (DUPMASK & 1) ? opaque_int(2) : 1; for (int rep_ = 0; rep_ < reps_; ++rep_) { const Params q = opaque_params(p); phase_prologue(q, (float*)lds); __syncthreads(); } }
    SEAM(0);
    for (int l = 0; l < DBG_NLAYERS; ++l) {
        const int pb = 1 + l * 12;
        const float* modl = WSP(float, WS_MODV) + (size_t)l * NCOND * NMOD;
        if (INL(0)) { const int reps_ = REPS(0); for (int rep_ = 0; rep_ < reps_; ++rep_) { const Params q = opaque_params(p); phase_norm(q, l, 0); __syncthreads(); } }
        SEAM(pb + 0);
        if (INL(1)) {
            if (g1_fp8(l, 0)) {
                pg8::Gemm g{H, (const bf16_t*)(WSP(unsigned char, WS_WGU) + ((size_t)l * 2 + 0) * NGU * DM * 2), M, NGU, DM / 2}; pg8::StaticOrder S; S.init(M, NGU, DM / 2, (int)gridDim.x, (int)blockIdx.x, 2);
                pg8::EpiSwiGLU8 E{WSP(unsigned char, WS_ACT), FFP, 1.0f / WGU_SCALE};
                pg8::gemm_phase<pg8::EpiSwiGLU8, pg8::StaticOrder, false, 1>(ldsl, g, S, E, nullptr);
            } else {
                pg8::Gemm g{H, WSP(bf16_t, WS_WGU) + ((size_t)l * 2 + 0) * NGU * DM, M, NGU, DM}; pg8::StaticOrder S; S.init(M, NGU, DM, (int)gridDim.x, (int)blockIdx.x, 0);
                pg8::EpiSwiGLU8 E{WSP(unsigned char, WS_ACT), FFP, 1.0f};
                pg8::gemm_phase<pg8::EpiSwiGLU8, pg8::StaticOrder, false, 0>(ldsl, g, S, E, nullptr);
            }
#if CONV_FILLER
            if (l + 1 < DBG_NLAYERS) {
                const int nw_ = (M / 256) * (NGU / 256), G_ = (int)gridDim.x; int f0_ = nw_ % G_; if (nw_ < G_) f0_ = 0;
                if (g1_fp8(l, 0)) f0_ = 2 * f0_ < G_ ? 2 * f0_ : f0_;
                const int nmb_ = (G_ - f0_ < NMOD / 128) ? (G_ - f0_) : NMOD / 128;
                if ((int)blockIdx.x >= f0_ && (int)blockIdx.x < f0_ + nmb_) { const Params q = opaque_params(p); mod_layer(q, l + 1, (int)blockIdx.x - f0_, nmb_, (float*)lds); }
            }
            CONV_FILL((M / 256) * (NGU / 256), 0, TF0, NMOD / 128 + (g1_fp8(l, 0) ? ((M / 256) * (NGU / 256)) % (int)gridDim.x : 0));
#endif
        }
        SEAM(pb + 1);
        if (INL(2)) {
            pg8::Gemm g{ACT, G2_FP8 ? (const bf16_t*)(WSP(unsigned char, WS_WDN) + ((size_t)l * 2 + 0) * DM * FFP) : WSP(bf16_t, WS_WDN) + ((size_t)l * 2 + 0) * DM * FF, M, DM, G2_FP8 ? FFP / 2 : FF}; pg8::StaticOrder S; S.init(M, DM, G2_FP8 ? FFP / 2 : FF, (int)gridDim.x, (int)blockIdx.x, SPLITK ? 1 : MSPLIT);
            pg8::EpiResid E{l == 0 ? p.in[I_XP] : X, X, DM, modl + 2 * DM, G2_FP8 ? 0.5f / WDN_SCALE : 0.5f, Z, WSP(unsigned, WS_CTL) + FLAG_WORD0, 8u * (unsigned)(l * (2 * SPLITK + SPLITK_G4) + SPLITK), l == 0 ? p.in[I_XS] : X, l == 0 ? MC : 0x7FFFFFFF};
            pg8::gemm_phase<pg8::EpiResid, pg8::StaticOrder, false, (G2_FP8 ? 1 : 0)>(ldsl, g, S, E, nullptr);
#if DUPMASK
            if (opaque_int(DUP(2))) { pg8::EpiResid E2{X, Z, DM, modl + 2 * DM, 0.5f, Z, WSP(unsigned, WS_CTL) + FLAG_WORD0, 0u, X, 0x7FFFFFFF}; pg8::gemm_phase<pg8::EpiResid, pg8::StaticOrder, false>(ldsl, g, S, E2, nullptr); }
#endif
        }
        SEAM(pb + 2);
        if (INL(3)) { const int reps_ = REPS(3); for (int rep_ = 0; rep_ < reps_; ++rep_) { const Params q = opaque_params(p); phase_norm(q, l, 1); __syncthreads(); } }
        SEAM(pb + 3);
        if (INL(4)) {
            pg8::Gemm g{H, WSP(bf16_t, WS_WIN) + (size_t)l * NINP * DM, M, NINP, DM}; pg8::StaticOrder S; S.init(M, NINP, DM, (int)gridDim.x, (int)blockIdx.x);
            pg8::EpiBf16Plain E{WSP(bf16_t, WS_Z), NINP};
            for (int r_ = 0, n_ = REPS(4); r_ < n_; ++r_) pg8::gemm_phase<pg8::EpiBf16Plain, pg8::StaticOrder, false>(ldsl, g, S, E, nullptr);
#if CONV_FILLER
            CONV_FILL((M / 256) * (NINP / 256), TF0, TF1, 0);
#endif
        }
        SEAM(pb + 4);
        if (INL(5)) { const int reps_ = REPS(5); for (int rep_ = 0; rep_ < reps_; ++rep_) { const Params q = opaque_params(p); phase_prep(q, l); __syncthreads(); } }
        SEAM(pb + 5);
        if (INL(6)) { const int reps_ = REPS(6); for (int rep_ = 0; rep_ < reps_; ++rep_) { const Params q = opaque_params(p); phase_mix(q, l, lds, rep_); __syncthreads(); } }
        SEAM(pb + 6);
        if (INL(7)) { const int reps_ = REPS(7); for (int rep_ = 0; rep_ < reps_; ++rep_) { const Params q = opaque_params(p); phase_post(q, l); __syncthreads(); } }
        SEAM(pb + 7);
        if (INL(8)) {
            pg8::Gemm g{MRG, WSP(bf16_t, WS_WOUT) + (size_t)l * DM * DM, M, DM, DM}; pg8::StaticOrder S; S.init(M, DM, DM, (int)gridDim.x, (int)blockIdx.x, SPLITK_G4);
            pg8::EpiResid E{X, X, DM, modl + 5 * DM, 1.0f, Z, WSP(unsigned, WS_CTL) + FLAG_WORD0, 8u * (unsigned)(l * (2 * SPLITK + SPLITK_G4) + SPLITK + SPLITK_G4), X, 0x7FFFFFFF};
            pg8::gemm_phase<pg8::EpiResid, pg8::StaticOrder, false>(ldsl, g, S, E, nullptr);
#if CONV_FILLER
            CONV_FILL((M / 256) * (DM / 256), TF1, TF2, 0);
#endif
#if DUPMASK
            if (opaque_int(DUP(8))) { pg8::EpiResid E2{X, Z, DM, modl + 5 * DM, 1.0f, Z, WSP(unsigned, WS_CTL) + FLAG_WORD0, 0u, X, 0x7FFFFFFF}; pg8::gemm_phase<pg8::EpiResid, pg8::StaticOrder, false>(ldsl, g, S, E2, nullptr); }
#endif
        }
        SEAM(pb + 8);
        if (INL(9)) { const int reps_ = REPS(9); for (int rep_ = 0; rep_ < reps_; ++rep_) { const Params q = opaque_params(p); phase_norm(q, l, 2); __syncthreads(); } }
        SEAM(pb + 9);
        if (INL(10)) {
            {
#if G1B_MODE
                pg8::Gemm g{H, (const bf16_t*)(WSP(unsigned char, WS_WGU) + ((size_t)l * 2 + 1) * NGU * DM * 2), M, NGU, DM / 2}; pg8::StaticOrder S; S.init(M, NGU, DM / 2, (int)gridDim.x, (int)blockIdx.x, G1B_MSPLIT);
                constexpr float ws_ = 1.0f / WGU_SCALE;
#else
                pg8::Gemm g{H, WSP(bf16_t, WS_WGU) + ((size_t)l * 2 + 1) * NGU * DM, M, NGU, DM}; pg8::StaticOrder S; S.init(M, NGU, DM, (int)gridDim.x, (int)blockIdx.x, G1B_MSPLIT);
                constexpr float ws_ = 1.0f;
#endif
#if G2_FP8
                pg8::EpiSwiGLU8 E{WSP(unsigned char, WS_ACT), FFP, ws_};
                pg8::gemm_phase<pg8::EpiSwiGLU8, pg8::StaticOrder, false, G1B_MODE>(ldsl, g, S, E, nullptr);
#else
                pg8::EpiSwiGLU E{ACT, FF};
                pg8::gemm_phase<pg8::EpiSwiGLU, pg8::StaticOrder, false, G1B_MODE>(ldsl, g, S, E, nullptr);
#endif
            }
#if CONV_FILLER
            CONV_FILL((M / 256) * (NGU / 256), TF2, NT_L, (G1B_MSPLIT ? ((M / 256) * (NGU / 256)) % (int)gridDim.x : 0));
#endif
        }
        SEAM(pb + 10);
        if (INL(11)) {
            pg8::Gemm g{ACT, G2_FP8 ? (const bf16_t*)(WSP(unsigned char, WS_WDN) + ((size_t)l * 2 + 1) * DM * FFP) : WSP(bf16_t, WS_WDN) + ((size_t)l * 2 + 1) * DM * FF, M, DM, G2_FP8 ? FFP / 2 : FF}; pg8::StaticOrder S; S.init(M, DM, G2_FP8 ? FFP / 2 : FF, (int)gridDim.x, (int)blockIdx.x, SPLITK ? 1 : MSPLIT);
            pg8::EpiResid E{X, (l == DEPTH - 1) ? p.out : X, DM, modl + 8 * DM, G2_FP8 ? 0.5f / WDN_SCALE : 0.5f, Z, WSP(unsigned, WS_CTL) + FLAG_WORD0, 8u * (unsigned)(l * (2 * SPLITK + SPLITK_G4) + 2 * SPLITK + SPLITK_G4), X, 0x7FFFFFFF};
            pg8::gemm_phase<pg8::EpiResid, pg8::StaticOrder, false, (G2_FP8 ? 1 : 0)>(ldsl, g, S, E, nullptr);
        }
        SEAM(pb + 11);
    }
#undef IN
#undef SEAM
}

#ifndef MULTI_LAUNCH
#define MULTI_LAUNCH 0
#endif
extern "C" void kernel_launch(void* const* d_in, const int* in_sizes, int n_in, void* d_out, int out_size, void* d_ws, size_t ws_size, hipStream_t stream) {
    static int grid = 0;
    if (grid == 0) {
        if (n_in != N_IN || (size_t)out_size != O_END || ws_size < WS_END) { fprintf(stderr, "kernel_launch: shape mismatch n_in %d out %d ws %zu (need %zu)\n", n_in, out_size, ws_size, (size_t)WS_END); grid = -1; return; }
        int dev = 0, cus = 0, per_cu = 0;
        if (hipGetDevice(&dev) != hipSuccess || hipDeviceGetAttribute(&cus, hipDeviceAttributeMultiprocessorCount, dev) != hipSuccess) { grid = -1; return; }
        if (hipFuncSetAttribute((const void*)fwd, hipFuncAttributeMaxDynamicSharedMemorySize, LDS_BYTES) != hipSuccess) { fprintf(stderr, "kernel_launch: hipFuncSetAttribute failed\n"); grid = -1; return; }
        if (hipOccupancyMaxActiveBlocksPerMultiprocessor(&per_cu, (const void*)fwd, 512, LDS_BYTES) != hipSuccess || per_cu < 1) { fprintf(stderr, "kernel_launch: occupancy query says %d\n", per_cu); (void)hipGetLastError(); }
        grid = cus;
    }
    if (grid < 0) return;
    (void)hipMemsetAsync((char*)d_ws + WS_CTL, 0, CTL_BYTES, stream);
    Params p{};
    for (int i = 0; i < N_IN; ++i) p.in[i] = (const float*)d_in[i];
    p.out = (float*)d_out; p.ws = (unsigned char*)d_ws;
#if MULTI_LAUNCH
    for (int ph = 0; ph < 1 + DBG_NLAYERS * 12; ++ph) { p.ph_lo = ph; p.ph_hi = ph + 1; hipLaunchKernelGGL(fwd, dim3(grid), dim3(512), LDS_BYTES, stream, p); }
#else
    p.ph_lo = 0; p.ph_hi = NPH; hipLaunchKernelGGL(fwd, dim3(grid), dim3(512), LDS_BYTES, stream, p);
#endif
    const hipError_t le = hipPeekAtLastError();
    if (le != hipSuccess) fprintf(stderr, "kernel_launch: launch failed: %s\n", hipGetErrorName(le));
}
```

```cpp
#include <hip/hip_runtime.h>
#include <cstdio>
#include <cstdint>

#ifndef CB_
#define CB_ 16
#endif
#ifndef LB_
#define LB_ 8
#endif
#ifndef DEPTH_
#define DEPTH_ 4
#endif
#ifndef G1A_LAYERS
#define G1A_LAYERS 0xC
#endif
#ifndef G1A_MODE
#define G1A_MODE 0
#endif
#ifndef G1B_MODE
#define G1B_MODE 1
#endif
#ifndef G2_FP8
#define G2_FP8 1
#endif
#ifndef FFN_FP8
#define FFN_FP8 (G1A_MODE != 0 || G1B_MODE != 0 || G2_FP8 != 0)
#endif
constexpr int DM = 2048, DEPTH = DEPTH_, CB = CB_, CT = 256, LB = LB_, LT = 1024;
constexpr int MC = CB * CT, ML = LB * LT, M = MC + ML;
constexpr int FF = 5504, NGU = 2 * FF, NIN = 6192, NINP = 6400, NMOD = 9 * DM, NCOND = 1 + LB;
constexpr float EPS = 1e-6f;
constexpr int FFP = 5632;
constexpr float WGU_SCALE = 32.0f, WDN_SCALE = 64.0f;
constexpr int Z_NAQ = 0, Z_NAK = 512, Z_NAV = 1024, Z_GLQ = 1536, Z_GLK = 1792, Z_GLV = 2048, Z_GLR = 2560, Z_GF = 3072, Z_GB = 3088,
              Z_GQQ = 3104, Z_GQK = 3616, Z_GQV = 3872, Z_DQKV = 4128, Z_DZ = 5664, Z_DB = 6176, Z_DA = 6184;
static_assert(Z_DA + 8 == NIN, "split");
enum { I_XP = 0, I_XS, I_CNAK, I_CNAV, I_CGK, I_CGV, I_SGLA, I_SGDN, I_C, I_CCTX, I_NORMG, I_WMOD, I_BMOD, I_GU, I_DOWN, I_WIN, I_WOUT, I_NAQKN, I_RPB,
       I_GUP, I_GBIAS, I_GLAON, I_GQAQKN, I_CONV, I_ALOG, I_DTB, I_GDNON, N_IN };
constexpr size_t O_YP = 0, O_YS = O_YP + (size_t)MC * DM, O_NAK = O_YS + (size_t)ML * DM, O_NAV = O_NAK + (size_t)CB * DEPTH * 4 * CT * 128,
                 O_GK = O_NAV + (size_t)CB * DEPTH * 4 * CT * 128, O_GV = O_GK + (size_t)CB * DEPTH * 2 * CT * 128,
                 O_SGLA = O_GV + (size_t)CB * DEPTH * 2 * CT * 128, O_SGDN = O_SGLA + (size_t)CB * DEPTH * 2 * 4 * 64 * 128,
                 O_END = O_SGDN + (size_t)CB * DEPTH * 2 * 4 * 128 * 128;
constexpr size_t al256(size_t x) { return (x + 255) & ~(size_t)255; }
constexpr size_t WS_CTL = 0, CTL_BYTES = 1u << 20;
constexpr size_t WS_WGU = CTL_BYTES;
constexpr size_t WS_WDN = WS_WGU + (size_t)DEPTH * 2 * NGU * DM * 2;
constexpr size_t WS_WIN = WS_WDN + (size_t)DEPTH * 2 * DM * FF * 2;
constexpr size_t WS_WOUT = WS_WIN + (size_t)DEPTH * NINP * DM * 2;
constexpr size_t WS_MODV = WS_WOUT + (size_t)DEPTH * DM * DM * 2;
constexpr size_t WS_ROPE = al256(WS_MODV + (size_t)DEPTH * NCOND * NMOD * 4);
constexpr size_t WS_X = al256(WS_ROPE + 2 * 64 * 32 * 4);
constexpr size_t WS_H = WS_X + (size_t)M * DM * 4;
constexpr size_t WS_ACT = WS_H + (size_t)M * DM * 2;
constexpr size_t WS_Z = WS_ACT + (size_t)M * FF * 2;
constexpr size_t WS_MRG = WS_Z + (size_t)M * NINP * 4;
constexpr size_t WS_NAQ = WS_MRG + (size_t)M * DM * 2;
constexpr size_t WS_NAK = WS_NAQ + (size_t)M * 512 * 2;
constexpr size_t WS_NAV = WS_NAK + (size_t)M * 512 * 2;
constexpr size_t WS_GQ = WS_NAV + (size_t)M * 512 * 2;
constexpr size_t WS_GK = WS_GQ + (size_t)M * 512 * 2;
constexpr size_t WS_GV = WS_GK + (size_t)M * 256 * 2;
constexpr size_t WS_CNAK = WS_GV + (size_t)M * 256 * 2;
constexpr size_t WS_CNAV = WS_CNAK + (size_t)LB * DEPTH * 256 * 512 * 2;
constexpr size_t WS_CGK = WS_CNAV + (size_t)LB * DEPTH * 256 * 512 * 2;
constexpr size_t WS_CGV = WS_CGK + (size_t)LB * DEPTH * 256 * 256 * 2;
constexpr size_t WS_AF = WS_CGV + (size_t)LB * DEPTH * 256 * 256 * 2;
constexpr size_t WS_AB = WS_AF + (size_t)M * 256 * 4;
constexpr size_t WS_DQ = WS_AB + (size_t)M * 256 * 4;
constexpr size_t WS_DK = WS_DQ + (size_t)M * 512 * 4;
constexpr size_t WS_DV = WS_DK + (size_t)M * 512 * 4;
constexpr size_t WS_DBA = WS_DV + (size_t)M * 512 * 4;
constexpr size_t WS_GOF = WS_DBA + (size_t)M * 16 * 4;
constexpr size_t WS_GOB = WS_GOF + (size_t)M * 512 * 4;
constexpr size_t WS_DOF = WS_GOB + (size_t)M * 512 * 4;
constexpr size_t WS_DOB = WS_DOF + (size_t)M * 512 * 4;
constexpr size_t WS_END = WS_DOB + (size_t)M * 512 * 4;

typedef unsigned short bf16_t;
struct Params { const float* in[N_IN]; float* out; unsigned char* ws; int ph_lo, ph_hi; };
static_assert(sizeof(Params) == N_IN * 8 + 8 + 8 + 8, "no padding");

#define WSP(T, off) ((T*)(p.ws + (off)))
__device__ __forceinline__ int opaque_tid() { int t = (int)threadIdx.x; asm volatile("" : "+v"(t)); return t; }
__device__ __forceinline__ Params opaque_params(const Params& p) { Params q = p; unsigned long long w = (unsigned long long)q.ws; asm volatile("" : "+s"(w)); q.ws = (unsigned char*)w; return q; }

typedef float vf4 __attribute__((ext_vector_type(4)));
__device__ __forceinline__ unsigned pack4_fp8(float a, float b, float c, float d) { int w = 0; w = __builtin_amdgcn_cvt_pk_fp8_f32(a, b, w, false); w = __builtin_amdgcn_cvt_pk_fp8_f32(c, d, w, true); return (unsigned)w; }
__device__ __forceinline__ float bf2f(unsigned short v) { return __uint_as_float((unsigned)v << 16); }
__device__ __forceinline__ vf4 ld4bf(const unsigned short* p) { const uint2 w = *(const uint2*)p; vf4 r; r.x = __uint_as_float(w.x << 16); r.y = __uint_as_float(w.x & 0xFFFF0000u); r.z = __uint_as_float(w.y << 16); r.w = __uint_as_float(w.y & 0xFFFF0000u); return r; }
__device__ __forceinline__ vf4 unp4bf(uint2 w) { vf4 r; r.x = __uint_as_float(w.x << 16); r.y = __uint_as_float(w.x & 0xFFFF0000u); r.z = __uint_as_float(w.y << 16); r.w = __uint_as_float(w.y & 0xFFFF0000u); return r; }
__device__ __forceinline__ void unp8bf(uint4 w, vf4& a, vf4& b) {
    a.x = __uint_as_float(w.x << 16); a.y = __uint_as_float(w.x & 0xFFFF0000u); a.z = __uint_as_float(w.y << 16); a.w = __uint_as_float(w.y & 0xFFFF0000u);
    b.x = __uint_as_float(w.z << 16); b.y = __uint_as_float(w.z & 0xFFFF0000u); b.z = __uint_as_float(w.w << 16); b.w = __uint_as_float(w.w & 0xFFFF0000u); }
__device__ __forceinline__ void ld8bf(const unsigned short* p, vf4& a, vf4& b) { const uint4 w = *(const uint4*)p;
    a.x = __uint_as_float(w.x << 16); a.y = __uint_as_float(w.x & 0xFFFF0000u); a.z = __uint_as_float(w.y << 16); a.w = __uint_as_float(w.y & 0xFFFF0000u);
    b.x = __uint_as_float(w.z << 16); b.y = __uint_as_float(w.z & 0xFFFF0000u); b.z = __uint_as_float(w.w << 16); b.w = __uint_as_float(w.w & 0xFFFF0000u); }
__device__ __forceinline__ float wave_sum(float v) {
#pragma unroll
    for (int o = 32; o >= 1; o >>= 1) v += __shfl_xor(v, o);
    return v;
}
__device__ __forceinline__ bf16_t f2bf(float f) { unsigned u = __float_as_uint(f); u += 0x7FFFu + ((u >> 16) & 1u); return (bf16_t)(u >> 16); }
__device__ __forceinline__ unsigned pack2(float a, float b) { return (unsigned)f2bf(a) | ((unsigned)f2bf(b) << 16); }
__device__ __forceinline__ float silu_f(float x) { return x / (1.f + expf(-x)); }
__device__ __forceinline__ float softplus_f(float x) { return fmaxf(x, 0.f) + log1pf(expf(-fabsf(x))); }
__device__ __forceinline__ float logsigmoid_f(float x) { return fminf(x, 0.f) - log1pf(expf(-fabsf(x))); }
__device__ __forceinline__ bool g1_fp8(int l, int f) { return f ? (G1B_MODE != 0) : (G1A_MODE != 0 || ((G1A_LAYERS >> l) & 1)); }
__device__ __forceinline__ int cond_of_row(int m) { return m < MC ? 0 : 1 + (m - MC) / LT; }
#ifndef CONV_FILLER
#define CONV_FILLER 1
#endif
__device__ __forceinline__ void conv_tile(const float* __restrict__ src, int ld_src, int ncols_src, int k0, int c0, bf16_t* __restrict__ dst, int ld_dst, int n0, float* tile) {
    const int tid = opaque_tid();
    {
        const int r = tid >> 3, c = (tid & 7) * 8;
        float4 a = make_float4(0.f, 0.f, 0.f, 0.f), b = a;
        if (c0 + c + 8 <= ncols_src) {
            const float* s = src + (size_t)(k0 + r) * ld_src + c0 + c;
            a = *(const float4*)s; b = *(const float4*)(s + 4);
        }
        float* t = tile + r * 65 + c;
        t[0] = a.x; t[1] = a.y; t[2] = a.z; t[3] = a.w; t[4] = b.x; t[5] = b.y; t[6] = b.z; t[7] = b.w;
    }
    __syncthreads();
    {
        const int n = tid >> 3, ks = (tid & 7) * 8;
        const float* t = tile + ks * 65 + n;
        uint4 w;
        w.x = pack2(t[0 * 65], t[1 * 65]); w.y = pack2(t[2 * 65], t[3 * 65]); w.z = pack2(t[4 * 65], t[5 * 65]); w.w = pack2(t[6 * 65], t[7 * 65]);
        *(uint4*)(dst + (size_t)(n0 + n) * ld_dst + k0 + ks) = w;
    }
    __syncthreads();
}

__device__ __forceinline__ void conv_tile8(const float* __restrict__ src, int ld_src, int nrows_src, int k0, int c0, unsigned char* __restrict__ dst, int ld_dst, int n0, float scale, float* tile) {
    const int tid = opaque_tid();
    {
        const int r = tid >> 3, c = (tid & 7) * 8;
        float4 a = make_float4(0.f, 0.f, 0.f, 0.f), b = a;
        if (k0 + r < nrows_src) { const float* s = src + (size_t)(k0 + r) * ld_src + c0 + c; a = *(const float4*)s; b = *(const float4*)(s + 4); }
        float* t = tile + r * 65 + c;
        t[0] = a.x * scale; t[1] = a.y * scale; t[2] = a.z * scale; t[3] = a.w * scale; t[4] = b.x * scale; t[5] = b.y * scale; t[6] = b.z * scale; t[7] = b.w * scale;
    }
    __syncthreads();
    {
        const int n = tid >> 3, ks = (tid & 7) * 8;
        const float* t = tile + ks * 65 + n;
        uint2 w; w.x = pack4_fp8(t[0 * 65], t[1 * 65], t[2 * 65], t[3 * 65]); w.y = pack4_fp8(t[4 * 65], t[5 * 65], t[6 * 65], t[7 * 65]);
        *(uint2*)(dst + (size_t)(n0 + n) * ld_dst + k0 + ks) = w;
    }
    __syncthreads();
}
constexpr int MOD_ITEMS = DEPTH * (NMOD / 128);
constexpr int TGU_KT = DM / 64, TGU_NT = NGU / 64, TDN_KT = (G2_FP8 ? FFP : FF) / 64, TDN_NT = DM / 64, TIN_KT = DM / 64, TIN_NT = NINP / 64, TOUT_KT = DM / 64, TOUT_NT = DM / 64;
constexpr int TL_GU = 2 * TGU_KT * TGU_NT, TL_DN = 2 * TDN_KT * TDN_NT, TL_IN = TIN_KT * TIN_NT, TL_OUT = TOUT_KT * TOUT_NT, NT_L = TL_GU + TL_DN + TL_IN + TL_OUT;
__device__ __forceinline__ void conv_layer_tiles(const Params& p, int l, int t_begin, int t_end, int first, int stride, float* s_tile) {
    for (int it = t_begin + first; it < t_end; it += stride) {
        if (it < TL_GU) {
            const int mat = l * 2 + it / (TGU_KT * TGU_NT), r = it % (TGU_KT * TGU_NT), kt = r / TGU_NT, nt = r % TGU_NT;
            const int n0 = nt * 64, t256 = n0 / 256, c = n0 % 256;
            const int c0 = c < 128 ? 128 * t256 + c : FF + 128 * t256 + (c - 128);
            if (g1_fp8(mat >> 1, mat & 1))
                conv_tile8(p.in[I_GU] + (size_t)mat * DM * NGU, NGU, DM, kt * 64, c0, WSP(unsigned char, WS_WGU) + (size_t)mat * NGU * DM * 2, DM, n0, WGU_SCALE, s_tile);
            else
                conv_tile(p.in[I_GU] + (size_t)mat * DM * NGU, NGU, NGU, kt * 64, c0, WSP(bf16_t, WS_WGU) + (size_t)mat * NGU * DM, DM, n0, s_tile);
        } else if (it < TL_GU + TL_DN) {
            const int i2 = it - TL_GU, mat = l * 2 + i2 / (TDN_KT * TDN_NT), r = i2 % (TDN_KT * TDN_NT), kt = r / TDN_NT, nt = r % TDN_NT;
#if G2_FP8
            conv_tile8(p.in[I_DOWN] + (size_t)mat * FF * DM, DM, FF, kt * 64, nt * 64, WSP(unsigned char, WS_WDN) + (size_t)mat * DM * FFP, FFP, nt * 64, WDN_SCALE, s_tile);
#else
            conv_tile(p.in[I_DOWN] + (size_t)mat * FF * DM, DM, DM, kt * 64, nt * 64, WSP(bf16_t, WS_WDN) + (size_t)mat * DM * FF, FF, nt * 64, s_tile);
#endif
        } else if (it < TL_GU + TL_DN + TL_IN) {
            const int i2 = it - TL_GU - TL_DN, kt = i2 / TIN_NT, nt = i2 % TIN_NT;
            conv_tile(p.in[I_WIN] + (size_t)l * DM * NIN, NIN, NIN, kt * 64, nt * 64, WSP(bf16_t, WS_WIN) + (size_t)l * NINP * DM, DM, nt * 64, s_tile);
        } else {
            const int i2 = it - TL_GU - TL_DN - TL_IN, kt = i2 / TOUT_NT, nt = i2 % TOUT_NT;
            conv_tile(p.in[I_WOUT] + (size_t)l * DM * DM, DM, DM, kt * 64, nt * 64, WSP(bf16_t, WS_WOUT) + (size_t)l * DM * DM, DM, nt * 64, s_tile);
        }
    }
}

__device__ __forceinline__ void mod_layer(const Params& p, int l, int first, int stride, float* smem) {
    const int tid = opaque_tid();
    float* s_cond = smem;
    float* s_red = s_cond + NCOND * DM;
    __syncthreads();
    for (int i = tid; i < NCOND * DM; i += 512) { const int ci = i / DM, k = i % DM; const float v = ci == 0 ? p.in[I_CCTX][k] : p.in[I_C][(size_t)(ci - 1) * DM + k]; s_cond[i] = silu_f(v); }
    __syncthreads();
    float* modv = WSP(float, WS_MODV);
    for (int jt = first; jt < NMOD / 128; jt += stride) {
        const int cl = tid & 127, kq = tid >> 7, col = jt * 128 + cl;
        const float* w = p.in[I_WMOD] + (size_t)l * DM * NMOD + col;
        float acc[NCOND];
#pragma unroll
        for (int ci = 0; ci < NCOND; ++ci) acc[ci] = 0.f;
        for (int k = kq * 512; k < kq * 512 + 512; k += 8) {
            float wv[8];
#pragma unroll
            for (int j = 0; j < 8; ++j) wv[j] = w[(size_t)(k + j) * NMOD];
#pragma unroll
            for (int ci = 0; ci < NCOND; ++ci) {
                const float4 s0 = *(const float4*)&s_cond[ci * DM + k], s1 = *(const float4*)&s_cond[ci * DM + k + 4];
                acc[ci] += s0.x * wv[0] + s0.y * wv[1] + s0.z * wv[2] + s0.w * wv[3] + s1.x * wv[4] + s1.y * wv[5] + s1.z * wv[6] + s1.w * wv[7];
            }
        }
        if (kq > 0) {
#pragma unroll
            for (int ci = 0; ci < NCOND; ++ci) s_red[((kq - 1) * 128 + cl) * NCOND + ci] = acc[ci];
        }
        __syncthreads();
        if (kq == 0) {
            const float bm = p.in[I_BMOD][(size_t)l * NMOD + col];
#pragma unroll
            for (int ci = 0; ci < NCOND; ++ci)
                modv[((size_t)l * NCOND + ci) * NMOD + col] = acc[ci] + s_red[(0 * 128 + cl) * NCOND + ci] + s_red[(1 * 128 + cl) * NCOND + ci] + s_red[(2 * 128 + cl) * NCOND + ci] + bm;
        }
        __syncthreads();
    }
}

__device__ __forceinline__ void phase_prologue(const Params& p, float* smem) {
    const int tid = threadIdx.x, nb = gridDim.x, bid = blockIdx.x;
    float* s_tile = smem + NCOND * DM + 3 * 128 * NCOND;
#if CONV_FILLER
    mod_layer(p, 0, bid, nb, smem);
#else
    for (int l2 = 0; l2 < DEPTH; ++l2) mod_layer(p, l2, bid, nb, smem);
#endif
    conv_layer_tiles(p, 0, 0, NT_L, bid, nb, s_tile);
#if !CONV_FILLER
    for (int l2 = 1; l2 < DEPTH; ++l2) conv_layer_tiles(p, l2, 0, NT_L, bid, nb, s_tile);
#endif
    const size_t gtid = (size_t)bid * 512 + tid, gstride = (size_t)nb * 512;
    {
        const size_t n_na = (size_t)LB * DEPTH * 256 * 512 / 8;
        for (size_t i = gtid; i < 2 * n_na; i += gstride) {
            const bool isv = i >= n_na; const size_t j = isv ? i - n_na : i;
            const int d8 = (int)(j % 16), h = (int)((j / 16) % 4), t = (int)((j / 64) % 256); const size_t bl = j / (64 * 256);
            const float* s = p.in[isv ? I_CNAV : I_CNAK] + ((bl * 4 + h) * 256 + t) * 128 + d8 * 8;
            const float4 a = *(const float4*)s, b = *(const float4*)(s + 4);
            uint4 w; w.x = pack2(a.x, a.y); w.y = pack2(a.z, a.w); w.z = pack2(b.x, b.y); w.w = pack2(b.z, b.w);
            *(uint4*)(WSP(bf16_t, isv ? WS_CNAV : WS_CNAK) + (bl * 256 + t) * 512 + h * 128 + d8 * 8) = w;
        }
        const size_t n_g = (size_t)LB * DEPTH * 256 * 256 / 8;
        for (size_t i = gtid; i < 2 * n_g; i += gstride) {
            const bool isv = i >= n_g; const size_t j = isv ? i - n_g : i;
            const int d8 = (int)(j % 16), h = (int)((j / 16) % 2), t = (int)((j / 32) % 256); const size_t bl = j / (32 * 256);
            const float* s = p.in[isv ? I_CGV : I_CGK] + ((bl * 2 + h) * 256 + t) * 128 + d8 * 8;
            const float4 a = *(const float4*)s, b = *(const float4*)(s + 4);
            uint4 w; w.x = pack2(a.x, a.y); w.y = pack2(a.z, a.w); w.z = pack2(b.x, b.y); w.w = pack2(b.z, b.w);
            *(uint4*)(WSP(bf16_t, isv ? WS_CGV : WS_CGK) + (bl * 256 + t) * 256 + h * 128 + d8 * 8) = w;
        }
    }
    for (size_t i = gtid; i < 64 * 32; i += gstride) {
        const int pos = (int)(i / 32), k = (int)(i % 32);
        const float inv = powf(10000.0f, -(float)(2 * k) / 64.0f);
        const float ang = (float)pos * inv;
        WSP(float, WS_ROPE)[i] = cosf(ang); WSP(float, WS_ROPE)[64 * 32 + i] = sinf(ang);
    }
}

__device__ __forceinline__ void phase_norm(const Params& p, int l, int which  ) {
    const int tid = opaque_tid(), lane = tid & 63, wv = tid >> 6;
    const float* X = WSP(float, WS_X); bf16_t* H = WSP(bf16_t, WS_H);
    const bool from_in = (l == 0 && which == 0);
    const float* g = p.in[I_NORMG] + ((size_t)l * 3 + which) * DM;
    const int nw = (int)gridDim.x * 8;
    for (int m0 = blockIdx.x * 8 + wv; m0 < M; m0 += 2 * nw) {
        const int m1 = m0 + nw; const bool has1 = m1 < M;
        const int mm[2] = {m0, has1 ? m1 : m0};
        vf4 v[2][8]; float ss[2] = {0.f, 0.f};
#pragma unroll
        for (int k = 0; k < 2; ++k) {
            const int m = mm[k];
            const float* x = from_in ? (m < MC ? p.in[I_XP] + (size_t)m * DM : p.in[I_XS] + (size_t)(m - MC) * DM) : X + (size_t)m * DM;
#pragma unroll
            for (int i = 0; i < 8; ++i) v[k][i] = *(const vf4*)(x + (i * 64 + lane) * 4);
        }
#pragma unroll
        for (int k = 0; k < 2; ++k) {
#pragma unroll
            for (int i = 0; i < 8; ++i) ss[k] += v[k][i].x * v[k][i].x + v[k][i].y * v[k][i].y + v[k][i].z * v[k][i].z + v[k][i].w * v[k][i].w;
            ss[k] = wave_sum(ss[k]);
        }
#pragma unroll
        for (int k = 0; k < 2; ++k) {
            if (k == 1 && !has1) break;
            const int m = mm[k];
            const float* mv = WSP(float, WS_MODV) + ((size_t)l * NCOND + cond_of_row(m)) * NMOD + (size_t)which * 3 * DM;
            const float r = 1.0f / sqrtf(ss[k] * (1.0f / DM) + EPS);
#pragma unroll
            for (int i = 0; i < 8; ++i) {
                const int c = (i * 64 + lane) * 4;
                const float4 gg = *(const float4*)(g + c), sh = *(const float4*)(mv + c), sc = *(const float4*)(mv + DM + c);
                const float o0 = v[k][i].x * r * gg.x * (1.f + sc.x) + sh.x, o1 = v[k][i].y * r * gg.y * (1.f + sc.y) + sh.y;
                const float o2 = v[k][i].z * r * gg.z * (1.f + sc.z) + sh.z, o3 = v[k][i].w * r * gg.w * (1.f + sc.w) + sh.w;
                if (which != 1 && g1_fp8(l, which >> 1)) *(unsigned*)((unsigned char*)H + (size_t)m * DM + c) = pack4_fp8(o0, o1, o2, o3);
                else { uint2 w; w.x = pack2(o0, o1); w.y = pack2(o2, o3); *(uint2*)(H + (size_t)m * DM + c) = w; }
            }
            if (G2_FP8 && which != 1 && lane < (FFP - FF) / 4) *(unsigned*)(WSP(unsigned char, WS_ACT) + (size_t)m * FFP + FF + 4 * lane) = 0u;
        }
    }
}

__device__ __forceinline__ float red16(float v);
__device__ __forceinline__ float ssq8(vf4 a, vf4 b) { const vf4 s = a * a + b * b; return (s.x + s.y) + (s.z + s.w); }
__device__ __forceinline__ uint4 pack8(vf4 a, vf4 b) { uint4 w; w.x = pack2(a.x, a.y); w.y = pack2(a.z, a.w); w.z = pack2(b.x, b.y); w.w = pack2(b.z, b.w); return w; }
__device__ __forceinline__ void phase_prep(const Params& p, int l) {
    const int tid = opaque_tid(), lane = tid & 63, wv = tid >> 6, rg = lane >> 4, sub = lane & 15, c8 = sub * 8;
    const bf16_t* Z = WSP(bf16_t, WS_Z);
    const float* ropec = WSP(float, WS_ROPE); const float* ropes = ropec + 64 * 32;
    const float* wnq = p.in[I_NAQKN] + ((size_t)l * 2 + 0) * 128 + c8; const float* wnk = wnq + 128;
    const float* wgq = p.in[I_GQAQKN] + ((size_t)l * 2 + 0) * 128 + c8; const float* wgk = wgq + 128;
    const float* cw = p.in[I_CONV] + (size_t)l * 5 * 1536 + rg * 128 + c8;
    const int rpw = (M + (int)gridDim.x * 8 - 1) / ((int)gridDim.x * 8);
    for (int m = ((int)blockIdx.x * 8 + wv) * rpw, mend = (m + rpw < M ? m + rpw : M); m < mend; ++m) {
        const bf16_t* z = Z + (size_t)m * NINP;
        const bool ctx = m < MC;
        const int b = ctx ? m / CT : (m - MC) / LT, t = ctx ? m % CT : (m - MC) % LT, T = ctx ? CT : LT;
        const int ho = rg * 128 + c8;
        uint4 rz[5]; uint2 rgz[2][4];
        {
            const bf16_t* zkv = z + (rg < 2 ? Z_GQK + rg * 128 : Z_GQV + (rg - 2) * 128) + c8;
            rz[0] = *(const uint4*)(z + Z_NAQ + ho); rz[1] = *(const uint4*)(z + Z_NAK + ho); rz[2] = *(const uint4*)(z + Z_NAV + ho); rz[3] = *(const uint4*)(z + Z_GQQ + ho); rz[4] = *(const uint4*)zkv;
#pragma unroll
            for (int dir = 0; dir < 2; ++dir)
#pragma unroll
                for (int r4 = 0; r4 < 4; ++r4) rgz[dir][r4] = *(const uint2*)(z + (dir ? Z_GB : Z_GF) + 4 * r4);
        }
        asm volatile("" ::: "memory");
        {
            vf4 q0, q1, k0, k1, v0, v1, g0, g1, x0, x1;
            unp8bf(rz[0], q0, q1); unp8bf(rz[1], k0, k1); unp8bf(rz[2], v0, v1); unp8bf(rz[3], g0, g1); unp8bf(rz[4], x0, x1);
            float r = 1.0f / sqrtf(red16(ssq8(q0, q1)) * (1.0f / 128) + EPS);
            q0 = q0 * r * *(const vf4*)wnq; q1 = q1 * r * *(const vf4*)(wnq + 4);
            *(uint4*)(WSP(bf16_t, WS_NAQ) + (size_t)m * 512 + ho) = pack8(q0, q1);
            r = 1.0f / sqrtf(red16(ssq8(k0, k1)) * (1.0f / 128) + EPS);
            k0 = k0 * r * *(const vf4*)wnk; k1 = k1 * r * *(const vf4*)(wnk + 4);
            *(uint4*)(WSP(bf16_t, WS_NAK) + (size_t)m * 512 + ho) = pack8(k0, k1);
            *(uint4*)(WSP(bf16_t, WS_NAV) + (size_t)m * 512 + ho) = pack8(v0, v1);
            if (ctx) {
                const size_t o = ((((size_t)b * DEPTH + l) * 4 + rg) * CT + t) * 128 + c8;
                *(vf4*)(p.out + O_NAK + o) = k0; *(vf4*)(p.out + O_NAK + o + 4) = k1; *(vf4*)(p.out + O_NAV + o) = v0; *(vf4*)(p.out + O_NAV + o + 4) = v1;
            }
            r = 1.0f / sqrtf(red16(ssq8(g0, g1)) * (1.0f / 128) + EPS);
            g0 = g0 * r * *(const vf4*)wgq; g1 = g1 * r * *(const vf4*)(wgq + 4);
            const float rk = 1.0f / sqrtf(red16(ssq8(x0, x1)) * (1.0f / 128) + EPS);
            if (rg < 2) { x0 = x0 * rk * *(const vf4*)wgk; x1 = x1 * rk * *(const vf4*)(wgk + 4); }
            if (!ctx) {
                const int pos = sub < 8 ? (t >> 6) : (t & 63), ai = pos * 32 + (c8 & 31);
                const vf4 c0 = *(const vf4*)(ropec + ai), c1 = *(const vf4*)(ropec + ai + 4), s0 = *(const vf4*)(ropes + ai), s1 = *(const vf4*)(ropes + ai + 4);
                const bool hi = (sub & 4) != 0;
                vf4 pg0, pg1, px0, px1;
#pragma unroll
                for (int j = 0; j < 4; ++j) { pg0[j] = __shfl_xor(g0[j], 4); pg1[j] = __shfl_xor(g1[j], 4); px0[j] = __shfl_xor(x0[j], 4); px1[j] = __shfl_xor(x1[j], 4); }
                g0 = hi ? pg0 * s0 + g0 * c0 : g0 * c0 - pg0 * s0; g1 = hi ? pg1 * s1 + g1 * c1 : g1 * c1 - pg1 * s1;
                if (rg < 2) { x0 = hi ? px0 * s0 + x0 * c0 : x0 * c0 - px0 * s0; x1 = hi ? px1 * s1 + x1 * c1 : x1 * c1 - px1 * s1; }
            }
            *(uint4*)(WSP(bf16_t, WS_GQ) + (size_t)m * 512 + ho) = pack8(g0, g1);
            *(uint4*)(WSP(bf16_t, rg < 2 ? WS_GK : WS_GV) + (size_t)m * 256 + (rg & 1) * 128 + c8) = pack8(x0, x1);
            if (ctx) {
                const size_t o = ((((size_t)b * DEPTH + l) * 2 + (rg & 1)) * CT + t) * 128 + c8;
                float* dst = p.out + (rg < 2 ? O_GK : O_GV) + o;
                *(vf4*)dst = x0; *(vf4*)(dst + 4) = x1;
            }
        }
        asm volatile("" ::: "memory");
        {
#pragma unroll
            for (int dir = 0; dir < 2; ++dir) {
                const float* up = p.in[I_GUP] + ((size_t)l * 2 + dir) * 16 * 256 + 4 * lane;
                vf4 acc = *(const vf4*)(p.in[I_GBIAS] + ((size_t)l * 2 + dir) * 256 + 4 * lane);
#pragma unroll
                for (int r4 = 0; r4 < 4; ++r4) {
                    const vf4 gv = unp4bf(rgz[dir][r4]);
                    acc += gv.x * *(const vf4*)(up + (4 * r4 + 0) * 256) + gv.y * *(const vf4*)(up + (4 * r4 + 1) * 256) + gv.z * *(const vf4*)(up + (4 * r4 + 2) * 256) + gv.w * *(const vf4*)(up + (4 * r4 + 3) * 256);
                }
                vf4 o;
#pragma unroll
                for (int j = 0; j < 4; ++j) o[j] = logsigmoid_f(acc[j]) * (1.0f / 16.0f);
                *(vf4*)(WSP(float, dir ? WS_AB : WS_AF) + (size_t)m * 256 + 4 * lane) = o;
            }
        }
        asm volatile("" ::: "memory");
        {
            uint4 rcz[3][5];
#pragma unroll
            for (int part = 0; part < 3; ++part)
#pragma unroll
                for (int j = 0; j < 5; ++j) { const int tt = t + j - 2;
                    rcz[part][j] = (tt >= 0 && tt < T) ? *(const uint4*)(Z + (size_t)(m + j - 2) * NINP + Z_DQKV + part * 512 + rg * 128 + c8) : make_uint4(0u, 0u, 0u, 0u); }
            asm volatile("" ::: "memory");
#pragma unroll
            for (int part = 0; part < 3; ++part) {
                vf4 a0 = (vf4){0.f, 0.f, 0.f, 0.f}, a1 = a0;
#pragma unroll
                for (int j = 0; j < 5; ++j) {
                    const float* cj = cw + j * 1536 + part * 512;
                    vf4 z0, z1; unp8bf(rcz[part][j], z0, z1);
                    a0 += *(const vf4*)cj * z0; a1 += *(const vf4*)(cj + 4) * z1;
                }
#pragma unroll
                for (int j = 0; j < 4; ++j) { a0[j] = silu_f(a0[j]); a1[j] = silu_f(a1[j]); }
                if (part < 2) { const float r = 1.0f / sqrtf(red16(ssq8(a0, a1)) + EPS) * (part == 0 ? 0.08838834764831845f : 1.0f); a0 *= r; a1 *= r; }
                *(uint4*)(WSP(bf16_t, part == 0 ? WS_DQ : part == 1 ? WS_DK : WS_DV) + (size_t)m * 512 + rg * 128 + c8) = pack8(a0, a1);
                asm volatile("" ::: "memory");
            }
            if (lane < 8) {
                const float beta = 1.0f / (1.0f + expf(-bf2f(z[Z_DB + lane])));
                const float g = -expf(p.in[I_ALOG][(size_t)l * 8 + lane]) * softplus_f(bf2f(z[Z_DA + lane]) + p.in[I_DTB][(size_t)l * 8 + lane]);
                float* ba = WSP(float, WS_DBA) + (size_t)m * 16;
                ba[lane] = beta; ba[8 + lane] = g;
            }
        }
    }
}

typedef float vf2 __attribute__((ext_vector_type(2)));
__device__ __forceinline__ float dpp_f(float v, const int ctrl) { return v; }
#define DPPF(v, ctrl) __int_as_float(__builtin_amdgcn_mov_dpp(__float_as_int(v), (ctrl), 0xF, 0xF, true))
__device__ __forceinline__ float red8(float v) { v += DPPF(v, 0xB1); v += DPPF(v, 0x4E); v += DPPF(v, 0x141); return v; }
__device__ __forceinline__ float red16(float v) { v = red8(v); v += DPPF(v, 0x140); return v; }

__device__ __forceinline__ void phase_post(const Params& p, int l) {
    const int tid = opaque_tid(), lane = tid & 63, wv = tid >> 6, rg = lane >> 4, c8 = (lane & 15) * 8;
    const bf16_t* Z = WSP(bf16_t, WS_Z); bf16_t* MRG = WSP(bf16_t, WS_MRG);
    const float* wg = p.in[I_GLAON] + (size_t)l * 128 + c8; const float* wd = p.in[I_GDNON] + (size_t)l * 128 + c8;
    for (int m = blockIdx.x * 8 + wv; m < M; m += gridDim.x * 8) {
        const bf16_t* z = Z + (size_t)m * NINP;
        const int ho = rg * 128 + c8;
#pragma unroll
        for (int g = 0; g < 2; ++g) {
            const float* of = WSP(float, g ? WS_DOF : WS_GOF) + (size_t)m * 512 + ho; const float* ob = WSP(float, g ? WS_DOB : WS_GOB) + (size_t)m * 512 + ho;
            const float* w = g ? wd : wg; const bf16_t* zg = z + (g ? Z_DZ : Z_GLR) + ho;
            vf4 a0 = *(const vf4*)of + *(const vf4*)ob, a1 = *(const vf4*)(of + 4) + *(const vf4*)(ob + 4);
            vf4 g0, g1; ld8bf(zg, g0, g1);
            const float r = 1.0f / sqrtf(red16(ssq8(a0, a1)) * (1.0f / 128) + EPS);
            a0 = a0 * r * *(const vf4*)w; a1 = a1 * r * *(const vf4*)(w + 4);
#pragma unroll
            for (int j = 0; j < 4; ++j) { a0[j] *= silu_f(g0[j]); a1[j] *= silu_f(g1[j]); }
            *(uint4*)(MRG + (size_t)m * DM + (g ? 1536 : 512) + ho) = pack8(a0, a1);
        }
    }
}
#define XB_TMO      128
#define XB_XCNT(j)  (256  + 64 * (j))
#define XB_XSUB(j)  (1280 + 64 * (j))
#define XB_XGEN(j)  (2304 + 64 * (j))
#define XB_TOP      3328
#define XB_TOPGEN   3392
#define XCD_BAR_WORDS 3456
#define XB_SPIN_CAP (1u << 22)
#define LAS __attribute__((address_space(3)))

__device__ __forceinline__ unsigned xb_ld(unsigned* p)              { return __hip_atomic_load(p, __ATOMIC_RELAXED, __HIP_MEMORY_SCOPE_AGENT); }
__device__ __forceinline__ unsigned xb_add(unsigned* p, unsigned v) { return __hip_atomic_fetch_add(p, v, __ATOMIC_RELAXED, __HIP_MEMORY_SCOPE_AGENT); }
__device__ __forceinline__ unsigned xb_xcc_id() { return (unsigned)__builtin_amdgcn_s_getreg((3 << 11) | 20) & 0xFu; }
#define XB_SPIN(cond, bar) do { unsigned _sp = 0; while (cond) { __builtin_amdgcn_s_sleep(1); \
    if ((++_sp & 255u) == 0u) { if (xb_ld(&(bar)[XB_TMO])) break; if (_sp > XB_SPIN_CAP) { atomicAdd(&(bar)[XB_TMO], 1u); break; } } } } while (0)

struct XcdBarrier {
    unsigned* bar; unsigned x;
    volatile LAS unsigned* st;
};

__device__ __forceinline__ XcdBarrier xcd_barrier_post(unsigned* bar, volatile LAS unsigned* st) {
    XcdBarrier b; b.bar = bar; b.x = xb_xcc_id(); b.st = st;
    if (threadIdx.x == 0) (void)xb_add(&bar[XB_XCNT(b.x)], 1u);
    return b;
}
__device__ __forceinline__ void xcd_barrier_complete(unsigned* bar, unsigned x, unsigned& nloc, unsigned& nx) {
    const unsigned G = gridDim.x * gridDim.y * gridDim.z;
    unsigned sum, cnt, mine, sp = 0u;
    for (;;) {
        sum = 0u; cnt = 0u; mine = 0u;
#pragma unroll
        for (unsigned j = 0; j < 16; ++j) { const unsigned c = xb_ld(&bar[XB_XCNT(j)]); sum += c; cnt += (c > 0u) ? 1u : 0u; mine = (j == x) ? c : mine; }
        if (sum == G) break;
        __builtin_amdgcn_s_sleep(1);
        if ((++sp & 255u) == 0u) { if (xb_ld(&bar[XB_TMO])) break; if (sp > XB_SPIN_CAP) { atomicAdd(&bar[XB_TMO], 1u); break; } }
    }
    nloc = mine > 0u ? mine : 1u; nx = cnt > 0u ? cnt : 1u;
}

__device__ __forceinline__ void xcd_barrier(const XcdBarrier& b) {
    asm volatile("s_waitcnt vmcnt(0)" ::: "memory");
    __syncthreads();
    if (threadIdx.x == 0) {
        unsigned* bar = b.bar;
        __builtin_amdgcn_s_waitcnt(0);
        unsigned nloc = b.st[0], nx = b.st[1];
        if (nloc == 0u) { xcd_barrier_complete(bar, b.x, nloc, nx); b.st[0] = nloc; b.st[1] = nx; }
        const unsigned old = xb_add(&bar[XB_XSUB(b.x)], 1u);
        const unsigned gen = old / nloc;
        if (old + 1u == (gen + 1u) * nloc) {
            __builtin_amdgcn_fence(__ATOMIC_RELEASE, "agent");
            asm volatile("s_waitcnt vmcnt(0)" ::: "memory");
            const unsigned og = xb_add(&bar[XB_TOP], 1u);
            const unsigned tg = og / nx;
            if (og + 1u == (tg + 1u) * nx) xb_add(&bar[XB_TOPGEN], 1u);
            else XB_SPIN(xb_ld(&bar[XB_TOPGEN]) == tg, bar);
            __builtin_amdgcn_fence(__ATOMIC_ACQUIRE, "agent");
            xb_add(&bar[XB_XGEN(b.x)], 1u);
            asm volatile("s_waitcnt vmcnt(0)" ::: "memory");
        } else {
            XB_SPIN(xb_ld(&bar[XB_XGEN(b.x)]) == gen, bar);
            __builtin_amdgcn_fence(__ATOMIC_ACQUIRE, "agent");
            asm volatile("s_waitcnt vmcnt(0)" ::: "memory");
        }
    }
    __syncthreads();
}

#ifndef NT_STORES
#define NT_STORES 0
#endif
namespace pg8 {
#define PG8_LAS __attribute__((address_space(3)))
typedef unsigned short bf16_t;
typedef short bf16x8 __attribute__((ext_vector_type(8)));
typedef float f32x4 __attribute__((ext_vector_type(4)));
typedef unsigned u32x4 __attribute__((ext_vector_type(4)));
typedef int v4i32 __attribute__((ext_vector_type(4)));
typedef int v8i32 __attribute__((ext_vector_type(8)));
constexpr int BM = 256, BK = 64, HALF = 128, HTB = HALF * BK * 2  , STAGE_BYTES = 8 * HTB, NXCD = 8, WGM = 8;

__host__ __device__ __forceinline__ int lds_byte(int r, int c) { const int st = (r >> 4) * 2 + (c >> 5), rr = r & 15, cc = c & 31, ob = rr * 64 + cc * 2; return st * 1024 + (ob ^ (((ob >> 9) & 1) << 5)); }
__host__ __device__ __forceinline__ void stage_rc(int b, int& R, int& C) { const int st = b / 1024, sb = b % 1024, swz = sb ^ (((sb >> 9) & 1) << 5); R = (st >> 1) * 16 + swz / 64; C = (st & 1) * 32 + (swz % 64) / 2; }
__host__ __device__ __forceinline__ int perm32(int rho) { const int n = rho >> 4, i = rho & 15; return 8 * (i >> 2) + 4 * n + (i & 3); }

struct Unit { int pm, pn, k0, nt, at, slot, msk; };
struct Gemm { const bf16_t* A; const bf16_t* Bt; int M, N, K; };

struct StaticOrder {
    int nM, nN, nwg, G, c, ntk, split, msplit;
    __host__ __device__ void init(int M, int N, int K, int G_, int c_, int split_ = 0) { nM = M / BM; nN = N / BM; nwg = nM * nN; G = G_; c = c_; ntk = K / BK; const int rem = nwg % G_; split = (split_ == 1 && rem > 0 && 2 * rem == G_ && ntk >= 8) ? 1 : 0; msplit = (split_ == 2 && rem > 0 && 2 * rem <= G_) ? 1 : 0; }
    __host__ __device__ bool next(int i, Unit& u) const {
        long L = (long)i * G + c; u.k0 = 0; u.nt = ntk; u.at = 0; u.slot = 0; u.msk = 3;
        if (msplit && i == nwg / G) { const int rem = nwg % G; if (c >= 2 * rem) return false; L = (long)i * G + (c % rem); u.msk = (c / rem) ? 2 : 1; }
        if (split && i == nwg / G) { const int rem = nwg % G, sl = c / rem, h0 = ((ntk / 2) + 1) & ~1; L = (long)i * G + (c % rem); u.k0 = sl ? h0 * BK : 0; u.nt = sl ? ntk - h0 : h0; u.at = sl ? 1 : 2; u.slot = c % rem; }
        if (L >= nwg) return false;
        int wgid = (int)L; { const int q = nwg / NXCD, r = nwg % NXCD, xcd = wgid % NXCD, off = wgid / NXCD; wgid = (xcd < r ? xcd * (q + 1) : r * (q + 1) + (xcd - r) * q) + off; }
        const int nig = WGM * nN, gid = wgid / nig, fm = gid * WGM, gsz = (nM - fm) < WGM ? (nM - fm) : WGM;
        u.pm = fm + ((wgid % nig) % gsz); u.pn = (wgid % nig) / gsz; return true;
    }
    __device__ __forceinline__ void a_ready(const Unit&) const {}
    __device__ __forceinline__ void done(const Unit&) const {}
};
__device__ __forceinline__ unsigned cvt_pk_bf16(float lo, float hi) { unsigned r; asm volatile("v_cvt_pk_bf16_f32 %0, %1, %2" : "=v"(r) : "v"(lo), "v"(hi)); return r; }
struct EpiF32 {
    static constexpr bool PERM = false, AFTER_DRAIN = false;
    float* C; int ldc; const float* bias;
    __device__ __forceinline__ void operator()(const f32x4 (&acc)[2][2][4][2], const Unit& u, int wr, int wc, int fr, int fq) const {
        const int row0 = u.pm * BM + wr * 64 + fr, col0 = u.pn * BM + wc * 32 + 4 * fq;
        f32x4 bv[2][2];
#pragma unroll
        for (int bj = 0; bj < 2; ++bj)
#pragma unroll
            for (int n = 0; n < 2; ++n) bv[bj][n] = bias ? *(const f32x4*)(bias + col0 + bj * HALF + n * 16) : (f32x4){0.f, 0.f, 0.f, 0.f};
#pragma unroll
        for (int ai = 0; ai < 2; ++ai)
#pragma unroll
            for (int m = 0; m < 4; ++m) { float* rowp = C + (size_t)(row0 + ai * HALF + m * 16) * ldc + col0;
#pragma unroll
                for (int bj = 0; bj < 2; ++bj)
#pragma unroll
                    for (int n = 0; n < 2; ++n) *(f32x4*)(rowp + bj * HALF + n * 16) = acc[ai][bj][m][n] + bv[bj][n]; }
    }
};

struct EpiSwiGLU {
    static constexpr bool PERM = true, AFTER_DRAIN = false;
    bf16_t* O; int ldc;
    __device__ __forceinline__ void operator()(const f32x4 (&acc)[2][2][4][2], const Unit& u, int wr, int wc, int fr, int fq) const {
        const int row0 = u.pm * BM + wr * 64 + fr, col0 = u.pn * 128 + wc * 32 + 8 * fq;
#pragma unroll
        for (int ai = 0; ai < 2; ++ai) if ((u.msk >> ai) & 1)
#pragma unroll
            for (int m = 0; m < 4; ++m) { bf16_t* rowp = O + (size_t)(row0 + ai * HALF + m * 16) * ldc + col0;
                const f32x4 g0 = acc[ai][0][m][0], g1 = acc[ai][0][m][1], u0 = acc[ai][1][m][0], u1 = acc[ai][1][m][1];
                float r[8];
#pragma unroll
                for (int j = 0; j < 4; ++j) {
                    r[j]     = g0[j] * __builtin_amdgcn_rcpf(1.0f + __builtin_amdgcn_exp2f(-1.4426950408889634f * g0[j])) * u0[j];
                    r[4 + j] = g1[j] * __builtin_amdgcn_rcpf(1.0f + __builtin_amdgcn_exp2f(-1.4426950408889634f * g1[j])) * u1[j]; }
                u32x4 w; w.x = cvt_pk_bf16(r[0], r[1]); w.y = cvt_pk_bf16(r[2], r[3]); w.z = cvt_pk_bf16(r[4], r[5]); w.w = cvt_pk_bf16(r[6], r[7]);
#if NT_STORES
                __builtin_nontemporal_store(w, (u32x4*)rowp);
#else
                *(u32x4*)rowp = w;
#endif
                }
    }
};
struct EpiSwiGLU8 {
    static constexpr bool PERM = true, AFTER_DRAIN = false;
    unsigned char* O; int ldc; float wscale;
    __device__ __forceinline__ void operator()(const f32x4 (&acc)[2][2][4][2], const Unit& u, int wr, int wc, int fr, int fq) const {
        const int row0 = u.pm * BM + wr * 64 + fr, col0 = u.pn * 128 + wc * 32 + 8 * fq;
#pragma unroll
        for (int ai = 0; ai < 2; ++ai) if ((u.msk >> ai) & 1)
#pragma unroll
            for (int m = 0; m < 4; ++m) { unsigned char* rowp = O + (size_t)(row0 + ai * HALF + m * 16) * ldc + col0;
                f32x4 g0 = acc[ai][0][m][0], g1 = acc[ai][0][m][1], u0 = acc[ai][1][m][0], u1 = acc[ai][1][m][1];
                asm volatile("" : "+v"(g0), "+v"(g1), "+v"(u0), "+v"(u1));
                g0 *= wscale; g1 *= wscale; u0 *= wscale; u1 *= wscale;
                float r[8];
#pragma unroll
                for (int j = 0; j < 4; ++j) {
                    r[j]     = g0[j] * __builtin_amdgcn_rcpf(1.0f + __builtin_amdgcn_exp2f(-1.4426950408889634f * g0[j])) * u0[j];
                    r[4 + j] = g1[j] * __builtin_amdgcn_rcpf(1.0f + __builtin_amdgcn_exp2f(-1.4426950408889634f * g1[j])) * u1[j]; }
                uint2 w; w.x = pack4_fp8(r[0], r[1], r[2], r[3]); w.y = pack4_fp8(r[4], r[5], r[6], r[7]);
                *(uint2*)rowp = w; asm volatile("" ::: "memory"); }
    }
};
struct EpiBf16Plain {
    static constexpr bool PERM = true, AFTER_DRAIN = false;
    bf16_t* O; int ldc;
    __device__ __forceinline__ void operator()(const f32x4 (&acc)[2][2][4][2], const Unit& u, int wr, int wc, int fr, int fq) const {
        const int row0 = u.pm * BM + wr * 64 + fr, col0 = u.pn * BM + wc * 32 + 8 * fq;
#pragma unroll
        for (int ai = 0; ai < 2; ++ai) if ((u.msk >> ai) & 1)
#pragma unroll
            for (int m = 0; m < 4; ++m) { bf16_t* rowp = O + (size_t)(row0 + ai * HALF + m * 16) * ldc + col0;
#pragma unroll
                for (int bj = 0; bj < 2; ++bj) { const f32x4 v0 = acc[ai][bj][m][0], v1 = acc[ai][bj][m][1];
                    u32x4 w; w.x = cvt_pk_bf16(v0[0], v0[1]); w.y = cvt_pk_bf16(v0[2], v0[3]); w.z = cvt_pk_bf16(v1[0], v1[1]); w.w = cvt_pk_bf16(v1[2], v1[3]);
                    *(u32x4*)(rowp + bj * HALF) = w; } }
    }
};
struct EpiResid {
    static constexpr bool PERM = false, AFTER_DRAIN = false;
    const float* res; float* out; int ldc; const float* gate0; float coef;
    float* slab; unsigned* flags; unsigned target;
    const float* res_hi; int row_hi;
    __device__ __forceinline__ void operator()(const f32x4 (&acc)[2][2][4][2], const Unit& u, int wr, int wc, int fr, int fq) const {
        const int tidx = ((wr * 4 + wc) * 4 + fq) * 16 + fr;
        if (u.at == 1) {
            const __amdgpu_buffer_rsrc_t rs = __builtin_amdgcn_make_buffer_rsrc((void*)slab, 0, 0x7FFFFFF0, 0x00020000);
            const unsigned base = ((unsigned)u.slot * 32u * 512u + (unsigned)tidx) * 16u;
#pragma unroll
            for (int ai = 0; ai < 2; ++ai)
#pragma unroll
                for (int bj = 0; bj < 2; ++bj)
#pragma unroll
                    for (int m = 0; m < 4; ++m)
#pragma unroll
                        for (int n = 0; n < 2; ++n) { const f32x4 v = acc[ai][bj][m][n]; u32x4 w; w.x = __float_as_uint(v[0]); w.y = __float_as_uint(v[1]); w.z = __float_as_uint(v[2]); w.w = __float_as_uint(v[3]);
                            __builtin_amdgcn_raw_buffer_store_b128(w, rs, base + (unsigned)((((ai * 2 + bj) * 4 + m) * 2 + n) * 512 * 16), 0, 16); }
            asm volatile("s_waitcnt vmcnt(0)" ::: "memory");
            if ((tidx & 63) == 0) __hip_atomic_fetch_add(flags + 64 * u.slot, 1u, __ATOMIC_RELAXED, __HIP_MEMORY_SCOPE_AGENT);
            return;
        }
        const float* part = nullptr;
        if (u.at == 2) {
            unsigned spins = 0;
            while (__hip_atomic_load(flags + 64 * u.slot, __ATOMIC_RELAXED, __HIP_MEMORY_SCOPE_AGENT) < target) { __builtin_amdgcn_s_sleep(2); if (++spins > (1u << 22)) break; }
            __builtin_amdgcn_fence(__ATOMIC_ACQUIRE, "agent");
            asm volatile("s_waitcnt vmcnt(0)" ::: "memory");
            part = slab + ((size_t)u.slot * 32 * 512 + tidx) * 4;
        }
        const int row0 = u.pm * BM + wr * 64 + fr, col0 = u.pn * BM + wc * 32 + 4 * fq;
        const float* gate = gate0 + (size_t)cond_of_row(u.pm * BM) * NMOD;
        const float* rbase = (u.pm * BM >= row_hi) ? res_hi - (size_t)row_hi * ldc : res;
        f32x4 gv[2][2];
#pragma unroll
        for (int bj = 0; bj < 2; ++bj)
#pragma unroll
            for (int n = 0; n < 2; ++n) gv[bj][n] = *(const f32x4*)(gate + col0 + bj * HALF + n * 16) * coef;
#pragma unroll
        for (int ai = 0; ai < 2; ++ai) if ((u.msk >> ai) & 1)
#pragma unroll
            for (int m = 0; m < 4; ++m) { const size_t off = (size_t)(row0 + ai * HALF + m * 16) * ldc + col0;
#pragma unroll
                for (int bj = 0; bj < 2; ++bj)
#pragma unroll
                    for (int n = 0; n < 2; ++n) {
                        f32x4 a = acc[ai][bj][m][n];
                        if (part) a += *(const f32x4*)(part + (size_t)((((ai * 2 + bj) * 4 + m) * 2 + n) * 512 * 4));
                        const f32x4 bs = *(const f32x4*)(rbase + off + bj * HALF + n * 16); *(f32x4*)(out + off + bj * HALF + n * 16) = bs + gv[bj][n] * a; }
                asm volatile("" ::: "memory"); }
    }
};
template <class Epi, class Sched, bool STAMP = false, int FP8 = 0>
__device__ __forceinline__ void gemm_phase(PG8_LAS unsigned char* lds, const Gemm g, const Sched& S, const Epi& E, unsigned long long* stamps) {
    const int tid = opaque_tid(), wid = __builtin_amdgcn_readfirstlane(tid >> 6), lane = tid & 63, wr = wid >> 2, wc = wid & 3, fr = lane & 15, fq = lane >> 4;
    const int K = g.K;
    int ts_lo = 0, ts_hi = 0, nts = 0; const unsigned long long rt_entry = STAMP ? (unsigned long long)wall_clock64() : 0ull;
#define PG8_STAMP() do { if (STAMP && wid == 0 && nts < 64) { const unsigned long long _c = (unsigned long long)clock64(); \
        ts_lo = (lane == nts) ? (int)(unsigned)_c : ts_lo; ts_hi = (lane == nts) ? (int)(unsigned)(_c >> 32) : ts_hi; ++nts; } } while (0)
    PG8_STAMP();
    unsigned voffA[2], voffB[2];
#pragma unroll
    for (int i = 0; i < 2; ++i) { int R, C; stage_rc(tid * 16 + i * 8192, R, C); const int Rb = Epi::PERM ? ((R & ~31) + perm32(R & 31)) : R;
        voffA[i] = (unsigned)(R * K + C) * 2u; voffB[i] = (unsigned)(Rb * K + C) * 2u; }
    const size_t kstep = (size_t)(BK * 2);
    const size_t hstep = (size_t)HALF * K * 2;
    const size_t tstep = 2 * hstep;
    const unsigned ldsw = (unsigned)wid * 1024u;
    const int aoff = lds_byte(wr * 64 + fr, fq * 8), boff = lds_byte(wc * 32 + fr, fq * 8);
#define PG8_SA(b, h) (((b) * 2 + (h)) * HTB)
#define PG8_SB(b, h) ((4 + (b) * 2 + (h)) * HTB)
#define PG8_STAGE(bufoff, gbase, voff) do { _Pragma("unroll") for (int _i = 0; _i < 2; ++_i) \
        __builtin_amdgcn_global_load_lds((const unsigned*)((const char*)(gbase) + (voff)[_i]), (PG8_LAS unsigned*)(lds + (bufoff) + ldsw + _i * 8192), 16, 0, 0); } while (0)
#define PG8_LDA(dst, b, h) do { _Pragma("unroll") for (int m = 0; m < 4; ++m) dst[m] = __builtin_shufflevector(*(const PG8_LAS v4i32*)(lds + PG8_SA(b, h) + aoff + m * 2048), *(const PG8_LAS v4i32*)(lds + PG8_SA(b, h) + aoff + m * 2048 + 1024), 0, 1, 2, 3, 4, 5, 6, 7); } while (0)
#define PG8_LDB(dst, b, h) do { _Pragma("unroll") for (int n = 0; n < 2; ++n) dst[n] = __builtin_shufflevector(*(const PG8_LAS v4i32*)(lds + PG8_SB(b, h) + boff + n * 2048), *(const PG8_LAS v4i32*)(lds + PG8_SB(b, h) + boff + n * 2048 + 1024), 0, 1, 2, 3, 4, 5, 6, 7); } while (0)
#define PG8_HALF(v, k) __builtin_bit_cast(bf16x8, __builtin_shufflevector(v, v, 4 * (k), 4 * (k) + 1, 4 * (k) + 2, 4 * (k) + 3))
#define PG8_MMA(ai, bj, At, Bt) do { __builtin_amdgcn_s_setprio(1); _Pragma("unroll") for (int m = 0; m < 4; ++m) _Pragma("unroll") for (int n = 0; n < 2; ++n) { \
        acc[ai][bj][m][n] = __builtin_amdgcn_mfma_f32_16x16x32_bf16(PG8_HALF(Bt[n], 0), PG8_HALF(At[m], 0), acc[ai][bj][m][n], 0, 0, 0); \
        acc[ai][bj][m][n] = __builtin_amdgcn_mfma_f32_16x16x32_bf16(PG8_HALF(Bt[n], 1), PG8_HALF(At[m], 1), acc[ai][bj][m][n], 0, 0, 0); } __builtin_amdgcn_s_setprio(0); } while (0)
#define PG8_MMA8(ai, bj, At, Bt) do { __builtin_amdgcn_s_setprio(1); _Pragma("unroll") for (int m = 0; m < 4; ++m) _Pragma("unroll") for (int n = 0; n < 2; ++n) \
        acc[ai][bj][m][n] = __builtin_amdgcn_mfma_scale_f32_16x16x128_f8f6f4(Bt[n], At[m], acc[ai][bj][m][n], 0, 0, 0, 127, 0, 127); __builtin_amdgcn_s_setprio(0); } while (0)
#define PG8_Q64(v, q) __builtin_bit_cast(long, __builtin_shufflevector(v, v, 2 * (q), 2 * (q) + 1))
#define PG8_M8L1(ai, bj, m, n, q) acc[ai][bj][m][n] = __builtin_amdgcn_mfma_f32_16x16x32_fp8_fp8(PG8_Q64(Bt_[n], q), PG8_Q64(At_[m], q), acc[ai][bj][m][n], 0, 0, 0)
#define PG8_MMA8L(ai, bj, At, Bt) do { auto& At_ = At; auto& Bt_ = Bt; __builtin_amdgcn_s_setprio(1); _Pragma("unroll") for (int m = 0; m < 4; ++m) _Pragma("unroll") for (int n = 0; n < 2; ++n) { \
        PG8_M8L1(ai, bj, m, n, 0); PG8_M8L1(ai, bj, m, n, 1); PG8_M8L1(ai, bj, m, n, 2); PG8_M8L1(ai, bj, m, n, 3); } __builtin_amdgcn_s_setprio(0); } while (0)
#define PG8_MMAG(ai, bj, At, Bt) do { if (mrow & (1 << (ai))) { if constexpr (FP8 == 1) PG8_MMA8(ai, bj, At, Bt); else if constexpr (FP8 == 2) PG8_MMA8L(ai, bj, At, Bt); else PG8_MMA(ai, bj, At, Bt); } } while (0)
#define PG8_WAIT_V(n) asm volatile("s_waitcnt vmcnt(" #n ")" ::: "memory")
#define PG8_WAIT_L(n) asm volatile("s_waitcnt lgkmcnt(" #n ")" ::: "memory")
#define PG8_BAR __builtin_amdgcn_s_barrier()
#define PG8_SCHED __builtin_amdgcn_sched_barrier(0)
    Unit cur, nxt; int ui = 0;
    if (!S.next(0, cur)) return;
    f32x4 acc[2][2][4][2];
#pragma unroll
    for (int a = 0; a < 2; ++a)
#pragma unroll
        for (int b = 0; b < 2; ++b)
#pragma unroll
            for (int m = 0; m < 4; ++m)
#pragma unroll
                for (int n = 0; n < 2; ++n) acc[a][b][m][n] = (f32x4){0.f, 0.f, 0.f, 0.f};
    v8i32 At[4], B0[2], B1[2];
    const char* cA = (const char*)g.A + (size_t)cur.pm * tstep + (size_t)cur.k0 * 2; const char* cB = (const char*)g.Bt + (size_t)cur.pn * tstep + (size_t)cur.k0 * 2;
    S.a_ready(cur);
    PG8_STAGE(PG8_SB(0, 0), cB, voffB); PG8_STAGE(PG8_SA(0, 0), cA, voffA); PG8_STAGE(PG8_SB(0, 1), cB + hstep, voffB); PG8_STAGE(PG8_SA(0, 1), cA + hstep, voffA);
    if (wr == 1) PG8_BAR;
    PG8_WAIT_V(4); PG8_BAR;
    PG8_STAGE(PG8_SB(1, 0), cB + kstep, voffB); PG8_STAGE(PG8_SA(1, 0), cA + kstep, voffA); PG8_STAGE(PG8_SB(1, 1), cB + hstep + kstep, voffB);
    PG8_WAIT_V(6); PG8_BAR;
    PG8_STAMP();
    for (;;) {
        const bool has_next = S.next(ui + 1, nxt);
        const char* nA = has_next ? (const char*)g.A + (size_t)nxt.pm * tstep + (size_t)nxt.k0 * 2 : cA; const char* nB = has_next ? (const char*)g.Bt + (size_t)nxt.pn * tstep + (size_t)nxt.k0 * 2 : cB;
        const int nt = cur.nt, mrow = cur.msk;
        for (int t = 0; t < nt; t += 2) {
            const bool last = (t == nt - 2);
            const char* a1 = cA + (size_t)(t + 1) * kstep;
            const char* a2 = last ? nA : cA + (size_t)(t + 2) * kstep; const char* b2 = last ? nB : cB + (size_t)(t + 2) * kstep;
            const char* a3 = a2 + kstep; const char* b3 = b2 + kstep;
            if (last && has_next) S.a_ready(nxt);
            PG8_LDB(B0, 0, 0); PG8_SCHED; PG8_LDA(At, 0, 0); PG8_STAGE(PG8_SA(1, 1), a1 + hstep, voffA);
            PG8_WAIT_L(8); PG8_BAR; PG8_WAIT_L(0); PG8_MMAG(0, 0, At, B0); PG8_BAR; PG8_SCHED;
            PG8_LDB(B1, 0, 1); PG8_STAGE(PG8_SB(0, 0), b2, voffB);
            PG8_BAR; PG8_WAIT_L(0); PG8_MMAG(0, 1, At, B1); PG8_BAR;
            PG8_LDA(At, 0, 1); PG8_STAGE(PG8_SA(0, 0), a2, voffA);
            PG8_BAR; PG8_WAIT_L(0); PG8_MMAG(1, 0, At, B0); PG8_BAR; PG8_SCHED;
            PG8_STAGE(PG8_SB(0, 1), b2 + hstep, voffB);
            PG8_WAIT_V(6); PG8_BAR; PG8_MMAG(1, 1, At, B1); PG8_BAR;
            PG8_LDB(B0, 1, 0); PG8_SCHED; PG8_LDA(At, 1, 0); PG8_STAGE(PG8_SA(0, 1), a2 + hstep, voffA);
            PG8_WAIT_L(8); PG8_BAR; PG8_WAIT_L(0); PG8_MMAG(0, 0, At, B0); PG8_BAR; PG8_SCHED;
            PG8_LDB(B1, 1, 1); PG8_STAGE(PG8_SB(1, 0), b3, voffB);
            PG8_BAR; PG8_WAIT_L(0); PG8_MMAG(0, 1, At, B1); PG8_BAR;
            PG8_LDA(At, 1, 1); PG8_STAGE(PG8_SA(1, 0), a3, voffA);
            PG8_BAR; PG8_WAIT_L(0); PG8_MMAG(1, 0, At, B0); PG8_BAR; PG8_SCHED;
            PG8_STAGE(PG8_SB(1, 1), b3 + hstep, voffB);
            PG8_WAIT_V(6); PG8_BAR; PG8_MMAG(1, 1, At, B1); PG8_BAR;
        }
        PG8_STAMP();
        if constexpr (!Epi::AFTER_DRAIN) { E(acc, cur, wr, wc, fr, fq); S.done(cur); }
        PG8_STAMP();
        if (!has_next) break;
#pragma unroll
        for (int a = 0; a < 2; ++a)
#pragma unroll
            for (int b = 0; b < 2; ++b)
#pragma unroll
                for (int m = 0; m < 4; ++m)
#pragma unroll
                    for (int n = 0; n < 2; ++n) acc[a][b][m][n] = (f32x4){0.f, 0.f, 0.f, 0.f};
        cur = nxt; cA = nA; cB = nB; ++ui;
    }
    PG8_WAIT_V(0);
    if (wr == 0) PG8_BAR;
    PG8_BAR;
    if constexpr (Epi::AFTER_DRAIN) { E.fused(acc, cur, wr, wc, fr, fq, lds, wid, lane); S.done(cur); }
    PG8_STAMP();
    if (STAMP && wid == 0) { stamps[lane] = lane < nts ? (((unsigned long long)(unsigned)ts_hi << 32) | (unsigned)ts_lo) : 0ull;
        if (lane == 62) stamps[62] = rt_entry; if (lane == 63) stamps[63] = (unsigned long long)wall_clock64(); }
#undef PG8_STAMP
#undef PG8_SA
#undef PG8_SB
#undef PG8_STAGE
#undef PG8_LDA
#undef PG8_LDB
#undef PG8_HALF
#undef PG8_MMA
#undef PG8_MMA8
#undef PG8_MMA8L
#undef PG8_M8L1
#undef PG8_Q64
#undef PG8_MMAG
#undef PG8_WAIT_V
#undef PG8_WAIT_L
#undef PG8_BAR
#undef PG8_SCHED
}
}
#ifndef ATT_INLINE
#define ATT_INLINE __forceinline__
#endif
namespace att {
constexpr int D = 128, NW = 8, QBLK = 32, KVBLK = 64, LDQ = 512, LDO = DM;
constexpr float SCALE = 0.088388347648318440f;
constexpr float THR = 8.f;
constexpr size_t SHM_V = KVBLK * D * 2, SHM_K = KVBLK * D * 2, SHM_Q = 256 * D * 2, SHM_ATTN = 2 * SHM_V + 2 * SHM_K + NW * 64 * 4 + SHM_Q;
using bf16x8 = __attribute__((ext_vector_type(8))) short;
using s16x4  = __attribute__((ext_vector_type(4))) short;
using f32x16 = __attribute__((ext_vector_type(16))) float;
using u32x4  = __attribute__((ext_vector_type(4))) unsigned;
#define KSWZ(row, colB) ((row) * 256 + ((colB) ^ (((row) & 7) << 4)))
#define SBAR() __builtin_amdgcn_sched_barrier(0)
__device__ __forceinline__ int crow(int r, int hi) { return (r & 3) + 8 * (r >> 2) + 4 * hi; }
__device__ __forceinline__ unsigned cvtpk(float lo, float hi) { unsigned r; asm volatile("v_cvt_pk_bf16_f32 %0, %1, %2" : "=v"(r) : "v"(lo), "v"(hi)); return r; }

__device__ __forceinline__ void partialSM(f32x16& p0, f32x16& p1, float& m_reg, float& mn, float& alpha) {
  constexpr float C = SCALE * 1.4426950408889634f;
  float pmax = p0[0]; for (int r = 1; r < 16; ++r) pmax = fmaxf(pmax, p0[r]); for (int r = 0; r < 16; ++r) pmax = fmaxf(pmax, p1[r]);
  { auto rr = __builtin_amdgcn_permlane32_swap(__float_as_uint(pmax), __float_as_uint(pmax), false, false);
    pmax = fmaxf(__uint_as_float(rr[0]), __uint_as_float(rr[1])); }
  if (__builtin_expect(__all(pmax - m_reg <= THR / SCALE), 1)) { mn = m_reg; alpha = 1.f; }
  else { mn = fmaxf(m_reg, pmax); alpha = __builtin_amdgcn_exp2f((m_reg - mn) * C); m_reg = mn; }
  float mnC = -mn * C;
  for (int r = 0; r < 16; ++r) p0[r] = fmaf(p0[r], C, mnC); for (int r = 0; r < 16; ++r) p1[r] = fmaf(p1[r], C, mnC);
  for (int r = 0; r < 16; ++r) p0[r] = __builtin_amdgcn_exp2f(p0[r]);
}
__device__ __forceinline__ void finishSM(f32x16& p0, f32x16& p1, float alpha, float& l_reg, bf16x8& pa0, bf16x8& pa1, bf16x8& pa2, bf16x8& pa3) {
  for (int r = 0; r < 16; ++r) p1[r] = __builtin_amdgcn_exp2f(p1[r]);
  float ps = 0; for (int r = 0; r < 16; ++r) ps += p0[r]; for (int r = 0; r < 16; ++r) ps += p1[r];
  { auto rr = __builtin_amdgcn_permlane32_swap(__float_as_uint(ps), __float_as_uint(ps), false, false);
    ps = __uint_as_float(rr[0]) + __uint_as_float(rr[1]); }
  l_reg = l_reg * alpha + ps;
#define PK4(P, BASE, OUT) do { unsigned a0 = cvtpk(P[BASE + 0], P[BASE + 1]), a1 = cvtpk(P[BASE + 2], P[BASE + 3]);   \
    unsigned b0 = cvtpk(P[BASE + 4], P[BASE + 5]), b1 = cvtpk(P[BASE + 6], P[BASE + 7]);                              \
    auto r0 = __builtin_amdgcn_permlane32_swap(a0, b0, false, false); auto r1 = __builtin_amdgcn_permlane32_swap(a1, b1, false, false); \
    u32x4 w = {r0[0], r1[0], r0[1], r1[1]}; OUT = *reinterpret_cast<bf16x8*>(&w); } while (0)
  PK4(p0, 0, pa0); PK4(p0, 8, pa1); PK4(p1, 0, pa2); PK4(p1, 8, pa3);
#undef PK4
}
__device__ __forceinline__ void qkt(f32x16& p0, f32x16& p1, const bf16_t* Ks, const bf16_t* Qs, int qrow, int r32, int hi) {
  p0 = f32x16{}; p1 = f32x16{};
#pragma unroll
  for (int d0 = 0; d0 < 8; ++d0) { int cb = (d0 * 16 + hi * 8) * 2;
    bf16x8 q = *reinterpret_cast<const bf16x8*>((const char*)Qs + KSWZ(qrow, cb));
    bf16x8 b0 = *reinterpret_cast<const bf16x8*>((const char*)Ks + KSWZ(r32, cb));
    bf16x8 b1 = *reinterpret_cast<const bf16x8*>((const char*)Ks + KSWZ(32 + r32, cb));
    p0 = __builtin_amdgcn_mfma_f32_32x32x16_bf16(b0, q, p0, 0, 0, 0);
    p1 = __builtin_amdgcn_mfma_f32_32x32x16_bf16(b1, q, p1, 0, 0, 0); }
}
__device__ __forceinline__ int v_st(int k, int c) { const int kk = (k & ~0xC) | ((k & 4) << 1) | ((k & 8) >> 1); return ((kk >> 3) * 4 + (c >> 5)) * 512 + ((kk & 7) * 32 + (c & 31)) * 2; }
__device__ __forceinline__ int v_rd_base(int lane) { return ((lane & 3) << 3) | (((lane >> 2) & 3) << 6) | (((lane >> 4) & 1) << 5) | (((lane >> 5) & 1) << 8); }
constexpr int v_rd_off(int d0, int ks, int half) { return d0 * 512 + ks * 4096 + half * 2048; }
template <int OFF> __device__ __forceinline__ s16x4 tr_read(int vb) {
  s16x4 r; asm volatile("ds_read_b64_tr_b16 %0, %1 offset:%2" : "=&v"(r) : "v"(vb), "i"(OFF) : "memory"); return r;
}
template <int D0> __device__ __forceinline__ void pv_one(f32x16& od, int vb, bf16x8 pa0, bf16x8 pa1, bf16x8 pa2, bf16x8 pa3) {
  const s16x4 l0 = tr_read<v_rd_off(D0, 0, 0)>(vb), h0 = tr_read<v_rd_off(D0, 0, 1)>(vb), l1 = tr_read<v_rd_off(D0, 1, 0)>(vb), h1 = tr_read<v_rd_off(D0, 1, 1)>(vb);
  const s16x4 l2 = tr_read<v_rd_off(D0, 2, 0)>(vb), h2 = tr_read<v_rd_off(D0, 2, 1)>(vb), l3 = tr_read<v_rd_off(D0, 3, 0)>(vb), h3 = tr_read<v_rd_off(D0, 3, 1)>(vb);
  asm volatile("s_waitcnt lgkmcnt(0)" ::: "memory"); SBAR();
#define PK(L, H) (bf16x8){L[0], L[1], L[2], L[3], H[0], H[1], H[2], H[3]}
  od = __builtin_amdgcn_mfma_f32_32x32x16_bf16(pa0, PK(l0, h0), od, 0, 0, 0);
  od = __builtin_amdgcn_mfma_f32_32x32x16_bf16(pa1, PK(l1, h1), od, 0, 0, 0);
  od = __builtin_amdgcn_mfma_f32_32x32x16_bf16(pa2, PK(l2, h2), od, 0, 0, 0);
  od = __builtin_amdgcn_mfma_f32_32x32x16_bf16(pa3, PK(l3, h3), od, 0, 0, 0);
#undef PK
}
__device__ __forceinline__ void pv_d0(f32x16* o, int vb, bf16x8 pa0, bf16x8 pa1, bf16x8 pa2, bf16x8 pa3) {
  pv_one<0>(o[0], vb, pa0, pa1, pa2, pa3); pv_one<1>(o[1], vb, pa0, pa1, pa2, pa3); pv_one<2>(o[2], vb, pa0, pa1, pa2, pa3); pv_one<3>(o[3], vb, pa0, pa1, pa2, pa3);
}

struct SrcOne { const bf16_t* k0; const bf16_t* v0; int ldk;
  __device__ __forceinline__ const bf16_t* k(int j) const { return k0 + (size_t)j * 64 * ldk; }
  __device__ __forceinline__ const bf16_t* v(int j) const { return v0 + (size_t)j * 64 * ldk; } };
struct SrcTwo { const bf16_t* ck; const bf16_t* cv; const bf16_t* k1; const bf16_t* v1; int ldk;
  __device__ __forceinline__ const bf16_t* k(int j) const { return j < 4 ? ck + (size_t)j * 64 * ldk : k1 + (size_t)(j - 4) * 64 * ldk; }
  __device__ __forceinline__ const bf16_t* v(int j) const { return j < 4 ? cv + (size_t)j * 64 * ldk : v1 + (size_t)(j - 4) * 64 * ldk; } };
struct NoBias { __device__ __forceinline__ void operator()(f32x16&, f32x16&, int, int, int, int) const {} };
struct NaBias { const float* tab; int i0, kr0;
  __device__ __forceinline__ void operator()(f32x16& p0, f32x16& p1, int jt, int wid, int r32, int hi) const {
    if (jt < 4) return;
    const int qi = i0 + wid * QBLK + r32, r = qi >> 6, qc = qi & 63, kr = kr0 + jt - 4;
    int lo = r - 4; lo = lo < 0 ? 0 : (lo > 8 ? 8 : lo);
    const bool rowok = (kr >= lo) && (kr < lo + 8);
    if (!rowok) {
#pragma unroll
      for (int rr = 0; rr < 16; ++rr) { p0[rr] = -1e30f; p1[rr] = -1e30f; }
      return;
    }
    int c0 = qc - 8; c0 = c0 < 0 ? 0 : (c0 > 48 ? 48 : c0);
    const int dr = kr - r + 7;
    const float* tb = tab + dr * 31 + (4 * hi - qc + 15);
    const int w0 = 4 * hi - c0;
#pragma unroll
    for (int g = 0; g < 4; ++g) {
#pragma unroll
      for (int q = 0; q < 4; ++q) {
        const int rr = 4 * g + q, kc0 = q + 8 * g;
        const float t0 = tb[kc0], t1 = tb[kc0 + 32];
        p0[rr] = ((unsigned)(kc0 + w0) < 16u) ? p0[rr] + t0 : -1e30f;
        p1[rr] = ((unsigned)(kc0 + 32 + w0) < 16u) ? p1[rr] + t1 : -1e30f;
      }
      SBAR();
    }
  } };

template <int SD, class Src, class Bias>
__device__ ATT_INLINE void attn_body(const bf16_t* __restrict__ Qb, const Src src, bf16_t* __restrict__ Ob, const int NT, char* lds, const Bias bias) {
  const int tid = opaque_tid(), wid = tid >> 6, lane = tid & 63, r32 = lane & 31, hi = lane >> 5;
  const int LDK = src.ldk;
  bf16_t* V_lds = (bf16_t*)lds; bf16_t* K_lds = (bf16_t*)(lds + 2 * SHM_V);
  float* ws = (float*)(lds + 2 * SHM_V + 2 * SHM_K) + wid * 64; float* li_l = ws; float* al_l = ws + 32;
  float m_reg = -1e30f, l_reg = 0; f32x16 o[4] = {};
  bf16_t* Q_lds = (bf16_t*)(lds + 2 * SHM_V + 2 * SHM_K + NW * 64 * 4);
  const int qrow = wid * QBLK + r32;
  {
#pragma unroll
    for (int i = 0; i < 8; ++i) { const int f = tid + 512 * i, row = f >> 4, c8 = (f & 15) * 8;
      *(bf16x8*)((char*)Q_lds + KSWZ(row, c8 * 2)) = *reinterpret_cast<const bf16x8*>(Qb + (long)row * LDQ + c8); }
  }
  const int sr = tid >> 4, sc = (tid & 15) * 8, vst0 = v_st(sr, sc), vst1 = v_st(32 + sr, sc);
  const int vb0 = (int)(uintptr_t)V_lds + v_rd_base(lane);
  struct { bf16x8 vs0, vs1, ks0, ks1; } sr_[SD];
#define SLOAD(i, jt) do { const bf16_t* kt_ = src.k(jt); const bf16_t* vt_ = src.v(jt); \
    sr_[i].vs0 = *reinterpret_cast<const bf16x8*>(&vt_[(long)sr * LDK + sc]); sr_[i].vs1 = *reinterpret_cast<const bf16x8*>(&vt_[(long)(32 + sr) * LDK + sc]); \
    sr_[i].ks0 = *reinterpret_cast<const bf16x8*>(&kt_[(long)sr * LDK + sc]); sr_[i].ks1 = *reinterpret_cast<const bf16x8*>(&kt_[(long)(32 + sr) * LDK + sc]); } while (0)
#define SWRITE(b, i) do { *(bf16x8*)((char*)V_lds + (b) * SHM_V + vst0) = sr_[i].vs0;          \
    *(bf16x8*)((char*)V_lds + (b) * SHM_V + vst1) = sr_[i].vs1; int kc = sc * 2;               \
    *(bf16x8*)((char*)K_lds + (b) * SHM_K + KSWZ(sr, kc)) = sr_[i].ks0;                       \
    *(bf16x8*)((char*)K_lds + (b) * SHM_K + KSWZ(32 + sr, kc)) = sr_[i].ks1; } while (0)
#define SWAIT() do { if constexpr (SD == 2) asm volatile("s_waitcnt vmcnt(4)" ::: "memory"); else asm volatile("s_waitcnt vmcnt(0)" ::: "memory"); } while (0)
#define RESC(a) do { if (__any((a) < 1.f)) { if (hi == 0) al_l[r32] = (a); asm volatile("s_waitcnt lgkmcnt(0)" ::: "memory"); \
    for (int d = 0; d < 4; ++d) for (int r = 0; r < 16; ++r) o[d][r] *= al_l[crow(r, hi)]; } } while (0)
  f32x16 pA0, pA1, pB0, pB1; float mnA, mnB, alA, alB; bf16x8 pa0, pa1, pa2, pa3;
  constexpr int SE = 0, SO = SD - 1;
  SLOAD(SE, 0); asm volatile("s_waitcnt vmcnt(0)" ::: "memory"); SWRITE(0, SE); __syncthreads();
  qkt(pA0, pA1, K_lds, Q_lds, qrow, r32, hi); bias(pA0, pA1, 0, wid, r32, hi); partialSM(pA0, pA1, m_reg, mnA, alA);
  SLOAD(SO, 1); if constexpr (SD == 2) { if (2 < NT) SLOAD(SE, 2); }
  SWAIT(); SWRITE(1, SO); __syncthreads();
  for (int j = 1; j + 1 < NT; j += 2) {
    SBAR(); qkt(pB0, pB1, (bf16_t*)((char*)K_lds + SHM_K), Q_lds, qrow, r32, hi); bias(pB0, pB1, j, wid, r32, hi);
    finishSM(pA0, pA1, alA, l_reg, pa0, pa1, pa2, pa3); SBAR();
    SLOAD(SO, j + SD); SBAR();
    pv_d0(o, vb0, pa0, pa1, pa2, pa3); partialSM(pB0, pB1, m_reg, mnB, alB);
    __syncthreads(); SWAIT(); SWRITE(0, SE);
    RESC(alB); __syncthreads();
    SBAR(); qkt(pA0, pA1, K_lds, Q_lds, qrow, r32, hi); bias(pA0, pA1, j + 1, wid, r32, hi);
    finishSM(pB0, pB1, alB, l_reg, pa0, pa1, pa2, pa3); SBAR();
    if (SD == 1 || j + 3 < NT) SLOAD(SE, j + 1 + SD); SBAR();
    pv_d0(o, vb0 + (int)SHM_V, pa0, pa1, pa2, pa3); partialSM(pA0, pA1, m_reg, mnA, alA);
    __syncthreads(); SWAIT(); SWRITE(1, SO);
    RESC(alA); __syncthreads();
  }
  SBAR(); qkt(pB0, pB1, (bf16_t*)((char*)K_lds + SHM_K), Q_lds, qrow, r32, hi); bias(pB0, pB1, NT - 1, wid, r32, hi);
  finishSM(pA0, pA1, alA, l_reg, pa0, pa1, pa2, pa3); SBAR();
  pv_d0(o, vb0, pa0, pa1, pa2, pa3); partialSM(pB0, pB1, m_reg, mnB, alB);
  __syncthreads(); RESC(alB);
  finishSM(pB0, pB1, alB, l_reg, pa0, pa1, pa2, pa3); SBAR();
  pv_d0(o, vb0 + (int)SHM_V, pa0, pa1, pa2, pa3);
  if (hi == 0) li_l[r32] = l_reg; asm volatile("s_waitcnt lgkmcnt(0)" ::: "memory");
  float rli[16];
#pragma unroll
  for (int r = 0; r < 16; ++r) rli[r] = __builtin_amdgcn_rcpf(li_l[crow(r, hi)]);
  bf16_t* Ow = Ob + (long)(wid * QBLK) * LDO;
#pragma unroll
  for (int r = 0; r < 16; ++r) { int orow = crow(r, hi);
    for (int d0 = 0; d0 < 4; ++d0) Ow[(long)orow * LDO + d0 * 32 + r32] = f2bf(o[d0][r] * rli[r]); }
#undef SLOAD
#undef SWRITE
#undef SWAIT
#undef RESC
}
}
namespace gdn {
using att::bf16x8; using att::f32x16; using att::crow;
constexpr int C = 32, SK = 136, SS = 40;
constexpr int OFF_KT = 0, OFF_QT = OFF_KT + C * SK * 2, OFF_W = OFF_QT + C * SK * 2, OFF_KTT = OFF_W + C * SK * 2, OFF_VTT = OFF_KTT + 128 * SS * 2,
              OFF_VN = OFF_VTT + 128 * SS * 2, OFF_VNS = OFF_VN + 128 * SS * 2, OFF_ST = OFF_VNS + 128 * SS * 2, OFF_TB = OFF_ST + 128 * SK * 2,
              OFF_TBE = OFF_TB + C * SS * 2, OFF_ATT = OFF_TBE + C * SS * 2, OFF_L = OFF_ATT + C * SS * 2, OFF_SC = OFF_L + C * C * 4, GDN_LDS = OFF_SC + 1024;
template <int K>
__device__ __forceinline__ f32x16 mm(const bf16_t* A, int lda, const bf16_t* Bt, int ldb, int l32, int hi, f32x16 acc) {
#pragma unroll
    for (int k0 = 0; k0 < K; k0 += 16) {
        const bf16x8 a = *reinterpret_cast<const bf16x8*>(A + l32 * lda + k0 + 8 * hi);
        const bf16x8 b = *reinterpret_cast<const bf16x8*>(Bt + l32 * ldb + k0 + 8 * hi);
        acc = __builtin_amdgcn_mfma_f32_32x32x16_bf16(a, b, acc, 0, 0, 0);
    }
    return acc;
}
__device__ __forceinline__ uint2 pk4(float a, float b, float c, float d) { uint2 w; w.x = pack2(a, b); w.y = pack2(c, d); return w; }

__device__ __forceinline__ void gdn_chunked(const Params& p, int l, bool ctx, int b, int h, int dir, unsigned char* lds) {
    const int tid = opaque_tid(), wid = tid >> 6, lane = tid & 63, l32 = lane & 31, hi = lane >> 5;
    const int T = ctx ? CT : ::LT; const size_t m0 = ctx ? (size_t)b * CT : (size_t)MC + (size_t)b * ::LT;
    const bf16_t* DQ = WSP(bf16_t, WS_DQ); const bf16_t* DK = WSP(bf16_t, WS_DK); const bf16_t* DV = WSP(bf16_t, WS_DV); const float* DBA = WSP(float, WS_DBA);
    float* O = WSP(float, dir ? WS_DOB : WS_DOF);
    bf16_t* Kt = (bf16_t*)(lds + OFF_KT); bf16_t* Qt = (bf16_t*)(lds + OFF_QT); bf16_t* W = (bf16_t*)(lds + OFF_W); bf16_t* KT = (bf16_t*)(lds + OFF_KTT); bf16_t* VT = (bf16_t*)(lds + OFF_VTT);
    bf16_t* VN = (bf16_t*)(lds + OFF_VN); bf16_t* VNS = (bf16_t*)(lds + OFF_VNS); bf16_t* ST = (bf16_t*)(lds + OFF_ST); bf16_t* TB = (bf16_t*)(lds + OFF_TB); bf16_t* TBE = (bf16_t*)(lds + OFF_TBE);
    bf16_t* ATT = (bf16_t*)(lds + OFF_ATT); float* Lm = (float*)(lds + OFF_L); float* sc = (float*)(lds + OFF_SC);
    const int nch = T / C;
#define TOK(c, s_) (m0 + (dir ? T - 1 - ((c) * C + (s_)) : (c) * C + (s_)))
    f32x16 S[2];
#pragma unroll
    for (int bi = 0; bi < 2; ++bi) {
        const int blk = wid * 2 + bi, d0 = 32 * (blk >> 2), e0 = 32 * (blk & 3);
        if (ctx) { S[bi] = f32x16{}; }
        else {
            const float* s0 = p.in[I_SGDN] + ((((size_t)b * DEPTH + l) * 2 + dir) * 4 + h) * 128 * 128 + e0 + l32;
#pragma unroll
            for (int r = 0; r < 16; ++r) S[bi][r] = s0[(size_t)(d0 + crow(r, hi)) * 128];
        }
    }
    const int ls = tid >> 5, lc = (tid & 31) * 4;
    vf4 pq0, pq1, pk0, pk1, pv0, pv1; float pbeta = 0.f, pg = 0.f;
#define GLOAD(c) do { const size_t ma = TOK(c, ls), mb = TOK(c, ls + 16); \
        pq0 = ld4bf(DQ + ma * 512 + h * 128 + lc); pq1 = ld4bf(DQ + mb * 512 + h * 128 + lc); \
        pk0 = ld4bf(DK + ma * 512 + h * 128 + lc); pk1 = ld4bf(DK + mb * 512 + h * 128 + lc); \
        pv0 = ld4bf(DV + ma * 512 + h * 128 + lc); pv1 = ld4bf(DV + mb * 512 + h * 128 + lc); \
        if (tid < C) { const size_t mt = TOK(c, tid); pbeta = DBA[mt * 16 + dir * 4 + h]; pg = DBA[mt * 16 + 8 + dir * 4 + h]; } } while (0)
#define GSTAGE() do { \
        *(uint2*)(Kt + ls * SK + lc) = pk4(pk0.x, pk0.y, pk0.z, pk0.w); *(uint2*)(Kt + (ls + 16) * SK + lc) = pk4(pk1.x, pk1.y, pk1.z, pk1.w); \
        *(uint2*)(Qt + ls * SK + lc) = pk4(pq0.x, pq0.y, pq0.z, pq0.w); *(uint2*)(Qt + (ls + 16) * SK + lc) = pk4(pq1.x, pq1.y, pq1.z, pq1.w); \
        _Pragma("unroll") for (int j = 0; j < 4; ++j) { KT[(lc + j) * SS + ls] = f2bf(pk0[j]); KT[(lc + j) * SS + ls + 16] = f2bf(pk1[j]); \
                                                        VT[(lc + j) * SS + ls] = f2bf(pv0[j]); VT[(lc + j) * SS + ls + 16] = f2bf(pv1[j]); } \
        if (wid == 0) { float x = pg; _Pragma("unroll") for (int o_ = 1; o_ < 32; o_ <<= 1) { const float y = __shfl_up(x, o_); if (lane >= o_) x += y; } \
            const float Bt_ = __shfl(x, 31); if (lane < C) { sc[lane] = pbeta; sc[32 + lane] = x; sc[64 + lane] = __expf(x); sc[96 + lane] = __expf(Bt_ - x); if (lane == 0) sc[128] = __expf(Bt_); } } } while (0)
    __syncthreads();
    GLOAD(0);
#pragma unroll
    for (int bi = 0; bi < 2; ++bi) {
        const int blk = wid * 2 + bi, d0 = 32 * (blk >> 2), e0 = 32 * (blk & 3);
#pragma unroll
        for (int g = 0; g < 4; ++g) *(uint2*)(ST + (e0 + l32) * SK + d0 + 8 * g + 4 * hi) = pk4(S[bi][4 * g], S[bi][4 * g + 1], S[bi][4 * g + 2], S[bi][4 * g + 3]);
    }
    GSTAGE();
    __syncthreads();
    for (int c = 0; c < nch; ++c) {
        if (c + 1 < nch) GLOAD(c + 1);
        f32x16 acc1 = f32x16{};
        if (wid == 0) {
            const f32x16 kk = mm<128>(Kt, SK, Kt, SK, l32, hi, f32x16{});
            const float bi_ = sc[32 + l32], be = sc[l32];
#pragma unroll
            for (int r = 0; r < 16; ++r) { const int j = crow(r, hi); const float v = (l32 > j) ? be * kk[r] * __expf(bi_ - sc[32 + j]) : 0.f;
                Lm[l32 * 32 + ((r & 3) + 4 * hi) * 4 + (r >> 2)] = v; }
        } else if (wid == 1) {
            const f32x16 kq = mm<128>(Kt, SK, Qt, SK, l32, hi, f32x16{});
            const float bi_ = sc[32 + l32];
            float a[16];
#pragma unroll
            for (int r = 0; r < 16; ++r) { const int j = crow(r, hi); a[r] = (l32 >= j) ? kq[r] * __expf(bi_ - sc[32 + j]) : 0.f; }
#pragma unroll
            for (int g = 0; g < 4; ++g) *(uint2*)(ATT + l32 * SS + 8 * g + 4 * hi) = pk4(a[4 * g], a[4 * g + 1], a[4 * g + 2], a[4 * g + 3]);
        } else if (wid >= 4) {
            acc1 = mm<128>(Qt, SK, ST + (32 * (wid - 4)) * SK, SK, l32, hi, f32x16{});
#pragma unroll
            for (int r = 0; r < 16; ++r) acc1[r] *= sc[64 + crow(r, hi)];
        }
        __syncthreads();
        if (tid < 256) {
            const int cc = tid >> 3, part = tid & 7;
            float Tr[4] = {0.f, 0.f, 0.f, 0.f};
            const float* Lp = Lm + part * 4;
#pragma unroll
            for (int i = 0; i < 32; ++i) {
                const vf4 lv = *(const vf4*)(Lp + i * 32);
                float s = lv.x * Tr[0] + lv.y * Tr[1] + lv.z * Tr[2] + lv.w * Tr[3];
                s = red8(s);
                const float t = (i == cc ? 1.f : 0.f) - s;
                if (part == (i & 7)) Tr[i >> 3] = t;
            }
            const float bc = sc[cc], bec = bc * sc[64 + cc];
#pragma unroll
            for (int jj = 0; jj < 4; ++jj) { TB[(part + 8 * jj) * SS + cc] = f2bf(Tr[jj] * bc); TBE[(part + 8 * jj) * SS + cc] = f2bf(Tr[jj] * bec); }
        }
        __syncthreads();
        if (wid < 4) {
            acc1 = mm<32>(TB, SS, VT + (32 * wid) * SS, SS, l32, hi, f32x16{});
        } else {
            const int d0 = 32 * (wid - 4);
            const f32x16 wt = mm<32>(KT + d0 * SS, SS, TBE, SS, l32, hi, f32x16{});
#pragma unroll
            for (int g = 0; g < 4; ++g) *(uint2*)(W + l32 * SK + d0 + 8 * g + 4 * hi) = pk4(wt[4 * g], wt[4 * g + 1], wt[4 * g + 2], wt[4 * g + 3]);
        }
        __syncthreads();
        if (wid < 4) {
            const int e0 = 32 * wid;
            const f32x16 ws = mm<128>(W, SK, ST + e0 * SK, SK, l32, hi, f32x16{});
            float vn[16], vs[16];
#pragma unroll
            for (int r = 0; r < 16; ++r) { vn[r] = acc1[r] - ws[r]; vs[r] = vn[r] * sc[96 + crow(r, hi)]; }
#pragma unroll
            for (int g = 0; g < 4; ++g) { *(uint2*)(VN + (e0 + l32) * SS + 8 * g + 4 * hi) = pk4(vn[4 * g], vn[4 * g + 1], vn[4 * g + 2], vn[4 * g + 3]);
                                          *(uint2*)(VNS + (e0 + l32) * SS + 8 * g + 4 * hi) = pk4(vs[4 * g], vs[4 * g + 1], vs[4 * g + 2], vs[4 * g + 3]); }
        }
        __syncthreads();
        if (wid >= 4) {
            const int e0 = 32 * (wid - 4);
            acc1 = mm<32>(ATT, SS, VN + e0 * SS, SS, l32, hi, acc1);
#pragma unroll
            for (int r = 0; r < 16; ++r) O[TOK(c, crow(r, hi)) * 512 + h * 128 + e0 + l32] = acc1[r];
        }
        {
            const float eB = sc[128];
#pragma unroll
            for (int bi = 0; bi < 2; ++bi) {
                const int blk = wid * 2 + bi, d0 = 32 * (blk >> 2), e0 = 32 * (blk & 3);
#pragma unroll
                for (int r = 0; r < 16; ++r) S[bi][r] *= eB;
                S[bi] = mm<32>(KT + d0 * SS, SS, VNS + e0 * SS, SS, l32, hi, S[bi]);
            }
        }
        __syncthreads();
#pragma unroll
        for (int bi = 0; bi < 2; ++bi) {
            const int blk = wid * 2 + bi, d0 = 32 * (blk >> 2), e0 = 32 * (blk & 3);
#pragma unroll
            for (int g = 0; g < 4; ++g) *(uint2*)(ST + (e0 + l32) * SK + d0 + 8 * g + 4 * hi) = pk4(S[bi][4 * g], S[bi][4 * g + 1], S[bi][4 * g + 2], S[bi][4 * g + 3]);
        }
        if (c + 1 < nch) GSTAGE();
        __syncthreads();
    }
#undef GLOAD
#undef GSTAGE
#undef TOK
    if (ctx) {
#pragma unroll
        for (int bi = 0; bi < 2; ++bi) {
            const int blk = wid * 2 + bi, d0 = 32 * (blk >> 2), e0 = 32 * (blk & 3);
            float* so = p.out + O_SGDN + ((((size_t)b * DEPTH + l) * 2 + dir) * 4 + h) * 128 * 128 + e0 + l32;
#pragma unroll
            for (int r = 0; r < 16; ++r) so[(size_t)(d0 + crow(r, hi)) * 128] = S[bi][r];
        }
    }
}
}

namespace gla {
using att::bf16x8; using att::f32x16; using att::crow; using gdn::mm; using gdn::pk4;
constexpr int C = 32, SQ = 72, SS = 40;
constexpr int OFF_QE = 0, OFF_KN = OFF_QE + C * SQ * 2, OFF_KET = OFF_KN + C * SQ * 2, OFF_VT = OFF_KET + 64 * SS * 2, OFF_ATT = OFF_VT + 128 * SS * 2, OFF_ST = OFF_ATT + C * SS * 2,
              OFF_LA = OFF_ST + 128 * SQ * 2, OFF_EB = OFF_LA + C * 64 * 4, GLA_LDS = OFF_EB + 256;
__device__ __forceinline__ void gla_chunked(const Params& p, int l, bool ctx, int b, int h, int dir, unsigned char* lds) {
    const int tid = opaque_tid(), wid = tid >> 6, lane = tid & 63, l32 = lane & 31, hi = lane >> 5;
    const int T = ctx ? CT : ::LT; const size_t m0 = ctx ? (size_t)b * CT : (size_t)MC + (size_t)b * ::LT;
    const bf16_t* Z = WSP(bf16_t, WS_Z); const float* LA = WSP(float, dir ? WS_AB : WS_AF);
    float* O = WSP(float, dir ? WS_GOB : WS_GOF);
    bf16_t* Qe = (bf16_t*)(lds + OFF_QE); bf16_t* Kn = (bf16_t*)(lds + OFF_KN); bf16_t* KeT = (bf16_t*)(lds + OFF_KET); bf16_t* VT = (bf16_t*)(lds + OFF_VT);
    bf16_t* ATT = (bf16_t*)(lds + OFF_ATT); bf16_t* ST = (bf16_t*)(lds + OFF_ST); float* la = (float*)(lds + OFF_LA); float* eB = (float*)(lds + OFF_EB);
    const int nch = T / C;
#define TOK(c, s_) (m0 + (dir ? T - 1 - ((c) * C + (s_)) : (c) * C + (s_)))
    const int d0 = 32 * (wid >> 2), e0 = 32 * (wid & 3);
    f32x16 S;
    if (ctx) S = f32x16{};
    else {
        const float* s0 = p.in[I_SGLA] + ((((size_t)b * DEPTH + l) * 2 + dir) * 4 + h) * 64 * 128 + e0 + l32;
#pragma unroll
        for (int r = 0; r < 16; ++r) S[r] = s0[(size_t)(d0 + crow(r, hi)) * 128];
    }
    const int ts = tid >> 4, dc = (tid & 15) * 4, vs = tid >> 5, vc = (tid & 31) * 4;
    vf4 pq, pk, pl, pv0, pv1;
#define GLOAD(c) do { const size_t mt = TOK(c, ts), ma = TOK(c, vs), mb = TOK(c, vs + 16); \
        pq = ld4bf(Z + mt * NINP + Z_GLQ + h * 64 + dc); pk = ld4bf(Z + mt * NINP + Z_GLK + h * 64 + dc); pl = *(const vf4*)(LA + mt * 256 + h * 64 + dc); \
        pv0 = ld4bf(Z + ma * NINP + Z_GLV + h * 128 + vc); pv1 = ld4bf(Z + mb * NINP + Z_GLV + h * 128 + vc); } while (0)
#define WRITE_ST() do { _Pragma("unroll") for (int g = 0; g < 4; ++g) *(uint2*)(ST + (e0 + l32) * SQ + d0 + 8 * g + 4 * hi) = pk4(S[4 * g], S[4 * g + 1], S[4 * g + 2], S[4 * g + 3]); } while (0)
#define GIMAGES() do { vf4 pre = (vf4){0.f, 0.f, 0.f, 0.f}, tot = pre; \
        _Pragma("unroll 8") for (int t_ = 0; t_ < C; ++t_) { const vf4 v_ = *(const vf4*)(la + t_ * 64 + dc); tot += v_; if (t_ <= ts) pre += v_; } \
        float qe[4], kn[4]; \
        _Pragma("unroll") for (int j = 0; j < 4; ++j) { qe[j] = pq[j] * 0.125f * __expf(pre[j]); kn[j] = pk[j] * __expf(fminf(-pre[j], 80.f)); \
            KeT[(dc + j) * SS + ts] = f2bf(pk[j] * __expf(tot[j] - pre[j])); } \
        *(uint2*)(Qe + ts * SQ + dc) = pk4(qe[0], qe[1], qe[2], qe[3]); *(uint2*)(Kn + ts * SQ + dc) = pk4(kn[0], kn[1], kn[2], kn[3]); \
        if (ts == 0) { _Pragma("unroll") for (int j = 0; j < 4; ++j) eB[dc + j] = __expf(tot[j]); } \
        _Pragma("unroll") for (int j = 0; j < 4; ++j) { VT[(vc + j) * SS + vs] = f2bf(pv0[j]); VT[(vc + j) * SS + vs + 16] = f2bf(pv1[j]); } } while (0)
    __syncthreads();
    GLOAD(0);
    WRITE_ST();
    *(vf4*)(la + ts * 64 + dc) = pl;
    __syncthreads();
    GIMAGES();
    __syncthreads();
    for (int c = 0; c < nch; ++c) {
        if (c + 1 < nch) GLOAD(c + 1);
        f32x16 o1 = f32x16{};
        if (wid == 0) {
            const f32x16 kq = mm<64>(Kn, SQ, Qe, SQ, l32, hi, f32x16{});
            float a[16];
#pragma unroll
            for (int r = 0; r < 16; ++r) a[r] = (l32 >= crow(r, hi)) ? kq[r] : 0.f;
#pragma unroll
            for (int g = 0; g < 4; ++g) *(uint2*)(ATT + l32 * SS + 8 * g + 4 * hi) = pk4(a[4 * g], a[4 * g + 1], a[4 * g + 2], a[4 * g + 3]);
        } else if (wid >= 4) {
            o1 = mm<64>(Qe, SQ, ST + (32 * (wid - 4)) * SQ, SQ, l32, hi, f32x16{});
        }
        __syncthreads();
        if (wid >= 4) {
            const int eo = 32 * (wid - 4);
            o1 = mm<32>(ATT, SS, VT + eo * SS, SS, l32, hi, o1);
#pragma unroll
            for (int r = 0; r < 16; ++r) O[TOK(c, crow(r, hi)) * 512 + h * 128 + eo + l32] = o1[r];
        }
#pragma unroll
        for (int r = 0; r < 16; ++r) S[r] *= eB[d0 + crow(r, hi)];
        S = mm<32>(KeT + d0 * SS, SS, VT + e0 * SS, SS, l32, hi, S);
        __syncthreads();
        WRITE_ST();
        if (c + 1 < nch) *(vf4*)(la + ts * 64 + dc) = pl;
        __syncthreads();
        if (c + 1 < nch) GIMAGES();
        __syncthreads();
    }
#undef GLOAD
#undef WRITE_ST
#undef GIMAGES
#undef TOK
    if (ctx) {
        float* so = p.out + O_SGLA + ((((size_t)b * DEPTH + l) * 2 + dir) * 4 + h) * 64 * 128 + e0 + l32;
#pragma unroll
        for (int r = 0; r < 16; ++r) so[(size_t)(d0 + crow(r, hi)) * 128] = S[r];
    }
}
}
#define LAS __attribute__((address_space(3)))
constexpr int LDS_BYTES = 147456, XBW_OFF = LDS_BYTES - 64;
constexpr int NPH = 1 + DEPTH * 12;
#ifndef DBG_NLAYERS
#define DBG_NLAYERS DEPTH
#endif

#ifndef DUPKIND
#define DUPKIND 0
#endif
__device__ __forceinline__ int opaque_int(int v) { asm volatile("" : "+s"(v)); return v; }
#ifndef MIXMASK
#define MIXMASK 0xFF
#endif
#define FOR_ITEMS(it, n, o, w) for (int bo_ = (o) * (int)gridDim.x / 256, bw_ = ((w) * (int)gridDim.x / 256) > 0 ? ((w) * (int)gridDim.x / 256) : 1, \
                                    it = ((int)blockIdx.x >= bo_ && (int)blockIdx.x < bo_ + bw_) ? (int)blockIdx.x - bo_ : (n); it < (n); it += bw_)

constexpr int TF0 = NT_L / 10, TF1 = NT_L / 4, TF2 = NT_L * 53 / 100, TF3 = NT_L * 88 / 100, MIXCONV_CH = 16, NI_CONV = (TF3 - TF2 + MIXCONV_CH - 1) / MIXCONV_CH;
#ifndef SPLITK
#define SPLITK 0
#endif
#ifndef SPLITK_G4
#define SPLITK_G4 0
#endif
constexpr int FLAG_WORD0 = 8192;
constexpr int QCTR_WORD0 = 1024;
constexpr int NI_GDNL = LB * 8, NI_GLAL = LB * 8, NI_GDNC = CB * 8, NI_GQAL = LB * 16, NI_NAL = LB * 16, NI_GLAC = CB * 8, NI_NAC = CB * 4, NI_GQAC = CB * 4;
#define KM(k) (1 + ((DUPKIND >> (k)) & 1))
constexpr int Q0 = NI_GDNL * KM(0), Q1 = Q0 + NI_GQAL * KM(1), Q2 = Q1 + NI_NAL * KM(2), Q3 = Q2 + NI_GLAL * KM(3), Q4 = Q3 + NI_GDNC * KM(4), Q5 = Q4 + NI_NAC * KM(5), Q6 = Q5 + NI_GQAC * KM(6), Q7 = Q6 + NI_GLAC * KM(7);
__device__ __forceinline__ void phase_mix(const Params& p, int l, unsigned char* lds, int rep) {
    const int tid = opaque_tid();
    float* smem = (float*)lds;
    const bf16_t* NAQ = WSP(bf16_t, WS_NAQ); const bf16_t* NAK = WSP(bf16_t, WS_NAK); const bf16_t* NAV = WSP(bf16_t, WS_NAV);
    const bf16_t* GQ = WSP(bf16_t, WS_GQ); const bf16_t* GK = WSP(bf16_t, WS_GK); const bf16_t* GV = WSP(bf16_t, WS_GV);
    bf16_t* MRG = WSP(bf16_t, WS_MRG);
    unsigned* qctr = WSP(unsigned, WS_CTL) + QCTR_WORD0 + 64 * l + 16 * rep;
    volatile int* qslot = (volatile int*)(lds + XBW_OFF + 16);
    for (;;) {
        __syncthreads();
        if (tid == 0) *qslot = (int)__hip_atomic_fetch_add(qctr, 1u, __ATOMIC_RELAXED, __HIP_MEMORY_SCOPE_AGENT);
        __syncthreads();
        const int q = __builtin_amdgcn_readfirstlane(*qslot);
        if (q >= Q7 + ((CONV_FILLER && l + 1 < DBG_NLAYERS) ? NI_CONV : 0)) break;
        if (q < Q0) { const int it = q % NI_GDNL; gdn::gdn_chunked(p, l, false, it / 8, (it / 2) % 4, it % 2, lds); }
        else if (q < Q1) {
            const int it = (q - Q0) % NI_GQAL, b = it / 16, qh = (it / 4) % 4, qb = it % 4, kvh = qh >> 1;
            const size_t r0 = (size_t)MC + (size_t)b * LT;
            att::SrcTwo src{WSP(bf16_t, WS_CGK) + ((size_t)b * DEPTH + l) * 256 * 256 + kvh * 128, WSP(bf16_t, WS_CGV) + ((size_t)b * DEPTH + l) * 256 * 256 + kvh * 128,
                            GK + r0 * 256 + kvh * 128, GV + r0 * 256 + kvh * 128, 256};
            att::attn_body<2>(GQ + (r0 + qb * 256) * 512 + qh * 128, src, MRG + (r0 + qb * 256) * DM + 1024 + qh * 128, 4 + LT / 64, (char*)lds, att::NoBias{});
        }
        else if (q < Q2) {
            const int it = (q - Q1) % NI_NAL, b = it / 16, h = (it / 4) % 4, qb = it % 4;
            const int kr0 = qb == 0 ? 0 : qb == 1 ? 0 : qb == 2 ? 4 : 8, nrows = (qb == 0 || qb == 3) ? 8 : 12;
            const size_t r0 = (size_t)MC + (size_t)b * LT;
            float* tab = (float*)(lds + att::SHM_ATTN);
            if (tid < 15 * 31) tab[tid] = p.in[I_RPB][((size_t)l * 4 + h) * 15 * 31 + tid] * (1.0f / att::SCALE);
            att::SrcTwo src{WSP(bf16_t, WS_CNAK) + ((size_t)b * DEPTH + l) * 256 * 512 + h * 128, WSP(bf16_t, WS_CNAV) + ((size_t)b * DEPTH + l) * 256 * 512 + h * 128,
                            NAK + (r0 + kr0 * 64) * 512 + h * 128, NAV + (r0 + kr0 * 64) * 512 + h * 128, 512};
            att::attn_body<1>(NAQ + (r0 + qb * 256) * 512 + h * 128, src, MRG + (r0 + qb * 256) * DM + 0 + h * 128, 4 + nrows, (char*)lds, att::NaBias{tab, qb * 256, kr0});
        }
        else if (q < Q3) { const int it = (q - Q2) % NI_GLAL; gla::gla_chunked(p, l, false, it / 8, (it / 2) % 4, it % 2, lds); }
        else if (q < Q4) { const int it = (q - Q3) % NI_GDNC; gdn::gdn_chunked(p, l, true, it / 8, (it / 2) % 4, it % 2, lds); }
        else if (q < Q5) {
            const int it = (q - Q4) % NI_NAC, b = it / 4, h = it % 4; const size_t r0 = (size_t)b * CT;
            att::SrcOne src{NAK + r0 * 512 + h * 128, NAV + r0 * 512 + h * 128, 512};
            att::attn_body<2>(NAQ + r0 * 512 + h * 128, src, MRG + r0 * DM + 0 + h * 128, CT / 64, (char*)lds, att::NoBias{});
        }
        else if (q < Q6) {
            const int it = (q - Q5) % NI_GQAC, b = it / 4, qh = it % 4, kvh = qh >> 1; const size_t r0 = (size_t)b * CT;
            att::SrcOne src{GK + r0 * 256 + kvh * 128, GV + r0 * 256 + kvh * 128, 256};
            att::attn_body<2>(GQ + r0 * 512 + qh * 128, src, MRG + r0 * DM + 1024 + qh * 128, CT / 64, (char*)lds, att::NoBias{});
        }
        else if (q < Q7) { const int it = (q - Q6) % NI_GLAC; gla::gla_chunked(p, l, true, it / 8, (it / 2) % 4, it % 2, lds); }
        else { const int t0 = TF2 + (q - Q7) * MIXCONV_CH, t1 = t0 + MIXCONV_CH < TF3 ? t0 + MIXCONV_CH : TF3; conv_layer_tiles(p, l + 1, t0, t1, 0, 1, (float*)lds); }
    }
}

#define CONV_FILL(nunits, t0, t1, skip) do { if (l + 1 < DBG_NLAYERS) { const int G_ = (int)gridDim.x; int f0_ = ((nunits) % G_) + (skip); if (f0_ >= G_) f0_ = 0; \
        if ((int)blockIdx.x >= f0_) { const Params q = opaque_params(p); conv_layer_tiles(q, l + 1, (t0), (t1), (int)blockIdx.x - f0_, G_ - f0_, (float*)lds); } } } while (0)
#define G1A_MSPLIT (G1A_MODE == 1 ? 2 : 0)
#define G1B_MSPLIT (G1B_MODE == 1 ? 2 : 0)
#ifndef MSPLIT
#define MSPLIT 2
#endif
static_assert(att::SHM_ATTN + 15 * 31 * 4 + 2048 <= (size_t)XBW_OFF, "LDS map");
static_assert((QCTR_WORD0 + 64 * DEPTH) < 4096, "ctl");
constexpr int BAR_WORD0 = 4096;
static_assert((BAR_WORD0 + XCD_BAR_WORDS) * 4 <= (int)CTL_BYTES, "ctl");

__global__ void __launch_bounds__(512, 2) fwd(Params p) {
    extern __shared__ __attribute__((aligned(16))) unsigned char lds[];
    const int tid = threadIdx.x;
    volatile LAS unsigned* xbw = (volatile LAS unsigned*)((LAS unsigned char*)lds + XBW_OFF);
    if (tid < 4) xbw[tid] = 0u;
    __syncthreads();
    XcdBarrier bar; bar.bar = WSP(unsigned, WS_CTL) + BAR_WORD0; bar.x = 0; bar.st = xbw;
    if (p.ph_hi - p.ph_lo > 1) bar = xcd_barrier_post(WSP(unsigned, WS_CTL) + BAR_WORD0, xbw);
#ifndef PHMASK
#define PHMASK 0x1FFF
#endif
#define IN(k) (p.ph_lo <= (k) && (k) < p.ph_hi)
#define INL(j) (((PHMASK >> ((j) + 1)) & 1) && IN(pb + (j)))
#ifndef DUPMASK
#define DUPMASK 0
#endif
#define DUP(j) ((DUPMASK >> ((j) + 1)) & 1)
#if DUPMASK
#define REPS(j) opaque_int(1 + DUP(j))
#else
#define REPS(j) 1
#endif
#ifndef DBLBAR
#define DBLBAR 0
#endif
#define SEAM(k) do { if (IN(k) && IN((k) + 1)) { xcd_barrier(bar); if (DBLBAR) xcd_barrier(bar); } } while (0)
    LAS unsigned char* ldsl = (LAS unsigned char*)lds;
    bf16_t* H = WSP(bf16_t, WS_H); bf16_t* ACT = WSP(bf16_t, WS_ACT); float* X = WSP(float, WS_X); float* Z = WSP(float, WS_Z); bf16_t* MRG = WSP(bf16_t, WS_MRG);

    if ((PHMASK & 1) && IN(0)) { const int reps_ = (DUPMASK & 1) ? opaque_int(2) : 1; for (int rep_ = 0; rep_ < reps_; ++rep_) { const Params q = opaque_params(p); phase_prologue(q, (float*)lds); __syncthreads(); } }
    SEAM(0);
    for (int l = 0; l < DBG_NLAYERS; ++l) {
        const int pb = 1 + l * 12;
        const float* modl = WSP(float, WS_MODV) + (size_t)l * NCOND * NMOD;
        if (INL(0)) { const int reps_ = REPS(0); for (int rep_ = 0; rep_ < reps_; ++rep_) { const Params q = opaque_params(p); phase_norm(q, l, 0); __syncthreads(); } }
        SEAM(pb + 0);
        if (INL(1)) {
            if (g1_fp8(l, 0)) {
                pg8::Gemm g{H, (const bf16_t*)(WSP(unsigned char, WS_WGU) + ((size_t)l * 2 + 0) * NGU * DM * 2), M, NGU, DM / 2}; pg8::StaticOrder S; S.init(M, NGU, DM / 2, (int)gridDim.x, (int)blockIdx.x, 2);
                pg8::EpiSwiGLU8 E{WSP(unsigned char, WS_ACT), FFP, 1.0f / WGU_SCALE};
                pg8::gemm_phase<pg8::EpiSwiGLU8, pg8::StaticOrder, false, 1>(ldsl, g, S, E, nullptr);
            } else {
                pg8::Gemm g{H, WSP(bf16_t, WS_WGU) + ((size_t)l * 2 + 0) * NGU * DM, M, NGU, DM}; pg8::StaticOrder S; S.init(M, NGU, DM, (int)gridDim.x, (int)blockIdx.x, 0);
                pg8::EpiSwiGLU8 E{WSP(unsigned char, WS_ACT), FFP, 1.0f};
                pg8::gemm_phase<pg8::EpiSwiGLU8, pg8::StaticOrder, false, 0>(ldsl, g, S, E, nullptr);
            }
#if CONV_FILLER
            if (l + 1 < DBG_NLAYERS) {
                const int nw_ = (M / 256) * (NGU / 256), G_ = (int)gridDim.x; int f0_ = nw_ % G_; if (nw_ < G_) f0_ = 0;
                if (g1_fp8(l, 0)) f0_ = 2 * f0_ < G_ ? 2 * f0_ : f0_;
                const int nmb_ = (G_ - f0_ < NMOD / 128) ? (G_ - f0_) : NMOD / 128;
                if ((int)blockIdx.x >= f0_ && (int)blockIdx.x < f0_ + nmb_) { const Params q = opaque_params(p); mod_layer(q, l + 1, (int)blockIdx.x - f0_, nmb_, (float*)lds); }
            }
            CONV_FILL((M / 256) * (NGU / 256), 0, TF0, NMOD / 128 + (g1_fp8(l, 0) ? ((M / 256) * (NGU / 256)) % (int)gridDim.x : 0));
#endif
        }
        SEAM(pb + 1);
        if (INL(2)) {
            pg8::Gemm g{ACT, G2_FP8 ? (const bf16_t*)(WSP(unsigned char, WS_WDN) + ((size_t)l * 2 + 0) * DM * FFP) : WSP(bf16_t, WS_WDN) + ((size_t)l * 2 + 0) * DM * FF, M, DM, G2_FP8 ? FFP / 2 : FF}; pg8::StaticOrder S; S.init(M, DM, G2_FP8 ? FFP / 2 : FF, (int)gridDim.x, (int)blockIdx.x, SPLITK ? 1 : MSPLIT);
            pg8::EpiResid E{l == 0 ? p.in[I_XP] : X, X, DM, modl + 2 * DM, G2_FP8 ? 0.5f / WDN_SCALE : 0.5f, Z, WSP(unsigned, WS_CTL) + FLAG_WORD0, 8u * (unsigned)(l * (2 * SPLITK + SPLITK_G4) + SPLITK), l == 0 ? p.in[I_XS] : X, l == 0 ? MC : 0x7FFFFFFF};
            pg8::gemm_phase<pg8::EpiResid, pg8::StaticOrder, false, (G2_FP8 ? 1 : 0)>(ldsl, g, S, E, nullptr);
#if DUPMASK
            if (opaque_int(DUP(2))) { pg8::EpiResid E2{X, Z, DM, modl + 2 * DM, 0.5f, Z, WSP(unsigned, WS_CTL) + FLAG_WORD0, 0u, X, 0x7FFFFFFF}; pg8::gemm_phase<pg8::EpiResid, pg8::StaticOrder, false>(ldsl, g, S, E2, nullptr); }
#endif
        }
        SEAM(pb + 2);
        if (INL(3)) { const int reps_ = REPS(3); for (int rep_ = 0; rep_ < reps_; ++rep_) { const Params q = opaque_params(p); phase_norm(q, l, 1); __syncthreads(); } }
        SEAM(pb + 3);
        if (INL(4)) {
            pg8::Gemm g{H, WSP(bf16_t, WS_WIN) + (size_t)l * NINP * DM, M, NINP, DM}; pg8::StaticOrder S; S.init(M, NINP, DM, (int)gridDim.x, (int)blockIdx.x);
            pg8::EpiBf16Plain E{WSP(bf16_t, WS_Z), NINP};
            for (int r_ = 0, n_ = REPS(4); r_ < n_; ++r_) pg8::gemm_phase<pg8::EpiBf16Plain, pg8::StaticOrder, false>(ldsl, g, S, E, nullptr);
#if CONV_FILLER
            CONV_FILL((M / 256) * (NINP / 256), TF0, TF1, 0);
#endif
        }
        SEAM(pb + 4);
        if (INL(5)) { const int reps_ = REPS(5); for (int rep_ = 0; rep_ < reps_; ++rep_) { const Params q = opaque_params(p); phase_prep(q, l); __syncthreads(); } }
        SEAM(pb + 5);
        if (INL(6)) { const int reps_ = REPS(6); for (int rep_ = 0; rep_ < reps_; ++rep_) { const Params q = opaque_params(p); phase_mix(q, l, lds, rep_); __syncthreads(); } }
        SEAM(pb + 6);
        if (INL(7)) { const int reps_ = REPS(7); for (int rep_ = 0; rep_ < reps_; ++rep_) { const Params q = opaque_params(p); phase_post(q, l); __syncthreads(); } }
        SEAM(pb + 7);
        if (INL(8)) {
            pg8::Gemm g{MRG, WSP(bf16_t, WS_WOUT) + (size_t)l * DM * DM, M, DM, DM}; pg8::StaticOrder S; S.init(M, DM, DM, (int)gridDim.x, (int)blockIdx.x, SPLITK_G4);
            pg8::EpiResid E{X, X, DM, modl + 5 * DM, 1.0f, Z, WSP(unsigned, WS_CTL) + FLAG_WORD0, 8u * (unsigned)(l * (2 * SPLITK + SPLITK_G4) + SPLITK + SPLITK_G4), X, 0x7FFFFFFF};
            pg8::gemm_phase<pg8::EpiResid, pg8::StaticOrder, false>(ldsl, g, S, E, nullptr);
#if CONV_FILLER
            CONV_FILL((M / 256) * (DM / 256), TF1, TF2, 0);
#endif
#if DUPMASK
            if (opaque_int(DUP(8))) { pg8::EpiResid E2{X, Z, DM, modl + 5 * DM, 1.0f, Z, WSP(unsigned, WS_CTL) + FLAG_WORD0, 0u, X, 0x7FFFFFFF}; pg8::gemm_phase<pg8::EpiResid, pg8::StaticOrder, false>(ldsl, g, S, E2, nullptr); }
#endif
        }
        SEAM(pb + 8);
        if (INL(9)) { const int reps_ = REPS(9); for (int rep_ = 0; rep_ < reps_; ++rep_) { const Params q = opaque_params(p); phase_norm(q, l, 2); __syncthreads(); } }
        SEAM(pb + 9);
        if (INL(10)) {
            {
#if G1B_MODE
                pg8::Gemm g{H, (const bf16_t*)(WSP(unsigned char, WS_WGU) + ((size_t)l * 2 + 1) * NGU * DM * 2), M, NGU, DM / 2}; pg8::StaticOrder S; S.init(M, NGU, DM / 2, (int)gridDim.x, (int)blockIdx.x, G1B_MSPLIT);
                constexpr float ws_ = 1.0f / WGU_SCALE;
#else
                pg8::Gemm g{H, WSP(bf16_t, WS_WGU) + ((size_t)l * 2 + 1) * NGU * DM, M, NGU, DM}; pg8::StaticOrder S; S.init(M, NGU, DM, (int)gridDim.x, (int)blockIdx.x, G1B_MSPLIT);
                constexpr float ws_ = 1.0f;
#endif
#if G2_FP8
                pg8::EpiSwiGLU8 E{WSP(unsigned char, WS_ACT), FFP, ws_};
                pg8::gemm_phase<pg8::EpiSwiGLU8, pg8::StaticOrder, false, G1B_MODE>(ldsl, g, S, E, nullptr);
#else
                pg8::EpiSwiGLU E{ACT, FF};
                pg8::gemm_phase<pg8::EpiSwiGLU, pg8::StaticOrder, false, G1B_MODE>(ldsl, g, S, E, nullptr);
#endif
            }
#if CONV_FILLER
            CONV_FILL((M / 256) * (NGU / 256), TF3, NT_L, (G1B_MSPLIT ? ((M / 256) * (NGU / 256)) % (int)gridDim.x : 0));
#endif
        }
        SEAM(pb + 10);
        if (INL(11)) {
            pg8::Gemm g{ACT, G2_FP8 ? (const bf16_t*)(WSP(unsigned char, WS_WDN) + ((size_t)l * 2 + 1) * DM * FFP) : WSP(bf16_t, WS_WDN) + ((size_t)l * 2 + 1) * DM * FF, M, DM, G2_FP8 ? FFP / 2 : FF}; pg8::StaticOrder S; S.init(M, DM, G2_FP8 ? FFP / 2 : FF, (int)gridDim.x, (int)blockIdx.x, SPLITK ? 1 : MSPLIT);
            pg8::EpiResid E{X, (l == DEPTH - 1) ? p.out : X, DM, modl + 8 * DM, G2_FP8 ? 0.5f / WDN_SCALE : 0.5f, Z, WSP(unsigned, WS_CTL) + FLAG_WORD0, 8u * (unsigned)(l * (2 * SPLITK + SPLITK_G4) + 2 * SPLITK + SPLITK_G4), X, 0x7FFFFFFF};
            pg8::gemm_phase<pg8::EpiResid, pg8::StaticOrder, false, (G2_FP8 ? 1 : 0)>(ldsl, g, S, E, nullptr);
        }
        SEAM(pb + 11);
    }
#undef IN
#undef SEAM
}

#ifndef MULTI_LAUNCH
#define MULTI_LAUNCH 0
#endif
extern "C" void kernel_launch(void* const* d_in, const int* in_sizes, int n_in, void* d_out, int out_size, void* d_ws, size_t ws_size, hipStream_t stream) {
    static int grid = 0;
    if (grid == 0) {
        if (n_in != N_IN || (size_t)out_size != O_END || ws_size < WS_END) { fprintf(stderr, "kernel_launch: shape mismatch n_in %d out %d ws %zu (need %zu)\n", n_in, out_size, ws_size, (size_t)WS_END); grid = -1; return; }
        int dev = 0, cus = 0, per_cu = 0;
        if (hipGetDevice(&dev) != hipSuccess || hipDeviceGetAttribute(&cus, hipDeviceAttributeMultiprocessorCount, dev) != hipSuccess) { grid = -1; return; }
        if (hipFuncSetAttribute((const void*)fwd, hipFuncAttributeMaxDynamicSharedMemorySize, LDS_BYTES) != hipSuccess) { fprintf(stderr, "kernel_launch: hipFuncSetAttribute failed\n"); grid = -1; return; }
        if (hipOccupancyMaxActiveBlocksPerMultiprocessor(&per_cu, (const void*)fwd, 512, LDS_BYTES) != hipSuccess || per_cu < 1) { fprintf(stderr, "kernel_launch: occupancy query says %d\n", per_cu); (void)hipGetLastError(); }
        grid = cus;
    }
    if (grid < 0) return;
    (void)hipMemsetAsync((char*)d_ws + WS_CTL, 0, CTL_BYTES, stream);
    Params p{};
    for (int i = 0; i < N_IN; ++i) p.in[i] = (const float*)d_in[i];
    p.out = (float*)d_out; p.ws = (unsigned char*)d_ws;
#if MULTI_LAUNCH
    for (int ph = 0; ph < 1 + DBG_NLAYERS * 12; ++ph) { p.ph_lo = ph; p.ph_hi = ph + 1; hipLaunchKernelGGL(fwd, dim3(grid), dim3(512), LDS_BYTES, stream, p); }
#else
    p.ph_lo = 0; p.ph_hi = NPH; hipLaunchKernelGGL(fwd, dim3(grid), dim3(512), LDS_BYTES, stream, p);
#endif
    const hipError_t le = hipPeekAtLastError();
    if (le != hipSuccess) fprintf(stderr, "kernel_launch: launch failed: %s\n", hipGetErrorName(le));
}
```

```cpp
#include <hip/hip_runtime.h>
#include <cstdio>
#include <cstdint>

#ifndef CB_
#define CB_ 16
#endif
#ifndef LB_
#define LB_ 8
#endif
#ifndef DEPTH_
#define DEPTH_ 4
#endif
#ifndef G1A_LAYERS
#define G1A_LAYERS 0xC
#endif
#ifndef G1A_MODE
#define G1A_MODE 0
#endif
#ifndef G1B_MODE
#define G1B_MODE 1
#endif
#ifndef XBF16
#define XBF16 0
#endif
#ifndef G2_FP8
#define G2_FP8 1
#endif
#ifndef FFN_FP8
#define FFN_FP8 (G1A_MODE != 0 || G1B_MODE != 0 || G2_FP8 != 0)
#endif
constexpr int DM = 2048, DEPTH = DEPTH_, CB = CB_, CT = 256, LB = LB_, LT = 1024;
constexpr int MC = CB * CT, ML = LB * LT, M = MC + ML;
constexpr int FF = 5504, NGU = 2 * FF, NIN = 6192, NINP = 6400, NMOD = 9 * DM, NCOND = 1 + LB;
constexpr float EPS = 1e-6f;
constexpr int FFP = 5632;
constexpr float WGU_SCALE = 32.0f, WDN_SCALE = 64.0f;
constexpr int Z_NAQ = 0, Z_NAK = 512, Z_NAV = 1024, Z_GLQ = 1536, Z_GLK = 1792, Z_GLV = 2048, Z_GLR = 2560, Z_GF = 3072, Z_GB = 3088,
              Z_GQQ = 3104, Z_GQK = 3616, Z_GQV = 3872, Z_DQKV = 4128, Z_DZ = 5664, Z_DB = 6176, Z_DA = 6184;
static_assert(Z_DA + 8 == NIN, "split");
enum { I_XP = 0, I_XS, I_CNAK, I_CNAV, I_CGK, I_CGV, I_SGLA, I_SGDN, I_C, I_CCTX, I_NORMG, I_WMOD, I_BMOD, I_GU, I_DOWN, I_WIN, I_WOUT, I_NAQKN, I_RPB,
       I_GUP, I_GBIAS, I_GLAON, I_GQAQKN, I_CONV, I_ALOG, I_DTB, I_GDNON, N_IN };
constexpr size_t O_YP = 0, O_YS = O_YP + (size_t)MC * DM, O_NAK = O_YS + (size_t)ML * DM, O_NAV = O_NAK + (size_t)CB * DEPTH * 4 * CT * 128,
                 O_GK = O_NAV + (size_t)CB * DEPTH * 4 * CT * 128, O_GV = O_GK + (size_t)CB * DEPTH * 2 * CT * 128,
                 O_SGLA = O_GV + (size_t)CB * DEPTH * 2 * CT * 128, O_SGDN = O_SGLA + (size_t)CB * DEPTH * 2 * 4 * 64 * 128,
                 O_END = O_SGDN + (size_t)CB * DEPTH * 2 * 4 * 128 * 128;
constexpr size_t al256(size_t x) { return (x + 255) & ~(size_t)255; }
constexpr size_t WS_CTL = 0, CTL_BYTES = 1u << 20;
constexpr size_t WS_WGU = CTL_BYTES;
constexpr size_t WS_WDN = WS_WGU + (size_t)DEPTH * 2 * NGU * DM * 2;
constexpr size_t WS_WIN = WS_WDN + (size_t)DEPTH * 2 * DM * FF * 2;
constexpr size_t WS_WOUT = WS_WIN + (size_t)DEPTH * NINP * DM * 2;
constexpr size_t WS_MODV = WS_WOUT + (size_t)DEPTH * DM * DM * 2;
constexpr size_t WS_ROPE = al256(WS_MODV + (size_t)DEPTH * NCOND * NMOD * 4);
constexpr size_t WS_X = al256(WS_ROPE + 2 * 64 * 32 * 4);
constexpr size_t WS_H = WS_X + (size_t)M * DM * 4;
constexpr size_t WS_ACT = WS_H + (size_t)M * DM * 2;
constexpr size_t WS_Z = WS_ACT + (size_t)M * FF * 2;
constexpr size_t WS_MRG = WS_Z + (size_t)M * NINP * 4;
constexpr size_t WS_NAQ = WS_MRG + (size_t)M * DM * 2;
constexpr size_t WS_NAK = WS_NAQ + (size_t)M * 512 * 2;
constexpr size_t WS_NAV = WS_NAK + (size_t)M * 512 * 2;
constexpr size_t WS_GQ = WS_NAV + (size_t)M * 512 * 2;
constexpr size_t WS_GK = WS_GQ + (size_t)M * 512 * 2;
constexpr size_t WS_GV = WS_GK + (size_t)M * 256 * 2;
constexpr size_t WS_CNAK = WS_GV + (size_t)M * 256 * 2;
constexpr size_t WS_CNAV = WS_CNAK + (size_t)LB * DEPTH * 256 * 512 * 2;
constexpr size_t WS_CGK = WS_CNAV + (size_t)LB * DEPTH * 256 * 512 * 2;
constexpr size_t WS_CGV = WS_CGK + (size_t)LB * DEPTH * 256 * 256 * 2;
constexpr size_t WS_AF = WS_CGV + (size_t)LB * DEPTH * 256 * 256 * 2;
constexpr size_t WS_AB = WS_AF + (size_t)M * 256 * 4;
constexpr size_t WS_DQ = WS_AB + (size_t)M * 256 * 4;
constexpr size_t WS_DK = WS_DQ + (size_t)M * 512 * 4;
constexpr size_t WS_DV = WS_DK + (size_t)M * 512 * 4;
constexpr size_t WS_DBA = WS_DV + (size_t)M * 512 * 4;
constexpr size_t WS_GOF = WS_DBA + (size_t)M * 16 * 4;
constexpr size_t WS_GOB = WS_GOF + (size_t)M * 512 * 4;
constexpr size_t WS_DOF = WS_GOB + (size_t)M * 512 * 4;
constexpr size_t WS_DOB = WS_DOF + (size_t)M * 512 * 4;
constexpr size_t WS_END = WS_DOB + (size_t)M * 512 * 4;

typedef unsigned short bf16_t;
struct Params { const float* in[N_IN]; float* out; unsigned char* ws; int ph_lo, ph_hi; };
static_assert(sizeof(Params) == N_IN * 8 + 8 + 8 + 8, "no padding");

#define WSP(T, off) ((T*)(p.ws + (off)))
__device__ __forceinline__ int opaque_tid() { int t = (int)threadIdx.x; asm volatile("" : "+v"(t)); return t; }
__device__ __forceinline__ Params opaque_params(const Params& p) { Params q = p; unsigned long long w = (unsigned long long)q.ws; asm volatile("" : "+s"(w)); q.ws = (unsigned char*)w; return q; }

typedef float vf4 __attribute__((ext_vector_type(4)));
__device__ __forceinline__ unsigned pack4_fp8(float a, float b, float c, float d) { int w = 0; w = __builtin_amdgcn_cvt_pk_fp8_f32(a, b, w, false); w = __builtin_amdgcn_cvt_pk_fp8_f32(c, d, w, true); return (unsigned)w; }
__device__ __forceinline__ float bf2f(unsigned short v) { return __uint_as_float((unsigned)v << 16); }
__device__ __forceinline__ vf4 ld4bf(const unsigned short* p) { const uint2 w = *(const uint2*)p; vf4 r; r.x = __uint_as_float(w.x << 16); r.y = __uint_as_float(w.x & 0xFFFF0000u); r.z = __uint_as_float(w.y << 16); r.w = __uint_as_float(w.y & 0xFFFF0000u); return r; }
__device__ __forceinline__ vf4 unp4bf(uint2 w) { vf4 r; r.x = __uint_as_float(w.x << 16); r.y = __uint_as_float(w.x & 0xFFFF0000u); r.z = __uint_as_float(w.y << 16); r.w = __uint_as_float(w.y & 0xFFFF0000u); return r; }
__device__ __forceinline__ void unp8bf(uint4 w, vf4& a, vf4& b) {
    a.x = __uint_as_float(w.x << 16); a.y = __uint_as_float(w.x & 0xFFFF0000u); a.z = __uint_as_float(w.y << 16); a.w = __uint_as_float(w.y & 0xFFFF0000u);
    b.x = __uint_as_float(w.z << 16); b.y = __uint_as_float(w.z & 0xFFFF0000u); b.z = __uint_as_float(w.w << 16); b.w = __uint_as_float(w.w & 0xFFFF0000u); }
__device__ __forceinline__ void ld8bf(const unsigned short* p, vf4& a, vf4& b) { const uint4 w = *(const uint4*)p;
    a.x = __uint_as_float(w.x << 16); a.y = __uint_as_float(w.x & 0xFFFF0000u); a.z = __uint_as_float(w.y << 16); a.w = __uint_as_float(w.y & 0xFFFF0000u);
    b.x = __uint_as_float(w.z << 16); b.y = __uint_as_float(w.z & 0xFFFF0000u); b.z = __uint_as_float(w.w << 16); b.w = __uint_as_float(w.w & 0xFFFF0000u); }
__device__ __forceinline__ float wave_sum(float v) {
#pragma unroll
    for (int o = 32; o >= 1; o >>= 1) v += __shfl_xor(v, o);
    return v;
}
typedef float vf2_ __attribute__((ext_vector_type(2)));
typedef __bf16 vb2_ __attribute__((ext_vector_type(2)));
__device__ __forceinline__ bf16_t f2bf(float f) { return __builtin_bit_cast(unsigned short, (__bf16)f); }
__device__ __forceinline__ unsigned pack2(float a, float b) { return __builtin_bit_cast(unsigned, __builtin_convertvector((vf2_){a, b}, vb2_)); }
__device__ __forceinline__ float silu_f(float x) { return x / (1.f + expf(-x)); }
__device__ __forceinline__ float rsqrt_fast(float x) { return __builtin_amdgcn_rsqf(x); }
__device__ __forceinline__ float silu_fast(float x) { return x * __builtin_amdgcn_rcpf(1.f + __expf(-x)); }
__device__ __forceinline__ float logsigmoid_fast(float x) { return fminf(x, 0.f) - __logf(1.f + __expf(-fabsf(x))); }
__device__ __forceinline__ float softplus_f(float x) { return fmaxf(x, 0.f) + log1pf(expf(-fabsf(x))); }
__device__ __forceinline__ float logsigmoid_f(float x) { return fminf(x, 0.f) - log1pf(expf(-fabsf(x))); }
__device__ __forceinline__ bool g1_fp8(int l, int f) { return f ? (G1B_MODE != 0) : (G1A_MODE != 0 || ((G1A_LAYERS >> l) & 1)); }
__device__ __forceinline__ int cond_of_row(int m) { return m < MC ? 0 : 1 + (m - MC) / LT; }
#ifndef CONV_FILLER
#define CONV_FILLER 1
#endif
__device__ __forceinline__ void conv_tile(const float* __restrict__ src, int ld_src, int ncols_src, int k0, int c0, bf16_t* __restrict__ dst, int ld_dst, int n0, float* tile) {
    const int tid = opaque_tid();
    {
        const int r = tid >> 3, c = (tid & 7) * 8;
        float4 a = make_float4(0.f, 0.f, 0.f, 0.f), b = a;
        if (c0 + c + 8 <= ncols_src) {
            const float* s = src + (size_t)(k0 + r) * ld_src + c0 + c;
            a = *(const float4*)s; b = *(const float4*)(s + 4);
        }
        float* t = tile + r * 65 + c;
        t[0] = a.x; t[1] = a.y; t[2] = a.z; t[3] = a.w; t[4] = b.x; t[5] = b.y; t[6] = b.z; t[7] = b.w;
    }
    __syncthreads();
    {
        const int n = tid >> 3, ks = (tid & 7) * 8;
        const float* t = tile + ks * 65 + n;
        uint4 w;
        w.x = pack2(t[0 * 65], t[1 * 65]); w.y = pack2(t[2 * 65], t[3 * 65]); w.z = pack2(t[4 * 65], t[5 * 65]); w.w = pack2(t[6 * 65], t[7 * 65]);
        *(uint4*)(dst + (size_t)(n0 + n) * ld_dst + k0 + ks) = w;
    }
    __syncthreads();
}

__device__ __forceinline__ void conv_tile8(const float* __restrict__ src, int ld_src, int nrows_src, int k0, int c0, unsigned char* __restrict__ dst, int ld_dst, int n0, float scale, float* tile) {
    const int tid = opaque_tid();
    {
        const int r = tid >> 3, c = (tid & 7) * 8;
        float4 a = make_float4(0.f, 0.f, 0.f, 0.f), b = a;
        if (k0 + r < nrows_src) { const float* s = src + (size_t)(k0 + r) * ld_src + c0 + c; a = *(const float4*)s; b = *(const float4*)(s + 4); }
        float* t = tile + r * 65 + c;
        t[0] = a.x * scale; t[1] = a.y * scale; t[2] = a.z * scale; t[3] = a.w * scale; t[4] = b.x * scale; t[5] = b.y * scale; t[6] = b.z * scale; t[7] = b.w * scale;
    }
    __syncthreads();
    {
        const int n = tid >> 3, ks = (tid & 7) * 8;
        const float* t = tile + ks * 65 + n;
        uint2 w; w.x = pack4_fp8(t[0 * 65], t[1 * 65], t[2 * 65], t[3 * 65]); w.y = pack4_fp8(t[4 * 65], t[5 * 65], t[6 * 65], t[7 * 65]);
        *(uint2*)(dst + (size_t)(n0 + n) * ld_dst + k0 + ks) = w;
    }
    __syncthreads();
}
constexpr int MOD_ITEMS = DEPTH * (NMOD / 128);
constexpr int TGU_KT = DM / 64, TGU_NT = NGU / 64, TDN_KT = (G2_FP8 ? FFP : FF) / 64, TDN_NT = DM / 64, TIN_KT = DM / 64, TIN_NT = NINP / 64, TOUT_KT = DM / 64, TOUT_NT = DM / 64;
constexpr int TL_GU = 2 * TGU_KT * TGU_NT, TL_DN = 2 * TDN_KT * TDN_NT, TL_IN = TIN_KT * TIN_NT, TL_OUT = TOUT_KT * TOUT_NT, NT_L = TL_GU + TL_DN + TL_IN + TL_OUT;
__device__ __forceinline__ void conv_layer_tiles(const Params& p, int l, int t_begin, int t_end, int first, int stride, float* s_tile) {
    for (int it = t_begin + first; it < t_end; it += stride) {
        if (it < TL_GU) {
            const int mat = l * 2 + it / (TGU_KT * TGU_NT), r = it % (TGU_KT * TGU_NT), kt = r / TGU_NT, nt = r % TGU_NT;
            const int n0 = nt * 64, t256 = n0 / 256, c = n0 % 256;
            const int c0 = c < 128 ? 128 * t256 + c : FF + 128 * t256 + (c - 128);
            if (g1_fp8(mat >> 1, mat & 1))
                conv_tile8(p.in[I_GU] + (size_t)mat * DM * NGU, NGU, DM, kt * 64, c0, WSP(unsigned char, WS_WGU) + (size_t)mat * NGU * DM * 2, DM, n0, WGU_SCALE, s_tile);
            else
                conv_tile(p.in[I_GU] + (size_t)mat * DM * NGU, NGU, NGU, kt * 64, c0, WSP(bf16_t, WS_WGU) + (size_t)mat * NGU * DM, DM, n0, s_tile);
        } else if (it < TL_GU + TL_DN) {
            const int i2 = it - TL_GU, mat = l * 2 + i2 / (TDN_KT * TDN_NT), r = i2 % (TDN_KT * TDN_NT), kt = r / TDN_NT, nt = r % TDN_NT;
#if G2_FP8
            conv_tile8(p.in[I_DOWN] + (size_t)mat * FF * DM, DM, FF, kt * 64, nt * 64, WSP(unsigned char, WS_WDN) + (size_t)mat * DM * FFP, FFP, nt * 64, WDN_SCALE, s_tile);
#else
            conv_tile(p.in[I_DOWN] + (size_t)mat * FF * DM, DM, DM, kt * 64, nt * 64, WSP(bf16_t, WS_WDN) + (size_t)mat * DM * FF, FF, nt * 64, s_tile);
#endif
        } else if (it < TL_GU + TL_DN + TL_IN) {
            const int i2 = it - TL_GU - TL_DN, kt = i2 / TIN_NT, nt = i2 % TIN_NT;
            conv_tile(p.in[I_WIN] + (size_t)l * DM * NIN, NIN, NIN, kt * 64, nt * 64, WSP(bf16_t, WS_WIN) + (size_t)l * NINP * DM, DM, nt * 64, s_tile);
        } else {
            const int i2 = it - TL_GU - TL_DN - TL_IN, kt = i2 / TOUT_NT, nt = i2 % TOUT_NT;
            conv_tile(p.in[I_WOUT] + (size_t)l * DM * DM, DM, DM, kt * 64, nt * 64, WSP(bf16_t, WS_WOUT) + (size_t)l * DM * DM, DM, nt * 64, s_tile);
        }
    }
}

__device__ __forceinline__ void mod_layer(const Params& p, int l, int first, int stride, float* smem) {
    const int tid = opaque_tid();
    float* s_cond = smem;
    float* s_red = s_cond + NCOND * DM;
    __syncthreads();
    for (int i = tid; i < NCOND * DM; i += 512) { const int ci = i / DM, k = i % DM; const float v = ci == 0 ? p.in[I_CCTX][k] : p.in[I_C][(size_t)(ci - 1) * DM + k]; s_cond[i] = silu_f(v); }
    __syncthreads();
    float* modv = WSP(float, WS_MODV);
    for (int jt = first; jt < NMOD / 128; jt += stride) {
        const int cl = tid & 127, kq = tid >> 7, col = jt * 128 + cl;
        const float* w = p.in[I_WMOD] + (size_t)l * DM * NMOD + col;
        float acc[NCOND];
#pragma unroll
        for (int ci = 0; ci < NCOND; ++ci) acc[ci] = 0.f;
        for (int k = kq * 512; k < kq * 512 + 512; k += 8) {
            float wv[8];
#pragma unroll
            for (int j = 0; j < 8; ++j) wv[j] = w[(size_t)(k + j) * NMOD];
#pragma unroll
            for (int ci = 0; ci < NCOND; ++ci) {
                const float4 s0 = *(const float4*)&s_cond[ci * DM + k], s1 = *(const float4*)&s_cond[ci * DM + k + 4];
                acc[ci] += s0.x * wv[0] + s0.y * wv[1] + s0.z * wv[2] + s0.w * wv[3] + s1.x * wv[4] + s1.y * wv[5] + s1.z * wv[6] + s1.w * wv[7];
            }
        }
        if (kq > 0) {
#pragma unroll
            for (int ci = 0; ci < NCOND; ++ci) s_red[((kq - 1) * 128 + cl) * NCOND + ci] = acc[ci];
        }
        __syncthreads();
        if (kq == 0) {
            const float bm = p.in[I_BMOD][(size_t)l * NMOD + col];
#pragma unroll
            for (int ci = 0; ci < NCOND; ++ci)
                modv[((size_t)l * NCOND + ci) * NMOD + col] = acc[ci] + s_red[(0 * 128 + cl) * NCOND + ci] + s_red[(1 * 128 + cl) * NCOND + ci] + s_red[(2 * 128 + cl) * NCOND + ci] + bm;
        }
        __syncthreads();
    }
}

__device__ __forceinline__ void phase_prologue(const Params& p, float* smem) {
    const int tid = threadIdx.x, nb = gridDim.x, bid = blockIdx.x;
    float* s_tile = smem + NCOND * DM + 3 * 128 * NCOND;
#if CONV_FILLER
    mod_layer(p, 0, bid, nb, smem);
#else
    for (int l2 = 0; l2 < DEPTH; ++l2) mod_layer(p, l2, bid, nb, smem);
#endif
    conv_layer_tiles(p, 0, 0, NT_L, bid, nb, s_tile);
#if !CONV_FILLER
    for (int l2 = 1; l2 < DEPTH; ++l2) conv_layer_tiles(p, l2, 0, NT_L, bid, nb, s_tile);
#endif
    const size_t gtid = (size_t)bid * 512 + tid, gstride = (size_t)nb * 512;
    {
        const size_t n_na = (size_t)LB * DEPTH * 256 * 512 / 8;
        for (size_t i = gtid; i < 2 * n_na; i += gstride) {
            const bool isv = i >= n_na; const size_t j = isv ? i - n_na : i;
            const int d8 = (int)(j % 16), h = (int)((j / 16) % 4), t = (int)((j / 64) % 256); const size_t bl = j / (64 * 256);
            const float* s = p.in[isv ? I_CNAV : I_CNAK] + ((bl * 4 + h) * 256 + t) * 128 + d8 * 8;
            const float4 a = *(const float4*)s, b = *(const float4*)(s + 4);
            uint4 w; w.x = pack2(a.x, a.y); w.y = pack2(a.z, a.w); w.z = pack2(b.x, b.y); w.w = pack2(b.z, b.w);
            *(uint4*)(WSP(bf16_t, isv ? WS_CNAV : WS_CNAK) + (bl * 256 + t) * 512 + h * 128 + d8 * 8) = w;
        }
        const size_t n_g = (size_t)LB * DEPTH * 256 * 256 / 8;
        for (size_t i = gtid; i < 2 * n_g; i += gstride) {
            const bool isv = i >= n_g; const size_t j = isv ? i - n_g : i;
            const int d8 = (int)(j % 16), h = (int)((j / 16) % 2), t = (int)((j / 32) % 256); const size_t bl = j / (32 * 256);
            const float* s = p.in[isv ? I_CGV : I_CGK] + ((bl * 2 + h) * 256 + t) * 128 + d8 * 8;
            const float4 a = *(const float4*)s, b = *(const float4*)(s + 4);
            uint4 w; w.x = pack2(a.x, a.y); w.y = pack2(a.z, a.w); w.z = pack2(b.x, b.y); w.w = pack2(b.z, b.w);
            *(uint4*)(WSP(bf16_t, isv ? WS_CGV : WS_CGK) + (bl * 256 + t) * 256 + h * 128 + d8 * 8) = w;
        }
    }
    for (size_t i = gtid; i < 64 * 32; i += gstride) {
        const int pos = (int)(i / 32), k = (int)(i % 32);
        const float inv = powf(10000.0f, -(float)(2 * k) / 64.0f);
        const float ang = (float)pos * inv;
        WSP(float, WS_ROPE)[i] = cosf(ang); WSP(float, WS_ROPE)[64 * 32 + i] = sinf(ang);
    }
}

__device__ __forceinline__ void phase_norm(const Params& p, int l, int which  ) {
    const int tid = opaque_tid(), lane = tid & 63, wv = tid >> 6;
    const float* X = WSP(float, WS_X); bf16_t* H = WSP(bf16_t, WS_H);
    const bool from_in = (l == 0 && which == 0);
    const float* g = p.in[I_NORMG] + ((size_t)l * 3 + which) * DM;
    const int nw = (int)gridDim.x * 8;
    for (int m0 = blockIdx.x * 8 + wv; m0 < M; m0 += 2 * nw) {
        const int m1 = m0 + nw; const bool has1 = m1 < M;
        const int mm[2] = {m0, has1 ? m1 : m0};
        vf4 v[2][8]; float ss[2] = {0.f, 0.f};
#pragma unroll
        for (int k = 0; k < 2; ++k) {
            const int m = mm[k];
            if (from_in || !XBF16) {
                const float* x = !from_in ? X + (size_t)m * DM : m < MC ? p.in[I_XP] + (size_t)m * DM : p.in[I_XS] + (size_t)(m - MC) * DM;
#pragma unroll
                for (int i = 0; i < 8; ++i) v[k][i] = *(const vf4*)(x + (i * 64 + lane) * 4);
            } else {
                const bf16_t* x = (const bf16_t*)X + (size_t)m * DM;
#pragma unroll
                for (int i = 0; i < 8; ++i) v[k][i] = ld4bf(x + (i * 64 + lane) * 4);
            }
        }
#pragma unroll
        for (int k = 0; k < 2; ++k) {
#pragma unroll
            for (int i = 0; i < 8; ++i) ss[k] += v[k][i].x * v[k][i].x + v[k][i].y * v[k][i].y + v[k][i].z * v[k][i].z + v[k][i].w * v[k][i].w;
            ss[k] = wave_sum(ss[k]);
        }
#pragma unroll
        for (int k = 0; k < 2; ++k) {
            if (k == 1 && !has1) break;
            const int m = mm[k];
            const float* mv = WSP(float, WS_MODV) + ((size_t)l * NCOND + cond_of_row(m)) * NMOD + (size_t)which * 3 * DM;
            const float r = rsqrt_fast(ss[k] * (1.0f / DM) + EPS);
#pragma unroll
            for (int i = 0; i < 8; ++i) {
                const int c = (i * 64 + lane) * 4;
                const float4 gg = *(const float4*)(g + c), sh = *(const float4*)(mv + c), sc = *(const float4*)(mv + DM + c);
                const float o0 = v[k][i].x * r * gg.x * (1.f + sc.x) + sh.x, o1 = v[k][i].y * r * gg.y * (1.f + sc.y) + sh.y;
                const float o2 = v[k][i].z * r * gg.z * (1.f + sc.z) + sh.z, o3 = v[k][i].w * r * gg.w * (1.f + sc.w) + sh.w;
                if (which != 1 && g1_fp8(l, which >> 1)) *(unsigned*)((unsigned char*)H + (size_t)m * DM + c) = pack4_fp8(o0, o1, o2, o3);
                else { uint2 w; w.x = pack2(o0, o1); w.y = pack2(o2, o3); *(uint2*)(H + (size_t)m * DM + c) = w; }
            }
            if (G2_FP8 && which != 1 && lane < (FFP - FF) / 4) *(unsigned*)(WSP(unsigned char, WS_ACT) + (size_t)m * FFP + FF + 4 * lane) = 0u;
        }
    }
}

__device__ __forceinline__ float red16(float v);
__device__ __forceinline__ float ssq8(vf4 a, vf4 b) { const vf4 s = a * a + b * b; return (s.x + s.y) + (s.z + s.w); }
__device__ __forceinline__ uint4 pack8(vf4 a, vf4 b) { uint4 w; w.x = pack2(a.x, a.y); w.y = pack2(a.z, a.w); w.z = pack2(b.x, b.y); w.w = pack2(b.z, b.w); return w; }
__device__ __forceinline__ void phase_prep(const Params& p, int l) {
    const int tid = opaque_tid(), lane = tid & 63, wv = tid >> 6, rg = lane >> 4, sub = lane & 15, c8 = sub * 8;
    const bf16_t* Z = WSP(bf16_t, WS_Z);
    const float* ropec = WSP(float, WS_ROPE); const float* ropes = ropec + 64 * 32;
    const float* wnq = p.in[I_NAQKN] + ((size_t)l * 2 + 0) * 128 + c8; const float* wnk = wnq + 128;
    const float* wgq = p.in[I_GQAQKN] + ((size_t)l * 2 + 0) * 128 + c8; const float* wgk = wgq + 128;
    const float* cw = p.in[I_CONV] + (size_t)l * 5 * 1536 + rg * 128 + c8;
    const int rpw = (M + (int)gridDim.x * 8 - 1) / ((int)gridDim.x * 8);
    for (int m = ((int)blockIdx.x * 8 + wv) * rpw, mend = (m + rpw < M ? m + rpw : M); m < mend; ++m) {
        const bf16_t* z = Z + (size_t)m * NINP;
        const bool ctx = m < MC;
        const int b = ctx ? m / CT : (m - MC) / LT, t = ctx ? m % CT : (m - MC) % LT, T = ctx ? CT : LT;
        const int ho = rg * 128 + c8;
        uint4 rz[5]; uint2 rgz[2][4];
        {
            const bf16_t* zkv = z + (rg < 2 ? Z_GQK + rg * 128 : Z_GQV + (rg - 2) * 128) + c8;
            rz[0] = *(const uint4*)(z + Z_NAQ + ho); rz[1] = *(const uint4*)(z + Z_NAK + ho); rz[2] = *(const uint4*)(z + Z_NAV + ho); rz[3] = *(const uint4*)(z + Z_GQQ + ho); rz[4] = *(const uint4*)zkv;
#pragma unroll
            for (int dir = 0; dir < 2; ++dir)
#pragma unroll
                for (int r4 = 0; r4 < 4; ++r4) rgz[dir][r4] = *(const uint2*)(z + (dir ? Z_GB : Z_GF) + 4 * r4);
        }
        asm volatile("" ::: "memory");
        {
            vf4 q0, q1, k0, k1, v0, v1, g0, g1, x0, x1;
            unp8bf(rz[0], q0, q1); unp8bf(rz[1], k0, k1); unp8bf(rz[2], v0, v1); unp8bf(rz[3], g0, g1); unp8bf(rz[4], x0, x1);
            float r = rsqrt_fast(red16(ssq8(q0, q1)) * (1.0f / 128) + EPS);
            q0 = q0 * r * *(const vf4*)wnq; q1 = q1 * r * *(const vf4*)(wnq + 4);
            *(uint4*)(WSP(bf16_t, WS_NAQ) + (size_t)m * 512 + ho) = pack8(q0, q1);
            r = rsqrt_fast(red16(ssq8(k0, k1)) * (1.0f / 128) + EPS);
            k0 = k0 * r * *(const vf4*)wnk; k1 = k1 * r * *(const vf4*)(wnk + 4);
            *(uint4*)(WSP(bf16_t, WS_NAK) + (size_t)m * 512 + ho) = pack8(k0, k1);
            *(uint4*)(WSP(bf16_t, WS_NAV) + (size_t)m * 512 + ho) = pack8(v0, v1);
            if (ctx) {
                const size_t o = ((((size_t)b * DEPTH + l) * 4 + rg) * CT + t) * 128 + c8;
                *(vf4*)(p.out + O_NAK + o) = k0; *(vf4*)(p.out + O_NAK + o + 4) = k1; *(vf4*)(p.out + O_NAV + o) = v0; *(vf4*)(p.out + O_NAV + o + 4) = v1;
            }
            r = rsqrt_fast(red16(ssq8(g0, g1)) * (1.0f / 128) + EPS);
            g0 = g0 * r * *(const vf4*)wgq; g1 = g1 * r * *(const vf4*)(wgq + 4);
            const float rk = rsqrt_fast(red16(ssq8(x0, x1)) * (1.0f / 128) + EPS);
            if (rg < 2) { x0 = x0 * rk * *(const vf4*)wgk; x1 = x1 * rk * *(const vf4*)(wgk + 4); }
            if (!ctx) {
                const int pos = sub < 8 ? (t >> 6) : (t & 63), ai = pos * 32 + (c8 & 31);
                const vf4 c0 = *(const vf4*)(ropec + ai), c1 = *(const vf4*)(ropec + ai + 4), s0 = *(const vf4*)(ropes + ai), s1 = *(const vf4*)(ropes + ai + 4);
                const bool hi = (sub & 4) != 0;
                vf4 pg0, pg1, px0, px1;
#pragma unroll
                for (int j = 0; j < 4; ++j) { pg0[j] = __shfl_xor(g0[j], 4); pg1[j] = __shfl_xor(g1[j], 4); px0[j] = __shfl_xor(x0[j], 4); px1[j] = __shfl_xor(x1[j], 4); }
                g0 = hi ? pg0 * s0 + g0 * c0 : g0 * c0 - pg0 * s0; g1 = hi ? pg1 * s1 + g1 * c1 : g1 * c1 - pg1 * s1;
                if (rg < 2) { x0 = hi ? px0 * s0 + x0 * c0 : x0 * c0 - px0 * s0; x1 = hi ? px1 * s1 + x1 * c1 : x1 * c1 - px1 * s1; }
            }
            *(uint4*)(WSP(bf16_t, WS_GQ) + (size_t)m * 512 + ho) = pack8(g0, g1);
            *(uint4*)(WSP(bf16_t, rg < 2 ? WS_GK : WS_GV) + (size_t)m * 256 + (rg & 1) * 128 + c8) = pack8(x0, x1);
            if (ctx) {
                const size_t o = ((((size_t)b * DEPTH + l) * 2 + (rg & 1)) * CT + t) * 128 + c8;
                float* dst = p.out + (rg < 2 ? O_GK : O_GV) + o;
                *(vf4*)dst = x0; *(vf4*)(dst + 4) = x1;
            }
        }
        asm volatile("" ::: "memory");
        {
#pragma unroll
            for (int dir = 0; dir < 2; ++dir) {
                const float* up = p.in[I_GUP] + ((size_t)l * 2 + dir) * 16 * 256 + 4 * lane;
                vf4 acc = *(const vf4*)(p.in[I_GBIAS] + ((size_t)l * 2 + dir) * 256 + 4 * lane);
#pragma unroll
                for (int r4 = 0; r4 < 4; ++r4) {
                    const vf4 gv = unp4bf(rgz[dir][r4]);
                    acc += gv.x * *(const vf4*)(up + (4 * r4 + 0) * 256) + gv.y * *(const vf4*)(up + (4 * r4 + 1) * 256) + gv.z * *(const vf4*)(up + (4 * r4 + 2) * 256) + gv.w * *(const vf4*)(up + (4 * r4 + 3) * 256);
                }
                vf4 o;
#pragma unroll
                for (int j = 0; j < 4; ++j) o[j] = logsigmoid_fast(acc[j]) * (1.0f / 16.0f);
                *(vf4*)(WSP(float, dir ? WS_AB : WS_AF) + (size_t)m * 256 + 4 * lane) = o;
            }
        }
        asm volatile("" ::: "memory");
        {
            uint4 rcz[3][5];
#pragma unroll
            for (int part = 0; part < 3; ++part)
#pragma unroll
                for (int j = 0; j < 5; ++j) { const int tt = t + j - 2;
                    rcz[part][j] = (tt >= 0 && tt < T) ? *(const uint4*)(Z + (size_t)(m + j - 2) * NINP + Z_DQKV + part * 512 + rg * 128 + c8) : make_uint4(0u, 0u, 0u, 0u); }
            asm volatile("" ::: "memory");
#pragma unroll
            for (int part = 0; part < 3; ++part) {
                vf4 a0 = (vf4){0.f, 0.f, 0.f, 0.f}, a1 = a0;
#pragma unroll
                for (int j = 0; j < 5; ++j) {
                    const float* cj = cw + j * 1536 + part * 512;
                    vf4 z0, z1; unp8bf(rcz[part][j], z0, z1);
                    a0 += *(const vf4*)cj * z0; a1 += *(const vf4*)(cj + 4) * z1;
                }
#pragma unroll
                for (int j = 0; j < 4; ++j) { a0[j] = silu_fast(a0[j]); a1[j] = silu_fast(a1[j]); }
                if (part < 2) { const float r = rsqrt_fast(red16(ssq8(a0, a1)) + EPS) * (part == 0 ? 0.08838834764831845f : 1.0f); a0 *= r; a1 *= r; }
                *(uint4*)(WSP(bf16_t, part == 0 ? WS_DQ : part == 1 ? WS_DK : WS_DV) + (size_t)m * 512 + rg * 128 + c8) = pack8(a0, a1);
                asm volatile("" ::: "memory");
            }
            if (lane < 8) {
                const float beta = 1.0f / (1.0f + expf(-bf2f(z[Z_DB + lane])));
                const float g = -expf(p.in[I_ALOG][(size_t)l * 8 + lane]) * softplus_f(bf2f(z[Z_DA + lane]) + p.in[I_DTB][(size_t)l * 8 + lane]);
                float* ba = WSP(float, WS_DBA) + (size_t)m * 16;
                ba[lane] = beta; ba[8 + lane] = g;
            }
        }
    }
}

typedef float vf2 __attribute__((ext_vector_type(2)));
__device__ __forceinline__ float dpp_f(float v, const int ctrl) { return v; }
#define DPPF(v, ctrl) __int_as_float(__builtin_amdgcn_mov_dpp(__float_as_int(v), (ctrl), 0xF, 0xF, true))
__device__ __forceinline__ float red8(float v) { v += DPPF(v, 0xB1); v += DPPF(v, 0x4E); v += DPPF(v, 0x141); return v; }
__device__ __forceinline__ float red16(float v) { v = red8(v); v += DPPF(v, 0x140); return v; }

__device__ __forceinline__ void phase_post(const Params& p, int l) {
    const int tid = opaque_tid(), lane = tid & 63, wv = tid >> 6, rg = lane >> 4, c8 = (lane & 15) * 8;
    const bf16_t* Z = WSP(bf16_t, WS_Z); bf16_t* MRG = WSP(bf16_t, WS_MRG);
    const float* wg = p.in[I_GLAON] + (size_t)l * 128 + c8; const float* wd = p.in[I_GDNON] + (size_t)l * 128 + c8;
    for (int m = blockIdx.x * 8 + wv; m < M; m += gridDim.x * 8) {
        const bf16_t* z = Z + (size_t)m * NINP;
        const int ho = rg * 128 + c8;
#pragma unroll
        for (int g = 0; g < 2; ++g) {
            const float* of = WSP(float, g ? WS_DOF : WS_GOF) + (size_t)m * 512 + ho; const float* ob = WSP(float, g ? WS_DOB : WS_GOB) + (size_t)m * 512 + ho;
            const float* w = g ? wd : wg; const bf16_t* zg = z + (g ? Z_DZ : Z_GLR) + ho;
            vf4 a0 = *(const vf4*)of + *(const vf4*)ob, a1 = *(const vf4*)(of + 4) + *(const vf4*)(ob + 4);
            vf4 g0, g1; ld8bf(zg, g0, g1);
            const float r = rsqrt_fast(red16(ssq8(a0, a1)) * (1.0f / 128) + EPS);
            a0 = a0 * r * *(const vf4*)w; a1 = a1 * r * *(const vf4*)(w + 4);
#pragma unroll
            for (int j = 0; j < 4; ++j) { a0[j] *= silu_fast(g0[j]); a1[j] *= silu_fast(g1[j]); }
            *(uint4*)(MRG + (size_t)m * DM + (g ? 1536 : 512) + ho) = pack8(a0, a1);
        }
    }
}
#define XB_TMO      128
#define XB_XCNT(j)  (256  + 64 * (j))
#define XB_XSUB(j)  (1280 + 64 * (j))
#define XB_XGEN(j)  (2304 + 64 * (j))
#define XB_TOP      3328
#define XB_TOPGEN   3392
#define XCD_BAR_WORDS 3456
#define XB_SPIN_CAP (1u << 22)
#define LAS __attribute__((address_space(3)))

__device__ __forceinline__ unsigned xb_ld(unsigned* p)              { return __hip_atomic_load(p, __ATOMIC_RELAXED, __HIP_MEMORY_SCOPE_AGENT); }
__device__ __forceinline__ unsigned xb_add(unsigned* p, unsigned v) { return __hip_atomic_fetch_add(p, v, __ATOMIC_RELAXED, __HIP_MEMORY_SCOPE_AGENT); }
__device__ __forceinline__ unsigned xb_xcc_id() { return (unsigned)__builtin_amdgcn_s_getreg((3 << 11) | 20) & 0xFu; }
#define XB_SPIN(cond, bar) do { unsigned _sp = 0; while (cond) { __builtin_amdgcn_s_sleep(1); \
    if ((++_sp & 255u) == 0u) { if (xb_ld(&(bar)[XB_TMO])) break; if (_sp > XB_SPIN_CAP) { atomicAdd(&(bar)[XB_TMO], 1u); break; } } } } while (0)

struct XcdBarrier {
    unsigned* bar; unsigned x;
    volatile LAS unsigned* st;
};

__device__ __forceinline__ XcdBarrier xcd_barrier_post(unsigned* bar, volatile LAS unsigned* st) {
    XcdBarrier b; b.bar = bar; b.x = xb_xcc_id(); b.st = st;
    if (threadIdx.x == 0) (void)xb_add(&bar[XB_XCNT(b.x)], 1u);
    return b;
}
__device__ __forceinline__ void xcd_barrier_complete(unsigned* bar, unsigned x, unsigned& nloc, unsigned& nx) {
    const unsigned G = gridDim.x * gridDim.y * gridDim.z;
    unsigned sum, cnt, mine, sp = 0u;
    for (;;) {
        sum = 0u; cnt = 0u; mine = 0u;
#pragma unroll
        for (unsigned j = 0; j < 16; ++j) { const unsigned c = xb_ld(&bar[XB_XCNT(j)]); sum += c; cnt += (c > 0u) ? 1u : 0u; mine = (j == x) ? c : mine; }
        if (sum == G) break;
        __builtin_amdgcn_s_sleep(1);
        if ((++sp & 255u) == 0u) { if (xb_ld(&bar[XB_TMO])) break; if (sp > XB_SPIN_CAP) { atomicAdd(&bar[XB_TMO], 1u); break; } }
    }
    nloc = mine > 0u ? mine : 1u; nx = cnt > 0u ? cnt : 1u;
}

__device__ __forceinline__ void xcd_barrier(const XcdBarrier& b) {
    asm volatile("s_waitcnt vmcnt(0)" ::: "memory");
    __syncthreads();
    if (threadIdx.x == 0) {
        unsigned* bar = b.bar;
        __builtin_amdgcn_s_waitcnt(0);
        unsigned nloc = b.st[0], nx = b.st[1];
        if (nloc == 0u) { xcd_barrier_complete(bar, b.x, nloc, nx); b.st[0] = nloc; b.st[1] = nx; }
        const unsigned old = xb_add(&bar[XB_XSUB(b.x)], 1u);
        const unsigned gen = old / nloc;
        if (old + 1u == (gen + 1u) * nloc) {
            __builtin_amdgcn_fence(__ATOMIC_RELEASE, "agent");
            asm volatile("s_waitcnt vmcnt(0)" ::: "memory");
            const unsigned og = xb_add(&bar[XB_TOP], 1u);
            const unsigned tg = og / nx;
            if (og + 1u == (tg + 1u) * nx) xb_add(&bar[XB_TOPGEN], 1u);
            else XB_SPIN(xb_ld(&bar[XB_TOPGEN]) == tg, bar);
            __builtin_amdgcn_fence(__ATOMIC_ACQUIRE, "agent");
            xb_add(&bar[XB_XGEN(b.x)], 1u);
            asm volatile("s_waitcnt vmcnt(0)" ::: "memory");
        } else {
            XB_SPIN(xb_ld(&bar[XB_XGEN(b.x)]) == gen, bar);
            __builtin_amdgcn_fence(__ATOMIC_ACQUIRE, "agent");
            asm volatile("s_waitcnt vmcnt(0)" ::: "memory");
        }
    }
    __syncthreads();
}

#ifndef NT_STORES
#define NT_STORES 0
#endif
namespace pg8 {
#define PG8_LAS __attribute__((address_space(3)))
typedef unsigned short bf16_t;
typedef short bf16x8 __attribute__((ext_vector_type(8)));
typedef float f32x4 __attribute__((ext_vector_type(4)));
typedef unsigned u32x4 __attribute__((ext_vector_type(4)));
typedef unsigned u32x2 __attribute__((ext_vector_type(2)));
typedef int v4i32 __attribute__((ext_vector_type(4)));
typedef int v8i32 __attribute__((ext_vector_type(8)));
constexpr int BM = 256, BK = 64, HALF = 128, HTB = HALF * BK * 2  , STAGE_BYTES = 8 * HTB, NXCD = 8, WGM = 8;

__host__ __device__ __forceinline__ int lds_byte(int r, int c) { const int st = (r >> 4) * 2 + (c >> 5), rr = r & 15, cc = c & 31, ob = rr * 64 + cc * 2; return st * 1024 + (ob ^ (((ob >> 9) & 1) << 5)); }
__host__ __device__ __forceinline__ void stage_rc(int b, int& R, int& C) { const int st = b / 1024, sb = b % 1024, swz = sb ^ (((sb >> 9) & 1) << 5); R = (st >> 1) * 16 + swz / 64; C = (st & 1) * 32 + (swz % 64) / 2; }
__host__ __device__ __forceinline__ int perm32(int rho) { const int n = rho >> 4, i = rho & 15; return 8 * (i >> 2) + 4 * n + (i & 3); }

struct Unit { int pm, pn, k0, nt, at, slot, msk; };
struct Gemm { const bf16_t* A; const bf16_t* Bt; int M, N, K; };

struct StaticOrder {
    int nM, nN, nwg, G, c, ntk, split, msplit;
    __host__ __device__ void init(int M, int N, int K, int G_, int c_, int split_ = 0) { nM = M / BM; nN = N / BM; nwg = nM * nN; G = G_; c = c_; ntk = K / BK; const int rem = nwg % G_; split = (split_ == 1 && rem > 0 && 2 * rem == G_ && ntk >= 8) ? 1 : 0; msplit = (split_ == 2 && rem > 0 && 2 * rem <= G_) ? 1 : 0; }
    __host__ __device__ bool next(int i, Unit& u) const {
        long L = (long)i * G + c; u.k0 = 0; u.nt = ntk; u.at = 0; u.slot = 0; u.msk = 3;
        if (msplit && i == nwg / G) { const int rem = nwg % G; if (c >= 2 * rem) return false; L = (long)i * G + (c % rem); u.msk = (c / rem) ? 2 : 1; }
        if (split && i == nwg / G) { const int rem = nwg % G, sl = c / rem, h0 = ((ntk / 2) + 1) & ~1; L = (long)i * G + (c % rem); u.k0 = sl ? h0 * BK : 0; u.nt = sl ? ntk - h0 : h0; u.at = sl ? 1 : 2; u.slot = c % rem; }
        if (L >= nwg) return false;
        int wgid = (int)L; { const int q = nwg / NXCD, r = nwg % NXCD, xcd = wgid % NXCD, off = wgid / NXCD; wgid = (xcd < r ? xcd * (q + 1) : r * (q + 1) + (xcd - r) * q) + off; }
        const int nig = WGM * nN, gid = wgid / nig, fm = gid * WGM, gsz = (nM - fm) < WGM ? (nM - fm) : WGM;
        u.pm = fm + ((wgid % nig) % gsz); u.pn = (wgid % nig) / gsz; return true;
    }
    __device__ __forceinline__ void a_ready(const Unit&) const {}
    __device__ __forceinline__ void done(const Unit&) const {}
};
__device__ __forceinline__ unsigned cvt_pk_bf16(float lo, float hi) { unsigned r; asm volatile("v_cvt_pk_bf16_f32 %0, %1, %2" : "=v"(r) : "v"(lo), "v"(hi)); return r; }
struct EpiF32 {
    static constexpr bool PERM = false, AFTER_DRAIN = false;
    float* C; int ldc; const float* bias;
    __device__ __forceinline__ void operator()(const f32x4 (&acc)[2][2][4][2], const Unit& u, int wr, int wc, int fr, int fq) const {
        const int row0 = u.pm * BM + wr * 64 + fr, col0 = u.pn * BM + wc * 32 + 4 * fq;
        f32x4 bv[2][2];
#pragma unroll
        for (int bj = 0; bj < 2; ++bj)
#pragma unroll
            for (int n = 0; n < 2; ++n) bv[bj][n] = bias ? *(const f32x4*)(bias + col0 + bj * HALF + n * 16) : (f32x4){0.f, 0.f, 0.f, 0.f};
#pragma unroll
        for (int ai = 0; ai < 2; ++ai)
#pragma unroll
            for (int m = 0; m < 4; ++m) { float* rowp = C + (size_t)(row0 + ai * HALF + m * 16) * ldc + col0;
#pragma unroll
                for (int bj = 0; bj < 2; ++bj)
#pragma unroll
                    for (int n = 0; n < 2; ++n) *(f32x4*)(rowp + bj * HALF + n * 16) = acc[ai][bj][m][n] + bv[bj][n]; }
    }
};

struct EpiSwiGLU {
    static constexpr bool PERM = true, AFTER_DRAIN = false;
    bf16_t* O; int ldc;
    __device__ __forceinline__ void operator()(const f32x4 (&acc)[2][2][4][2], const Unit& u, int wr, int wc, int fr, int fq) const {
        const int row0 = u.pm * BM + wr * 64 + fr, col0 = u.pn * 128 + wc * 32 + 8 * fq;
#pragma unroll
        for (int ai = 0; ai < 2; ++ai) if ((u.msk >> ai) & 1)
#pragma unroll
            for (int m = 0; m < 4; ++m) { bf16_t* rowp = O + (size_t)(row0 + ai * HALF + m * 16) * ldc + col0;
                const f32x4 g0 = acc[ai][0][m][0], g1 = acc[ai][0][m][1], u0 = acc[ai][1][m][0], u1 = acc[ai][1][m][1];
                float r[8];
#pragma unroll
                for (int j = 0; j < 4; ++j) {
                    r[j]     = g0[j] * __builtin_amdgcn_rcpf(1.0f + __builtin_amdgcn_exp2f(-1.4426950408889634f * g0[j])) * u0[j];
                    r[4 + j] = g1[j] * __builtin_amdgcn_rcpf(1.0f + __builtin_amdgcn_exp2f(-1.4426950408889634f * g1[j])) * u1[j]; }
                u32x4 w; w.x = cvt_pk_bf16(r[0], r[1]); w.y = cvt_pk_bf16(r[2], r[3]); w.z = cvt_pk_bf16(r[4], r[5]); w.w = cvt_pk_bf16(r[6], r[7]);
#if NT_STORES
                __builtin_nontemporal_store(w, (u32x4*)rowp);
#else
                *(u32x4*)rowp = w;
#endif
                }
    }
};
struct EpiSwiGLU8 {
    static constexpr bool PERM = true, AFTER_DRAIN = false;
    unsigned char* O; int ldc; float wscale;
    __device__ __forceinline__ void operator()(const f32x4 (&acc)[2][2][4][2], const Unit& u, int wr, int wc, int fr, int fq) const {
        const int row0 = u.pm * BM + wr * 64 + fr, col0 = u.pn * 128 + wc * 32 + 8 * fq;
#pragma unroll
        for (int ai = 0; ai < 2; ++ai) if ((u.msk >> ai) & 1)
#pragma unroll
            for (int m = 0; m < 4; ++m) { unsigned char* rowp = O + (size_t)(row0 + ai * HALF + m * 16) * ldc + col0;
                f32x4 g0 = acc[ai][0][m][0], g1 = acc[ai][0][m][1], u0 = acc[ai][1][m][0], u1 = acc[ai][1][m][1];
                asm volatile("" : "+v"(g0), "+v"(g1), "+v"(u0), "+v"(u1));
                g0 *= wscale; g1 *= wscale; u0 *= wscale; u1 *= wscale;
                float r[8];
#pragma unroll
                for (int j = 0; j < 4; ++j) {
                    r[j]     = g0[j] * __builtin_amdgcn_rcpf(1.0f + __builtin_amdgcn_exp2f(-1.4426950408889634f * g0[j])) * u0[j];
                    r[4 + j] = g1[j] * __builtin_amdgcn_rcpf(1.0f + __builtin_amdgcn_exp2f(-1.4426950408889634f * g1[j])) * u1[j]; }
                uint2 w; w.x = pack4_fp8(r[0], r[1], r[2], r[3]); w.y = pack4_fp8(r[4], r[5], r[6], r[7]);
                *(uint2*)rowp = w; asm volatile("" ::: "memory"); }
    }
};
struct EpiBf16Plain {
    static constexpr bool PERM = true, AFTER_DRAIN = false;
    bf16_t* O; int ldc;
    __device__ __forceinline__ void operator()(const f32x4 (&acc)[2][2][4][2], const Unit& u, int wr, int wc, int fr, int fq) const {
        const int row0 = u.pm * BM + wr * 64 + fr, col0 = u.pn * BM + wc * 32 + 8 * fq;
#pragma unroll
        for (int ai = 0; ai < 2; ++ai) if ((u.msk >> ai) & 1)
#pragma unroll
            for (int m = 0; m < 4; ++m) { bf16_t* rowp = O + (size_t)(row0 + ai * HALF + m * 16) * ldc + col0;
#pragma unroll
                for (int bj = 0; bj < 2; ++bj) { const f32x4 v0 = acc[ai][bj][m][0], v1 = acc[ai][bj][m][1];
                    u32x4 w; w.x = pack2(v0[0], v0[1]); w.y = pack2(v0[2], v0[3]); w.z = pack2(v1[0], v1[1]); w.w = pack2(v1[2], v1[3]);
                    *(u32x4*)(rowp + bj * HALF) = w; } }
    }
};
struct EpiResid {
    static constexpr bool PERM = false, AFTER_DRAIN = false;
    const float* res; float* out; int ldc; const float* gate0; float coef;
    float* slab; unsigned* flags; unsigned target;
    const float* res_hi; int row_hi;
    int res_bf16, out_bf16;
    __device__ __forceinline__ void operator()(const f32x4 (&acc)[2][2][4][2], const Unit& u, int wr, int wc, int fr, int fq) const {
        const int tidx = ((wr * 4 + wc) * 4 + fq) * 16 + fr;
        if (u.at == 1) {
            const __amdgpu_buffer_rsrc_t rs = __builtin_amdgcn_make_buffer_rsrc((void*)slab, 0, 0x7FFFFFF0, 0x00020000);
            const unsigned base = ((unsigned)u.slot * 32u * 512u + (unsigned)tidx) * 16u;
#pragma unroll
            for (int ai = 0; ai < 2; ++ai)
#pragma unroll
                for (int bj = 0; bj < 2; ++bj)
#pragma unroll
                    for (int m = 0; m < 4; ++m)
#pragma unroll
                        for (int n = 0; n < 2; ++n) { const f32x4 v = acc[ai][bj][m][n]; u32x4 w; w.x = __float_as_uint(v[0]); w.y = __float_as_uint(v[1]); w.z = __float_as_uint(v[2]); w.w = __float_as_uint(v[3]);
                            __builtin_amdgcn_raw_buffer_store_b128(w, rs, base + (unsigned)((((ai * 2 + bj) * 4 + m) * 2 + n) * 512 * 16), 0, 16); }
            asm volatile("s_waitcnt vmcnt(0)" ::: "memory");
            if ((tidx & 63) == 0) __hip_atomic_fetch_add(flags + 64 * u.slot, 1u, __ATOMIC_RELAXED, __HIP_MEMORY_SCOPE_AGENT);
            return;
        }
        const float* part = nullptr;
        if (u.at == 2) {
            unsigned spins = 0;
            while (__hip_atomic_load(flags + 64 * u.slot, __ATOMIC_RELAXED, __HIP_MEMORY_SCOPE_AGENT) < target) { __builtin_amdgcn_s_sleep(2); if (++spins > (1u << 22)) break; }
            __builtin_amdgcn_fence(__ATOMIC_ACQUIRE, "agent");
            asm volatile("s_waitcnt vmcnt(0)" ::: "memory");
            part = slab + ((size_t)u.slot * 32 * 512 + tidx) * 4;
        }
        const int row0 = u.pm * BM + wr * 64 + fr, col0 = u.pn * BM + wc * 32 + 4 * fq;
        const float* gate = gate0 + (size_t)cond_of_row(u.pm * BM) * NMOD;
        const float* rbase = (u.pm * BM >= row_hi) ? res_hi - (size_t)row_hi * ldc : res;
        f32x4 gv[2][2];
#pragma unroll
        for (int bj = 0; bj < 2; ++bj)
#pragma unroll
            for (int n = 0; n < 2; ++n) gv[bj][n] = *(const f32x4*)(gate + col0 + bj * HALF + n * 16) * coef;
#pragma unroll
        for (int ai = 0; ai < 2; ++ai) if ((u.msk >> ai) & 1)
#pragma unroll
            for (int m = 0; m < 4; ++m) { const size_t off = (size_t)(row0 + ai * HALF + m * 16) * ldc + col0;
#pragma unroll
                for (int bj = 0; bj < 2; ++bj)
#pragma unroll
                    for (int n = 0; n < 2; ++n) {
                        f32x4 a = acc[ai][bj][m][n];
                        if (part) a += *(const f32x4*)(part + (size_t)((((ai * 2 + bj) * 4 + m) * 2 + n) * 512 * 4));
                        const size_t eo = off + bj * HALF + n * 16;
                        f32x4 bs;
                        if (res_bf16) { const u32x2 w = *(const u32x2*)((const bf16_t*)rbase + eo); bs[0] = __uint_as_float(w.x << 16); bs[1] = __uint_as_float(w.x & 0xFFFF0000u); bs[2] = __uint_as_float(w.y << 16); bs[3] = __uint_as_float(w.y & 0xFFFF0000u); }
                        else bs = *(const f32x4*)(rbase + eo);
                        const f32x4 o = bs + gv[bj][n] * a;
                        if (out_bf16) { u32x2 w; w.x = cvt_pk_bf16(o[0], o[1]); w.y = cvt_pk_bf16(o[2], o[3]); *(u32x2*)((bf16_t*)out + eo) = w; }
                        else *(f32x4*)(out + eo) = o; }
                asm volatile("" ::: "memory"); }
    }
};
template <class Epi, class Sched, bool STAMP = false, int FP8 = 0>
__device__ __forceinline__ void gemm_phase(PG8_LAS unsigned char* lds, const Gemm g, const Sched& S, const Epi& E, unsigned long long* stamps) {
    const int tid = opaque_tid(), wid = __builtin_amdgcn_readfirstlane(tid >> 6), lane = tid & 63, wr = wid >> 2, wc = wid & 3, fr = lane & 15, fq = lane >> 4;
    const int K = g.K;
    int ts_lo = 0, ts_hi = 0, nts = 0; const unsigned long long rt_entry = STAMP ? (unsigned long long)wall_clock64() : 0ull;
#define PG8_STAMP() do { if (STAMP && wid == 0 && nts < 64) { const unsigned long long _c = (unsigned long long)clock64(); \
        ts_lo = (lane == nts) ? (int)(unsigned)_c : ts_lo; ts_hi = (lane == nts) ? (int)(unsigned)(_c >> 32) : ts_hi; ++nts; } } while (0)
    PG8_STAMP();
    unsigned voffA[2], voffB[2];
#pragma unroll
    for (int i = 0; i < 2; ++i) { int R, C; stage_rc(tid * 16 + i * 8192, R, C); const int Rb = Epi::PERM ? ((R & ~31) + perm32(R & 31)) : R;
        voffA[i] = (unsigned)(R * K + C) * 2u; voffB[i] = (unsigned)(Rb * K + C) * 2u; }
    const size_t kstep = (size_t)(BK * 2);
    const size_t hstep = (size_t)HALF * K * 2;
    const size_t tstep = 2 * hstep;
    const unsigned ldsw = (unsigned)wid * 1024u;
    const int aoff = lds_byte(wr * 64 + fr, fq * 8), boff = lds_byte(wc * 32 + fr, fq * 8);
#define PG8_SA(b, h) (((b) * 2 + (h)) * HTB)
#define PG8_SB(b, h) ((4 + (b) * 2 + (h)) * HTB)
#define PG8_STAGE(bufoff, gbase, voff) do { _Pragma("unroll") for (int _i = 0; _i < 2; ++_i) \
        __builtin_amdgcn_global_load_lds((const unsigned*)((const char*)(gbase) + (voff)[_i]), (PG8_LAS unsigned*)(lds + (bufoff) + ldsw + _i * 8192), 16, 0, 0); } while (0)
#define PG8_LDA(dst, b, h) do { _Pragma("unroll") for (int m = 0; m < 4; ++m) dst[m] = __builtin_shufflevector(*(const PG8_LAS v4i32*)(lds + PG8_SA(b, h) + aoff + m * 2048), *(const PG8_LAS v4i32*)(lds + PG8_SA(b, h) + aoff + m * 2048 + 1024), 0, 1, 2, 3, 4, 5, 6, 7); } while (0)
#define PG8_LDB(dst, b, h) do { _Pragma("unroll") for (int n = 0; n < 2; ++n) dst[n] = __builtin_shufflevector(*(const PG8_LAS v4i32*)(lds + PG8_SB(b, h) + boff + n * 2048), *(const PG8_LAS v4i32*)(lds + PG8_SB(b, h) + boff + n * 2048 + 1024), 0, 1, 2, 3, 4, 5, 6, 7); } while (0)
#define PG8_HALF(v, k) __builtin_bit_cast(bf16x8, __builtin_shufflevector(v, v, 4 * (k), 4 * (k) + 1, 4 * (k) + 2, 4 * (k) + 3))
#define PG8_MMA(ai, bj, At, Bt) do { __builtin_amdgcn_s_setprio(1); _Pragma("unroll") for (int m = 0; m < 4; ++m) _Pragma("unroll") for (int n = 0; n < 2; ++n) { \
        acc[ai][bj][m][n] = __builtin_amdgcn_mfma_f32_16x16x32_bf16(PG8_HALF(Bt[n], 0), PG8_HALF(At[m], 0), acc[ai][bj][m][n], 0, 0, 0); \
        acc[ai][bj][m][n] = __builtin_amdgcn_mfma_f32_16x16x32_bf16(PG8_HALF(Bt[n], 1), PG8_HALF(At[m], 1), acc[ai][bj][m][n], 0, 0, 0); } __builtin_amdgcn_s_setprio(0); } while (0)
#define PG8_MMA8(ai, bj, At, Bt) do { __builtin_amdgcn_s_setprio(1); _Pragma("unroll") for (int m = 0; m < 4; ++m) _Pragma("unroll") for (int n = 0; n < 2; ++n) \
        acc[ai][bj][m][n] = __builtin_amdgcn_mfma_scale_f32_16x16x128_f8f6f4(Bt[n], At[m], acc[ai][bj][m][n], 0, 0, 0, 127, 0, 127); __builtin_amdgcn_s_setprio(0); } while (0)
#define PG8_Q64(v, q) __builtin_bit_cast(long, __builtin_shufflevector(v, v, 2 * (q), 2 * (q) + 1))
#define PG8_M8L1(ai, bj, m, n, q) acc[ai][bj][m][n] = __builtin_amdgcn_mfma_f32_16x16x32_fp8_fp8(PG8_Q64(Bt_[n], q), PG8_Q64(At_[m], q), acc[ai][bj][m][n], 0, 0, 0)
#define PG8_MMA8L(ai, bj, At, Bt) do { auto& At_ = At; auto& Bt_ = Bt; __builtin_amdgcn_s_setprio(1); _Pragma("unroll") for (int m = 0; m < 4; ++m) _Pragma("unroll") for (int n = 0; n < 2; ++n) { \
        PG8_M8L1(ai, bj, m, n, 0); PG8_M8L1(ai, bj, m, n, 1); PG8_M8L1(ai, bj, m, n, 2); PG8_M8L1(ai, bj, m, n, 3); } __builtin_amdgcn_s_setprio(0); } while (0)
#define PG8_MMAG(ai, bj, At, Bt) do { if (mrow & (1 << (ai))) { if constexpr (FP8 == 1) PG8_MMA8(ai, bj, At, Bt); else if constexpr (FP8 == 2) PG8_MMA8L(ai, bj, At, Bt); else PG8_MMA(ai, bj, At, Bt); } } while (0)
#define PG8_WAIT_V(n) asm volatile("s_waitcnt vmcnt(" #n ")" ::: "memory")
#define PG8_WAIT_L(n) asm volatile("s_waitcnt lgkmcnt(" #n ")" ::: "memory")
#define PG8_BAR __builtin_amdgcn_s_barrier()
#define PG8_SCHED __builtin_amdgcn_sched_barrier(0)
    Unit cur, nxt; int ui = 0;
    if (!S.next(0, cur)) return;
    f32x4 acc[2][2][4][2];
#pragma unroll
    for (int a = 0; a < 2; ++a)
#pragma unroll
        for (int b = 0; b < 2; ++b)
#pragma unroll
            for (int m = 0; m < 4; ++m)
#pragma unroll
                for (int n = 0; n < 2; ++n) acc[a][b][m][n] = (f32x4){0.f, 0.f, 0.f, 0.f};
    v8i32 At[4], B0[2], B1[2];
    const char* cA = (const char*)g.A + (size_t)cur.pm * tstep + (size_t)cur.k0 * 2; const char* cB = (const char*)g.Bt + (size_t)cur.pn * tstep + (size_t)cur.k0 * 2;
    S.a_ready(cur);
    PG8_STAGE(PG8_SB(0, 0), cB, voffB); PG8_STAGE(PG8_SA(0, 0), cA, voffA); PG8_STAGE(PG8_SB(0, 1), cB + hstep, voffB); PG8_STAGE(PG8_SA(0, 1), cA + hstep, voffA);
    if (wr == 1) PG8_BAR;
    PG8_WAIT_V(4); PG8_BAR;
    PG8_STAGE(PG8_SB(1, 0), cB + kstep, voffB); PG8_STAGE(PG8_SA(1, 0), cA + kstep, voffA); PG8_STAGE(PG8_SB(1, 1), cB + hstep + kstep, voffB);
    PG8_WAIT_V(6); PG8_BAR;
    PG8_STAMP();
    for (;;) {
        const bool has_next = S.next(ui + 1, nxt);
        const char* nA = has_next ? (const char*)g.A + (size_t)nxt.pm * tstep + (size_t)nxt.k0 * 2 : cA; const char* nB = has_next ? (const char*)g.Bt + (size_t)nxt.pn * tstep + (size_t)nxt.k0 * 2 : cB;
        const int nt = cur.nt, mrow = cur.msk;
        for (int t = 0; t < nt; t += 2) {
            const bool last = (t == nt - 2);
            const char* a1 = cA + (size_t)(t + 1) * kstep;
            const char* a2 = last ? nA : cA + (size_t)(t + 2) * kstep; const char* b2 = last ? nB : cB + (size_t)(t + 2) * kstep;
            const char* a3 = a2 + kstep; const char* b3 = b2 + kstep;
            if (last && has_next) S.a_ready(nxt);
            PG8_LDB(B0, 0, 0); PG8_SCHED; PG8_LDA(At, 0, 0); PG8_STAGE(PG8_SA(1, 1), a1 + hstep, voffA);
            PG8_WAIT_L(8); PG8_BAR; PG8_WAIT_L(0); PG8_MMAG(0, 0, At, B0); PG8_BAR; PG8_SCHED;
            PG8_LDB(B1, 0, 1); PG8_STAGE(PG8_SB(0, 0), b2, voffB);
            PG8_BAR; PG8_WAIT_L(0); PG8_MMAG(0, 1, At, B1); PG8_BAR;
            PG8_LDA(At, 0, 1); PG8_STAGE(PG8_SA(0, 0), a2, voffA);
            PG8_BAR; PG8_WAIT_L(0); PG8_MMAG(1, 0, At, B0); PG8_BAR; PG8_SCHED;
            PG8_STAGE(PG8_SB(0, 1), b2 + hstep, voffB);
            PG8_WAIT_V(6); PG8_BAR; PG8_MMAG(1, 1, At, B1); PG8_BAR;
            PG8_LDB(B0, 1, 0); PG8_SCHED; PG8_LDA(At, 1, 0); PG8_STAGE(PG8_SA(0, 1), a2 + hstep, voffA);
            PG8_WAIT_L(8); PG8_BAR; PG8_WAIT_L(0); PG8_MMAG(0, 0, At, B0); PG8_BAR; PG8_SCHED;
            PG8_LDB(B1, 1, 1); PG8_STAGE(PG8_SB(1, 0), b3, voffB);
            PG8_BAR; PG8_WAIT_L(0); PG8_MMAG(0, 1, At, B1); PG8_BAR;
            PG8_LDA(At, 1, 1); PG8_STAGE(PG8_SA(1, 0), a3, voffA);
            PG8_BAR; PG8_WAIT_L(0); PG8_MMAG(1, 0, At, B0); PG8_BAR; PG8_SCHED;
            PG8_STAGE(PG8_SB(1, 1), b3 + hstep, voffB);
            PG8_WAIT_V(6); PG8_BAR; PG8_MMAG(1, 1, At, B1); PG8_BAR;
        }
        PG8_STAMP();
        if constexpr (!Epi::AFTER_DRAIN) { E(acc, cur, wr, wc, fr, fq); S.done(cur); }
        PG8_STAMP();
        if (!has_next) break;
#pragma unroll
        for (int a = 0; a < 2; ++a)
#pragma unroll
            for (int b = 0; b < 2; ++b)
#pragma unroll
                for (int m = 0; m < 4; ++m)
#pragma unroll
                    for (int n = 0; n < 2; ++n) acc[a][b][m][n] = (f32x4){0.f, 0.f, 0.f, 0.f};
        cur = nxt; cA = nA; cB = nB; ++ui;
    }
    PG8_WAIT_V(0);
    if (wr == 0) PG8_BAR;
    PG8_BAR;
    if constexpr (Epi::AFTER_DRAIN) { E.fused(acc, cur, wr, wc, fr, fq, lds, wid, lane); S.done(cur); }
    PG8_STAMP();
    if (STAMP && wid == 0) { stamps[lane] = lane < nts ? (((unsigned long long)(unsigned)ts_hi << 32) | (unsigned)ts_lo) : 0ull;
        if (lane == 62) stamps[62] = rt_entry; if (lane == 63) stamps[63] = (unsigned long long)wall_clock64(); }
#undef PG8_STAMP
#undef PG8_SA
#undef PG8_SB
#undef PG8_STAGE
#undef PG8_LDA
#undef PG8_LDB
#undef PG8_HALF
#undef PG8_MMA
#undef PG8_MMA8
#undef PG8_MMA8L
#undef PG8_M8L1
#undef PG8_Q64
#undef PG8_MMAG
#undef PG8_WAIT_V
#undef PG8_WAIT_L
#undef PG8_BAR
#undef PG8_SCHED
}
}
#ifndef ATT_INLINE
#define ATT_INLINE __forceinline__
#endif
namespace att {
constexpr int D = 128, NW = 8, QBLK = 32, KVBLK = 64, LDQ = 512, LDO = DM;
constexpr float SCALE = 0.088388347648318440f;
constexpr float THR = 8.f;
constexpr size_t SHM_V = KVBLK * D * 2, SHM_K = KVBLK * D * 2, SHM_Q = 256 * D * 2, SHM_ATTN = 2 * SHM_V + 2 * SHM_K + NW * 64 * 4 + SHM_Q;
using bf16x8 = __attribute__((ext_vector_type(8))) short;
using s16x4  = __attribute__((ext_vector_type(4))) short;
using f32x16 = __attribute__((ext_vector_type(16))) float;
using u32x4  = __attribute__((ext_vector_type(4))) unsigned;
#define KSWZ(row, colB) ((row) * 256 + ((colB) ^ (((row) & 7) << 4)))
#define SBAR() __builtin_amdgcn_sched_barrier(0)
__device__ __forceinline__ int crow(int r, int hi) { return (r & 3) + 8 * (r >> 2) + 4 * hi; }
__device__ __forceinline__ unsigned cvtpk(float lo, float hi) { unsigned r; asm volatile("v_cvt_pk_bf16_f32 %0, %1, %2" : "=v"(r) : "v"(lo), "v"(hi)); return r; }

__device__ __forceinline__ void partialSM(f32x16& p0, f32x16& p1, float& m_reg, float& mn, float& alpha) {
  constexpr float C = SCALE * 1.4426950408889634f;
  float pmax = p0[0]; for (int r = 1; r < 16; ++r) pmax = fmaxf(pmax, p0[r]); for (int r = 0; r < 16; ++r) pmax = fmaxf(pmax, p1[r]);
  { auto rr = __builtin_amdgcn_permlane32_swap(__float_as_uint(pmax), __float_as_uint(pmax), false, false);
    pmax = fmaxf(__uint_as_float(rr[0]), __uint_as_float(rr[1])); }
  if (__builtin_expect(__all(pmax - m_reg <= THR / SCALE), 1)) { mn = m_reg; alpha = 1.f; }
  else { mn = fmaxf(m_reg, pmax); alpha = __builtin_amdgcn_exp2f((m_reg - mn) * C); m_reg = mn; }
  float mnC = -mn * C;
  for (int r = 0; r < 16; ++r) p0[r] = fmaf(p0[r], C, mnC); for (int r = 0; r < 16; ++r) p1[r] = fmaf(p1[r], C, mnC);
  for (int r = 0; r < 16; ++r) p0[r] = __builtin_amdgcn_exp2f(p0[r]);
}
__device__ __forceinline__ void finishSM(f32x16& p0, f32x16& p1, float alpha, float& l_reg, bf16x8& pa0, bf16x8& pa1, bf16x8& pa2, bf16x8& pa3) {
  for (int r = 0; r < 16; ++r) p1[r] = __builtin_amdgcn_exp2f(p1[r]);
  float ps = 0; for (int r = 0; r < 16; ++r) ps += p0[r]; for (int r = 0; r < 16; ++r) ps += p1[r];
  { auto rr = __builtin_amdgcn_permlane32_swap(__float_as_uint(ps), __float_as_uint(ps), false, false);
    ps = __uint_as_float(rr[0]) + __uint_as_float(rr[1]); }
  l_reg = l_reg * alpha + ps;
#define PK4(P, BASE, OUT) do { unsigned a0 = cvtpk(P[BASE + 0], P[BASE + 1]), a1 = cvtpk(P[BASE + 2], P[BASE + 3]);   \
    unsigned b0 = cvtpk(P[BASE + 4], P[BASE + 5]), b1 = cvtpk(P[BASE + 6], P[BASE + 7]);                              \
    auto r0 = __builtin_amdgcn_permlane32_swap(a0, b0, false, false); auto r1 = __builtin_amdgcn_permlane32_swap(a1, b1, false, false); \
    u32x4 w = {r0[0], r1[0], r0[1], r1[1]}; OUT = *reinterpret_cast<bf16x8*>(&w); } while (0)
  PK4(p0, 0, pa0); PK4(p0, 8, pa1); PK4(p1, 0, pa2); PK4(p1, 8, pa3);
#undef PK4
}
__device__ __forceinline__ void qkt(f32x16& p0, f32x16& p1, const bf16_t* Ks, const bf16_t* Qs, int qrow, int r32, int hi) {
  p0 = f32x16{}; p1 = f32x16{};
#pragma unroll
  for (int d0 = 0; d0 < 8; ++d0) { int cb = (d0 * 16 + hi * 8) * 2;
    bf16x8 q = *reinterpret_cast<const bf16x8*>((const char*)Qs + KSWZ(qrow, cb));
    bf16x8 b0 = *reinterpret_cast<const bf16x8*>((const char*)Ks + KSWZ(r32, cb));
    bf16x8 b1 = *reinterpret_cast<const bf16x8*>((const char*)Ks + KSWZ(32 + r32, cb));
    p0 = __builtin_amdgcn_mfma_f32_32x32x16_bf16(b0, q, p0, 0, 0, 0);
    p1 = __builtin_amdgcn_mfma_f32_32x32x16_bf16(b1, q, p1, 0, 0, 0); }
}
__device__ __forceinline__ int v_st(int k, int c) { const int kk = (k & ~0xC) | ((k & 4) << 1) | ((k & 8) >> 1); return ((kk >> 3) * 4 + (c >> 5)) * 512 + ((kk & 7) * 32 + (c & 31)) * 2; }
__device__ __forceinline__ int v_rd_base(int lane) { return ((lane & 3) << 3) | (((lane >> 2) & 3) << 6) | (((lane >> 4) & 1) << 5) | (((lane >> 5) & 1) << 8); }
constexpr int v_rd_off(int d0, int ks, int half) { return d0 * 512 + ks * 4096 + half * 2048; }
template <int OFF> __device__ __forceinline__ s16x4 tr_read(int vb) {
  s16x4 r; asm volatile("ds_read_b64_tr_b16 %0, %1 offset:%2" : "=&v"(r) : "v"(vb), "i"(OFF) : "memory"); return r;
}
template <int D0> __device__ __forceinline__ void pv_one(f32x16& od, int vb, bf16x8 pa0, bf16x8 pa1, bf16x8 pa2, bf16x8 pa3) {
  const s16x4 l0 = tr_read<v_rd_off(D0, 0, 0)>(vb), h0 = tr_read<v_rd_off(D0, 0, 1)>(vb), l1 = tr_read<v_rd_off(D0, 1, 0)>(vb), h1 = tr_read<v_rd_off(D0, 1, 1)>(vb);
  const s16x4 l2 = tr_read<v_rd_off(D0, 2, 0)>(vb), h2 = tr_read<v_rd_off(D0, 2, 1)>(vb), l3 = tr_read<v_rd_off(D0, 3, 0)>(vb), h3 = tr_read<v_rd_off(D0, 3, 1)>(vb);
  asm volatile("s_waitcnt lgkmcnt(0)" ::: "memory"); SBAR();
#define PK(L, H) (bf16x8){L[0], L[1], L[2], L[3], H[0], H[1], H[2], H[3]}
  od = __builtin_amdgcn_mfma_f32_32x32x16_bf16(pa0, PK(l0, h0), od, 0, 0, 0);
  od = __builtin_amdgcn_mfma_f32_32x32x16_bf16(pa1, PK(l1, h1), od, 0, 0, 0);
  od = __builtin_amdgcn_mfma_f32_32x32x16_bf16(pa2, PK(l2, h2), od, 0, 0, 0);
  od = __builtin_amdgcn_mfma_f32_32x32x16_bf16(pa3, PK(l3, h3), od, 0, 0, 0);
#undef PK
}
__device__ __forceinline__ void pv_d0(f32x16* o, int vb, bf16x8 pa0, bf16x8 pa1, bf16x8 pa2, bf16x8 pa3) {
  pv_one<0>(o[0], vb, pa0, pa1, pa2, pa3); pv_one<1>(o[1], vb, pa0, pa1, pa2, pa3); pv_one<2>(o[2], vb, pa0, pa1, pa2, pa3); pv_one<3>(o[3], vb, pa0, pa1, pa2, pa3);
}

struct SrcOne { const bf16_t* k0; const bf16_t* v0; int ldk;
  __device__ __forceinline__ const bf16_t* k(int j) const { return k0 + (size_t)j * 64 * ldk; }
  __device__ __forceinline__ const bf16_t* v(int j) const { return v0 + (size_t)j * 64 * ldk; } };
struct SrcTwo { const bf16_t* ck; const bf16_t* cv; const bf16_t* k1; const bf16_t* v1; int ldk;
  __device__ __forceinline__ const bf16_t* k(int j) const { return j < 4 ? ck + (size_t)j * 64 * ldk : k1 + (size_t)(j - 4) * 64 * ldk; }
  __device__ __forceinline__ const bf16_t* v(int j) const { return j < 4 ? cv + (size_t)j * 64 * ldk : v1 + (size_t)(j - 4) * 64 * ldk; } };
struct NoBias { __device__ __forceinline__ void operator()(f32x16&, f32x16&, int, int, int, int) const {} };
struct NaBias { const float* tab; int i0, kr0;
  __device__ __forceinline__ void operator()(f32x16& p0, f32x16& p1, int jt, int wid, int r32, int hi) const {
    if (jt < 4) return;
    const int qi = i0 + wid * QBLK + r32, r = qi >> 6, qc = qi & 63, kr = kr0 + jt - 4;
    int lo = r - 4; lo = lo < 0 ? 0 : (lo > 8 ? 8 : lo);
    const bool rowok = (kr >= lo) && (kr < lo + 8);
    if (!rowok) {
#pragma unroll
      for (int rr = 0; rr < 16; ++rr) { p0[rr] = -1e30f; p1[rr] = -1e30f; }
      return;
    }
    int c0 = qc - 8; c0 = c0 < 0 ? 0 : (c0 > 48 ? 48 : c0);
    const int dr = kr - r + 7;
    const float* tb = tab + dr * 31 + (4 * hi - qc + 15);
    const int w0 = 4 * hi - c0;
#pragma unroll
    for (int g = 0; g < 4; ++g) {
#pragma unroll
      for (int q = 0; q < 4; ++q) {
        const int rr = 4 * g + q, kc0 = q + 8 * g;
        const float t0 = tb[kc0], t1 = tb[kc0 + 32];
        p0[rr] = ((unsigned)(kc0 + w0) < 16u) ? p0[rr] + t0 : -1e30f;
        p1[rr] = ((unsigned)(kc0 + 32 + w0) < 16u) ? p1[rr] + t1 : -1e30f;
      }
      SBAR();
    }
  } };

template <int SD, class Src, class Bias>
__device__ ATT_INLINE void attn_body(const bf16_t* __restrict__ Qb, const Src src, bf16_t* __restrict__ Ob, const int NT, char* lds, const Bias bias) {
  const int tid = opaque_tid(), wid = tid >> 6, lane = tid & 63, r32 = lane & 31, hi = lane >> 5;
  const int LDK = src.ldk;
  bf16_t* V_lds = (bf16_t*)lds; bf16_t* K_lds = (bf16_t*)(lds + 2 * SHM_V);
  float* ws = (float*)(lds + 2 * SHM_V + 2 * SHM_K) + wid * 64; float* li_l = ws; float* al_l = ws + 32;
  float m_reg = -1e30f, l_reg = 0; f32x16 o[4] = {};
  bf16_t* Q_lds = (bf16_t*)(lds + 2 * SHM_V + 2 * SHM_K + NW * 64 * 4);
  const int qrow = wid * QBLK + r32;
  {
#pragma unroll
    for (int i = 0; i < 8; ++i) { const int f = tid + 512 * i, row = f >> 4, c8 = (f & 15) * 8;
      *(bf16x8*)((char*)Q_lds + KSWZ(row, c8 * 2)) = *reinterpret_cast<const bf16x8*>(Qb + (long)row * LDQ + c8); }
  }
  const int sr = tid >> 4, sc = (tid & 15) * 8, vst0 = v_st(sr, sc), vst1 = v_st(32 + sr, sc);
  const int vb0 = (int)(uintptr_t)V_lds + v_rd_base(lane);
  struct { bf16x8 vs0, vs1, ks0, ks1; } sr_[SD];
#define SLOAD(i, jt) do { const bf16_t* kt_ = src.k(jt); const bf16_t* vt_ = src.v(jt); \
    sr_[i].vs0 = *reinterpret_cast<const bf16x8*>(&vt_[(long)sr * LDK + sc]); sr_[i].vs1 = *reinterpret_cast<const bf16x8*>(&vt_[(long)(32 + sr) * LDK + sc]); \
    sr_[i].ks0 = *reinterpret_cast<const bf16x8*>(&kt_[(long)sr * LDK + sc]); sr_[i].ks1 = *reinterpret_cast<const bf16x8*>(&kt_[(long)(32 + sr) * LDK + sc]); } while (0)
#define SWRITE(b, i) do { *(bf16x8*)((char*)V_lds + (b) * SHM_V + vst0) = sr_[i].vs0;          \
    *(bf16x8*)((char*)V_lds + (b) * SHM_V + vst1) = sr_[i].vs1; int kc = sc * 2;               \
    *(bf16x8*)((char*)K_lds + (b) * SHM_K + KSWZ(sr, kc)) = sr_[i].ks0;                       \
    *(bf16x8*)((char*)K_lds + (b) * SHM_K + KSWZ(32 + sr, kc)) = sr_[i].ks1; } while (0)
#define SWAIT() do { if constexpr (SD == 2) asm volatile("s_waitcnt vmcnt(4)" ::: "memory"); else asm volatile("s_waitcnt vmcnt(0)" ::: "memory"); } while (0)
#define RESC(a) do { if (__any((a) < 1.f)) { if (hi == 0) al_l[r32] = (a); asm volatile("s_waitcnt lgkmcnt(0)" ::: "memory"); \
    for (int d = 0; d < 4; ++d) for (int r = 0; r < 16; ++r) o[d][r] *= al_l[crow(r, hi)]; } } while (0)
  f32x16 pA0, pA1, pB0, pB1; float mnA, mnB, alA, alB; bf16x8 pa0, pa1, pa2, pa3;
  constexpr int SE = 0, SO = SD - 1;
  SLOAD(SE, 0); asm volatile("s_waitcnt vmcnt(0)" ::: "memory"); SWRITE(0, SE); __syncthreads();
  qkt(pA0, pA1, K_lds, Q_lds, qrow, r32, hi); bias(pA0, pA1, 0, wid, r32, hi); partialSM(pA0, pA1, m_reg, mnA, alA);
  SLOAD(SO, 1); if constexpr (SD == 2) { if (2 < NT) SLOAD(SE, 2); }
  SWAIT(); SWRITE(1, SO); __syncthreads();
  for (int j = 1; j + 1 < NT; j += 2) {
    SBAR(); qkt(pB0, pB1, (bf16_t*)((char*)K_lds + SHM_K), Q_lds, qrow, r32, hi); bias(pB0, pB1, j, wid, r32, hi);
    finishSM(pA0, pA1, alA, l_reg, pa0, pa1, pa2, pa3); SBAR();
    SLOAD(SO, j + SD); SBAR();
    pv_d0(o, vb0, pa0, pa1, pa2, pa3); partialSM(pB0, pB1, m_reg, mnB, alB);
    __syncthreads(); SWAIT(); SWRITE(0, SE);
    RESC(alB); __syncthreads();
    SBAR(); qkt(pA0, pA1, K_lds, Q_lds, qrow, r32, hi); bias(pA0, pA1, j + 1, wid, r32, hi);
    finishSM(pB0, pB1, alB, l_reg, pa0, pa1, pa2, pa3); SBAR();
    if (SD == 1 || j + 3 < NT) SLOAD(SE, j + 1 + SD); SBAR();
    pv_d0(o, vb0 + (int)SHM_V, pa0, pa1, pa2, pa3); partialSM(pA0, pA1, m_reg, mnA, alA);
    __syncthreads(); SWAIT(); SWRITE(1, SO);
    RESC(alA); __syncthreads();
  }
  SBAR(); qkt(pB0, pB1, (bf16_t*)((char*)K_lds + SHM_K), Q_lds, qrow, r32, hi); bias(pB0, pB1, NT - 1, wid, r32, hi);
  finishSM(pA0, pA1, alA, l_reg, pa0, pa1, pa2, pa3); SBAR();
  pv_d0(o, vb0, pa0, pa1, pa2, pa3); partialSM(pB0, pB1, m_reg, mnB, alB);
  __syncthreads(); RESC(alB);
  finishSM(pB0, pB1, alB, l_reg, pa0, pa1, pa2, pa3); SBAR();
  pv_d0(o, vb0 + (int)SHM_V, pa0, pa1, pa2, pa3);
  if (hi == 0) li_l[r32] = l_reg; asm volatile("s_waitcnt lgkmcnt(0)" ::: "memory");
  float rli[16];
#pragma unroll
  for (int r = 0; r < 16; ++r) rli[r] = __builtin_amdgcn_rcpf(li_l[crow(r, hi)]);
  bf16_t* Ow = Ob + (long)(wid * QBLK) * LDO;
#pragma unroll
  for (int r = 0; r < 16; ++r) { int orow = crow(r, hi);
    for (int d0 = 0; d0 < 4; ++d0) Ow[(long)orow * LDO + d0 * 32 + r32] = f2bf(o[d0][r] * rli[r]); }
#undef SLOAD
#undef SWRITE
#undef SWAIT
#undef RESC
}
}
namespace gdn {
using att::bf16x8; using att::f32x16; using att::crow;
constexpr int C = 32, SK = 136, SS = 40;
constexpr int OFF_KT = 0, OFF_QT = OFF_KT + C * SK * 2, OFF_W = OFF_QT + C * SK * 2, OFF_KTT = OFF_W + C * SK * 2, OFF_VTT = OFF_KTT + 128 * SS * 2,
              OFF_VN = OFF_VTT + 128 * SS * 2, OFF_VNS = OFF_VN + 128 * SS * 2, OFF_ST = OFF_VNS + 128 * SS * 2, OFF_TB = OFF_ST + 128 * SK * 2,
              OFF_TBE = OFF_TB + C * SS * 2, OFF_ATT = OFF_TBE + C * SS * 2, OFF_L = OFF_ATT + C * SS * 2, OFF_SC = OFF_L + C * C * 4, GDN_LDS = OFF_SC + 1024;
template <int K>
__device__ __forceinline__ f32x16 mm(const bf16_t* A, int lda, const bf16_t* Bt, int ldb, int l32, int hi, f32x16 acc) {
#pragma unroll
    for (int k0 = 0; k0 < K; k0 += 16) {
        const bf16x8 a = *reinterpret_cast<const bf16x8*>(A + l32 * lda + k0 + 8 * hi);
        const bf16x8 b = *reinterpret_cast<const bf16x8*>(Bt + l32 * ldb + k0 + 8 * hi);
        acc = __builtin_amdgcn_mfma_f32_32x32x16_bf16(a, b, acc, 0, 0, 0);
    }
    return acc;
}
__device__ __forceinline__ uint2 pk4(float a, float b, float c, float d) { uint2 w; w.x = pack2(a, b); w.y = pack2(c, d); return w; }

__device__ __forceinline__ void gdn_chunked(const Params& p, int l, bool ctx, int b, int h, int dir, unsigned char* lds) {
    const int tid = opaque_tid(), wid = tid >> 6, lane = tid & 63, l32 = lane & 31, hi = lane >> 5;
    const int T = ctx ? CT : ::LT; const size_t m0 = ctx ? (size_t)b * CT : (size_t)MC + (size_t)b * ::LT;
    const bf16_t* DQ = WSP(bf16_t, WS_DQ); const bf16_t* DK = WSP(bf16_t, WS_DK); const bf16_t* DV = WSP(bf16_t, WS_DV); const float* DBA = WSP(float, WS_DBA);
    float* O = WSP(float, dir ? WS_DOB : WS_DOF);
    bf16_t* Kt = (bf16_t*)(lds + OFF_KT); bf16_t* Qt = (bf16_t*)(lds + OFF_QT); bf16_t* W = (bf16_t*)(lds + OFF_W); bf16_t* KT = (bf16_t*)(lds + OFF_KTT); bf16_t* VT = (bf16_t*)(lds + OFF_VTT);
    bf16_t* VN = (bf16_t*)(lds + OFF_VN); bf16_t* VNS = (bf16_t*)(lds + OFF_VNS); bf16_t* ST = (bf16_t*)(lds + OFF_ST); bf16_t* TB = (bf16_t*)(lds + OFF_TB); bf16_t* TBE = (bf16_t*)(lds + OFF_TBE);
    bf16_t* ATT = (bf16_t*)(lds + OFF_ATT); float* Lm = (float*)(lds + OFF_L); float* sc = (float*)(lds + OFF_SC);
    const int nch = T / C;
#define TOK(c, s_) (m0 + (dir ? T - 1 - ((c) * C + (s_)) : (c) * C + (s_)))
    f32x16 S[2];
#pragma unroll
    for (int bi = 0; bi < 2; ++bi) {
        const int blk = wid * 2 + bi, d0 = 32 * (blk >> 2), e0 = 32 * (blk & 3);
        if (ctx) { S[bi] = f32x16{}; }
        else {
            const float* s0 = p.in[I_SGDN] + ((((size_t)b * DEPTH + l) * 2 + dir) * 4 + h) * 128 * 128 + e0 + l32;
#pragma unroll
            for (int r = 0; r < 16; ++r) S[bi][r] = s0[(size_t)(d0 + crow(r, hi)) * 128];
        }
    }
    const int ls = tid >> 5, lc = (tid & 31) * 4;
    vf4 pq0, pq1, pk0, pk1, pv0, pv1; float pbeta = 0.f, pg = 0.f;
#define GLOAD(c) do { const size_t ma = TOK(c, ls), mb = TOK(c, ls + 16); \
        pq0 = ld4bf(DQ + ma * 512 + h * 128 + lc); pq1 = ld4bf(DQ + mb * 512 + h * 128 + lc); \
        pk0 = ld4bf(DK + ma * 512 + h * 128 + lc); pk1 = ld4bf(DK + mb * 512 + h * 128 + lc); \
        pv0 = ld4bf(DV + ma * 512 + h * 128 + lc); pv1 = ld4bf(DV + mb * 512 + h * 128 + lc); \
        if (tid < C) { const size_t mt = TOK(c, tid); pbeta = DBA[mt * 16 + dir * 4 + h]; pg = DBA[mt * 16 + 8 + dir * 4 + h]; } } while (0)
#define GSTAGE() do { \
        *(uint2*)(Kt + ls * SK + lc) = pk4(pk0.x, pk0.y, pk0.z, pk0.w); *(uint2*)(Kt + (ls + 16) * SK + lc) = pk4(pk1.x, pk1.y, pk1.z, pk1.w); \
        *(uint2*)(Qt + ls * SK + lc) = pk4(pq0.x, pq0.y, pq0.z, pq0.w); *(uint2*)(Qt + (ls + 16) * SK + lc) = pk4(pq1.x, pq1.y, pq1.z, pq1.w); \
        _Pragma("unroll") for (int j = 0; j < 4; ++j) { KT[(lc + j) * SS + ls] = f2bf(pk0[j]); KT[(lc + j) * SS + ls + 16] = f2bf(pk1[j]); \
                                                        VT[(lc + j) * SS + ls] = f2bf(pv0[j]); VT[(lc + j) * SS + ls + 16] = f2bf(pv1[j]); } \
        if (wid == 0) { float x = pg; _Pragma("unroll") for (int o_ = 1; o_ < 32; o_ <<= 1) { const float y = __shfl_up(x, o_); if (lane >= o_) x += y; } \
            const float Bt_ = __shfl(x, 31); if (lane < C) { sc[lane] = pbeta; sc[32 + lane] = x; sc[64 + lane] = __expf(x); sc[96 + lane] = __expf(Bt_ - x); if (lane == 0) sc[128] = __expf(Bt_); } } } while (0)
    __syncthreads();
    GLOAD(0);
#pragma unroll
    for (int bi = 0; bi < 2; ++bi) {
        const int blk = wid * 2 + bi, d0 = 32 * (blk >> 2), e0 = 32 * (blk & 3);
#pragma unroll
        for (int g = 0; g < 4; ++g) *(uint2*)(ST + (e0 + l32) * SK + d0 + 8 * g + 4 * hi) = pk4(S[bi][4 * g], S[bi][4 * g + 1], S[bi][4 * g + 2], S[bi][4 * g + 3]);
    }
    GSTAGE();
    __syncthreads();
    for (int c = 0; c < nch; ++c) {
        if (c + 1 < nch) GLOAD(c + 1);
        f32x16 acc1 = f32x16{};
        if (wid == 0) {
            const f32x16 kk = mm<128>(Kt, SK, Kt, SK, l32, hi, f32x16{});
            const float bi_ = sc[32 + l32], be = sc[l32];
#pragma unroll
            for (int r = 0; r < 16; ++r) { const int j = crow(r, hi); const float v = (l32 > j) ? be * kk[r] * __expf(bi_ - sc[32 + j]) : 0.f;
                Lm[l32 * 32 + ((r & 3) + 4 * hi) * 4 + (r >> 2)] = v; }
        } else if (wid == 1) {
            const f32x16 kq = mm<128>(Kt, SK, Qt, SK, l32, hi, f32x16{});
            const float bi_ = sc[32 + l32];
            float a[16];
#pragma unroll
            for (int r = 0; r < 16; ++r) { const int j = crow(r, hi); a[r] = (l32 >= j) ? kq[r] * __expf(bi_ - sc[32 + j]) : 0.f; }
#pragma unroll
            for (int g = 0; g < 4; ++g) *(uint2*)(ATT + l32 * SS + 8 * g + 4 * hi) = pk4(a[4 * g], a[4 * g + 1], a[4 * g + 2], a[4 * g + 3]);
        } else if (wid >= 4) {
            acc1 = mm<128>(Qt, SK, ST + (32 * (wid - 4)) * SK, SK, l32, hi, f32x16{});
#pragma unroll
            for (int r = 0; r < 16; ++r) acc1[r] *= sc[64 + crow(r, hi)];
        }
        __syncthreads();
        if (tid < 256) {
            const int cc = tid >> 3, part = tid & 7;
            float Tr[4] = {0.f, 0.f, 0.f, 0.f};
            const float* Lp = Lm + part * 4;
#pragma unroll
            for (int i = 0; i < 32; ++i) {
                const vf4 lv = *(const vf4*)(Lp + i * 32);
                float s = lv.x * Tr[0] + lv.y * Tr[1] + lv.z * Tr[2] + lv.w * Tr[3];
                s = red8(s);
                const float t = (i == cc ? 1.f : 0.f) - s;
                if (part == (i & 7)) Tr[i >> 3] = t;
            }
            const float bc = sc[cc], bec = bc * sc[64 + cc];
#pragma unroll
            for (int jj = 0; jj < 4; ++jj) { TB[(part + 8 * jj) * SS + cc] = f2bf(Tr[jj] * bc); TBE[(part + 8 * jj) * SS + cc] = f2bf(Tr[jj] * bec); }
        }
        __syncthreads();
        if (wid < 4) {
            acc1 = mm<32>(TB, SS, VT + (32 * wid) * SS, SS, l32, hi, f32x16{});
        } else {
            const int d0 = 32 * (wid - 4);
            const f32x16 wt = mm<32>(KT + d0 * SS, SS, TBE, SS, l32, hi, f32x16{});
#pragma unroll
            for (int g = 0; g < 4; ++g) *(uint2*)(W + l32 * SK + d0 + 8 * g + 4 * hi) = pk4(wt[4 * g], wt[4 * g + 1], wt[4 * g + 2], wt[4 * g + 3]);
        }
        __syncthreads();
        if (wid < 4) {
            const int e0 = 32 * wid;
            const f32x16 ws = mm<128>(W, SK, ST + e0 * SK, SK, l32, hi, f32x16{});
            float vn[16], vs[16];
#pragma unroll
            for (int r = 0; r < 16; ++r) { vn[r] = acc1[r] - ws[r]; vs[r] = vn[r] * sc[96 + crow(r, hi)]; }
#pragma unroll
            for (int g = 0; g < 4; ++g) { *(uint2*)(VN + (e0 + l32) * SS + 8 * g + 4 * hi) = pk4(vn[4 * g], vn[4 * g + 1], vn[4 * g + 2], vn[4 * g + 3]);
                                          *(uint2*)(VNS + (e0 + l32) * SS + 8 * g + 4 * hi) = pk4(vs[4 * g], vs[4 * g + 1], vs[4 * g + 2], vs[4 * g + 3]); }
        }
        __syncthreads();
        if (wid >= 4) {
            const int e0 = 32 * (wid - 4);
            acc1 = mm<32>(ATT, SS, VN + e0 * SS, SS, l32, hi, acc1);
#pragma unroll
            for (int r = 0; r < 16; ++r) O[TOK(c, crow(r, hi)) * 512 + h * 128 + e0 + l32] = acc1[r];
        }
        {
            const float eB = sc[128];
#pragma unroll
            for (int bi = 0; bi < 2; ++bi) {
                const int blk = wid * 2 + bi, d0 = 32 * (blk >> 2), e0 = 32 * (blk & 3);
#pragma unroll
                for (int r = 0; r < 16; ++r) S[bi][r] *= eB;
                S[bi] = mm<32>(KT + d0 * SS, SS, VNS + e0 * SS, SS, l32, hi, S[bi]);
            }
        }
        __syncthreads();
#pragma unroll
        for (int bi = 0; bi < 2; ++bi) {
            const int blk = wid * 2 + bi, d0 = 32 * (blk >> 2), e0 = 32 * (blk & 3);
#pragma unroll
            for (int g = 0; g < 4; ++g) *(uint2*)(ST + (e0 + l32) * SK + d0 + 8 * g + 4 * hi) = pk4(S[bi][4 * g], S[bi][4 * g + 1], S[bi][4 * g + 2], S[bi][4 * g + 3]);
        }
        if (c + 1 < nch) GSTAGE();
        __syncthreads();
    }
#undef GLOAD
#undef GSTAGE
#undef TOK
    if (ctx) {
#pragma unroll
        for (int bi = 0; bi < 2; ++bi) {
            const int blk = wid * 2 + bi, d0 = 32 * (blk >> 2), e0 = 32 * (blk & 3);
            float* so = p.out + O_SGDN + ((((size_t)b * DEPTH + l) * 2 + dir) * 4 + h) * 128 * 128 + e0 + l32;
#pragma unroll
            for (int r = 0; r < 16; ++r) so[(size_t)(d0 + crow(r, hi)) * 128] = S[bi][r];
        }
    }
}
}

namespace gla {
using att::bf16x8; using att::f32x16; using att::crow; using gdn::mm; using gdn::pk4;
constexpr int C = 32, SQ = 72, SS = 40;
constexpr int OFF_QE = 0, OFF_KN = OFF_QE + C * SQ * 2, OFF_KET = OFF_KN + C * SQ * 2, OFF_VT = OFF_KET + 64 * SS * 2, OFF_ATT = OFF_VT + 128 * SS * 2, OFF_ST = OFF_ATT + C * SS * 2,
              OFF_LA = OFF_ST + 128 * SQ * 2, OFF_EB = OFF_LA + C * 64 * 4, GLA_LDS = OFF_EB + 256;
__device__ __forceinline__ void gla_chunked(const Params& p, int l, bool ctx, int b, int h, int dir, unsigned char* lds) {
    const int tid = opaque_tid(), wid = tid >> 6, lane = tid & 63, l32 = lane & 31, hi = lane >> 5;
    const int T = ctx ? CT : ::LT; const size_t m0 = ctx ? (size_t)b * CT : (size_t)MC + (size_t)b * ::LT;
    const bf16_t* Z = WSP(bf16_t, WS_Z); const float* LA = WSP(float, dir ? WS_AB : WS_AF);
    float* O = WSP(float, dir ? WS_GOB : WS_GOF);
    bf16_t* Qe = (bf16_t*)(lds + OFF_QE); bf16_t* Kn = (bf16_t*)(lds + OFF_KN); bf16_t* KeT = (bf16_t*)(lds + OFF_KET); bf16_t* VT = (bf16_t*)(lds + OFF_VT);
    bf16_t* ATT = (bf16_t*)(lds + OFF_ATT); bf16_t* ST = (bf16_t*)(lds + OFF_ST); float* la = (float*)(lds + OFF_LA); float* eB = (float*)(lds + OFF_EB);
    const int nch = T / C;
#define TOK(c, s_) (m0 + (dir ? T - 1 - ((c) * C + (s_)) : (c) * C + (s_)))
    const int d0 = 32 * (wid >> 2), e0 = 32 * (wid & 3);
    f32x16 S;
    if (ctx) S = f32x16{};
    else {
        const float* s0 = p.in[I_SGLA] + ((((size_t)b * DEPTH + l) * 2 + dir) * 4 + h) * 64 * 128 + e0 + l32;
#pragma unroll
        for (int r = 0; r < 16; ++r) S[r] = s0[(size_t)(d0 + crow(r, hi)) * 128];
    }
    const int ts = tid >> 4, dc = (tid & 15) * 4, vs = tid >> 5, vc = (tid & 31) * 4;
    vf4 pq, pk, pl, pv0, pv1;
#define GLOAD(c) do { const size_t mt = TOK(c, ts), ma = TOK(c, vs), mb = TOK(c, vs + 16); \
        pq = ld4bf(Z + mt * NINP + Z_GLQ + h * 64 + dc); pk = ld4bf(Z + mt * NINP + Z_GLK + h * 64 + dc); pl = *(const vf4*)(LA + mt * 256 + h * 64 + dc); \
        pv0 = ld4bf(Z + ma * NINP + Z_GLV + h * 128 + vc); pv1 = ld4bf(Z + mb * NINP + Z_GLV + h * 128 + vc); } while (0)
#define WRITE_ST() do { _Pragma("unroll") for (int g = 0; g < 4; ++g) *(uint2*)(ST + (e0 + l32) * SQ + d0 + 8 * g + 4 * hi) = pk4(S[4 * g], S[4 * g + 1], S[4 * g + 2], S[4 * g + 3]); } while (0)
#define GIMAGES() do { vf4 pre = (vf4){0.f, 0.f, 0.f, 0.f}, tot = pre; \
        _Pragma("unroll 8") for (int t_ = 0; t_ < C; ++t_) { const vf4 v_ = *(const vf4*)(la + t_ * 64 + dc); tot += v_; if (t_ <= ts) pre += v_; } \
        float qe[4], kn[4]; \
        _Pragma("unroll") for (int j = 0; j < 4; ++j) { qe[j] = pq[j] * 0.125f * __expf(pre[j]); kn[j] = pk[j] * __expf(fminf(-pre[j], 80.f)); \
            KeT[(dc + j) * SS + ts] = f2bf(pk[j] * __expf(tot[j] - pre[j])); } \
        *(uint2*)(Qe + ts * SQ + dc) = pk4(qe[0], qe[1], qe[2], qe[3]); *(uint2*)(Kn + ts * SQ + dc) = pk4(kn[0], kn[1], kn[2], kn[3]); \
        if (ts == 0) { _Pragma("unroll") for (int j = 0; j < 4; ++j) eB[dc + j] = __expf(tot[j]); } \
        _Pragma("unroll") for (int j = 0; j < 4; ++j) { VT[(vc + j) * SS + vs] = f2bf(pv0[j]); VT[(vc + j) * SS + vs + 16] = f2bf(pv1[j]); } } while (0)
    __syncthreads();
    GLOAD(0);
    WRITE_ST();
    *(vf4*)(la + ts * 64 + dc) = pl;
    __syncthreads();
    GIMAGES();
    __syncthreads();
    for (int c = 0; c < nch; ++c) {
        if (c + 1 < nch) GLOAD(c + 1);
        f32x16 o1 = f32x16{};
        if (wid == 0) {
            const f32x16 kq = mm<64>(Kn, SQ, Qe, SQ, l32, hi, f32x16{});
            float a[16];
#pragma unroll
            for (int r = 0; r < 16; ++r) a[r] = (l32 >= crow(r, hi)) ? kq[r] : 0.f;
#pragma unroll
            for (int g = 0; g < 4; ++g) *(uint2*)(ATT + l32 * SS + 8 * g + 4 * hi) = pk4(a[4 * g], a[4 * g + 1], a[4 * g + 2], a[4 * g + 3]);
        } else if (wid >= 4) {
            o1 = mm<64>(Qe, SQ, ST + (32 * (wid - 4)) * SQ, SQ, l32, hi, f32x16{});
        }
        __syncthreads();
        if (wid >= 4) {
            const int eo = 32 * (wid - 4);
            o1 = mm<32>(ATT, SS, VT + eo * SS, SS, l32, hi, o1);
#pragma unroll
            for (int r = 0; r < 16; ++r) O[TOK(c, crow(r, hi)) * 512 + h * 128 + eo + l32] = o1[r];
        }
#pragma unroll
        for (int r = 0; r < 16; ++r) S[r] *= eB[d0 + crow(r, hi)];
        S = mm<32>(KeT + d0 * SS, SS, VT + e0 * SS, SS, l32, hi, S);
        __syncthreads();
        WRITE_ST();
        if (c + 1 < nch) *(vf4*)(la + ts * 64 + dc) = pl;
        __syncthreads();
        if (c + 1 < nch) GIMAGES();
        __syncthreads();
    }
#undef GLOAD
#undef WRITE_ST
#undef GIMAGES
#undef TOK
    if (ctx) {
        float* so = p.out + O_SGLA + ((((size_t)b * DEPTH + l) * 2 + dir) * 4 + h) * 64 * 128 + e0 + l32;
#pragma unroll
        for (int r = 0; r < 16; ++r) so[(size_t)(d0 + crow(r, hi)) * 128] = S[r];
    }
}
}
#define LAS __attribute__((address_space(3)))
constexpr int LDS_BYTES = 147456, XBW_OFF = LDS_BYTES - 64;
constexpr int NPH = 1 + DEPTH * 12;
#ifndef DBG_NLAYERS
#define DBG_NLAYERS DEPTH
#endif

#ifndef DUPKIND
#define DUPKIND 0
#endif
__device__ __forceinline__ int opaque_int(int v) { asm volatile("" : "+s"(v)); return v; }
#ifndef MIXMASK
#define MIXMASK 0xFF
#endif
#define FOR_ITEMS(it, n, o, w) for (int bo_ = (o) * (int)gridDim.x / 256, bw_ = ((w) * (int)gridDim.x / 256) > 0 ? ((w) * (int)gridDim.x / 256) : 1, \
                                    it = ((int)blockIdx.x >= bo_ && (int)blockIdx.x < bo_ + bw_) ? (int)blockIdx.x - bo_ : (n); it < (n); it += bw_)

constexpr int TF0 = NT_L / 10, TF1 = NT_L / 4, TF2 = NT_L * 53 / 100, TF3 = NT_L * 88 / 100, MIXCONV_CH = 16, NI_CONV = (TF3 - TF2 + MIXCONV_CH - 1) / MIXCONV_CH;
#ifndef SPLITK
#define SPLITK 0
#endif
#ifndef SPLITK_G4
#define SPLITK_G4 0
#endif
constexpr int FLAG_WORD0 = 8192;
constexpr int QCTR_WORD0 = 1024;
constexpr int NI_GDNL = LB * 8, NI_GLAL = LB * 8, NI_GDNC = CB * 8, NI_GQAL = LB * 16, NI_NAL = LB * 16, NI_GLAC = CB * 8, NI_NAC = CB * 4, NI_GQAC = CB * 4;
#define KM(k) (1 + ((DUPKIND >> (k)) & 1))
constexpr int Q0 = NI_GDNL * KM(0), Q1 = Q0 + NI_GQAL * KM(1), Q2 = Q1 + NI_NAL * KM(2), Q3 = Q2 + NI_GLAL * KM(3), Q4 = Q3 + NI_GDNC * KM(4), Q5 = Q4 + NI_NAC * KM(5), Q6 = Q5 + NI_GQAC * KM(6), Q7 = Q6 + NI_GLAC * KM(7);
__device__ __forceinline__ void phase_mix(const Params& p, int l, unsigned char* lds, int rep) {
    const int tid = opaque_tid();
    float* smem = (float*)lds;
    const bf16_t* NAQ = WSP(bf16_t, WS_NAQ); const bf16_t* NAK = WSP(bf16_t, WS_NAK); const bf16_t* NAV = WSP(bf16_t, WS_NAV);
    const bf16_t* GQ = WSP(bf16_t, WS_GQ); const bf16_t* GK = WSP(bf16_t, WS_GK); const bf16_t* GV = WSP(bf16_t, WS_GV);
    bf16_t* MRG = WSP(bf16_t, WS_MRG);
    unsigned* qctr = WSP(unsigned, WS_CTL) + QCTR_WORD0 + 64 * l + 16 * rep;
    volatile int* qslot = (volatile int*)(lds + XBW_OFF + 16);
    for (;;) {
        __syncthreads();
        if (tid == 0) *qslot = (int)__hip_atomic_fetch_add(qctr, 1u, __ATOMIC_RELAXED, __HIP_MEMORY_SCOPE_AGENT);
        __syncthreads();
        const int q = __builtin_amdgcn_readfirstlane(*qslot);
        if (q >= Q7 + ((CONV_FILLER && l + 1 < DBG_NLAYERS) ? NI_CONV : 0)) break;
        if (q < Q0) { const int it = q % NI_GDNL; gdn::gdn_chunked(p, l, false, it / 8, (it / 2) % 4, it % 2, lds); }
        else if (q < Q1) {
            const int it = (q - Q0) % NI_GQAL, b = it / 16, qh = (it / 4) % 4, qb = it % 4, kvh = qh >> 1;
            const size_t r0 = (size_t)MC + (size_t)b * LT;
            att::SrcTwo src{WSP(bf16_t, WS_CGK) + ((size_t)b * DEPTH + l) * 256 * 256 + kvh * 128, WSP(bf16_t, WS_CGV) + ((size_t)b * DEPTH + l) * 256 * 256 + kvh * 128,
                            GK + r0 * 256 + kvh * 128, GV + r0 * 256 + kvh * 128, 256};
            att::attn_body<2>(GQ + (r0 + qb * 256) * 512 + qh * 128, src, MRG + (r0 + qb * 256) * DM + 1024 + qh * 128, 4 + LT / 64, (char*)lds, att::NoBias{});
        }
        else if (q < Q2) {
            const int it = (q - Q1) % NI_NAL, b = it / 16, h = (it / 4) % 4, qb = it % 4;
            const int kr0 = qb == 0 ? 0 : qb == 1 ? 0 : qb == 2 ? 4 : 8, nrows = (qb == 0 || qb == 3) ? 8 : 12;
            const size_t r0 = (size_t)MC + (size_t)b * LT;
            float* tab = (float*)(lds + att::SHM_ATTN);
            if (tid < 15 * 31) tab[tid] = p.in[I_RPB][((size_t)l * 4 + h) * 15 * 31 + tid] * (1.0f / att::SCALE);
            att::SrcTwo src{WSP(bf16_t, WS_CNAK) + ((size_t)b * DEPTH + l) * 256 * 512 + h * 128, WSP(bf16_t, WS_CNAV) + ((size_t)b * DEPTH + l) * 256 * 512 + h * 128,
                            NAK + (r0 + kr0 * 64) * 512 + h * 128, NAV + (r0 + kr0 * 64) * 512 + h * 128, 512};
            att::attn_body<1>(NAQ + (r0 + qb * 256) * 512 + h * 128, src, MRG + (r0 + qb * 256) * DM + 0 + h * 128, 4 + nrows, (char*)lds, att::NaBias{tab, qb * 256, kr0});
        }
        else if (q < Q3) { const int it = (q - Q2) % NI_GLAL; gla::gla_chunked(p, l, false, it / 8, (it / 2) % 4, it % 2, lds); }
        else if (q < Q4) { const int it = (q - Q3) % NI_GDNC; gdn::gdn_chunked(p, l, true, it / 8, (it / 2) % 4, it % 2, lds); }
        else if (q < Q5) {
            const int it = (q - Q4) % NI_NAC, b = it / 4, h = it % 4; const size_t r0 = (size_t)b * CT;
            att::SrcOne src{NAK + r0 * 512 + h * 128, NAV + r0 * 512 + h * 128, 512};
            att::attn_body<2>(NAQ + r0 * 512 + h * 128, src, MRG + r0 * DM + 0 + h * 128, CT / 64, (char*)lds, att::NoBias{});
        }
        else if (q < Q6) {
            const int it = (q - Q5) % NI_GQAC, b = it / 4, qh = it % 4, kvh = qh >> 1; const size_t r0 = (size_t)b * CT;
            att::SrcOne src{GK + r0 * 256 + kvh * 128, GV + r0 * 256 + kvh * 128, 256};
            att::attn_body<2>(GQ + r0 * 512 + qh * 128, src, MRG + r0 * DM + 1024 + qh * 128, CT / 64, (char*)lds, att::NoBias{});
        }
        else if (q < Q7) { const int it = (q - Q6) % NI_GLAC; gla::gla_chunked(p, l, true, it / 8, (it / 2) % 4, it % 2, lds); }
        else { const int t0 = TF2 + (q - Q7) * MIXCONV_CH, t1 = t0 + MIXCONV_CH < TF3 ? t0 + MIXCONV_CH : TF3; conv_layer_tiles(p, l + 1, t0, t1, 0, 1, (float*)lds); }
    }
}

#define CONV_FILL(nunits, t0, t1, skip) do { if (l + 1 < DBG_NLAYERS) { const int G_ = (int)gridDim.x; int f0_ = ((nunits) % G_) + (skip); if (f0_ >= G_) f0_ = 0; \
        if ((int)blockIdx.x >= f0_) { const Params q = opaque_params(p); conv_layer_tiles(q, l + 1, (t0), (t1), (int)blockIdx.x - f0_, G_ - f0_, (float*)lds); } } } while (0)
#define G1A_MSPLIT (G1A_MODE == 1 ? 2 : 0)
#define G1B_MSPLIT (G1B_MODE == 1 ? 2 : 0)
#ifndef MSPLIT
#define MSPLIT 2
#endif
static_assert(att::SHM_ATTN + 15 * 31 * 4 + 2048 <= (size_t)XBW_OFF, "LDS map");
static_assert((QCTR_WORD0 + 64 * DEPTH) < 4096, "ctl");
constexpr int BAR_WORD0 = 4096;
static_assert((BAR_WORD0 + XCD_BAR_WORDS) * 4 <= (int)CTL_BYTES, "ctl");

__global__ void __launch_bounds__(512, 2) fwd(Params p) {
    extern __shared__ __attribute__((aligned(16))) unsigned char lds[];
    const int tid = threadIdx.x;
    volatile LAS unsigned* xbw = (volatile LAS unsigned*)((LAS unsigned char*)lds + XBW_OFF);
    if (tid < 4) xbw[tid] = 0u;
    __syncthreads();
    XcdBarrier bar; bar.bar = WSP(unsigned, WS_CTL) + BAR_WORD0; bar.x = 0; bar.st = xbw;
    if (p.ph_hi - p.ph_lo > 1) bar = xcd_barrier_post(WSP(unsigned, WS_CTL) + BAR_WORD0, xbw);
#ifndef PHMASK
#define PHMASK 0x1FFF
#endif
#define IN(k) (p.ph_lo <= (k) && (k) < p.ph_hi)
#define INL(j) (((PHMASK >> ((j) + 1)) & 1) && IN(pb + (j)))
#ifndef DUPMASK
#define DUPMASK 0
#endif
#define DUP(j) ((DUPMASK >> ((j) + 1)) & 1)
#if DUPMASK
#define REPS(j) opaque_int(1 + DUP(j))
#else
#define REPS(j) 1
#endif
#ifndef DBLBAR
#define DBLBAR 0
#endif
#define SEAM(k) do { if (IN(k) && IN((k) + 1)) { xcd_barrier(bar); if (DBLBAR) xcd_barrier(bar); } } while (0)
    LAS unsigned char* ldsl = (LAS unsigned char*)lds;
    bf16_t* H = WSP(bf16_t, WS_H); bf16_t* ACT = WSP(bf16_t, WS_ACT); float* X = WSP(float, WS_X); float* Z = WSP(float, WS_Z); bf16_t* MRG = WSP(bf16_t, WS_MRG);

    if ((PHMASK & 1) && IN(0)) { const int reps_ = (DUPMASK & 1) ? opaque_int(2) : 1; for (int rep_ = 0; rep_ < reps_; ++rep_) { const Params q = opaque_params(p); phase_prologue(q, (float*)lds); __syncthreads(); } }
    SEAM(0);
    for (int l = 0; l < DBG_NLAYERS; ++l) {
        const int pb = 1 + l * 12;
        const float* modl = WSP(float, WS_MODV) + (size_t)l * NCOND * NMOD;
        if (INL(0)) { const int reps_ = REPS(0); for (int rep_ = 0; rep_ < reps_; ++rep_) { const Params q = opaque_params(p); phase_norm(q, l, 0); __syncthreads(); } }
        SEAM(pb + 0);
        if (INL(1)) {
            if (g1_fp8(l, 0)) {
                pg8::Gemm g{H, (const bf16_t*)(WSP(unsigned char, WS_WGU) + ((size_t)l * 2 + 0) * NGU * DM * 2), M, NGU, DM / 2}; pg8::StaticOrder S; S.init(M, NGU, DM / 2, (int)gridDim.x, (int)blockIdx.x, 2);
                pg8::EpiSwiGLU8 E{WSP(unsigned char, WS_ACT), FFP, 1.0f / WGU_SCALE};
                pg8::gemm_phase<pg8::EpiSwiGLU8, pg8::StaticOrder, false, 1>(ldsl, g, S, E, nullptr);
            } else {
                pg8::Gemm g{H, WSP(bf16_t, WS_WGU) + ((size_t)l * 2 + 0) * NGU * DM, M, NGU, DM}; pg8::StaticOrder S; S.init(M, NGU, DM, (int)gridDim.x, (int)blockIdx.x, 0);
                pg8::EpiSwiGLU8 E{WSP(unsigned char, WS_ACT), FFP, 1.0f};
                pg8::gemm_phase<pg8::EpiSwiGLU8, pg8::StaticOrder, false, 0>(ldsl, g, S, E, nullptr);
            }
#if CONV_FILLER
            if (l + 1 < DBG_NLAYERS) {
                const int nw_ = (M / 256) * (NGU / 256), G_ = (int)gridDim.x; int f0_ = nw_ % G_; if (nw_ < G_) f0_ = 0;
                if (g1_fp8(l, 0)) f0_ = 2 * f0_ < G_ ? 2 * f0_ : f0_;
                const int nmb_ = (G_ - f0_ < NMOD / 128) ? (G_ - f0_) : NMOD / 128;
                if ((int)blockIdx.x >= f0_ && (int)blockIdx.x < f0_ + nmb_) { const Params q = opaque_params(p); mod_layer(q, l + 1, (int)blockIdx.x - f0_, nmb_, (float*)lds); }
            }
            CONV_FILL((M / 256) * (NGU / 256), 0, TF0, NMOD / 128 + (g1_fp8(l, 0) ? ((M / 256) * (NGU / 256)) % (int)gridDim.x : 0));
#endif
        }
        SEAM(pb + 1);
        if (INL(2)) {
            pg8::Gemm g{ACT, G2_FP8 ? (const bf16_t*)(WSP(unsigned char, WS_WDN) + ((size_t)l * 2 + 0) * DM * FFP) : WSP(bf16_t, WS_WDN) + ((size_t)l * 2 + 0) * DM * FF, M, DM, G2_FP8 ? FFP / 2 : FF}; pg8::StaticOrder S; S.init(M, DM, G2_FP8 ? FFP / 2 : FF, (int)gridDim.x, (int)blockIdx.x, SPLITK ? 1 : MSPLIT);
            pg8::EpiResid E{l == 0 ? p.in[I_XP] : X, X, DM, modl + 2 * DM, G2_FP8 ? 0.5f / WDN_SCALE : 0.5f, Z, WSP(unsigned, WS_CTL) + FLAG_WORD0, 8u * (unsigned)(l * (2 * SPLITK + SPLITK_G4) + SPLITK), l == 0 ? p.in[I_XS] : X, l == 0 ? MC : 0x7FFFFFFF, (XBF16 && l != 0), XBF16};
            pg8::gemm_phase<pg8::EpiResid, pg8::StaticOrder, false, (G2_FP8 ? 1 : 0)>(ldsl, g, S, E, nullptr);
#if DUPMASK
            if (opaque_int(DUP(2))) { pg8::EpiResid E2{X, Z, DM, modl + 2 * DM, 0.5f, Z, WSP(unsigned, WS_CTL) + FLAG_WORD0, 0u, X, 0x7FFFFFFF, 1, 0}; pg8::gemm_phase<pg8::EpiResid, pg8::StaticOrder, false>(ldsl, g, S, E2, nullptr); }
#endif
        }
        SEAM(pb + 2);
        if (INL(3)) { const int reps_ = REPS(3); for (int rep_ = 0; rep_ < reps_; ++rep_) { const Params q = opaque_params(p); phase_norm(q, l, 1); __syncthreads(); } }
        SEAM(pb + 3);
        if (INL(4)) {
            pg8::Gemm g{H, WSP(bf16_t, WS_WIN) + (size_t)l * NINP * DM, M, NINP, DM}; pg8::StaticOrder S; S.init(M, NINP, DM, (int)gridDim.x, (int)blockIdx.x);
            pg8::EpiBf16Plain E{WSP(bf16_t, WS_Z), NINP};
            for (int r_ = 0, n_ = REPS(4); r_ < n_; ++r_) pg8::gemm_phase<pg8::EpiBf16Plain, pg8::StaticOrder, false>(ldsl, g, S, E, nullptr);
#if CONV_FILLER
            CONV_FILL((M / 256) * (NINP / 256), TF0, TF1, 0);
#endif
        }
        SEAM(pb + 4);
        if (INL(5)) { const int reps_ = REPS(5); for (int rep_ = 0; rep_ < reps_; ++rep_) { const Params q = opaque_params(p); phase_prep(q, l); __syncthreads(); } }
        SEAM(pb + 5);
        if (INL(6)) { const int reps_ = REPS(6); for (int rep_ = 0; rep_ < reps_; ++rep_) { const Params q = opaque_params(p); phase_mix(q, l, lds, rep_); __syncthreads(); } }
        SEAM(pb + 6);
        if (INL(7)) { const int reps_ = REPS(7); for (int rep_ = 0; rep_ < reps_; ++rep_) { const Params q = opaque_params(p); phase_post(q, l); __syncthreads(); } }
        SEAM(pb + 7);
        if (INL(8)) {
            pg8::Gemm g{MRG, WSP(bf16_t, WS_WOUT) + (size_t)l * DM * DM, M, DM, DM}; pg8::StaticOrder S; S.init(M, DM, DM, (int)gridDim.x, (int)blockIdx.x, SPLITK_G4);
            pg8::EpiResid E{X, X, DM, modl + 5 * DM, 1.0f, Z, WSP(unsigned, WS_CTL) + FLAG_WORD0, 8u * (unsigned)(l * (2 * SPLITK + SPLITK_G4) + SPLITK + SPLITK_G4), X, 0x7FFFFFFF, XBF16, XBF16};
            pg8::gemm_phase<pg8::EpiResid, pg8::StaticOrder, false>(ldsl, g, S, E, nullptr);
#if CONV_FILLER
            CONV_FILL((M / 256) * (DM / 256), TF1, TF2, 0);
#endif
#if DUPMASK
            if (opaque_int(DUP(8))) { pg8::EpiResid E2{X, Z, DM, modl + 5 * DM, 1.0f, Z, WSP(unsigned, WS_CTL) + FLAG_WORD0, 0u, X, 0x7FFFFFFF, 1, 0}; pg8::gemm_phase<pg8::EpiResid, pg8::StaticOrder, false>(ldsl, g, S, E2, nullptr); }
#endif
        }
        SEAM(pb + 8);
        if (INL(9)) { const int reps_ = REPS(9); for (int rep_ = 0; rep_ < reps_; ++rep_) { const Params q = opaque_params(p); phase_norm(q, l, 2); __syncthreads(); } }
        SEAM(pb + 9);
        if (INL(10)) {
            {
#if G1B_MODE
                pg8::Gemm g{H, (const bf16_t*)(WSP(unsigned char, WS_WGU) + ((size_t)l * 2 + 1) * NGU * DM * 2), M, NGU, DM / 2}; pg8::StaticOrder S; S.init(M, NGU, DM / 2, (int)gridDim.x, (int)blockIdx.x, G1B_MSPLIT);
                constexpr float ws_ = 1.0f / WGU_SCALE;
#else
                pg8::Gemm g{H, WSP(bf16_t, WS_WGU) + ((size_t)l * 2 + 1) * NGU * DM, M, NGU, DM}; pg8::StaticOrder S; S.init(M, NGU, DM, (int)gridDim.x, (int)blockIdx.x, G1B_MSPLIT);
                constexpr float ws_ = 1.0f;
#endif
#if G2_FP8
                pg8::EpiSwiGLU8 E{WSP(unsigned char, WS_ACT), FFP, ws_};
                pg8::gemm_phase<pg8::EpiSwiGLU8, pg8::StaticOrder, false, G1B_MODE>(ldsl, g, S, E, nullptr);
#else
                pg8::EpiSwiGLU E{ACT, FF};
                pg8::gemm_phase<pg8::EpiSwiGLU, pg8::StaticOrder, false, G1B_MODE>(ldsl, g, S, E, nullptr);
#endif
            }
#if CONV_FILLER
            CONV_FILL((M / 256) * (NGU / 256), TF3, NT_L, (G1B_MSPLIT ? ((M / 256) * (NGU / 256)) % (int)gridDim.x : 0));
#endif
        }
        SEAM(pb + 10);
        if (INL(11)) {
            pg8::Gemm g{ACT, G2_FP8 ? (const bf16_t*)(WSP(unsigned char, WS_WDN) + ((size_t)l * 2 + 1) * DM * FFP) : WSP(bf16_t, WS_WDN) + ((size_t)l * 2 + 1) * DM * FF, M, DM, G2_FP8 ? FFP / 2 : FF}; pg8::StaticOrder S; S.init(M, DM, G2_FP8 ? FFP / 2 : FF, (int)gridDim.x, (int)blockIdx.x, SPLITK ? 1 : MSPLIT);
            pg8::EpiResid E{X, (l == DEPTH - 1) ? p.out : X, DM, modl + 8 * DM, G2_FP8 ? 0.5f / WDN_SCALE : 0.5f, Z, WSP(unsigned, WS_CTL) + FLAG_WORD0, 8u * (unsigned)(l * (2 * SPLITK + SPLITK_G4) + 2 * SPLITK + SPLITK_G4), X, 0x7FFFFFFF, XBF16, (XBF16 && l != DEPTH - 1)};
            pg8::gemm_phase<pg8::EpiResid, pg8::StaticOrder, false, (G2_FP8 ? 1 : 0)>(ldsl, g, S, E, nullptr);
        }
        SEAM(pb + 11);
    }
#undef IN
#undef SEAM
}

#ifndef MULTI_LAUNCH
#define MULTI_LAUNCH 0
#endif
extern "C" void kernel_launch(void* const* d_in, const int* in_sizes, int n_in, void* d_out, int out_size, void* d_ws, size_t ws_size, hipStream_t stream) {
    static int grid = 0;
    if (grid == 0) {
        if (n_in != N_IN || (size_t)out_size != O_END || ws_size < WS_END) { fprintf(stderr, "kernel_launch: shape mismatch n_in %d out %d ws %zu (need %zu)\n", n_in, out_size, ws_size, (size_t)WS_END); grid = -1; return; }
        int dev = 0, cus = 0, per_cu = 0;
        if (hipGetDevice(&dev) != hipSuccess || hipDeviceGetAttribute(&cus, hipDeviceAttributeMultiprocessorCount, dev) != hipSuccess) { grid = -1; return; }
        if (hipFuncSetAttribute((const void*)fwd, hipFuncAttributeMaxDynamicSharedMemorySize, LDS_BYTES) != hipSuccess) { fprintf(stderr, "kernel_launch: hipFuncSetAttribute failed\n"); grid = -1; return; }
        if (hipOccupancyMaxActiveBlocksPerMultiprocessor(&per_cu, (const void*)fwd, 512, LDS_BYTES) != hipSuccess || per_cu < 1) { fprintf(stderr, "kernel_launch: occupancy query says %d\n", per_cu); (void)hipGetLastError(); }
        grid = cus;
    }
    if (grid < 0) return;
    (void)hipMemsetAsync((char*)d_ws + WS_CTL, 0, CTL_BYTES, stream);
    Params p{};
    for (int i = 0; i < N_IN; ++i) p.in[i] = (const float*)d_in[i];
    p.out = (float*)d_out; p.ws = (unsigned char*)d_ws;
#if MULTI_LAUNCH
    for (int ph = 0; ph < 1 + DBG_NLAYERS * 12; ++ph) { p.ph_lo = ph; p.ph_hi = ph + 1; hipLaunchKernelGGL(fwd, dim3(grid), dim3(512), LDS_BYTES, stream, p); }
#else
    p.ph_lo = 0; p.ph_hi = NPH; hipLaunchKernelGGL(fwd, dim3(grid), dim3(512), LDS_BYTES, stream, p);
#endif
    const hipError_t le = hipPeekAtLastError();
    if (le != hipSuccess) fprintf(stderr, "kernel_launch: launch failed: %s\n", hipGetErrorName(le));
}
```

```cpp
#include <hip/hip_runtime.h>
#include <cstdio>
#include <cstdint>

#ifndef CB_
#define CB_ 16
#endif
#ifndef LB_
#define LB_ 8
#endif
#ifndef DEPTH_
#define DEPTH_ 4
#endif
#ifndef G1A_LAYERS
#define G1A_LAYERS 0xC
#endif
#ifndef G1A_MODE
#define G1A_MODE 0
#endif
#ifndef G1B_MODE
#define G1B_MODE 1
#endif
#ifndef XBF16
#define XBF16 0
#endif
#ifndef G2_FP8
#define G2_FP8 1
#endif
#ifndef FFN_FP8
#define FFN_FP8 (G1A_MODE != 0 || G1B_MODE != 0 || G2_FP8 != 0)
#endif
constexpr int DM = 2048, DEPTH = DEPTH_, CB = CB_, CT = 256, LB = LB_, LT = 1024;
constexpr int MC = CB * CT, ML = LB * LT, M = MC + ML;
constexpr int FF = 5504, NGU = 2 * FF, NIN = 6192, NINP = 6400, NMOD = 9 * DM, NCOND = 1 + LB;
constexpr float EPS = 1e-6f;
constexpr int FFP = 5632;
constexpr float WGU_SCALE = 32.0f, WDN_SCALE = 64.0f;
constexpr int Z_NAQ = 0, Z_NAK = 512, Z_NAV = 1024, Z_GLQ = 1536, Z_GLK = 1792, Z_GLV = 2048, Z_GLR = 2560, Z_GF = 3072, Z_GB = 3088,
              Z_GQQ = 3104, Z_GQK = 3616, Z_GQV = 3872, Z_DQKV = 4128, Z_DZ = 5664, Z_DB = 6176, Z_DA = 6184;
static_assert(Z_DA + 8 == NIN, "split");
enum { I_XP = 0, I_XS, I_CNAK, I_CNAV, I_CGK, I_CGV, I_SGLA, I_SGDN, I_C, I_CCTX, I_NORMG, I_WMOD, I_BMOD, I_GU, I_DOWN, I_WIN, I_WOUT, I_NAQKN, I_RPB,
       I_GUP, I_GBIAS, I_GLAON, I_GQAQKN, I_CONV, I_ALOG, I_DTB, I_GDNON, N_IN };
constexpr size_t O_YP = 0, O_YS = O_YP + (size_t)MC * DM, O_NAK = O_YS + (size_t)ML * DM, O_NAV = O_NAK + (size_t)CB * DEPTH * 4 * CT * 128,
                 O_GK = O_NAV + (size_t)CB * DEPTH * 4 * CT * 128, O_GV = O_GK + (size_t)CB * DEPTH * 2 * CT * 128,
                 O_SGLA = O_GV + (size_t)CB * DEPTH * 2 * CT * 128, O_SGDN = O_SGLA + (size_t)CB * DEPTH * 2 * 4 * 64 * 128,
                 O_END = O_SGDN + (size_t)CB * DEPTH * 2 * 4 * 128 * 128;
constexpr size_t al256(size_t x) { return (x + 255) & ~(size_t)255; }
constexpr size_t WS_CTL = 0, CTL_BYTES = 1u << 20;
constexpr size_t WS_WGU = CTL_BYTES;
constexpr size_t WS_WDN = WS_WGU + (size_t)DEPTH * 2 * NGU * DM * 2;
constexpr size_t WS_WIN = WS_WDN + (size_t)DEPTH * 2 * DM * FF * 2;
constexpr size_t WS_WOUT = WS_WIN + (size_t)DEPTH * NINP * DM * 2;
constexpr size_t WS_MODV = WS_WOUT + (size_t)DEPTH * DM * DM * 2;
constexpr size_t WS_ROPE = al256(WS_MODV + (size_t)DEPTH * NCOND * NMOD * 4);
constexpr size_t WS_X = al256(WS_ROPE + 2 * 64 * 32 * 4);
constexpr size_t WS_H = WS_X + (size_t)M * DM * 4;
constexpr size_t WS_ACT = WS_H + (size_t)M * DM * 2;
constexpr size_t WS_Z = WS_ACT + (size_t)M * FF * 2;
constexpr size_t WS_MRG = WS_Z + (size_t)M * NINP * 4;
constexpr size_t WS_NAQ = WS_MRG + (size_t)M * DM * 2;
constexpr size_t WS_NAK = WS_NAQ + (size_t)M * 512 * 2;
constexpr size_t WS_NAV = WS_NAK + (size_t)M * 512 * 2;
constexpr size_t WS_GQ = WS_NAV + (size_t)M * 512 * 2;
constexpr size_t WS_GK = WS_GQ + (size_t)M * 512 * 2;
constexpr size_t WS_GV = WS_GK + (size_t)M * 256 * 2;
constexpr size_t WS_CNAK = WS_GV + (size_t)M * 256 * 2;
constexpr size_t WS_CNAV = WS_CNAK + (size_t)LB * DEPTH * 256 * 512 * 2;
constexpr size_t WS_CGK = WS_CNAV + (size_t)LB * DEPTH * 256 * 512 * 2;
constexpr size_t WS_CGV = WS_CGK + (size_t)LB * DEPTH * 256 * 256 * 2;
constexpr size_t WS_AF = WS_CGV + (size_t)LB * DEPTH * 256 * 256 * 2;
constexpr size_t WS_AB = WS_AF + (size_t)M * 256 * 4;
constexpr size_t WS_DQ = WS_AB + (size_t)M * 256 * 4;
constexpr size_t WS_DK = WS_DQ + (size_t)M * 512 * 4;
constexpr size_t WS_DV = WS_DK + (size_t)M * 512 * 4;
constexpr size_t WS_DBA = WS_DV + (size_t)M * 512 * 4;
constexpr size_t WS_GOF = WS_DBA + (size_t)M * 16 * 4;
constexpr size_t WS_GOB = WS_GOF + (size_t)M * 512 * 4;
constexpr size_t WS_DOF = WS_GOB + (size_t)M * 512 * 4;
constexpr size_t WS_DOB = WS_DOF + (size_t)M * 512 * 4;
constexpr size_t WS_END = WS_DOB + (size_t)M * 512 * 4;

typedef unsigned short bf16_t;
struct Params { const float* in[N_IN]; float* out; unsigned char* ws; int ph_lo, ph_hi; };
static_assert(sizeof(Params) == N_IN * 8 + 8 + 8 + 8, "no padding");

#define WSP(T, off) ((T*)(p.ws + (off)))
__device__ __forceinline__ int opaque_tid() { int t = (int)threadIdx.x; asm volatile("" : "+v"(t)); return t; }
__device__ __forceinline__ Params opaque_params(const Params& p) { Params q = p; unsigned long long w = (unsigned long long)q.ws; asm volatile("" : "+s"(w));
    q.ws = (unsigned char*)(__attribute__((address_space(1))) unsigned char*)w; return q; }

typedef float vf4 __attribute__((ext_vector_type(4)));
__device__ __forceinline__ unsigned pack4_fp8(float a, float b, float c, float d) { int w = 0; w = __builtin_amdgcn_cvt_pk_fp8_f32(a, b, w, false); w = __builtin_amdgcn_cvt_pk_fp8_f32(c, d, w, true); return (unsigned)w; }
__device__ __forceinline__ float bf2f(unsigned short v) { return __uint_as_float((unsigned)v << 16); }
__device__ __forceinline__ vf4 ld4bf(const unsigned short* p) { const uint2 w = *(const uint2*)p; vf4 r; r.x = __uint_as_float(w.x << 16); r.y = __uint_as_float(w.x & 0xFFFF0000u); r.z = __uint_as_float(w.y << 16); r.w = __uint_as_float(w.y & 0xFFFF0000u); return r; }
__device__ __forceinline__ vf4 unp4bf(uint2 w) { vf4 r; r.x = __uint_as_float(w.x << 16); r.y = __uint_as_float(w.x & 0xFFFF0000u); r.z = __uint_as_float(w.y << 16); r.w = __uint_as_float(w.y & 0xFFFF0000u); return r; }
__device__ __forceinline__ void unp8bf(uint4 w, vf4& a, vf4& b) {
    a.x = __uint_as_float(w.x << 16); a.y = __uint_as_float(w.x & 0xFFFF0000u); a.z = __uint_as_float(w.y << 16); a.w = __uint_as_float(w.y & 0xFFFF0000u);
    b.x = __uint_as_float(w.z << 16); b.y = __uint_as_float(w.z & 0xFFFF0000u); b.z = __uint_as_float(w.w << 16); b.w = __uint_as_float(w.w & 0xFFFF0000u); }
__device__ __forceinline__ void ld8bf(const unsigned short* p, vf4& a, vf4& b) { const uint4 w = *(const uint4*)p;
    a.x = __uint_as_float(w.x << 16); a.y = __uint_as_float(w.x & 0xFFFF0000u); a.z = __uint_as_float(w.y << 16); a.w = __uint_as_float(w.y & 0xFFFF0000u);
    b.x = __uint_as_float(w.z << 16); b.y = __uint_as_float(w.z & 0xFFFF0000u); b.z = __uint_as_float(w.w << 16); b.w = __uint_as_float(w.w & 0xFFFF0000u); }
__device__ __forceinline__ float wave_sum(float v) {
#pragma unroll
    for (int o = 32; o >= 1; o >>= 1) v += __shfl_xor(v, o);
    return v;
}
typedef float vf2_ __attribute__((ext_vector_type(2)));
typedef __bf16 vb2_ __attribute__((ext_vector_type(2)));
__device__ __forceinline__ bf16_t f2bf(float f) { return __builtin_bit_cast(unsigned short, (__bf16)f); }
__device__ __forceinline__ unsigned pack2(float a, float b) { return __builtin_bit_cast(unsigned, __builtin_convertvector((vf2_){a, b}, vb2_)); }
__device__ __forceinline__ float silu_f(float x) { return x / (1.f + expf(-x)); }
__device__ __forceinline__ float rsqrt_fast(float x) { return __builtin_amdgcn_rsqf(x); }
__device__ __forceinline__ float silu_fast(float x) { return x * __builtin_amdgcn_rcpf(1.f + __expf(-x)); }
__device__ __forceinline__ float logsigmoid_fast(float x) { return fminf(x, 0.f) - __logf(1.f + __expf(-fabsf(x))); }
__device__ __forceinline__ float softplus_f(float x) { return fmaxf(x, 0.f) + log1pf(expf(-fabsf(x))); }
__device__ __forceinline__ float logsigmoid_f(float x) { return fminf(x, 0.f) - log1pf(expf(-fabsf(x))); }
__device__ __forceinline__ bool g1_fp8(int l, int f) { return f ? (G1B_MODE != 0) : (G1A_MODE != 0 || ((G1A_LAYERS >> l) & 1)); }
__device__ __forceinline__ int cond_of_row(int m) { return m < MC ? 0 : 1 + (m - MC) / LT; }
#ifndef CONV_FILLER
#define CONV_FILLER 1
#endif
__device__ __forceinline__ void conv_tile(const float* __restrict__ src, int ld_src, int ncols_src, int k0, int c0, bf16_t* __restrict__ dst, int ld_dst, int n0, float* tile) {
    const int tid = opaque_tid();
    {
        const int r = tid >> 3, c = (tid & 7) * 8;
        float4 a = make_float4(0.f, 0.f, 0.f, 0.f), b = a;
        if (c0 + c + 8 <= ncols_src) {
            const float* s = src + (size_t)(k0 + r) * ld_src + c0 + c;
            a = *(const float4*)s; b = *(const float4*)(s + 4);
        }
        float* t = tile + r * 65 + c;
        t[0] = a.x; t[1] = a.y; t[2] = a.z; t[3] = a.w; t[4] = b.x; t[5] = b.y; t[6] = b.z; t[7] = b.w;
    }
    __syncthreads();
    {
        const int n = tid >> 3, ks = (tid & 7) * 8;
        const float* t = tile + ks * 65 + n;
        uint4 w;
        w.x = pack2(t[0 * 65], t[1 * 65]); w.y = pack2(t[2 * 65], t[3 * 65]); w.z = pack2(t[4 * 65], t[5 * 65]); w.w = pack2(t[6 * 65], t[7 * 65]);
        *(uint4*)(dst + (size_t)(n0 + n) * ld_dst + k0 + ks) = w;
    }
    __syncthreads();
}

__device__ __forceinline__ void conv_tile8(const float* __restrict__ src, int ld_src, int nrows_src, int k0, int c0, unsigned char* __restrict__ dst, int ld_dst, int n0, float scale, float* tile) {
    const int tid = opaque_tid();
    {
        const int r = tid >> 3, c = (tid & 7) * 8;
        float4 a = make_float4(0.f, 0.f, 0.f, 0.f), b = a;
        if (k0 + r < nrows_src) { const float* s = src + (size_t)(k0 + r) * ld_src + c0 + c; a = *(const float4*)s; b = *(const float4*)(s + 4); }
        float* t = tile + r * 65 + c;
        t[0] = a.x * scale; t[1] = a.y * scale; t[2] = a.z * scale; t[3] = a.w * scale; t[4] = b.x * scale; t[5] = b.y * scale; t[6] = b.z * scale; t[7] = b.w * scale;
    }
    __syncthreads();
    {
        const int n = tid >> 3, ks = (tid & 7) * 8;
        const float* t = tile + ks * 65 + n;
        uint2 w; w.x = pack4_fp8(t[0 * 65], t[1 * 65], t[2 * 65], t[3 * 65]); w.y = pack4_fp8(t[4 * 65], t[5 * 65], t[6 * 65], t[7 * 65]);
        *(uint2*)(dst + (size_t)(n0 + n) * ld_dst + k0 + ks) = w;
    }
    __syncthreads();
}
constexpr int MOD_ITEMS = DEPTH * (NMOD / 128);
constexpr int TGU_KT = DM / 64, TGU_NT = NGU / 64, TDN_KT = (G2_FP8 ? FFP : FF) / 64, TDN_NT = DM / 64, TIN_KT = DM / 64, TIN_NT = NINP / 64, TOUT_KT = DM / 64, TOUT_NT = DM / 64;
constexpr int TL_GU = 2 * TGU_KT * TGU_NT, TL_DN = 2 * TDN_KT * TDN_NT, TL_IN = TIN_KT * TIN_NT, TL_OUT = TOUT_KT * TOUT_NT, NT_L = TL_GU + TL_DN + TL_IN + TL_OUT;
__device__ __forceinline__ void conv_layer_tiles(const Params& p, int l, int t_begin, int t_end, int first, int stride, float* s_tile) {
    for (int it = t_begin + first; it < t_end; it += stride) {
        if (it < TL_GU) {
            const int mat = l * 2 + it / (TGU_KT * TGU_NT), r = it % (TGU_KT * TGU_NT), kt = r / TGU_NT, nt = r % TGU_NT;
            const int n0 = nt * 64, t256 = n0 / 256, c = n0 % 256;
            const int c0 = c < 128 ? 128 * t256 + c : FF + 128 * t256 + (c - 128);
            if (g1_fp8(mat >> 1, mat & 1))
                conv_tile8(p.in[I_GU] + (size_t)mat * DM * NGU, NGU, DM, kt * 64, c0, WSP(unsigned char, WS_WGU) + (size_t)mat * NGU * DM * 2, DM, n0, WGU_SCALE, s_tile);
            else
                conv_tile(p.in[I_GU] + (size_t)mat * DM * NGU, NGU, NGU, kt * 64, c0, WSP(bf16_t, WS_WGU) + (size_t)mat * NGU * DM, DM, n0, s_tile);
        } else if (it < TL_GU + TL_DN) {
            const int i2 = it - TL_GU, mat = l * 2 + i2 / (TDN_KT * TDN_NT), r = i2 % (TDN_KT * TDN_NT), kt = r / TDN_NT, nt = r % TDN_NT;
#if G2_FP8
            conv_tile8(p.in[I_DOWN] + (size_t)mat * FF * DM, DM, FF, kt * 64, nt * 64, WSP(unsigned char, WS_WDN) + (size_t)mat * DM * FFP, FFP, nt * 64, WDN_SCALE, s_tile);
#else
            conv_tile(p.in[I_DOWN] + (size_t)mat * FF * DM, DM, DM, kt * 64, nt * 64, WSP(bf16_t, WS_WDN) + (size_t)mat * DM * FF, FF, nt * 64, s_tile);
#endif
        } else if (it < TL_GU + TL_DN + TL_IN) {
            const int i2 = it - TL_GU - TL_DN, kt = i2 / TIN_NT, nt = i2 % TIN_NT;
            conv_tile(p.in[I_WIN] + (size_t)l * DM * NIN, NIN, NIN, kt * 64, nt * 64, WSP(bf16_t, WS_WIN) + (size_t)l * NINP * DM, DM, nt * 64, s_tile);
        } else {
            const int i2 = it - TL_GU - TL_DN - TL_IN, kt = i2 / TOUT_NT, nt = i2 % TOUT_NT;
            conv_tile(p.in[I_WOUT] + (size_t)l * DM * DM, DM, DM, kt * 64, nt * 64, WSP(bf16_t, WS_WOUT) + (size_t)l * DM * DM, DM, nt * 64, s_tile);
        }
    }
}

__device__ __forceinline__ void mod_layer(const Params& p, int l, int first, int stride, float* smem) {
    const int tid = opaque_tid();
    float* s_cond = smem;
    float* s_red = s_cond + NCOND * DM;
    __syncthreads();
    for (int i = tid; i < NCOND * DM; i += 512) { const int ci = i / DM, k = i % DM; const float v = ci == 0 ? p.in[I_CCTX][k] : p.in[I_C][(size_t)(ci - 1) * DM + k]; s_cond[i] = silu_f(v); }
    __syncthreads();
    float* modv = WSP(float, WS_MODV);
    for (int jt = first; jt < NMOD / 128; jt += stride) {
        const int cl = tid & 127, kq = tid >> 7, col = jt * 128 + cl;
        const float* w = p.in[I_WMOD] + (size_t)l * DM * NMOD + col;
        float acc[NCOND];
#pragma unroll
        for (int ci = 0; ci < NCOND; ++ci) acc[ci] = 0.f;
        for (int k = kq * 512; k < kq * 512 + 512; k += 8) {
            float wv[8];
#pragma unroll
            for (int j = 0; j < 8; ++j) wv[j] = w[(size_t)(k + j) * NMOD];
#pragma unroll
            for (int ci = 0; ci < NCOND; ++ci) {
                const float4 s0 = *(const float4*)&s_cond[ci * DM + k], s1 = *(const float4*)&s_cond[ci * DM + k + 4];
                acc[ci] += s0.x * wv[0] + s0.y * wv[1] + s0.z * wv[2] + s0.w * wv[3] + s1.x * wv[4] + s1.y * wv[5] + s1.z * wv[6] + s1.w * wv[7];
            }
        }
        if (kq > 0) {
#pragma unroll
            for (int ci = 0; ci < NCOND; ++ci) s_red[((kq - 1) * 128 + cl) * NCOND + ci] = acc[ci];
        }
        __syncthreads();
        if (kq == 0) {
            const float bm = p.in[I_BMOD][(size_t)l * NMOD + col];
#pragma unroll
            for (int ci = 0; ci < NCOND; ++ci)
                modv[((size_t)l * NCOND + ci) * NMOD + col] = acc[ci] + s_red[(0 * 128 + cl) * NCOND + ci] + s_red[(1 * 128 + cl) * NCOND + ci] + s_red[(2 * 128 + cl) * NCOND + ci] + bm;
        }
        __syncthreads();
    }
}

__device__ __forceinline__ void phase_prologue(const Params& p, float* smem) {
    const int tid = threadIdx.x, nb = gridDim.x, bid = blockIdx.x;
    float* s_tile = smem + NCOND * DM + 3 * 128 * NCOND;
#if CONV_FILLER
    mod_layer(p, 0, bid, nb, smem);
#else
    for (int l2 = 0; l2 < DEPTH; ++l2) mod_layer(p, l2, bid, nb, smem);
#endif
    conv_layer_tiles(p, 0, 0, NT_L, bid, nb, s_tile);
#if !CONV_FILLER
    for (int l2 = 1; l2 < DEPTH; ++l2) conv_layer_tiles(p, l2, 0, NT_L, bid, nb, s_tile);
#endif
    const size_t gtid = (size_t)bid * 512 + tid, gstride = (size_t)nb * 512;
    {
        const size_t n_na = (size_t)LB * DEPTH * 256 * 512 / 8;
        for (size_t i = gtid; i < 2 * n_na; i += gstride) {
            const bool isv = i >= n_na; const size_t j = isv ? i - n_na : i;
            const int d8 = (int)(j % 16), h = (int)((j / 16) % 4), t = (int)((j / 64) % 256); const size_t bl = j / (64 * 256);
            const float* s = p.in[isv ? I_CNAV : I_CNAK] + ((bl * 4 + h) * 256 + t) * 128 + d8 * 8;
            const float4 a = *(const float4*)s, b = *(const float4*)(s + 4);
            uint4 w; w.x = pack2(a.x, a.y); w.y = pack2(a.z, a.w); w.z = pack2(b.x, b.y); w.w = pack2(b.z, b.w);
            *(uint4*)(WSP(bf16_t, isv ? WS_CNAV : WS_CNAK) + (bl * 256 + t) * 512 + h * 128 + d8 * 8) = w;
        }
        const size_t n_g = (size_t)LB * DEPTH * 256 * 256 / 8;
        for (size_t i = gtid; i < 2 * n_g; i += gstride) {
            const bool isv = i >= n_g; const size_t j = isv ? i - n_g : i;
            const int d8 = (int)(j % 16), h = (int)((j / 16) % 2), t = (int)((j / 32) % 256); const size_t bl = j / (32 * 256);
            const float* s = p.in[isv ? I_CGV : I_CGK] + ((bl * 2 + h) * 256 + t) * 128 + d8 * 8;
            const float4 a = *(const float4*)s, b = *(const float4*)(s + 4);
            uint4 w; w.x = pack2(a.x, a.y); w.y = pack2(a.z, a.w); w.z = pack2(b.x, b.y); w.w = pack2(b.z, b.w);
            *(uint4*)(WSP(bf16_t, isv ? WS_CGV : WS_CGK) + (bl * 256 + t) * 256 + h * 128 + d8 * 8) = w;
        }
    }
    for (size_t i = gtid; i < 64 * 32; i += gstride) {
        const int pos = (int)(i / 32), k = (int)(i % 32);
        const float inv = powf(10000.0f, -(float)(2 * k) / 64.0f);
        const float ang = (float)pos * inv;
        WSP(float, WS_ROPE)[i] = cosf(ang); WSP(float, WS_ROPE)[64 * 32 + i] = sinf(ang);
    }
}

__device__ __forceinline__ void phase_norm(const Params& p, int l, int which  ) {
    const int tid = opaque_tid(), lane = tid & 63, wv = tid >> 6;
    const float* X = WSP(float, WS_X); bf16_t* H = WSP(bf16_t, WS_H);
    const bool from_in = (l == 0 && which == 0);
    const float* g = p.in[I_NORMG] + ((size_t)l * 3 + which) * DM;
    const int nw = (int)gridDim.x * 8;
    for (int m0 = blockIdx.x * 8 + wv; m0 < M; m0 += 2 * nw) {
        const int m1 = m0 + nw; const bool has1 = m1 < M;
        const int mm[2] = {m0, has1 ? m1 : m0};
        vf4 v[2][8]; float ss[2] = {0.f, 0.f};
#pragma unroll
        for (int k = 0; k < 2; ++k) {
            const int m = mm[k];
            if (from_in || !XBF16) {
                const float* x = !from_in ? X + (size_t)m * DM : m < MC ? p.in[I_XP] + (size_t)m * DM : p.in[I_XS] + (size_t)(m - MC) * DM;
#pragma unroll
                for (int i = 0; i < 8; ++i) v[k][i] = *(const vf4*)(x + (i * 64 + lane) * 4);
            } else {
                const bf16_t* x = (const bf16_t*)X + (size_t)m * DM;
#pragma unroll
                for (int i = 0; i < 8; ++i) v[k][i] = ld4bf(x + (i * 64 + lane) * 4);
            }
        }
#pragma unroll
        for (int k = 0; k < 2; ++k) {
#pragma unroll
            for (int i = 0; i < 8; ++i) ss[k] += v[k][i].x * v[k][i].x + v[k][i].y * v[k][i].y + v[k][i].z * v[k][i].z + v[k][i].w * v[k][i].w;
            ss[k] = wave_sum(ss[k]);
        }
#pragma unroll
        for (int k = 0; k < 2; ++k) {
            if (k == 1 && !has1) break;
            const int m = mm[k];
            const float* mv = WSP(float, WS_MODV) + ((size_t)l * NCOND + cond_of_row(m)) * NMOD + (size_t)which * 3 * DM;
            const float r = rsqrt_fast(ss[k] * (1.0f / DM) + EPS);
#pragma unroll
            for (int i = 0; i < 8; ++i) {
                const int c = (i * 64 + lane) * 4;
                const float4 gg = *(const float4*)(g + c), sh = *(const float4*)(mv + c), sc = *(const float4*)(mv + DM + c);
                const float o0 = v[k][i].x * r * gg.x * (1.f + sc.x) + sh.x, o1 = v[k][i].y * r * gg.y * (1.f + sc.y) + sh.y;
                const float o2 = v[k][i].z * r * gg.z * (1.f + sc.z) + sh.z, o3 = v[k][i].w * r * gg.w * (1.f + sc.w) + sh.w;
                if (which != 1 && g1_fp8(l, which >> 1)) *(unsigned*)((unsigned char*)H + (size_t)m * DM + c) = pack4_fp8(o0, o1, o2, o3);
                else { uint2 w; w.x = pack2(o0, o1); w.y = pack2(o2, o3); *(uint2*)(H + (size_t)m * DM + c) = w; }
            }
            if (G2_FP8 && which != 1 && lane < (FFP - FF) / 4) *(unsigned*)(WSP(unsigned char, WS_ACT) + (size_t)m * FFP + FF + 4 * lane) = 0u;
        }
    }
}

__device__ __forceinline__ float red16(float v);
__device__ __forceinline__ float ssq8(vf4 a, vf4 b) { const vf4 s = a * a + b * b; return (s.x + s.y) + (s.z + s.w); }
__device__ __forceinline__ uint4 pack8(vf4 a, vf4 b) { uint4 w; w.x = pack2(a.x, a.y); w.y = pack2(a.z, a.w); w.z = pack2(b.x, b.y); w.w = pack2(b.z, b.w); return w; }
__device__ __forceinline__ void phase_prep(const Params& p, int l) {
    const int tid = opaque_tid(), lane = tid & 63, wv = tid >> 6, rg = lane >> 4, sub = lane & 15, c8 = sub * 8;
    const bf16_t* Z = WSP(bf16_t, WS_Z);
    const float* ropec = WSP(float, WS_ROPE); const float* ropes = ropec + 64 * 32;
    const float* wnq = p.in[I_NAQKN] + ((size_t)l * 2 + 0) * 128 + c8; const float* wnk = wnq + 128;
    const float* wgq = p.in[I_GQAQKN] + ((size_t)l * 2 + 0) * 128 + c8; const float* wgk = wgq + 128;
    const float* cw = p.in[I_CONV] + (size_t)l * 5 * 1536 + rg * 128 + c8;
    const int rpw = (M + (int)gridDim.x * 8 - 1) / ((int)gridDim.x * 8);
    for (int m = ((int)blockIdx.x * 8 + wv) * rpw, mend = (m + rpw < M ? m + rpw : M); m < mend; ++m) {
        const bf16_t* z = Z + (size_t)m * NINP;
        const bool ctx = m < MC;
        const int b = ctx ? m / CT : (m - MC) / LT, t = ctx ? m % CT : (m - MC) % LT, T = ctx ? CT : LT;
        const int ho = rg * 128 + c8;
        uint4 rz[5]; uint2 rgz[2][4];
        {
            const bf16_t* zkv = z + (rg < 2 ? Z_GQK + rg * 128 : Z_GQV + (rg - 2) * 128) + c8;
            rz[0] = *(const uint4*)(z + Z_NAQ + ho); rz[1] = *(const uint4*)(z + Z_NAK + ho); rz[2] = *(const uint4*)(z + Z_NAV + ho); rz[3] = *(const uint4*)(z + Z_GQQ + ho); rz[4] = *(const uint4*)zkv;
#pragma unroll
            for (int dir = 0; dir < 2; ++dir)
#pragma unroll
                for (int r4 = 0; r4 < 4; ++r4) rgz[dir][r4] = *(const uint2*)(z + (dir ? Z_GB : Z_GF) + 4 * r4);
        }
        asm volatile("" ::: "memory");
        {
            vf4 q0, q1, k0, k1, v0, v1, g0, g1, x0, x1;
            unp8bf(rz[0], q0, q1); unp8bf(rz[1], k0, k1); unp8bf(rz[2], v0, v1); unp8bf(rz[3], g0, g1); unp8bf(rz[4], x0, x1);
            float r = rsqrt_fast(red16(ssq8(q0, q1)) * (1.0f / 128) + EPS);
            q0 = q0 * r * *(const vf4*)wnq; q1 = q1 * r * *(const vf4*)(wnq + 4);
            *(uint4*)(WSP(bf16_t, WS_NAQ) + (size_t)m * 512 + ho) = pack8(q0, q1);
            r = rsqrt_fast(red16(ssq8(k0, k1)) * (1.0f / 128) + EPS);
            k0 = k0 * r * *(const vf4*)wnk; k1 = k1 * r * *(const vf4*)(wnk + 4);
            *(uint4*)(WSP(bf16_t, WS_NAK) + (size_t)m * 512 + ho) = pack8(k0, k1);
            *(uint4*)(WSP(bf16_t, WS_NAV) + (size_t)m * 512 + ho) = pack8(v0, v1);
            if (ctx) {
                const size_t o = ((((size_t)b * DEPTH + l) * 4 + rg) * CT + t) * 128 + c8;
                *(vf4*)(p.out + O_NAK + o) = k0; *(vf4*)(p.out + O_NAK + o + 4) = k1; *(vf4*)(p.out + O_NAV + o) = v0; *(vf4*)(p.out + O_NAV + o + 4) = v1;
            }
            r = rsqrt_fast(red16(ssq8(g0, g1)) * (1.0f / 128) + EPS);
            g0 = g0 * r * *(const vf4*)wgq; g1 = g1 * r * *(const vf4*)(wgq + 4);
            const float rk = rsqrt_fast(red16(ssq8(x0, x1)) * (1.0f / 128) + EPS);
            if (rg < 2) { x0 = x0 * rk * *(const vf4*)wgk; x1 = x1 * rk * *(const vf4*)(wgk + 4); }
            if (!ctx) {
                const int pos = sub < 8 ? (t >> 6) : (t & 63), ai = pos * 32 + (c8 & 31);
                const vf4 c0 = *(const vf4*)(ropec + ai), c1 = *(const vf4*)(ropec + ai + 4), s0 = *(const vf4*)(ropes + ai), s1 = *(const vf4*)(ropes + ai + 4);
                const bool hi = (sub & 4) != 0;
                vf4 pg0, pg1, px0, px1;
#pragma unroll
                for (int j = 0; j < 4; ++j) { pg0[j] = __shfl_xor(g0[j], 4); pg1[j] = __shfl_xor(g1[j], 4); px0[j] = __shfl_xor(x0[j], 4); px1[j] = __shfl_xor(x1[j], 4); }
                g0 = hi ? pg0 * s0 + g0 * c0 : g0 * c0 - pg0 * s0; g1 = hi ? pg1 * s1 + g1 * c1 : g1 * c1 - pg1 * s1;
                if (rg < 2) { x0 = hi ? px0 * s0 + x0 * c0 : x0 * c0 - px0 * s0; x1 = hi ? px1 * s1 + x1 * c1 : x1 * c1 - px1 * s1; }
            }
            *(uint4*)(WSP(bf16_t, WS_GQ) + (size_t)m * 512 + ho) = pack8(g0, g1);
            *(uint4*)(WSP(bf16_t, rg < 2 ? WS_GK : WS_GV) + (size_t)m * 256 + (rg & 1) * 128 + c8) = pack8(x0, x1);
            if (ctx) {
                const size_t o = ((((size_t)b * DEPTH + l) * 2 + (rg & 1)) * CT + t) * 128 + c8;
                float* dst = p.out + (rg < 2 ? O_GK : O_GV) + o;
                *(vf4*)dst = x0; *(vf4*)(dst + 4) = x1;
            }
        }
        asm volatile("" ::: "memory");
        {
#pragma unroll
            for (int dir = 0; dir < 2; ++dir) {
                const float* up = p.in[I_GUP] + ((size_t)l * 2 + dir) * 16 * 256 + 4 * lane;
                vf4 acc = *(const vf4*)(p.in[I_GBIAS] + ((size_t)l * 2 + dir) * 256 + 4 * lane);
#pragma unroll
                for (int r4 = 0; r4 < 4; ++r4) {
                    const vf4 gv = unp4bf(rgz[dir][r4]);
                    acc += gv.x * *(const vf4*)(up + (4 * r4 + 0) * 256) + gv.y * *(const vf4*)(up + (4 * r4 + 1) * 256) + gv.z * *(const vf4*)(up + (4 * r4 + 2) * 256) + gv.w * *(const vf4*)(up + (4 * r4 + 3) * 256);
                }
                vf4 o;
#pragma unroll
                for (int j = 0; j < 4; ++j) o[j] = logsigmoid_fast(acc[j]) * (1.0f / 16.0f);
                *(vf4*)(WSP(float, dir ? WS_AB : WS_AF) + (size_t)m * 256 + 4 * lane) = o;
            }
        }
        asm volatile("" ::: "memory");
        {
            uint4 rcz[3][5];
#pragma unroll
            for (int part = 0; part < 3; ++part)
#pragma unroll
                for (int j = 0; j < 5; ++j) { const int tt = t + j - 2;
                    rcz[part][j] = (tt >= 0 && tt < T) ? *(const uint4*)(Z + (size_t)(m + j - 2) * NINP + Z_DQKV + part * 512 + rg * 128 + c8) : make_uint4(0u, 0u, 0u, 0u); }
            asm volatile("" ::: "memory");
#pragma unroll
            for (int part = 0; part < 3; ++part) {
                vf4 a0 = (vf4){0.f, 0.f, 0.f, 0.f}, a1 = a0;
#pragma unroll
                for (int j = 0; j < 5; ++j) {
                    const float* cj = cw + j * 1536 + part * 512;
                    vf4 z0, z1; unp8bf(rcz[part][j], z0, z1);
                    a0 += *(const vf4*)cj * z0; a1 += *(const vf4*)(cj + 4) * z1;
                }
#pragma unroll
                for (int j = 0; j < 4; ++j) { a0[j] = silu_fast(a0[j]); a1[j] = silu_fast(a1[j]); }
                if (part < 2) { const float r = rsqrt_fast(red16(ssq8(a0, a1)) + EPS) * (part == 0 ? 0.08838834764831845f : 1.0f); a0 *= r; a1 *= r; }
                *(uint4*)(WSP(bf16_t, part == 0 ? WS_DQ : part == 1 ? WS_DK : WS_DV) + (size_t)m * 512 + rg * 128 + c8) = pack8(a0, a1);
                asm volatile("" ::: "memory");
            }
            if (lane < 8) {
                const float beta = 1.0f / (1.0f + expf(-bf2f(z[Z_DB + lane])));
                const float g = -expf(p.in[I_ALOG][(size_t)l * 8 + lane]) * softplus_f(bf2f(z[Z_DA + lane]) + p.in[I_DTB][(size_t)l * 8 + lane]);
                float* ba = WSP(float, WS_DBA) + (size_t)m * 16;
                ba[lane] = beta; ba[8 + lane] = g;
            }
        }
    }
}

typedef float vf2 __attribute__((ext_vector_type(2)));
__device__ __forceinline__ float dpp_f(float v, const int ctrl) { return v; }
#define DPPF(v, ctrl) __int_as_float(__builtin_amdgcn_mov_dpp(__float_as_int(v), (ctrl), 0xF, 0xF, true))
__device__ __forceinline__ float red8(float v) { v += DPPF(v, 0xB1); v += DPPF(v, 0x4E); v += DPPF(v, 0x141); return v; }
__device__ __forceinline__ float red16(float v) { v = red8(v); v += DPPF(v, 0x140); return v; }

__device__ __forceinline__ void phase_post(const Params& p, int l) {
    const int tid = opaque_tid(), lane = tid & 63, wv = tid >> 6, rg = lane >> 4, c8 = (lane & 15) * 8;
    const bf16_t* Z = WSP(bf16_t, WS_Z); bf16_t* MRG = WSP(bf16_t, WS_MRG);
    const float* wg = p.in[I_GLAON] + (size_t)l * 128 + c8; const float* wd = p.in[I_GDNON] + (size_t)l * 128 + c8;
    for (int m = blockIdx.x * 8 + wv; m < M; m += gridDim.x * 8) {
        const bf16_t* z = Z + (size_t)m * NINP;
        const int ho = rg * 128 + c8;
#pragma unroll
        for (int g = 0; g < 2; ++g) {
            const float* of = WSP(float, g ? WS_DOF : WS_GOF) + (size_t)m * 512 + ho; const float* ob = WSP(float, g ? WS_DOB : WS_GOB) + (size_t)m * 512 + ho;
            const float* w = g ? wd : wg; const bf16_t* zg = z + (g ? Z_DZ : Z_GLR) + ho;
            vf4 a0 = *(const vf4*)of + *(const vf4*)ob, a1 = *(const vf4*)(of + 4) + *(const vf4*)(ob + 4);
            vf4 g0, g1; ld8bf(zg, g0, g1);
            const float r = rsqrt_fast(red16(ssq8(a0, a1)) * (1.0f / 128) + EPS);
            a0 = a0 * r * *(const vf4*)w; a1 = a1 * r * *(const vf4*)(w + 4);
#pragma unroll
            for (int j = 0; j < 4; ++j) { a0[j] *= silu_fast(g0[j]); a1[j] *= silu_fast(g1[j]); }
            *(uint4*)(MRG + (size_t)m * DM + (g ? 1536 : 512) + ho) = pack8(a0, a1);
        }
    }
}
#define XB_TMO      128
#define XB_XCNT(j)  (256  + 64 * (j))
#define XB_XSUB(j)  (1280 + 64 * (j))
#define XB_XGEN(j)  (2304 + 64 * (j))
#define XB_TOP      3328
#define XB_TOPGEN   3392
#define XCD_BAR_WORDS 3456
#define XB_SPIN_CAP (1u << 22)
#define LAS __attribute__((address_space(3)))

__device__ __forceinline__ unsigned xb_ld(unsigned* p)              { return __hip_atomic_load(p, __ATOMIC_RELAXED, __HIP_MEMORY_SCOPE_AGENT); }
__device__ __forceinline__ unsigned xb_add(unsigned* p, unsigned v) { return __hip_atomic_fetch_add(p, v, __ATOMIC_RELAXED, __HIP_MEMORY_SCOPE_AGENT); }
__device__ __forceinline__ unsigned xb_xcc_id() { return (unsigned)__builtin_amdgcn_s_getreg((3 << 11) | 20) & 0xFu; }
#define XB_SPIN(cond, bar) do { unsigned _sp = 0; while (cond) { __builtin_amdgcn_s_sleep(1); \
    if ((++_sp & 255u) == 0u) { if (xb_ld(&(bar)[XB_TMO])) break; if (_sp > XB_SPIN_CAP) { atomicAdd(&(bar)[XB_TMO], 1u); break; } } } } while (0)

struct XcdBarrier {
    unsigned* bar; unsigned x;
    volatile LAS unsigned* st;
};

__device__ __forceinline__ XcdBarrier xcd_barrier_post(unsigned* bar, volatile LAS unsigned* st) {
    XcdBarrier b; b.bar = bar; b.x = xb_xcc_id(); b.st = st;
    if (threadIdx.x == 0) (void)xb_add(&bar[XB_XCNT(b.x)], 1u);
    return b;
}
__device__ __forceinline__ void xcd_barrier_complete(unsigned* bar, unsigned x, unsigned& nloc, unsigned& nx) {
    const unsigned G = gridDim.x * gridDim.y * gridDim.z;
    unsigned sum, cnt, mine, sp = 0u;
    for (;;) {
        sum = 0u; cnt = 0u; mine = 0u;
#pragma unroll
        for (unsigned j = 0; j < 16; ++j) { const unsigned c = xb_ld(&bar[XB_XCNT(j)]); sum += c; cnt += (c > 0u) ? 1u : 0u; mine = (j == x) ? c : mine; }
        if (sum == G) break;
        __builtin_amdgcn_s_sleep(1);
        if ((++sp & 255u) == 0u) { if (xb_ld(&bar[XB_TMO])) break; if (sp > XB_SPIN_CAP) { atomicAdd(&bar[XB_TMO], 1u); break; } }
    }
    nloc = mine > 0u ? mine : 1u; nx = cnt > 0u ? cnt : 1u;
}

__device__ __forceinline__ void xcd_barrier(const XcdBarrier& b) {
    asm volatile("s_waitcnt vmcnt(0)" ::: "memory");
    __syncthreads();
    if (threadIdx.x == 0) {
        unsigned* bar = b.bar;
        __builtin_amdgcn_s_waitcnt(0);
        unsigned nloc = b.st[0], nx = b.st[1];
        if (nloc == 0u) { xcd_barrier_complete(bar, b.x, nloc, nx); b.st[0] = nloc; b.st[1] = nx; }
        const unsigned old = xb_add(&bar[XB_XSUB(b.x)], 1u);
        const unsigned gen = old / nloc;
        if (old + 1u == (gen + 1u) * nloc) {
            __builtin_amdgcn_fence(__ATOMIC_RELEASE, "agent");
            asm volatile("s_waitcnt vmcnt(0)" ::: "memory");
            const unsigned og = xb_add(&bar[XB_TOP], 1u);
            const unsigned tg = og / nx;
            if (og + 1u == (tg + 1u) * nx) xb_add(&bar[XB_TOPGEN], 1u);
            else XB_SPIN(xb_ld(&bar[XB_TOPGEN]) == tg, bar);
            __builtin_amdgcn_fence(__ATOMIC_ACQUIRE, "agent");
            xb_add(&bar[XB_XGEN(b.x)], 1u);
            asm volatile("s_waitcnt vmcnt(0)" ::: "memory");
        } else {
            XB_SPIN(xb_ld(&bar[XB_XGEN(b.x)]) == gen, bar);
            __builtin_amdgcn_fence(__ATOMIC_ACQUIRE, "agent");
            asm volatile("s_waitcnt vmcnt(0)" ::: "memory");
        }
    }
    __syncthreads();
}

#ifndef NT_STORES
#define NT_STORES 0
#endif
namespace pg8 {
#define PG8_LAS __attribute__((address_space(3)))
typedef unsigned short bf16_t;
typedef short bf16x8 __attribute__((ext_vector_type(8)));
typedef float f32x4 __attribute__((ext_vector_type(4)));
typedef unsigned u32x4 __attribute__((ext_vector_type(4)));
typedef unsigned u32x2 __attribute__((ext_vector_type(2)));
typedef int v4i32 __attribute__((ext_vector_type(4)));
typedef int v8i32 __attribute__((ext_vector_type(8)));
constexpr int BM = 256, BK = 64, HALF = 128, HTB = HALF * BK * 2  , STAGE_BYTES = 8 * HTB, NXCD = 8, WGM = 8;

__host__ __device__ __forceinline__ int lds_byte(int r, int c) { const int st = (r >> 4) * 2 + (c >> 5), rr = r & 15, cc = c & 31, ob = rr * 64 + cc * 2; return st * 1024 + (ob ^ (((ob >> 9) & 1) << 5)); }
__host__ __device__ __forceinline__ void stage_rc(int b, int& R, int& C) { const int st = b / 1024, sb = b % 1024, swz = sb ^ (((sb >> 9) & 1) << 5); R = (st >> 1) * 16 + swz / 64; C = (st & 1) * 32 + (swz % 64) / 2; }
__host__ __device__ __forceinline__ int perm32(int rho) { const int n = rho >> 4, i = rho & 15; return 8 * (i >> 2) + 4 * n + (i & 3); }

struct Unit { int pm, pn, k0, nt, at, slot, msk; };
struct Gemm { const bf16_t* A; const bf16_t* Bt; int M, N, K; };

struct StaticOrder {
    int nM, nN, nwg, G, c, ntk, split, msplit;
    __host__ __device__ void init(int M, int N, int K, int G_, int c_, int split_ = 0) { nM = M / BM; nN = N / BM; nwg = nM * nN; G = G_; c = c_; ntk = K / BK; const int rem = nwg % G_; split = (split_ == 1 && rem > 0 && 2 * rem == G_ && ntk >= 8) ? 1 : 0; msplit = (split_ == 2 && rem > 0 && 2 * rem <= G_) ? 1 : 0; }
    __host__ __device__ bool next(int i, Unit& u) const {
        long L = (long)i * G + c; u.k0 = 0; u.nt = ntk; u.at = 0; u.slot = 0; u.msk = 3;
        if (msplit && i == nwg / G) { const int rem = nwg % G; if (c >= 2 * rem) return false; L = (long)i * G + (c % rem); u.msk = (c / rem) ? 2 : 1; }
        if (split && i == nwg / G) { const int rem = nwg % G, sl = c / rem, h0 = ((ntk / 2) + 1) & ~1; L = (long)i * G + (c % rem); u.k0 = sl ? h0 * BK : 0; u.nt = sl ? ntk - h0 : h0; u.at = sl ? 1 : 2; u.slot = c % rem; }
        if (L >= nwg) return false;
        int wgid = (int)L; { const int q = nwg / NXCD, r = nwg % NXCD, xcd = wgid % NXCD, off = wgid / NXCD; wgid = (xcd < r ? xcd * (q + 1) : r * (q + 1) + (xcd - r) * q) + off; }
        const int nig = WGM * nN, gid = wgid / nig, fm = gid * WGM, gsz = (nM - fm) < WGM ? (nM - fm) : WGM;
        u.pm = fm + ((wgid % nig) % gsz); u.pn = (wgid % nig) / gsz; return true;
    }
    __device__ __forceinline__ void a_ready(const Unit&) const {}
    __device__ __forceinline__ void done(const Unit&) const {}
};
__device__ __forceinline__ unsigned cvt_pk_bf16(float lo, float hi) { unsigned r; asm volatile("v_cvt_pk_bf16_f32 %0, %1, %2" : "=v"(r) : "v"(lo), "v"(hi)); return r; }
struct EpiF32 {
    static constexpr bool PERM = false, AFTER_DRAIN = false;
    float* C; int ldc; const float* bias;
    __device__ __forceinline__ void operator()(const f32x4 (&acc)[2][2][4][2], const Unit& u, int wr, int wc, int fr, int fq) const {
        const int row0 = u.pm * BM + wr * 64 + fr, col0 = u.pn * BM + wc * 32 + 4 * fq;
        f32x4 bv[2][2];
#pragma unroll
        for (int bj = 0; bj < 2; ++bj)
#pragma unroll
            for (int n = 0; n < 2; ++n) bv[bj][n] = bias ? *(const f32x4*)(bias + col0 + bj * HALF + n * 16) : (f32x4){0.f, 0.f, 0.f, 0.f};
#pragma unroll
        for (int ai = 0; ai < 2; ++ai)
#pragma unroll
            for (int m = 0; m < 4; ++m) { float* rowp = C + (size_t)(row0 + ai * HALF + m * 16) * ldc + col0;
#pragma unroll
                for (int bj = 0; bj < 2; ++bj)
#pragma unroll
                    for (int n = 0; n < 2; ++n) *(f32x4*)(rowp + bj * HALF + n * 16) = acc[ai][bj][m][n] + bv[bj][n]; }
    }
};

struct EpiSwiGLU {
    static constexpr bool PERM = true, AFTER_DRAIN = false;
    bf16_t* O; int ldc;
    __device__ __forceinline__ void operator()(const f32x4 (&acc)[2][2][4][2], const Unit& u, int wr, int wc, int fr, int fq) const {
        const int row0 = u.pm * BM + wr * 64 + fr, col0 = u.pn * 128 + wc * 32 + 8 * fq;
#pragma unroll
        for (int ai = 0; ai < 2; ++ai) if ((u.msk >> ai) & 1)
#pragma unroll
            for (int m = 0; m < 4; ++m) { bf16_t* rowp = O + (size_t)(row0 + ai * HALF + m * 16) * ldc + col0;
                const f32x4 g0 = acc[ai][0][m][0], g1 = acc[ai][0][m][1], u0 = acc[ai][1][m][0], u1 = acc[ai][1][m][1];
                float r[8];
#pragma unroll
                for (int j = 0; j < 4; ++j) {
                    r[j]     = g0[j] * __builtin_amdgcn_rcpf(1.0f + __builtin_amdgcn_exp2f(-1.4426950408889634f * g0[j])) * u0[j];
                    r[4 + j] = g1[j] * __builtin_amdgcn_rcpf(1.0f + __builtin_amdgcn_exp2f(-1.4426950408889634f * g1[j])) * u1[j]; }
                u32x4 w; w.x = cvt_pk_bf16(r[0], r[1]); w.y = cvt_pk_bf16(r[2], r[3]); w.z = cvt_pk_bf16(r[4], r[5]); w.w = cvt_pk_bf16(r[6], r[7]);
#if NT_STORES
                __builtin_nontemporal_store(w, (u32x4*)rowp);
#else
                *(u32x4*)rowp = w;
#endif
                }
    }
};
struct EpiSwiGLU8 {
    static constexpr bool PERM = true, AFTER_DRAIN = false;
    unsigned char* O; int ldc; float wscale;
    __device__ __forceinline__ void operator()(const f32x4 (&acc)[2][2][4][2], const Unit& u, int wr, int wc, int fr, int fq) const {
        const int row0 = u.pm * BM + wr * 64 + fr, col0 = u.pn * 128 + wc * 32 + 8 * fq;
#pragma unroll
        for (int ai = 0; ai < 2; ++ai) if ((u.msk >> ai) & 1)
#pragma unroll
            for (int m = 0; m < 4; ++m) { unsigned char* rowp = O + (size_t)(row0 + ai * HALF + m * 16) * ldc + col0;
                f32x4 g0 = acc[ai][0][m][0], g1 = acc[ai][0][m][1], u0 = acc[ai][1][m][0], u1 = acc[ai][1][m][1];
                asm volatile("" : "+v"(g0), "+v"(g1), "+v"(u0), "+v"(u1));
                g0 *= wscale; g1 *= wscale; u0 *= wscale; u1 *= wscale;
                float r[8];
#pragma unroll
                for (int j = 0; j < 4; ++j) {
                    r[j]     = g0[j] * __builtin_amdgcn_rcpf(1.0f + __builtin_amdgcn_exp2f(-1.4426950408889634f * g0[j])) * u0[j];
                    r[4 + j] = g1[j] * __builtin_amdgcn_rcpf(1.0f + __builtin_amdgcn_exp2f(-1.4426950408889634f * g1[j])) * u1[j]; }
                uint2 w; w.x = pack4_fp8(r[0], r[1], r[2], r[3]); w.y = pack4_fp8(r[4], r[5], r[6], r[7]);
                *(uint2*)rowp = w; asm volatile("" ::: "memory"); }
    }
};
struct EpiBf16Plain {
    static constexpr bool PERM = true, AFTER_DRAIN = false;
    bf16_t* O; int ldc;
    __device__ __forceinline__ void operator()(const f32x4 (&acc)[2][2][4][2], const Unit& u, int wr, int wc, int fr, int fq) const {
        const int row0 = u.pm * BM + wr * 64 + fr, col0 = u.pn * BM + wc * 32 + 8 * fq;
#pragma unroll
        for (int ai = 0; ai < 2; ++ai) if ((u.msk >> ai) & 1)
#pragma unroll
            for (int m = 0; m < 4; ++m) { bf16_t* rowp = O + (size_t)(row0 + ai * HALF + m * 16) * ldc + col0;
#pragma unroll
                for (int bj = 0; bj < 2; ++bj) { const f32x4 v0 = acc[ai][bj][m][0], v1 = acc[ai][bj][m][1];
                    u32x4 w; w.x = pack2(v0[0], v0[1]); w.y = pack2(v0[2], v0[3]); w.z = pack2(v1[0], v1[1]); w.w = pack2(v1[2], v1[3]);
                    *(u32x4*)(rowp + bj * HALF) = w; } }
    }
};
struct EpiResid {
    static constexpr bool PERM = false, AFTER_DRAIN = false;
    const float* res; float* out; int ldc; const float* gate0; float coef;
    float* slab; unsigned* flags; unsigned target;
    const float* res_hi; int row_hi;
    int res_bf16, out_bf16;
    __device__ __forceinline__ void operator()(const f32x4 (&acc)[2][2][4][2], const Unit& u, int wr, int wc, int fr, int fq) const {
        const int tidx = ((wr * 4 + wc) * 4 + fq) * 16 + fr;
        if (u.at == 1) {
            const __amdgpu_buffer_rsrc_t rs = __builtin_amdgcn_make_buffer_rsrc((void*)slab, 0, 0x7FFFFFF0, 0x00020000);
            const unsigned base = ((unsigned)u.slot * 32u * 512u + (unsigned)tidx) * 16u;
#pragma unroll
            for (int ai = 0; ai < 2; ++ai)
#pragma unroll
                for (int bj = 0; bj < 2; ++bj)
#pragma unroll
                    for (int m = 0; m < 4; ++m)
#pragma unroll
                        for (int n = 0; n < 2; ++n) { const f32x4 v = acc[ai][bj][m][n]; u32x4 w; w.x = __float_as_uint(v[0]); w.y = __float_as_uint(v[1]); w.z = __float_as_uint(v[2]); w.w = __float_as_uint(v[3]);
                            __builtin_amdgcn_raw_buffer_store_b128(w, rs, base + (unsigned)((((ai * 2 + bj) * 4 + m) * 2 + n) * 512 * 16), 0, 16); }
            asm volatile("s_waitcnt vmcnt(0)" ::: "memory");
            if ((tidx & 63) == 0) __hip_atomic_fetch_add(flags + 64 * u.slot, 1u, __ATOMIC_RELAXED, __HIP_MEMORY_SCOPE_AGENT);
            return;
        }
        const float* part = nullptr;
        if (u.at == 2) {
            unsigned spins = 0;
            while (__hip_atomic_load(flags + 64 * u.slot, __ATOMIC_RELAXED, __HIP_MEMORY_SCOPE_AGENT) < target) { __builtin_amdgcn_s_sleep(2); if (++spins > (1u << 22)) break; }
            __builtin_amdgcn_fence(__ATOMIC_ACQUIRE, "agent");
            asm volatile("s_waitcnt vmcnt(0)" ::: "memory");
            part = slab + ((size_t)u.slot * 32 * 512 + tidx) * 4;
        }
        const int row0 = u.pm * BM + wr * 64 + fr, col0 = u.pn * BM + wc * 32 + 4 * fq;
        const float* gate = gate0 + (size_t)cond_of_row(u.pm * BM) * NMOD;
        const float* rbase = (u.pm * BM >= row_hi) ? res_hi - (size_t)row_hi * ldc : res;
        f32x4 gv[2][2];
#pragma unroll
        for (int bj = 0; bj < 2; ++bj)
#pragma unroll
            for (int n = 0; n < 2; ++n) gv[bj][n] = *(const f32x4*)(gate + col0 + bj * HALF + n * 16) * coef;
#pragma unroll
        for (int ai = 0; ai < 2; ++ai) if ((u.msk >> ai) & 1)
#pragma unroll
            for (int m = 0; m < 4; ++m) { const size_t off = (size_t)(row0 + ai * HALF + m * 16) * ldc + col0;
#pragma unroll
                for (int bj = 0; bj < 2; ++bj)
#pragma unroll
                    for (int n = 0; n < 2; ++n) {
                        f32x4 a = acc[ai][bj][m][n];
                        if (part) a += *(const f32x4*)(part + (size_t)((((ai * 2 + bj) * 4 + m) * 2 + n) * 512 * 4));
                        const size_t eo = off + bj * HALF + n * 16;
                        f32x4 bs;
                        if (res_bf16) { const u32x2 w = *(const u32x2*)((const bf16_t*)rbase + eo); bs[0] = __uint_as_float(w.x << 16); bs[1] = __uint_as_float(w.x & 0xFFFF0000u); bs[2] = __uint_as_float(w.y << 16); bs[3] = __uint_as_float(w.y & 0xFFFF0000u); }
                        else bs = *(const f32x4*)(rbase + eo);
                        const f32x4 o = bs + gv[bj][n] * a;
                        if (out_bf16) { u32x2 w; w.x = cvt_pk_bf16(o[0], o[1]); w.y = cvt_pk_bf16(o[2], o[3]); *(u32x2*)((bf16_t*)out + eo) = w; }
                        else *(f32x4*)(out + eo) = o; }
                asm volatile("" ::: "memory"); }
    }
};
template <class Epi, class Sched, bool STAMP = false, int FP8 = 0>
__device__ __forceinline__ void gemm_phase(PG8_LAS unsigned char* lds, const Gemm g, const Sched& S, const Epi& E, unsigned long long* stamps) {
    const int tid = opaque_tid(), wid = __builtin_amdgcn_readfirstlane(tid >> 6), lane = tid & 63, wr = wid >> 2, wc = wid & 3, fr = lane & 15, fq = lane >> 4;
    const int K = g.K;
    int ts_lo = 0, ts_hi = 0, nts = 0; const unsigned long long rt_entry = STAMP ? (unsigned long long)wall_clock64() : 0ull;
#define PG8_STAMP() do { if (STAMP && wid == 0 && nts < 64) { const unsigned long long _c = (unsigned long long)clock64(); \
        ts_lo = (lane == nts) ? (int)(unsigned)_c : ts_lo; ts_hi = (lane == nts) ? (int)(unsigned)(_c >> 32) : ts_hi; ++nts; } } while (0)
    PG8_STAMP();
    unsigned voffA[2], voffB[2];
#pragma unroll
    for (int i = 0; i < 2; ++i) { int R, C; stage_rc(tid * 16 + i * 8192, R, C); const int Rb = Epi::PERM ? ((R & ~31) + perm32(R & 31)) : R;
        voffA[i] = (unsigned)(R * K + C) * 2u; voffB[i] = (unsigned)(Rb * K + C) * 2u; }
    const size_t kstep = (size_t)(BK * 2);
    const size_t hstep = (size_t)HALF * K * 2;
    const size_t tstep = 2 * hstep;
    const unsigned ldsw = (unsigned)wid * 1024u;
    const int aoff = lds_byte(wr * 64 + fr, fq * 8), boff = lds_byte(wc * 32 + fr, fq * 8);
#define PG8_SA(b, h) (((b) * 2 + (h)) * HTB)
#define PG8_SB(b, h) ((4 + (b) * 2 + (h)) * HTB)
#define PG8_STAGE(bufoff, gbase, voff) do { _Pragma("unroll") for (int _i = 0; _i < 2; ++_i) \
        __builtin_amdgcn_global_load_lds((const unsigned*)((const char*)(gbase) + (voff)[_i]), (PG8_LAS unsigned*)(lds + (bufoff) + ldsw + _i * 8192), 16, 0, 0); } while (0)
#define PG8_LDA(dst, b, h) do { _Pragma("unroll") for (int m = 0; m < 4; ++m) dst[m] = __builtin_shufflevector(*(const PG8_LAS v4i32*)(lds + PG8_SA(b, h) + aoff + m * 2048), *(const PG8_LAS v4i32*)(lds + PG8_SA(b, h) + aoff + m * 2048 + 1024), 0, 1, 2, 3, 4, 5, 6, 7); } while (0)
#define PG8_LDB(dst, b, h) do { _Pragma("unroll") for (int n = 0; n < 2; ++n) dst[n] = __builtin_shufflevector(*(const PG8_LAS v4i32*)(lds + PG8_SB(b, h) + boff + n * 2048), *(const PG8_LAS v4i32*)(lds + PG8_SB(b, h) + boff + n * 2048 + 1024), 0, 1, 2, 3, 4, 5, 6, 7); } while (0)
#define PG8_HALF(v, k) __builtin_bit_cast(bf16x8, __builtin_shufflevector(v, v, 4 * (k), 4 * (k) + 1, 4 * (k) + 2, 4 * (k) + 3))
#define PG8_MMA(ai, bj, At, Bt) do { __builtin_amdgcn_s_setprio(1); _Pragma("unroll") for (int m = 0; m < 4; ++m) _Pragma("unroll") for (int n = 0; n < 2; ++n) { \
        acc[ai][bj][m][n] = __builtin_amdgcn_mfma_f32_16x16x32_bf16(PG8_HALF(Bt[n], 0), PG8_HALF(At[m], 0), acc[ai][bj][m][n], 0, 0, 0); \
        acc[ai][bj][m][n] = __builtin_amdgcn_mfma_f32_16x16x32_bf16(PG8_HALF(Bt[n], 1), PG8_HALF(At[m], 1), acc[ai][bj][m][n], 0, 0, 0); } __builtin_amdgcn_s_setprio(0); } while (0)
#define PG8_MMA8(ai, bj, At, Bt) do { __builtin_amdgcn_s_setprio(1); _Pragma("unroll") for (int m = 0; m < 4; ++m) _Pragma("unroll") for (int n = 0; n < 2; ++n) \
        acc[ai][bj][m][n] = __builtin_amdgcn_mfma_scale_f32_16x16x128_f8f6f4(Bt[n], At[m], acc[ai][bj][m][n], 0, 0, 0, 127, 0, 127); __builtin_amdgcn_s_setprio(0); } while (0)
#define PG8_Q64(v, q) __builtin_bit_cast(long, __builtin_shufflevector(v, v, 2 * (q), 2 * (q) + 1))
#define PG8_M8L1(ai, bj, m, n, q) acc[ai][bj][m][n] = __builtin_amdgcn_mfma_f32_16x16x32_fp8_fp8(PG8_Q64(Bt_[n], q), PG8_Q64(At_[m], q), acc[ai][bj][m][n], 0, 0, 0)
#define PG8_MMA8L(ai, bj, At, Bt) do { auto& At_ = At; auto& Bt_ = Bt; __builtin_amdgcn_s_setprio(1); _Pragma("unroll") for (int m = 0; m < 4; ++m) _Pragma("unroll") for (int n = 0; n < 2; ++n) { \
        PG8_M8L1(ai, bj, m, n, 0); PG8_M8L1(ai, bj, m, n, 1); PG8_M8L1(ai, bj, m, n, 2); PG8_M8L1(ai, bj, m, n, 3); } __builtin_amdgcn_s_setprio(0); } while (0)
#define PG8_MMAG(ai, bj, At, Bt) do { if (mrow & (1 << (ai))) { if constexpr (FP8 == 1) PG8_MMA8(ai, bj, At, Bt); else if constexpr (FP8 == 2) PG8_MMA8L(ai, bj, At, Bt); else PG8_MMA(ai, bj, At, Bt); } } while (0)
#define PG8_WAIT_V(n) asm volatile("s_waitcnt vmcnt(" #n ")" ::: "memory")
#define PG8_WAIT_L(n) asm volatile("s_waitcnt lgkmcnt(" #n ")" ::: "memory")
#define PG8_BAR __builtin_amdgcn_s_barrier()
#define PG8_SCHED __builtin_amdgcn_sched_barrier(0)
    Unit cur, nxt; int ui = 0;
    if (!S.next(0, cur)) return;
    f32x4 acc[2][2][4][2];
#pragma unroll
    for (int a = 0; a < 2; ++a)
#pragma unroll
        for (int b = 0; b < 2; ++b)
#pragma unroll
            for (int m = 0; m < 4; ++m)
#pragma unroll
                for (int n = 0; n < 2; ++n) acc[a][b][m][n] = (f32x4){0.f, 0.f, 0.f, 0.f};
    v8i32 At[4], B0[2], B1[2];
    const char* cA = (const char*)g.A + (size_t)cur.pm * tstep + (size_t)cur.k0 * 2; const char* cB = (const char*)g.Bt + (size_t)cur.pn * tstep + (size_t)cur.k0 * 2;
    S.a_ready(cur);
    PG8_STAGE(PG8_SB(0, 0), cB, voffB); PG8_STAGE(PG8_SA(0, 0), cA, voffA); PG8_STAGE(PG8_SB(0, 1), cB + hstep, voffB); PG8_STAGE(PG8_SA(0, 1), cA + hstep, voffA);
    if (wr == 1) PG8_BAR;
    PG8_WAIT_V(4); PG8_BAR;
    PG8_STAGE(PG8_SB(1, 0), cB + kstep, voffB); PG8_STAGE(PG8_SA(1, 0), cA + kstep, voffA); PG8_STAGE(PG8_SB(1, 1), cB + hstep + kstep, voffB);
    PG8_WAIT_V(6); PG8_BAR;
    PG8_STAMP();
    for (;;) {
        const bool has_next = S.next(ui + 1, nxt);
        const char* nA = has_next ? (const char*)g.A + (size_t)nxt.pm * tstep + (size_t)nxt.k0 * 2 : cA; const char* nB = has_next ? (const char*)g.Bt + (size_t)nxt.pn * tstep + (size_t)nxt.k0 * 2 : cB;
        const int nt = cur.nt, mrow = cur.msk;
        for (int t = 0; t < nt; t += 2) {
            const bool last = (t == nt - 2);
            const char* a1 = cA + (size_t)(t + 1) * kstep;
            const char* a2 = last ? nA : cA + (size_t)(t + 2) * kstep; const char* b2 = last ? nB : cB + (size_t)(t + 2) * kstep;
            const char* a3 = a2 + kstep; const char* b3 = b2 + kstep;
            if (last && has_next) S.a_ready(nxt);
            PG8_LDB(B0, 0, 0); PG8_SCHED; PG8_LDA(At, 0, 0); PG8_STAGE(PG8_SA(1, 1), a1 + hstep, voffA);
            PG8_WAIT_L(8); PG8_BAR; PG8_WAIT_L(0); PG8_MMAG(0, 0, At, B0); PG8_BAR; PG8_SCHED;
            PG8_LDB(B1, 0, 1); PG8_STAGE(PG8_SB(0, 0), b2, voffB);
            PG8_BAR; PG8_WAIT_L(0); PG8_MMAG(0, 1, At, B1); PG8_BAR;
            PG8_LDA(At, 0, 1); PG8_STAGE(PG8_SA(0, 0), a2, voffA);
            PG8_BAR; PG8_WAIT_L(0); PG8_MMAG(1, 0, At, B0); PG8_BAR; PG8_SCHED;
            PG8_STAGE(PG8_SB(0, 1), b2 + hstep, voffB);
            PG8_WAIT_V(6); PG8_BAR; PG8_MMAG(1, 1, At, B1); PG8_BAR;
            PG8_LDB(B0, 1, 0); PG8_SCHED; PG8_LDA(At, 1, 0); PG8_STAGE(PG8_SA(0, 1), a2 + hstep, voffA);
            PG8_WAIT_L(8); PG8_BAR; PG8_WAIT_L(0); PG8_MMAG(0, 0, At, B0); PG8_BAR; PG8_SCHED;
            PG8_LDB(B1, 1, 1); PG8_STAGE(PG8_SB(1, 0), b3, voffB);
            PG8_BAR; PG8_WAIT_L(0); PG8_MMAG(0, 1, At, B1); PG8_BAR;
            PG8_LDA(At, 1, 1); PG8_STAGE(PG8_SA(1, 0), a3, voffA);
            PG8_BAR; PG8_WAIT_L(0); PG8_MMAG(1, 0, At, B0); PG8_BAR; PG8_SCHED;
            PG8_STAGE(PG8_SB(1, 1), b3 + hstep, voffB);
            PG8_WAIT_V(6); PG8_BAR; PG8_MMAG(1, 1, At, B1); PG8_BAR;
        }
        PG8_STAMP();
        if constexpr (!Epi::AFTER_DRAIN) { E(acc, cur, wr, wc, fr, fq); S.done(cur); }
        PG8_STAMP();
        if (!has_next) break;
#pragma unroll
        for (int a = 0; a < 2; ++a)
#pragma unroll
            for (int b = 0; b < 2; ++b)
#pragma unroll
                for (int m = 0; m < 4; ++m)
#pragma unroll
                    for (int n = 0; n < 2; ++n) acc[a][b][m][n] = (f32x4){0.f, 0.f, 0.f, 0.f};
        cur = nxt; cA = nA; cB = nB; ++ui;
    }
    PG8_WAIT_V(0);
    if (wr == 0) PG8_BAR;
    PG8_BAR;
    if constexpr (Epi::AFTER_DRAIN) { E.fused(acc, cur, wr, wc, fr, fq, lds, wid, lane); S.done(cur); }
    PG8_STAMP();
    if (STAMP && wid == 0) { stamps[lane] = lane < nts ? (((unsigned long long)(unsigned)ts_hi << 32) | (unsigned)ts_lo) : 0ull;
        if (lane == 62) stamps[62] = rt_entry; if (lane == 63) stamps[63] = (unsigned long long)wall_clock64(); }
#undef PG8_STAMP
#undef PG8_SA
#undef PG8_SB
#undef PG8_STAGE
#undef PG8_LDA
#undef PG8_LDB
#undef PG8_HALF
#undef PG8_MMA
#undef PG8_MMA8
#undef PG8_MMA8L
#undef PG8_M8L1
#undef PG8_Q64
#undef PG8_MMAG
#undef PG8_WAIT_V
#undef PG8_WAIT_L
#undef PG8_BAR
#undef PG8_SCHED
}
}
#ifndef ATT_INLINE
#define ATT_INLINE __forceinline__
#endif
namespace att {
constexpr int D = 128, NW = 8, QBLK = 32, KVBLK = 64, LDQ = 512, LDO = DM;
constexpr float SCALE = 0.088388347648318440f;
constexpr float THR = 8.f;
constexpr size_t SHM_V = KVBLK * D * 2, SHM_K = KVBLK * D * 2, SHM_Q = 256 * D * 2, SHM_ATTN = 2 * SHM_V + 2 * SHM_K + NW * 64 * 4 + SHM_Q;
using bf16x8 = __attribute__((ext_vector_type(8))) short;
using s16x4  = __attribute__((ext_vector_type(4))) short;
using f32x16 = __attribute__((ext_vector_type(16))) float;
using u32x4  = __attribute__((ext_vector_type(4))) unsigned;
#define KSWZ(row, colB) ((row) * 256 + ((colB) ^ (((row) & 7) << 4)))
#define SBAR() __builtin_amdgcn_sched_barrier(0)
__device__ __forceinline__ int crow(int r, int hi) { return (r & 3) + 8 * (r >> 2) + 4 * hi; }
__device__ __forceinline__ unsigned cvtpk(float lo, float hi) { unsigned r; asm volatile("v_cvt_pk_bf16_f32 %0, %1, %2" : "=v"(r) : "v"(lo), "v"(hi)); return r; }

__device__ __forceinline__ void partialSM(f32x16& p0, f32x16& p1, float& m_reg, float& mn, float& alpha) {
  constexpr float C = SCALE * 1.4426950408889634f;
  float pmax = p0[0]; for (int r = 1; r < 16; ++r) pmax = fmaxf(pmax, p0[r]); for (int r = 0; r < 16; ++r) pmax = fmaxf(pmax, p1[r]);
  { auto rr = __builtin_amdgcn_permlane32_swap(__float_as_uint(pmax), __float_as_uint(pmax), false, false);
    pmax = fmaxf(__uint_as_float(rr[0]), __uint_as_float(rr[1])); }
  if (__builtin_expect(__all(pmax - m_reg <= THR / SCALE), 1)) { mn = m_reg; alpha = 1.f; }
  else { mn = fmaxf(m_reg, pmax); alpha = __builtin_amdgcn_exp2f((m_reg - mn) * C); m_reg = mn; }
  float mnC = -mn * C;
  for (int r = 0; r < 16; ++r) p0[r] = fmaf(p0[r], C, mnC); for (int r = 0; r < 16; ++r) p1[r] = fmaf(p1[r], C, mnC);
  for (int r = 0; r < 16; ++r) p0[r] = __builtin_amdgcn_exp2f(p0[r]);
}
__device__ __forceinline__ void finishSM(f32x16& p0, f32x16& p1, float alpha, float& l_reg, bf16x8& pa0, bf16x8& pa1, bf16x8& pa2, bf16x8& pa3) {
  for (int r = 0; r < 16; ++r) p1[r] = __builtin_amdgcn_exp2f(p1[r]);
  float ps = 0; for (int r = 0; r < 16; ++r) ps += p0[r]; for (int r = 0; r < 16; ++r) ps += p1[r];
  { auto rr = __builtin_amdgcn_permlane32_swap(__float_as_uint(ps), __float_as_uint(ps), false, false);
    ps = __uint_as_float(rr[0]) + __uint_as_float(rr[1]); }
  l_reg = l_reg * alpha + ps;
#define PK4(P, BASE, OUT) do { unsigned a0 = cvtpk(P[BASE + 0], P[BASE + 1]), a1 = cvtpk(P[BASE + 2], P[BASE + 3]);   \
    unsigned b0 = cvtpk(P[BASE + 4], P[BASE + 5]), b1 = cvtpk(P[BASE + 6], P[BASE + 7]);                              \
    auto r0 = __builtin_amdgcn_permlane32_swap(a0, b0, false, false); auto r1 = __builtin_amdgcn_permlane32_swap(a1, b1, false, false); \
    u32x4 w = {r0[0], r1[0], r0[1], r1[1]}; OUT = *reinterpret_cast<bf16x8*>(&w); } while (0)
  PK4(p0, 0, pa0); PK4(p0, 8, pa1); PK4(p1, 0, pa2); PK4(p1, 8, pa3);
#undef PK4
}
__device__ __forceinline__ void qkt(f32x16& p0, f32x16& p1, const bf16_t* Ks, const bf16_t* Qs, int qrow, int r32, int hi) {
  p0 = f32x16{}; p1 = f32x16{};
#pragma unroll
  for (int d0 = 0; d0 < 8; ++d0) { int cb = (d0 * 16 + hi * 8) * 2;
    bf16x8 q = *reinterpret_cast<const bf16x8*>((const char*)Qs + KSWZ(qrow, cb));
    bf16x8 b0 = *reinterpret_cast<const bf16x8*>((const char*)Ks + KSWZ(r32, cb));
    bf16x8 b1 = *reinterpret_cast<const bf16x8*>((const char*)Ks + KSWZ(32 + r32, cb));
    p0 = __builtin_amdgcn_mfma_f32_32x32x16_bf16(b0, q, p0, 0, 0, 0);
    p1 = __builtin_amdgcn_mfma_f32_32x32x16_bf16(b1, q, p1, 0, 0, 0); }
}
__device__ __forceinline__ int v_st(int k, int c) { const int kk = (k & ~0xC) | ((k & 4) << 1) | ((k & 8) >> 1); return ((kk >> 3) * 4 + (c >> 5)) * 512 + ((kk & 7) * 32 + (c & 31)) * 2; }
__device__ __forceinline__ int v_rd_base(int lane) { return ((lane & 3) << 3) | (((lane >> 2) & 3) << 6) | (((lane >> 4) & 1) << 5) | (((lane >> 5) & 1) << 8); }
constexpr int v_rd_off(int d0, int ks, int half) { return d0 * 512 + ks * 4096 + half * 2048; }
template <int OFF> __device__ __forceinline__ s16x4 tr_read(int vb) {
  s16x4 r; asm volatile("ds_read_b64_tr_b16 %0, %1 offset:%2" : "=&v"(r) : "v"(vb), "i"(OFF) : "memory"); return r;
}
template <int D0> __device__ __forceinline__ void pv_one(f32x16& od, int vb, bf16x8 pa0, bf16x8 pa1, bf16x8 pa2, bf16x8 pa3) {
  const s16x4 l0 = tr_read<v_rd_off(D0, 0, 0)>(vb), h0 = tr_read<v_rd_off(D0, 0, 1)>(vb), l1 = tr_read<v_rd_off(D0, 1, 0)>(vb), h1 = tr_read<v_rd_off(D0, 1, 1)>(vb);
  const s16x4 l2 = tr_read<v_rd_off(D0, 2, 0)>(vb), h2 = tr_read<v_rd_off(D0, 2, 1)>(vb), l3 = tr_read<v_rd_off(D0, 3, 0)>(vb), h3 = tr_read<v_rd_off(D0, 3, 1)>(vb);
  asm volatile("s_waitcnt lgkmcnt(0)" ::: "memory"); SBAR();
#define PK(L, H) (bf16x8){L[0], L[1], L[2], L[3], H[0], H[1], H[2], H[3]}
  od = __builtin_amdgcn_mfma_f32_32x32x16_bf16(pa0, PK(l0, h0), od, 0, 0, 0);
  od = __builtin_amdgcn_mfma_f32_32x32x16_bf16(pa1, PK(l1, h1), od, 0, 0, 0);
  od = __builtin_amdgcn_mfma_f32_32x32x16_bf16(pa2, PK(l2, h2), od, 0, 0, 0);
  od = __builtin_amdgcn_mfma_f32_32x32x16_bf16(pa3, PK(l3, h3), od, 0, 0, 0);
#undef PK
}
__device__ __forceinline__ void pv_d0(f32x16* o, int vb, bf16x8 pa0, bf16x8 pa1, bf16x8 pa2, bf16x8 pa3) {
  pv_one<0>(o[0], vb, pa0, pa1, pa2, pa3); pv_one<1>(o[1], vb, pa0, pa1, pa2, pa3); pv_one<2>(o[2], vb, pa0, pa1, pa2, pa3); pv_one<3>(o[3], vb, pa0, pa1, pa2, pa3);
}

struct SrcOne { const bf16_t* k0; const bf16_t* v0; int ldk;
  __device__ __forceinline__ const bf16_t* k(int j) const { return k0 + (size_t)j * 64 * ldk; }
  __device__ __forceinline__ const bf16_t* v(int j) const { return v0 + (size_t)j * 64 * ldk; } };
struct SrcTwo { const bf16_t* ck; const bf16_t* cv; const bf16_t* k1; const bf16_t* v1; int ldk;
  __device__ __forceinline__ const bf16_t* k(int j) const { return j < 4 ? ck + (size_t)j * 64 * ldk : k1 + (size_t)(j - 4) * 64 * ldk; }
  __device__ __forceinline__ const bf16_t* v(int j) const { return j < 4 ? cv + (size_t)j * 64 * ldk : v1 + (size_t)(j - 4) * 64 * ldk; } };
struct NoBias { __device__ __forceinline__ void operator()(f32x16&, f32x16&, int, int, int, int) const {} };
struct NaBias { const float* tab; int i0, kr0;
  __device__ __forceinline__ void operator()(f32x16& p0, f32x16& p1, int jt, int wid, int r32, int hi) const {
    if (jt < 4) return;
    const int qi = i0 + wid * QBLK + r32, r = qi >> 6, qc = qi & 63, kr = kr0 + jt - 4;
    int lo = r - 4; lo = lo < 0 ? 0 : (lo > 8 ? 8 : lo);
    const bool rowok = (kr >= lo) && (kr < lo + 8);
    if (!rowok) {
#pragma unroll
      for (int rr = 0; rr < 16; ++rr) { p0[rr] = -1e30f; p1[rr] = -1e30f; }
      return;
    }
    int c0 = qc - 8; c0 = c0 < 0 ? 0 : (c0 > 48 ? 48 : c0);
    const int dr = kr - r + 7;
    const float* tb = tab + dr * 31 + (4 * hi - qc + 15);
    const int w0 = 4 * hi - c0;
#pragma unroll
    for (int g = 0; g < 4; ++g) {
#pragma unroll
      for (int q = 0; q < 4; ++q) {
        const int rr = 4 * g + q, kc0 = q + 8 * g;
        const float t0 = tb[kc0], t1 = tb[kc0 + 32];
        p0[rr] = ((unsigned)(kc0 + w0) < 16u) ? p0[rr] + t0 : -1e30f;
        p1[rr] = ((unsigned)(kc0 + 32 + w0) < 16u) ? p1[rr] + t1 : -1e30f;
      }
      SBAR();
    }
  } };

template <int SD, class Src, class Bias>
__device__ ATT_INLINE void attn_body(const bf16_t* __restrict__ Qb, const Src src, bf16_t* __restrict__ Ob, const int NT, char* lds, const Bias bias) {
  const int tid = opaque_tid(), wid = tid >> 6, lane = tid & 63, r32 = lane & 31, hi = lane >> 5;
  const int LDK = src.ldk;
  bf16_t* V_lds = (bf16_t*)lds; bf16_t* K_lds = (bf16_t*)(lds + 2 * SHM_V);
  float* ws = (float*)(lds + 2 * SHM_V + 2 * SHM_K) + wid * 64; float* li_l = ws; float* al_l = ws + 32;
  float m_reg = -1e30f, l_reg = 0; f32x16 o[4] = {};
  bf16_t* Q_lds = (bf16_t*)(lds + 2 * SHM_V + 2 * SHM_K + NW * 64 * 4);
  const int qrow = wid * QBLK + r32;
  {
#pragma unroll
    for (int i = 0; i < 8; ++i) { const int f = tid + 512 * i, row = f >> 4, c8 = (f & 15) * 8;
      *(bf16x8*)((char*)Q_lds + KSWZ(row, c8 * 2)) = *reinterpret_cast<const bf16x8*>(Qb + (long)row * LDQ + c8); }
  }
  const int sr = tid >> 4, sc = (tid & 15) * 8, vst0 = v_st(sr, sc), vst1 = v_st(32 + sr, sc);
  const int vb0 = (int)(uintptr_t)V_lds + v_rd_base(lane);
  struct { bf16x8 vs0, vs1, ks0, ks1; } sr_[SD];
#define SLOAD(i, jt) do { const bf16_t* kt_ = src.k(jt); const bf16_t* vt_ = src.v(jt); \
    sr_[i].vs0 = *reinterpret_cast<const bf16x8*>(&vt_[(long)sr * LDK + sc]); sr_[i].vs1 = *reinterpret_cast<const bf16x8*>(&vt_[(long)(32 + sr) * LDK + sc]); \
    sr_[i].ks0 = *reinterpret_cast<const bf16x8*>(&kt_[(long)sr * LDK + sc]); sr_[i].ks1 = *reinterpret_cast<const bf16x8*>(&kt_[(long)(32 + sr) * LDK + sc]); } while (0)
#define SWRITE(b, i) do { *(bf16x8*)((char*)V_lds + (b) * SHM_V + vst0) = sr_[i].vs0;          \
    *(bf16x8*)((char*)V_lds + (b) * SHM_V + vst1) = sr_[i].vs1; int kc = sc * 2;               \
    *(bf16x8*)((char*)K_lds + (b) * SHM_K + KSWZ(sr, kc)) = sr_[i].ks0;                       \
    *(bf16x8*)((char*)K_lds + (b) * SHM_K + KSWZ(32 + sr, kc)) = sr_[i].ks1; } while (0)
#define SWAIT() do { if constexpr (SD == 2) asm volatile("s_waitcnt vmcnt(4)" ::: "memory"); else asm volatile("s_waitcnt vmcnt(0)" ::: "memory"); } while (0)
#define RESC(a) do { if (__any((a) < 1.f)) { if (hi == 0) al_l[r32] = (a); asm volatile("s_waitcnt lgkmcnt(0)" ::: "memory"); \
    for (int d = 0; d < 4; ++d) for (int r = 0; r < 16; ++r) o[d][r] *= al_l[crow(r, hi)]; } } while (0)
  f32x16 pA0, pA1, pB0, pB1; float mnA, mnB, alA, alB; bf16x8 pa0, pa1, pa2, pa3;
  constexpr int SE = 0, SO = SD - 1;
  SLOAD(SE, 0); asm volatile("s_waitcnt vmcnt(0)" ::: "memory"); SWRITE(0, SE); __syncthreads();
  qkt(pA0, pA1, K_lds, Q_lds, qrow, r32, hi); bias(pA0, pA1, 0, wid, r32, hi); partialSM(pA0, pA1, m_reg, mnA, alA);
  SLOAD(SO, 1); if constexpr (SD == 2) { if (2 < NT) SLOAD(SE, 2); }
  SWAIT(); SWRITE(1, SO); __syncthreads();
  for (int j = 1; j + 1 < NT; j += 2) {
    SBAR(); qkt(pB0, pB1, (bf16_t*)((char*)K_lds + SHM_K), Q_lds, qrow, r32, hi); bias(pB0, pB1, j, wid, r32, hi);
    finishSM(pA0, pA1, alA, l_reg, pa0, pa1, pa2, pa3); SBAR();
    SLOAD(SO, j + SD); SBAR();
    pv_d0(o, vb0, pa0, pa1, pa2, pa3); partialSM(pB0, pB1, m_reg, mnB, alB);
    __syncthreads(); SWAIT(); SWRITE(0, SE);
    RESC(alB); __syncthreads();
    SBAR(); qkt(pA0, pA1, K_lds, Q_lds, qrow, r32, hi); bias(pA0, pA1, j + 1, wid, r32, hi);
    finishSM(pB0, pB1, alB, l_reg, pa0, pa1, pa2, pa3); SBAR();
    if (SD == 1 || j + 3 < NT) SLOAD(SE, j + 1 + SD); SBAR();
    pv_d0(o, vb0 + (int)SHM_V, pa0, pa1, pa2, pa3); partialSM(pA0, pA1, m_reg, mnA, alA);
    __syncthreads(); SWAIT(); SWRITE(1, SO);
    RESC(alA); __syncthreads();
  }
  SBAR(); qkt(pB0, pB1, (bf16_t*)((char*)K_lds + SHM_K), Q_lds, qrow, r32, hi); bias(pB0, pB1, NT - 1, wid, r32, hi);
  finishSM(pA0, pA1, alA, l_reg, pa0, pa1, pa2, pa3); SBAR();
  pv_d0(o, vb0, pa0, pa1, pa2, pa3); partialSM(pB0, pB1, m_reg, mnB, alB);
  __syncthreads(); RESC(alB);
  finishSM(pB0, pB1, alB, l_reg, pa0, pa1, pa2, pa3); SBAR();
  pv_d0(o, vb0 + (int)SHM_V, pa0, pa1, pa2, pa3);
  if (hi == 0) li_l[r32] = l_reg; asm volatile("s_waitcnt lgkmcnt(0)" ::: "memory");
  float rli[16];
#pragma unroll
  for (int r = 0; r < 16; ++r) rli[r] = __builtin_amdgcn_rcpf(li_l[crow(r, hi)]);
  bf16_t* Ow = Ob + (long)(wid * QBLK) * LDO;
#pragma unroll
  for (int r = 0; r < 16; ++r) { int orow = crow(r, hi);
    for (int d0 = 0; d0 < 4; ++d0) Ow[(long)orow * LDO + d0 * 32 + r32] = f2bf(o[d0][r] * rli[r]); }
#undef SLOAD
#undef SWRITE
#undef SWAIT
#undef RESC
}
}
#define H16(w, j) ((bf16_t)(((j) & 1) ? ((j) < 2 ? (w).x >> 16 : (w).y >> 16) : ((j) < 2 ? (w).x & 0xFFFFu : (w).y & 0xFFFFu)))
#define DPPU(v, ctrl, rmask) __int_as_float(__builtin_amdgcn_update_dpp(0, __float_as_int(v), (ctrl), (rmask), 0xF, false))
__device__ __forceinline__ float scan32(float x) { x += DPPU(x, 0x111, 0xF); x += DPPU(x, 0x112, 0xF); x += DPPU(x, 0x114, 0xF); x += DPPU(x, 0x118, 0xF); x += DPPU(x, 0x142, 0xA); return x; }
__device__ __forceinline__ float last32(float x, int lane) { const float a = __int_as_float(__builtin_amdgcn_readlane(__float_as_int(x), 31)), b = __int_as_float(__builtin_amdgcn_readlane(__float_as_int(x), 63)); return lane < 32 ? a : b; }
namespace gdn {
using att::bf16x8; using att::f32x16; using att::crow;
constexpr int C = 32, SK = 136, SS = 40;
constexpr int OFF_KT = 0, OFF_QT = OFF_KT + C * SK * 2, OFF_W = OFF_QT + C * SK * 2, OFF_KTT = OFF_W + C * SK * 2, OFF_VTT = OFF_KTT + 128 * SS * 2,
              OFF_VN = OFF_VTT + 128 * SS * 2, OFF_VNS = OFF_VN + 128 * SS * 2, OFF_ST = OFF_VNS + 128 * SS * 2, OFF_TB = OFF_ST + 128 * SK * 2,
              OFF_TBE = OFF_TB + C * SS * 2, OFF_ATT = OFF_TBE + C * SS * 2, OFF_L = OFF_ATT + C * SS * 2, OFF_SC = OFF_L + C * C * 4, GDN_LDS = OFF_SC + 1024;
template <int K>
__device__ __forceinline__ f32x16 mm(const bf16_t* A, int lda, const bf16_t* Bt, int ldb, int l32, int hi, f32x16 acc) {
#pragma unroll
    for (int k0 = 0; k0 < K; k0 += 16) {
        const bf16x8 a = *reinterpret_cast<const bf16x8*>(A + l32 * lda + k0 + 8 * hi);
        const bf16x8 b = *reinterpret_cast<const bf16x8*>(Bt + l32 * ldb + k0 + 8 * hi);
        acc = __builtin_amdgcn_mfma_f32_32x32x16_bf16(a, b, acc, 0, 0, 0);
    }
    return acc;
}
__device__ __forceinline__ uint2 pk4(float a, float b, float c, float d) { uint2 w; w.x = pack2(a, b); w.y = pack2(c, d); return w; }

__device__ __forceinline__ void gdn_chunked(const Params& p, int l, bool ctx, int b, int h, int dir, unsigned char* lds) {
    const int tid = opaque_tid(), wid = tid >> 6, lane = tid & 63, l32 = lane & 31, hi = lane >> 5;
    const int T = ctx ? CT : ::LT; const size_t m0 = ctx ? (size_t)b * CT : (size_t)MC + (size_t)b * ::LT;
    const bf16_t* DQ = WSP(bf16_t, WS_DQ); const bf16_t* DK = WSP(bf16_t, WS_DK); const bf16_t* DV = WSP(bf16_t, WS_DV); const float* DBA = WSP(float, WS_DBA);
    float* O = WSP(float, dir ? WS_DOB : WS_DOF);
    bf16_t* Kt = (bf16_t*)(lds + OFF_KT); bf16_t* Qt = (bf16_t*)(lds + OFF_QT); bf16_t* W = (bf16_t*)(lds + OFF_W); bf16_t* KT = (bf16_t*)(lds + OFF_KTT); bf16_t* VT = (bf16_t*)(lds + OFF_VTT);
    bf16_t* VN = (bf16_t*)(lds + OFF_VN); bf16_t* VNS = (bf16_t*)(lds + OFF_VNS); bf16_t* ST = (bf16_t*)(lds + OFF_ST); bf16_t* TB = (bf16_t*)(lds + OFF_TB); bf16_t* TBE = (bf16_t*)(lds + OFF_TBE);
    bf16_t* ATT = (bf16_t*)(lds + OFF_ATT); float* Lm = (float*)(lds + OFF_L); float* sc = (float*)(lds + OFF_SC);
    const int nch = T / C;
#define TOK(c, s_) (m0 + (dir ? T - 1 - ((c) * C + (s_)) : (c) * C + (s_)))
    f32x16 S[2];
#pragma unroll
    for (int bi = 0; bi < 2; ++bi) {
        const int blk = wid * 2 + bi, d0 = 32 * (blk >> 2), e0 = 32 * (blk & 3);
        if (ctx) { S[bi] = f32x16{}; }
        else {
            const float* s0 = p.in[I_SGDN] + ((((size_t)b * DEPTH + l) * 2 + dir) * 4 + h) * 128 * 128 + e0 + l32;
#pragma unroll
            for (int r = 0; r < 16; ++r) S[bi][r] = s0[(size_t)(d0 + crow(r, hi)) * 128];
        }
    }
    const int ts = tid & 31, c0 = (tid >> 5) * 4, c1 = 64 + c0;
    uint2 rq0, rq1, rk0, rk1, rv0, rv1; float pbeta = 0.f, pg = 0.f;
#define GLOAD(c) do { const size_t mt_ = TOK(c, ts); \
        rq0 = *(const uint2*)(DQ + mt_ * 512 + h * 128 + c0); rq1 = *(const uint2*)(DQ + mt_ * 512 + h * 128 + c1); \
        rk0 = *(const uint2*)(DK + mt_ * 512 + h * 128 + c0); rk1 = *(const uint2*)(DK + mt_ * 512 + h * 128 + c1); \
        rv0 = *(const uint2*)(DV + mt_ * 512 + h * 128 + c0); rv1 = *(const uint2*)(DV + mt_ * 512 + h * 128 + c1); \
        if (tid < C) { const size_t mt = TOK(c, tid); pbeta = DBA[mt * 16 + dir * 4 + h]; pg = DBA[mt * 16 + 8 + dir * 4 + h]; } } while (0)
#define GSTAGE() do { \
        *(uint2*)(Kt + ts * SK + c0) = rk0; *(uint2*)(Kt + ts * SK + c1) = rk1; \
        *(uint2*)(Qt + ts * SK + c0) = rq0; *(uint2*)(Qt + ts * SK + c1) = rq1; \
        _Pragma("unroll") for (int j = 0; j < 4; ++j) { KT[(c0 + j) * SS + ts] = H16(rk0, j); KT[(c1 + j) * SS + ts] = H16(rk1, j); \
                                                        VT[(c0 + j) * SS + ts] = H16(rv0, j); VT[(c1 + j) * SS + ts] = H16(rv1, j); } \
        if (wid == 0) { float x = pg; _Pragma("unroll") for (int o_ = 1; o_ < 32; o_ <<= 1) { const float y = __shfl_up(x, o_); if (lane >= o_) x += y; } \
            const float Bt_ = __shfl(x, 31); if (lane < C) { sc[lane] = pbeta; sc[32 + lane] = x; sc[64 + lane] = __expf(x); sc[96 + lane] = __expf(Bt_ - x); if (lane == 0) sc[128] = __expf(Bt_); } } } while (0)
    __syncthreads();
    GLOAD(0);
#pragma unroll
    for (int bi = 0; bi < 2; ++bi) {
        const int blk = wid * 2 + bi, d0 = 32 * (blk >> 2), e0 = 32 * (blk & 3);
#pragma unroll
        for (int g = 0; g < 4; ++g) *(uint2*)(ST + (e0 + l32) * SK + d0 + 8 * g + 4 * hi) = pk4(S[bi][4 * g], S[bi][4 * g + 1], S[bi][4 * g + 2], S[bi][4 * g + 3]);
    }
    GSTAGE();
    __syncthreads();
    for (int c = 0; c < nch; ++c) {
        if (c + 1 < nch) GLOAD(c + 1);
        f32x16 acc1 = f32x16{};
        if (wid == 0) {
            const f32x16 kk = mm<128>(Kt, SK, Kt, SK, l32, hi, f32x16{});
            const float bi_ = sc[32 + l32], be = sc[l32];
#pragma unroll
            for (int r = 0; r < 16; ++r) { const int j = crow(r, hi); const float v = (l32 > j) ? be * kk[r] * __expf(bi_ - sc[32 + j]) : 0.f;
                Lm[l32 * 32 + ((((r & 3) + 4 * hi) ^ (l32 & 7)) * 4) + (r >> 2)] = v; }
        } else if (wid == 1) {
            const f32x16 kq = mm<128>(Kt, SK, Qt, SK, l32, hi, f32x16{});
            const float bi_ = sc[32 + l32];
            float a[16];
#pragma unroll
            for (int r = 0; r < 16; ++r) { const int j = crow(r, hi); a[r] = (l32 >= j) ? kq[r] * __expf(bi_ - sc[32 + j]) : 0.f; }
#pragma unroll
            for (int g = 0; g < 4; ++g) *(uint2*)(ATT + l32 * SS + 8 * g + 4 * hi) = pk4(a[4 * g], a[4 * g + 1], a[4 * g + 2], a[4 * g + 3]);
        } else if (wid >= 4) {
            acc1 = mm<128>(Qt, SK, ST + (32 * (wid - 4)) * SK, SK, l32, hi, f32x16{});
#pragma unroll
            for (int r = 0; r < 16; ++r) acc1[r] *= sc[64 + crow(r, hi)];
        }
        __syncthreads();
        if (tid < 256) {
            const int cc = tid >> 3, part = tid & 7;
            float Tr[4] = {0.f, 0.f, 0.f, 0.f};
#pragma unroll
            for (int i = 0; i < 32; ++i) {
                const vf4 lv = *(const vf4*)(Lm + i * 32 + ((part ^ (i & 7)) * 4));
                float s = lv.x * Tr[0] + lv.y * Tr[1] + lv.z * Tr[2] + lv.w * Tr[3];
                s = red8(s);
                const float t = (i == cc ? 1.f : 0.f) - s;
                if (part == (i & 7)) Tr[i >> 3] = t;
            }
            const float bc = sc[cc], bec = bc * sc[64 + cc];
#pragma unroll
            for (int jj = 0; jj < 4; ++jj) { TB[(part + 8 * jj) * SS + cc] = f2bf(Tr[jj] * bc); TBE[(part + 8 * jj) * SS + cc] = f2bf(Tr[jj] * bec); }
        }
        __syncthreads();
        if (wid < 4) {
            acc1 = mm<32>(TB, SS, VT + (32 * wid) * SS, SS, l32, hi, f32x16{});
        } else {
            const int d0 = 32 * (wid - 4);
            const f32x16 wt = mm<32>(KT + d0 * SS, SS, TBE, SS, l32, hi, f32x16{});
#pragma unroll
            for (int g = 0; g < 4; ++g) *(uint2*)(W + l32 * SK + d0 + 8 * g + 4 * hi) = pk4(wt[4 * g], wt[4 * g + 1], wt[4 * g + 2], wt[4 * g + 3]);
        }
        __syncthreads();
        if (wid < 4) {
            const int e0 = 32 * wid;
            const f32x16 ws = mm<128>(W, SK, ST + e0 * SK, SK, l32, hi, f32x16{});
            float vn[16], vs[16];
#pragma unroll
            for (int r = 0; r < 16; ++r) { vn[r] = acc1[r] - ws[r]; vs[r] = vn[r] * sc[96 + crow(r, hi)]; }
#pragma unroll
            for (int g = 0; g < 4; ++g) { *(uint2*)(VN + (e0 + l32) * SS + 8 * g + 4 * hi) = pk4(vn[4 * g], vn[4 * g + 1], vn[4 * g + 2], vn[4 * g + 3]);
                                          *(uint2*)(VNS + (e0 + l32) * SS + 8 * g + 4 * hi) = pk4(vs[4 * g], vs[4 * g + 1], vs[4 * g + 2], vs[4 * g + 3]); }
        }
        __syncthreads();
        if (wid >= 4) {
            const int e0 = 32 * (wid - 4);
            acc1 = mm<32>(ATT, SS, VN + e0 * SS, SS, l32, hi, acc1);
#pragma unroll
            for (int r = 0; r < 16; ++r) O[TOK(c, crow(r, hi)) * 512 + h * 128 + e0 + l32] = acc1[r];
        }
        {
            const float eB = sc[128];
#pragma unroll
            for (int bi = 0; bi < 2; ++bi) {
                const int blk = wid * 2 + bi, d0 = 32 * (blk >> 2), e0 = 32 * (blk & 3);
#pragma unroll
                for (int r = 0; r < 16; ++r) S[bi][r] *= eB;
                S[bi] = mm<32>(KT + d0 * SS, SS, VNS + e0 * SS, SS, l32, hi, S[bi]);
            }
        }
        __syncthreads();
#pragma unroll
        for (int bi = 0; bi < 2; ++bi) {
            const int blk = wid * 2 + bi, d0 = 32 * (blk >> 2), e0 = 32 * (blk & 3);
#pragma unroll
            for (int g = 0; g < 4; ++g) *(uint2*)(ST + (e0 + l32) * SK + d0 + 8 * g + 4 * hi) = pk4(S[bi][4 * g], S[bi][4 * g + 1], S[bi][4 * g + 2], S[bi][4 * g + 3]);
        }
        if (c + 1 < nch) GSTAGE();
        __syncthreads();
    }
#undef GLOAD
#undef GSTAGE
#undef TOK
    if (ctx) {
#pragma unroll
        for (int bi = 0; bi < 2; ++bi) {
            const int blk = wid * 2 + bi, d0 = 32 * (blk >> 2), e0 = 32 * (blk & 3);
            float* so = p.out + O_SGDN + ((((size_t)b * DEPTH + l) * 2 + dir) * 4 + h) * 128 * 128 + e0 + l32;
#pragma unroll
            for (int r = 0; r < 16; ++r) so[(size_t)(d0 + crow(r, hi)) * 128] = S[bi][r];
        }
    }
}
}

namespace gla {
using att::bf16x8; using att::f32x16; using att::crow; using gdn::mm; using gdn::pk4;
constexpr int C = 32, SQ = 72, SS = 40;
constexpr int OFF_QE = 0, OFF_KN = OFF_QE + C * SQ * 2, OFF_KET = OFF_KN + C * SQ * 2, OFF_VT = OFF_KET + 64 * SS * 2, OFF_ATT = OFF_VT + 128 * SS * 2, OFF_ST = OFF_ATT + C * SS * 2,
              OFF_LA = OFF_ST + 128 * SQ * 2, OFF_EB = OFF_LA + C * 64 * 4, GLA_LDS = OFF_EB + 256;
__device__ __forceinline__ void gla_chunked(const Params& p, int l, bool ctx, int b, int h, int dir, unsigned char* lds) {
    const int tid = opaque_tid(), wid = tid >> 6, lane = tid & 63, l32 = lane & 31, hi = lane >> 5;
    const int T = ctx ? CT : ::LT; const size_t m0 = ctx ? (size_t)b * CT : (size_t)MC + (size_t)b * ::LT;
    const bf16_t* Z = WSP(bf16_t, WS_Z); const float* LA = WSP(float, dir ? WS_AB : WS_AF);
    float* O = WSP(float, dir ? WS_GOB : WS_GOF);
    bf16_t* Qe = (bf16_t*)(lds + OFF_QE); bf16_t* Kn = (bf16_t*)(lds + OFF_KN); bf16_t* KeT = (bf16_t*)(lds + OFF_KET); bf16_t* VT = (bf16_t*)(lds + OFF_VT);
    bf16_t* ATT = (bf16_t*)(lds + OFF_ATT); bf16_t* ST = (bf16_t*)(lds + OFF_ST); float* eB = (float*)(lds + OFF_EB);
    const int nch = T / C;
#define TOK(c, s_) (m0 + (dir ? T - 1 - ((c) * C + (s_)) : (c) * C + (s_)))
    const int d0 = 32 * (wid >> 2), e0 = 32 * (wid & 3);
    f32x16 S;
    if (ctx) S = f32x16{};
    else {
        const float* s0 = p.in[I_SGLA] + ((((size_t)b * DEPTH + l) * 2 + dir) * 4 + h) * 64 * 128 + e0 + l32;
#pragma unroll
        for (int r = 0; r < 16; ++r) S[r] = s0[(size_t)(d0 + crow(r, hi)) * 128];
    }
    const int ts = tid & 31, dc = (tid >> 5) * 4, vc0 = dc, vc1 = 64 + dc;
    uint2 rq, rk, rv0, rv1; vf4 pl;
#define GLOAD(c) do { const size_t mt = TOK(c, ts); \
        rq = *(const uint2*)(Z + mt * NINP + Z_GLQ + h * 64 + dc); rk = *(const uint2*)(Z + mt * NINP + Z_GLK + h * 64 + dc); pl = *(const vf4*)(LA + mt * 256 + h * 64 + dc); \
        rv0 = *(const uint2*)(Z + mt * NINP + Z_GLV + h * 128 + vc0); rv1 = *(const uint2*)(Z + mt * NINP + Z_GLV + h * 128 + vc1); } while (0)
#define WRITE_ST() do { _Pragma("unroll") for (int g = 0; g < 4; ++g) *(uint2*)(ST + (e0 + l32) * SQ + d0 + 8 * g + 4 * hi) = pk4(S[4 * g], S[4 * g + 1], S[4 * g + 2], S[4 * g + 3]); } while (0)
#define GIMAGES() do { vf4 pre, tot; const vf4 pq = unp4bf(rq), pk = unp4bf(rk); \
        _Pragma("unroll") for (int j = 0; j < 4; ++j) { pre[j] = scan32(pl[j]); tot[j] = last32(pre[j], lane); } \
        float qe[4], kn[4]; \
        _Pragma("unroll") for (int j = 0; j < 4; ++j) { qe[j] = pq[j] * 0.125f * __expf(pre[j]); kn[j] = pk[j] * __expf(fminf(-pre[j], 80.f)); \
            KeT[(dc + j) * SS + ts] = f2bf(pk[j] * __expf(tot[j] - pre[j])); } \
        *(uint2*)(Qe + ts * SQ + dc) = pk4(qe[0], qe[1], qe[2], qe[3]); *(uint2*)(Kn + ts * SQ + dc) = pk4(kn[0], kn[1], kn[2], kn[3]); \
        if (ts == 0) { _Pragma("unroll") for (int j = 0; j < 4; ++j) eB[dc + j] = __expf(tot[j]); } \
        _Pragma("unroll") for (int j = 0; j < 4; ++j) { VT[(vc0 + j) * SS + ts] = H16(rv0, j); VT[(vc1 + j) * SS + ts] = H16(rv1, j); } } while (0)
    __syncthreads();
    GLOAD(0);
    WRITE_ST();
    GIMAGES();
    __syncthreads();
    for (int c = 0; c < nch; ++c) {
        if (c + 1 < nch) GLOAD(c + 1);
        f32x16 o1 = f32x16{};
        if (wid == 0) {
            const f32x16 kq = mm<64>(Kn, SQ, Qe, SQ, l32, hi, f32x16{});
            float a[16];
#pragma unroll
            for (int r = 0; r < 16; ++r) a[r] = (l32 >= crow(r, hi)) ? kq[r] : 0.f;
#pragma unroll
            for (int g = 0; g < 4; ++g) *(uint2*)(ATT + l32 * SS + 8 * g + 4 * hi) = pk4(a[4 * g], a[4 * g + 1], a[4 * g + 2], a[4 * g + 3]);
        } else if (wid >= 4) {
            o1 = mm<64>(Qe, SQ, ST + (32 * (wid - 4)) * SQ, SQ, l32, hi, f32x16{});
        }
        __syncthreads();
        if (wid >= 4) {
            const int eo = 32 * (wid - 4);
            o1 = mm<32>(ATT, SS, VT + eo * SS, SS, l32, hi, o1);
#pragma unroll
            for (int r = 0; r < 16; ++r) O[TOK(c, crow(r, hi)) * 512 + h * 128 + eo + l32] = o1[r];
        }
#pragma unroll
        for (int r = 0; r < 16; ++r) S[r] *= eB[d0 + crow(r, hi)];
        S = mm<32>(KeT + d0 * SS, SS, VT + e0 * SS, SS, l32, hi, S);
        __syncthreads();
        WRITE_ST();
        if (c + 1 < nch) GIMAGES();
#ifdef GLA_DUP_IMAGES
        __syncthreads(); if (c + 1 < nch) GIMAGES();
#endif
        __syncthreads();
    }
#undef GLOAD
#undef WRITE_ST
#undef GIMAGES
#undef TOK
    if (ctx) {
        float* so = p.out + O_SGLA + ((((size_t)b * DEPTH + l) * 2 + dir) * 4 + h) * 64 * 128 + e0 + l32;
#pragma unroll
        for (int r = 0; r < 16; ++r) so[(size_t)(d0 + crow(r, hi)) * 128] = S[r];
    }
}
}
#define LAS __attribute__((address_space(3)))
constexpr int LDS_BYTES = 147456, XBW_OFF = LDS_BYTES - 64;
constexpr int NPH = 1 + DEPTH * 12;
#ifndef DBG_NLAYERS
#define DBG_NLAYERS DEPTH
#endif

#ifndef DUPKIND
#define DUPKIND 0
#endif
__device__ __forceinline__ int opaque_int(int v) { asm volatile("" : "+s"(v)); return v; }
#ifndef MIXMASK
#define MIXMASK 0xFF
#endif
#define FOR_ITEMS(it, n, o, w) for (int bo_ = (o) * (int)gridDim.x / 256, bw_ = ((w) * (int)gridDim.x / 256) > 0 ? ((w) * (int)gridDim.x / 256) : 1, \
                                    it = ((int)blockIdx.x >= bo_ && (int)blockIdx.x < bo_ + bw_) ? (int)blockIdx.x - bo_ : (n); it < (n); it += bw_)

constexpr int TF0 = NT_L / 10, TF1 = NT_L / 4, TF2 = NT_L * 53 / 100, TF3 = NT_L * 88 / 100, MIXCONV_CH = 16, NI_CONV = (TF3 - TF2 + MIXCONV_CH - 1) / MIXCONV_CH;
#ifndef SPLITK
#define SPLITK 0
#endif
#ifndef SPLITK_G4
#define SPLITK_G4 0
#endif
constexpr int FLAG_WORD0 = 8192;
constexpr int QCTR_WORD0 = 1024;
constexpr int NI_GDNL = LB * 8, NI_GLAL = LB * 8, NI_GDNC = CB * 8, NI_GQAL = LB * 16, NI_NAL = LB * 16, NI_GLAC = CB * 8, NI_NAC = CB * 4, NI_GQAC = CB * 4;
#define KM(k) (1 + ((DUPKIND >> (k)) & 1))
constexpr int Q0 = NI_GDNL * KM(0), Q1 = Q0 + NI_GQAL * KM(1), Q2 = Q1 + NI_NAL * KM(2), Q3 = Q2 + NI_GLAL * KM(3), Q4 = Q3 + NI_GDNC * KM(4), Q5 = Q4 + NI_NAC * KM(5), Q6 = Q5 + NI_GQAC * KM(6), Q7 = Q6 + NI_GLAC * KM(7);
__device__ __forceinline__ void phase_mix(const Params& p, int l, unsigned char* lds, int rep) {
    const int tid = opaque_tid();
    float* smem = (float*)lds;
    const bf16_t* NAQ = WSP(bf16_t, WS_NAQ); const bf16_t* NAK = WSP(bf16_t, WS_NAK); const bf16_t* NAV = WSP(bf16_t, WS_NAV);
    const bf16_t* GQ = WSP(bf16_t, WS_GQ); const bf16_t* GK = WSP(bf16_t, WS_GK); const bf16_t* GV = WSP(bf16_t, WS_GV);
    bf16_t* MRG = WSP(bf16_t, WS_MRG);
    unsigned* qctr = WSP(unsigned, WS_CTL) + QCTR_WORD0 + 64 * l + 16 * rep;
    volatile int* qslot = (volatile int*)(lds + XBW_OFF + 16);
    for (;;) {
        __syncthreads();
        if (tid == 0) *qslot = (int)__hip_atomic_fetch_add(qctr, 1u, __ATOMIC_RELAXED, __HIP_MEMORY_SCOPE_AGENT);
        __syncthreads();
        const int q = __builtin_amdgcn_readfirstlane(*qslot);
        if (q >= Q7 + ((CONV_FILLER && l + 1 < DBG_NLAYERS) ? NI_CONV : 0)) break;
        if (q < Q0) { const int it = q % NI_GDNL; gdn::gdn_chunked(p, l, false, it / 8, (it / 2) % 4, it % 2, lds); }
        else if (q < Q1) {
            const int it = (q - Q0) % NI_GQAL, b = it / 16, qh = (it / 4) % 4, qb = it % 4, kvh = qh >> 1;
            const size_t r0 = (size_t)MC + (size_t)b * LT;
            att::SrcTwo src{WSP(bf16_t, WS_CGK) + ((size_t)b * DEPTH + l) * 256 * 256 + kvh * 128, WSP(bf16_t, WS_CGV) + ((size_t)b * DEPTH + l) * 256 * 256 + kvh * 128,
                            GK + r0 * 256 + kvh * 128, GV + r0 * 256 + kvh * 128, 256};
            att::attn_body<2>(GQ + (r0 + qb * 256) * 512 + qh * 128, src, MRG + (r0 + qb * 256) * DM + 1024 + qh * 128, 4 + LT / 64, (char*)lds, att::NoBias{});
        }
        else if (q < Q2) {
            const int it = (q - Q1) % NI_NAL, b = it / 16, h = (it / 4) % 4, qb = it % 4;
            const int kr0 = qb == 0 ? 0 : qb == 1 ? 0 : qb == 2 ? 4 : 8, nrows = (qb == 0 || qb == 3) ? 8 : 12;
            const size_t r0 = (size_t)MC + (size_t)b * LT;
            float* tab = (float*)(lds + att::SHM_ATTN);
            if (tid < 15 * 31) tab[tid] = p.in[I_RPB][((size_t)l * 4 + h) * 15 * 31 + tid] * (1.0f / att::SCALE);
            att::SrcTwo src{WSP(bf16_t, WS_CNAK) + ((size_t)b * DEPTH + l) * 256 * 512 + h * 128, WSP(bf16_t, WS_CNAV) + ((size_t)b * DEPTH + l) * 256 * 512 + h * 128,
                            NAK + (r0 + kr0 * 64) * 512 + h * 128, NAV + (r0 + kr0 * 64) * 512 + h * 128, 512};
            att::attn_body<1>(NAQ + (r0 + qb * 256) * 512 + h * 128, src, MRG + (r0 + qb * 256) * DM + 0 + h * 128, 4 + nrows, (char*)lds, att::NaBias{tab, qb * 256, kr0});
        }
        else if (q < Q3) { const int it = (q - Q2) % NI_GLAL;
#ifdef GLA_REP
            for (int r_ = 0, n_ = opaque_int(GLA_REP); r_ < n_; ++r_)
#endif
            gla::gla_chunked(p, l, false, it / 8, (it / 2) % 4, it % 2, lds); }
        else if (q < Q4) { const int it = (q - Q3) % NI_GDNC; gdn::gdn_chunked(p, l, true, it / 8, (it / 2) % 4, it % 2, lds); }
        else if (q < Q5) {
            const int it = (q - Q4) % NI_NAC, b = it / 4, h = it % 4; const size_t r0 = (size_t)b * CT;
            att::SrcOne src{NAK + r0 * 512 + h * 128, NAV + r0 * 512 + h * 128, 512};
            att::attn_body<2>(NAQ + r0 * 512 + h * 128, src, MRG + r0 * DM + 0 + h * 128, CT / 64, (char*)lds, att::NoBias{});
        }
        else if (q < Q6) {
            const int it = (q - Q5) % NI_GQAC, b = it / 4, qh = it % 4, kvh = qh >> 1; const size_t r0 = (size_t)b * CT;
            att::SrcOne src{GK + r0 * 256 + kvh * 128, GV + r0 * 256 + kvh * 128, 256};
            att::attn_body<2>(GQ + r0 * 512 + qh * 128, src, MRG + r0 * DM + 1024 + qh * 128, CT / 64, (char*)lds, att::NoBias{});
        }
        else if (q < Q7) { const int it = (q - Q6) % NI_GLAC; gla::gla_chunked(p, l, true, it / 8, (it / 2) % 4, it % 2, lds); }
        else { const int t0 = TF2 + (q - Q7) * MIXCONV_CH, t1 = t0 + MIXCONV_CH < TF3 ? t0 + MIXCONV_CH : TF3; conv_layer_tiles(p, l + 1, t0, t1, 0, 1, (float*)lds); }
    }
}

#define CONV_FILL(nunits, t0, t1, skip) do { if (l + 1 < DBG_NLAYERS) { const int G_ = (int)gridDim.x; int f0_ = ((nunits) % G_) + (skip); if (f0_ >= G_) f0_ = 0; \
        if ((int)blockIdx.x >= f0_) { const Params q = opaque_params(p); conv_layer_tiles(q, l + 1, (t0), (t1), (int)blockIdx.x - f0_, G_ - f0_, (float*)lds); } } } while (0)
#define G1A_MSPLIT (G1A_MODE == 1 ? 2 : 0)
#define G1B_MSPLIT (G1B_MODE == 1 ? 2 : 0)
#ifndef MSPLIT
#define MSPLIT 2
#endif
static_assert(att::SHM_ATTN + 15 * 31 * 4 + 2048 <= (size_t)XBW_OFF, "LDS map");
static_assert((QCTR_WORD0 + 64 * DEPTH) < 4096, "ctl");
constexpr int BAR_WORD0 = 4096;
static_assert((BAR_WORD0 + XCD_BAR_WORDS) * 4 <= (int)CTL_BYTES, "ctl");

__global__ void __launch_bounds__(512, 2) fwd(Params p) {
    extern __shared__ __attribute__((aligned(16))) unsigned char lds[];
    const int tid = threadIdx.x;
    volatile LAS unsigned* xbw = (volatile LAS unsigned*)((LAS unsigned char*)lds + XBW_OFF);
    if (tid < 4) xbw[tid] = 0u;
    __syncthreads();
    XcdBarrier bar; bar.bar = WSP(unsigned, WS_CTL) + BAR_WORD0; bar.x = 0; bar.st = xbw;
    if (p.ph_hi - p.ph_lo > 1) bar = xcd_barrier_post(WSP(unsigned, WS_CTL) + BAR_WORD0, xbw);
#ifndef PHMASK
#define PHMASK 0x1FFF
#endif
#define IN(k) (p.ph_lo <= (k) && (k) < p.ph_hi)
#define INL(j) (((PHMASK >> ((j) + 1)) & 1) && IN(pb + (j)))
#ifndef DUPMASK
#define DUPMASK 0
#endif
#define DUP(j) ((DUPMASK >> ((j) + 1)) & 1)
#if DUPMASK
#define REPS(j) opaque_int(1 + DUP(j))
#else
#define REPS(j) 1
#endif
#ifndef DBLBAR
#define DBLBAR 0
#endif
#ifdef DIAG_KIND
    unsigned long long dg_sum = 0ull, dg_prev = wall_clock64();
#define DIAG_AT(k) do { const unsigned long long now_ = wall_clock64(); if ((((k) == 0) ? 12 : (((k) - 1) % 12)) == DIAG_KIND) dg_sum += now_ - dg_prev; dg_prev = now_; } while (0)
#else
#define DIAG_AT(k) do { } while (0)
#endif
#define SEAM(k) do { if (IN(k) && IN((k) + 1)) { xcd_barrier(bar); if (DBLBAR) xcd_barrier(bar); } DIAG_AT(k); } while (0)
    LAS unsigned char* ldsl = (LAS unsigned char*)lds;
    bf16_t* H = WSP(bf16_t, WS_H); bf16_t* ACT = WSP(bf16_t, WS_ACT); float* X = WSP(float, WS_X); float* Z = WSP(float, WS_Z); bf16_t* MRG = WSP(bf16_t, WS_MRG);

    if ((PHMASK & 1) && IN(0)) { const int reps_ = (DUPMASK & 1) ? opaque_int(2) : 1; for (int rep_ = 0; rep_ < reps_; ++rep_) { const Params q = opaque_params(p); phase_prologue(q, (float*)lds); __syncthreads(); } }
    SEAM(0);
    for (int l = 0; l < DBG_NLAYERS; ++l) {
        const int pb = 1 + l * 12;
        const float* modl = WSP(float, WS_MODV) + (size_t)l * NCOND * NMOD;
        if (INL(0)) { const int reps_ = REPS(0); for (int rep_ = 0; rep_ < reps_; ++rep_) { const Params q = opaque_params(p); phase_norm(q, l, 0); __syncthreads(); } }
        SEAM(pb + 0);
        if (INL(1)) {
            if (g1_fp8(l, 0)) {
                pg8::Gemm g{H, (const bf16_t*)(WSP(unsigned char, WS_WGU) + ((size_t)l * 2 + 0) * NGU * DM * 2), M, NGU, DM / 2}; pg8::StaticOrder S; S.init(M, NGU, DM / 2, (int)gridDim.x, (int)blockIdx.x, 2);
                pg8::EpiSwiGLU8 E{WSP(unsigned char, WS_ACT), FFP, 1.0f / WGU_SCALE};
                pg8::gemm_phase<pg8::EpiSwiGLU8, pg8::StaticOrder, false, 1>(ldsl, g, S, E, nullptr);
            } else {
                pg8::Gemm g{H, WSP(bf16_t, WS_WGU) + ((size_t)l * 2 + 0) * NGU * DM, M, NGU, DM}; pg8::StaticOrder S; S.init(M, NGU, DM, (int)gridDim.x, (int)blockIdx.x, 0);
                pg8::EpiSwiGLU8 E{WSP(unsigned char, WS_ACT), FFP, 1.0f};
                pg8::gemm_phase<pg8::EpiSwiGLU8, pg8::StaticOrder, false, 0>(ldsl, g, S, E, nullptr);
            }
#if CONV_FILLER
            if (l + 1 < DBG_NLAYERS) {
                const int nw_ = (M / 256) * (NGU / 256), G_ = (int)gridDim.x; int f0_ = nw_ % G_; if (nw_ < G_) f0_ = 0;
                if (g1_fp8(l, 0)) f0_ = 2 * f0_ < G_ ? 2 * f0_ : f0_;
                const int nmb_ = (G_ - f0_ < NMOD / 128) ? (G_ - f0_) : NMOD / 128;
                if ((int)blockIdx.x >= f0_ && (int)blockIdx.x < f0_ + nmb_) { const Params q = opaque_params(p); mod_layer(q, l + 1, (int)blockIdx.x - f0_, nmb_, (float*)lds); }
            }
            CONV_FILL((M / 256) * (NGU / 256), 0, TF0, NMOD / 128 + (g1_fp8(l, 0) ? ((M / 256) * (NGU / 256)) % (int)gridDim.x : 0));
#endif
        }
        SEAM(pb + 1);
        if (INL(2)) {
            pg8::Gemm g{ACT, G2_FP8 ? (const bf16_t*)(WSP(unsigned char, WS_WDN) + ((size_t)l * 2 + 0) * DM * FFP) : WSP(bf16_t, WS_WDN) + ((size_t)l * 2 + 0) * DM * FF, M, DM, G2_FP8 ? FFP / 2 : FF}; pg8::StaticOrder S; S.init(M, DM, G2_FP8 ? FFP / 2 : FF, (int)gridDim.x, (int)blockIdx.x, SPLITK ? 1 : MSPLIT);
            pg8::EpiResid E{l == 0 ? p.in[I_XP] : X, X, DM, modl + 2 * DM, G2_FP8 ? 0.5f / WDN_SCALE : 0.5f, Z, WSP(unsigned, WS_CTL) + FLAG_WORD0, 8u * (unsigned)(l * (2 * SPLITK + SPLITK_G4) + SPLITK), l == 0 ? p.in[I_XS] : X, l == 0 ? MC : 0x7FFFFFFF, (XBF16 && l != 0), XBF16};
            pg8::gemm_phase<pg8::EpiResid, pg8::StaticOrder, false, (G2_FP8 ? 1 : 0)>(ldsl, g, S, E, nullptr);
#if DUPMASK
            if (opaque_int(DUP(2))) { pg8::EpiResid E2{X, Z, DM, modl + 2 * DM, 0.5f, Z, WSP(unsigned, WS_CTL) + FLAG_WORD0, 0u, X, 0x7FFFFFFF, 1, 0}; pg8::gemm_phase<pg8::EpiResid, pg8::StaticOrder, false>(ldsl, g, S, E2, nullptr); }
#endif
        }
        SEAM(pb + 2);
        if (INL(3)) { const int reps_ = REPS(3); for (int rep_ = 0; rep_ < reps_; ++rep_) { const Params q = opaque_params(p); phase_norm(q, l, 1); __syncthreads(); } }
        SEAM(pb + 3);
        if (INL(4)) {
            pg8::Gemm g{H, WSP(bf16_t, WS_WIN) + (size_t)l * NINP * DM, M, NINP, DM}; pg8::StaticOrder S; S.init(M, NINP, DM, (int)gridDim.x, (int)blockIdx.x);
            pg8::EpiBf16Plain E{WSP(bf16_t, WS_Z), NINP};
            for (int r_ = 0, n_ = REPS(4); r_ < n_; ++r_) pg8::gemm_phase<pg8::EpiBf16Plain, pg8::StaticOrder, false>(ldsl, g, S, E, nullptr);
#if CONV_FILLER
            CONV_FILL((M / 256) * (NINP / 256), TF0, TF1, 0);
#endif
        }
        SEAM(pb + 4);
        if (INL(5)) { const int reps_ = REPS(5); for (int rep_ = 0; rep_ < reps_; ++rep_) { const Params q = opaque_params(p); phase_prep(q, l); __syncthreads(); } }
        SEAM(pb + 5);
        if (INL(6)) { const int reps_ = REPS(6); for (int rep_ = 0; rep_ < reps_; ++rep_) { const Params q = opaque_params(p); phase_mix(q, l, lds, rep_); __syncthreads(); } }
        SEAM(pb + 6);
        if (INL(7)) { const int reps_ = REPS(7); for (int rep_ = 0; rep_ < reps_; ++rep_) { const Params q = opaque_params(p); phase_post(q, l); __syncthreads(); } }
        SEAM(pb + 7);
        if (INL(8)) {
            pg8::Gemm g{MRG, WSP(bf16_t, WS_WOUT) + (size_t)l * DM * DM, M, DM, DM}; pg8::StaticOrder S; S.init(M, DM, DM, (int)gridDim.x, (int)blockIdx.x, SPLITK_G4);
            pg8::EpiResid E{X, X, DM, modl + 5 * DM, 1.0f, Z, WSP(unsigned, WS_CTL) + FLAG_WORD0, 8u * (unsigned)(l * (2 * SPLITK + SPLITK_G4) + SPLITK + SPLITK_G4), X, 0x7FFFFFFF, XBF16, XBF16};
            pg8::gemm_phase<pg8::EpiResid, pg8::StaticOrder, false>(ldsl, g, S, E, nullptr);
#if CONV_FILLER
            CONV_FILL((M / 256) * (DM / 256), TF1, TF2, 0);
#endif
#if DUPMASK
            if (opaque_int(DUP(8))) { pg8::EpiResid E2{X, Z, DM, modl + 5 * DM, 1.0f, Z, WSP(unsigned, WS_CTL) + FLAG_WORD0, 0u, X, 0x7FFFFFFF, 1, 0}; pg8::gemm_phase<pg8::EpiResid, pg8::StaticOrder, false>(ldsl, g, S, E2, nullptr); }
#endif
        }
        SEAM(pb + 8);
        if (INL(9)) { const int reps_ = REPS(9); for (int rep_ = 0; rep_ < reps_; ++rep_) { const Params q = opaque_params(p); phase_norm(q, l, 2); __syncthreads(); } }
        SEAM(pb + 9);
        if (INL(10)) {
            {
#if G1B_MODE
                pg8::Gemm g{H, (const bf16_t*)(WSP(unsigned char, WS_WGU) + ((size_t)l * 2 + 1) * NGU * DM * 2), M, NGU, DM / 2}; pg8::StaticOrder S; S.init(M, NGU, DM / 2, (int)gridDim.x, (int)blockIdx.x, G1B_MSPLIT);
                constexpr float ws_ = 1.0f / WGU_SCALE;
#else
                pg8::Gemm g{H, WSP(bf16_t, WS_WGU) + ((size_t)l * 2 + 1) * NGU * DM, M, NGU, DM}; pg8::StaticOrder S; S.init(M, NGU, DM, (int)gridDim.x, (int)blockIdx.x, G1B_MSPLIT);
                constexpr float ws_ = 1.0f;
#endif
#if G2_FP8
                pg8::EpiSwiGLU8 E{WSP(unsigned char, WS_ACT), FFP, ws_};
                pg8::gemm_phase<pg8::EpiSwiGLU8, pg8::StaticOrder, false, G1B_MODE>(ldsl, g, S, E, nullptr);
#else
                pg8::EpiSwiGLU E{ACT, FF};
                pg8::gemm_phase<pg8::EpiSwiGLU, pg8::StaticOrder, false, G1B_MODE>(ldsl, g, S, E, nullptr);
#endif
            }
#if CONV_FILLER
            CONV_FILL((M / 256) * (NGU / 256), TF3, NT_L, (G1B_MSPLIT ? ((M / 256) * (NGU / 256)) % (int)gridDim.x : 0));
#endif
        }
        SEAM(pb + 10);
        if (INL(11)) {
            pg8::Gemm g{ACT, G2_FP8 ? (const bf16_t*)(WSP(unsigned char, WS_WDN) + ((size_t)l * 2 + 1) * DM * FFP) : WSP(bf16_t, WS_WDN) + ((size_t)l * 2 + 1) * DM * FF, M, DM, G2_FP8 ? FFP / 2 : FF}; pg8::StaticOrder S; S.init(M, DM, G2_FP8 ? FFP / 2 : FF, (int)gridDim.x, (int)blockIdx.x, SPLITK ? 1 : MSPLIT);
            pg8::EpiResid E{X, (l == DEPTH - 1) ? p.out : X, DM, modl + 8 * DM, G2_FP8 ? 0.5f / WDN_SCALE : 0.5f, Z, WSP(unsigned, WS_CTL) + FLAG_WORD0, 8u * (unsigned)(l * (2 * SPLITK + SPLITK_G4) + 2 * SPLITK + SPLITK_G4), X, 0x7FFFFFFF, XBF16, (XBF16 && l != DEPTH - 1)};
            pg8::gemm_phase<pg8::EpiResid, pg8::StaticOrder, false, (G2_FP8 ? 1 : 0)>(ldsl, g, S, E, nullptr);
        }
        SEAM(pb + 11);
    }
#ifdef DIAG_KIND
    xcd_barrier(bar);
    if (blockIdx.x == 0 && threadIdx.x == 0) p.out[0] = (float)dg_sum * 10.0f;
#endif
#undef IN
#undef SEAM
}

#ifndef MULTI_LAUNCH
#define MULTI_LAUNCH 0
#endif
extern "C" void kernel_launch(void* const* d_in, const int* in_sizes, int n_in, void* d_out, int out_size, void* d_ws, size_t ws_size, hipStream_t stream) {
    static int grid = 0;
    if (grid == 0) {
        if (n_in != N_IN || (size_t)out_size != O_END || ws_size < WS_END) { fprintf(stderr, "kernel_launch: shape mismatch n_in %d out %d ws %zu (need %zu)\n", n_in, out_size, ws_size, (size_t)WS_END); grid = -1; return; }
        int dev = 0, cus = 0, per_cu = 0;
        if (hipGetDevice(&dev) != hipSuccess || hipDeviceGetAttribute(&cus, hipDeviceAttributeMultiprocessorCount, dev) != hipSuccess) { grid = -1; return; }
        if (hipFuncSetAttribute((const void*)fwd, hipFuncAttributeMaxDynamicSharedMemorySize, LDS_BYTES) != hipSuccess) { fprintf(stderr, "kernel_launch: hipFuncSetAttribute failed\n"); grid = -1; return; }
        if (hipOccupancyMaxActiveBlocksPerMultiprocessor(&per_cu, (const void*)fwd, 512, LDS_BYTES) != hipSuccess || per_cu < 1) { fprintf(stderr, "kernel_launch: occupancy query says %d\n", per_cu); (void)hipGetLastError(); }
        grid = cus;
    }
    if (grid < 0) return;
    (void)hipMemsetAsync((char*)d_ws + WS_CTL, 0, CTL_BYTES, stream);
    Params p{};
    for (int i = 0; i < N_IN; ++i) p.in[i] = (const float*)d_in[i];
    p.out = (float*)d_out; p.ws = (unsigned char*)d_ws;
#if MULTI_LAUNCH
    for (int ph = 0; ph < 1 + DBG_NLAYERS * 12; ++ph) { p.ph_lo = ph; p.ph_hi = ph + 1; hipLaunchKernelGGL(fwd, dim3(grid), dim3(512), LDS_BYTES, stream, p); }
#else
    p.ph_lo = 0; p.ph_hi = NPH; hipLaunchKernelGGL(fwd, dim3(grid), dim3(512), LDS_BYTES, stream, p);
#endif
    const hipError_t le = hipPeekAtLastError();
    if (le != hipSuccess) fprintf(stderr, "kernel_launch: launch failed: %s\n", hipGetErrorName(le));
}
```

```cpp
#include <hip/hip_runtime.h>
#include <cstdio>
#include <cstdint>

#ifndef CB_
#define CB_ 16
#endif
#ifndef LB_
#define LB_ 8
#endif
#ifndef DEPTH_
#define DEPTH_ 4
#endif
#ifndef G1A_LAYERS
#define G1A_LAYERS 0xC
#endif
#ifndef G1A_MODE
#define G1A_MODE 0
#endif
#ifndef G1B_MODE
#define G1B_MODE 1
#endif
#ifndef XBF16
#define XBF16 0
#endif
#ifndef G2_FP8
#define G2_FP8 1
#endif
#ifndef FFN_FP8
#define FFN_FP8 (G1A_MODE != 0 || G1B_MODE != 0 || G2_FP8 != 0)
#endif
constexpr int DM = 2048, DEPTH = DEPTH_, CB = CB_, CT = 256, LB = LB_, LT = 1024;
constexpr int MC = CB * CT, ML = LB * LT, M = MC + ML;
constexpr int FF = 5504, NGU = 2 * FF, NIN = 6192, NINP = 6400, NMOD = 9 * DM, NCOND = 1 + LB;
constexpr float EPS = 1e-6f;
constexpr int FFP = 5632;
constexpr float WGU_SCALE = 32.0f, WDN_SCALE = 64.0f;
constexpr int Z_NAQ = 0, Z_NAK = 512, Z_NAV = 1024, Z_GLQ = 1536, Z_GLK = 1792, Z_GLV = 2048, Z_GLR = 2560, Z_GF = 3072, Z_GB = 3088,
              Z_GQQ = 3104, Z_GQK = 3616, Z_GQV = 3872, Z_DQKV = 4128, Z_DZ = 5664, Z_DB = 6176, Z_DA = 6184;
static_assert(Z_DA + 8 == NIN, "split");
enum { I_XP = 0, I_XS, I_CNAK, I_CNAV, I_CGK, I_CGV, I_SGLA, I_SGDN, I_C, I_CCTX, I_NORMG, I_WMOD, I_BMOD, I_GU, I_DOWN, I_WIN, I_WOUT, I_NAQKN, I_RPB,
       I_GUP, I_GBIAS, I_GLAON, I_GQAQKN, I_CONV, I_ALOG, I_DTB, I_GDNON, N_IN };
constexpr size_t O_YP = 0, O_YS = O_YP + (size_t)MC * DM, O_NAK = O_YS + (size_t)ML * DM, O_NAV = O_NAK + (size_t)CB * DEPTH * 4 * CT * 128,
                 O_GK = O_NAV + (size_t)CB * DEPTH * 4 * CT * 128, O_GV = O_GK + (size_t)CB * DEPTH * 2 * CT * 128,
                 O_SGLA = O_GV + (size_t)CB * DEPTH * 2 * CT * 128, O_SGDN = O_SGLA + (size_t)CB * DEPTH * 2 * 4 * 64 * 128,
                 O_END = O_SGDN + (size_t)CB * DEPTH * 2 * 4 * 128 * 128;
constexpr size_t al256(size_t x) { return (x + 255) & ~(size_t)255; }
constexpr size_t WS_CTL = 0, CTL_BYTES = 1u << 20;
constexpr size_t WS_WGU = CTL_BYTES;
constexpr size_t WS_WDN = WS_WGU + (size_t)DEPTH * 2 * NGU * DM * 2;
constexpr size_t WS_WIN = WS_WDN + (size_t)DEPTH * 2 * DM * FF * 2;
constexpr size_t WS_WOUT = WS_WIN + (size_t)DEPTH * NINP * DM * 2;
constexpr size_t WS_MODV = WS_WOUT + (size_t)DEPTH * DM * DM * 2;
constexpr size_t WS_ROPE = al256(WS_MODV + (size_t)DEPTH * NCOND * NMOD * 4);
constexpr size_t WS_X = al256(WS_ROPE + 2 * 64 * 32 * 4);
constexpr size_t WS_H = WS_X + (size_t)M * DM * 4;
constexpr size_t WS_ACT = WS_H + (size_t)M * DM * 2;
constexpr size_t WS_Z = WS_ACT + (size_t)M * FF * 2;
constexpr size_t WS_MRG = WS_Z + (size_t)M * NINP * 4;
constexpr size_t WS_NAQ = WS_MRG + (size_t)M * DM * 2;
constexpr size_t WS_NAK = WS_NAQ + (size_t)M * 512 * 2;
constexpr size_t WS_NAV = WS_NAK + (size_t)M * 512 * 2;
constexpr size_t WS_GQ = WS_NAV + (size_t)M * 512 * 2;
constexpr size_t WS_GK = WS_GQ + (size_t)M * 512 * 2;
constexpr size_t WS_GV = WS_GK + (size_t)M * 256 * 2;
constexpr size_t WS_CNAK = WS_GV + (size_t)M * 256 * 2;
constexpr size_t WS_CNAV = WS_CNAK + (size_t)LB * DEPTH * 256 * 512 * 2;
constexpr size_t WS_CGK = WS_CNAV + (size_t)LB * DEPTH * 256 * 512 * 2;
constexpr size_t WS_CGV = WS_CGK + (size_t)LB * DEPTH * 256 * 256 * 2;
constexpr size_t WS_AF = WS_CGV + (size_t)LB * DEPTH * 256 * 256 * 2;
constexpr size_t WS_AB = WS_AF + (size_t)M * 256 * 4;
constexpr size_t WS_DQ = WS_AB + (size_t)M * 256 * 4;
constexpr size_t WS_DK = WS_DQ + (size_t)M * 512 * 4;
constexpr size_t WS_DV = WS_DK + (size_t)M * 512 * 4;
constexpr size_t WS_DBA = WS_DV + (size_t)M * 512 * 4;
constexpr size_t WS_GOF = WS_DBA + (size_t)M * 16 * 4;
constexpr size_t WS_GOB = WS_GOF + (size_t)M * 512 * 4;
constexpr size_t WS_DOF = WS_GOB + (size_t)M * 512 * 4;
constexpr size_t WS_DOB = WS_DOF + (size_t)M * 512 * 4;
constexpr size_t WS_END = WS_DOB + (size_t)M * 512 * 4;

typedef unsigned short bf16_t;
struct Params { const float* in[N_IN]; float* out; unsigned char* ws; int ph_lo, ph_hi; };
static_assert(sizeof(Params) == N_IN * 8 + 8 + 8 + 8, "no padding");

#define WSP(T, off) ((T*)(p.ws + (off)))
__device__ __forceinline__ int opaque_tid() { int t = (int)threadIdx.x; asm volatile("" : "+v"(t)); return t; }
__device__ __forceinline__ Params opaque_params(const Params& p) { Params q = p; unsigned long long w = (unsigned long long)q.ws; asm volatile("" : "+s"(w));
    q.ws = (unsigned char*)(__attribute__((address_space(1))) unsigned char*)w; return q; }

typedef float vf4 __attribute__((ext_vector_type(4)));
__device__ __forceinline__ unsigned pack4_fp8(float a, float b, float c, float d) { int w = 0; w = __builtin_amdgcn_cvt_pk_fp8_f32(a, b, w, false); w = __builtin_amdgcn_cvt_pk_fp8_f32(c, d, w, true); return (unsigned)w; }
__device__ __forceinline__ float bf2f(unsigned short v) { return __uint_as_float((unsigned)v << 16); }
__device__ __forceinline__ vf4 ld4bf(const unsigned short* p) { const uint2 w = *(const uint2*)p; vf4 r; r.x = __uint_as_float(w.x << 16); r.y = __uint_as_float(w.x & 0xFFFF0000u); r.z = __uint_as_float(w.y << 16); r.w = __uint_as_float(w.y & 0xFFFF0000u); return r; }
__device__ __forceinline__ vf4 unp4bf(uint2 w) { vf4 r; r.x = __uint_as_float(w.x << 16); r.y = __uint_as_float(w.x & 0xFFFF0000u); r.z = __uint_as_float(w.y << 16); r.w = __uint_as_float(w.y & 0xFFFF0000u); return r; }
__device__ __forceinline__ void unp8bf(uint4 w, vf4& a, vf4& b) {
    a.x = __uint_as_float(w.x << 16); a.y = __uint_as_float(w.x & 0xFFFF0000u); a.z = __uint_as_float(w.y << 16); a.w = __uint_as_float(w.y & 0xFFFF0000u);
    b.x = __uint_as_float(w.z << 16); b.y = __uint_as_float(w.z & 0xFFFF0000u); b.z = __uint_as_float(w.w << 16); b.w = __uint_as_float(w.w & 0xFFFF0000u); }
__device__ __forceinline__ void ld8bf(const unsigned short* p, vf4& a, vf4& b) { const uint4 w = *(const uint4*)p;
    a.x = __uint_as_float(w.x << 16); a.y = __uint_as_float(w.x & 0xFFFF0000u); a.z = __uint_as_float(w.y << 16); a.w = __uint_as_float(w.y & 0xFFFF0000u);
    b.x = __uint_as_float(w.z << 16); b.y = __uint_as_float(w.z & 0xFFFF0000u); b.z = __uint_as_float(w.w << 16); b.w = __uint_as_float(w.w & 0xFFFF0000u); }
__device__ __forceinline__ float wave_sum(float v) {
#pragma unroll
    for (int o = 32; o >= 1; o >>= 1) v += __shfl_xor(v, o);
    return v;
}
typedef float vf2_ __attribute__((ext_vector_type(2)));
typedef __bf16 vb2_ __attribute__((ext_vector_type(2)));
__device__ __forceinline__ bf16_t f2bf(float f) { return __builtin_bit_cast(unsigned short, (__bf16)f); }
__device__ __forceinline__ unsigned pack2(float a, float b) { return __builtin_bit_cast(unsigned, __builtin_convertvector((vf2_){a, b}, vb2_)); }
__device__ __forceinline__ float silu_f(float x) { return x / (1.f + expf(-x)); }
__device__ __forceinline__ float rsqrt_fast(float x) { return __builtin_amdgcn_rsqf(x); }
__device__ __forceinline__ float silu_fast(float x) { return x * __builtin_amdgcn_rcpf(1.f + __expf(-x)); }
__device__ __forceinline__ float logsigmoid_fast(float x) { return fminf(x, 0.f) - __logf(1.f + __expf(-fabsf(x))); }
__device__ __forceinline__ float softplus_f(float x) { return fmaxf(x, 0.f) + log1pf(expf(-fabsf(x))); }
__device__ __forceinline__ float logsigmoid_f(float x) { return fminf(x, 0.f) - log1pf(expf(-fabsf(x))); }
__device__ __forceinline__ bool g1_fp8(int l, int f) { return f ? (G1B_MODE != 0) : (G1A_MODE != 0 || ((G1A_LAYERS >> l) & 1)); }
__device__ __forceinline__ int cond_of_row(int m) { return m < MC ? 0 : 1 + (m - MC) / LT; }
#ifndef CONV_FILLER
#define CONV_FILLER 1
#endif
__device__ __forceinline__ void conv_tile(const float* __restrict__ src, int ld_src, int ncols_src, int k0, int c0, bf16_t* __restrict__ dst, int ld_dst, int n0, float* tile) {
    const int tid = opaque_tid();
    {
        const int r = tid >> 3, c = (tid & 7) * 8;
        float4 a = make_float4(0.f, 0.f, 0.f, 0.f), b = a;
        if (c0 + c + 8 <= ncols_src) {
            const float* s = src + (size_t)(k0 + r) * ld_src + c0 + c;
            a = *(const float4*)s; b = *(const float4*)(s + 4);
        }
        float* t = tile + r * 65 + c;
        t[0] = a.x; t[1] = a.y; t[2] = a.z; t[3] = a.w; t[4] = b.x; t[5] = b.y; t[6] = b.z; t[7] = b.w;
    }
    __syncthreads();
    {
        const int n = tid >> 3, ks = (tid & 7) * 8;
        const float* t = tile + ks * 65 + n;
        uint4 w;
        w.x = pack2(t[0 * 65], t[1 * 65]); w.y = pack2(t[2 * 65], t[3 * 65]); w.z = pack2(t[4 * 65], t[5 * 65]); w.w = pack2(t[6 * 65], t[7 * 65]);
        *(uint4*)(dst + (size_t)(n0 + n) * ld_dst + k0 + ks) = w;
    }
    __syncthreads();
}

__device__ __forceinline__ void conv_tile8(const float* __restrict__ src, int ld_src, int nrows_src, int k0, int c0, unsigned char* __restrict__ dst, int ld_dst, int n0, float scale, float* tile) {
    const int tid = opaque_tid();
    {
        const int r = tid >> 3, c = (tid & 7) * 8;
        float4 a = make_float4(0.f, 0.f, 0.f, 0.f), b = a;
        if (k0 + r < nrows_src) { const float* s = src + (size_t)(k0 + r) * ld_src + c0 + c; a = *(const float4*)s; b = *(const float4*)(s + 4); }
        float* t = tile + r * 65 + c;
        t[0] = a.x * scale; t[1] = a.y * scale; t[2] = a.z * scale; t[3] = a.w * scale; t[4] = b.x * scale; t[5] = b.y * scale; t[6] = b.z * scale; t[7] = b.w * scale;
    }
    __syncthreads();
    {
        const int n = tid >> 3, ks = (tid & 7) * 8;
        const float* t = tile + ks * 65 + n;
        uint2 w; w.x = pack4_fp8(t[0 * 65], t[1 * 65], t[2 * 65], t[3 * 65]); w.y = pack4_fp8(t[4 * 65], t[5 * 65], t[6 * 65], t[7 * 65]);
        *(uint2*)(dst + (size_t)(n0 + n) * ld_dst + k0 + ks) = w;
    }
    __syncthreads();
}
constexpr int MOD_ITEMS = DEPTH * (NMOD / 128);
constexpr int TGU_KT = DM / 64, TGU_NT = NGU / 64, TDN_KT = (G2_FP8 ? FFP : FF) / 64, TDN_NT = DM / 64, TIN_KT = DM / 64, TIN_NT = NINP / 64, TOUT_KT = DM / 64, TOUT_NT = DM / 64;
constexpr int TL_GU = 2 * TGU_KT * TGU_NT, TL_DN = 2 * TDN_KT * TDN_NT, TL_IN = TIN_KT * TIN_NT, TL_OUT = TOUT_KT * TOUT_NT, NT_L = TL_GU + TL_DN + TL_IN + TL_OUT;
struct CTile { const float* sp; unsigned char* dp; float scale; int fp8; };
__device__ __forceinline__ CTile conv_desc(const Params& p, int l, int it, int tid) {
    const int r = tid >> 3, c = (tid & 7) * 8;
    CTile d; d.scale = 1.0f; d.fp8 = 0;
    if (it < TL_GU) {
        const int mat = l * 2 + it / (TGU_KT * TGU_NT), rr = it % (TGU_KT * TGU_NT), kt = rr / TGU_NT, nt = rr % TGU_NT;
        const int n0 = nt * 64, t256 = n0 / 256, cc = n0 % 256;
        const int c0 = cc < 128 ? 128 * t256 + cc : FF + 128 * t256 + (cc - 128);
        d.sp = p.in[I_GU] + (size_t)mat * DM * NGU + (size_t)(kt * 64 + r) * NGU + c0 + c;
        if (g1_fp8(mat >> 1, mat & 1)) { d.fp8 = 1; d.scale = WGU_SCALE; d.dp = WSP(unsigned char, WS_WGU) + (size_t)mat * NGU * DM * 2 + (size_t)(n0 + r) * DM + kt * 64 + c; }
        else d.dp = WSP(unsigned char, WS_WGU) + ((size_t)mat * NGU * DM + (size_t)(n0 + r) * DM + kt * 64 + c) * 2;
    } else if (it < TL_GU + TL_DN) {
        const int i2 = it - TL_GU, mat = l * 2 + i2 / (TDN_KT * TDN_NT), rr = i2 % (TDN_KT * TDN_NT), kt = rr / TDN_NT, nt = rr % TDN_NT;
        d.sp = (kt * 64 + r < FF) ? p.in[I_DOWN] + (size_t)mat * FF * DM + (size_t)(kt * 64 + r) * DM + nt * 64 + c : nullptr;
#if G2_FP8
        d.fp8 = 1; d.scale = WDN_SCALE; d.dp = WSP(unsigned char, WS_WDN) + (size_t)mat * DM * FFP + (size_t)(nt * 64 + r) * FFP + kt * 64 + c;
#else
        d.dp = WSP(unsigned char, WS_WDN) + ((size_t)mat * DM * FF + (size_t)(nt * 64 + r) * FF + kt * 64 + c) * 2;
#endif
    } else if (it < TL_GU + TL_DN + TL_IN) {
        const int i2 = it - TL_GU - TL_DN, kt = i2 / TIN_NT, nt = i2 % TIN_NT;
        d.sp = (nt * 64 + c + 8 <= NIN) ? p.in[I_WIN] + (size_t)l * DM * NIN + (size_t)(kt * 64 + r) * NIN + nt * 64 + c : nullptr;
        d.dp = WSP(unsigned char, WS_WIN) + ((size_t)l * NINP * DM + (size_t)(nt * 64 + r) * DM + kt * 64 + c) * 2;
    } else {
        const int i2 = it - TL_GU - TL_DN - TL_IN, kt = i2 / TOUT_NT, nt = i2 % TOUT_NT;
        d.sp = p.in[I_WOUT] + (size_t)l * DM * DM + (size_t)(kt * 64 + r) * DM + nt * 64 + c;
        d.dp = WSP(unsigned char, WS_WOUT) + ((size_t)l * DM * DM + (size_t)(nt * 64 + r) * DM + kt * 64 + c) * 2;
    }
    return d;
}
__device__ __forceinline__ void conv_layer_tiles(const Params& p, int l, int t_begin, int t_end, int first, int stride, float* s_tile) {
    const int tid = opaque_tid(), r = tid >> 3, c = (tid & 7) * 8;
    int it = t_begin + first;
    if (it >= t_end) return;
    __syncthreads();
    CTile d = conv_desc(p, l, it, tid);
    float4 a = make_float4(0.f, 0.f, 0.f, 0.f), b = a;
    if (d.sp) { a = *(const float4*)d.sp; b = *(const float4*)(d.sp + 4); }
    for (int par = 0; it < t_end; it += stride, par ^= 1) {
        const int nx = it + stride;
        CTile dn = d; float4 na = make_float4(0.f, 0.f, 0.f, 0.f), nb = na;
        if (nx < t_end) { dn = conv_desc(p, l, nx, tid); if (dn.sp) { na = *(const float4*)dn.sp; nb = *(const float4*)(dn.sp + 4); } }
        float* tile = s_tile + par * (64 * 65);
        { float* t = tile + r * 65 + c; const float sc = d.scale;
          t[0] = a.x * sc; t[1] = a.y * sc; t[2] = a.z * sc; t[3] = a.w * sc; t[4] = b.x * sc; t[5] = b.y * sc; t[6] = b.z * sc; t[7] = b.w * sc; }
        __syncthreads();
        { const float* t = tile + c * 65 + r;
          if (d.fp8) { uint2 w; w.x = pack4_fp8(t[0 * 65], t[1 * 65], t[2 * 65], t[3 * 65]); w.y = pack4_fp8(t[4 * 65], t[5 * 65], t[6 * 65], t[7 * 65]); *(uint2*)d.dp = w; }
          else { uint4 w; w.x = pack2(t[0 * 65], t[1 * 65]); w.y = pack2(t[2 * 65], t[3 * 65]); w.z = pack2(t[4 * 65], t[5 * 65]); w.w = pack2(t[6 * 65], t[7 * 65]); *(uint4*)d.dp = w; } }
        d = dn; a = na; b = nb;
    }
    __syncthreads();
}

__device__ __forceinline__ void mod_layer(const Params& p, int l, int first, int stride, float* smem) {
    const int tid = opaque_tid();
    float* s_cond = smem;
    float* s_red = s_cond + NCOND * DM;
    __syncthreads();
    for (int i = tid; i < NCOND * DM; i += 512) { const int ci = i / DM, k = i % DM; const float v = ci == 0 ? p.in[I_CCTX][k] : p.in[I_C][(size_t)(ci - 1) * DM + k]; s_cond[i] = silu_f(v); }
    __syncthreads();
    float* modv = WSP(float, WS_MODV);
    for (int jt = first; jt < NMOD / 128; jt += stride) {
        const int cl = tid & 127, kq = tid >> 7, col = jt * 128 + cl;
        const float* w = p.in[I_WMOD] + (size_t)l * DM * NMOD + col;
        float acc[NCOND];
#pragma unroll
        for (int ci = 0; ci < NCOND; ++ci) acc[ci] = 0.f;
        for (int k = kq * 512; k < kq * 512 + 512; k += 8) {
            float wv[8];
#pragma unroll
            for (int j = 0; j < 8; ++j) wv[j] = w[(size_t)(k + j) * NMOD];
#pragma unroll
            for (int ci = 0; ci < NCOND; ++ci) {
                const float4 s0 = *(const float4*)&s_cond[ci * DM + k], s1 = *(const float4*)&s_cond[ci * DM + k + 4];
                acc[ci] += s0.x * wv[0] + s0.y * wv[1] + s0.z * wv[2] + s0.w * wv[3] + s1.x * wv[4] + s1.y * wv[5] + s1.z * wv[6] + s1.w * wv[7];
            }
        }
        if (kq > 0) {
#pragma unroll
            for (int ci = 0; ci < NCOND; ++ci) s_red[((kq - 1) * 128 + cl) * NCOND + ci] = acc[ci];
        }
        __syncthreads();
        if (kq == 0) {
            const float bm = p.in[I_BMOD][(size_t)l * NMOD + col];
#pragma unroll
            for (int ci = 0; ci < NCOND; ++ci)
                modv[((size_t)l * NCOND + ci) * NMOD + col] = acc[ci] + s_red[(0 * 128 + cl) * NCOND + ci] + s_red[(1 * 128 + cl) * NCOND + ci] + s_red[(2 * 128 + cl) * NCOND + ci] + bm;
        }
        __syncthreads();
    }
}

__device__ __forceinline__ void phase_prologue(const Params& p, float* smem) {
    const int tid = threadIdx.x, nb = gridDim.x, bid = blockIdx.x;
    float* s_tile = smem + NCOND * DM + 3 * 128 * NCOND;
#if CONV_FILLER
    mod_layer(p, 0, bid, nb, smem);
#else
    for (int l2 = 0; l2 < DEPTH; ++l2) mod_layer(p, l2, bid, nb, smem);
#endif
    conv_layer_tiles(p, 0, 0, NT_L, bid, nb, s_tile);
#if !CONV_FILLER
    for (int l2 = 1; l2 < DEPTH; ++l2) conv_layer_tiles(p, l2, 0, NT_L, bid, nb, s_tile);
#endif
    const size_t gtid = (size_t)bid * 512 + tid, gstride = (size_t)nb * 512;
    {
        const size_t n_na = (size_t)LB * DEPTH * 256 * 512 / 8;
        for (size_t i = gtid; i < 2 * n_na; i += gstride) {
            const bool isv = i >= n_na; const size_t j = isv ? i - n_na : i;
            const int d8 = (int)(j % 16), h = (int)((j / 16) % 4), t = (int)((j / 64) % 256); const size_t bl = j / (64 * 256);
            const float* s = p.in[isv ? I_CNAV : I_CNAK] + ((bl * 4 + h) * 256 + t) * 128 + d8 * 8;
            const float4 a = *(const float4*)s, b = *(const float4*)(s + 4);
            uint4 w; w.x = pack2(a.x, a.y); w.y = pack2(a.z, a.w); w.z = pack2(b.x, b.y); w.w = pack2(b.z, b.w);
            *(uint4*)(WSP(bf16_t, isv ? WS_CNAV : WS_CNAK) + (bl * 256 + t) * 512 + h * 128 + d8 * 8) = w;
        }
        const size_t n_g = (size_t)LB * DEPTH * 256 * 256 / 8;
        for (size_t i = gtid; i < 2 * n_g; i += gstride) {
            const bool isv = i >= n_g; const size_t j = isv ? i - n_g : i;
            const int d8 = (int)(j % 16), h = (int)((j / 16) % 2), t = (int)((j / 32) % 256); const size_t bl = j / (32 * 256);
            const float* s = p.in[isv ? I_CGV : I_CGK] + ((bl * 2 + h) * 256 + t) * 128 + d8 * 8;
            const float4 a = *(const float4*)s, b = *(const float4*)(s + 4);
            uint4 w; w.x = pack2(a.x, a.y); w.y = pack2(a.z, a.w); w.z = pack2(b.x, b.y); w.w = pack2(b.z, b.w);
            *(uint4*)(WSP(bf16_t, isv ? WS_CGV : WS_CGK) + (bl * 256 + t) * 256 + h * 128 + d8 * 8) = w;
        }
    }
    for (size_t i = gtid; i < 64 * 32; i += gstride) {
        const int pos = (int)(i / 32), k = (int)(i % 32);
        const float inv = powf(10000.0f, -(float)(2 * k) / 64.0f);
        const float ang = (float)pos * inv;
        WSP(float, WS_ROPE)[i] = cosf(ang); WSP(float, WS_ROPE)[64 * 32 + i] = sinf(ang);
    }
}

#ifndef NORM_NR
#define NORM_NR 2
#endif
__device__ __forceinline__ void phase_norm(const Params& p, int l, int which  ) {
    const int tid = opaque_tid(), lane = tid & 63, wv = tid >> 6;
    const float* X = WSP(float, WS_X); bf16_t* H = WSP(bf16_t, WS_H);
    const bool from_in = (l == 0 && which == 0);
    const float* g = p.in[I_NORMG] + ((size_t)l * 3 + which) * DM;
    const int nw = (int)gridDim.x * 8;
    for (int m0 = blockIdx.x * 8 + wv; m0 < M; m0 += NORM_NR * nw) {
        int mm[NORM_NR]; bool has[NORM_NR];
#pragma unroll
        for (int k = 0; k < NORM_NR; ++k) { has[k] = m0 + k * nw < M; mm[k] = has[k] ? m0 + k * nw : m0; }
        vf4 v[NORM_NR][8]; float ss[NORM_NR];
#pragma unroll
        for (int k = 0; k < NORM_NR; ++k) {
            const int m = mm[k];
            if (from_in || !XBF16) {
                const float* x = !from_in ? X + (size_t)m * DM : m < MC ? p.in[I_XP] + (size_t)m * DM : p.in[I_XS] + (size_t)(m - MC) * DM;
#pragma unroll
                for (int i = 0; i < 8; ++i) v[k][i] = *(const vf4*)(x + (i * 64 + lane) * 4);
            } else {
                const bf16_t* x = (const bf16_t*)X + (size_t)m * DM;
#pragma unroll
                for (int i = 0; i < 8; ++i) v[k][i] = ld4bf(x + (i * 64 + lane) * 4);
            }
        }
#pragma unroll
        for (int k = 0; k < NORM_NR; ++k) {
            ss[k] = 0.f;
#pragma unroll
            for (int i = 0; i < 8; ++i) ss[k] += v[k][i].x * v[k][i].x + v[k][i].y * v[k][i].y + v[k][i].z * v[k][i].z + v[k][i].w * v[k][i].w;
            ss[k] = wave_sum(ss[k]);
        }
#pragma unroll
        for (int k = 0; k < NORM_NR; ++k) {
            if (k > 0 && !has[k]) break;
            const int m = mm[k];
            const float* mv = WSP(float, WS_MODV) + ((size_t)l * NCOND + cond_of_row(m)) * NMOD + (size_t)which * 3 * DM;
            const float r = rsqrt_fast(ss[k] * (1.0f / DM) + EPS);
#pragma unroll
            for (int i = 0; i < 8; ++i) {
                const int c = (i * 64 + lane) * 4;
                const float4 gg = *(const float4*)(g + c), sh = *(const float4*)(mv + c), sc = *(const float4*)(mv + DM + c);
                const float o0 = v[k][i].x * r * gg.x * (1.f + sc.x) + sh.x, o1 = v[k][i].y * r * gg.y * (1.f + sc.y) + sh.y;
                const float o2 = v[k][i].z * r * gg.z * (1.f + sc.z) + sh.z, o3 = v[k][i].w * r * gg.w * (1.f + sc.w) + sh.w;
                if (which != 1 && g1_fp8(l, which >> 1)) *(unsigned*)((unsigned char*)H + (size_t)m * DM + c) = pack4_fp8(o0, o1, o2, o3);
                else { uint2 w; w.x = pack2(o0, o1); w.y = pack2(o2, o3); *(uint2*)(H + (size_t)m * DM + c) = w; }
            }
            if (G2_FP8 && which != 1 && lane < (FFP - FF) / 4) *(unsigned*)(WSP(unsigned char, WS_ACT) + (size_t)m * FFP + FF + 4 * lane) = 0u;
        }
    }
}

__device__ __forceinline__ float red16(float v);
__device__ __forceinline__ float ssq8(vf4 a, vf4 b) { const vf4 s = a * a + b * b; return (s.x + s.y) + (s.z + s.w); }
__device__ __forceinline__ uint4 pack8(vf4 a, vf4 b) { uint4 w; w.x = pack2(a.x, a.y); w.y = pack2(a.z, a.w); w.z = pack2(b.x, b.y); w.w = pack2(b.z, b.w); return w; }
constexpr int PL_CW = 0, PL_UP = PL_CW + 5 * 1536, PL_GB = PL_UP + 2 * 16 * 256, PL_NQ = PL_GB + 512, PL_ROPE = PL_NQ + 512, PL_END = PL_ROPE + 2 * 64 * 32;
__device__ __forceinline__ void phase_prep(const Params& p, int l, unsigned char* lds) {
    const int tid = opaque_tid(), lane = tid & 63, wv = tid >> 6, rg = lane >> 4, sub = lane & 15, c8 = sub * 8;
    const bf16_t* Z = WSP(bf16_t, WS_Z);
    float* sw = (float*)lds;
    for (int i = tid; i < 5 * 1536; i += 512) { const int j = i / 1536, col = i % 1536; sw[PL_CW + j * 1536 + ((col >> 2) & 1) * 768 + (col >> 3) * 4 + (col & 3)] = p.in[I_CONV][(size_t)l * 5 * 1536 + i]; }
    for (int i = tid; i < 2 * 16 * 256 / 4; i += 512) ((vf4*)(sw + PL_UP))[i] = ((const vf4*)(p.in[I_GUP] + (size_t)l * 2 * 16 * 256))[i];
    sw[PL_GB + tid] = p.in[I_GBIAS][(size_t)l * 512 + tid];
    { const int v = tid >> 7, c = tid & 127; const float* src = (v < 2 ? p.in[I_NAQKN] : p.in[I_GQAQKN]) + ((size_t)l * 2 + (v & 1)) * 128; sw[PL_NQ + v * 128 + ((c >> 2) & 1) * 64 + (c >> 3) * 4 + (c & 3)] = src[c]; }
    for (int i = tid; i < 2 * 64 * 32 / 4; i += 512) ((vf4*)(sw + PL_ROPE))[i] = ((const vf4*)WSP(float, WS_ROPE))[i];
    __syncthreads();
    const float* ropec = sw + PL_ROPE; const float* ropes = ropec + 64 * 32;
    const float* wnq = sw + PL_NQ + sub * 4; const float* wnk = wnq + 128;
    const float* wgq = wnq + 256; const float* wgk = wnq + 384;
    const float* cw = sw + PL_CW + (rg * 16 + sub) * 4;
    const int rpw = (M + (int)gridDim.x * 8 - 1) / ((int)gridDim.x * 8);
    for (int m = ((int)blockIdx.x * 8 + wv) * rpw, mend = (m + rpw < M ? m + rpw : M); m < mend; ++m) {
        const bf16_t* z = Z + (size_t)m * NINP;
        const bool ctx = m < MC;
        const int b = ctx ? m / CT : (m - MC) / LT, t = ctx ? m % CT : (m - MC) % LT, T = ctx ? CT : LT;
        const int ho = rg * 128 + c8;
        uint4 rz[5]; uint2 rgz[2][4];
        {
            const bf16_t* zkv = z + (rg < 2 ? Z_GQK + rg * 128 : Z_GQV + (rg - 2) * 128) + c8;
            rz[0] = *(const uint4*)(z + Z_NAQ + ho); rz[1] = *(const uint4*)(z + Z_NAK + ho); rz[2] = *(const uint4*)(z + Z_NAV + ho); rz[3] = *(const uint4*)(z + Z_GQQ + ho); rz[4] = *(const uint4*)zkv;
#pragma unroll
            for (int dir = 0; dir < 2; ++dir)
#pragma unroll
                for (int r4 = 0; r4 < 4; ++r4) rgz[dir][r4] = *(const uint2*)(z + (dir ? Z_GB : Z_GF) + 4 * r4);
        }
        asm volatile("" ::: "memory");
        {
            vf4 q0, q1, k0, k1, v0, v1, g0, g1, x0, x1;
            unp8bf(rz[0], q0, q1); unp8bf(rz[1], k0, k1); unp8bf(rz[2], v0, v1); unp8bf(rz[3], g0, g1); unp8bf(rz[4], x0, x1);
            float r = rsqrt_fast(red16(ssq8(q0, q1)) * (1.0f / 128) + EPS);
            q0 = q0 * r * *(const vf4*)wnq; q1 = q1 * r * *(const vf4*)(wnq + 64);
            *(uint4*)(WSP(bf16_t, WS_NAQ) + (size_t)m * 512 + ho) = pack8(q0, q1);
            r = rsqrt_fast(red16(ssq8(k0, k1)) * (1.0f / 128) + EPS);
            k0 = k0 * r * *(const vf4*)wnk; k1 = k1 * r * *(const vf4*)(wnk + 64);
            *(uint4*)(WSP(bf16_t, WS_NAK) + (size_t)m * 512 + ho) = pack8(k0, k1);
            *(uint4*)(WSP(bf16_t, WS_NAV) + (size_t)m * 512 + ho) = pack8(v0, v1);
            if (ctx) {
                const size_t o = ((((size_t)b * DEPTH + l) * 4 + rg) * CT + t) * 128 + c8;
                *(vf4*)(p.out + O_NAK + o) = k0; *(vf4*)(p.out + O_NAK + o + 4) = k1; *(vf4*)(p.out + O_NAV + o) = v0; *(vf4*)(p.out + O_NAV + o + 4) = v1;
            }
            r = rsqrt_fast(red16(ssq8(g0, g1)) * (1.0f / 128) + EPS);
            g0 = g0 * r * *(const vf4*)wgq; g1 = g1 * r * *(const vf4*)(wgq + 64);
            const float rk = rsqrt_fast(red16(ssq8(x0, x1)) * (1.0f / 128) + EPS);
            if (rg < 2) { x0 = x0 * rk * *(const vf4*)wgk; x1 = x1 * rk * *(const vf4*)(wgk + 64); }
            if (!ctx) {
                const int pos = sub < 8 ? (t >> 6) : (t & 63), ai = pos * 32 + (c8 & 31);
                const vf4 c0 = *(const vf4*)(ropec + ai), c1 = *(const vf4*)(ropec + ai + 4), s0 = *(const vf4*)(ropes + ai), s1 = *(const vf4*)(ropes + ai + 4);
                const bool hi = (sub & 4) != 0;
                vf4 pg0, pg1, px0, px1;
#pragma unroll
                for (int j = 0; j < 4; ++j) { pg0[j] = __shfl_xor(g0[j], 4); pg1[j] = __shfl_xor(g1[j], 4); px0[j] = __shfl_xor(x0[j], 4); px1[j] = __shfl_xor(x1[j], 4); }
                g0 = hi ? pg0 * s0 + g0 * c0 : g0 * c0 - pg0 * s0; g1 = hi ? pg1 * s1 + g1 * c1 : g1 * c1 - pg1 * s1;
                if (rg < 2) { x0 = hi ? px0 * s0 + x0 * c0 : x0 * c0 - px0 * s0; x1 = hi ? px1 * s1 + x1 * c1 : x1 * c1 - px1 * s1; }
            }
            *(uint4*)(WSP(bf16_t, WS_GQ) + (size_t)m * 512 + ho) = pack8(g0, g1);
            *(uint4*)(WSP(bf16_t, rg < 2 ? WS_GK : WS_GV) + (size_t)m * 256 + (rg & 1) * 128 + c8) = pack8(x0, x1);
            if (ctx) {
                const size_t o = ((((size_t)b * DEPTH + l) * 2 + (rg & 1)) * CT + t) * 128 + c8;
                float* dst = p.out + (rg < 2 ? O_GK : O_GV) + o;
                *(vf4*)dst = x0; *(vf4*)(dst + 4) = x1;
            }
        }
        asm volatile("" ::: "memory");
        {
#pragma unroll
            for (int dir = 0; dir < 2; ++dir) {
                const float* up = sw + PL_UP + dir * 16 * 256 + 4 * lane;
                vf4 acc = *(const vf4*)(sw + PL_GB + dir * 256 + 4 * lane);
#pragma unroll
                for (int r4 = 0; r4 < 4; ++r4) {
                    const vf4 gv = unp4bf(rgz[dir][r4]);
                    acc += gv.x * *(const vf4*)(up + (4 * r4 + 0) * 256) + gv.y * *(const vf4*)(up + (4 * r4 + 1) * 256) + gv.z * *(const vf4*)(up + (4 * r4 + 2) * 256) + gv.w * *(const vf4*)(up + (4 * r4 + 3) * 256);
                }
                vf4 o;
#pragma unroll
                for (int j = 0; j < 4; ++j) o[j] = logsigmoid_fast(acc[j]) * (1.0f / 16.0f);
                *(vf4*)(WSP(float, dir ? WS_AB : WS_AF) + (size_t)m * 256 + 4 * lane) = o;
            }
        }
        asm volatile("" ::: "memory");
        {
            uint4 rcz[3][5];
#pragma unroll
            for (int part = 0; part < 3; ++part)
#pragma unroll
                for (int j = 0; j < 5; ++j) { const int tt = t + j - 2;
                    rcz[part][j] = (tt >= 0 && tt < T) ? *(const uint4*)(Z + (size_t)(m + j - 2) * NINP + Z_DQKV + part * 512 + rg * 128 + c8) : make_uint4(0u, 0u, 0u, 0u); }
            asm volatile("" ::: "memory");
#pragma unroll
            for (int part = 0; part < 3; ++part) {
                vf4 a0 = (vf4){0.f, 0.f, 0.f, 0.f}, a1 = a0;
#pragma unroll
                for (int j = 0; j < 5; ++j) {
                    const float* cj = cw + j * 1536 + part * 256;
                    vf4 z0, z1; unp8bf(rcz[part][j], z0, z1);
                    a0 += *(const vf4*)cj * z0; a1 += *(const vf4*)(cj + 768) * z1;
                }
#pragma unroll
                for (int j = 0; j < 4; ++j) { a0[j] = silu_fast(a0[j]); a1[j] = silu_fast(a1[j]); }
                if (part < 2) { const float r = rsqrt_fast(red16(ssq8(a0, a1)) + EPS) * (part == 0 ? 0.08838834764831845f : 1.0f); a0 *= r; a1 *= r; }
                *(uint4*)(WSP(bf16_t, part == 0 ? WS_DQ : part == 1 ? WS_DK : WS_DV) + (size_t)m * 512 + rg * 128 + c8) = pack8(a0, a1);
                asm volatile("" ::: "memory");
            }
            if (lane < 8) {
                const float beta = 1.0f / (1.0f + expf(-bf2f(z[Z_DB + lane])));
                const float g = -expf(p.in[I_ALOG][(size_t)l * 8 + lane]) * softplus_f(bf2f(z[Z_DA + lane]) + p.in[I_DTB][(size_t)l * 8 + lane]);
                float* ba = WSP(float, WS_DBA) + (size_t)m * 16;
                ba[lane] = beta; ba[8 + lane] = g;
            }
        }
    }
}

typedef float vf2 __attribute__((ext_vector_type(2)));
__device__ __forceinline__ float dpp_f(float v, const int ctrl) { return v; }
#define DPPF(v, ctrl) __int_as_float(__builtin_amdgcn_mov_dpp(__float_as_int(v), (ctrl), 0xF, 0xF, true))
__device__ __forceinline__ float red8(float v) { v += DPPF(v, 0xB1); v += DPPF(v, 0x4E); v += DPPF(v, 0x141); return v; }
__device__ __forceinline__ float red16(float v) { v = red8(v); v += DPPF(v, 0x140); return v; }

__device__ __forceinline__ void phase_post(const Params& p, int l) {
    const int tid = opaque_tid(), lane = tid & 63, wv = tid >> 6, rg = lane >> 4, c8 = (lane & 15) * 8;
    const bf16_t* Z = WSP(bf16_t, WS_Z); bf16_t* MRG = WSP(bf16_t, WS_MRG);
    const float* wg = p.in[I_GLAON] + (size_t)l * 128 + c8; const float* wd = p.in[I_GDNON] + (size_t)l * 128 + c8;
    for (int m = blockIdx.x * 8 + wv; m < M; m += gridDim.x * 8) {
        const bf16_t* z = Z + (size_t)m * NINP;
        const int ho = rg * 128 + c8;
#pragma unroll
        for (int g = 0; g < 2; ++g) {
            const float* of = WSP(float, g ? WS_DOF : WS_GOF) + (size_t)m * 512 + ho; const float* ob = WSP(float, g ? WS_DOB : WS_GOB) + (size_t)m * 512 + ho;
            const float* w = g ? wd : wg; const bf16_t* zg = z + (g ? Z_DZ : Z_GLR) + ho;
            vf4 a0 = *(const vf4*)of + *(const vf4*)ob, a1 = *(const vf4*)(of + 4) + *(const vf4*)(ob + 4);
            vf4 g0, g1; ld8bf(zg, g0, g1);
            const float r = rsqrt_fast(red16(ssq8(a0, a1)) * (1.0f / 128) + EPS);
            a0 = a0 * r * *(const vf4*)w; a1 = a1 * r * *(const vf4*)(w + 4);
#pragma unroll
            for (int j = 0; j < 4; ++j) { a0[j] *= silu_fast(g0[j]); a1[j] *= silu_fast(g1[j]); }
            *(uint4*)(MRG + (size_t)m * DM + (g ? 1536 : 512) + ho) = pack8(a0, a1);
        }
    }
}
#define XB_TMO      128
#define XB_XCNT(j)  (256  + 64 * (j))
#define XB_XSUB(j)  (1280 + 64 * (j))
#define XB_XGEN(j)  (2304 + 64 * (j))
#define XB_TOP      3328
#define XB_TOPGEN   3392
#define XCD_BAR_WORDS 3456
#define XB_SPIN_CAP (1u << 22)
#define LAS __attribute__((address_space(3)))

__device__ __forceinline__ unsigned xb_ld(unsigned* p)              { return __hip_atomic_load(p, __ATOMIC_RELAXED, __HIP_MEMORY_SCOPE_AGENT); }
__device__ __forceinline__ unsigned xb_add(unsigned* p, unsigned v) { return __hip_atomic_fetch_add(p, v, __ATOMIC_RELAXED, __HIP_MEMORY_SCOPE_AGENT); }
__device__ __forceinline__ unsigned xb_xcc_id() { return (unsigned)__builtin_amdgcn_s_getreg((3 << 11) | 20) & 0xFu; }
#define XB_SPIN(cond, bar) do { unsigned _sp = 0; while (cond) { __builtin_amdgcn_s_sleep(1); \
    if ((++_sp & 255u) == 0u) { if (xb_ld(&(bar)[XB_TMO])) break; if (_sp > XB_SPIN_CAP) { atomicAdd(&(bar)[XB_TMO], 1u); break; } } } } while (0)

struct XcdBarrier {
    unsigned* bar; unsigned x;
    volatile LAS unsigned* st;
};

__device__ __forceinline__ XcdBarrier xcd_barrier_post(unsigned* bar, volatile LAS unsigned* st) {
    XcdBarrier b; b.bar = bar; b.x = xb_xcc_id(); b.st = st;
    if (threadIdx.x == 0) (void)xb_add(&bar[XB_XCNT(b.x)], 1u);
    return b;
}
__device__ __forceinline__ void xcd_barrier_complete(unsigned* bar, unsigned x, unsigned& nloc, unsigned& nx) {
    const unsigned G = gridDim.x * gridDim.y * gridDim.z;
    unsigned sum, cnt, mine, sp = 0u;
    for (;;) {
        sum = 0u; cnt = 0u; mine = 0u;
#pragma unroll
        for (unsigned j = 0; j < 16; ++j) { const unsigned c = xb_ld(&bar[XB_XCNT(j)]); sum += c; cnt += (c > 0u) ? 1u : 0u; mine = (j == x) ? c : mine; }
        if (sum == G) break;
        __builtin_amdgcn_s_sleep(1);
        if ((++sp & 255u) == 0u) { if (xb_ld(&bar[XB_TMO])) break; if (sp > XB_SPIN_CAP) { atomicAdd(&bar[XB_TMO], 1u); break; } }
    }
    nloc = mine > 0u ? mine : 1u; nx = cnt > 0u ? cnt : 1u;
}

__device__ __forceinline__ void xcd_barrier(const XcdBarrier& b) {
    asm volatile("s_waitcnt vmcnt(0)" ::: "memory");
    __syncthreads();
    if (threadIdx.x == 0) {
        unsigned* bar = b.bar;
        __builtin_amdgcn_s_waitcnt(0);
        unsigned nloc = b.st[0], nx = b.st[1];
        if (nloc == 0u) { xcd_barrier_complete(bar, b.x, nloc, nx); b.st[0] = nloc; b.st[1] = nx; }
        const unsigned old = xb_add(&bar[XB_XSUB(b.x)], 1u);
        const unsigned gen = old / nloc;
        if (old + 1u == (gen + 1u) * nloc) {
            __builtin_amdgcn_fence(__ATOMIC_RELEASE, "agent");
            asm volatile("s_waitcnt vmcnt(0)" ::: "memory");
            const unsigned og = xb_add(&bar[XB_TOP], 1u);
            const unsigned tg = og / nx;
            if (og + 1u == (tg + 1u) * nx) xb_add(&bar[XB_TOPGEN], 1u);
            else XB_SPIN(xb_ld(&bar[XB_TOPGEN]) == tg, bar);
            __builtin_amdgcn_fence(__ATOMIC_ACQUIRE, "agent");
            xb_add(&bar[XB_XGEN(b.x)], 1u);
            asm volatile("s_waitcnt vmcnt(0)" ::: "memory");
        } else {
            XB_SPIN(xb_ld(&bar[XB_XGEN(b.x)]) == gen, bar);
            __builtin_amdgcn_fence(__ATOMIC_ACQUIRE, "agent");
            asm volatile("s_waitcnt vmcnt(0)" ::: "memory");
        }
    }
    __syncthreads();
}

#ifndef NT_STORES
#define NT_STORES 0
#endif
namespace pg8 {
#define PG8_LAS __attribute__((address_space(3)))
typedef unsigned short bf16_t;
typedef short bf16x8 __attribute__((ext_vector_type(8)));
typedef float f32x4 __attribute__((ext_vector_type(4)));
typedef unsigned u32x4 __attribute__((ext_vector_type(4)));
typedef unsigned u32x2 __attribute__((ext_vector_type(2)));
typedef int v4i32 __attribute__((ext_vector_type(4)));
typedef int v8i32 __attribute__((ext_vector_type(8)));
constexpr int BM = 256, BK = 64, HALF = 128, HTB = HALF * BK * 2  , STAGE_BYTES = 8 * HTB, NXCD = 8, WGM = 8;

__host__ __device__ __forceinline__ int lds_byte(int r, int c) { const int st = (r >> 4) * 2 + (c >> 5), rr = r & 15, cc = c & 31, ob = rr * 64 + cc * 2; return st * 1024 + (ob ^ (((ob >> 9) & 1) << 5)); }
__host__ __device__ __forceinline__ void stage_rc(int b, int& R, int& C) { const int st = b / 1024, sb = b % 1024, swz = sb ^ (((sb >> 9) & 1) << 5); R = (st >> 1) * 16 + swz / 64; C = (st & 1) * 32 + (swz % 64) / 2; }
__host__ __device__ __forceinline__ int perm32(int rho) { const int n = rho >> 4, i = rho & 15; return 8 * (i >> 2) + 4 * n + (i & 3); }

struct Unit { int pm, pn, k0, nt, at, slot, msk; };
struct Gemm { const bf16_t* A; const bf16_t* Bt; int M, N, K; };

struct StaticOrder {
    int nM, nN, nwg, G, c, ntk, split, msplit;
    __host__ __device__ void init(int M, int N, int K, int G_, int c_, int split_ = 0) { nM = M / BM; nN = N / BM; nwg = nM * nN; G = G_; c = c_; ntk = K / BK; const int rem = nwg % G_; split = (split_ == 1 && rem > 0 && 2 * rem == G_ && ntk >= 8) ? 1 : 0; msplit = (split_ == 2 && rem > 0 && 2 * rem <= G_) ? 1 : 0; }
    __host__ __device__ bool next(int i, Unit& u) const {
        long L = (long)i * G + c; u.k0 = 0; u.nt = ntk; u.at = 0; u.slot = 0; u.msk = 3;
        if (msplit && i == nwg / G) { const int rem = nwg % G; if (c >= 2 * rem) return false; L = (long)i * G + (c % rem); u.msk = (c / rem) ? 2 : 1; }
        if (split && i == nwg / G) { const int rem = nwg % G, sl = c / rem, h0 = ((ntk / 2) + 1) & ~1; L = (long)i * G + (c % rem); u.k0 = sl ? h0 * BK : 0; u.nt = sl ? ntk - h0 : h0; u.at = sl ? 1 : 2; u.slot = c % rem; }
        if (L >= nwg) return false;
        int wgid = (int)L; { const int q = nwg / NXCD, r = nwg % NXCD, xcd = wgid % NXCD, off = wgid / NXCD; wgid = (xcd < r ? xcd * (q + 1) : r * (q + 1) + (xcd - r) * q) + off; }
        const int nig = WGM * nN, gid = wgid / nig, fm = gid * WGM, gsz = (nM - fm) < WGM ? (nM - fm) : WGM;
        u.pm = fm + ((wgid % nig) % gsz); u.pn = (wgid % nig) / gsz; return true;
    }
    __device__ __forceinline__ void a_ready(const Unit&) const {}
    __device__ __forceinline__ void done(const Unit&) const {}
};
__device__ __forceinline__ unsigned cvt_pk_bf16(float lo, float hi) { unsigned r; asm volatile("v_cvt_pk_bf16_f32 %0, %1, %2" : "=v"(r) : "v"(lo), "v"(hi)); return r; }
struct EpiF32 {
    static constexpr bool PERM = false, AFTER_DRAIN = false;
    float* C; int ldc; const float* bias;
    __device__ __forceinline__ void operator()(const f32x4 (&acc)[2][2][4][2], const Unit& u, int wr, int wc, int fr, int fq) const {
        const int row0 = u.pm * BM + wr * 64 + fr, col0 = u.pn * BM + wc * 32 + 4 * fq;
        f32x4 bv[2][2];
#pragma unroll
        for (int bj = 0; bj < 2; ++bj)
#pragma unroll
            for (int n = 0; n < 2; ++n) bv[bj][n] = bias ? *(const f32x4*)(bias + col0 + bj * HALF + n * 16) : (f32x4){0.f, 0.f, 0.f, 0.f};
#pragma unroll
        for (int ai = 0; ai < 2; ++ai)
#pragma unroll
            for (int m = 0; m < 4; ++m) { float* rowp = C + (size_t)(row0 + ai * HALF + m * 16) * ldc + col0;
#pragma unroll
                for (int bj = 0; bj < 2; ++bj)
#pragma unroll
                    for (int n = 0; n < 2; ++n) *(f32x4*)(rowp + bj * HALF + n * 16) = acc[ai][bj][m][n] + bv[bj][n]; }
    }
};

struct EpiSwiGLU {
    static constexpr bool PERM = true, AFTER_DRAIN = false;
    bf16_t* O; int ldc;
    __device__ __forceinline__ void operator()(const f32x4 (&acc)[2][2][4][2], const Unit& u, int wr, int wc, int fr, int fq) const {
        const int row0 = u.pm * BM + wr * 64 + fr, col0 = u.pn * 128 + wc * 32 + 8 * fq;
#pragma unroll
        for (int ai = 0; ai < 2; ++ai) if ((u.msk >> ai) & 1)
#pragma unroll
            for (int m = 0; m < 4; ++m) { bf16_t* rowp = O + (size_t)(row0 + ai * HALF + m * 16) * ldc + col0;
                const f32x4 g0 = acc[ai][0][m][0], g1 = acc[ai][0][m][1], u0 = acc[ai][1][m][0], u1 = acc[ai][1][m][1];
                float r[8];
#pragma unroll
                for (int j = 0; j < 4; ++j) {
                    r[j]     = g0[j] * __builtin_amdgcn_rcpf(1.0f + __builtin_amdgcn_exp2f(-1.4426950408889634f * g0[j])) * u0[j];
                    r[4 + j] = g1[j] * __builtin_amdgcn_rcpf(1.0f + __builtin_amdgcn_exp2f(-1.4426950408889634f * g1[j])) * u1[j]; }
                u32x4 w; w.x = cvt_pk_bf16(r[0], r[1]); w.y = cvt_pk_bf16(r[2], r[3]); w.z = cvt_pk_bf16(r[4], r[5]); w.w = cvt_pk_bf16(r[6], r[7]);
#if NT_STORES
                __builtin_nontemporal_store(w, (u32x4*)rowp);
#else
                *(u32x4*)rowp = w;
#endif
                }
    }
};
struct EpiSwiGLU8 {
    static constexpr bool PERM = true, AFTER_DRAIN = false;
    unsigned char* O; int ldc; float wscale;
    __device__ __forceinline__ void operator()(const f32x4 (&acc)[2][2][4][2], const Unit& u, int wr, int wc, int fr, int fq) const {
        const int row0 = u.pm * BM + wr * 64 + fr, col0 = u.pn * 128 + wc * 32 + 8 * fq;
#pragma unroll
        for (int ai = 0; ai < 2; ++ai) if ((u.msk >> ai) & 1)
#pragma unroll
            for (int m = 0; m < 4; ++m) { unsigned char* rowp = O + (size_t)(row0 + ai * HALF + m * 16) * ldc + col0;
                f32x4 g0 = acc[ai][0][m][0], g1 = acc[ai][0][m][1], u0 = acc[ai][1][m][0], u1 = acc[ai][1][m][1];
                asm volatile("" : "+v"(g0), "+v"(g1), "+v"(u0), "+v"(u1));
                g0 *= wscale; g1 *= wscale; u0 *= wscale; u1 *= wscale;
                float r[8];
#pragma unroll
                for (int j = 0; j < 4; ++j) {
                    r[j]     = g0[j] * __builtin_amdgcn_rcpf(1.0f + __builtin_amdgcn_exp2f(-1.4426950408889634f * g0[j])) * u0[j];
                    r[4 + j] = g1[j] * __builtin_amdgcn_rcpf(1.0f + __builtin_amdgcn_exp2f(-1.4426950408889634f * g1[j])) * u1[j]; }
                uint2 w; w.x = pack4_fp8(r[0], r[1], r[2], r[3]); w.y = pack4_fp8(r[4], r[5], r[6], r[7]);
                *(uint2*)rowp = w; asm volatile("" ::: "memory"); }
    }
};
struct EpiBf16Plain {
    static constexpr bool PERM = true, AFTER_DRAIN = false;
    bf16_t* O; int ldc;
    __device__ __forceinline__ void operator()(const f32x4 (&acc)[2][2][4][2], const Unit& u, int wr, int wc, int fr, int fq) const {
        const int row0 = u.pm * BM + wr * 64 + fr, col0 = u.pn * BM + wc * 32 + 8 * fq;
#pragma unroll
        for (int ai = 0; ai < 2; ++ai) if ((u.msk >> ai) & 1)
#pragma unroll
            for (int m = 0; m < 4; ++m) { bf16_t* rowp = O + (size_t)(row0 + ai * HALF + m * 16) * ldc + col0;
#pragma unroll
                for (int bj = 0; bj < 2; ++bj) { const f32x4 v0 = acc[ai][bj][m][0], v1 = acc[ai][bj][m][1];
                    u32x4 w; w.x = pack2(v0[0], v0[1]); w.y = pack2(v0[2], v0[3]); w.z = pack2(v1[0], v1[1]); w.w = pack2(v1[2], v1[3]);
                    *(u32x4*)(rowp + bj * HALF) = w; } }
    }
};
struct EpiResid {
    static constexpr bool PERM = false, AFTER_DRAIN = false;
    const float* res; float* out; int ldc; const float* gate0; float coef;
    float* slab; unsigned* flags; unsigned target;
    const float* res_hi; int row_hi;
    int res_bf16, out_bf16;
    __device__ __forceinline__ void operator()(const f32x4 (&acc)[2][2][4][2], const Unit& u, int wr, int wc, int fr, int fq) const {
        const int tidx = ((wr * 4 + wc) * 4 + fq) * 16 + fr;
        if (u.at == 1) {
            const __amdgpu_buffer_rsrc_t rs = __builtin_amdgcn_make_buffer_rsrc((void*)slab, 0, 0x7FFFFFF0, 0x00020000);
            const unsigned base = ((unsigned)u.slot * 32u * 512u + (unsigned)tidx) * 16u;
#pragma unroll
            for (int ai = 0; ai < 2; ++ai)
#pragma unroll
                for (int bj = 0; bj < 2; ++bj)
#pragma unroll
                    for (int m = 0; m < 4; ++m)
#pragma unroll
                        for (int n = 0; n < 2; ++n) { const f32x4 v = acc[ai][bj][m][n]; u32x4 w; w.x = __float_as_uint(v[0]); w.y = __float_as_uint(v[1]); w.z = __float_as_uint(v[2]); w.w = __float_as_uint(v[3]);
                            __builtin_amdgcn_raw_buffer_store_b128(w, rs, base + (unsigned)((((ai * 2 + bj) * 4 + m) * 2 + n) * 512 * 16), 0, 16); }
            asm volatile("s_waitcnt vmcnt(0)" ::: "memory");
            if ((tidx & 63) == 0) __hip_atomic_fetch_add(flags + 64 * u.slot, 1u, __ATOMIC_RELAXED, __HIP_MEMORY_SCOPE_AGENT);
            return;
        }
        const float* part = nullptr;
        if (u.at == 2) {
            unsigned spins = 0;
            while (__hip_atomic_load(flags + 64 * u.slot, __ATOMIC_RELAXED, __HIP_MEMORY_SCOPE_AGENT) < target) { __builtin_amdgcn_s_sleep(2); if (++spins > (1u << 22)) break; }
            __builtin_amdgcn_fence(__ATOMIC_ACQUIRE, "agent");
            asm volatile("s_waitcnt vmcnt(0)" ::: "memory");
            part = slab + ((size_t)u.slot * 32 * 512 + tidx) * 4;
        }
        const int row0 = u.pm * BM + wr * 64 + fr, col0 = u.pn * BM + wc * 32 + 4 * fq;
        const float* gate = gate0 + (size_t)cond_of_row(u.pm * BM) * NMOD;
        const float* rbase = (u.pm * BM >= row_hi) ? res_hi - (size_t)row_hi * ldc : res;
        f32x4 gv[2][2];
#pragma unroll
        for (int bj = 0; bj < 2; ++bj)
#pragma unroll
            for (int n = 0; n < 2; ++n) gv[bj][n] = *(const f32x4*)(gate + col0 + bj * HALF + n * 16) * coef;
#pragma unroll
        for (int ai = 0; ai < 2; ++ai) if ((u.msk >> ai) & 1)
#pragma unroll
            for (int m = 0; m < 4; ++m) { const size_t off = (size_t)(row0 + ai * HALF + m * 16) * ldc + col0;
#pragma unroll
                for (int bj = 0; bj < 2; ++bj)
#pragma unroll
                    for (int n = 0; n < 2; ++n) {
                        f32x4 a = acc[ai][bj][m][n];
                        if (part) a += *(const f32x4*)(part + (size_t)((((ai * 2 + bj) * 4 + m) * 2 + n) * 512 * 4));
                        const size_t eo = off + bj * HALF + n * 16;
                        f32x4 bs;
                        if (res_bf16) { const u32x2 w = *(const u32x2*)((const bf16_t*)rbase + eo); bs[0] = __uint_as_float(w.x << 16); bs[1] = __uint_as_float(w.x & 0xFFFF0000u); bs[2] = __uint_as_float(w.y << 16); bs[3] = __uint_as_float(w.y & 0xFFFF0000u); }
                        else bs = *(const f32x4*)(rbase + eo);
                        const f32x4 o = bs + gv[bj][n] * a;
                        if (out_bf16) { u32x2 w; w.x = cvt_pk_bf16(o[0], o[1]); w.y = cvt_pk_bf16(o[2], o[3]); *(u32x2*)((bf16_t*)out + eo) = w; }
                        else *(f32x4*)(out + eo) = o; }
                asm volatile("" ::: "memory"); }
    }
};
template <class Epi, class Sched, bool STAMP = false, int FP8 = 0>
__device__ __forceinline__ void gemm_phase(PG8_LAS unsigned char* lds, const Gemm g, const Sched& S, const Epi& E, unsigned long long* stamps) {
    const int tid = opaque_tid(), wid = __builtin_amdgcn_readfirstlane(tid >> 6), lane = tid & 63, wr = wid >> 2, wc = wid & 3, fr = lane & 15, fq = lane >> 4;
    const int K = g.K;
    int ts_lo = 0, ts_hi = 0, nts = 0; const unsigned long long rt_entry = STAMP ? (unsigned long long)wall_clock64() : 0ull;
#define PG8_STAMP() do { if (STAMP && wid == 0 && nts < 64) { const unsigned long long _c = (unsigned long long)clock64(); \
        ts_lo = (lane == nts) ? (int)(unsigned)_c : ts_lo; ts_hi = (lane == nts) ? (int)(unsigned)(_c >> 32) : ts_hi; ++nts; } } while (0)
    PG8_STAMP();
    unsigned voffA[2], voffB[2];
#pragma unroll
    for (int i = 0; i < 2; ++i) { int R, C; stage_rc(tid * 16 + i * 8192, R, C); const int Rb = Epi::PERM ? ((R & ~31) + perm32(R & 31)) : R;
        voffA[i] = (unsigned)(R * K + C) * 2u; voffB[i] = (unsigned)(Rb * K + C) * 2u; }
    const size_t kstep = (size_t)(BK * 2);
    const size_t hstep = (size_t)HALF * K * 2;
    const size_t tstep = 2 * hstep;
    const unsigned ldsw = (unsigned)wid * 1024u;
    const int aoff = lds_byte(wr * 64 + fr, fq * 8), boff = lds_byte(wc * 32 + fr, fq * 8);
#define PG8_SA(b, h) (((b) * 2 + (h)) * HTB)
#define PG8_SB(b, h) ((4 + (b) * 2 + (h)) * HTB)
#define PG8_STAGE(bufoff, gbase, voff) do { _Pragma("unroll") for (int _i = 0; _i < 2; ++_i) \
        __builtin_amdgcn_global_load_lds((const unsigned*)((const char*)(gbase) + (voff)[_i]), (PG8_LAS unsigned*)(lds + (bufoff) + ldsw + _i * 8192), 16, 0, 0); } while (0)
#define PG8_LDA(dst, b, h) do { _Pragma("unroll") for (int m = 0; m < 4; ++m) dst[m] = __builtin_shufflevector(*(const PG8_LAS v4i32*)(lds + PG8_SA(b, h) + aoff + m * 2048), *(const PG8_LAS v4i32*)(lds + PG8_SA(b, h) + aoff + m * 2048 + 1024), 0, 1, 2, 3, 4, 5, 6, 7); } while (0)
#define PG8_LDB(dst, b, h) do { _Pragma("unroll") for (int n = 0; n < 2; ++n) dst[n] = __builtin_shufflevector(*(const PG8_LAS v4i32*)(lds + PG8_SB(b, h) + boff + n * 2048), *(const PG8_LAS v4i32*)(lds + PG8_SB(b, h) + boff + n * 2048 + 1024), 0, 1, 2, 3, 4, 5, 6, 7); } while (0)
#define PG8_HALF(v, k) __builtin_bit_cast(bf16x8, __builtin_shufflevector(v, v, 4 * (k), 4 * (k) + 1, 4 * (k) + 2, 4 * (k) + 3))
#define PG8_MMA(ai, bj, At, Bt) do { __builtin_amdgcn_s_setprio(1); _Pragma("unroll") for (int m = 0; m < 4; ++m) _Pragma("unroll") for (int n = 0; n < 2; ++n) { \
        acc[ai][bj][m][n] = __builtin_amdgcn_mfma_f32_16x16x32_bf16(PG8_HALF(Bt[n], 0), PG8_HALF(At[m], 0), acc[ai][bj][m][n], 0, 0, 0); \
        acc[ai][bj][m][n] = __builtin_amdgcn_mfma_f32_16x16x32_bf16(PG8_HALF(Bt[n], 1), PG8_HALF(At[m], 1), acc[ai][bj][m][n], 0, 0, 0); } __builtin_amdgcn_s_setprio(0); } while (0)
#define PG8_MMA8(ai, bj, At, Bt) do { __builtin_amdgcn_s_setprio(1); _Pragma("unroll") for (int m = 0; m < 4; ++m) _Pragma("unroll") for (int n = 0; n < 2; ++n) \
        acc[ai][bj][m][n] = __builtin_amdgcn_mfma_scale_f32_16x16x128_f8f6f4(Bt[n], At[m], acc[ai][bj][m][n], 0, 0, 0, 127, 0, 127); __builtin_amdgcn_s_setprio(0); } while (0)
#define PG8_Q64(v, q) __builtin_bit_cast(long, __builtin_shufflevector(v, v, 2 * (q), 2 * (q) + 1))
#define PG8_M8L1(ai, bj, m, n, q) acc[ai][bj][m][n] = __builtin_amdgcn_mfma_f32_16x16x32_fp8_fp8(PG8_Q64(Bt_[n], q), PG8_Q64(At_[m], q), acc[ai][bj][m][n], 0, 0, 0)
#define PG8_MMA8L(ai, bj, At, Bt) do { auto& At_ = At; auto& Bt_ = Bt; __builtin_amdgcn_s_setprio(1); _Pragma("unroll") for (int m = 0; m < 4; ++m) _Pragma("unroll") for (int n = 0; n < 2; ++n) { \
        PG8_M8L1(ai, bj, m, n, 0); PG8_M8L1(ai, bj, m, n, 1); PG8_M8L1(ai, bj, m, n, 2); PG8_M8L1(ai, bj, m, n, 3); } __builtin_amdgcn_s_setprio(0); } while (0)
#define PG8_MMAG(ai, bj, At, Bt) do { if (mrow & (1 << (ai))) { if constexpr (FP8 == 1) PG8_MMA8(ai, bj, At, Bt); else if constexpr (FP8 == 2) PG8_MMA8L(ai, bj, At, Bt); else PG8_MMA(ai, bj, At, Bt); } } while (0)
#define PG8_WAIT_V(n) asm volatile("s_waitcnt vmcnt(" #n ")" ::: "memory")
#define PG8_WAIT_L(n) asm volatile("s_waitcnt lgkmcnt(" #n ")" ::: "memory")
#define PG8_BAR __builtin_amdgcn_s_barrier()
#define PG8_SCHED __builtin_amdgcn_sched_barrier(0)
    Unit cur, nxt; int ui = 0;
    if (!S.next(0, cur)) return;
    f32x4 acc[2][2][4][2];
#pragma unroll
    for (int a = 0; a < 2; ++a)
#pragma unroll
        for (int b = 0; b < 2; ++b)
#pragma unroll
            for (int m = 0; m < 4; ++m)
#pragma unroll
                for (int n = 0; n < 2; ++n) acc[a][b][m][n] = (f32x4){0.f, 0.f, 0.f, 0.f};
    v8i32 At[4], B0[2], B1[2];
    const char* cA = (const char*)g.A + (size_t)cur.pm * tstep + (size_t)cur.k0 * 2; const char* cB = (const char*)g.Bt + (size_t)cur.pn * tstep + (size_t)cur.k0 * 2;
    S.a_ready(cur);
    PG8_STAGE(PG8_SB(0, 0), cB, voffB); PG8_STAGE(PG8_SA(0, 0), cA, voffA); PG8_STAGE(PG8_SB(0, 1), cB + hstep, voffB); PG8_STAGE(PG8_SA(0, 1), cA + hstep, voffA);
    if (wr == 1) PG8_BAR;
    PG8_WAIT_V(4); PG8_BAR;
    PG8_STAGE(PG8_SB(1, 0), cB + kstep, voffB); PG8_STAGE(PG8_SA(1, 0), cA + kstep, voffA); PG8_STAGE(PG8_SB(1, 1), cB + hstep + kstep, voffB);
    PG8_WAIT_V(6); PG8_BAR;
    PG8_STAMP();
    for (;;) {
        const bool has_next = S.next(ui + 1, nxt);
        const char* nA = has_next ? (const char*)g.A + (size_t)nxt.pm * tstep + (size_t)nxt.k0 * 2 : cA; const char* nB = has_next ? (const char*)g.Bt + (size_t)nxt.pn * tstep + (size_t)nxt.k0 * 2 : cB;
        const int nt = cur.nt, mrow = cur.msk;
        for (int t = 0; t < nt; t += 2) {
            const bool last = (t == nt - 2);
            const char* a1 = cA + (size_t)(t + 1) * kstep;
            const char* a2 = last ? nA : cA + (size_t)(t + 2) * kstep; const char* b2 = last ? nB : cB + (size_t)(t + 2) * kstep;
            const char* a3 = a2 + kstep; const char* b3 = b2 + kstep;
            if (last && has_next) S.a_ready(nxt);
            PG8_LDB(B0, 0, 0); PG8_SCHED; PG8_LDA(At, 0, 0); PG8_STAGE(PG8_SA(1, 1), a1 + hstep, voffA);
            PG8_WAIT_L(8); PG8_BAR; PG8_WAIT_L(0); PG8_MMAG(0, 0, At, B0); PG8_BAR; PG8_SCHED;
            PG8_LDB(B1, 0, 1); PG8_STAGE(PG8_SB(0, 0), b2, voffB);
            PG8_BAR; PG8_WAIT_L(0); PG8_MMAG(0, 1, At, B1); PG8_BAR;
            PG8_LDA(At, 0, 1); PG8_STAGE(PG8_SA(0, 0), a2, voffA);
            PG8_BAR; PG8_WAIT_L(0); PG8_MMAG(1, 0, At, B0); PG8_BAR; PG8_SCHED;
            PG8_STAGE(PG8_SB(0, 1), b2 + hstep, voffB);
            PG8_WAIT_V(6); PG8_BAR; PG8_MMAG(1, 1, At, B1); PG8_BAR;
            PG8_LDB(B0, 1, 0); PG8_SCHED; PG8_LDA(At, 1, 0); PG8_STAGE(PG8_SA(0, 1), a2 + hstep, voffA);
            PG8_WAIT_L(8); PG8_BAR; PG8_WAIT_L(0); PG8_MMAG(0, 0, At, B0); PG8_BAR; PG8_SCHED;
            PG8_LDB(B1, 1, 1); PG8_STAGE(PG8_SB(1, 0), b3, voffB);
            PG8_BAR; PG8_WAIT_L(0); PG8_MMAG(0, 1, At, B1); PG8_BAR;
            PG8_LDA(At, 1, 1); PG8_STAGE(PG8_SA(1, 0), a3, voffA);
            PG8_BAR; PG8_WAIT_L(0); PG8_MMAG(1, 0, At, B0); PG8_BAR; PG8_SCHED;
            PG8_STAGE(PG8_SB(1, 1), b3 + hstep, voffB);
            PG8_WAIT_V(6); PG8_BAR; PG8_MMAG(1, 1, At, B1); PG8_BAR;
        }
        PG8_STAMP();
        if constexpr (!Epi::AFTER_DRAIN) { E(acc, cur, wr, wc, fr, fq); S.done(cur); }
        PG8_STAMP();
        if (!has_next) break;
#pragma unroll
        for (int a = 0; a < 2; ++a)
#pragma unroll
            for (int b = 0; b < 2; ++b)
#pragma unroll
                for (int m = 0; m < 4; ++m)
#pragma unroll
                    for (int n = 0; n < 2; ++n) acc[a][b][m][n] = (f32x4){0.f, 0.f, 0.f, 0.f};
        cur = nxt; cA = nA; cB = nB; ++ui;
    }
    PG8_WAIT_V(0);
    if (wr == 0) PG8_BAR;
    PG8_BAR;
    if constexpr (Epi::AFTER_DRAIN) { E.fused(acc, cur, wr, wc, fr, fq, lds, wid, lane); S.done(cur); }
    PG8_STAMP();
    if (STAMP && wid == 0) { stamps[lane] = lane < nts ? (((unsigned long long)(unsigned)ts_hi << 32) | (unsigned)ts_lo) : 0ull;
        if (lane == 62) stamps[62] = rt_entry; if (lane == 63) stamps[63] = (unsigned long long)wall_clock64(); }
#undef PG8_STAMP
#undef PG8_SA
#undef PG8_SB
#undef PG8_STAGE
#undef PG8_LDA
#undef PG8_LDB
#undef PG8_HALF
#undef PG8_MMA
#undef PG8_MMA8
#undef PG8_MMA8L
#undef PG8_M8L1
#undef PG8_Q64
#undef PG8_MMAG
#undef PG8_WAIT_V
#undef PG8_WAIT_L
#undef PG8_BAR
#undef PG8_SCHED
}
}
#ifndef ATT_INLINE
#define ATT_INLINE __forceinline__
#endif
namespace att {
constexpr int D = 128, NW = 8, QBLK = 32, KVBLK = 64, LDQ = 512, LDO = DM;
constexpr float SCALE = 0.088388347648318440f;
constexpr float THR = 8.f;
constexpr size_t SHM_V = KVBLK * D * 2, SHM_K = KVBLK * D * 2, SHM_Q = 256 * D * 2, SHM_ATTN = 2 * SHM_V + 2 * SHM_K + NW * 64 * 4 + SHM_Q;
using bf16x8 = __attribute__((ext_vector_type(8))) short;
using s16x4  = __attribute__((ext_vector_type(4))) short;
using f32x16 = __attribute__((ext_vector_type(16))) float;
using u32x4  = __attribute__((ext_vector_type(4))) unsigned;
#define KSWZ(row, colB) ((row) * 256 + ((colB) ^ (((row) & 7) << 4)))
#define SBAR() __builtin_amdgcn_sched_barrier(0)
__device__ __forceinline__ int crow(int r, int hi) { return (r & 3) + 8 * (r >> 2) + 4 * hi; }
__device__ __forceinline__ unsigned cvtpk(float lo, float hi) { unsigned r; asm volatile("v_cvt_pk_bf16_f32 %0, %1, %2" : "=v"(r) : "v"(lo), "v"(hi)); return r; }

__device__ __forceinline__ void partialSM(f32x16& p0, f32x16& p1, float& m_reg, float& mn, float& alpha) {
  constexpr float C = SCALE * 1.4426950408889634f;
  float pmax = p0[0]; for (int r = 1; r < 16; ++r) pmax = fmaxf(pmax, p0[r]); for (int r = 0; r < 16; ++r) pmax = fmaxf(pmax, p1[r]);
  { auto rr = __builtin_amdgcn_permlane32_swap(__float_as_uint(pmax), __float_as_uint(pmax), false, false);
    pmax = fmaxf(__uint_as_float(rr[0]), __uint_as_float(rr[1])); }
  if (__builtin_expect(__all(pmax - m_reg <= THR / SCALE), 1)) { mn = m_reg; alpha = 1.f; }
  else { mn = fmaxf(m_reg, pmax); alpha = __builtin_amdgcn_exp2f((m_reg - mn) * C); m_reg = mn; }
  float mnC = -mn * C;
  for (int r = 0; r < 16; ++r) p0[r] = fmaf(p0[r], C, mnC); for (int r = 0; r < 16; ++r) p1[r] = fmaf(p1[r], C, mnC);
  for (int r = 0; r < 16; ++r) p0[r] = __builtin_amdgcn_exp2f(p0[r]);
}
__device__ __forceinline__ void finishSM(f32x16& p0, f32x16& p1, float alpha, float& l_reg, bf16x8& pa0, bf16x8& pa1, bf16x8& pa2, bf16x8& pa3) {
  for (int r = 0; r < 16; ++r) p1[r] = __builtin_amdgcn_exp2f(p1[r]);
  float ps = 0; for (int r = 0; r < 16; ++r) ps += p0[r]; for (int r = 0; r < 16; ++r) ps += p1[r];
  { auto rr = __builtin_amdgcn_permlane32_swap(__float_as_uint(ps), __float_as_uint(ps), false, false);
    ps = __uint_as_float(rr[0]) + __uint_as_float(rr[1]); }
  l_reg = l_reg * alpha + ps;
#define PK4(P, BASE, OUT) do { unsigned a0 = cvtpk(P[BASE + 0], P[BASE + 1]), a1 = cvtpk(P[BASE + 2], P[BASE + 3]);   \
    unsigned b0 = cvtpk(P[BASE + 4], P[BASE + 5]), b1 = cvtpk(P[BASE + 6], P[BASE + 7]);                              \
    auto r0 = __builtin_amdgcn_permlane32_swap(a0, b0, false, false); auto r1 = __builtin_amdgcn_permlane32_swap(a1, b1, false, false); \
    u32x4 w = {r0[0], r1[0], r0[1], r1[1]}; OUT = *reinterpret_cast<bf16x8*>(&w); } while (0)
  PK4(p0, 0, pa0); PK4(p0, 8, pa1); PK4(p1, 0, pa2); PK4(p1, 8, pa3);
#undef PK4
}
__device__ __forceinline__ void qkt(f32x16& p0, f32x16& p1, const bf16_t* Ks, const bf16_t* Qs, int qrow, int r32, int hi) {
  p0 = f32x16{}; p1 = f32x16{};
#pragma unroll
  for (int d0 = 0; d0 < 8; ++d0) { int cb = (d0 * 16 + hi * 8) * 2;
    bf16x8 q = *reinterpret_cast<const bf16x8*>((const char*)Qs + KSWZ(qrow, cb));
    bf16x8 b0 = *reinterpret_cast<const bf16x8*>((const char*)Ks + KSWZ(r32, cb));
    bf16x8 b1 = *reinterpret_cast<const bf16x8*>((const char*)Ks + KSWZ(32 + r32, cb));
    p0 = __builtin_amdgcn_mfma_f32_32x32x16_bf16(b0, q, p0, 0, 0, 0);
    p1 = __builtin_amdgcn_mfma_f32_32x32x16_bf16(b1, q, p1, 0, 0, 0); }
}
__device__ __forceinline__ int v_st(int k, int c) { const int kk = (k & ~0xC) | ((k & 4) << 1) | ((k & 8) >> 1); return ((kk >> 3) * 4 + (c >> 5)) * 512 + ((kk & 7) * 32 + (c & 31)) * 2; }
__device__ __forceinline__ int v_rd_base(int lane) { return ((lane & 3) << 3) | (((lane >> 2) & 3) << 6) | (((lane >> 4) & 1) << 5) | (((lane >> 5) & 1) << 8); }
constexpr int v_rd_off(int d0, int ks, int half) { return d0 * 512 + ks * 4096 + half * 2048; }
template <int OFF> __device__ __forceinline__ s16x4 tr_read(int vb) {
  s16x4 r; asm volatile("ds_read_b64_tr_b16 %0, %1 offset:%2" : "=&v"(r) : "v"(vb), "i"(OFF) : "memory"); return r;
}
template <int D0> __device__ __forceinline__ void pv_one(f32x16& od, int vb, bf16x8 pa0, bf16x8 pa1, bf16x8 pa2, bf16x8 pa3) {
  const s16x4 l0 = tr_read<v_rd_off(D0, 0, 0)>(vb), h0 = tr_read<v_rd_off(D0, 0, 1)>(vb), l1 = tr_read<v_rd_off(D0, 1, 0)>(vb), h1 = tr_read<v_rd_off(D0, 1, 1)>(vb);
  const s16x4 l2 = tr_read<v_rd_off(D0, 2, 0)>(vb), h2 = tr_read<v_rd_off(D0, 2, 1)>(vb), l3 = tr_read<v_rd_off(D0, 3, 0)>(vb), h3 = tr_read<v_rd_off(D0, 3, 1)>(vb);
  asm volatile("s_waitcnt lgkmcnt(0)" ::: "memory"); SBAR();
#define PK(L, H) (bf16x8){L[0], L[1], L[2], L[3], H[0], H[1], H[2], H[3]}
  od = __builtin_amdgcn_mfma_f32_32x32x16_bf16(pa0, PK(l0, h0), od, 0, 0, 0);
  od = __builtin_amdgcn_mfma_f32_32x32x16_bf16(pa1, PK(l1, h1), od, 0, 0, 0);
  od = __builtin_amdgcn_mfma_f32_32x32x16_bf16(pa2, PK(l2, h2), od, 0, 0, 0);
  od = __builtin_amdgcn_mfma_f32_32x32x16_bf16(pa3, PK(l3, h3), od, 0, 0, 0);
#undef PK
}
__device__ __forceinline__ void pv_d0(f32x16* o, int vb, bf16x8 pa0, bf16x8 pa1, bf16x8 pa2, bf16x8 pa3) {
  pv_one<0>(o[0], vb, pa0, pa1, pa2, pa3); pv_one<1>(o[1], vb, pa0, pa1, pa2, pa3); pv_one<2>(o[2], vb, pa0, pa1, pa2, pa3); pv_one<3>(o[3], vb, pa0, pa1, pa2, pa3);
}

struct SrcOne { const bf16_t* k0; const bf16_t* v0; int ldk;
  __device__ __forceinline__ const bf16_t* k(int j) const { return k0 + (size_t)j * 64 * ldk; }
  __device__ __forceinline__ const bf16_t* v(int j) const { return v0 + (size_t)j * 64 * ldk; } };
struct SrcTwo { const bf16_t* ck; const bf16_t* cv; const bf16_t* k1; const bf16_t* v1; int ldk;
  __device__ __forceinline__ const bf16_t* k(int j) const { return j < 4 ? ck + (size_t)j * 64 * ldk : k1 + (size_t)(j - 4) * 64 * ldk; }
  __device__ __forceinline__ const bf16_t* v(int j) const { return j < 4 ? cv + (size_t)j * 64 * ldk : v1 + (size_t)(j - 4) * 64 * ldk; } };
struct NoBias { __device__ __forceinline__ void operator()(f32x16&, f32x16&, int, int, int, int) const {} };
struct NaBias { const float* tab; int i0, kr0;
  __device__ __forceinline__ void operator()(f32x16& p0, f32x16& p1, int jt, int wid, int r32, int hi) const {
    if (jt < 4) return;
    const int qi = i0 + wid * QBLK + r32, r = qi >> 6, qc = qi & 63, kr = kr0 + jt - 4;
    int lo = r - 4; lo = lo < 0 ? 0 : (lo > 8 ? 8 : lo);
    const bool rowok = (kr >= lo) && (kr < lo + 8);
    if (!rowok) {
#pragma unroll
      for (int rr = 0; rr < 16; ++rr) { p0[rr] = -1e30f; p1[rr] = -1e30f; }
      return;
    }
    int c0 = qc - 8; c0 = c0 < 0 ? 0 : (c0 > 48 ? 48 : c0);
    const int dr = kr - r + 7;
    const float* tb = tab + dr * 31 + (4 * hi - qc + 15);
    const int w0 = 4 * hi - c0;
#pragma unroll
    for (int g = 0; g < 4; ++g) {
#pragma unroll
      for (int q = 0; q < 4; ++q) {
        const int rr = 4 * g + q, kc0 = q + 8 * g;
        const float t0 = tb[kc0], t1 = tb[kc0 + 32];
        p0[rr] = ((unsigned)(kc0 + w0) < 16u) ? p0[rr] + t0 : -1e30f;
        p1[rr] = ((unsigned)(kc0 + 32 + w0) < 16u) ? p1[rr] + t1 : -1e30f;
      }
      SBAR();
    }
  } };

template <int SD, class Src, class Bias>
__device__ ATT_INLINE void attn_body(const bf16_t* __restrict__ Qb, const Src src, bf16_t* __restrict__ Ob, const int NT, char* lds, const Bias bias) {
  const int tid = opaque_tid(), wid = tid >> 6, lane = tid & 63, r32 = lane & 31, hi = lane >> 5;
  const int LDK = src.ldk;
  bf16_t* V_lds = (bf16_t*)lds; bf16_t* K_lds = (bf16_t*)(lds + 2 * SHM_V);
  float* ws = (float*)(lds + 2 * SHM_V + 2 * SHM_K) + wid * 64; float* li_l = ws; float* al_l = ws + 32;
  float m_reg = -1e30f, l_reg = 0; f32x16 o[4] = {};
  bf16_t* Q_lds = (bf16_t*)(lds + 2 * SHM_V + 2 * SHM_K + NW * 64 * 4);
  const int qrow = wid * QBLK + r32;
  {
#pragma unroll
    for (int i = 0; i < 8; ++i) { const int f = tid + 512 * i, row = f >> 4, c8 = (f & 15) * 8;
      *(bf16x8*)((char*)Q_lds + KSWZ(row, c8 * 2)) = *reinterpret_cast<const bf16x8*>(Qb + (long)row * LDQ + c8); }
  }
  const int sr = tid >> 4, sc = (tid & 15) * 8, vst0 = v_st(sr, sc), vst1 = v_st(32 + sr, sc);
  const int vb0 = (int)(uintptr_t)V_lds + v_rd_base(lane);
  struct { bf16x8 vs0, vs1, ks0, ks1; } sr_[SD];
#define SLOAD(i, jt) do { const bf16_t* kt_ = src.k(jt); const bf16_t* vt_ = src.v(jt); \
    sr_[i].vs0 = *reinterpret_cast<const bf16x8*>(&vt_[(long)sr * LDK + sc]); sr_[i].vs1 = *reinterpret_cast<const bf16x8*>(&vt_[(long)(32 + sr) * LDK + sc]); \
    sr_[i].ks0 = *reinterpret_cast<const bf16x8*>(&kt_[(long)sr * LDK + sc]); sr_[i].ks1 = *reinterpret_cast<const bf16x8*>(&kt_[(long)(32 + sr) * LDK + sc]); } while (0)
#define SWRITE(b, i) do { *(bf16x8*)((char*)V_lds + (b) * SHM_V + vst0) = sr_[i].vs0;          \
    *(bf16x8*)((char*)V_lds + (b) * SHM_V + vst1) = sr_[i].vs1; int kc = sc * 2;               \
    *(bf16x8*)((char*)K_lds + (b) * SHM_K + KSWZ(sr, kc)) = sr_[i].ks0;                       \
    *(bf16x8*)((char*)K_lds + (b) * SHM_K + KSWZ(32 + sr, kc)) = sr_[i].ks1; } while (0)
#define SWAIT() do { if constexpr (SD == 2) asm volatile("s_waitcnt vmcnt(4)" ::: "memory"); else asm volatile("s_waitcnt vmcnt(0)" ::: "memory"); } while (0)
#define RESC(a) do { if (__any((a) < 1.f)) { if (hi == 0) al_l[r32] = (a); asm volatile("s_waitcnt lgkmcnt(0)" ::: "memory"); \
    for (int d = 0; d < 4; ++d) for (int r = 0; r < 16; ++r) o[d][r] *= al_l[crow(r, hi)]; } } while (0)
  f32x16 pA0, pA1, pB0, pB1; float mnA, mnB, alA, alB; bf16x8 pa0, pa1, pa2, pa3;
  constexpr int SE = 0, SO = SD - 1;
  SLOAD(SE, 0); asm volatile("s_waitcnt vmcnt(0)" ::: "memory"); SWRITE(0, SE); __syncthreads();
  qkt(pA0, pA1, K_lds, Q_lds, qrow, r32, hi); bias(pA0, pA1, 0, wid, r32, hi); partialSM(pA0, pA1, m_reg, mnA, alA);
  SLOAD(SO, 1); if constexpr (SD == 2) { if (2 < NT) SLOAD(SE, 2); }
  SWAIT(); SWRITE(1, SO); __syncthreads();
  for (int j = 1; j + 1 < NT; j += 2) {
    SBAR(); qkt(pB0, pB1, (bf16_t*)((char*)K_lds + SHM_K), Q_lds, qrow, r32, hi); bias(pB0, pB1, j, wid, r32, hi);
    finishSM(pA0, pA1, alA, l_reg, pa0, pa1, pa2, pa3); SBAR();
    SLOAD(SO, j + SD); SBAR();
    pv_d0(o, vb0, pa0, pa1, pa2, pa3); partialSM(pB0, pB1, m_reg, mnB, alB);
    __syncthreads(); SWAIT(); SWRITE(0, SE);
    RESC(alB); __syncthreads();
    SBAR(); qkt(pA0, pA1, K_lds, Q_lds, qrow, r32, hi); bias(pA0, pA1, j + 1, wid, r32, hi);
    finishSM(pB0, pB1, alB, l_reg, pa0, pa1, pa2, pa3); SBAR();
    if (SD == 1 || j + 3 < NT) SLOAD(SE, j + 1 + SD); SBAR();
    pv_d0(o, vb0 + (int)SHM_V, pa0, pa1, pa2, pa3); partialSM(pA0, pA1, m_reg, mnA, alA);
    __syncthreads(); SWAIT(); SWRITE(1, SO);
    RESC(alA); __syncthreads();
  }
  SBAR(); qkt(pB0, pB1, (bf16_t*)((char*)K_lds + SHM_K), Q_lds, qrow, r32, hi); bias(pB0, pB1, NT - 1, wid, r32, hi);
  finishSM(pA0, pA1, alA, l_reg, pa0, pa1, pa2, pa3); SBAR();
  pv_d0(o, vb0, pa0, pa1, pa2, pa3); partialSM(pB0, pB1, m_reg, mnB, alB);
  __syncthreads(); RESC(alB);
  finishSM(pB0, pB1, alB, l_reg, pa0, pa1, pa2, pa3); SBAR();
  pv_d0(o, vb0 + (int)SHM_V, pa0, pa1, pa2, pa3);
  if (hi == 0) li_l[r32] = l_reg; asm volatile("s_waitcnt lgkmcnt(0)" ::: "memory");
  float rli[16];
#pragma unroll
  for (int r = 0; r < 16; ++r) rli[r] = __builtin_amdgcn_rcpf(li_l[crow(r, hi)]);
  bf16_t* Ow = Ob + (long)(wid * QBLK) * LDO;
#pragma unroll
  for (int r = 0; r < 16; ++r) { int orow = crow(r, hi);
    for (int d0 = 0; d0 < 4; ++d0) Ow[(long)orow * LDO + d0 * 32 + r32] = f2bf(o[d0][r] * rli[r]); }
#undef SLOAD
#undef SWRITE
#undef SWAIT
#undef RESC
}
}
#define H16(w, j) ((bf16_t)(((j) & 1) ? ((j) < 2 ? (w).x >> 16 : (w).y >> 16) : ((j) < 2 ? (w).x & 0xFFFFu : (w).y & 0xFFFFu)))
#define DPPU(v, ctrl, rmask) __int_as_float(__builtin_amdgcn_update_dpp(0, __float_as_int(v), (ctrl), (rmask), 0xF, false))
__device__ __forceinline__ float scan32(float x) { x += DPPU(x, 0x111, 0xF); x += DPPU(x, 0x112, 0xF); x += DPPU(x, 0x114, 0xF); x += DPPU(x, 0x118, 0xF); x += DPPU(x, 0x142, 0xA); return x; }
__device__ __forceinline__ float last32(float x, int lane) { const float a = __int_as_float(__builtin_amdgcn_readlane(__float_as_int(x), 31)), b = __int_as_float(__builtin_amdgcn_readlane(__float_as_int(x), 63)); return lane < 32 ? a : b; }
namespace gdn {
using att::bf16x8; using att::f32x16; using att::crow;
constexpr int C = 32, SK = 136, SS = 40;
constexpr int OFF_KT = 0, OFF_QT = OFF_KT + C * SK * 2, OFF_W = OFF_QT + C * SK * 2, OFF_KTT = OFF_W + C * SK * 2, OFF_VTT = OFF_KTT + 128 * SS * 2,
              OFF_VN = OFF_VTT + 128 * SS * 2, OFF_VNS = OFF_VN + 128 * SS * 2, OFF_ST = OFF_VNS + 128 * SS * 2, OFF_TB = OFF_ST + 128 * SK * 2,
              OFF_TBE = OFF_TB + C * SS * 2, OFF_ATT = OFF_TBE + C * SS * 2, OFF_L = OFF_ATT + C * SS * 2, OFF_SC = OFF_L + C * C * 4, GDN_LDS = OFF_SC + 1024;
template <int K>
__device__ __forceinline__ f32x16 mm(const bf16_t* A, int lda, const bf16_t* Bt, int ldb, int l32, int hi, f32x16 acc) {
#pragma unroll
    for (int k0 = 0; k0 < K; k0 += 16) {
        const bf16x8 a = *reinterpret_cast<const bf16x8*>(A + l32 * lda + k0 + 8 * hi);
        const bf16x8 b = *reinterpret_cast<const bf16x8*>(Bt + l32 * ldb + k0 + 8 * hi);
        acc = __builtin_amdgcn_mfma_f32_32x32x16_bf16(a, b, acc, 0, 0, 0);
    }
    return acc;
}
__device__ __forceinline__ uint2 pk4(float a, float b, float c, float d) { uint2 w; w.x = pack2(a, b); w.y = pack2(c, d); return w; }

__device__ __forceinline__ void gdn_chunked(const Params& p, int l, bool ctx, int b, int h, int dir, unsigned char* lds) {
    const int tid = opaque_tid(), wid = tid >> 6, lane = tid & 63, l32 = lane & 31, hi = lane >> 5;
    const int T = ctx ? CT : ::LT; const size_t m0 = ctx ? (size_t)b * CT : (size_t)MC + (size_t)b * ::LT;
    const bf16_t* DQ = WSP(bf16_t, WS_DQ); const bf16_t* DK = WSP(bf16_t, WS_DK); const bf16_t* DV = WSP(bf16_t, WS_DV); const float* DBA = WSP(float, WS_DBA);
    float* O = WSP(float, dir ? WS_DOB : WS_DOF);
    bf16_t* Kt = (bf16_t*)(lds + OFF_KT); bf16_t* Qt = (bf16_t*)(lds + OFF_QT); bf16_t* W = (bf16_t*)(lds + OFF_W); bf16_t* KT = (bf16_t*)(lds + OFF_KTT); bf16_t* VT = (bf16_t*)(lds + OFF_VTT);
    bf16_t* VN = (bf16_t*)(lds + OFF_VN); bf16_t* VNS = (bf16_t*)(lds + OFF_VNS); bf16_t* ST = (bf16_t*)(lds + OFF_ST); bf16_t* TB = (bf16_t*)(lds + OFF_TB); bf16_t* TBE = (bf16_t*)(lds + OFF_TBE);
    bf16_t* ATT = (bf16_t*)(lds + OFF_ATT); float* Lm = (float*)(lds + OFF_L); float* sc = (float*)(lds + OFF_SC);
    const int nch = T / C;
#define TOK(c, s_) (m0 + (dir ? T - 1 - ((c) * C + (s_)) : (c) * C + (s_)))
    f32x16 S[2];
#pragma unroll
    for (int bi = 0; bi < 2; ++bi) {
        const int blk = wid * 2 + bi, d0 = 32 * (blk >> 2), e0 = 32 * (blk & 3);
        if (ctx) { S[bi] = f32x16{}; }
        else {
            const float* s0 = p.in[I_SGDN] + ((((size_t)b * DEPTH + l) * 2 + dir) * 4 + h) * 128 * 128 + e0 + l32;
#pragma unroll
            for (int r = 0; r < 16; ++r) S[bi][r] = s0[(size_t)(d0 + crow(r, hi)) * 128];
        }
    }
    const int ts = tid & 31, c0 = (tid >> 5) * 4, c1 = 64 + c0;
    uint2 rq0, rq1, rk0, rk1, rv0, rv1; float pbeta = 0.f, pg = 0.f;
#define GLOAD(c) do { const size_t mt_ = TOK(c, ts); \
        rq0 = *(const uint2*)(DQ + mt_ * 512 + h * 128 + c0); rq1 = *(const uint2*)(DQ + mt_ * 512 + h * 128 + c1); \
        rk0 = *(const uint2*)(DK + mt_ * 512 + h * 128 + c0); rk1 = *(const uint2*)(DK + mt_ * 512 + h * 128 + c1); \
        rv0 = *(const uint2*)(DV + mt_ * 512 + h * 128 + c0); rv1 = *(const uint2*)(DV + mt_ * 512 + h * 128 + c1); \
        if (tid < C) { const size_t mt = TOK(c, tid); pbeta = DBA[mt * 16 + dir * 4 + h]; pg = DBA[mt * 16 + 8 + dir * 4 + h]; } } while (0)
#define GSTAGE() do { \
        *(uint2*)(Kt + ts * SK + c0) = rk0; *(uint2*)(Kt + ts * SK + c1) = rk1; \
        *(uint2*)(Qt + ts * SK + c0) = rq0; *(uint2*)(Qt + ts * SK + c1) = rq1; \
        _Pragma("unroll") for (int j = 0; j < 4; ++j) { KT[(c0 + j) * SS + ts] = H16(rk0, j); KT[(c1 + j) * SS + ts] = H16(rk1, j); \
                                                        VT[(c0 + j) * SS + ts] = H16(rv0, j); VT[(c1 + j) * SS + ts] = H16(rv1, j); } \
        if (wid == 0) { float x = pg; _Pragma("unroll") for (int o_ = 1; o_ < 32; o_ <<= 1) { const float y = __shfl_up(x, o_); if (lane >= o_) x += y; } \
            const float Bt_ = __shfl(x, 31); if (lane < C) { sc[lane] = pbeta; sc[32 + lane] = x; sc[64 + lane] = __expf(x); sc[96 + lane] = __expf(Bt_ - x); if (lane == 0) sc[128] = __expf(Bt_); } } } while (0)
    __syncthreads();
    GLOAD(0);
#pragma unroll
    for (int bi = 0; bi < 2; ++bi) {
        const int blk = wid * 2 + bi, d0 = 32 * (blk >> 2), e0 = 32 * (blk & 3);
#pragma unroll
        for (int g = 0; g < 4; ++g) *(uint2*)(ST + (e0 + l32) * SK + d0 + 8 * g + 4 * hi) = pk4(S[bi][4 * g], S[bi][4 * g + 1], S[bi][4 * g + 2], S[bi][4 * g + 3]);
    }
    GSTAGE();
    __syncthreads();
    for (int c = 0; c < nch; ++c) {
        if (c + 1 < nch) GLOAD(c + 1);
        f32x16 acc1 = f32x16{};
        if (wid == 0) {
            const f32x16 kk = mm<128>(Kt, SK, Kt, SK, l32, hi, f32x16{});
            const float bi_ = sc[32 + l32], be = sc[l32];
#pragma unroll
            for (int r = 0; r < 16; ++r) { const int j = crow(r, hi); const float v = (l32 > j) ? be * kk[r] * __expf(bi_ - sc[32 + j]) : 0.f;
                Lm[l32 * 32 + ((((r & 3) + 4 * hi) ^ (l32 & 7)) * 4) + (r >> 2)] = v; }
        } else if (wid == 1) {
            const f32x16 kq = mm<128>(Kt, SK, Qt, SK, l32, hi, f32x16{});
            const float bi_ = sc[32 + l32];
            float a[16];
#pragma unroll
            for (int r = 0; r < 16; ++r) { const int j = crow(r, hi); a[r] = (l32 >= j) ? kq[r] * __expf(bi_ - sc[32 + j]) : 0.f; }
#pragma unroll
            for (int g = 0; g < 4; ++g) *(uint2*)(ATT + l32 * SS + 8 * g + 4 * hi) = pk4(a[4 * g], a[4 * g + 1], a[4 * g + 2], a[4 * g + 3]);
        } else if (wid >= 4) {
            acc1 = mm<128>(Qt, SK, ST + (32 * (wid - 4)) * SK, SK, l32, hi, f32x16{});
#pragma unroll
            for (int r = 0; r < 16; ++r) acc1[r] *= sc[64 + crow(r, hi)];
        }
        __syncthreads();
        if (tid < 256) {
            const int cc = tid >> 3, part = tid & 7;
            float Tr[4] = {0.f, 0.f, 0.f, 0.f};
#pragma unroll
            for (int i = 0; i < 32; ++i) {
                const vf4 lv = *(const vf4*)(Lm + i * 32 + ((part ^ (i & 7)) * 4));
                float s = lv.x * Tr[0] + lv.y * Tr[1] + lv.z * Tr[2] + lv.w * Tr[3];
                s = red8(s);
                const float t = (i == cc ? 1.f : 0.f) - s;
                if (part == (i & 7)) Tr[i >> 3] = t;
            }
            const float bc = sc[cc], bec = bc * sc[64 + cc];
#pragma unroll
            for (int jj = 0; jj < 4; ++jj) { TB[(part + 8 * jj) * SS + cc] = f2bf(Tr[jj] * bc); TBE[(part + 8 * jj) * SS + cc] = f2bf(Tr[jj] * bec); }
        }
        __syncthreads();
        if (wid < 4) {
            acc1 = mm<32>(TB, SS, VT + (32 * wid) * SS, SS, l32, hi, f32x16{});
        } else {
            const int d0 = 32 * (wid - 4);
            const f32x16 wt = mm<32>(KT + d0 * SS, SS, TBE, SS, l32, hi, f32x16{});
#pragma unroll
            for (int g = 0; g < 4; ++g) *(uint2*)(W + l32 * SK + d0 + 8 * g + 4 * hi) = pk4(wt[4 * g], wt[4 * g + 1], wt[4 * g + 2], wt[4 * g + 3]);
        }
        __syncthreads();
        if (wid < 4) {
            const int e0 = 32 * wid;
            const f32x16 ws = mm<128>(W, SK, ST + e0 * SK, SK, l32, hi, f32x16{});
            float vn[16], vs[16];
#pragma unroll
            for (int r = 0; r < 16; ++r) { vn[r] = acc1[r] - ws[r]; vs[r] = vn[r] * sc[96 + crow(r, hi)]; }
#pragma unroll
            for (int g = 0; g < 4; ++g) { *(uint2*)(VN + (e0 + l32) * SS + 8 * g + 4 * hi) = pk4(vn[4 * g], vn[4 * g + 1], vn[4 * g + 2], vn[4 * g + 3]);
                                          *(uint2*)(VNS + (e0 + l32) * SS + 8 * g + 4 * hi) = pk4(vs[4 * g], vs[4 * g + 1], vs[4 * g + 2], vs[4 * g + 3]); }
        }
        __syncthreads();
        if (wid >= 4) {
            const int e0 = 32 * (wid - 4);
            acc1 = mm<32>(ATT, SS, VN + e0 * SS, SS, l32, hi, acc1);
#pragma unroll
            for (int r = 0; r < 16; ++r) O[TOK(c, crow(r, hi)) * 512 + h * 128 + e0 + l32] = acc1[r];
        }
        {
            const float eB = sc[128];
#pragma unroll
            for (int bi = 0; bi < 2; ++bi) {
                const int blk = wid * 2 + bi, d0 = 32 * (blk >> 2), e0 = 32 * (blk & 3);
#pragma unroll
                for (int r = 0; r < 16; ++r) S[bi][r] *= eB;
                S[bi] = mm<32>(KT + d0 * SS, SS, VNS + e0 * SS, SS, l32, hi, S[bi]);
            }
        }
        __syncthreads();
#pragma unroll
        for (int bi = 0; bi < 2; ++bi) {
            const int blk = wid * 2 + bi, d0 = 32 * (blk >> 2), e0 = 32 * (blk & 3);
#pragma unroll
            for (int g = 0; g < 4; ++g) *(uint2*)(ST + (e0 + l32) * SK + d0 + 8 * g + 4 * hi) = pk4(S[bi][4 * g], S[bi][4 * g + 1], S[bi][4 * g + 2], S[bi][4 * g + 3]);
        }
        if (c + 1 < nch) GSTAGE();
        __syncthreads();
    }
#undef GLOAD
#undef GSTAGE
#undef TOK
    if (ctx) {
#pragma unroll
        for (int bi = 0; bi < 2; ++bi) {
            const int blk = wid * 2 + bi, d0 = 32 * (blk >> 2), e0 = 32 * (blk & 3);
            float* so = p.out + O_SGDN + ((((size_t)b * DEPTH + l) * 2 + dir) * 4 + h) * 128 * 128 + e0 + l32;
#pragma unroll
            for (int r = 0; r < 16; ++r) so[(size_t)(d0 + crow(r, hi)) * 128] = S[bi][r];
        }
    }
}
}

namespace gla {
using att::bf16x8; using att::f32x16; using att::crow; using gdn::mm; using gdn::pk4;
constexpr int C = 32, SQ = 72, SS = 40;
constexpr int OFF_QE = 0, OFF_KN = OFF_QE + C * SQ * 2, OFF_KET = OFF_KN + C * SQ * 2, OFF_VT = OFF_KET + 64 * SS * 2, OFF_ATT = OFF_VT + 128 * SS * 2, OFF_ST = OFF_ATT + C * SS * 2,
              OFF_LA = OFF_ST + 128 * SQ * 2, OFF_EB = OFF_LA + C * 64 * 4, GLA_LDS = OFF_EB + 256;
__device__ __forceinline__ void gla_chunked(const Params& p, int l, bool ctx, int b, int h, int dir, unsigned char* lds) {
    const int tid = opaque_tid(), wid = tid >> 6, lane = tid & 63, l32 = lane & 31, hi = lane >> 5;
    const int T = ctx ? CT : ::LT; const size_t m0 = ctx ? (size_t)b * CT : (size_t)MC + (size_t)b * ::LT;
    const bf16_t* Z = WSP(bf16_t, WS_Z); const float* LA = WSP(float, dir ? WS_AB : WS_AF);
    float* O = WSP(float, dir ? WS_GOB : WS_GOF);
    bf16_t* Qe = (bf16_t*)(lds + OFF_QE); bf16_t* Kn = (bf16_t*)(lds + OFF_KN); bf16_t* KeT = (bf16_t*)(lds + OFF_KET); bf16_t* VT = (bf16_t*)(lds + OFF_VT);
    bf16_t* ATT = (bf16_t*)(lds + OFF_ATT); bf16_t* ST = (bf16_t*)(lds + OFF_ST); float* eB = (float*)(lds + OFF_EB);
    const int nch = T / C;
#define TOK(c, s_) (m0 + (dir ? T - 1 - ((c) * C + (s_)) : (c) * C + (s_)))
    const int d0 = 32 * (wid >> 2), e0 = 32 * (wid & 3);
    f32x16 S;
    if (ctx) S = f32x16{};
    else {
        const float* s0 = p.in[I_SGLA] + ((((size_t)b * DEPTH + l) * 2 + dir) * 4 + h) * 64 * 128 + e0 + l32;
#pragma unroll
        for (int r = 0; r < 16; ++r) S[r] = s0[(size_t)(d0 + crow(r, hi)) * 128];
    }
    const int ts = tid & 31, dc = (tid >> 5) * 4, vc0 = dc, vc1 = 64 + dc;
    uint2 rq, rk, rv0, rv1; vf4 pl;
#define GLOAD(c) do { const size_t mt = TOK(c, ts); \
        rq = *(const uint2*)(Z + mt * NINP + Z_GLQ + h * 64 + dc); rk = *(const uint2*)(Z + mt * NINP + Z_GLK + h * 64 + dc); pl = *(const vf4*)(LA + mt * 256 + h * 64 + dc); \
        rv0 = *(const uint2*)(Z + mt * NINP + Z_GLV + h * 128 + vc0); rv1 = *(const uint2*)(Z + mt * NINP + Z_GLV + h * 128 + vc1); } while (0)
#define WRITE_ST() do { _Pragma("unroll") for (int g = 0; g < 4; ++g) *(uint2*)(ST + (e0 + l32) * SQ + d0 + 8 * g + 4 * hi) = pk4(S[4 * g], S[4 * g + 1], S[4 * g + 2], S[4 * g + 3]); } while (0)
#define GIMAGES() do { vf4 pre, tot; const vf4 pq = unp4bf(rq), pk = unp4bf(rk); \
        _Pragma("unroll") for (int j = 0; j < 4; ++j) { pre[j] = scan32(pl[j]); tot[j] = last32(pre[j], lane); } \
        float qe[4], kn[4]; \
        _Pragma("unroll") for (int j = 0; j < 4; ++j) { qe[j] = pq[j] * 0.125f * __expf(pre[j]); kn[j] = pk[j] * __expf(fminf(-pre[j], 80.f)); \
            KeT[(dc + j) * SS + ts] = f2bf(pk[j] * __expf(tot[j] - pre[j])); } \
        *(uint2*)(Qe + ts * SQ + dc) = pk4(qe[0], qe[1], qe[2], qe[3]); *(uint2*)(Kn + ts * SQ + dc) = pk4(kn[0], kn[1], kn[2], kn[3]); \
        if (ts == 0) { _Pragma("unroll") for (int j = 0; j < 4; ++j) eB[dc + j] = __expf(tot[j]); } \
        _Pragma("unroll") for (int j = 0; j < 4; ++j) { VT[(vc0 + j) * SS + ts] = H16(rv0, j); VT[(vc1 + j) * SS + ts] = H16(rv1, j); } } while (0)
    __syncthreads();
    GLOAD(0);
    WRITE_ST();
    GIMAGES();
    __syncthreads();
    for (int c = 0; c < nch; ++c) {
        if (c + 1 < nch) GLOAD(c + 1);
        f32x16 o1 = f32x16{};
        if (wid == 0) {
            const f32x16 kq = mm<64>(Kn, SQ, Qe, SQ, l32, hi, f32x16{});
            float a[16];
#pragma unroll
            for (int r = 0; r < 16; ++r) a[r] = (l32 >= crow(r, hi)) ? kq[r] : 0.f;
#pragma unroll
            for (int g = 0; g < 4; ++g) *(uint2*)(ATT + l32 * SS + 8 * g + 4 * hi) = pk4(a[4 * g], a[4 * g + 1], a[4 * g + 2], a[4 * g + 3]);
        } else if (wid >= 4) {
            o1 = mm<64>(Qe, SQ, ST + (32 * (wid - 4)) * SQ, SQ, l32, hi, f32x16{});
        }
        __syncthreads();
        if (wid >= 4) {
            const int eo = 32 * (wid - 4);
            o1 = mm<32>(ATT, SS, VT + eo * SS, SS, l32, hi, o1);
#pragma unroll
            for (int r = 0; r < 16; ++r) O[TOK(c, crow(r, hi)) * 512 + h * 128 + eo + l32] = o1[r];
        }
#pragma unroll
        for (int r = 0; r < 16; ++r) S[r] *= eB[d0 + crow(r, hi)];
        S = mm<32>(KeT + d0 * SS, SS, VT + e0 * SS, SS, l32, hi, S);
        __syncthreads();
        WRITE_ST();
        if (c + 1 < nch) GIMAGES();
#ifdef GLA_DUP_IMAGES
        __syncthreads(); if (c + 1 < nch) GIMAGES();
#endif
        __syncthreads();
    }
#undef GLOAD
#undef WRITE_ST
#undef GIMAGES
#undef TOK
    if (ctx) {
        float* so = p.out + O_SGLA + ((((size_t)b * DEPTH + l) * 2 + dir) * 4 + h) * 64 * 128 + e0 + l32;
#pragma unroll
        for (int r = 0; r < 16; ++r) so[(size_t)(d0 + crow(r, hi)) * 128] = S[r];
    }
}
}
#define LAS __attribute__((address_space(3)))
constexpr int LDS_BYTES = 147456, XBW_OFF = LDS_BYTES - 64;
constexpr int NPH = 1 + DEPTH * 12;
#ifndef DBG_NLAYERS
#define DBG_NLAYERS DEPTH
#endif

#ifndef DUPKIND
#define DUPKIND 0
#endif
__device__ __forceinline__ int opaque_int(int v) { asm volatile("" : "+s"(v)); return v; }
#ifndef MIXMASK
#define MIXMASK 0xFF
#endif
#define FOR_ITEMS(it, n, o, w) for (int bo_ = (o) * (int)gridDim.x / 256, bw_ = ((w) * (int)gridDim.x / 256) > 0 ? ((w) * (int)gridDim.x / 256) : 1, \
                                    it = ((int)blockIdx.x >= bo_ && (int)blockIdx.x < bo_ + bw_) ? (int)blockIdx.x - bo_ : (n); it < (n); it += bw_)

constexpr int TF0 = NT_L / 10, TF1 = NT_L / 4, TF2 = NT_L * 53 / 100, TF3 = NT_L * 88 / 100, MIXCONV_CH = 16, NI_CONV = (TF3 - TF2 + MIXCONV_CH - 1) / MIXCONV_CH;
#ifndef SPLITK
#define SPLITK 0
#endif
#ifndef SPLITK_G4
#define SPLITK_G4 0
#endif
constexpr int FLAG_WORD0 = 8192;
constexpr int QCTR_WORD0 = 1024;
constexpr int NI_GDNL = LB * 8, NI_GLAL = LB * 8, NI_GDNC = CB * 8, NI_GQAL = LB * 16, NI_NAL = LB * 16, NI_GLAC = CB * 8, NI_NAC = CB * 4, NI_GQAC = CB * 4;
#define KM(k) (1 + ((DUPKIND >> (k)) & 1))
constexpr int Q0 = NI_GDNL * KM(0), Q1 = Q0 + NI_GQAL * KM(1), Q2 = Q1 + NI_NAL * KM(2), Q3 = Q2 + NI_GLAL * KM(3), Q4 = Q3 + NI_GDNC * KM(4), Q5 = Q4 + NI_NAC * KM(5), Q6 = Q5 + NI_GQAC * KM(6), Q7 = Q6 + NI_GLAC * KM(7);
__device__ __forceinline__ void phase_mix(const Params& p, int l, unsigned char* lds, int rep) {
    const int tid = opaque_tid();
    float* smem = (float*)lds;
    const bf16_t* NAQ = WSP(bf16_t, WS_NAQ); const bf16_t* NAK = WSP(bf16_t, WS_NAK); const bf16_t* NAV = WSP(bf16_t, WS_NAV);
    const bf16_t* GQ = WSP(bf16_t, WS_GQ); const bf16_t* GK = WSP(bf16_t, WS_GK); const bf16_t* GV = WSP(bf16_t, WS_GV);
    bf16_t* MRG = WSP(bf16_t, WS_MRG);
    unsigned* qctr = WSP(unsigned, WS_CTL) + QCTR_WORD0 + 64 * l + 16 * rep;
    volatile int* qslot = (volatile int*)(lds + XBW_OFF + 16);
    for (;;) {
        __syncthreads();
        if (tid == 0) *qslot = (int)__hip_atomic_fetch_add(qctr, 1u, __ATOMIC_RELAXED, __HIP_MEMORY_SCOPE_AGENT);
        __syncthreads();
        const int q = __builtin_amdgcn_readfirstlane(*qslot);
        if (q >= Q7 + ((CONV_FILLER && l + 1 < DBG_NLAYERS) ? NI_CONV : 0)) break;
        if (q < Q0) { const int it = q % NI_GDNL; gdn::gdn_chunked(p, l, false, it / 8, (it / 2) % 4, it % 2, lds); }
        else if (q < Q1) {
            const int it = (q - Q0) % NI_GQAL, b = it / 16, qh = (it / 4) % 4, qb = it % 4, kvh = qh >> 1;
            const size_t r0 = (size_t)MC + (size_t)b * LT;
            att::SrcTwo src{WSP(bf16_t, WS_CGK) + ((size_t)b * DEPTH + l) * 256 * 256 + kvh * 128, WSP(bf16_t, WS_CGV) + ((size_t)b * DEPTH + l) * 256 * 256 + kvh * 128,
                            GK + r0 * 256 + kvh * 128, GV + r0 * 256 + kvh * 128, 256};
            att::attn_body<2>(GQ + (r0 + qb * 256) * 512 + qh * 128, src, MRG + (r0 + qb * 256) * DM + 1024 + qh * 128, 4 + LT / 64, (char*)lds, att::NoBias{});
        }
        else if (q < Q2) {
            const int it = (q - Q1) % NI_NAL, b = it / 16, h = (it / 4) % 4, qb = it % 4;
            const int kr0 = qb == 0 ? 0 : qb == 1 ? 0 : qb == 2 ? 4 : 8, nrows = (qb == 0 || qb == 3) ? 8 : 12;
            const size_t r0 = (size_t)MC + (size_t)b * LT;
            float* tab = (float*)(lds + att::SHM_ATTN);
            if (tid < 15 * 31) tab[tid] = p.in[I_RPB][((size_t)l * 4 + h) * 15 * 31 + tid] * (1.0f / att::SCALE);
            att::SrcTwo src{WSP(bf16_t, WS_CNAK) + ((size_t)b * DEPTH + l) * 256 * 512 + h * 128, WSP(bf16_t, WS_CNAV) + ((size_t)b * DEPTH + l) * 256 * 512 + h * 128,
                            NAK + (r0 + kr0 * 64) * 512 + h * 128, NAV + (r0 + kr0 * 64) * 512 + h * 128, 512};
            att::attn_body<1>(NAQ + (r0 + qb * 256) * 512 + h * 128, src, MRG + (r0 + qb * 256) * DM + 0 + h * 128, 4 + nrows, (char*)lds, att::NaBias{tab, qb * 256, kr0});
        }
        else if (q < Q3) { const int it = (q - Q2) % NI_GLAL;
#ifdef GLA_REP
            for (int r_ = 0, n_ = opaque_int(GLA_REP); r_ < n_; ++r_)
#endif
            gla::gla_chunked(p, l, false, it / 8, (it / 2) % 4, it % 2, lds); }
        else if (q < Q4) { const int it = (q - Q3) % NI_GDNC; gdn::gdn_chunked(p, l, true, it / 8, (it / 2) % 4, it % 2, lds); }
        else if (q < Q5) {
            const int it = (q - Q4) % NI_NAC, b = it / 4, h = it % 4; const size_t r0 = (size_t)b * CT;
            att::SrcOne src{NAK + r0 * 512 + h * 128, NAV + r0 * 512 + h * 128, 512};
            att::attn_body<2>(NAQ + r0 * 512 + h * 128, src, MRG + r0 * DM + 0 + h * 128, CT / 64, (char*)lds, att::NoBias{});
        }
        else if (q < Q6) {
            const int it = (q - Q5) % NI_GQAC, b = it / 4, qh = it % 4, kvh = qh >> 1; const size_t r0 = (size_t)b * CT;
            att::SrcOne src{GK + r0 * 256 + kvh * 128, GV + r0 * 256 + kvh * 128, 256};
            att::attn_body<2>(GQ + r0 * 512 + qh * 128, src, MRG + r0 * DM + 1024 + qh * 128, CT / 64, (char*)lds, att::NoBias{});
        }
        else if (q < Q7) { const int it = (q - Q6) % NI_GLAC; gla::gla_chunked(p, l, true, it / 8, (it / 2) % 4, it % 2, lds); }
        else { const int t0 = TF2 + (q - Q7) * MIXCONV_CH, t1 = t0 + MIXCONV_CH < TF3 ? t0 + MIXCONV_CH : TF3; conv_layer_tiles(p, l + 1, t0, t1, 0, 1, (float*)lds); }
    }
}

#define CONV_FILL(nunits, t0, t1, skip) do { if (l + 1 < DBG_NLAYERS) { const int G_ = (int)gridDim.x; int f0_ = ((nunits) % G_) + (skip); if (f0_ >= G_) f0_ = 0; \
        if ((int)blockIdx.x >= f0_) { const Params q = opaque_params(p); conv_layer_tiles(q, l + 1, (t0), (t1), (int)blockIdx.x - f0_, G_ - f0_, (float*)lds); } } } while (0)
#define G1A_MSPLIT (G1A_MODE == 1 ? 2 : 0)
#define G1B_MSPLIT (G1B_MODE == 1 ? 2 : 0)
#ifndef MSPLIT
#define MSPLIT 2
#endif
static_assert(att::SHM_ATTN + 15 * 31 * 4 + 2048 <= (size_t)XBW_OFF, "LDS map");
static_assert((QCTR_WORD0 + 64 * DEPTH) < 4096, "ctl");
constexpr int BAR_WORD0 = 4096;
static_assert((BAR_WORD0 + XCD_BAR_WORDS) * 4 <= (int)CTL_BYTES, "ctl");

__global__ void __launch_bounds__(512, 2) fwd(Params p) {
    extern __shared__ __attribute__((aligned(16))) unsigned char lds[];
    const int tid = threadIdx.x;
    volatile LAS unsigned* xbw = (volatile LAS unsigned*)((LAS unsigned char*)lds + XBW_OFF);
    if (tid < 4) xbw[tid] = 0u;
    __syncthreads();
    XcdBarrier bar; bar.bar = WSP(unsigned, WS_CTL) + BAR_WORD0; bar.x = 0; bar.st = xbw;
    if (p.ph_hi - p.ph_lo > 1) bar = xcd_barrier_post(WSP(unsigned, WS_CTL) + BAR_WORD0, xbw);
#ifndef PHMASK
#define PHMASK 0x1FFF
#endif
#define IN(k) (p.ph_lo <= (k) && (k) < p.ph_hi)
#define INL(j) (((PHMASK >> ((j) + 1)) & 1) && IN(pb + (j)))
#ifndef DUPMASK
#define DUPMASK 0
#endif
#define DUP(j) ((DUPMASK >> ((j) + 1)) & 1)
#if DUPMASK
#define REPS(j) opaque_int(1 + DUP(j))
#else
#define REPS(j) 1
#endif
#ifndef DBLBAR
#define DBLBAR 0
#endif
#ifdef DIAG_KIND
#ifndef DIAG_SCALE
#define DIAG_SCALE 0.01f
#endif
    unsigned long long dg_sum = 0ull, dg_prev = wall_clock64();
#define DIAG_AT(k) do { const unsigned long long now_ = wall_clock64(); if ((DIAG_KIND >> (((k) == 0) ? 12 : (((k) - 1) % 12))) & 1) dg_sum += now_ - dg_prev; dg_prev = now_; } while (0)
#else
#define DIAG_AT(k) do { } while (0)
#endif
#define SEAM(k) do { if (IN(k) && IN((k) + 1)) { xcd_barrier(bar); if (DBLBAR) xcd_barrier(bar); } DIAG_AT(k); } while (0)
    LAS unsigned char* ldsl = (LAS unsigned char*)lds;
    bf16_t* H = WSP(bf16_t, WS_H); bf16_t* ACT = WSP(bf16_t, WS_ACT); float* X = WSP(float, WS_X); float* Z = WSP(float, WS_Z); bf16_t* MRG = WSP(bf16_t, WS_MRG);

    if ((PHMASK & 1) && IN(0)) { const int reps_ = (DUPMASK & 1) ? opaque_int(2) : 1; for (int rep_ = 0; rep_ < reps_; ++rep_) { const Params q = opaque_params(p); phase_prologue(q, (float*)lds); __syncthreads(); } }
    SEAM(0);
    for (int l = 0; l < DBG_NLAYERS; ++l) {
        const int pb = 1 + l * 12;
        const float* modl = WSP(float, WS_MODV) + (size_t)l * NCOND * NMOD;
        if (INL(0)) { const int reps_ = REPS(0); for (int rep_ = 0; rep_ < reps_; ++rep_) { const Params q = opaque_params(p); phase_norm(q, l, 0); __syncthreads(); } }
        SEAM(pb + 0);
        if (INL(1)) {
            if (g1_fp8(l, 0)) {
                pg8::Gemm g{H, (const bf16_t*)(WSP(unsigned char, WS_WGU) + ((size_t)l * 2 + 0) * NGU * DM * 2), M, NGU, DM / 2}; pg8::StaticOrder S; S.init(M, NGU, DM / 2, (int)gridDim.x, (int)blockIdx.x, 2);
                pg8::EpiSwiGLU8 E{WSP(unsigned char, WS_ACT), FFP, 1.0f / WGU_SCALE};
                for (int r_ = 0, n_ = REPS(1); r_ < n_; ++r_) pg8::gemm_phase<pg8::EpiSwiGLU8, pg8::StaticOrder, false, 1>(ldsl, g, S, E, nullptr);
            } else {
                pg8::Gemm g{H, WSP(bf16_t, WS_WGU) + ((size_t)l * 2 + 0) * NGU * DM, M, NGU, DM}; pg8::StaticOrder S; S.init(M, NGU, DM, (int)gridDim.x, (int)blockIdx.x, 0);
                pg8::EpiSwiGLU8 E{WSP(unsigned char, WS_ACT), FFP, 1.0f};
                for (int r_ = 0, n_ = REPS(1); r_ < n_; ++r_) pg8::gemm_phase<pg8::EpiSwiGLU8, pg8::StaticOrder, false, 0>(ldsl, g, S, E, nullptr);
            }
#if CONV_FILLER
            if (l + 1 < DBG_NLAYERS) {
                const int nw_ = (M / 256) * (NGU / 256), G_ = (int)gridDim.x; int f0_ = nw_ % G_; if (nw_ < G_) f0_ = 0;
                if (g1_fp8(l, 0)) f0_ = 2 * f0_ < G_ ? 2 * f0_ : f0_;
                const int nmb_ = (G_ - f0_ < NMOD / 128) ? (G_ - f0_) : NMOD / 128;
                if ((int)blockIdx.x >= f0_ && (int)blockIdx.x < f0_ + nmb_) { const Params q = opaque_params(p); mod_layer(q, l + 1, (int)blockIdx.x - f0_, nmb_, (float*)lds); }
            }
            CONV_FILL((M / 256) * (NGU / 256), 0, TF0, NMOD / 128 + (g1_fp8(l, 0) ? ((M / 256) * (NGU / 256)) % (int)gridDim.x : 0));
#endif
        }
        SEAM(pb + 1);
        if (INL(2)) {
            pg8::Gemm g{ACT, G2_FP8 ? (const bf16_t*)(WSP(unsigned char, WS_WDN) + ((size_t)l * 2 + 0) * DM * FFP) : WSP(bf16_t, WS_WDN) + ((size_t)l * 2 + 0) * DM * FF, M, DM, G2_FP8 ? FFP / 2 : FF}; pg8::StaticOrder S; S.init(M, DM, G2_FP8 ? FFP / 2 : FF, (int)gridDim.x, (int)blockIdx.x, SPLITK ? 1 : MSPLIT);
            pg8::EpiResid E{l == 0 ? p.in[I_XP] : X, X, DM, modl + 2 * DM, G2_FP8 ? 0.5f / WDN_SCALE : 0.5f, Z, WSP(unsigned, WS_CTL) + FLAG_WORD0, 8u * (unsigned)(l * (2 * SPLITK + SPLITK_G4) + SPLITK), l == 0 ? p.in[I_XS] : X, l == 0 ? MC : 0x7FFFFFFF, (XBF16 && l != 0), XBF16};
            pg8::gemm_phase<pg8::EpiResid, pg8::StaticOrder, false, (G2_FP8 ? 1 : 0)>(ldsl, g, S, E, nullptr);
#if DUPMASK
            if (opaque_int(DUP(2))) { pg8::EpiResid E2{l == 0 ? p.in[I_XP] : X, Z, DM, modl + 2 * DM, G2_FP8 ? 0.5f / WDN_SCALE : 0.5f, Z, WSP(unsigned, WS_CTL) + FLAG_WORD0, 0u, l == 0 ? p.in[I_XS] : X, l == 0 ? MC : 0x7FFFFFFF, 0, 0}; pg8::gemm_phase<pg8::EpiResid, pg8::StaticOrder, false, (G2_FP8 ? 1 : 0)>(ldsl, g, S, E2, nullptr); }
#endif
        }
        SEAM(pb + 2);
        if (INL(3)) { const int reps_ = REPS(3); for (int rep_ = 0; rep_ < reps_; ++rep_) { const Params q = opaque_params(p); phase_norm(q, l, 1); __syncthreads(); } }
        SEAM(pb + 3);
        if (INL(4)) {
            pg8::Gemm g{H, WSP(bf16_t, WS_WIN) + (size_t)l * NINP * DM, M, NINP, DM}; pg8::StaticOrder S; S.init(M, NINP, DM, (int)gridDim.x, (int)blockIdx.x);
            pg8::EpiBf16Plain E{WSP(bf16_t, WS_Z), NINP};
            for (int r_ = 0, n_ = REPS(4); r_ < n_; ++r_) pg8::gemm_phase<pg8::EpiBf16Plain, pg8::StaticOrder, false>(ldsl, g, S, E, nullptr);
#if CONV_FILLER
            CONV_FILL((M / 256) * (NINP / 256), TF0, TF1, 0);
#endif
        }
        SEAM(pb + 4);
        if (INL(5)) { const int reps_ = REPS(5); for (int rep_ = 0; rep_ < reps_; ++rep_) { const Params q = opaque_params(p); phase_prep(q, l, lds); __syncthreads(); } }
        SEAM(pb + 5);
        if (INL(6)) { const int reps_ = REPS(6); for (int rep_ = 0; rep_ < reps_; ++rep_) { const Params q = opaque_params(p); phase_mix(q, l, lds, rep_); __syncthreads(); } }
        SEAM(pb + 6);
        if (INL(7)) { const int reps_ = REPS(7); for (int rep_ = 0; rep_ < reps_; ++rep_) { const Params q = opaque_params(p); phase_post(q, l); __syncthreads(); } }
        SEAM(pb + 7);
        if (INL(8)) {
            pg8::Gemm g{MRG, WSP(bf16_t, WS_WOUT) + (size_t)l * DM * DM, M, DM, DM}; pg8::StaticOrder S; S.init(M, DM, DM, (int)gridDim.x, (int)blockIdx.x, SPLITK_G4);
            pg8::EpiResid E{X, X, DM, modl + 5 * DM, 1.0f, Z, WSP(unsigned, WS_CTL) + FLAG_WORD0, 8u * (unsigned)(l * (2 * SPLITK + SPLITK_G4) + SPLITK + SPLITK_G4), X, 0x7FFFFFFF, XBF16, XBF16};
            pg8::gemm_phase<pg8::EpiResid, pg8::StaticOrder, false>(ldsl, g, S, E, nullptr);
#if CONV_FILLER
            CONV_FILL((M / 256) * (DM / 256), TF1, TF2, 0);
#endif
#if DUPMASK
            if (opaque_int(DUP(8))) { pg8::EpiResid E2{X, Z, DM, modl + 5 * DM, 1.0f, Z, WSP(unsigned, WS_CTL) + FLAG_WORD0, 0u, X, 0x7FFFFFFF, 0, 0}; pg8::gemm_phase<pg8::EpiResid, pg8::StaticOrder, false>(ldsl, g, S, E2, nullptr); }
#endif
        }
        SEAM(pb + 8);
        if (INL(9)) { const int reps_ = REPS(9); for (int rep_ = 0; rep_ < reps_; ++rep_) { const Params q = opaque_params(p); phase_norm(q, l, 2); __syncthreads(); } }
        SEAM(pb + 9);
        if (INL(10)) {
            {
#if G1B_MODE
                pg8::Gemm g{H, (const bf16_t*)(WSP(unsigned char, WS_WGU) + ((size_t)l * 2 + 1) * NGU * DM * 2), M, NGU, DM / 2}; pg8::StaticOrder S; S.init(M, NGU, DM / 2, (int)gridDim.x, (int)blockIdx.x, G1B_MSPLIT);
                constexpr float ws_ = 1.0f / WGU_SCALE;
#else
                pg8::Gemm g{H, WSP(bf16_t, WS_WGU) + ((size_t)l * 2 + 1) * NGU * DM, M, NGU, DM}; pg8::StaticOrder S; S.init(M, NGU, DM, (int)gridDim.x, (int)blockIdx.x, G1B_MSPLIT);
                constexpr float ws_ = 1.0f;
#endif
#if G2_FP8
                pg8::EpiSwiGLU8 E{WSP(unsigned char, WS_ACT), FFP, ws_};
                for (int r_ = 0, n_ = REPS(10); r_ < n_; ++r_) pg8::gemm_phase<pg8::EpiSwiGLU8, pg8::StaticOrder, false, G1B_MODE>(ldsl, g, S, E, nullptr);
#else
                pg8::EpiSwiGLU E{ACT, FF};
                pg8::gemm_phase<pg8::EpiSwiGLU, pg8::StaticOrder, false, G1B_MODE>(ldsl, g, S, E, nullptr);
#endif
            }
#if CONV_FILLER
            CONV_FILL((M / 256) * (NGU / 256), TF3, NT_L, (G1B_MSPLIT ? ((M / 256) * (NGU / 256)) % (int)gridDim.x : 0));
#endif
        }
        SEAM(pb + 10);
        if (INL(11)) {
            pg8::Gemm g{ACT, G2_FP8 ? (const bf16_t*)(WSP(unsigned char, WS_WDN) + ((size_t)l * 2 + 1) * DM * FFP) : WSP(bf16_t, WS_WDN) + ((size_t)l * 2 + 1) * DM * FF, M, DM, G2_FP8 ? FFP / 2 : FF}; pg8::StaticOrder S; S.init(M, DM, G2_FP8 ? FFP / 2 : FF, (int)gridDim.x, (int)blockIdx.x, SPLITK ? 1 : MSPLIT);
            pg8::EpiResid E{X, (l == DEPTH - 1) ? p.out : X, DM, modl + 8 * DM, G2_FP8 ? 0.5f / WDN_SCALE : 0.5f, Z, WSP(unsigned, WS_CTL) + FLAG_WORD0, 8u * (unsigned)(l * (2 * SPLITK + SPLITK_G4) + 2 * SPLITK + SPLITK_G4), X, 0x7FFFFFFF, XBF16, (XBF16 && l != DEPTH - 1)};
            pg8::gemm_phase<pg8::EpiResid, pg8::StaticOrder, false, (G2_FP8 ? 1 : 0)>(ldsl, g, S, E, nullptr);
        }
        SEAM(pb + 11);
    }
#ifdef DIAG_KIND
    xcd_barrier(bar);
    if (blockIdx.x == 0 && threadIdx.x == 0) p.out[0] += (float)dg_sum * 0.01f * DIAG_SCALE;
#endif
#undef IN
#undef SEAM
}

#ifndef MULTI_LAUNCH
#define MULTI_LAUNCH 0
#endif
extern "C" void kernel_launch(void* const* d_in, const int* in_sizes, int n_in, void* d_out, int out_size, void* d_ws, size_t ws_size, hipStream_t stream) {
    static int grid = 0;
    if (grid == 0) {
        if (n_in != N_IN || (size_t)out_size != O_END || ws_size < WS_END) { fprintf(stderr, "kernel_launch: shape mismatch n_in %d out %d ws %zu (need %zu)\n", n_in, out_size, ws_size, (size_t)WS_END); grid = -1; return; }
        int dev = 0, cus = 0, per_cu = 0;
        if (hipGetDevice(&dev) != hipSuccess || hipDeviceGetAttribute(&cus, hipDeviceAttributeMultiprocessorCount, dev) != hipSuccess) { grid = -1; return; }
        if (hipFuncSetAttribute((const void*)fwd, hipFuncAttributeMaxDynamicSharedMemorySize, LDS_BYTES) != hipSuccess) { fprintf(stderr, "kernel_launch: hipFuncSetAttribute failed\n"); grid = -1; return; }
        if (hipOccupancyMaxActiveBlocksPerMultiprocessor(&per_cu, (const void*)fwd, 512, LDS_BYTES) != hipSuccess || per_cu < 1) { fprintf(stderr, "kernel_launch: occupancy query says %d\n", per_cu); (void)hipGetLastError(); }
        grid = cus;
    }
    if (grid < 0) return;
    (void)hipMemsetAsync((char*)d_ws + WS_CTL, 0, CTL_BYTES, stream);
    Params p{};
    for (int i = 0; i < N_IN; ++i) p.in[i] = (const float*)d_in[i];
    p.out = (float*)d_out; p.ws = (unsigned char*)d_ws;
#if MULTI_LAUNCH
    for (int ph = 0; ph < 1 + DBG_NLAYERS * 12; ++ph) { p.ph_lo = ph; p.ph_hi = ph + 1; hipLaunchKernelGGL(fwd, dim3(grid), dim3(512), LDS_BYTES, stream, p); }
#else
    p.ph_lo = 0; p.ph_hi = NPH; hipLaunchKernelGGL(fwd, dim3(grid), dim3(512), LDS_BYTES, stream, p);
#endif
    const hipError_t le = hipPeekAtLastError();
    if (le != hipSuccess) fprintf(stderr, "kernel_launch: launch failed: %s\n", hipGetErrorName(le));
}
```

```cpp
#include <hip/hip_runtime.h>
#include <cstdio>
#include <cstdint>

#ifndef CB_
#define CB_ 16
#endif
#ifndef LB_
#define LB_ 8
#endif
#ifndef DEPTH_
#define DEPTH_ 4
#endif
#ifndef G1A_LAYERS
#define G1A_LAYERS 0xC
#endif
#ifndef G1A_MODE
#define G1A_MODE 0
#endif
#ifndef G1B_MODE
#define G1B_MODE 1
#endif
#ifndef XBF16
#define XBF16 0
#endif
#ifndef G2_FP8
#define G2_FP8 1
#endif
#ifndef FFN_FP8
#define FFN_FP8 (G1A_MODE != 0 || G1B_MODE != 0 || G2_FP8 != 0)
#endif
constexpr int DM = 2048, DEPTH = DEPTH_, CB = CB_, CT = 256, LB = LB_, LT = 1024;
constexpr int MC = CB * CT, ML = LB * LT, M = MC + ML;
constexpr int FF = 5504, NGU = 2 * FF, NIN = 6192, NINP = 6400, NMOD = 9 * DM, NCOND = 1 + LB;
constexpr float EPS = 1e-6f;
constexpr int FFP = 5632;
constexpr float WGU_SCALE = 32.0f, WDN_SCALE = 64.0f;
constexpr int Z_NAQ = 0, Z_NAK = 512, Z_NAV = 1024, Z_GLQ = 1536, Z_GLK = 1792, Z_GLV = 2048, Z_GLR = 2560, Z_GF = 3072, Z_GB = 3088,
              Z_GQQ = 3104, Z_GQK = 3616, Z_GQV = 3872, Z_DQKV = 4128, Z_DZ = 5664, Z_DB = 6176, Z_DA = 6184;
static_assert(Z_DA + 8 == NIN, "split");
enum { I_XP = 0, I_XS, I_CNAK, I_CNAV, I_CGK, I_CGV, I_SGLA, I_SGDN, I_C, I_CCTX, I_NORMG, I_WMOD, I_BMOD, I_GU, I_DOWN, I_WIN, I_WOUT, I_NAQKN, I_RPB,
       I_GUP, I_GBIAS, I_GLAON, I_GQAQKN, I_CONV, I_ALOG, I_DTB, I_GDNON, N_IN };
constexpr size_t O_YP = 0, O_YS = O_YP + (size_t)MC * DM, O_NAK = O_YS + (size_t)ML * DM, O_NAV = O_NAK + (size_t)CB * DEPTH * 4 * CT * 128,
                 O_GK = O_NAV + (size_t)CB * DEPTH * 4 * CT * 128, O_GV = O_GK + (size_t)CB * DEPTH * 2 * CT * 128,
                 O_SGLA = O_GV + (size_t)CB * DEPTH * 2 * CT * 128, O_SGDN = O_SGLA + (size_t)CB * DEPTH * 2 * 4 * 64 * 128,
                 O_END = O_SGDN + (size_t)CB * DEPTH * 2 * 4 * 128 * 128;
constexpr size_t al256(size_t x) { return (x + 255) & ~(size_t)255; }
constexpr size_t WS_CTL = 0, CTL_BYTES = 1u << 20;
constexpr size_t WS_WGU = CTL_BYTES;
constexpr size_t WS_WDN = WS_WGU + (size_t)DEPTH * 2 * NGU * DM * 2;
constexpr size_t WS_WIN = WS_WDN + (size_t)DEPTH * 2 * DM * FF * 2;
constexpr size_t WS_WOUT = WS_WIN + (size_t)DEPTH * NINP * DM * 2;
constexpr size_t WS_MODV = WS_WOUT + (size_t)DEPTH * DM * DM * 2;
constexpr size_t WS_ROPE = al256(WS_MODV + (size_t)DEPTH * NCOND * NMOD * 4);
constexpr size_t WS_X = al256(WS_ROPE + 2 * 64 * 32 * 4);
constexpr size_t WS_H = WS_X + (size_t)M * DM * 4;
constexpr size_t WS_ACT = WS_H + (size_t)M * DM * 2;
constexpr size_t WS_Z = WS_ACT + (size_t)M * FF * 2;
constexpr size_t WS_MRG = WS_Z + (size_t)M * NINP * 4;
constexpr size_t WS_NAQ = WS_MRG + (size_t)M * DM * 2;
constexpr size_t WS_NAK = WS_NAQ + (size_t)M * 512 * 2;
constexpr size_t WS_NAV = WS_NAK + (size_t)M * 512 * 2;
constexpr size_t WS_GQ = WS_NAV + (size_t)M * 512 * 2;
constexpr size_t WS_GK = WS_GQ + (size_t)M * 512 * 2;
constexpr size_t WS_GV = WS_GK + (size_t)M * 256 * 2;
constexpr size_t WS_CNAK = WS_GV + (size_t)M * 256 * 2;
constexpr size_t WS_CNAV = WS_CNAK + (size_t)LB * DEPTH * 256 * 512 * 2;
constexpr size_t WS_CGK = WS_CNAV + (size_t)LB * DEPTH * 256 * 512 * 2;
constexpr size_t WS_CGV = WS_CGK + (size_t)LB * DEPTH * 256 * 256 * 2;
constexpr size_t WS_AF = WS_CGV + (size_t)LB * DEPTH * 256 * 256 * 2;
constexpr size_t WS_AB = WS_AF + (size_t)M * 256 * 4;
constexpr size_t WS_DQ = WS_AB + (size_t)M * 256 * 4;
constexpr size_t WS_DK = WS_DQ + (size_t)M * 512 * 4;
constexpr size_t WS_DV = WS_DK + (size_t)M * 512 * 4;
constexpr size_t WS_DBA = WS_DV + (size_t)M * 512 * 4;
constexpr size_t WS_GOF = WS_DBA + (size_t)M * 16 * 4;
constexpr size_t WS_GOB = WS_GOF + (size_t)M * 512 * 4;
constexpr size_t WS_DOF = WS_GOB + (size_t)M * 512 * 4;
constexpr size_t WS_DOB = WS_DOF + (size_t)M * 512 * 4;
constexpr size_t WS_END = WS_DOB + (size_t)M * 512 * 4;

typedef unsigned short bf16_t;
struct Params { const float* in[N_IN]; float* out; unsigned char* ws; int ph_lo, ph_hi; };
static_assert(sizeof(Params) == N_IN * 8 + 8 + 8 + 8, "no padding");

#define WSP(T, off) ((T*)(p.ws + (off)))
__device__ __forceinline__ int opaque_tid() { int t = (int)threadIdx.x; asm volatile("" : "+v"(t)); return t; }
__device__ __forceinline__ Params opaque_params(const Params& p) { Params q = p; unsigned long long w = (unsigned long long)q.ws; asm volatile("" : "+s"(w));
    q.ws = (unsigned char*)(__attribute__((address_space(1))) unsigned char*)w; return q; }

typedef float vf4 __attribute__((ext_vector_type(4)));
__device__ __forceinline__ unsigned pack4_fp8(float a, float b, float c, float d) { int w = 0; w = __builtin_amdgcn_cvt_pk_fp8_f32(a, b, w, false); w = __builtin_amdgcn_cvt_pk_fp8_f32(c, d, w, true); return (unsigned)w; }
__device__ __forceinline__ float bf2f(unsigned short v) { return __uint_as_float((unsigned)v << 16); }
__device__ __forceinline__ vf4 ld4bf(const unsigned short* p) { const uint2 w = *(const uint2*)p; vf4 r; r.x = __uint_as_float(w.x << 16); r.y = __uint_as_float(w.x & 0xFFFF0000u); r.z = __uint_as_float(w.y << 16); r.w = __uint_as_float(w.y & 0xFFFF0000u); return r; }
__device__ __forceinline__ vf4 unp4bf(uint2 w) { vf4 r; r.x = __uint_as_float(w.x << 16); r.y = __uint_as_float(w.x & 0xFFFF0000u); r.z = __uint_as_float(w.y << 16); r.w = __uint_as_float(w.y & 0xFFFF0000u); return r; }
__device__ __forceinline__ void unp8bf(uint4 w, vf4& a, vf4& b) {
    a.x = __uint_as_float(w.x << 16); a.y = __uint_as_float(w.x & 0xFFFF0000u); a.z = __uint_as_float(w.y << 16); a.w = __uint_as_float(w.y & 0xFFFF0000u);
    b.x = __uint_as_float(w.z << 16); b.y = __uint_as_float(w.z & 0xFFFF0000u); b.z = __uint_as_float(w.w << 16); b.w = __uint_as_float(w.w & 0xFFFF0000u); }
__device__ __forceinline__ void ld8bf(const unsigned short* p, vf4& a, vf4& b) { const uint4 w = *(const uint4*)p;
    a.x = __uint_as_float(w.x << 16); a.y = __uint_as_float(w.x & 0xFFFF0000u); a.z = __uint_as_float(w.y << 16); a.w = __uint_as_float(w.y & 0xFFFF0000u);
    b.x = __uint_as_float(w.z << 16); b.y = __uint_as_float(w.z & 0xFFFF0000u); b.z = __uint_as_float(w.w << 16); b.w = __uint_as_float(w.w & 0xFFFF0000u); }
__device__ __forceinline__ float wave_sum(float v) {
#pragma unroll
    for (int o = 32; o >= 1; o >>= 1) v += __shfl_xor(v, o);
    return v;
}
typedef float vf2_ __attribute__((ext_vector_type(2)));
typedef __bf16 vb2_ __attribute__((ext_vector_type(2)));
__device__ __forceinline__ bf16_t f2bf(float f) { return __builtin_bit_cast(unsigned short, (__bf16)f); }
__device__ __forceinline__ unsigned pack2(float a, float b) { return __builtin_bit_cast(unsigned, __builtin_convertvector((vf2_){a, b}, vb2_)); }
__device__ __forceinline__ float silu_f(float x) { return x / (1.f + expf(-x)); }
__device__ __forceinline__ float rsqrt_fast(float x) { return __builtin_amdgcn_rsqf(x); }
__device__ __forceinline__ float silu_fast(float x) { return x * __builtin_amdgcn_rcpf(1.f + __expf(-x)); }
__device__ __forceinline__ float logsigmoid_fast(float x) { return fminf(x, 0.f) - __logf(1.f + __expf(-fabsf(x))); }
__device__ __forceinline__ float softplus_f(float x) { return fmaxf(x, 0.f) + log1pf(expf(-fabsf(x))); }
__device__ __forceinline__ float logsigmoid_f(float x) { return fminf(x, 0.f) - log1pf(expf(-fabsf(x))); }
__device__ __forceinline__ bool g1_fp8(int l, int f) { return f ? (G1B_MODE != 0) : (G1A_MODE != 0 || ((G1A_LAYERS >> l) & 1)); }
__device__ __forceinline__ int cond_of_row(int m) { return m < MC ? 0 : 1 + (m - MC) / LT; }
#ifndef CONV_FILLER
#define CONV_FILLER 1
#endif
__device__ __forceinline__ void conv_tile(const float* __restrict__ src, int ld_src, int ncols_src, int k0, int c0, bf16_t* __restrict__ dst, int ld_dst, int n0, float* tile) {
    const int tid = opaque_tid();
    {
        const int r = tid >> 3, c = (tid & 7) * 8;
        float4 a = make_float4(0.f, 0.f, 0.f, 0.f), b = a;
        if (c0 + c + 8 <= ncols_src) {
            const float* s = src + (size_t)(k0 + r) * ld_src + c0 + c;
            a = *(const float4*)s; b = *(const float4*)(s + 4);
        }
        float* t = tile + r * 65 + c;
        t[0] = a.x; t[1] = a.y; t[2] = a.z; t[3] = a.w; t[4] = b.x; t[5] = b.y; t[6] = b.z; t[7] = b.w;
    }
    __syncthreads();
    {
        const int n = tid >> 3, ks = (tid & 7) * 8;
        const float* t = tile + ks * 65 + n;
        uint4 w;
        w.x = pack2(t[0 * 65], t[1 * 65]); w.y = pack2(t[2 * 65], t[3 * 65]); w.z = pack2(t[4 * 65], t[5 * 65]); w.w = pack2(t[6 * 65], t[7 * 65]);
        *(uint4*)(dst + (size_t)(n0 + n) * ld_dst + k0 + ks) = w;
    }
    __syncthreads();
}

__device__ __forceinline__ void conv_tile8(const float* __restrict__ src, int ld_src, int nrows_src, int k0, int c0, unsigned char* __restrict__ dst, int ld_dst, int n0, float scale, float* tile) {
    const int tid = opaque_tid();
    {
        const int r = tid >> 3, c = (tid & 7) * 8;
        float4 a = make_float4(0.f, 0.f, 0.f, 0.f), b = a;
        if (k0 + r < nrows_src) { const float* s = src + (size_t)(k0 + r) * ld_src + c0 + c; a = *(const float4*)s; b = *(const float4*)(s + 4); }
        float* t = tile + r * 65 + c;
        t[0] = a.x * scale; t[1] = a.y * scale; t[2] = a.z * scale; t[3] = a.w * scale; t[4] = b.x * scale; t[5] = b.y * scale; t[6] = b.z * scale; t[7] = b.w * scale;
    }
    __syncthreads();
    {
        const int n = tid >> 3, ks = (tid & 7) * 8;
        const float* t = tile + ks * 65 + n;
        uint2 w; w.x = pack4_fp8(t[0 * 65], t[1 * 65], t[2 * 65], t[3 * 65]); w.y = pack4_fp8(t[4 * 65], t[5 * 65], t[6 * 65], t[7 * 65]);
        *(uint2*)(dst + (size_t)(n0 + n) * ld_dst + k0 + ks) = w;
    }
    __syncthreads();
}
constexpr int MOD_ITEMS = DEPTH * (NMOD / 128);
constexpr int TGU_KT = DM / 64, TGU_NT = NGU / 64, TDN_KT = (G2_FP8 ? FFP : FF) / 64, TDN_NT = DM / 64, TIN_KT = DM / 64, TIN_NT = NINP / 64, TOUT_KT = DM / 64, TOUT_NT = DM / 64;
constexpr int TL_GU = 2 * TGU_KT * TGU_NT, TL_DN = 2 * TDN_KT * TDN_NT, TL_IN = TIN_KT * TIN_NT, TL_OUT = TOUT_KT * TOUT_NT, NT_L = TL_GU + TL_DN + TL_IN + TL_OUT;
struct CTile { const float* sp; unsigned char* dp; float scale; int fp8; };
__device__ __forceinline__ CTile conv_desc(const Params& p, int l, int it, int tid) {
    const int r = tid >> 3, c = (tid & 7) * 8;
    CTile d; d.scale = 1.0f; d.fp8 = 0;
    if (it < TL_GU) {
        const int mat = l * 2 + it / (TGU_KT * TGU_NT), rr = it % (TGU_KT * TGU_NT), kt = rr / TGU_NT, nt = rr % TGU_NT;
        const int n0 = nt * 64, t256 = n0 / 256, cc = n0 % 256;
        const int c0 = cc < 128 ? 128 * t256 + cc : FF + 128 * t256 + (cc - 128);
        d.sp = p.in[I_GU] + (size_t)mat * DM * NGU + (size_t)(kt * 64 + r) * NGU + c0 + c;
        if (g1_fp8(mat >> 1, mat & 1)) { d.fp8 = 1; d.scale = WGU_SCALE; d.dp = WSP(unsigned char, WS_WGU) + (size_t)mat * NGU * DM * 2 + (size_t)(n0 + r) * DM + kt * 64 + c; }
        else d.dp = WSP(unsigned char, WS_WGU) + ((size_t)mat * NGU * DM + (size_t)(n0 + r) * DM + kt * 64 + c) * 2;
    } else if (it < TL_GU + TL_DN) {
        const int i2 = it - TL_GU, mat = l * 2 + i2 / (TDN_KT * TDN_NT), rr = i2 % (TDN_KT * TDN_NT), kt = rr / TDN_NT, nt = rr % TDN_NT;
        d.sp = (kt * 64 + r < FF) ? p.in[I_DOWN] + (size_t)mat * FF * DM + (size_t)(kt * 64 + r) * DM + nt * 64 + c : nullptr;
#if G2_FP8
        d.fp8 = 1; d.scale = WDN_SCALE; d.dp = WSP(unsigned char, WS_WDN) + (size_t)mat * DM * FFP + (size_t)(nt * 64 + r) * FFP + kt * 64 + c;
#else
        d.dp = WSP(unsigned char, WS_WDN) + ((size_t)mat * DM * FF + (size_t)(nt * 64 + r) * FF + kt * 64 + c) * 2;
#endif
    } else if (it < TL_GU + TL_DN + TL_IN) {
        const int i2 = it - TL_GU - TL_DN, kt = i2 / TIN_NT, nt = i2 % TIN_NT;
        d.sp = (nt * 64 + c + 8 <= NIN) ? p.in[I_WIN] + (size_t)l * DM * NIN + (size_t)(kt * 64 + r) * NIN + nt * 64 + c : nullptr;
        d.dp = WSP(unsigned char, WS_WIN) + ((size_t)l * NINP * DM + (size_t)(nt * 64 + r) * DM + kt * 64 + c) * 2;
    } else {
        const int i2 = it - TL_GU - TL_DN - TL_IN, kt = i2 / TOUT_NT, nt = i2 % TOUT_NT;
        d.sp = p.in[I_WOUT] + (size_t)l * DM * DM + (size_t)(kt * 64 + r) * DM + nt * 64 + c;
        d.dp = WSP(unsigned char, WS_WOUT) + ((size_t)l * DM * DM + (size_t)(nt * 64 + r) * DM + kt * 64 + c) * 2;
    }
    return d;
}
__device__ __forceinline__ void conv_layer_tiles(const Params& p, int l, int t_begin, int t_end, int first, int stride, float* s_tile) {
    const int tid = opaque_tid(), r = tid >> 3, c = (tid & 7) * 8;
    int it = t_begin + first;
    if (it >= t_end) return;
    __syncthreads();
    CTile d = conv_desc(p, l, it, tid);
    float4 a = make_float4(0.f, 0.f, 0.f, 0.f), b = a;
    if (d.sp) { a = *(const float4*)d.sp; b = *(const float4*)(d.sp + 4); }
    for (int par = 0; it < t_end; it += stride, par ^= 1) {
        const int nx = it + stride;
        CTile dn = d; float4 na = make_float4(0.f, 0.f, 0.f, 0.f), nb = na;
        if (nx < t_end) { dn = conv_desc(p, l, nx, tid); if (dn.sp) { na = *(const float4*)dn.sp; nb = *(const float4*)(dn.sp + 4); } }
        float* tile = s_tile + par * (64 * 65);
        { float* t = tile + r * 65 + c; const float sc = d.scale;
          t[0] = a.x * sc; t[1] = a.y * sc; t[2] = a.z * sc; t[3] = a.w * sc; t[4] = b.x * sc; t[5] = b.y * sc; t[6] = b.z * sc; t[7] = b.w * sc; }
        __syncthreads();
        { const float* t = tile + c * 65 + r;
          if (d.fp8) { uint2 w; w.x = pack4_fp8(t[0 * 65], t[1 * 65], t[2 * 65], t[3 * 65]); w.y = pack4_fp8(t[4 * 65], t[5 * 65], t[6 * 65], t[7 * 65]); *(uint2*)d.dp = w; }
          else { uint4 w; w.x = pack2(t[0 * 65], t[1 * 65]); w.y = pack2(t[2 * 65], t[3 * 65]); w.z = pack2(t[4 * 65], t[5 * 65]); w.w = pack2(t[6 * 65], t[7 * 65]); *(uint4*)d.dp = w; } }
        d = dn; a = na; b = nb;
    }
    __syncthreads();
}

__device__ __forceinline__ void mod_layer(const Params& p, int l, int first, int stride, float* smem) {
    const int tid = opaque_tid();
    float* s_cond = smem;
    float* s_red = s_cond + NCOND * DM;
    __syncthreads();
    for (int i = tid; i < NCOND * DM; i += 512) { const int ci = i / DM, k = i % DM; const float v = ci == 0 ? p.in[I_CCTX][k] : p.in[I_C][(size_t)(ci - 1) * DM + k]; s_cond[i] = silu_f(v); }
    __syncthreads();
    float* modv = WSP(float, WS_MODV);
    for (int jt = first; jt < NMOD / 128; jt += stride) {
        const int cl = tid & 127, kq = tid >> 7, col = jt * 128 + cl;
        const float* w = p.in[I_WMOD] + (size_t)l * DM * NMOD + col;
        float acc[NCOND];
#pragma unroll
        for (int ci = 0; ci < NCOND; ++ci) acc[ci] = 0.f;
        for (int k = kq * 512; k < kq * 512 + 512; k += 8) {
            float wv[8];
#pragma unroll
            for (int j = 0; j < 8; ++j) wv[j] = w[(size_t)(k + j) * NMOD];
#pragma unroll
            for (int ci = 0; ci < NCOND; ++ci) {
                const float4 s0 = *(const float4*)&s_cond[ci * DM + k], s1 = *(const float4*)&s_cond[ci * DM + k + 4];
                acc[ci] += s0.x * wv[0] + s0.y * wv[1] + s0.z * wv[2] + s0.w * wv[3] + s1.x * wv[4] + s1.y * wv[5] + s1.z * wv[6] + s1.w * wv[7];
            }
        }
        if (kq > 0) {
#pragma unroll
            for (int ci = 0; ci < NCOND; ++ci) s_red[((kq - 1) * 128 + cl) * NCOND + ci] = acc[ci];
        }
        __syncthreads();
        if (kq == 0) {
            const float bm = p.in[I_BMOD][(size_t)l * NMOD + col];
#pragma unroll
            for (int ci = 0; ci < NCOND; ++ci)
                modv[((size_t)l * NCOND + ci) * NMOD + col] = acc[ci] + s_red[(0 * 128 + cl) * NCOND + ci] + s_red[(1 * 128 + cl) * NCOND + ci] + s_red[(2 * 128 + cl) * NCOND + ci] + bm;
        }
        __syncthreads();
    }
}

__device__ __forceinline__ void phase_prologue(const Params& p, float* smem) {
    const int tid = threadIdx.x, nb = gridDim.x, bid = blockIdx.x;
    float* s_tile = smem + NCOND * DM + 3 * 128 * NCOND;
#if CONV_FILLER
    mod_layer(p, 0, bid, nb, smem);
#else
    for (int l2 = 0; l2 < DEPTH; ++l2) mod_layer(p, l2, bid, nb, smem);
#endif
    conv_layer_tiles(p, 0, 0, NT_L, bid, nb, s_tile);
#if !CONV_FILLER
    for (int l2 = 1; l2 < DEPTH; ++l2) conv_layer_tiles(p, l2, 0, NT_L, bid, nb, s_tile);
#endif
    const size_t gtid = (size_t)bid * 512 + tid, gstride = (size_t)nb * 512;
    {
        const size_t n_na = (size_t)LB * DEPTH * 256 * 512 / 8;
        for (size_t i = gtid; i < 2 * n_na; i += gstride) {
            const bool isv = i >= n_na; const size_t j = isv ? i - n_na : i;
            const int d8 = (int)(j % 16), h = (int)((j / 16) % 4), t = (int)((j / 64) % 256); const size_t bl = j / (64 * 256);
            const float* s = p.in[isv ? I_CNAV : I_CNAK] + ((bl * 4 + h) * 256 + t) * 128 + d8 * 8;
            const float4 a = *(const float4*)s, b = *(const float4*)(s + 4);
            uint4 w; w.x = pack2(a.x, a.y); w.y = pack2(a.z, a.w); w.z = pack2(b.x, b.y); w.w = pack2(b.z, b.w);
            *(uint4*)(WSP(bf16_t, isv ? WS_CNAV : WS_CNAK) + (bl * 256 + t) * 512 + h * 128 + d8 * 8) = w;
        }
        const size_t n_g = (size_t)LB * DEPTH * 256 * 256 / 8;
        for (size_t i = gtid; i < 2 * n_g; i += gstride) {
            const bool isv = i >= n_g; const size_t j = isv ? i - n_g : i;
            const int d8 = (int)(j % 16), h = (int)((j / 16) % 2), t = (int)((j / 32) % 256); const size_t bl = j / (32 * 256);
            const float* s = p.in[isv ? I_CGV : I_CGK] + ((bl * 2 + h) * 256 + t) * 128 + d8 * 8;
            const float4 a = *(const float4*)s, b = *(const float4*)(s + 4);
            uint4 w; w.x = pack2(a.x, a.y); w.y = pack2(a.z, a.w); w.z = pack2(b.x, b.y); w.w = pack2(b.z, b.w);
            *(uint4*)(WSP(bf16_t, isv ? WS_CGV : WS_CGK) + (bl * 256 + t) * 256 + h * 128 + d8 * 8) = w;
        }
    }
    for (size_t i = gtid; i < 64 * 32; i += gstride) {
        const int pos = (int)(i / 32), k = (int)(i % 32);
        const float inv = powf(10000.0f, -(float)(2 * k) / 64.0f);
        const float ang = (float)pos * inv;
        WSP(float, WS_ROPE)[i] = cosf(ang); WSP(float, WS_ROPE)[64 * 32 + i] = sinf(ang);
    }
}

#ifndef NORM_NR
#define NORM_NR 2
#endif
constexpr int NORM_MAXC = 6;
__device__ __forceinline__ void phase_norm(const Params& p, int l, int which  , unsigned char* lds) {
    const int tid = opaque_tid(), lane = tid & 63, wv = tid >> 6;
    const float* X = WSP(float, WS_X); bf16_t* H = WSP(bf16_t, WS_H);
    const bool from_in = (l == 0 && which == 0);
    const float* g = p.in[I_NORMG] + ((size_t)l * 3 + which) * DM;
    const int rpb = (M + (int)gridDim.x - 1) / (int)gridDim.x;
    const int r0 = (int)blockIdx.x * rpb, r1 = r0 + rpb < M ? r0 + rpb : M;
    if (r0 >= r1) return;
    const int c_lo = cond_of_row(r0), c_hi = cond_of_row(r1 - 1);
    float* sw = (float*)lds;
    for (int ci = 0; ci <= c_hi - c_lo && ci < NORM_MAXC; ++ci) {
        const float* mv = WSP(float, WS_MODV) + ((size_t)l * NCOND + c_lo + ci) * NMOD + (size_t)which * 3 * DM;
        const int c = tid * 4;
        const vf4 gg = *(const vf4*)(g + c), sh = *(const vf4*)(mv + c), sc = *(const vf4*)(mv + DM + c);
        *(vf4*)(sw + (size_t)ci * 2 * DM + c) = gg * (1.f + sc);
        *(vf4*)(sw + (size_t)ci * 2 * DM + DM + c) = sh;
    }
    __syncthreads();
    for (int m0 = r0 + wv; m0 < r1; m0 += NORM_NR * 8) {
        int mm[NORM_NR]; bool has[NORM_NR];
#pragma unroll
        for (int k = 0; k < NORM_NR; ++k) { has[k] = m0 + k * 8 < r1; mm[k] = has[k] ? m0 + k * 8 : m0; }
        vf4 v[NORM_NR][8]; float ss[NORM_NR];
#pragma unroll
        for (int k = 0; k < NORM_NR; ++k) {
            const int m = mm[k];
            if (from_in || !XBF16) {
                const float* x = !from_in ? X + (size_t)m * DM : m < MC ? p.in[I_XP] + (size_t)m * DM : p.in[I_XS] + (size_t)(m - MC) * DM;
#pragma unroll
                for (int i = 0; i < 8; ++i) v[k][i] = *(const vf4*)(x + (i * 64 + lane) * 4);
            } else {
                const bf16_t* x = (const bf16_t*)X + (size_t)m * DM;
#pragma unroll
                for (int i = 0; i < 8; ++i) v[k][i] = ld4bf(x + (i * 64 + lane) * 4);
            }
        }
#pragma unroll
        for (int k = 0; k < NORM_NR; ++k) {
            ss[k] = 0.f;
#pragma unroll
            for (int i = 0; i < 8; ++i) ss[k] += v[k][i].x * v[k][i].x + v[k][i].y * v[k][i].y + v[k][i].z * v[k][i].z + v[k][i].w * v[k][i].w;
            ss[k] = wave_sum(ss[k]);
        }
#pragma unroll
        for (int k = 0; k < NORM_NR; ++k) {
            if (k > 0 && !has[k]) break;
            const int m = mm[k];
            const float* a = sw + (size_t)(cond_of_row(m) - c_lo) * 2 * DM;
            const float r = rsqrt_fast(ss[k] * (1.0f / DM) + EPS);
#pragma unroll
            for (int i = 0; i < 8; ++i) {
                const int c = (i * 64 + lane) * 4;
                const vf4 o = v[k][i] * r * *(const vf4*)(a + c) + *(const vf4*)(a + DM + c);
                if (which != 1 && g1_fp8(l, which >> 1)) *(unsigned*)((unsigned char*)H + (size_t)m * DM + c) = pack4_fp8(o.x, o.y, o.z, o.w);
                else { uint2 w; w.x = pack2(o.x, o.y); w.y = pack2(o.z, o.w); *(uint2*)(H + (size_t)m * DM + c) = w; }
            }
            if (G2_FP8 && which != 1 && lane < (FFP - FF) / 4) *(unsigned*)(WSP(unsigned char, WS_ACT) + (size_t)m * FFP + FF + 4 * lane) = 0u;
        }
    }
}

__device__ __forceinline__ float red16(float v);
__device__ __forceinline__ float ssq8(vf4 a, vf4 b) { const vf4 s = a * a + b * b; return (s.x + s.y) + (s.z + s.w); }
__device__ __forceinline__ uint4 pack8(vf4 a, vf4 b) { uint4 w; w.x = pack2(a.x, a.y); w.y = pack2(a.z, a.w); w.z = pack2(b.x, b.y); w.w = pack2(b.z, b.w); return w; }
constexpr int PL_CW = 0, PL_UP = PL_CW + 5 * 1536, PL_GB = PL_UP + 2 * 16 * 256, PL_NQ = PL_GB + 512, PL_ROPE = PL_NQ + 512, PL_END = PL_ROPE + 2 * 64 * 32;
__device__ __forceinline__ void phase_prep(const Params& p, int l, unsigned char* lds) {
    const int tid = opaque_tid(), lane = tid & 63, wv = tid >> 6, rg = lane >> 4, sub = lane & 15, c8 = sub * 8;
    const bf16_t* Z = WSP(bf16_t, WS_Z);
    float* sw = (float*)lds;
    for (int i = tid; i < 5 * 1536; i += 512) { const int j = i / 1536, col = i % 1536; sw[PL_CW + j * 1536 + ((col >> 2) & 1) * 768 + (col >> 3) * 4 + (col & 3)] = p.in[I_CONV][(size_t)l * 5 * 1536 + i]; }
    for (int i = tid; i < 2 * 16 * 256 / 4; i += 512) ((vf4*)(sw + PL_UP))[i] = ((const vf4*)(p.in[I_GUP] + (size_t)l * 2 * 16 * 256))[i];
    sw[PL_GB + tid] = p.in[I_GBIAS][(size_t)l * 512 + tid];
    { const int v = tid >> 7, c = tid & 127; const float* src = (v < 2 ? p.in[I_NAQKN] : p.in[I_GQAQKN]) + ((size_t)l * 2 + (v & 1)) * 128; sw[PL_NQ + v * 128 + ((c >> 2) & 1) * 64 + (c >> 3) * 4 + (c & 3)] = src[c]; }
    for (int i = tid; i < 2 * 64 * 32 / 4; i += 512) ((vf4*)(sw + PL_ROPE))[i] = ((const vf4*)WSP(float, WS_ROPE))[i];
    __syncthreads();
    const float* ropec = sw + PL_ROPE; const float* ropes = ropec + 64 * 32;
    const float* wnq = sw + PL_NQ + sub * 4; const float* wnk = wnq + 128;
    const float* wgq = wnq + 256; const float* wgk = wnq + 384;
    const float* cw = sw + PL_CW + (rg * 16 + sub) * 4;
    const int rpw = (M + (int)gridDim.x * 8 - 1) / ((int)gridDim.x * 8);
    for (int m = ((int)blockIdx.x * 8 + wv) * rpw, mend = (m + rpw < M ? m + rpw : M); m < mend; ++m) {
        const bf16_t* z = Z + (size_t)m * NINP;
        const bool ctx = m < MC;
        const int b = ctx ? m / CT : (m - MC) / LT, t = ctx ? m % CT : (m - MC) % LT, T = ctx ? CT : LT;
        const int ho = rg * 128 + c8;
        uint4 rz[5]; uint2 rgz[2][4];
        {
            const bf16_t* zkv = z + (rg < 2 ? Z_GQK + rg * 128 : Z_GQV + (rg - 2) * 128) + c8;
            rz[0] = *(const uint4*)(z + Z_NAQ + ho); rz[1] = *(const uint4*)(z + Z_NAK + ho); rz[2] = *(const uint4*)(z + Z_NAV + ho); rz[3] = *(const uint4*)(z + Z_GQQ + ho); rz[4] = *(const uint4*)zkv;
#pragma unroll
            for (int dir = 0; dir < 2; ++dir)
#pragma unroll
                for (int r4 = 0; r4 < 4; ++r4) rgz[dir][r4] = *(const uint2*)(z + (dir ? Z_GB : Z_GF) + 4 * r4);
        }
        asm volatile("" ::: "memory");
        {
            vf4 q0, q1, k0, k1, v0, v1, g0, g1, x0, x1;
            unp8bf(rz[0], q0, q1); unp8bf(rz[1], k0, k1); unp8bf(rz[2], v0, v1); unp8bf(rz[3], g0, g1); unp8bf(rz[4], x0, x1);
            float r = rsqrt_fast(red16(ssq8(q0, q1)) * (1.0f / 128) + EPS);
            q0 = q0 * r * *(const vf4*)wnq; q1 = q1 * r * *(const vf4*)(wnq + 64);
            *(uint4*)(WSP(bf16_t, WS_NAQ) + (size_t)m * 512 + ho) = pack8(q0, q1);
            r = rsqrt_fast(red16(ssq8(k0, k1)) * (1.0f / 128) + EPS);
            k0 = k0 * r * *(const vf4*)wnk; k1 = k1 * r * *(const vf4*)(wnk + 64);
            *(uint4*)(WSP(bf16_t, WS_NAK) + (size_t)m * 512 + ho) = pack8(k0, k1);
            *(uint4*)(WSP(bf16_t, WS_NAV) + (size_t)m * 512 + ho) = pack8(v0, v1);
            if (ctx) {
                const size_t o = ((((size_t)b * DEPTH + l) * 4 + rg) * CT + t) * 128 + c8;
                *(vf4*)(p.out + O_NAK + o) = k0; *(vf4*)(p.out + O_NAK + o + 4) = k1; *(vf4*)(p.out + O_NAV + o) = v0; *(vf4*)(p.out + O_NAV + o + 4) = v1;
            }
            r = rsqrt_fast(red16(ssq8(g0, g1)) * (1.0f / 128) + EPS);
            g0 = g0 * r * *(const vf4*)wgq; g1 = g1 * r * *(const vf4*)(wgq + 64);
            const float rk = rsqrt_fast(red16(ssq8(x0, x1)) * (1.0f / 128) + EPS);
            if (rg < 2) { x0 = x0 * rk * *(const vf4*)wgk; x1 = x1 * rk * *(const vf4*)(wgk + 64); }
            if (!ctx) {
                const int pos = sub < 8 ? (t >> 6) : (t & 63), ai = pos * 32 + (c8 & 31);
                const vf4 c0 = *(const vf4*)(ropec + ai), c1 = *(const vf4*)(ropec + ai + 4), s0 = *(const vf4*)(ropes + ai), s1 = *(const vf4*)(ropes + ai + 4);
                const bool hi = (sub & 4) != 0;
                vf4 pg0, pg1, px0, px1;
#pragma unroll
                for (int j = 0; j < 4; ++j) { pg0[j] = __shfl_xor(g0[j], 4); pg1[j] = __shfl_xor(g1[j], 4); px0[j] = __shfl_xor(x0[j], 4); px1[j] = __shfl_xor(x1[j], 4); }
                g0 = hi ? pg0 * s0 + g0 * c0 : g0 * c0 - pg0 * s0; g1 = hi ? pg1 * s1 + g1 * c1 : g1 * c1 - pg1 * s1;
                if (rg < 2) { x0 = hi ? px0 * s0 + x0 * c0 : x0 * c0 - px0 * s0; x1 = hi ? px1 * s1 + x1 * c1 : x1 * c1 - px1 * s1; }
            }
            *(uint4*)(WSP(bf16_t, WS_GQ) + (size_t)m * 512 + ho) = pack8(g0, g1);
            *(uint4*)(WSP(bf16_t, rg < 2 ? WS_GK : WS_GV) + (size_t)m * 256 + (rg & 1) * 128 + c8) = pack8(x0, x1);
            if (ctx) {
                const size_t o = ((((size_t)b * DEPTH + l) * 2 + (rg & 1)) * CT + t) * 128 + c8;
                float* dst = p.out + (rg < 2 ? O_GK : O_GV) + o;
                *(vf4*)dst = x0; *(vf4*)(dst + 4) = x1;
            }
        }
        asm volatile("" ::: "memory");
        {
#pragma unroll
            for (int dir = 0; dir < 2; ++dir) {
                const float* up = sw + PL_UP + dir * 16 * 256 + 4 * lane;
                vf4 acc = *(const vf4*)(sw + PL_GB + dir * 256 + 4 * lane);
#pragma unroll
                for (int r4 = 0; r4 < 4; ++r4) {
                    const vf4 gv = unp4bf(rgz[dir][r4]);
                    acc += gv.x * *(const vf4*)(up + (4 * r4 + 0) * 256) + gv.y * *(const vf4*)(up + (4 * r4 + 1) * 256) + gv.z * *(const vf4*)(up + (4 * r4 + 2) * 256) + gv.w * *(const vf4*)(up + (4 * r4 + 3) * 256);
                }
                vf4 o;
#pragma unroll
                for (int j = 0; j < 4; ++j) o[j] = logsigmoid_fast(acc[j]) * (1.0f / 16.0f);
                *(vf4*)(WSP(float, dir ? WS_AB : WS_AF) + (size_t)m * 256 + 4 * lane) = o;
            }
        }
        asm volatile("" ::: "memory");
        {
            uint4 rcz[3][5];
#pragma unroll
            for (int part = 0; part < 3; ++part)
#pragma unroll
                for (int j = 0; j < 5; ++j) { const int tt = t + j - 2;
                    rcz[part][j] = (tt >= 0 && tt < T) ? *(const uint4*)(Z + (size_t)(m + j - 2) * NINP + Z_DQKV + part * 512 + rg * 128 + c8) : make_uint4(0u, 0u, 0u, 0u); }
            asm volatile("" ::: "memory");
#pragma unroll
            for (int part = 0; part < 3; ++part) {
                vf4 a0 = (vf4){0.f, 0.f, 0.f, 0.f}, a1 = a0;
#pragma unroll
                for (int j = 0; j < 5; ++j) {
                    const float* cj = cw + j * 1536 + part * 256;
                    vf4 z0, z1; unp8bf(rcz[part][j], z0, z1);
                    a0 += *(const vf4*)cj * z0; a1 += *(const vf4*)(cj + 768) * z1;
                }
#pragma unroll
                for (int j = 0; j < 4; ++j) { a0[j] = silu_fast(a0[j]); a1[j] = silu_fast(a1[j]); }
                if (part < 2) { const float r = rsqrt_fast(red16(ssq8(a0, a1)) + EPS) * (part == 0 ? 0.08838834764831845f : 1.0f); a0 *= r; a1 *= r; }
                *(uint4*)(WSP(bf16_t, part == 0 ? WS_DQ : part == 1 ? WS_DK : WS_DV) + (size_t)m * 512 + rg * 128 + c8) = pack8(a0, a1);
                asm volatile("" ::: "memory");
            }
            if (lane < 8) {
                const float beta = 1.0f / (1.0f + expf(-bf2f(z[Z_DB + lane])));
                const float g = -expf(p.in[I_ALOG][(size_t)l * 8 + lane]) * softplus_f(bf2f(z[Z_DA + lane]) + p.in[I_DTB][(size_t)l * 8 + lane]);
                float* ba = WSP(float, WS_DBA) + (size_t)m * 16;
                ba[lane] = beta; ba[8 + lane] = g;
            }
        }
    }
}

typedef float vf2 __attribute__((ext_vector_type(2)));
__device__ __forceinline__ float dpp_f(float v, const int ctrl) { return v; }
#define DPPF(v, ctrl) __int_as_float(__builtin_amdgcn_mov_dpp(__float_as_int(v), (ctrl), 0xF, 0xF, true))
__device__ __forceinline__ float red8(float v) { v += DPPF(v, 0xB1); v += DPPF(v, 0x4E); v += DPPF(v, 0x141); return v; }
__device__ __forceinline__ float red16(float v) { v = red8(v); v += DPPF(v, 0x140); return v; }

__device__ __forceinline__ void phase_post(const Params& p, int l) {
    const int tid = opaque_tid(), lane = tid & 63, wv = tid >> 6, rg = lane >> 4, c8 = (lane & 15) * 8;
    const bf16_t* Z = WSP(bf16_t, WS_Z); bf16_t* MRG = WSP(bf16_t, WS_MRG);
    const float* wg = p.in[I_GLAON] + (size_t)l * 128 + c8; const float* wd = p.in[I_GDNON] + (size_t)l * 128 + c8;
    for (int m = blockIdx.x * 8 + wv; m < M; m += gridDim.x * 8) {
        const bf16_t* z = Z + (size_t)m * NINP;
        const int ho = rg * 128 + c8;
#pragma unroll
        for (int g = 0; g < 2; ++g) {
            const float* of = WSP(float, g ? WS_DOF : WS_GOF) + (size_t)m * 512 + ho; const float* ob = WSP(float, g ? WS_DOB : WS_GOB) + (size_t)m * 512 + ho;
            const float* w = g ? wd : wg; const bf16_t* zg = z + (g ? Z_DZ : Z_GLR) + ho;
            vf4 a0 = *(const vf4*)of + *(const vf4*)ob, a1 = *(const vf4*)(of + 4) + *(const vf4*)(ob + 4);
            vf4 g0, g1; ld8bf(zg, g0, g1);
            const float r = rsqrt_fast(red16(ssq8(a0, a1)) * (1.0f / 128) + EPS);
            a0 = a0 * r * *(const vf4*)w; a1 = a1 * r * *(const vf4*)(w + 4);
#pragma unroll
            for (int j = 0; j < 4; ++j) { a0[j] *= silu_fast(g0[j]); a1[j] *= silu_fast(g1[j]); }
            *(uint4*)(MRG + (size_t)m * DM + (g ? 1536 : 512) + ho) = pack8(a0, a1);
        }
    }
}
#define XB_TMO      128
#define XB_XCNT(j)  (256  + 64 * (j))
#define XB_XSUB(j)  (1280 + 64 * (j))
#define XB_XGEN(j)  (2304 + 64 * (j))
#define XB_TOP      3328
#define XB_TOPGEN   3392
#define XCD_BAR_WORDS 3456
#define XB_SPIN_CAP (1u << 22)
#define LAS __attribute__((address_space(3)))

__device__ __forceinline__ unsigned xb_ld(unsigned* p)              { return __hip_atomic_load(p, __ATOMIC_RELAXED, __HIP_MEMORY_SCOPE_AGENT); }
__device__ __forceinline__ unsigned xb_add(unsigned* p, unsigned v) { return __hip_atomic_fetch_add(p, v, __ATOMIC_RELAXED, __HIP_MEMORY_SCOPE_AGENT); }
__device__ __forceinline__ unsigned xb_xcc_id() { return (unsigned)__builtin_amdgcn_s_getreg((3 << 11) | 20) & 0xFu; }
#define XB_SPIN(cond, bar) do { unsigned _sp = 0; while (cond) { __builtin_amdgcn_s_sleep(1); \
    if ((++_sp & 255u) == 0u) { if (xb_ld(&(bar)[XB_TMO])) break; if (_sp > XB_SPIN_CAP) { atomicAdd(&(bar)[XB_TMO], 1u); break; } } } } while (0)

struct XcdBarrier {
    unsigned* bar; unsigned x;
    volatile LAS unsigned* st;
};

__device__ __forceinline__ XcdBarrier xcd_barrier_post(unsigned* bar, volatile LAS unsigned* st) {
    XcdBarrier b; b.bar = bar; b.x = xb_xcc_id(); b.st = st;
    if (threadIdx.x == 0) (void)xb_add(&bar[XB_XCNT(b.x)], 1u);
    return b;
}
__device__ __forceinline__ void xcd_barrier_complete(unsigned* bar, unsigned x, unsigned& nloc, unsigned& nx) {
    const unsigned G = gridDim.x * gridDim.y * gridDim.z;
    unsigned sum, cnt, mine, sp = 0u;
    for (;;) {
        sum = 0u; cnt = 0u; mine = 0u;
#pragma unroll
        for (unsigned j = 0; j < 16; ++j) { const unsigned c = xb_ld(&bar[XB_XCNT(j)]); sum += c; cnt += (c > 0u) ? 1u : 0u; mine = (j == x) ? c : mine; }
        if (sum == G) break;
        __builtin_amdgcn_s_sleep(1);
        if ((++sp & 255u) == 0u) { if (xb_ld(&bar[XB_TMO])) break; if (sp > XB_SPIN_CAP) { atomicAdd(&bar[XB_TMO], 1u); break; } }
    }
    nloc = mine > 0u ? mine : 1u; nx = cnt > 0u ? cnt : 1u;
}

__device__ __forceinline__ void xcd_barrier(const XcdBarrier& b) {
    asm volatile("s_waitcnt vmcnt(0)" ::: "memory");
    __syncthreads();
    if (threadIdx.x == 0) {
        unsigned* bar = b.bar;
        __builtin_amdgcn_s_waitcnt(0);
        unsigned nloc = b.st[0], nx = b.st[1];
        if (nloc == 0u) { xcd_barrier_complete(bar, b.x, nloc, nx); b.st[0] = nloc; b.st[1] = nx; }
        const unsigned old = xb_add(&bar[XB_XSUB(b.x)], 1u);
        const unsigned gen = old / nloc;
        if (old + 1u == (gen + 1u) * nloc) {
            __builtin_amdgcn_fence(__ATOMIC_RELEASE, "agent");
            asm volatile("s_waitcnt vmcnt(0)" ::: "memory");
            const unsigned og = xb_add(&bar[XB_TOP], 1u);
            const unsigned tg = og / nx;
            if (og + 1u == (tg + 1u) * nx) xb_add(&bar[XB_TOPGEN], 1u);
            else XB_SPIN(xb_ld(&bar[XB_TOPGEN]) == tg, bar);
            __builtin_amdgcn_fence(__ATOMIC_ACQUIRE, "agent");
            xb_add(&bar[XB_XGEN(b.x)], 1u);
            asm volatile("s_waitcnt vmcnt(0)" ::: "memory");
        } else {
            XB_SPIN(xb_ld(&bar[XB_XGEN(b.x)]) == gen, bar);
            __builtin_amdgcn_fence(__ATOMIC_ACQUIRE, "agent");
            asm volatile("s_waitcnt vmcnt(0)" ::: "memory");
        }
    }
    __syncthreads();
}

#ifndef NT_STORES
#define NT_STORES 0
#endif
namespace pg8 {
#define PG8_LAS __attribute__((address_space(3)))
typedef unsigned short bf16_t;
typedef short bf16x8 __attribute__((ext_vector_type(8)));
typedef float f32x4 __attribute__((ext_vector_type(4)));
typedef unsigned u32x4 __attribute__((ext_vector_type(4)));
typedef unsigned u32x2 __attribute__((ext_vector_type(2)));
typedef int v4i32 __attribute__((ext_vector_type(4)));
typedef int v8i32 __attribute__((ext_vector_type(8)));
constexpr int BM = 256, BK = 64, HALF = 128, HTB = HALF * BK * 2  , STAGE_BYTES = 8 * HTB, NXCD = 8, WGM = 8;

__host__ __device__ __forceinline__ int lds_byte(int r, int c) { const int st = (r >> 4) * 2 + (c >> 5), rr = r & 15, cc = c & 31, ob = rr * 64 + cc * 2; return st * 1024 + (ob ^ (((ob >> 9) & 1) << 5)); }
__host__ __device__ __forceinline__ void stage_rc(int b, int& R, int& C) { const int st = b / 1024, sb = b % 1024, swz = sb ^ (((sb >> 9) & 1) << 5); R = (st >> 1) * 16 + swz / 64; C = (st & 1) * 32 + (swz % 64) / 2; }
__host__ __device__ __forceinline__ int perm32(int rho) { const int n = rho >> 4, i = rho & 15; return 8 * (i >> 2) + 4 * n + (i & 3); }

struct Unit { int pm, pn, k0, nt, at, slot, msk; };
struct Gemm { const bf16_t* A; const bf16_t* Bt; int M, N, K; };

struct StaticOrder {
    int nM, nN, nwg, G, c, ntk, split, msplit;
    __host__ __device__ void init(int M, int N, int K, int G_, int c_, int split_ = 0) { nM = M / BM; nN = N / BM; nwg = nM * nN; G = G_; c = c_; ntk = K / BK; const int rem = nwg % G_; split = (split_ == 1 && rem > 0 && 2 * rem == G_ && ntk >= 8) ? 1 : 0; msplit = (split_ == 2 && rem > 0 && 2 * rem <= G_) ? 1 : 0; }
    __host__ __device__ bool next(int i, Unit& u) const {
        long L = (long)i * G + c; u.k0 = 0; u.nt = ntk; u.at = 0; u.slot = 0; u.msk = 3;
        if (msplit && i == nwg / G) { const int rem = nwg % G; if (c >= 2 * rem) return false; L = (long)i * G + (c % rem); u.msk = (c / rem) ? 2 : 1; }
        if (split && i == nwg / G) { const int rem = nwg % G, sl = c / rem, h0 = ((ntk / 2) + 1) & ~1; L = (long)i * G + (c % rem); u.k0 = sl ? h0 * BK : 0; u.nt = sl ? ntk - h0 : h0; u.at = sl ? 1 : 2; u.slot = c % rem; }
        if (L >= nwg) return false;
        int wgid = (int)L; { const int q = nwg / NXCD, r = nwg % NXCD, xcd = wgid % NXCD, off = wgid / NXCD; wgid = (xcd < r ? xcd * (q + 1) : r * (q + 1) + (xcd - r) * q) + off; }
        const int nig = WGM * nN, gid = wgid / nig, fm = gid * WGM, gsz = (nM - fm) < WGM ? (nM - fm) : WGM;
        u.pm = fm + ((wgid % nig) % gsz); u.pn = (wgid % nig) / gsz; return true;
    }
    __device__ __forceinline__ void a_ready(const Unit&) const {}
    __device__ __forceinline__ void done(const Unit&) const {}
};
__device__ __forceinline__ unsigned cvt_pk_bf16(float lo, float hi) { unsigned r; asm volatile("v_cvt_pk_bf16_f32 %0, %1, %2" : "=v"(r) : "v"(lo), "v"(hi)); return r; }
struct EpiF32 {
    static constexpr bool PERM = false, AFTER_DRAIN = false;
    float* C; int ldc; const float* bias;
    __device__ __forceinline__ void operator()(const f32x4 (&acc)[2][2][4][2], const Unit& u, int wr, int wc, int fr, int fq) const {
        const int row0 = u.pm * BM + wr * 64 + fr, col0 = u.pn * BM + wc * 32 + 4 * fq;
        f32x4 bv[2][2];
#pragma unroll
        for (int bj = 0; bj < 2; ++bj)
#pragma unroll
            for (int n = 0; n < 2; ++n) bv[bj][n] = bias ? *(const f32x4*)(bias + col0 + bj * HALF + n * 16) : (f32x4){0.f, 0.f, 0.f, 0.f};
#pragma unroll
        for (int ai = 0; ai < 2; ++ai)
#pragma unroll
            for (int m = 0; m < 4; ++m) { float* rowp = C + (size_t)(row0 + ai * HALF + m * 16) * ldc + col0;
#pragma unroll
                for (int bj = 0; bj < 2; ++bj)
#pragma unroll
                    for (int n = 0; n < 2; ++n) *(f32x4*)(rowp + bj * HALF + n * 16) = acc[ai][bj][m][n] + bv[bj][n]; }
    }
};

struct EpiSwiGLU {
    static constexpr bool PERM = true, AFTER_DRAIN = false;
    bf16_t* O; int ldc;
    __device__ __forceinline__ void operator()(const f32x4 (&acc)[2][2][4][2], const Unit& u, int wr, int wc, int fr, int fq) const {
        const int row0 = u.pm * BM + wr * 64 + fr, col0 = u.pn * 128 + wc * 32 + 8 * fq;
#pragma unroll
        for (int ai = 0; ai < 2; ++ai) if ((u.msk >> ai) & 1)
#pragma unroll
            for (int m = 0; m < 4; ++m) { bf16_t* rowp = O + (size_t)(row0 + ai * HALF + m * 16) * ldc + col0;
                const f32x4 g0 = acc[ai][0][m][0], g1 = acc[ai][0][m][1], u0 = acc[ai][1][m][0], u1 = acc[ai][1][m][1];
                float r[8];
#pragma unroll
                for (int j = 0; j < 4; ++j) {
                    r[j]     = g0[j] * __builtin_amdgcn_rcpf(1.0f + __builtin_amdgcn_exp2f(-1.4426950408889634f * g0[j])) * u0[j];
                    r[4 + j] = g1[j] * __builtin_amdgcn_rcpf(1.0f + __builtin_amdgcn_exp2f(-1.4426950408889634f * g1[j])) * u1[j]; }
                u32x4 w; w.x = cvt_pk_bf16(r[0], r[1]); w.y = cvt_pk_bf16(r[2], r[3]); w.z = cvt_pk_bf16(r[4], r[5]); w.w = cvt_pk_bf16(r[6], r[7]);
#if NT_STORES
                __builtin_nontemporal_store(w, (u32x4*)rowp);
#else
                *(u32x4*)rowp = w;
#endif
                }
    }
};
struct EpiSwiGLU8 {
    static constexpr bool PERM = true, AFTER_DRAIN = false;
    unsigned char* O; int ldc; float wscale;
    __device__ __forceinline__ void operator()(const f32x4 (&acc)[2][2][4][2], const Unit& u, int wr, int wc, int fr, int fq) const {
        const int row0 = u.pm * BM + wr * 64 + fr, col0 = u.pn * 128 + wc * 32 + 8 * fq;
#pragma unroll
        for (int ai = 0; ai < 2; ++ai) if ((u.msk >> ai) & 1)
#pragma unroll
            for (int m = 0; m < 4; ++m) { unsigned char* rowp = O + (size_t)(row0 + ai * HALF + m * 16) * ldc + col0;
                f32x4 g0 = acc[ai][0][m][0], g1 = acc[ai][0][m][1], u0 = acc[ai][1][m][0], u1 = acc[ai][1][m][1];
                asm volatile("" : "+v"(g0), "+v"(g1), "+v"(u0), "+v"(u1));
                g0 *= wscale; g1 *= wscale; u0 *= wscale; u1 *= wscale;
                float r[8];
#pragma unroll
                for (int j = 0; j < 4; ++j) {
                    r[j]     = g0[j] * __builtin_amdgcn_rcpf(1.0f + __builtin_amdgcn_exp2f(-1.4426950408889634f * g0[j])) * u0[j];
                    r[4 + j] = g1[j] * __builtin_amdgcn_rcpf(1.0f + __builtin_amdgcn_exp2f(-1.4426950408889634f * g1[j])) * u1[j]; }
                uint2 w; w.x = pack4_fp8(r[0], r[1], r[2], r[3]); w.y = pack4_fp8(r[4], r[5], r[6], r[7]);
                *(uint2*)rowp = w; asm volatile("" ::: "memory"); }
    }
};
struct EpiBf16Plain {
    static constexpr bool PERM = true, AFTER_DRAIN = false;
    bf16_t* O; int ldc;
    __device__ __forceinline__ void operator()(const f32x4 (&acc)[2][2][4][2], const Unit& u, int wr, int wc, int fr, int fq) const {
        const int row0 = u.pm * BM + wr * 64 + fr, col0 = u.pn * BM + wc * 32 + 8 * fq;
#pragma unroll
        for (int ai = 0; ai < 2; ++ai) if ((u.msk >> ai) & 1)
#pragma unroll
            for (int m = 0; m < 4; ++m) { bf16_t* rowp = O + (size_t)(row0 + ai * HALF + m * 16) * ldc + col0;
#pragma unroll
                for (int bj = 0; bj < 2; ++bj) { const f32x4 v0 = acc[ai][bj][m][0], v1 = acc[ai][bj][m][1];
                    u32x4 w; w.x = pack2(v0[0], v0[1]); w.y = pack2(v0[2], v0[3]); w.z = pack2(v1[0], v1[1]); w.w = pack2(v1[2], v1[3]);
                    *(u32x4*)(rowp + bj * HALF) = w; } }
    }
};
struct EpiResid {
    static constexpr bool PERM = false, AFTER_DRAIN = false;
    const float* res; float* out; int ldc; const float* gate0; float coef;
    float* slab; unsigned* flags; unsigned target;
    const float* res_hi; int row_hi;
    int res_bf16, out_bf16;
    __device__ __forceinline__ void operator()(const f32x4 (&acc)[2][2][4][2], const Unit& u, int wr, int wc, int fr, int fq) const {
        const int tidx = ((wr * 4 + wc) * 4 + fq) * 16 + fr;
        if (u.at == 1) {
            const __amdgpu_buffer_rsrc_t rs = __builtin_amdgcn_make_buffer_rsrc((void*)slab, 0, 0x7FFFFFF0, 0x00020000);
            const unsigned base = ((unsigned)u.slot * 32u * 512u + (unsigned)tidx) * 16u;
#pragma unroll
            for (int ai = 0; ai < 2; ++ai)
#pragma unroll
                for (int bj = 0; bj < 2; ++bj)
#pragma unroll
                    for (int m = 0; m < 4; ++m)
#pragma unroll
                        for (int n = 0; n < 2; ++n) { const f32x4 v = acc[ai][bj][m][n]; u32x4 w; w.x = __float_as_uint(v[0]); w.y = __float_as_uint(v[1]); w.z = __float_as_uint(v[2]); w.w = __float_as_uint(v[3]);
                            __builtin_amdgcn_raw_buffer_store_b128(w, rs, base + (unsigned)((((ai * 2 + bj) * 4 + m) * 2 + n) * 512 * 16), 0, 16); }
            asm volatile("s_waitcnt vmcnt(0)" ::: "memory");
            if ((tidx & 63) == 0) __hip_atomic_fetch_add(flags + 64 * u.slot, 1u, __ATOMIC_RELAXED, __HIP_MEMORY_SCOPE_AGENT);
            return;
        }
        const float* part = nullptr;
        if (u.at == 2) {
            unsigned spins = 0;
            while (__hip_atomic_load(flags + 64 * u.slot, __ATOMIC_RELAXED, __HIP_MEMORY_SCOPE_AGENT) < target) { __builtin_amdgcn_s_sleep(2); if (++spins > (1u << 22)) break; }
            __builtin_amdgcn_fence(__ATOMIC_ACQUIRE, "agent");
            asm volatile("s_waitcnt vmcnt(0)" ::: "memory");
            part = slab + ((size_t)u.slot * 32 * 512 + tidx) * 4;
        }
        const int row0 = u.pm * BM + wr * 64 + fr, col0 = u.pn * BM + wc * 32 + 4 * fq;
        const float* gate = gate0 + (size_t)cond_of_row(u.pm * BM) * NMOD;
        const float* rbase = (u.pm * BM >= row_hi) ? res_hi - (size_t)row_hi * ldc : res;
        f32x4 gv[2][2];
#pragma unroll
        for (int bj = 0; bj < 2; ++bj)
#pragma unroll
            for (int n = 0; n < 2; ++n) gv[bj][n] = *(const f32x4*)(gate + col0 + bj * HALF + n * 16) * coef;
#pragma unroll
        for (int ai = 0; ai < 2; ++ai) if ((u.msk >> ai) & 1)
#pragma unroll
            for (int m = 0; m < 4; ++m) { const size_t off = (size_t)(row0 + ai * HALF + m * 16) * ldc + col0;
#pragma unroll
                for (int bj = 0; bj < 2; ++bj)
#pragma unroll
                    for (int n = 0; n < 2; ++n) {
                        f32x4 a = acc[ai][bj][m][n];
                        if (part) a += *(const f32x4*)(part + (size_t)((((ai * 2 + bj) * 4 + m) * 2 + n) * 512 * 4));
                        const size_t eo = off + bj * HALF + n * 16;
                        f32x4 bs;
                        if (res_bf16) { const u32x2 w = *(const u32x2*)((const bf16_t*)rbase + eo); bs[0] = __uint_as_float(w.x << 16); bs[1] = __uint_as_float(w.x & 0xFFFF0000u); bs[2] = __uint_as_float(w.y << 16); bs[3] = __uint_as_float(w.y & 0xFFFF0000u); }
                        else bs = *(const f32x4*)(rbase + eo);
                        const f32x4 o = bs + gv[bj][n] * a;
                        if (out_bf16) { u32x2 w; w.x = cvt_pk_bf16(o[0], o[1]); w.y = cvt_pk_bf16(o[2], o[3]); *(u32x2*)((bf16_t*)out + eo) = w; }
                        else *(f32x4*)(out + eo) = o; }
                asm volatile("" ::: "memory"); }
    }
};
template <class Epi, class Sched, bool STAMP = false, int FP8 = 0>
__device__ __forceinline__ void gemm_phase(PG8_LAS unsigned char* lds, const Gemm g, const Sched& S, const Epi& E, unsigned long long* stamps) {
    const int tid = opaque_tid(), wid = __builtin_amdgcn_readfirstlane(tid >> 6), lane = tid & 63, wr = wid >> 2, wc = wid & 3, fr = lane & 15, fq = lane >> 4;
    const int K = g.K;
    int ts_lo = 0, ts_hi = 0, nts = 0; const unsigned long long rt_entry = STAMP ? (unsigned long long)wall_clock64() : 0ull;
#define PG8_STAMP() do { if (STAMP && wid == 0 && nts < 64) { const unsigned long long _c = (unsigned long long)clock64(); \
        ts_lo = (lane == nts) ? (int)(unsigned)_c : ts_lo; ts_hi = (lane == nts) ? (int)(unsigned)(_c >> 32) : ts_hi; ++nts; } } while (0)
    PG8_STAMP();
    unsigned voffA[2], voffB[2];
#pragma unroll
    for (int i = 0; i < 2; ++i) { int R, C; stage_rc(tid * 16 + i * 8192, R, C); const int Rb = Epi::PERM ? ((R & ~31) + perm32(R & 31)) : R;
        voffA[i] = (unsigned)(R * K + C) * 2u; voffB[i] = (unsigned)(Rb * K + C) * 2u; }
    const size_t kstep = (size_t)(BK * 2);
    const size_t hstep = (size_t)HALF * K * 2;
    const size_t tstep = 2 * hstep;
    const unsigned ldsw = (unsigned)wid * 1024u;
    const int aoff = lds_byte(wr * 64 + fr, fq * 8), boff = lds_byte(wc * 32 + fr, fq * 8);
#define PG8_SA(b, h) (((b) * 2 + (h)) * HTB)
#define PG8_SB(b, h) ((4 + (b) * 2 + (h)) * HTB)
#define PG8_STAGE(bufoff, gbase, voff) do { _Pragma("unroll") for (int _i = 0; _i < 2; ++_i) \
        __builtin_amdgcn_global_load_lds((const unsigned*)((const char*)(gbase) + (voff)[_i]), (PG8_LAS unsigned*)(lds + (bufoff) + ldsw + _i * 8192), 16, 0, 0); } while (0)
#define PG8_LDA(dst, b, h) do { _Pragma("unroll") for (int m = 0; m < 4; ++m) dst[m] = __builtin_shufflevector(*(const PG8_LAS v4i32*)(lds + PG8_SA(b, h) + aoff + m * 2048), *(const PG8_LAS v4i32*)(lds + PG8_SA(b, h) + aoff + m * 2048 + 1024), 0, 1, 2, 3, 4, 5, 6, 7); } while (0)
#define PG8_LDB(dst, b, h) do { _Pragma("unroll") for (int n = 0; n < 2; ++n) dst[n] = __builtin_shufflevector(*(const PG8_LAS v4i32*)(lds + PG8_SB(b, h) + boff + n * 2048), *(const PG8_LAS v4i32*)(lds + PG8_SB(b, h) + boff + n * 2048 + 1024), 0, 1, 2, 3, 4, 5, 6, 7); } while (0)
#define PG8_HALF(v, k) __builtin_bit_cast(bf16x8, __builtin_shufflevector(v, v, 4 * (k), 4 * (k) + 1, 4 * (k) + 2, 4 * (k) + 3))
#define PG8_MMA(ai, bj, At, Bt) do { __builtin_amdgcn_s_setprio(1); _Pragma("unroll") for (int m = 0; m < 4; ++m) _Pragma("unroll") for (int n = 0; n < 2; ++n) { \
        acc[ai][bj][m][n] = __builtin_amdgcn_mfma_f32_16x16x32_bf16(PG8_HALF(Bt[n], 0), PG8_HALF(At[m], 0), acc[ai][bj][m][n], 0, 0, 0); \
        acc[ai][bj][m][n] = __builtin_amdgcn_mfma_f32_16x16x32_bf16(PG8_HALF(Bt[n], 1), PG8_HALF(At[m], 1), acc[ai][bj][m][n], 0, 0, 0); } __builtin_amdgcn_s_setprio(0); } while (0)
#define PG8_MMA8(ai, bj, At, Bt) do { __builtin_amdgcn_s_setprio(1); _Pragma("unroll") for (int m = 0; m < 4; ++m) _Pragma("unroll") for (int n = 0; n < 2; ++n) \
        acc[ai][bj][m][n] = __builtin_amdgcn_mfma_scale_f32_16x16x128_f8f6f4(Bt[n], At[m], acc[ai][bj][m][n], 0, 0, 0, 127, 0, 127); __builtin_amdgcn_s_setprio(0); } while (0)
#define PG8_Q64(v, q) __builtin_bit_cast(long, __builtin_shufflevector(v, v, 2 * (q), 2 * (q) + 1))
#define PG8_M8L1(ai, bj, m, n, q) acc[ai][bj][m][n] = __builtin_amdgcn_mfma_f32_16x16x32_fp8_fp8(PG8_Q64(Bt_[n], q), PG8_Q64(At_[m], q), acc[ai][bj][m][n], 0, 0, 0)
#define PG8_MMA8L(ai, bj, At, Bt) do { auto& At_ = At; auto& Bt_ = Bt; __builtin_amdgcn_s_setprio(1); _Pragma("unroll") for (int m = 0; m < 4; ++m) _Pragma("unroll") for (int n = 0; n < 2; ++n) { \
        PG8_M8L1(ai, bj, m, n, 0); PG8_M8L1(ai, bj, m, n, 1); PG8_M8L1(ai, bj, m, n, 2); PG8_M8L1(ai, bj, m, n, 3); } __builtin_amdgcn_s_setprio(0); } while (0)
#define PG8_MMAG(ai, bj, At, Bt) do { if (mrow & (1 << (ai))) { if constexpr (FP8 == 1) PG8_MMA8(ai, bj, At, Bt); else if constexpr (FP8 == 2) PG8_MMA8L(ai, bj, At, Bt); else PG8_MMA(ai, bj, At, Bt); } } while (0)
#define PG8_WAIT_V(n) asm volatile("s_waitcnt vmcnt(" #n ")" ::: "memory")
#define PG8_WAIT_L(n) asm volatile("s_waitcnt lgkmcnt(" #n ")" ::: "memory")
#define PG8_BAR __builtin_amdgcn_s_barrier()
#define PG8_SCHED __builtin_amdgcn_sched_barrier(0)
    Unit cur, nxt; int ui = 0;
    if (!S.next(0, cur)) return;
    f32x4 acc[2][2][4][2];
#pragma unroll
    for (int a = 0; a < 2; ++a)
#pragma unroll
        for (int b = 0; b < 2; ++b)
#pragma unroll
            for (int m = 0; m < 4; ++m)
#pragma unroll
                for (int n = 0; n < 2; ++n) acc[a][b][m][n] = (f32x4){0.f, 0.f, 0.f, 0.f};
    v8i32 At[4], B0[2], B1[2];
    const char* cA = (const char*)g.A + (size_t)cur.pm * tstep + (size_t)cur.k0 * 2; const char* cB = (const char*)g.Bt + (size_t)cur.pn * tstep + (size_t)cur.k0 * 2;
    S.a_ready(cur);
    PG8_STAGE(PG8_SB(0, 0), cB, voffB); PG8_STAGE(PG8_SA(0, 0), cA, voffA); PG8_STAGE(PG8_SB(0, 1), cB + hstep, voffB); PG8_STAGE(PG8_SA(0, 1), cA + hstep, voffA);
    if (wr == 1) PG8_BAR;
    PG8_WAIT_V(4); PG8_BAR;
    PG8_STAGE(PG8_SB(1, 0), cB + kstep, voffB); PG8_STAGE(PG8_SA(1, 0), cA + kstep, voffA); PG8_STAGE(PG8_SB(1, 1), cB + hstep + kstep, voffB);
    PG8_WAIT_V(6); PG8_BAR;
    PG8_STAMP();
    for (;;) {
        const bool has_next = S.next(ui + 1, nxt);
        const char* nA = has_next ? (const char*)g.A + (size_t)nxt.pm * tstep + (size_t)nxt.k0 * 2 : cA; const char* nB = has_next ? (const char*)g.Bt + (size_t)nxt.pn * tstep + (size_t)nxt.k0 * 2 : cB;
        const int nt = cur.nt, mrow = cur.msk;
        for (int t = 0; t < nt; t += 2) {
            const bool last = (t == nt - 2);
            const char* a1 = cA + (size_t)(t + 1) * kstep;
            const char* a2 = last ? nA : cA + (size_t)(t + 2) * kstep; const char* b2 = last ? nB : cB + (size_t)(t + 2) * kstep;
            const char* a3 = a2 + kstep; const char* b3 = b2 + kstep;
            if (last && has_next) S.a_ready(nxt);
            PG8_LDB(B0, 0, 0); PG8_SCHED; PG8_LDA(At, 0, 0); PG8_STAGE(PG8_SA(1, 1), a1 + hstep, voffA);
            PG8_WAIT_L(8); PG8_BAR; PG8_WAIT_L(0); PG8_MMAG(0, 0, At, B0); PG8_BAR; PG8_SCHED;
            PG8_LDB(B1, 0, 1); PG8_STAGE(PG8_SB(0, 0), b2, voffB);
            PG8_BAR; PG8_WAIT_L(0); PG8_MMAG(0, 1, At, B1); PG8_BAR;
            PG8_LDA(At, 0, 1); PG8_STAGE(PG8_SA(0, 0), a2, voffA);
            PG8_BAR; PG8_WAIT_L(0); PG8_MMAG(1, 0, At, B0); PG8_BAR; PG8_SCHED;
            PG8_STAGE(PG8_SB(0, 1), b2 + hstep, voffB);
            PG8_WAIT_V(6); PG8_BAR; PG8_MMAG(1, 1, At, B1); PG8_BAR;
            PG8_LDB(B0, 1, 0); PG8_SCHED; PG8_LDA(At, 1, 0); PG8_STAGE(PG8_SA(0, 1), a2 + hstep, voffA);
            PG8_WAIT_L(8); PG8_BAR; PG8_WAIT_L(0); PG8_MMAG(0, 0, At, B0); PG8_BAR; PG8_SCHED;
            PG8_LDB(B1, 1, 1); PG8_STAGE(PG8_SB(1, 0), b3, voffB);
            PG8_BAR; PG8_WAIT_L(0); PG8_MMAG(0, 1, At, B1); PG8_BAR;
            PG8_LDA(At, 1, 1); PG8_STAGE(PG8_SA(1, 0), a3, voffA);
            PG8_BAR; PG8_WAIT_L(0); PG8_MMAG(1, 0, At, B0); PG8_BAR; PG8_SCHED;
            PG8_STAGE(PG8_SB(1, 1), b3 + hstep, voffB);
            PG8_WAIT_V(6); PG8_BAR; PG8_MMAG(1, 1, At, B1); PG8_BAR;
        }
        PG8_STAMP();
        if constexpr (!Epi::AFTER_DRAIN) { E(acc, cur, wr, wc, fr, fq); S.done(cur); }
        PG8_STAMP();
        if (!has_next) break;
#pragma unroll
        for (int a = 0; a < 2; ++a)
#pragma unroll
            for (int b = 0; b < 2; ++b)
#pragma unroll
                for (int m = 0; m < 4; ++m)
#pragma unroll
                    for (int n = 0; n < 2; ++n) acc[a][b][m][n] = (f32x4){0.f, 0.f, 0.f, 0.f};
        cur = nxt; cA = nA; cB = nB; ++ui;
    }
    PG8_WAIT_V(0);
    if (wr == 0) PG8_BAR;
    PG8_BAR;
    if constexpr (Epi::AFTER_DRAIN) { E.fused(acc, cur, wr, wc, fr, fq, lds, wid, lane); S.done(cur); }
    PG8_STAMP();
    if (STAMP && wid == 0) { stamps[lane] = lane < nts ? (((unsigned long long)(unsigned)ts_hi << 32) | (unsigned)ts_lo) : 0ull;
        if (lane == 62) stamps[62] = rt_entry; if (lane == 63) stamps[63] = (unsigned long long)wall_clock64(); }
#undef PG8_STAMP
#undef PG8_SA
#undef PG8_SB
#undef PG8_STAGE
#undef PG8_LDA
#undef PG8_LDB
#undef PG8_HALF
#undef PG8_MMA
#undef PG8_MMA8
#undef PG8_MMA8L
#undef PG8_M8L1
#undef PG8_Q64
#undef PG8_MMAG
#undef PG8_WAIT_V
#undef PG8_WAIT_L
#undef PG8_BAR
#undef PG8_SCHED
}
}
#ifndef ATT_INLINE
#define ATT_INLINE __forceinline__
#endif
namespace att {
constexpr int D = 128, NW = 8, QBLK = 32, KVBLK = 64, LDQ = 512, LDO = DM;
constexpr float SCALE = 0.088388347648318440f;
constexpr float THR = 8.f;
constexpr size_t SHM_V = KVBLK * D * 2, SHM_K = KVBLK * D * 2, SHM_Q = 256 * D * 2, SHM_ATTN = 2 * SHM_V + 2 * SHM_K + NW * 64 * 4 + SHM_Q;
using bf16x8 = __attribute__((ext_vector_type(8))) short;
using s16x4  = __attribute__((ext_vector_type(4))) short;
using f32x16 = __attribute__((ext_vector_type(16))) float;
using u32x4  = __attribute__((ext_vector_type(4))) unsigned;
#define KSWZ(row, colB) ((row) * 256 + ((colB) ^ (((row) & 7) << 4)))
#define SBAR() __builtin_amdgcn_sched_barrier(0)
__device__ __forceinline__ int crow(int r, int hi) { return (r & 3) + 8 * (r >> 2) + 4 * hi; }
__device__ __forceinline__ unsigned cvtpk(float lo, float hi) { unsigned r; asm volatile("v_cvt_pk_bf16_f32 %0, %1, %2" : "=v"(r) : "v"(lo), "v"(hi)); return r; }

__device__ __forceinline__ void partialSM(f32x16& p0, f32x16& p1, float& m_reg, float& mn, float& alpha) {
  constexpr float C = SCALE * 1.4426950408889634f;
  float pmax = p0[0]; for (int r = 1; r < 16; ++r) pmax = fmaxf(pmax, p0[r]); for (int r = 0; r < 16; ++r) pmax = fmaxf(pmax, p1[r]);
  { auto rr = __builtin_amdgcn_permlane32_swap(__float_as_uint(pmax), __float_as_uint(pmax), false, false);
    pmax = fmaxf(__uint_as_float(rr[0]), __uint_as_float(rr[1])); }
  if (__builtin_expect(__all(pmax - m_reg <= THR / SCALE), 1)) { mn = m_reg; alpha = 1.f; }
  else { mn = fmaxf(m_reg, pmax); alpha = __builtin_amdgcn_exp2f((m_reg - mn) * C); m_reg = mn; }
  float mnC = -mn * C;
  for (int r = 0; r < 16; ++r) p0[r] = fmaf(p0[r], C, mnC); for (int r = 0; r < 16; ++r) p1[r] = fmaf(p1[r], C, mnC);
  for (int r = 0; r < 16; ++r) p0[r] = __builtin_amdgcn_exp2f(p0[r]);
}
__device__ __forceinline__ void finishSM(f32x16& p0, f32x16& p1, float alpha, float& l_reg, bf16x8& pa0, bf16x8& pa1, bf16x8& pa2, bf16x8& pa3) {
  for (int r = 0; r < 16; ++r) p1[r] = __builtin_amdgcn_exp2f(p1[r]);
  float ps = 0; for (int r = 0; r < 16; ++r) ps += p0[r]; for (int r = 0; r < 16; ++r) ps += p1[r];
  { auto rr = __builtin_amdgcn_permlane32_swap(__float_as_uint(ps), __float_as_uint(ps), false, false);
    ps = __uint_as_float(rr[0]) + __uint_as_float(rr[1]); }
  l_reg = l_reg * alpha + ps;
#define PK4(P, BASE, OUT) do { unsigned a0 = cvtpk(P[BASE + 0], P[BASE + 1]), a1 = cvtpk(P[BASE + 2], P[BASE + 3]);   \
    unsigned b0 = cvtpk(P[BASE + 4], P[BASE + 5]), b1 = cvtpk(P[BASE + 6], P[BASE + 7]);                              \
    auto r0 = __builtin_amdgcn_permlane32_swap(a0, b0, false, false); auto r1 = __builtin_amdgcn_permlane32_swap(a1, b1, false, false); \
    u32x4 w = {r0[0], r1[0], r0[1], r1[1]}; OUT = *reinterpret_cast<bf16x8*>(&w); } while (0)
  PK4(p0, 0, pa0); PK4(p0, 8, pa1); PK4(p1, 0, pa2); PK4(p1, 8, pa3);
#undef PK4
}
__device__ __forceinline__ void qkt(f32x16& p0, f32x16& p1, const bf16_t* Ks, const bf16_t* Qs, int qrow, int r32, int hi) {
  p0 = f32x16{}; p1 = f32x16{};
#pragma unroll
  for (int d0 = 0; d0 < 8; ++d0) { int cb = (d0 * 16 + hi * 8) * 2;
    bf16x8 q = *reinterpret_cast<const bf16x8*>((const char*)Qs + KSWZ(qrow, cb));
    bf16x8 b0 = *reinterpret_cast<const bf16x8*>((const char*)Ks + KSWZ(r32, cb));
    bf16x8 b1 = *reinterpret_cast<const bf16x8*>((const char*)Ks + KSWZ(32 + r32, cb));
    p0 = __builtin_amdgcn_mfma_f32_32x32x16_bf16(b0, q, p0, 0, 0, 0);
    p1 = __builtin_amdgcn_mfma_f32_32x32x16_bf16(b1, q, p1, 0, 0, 0); }
}
__device__ __forceinline__ int v_st(int k, int c) { const int kk = (k & ~0xC) | ((k & 4) << 1) | ((k & 8) >> 1); return ((kk >> 3) * 4 + (c >> 5)) * 512 + ((kk & 7) * 32 + (c & 31)) * 2; }
__device__ __forceinline__ int v_rd_base(int lane) { return ((lane & 3) << 3) | (((lane >> 2) & 3) << 6) | (((lane >> 4) & 1) << 5) | (((lane >> 5) & 1) << 8); }
constexpr int v_rd_off(int d0, int ks, int half) { return d0 * 512 + ks * 4096 + half * 2048; }
template <int OFF> __device__ __forceinline__ s16x4 tr_read(int vb) {
  s16x4 r; asm volatile("ds_read_b64_tr_b16 %0, %1 offset:%2" : "=&v"(r) : "v"(vb), "i"(OFF) : "memory"); return r;
}
template <int D0> __device__ __forceinline__ void pv_one(f32x16& od, int vb, bf16x8 pa0, bf16x8 pa1, bf16x8 pa2, bf16x8 pa3) {
  const s16x4 l0 = tr_read<v_rd_off(D0, 0, 0)>(vb), h0 = tr_read<v_rd_off(D0, 0, 1)>(vb), l1 = tr_read<v_rd_off(D0, 1, 0)>(vb), h1 = tr_read<v_rd_off(D0, 1, 1)>(vb);
  const s16x4 l2 = tr_read<v_rd_off(D0, 2, 0)>(vb), h2 = tr_read<v_rd_off(D0, 2, 1)>(vb), l3 = tr_read<v_rd_off(D0, 3, 0)>(vb), h3 = tr_read<v_rd_off(D0, 3, 1)>(vb);
  asm volatile("s_waitcnt lgkmcnt(0)" ::: "memory"); SBAR();
#define PK(L, H) (bf16x8){L[0], L[1], L[2], L[3], H[0], H[1], H[2], H[3]}
  od = __builtin_amdgcn_mfma_f32_32x32x16_bf16(pa0, PK(l0, h0), od, 0, 0, 0);
  od = __builtin_amdgcn_mfma_f32_32x32x16_bf16(pa1, PK(l1, h1), od, 0, 0, 0);
  od = __builtin_amdgcn_mfma_f32_32x32x16_bf16(pa2, PK(l2, h2), od, 0, 0, 0);
  od = __builtin_amdgcn_mfma_f32_32x32x16_bf16(pa3, PK(l3, h3), od, 0, 0, 0);
#undef PK
}
__device__ __forceinline__ void pv_d0(f32x16* o, int vb, bf16x8 pa0, bf16x8 pa1, bf16x8 pa2, bf16x8 pa3) {
  pv_one<0>(o[0], vb, pa0, pa1, pa2, pa3); pv_one<1>(o[1], vb, pa0, pa1, pa2, pa3); pv_one<2>(o[2], vb, pa0, pa1, pa2, pa3); pv_one<3>(o[3], vb, pa0, pa1, pa2, pa3);
}

struct SrcOne { const bf16_t* k0; const bf16_t* v0; int ldk;
  __device__ __forceinline__ const bf16_t* k(int j) const { return k0 + (size_t)j * 64 * ldk; }
  __device__ __forceinline__ const bf16_t* v(int j) const { return v0 + (size_t)j * 64 * ldk; } };
struct SrcTwo { const bf16_t* ck; const bf16_t* cv; const bf16_t* k1; const bf16_t* v1; int ldk;
  __device__ __forceinline__ const bf16_t* k(int j) const { return j < 4 ? ck + (size_t)j * 64 * ldk : k1 + (size_t)(j - 4) * 64 * ldk; }
  __device__ __forceinline__ const bf16_t* v(int j) const { return j < 4 ? cv + (size_t)j * 64 * ldk : v1 + (size_t)(j - 4) * 64 * ldk; } };
struct NoBias { __device__ __forceinline__ void operator()(f32x16&, f32x16&, int, int, int, int) const {} };
struct NaBias { const float* tab; int i0, kr0;
  __device__ __forceinline__ void operator()(f32x16& p0, f32x16& p1, int jt, int wid, int r32, int hi) const {
    if (jt < 4) return;
    const int qi = i0 + wid * QBLK + r32, r = qi >> 6, qc = qi & 63, kr = kr0 + jt - 4;
    int lo = r - 4; lo = lo < 0 ? 0 : (lo > 8 ? 8 : lo);
    const bool rowok = (kr >= lo) && (kr < lo + 8);
    if (!rowok) {
#pragma unroll
      for (int rr = 0; rr < 16; ++rr) { p0[rr] = -1e30f; p1[rr] = -1e30f; }
      return;
    }
    int c0 = qc - 8; c0 = c0 < 0 ? 0 : (c0 > 48 ? 48 : c0);
    const int dr = kr - r + 7;
    const float* tb = tab + dr * 31 + (4 * hi - qc + 15);
    const int w0 = 4 * hi - c0;
#pragma unroll
    for (int g = 0; g < 4; ++g) {
#pragma unroll
      for (int q = 0; q < 4; ++q) {
        const int rr = 4 * g + q, kc0 = q + 8 * g;
        const float t0 = tb[kc0], t1 = tb[kc0 + 32];
        p0[rr] = ((unsigned)(kc0 + w0) < 16u) ? p0[rr] + t0 : -1e30f;
        p1[rr] = ((unsigned)(kc0 + 32 + w0) < 16u) ? p1[rr] + t1 : -1e30f;
      }
      SBAR();
    }
  } };

template <int SD, class Src, class Bias>
__device__ ATT_INLINE void attn_body(const bf16_t* __restrict__ Qb, const Src src, bf16_t* __restrict__ Ob, const int NT, char* lds, const Bias bias) {
  const int tid = opaque_tid(), wid = tid >> 6, lane = tid & 63, r32 = lane & 31, hi = lane >> 5;
  const int LDK = src.ldk;
  bf16_t* V_lds = (bf16_t*)lds; bf16_t* K_lds = (bf16_t*)(lds + 2 * SHM_V);
  float* ws = (float*)(lds + 2 * SHM_V + 2 * SHM_K) + wid * 64; float* li_l = ws; float* al_l = ws + 32;
  float m_reg = -1e30f, l_reg = 0; f32x16 o[4] = {};
  bf16_t* Q_lds = (bf16_t*)(lds + 2 * SHM_V + 2 * SHM_K + NW * 64 * 4);
  const int qrow = wid * QBLK + r32;
  {
#pragma unroll
    for (int i = 0; i < 8; ++i) { const int f = tid + 512 * i, row = f >> 4, c8 = (f & 15) * 8;
      *(bf16x8*)((char*)Q_lds + KSWZ(row, c8 * 2)) = *reinterpret_cast<const bf16x8*>(Qb + (long)row * LDQ + c8); }
  }
  const int sr = tid >> 4, sc = (tid & 15) * 8, vst0 = v_st(sr, sc), vst1 = v_st(32 + sr, sc);
  const int vb0 = (int)(uintptr_t)V_lds + v_rd_base(lane);
  struct { bf16x8 vs0, vs1, ks0, ks1; } sr_[SD];
#define SLOAD(i, jt) do { const bf16_t* kt_ = src.k(jt); const bf16_t* vt_ = src.v(jt); \
    sr_[i].vs0 = *reinterpret_cast<const bf16x8*>(&vt_[(long)sr * LDK + sc]); sr_[i].vs1 = *reinterpret_cast<const bf16x8*>(&vt_[(long)(32 + sr) * LDK + sc]); \
    sr_[i].ks0 = *reinterpret_cast<const bf16x8*>(&kt_[(long)sr * LDK + sc]); sr_[i].ks1 = *reinterpret_cast<const bf16x8*>(&kt_[(long)(32 + sr) * LDK + sc]); } while (0)
#define SWRITE(b, i) do { *(bf16x8*)((char*)V_lds + (b) * SHM_V + vst0) = sr_[i].vs0;          \
    *(bf16x8*)((char*)V_lds + (b) * SHM_V + vst1) = sr_[i].vs1; int kc = sc * 2;               \
    *(bf16x8*)((char*)K_lds + (b) * SHM_K + KSWZ(sr, kc)) = sr_[i].ks0;                       \
    *(bf16x8*)((char*)K_lds + (b) * SHM_K + KSWZ(32 + sr, kc)) = sr_[i].ks1; } while (0)
#define SWAIT() do { if constexpr (SD == 2) asm volatile("s_waitcnt vmcnt(4)" ::: "memory"); else asm volatile("s_waitcnt vmcnt(0)" ::: "memory"); } while (0)
#define RESC(a) do { if (__any((a) < 1.f)) { if (hi == 0) al_l[r32] = (a); asm volatile("s_waitcnt lgkmcnt(0)" ::: "memory"); \
    for (int d = 0; d < 4; ++d) for (int r = 0; r < 16; ++r) o[d][r] *= al_l[crow(r, hi)]; } } while (0)
  f32x16 pA0, pA1, pB0, pB1; float mnA, mnB, alA, alB; bf16x8 pa0, pa1, pa2, pa3;
  constexpr int SE = 0, SO = SD - 1;
  SLOAD(SE, 0); asm volatile("s_waitcnt vmcnt(0)" ::: "memory"); SWRITE(0, SE); __syncthreads();
  qkt(pA0, pA1, K_lds, Q_lds, qrow, r32, hi); bias(pA0, pA1, 0, wid, r32, hi); partialSM(pA0, pA1, m_reg, mnA, alA);
  SLOAD(SO, 1); if constexpr (SD == 2) { if (2 < NT) SLOAD(SE, 2); }
  SWAIT(); SWRITE(1, SO); __syncthreads();
  for (int j = 1; j + 1 < NT; j += 2) {
    SBAR(); qkt(pB0, pB1, (bf16_t*)((char*)K_lds + SHM_K), Q_lds, qrow, r32, hi); bias(pB0, pB1, j, wid, r32, hi);
    finishSM(pA0, pA1, alA, l_reg, pa0, pa1, pa2, pa3); SBAR();
    SLOAD(SO, j + SD); SBAR();
    pv_d0(o, vb0, pa0, pa1, pa2, pa3); partialSM(pB0, pB1, m_reg, mnB, alB);
    __syncthreads(); SWAIT(); SWRITE(0, SE);
    RESC(alB); __syncthreads();
    SBAR(); qkt(pA0, pA1, K_lds, Q_lds, qrow, r32, hi); bias(pA0, pA1, j + 1, wid, r32, hi);
    finishSM(pB0, pB1, alB, l_reg, pa0, pa1, pa2, pa3); SBAR();
    if (SD == 1 || j + 3 < NT) SLOAD(SE, j + 1 + SD); SBAR();
    pv_d0(o, vb0 + (int)SHM_V, pa0, pa1, pa2, pa3); partialSM(pA0, pA1, m_reg, mnA, alA);
    __syncthreads(); SWAIT(); SWRITE(1, SO);
    RESC(alA); __syncthreads();
  }
  SBAR(); qkt(pB0, pB1, (bf16_t*)((char*)K_lds + SHM_K), Q_lds, qrow, r32, hi); bias(pB0, pB1, NT - 1, wid, r32, hi);
  finishSM(pA0, pA1, alA, l_reg, pa0, pa1, pa2, pa3); SBAR();
  pv_d0(o, vb0, pa0, pa1, pa2, pa3); partialSM(pB0, pB1, m_reg, mnB, alB);
  __syncthreads(); RESC(alB);
  finishSM(pB0, pB1, alB, l_reg, pa0, pa1, pa2, pa3); SBAR();
  pv_d0(o, vb0 + (int)SHM_V, pa0, pa1, pa2, pa3);
  if (hi == 0) li_l[r32] = l_reg; asm volatile("s_waitcnt lgkmcnt(0)" ::: "memory");
  float rli[16];
#pragma unroll
  for (int r = 0; r < 16; ++r) rli[r] = __builtin_amdgcn_rcpf(li_l[crow(r, hi)]);
  bf16_t* Ow = Ob + (long)(wid * QBLK) * LDO;
#pragma unroll
  for (int r = 0; r < 16; ++r) { int orow = crow(r, hi);
    for (int d0 = 0; d0 < 4; ++d0) Ow[(long)orow * LDO + d0 * 32 + r32] = f2bf(o[d0][r] * rli[r]); }
#undef SLOAD
#undef SWRITE
#undef SWAIT
#undef RESC
}
}
#define H16(w, j) ((bf16_t)(((j) & 1) ? ((j) < 2 ? (w).x >> 16 : (w).y >> 16) : ((j) < 2 ? (w).x & 0xFFFFu : (w).y & 0xFFFFu)))
#define DPPU(v, ctrl, rmask) __int_as_float(__builtin_amdgcn_update_dpp(0, __float_as_int(v), (ctrl), (rmask), 0xF, false))
__device__ __forceinline__ float scan32(float x) { x += DPPU(x, 0x111, 0xF); x += DPPU(x, 0x112, 0xF); x += DPPU(x, 0x114, 0xF); x += DPPU(x, 0x118, 0xF); x += DPPU(x, 0x142, 0xA); return x; }
__device__ __forceinline__ float last32(float x, int lane) { const float a = __int_as_float(__builtin_amdgcn_readlane(__float_as_int(x), 31)), b = __int_as_float(__builtin_amdgcn_readlane(__float_as_int(x), 63)); return lane < 32 ? a : b; }
namespace gdn {
using att::bf16x8; using att::f32x16; using att::crow;
constexpr int C = 32, SK = 136, SS = 40;
constexpr int OFF_KT = 0, OFF_QT = OFF_KT + C * SK * 2, OFF_W = OFF_QT + C * SK * 2, OFF_KTT = OFF_W + C * SK * 2, OFF_VTT = OFF_KTT + 128 * SS * 2,
              OFF_VN = OFF_VTT + 128 * SS * 2, OFF_VNS = OFF_VN + 128 * SS * 2, OFF_ST = OFF_VNS + 128 * SS * 2, OFF_TB = OFF_ST + 128 * SK * 2,
              OFF_TBE = OFF_TB + C * SS * 2, OFF_ATT = OFF_TBE + C * SS * 2, OFF_L = OFF_ATT + C * SS * 2, OFF_SC = OFF_L + C * C * 4, GDN_LDS = OFF_SC + 1024;
template <int K>
__device__ __forceinline__ f32x16 mm(const bf16_t* A, int lda, const bf16_t* Bt, int ldb, int l32, int hi, f32x16 acc) {
#pragma unroll
    for (int k0 = 0; k0 < K; k0 += 16) {
        const bf16x8 a = *reinterpret_cast<const bf16x8*>(A + l32 * lda + k0 + 8 * hi);
        const bf16x8 b = *reinterpret_cast<const bf16x8*>(Bt + l32 * ldb + k0 + 8 * hi);
        acc = __builtin_amdgcn_mfma_f32_32x32x16_bf16(a, b, acc, 0, 0, 0);
    }
    return acc;
}
__device__ __forceinline__ uint2 pk4(float a, float b, float c, float d) { uint2 w; w.x = pack2(a, b); w.y = pack2(c, d); return w; }

__device__ __forceinline__ void gdn_chunked(const Params& p, int l, bool ctx, int b, int h, int dir, unsigned char* lds) {
    const int tid = opaque_tid(), wid = tid >> 6, lane = tid & 63, l32 = lane & 31, hi = lane >> 5;
    const int T = ctx ? CT : ::LT; const size_t m0 = ctx ? (size_t)b * CT : (size_t)MC + (size_t)b * ::LT;
    const bf16_t* DQ = WSP(bf16_t, WS_DQ); const bf16_t* DK = WSP(bf16_t, WS_DK); const bf16_t* DV = WSP(bf16_t, WS_DV); const float* DBA = WSP(float, WS_DBA);
    float* O = WSP(float, dir ? WS_DOB : WS_DOF);
    bf16_t* Kt = (bf16_t*)(lds + OFF_KT); bf16_t* Qt = (bf16_t*)(lds + OFF_QT); bf16_t* W = (bf16_t*)(lds + OFF_W); bf16_t* KT = (bf16_t*)(lds + OFF_KTT); bf16_t* VT = (bf16_t*)(lds + OFF_VTT);
    bf16_t* VN = (bf16_t*)(lds + OFF_VN); bf16_t* VNS = (bf16_t*)(lds + OFF_VNS); bf16_t* ST = (bf16_t*)(lds + OFF_ST); bf16_t* TB = (bf16_t*)(lds + OFF_TB); bf16_t* TBE = (bf16_t*)(lds + OFF_TBE);
    bf16_t* ATT = (bf16_t*)(lds + OFF_ATT); float* Lm = (float*)(lds + OFF_L); float* sc = (float*)(lds + OFF_SC);
    const int nch = T / C;
#define TOK(c, s_) (m0 + (dir ? T - 1 - ((c) * C + (s_)) : (c) * C + (s_)))
    f32x16 S[2];
#pragma unroll
    for (int bi = 0; bi < 2; ++bi) {
        const int blk = wid * 2 + bi, d0 = 32 * (blk >> 2), e0 = 32 * (blk & 3);
        if (ctx) { S[bi] = f32x16{}; }
        else {
            const float* s0 = p.in[I_SGDN] + ((((size_t)b * DEPTH + l) * 2 + dir) * 4 + h) * 128 * 128 + e0 + l32;
#pragma unroll
            for (int r = 0; r < 16; ++r) S[bi][r] = s0[(size_t)(d0 + crow(r, hi)) * 128];
        }
    }
    const int ts = tid & 31, c0 = (tid >> 5) * 4, c1 = 64 + c0;
    uint2 rq0, rq1, rk0, rk1, rv0, rv1; float pbeta = 0.f, pg = 0.f;
#define GLOAD(c) do { const size_t mt_ = TOK(c, ts); \
        rq0 = *(const uint2*)(DQ + mt_ * 512 + h * 128 + c0); rq1 = *(const uint2*)(DQ + mt_ * 512 + h * 128 + c1); \
        rk0 = *(const uint2*)(DK + mt_ * 512 + h * 128 + c0); rk1 = *(const uint2*)(DK + mt_ * 512 + h * 128 + c1); \
        rv0 = *(const uint2*)(DV + mt_ * 512 + h * 128 + c0); rv1 = *(const uint2*)(DV + mt_ * 512 + h * 128 + c1); \
        if (tid < C) { const size_t mt = TOK(c, tid); pbeta = DBA[mt * 16 + dir * 4 + h]; pg = DBA[mt * 16 + 8 + dir * 4 + h]; } } while (0)
#define GSTAGE() do { \
        *(uint2*)(Kt + ts * SK + c0) = rk0; *(uint2*)(Kt + ts * SK + c1) = rk1; \
        *(uint2*)(Qt + ts * SK + c0) = rq0; *(uint2*)(Qt + ts * SK + c1) = rq1; \
        _Pragma("unroll") for (int j = 0; j < 4; ++j) { KT[(c0 + j) * SS + ts] = H16(rk0, j); KT[(c1 + j) * SS + ts] = H16(rk1, j); \
                                                        VT[(c0 + j) * SS + ts] = H16(rv0, j); VT[(c1 + j) * SS + ts] = H16(rv1, j); } \
        if (wid == 0) { float x = pg; _Pragma("unroll") for (int o_ = 1; o_ < 32; o_ <<= 1) { const float y = __shfl_up(x, o_); if (lane >= o_) x += y; } \
            const float Bt_ = __shfl(x, 31); if (lane < C) { sc[lane] = pbeta; sc[32 + lane] = x; sc[64 + lane] = __expf(x); sc[96 + lane] = __expf(Bt_ - x); if (lane == 0) sc[128] = __expf(Bt_); } } } while (0)
    __syncthreads();
    GLOAD(0);
#pragma unroll
    for (int bi = 0; bi < 2; ++bi) {
        const int blk = wid * 2 + bi, d0 = 32 * (blk >> 2), e0 = 32 * (blk & 3);
#pragma unroll
        for (int g = 0; g < 4; ++g) *(uint2*)(ST + (e0 + l32) * SK + d0 + 8 * g + 4 * hi) = pk4(S[bi][4 * g], S[bi][4 * g + 1], S[bi][4 * g + 2], S[bi][4 * g + 3]);
    }
    GSTAGE();
    __syncthreads();
    for (int c = 0; c < nch; ++c) {
        if (c + 1 < nch) GLOAD(c + 1);
        f32x16 acc1 = f32x16{};
        if (wid == 0) {
            const f32x16 kk = mm<128>(Kt, SK, Kt, SK, l32, hi, f32x16{});
            const float bi_ = sc[32 + l32], be = sc[l32];
#pragma unroll
            for (int r = 0; r < 16; ++r) { const int j = crow(r, hi); const float v = (l32 > j) ? be * kk[r] * __expf(bi_ - sc[32 + j]) : 0.f;
                Lm[l32 * 32 + ((((r & 3) + 4 * hi) ^ (l32 & 7)) * 4) + (r >> 2)] = v; }
        } else if (wid == 1) {
            const f32x16 kq = mm<128>(Kt, SK, Qt, SK, l32, hi, f32x16{});
            const float bi_ = sc[32 + l32];
            float a[16];
#pragma unroll
            for (int r = 0; r < 16; ++r) { const int j = crow(r, hi); a[r] = (l32 >= j) ? kq[r] * __expf(bi_ - sc[32 + j]) : 0.f; }
#pragma unroll
            for (int g = 0; g < 4; ++g) *(uint2*)(ATT + l32 * SS + 8 * g + 4 * hi) = pk4(a[4 * g], a[4 * g + 1], a[4 * g + 2], a[4 * g + 3]);
        } else if (wid >= 4) {
            acc1 = mm<128>(Qt, SK, ST + (32 * (wid - 4)) * SK, SK, l32, hi, f32x16{});
#pragma unroll
            for (int r = 0; r < 16; ++r) acc1[r] *= sc[64 + crow(r, hi)];
        }
        __syncthreads();
        if (tid < 256) {
            const int cc = tid >> 3, part = tid & 7;
            float Tr[4] = {0.f, 0.f, 0.f, 0.f};
#pragma unroll
            for (int i = 0; i < 32; ++i) {
                const vf4 lv = *(const vf4*)(Lm + i * 32 + ((part ^ (i & 7)) * 4));
                float s = lv.x * Tr[0] + lv.y * Tr[1] + lv.z * Tr[2] + lv.w * Tr[3];
                s = red8(s);
                const float t = (i == cc ? 1.f : 0.f) - s;
                if (part == (i & 7)) Tr[i >> 3] = t;
            }
            const float bc = sc[cc], bec = bc * sc[64 + cc];
#pragma unroll
            for (int jj = 0; jj < 4; ++jj) { TB[(part + 8 * jj) * SS + cc] = f2bf(Tr[jj] * bc); TBE[(part + 8 * jj) * SS + cc] = f2bf(Tr[jj] * bec); }
        }
        __syncthreads();
        if (wid < 4) {
            acc1 = mm<32>(TB, SS, VT + (32 * wid) * SS, SS, l32, hi, f32x16{});
        } else {
            const int d0 = 32 * (wid - 4);
            const f32x16 wt = mm<32>(KT + d0 * SS, SS, TBE, SS, l32, hi, f32x16{});
#pragma unroll
            for (int g = 0; g < 4; ++g) *(uint2*)(W + l32 * SK + d0 + 8 * g + 4 * hi) = pk4(wt[4 * g], wt[4 * g + 1], wt[4 * g + 2], wt[4 * g + 3]);
        }
        __syncthreads();
        if (wid < 4) {
            const int e0 = 32 * wid;
            const f32x16 ws = mm<128>(W, SK, ST + e0 * SK, SK, l32, hi, f32x16{});
            float vn[16], vs[16];
#pragma unroll
            for (int r = 0; r < 16; ++r) { vn[r] = acc1[r] - ws[r]; vs[r] = vn[r] * sc[96 + crow(r, hi)]; }
#pragma unroll
            for (int g = 0; g < 4; ++g) { *(uint2*)(VN + (e0 + l32) * SS + 8 * g + 4 * hi) = pk4(vn[4 * g], vn[4 * g + 1], vn[4 * g + 2], vn[4 * g + 3]);
                                          *(uint2*)(VNS + (e0 + l32) * SS + 8 * g + 4 * hi) = pk4(vs[4 * g], vs[4 * g + 1], vs[4 * g + 2], vs[4 * g + 3]); }
        }
        __syncthreads();
        if (wid >= 4) {
            const int e0 = 32 * (wid - 4);
            acc1 = mm<32>(ATT, SS, VN + e0 * SS, SS, l32, hi, acc1);
#pragma unroll
            for (int r = 0; r < 16; ++r) O[TOK(c, crow(r, hi)) * 512 + h * 128 + e0 + l32] = acc1[r];
        }
        {
            const float eB = sc[128];
#pragma unroll
            for (int bi = 0; bi < 2; ++bi) {
                const int blk = wid * 2 + bi, d0 = 32 * (blk >> 2), e0 = 32 * (blk & 3);
#pragma unroll
                for (int r = 0; r < 16; ++r) S[bi][r] *= eB;
                S[bi] = mm<32>(KT + d0 * SS, SS, VNS + e0 * SS, SS, l32, hi, S[bi]);
            }
        }
        __syncthreads();
#pragma unroll
        for (int bi = 0; bi < 2; ++bi) {
            const int blk = wid * 2 + bi, d0 = 32 * (blk >> 2), e0 = 32 * (blk & 3);
#pragma unroll
            for (int g = 0; g < 4; ++g) *(uint2*)(ST + (e0 + l32) * SK + d0 + 8 * g + 4 * hi) = pk4(S[bi][4 * g], S[bi][4 * g + 1], S[bi][4 * g + 2], S[bi][4 * g + 3]);
        }
        if (c + 1 < nch) GSTAGE();
        __syncthreads();
    }
#undef GLOAD
#undef GSTAGE
#undef TOK
    if (ctx) {
#pragma unroll
        for (int bi = 0; bi < 2; ++bi) {
            const int blk = wid * 2 + bi, d0 = 32 * (blk >> 2), e0 = 32 * (blk & 3);
            float* so = p.out + O_SGDN + ((((size_t)b * DEPTH + l) * 2 + dir) * 4 + h) * 128 * 128 + e0 + l32;
#pragma unroll
            for (int r = 0; r < 16; ++r) so[(size_t)(d0 + crow(r, hi)) * 128] = S[bi][r];
        }
    }
}
}

namespace gla {
using att::bf16x8; using att::f32x16; using att::crow; using gdn::mm; using gdn::pk4;
constexpr int C = 32, SQ = 72, SS = 40;
constexpr int OFF_QE = 0, OFF_KN = OFF_QE + C * SQ * 2, OFF_KET = OFF_KN + C * SQ * 2, OFF_VT = OFF_KET + 64 * SS * 2, OFF_ATT = OFF_VT + 128 * SS * 2, OFF_ST = OFF_ATT + C * SS * 2,
              OFF_LA = OFF_ST + 128 * SQ * 2, OFF_EB = OFF_LA + C * 64 * 4, GLA_LDS = OFF_EB + 256;
__device__ __forceinline__ void gla_chunked(const Params& p, int l, bool ctx, int b, int h, int dir, unsigned char* lds) {
    const int tid = opaque_tid(), wid = tid >> 6, lane = tid & 63, l32 = lane & 31, hi = lane >> 5;
    const int T = ctx ? CT : ::LT; const size_t m0 = ctx ? (size_t)b * CT : (size_t)MC + (size_t)b * ::LT;
    const bf16_t* Z = WSP(bf16_t, WS_Z); const float* LA = WSP(float, dir ? WS_AB : WS_AF);
    float* O = WSP(float, dir ? WS_GOB : WS_GOF);
    bf16_t* Qe = (bf16_t*)(lds + OFF_QE); bf16_t* Kn = (bf16_t*)(lds + OFF_KN); bf16_t* KeT = (bf16_t*)(lds + OFF_KET); bf16_t* VT = (bf16_t*)(lds + OFF_VT);
    bf16_t* ATT = (bf16_t*)(lds + OFF_ATT); bf16_t* ST = (bf16_t*)(lds + OFF_ST); float* eB = (float*)(lds + OFF_EB);
    const int nch = T / C;
#define TOK(c, s_) (m0 + (dir ? T - 1 - ((c) * C + (s_)) : (c) * C + (s_)))
    const int d0 = 32 * (wid >> 2), e0 = 32 * (wid & 3);
    f32x16 S;
    if (ctx) S = f32x16{};
    else {
        const float* s0 = p.in[I_SGLA] + ((((size_t)b * DEPTH + l) * 2 + dir) * 4 + h) * 64 * 128 + e0 + l32;
#pragma unroll
        for (int r = 0; r < 16; ++r) S[r] = s0[(size_t)(d0 + crow(r, hi)) * 128];
    }
    const int ts = tid & 31, dc = (tid >> 5) * 4, vc0 = dc, vc1 = 64 + dc;
    uint2 rq, rk, rv0, rv1; vf4 pl;
#define GLOAD(c) do { const size_t mt = TOK(c, ts); \
        rq = *(const uint2*)(Z + mt * NINP + Z_GLQ + h * 64 + dc); rk = *(const uint2*)(Z + mt * NINP + Z_GLK + h * 64 + dc); pl = *(const vf4*)(LA + mt * 256 + h * 64 + dc); \
        rv0 = *(const uint2*)(Z + mt * NINP + Z_GLV + h * 128 + vc0); rv1 = *(const uint2*)(Z + mt * NINP + Z_GLV + h * 128 + vc1); } while (0)
#define WRITE_ST() do { _Pragma("unroll") for (int g = 0; g < 4; ++g) *(uint2*)(ST + (e0 + l32) * SQ + d0 + 8 * g + 4 * hi) = pk4(S[4 * g], S[4 * g + 1], S[4 * g + 2], S[4 * g + 3]); } while (0)
#define GIMAGES() do { vf4 pre, tot; const vf4 pq = unp4bf(rq), pk = unp4bf(rk); \
        _Pragma("unroll") for (int j = 0; j < 4; ++j) { pre[j] = scan32(pl[j]); tot[j] = last32(pre[j], lane); } \
        float qe[4], kn[4]; \
        _Pragma("unroll") for (int j = 0; j < 4; ++j) { qe[j] = pq[j] * 0.125f * __expf(pre[j]); kn[j] = pk[j] * __expf(fminf(-pre[j], 80.f)); \
            KeT[(dc + j) * SS + ts] = f2bf(pk[j] * __expf(tot[j] - pre[j])); } \
        *(uint2*)(Qe + ts * SQ + dc) = pk4(qe[0], qe[1], qe[2], qe[3]); *(uint2*)(Kn + ts * SQ + dc) = pk4(kn[0], kn[1], kn[2], kn[3]); \
        if (ts == 0) { _Pragma("unroll") for (int j = 0; j < 4; ++j) eB[dc + j] = __expf(tot[j]); } \
        _Pragma("unroll") for (int j = 0; j < 4; ++j) { VT[(vc0 + j) * SS + ts] = H16(rv0, j); VT[(vc1 + j) * SS + ts] = H16(rv1, j); } } while (0)
    __syncthreads();
    GLOAD(0);
    WRITE_ST();
    GIMAGES();
    __syncthreads();
    for (int c = 0; c < nch; ++c) {
        if (c + 1 < nch) GLOAD(c + 1);
        f32x16 o1 = f32x16{};
        if (wid == 0) {
            const f32x16 kq = mm<64>(Kn, SQ, Qe, SQ, l32, hi, f32x16{});
            float a[16];
#pragma unroll
            for (int r = 0; r < 16; ++r) a[r] = (l32 >= crow(r, hi)) ? kq[r] : 0.f;
#pragma unroll
            for (int g = 0; g < 4; ++g) *(uint2*)(ATT + l32 * SS + 8 * g + 4 * hi) = pk4(a[4 * g], a[4 * g + 1], a[4 * g + 2], a[4 * g + 3]);
        } else if (wid >= 4) {
            o1 = mm<64>(Qe, SQ, ST + (32 * (wid - 4)) * SQ, SQ, l32, hi, f32x16{});
        }
        __syncthreads();
        if (wid >= 4) {
            const int eo = 32 * (wid - 4);
            o1 = mm<32>(ATT, SS, VT + eo * SS, SS, l32, hi, o1);
#pragma unroll
            for (int r = 0; r < 16; ++r) O[TOK(c, crow(r, hi)) * 512 + h * 128 + eo + l32] = o1[r];
        }
#pragma unroll
        for (int r = 0; r < 16; ++r) S[r] *= eB[d0 + crow(r, hi)];
        S = mm<32>(KeT + d0 * SS, SS, VT + e0 * SS, SS, l32, hi, S);
        __syncthreads();
        WRITE_ST();
        if (c + 1 < nch) GIMAGES();
#ifdef GLA_DUP_IMAGES
        __syncthreads(); if (c + 1 < nch) GIMAGES();
#endif
        __syncthreads();
    }
#undef GLOAD
#undef WRITE_ST
#undef GIMAGES
#undef TOK
    if (ctx) {
        float* so = p.out + O_SGLA + ((((size_t)b * DEPTH + l) * 2 + dir) * 4 + h) * 64 * 128 + e0 + l32;
#pragma unroll
        for (int r = 0; r < 16; ++r) so[(size_t)(d0 + crow(r, hi)) * 128] = S[r];
    }
}
}
#define LAS __attribute__((address_space(3)))
constexpr int LDS_BYTES = 147456, XBW_OFF = LDS_BYTES - 64;
constexpr int NPH = 1 + DEPTH * 12;
#ifndef DBG_NLAYERS
#define DBG_NLAYERS DEPTH
#endif

#ifndef DUPKIND
#define DUPKIND 0
#endif
__device__ __forceinline__ int opaque_int(int v) { asm volatile("" : "+s"(v)); return v; }
#ifndef MIXMASK
#define MIXMASK 0xFF
#endif
#define FOR_ITEMS(it, n, o, w) for (int bo_ = (o) * (int)gridDim.x / 256, bw_ = ((w) * (int)gridDim.x / 256) > 0 ? ((w) * (int)gridDim.x / 256) : 1, \
                                    it = ((int)blockIdx.x >= bo_ && (int)blockIdx.x < bo_ + bw_) ? (int)blockIdx.x - bo_ : (n); it < (n); it += bw_)

constexpr int TF0 = NT_L / 10, TF1 = NT_L / 4, TF2 = NT_L * 53 / 100, TF3 = NT_L * 88 / 100, MIXCONV_CH = 16, NI_CONV = (TF3 - TF2 + MIXCONV_CH - 1) / MIXCONV_CH;
#ifndef SPLITK
#define SPLITK 0
#endif
#ifndef SPLITK_G4
#define SPLITK_G4 0
#endif
constexpr int FLAG_WORD0 = 8192;
constexpr int QCTR_WORD0 = 1024;
constexpr int NI_GDNL = LB * 8, NI_GLAL = LB * 8, NI_GDNC = CB * 8, NI_GQAL = LB * 16, NI_NAL = LB * 16, NI_GLAC = CB * 8, NI_NAC = CB * 4, NI_GQAC = CB * 4;
#define KM(k) (1 + ((DUPKIND >> (k)) & 1))
constexpr int Q0 = NI_GDNL * KM(0), Q1 = Q0 + NI_GQAL * KM(1), Q2 = Q1 + NI_NAL * KM(2), Q3 = Q2 + NI_GLAL * KM(3), Q4 = Q3 + NI_GDNC * KM(4), Q5 = Q4 + NI_NAC * KM(5), Q6 = Q5 + NI_GQAC * KM(6), Q7 = Q6 + NI_GLAC * KM(7);
__device__ __forceinline__ void phase_mix(const Params& p, int l, unsigned char* lds, int rep) {
    const int tid = opaque_tid();
    float* smem = (float*)lds;
    const bf16_t* NAQ = WSP(bf16_t, WS_NAQ); const bf16_t* NAK = WSP(bf16_t, WS_NAK); const bf16_t* NAV = WSP(bf16_t, WS_NAV);
    const bf16_t* GQ = WSP(bf16_t, WS_GQ); const bf16_t* GK = WSP(bf16_t, WS_GK); const bf16_t* GV = WSP(bf16_t, WS_GV);
    bf16_t* MRG = WSP(bf16_t, WS_MRG);
    unsigned* qctr = WSP(unsigned, WS_CTL) + QCTR_WORD0 + 64 * l + 16 * rep;
    volatile int* qslot = (volatile int*)(lds + XBW_OFF + 16);
    for (;;) {
        __syncthreads();
        if (tid == 0) *qslot = (int)__hip_atomic_fetch_add(qctr, 1u, __ATOMIC_RELAXED, __HIP_MEMORY_SCOPE_AGENT);
        __syncthreads();
        const int q = __builtin_amdgcn_readfirstlane(*qslot);
        if (q >= Q7 + ((CONV_FILLER && l + 1 < DBG_NLAYERS) ? NI_CONV : 0)) break;
        if (q < Q0) { const int it = q % NI_GDNL; gdn::gdn_chunked(p, l, false, it / 8, (it / 2) % 4, it % 2, lds); }
        else if (q < Q1) {
            const int it = (q - Q0) % NI_GQAL, b = it / 16, qh = (it / 4) % 4, qb = it % 4, kvh = qh >> 1;
            const size_t r0 = (size_t)MC + (size_t)b * LT;
            att::SrcTwo src{WSP(bf16_t, WS_CGK) + ((size_t)b * DEPTH + l) * 256 * 256 + kvh * 128, WSP(bf16_t, WS_CGV) + ((size_t)b * DEPTH + l) * 256 * 256 + kvh * 128,
                            GK + r0 * 256 + kvh * 128, GV + r0 * 256 + kvh * 128, 256};
            att::attn_body<2>(GQ + (r0 + qb * 256) * 512 + qh * 128, src, MRG + (r0 + qb * 256) * DM + 1024 + qh * 128, 4 + LT / 64, (char*)lds, att::NoBias{});
        }
        else if (q < Q2) {
            const int it = (q - Q1) % NI_NAL, b = it / 16, h = (it / 4) % 4, qb = it % 4;
            const int kr0 = qb == 0 ? 0 : qb == 1 ? 0 : qb == 2 ? 4 : 8, nrows = (qb == 0 || qb == 3) ? 8 : 12;
            const size_t r0 = (size_t)MC + (size_t)b * LT;
            float* tab = (float*)(lds + att::SHM_ATTN);
            if (tid < 15 * 31) tab[tid] = p.in[I_RPB][((size_t)l * 4 + h) * 15 * 31 + tid] * (1.0f / att::SCALE);
            att::SrcTwo src{WSP(bf16_t, WS_CNAK) + ((size_t)b * DEPTH + l) * 256 * 512 + h * 128, WSP(bf16_t, WS_CNAV) + ((size_t)b * DEPTH + l) * 256 * 512 + h * 128,
                            NAK + (r0 + kr0 * 64) * 512 + h * 128, NAV + (r0 + kr0 * 64) * 512 + h * 128, 512};
            att::attn_body<1>(NAQ + (r0 + qb * 256) * 512 + h * 128, src, MRG + (r0 + qb * 256) * DM + 0 + h * 128, 4 + nrows, (char*)lds, att::NaBias{tab, qb * 256, kr0});
        }
        else if (q < Q3) { const int it = (q - Q2) % NI_GLAL;
#ifdef GLA_REP
            for (int r_ = 0, n_ = opaque_int(GLA_REP); r_ < n_; ++r_)
#endif
            gla::gla_chunked(p, l, false, it / 8, (it / 2) % 4, it % 2, lds); }
        else if (q < Q4) { const int it = (q - Q3) % NI_GDNC; gdn::gdn_chunked(p, l, true, it / 8, (it / 2) % 4, it % 2, lds); }
        else if (q < Q5) {
            const int it = (q - Q4) % NI_NAC, b = it / 4, h = it % 4; const size_t r0 = (size_t)b * CT;
            att::SrcOne src{NAK + r0 * 512 + h * 128, NAV + r0 * 512 + h * 128, 512};
            att::attn_body<2>(NAQ + r0 * 512 + h * 128, src, MRG + r0 * DM + 0 + h * 128, CT / 64, (char*)lds, att::NoBias{});
        }
        else if (q < Q6) {
            const int it = (q - Q5) % NI_GQAC, b = it / 4, qh = it % 4, kvh = qh >> 1; const size_t r0 = (size_t)b * CT;
            att::SrcOne src{GK + r0 * 256 + kvh * 128, GV + r0 * 256 + kvh * 128, 256};
            att::attn_body<2>(GQ + r0 * 512 + qh * 128, src, MRG + r0 * DM + 1024 + qh * 128, CT / 64, (char*)lds, att::NoBias{});
        }
        else if (q < Q7) { const int it = (q - Q6) % NI_GLAC; gla::gla_chunked(p, l, true, it / 8, (it / 2) % 4, it % 2, lds); }
        else { const int t0 = TF2 + (q - Q7) * MIXCONV_CH, t1 = t0 + MIXCONV_CH < TF3 ? t0 + MIXCONV_CH : TF3; conv_layer_tiles(p, l + 1, t0, t1, 0, 1, (float*)lds); }
    }
}

#define CONV_FILL(nunits, t0, t1, skip) do { if (l + 1 < DBG_NLAYERS) { const int G_ = (int)gridDim.x; int f0_ = ((nunits) % G_) + (skip); if (f0_ >= G_) f0_ = 0; \
        if ((int)blockIdx.x >= f0_) { const Params q = opaque_params(p); conv_layer_tiles(q, l + 1, (t0), (t1), (int)blockIdx.x - f0_, G_ - f0_, (float*)lds); } } } while (0)
#define G1A_MSPLIT (G1A_MODE == 1 ? 2 : 0)
#define G1B_MSPLIT (G1B_MODE == 1 ? 2 : 0)
#ifndef MSPLIT
#define MSPLIT 2
#endif
static_assert(att::SHM_ATTN + 15 * 31 * 4 + 2048 <= (size_t)XBW_OFF, "LDS map");
static_assert((QCTR_WORD0 + 64 * DEPTH) < 4096, "ctl");
constexpr int BAR_WORD0 = 4096;
static_assert((BAR_WORD0 + XCD_BAR_WORDS) * 4 <= (int)CTL_BYTES, "ctl");

__global__ void __launch_bounds__(512, 2) fwd(Params p) {
    extern __shared__ __attribute__((aligned(16))) unsigned char lds[];
    const int tid = threadIdx.x;
    volatile LAS unsigned* xbw = (volatile LAS unsigned*)((LAS unsigned char*)lds + XBW_OFF);
    if (tid < 4) xbw[tid] = 0u;
    __syncthreads();
    XcdBarrier bar; bar.bar = WSP(unsigned, WS_CTL) + BAR_WORD0; bar.x = 0; bar.st = xbw;
    if (p.ph_hi - p.ph_lo > 1) bar = xcd_barrier_post(WSP(unsigned, WS_CTL) + BAR_WORD0, xbw);
#ifndef PHMASK
#define PHMASK 0x1FFF
#endif
#define IN(k) (p.ph_lo <= (k) && (k) < p.ph_hi)
#define INL(j) (((PHMASK >> ((j) + 1)) & 1) && IN(pb + (j)))
#ifndef DUPMASK
#define DUPMASK 0
#endif
#define DUP(j) ((DUPMASK >> ((j) + 1)) & 1)
#if DUPMASK
#define REPS(j) opaque_int(1 + DUP(j))
#else
#define REPS(j) 1
#endif
#ifndef DBLBAR
#define DBLBAR 0
#endif
#ifdef DIAG_KIND
#ifndef DIAG_SCALE
#define DIAG_SCALE 0.01f
#endif
    unsigned long long dg_sum = 0ull, dg_prev = wall_clock64();
#define DIAG_AT(k) do { const unsigned long long now_ = wall_clock64(); if ((DIAG_KIND >> (((k) == 0) ? 12 : (((k) - 1) % 12))) & 1) dg_sum += now_ - dg_prev; dg_prev = now_; } while (0)
#else
#define DIAG_AT(k) do { } while (0)
#endif
#define SEAM(k) do { if (IN(k) && IN((k) + 1)) { xcd_barrier(bar); if (DBLBAR) xcd_barrier(bar); } DIAG_AT(k); } while (0)
    LAS unsigned char* ldsl = (LAS unsigned char*)lds;
    bf16_t* H = WSP(bf16_t, WS_H); bf16_t* ACT = WSP(bf16_t, WS_ACT); float* X = WSP(float, WS_X); float* Z = WSP(float, WS_Z); bf16_t* MRG = WSP(bf16_t, WS_MRG);

    if ((PHMASK & 1) && IN(0)) { const int reps_ = (DUPMASK & 1) ? opaque_int(2) : 1; for (int rep_ = 0; rep_ < reps_; ++rep_) { const Params q = opaque_params(p); phase_prologue(q, (float*)lds); __syncthreads(); } }
    SEAM(0);
    for (int l = 0; l < DBG_NLAYERS; ++l) {
        const int pb = 1 + l * 12;
        const float* modl = WSP(float, WS_MODV) + (size_t)l * NCOND * NMOD;
        if (INL(0)) { const int reps_ = REPS(0); for (int rep_ = 0; rep_ < reps_; ++rep_) { const Params q = opaque_params(p); phase_norm(q, l, 0, lds); __syncthreads(); } }
        SEAM(pb + 0);
        if (INL(1)) {
            if (g1_fp8(l, 0)) {
                pg8::Gemm g{H, (const bf16_t*)(WSP(unsigned char, WS_WGU) + ((size_t)l * 2 + 0) * NGU * DM * 2), M, NGU, DM / 2}; pg8::StaticOrder S; S.init(M, NGU, DM / 2, (int)gridDim.x, (int)blockIdx.x, 2);
                pg8::EpiSwiGLU8 E{WSP(unsigned char, WS_ACT), FFP, 1.0f / WGU_SCALE};
                for (int r_ = 0, n_ = REPS(1); r_ < n_; ++r_) pg8::gemm_phase<pg8::EpiSwiGLU8, pg8::StaticOrder, false, 1>(ldsl, g, S, E, nullptr);
            } else {
                pg8::Gemm g{H, WSP(bf16_t, WS_WGU) + ((size_t)l * 2 + 0) * NGU * DM, M, NGU, DM}; pg8::StaticOrder S; S.init(M, NGU, DM, (int)gridDim.x, (int)blockIdx.x, 0);
                pg8::EpiSwiGLU8 E{WSP(unsigned char, WS_ACT), FFP, 1.0f};
                for (int r_ = 0, n_ = REPS(1); r_ < n_; ++r_) pg8::gemm_phase<pg8::EpiSwiGLU8, pg8::StaticOrder, false, 0>(ldsl, g, S, E, nullptr);
            }
#if CONV_FILLER
            if (l + 1 < DBG_NLAYERS) {
                const int nw_ = (M / 256) * (NGU / 256), G_ = (int)gridDim.x; int f0_ = nw_ % G_; if (nw_ < G_) f0_ = 0;
                if (g1_fp8(l, 0)) f0_ = 2 * f0_ < G_ ? 2 * f0_ : f0_;
                const int nmb_ = (G_ - f0_ < NMOD / 128) ? (G_ - f0_) : NMOD / 128;
                if ((int)blockIdx.x >= f0_ && (int)blockIdx.x < f0_ + nmb_) { const Params q = opaque_params(p); mod_layer(q, l + 1, (int)blockIdx.x - f0_, nmb_, (float*)lds); }
            }
            CONV_FILL((M / 256) * (NGU / 256), 0, TF0, NMOD / 128 + (g1_fp8(l, 0) ? ((M / 256) * (NGU / 256)) % (int)gridDim.x : 0));
#endif
        }
        SEAM(pb + 1);
        if (INL(2)) {
            pg8::Gemm g{ACT, G2_FP8 ? (const bf16_t*)(WSP(unsigned char, WS_WDN) + ((size_t)l * 2 + 0) * DM * FFP) : WSP(bf16_t, WS_WDN) + ((size_t)l * 2 + 0) * DM * FF, M, DM, G2_FP8 ? FFP / 2 : FF}; pg8::StaticOrder S; S.init(M, DM, G2_FP8 ? FFP / 2 : FF, (int)gridDim.x, (int)blockIdx.x, SPLITK ? 1 : MSPLIT);
            pg8::EpiResid E{l == 0 ? p.in[I_XP] : X, X, DM, modl + 2 * DM, G2_FP8 ? 0.5f / WDN_SCALE : 0.5f, Z, WSP(unsigned, WS_CTL) + FLAG_WORD0, 8u * (unsigned)(l * (2 * SPLITK + SPLITK_G4) + SPLITK), l == 0 ? p.in[I_XS] : X, l == 0 ? MC : 0x7FFFFFFF, (XBF16 && l != 0), XBF16};
            pg8::gemm_phase<pg8::EpiResid, pg8::StaticOrder, false, (G2_FP8 ? 1 : 0)>(ldsl, g, S, E, nullptr);
#if DUPMASK
            if (opaque_int(DUP(2))) { pg8::EpiResid E2{l == 0 ? p.in[I_XP] : X, Z, DM, modl + 2 * DM, G2_FP8 ? 0.5f / WDN_SCALE : 0.5f, Z, WSP(unsigned, WS_CTL) + FLAG_WORD0, 0u, l == 0 ? p.in[I_XS] : X, l == 0 ? MC : 0x7FFFFFFF, 0, 0}; pg8::gemm_phase<pg8::EpiResid, pg8::StaticOrder, false, (G2_FP8 ? 1 : 0)>(ldsl, g, S, E2, nullptr); }
#endif
        }
        SEAM(pb + 2);
        if (INL(3)) { const int reps_ = REPS(3); for (int rep_ = 0; rep_ < reps_; ++rep_) { const Params q = opaque_params(p); phase_norm(q, l, 1, lds); __syncthreads(); } }
        SEAM(pb + 3);
        if (INL(4)) {
            pg8::Gemm g{H, WSP(bf16_t, WS_WIN) + (size_t)l * NINP * DM, M, NINP, DM}; pg8::StaticOrder S; S.init(M, NINP, DM, (int)gridDim.x, (int)blockIdx.x);
            pg8::EpiBf16Plain E{WSP(bf16_t, WS_Z), NINP};
            for (int r_ = 0, n_ = REPS(4); r_ < n_; ++r_) pg8::gemm_phase<pg8::EpiBf16Plain, pg8::StaticOrder, false>(ldsl, g, S, E, nullptr);
#if CONV_FILLER
            CONV_FILL((M / 256) * (NINP / 256), TF0, TF1, 0);
#endif
        }
        SEAM(pb + 4);
        if (INL(5)) { const int reps_ = REPS(5); for (int rep_ = 0; rep_ < reps_; ++rep_) { const Params q = opaque_params(p); phase_prep(q, l, lds); __syncthreads(); } }
        SEAM(pb + 5);
        if (INL(6)) { const int reps_ = REPS(6); for (int rep_ = 0; rep_ < reps_; ++rep_) { const Params q = opaque_params(p); phase_mix(q, l, lds, rep_); __syncthreads(); } }
        SEAM(pb + 6);
        if (INL(7)) { const int reps_ = REPS(7); for (int rep_ = 0; rep_ < reps_; ++rep_) { const Params q = opaque_params(p); phase_post(q, l); __syncthreads(); } }
        SEAM(pb + 7);
        if (INL(8)) {
            pg8::Gemm g{MRG, WSP(bf16_t, WS_WOUT) + (size_t)l * DM * DM, M, DM, DM}; pg8::StaticOrder S; S.init(M, DM, DM, (int)gridDim.x, (int)blockIdx.x, SPLITK_G4);
            pg8::EpiResid E{X, X, DM, modl + 5 * DM, 1.0f, Z, WSP(unsigned, WS_CTL) + FLAG_WORD0, 8u * (unsigned)(l * (2 * SPLITK + SPLITK_G4) + SPLITK + SPLITK_G4), X, 0x7FFFFFFF, XBF16, XBF16};
            pg8::gemm_phase<pg8::EpiResid, pg8::StaticOrder, false>(ldsl, g, S, E, nullptr);
#if CONV_FILLER
            CONV_FILL((M / 256) * (DM / 256), TF1, TF2, 0);
#endif
#if DUPMASK
            if (opaque_int(DUP(8))) { pg8::EpiResid E2{X, Z, DM, modl + 5 * DM, 1.0f, Z, WSP(unsigned, WS_CTL) + FLAG_WORD0, 0u, X, 0x7FFFFFFF, 0, 0}; pg8::gemm_phase<pg8::EpiResid, pg8::StaticOrder, false>(ldsl, g, S, E2, nullptr); }
#endif
        }
        SEAM(pb + 8);
        if (INL(9)) { const int reps_ = REPS(9); for (int rep_ = 0; rep_ < reps_; ++rep_) { const Params q = opaque_params(p); phase_norm(q, l, 2, lds); __syncthreads(); } }
        SEAM(pb + 9);
        if (INL(10)) {
            {
#if G1B_MODE
                pg8::Gemm g{H, (const bf16_t*)(WSP(unsigned char, WS_WGU) + ((size_t)l * 2 + 1) * NGU * DM * 2), M, NGU, DM / 2}; pg8::StaticOrder S; S.init(M, NGU, DM / 2, (int)gridDim.x, (int)blockIdx.x, G1B_MSPLIT);
                constexpr float ws_ = 1.0f / WGU_SCALE;
#else
                pg8::Gemm g{H, WSP(bf16_t, WS_WGU) + ((size_t)l * 2 + 1) * NGU * DM, M, NGU, DM}; pg8::StaticOrder S; S.init(M, NGU, DM, (int)gridDim.x, (int)blockIdx.x, G1B_MSPLIT);
                constexpr float ws_ = 1.0f;
#endif
#if G2_FP8
                pg8::EpiSwiGLU8 E{WSP(unsigned char, WS_ACT), FFP, ws_};
                for (int r_ = 0, n_ = REPS(10); r_ < n_; ++r_) pg8::gemm_phase<pg8::EpiSwiGLU8, pg8::StaticOrder, false, G1B_MODE>(ldsl, g, S, E, nullptr);
#else
                pg8::EpiSwiGLU E{ACT, FF};
                pg8::gemm_phase<pg8::EpiSwiGLU, pg8::StaticOrder, false, G1B_MODE>(ldsl, g, S, E, nullptr);
#endif
            }
#if CONV_FILLER
            CONV_FILL((M / 256) * (NGU / 256), TF3, NT_L, (G1B_MSPLIT ? ((M / 256) * (NGU / 256)) % (int)gridDim.x : 0));
#endif
        }
        SEAM(pb + 10);
        if (INL(11)) {
            pg8::Gemm g{ACT, G2_FP8 ? (const bf16_t*)(WSP(unsigned char, WS_WDN) + ((size_t)l * 2 + 1) * DM * FFP) : WSP(bf16_t, WS_WDN) + ((size_t)l * 2 + 1) * DM * FF, M, DM, G2_FP8 ? FFP / 2 : FF}; pg8::StaticOrder S; S.init(M, DM, G2_FP8 ? FFP / 2 : FF, (int)gridDim.x, (int)blockIdx.x, SPLITK ? 1 : MSPLIT);
            pg8::EpiResid E{X, (l == DEPTH - 1) ? p.out : X, DM, modl + 8 * DM, G2_FP8 ? 0.5f / WDN_SCALE : 0.5f, Z, WSP(unsigned, WS_CTL) + FLAG_WORD0, 8u * (unsigned)(l * (2 * SPLITK + SPLITK_G4) + 2 * SPLITK + SPLITK_G4), X, 0x7FFFFFFF, XBF16, (XBF16 && l != DEPTH - 1)};
            pg8::gemm_phase<pg8::EpiResid, pg8::StaticOrder, false, (G2_FP8 ? 1 : 0)>(ldsl, g, S, E, nullptr);
        }
        SEAM(pb + 11);
    }
#ifdef DIAG_KIND
    xcd_barrier(bar);
    if (blockIdx.x == 0 && threadIdx.x == 0) p.out[0] += (float)dg_sum * 0.01f * DIAG_SCALE;
#endif
#undef IN
#undef SEAM
}

#ifndef MULTI_LAUNCH
#define MULTI_LAUNCH 0
#endif
extern "C" void kernel_launch(void* const* d_in, const int* in_sizes, int n_in, void* d_out, int out_size, void* d_ws, size_t ws_size, hipStream_t stream) {
    static int grid = 0;
    if (grid == 0) {
        if (n_in != N_IN || (size_t)out_size != O_END || ws_size < WS_END) { fprintf(stderr, "kernel_launch: shape mismatch n_in %d out %d ws %zu (need %zu)\n", n_in, out_size, ws_size, (size_t)WS_END); grid = -1; return; }
        int dev = 0, cus = 0, per_cu = 0;
        if (hipGetDevice(&dev) != hipSuccess || hipDeviceGetAttribute(&cus, hipDeviceAttributeMultiprocessorCount, dev) != hipSuccess) { grid = -1; return; }
        if (hipFuncSetAttribute((const void*)fwd, hipFuncAttributeMaxDynamicSharedMemorySize, LDS_BYTES) != hipSuccess) { fprintf(stderr, "kernel_launch: hipFuncSetAttribute failed\n"); grid = -1; return; }
        if (hipOccupancyMaxActiveBlocksPerMultiprocessor(&per_cu, (const void*)fwd, 512, LDS_BYTES) != hipSuccess || per_cu < 1) { fprintf(stderr, "kernel_launch: occupancy query says %d\n", per_cu); (void)hipGetLastError(); }
        grid = cus;
    }
    if (grid < 0) return;
    (void)hipMemsetAsync((char*)d_ws + WS_CTL, 0, CTL_BYTES, stream);
    Params p{};
    for (int i = 0; i < N_IN; ++i) p.in[i] = (const float*)d_in[i];
    p.out = (float*)d_out; p.ws = (unsigned char*)d_ws;
#if MULTI_LAUNCH
    for (int ph = 0; ph < 1 + DBG_NLAYERS * 12; ++ph) { p.ph_lo = ph; p.ph_hi = ph + 1; hipLaunchKernelGGL(fwd, dim3(grid), dim3(512), LDS_BYTES, stream, p); }
#else
    p.ph_lo = 0; p.ph_hi = NPH; hipLaunchKernelGGL(fwd, dim3(grid), dim3(512), LDS_BYTES, stream, p);
#endif
    const hipError_t le = hipPeekAtLastError();
    if (le != hipSuccess) fprintf(stderr, "kernel_launch: launch failed: %s\n", hipGetErrorName(le));
}
```

```cpp
#include <hip/hip_runtime.h>
#include <cstdio>
#include <cstdint>

#ifndef CB_
#define CB_ 16
#endif
#ifndef LB_
#define LB_ 8
#endif
#ifndef DEPTH_
#define DEPTH_ 4
#endif
#ifndef G1A_LAYERS
#define G1A_LAYERS 0xC
#endif
#ifndef G1A_MODE
#define G1A_MODE 0
#endif
#ifndef G1B_MODE
#define G1B_MODE 1
#endif
#ifndef XBF16
#define XBF16 0
#endif
#ifndef G2_FP8
#define G2_FP8 1
#endif
#ifndef FFN_FP8
#define FFN_FP8 (G1A_MODE != 0 || G1B_MODE != 0 || G2_FP8 != 0)
#endif
constexpr int DM = 2048, DEPTH = DEPTH_, CB = CB_, CT = 256, LB = LB_, LT = 1024;
constexpr int MC = CB * CT, ML = LB * LT, M = MC + ML;
constexpr int FF = 5504, NGU = 2 * FF, NIN = 6192, NINP = 6400, NMOD = 9 * DM, NCOND = 1 + LB;
constexpr float EPS = 1e-6f;
constexpr int FFP = 5632;
constexpr float WGU_SCALE = 32.0f, WDN_SCALE = 64.0f;
constexpr int Z_NAQ = 0, Z_NAK = 512, Z_NAV = 1024, Z_GLQ = 1536, Z_GLK = 1792, Z_GLV = 2048, Z_GLR = 2560, Z_GF = 3072, Z_GB = 3088,
              Z_GQQ = 3104, Z_GQK = 3616, Z_GQV = 3872, Z_DQKV = 4128, Z_DZ = 5664, Z_DB = 6176, Z_DA = 6184;
static_assert(Z_DA + 8 == NIN, "split");
enum { I_XP = 0, I_XS, I_CNAK, I_CNAV, I_CGK, I_CGV, I_SGLA, I_SGDN, I_C, I_CCTX, I_NORMG, I_WMOD, I_BMOD, I_GU, I_DOWN, I_WIN, I_WOUT, I_NAQKN, I_RPB,
       I_GUP, I_GBIAS, I_GLAON, I_GQAQKN, I_CONV, I_ALOG, I_DTB, I_GDNON, N_IN };
constexpr size_t O_YP = 0, O_YS = O_YP + (size_t)MC * DM, O_NAK = O_YS + (size_t)ML * DM, O_NAV = O_NAK + (size_t)CB * DEPTH * 4 * CT * 128,
                 O_GK = O_NAV + (size_t)CB * DEPTH * 4 * CT * 128, O_GV = O_GK + (size_t)CB * DEPTH * 2 * CT * 128,
                 O_SGLA = O_GV + (size_t)CB * DEPTH * 2 * CT * 128, O_SGDN = O_SGLA + (size_t)CB * DEPTH * 2 * 4 * 64 * 128,
                 O_END = O_SGDN + (size_t)CB * DEPTH * 2 * 4 * 128 * 128;
constexpr size_t al256(size_t x) { return (x + 255) & ~(size_t)255; }
constexpr size_t WS_CTL = 0, CTL_BYTES = 1u << 20;
constexpr size_t WS_WGU = CTL_BYTES;
constexpr size_t WS_WDN = WS_WGU + (size_t)DEPTH * 2 * NGU * DM * 2;
constexpr size_t WS_WIN = WS_WDN + (size_t)DEPTH * 2 * DM * FF * 2;
constexpr size_t WS_WOUT = WS_WIN + (size_t)DEPTH * NINP * DM * 2;
constexpr size_t WS_MODV = WS_WOUT + (size_t)DEPTH * DM * DM * 2;
constexpr size_t WS_ROPE = al256(WS_MODV + (size_t)DEPTH * NCOND * NMOD * 4);
constexpr size_t WS_X = al256(WS_ROPE + 2 * 64 * 32 * 4);
constexpr size_t WS_H = WS_X + (size_t)M * DM * 4;
constexpr size_t WS_ACT = WS_H + (size_t)M * DM * 2;
constexpr size_t WS_Z = WS_ACT + (size_t)M * FF * 2;
constexpr size_t WS_MRG = WS_Z + (size_t)M * NINP * 4;
constexpr size_t WS_NAQ = WS_MRG + (size_t)M * DM * 2;
constexpr size_t WS_NAK = WS_NAQ + (size_t)M * 512 * 2;
constexpr size_t WS_NAV = WS_NAK + (size_t)M * 512 * 2;
constexpr size_t WS_GQ = WS_NAV + (size_t)M * 512 * 2;
constexpr size_t WS_GK = WS_GQ + (size_t)M * 512 * 2;
constexpr size_t WS_GV = WS_GK + (size_t)M * 256 * 2;
constexpr size_t WS_CNAK = WS_GV + (size_t)M * 256 * 2;
constexpr size_t WS_CNAV = WS_CNAK + (size_t)LB * DEPTH * 256 * 512 * 2;
constexpr size_t WS_CGK = WS_CNAV + (size_t)LB * DEPTH * 256 * 512 * 2;
constexpr size_t WS_CGV = WS_CGK + (size_t)LB * DEPTH * 256 * 256 * 2;
constexpr size_t WS_AF = WS_CGV + (size_t)LB * DEPTH * 256 * 256 * 2;
constexpr size_t WS_AB = WS_AF + (size_t)M * 256 * 4;
constexpr size_t WS_DQ = WS_AB + (size_t)M * 256 * 4;
constexpr size_t WS_DK = WS_DQ + (size_t)M * 512 * 4;
constexpr size_t WS_DV = WS_DK + (size_t)M * 512 * 4;
constexpr size_t WS_DBA = WS_DV + (size_t)M * 512 * 4;
constexpr size_t WS_GOF = WS_DBA + (size_t)M * 16 * 4;
constexpr size_t WS_GOB = WS_GOF + (size_t)M * 512 * 4;
constexpr size_t WS_DOF = WS_GOB + (size_t)M * 512 * 4;
constexpr size_t WS_DOB = WS_DOF + (size_t)M * 512 * 4;
constexpr size_t WS_END = WS_DOB + (size_t)M * 512 * 4;

typedef unsigned short bf16_t;
struct Params { const float* in[N_IN]; float* out; unsigned char* ws; int ph_lo, ph_hi; };
static_assert(sizeof(Params) == N_IN * 8 + 8 + 8 + 8, "no padding");

#define WSP(T, off) ((T*)(p.ws + (off)))
__device__ __forceinline__ int opaque_tid() { int t = (int)threadIdx.x; asm volatile("" : "+v"(t)); return t; }
__device__ __forceinline__ Params opaque_params(const Params& p) { Params q = p; unsigned long long w = (unsigned long long)q.ws; asm volatile("" : "+s"(w));
    q.ws = (unsigned char*)(__attribute__((address_space(1))) unsigned char*)w; return q; }

typedef float vf4 __attribute__((ext_vector_type(4)));
__device__ __forceinline__ unsigned pack4_fp8(float a, float b, float c, float d) { int w = 0; w = __builtin_amdgcn_cvt_pk_fp8_f32(a, b, w, false); w = __builtin_amdgcn_cvt_pk_fp8_f32(c, d, w, true); return (unsigned)w; }
__device__ __forceinline__ float bf2f(unsigned short v) { return __uint_as_float((unsigned)v << 16); }
__device__ __forceinline__ vf4 ld4bf(const unsigned short* p) { const uint2 w = *(const uint2*)p; vf4 r; r.x = __uint_as_float(w.x << 16); r.y = __uint_as_float(w.x & 0xFFFF0000u); r.z = __uint_as_float(w.y << 16); r.w = __uint_as_float(w.y & 0xFFFF0000u); return r; }
__device__ __forceinline__ vf4 unp4bf(uint2 w) { vf4 r; r.x = __uint_as_float(w.x << 16); r.y = __uint_as_float(w.x & 0xFFFF0000u); r.z = __uint_as_float(w.y << 16); r.w = __uint_as_float(w.y & 0xFFFF0000u); return r; }
__device__ __forceinline__ void unp8bf(uint4 w, vf4& a, vf4& b) {
    a.x = __uint_as_float(w.x << 16); a.y = __uint_as_float(w.x & 0xFFFF0000u); a.z = __uint_as_float(w.y << 16); a.w = __uint_as_float(w.y & 0xFFFF0000u);
    b.x = __uint_as_float(w.z << 16); b.y = __uint_as_float(w.z & 0xFFFF0000u); b.z = __uint_as_float(w.w << 16); b.w = __uint_as_float(w.w & 0xFFFF0000u); }
__device__ __forceinline__ void ld8bf(const unsigned short* p, vf4& a, vf4& b) { const uint4 w = *(const uint4*)p;
    a.x = __uint_as_float(w.x << 16); a.y = __uint_as_float(w.x & 0xFFFF0000u); a.z = __uint_as_float(w.y << 16); a.w = __uint_as_float(w.y & 0xFFFF0000u);
    b.x = __uint_as_float(w.z << 16); b.y = __uint_as_float(w.z & 0xFFFF0000u); b.z = __uint_as_float(w.w << 16); b.w = __uint_as_float(w.w & 0xFFFF0000u); }
__device__ __forceinline__ float wave_sum(float v) {
#pragma unroll
    for (int o = 32; o >= 1; o >>= 1) v += __shfl_xor(v, o);
    return v;
}
typedef float vf2_ __attribute__((ext_vector_type(2)));
typedef __bf16 vb2_ __attribute__((ext_vector_type(2)));
__device__ __forceinline__ bf16_t f2bf(float f) { return __builtin_bit_cast(unsigned short, (__bf16)f); }
__device__ __forceinline__ unsigned pack2(float a, float b) { return __builtin_bit_cast(unsigned, __builtin_convertvector((vf2_){a, b}, vb2_)); }
__device__ __forceinline__ float silu_f(float x) { return x / (1.f + expf(-x)); }
__device__ __forceinline__ float rsqrt_fast(float x) { return __builtin_amdgcn_rsqf(x); }
__device__ __forceinline__ float silu_fast(float x) { return x * __builtin_amdgcn_rcpf(1.f + __expf(-x)); }
__device__ __forceinline__ float logsigmoid_fast(float x) { return fminf(x, 0.f) - __logf(1.f + __expf(-fabsf(x))); }
__device__ __forceinline__ float softplus_f(float x) { return fmaxf(x, 0.f) + log1pf(expf(-fabsf(x))); }
__device__ __forceinline__ float logsigmoid_f(float x) { return fminf(x, 0.f) - log1pf(expf(-fabsf(x))); }
__device__ __forceinline__ bool g1_fp8(int l, int f) { return f ? (G1B_MODE != 0) : (G1A_MODE != 0 || ((G1A_LAYERS >> l) & 1)); }
__device__ __forceinline__ int cond_of_row(int m) { return m < MC ? 0 : 1 + (m - MC) / LT; }
#ifndef CONV_FILLER
#define CONV_FILLER 1
#endif
__device__ __forceinline__ void conv_tile(const float* __restrict__ src, int ld_src, int ncols_src, int k0, int c0, bf16_t* __restrict__ dst, int ld_dst, int n0, float* tile) {
    const int tid = opaque_tid();
    {
        const int r = tid >> 3, c = (tid & 7) * 8;
        float4 a = make_float4(0.f, 0.f, 0.f, 0.f), b = a;
        if (c0 + c + 8 <= ncols_src) {
            const float* s = src + (size_t)(k0 + r) * ld_src + c0 + c;
            a = *(const float4*)s; b = *(const float4*)(s + 4);
        }
        float* t = tile + r * 65 + c;
        t[0] = a.x; t[1] = a.y; t[2] = a.z; t[3] = a.w; t[4] = b.x; t[5] = b.y; t[6] = b.z; t[7] = b.w;
    }
    __syncthreads();
    {
        const int n = tid >> 3, ks = (tid & 7) * 8;
        const float* t = tile + ks * 65 + n;
        uint4 w;
        w.x = pack2(t[0 * 65], t[1 * 65]); w.y = pack2(t[2 * 65], t[3 * 65]); w.z = pack2(t[4 * 65], t[5 * 65]); w.w = pack2(t[6 * 65], t[7 * 65]);
        *(uint4*)(dst + (size_t)(n0 + n) * ld_dst + k0 + ks) = w;
    }
    __syncthreads();
}

__device__ __forceinline__ void conv_tile8(const float* __restrict__ src, int ld_src, int nrows_src, int k0, int c0, unsigned char* __restrict__ dst, int ld_dst, int n0, float scale, float* tile) {
    const int tid = opaque_tid();
    {
        const int r = tid >> 3, c = (tid & 7) * 8;
        float4 a = make_float4(0.f, 0.f, 0.f, 0.f), b = a;
        if (k0 + r < nrows_src) { const float* s = src + (size_t)(k0 + r) * ld_src + c0 + c; a = *(const float4*)s; b = *(const float4*)(s + 4); }
        float* t = tile + r * 65 + c;
        t[0] = a.x * scale; t[1] = a.y * scale; t[2] = a.z * scale; t[3] = a.w * scale; t[4] = b.x * scale; t[5] = b.y * scale; t[6] = b.z * scale; t[7] = b.w * scale;
    }
    __syncthreads();
    {
        const int n = tid >> 3, ks = (tid & 7) * 8;
        const float* t = tile + ks * 65 + n;
        uint2 w; w.x = pack4_fp8(t[0 * 65], t[1 * 65], t[2 * 65], t[3 * 65]); w.y = pack4_fp8(t[4 * 65], t[5 * 65], t[6 * 65], t[7 * 65]);
        *(uint2*)(dst + (size_t)(n0 + n) * ld_dst + k0 + ks) = w;
    }
    __syncthreads();
}
constexpr int MOD_ITEMS = DEPTH * (NMOD / 128);
constexpr int TGU_KT = DM / 64, TGU_NT = NGU / 64, TDN_KT = (G2_FP8 ? FFP : FF) / 64, TDN_NT = DM / 64, TIN_KT = DM / 64, TIN_NT = NINP / 64, TOUT_KT = DM / 64, TOUT_NT = DM / 64;
constexpr int TL_GU = 2 * TGU_KT * TGU_NT, TL_DN = 2 * TDN_KT * TDN_NT, TL_IN = TIN_KT * TIN_NT, TL_OUT = TOUT_KT * TOUT_NT, NT_L = TL_GU + TL_DN + TL_IN + TL_OUT;
struct CTile { const float* sp; unsigned char* dp; float scale; int fp8; };
__device__ __forceinline__ CTile conv_desc(const Params& p, int l, int it, int tid) {
    const int r = tid >> 3, c = (tid & 7) * 8;
    CTile d; d.scale = 1.0f; d.fp8 = 0;
    if (it < TL_GU) {
        const int mat = l * 2 + it / (TGU_KT * TGU_NT), rr = it % (TGU_KT * TGU_NT), kt = rr / TGU_NT, nt = rr % TGU_NT;
        const int n0 = nt * 64, t256 = n0 / 256, cc = n0 % 256;
        const int c0 = cc < 128 ? 128 * t256 + cc : FF + 128 * t256 + (cc - 128);
        d.sp = p.in[I_GU] + (size_t)mat * DM * NGU + (size_t)(kt * 64 + r) * NGU + c0 + c;
        if (g1_fp8(mat >> 1, mat & 1)) { d.fp8 = 1; d.scale = WGU_SCALE; d.dp = WSP(unsigned char, WS_WGU) + (size_t)mat * NGU * DM * 2 + (size_t)(n0 + r) * DM + kt * 64 + c; }
        else d.dp = WSP(unsigned char, WS_WGU) + ((size_t)mat * NGU * DM + (size_t)(n0 + r) * DM + kt * 64 + c) * 2;
    } else if (it < TL_GU + TL_DN) {
        const int i2 = it - TL_GU, mat = l * 2 + i2 / (TDN_KT * TDN_NT), rr = i2 % (TDN_KT * TDN_NT), kt = rr / TDN_NT, nt = rr % TDN_NT;
        d.sp = (kt * 64 + r < FF) ? p.in[I_DOWN] + (size_t)mat * FF * DM + (size_t)(kt * 64 + r) * DM + nt * 64 + c : nullptr;
#if G2_FP8
        d.fp8 = 1; d.scale = WDN_SCALE; d.dp = WSP(unsigned char, WS_WDN) + (size_t)mat * DM * FFP + (size_t)(nt * 64 + r) * FFP + kt * 64 + c;
#else
        d.dp = WSP(unsigned char, WS_WDN) + ((size_t)mat * DM * FF + (size_t)(nt * 64 + r) * FF + kt * 64 + c) * 2;
#endif
    } else if (it < TL_GU + TL_DN + TL_IN) {
        const int i2 = it - TL_GU - TL_DN, kt = i2 / TIN_NT, nt = i2 % TIN_NT;
        d.sp = (nt * 64 + c + 8 <= NIN) ? p.in[I_WIN] + (size_t)l * DM * NIN + (size_t)(kt * 64 + r) * NIN + nt * 64 + c : nullptr;
        d.dp = WSP(unsigned char, WS_WIN) + ((size_t)l * NINP * DM + (size_t)(nt * 64 + r) * DM + kt * 64 + c) * 2;
    } else {
        const int i2 = it - TL_GU - TL_DN - TL_IN, kt = i2 / TOUT_NT, nt = i2 % TOUT_NT;
        d.sp = p.in[I_WOUT] + (size_t)l * DM * DM + (size_t)(kt * 64 + r) * DM + nt * 64 + c;
        d.dp = WSP(unsigned char, WS_WOUT) + ((size_t)l * DM * DM + (size_t)(nt * 64 + r) * DM + kt * 64 + c) * 2;
    }
    return d;
}
__device__ __forceinline__ void conv_layer_tiles(const Params& p, int l, int t_begin, int t_end, int first, int stride, float* s_tile) {
    const int tid = opaque_tid(), r = tid >> 3, c = (tid & 7) * 8;
    int it = t_begin + first;
    if (it >= t_end) return;
    __syncthreads();
    CTile d = conv_desc(p, l, it, tid);
    float4 a = make_float4(0.f, 0.f, 0.f, 0.f), b = a;
    if (d.sp) { a = *(const float4*)d.sp; b = *(const float4*)(d.sp + 4); }
    for (int par = 0; it < t_end; it += stride, par ^= 1) {
        const int nx = it + stride;
        CTile dn = d; float4 na = make_float4(0.f, 0.f, 0.f, 0.f), nb = na;
        if (nx < t_end) { dn = conv_desc(p, l, nx, tid); if (dn.sp) { na = *(const float4*)dn.sp; nb = *(const float4*)(dn.sp + 4); } }
        float* tile = s_tile + par * (64 * 65);
        { float* t = tile + r * 65 + c; const float sc = d.scale;
          t[0] = a.x * sc; t[1] = a.y * sc; t[2] = a.z * sc; t[3] = a.w * sc; t[4] = b.x * sc; t[5] = b.y * sc; t[6] = b.z * sc; t[7] = b.w * sc; }
        __syncthreads();
        { const float* t = tile + c * 65 + r;
          if (d.fp8) { uint2 w; w.x = pack4_fp8(t[0 * 65], t[1 * 65], t[2 * 65], t[3 * 65]); w.y = pack4_fp8(t[4 * 65], t[5 * 65], t[6 * 65], t[7 * 65]); *(uint2*)d.dp = w; }
          else { uint4 w; w.x = pack2(t[0 * 65], t[1 * 65]); w.y = pack2(t[2 * 65], t[3 * 65]); w.z = pack2(t[4 * 65], t[5 * 65]); w.w = pack2(t[6 * 65], t[7 * 65]); *(uint4*)d.dp = w; } }
        d = dn; a = na; b = nb;
    }
    __syncthreads();
}

__device__ __forceinline__ void mod_layer(const Params& p, int l, int first, int stride, float* smem) {
    const int tid = opaque_tid();
    float* s_cond = smem;
    float* s_red = s_cond + NCOND * DM;
    __syncthreads();
    for (int i = tid; i < NCOND * DM; i += 512) { const int ci = i / DM, k = i % DM; const float v = ci == 0 ? p.in[I_CCTX][k] : p.in[I_C][(size_t)(ci - 1) * DM + k]; s_cond[i] = silu_f(v); }
    __syncthreads();
    float* modv = WSP(float, WS_MODV);
    for (int jt = first; jt < NMOD / 128; jt += stride) {
        const int cl = tid & 127, kq = tid >> 7, col = jt * 128 + cl;
        const float* w = p.in[I_WMOD] + (size_t)l * DM * NMOD + col;
        float acc[NCOND];
#pragma unroll
        for (int ci = 0; ci < NCOND; ++ci) acc[ci] = 0.f;
        for (int k = kq * 512; k < kq * 512 + 512; k += 8) {
            float wv[8];
#pragma unroll
            for (int j = 0; j < 8; ++j) wv[j] = w[(size_t)(k + j) * NMOD];
#pragma unroll
            for (int ci = 0; ci < NCOND; ++ci) {
                const float4 s0 = *(const float4*)&s_cond[ci * DM + k], s1 = *(const float4*)&s_cond[ci * DM + k + 4];
                acc[ci] += s0.x * wv[0] + s0.y * wv[1] + s0.z * wv[2] + s0.w * wv[3] + s1.x * wv[4] + s1.y * wv[5] + s1.z * wv[6] + s1.w * wv[7];
            }
        }
        if (kq > 0) {
#pragma unroll
            for (int ci = 0; ci < NCOND; ++ci) s_red[((kq - 1) * 128 + cl) * NCOND + ci] = acc[ci];
        }
        __syncthreads();
        if (kq == 0) {
            const float bm = p.in[I_BMOD][(size_t)l * NMOD + col];
#pragma unroll
            for (int ci = 0; ci < NCOND; ++ci)
                modv[((size_t)l * NCOND + ci) * NMOD + col] = acc[ci] + s_red[(0 * 128 + cl) * NCOND + ci] + s_red[(1 * 128 + cl) * NCOND + ci] + s_red[(2 * 128 + cl) * NCOND + ci] + bm;
        }
        __syncthreads();
    }
}

__device__ __forceinline__ void phase_prologue(const Params& p, float* smem) {
    const int tid = threadIdx.x, nb = gridDim.x, bid = blockIdx.x;
    float* s_tile = smem + NCOND * DM + 3 * 128 * NCOND;
#if CONV_FILLER
    mod_layer(p, 0, bid, nb, smem);
#else
    for (int l2 = 0; l2 < DEPTH; ++l2) mod_layer(p, l2, bid, nb, smem);
#endif
    conv_layer_tiles(p, 0, 0, NT_L, bid, nb, s_tile);
#if !CONV_FILLER
    for (int l2 = 1; l2 < DEPTH; ++l2) conv_layer_tiles(p, l2, 0, NT_L, bid, nb, s_tile);
#endif
    const size_t gtid = (size_t)bid * 512 + tid, gstride = (size_t)nb * 512;
    {
        const size_t n_na = (size_t)LB * DEPTH * 256 * 512 / 8;
        for (size_t i = gtid; i < 2 * n_na; i += gstride) {
            const bool isv = i >= n_na; const size_t j = isv ? i - n_na : i;
            const int d8 = (int)(j % 16), h = (int)((j / 16) % 4), t = (int)((j / 64) % 256); const size_t bl = j / (64 * 256);
            const float* s = p.in[isv ? I_CNAV : I_CNAK] + ((bl * 4 + h) * 256 + t) * 128 + d8 * 8;
            const float4 a = *(const float4*)s, b = *(const float4*)(s + 4);
            uint4 w; w.x = pack2(a.x, a.y); w.y = pack2(a.z, a.w); w.z = pack2(b.x, b.y); w.w = pack2(b.z, b.w);
            *(uint4*)(WSP(bf16_t, isv ? WS_CNAV : WS_CNAK) + (bl * 256 + t) * 512 + h * 128 + d8 * 8) = w;
        }
        const size_t n_g = (size_t)LB * DEPTH * 256 * 256 / 8;
        for (size_t i = gtid; i < 2 * n_g; i += gstride) {
            const bool isv = i >= n_g; const size_t j = isv ? i - n_g : i;
            const int d8 = (int)(j % 16), h = (int)((j / 16) % 2), t = (int)((j / 32) % 256); const size_t bl = j / (32 * 256);
            const float* s = p.in[isv ? I_CGV : I_CGK] + ((bl * 2 + h) * 256 + t) * 128 + d8 * 8;
            const float4 a = *(const float4*)s, b = *(const float4*)(s + 4);
            uint4 w; w.x = pack2(a.x, a.y); w.y = pack2(a.z, a.w); w.z = pack2(b.x, b.y); w.w = pack2(b.z, b.w);
            *(uint4*)(WSP(bf16_t, isv ? WS_CGV : WS_CGK) + (bl * 256 + t) * 256 + h * 128 + d8 * 8) = w;
        }
    }
    for (size_t i = gtid; i < 64 * 32; i += gstride) {
        const int pos = (int)(i / 32), k = (int)(i % 32);
        const float inv = powf(10000.0f, -(float)(2 * k) / 64.0f);
        const float ang = (float)pos * inv;
        WSP(float, WS_ROPE)[i] = cosf(ang); WSP(float, WS_ROPE)[64 * 32 + i] = sinf(ang);
    }
}

#ifndef NORM_NR
#define NORM_NR 2
#endif
constexpr int NORM_MAXC = 6;
__device__ __forceinline__ void phase_norm(const Params& p, int l, int which  , unsigned char* lds) {
    const int tid = opaque_tid(), lane = tid & 63, wv = tid >> 6;
    const float* X = WSP(float, WS_X); bf16_t* H = WSP(bf16_t, WS_H);
    const bool from_in = (l == 0 && which == 0);
    const float* g = p.in[I_NORMG] + ((size_t)l * 3 + which) * DM;
    const int rpb = (M + (int)gridDim.x - 1) / (int)gridDim.x;
    const int r0 = (int)blockIdx.x * rpb, r1 = r0 + rpb < M ? r0 + rpb : M;
    if (r0 >= r1) return;
    const int c_lo = cond_of_row(r0), c_hi = cond_of_row(r1 - 1);
    float* sw = (float*)lds;
    for (int ci = 0; ci <= c_hi - c_lo && ci < NORM_MAXC; ++ci) {
        const float* mv = WSP(float, WS_MODV) + ((size_t)l * NCOND + c_lo + ci) * NMOD + (size_t)which * 3 * DM;
        const int c = tid * 4;
        const vf4 gg = *(const vf4*)(g + c), sh = *(const vf4*)(mv + c), sc = *(const vf4*)(mv + DM + c);
        *(vf4*)(sw + (size_t)ci * 2 * DM + c) = gg * (1.f + sc);
        *(vf4*)(sw + (size_t)ci * 2 * DM + DM + c) = sh;
    }
    __syncthreads();
    for (int m0 = r0 + wv; m0 < r1; m0 += NORM_NR * 8) {
        int mm[NORM_NR]; bool has[NORM_NR];
#pragma unroll
        for (int k = 0; k < NORM_NR; ++k) { has[k] = m0 + k * 8 < r1; mm[k] = has[k] ? m0 + k * 8 : m0; }
        vf4 v[NORM_NR][8]; float ss[NORM_NR];
#pragma unroll
        for (int k = 0; k < NORM_NR; ++k) {
            const int m = mm[k];
            if (from_in || !XBF16) {
                const float* x = !from_in ? X + (size_t)m * DM : m < MC ? p.in[I_XP] + (size_t)m * DM : p.in[I_XS] + (size_t)(m - MC) * DM;
#pragma unroll
                for (int i = 0; i < 8; ++i) v[k][i] = *(const vf4*)(x + (i * 64 + lane) * 4);
            } else {
                const bf16_t* x = (const bf16_t*)X + (size_t)m * DM;
#pragma unroll
                for (int i = 0; i < 8; ++i) v[k][i] = ld4bf(x + (i * 64 + lane) * 4);
            }
        }
#pragma unroll
        for (int k = 0; k < NORM_NR; ++k) {
            ss[k] = 0.f;
#pragma unroll
            for (int i = 0; i < 8; ++i) ss[k] += v[k][i].x * v[k][i].x + v[k][i].y * v[k][i].y + v[k][i].z * v[k][i].z + v[k][i].w * v[k][i].w;
            ss[k] = wave_sum(ss[k]);
        }
#pragma unroll
        for (int k = 0; k < NORM_NR; ++k) {
            if (k > 0 && !has[k]) break;
            const int m = mm[k];
            const float* a = sw + (size_t)(cond_of_row(m) - c_lo) * 2 * DM;
            const float r = rsqrt_fast(ss[k] * (1.0f / DM) + EPS);
#pragma unroll
            for (int i = 0; i < 8; ++i) {
                const int c = (i * 64 + lane) * 4;
                const vf4 o = v[k][i] * r * *(const vf4*)(a + c) + *(const vf4*)(a + DM + c);
                if (which != 1 && g1_fp8(l, which >> 1)) *(unsigned*)((unsigned char*)H + (size_t)m * DM + c) = pack4_fp8(o.x, o.y, o.z, o.w);
                else { uint2 w; w.x = pack2(o.x, o.y); w.y = pack2(o.z, o.w); *(uint2*)(H + (size_t)m * DM + c) = w; }
            }
            if (G2_FP8 && which != 1 && lane < (FFP - FF) / 4) *(unsigned*)(WSP(unsigned char, WS_ACT) + (size_t)m * FFP + FF + 4 * lane) = 0u;
        }
    }
}

__device__ __forceinline__ float red16(float v);
__device__ __forceinline__ float ssq8(vf4 a, vf4 b) { const vf4 s = a * a + b * b; return (s.x + s.y) + (s.z + s.w); }
__device__ __forceinline__ uint4 pack8(vf4 a, vf4 b) { uint4 w; w.x = pack2(a.x, a.y); w.y = pack2(a.z, a.w); w.z = pack2(b.x, b.y); w.w = pack2(b.z, b.w); return w; }
constexpr int PL_CW = 0, PL_UP = PL_CW + 5 * 1536, PL_GB = PL_UP + 2 * 16 * 256, PL_NQ = PL_GB + 512, PL_ROPE = PL_NQ + 512, PL_END = PL_ROPE + 2 * 64 * 32;
__device__ __forceinline__ void phase_prep(const Params& p, int l, unsigned char* lds) {
    const int tid = opaque_tid(), lane = tid & 63, wv = tid >> 6, rg = lane >> 4, sub = lane & 15, c8 = sub * 8;
    const bf16_t* Z = WSP(bf16_t, WS_Z);
    float* sw = (float*)lds;
    for (int i = tid; i < 5 * 1536; i += 512) { const int j = i / 1536, col = i % 1536; sw[PL_CW + j * 1536 + ((col >> 2) & 1) * 768 + (col >> 3) * 4 + (col & 3)] = p.in[I_CONV][(size_t)l * 5 * 1536 + i]; }
    for (int i = tid; i < 2 * 16 * 256 / 4; i += 512) ((vf4*)(sw + PL_UP))[i] = ((const vf4*)(p.in[I_GUP] + (size_t)l * 2 * 16 * 256))[i];
    sw[PL_GB + tid] = p.in[I_GBIAS][(size_t)l * 512 + tid];
    { const int v = tid >> 7, c = tid & 127; const float* src = (v < 2 ? p.in[I_NAQKN] : p.in[I_GQAQKN]) + ((size_t)l * 2 + (v & 1)) * 128; sw[PL_NQ + v * 128 + ((c >> 2) & 1) * 64 + (c >> 3) * 4 + (c & 3)] = src[c]; }
    for (int i = tid; i < 2 * 64 * 32 / 4; i += 512) ((vf4*)(sw + PL_ROPE))[i] = ((const vf4*)WSP(float, WS_ROPE))[i];
    __syncthreads();
    const float* ropec = sw + PL_ROPE; const float* ropes = ropec + 64 * 32;
    const float* wnq = sw + PL_NQ + sub * 4; const float* wnk = wnq + 128;
    const float* wgq = wnq + 256; const float* wgk = wnq + 384;
    const float* cw = sw + PL_CW + (rg * 16 + sub) * 4;
    const int rpw = (M + (int)gridDim.x * 8 - 1) / ((int)gridDim.x * 8);
    for (int m = ((int)blockIdx.x * 8 + wv) * rpw, mend = (m + rpw < M ? m + rpw : M); m < mend; ++m) {
        const bf16_t* z = Z + (size_t)m * NINP;
        const bool ctx = m < MC;
        const int b = ctx ? m / CT : (m - MC) / LT, t = ctx ? m % CT : (m - MC) % LT, T = ctx ? CT : LT;
        const int ho = rg * 128 + c8;
        uint4 rz[5]; uint2 rgz[2][4];
        {
            const bf16_t* zkv = z + (rg < 2 ? Z_GQK + rg * 128 : Z_GQV + (rg - 2) * 128) + c8;
            rz[0] = *(const uint4*)(z + Z_NAQ + ho); rz[1] = *(const uint4*)(z + Z_NAK + ho); rz[2] = *(const uint4*)(z + Z_NAV + ho); rz[3] = *(const uint4*)(z + Z_GQQ + ho); rz[4] = *(const uint4*)zkv;
#pragma unroll
            for (int dir = 0; dir < 2; ++dir)
#pragma unroll
                for (int r4 = 0; r4 < 4; ++r4) rgz[dir][r4] = *(const uint2*)(z + (dir ? Z_GB : Z_GF) + 4 * r4);
        }
        asm volatile("" ::: "memory");
        {
            vf4 q0, q1, k0, k1, v0, v1, g0, g1, x0, x1;
            unp8bf(rz[0], q0, q1); unp8bf(rz[1], k0, k1); unp8bf(rz[2], v0, v1); unp8bf(rz[3], g0, g1); unp8bf(rz[4], x0, x1);
            float r = rsqrt_fast(red16(ssq8(q0, q1)) * (1.0f / 128) + EPS);
            q0 = q0 * r * *(const vf4*)wnq; q1 = q1 * r * *(const vf4*)(wnq + 64);
            *(uint4*)(WSP(bf16_t, WS_NAQ) + (size_t)m * 512 + ho) = pack8(q0, q1);
            r = rsqrt_fast(red16(ssq8(k0, k1)) * (1.0f / 128) + EPS);
            k0 = k0 * r * *(const vf4*)wnk; k1 = k1 * r * *(const vf4*)(wnk + 64);
            *(uint4*)(WSP(bf16_t, WS_NAK) + (size_t)m * 512 + ho) = pack8(k0, k1);
            *(uint4*)(WSP(bf16_t, WS_NAV) + (size_t)m * 512 + ho) = pack8(v0, v1);
            if (ctx) {
                const size_t o = ((((size_t)b * DEPTH + l) * 4 + rg) * CT + t) * 128 + c8;
                *(vf4*)(p.out + O_NAK + o) = k0; *(vf4*)(p.out + O_NAK + o + 4) = k1; *(vf4*)(p.out + O_NAV + o) = v0; *(vf4*)(p.out + O_NAV + o + 4) = v1;
            }
            r = rsqrt_fast(red16(ssq8(g0, g1)) * (1.0f / 128) + EPS);
            g0 = g0 * r * *(const vf4*)wgq; g1 = g1 * r * *(const vf4*)(wgq + 64);
            const float rk = rsqrt_fast(red16(ssq8(x0, x1)) * (1.0f / 128) + EPS);
            if (rg < 2) { x0 = x0 * rk * *(const vf4*)wgk; x1 = x1 * rk * *(const vf4*)(wgk + 64); }
            if (!ctx) {
                const int pos = sub < 8 ? (t >> 6) : (t & 63), ai = pos * 32 + (c8 & 31);
                const vf4 c0 = *(const vf4*)(ropec + ai), c1 = *(const vf4*)(ropec + ai + 4), s0 = *(const vf4*)(ropes + ai), s1 = *(const vf4*)(ropes + ai + 4);
                const bool hi = (sub & 4) != 0;
                vf4 pg0, pg1, px0, px1;
#pragma unroll
                for (int j = 0; j < 4; ++j) { pg0[j] = __shfl_xor(g0[j], 4); pg1[j] = __shfl_xor(g1[j], 4); px0[j] = __shfl_xor(x0[j], 4); px1[j] = __shfl_xor(x1[j], 4); }
                g0 = hi ? pg0 * s0 + g0 * c0 : g0 * c0 - pg0 * s0; g1 = hi ? pg1 * s1 + g1 * c1 : g1 * c1 - pg1 * s1;
                if (rg < 2) { x0 = hi ? px0 * s0 + x0 * c0 : x0 * c0 - px0 * s0; x1 = hi ? px1 * s1 + x1 * c1 : x1 * c1 - px1 * s1; }
            }
            *(uint4*)(WSP(bf16_t, WS_GQ) + (size_t)m * 512 + ho) = pack8(g0, g1);
            *(uint4*)(WSP(bf16_t, rg < 2 ? WS_GK : WS_GV) + (size_t)m * 256 + (rg & 1) * 128 + c8) = pack8(x0, x1);
            if (ctx) {
                const size_t o = ((((size_t)b * DEPTH + l) * 2 + (rg & 1)) * CT + t) * 128 + c8;
                float* dst = p.out + (rg < 2 ? O_GK : O_GV) + o;
                *(vf4*)dst = x0; *(vf4*)(dst + 4) = x1;
            }
        }
        asm volatile("" ::: "memory");
        {
#pragma unroll
            for (int dir = 0; dir < 2; ++dir) {
                const float* up = sw + PL_UP + dir * 16 * 256 + 4 * lane;
                vf4 acc = *(const vf4*)(sw + PL_GB + dir * 256 + 4 * lane);
#pragma unroll
                for (int r4 = 0; r4 < 4; ++r4) {
                    const vf4 gv = unp4bf(rgz[dir][r4]);
                    acc += gv.x * *(const vf4*)(up + (4 * r4 + 0) * 256) + gv.y * *(const vf4*)(up + (4 * r4 + 1) * 256) + gv.z * *(const vf4*)(up + (4 * r4 + 2) * 256) + gv.w * *(const vf4*)(up + (4 * r4 + 3) * 256);
                }
                vf4 o;
#pragma unroll
                for (int j = 0; j < 4; ++j) o[j] = logsigmoid_fast(acc[j]) * (1.0f / 16.0f);
                *(vf4*)(WSP(float, dir ? WS_AB : WS_AF) + (size_t)m * 256 + 4 * lane) = o;
            }
        }
        asm volatile("" ::: "memory");
        {
            uint4 rcz[3][5];
#pragma unroll
            for (int part = 0; part < 3; ++part)
#pragma unroll
                for (int j = 0; j < 5; ++j) { const int tt = t + j - 2;
                    rcz[part][j] = (tt >= 0 && tt < T) ? *(const uint4*)(Z + (size_t)(m + j - 2) * NINP + Z_DQKV + part * 512 + rg * 128 + c8) : make_uint4(0u, 0u, 0u, 0u); }
            asm volatile("" ::: "memory");
#pragma unroll
            for (int part = 0; part < 3; ++part) {
                vf4 a0 = (vf4){0.f, 0.f, 0.f, 0.f}, a1 = a0;
#pragma unroll
                for (int j = 0; j < 5; ++j) {
                    const float* cj = cw + j * 1536 + part * 256;
                    vf4 z0, z1; unp8bf(rcz[part][j], z0, z1);
                    a0 += *(const vf4*)cj * z0; a1 += *(const vf4*)(cj + 768) * z1;
                }
#pragma unroll
                for (int j = 0; j < 4; ++j) { a0[j] = silu_fast(a0[j]); a1[j] = silu_fast(a1[j]); }
                if (part < 2) { const float r = rsqrt_fast(red16(ssq8(a0, a1)) + EPS) * (part == 0 ? 0.08838834764831845f : 1.0f); a0 *= r; a1 *= r; }
                *(uint4*)(WSP(bf16_t, part == 0 ? WS_DQ : part == 1 ? WS_DK : WS_DV) + (size_t)m * 512 + rg * 128 + c8) = pack8(a0, a1);
                asm volatile("" ::: "memory");
            }
            if (lane < 8) {
                const float beta = 1.0f / (1.0f + expf(-bf2f(z[Z_DB + lane])));
                const float g = -expf(p.in[I_ALOG][(size_t)l * 8 + lane]) * softplus_f(bf2f(z[Z_DA + lane]) + p.in[I_DTB][(size_t)l * 8 + lane]);
                float* ba = WSP(float, WS_DBA) + (size_t)m * 16;
                ba[lane] = beta; ba[8 + lane] = g;
            }
        }
    }
}

typedef float vf2 __attribute__((ext_vector_type(2)));
__device__ __forceinline__ float dpp_f(float v, const int ctrl) { return v; }
#define DPPF(v, ctrl) __int_as_float(__builtin_amdgcn_mov_dpp(__float_as_int(v), (ctrl), 0xF, 0xF, true))
__device__ __forceinline__ float red8(float v) { v += DPPF(v, 0xB1); v += DPPF(v, 0x4E); v += DPPF(v, 0x141); return v; }
__device__ __forceinline__ float red16(float v) { v = red8(v); v += DPPF(v, 0x140); return v; }

__device__ __forceinline__ void phase_post(const Params& p, int l) {
    const int tid = opaque_tid(), lane = tid & 63, wv = tid >> 6, rg = lane >> 4, c8 = (lane & 15) * 8;
    const bf16_t* Z = WSP(bf16_t, WS_Z); bf16_t* MRG = WSP(bf16_t, WS_MRG);
    const float* wg = p.in[I_GLAON] + (size_t)l * 128 + c8; const float* wd = p.in[I_GDNON] + (size_t)l * 128 + c8;
    for (int m = blockIdx.x * 8 + wv; m < M; m += gridDim.x * 8) {
        const bf16_t* z = Z + (size_t)m * NINP;
        const int ho = rg * 128 + c8;
#pragma unroll
        for (int g = 0; g < 2; ++g) {
            const float* of = WSP(float, g ? WS_DOF : WS_GOF) + (size_t)m * 512 + ho; const float* ob = WSP(float, g ? WS_DOB : WS_GOB) + (size_t)m * 512 + ho;
            const float* w = g ? wd : wg; const bf16_t* zg = z + (g ? Z_DZ : Z_GLR) + ho;
            vf4 a0 = *(const vf4*)of + *(const vf4*)ob, a1 = *(const vf4*)(of + 4) + *(const vf4*)(ob + 4);
            vf4 g0, g1; ld8bf(zg, g0, g1);
            const float r = rsqrt_fast(red16(ssq8(a0, a1)) * (1.0f / 128) + EPS);
            a0 = a0 * r * *(const vf4*)w; a1 = a1 * r * *(const vf4*)(w + 4);
#pragma unroll
            for (int j = 0; j < 4; ++j) { a0[j] *= silu_fast(g0[j]); a1[j] *= silu_fast(g1[j]); }
            *(uint4*)(MRG + (size_t)m * DM + (g ? 1536 : 512) + ho) = pack8(a0, a1);
        }
    }
}
#define XB_TMO      128
#define XB_XCNT(j)  (256  + 64 * (j))
#define XB_XSUB(j)  (1280 + 64 * (j))
#define XB_XGEN(j)  (2304 + 64 * (j))
#define XB_TOP      3328
#define XB_TOPGEN   3392
#define XCD_BAR_WORDS 3456
#define XB_SPIN_CAP (1u << 22)
#define LAS __attribute__((address_space(3)))

__device__ __forceinline__ unsigned xb_ld(unsigned* p)              { return __hip_atomic_load(p, __ATOMIC_RELAXED, __HIP_MEMORY_SCOPE_AGENT); }
__device__ __forceinline__ unsigned xb_add(unsigned* p, unsigned v) { return __hip_atomic_fetch_add(p, v, __ATOMIC_RELAXED, __HIP_MEMORY_SCOPE_AGENT); }
__device__ __forceinline__ unsigned xb_xcc_id() { return (unsigned)__builtin_amdgcn_s_getreg((3 << 11) | 20) & 0xFu; }
#define XB_SPIN(cond, bar) do { unsigned _sp = 0; while (cond) { __builtin_amdgcn_s_sleep(1); \
    if ((++_sp & 255u) == 0u) { if (xb_ld(&(bar)[XB_TMO])) break; if (_sp > XB_SPIN_CAP) { atomicAdd(&(bar)[XB_TMO], 1u); break; } } } } while (0)

struct XcdBarrier {
    unsigned* bar; unsigned x;
    volatile LAS unsigned* st;
};

__device__ __forceinline__ XcdBarrier xcd_barrier_post(unsigned* bar, volatile LAS unsigned* st) {
    XcdBarrier b; b.bar = bar; b.x = xb_xcc_id(); b.st = st;
    if (threadIdx.x == 0) (void)xb_add(&bar[XB_XCNT(b.x)], 1u);
    return b;
}
__device__ __forceinline__ void xcd_barrier_complete(unsigned* bar, unsigned x, unsigned& nloc, unsigned& nx) {
    const unsigned G = gridDim.x * gridDim.y * gridDim.z;
    unsigned sum, cnt, mine, sp = 0u;
    for (;;) {
        sum = 0u; cnt = 0u; mine = 0u;
#pragma unroll
        for (unsigned j = 0; j < 16; ++j) { const unsigned c = xb_ld(&bar[XB_XCNT(j)]); sum += c; cnt += (c > 0u) ? 1u : 0u; mine = (j == x) ? c : mine; }
        if (sum == G) break;
        __builtin_amdgcn_s_sleep(1);
        if ((++sp & 255u) == 0u) { if (xb_ld(&bar[XB_TMO])) break; if (sp > XB_SPIN_CAP) { atomicAdd(&bar[XB_TMO], 1u); break; } }
    }
    nloc = mine > 0u ? mine : 1u; nx = cnt > 0u ? cnt : 1u;
}

__device__ __forceinline__ void xcd_barrier(const XcdBarrier& b) {
    asm volatile("s_waitcnt vmcnt(0)" ::: "memory");
    __syncthreads();
    if (threadIdx.x == 0) {
        unsigned* bar = b.bar;
        __builtin_amdgcn_s_waitcnt(0);
        unsigned nloc = b.st[0], nx = b.st[1];
        if (nloc == 0u) { xcd_barrier_complete(bar, b.x, nloc, nx); b.st[0] = nloc; b.st[1] = nx; }
        const unsigned old = xb_add(&bar[XB_XSUB(b.x)], 1u);
        const unsigned gen = old / nloc;
        if (old + 1u == (gen + 1u) * nloc) {
            __builtin_amdgcn_fence(__ATOMIC_RELEASE, "agent");
            asm volatile("s_waitcnt vmcnt(0)" ::: "memory");
            const unsigned og = xb_add(&bar[XB_TOP], 1u);
            const unsigned tg = og / nx;
            if (og + 1u == (tg + 1u) * nx) xb_add(&bar[XB_TOPGEN], 1u);
            else XB_SPIN(xb_ld(&bar[XB_TOPGEN]) == tg, bar);
            __builtin_amdgcn_fence(__ATOMIC_ACQUIRE, "agent");
            xb_add(&bar[XB_XGEN(b.x)], 1u);
            asm volatile("s_waitcnt vmcnt(0)" ::: "memory");
        } else {
            XB_SPIN(xb_ld(&bar[XB_XGEN(b.x)]) == gen, bar);
            __builtin_amdgcn_fence(__ATOMIC_ACQUIRE, "agent");
            asm volatile("s_waitcnt vmcnt(0)" ::: "memory");
        }
    }
    __syncthreads();
}

#ifndef NT_STORES
#define NT_STORES 0
#endif
namespace pg8 {
#define PG8_LAS __attribute__((address_space(3)))
typedef unsigned short bf16_t;
typedef short bf16x8 __attribute__((ext_vector_type(8)));
typedef float f32x4 __attribute__((ext_vector_type(4)));
typedef unsigned u32x4 __attribute__((ext_vector_type(4)));
typedef unsigned u32x2 __attribute__((ext_vector_type(2)));
typedef int v4i32 __attribute__((ext_vector_type(4)));
typedef int v8i32 __attribute__((ext_vector_type(8)));
constexpr int BM = 256, BK = 64, HALF = 128, HTB = HALF * BK * 2  , STAGE_BYTES = 8 * HTB, NXCD = 8, WGM = 8;

__host__ __device__ __forceinline__ int lds_byte(int r, int c) { const int st = (r >> 4) * 2 + (c >> 5), rr = r & 15, cc = c & 31, ob = rr * 64 + cc * 2; return st * 1024 + (ob ^ (((ob >> 9) & 1) << 5)); }
__host__ __device__ __forceinline__ void stage_rc(int b, int& R, int& C) { const int st = b / 1024, sb = b % 1024, swz = sb ^ (((sb >> 9) & 1) << 5); R = (st >> 1) * 16 + swz / 64; C = (st & 1) * 32 + (swz % 64) / 2; }
__host__ __device__ __forceinline__ int perm32(int rho) { const int n = rho >> 4, i = rho & 15; return 8 * (i >> 2) + 4 * n + (i & 3); }

struct Unit { int pm, pn, k0, nt, at, slot, msk; };
struct Gemm { const bf16_t* A; const bf16_t* Bt; int M, N, K; };

struct StaticOrder {
    int nM, nN, nwg, G, c, ntk, split, msplit;
    __host__ __device__ void init(int M, int N, int K, int G_, int c_, int split_ = 0) { nM = M / BM; nN = N / BM; nwg = nM * nN; G = G_; c = c_; ntk = K / BK; const int rem = nwg % G_; split = (split_ == 1 && rem > 0 && 2 * rem == G_ && ntk >= 8) ? 1 : 0; msplit = (split_ == 2 && rem > 0 && 2 * rem <= G_) ? 1 : 0; }
    __host__ __device__ bool next(int i, Unit& u) const {
        long L = (long)i * G + c; u.k0 = 0; u.nt = ntk; u.at = 0; u.slot = 0; u.msk = 3;
        if (msplit && i == nwg / G) { const int rem = nwg % G; if (c >= 2 * rem) return false; L = (long)i * G + (c % rem); u.msk = (c / rem) ? 2 : 1; }
        if (split && i == nwg / G) { const int rem = nwg % G, sl = c / rem, h0 = ((ntk / 2) + 1) & ~1; L = (long)i * G + (c % rem); u.k0 = sl ? h0 * BK : 0; u.nt = sl ? ntk - h0 : h0; u.at = sl ? 1 : 2; u.slot = c % rem; }
        if (L >= nwg) return false;
        int wgid = (int)L; { const int q = nwg / NXCD, r = nwg % NXCD, xcd = wgid % NXCD, off = wgid / NXCD; wgid = (xcd < r ? xcd * (q + 1) : r * (q + 1) + (xcd - r) * q) + off; }
        const int nig = WGM * nN, gid = wgid / nig, fm = gid * WGM, gsz = (nM - fm) < WGM ? (nM - fm) : WGM;
        u.pm = fm + ((wgid % nig) % gsz); u.pn = (wgid % nig) / gsz; return true;
    }
    __device__ __forceinline__ void a_ready(const Unit&) const {}
    __device__ __forceinline__ void done(const Unit&) const {}
};
__device__ __forceinline__ unsigned cvt_pk_bf16(float lo, float hi) { unsigned r; asm volatile("v_cvt_pk_bf16_f32 %0, %1, %2" : "=v"(r) : "v"(lo), "v"(hi)); return r; }
struct EpiF32 {
    static constexpr bool PERM = false, AFTER_DRAIN = false;
    float* C; int ldc; const float* bias;
    __device__ __forceinline__ void operator()(const f32x4 (&acc)[2][2][4][2], const Unit& u, int wr, int wc, int fr, int fq) const {
        const int row0 = u.pm * BM + wr * 64 + fr, col0 = u.pn * BM + wc * 32 + 4 * fq;
        f32x4 bv[2][2];
#pragma unroll
        for (int bj = 0; bj < 2; ++bj)
#pragma unroll
            for (int n = 0; n < 2; ++n) bv[bj][n] = bias ? *(const f32x4*)(bias + col0 + bj * HALF + n * 16) : (f32x4){0.f, 0.f, 0.f, 0.f};
#pragma unroll
        for (int ai = 0; ai < 2; ++ai)
#pragma unroll
            for (int m = 0; m < 4; ++m) { float* rowp = C + (size_t)(row0 + ai * HALF + m * 16) * ldc + col0;
#pragma unroll
                for (int bj = 0; bj < 2; ++bj)
#pragma unroll
                    for (int n = 0; n < 2; ++n) *(f32x4*)(rowp + bj * HALF + n * 16) = acc[ai][bj][m][n] + bv[bj][n]; }
    }
};

struct EpiSwiGLU {
    static constexpr bool PERM = true, AFTER_DRAIN = false;
    bf16_t* O; int ldc;
    __device__ __forceinline__ void operator()(const f32x4 (&acc)[2][2][4][2], const Unit& u, int wr, int wc, int fr, int fq) const {
        const int row0 = u.pm * BM + wr * 64 + fr, col0 = u.pn * 128 + wc * 32 + 8 * fq;
#pragma unroll
        for (int ai = 0; ai < 2; ++ai) if ((u.msk >> ai) & 1)
#pragma unroll
            for (int m = 0; m < 4; ++m) { bf16_t* rowp = O + (size_t)(row0 + ai * HALF + m * 16) * ldc + col0;
                const f32x4 g0 = acc[ai][0][m][0], g1 = acc[ai][0][m][1], u0 = acc[ai][1][m][0], u1 = acc[ai][1][m][1];
                float r[8];
#pragma unroll
                for (int j = 0; j < 4; ++j) {
                    r[j]     = g0[j] * __builtin_amdgcn_rcpf(1.0f + __builtin_amdgcn_exp2f(-1.4426950408889634f * g0[j])) * u0[j];
                    r[4 + j] = g1[j] * __builtin_amdgcn_rcpf(1.0f + __builtin_amdgcn_exp2f(-1.4426950408889634f * g1[j])) * u1[j]; }
                u32x4 w; w.x = cvt_pk_bf16(r[0], r[1]); w.y = cvt_pk_bf16(r[2], r[3]); w.z = cvt_pk_bf16(r[4], r[5]); w.w = cvt_pk_bf16(r[6], r[7]);
#if NT_STORES
                __builtin_nontemporal_store(w, (u32x4*)rowp);
#else
                *(u32x4*)rowp = w;
#endif
                }
    }
};
struct EpiSwiGLU8 {
    static constexpr bool PERM = true, AFTER_DRAIN = false;
    unsigned char* O; int ldc; float wscale;
    __device__ __forceinline__ void operator()(const f32x4 (&acc)[2][2][4][2], const Unit& u, int wr, int wc, int fr, int fq) const {
        const int row0 = u.pm * BM + wr * 64 + fr, col0 = u.pn * 128 + wc * 32 + 8 * fq;
#pragma unroll
        for (int ai = 0; ai < 2; ++ai) if ((u.msk >> ai) & 1)
#pragma unroll
            for (int m = 0; m < 4; ++m) { unsigned char* rowp = O + (size_t)(row0 + ai * HALF + m * 16) * ldc + col0;
                f32x4 g0 = acc[ai][0][m][0], g1 = acc[ai][0][m][1], u0 = acc[ai][1][m][0], u1 = acc[ai][1][m][1];
                asm volatile("" : "+v"(g0), "+v"(g1), "+v"(u0), "+v"(u1));
                g0 *= wscale; g1 *= wscale; u0 *= wscale; u1 *= wscale;
                float r[8];
#pragma unroll
                for (int j = 0; j < 4; ++j) {
                    r[j]     = g0[j] * __builtin_amdgcn_rcpf(1.0f + __builtin_amdgcn_exp2f(-1.4426950408889634f * g0[j])) * u0[j];
                    r[4 + j] = g1[j] * __builtin_amdgcn_rcpf(1.0f + __builtin_amdgcn_exp2f(-1.4426950408889634f * g1[j])) * u1[j]; }
                uint2 w; w.x = pack4_fp8(r[0], r[1], r[2], r[3]); w.y = pack4_fp8(r[4], r[5], r[6], r[7]);
                *(uint2*)rowp = w; asm volatile("" ::: "memory"); }
    }
};
struct EpiBf16Plain {
    static constexpr bool PERM = true, AFTER_DRAIN = false;
    bf16_t* O; int ldc;
    __device__ __forceinline__ void operator()(const f32x4 (&acc)[2][2][4][2], const Unit& u, int wr, int wc, int fr, int fq) const {
        const int row0 = u.pm * BM + wr * 64 + fr, col0 = u.pn * BM + wc * 32 + 8 * fq;
#pragma unroll
        for (int ai = 0; ai < 2; ++ai) if ((u.msk >> ai) & 1)
#pragma unroll
            for (int m = 0; m < 4; ++m) { bf16_t* rowp = O + (size_t)(row0 + ai * HALF + m * 16) * ldc + col0;
#pragma unroll
                for (int bj = 0; bj < 2; ++bj) { const f32x4 v0 = acc[ai][bj][m][0], v1 = acc[ai][bj][m][1];
                    u32x4 w; w.x = pack2(v0[0], v0[1]); w.y = pack2(v0[2], v0[3]); w.z = pack2(v1[0], v1[1]); w.w = pack2(v1[2], v1[3]);
                    *(u32x4*)(rowp + bj * HALF) = w; } }
    }
};
struct EpiResid {
    static constexpr bool PERM = false, AFTER_DRAIN = false;
    const float* res; float* out; int ldc; const float* gate0; float coef;
    float* slab; unsigned* flags; unsigned target;
    const float* res_hi; int row_hi;
    int res_bf16, out_bf16;
    __device__ __forceinline__ void operator()(const f32x4 (&acc)[2][2][4][2], const Unit& u, int wr, int wc, int fr, int fq) const {
        const int tidx = ((wr * 4 + wc) * 4 + fq) * 16 + fr;
        if (u.at == 1) {
            const __amdgpu_buffer_rsrc_t rs = __builtin_amdgcn_make_buffer_rsrc((void*)slab, 0, 0x7FFFFFF0, 0x00020000);
            const unsigned base = ((unsigned)u.slot * 32u * 512u + (unsigned)tidx) * 16u;
#pragma unroll
            for (int ai = 0; ai < 2; ++ai)
#pragma unroll
                for (int bj = 0; bj < 2; ++bj)
#pragma unroll
                    for (int m = 0; m < 4; ++m)
#pragma unroll
                        for (int n = 0; n < 2; ++n) { const f32x4 v = acc[ai][bj][m][n]; u32x4 w; w.x = __float_as_uint(v[0]); w.y = __float_as_uint(v[1]); w.z = __float_as_uint(v[2]); w.w = __float_as_uint(v[3]);
                            __builtin_amdgcn_raw_buffer_store_b128(w, rs, base + (unsigned)((((ai * 2 + bj) * 4 + m) * 2 + n) * 512 * 16), 0, 16); }
            asm volatile("s_waitcnt vmcnt(0)" ::: "memory");
            if ((tidx & 63) == 0) __hip_atomic_fetch_add(flags + 64 * u.slot, 1u, __ATOMIC_RELAXED, __HIP_MEMORY_SCOPE_AGENT);
            return;
        }
        const float* part = nullptr;
        if (u.at == 2) {
            unsigned spins = 0;
            while (__hip_atomic_load(flags + 64 * u.slot, __ATOMIC_RELAXED, __HIP_MEMORY_SCOPE_AGENT) < target) { __builtin_amdgcn_s_sleep(2); if (++spins > (1u << 22)) break; }
            __builtin_amdgcn_fence(__ATOMIC_ACQUIRE, "agent");
            asm volatile("s_waitcnt vmcnt(0)" ::: "memory");
            part = slab + ((size_t)u.slot * 32 * 512 + tidx) * 4;
        }
        const int row0 = u.pm * BM + wr * 64 + fr, col0 = u.pn * BM + wc * 32 + 4 * fq;
        const float* gate = gate0 + (size_t)cond_of_row(u.pm * BM) * NMOD;
        const float* rbase = (u.pm * BM >= row_hi) ? res_hi - (size_t)row_hi * ldc : res;
        f32x4 gv[2][2];
#pragma unroll
        for (int bj = 0; bj < 2; ++bj)
#pragma unroll
            for (int n = 0; n < 2; ++n) gv[bj][n] = *(const f32x4*)(gate + col0 + bj * HALF + n * 16) * coef;
#pragma unroll
        for (int ai = 0; ai < 2; ++ai) if ((u.msk >> ai) & 1) {
            f32x4 bs[4][2][2];
#pragma unroll
            for (int m = 0; m < 4; ++m) { const size_t off = (size_t)(row0 + ai * HALF + m * 16) * ldc + col0;
#pragma unroll
                for (int bj = 0; bj < 2; ++bj)
#pragma unroll
                    for (int n = 0; n < 2; ++n) {
                        const size_t eo = off + bj * HALF + n * 16;
                        if (res_bf16) { const u32x2 w = *(const u32x2*)((const bf16_t*)rbase + eo); bs[m][bj][n][0] = __uint_as_float(w.x << 16); bs[m][bj][n][1] = __uint_as_float(w.x & 0xFFFF0000u); bs[m][bj][n][2] = __uint_as_float(w.y << 16); bs[m][bj][n][3] = __uint_as_float(w.y & 0xFFFF0000u); }
                        else bs[m][bj][n] = *(const f32x4*)(rbase + eo); } }
            asm volatile("" ::: "memory");
#pragma unroll
            for (int m = 0; m < 4; ++m) { const size_t off = (size_t)(row0 + ai * HALF + m * 16) * ldc + col0;
#pragma unroll
                for (int bj = 0; bj < 2; ++bj)
#pragma unroll
                    for (int n = 0; n < 2; ++n) {
                        f32x4 a = acc[ai][bj][m][n];
                        if (part) a += *(const f32x4*)(part + (size_t)((((ai * 2 + bj) * 4 + m) * 2 + n) * 512 * 4));
                        const size_t eo = off + bj * HALF + n * 16;
                        const f32x4 o = bs[m][bj][n] + gv[bj][n] * a;
                        if (out_bf16) { u32x2 w; w.x = cvt_pk_bf16(o[0], o[1]); w.y = cvt_pk_bf16(o[2], o[3]); *(u32x2*)((bf16_t*)out + eo) = w; }
                        else *(f32x4*)(out + eo) = o; } }
            asm volatile("" ::: "memory"); }
    }
};
template <class Epi, class Sched, bool STAMP = false, int FP8 = 0>
__device__ __forceinline__ void gemm_phase(PG8_LAS unsigned char* lds, const Gemm g, const Sched& S, const Epi& E, unsigned long long* stamps) {
    const int tid = opaque_tid(), wid = __builtin_amdgcn_readfirstlane(tid >> 6), lane = tid & 63, wr = wid >> 2, wc = wid & 3, fr = lane & 15, fq = lane >> 4;
    const int K = g.K;
    int ts_lo = 0, ts_hi = 0, nts = 0; const unsigned long long rt_entry = STAMP ? (unsigned long long)wall_clock64() : 0ull;
#define PG8_STAMP() do { if (STAMP && wid == 0 && nts < 64) { const unsigned long long _c = (unsigned long long)clock64(); \
        ts_lo = (lane == nts) ? (int)(unsigned)_c : ts_lo; ts_hi = (lane == nts) ? (int)(unsigned)(_c >> 32) : ts_hi; ++nts; } } while (0)
    PG8_STAMP();
    unsigned voffA[2], voffB[2];
#pragma unroll
    for (int i = 0; i < 2; ++i) { int R, C; stage_rc(tid * 16 + i * 8192, R, C); const int Rb = Epi::PERM ? ((R & ~31) + perm32(R & 31)) : R;
        voffA[i] = (unsigned)(R * K + C) * 2u; voffB[i] = (unsigned)(Rb * K + C) * 2u; }
    const size_t kstep = (size_t)(BK * 2);
    const size_t hstep = (size_t)HALF * K * 2;
    const size_t tstep = 2 * hstep;
    const unsigned ldsw = (unsigned)wid * 1024u;
    const int aoff = lds_byte(wr * 64 + fr, fq * 8), boff = lds_byte(wc * 32 + fr, fq * 8);
#define PG8_SA(b, h) (((b) * 2 + (h)) * HTB)
#define PG8_SB(b, h) ((4 + (b) * 2 + (h)) * HTB)
#define PG8_STAGE(bufoff, gbase, voff) do { _Pragma("unroll") for (int _i = 0; _i < 2; ++_i) \
        __builtin_amdgcn_global_load_lds((const unsigned*)((const char*)(gbase) + (voff)[_i]), (PG8_LAS unsigned*)(lds + (bufoff) + ldsw + _i * 8192), 16, 0, 0); } while (0)
#define PG8_LDA(dst, b, h) do { _Pragma("unroll") for (int m = 0; m < 4; ++m) dst[m] = __builtin_shufflevector(*(const PG8_LAS v4i32*)(lds + PG8_SA(b, h) + aoff + m * 2048), *(const PG8_LAS v4i32*)(lds + PG8_SA(b, h) + aoff + m * 2048 + 1024), 0, 1, 2, 3, 4, 5, 6, 7); } while (0)
#define PG8_LDB(dst, b, h) do { _Pragma("unroll") for (int n = 0; n < 2; ++n) dst[n] = __builtin_shufflevector(*(const PG8_LAS v4i32*)(lds + PG8_SB(b, h) + boff + n * 2048), *(const PG8_LAS v4i32*)(lds + PG8_SB(b, h) + boff + n * 2048 + 1024), 0, 1, 2, 3, 4, 5, 6, 7); } while (0)
#define PG8_HALF(v, k) __builtin_bit_cast(bf16x8, __builtin_shufflevector(v, v, 4 * (k), 4 * (k) + 1, 4 * (k) + 2, 4 * (k) + 3))
#define PG8_MMA(ai, bj, At, Bt) do { __builtin_amdgcn_s_setprio(1); _Pragma("unroll") for (int m = 0; m < 4; ++m) _Pragma("unroll") for (int n = 0; n < 2; ++n) { \
        acc[ai][bj][m][n] = __builtin_amdgcn_mfma_f32_16x16x32_bf16(PG8_HALF(Bt[n], 0), PG8_HALF(At[m], 0), acc[ai][bj][m][n], 0, 0, 0); \
        acc[ai][bj][m][n] = __builtin_amdgcn_mfma_f32_16x16x32_bf16(PG8_HALF(Bt[n], 1), PG8_HALF(At[m], 1), acc[ai][bj][m][n], 0, 0, 0); } __builtin_amdgcn_s_setprio(0); } while (0)
#define PG8_MMA8(ai, bj, At, Bt) do { __builtin_amdgcn_s_setprio(1); _Pragma("unroll") for (int m = 0; m < 4; ++m) _Pragma("unroll") for (int n = 0; n < 2; ++n) \
        acc[ai][bj][m][n] = __builtin_amdgcn_mfma_scale_f32_16x16x128_f8f6f4(Bt[n], At[m], acc[ai][bj][m][n], 0, 0, 0, 127, 0, 127); __builtin_amdgcn_s_setprio(0); } while (0)
#define PG8_Q64(v, q) __builtin_bit_cast(long, __builtin_shufflevector(v, v, 2 * (q), 2 * (q) + 1))
#define PG8_M8L1(ai, bj, m, n, q) acc[ai][bj][m][n] = __builtin_amdgcn_mfma_f32_16x16x32_fp8_fp8(PG8_Q64(Bt_[n], q), PG8_Q64(At_[m], q), acc[ai][bj][m][n], 0, 0, 0)
#define PG8_MMA8L(ai, bj, At, Bt) do { auto& At_ = At; auto& Bt_ = Bt; __builtin_amdgcn_s_setprio(1); _Pragma("unroll") for (int m = 0; m < 4; ++m) _Pragma("unroll") for (int n = 0; n < 2; ++n) { \
        PG8_M8L1(ai, bj, m, n, 0); PG8_M8L1(ai, bj, m, n, 1); PG8_M8L1(ai, bj, m, n, 2); PG8_M8L1(ai, bj, m, n, 3); } __builtin_amdgcn_s_setprio(0); } while (0)
#define PG8_MMAG(ai, bj, At, Bt) do { if (mrow & (1 << (ai))) { if constexpr (FP8 == 1) PG8_MMA8(ai, bj, At, Bt); else if constexpr (FP8 == 2) PG8_MMA8L(ai, bj, At, Bt); else PG8_MMA(ai, bj, At, Bt); } } while (0)
#define PG8_WAIT_V(n) asm volatile("s_waitcnt vmcnt(" #n ")" ::: "memory")
#define PG8_WAIT_L(n) asm volatile("s_waitcnt lgkmcnt(" #n ")" ::: "memory")
#define PG8_BAR __builtin_amdgcn_s_barrier()
#define PG8_SCHED __builtin_amdgcn_sched_barrier(0)
    Unit cur, nxt; int ui = 0;
    if (!S.next(0, cur)) return;
    f32x4 acc[2][2][4][2];
#pragma unroll
    for (int a = 0; a < 2; ++a)
#pragma unroll
        for (int b = 0; b < 2; ++b)
#pragma unroll
            for (int m = 0; m < 4; ++m)
#pragma unroll
                for (int n = 0; n < 2; ++n) acc[a][b][m][n] = (f32x4){0.f, 0.f, 0.f, 0.f};
    v8i32 At[4], B0[2], B1[2];
    const char* cA = (const char*)g.A + (size_t)cur.pm * tstep + (size_t)cur.k0 * 2; const char* cB = (const char*)g.Bt + (size_t)cur.pn * tstep + (size_t)cur.k0 * 2;
    S.a_ready(cur);
    PG8_STAGE(PG8_SB(0, 0), cB, voffB); PG8_STAGE(PG8_SA(0, 0), cA, voffA); PG8_STAGE(PG8_SB(0, 1), cB + hstep, voffB); PG8_STAGE(PG8_SA(0, 1), cA + hstep, voffA);
    if (wr == 1) PG8_BAR;
    PG8_WAIT_V(4); PG8_BAR;
    PG8_STAGE(PG8_SB(1, 0), cB + kstep, voffB); PG8_STAGE(PG8_SA(1, 0), cA + kstep, voffA); PG8_STAGE(PG8_SB(1, 1), cB + hstep + kstep, voffB);
    PG8_WAIT_V(6); PG8_BAR;
    PG8_STAMP();
    for (;;) {
        const bool has_next = S.next(ui + 1, nxt);
        const char* nA = has_next ? (const char*)g.A + (size_t)nxt.pm * tstep + (size_t)nxt.k0 * 2 : cA; const char* nB = has_next ? (const char*)g.Bt + (size_t)nxt.pn * tstep + (size_t)nxt.k0 * 2 : cB;
        const int nt = cur.nt, mrow = cur.msk;
        for (int t = 0; t < nt; t += 2) {
            const bool last = (t == nt - 2);
            const char* a1 = cA + (size_t)(t + 1) * kstep;
            const char* a2 = last ? nA : cA + (size_t)(t + 2) * kstep; const char* b2 = last ? nB : cB + (size_t)(t + 2) * kstep;
            const char* a3 = a2 + kstep; const char* b3 = b2 + kstep;
            if (last && has_next) S.a_ready(nxt);
            PG8_LDB(B0, 0, 0); PG8_SCHED; PG8_LDA(At, 0, 0); PG8_STAGE(PG8_SA(1, 1), a1 + hstep, voffA);
            PG8_WAIT_L(8); PG8_BAR; PG8_WAIT_L(0); PG8_MMAG(0, 0, At, B0); PG8_BAR; PG8_SCHED;
            PG8_LDB(B1, 0, 1); PG8_STAGE(PG8_SB(0, 0), b2, voffB);
            PG8_BAR; PG8_WAIT_L(0); PG8_MMAG(0, 1, At, B1); PG8_BAR;
            PG8_LDA(At, 0, 1); PG8_STAGE(PG8_SA(0, 0), a2, voffA);
            PG8_BAR; PG8_WAIT_L(0); PG8_MMAG(1, 0, At, B0); PG8_BAR; PG8_SCHED;
            PG8_STAGE(PG8_SB(0, 1), b2 + hstep, voffB);
            PG8_WAIT_V(6); PG8_BAR; PG8_MMAG(1, 1, At, B1); PG8_BAR;
            PG8_LDB(B0, 1, 0); PG8_SCHED; PG8_LDA(At, 1, 0); PG8_STAGE(PG8_SA(0, 1), a2 + hstep, voffA);
            PG8_WAIT_L(8); PG8_BAR; PG8_WAIT_L(0); PG8_MMAG(0, 0, At, B0); PG8_BAR; PG8_SCHED;
            PG8_LDB(B1, 1, 1); PG8_STAGE(PG8_SB(1, 0), b3, voffB);
            PG8_BAR; PG8_WAIT_L(0); PG8_MMAG(0, 1, At, B1); PG8_BAR;
            PG8_LDA(At, 1, 1); PG8_STAGE(PG8_SA(1, 0), a3, voffA);
            PG8_BAR; PG8_WAIT_L(0); PG8_MMAG(1, 0, At, B0); PG8_BAR; PG8_SCHED;
            PG8_STAGE(PG8_SB(1, 1), b3 + hstep, voffB);
            PG8_WAIT_V(6); PG8_BAR; PG8_MMAG(1, 1, At, B1); PG8_BAR;
        }
        PG8_STAMP();
        if constexpr (!Epi::AFTER_DRAIN) { E(acc, cur, wr, wc, fr, fq); S.done(cur); }
        PG8_STAMP();
        if (!has_next) break;
#pragma unroll
        for (int a = 0; a < 2; ++a)
#pragma unroll
            for (int b = 0; b < 2; ++b)
#pragma unroll
                for (int m = 0; m < 4; ++m)
#pragma unroll
                    for (int n = 0; n < 2; ++n) acc[a][b][m][n] = (f32x4){0.f, 0.f, 0.f, 0.f};
        cur = nxt; cA = nA; cB = nB; ++ui;
    }
    PG8_WAIT_V(0);
    if (wr == 0) PG8_BAR;
    PG8_BAR;
    if constexpr (Epi::AFTER_DRAIN) { E.fused(acc, cur, wr, wc, fr, fq, lds, wid, lane); S.done(cur); }
    PG8_STAMP();
    if (STAMP && wid == 0) { stamps[lane] = lane < nts ? (((unsigned long long)(unsigned)ts_hi << 32) | (unsigned)ts_lo) : 0ull;
        if (lane == 62) stamps[62] = rt_entry; if (lane == 63) stamps[63] = (unsigned long long)wall_clock64(); }
#undef PG8_STAMP
#undef PG8_SA
#undef PG8_SB
#undef PG8_STAGE
#undef PG8_LDA
#undef PG8_LDB
#undef PG8_HALF
#undef PG8_MMA
#undef PG8_MMA8
#undef PG8_MMA8L
#undef PG8_M8L1
#undef PG8_Q64
#undef PG8_MMAG
#undef PG8_WAIT_V
#undef PG8_WAIT_L
#undef PG8_BAR
#undef PG8_SCHED
}
}
#ifndef ATT_INLINE
#define ATT_INLINE __forceinline__
#endif
namespace att {
constexpr int D = 128, NW = 8, QBLK = 32, KVBLK = 64, LDQ = 512, LDO = DM;
constexpr float SCALE = 0.088388347648318440f;
constexpr float THR = 8.f;
constexpr size_t SHM_V = KVBLK * D * 2, SHM_K = KVBLK * D * 2, SHM_Q = 256 * D * 2, SHM_ATTN = 2 * SHM_V + 2 * SHM_K + NW * 64 * 4 + SHM_Q;
using bf16x8 = __attribute__((ext_vector_type(8))) short;
using s16x4  = __attribute__((ext_vector_type(4))) short;
using f32x16 = __attribute__((ext_vector_type(16))) float;
using u32x4  = __attribute__((ext_vector_type(4))) unsigned;
#define KSWZ(row, colB) ((row) * 256 + ((colB) ^ (((row) & 7) << 4)))
#define SBAR() __builtin_amdgcn_sched_barrier(0)
__device__ __forceinline__ int crow(int r, int hi) { return (r & 3) + 8 * (r >> 2) + 4 * hi; }
__device__ __forceinline__ unsigned cvtpk(float lo, float hi) { unsigned r; asm volatile("v_cvt_pk_bf16_f32 %0, %1, %2" : "=v"(r) : "v"(lo), "v"(hi)); return r; }

__device__ __forceinline__ void partialSM(f32x16& p0, f32x16& p1, float& m_reg, float& mn, float& alpha) {
  constexpr float C = SCALE * 1.4426950408889634f;
  float pmax = p0[0]; for (int r = 1; r < 16; ++r) pmax = fmaxf(pmax, p0[r]); for (int r = 0; r < 16; ++r) pmax = fmaxf(pmax, p1[r]);
  { auto rr = __builtin_amdgcn_permlane32_swap(__float_as_uint(pmax), __float_as_uint(pmax), false, false);
    pmax = fmaxf(__uint_as_float(rr[0]), __uint_as_float(rr[1])); }
  if (__builtin_expect(__all(pmax - m_reg <= THR / SCALE), 1)) { mn = m_reg; alpha = 1.f; }
  else { mn = fmaxf(m_reg, pmax); alpha = __builtin_amdgcn_exp2f((m_reg - mn) * C); m_reg = mn; }
  float mnC = -mn * C;
  for (int r = 0; r < 16; ++r) p0[r] = fmaf(p0[r], C, mnC); for (int r = 0; r < 16; ++r) p1[r] = fmaf(p1[r], C, mnC);
  for (int r = 0; r < 16; ++r) p0[r] = __builtin_amdgcn_exp2f(p0[r]);
}
__device__ __forceinline__ void finishSM(f32x16& p0, f32x16& p1, float alpha, float& l_reg, bf16x8& pa0, bf16x8& pa1, bf16x8& pa2, bf16x8& pa3) {
  for (int r = 0; r < 16; ++r) p1[r] = __builtin_amdgcn_exp2f(p1[r]);
  float ps = 0; for (int r = 0; r < 16; ++r) ps += p0[r]; for (int r = 0; r < 16; ++r) ps += p1[r];
  { auto rr = __builtin_amdgcn_permlane32_swap(__float_as_uint(ps), __float_as_uint(ps), false, false);
    ps = __uint_as_float(rr[0]) + __uint_as_float(rr[1]); }
  l_reg = l_reg * alpha + ps;
#define PK4(P, BASE, OUT) do { unsigned a0 = cvtpk(P[BASE + 0], P[BASE + 1]), a1 = cvtpk(P[BASE + 2], P[BASE + 3]);   \
    unsigned b0 = cvtpk(P[BASE + 4], P[BASE + 5]), b1 = cvtpk(P[BASE + 6], P[BASE + 7]);                              \
    auto r0 = __builtin_amdgcn_permlane32_swap(a0, b0, false, false); auto r1 = __builtin_amdgcn_permlane32_swap(a1, b1, false, false); \
    u32x4 w = {r0[0], r1[0], r0[1], r1[1]}; OUT = *reinterpret_cast<bf16x8*>(&w); } while (0)
  PK4(p0, 0, pa0); PK4(p0, 8, pa1); PK4(p1, 0, pa2); PK4(p1, 8, pa3);
#undef PK4
}
__device__ __forceinline__ void qkt(f32x16& p0, f32x16& p1, const bf16_t* Ks, const bf16_t* Qs, int qrow, int r32, int hi) {
  p0 = f32x16{}; p1 = f32x16{};
#pragma unroll
  for (int d0 = 0; d0 < 8; ++d0) { int cb = (d0 * 16 + hi * 8) * 2;
    bf16x8 q = *reinterpret_cast<const bf16x8*>((const char*)Qs + KSWZ(qrow, cb));
    bf16x8 b0 = *reinterpret_cast<const bf16x8*>((const char*)Ks + KSWZ(r32, cb));
    bf16x8 b1 = *reinterpret_cast<const bf16x8*>((const char*)Ks + KSWZ(32 + r32, cb));
    p0 = __builtin_amdgcn_mfma_f32_32x32x16_bf16(b0, q, p0, 0, 0, 0);
    p1 = __builtin_amdgcn_mfma_f32_32x32x16_bf16(b1, q, p1, 0, 0, 0); }
}
__device__ __forceinline__ int v_st(int k, int c) { const int kk = (k & ~0xC) | ((k & 4) << 1) | ((k & 8) >> 1); return ((kk >> 3) * 4 + (c >> 5)) * 512 + ((kk & 7) * 32 + (c & 31)) * 2; }
__device__ __forceinline__ int v_rd_base(int lane) { return ((lane & 3) << 3) | (((lane >> 2) & 3) << 6) | (((lane >> 4) & 1) << 5) | (((lane >> 5) & 1) << 8); }
constexpr int v_rd_off(int d0, int ks, int half) { return d0 * 512 + ks * 4096 + half * 2048; }
template <int OFF> __device__ __forceinline__ s16x4 tr_read(int vb) {
  s16x4 r; asm volatile("ds_read_b64_tr_b16 %0, %1 offset:%2" : "=&v"(r) : "v"(vb), "i"(OFF) : "memory"); return r;
}
template <int D0> __device__ __forceinline__ void pv_one(f32x16& od, int vb, bf16x8 pa0, bf16x8 pa1, bf16x8 pa2, bf16x8 pa3) {
  const s16x4 l0 = tr_read<v_rd_off(D0, 0, 0)>(vb), h0 = tr_read<v_rd_off(D0, 0, 1)>(vb), l1 = tr_read<v_rd_off(D0, 1, 0)>(vb), h1 = tr_read<v_rd_off(D0, 1, 1)>(vb);
  const s16x4 l2 = tr_read<v_rd_off(D0, 2, 0)>(vb), h2 = tr_read<v_rd_off(D0, 2, 1)>(vb), l3 = tr_read<v_rd_off(D0, 3, 0)>(vb), h3 = tr_read<v_rd_off(D0, 3, 1)>(vb);
  asm volatile("s_waitcnt lgkmcnt(0)" ::: "memory"); SBAR();
#define PK(L, H) (bf16x8){L[0], L[1], L[2], L[3], H[0], H[1], H[2], H[3]}
  od = __builtin_amdgcn_mfma_f32_32x32x16_bf16(pa0, PK(l0, h0), od, 0, 0, 0);
  od = __builtin_amdgcn_mfma_f32_32x32x16_bf16(pa1, PK(l1, h1), od, 0, 0, 0);
  od = __builtin_amdgcn_mfma_f32_32x32x16_bf16(pa2, PK(l2, h2), od, 0, 0, 0);
  od = __builtin_amdgcn_mfma_f32_32x32x16_bf16(pa3, PK(l3, h3), od, 0, 0, 0);
#undef PK
}
__device__ __forceinline__ void pv_d0(f32x16* o, int vb, bf16x8 pa0, bf16x8 pa1, bf16x8 pa2, bf16x8 pa3) {
  pv_one<0>(o[0], vb, pa0, pa1, pa2, pa3); pv_one<1>(o[1], vb, pa0, pa1, pa2, pa3); pv_one<2>(o[2], vb, pa0, pa1, pa2, pa3); pv_one<3>(o[3], vb, pa0, pa1, pa2, pa3);
}

struct SrcOne { const bf16_t* k0; const bf16_t* v0; int ldk;
  __device__ __forceinline__ const bf16_t* k(int j) const { return k0 + (size_t)j * 64 * ldk; }
  __device__ __forceinline__ const bf16_t* v(int j) const { return v0 + (size_t)j * 64 * ldk; } };
struct SrcTwo { const bf16_t* ck; const bf16_t* cv; const bf16_t* k1; const bf16_t* v1; int ldk;
  __device__ __forceinline__ const bf16_t* k(int j) const { return j < 4 ? ck + (size_t)j * 64 * ldk : k1 + (size_t)(j - 4) * 64 * ldk; }
  __device__ __forceinline__ const bf16_t* v(int j) const { return j < 4 ? cv + (size_t)j * 64 * ldk : v1 + (size_t)(j - 4) * 64 * ldk; } };
struct NoBias { __device__ __forceinline__ void operator()(f32x16&, f32x16&, int, int, int, int) const {} };
struct NaBias { const float* tab; int i0, kr0;
  __device__ __forceinline__ void operator()(f32x16& p0, f32x16& p1, int jt, int wid, int r32, int hi) const {
    if (jt < 4) return;
    const int qi = i0 + wid * QBLK + r32, r = qi >> 6, qc = qi & 63, kr = kr0 + jt - 4;
    int lo = r - 4; lo = lo < 0 ? 0 : (lo > 8 ? 8 : lo);
    const bool rowok = (kr >= lo) && (kr < lo + 8);
    if (!rowok) {
#pragma unroll
      for (int rr = 0; rr < 16; ++rr) { p0[rr] = -1e30f; p1[rr] = -1e30f; }
      return;
    }
    int c0 = qc - 8; c0 = c0 < 0 ? 0 : (c0 > 48 ? 48 : c0);
    const int dr = kr - r + 7;
    const float* tb = tab + dr * 31 + (4 * hi - qc + 15);
    const int w0 = 4 * hi - c0;
#pragma unroll
    for (int g = 0; g < 4; ++g) {
#pragma unroll
      for (int q = 0; q < 4; ++q) {
        const int rr = 4 * g + q, kc0 = q + 8 * g;
        const float t0 = tb[kc0], t1 = tb[kc0 + 32];
        p0[rr] = ((unsigned)(kc0 + w0) < 16u) ? p0[rr] + t0 : -1e30f;
        p1[rr] = ((unsigned)(kc0 + 32 + w0) < 16u) ? p1[rr] + t1 : -1e30f;
      }
      SBAR();
    }
  } };

template <int SD, class Src, class Bias>
__device__ ATT_INLINE void attn_body(const bf16_t* __restrict__ Qb, const Src src, bf16_t* __restrict__ Ob, const int NT, char* lds, const Bias bias) {
  const int tid = opaque_tid(), wid = tid >> 6, lane = tid & 63, r32 = lane & 31, hi = lane >> 5;
  const int LDK = src.ldk;
  bf16_t* V_lds = (bf16_t*)lds; bf16_t* K_lds = (bf16_t*)(lds + 2 * SHM_V);
  float* ws = (float*)(lds + 2 * SHM_V + 2 * SHM_K) + wid * 64; float* li_l = ws; float* al_l = ws + 32;
  float m_reg = -1e30f, l_reg = 0; f32x16 o[4] = {};
  bf16_t* Q_lds = (bf16_t*)(lds + 2 * SHM_V + 2 * SHM_K + NW * 64 * 4);
  const int qrow = wid * QBLK + r32;
  {
#pragma unroll
    for (int i = 0; i < 8; ++i) { const int f = tid + 512 * i, row = f >> 4, c8 = (f & 15) * 8;
      *(bf16x8*)((char*)Q_lds + KSWZ(row, c8 * 2)) = *reinterpret_cast<const bf16x8*>(Qb + (long)row * LDQ + c8); }
  }
  const int sr = tid >> 4, sc = (tid & 15) * 8, vst0 = v_st(sr, sc), vst1 = v_st(32 + sr, sc);
  const int vb0 = (int)(uintptr_t)V_lds + v_rd_base(lane);
  struct { bf16x8 vs0, vs1, ks0, ks1; } sr_[SD];
#define SLOAD(i, jt) do { const bf16_t* kt_ = src.k(jt); const bf16_t* vt_ = src.v(jt); \
    sr_[i].vs0 = *reinterpret_cast<const bf16x8*>(&vt_[(long)sr * LDK + sc]); sr_[i].vs1 = *reinterpret_cast<const bf16x8*>(&vt_[(long)(32 + sr) * LDK + sc]); \
    sr_[i].ks0 = *reinterpret_cast<const bf16x8*>(&kt_[(long)sr * LDK + sc]); sr_[i].ks1 = *reinterpret_cast<const bf16x8*>(&kt_[(long)(32 + sr) * LDK + sc]); } while (0)
#define SWRITE(b, i) do { *(bf16x8*)((char*)V_lds + (b) * SHM_V + vst0) = sr_[i].vs0;          \
    *(bf16x8*)((char*)V_lds + (b) * SHM_V + vst1) = sr_[i].vs1; int kc = sc * 2;               \
    *(bf16x8*)((char*)K_lds + (b) * SHM_K + KSWZ(sr, kc)) = sr_[i].ks0;                       \
    *(bf16x8*)((char*)K_lds + (b) * SHM_K + KSWZ(32 + sr, kc)) = sr_[i].ks1; } while (0)
#define SWAIT() do { if constexpr (SD == 2) asm volatile("s_waitcnt vmcnt(4)" ::: "memory"); else asm volatile("s_waitcnt vmcnt(0)" ::: "memory"); } while (0)
#define RESC(a) do { if (__any((a) < 1.f)) { if (hi == 0) al_l[r32] = (a); asm volatile("s_waitcnt lgkmcnt(0)" ::: "memory"); \
    for (int d = 0; d < 4; ++d) for (int r = 0; r < 16; ++r) o[d][r] *= al_l[crow(r, hi)]; } } while (0)
  f32x16 pA0, pA1, pB0, pB1; float mnA, mnB, alA, alB; bf16x8 pa0, pa1, pa2, pa3;
  constexpr int SE = 0, SO = SD - 1;
  SLOAD(SE, 0); asm volatile("s_waitcnt vmcnt(0)" ::: "memory"); SWRITE(0, SE); __syncthreads();
  qkt(pA0, pA1, K_lds, Q_lds, qrow, r32, hi); bias(pA0, pA1, 0, wid, r32, hi); partialSM(pA0, pA1, m_reg, mnA, alA);
  SLOAD(SO, 1); if constexpr (SD == 2) { if (2 < NT) SLOAD(SE, 2); }
  SWAIT(); SWRITE(1, SO); __syncthreads();
  for (int j = 1; j + 1 < NT; j += 2) {
    SBAR(); qkt(pB0, pB1, (bf16_t*)((char*)K_lds + SHM_K), Q_lds, qrow, r32, hi); bias(pB0, pB1, j, wid, r32, hi);
    finishSM(pA0, pA1, alA, l_reg, pa0, pa1, pa2, pa3); SBAR();
    SLOAD(SO, j + SD); SBAR();
    pv_d0(o, vb0, pa0, pa1, pa2, pa3); partialSM(pB0, pB1, m_reg, mnB, alB);
    __syncthreads(); SWAIT(); SWRITE(0, SE);
    RESC(alB); __syncthreads();
    SBAR(); qkt(pA0, pA1, K_lds, Q_lds, qrow, r32, hi); bias(pA0, pA1, j + 1, wid, r32, hi);
    finishSM(pB0, pB1, alB, l_reg, pa0, pa1, pa2, pa3); SBAR();
    if (SD == 1 || j + 3 < NT) SLOAD(SE, j + 1 + SD); SBAR();
    pv_d0(o, vb0 + (int)SHM_V, pa0, pa1, pa2, pa3); partialSM(pA0, pA1, m_reg, mnA, alA);
    __syncthreads(); SWAIT(); SWRITE(1, SO);
    RESC(alA); __syncthreads();
  }
  SBAR(); qkt(pB0, pB1, (bf16_t*)((char*)K_lds + SHM_K), Q_lds, qrow, r32, hi); bias(pB0, pB1, NT - 1, wid, r32, hi);
  finishSM(pA0, pA1, alA, l_reg, pa0, pa1, pa2, pa3); SBAR();
  pv_d0(o, vb0, pa0, pa1, pa2, pa3); partialSM(pB0, pB1, m_reg, mnB, alB);
  __syncthreads(); RESC(alB);
  finishSM(pB0, pB1, alB, l_reg, pa0, pa1, pa2, pa3); SBAR();
  pv_d0(o, vb0 + (int)SHM_V, pa0, pa1, pa2, pa3);
  if (hi == 0) li_l[r32] = l_reg; asm volatile("s_waitcnt lgkmcnt(0)" ::: "memory");
  float rli[16];
#pragma unroll
  for (int r = 0; r < 16; ++r) rli[r] = __builtin_amdgcn_rcpf(li_l[crow(r, hi)]);
  bf16_t* Ow = Ob + (long)(wid * QBLK) * LDO;
#pragma unroll
  for (int r = 0; r < 16; ++r) { int orow = crow(r, hi);
    for (int d0 = 0; d0 < 4; ++d0) Ow[(long)orow * LDO + d0 * 32 + r32] = f2bf(o[d0][r] * rli[r]); }
#undef SLOAD
#undef SWRITE
#undef SWAIT
#undef RESC
}
}
#define H16(w, j) ((bf16_t)(((j) & 1) ? ((j) < 2 ? (w).x >> 16 : (w).y >> 16) : ((j) < 2 ? (w).x & 0xFFFFu : (w).y & 0xFFFFu)))
#define DPPU(v, ctrl, rmask) __int_as_float(__builtin_amdgcn_update_dpp(0, __float_as_int(v), (ctrl), (rmask), 0xF, false))
__device__ __forceinline__ float scan32(float x) { x += DPPU(x, 0x111, 0xF); x += DPPU(x, 0x112, 0xF); x += DPPU(x, 0x114, 0xF); x += DPPU(x, 0x118, 0xF); x += DPPU(x, 0x142, 0xA); return x; }
__device__ __forceinline__ float last32(float x, int lane) { const float a = __int_as_float(__builtin_amdgcn_readlane(__float_as_int(x), 31)), b = __int_as_float(__builtin_amdgcn_readlane(__float_as_int(x), 63)); return lane < 32 ? a : b; }
namespace gdn {
using att::bf16x8; using att::f32x16; using att::crow;
constexpr int C = 32, SK = 136, SS = 40;
constexpr int OFF_KT = 0, OFF_QT = OFF_KT + C * SK * 2, OFF_W = OFF_QT + C * SK * 2, OFF_KTT = OFF_W + C * SK * 2, OFF_VTT = OFF_KTT + 128 * SS * 2,
              OFF_VN = OFF_VTT + 128 * SS * 2, OFF_VNS = OFF_VN + 128 * SS * 2, OFF_ST = OFF_VNS + 128 * SS * 2, OFF_TB = OFF_ST + 128 * SK * 2,
              OFF_TBE = OFF_TB + C * SS * 2, OFF_ATT = OFF_TBE + C * SS * 2, OFF_L = OFF_ATT + C * SS * 2, OFF_SC = OFF_L + C * C * 4, GDN_LDS = OFF_SC + 1024;
template <int K>
__device__ __forceinline__ f32x16 mm(const bf16_t* A, int lda, const bf16_t* Bt, int ldb, int l32, int hi, f32x16 acc) {
#pragma unroll
    for (int k0 = 0; k0 < K; k0 += 16) {
        const bf16x8 a = *reinterpret_cast<const bf16x8*>(A + l32 * lda + k0 + 8 * hi);
        const bf16x8 b = *reinterpret_cast<const bf16x8*>(Bt + l32 * ldb + k0 + 8 * hi);
        acc = __builtin_amdgcn_mfma_f32_32x32x16_bf16(a, b, acc, 0, 0, 0);
    }
    return acc;
}
__device__ __forceinline__ uint2 pk4(float a, float b, float c, float d) { uint2 w; w.x = pack2(a, b); w.y = pack2(c, d); return w; }

__device__ __forceinline__ void gdn_chunked(const Params& p, int l, bool ctx, int b, int h, int dir, unsigned char* lds) {
    const int tid = opaque_tid(), wid = tid >> 6, lane = tid & 63, l32 = lane & 31, hi = lane >> 5;
    const int T = ctx ? CT : ::LT; const size_t m0 = ctx ? (size_t)b * CT : (size_t)MC + (size_t)b * ::LT;
    const bf16_t* DQ = WSP(bf16_t, WS_DQ); const bf16_t* DK = WSP(bf16_t, WS_DK); const bf16_t* DV = WSP(bf16_t, WS_DV); const float* DBA = WSP(float, WS_DBA);
    float* O = WSP(float, dir ? WS_DOB : WS_DOF);
    bf16_t* Kt = (bf16_t*)(lds + OFF_KT); bf16_t* Qt = (bf16_t*)(lds + OFF_QT); bf16_t* W = (bf16_t*)(lds + OFF_W); bf16_t* KT = (bf16_t*)(lds + OFF_KTT); bf16_t* VT = (bf16_t*)(lds + OFF_VTT);
    bf16_t* VN = (bf16_t*)(lds + OFF_VN); bf16_t* VNS = (bf16_t*)(lds + OFF_VNS); bf16_t* ST = (bf16_t*)(lds + OFF_ST); bf16_t* TB = (bf16_t*)(lds + OFF_TB); bf16_t* TBE = (bf16_t*)(lds + OFF_TBE);
    bf16_t* ATT = (bf16_t*)(lds + OFF_ATT); float* Lm = (float*)(lds + OFF_L); float* sc = (float*)(lds + OFF_SC);
    const int nch = T / C;
#define TOK(c, s_) (m0 + (dir ? T - 1 - ((c) * C + (s_)) : (c) * C + (s_)))
    f32x16 S[2];
#pragma unroll
    for (int bi = 0; bi < 2; ++bi) {
        const int blk = wid * 2 + bi, d0 = 32 * (blk >> 2), e0 = 32 * (blk & 3);
        if (ctx) { S[bi] = f32x16{}; }
        else {
            const float* s0 = p.in[I_SGDN] + ((((size_t)b * DEPTH + l) * 2 + dir) * 4 + h) * 128 * 128 + e0 + l32;
#pragma unroll
            for (int r = 0; r < 16; ++r) S[bi][r] = s0[(size_t)(d0 + crow(r, hi)) * 128];
        }
    }
    const int ts = tid & 31, c0 = (tid >> 5) * 4, c1 = 64 + c0;
    uint2 rq0, rq1, rk0, rk1, rv0, rv1; float pbeta = 0.f, pg = 0.f;
#define GLOAD(c) do { const size_t mt_ = TOK(c, ts); \
        rq0 = *(const uint2*)(DQ + mt_ * 512 + h * 128 + c0); rq1 = *(const uint2*)(DQ + mt_ * 512 + h * 128 + c1); \
        rk0 = *(const uint2*)(DK + mt_ * 512 + h * 128 + c0); rk1 = *(const uint2*)(DK + mt_ * 512 + h * 128 + c1); \
        rv0 = *(const uint2*)(DV + mt_ * 512 + h * 128 + c0); rv1 = *(const uint2*)(DV + mt_ * 512 + h * 128 + c1); \
        if (tid < C) { const size_t mt = TOK(c, tid); pbeta = DBA[mt * 16 + dir * 4 + h]; pg = DBA[mt * 16 + 8 + dir * 4 + h]; } } while (0)
#define GSTAGE() do { \
        *(uint2*)(Kt + ts * SK + c0) = rk0; *(uint2*)(Kt + ts * SK + c1) = rk1; \
        *(uint2*)(Qt + ts * SK + c0) = rq0; *(uint2*)(Qt + ts * SK + c1) = rq1; \
        _Pragma("unroll") for (int j = 0; j < 4; ++j) { KT[(c0 + j) * SS + ts] = H16(rk0, j); KT[(c1 + j) * SS + ts] = H16(rk1, j); \
                                                        VT[(c0 + j) * SS + ts] = H16(rv0, j); VT[(c1 + j) * SS + ts] = H16(rv1, j); } \
        if (wid == 0) { float x = pg; _Pragma("unroll") for (int o_ = 1; o_ < 32; o_ <<= 1) { const float y = __shfl_up(x, o_); if (lane >= o_) x += y; } \
            const float Bt_ = __shfl(x, 31); if (lane < C) { sc[lane] = pbeta; sc[32 + lane] = x; sc[64 + lane] = __expf(x); sc[96 + lane] = __expf(Bt_ - x); if (lane == 0) sc[128] = __expf(Bt_); } } } while (0)
    __syncthreads();
    GLOAD(0);
#pragma unroll
    for (int bi = 0; bi < 2; ++bi) {
        const int blk = wid * 2 + bi, d0 = 32 * (blk >> 2), e0 = 32 * (blk & 3);
#pragma unroll
        for (int g = 0; g < 4; ++g) *(uint2*)(ST + (e0 + l32) * SK + d0 + 8 * g + 4 * hi) = pk4(S[bi][4 * g], S[bi][4 * g + 1], S[bi][4 * g + 2], S[bi][4 * g + 3]);
    }
    GSTAGE();
    __syncthreads();
    for (int c = 0; c < nch; ++c) {
        if (c + 1 < nch) GLOAD(c + 1);
        f32x16 acc1 = f32x16{};
        if (wid == 0) {
            const f32x16 kk = mm<128>(Kt, SK, Kt, SK, l32, hi, f32x16{});
            const float bi_ = sc[32 + l32], be = sc[l32];
#pragma unroll
            for (int r = 0; r < 16; ++r) { const int j = crow(r, hi); const float v = (l32 > j) ? be * kk[r] * __expf(bi_ - sc[32 + j]) : 0.f;
                Lm[l32 * 32 + ((((r & 3) + 4 * hi) ^ (l32 & 7)) * 4) + (r >> 2)] = v; }
        } else if (wid == 1) {
            const f32x16 kq = mm<128>(Kt, SK, Qt, SK, l32, hi, f32x16{});
            const float bi_ = sc[32 + l32];
            float a[16];
#pragma unroll
            for (int r = 0; r < 16; ++r) { const int j = crow(r, hi); a[r] = (l32 >= j) ? kq[r] * __expf(bi_ - sc[32 + j]) : 0.f; }
#pragma unroll
            for (int g = 0; g < 4; ++g) *(uint2*)(ATT + l32 * SS + 8 * g + 4 * hi) = pk4(a[4 * g], a[4 * g + 1], a[4 * g + 2], a[4 * g + 3]);
        } else if (wid >= 4) {
            acc1 = mm<128>(Qt, SK, ST + (32 * (wid - 4)) * SK, SK, l32, hi, f32x16{});
#pragma unroll
            for (int r = 0; r < 16; ++r) acc1[r] *= sc[64 + crow(r, hi)];
        }
        __syncthreads();
        if (tid < 256) {
            const int cc = tid >> 3, part = tid & 7;
            float Tr[4] = {0.f, 0.f, 0.f, 0.f};
#pragma unroll
            for (int i = 0; i < 32; ++i) {
                const vf4 lv = *(const vf4*)(Lm + i * 32 + ((part ^ (i & 7)) * 4));
                float s = lv.x * Tr[0] + lv.y * Tr[1] + lv.z * Tr[2] + lv.w * Tr[3];
                s = red8(s);
                const float t = (i == cc ? 1.f : 0.f) - s;
                if (part == (i & 7)) Tr[i >> 3] = t;
            }
            const float bc = sc[cc], bec = bc * sc[64 + cc];
#pragma unroll
            for (int jj = 0; jj < 4; ++jj) { TB[(part + 8 * jj) * SS + cc] = f2bf(Tr[jj] * bc); TBE[(part + 8 * jj) * SS + cc] = f2bf(Tr[jj] * bec); }
        }
        __syncthreads();
        if (wid < 4) {
            acc1 = mm<32>(TB, SS, VT + (32 * wid) * SS, SS, l32, hi, f32x16{});
        } else {
            const int d0 = 32 * (wid - 4);
            const f32x16 wt = mm<32>(KT + d0 * SS, SS, TBE, SS, l32, hi, f32x16{});
#pragma unroll
            for (int g = 0; g < 4; ++g) *(uint2*)(W + l32 * SK + d0 + 8 * g + 4 * hi) = pk4(wt[4 * g], wt[4 * g + 1], wt[4 * g + 2], wt[4 * g + 3]);
        }
        __syncthreads();
        if (wid < 4) {
            const int e0 = 32 * wid;
            const f32x16 ws = mm<128>(W, SK, ST + e0 * SK, SK, l32, hi, f32x16{});
            float vn[16], vs[16];
#pragma unroll
            for (int r = 0; r < 16; ++r) { vn[r] = acc1[r] - ws[r]; vs[r] = vn[r] * sc[96 + crow(r, hi)]; }
#pragma unroll
            for (int g = 0; g < 4; ++g) { *(uint2*)(VN + (e0 + l32) * SS + 8 * g + 4 * hi) = pk4(vn[4 * g], vn[4 * g + 1], vn[4 * g + 2], vn[4 * g + 3]);
                                          *(uint2*)(VNS + (e0 + l32) * SS + 8 * g + 4 * hi) = pk4(vs[4 * g], vs[4 * g + 1], vs[4 * g + 2], vs[4 * g + 3]); }
        }
        __syncthreads();
        if (wid >= 4) {
            const int e0 = 32 * (wid - 4);
            acc1 = mm<32>(ATT, SS, VN + e0 * SS, SS, l32, hi, acc1);
#pragma unroll
            for (int r = 0; r < 16; ++r) O[TOK(c, crow(r, hi)) * 512 + h * 128 + e0 + l32] = acc1[r];
        }
        {
            const float eB = sc[128];
#pragma unroll
            for (int bi = 0; bi < 2; ++bi) {
                const int blk = wid * 2 + bi, d0 = 32 * (blk >> 2), e0 = 32 * (blk & 3);
#pragma unroll
                for (int r = 0; r < 16; ++r) S[bi][r] *= eB;
                S[bi] = mm<32>(KT + d0 * SS, SS, VNS + e0 * SS, SS, l32, hi, S[bi]);
            }
        }
        __syncthreads();
#pragma unroll
        for (int bi = 0; bi < 2; ++bi) {
            const int blk = wid * 2 + bi, d0 = 32 * (blk >> 2), e0 = 32 * (blk & 3);
#pragma unroll
            for (int g = 0; g < 4; ++g) *(uint2*)(ST + (e0 + l32) * SK + d0 + 8 * g + 4 * hi) = pk4(S[bi][4 * g], S[bi][4 * g + 1], S[bi][4 * g + 2], S[bi][4 * g + 3]);
        }
        if (c + 1 < nch) GSTAGE();
        __syncthreads();
    }
#undef GLOAD
#undef GSTAGE
#undef TOK
    if (ctx) {
#pragma unroll
        for (int bi = 0; bi < 2; ++bi) {
            const int blk = wid * 2 + bi, d0 = 32 * (blk >> 2), e0 = 32 * (blk & 3);
            float* so = p.out + O_SGDN + ((((size_t)b * DEPTH + l) * 2 + dir) * 4 + h) * 128 * 128 + e0 + l32;
#pragma unroll
            for (int r = 0; r < 16; ++r) so[(size_t)(d0 + crow(r, hi)) * 128] = S[bi][r];
        }
    }
}
}

namespace gla {
using att::bf16x8; using att::f32x16; using att::crow; using gdn::mm; using gdn::pk4;
constexpr int C = 32, SQ = 72, SS = 40;
constexpr int OFF_QE = 0, OFF_KN = OFF_QE + C * SQ * 2, OFF_KET = OFF_KN + C * SQ * 2, OFF_VT = OFF_KET + 64 * SS * 2, OFF_ATT = OFF_VT + 128 * SS * 2, OFF_ST = OFF_ATT + C * SS * 2,
              OFF_LA = OFF_ST + 128 * SQ * 2, OFF_EB = OFF_LA + C * 64 * 4, GLA_LDS = OFF_EB + 256;
__device__ __forceinline__ void gla_chunked(const Params& p, int l, bool ctx, int b, int h, int dir, unsigned char* lds) {
    const int tid = opaque_tid(), wid = tid >> 6, lane = tid & 63, l32 = lane & 31, hi = lane >> 5;
    const int T = ctx ? CT : ::LT; const size_t m0 = ctx ? (size_t)b * CT : (size_t)MC + (size_t)b * ::LT;
    const bf16_t* Z = WSP(bf16_t, WS_Z); const float* LA = WSP(float, dir ? WS_AB : WS_AF);
    float* O = WSP(float, dir ? WS_GOB : WS_GOF);
    bf16_t* Qe = (bf16_t*)(lds + OFF_QE); bf16_t* Kn = (bf16_t*)(lds + OFF_KN); bf16_t* KeT = (bf16_t*)(lds + OFF_KET); bf16_t* VT = (bf16_t*)(lds + OFF_VT);
    bf16_t* ATT = (bf16_t*)(lds + OFF_ATT); bf16_t* ST = (bf16_t*)(lds + OFF_ST); float* eB = (float*)(lds + OFF_EB);
    const int nch = T / C;
#define TOK(c, s_) (m0 + (dir ? T - 1 - ((c) * C + (s_)) : (c) * C + (s_)))
    const int d0 = 32 * (wid >> 2), e0 = 32 * (wid & 3);
    f32x16 S;
    if (ctx) S = f32x16{};
    else {
        const float* s0 = p.in[I_SGLA] + ((((size_t)b * DEPTH + l) * 2 + dir) * 4 + h) * 64 * 128 + e0 + l32;
#pragma unroll
        for (int r = 0; r < 16; ++r) S[r] = s0[(size_t)(d0 + crow(r, hi)) * 128];
    }
    const int ts = tid & 31, dc = (tid >> 5) * 4, vc0 = dc, vc1 = 64 + dc;
    uint2 rq, rk, rv0, rv1; vf4 pl;
#define GLOAD(c) do { const size_t mt = TOK(c, ts); \
        rq = *(const uint2*)(Z + mt * NINP + Z_GLQ + h * 64 + dc); rk = *(const uint2*)(Z + mt * NINP + Z_GLK + h * 64 + dc); pl = *(const vf4*)(LA + mt * 256 + h * 64 + dc); \
        rv0 = *(const uint2*)(Z + mt * NINP + Z_GLV + h * 128 + vc0); rv1 = *(const uint2*)(Z + mt * NINP + Z_GLV + h * 128 + vc1); } while (0)
#define WRITE_ST() do { _Pragma("unroll") for (int g = 0; g < 4; ++g) *(uint2*)(ST + (e0 + l32) * SQ + d0 + 8 * g + 4 * hi) = pk4(S[4 * g], S[4 * g + 1], S[4 * g + 2], S[4 * g + 3]); } while (0)
#define GIMAGES() do { vf4 pre, tot; const vf4 pq = unp4bf(rq), pk = unp4bf(rk); \
        _Pragma("unroll") for (int j = 0; j < 4; ++j) { pre[j] = scan32(pl[j]); tot[j] = last32(pre[j], lane); } \
        float qe[4], kn[4]; \
        _Pragma("unroll") for (int j = 0; j < 4; ++j) { qe[j] = pq[j] * 0.125f * __expf(pre[j]); kn[j] = pk[j] * __expf(fminf(-pre[j], 80.f)); \
            KeT[(dc + j) * SS + ts] = f2bf(pk[j] * __expf(tot[j] - pre[j])); } \
        *(uint2*)(Qe + ts * SQ + dc) = pk4(qe[0], qe[1], qe[2], qe[3]); *(uint2*)(Kn + ts * SQ + dc) = pk4(kn[0], kn[1], kn[2], kn[3]); \
        if (ts == 0) { _Pragma("unroll") for (int j = 0; j < 4; ++j) eB[dc + j] = __expf(tot[j]); } \
        _Pragma("unroll") for (int j = 0; j < 4; ++j) { VT[(vc0 + j) * SS + ts] = H16(rv0, j); VT[(vc1 + j) * SS + ts] = H16(rv1, j); } } while (0)
    __syncthreads();
    GLOAD(0);
    WRITE_ST();
    GIMAGES();
    __syncthreads();
    for (int c = 0; c < nch; ++c) {
        if (c + 1 < nch) GLOAD(c + 1);
        f32x16 o1 = f32x16{};
        if (wid == 0) {
            const f32x16 kq = mm<64>(Kn, SQ, Qe, SQ, l32, hi, f32x16{});
            float a[16];
#pragma unroll
            for (int r = 0; r < 16; ++r) a[r] = (l32 >= crow(r, hi)) ? kq[r] : 0.f;
#pragma unroll
            for (int g = 0; g < 4; ++g) *(uint2*)(ATT + l32 * SS + 8 * g + 4 * hi) = pk4(a[4 * g], a[4 * g + 1], a[4 * g + 2], a[4 * g + 3]);
        } else if (wid >= 4) {
            o1 = mm<64>(Qe, SQ, ST + (32 * (wid - 4)) * SQ, SQ, l32, hi, f32x16{});
        }
        __syncthreads();
        if (wid >= 4) {
            const int eo = 32 * (wid - 4);
            o1 = mm<32>(ATT, SS, VT + eo * SS, SS, l32, hi, o1);
#pragma unroll
            for (int r = 0; r < 16; ++r) O[TOK(c, crow(r, hi)) * 512 + h * 128 + eo + l32] = o1[r];
        }
#pragma unroll
        for (int r = 0; r < 16; ++r) S[r] *= eB[d0 + crow(r, hi)];
        S = mm<32>(KeT + d0 * SS, SS, VT + e0 * SS, SS, l32, hi, S);
        __syncthreads();
        WRITE_ST();
        if (c + 1 < nch) GIMAGES();
#ifdef GLA_DUP_IMAGES
        __syncthreads(); if (c + 1 < nch) GIMAGES();
#endif
        __syncthreads();
    }
#undef GLOAD
#undef WRITE_ST
#undef GIMAGES
#undef TOK
    if (ctx) {
        float* so = p.out + O_SGLA + ((((size_t)b * DEPTH + l) * 2 + dir) * 4 + h) * 64 * 128 + e0 + l32;
#pragma unroll
        for (int r = 0; r < 16; ++r) so[(size_t)(d0 + crow(r, hi)) * 128] = S[r];
    }
}
}
#define LAS __attribute__((address_space(3)))
constexpr int LDS_BYTES = 147456, XBW_OFF = LDS_BYTES - 64;
constexpr int NPH = 1 + DEPTH * 12;
#ifndef DBG_NLAYERS
#define DBG_NLAYERS DEPTH
#endif

#ifndef DUPKIND
#define DUPKIND 0
#endif
__device__ __forceinline__ int opaque_int(int v) { asm volatile("" : "+s"(v)); return v; }
#ifndef MIXMASK
#define MIXMASK 0xFF
#endif
#define FOR_ITEMS(it, n, o, w) for (int bo_ = (o) * (int)gridDim.x / 256, bw_ = ((w) * (int)gridDim.x / 256) > 0 ? ((w) * (int)gridDim.x / 256) : 1, \
                                    it = ((int)blockIdx.x >= bo_ && (int)blockIdx.x < bo_ + bw_) ? (int)blockIdx.x - bo_ : (n); it < (n); it += bw_)

constexpr int TF0 = NT_L / 10, TF1 = NT_L / 4, TF2 = NT_L * 53 / 100, TF3 = NT_L * 88 / 100, MIXCONV_CH = 16, NI_CONV = (TF3 - TF2 + MIXCONV_CH - 1) / MIXCONV_CH;
#ifndef SPLITK
#define SPLITK 0
#endif
#ifndef SPLITK_G4
#define SPLITK_G4 0
#endif
constexpr int FLAG_WORD0 = 8192;
constexpr int QCTR_WORD0 = 1024;
constexpr int NI_GDNL = LB * 8, NI_GLAL = LB * 8, NI_GDNC = CB * 8, NI_GQAL = LB * 16, NI_NAL = LB * 16, NI_GLAC = CB * 8, NI_NAC = CB * 4, NI_GQAC = CB * 4;
#define KM(k) (1 + ((DUPKIND >> (k)) & 1))
constexpr int Q0 = NI_GDNL * KM(0), Q1 = Q0 + NI_GQAL * KM(1), Q2 = Q1 + NI_NAL * KM(2), Q3 = Q2 + NI_GLAL * KM(3), Q4 = Q3 + NI_GDNC * KM(4), Q5 = Q4 + NI_NAC * KM(5), Q6 = Q5 + NI_GQAC * KM(6), Q7 = Q6 + NI_GLAC * KM(7);
__device__ __forceinline__ void phase_mix(const Params& p, int l, unsigned char* lds, int rep) {
    const int tid = opaque_tid();
    float* smem = (float*)lds;
    const bf16_t* NAQ = WSP(bf16_t, WS_NAQ); const bf16_t* NAK = WSP(bf16_t, WS_NAK); const bf16_t* NAV = WSP(bf16_t, WS_NAV);
    const bf16_t* GQ = WSP(bf16_t, WS_GQ); const bf16_t* GK = WSP(bf16_t, WS_GK); const bf16_t* GV = WSP(bf16_t, WS_GV);
    bf16_t* MRG = WSP(bf16_t, WS_MRG);
    unsigned* qctr = WSP(unsigned, WS_CTL) + QCTR_WORD0 + 64 * l + 16 * rep;
    volatile int* qslot = (volatile int*)(lds + XBW_OFF + 16);
    for (;;) {
        __syncthreads();
        if (tid == 0) *qslot = (int)__hip_atomic_fetch_add(qctr, 1u, __ATOMIC_RELAXED, __HIP_MEMORY_SCOPE_AGENT);
        __syncthreads();
        const int q = __builtin_amdgcn_readfirstlane(*qslot);
        if (q >= Q7 + ((CONV_FILLER && l + 1 < DBG_NLAYERS) ? NI_CONV : 0)) break;
        if (q < Q0) { const int it = q % NI_GDNL; gdn::gdn_chunked(p, l, false, it / 8, (it / 2) % 4, it % 2, lds); }
        else if (q < Q1) {
            const int it = (q - Q0) % NI_GQAL, b = it / 16, qh = (it / 4) % 4, qb = it % 4, kvh = qh >> 1;
            const size_t r0 = (size_t)MC + (size_t)b * LT;
            att::SrcTwo src{WSP(bf16_t, WS_CGK) + ((size_t)b * DEPTH + l) * 256 * 256 + kvh * 128, WSP(bf16_t, WS_CGV) + ((size_t)b * DEPTH + l) * 256 * 256 + kvh * 128,
                            GK + r0 * 256 + kvh * 128, GV + r0 * 256 + kvh * 128, 256};
            att::attn_body<2>(GQ + (r0 + qb * 256) * 512 + qh * 128, src, MRG + (r0 + qb * 256) * DM + 1024 + qh * 128, 4 + LT / 64, (char*)lds, att::NoBias{});
        }
        else if (q < Q2) {
            const int it = (q - Q1) % NI_NAL, b = it / 16, h = (it / 4) % 4, qb = it % 4;
            const int kr0 = qb == 0 ? 0 : qb == 1 ? 0 : qb == 2 ? 4 : 8, nrows = (qb == 0 || qb == 3) ? 8 : 12;
            const size_t r0 = (size_t)MC + (size_t)b * LT;
            float* tab = (float*)(lds + att::SHM_ATTN);
            if (tid < 15 * 31) tab[tid] = p.in[I_RPB][((size_t)l * 4 + h) * 15 * 31 + tid] * (1.0f / att::SCALE);
            att::SrcTwo src{WSP(bf16_t, WS_CNAK) + ((size_t)b * DEPTH + l) * 256 * 512 + h * 128, WSP(bf16_t, WS_CNAV) + ((size_t)b * DEPTH + l) * 256 * 512 + h * 128,
                            NAK + (r0 + kr0 * 64) * 512 + h * 128, NAV + (r0 + kr0 * 64) * 512 + h * 128, 512};
            att::attn_body<1>(NAQ + (r0 + qb * 256) * 512 + h * 128, src, MRG + (r0 + qb * 256) * DM + 0 + h * 128, 4 + nrows, (char*)lds, att::NaBias{tab, qb * 256, kr0});
        }
        else if (q < Q3) { const int it = (q - Q2) % NI_GLAL;
#ifdef GLA_REP
            for (int r_ = 0, n_ = opaque_int(GLA_REP); r_ < n_; ++r_)
#endif
            gla::gla_chunked(p, l, false, it / 8, (it / 2) % 4, it % 2, lds); }
        else if (q < Q4) { const int it = (q - Q3) % NI_GDNC; gdn::gdn_chunked(p, l, true, it / 8, (it / 2) % 4, it % 2, lds); }
        else if (q < Q5) {
            const int it = (q - Q4) % NI_NAC, b = it / 4, h = it % 4; const size_t r0 = (size_t)b * CT;
            att::SrcOne src{NAK + r0 * 512 + h * 128, NAV + r0 * 512 + h * 128, 512};
            att::attn_body<2>(NAQ + r0 * 512 + h * 128, src, MRG + r0 * DM + 0 + h * 128, CT / 64, (char*)lds, att::NoBias{});
        }
        else if (q < Q6) {
            const int it = (q - Q5) % NI_GQAC, b = it / 4, qh = it % 4, kvh = qh >> 1; const size_t r0 = (size_t)b * CT;
            att::SrcOne src{GK + r0 * 256 + kvh * 128, GV + r0 * 256 + kvh * 128, 256};
            att::attn_body<2>(GQ + r0 * 512 + qh * 128, src, MRG + r0 * DM + 1024 + qh * 128, CT / 64, (char*)lds, att::NoBias{});
        }
        else if (q < Q7) { const int it = (q - Q6) % NI_GLAC; gla::gla_chunked(p, l, true, it / 8, (it / 2) % 4, it % 2, lds); }
        else { const int t0 = TF2 + (q - Q7) * MIXCONV_CH, t1 = t0 + MIXCONV_CH < TF3 ? t0 + MIXCONV_CH : TF3; conv_layer_tiles(p, l + 1, t0, t1, 0, 1, (float*)lds); }
    }
}

#define CONV_FILL(nunits, t0, t1, skip) do { if (l + 1 < DBG_NLAYERS) { const int G_ = (int)gridDim.x; int f0_ = ((nunits) % G_) + (skip); if (f0_ >= G_) f0_ = 0; \
        if ((int)blockIdx.x >= f0_) { const Params q = opaque_params(p); conv_layer_tiles(q, l + 1, (t0), (t1), (int)blockIdx.x - f0_, G_ - f0_, (float*)lds); } } } while (0)
#define G1A_MSPLIT (G1A_MODE == 1 ? 2 : 0)
#define G1B_MSPLIT (G1B_MODE == 1 ? 2 : 0)
#ifndef MSPLIT
#define MSPLIT 2
#endif
static_assert(att::SHM_ATTN + 15 * 31 * 4 + 2048 <= (size_t)XBW_OFF, "LDS map");
static_assert((QCTR_WORD0 + 64 * DEPTH) < 4096, "ctl");
constexpr int BAR_WORD0 = 4096;
static_assert((BAR_WORD0 + XCD_BAR_WORDS) * 4 <= (int)CTL_BYTES, "ctl");

__global__ void __launch_bounds__(512, 2) fwd(Params p) {
    extern __shared__ __attribute__((aligned(16))) unsigned char lds[];
    const int tid = threadIdx.x;
    volatile LAS unsigned* xbw = (volatile LAS unsigned*)((LAS unsigned char*)lds + XBW_OFF);
    if (tid < 4) xbw[tid] = 0u;
    __syncthreads();
    XcdBarrier bar; bar.bar = WSP(unsigned, WS_CTL) + BAR_WORD0; bar.x = 0; bar.st = xbw;
    if (p.ph_hi - p.ph_lo > 1) bar = xcd_barrier_post(WSP(unsigned, WS_CTL) + BAR_WORD0, xbw);
#ifndef PHMASK
#define PHMASK 0x1FFF
#endif
#define IN(k) (p.ph_lo <= (k) && (k) < p.ph_hi)
#define INL(j) (((PHMASK >> ((j) + 1)) & 1) && IN(pb + (j)))
#ifndef DUPMASK
#define DUPMASK 0
#endif
#define DUP(j) ((DUPMASK >> ((j) + 1)) & 1)
#if DUPMASK
#define REPS(j) opaque_int(1 + DUP(j))
#else
#define REPS(j) 1
#endif
#ifndef DBLBAR
#define DBLBAR 0
#endif
#ifdef DIAG_KIND
#ifndef DIAG_SCALE
#define DIAG_SCALE 0.01f
#endif
    unsigned long long dg_sum = 0ull, dg_prev = wall_clock64();
#define DIAG_AT(k) do { const unsigned long long now_ = wall_clock64(); if ((DIAG_KIND >> (((k) == 0) ? 12 : (((k) - 1) % 12))) & 1) dg_sum += now_ - dg_prev; dg_prev = now_; } while (0)
#else
#define DIAG_AT(k) do { } while (0)
#endif
#define SEAM(k) do { if (IN(k) && IN((k) + 1)) { xcd_barrier(bar); if (DBLBAR) xcd_barrier(bar); } DIAG_AT(k); } while (0)
    LAS unsigned char* ldsl = (LAS unsigned char*)lds;
    bf16_t* H = WSP(bf16_t, WS_H); bf16_t* ACT = WSP(bf16_t, WS_ACT); float* X = WSP(float, WS_X); float* Z = WSP(float, WS_Z); bf16_t* MRG = WSP(bf16_t, WS_MRG);

    if ((PHMASK & 1) && IN(0)) { const int reps_ = (DUPMASK & 1) ? opaque_int(2) : 1; for (int rep_ = 0; rep_ < reps_; ++rep_) { const Params q = opaque_params(p); phase_prologue(q, (float*)lds); __syncthreads(); } }
    SEAM(0);
    for (int l = 0; l < DBG_NLAYERS; ++l) {
        const int pb = 1 + l * 12;
        const float* modl = WSP(float, WS_MODV) + (size_t)l * NCOND * NMOD;
        if (INL(0)) { const int reps_ = REPS(0); for (int rep_ = 0; rep_ < reps_; ++rep_) { const Params q = opaque_params(p); phase_norm(q, l, 0, lds); __syncthreads(); } }
        SEAM(pb + 0);
        if (INL(1)) {
            if (g1_fp8(l, 0)) {
                pg8::Gemm g{H, (const bf16_t*)(WSP(unsigned char, WS_WGU) + ((size_t)l * 2 + 0) * NGU * DM * 2), M, NGU, DM / 2}; pg8::StaticOrder S; S.init(M, NGU, DM / 2, (int)gridDim.x, (int)blockIdx.x, 2);
                pg8::EpiSwiGLU8 E{WSP(unsigned char, WS_ACT), FFP, 1.0f / WGU_SCALE};
                for (int r_ = 0, n_ = REPS(1); r_ < n_; ++r_) pg8::gemm_phase<pg8::EpiSwiGLU8, pg8::StaticOrder, false, 1>(ldsl, g, S, E, nullptr);
            } else {
                pg8::Gemm g{H, WSP(bf16_t, WS_WGU) + ((size_t)l * 2 + 0) * NGU * DM, M, NGU, DM}; pg8::StaticOrder S; S.init(M, NGU, DM, (int)gridDim.x, (int)blockIdx.x, 0);
                pg8::EpiSwiGLU8 E{WSP(unsigned char, WS_ACT), FFP, 1.0f};
                for (int r_ = 0, n_ = REPS(1); r_ < n_; ++r_) pg8::gemm_phase<pg8::EpiSwiGLU8, pg8::StaticOrder, false, 0>(ldsl, g, S, E, nullptr);
            }
#if CONV_FILLER
            if (l + 1 < DBG_NLAYERS) {
                const int nw_ = (M / 256) * (NGU / 256), G_ = (int)gridDim.x; int f0_ = nw_ % G_; if (nw_ < G_) f0_ = 0;
                if (g1_fp8(l, 0)) f0_ = 2 * f0_ < G_ ? 2 * f0_ : f0_;
                const int nmb_ = (G_ - f0_ < NMOD / 128) ? (G_ - f0_) : NMOD / 128;
                if ((int)blockIdx.x >= f0_ && (int)blockIdx.x < f0_ + nmb_) { const Params q = opaque_params(p); mod_layer(q, l + 1, (int)blockIdx.x - f0_, nmb_, (float*)lds); }
            }
            CONV_FILL((M / 256) * (NGU / 256), 0, TF0, NMOD / 128 + (g1_fp8(l, 0) ? ((M / 256) * (NGU / 256)) % (int)gridDim.x : 0));
#endif
        }
        SEAM(pb + 1);
        if (INL(2)) {
            pg8::Gemm g{ACT, G2_FP8 ? (const bf16_t*)(WSP(unsigned char, WS_WDN) + ((size_t)l * 2 + 0) * DM * FFP) : WSP(bf16_t, WS_WDN) + ((size_t)l * 2 + 0) * DM * FF, M, DM, G2_FP8 ? FFP / 2 : FF}; pg8::StaticOrder S; S.init(M, DM, G2_FP8 ? FFP / 2 : FF, (int)gridDim.x, (int)blockIdx.x, SPLITK ? 1 : MSPLIT);
            pg8::EpiResid E{l == 0 ? p.in[I_XP] : X, X, DM, modl + 2 * DM, G2_FP8 ? 0.5f / WDN_SCALE : 0.5f, Z, WSP(unsigned, WS_CTL) + FLAG_WORD0, 8u * (unsigned)(l * (2 * SPLITK + SPLITK_G4) + SPLITK), l == 0 ? p.in[I_XS] : X, l == 0 ? MC : 0x7FFFFFFF, (XBF16 && l != 0), XBF16};
            pg8::gemm_phase<pg8::EpiResid, pg8::StaticOrder, false, (G2_FP8 ? 1 : 0)>(ldsl, g, S, E, nullptr);
#if DUPMASK
            if (opaque_int(DUP(2))) { pg8::EpiResid E2{l == 0 ? p.in[I_XP] : X, Z, DM, modl + 2 * DM, G2_FP8 ? 0.5f / WDN_SCALE : 0.5f, Z, WSP(unsigned, WS_CTL) + FLAG_WORD0, 0u, l == 0 ? p.in[I_XS] : X, l == 0 ? MC : 0x7FFFFFFF, 0, 0}; pg8::gemm_phase<pg8::EpiResid, pg8::StaticOrder, false, (G2_FP8 ? 1 : 0)>(ldsl, g, S, E2, nullptr); }
#endif
        }
        SEAM(pb + 2);
        if (INL(3)) { const int reps_ = REPS(3); for (int rep_ = 0; rep_ < reps_; ++rep_) { const Params q = opaque_params(p); phase_norm(q, l, 1, lds); __syncthreads(); } }
        SEAM(pb + 3);
        if (INL(4)) {
            pg8::Gemm g{H, WSP(bf16_t, WS_WIN) + (size_t)l * NINP * DM, M, NINP, DM}; pg8::StaticOrder S; S.init(M, NINP, DM, (int)gridDim.x, (int)blockIdx.x);
            pg8::EpiBf16Plain E{WSP(bf16_t, WS_Z), NINP};
            for (int r_ = 0, n_ = REPS(4); r_ < n_; ++r_) pg8::gemm_phase<pg8::EpiBf16Plain, pg8::StaticOrder, false>(ldsl, g, S, E, nullptr);
#if CONV_FILLER
            CONV_FILL((M / 256) * (NINP / 256), TF0, TF1, 0);
#endif
        }
        SEAM(pb + 4);
        if (INL(5)) { const int reps_ = REPS(5); for (int rep_ = 0; rep_ < reps_; ++rep_) { const Params q = opaque_params(p); phase_prep(q, l, lds); __syncthreads(); } }
        SEAM(pb + 5);
        if (INL(6)) { const int reps_ = REPS(6); for (int rep_ = 0; rep_ < reps_; ++rep_) { const Params q = opaque_params(p); phase_mix(q, l, lds, rep_); __syncthreads(); } }
        SEAM(pb + 6);
        if (INL(7)) { const int reps_ = REPS(7); for (int rep_ = 0; rep_ < reps_; ++rep_) { const Params q = opaque_params(p); phase_post(q, l); __syncthreads(); } }
        SEAM(pb + 7);
        if (INL(8)) {
            pg8::Gemm g{MRG, WSP(bf16_t, WS_WOUT) + (size_t)l * DM * DM, M, DM, DM}; pg8::StaticOrder S; S.init(M, DM, DM, (int)gridDim.x, (int)blockIdx.x, SPLITK_G4);
            pg8::EpiResid E{X, X, DM, modl + 5 * DM, 1.0f, Z, WSP(unsigned, WS_CTL) + FLAG_WORD0, 8u * (unsigned)(l * (2 * SPLITK + SPLITK_G4) + SPLITK + SPLITK_G4), X, 0x7FFFFFFF, XBF16, XBF16};
            pg8::gemm_phase<pg8::EpiResid, pg8::StaticOrder, false>(ldsl, g, S, E, nullptr);
#if CONV_FILLER
            CONV_FILL((M / 256) * (DM / 256), TF1, TF2, 0);
#endif
#if DUPMASK
            if (opaque_int(DUP(8))) { pg8::EpiResid E2{X, Z, DM, modl + 5 * DM, 1.0f, Z, WSP(unsigned, WS_CTL) + FLAG_WORD0, 0u, X, 0x7FFFFFFF, 0, 0}; pg8::gemm_phase<pg8::EpiResid, pg8::StaticOrder, false>(ldsl, g, S, E2, nullptr); }
#endif
        }
        SEAM(pb + 8);
        if (INL(9)) { const int reps_ = REPS(9); for (int rep_ = 0; rep_ < reps_; ++rep_) { const Params q = opaque_params(p); phase_norm(q, l, 2, lds); __syncthreads(); } }
        SEAM(pb + 9);
        if (INL(10)) {
            {
#if G1B_MODE
                pg8::Gemm g{H, (const bf16_t*)(WSP(unsigned char, WS_WGU) + ((size_t)l * 2 + 1) * NGU * DM * 2), M, NGU, DM / 2}; pg8::StaticOrder S; S.init(M, NGU, DM / 2, (int)gridDim.x, (int)blockIdx.x, G1B_MSPLIT);
                constexpr float ws_ = 1.0f / WGU_SCALE;
#else
                pg8::Gemm g{H, WSP(bf16_t, WS_WGU) + ((size_t)l * 2 + 1) * NGU * DM, M, NGU, DM}; pg8::StaticOrder S; S.init(M, NGU, DM, (int)gridDim.x, (int)blockIdx.x, G1B_MSPLIT);
                constexpr float ws_ = 1.0f;
#endif
#if G2_FP8
                pg8::EpiSwiGLU8 E{WSP(unsigned char, WS_ACT), FFP, ws_};
                for (int r_ = 0, n_ = REPS(10); r_ < n_; ++r_) pg8::gemm_phase<pg8::EpiSwiGLU8, pg8::StaticOrder, false, G1B_MODE>(ldsl, g, S, E, nullptr);
#else
                pg8::EpiSwiGLU E{ACT, FF};
                pg8::gemm_phase<pg8::EpiSwiGLU, pg8::StaticOrder, false, G1B_MODE>(ldsl, g, S, E, nullptr);
#endif
            }
#if CONV_FILLER
            CONV_FILL((M / 256) * (NGU / 256), TF3, NT_L, (G1B_MSPLIT ? ((M / 256) * (NGU / 256)) % (int)gridDim.x : 0));
#endif
        }
        SEAM(pb + 10);
        if (INL(11)) {
            pg8::Gemm g{ACT, G2_FP8 ? (const bf16_t*)(WSP(unsigned char, WS_WDN) + ((size_t)l * 2 + 1) * DM * FFP) : WSP(bf16_t, WS_WDN) + ((size_t)l * 2 + 1) * DM * FF, M, DM, G2_FP8 ? FFP / 2 : FF}; pg8::StaticOrder S; S.init(M, DM, G2_FP8 ? FFP / 2 : FF, (int)gridDim.x, (int)blockIdx.x, SPLITK ? 1 : MSPLIT);
            pg8::EpiResid E{X, (l == DEPTH - 1) ? p.out : X, DM, modl + 8 * DM, G2_FP8 ? 0.5f / WDN_SCALE : 0.5f, Z, WSP(unsigned, WS_CTL) + FLAG_WORD0, 8u * (unsigned)(l * (2 * SPLITK + SPLITK_G4) + 2 * SPLITK + SPLITK_G4), X, 0x7FFFFFFF, XBF16, (XBF16 && l != DEPTH - 1)};
            pg8::gemm_phase<pg8::EpiResid, pg8::StaticOrder, false, (G2_FP8 ? 1 : 0)>(ldsl, g, S, E, nullptr);
        }
        SEAM(pb + 11);
    }
#ifdef DIAG_KIND
    xcd_barrier(bar);
    if (blockIdx.x == 0 && threadIdx.x == 0) p.out[0] += (float)dg_sum * 0.01f * DIAG_SCALE;
#endif
#undef IN
#undef SEAM
}

#ifndef MULTI_LAUNCH
#define MULTI_LAUNCH 0
#endif
extern "C" void kernel_launch(void* const* d_in, const int* in_sizes, int n_in, void* d_out, int out_size, void* d_ws, size_t ws_size, hipStream_t stream) {
    static int grid = 0;
    if (grid == 0) {
        if (n_in != N_IN || (size_t)out_size != O_END || ws_size < WS_END) { fprintf(stderr, "kernel_launch: shape mismatch n_in %d out %d ws %zu (need %zu)\n", n_in, out_size, ws_size, (size_t)WS_END); grid = -1; return; }
        int dev = 0, cus = 0, per_cu = 0;
        if (hipGetDevice(&dev) != hipSuccess || hipDeviceGetAttribute(&cus, hipDeviceAttributeMultiprocessorCount, dev) != hipSuccess) { grid = -1; return; }
        if (hipFuncSetAttribute((const void*)fwd, hipFuncAttributeMaxDynamicSharedMemorySize, LDS_BYTES) != hipSuccess) { fprintf(stderr, "kernel_launch: hipFuncSetAttribute failed\n"); grid = -1; return; }
        if (hipOccupancyMaxActiveBlocksPerMultiprocessor(&per_cu, (const void*)fwd, 512, LDS_BYTES) != hipSuccess || per_cu < 1) { fprintf(stderr, "kernel_launch: occupancy query says %d\n", per_cu); (void)hipGetLastError(); }
        grid = cus;
    }
    if (grid < 0) return;
    (void)hipMemsetAsync((char*)d_ws + WS_CTL, 0, CTL_BYTES, stream);
    Params p{};
    for (int i = 0; i < N_IN; ++i) p.in[i] = (const float*)d_in[i];
    p.out = (float*)d_out; p.ws = (unsigned char*)d_ws;
#if MULTI_LAUNCH
    for (int ph = 0; ph < 1 + DBG_NLAYERS * 12; ++ph) { p.ph_lo = ph; p.ph_hi = ph + 1; hipLaunchKernelGGL(fwd, dim3(grid), dim3(512), LDS_BYTES, stream, p); }
#else
    p.ph_lo = 0; p.ph_hi = NPH; hipLaunchKernelGGL(fwd, dim3(grid), dim3(512), LDS_BYTES, stream, p);
#endif
    const hipError_t le = hipPeekAtLastError();
    if (le != hipSuccess) fprintf(stderr, "kernel_launch: launch failed: %s\n", hipGetErrorName(le));
}
```

```cpp
#define G1A_LAYERS 0xE
#include <hip/hip_runtime.h>
#include <cstdio>
#include <cstdint>

#ifndef CB_
#define CB_ 16
#endif
#ifndef LB_
#define LB_ 8
#endif
#ifndef DEPTH_
#define DEPTH_ 4
#endif
#ifndef G1A_LAYERS
#define G1A_LAYERS 0xC
#endif
#ifndef G1A_MODE
#define G1A_MODE 0
#endif
#ifndef G1B_MODE
#define G1B_MODE 1
#endif
#ifndef XBF16
#define XBF16 0
#endif
#ifndef G2_FP8
#define G2_FP8 1
#endif
#ifndef FFN_FP8
#define FFN_FP8 (G1A_MODE != 0 || G1B_MODE != 0 || G2_FP8 != 0)
#endif
constexpr int DM = 2048, DEPTH = DEPTH_, CB = CB_, CT = 256, LB = LB_, LT = 1024;
constexpr int MC = CB * CT, ML = LB * LT, M = MC + ML;
constexpr int FF = 5504, NGU = 2 * FF, NIN = 6192, NINP = 6400, NMOD = 9 * DM, NCOND = 1 + LB;
constexpr float EPS = 1e-6f;
constexpr int FFP = 5632;
constexpr float WGU_SCALE = 32.0f, WDN_SCALE = 64.0f;
constexpr int Z_NAQ = 0, Z_NAK = 512, Z_NAV = 1024, Z_GLQ = 1536, Z_GLK = 1792, Z_GLV = 2048, Z_GLR = 2560, Z_GF = 3072, Z_GB = 3088,
              Z_GQQ = 3104, Z_GQK = 3616, Z_GQV = 3872, Z_DQKV = 4128, Z_DZ = 5664, Z_DB = 6176, Z_DA = 6184;
static_assert(Z_DA + 8 == NIN, "split");
enum { I_XP = 0, I_XS, I_CNAK, I_CNAV, I_CGK, I_CGV, I_SGLA, I_SGDN, I_C, I_CCTX, I_NORMG, I_WMOD, I_BMOD, I_GU, I_DOWN, I_WIN, I_WOUT, I_NAQKN, I_RPB,
       I_GUP, I_GBIAS, I_GLAON, I_GQAQKN, I_CONV, I_ALOG, I_DTB, I_GDNON, N_IN };
constexpr size_t O_YP = 0, O_YS = O_YP + (size_t)MC * DM, O_NAK = O_YS + (size_t)ML * DM, O_NAV = O_NAK + (size_t)CB * DEPTH * 4 * CT * 128,
                 O_GK = O_NAV + (size_t)CB * DEPTH * 4 * CT * 128, O_GV = O_GK + (size_t)CB * DEPTH * 2 * CT * 128,
                 O_SGLA = O_GV + (size_t)CB * DEPTH * 2 * CT * 128, O_SGDN = O_SGLA + (size_t)CB * DEPTH * 2 * 4 * 64 * 128,
                 O_END = O_SGDN + (size_t)CB * DEPTH * 2 * 4 * 128 * 128;
constexpr size_t al256(size_t x) { return (x + 255) & ~(size_t)255; }
constexpr size_t WS_CTL = 0, CTL_BYTES = 1u << 20;
constexpr size_t WS_WGU = CTL_BYTES;
constexpr size_t WS_WDN = WS_WGU + (size_t)DEPTH * 2 * NGU * DM * 2;
constexpr size_t WS_WIN = WS_WDN + (size_t)DEPTH * 2 * DM * FF * 2;
constexpr size_t WS_WOUT = WS_WIN + (size_t)DEPTH * NINP * DM * 2;
constexpr size_t WS_MODV = WS_WOUT + (size_t)DEPTH * DM * DM * 2;
constexpr size_t WS_ROPE = al256(WS_MODV + (size_t)DEPTH * NCOND * NMOD * 4);
constexpr size_t WS_X = al256(WS_ROPE + 2 * 64 * 32 * 4);
constexpr size_t WS_H = WS_X + (size_t)M * DM * 4;
constexpr size_t WS_ACT = WS_H + (size_t)M * DM * 2;
constexpr size_t WS_Z = WS_ACT + (size_t)M * FF * 2;
constexpr size_t WS_MRG = WS_Z + (size_t)M * NINP * 4;
constexpr size_t WS_NAQ = WS_MRG + (size_t)M * DM * 2;
constexpr size_t WS_NAK = WS_NAQ + (size_t)M * 512 * 2;
constexpr size_t WS_NAV = WS_NAK + (size_t)M * 512 * 2;
constexpr size_t WS_GQ = WS_NAV + (size_t)M * 512 * 2;
constexpr size_t WS_GK = WS_GQ + (size_t)M * 512 * 2;
constexpr size_t WS_GV = WS_GK + (size_t)M * 256 * 2;
constexpr size_t WS_CNAK = WS_GV + (size_t)M * 256 * 2;
constexpr size_t WS_CNAV = WS_CNAK + (size_t)LB * DEPTH * 256 * 512 * 2;
constexpr size_t WS_CGK = WS_CNAV + (size_t)LB * DEPTH * 256 * 512 * 2;
constexpr size_t WS_CGV = WS_CGK + (size_t)LB * DEPTH * 256 * 256 * 2;
constexpr size_t WS_AF = WS_CGV + (size_t)LB * DEPTH * 256 * 256 * 2;
constexpr size_t WS_AB = WS_AF + (size_t)M * 256 * 4;
constexpr size_t WS_DQ = WS_AB + (size_t)M * 256 * 4;
constexpr size_t WS_DK = WS_DQ + (size_t)M * 512 * 4;
constexpr size_t WS_DV = WS_DK + (size_t)M * 512 * 4;
constexpr size_t WS_DBA = WS_DV + (size_t)M * 512 * 4;
constexpr size_t WS_GOF = WS_DBA + (size_t)M * 16 * 4;
constexpr size_t WS_GOB = WS_GOF + (size_t)M * 512 * 4;
constexpr size_t WS_DOF = WS_GOB + (size_t)M * 512 * 4;
constexpr size_t WS_DOB = WS_DOF + (size_t)M * 512 * 4;
constexpr size_t WS_END = WS_DOB + (size_t)M * 512 * 4;

typedef unsigned short bf16_t;
struct Params { const float* in[N_IN]; float* out; unsigned char* ws; int ph_lo, ph_hi; };
static_assert(sizeof(Params) == N_IN * 8 + 8 + 8 + 8, "no padding");

#define WSP(T, off) ((T*)(p.ws + (off)))
__device__ __forceinline__ int opaque_tid() { int t = (int)threadIdx.x; asm volatile("" : "+v"(t)); return t; }
__device__ __forceinline__ Params opaque_params(const Params& p) { Params q = p; unsigned long long w = (unsigned long long)q.ws; asm volatile("" : "+s"(w));
    q.ws = (unsigned char*)(__attribute__((address_space(1))) unsigned char*)w; return q; }

typedef float vf4 __attribute__((ext_vector_type(4)));
__device__ __forceinline__ unsigned pack4_fp8(float a, float b, float c, float d) { int w = 0; w = __builtin_amdgcn_cvt_pk_fp8_f32(a, b, w, false); w = __builtin_amdgcn_cvt_pk_fp8_f32(c, d, w, true); return (unsigned)w; }
__device__ __forceinline__ float bf2f(unsigned short v) { return __uint_as_float((unsigned)v << 16); }
__device__ __forceinline__ vf4 ld4bf(const unsigned short* p) { const uint2 w = *(const uint2*)p; vf4 r; r.x = __uint_as_float(w.x << 16); r.y = __uint_as_float(w.x & 0xFFFF0000u); r.z = __uint_as_float(w.y << 16); r.w = __uint_as_float(w.y & 0xFFFF0000u); return r; }
__device__ __forceinline__ vf4 unp4bf(uint2 w) { vf4 r; r.x = __uint_as_float(w.x << 16); r.y = __uint_as_float(w.x & 0xFFFF0000u); r.z = __uint_as_float(w.y << 16); r.w = __uint_as_float(w.y & 0xFFFF0000u); return r; }
__device__ __forceinline__ void unp8bf(uint4 w, vf4& a, vf4& b) {
    a.x = __uint_as_float(w.x << 16); a.y = __uint_as_float(w.x & 0xFFFF0000u); a.z = __uint_as_float(w.y << 16); a.w = __uint_as_float(w.y & 0xFFFF0000u);
    b.x = __uint_as_float(w.z << 16); b.y = __uint_as_float(w.z & 0xFFFF0000u); b.z = __uint_as_float(w.w << 16); b.w = __uint_as_float(w.w & 0xFFFF0000u); }
__device__ __forceinline__ void ld8bf(const unsigned short* p, vf4& a, vf4& b) { const uint4 w = *(const uint4*)p;
    a.x = __uint_as_float(w.x << 16); a.y = __uint_as_float(w.x & 0xFFFF0000u); a.z = __uint_as_float(w.y << 16); a.w = __uint_as_float(w.y & 0xFFFF0000u);
    b.x = __uint_as_float(w.z << 16); b.y = __uint_as_float(w.z & 0xFFFF0000u); b.z = __uint_as_float(w.w << 16); b.w = __uint_as_float(w.w & 0xFFFF0000u); }
__device__ __forceinline__ float wave_sum(float v) {
#pragma unroll
    for (int o = 32; o >= 1; o >>= 1) v += __shfl_xor(v, o);
    return v;
}
typedef float vf2_ __attribute__((ext_vector_type(2)));
typedef __bf16 vb2_ __attribute__((ext_vector_type(2)));
__device__ __forceinline__ bf16_t f2bf(float f) { return __builtin_bit_cast(unsigned short, (__bf16)f); }
__device__ __forceinline__ unsigned pack2(float a, float b) { return __builtin_bit_cast(unsigned, __builtin_convertvector((vf2_){a, b}, vb2_)); }
__device__ __forceinline__ float silu_f(float x) { return x / (1.f + expf(-x)); }
__device__ __forceinline__ float rsqrt_fast(float x) { return __builtin_amdgcn_rsqf(x); }
__device__ __forceinline__ float silu_fast(float x) { return x * __builtin_amdgcn_rcpf(1.f + __expf(-x)); }
__device__ __forceinline__ float logsigmoid_fast(float x) { return fminf(x, 0.f) - __logf(1.f + __expf(-fabsf(x))); }
__device__ __forceinline__ float softplus_f(float x) { return fmaxf(x, 0.f) + log1pf(expf(-fabsf(x))); }
__device__ __forceinline__ float logsigmoid_f(float x) { return fminf(x, 0.f) - log1pf(expf(-fabsf(x))); }
__device__ __forceinline__ bool g1_fp8(int l, int f) { return f ? (G1B_MODE != 0) : (G1A_MODE != 0 || ((G1A_LAYERS >> l) & 1)); }
__device__ __forceinline__ int opaque_int(int v) { asm volatile("" : "+s"(v)); return v; }
__device__ __forceinline__ int cond_of_row(int m) { return m < MC ? 0 : 1 + (m - MC) / LT; }
#ifndef CONV_FILLER
#define CONV_FILLER 1
#endif
__device__ __forceinline__ void conv_tile(const float* __restrict__ src, int ld_src, int ncols_src, int k0, int c0, bf16_t* __restrict__ dst, int ld_dst, int n0, float* tile) {
    const int tid = opaque_tid();
    {
        const int r = tid >> 3, c = (tid & 7) * 8;
        float4 a = make_float4(0.f, 0.f, 0.f, 0.f), b = a;
        if (c0 + c + 8 <= ncols_src) {
            const float* s = src + (size_t)(k0 + r) * ld_src + c0 + c;
            a = *(const float4*)s; b = *(const float4*)(s + 4);
        }
        float* t = tile + r * 65 + c;
        t[0] = a.x; t[1] = a.y; t[2] = a.z; t[3] = a.w; t[4] = b.x; t[5] = b.y; t[6] = b.z; t[7] = b.w;
    }
    __syncthreads();
    {
        const int n = tid >> 3, ks = (tid & 7) * 8;
        const float* t = tile + ks * 65 + n;
        uint4 w;
        w.x = pack2(t[0 * 65], t[1 * 65]); w.y = pack2(t[2 * 65], t[3 * 65]); w.z = pack2(t[4 * 65], t[5 * 65]); w.w = pack2(t[6 * 65], t[7 * 65]);
        *(uint4*)(dst + (size_t)(n0 + n) * ld_dst + k0 + ks) = w;
    }
    __syncthreads();
}

__device__ __forceinline__ void conv_tile8(const float* __restrict__ src, int ld_src, int nrows_src, int k0, int c0, unsigned char* __restrict__ dst, int ld_dst, int n0, float scale, float* tile) {
    const int tid = opaque_tid();
    {
        const int r = tid >> 3, c = (tid & 7) * 8;
        float4 a = make_float4(0.f, 0.f, 0.f, 0.f), b = a;
        if (k0 + r < nrows_src) { const float* s = src + (size_t)(k0 + r) * ld_src + c0 + c; a = *(const float4*)s; b = *(const float4*)(s + 4); }
        float* t = tile + r * 65 + c;
        t[0] = a.x * scale; t[1] = a.y * scale; t[2] = a.z * scale; t[3] = a.w * scale; t[4] = b.x * scale; t[5] = b.y * scale; t[6] = b.z * scale; t[7] = b.w * scale;
    }
    __syncthreads();
    {
        const int n = tid >> 3, ks = (tid & 7) * 8;
        const float* t = tile + ks * 65 + n;
        uint2 w; w.x = pack4_fp8(t[0 * 65], t[1 * 65], t[2 * 65], t[3 * 65]); w.y = pack4_fp8(t[4 * 65], t[5 * 65], t[6 * 65], t[7 * 65]);
        *(uint2*)(dst + (size_t)(n0 + n) * ld_dst + k0 + ks) = w;
    }
    __syncthreads();
}
constexpr int MOD_ITEMS = DEPTH * (NMOD / 128);
constexpr int TGU_KT = DM / 64, TGU_NT = NGU / 64, TDN_KT = (G2_FP8 ? FFP : FF) / 64, TDN_NT = DM / 64, TIN_KT = DM / 64, TIN_NT = NINP / 64, TOUT_KT = DM / 64, TOUT_NT = DM / 64;
constexpr int TL_GU = 2 * TGU_KT * TGU_NT, TL_DN = 2 * TDN_KT * TDN_NT, TL_IN = TIN_KT * TIN_NT, TL_OUT = TOUT_KT * TOUT_NT, NT_L = TL_GU + TL_DN + TL_IN + TL_OUT;
struct CTile { const float* sp; unsigned char* dp; float scale; int fp8; };
__device__ __forceinline__ CTile conv_desc(const Params& p, int l, int it, int tid) {
    const int r = tid >> 3, c = (tid & 7) * 8;
    CTile d; d.scale = 1.0f; d.fp8 = 0;
    if (it < TL_GU) {
        const int mat = l * 2 + it / (TGU_KT * TGU_NT), rr = it % (TGU_KT * TGU_NT), kt = rr / TGU_NT, nt = rr % TGU_NT;
        const int n0 = nt * 64, t256 = n0 / 256, cc = n0 % 256;
        const int c0 = cc < 128 ? 128 * t256 + cc : FF + 128 * t256 + (cc - 128);
        d.sp = p.in[I_GU] + (size_t)mat * DM * NGU + (size_t)(kt * 64 + r) * NGU + c0 + c;
        if (g1_fp8(mat >> 1, mat & 1)) { d.fp8 = 1; d.scale = WGU_SCALE; d.dp = WSP(unsigned char, WS_WGU) + (size_t)mat * NGU * DM * 2 + (size_t)(n0 + r) * DM + kt * 64 + c; }
        else d.dp = WSP(unsigned char, WS_WGU) + ((size_t)mat * NGU * DM + (size_t)(n0 + r) * DM + kt * 64 + c) * 2;
    } else if (it < TL_GU + TL_DN) {
        const int i2 = it - TL_GU, mat = l * 2 + i2 / (TDN_KT * TDN_NT), rr = i2 % (TDN_KT * TDN_NT), kt = rr / TDN_NT, nt = rr % TDN_NT;
        d.sp = (kt * 64 + r < FF) ? p.in[I_DOWN] + (size_t)mat * FF * DM + (size_t)(kt * 64 + r) * DM + nt * 64 + c : nullptr;
#if G2_FP8
        d.fp8 = 1; d.scale = WDN_SCALE; d.dp = WSP(unsigned char, WS_WDN) + (size_t)mat * DM * FFP + (size_t)(nt * 64 + r) * FFP + kt * 64 + c;
#else
        d.dp = WSP(unsigned char, WS_WDN) + ((size_t)mat * DM * FF + (size_t)(nt * 64 + r) * FF + kt * 64 + c) * 2;
#endif
    } else if (it < TL_GU + TL_DN + TL_IN) {
        const int i2 = it - TL_GU - TL_DN, kt = i2 / TIN_NT, nt = i2 % TIN_NT;
        d.sp = (nt * 64 + c + 8 <= NIN) ? p.in[I_WIN] + (size_t)l * DM * NIN + (size_t)(kt * 64 + r) * NIN + nt * 64 + c : nullptr;
        d.dp = WSP(unsigned char, WS_WIN) + ((size_t)l * NINP * DM + (size_t)(nt * 64 + r) * DM + kt * 64 + c) * 2;
    } else {
        const int i2 = it - TL_GU - TL_DN - TL_IN, kt = i2 / TOUT_NT, nt = i2 % TOUT_NT;
        d.sp = p.in[I_WOUT] + (size_t)l * DM * DM + (size_t)(kt * 64 + r) * DM + nt * 64 + c;
        d.dp = WSP(unsigned char, WS_WOUT) + ((size_t)l * DM * DM + (size_t)(nt * 64 + r) * DM + kt * 64 + c) * 2;
    }
    return d;
}
__device__ __forceinline__ void conv_layer_tiles(const Params& p, int l, int t_begin, int t_end, int first, int stride, float* s_tile) {
    const int tid = opaque_tid(), r = tid >> 3, c = (tid & 7) * 8;
    int it = t_begin + first;
    if (it >= t_end) return;
    __syncthreads();
    CTile d = conv_desc(p, l, it, tid);
    float4 a = make_float4(0.f, 0.f, 0.f, 0.f), b = a;
    if (d.sp) { a = *(const float4*)d.sp; b = *(const float4*)(d.sp + 4); }
    for (int par = 0; it < t_end; it += stride, par ^= 1) {
        const int nx = it + stride;
        CTile dn = d; float4 na = make_float4(0.f, 0.f, 0.f, 0.f), nb = na;
        if (nx < t_end) { dn = conv_desc(p, l, nx, tid); if (dn.sp) { na = *(const float4*)dn.sp; nb = *(const float4*)(dn.sp + 4); } }
        float* tile = s_tile + par * (64 * 65);
        { float* t = tile + r * 65 + c; const float sc = d.scale;
          t[0] = a.x * sc; t[1] = a.y * sc; t[2] = a.z * sc; t[3] = a.w * sc; t[4] = b.x * sc; t[5] = b.y * sc; t[6] = b.z * sc; t[7] = b.w * sc; }
        __syncthreads();
        { const float* t = tile + c * 65 + r;
          if (d.fp8) { uint2 w; w.x = pack4_fp8(t[0 * 65], t[1 * 65], t[2 * 65], t[3 * 65]); w.y = pack4_fp8(t[4 * 65], t[5 * 65], t[6 * 65], t[7 * 65]); *(uint2*)d.dp = w; }
          else { uint4 w; w.x = pack2(t[0 * 65], t[1 * 65]); w.y = pack2(t[2 * 65], t[3 * 65]); w.z = pack2(t[4 * 65], t[5 * 65]); w.w = pack2(t[6 * 65], t[7 * 65]); *(uint4*)d.dp = w; } }
        d = dn; a = na; b = nb;
    }
    __syncthreads();
}

constexpr int MOD_TC = 72, MOD_CG = MOD_TC / 4, MOD_KS = 16, MOD_KR = DM / MOD_KS, MOD_NT = NMOD / MOD_TC;
constexpr int MOD_LDS_FLOATS = NCOND * DM + MOD_KS * MOD_CG * NCOND * 4;
static_assert(NMOD % MOD_TC == 0 && MOD_CG * MOD_KS <= 512 && DM % MOD_KS == 0 && MOD_KR % 16 == 0, "mod tiling");
__device__ __forceinline__ void mod_layer(const Params& p, int l, int first, int stride, float* smem) {
    const int tid = opaque_tid();
    float* s_cond = smem;
    float* s_red = s_cond + NCOND * DM;
    __syncthreads();
    for (int i = tid; i < NCOND * DM; i += 512) { const int ci = i / DM, k = i % DM; const float v = ci == 0 ? p.in[I_CCTX][k] : p.in[I_C][(size_t)(ci - 1) * DM + k]; s_cond[i] = silu_f(v); }
    __syncthreads();
    float* modv = WSP(float, WS_MODV);
    const int cg = tid % MOD_CG, ks = tid / MOD_CG;
    for (int jt = first; jt < MOD_NT; jt += stride) {
        if (ks < MOD_KS) {
            const float* w = p.in[I_WMOD] + (size_t)l * DM * NMOD + (size_t)(ks * MOD_KR) * NMOD + jt * MOD_TC + cg * 4;
            const float* sc = s_cond + ks * MOD_KR;
            vf4 acc[NCOND];
#pragma unroll
            for (int ci = 0; ci < NCOND; ++ci) acc[ci] = (vf4){0.f, 0.f, 0.f, 0.f};
            for (int k = 0; k < MOD_KR; k += 16) {
                vf4 wv[16];
#pragma unroll
                for (int j = 0; j < 16; ++j) wv[j] = *(const vf4*)(w + (size_t)(k + j) * NMOD);
#pragma unroll
                for (int j4 = 0; j4 < 4; ++j4)
#pragma unroll
                    for (int ci = 0; ci < NCOND; ++ci) {
                        const vf4 s = *(const vf4*)&sc[ci * DM + k + j4 * 4];
                        acc[ci] += s.x * wv[j4 * 4] + s.y * wv[j4 * 4 + 1] + s.z * wv[j4 * 4 + 2] + s.w * wv[j4 * 4 + 3];
                    }
            }
#pragma unroll
            for (int ci = 0; ci < NCOND; ++ci) *(vf4*)&s_red[((ks * MOD_CG + cg) * NCOND + ci) * 4] = acc[ci];
        }
        __syncthreads();
        for (int i = tid; i < MOD_TC * NCOND; i += 512) {
            const int c = i % MOD_TC, ci = i / MOD_TC, col = jt * MOD_TC + c;
            float sum = p.in[I_BMOD][(size_t)l * NMOD + col];
#pragma unroll
            for (int k2 = 0; k2 < MOD_KS; ++k2) sum += s_red[((k2 * MOD_CG + (c >> 2)) * NCOND + ci) * 4 + (c & 3)];
            modv[((size_t)l * NCOND + ci) * NMOD + col] = sum;
        }
        __syncthreads();
    }
}

__device__ __forceinline__ void phase_prologue(const Params& p, float* smem) {
    const int tid = threadIdx.x, nb = gridDim.x, bid = blockIdx.x;
    float* s_tile = smem;
#if CONV_FILLER
    mod_layer(p, 0, bid, nb, smem);
#ifdef PRO_DUP_MOD
    for (int r_ = 0; r_ < opaque_int(PRO_DUP_MOD); ++r_) mod_layer(p, 0, bid, nb, smem);
#endif
#else
    for (int l2 = 0; l2 < DEPTH; ++l2) mod_layer(p, l2, bid, nb, smem);
#endif
    conv_layer_tiles(p, 0, 0, NT_L, bid, nb, s_tile);
#ifdef PRO_DUP_CONV
    for (int r_ = 0; r_ < opaque_int(PRO_DUP_CONV); ++r_) conv_layer_tiles(p, 0, 0, NT_L, bid, nb, s_tile);
#endif
#if !CONV_FILLER
    for (int l2 = 1; l2 < DEPTH; ++l2) conv_layer_tiles(p, l2, 0, NT_L, bid, nb, s_tile);
#endif
    const size_t gtid = (size_t)bid * 512 + tid, gstride = (size_t)nb * 512;
    {
        const size_t n_na = (size_t)LB * DEPTH * 256 * 512 / 8;
        for (size_t i = gtid; i < 2 * n_na; i += gstride) {
            const bool isv = i >= n_na; const size_t j = isv ? i - n_na : i;
            const int d8 = (int)(j % 16), h = (int)((j / 16) % 4), t = (int)((j / 64) % 256); const size_t bl = j / (64 * 256);
            const float* s = p.in[isv ? I_CNAV : I_CNAK] + ((bl * 4 + h) * 256 + t) * 128 + d8 * 8;
            const float4 a = *(const float4*)s, b = *(const float4*)(s + 4);
            uint4 w; w.x = pack2(a.x, a.y); w.y = pack2(a.z, a.w); w.z = pack2(b.x, b.y); w.w = pack2(b.z, b.w);
            *(uint4*)(WSP(bf16_t, isv ? WS_CNAV : WS_CNAK) + (bl * 256 + t) * 512 + h * 128 + d8 * 8) = w;
        }
        const size_t n_g = (size_t)LB * DEPTH * 256 * 256 / 8;
        for (size_t i = gtid; i < 2 * n_g; i += gstride) {
            const bool isv = i >= n_g; const size_t j = isv ? i - n_g : i;
            const int d8 = (int)(j % 16), h = (int)((j / 16) % 2), t = (int)((j / 32) % 256); const size_t bl = j / (32 * 256);
            const float* s = p.in[isv ? I_CGV : I_CGK] + ((bl * 2 + h) * 256 + t) * 128 + d8 * 8;
            const float4 a = *(const float4*)s, b = *(const float4*)(s + 4);
            uint4 w; w.x = pack2(a.x, a.y); w.y = pack2(a.z, a.w); w.z = pack2(b.x, b.y); w.w = pack2(b.z, b.w);
            *(uint4*)(WSP(bf16_t, isv ? WS_CGV : WS_CGK) + (bl * 256 + t) * 256 + h * 128 + d8 * 8) = w;
        }
    }
    for (size_t i = gtid; i < 64 * 32; i += gstride) {
        const int pos = (int)(i / 32), k = (int)(i % 32);
        const float inv = powf(10000.0f, -(float)(2 * k) / 64.0f);
        const float ang = (float)pos * inv;
        WSP(float, WS_ROPE)[i] = cosf(ang); WSP(float, WS_ROPE)[64 * 32 + i] = sinf(ang);
    }
}

#ifndef NORM_NR
#define NORM_NR 2
#endif
constexpr int NORM_MAXC = 6;
__device__ __forceinline__ void phase_norm(const Params& p, int l, int which  , unsigned char* lds) {
    const int tid = opaque_tid(), lane = tid & 63, wv = tid >> 6;
    const float* X = WSP(float, WS_X); bf16_t* H = WSP(bf16_t, WS_H);
    const bool from_in = (l == 0 && which == 0);
    const float* g = p.in[I_NORMG] + ((size_t)l * 3 + which) * DM;
    const int rpb = (M + (int)gridDim.x - 1) / (int)gridDim.x;
    const int r0 = (int)blockIdx.x * rpb, r1 = r0 + rpb < M ? r0 + rpb : M;
    if (r0 >= r1) return;
    const int c_lo = cond_of_row(r0), c_hi = cond_of_row(r1 - 1);
    float* sw = (float*)lds;
    for (int ci = 0; ci <= c_hi - c_lo && ci < NORM_MAXC; ++ci) {
        const float* mv = WSP(float, WS_MODV) + ((size_t)l * NCOND + c_lo + ci) * NMOD + (size_t)which * 3 * DM;
        const int c = tid * 4;
        const vf4 gg = *(const vf4*)(g + c), sh = *(const vf4*)(mv + c), sc = *(const vf4*)(mv + DM + c);
        *(vf4*)(sw + (size_t)ci * 2 * DM + c) = gg * (1.f + sc);
        *(vf4*)(sw + (size_t)ci * 2 * DM + DM + c) = sh;
    }
    __syncthreads();
    for (int m0 = r0 + wv; m0 < r1; m0 += NORM_NR * 8) {
        int mm[NORM_NR]; bool has[NORM_NR];
#pragma unroll
        for (int k = 0; k < NORM_NR; ++k) { has[k] = m0 + k * 8 < r1; mm[k] = has[k] ? m0 + k * 8 : m0; }
        vf4 v[NORM_NR][8]; float ss[NORM_NR];
#pragma unroll
        for (int k = 0; k < NORM_NR; ++k) {
            const int m = mm[k];
            if (from_in || !XBF16) {
                const float* x = !from_in ? X + (size_t)m * DM : m < MC ? p.in[I_XP] + (size_t)m * DM : p.in[I_XS] + (size_t)(m - MC) * DM;
#pragma unroll
                for (int i = 0; i < 8; ++i) v[k][i] = *(const vf4*)(x + (i * 64 + lane) * 4);
            } else {
                const bf16_t* x = (const bf16_t*)X + (size_t)m * DM;
#pragma unroll
                for (int i = 0; i < 8; ++i) v[k][i] = ld4bf(x + (i * 64 + lane) * 4);
            }
        }
#pragma unroll
        for (int k = 0; k < NORM_NR; ++k) {
            ss[k] = 0.f;
#pragma unroll
            for (int i = 0; i < 8; ++i) ss[k] += v[k][i].x * v[k][i].x + v[k][i].y * v[k][i].y + v[k][i].z * v[k][i].z + v[k][i].w * v[k][i].w;
            ss[k] = wave_sum(ss[k]);
        }
#pragma unroll
        for (int k = 0; k < NORM_NR; ++k) {
            if (k > 0 && !has[k]) break;
            const int m = mm[k];
            const float* a = sw + (size_t)(cond_of_row(m) - c_lo) * 2 * DM;
            const float r = rsqrt_fast(ss[k] * (1.0f / DM) + EPS);
#pragma unroll
            for (int i = 0; i < 8; ++i) {
                const int c = (i * 64 + lane) * 4;
                const vf4 o = v[k][i] * r * *(const vf4*)(a + c) + *(const vf4*)(a + DM + c);
                if (which != 1 && g1_fp8(l, which >> 1)) *(unsigned*)((unsigned char*)H + (size_t)m * DM + c) = pack4_fp8(o.x, o.y, o.z, o.w);
                else { uint2 w; w.x = pack2(o.x, o.y); w.y = pack2(o.z, o.w); *(uint2*)(H + (size_t)m * DM + c) = w; }
            }
            if (G2_FP8 && which != 1 && lane < (FFP - FF) / 4) *(unsigned*)(WSP(unsigned char, WS_ACT) + (size_t)m * FFP + FF + 4 * lane) = 0u;
        }
    }
}

__device__ __forceinline__ float red16(float v);
__device__ __forceinline__ float ssq8(vf4 a, vf4 b) { const vf4 s = a * a + b * b; return (s.x + s.y) + (s.z + s.w); }
__device__ __forceinline__ uint4 pack8(vf4 a, vf4 b) { uint4 w; w.x = pack2(a.x, a.y); w.y = pack2(a.z, a.w); w.z = pack2(b.x, b.y); w.w = pack2(b.z, b.w); return w; }
constexpr int PL_CW = 0, PL_UP = PL_CW + 5 * 1536, PL_GB = PL_UP + 2 * 16 * 256, PL_NQ = PL_GB + 512, PL_ROPE = PL_NQ + 512, PL_END = PL_ROPE + 2 * 64 * 32;
__device__ __forceinline__ void phase_prep(const Params& p, int l, unsigned char* lds) {
    const int tid = opaque_tid(), lane = tid & 63, wv = tid >> 6, rg = lane >> 4, sub = lane & 15, c8 = sub * 8;
    const bf16_t* Z = WSP(bf16_t, WS_Z);
    float* sw = (float*)lds;
    for (int i = tid; i < 5 * 1536; i += 512) { const int j = i / 1536, col = i % 1536; sw[PL_CW + j * 1536 + ((col >> 2) & 1) * 768 + (col >> 3) * 4 + (col & 3)] = p.in[I_CONV][(size_t)l * 5 * 1536 + i]; }
    for (int i = tid; i < 2 * 16 * 256 / 4; i += 512) ((vf4*)(sw + PL_UP))[i] = ((const vf4*)(p.in[I_GUP] + (size_t)l * 2 * 16 * 256))[i];
    sw[PL_GB + tid] = p.in[I_GBIAS][(size_t)l * 512 + tid];
    { const int v = tid >> 7, c = tid & 127; const float* src = (v < 2 ? p.in[I_NAQKN] : p.in[I_GQAQKN]) + ((size_t)l * 2 + (v & 1)) * 128; sw[PL_NQ + v * 128 + ((c >> 2) & 1) * 64 + (c >> 3) * 4 + (c & 3)] = src[c]; }
    for (int i = tid; i < 2 * 64 * 32 / 4; i += 512) ((vf4*)(sw + PL_ROPE))[i] = ((const vf4*)WSP(float, WS_ROPE))[i];
    __syncthreads();
    const float* ropec = sw + PL_ROPE; const float* ropes = ropec + 64 * 32;
    const float* wnq = sw + PL_NQ + sub * 4; const float* wnk = wnq + 128;
    const float* wgq = wnq + 256; const float* wgk = wnq + 384;
    const float* cw = sw + PL_CW + (rg * 16 + sub) * 4;
    const int rpw = (M + (int)gridDim.x * 8 - 1) / ((int)gridDim.x * 8);
    for (int m = ((int)blockIdx.x * 8 + wv) * rpw, mend = (m + rpw < M ? m + rpw : M); m < mend; ++m) {
        const bf16_t* z = Z + (size_t)m * NINP;
        const bool ctx = m < MC;
        const int b = ctx ? m / CT : (m - MC) / LT, t = ctx ? m % CT : (m - MC) % LT, T = ctx ? CT : LT;
        const int ho = rg * 128 + c8;
        uint4 rz[5]; uint2 rgz[2][4];
        {
            const bf16_t* zkv = z + (rg < 2 ? Z_GQK + rg * 128 : Z_GQV + (rg - 2) * 128) + c8;
            rz[0] = *(const uint4*)(z + Z_NAQ + ho); rz[1] = *(const uint4*)(z + Z_NAK + ho); rz[2] = *(const uint4*)(z + Z_NAV + ho); rz[3] = *(const uint4*)(z + Z_GQQ + ho); rz[4] = *(const uint4*)zkv;
#pragma unroll
            for (int dir = 0; dir < 2; ++dir)
#pragma unroll
                for (int r4 = 0; r4 < 4; ++r4) rgz[dir][r4] = *(const uint2*)(z + (dir ? Z_GB : Z_GF) + 4 * r4);
        }
        asm volatile("" ::: "memory");
        {
            vf4 q0, q1, k0, k1, v0, v1, g0, g1, x0, x1;
            unp8bf(rz[0], q0, q1); unp8bf(rz[1], k0, k1); unp8bf(rz[2], v0, v1); unp8bf(rz[3], g0, g1); unp8bf(rz[4], x0, x1);
            float r = rsqrt_fast(red16(ssq8(q0, q1)) * (1.0f / 128) + EPS);
            q0 = q0 * r * *(const vf4*)wnq; q1 = q1 * r * *(const vf4*)(wnq + 64);
            *(uint4*)(WSP(bf16_t, WS_NAQ) + (size_t)m * 512 + ho) = pack8(q0, q1);
            r = rsqrt_fast(red16(ssq8(k0, k1)) * (1.0f / 128) + EPS);
            k0 = k0 * r * *(const vf4*)wnk; k1 = k1 * r * *(const vf4*)(wnk + 64);
            *(uint4*)(WSP(bf16_t, WS_NAK) + (size_t)m * 512 + ho) = pack8(k0, k1);
            *(uint4*)(WSP(bf16_t, WS_NAV) + (size_t)m * 512 + ho) = pack8(v0, v1);
            if (ctx) {
                const size_t o = ((((size_t)b * DEPTH + l) * 4 + rg) * CT + t) * 128 + c8;
                *(vf4*)(p.out + O_NAK + o) = k0; *(vf4*)(p.out + O_NAK + o + 4) = k1; *(vf4*)(p.out + O_NAV + o) = v0; *(vf4*)(p.out + O_NAV + o + 4) = v1;
            }
            r = rsqrt_fast(red16(ssq8(g0, g1)) * (1.0f / 128) + EPS);
            g0 = g0 * r * *(const vf4*)wgq; g1 = g1 * r * *(const vf4*)(wgq + 64);
            const float rk = rsqrt_fast(red16(ssq8(x0, x1)) * (1.0f / 128) + EPS);
            if (rg < 2) { x0 = x0 * rk * *(const vf4*)wgk; x1 = x1 * rk * *(const vf4*)(wgk + 64); }
            if (!ctx) {
                const int pos = sub < 8 ? (t >> 6) : (t & 63), ai = pos * 32 + (c8 & 31);
                const vf4 c0 = *(const vf4*)(ropec + ai), c1 = *(const vf4*)(ropec + ai + 4), s0 = *(const vf4*)(ropes + ai), s1 = *(const vf4*)(ropes + ai + 4);
                const bool hi = (sub & 4) != 0;
                vf4 pg0, pg1, px0, px1;
#pragma unroll
                for (int j = 0; j < 4; ++j) { pg0[j] = __shfl_xor(g0[j], 4); pg1[j] = __shfl_xor(g1[j], 4); px0[j] = __shfl_xor(x0[j], 4); px1[j] = __shfl_xor(x1[j], 4); }
                g0 = hi ? pg0 * s0 + g0 * c0 : g0 * c0 - pg0 * s0; g1 = hi ? pg1 * s1 + g1 * c1 : g1 * c1 - pg1 * s1;
                if (rg < 2) { x0 = hi ? px0 * s0 + x0 * c0 : x0 * c0 - px0 * s0; x1 = hi ? px1 * s1 + x1 * c1 : x1 * c1 - px1 * s1; }
            }
            *(uint4*)(WSP(bf16_t, WS_GQ) + (size_t)m * 512 + ho) = pack8(g0, g1);
            *(uint4*)(WSP(bf16_t, rg < 2 ? WS_GK : WS_GV) + (size_t)m * 256 + (rg & 1) * 128 + c8) = pack8(x0, x1);
            if (ctx) {
                const size_t o = ((((size_t)b * DEPTH + l) * 2 + (rg & 1)) * CT + t) * 128 + c8;
                float* dst = p.out + (rg < 2 ? O_GK : O_GV) + o;
                *(vf4*)dst = x0; *(vf4*)(dst + 4) = x1;
            }
        }
        asm volatile("" ::: "memory");
        {
#pragma unroll
            for (int dir = 0; dir < 2; ++dir) {
                const float* up = sw + PL_UP + dir * 16 * 256 + 4 * lane;
                vf4 acc = *(const vf4*)(sw + PL_GB + dir * 256 + 4 * lane);
#pragma unroll
                for (int r4 = 0; r4 < 4; ++r4) {
                    const vf4 gv = unp4bf(rgz[dir][r4]);
                    acc += gv.x * *(const vf4*)(up + (4 * r4 + 0) * 256) + gv.y * *(const vf4*)(up + (4 * r4 + 1) * 256) + gv.z * *(const vf4*)(up + (4 * r4 + 2) * 256) + gv.w * *(const vf4*)(up + (4 * r4 + 3) * 256);
                }
                vf4 o;
#pragma unroll
                for (int j = 0; j < 4; ++j) o[j] = logsigmoid_fast(acc[j]) * (1.0f / 16.0f);
                *(vf4*)(WSP(float, dir ? WS_AB : WS_AF) + (size_t)m * 256 + 4 * lane) = o;
            }
        }
        asm volatile("" ::: "memory");
        {
            uint4 rcz[3][5];
#pragma unroll
            for (int part = 0; part < 3; ++part)
#pragma unroll
                for (int j = 0; j < 5; ++j) { const int tt = t + j - 2;
                    rcz[part][j] = (tt >= 0 && tt < T) ? *(const uint4*)(Z + (size_t)(m + j - 2) * NINP + Z_DQKV + part * 512 + rg * 128 + c8) : make_uint4(0u, 0u, 0u, 0u); }
            asm volatile("" ::: "memory");
#pragma unroll
            for (int part = 0; part < 3; ++part) {
                vf4 a0 = (vf4){0.f, 0.f, 0.f, 0.f}, a1 = a0;
#pragma unroll
                for (int j = 0; j < 5; ++j) {
                    const float* cj = cw + j * 1536 + part * 256;
                    vf4 z0, z1; unp8bf(rcz[part][j], z0, z1);
                    a0 += *(const vf4*)cj * z0; a1 += *(const vf4*)(cj + 768) * z1;
                }
#pragma unroll
                for (int j = 0; j < 4; ++j) { a0[j] = silu_fast(a0[j]); a1[j] = silu_fast(a1[j]); }
                if (part < 2) { const float r = rsqrt_fast(red16(ssq8(a0, a1)) + EPS) * (part == 0 ? 0.08838834764831845f : 1.0f); a0 *= r; a1 *= r; }
                *(uint4*)(WSP(bf16_t, part == 0 ? WS_DQ : part == 1 ? WS_DK : WS_DV) + (size_t)m * 512 + rg * 128 + c8) = pack8(a0, a1);
                asm volatile("" ::: "memory");
            }
            if (lane < 8) {
                const float beta = 1.0f / (1.0f + expf(-bf2f(z[Z_DB + lane])));
                const float g = -expf(p.in[I_ALOG][(size_t)l * 8 + lane]) * softplus_f(bf2f(z[Z_DA + lane]) + p.in[I_DTB][(size_t)l * 8 + lane]);
                float* ba = WSP(float, WS_DBA) + (size_t)m * 16;
                ba[lane] = beta; ba[8 + lane] = g;
            }
        }
    }
}

typedef float vf2 __attribute__((ext_vector_type(2)));
__device__ __forceinline__ float dpp_f(float v, const int ctrl) { return v; }
#define DPPF(v, ctrl) __int_as_float(__builtin_amdgcn_mov_dpp(__float_as_int(v), (ctrl), 0xF, 0xF, true))
__device__ __forceinline__ float red8(float v) { v += DPPF(v, 0xB1); v += DPPF(v, 0x4E); v += DPPF(v, 0x141); return v; }
__device__ __forceinline__ float red16(float v) { v = red8(v); v += DPPF(v, 0x140); return v; }

__device__ __forceinline__ void phase_post(const Params& p, int l) {
    const int tid = opaque_tid(), lane = tid & 63, wv = tid >> 6, rg = lane >> 4, c8 = (lane & 15) * 8;
    const bf16_t* Z = WSP(bf16_t, WS_Z); bf16_t* MRG = WSP(bf16_t, WS_MRG);
    const float* wg = p.in[I_GLAON] + (size_t)l * 128 + c8; const float* wd = p.in[I_GDNON] + (size_t)l * 128 + c8;
    for (int m = blockIdx.x * 8 + wv; m < M; m += gridDim.x * 8) {
        const bf16_t* z = Z + (size_t)m * NINP;
        const int ho = rg * 128 + c8;
#pragma unroll
        for (int g = 0; g < 2; ++g) {
            const float* of = WSP(float, g ? WS_DOF : WS_GOF) + (size_t)m * 512 + ho; const float* ob = WSP(float, g ? WS_DOB : WS_GOB) + (size_t)m * 512 + ho;
            const float* w = g ? wd : wg; const bf16_t* zg = z + (g ? Z_DZ : Z_GLR) + ho;
            vf4 a0 = *(const vf4*)of + *(const vf4*)ob, a1 = *(const vf4*)(of + 4) + *(const vf4*)(ob + 4);
            vf4 g0, g1; ld8bf(zg, g0, g1);
            const float r = rsqrt_fast(red16(ssq8(a0, a1)) * (1.0f / 128) + EPS);
            a0 = a0 * r * *(const vf4*)w; a1 = a1 * r * *(const vf4*)(w + 4);
#pragma unroll
            for (int j = 0; j < 4; ++j) { a0[j] *= silu_fast(g0[j]); a1[j] *= silu_fast(g1[j]); }
            *(uint4*)(MRG + (size_t)m * DM + (g ? 1536 : 512) + ho) = pack8(a0, a1);
        }
    }
}
#define XB_TMO      128
#define XB_XCNT(j)  (256  + 64 * (j))
#define XB_XSUB(j)  (1280 + 64 * (j))
#define XB_XGEN(j)  (2304 + 64 * (j))
#define XB_TOP      3328
#define XB_TOPGEN   3392
#define XCD_BAR_WORDS 3456
#define XB_SPIN_CAP (1u << 22)
#define LAS __attribute__((address_space(3)))

__device__ __forceinline__ unsigned xb_ld(unsigned* p)              { return __hip_atomic_load(p, __ATOMIC_RELAXED, __HIP_MEMORY_SCOPE_AGENT); }
__device__ __forceinline__ unsigned xb_add(unsigned* p, unsigned v) { return __hip_atomic_fetch_add(p, v, __ATOMIC_RELAXED, __HIP_MEMORY_SCOPE_AGENT); }
__device__ __forceinline__ unsigned xb_xcc_id() { return (unsigned)__builtin_amdgcn_s_getreg((3 << 11) | 20) & 0xFu; }
#define XB_SPIN(cond, bar) do { unsigned _sp = 0; while (cond) { __builtin_amdgcn_s_sleep(1); \
    if ((++_sp & 255u) == 0u) { if (xb_ld(&(bar)[XB_TMO])) break; if (_sp > XB_SPIN_CAP) { atomicAdd(&(bar)[XB_TMO], 1u); break; } } } } while (0)

struct XcdBarrier {
    unsigned* bar; unsigned x;
    volatile LAS unsigned* st;
};

__device__ __forceinline__ XcdBarrier xcd_barrier_post(unsigned* bar, volatile LAS unsigned* st) {
    XcdBarrier b; b.bar = bar; b.x = xb_xcc_id(); b.st = st;
    if (threadIdx.x == 0) (void)xb_add(&bar[XB_XCNT(b.x)], 1u);
    return b;
}
__device__ __forceinline__ void xcd_barrier_complete(unsigned* bar, unsigned x, unsigned& nloc, unsigned& nx) {
    const unsigned G = gridDim.x * gridDim.y * gridDim.z;
    unsigned sum, cnt, mine, sp = 0u;
    for (;;) {
        sum = 0u; cnt = 0u; mine = 0u;
#pragma unroll
        for (unsigned j = 0; j < 16; ++j) { const unsigned c = xb_ld(&bar[XB_XCNT(j)]); sum += c; cnt += (c > 0u) ? 1u : 0u; mine = (j == x) ? c : mine; }
        if (sum == G) break;
        __builtin_amdgcn_s_sleep(1);
        if ((++sp & 255u) == 0u) { if (xb_ld(&bar[XB_TMO])) break; if (sp > XB_SPIN_CAP) { atomicAdd(&bar[XB_TMO], 1u); break; } }
    }
    nloc = mine > 0u ? mine : 1u; nx = cnt > 0u ? cnt : 1u;
}

__device__ __forceinline__ void xcd_barrier(const XcdBarrier& b) {
    asm volatile("s_waitcnt vmcnt(0)" ::: "memory");
    __syncthreads();
    if (threadIdx.x == 0) {
        unsigned* bar = b.bar;
        __builtin_amdgcn_s_waitcnt(0);
        unsigned nloc = b.st[0], nx = b.st[1];
        if (nloc == 0u) { xcd_barrier_complete(bar, b.x, nloc, nx); b.st[0] = nloc; b.st[1] = nx; }
        const unsigned old = xb_add(&bar[XB_XSUB(b.x)], 1u);
        const unsigned gen = old / nloc;
        if (old + 1u == (gen + 1u) * nloc) {
            __builtin_amdgcn_fence(__ATOMIC_RELEASE, "agent");
            asm volatile("s_waitcnt vmcnt(0)" ::: "memory");
            const unsigned og = xb_add(&bar[XB_TOP], 1u);
            const unsigned tg = og / nx;
            if (og + 1u == (tg + 1u) * nx) xb_add(&bar[XB_TOPGEN], 1u);
            else XB_SPIN(xb_ld(&bar[XB_TOPGEN]) == tg, bar);
            __builtin_amdgcn_fence(__ATOMIC_ACQUIRE, "agent");
            xb_add(&bar[XB_XGEN(b.x)], 1u);
            asm volatile("s_waitcnt vmcnt(0)" ::: "memory");
        } else {
            XB_SPIN(xb_ld(&bar[XB_XGEN(b.x)]) == gen, bar);
            __builtin_amdgcn_fence(__ATOMIC_ACQUIRE, "agent");
            asm volatile("s_waitcnt vmcnt(0)" ::: "memory");
        }
    }
    __syncthreads();
}

#ifndef NT_STORES
#define NT_STORES 0
#endif
namespace pg8 {
#define PG8_LAS __attribute__((address_space(3)))
typedef unsigned short bf16_t;
typedef short bf16x8 __attribute__((ext_vector_type(8)));
typedef float f32x4 __attribute__((ext_vector_type(4)));
typedef unsigned u32x4 __attribute__((ext_vector_type(4)));
typedef unsigned u32x2 __attribute__((ext_vector_type(2)));
typedef int v4i32 __attribute__((ext_vector_type(4)));
typedef int v8i32 __attribute__((ext_vector_type(8)));
constexpr int BM = 256, BK = 64, HALF = 128, HTB = HALF * BK * 2  , STAGE_BYTES = 8 * HTB, NXCD = 8, WGM = 8;

__host__ __device__ __forceinline__ int lds_byte(int r, int c) { const int st = (r >> 4) * 2 + (c >> 5), rr = r & 15, cc = c & 31, ob = rr * 64 + cc * 2; return st * 1024 + (ob ^ (((ob >> 9) & 1) << 5)); }
__host__ __device__ __forceinline__ void stage_rc(int b, int& R, int& C) { const int st = b / 1024, sb = b % 1024, swz = sb ^ (((sb >> 9) & 1) << 5); R = (st >> 1) * 16 + swz / 64; C = (st & 1) * 32 + (swz % 64) / 2; }
__host__ __device__ __forceinline__ int perm32(int rho) { const int n = rho >> 4, i = rho & 15; return 8 * (i >> 2) + 4 * n + (i & 3); }

struct Unit { int pm, pn, k0, nt, at, slot, msk; };
struct Gemm { const bf16_t* A; const bf16_t* Bt; int M, N, K; };

struct StaticOrder {
    int nM, nN, nwg, G, c, ntk, split, msplit;
    __host__ __device__ void init(int M, int N, int K, int G_, int c_, int split_ = 0) { nM = M / BM; nN = N / BM; nwg = nM * nN; G = G_; c = c_; ntk = K / BK; const int rem = nwg % G_; split = (split_ == 1 && rem > 0 && 2 * rem == G_ && ntk >= 8) ? 1 : 0; msplit = (split_ == 2 && rem > 0 && 2 * rem <= G_) ? 1 : 0; }
    __host__ __device__ bool next(int i, Unit& u) const {
        long L = (long)i * G + c; u.k0 = 0; u.nt = ntk; u.at = 0; u.slot = 0; u.msk = 3;
        if (msplit && i == nwg / G) { const int rem = nwg % G; if (c >= 2 * rem) return false; L = (long)i * G + (c % rem); u.msk = (c / rem) ? 2 : 1; }
        if (split && i == nwg / G) { const int rem = nwg % G, sl = c / rem, h0 = ((ntk / 2) + 1) & ~1; L = (long)i * G + (c % rem); u.k0 = sl ? h0 * BK : 0; u.nt = sl ? ntk - h0 : h0; u.at = sl ? 1 : 2; u.slot = c % rem; }
        if (L >= nwg) return false;
        int wgid = (int)L; { const int q = nwg / NXCD, r = nwg % NXCD, xcd = wgid % NXCD, off = wgid / NXCD; wgid = (xcd < r ? xcd * (q + 1) : r * (q + 1) + (xcd - r) * q) + off; }
        const int nig = WGM * nN, gid = wgid / nig, fm = gid * WGM, gsz = (nM - fm) < WGM ? (nM - fm) : WGM;
        u.pm = fm + ((wgid % nig) % gsz); u.pn = (wgid % nig) / gsz; return true;
    }
    __device__ __forceinline__ void a_ready(const Unit&) const {}
    __device__ __forceinline__ void done(const Unit&) const {}
};
__device__ __forceinline__ unsigned cvt_pk_bf16(float lo, float hi) { unsigned r; asm volatile("v_cvt_pk_bf16_f32 %0, %1, %2" : "=v"(r) : "v"(lo), "v"(hi)); return r; }
struct EpiF32 {
    static constexpr bool PERM = false, AFTER_DRAIN = false;
    float* C; int ldc; const float* bias;
    __device__ __forceinline__ void operator()(const f32x4 (&acc)[2][2][4][2], const Unit& u, int wr, int wc, int fr, int fq) const {
        const int row0 = u.pm * BM + wr * 64 + fr, col0 = u.pn * BM + wc * 32 + 4 * fq;
        f32x4 bv[2][2];
#pragma unroll
        for (int bj = 0; bj < 2; ++bj)
#pragma unroll
            for (int n = 0; n < 2; ++n) bv[bj][n] = bias ? *(const f32x4*)(bias + col0 + bj * HALF + n * 16) : (f32x4){0.f, 0.f, 0.f, 0.f};
#pragma unroll
        for (int ai = 0; ai < 2; ++ai)
#pragma unroll
            for (int m = 0; m < 4; ++m) { float* rowp = C + (size_t)(row0 + ai * HALF + m * 16) * ldc + col0;
#pragma unroll
                for (int bj = 0; bj < 2; ++bj)
#pragma unroll
                    for (int n = 0; n < 2; ++n) *(f32x4*)(rowp + bj * HALF + n * 16) = acc[ai][bj][m][n] + bv[bj][n]; }
    }
};

struct EpiSwiGLU {
    static constexpr bool PERM = true, AFTER_DRAIN = false;
    bf16_t* O; int ldc;
    __device__ __forceinline__ void operator()(const f32x4 (&acc)[2][2][4][2], const Unit& u, int wr, int wc, int fr, int fq) const {
        const int row0 = u.pm * BM + wr * 64 + fr, col0 = u.pn * 128 + wc * 32 + 8 * fq;
#pragma unroll
        for (int ai = 0; ai < 2; ++ai) if ((u.msk >> ai) & 1)
#pragma unroll
            for (int m = 0; m < 4; ++m) { bf16_t* rowp = O + (size_t)(row0 + ai * HALF + m * 16) * ldc + col0;
                const f32x4 g0 = acc[ai][0][m][0], g1 = acc[ai][0][m][1], u0 = acc[ai][1][m][0], u1 = acc[ai][1][m][1];
                float r[8];
#pragma unroll
                for (int j = 0; j < 4; ++j) {
                    r[j]     = g0[j] * __builtin_amdgcn_rcpf(1.0f + __builtin_amdgcn_exp2f(-1.4426950408889634f * g0[j])) * u0[j];
                    r[4 + j] = g1[j] * __builtin_amdgcn_rcpf(1.0f + __builtin_amdgcn_exp2f(-1.4426950408889634f * g1[j])) * u1[j]; }
                u32x4 w; w.x = cvt_pk_bf16(r[0], r[1]); w.y = cvt_pk_bf16(r[2], r[3]); w.z = cvt_pk_bf16(r[4], r[5]); w.w = cvt_pk_bf16(r[6], r[7]);
#if NT_STORES
                __builtin_nontemporal_store(w, (u32x4*)rowp);
#else
                *(u32x4*)rowp = w;
#endif
                }
    }
};
struct EpiSwiGLU8 {
    static constexpr bool PERM = true, AFTER_DRAIN = false;
    unsigned char* O; int ldc; float wscale;
    __device__ __forceinline__ void operator()(const f32x4 (&acc)[2][2][4][2], const Unit& u, int wr, int wc, int fr, int fq) const {
        const int row0 = u.pm * BM + wr * 64 + fr, col0 = u.pn * 128 + wc * 32 + 8 * fq;
#pragma unroll
        for (int ai = 0; ai < 2; ++ai) if ((u.msk >> ai) & 1)
#pragma unroll
            for (int m = 0; m < 4; ++m) { unsigned char* rowp = O + (size_t)(row0 + ai * HALF + m * 16) * ldc + col0;
                f32x4 g0 = acc[ai][0][m][0], g1 = acc[ai][0][m][1], u0 = acc[ai][1][m][0], u1 = acc[ai][1][m][1];
                asm volatile("" : "+v"(g0), "+v"(g1), "+v"(u0), "+v"(u1));
                g0 *= wscale; g1 *= wscale; u0 *= wscale; u1 *= wscale;
                float r[8];
#pragma unroll
                for (int j = 0; j < 4; ++j) {
                    r[j]     = g0[j] * __builtin_amdgcn_rcpf(1.0f + __builtin_amdgcn_exp2f(-1.4426950408889634f * g0[j])) * u0[j];
                    r[4 + j] = g1[j] * __builtin_amdgcn_rcpf(1.0f + __builtin_amdgcn_exp2f(-1.4426950408889634f * g1[j])) * u1[j]; }
                uint2 w; w.x = pack4_fp8(r[0], r[1], r[2], r[3]); w.y = pack4_fp8(r[4], r[5], r[6], r[7]);
                *(uint2*)rowp = w; asm volatile("" ::: "memory"); }
    }
};
struct EpiBf16Plain {
    static constexpr bool PERM = true, AFTER_DRAIN = false;
    bf16_t* O; int ldc;
    __device__ __forceinline__ void operator()(const f32x4 (&acc)[2][2][4][2], const Unit& u, int wr, int wc, int fr, int fq) const {
        const int row0 = u.pm * BM + wr * 64 + fr, col0 = u.pn * BM + wc * 32 + 8 * fq;
#pragma unroll
        for (int ai = 0; ai < 2; ++ai) if ((u.msk >> ai) & 1)
#pragma unroll
            for (int m = 0; m < 4; ++m) { bf16_t* rowp = O + (size_t)(row0 + ai * HALF + m * 16) * ldc + col0;
#pragma unroll
                for (int bj = 0; bj < 2; ++bj) { const f32x4 v0 = acc[ai][bj][m][0], v1 = acc[ai][bj][m][1];
                    u32x4 w; w.x = pack2(v0[0], v0[1]); w.y = pack2(v0[2], v0[3]); w.z = pack2(v1[0], v1[1]); w.w = pack2(v1[2], v1[3]);
                    *(u32x4*)(rowp + bj * HALF) = w; } }
    }
};
struct EpiResid {
    static constexpr bool PERM = false, AFTER_DRAIN = false;
    const float* res; float* out; int ldc; const float* gate0; float coef;
    float* slab; unsigned* flags; unsigned target;
    const float* res_hi; int row_hi;
    int res_bf16, out_bf16;
    __device__ __forceinline__ void operator()(const f32x4 (&acc)[2][2][4][2], const Unit& u, int wr, int wc, int fr, int fq) const {
        const int tidx = ((wr * 4 + wc) * 4 + fq) * 16 + fr;
        if (u.at == 1) {
            const __amdgpu_buffer_rsrc_t rs = __builtin_amdgcn_make_buffer_rsrc((void*)slab, 0, 0x7FFFFFF0, 0x00020000);
            const unsigned base = ((unsigned)u.slot * 32u * 512u + (unsigned)tidx) * 16u;
#pragma unroll
            for (int ai = 0; ai < 2; ++ai)
#pragma unroll
                for (int bj = 0; bj < 2; ++bj)
#pragma unroll
                    for (int m = 0; m < 4; ++m)
#pragma unroll
                        for (int n = 0; n < 2; ++n) { const f32x4 v = acc[ai][bj][m][n]; u32x4 w; w.x = __float_as_uint(v[0]); w.y = __float_as_uint(v[1]); w.z = __float_as_uint(v[2]); w.w = __float_as_uint(v[3]);
                            __builtin_amdgcn_raw_buffer_store_b128(w, rs, base + (unsigned)((((ai * 2 + bj) * 4 + m) * 2 + n) * 512 * 16), 0, 16); }
            asm volatile("s_waitcnt vmcnt(0)" ::: "memory");
            if ((tidx & 63) == 0) __hip_atomic_fetch_add(flags + 64 * u.slot, 1u, __ATOMIC_RELAXED, __HIP_MEMORY_SCOPE_AGENT);
            return;
        }
        const float* part = nullptr;
        if (u.at == 2) {
            unsigned spins = 0;
            while (__hip_atomic_load(flags + 64 * u.slot, __ATOMIC_RELAXED, __HIP_MEMORY_SCOPE_AGENT) < target) { __builtin_amdgcn_s_sleep(2); if (++spins > (1u << 22)) break; }
            __builtin_amdgcn_fence(__ATOMIC_ACQUIRE, "agent");
            asm volatile("s_waitcnt vmcnt(0)" ::: "memory");
            part = slab + ((size_t)u.slot * 32 * 512 + tidx) * 4;
        }
        const int row0 = u.pm * BM + wr * 64 + fr, col0 = u.pn * BM + wc * 32 + 4 * fq;
        const float* gate = gate0 + (size_t)cond_of_row(u.pm * BM) * NMOD;
        const float* rbase = (u.pm * BM >= row_hi) ? res_hi - (size_t)row_hi * ldc : res;
        f32x4 gv[2][2];
#pragma unroll
        for (int bj = 0; bj < 2; ++bj)
#pragma unroll
            for (int n = 0; n < 2; ++n) gv[bj][n] = *(const f32x4*)(gate + col0 + bj * HALF + n * 16) * coef;
#pragma unroll
        for (int ai = 0; ai < 2; ++ai) if ((u.msk >> ai) & 1) {
            f32x4 bs[4][2][2];
#pragma unroll
            for (int m = 0; m < 4; ++m) { const size_t off = (size_t)(row0 + ai * HALF + m * 16) * ldc + col0;
#pragma unroll
                for (int bj = 0; bj < 2; ++bj)
#pragma unroll
                    for (int n = 0; n < 2; ++n) {
                        const size_t eo = off + bj * HALF + n * 16;
                        if (res_bf16) { const u32x2 w = *(const u32x2*)((const bf16_t*)rbase + eo); bs[m][bj][n][0] = __uint_as_float(w.x << 16); bs[m][bj][n][1] = __uint_as_float(w.x & 0xFFFF0000u); bs[m][bj][n][2] = __uint_as_float(w.y << 16); bs[m][bj][n][3] = __uint_as_float(w.y & 0xFFFF0000u); }
                        else bs[m][bj][n] = *(const f32x4*)(rbase + eo); } }
            asm volatile("" ::: "memory");
#pragma unroll
            for (int m = 0; m < 4; ++m) { const size_t off = (size_t)(row0 + ai * HALF + m * 16) * ldc + col0;
#pragma unroll
                for (int bj = 0; bj < 2; ++bj)
#pragma unroll
                    for (int n = 0; n < 2; ++n) {
                        f32x4 a = acc[ai][bj][m][n];
                        if (part) a += *(const f32x4*)(part + (size_t)((((ai * 2 + bj) * 4 + m) * 2 + n) * 512 * 4));
                        const size_t eo = off + bj * HALF + n * 16;
                        const f32x4 o = bs[m][bj][n] + gv[bj][n] * a;
                        if (out_bf16) { u32x2 w; w.x = cvt_pk_bf16(o[0], o[1]); w.y = cvt_pk_bf16(o[2], o[3]); *(u32x2*)((bf16_t*)out + eo) = w; }
                        else *(f32x4*)(out + eo) = o; } }
            asm volatile("" ::: "memory"); }
    }
};
template <class Epi, class Sched, bool STAMP = false, int FP8 = 0>
__device__ __forceinline__ void gemm_phase(PG8_LAS unsigned char* lds, const Gemm g, const Sched& S, const Epi& E, unsigned long long* stamps) {
    const int tid = opaque_tid(), wid = __builtin_amdgcn_readfirstlane(tid >> 6), lane = tid & 63, wr = wid >> 2, wc = wid & 3, fr = lane & 15, fq = lane >> 4;
    const int K = g.K;
    int ts_lo = 0, ts_hi = 0, nts = 0; const unsigned long long rt_entry = STAMP ? (unsigned long long)wall_clock64() : 0ull;
#define PG8_STAMP() do { if (STAMP && wid == 0 && nts < 64) { const unsigned long long _c = (unsigned long long)clock64(); \
        ts_lo = (lane == nts) ? (int)(unsigned)_c : ts_lo; ts_hi = (lane == nts) ? (int)(unsigned)(_c >> 32) : ts_hi; ++nts; } } while (0)
    PG8_STAMP();
    unsigned voffA[2], voffB[2];
#pragma unroll
    for (int i = 0; i < 2; ++i) { int R, C; stage_rc(tid * 16 + i * 8192, R, C); const int Rb = Epi::PERM ? ((R & ~31) + perm32(R & 31)) : R;
        voffA[i] = (unsigned)(R * K + C) * 2u; voffB[i] = (unsigned)(Rb * K + C) * 2u; }
    const size_t kstep = (size_t)(BK * 2);
    const size_t hstep = (size_t)HALF * K * 2;
    const size_t tstep = 2 * hstep;
    const unsigned ldsw = (unsigned)wid * 1024u;
    const int aoff = lds_byte(wr * 64 + fr, fq * 8), boff = lds_byte(wc * 32 + fr, fq * 8);
#define PG8_SA(b, h) (((b) * 2 + (h)) * HTB)
#define PG8_SB(b, h) ((4 + (b) * 2 + (h)) * HTB)
#define PG8_STAGE(bufoff, gbase, voff) do { _Pragma("unroll") for (int _i = 0; _i < 2; ++_i) \
        __builtin_amdgcn_global_load_lds((const unsigned*)((const char*)(gbase) + (voff)[_i]), (PG8_LAS unsigned*)(lds + (bufoff) + ldsw + _i * 8192), 16, 0, 0); } while (0)
#define PG8_LDA(dst, b, h) do { _Pragma("unroll") for (int m = 0; m < 4; ++m) dst[m] = __builtin_shufflevector(*(const PG8_LAS v4i32*)(lds + PG8_SA(b, h) + aoff + m * 2048), *(const PG8_LAS v4i32*)(lds + PG8_SA(b, h) + aoff + m * 2048 + 1024), 0, 1, 2, 3, 4, 5, 6, 7); } while (0)
#define PG8_LDB(dst, b, h) do { _Pragma("unroll") for (int n = 0; n < 2; ++n) dst[n] = __builtin_shufflevector(*(const PG8_LAS v4i32*)(lds + PG8_SB(b, h) + boff + n * 2048), *(const PG8_LAS v4i32*)(lds + PG8_SB(b, h) + boff + n * 2048 + 1024), 0, 1, 2, 3, 4, 5, 6, 7); } while (0)
#define PG8_HALF(v, k) __builtin_bit_cast(bf16x8, __builtin_shufflevector(v, v, 4 * (k), 4 * (k) + 1, 4 * (k) + 2, 4 * (k) + 3))
#define PG8_MMA(ai, bj, At, Bt) do { __builtin_amdgcn_s_setprio(1); _Pragma("unroll") for (int m = 0; m < 4; ++m) _Pragma("unroll") for (int n = 0; n < 2; ++n) { \
        acc[ai][bj][m][n] = __builtin_amdgcn_mfma_f32_16x16x32_bf16(PG8_HALF(Bt[n], 0), PG8_HALF(At[m], 0), acc[ai][bj][m][n], 0, 0, 0); \
        acc[ai][bj][m][n] = __builtin_amdgcn_mfma_f32_16x16x32_bf16(PG8_HALF(Bt[n], 1), PG8_HALF(At[m], 1), acc[ai][bj][m][n], 0, 0, 0); } __builtin_amdgcn_s_setprio(0); } while (0)
#define PG8_MMA8(ai, bj, At, Bt) do { __builtin_amdgcn_s_setprio(1); _Pragma("unroll") for (int m = 0; m < 4; ++m) _Pragma("unroll") for (int n = 0; n < 2; ++n) \
        acc[ai][bj][m][n] = __builtin_amdgcn_mfma_scale_f32_16x16x128_f8f6f4(Bt[n], At[m], acc[ai][bj][m][n], 0, 0, 0, 127, 0, 127); __builtin_amdgcn_s_setprio(0); } while (0)
#define PG8_Q64(v, q) __builtin_bit_cast(long, __builtin_shufflevector(v, v, 2 * (q), 2 * (q) + 1))
#define PG8_M8L1(ai, bj, m, n, q) acc[ai][bj][m][n] = __builtin_amdgcn_mfma_f32_16x16x32_fp8_fp8(PG8_Q64(Bt_[n], q), PG8_Q64(At_[m], q), acc[ai][bj][m][n], 0, 0, 0)
#define PG8_MMA8L(ai, bj, At, Bt) do { auto& At_ = At; auto& Bt_ = Bt; __builtin_amdgcn_s_setprio(1); _Pragma("unroll") for (int m = 0; m < 4; ++m) _Pragma("unroll") for (int n = 0; n < 2; ++n) { \
        PG8_M8L1(ai, bj, m, n, 0); PG8_M8L1(ai, bj, m, n, 1); PG8_M8L1(ai, bj, m, n, 2); PG8_M8L1(ai, bj, m, n, 3); } __builtin_amdgcn_s_setprio(0); } while (0)
#define PG8_MMAG(ai, bj, At, Bt) do { if (mrow & (1 << (ai))) { if constexpr (FP8 == 1) PG8_MMA8(ai, bj, At, Bt); else if constexpr (FP8 == 2) PG8_MMA8L(ai, bj, At, Bt); else PG8_MMA(ai, bj, At, Bt); } } while (0)
#define PG8_WAIT_V(n) asm volatile("s_waitcnt vmcnt(" #n ")" ::: "memory")
#define PG8_WAIT_L(n) asm volatile("s_waitcnt lgkmcnt(" #n ")" ::: "memory")
#define PG8_BAR __builtin_amdgcn_s_barrier()
#define PG8_SCHED __builtin_amdgcn_sched_barrier(0)
    Unit cur, nxt; int ui = 0;
    if (!S.next(0, cur)) return;
    f32x4 acc[2][2][4][2];
#pragma unroll
    for (int a = 0; a < 2; ++a)
#pragma unroll
        for (int b = 0; b < 2; ++b)
#pragma unroll
            for (int m = 0; m < 4; ++m)
#pragma unroll
                for (int n = 0; n < 2; ++n) acc[a][b][m][n] = (f32x4){0.f, 0.f, 0.f, 0.f};
    v8i32 At[4], B0[2], B1[2];
    const char* cA = (const char*)g.A + (size_t)cur.pm * tstep + (size_t)cur.k0 * 2; const char* cB = (const char*)g.Bt + (size_t)cur.pn * tstep + (size_t)cur.k0 * 2;
    S.a_ready(cur);
    PG8_STAGE(PG8_SB(0, 0), cB, voffB); PG8_STAGE(PG8_SA(0, 0), cA, voffA); PG8_STAGE(PG8_SB(0, 1), cB + hstep, voffB); PG8_STAGE(PG8_SA(0, 1), cA + hstep, voffA);
    if (wr == 1) PG8_BAR;
    PG8_WAIT_V(4); PG8_BAR;
    PG8_STAGE(PG8_SB(1, 0), cB + kstep, voffB); PG8_STAGE(PG8_SA(1, 0), cA + kstep, voffA); PG8_STAGE(PG8_SB(1, 1), cB + hstep + kstep, voffB);
    PG8_WAIT_V(6); PG8_BAR;
    PG8_STAMP();
    for (;;) {
        const bool has_next = S.next(ui + 1, nxt);
        const char* nA = has_next ? (const char*)g.A + (size_t)nxt.pm * tstep + (size_t)nxt.k0 * 2 : cA; const char* nB = has_next ? (const char*)g.Bt + (size_t)nxt.pn * tstep + (size_t)nxt.k0 * 2 : cB;
        const int nt = cur.nt, mrow = cur.msk;
        for (int t = 0; t < nt; t += 2) {
            const bool last = (t == nt - 2);
            const char* a1 = cA + (size_t)(t + 1) * kstep;
            const char* a2 = last ? nA : cA + (size_t)(t + 2) * kstep; const char* b2 = last ? nB : cB + (size_t)(t + 2) * kstep;
            const char* a3 = a2 + kstep; const char* b3 = b2 + kstep;
            if (last && has_next) S.a_ready(nxt);
            PG8_LDB(B0, 0, 0); PG8_SCHED; PG8_LDA(At, 0, 0); PG8_STAGE(PG8_SA(1, 1), a1 + hstep, voffA);
            PG8_WAIT_L(8); PG8_BAR; PG8_WAIT_L(0); PG8_MMAG(0, 0, At, B0); PG8_BAR; PG8_SCHED;
            PG8_LDB(B1, 0, 1); PG8_STAGE(PG8_SB(0, 0), b2, voffB);
            PG8_BAR; PG8_WAIT_L(0); PG8_MMAG(0, 1, At, B1); PG8_BAR;
            PG8_LDA(At, 0, 1); PG8_STAGE(PG8_SA(0, 0), a2, voffA);
            PG8_BAR; PG8_WAIT_L(0); PG8_MMAG(1, 0, At, B0); PG8_BAR; PG8_SCHED;
            PG8_STAGE(PG8_SB(0, 1), b2 + hstep, voffB);
            PG8_WAIT_V(6); PG8_BAR; PG8_MMAG(1, 1, At, B1); PG8_BAR;
            PG8_LDB(B0, 1, 0); PG8_SCHED; PG8_LDA(At, 1, 0); PG8_STAGE(PG8_SA(0, 1), a2 + hstep, voffA);
            PG8_WAIT_L(8); PG8_BAR; PG8_WAIT_L(0); PG8_MMAG(0, 0, At, B0); PG8_BAR; PG8_SCHED;
            PG8_LDB(B1, 1, 1); PG8_STAGE(PG8_SB(1, 0), b3, voffB);
            PG8_BAR; PG8_WAIT_L(0); PG8_MMAG(0, 1, At, B1); PG8_BAR;
            PG8_LDA(At, 1, 1); PG8_STAGE(PG8_SA(1, 0), a3, voffA);
            PG8_BAR; PG8_WAIT_L(0); PG8_MMAG(1, 0, At, B0); PG8_BAR; PG8_SCHED;
            PG8_STAGE(PG8_SB(1, 1), b3 + hstep, voffB);
            PG8_WAIT_V(6); PG8_BAR; PG8_MMAG(1, 1, At, B1); PG8_BAR;
        }
        PG8_STAMP();
        if constexpr (!Epi::AFTER_DRAIN) { E(acc, cur, wr, wc, fr, fq); S.done(cur); }
        PG8_STAMP();
        if (!has_next) break;
#pragma unroll
        for (int a = 0; a < 2; ++a)
#pragma unroll
            for (int b = 0; b < 2; ++b)
#pragma unroll
                for (int m = 0; m < 4; ++m)
#pragma unroll
                    for (int n = 0; n < 2; ++n) acc[a][b][m][n] = (f32x4){0.f, 0.f, 0.f, 0.f};
        cur = nxt; cA = nA; cB = nB; ++ui;
    }
    PG8_WAIT_V(0);
    if (wr == 0) PG8_BAR;
    PG8_BAR;
    if constexpr (Epi::AFTER_DRAIN) { E.fused(acc, cur, wr, wc, fr, fq, lds, wid, lane); S.done(cur); }
    PG8_STAMP();
    if (STAMP && wid == 0) { stamps[lane] = lane < nts ? (((unsigned long long)(unsigned)ts_hi << 32) | (unsigned)ts_lo) : 0ull;
        if (lane == 62) stamps[62] = rt_entry; if (lane == 63) stamps[63] = (unsigned long long)wall_clock64(); }
#undef PG8_STAMP
#undef PG8_SA
#undef PG8_SB
#undef PG8_STAGE
#undef PG8_LDA
#undef PG8_LDB
#undef PG8_HALF
#undef PG8_MMA
#undef PG8_MMA8
#undef PG8_MMA8L
#undef PG8_M8L1
#undef PG8_Q64
#undef PG8_MMAG
#undef PG8_WAIT_V
#undef PG8_WAIT_L
#undef PG8_BAR
#undef PG8_SCHED
}
}
#ifndef ATT_INLINE
#define ATT_INLINE __forceinline__
#endif
namespace att {
constexpr int D = 128, NW = 8, QBLK = 32, KVBLK = 64, LDQ = 512, LDO = DM;
constexpr float SCALE = 0.088388347648318440f;
constexpr float THR = 8.f;
constexpr size_t SHM_V = KVBLK * D * 2, SHM_K = KVBLK * D * 2, SHM_Q = 256 * D * 2, SHM_ATTN = 2 * SHM_V + 2 * SHM_K + NW * 64 * 4 + SHM_Q;
using bf16x8 = __attribute__((ext_vector_type(8))) short;
using s16x4  = __attribute__((ext_vector_type(4))) short;
using f32x16 = __attribute__((ext_vector_type(16))) float;
using u32x4  = __attribute__((ext_vector_type(4))) unsigned;
#define KSWZ(row, colB) ((row) * 256 + ((colB) ^ (((row) & 7) << 4)))
#define SBAR() __builtin_amdgcn_sched_barrier(0)
__device__ __forceinline__ int crow(int r, int hi) { return (r & 3) + 8 * (r >> 2) + 4 * hi; }
__device__ __forceinline__ unsigned cvtpk(float lo, float hi) { unsigned r; asm volatile("v_cvt_pk_bf16_f32 %0, %1, %2" : "=v"(r) : "v"(lo), "v"(hi)); return r; }

__device__ __forceinline__ void partialSM(f32x16& p0, f32x16& p1, float& m_reg, float& mn, float& alpha) {
  constexpr float C = SCALE * 1.4426950408889634f;
  float pmax = p0[0]; for (int r = 1; r < 16; ++r) pmax = fmaxf(pmax, p0[r]); for (int r = 0; r < 16; ++r) pmax = fmaxf(pmax, p1[r]);
  { auto rr = __builtin_amdgcn_permlane32_swap(__float_as_uint(pmax), __float_as_uint(pmax), false, false);
    pmax = fmaxf(__uint_as_float(rr[0]), __uint_as_float(rr[1])); }
  if (__builtin_expect(__all(pmax - m_reg <= THR / SCALE), 1)) { mn = m_reg; alpha = 1.f; }
  else { mn = fmaxf(m_reg, pmax); alpha = __builtin_amdgcn_exp2f((m_reg - mn) * C); m_reg = mn; }
  float mnC = -mn * C;
  for (int r = 0; r < 16; ++r) p0[r] = fmaf(p0[r], C, mnC); for (int r = 0; r < 16; ++r) p1[r] = fmaf(p1[r], C, mnC);
  for (int r = 0; r < 16; ++r) p0[r] = __builtin_amdgcn_exp2f(p0[r]);
}
__device__ __forceinline__ void finishSM(f32x16& p0, f32x16& p1, float alpha, float& l_reg, bf16x8& pa0, bf16x8& pa1, bf16x8& pa2, bf16x8& pa3) {
  for (int r = 0; r < 16; ++r) p1[r] = __builtin_amdgcn_exp2f(p1[r]);
  float ps = 0; for (int r = 0; r < 16; ++r) ps += p0[r]; for (int r = 0; r < 16; ++r) ps += p1[r];
  { auto rr = __builtin_amdgcn_permlane32_swap(__float_as_uint(ps), __float_as_uint(ps), false, false);
    ps = __uint_as_float(rr[0]) + __uint_as_float(rr[1]); }
  l_reg = l_reg * alpha + ps;
#define PK4(P, BASE, OUT) do { unsigned a0 = cvtpk(P[BASE + 0], P[BASE + 1]), a1 = cvtpk(P[BASE + 2], P[BASE + 3]);   \
    unsigned b0 = cvtpk(P[BASE + 4], P[BASE + 5]), b1 = cvtpk(P[BASE + 6], P[BASE + 7]);                              \
    auto r0 = __builtin_amdgcn_permlane32_swap(a0, b0, false, false); auto r1 = __builtin_amdgcn_permlane32_swap(a1, b1, false, false); \
    u32x4 w = {r0[0], r1[0], r0[1], r1[1]}; OUT = *reinterpret_cast<bf16x8*>(&w); } while (0)
  PK4(p0, 0, pa0); PK4(p0, 8, pa1); PK4(p1, 0, pa2); PK4(p1, 8, pa3);
#undef PK4
}
__device__ __forceinline__ void qkt(f32x16& p0, f32x16& p1, const bf16_t* Ks, const bf16_t* Qs, int qrow, int r32, int hi) {
  p0 = f32x16{}; p1 = f32x16{};
#pragma unroll
  for (int d0 = 0; d0 < 8; ++d0) { int cb = (d0 * 16 + hi * 8) * 2;
    bf16x8 q = *reinterpret_cast<const bf16x8*>((const char*)Qs + KSWZ(qrow, cb));
    bf16x8 b0 = *reinterpret_cast<const bf16x8*>((const char*)Ks + KSWZ(r32, cb));
    bf16x8 b1 = *reinterpret_cast<const bf16x8*>((const char*)Ks + KSWZ(32 + r32, cb));
    p0 = __builtin_amdgcn_mfma_f32_32x32x16_bf16(b0, q, p0, 0, 0, 0);
    p1 = __builtin_amdgcn_mfma_f32_32x32x16_bf16(b1, q, p1, 0, 0, 0); }
}
__device__ __forceinline__ int v_st(int k, int c) { const int kk = (k & ~0xC) | ((k & 4) << 1) | ((k & 8) >> 1); return ((kk >> 3) * 4 + (c >> 5)) * 512 + ((kk & 7) * 32 + (c & 31)) * 2; }
__device__ __forceinline__ int v_rd_base(int lane) { return ((lane & 3) << 3) | (((lane >> 2) & 3) << 6) | (((lane >> 4) & 1) << 5) | (((lane >> 5) & 1) << 8); }
constexpr int v_rd_off(int d0, int ks, int half) { return d0 * 512 + ks * 4096 + half * 2048; }
template <int OFF> __device__ __forceinline__ s16x4 tr_read(int vb) {
  s16x4 r; asm volatile("ds_read_b64_tr_b16 %0, %1 offset:%2" : "=&v"(r) : "v"(vb), "i"(OFF) : "memory"); return r;
}
template <int D0> __device__ __forceinline__ void pv_one(f32x16& od, int vb, bf16x8 pa0, bf16x8 pa1, bf16x8 pa2, bf16x8 pa3) {
  const s16x4 l0 = tr_read<v_rd_off(D0, 0, 0)>(vb), h0 = tr_read<v_rd_off(D0, 0, 1)>(vb), l1 = tr_read<v_rd_off(D0, 1, 0)>(vb), h1 = tr_read<v_rd_off(D0, 1, 1)>(vb);
  const s16x4 l2 = tr_read<v_rd_off(D0, 2, 0)>(vb), h2 = tr_read<v_rd_off(D0, 2, 1)>(vb), l3 = tr_read<v_rd_off(D0, 3, 0)>(vb), h3 = tr_read<v_rd_off(D0, 3, 1)>(vb);
  asm volatile("s_waitcnt lgkmcnt(0)" ::: "memory"); SBAR();
#define PK(L, H) (bf16x8){L[0], L[1], L[2], L[3], H[0], H[1], H[2], H[3]}
  od = __builtin_amdgcn_mfma_f32_32x32x16_bf16(pa0, PK(l0, h0), od, 0, 0, 0);
  od = __builtin_amdgcn_mfma_f32_32x32x16_bf16(pa1, PK(l1, h1), od, 0, 0, 0);
  od = __builtin_amdgcn_mfma_f32_32x32x16_bf16(pa2, PK(l2, h2), od, 0, 0, 0);
  od = __builtin_amdgcn_mfma_f32_32x32x16_bf16(pa3, PK(l3, h3), od, 0, 0, 0);
#undef PK
}
__device__ __forceinline__ void pv_d0(f32x16* o, int vb, bf16x8 pa0, bf16x8 pa1, bf16x8 pa2, bf16x8 pa3) {
  pv_one<0>(o[0], vb, pa0, pa1, pa2, pa3); pv_one<1>(o[1], vb, pa0, pa1, pa2, pa3); pv_one<2>(o[2], vb, pa0, pa1, pa2, pa3); pv_one<3>(o[3], vb, pa0, pa1, pa2, pa3);
}

struct SrcOne { const bf16_t* k0; const bf16_t* v0; int ldk;
  __device__ __forceinline__ const bf16_t* k(int j) const { return k0 + (size_t)j * 64 * ldk; }
  __device__ __forceinline__ const bf16_t* v(int j) const { return v0 + (size_t)j * 64 * ldk; } };
struct SrcTwo { const bf16_t* ck; const bf16_t* cv; const bf16_t* k1; const bf16_t* v1; int ldk;
  __device__ __forceinline__ const bf16_t* k(int j) const { return j < 4 ? ck + (size_t)j * 64 * ldk : k1 + (size_t)(j - 4) * 64 * ldk; }
  __device__ __forceinline__ const bf16_t* v(int j) const { return j < 4 ? cv + (size_t)j * 64 * ldk : v1 + (size_t)(j - 4) * 64 * ldk; } };
struct NoBias { __device__ __forceinline__ void operator()(f32x16&, f32x16&, int, int, int, int) const {} };
struct NaBias { const float* tab; int i0, kr0;
  __device__ __forceinline__ void operator()(f32x16& p0, f32x16& p1, int jt, int wid, int r32, int hi) const {
    if (jt < 4) return;
    const int qi = i0 + wid * QBLK + r32, r = qi >> 6, qc = qi & 63, kr = kr0 + jt - 4;
    int lo = r - 4; lo = lo < 0 ? 0 : (lo > 8 ? 8 : lo);
    const bool rowok = (kr >= lo) && (kr < lo + 8);
    if (!rowok) {
#pragma unroll
      for (int rr = 0; rr < 16; ++rr) { p0[rr] = -1e30f; p1[rr] = -1e30f; }
      return;
    }
    int c0 = qc - 8; c0 = c0 < 0 ? 0 : (c0 > 48 ? 48 : c0);
    const int dr = kr - r + 7;
    const float* tb = tab + dr * 31 + (4 * hi - qc + 15);
    const int w0 = 4 * hi - c0;
#pragma unroll
    for (int g = 0; g < 4; ++g) {
#pragma unroll
      for (int q = 0; q < 4; ++q) {
        const int rr = 4 * g + q, kc0 = q + 8 * g;
        const float t0 = tb[kc0], t1 = tb[kc0 + 32];
        p0[rr] = ((unsigned)(kc0 + w0) < 16u) ? p0[rr] + t0 : -1e30f;
        p1[rr] = ((unsigned)(kc0 + 32 + w0) < 16u) ? p1[rr] + t1 : -1e30f;
      }
      SBAR();
    }
  } };

template <int SD, class Src, class Bias>
__device__ ATT_INLINE void attn_body(const bf16_t* __restrict__ Qb, const Src src, bf16_t* __restrict__ Ob, const int NT, char* lds, const Bias bias) {
  const int tid = opaque_tid(), wid = tid >> 6, lane = tid & 63, r32 = lane & 31, hi = lane >> 5;
  const int LDK = src.ldk;
  bf16_t* V_lds = (bf16_t*)lds; bf16_t* K_lds = (bf16_t*)(lds + 2 * SHM_V);
  float* ws = (float*)(lds + 2 * SHM_V + 2 * SHM_K) + wid * 64; float* li_l = ws; float* al_l = ws + 32;
  float m_reg = -1e30f, l_reg = 0; f32x16 o[4] = {};
  bf16_t* Q_lds = (bf16_t*)(lds + 2 * SHM_V + 2 * SHM_K + NW * 64 * 4);
  const int qrow = wid * QBLK + r32;
  {
#pragma unroll
    for (int i = 0; i < 8; ++i) { const int f = tid + 512 * i, row = f >> 4, c8 = (f & 15) * 8;
      *(bf16x8*)((char*)Q_lds + KSWZ(row, c8 * 2)) = *reinterpret_cast<const bf16x8*>(Qb + (long)row * LDQ + c8); }
  }
  const int sr = tid >> 4, sc = (tid & 15) * 8, vst0 = v_st(sr, sc), vst1 = v_st(32 + sr, sc);
  const int vb0 = (int)(uintptr_t)V_lds + v_rd_base(lane);
  struct { bf16x8 vs0, vs1, ks0, ks1; } sr_[SD];
#define SLOAD(i, jt) do { const bf16_t* kt_ = src.k(jt); const bf16_t* vt_ = src.v(jt); \
    sr_[i].vs0 = *reinterpret_cast<const bf16x8*>(&vt_[(long)sr * LDK + sc]); sr_[i].vs1 = *reinterpret_cast<const bf16x8*>(&vt_[(long)(32 + sr) * LDK + sc]); \
    sr_[i].ks0 = *reinterpret_cast<const bf16x8*>(&kt_[(long)sr * LDK + sc]); sr_[i].ks1 = *reinterpret_cast<const bf16x8*>(&kt_[(long)(32 + sr) * LDK + sc]); } while (0)
#define SWRITE(b, i) do { *(bf16x8*)((char*)V_lds + (b) * SHM_V + vst0) = sr_[i].vs0;          \
    *(bf16x8*)((char*)V_lds + (b) * SHM_V + vst1) = sr_[i].vs1; int kc = sc * 2;               \
    *(bf16x8*)((char*)K_lds + (b) * SHM_K + KSWZ(sr, kc)) = sr_[i].ks0;                       \
    *(bf16x8*)((char*)K_lds + (b) * SHM_K + KSWZ(32 + sr, kc)) = sr_[i].ks1; } while (0)
#define SWAIT() do { if constexpr (SD == 2) asm volatile("s_waitcnt vmcnt(4)" ::: "memory"); else asm volatile("s_waitcnt vmcnt(0)" ::: "memory"); } while (0)
#define RESC(a) do { if (__any((a) < 1.f)) { if (hi == 0) al_l[r32] = (a); asm volatile("s_waitcnt lgkmcnt(0)" ::: "memory"); \
    for (int d = 0; d < 4; ++d) for (int r = 0; r < 16; ++r) o[d][r] *= al_l[crow(r, hi)]; } } while (0)
  f32x16 pA0, pA1, pB0, pB1; float mnA, mnB, alA, alB; bf16x8 pa0, pa1, pa2, pa3;
  constexpr int SE = 0, SO = SD - 1;
  SLOAD(SE, 0); asm volatile("s_waitcnt vmcnt(0)" ::: "memory"); SWRITE(0, SE); __syncthreads();
  qkt(pA0, pA1, K_lds, Q_lds, qrow, r32, hi); bias(pA0, pA1, 0, wid, r32, hi); partialSM(pA0, pA1, m_reg, mnA, alA);
  SLOAD(SO, 1); if constexpr (SD == 2) { if (2 < NT) SLOAD(SE, 2); }
  SWAIT(); SWRITE(1, SO); __syncthreads();
  for (int j = 1; j + 1 < NT; j += 2) {
    SBAR(); qkt(pB0, pB1, (bf16_t*)((char*)K_lds + SHM_K), Q_lds, qrow, r32, hi); bias(pB0, pB1, j, wid, r32, hi);
    finishSM(pA0, pA1, alA, l_reg, pa0, pa1, pa2, pa3); SBAR();
    SLOAD(SO, j + SD); SBAR();
    pv_d0(o, vb0, pa0, pa1, pa2, pa3); partialSM(pB0, pB1, m_reg, mnB, alB);
    __syncthreads(); SWAIT(); SWRITE(0, SE);
    RESC(alB); __syncthreads();
    SBAR(); qkt(pA0, pA1, K_lds, Q_lds, qrow, r32, hi); bias(pA0, pA1, j + 1, wid, r32, hi);
    finishSM(pB0, pB1, alB, l_reg, pa0, pa1, pa2, pa3); SBAR();
    if (SD == 1 || j + 3 < NT) SLOAD(SE, j + 1 + SD); SBAR();
    pv_d0(o, vb0 + (int)SHM_V, pa0, pa1, pa2, pa3); partialSM(pA0, pA1, m_reg, mnA, alA);
    __syncthreads(); SWAIT(); SWRITE(1, SO);
    RESC(alA); __syncthreads();
  }
  SBAR(); qkt(pB0, pB1, (bf16_t*)((char*)K_lds + SHM_K), Q_lds, qrow, r32, hi); bias(pB0, pB1, NT - 1, wid, r32, hi);
  finishSM(pA0, pA1, alA, l_reg, pa0, pa1, pa2, pa3); SBAR();
  pv_d0(o, vb0, pa0, pa1, pa2, pa3); partialSM(pB0, pB1, m_reg, mnB, alB);
  __syncthreads(); RESC(alB);
  finishSM(pB0, pB1, alB, l_reg, pa0, pa1, pa2, pa3); SBAR();
  pv_d0(o, vb0 + (int)SHM_V, pa0, pa1, pa2, pa3);
  if (hi == 0) li_l[r32] = l_reg; asm volatile("s_waitcnt lgkmcnt(0)" ::: "memory");
  float rli[16];
#pragma unroll
  for (int r = 0; r < 16; ++r) rli[r] = __builtin_amdgcn_rcpf(li_l[crow(r, hi)]);
  bf16_t* Ow = Ob + (long)(wid * QBLK) * LDO;
#pragma unroll
  for (int r = 0; r < 16; ++r) { int orow = crow(r, hi);
    for (int d0 = 0; d0 < 4; ++d0) Ow[(long)orow * LDO + d0 * 32 + r32] = f2bf(o[d0][r] * rli[r]); }
#undef SLOAD
#undef SWRITE
#undef SWAIT
#undef RESC
}
}
#define H16(w, j) ((bf16_t)(((j) & 1) ? ((j) < 2 ? (w).x >> 16 : (w).y >> 16) : ((j) < 2 ? (w).x & 0xFFFFu : (w).y & 0xFFFFu)))
#define DPPU(v, ctrl, rmask) __int_as_float(__builtin_amdgcn_update_dpp(0, __float_as_int(v), (ctrl), (rmask), 0xF, false))
__device__ __forceinline__ float scan32(float x) { x += DPPU(x, 0x111, 0xF); x += DPPU(x, 0x112, 0xF); x += DPPU(x, 0x114, 0xF); x += DPPU(x, 0x118, 0xF); x += DPPU(x, 0x142, 0xA); return x; }
__device__ __forceinline__ float last32(float x, int lane) { const float a = __int_as_float(__builtin_amdgcn_readlane(__float_as_int(x), 31)), b = __int_as_float(__builtin_amdgcn_readlane(__float_as_int(x), 63)); return lane < 32 ? a : b; }
namespace gdn {
using att::bf16x8; using att::f32x16; using att::crow;
constexpr int C = 32, SK = 136, SS = 40;
constexpr int OFF_KT = 0, OFF_QT = OFF_KT + C * SK * 2, OFF_W = OFF_QT + C * SK * 2, OFF_KTT = OFF_W + C * SK * 2, OFF_VTT = OFF_KTT + 128 * SS * 2,
              OFF_VN = OFF_VTT + 128 * SS * 2, OFF_VNS = OFF_VN + 128 * SS * 2, OFF_ST = OFF_VNS + 128 * SS * 2, OFF_TB = OFF_ST + 128 * SK * 2,
              OFF_TBE = OFF_TB + C * SS * 2, OFF_ATT = OFF_TBE + C * SS * 2, OFF_L = OFF_ATT + C * SS * 2, OFF_SC = OFF_L + C * C * 4, GDN_LDS = OFF_SC + 1024;
template <int K>
__device__ __forceinline__ f32x16 mm(const bf16_t* A, int lda, const bf16_t* Bt, int ldb, int l32, int hi, f32x16 acc) {
#pragma unroll
    for (int k0 = 0; k0 < K; k0 += 16) {
        const bf16x8 a = *reinterpret_cast<const bf16x8*>(A + l32 * lda + k0 + 8 * hi);
        const bf16x8 b = *reinterpret_cast<const bf16x8*>(Bt + l32 * ldb + k0 + 8 * hi);
        acc = __builtin_amdgcn_mfma_f32_32x32x16_bf16(a, b, acc, 0, 0, 0);
    }
    return acc;
}
__device__ __forceinline__ uint2 pk4(float a, float b, float c, float d) { uint2 w; w.x = pack2(a, b); w.y = pack2(c, d); return w; }

__device__ __forceinline__ void gdn_chunked(const Params& p, int l, bool ctx, int b, int h, int dir, unsigned char* lds) {
    const int tid = opaque_tid(), wid = tid >> 6, lane = tid & 63, l32 = lane & 31, hi = lane >> 5;
    const int T = ctx ? CT : ::LT; const size_t m0 = ctx ? (size_t)b * CT : (size_t)MC + (size_t)b * ::LT;
    const bf16_t* DQ = WSP(bf16_t, WS_DQ); const bf16_t* DK = WSP(bf16_t, WS_DK); const bf16_t* DV = WSP(bf16_t, WS_DV); const float* DBA = WSP(float, WS_DBA);
    float* O = WSP(float, dir ? WS_DOB : WS_DOF);
    bf16_t* Kt = (bf16_t*)(lds + OFF_KT); bf16_t* Qt = (bf16_t*)(lds + OFF_QT); bf16_t* W = (bf16_t*)(lds + OFF_W); bf16_t* KT = (bf16_t*)(lds + OFF_KTT); bf16_t* VT = (bf16_t*)(lds + OFF_VTT);
    bf16_t* VN = (bf16_t*)(lds + OFF_VN); bf16_t* VNS = (bf16_t*)(lds + OFF_VNS); bf16_t* ST = (bf16_t*)(lds + OFF_ST); bf16_t* TB = (bf16_t*)(lds + OFF_TB); bf16_t* TBE = (bf16_t*)(lds + OFF_TBE);
    bf16_t* ATT = (bf16_t*)(lds + OFF_ATT); float* Lm = (float*)(lds + OFF_L); float* sc = (float*)(lds + OFF_SC);
    const int nch = T / C;
#define TOK(c, s_) (m0 + (dir ? T - 1 - ((c) * C + (s_)) : (c) * C + (s_)))
    f32x16 S[2];
#pragma unroll
    for (int bi = 0; bi < 2; ++bi) {
        const int blk = wid * 2 + bi, d0 = 32 * (blk >> 2), e0 = 32 * (blk & 3);
        if (ctx) { S[bi] = f32x16{}; }
        else {
            const float* s0 = p.in[I_SGDN] + ((((size_t)b * DEPTH + l) * 2 + dir) * 4 + h) * 128 * 128 + e0 + l32;
#pragma unroll
            for (int r = 0; r < 16; ++r) S[bi][r] = s0[(size_t)(d0 + crow(r, hi)) * 128];
        }
    }
    const int ts = tid & 31, c0 = (tid >> 5) * 4, c1 = 64 + c0;
    uint2 rq0, rq1, rk0, rk1, rv0, rv1; float pbeta = 0.f, pg = 0.f;
#define GLOAD(c) do { const size_t mt_ = TOK(c, ts); \
        rq0 = *(const uint2*)(DQ + mt_ * 512 + h * 128 + c0); rq1 = *(const uint2*)(DQ + mt_ * 512 + h * 128 + c1); \
        rk0 = *(const uint2*)(DK + mt_ * 512 + h * 128 + c0); rk1 = *(const uint2*)(DK + mt_ * 512 + h * 128 + c1); \
        rv0 = *(const uint2*)(DV + mt_ * 512 + h * 128 + c0); rv1 = *(const uint2*)(DV + mt_ * 512 + h * 128 + c1); \
        if (tid < C) { const size_t mt = TOK(c, tid); pbeta = DBA[mt * 16 + dir * 4 + h]; pg = DBA[mt * 16 + 8 + dir * 4 + h]; } } while (0)
#define GSTAGE() do { \
        *(uint2*)(Kt + ts * SK + c0) = rk0; *(uint2*)(Kt + ts * SK + c1) = rk1; \
        *(uint2*)(Qt + ts * SK + c0) = rq0; *(uint2*)(Qt + ts * SK + c1) = rq1; \
        _Pragma("unroll") for (int j = 0; j < 4; ++j) { KT[(c0 + j) * SS + ts] = H16(rk0, j); KT[(c1 + j) * SS + ts] = H16(rk1, j); \
                                                        VT[(c0 + j) * SS + ts] = H16(rv0, j); VT[(c1 + j) * SS + ts] = H16(rv1, j); } \
        if (wid == 0) { float x = pg; _Pragma("unroll") for (int o_ = 1; o_ < 32; o_ <<= 1) { const float y = __shfl_up(x, o_); if (lane >= o_) x += y; } \
            const float Bt_ = __shfl(x, 31); if (lane < C) { sc[lane] = pbeta; sc[32 + lane] = x; sc[64 + lane] = __expf(x); sc[96 + lane] = __expf(Bt_ - x); if (lane == 0) sc[128] = __expf(Bt_); } } } while (0)
    __syncthreads();
    GLOAD(0);
#pragma unroll
    for (int bi = 0; bi < 2; ++bi) {
        const int blk = wid * 2 + bi, d0 = 32 * (blk >> 2), e0 = 32 * (blk & 3);
#pragma unroll
        for (int g = 0; g < 4; ++g) *(uint2*)(ST + (e0 + l32) * SK + d0 + 8 * g + 4 * hi) = pk4(S[bi][4 * g], S[bi][4 * g + 1], S[bi][4 * g + 2], S[bi][4 * g + 3]);
    }
    GSTAGE();
    __syncthreads();
    for (int c = 0; c < nch; ++c) {
        if (c + 1 < nch) GLOAD(c + 1);
        f32x16 acc1 = f32x16{};
        if (wid == 0) {
            const f32x16 kk = mm<128>(Kt, SK, Kt, SK, l32, hi, f32x16{});
            const float bi_ = sc[32 + l32], be = sc[l32];
#pragma unroll
            for (int r = 0; r < 16; ++r) { const int j = crow(r, hi); const float v = (l32 > j) ? be * kk[r] * __expf(bi_ - sc[32 + j]) : 0.f;
                Lm[l32 * 32 + ((((r & 3) + 4 * hi) ^ (l32 & 7)) * 4) + (r >> 2)] = v; }
        } else if (wid == 1) {
            const f32x16 kq = mm<128>(Kt, SK, Qt, SK, l32, hi, f32x16{});
            const float bi_ = sc[32 + l32];
            float a[16];
#pragma unroll
            for (int r = 0; r < 16; ++r) { const int j = crow(r, hi); a[r] = (l32 >= j) ? kq[r] * __expf(bi_ - sc[32 + j]) : 0.f; }
#pragma unroll
            for (int g = 0; g < 4; ++g) *(uint2*)(ATT + l32 * SS + 8 * g + 4 * hi) = pk4(a[4 * g], a[4 * g + 1], a[4 * g + 2], a[4 * g + 3]);
        } else if (wid >= 4) {
            acc1 = mm<128>(Qt, SK, ST + (32 * (wid - 4)) * SK, SK, l32, hi, f32x16{});
#pragma unroll
            for (int r = 0; r < 16; ++r) acc1[r] *= sc[64 + crow(r, hi)];
        }
        __syncthreads();
        if (tid < 256) {
            const int cc = tid >> 3, part = tid & 7;
            float Tr[4] = {0.f, 0.f, 0.f, 0.f};
#pragma unroll
            for (int i = 0; i < 32; ++i) {
                const vf4 lv = *(const vf4*)(Lm + i * 32 + ((part ^ (i & 7)) * 4));
                float s = lv.x * Tr[0] + lv.y * Tr[1] + lv.z * Tr[2] + lv.w * Tr[3];
                s = red8(s);
                const float t = (i == cc ? 1.f : 0.f) - s;
                if (part == (i & 7)) Tr[i >> 3] = t;
            }
            const float bc = sc[cc], bec = bc * sc[64 + cc];
#pragma unroll
            for (int jj = 0; jj < 4; ++jj) { TB[(part + 8 * jj) * SS + cc] = f2bf(Tr[jj] * bc); TBE[(part + 8 * jj) * SS + cc] = f2bf(Tr[jj] * bec); }
        }
        __syncthreads();
        if (wid < 4) {
            acc1 = mm<32>(TB, SS, VT + (32 * wid) * SS, SS, l32, hi, f32x16{});
        } else {
            const int d0 = 32 * (wid - 4);
            const f32x16 wt = mm<32>(KT + d0 * SS, SS, TBE, SS, l32, hi, f32x16{});
#pragma unroll
            for (int g = 0; g < 4; ++g) *(uint2*)(W + l32 * SK + d0 + 8 * g + 4 * hi) = pk4(wt[4 * g], wt[4 * g + 1], wt[4 * g + 2], wt[4 * g + 3]);
        }
        __syncthreads();
        if (wid < 4) {
            const int e0 = 32 * wid;
            const f32x16 ws = mm<128>(W, SK, ST + e0 * SK, SK, l32, hi, f32x16{});
            float vn[16], vs[16];
#pragma unroll
            for (int r = 0; r < 16; ++r) { vn[r] = acc1[r] - ws[r]; vs[r] = vn[r] * sc[96 + crow(r, hi)]; }
#pragma unroll
            for (int g = 0; g < 4; ++g) { *(uint2*)(VN + (e0 + l32) * SS + 8 * g + 4 * hi) = pk4(vn[4 * g], vn[4 * g + 1], vn[4 * g + 2], vn[4 * g + 3]);
                                          *(uint2*)(VNS + (e0 + l32) * SS + 8 * g + 4 * hi) = pk4(vs[4 * g], vs[4 * g + 1], vs[4 * g + 2], vs[4 * g + 3]); }
        }
        __syncthreads();
        if (wid >= 4) {
            const int e0 = 32 * (wid - 4);
            acc1 = mm<32>(ATT, SS, VN + e0 * SS, SS, l32, hi, acc1);
#pragma unroll
            for (int r = 0; r < 16; ++r) O[TOK(c, crow(r, hi)) * 512 + h * 128 + e0 + l32] = acc1[r];
        }
        {
            const float eB = sc[128];
#pragma unroll
            for (int bi = 0; bi < 2; ++bi) {
                const int blk = wid * 2 + bi, d0 = 32 * (blk >> 2), e0 = 32 * (blk & 3);
#pragma unroll
                for (int r = 0; r < 16; ++r) S[bi][r] *= eB;
                S[bi] = mm<32>(KT + d0 * SS, SS, VNS + e0 * SS, SS, l32, hi, S[bi]);
            }
        }
        __syncthreads();
#pragma unroll
        for (int bi = 0; bi < 2; ++bi) {
            const int blk = wid * 2 + bi, d0 = 32 * (blk >> 2), e0 = 32 * (blk & 3);
#pragma unroll
            for (int g = 0; g < 4; ++g) *(uint2*)(ST + (e0 + l32) * SK + d0 + 8 * g + 4 * hi) = pk4(S[bi][4 * g], S[bi][4 * g + 1], S[bi][4 * g + 2], S[bi][4 * g + 3]);
        }
        if (c + 1 < nch) GSTAGE();
        __syncthreads();
    }
#undef GLOAD
#undef GSTAGE
#undef TOK
    if (ctx) {
#pragma unroll
        for (int bi = 0; bi < 2; ++bi) {
            const int blk = wid * 2 + bi, d0 = 32 * (blk >> 2), e0 = 32 * (blk & 3);
            float* so = p.out + O_SGDN + ((((size_t)b * DEPTH + l) * 2 + dir) * 4 + h) * 128 * 128 + e0 + l32;
#pragma unroll
            for (int r = 0; r < 16; ++r) so[(size_t)(d0 + crow(r, hi)) * 128] = S[bi][r];
        }
    }
}
}

namespace gla {
using att::bf16x8; using att::f32x16; using att::crow; using gdn::mm; using gdn::pk4;
constexpr int C = 32, SQ = 72, SS = 40;
constexpr int OFF_QE = 0, OFF_KN = OFF_QE + C * SQ * 2, OFF_KET = OFF_KN + C * SQ * 2, OFF_VT = OFF_KET + 64 * SS * 2, OFF_ATT = OFF_VT + 128 * SS * 2, OFF_ST = OFF_ATT + C * SS * 2,
              OFF_LA = OFF_ST + 128 * SQ * 2, OFF_EB = OFF_LA + C * 64 * 4, GLA_LDS = OFF_EB + 256;
__device__ __forceinline__ void gla_chunked(const Params& p, int l, bool ctx, int b, int h, int dir, unsigned char* lds) {
    const int tid = opaque_tid(), wid = tid >> 6, lane = tid & 63, l32 = lane & 31, hi = lane >> 5;
    const int T = ctx ? CT : ::LT; const size_t m0 = ctx ? (size_t)b * CT : (size_t)MC + (size_t)b * ::LT;
    const bf16_t* Z = WSP(bf16_t, WS_Z); const float* LA = WSP(float, dir ? WS_AB : WS_AF);
    float* O = WSP(float, dir ? WS_GOB : WS_GOF);
    bf16_t* Qe = (bf16_t*)(lds + OFF_QE); bf16_t* Kn = (bf16_t*)(lds + OFF_KN); bf16_t* KeT = (bf16_t*)(lds + OFF_KET); bf16_t* VT = (bf16_t*)(lds + OFF_VT);
    bf16_t* ATT = (bf16_t*)(lds + OFF_ATT); bf16_t* ST = (bf16_t*)(lds + OFF_ST); float* eB = (float*)(lds + OFF_EB);
    const int nch = T / C;
#define TOK(c, s_) (m0 + (dir ? T - 1 - ((c) * C + (s_)) : (c) * C + (s_)))
    const int d0 = 32 * (wid >> 2), e0 = 32 * (wid & 3);
    f32x16 S;
    if (ctx) S = f32x16{};
    else {
        const float* s0 = p.in[I_SGLA] + ((((size_t)b * DEPTH + l) * 2 + dir) * 4 + h) * 64 * 128 + e0 + l32;
#pragma unroll
        for (int r = 0; r < 16; ++r) S[r] = s0[(size_t)(d0 + crow(r, hi)) * 128];
    }
    const int ts = tid & 31, dc = (tid >> 5) * 4, vc0 = dc, vc1 = 64 + dc;
    uint2 rq, rk, rv0, rv1; vf4 pl;
#define GLOAD(c) do { const size_t mt = TOK(c, ts); \
        rq = *(const uint2*)(Z + mt * NINP + Z_GLQ + h * 64 + dc); rk = *(const uint2*)(Z + mt * NINP + Z_GLK + h * 64 + dc); pl = *(const vf4*)(LA + mt * 256 + h * 64 + dc); \
        rv0 = *(const uint2*)(Z + mt * NINP + Z_GLV + h * 128 + vc0); rv1 = *(const uint2*)(Z + mt * NINP + Z_GLV + h * 128 + vc1); } while (0)
#define WRITE_ST() do { _Pragma("unroll") for (int g = 0; g < 4; ++g) *(uint2*)(ST + (e0 + l32) * SQ + d0 + 8 * g + 4 * hi) = pk4(S[4 * g], S[4 * g + 1], S[4 * g + 2], S[4 * g + 3]); } while (0)
#define GIMAGES() do { vf4 pre, tot; const vf4 pq = unp4bf(rq), pk = unp4bf(rk); \
        _Pragma("unroll") for (int j = 0; j < 4; ++j) { pre[j] = scan32(pl[j]); tot[j] = last32(pre[j], lane); } \
        float qe[4], kn[4]; \
        _Pragma("unroll") for (int j = 0; j < 4; ++j) { qe[j] = pq[j] * 0.125f * __expf(pre[j]); kn[j] = pk[j] * __expf(fminf(-pre[j], 80.f)); \
            KeT[(dc + j) * SS + ts] = f2bf(pk[j] * __expf(tot[j] - pre[j])); } \
        *(uint2*)(Qe + ts * SQ + dc) = pk4(qe[0], qe[1], qe[2], qe[3]); *(uint2*)(Kn + ts * SQ + dc) = pk4(kn[0], kn[1], kn[2], kn[3]); \
        if (ts == 0) { _Pragma("unroll") for (int j = 0; j < 4; ++j) eB[dc + j] = __expf(tot[j]); } \
        _Pragma("unroll") for (int j = 0; j < 4; ++j) { VT[(vc0 + j) * SS + ts] = H16(rv0, j); VT[(vc1 + j) * SS + ts] = H16(rv1, j); } } while (0)
    __syncthreads();
    GLOAD(0);
    WRITE_ST();
    GIMAGES();
    __syncthreads();
    for (int c = 0; c < nch; ++c) {
        if (c + 1 < nch) GLOAD(c + 1);
        f32x16 o1 = f32x16{};
        if (wid == 0) {
            const f32x16 kq = mm<64>(Kn, SQ, Qe, SQ, l32, hi, f32x16{});
            float a[16];
#pragma unroll
            for (int r = 0; r < 16; ++r) a[r] = (l32 >= crow(r, hi)) ? kq[r] : 0.f;
#pragma unroll
            for (int g = 0; g < 4; ++g) *(uint2*)(ATT + l32 * SS + 8 * g + 4 * hi) = pk4(a[4 * g], a[4 * g + 1], a[4 * g + 2], a[4 * g + 3]);
        } else if (wid >= 4) {
            o1 = mm<64>(Qe, SQ, ST + (32 * (wid - 4)) * SQ, SQ, l32, hi, f32x16{});
        }
        __syncthreads();
        if (wid >= 4) {
            const int eo = 32 * (wid - 4);
            o1 = mm<32>(ATT, SS, VT + eo * SS, SS, l32, hi, o1);
#pragma unroll
            for (int r = 0; r < 16; ++r) O[TOK(c, crow(r, hi)) * 512 + h * 128 + eo + l32] = o1[r];
        }
#pragma unroll
        for (int r = 0; r < 16; ++r) S[r] *= eB[d0 + crow(r, hi)];
        S = mm<32>(KeT + d0 * SS, SS, VT + e0 * SS, SS, l32, hi, S);
        __syncthreads();
        WRITE_ST();
        if (c + 1 < nch) GIMAGES();
#ifdef GLA_DUP_IMAGES
        __syncthreads(); if (c + 1 < nch) GIMAGES();
#endif
        __syncthreads();
    }
#undef GLOAD
#undef WRITE_ST
#undef GIMAGES
#undef TOK
    if (ctx) {
        float* so = p.out + O_SGLA + ((((size_t)b * DEPTH + l) * 2 + dir) * 4 + h) * 64 * 128 + e0 + l32;
#pragma unroll
        for (int r = 0; r < 16; ++r) so[(size_t)(d0 + crow(r, hi)) * 128] = S[r];
    }
}
}
#define LAS __attribute__((address_space(3)))
constexpr int LDS_BYTES = 147456, XBW_OFF = LDS_BYTES - 64;
constexpr int NPH = 1 + DEPTH * 12;
#ifndef DBG_NLAYERS
#define DBG_NLAYERS DEPTH
#endif

#ifndef DUPKIND
#define DUPKIND 0
#endif
#ifndef MIXMASK
#define MIXMASK 0xFF
#endif
#define FOR_ITEMS(it, n, o, w) for (int bo_ = (o) * (int)gridDim.x / 256, bw_ = ((w) * (int)gridDim.x / 256) > 0 ? ((w) * (int)gridDim.x / 256) : 1, \
                                    it = ((int)blockIdx.x >= bo_ && (int)blockIdx.x < bo_ + bw_) ? (int)blockIdx.x - bo_ : (n); it < (n); it += bw_)

constexpr int TF0 = NT_L / 10, TF1 = NT_L / 4, TF2 = NT_L * 53 / 100, TF3 = NT_L * 88 / 100, MIXCONV_CH = 16, NI_CONV = (TF3 - TF2 + MIXCONV_CH - 1) / MIXCONV_CH;
#ifndef SPLITK
#define SPLITK 0
#endif
#ifndef SPLITK_G4
#define SPLITK_G4 0
#endif
constexpr int FLAG_WORD0 = 8192;
constexpr int QCTR_WORD0 = 1024;
constexpr int NI_GDNL = LB * 8, NI_GLAL = LB * 8, NI_GDNC = CB * 8, NI_GQAL = LB * 16, NI_NAL = LB * 16, NI_GLAC = CB * 8, NI_NAC = CB * 4, NI_GQAC = CB * 4;
#define KM(k) (1 + ((DUPKIND >> (k)) & 1))
constexpr int Q0 = NI_GDNL * KM(0), Q1 = Q0 + NI_GQAL * KM(1), Q2 = Q1 + NI_NAL * KM(2), Q3 = Q2 + NI_GLAL * KM(3), Q4 = Q3 + NI_GDNC * KM(4), Q5 = Q4 + NI_NAC * KM(5), Q6 = Q5 + NI_GQAC * KM(6), Q7 = Q6 + NI_GLAC * KM(7);
__device__ __forceinline__ void phase_mix(const Params& p, int l, unsigned char* lds, int rep) {
    const int tid = opaque_tid();
    float* smem = (float*)lds;
    const bf16_t* NAQ = WSP(bf16_t, WS_NAQ); const bf16_t* NAK = WSP(bf16_t, WS_NAK); const bf16_t* NAV = WSP(bf16_t, WS_NAV);
    const bf16_t* GQ = WSP(bf16_t, WS_GQ); const bf16_t* GK = WSP(bf16_t, WS_GK); const bf16_t* GV = WSP(bf16_t, WS_GV);
    bf16_t* MRG = WSP(bf16_t, WS_MRG);
    unsigned* qctr = WSP(unsigned, WS_CTL) + QCTR_WORD0 + 64 * l + 16 * rep;
    volatile int* qslot = (volatile int*)(lds + XBW_OFF + 16);
    for (;;) {
        __syncthreads();
        if (tid == 0) *qslot = (int)__hip_atomic_fetch_add(qctr, 1u, __ATOMIC_RELAXED, __HIP_MEMORY_SCOPE_AGENT);
        __syncthreads();
        const int q = __builtin_amdgcn_readfirstlane(*qslot);
        if (q >= Q7 + ((CONV_FILLER && l + 1 < DBG_NLAYERS) ? NI_CONV : 0)) break;
        if (q < Q0) { const int it = q % NI_GDNL; gdn::gdn_chunked(p, l, false, it / 8, (it / 2) % 4, it % 2, lds); }
        else if (q < Q1) {
            const int it = (q - Q0) % NI_GQAL, b = it / 16, qh = (it / 4) % 4, qb = it % 4, kvh = qh >> 1;
            const size_t r0 = (size_t)MC + (size_t)b * LT;
            att::SrcTwo src{WSP(bf16_t, WS_CGK) + ((size_t)b * DEPTH + l) * 256 * 256 + kvh * 128, WSP(bf16_t, WS_CGV) + ((size_t)b * DEPTH + l) * 256 * 256 + kvh * 128,
                            GK + r0 * 256 + kvh * 128, GV + r0 * 256 + kvh * 128, 256};
            att::attn_body<2>(GQ + (r0 + qb * 256) * 512 + qh * 128, src, MRG + (r0 + qb * 256) * DM + 1024 + qh * 128, 4 + LT / 64, (char*)lds, att::NoBias{});
        }
        else if (q < Q2) {
            const int it = (q - Q1) % NI_NAL, b = it / 16, h = (it / 4) % 4, qb = it % 4;
            const int kr0 = qb == 0 ? 0 : qb == 1 ? 0 : qb == 2 ? 4 : 8, nrows = (qb == 0 || qb == 3) ? 8 : 12;
            const size_t r0 = (size_t)MC + (size_t)b * LT;
            float* tab = (float*)(lds + att::SHM_ATTN);
            if (tid < 15 * 31) tab[tid] = p.in[I_RPB][((size_t)l * 4 + h) * 15 * 31 + tid] * (1.0f / att::SCALE);
            att::SrcTwo src{WSP(bf16_t, WS_CNAK) + ((size_t)b * DEPTH + l) * 256 * 512 + h * 128, WSP(bf16_t, WS_CNAV) + ((size_t)b * DEPTH + l) * 256 * 512 + h * 128,
                            NAK + (r0 + kr0 * 64) * 512 + h * 128, NAV + (r0 + kr0 * 64) * 512 + h * 128, 512};
            att::attn_body<1>(NAQ + (r0 + qb * 256) * 512 + h * 128, src, MRG + (r0 + qb * 256) * DM + 0 + h * 128, 4 + nrows, (char*)lds, att::NaBias{tab, qb * 256, kr0});
        }
        else if (q < Q3) { const int it = (q - Q2) % NI_GLAL;
#ifdef GLA_REP
            for (int r_ = 0, n_ = opaque_int(GLA_REP); r_ < n_; ++r_)
#endif
            gla::gla_chunked(p, l, false, it / 8, (it / 2) % 4, it % 2, lds); }
        else if (q < Q4) { const int it = (q - Q3) % NI_GDNC; gdn::gdn_chunked(p, l, true, it / 8, (it / 2) % 4, it % 2, lds); }
        else if (q < Q5) {
            const int it = (q - Q4) % NI_NAC, b = it / 4, h = it % 4; const size_t r0 = (size_t)b * CT;
            att::SrcOne src{NAK + r0 * 512 + h * 128, NAV + r0 * 512 + h * 128, 512};
            att::attn_body<2>(NAQ + r0 * 512 + h * 128, src, MRG + r0 * DM + 0 + h * 128, CT / 64, (char*)lds, att::NoBias{});
        }
        else if (q < Q6) {
            const int it = (q - Q5) % NI_GQAC, b = it / 4, qh = it % 4, kvh = qh >> 1; const size_t r0 = (size_t)b * CT;
            att::SrcOne src{GK + r0 * 256 + kvh * 128, GV + r0 * 256 + kvh * 128, 256};
            att::attn_body<2>(GQ + r0 * 512 + qh * 128, src, MRG + r0 * DM + 1024 + qh * 128, CT / 64, (char*)lds, att::NoBias{});
        }
        else if (q < Q7) { const int it = (q - Q6) % NI_GLAC; gla::gla_chunked(p, l, true, it / 8, (it / 2) % 4, it % 2, lds); }
        else { const int t0 = TF2 + (q - Q7) * MIXCONV_CH, t1 = t0 + MIXCONV_CH < TF3 ? t0 + MIXCONV_CH : TF3; conv_layer_tiles(p, l + 1, t0, t1, 0, 1, (float*)lds); }
    }
}

#define CONV_FILL(nunits, t0, t1, skip) do { if (l + 1 < DBG_NLAYERS) { const int G_ = (int)gridDim.x; int f0_ = ((nunits) % G_) + (skip); if (f0_ >= G_) f0_ = 0; \
        if ((int)blockIdx.x >= f0_) { const Params q = opaque_params(p); conv_layer_tiles(q, l + 1, (t0), (t1), (int)blockIdx.x - f0_, G_ - f0_, (float*)lds); } } } while (0)
#define G1A_MSPLIT (G1A_MODE == 1 ? 2 : 0)
#define G1B_MSPLIT (G1B_MODE == 1 ? 2 : 0)
#ifndef MSPLIT
#define MSPLIT 2
#endif
static_assert(att::SHM_ATTN + 15 * 31 * 4 + 2048 <= (size_t)XBW_OFF, "LDS map");
static_assert((QCTR_WORD0 + 64 * DEPTH) < 4096, "ctl");
constexpr int BAR_WORD0 = 4096;
static_assert((BAR_WORD0 + XCD_BAR_WORDS) * 4 <= (int)CTL_BYTES, "ctl");

__global__ void __launch_bounds__(512, 2) fwd(Params p) {
    extern __shared__ __attribute__((aligned(16))) unsigned char lds[];
    const int tid = threadIdx.x;
    volatile LAS unsigned* xbw = (volatile LAS unsigned*)((LAS unsigned char*)lds + XBW_OFF);
    if (tid < 4) xbw[tid] = 0u;
    __syncthreads();
    XcdBarrier bar; bar.bar = WSP(unsigned, WS_CTL) + BAR_WORD0; bar.x = 0; bar.st = xbw;
    if (p.ph_hi - p.ph_lo > 1) bar = xcd_barrier_post(WSP(unsigned, WS_CTL) + BAR_WORD0, xbw);
#ifndef PHMASK
#define PHMASK 0x1FFF
#endif
#define IN(k) (p.ph_lo <= (k) && (k) < p.ph_hi)
#define INL(j) (((PHMASK >> ((j) + 1)) & 1) && IN(pb + (j)))
#ifndef DUPMASK
#define DUPMASK 0
#endif
#define DUP(j) ((DUPMASK >> ((j) + 1)) & 1)
#if DUPMASK
#define REPS(j) opaque_int(1 + DUP(j))
#else
#define REPS(j) 1
#endif
#ifndef DBLBAR
#define DBLBAR 0
#endif
#ifdef DIAG_KIND
#ifndef DIAG_SCALE
#define DIAG_SCALE 0.01f
#endif
    unsigned long long dg_sum = 0ull, dg_prev = wall_clock64();
#define DIAG_AT(k) do { const unsigned long long now_ = wall_clock64(); if ((DIAG_KIND >> (((k) == 0) ? 12 : (((k) - 1) % 12))) & 1) dg_sum += now_ - dg_prev; dg_prev = now_; } while (0)
#else
#define DIAG_AT(k) do { } while (0)
#endif
#define SEAM(k) do { if (IN(k) && IN((k) + 1)) { xcd_barrier(bar); if (DBLBAR) xcd_barrier(bar); } DIAG_AT(k); } while (0)
    LAS unsigned char* ldsl = (LAS unsigned char*)lds;
    bf16_t* H = WSP(bf16_t, WS_H); bf16_t* ACT = WSP(bf16_t, WS_ACT); float* X = WSP(float, WS_X); float* Z = WSP(float, WS_Z); bf16_t* MRG = WSP(bf16_t, WS_MRG);

    if ((PHMASK & 1) && IN(0)) { const int reps_ = (DUPMASK & 1) ? opaque_int(2) : 1; for (int rep_ = 0; rep_ < reps_; ++rep_) { const Params q = opaque_params(p); phase_prologue(q, (float*)lds); __syncthreads(); } }
    SEAM(0);
    for (int l = 0; l < DBG_NLAYERS; ++l) {
        const int pb = 1 + l * 12;
        const float* modl = WSP(float, WS_MODV) + (size_t)l * NCOND * NMOD;
        if (INL(0)) { const int reps_ = REPS(0); for (int rep_ = 0; rep_ < reps_; ++rep_) { const Params q = opaque_params(p); phase_norm(q, l, 0, lds); __syncthreads(); } }
        SEAM(pb + 0);
        if (INL(1)) {
            if (g1_fp8(l, 0)) {
                pg8::Gemm g{H, (const bf16_t*)(WSP(unsigned char, WS_WGU) + ((size_t)l * 2 + 0) * NGU * DM * 2), M, NGU, DM / 2}; pg8::StaticOrder S; S.init(M, NGU, DM / 2, (int)gridDim.x, (int)blockIdx.x, 2);
                pg8::EpiSwiGLU8 E{WSP(unsigned char, WS_ACT), FFP, 1.0f / WGU_SCALE};
                for (int r_ = 0, n_ = REPS(1); r_ < n_; ++r_) pg8::gemm_phase<pg8::EpiSwiGLU8, pg8::StaticOrder, false, 1>(ldsl, g, S, E, nullptr);
            } else {
                pg8::Gemm g{H, WSP(bf16_t, WS_WGU) + ((size_t)l * 2 + 0) * NGU * DM, M, NGU, DM}; pg8::StaticOrder S; S.init(M, NGU, DM, (int)gridDim.x, (int)blockIdx.x, 0);
                pg8::EpiSwiGLU8 E{WSP(unsigned char, WS_ACT), FFP, 1.0f};
                for (int r_ = 0, n_ = REPS(1); r_ < n_; ++r_) pg8::gemm_phase<pg8::EpiSwiGLU8, pg8::StaticOrder, false, 0>(ldsl, g, S, E, nullptr);
            }
#if CONV_FILLER
            if (l + 1 < DBG_NLAYERS) {
                const int nw_ = (M / 256) * (NGU / 256), G_ = (int)gridDim.x; int f0_ = nw_ % G_; if (nw_ < G_) f0_ = 0;
                if (g1_fp8(l, 0)) f0_ = 2 * f0_ < G_ ? 2 * f0_ : f0_;
                if ((int)blockIdx.x >= f0_) { const Params q = opaque_params(p); mod_layer(q, l + 1, (int)blockIdx.x - f0_, G_ - f0_, (float*)lds); }
            }
            CONV_FILL((M / 256) * (NGU / 256), 0, TF0, (g1_fp8(l, 0) ? ((M / 256) * (NGU / 256)) % (int)gridDim.x : 0));
#endif
        }
        SEAM(pb + 1);
        if (INL(2)) {
            pg8::Gemm g{ACT, G2_FP8 ? (const bf16_t*)(WSP(unsigned char, WS_WDN) + ((size_t)l * 2 + 0) * DM * FFP) : WSP(bf16_t, WS_WDN) + ((size_t)l * 2 + 0) * DM * FF, M, DM, G2_FP8 ? FFP / 2 : FF}; pg8::StaticOrder S; S.init(M, DM, G2_FP8 ? FFP / 2 : FF, (int)gridDim.x, (int)blockIdx.x, SPLITK ? 1 : MSPLIT);
            pg8::EpiResid E{l == 0 ? p.in[I_XP] : X, X, DM, modl + 2 * DM, G2_FP8 ? 0.5f / WDN_SCALE : 0.5f, Z, WSP(unsigned, WS_CTL) + FLAG_WORD0, 8u * (unsigned)(l * (2 * SPLITK + SPLITK_G4) + SPLITK), l == 0 ? p.in[I_XS] : X, l == 0 ? MC : 0x7FFFFFFF, (XBF16 && l != 0), XBF16};
            pg8::gemm_phase<pg8::EpiResid, pg8::StaticOrder, false, (G2_FP8 ? 1 : 0)>(ldsl, g, S, E, nullptr);
#if DUPMASK
            if (opaque_int(DUP(2))) { pg8::EpiResid E2{l == 0 ? p.in[I_XP] : X, Z, DM, modl + 2 * DM, G2_FP8 ? 0.5f / WDN_SCALE : 0.5f, Z, WSP(unsigned, WS_CTL) + FLAG_WORD0, 0u, l == 0 ? p.in[I_XS] : X, l == 0 ? MC : 0x7FFFFFFF, 0, 0}; pg8::gemm_phase<pg8::EpiResid, pg8::StaticOrder, false, (G2_FP8 ? 1 : 0)>(ldsl, g, S, E2, nullptr); }
#endif
        }
        SEAM(pb + 2);
        if (INL(3)) { const int reps_ = REPS(3); for (int rep_ = 0; rep_ < reps_; ++rep_) { const Params q = opaque_params(p); phase_norm(q, l, 1, lds); __syncthreads(); } }
        SEAM(pb + 3);
        if (INL(4)) {
            pg8::Gemm g{H, WSP(bf16_t, WS_WIN) + (size_t)l * NINP * DM, M, NINP, DM}; pg8::StaticOrder S; S.init(M, NINP, DM, (int)gridDim.x, (int)blockIdx.x);
            pg8::EpiBf16Plain E{WSP(bf16_t, WS_Z), NINP};
            for (int r_ = 0, n_ = REPS(4); r_ < n_; ++r_) pg8::gemm_phase<pg8::EpiBf16Plain, pg8::StaticOrder, false>(ldsl, g, S, E, nullptr);
#if CONV_FILLER
            CONV_FILL((M / 256) * (NINP / 256), TF0, TF1, 0);
#endif
        }
        SEAM(pb + 4);
        if (INL(5)) { const int reps_ = REPS(5); for (int rep_ = 0; rep_ < reps_; ++rep_) { const Params q = opaque_params(p); phase_prep(q, l, lds); __syncthreads(); } }
        SEAM(pb + 5);
        if (INL(6)) { const int reps_ = REPS(6); for (int rep_ = 0; rep_ < reps_; ++rep_) { const Params q = opaque_params(p); phase_mix(q, l, lds, rep_); __syncthreads(); } }
        SEAM(pb + 6);
        if (INL(7)) { const int reps_ = REPS(7); for (int rep_ = 0; rep_ < reps_; ++rep_) { const Params q = opaque_params(p); phase_post(q, l); __syncthreads(); } }
        SEAM(pb + 7);
        if (INL(8)) {
            pg8::Gemm g{MRG, WSP(bf16_t, WS_WOUT) + (size_t)l * DM * DM, M, DM, DM}; pg8::StaticOrder S; S.init(M, DM, DM, (int)gridDim.x, (int)blockIdx.x, SPLITK_G4);
            pg8::EpiResid E{X, X, DM, modl + 5 * DM, 1.0f, Z, WSP(unsigned, WS_CTL) + FLAG_WORD0, 8u * (unsigned)(l * (2 * SPLITK + SPLITK_G4) + SPLITK + SPLITK_G4), X, 0x7FFFFFFF, XBF16, XBF16};
            pg8::gemm_phase<pg8::EpiResid, pg8::StaticOrder, false>(ldsl, g, S, E, nullptr);
#if CONV_FILLER
            CONV_FILL((M / 256) * (DM / 256), TF1, TF2, 0);
#endif
#if DUPMASK
            if (opaque_int(DUP(8))) { pg8::EpiResid E2{X, Z, DM, modl + 5 * DM, 1.0f, Z, WSP(unsigned, WS_CTL) + FLAG_WORD0, 0u, X, 0x7FFFFFFF, 0, 0}; pg8::gemm_phase<pg8::EpiResid, pg8::StaticOrder, false>(ldsl, g, S, E2, nullptr); }
#endif
        }
        SEAM(pb + 8);
        if (INL(9)) { const int reps_ = REPS(9); for (int rep_ = 0; rep_ < reps_; ++rep_) { const Params q = opaque_params(p); phase_norm(q, l, 2, lds); __syncthreads(); } }
        SEAM(pb + 9);
        if (INL(10)) {
            {
#if G1B_MODE
                pg8::Gemm g{H, (const bf16_t*)(WSP(unsigned char, WS_WGU) + ((size_t)l * 2 + 1) * NGU * DM * 2), M, NGU, DM / 2}; pg8::StaticOrder S; S.init(M, NGU, DM / 2, (int)gridDim.x, (int)blockIdx.x, G1B_MSPLIT);
                constexpr float ws_ = 1.0f / WGU_SCALE;
#else
                pg8::Gemm g{H, WSP(bf16_t, WS_WGU) + ((size_t)l * 2 + 1) * NGU * DM, M, NGU, DM}; pg8::StaticOrder S; S.init(M, NGU, DM, (int)gridDim.x, (int)blockIdx.x, G1B_MSPLIT);
                constexpr float ws_ = 1.0f;
#endif
#if G2_FP8
                pg8::EpiSwiGLU8 E{WSP(unsigned char, WS_ACT), FFP, ws_};
                for (int r_ = 0, n_ = REPS(10); r_ < n_; ++r_) pg8::gemm_phase<pg8::EpiSwiGLU8, pg8::StaticOrder, false, G1B_MODE>(ldsl, g, S, E, nullptr);
#else
                pg8::EpiSwiGLU E{ACT, FF};
                pg8::gemm_phase<pg8::EpiSwiGLU, pg8::StaticOrder, false, G1B_MODE>(ldsl, g, S, E, nullptr);
#endif
            }
#if CONV_FILLER
            CONV_FILL((M / 256) * (NGU / 256), TF3, NT_L, (G1B_MSPLIT ? ((M / 256) * (NGU / 256)) % (int)gridDim.x : 0));
#endif
        }
        SEAM(pb + 10);
        if (INL(11)) {
            pg8::Gemm g{ACT, G2_FP8 ? (const bf16_t*)(WSP(unsigned char, WS_WDN) + ((size_t)l * 2 + 1) * DM * FFP) : WSP(bf16_t, WS_WDN) + ((size_t)l * 2 + 1) * DM * FF, M, DM, G2_FP8 ? FFP / 2 : FF}; pg8::StaticOrder S; S.init(M, DM, G2_FP8 ? FFP / 2 : FF, (int)gridDim.x, (int)blockIdx.x, SPLITK ? 1 : MSPLIT);
            pg8::EpiResid E{X, (l == DEPTH - 1) ? p.out : X, DM, modl + 8 * DM, G2_FP8 ? 0.5f / WDN_SCALE : 0.5f, Z, WSP(unsigned, WS_CTL) + FLAG_WORD0, 8u * (unsigned)(l * (2 * SPLITK + SPLITK_G4) + 2 * SPLITK + SPLITK_G4), X, 0x7FFFFFFF, XBF16, (XBF16 && l != DEPTH - 1)};
            pg8::gemm_phase<pg8::EpiResid, pg8::StaticOrder, false, (G2_FP8 ? 1 : 0)>(ldsl, g, S, E, nullptr);
        }
        SEAM(pb + 11);
    }
#ifdef DIAG_KIND
    xcd_barrier(bar);
    if (blockIdx.x == 0 && threadIdx.x == 0) p.out[0] += (float)dg_sum * 0.01f * DIAG_SCALE;
#endif
#undef IN
#undef SEAM
}

#ifndef MULTI_LAUNCH
#define MULTI_LAUNCH 0
#endif
extern "C" void kernel_launch(void* const* d_in, const int* in_sizes, int n_in, void* d_out, int out_size, void* d_ws, size_t ws_size, hipStream_t stream) {
    static int grid = 0;
    if (grid == 0) {
        if (n_in != N_IN || (size_t)out_size != O_END || ws_size < WS_END) { fprintf(stderr, "kernel_launch: shape mismatch n_in %d out %d ws %zu (need %zu)\n", n_in, out_size, ws_size, (size_t)WS_END); grid = -1; return; }
        int dev = 0, cus = 0, per_cu = 0;
        if (hipGetDevice(&dev) != hipSuccess || hipDeviceGetAttribute(&cus, hipDeviceAttributeMultiprocessorCount, dev) != hipSuccess) { grid = -1; return; }
        if (hipFuncSetAttribute((const void*)fwd, hipFuncAttributeMaxDynamicSharedMemorySize, LDS_BYTES) != hipSuccess) { fprintf(stderr, "kernel_launch: hipFuncSetAttribute failed\n"); grid = -1; return; }
        if (hipOccupancyMaxActiveBlocksPerMultiprocessor(&per_cu, (const void*)fwd, 512, LDS_BYTES) != hipSuccess || per_cu < 1) { fprintf(stderr, "kernel_launch: occupancy query says %d\n", per_cu); (void)hipGetLastError(); }
        grid = cus;
    }
    if (grid < 0) return;
    (void)hipMemsetAsync((char*)d_ws + WS_CTL, 0, CTL_BYTES, stream);
    Params p{};
    for (int i = 0; i < N_IN; ++i) p.in[i] = (const float*)d_in[i];
    p.out = (float*)d_out; p.ws = (unsigned char*)d_ws;
#if MULTI_LAUNCH
    for (int ph = 0; ph < 1 + DBG_NLAYERS * 12; ++ph) { p.ph_lo = ph; p.ph_hi = ph + 1; hipLaunchKernelGGL(fwd, dim3(grid), dim3(512), LDS_BYTES, stream, p); }
#else
    p.ph_lo = 0; p.ph_hi = NPH; hipLaunchKernelGGL(fwd, dim3(grid), dim3(512), LDS_BYTES, stream, p);
#endif
    const hipError_t le = hipPeekAtLastError();
    if (le != hipSuccess) fprintf(stderr, "kernel_launch: launch failed: %s\n", hipGetErrorName(le));
}
```

```cpp
#define G1A_LAYERS 0xF
#include <hip/hip_runtime.h>
#include <cstdio>
#include <cstdint>

#ifndef CB_
#define CB_ 16
#endif
#ifndef LB_
#define LB_ 8
#endif
#ifndef DEPTH_
#define DEPTH_ 4
#endif
#ifndef G1A_LAYERS
#define G1A_LAYERS 0xC
#endif
#ifndef G1A_MODE
#define G1A_MODE 0
#endif
#ifndef G1B_MODE
#define G1B_MODE 1
#endif
#ifndef XBF16
#define XBF16 0
#endif
#ifndef G2_FP8
#define G2_FP8 1
#endif
#ifndef FFN_FP8
#define FFN_FP8 (G1A_MODE != 0 || G1B_MODE != 0 || G2_FP8 != 0)
#endif
constexpr int DM = 2048, DEPTH = DEPTH_, CB = CB_, CT = 256, LB = LB_, LT = 1024;
constexpr int MC = CB * CT, ML = LB * LT, M = MC + ML;
constexpr int FF = 5504, NGU = 2 * FF, NIN = 6192, NINP = 6400, NMOD = 9 * DM, NCOND = 1 + LB;
constexpr float EPS = 1e-6f;
constexpr int FFP = 5632;
constexpr float WGU_SCALE = 32.0f, WDN_SCALE = 64.0f;
constexpr int Z_NAQ = 0, Z_NAK = 512, Z_NAV = 1024, Z_GLQ = 1536, Z_GLK = 1792, Z_GLV = 2048, Z_GLR = 2560, Z_GF = 3072, Z_GB = 3088,
              Z_GQQ = 3104, Z_GQK = 3616, Z_GQV = 3872, Z_DQKV = 4128, Z_DZ = 5664, Z_DB = 6176, Z_DA = 6184;
static_assert(Z_DA + 8 == NIN, "split");
enum { I_XP = 0, I_XS, I_CNAK, I_CNAV, I_CGK, I_CGV, I_SGLA, I_SGDN, I_C, I_CCTX, I_NORMG, I_WMOD, I_BMOD, I_GU, I_DOWN, I_WIN, I_WOUT, I_NAQKN, I_RPB,
       I_GUP, I_GBIAS, I_GLAON, I_GQAQKN, I_CONV, I_ALOG, I_DTB, I_GDNON, N_IN };
constexpr size_t O_YP = 0, O_YS = O_YP + (size_t)MC * DM, O_NAK = O_YS + (size_t)ML * DM, O_NAV = O_NAK + (size_t)CB * DEPTH * 4 * CT * 128,
                 O_GK = O_NAV + (size_t)CB * DEPTH * 4 * CT * 128, O_GV = O_GK + (size_t)CB * DEPTH * 2 * CT * 128,
                 O_SGLA = O_GV + (size_t)CB * DEPTH * 2 * CT * 128, O_SGDN = O_SGLA + (size_t)CB * DEPTH * 2 * 4 * 64 * 128,
                 O_END = O_SGDN + (size_t)CB * DEPTH * 2 * 4 * 128 * 128;
constexpr size_t al256(size_t x) { return (x + 255) & ~(size_t)255; }
constexpr size_t WS_CTL = 0, CTL_BYTES = 1u << 20;
constexpr size_t WS_WGU = CTL_BYTES;
constexpr size_t WS_WDN = WS_WGU + (size_t)DEPTH * 2 * NGU * DM * 2;
constexpr size_t WS_WIN = WS_WDN + (size_t)DEPTH * 2 * DM * FF * 2;
constexpr size_t WS_WOUT = WS_WIN + (size_t)DEPTH * NINP * DM * 2;
constexpr size_t WS_MODV = WS_WOUT + (size_t)DEPTH * DM * DM * 2;
constexpr size_t WS_ROPE = al256(WS_MODV + (size_t)DEPTH * NCOND * NMOD * 4);
constexpr size_t WS_X = al256(WS_ROPE + 2 * 64 * 32 * 4);
constexpr size_t WS_H = WS_X + (size_t)M * DM * 4;
constexpr size_t WS_ACT = WS_H + (size_t)M * DM * 2;
constexpr size_t WS_Z = WS_ACT + (size_t)M * FF * 2;
constexpr size_t WS_MRG = WS_Z + (size_t)M * NINP * 4;
constexpr size_t WS_NAQ = WS_MRG + (size_t)M * DM * 2;
constexpr size_t WS_NAK = WS_NAQ + (size_t)M * 512 * 2;
constexpr size_t WS_NAV = WS_NAK + (size_t)M * 512 * 2;
constexpr size_t WS_GQ = WS_NAV + (size_t)M * 512 * 2;
constexpr size_t WS_GK = WS_GQ + (size_t)M * 512 * 2;
constexpr size_t WS_GV = WS_GK + (size_t)M * 256 * 2;
constexpr size_t WS_CNAK = WS_GV + (size_t)M * 256 * 2;
constexpr size_t WS_CNAV = WS_CNAK + (size_t)LB * DEPTH * 256 * 512 * 2;
constexpr size_t WS_CGK = WS_CNAV + (size_t)LB * DEPTH * 256 * 512 * 2;
constexpr size_t WS_CGV = WS_CGK + (size_t)LB * DEPTH * 256 * 256 * 2;
constexpr size_t WS_AF = WS_CGV + (size_t)LB * DEPTH * 256 * 256 * 2;
constexpr size_t WS_AB = WS_AF + (size_t)M * 256 * 4;
constexpr size_t WS_DQ = WS_AB + (size_t)M * 256 * 4;
constexpr size_t WS_DK = WS_DQ + (size_t)M * 512 * 4;
constexpr size_t WS_DV = WS_DK + (size_t)M * 512 * 4;
constexpr size_t WS_DBA = WS_DV + (size_t)M * 512 * 4;
constexpr size_t WS_GOF = WS_DBA + (size_t)M * 16 * 4;
constexpr size_t WS_GOB = WS_GOF + (size_t)M * 512 * 4;
constexpr size_t WS_DOF = WS_GOB + (size_t)M * 512 * 4;
constexpr size_t WS_DOB = WS_DOF + (size_t)M * 512 * 4;
constexpr size_t WS_END = WS_DOB + (size_t)M * 512 * 4;

typedef unsigned short bf16_t;
struct Params { const float* in[N_IN]; float* out; unsigned char* ws; int ph_lo, ph_hi; };
static_assert(sizeof(Params) == N_IN * 8 + 8 + 8 + 8, "no padding");

#define WSP(T, off) ((T*)(p.ws + (off)))
__device__ __forceinline__ int opaque_tid() { int t = (int)threadIdx.x; asm volatile("" : "+v"(t)); return t; }
__device__ __forceinline__ Params opaque_params(const Params& p) { Params q = p; unsigned long long w = (unsigned long long)q.ws; asm volatile("" : "+s"(w));
    q.ws = (unsigned char*)(__attribute__((address_space(1))) unsigned char*)w; return q; }

typedef float vf4 __attribute__((ext_vector_type(4)));
__device__ __forceinline__ unsigned pack4_fp8(float a, float b, float c, float d) { int w = 0; w = __builtin_amdgcn_cvt_pk_fp8_f32(a, b, w, false); w = __builtin_amdgcn_cvt_pk_fp8_f32(c, d, w, true); return (unsigned)w; }
__device__ __forceinline__ float bf2f(unsigned short v) { return __uint_as_float((unsigned)v << 16); }
__device__ __forceinline__ vf4 ld4bf(const unsigned short* p) { const uint2 w = *(const uint2*)p; vf4 r; r.x = __uint_as_float(w.x << 16); r.y = __uint_as_float(w.x & 0xFFFF0000u); r.z = __uint_as_float(w.y << 16); r.w = __uint_as_float(w.y & 0xFFFF0000u); return r; }
__device__ __forceinline__ vf4 unp4bf(uint2 w) { vf4 r; r.x = __uint_as_float(w.x << 16); r.y = __uint_as_float(w.x & 0xFFFF0000u); r.z = __uint_as_float(w.y << 16); r.w = __uint_as_float(w.y & 0xFFFF0000u); return r; }
__device__ __forceinline__ void unp8bf(uint4 w, vf4& a, vf4& b) {
    a.x = __uint_as_float(w.x << 16); a.y = __uint_as_float(w.x & 0xFFFF0000u); a.z = __uint_as_float(w.y << 16); a.w = __uint_as_float(w.y & 0xFFFF0000u);
    b.x = __uint_as_float(w.z << 16); b.y = __uint_as_float(w.z & 0xFFFF0000u); b.z = __uint_as_float(w.w << 16); b.w = __uint_as_float(w.w & 0xFFFF0000u); }
__device__ __forceinline__ void ld8bf(const unsigned short* p, vf4& a, vf4& b) { const uint4 w = *(const uint4*)p;
    a.x = __uint_as_float(w.x << 16); a.y = __uint_as_float(w.x & 0xFFFF0000u); a.z = __uint_as_float(w.y << 16); a.w = __uint_as_float(w.y & 0xFFFF0000u);
    b.x = __uint_as_float(w.z << 16); b.y = __uint_as_float(w.z & 0xFFFF0000u); b.z = __uint_as_float(w.w << 16); b.w = __uint_as_float(w.w & 0xFFFF0000u); }
__device__ __forceinline__ float wave_sum(float v) {
#pragma unroll
    for (int o = 32; o >= 1; o >>= 1) v += __shfl_xor(v, o);
    return v;
}
typedef float vf2_ __attribute__((ext_vector_type(2)));
typedef __bf16 vb2_ __attribute__((ext_vector_type(2)));
__device__ __forceinline__ bf16_t f2bf(float f) { return __builtin_bit_cast(unsigned short, (__bf16)f); }
__device__ __forceinline__ unsigned pack2(float a, float b) { return __builtin_bit_cast(unsigned, __builtin_convertvector((vf2_){a, b}, vb2_)); }
__device__ __forceinline__ float silu_f(float x) { return x / (1.f + expf(-x)); }
__device__ __forceinline__ float rsqrt_fast(float x) { return __builtin_amdgcn_rsqf(x); }
__device__ __forceinline__ float silu_fast(float x) { return x * __builtin_amdgcn_rcpf(1.f + __expf(-x)); }
__device__ __forceinline__ float logsigmoid_fast(float x) { return fminf(x, 0.f) - __logf(1.f + __expf(-fabsf(x))); }
__device__ __forceinline__ float softplus_f(float x) { return fmaxf(x, 0.f) + log1pf(expf(-fabsf(x))); }
__device__ __forceinline__ float logsigmoid_f(float x) { return fminf(x, 0.f) - log1pf(expf(-fabsf(x))); }
__device__ __forceinline__ bool g1_fp8(int l, int f) { return f ? (G1B_MODE != 0) : (G1A_MODE != 0 || ((G1A_LAYERS >> l) & 1)); }
__device__ __forceinline__ int opaque_int(int v) { asm volatile("" : "+s"(v)); return v; }
__device__ __forceinline__ int cond_of_row(int m) { return m < MC ? 0 : 1 + (m - MC) / LT; }
#ifndef CONV_FILLER
#define CONV_FILLER 1
#endif
__device__ __forceinline__ void conv_tile(const float* __restrict__ src, int ld_src, int ncols_src, int k0, int c0, bf16_t* __restrict__ dst, int ld_dst, int n0, float* tile) {
    const int tid = opaque_tid();
    {
        const int r = tid >> 3, c = (tid & 7) * 8;
        float4 a = make_float4(0.f, 0.f, 0.f, 0.f), b = a;
        if (c0 + c + 8 <= ncols_src) {
            const float* s = src + (size_t)(k0 + r) * ld_src + c0 + c;
            a = *(const float4*)s; b = *(const float4*)(s + 4);
        }
        float* t = tile + r * 65 + c;
        t[0] = a.x; t[1] = a.y; t[2] = a.z; t[3] = a.w; t[4] = b.x; t[5] = b.y; t[6] = b.z; t[7] = b.w;
    }
    __syncthreads();
    {
        const int n = tid >> 3, ks = (tid & 7) * 8;
        const float* t = tile + ks * 65 + n;
        uint4 w;
        w.x = pack2(t[0 * 65], t[1 * 65]); w.y = pack2(t[2 * 65], t[3 * 65]); w.z = pack2(t[4 * 65], t[5 * 65]); w.w = pack2(t[6 * 65], t[7 * 65]);
        *(uint4*)(dst + (size_t)(n0 + n) * ld_dst + k0 + ks) = w;
    }
    __syncthreads();
}

__device__ __forceinline__ void conv_tile8(const float* __restrict__ src, int ld_src, int nrows_src, int k0, int c0, unsigned char* __restrict__ dst, int ld_dst, int n0, float scale, float* tile) {
    const int tid = opaque_tid();
    {
        const int r = tid >> 3, c = (tid & 7) * 8;
        float4 a = make_float4(0.f, 0.f, 0.f, 0.f), b = a;
        if (k0 + r < nrows_src) { const float* s = src + (size_t)(k0 + r) * ld_src + c0 + c; a = *(const float4*)s; b = *(const float4*)(s + 4); }
        float* t = tile + r * 65 + c;
        t[0] = a.x * scale; t[1] = a.y * scale; t[2] = a.z * scale; t[3] = a.w * scale; t[4] = b.x * scale; t[5] = b.y * scale; t[6] = b.z * scale; t[7] = b.w * scale;
    }
    __syncthreads();
    {
        const int n = tid >> 3, ks = (tid & 7) * 8;
        const float* t = tile + ks * 65 + n;
        uint2 w; w.x = pack4_fp8(t[0 * 65], t[1 * 65], t[2 * 65], t[3 * 65]); w.y = pack4_fp8(t[4 * 65], t[5 * 65], t[6 * 65], t[7 * 65]);
        *(uint2*)(dst + (size_t)(n0 + n) * ld_dst + k0 + ks) = w;
    }
    __syncthreads();
}
constexpr int MOD_ITEMS = DEPTH * (NMOD / 128);
constexpr int TGU_KT = DM / 64, TGU_NT = NGU / 64, TDN_KT = (G2_FP8 ? FFP : FF) / 64, TDN_NT = DM / 64, TIN_KT = DM / 64, TIN_NT = NINP / 64, TOUT_KT = DM / 64, TOUT_NT = DM / 64;
constexpr int TL_GU = 2 * TGU_KT * TGU_NT, TL_DN = 2 * TDN_KT * TDN_NT, TL_IN = TIN_KT * TIN_NT, TL_OUT = TOUT_KT * TOUT_NT, NT_L = TL_GU + TL_DN + TL_IN + TL_OUT;
struct CTile { const float* sp; unsigned char* dp; float scale; int fp8; };
__device__ __forceinline__ CTile conv_desc(const Params& p, int l, int it, int tid) {
    const int r = tid >> 3, c = (tid & 7) * 8;
    CTile d; d.scale = 1.0f; d.fp8 = 0;
    if (it < TL_GU) {
        const int mat = l * 2 + it / (TGU_KT * TGU_NT), rr = it % (TGU_KT * TGU_NT), kt = rr / TGU_NT, nt = rr % TGU_NT;
        const int n0 = nt * 64, t256 = n0 / 256, cc = n0 % 256;
        const int c0 = cc < 128 ? 128 * t256 + cc : FF + 128 * t256 + (cc - 128);
        d.sp = p.in[I_GU] + (size_t)mat * DM * NGU + (size_t)(kt * 64 + r) * NGU + c0 + c;
        if (g1_fp8(mat >> 1, mat & 1)) { d.fp8 = 1; d.scale = WGU_SCALE; d.dp = WSP(unsigned char, WS_WGU) + (size_t)mat * NGU * DM * 2 + (size_t)(n0 + r) * DM + kt * 64 + c; }
        else d.dp = WSP(unsigned char, WS_WGU) + ((size_t)mat * NGU * DM + (size_t)(n0 + r) * DM + kt * 64 + c) * 2;
    } else if (it < TL_GU + TL_DN) {
        const int i2 = it - TL_GU, mat = l * 2 + i2 / (TDN_KT * TDN_NT), rr = i2 % (TDN_KT * TDN_NT), kt = rr / TDN_NT, nt = rr % TDN_NT;
        d.sp = (kt * 64 + r < FF) ? p.in[I_DOWN] + (size_t)mat * FF * DM + (size_t)(kt * 64 + r) * DM + nt * 64 + c : nullptr;
#if G2_FP8
        d.fp8 = 1; d.scale = WDN_SCALE; d.dp = WSP(unsigned char, WS_WDN) + (size_t)mat * DM * FFP + (size_t)(nt * 64 + r) * FFP + kt * 64 + c;
#else
        d.dp = WSP(unsigned char, WS_WDN) + ((size_t)mat * DM * FF + (size_t)(nt * 64 + r) * FF + kt * 64 + c) * 2;
#endif
    } else if (it < TL_GU + TL_DN + TL_IN) {
        const int i2 = it - TL_GU - TL_DN, kt = i2 / TIN_NT, nt = i2 % TIN_NT;
        d.sp = (nt * 64 + c + 8 <= NIN) ? p.in[I_WIN] + (size_t)l * DM * NIN + (size_t)(kt * 64 + r) * NIN + nt * 64 + c : nullptr;
        d.dp = WSP(unsigned char, WS_WIN) + ((size_t)l * NINP * DM + (size_t)(nt * 64 + r) * DM + kt * 64 + c) * 2;
    } else {
        const int i2 = it - TL_GU - TL_DN - TL_IN, kt = i2 / TOUT_NT, nt = i2 % TOUT_NT;
        d.sp = p.in[I_WOUT] + (size_t)l * DM * DM + (size_t)(kt * 64 + r) * DM + nt * 64 + c;
        d.dp = WSP(unsigned char, WS_WOUT) + ((size_t)l * DM * DM + (size_t)(nt * 64 + r) * DM + kt * 64 + c) * 2;
    }
    return d;
}
__device__ __forceinline__ void conv_layer_tiles(const Params& p, int l, int t_begin, int t_end, int first, int stride, float* s_tile) {
    const int tid = opaque_tid(), r = tid >> 3, c = (tid & 7) * 8;
    int it = t_begin + first;
    if (it >= t_end) return;
    __syncthreads();
    CTile d = conv_desc(p, l, it, tid);
    float4 a = make_float4(0.f, 0.f, 0.f, 0.f), b = a;
    if (d.sp) { a = *(const float4*)d.sp; b = *(const float4*)(d.sp + 4); }
    for (int par = 0; it < t_end; it += stride, par ^= 1) {
        const int nx = it + stride;
        CTile dn = d; float4 na = make_float4(0.f, 0.f, 0.f, 0.f), nb = na;
        if (nx < t_end) { dn = conv_desc(p, l, nx, tid); if (dn.sp) { na = *(const float4*)dn.sp; nb = *(const float4*)(dn.sp + 4); } }
        float* tile = s_tile + par * (64 * 65);
        { float* t = tile + r * 65 + c; const float sc = d.scale;
          t[0] = a.x * sc; t[1] = a.y * sc; t[2] = a.z * sc; t[3] = a.w * sc; t[4] = b.x * sc; t[5] = b.y * sc; t[6] = b.z * sc; t[7] = b.w * sc; }
        __syncthreads();
        { const float* t = tile + c * 65 + r;
          if (d.fp8) { uint2 w; w.x = pack4_fp8(t[0 * 65], t[1 * 65], t[2 * 65], t[3 * 65]); w.y = pack4_fp8(t[4 * 65], t[5 * 65], t[6 * 65], t[7 * 65]); *(uint2*)d.dp = w; }
          else { uint4 w; w.x = pack2(t[0 * 65], t[1 * 65]); w.y = pack2(t[2 * 65], t[3 * 65]); w.z = pack2(t[4 * 65], t[5 * 65]); w.w = pack2(t[6 * 65], t[7 * 65]); *(uint4*)d.dp = w; } }
        d = dn; a = na; b = nb;
    }
    __syncthreads();
}

constexpr int MOD_TC = 72, MOD_CG = MOD_TC / 4, MOD_KS = 16, MOD_KR = DM / MOD_KS, MOD_NT = NMOD / MOD_TC;
constexpr int MOD_LDS_FLOATS = NCOND * DM + MOD_KS * MOD_CG * NCOND * 4;
static_assert(NMOD % MOD_TC == 0 && MOD_CG * MOD_KS <= 512 && DM % MOD_KS == 0 && MOD_KR % 16 == 0, "mod tiling");
__device__ __forceinline__ void mod_layer(const Params& p, int l, int first, int stride, float* smem) {
    const int tid = opaque_tid();
    float* s_cond = smem;
    float* s_red = s_cond + NCOND * DM;
    __syncthreads();
    for (int i = tid; i < NCOND * DM; i += 512) { const int ci = i / DM, k = i % DM; const float v = ci == 0 ? p.in[I_CCTX][k] : p.in[I_C][(size_t)(ci - 1) * DM + k]; s_cond[i] = silu_f(v); }
    __syncthreads();
    float* modv = WSP(float, WS_MODV);
    const int cg = tid % MOD_CG, ks = tid / MOD_CG;
    for (int jt = first; jt < MOD_NT; jt += stride) {
        if (ks < MOD_KS) {
            const float* w = p.in[I_WMOD] + (size_t)l * DM * NMOD + (size_t)(ks * MOD_KR) * NMOD + jt * MOD_TC + cg * 4;
            const float* sc = s_cond + ks * MOD_KR;
            vf4 acc[NCOND];
#pragma unroll
            for (int ci = 0; ci < NCOND; ++ci) acc[ci] = (vf4){0.f, 0.f, 0.f, 0.f};
            for (int k = 0; k < MOD_KR; k += 16) {
                vf4 wv[16];
#pragma unroll
                for (int j = 0; j < 16; ++j) wv[j] = *(const vf4*)(w + (size_t)(k + j) * NMOD);
#pragma unroll
                for (int j4 = 0; j4 < 4; ++j4)
#pragma unroll
                    for (int ci = 0; ci < NCOND; ++ci) {
                        const vf4 s = *(const vf4*)&sc[ci * DM + k + j4 * 4];
                        acc[ci] += s.x * wv[j4 * 4] + s.y * wv[j4 * 4 + 1] + s.z * wv[j4 * 4 + 2] + s.w * wv[j4 * 4 + 3];
                    }
            }
#pragma unroll
            for (int ci = 0; ci < NCOND; ++ci) *(vf4*)&s_red[((ks * MOD_CG + cg) * NCOND + ci) * 4] = acc[ci];
        }
        __syncthreads();
        for (int i = tid; i < MOD_TC * NCOND; i += 512) {
            const int c = i % MOD_TC, ci = i / MOD_TC, col = jt * MOD_TC + c;
            float sum = p.in[I_BMOD][(size_t)l * NMOD + col];
#pragma unroll
            for (int k2 = 0; k2 < MOD_KS; ++k2) sum += s_red[((k2 * MOD_CG + (c >> 2)) * NCOND + ci) * 4 + (c & 3)];
            modv[((size_t)l * NCOND + ci) * NMOD + col] = sum;
        }
        __syncthreads();
    }
}

__device__ __forceinline__ void phase_prologue(const Params& p, float* smem) {
    const int tid = threadIdx.x, nb = gridDim.x, bid = blockIdx.x;
    float* s_tile = smem;
#if CONV_FILLER
    mod_layer(p, 0, bid, nb, smem);
#ifdef PRO_DUP_MOD
    for (int r_ = 0; r_ < opaque_int(PRO_DUP_MOD); ++r_) mod_layer(p, 0, bid, nb, smem);
#endif
#else
    for (int l2 = 0; l2 < DEPTH; ++l2) mod_layer(p, l2, bid, nb, smem);
#endif
    conv_layer_tiles(p, 0, 0, NT_L, bid, nb, s_tile);
#ifdef PRO_DUP_CONV
    for (int r_ = 0; r_ < opaque_int(PRO_DUP_CONV); ++r_) conv_layer_tiles(p, 0, 0, NT_L, bid, nb, s_tile);
#endif
#if !CONV_FILLER
    for (int l2 = 1; l2 < DEPTH; ++l2) conv_layer_tiles(p, l2, 0, NT_L, bid, nb, s_tile);
#endif
    const size_t gtid = (size_t)bid * 512 + tid, gstride = (size_t)nb * 512;
    {
        const size_t n_na = (size_t)LB * DEPTH * 256 * 512 / 8;
        for (size_t i = gtid; i < 2 * n_na; i += gstride) {
            const bool isv = i >= n_na; const size_t j = isv ? i - n_na : i;
            const int d8 = (int)(j % 16), h = (int)((j / 16) % 4), t = (int)((j / 64) % 256); const size_t bl = j / (64 * 256);
            const float* s = p.in[isv ? I_CNAV : I_CNAK] + ((bl * 4 + h) * 256 + t) * 128 + d8 * 8;
            const float4 a = *(const float4*)s, b = *(const float4*)(s + 4);
            uint4 w; w.x = pack2(a.x, a.y); w.y = pack2(a.z, a.w); w.z = pack2(b.x, b.y); w.w = pack2(b.z, b.w);
            *(uint4*)(WSP(bf16_t, isv ? WS_CNAV : WS_CNAK) + (bl * 256 + t) * 512 + h * 128 + d8 * 8) = w;
        }
        const size_t n_g = (size_t)LB * DEPTH * 256 * 256 / 8;
        for (size_t i = gtid; i < 2 * n_g; i += gstride) {
            const bool isv = i >= n_g; const size_t j = isv ? i - n_g : i;
            const int d8 = (int)(j % 16), h = (int)((j / 16) % 2), t = (int)((j / 32) % 256); const size_t bl = j / (32 * 256);
            const float* s = p.in[isv ? I_CGV : I_CGK] + ((bl * 2 + h) * 256 + t) * 128 + d8 * 8;
            const float4 a = *(const float4*)s, b = *(const float4*)(s + 4);
            uint4 w; w.x = pack2(a.x, a.y); w.y = pack2(a.z, a.w); w.z = pack2(b.x, b.y); w.w = pack2(b.z, b.w);
            *(uint4*)(WSP(bf16_t, isv ? WS_CGV : WS_CGK) + (bl * 256 + t) * 256 + h * 128 + d8 * 8) = w;
        }
    }
    for (size_t i = gtid; i < 64 * 32; i += gstride) {
        const int pos = (int)(i / 32), k = (int)(i % 32);
        const float inv = powf(10000.0f, -(float)(2 * k) / 64.0f);
        const float ang = (float)pos * inv;
        WSP(float, WS_ROPE)[i] = cosf(ang); WSP(float, WS_ROPE)[64 * 32 + i] = sinf(ang);
    }
}

#ifndef NORM_NR
#define NORM_NR 2
#endif
constexpr int NORM_MAXC = 6;
__device__ __forceinline__ void phase_norm(const Params& p, int l, int which  , unsigned char* lds) {
    const int tid = opaque_tid(), lane = tid & 63, wv = tid >> 6;
    const float* X = WSP(float, WS_X); bf16_t* H = WSP(bf16_t, WS_H);
    const bool from_in = (l == 0 && which == 0);
    const float* g = p.in[I_NORMG] + ((size_t)l * 3 + which) * DM;
    const int rpb = (M + (int)gridDim.x - 1) / (int)gridDim.x;
    const int r0 = (int)blockIdx.x * rpb, r1 = r0 + rpb < M ? r0 + rpb : M;
    if (r0 >= r1) return;
    const int c_lo = cond_of_row(r0), c_hi = cond_of_row(r1 - 1);
    float* sw = (float*)lds;
    for (int ci = 0; ci <= c_hi - c_lo && ci < NORM_MAXC; ++ci) {
        const float* mv = WSP(float, WS_MODV) + ((size_t)l * NCOND + c_lo + ci) * NMOD + (size_t)which * 3 * DM;
        const int c = tid * 4;
        const vf4 gg = *(const vf4*)(g + c), sh = *(const vf4*)(mv + c), sc = *(const vf4*)(mv + DM + c);
        *(vf4*)(sw + (size_t)ci * 2 * DM + c) = gg * (1.f + sc);
        *(vf4*)(sw + (size_t)ci * 2 * DM + DM + c) = sh;
    }
    __syncthreads();
    for (int m0 = r0 + wv; m0 < r1; m0 += NORM_NR * 8) {
        int mm[NORM_NR]; bool has[NORM_NR];
#pragma unroll
        for (int k = 0; k < NORM_NR; ++k) { has[k] = m0 + k * 8 < r1; mm[k] = has[k] ? m0 + k * 8 : m0; }
        vf4 v[NORM_NR][8]; float ss[NORM_NR];
#pragma unroll
        for (int k = 0; k < NORM_NR; ++k) {
            const int m = mm[k];
            if (from_in || !XBF16) {
                const float* x = !from_in ? X + (size_t)m * DM : m < MC ? p.in[I_XP] + (size_t)m * DM : p.in[I_XS] + (size_t)(m - MC) * DM;
#pragma unroll
                for (int i = 0; i < 8; ++i) v[k][i] = *(const vf4*)(x + (i * 64 + lane) * 4);
            } else {
                const bf16_t* x = (const bf16_t*)X + (size_t)m * DM;
#pragma unroll
                for (int i = 0; i < 8; ++i) v[k][i] = ld4bf(x + (i * 64 + lane) * 4);
            }
        }
#pragma unroll
        for (int k = 0; k < NORM_NR; ++k) {
            ss[k] = 0.f;
#pragma unroll
            for (int i = 0; i < 8; ++i) ss[k] += v[k][i].x * v[k][i].x + v[k][i].y * v[k][i].y + v[k][i].z * v[k][i].z + v[k][i].w * v[k][i].w;
            ss[k] = wave_sum(ss[k]);
        }
#pragma unroll
        for (int k = 0; k < NORM_NR; ++k) {
            if (k > 0 && !has[k]) break;
            const int m = mm[k];
            const float* a = sw + (size_t)(cond_of_row(m) - c_lo) * 2 * DM;
            const float r = rsqrt_fast(ss[k] * (1.0f / DM) + EPS);
#pragma unroll
            for (int i = 0; i < 8; ++i) {
                const int c = (i * 64 + lane) * 4;
                const vf4 o = v[k][i] * r * *(const vf4*)(a + c) + *(const vf4*)(a + DM + c);
                if (which != 1 && g1_fp8(l, which >> 1)) *(unsigned*)((unsigned char*)H + (size_t)m * DM + c) = pack4_fp8(o.x, o.y, o.z, o.w);
                else { uint2 w; w.x = pack2(o.x, o.y); w.y = pack2(o.z, o.w); *(uint2*)(H + (size_t)m * DM + c) = w; }
            }
            if (G2_FP8 && which != 1 && lane < (FFP - FF) / 4) *(unsigned*)(WSP(unsigned char, WS_ACT) + (size_t)m * FFP + FF + 4 * lane) = 0u;
        }
    }
}

__device__ __forceinline__ float red16(float v);
__device__ __forceinline__ float ssq8(vf4 a, vf4 b) { const vf4 s = a * a + b * b; return (s.x + s.y) + (s.z + s.w); }
__device__ __forceinline__ uint4 pack8(vf4 a, vf4 b) { uint4 w; w.x = pack2(a.x, a.y); w.y = pack2(a.z, a.w); w.z = pack2(b.x, b.y); w.w = pack2(b.z, b.w); return w; }
constexpr int PL_CW = 0, PL_UP = PL_CW + 5 * 1536, PL_GB = PL_UP + 2 * 16 * 256, PL_NQ = PL_GB + 512, PL_ROPE = PL_NQ + 512, PL_END = PL_ROPE + 2 * 64 * 32;
__device__ __forceinline__ void phase_prep(const Params& p, int l, unsigned char* lds) {
    const int tid = opaque_tid(), lane = tid & 63, wv = tid >> 6, rg = lane >> 4, sub = lane & 15, c8 = sub * 8;
    const bf16_t* Z = WSP(bf16_t, WS_Z);
    float* sw = (float*)lds;
    for (int i = tid; i < 5 * 1536; i += 512) { const int j = i / 1536, col = i % 1536; sw[PL_CW + j * 1536 + ((col >> 2) & 1) * 768 + (col >> 3) * 4 + (col & 3)] = p.in[I_CONV][(size_t)l * 5 * 1536 + i]; }
    for (int i = tid; i < 2 * 16 * 256 / 4; i += 512) ((vf4*)(sw + PL_UP))[i] = ((const vf4*)(p.in[I_GUP] + (size_t)l * 2 * 16 * 256))[i];
    sw[PL_GB + tid] = p.in[I_GBIAS][(size_t)l * 512 + tid];
    { const int v = tid >> 7, c = tid & 127; const float* src = (v < 2 ? p.in[I_NAQKN] : p.in[I_GQAQKN]) + ((size_t)l * 2 + (v & 1)) * 128; sw[PL_NQ + v * 128 + ((c >> 2) & 1) * 64 + (c >> 3) * 4 + (c & 3)] = src[c]; }
    for (int i = tid; i < 2 * 64 * 32 / 4; i += 512) ((vf4*)(sw + PL_ROPE))[i] = ((const vf4*)WSP(float, WS_ROPE))[i];
    __syncthreads();
    const float* ropec = sw + PL_ROPE; const float* ropes = ropec + 64 * 32;
    const float* wnq = sw + PL_NQ + sub * 4; const float* wnk = wnq + 128;
    const float* wgq = wnq + 256; const float* wgk = wnq + 384;
    const float* cw = sw + PL_CW + (rg * 16 + sub) * 4;
    const int rpw = (M + (int)gridDim.x * 8 - 1) / ((int)gridDim.x * 8);
    for (int m = ((int)blockIdx.x * 8 + wv) * rpw, mend = (m + rpw < M ? m + rpw : M); m < mend; ++m) {
        const bf16_t* z = Z + (size_t)m * NINP;
        const bool ctx = m < MC;
        const int b = ctx ? m / CT : (m - MC) / LT, t = ctx ? m % CT : (m - MC) % LT, T = ctx ? CT : LT;
        const int ho = rg * 128 + c8;
        uint4 rz[5]; uint2 rgz[2][4];
        {
            const bf16_t* zkv = z + (rg < 2 ? Z_GQK + rg * 128 : Z_GQV + (rg - 2) * 128) + c8;
            rz[0] = *(const uint4*)(z + Z_NAQ + ho); rz[1] = *(const uint4*)(z + Z_NAK + ho); rz[2] = *(const uint4*)(z + Z_NAV + ho); rz[3] = *(const uint4*)(z + Z_GQQ + ho); rz[4] = *(const uint4*)zkv;
#pragma unroll
            for (int dir = 0; dir < 2; ++dir)
#pragma unroll
                for (int r4 = 0; r4 < 4; ++r4) rgz[dir][r4] = *(const uint2*)(z + (dir ? Z_GB : Z_GF) + 4 * r4);
        }
        asm volatile("" ::: "memory");
        {
            vf4 q0, q1, k0, k1, v0, v1, g0, g1, x0, x1;
            unp8bf(rz[0], q0, q1); unp8bf(rz[1], k0, k1); unp8bf(rz[2], v0, v1); unp8bf(rz[3], g0, g1); unp8bf(rz[4], x0, x1);
            float r = rsqrt_fast(red16(ssq8(q0, q1)) * (1.0f / 128) + EPS);
            q0 = q0 * r * *(const vf4*)wnq; q1 = q1 * r * *(const vf4*)(wnq + 64);
            *(uint4*)(WSP(bf16_t, WS_NAQ) + (size_t)m * 512 + ho) = pack8(q0, q1);
            r = rsqrt_fast(red16(ssq8(k0, k1)) * (1.0f / 128) + EPS);
            k0 = k0 * r * *(const vf4*)wnk; k1 = k1 * r * *(const vf4*)(wnk + 64);
            *(uint4*)(WSP(bf16_t, WS_NAK) + (size_t)m * 512 + ho) = pack8(k0, k1);
            *(uint4*)(WSP(bf16_t, WS_NAV) + (size_t)m * 512 + ho) = pack8(v0, v1);
            if (ctx) {
                const size_t o = ((((size_t)b * DEPTH + l) * 4 + rg) * CT + t) * 128 + c8;
                *(vf4*)(p.out + O_NAK + o) = k0; *(vf4*)(p.out + O_NAK + o + 4) = k1; *(vf4*)(p.out + O_NAV + o) = v0; *(vf4*)(p.out + O_NAV + o + 4) = v1;
            }
            r = rsqrt_fast(red16(ssq8(g0, g1)) * (1.0f / 128) + EPS);
            g0 = g0 * r * *(const vf4*)wgq; g1 = g1 * r * *(const vf4*)(wgq + 64);
            const float rk = rsqrt_fast(red16(ssq8(x0, x1)) * (1.0f / 128) + EPS);
            if (rg < 2) { x0 = x0 * rk * *(const vf4*)wgk; x1 = x1 * rk * *(const vf4*)(wgk + 64); }
            if (!ctx) {
                const int pos = sub < 8 ? (t >> 6) : (t & 63), ai = pos * 32 + (c8 & 31);
                const vf4 c0 = *(const vf4*)(ropec + ai), c1 = *(const vf4*)(ropec + ai + 4), s0 = *(const vf4*)(ropes + ai), s1 = *(const vf4*)(ropes + ai + 4);
                const bool hi = (sub & 4) != 0;
                vf4 pg0, pg1, px0, px1;
#pragma unroll
                for (int j = 0; j < 4; ++j) { pg0[j] = __shfl_xor(g0[j], 4); pg1[j] = __shfl_xor(g1[j], 4); px0[j] = __shfl_xor(x0[j], 4); px1[j] = __shfl_xor(x1[j], 4); }
                g0 = hi ? pg0 * s0 + g0 * c0 : g0 * c0 - pg0 * s0; g1 = hi ? pg1 * s1 + g1 * c1 : g1 * c1 - pg1 * s1;
                if (rg < 2) { x0 = hi ? px0 * s0 + x0 * c0 : x0 * c0 - px0 * s0; x1 = hi ? px1 * s1 + x1 * c1 : x1 * c1 - px1 * s1; }
            }
            *(uint4*)(WSP(bf16_t, WS_GQ) + (size_t)m * 512 + ho) = pack8(g0, g1);
            *(uint4*)(WSP(bf16_t, rg < 2 ? WS_GK : WS_GV) + (size_t)m * 256 + (rg & 1) * 128 + c8) = pack8(x0, x1);
            if (ctx) {
                const size_t o = ((((size_t)b * DEPTH + l) * 2 + (rg & 1)) * CT + t) * 128 + c8;
                float* dst = p.out + (rg < 2 ? O_GK : O_GV) + o;
                *(vf4*)dst = x0; *(vf4*)(dst + 4) = x1;
            }
        }
        asm volatile("" ::: "memory");
        {
#pragma unroll
            for (int dir = 0; dir < 2; ++dir) {
                const float* up = sw + PL_UP + dir * 16 * 256 + 4 * lane;
                vf4 acc = *(const vf4*)(sw + PL_GB + dir * 256 + 4 * lane);
#pragma unroll
                for (int r4 = 0; r4 < 4; ++r4) {
                    const vf4 gv = unp4bf(rgz[dir][r4]);
                    acc += gv.x * *(const vf4*)(up + (4 * r4 + 0) * 256) + gv.y * *(const vf4*)(up + (4 * r4 + 1) * 256) + gv.z * *(const vf4*)(up + (4 * r4 + 2) * 256) + gv.w * *(const vf4*)(up + (4 * r4 + 3) * 256);
                }
                vf4 o;
#pragma unroll
                for (int j = 0; j < 4; ++j) o[j] = logsigmoid_fast(acc[j]) * (1.0f / 16.0f);
                *(vf4*)(WSP(float, dir ? WS_AB : WS_AF) + (size_t)m * 256 + 4 * lane) = o;
            }
        }
        asm volatile("" ::: "memory");
        {
            uint4 rcz[3][5];
#pragma unroll
            for (int part = 0; part < 3; ++part)
#pragma unroll
                for (int j = 0; j < 5; ++j) { const int tt = t + j - 2;
                    rcz[part][j] = (tt >= 0 && tt < T) ? *(const uint4*)(Z + (size_t)(m + j - 2) * NINP + Z_DQKV + part * 512 + rg * 128 + c8) : make_uint4(0u, 0u, 0u, 0u); }
            asm volatile("" ::: "memory");
#pragma unroll
            for (int part = 0; part < 3; ++part) {
                vf4 a0 = (vf4){0.f, 0.f, 0.f, 0.f}, a1 = a0;
#pragma unroll
                for (int j = 0; j < 5; ++j) {
                    const float* cj = cw + j * 1536 + part * 256;
                    vf4 z0, z1; unp8bf(rcz[part][j], z0, z1);
                    a0 += *(const vf4*)cj * z0; a1 += *(const vf4*)(cj + 768) * z1;
                }
#pragma unroll
                for (int j = 0; j < 4; ++j) { a0[j] = silu_fast(a0[j]); a1[j] = silu_fast(a1[j]); }
                if (part < 2) { const float r = rsqrt_fast(red16(ssq8(a0, a1)) + EPS) * (part == 0 ? 0.08838834764831845f : 1.0f); a0 *= r; a1 *= r; }
                *(uint4*)(WSP(bf16_t, part == 0 ? WS_DQ : part == 1 ? WS_DK : WS_DV) + (size_t)m * 512 + rg * 128 + c8) = pack8(a0, a1);
                asm volatile("" ::: "memory");
            }
            if (lane < 8) {
                const float beta = 1.0f / (1.0f + expf(-bf2f(z[Z_DB + lane])));
                const float g = -expf(p.in[I_ALOG][(size_t)l * 8 + lane]) * softplus_f(bf2f(z[Z_DA + lane]) + p.in[I_DTB][(size_t)l * 8 + lane]);
                float* ba = WSP(float, WS_DBA) + (size_t)m * 16;
                ba[lane] = beta; ba[8 + lane] = g;
            }
        }
    }
}

typedef float vf2 __attribute__((ext_vector_type(2)));
__device__ __forceinline__ float dpp_f(float v, const int ctrl) { return v; }
#define DPPF(v, ctrl) __int_as_float(__builtin_amdgcn_mov_dpp(__float_as_int(v), (ctrl), 0xF, 0xF, true))
__device__ __forceinline__ float red8(float v) { v += DPPF(v, 0xB1); v += DPPF(v, 0x4E); v += DPPF(v, 0x141); return v; }
__device__ __forceinline__ float red16(float v) { v = red8(v); v += DPPF(v, 0x140); return v; }

__device__ __forceinline__ void phase_post(const Params& p, int l) {
    const int tid = opaque_tid(), lane = tid & 63, wv = tid >> 6, rg = lane >> 4, c8 = (lane & 15) * 8;
    const bf16_t* Z = WSP(bf16_t, WS_Z); bf16_t* MRG = WSP(bf16_t, WS_MRG);
    const float* wg = p.in[I_GLAON] + (size_t)l * 128 + c8; const float* wd = p.in[I_GDNON] + (size_t)l * 128 + c8;
    for (int m = blockIdx.x * 8 + wv; m < M; m += gridDim.x * 8) {
        const bf16_t* z = Z + (size_t)m * NINP;
        const int ho = rg * 128 + c8;
#pragma unroll
        for (int g = 0; g < 2; ++g) {
            const float* of = WSP(float, g ? WS_DOF : WS_GOF) + (size_t)m * 512 + ho; const float* ob = WSP(float, g ? WS_DOB : WS_GOB) + (size_t)m * 512 + ho;
            const float* w = g ? wd : wg; const bf16_t* zg = z + (g ? Z_DZ : Z_GLR) + ho;
            vf4 a0 = *(const vf4*)of + *(const vf4*)ob, a1 = *(const vf4*)(of + 4) + *(const vf4*)(ob + 4);
            vf4 g0, g1; ld8bf(zg, g0, g1);
            const float r = rsqrt_fast(red16(ssq8(a0, a1)) * (1.0f / 128) + EPS);
            a0 = a0 * r * *(const vf4*)w; a1 = a1 * r * *(const vf4*)(w + 4);
#pragma unroll
            for (int j = 0; j < 4; ++j) { a0[j] *= silu_fast(g0[j]); a1[j] *= silu_fast(g1[j]); }
            *(uint4*)(MRG + (size_t)m * DM + (g ? 1536 : 512) + ho) = pack8(a0, a1);
        }
    }
}
#define XB_TMO      128
#define XB_XCNT(j)  (256  + 64 * (j))
#define XB_XSUB(j)  (1280 + 64 * (j))
#define XB_XGEN(j)  (2304 + 64 * (j))
#define XB_TOP      3328
#define XB_TOPGEN   3392
#define XCD_BAR_WORDS 3456
#define XB_SPIN_CAP (1u << 22)
#define LAS __attribute__((address_space(3)))

__device__ __forceinline__ unsigned xb_ld(unsigned* p)              { return __hip_atomic_load(p, __ATOMIC_RELAXED, __HIP_MEMORY_SCOPE_AGENT); }
__device__ __forceinline__ unsigned xb_add(unsigned* p, unsigned v) { return __hip_atomic_fetch_add(p, v, __ATOMIC_RELAXED, __HIP_MEMORY_SCOPE_AGENT); }
__device__ __forceinline__ unsigned xb_xcc_id() { return (unsigned)__builtin_amdgcn_s_getreg((3 << 11) | 20) & 0xFu; }
#define XB_SPIN(cond, bar) do { unsigned _sp = 0; while (cond) { __builtin_amdgcn_s_sleep(1); \
    if ((++_sp & 255u) == 0u) { if (xb_ld(&(bar)[XB_TMO])) break; if (_sp > XB_SPIN_CAP) { atomicAdd(&(bar)[XB_TMO], 1u); break; } } } } while (0)

struct XcdBarrier {
    unsigned* bar; unsigned x;
    volatile LAS unsigned* st;
};

__device__ __forceinline__ XcdBarrier xcd_barrier_post(unsigned* bar, volatile LAS unsigned* st) {
    XcdBarrier b; b.bar = bar; b.x = xb_xcc_id(); b.st = st;
    if (threadIdx.x == 0) (void)xb_add(&bar[XB_XCNT(b.x)], 1u);
    return b;
}
__device__ __forceinline__ void xcd_barrier_complete(unsigned* bar, unsigned x, unsigned& nloc, unsigned& nx) {
    const unsigned G = gridDim.x * gridDim.y * gridDim.z;
    unsigned sum, cnt, mine, sp = 0u;
    for (;;) {
        sum = 0u; cnt = 0u; mine = 0u;
#pragma unroll
        for (unsigned j = 0; j < 16; ++j) { const unsigned c = xb_ld(&bar[XB_XCNT(j)]); sum += c; cnt += (c > 0u) ? 1u : 0u; mine = (j == x) ? c : mine; }
        if (sum == G) break;
        __builtin_amdgcn_s_sleep(1);
        if ((++sp & 255u) == 0u) { if (xb_ld(&bar[XB_TMO])) break; if (sp > XB_SPIN_CAP) { atomicAdd(&bar[XB_TMO], 1u); break; } }
    }
    nloc = mine > 0u ? mine : 1u; nx = cnt > 0u ? cnt : 1u;
}

__device__ __forceinline__ void xcd_barrier(const XcdBarrier& b) {
    asm volatile("s_waitcnt vmcnt(0)" ::: "memory");
    __syncthreads();
    if (threadIdx.x == 0) {
        unsigned* bar = b.bar;
        __builtin_amdgcn_s_waitcnt(0);
        unsigned nloc = b.st[0], nx = b.st[1];
        if (nloc == 0u) { xcd_barrier_complete(bar, b.x, nloc, nx); b.st[0] = nloc; b.st[1] = nx; }
        const unsigned old = xb_add(&bar[XB_XSUB(b.x)], 1u);
        const unsigned gen = old / nloc;
        if (old + 1u == (gen + 1u) * nloc) {
            __builtin_amdgcn_fence(__ATOMIC_RELEASE, "agent");
            asm volatile("s_waitcnt vmcnt(0)" ::: "memory");
            const unsigned og = xb_add(&bar[XB_TOP], 1u);
            const unsigned tg = og / nx;
            if (og + 1u == (tg + 1u) * nx) xb_add(&bar[XB_TOPGEN], 1u);
            else XB_SPIN(xb_ld(&bar[XB_TOPGEN]) == tg, bar);
            __builtin_amdgcn_fence(__ATOMIC_ACQUIRE, "agent");
            xb_add(&bar[XB_XGEN(b.x)], 1u);
            asm volatile("s_waitcnt vmcnt(0)" ::: "memory");
        } else {
            XB_SPIN(xb_ld(&bar[XB_XGEN(b.x)]) == gen, bar);
            __builtin_amdgcn_fence(__ATOMIC_ACQUIRE, "agent");
            asm volatile("s_waitcnt vmcnt(0)" ::: "memory");
        }
    }
    __syncthreads();
}

#ifndef NT_STORES
#define NT_STORES 0
#endif
namespace pg8 {
#define PG8_LAS __attribute__((address_space(3)))
typedef unsigned short bf16_t;
typedef short bf16x8 __attribute__((ext_vector_type(8)));
typedef float f32x4 __attribute__((ext_vector_type(4)));
typedef unsigned u32x4 __attribute__((ext_vector_type(4)));
typedef unsigned u32x2 __attribute__((ext_vector_type(2)));
typedef int v4i32 __attribute__((ext_vector_type(4)));
typedef int v8i32 __attribute__((ext_vector_type(8)));
constexpr int BM = 256, BK = 64, HALF = 128, HTB = HALF * BK * 2  , STAGE_BYTES = 8 * HTB, NXCD = 8, WGM = 8;

__host__ __device__ __forceinline__ int lds_byte(int r, int c) { const int st = (r >> 4) * 2 + (c >> 5), rr = r & 15, cc = c & 31, ob = rr * 64 + cc * 2; return st * 1024 + (ob ^ (((ob >> 9) & 1) << 5)); }
__host__ __device__ __forceinline__ void stage_rc(int b, int& R, int& C) { const int st = b / 1024, sb = b % 1024, swz = sb ^ (((sb >> 9) & 1) << 5); R = (st >> 1) * 16 + swz / 64; C = (st & 1) * 32 + (swz % 64) / 2; }
__host__ __device__ __forceinline__ int perm32(int rho) { const int n = rho >> 4, i = rho & 15; return 8 * (i >> 2) + 4 * n + (i & 3); }

struct Unit { int pm, pn, k0, nt, at, slot, msk; };
struct Gemm { const bf16_t* A; const bf16_t* Bt; int M, N, K; };

struct StaticOrder {
    int nM, nN, nwg, G, c, ntk, split, msplit;
    __host__ __device__ void init(int M, int N, int K, int G_, int c_, int split_ = 0) { nM = M / BM; nN = N / BM; nwg = nM * nN; G = G_; c = c_; ntk = K / BK; const int rem = nwg % G_; split = (split_ == 1 && rem > 0 && 2 * rem == G_ && ntk >= 8) ? 1 : 0; msplit = (split_ == 2 && rem > 0 && 2 * rem <= G_) ? 1 : 0; }
    __host__ __device__ bool next(int i, Unit& u) const {
        long L = (long)i * G + c; u.k0 = 0; u.nt = ntk; u.at = 0; u.slot = 0; u.msk = 3;
        if (msplit && i == nwg / G) { const int rem = nwg % G; if (c >= 2 * rem) return false; L = (long)i * G + (c % rem); u.msk = (c / rem) ? 2 : 1; }
        if (split && i == nwg / G) { const int rem = nwg % G, sl = c / rem, h0 = ((ntk / 2) + 1) & ~1; L = (long)i * G + (c % rem); u.k0 = sl ? h0 * BK : 0; u.nt = sl ? ntk - h0 : h0; u.at = sl ? 1 : 2; u.slot = c % rem; }
        if (L >= nwg) return false;
        int wgid = (int)L; { const int q = nwg / NXCD, r = nwg % NXCD, xcd = wgid % NXCD, off = wgid / NXCD; wgid = (xcd < r ? xcd * (q + 1) : r * (q + 1) + (xcd - r) * q) + off; }
        const int nig = WGM * nN, gid = wgid / nig, fm = gid * WGM, gsz = (nM - fm) < WGM ? (nM - fm) : WGM;
        u.pm = fm + ((wgid % nig) % gsz); u.pn = (wgid % nig) / gsz; return true;
    }
    __device__ __forceinline__ void a_ready(const Unit&) const {}
    __device__ __forceinline__ void done(const Unit&) const {}
};
__device__ __forceinline__ unsigned cvt_pk_bf16(float lo, float hi) { unsigned r; asm volatile("v_cvt_pk_bf16_f32 %0, %1, %2" : "=v"(r) : "v"(lo), "v"(hi)); return r; }
struct EpiF32 {
    static constexpr bool PERM = false, AFTER_DRAIN = false;
    float* C; int ldc; const float* bias;
    __device__ __forceinline__ void operator()(const f32x4 (&acc)[2][2][4][2], const Unit& u, int wr, int wc, int fr, int fq) const {
        const int row0 = u.pm * BM + wr * 64 + fr, col0 = u.pn * BM + wc * 32 + 4 * fq;
        f32x4 bv[2][2];
#pragma unroll
        for (int bj = 0; bj < 2; ++bj)
#pragma unroll
            for (int n = 0; n < 2; ++n) bv[bj][n] = bias ? *(const f32x4*)(bias + col0 + bj * HALF + n * 16) : (f32x4){0.f, 0.f, 0.f, 0.f};
#pragma unroll
        for (int ai = 0; ai < 2; ++ai)
#pragma unroll
            for (int m = 0; m < 4; ++m) { float* rowp = C + (size_t)(row0 + ai * HALF + m * 16) * ldc + col0;
#pragma unroll
                for (int bj = 0; bj < 2; ++bj)
#pragma unroll
                    for (int n = 0; n < 2; ++n) *(f32x4*)(rowp + bj * HALF + n * 16) = acc[ai][bj][m][n] + bv[bj][n]; }
    }
};

struct EpiSwiGLU {
    static constexpr bool PERM = true, AFTER_DRAIN = false;
    bf16_t* O; int ldc;
    __device__ __forceinline__ void operator()(const f32x4 (&acc)[2][2][4][2], const Unit& u, int wr, int wc, int fr, int fq) const {
        const int row0 = u.pm * BM + wr * 64 + fr, col0 = u.pn * 128 + wc * 32 + 8 * fq;
#pragma unroll
        for (int ai = 0; ai < 2; ++ai) if ((u.msk >> ai) & 1)
#pragma unroll
            for (int m = 0; m < 4; ++m) { bf16_t* rowp = O + (size_t)(row0 + ai * HALF + m * 16) * ldc + col0;
                const f32x4 g0 = acc[ai][0][m][0], g1 = acc[ai][0][m][1], u0 = acc[ai][1][m][0], u1 = acc[ai][1][m][1];
                float r[8];
#pragma unroll
                for (int j = 0; j < 4; ++j) {
                    r[j]     = g0[j] * __builtin_amdgcn_rcpf(1.0f + __builtin_amdgcn_exp2f(-1.4426950408889634f * g0[j])) * u0[j];
                    r[4 + j] = g1[j] * __builtin_amdgcn_rcpf(1.0f + __builtin_amdgcn_exp2f(-1.4426950408889634f * g1[j])) * u1[j]; }
                u32x4 w; w.x = cvt_pk_bf16(r[0], r[1]); w.y = cvt_pk_bf16(r[2], r[3]); w.z = cvt_pk_bf16(r[4], r[5]); w.w = cvt_pk_bf16(r[6], r[7]);
#if NT_STORES
                __builtin_nontemporal_store(w, (u32x4*)rowp);
#else
                *(u32x4*)rowp = w;
#endif
                }
    }
};
struct EpiSwiGLU8 {
    static constexpr bool PERM = true, AFTER_DRAIN = false;
    unsigned char* O; int ldc; float wscale;
    __device__ __forceinline__ void operator()(const f32x4 (&acc)[2][2][4][2], const Unit& u, int wr, int wc, int fr, int fq) const {
        const int row0 = u.pm * BM + wr * 64 + fr, col0 = u.pn * 128 + wc * 32 + 8 * fq;
#pragma unroll
        for (int ai = 0; ai < 2; ++ai) if ((u.msk >> ai) & 1)
#pragma unroll
            for (int m = 0; m < 4; ++m) { unsigned char* rowp = O + (size_t)(row0 + ai * HALF + m * 16) * ldc + col0;
                f32x4 g0 = acc[ai][0][m][0], g1 = acc[ai][0][m][1], u0 = acc[ai][1][m][0], u1 = acc[ai][1][m][1];
                asm volatile("" : "+v"(g0), "+v"(g1), "+v"(u0), "+v"(u1));
                g0 *= wscale; g1 *= wscale; u0 *= wscale; u1 *= wscale;
                float r[8];
#pragma unroll
                for (int j = 0; j < 4; ++j) {
                    r[j]     = g0[j] * __builtin_amdgcn_rcpf(1.0f + __builtin_amdgcn_exp2f(-1.4426950408889634f * g0[j])) * u0[j];
                    r[4 + j] = g1[j] * __builtin_amdgcn_rcpf(1.0f + __builtin_amdgcn_exp2f(-1.4426950408889634f * g1[j])) * u1[j]; }
                uint2 w; w.x = pack4_fp8(r[0], r[1], r[2], r[3]); w.y = pack4_fp8(r[4], r[5], r[6], r[7]);
                *(uint2*)rowp = w; asm volatile("" ::: "memory"); }
    }
};
struct EpiBf16Plain {
    static constexpr bool PERM = true, AFTER_DRAIN = false;
    bf16_t* O; int ldc;
    __device__ __forceinline__ void operator()(const f32x4 (&acc)[2][2][4][2], const Unit& u, int wr, int wc, int fr, int fq) const {
        const int row0 = u.pm * BM + wr * 64 + fr, col0 = u.pn * BM + wc * 32 + 8 * fq;
#pragma unroll
        for (int ai = 0; ai < 2; ++ai) if ((u.msk >> ai) & 1)
#pragma unroll
            for (int m = 0; m < 4; ++m) { bf16_t* rowp = O + (size_t)(row0 + ai * HALF + m * 16) * ldc + col0;
#pragma unroll
                for (int bj = 0; bj < 2; ++bj) { const f32x4 v0 = acc[ai][bj][m][0], v1 = acc[ai][bj][m][1];
                    u32x4 w; w.x = pack2(v0[0], v0[1]); w.y = pack2(v0[2], v0[3]); w.z = pack2(v1[0], v1[1]); w.w = pack2(v1[2], v1[3]);
                    *(u32x4*)(rowp + bj * HALF) = w; } }
    }
};
struct EpiResid {
    static constexpr bool PERM = false, AFTER_DRAIN = false;
    const float* res; float* out; int ldc; const float* gate0; float coef;
    float* slab; unsigned* flags; unsigned target;
    const float* res_hi; int row_hi;
    int res_bf16, out_bf16;
    __device__ __forceinline__ void operator()(const f32x4 (&acc)[2][2][4][2], const Unit& u, int wr, int wc, int fr, int fq) const {
        const int tidx = ((wr * 4 + wc) * 4 + fq) * 16 + fr;
        if (u.at == 1) {
            const __amdgpu_buffer_rsrc_t rs = __builtin_amdgcn_make_buffer_rsrc((void*)slab, 0, 0x7FFFFFF0, 0x00020000);
            const unsigned base = ((unsigned)u.slot * 32u * 512u + (unsigned)tidx) * 16u;
#pragma unroll
            for (int ai = 0; ai < 2; ++ai)
#pragma unroll
                for (int bj = 0; bj < 2; ++bj)
#pragma unroll
                    for (int m = 0; m < 4; ++m)
#pragma unroll
                        for (int n = 0; n < 2; ++n) { const f32x4 v = acc[ai][bj][m][n]; u32x4 w; w.x = __float_as_uint(v[0]); w.y = __float_as_uint(v[1]); w.z = __float_as_uint(v[2]); w.w = __float_as_uint(v[3]);
                            __builtin_amdgcn_raw_buffer_store_b128(w, rs, base + (unsigned)((((ai * 2 + bj) * 4 + m) * 2 + n) * 512 * 16), 0, 16); }
            asm volatile("s_waitcnt vmcnt(0)" ::: "memory");
            if ((tidx & 63) == 0) __hip_atomic_fetch_add(flags + 64 * u.slot, 1u, __ATOMIC_RELAXED, __HIP_MEMORY_SCOPE_AGENT);
            return;
        }
        const float* part = nullptr;
        if (u.at == 2) {
            unsigned spins = 0;
            while (__hip_atomic_load(flags + 64 * u.slot, __ATOMIC_RELAXED, __HIP_MEMORY_SCOPE_AGENT) < target) { __builtin_amdgcn_s_sleep(2); if (++spins > (1u << 22)) break; }
            __builtin_amdgcn_fence(__ATOMIC_ACQUIRE, "agent");
            asm volatile("s_waitcnt vmcnt(0)" ::: "memory");
            part = slab + ((size_t)u.slot * 32 * 512 + tidx) * 4;
        }
        const int row0 = u.pm * BM + wr * 64 + fr, col0 = u.pn * BM + wc * 32 + 4 * fq;
        const float* gate = gate0 + (size_t)cond_of_row(u.pm * BM) * NMOD;
        const float* rbase = (u.pm * BM >= row_hi) ? res_hi - (size_t)row_hi * ldc : res;
        f32x4 gv[2][2];
#pragma unroll
        for (int bj = 0; bj < 2; ++bj)
#pragma unroll
            for (int n = 0; n < 2; ++n) gv[bj][n] = *(const f32x4*)(gate + col0 + bj * HALF + n * 16) * coef;
#pragma unroll
        for (int ai = 0; ai < 2; ++ai) if ((u.msk >> ai) & 1) {
            f32x4 bs[4][2][2];
#pragma unroll
            for (int m = 0; m < 4; ++m) { const size_t off = (size_t)(row0 + ai * HALF + m * 16) * ldc + col0;
#pragma unroll
                for (int bj = 0; bj < 2; ++bj)
#pragma unroll
                    for (int n = 0; n < 2; ++n) {
                        const size_t eo = off + bj * HALF + n * 16;
                        if (res_bf16) { const u32x2 w = *(const u32x2*)((const bf16_t*)rbase + eo); bs[m][bj][n][0] = __uint_as_float(w.x << 16); bs[m][bj][n][1] = __uint_as_float(w.x & 0xFFFF0000u); bs[m][bj][n][2] = __uint_as_float(w.y << 16); bs[m][bj][n][3] = __uint_as_float(w.y & 0xFFFF0000u); }
                        else bs[m][bj][n] = *(const f32x4*)(rbase + eo); } }
            asm volatile("" ::: "memory");
#pragma unroll
            for (int m = 0; m < 4; ++m) { const size_t off = (size_t)(row0 + ai * HALF + m * 16) * ldc + col0;
#pragma unroll
                for (int bj = 0; bj < 2; ++bj)
#pragma unroll
                    for (int n = 0; n < 2; ++n) {
                        f32x4 a = acc[ai][bj][m][n];
                        if (part) a += *(const f32x4*)(part + (size_t)((((ai * 2 + bj) * 4 + m) * 2 + n) * 512 * 4));
                        const size_t eo = off + bj * HALF + n * 16;
                        const f32x4 o = bs[m][bj][n] + gv[bj][n] * a;
                        if (out_bf16) { u32x2 w; w.x = cvt_pk_bf16(o[0], o[1]); w.y = cvt_pk_bf16(o[2], o[3]); *(u32x2*)((bf16_t*)out + eo) = w; }
                        else *(f32x4*)(out + eo) = o; } }
            asm volatile("" ::: "memory"); }
    }
};
template <class Epi, class Sched, bool STAMP = false, int FP8 = 0>
__device__ __forceinline__ void gemm_phase(PG8_LAS unsigned char* lds, const Gemm g, const Sched& S, const Epi& E, unsigned long long* stamps) {
    const int tid = opaque_tid(), wid = __builtin_amdgcn_readfirstlane(tid >> 6), lane = tid & 63, wr = wid >> 2, wc = wid & 3, fr = lane & 15, fq = lane >> 4;
    const int K = g.K;
    int ts_lo = 0, ts_hi = 0, nts = 0; const unsigned long long rt_entry = STAMP ? (unsigned long long)wall_clock64() : 0ull;
#define PG8_STAMP() do { if (STAMP && wid == 0 && nts < 64) { const unsigned long long _c = (unsigned long long)clock64(); \
        ts_lo = (lane == nts) ? (int)(unsigned)_c : ts_lo; ts_hi = (lane == nts) ? (int)(unsigned)(_c >> 32) : ts_hi; ++nts; } } while (0)
    PG8_STAMP();
    unsigned voffA[2], voffB[2];
#pragma unroll
    for (int i = 0; i < 2; ++i) { int R, C; stage_rc(tid * 16 + i * 8192, R, C); const int Rb = Epi::PERM ? ((R & ~31) + perm32(R & 31)) : R;
        voffA[i] = (unsigned)(R * K + C) * 2u; voffB[i] = (unsigned)(Rb * K + C) * 2u; }
    const size_t kstep = (size_t)(BK * 2);
    const size_t hstep = (size_t)HALF * K * 2;
    const size_t tstep = 2 * hstep;
    const unsigned ldsw = (unsigned)wid * 1024u;
    const int aoff = lds_byte(wr * 64 + fr, fq * 8), boff = lds_byte(wc * 32 + fr, fq * 8);
#define PG8_SA(b, h) (((b) * 2 + (h)) * HTB)
#define PG8_SB(b, h) ((4 + (b) * 2 + (h)) * HTB)
#define PG8_STAGE(bufoff, gbase, voff) do { _Pragma("unroll") for (int _i = 0; _i < 2; ++_i) \
        __builtin_amdgcn_global_load_lds((const unsigned*)((const char*)(gbase) + (voff)[_i]), (PG8_LAS unsigned*)(lds + (bufoff) + ldsw + _i * 8192), 16, 0, 0); } while (0)
#define PG8_LDA(dst, b, h) do { _Pragma("unroll") for (int m = 0; m < 4; ++m) dst[m] = __builtin_shufflevector(*(const PG8_LAS v4i32*)(lds + PG8_SA(b, h) + aoff + m * 2048), *(const PG8_LAS v4i32*)(lds + PG8_SA(b, h) + aoff + m * 2048 + 1024), 0, 1, 2, 3, 4, 5, 6, 7); } while (0)
#define PG8_LDB(dst, b, h) do { _Pragma("unroll") for (int n = 0; n < 2; ++n) dst[n] = __builtin_shufflevector(*(const PG8_LAS v4i32*)(lds + PG8_SB(b, h) + boff + n * 2048), *(const PG8_LAS v4i32*)(lds + PG8_SB(b, h) + boff + n * 2048 + 1024), 0, 1, 2, 3, 4, 5, 6, 7); } while (0)
#define PG8_HALF(v, k) __builtin_bit_cast(bf16x8, __builtin_shufflevector(v, v, 4 * (k), 4 * (k) + 1, 4 * (k) + 2, 4 * (k) + 3))
#define PG8_MMA(ai, bj, At, Bt) do { __builtin_amdgcn_s_setprio(1); _Pragma("unroll") for (int m = 0; m < 4; ++m) _Pragma("unroll") for (int n = 0; n < 2; ++n) { \
        acc[ai][bj][m][n] = __builtin_amdgcn_mfma_f32_16x16x32_bf16(PG8_HALF(Bt[n], 0), PG8_HALF(At[m], 0), acc[ai][bj][m][n], 0, 0, 0); \
        acc[ai][bj][m][n] = __builtin_amdgcn_mfma_f32_16x16x32_bf16(PG8_HALF(Bt[n], 1), PG8_HALF(At[m], 1), acc[ai][bj][m][n], 0, 0, 0); } __builtin_amdgcn_s_setprio(0); } while (0)
#define PG8_MMA8(ai, bj, At, Bt) do { __builtin_amdgcn_s_setprio(1); _Pragma("unroll") for (int m = 0; m < 4; ++m) _Pragma("unroll") for (int n = 0; n < 2; ++n) \
        acc[ai][bj][m][n] = __builtin_amdgcn_mfma_scale_f32_16x16x128_f8f6f4(Bt[n], At[m], acc[ai][bj][m][n], 0, 0, 0, 127, 0, 127); __builtin_amdgcn_s_setprio(0); } while (0)
#define PG8_Q64(v, q) __builtin_bit_cast(long, __builtin_shufflevector(v, v, 2 * (q), 2 * (q) + 1))
#define PG8_M8L1(ai, bj, m, n, q) acc[ai][bj][m][n] = __builtin_amdgcn_mfma_f32_16x16x32_fp8_fp8(PG8_Q64(Bt_[n], q), PG8_Q64(At_[m], q), acc[ai][bj][m][n], 0, 0, 0)
#define PG8_MMA8L(ai, bj, At, Bt) do { auto& At_ = At; auto& Bt_ = Bt; __builtin_amdgcn_s_setprio(1); _Pragma("unroll") for (int m = 0; m < 4; ++m) _Pragma("unroll") for (int n = 0; n < 2; ++n) { \
        PG8_M8L1(ai, bj, m, n, 0); PG8_M8L1(ai, bj, m, n, 1); PG8_M8L1(ai, bj, m, n, 2); PG8_M8L1(ai, bj, m, n, 3); } __builtin_amdgcn_s_setprio(0); } while (0)
#define PG8_MMAG(ai, bj, At, Bt) do { if (mrow & (1 << (ai))) { if constexpr (FP8 == 1) PG8_MMA8(ai, bj, At, Bt); else if constexpr (FP8 == 2) PG8_MMA8L(ai, bj, At, Bt); else PG8_MMA(ai, bj, At, Bt); } } while (0)
#define PG8_WAIT_V(n) asm volatile("s_waitcnt vmcnt(" #n ")" ::: "memory")
#define PG8_WAIT_L(n) asm volatile("s_waitcnt lgkmcnt(" #n ")" ::: "memory")
#define PG8_BAR __builtin_amdgcn_s_barrier()
#define PG8_SCHED __builtin_amdgcn_sched_barrier(0)
    Unit cur, nxt; int ui = 0;
    if (!S.next(0, cur)) return;
    f32x4 acc[2][2][4][2];
#pragma unroll
    for (int a = 0; a < 2; ++a)
#pragma unroll
        for (int b = 0; b < 2; ++b)
#pragma unroll
            for (int m = 0; m < 4; ++m)
#pragma unroll
                for (int n = 0; n < 2; ++n) acc[a][b][m][n] = (f32x4){0.f, 0.f, 0.f, 0.f};
    v8i32 At[4], B0[2], B1[2];
    const char* cA = (const char*)g.A + (size_t)cur.pm * tstep + (size_t)cur.k0 * 2; const char* cB = (const char*)g.Bt + (size_t)cur.pn * tstep + (size_t)cur.k0 * 2;
    S.a_ready(cur);
    PG8_STAGE(PG8_SB(0, 0), cB, voffB); PG8_STAGE(PG8_SA(0, 0), cA, voffA); PG8_STAGE(PG8_SB(0, 1), cB + hstep, voffB); PG8_STAGE(PG8_SA(0, 1), cA + hstep, voffA);
    if (wr == 1) PG8_BAR;
    PG8_WAIT_V(4); PG8_BAR;
    PG8_STAGE(PG8_SB(1, 0), cB + kstep, voffB); PG8_STAGE(PG8_SA(1, 0), cA + kstep, voffA); PG8_STAGE(PG8_SB(1, 1), cB + hstep + kstep, voffB);
    PG8_WAIT_V(6); PG8_BAR;
    PG8_STAMP();
    for (;;) {
        const bool has_next = S.next(ui + 1, nxt);
        const char* nA = has_next ? (const char*)g.A + (size_t)nxt.pm * tstep + (size_t)nxt.k0 * 2 : cA; const char* nB = has_next ? (const char*)g.Bt + (size_t)nxt.pn * tstep + (size_t)nxt.k0 * 2 : cB;
        const int nt = cur.nt, mrow = cur.msk;
        for (int t = 0; t < nt; t += 2) {
            const bool last = (t == nt - 2);
            const char* a1 = cA + (size_t)(t + 1) * kstep;
            const char* a2 = last ? nA : cA + (size_t)(t + 2) * kstep; const char* b2 = last ? nB : cB + (size_t)(t + 2) * kstep;
            const char* a3 = a2 + kstep; const char* b3 = b2 + kstep;
            if (last && has_next) S.a_ready(nxt);
            PG8_LDB(B0, 0, 0); PG8_SCHED; PG8_LDA(At, 0, 0); PG8_STAGE(PG8_SA(1, 1), a1 + hstep, voffA);
            PG8_WAIT_L(8); PG8_BAR; PG8_WAIT_L(0); PG8_MMAG(0, 0, At, B0); PG8_BAR; PG8_SCHED;
            PG8_LDB(B1, 0, 1); PG8_STAGE(PG8_SB(0, 0), b2, voffB);
            PG8_BAR; PG8_WAIT_L(0); PG8_MMAG(0, 1, At, B1); PG8_BAR;
            PG8_LDA(At, 0, 1); PG8_STAGE(PG8_SA(0, 0), a2, voffA);
            PG8_BAR; PG8_WAIT_L(0); PG8_MMAG(1, 0, At, B0); PG8_BAR; PG8_SCHED;
            PG8_STAGE(PG8_SB(0, 1), b2 + hstep, voffB);
            PG8_WAIT_V(6); PG8_BAR; PG8_MMAG(1, 1, At, B1); PG8_BAR;
            PG8_LDB(B0, 1, 0); PG8_SCHED; PG8_LDA(At, 1, 0); PG8_STAGE(PG8_SA(0, 1), a2 + hstep, voffA);
            PG8_WAIT_L(8); PG8_BAR; PG8_WAIT_L(0); PG8_MMAG(0, 0, At, B0); PG8_BAR; PG8_SCHED;
            PG8_LDB(B1, 1, 1); PG8_STAGE(PG8_SB(1, 0), b3, voffB);
            PG8_BAR; PG8_WAIT_L(0); PG8_MMAG(0, 1, At, B1); PG8_BAR;
            PG8_LDA(At, 1, 1); PG8_STAGE(PG8_SA(1, 0), a3, voffA);
            PG8_BAR; PG8_WAIT_L(0); PG8_MMAG(1, 0, At, B0); PG8_BAR; PG8_SCHED;
            PG8_STAGE(PG8_SB(1, 1), b3 + hstep, voffB);
            PG8_WAIT_V(6); PG8_BAR; PG8_MMAG(1, 1, At, B1); PG8_BAR;
        }
        PG8_STAMP();
        if constexpr (!Epi::AFTER_DRAIN) { E(acc, cur, wr, wc, fr, fq); S.done(cur); }
        PG8_STAMP();
        if (!has_next) break;
#pragma unroll
        for (int a = 0; a < 2; ++a)
#pragma unroll
            for (int b = 0; b < 2; ++b)
#pragma unroll
                for (int m = 0; m < 4; ++m)
#pragma unroll
                    for (int n = 0; n < 2; ++n) acc[a][b][m][n] = (f32x4){0.f, 0.f, 0.f, 0.f};
        cur = nxt; cA = nA; cB = nB; ++ui;
    }
    PG8_WAIT_V(0);
    if (wr == 0) PG8_BAR;
    PG8_BAR;
    if constexpr (Epi::AFTER_DRAIN) { E.fused(acc, cur, wr, wc, fr, fq, lds, wid, lane); S.done(cur); }
    PG8_STAMP();
    if (STAMP && wid == 0) { stamps[lane] = lane < nts ? (((unsigned long long)(unsigned)ts_hi << 32) | (unsigned)ts_lo) : 0ull;
        if (lane == 62) stamps[62] = rt_entry; if (lane == 63) stamps[63] = (unsigned long long)wall_clock64(); }
#undef PG8_STAMP
#undef PG8_SA
#undef PG8_SB
#undef PG8_STAGE
#undef PG8_LDA
#undef PG8_LDB
#undef PG8_HALF
#undef PG8_MMA
#undef PG8_MMA8
#undef PG8_MMA8L
#undef PG8_M8L1
#undef PG8_Q64
#undef PG8_MMAG
#undef PG8_WAIT_V
#undef PG8_WAIT_L
#undef PG8_BAR
#undef PG8_SCHED
}
}
#ifndef ATT_INLINE
#define ATT_INLINE __forceinline__
#endif
namespace att {
constexpr int D = 128, NW = 8, QBLK = 32, KVBLK = 64, LDQ = 512, LDO = DM;
constexpr float SCALE = 0.088388347648318440f;
constexpr float THR = 8.f;
constexpr size_t SHM_V = KVBLK * D * 2, SHM_K = KVBLK * D * 2, SHM_Q = 256 * D * 2, SHM_ATTN = 2 * SHM_V + 2 * SHM_K + NW * 64 * 4 + SHM_Q;
using bf16x8 = __attribute__((ext_vector_type(8))) short;
using s16x4  = __attribute__((ext_vector_type(4))) short;
using f32x16 = __attribute__((ext_vector_type(16))) float;
using u32x4  = __attribute__((ext_vector_type(4))) unsigned;
#define KSWZ(row, colB) ((row) * 256 + ((colB) ^ (((row) & 7) << 4)))
#define SBAR() __builtin_amdgcn_sched_barrier(0)
__device__ __forceinline__ int crow(int r, int hi) { return (r & 3) + 8 * (r >> 2) + 4 * hi; }
__device__ __forceinline__ unsigned cvtpk(float lo, float hi) { unsigned r; asm volatile("v_cvt_pk_bf16_f32 %0, %1, %2" : "=v"(r) : "v"(lo), "v"(hi)); return r; }

__device__ __forceinline__ void partialSM(f32x16& p0, f32x16& p1, float& m_reg, float& mn, float& alpha) {
  constexpr float C = SCALE * 1.4426950408889634f;
  float pmax = p0[0]; for (int r = 1; r < 16; ++r) pmax = fmaxf(pmax, p0[r]); for (int r = 0; r < 16; ++r) pmax = fmaxf(pmax, p1[r]);
  { auto rr = __builtin_amdgcn_permlane32_swap(__float_as_uint(pmax), __float_as_uint(pmax), false, false);
    pmax = fmaxf(__uint_as_float(rr[0]), __uint_as_float(rr[1])); }
  if (__builtin_expect(__all(pmax - m_reg <= THR / SCALE), 1)) { mn = m_reg; alpha = 1.f; }
  else { mn = fmaxf(m_reg, pmax); alpha = __builtin_amdgcn_exp2f((m_reg - mn) * C); m_reg = mn; }
  float mnC = -mn * C;
  for (int r = 0; r < 16; ++r) p0[r] = fmaf(p0[r], C, mnC); for (int r = 0; r < 16; ++r) p1[r] = fmaf(p1[r], C, mnC);
  for (int r = 0; r < 16; ++r) p0[r] = __builtin_amdgcn_exp2f(p0[r]);
}
__device__ __forceinline__ void finishSM(f32x16& p0, f32x16& p1, float alpha, float& l_reg, bf16x8& pa0, bf16x8& pa1, bf16x8& pa2, bf16x8& pa3) {
  for (int r = 0; r < 16; ++r) p1[r] = __builtin_amdgcn_exp2f(p1[r]);
  float ps = 0; for (int r = 0; r < 16; ++r) ps += p0[r]; for (int r = 0; r < 16; ++r) ps += p1[r];
  { auto rr = __builtin_amdgcn_permlane32_swap(__float_as_uint(ps), __float_as_uint(ps), false, false);
    ps = __uint_as_float(rr[0]) + __uint_as_float(rr[1]); }
  l_reg = l_reg * alpha + ps;
#define PK4(P, BASE, OUT) do { unsigned a0 = cvtpk(P[BASE + 0], P[BASE + 1]), a1 = cvtpk(P[BASE + 2], P[BASE + 3]);   \
    unsigned b0 = cvtpk(P[BASE + 4], P[BASE + 5]), b1 = cvtpk(P[BASE + 6], P[BASE + 7]);                              \
    auto r0 = __builtin_amdgcn_permlane32_swap(a0, b0, false, false); auto r1 = __builtin_amdgcn_permlane32_swap(a1, b1, false, false); \
    u32x4 w = {r0[0], r1[0], r0[1], r1[1]}; OUT = *reinterpret_cast<bf16x8*>(&w); } while (0)
  PK4(p0, 0, pa0); PK4(p0, 8, pa1); PK4(p1, 0, pa2); PK4(p1, 8, pa3);
#undef PK4
}
__device__ __forceinline__ void qkt(f32x16& p0, f32x16& p1, const bf16_t* Ks, const bf16_t* Qs, int qrow, int r32, int hi) {
  p0 = f32x16{}; p1 = f32x16{};
#pragma unroll
  for (int d0 = 0; d0 < 8; ++d0) { int cb = (d0 * 16 + hi * 8) * 2;
    bf16x8 q = *reinterpret_cast<const bf16x8*>((const char*)Qs + KSWZ(qrow, cb));
    bf16x8 b0 = *reinterpret_cast<const bf16x8*>((const char*)Ks + KSWZ(r32, cb));
    bf16x8 b1 = *reinterpret_cast<const bf16x8*>((const char*)Ks + KSWZ(32 + r32, cb));
    p0 = __builtin_amdgcn_mfma_f32_32x32x16_bf16(b0, q, p0, 0, 0, 0);
    p1 = __builtin_amdgcn_mfma_f32_32x32x16_bf16(b1, q, p1, 0, 0, 0); }
}
__device__ __forceinline__ int v_st(int k, int c) { const int kk = (k & ~0xC) | ((k & 4) << 1) | ((k & 8) >> 1); return ((kk >> 3) * 4 + (c >> 5)) * 512 + ((kk & 7) * 32 + (c & 31)) * 2; }
__device__ __forceinline__ int v_rd_base(int lane) { return ((lane & 3) << 3) | (((lane >> 2) & 3) << 6) | (((lane >> 4) & 1) << 5) | (((lane >> 5) & 1) << 8); }
constexpr int v_rd_off(int d0, int ks, int half) { return d0 * 512 + ks * 4096 + half * 2048; }
template <int OFF> __device__ __forceinline__ s16x4 tr_read(int vb) {
  s16x4 r; asm volatile("ds_read_b64_tr_b16 %0, %1 offset:%2" : "=&v"(r) : "v"(vb), "i"(OFF) : "memory"); return r;
}
template <int D0> __device__ __forceinline__ void pv_one(f32x16& od, int vb, bf16x8 pa0, bf16x8 pa1, bf16x8 pa2, bf16x8 pa3) {
  const s16x4 l0 = tr_read<v_rd_off(D0, 0, 0)>(vb), h0 = tr_read<v_rd_off(D0, 0, 1)>(vb), l1 = tr_read<v_rd_off(D0, 1, 0)>(vb), h1 = tr_read<v_rd_off(D0, 1, 1)>(vb);
  const s16x4 l2 = tr_read<v_rd_off(D0, 2, 0)>(vb), h2 = tr_read<v_rd_off(D0, 2, 1)>(vb), l3 = tr_read<v_rd_off(D0, 3, 0)>(vb), h3 = tr_read<v_rd_off(D0, 3, 1)>(vb);
  asm volatile("s_waitcnt lgkmcnt(0)" ::: "memory"); SBAR();
#define PK(L, H) (bf16x8){L[0], L[1], L[2], L[3], H[0], H[1], H[2], H[3]}
  od = __builtin_amdgcn_mfma_f32_32x32x16_bf16(pa0, PK(l0, h0), od, 0, 0, 0);
  od = __builtin_amdgcn_mfma_f32_32x32x16_bf16(pa1, PK(l1, h1), od, 0, 0, 0);
  od = __builtin_amdgcn_mfma_f32_32x32x16_bf16(pa2, PK(l2, h2), od, 0, 0, 0);
  od = __builtin_amdgcn_mfma_f32_32x32x16_bf16(pa3, PK(l3, h3), od, 0, 0, 0);
#undef PK
}
__device__ __forceinline__ void pv_d0(f32x16* o, int vb, bf16x8 pa0, bf16x8 pa1, bf16x8 pa2, bf16x8 pa3) {
  pv_one<0>(o[0], vb, pa0, pa1, pa2, pa3); pv_one<1>(o[1], vb, pa0, pa1, pa2, pa3); pv_one<2>(o[2], vb, pa0, pa1, pa2, pa3); pv_one<3>(o[3], vb, pa0, pa1, pa2, pa3);
}

struct SrcOne { const bf16_t* k0; const bf16_t* v0; int ldk;
  __device__ __forceinline__ const bf16_t* k(int j) const { return k0 + (size_t)j * 64 * ldk; }
  __device__ __forceinline__ const bf16_t* v(int j) const { return v0 + (size_t)j * 64 * ldk; } };
struct SrcTwo { const bf16_t* ck; const bf16_t* cv; const bf16_t* k1; const bf16_t* v1; int ldk;
  __device__ __forceinline__ const bf16_t* k(int j) const { return j < 4 ? ck + (size_t)j * 64 * ldk : k1 + (size_t)(j - 4) * 64 * ldk; }
  __device__ __forceinline__ const bf16_t* v(int j) const { return j < 4 ? cv + (size_t)j * 64 * ldk : v1 + (size_t)(j - 4) * 64 * ldk; } };
struct NoBias { __device__ __forceinline__ void operator()(f32x16&, f32x16&, int, int, int, int) const {} };
struct NaBias { const float* tab; int i0, kr0;
  __device__ __forceinline__ void operator()(f32x16& p0, f32x16& p1, int jt, int wid, int r32, int hi) const {
    if (jt < 4) return;
    const int qi = i0 + wid * QBLK + r32, r = qi >> 6, qc = qi & 63, kr = kr0 + jt - 4;
    int lo = r - 4; lo = lo < 0 ? 0 : (lo > 8 ? 8 : lo);
    const bool rowok = (kr >= lo) && (kr < lo + 8);
    if (!rowok) {
#pragma unroll
      for (int rr = 0; rr < 16; ++rr) { p0[rr] = -1e30f; p1[rr] = -1e30f; }
      return;
    }
    int c0 = qc - 8; c0 = c0 < 0 ? 0 : (c0 > 48 ? 48 : c0);
    const int dr = kr - r + 7;
    const float* tb = tab + dr * 31 + (4 * hi - qc + 15);
    const int w0 = 4 * hi - c0;
#pragma unroll
    for (int g = 0; g < 4; ++g) {
#pragma unroll
      for (int q = 0; q < 4; ++q) {
        const int rr = 4 * g + q, kc0 = q + 8 * g;
        const float t0 = tb[kc0], t1 = tb[kc0 + 32];
        p0[rr] = ((unsigned)(kc0 + w0) < 16u) ? p0[rr] + t0 : -1e30f;
        p1[rr] = ((unsigned)(kc0 + 32 + w0) < 16u) ? p1[rr] + t1 : -1e30f;
      }
      SBAR();
    }
  } };

template <int SD, class Src, class Bias>
__device__ ATT_INLINE void attn_body(const bf16_t* __restrict__ Qb, const Src src, bf16_t* __restrict__ Ob, const int NT, char* lds, const Bias bias) {
  const int tid = opaque_tid(), wid = tid >> 6, lane = tid & 63, r32 = lane & 31, hi = lane >> 5;
  const int LDK = src.ldk;
  bf16_t* V_lds = (bf16_t*)lds; bf16_t* K_lds = (bf16_t*)(lds + 2 * SHM_V);
  float* ws = (float*)(lds + 2 * SHM_V + 2 * SHM_K) + wid * 64; float* li_l = ws; float* al_l = ws + 32;
  float m_reg = -1e30f, l_reg = 0; f32x16 o[4] = {};
  bf16_t* Q_lds = (bf16_t*)(lds + 2 * SHM_V + 2 * SHM_K + NW * 64 * 4);
  const int qrow = wid * QBLK + r32;
  {
#pragma unroll
    for (int i = 0; i < 8; ++i) { const int f = tid + 512 * i, row = f >> 4, c8 = (f & 15) * 8;
      *(bf16x8*)((char*)Q_lds + KSWZ(row, c8 * 2)) = *reinterpret_cast<const bf16x8*>(Qb + (long)row * LDQ + c8); }
  }
  const int sr = tid >> 4, sc = (tid & 15) * 8, vst0 = v_st(sr, sc), vst1 = v_st(32 + sr, sc);
  const int vb0 = (int)(uintptr_t)V_lds + v_rd_base(lane);
  struct { bf16x8 vs0, vs1, ks0, ks1; } sr_[SD];
#define SLOAD(i, jt) do { const bf16_t* kt_ = src.k(jt); const bf16_t* vt_ = src.v(jt); \
    sr_[i].vs0 = *reinterpret_cast<const bf16x8*>(&vt_[(long)sr * LDK + sc]); sr_[i].vs1 = *reinterpret_cast<const bf16x8*>(&vt_[(long)(32 + sr) * LDK + sc]); \
    sr_[i].ks0 = *reinterpret_cast<const bf16x8*>(&kt_[(long)sr * LDK + sc]); sr_[i].ks1 = *reinterpret_cast<const bf16x8*>(&kt_[(long)(32 + sr) * LDK + sc]); } while (0)
#define SWRITE(b, i) do { *(bf16x8*)((char*)V_lds + (b) * SHM_V + vst0) = sr_[i].vs0;          \
    *(bf16x8*)((char*)V_lds + (b) * SHM_V + vst1) = sr_[i].vs1; int kc = sc * 2;               \
    *(bf16x8*)((char*)K_lds + (b) * SHM_K + KSWZ(sr, kc)) = sr_[i].ks0;                       \
    *(bf16x8*)((char*)K_lds + (b) * SHM_K + KSWZ(32 + sr, kc)) = sr_[i].ks1; } while (0)
#define SWAIT() do { if constexpr (SD == 2) asm volatile("s_waitcnt vmcnt(4)" ::: "memory"); else asm volatile("s_waitcnt vmcnt(0)" ::: "memory"); } while (0)
#define RESC(a) do { if (__any((a) < 1.f)) { if (hi == 0) al_l[r32] = (a); asm volatile("s_waitcnt lgkmcnt(0)" ::: "memory"); \
    for (int d = 0; d < 4; ++d) for (int r = 0; r < 16; ++r) o[d][r] *= al_l[crow(r, hi)]; } } while (0)
  f32x16 pA0, pA1, pB0, pB1; float mnA, mnB, alA, alB; bf16x8 pa0, pa1, pa2, pa3;
  constexpr int SE = 0, SO = SD - 1;
  SLOAD(SE, 0); asm volatile("s_waitcnt vmcnt(0)" ::: "memory"); SWRITE(0, SE); __syncthreads();
  qkt(pA0, pA1, K_lds, Q_lds, qrow, r32, hi); bias(pA0, pA1, 0, wid, r32, hi); partialSM(pA0, pA1, m_reg, mnA, alA);
  SLOAD(SO, 1); if constexpr (SD == 2) { if (2 < NT) SLOAD(SE, 2); }
  SWAIT(); SWRITE(1, SO); __syncthreads();
  for (int j = 1; j + 1 < NT; j += 2) {
    SBAR(); qkt(pB0, pB1, (bf16_t*)((char*)K_lds + SHM_K), Q_lds, qrow, r32, hi); bias(pB0, pB1, j, wid, r32, hi);
    finishSM(pA0, pA1, alA, l_reg, pa0, pa1, pa2, pa3); SBAR();
    SLOAD(SO, j + SD); SBAR();
    pv_d0(o, vb0, pa0, pa1, pa2, pa3); partialSM(pB0, pB1, m_reg, mnB, alB);
    __syncthreads(); SWAIT(); SWRITE(0, SE);
    RESC(alB); __syncthreads();
    SBAR(); qkt(pA0, pA1, K_lds, Q_lds, qrow, r32, hi); bias(pA0, pA1, j + 1, wid, r32, hi);
    finishSM(pB0, pB1, alB, l_reg, pa0, pa1, pa2, pa3); SBAR();
    if (SD == 1 || j + 3 < NT) SLOAD(SE, j + 1 + SD); SBAR();
    pv_d0(o, vb0 + (int)SHM_V, pa0, pa1, pa2, pa3); partialSM(pA0, pA1, m_reg, mnA, alA);
    __syncthreads(); SWAIT(); SWRITE(1, SO);
    RESC(alA); __syncthreads();
  }
  SBAR(); qkt(pB0, pB1, (bf16_t*)((char*)K_lds + SHM_K), Q_lds, qrow, r32, hi); bias(pB0, pB1, NT - 1, wid, r32, hi);
  finishSM(pA0, pA1, alA, l_reg, pa0, pa1, pa2, pa3); SBAR();
  pv_d0(o, vb0, pa0, pa1, pa2, pa3); partialSM(pB0, pB1, m_reg, mnB, alB);
  __syncthreads(); RESC(alB);
  finishSM(pB0, pB1, alB, l_reg, pa0, pa1, pa2, pa3); SBAR();
  pv_d0(o, vb0 + (int)SHM_V, pa0, pa1, pa2, pa3);
  if (hi == 0) li_l[r32] = l_reg; asm volatile("s_waitcnt lgkmcnt(0)" ::: "memory");
  float rli[16];
#pragma unroll
  for (int r = 0; r < 16; ++r) rli[r] = __builtin_amdgcn_rcpf(li_l[crow(r, hi)]);
  bf16_t* Ow = Ob + (long)(wid * QBLK) * LDO;
#pragma unroll
  for (int r = 0; r < 16; ++r) { int orow = crow(r, hi);
    for (int d0 = 0; d0 < 4; ++d0) Ow[(long)orow * LDO + d0 * 32 + r32] = f2bf(o[d0][r] * rli[r]); }
#undef SLOAD
#undef SWRITE
#undef SWAIT
#undef RESC
}
}
#define H16(w, j) ((bf16_t)(((j) & 1) ? ((j) < 2 ? (w).x >> 16 : (w).y >> 16) : ((j) < 2 ? (w).x & 0xFFFFu : (w).y & 0xFFFFu)))
#define DPPU(v, ctrl, rmask) __int_as_float(__builtin_amdgcn_update_dpp(0, __float_as_int(v), (ctrl), (rmask), 0xF, false))
__device__ __forceinline__ float scan32(float x) { x += DPPU(x, 0x111, 0xF); x += DPPU(x, 0x112, 0xF); x += DPPU(x, 0x114, 0xF); x += DPPU(x, 0x118, 0xF); x += DPPU(x, 0x142, 0xA); return x; }
__device__ __forceinline__ float last32(float x, int lane) { const float a = __int_as_float(__builtin_amdgcn_readlane(__float_as_int(x), 31)), b = __int_as_float(__builtin_amdgcn_readlane(__float_as_int(x), 63)); return lane < 32 ? a : b; }
namespace gdn {
using att::bf16x8; using att::f32x16; using att::crow;
constexpr int C = 32, SK = 136, SS = 40;
constexpr int OFF_KT = 0, OFF_QT = OFF_KT + C * SK * 2, OFF_W = OFF_QT + C * SK * 2, OFF_KTT = OFF_W + C * SK * 2, OFF_VTT = OFF_KTT + 128 * SS * 2,
              OFF_VN = OFF_VTT + 128 * SS * 2, OFF_VNS = OFF_VN + 128 * SS * 2, OFF_ST = OFF_VNS + 128 * SS * 2, OFF_TB = OFF_ST + 128 * SK * 2,
              OFF_TBE = OFF_TB + C * SS * 2, OFF_ATT = OFF_TBE + C * SS * 2, OFF_L = OFF_ATT + C * SS * 2, OFF_SC = OFF_L + C * C * 4, GDN_LDS = OFF_SC + 1024;
template <int K>
__device__ __forceinline__ f32x16 mm(const bf16_t* A, int lda, const bf16_t* Bt, int ldb, int l32, int hi, f32x16 acc) {
#pragma unroll
    for (int k0 = 0; k0 < K; k0 += 16) {
        const bf16x8 a = *reinterpret_cast<const bf16x8*>(A + l32 * lda + k0 + 8 * hi);
        const bf16x8 b = *reinterpret_cast<const bf16x8*>(Bt + l32 * ldb + k0 + 8 * hi);
        acc = __builtin_amdgcn_mfma_f32_32x32x16_bf16(a, b, acc, 0, 0, 0);
    }
    return acc;
}
__device__ __forceinline__ uint2 pk4(float a, float b, float c, float d) { uint2 w; w.x = pack2(a, b); w.y = pack2(c, d); return w; }

__device__ __forceinline__ void gdn_chunked(const Params& p, int l, bool ctx, int b, int h, int dir, unsigned char* lds) {
    const int tid = opaque_tid(), wid = tid >> 6, lane = tid & 63, l32 = lane & 31, hi = lane >> 5;
    const int T = ctx ? CT : ::LT; const size_t m0 = ctx ? (size_t)b * CT : (size_t)MC + (size_t)b * ::LT;
    const bf16_t* DQ = WSP(bf16_t, WS_DQ); const bf16_t* DK = WSP(bf16_t, WS_DK); const bf16_t* DV = WSP(bf16_t, WS_DV); const float* DBA = WSP(float, WS_DBA);
    float* O = WSP(float, dir ? WS_DOB : WS_DOF);
    bf16_t* Kt = (bf16_t*)(lds + OFF_KT); bf16_t* Qt = (bf16_t*)(lds + OFF_QT); bf16_t* W = (bf16_t*)(lds + OFF_W); bf16_t* KT = (bf16_t*)(lds + OFF_KTT); bf16_t* VT = (bf16_t*)(lds + OFF_VTT);
    bf16_t* VN = (bf16_t*)(lds + OFF_VN); bf16_t* VNS = (bf16_t*)(lds + OFF_VNS); bf16_t* ST = (bf16_t*)(lds + OFF_ST); bf16_t* TB = (bf16_t*)(lds + OFF_TB); bf16_t* TBE = (bf16_t*)(lds + OFF_TBE);
    bf16_t* ATT = (bf16_t*)(lds + OFF_ATT); float* Lm = (float*)(lds + OFF_L); float* sc = (float*)(lds + OFF_SC);
    const int nch = T / C;
#define TOK(c, s_) (m0 + (dir ? T - 1 - ((c) * C + (s_)) : (c) * C + (s_)))
    f32x16 S[2];
#pragma unroll
    for (int bi = 0; bi < 2; ++bi) {
        const int blk = wid * 2 + bi, d0 = 32 * (blk >> 2), e0 = 32 * (blk & 3);
        if (ctx) { S[bi] = f32x16{}; }
        else {
            const float* s0 = p.in[I_SGDN] + ((((size_t)b * DEPTH + l) * 2 + dir) * 4 + h) * 128 * 128 + e0 + l32;
#pragma unroll
            for (int r = 0; r < 16; ++r) S[bi][r] = s0[(size_t)(d0 + crow(r, hi)) * 128];
        }
    }
    const int ts = tid & 31, c0 = (tid >> 5) * 4, c1 = 64 + c0;
    uint2 rq0, rq1, rk0, rk1, rv0, rv1; float pbeta = 0.f, pg = 0.f;
#define GLOAD(c) do { const size_t mt_ = TOK(c, ts); \
        rq0 = *(const uint2*)(DQ + mt_ * 512 + h * 128 + c0); rq1 = *(const uint2*)(DQ + mt_ * 512 + h * 128 + c1); \
        rk0 = *(const uint2*)(DK + mt_ * 512 + h * 128 + c0); rk1 = *(const uint2*)(DK + mt_ * 512 + h * 128 + c1); \
        rv0 = *(const uint2*)(DV + mt_ * 512 + h * 128 + c0); rv1 = *(const uint2*)(DV + mt_ * 512 + h * 128 + c1); \
        if (tid < C) { const size_t mt = TOK(c, tid); pbeta = DBA[mt * 16 + dir * 4 + h]; pg = DBA[mt * 16 + 8 + dir * 4 + h]; } } while (0)
#define GSTAGE() do { \
        *(uint2*)(Kt + ts * SK + c0) = rk0; *(uint2*)(Kt + ts * SK + c1) = rk1; \
        *(uint2*)(Qt + ts * SK + c0) = rq0; *(uint2*)(Qt + ts * SK + c1) = rq1; \
        _Pragma("unroll") for (int j = 0; j < 4; ++j) { KT[(c0 + j) * SS + ts] = H16(rk0, j); KT[(c1 + j) * SS + ts] = H16(rk1, j); \
                                                        VT[(c0 + j) * SS + ts] = H16(rv0, j); VT[(c1 + j) * SS + ts] = H16(rv1, j); } \
        if (wid == 0) { float x = pg; _Pragma("unroll") for (int o_ = 1; o_ < 32; o_ <<= 1) { const float y = __shfl_up(x, o_); if (lane >= o_) x += y; } \
            const float Bt_ = __shfl(x, 31); if (lane < C) { sc[lane] = pbeta; sc[32 + lane] = x; sc[64 + lane] = __expf(x); sc[96 + lane] = __expf(Bt_ - x); if (lane == 0) sc[128] = __expf(Bt_); } } } while (0)
    __syncthreads();
    GLOAD(0);
#pragma unroll
    for (int bi = 0; bi < 2; ++bi) {
        const int blk = wid * 2 + bi, d0 = 32 * (blk >> 2), e0 = 32 * (blk & 3);
#pragma unroll
        for (int g = 0; g < 4; ++g) *(uint2*)(ST + (e0 + l32) * SK + d0 + 8 * g + 4 * hi) = pk4(S[bi][4 * g], S[bi][4 * g + 1], S[bi][4 * g + 2], S[bi][4 * g + 3]);
    }
    GSTAGE();
    __syncthreads();
    for (int c = 0; c < nch; ++c) {
        if (c + 1 < nch) GLOAD(c + 1);
        f32x16 acc1 = f32x16{};
        if (wid == 0) {
            const f32x16 kk = mm<128>(Kt, SK, Kt, SK, l32, hi, f32x16{});
            const float bi_ = sc[32 + l32], be = sc[l32];
#pragma unroll
            for (int r = 0; r < 16; ++r) { const int j = crow(r, hi); const float v = (l32 > j) ? be * kk[r] * __expf(bi_ - sc[32 + j]) : 0.f;
                Lm[l32 * 32 + ((((r & 3) + 4 * hi) ^ (l32 & 7)) * 4) + (r >> 2)] = v; }
        } else if (wid == 1) {
            const f32x16 kq = mm<128>(Kt, SK, Qt, SK, l32, hi, f32x16{});
            const float bi_ = sc[32 + l32];
            float a[16];
#pragma unroll
            for (int r = 0; r < 16; ++r) { const int j = crow(r, hi); a[r] = (l32 >= j) ? kq[r] * __expf(bi_ - sc[32 + j]) : 0.f; }
#pragma unroll
            for (int g = 0; g < 4; ++g) *(uint2*)(ATT + l32 * SS + 8 * g + 4 * hi) = pk4(a[4 * g], a[4 * g + 1], a[4 * g + 2], a[4 * g + 3]);
        } else if (wid >= 4) {
            acc1 = mm<128>(Qt, SK, ST + (32 * (wid - 4)) * SK, SK, l32, hi, f32x16{});
#pragma unroll
            for (int r = 0; r < 16; ++r) acc1[r] *= sc[64 + crow(r, hi)];
        }
        __syncthreads();
        if (tid < 256) {
            const int cc = tid >> 3, part = tid & 7;
            float Tr[4] = {0.f, 0.f, 0.f, 0.f};
#pragma unroll
            for (int i = 0; i < 32; ++i) {
                const vf4 lv = *(const vf4*)(Lm + i * 32 + ((part ^ (i & 7)) * 4));
                float s = lv.x * Tr[0] + lv.y * Tr[1] + lv.z * Tr[2] + lv.w * Tr[3];
                s = red8(s);
                const float t = (i == cc ? 1.f : 0.f) - s;
                if (part == (i & 7)) Tr[i >> 3] = t;
            }
            const float bc = sc[cc], bec = bc * sc[64 + cc];
#pragma unroll
            for (int jj = 0; jj < 4; ++jj) { TB[(part + 8 * jj) * SS + cc] = f2bf(Tr[jj] * bc); TBE[(part + 8 * jj) * SS + cc] = f2bf(Tr[jj] * bec); }
        }
        __syncthreads();
        if (wid < 4) {
            acc1 = mm<32>(TB, SS, VT + (32 * wid) * SS, SS, l32, hi, f32x16{});
        } else {
            const int d0 = 32 * (wid - 4);
            const f32x16 wt = mm<32>(KT + d0 * SS, SS, TBE, SS, l32, hi, f32x16{});
#pragma unroll
            for (int g = 0; g < 4; ++g) *(uint2*)(W + l32 * SK + d0 + 8 * g + 4 * hi) = pk4(wt[4 * g], wt[4 * g + 1], wt[4 * g + 2], wt[4 * g + 3]);
        }
        __syncthreads();
        if (wid < 4) {
            const int e0 = 32 * wid;
            const f32x16 ws = mm<128>(W, SK, ST + e0 * SK, SK, l32, hi, f32x16{});
            float vn[16], vs[16];
#pragma unroll
            for (int r = 0; r < 16; ++r) { vn[r] = acc1[r] - ws[r]; vs[r] = vn[r] * sc[96 + crow(r, hi)]; }
#pragma unroll
            for (int g = 0; g < 4; ++g) { *(uint2*)(VN + (e0 + l32) * SS + 8 * g + 4 * hi) = pk4(vn[4 * g], vn[4 * g + 1], vn[4 * g + 2], vn[4 * g + 3]);
                                          *(uint2*)(VNS + (e0 + l32) * SS + 8 * g + 4 * hi) = pk4(vs[4 * g], vs[4 * g + 1], vs[4 * g + 2], vs[4 * g + 3]); }
        }
        __syncthreads();
        if (wid >= 4) {
            const int e0 = 32 * (wid - 4);
            acc1 = mm<32>(ATT, SS, VN + e0 * SS, SS, l32, hi, acc1);
#pragma unroll
            for (int r = 0; r < 16; ++r) O[TOK(c, crow(r, hi)) * 512 + h * 128 + e0 + l32] = acc1[r];
        }
        {
            const float eB = sc[128];
#pragma unroll
            for (int bi = 0; bi < 2; ++bi) {
                const int blk = wid * 2 + bi, d0 = 32 * (blk >> 2), e0 = 32 * (blk & 3);
#pragma unroll
                for (int r = 0; r < 16; ++r) S[bi][r] *= eB;
                S[bi] = mm<32>(KT + d0 * SS, SS, VNS + e0 * SS, SS, l32, hi, S[bi]);
            }
        }
        __syncthreads();
#pragma unroll
        for (int bi = 0; bi < 2; ++bi) {
            const int blk = wid * 2 + bi, d0 = 32 * (blk >> 2), e0 = 32 * (blk & 3);
#pragma unroll
            for (int g = 0; g < 4; ++g) *(uint2*)(ST + (e0 + l32) * SK + d0 + 8 * g + 4 * hi) = pk4(S[bi][4 * g], S[bi][4 * g + 1], S[bi][4 * g + 2], S[bi][4 * g + 3]);
        }
        if (c + 1 < nch) GSTAGE();
        __syncthreads();
    }
#undef GLOAD
#undef GSTAGE
#undef TOK
    if (ctx) {
#pragma unroll
        for (int bi = 0; bi < 2; ++bi) {
            const int blk = wid * 2 + bi, d0 = 32 * (blk >> 2), e0 = 32 * (blk & 3);
            float* so = p.out + O_SGDN + ((((size_t)b * DEPTH + l) * 2 + dir) * 4 + h) * 128 * 128 + e0 + l32;
#pragma unroll
            for (int r = 0; r < 16; ++r) so[(size_t)(d0 + crow(r, hi)) * 128] = S[bi][r];
        }
    }
}
}

namespace gla {
using att::bf16x8; using att::f32x16; using att::crow; using gdn::mm; using gdn::pk4;
constexpr int C = 32, SQ = 72, SS = 40;
constexpr int OFF_QE = 0, OFF_KN = OFF_QE + C * SQ * 2, OFF_KET = OFF_KN + C * SQ * 2, OFF_VT = OFF_KET + 64 * SS * 2, OFF_ATT = OFF_VT + 128 * SS * 2, OFF_ST = OFF_ATT + C * SS * 2,
              OFF_LA = OFF_ST + 128 * SQ * 2, OFF_EB = OFF_LA + C * 64 * 4, GLA_LDS = OFF_EB + 256;
__device__ __forceinline__ void gla_chunked(const Params& p, int l, bool ctx, int b, int h, int dir, unsigned char* lds) {
    const int tid = opaque_tid(), wid = tid >> 6, lane = tid & 63, l32 = lane & 31, hi = lane >> 5;
    const int T = ctx ? CT : ::LT; const size_t m0 = ctx ? (size_t)b * CT : (size_t)MC + (size_t)b * ::LT;
    const bf16_t* Z = WSP(bf16_t, WS_Z); const float* LA = WSP(float, dir ? WS_AB : WS_AF);
    float* O = WSP(float, dir ? WS_GOB : WS_GOF);
    bf16_t* Qe = (bf16_t*)(lds + OFF_QE); bf16_t* Kn = (bf16_t*)(lds + OFF_KN); bf16_t* KeT = (bf16_t*)(lds + OFF_KET); bf16_t* VT = (bf16_t*)(lds + OFF_VT);
    bf16_t* ATT = (bf16_t*)(lds + OFF_ATT); bf16_t* ST = (bf16_t*)(lds + OFF_ST); float* eB = (float*)(lds + OFF_EB);
    const int nch = T / C;
#define TOK(c, s_) (m0 + (dir ? T - 1 - ((c) * C + (s_)) : (c) * C + (s_)))
    const int d0 = 32 * (wid >> 2), e0 = 32 * (wid & 3);
    f32x16 S;
    if (ctx) S = f32x16{};
    else {
        const float* s0 = p.in[I_SGLA] + ((((size_t)b * DEPTH + l) * 2 + dir) * 4 + h) * 64 * 128 + e0 + l32;
#pragma unroll
        for (int r = 0; r < 16; ++r) S[r] = s0[(size_t)(d0 + crow(r, hi)) * 128];
    }
    const int ts = tid & 31, dc = (tid >> 5) * 4, vc0 = dc, vc1 = 64 + dc;
    uint2 rq, rk, rv0, rv1; vf4 pl;
#define GLOAD(c) do { const size_t mt = TOK(c, ts); \
        rq = *(const uint2*)(Z + mt * NINP + Z_GLQ + h * 64 + dc); rk = *(const uint2*)(Z + mt * NINP + Z_GLK + h * 64 + dc); pl = *(const vf4*)(LA + mt * 256 + h * 64 + dc); \
        rv0 = *(const uint2*)(Z + mt * NINP + Z_GLV + h * 128 + vc0); rv1 = *(const uint2*)(Z + mt * NINP + Z_GLV + h * 128 + vc1); } while (0)
#define WRITE_ST() do { _Pragma("unroll") for (int g = 0; g < 4; ++g) *(uint2*)(ST + (e0 + l32) * SQ + d0 + 8 * g + 4 * hi) = pk4(S[4 * g], S[4 * g + 1], S[4 * g + 2], S[4 * g + 3]); } while (0)
#define GIMAGES() do { vf4 pre, tot; const vf4 pq = unp4bf(rq), pk = unp4bf(rk); \
        _Pragma("unroll") for (int j = 0; j < 4; ++j) { pre[j] = scan32(pl[j]); tot[j] = last32(pre[j], lane); } \
        float qe[4], kn[4]; \
        _Pragma("unroll") for (int j = 0; j < 4; ++j) { qe[j] = pq[j] * 0.125f * __expf(pre[j]); kn[j] = pk[j] * __expf(fminf(-pre[j], 80.f)); \
            KeT[(dc + j) * SS + ts] = f2bf(pk[j] * __expf(tot[j] - pre[j])); } \
        *(uint2*)(Qe + ts * SQ + dc) = pk4(qe[0], qe[1], qe[2], qe[3]); *(uint2*)(Kn + ts * SQ + dc) = pk4(kn[0], kn[1], kn[2], kn[3]); \
        if (ts == 0) { _Pragma("unroll") for (int j = 0; j < 4; ++j) eB[dc + j] = __expf(tot[j]); } \
        _Pragma("unroll") for (int j = 0; j < 4; ++j) { VT[(vc0 + j) * SS + ts] = H16(rv0, j); VT[(vc1 + j) * SS + ts] = H16(rv1, j); } } while (0)
    __syncthreads();
    GLOAD(0);
    WRITE_ST();
    GIMAGES();
    __syncthreads();
    for (int c = 0; c < nch; ++c) {
        if (c + 1 < nch) GLOAD(c + 1);
        f32x16 o1 = f32x16{};
        if (wid == 0) {
            const f32x16 kq = mm<64>(Kn, SQ, Qe, SQ, l32, hi, f32x16{});
            float a[16];
#pragma unroll
            for (int r = 0; r < 16; ++r) a[r] = (l32 >= crow(r, hi)) ? kq[r] : 0.f;
#pragma unroll
            for (int g = 0; g < 4; ++g) *(uint2*)(ATT + l32 * SS + 8 * g + 4 * hi) = pk4(a[4 * g], a[4 * g + 1], a[4 * g + 2], a[4 * g + 3]);
        } else if (wid >= 4) {
            o1 = mm<64>(Qe, SQ, ST + (32 * (wid - 4)) * SQ, SQ, l32, hi, f32x16{});
        }
        __syncthreads();
        if (wid >= 4) {
            const int eo = 32 * (wid - 4);
            o1 = mm<32>(ATT, SS, VT + eo * SS, SS, l32, hi, o1);
#pragma unroll
            for (int r = 0; r < 16; ++r) O[TOK(c, crow(r, hi)) * 512 + h * 128 + eo + l32] = o1[r];
        }
#pragma unroll
        for (int r = 0; r < 16; ++r) S[r] *= eB[d0 + crow(r, hi)];
        S = mm<32>(KeT + d0 * SS, SS, VT + e0 * SS, SS, l32, hi, S);
        __syncthreads();
        WRITE_ST();
        if (c + 1 < nch) GIMAGES();
#ifdef GLA_DUP_IMAGES
        __syncthreads(); if (c + 1 < nch) GIMAGES();
#endif
        __syncthreads();
    }
#undef GLOAD
#undef WRITE_ST
#undef GIMAGES
#undef TOK
    if (ctx) {
        float* so = p.out + O_SGLA + ((((size_t)b * DEPTH + l) * 2 + dir) * 4 + h) * 64 * 128 + e0 + l32;
#pragma unroll
        for (int r = 0; r < 16; ++r) so[(size_t)(d0 + crow(r, hi)) * 128] = S[r];
    }
}
}
#define LAS __attribute__((address_space(3)))
constexpr int LDS_BYTES = 147456, XBW_OFF = LDS_BYTES - 64;
constexpr int NPH = 1 + DEPTH * 12;
#ifndef DBG_NLAYERS
#define DBG_NLAYERS DEPTH
#endif

#ifndef DUPKIND
#define DUPKIND 0
#endif
#ifndef MIXMASK
#define MIXMASK 0xFF
#endif
#define FOR_ITEMS(it, n, o, w) for (int bo_ = (o) * (int)gridDim.x / 256, bw_ = ((w) * (int)gridDim.x / 256) > 0 ? ((w) * (int)gridDim.x / 256) : 1, \
                                    it = ((int)blockIdx.x >= bo_ && (int)blockIdx.x < bo_ + bw_) ? (int)blockIdx.x - bo_ : (n); it < (n); it += bw_)

constexpr int TF0 = NT_L / 10, TF1 = NT_L / 4, TF2 = NT_L * 53 / 100, TF3 = NT_L * 88 / 100, MIXCONV_CH = 16, NI_CONV = (TF3 - TF2 + MIXCONV_CH - 1) / MIXCONV_CH;
#ifndef SPLITK
#define SPLITK 0
#endif
#ifndef SPLITK_G4
#define SPLITK_G4 0
#endif
constexpr int FLAG_WORD0 = 8192;
constexpr int QCTR_WORD0 = 1024;
constexpr int NI_GDNL = LB * 8, NI_GLAL = LB * 8, NI_GDNC = CB * 8, NI_GQAL = LB * 16, NI_NAL = LB * 16, NI_GLAC = CB * 8, NI_NAC = CB * 4, NI_GQAC = CB * 4;
#define KM(k) (1 + ((DUPKIND >> (k)) & 1))
constexpr int Q0 = NI_GDNL * KM(0), Q1 = Q0 + NI_GQAL * KM(1), Q2 = Q1 + NI_NAL * KM(2), Q3 = Q2 + NI_GLAL * KM(3), Q4 = Q3 + NI_GDNC * KM(4), Q5 = Q4 + NI_NAC * KM(5), Q6 = Q5 + NI_GQAC * KM(6), Q7 = Q6 + NI_GLAC * KM(7);
__device__ __forceinline__ void phase_mix(const Params& p, int l, unsigned char* lds, int rep) {
    const int tid = opaque_tid();
    float* smem = (float*)lds;
    const bf16_t* NAQ = WSP(bf16_t, WS_NAQ); const bf16_t* NAK = WSP(bf16_t, WS_NAK); const bf16_t* NAV = WSP(bf16_t, WS_NAV);
    const bf16_t* GQ = WSP(bf16_t, WS_GQ); const bf16_t* GK = WSP(bf16_t, WS_GK); const bf16_t* GV = WSP(bf16_t, WS_GV);
    bf16_t* MRG = WSP(bf16_t, WS_MRG);
    unsigned* qctr = WSP(unsigned, WS_CTL) + QCTR_WORD0 + 64 * l + 16 * rep;
    volatile int* qslot = (volatile int*)(lds + XBW_OFF + 16);
    for (;;) {
        __syncthreads();
        if (tid == 0) *qslot = (int)__hip_atomic_fetch_add(qctr, 1u, __ATOMIC_RELAXED, __HIP_MEMORY_SCOPE_AGENT);
        __syncthreads();
        const int q = __builtin_amdgcn_readfirstlane(*qslot);
        if (q >= Q7 + ((CONV_FILLER && l + 1 < DBG_NLAYERS) ? NI_CONV : 0)) break;
        if (q < Q0) { const int it = q % NI_GDNL; gdn::gdn_chunked(p, l, false, it / 8, (it / 2) % 4, it % 2, lds); }
        else if (q < Q1) {
            const int it = (q - Q0) % NI_GQAL, b = it / 16, qh = (it / 4) % 4, qb = it % 4, kvh = qh >> 1;
            const size_t r0 = (size_t)MC + (size_t)b * LT;
            att::SrcTwo src{WSP(bf16_t, WS_CGK) + ((size_t)b * DEPTH + l) * 256 * 256 + kvh * 128, WSP(bf16_t, WS_CGV) + ((size_t)b * DEPTH + l) * 256 * 256 + kvh * 128,
                            GK + r0 * 256 + kvh * 128, GV + r0 * 256 + kvh * 128, 256};
            att::attn_body<2>(GQ + (r0 + qb * 256) * 512 + qh * 128, src, MRG + (r0 + qb * 256) * DM + 1024 + qh * 128, 4 + LT / 64, (char*)lds, att::NoBias{});
        }
        else if (q < Q2) {
            const int it = (q - Q1) % NI_NAL, b = it / 16, h = (it / 4) % 4, qb = it % 4;
            const int kr0 = qb == 0 ? 0 : qb == 1 ? 0 : qb == 2 ? 4 : 8, nrows = (qb == 0 || qb == 3) ? 8 : 12;
            const size_t r0 = (size_t)MC + (size_t)b * LT;
            float* tab = (float*)(lds + att::SHM_ATTN);
            if (tid < 15 * 31) tab[tid] = p.in[I_RPB][((size_t)l * 4 + h) * 15 * 31 + tid] * (1.0f / att::SCALE);
            att::SrcTwo src{WSP(bf16_t, WS_CNAK) + ((size_t)b * DEPTH + l) * 256 * 512 + h * 128, WSP(bf16_t, WS_CNAV) + ((size_t)b * DEPTH + l) * 256 * 512 + h * 128,
                            NAK + (r0 + kr0 * 64) * 512 + h * 128, NAV + (r0 + kr0 * 64) * 512 + h * 128, 512};
            att::attn_body<1>(NAQ + (r0 + qb * 256) * 512 + h * 128, src, MRG + (r0 + qb * 256) * DM + 0 + h * 128, 4 + nrows, (char*)lds, att::NaBias{tab, qb * 256, kr0});
        }
        else if (q < Q3) { const int it = (q - Q2) % NI_GLAL;
#ifdef GLA_REP
            for (int r_ = 0, n_ = opaque_int(GLA_REP); r_ < n_; ++r_)
#endif
            gla::gla_chunked(p, l, false, it / 8, (it / 2) % 4, it % 2, lds); }
        else if (q < Q4) { const int it = (q - Q3) % NI_GDNC; gdn::gdn_chunked(p, l, true, it / 8, (it / 2) % 4, it % 2, lds); }
        else if (q < Q5) {
            const int it = (q - Q4) % NI_NAC, b = it / 4, h = it % 4; const size_t r0 = (size_t)b * CT;
            att::SrcOne src{NAK + r0 * 512 + h * 128, NAV + r0 * 512 + h * 128, 512};
            att::attn_body<2>(NAQ + r0 * 512 + h * 128, src, MRG + r0 * DM + 0 + h * 128, CT / 64, (char*)lds, att::NoBias{});
        }
        else if (q < Q6) {
            const int it = (q - Q5) % NI_GQAC, b = it / 4, qh = it % 4, kvh = qh >> 1; const size_t r0 = (size_t)b * CT;
            att::SrcOne src{GK + r0 * 256 + kvh * 128, GV + r0 * 256 + kvh * 128, 256};
            att::attn_body<2>(GQ + r0 * 512 + qh * 128, src, MRG + r0 * DM + 1024 + qh * 128, CT / 64, (char*)lds, att::NoBias{});
        }
        else if (q < Q7) { const int it = (q - Q6) % NI_GLAC; gla::gla_chunked(p, l, true, it / 8, (it / 2) % 4, it % 2, lds); }
        else { const int t0 = TF2 + (q - Q7) * MIXCONV_CH, t1 = t0 + MIXCONV_CH < TF3 ? t0 + MIXCONV_CH : TF3; conv_layer_tiles(p, l + 1, t0, t1, 0, 1, (float*)lds); }
    }
}

#define CONV_FILL(nunits, t0, t1, skip) do { if (l + 1 < DBG_NLAYERS) { const int G_ = (int)gridDim.x; int f0_ = ((nunits) % G_) + (skip); if (f0_ >= G_) f0_ = 0; \
        if ((int)blockIdx.x >= f0_) { const Params q = opaque_params(p); conv_layer_tiles(q, l + 1, (t0), (t1), (int)blockIdx.x - f0_, G_ - f0_, (float*)lds); } } } while (0)
#define G1A_MSPLIT (G1A_MODE == 1 ? 2 : 0)
#define G1B_MSPLIT (G1B_MODE == 1 ? 2 : 0)
#ifndef MSPLIT
#define MSPLIT 2
#endif
static_assert(att::SHM_ATTN + 15 * 31 * 4 + 2048 <= (size_t)XBW_OFF, "LDS map");
static_assert((QCTR_WORD0 + 64 * DEPTH) < 4096, "ctl");
constexpr int BAR_WORD0 = 4096;
static_assert((BAR_WORD0 + XCD_BAR_WORDS) * 4 <= (int)CTL_BYTES, "ctl");

__global__ void __launch_bounds__(512, 2) fwd(Params p) {
    extern __shared__ __attribute__((aligned(16))) unsigned char lds[];
    const int tid = threadIdx.x;
    volatile LAS unsigned* xbw = (volatile LAS unsigned*)((LAS unsigned char*)lds + XBW_OFF);
    if (tid < 4) xbw[tid] = 0u;
    __syncthreads();
    XcdBarrier bar; bar.bar = WSP(unsigned, WS_CTL) + BAR_WORD0; bar.x = 0; bar.st = xbw;
    if (p.ph_hi - p.ph_lo > 1) bar = xcd_barrier_post(WSP(unsigned, WS_CTL) + BAR_WORD0, xbw);
#ifndef PHMASK
#define PHMASK 0x1FFF
#endif
#define IN(k) (p.ph_lo <= (k) && (k) < p.ph_hi)
#define INL(j) (((PHMASK >> ((j) + 1)) & 1) && IN(pb + (j)))
#ifndef DUPMASK
#define DUPMASK 0
#endif
#define DUP(j) ((DUPMASK >> ((j) + 1)) & 1)
#if DUPMASK
#define REPS(j) opaque_int(1 + DUP(j))
#else
#define REPS(j) 1
#endif
#ifndef DBLBAR
#define DBLBAR 0
#endif
#ifdef DIAG_KIND
#ifndef DIAG_SCALE
#define DIAG_SCALE 0.01f
#endif
    unsigned long long dg_sum = 0ull, dg_prev = wall_clock64();
#define DIAG_AT(k) do { const unsigned long long now_ = wall_clock64(); if ((DIAG_KIND >> (((k) == 0) ? 12 : (((k) - 1) % 12))) & 1) dg_sum += now_ - dg_prev; dg_prev = now_; } while (0)
#else
#define DIAG_AT(k) do { } while (0)
#endif
#define SEAM(k) do { if (IN(k) && IN((k) + 1)) { xcd_barrier(bar); if (DBLBAR) xcd_barrier(bar); } DIAG_AT(k); } while (0)
    LAS unsigned char* ldsl = (LAS unsigned char*)lds;
    bf16_t* H = WSP(bf16_t, WS_H); bf16_t* ACT = WSP(bf16_t, WS_ACT); float* X = WSP(float, WS_X); float* Z = WSP(float, WS_Z); bf16_t* MRG = WSP(bf16_t, WS_MRG);

    if ((PHMASK & 1) && IN(0)) { const int reps_ = (DUPMASK & 1) ? opaque_int(2) : 1; for (int rep_ = 0; rep_ < reps_; ++rep_) { const Params q = opaque_params(p); phase_prologue(q, (float*)lds); __syncthreads(); } }
    SEAM(0);
    for (int l = 0; l < DBG_NLAYERS; ++l) {
        const int pb = 1 + l * 12;
        const float* modl = WSP(float, WS_MODV) + (size_t)l * NCOND * NMOD;
        if (INL(0)) { const int reps_ = REPS(0); for (int rep_ = 0; rep_ < reps_; ++rep_) { const Params q = opaque_params(p); phase_norm(q, l, 0, lds); __syncthreads(); } }
        SEAM(pb + 0);
        if (INL(1)) {
            if (g1_fp8(l, 0)) {
                pg8::Gemm g{H, (const bf16_t*)(WSP(unsigned char, WS_WGU) + ((size_t)l * 2 + 0) * NGU * DM * 2), M, NGU, DM / 2}; pg8::StaticOrder S; S.init(M, NGU, DM / 2, (int)gridDim.x, (int)blockIdx.x, 2);
                pg8::EpiSwiGLU8 E{WSP(unsigned char, WS_ACT), FFP, 1.0f / WGU_SCALE};
                for (int r_ = 0, n_ = REPS(1); r_ < n_; ++r_) pg8::gemm_phase<pg8::EpiSwiGLU8, pg8::StaticOrder, false, 1>(ldsl, g, S, E, nullptr);
            } else {
                pg8::Gemm g{H, WSP(bf16_t, WS_WGU) + ((size_t)l * 2 + 0) * NGU * DM, M, NGU, DM}; pg8::StaticOrder S; S.init(M, NGU, DM, (int)gridDim.x, (int)blockIdx.x, 0);
                pg8::EpiSwiGLU8 E{WSP(unsigned char, WS_ACT), FFP, 1.0f};
                for (int r_ = 0, n_ = REPS(1); r_ < n_; ++r_) pg8::gemm_phase<pg8::EpiSwiGLU8, pg8::StaticOrder, false, 0>(ldsl, g, S, E, nullptr);
            }
#if CONV_FILLER
            if (l + 1 < DBG_NLAYERS) {
                const int nw_ = (M / 256) * (NGU / 256), G_ = (int)gridDim.x; int f0_ = nw_ % G_; if (nw_ < G_) f0_ = 0;
                if (g1_fp8(l, 0)) f0_ = 2 * f0_ < G_ ? 2 * f0_ : f0_;
                if ((int)blockIdx.x >= f0_) { const Params q = opaque_params(p); mod_layer(q, l + 1, (int)blockIdx.x - f0_, G_ - f0_, (float*)lds); }
            }
            CONV_FILL((M / 256) * (NGU / 256), 0, TF0, (g1_fp8(l, 0) ? ((M / 256) * (NGU / 256)) % (int)gridDim.x : 0));
#endif
        }
        SEAM(pb + 1);
        if (INL(2)) {
            pg8::Gemm g{ACT, G2_FP8 ? (const bf16_t*)(WSP(unsigned char, WS_WDN) + ((size_t)l * 2 + 0) * DM * FFP) : WSP(bf16_t, WS_WDN) + ((size_t)l * 2 + 0) * DM * FF, M, DM, G2_FP8 ? FFP / 2 : FF}; pg8::StaticOrder S; S.init(M, DM, G2_FP8 ? FFP / 2 : FF, (int)gridDim.x, (int)blockIdx.x, SPLITK ? 1 : MSPLIT);
            pg8::EpiResid E{l == 0 ? p.in[I_XP] : X, X, DM, modl + 2 * DM, G2_FP8 ? 0.5f / WDN_SCALE : 0.5f, Z, WSP(unsigned, WS_CTL) + FLAG_WORD0, 8u * (unsigned)(l * (2 * SPLITK + SPLITK_G4) + SPLITK), l == 0 ? p.in[I_XS] : X, l == 0 ? MC : 0x7FFFFFFF, (XBF16 && l != 0), XBF16};
            pg8::gemm_phase<pg8::EpiResid, pg8::StaticOrder, false, (G2_FP8 ? 1 : 0)>(ldsl, g, S, E, nullptr);
#if DUPMASK
            if (opaque_int(DUP(2))) { pg8::EpiResid E2{l == 0 ? p.in[I_XP] : X, Z, DM, modl + 2 * DM, G2_FP8 ? 0.5f / WDN_SCALE : 0.5f, Z, WSP(unsigned, WS_CTL) + FLAG_WORD0, 0u, l == 0 ? p.in[I_XS] : X, l == 0 ? MC : 0x7FFFFFFF, 0, 0}; pg8::gemm_phase<pg8::EpiResid, pg8::StaticOrder, false, (G2_FP8 ? 1 : 0)>(ldsl, g, S, E2, nullptr); }
#endif
        }
        SEAM(pb + 2);
        if (INL(3)) { const int reps_ = REPS(3); for (int rep_ = 0; rep_ < reps_; ++rep_) { const Params q = opaque_params(p); phase_norm(q, l, 1, lds); __syncthreads(); } }
        SEAM(pb + 3);
        if (INL(4)) {
            pg8::Gemm g{H, WSP(bf16_t, WS_WIN) + (size_t)l * NINP * DM, M, NINP, DM}; pg8::StaticOrder S; S.init(M, NINP, DM, (int)gridDim.x, (int)blockIdx.x);
            pg8::EpiBf16Plain E{WSP(bf16_t, WS_Z), NINP};
            for (int r_ = 0, n_ = REPS(4); r_ < n_; ++r_) pg8::gemm_phase<pg8::EpiBf16Plain, pg8::StaticOrder, false>(ldsl, g, S, E, nullptr);
#if CONV_FILLER
            CONV_FILL((M / 256) * (NINP / 256), TF0, TF1, 0);
#endif
        }
        SEAM(pb + 4);
        if (INL(5)) { const int reps_ = REPS(5); for (int rep_ = 0; rep_ < reps_; ++rep_) { const Params q = opaque_params(p); phase_prep(q, l, lds); __syncthreads(); } }
        SEAM(pb + 5);
        if (INL(6)) { const int reps_ = REPS(6); for (int rep_ = 0; rep_ < reps_; ++rep_) { const Params q = opaque_params(p); phase_mix(q, l, lds, rep_); __syncthreads(); } }
        SEAM(pb + 6);
        if (INL(7)) { const int reps_ = REPS(7); for (int rep_ = 0; rep_ < reps_; ++rep_) { const Params q = opaque_params(p); phase_post(q, l); __syncthreads(); } }
        SEAM(pb + 7);
        if (INL(8)) {
            pg8::Gemm g{MRG, WSP(bf16_t, WS_WOUT) + (size_t)l * DM * DM, M, DM, DM}; pg8::StaticOrder S; S.init(M, DM, DM, (int)gridDim.x, (int)blockIdx.x, SPLITK_G4);
            pg8::EpiResid E{X, X, DM, modl + 5 * DM, 1.0f, Z, WSP(unsigned, WS_CTL) + FLAG_WORD0, 8u * (unsigned)(l * (2 * SPLITK + SPLITK_G4) + SPLITK + SPLITK_G4), X, 0x7FFFFFFF, XBF16, XBF16};
            pg8::gemm_phase<pg8::EpiResid, pg8::StaticOrder, false>(ldsl, g, S, E, nullptr);
#if CONV_FILLER
            CONV_FILL((M / 256) * (DM / 256), TF1, TF2, 0);
#endif
#if DUPMASK
            if (opaque_int(DUP(8))) { pg8::EpiResid E2{X, Z, DM, modl + 5 * DM, 1.0f, Z, WSP(unsigned, WS_CTL) + FLAG_WORD0, 0u, X, 0x7FFFFFFF, 0, 0}; pg8::gemm_phase<pg8::EpiResid, pg8::StaticOrder, false>(ldsl, g, S, E2, nullptr); }
#endif
        }
        SEAM(pb + 8);
        if (INL(9)) { const int reps_ = REPS(9); for (int rep_ = 0; rep_ < reps_; ++rep_) { const Params q = opaque_params(p); phase_norm(q, l, 2, lds); __syncthreads(); } }
        SEAM(pb + 9);
        if (INL(10)) {
            {
#if G1B_MODE
                pg8::Gemm g{H, (const bf16_t*)(WSP(unsigned char, WS_WGU) + ((size_t)l * 2 + 1) * NGU * DM * 2), M, NGU, DM / 2}; pg8::StaticOrder S; S.init(M, NGU, DM / 2, (int)gridDim.x, (int)blockIdx.x, G1B_MSPLIT);
                constexpr float ws_ = 1.0f / WGU_SCALE;
#else
                pg8::Gemm g{H, WSP(bf16_t, WS_WGU) + ((size_t)l * 2 + 1) * NGU * DM, M, NGU, DM}; pg8::StaticOrder S; S.init(M, NGU, DM, (int)gridDim.x, (int)blockIdx.x, G1B_MSPLIT);
                constexpr float ws_ = 1.0f;
#endif
#if G2_FP8
                pg8::EpiSwiGLU8 E{WSP(unsigned char, WS_ACT), FFP, ws_};
                for (int r_ = 0, n_ = REPS(10); r_ < n_; ++r_) pg8::gemm_phase<pg8::EpiSwiGLU8, pg8::StaticOrder, false, G1B_MODE>(ldsl, g, S, E, nullptr);
#else
                pg8::EpiSwiGLU E{ACT, FF};
                pg8::gemm_phase<pg8::EpiSwiGLU, pg8::StaticOrder, false, G1B_MODE>(ldsl, g, S, E, nullptr);
#endif
            }
#if CONV_FILLER
            CONV_FILL((M / 256) * (NGU / 256), TF3, NT_L, (G1B_MSPLIT ? ((M / 256) * (NGU / 256)) % (int)gridDim.x : 0));
#endif
        }
        SEAM(pb + 10);
        if (INL(11)) {
            pg8::Gemm g{ACT, G2_FP8 ? (const bf16_t*)(WSP(unsigned char, WS_WDN) + ((size_t)l * 2 + 1) * DM * FFP) : WSP(bf16_t, WS_WDN) + ((size_t)l * 2 + 1) * DM * FF, M, DM, G2_FP8 ? FFP / 2 : FF}; pg8::StaticOrder S; S.init(M, DM, G2_FP8 ? FFP / 2 : FF, (int)gridDim.x, (int)blockIdx.x, SPLITK ? 1 : MSPLIT);
            pg8::EpiResid E{X, (l == DEPTH - 1) ? p.out : X, DM, modl + 8 * DM, G2_FP8 ? 0.5f / WDN_SCALE : 0.5f, Z, WSP(unsigned, WS_CTL) + FLAG_WORD0, 8u * (unsigned)(l * (2 * SPLITK + SPLITK_G4) + 2 * SPLITK + SPLITK_G4), X, 0x7FFFFFFF, XBF16, (XBF16 && l != DEPTH - 1)};
            pg8::gemm_phase<pg8::EpiResid, pg8::StaticOrder, false, (G2_FP8 ? 1 : 0)>(ldsl, g, S, E, nullptr);
        }
        SEAM(pb + 11);
    }
#ifdef DIAG_KIND
    xcd_barrier(bar);
    if (blockIdx.x == 0 && threadIdx.x == 0) p.out[0] += (float)dg_sum * 0.01f * DIAG_SCALE;
#endif
#undef IN
#undef SEAM
}

#ifndef MULTI_LAUNCH
#define MULTI_LAUNCH 0
#endif
extern "C" void kernel_launch(void* const* d_in, const int* in_sizes, int n_in, void* d_out, int out_size, void* d_ws, size_t ws_size, hipStream_t stream) {
    static int grid = 0;
    if (grid == 0) {
        if (n_in != N_IN || (size_t)out_size != O_END || ws_size < WS_END) { fprintf(stderr, "kernel_launch: shape mismatch n_in %d out %d ws %zu (need %zu)\n", n_in, out_size, ws_size, (size_t)WS_END); grid = -1; return; }
        int dev = 0, cus = 0, per_cu = 0;
        if (hipGetDevice(&dev) != hipSuccess || hipDeviceGetAttribute(&cus, hipDeviceAttributeMultiprocessorCount, dev) != hipSuccess) { grid = -1; return; }
        if (hipFuncSetAttribute((const void*)fwd, hipFuncAttributeMaxDynamicSharedMemorySize, LDS_BYTES) != hipSuccess) { fprintf(stderr, "kernel_launch: hipFuncSetAttribute failed\n"); grid = -1; return; }
        if (hipOccupancyMaxActiveBlocksPerMultiprocessor(&per_cu, (const void*)fwd, 512, LDS_BYTES) != hipSuccess || per_cu < 1) { fprintf(stderr, "kernel_launch: occupancy query says %d\n", per_cu); (void)hipGetLastError(); }
        grid = cus;
    }
    if (grid < 0) return;
    (void)hipMemsetAsync((char*)d_ws + WS_CTL, 0, CTL_BYTES, stream);
    Params p{};
    for (int i = 0; i < N_IN; ++i) p.in[i] = (const float*)d_in[i];
    p.out = (float*)d_out; p.ws = (unsigned char*)d_ws;
#if MULTI_LAUNCH
    for (int ph = 0; ph < 1 + DBG_NLAYERS * 12; ++ph) { p.ph_lo = ph; p.ph_hi = ph + 1; hipLaunchKernelGGL(fwd, dim3(grid), dim3(512), LDS_BYTES, stream, p); }
#else
    p.ph_lo = 0; p.ph_hi = NPH; hipLaunchKernelGGL(fwd, dim3(grid), dim3(512), LDS_BYTES, stream, p);
#endif
    const hipError_t le = hipPeekAtLastError();
    if (le != hipSuccess) fprintf(stderr, "kernel_launch: launch failed: %s\n", hipGetErrorName(le));
}
```

```cpp
#include <hip/hip_runtime.h>
#include <cstdio>
#include <cstdint>

#ifndef CB_
#define CB_ 16
#endif
#ifndef LB_
#define LB_ 8
#endif
#ifndef DEPTH_
#define DEPTH_ 4
#endif
#ifndef G1A_LAYERS
#define G1A_LAYERS 0xE
#endif
#ifndef G1A_MODE
#define G1A_MODE 0
#endif
#ifndef G1B_MODE
#define G1B_MODE 1
#endif
#ifndef XBF16
#define XBF16 0
#endif
#ifndef G3_FP8
#define G3_FP8 0
#endif
#ifndef G2_FP8
#define G2_FP8 1
#endif
#ifndef FFN_FP8
#define FFN_FP8 (G1A_MODE != 0 || G1B_MODE != 0 || G2_FP8 != 0)
#endif
constexpr int DM = 2048, DEPTH = DEPTH_, CB = CB_, CT = 256, LB = LB_, LT = 1024;
constexpr int MC = CB * CT, ML = LB * LT, M = MC + ML;
constexpr int FF = 5504, NGU = 2 * FF, NIN = 6192, NINP = 6400, NMOD = 9 * DM, NCOND = 1 + LB;
constexpr float EPS = 1e-6f;
constexpr int FFP = 5632;
constexpr float WGU_SCALE = 32.0f, WDN_SCALE = 64.0f, WIN_SCALE = 32.0f;
constexpr int Z_NAQ = 0, Z_NAK = 512, Z_NAV = 1024, Z_GLQ = 1536, Z_GLK = 1792, Z_GLV = 2048, Z_GLR = 2560, Z_GF = 3072, Z_GB = 3088,
              Z_GQQ = 3104, Z_GQK = 3616, Z_GQV = 3872, Z_DQKV = 4128, Z_DZ = 5664, Z_DB = 6176, Z_DA = 6184;
static_assert(Z_DA + 8 == NIN, "split");
enum { I_XP = 0, I_XS, I_CNAK, I_CNAV, I_CGK, I_CGV, I_SGLA, I_SGDN, I_C, I_CCTX, I_NORMG, I_WMOD, I_BMOD, I_GU, I_DOWN, I_WIN, I_WOUT, I_NAQKN, I_RPB,
       I_GUP, I_GBIAS, I_GLAON, I_GQAQKN, I_CONV, I_ALOG, I_DTB, I_GDNON, N_IN };
constexpr size_t O_YP = 0, O_YS = O_YP + (size_t)MC * DM, O_NAK = O_YS + (size_t)ML * DM, O_NAV = O_NAK + (size_t)CB * DEPTH * 4 * CT * 128,
                 O_GK = O_NAV + (size_t)CB * DEPTH * 4 * CT * 128, O_GV = O_GK + (size_t)CB * DEPTH * 2 * CT * 128,
                 O_SGLA = O_GV + (size_t)CB * DEPTH * 2 * CT * 128, O_SGDN = O_SGLA + (size_t)CB * DEPTH * 2 * 4 * 64 * 128,
                 O_END = O_SGDN + (size_t)CB * DEPTH * 2 * 4 * 128 * 128;
constexpr size_t al256(size_t x) { return (x + 255) & ~(size_t)255; }
constexpr size_t WS_CTL = 0, CTL_BYTES = 1u << 20;
constexpr size_t WS_WGU = CTL_BYTES;
constexpr size_t WS_WDN = WS_WGU + (size_t)DEPTH * 2 * NGU * DM * 2;
constexpr size_t WS_WIN = WS_WDN + (size_t)DEPTH * 2 * DM * FF * 2;
constexpr size_t WS_WOUT = WS_WIN + (size_t)DEPTH * NINP * DM * 2;
constexpr size_t WS_MODV = WS_WOUT + (size_t)DEPTH * DM * DM * 2;
constexpr size_t WS_ROPE = al256(WS_MODV + (size_t)DEPTH * NCOND * NMOD * 4);
constexpr size_t WS_X = al256(WS_ROPE + 2 * 64 * 32 * 4);
constexpr size_t WS_H = WS_X + (size_t)M * DM * 4;
constexpr size_t WS_ACT = WS_H + (size_t)M * DM * 2;
constexpr size_t WS_Z = WS_ACT + (size_t)M * FF * 2;
constexpr size_t WS_MRG = WS_Z + (size_t)M * NINP * 4;
constexpr size_t WS_NAQ = WS_MRG + (size_t)M * DM * 2;
constexpr size_t WS_NAK = WS_NAQ + (size_t)M * 512 * 2;
constexpr size_t WS_NAV = WS_NAK + (size_t)M * 512 * 2;
constexpr size_t WS_GQ = WS_NAV + (size_t)M * 512 * 2;
constexpr size_t WS_GK = WS_GQ + (size_t)M * 512 * 2;
constexpr size_t WS_GV = WS_GK + (size_t)M * 256 * 2;
constexpr size_t WS_CNAK = WS_GV + (size_t)M * 256 * 2;
constexpr size_t WS_CNAV = WS_CNAK + (size_t)LB * DEPTH * 256 * 512 * 2;
constexpr size_t WS_CGK = WS_CNAV + (size_t)LB * DEPTH * 256 * 512 * 2;
constexpr size_t WS_CGV = WS_CGK + (size_t)LB * DEPTH * 256 * 256 * 2;
constexpr size_t WS_AF = WS_CGV + (size_t)LB * DEPTH * 256 * 256 * 2;
constexpr size_t WS_AB = WS_AF + (size_t)M * 256 * 4;
constexpr size_t WS_DQ = WS_AB + (size_t)M * 256 * 4;
constexpr size_t WS_DK = WS_DQ + (size_t)M * 512 * 4;
constexpr size_t WS_DV = WS_DK + (size_t)M * 512 * 4;
constexpr size_t WS_DBA = WS_DV + (size_t)M * 512 * 4;
constexpr size_t WS_GOF = WS_DBA + (size_t)M * 16 * 4;
constexpr size_t WS_GOB = WS_GOF + (size_t)M * 512 * 4;
constexpr size_t WS_DOF = WS_GOB + (size_t)M * 512 * 4;
constexpr size_t WS_DOB = WS_DOF + (size_t)M * 512 * 4;
constexpr size_t WS_END = WS_DOB + (size_t)M * 512 * 4;

typedef unsigned short bf16_t;
struct Params { const float* in[N_IN]; float* out; unsigned char* ws; int ph_lo, ph_hi; };
static_assert(sizeof(Params) == N_IN * 8 + 8 + 8 + 8, "no padding");

#define WSP(T, off) ((T*)(p.ws + (off)))
__device__ __forceinline__ int opaque_tid() { int t = (int)threadIdx.x; asm volatile("" : "+v"(t)); return t; }
__device__ __forceinline__ Params opaque_params(const Params& p) { Params q = p; unsigned long long w = (unsigned long long)q.ws; asm volatile("" : "+s"(w));
    q.ws = (unsigned char*)(__attribute__((address_space(1))) unsigned char*)w; return q; }

typedef float vf4 __attribute__((ext_vector_type(4)));
__device__ __forceinline__ unsigned pack4_fp8(float a, float b, float c, float d) { int w = 0; w = __builtin_amdgcn_cvt_pk_fp8_f32(a, b, w, false); w = __builtin_amdgcn_cvt_pk_fp8_f32(c, d, w, true); return (unsigned)w; }
__device__ __forceinline__ float bf2f(unsigned short v) { return __uint_as_float((unsigned)v << 16); }
__device__ __forceinline__ vf4 ld4bf(const unsigned short* p) { const uint2 w = *(const uint2*)p; vf4 r; r.x = __uint_as_float(w.x << 16); r.y = __uint_as_float(w.x & 0xFFFF0000u); r.z = __uint_as_float(w.y << 16); r.w = __uint_as_float(w.y & 0xFFFF0000u); return r; }
__device__ __forceinline__ vf4 unp4bf(uint2 w) { vf4 r; r.x = __uint_as_float(w.x << 16); r.y = __uint_as_float(w.x & 0xFFFF0000u); r.z = __uint_as_float(w.y << 16); r.w = __uint_as_float(w.y & 0xFFFF0000u); return r; }
__device__ __forceinline__ void unp8bf(uint4 w, vf4& a, vf4& b) {
    a.x = __uint_as_float(w.x << 16); a.y = __uint_as_float(w.x & 0xFFFF0000u); a.z = __uint_as_float(w.y << 16); a.w = __uint_as_float(w.y & 0xFFFF0000u);
    b.x = __uint_as_float(w.z << 16); b.y = __uint_as_float(w.z & 0xFFFF0000u); b.z = __uint_as_float(w.w << 16); b.w = __uint_as_float(w.w & 0xFFFF0000u); }
__device__ __forceinline__ void ld8bf(const unsigned short* p, vf4& a, vf4& b) { const uint4 w = *(const uint4*)p;
    a.x = __uint_as_float(w.x << 16); a.y = __uint_as_float(w.x & 0xFFFF0000u); a.z = __uint_as_float(w.y << 16); a.w = __uint_as_float(w.y & 0xFFFF0000u);
    b.x = __uint_as_float(w.z << 16); b.y = __uint_as_float(w.z & 0xFFFF0000u); b.z = __uint_as_float(w.w << 16); b.w = __uint_as_float(w.w & 0xFFFF0000u); }
__device__ __forceinline__ float wave_sum(float v) {
#pragma unroll
    for (int o = 32; o >= 1; o >>= 1) v += __shfl_xor(v, o);
    return v;
}
typedef float vf2_ __attribute__((ext_vector_type(2)));
typedef __bf16 vb2_ __attribute__((ext_vector_type(2)));
__device__ __forceinline__ bf16_t f2bf(float f) { return __builtin_bit_cast(unsigned short, (__bf16)f); }
__device__ __forceinline__ unsigned pack2(float a, float b) { return __builtin_bit_cast(unsigned, __builtin_convertvector((vf2_){a, b}, vb2_)); }
__device__ __forceinline__ float silu_f(float x) { return x / (1.f + expf(-x)); }
__device__ __forceinline__ float rsqrt_fast(float x) { return __builtin_amdgcn_rsqf(x); }
__device__ __forceinline__ float silu_fast(float x) { return x * __builtin_amdgcn_rcpf(1.f + __expf(-x)); }
__device__ __forceinline__ float logsigmoid_fast(float x) { return fminf(x, 0.f) - __logf(1.f + __expf(-fabsf(x))); }
__device__ __forceinline__ float softplus_f(float x) { return fmaxf(x, 0.f) + log1pf(expf(-fabsf(x))); }
__device__ __forceinline__ float logsigmoid_f(float x) { return fminf(x, 0.f) - log1pf(expf(-fabsf(x))); }
__device__ __forceinline__ bool g1_fp8(int l, int f) { return f ? (G1B_MODE != 0) : (G1A_MODE != 0 || ((G1A_LAYERS >> l) & 1)); }
__device__ __forceinline__ int opaque_int(int v) { asm volatile("" : "+s"(v)); return v; }
__device__ __forceinline__ int cond_of_row(int m) { return m < MC ? 0 : 1 + (m - MC) / LT; }
#ifndef CONV_FILLER
#define CONV_FILLER 1
#endif
__device__ __forceinline__ void conv_tile(const float* __restrict__ src, int ld_src, int ncols_src, int k0, int c0, bf16_t* __restrict__ dst, int ld_dst, int n0, float* tile) {
    const int tid = opaque_tid();
    {
        const int r = tid >> 3, c = (tid & 7) * 8;
        float4 a = make_float4(0.f, 0.f, 0.f, 0.f), b = a;
        if (c0 + c + 8 <= ncols_src) {
            const float* s = src + (size_t)(k0 + r) * ld_src + c0 + c;
            a = *(const float4*)s; b = *(const float4*)(s + 4);
        }
        float* t = tile + r * 65 + c;
        t[0] = a.x; t[1] = a.y; t[2] = a.z; t[3] = a.w; t[4] = b.x; t[5] = b.y; t[6] = b.z; t[7] = b.w;
    }
    __syncthreads();
    {
        const int n = tid >> 3, ks = (tid & 7) * 8;
        const float* t = tile + ks * 65 + n;
        uint4 w;
        w.x = pack2(t[0 * 65], t[1 * 65]); w.y = pack2(t[2 * 65], t[3 * 65]); w.z = pack2(t[4 * 65], t[5 * 65]); w.w = pack2(t[6 * 65], t[7 * 65]);
        *(uint4*)(dst + (size_t)(n0 + n) * ld_dst + k0 + ks) = w;
    }
    __syncthreads();
}

__device__ __forceinline__ void conv_tile8(const float* __restrict__ src, int ld_src, int nrows_src, int k0, int c0, unsigned char* __restrict__ dst, int ld_dst, int n0, float scale, float* tile) {
    const int tid = opaque_tid();
    {
        const int r = tid >> 3, c = (tid & 7) * 8;
        float4 a = make_float4(0.f, 0.f, 0.f, 0.f), b = a;
        if (k0 + r < nrows_src) { const float* s = src + (size_t)(k0 + r) * ld_src + c0 + c; a = *(const float4*)s; b = *(const float4*)(s + 4); }
        float* t = tile + r * 65 + c;
        t[0] = a.x * scale; t[1] = a.y * scale; t[2] = a.z * scale; t[3] = a.w * scale; t[4] = b.x * scale; t[5] = b.y * scale; t[6] = b.z * scale; t[7] = b.w * scale;
    }
    __syncthreads();
    {
        const int n = tid >> 3, ks = (tid & 7) * 8;
        const float* t = tile + ks * 65 + n;
        uint2 w; w.x = pack4_fp8(t[0 * 65], t[1 * 65], t[2 * 65], t[3 * 65]); w.y = pack4_fp8(t[4 * 65], t[5 * 65], t[6 * 65], t[7 * 65]);
        *(uint2*)(dst + (size_t)(n0 + n) * ld_dst + k0 + ks) = w;
    }
    __syncthreads();
}
constexpr int MOD_ITEMS = DEPTH * (NMOD / 128);
constexpr int TGU_KT = DM / 64, TGU_NT = NGU / 64, TDN_KT = (G2_FP8 ? FFP : FF) / 64, TDN_NT = DM / 64, TIN_KT = DM / 64, TIN_NT = NINP / 64, TOUT_KT = DM / 64, TOUT_NT = DM / 64;
constexpr int TL_GU = 2 * TGU_KT * TGU_NT, TL_DN = 2 * TDN_KT * TDN_NT, TL_IN = TIN_KT * TIN_NT, TL_OUT = TOUT_KT * TOUT_NT, NT_L = TL_GU + TL_DN + TL_IN + TL_OUT;
struct CTile { const float* sp; unsigned char* dp; float scale; int fp8; };
__device__ __forceinline__ CTile conv_desc(const Params& p, int l, int it, int tid) {
    const int r = tid >> 3, c = (tid & 7) * 8;
    CTile d; d.scale = 1.0f; d.fp8 = 0;
    if (it < TL_GU) {
        const int mat = l * 2 + it / (TGU_KT * TGU_NT), rr = it % (TGU_KT * TGU_NT), kt = rr / TGU_NT, nt = rr % TGU_NT;
        const int n0 = nt * 64, t256 = n0 / 256, cc = n0 % 256;
        const int c0 = cc < 128 ? 128 * t256 + cc : FF + 128 * t256 + (cc - 128);
        d.sp = p.in[I_GU] + (size_t)mat * DM * NGU + (size_t)(kt * 64 + r) * NGU + c0 + c;
        if (g1_fp8(mat >> 1, mat & 1)) { d.fp8 = 1; d.scale = WGU_SCALE; d.dp = WSP(unsigned char, WS_WGU) + (size_t)mat * NGU * DM * 2 + (size_t)(n0 + r) * DM + kt * 64 + c; }
        else d.dp = WSP(unsigned char, WS_WGU) + ((size_t)mat * NGU * DM + (size_t)(n0 + r) * DM + kt * 64 + c) * 2;
    } else if (it < TL_GU + TL_DN) {
        const int i2 = it - TL_GU, mat = l * 2 + i2 / (TDN_KT * TDN_NT), rr = i2 % (TDN_KT * TDN_NT), kt = rr / TDN_NT, nt = rr % TDN_NT;
        d.sp = (kt * 64 + r < FF) ? p.in[I_DOWN] + (size_t)mat * FF * DM + (size_t)(kt * 64 + r) * DM + nt * 64 + c : nullptr;
#if G2_FP8
        d.fp8 = 1; d.scale = WDN_SCALE; d.dp = WSP(unsigned char, WS_WDN) + (size_t)mat * DM * FFP + (size_t)(nt * 64 + r) * FFP + kt * 64 + c;
#else
        d.dp = WSP(unsigned char, WS_WDN) + ((size_t)mat * DM * FF + (size_t)(nt * 64 + r) * FF + kt * 64 + c) * 2;
#endif
    } else if (it < TL_GU + TL_DN + TL_IN) {
        const int i2 = it - TL_GU - TL_DN, kt = i2 / TIN_NT, nt = i2 % TIN_NT;
        d.sp = (nt * 64 + c + 8 <= NIN) ? p.in[I_WIN] + (size_t)l * DM * NIN + (size_t)(kt * 64 + r) * NIN + nt * 64 + c : nullptr;
#if G3_FP8
        d.fp8 = 1; d.scale = WIN_SCALE; d.dp = WSP(unsigned char, WS_WIN) + (size_t)l * NINP * DM * 2 + (size_t)(nt * 64 + r) * DM + kt * 64 + c;
#else
        d.dp = WSP(unsigned char, WS_WIN) + ((size_t)l * NINP * DM + (size_t)(nt * 64 + r) * DM + kt * 64 + c) * 2;
#endif
    } else {
        const int i2 = it - TL_GU - TL_DN - TL_IN, kt = i2 / TOUT_NT, nt = i2 % TOUT_NT;
        d.sp = p.in[I_WOUT] + (size_t)l * DM * DM + (size_t)(kt * 64 + r) * DM + nt * 64 + c;
        d.dp = WSP(unsigned char, WS_WOUT) + ((size_t)l * DM * DM + (size_t)(nt * 64 + r) * DM + kt * 64 + c) * 2;
    }
    return d;
}
#ifndef CONV_U
#define CONV_U 8
#endif
__device__ __forceinline__ void conv_layer_tiles(const Params& p, int l, int t_begin, int t_end, int first, int stride, float* s_tile) {
    const int tid = opaque_tid(), r = tid >> 3, c = (tid & 7) * 8;
    int it = t_begin + first;
    if (it >= t_end) return;
    __syncthreads();
    for (; it < t_end; it += CONV_U * stride) {
        const float* sp[CONV_U]; unsigned char* dp[CONV_U]; float sc[CONV_U]; int f8[CONV_U]; float4 a[CONV_U], b[CONV_U];
#pragma unroll
        for (int u = 0; u < CONV_U; ++u) {
            const int iu = it + u * stride; const bool ok = iu < t_end;
            const CTile d = conv_desc(p, l, ok ? iu : it, tid);
            sp[u] = ok ? d.sp : nullptr; dp[u] = ok ? d.dp : nullptr; sc[u] = d.scale; f8[u] = d.fp8;
            a[u] = make_float4(0.f, 0.f, 0.f, 0.f); b[u] = a[u];
            if (sp[u]) { a[u] = *(const float4*)sp[u]; b[u] = *(const float4*)(sp[u] + 4); }
        }
#pragma unroll
        for (int u = 0; u < CONV_U; ++u) {
            float* t = s_tile + u * (64 * 65) + r * 65 + c; const float s1 = sc[u];
            t[0] = a[u].x * s1; t[1] = a[u].y * s1; t[2] = a[u].z * s1; t[3] = a[u].w * s1; t[4] = b[u].x * s1; t[5] = b[u].y * s1; t[6] = b[u].z * s1; t[7] = b[u].w * s1;
        }
        __syncthreads();
#pragma unroll
        for (int u = 0; u < CONV_U; ++u) if (dp[u]) {
            const float* t = s_tile + u * (64 * 65) + c * 65 + r;
            if (f8[u]) { uint2 w; w.x = pack4_fp8(t[0 * 65], t[1 * 65], t[2 * 65], t[3 * 65]); w.y = pack4_fp8(t[4 * 65], t[5 * 65], t[6 * 65], t[7 * 65]); *(uint2*)dp[u] = w; }
            else { uint4 w; w.x = pack2(t[0 * 65], t[1 * 65]); w.y = pack2(t[2 * 65], t[3 * 65]); w.z = pack2(t[4 * 65], t[5 * 65]); w.w = pack2(t[6 * 65], t[7 * 65]); *(uint4*)dp[u] = w; }
        }
        __syncthreads();
    }
}
constexpr int MOD_TC = 72, MOD_CG = MOD_TC / 4, MOD_KS = 16, MOD_KR = DM / MOD_KS, MOD_NT = NMOD / MOD_TC;
constexpr int MOD_LDS_FLOATS = NCOND * DM + MOD_KS * MOD_CG * NCOND * 4;
static_assert(NMOD % MOD_TC == 0 && MOD_CG * MOD_KS <= 512 && DM % MOD_KS == 0 && MOD_KR % 16 == 0 && (NCOND * DM) % (512 * 12) == 0, "mod tiling");
__device__ __forceinline__ void mod_layer(const Params& p, int l, int first, int stride, float* smem) {
    const int tid = opaque_tid();
    float* s_cond = smem;
    float* s_red = s_cond + NCOND * DM;
    __syncthreads();
    for (int i0 = tid; i0 < NCOND * DM; i0 += 512 * 12) {
        float cv[12];
#pragma unroll
        for (int k = 0; k < 12; ++k) { const int i = i0 + 512 * k, ci = i / DM, kk = i % DM; cv[k] = ci == 0 ? p.in[I_CCTX][kk] : p.in[I_C][(size_t)(ci - 1) * DM + kk]; }
#pragma unroll
        for (int k = 0; k < 12; ++k) s_cond[i0 + 512 * k] = silu_f(cv[k]);
    }
    __syncthreads();
    float* modv = WSP(float, WS_MODV);
    const int cg = tid % MOD_CG, ks = tid / MOD_CG;
    for (int jt = first; jt < MOD_NT; jt += stride) {
        if (ks < MOD_KS) {
            const float* w = p.in[I_WMOD] + (size_t)l * DM * NMOD + (size_t)(ks * MOD_KR) * NMOD + jt * MOD_TC + cg * 4;
            const float* sc = s_cond + ks * MOD_KR;
            vf4 acc[NCOND];
#pragma unroll
            for (int ci = 0; ci < NCOND; ++ci) acc[ci] = (vf4){0.f, 0.f, 0.f, 0.f};
            for (int k = 0; k < MOD_KR; k += 16) {
                vf4 wv[16];
#pragma unroll
                for (int j = 0; j < 16; ++j) wv[j] = *(const vf4*)(w + (size_t)(k + j) * NMOD);
#pragma unroll
                for (int j4 = 0; j4 < 4; ++j4)
#pragma unroll
                    for (int ci = 0; ci < NCOND; ++ci) {
                        const vf4 s = *(const vf4*)&sc[ci * DM + k + j4 * 4];
                        acc[ci] += s.x * wv[j4 * 4] + s.y * wv[j4 * 4 + 1] + s.z * wv[j4 * 4 + 2] + s.w * wv[j4 * 4 + 3];
                    }
            }
#pragma unroll
            for (int ci = 0; ci < NCOND; ++ci) *(vf4*)&s_red[((ks * MOD_CG + cg) * NCOND + ci) * 4] = acc[ci];
        }
        __syncthreads();
        for (int i = tid; i < MOD_TC * NCOND; i += 512) {
            const int c = i % MOD_TC, ci = i / MOD_TC, col = jt * MOD_TC + c;
            float sum = p.in[I_BMOD][(size_t)l * NMOD + col];
#pragma unroll
            for (int k2 = 0; k2 < MOD_KS; ++k2) sum += s_red[((k2 * MOD_CG + (c >> 2)) * NCOND + ci) * 4 + (c & 3)];
            modv[((size_t)l * NCOND + ci) * NMOD + col] = sum;
        }
        __syncthreads();
    }
}

__device__ __forceinline__ void phase_prologue(const Params& p, float* smem) {
    const int tid = threadIdx.x, nb = gridDim.x, bid = blockIdx.x;
    float* s_tile = smem;
#if CONV_FILLER
    mod_layer(p, 0, bid, nb, smem);
#ifdef PRO_DUP_MOD
    for (int r_ = 0; r_ < opaque_int(PRO_DUP_MOD); ++r_) mod_layer(p, 0, bid, nb, smem);
#endif
#else
    for (int l2 = 0; l2 < DEPTH; ++l2) mod_layer(p, l2, bid, nb, smem);
#endif
    conv_layer_tiles(p, 0, 0, NT_L, bid, nb, s_tile);
#ifdef PRO_DUP_CONV
    for (int r_ = 0; r_ < opaque_int(PRO_DUP_CONV); ++r_) conv_layer_tiles(p, 0, 0, NT_L, bid, nb, s_tile);
#endif
#if !CONV_FILLER
    for (int l2 = 1; l2 < DEPTH; ++l2) conv_layer_tiles(p, l2, 0, NT_L, bid, nb, s_tile);
#endif
    const size_t gtid = (size_t)bid * 512 + tid, gstride = (size_t)nb * 512;
    {
        const size_t n_na = (size_t)LB * DEPTH * 256 * 512 / 8;
        for (size_t i = gtid; i < 2 * n_na; i += gstride) {
            const bool isv = i >= n_na; const size_t j = isv ? i - n_na : i;
            const int d8 = (int)(j % 16), h = (int)((j / 16) % 4), t = (int)((j / 64) % 256); const size_t bl = j / (64 * 256);
            const float* s = p.in[isv ? I_CNAV : I_CNAK] + ((bl * 4 + h) * 256 + t) * 128 + d8 * 8;
            const float4 a = *(const float4*)s, b = *(const float4*)(s + 4);
            uint4 w; w.x = pack2(a.x, a.y); w.y = pack2(a.z, a.w); w.z = pack2(b.x, b.y); w.w = pack2(b.z, b.w);
            *(uint4*)(WSP(bf16_t, isv ? WS_CNAV : WS_CNAK) + (bl * 256 + t) * 512 + h * 128 + d8 * 8) = w;
        }
        const size_t n_g = (size_t)LB * DEPTH * 256 * 256 / 8;
        for (size_t i = gtid; i < 2 * n_g; i += gstride) {
            const bool isv = i >= n_g; const size_t j = isv ? i - n_g : i;
            const int d8 = (int)(j % 16), h = (int)((j / 16) % 2), t = (int)((j / 32) % 256); const size_t bl = j / (32 * 256);
            const float* s = p.in[isv ? I_CGV : I_CGK] + ((bl * 2 + h) * 256 + t) * 128 + d8 * 8;
            const float4 a = *(const float4*)s, b = *(const float4*)(s + 4);
            uint4 w; w.x = pack2(a.x, a.y); w.y = pack2(a.z, a.w); w.z = pack2(b.x, b.y); w.w = pack2(b.z, b.w);
            *(uint4*)(WSP(bf16_t, isv ? WS_CGV : WS_CGK) + (bl * 256 + t) * 256 + h * 128 + d8 * 8) = w;
        }
    }
    for (size_t i = gtid; i < 64 * 32; i += gstride) {
        const int pos = (int)(i / 32), k = (int)(i % 32);
        const float inv = powf(10000.0f, -(float)(2 * k) / 64.0f);
        const float ang = (float)pos * inv;
        WSP(float, WS_ROPE)[i] = cosf(ang); WSP(float, WS_ROPE)[64 * 32 + i] = sinf(ang);
    }
}

#ifndef NORM_NR
#define NORM_NR 2
#endif
constexpr int NORM_MAXC = 6;
__device__ __forceinline__ void phase_norm(const Params& p, int l, int which  , unsigned char* lds) {
    const int tid = opaque_tid(), lane = tid & 63, wv = tid >> 6;
    const float* X = WSP(float, WS_X); bf16_t* H = WSP(bf16_t, WS_H);
    const bool from_in = (l == 0 && which == 0);
    const float* g = p.in[I_NORMG] + ((size_t)l * 3 + which) * DM;
    const int rpb = (M + (int)gridDim.x - 1) / (int)gridDim.x;
    const int r0 = (int)blockIdx.x * rpb, r1 = r0 + rpb < M ? r0 + rpb : M;
    if (r0 >= r1) return;
    const int c_lo = cond_of_row(r0), c_hi = cond_of_row(r1 - 1);
    float* sw = (float*)lds;
    for (int ci = 0; ci <= c_hi - c_lo && ci < NORM_MAXC; ++ci) {
        const float* mv = WSP(float, WS_MODV) + ((size_t)l * NCOND + c_lo + ci) * NMOD + (size_t)which * 3 * DM;
        const int c = tid * 4;
        const vf4 gg = *(const vf4*)(g + c), sh = *(const vf4*)(mv + c), sc = *(const vf4*)(mv + DM + c);
        *(vf4*)(sw + (size_t)ci * 2 * DM + c) = gg * (1.f + sc);
        *(vf4*)(sw + (size_t)ci * 2 * DM + DM + c) = sh;
    }
    __syncthreads();
    for (int m0 = r0 + wv; m0 < r1; m0 += NORM_NR * 8) {
        int mm[NORM_NR]; bool has[NORM_NR];
#pragma unroll
        for (int k = 0; k < NORM_NR; ++k) { has[k] = m0 + k * 8 < r1; mm[k] = has[k] ? m0 + k * 8 : m0; }
        vf4 v[NORM_NR][8]; float ss[NORM_NR];
#pragma unroll
        for (int k = 0; k < NORM_NR; ++k) {
            const int m = mm[k];
            if (from_in || !XBF16) {
                const float* x = !from_in ? X + (size_t)m * DM : m < MC ? p.in[I_XP] + (size_t)m * DM : p.in[I_XS] + (size_t)(m - MC) * DM;
#pragma unroll
                for (int i = 0; i < 8; ++i) v[k][i] = *(const vf4*)(x + (i * 64 + lane) * 4);
            } else {
                const bf16_t* x = (const bf16_t*)X + (size_t)m * DM;
#pragma unroll
                for (int i = 0; i < 8; ++i) v[k][i] = ld4bf(x + (i * 64 + lane) * 4);
            }
        }
#pragma unroll
        for (int k = 0; k < NORM_NR; ++k) {
            ss[k] = 0.f;
#pragma unroll
            for (int i = 0; i < 8; ++i) ss[k] += v[k][i].x * v[k][i].x + v[k][i].y * v[k][i].y + v[k][i].z * v[k][i].z + v[k][i].w * v[k][i].w;
            ss[k] = wave_sum(ss[k]);
        }
#pragma unroll
        for (int k = 0; k < NORM_NR; ++k) {
            if (k > 0 && !has[k]) break;
            const int m = mm[k];
            const float* a = sw + (size_t)(cond_of_row(m) - c_lo) * 2 * DM;
            const float r = rsqrt_fast(ss[k] * (1.0f / DM) + EPS);
#pragma unroll
            for (int i = 0; i < 8; ++i) {
                const int c = (i * 64 + lane) * 4;
                const vf4 o = v[k][i] * r * *(const vf4*)(a + c) + *(const vf4*)(a + DM + c);
                if (which == 1 ? (G3_FP8 != 0) : g1_fp8(l, which >> 1)) *(unsigned*)((unsigned char*)H + (size_t)m * DM + c) = pack4_fp8(o.x, o.y, o.z, o.w);
                else { uint2 w; w.x = pack2(o.x, o.y); w.y = pack2(o.z, o.w); *(uint2*)(H + (size_t)m * DM + c) = w; }
            }
            if (G2_FP8 && which != 1 && lane < (FFP - FF) / 4) *(unsigned*)(WSP(unsigned char, WS_ACT) + (size_t)m * FFP + FF + 4 * lane) = 0u;
        }
    }
}

__device__ __forceinline__ float red16(float v);
__device__ __forceinline__ float ssq8(vf4 a, vf4 b) { const vf4 s = a * a + b * b; return (s.x + s.y) + (s.z + s.w); }
__device__ __forceinline__ uint4 pack8(vf4 a, vf4 b) { uint4 w; w.x = pack2(a.x, a.y); w.y = pack2(a.z, a.w); w.z = pack2(b.x, b.y); w.w = pack2(b.z, b.w); return w; }
constexpr int PL_CW = 0, PL_UP = PL_CW + 5 * 1536, PL_GB = PL_UP + 2 * 16 * 256, PL_NQ = PL_GB + 512, PL_ROPE = PL_NQ + 512, PL_END = PL_ROPE + 2 * 64 * 32;
__device__ __forceinline__ void phase_prep(const Params& p, int l, unsigned char* lds) {
    const int tid = opaque_tid(), lane = tid & 63, wv = tid >> 6, rg = lane >> 4, sub = lane & 15, c8 = sub * 8;
    const bf16_t* Z = WSP(bf16_t, WS_Z);
    float* sw = (float*)lds;
    {
        float cv[15]; vf4 uv[4], rv[2];
#pragma unroll
        for (int k = 0; k < 15; ++k) cv[k] = p.in[I_CONV][(size_t)l * 5 * 1536 + tid + 512 * k];
#pragma unroll
        for (int k = 0; k < 4; ++k) uv[k] = ((const vf4*)(p.in[I_GUP] + (size_t)l * 2 * 16 * 256))[tid + 512 * k];
        const float gb = p.in[I_GBIAS][(size_t)l * 512 + tid];
        const int v = tid >> 7, c = tid & 127; const float nq = ((v < 2 ? p.in[I_NAQKN] : p.in[I_GQAQKN]) + ((size_t)l * 2 + (v & 1)) * 128)[c];
#pragma unroll
        for (int k = 0; k < 2; ++k) rv[k] = ((const vf4*)WSP(float, WS_ROPE))[tid + 512 * k];
#pragma unroll
        for (int k = 0; k < 15; ++k) { const int i = tid + 512 * k, j = i / 1536, col = i % 1536; sw[PL_CW + j * 1536 + ((col >> 2) & 1) * 768 + (col >> 3) * 4 + (col & 3)] = cv[k]; }
#pragma unroll
        for (int k = 0; k < 4; ++k) ((vf4*)(sw + PL_UP))[tid + 512 * k] = uv[k];
        sw[PL_GB + tid] = gb;
        sw[PL_NQ + v * 128 + ((c >> 2) & 1) * 64 + (c >> 3) * 4 + (c & 3)] = nq;
#pragma unroll
        for (int k = 0; k < 2; ++k) ((vf4*)(sw + PL_ROPE))[tid + 512 * k] = rv[k];
    }
    __syncthreads();
    const float* ropec = sw + PL_ROPE; const float* ropes = ropec + 64 * 32;
    const float* wnq = sw + PL_NQ + sub * 4; const float* wnk = wnq + 128;
    const float* wgq = wnq + 256; const float* wgk = wnq + 384;
    const float* cw = sw + PL_CW + (rg * 16 + sub) * 4;
    const int rpw = (M + (int)gridDim.x * 8 - 1) / ((int)gridDim.x * 8);
    for (int m = ((int)blockIdx.x * 8 + wv) * rpw, mend = (m + rpw < M ? m + rpw : M); m < mend; ++m) {
        const bf16_t* z = Z + (size_t)m * NINP;
        const bool ctx = m < MC;
        const int b = ctx ? m / CT : (m - MC) / LT, t = ctx ? m % CT : (m - MC) % LT, T = ctx ? CT : LT;
        const int ho = rg * 128 + c8;
        uint4 rz[5]; uint2 rgz[2][4];
        {
            const bf16_t* zkv = z + (rg < 2 ? Z_GQK + rg * 128 : Z_GQV + (rg - 2) * 128) + c8;
            rz[0] = *(const uint4*)(z + Z_NAQ + ho); rz[1] = *(const uint4*)(z + Z_NAK + ho); rz[2] = *(const uint4*)(z + Z_NAV + ho); rz[3] = *(const uint4*)(z + Z_GQQ + ho); rz[4] = *(const uint4*)zkv;
#pragma unroll
            for (int dir = 0; dir < 2; ++dir)
#pragma unroll
                for (int r4 = 0; r4 < 4; ++r4) rgz[dir][r4] = *(const uint2*)(z + (dir ? Z_GB : Z_GF) + 4 * r4);
        }
        uint4 rcz[3][5];
#pragma unroll
        for (int part = 0; part < 3; ++part)
#pragma unroll
            for (int j = 0; j < 5; ++j) { const int tt = t + j - 2;
                rcz[part][j] = (tt >= 0 && tt < T) ? *(const uint4*)(Z + (size_t)(m + j - 2) * NINP + Z_DQKV + part * 512 + rg * 128 + c8) : make_uint4(0u, 0u, 0u, 0u); }
        asm volatile("" ::: "memory");
        {
            vf4 q0, q1, k0, k1, v0, v1, g0, g1, x0, x1;
            unp8bf(rz[0], q0, q1); unp8bf(rz[1], k0, k1); unp8bf(rz[2], v0, v1); unp8bf(rz[3], g0, g1); unp8bf(rz[4], x0, x1);
            float r = rsqrt_fast(red16(ssq8(q0, q1)) * (1.0f / 128) + EPS);
            q0 = q0 * r * *(const vf4*)wnq; q1 = q1 * r * *(const vf4*)(wnq + 64);
            *(uint4*)(WSP(bf16_t, WS_NAQ) + (size_t)m * 512 + ho) = pack8(q0, q1);
            r = rsqrt_fast(red16(ssq8(k0, k1)) * (1.0f / 128) + EPS);
            k0 = k0 * r * *(const vf4*)wnk; k1 = k1 * r * *(const vf4*)(wnk + 64);
            *(uint4*)(WSP(bf16_t, WS_NAK) + (size_t)m * 512 + ho) = pack8(k0, k1);
            *(uint4*)(WSP(bf16_t, WS_NAV) + (size_t)m * 512 + ho) = pack8(v0, v1);
            if (ctx) {
                const size_t o = ((((size_t)b * DEPTH + l) * 4 + rg) * CT + t) * 128 + c8;
                *(vf4*)(p.out + O_NAK + o) = k0; *(vf4*)(p.out + O_NAK + o + 4) = k1; *(vf4*)(p.out + O_NAV + o) = v0; *(vf4*)(p.out + O_NAV + o + 4) = v1;
            }
            r = rsqrt_fast(red16(ssq8(g0, g1)) * (1.0f / 128) + EPS);
            g0 = g0 * r * *(const vf4*)wgq; g1 = g1 * r * *(const vf4*)(wgq + 64);
            const float rk = rsqrt_fast(red16(ssq8(x0, x1)) * (1.0f / 128) + EPS);
            if (rg < 2) { x0 = x0 * rk * *(const vf4*)wgk; x1 = x1 * rk * *(const vf4*)(wgk + 64); }
            if (!ctx) {
                const int pos = sub < 8 ? (t >> 6) : (t & 63), ai = pos * 32 + (c8 & 31);
                const vf4 c0 = *(const vf4*)(ropec + ai), c1 = *(const vf4*)(ropec + ai + 4), s0 = *(const vf4*)(ropes + ai), s1 = *(const vf4*)(ropes + ai + 4);
                const bool hi = (sub & 4) != 0;
                vf4 pg0, pg1, px0, px1;
#pragma unroll
                for (int j = 0; j < 4; ++j) { pg0[j] = __shfl_xor(g0[j], 4); pg1[j] = __shfl_xor(g1[j], 4); px0[j] = __shfl_xor(x0[j], 4); px1[j] = __shfl_xor(x1[j], 4); }
                g0 = hi ? pg0 * s0 + g0 * c0 : g0 * c0 - pg0 * s0; g1 = hi ? pg1 * s1 + g1 * c1 : g1 * c1 - pg1 * s1;
                if (rg < 2) { x0 = hi ? px0 * s0 + x0 * c0 : x0 * c0 - px0 * s0; x1 = hi ? px1 * s1 + x1 * c1 : x1 * c1 - px1 * s1; }
            }
            *(uint4*)(WSP(bf16_t, WS_GQ) + (size_t)m * 512 + ho) = pack8(g0, g1);
            *(uint4*)(WSP(bf16_t, rg < 2 ? WS_GK : WS_GV) + (size_t)m * 256 + (rg & 1) * 128 + c8) = pack8(x0, x1);
            if (ctx) {
                const size_t o = ((((size_t)b * DEPTH + l) * 2 + (rg & 1)) * CT + t) * 128 + c8;
                float* dst = p.out + (rg < 2 ? O_GK : O_GV) + o;
                *(vf4*)dst = x0; *(vf4*)(dst + 4) = x1;
            }
        }
        asm volatile("" ::: "memory");
        {
#pragma unroll
            for (int dir = 0; dir < 2; ++dir) {
                const float* up = sw + PL_UP + dir * 16 * 256 + 4 * lane;
                vf4 acc = *(const vf4*)(sw + PL_GB + dir * 256 + 4 * lane);
#pragma unroll
                for (int r4 = 0; r4 < 4; ++r4) {
                    const vf4 gv = unp4bf(rgz[dir][r4]);
                    acc += gv.x * *(const vf4*)(up + (4 * r4 + 0) * 256) + gv.y * *(const vf4*)(up + (4 * r4 + 1) * 256) + gv.z * *(const vf4*)(up + (4 * r4 + 2) * 256) + gv.w * *(const vf4*)(up + (4 * r4 + 3) * 256);
                }
                vf4 o;
#pragma unroll
                for (int j = 0; j < 4; ++j) o[j] = logsigmoid_fast(acc[j]) * (1.0f / 16.0f);
                *(vf4*)(WSP(float, dir ? WS_AB : WS_AF) + (size_t)m * 256 + 4 * lane) = o;
            }
        }
        asm volatile("" ::: "memory");
        {
#pragma unroll
            for (int part = 0; part < 3; ++part) {
                vf4 a0 = (vf4){0.f, 0.f, 0.f, 0.f}, a1 = a0;
#pragma unroll
                for (int j = 0; j < 5; ++j) {
                    const float* cj = cw + j * 1536 + part * 256;
                    vf4 z0, z1; unp8bf(rcz[part][j], z0, z1);
                    a0 += *(const vf4*)cj * z0; a1 += *(const vf4*)(cj + 768) * z1;
                }
#pragma unroll
                for (int j = 0; j < 4; ++j) { a0[j] = silu_fast(a0[j]); a1[j] = silu_fast(a1[j]); }
                if (part < 2) { const float r = rsqrt_fast(red16(ssq8(a0, a1)) + EPS) * (part == 0 ? 0.08838834764831845f : 1.0f); a0 *= r; a1 *= r; }
                *(uint4*)(WSP(bf16_t, part == 0 ? WS_DQ : part == 1 ? WS_DK : WS_DV) + (size_t)m * 512 + rg * 128 + c8) = pack8(a0, a1);
                asm volatile("" ::: "memory");
            }
            if (lane < 8) {
                const float beta = 1.0f / (1.0f + expf(-bf2f(z[Z_DB + lane])));
                const float g = -expf(p.in[I_ALOG][(size_t)l * 8 + lane]) * softplus_f(bf2f(z[Z_DA + lane]) + p.in[I_DTB][(size_t)l * 8 + lane]);
                float* ba = WSP(float, WS_DBA) + (size_t)m * 16;
                ba[lane] = beta; ba[8 + lane] = g;
            }
        }
    }
}

typedef float vf2 __attribute__((ext_vector_type(2)));
__device__ __forceinline__ float dpp_f(float v, const int ctrl) { return v; }
#define DPPF(v, ctrl) __int_as_float(__builtin_amdgcn_mov_dpp(__float_as_int(v), (ctrl), 0xF, 0xF, true))
__device__ __forceinline__ float red8(float v) { v += DPPF(v, 0xB1); v += DPPF(v, 0x4E); v += DPPF(v, 0x141); return v; }
__device__ __forceinline__ float red16(float v) { v = red8(v); v += DPPF(v, 0x140); return v; }

__device__ __forceinline__ void phase_post(const Params& p, int l) {
    const int tid = opaque_tid(), lane = tid & 63, wv = tid >> 6, rg = lane >> 4, c8 = (lane & 15) * 8;
    const bf16_t* Z = WSP(bf16_t, WS_Z); bf16_t* MRG = WSP(bf16_t, WS_MRG);
    const float* wgp = p.in[I_GLAON] + (size_t)l * 128 + c8; const float* wdp = p.in[I_GDNON] + (size_t)l * 128 + c8;
    const vf4 wg0 = *(const vf4*)wgp, wg1 = *(const vf4*)(wgp + 4), wd0 = *(const vf4*)wdp, wd1 = *(const vf4*)(wdp + 4);
    const int ho = rg * 128 + c8, nw = (int)gridDim.x * 8;
    for (int m0 = blockIdx.x * 8 + wv; m0 < M; m0 += 2 * nw) {
        const bool has1 = m0 + nw < M; const int mm[2] = {m0, has1 ? m0 + nw : m0};
        uint4 rf[2][2], rb[2][2], rz[2][2];
#pragma unroll
        for (int k = 0; k < 2; ++k)
#pragma unroll
            for (int g = 0; g < 2; ++g) {
                const size_t o = (size_t)mm[k] * 512 + ho;
                rf[k][g] = *(const uint4*)(WSP(bf16_t, g ? WS_DOF : WS_GOF) + o); rb[k][g] = *(const uint4*)(WSP(bf16_t, g ? WS_DOB : WS_GOB) + o);
                rz[k][g] = *(const uint4*)(Z + (size_t)mm[k] * NINP + (g ? Z_DZ : Z_GLR) + ho);
            }
        asm volatile("" ::: "memory");
#pragma unroll
        for (int k = 0; k < 2; ++k) {
            if (k == 1 && !has1) break;
#pragma unroll
            for (int g = 0; g < 2; ++g) {
                vf4 a0, a1, b0, b1, g0, g1; unp8bf(rf[k][g], a0, a1); unp8bf(rb[k][g], b0, b1); unp8bf(rz[k][g], g0, g1); a0 += b0; a1 += b1;
                const float r = rsqrt_fast(red16(ssq8(a0, a1)) * (1.0f / 128) + EPS);
                a0 = a0 * r * (g ? wd0 : wg0); a1 = a1 * r * (g ? wd1 : wg1);
#pragma unroll
                for (int j = 0; j < 4; ++j) { a0[j] *= silu_fast(g0[j]); a1[j] *= silu_fast(g1[j]); }
                *(uint4*)(MRG + (size_t)mm[k] * DM + (g ? 1536 : 512) + ho) = pack8(a0, a1);
            }
        }
    }
}
#define XB_TMO      128
#define XB_XCNT(j)  (256  + 64 * (j))
#define XB_XSUB(j)  (1280 + 64 * (j))
#define XB_XGEN(j)  (2304 + 64 * (j))
#define XB_TOP      3328
#define XB_TOPGEN   3392
#define XCD_BAR_WORDS 3456
#define XB_SPIN_CAP (1u << 22)
#define LAS __attribute__((address_space(3)))

__device__ __forceinline__ unsigned xb_ld(unsigned* p)              { return __hip_atomic_load(p, __ATOMIC_RELAXED, __HIP_MEMORY_SCOPE_AGENT); }
__device__ __forceinline__ unsigned xb_add(unsigned* p, unsigned v) { return __hip_atomic_fetch_add(p, v, __ATOMIC_RELAXED, __HIP_MEMORY_SCOPE_AGENT); }
__device__ __forceinline__ unsigned xb_xcc_id() { return (unsigned)__builtin_amdgcn_s_getreg((3 << 11) | 20) & 0xFu; }
#define XB_SPIN(cond, bar) do { unsigned _sp = 0; while (cond) { __builtin_amdgcn_s_sleep(1); \
    if ((++_sp & 255u) == 0u) { if (xb_ld(&(bar)[XB_TMO])) break; if (_sp > XB_SPIN_CAP) { atomicAdd(&(bar)[XB_TMO], 1u); break; } } } } while (0)

struct XcdBarrier {
    unsigned* bar; unsigned x;
    volatile LAS unsigned* st;
};

__device__ __forceinline__ XcdBarrier xcd_barrier_post(unsigned* bar, volatile LAS unsigned* st) {
    XcdBarrier b; b.bar = bar; b.x = xb_xcc_id(); b.st = st;
    if (threadIdx.x == 0) (void)xb_add(&bar[XB_XCNT(b.x)], 1u);
    return b;
}
__device__ __forceinline__ void xcd_barrier_complete(unsigned* bar, unsigned x, unsigned& nloc, unsigned& nx) {
    const unsigned G = gridDim.x * gridDim.y * gridDim.z;
    unsigned sum, cnt, mine, sp = 0u;
    for (;;) {
        sum = 0u; cnt = 0u; mine = 0u;
#pragma unroll
        for (unsigned j = 0; j < 16; ++j) { const unsigned c = xb_ld(&bar[XB_XCNT(j)]); sum += c; cnt += (c > 0u) ? 1u : 0u; mine = (j == x) ? c : mine; }
        if (sum == G) break;
        __builtin_amdgcn_s_sleep(1);
        if ((++sp & 255u) == 0u) { if (xb_ld(&bar[XB_TMO])) break; if (sp > XB_SPIN_CAP) { atomicAdd(&bar[XB_TMO], 1u); break; } }
    }
    nloc = mine > 0u ? mine : 1u; nx = cnt > 0u ? cnt : 1u;
}

__device__ __forceinline__ void xcd_barrier(const XcdBarrier& b) {
    asm volatile("s_waitcnt vmcnt(0)" ::: "memory");
    __syncthreads();
    if (threadIdx.x == 0) {
        unsigned* bar = b.bar;
        __builtin_amdgcn_s_waitcnt(0);
        unsigned nloc = b.st[0], nx = b.st[1];
        if (nloc == 0u) { xcd_barrier_complete(bar, b.x, nloc, nx); b.st[0] = nloc; b.st[1] = nx; }
        const unsigned old = xb_add(&bar[XB_XSUB(b.x)], 1u);
        const unsigned gen = old / nloc;
        if (old + 1u == (gen + 1u) * nloc) {
            __builtin_amdgcn_fence(__ATOMIC_RELEASE, "agent");
            asm volatile("s_waitcnt vmcnt(0)" ::: "memory");
            const unsigned og = xb_add(&bar[XB_TOP], 1u);
            const unsigned tg = og / nx;
            if (og + 1u == (tg + 1u) * nx) xb_add(&bar[XB_TOPGEN], 1u);
            else XB_SPIN(xb_ld(&bar[XB_TOPGEN]) == tg, bar);
            __builtin_amdgcn_fence(__ATOMIC_ACQUIRE, "agent");
            xb_add(&bar[XB_XGEN(b.x)], 1u);
            asm volatile("s_waitcnt vmcnt(0)" ::: "memory");
        } else {
            XB_SPIN(xb_ld(&bar[XB_XGEN(b.x)]) == gen, bar);
            __builtin_amdgcn_fence(__ATOMIC_ACQUIRE, "agent");
            asm volatile("s_waitcnt vmcnt(0)" ::: "memory");
        }
    }
    __syncthreads();
}

#ifndef NT_STORES
#define NT_STORES 0
#endif
namespace pg8 {
#define PG8_LAS __attribute__((address_space(3)))
typedef unsigned short bf16_t;
typedef short bf16x8 __attribute__((ext_vector_type(8)));
typedef float f32x4 __attribute__((ext_vector_type(4)));
typedef unsigned u32x4 __attribute__((ext_vector_type(4)));
typedef unsigned u32x2 __attribute__((ext_vector_type(2)));
typedef int v4i32 __attribute__((ext_vector_type(4)));
typedef int v8i32 __attribute__((ext_vector_type(8)));
constexpr int BM = 256, BK = 64, HALF = 128, HTB = HALF * BK * 2  , STAGE_BYTES = 8 * HTB, NXCD = 8, WGM = 8;

__host__ __device__ __forceinline__ int lds_byte(int r, int c) { const int st = (r >> 4) * 2 + (c >> 5), rr = r & 15, cc = c & 31, ob = rr * 64 + cc * 2; return st * 1024 + (ob ^ (((ob >> 9) & 1) << 5)); }
__host__ __device__ __forceinline__ void stage_rc(int b, int& R, int& C) { const int st = b / 1024, sb = b % 1024, swz = sb ^ (((sb >> 9) & 1) << 5); R = (st >> 1) * 16 + swz / 64; C = (st & 1) * 32 + (swz % 64) / 2; }
__host__ __device__ __forceinline__ int perm32(int rho) { const int n = rho >> 4, i = rho & 15; return 8 * (i >> 2) + 4 * n + (i & 3); }

struct Unit { int pm, pn, k0, nt, at, slot, msk; };
struct Gemm { const bf16_t* A; const bf16_t* Bt; int M, N, K; };

struct StaticOrder {
    int nM, nN, nwg, G, c, ntk, split, msplit;
    __host__ __device__ void init(int M, int N, int K, int G_, int c_, int split_ = 0) { nM = M / BM; nN = N / BM; nwg = nM * nN; G = G_; c = c_; ntk = K / BK; const int rem = nwg % G_; split = (split_ == 1 && rem > 0 && 2 * rem == G_ && ntk >= 8) ? 1 : 0; msplit = (split_ == 2 && rem > 0 && 2 * rem <= G_) ? 1 : 0; }
    __host__ __device__ bool next(int i, Unit& u) const {
        long L = (long)i * G + c; u.k0 = 0; u.nt = ntk; u.at = 0; u.slot = 0; u.msk = 3;
        if (msplit && i == nwg / G) { const int rem = nwg % G; if (c >= 2 * rem) return false; L = (long)i * G + (c % rem); u.msk = (c / rem) ? 2 : 1; }
        if (split && i == nwg / G) { const int rem = nwg % G, sl = c / rem, h0 = ((ntk / 2) + 1) & ~1; L = (long)i * G + (c % rem); u.k0 = sl ? h0 * BK : 0; u.nt = sl ? ntk - h0 : h0; u.at = sl ? 1 : 2; u.slot = c % rem; }
        if (L >= nwg) return false;
        int wgid = (int)L; { const int q = nwg / NXCD, r = nwg % NXCD, xcd = wgid % NXCD, off = wgid / NXCD; wgid = (xcd < r ? xcd * (q + 1) : r * (q + 1) + (xcd - r) * q) + off; }
        const int nig = WGM * nN, gid = wgid / nig, fm = gid * WGM, gsz = (nM - fm) < WGM ? (nM - fm) : WGM;
        u.pm = fm + ((wgid % nig) % gsz); u.pn = (wgid % nig) / gsz; return true;
    }
    __device__ __forceinline__ void a_ready(const Unit&) const {}
    __device__ __forceinline__ void done(const Unit&) const {}
};
__device__ __forceinline__ unsigned cvt_pk_bf16(float lo, float hi) { unsigned r; asm volatile("v_cvt_pk_bf16_f32 %0, %1, %2" : "=v"(r) : "v"(lo), "v"(hi)); return r; }
struct EpiF32 {
    static constexpr bool PERM = false, AFTER_DRAIN = false;
    float* C; int ldc; const float* bias;
    __device__ __forceinline__ void operator()(const f32x4 (&acc)[2][2][4][2], const Unit& u, int wr, int wc, int fr, int fq) const {
        const int row0 = u.pm * BM + wr * 64 + fr, col0 = u.pn * BM + wc * 32 + 4 * fq;
        f32x4 bv[2][2];
#pragma unroll
        for (int bj = 0; bj < 2; ++bj)
#pragma unroll
            for (int n = 0; n < 2; ++n) bv[bj][n] = bias ? *(const f32x4*)(bias + col0 + bj * HALF + n * 16) : (f32x4){0.f, 0.f, 0.f, 0.f};
#pragma unroll
        for (int ai = 0; ai < 2; ++ai)
#pragma unroll
            for (int m = 0; m < 4; ++m) { float* rowp = C + (size_t)(row0 + ai * HALF + m * 16) * ldc + col0;
#pragma unroll
                for (int bj = 0; bj < 2; ++bj)
#pragma unroll
                    for (int n = 0; n < 2; ++n) *(f32x4*)(rowp + bj * HALF + n * 16) = acc[ai][bj][m][n] + bv[bj][n]; }
    }
};

struct EpiSwiGLU {
    static constexpr bool PERM = true, AFTER_DRAIN = false;
    bf16_t* O; int ldc;
    __device__ __forceinline__ void operator()(const f32x4 (&acc)[2][2][4][2], const Unit& u, int wr, int wc, int fr, int fq) const {
        const int row0 = u.pm * BM + wr * 64 + fr, col0 = u.pn * 128 + wc * 32 + 8 * fq;
#pragma unroll
        for (int ai = 0; ai < 2; ++ai) if ((u.msk >> ai) & 1)
#pragma unroll
            for (int m = 0; m < 4; ++m) { bf16_t* rowp = O + (size_t)(row0 + ai * HALF + m * 16) * ldc + col0;
                const f32x4 g0 = acc[ai][0][m][0], g1 = acc[ai][0][m][1], u0 = acc[ai][1][m][0], u1 = acc[ai][1][m][1];
                float r[8];
#pragma unroll
                for (int j = 0; j < 4; ++j) {
                    r[j]     = g0[j] * __builtin_amdgcn_rcpf(1.0f + __builtin_amdgcn_exp2f(-1.4426950408889634f * g0[j])) * u0[j];
                    r[4 + j] = g1[j] * __builtin_amdgcn_rcpf(1.0f + __builtin_amdgcn_exp2f(-1.4426950408889634f * g1[j])) * u1[j]; }
                u32x4 w; w.x = cvt_pk_bf16(r[0], r[1]); w.y = cvt_pk_bf16(r[2], r[3]); w.z = cvt_pk_bf16(r[4], r[5]); w.w = cvt_pk_bf16(r[6], r[7]);
#if NT_STORES
                __builtin_nontemporal_store(w, (u32x4*)rowp);
#else
                *(u32x4*)rowp = w;
#endif
                }
    }
};
struct EpiSwiGLU8 {
    static constexpr bool PERM = true, AFTER_DRAIN = false;
    static constexpr int NST = 4;
    unsigned char* O; int ldc; float wscale;
    __device__ __forceinline__ void operator()(const f32x4 (&acc)[2][2][4][2], const Unit& u, int wr, int wc, int fr, int fq) const {
        const int row0 = u.pm * BM + wr * 64 + fr, col0 = u.pn * 128 + wc * 32 + 8 * fq;
#pragma unroll
        for (int ai = 0; ai < 2; ++ai) if ((u.msk >> ai) & 1)
#pragma unroll
            for (int m = 0; m < 4; ++m) { unsigned char* rowp = O + (size_t)(row0 + ai * HALF + m * 16) * ldc + col0;
                f32x4 g0 = acc[ai][0][m][0], g1 = acc[ai][0][m][1], u0 = acc[ai][1][m][0], u1 = acc[ai][1][m][1];
                asm volatile("" : "+v"(g0), "+v"(g1), "+v"(u0), "+v"(u1));
                g0 *= wscale; g1 *= wscale; u0 *= wscale; u1 *= wscale;
                float r[8];
#pragma unroll
                for (int j = 0; j < 4; ++j) {
                    r[j]     = g0[j] * __builtin_amdgcn_rcpf(1.0f + __builtin_amdgcn_exp2f(-1.4426950408889634f * g0[j])) * u0[j];
                    r[4 + j] = g1[j] * __builtin_amdgcn_rcpf(1.0f + __builtin_amdgcn_exp2f(-1.4426950408889634f * g1[j])) * u1[j]; }
                uint2 w; w.x = pack4_fp8(r[0], r[1], r[2], r[3]); w.y = pack4_fp8(r[4], r[5], r[6], r[7]);
                *(uint2*)rowp = w; asm volatile("" ::: "memory"); }
    }
};
struct EpiBf16Plain {
    static constexpr bool PERM = true, AFTER_DRAIN = false;
    static constexpr int NST = 8;
    bf16_t* O; int ldc; float coef;
    __device__ __forceinline__ void operator()(const f32x4 (&acc)[2][2][4][2], const Unit& u, int wr, int wc, int fr, int fq) const {
        const int row0 = u.pm * BM + wr * 64 + fr, col0 = u.pn * BM + wc * 32 + 8 * fq;
#pragma unroll
        for (int ai = 0; ai < 2; ++ai) if ((u.msk >> ai) & 1)
#pragma unroll
            for (int m = 0; m < 4; ++m) { bf16_t* rowp = O + (size_t)(row0 + ai * HALF + m * 16) * ldc + col0;
#pragma unroll
                for (int bj = 0; bj < 2; ++bj) { const f32x4 v0 = acc[ai][bj][m][0] * coef, v1 = acc[ai][bj][m][1] * coef;
                    u32x4 w; w.x = pack2(v0[0], v0[1]); w.y = pack2(v0[2], v0[3]); w.z = pack2(v1[0], v1[1]); w.w = pack2(v1[2], v1[3]);
                    *(u32x4*)(rowp + bj * HALF) = w; } }
    }
};
struct EpiResid {
    static constexpr bool PERM = false, AFTER_DRAIN = false;
    const float* res; float* out; int ldc; const float* gate0; float coef;
    float* slab; unsigned* flags; unsigned target;
    const float* res_hi; int row_hi;
    int res_bf16, out_bf16;
    __device__ __forceinline__ void operator()(const f32x4 (&acc)[2][2][4][2], const Unit& u, int wr, int wc, int fr, int fq) const {
        const int tidx = ((wr * 4 + wc) * 4 + fq) * 16 + fr;
        if (u.at == 1) {
            const __amdgpu_buffer_rsrc_t rs = __builtin_amdgcn_make_buffer_rsrc((void*)slab, 0, 0x7FFFFFF0, 0x00020000);
            const unsigned base = ((unsigned)u.slot * 32u * 512u + (unsigned)tidx) * 16u;
#pragma unroll
            for (int ai = 0; ai < 2; ++ai)
#pragma unroll
                for (int bj = 0; bj < 2; ++bj)
#pragma unroll
                    for (int m = 0; m < 4; ++m)
#pragma unroll
                        for (int n = 0; n < 2; ++n) { const f32x4 v = acc[ai][bj][m][n]; u32x4 w; w.x = __float_as_uint(v[0]); w.y = __float_as_uint(v[1]); w.z = __float_as_uint(v[2]); w.w = __float_as_uint(v[3]);
                            __builtin_amdgcn_raw_buffer_store_b128(w, rs, base + (unsigned)((((ai * 2 + bj) * 4 + m) * 2 + n) * 512 * 16), 0, 16); }
            asm volatile("s_waitcnt vmcnt(0)" ::: "memory");
            if ((tidx & 63) == 0) __hip_atomic_fetch_add(flags + 64 * u.slot, 1u, __ATOMIC_RELAXED, __HIP_MEMORY_SCOPE_AGENT);
            return;
        }
        const float* part = nullptr;
        if (u.at == 2) {
            unsigned spins = 0;
            while (__hip_atomic_load(flags + 64 * u.slot, __ATOMIC_RELAXED, __HIP_MEMORY_SCOPE_AGENT) < target) { __builtin_amdgcn_s_sleep(2); if (++spins > (1u << 22)) break; }
            __builtin_amdgcn_fence(__ATOMIC_ACQUIRE, "agent");
            asm volatile("s_waitcnt vmcnt(0)" ::: "memory");
            part = slab + ((size_t)u.slot * 32 * 512 + tidx) * 4;
        }
        const int row0 = u.pm * BM + wr * 64 + fr, col0 = u.pn * BM + wc * 32 + 4 * fq;
        const float* gate = gate0 + (size_t)cond_of_row(u.pm * BM) * NMOD;
        const float* rbase = (u.pm * BM >= row_hi) ? res_hi - (size_t)row_hi * ldc : res;
        f32x4 gv[2][2];
#pragma unroll
        for (int bj = 0; bj < 2; ++bj)
#pragma unroll
            for (int n = 0; n < 2; ++n) gv[bj][n] = *(const f32x4*)(gate + col0 + bj * HALF + n * 16) * coef;
#pragma unroll
        for (int ai = 0; ai < 2; ++ai) if ((u.msk >> ai) & 1) {
            f32x4 bs[4][2][2];
#pragma unroll
            for (int m = 0; m < 4; ++m) { const size_t off = (size_t)(row0 + ai * HALF + m * 16) * ldc + col0;
#pragma unroll
                for (int bj = 0; bj < 2; ++bj)
#pragma unroll
                    for (int n = 0; n < 2; ++n) {
                        const size_t eo = off + bj * HALF + n * 16;
                        if (res_bf16) { const u32x2 w = *(const u32x2*)((const bf16_t*)rbase + eo); bs[m][bj][n][0] = __uint_as_float(w.x << 16); bs[m][bj][n][1] = __uint_as_float(w.x & 0xFFFF0000u); bs[m][bj][n][2] = __uint_as_float(w.y << 16); bs[m][bj][n][3] = __uint_as_float(w.y & 0xFFFF0000u); }
                        else bs[m][bj][n] = *(const f32x4*)(rbase + eo); } }
            asm volatile("" ::: "memory");
#pragma unroll
            for (int m = 0; m < 4; ++m) { const size_t off = (size_t)(row0 + ai * HALF + m * 16) * ldc + col0;
#pragma unroll
                for (int bj = 0; bj < 2; ++bj)
#pragma unroll
                    for (int n = 0; n < 2; ++n) {
                        f32x4 a = acc[ai][bj][m][n];
                        if (part) a += *(const f32x4*)(part + (size_t)((((ai * 2 + bj) * 4 + m) * 2 + n) * 512 * 4));
                        const size_t eo = off + bj * HALF + n * 16;
                        const f32x4 o = bs[m][bj][n] + gv[bj][n] * a;
                        if (out_bf16) { u32x2 w; w.x = cvt_pk_bf16(o[0], o[1]); w.y = cvt_pk_bf16(o[2], o[3]); *(u32x2*)((bf16_t*)out + eo) = w; }
                        else *(f32x4*)(out + eo) = o; } }
            asm volatile("" ::: "memory"); }
    }
};
template <class Epi, class Sched, bool STAMP = false, int FP8 = 0, bool GUARD = true, bool PRESTAGE = false>
__device__ __forceinline__ void gemm_phase(PG8_LAS unsigned char* lds, const Gemm g, const Sched& S, const Epi& E, unsigned long long* stamps) {
    const int tid = opaque_tid(), wid = __builtin_amdgcn_readfirstlane(tid >> 6), lane = tid & 63, wr = wid >> 2, wc = wid & 3, fr = lane & 15, fq = lane >> 4;
    const int K = g.K;
    int ts_lo = 0, ts_hi = 0, nts = 0; const unsigned long long rt_entry = STAMP ? (unsigned long long)wall_clock64() : 0ull;
#define PG8_STAMP() do { if (STAMP && wid == 0 && nts < 64) { const unsigned long long _c = (unsigned long long)clock64(); \
        ts_lo = (lane == nts) ? (int)(unsigned)_c : ts_lo; ts_hi = (lane == nts) ? (int)(unsigned)(_c >> 32) : ts_hi; ++nts; } } while (0)
    PG8_STAMP();
    unsigned voffA[2], voffB[2];
#pragma unroll
    for (int i = 0; i < 2; ++i) { int R, C; stage_rc(tid * 16 + i * 8192, R, C); const int Rb = Epi::PERM ? ((R & ~31) + perm32(R & 31)) : R;
        voffA[i] = (unsigned)(R * K + C) * 2u; voffB[i] = (unsigned)(Rb * K + C) * 2u; }
    const size_t kstep = (size_t)(BK * 2);
    const size_t hstep = (size_t)HALF * K * 2;
    const size_t tstep = 2 * hstep;
    const unsigned ldsw = (unsigned)wid * 1024u;
    const int aoff = lds_byte(wr * 64 + fr, fq * 8), boff = lds_byte(wc * 32 + fr, fq * 8);
#define PG8_SA(b, h) (((b) * 2 + (h)) * HTB)
#define PG8_SB(b, h) ((4 + (b) * 2 + (h)) * HTB)
#define PG8_STAGE(bufoff, gbase, voff) do { _Pragma("unroll") for (int _i = 0; _i < 2; ++_i) \
        __builtin_amdgcn_global_load_lds((const unsigned*)((const char*)(gbase) + (voff)[_i]), (PG8_LAS unsigned*)(lds + (bufoff) + ldsw + _i * 8192), 16, 0, 0); } while (0)
#define PG8_LDA(dst, b, h) do { _Pragma("unroll") for (int m = 0; m < 4; ++m) dst[m] = __builtin_shufflevector(*(const PG8_LAS v4i32*)(lds + PG8_SA(b, h) + aoff + m * 2048), *(const PG8_LAS v4i32*)(lds + PG8_SA(b, h) + aoff + m * 2048 + 1024), 0, 1, 2, 3, 4, 5, 6, 7); } while (0)
#define PG8_LDB(dst, b, h) do { _Pragma("unroll") for (int n = 0; n < 2; ++n) dst[n] = __builtin_shufflevector(*(const PG8_LAS v4i32*)(lds + PG8_SB(b, h) + boff + n * 2048), *(const PG8_LAS v4i32*)(lds + PG8_SB(b, h) + boff + n * 2048 + 1024), 0, 1, 2, 3, 4, 5, 6, 7); } while (0)
#define PG8_HALF(v, k) __builtin_bit_cast(bf16x8, __builtin_shufflevector(v, v, 4 * (k), 4 * (k) + 1, 4 * (k) + 2, 4 * (k) + 3))
#define PG8_MMA(ai, bj, At, Bt) do { __builtin_amdgcn_s_setprio(1); _Pragma("unroll") for (int m = 0; m < 4; ++m) _Pragma("unroll") for (int n = 0; n < 2; ++n) { \
        acc[ai][bj][m][n] = __builtin_amdgcn_mfma_f32_16x16x32_bf16(PG8_HALF(Bt[n], 0), PG8_HALF(At[m], 0), acc[ai][bj][m][n], 0, 0, 0); \
        acc[ai][bj][m][n] = __builtin_amdgcn_mfma_f32_16x16x32_bf16(PG8_HALF(Bt[n], 1), PG8_HALF(At[m], 1), acc[ai][bj][m][n], 0, 0, 0); } __builtin_amdgcn_s_setprio(0); } while (0)
#define PG8_MMA8(ai, bj, At, Bt) do { __builtin_amdgcn_s_setprio(1); _Pragma("unroll") for (int m = 0; m < 4; ++m) _Pragma("unroll") for (int n = 0; n < 2; ++n) \
        acc[ai][bj][m][n] = __builtin_amdgcn_mfma_scale_f32_16x16x128_f8f6f4(Bt[n], At[m], acc[ai][bj][m][n], 0, 0, 0, 127, 0, 127); __builtin_amdgcn_s_setprio(0); } while (0)
#define PG8_Q64(v, q) __builtin_bit_cast(long, __builtin_shufflevector(v, v, 2 * (q), 2 * (q) + 1))
#define PG8_M8L1(ai, bj, m, n, q) acc[ai][bj][m][n] = __builtin_amdgcn_mfma_f32_16x16x32_fp8_fp8(PG8_Q64(Bt_[n], q), PG8_Q64(At_[m], q), acc[ai][bj][m][n], 0, 0, 0)
#define PG8_MMA8L(ai, bj, At, Bt) do { auto& At_ = At; auto& Bt_ = Bt; __builtin_amdgcn_s_setprio(1); _Pragma("unroll") for (int m = 0; m < 4; ++m) _Pragma("unroll") for (int n = 0; n < 2; ++n) { \
        PG8_M8L1(ai, bj, m, n, 0); PG8_M8L1(ai, bj, m, n, 1); PG8_M8L1(ai, bj, m, n, 2); PG8_M8L1(ai, bj, m, n, 3); } __builtin_amdgcn_s_setprio(0); } while (0)
#define PG8_MMAG(ai, bj, At, Bt) do { if (!GUARD || (mrow & (1 << (ai)))) { if constexpr (FP8 == 1) PG8_MMA8(ai, bj, At, Bt); else if constexpr (FP8 == 2) PG8_MMA8L(ai, bj, At, Bt); else PG8_MMA(ai, bj, At, Bt); } } while (0)
#define PG8_WAIT_V(n) asm volatile("s_waitcnt vmcnt(" #n ")" ::: "memory")
#define PG8_WAIT_L(n) asm volatile("s_waitcnt lgkmcnt(" #n ")" ::: "memory")
#define PG8_BAR __builtin_amdgcn_s_barrier()
#define PG8_SCHED __builtin_amdgcn_sched_barrier(0)
    Unit cur, nxt; int ui = 0;
    if (!S.next(0, cur)) return;
    __builtin_amdgcn_s_waitcnt(0x0F70);
    f32x4 acc[2][2][4][2];
#pragma unroll
    for (int a = 0; a < 2; ++a)
#pragma unroll
        for (int b = 0; b < 2; ++b)
#pragma unroll
            for (int m = 0; m < 4; ++m)
#pragma unroll
                for (int n = 0; n < 2; ++n) acc[a][b][m][n] = (f32x4){0.f, 0.f, 0.f, 0.f};
    v8i32 At[4], B0[2], B1[2];
    const char* cA = (const char*)g.A + (size_t)cur.pm * tstep + (size_t)cur.k0 * 2; const char* cB = (const char*)g.Bt + (size_t)cur.pn * tstep + (size_t)cur.k0 * 2;
    S.a_ready(cur);
    PG8_STAGE(PG8_SB(0, 0), cB, voffB); PG8_STAGE(PG8_SA(0, 0), cA, voffA); PG8_STAGE(PG8_SB(0, 1), cB + hstep, voffB); PG8_STAGE(PG8_SA(0, 1), cA + hstep, voffA);
    if (wr == 1) PG8_BAR;
    PG8_WAIT_V(4); PG8_BAR;
    PG8_STAGE(PG8_SB(1, 0), cB + kstep, voffB); PG8_STAGE(PG8_SA(1, 0), cA + kstep, voffA); PG8_STAGE(PG8_SB(1, 1), cB + hstep + kstep, voffB);
    PG8_WAIT_V(6); PG8_BAR;
    PG8_STAMP();
    int pre_msk = 0;
    for (;;) {
        const bool has_next = S.next(ui + 1, nxt);
        const char* nA = has_next ? (const char*)g.A + (size_t)nxt.pm * tstep + (size_t)nxt.k0 * 2 : cA; const char* nB = has_next ? (const char*)g.Bt + (size_t)nxt.pn * tstep + (size_t)nxt.k0 * 2 : cB;
        const int nt = cur.nt, mrow = cur.msk;
        for (int t = 0; t < nt; t += 2) {
            const bool pre0 = PRESTAGE && pre_msk != 0 && t == 0;
            const bool last = (t == nt - 2);
            const char* a1 = cA + (size_t)(t + 1) * kstep;
            const char* a2 = last ? nA : cA + (size_t)(t + 2) * kstep; const char* b2 = last ? nB : cB + (size_t)(t + 2) * kstep;
            const char* a3 = a2 + kstep; const char* b3 = b2 + kstep;
            if (last && has_next) S.a_ready(nxt);
            PG8_LDB(B0, 0, 0); PG8_SCHED; PG8_LDA(At, 0, 0); if (!pre0) PG8_STAGE(PG8_SA(1, 1), a1 + hstep, voffA);
            PG8_WAIT_L(8); PG8_BAR; PG8_WAIT_L(0); PG8_MMAG(0, 0, At, B0); PG8_BAR; PG8_SCHED;
            PG8_LDB(B1, 0, 1); PG8_STAGE(PG8_SB(0, 0), b2, voffB);
            PG8_BAR; PG8_WAIT_L(0); PG8_MMAG(0, 1, At, B1); PG8_BAR;
            PG8_LDA(At, 0, 1); PG8_STAGE(PG8_SA(0, 0), a2, voffA);
            PG8_BAR; PG8_WAIT_L(0); PG8_MMAG(1, 0, At, B0); PG8_BAR; PG8_SCHED;
            PG8_STAGE(PG8_SB(0, 1), b2 + hstep, voffB);
            if constexpr (PRESTAGE) {
                if (pre0) { if (pre_msk == 3) asm volatile("s_waitcnt vmcnt(%0)" :: "n"(6 + 2 * Epi::NST) : "memory"); else asm volatile("s_waitcnt vmcnt(%0)" :: "n"(6 + Epi::NST) : "memory"); }
                else PG8_WAIT_V(6);
            } else PG8_WAIT_V(6);
            PG8_BAR; PG8_MMAG(1, 1, At, B1); PG8_BAR;
            PG8_LDB(B0, 1, 0); PG8_SCHED; PG8_LDA(At, 1, 0); PG8_STAGE(PG8_SA(0, 1), a2 + hstep, voffA);
            PG8_WAIT_L(8); PG8_BAR; PG8_WAIT_L(0); PG8_MMAG(0, 0, At, B0); PG8_BAR; PG8_SCHED;
            PG8_LDB(B1, 1, 1); PG8_STAGE(PG8_SB(1, 0), b3, voffB);
            PG8_BAR; PG8_WAIT_L(0); PG8_MMAG(0, 1, At, B1); PG8_BAR;
            PG8_LDA(At, 1, 1); PG8_STAGE(PG8_SA(1, 0), a3, voffA);
            PG8_BAR; PG8_WAIT_L(0); PG8_MMAG(1, 0, At, B0); PG8_BAR; PG8_SCHED;
            PG8_STAGE(PG8_SB(1, 1), b3 + hstep, voffB);
            PG8_WAIT_V(6); PG8_BAR; PG8_MMAG(1, 1, At, B1); PG8_BAR;
        }
        PG8_STAMP();
        if constexpr (PRESTAGE) { pre_msk = 0; if (has_next) { PG8_STAGE(PG8_SA(1, 1), nA + kstep + hstep, voffA); pre_msk = cur.msk; } }
        if constexpr (!Epi::AFTER_DRAIN) { E(acc, cur, wr, wc, fr, fq); S.done(cur); }
        PG8_STAMP();
        if (!has_next) break;
#pragma unroll
        for (int a = 0; a < 2; ++a)
#pragma unroll
            for (int b = 0; b < 2; ++b)
#pragma unroll
                for (int m = 0; m < 4; ++m)
#pragma unroll
                    for (int n = 0; n < 2; ++n) acc[a][b][m][n] = (f32x4){0.f, 0.f, 0.f, 0.f};
        cur = nxt; cA = nA; cB = nB; ++ui;
    }
    PG8_WAIT_V(0);
    if (wr == 0) PG8_BAR;
    PG8_BAR;
    if constexpr (Epi::AFTER_DRAIN) { E.fused(acc, cur, wr, wc, fr, fq, lds, wid, lane); S.done(cur); }
    PG8_STAMP();
    if (STAMP && wid == 0) { stamps[lane] = lane < nts ? (((unsigned long long)(unsigned)ts_hi << 32) | (unsigned)ts_lo) : 0ull;
        if (lane == 62) stamps[62] = rt_entry; if (lane == 63) stamps[63] = (unsigned long long)wall_clock64(); }
#undef PG8_STAMP
#undef PG8_SA
#undef PG8_SB
#undef PG8_STAGE
#undef PG8_LDA
#undef PG8_LDB
#undef PG8_HALF
#undef PG8_MMA
#undef PG8_MMA8
#undef PG8_MMA8L
#undef PG8_M8L1
#undef PG8_Q64
#undef PG8_MMAG
#undef PG8_WAIT_V
#undef PG8_WAIT_L
#undef PG8_BAR
#undef PG8_SCHED
}
}
#ifndef ATT_INLINE
#define ATT_INLINE __forceinline__
#endif
namespace att {
constexpr int D = 128, NW = 8, QBLK = 32, KVBLK = 64, LDQ = 512, LDO = DM;
constexpr float SCALE = 0.088388347648318440f;
constexpr float THR = 8.f;
constexpr size_t SHM_V = KVBLK * D * 2, SHM_K = KVBLK * D * 2, SHM_Q = 256 * D * 2, SHM_ATTN = 2 * SHM_V + 2 * SHM_K + NW * 64 * 4 + SHM_Q;
using bf16x8 = __attribute__((ext_vector_type(8))) short;
using s16x4  = __attribute__((ext_vector_type(4))) short;
using f32x16 = __attribute__((ext_vector_type(16))) float;
using u32x4  = __attribute__((ext_vector_type(4))) unsigned;
#define KSWZ(row, colB) ((row) * 256 + ((colB) ^ (((row) & 7) << 4)))
#define SBAR() __builtin_amdgcn_sched_barrier(0)
__device__ __forceinline__ int crow(int r, int hi) { return (r & 3) + 8 * (r >> 2) + 4 * hi; }
__device__ __forceinline__ unsigned cvtpk(float lo, float hi) { unsigned r; asm volatile("v_cvt_pk_bf16_f32 %0, %1, %2" : "=v"(r) : "v"(lo), "v"(hi)); return r; }

__device__ __forceinline__ void partialSM(f32x16& p0, f32x16& p1, float& m_reg, float& mn, float& alpha) {
  constexpr float C = SCALE * 1.4426950408889634f;
  float pmax = p0[0]; for (int r = 1; r < 16; ++r) pmax = fmaxf(pmax, p0[r]); for (int r = 0; r < 16; ++r) pmax = fmaxf(pmax, p1[r]);
  { auto rr = __builtin_amdgcn_permlane32_swap(__float_as_uint(pmax), __float_as_uint(pmax), false, false);
    pmax = fmaxf(__uint_as_float(rr[0]), __uint_as_float(rr[1])); }
  if (__builtin_expect(__all(pmax - m_reg <= THR / SCALE), 1)) { mn = m_reg; alpha = 1.f; }
  else { mn = fmaxf(m_reg, pmax); alpha = __builtin_amdgcn_exp2f((m_reg - mn) * C); m_reg = mn; }
  float mnC = -mn * C;
  for (int r = 0; r < 16; ++r) p0[r] = fmaf(p0[r], C, mnC); for (int r = 0; r < 16; ++r) p1[r] = fmaf(p1[r], C, mnC);
  for (int r = 0; r < 16; ++r) p0[r] = __builtin_amdgcn_exp2f(p0[r]);
}
__device__ __forceinline__ void finishSM(f32x16& p0, f32x16& p1, float alpha, float& l_reg, bf16x8& pa0, bf16x8& pa1, bf16x8& pa2, bf16x8& pa3) {
  for (int r = 0; r < 16; ++r) p1[r] = __builtin_amdgcn_exp2f(p1[r]);
  float ps = 0; for (int r = 0; r < 16; ++r) ps += p0[r]; for (int r = 0; r < 16; ++r) ps += p1[r];
  { auto rr = __builtin_amdgcn_permlane32_swap(__float_as_uint(ps), __float_as_uint(ps), false, false);
    ps = __uint_as_float(rr[0]) + __uint_as_float(rr[1]); }
  l_reg = l_reg * alpha + ps;
#define PK4(P, BASE, OUT) do { unsigned a0 = cvtpk(P[BASE + 0], P[BASE + 1]), a1 = cvtpk(P[BASE + 2], P[BASE + 3]);   \
    unsigned b0 = cvtpk(P[BASE + 4], P[BASE + 5]), b1 = cvtpk(P[BASE + 6], P[BASE + 7]);                              \
    auto r0 = __builtin_amdgcn_permlane32_swap(a0, b0, false, false); auto r1 = __builtin_amdgcn_permlane32_swap(a1, b1, false, false); \
    u32x4 w = {r0[0], r1[0], r0[1], r1[1]}; OUT = *reinterpret_cast<bf16x8*>(&w); } while (0)
  PK4(p0, 0, pa0); PK4(p0, 8, pa1); PK4(p1, 0, pa2); PK4(p1, 8, pa3);
#undef PK4
}
__device__ __forceinline__ void qkt(f32x16& p0, f32x16& p1, const bf16_t* Ks, const bf16_t* Qs, int qrow, int r32, int hi) {
  p0 = f32x16{}; p1 = f32x16{};
#pragma unroll
  for (int d0 = 0; d0 < 8; ++d0) { int cb = (d0 * 16 + hi * 8) * 2;
    bf16x8 q = *reinterpret_cast<const bf16x8*>((const char*)Qs + KSWZ(qrow, cb));
    bf16x8 b0 = *reinterpret_cast<const bf16x8*>((const char*)Ks + KSWZ(r32, cb));
    bf16x8 b1 = *reinterpret_cast<const bf16x8*>((const char*)Ks + KSWZ(32 + r32, cb));
    p0 = __builtin_amdgcn_mfma_f32_32x32x16_bf16(b0, q, p0, 0, 0, 0);
    p1 = __builtin_amdgcn_mfma_f32_32x32x16_bf16(b1, q, p1, 0, 0, 0); }
}
__device__ __forceinline__ int v_st(int k, int c) { const int kk = (k & ~0xC) | ((k & 4) << 1) | ((k & 8) >> 1); return ((kk >> 3) * 4 + (c >> 5)) * 512 + ((kk & 7) * 32 + (c & 31)) * 2; }
__device__ __forceinline__ int v_rd_base(int lane) { return ((lane & 3) << 3) | (((lane >> 2) & 3) << 6) | (((lane >> 4) & 1) << 5) | (((lane >> 5) & 1) << 8); }
constexpr int v_rd_off(int d0, int ks, int half) { return d0 * 512 + ks * 4096 + half * 2048; }
template <int OFF> __device__ __forceinline__ s16x4 tr_read(int vb) {
  s16x4 r; asm volatile("ds_read_b64_tr_b16 %0, %1 offset:%2" : "=&v"(r) : "v"(vb), "i"(OFF) : "memory"); return r;
}
template <int D0> __device__ __forceinline__ void pv_one(f32x16& od, int vb, bf16x8 pa0, bf16x8 pa1, bf16x8 pa2, bf16x8 pa3) {
  const s16x4 l0 = tr_read<v_rd_off(D0, 0, 0)>(vb), h0 = tr_read<v_rd_off(D0, 0, 1)>(vb), l1 = tr_read<v_rd_off(D0, 1, 0)>(vb), h1 = tr_read<v_rd_off(D0, 1, 1)>(vb);
  const s16x4 l2 = tr_read<v_rd_off(D0, 2, 0)>(vb), h2 = tr_read<v_rd_off(D0, 2, 1)>(vb), l3 = tr_read<v_rd_off(D0, 3, 0)>(vb), h3 = tr_read<v_rd_off(D0, 3, 1)>(vb);
  asm volatile("s_waitcnt lgkmcnt(0)" ::: "memory"); SBAR();
#define PK(L, H) (bf16x8){L[0], L[1], L[2], L[3], H[0], H[1], H[2], H[3]}
  od = __builtin_amdgcn_mfma_f32_32x32x16_bf16(pa0, PK(l0, h0), od, 0, 0, 0);
  od = __builtin_amdgcn_mfma_f32_32x32x16_bf16(pa1, PK(l1, h1), od, 0, 0, 0);
  od = __builtin_amdgcn_mfma_f32_32x32x16_bf16(pa2, PK(l2, h2), od, 0, 0, 0);
  od = __builtin_amdgcn_mfma_f32_32x32x16_bf16(pa3, PK(l3, h3), od, 0, 0, 0);
#undef PK
}
__device__ __forceinline__ void pv_d0(f32x16* o, int vb, bf16x8 pa0, bf16x8 pa1, bf16x8 pa2, bf16x8 pa3) {
  pv_one<0>(o[0], vb, pa0, pa1, pa2, pa3); pv_one<1>(o[1], vb, pa0, pa1, pa2, pa3); pv_one<2>(o[2], vb, pa0, pa1, pa2, pa3); pv_one<3>(o[3], vb, pa0, pa1, pa2, pa3);
}

struct SrcOne { const bf16_t* k0; const bf16_t* v0; int ldk;
  __device__ __forceinline__ const bf16_t* k(int j) const { return k0 + (size_t)j * 64 * ldk; }
  __device__ __forceinline__ const bf16_t* v(int j) const { return v0 + (size_t)j * 64 * ldk; } };
struct SrcTwo { const bf16_t* ck; const bf16_t* cv; const bf16_t* k1; const bf16_t* v1; int ldk;
  __device__ __forceinline__ const bf16_t* k(int j) const { return j < 4 ? ck + (size_t)j * 64 * ldk : k1 + (size_t)(j - 4) * 64 * ldk; }
  __device__ __forceinline__ const bf16_t* v(int j) const { return j < 4 ? cv + (size_t)j * 64 * ldk : v1 + (size_t)(j - 4) * 64 * ldk; } };
struct NoBias { __device__ __forceinline__ void operator()(f32x16&, f32x16&, int, int, int, int) const {} };
struct NaBias { const float* tab; int i0, kr0;
  __device__ __forceinline__ void operator()(f32x16& p0, f32x16& p1, int jt, int wid, int r32, int hi) const {
    if (jt < 4) return;
    const int qi = i0 + wid * QBLK + r32, r = qi >> 6, qc = qi & 63, kr = kr0 + jt - 4;
    int lo = r - 4; lo = lo < 0 ? 0 : (lo > 8 ? 8 : lo);
    const bool rowok = (kr >= lo) && (kr < lo + 8);
    if (!rowok) {
#pragma unroll
      for (int rr = 0; rr < 16; ++rr) { p0[rr] = -1e30f; p1[rr] = -1e30f; }
      return;
    }
    int c0 = qc - 8; c0 = c0 < 0 ? 0 : (c0 > 48 ? 48 : c0);
    const int dr = kr - r + 7;
    const float* tb = tab + dr * 31 + (4 * hi - qc + 15);
    const int w0 = 4 * hi - c0;
#pragma unroll
    for (int g = 0; g < 4; ++g) {
#pragma unroll
      for (int q = 0; q < 4; ++q) {
        const int rr = 4 * g + q, kc0 = q + 8 * g;
        const float t0 = tb[kc0], t1 = tb[kc0 + 32];
        p0[rr] = ((unsigned)(kc0 + w0) < 16u) ? p0[rr] + t0 : -1e30f;
        p1[rr] = ((unsigned)(kc0 + 32 + w0) < 16u) ? p1[rr] + t1 : -1e30f;
      }
      SBAR();
    }
  } };

template <int SD, class Src, class Bias>
__device__ ATT_INLINE void attn_body(const bf16_t* __restrict__ Qb, const Src src, bf16_t* __restrict__ Ob, const int NT, char* lds, const Bias bias) {
  const int tid = opaque_tid(), wid = tid >> 6, lane = tid & 63, r32 = lane & 31, hi = lane >> 5;
  const int LDK = src.ldk;
  bf16_t* V_lds = (bf16_t*)lds; bf16_t* K_lds = (bf16_t*)(lds + 2 * SHM_V);
  float* ws = (float*)(lds + 2 * SHM_V + 2 * SHM_K) + wid * 64; float* li_l = ws; float* al_l = ws + 32;
  float m_reg = -1e30f, l_reg = 0; f32x16 o[4] = {};
  bf16_t* Q_lds = (bf16_t*)(lds + 2 * SHM_V + 2 * SHM_K + NW * 64 * 4);
  const int qrow = wid * QBLK + r32;
  {
    bf16x8 qv[8];
#pragma unroll
    for (int i = 0; i < 8; ++i) { const int f = tid + 512 * i, row = f >> 4, c8 = (f & 15) * 8; qv[i] = *reinterpret_cast<const bf16x8*>(Qb + (long)row * LDQ + c8); }
#pragma unroll
    for (int i = 0; i < 8; ++i) { const int f = tid + 512 * i, row = f >> 4, c8 = (f & 15) * 8; *(bf16x8*)((char*)Q_lds + KSWZ(row, c8 * 2)) = qv[i]; }
  }
  const int sr = tid >> 4, sc = (tid & 15) * 8, vst0 = v_st(sr, sc), vst1 = v_st(32 + sr, sc);
  const int vb0 = (int)(uintptr_t)V_lds + v_rd_base(lane);
  struct { bf16x8 vs0, vs1, ks0, ks1; } sr_[SD];
#define SLOAD(i, jt) do { const bf16_t* kt_ = src.k(jt); const bf16_t* vt_ = src.v(jt); \
    sr_[i].vs0 = *reinterpret_cast<const bf16x8*>(&vt_[(long)sr * LDK + sc]); sr_[i].vs1 = *reinterpret_cast<const bf16x8*>(&vt_[(long)(32 + sr) * LDK + sc]); \
    sr_[i].ks0 = *reinterpret_cast<const bf16x8*>(&kt_[(long)sr * LDK + sc]); sr_[i].ks1 = *reinterpret_cast<const bf16x8*>(&kt_[(long)(32 + sr) * LDK + sc]); } while (0)
#define SWRITE(b, i) do { *(bf16x8*)((char*)V_lds + (b) * SHM_V + vst0) = sr_[i].vs0;          \
    *(bf16x8*)((char*)V_lds + (b) * SHM_V + vst1) = sr_[i].vs1; int kc = sc * 2;               \
    *(bf16x8*)((char*)K_lds + (b) * SHM_K + KSWZ(sr, kc)) = sr_[i].ks0;                       \
    *(bf16x8*)((char*)K_lds + (b) * SHM_K + KSWZ(32 + sr, kc)) = sr_[i].ks1; } while (0)
#define SWAIT() do { if constexpr (SD == 2) asm volatile("s_waitcnt vmcnt(4)" ::: "memory"); else asm volatile("s_waitcnt vmcnt(0)" ::: "memory"); } while (0)
#define RESC(a) do { if (__any((a) < 1.f)) { if (hi == 0) al_l[r32] = (a); asm volatile("s_waitcnt lgkmcnt(0)" ::: "memory"); \
    for (int d = 0; d < 4; ++d) for (int r = 0; r < 16; ++r) o[d][r] *= al_l[crow(r, hi)]; } } while (0)
  f32x16 pA0, pA1, pB0, pB1; float mnA, mnB, alA, alB; bf16x8 pa0, pa1, pa2, pa3;
  constexpr int SE = 0, SO = SD - 1;
  SLOAD(SE, 0); asm volatile("s_waitcnt vmcnt(0)" ::: "memory"); SWRITE(0, SE); __syncthreads();
  qkt(pA0, pA1, K_lds, Q_lds, qrow, r32, hi); bias(pA0, pA1, 0, wid, r32, hi); partialSM(pA0, pA1, m_reg, mnA, alA);
  SLOAD(SO, 1); if constexpr (SD == 2) { if (2 < NT) SLOAD(SE, 2); }
  SWAIT(); SWRITE(1, SO); __syncthreads();
  for (int j = 1; j + 1 < NT; j += 2) {
    SBAR(); qkt(pB0, pB1, (bf16_t*)((char*)K_lds + SHM_K), Q_lds, qrow, r32, hi); bias(pB0, pB1, j, wid, r32, hi);
    finishSM(pA0, pA1, alA, l_reg, pa0, pa1, pa2, pa3); SBAR();
    SLOAD(SO, j + SD); SBAR();
    pv_d0(o, vb0, pa0, pa1, pa2, pa3); partialSM(pB0, pB1, m_reg, mnB, alB);
    __syncthreads(); SWAIT(); SWRITE(0, SE);
    RESC(alB); __syncthreads();
    SBAR(); qkt(pA0, pA1, K_lds, Q_lds, qrow, r32, hi); bias(pA0, pA1, j + 1, wid, r32, hi);
    finishSM(pB0, pB1, alB, l_reg, pa0, pa1, pa2, pa3); SBAR();
    if (SD == 1 || j + 3 < NT) SLOAD(SE, j + 1 + SD); SBAR();
    pv_d0(o, vb0 + (int)SHM_V, pa0, pa1, pa2, pa3); partialSM(pA0, pA1, m_reg, mnA, alA);
    __syncthreads(); SWAIT(); SWRITE(1, SO);
    RESC(alA); __syncthreads();
  }
  SBAR(); qkt(pB0, pB1, (bf16_t*)((char*)K_lds + SHM_K), Q_lds, qrow, r32, hi); bias(pB0, pB1, NT - 1, wid, r32, hi);
  finishSM(pA0, pA1, alA, l_reg, pa0, pa1, pa2, pa3); SBAR();
  pv_d0(o, vb0, pa0, pa1, pa2, pa3); partialSM(pB0, pB1, m_reg, mnB, alB);
  __syncthreads(); RESC(alB);
  finishSM(pB0, pB1, alB, l_reg, pa0, pa1, pa2, pa3); SBAR();
  pv_d0(o, vb0 + (int)SHM_V, pa0, pa1, pa2, pa3);
  if (hi == 0) li_l[r32] = l_reg; asm volatile("s_waitcnt lgkmcnt(0)" ::: "memory");
  float rli[16];
#pragma unroll
  for (int r = 0; r < 16; ++r) rli[r] = __builtin_amdgcn_rcpf(li_l[crow(r, hi)]);
  bf16_t* Ow = Ob + (long)(wid * QBLK) * LDO;
#pragma unroll
  for (int r = 0; r < 16; ++r) { int orow = crow(r, hi);
    for (int d0 = 0; d0 < 4; ++d0) Ow[(long)orow * LDO + d0 * 32 + r32] = f2bf(o[d0][r] * rli[r]); }
#undef SLOAD
#undef SWRITE
#undef SWAIT
#undef RESC
}
}
#define H16(w, j) ((bf16_t)(((j) & 1) ? ((j) < 2 ? (w).x >> 16 : (w).y >> 16) : ((j) < 2 ? (w).x & 0xFFFFu : (w).y & 0xFFFFu)))
#define DPPU(v, ctrl, rmask) __int_as_float(__builtin_amdgcn_update_dpp(0, __float_as_int(v), (ctrl), (rmask), 0xF, false))
__device__ __forceinline__ float scan32(float x) { x += DPPU(x, 0x111, 0xF); x += DPPU(x, 0x112, 0xF); x += DPPU(x, 0x114, 0xF); x += DPPU(x, 0x118, 0xF); x += DPPU(x, 0x142, 0xA); return x; }
__device__ __forceinline__ float last32(float x, int lane) { const float a = __int_as_float(__builtin_amdgcn_readlane(__float_as_int(x), 31)), b = __int_as_float(__builtin_amdgcn_readlane(__float_as_int(x), 63)); return lane < 32 ? a : b; }
namespace gdn {
using att::bf16x8; using att::f32x16; using att::crow;
constexpr int C = 32, SK = 136, SS = 40;
constexpr int OFF_KT = 0, OFF_QT = OFF_KT + C * SK * 2, OFF_W = OFF_QT + C * SK * 2, OFF_KTT = OFF_W + C * SK * 2, OFF_VTT = OFF_KTT + 128 * SS * 2,
              OFF_VN = OFF_VTT + 128 * SS * 2, OFF_VNS = OFF_VN + 128 * SS * 2, OFF_ST = OFF_VNS + 128 * SS * 2, OFF_TB = OFF_ST + 128 * SK * 2,
              OFF_TBE = OFF_TB + C * SS * 2, OFF_ATT = OFF_TBE + C * SS * 2, OFF_L = OFF_ATT + C * SS * 2, OFF_SC = OFF_L + C * C * 4, GDN_LDS = OFF_SC + 1024;
template <int K>
__device__ __forceinline__ f32x16 mm(const bf16_t* A, int lda, const bf16_t* Bt, int ldb, int l32, int hi, f32x16 acc) {
#pragma unroll
    for (int k0 = 0; k0 < K; k0 += 16) {
        const bf16x8 a = *reinterpret_cast<const bf16x8*>(A + l32 * lda + k0 + 8 * hi);
        const bf16x8 b = *reinterpret_cast<const bf16x8*>(Bt + l32 * ldb + k0 + 8 * hi);
        acc = __builtin_amdgcn_mfma_f32_32x32x16_bf16(a, b, acc, 0, 0, 0);
    }
    return acc;
}
__device__ __forceinline__ uint2 pk4(float a, float b, float c, float d) { uint2 w; w.x = pack2(a, b); w.y = pack2(c, d); return w; }

__device__ __forceinline__ void gdn_chunked(const Params& p, int l, bool ctx, int b, int h, int dir, unsigned char* lds) {
    const int tid = opaque_tid(), wid = tid >> 6, lane = tid & 63, l32 = lane & 31, hi = lane >> 5;
    const int T = ctx ? CT : ::LT; const size_t m0 = ctx ? (size_t)b * CT : (size_t)MC + (size_t)b * ::LT;
    const bf16_t* DQ = WSP(bf16_t, WS_DQ); const bf16_t* DK = WSP(bf16_t, WS_DK); const bf16_t* DV = WSP(bf16_t, WS_DV); const float* DBA = WSP(float, WS_DBA);
    bf16_t* O = WSP(bf16_t, dir ? WS_DOB : WS_DOF);
    bf16_t* Kt = (bf16_t*)(lds + OFF_KT); bf16_t* Qt = (bf16_t*)(lds + OFF_QT); bf16_t* W = (bf16_t*)(lds + OFF_W); bf16_t* KT = (bf16_t*)(lds + OFF_KTT); bf16_t* VT = (bf16_t*)(lds + OFF_VTT);
    bf16_t* VN = (bf16_t*)(lds + OFF_VN); bf16_t* VNS = (bf16_t*)(lds + OFF_VNS); bf16_t* ST = (bf16_t*)(lds + OFF_ST); bf16_t* TB = (bf16_t*)(lds + OFF_TB); bf16_t* TBE = (bf16_t*)(lds + OFF_TBE);
    bf16_t* ATT = (bf16_t*)(lds + OFF_ATT); float* Lm = (float*)(lds + OFF_L); float* sc = (float*)(lds + OFF_SC);
    const int nch = T / C;
#define TOK(c, s_) (m0 + (dir ? T - 1 - ((c) * C + (s_)) : (c) * C + (s_)))
    f32x16 S[2];
#pragma unroll
    for (int bi = 0; bi < 2; ++bi) {
        const int blk = wid * 2 + bi, d0 = 32 * (blk >> 2), e0 = 32 * (blk & 3);
        if (ctx) { S[bi] = f32x16{}; }
        else {
            const float* s0 = p.in[I_SGDN] + ((((size_t)b * DEPTH + l) * 2 + dir) * 4 + h) * 128 * 128 + e0 + l32;
#pragma unroll
            for (int r = 0; r < 16; ++r) S[bi][r] = s0[(size_t)(d0 + crow(r, hi)) * 128];
        }
    }
    const int ts = tid & 31, c0 = (tid >> 5) * 4, c1 = 64 + c0;
    uint2 rq0, rq1, rk0, rk1, rv0, rv1; float pbeta = 0.f, pg = 0.f;
#define GLOAD(c) do { const size_t mt_ = TOK(c, ts); \
        rq0 = *(const uint2*)(DQ + mt_ * 512 + h * 128 + c0); rq1 = *(const uint2*)(DQ + mt_ * 512 + h * 128 + c1); \
        rk0 = *(const uint2*)(DK + mt_ * 512 + h * 128 + c0); rk1 = *(const uint2*)(DK + mt_ * 512 + h * 128 + c1); \
        rv0 = *(const uint2*)(DV + mt_ * 512 + h * 128 + c0); rv1 = *(const uint2*)(DV + mt_ * 512 + h * 128 + c1); \
        if (tid < C) { const size_t mt = TOK(c, tid); pbeta = DBA[mt * 16 + dir * 4 + h]; pg = DBA[mt * 16 + 8 + dir * 4 + h]; } } while (0)
#define GSTAGE() do { \
        *(uint2*)(Kt + ts * SK + c0) = rk0; *(uint2*)(Kt + ts * SK + c1) = rk1; \
        *(uint2*)(Qt + ts * SK + c0) = rq0; *(uint2*)(Qt + ts * SK + c1) = rq1; \
        _Pragma("unroll") for (int j = 0; j < 4; ++j) { KT[(c0 + j) * SS + ts] = H16(rk0, j); KT[(c1 + j) * SS + ts] = H16(rk1, j); \
                                                        VT[(c0 + j) * SS + ts] = H16(rv0, j); VT[(c1 + j) * SS + ts] = H16(rv1, j); } \
        if (wid == 0) { float x = pg; _Pragma("unroll") for (int o_ = 1; o_ < 32; o_ <<= 1) { const float y = __shfl_up(x, o_); if (lane >= o_) x += y; } \
            const float Bt_ = __shfl(x, 31); if (lane < C) { sc[lane] = pbeta; sc[32 + lane] = x; sc[64 + lane] = __expf(x); sc[96 + lane] = __expf(Bt_ - x); if (lane == 0) sc[128] = __expf(Bt_); } } } while (0)
    __syncthreads();
    GLOAD(0);
#pragma unroll
    for (int bi = 0; bi < 2; ++bi) {
        const int blk = wid * 2 + bi, d0 = 32 * (blk >> 2), e0 = 32 * (blk & 3);
#pragma unroll
        for (int g = 0; g < 4; ++g) *(uint2*)(ST + (e0 + l32) * SK + d0 + 8 * g + 4 * hi) = pk4(S[bi][4 * g], S[bi][4 * g + 1], S[bi][4 * g + 2], S[bi][4 * g + 3]);
    }
    GSTAGE();
    __syncthreads();
    for (int c = 0; c < nch; ++c) {
        if (c + 1 < nch) GLOAD(c + 1);
        f32x16 acc1 = f32x16{};
        if (wid == 0) {
            const f32x16 kk = mm<128>(Kt, SK, Kt, SK, l32, hi, f32x16{});
            const float bi_ = sc[32 + l32], be = sc[l32];
#pragma unroll
            for (int r = 0; r < 16; ++r) { const int j = crow(r, hi); const float v = (l32 > j) ? be * kk[r] * __expf(bi_ - sc[32 + j]) : 0.f;
                Lm[l32 * 32 + ((((r & 3) + 4 * hi) ^ (l32 & 7)) * 4) + (r >> 2)] = v; }
        } else if (wid == 1) {
            const f32x16 kq = mm<128>(Kt, SK, Qt, SK, l32, hi, f32x16{});
            const float bi_ = sc[32 + l32];
            float a[16];
#pragma unroll
            for (int r = 0; r < 16; ++r) { const int j = crow(r, hi); a[r] = (l32 >= j) ? kq[r] * __expf(bi_ - sc[32 + j]) : 0.f; }
#pragma unroll
            for (int g = 0; g < 4; ++g) *(uint2*)(ATT + l32 * SS + 8 * g + 4 * hi) = pk4(a[4 * g], a[4 * g + 1], a[4 * g + 2], a[4 * g + 3]);
        } else if (wid >= 4) {
            acc1 = mm<128>(Qt, SK, ST + (32 * (wid - 4)) * SK, SK, l32, hi, f32x16{});
#pragma unroll
            for (int r = 0; r < 16; ++r) acc1[r] *= sc[64 + crow(r, hi)];
        }
        __syncthreads();
        if (tid < 256) {
            const int cc = tid >> 3, part = tid & 7;
            float Tr[4] = {0.f, 0.f, 0.f, 0.f};
#pragma unroll
            for (int i = 0; i < 32; ++i) {
                const vf4 lv = *(const vf4*)(Lm + i * 32 + ((part ^ (i & 7)) * 4));
                float s = lv.x * Tr[0] + lv.y * Tr[1] + lv.z * Tr[2] + lv.w * Tr[3];
                s = red8(s);
                const float t = (i == cc ? 1.f : 0.f) - s;
                if (part == (i & 7)) Tr[i >> 3] = t;
            }
            const float bc = sc[cc], bec = bc * sc[64 + cc];
#pragma unroll
            for (int jj = 0; jj < 4; ++jj) { TB[(part + 8 * jj) * SS + cc] = f2bf(Tr[jj] * bc); TBE[(part + 8 * jj) * SS + cc] = f2bf(Tr[jj] * bec); }
        }
        __syncthreads();
        if (wid < 4) {
            acc1 = mm<32>(TB, SS, VT + (32 * wid) * SS, SS, l32, hi, f32x16{});
        } else {
            const int d0 = 32 * (wid - 4);
            const f32x16 wt = mm<32>(KT + d0 * SS, SS, TBE, SS, l32, hi, f32x16{});
#pragma unroll
            for (int g = 0; g < 4; ++g) *(uint2*)(W + l32 * SK + d0 + 8 * g + 4 * hi) = pk4(wt[4 * g], wt[4 * g + 1], wt[4 * g + 2], wt[4 * g + 3]);
        }
        __syncthreads();
        if (wid < 4) {
            const int e0 = 32 * wid;
            const f32x16 ws = mm<128>(W, SK, ST + e0 * SK, SK, l32, hi, f32x16{});
            float vn[16], vs[16];
#pragma unroll
            for (int r = 0; r < 16; ++r) { vn[r] = acc1[r] - ws[r]; vs[r] = vn[r] * sc[96 + crow(r, hi)]; }
#pragma unroll
            for (int g = 0; g < 4; ++g) { *(uint2*)(VN + (e0 + l32) * SS + 8 * g + 4 * hi) = pk4(vn[4 * g], vn[4 * g + 1], vn[4 * g + 2], vn[4 * g + 3]);
                                          *(uint2*)(VNS + (e0 + l32) * SS + 8 * g + 4 * hi) = pk4(vs[4 * g], vs[4 * g + 1], vs[4 * g + 2], vs[4 * g + 3]); }
        }
        __syncthreads();
        if (wid >= 4) {
            const int e0 = 32 * (wid - 4);
            acc1 = mm<32>(ATT, SS, VN + e0 * SS, SS, l32, hi, acc1);
#pragma unroll
            for (int r = 0; r < 16; ++r) O[TOK(c, crow(r, hi)) * 512 + h * 128 + e0 + l32] = f2bf(acc1[r]);
        }
        {
            const float eB = sc[128];
#pragma unroll
            for (int bi = 0; bi < 2; ++bi) {
                const int blk = wid * 2 + bi, d0 = 32 * (blk >> 2), e0 = 32 * (blk & 3);
#pragma unroll
                for (int r = 0; r < 16; ++r) S[bi][r] *= eB;
                S[bi] = mm<32>(KT + d0 * SS, SS, VNS + e0 * SS, SS, l32, hi, S[bi]);
            }
        }
        __syncthreads();
#pragma unroll
        for (int bi = 0; bi < 2; ++bi) {
            const int blk = wid * 2 + bi, d0 = 32 * (blk >> 2), e0 = 32 * (blk & 3);
#pragma unroll
            for (int g = 0; g < 4; ++g) *(uint2*)(ST + (e0 + l32) * SK + d0 + 8 * g + 4 * hi) = pk4(S[bi][4 * g], S[bi][4 * g + 1], S[bi][4 * g + 2], S[bi][4 * g + 3]);
        }
        if (c + 1 < nch) GSTAGE();
        __syncthreads();
    }
#undef GLOAD
#undef GSTAGE
#undef TOK
    if (ctx) {
#pragma unroll
        for (int bi = 0; bi < 2; ++bi) {
            const int blk = wid * 2 + bi, d0 = 32 * (blk >> 2), e0 = 32 * (blk & 3);
            float* so = p.out + O_SGDN + ((((size_t)b * DEPTH + l) * 2 + dir) * 4 + h) * 128 * 128 + e0 + l32;
#pragma unroll
            for (int r = 0; r < 16; ++r) so[(size_t)(d0 + crow(r, hi)) * 128] = S[bi][r];
        }
    }
}
}

namespace gla {
using att::bf16x8; using att::f32x16; using att::crow; using gdn::mm; using gdn::pk4;
constexpr int C = 32, SQ = 72, SS = 40;
constexpr int OFF_QE = 0, OFF_KN = OFF_QE + C * SQ * 2, OFF_KET = OFF_KN + C * SQ * 2, OFF_VT = OFF_KET + 64 * SS * 2, OFF_ATT = OFF_VT + 128 * SS * 2, OFF_ST = OFF_ATT + C * SS * 2,
              OFF_LA = OFF_ST + 128 * SQ * 2, OFF_EB = OFF_LA + C * 64 * 4, GLA_LDS = OFF_EB + 256;
__device__ __forceinline__ void gla_chunked(const Params& p, int l, bool ctx, int b, int h, int dir, unsigned char* lds) {
    const int tid = opaque_tid(), wid = tid >> 6, lane = tid & 63, l32 = lane & 31, hi = lane >> 5;
    const int T = ctx ? CT : ::LT; const size_t m0 = ctx ? (size_t)b * CT : (size_t)MC + (size_t)b * ::LT;
    const bf16_t* Z = WSP(bf16_t, WS_Z); const float* LA = WSP(float, dir ? WS_AB : WS_AF);
    bf16_t* O = WSP(bf16_t, dir ? WS_GOB : WS_GOF);
    bf16_t* Qe = (bf16_t*)(lds + OFF_QE); bf16_t* Kn = (bf16_t*)(lds + OFF_KN); bf16_t* KeT = (bf16_t*)(lds + OFF_KET); bf16_t* VT = (bf16_t*)(lds + OFF_VT);
    bf16_t* ATT = (bf16_t*)(lds + OFF_ATT); bf16_t* ST = (bf16_t*)(lds + OFF_ST); float* eB = (float*)(lds + OFF_EB);
    const int nch = T / C;
#define TOK(c, s_) (m0 + (dir ? T - 1 - ((c) * C + (s_)) : (c) * C + (s_)))
    const int d0 = 32 * (wid >> 2), e0 = 32 * (wid & 3);
    f32x16 S;
    if (ctx) S = f32x16{};
    else {
        const float* s0 = p.in[I_SGLA] + ((((size_t)b * DEPTH + l) * 2 + dir) * 4 + h) * 64 * 128 + e0 + l32;
#pragma unroll
        for (int r = 0; r < 16; ++r) S[r] = s0[(size_t)(d0 + crow(r, hi)) * 128];
    }
    const int ts = tid & 31, dc = (tid >> 5) * 4, vc0 = dc, vc1 = 64 + dc;
    uint2 rq, rk, rv0, rv1; vf4 pl;
#define GLOAD(c) do { const size_t mt = TOK(c, ts); \
        rq = *(const uint2*)(Z + mt * NINP + Z_GLQ + h * 64 + dc); rk = *(const uint2*)(Z + mt * NINP + Z_GLK + h * 64 + dc); pl = *(const vf4*)(LA + mt * 256 + h * 64 + dc); \
        rv0 = *(const uint2*)(Z + mt * NINP + Z_GLV + h * 128 + vc0); rv1 = *(const uint2*)(Z + mt * NINP + Z_GLV + h * 128 + vc1); } while (0)
#define WRITE_ST() do { _Pragma("unroll") for (int g = 0; g < 4; ++g) *(uint2*)(ST + (e0 + l32) * SQ + d0 + 8 * g + 4 * hi) = pk4(S[4 * g], S[4 * g + 1], S[4 * g + 2], S[4 * g + 3]); } while (0)
#define GIMAGES() do { vf4 pre, tot; const vf4 pq = unp4bf(rq), pk = unp4bf(rk); \
        _Pragma("unroll") for (int j = 0; j < 4; ++j) { pre[j] = scan32(pl[j]); tot[j] = last32(pre[j], lane); } \
        float qe[4], kn[4]; \
        _Pragma("unroll") for (int j = 0; j < 4; ++j) { qe[j] = pq[j] * 0.125f * __expf(pre[j]); kn[j] = pk[j] * __expf(fminf(-pre[j], 80.f)); \
            KeT[(dc + j) * SS + ts] = f2bf(pk[j] * __expf(tot[j] - pre[j])); } \
        *(uint2*)(Qe + ts * SQ + dc) = pk4(qe[0], qe[1], qe[2], qe[3]); *(uint2*)(Kn + ts * SQ + dc) = pk4(kn[0], kn[1], kn[2], kn[3]); \
        if (ts == 0) { _Pragma("unroll") for (int j = 0; j < 4; ++j) eB[dc + j] = __expf(tot[j]); } \
        _Pragma("unroll") for (int j = 0; j < 4; ++j) { VT[(vc0 + j) * SS + ts] = H16(rv0, j); VT[(vc1 + j) * SS + ts] = H16(rv1, j); } } while (0)
    __syncthreads();
    GLOAD(0);
    WRITE_ST();
    GIMAGES();
    __syncthreads();
    for (int c = 0; c < nch; ++c) {
        if (c + 1 < nch) GLOAD(c + 1);
        f32x16 o1 = f32x16{};
        if (wid == 0) {
            const f32x16 kq = mm<64>(Kn, SQ, Qe, SQ, l32, hi, f32x16{});
            float a[16];
#pragma unroll
            for (int r = 0; r < 16; ++r) a[r] = (l32 >= crow(r, hi)) ? kq[r] : 0.f;
#pragma unroll
            for (int g = 0; g < 4; ++g) *(uint2*)(ATT + l32 * SS + 8 * g + 4 * hi) = pk4(a[4 * g], a[4 * g + 1], a[4 * g + 2], a[4 * g + 3]);
        } else if (wid >= 4) {
            o1 = mm<64>(Qe, SQ, ST + (32 * (wid - 4)) * SQ, SQ, l32, hi, f32x16{});
        }
        __syncthreads();
        if (wid >= 4) {
            const int eo = 32 * (wid - 4);
            o1 = mm<32>(ATT, SS, VT + eo * SS, SS, l32, hi, o1);
#pragma unroll
            for (int r = 0; r < 16; ++r) O[TOK(c, crow(r, hi)) * 512 + h * 128 + eo + l32] = f2bf(o1[r]);
        }
#pragma unroll
        for (int r = 0; r < 16; ++r) S[r] *= eB[d0 + crow(r, hi)];
        S = mm<32>(KeT + d0 * SS, SS, VT + e0 * SS, SS, l32, hi, S);
        __syncthreads();
        WRITE_ST();
        if (c + 1 < nch) GIMAGES();
#ifdef GLA_DUP_IMAGES
        __syncthreads(); if (c + 1 < nch) GIMAGES();
#endif
        __syncthreads();
    }
#undef GLOAD
#undef WRITE_ST
#undef GIMAGES
#undef TOK
    if (ctx) {
        float* so = p.out + O_SGLA + ((((size_t)b * DEPTH + l) * 2 + dir) * 4 + h) * 64 * 128 + e0 + l32;
#pragma unroll
        for (int r = 0; r < 16; ++r) so[(size_t)(d0 + crow(r, hi)) * 128] = S[r];
    }
}
}
#define LAS __attribute__((address_space(3)))
constexpr int LDS_BYTES = 147456, XBW_OFF = LDS_BYTES - 64;
constexpr int NPH = 1 + DEPTH * 12;
#ifndef DBG_NLAYERS
#define DBG_NLAYERS DEPTH
#endif

#ifndef DUPKIND
#define DUPKIND 0
#endif
#ifndef MIXMASK
#define MIXMASK 0xFF
#endif
#define FOR_ITEMS(it, n, o, w) for (int bo_ = (o) * (int)gridDim.x / 256, bw_ = ((w) * (int)gridDim.x / 256) > 0 ? ((w) * (int)gridDim.x / 256) : 1, \
                                    it = ((int)blockIdx.x >= bo_ && (int)blockIdx.x < bo_ + bw_) ? (int)blockIdx.x - bo_ : (n); it < (n); it += bw_)

#ifndef TF1_PCT
#define TF1_PCT 25
#endif
constexpr int TF0 = NT_L / 10, TF1 = NT_L * TF1_PCT / 100, TF2 = NT_L * 53 / 100, TF3 = NT_L * 88 / 100, MIXCONV_CH = CONV_U, NI_CONV = (TF3 - TF2 + MIXCONV_CH - 1) / MIXCONV_CH;
#ifndef SPLITK
#define SPLITK 0
#endif
#ifndef SPLITK_G4
#define SPLITK_G4 0
#endif
constexpr int FLAG_WORD0 = 8192;
constexpr int QCTR_WORD0 = 1024;
constexpr int NI_GDNL = LB * 8, NI_GLAL = LB * 8, NI_GDNC = CB * 8, NI_GQAL = LB * 16, NI_NAL = LB * 16, NI_GLAC = CB * 8, NI_NAC = CB * 4, NI_GQAC = CB * 4;
#define KM(k) (1 + ((DUPKIND >> (k)) & 1))
constexpr int Q0 = NI_GDNL * KM(0), Q1 = Q0 + NI_GQAL * KM(1), Q2 = Q1 + NI_NAL * KM(2), Q3 = Q2 + NI_GLAL * KM(3), Q4 = Q3 + NI_GDNC * KM(4), Q5 = Q4 + NI_NAC * KM(5), Q6 = Q5 + NI_GQAC * KM(6), Q7 = Q6 + NI_GLAC * KM(7);
__device__ __forceinline__ void phase_mix(const Params& p, int l, unsigned char* lds, int rep) {
    const int tid = opaque_tid();
    float* smem = (float*)lds;
    const bf16_t* NAQ = WSP(bf16_t, WS_NAQ); const bf16_t* NAK = WSP(bf16_t, WS_NAK); const bf16_t* NAV = WSP(bf16_t, WS_NAV);
    const bf16_t* GQ = WSP(bf16_t, WS_GQ); const bf16_t* GK = WSP(bf16_t, WS_GK); const bf16_t* GV = WSP(bf16_t, WS_GV);
    bf16_t* MRG = WSP(bf16_t, WS_MRG);
    unsigned* qctr = WSP(unsigned, WS_CTL) + QCTR_WORD0 + 64 * l + 16 * rep;
    volatile int* qslot = (volatile int*)(lds + XBW_OFF + 16);
    for (;;) {
        __syncthreads();
        if (tid == 0) *qslot = (int)__hip_atomic_fetch_add(qctr, 1u, __ATOMIC_RELAXED, __HIP_MEMORY_SCOPE_AGENT);
        __syncthreads();
        const int q = __builtin_amdgcn_readfirstlane(*qslot);
        if (q >= Q7 + ((CONV_FILLER && l + 1 < DBG_NLAYERS) ? NI_CONV : 0)) break;
        if (q < Q0) { const int it = q % NI_GDNL; gdn::gdn_chunked(p, l, false, it / 8, (it / 2) % 4, it % 2, lds); }
        else if (q < Q1) {
            const int it = (q - Q0) % NI_GQAL, b = it / 16, qh = (it / 4) % 4, qb = it % 4, kvh = qh >> 1;
            const size_t r0 = (size_t)MC + (size_t)b * LT;
            att::SrcTwo src{WSP(bf16_t, WS_CGK) + ((size_t)b * DEPTH + l) * 256 * 256 + kvh * 128, WSP(bf16_t, WS_CGV) + ((size_t)b * DEPTH + l) * 256 * 256 + kvh * 128,
                            GK + r0 * 256 + kvh * 128, GV + r0 * 256 + kvh * 128, 256};
            att::attn_body<2>(GQ + (r0 + qb * 256) * 512 + qh * 128, src, MRG + (r0 + qb * 256) * DM + 1024 + qh * 128, 4 + LT / 64, (char*)lds, att::NoBias{});
        }
        else if (q < Q2) {
            const int it = (q - Q1) % NI_NAL, b = it / 16, h = (it / 4) % 4, qb = it % 4;
            const int kr0 = qb == 0 ? 0 : qb == 1 ? 0 : qb == 2 ? 4 : 8, nrows = (qb == 0 || qb == 3) ? 8 : 12;
            const size_t r0 = (size_t)MC + (size_t)b * LT;
            float* tab = (float*)(lds + att::SHM_ATTN);
            if (tid < 15 * 31) tab[tid] = p.in[I_RPB][((size_t)l * 4 + h) * 15 * 31 + tid] * (1.0f / att::SCALE);
            att::SrcTwo src{WSP(bf16_t, WS_CNAK) + ((size_t)b * DEPTH + l) * 256 * 512 + h * 128, WSP(bf16_t, WS_CNAV) + ((size_t)b * DEPTH + l) * 256 * 512 + h * 128,
                            NAK + (r0 + kr0 * 64) * 512 + h * 128, NAV + (r0 + kr0 * 64) * 512 + h * 128, 512};
            att::attn_body<1>(NAQ + (r0 + qb * 256) * 512 + h * 128, src, MRG + (r0 + qb * 256) * DM + 0 + h * 128, 4 + nrows, (char*)lds, att::NaBias{tab, qb * 256, kr0});
        }
        else if (q < Q3) { const int it = (q - Q2) % NI_GLAL;
#ifdef GLA_REP
            for (int r_ = 0, n_ = opaque_int(GLA_REP); r_ < n_; ++r_)
#endif
            gla::gla_chunked(p, l, false, it / 8, (it / 2) % 4, it % 2, lds); }
        else if (q < Q4) { const int it = (q - Q3) % NI_GDNC; gdn::gdn_chunked(p, l, true, it / 8, (it / 2) % 4, it % 2, lds); }
        else if (q < Q5) {
            const int it = (q - Q4) % NI_NAC, b = it / 4, h = it % 4; const size_t r0 = (size_t)b * CT;
            att::SrcOne src{NAK + r0 * 512 + h * 128, NAV + r0 * 512 + h * 128, 512};
            att::attn_body<2>(NAQ + r0 * 512 + h * 128, src, MRG + r0 * DM + 0 + h * 128, CT / 64, (char*)lds, att::NoBias{});
        }
        else if (q < Q6) {
            const int it = (q - Q5) % NI_GQAC, b = it / 4, qh = it % 4, kvh = qh >> 1; const size_t r0 = (size_t)b * CT;
            att::SrcOne src{GK + r0 * 256 + kvh * 128, GV + r0 * 256 + kvh * 128, 256};
            att::attn_body<2>(GQ + r0 * 512 + qh * 128, src, MRG + r0 * DM + 1024 + qh * 128, CT / 64, (char*)lds, att::NoBias{});
        }
        else if (q < Q7) { const int it = (q - Q6) % NI_GLAC; gla::gla_chunked(p, l, true, it / 8, (it / 2) % 4, it % 2, lds); }
        else { const int t0 = TF2 + (q - Q7) * MIXCONV_CH, t1 = t0 + MIXCONV_CH < TF3 ? t0 + MIXCONV_CH : TF3; conv_layer_tiles(p, l + 1, t0, t1, 0, 1, (float*)lds); }
    }
}

#define CONV_FILL(nunits, t0, t1, skip) do { if (l + 1 < DBG_NLAYERS) { const int G_ = (int)gridDim.x; int f0_ = ((nunits) % G_) + (skip); if (f0_ >= G_) f0_ = 0; \
        if ((int)blockIdx.x >= f0_) { const Params q = opaque_params(p); conv_layer_tiles(q, l + 1, (t0), (t1), (int)blockIdx.x - f0_, G_ - f0_, (float*)lds); } } } while (0)
#define G1A_MSPLIT (G1A_MODE == 1 ? 2 : 0)
#define G1B_MSPLIT (G1B_MODE == 1 ? 2 : 0)
#ifndef PRESTAGE_ON
#define PRESTAGE_ON false
#endif
#ifndef PRESTAGE_F8
#define PRESTAGE_F8 true
#endif
#ifndef MSPLIT
#define MSPLIT 2
#endif
static_assert(att::SHM_ATTN + 15 * 31 * 4 + 2048 <= (size_t)XBW_OFF, "LDS map");
static_assert((QCTR_WORD0 + 64 * DEPTH) < 4096, "ctl");
constexpr int BAR_WORD0 = 4096;
static_assert((BAR_WORD0 + XCD_BAR_WORDS) * 4 <= (int)CTL_BYTES, "ctl");

__global__ void __launch_bounds__(512, 2) fwd(Params p) {
    extern __shared__ __attribute__((aligned(16))) unsigned char lds[];
    const int tid = threadIdx.x;
    volatile LAS unsigned* xbw = (volatile LAS unsigned*)((LAS unsigned char*)lds + XBW_OFF);
    if (tid < 4) xbw[tid] = 0u;
    __syncthreads();
    XcdBarrier bar; bar.bar = WSP(unsigned, WS_CTL) + BAR_WORD0; bar.x = 0; bar.st = xbw;
    if (p.ph_hi - p.ph_lo > 1) bar = xcd_barrier_post(WSP(unsigned, WS_CTL) + BAR_WORD0, xbw);
#ifndef PHMASK
#define PHMASK 0x1FFF
#endif
#define IN(k) (p.ph_lo <= (k) && (k) < p.ph_hi)
#define INL(j) (((PHMASK >> ((j) + 1)) & 1) && IN(pb + (j)))
#ifndef DUPMASK
#define DUPMASK 0
#endif
#define DUP(j) ((DUPMASK >> ((j) + 1)) & 1)
#if DUPMASK
#define REPS(j) opaque_int(1 + DUP(j))
#else
#define REPS(j) 1
#endif
#ifndef DBLBAR
#define DBLBAR 0
#endif
#ifdef DIAG_KIND
#ifndef DIAG_SCALE
#define DIAG_SCALE 0.01f
#endif
    unsigned long long dg_sum = 0ull, dg_prev = wall_clock64();
#define DIAG_AT(k) do { const unsigned long long now_ = wall_clock64(); if ((DIAG_KIND >> (((k) == 0) ? 12 : (((k) - 1) % 12))) & 1) dg_sum += now_ - dg_prev; dg_prev = now_; } while (0)
#else
#define DIAG_AT(k) do { } while (0)
#endif
#define SEAM(k) do { if (IN(k) && IN((k) + 1)) { xcd_barrier(bar); if (DBLBAR) xcd_barrier(bar); } DIAG_AT(k); } while (0)
    LAS unsigned char* ldsl = (LAS unsigned char*)lds;
    bf16_t* H = WSP(bf16_t, WS_H); bf16_t* ACT = WSP(bf16_t, WS_ACT); float* X = WSP(float, WS_X); float* Z = WSP(float, WS_Z); bf16_t* MRG = WSP(bf16_t, WS_MRG);

    if ((PHMASK & 1) && IN(0)) { const int reps_ = (DUPMASK & 1) ? opaque_int(2) : 1; for (int rep_ = 0; rep_ < reps_; ++rep_) { const Params q = opaque_params(p); phase_prologue(q, (float*)lds); __syncthreads(); } }
    SEAM(0);
    for (int l = 0; l < DBG_NLAYERS; ++l) {
        const int pb = 1 + l * 12;
        const float* modl = WSP(float, WS_MODV) + (size_t)l * NCOND * NMOD;
        if (INL(0)) { const int reps_ = REPS(0); for (int rep_ = 0; rep_ < reps_; ++rep_) { const Params q = opaque_params(p); phase_norm(q, l, 0, lds); __syncthreads(); } }
        SEAM(pb + 0);
        if (INL(1)) {
            if (g1_fp8(l, 0)) {
                pg8::Gemm g{H, (const bf16_t*)(WSP(unsigned char, WS_WGU) + ((size_t)l * 2 + 0) * NGU * DM * 2), M, NGU, DM / 2}; pg8::StaticOrder S; S.init(M, NGU, DM / 2, (int)gridDim.x, (int)blockIdx.x, 2);
                pg8::EpiSwiGLU8 E{WSP(unsigned char, WS_ACT), FFP, 1.0f / WGU_SCALE};
                for (int r_ = 0, n_ = REPS(1); r_ < n_; ++r_) pg8::gemm_phase<pg8::EpiSwiGLU8, pg8::StaticOrder, false, 1, true, PRESTAGE_F8>(ldsl, g, S, E, nullptr);
            } else {
                pg8::Gemm g{H, WSP(bf16_t, WS_WGU) + ((size_t)l * 2 + 0) * NGU * DM, M, NGU, DM}; pg8::StaticOrder S; S.init(M, NGU, DM, (int)gridDim.x, (int)blockIdx.x, 0);
                pg8::EpiSwiGLU8 E{WSP(unsigned char, WS_ACT), FFP, 1.0f};
                for (int r_ = 0, n_ = REPS(1); r_ < n_; ++r_) pg8::gemm_phase<pg8::EpiSwiGLU8, pg8::StaticOrder, false, 0, false, PRESTAGE_ON>(ldsl, g, S, E, nullptr);
            }
#if CONV_FILLER
            if (l + 1 < DBG_NLAYERS) {
                const int nw_ = (M / 256) * (NGU / 256), G_ = (int)gridDim.x; int f0_ = nw_ % G_; if (nw_ < G_) f0_ = 0;
                if (g1_fp8(l, 0)) f0_ = 2 * f0_ < G_ ? 2 * f0_ : f0_;
                if ((int)blockIdx.x >= f0_) { const Params q = opaque_params(p); mod_layer(q, l + 1, (int)blockIdx.x - f0_, G_ - f0_, (float*)lds); }
            }
            CONV_FILL((M / 256) * (NGU / 256), 0, TF0, (g1_fp8(l, 0) ? ((M / 256) * (NGU / 256)) % (int)gridDim.x : 0));
#endif
        }
        SEAM(pb + 1);
        if (INL(2)) {
            pg8::Gemm g{ACT, G2_FP8 ? (const bf16_t*)(WSP(unsigned char, WS_WDN) + ((size_t)l * 2 + 0) * DM * FFP) : WSP(bf16_t, WS_WDN) + ((size_t)l * 2 + 0) * DM * FF, M, DM, G2_FP8 ? FFP / 2 : FF}; pg8::StaticOrder S; S.init(M, DM, G2_FP8 ? FFP / 2 : FF, (int)gridDim.x, (int)blockIdx.x, SPLITK ? 1 : MSPLIT);
            pg8::EpiResid E{l == 0 ? p.in[I_XP] : X, X, DM, modl + 2 * DM, G2_FP8 ? 0.5f / WDN_SCALE : 0.5f, Z, WSP(unsigned, WS_CTL) + FLAG_WORD0, 8u * (unsigned)(l * (2 * SPLITK + SPLITK_G4) + SPLITK), l == 0 ? p.in[I_XS] : X, l == 0 ? MC : 0x7FFFFFFF, (XBF16 && l != 0), XBF16};
            pg8::gemm_phase<pg8::EpiResid, pg8::StaticOrder, false, (G2_FP8 ? 1 : 0)>(ldsl, g, S, E, nullptr);
#if DUPMASK
            if (opaque_int(DUP(2))) { pg8::EpiResid E2{l == 0 ? p.in[I_XP] : X, Z, DM, modl + 2 * DM, G2_FP8 ? 0.5f / WDN_SCALE : 0.5f, Z, WSP(unsigned, WS_CTL) + FLAG_WORD0, 0u, l == 0 ? p.in[I_XS] : X, l == 0 ? MC : 0x7FFFFFFF, 0, 0}; pg8::gemm_phase<pg8::EpiResid, pg8::StaticOrder, false, (G2_FP8 ? 1 : 0)>(ldsl, g, S, E2, nullptr); }
#endif
        }
        SEAM(pb + 2);
        if (INL(3)) { const int reps_ = REPS(3); for (int rep_ = 0; rep_ < reps_; ++rep_) { const Params q = opaque_params(p); phase_norm(q, l, 1, lds); __syncthreads(); } }
        SEAM(pb + 3);
        if (INL(4)) {
#if G3_FP8
            pg8::Gemm g{H, WSP(bf16_t, WS_WIN) + (size_t)l * NINP * DM, M, NINP, DM / 2}; pg8::StaticOrder S; S.init(M, NINP, DM / 2, (int)gridDim.x, (int)blockIdx.x, 2);
            pg8::EpiBf16Plain E{WSP(bf16_t, WS_Z), NINP, 1.0f / WIN_SCALE};
            for (int r_ = 0, n_ = REPS(4); r_ < n_; ++r_) pg8::gemm_phase<pg8::EpiBf16Plain, pg8::StaticOrder, false, 1>(ldsl, g, S, E, nullptr);
#else
            pg8::Gemm g{H, WSP(bf16_t, WS_WIN) + (size_t)l * NINP * DM, M, NINP, DM}; pg8::StaticOrder S; S.init(M, NINP, DM, (int)gridDim.x, (int)blockIdx.x);
            pg8::EpiBf16Plain E{WSP(bf16_t, WS_Z), NINP, 1.0f};
            for (int r_ = 0, n_ = REPS(4); r_ < n_; ++r_) pg8::gemm_phase<pg8::EpiBf16Plain, pg8::StaticOrder, false, 0, false, PRESTAGE_ON>(ldsl, g, S, E, nullptr);
#endif
#if CONV_FILLER
            CONV_FILL((M / 256) * (NINP / 256), TF0, TF1, 0);
#endif
        }
        SEAM(pb + 4);
        if (INL(5)) { const int reps_ = REPS(5); for (int rep_ = 0; rep_ < reps_; ++rep_) { const Params q = opaque_params(p); phase_prep(q, l, lds); __syncthreads(); } }
        SEAM(pb + 5);
        if (INL(6)) { const int reps_ = REPS(6); for (int rep_ = 0; rep_ < reps_; ++rep_) { const Params q = opaque_params(p); phase_mix(q, l, lds, rep_); __syncthreads(); } }
        SEAM(pb + 6);
        if (INL(7)) { const int reps_ = REPS(7); for (int rep_ = 0; rep_ < reps_; ++rep_) { const Params q = opaque_params(p); phase_post(q, l); __syncthreads(); } }
        SEAM(pb + 7);
        if (INL(8)) {
            pg8::Gemm g{MRG, WSP(bf16_t, WS_WOUT) + (size_t)l * DM * DM, M, DM, DM}; pg8::StaticOrder S; S.init(M, DM, DM, (int)gridDim.x, (int)blockIdx.x, SPLITK_G4);
            pg8::EpiResid E{X, X, DM, modl + 5 * DM, 1.0f, Z, WSP(unsigned, WS_CTL) + FLAG_WORD0, 8u * (unsigned)(l * (2 * SPLITK + SPLITK_G4) + SPLITK + SPLITK_G4), X, 0x7FFFFFFF, XBF16, XBF16};
            pg8::gemm_phase<pg8::EpiResid, pg8::StaticOrder, false>(ldsl, g, S, E, nullptr);
#if CONV_FILLER
            CONV_FILL((M / 256) * (DM / 256), TF1, TF2, 0);
#endif
#if DUPMASK
            if (opaque_int(DUP(8))) { pg8::EpiResid E2{X, Z, DM, modl + 5 * DM, 1.0f, Z, WSP(unsigned, WS_CTL) + FLAG_WORD0, 0u, X, 0x7FFFFFFF, 0, 0}; pg8::gemm_phase<pg8::EpiResid, pg8::StaticOrder, false>(ldsl, g, S, E2, nullptr); }
#endif
        }
        SEAM(pb + 8);
        if (INL(9)) { const int reps_ = REPS(9); for (int rep_ = 0; rep_ < reps_; ++rep_) { const Params q = opaque_params(p); phase_norm(q, l, 2, lds); __syncthreads(); } }
        SEAM(pb + 9);
        if (INL(10)) {
            {
#if G1B_MODE
                pg8::Gemm g{H, (const bf16_t*)(WSP(unsigned char, WS_WGU) + ((size_t)l * 2 + 1) * NGU * DM * 2), M, NGU, DM / 2}; pg8::StaticOrder S; S.init(M, NGU, DM / 2, (int)gridDim.x, (int)blockIdx.x, G1B_MSPLIT);
                constexpr float ws_ = 1.0f / WGU_SCALE;
#else
                pg8::Gemm g{H, WSP(bf16_t, WS_WGU) + ((size_t)l * 2 + 1) * NGU * DM, M, NGU, DM}; pg8::StaticOrder S; S.init(M, NGU, DM, (int)gridDim.x, (int)blockIdx.x, G1B_MSPLIT);
                constexpr float ws_ = 1.0f;
#endif
#if G2_FP8
                pg8::EpiSwiGLU8 E{WSP(unsigned char, WS_ACT), FFP, ws_};
                for (int r_ = 0, n_ = REPS(10); r_ < n_; ++r_) pg8::gemm_phase<pg8::EpiSwiGLU8, pg8::StaticOrder, false, G1B_MODE, true, PRESTAGE_F8>(ldsl, g, S, E, nullptr);
#else
                pg8::EpiSwiGLU E{ACT, FF};
                pg8::gemm_phase<pg8::EpiSwiGLU, pg8::StaticOrder, false, G1B_MODE>(ldsl, g, S, E, nullptr);
#endif
            }
#if CONV_FILLER
            CONV_FILL((M / 256) * (NGU / 256), TF3, NT_L, (G1B_MSPLIT ? ((M / 256) * (NGU / 256)) % (int)gridDim.x : 0));
#endif
        }
        SEAM(pb + 10);
        if (INL(11)) {
            pg8::Gemm g{ACT, G2_FP8 ? (const bf16_t*)(WSP(unsigned char, WS_WDN) + ((size_t)l * 2 + 1) * DM * FFP) : WSP(bf16_t, WS_WDN) + ((size_t)l * 2 + 1) * DM * FF, M, DM, G2_FP8 ? FFP / 2 : FF}; pg8::StaticOrder S; S.init(M, DM, G2_FP8 ? FFP / 2 : FF, (int)gridDim.x, (int)blockIdx.x, SPLITK ? 1 : MSPLIT);
            pg8::EpiResid E{X, (l == DEPTH - 1) ? p.out : X, DM, modl + 8 * DM, G2_FP8 ? 0.5f / WDN_SCALE : 0.5f, Z, WSP(unsigned, WS_CTL) + FLAG_WORD0, 8u * (unsigned)(l * (2 * SPLITK + SPLITK_G4) + 2 * SPLITK + SPLITK_G4), X, 0x7FFFFFFF, XBF16, (XBF16 && l != DEPTH - 1)};
            pg8::gemm_phase<pg8::EpiResid, pg8::StaticOrder, false, (G2_FP8 ? 1 : 0)>(ldsl, g, S, E, nullptr);
        }
        SEAM(pb + 11);
    }
#ifdef DIAG_KIND
    xcd_barrier(bar);
    if (blockIdx.x == 0 && threadIdx.x == 0) p.out[0] += (float)dg_sum * 0.01f * DIAG_SCALE;
#endif
#undef IN
#undef SEAM
}

#ifndef MULTI_LAUNCH
#define MULTI_LAUNCH 0
#endif
extern "C" void kernel_launch(void* const* d_in, const int* in_sizes, int n_in, void* d_out, int out_size, void* d_ws, size_t ws_size, hipStream_t stream) {
    static int grid = 0;
    if (grid == 0) {
        if (n_in != N_IN || (size_t)out_size != O_END || ws_size < WS_END) { fprintf(stderr, "kernel_launch: shape mismatch n_in %d out %d ws %zu (need %zu)\n", n_in, out_size, ws_size, (size_t)WS_END); grid = -1; return; }
        int dev = 0, cus = 0, per_cu = 0;
        if (hipGetDevice(&dev) != hipSuccess || hipDeviceGetAttribute(&cus, hipDeviceAttributeMultiprocessorCount, dev) != hipSuccess) { grid = -1; return; }
        if (hipFuncSetAttribute((const void*)fwd, hipFuncAttributeMaxDynamicSharedMemorySize, LDS_BYTES) != hipSuccess) { fprintf(stderr, "kernel_launch: hipFuncSetAttribute failed\n"); grid = -1; return; }
        if (hipOccupancyMaxActiveBlocksPerMultiprocessor(&per_cu, (const void*)fwd, 512, LDS_BYTES) != hipSuccess || per_cu < 1) { fprintf(stderr, "kernel_launch: occupancy query says %d\n", per_cu); (void)hipGetLastError(); }
        grid = cus;
    }
    if (grid < 0) return;
    (void)hipMemsetAsync((char*)d_ws + WS_CTL, 0, CTL_BYTES, stream);
    Params p{};
    for (int i = 0; i < N_IN; ++i) p.in[i] = (const float*)d_in[i];
    p.out = (float*)d_out; p.ws = (unsigned char*)d_ws;
#if MULTI_LAUNCH
    for (int ph = 0; ph < 1 + DBG_NLAYERS * 12; ++ph) { p.ph_lo = ph; p.ph_hi = ph + 1; hipLaunchKernelGGL(fwd, dim3(grid), dim3(512), LDS_BYTES, stream, p); }
#else
    p.ph_lo = 0; p.ph_hi = NPH; hipLaunchKernelGGL(fwd, dim3(grid), dim3(512), LDS_BYTES, stream, p);
#endif
    const hipError_t le = hipPeekAtLastError();
    if (le != hipSuccess) fprintf(stderr, "kernel_launch: launch failed: %s\n", hipGetErrorName(le));
}
```

```cpp
#include <hip/hip_runtime.h>
#include <cstdio>
#include <cstdint>

#ifndef CB_
#define CB_ 16
#endif
#ifndef LB_
#define LB_ 8
#endif
#ifndef DEPTH_
#define DEPTH_ 4
#endif
#ifndef G1A_LAYERS
#define G1A_LAYERS 0xE
#endif
#ifndef G1A_MODE
#define G1A_MODE 0
#endif
#ifndef G1B_MODE
#define G1B_MODE 1
#endif
#ifndef XBF16
#define XBF16 0
#endif
#ifndef G3_FP8
#define G3_FP8 0
#endif
#ifndef G2_FP8
#define G2_FP8 1
#endif
#ifndef FFN_FP8
#define FFN_FP8 (G1A_MODE != 0 || G1B_MODE != 0 || G2_FP8 != 0)
#endif
constexpr int DM = 2048, DEPTH = DEPTH_, CB = CB_, CT = 256, LB = LB_, LT = 1024;
constexpr int MC = CB * CT, ML = LB * LT, M = MC + ML;
constexpr int FF = 5504, NGU = 2 * FF, NIN = 6192, NINP = 6400, NMOD = 9 * DM, NCOND = 1 + LB;
constexpr float EPS = 1e-6f;
constexpr int FFP = 5632;
constexpr float WGU_SCALE = 32.0f, WDN_SCALE = 64.0f, WIN_SCALE = 32.0f;
constexpr int Z_NAQ = 0, Z_NAK = 512, Z_NAV = 1024, Z_GLQ = 1536, Z_GLK = 1792, Z_GLV = 2048, Z_GLR = 2560, Z_GF = 3072, Z_GB = 3088,
              Z_GQQ = 3104, Z_GQK = 3616, Z_GQV = 3872, Z_DQKV = 4128, Z_DZ = 5664, Z_DB = 6176, Z_DA = 6184;
static_assert(Z_DA + 8 == NIN, "split");
enum { I_XP = 0, I_XS, I_CNAK, I_CNAV, I_CGK, I_CGV, I_SGLA, I_SGDN, I_C, I_CCTX, I_NORMG, I_WMOD, I_BMOD, I_GU, I_DOWN, I_WIN, I_WOUT, I_NAQKN, I_RPB,
       I_GUP, I_GBIAS, I_GLAON, I_GQAQKN, I_CONV, I_ALOG, I_DTB, I_GDNON, N_IN };
constexpr size_t O_YP = 0, O_YS = O_YP + (size_t)MC * DM, O_NAK = O_YS + (size_t)ML * DM, O_NAV = O_NAK + (size_t)CB * DEPTH * 4 * CT * 128,
                 O_GK = O_NAV + (size_t)CB * DEPTH * 4 * CT * 128, O_GV = O_GK + (size_t)CB * DEPTH * 2 * CT * 128,
                 O_SGLA = O_GV + (size_t)CB * DEPTH * 2 * CT * 128, O_SGDN = O_SGLA + (size_t)CB * DEPTH * 2 * 4 * 64 * 128,
                 O_END = O_SGDN + (size_t)CB * DEPTH * 2 * 4 * 128 * 128;
constexpr size_t al256(size_t x) { return (x + 255) & ~(size_t)255; }
constexpr size_t WS_CTL = 0, CTL_BYTES = 1u << 20;
constexpr size_t WS_WGU = CTL_BYTES;
constexpr size_t WS_WDN = WS_WGU + (size_t)DEPTH * 2 * NGU * DM * 2;
constexpr size_t WS_WIN = WS_WDN + (size_t)DEPTH * 2 * DM * FF * 2;
constexpr size_t WS_WOUT = WS_WIN + (size_t)DEPTH * NINP * DM * 2;
constexpr size_t WS_MODV = WS_WOUT + (size_t)DEPTH * DM * DM * 2;
constexpr size_t WS_ROPE = al256(WS_MODV + (size_t)DEPTH * NCOND * NMOD * 4);
constexpr size_t WS_X = al256(WS_ROPE + 2 * 64 * 32 * 4);
constexpr size_t WS_H = WS_X + (size_t)M * DM * 4;
constexpr size_t WS_ACT = WS_H + (size_t)M * DM * 2;
constexpr size_t WS_Z = WS_ACT + (size_t)M * FF * 2;
constexpr size_t WS_MRG = WS_Z + (size_t)M * NINP * 4;
constexpr size_t WS_NAQ = WS_MRG + (size_t)M * DM * 2;
constexpr size_t WS_NAK = WS_NAQ + (size_t)M * 512 * 2;
constexpr size_t WS_NAV = WS_NAK + (size_t)M * 512 * 2;
constexpr size_t WS_GQ = WS_NAV + (size_t)M * 512 * 2;
constexpr size_t WS_GK = WS_GQ + (size_t)M * 512 * 2;
constexpr size_t WS_GV = WS_GK + (size_t)M * 256 * 2;
constexpr size_t WS_CNAK = WS_GV + (size_t)M * 256 * 2;
constexpr size_t WS_CNAV = WS_CNAK + (size_t)LB * DEPTH * 256 * 512 * 2;
constexpr size_t WS_CGK = WS_CNAV + (size_t)LB * DEPTH * 256 * 512 * 2;
constexpr size_t WS_CGV = WS_CGK + (size_t)LB * DEPTH * 256 * 256 * 2;
constexpr size_t WS_AF = WS_CGV + (size_t)LB * DEPTH * 256 * 256 * 2;
constexpr size_t WS_AB = WS_AF + (size_t)M * 256 * 4;
constexpr size_t WS_DQ = WS_AB + (size_t)M * 256 * 4;
constexpr size_t WS_DK = WS_DQ + (size_t)M * 512 * 4;
constexpr size_t WS_DV = WS_DK + (size_t)M * 512 * 4;
constexpr size_t WS_DBA = WS_DV + (size_t)M * 512 * 4;
constexpr size_t WS_GOF = WS_DBA + (size_t)M * 16 * 4;
constexpr size_t WS_GOB = WS_GOF + (size_t)M * 512 * 4;
constexpr size_t WS_DOF = WS_GOB + (size_t)M * 512 * 4;
constexpr size_t WS_DOB = WS_DOF + (size_t)M * 512 * 4;
constexpr size_t WS_END = WS_DOB + (size_t)M * 512 * 4;

typedef unsigned short bf16_t;
struct Params { const float* in[N_IN]; float* out; unsigned char* ws; int ph_lo, ph_hi; };
static_assert(sizeof(Params) == N_IN * 8 + 8 + 8 + 8, "no padding");

#define WSP(T, off) ((T*)(p.ws + (off)))
__device__ __forceinline__ int opaque_tid() { int t = (int)threadIdx.x; asm volatile("" : "+v"(t)); return t; }
__device__ __forceinline__ Params opaque_params(const Params& p) { Params q = p; unsigned long long w = (unsigned long long)q.ws; asm volatile("" : "+s"(w));
    q.ws = (unsigned char*)(__attribute__((address_space(1))) unsigned char*)w; return q; }

typedef float vf4 __attribute__((ext_vector_type(4)));
__device__ __forceinline__ unsigned pack4_fp8(float a, float b, float c, float d) { int w = 0; w = __builtin_amdgcn_cvt_pk_fp8_f32(a, b, w, false); w = __builtin_amdgcn_cvt_pk_fp8_f32(c, d, w, true); return (unsigned)w; }
__device__ __forceinline__ float bf2f(unsigned short v) { return __uint_as_float((unsigned)v << 16); }
__device__ __forceinline__ vf4 ld4bf(const unsigned short* p) { const uint2 w = *(const uint2*)p; vf4 r; r.x = __uint_as_float(w.x << 16); r.y = __uint_as_float(w.x & 0xFFFF0000u); r.z = __uint_as_float(w.y << 16); r.w = __uint_as_float(w.y & 0xFFFF0000u); return r; }
__device__ __forceinline__ vf4 unp4bf(uint2 w) { vf4 r; r.x = __uint_as_float(w.x << 16); r.y = __uint_as_float(w.x & 0xFFFF0000u); r.z = __uint_as_float(w.y << 16); r.w = __uint_as_float(w.y & 0xFFFF0000u); return r; }
__device__ __forceinline__ void unp8bf(uint4 w, vf4& a, vf4& b) {
    a.x = __uint_as_float(w.x << 16); a.y = __uint_as_float(w.x & 0xFFFF0000u); a.z = __uint_as_float(w.y << 16); a.w = __uint_as_float(w.y & 0xFFFF0000u);
    b.x = __uint_as_float(w.z << 16); b.y = __uint_as_float(w.z & 0xFFFF0000u); b.z = __uint_as_float(w.w << 16); b.w = __uint_as_float(w.w & 0xFFFF0000u); }
__device__ __forceinline__ void ld8bf(const unsigned short* p, vf4& a, vf4& b) { const uint4 w = *(const uint4*)p;
    a.x = __uint_as_float(w.x << 16); a.y = __uint_as_float(w.x & 0xFFFF0000u); a.z = __uint_as_float(w.y << 16); a.w = __uint_as_float(w.y & 0xFFFF0000u);
    b.x = __uint_as_float(w.z << 16); b.y = __uint_as_float(w.z & 0xFFFF0000u); b.z = __uint_as_float(w.w << 16); b.w = __uint_as_float(w.w & 0xFFFF0000u); }
__device__ __forceinline__ float wave_sum(float v) {
#pragma unroll
    for (int o = 32; o >= 1; o >>= 1) v += __shfl_xor(v, o);
    return v;
}
typedef float vf2_ __attribute__((ext_vector_type(2)));
typedef __bf16 vb2_ __attribute__((ext_vector_type(2)));
__device__ __forceinline__ bf16_t f2bf(float f) { return __builtin_bit_cast(unsigned short, (__bf16)f); }
__device__ __forceinline__ unsigned pack2(float a, float b) { return __builtin_bit_cast(unsigned, __builtin_convertvector((vf2_){a, b}, vb2_)); }
__device__ __forceinline__ float silu_f(float x) { return x / (1.f + expf(-x)); }
__device__ __forceinline__ float rsqrt_fast(float x) { return __builtin_amdgcn_rsqf(x); }
__device__ __forceinline__ float silu_fast(float x) { return x * __builtin_amdgcn_rcpf(1.f + __expf(-x)); }
__device__ __forceinline__ float logsigmoid_fast(float x) { return fminf(x, 0.f) - __logf(1.f + __expf(-fabsf(x))); }
__device__ __forceinline__ float softplus_f(float x) { return fmaxf(x, 0.f) + log1pf(expf(-fabsf(x))); }
__device__ __forceinline__ float logsigmoid_f(float x) { return fminf(x, 0.f) - log1pf(expf(-fabsf(x))); }
__device__ __forceinline__ bool g1_fp8(int l, int f) { return f ? (G1B_MODE != 0) : (G1A_MODE != 0 || ((G1A_LAYERS >> l) & 1)); }
__device__ __forceinline__ int opaque_int(int v) { asm volatile("" : "+s"(v)); return v; }
__device__ __forceinline__ int cond_of_row(int m) { return m < MC ? 0 : 1 + (m - MC) / LT; }
#ifndef CONV_FILLER
#define CONV_FILLER 1
#endif
__device__ __forceinline__ void conv_tile(const float* __restrict__ src, int ld_src, int ncols_src, int k0, int c0, bf16_t* __restrict__ dst, int ld_dst, int n0, float* tile) {
    const int tid = opaque_tid();
    {
        const int r = tid >> 3, c = (tid & 7) * 8;
        float4 a = make_float4(0.f, 0.f, 0.f, 0.f), b = a;
        if (c0 + c + 8 <= ncols_src) {
            const float* s = src + (size_t)(k0 + r) * ld_src + c0 + c;
            a = *(const float4*)s; b = *(const float4*)(s + 4);
        }
        float* t = tile + r * 65 + c;
        t[0] = a.x; t[1] = a.y; t[2] = a.z; t[3] = a.w; t[4] = b.x; t[5] = b.y; t[6] = b.z; t[7] = b.w;
    }
    __syncthreads();
    {
        const int n = tid >> 3, ks = (tid & 7) * 8;
        const float* t = tile + ks * 65 + n;
        uint4 w;
        w.x = pack2(t[0 * 65], t[1 * 65]); w.y = pack2(t[2 * 65], t[3 * 65]); w.z = pack2(t[4 * 65], t[5 * 65]); w.w = pack2(t[6 * 65], t[7 * 65]);
        *(uint4*)(dst + (size_t)(n0 + n) * ld_dst + k0 + ks) = w;
    }
    __syncthreads();
}

__device__ __forceinline__ void conv_tile8(const float* __restrict__ src, int ld_src, int nrows_src, int k0, int c0, unsigned char* __restrict__ dst, int ld_dst, int n0, float scale, float* tile) {
    const int tid = opaque_tid();
    {
        const int r = tid >> 3, c = (tid & 7) * 8;
        float4 a = make_float4(0.f, 0.f, 0.f, 0.f), b = a;
        if (k0 + r < nrows_src) { const float* s = src + (size_t)(k0 + r) * ld_src + c0 + c; a = *(const float4*)s; b = *(const float4*)(s + 4); }
        float* t = tile + r * 65 + c;
        t[0] = a.x * scale; t[1] = a.y * scale; t[2] = a.z * scale; t[3] = a.w * scale; t[4] = b.x * scale; t[5] = b.y * scale; t[6] = b.z * scale; t[7] = b.w * scale;
    }
    __syncthreads();
    {
        const int n = tid >> 3, ks = (tid & 7) * 8;
        const float* t = tile + ks * 65 + n;
        uint2 w; w.x = pack4_fp8(t[0 * 65], t[1 * 65], t[2 * 65], t[3 * 65]); w.y = pack4_fp8(t[4 * 65], t[5 * 65], t[6 * 65], t[7 * 65]);
        *(uint2*)(dst + (size_t)(n0 + n) * ld_dst + k0 + ks) = w;
    }
    __syncthreads();
}
constexpr int MOD_ITEMS = DEPTH * (NMOD / 128);
constexpr int TGU_KT = DM / 64, TGU_NT = NGU / 64, TDN_KT = (G2_FP8 ? FFP : FF) / 64, TDN_NT = DM / 64, TIN_KT = DM / 64, TIN_NT = NINP / 64, TOUT_KT = DM / 64, TOUT_NT = DM / 64;
constexpr int TL_GU = 2 * TGU_KT * TGU_NT, TL_DN = 2 * TDN_KT * TDN_NT, TL_IN = TIN_KT * TIN_NT, TL_OUT = TOUT_KT * TOUT_NT, NT_L = TL_GU + TL_DN + TL_IN + TL_OUT;
struct CTile { const float* sp; unsigned char* dp; float scale; int fp8; };
__device__ __forceinline__ CTile conv_desc(const Params& p, int l, int it, int tid) {
    const int r = tid >> 3, c = (tid & 7) * 8;
    CTile d; d.scale = 1.0f; d.fp8 = 0;
    if (it < TL_GU) {
        const int mat = l * 2 + it / (TGU_KT * TGU_NT), rr = it % (TGU_KT * TGU_NT), kt = rr / TGU_NT, nt = rr % TGU_NT;
        const int n0 = nt * 64, t256 = n0 / 256, cc = n0 % 256;
        const int c0 = cc < 128 ? 128 * t256 + cc : FF + 128 * t256 + (cc - 128);
        d.sp = p.in[I_GU] + (size_t)mat * DM * NGU + (size_t)(kt * 64 + r) * NGU + c0 + c;
        if (g1_fp8(mat >> 1, mat & 1)) { d.fp8 = 1; d.scale = WGU_SCALE; d.dp = WSP(unsigned char, WS_WGU) + (size_t)mat * NGU * DM * 2 + (size_t)(n0 + r) * DM + kt * 64 + c; }
        else d.dp = WSP(unsigned char, WS_WGU) + ((size_t)mat * NGU * DM + (size_t)(n0 + r) * DM + kt * 64 + c) * 2;
    } else if (it < TL_GU + TL_DN) {
        const int i2 = it - TL_GU, mat = l * 2 + i2 / (TDN_KT * TDN_NT), rr = i2 % (TDN_KT * TDN_NT), kt = rr / TDN_NT, nt = rr % TDN_NT;
        d.sp = (kt * 64 + r < FF) ? p.in[I_DOWN] + (size_t)mat * FF * DM + (size_t)(kt * 64 + r) * DM + nt * 64 + c : nullptr;
#if G2_FP8
        d.fp8 = 1; d.scale = WDN_SCALE; d.dp = WSP(unsigned char, WS_WDN) + (size_t)mat * DM * FFP + (size_t)(nt * 64 + r) * FFP + kt * 64 + c;
#else
        d.dp = WSP(unsigned char, WS_WDN) + ((size_t)mat * DM * FF + (size_t)(nt * 64 + r) * FF + kt * 64 + c) * 2;
#endif
    } else if (it < TL_GU + TL_DN + TL_IN) {
        const int i2 = it - TL_GU - TL_DN, kt = i2 / TIN_NT, nt = i2 % TIN_NT;
        d.sp = (nt * 64 + c + 8 <= NIN) ? p.in[I_WIN] + (size_t)l * DM * NIN + (size_t)(kt * 64 + r) * NIN + nt * 64 + c : nullptr;
#if G3_FP8
        d.fp8 = 1; d.scale = WIN_SCALE; d.dp = WSP(unsigned char, WS_WIN) + (size_t)l * NINP * DM * 2 + (size_t)(nt * 64 + r) * DM + kt * 64 + c;
#else
        d.dp = WSP(unsigned char, WS_WIN) + ((size_t)l * NINP * DM + (size_t)(nt * 64 + r) * DM + kt * 64 + c) * 2;
#endif
    } else {
        const int i2 = it - TL_GU - TL_DN - TL_IN, kt = i2 / TOUT_NT, nt = i2 % TOUT_NT;
        d.sp = p.in[I_WOUT] + (size_t)l * DM * DM + (size_t)(kt * 64 + r) * DM + nt * 64 + c;
        d.dp = WSP(unsigned char, WS_WOUT) + ((size_t)l * DM * DM + (size_t)(nt * 64 + r) * DM + kt * 64 + c) * 2;
    }
    return d;
}
#ifndef CONV_U
#define CONV_U 8
#endif
__device__ __forceinline__ void conv_layer_tiles(const Params& p, int l, int t_begin, int t_end, int first, int stride, float* s_tile) {
    const int tid = opaque_tid(), r = tid >> 3, c = (tid & 7) * 8;
    int it = t_begin + first;
    if (it >= t_end) return;
    __syncthreads();
    for (; it < t_end; it += CONV_U * stride) {
        const float* sp[CONV_U]; unsigned char* dp[CONV_U]; float sc[CONV_U]; int f8[CONV_U]; float4 a[CONV_U], b[CONV_U];
#pragma unroll
        for (int u = 0; u < CONV_U; ++u) {
            const int iu = it + u * stride; const bool ok = iu < t_end;
            const CTile d = conv_desc(p, l, ok ? iu : it, tid);
            sp[u] = ok ? d.sp : nullptr; dp[u] = ok ? d.dp : nullptr; sc[u] = d.scale; f8[u] = d.fp8;
            a[u] = make_float4(0.f, 0.f, 0.f, 0.f); b[u] = a[u];
            if (sp[u]) { a[u] = *(const float4*)sp[u]; b[u] = *(const float4*)(sp[u] + 4); }
        }
#pragma unroll
        for (int u = 0; u < CONV_U; ++u) {
            float* t = s_tile + u * (64 * 65) + r * 65 + c; const float s1 = sc[u];
            t[0] = a[u].x * s1; t[1] = a[u].y * s1; t[2] = a[u].z * s1; t[3] = a[u].w * s1; t[4] = b[u].x * s1; t[5] = b[u].y * s1; t[6] = b[u].z * s1; t[7] = b[u].w * s1;
        }
        __syncthreads();
#pragma unroll
        for (int u = 0; u < CONV_U; ++u) if (dp[u]) {
            const float* t = s_tile + u * (64 * 65) + c * 65 + r;
            if (f8[u]) { uint2 w; w.x = pack4_fp8(t[0 * 65], t[1 * 65], t[2 * 65], t[3 * 65]); w.y = pack4_fp8(t[4 * 65], t[5 * 65], t[6 * 65], t[7 * 65]); *(uint2*)dp[u] = w; }
            else { uint4 w; w.x = pack2(t[0 * 65], t[1 * 65]); w.y = pack2(t[2 * 65], t[3 * 65]); w.z = pack2(t[4 * 65], t[5 * 65]); w.w = pack2(t[6 * 65], t[7 * 65]); *(uint4*)dp[u] = w; }
        }
        __syncthreads();
    }
}
constexpr int MOD_TC = 72, MOD_CG = MOD_TC / 4, MOD_KS = 16, MOD_KR = DM / MOD_KS, MOD_NT = NMOD / MOD_TC;
constexpr int MOD_LDS_FLOATS = NCOND * DM + MOD_KS * MOD_CG * NCOND * 4;
static_assert(NMOD % MOD_TC == 0 && MOD_CG * MOD_KS <= 512 && DM % MOD_KS == 0 && MOD_KR % 16 == 0 && (NCOND * DM) % (512 * 12) == 0, "mod tiling");
__device__ __forceinline__ void mod_layer(const Params& p, int l, int first, int stride, float* smem) {
    const int tid = opaque_tid();
    float* s_cond = smem;
    float* s_red = s_cond + NCOND * DM;
    __syncthreads();
    for (int i0 = tid; i0 < NCOND * DM; i0 += 512 * 12) {
        float cv[12];
#pragma unroll
        for (int k = 0; k < 12; ++k) { const int i = i0 + 512 * k, ci = i / DM, kk = i % DM; cv[k] = ci == 0 ? p.in[I_CCTX][kk] : p.in[I_C][(size_t)(ci - 1) * DM + kk]; }
#pragma unroll
        for (int k = 0; k < 12; ++k) s_cond[i0 + 512 * k] = silu_f(cv[k]);
    }
    __syncthreads();
    float* modv = WSP(float, WS_MODV);
    const int cg = tid % MOD_CG, ks = tid / MOD_CG;
    for (int jt = first; jt < MOD_NT; jt += stride) {
        if (ks < MOD_KS) {
            const float* w = p.in[I_WMOD] + (size_t)l * DM * NMOD + (size_t)(ks * MOD_KR) * NMOD + jt * MOD_TC + cg * 4;
            const float* sc = s_cond + ks * MOD_KR;
            vf4 acc[NCOND];
#pragma unroll
            for (int ci = 0; ci < NCOND; ++ci) acc[ci] = (vf4){0.f, 0.f, 0.f, 0.f};
            for (int k = 0; k < MOD_KR; k += 16) {
                vf4 wv[16];
#pragma unroll
                for (int j = 0; j < 16; ++j) wv[j] = *(const vf4*)(w + (size_t)(k + j) * NMOD);
#pragma unroll
                for (int j4 = 0; j4 < 4; ++j4)
#pragma unroll
                    for (int ci = 0; ci < NCOND; ++ci) {
                        const vf4 s = *(const vf4*)&sc[ci * DM + k + j4 * 4];
                        acc[ci] += s.x * wv[j4 * 4] + s.y * wv[j4 * 4 + 1] + s.z * wv[j4 * 4 + 2] + s.w * wv[j4 * 4 + 3];
                    }
            }
#pragma unroll
            for (int ci = 0; ci < NCOND; ++ci) *(vf4*)&s_red[((ks * MOD_CG + cg) * NCOND + ci) * 4] = acc[ci];
        }
        __syncthreads();
        for (int i = tid; i < MOD_TC * NCOND; i += 512) {
            const int c = i % MOD_TC, ci = i / MOD_TC, col = jt * MOD_TC + c;
            float sum = p.in[I_BMOD][(size_t)l * NMOD + col];
#pragma unroll
            for (int k2 = 0; k2 < MOD_KS; ++k2) sum += s_red[((k2 * MOD_CG + (c >> 2)) * NCOND + ci) * 4 + (c & 3)];
            modv[((size_t)l * NCOND + ci) * NMOD + col] = sum;
        }
        __syncthreads();
    }
}

__device__ __forceinline__ void phase_prologue(const Params& p, float* smem) {
    const int tid = threadIdx.x, nb = gridDim.x, bid = blockIdx.x;
    float* s_tile = smem;
#if CONV_FILLER
    mod_layer(p, 0, bid, nb, smem);
#ifdef PRO_DUP_MOD
    for (int r_ = 0; r_ < opaque_int(PRO_DUP_MOD); ++r_) mod_layer(p, 0, bid, nb, smem);
#endif
#else
    for (int l2 = 0; l2 < DEPTH; ++l2) mod_layer(p, l2, bid, nb, smem);
#endif
    conv_layer_tiles(p, 0, 0, NT_L, bid, nb, s_tile);
#ifdef PRO_DUP_CONV
    for (int r_ = 0; r_ < opaque_int(PRO_DUP_CONV); ++r_) conv_layer_tiles(p, 0, 0, NT_L, bid, nb, s_tile);
#endif
#if !CONV_FILLER
    for (int l2 = 1; l2 < DEPTH; ++l2) conv_layer_tiles(p, l2, 0, NT_L, bid, nb, s_tile);
#endif
    const size_t gtid = (size_t)bid * 512 + tid, gstride = (size_t)nb * 512;
    {
        const size_t n_na = (size_t)LB * DEPTH * 256 * 512 / 8;
        for (size_t i = gtid; i < 2 * n_na; i += gstride) {
            const bool isv = i >= n_na; const size_t j = isv ? i - n_na : i;
            const int d8 = (int)(j % 16), h = (int)((j / 16) % 4), t = (int)((j / 64) % 256); const size_t bl = j / (64 * 256);
            const float* s = p.in[isv ? I_CNAV : I_CNAK] + ((bl * 4 + h) * 256 + t) * 128 + d8 * 8;
            const float4 a = *(const float4*)s, b = *(const float4*)(s + 4);
            uint4 w; w.x = pack2(a.x, a.y); w.y = pack2(a.z, a.w); w.z = pack2(b.x, b.y); w.w = pack2(b.z, b.w);
            *(uint4*)(WSP(bf16_t, isv ? WS_CNAV : WS_CNAK) + (bl * 256 + t) * 512 + h * 128 + d8 * 8) = w;
        }
        const size_t n_g = (size_t)LB * DEPTH * 256 * 256 / 8;
        for (size_t i = gtid; i < 2 * n_g; i += gstride) {
            const bool isv = i >= n_g; const size_t j = isv ? i - n_g : i;
            const int d8 = (int)(j % 16), h = (int)((j / 16) % 2), t = (int)((j / 32) % 256); const size_t bl = j / (32 * 256);
            const float* s = p.in[isv ? I_CGV : I_CGK] + ((bl * 2 + h) * 256 + t) * 128 + d8 * 8;
            const float4 a = *(const float4*)s, b = *(const float4*)(s + 4);
            uint4 w; w.x = pack2(a.x, a.y); w.y = pack2(a.z, a.w); w.z = pack2(b.x, b.y); w.w = pack2(b.z, b.w);
            *(uint4*)(WSP(bf16_t, isv ? WS_CGV : WS_CGK) + (bl * 256 + t) * 256 + h * 128 + d8 * 8) = w;
        }
    }
    for (size_t i = gtid; i < 64 * 32; i += gstride) {
        const int pos = (int)(i / 32), k = (int)(i % 32);
        const float inv = powf(10000.0f, -(float)(2 * k) / 64.0f);
        const float ang = (float)pos * inv;
        WSP(float, WS_ROPE)[i] = cosf(ang); WSP(float, WS_ROPE)[64 * 32 + i] = sinf(ang);
    }
}

#ifndef NORM_NR
#define NORM_NR 2
#endif
constexpr int NORM_MAXC = 6;
__device__ __forceinline__ void phase_norm(const Params& p, int l, int which  , unsigned char* lds) {
    const int tid = opaque_tid(), lane = tid & 63, wv = tid >> 6;
    const float* X = WSP(float, WS_X); bf16_t* H = WSP(bf16_t, WS_H);
    const bool from_in = (l == 0 && which == 0);
    const float* g = p.in[I_NORMG] + ((size_t)l * 3 + which) * DM;
    const int rpb = (M + (int)gridDim.x - 1) / (int)gridDim.x;
    const int r0 = (int)blockIdx.x * rpb, r1 = r0 + rpb < M ? r0 + rpb : M;
    if (r0 >= r1) return;
    const int c_lo = cond_of_row(r0), c_hi = cond_of_row(r1 - 1);
    float* sw = (float*)lds;
    for (int ci = 0; ci <= c_hi - c_lo && ci < NORM_MAXC; ++ci) {
        const float* mv = WSP(float, WS_MODV) + ((size_t)l * NCOND + c_lo + ci) * NMOD + (size_t)which * 3 * DM;
        const int c = tid * 4;
        const vf4 gg = *(const vf4*)(g + c), sh = *(const vf4*)(mv + c), sc = *(const vf4*)(mv + DM + c);
        *(vf4*)(sw + (size_t)ci * 2 * DM + c) = gg * (1.f + sc);
        *(vf4*)(sw + (size_t)ci * 2 * DM + DM + c) = sh;
    }
    __syncthreads();
    for (int m0 = r0 + wv; m0 < r1; m0 += NORM_NR * 8) {
        int mm[NORM_NR]; bool has[NORM_NR];
#pragma unroll
        for (int k = 0; k < NORM_NR; ++k) { has[k] = m0 + k * 8 < r1; mm[k] = has[k] ? m0 + k * 8 : m0; }
        vf4 v[NORM_NR][8]; float ss[NORM_NR];
#pragma unroll
        for (int k = 0; k < NORM_NR; ++k) {
            const int m = mm[k];
            if (from_in || !XBF16) {
                const float* x = !from_in ? X + (size_t)m * DM : m < MC ? p.in[I_XP] + (size_t)m * DM : p.in[I_XS] + (size_t)(m - MC) * DM;
#pragma unroll
                for (int i = 0; i < 8; ++i) v[k][i] = *(const vf4*)(x + (i * 64 + lane) * 4);
            } else {
                const bf16_t* x = (const bf16_t*)X + (size_t)m * DM;
#pragma unroll
                for (int i = 0; i < 8; ++i) v[k][i] = ld4bf(x + (i * 64 + lane) * 4);
            }
        }
#pragma unroll
        for (int k = 0; k < NORM_NR; ++k) {
            ss[k] = 0.f;
#pragma unroll
            for (int i = 0; i < 8; ++i) ss[k] += v[k][i].x * v[k][i].x + v[k][i].y * v[k][i].y + v[k][i].z * v[k][i].z + v[k][i].w * v[k][i].w;
            ss[k] = wave_sum(ss[k]);
        }
#pragma unroll
        for (int k = 0; k < NORM_NR; ++k) {
            if (k > 0 && !has[k]) break;
            const int m = mm[k];
            const float* a = sw + (size_t)(cond_of_row(m) - c_lo) * 2 * DM;
            const float r = rsqrt_fast(ss[k] * (1.0f / DM) + EPS);
#pragma unroll
            for (int i = 0; i < 8; ++i) {
                const int c = (i * 64 + lane) * 4;
                const vf4 o = v[k][i] * r * *(const vf4*)(a + c) + *(const vf4*)(a + DM + c);
                if (which == 1 ? (G3_FP8 != 0) : g1_fp8(l, which >> 1)) *(unsigned*)((unsigned char*)H + (size_t)m * DM + c) = pack4_fp8(o.x, o.y, o.z, o.w);
                else { uint2 w; w.x = pack2(o.x, o.y); w.y = pack2(o.z, o.w); *(uint2*)(H + (size_t)m * DM + c) = w; }
            }
            if (G2_FP8 && which != 1 && lane < (FFP - FF) / 4) *(unsigned*)(WSP(unsigned char, WS_ACT) + (size_t)m * FFP + FF + 4 * lane) = 0u;
        }
    }
}

__device__ __forceinline__ float red16(float v);
__device__ __forceinline__ float ssq8(vf4 a, vf4 b) { const vf4 s = a * a + b * b; return (s.x + s.y) + (s.z + s.w); }
__device__ __forceinline__ uint4 pack8(vf4 a, vf4 b) { uint4 w; w.x = pack2(a.x, a.y); w.y = pack2(a.z, a.w); w.z = pack2(b.x, b.y); w.w = pack2(b.z, b.w); return w; }
constexpr int PL_CW = 0, PL_UP = PL_CW + 5 * 1536, PL_GB = PL_UP + 2 * 16 * 256, PL_NQ = PL_GB + 512, PL_ROPE = PL_NQ + 512, PL_END = PL_ROPE + 2 * 64 * 32;
__device__ __forceinline__ void phase_prep(const Params& p, int l, unsigned char* lds) {
    const int tid = opaque_tid(), lane = tid & 63, wv = tid >> 6, rg = lane >> 4, sub = lane & 15, c8 = sub * 8;
    const bf16_t* Z = WSP(bf16_t, WS_Z);
    float* sw = (float*)lds;
    {
        float cv[15]; vf4 uv[4], rv[2];
#pragma unroll
        for (int k = 0; k < 15; ++k) cv[k] = p.in[I_CONV][(size_t)l * 5 * 1536 + tid + 512 * k];
#pragma unroll
        for (int k = 0; k < 4; ++k) uv[k] = ((const vf4*)(p.in[I_GUP] + (size_t)l * 2 * 16 * 256))[tid + 512 * k];
        const float gb = p.in[I_GBIAS][(size_t)l * 512 + tid];
        const int v = tid >> 7, c = tid & 127; const float nq = ((v < 2 ? p.in[I_NAQKN] : p.in[I_GQAQKN]) + ((size_t)l * 2 + (v & 1)) * 128)[c];
#pragma unroll
        for (int k = 0; k < 2; ++k) rv[k] = ((const vf4*)WSP(float, WS_ROPE))[tid + 512 * k];
#pragma unroll
        for (int k = 0; k < 15; ++k) { const int i = tid + 512 * k, j = i / 1536, col = i % 1536; sw[PL_CW + j * 1536 + ((col >> 2) & 1) * 768 + (col >> 3) * 4 + (col & 3)] = cv[k]; }
#pragma unroll
        for (int k = 0; k < 4; ++k) ((vf4*)(sw + PL_UP))[tid + 512 * k] = uv[k];
        sw[PL_GB + tid] = gb;
        sw[PL_NQ + v * 128 + ((c >> 2) & 1) * 64 + (c >> 3) * 4 + (c & 3)] = nq;
#pragma unroll
        for (int k = 0; k < 2; ++k) ((vf4*)(sw + PL_ROPE))[tid + 512 * k] = rv[k];
    }
    __syncthreads();
    const float* ropec = sw + PL_ROPE; const float* ropes = ropec + 64 * 32;
    const float* wnq = sw + PL_NQ + sub * 4; const float* wnk = wnq + 128;
    const float* wgq = wnq + 256; const float* wgk = wnq + 384;
    const float* cw = sw + PL_CW + (rg * 16 + sub) * 4;
    const int rpw = (M + (int)gridDim.x * 8 - 1) / ((int)gridDim.x * 8);
    for (int m = ((int)blockIdx.x * 8 + wv) * rpw, mend = (m + rpw < M ? m + rpw : M); m < mend; ++m) {
        const bf16_t* z = Z + (size_t)m * NINP;
        const bool ctx = m < MC;
        const int b = ctx ? m / CT : (m - MC) / LT, t = ctx ? m % CT : (m - MC) % LT, T = ctx ? CT : LT;
        const int ho = rg * 128 + c8;
        uint4 rz[5]; uint2 rgz[2][4];
        {
            const bf16_t* zkv = z + (rg < 2 ? Z_GQK + rg * 128 : Z_GQV + (rg - 2) * 128) + c8;
            rz[0] = *(const uint4*)(z + Z_NAQ + ho); rz[1] = *(const uint4*)(z + Z_NAK + ho); rz[2] = *(const uint4*)(z + Z_NAV + ho); rz[3] = *(const uint4*)(z + Z_GQQ + ho); rz[4] = *(const uint4*)zkv;
#pragma unroll
            for (int dir = 0; dir < 2; ++dir)
#pragma unroll
                for (int r4 = 0; r4 < 4; ++r4) rgz[dir][r4] = *(const uint2*)(z + (dir ? Z_GB : Z_GF) + 4 * r4);
        }
        uint4 rcz[3][5];
#pragma unroll
        for (int part = 0; part < 3; ++part)
#pragma unroll
            for (int j = 0; j < 5; ++j) { const int tt = t + j - 2;
                rcz[part][j] = (tt >= 0 && tt < T) ? *(const uint4*)(Z + (size_t)(m + j - 2) * NINP + Z_DQKV + part * 512 + rg * 128 + c8) : make_uint4(0u, 0u, 0u, 0u); }
        asm volatile("" ::: "memory");
        {
            vf4 q0, q1, k0, k1, v0, v1, g0, g1, x0, x1;
            unp8bf(rz[0], q0, q1); unp8bf(rz[1], k0, k1); unp8bf(rz[2], v0, v1); unp8bf(rz[3], g0, g1); unp8bf(rz[4], x0, x1);
            float r = rsqrt_fast(red16(ssq8(q0, q1)) * (1.0f / 128) + EPS);
            q0 = q0 * r * *(const vf4*)wnq; q1 = q1 * r * *(const vf4*)(wnq + 64);
            *(uint4*)(WSP(bf16_t, WS_NAQ) + (size_t)m * 512 + ho) = pack8(q0, q1);
            r = rsqrt_fast(red16(ssq8(k0, k1)) * (1.0f / 128) + EPS);
            k0 = k0 * r * *(const vf4*)wnk; k1 = k1 * r * *(const vf4*)(wnk + 64);
            *(uint4*)(WSP(bf16_t, WS_NAK) + (size_t)m * 512 + ho) = pack8(k0, k1);
            *(uint4*)(WSP(bf16_t, WS_NAV) + (size_t)m * 512 + ho) = pack8(v0, v1);
            if (ctx) {
                const size_t o = ((((size_t)b * DEPTH + l) * 4 + rg) * CT + t) * 128 + c8;
                *(vf4*)(p.out + O_NAK + o) = k0; *(vf4*)(p.out + O_NAK + o + 4) = k1; *(vf4*)(p.out + O_NAV + o) = v0; *(vf4*)(p.out + O_NAV + o + 4) = v1;
            }
            r = rsqrt_fast(red16(ssq8(g0, g1)) * (1.0f / 128) + EPS);
            g0 = g0 * r * *(const vf4*)wgq; g1 = g1 * r * *(const vf4*)(wgq + 64);
            const float rk = rsqrt_fast(red16(ssq8(x0, x1)) * (1.0f / 128) + EPS);
            if (rg < 2) { x0 = x0 * rk * *(const vf4*)wgk; x1 = x1 * rk * *(const vf4*)(wgk + 64); }
            if (!ctx) {
                const int pos = sub < 8 ? (t >> 6) : (t & 63), ai = pos * 32 + (c8 & 31);
                const vf4 c0 = *(const vf4*)(ropec + ai), c1 = *(const vf4*)(ropec + ai + 4), s0 = *(const vf4*)(ropes + ai), s1 = *(const vf4*)(ropes + ai + 4);
                const bool hi = (sub & 4) != 0;
                vf4 pg0, pg1, px0, px1;
#pragma unroll
                for (int j = 0; j < 4; ++j) { pg0[j] = __shfl_xor(g0[j], 4); pg1[j] = __shfl_xor(g1[j], 4); px0[j] = __shfl_xor(x0[j], 4); px1[j] = __shfl_xor(x1[j], 4); }
                g0 = hi ? pg0 * s0 + g0 * c0 : g0 * c0 - pg0 * s0; g1 = hi ? pg1 * s1 + g1 * c1 : g1 * c1 - pg1 * s1;
                if (rg < 2) { x0 = hi ? px0 * s0 + x0 * c0 : x0 * c0 - px0 * s0; x1 = hi ? px1 * s1 + x1 * c1 : x1 * c1 - px1 * s1; }
            }
            *(uint4*)(WSP(bf16_t, WS_GQ) + (size_t)m * 512 + ho) = pack8(g0, g1);
            *(uint4*)(WSP(bf16_t, rg < 2 ? WS_GK : WS_GV) + (size_t)m * 256 + (rg & 1) * 128 + c8) = pack8(x0, x1);
            if (ctx) {
                const size_t o = ((((size_t)b * DEPTH + l) * 2 + (rg & 1)) * CT + t) * 128 + c8;
                float* dst = p.out + (rg < 2 ? O_GK : O_GV) + o;
                *(vf4*)dst = x0; *(vf4*)(dst + 4) = x1;
            }
        }
        asm volatile("" ::: "memory");
        {
#pragma unroll
            for (int dir = 0; dir < 2; ++dir) {
                const float* up = sw + PL_UP + dir * 16 * 256 + 4 * lane;
                vf4 acc = *(const vf4*)(sw + PL_GB + dir * 256 + 4 * lane);
#pragma unroll
                for (int r4 = 0; r4 < 4; ++r4) {
                    const vf4 gv = unp4bf(rgz[dir][r4]);
                    acc += gv.x * *(const vf4*)(up + (4 * r4 + 0) * 256) + gv.y * *(const vf4*)(up + (4 * r4 + 1) * 256) + gv.z * *(const vf4*)(up + (4 * r4 + 2) * 256) + gv.w * *(const vf4*)(up + (4 * r4 + 3) * 256);
                }
                vf4 o;
#pragma unroll
                for (int j = 0; j < 4; ++j) o[j] = logsigmoid_fast(acc[j]) * (1.0f / 16.0f);
                *(vf4*)(WSP(float, dir ? WS_AB : WS_AF) + (size_t)m * 256 + 4 * lane) = o;
            }
        }
        asm volatile("" ::: "memory");
        {
#pragma unroll
            for (int part = 0; part < 3; ++part) {
                vf4 a0 = (vf4){0.f, 0.f, 0.f, 0.f}, a1 = a0;
#pragma unroll
                for (int j = 0; j < 5; ++j) {
                    const float* cj = cw + j * 1536 + part * 256;
                    vf4 z0, z1; unp8bf(rcz[part][j], z0, z1);
                    a0 += *(const vf4*)cj * z0; a1 += *(const vf4*)(cj + 768) * z1;
                }
#pragma unroll
                for (int j = 0; j < 4; ++j) { a0[j] = silu_fast(a0[j]); a1[j] = silu_fast(a1[j]); }
                if (part < 2) { const float r = rsqrt_fast(red16(ssq8(a0, a1)) + EPS) * (part == 0 ? 0.08838834764831845f : 1.0f); a0 *= r; a1 *= r; }
                *(uint4*)(WSP(bf16_t, part == 0 ? WS_DQ : part == 1 ? WS_DK : WS_DV) + (size_t)m * 512 + rg * 128 + c8) = pack8(a0, a1);
                asm volatile("" ::: "memory");
            }
            if (lane < 8) {
                const float beta = 1.0f / (1.0f + expf(-bf2f(z[Z_DB + lane])));
                const float g = -expf(p.in[I_ALOG][(size_t)l * 8 + lane]) * softplus_f(bf2f(z[Z_DA + lane]) + p.in[I_DTB][(size_t)l * 8 + lane]);
                float* ba = WSP(float, WS_DBA) + (size_t)m * 16;
                ba[lane] = beta; ba[8 + lane] = g;
            }
        }
    }
}

typedef float vf2 __attribute__((ext_vector_type(2)));
__device__ __forceinline__ float dpp_f(float v, const int ctrl) { return v; }
#define DPPF(v, ctrl) __int_as_float(__builtin_amdgcn_mov_dpp(__float_as_int(v), (ctrl), 0xF, 0xF, true))
__device__ __forceinline__ float red8(float v) { v += DPPF(v, 0xB1); v += DPPF(v, 0x4E); v += DPPF(v, 0x141); return v; }
__device__ __forceinline__ float red16(float v) { v = red8(v); v += DPPF(v, 0x140); return v; }

__device__ __forceinline__ void phase_post(const Params& p, int l) {
    const int tid = opaque_tid(), lane = tid & 63, wv = tid >> 6, rg = lane >> 4, c8 = (lane & 15) * 8;
    const bf16_t* Z = WSP(bf16_t, WS_Z); bf16_t* MRG = WSP(bf16_t, WS_MRG);
    const float* wgp = p.in[I_GLAON] + (size_t)l * 128 + c8; const float* wdp = p.in[I_GDNON] + (size_t)l * 128 + c8;
    const vf4 wg0 = *(const vf4*)wgp, wg1 = *(const vf4*)(wgp + 4), wd0 = *(const vf4*)wdp, wd1 = *(const vf4*)(wdp + 4);
    const int ho = rg * 128 + c8, nw = (int)gridDim.x * 8;
    for (int m0 = blockIdx.x * 8 + wv; m0 < M; m0 += 2 * nw) {
        const bool has1 = m0 + nw < M; const int mm[2] = {m0, has1 ? m0 + nw : m0};
        uint4 rf[2][2], rb[2][2], rz[2][2];
#pragma unroll
        for (int k = 0; k < 2; ++k)
#pragma unroll
            for (int g = 0; g < 2; ++g) {
                const size_t o = (size_t)mm[k] * 512 + ho;
                rf[k][g] = *(const uint4*)(WSP(bf16_t, g ? WS_DOF : WS_GOF) + o); rb[k][g] = *(const uint4*)(WSP(bf16_t, g ? WS_DOB : WS_GOB) + o);
                rz[k][g] = *(const uint4*)(Z + (size_t)mm[k] * NINP + (g ? Z_DZ : Z_GLR) + ho);
            }
        asm volatile("" ::: "memory");
#pragma unroll
        for (int k = 0; k < 2; ++k) {
            if (k == 1 && !has1) break;
#pragma unroll
            for (int g = 0; g < 2; ++g) {
                vf4 a0, a1, b0, b1, g0, g1; unp8bf(rf[k][g], a0, a1); unp8bf(rb[k][g], b0, b1); unp8bf(rz[k][g], g0, g1); a0 += b0; a1 += b1;
                const float r = rsqrt_fast(red16(ssq8(a0, a1)) * (1.0f / 128) + EPS);
                a0 = a0 * r * (g ? wd0 : wg0); a1 = a1 * r * (g ? wd1 : wg1);
#pragma unroll
                for (int j = 0; j < 4; ++j) { a0[j] *= silu_fast(g0[j]); a1[j] *= silu_fast(g1[j]); }
                *(uint4*)(MRG + (size_t)mm[k] * DM + (g ? 1536 : 512) + ho) = pack8(a0, a1);
            }
        }
    }
}
#define XB_TMO      128
#define XB_XCNT(j)  (256  + 64 * (j))
#define XB_XSUB(j)  (1280 + 64 * (j))
#define XB_XGEN(j)  (2304 + 64 * (j))
#define XB_TOP      3328
#define XB_TOPGEN   3392
#define XCD_BAR_WORDS 3456
#define XB_SPIN_CAP (1u << 22)
#define LAS __attribute__((address_space(3)))

__device__ __forceinline__ unsigned xb_ld(unsigned* p)              { return __hip_atomic_load(p, __ATOMIC_RELAXED, __HIP_MEMORY_SCOPE_AGENT); }
__device__ __forceinline__ unsigned xb_add(unsigned* p, unsigned v) { return __hip_atomic_fetch_add(p, v, __ATOMIC_RELAXED, __HIP_MEMORY_SCOPE_AGENT); }
__device__ __forceinline__ unsigned xb_xcc_id() { return (unsigned)__builtin_amdgcn_s_getreg((3 << 11) | 20) & 0xFu; }
#define XB_SPIN(cond, bar) do { unsigned _sp = 0; while (cond) { __builtin_amdgcn_s_sleep(1); \
    if ((++_sp & 255u) == 0u) { if (xb_ld(&(bar)[XB_TMO])) break; if (_sp > XB_SPIN_CAP) { atomicAdd(&(bar)[XB_TMO], 1u); break; } } } } while (0)

struct XcdBarrier {
    unsigned* bar; unsigned x;
    volatile LAS unsigned* st;
};

__device__ __forceinline__ XcdBarrier xcd_barrier_post(unsigned* bar, volatile LAS unsigned* st) {
    XcdBarrier b; b.bar = bar; b.x = xb_xcc_id(); b.st = st;
    if (threadIdx.x == 0) (void)xb_add(&bar[XB_XCNT(b.x)], 1u);
    return b;
}
__device__ __forceinline__ void xcd_barrier_complete(unsigned* bar, unsigned x, unsigned& nloc, unsigned& nx) {
    const unsigned G = gridDim.x * gridDim.y * gridDim.z;
    unsigned sum, cnt, mine, sp = 0u;
    for (;;) {
        sum = 0u; cnt = 0u; mine = 0u;
#pragma unroll
        for (unsigned j = 0; j < 16; ++j) { const unsigned c = xb_ld(&bar[XB_XCNT(j)]); sum += c; cnt += (c > 0u) ? 1u : 0u; mine = (j == x) ? c : mine; }
        if (sum == G) break;
        __builtin_amdgcn_s_sleep(1);
        if ((++sp & 255u) == 0u) { if (xb_ld(&bar[XB_TMO])) break; if (sp > XB_SPIN_CAP) { atomicAdd(&bar[XB_TMO], 1u); break; } }
    }
    nloc = mine > 0u ? mine : 1u; nx = cnt > 0u ? cnt : 1u;
}

__device__ __forceinline__ void xcd_barrier(const XcdBarrier& b) {
    asm volatile("s_waitcnt vmcnt(0)" ::: "memory");
    __syncthreads();
    if (threadIdx.x == 0) {
        unsigned* bar = b.bar;
        __builtin_amdgcn_s_waitcnt(0);
        unsigned nloc = b.st[0], nx = b.st[1];
        if (nloc == 0u) { xcd_barrier_complete(bar, b.x, nloc, nx); b.st[0] = nloc; b.st[1] = nx; }
        const unsigned old = xb_add(&bar[XB_XSUB(b.x)], 1u);
        const unsigned gen = old / nloc;
        if (old + 1u == (gen + 1u) * nloc) {
            __builtin_amdgcn_fence(__ATOMIC_RELEASE, "agent");
            asm volatile("s_waitcnt vmcnt(0)" ::: "memory");
            const unsigned og = xb_add(&bar[XB_TOP], 1u);
            const unsigned tg = og / nx;
            if (og + 1u == (tg + 1u) * nx) xb_add(&bar[XB_TOPGEN], 1u);
            else XB_SPIN(xb_ld(&bar[XB_TOPGEN]) == tg, bar);
            __builtin_amdgcn_fence(__ATOMIC_ACQUIRE, "agent");
            xb_add(&bar[XB_XGEN(b.x)], 1u);
            asm volatile("s_waitcnt vmcnt(0)" ::: "memory");
        } else {
            XB_SPIN(xb_ld(&bar[XB_XGEN(b.x)]) == gen, bar);
            __builtin_amdgcn_fence(__ATOMIC_ACQUIRE, "agent");
            asm volatile("s_waitcnt vmcnt(0)" ::: "memory");
        }
    }
    __syncthreads();
}

#ifndef NT_STORES
#define NT_STORES 0
#endif
namespace pg8 {
#define PG8_LAS __attribute__((address_space(3)))
typedef unsigned short bf16_t;
typedef short bf16x8 __attribute__((ext_vector_type(8)));
typedef float f32x4 __attribute__((ext_vector_type(4)));
typedef unsigned u32x4 __attribute__((ext_vector_type(4)));
typedef unsigned u32x2 __attribute__((ext_vector_type(2)));
typedef int v4i32 __attribute__((ext_vector_type(4)));
typedef int v8i32 __attribute__((ext_vector_type(8)));
constexpr int BM = 256, BK = 64, HALF = 128, HTB = HALF * BK * 2  , STAGE_BYTES = 8 * HTB, NXCD = 8, WGM = 8;

__host__ __device__ __forceinline__ int lds_byte(int r, int c) { const int st = (r >> 4) * 2 + (c >> 5), rr = r & 15, cc = c & 31, ob = rr * 64 + cc * 2; return st * 1024 + (ob ^ (((ob >> 9) & 1) << 5)); }
__host__ __device__ __forceinline__ void stage_rc(int b, int& R, int& C) { const int st = b / 1024, sb = b % 1024, swz = sb ^ (((sb >> 9) & 1) << 5); R = (st >> 1) * 16 + swz / 64; C = (st & 1) * 32 + (swz % 64) / 2; }
__host__ __device__ __forceinline__ int perm32(int rho) { const int n = rho >> 4, i = rho & 15; return 8 * (i >> 2) + 4 * n + (i & 3); }

struct Unit { int pm, pn, k0, nt, at, slot, msk; };
struct Gemm { const bf16_t* A; const bf16_t* Bt; int M, N, K; };

struct StaticOrder {
    int nM, nN, nwg, G, c, ntk, split, msplit;
    __host__ __device__ void init(int M, int N, int K, int G_, int c_, int split_ = 0) { nM = M / BM; nN = N / BM; nwg = nM * nN; G = G_; c = c_; ntk = K / BK; const int rem = nwg % G_; split = (split_ == 1 && rem > 0 && 2 * rem == G_ && ntk >= 8) ? 1 : 0; msplit = (split_ == 2 && rem > 0 && 2 * rem <= G_) ? 1 : 0; }
    __host__ __device__ bool next(int i, Unit& u) const {
        long L = (long)i * G + c; u.k0 = 0; u.nt = ntk; u.at = 0; u.slot = 0; u.msk = 3;
        if (msplit && i == nwg / G) { const int rem = nwg % G; if (c >= 2 * rem) return false; L = (long)i * G + (c % rem); u.msk = (c / rem) ? 2 : 1; }
        if (split && i == nwg / G) { const int rem = nwg % G, sl = c / rem, h0 = ((ntk / 2) + 1) & ~1; L = (long)i * G + (c % rem); u.k0 = sl ? h0 * BK : 0; u.nt = sl ? ntk - h0 : h0; u.at = sl ? 1 : 2; u.slot = c % rem; }
        if (L >= nwg) return false;
        int wgid = (int)L; { const int q = nwg / NXCD, r = nwg % NXCD, xcd = wgid % NXCD, off = wgid / NXCD; wgid = (xcd < r ? xcd * (q + 1) : r * (q + 1) + (xcd - r) * q) + off; }
        const int nig = WGM * nN, gid = wgid / nig, fm = gid * WGM, gsz = (nM - fm) < WGM ? (nM - fm) : WGM;
        u.pm = fm + ((wgid % nig) % gsz); u.pn = (wgid % nig) / gsz; return true;
    }
    __device__ __forceinline__ void a_ready(const Unit&) const {}
    __device__ __forceinline__ void done(const Unit&) const {}
};
__device__ __forceinline__ unsigned cvt_pk_bf16(float lo, float hi) { unsigned r; asm volatile("v_cvt_pk_bf16_f32 %0, %1, %2" : "=v"(r) : "v"(lo), "v"(hi)); return r; }
struct EpiF32 {
    static constexpr bool PERM = false, AFTER_DRAIN = false;
    float* C; int ldc; const float* bias;
    __device__ __forceinline__ void operator()(const f32x4 (&acc)[2][2][4][2], const Unit& u, int wr, int wc, int fr, int fq) const {
        const int row0 = u.pm * BM + wr * 64 + fr, col0 = u.pn * BM + wc * 32 + 4 * fq;
        f32x4 bv[2][2];
#pragma unroll
        for (int bj = 0; bj < 2; ++bj)
#pragma unroll
            for (int n = 0; n < 2; ++n) bv[bj][n] = bias ? *(const f32x4*)(bias + col0 + bj * HALF + n * 16) : (f32x4){0.f, 0.f, 0.f, 0.f};
#pragma unroll
        for (int ai = 0; ai < 2; ++ai)
#pragma unroll
            for (int m = 0; m < 4; ++m) { float* rowp = C + (size_t)(row0 + ai * HALF + m * 16) * ldc + col0;
#pragma unroll
                for (int bj = 0; bj < 2; ++bj)
#pragma unroll
                    for (int n = 0; n < 2; ++n) *(f32x4*)(rowp + bj * HALF + n * 16) = acc[ai][bj][m][n] + bv[bj][n]; }
    }
};

struct EpiSwiGLU {
    static constexpr bool PERM = true, AFTER_DRAIN = false;
    bf16_t* O; int ldc;
    __device__ __forceinline__ void operator()(const f32x4 (&acc)[2][2][4][2], const Unit& u, int wr, int wc, int fr, int fq) const {
        const int row0 = u.pm * BM + wr * 64 + fr, col0 = u.pn * 128 + wc * 32 + 8 * fq;
#pragma unroll
        for (int ai = 0; ai < 2; ++ai) if ((u.msk >> ai) & 1)
#pragma unroll
            for (int m = 0; m < 4; ++m) { bf16_t* rowp = O + (size_t)(row0 + ai * HALF + m * 16) * ldc + col0;
                const f32x4 g0 = acc[ai][0][m][0], g1 = acc[ai][0][m][1], u0 = acc[ai][1][m][0], u1 = acc[ai][1][m][1];
                float r[8];
#pragma unroll
                for (int j = 0; j < 4; ++j) {
                    r[j]     = g0[j] * __builtin_amdgcn_rcpf(1.0f + __builtin_amdgcn_exp2f(-1.4426950408889634f * g0[j])) * u0[j];
                    r[4 + j] = g1[j] * __builtin_amdgcn_rcpf(1.0f + __builtin_amdgcn_exp2f(-1.4426950408889634f * g1[j])) * u1[j]; }
                u32x4 w; w.x = cvt_pk_bf16(r[0], r[1]); w.y = cvt_pk_bf16(r[2], r[3]); w.z = cvt_pk_bf16(r[4], r[5]); w.w = cvt_pk_bf16(r[6], r[7]);
#if NT_STORES
                __builtin_nontemporal_store(w, (u32x4*)rowp);
#else
                *(u32x4*)rowp = w;
#endif
                }
    }
};
struct EpiSwiGLU8 {
    static constexpr bool PERM = true, AFTER_DRAIN = false;
    static constexpr int NST = 4; static constexpr bool NST_PER_HALF = true;
    unsigned char* O; int ldc; float wscale;
    __device__ __forceinline__ void operator()(const f32x4 (&acc)[2][2][4][2], const Unit& u, int wr, int wc, int fr, int fq) const {
        const int row0 = u.pm * BM + wr * 64 + fr, col0 = u.pn * 128 + wc * 32 + 8 * fq;
#pragma unroll
        for (int ai = 0; ai < 2; ++ai) if ((u.msk >> ai) & 1)
#pragma unroll
            for (int m = 0; m < 4; ++m) { unsigned char* rowp = O + (size_t)(row0 + ai * HALF + m * 16) * ldc + col0;
                f32x4 g0 = acc[ai][0][m][0], g1 = acc[ai][0][m][1], u0 = acc[ai][1][m][0], u1 = acc[ai][1][m][1];
                asm volatile("" : "+v"(g0), "+v"(g1), "+v"(u0), "+v"(u1));
                g0 *= wscale; g1 *= wscale; u0 *= wscale; u1 *= wscale;
                float r[8];
#pragma unroll
                for (int j = 0; j < 4; ++j) {
                    r[j]     = g0[j] * __builtin_amdgcn_rcpf(1.0f + __builtin_amdgcn_exp2f(-1.4426950408889634f * g0[j])) * u0[j];
                    r[4 + j] = g1[j] * __builtin_amdgcn_rcpf(1.0f + __builtin_amdgcn_exp2f(-1.4426950408889634f * g1[j])) * u1[j]; }
                uint2 w; w.x = pack4_fp8(r[0], r[1], r[2], r[3]); w.y = pack4_fp8(r[4], r[5], r[6], r[7]);
                *(uint2*)rowp = w; asm volatile("" ::: "memory"); }
    }
};
struct EpiBf16Plain {
    static constexpr bool PERM = true, AFTER_DRAIN = false;
    static constexpr int NST = 8; static constexpr bool NST_PER_HALF = true;
    bf16_t* O; int ldc; float coef;
    __device__ __forceinline__ void operator()(const f32x4 (&acc)[2][2][4][2], const Unit& u, int wr, int wc, int fr, int fq) const {
        const int row0 = u.pm * BM + wr * 64 + fr, col0 = u.pn * BM + wc * 32 + 8 * fq;
#pragma unroll
        for (int ai = 0; ai < 2; ++ai) if ((u.msk >> ai) & 1)
#pragma unroll
            for (int m = 0; m < 4; ++m) { bf16_t* rowp = O + (size_t)(row0 + ai * HALF + m * 16) * ldc + col0;
#pragma unroll
                for (int bj = 0; bj < 2; ++bj) { const f32x4 v0 = acc[ai][bj][m][0] * coef, v1 = acc[ai][bj][m][1] * coef;
                    u32x4 w; w.x = pack2(v0[0], v0[1]); w.y = pack2(v0[2], v0[3]); w.z = pack2(v1[0], v1[1]); w.w = pack2(v1[2], v1[3]);
                    *(u32x4*)(rowp + bj * HALF) = w; } }
    }
};
struct EpiResid {
    static constexpr bool PERM = false, AFTER_DRAIN = false;
    static constexpr int NST = 16; static constexpr bool NST_PER_HALF = false;
    const float* res; float* out; int ldc; const float* gate0; float coef;
    float* slab; unsigned* flags; unsigned target;
    const float* res_hi; int row_hi;
    int res_bf16, out_bf16;
    __device__ __forceinline__ void operator()(const f32x4 (&acc)[2][2][4][2], const Unit& u, int wr, int wc, int fr, int fq) const {
        const int tidx = ((wr * 4 + wc) * 4 + fq) * 16 + fr;
        if (u.at == 1) {
            const __amdgpu_buffer_rsrc_t rs = __builtin_amdgcn_make_buffer_rsrc((void*)slab, 0, 0x7FFFFFF0, 0x00020000);
            const unsigned base = ((unsigned)u.slot * 32u * 512u + (unsigned)tidx) * 16u;
#pragma unroll
            for (int ai = 0; ai < 2; ++ai)
#pragma unroll
                for (int bj = 0; bj < 2; ++bj)
#pragma unroll
                    for (int m = 0; m < 4; ++m)
#pragma unroll
                        for (int n = 0; n < 2; ++n) { const f32x4 v = acc[ai][bj][m][n]; u32x4 w; w.x = __float_as_uint(v[0]); w.y = __float_as_uint(v[1]); w.z = __float_as_uint(v[2]); w.w = __float_as_uint(v[3]);
                            __builtin_amdgcn_raw_buffer_store_b128(w, rs, base + (unsigned)((((ai * 2 + bj) * 4 + m) * 2 + n) * 512 * 16), 0, 16); }
            asm volatile("s_waitcnt vmcnt(0)" ::: "memory");
            if ((tidx & 63) == 0) __hip_atomic_fetch_add(flags + 64 * u.slot, 1u, __ATOMIC_RELAXED, __HIP_MEMORY_SCOPE_AGENT);
            return;
        }
        const float* part = nullptr;
        if (u.at == 2) {
            unsigned spins = 0;
            while (__hip_atomic_load(flags + 64 * u.slot, __ATOMIC_RELAXED, __HIP_MEMORY_SCOPE_AGENT) < target) { __builtin_amdgcn_s_sleep(2); if (++spins > (1u << 22)) break; }
            __builtin_amdgcn_fence(__ATOMIC_ACQUIRE, "agent");
            asm volatile("s_waitcnt vmcnt(0)" ::: "memory");
            part = slab + ((size_t)u.slot * 32 * 512 + tidx) * 4;
        }
        const int row0 = u.pm * BM + wr * 64 + fr, col0 = u.pn * BM + wc * 32 + 4 * fq;
        const float* gate = gate0 + (size_t)cond_of_row(u.pm * BM) * NMOD;
        const float* rbase = (u.pm * BM >= row_hi) ? res_hi - (size_t)row_hi * ldc : res;
        f32x4 gv[2][2];
#pragma unroll
        for (int bj = 0; bj < 2; ++bj)
#pragma unroll
            for (int n = 0; n < 2; ++n) gv[bj][n] = *(const f32x4*)(gate + col0 + bj * HALF + n * 16) * coef;
#pragma unroll
        for (int ai = 0; ai < 2; ++ai) if ((u.msk >> ai) & 1) {
            f32x4 bs[4][2][2];
#pragma unroll
            for (int m = 0; m < 4; ++m) { const size_t off = (size_t)(row0 + ai * HALF + m * 16) * ldc + col0;
#pragma unroll
                for (int bj = 0; bj < 2; ++bj)
#pragma unroll
                    for (int n = 0; n < 2; ++n) {
                        const size_t eo = off + bj * HALF + n * 16;
                        if (res_bf16) { const u32x2 w = *(const u32x2*)((const bf16_t*)rbase + eo); bs[m][bj][n][0] = __uint_as_float(w.x << 16); bs[m][bj][n][1] = __uint_as_float(w.x & 0xFFFF0000u); bs[m][bj][n][2] = __uint_as_float(w.y << 16); bs[m][bj][n][3] = __uint_as_float(w.y & 0xFFFF0000u); }
                        else bs[m][bj][n] = *(const f32x4*)(rbase + eo); } }
            asm volatile("" ::: "memory");
#pragma unroll
            for (int m = 0; m < 4; ++m) { const size_t off = (size_t)(row0 + ai * HALF + m * 16) * ldc + col0;
#pragma unroll
                for (int bj = 0; bj < 2; ++bj)
#pragma unroll
                    for (int n = 0; n < 2; ++n) {
                        f32x4 a = acc[ai][bj][m][n];
                        if (part) a += *(const f32x4*)(part + (size_t)((((ai * 2 + bj) * 4 + m) * 2 + n) * 512 * 4));
                        const size_t eo = off + bj * HALF + n * 16;
                        const f32x4 o = bs[m][bj][n] + gv[bj][n] * a;
                        if (out_bf16) { u32x2 w; w.x = cvt_pk_bf16(o[0], o[1]); w.y = cvt_pk_bf16(o[2], o[3]); *(u32x2*)((bf16_t*)out + eo) = w; }
                        else *(f32x4*)(out + eo) = o; } }
            asm volatile("" ::: "memory"); }
    }
};
template <class Epi, class Sched, bool STAMP = false, int FP8 = 0, bool GUARD = true, bool PRESTAGE = false>
__device__ __forceinline__ void gemm_phase(PG8_LAS unsigned char* lds, const Gemm g, const Sched& S, const Epi& E, unsigned long long* stamps) {
    const int tid = opaque_tid(), wid = __builtin_amdgcn_readfirstlane(tid >> 6), lane = tid & 63, wr = wid >> 2, wc = wid & 3, fr = lane & 15, fq = lane >> 4;
    const int K = g.K;
    int ts_lo = 0, ts_hi = 0, nts = 0; const unsigned long long rt_entry = STAMP ? (unsigned long long)wall_clock64() : 0ull;
#define PG8_STAMP() do { if (STAMP && wid == 0 && nts < 64) { const unsigned long long _c = (unsigned long long)clock64(); \
        ts_lo = (lane == nts) ? (int)(unsigned)_c : ts_lo; ts_hi = (lane == nts) ? (int)(unsigned)(_c >> 32) : ts_hi; ++nts; } } while (0)
    PG8_STAMP();
    unsigned voffA[2], voffB[2];
#pragma unroll
    for (int i = 0; i < 2; ++i) { int R, C; stage_rc(tid * 16 + i * 8192, R, C); const int Rb = Epi::PERM ? ((R & ~31) + perm32(R & 31)) : R;
        voffA[i] = (unsigned)(R * K + C) * 2u; voffB[i] = (unsigned)(Rb * K + C) * 2u; }
    const size_t kstep = (size_t)(BK * 2);
    const size_t hstep = (size_t)HALF * K * 2;
    const size_t tstep = 2 * hstep;
    const unsigned ldsw = (unsigned)wid * 1024u;
    const int aoff = lds_byte(wr * 64 + fr, fq * 8), boff = lds_byte(wc * 32 + fr, fq * 8);
#define PG8_SA(b, h) (((b) * 2 + (h)) * HTB)
#define PG8_SB(b, h) ((4 + (b) * 2 + (h)) * HTB)
#define PG8_STAGE(bufoff, gbase, voff) do { _Pragma("unroll") for (int _i = 0; _i < 2; ++_i) \
        __builtin_amdgcn_global_load_lds((const unsigned*)((const char*)(gbase) + (voff)[_i]), (PG8_LAS unsigned*)(lds + (bufoff) + ldsw + _i * 8192), 16, 0, 0); } while (0)
#define PG8_LDA(dst, b, h) do { _Pragma("unroll") for (int m = 0; m < 4; ++m) dst[m] = __builtin_shufflevector(*(const PG8_LAS v4i32*)(lds + PG8_SA(b, h) + aoff + m * 2048), *(const PG8_LAS v4i32*)(lds + PG8_SA(b, h) + aoff + m * 2048 + 1024), 0, 1, 2, 3, 4, 5, 6, 7); } while (0)
#define PG8_LDB(dst, b, h) do { _Pragma("unroll") for (int n = 0; n < 2; ++n) dst[n] = __builtin_shufflevector(*(const PG8_LAS v4i32*)(lds + PG8_SB(b, h) + boff + n * 2048), *(const PG8_LAS v4i32*)(lds + PG8_SB(b, h) + boff + n * 2048 + 1024), 0, 1, 2, 3, 4, 5, 6, 7); } while (0)
#define PG8_HALF(v, k) __builtin_bit_cast(bf16x8, __builtin_shufflevector(v, v, 4 * (k), 4 * (k) + 1, 4 * (k) + 2, 4 * (k) + 3))
#define PG8_MMA(ai, bj, At, Bt) do { __builtin_amdgcn_s_setprio(1); _Pragma("unroll") for (int m = 0; m < 4; ++m) _Pragma("unroll") for (int n = 0; n < 2; ++n) { \
        acc[ai][bj][m][n] = __builtin_amdgcn_mfma_f32_16x16x32_bf16(PG8_HALF(Bt[n], 0), PG8_HALF(At[m], 0), acc[ai][bj][m][n], 0, 0, 0); \
        acc[ai][bj][m][n] = __builtin_amdgcn_mfma_f32_16x16x32_bf16(PG8_HALF(Bt[n], 1), PG8_HALF(At[m], 1), acc[ai][bj][m][n], 0, 0, 0); } __builtin_amdgcn_s_setprio(0); } while (0)
#define PG8_MMA8(ai, bj, At, Bt) do { __builtin_amdgcn_s_setprio(1); _Pragma("unroll") for (int m = 0; m < 4; ++m) _Pragma("unroll") for (int n = 0; n < 2; ++n) \
        acc[ai][bj][m][n] = __builtin_amdgcn_mfma_scale_f32_16x16x128_f8f6f4(Bt[n], At[m], acc[ai][bj][m][n], 0, 0, 0, 127, 0, 127); __builtin_amdgcn_s_setprio(0); } while (0)
#define PG8_Q64(v, q) __builtin_bit_cast(long, __builtin_shufflevector(v, v, 2 * (q), 2 * (q) + 1))
#define PG8_M8L1(ai, bj, m, n, q) acc[ai][bj][m][n] = __builtin_amdgcn_mfma_f32_16x16x32_fp8_fp8(PG8_Q64(Bt_[n], q), PG8_Q64(At_[m], q), acc[ai][bj][m][n], 0, 0, 0)
#define PG8_MMA8L(ai, bj, At, Bt) do { auto& At_ = At; auto& Bt_ = Bt; __builtin_amdgcn_s_setprio(1); _Pragma("unroll") for (int m = 0; m < 4; ++m) _Pragma("unroll") for (int n = 0; n < 2; ++n) { \
        PG8_M8L1(ai, bj, m, n, 0); PG8_M8L1(ai, bj, m, n, 1); PG8_M8L1(ai, bj, m, n, 2); PG8_M8L1(ai, bj, m, n, 3); } __builtin_amdgcn_s_setprio(0); } while (0)
#define PG8_MMAG(ai, bj, At, Bt) do { if (!GUARD || (mrow & (1 << (ai)))) { if constexpr (FP8 == 1) PG8_MMA8(ai, bj, At, Bt); else if constexpr (FP8 == 2) PG8_MMA8L(ai, bj, At, Bt); else PG8_MMA(ai, bj, At, Bt); } } while (0)
#define PG8_WAIT_V(n) asm volatile("s_waitcnt vmcnt(" #n ")" ::: "memory")
#define PG8_WAIT_L(n) asm volatile("s_waitcnt lgkmcnt(" #n ")" ::: "memory")
#define PG8_BAR __builtin_amdgcn_s_barrier()
#define PG8_SCHED __builtin_amdgcn_sched_barrier(0)
    Unit cur, nxt; int ui = 0;
    if (!S.next(0, cur)) return;
    __builtin_amdgcn_s_waitcnt(0x0F70);
    f32x4 acc[2][2][4][2];
#pragma unroll
    for (int a = 0; a < 2; ++a)
#pragma unroll
        for (int b = 0; b < 2; ++b)
#pragma unroll
            for (int m = 0; m < 4; ++m)
#pragma unroll
                for (int n = 0; n < 2; ++n) acc[a][b][m][n] = (f32x4){0.f, 0.f, 0.f, 0.f};
    v8i32 At[4], B0[2], B1[2];
    const char* cA = (const char*)g.A + (size_t)cur.pm * tstep + (size_t)cur.k0 * 2; const char* cB = (const char*)g.Bt + (size_t)cur.pn * tstep + (size_t)cur.k0 * 2;
    S.a_ready(cur);
    PG8_STAGE(PG8_SB(0, 0), cB, voffB); PG8_STAGE(PG8_SA(0, 0), cA, voffA); PG8_STAGE(PG8_SB(0, 1), cB + hstep, voffB); PG8_STAGE(PG8_SA(0, 1), cA + hstep, voffA);
    if (wr == 1) PG8_BAR;
    PG8_WAIT_V(4); PG8_BAR;
    PG8_STAGE(PG8_SB(1, 0), cB + kstep, voffB); PG8_STAGE(PG8_SA(1, 0), cA + kstep, voffA); PG8_STAGE(PG8_SB(1, 1), cB + hstep + kstep, voffB);
    PG8_WAIT_V(6); PG8_BAR;
    PG8_STAMP();
    int pre_msk = 0;
    for (;;) {
        const bool has_next = S.next(ui + 1, nxt);
        const char* nA = has_next ? (const char*)g.A + (size_t)nxt.pm * tstep + (size_t)nxt.k0 * 2 : cA; const char* nB = has_next ? (const char*)g.Bt + (size_t)nxt.pn * tstep + (size_t)nxt.k0 * 2 : cB;
        const int nt = cur.nt, mrow = cur.msk;
        for (int t = 0; t < nt; t += 2) {
            const bool pre0 = PRESTAGE && pre_msk != 0 && t == 0;
            const bool last = (t == nt - 2);
            const char* a1 = cA + (size_t)(t + 1) * kstep;
            const char* a2 = last ? nA : cA + (size_t)(t + 2) * kstep; const char* b2 = last ? nB : cB + (size_t)(t + 2) * kstep;
            const char* a3 = a2 + kstep; const char* b3 = b2 + kstep;
            if (last && has_next) S.a_ready(nxt);
            PG8_LDB(B0, 0, 0); PG8_SCHED; PG8_LDA(At, 0, 0); if (!pre0) PG8_STAGE(PG8_SA(1, 1), a1 + hstep, voffA);
            PG8_WAIT_L(8); PG8_BAR; PG8_WAIT_L(0); PG8_MMAG(0, 0, At, B0); PG8_BAR; PG8_SCHED;
            PG8_LDB(B1, 0, 1); PG8_STAGE(PG8_SB(0, 0), b2, voffB);
            PG8_BAR; PG8_WAIT_L(0); PG8_MMAG(0, 1, At, B1); PG8_BAR;
            PG8_LDA(At, 0, 1); PG8_STAGE(PG8_SA(0, 0), a2, voffA);
            PG8_BAR; PG8_WAIT_L(0); PG8_MMAG(1, 0, At, B0); PG8_BAR; PG8_SCHED;
            PG8_STAGE(PG8_SB(0, 1), b2 + hstep, voffB);
            if constexpr (PRESTAGE) {
                if (pre0) { if (Epi::NST_PER_HALF && pre_msk == 3) asm volatile("s_waitcnt vmcnt(%0)" :: "n"(6 + 2 * Epi::NST) : "memory"); else asm volatile("s_waitcnt vmcnt(%0)" :: "n"(6 + Epi::NST) : "memory"); }
                else PG8_WAIT_V(6);
            } else PG8_WAIT_V(6);
            PG8_BAR; PG8_MMAG(1, 1, At, B1); PG8_BAR;
            PG8_LDB(B0, 1, 0); PG8_SCHED; PG8_LDA(At, 1, 0); PG8_STAGE(PG8_SA(0, 1), a2 + hstep, voffA);
            PG8_WAIT_L(8); PG8_BAR; PG8_WAIT_L(0); PG8_MMAG(0, 0, At, B0); PG8_BAR; PG8_SCHED;
            PG8_LDB(B1, 1, 1); PG8_STAGE(PG8_SB(1, 0), b3, voffB);
            PG8_BAR; PG8_WAIT_L(0); PG8_MMAG(0, 1, At, B1); PG8_BAR;
            PG8_LDA(At, 1, 1); PG8_STAGE(PG8_SA(1, 0), a3, voffA);
            PG8_BAR; PG8_WAIT_L(0); PG8_MMAG(1, 0, At, B0); PG8_BAR; PG8_SCHED;
            PG8_STAGE(PG8_SB(1, 1), b3 + hstep, voffB);
            PG8_WAIT_V(6); PG8_BAR; PG8_MMAG(1, 1, At, B1); PG8_BAR;
        }
        PG8_STAMP();
        if constexpr (PRESTAGE) { pre_msk = 0; if (has_next) { PG8_STAGE(PG8_SA(1, 1), nA + kstep + hstep, voffA); pre_msk = cur.msk; } }
        if constexpr (!Epi::AFTER_DRAIN) { E(acc, cur, wr, wc, fr, fq); S.done(cur); }
        PG8_STAMP();
        if (!has_next) break;
#pragma unroll
        for (int a = 0; a < 2; ++a)
#pragma unroll
            for (int b = 0; b < 2; ++b)
#pragma unroll
                for (int m = 0; m < 4; ++m)
#pragma unroll
                    for (int n = 0; n < 2; ++n) acc[a][b][m][n] = (f32x4){0.f, 0.f, 0.f, 0.f};
        cur = nxt; cA = nA; cB = nB; ++ui;
    }
    PG8_WAIT_V(0);
    if (wr == 0) PG8_BAR;
    PG8_BAR;
    if constexpr (Epi::AFTER_DRAIN) { E.fused(acc, cur, wr, wc, fr, fq, lds, wid, lane); S.done(cur); }
    PG8_STAMP();
    if (STAMP && wid == 0) { stamps[lane] = lane < nts ? (((unsigned long long)(unsigned)ts_hi << 32) | (unsigned)ts_lo) : 0ull;
        if (lane == 62) stamps[62] = rt_entry; if (lane == 63) stamps[63] = (unsigned long long)wall_clock64(); }
#undef PG8_STAMP
#undef PG8_SA
#undef PG8_SB
#undef PG8_STAGE
#undef PG8_LDA
#undef PG8_LDB
#undef PG8_HALF
#undef PG8_MMA
#undef PG8_MMA8
#undef PG8_MMA8L
#undef PG8_M8L1
#undef PG8_Q64
#undef PG8_MMAG
#undef PG8_WAIT_V
#undef PG8_WAIT_L
#undef PG8_BAR
#undef PG8_SCHED
}
}
#ifndef ATT_INLINE
#define ATT_INLINE __forceinline__
#endif
namespace att {
constexpr int D = 128, NW = 8, QBLK = 32, KVBLK = 64, LDQ = 512, LDO = DM;
constexpr float SCALE = 0.088388347648318440f;
constexpr float THR = 8.f;
constexpr size_t SHM_V = KVBLK * D * 2, SHM_K = KVBLK * D * 2, SHM_Q = 256 * D * 2, SHM_ATTN = 2 * SHM_V + 2 * SHM_K + NW * 64 * 4 + SHM_Q;
using bf16x8 = __attribute__((ext_vector_type(8))) short;
using s16x4  = __attribute__((ext_vector_type(4))) short;
using f32x16 = __attribute__((ext_vector_type(16))) float;
using u32x4  = __attribute__((ext_vector_type(4))) unsigned;
#define KSWZ(row, colB) ((row) * 256 + ((colB) ^ (((row) & 7) << 4)))
#define SBAR() __builtin_amdgcn_sched_barrier(0)
__device__ __forceinline__ int crow(int r, int hi) { return (r & 3) + 8 * (r >> 2) + 4 * hi; }
__device__ __forceinline__ unsigned cvtpk(float lo, float hi) { unsigned r; asm volatile("v_cvt_pk_bf16_f32 %0, %1, %2" : "=v"(r) : "v"(lo), "v"(hi)); return r; }

__device__ __forceinline__ void partialSM(f32x16& p0, f32x16& p1, float& m_reg, float& mn, float& alpha) {
  constexpr float C = SCALE * 1.4426950408889634f;
  float pmax = p0[0]; for (int r = 1; r < 16; ++r) pmax = fmaxf(pmax, p0[r]); for (int r = 0; r < 16; ++r) pmax = fmaxf(pmax, p1[r]);
  { auto rr = __builtin_amdgcn_permlane32_swap(__float_as_uint(pmax), __float_as_uint(pmax), false, false);
    pmax = fmaxf(__uint_as_float(rr[0]), __uint_as_float(rr[1])); }
  if (__builtin_expect(__all(pmax - m_reg <= THR / SCALE), 1)) { mn = m_reg; alpha = 1.f; }
  else { mn = fmaxf(m_reg, pmax); alpha = __builtin_amdgcn_exp2f((m_reg - mn) * C); m_reg = mn; }
  float mnC = -mn * C;
  for (int r = 0; r < 16; ++r) p0[r] = fmaf(p0[r], C, mnC); for (int r = 0; r < 16; ++r) p1[r] = fmaf(p1[r], C, mnC);
  for (int r = 0; r < 16; ++r) p0[r] = __builtin_amdgcn_exp2f(p0[r]);
}
__device__ __forceinline__ void finishSM(f32x16& p0, f32x16& p1, float alpha, float& l_reg, bf16x8& pa0, bf16x8& pa1, bf16x8& pa2, bf16x8& pa3) {
  for (int r = 0; r < 16; ++r) p1[r] = __builtin_amdgcn_exp2f(p1[r]);
  float ps = 0; for (int r = 0; r < 16; ++r) ps += p0[r]; for (int r = 0; r < 16; ++r) ps += p1[r];
  { auto rr = __builtin_amdgcn_permlane32_swap(__float_as_uint(ps), __float_as_uint(ps), false, false);
    ps = __uint_as_float(rr[0]) + __uint_as_float(rr[1]); }
  l_reg = l_reg * alpha + ps;
#define PK4(P, BASE, OUT) do { unsigned a0 = cvtpk(P[BASE + 0], P[BASE + 1]), a1 = cvtpk(P[BASE + 2], P[BASE + 3]);   \
    unsigned b0 = cvtpk(P[BASE + 4], P[BASE + 5]), b1 = cvtpk(P[BASE + 6], P[BASE + 7]);                              \
    auto r0 = __builtin_amdgcn_permlane32_swap(a0, b0, false, false); auto r1 = __builtin_amdgcn_permlane32_swap(a1, b1, false, false); \
    u32x4 w = {r0[0], r1[0], r0[1], r1[1]}; OUT = *reinterpret_cast<bf16x8*>(&w); } while (0)
  PK4(p0, 0, pa0); PK4(p0, 8, pa1); PK4(p1, 0, pa2); PK4(p1, 8, pa3);
#undef PK4
}
__device__ __forceinline__ void qkt(f32x16& p0, f32x16& p1, const bf16_t* Ks, const bf16_t* Qs, int qrow, int r32, int hi) {
  p0 = f32x16{}; p1 = f32x16{};
#pragma unroll
  for (int d0 = 0; d0 < 8; ++d0) { int cb = (d0 * 16 + hi * 8) * 2;
    bf16x8 q = *reinterpret_cast<const bf16x8*>((const char*)Qs + KSWZ(qrow, cb));
    bf16x8 b0 = *reinterpret_cast<const bf16x8*>((const char*)Ks + KSWZ(r32, cb));
    bf16x8 b1 = *reinterpret_cast<const bf16x8*>((const char*)Ks + KSWZ(32 + r32, cb));
    p0 = __builtin_amdgcn_mfma_f32_32x32x16_bf16(b0, q, p0, 0, 0, 0);
    p1 = __builtin_amdgcn_mfma_f32_32x32x16_bf16(b1, q, p1, 0, 0, 0); }
}
__device__ __forceinline__ int v_st(int k, int c) { const int kk = (k & ~0xC) | ((k & 4) << 1) | ((k & 8) >> 1); return ((kk >> 3) * 4 + (c >> 5)) * 512 + ((kk & 7) * 32 + (c & 31)) * 2; }
__device__ __forceinline__ int v_rd_base(int lane) { return ((lane & 3) << 3) | (((lane >> 2) & 3) << 6) | (((lane >> 4) & 1) << 5) | (((lane >> 5) & 1) << 8); }
constexpr int v_rd_off(int d0, int ks, int half) { return d0 * 512 + ks * 4096 + half * 2048; }
template <int OFF> __device__ __forceinline__ s16x4 tr_read(int vb) {
  s16x4 r; asm volatile("ds_read_b64_tr_b16 %0, %1 offset:%2" : "=&v"(r) : "v"(vb), "i"(OFF) : "memory"); return r;
}
template <int D0> __device__ __forceinline__ void pv_one(f32x16& od, int vb, bf16x8 pa0, bf16x8 pa1, bf16x8 pa2, bf16x8 pa3) {
  const s16x4 l0 = tr_read<v_rd_off(D0, 0, 0)>(vb), h0 = tr_read<v_rd_off(D0, 0, 1)>(vb), l1 = tr_read<v_rd_off(D0, 1, 0)>(vb), h1 = tr_read<v_rd_off(D0, 1, 1)>(vb);
  const s16x4 l2 = tr_read<v_rd_off(D0, 2, 0)>(vb), h2 = tr_read<v_rd_off(D0, 2, 1)>(vb), l3 = tr_read<v_rd_off(D0, 3, 0)>(vb), h3 = tr_read<v_rd_off(D0, 3, 1)>(vb);
  asm volatile("s_waitcnt lgkmcnt(0)" ::: "memory"); SBAR();
#define PK(L, H) (bf16x8){L[0], L[1], L[2], L[3], H[0], H[1], H[2], H[3]}
  od = __builtin_amdgcn_mfma_f32_32x32x16_bf16(pa0, PK(l0, h0), od, 0, 0, 0);
  od = __builtin_amdgcn_mfma_f32_32x32x16_bf16(pa1, PK(l1, h1), od, 0, 0, 0);
  od = __builtin_amdgcn_mfma_f32_32x32x16_bf16(pa2, PK(l2, h2), od, 0, 0, 0);
  od = __builtin_amdgcn_mfma_f32_32x32x16_bf16(pa3, PK(l3, h3), od, 0, 0, 0);
#undef PK
}
__device__ __forceinline__ void pv_d0(f32x16* o, int vb, bf16x8 pa0, bf16x8 pa1, bf16x8 pa2, bf16x8 pa3) {
  pv_one<0>(o[0], vb, pa0, pa1, pa2, pa3); pv_one<1>(o[1], vb, pa0, pa1, pa2, pa3); pv_one<2>(o[2], vb, pa0, pa1, pa2, pa3); pv_one<3>(o[3], vb, pa0, pa1, pa2, pa3);
}

struct SrcOne { const bf16_t* k0; const bf16_t* v0; int ldk;
  __device__ __forceinline__ const bf16_t* k(int j) const { return k0 + (size_t)j * 64 * ldk; }
  __device__ __forceinline__ const bf16_t* v(int j) const { return v0 + (size_t)j * 64 * ldk; } };
struct SrcTwo { const bf16_t* ck; const bf16_t* cv; const bf16_t* k1; const bf16_t* v1; int ldk;
  __device__ __forceinline__ const bf16_t* k(int j) const { return j < 4 ? ck + (size_t)j * 64 * ldk : k1 + (size_t)(j - 4) * 64 * ldk; }
  __device__ __forceinline__ const bf16_t* v(int j) const { return j < 4 ? cv + (size_t)j * 64 * ldk : v1 + (size_t)(j - 4) * 64 * ldk; } };
struct NoBias { __device__ __forceinline__ void operator()(f32x16&, f32x16&, int, int, int, int) const {} };
struct NaBias { const float* tab; int i0, kr0;
  __device__ __forceinline__ void operator()(f32x16& p0, f32x16& p1, int jt, int wid, int r32, int hi) const {
    if (jt < 4) return;
    const int qi = i0 + wid * QBLK + r32, r = qi >> 6, qc = qi & 63, kr = kr0 + jt - 4;
    int lo = r - 4; lo = lo < 0 ? 0 : (lo > 8 ? 8 : lo);
    const bool rowok = (kr >= lo) && (kr < lo + 8);
    if (!rowok) {
#pragma unroll
      for (int rr = 0; rr < 16; ++rr) { p0[rr] = -1e30f; p1[rr] = -1e30f; }
      return;
    }
    int c0 = qc - 8; c0 = c0 < 0 ? 0 : (c0 > 48 ? 48 : c0);
    const int dr = kr - r + 7;
    const float* tb = tab + dr * 31 + (4 * hi - qc + 15);
    const int w0 = 4 * hi - c0;
#pragma unroll
    for (int g = 0; g < 4; ++g) {
#pragma unroll
      for (int q = 0; q < 4; ++q) {
        const int rr = 4 * g + q, kc0 = q + 8 * g;
        const float t0 = tb[kc0], t1 = tb[kc0 + 32];
        p0[rr] = ((unsigned)(kc0 + w0) < 16u) ? p0[rr] + t0 : -1e30f;
        p1[rr] = ((unsigned)(kc0 + 32 + w0) < 16u) ? p1[rr] + t1 : -1e30f;
      }
      SBAR();
    }
  } };

template <int SD, class Src, class Bias>
__device__ ATT_INLINE void attn_body(const bf16_t* __restrict__ Qb, const Src src, bf16_t* __restrict__ Ob, const int NT, char* lds, const Bias bias) {
  const int tid = opaque_tid(), wid = tid >> 6, lane = tid & 63, r32 = lane & 31, hi = lane >> 5;
  const int LDK = src.ldk;
  bf16_t* V_lds = (bf16_t*)lds; bf16_t* K_lds = (bf16_t*)(lds + 2 * SHM_V);
  float* ws = (float*)(lds + 2 * SHM_V + 2 * SHM_K) + wid * 64; float* li_l = ws; float* al_l = ws + 32;
  float m_reg = -1e30f, l_reg = 0; f32x16 o[4] = {};
  bf16_t* Q_lds = (bf16_t*)(lds + 2 * SHM_V + 2 * SHM_K + NW * 64 * 4);
  const int qrow = wid * QBLK + r32;
  {
    bf16x8 qv[8];
#pragma unroll
    for (int i = 0; i < 8; ++i) { const int f = tid + 512 * i, row = f >> 4, c8 = (f & 15) * 8; qv[i] = *reinterpret_cast<const bf16x8*>(Qb + (long)row * LDQ + c8); }
#pragma unroll
    for (int i = 0; i < 8; ++i) { const int f = tid + 512 * i, row = f >> 4, c8 = (f & 15) * 8; *(bf16x8*)((char*)Q_lds + KSWZ(row, c8 * 2)) = qv[i]; }
  }
  const int sr = tid >> 4, sc = (tid & 15) * 8, vst0 = v_st(sr, sc), vst1 = v_st(32 + sr, sc);
  const int vb0 = (int)(uintptr_t)V_lds + v_rd_base(lane);
  struct { bf16x8 vs0, vs1, ks0, ks1; } sr_[SD];
#define SLOAD(i, jt) do { const bf16_t* kt_ = src.k(jt); const bf16_t* vt_ = src.v(jt); \
    sr_[i].vs0 = *reinterpret_cast<const bf16x8*>(&vt_[(long)sr * LDK + sc]); sr_[i].vs1 = *reinterpret_cast<const bf16x8*>(&vt_[(long)(32 + sr) * LDK + sc]); \
    sr_[i].ks0 = *reinterpret_cast<const bf16x8*>(&kt_[(long)sr * LDK + sc]); sr_[i].ks1 = *reinterpret_cast<const bf16x8*>(&kt_[(long)(32 + sr) * LDK + sc]); } while (0)
#define SWRITE(b, i) do { *(bf16x8*)((char*)V_lds + (b) * SHM_V + vst0) = sr_[i].vs0;          \
    *(bf16x8*)((char*)V_lds + (b) * SHM_V + vst1) = sr_[i].vs1; int kc = sc * 2;               \
    *(bf16x8*)((char*)K_lds + (b) * SHM_K + KSWZ(sr, kc)) = sr_[i].ks0;                       \
    *(bf16x8*)((char*)K_lds + (b) * SHM_K + KSWZ(32 + sr, kc)) = sr_[i].ks1; } while (0)
#define SWAIT() do { if constexpr (SD == 2) asm volatile("s_waitcnt vmcnt(4)" ::: "memory"); else asm volatile("s_waitcnt vmcnt(0)" ::: "memory"); } while (0)
#define RESC(a) do { if (__any((a) < 1.f)) { if (hi == 0) al_l[r32] = (a); asm volatile("s_waitcnt lgkmcnt(0)" ::: "memory"); \
    for (int d = 0; d < 4; ++d) for (int r = 0; r < 16; ++r) o[d][r] *= al_l[crow(r, hi)]; } } while (0)
  f32x16 pA0, pA1, pB0, pB1; float mnA, mnB, alA, alB; bf16x8 pa0, pa1, pa2, pa3;
  constexpr int SE = 0, SO = SD - 1;
  SLOAD(SE, 0); asm volatile("s_waitcnt vmcnt(0)" ::: "memory"); SWRITE(0, SE); __syncthreads();
  qkt(pA0, pA1, K_lds, Q_lds, qrow, r32, hi); bias(pA0, pA1, 0, wid, r32, hi); partialSM(pA0, pA1, m_reg, mnA, alA);
  SLOAD(SO, 1); if constexpr (SD == 2) { if (2 < NT) SLOAD(SE, 2); }
  SWAIT(); SWRITE(1, SO); __syncthreads();
  for (int j = 1; j + 1 < NT; j += 2) {
    SBAR(); qkt(pB0, pB1, (bf16_t*)((char*)K_lds + SHM_K), Q_lds, qrow, r32, hi); bias(pB0, pB1, j, wid, r32, hi);
    finishSM(pA0, pA1, alA, l_reg, pa0, pa1, pa2, pa3); SBAR();
    SLOAD(SO, j + SD); SBAR();
    pv_d0(o, vb0, pa0, pa1, pa2, pa3); partialSM(pB0, pB1, m_reg, mnB, alB);
    __syncthreads(); SWAIT(); SWRITE(0, SE);
    RESC(alB); __syncthreads();
    SBAR(); qkt(pA0, pA1, K_lds, Q_lds, qrow, r32, hi); bias(pA0, pA1, j + 1, wid, r32, hi);
    finishSM(pB0, pB1, alB, l_reg, pa0, pa1, pa2, pa3); SBAR();
    if (SD == 1 || j + 3 < NT) SLOAD(SE, j + 1 + SD); SBAR();
    pv_d0(o, vb0 + (int)SHM_V, pa0, pa1, pa2, pa3); partialSM(pA0, pA1, m_reg, mnA, alA);
    __syncthreads(); SWAIT(); SWRITE(1, SO);
    RESC(alA); __syncthreads();
  }
  SBAR(); qkt(pB0, pB1, (bf16_t*)((char*)K_lds + SHM_K), Q_lds, qrow, r32, hi); bias(pB0, pB1, NT - 1, wid, r32, hi);
  finishSM(pA0, pA1, alA, l_reg, pa0, pa1, pa2, pa3); SBAR();
  pv_d0(o, vb0, pa0, pa1, pa2, pa3); partialSM(pB0, pB1, m_reg, mnB, alB);
  __syncthreads(); RESC(alB);
  finishSM(pB0, pB1, alB, l_reg, pa0, pa1, pa2, pa3); SBAR();
  pv_d0(o, vb0 + (int)SHM_V, pa0, pa1, pa2, pa3);
  if (hi == 0) li_l[r32] = l_reg; asm volatile("s_waitcnt lgkmcnt(0)" ::: "memory");
  float rli[16];
#pragma unroll
  for (int r = 0; r < 16; ++r) rli[r] = __builtin_amdgcn_rcpf(li_l[crow(r, hi)]);
  bf16_t* Ow = Ob + (long)(wid * QBLK) * LDO;
#pragma unroll
  for (int r = 0; r < 16; ++r) { int orow = crow(r, hi);
    for (int d0 = 0; d0 < 4; ++d0) Ow[(long)orow * LDO + d0 * 32 + r32] = f2bf(o[d0][r] * rli[r]); }
#undef SLOAD
#undef SWRITE
#undef SWAIT
#undef RESC
}
}
#define H16(w, j) ((bf16_t)(((j) & 1) ? ((j) < 2 ? (w).x >> 16 : (w).y >> 16) : ((j) < 2 ? (w).x & 0xFFFFu : (w).y & 0xFFFFu)))
#define DPPU(v, ctrl, rmask) __int_as_float(__builtin_amdgcn_update_dpp(0, __float_as_int(v), (ctrl), (rmask), 0xF, false))
__device__ __forceinline__ float scan32(float x) { x += DPPU(x, 0x111, 0xF); x += DPPU(x, 0x112, 0xF); x += DPPU(x, 0x114, 0xF); x += DPPU(x, 0x118, 0xF); x += DPPU(x, 0x142, 0xA); return x; }
__device__ __forceinline__ float last32(float x, int lane) { const float a = __int_as_float(__builtin_amdgcn_readlane(__float_as_int(x), 31)), b = __int_as_float(__builtin_amdgcn_readlane(__float_as_int(x), 63)); return lane < 32 ? a : b; }
namespace gdn {
using att::bf16x8; using att::f32x16; using att::crow;
constexpr int C = 32, SK = 136, SS = 40;
constexpr int OFF_KT = 0, OFF_QT = OFF_KT + C * SK * 2, OFF_W = OFF_QT + C * SK * 2, OFF_KTT = OFF_W + C * SK * 2, OFF_VTT = OFF_KTT + 128 * SS * 2,
              OFF_VN = OFF_VTT + 128 * SS * 2, OFF_VNS = OFF_VN + 128 * SS * 2, OFF_ST = OFF_VNS + 128 * SS * 2, OFF_TB = OFF_ST + 128 * SK * 2,
              OFF_TBE = OFF_TB + C * SS * 2, OFF_ATT = OFF_TBE + C * SS * 2, OFF_L = OFF_ATT + C * SS * 2, OFF_SC = OFF_L + C * C * 4, GDN_LDS = OFF_SC + 1024;
template <int K>
__device__ __forceinline__ f32x16 mm(const bf16_t* A, int lda, const bf16_t* Bt, int ldb, int l32, int hi, f32x16 acc) {
#pragma unroll
    for (int k0 = 0; k0 < K; k0 += 16) {
        const bf16x8 a = *reinterpret_cast<const bf16x8*>(A + l32 * lda + k0 + 8 * hi);
        const bf16x8 b = *reinterpret_cast<const bf16x8*>(Bt + l32 * ldb + k0 + 8 * hi);
        acc = __builtin_amdgcn_mfma_f32_32x32x16_bf16(a, b, acc, 0, 0, 0);
    }
    return acc;
}
__device__ __forceinline__ uint2 pk4(float a, float b, float c, float d) { uint2 w; w.x = pack2(a, b); w.y = pack2(c, d); return w; }

__device__ __forceinline__ void gdn_chunked(const Params& p, int l, bool ctx, int b, int h, int dir, unsigned char* lds) {
    const int tid = opaque_tid(), wid = tid >> 6, lane = tid & 63, l32 = lane & 31, hi = lane >> 5;
    const int T = ctx ? CT : ::LT; const size_t m0 = ctx ? (size_t)b * CT : (size_t)MC + (size_t)b * ::LT;
    const bf16_t* DQ = WSP(bf16_t, WS_DQ); const bf16_t* DK = WSP(bf16_t, WS_DK); const bf16_t* DV = WSP(bf16_t, WS_DV); const float* DBA = WSP(float, WS_DBA);
    bf16_t* O = WSP(bf16_t, dir ? WS_DOB : WS_DOF);
    bf16_t* Kt = (bf16_t*)(lds + OFF_KT); bf16_t* Qt = (bf16_t*)(lds + OFF_QT); bf16_t* W = (bf16_t*)(lds + OFF_W); bf16_t* KT = (bf16_t*)(lds + OFF_KTT); bf16_t* VT = (bf16_t*)(lds + OFF_VTT);
    bf16_t* VN = (bf16_t*)(lds + OFF_VN); bf16_t* VNS = (bf16_t*)(lds + OFF_VNS); bf16_t* ST = (bf16_t*)(lds + OFF_ST); bf16_t* TB = (bf16_t*)(lds + OFF_TB); bf16_t* TBE = (bf16_t*)(lds + OFF_TBE);
    bf16_t* ATT = (bf16_t*)(lds + OFF_ATT); float* Lm = (float*)(lds + OFF_L); float* sc = (float*)(lds + OFF_SC);
    const int nch = T / C;
#define TOK(c, s_) (m0 + (dir ? T - 1 - ((c) * C + (s_)) : (c) * C + (s_)))
    f32x16 S[2];
#pragma unroll
    for (int bi = 0; bi < 2; ++bi) {
        const int blk = wid * 2 + bi, d0 = 32 * (blk >> 2), e0 = 32 * (blk & 3);
        if (ctx) { S[bi] = f32x16{}; }
        else {
            const float* s0 = p.in[I_SGDN] + ((((size_t)b * DEPTH + l) * 2 + dir) * 4 + h) * 128 * 128 + e0 + l32;
#pragma unroll
            for (int r = 0; r < 16; ++r) S[bi][r] = s0[(size_t)(d0 + crow(r, hi)) * 128];
        }
    }
    const int ts = tid & 31, c0 = (tid >> 5) * 4, c1 = 64 + c0;
    uint2 rq0, rq1, rk0, rk1, rv0, rv1; float pbeta = 0.f, pg = 0.f;
#define GLOAD(c) do { const size_t mt_ = TOK(c, ts); \
        rq0 = *(const uint2*)(DQ + mt_ * 512 + h * 128 + c0); rq1 = *(const uint2*)(DQ + mt_ * 512 + h * 128 + c1); \
        rk0 = *(const uint2*)(DK + mt_ * 512 + h * 128 + c0); rk1 = *(const uint2*)(DK + mt_ * 512 + h * 128 + c1); \
        rv0 = *(const uint2*)(DV + mt_ * 512 + h * 128 + c0); rv1 = *(const uint2*)(DV + mt_ * 512 + h * 128 + c1); \
        if (tid < C) { const size_t mt = TOK(c, tid); pbeta = DBA[mt * 16 + dir * 4 + h]; pg = DBA[mt * 16 + 8 + dir * 4 + h]; } } while (0)
#define GSTAGE() do { \
        *(uint2*)(Kt + ts * SK + c0) = rk0; *(uint2*)(Kt + ts * SK + c1) = rk1; \
        *(uint2*)(Qt + ts * SK + c0) = rq0; *(uint2*)(Qt + ts * SK + c1) = rq1; \
        _Pragma("unroll") for (int j = 0; j < 4; ++j) { KT[(c0 + j) * SS + ts] = H16(rk0, j); KT[(c1 + j) * SS + ts] = H16(rk1, j); \
                                                        VT[(c0 + j) * SS + ts] = H16(rv0, j); VT[(c1 + j) * SS + ts] = H16(rv1, j); } \
        if (wid == 0) { float x = pg; _Pragma("unroll") for (int o_ = 1; o_ < 32; o_ <<= 1) { const float y = __shfl_up(x, o_); if (lane >= o_) x += y; } \
            const float Bt_ = __shfl(x, 31); if (lane < C) { sc[lane] = pbeta; sc[32 + lane] = x; sc[64 + lane] = __expf(x); sc[96 + lane] = __expf(Bt_ - x); if (lane == 0) sc[128] = __expf(Bt_); } } } while (0)
    __syncthreads();
    GLOAD(0);
#pragma unroll
    for (int bi = 0; bi < 2; ++bi) {
        const int blk = wid * 2 + bi, d0 = 32 * (blk >> 2), e0 = 32 * (blk & 3);
#pragma unroll
        for (int g = 0; g < 4; ++g) *(uint2*)(ST + (e0 + l32) * SK + d0 + 8 * g + 4 * hi) = pk4(S[bi][4 * g], S[bi][4 * g + 1], S[bi][4 * g + 2], S[bi][4 * g + 3]);
    }
    GSTAGE();
    __syncthreads();
    for (int c = 0; c < nch; ++c) {
        if (c + 1 < nch) GLOAD(c + 1);
        f32x16 acc1 = f32x16{};
        if (wid == 0) {
            const f32x16 kk = mm<128>(Kt, SK, Kt, SK, l32, hi, f32x16{});
            const float bi_ = sc[32 + l32], be = sc[l32];
#pragma unroll
            for (int r = 0; r < 16; ++r) { const int j = crow(r, hi); const float v = (l32 > j) ? be * kk[r] * __expf(bi_ - sc[32 + j]) : 0.f;
                Lm[l32 * 32 + ((((r & 3) + 4 * hi) ^ (l32 & 7)) * 4) + (r >> 2)] = v; }
        } else if (wid == 1) {
            const f32x16 kq = mm<128>(Kt, SK, Qt, SK, l32, hi, f32x16{});
            const float bi_ = sc[32 + l32];
            float a[16];
#pragma unroll
            for (int r = 0; r < 16; ++r) { const int j = crow(r, hi); a[r] = (l32 >= j) ? kq[r] * __expf(bi_ - sc[32 + j]) : 0.f; }
#pragma unroll
            for (int g = 0; g < 4; ++g) *(uint2*)(ATT + l32 * SS + 8 * g + 4 * hi) = pk4(a[4 * g], a[4 * g + 1], a[4 * g + 2], a[4 * g + 3]);
        } else if (wid >= 4) {
            acc1 = mm<128>(Qt, SK, ST + (32 * (wid - 4)) * SK, SK, l32, hi, f32x16{});
#pragma unroll
            for (int r = 0; r < 16; ++r) acc1[r] *= sc[64 + crow(r, hi)];
        }
        __syncthreads();
        if (tid < 256) {
            const int cc = tid >> 3, part = tid & 7;
            float Tr[4] = {0.f, 0.f, 0.f, 0.f};
#pragma unroll
            for (int i = 0; i < 32; ++i) {
                const vf4 lv = *(const vf4*)(Lm + i * 32 + ((part ^ (i & 7)) * 4));
                float s = lv.x * Tr[0] + lv.y * Tr[1] + lv.z * Tr[2] + lv.w * Tr[3];
                s = red8(s);
                const float t = (i == cc ? 1.f : 0.f) - s;
                if (part == (i & 7)) Tr[i >> 3] = t;
            }
            const float bc = sc[cc], bec = bc * sc[64 + cc];
#pragma unroll
            for (int jj = 0; jj < 4; ++jj) { TB[(part + 8 * jj) * SS + cc] = f2bf(Tr[jj] * bc); TBE[(part + 8 * jj) * SS + cc] = f2bf(Tr[jj] * bec); }
        }
        __syncthreads();
        if (wid < 4) {
            acc1 = mm<32>(TB, SS, VT + (32 * wid) * SS, SS, l32, hi, f32x16{});
        } else {
            const int d0 = 32 * (wid - 4);
            const f32x16 wt = mm<32>(KT + d0 * SS, SS, TBE, SS, l32, hi, f32x16{});
#pragma unroll
            for (int g = 0; g < 4; ++g) *(uint2*)(W + l32 * SK + d0 + 8 * g + 4 * hi) = pk4(wt[4 * g], wt[4 * g + 1], wt[4 * g + 2], wt[4 * g + 3]);
        }
        __syncthreads();
        if (wid < 4) {
            const int e0 = 32 * wid;
            const f32x16 ws = mm<128>(W, SK, ST + e0 * SK, SK, l32, hi, f32x16{});
            float vn[16], vs[16];
#pragma unroll
            for (int r = 0; r < 16; ++r) { vn[r] = acc1[r] - ws[r]; vs[r] = vn[r] * sc[96 + crow(r, hi)]; }
#pragma unroll
            for (int g = 0; g < 4; ++g) { *(uint2*)(VN + (e0 + l32) * SS + 8 * g + 4 * hi) = pk4(vn[4 * g], vn[4 * g + 1], vn[4 * g + 2], vn[4 * g + 3]);
                                          *(uint2*)(VNS + (e0 + l32) * SS + 8 * g + 4 * hi) = pk4(vs[4 * g], vs[4 * g + 1], vs[4 * g + 2], vs[4 * g + 3]); }
        }
        __syncthreads();
        if (wid >= 4) {
            const int e0 = 32 * (wid - 4);
            acc1 = mm<32>(ATT, SS, VN + e0 * SS, SS, l32, hi, acc1);
#pragma unroll
            for (int r = 0; r < 16; ++r) O[TOK(c, crow(r, hi)) * 512 + h * 128 + e0 + l32] = f2bf(acc1[r]);
        }
        {
            const float eB = sc[128];
#pragma unroll
            for (int bi = 0; bi < 2; ++bi) {
                const int blk = wid * 2 + bi, d0 = 32 * (blk >> 2), e0 = 32 * (blk & 3);
#pragma unroll
                for (int r = 0; r < 16; ++r) S[bi][r] *= eB;
                S[bi] = mm<32>(KT + d0 * SS, SS, VNS + e0 * SS, SS, l32, hi, S[bi]);
            }
        }
        __syncthreads();
#pragma unroll
        for (int bi = 0; bi < 2; ++bi) {
            const int blk = wid * 2 + bi, d0 = 32 * (blk >> 2), e0 = 32 * (blk & 3);
#pragma unroll
            for (int g = 0; g < 4; ++g) *(uint2*)(ST + (e0 + l32) * SK + d0 + 8 * g + 4 * hi) = pk4(S[bi][4 * g], S[bi][4 * g + 1], S[bi][4 * g + 2], S[bi][4 * g + 3]);
        }
        if (c + 1 < nch) GSTAGE();
        __syncthreads();
    }
#undef GLOAD
#undef GSTAGE
#undef TOK
    if (ctx) {
#pragma unroll
        for (int bi = 0; bi < 2; ++bi) {
            const int blk = wid * 2 + bi, d0 = 32 * (blk >> 2), e0 = 32 * (blk & 3);
            float* so = p.out + O_SGDN + ((((size_t)b * DEPTH + l) * 2 + dir) * 4 + h) * 128 * 128 + e0 + l32;
#pragma unroll
            for (int r = 0; r < 16; ++r) so[(size_t)(d0 + crow(r, hi)) * 128] = S[bi][r];
        }
    }
}
}

namespace gla {
using att::bf16x8; using att::f32x16; using att::crow; using gdn::mm; using gdn::pk4;
constexpr int C = 32, SQ = 72, SS = 40;
constexpr int OFF_QE = 0, OFF_KN = OFF_QE + C * SQ * 2, OFF_KET = OFF_KN + C * SQ * 2, OFF_VT = OFF_KET + 64 * SS * 2, OFF_ATT = OFF_VT + 128 * SS * 2, OFF_ST = OFF_ATT + C * SS * 2,
              OFF_LA = OFF_ST + 128 * SQ * 2, OFF_EB = OFF_LA + C * 64 * 4, GLA_LDS = OFF_EB + 256;
__device__ __forceinline__ void gla_chunked(const Params& p, int l, bool ctx, int b, int h, int dir, unsigned char* lds) {
    const int tid = opaque_tid(), wid = tid >> 6, lane = tid & 63, l32 = lane & 31, hi = lane >> 5;
    const int T = ctx ? CT : ::LT; const size_t m0 = ctx ? (size_t)b * CT : (size_t)MC + (size_t)b * ::LT;
    const bf16_t* Z = WSP(bf16_t, WS_Z); const float* LA = WSP(float, dir ? WS_AB : WS_AF);
    bf16_t* O = WSP(bf16_t, dir ? WS_GOB : WS_GOF);
    bf16_t* Qe = (bf16_t*)(lds + OFF_QE); bf16_t* Kn = (bf16_t*)(lds + OFF_KN); bf16_t* KeT = (bf16_t*)(lds + OFF_KET); bf16_t* VT = (bf16_t*)(lds + OFF_VT);
    bf16_t* ATT = (bf16_t*)(lds + OFF_ATT); bf16_t* ST = (bf16_t*)(lds + OFF_ST); float* eB = (float*)(lds + OFF_EB);
    const int nch = T / C;
#define TOK(c, s_) (m0 + (dir ? T - 1 - ((c) * C + (s_)) : (c) * C + (s_)))
    const int d0 = 32 * (wid >> 2), e0 = 32 * (wid & 3);
    f32x16 S;
    if (ctx) S = f32x16{};
    else {
        const float* s0 = p.in[I_SGLA] + ((((size_t)b * DEPTH + l) * 2 + dir) * 4 + h) * 64 * 128 + e0 + l32;
#pragma unroll
        for (int r = 0; r < 16; ++r) S[r] = s0[(size_t)(d0 + crow(r, hi)) * 128];
    }
    const int ts = tid & 31, dc = (tid >> 5) * 4, vc0 = dc, vc1 = 64 + dc;
    uint2 rq, rk, rv0, rv1; vf4 pl;
#define GLOAD(c) do { const size_t mt = TOK(c, ts); \
        rq = *(const uint2*)(Z + mt * NINP + Z_GLQ + h * 64 + dc); rk = *(const uint2*)(Z + mt * NINP + Z_GLK + h * 64 + dc); pl = *(const vf4*)(LA + mt * 256 + h * 64 + dc); \
        rv0 = *(const uint2*)(Z + mt * NINP + Z_GLV + h * 128 + vc0); rv1 = *(const uint2*)(Z + mt * NINP + Z_GLV + h * 128 + vc1); } while (0)
#define WRITE_ST() do { _Pragma("unroll") for (int g = 0; g < 4; ++g) *(uint2*)(ST + (e0 + l32) * SQ + d0 + 8 * g + 4 * hi) = pk4(S[4 * g], S[4 * g + 1], S[4 * g + 2], S[4 * g + 3]); } while (0)
#define GIMAGES() do { vf4 pre, tot; const vf4 pq = unp4bf(rq), pk = unp4bf(rk); \
        _Pragma("unroll") for (int j = 0; j < 4; ++j) { pre[j] = scan32(pl[j]); tot[j] = last32(pre[j], lane); } \
        float qe[4], kn[4]; \
        _Pragma("unroll") for (int j = 0; j < 4; ++j) { qe[j] = pq[j] * 0.125f * __expf(pre[j]); kn[j] = pk[j] * __expf(fminf(-pre[j], 80.f)); \
            KeT[(dc + j) * SS + ts] = f2bf(pk[j] * __expf(tot[j] - pre[j])); } \
        *(uint2*)(Qe + ts * SQ + dc) = pk4(qe[0], qe[1], qe[2], qe[3]); *(uint2*)(Kn + ts * SQ + dc) = pk4(kn[0], kn[1], kn[2], kn[3]); \
        if (ts == 0) { _Pragma("unroll") for (int j = 0; j < 4; ++j) eB[dc + j] = __expf(tot[j]); } \
        _Pragma("unroll") for (int j = 0; j < 4; ++j) { VT[(vc0 + j) * SS + ts] = H16(rv0, j); VT[(vc1 + j) * SS + ts] = H16(rv1, j); } } while (0)
    __syncthreads();
    GLOAD(0);
    WRITE_ST();
    GIMAGES();
    __syncthreads();
    for (int c = 0; c < nch; ++c) {
        if (c + 1 < nch) GLOAD(c + 1);
        f32x16 o1 = f32x16{};
        if (wid == 0) {
            const f32x16 kq = mm<64>(Kn, SQ, Qe, SQ, l32, hi, f32x16{});
            float a[16];
#pragma unroll
            for (int r = 0; r < 16; ++r) a[r] = (l32 >= crow(r, hi)) ? kq[r] : 0.f;
#pragma unroll
            for (int g = 0; g < 4; ++g) *(uint2*)(ATT + l32 * SS + 8 * g + 4 * hi) = pk4(a[4 * g], a[4 * g + 1], a[4 * g + 2], a[4 * g + 3]);
        } else if (wid >= 4) {
            o1 = mm<64>(Qe, SQ, ST + (32 * (wid - 4)) * SQ, SQ, l32, hi, f32x16{});
        }
        __syncthreads();
        if (wid >= 4) {
            const int eo = 32 * (wid - 4);
            o1 = mm<32>(ATT, SS, VT + eo * SS, SS, l32, hi, o1);
#pragma unroll
            for (int r = 0; r < 16; ++r) O[TOK(c, crow(r, hi)) * 512 + h * 128 + eo + l32] = f2bf(o1[r]);
        }
#pragma unroll
        for (int r = 0; r < 16; ++r) S[r] *= eB[d0 + crow(r, hi)];
        S = mm<32>(KeT + d0 * SS, SS, VT + e0 * SS, SS, l32, hi, S);
        __syncthreads();
        WRITE_ST();
        if (c + 1 < nch) GIMAGES();
#ifdef GLA_DUP_IMAGES
        __syncthreads(); if (c + 1 < nch) GIMAGES();
#endif
        __syncthreads();
    }
#undef GLOAD
#undef WRITE_ST
#undef GIMAGES
#undef TOK
    if (ctx) {
        float* so = p.out + O_SGLA + ((((size_t)b * DEPTH + l) * 2 + dir) * 4 + h) * 64 * 128 + e0 + l32;
#pragma unroll
        for (int r = 0; r < 16; ++r) so[(size_t)(d0 + crow(r, hi)) * 128] = S[r];
    }
}
}
#define LAS __attribute__((address_space(3)))
constexpr int LDS_BYTES = 147456, XBW_OFF = LDS_BYTES - 64;
constexpr int NPH = 1 + DEPTH * 12;
#ifndef DBG_NLAYERS
#define DBG_NLAYERS DEPTH
#endif

#ifndef DUPKIND
#define DUPKIND 0
#endif
#ifndef MIXMASK
#define MIXMASK 0xFF
#endif
#define FOR_ITEMS(it, n, o, w) for (int bo_ = (o) * (int)gridDim.x / 256, bw_ = ((w) * (int)gridDim.x / 256) > 0 ? ((w) * (int)gridDim.x / 256) : 1, \
                                    it = ((int)blockIdx.x >= bo_ && (int)blockIdx.x < bo_ + bw_) ? (int)blockIdx.x - bo_ : (n); it < (n); it += bw_)

#ifndef TF1_PCT
#define TF1_PCT 25
#endif
constexpr int TF0 = NT_L / 10, TF1 = NT_L * TF1_PCT / 100, TF2 = NT_L * 53 / 100, TF3 = NT_L * 88 / 100, MIXCONV_CH = CONV_U, NI_CONV = (TF3 - TF2 + MIXCONV_CH - 1) / MIXCONV_CH;
#ifndef SPLITK
#define SPLITK 0
#endif
#ifndef SPLITK_G4
#define SPLITK_G4 0
#endif
constexpr int FLAG_WORD0 = 8192;
constexpr int QCTR_WORD0 = 1024;
constexpr int NI_GDNL = LB * 8, NI_GLAL = LB * 8, NI_GDNC = CB * 8, NI_GQAL = LB * 16, NI_NAL = LB * 16, NI_GLAC = CB * 8, NI_NAC = CB * 4, NI_GQAC = CB * 4;
#define KM(k) (1 + ((DUPKIND >> (k)) & 1))
constexpr int Q0 = NI_GDNL * KM(0), Q1 = Q0 + NI_GQAL * KM(1), Q2 = Q1 + NI_NAL * KM(2), Q3 = Q2 + NI_GLAL * KM(3), Q4 = Q3 + NI_GDNC * KM(4), Q5 = Q4 + NI_NAC * KM(5), Q6 = Q5 + NI_GQAC * KM(6), Q7 = Q6 + NI_GLAC * KM(7);
__device__ __forceinline__ void phase_mix(const Params& p, int l, unsigned char* lds, int rep) {
    const int tid = opaque_tid();
    float* smem = (float*)lds;
    const bf16_t* NAQ = WSP(bf16_t, WS_NAQ); const bf16_t* NAK = WSP(bf16_t, WS_NAK); const bf16_t* NAV = WSP(bf16_t, WS_NAV);
    const bf16_t* GQ = WSP(bf16_t, WS_GQ); const bf16_t* GK = WSP(bf16_t, WS_GK); const bf16_t* GV = WSP(bf16_t, WS_GV);
    bf16_t* MRG = WSP(bf16_t, WS_MRG);
    unsigned* qctr = WSP(unsigned, WS_CTL) + QCTR_WORD0 + 64 * l + 16 * rep;
    volatile int* qslot = (volatile int*)(lds + XBW_OFF + 16);
    for (;;) {
        __syncthreads();
        if (tid == 0) *qslot = (int)__hip_atomic_fetch_add(qctr, 1u, __ATOMIC_RELAXED, __HIP_MEMORY_SCOPE_AGENT);
        __syncthreads();
        const int q = __builtin_amdgcn_readfirstlane(*qslot);
        if (q >= Q7 + ((CONV_FILLER && l + 1 < DBG_NLAYERS) ? NI_CONV : 0)) break;
        if (q < Q0) { const int it = q % NI_GDNL; gdn::gdn_chunked(p, l, false, it / 8, (it / 2) % 4, it % 2, lds); }
        else if (q < Q1) {
            const int it = (q - Q0) % NI_GQAL, b = it / 16, qh = (it / 4) % 4, qb = it % 4, kvh = qh >> 1;
            const size_t r0 = (size_t)MC + (size_t)b * LT;
            att::SrcTwo src{WSP(bf16_t, WS_CGK) + ((size_t)b * DEPTH + l) * 256 * 256 + kvh * 128, WSP(bf16_t, WS_CGV) + ((size_t)b * DEPTH + l) * 256 * 256 + kvh * 128,
                            GK + r0 * 256 + kvh * 128, GV + r0 * 256 + kvh * 128, 256};
            att::attn_body<2>(GQ + (r0 + qb * 256) * 512 + qh * 128, src, MRG + (r0 + qb * 256) * DM + 1024 + qh * 128, 4 + LT / 64, (char*)lds, att::NoBias{});
        }
        else if (q < Q2) {
            const int it = (q - Q1) % NI_NAL, b = it / 16, h = (it / 4) % 4, qb = it % 4;
            const int kr0 = qb == 0 ? 0 : qb == 1 ? 0 : qb == 2 ? 4 : 8, nrows = (qb == 0 || qb == 3) ? 8 : 12;
            const size_t r0 = (size_t)MC + (size_t)b * LT;
            float* tab = (float*)(lds + att::SHM_ATTN);
            if (tid < 15 * 31) tab[tid] = p.in[I_RPB][((size_t)l * 4 + h) * 15 * 31 + tid] * (1.0f / att::SCALE);
            att::SrcTwo src{WSP(bf16_t, WS_CNAK) + ((size_t)b * DEPTH + l) * 256 * 512 + h * 128, WSP(bf16_t, WS_CNAV) + ((size_t)b * DEPTH + l) * 256 * 512 + h * 128,
                            NAK + (r0 + kr0 * 64) * 512 + h * 128, NAV + (r0 + kr0 * 64) * 512 + h * 128, 512};
            att::attn_body<1>(NAQ + (r0 + qb * 256) * 512 + h * 128, src, MRG + (r0 + qb * 256) * DM + 0 + h * 128, 4 + nrows, (char*)lds, att::NaBias{tab, qb * 256, kr0});
        }
        else if (q < Q3) { const int it = (q - Q2) % NI_GLAL;
#ifdef GLA_REP
            for (int r_ = 0, n_ = opaque_int(GLA_REP); r_ < n_; ++r_)
#endif
            gla::gla_chunked(p, l, false, it / 8, (it / 2) % 4, it % 2, lds); }
        else if (q < Q4) { const int it = (q - Q3) % NI_GDNC; gdn::gdn_chunked(p, l, true, it / 8, (it / 2) % 4, it % 2, lds); }
        else if (q < Q5) {
            const int it = (q - Q4) % NI_NAC, b = it / 4, h = it % 4; const size_t r0 = (size_t)b * CT;
            att::SrcOne src{NAK + r0 * 512 + h * 128, NAV + r0 * 512 + h * 128, 512};
            att::attn_body<2>(NAQ + r0 * 512 + h * 128, src, MRG + r0 * DM + 0 + h * 128, CT / 64, (char*)lds, att::NoBias{});
        }
        else if (q < Q6) {
            const int it = (q - Q5) % NI_GQAC, b = it / 4, qh = it % 4, kvh = qh >> 1; const size_t r0 = (size_t)b * CT;
            att::SrcOne src{GK + r0 * 256 + kvh * 128, GV + r0 * 256 + kvh * 128, 256};
            att::attn_body<2>(GQ + r0 * 512 + qh * 128, src, MRG + r0 * DM + 1024 + qh * 128, CT / 64, (char*)lds, att::NoBias{});
        }
        else if (q < Q7) { const int it = (q - Q6) % NI_GLAC; gla::gla_chunked(p, l, true, it / 8, (it / 2) % 4, it % 2, lds); }
        else { const int t0 = TF2 + (q - Q7) * MIXCONV_CH, t1 = t0 + MIXCONV_CH < TF3 ? t0 + MIXCONV_CH : TF3; conv_layer_tiles(p, l + 1, t0, t1, 0, 1, (float*)lds); }
    }
}

#define CONV_FILL(nunits, t0, t1, skip) do { if (l + 1 < DBG_NLAYERS) { const int G_ = (int)gridDim.x; int f0_ = ((nunits) % G_) + (skip); if (f0_ >= G_) f0_ = 0; \
        if ((int)blockIdx.x >= f0_) { const Params q = opaque_params(p); conv_layer_tiles(q, l + 1, (t0), (t1), (int)blockIdx.x - f0_, G_ - f0_, (float*)lds); } } } while (0)
#define G1A_MSPLIT (G1A_MODE == 1 ? 2 : 0)
#define G1B_MSPLIT (G1B_MODE == 1 ? 2 : 0)
#ifndef PRESTAGE_ON
#define PRESTAGE_ON false
#endif
#ifndef PRESTAGE_G4
#define PRESTAGE_G4 false
#endif
#ifndef PRESTAGE_RS
#define PRESTAGE_RS true
#endif
#ifndef PRESTAGE_F8
#define PRESTAGE_F8 true
#endif
#ifndef MSPLIT
#define MSPLIT 2
#endif
static_assert(att::SHM_ATTN + 15 * 31 * 4 + 2048 <= (size_t)XBW_OFF, "LDS map");
static_assert((QCTR_WORD0 + 64 * DEPTH) < 4096, "ctl");
constexpr int BAR_WORD0 = 4096;
static_assert((BAR_WORD0 + XCD_BAR_WORDS) * 4 <= (int)CTL_BYTES, "ctl");

__global__ void __launch_bounds__(512, 2) fwd(Params p) {
    extern __shared__ __attribute__((aligned(16))) unsigned char lds[];
    const int tid = threadIdx.x;
    volatile LAS unsigned* xbw = (volatile LAS unsigned*)((LAS unsigned char*)lds + XBW_OFF);
    if (tid < 4) xbw[tid] = 0u;
    __syncthreads();
    XcdBarrier bar; bar.bar = WSP(unsigned, WS_CTL) + BAR_WORD0; bar.x = 0; bar.st = xbw;
    if (p.ph_hi - p.ph_lo > 1) bar = xcd_barrier_post(WSP(unsigned, WS_CTL) + BAR_WORD0, xbw);
#ifndef PHMASK
#define PHMASK 0x1FFF
#endif
#define IN(k) (p.ph_lo <= (k) && (k) < p.ph_hi)
#define INL(j) (((PHMASK >> ((j) + 1)) & 1) && IN(pb + (j)))
#ifndef DUPMASK
#define DUPMASK 0
#endif
#define DUP(j) ((DUPMASK >> ((j) + 1)) & 1)
#if DUPMASK
#define REPS(j) opaque_int(1 + DUP(j))
#else
#define REPS(j) 1
#endif
#ifndef DBLBAR
#define DBLBAR 0
#endif
#ifdef DIAG_KIND
#ifndef DIAG_SCALE
#define DIAG_SCALE 0.01f
#endif
    unsigned long long dg_sum = 0ull, dg_prev = wall_clock64();
#define DIAG_AT(k) do { const unsigned long long now_ = wall_clock64(); if ((DIAG_KIND >> (((k) == 0) ? 12 : (((k) - 1) % 12))) & 1) dg_sum += now_ - dg_prev; dg_prev = now_; } while (0)
#else
#define DIAG_AT(k) do { } while (0)
#endif
#define SEAM(k) do { if (IN(k) && IN((k) + 1)) { xcd_barrier(bar); if (DBLBAR) xcd_barrier(bar); } DIAG_AT(k); } while (0)
    LAS unsigned char* ldsl = (LAS unsigned char*)lds;
    bf16_t* H = WSP(bf16_t, WS_H); bf16_t* ACT = WSP(bf16_t, WS_ACT); float* X = WSP(float, WS_X); float* Z = WSP(float, WS_Z); bf16_t* MRG = WSP(bf16_t, WS_MRG);

    if ((PHMASK & 1) && IN(0)) { const int reps_ = (DUPMASK & 1) ? opaque_int(2) : 1; for (int rep_ = 0; rep_ < reps_; ++rep_) { const Params q = opaque_params(p); phase_prologue(q, (float*)lds); __syncthreads(); } }
    SEAM(0);
    for (int l = 0; l < DBG_NLAYERS; ++l) {
        const int pb = 1 + l * 12;
        const float* modl = WSP(float, WS_MODV) + (size_t)l * NCOND * NMOD;
        if (INL(0)) { const int reps_ = REPS(0); for (int rep_ = 0; rep_ < reps_; ++rep_) { const Params q = opaque_params(p); phase_norm(q, l, 0, lds); __syncthreads(); } }
        SEAM(pb + 0);
        if (INL(1)) {
            if (g1_fp8(l, 0)) {
                pg8::Gemm g{H, (const bf16_t*)(WSP(unsigned char, WS_WGU) + ((size_t)l * 2 + 0) * NGU * DM * 2), M, NGU, DM / 2}; pg8::StaticOrder S; S.init(M, NGU, DM / 2, (int)gridDim.x, (int)blockIdx.x, 2);
                pg8::EpiSwiGLU8 E{WSP(unsigned char, WS_ACT), FFP, 1.0f / WGU_SCALE};
                for (int r_ = 0, n_ = REPS(1); r_ < n_; ++r_) pg8::gemm_phase<pg8::EpiSwiGLU8, pg8::StaticOrder, false, 1, true, PRESTAGE_F8>(ldsl, g, S, E, nullptr);
            } else {
                pg8::Gemm g{H, WSP(bf16_t, WS_WGU) + ((size_t)l * 2 + 0) * NGU * DM, M, NGU, DM}; pg8::StaticOrder S; S.init(M, NGU, DM, (int)gridDim.x, (int)blockIdx.x, 0);
                pg8::EpiSwiGLU8 E{WSP(unsigned char, WS_ACT), FFP, 1.0f};
                for (int r_ = 0, n_ = REPS(1); r_ < n_; ++r_) pg8::gemm_phase<pg8::EpiSwiGLU8, pg8::StaticOrder, false, 0, false, PRESTAGE_ON>(ldsl, g, S, E, nullptr);
            }
#if CONV_FILLER
            if (l + 1 < DBG_NLAYERS) {
                const int nw_ = (M / 256) * (NGU / 256), G_ = (int)gridDim.x; int f0_ = nw_ % G_; if (nw_ < G_) f0_ = 0;
                if (g1_fp8(l, 0)) f0_ = 2 * f0_ < G_ ? 2 * f0_ : f0_;
                if ((int)blockIdx.x >= f0_) { const Params q = opaque_params(p); mod_layer(q, l + 1, (int)blockIdx.x - f0_, G_ - f0_, (float*)lds); }
            }
            CONV_FILL((M / 256) * (NGU / 256), 0, TF0, (g1_fp8(l, 0) ? ((M / 256) * (NGU / 256)) % (int)gridDim.x : 0));
#endif
        }
        SEAM(pb + 1);
        if (INL(2)) {
            pg8::Gemm g{ACT, G2_FP8 ? (const bf16_t*)(WSP(unsigned char, WS_WDN) + ((size_t)l * 2 + 0) * DM * FFP) : WSP(bf16_t, WS_WDN) + ((size_t)l * 2 + 0) * DM * FF, M, DM, G2_FP8 ? FFP / 2 : FF}; pg8::StaticOrder S; S.init(M, DM, G2_FP8 ? FFP / 2 : FF, (int)gridDim.x, (int)blockIdx.x, SPLITK ? 1 : MSPLIT);
            pg8::EpiResid E{l == 0 ? p.in[I_XP] : X, X, DM, modl + 2 * DM, G2_FP8 ? 0.5f / WDN_SCALE : 0.5f, Z, WSP(unsigned, WS_CTL) + FLAG_WORD0, 8u * (unsigned)(l * (2 * SPLITK + SPLITK_G4) + SPLITK), l == 0 ? p.in[I_XS] : X, l == 0 ? MC : 0x7FFFFFFF, (XBF16 && l != 0), XBF16};
            pg8::gemm_phase<pg8::EpiResid, pg8::StaticOrder, false, (G2_FP8 ? 1 : 0), true, PRESTAGE_RS>(ldsl, g, S, E, nullptr);
#if DUPMASK
            if (opaque_int(DUP(2))) { pg8::EpiResid E2{l == 0 ? p.in[I_XP] : X, Z, DM, modl + 2 * DM, G2_FP8 ? 0.5f / WDN_SCALE : 0.5f, Z, WSP(unsigned, WS_CTL) + FLAG_WORD0, 0u, l == 0 ? p.in[I_XS] : X, l == 0 ? MC : 0x7FFFFFFF, 0, 0}; pg8::gemm_phase<pg8::EpiResid, pg8::StaticOrder, false, (G2_FP8 ? 1 : 0)>(ldsl, g, S, E2, nullptr); }
#endif
        }
        SEAM(pb + 2);
        if (INL(3)) { const int reps_ = REPS(3); for (int rep_ = 0; rep_ < reps_; ++rep_) { const Params q = opaque_params(p); phase_norm(q, l, 1, lds); __syncthreads(); } }
        SEAM(pb + 3);
        if (INL(4)) {
#if G3_FP8
            pg8::Gemm g{H, WSP(bf16_t, WS_WIN) + (size_t)l * NINP * DM, M, NINP, DM / 2}; pg8::StaticOrder S; S.init(M, NINP, DM / 2, (int)gridDim.x, (int)blockIdx.x, 2);
            pg8::EpiBf16Plain E{WSP(bf16_t, WS_Z), NINP, 1.0f / WIN_SCALE};
            for (int r_ = 0, n_ = REPS(4); r_ < n_; ++r_) pg8::gemm_phase<pg8::EpiBf16Plain, pg8::StaticOrder, false, 1>(ldsl, g, S, E, nullptr);
#else
            pg8::Gemm g{H, WSP(bf16_t, WS_WIN) + (size_t)l * NINP * DM, M, NINP, DM}; pg8::StaticOrder S; S.init(M, NINP, DM, (int)gridDim.x, (int)blockIdx.x);
            pg8::EpiBf16Plain E{WSP(bf16_t, WS_Z), NINP, 1.0f};
            for (int r_ = 0, n_ = REPS(4); r_ < n_; ++r_) pg8::gemm_phase<pg8::EpiBf16Plain, pg8::StaticOrder, false, 0, false, PRESTAGE_ON>(ldsl, g, S, E, nullptr);
#endif
#if CONV_FILLER
            CONV_FILL((M / 256) * (NINP / 256), TF0, TF1, 0);
#endif
        }
        SEAM(pb + 4);
        if (INL(5)) { const int reps_ = REPS(5); for (int rep_ = 0; rep_ < reps_; ++rep_) { const Params q = opaque_params(p); phase_prep(q, l, lds); __syncthreads(); } }
        SEAM(pb + 5);
        if (INL(6)) { const int reps_ = REPS(6); for (int rep_ = 0; rep_ < reps_; ++rep_) { const Params q = opaque_params(p); phase_mix(q, l, lds, rep_); __syncthreads(); } }
        SEAM(pb + 6);
        if (INL(7)) { const int reps_ = REPS(7); for (int rep_ = 0; rep_ < reps_; ++rep_) { const Params q = opaque_params(p); phase_post(q, l); __syncthreads(); } }
        SEAM(pb + 7);
        if (INL(8)) {
            pg8::Gemm g{MRG, WSP(bf16_t, WS_WOUT) + (size_t)l * DM * DM, M, DM, DM}; pg8::StaticOrder S; S.init(M, DM, DM, (int)gridDim.x, (int)blockIdx.x, SPLITK_G4);
            pg8::EpiResid E{X, X, DM, modl + 5 * DM, 1.0f, Z, WSP(unsigned, WS_CTL) + FLAG_WORD0, 8u * (unsigned)(l * (2 * SPLITK + SPLITK_G4) + SPLITK + SPLITK_G4), X, 0x7FFFFFFF, XBF16, XBF16};
            pg8::gemm_phase<pg8::EpiResid, pg8::StaticOrder, false, 0, true, PRESTAGE_G4>(ldsl, g, S, E, nullptr);
#if CONV_FILLER
            CONV_FILL((M / 256) * (DM / 256), TF1, TF2, 0);
#endif
#if DUPMASK
            if (opaque_int(DUP(8))) { pg8::EpiResid E2{X, Z, DM, modl + 5 * DM, 1.0f, Z, WSP(unsigned, WS_CTL) + FLAG_WORD0, 0u, X, 0x7FFFFFFF, 0, 0}; pg8::gemm_phase<pg8::EpiResid, pg8::StaticOrder, false>(ldsl, g, S, E2, nullptr); }
#endif
        }
        SEAM(pb + 8);
        if (INL(9)) { const int reps_ = REPS(9); for (int rep_ = 0; rep_ < reps_; ++rep_) { const Params q = opaque_params(p); phase_norm(q, l, 2, lds); __syncthreads(); } }
        SEAM(pb + 9);
        if (INL(10)) {
            {
#if G1B_MODE
                pg8::Gemm g{H, (const bf16_t*)(WSP(unsigned char, WS_WGU) + ((size_t)l * 2 + 1) * NGU * DM * 2), M, NGU, DM / 2}; pg8::StaticOrder S; S.init(M, NGU, DM / 2, (int)gridDim.x, (int)blockIdx.x, G1B_MSPLIT);
                constexpr float ws_ = 1.0f / WGU_SCALE;
#else
                pg8::Gemm g{H, WSP(bf16_t, WS_WGU) + ((size_t)l * 2 + 1) * NGU * DM, M, NGU, DM}; pg8::StaticOrder S; S.init(M, NGU, DM, (int)gridDim.x, (int)blockIdx.x, G1B_MSPLIT);
                constexpr float ws_ = 1.0f;
#endif
#if G2_FP8
                pg8::EpiSwiGLU8 E{WSP(unsigned char, WS_ACT), FFP, ws_};
                for (int r_ = 0, n_ = REPS(10); r_ < n_; ++r_) pg8::gemm_phase<pg8::EpiSwiGLU8, pg8::StaticOrder, false, G1B_MODE, true, PRESTAGE_F8>(ldsl, g, S, E, nullptr);
#else
                pg8::EpiSwiGLU E{ACT, FF};
                pg8::gemm_phase<pg8::EpiSwiGLU, pg8::StaticOrder, false, G1B_MODE>(ldsl, g, S, E, nullptr);
#endif
            }
#if CONV_FILLER
            CONV_FILL((M / 256) * (NGU / 256), TF3, NT_L, (G1B_MSPLIT ? ((M / 256) * (NGU / 256)) % (int)gridDim.x : 0));
#endif
        }
        SEAM(pb + 10);
        if (INL(11)) {
            pg8::Gemm g{ACT, G2_FP8 ? (const bf16_t*)(WSP(unsigned char, WS_WDN) + ((size_t)l * 2 + 1) * DM * FFP) : WSP(bf16_t, WS_WDN) + ((size_t)l * 2 + 1) * DM * FF, M, DM, G2_FP8 ? FFP / 2 : FF}; pg8::StaticOrder S; S.init(M, DM, G2_FP8 ? FFP / 2 : FF, (int)gridDim.x, (int)blockIdx.x, SPLITK ? 1 : MSPLIT);
            pg8::EpiResid E{X, (l == DEPTH - 1) ? p.out : X, DM, modl + 8 * DM, G2_FP8 ? 0.5f / WDN_SCALE : 0.5f, Z, WSP(unsigned, WS_CTL) + FLAG_WORD0, 8u * (unsigned)(l * (2 * SPLITK + SPLITK_G4) + 2 * SPLITK + SPLITK_G4), X, 0x7FFFFFFF, XBF16, (XBF16 && l != DEPTH - 1)};
            pg8::gemm_phase<pg8::EpiResid, pg8::StaticOrder, false, (G2_FP8 ? 1 : 0), true, PRESTAGE_RS>(ldsl, g, S, E, nullptr);
        }
        SEAM(pb + 11);
    }
#ifdef DIAG_KIND
    xcd_barrier(bar);
    if (blockIdx.x == 0 && threadIdx.x == 0) p.out[0] += (float)dg_sum * 0.01f * DIAG_SCALE;
#endif
#undef IN
#undef SEAM
}

#ifndef MULTI_LAUNCH
#define MULTI_LAUNCH 0
#endif
extern "C" void kernel_launch(void* const* d_in, const int* in_sizes, int n_in, void* d_out, int out_size, void* d_ws, size_t ws_size, hipStream_t stream) {
    static int grid = 0;
    if (grid == 0) {
        if (n_in != N_IN || (size_t)out_size != O_END || ws_size < WS_END) { fprintf(stderr, "kernel_launch: shape mismatch n_in %d out %d ws %zu (need %zu)\n", n_in, out_size, ws_size, (size_t)WS_END); grid = -1; return; }
        int dev = 0, cus = 0, per_cu = 0;
        if (hipGetDevice(&dev) != hipSuccess || hipDeviceGetAttribute(&cus, hipDeviceAttributeMultiprocessorCount, dev) != hipSuccess) { grid = -1; return; }
        if (hipFuncSetAttribute((const void*)fwd, hipFuncAttributeMaxDynamicSharedMemorySize, LDS_BYTES) != hipSuccess) { fprintf(stderr, "kernel_launch: hipFuncSetAttribute failed\n"); grid = -1; return; }
        if (hipOccupancyMaxActiveBlocksPerMultiprocessor(&per_cu, (const void*)fwd, 512, LDS_BYTES) != hipSuccess || per_cu < 1) { fprintf(stderr, "kernel_launch: occupancy query says %d\n", per_cu); (void)hipGetLastError(); }
        grid = cus;
    }
    if (grid < 0) return;
    (void)hipMemsetAsync((char*)d_ws + WS_CTL, 0, CTL_BYTES, stream);
    Params p{};
    for (int i = 0; i < N_IN; ++i) p.in[i] = (const float*)d_in[i];
    p.out = (float*)d_out; p.ws = (unsigned char*)d_ws;
#if MULTI_LAUNCH
    for (int ph = 0; ph < 1 + DBG_NLAYERS * 12; ++ph) { p.ph_lo = ph; p.ph_hi = ph + 1; hipLaunchKernelGGL(fwd, dim3(grid), dim3(512), LDS_BYTES, stream, p); }
#else
    p.ph_lo = 0; p.ph_hi = NPH; hipLaunchKernelGGL(fwd, dim3(grid), dim3(512), LDS_BYTES, stream, p);
#endif
    const hipError_t le = hipPeekAtLastError();
    if (le != hipSuccess) fprintf(stderr, "kernel_launch: launch failed: %s\n", hipGetErrorName(le));
}
```

```cpp
#define G1A_LAYERS 0xF
#include <hip/hip_runtime.h>
#include <cstdio>
#include <cstdint>

#ifndef CB_
#define CB_ 16
#endif
#ifndef LB_
#define LB_ 8
#endif
#ifndef DEPTH_
#define DEPTH_ 4
#endif
#ifndef G1A_LAYERS
#define G1A_LAYERS 0xE
#endif
#ifndef G1A_MODE
#define G1A_MODE 0
#endif
#ifndef G1B_MODE
#define G1B_MODE 1
#endif
#ifndef XBF16
#define XBF16 0
#endif
#ifndef G3_FP8
#define G3_FP8 0
#endif
#ifndef G2_FP8
#define G2_FP8 1
#endif
#ifndef FFN_FP8
#define FFN_FP8 (G1A_MODE != 0 || G1B_MODE != 0 || G2_FP8 != 0)
#endif
constexpr int DM = 2048, DEPTH = DEPTH_, CB = CB_, CT = 256, LB = LB_, LT = 1024;
constexpr int MC = CB * CT, ML = LB * LT, M = MC + ML;
constexpr int FF = 5504, NGU = 2 * FF, NIN = 6192, NINP = 6400, NMOD = 9 * DM, NCOND = 1 + LB;
constexpr float EPS = 1e-6f;
constexpr int FFP = 5632;
constexpr float WGU_SCALE = 32.0f, WDN_SCALE = 64.0f, WIN_SCALE = 32.0f;
constexpr int Z_NAQ = 0, Z_NAK = 512, Z_NAV = 1024, Z_GLQ = 1536, Z_GLK = 1792, Z_GLV = 2048, Z_GLR = 2560, Z_GF = 3072, Z_GB = 3088,
              Z_GQQ = 3104, Z_GQK = 3616, Z_GQV = 3872, Z_DQKV = 4128, Z_DZ = 5664, Z_DB = 6176, Z_DA = 6184;
static_assert(Z_DA + 8 == NIN, "split");
enum { I_XP = 0, I_XS, I_CNAK, I_CNAV, I_CGK, I_CGV, I_SGLA, I_SGDN, I_C, I_CCTX, I_NORMG, I_WMOD, I_BMOD, I_GU, I_DOWN, I_WIN, I_WOUT, I_NAQKN, I_RPB,
       I_GUP, I_GBIAS, I_GLAON, I_GQAQKN, I_CONV, I_ALOG, I_DTB, I_GDNON, N_IN };
constexpr size_t O_YP = 0, O_YS = O_YP + (size_t)MC * DM, O_NAK = O_YS + (size_t)ML * DM, O_NAV = O_NAK + (size_t)CB * DEPTH * 4 * CT * 128,
                 O_GK = O_NAV + (size_t)CB * DEPTH * 4 * CT * 128, O_GV = O_GK + (size_t)CB * DEPTH * 2 * CT * 128,
                 O_SGLA = O_GV + (size_t)CB * DEPTH * 2 * CT * 128, O_SGDN = O_SGLA + (size_t)CB * DEPTH * 2 * 4 * 64 * 128,
                 O_END = O_SGDN + (size_t)CB * DEPTH * 2 * 4 * 128 * 128;
constexpr size_t al256(size_t x) { return (x + 255) & ~(size_t)255; }
constexpr size_t WS_CTL = 0, CTL_BYTES = 1u << 20;
constexpr size_t WS_WGU = CTL_BYTES;
constexpr size_t WS_WDN = WS_WGU + (size_t)DEPTH * 2 * NGU * DM * 2;
constexpr size_t WS_WIN = WS_WDN + (size_t)DEPTH * 2 * DM * FF * 2;
constexpr size_t WS_WOUT = WS_WIN + (size_t)DEPTH * NINP * DM * 2;
constexpr size_t WS_MODV = WS_WOUT + (size_t)DEPTH * DM * DM * 2;
constexpr size_t WS_ROPE = al256(WS_MODV + (size_t)DEPTH * NCOND * NMOD * 4);
constexpr size_t WS_X = al256(WS_ROPE + 2 * 64 * 32 * 4);
constexpr size_t WS_H = WS_X + (size_t)M * DM * 4;
constexpr size_t WS_ACT = WS_H + (size_t)M * DM * 2;
constexpr size_t WS_Z = WS_ACT + (size_t)M * FF * 2;
constexpr size_t WS_MRG = WS_Z + (size_t)M * NINP * 4;
constexpr size_t WS_NAQ = WS_MRG + (size_t)M * DM * 2;
constexpr size_t WS_NAK = WS_NAQ + (size_t)M * 512 * 2;
constexpr size_t WS_NAV = WS_NAK + (size_t)M * 512 * 2;
constexpr size_t WS_GQ = WS_NAV + (size_t)M * 512 * 2;
constexpr size_t WS_GK = WS_GQ + (size_t)M * 512 * 2;
constexpr size_t WS_GV = WS_GK + (size_t)M * 256 * 2;
constexpr size_t WS_CNAK = WS_GV + (size_t)M * 256 * 2;
constexpr size_t WS_CNAV = WS_CNAK + (size_t)LB * DEPTH * 256 * 512 * 2;
constexpr size_t WS_CGK = WS_CNAV + (size_t)LB * DEPTH * 256 * 512 * 2;
constexpr size_t WS_CGV = WS_CGK + (size_t)LB * DEPTH * 256 * 256 * 2;
constexpr size_t WS_AF = WS_CGV + (size_t)LB * DEPTH * 256 * 256 * 2;
constexpr size_t WS_AB = WS_AF + (size_t)M * 256 * 4;
constexpr size_t WS_DQ = WS_AB + (size_t)M * 256 * 4;
constexpr size_t WS_DK = WS_DQ + (size_t)M * 512 * 4;
constexpr size_t WS_DV = WS_DK + (size_t)M * 512 * 4;
constexpr size_t WS_DBA = WS_DV + (size_t)M * 512 * 4;
constexpr size_t WS_GOF = WS_DBA + (size_t)M * 16 * 4;
constexpr size_t WS_GOB = WS_GOF + (size_t)M * 512 * 4;
constexpr size_t WS_DOF = WS_GOB + (size_t)M * 512 * 4;
constexpr size_t WS_DOB = WS_DOF + (size_t)M * 512 * 4;
constexpr size_t WS_END = WS_DOB + (size_t)M * 512 * 4;

typedef unsigned short bf16_t;
struct Params { const float* in[N_IN]; float* out; unsigned char* ws; int ph_lo, ph_hi; };
static_assert(sizeof(Params) == N_IN * 8 + 8 + 8 + 8, "no padding");

#define WSP(T, off) ((T*)(p.ws + (off)))
__device__ __forceinline__ int opaque_tid() { int t = (int)threadIdx.x; asm volatile("" : "+v"(t)); return t; }
__device__ __forceinline__ Params opaque_params(const Params& p) { Params q = p; unsigned long long w = (unsigned long long)q.ws; asm volatile("" : "+s"(w));
    q.ws = (unsigned char*)(__attribute__((address_space(1))) unsigned char*)w; return q; }

typedef float vf4 __attribute__((ext_vector_type(4)));
__device__ __forceinline__ unsigned pack4_fp8(float a, float b, float c, float d) { int w = 0; w = __builtin_amdgcn_cvt_pk_fp8_f32(a, b, w, false); w = __builtin_amdgcn_cvt_pk_fp8_f32(c, d, w, true); return (unsigned)w; }
__device__ __forceinline__ float bf2f(unsigned short v) { return __uint_as_float((unsigned)v << 16); }
__device__ __forceinline__ vf4 ld4bf(const unsigned short* p) { const uint2 w = *(const uint2*)p; vf4 r; r.x = __uint_as_float(w.x << 16); r.y = __uint_as_float(w.x & 0xFFFF0000u); r.z = __uint_as_float(w.y << 16); r.w = __uint_as_float(w.y & 0xFFFF0000u); return r; }
__device__ __forceinline__ vf4 unp4bf(uint2 w) { vf4 r; r.x = __uint_as_float(w.x << 16); r.y = __uint_as_float(w.x & 0xFFFF0000u); r.z = __uint_as_float(w.y << 16); r.w = __uint_as_float(w.y & 0xFFFF0000u); return r; }
__device__ __forceinline__ void unp8bf(uint4 w, vf4& a, vf4& b) {
    a.x = __uint_as_float(w.x << 16); a.y = __uint_as_float(w.x & 0xFFFF0000u); a.z = __uint_as_float(w.y << 16); a.w = __uint_as_float(w.y & 0xFFFF0000u);
    b.x = __uint_as_float(w.z << 16); b.y = __uint_as_float(w.z & 0xFFFF0000u); b.z = __uint_as_float(w.w << 16); b.w = __uint_as_float(w.w & 0xFFFF0000u); }
__device__ __forceinline__ void ld8bf(const unsigned short* p, vf4& a, vf4& b) { const uint4 w = *(const uint4*)p;
    a.x = __uint_as_float(w.x << 16); a.y = __uint_as_float(w.x & 0xFFFF0000u); a.z = __uint_as_float(w.y << 16); a.w = __uint_as_float(w.y & 0xFFFF0000u);
    b.x = __uint_as_float(w.z << 16); b.y = __uint_as_float(w.z & 0xFFFF0000u); b.z = __uint_as_float(w.w << 16); b.w = __uint_as_float(w.w & 0xFFFF0000u); }
__device__ __forceinline__ float wave_sum(float v) {
#pragma unroll
    for (int o = 32; o >= 1; o >>= 1) v += __shfl_xor(v, o);
    return v;
}
typedef float vf2_ __attribute__((ext_vector_type(2)));
typedef __bf16 vb2_ __attribute__((ext_vector_type(2)));
__device__ __forceinline__ bf16_t f2bf(float f) { return __builtin_bit_cast(unsigned short, (__bf16)f); }
__device__ __forceinline__ unsigned pack2(float a, float b) { return __builtin_bit_cast(unsigned, __builtin_convertvector((vf2_){a, b}, vb2_)); }
__device__ __forceinline__ float silu_f(float x) { return x / (1.f + expf(-x)); }
__device__ __forceinline__ float rsqrt_fast(float x) { return __builtin_amdgcn_rsqf(x); }
__device__ __forceinline__ float silu_fast(float x) { return x * __builtin_amdgcn_rcpf(1.f + __expf(-x)); }
__device__ __forceinline__ float logsigmoid_fast(float x) { return fminf(x, 0.f) - __logf(1.f + __expf(-fabsf(x))); }
__device__ __forceinline__ float softplus_f(float x) { return fmaxf(x, 0.f) + log1pf(expf(-fabsf(x))); }
__device__ __forceinline__ float logsigmoid_f(float x) { return fminf(x, 0.f) - log1pf(expf(-fabsf(x))); }
__device__ __forceinline__ bool g1_fp8(int l, int f) { return f ? (G1B_MODE != 0) : (G1A_MODE != 0 || ((G1A_LAYERS >> l) & 1)); }
__device__ __forceinline__ int opaque_int(int v) { asm volatile("" : "+s"(v)); return v; }
__device__ __forceinline__ int cond_of_row(int m) { return m < MC ? 0 : 1 + (m - MC) / LT; }
#ifndef CONV_FILLER
#define CONV_FILLER 1
#endif
__device__ __forceinline__ void conv_tile(const float* __restrict__ src, int ld_src, int ncols_src, int k0, int c0, bf16_t* __restrict__ dst, int ld_dst, int n0, float* tile) {
    const int tid = opaque_tid();
    {
        const int r = tid >> 3, c = (tid & 7) * 8;
        float4 a = make_float4(0.f, 0.f, 0.f, 0.f), b = a;
        if (c0 + c + 8 <= ncols_src) {
            const float* s = src + (size_t)(k0 + r) * ld_src + c0 + c;
            a = *(const float4*)s; b = *(const float4*)(s + 4);
        }
        float* t = tile + r * 65 + c;
        t[0] = a.x; t[1] = a.y; t[2] = a.z; t[3] = a.w; t[4] = b.x; t[5] = b.y; t[6] = b.z; t[7] = b.w;
    }
    __syncthreads();
    {
        const int n = tid >> 3, ks = (tid & 7) * 8;
        const float* t = tile + ks * 65 + n;
        uint4 w;
        w.x = pack2(t[0 * 65], t[1 * 65]); w.y = pack2(t[2 * 65], t[3 * 65]); w.z = pack2(t[4 * 65], t[5 * 65]); w.w = pack2(t[6 * 65], t[7 * 65]);
        *(uint4*)(dst + (size_t)(n0 + n) * ld_dst + k0 + ks) = w;
    }
    __syncthreads();
}

__device__ __forceinline__ void conv_tile8(const float* __restrict__ src, int ld_src, int nrows_src, int k0, int c0, unsigned char* __restrict__ dst, int ld_dst, int n0, float scale, float* tile) {
    const int tid = opaque_tid();
    {
        const int r = tid >> 3, c = (tid & 7) * 8;
        float4 a = make_float4(0.f, 0.f, 0.f, 0.f), b = a;
        if (k0 + r < nrows_src) { const float* s = src + (size_t)(k0 + r) * ld_src + c0 + c; a = *(const float4*)s; b = *(const float4*)(s + 4); }
        float* t = tile + r * 65 + c;
        t[0] = a.x * scale; t[1] = a.y * scale; t[2] = a.z * scale; t[3] = a.w * scale; t[4] = b.x * scale; t[5] = b.y * scale; t[6] = b.z * scale; t[7] = b.w * scale;
    }
    __syncthreads();
    {
        const int n = tid >> 3, ks = (tid & 7) * 8;
        const float* t = tile + ks * 65 + n;
        uint2 w; w.x = pack4_fp8(t[0 * 65], t[1 * 65], t[2 * 65], t[3 * 65]); w.y = pack4_fp8(t[4 * 65], t[5 * 65], t[6 * 65], t[7 * 65]);
        *(uint2*)(dst + (size_t)(n0 + n) * ld_dst + k0 + ks) = w;
    }
    __syncthreads();
}
constexpr int MOD_ITEMS = DEPTH * (NMOD / 128);
constexpr int TGU_KT = DM / 64, TGU_NT = NGU / 64, TDN_KT = (G2_FP8 ? FFP : FF) / 64, TDN_NT = DM / 64, TIN_KT = DM / 64, TIN_NT = NINP / 64, TOUT_KT = DM / 64, TOUT_NT = DM / 64;
constexpr int TL_GU = 2 * TGU_KT * TGU_NT, TL_DN = 2 * TDN_KT * TDN_NT, TL_IN = TIN_KT * TIN_NT, TL_OUT = TOUT_KT * TOUT_NT, NT_L = TL_GU + TL_DN + TL_IN + TL_OUT;
struct CTile { const float* sp; unsigned char* dp; float scale; int fp8; };
__device__ __forceinline__ CTile conv_desc(const Params& p, int l, int it, int tid) {
    const int r = tid >> 3, c = (tid & 7) * 8;
    CTile d; d.scale = 1.0f; d.fp8 = 0;
    if (it < TL_GU) {
        const int mat = l * 2 + it / (TGU_KT * TGU_NT), rr = it % (TGU_KT * TGU_NT), kt = rr / TGU_NT, nt = rr % TGU_NT;
        const int n0 = nt * 64, t256 = n0 / 256, cc = n0 % 256;
        const int c0 = cc < 128 ? 128 * t256 + cc : FF + 128 * t256 + (cc - 128);
        d.sp = p.in[I_GU] + (size_t)mat * DM * NGU + (size_t)(kt * 64 + r) * NGU + c0 + c;
        if (g1_fp8(mat >> 1, mat & 1)) { d.fp8 = 1; d.scale = WGU_SCALE; d.dp = WSP(unsigned char, WS_WGU) + (size_t)mat * NGU * DM * 2 + (size_t)(n0 + r) * DM + kt * 64 + c; }
        else d.dp = WSP(unsigned char, WS_WGU) + ((size_t)mat * NGU * DM + (size_t)(n0 + r) * DM + kt * 64 + c) * 2;
    } else if (it < TL_GU + TL_DN) {
        const int i2 = it - TL_GU, mat = l * 2 + i2 / (TDN_KT * TDN_NT), rr = i2 % (TDN_KT * TDN_NT), kt = rr / TDN_NT, nt = rr % TDN_NT;
        d.sp = (kt * 64 + r < FF) ? p.in[I_DOWN] + (size_t)mat * FF * DM + (size_t)(kt * 64 + r) * DM + nt * 64 + c : nullptr;
#if G2_FP8
        d.fp8 = 1; d.scale = WDN_SCALE; d.dp = WSP(unsigned char, WS_WDN) + (size_t)mat * DM * FFP + (size_t)(nt * 64 + r) * FFP + kt * 64 + c;
#else
        d.dp = WSP(unsigned char, WS_WDN) + ((size_t)mat * DM * FF + (size_t)(nt * 64 + r) * FF + kt * 64 + c) * 2;
#endif
    } else if (it < TL_GU + TL_DN + TL_IN) {
        const int i2 = it - TL_GU - TL_DN, kt = i2 / TIN_NT, nt = i2 % TIN_NT;
        d.sp = (nt * 64 + c + 8 <= NIN) ? p.in[I_WIN] + (size_t)l * DM * NIN + (size_t)(kt * 64 + r) * NIN + nt * 64 + c : nullptr;
#if G3_FP8
        d.fp8 = 1; d.scale = WIN_SCALE; d.dp = WSP(unsigned char, WS_WIN) + (size_t)l * NINP * DM * 2 + (size_t)(nt * 64 + r) * DM + kt * 64 + c;
#else
        d.dp = WSP(unsigned char, WS_WIN) + ((size_t)l * NINP * DM + (size_t)(nt * 64 + r) * DM + kt * 64 + c) * 2;
#endif
    } else {
        const int i2 = it - TL_GU - TL_DN - TL_IN, kt = i2 / TOUT_NT, nt = i2 % TOUT_NT;
        d.sp = p.in[I_WOUT] + (size_t)l * DM * DM + (size_t)(kt * 64 + r) * DM + nt * 64 + c;
        d.dp = WSP(unsigned char, WS_WOUT) + ((size_t)l * DM * DM + (size_t)(nt * 64 + r) * DM + kt * 64 + c) * 2;
    }
    return d;
}
#ifndef CONV_U
#define CONV_U 8
#endif
constexpr int CS_U0 = TL_GU / 2, CS_U1 = CS_U0 + TL_DN / 2, CS_U2 = CS_U1 + TL_IN, CS_U3 = CS_U2 + TL_OUT, CS_U4 = CS_U3 + TL_GU / 2, CS_PRO = CS_U2, CS_END = DEPTH * NT_L;
__device__ __forceinline__ int conv_remap(int s) {
    if (s < CS_U0) return s;
    if (s < CS_U1) return TL_GU + (s - CS_U0);
    if (s < CS_U2) return TL_GU + TL_DN + (s - CS_U1);
    if (s < CS_U3) return TL_GU + TL_DN + TL_IN + (s - CS_U2);
    if (s < CS_U4) return TL_GU / 2 + (s - CS_U3);
    return TL_GU + TL_DN / 2 + (s - CS_U4);
}
__device__ __forceinline__ void conv_layer_tiles(const Params& p, int  , int t_begin, int t_end, int first, int stride, float* s_tile) {
    const int tid = opaque_tid(), r = tid >> 3, c = (tid & 7) * 8;
    int it = t_begin + first;
    if (it >= t_end) return;
    __syncthreads();
    for (; it < t_end; it += CONV_U * stride) {
        const float* sp[CONV_U]; unsigned char* dp[CONV_U]; float sc[CONV_U]; int f8[CONV_U]; float4 a[CONV_U], b[CONV_U];
#pragma unroll
        for (int u = 0; u < CONV_U; ++u) {
            const int iu = it + u * stride; const bool ok = iu < t_end;
            const int gs_ = ok ? iu : it;
            const CTile d = conv_desc(p, gs_ / NT_L, conv_remap(gs_ % NT_L), tid);
            sp[u] = ok ? d.sp : nullptr; dp[u] = ok ? d.dp : nullptr; sc[u] = d.scale; f8[u] = d.fp8;
            a[u] = make_float4(0.f, 0.f, 0.f, 0.f); b[u] = a[u];
            if (sp[u]) { a[u] = *(const float4*)sp[u]; b[u] = *(const float4*)(sp[u] + 4); }
        }
#pragma unroll
        for (int u = 0; u < CONV_U; ++u) {
            float* t = s_tile + u * (64 * 65) + r * 65 + c; const float s1 = sc[u];
            t[0] = a[u].x * s1; t[1] = a[u].y * s1; t[2] = a[u].z * s1; t[3] = a[u].w * s1; t[4] = b[u].x * s1; t[5] = b[u].y * s1; t[6] = b[u].z * s1; t[7] = b[u].w * s1;
        }
        __syncthreads();
#pragma unroll
        for (int u = 0; u < CONV_U; ++u) if (dp[u]) {
            const float* t = s_tile + u * (64 * 65) + c * 65 + r;
            if (f8[u]) { uint2 w; w.x = pack4_fp8(t[0 * 65], t[1 * 65], t[2 * 65], t[3 * 65]); w.y = pack4_fp8(t[4 * 65], t[5 * 65], t[6 * 65], t[7 * 65]); *(uint2*)dp[u] = w; }
            else { uint4 w; w.x = pack2(t[0 * 65], t[1 * 65]); w.y = pack2(t[2 * 65], t[3 * 65]); w.z = pack2(t[4 * 65], t[5 * 65]); w.w = pack2(t[6 * 65], t[7 * 65]); *(uint4*)dp[u] = w; }
        }
        __syncthreads();
    }
}
constexpr int MOD_TC = 72, MOD_CG = MOD_TC / 4, MOD_KS = 16, MOD_KR = DM / MOD_KS, MOD_NT = NMOD / MOD_TC;
constexpr int MOD_LDS_FLOATS = NCOND * DM + MOD_KS * MOD_CG * NCOND * 4;
static_assert(NMOD % MOD_TC == 0 && MOD_CG * MOD_KS <= 512 && DM % MOD_KS == 0 && MOD_KR % 16 == 0 && (NCOND * DM) % (512 * 12) == 0, "mod tiling");
__device__ __forceinline__ void mod_layer(const Params& p, int l, int first, int stride, float* smem) {
    const int tid = opaque_tid();
    float* s_cond = smem;
    float* s_red = s_cond + NCOND * DM;
    __syncthreads();
    for (int i0 = tid; i0 < NCOND * DM; i0 += 512 * 12) {
        float cv[12];
#pragma unroll
        for (int k = 0; k < 12; ++k) { const int i = i0 + 512 * k, ci = i / DM, kk = i % DM; cv[k] = ci == 0 ? p.in[I_CCTX][kk] : p.in[I_C][(size_t)(ci - 1) * DM + kk]; }
#pragma unroll
        for (int k = 0; k < 12; ++k) s_cond[i0 + 512 * k] = silu_f(cv[k]);
    }
    __syncthreads();
    float* modv = WSP(float, WS_MODV);
    const int cg = tid % MOD_CG, ks = tid / MOD_CG;
    for (int jt = first; jt < MOD_NT; jt += stride) {
        if (ks < MOD_KS) {
            const float* w = p.in[I_WMOD] + (size_t)l * DM * NMOD + (size_t)(ks * MOD_KR) * NMOD + jt * MOD_TC + cg * 4;
            const float* sc = s_cond + ks * MOD_KR;
            vf4 acc[NCOND];
#pragma unroll
            for (int ci = 0; ci < NCOND; ++ci) acc[ci] = (vf4){0.f, 0.f, 0.f, 0.f};
            for (int k = 0; k < MOD_KR; k += 16) {
                vf4 wv[16];
#pragma unroll
                for (int j = 0; j < 16; ++j) wv[j] = *(const vf4*)(w + (size_t)(k + j) * NMOD);
#pragma unroll
                for (int j4 = 0; j4 < 4; ++j4)
#pragma unroll
                    for (int ci = 0; ci < NCOND; ++ci) {
                        const vf4 s = *(const vf4*)&sc[ci * DM + k + j4 * 4];
                        acc[ci] += s.x * wv[j4 * 4] + s.y * wv[j4 * 4 + 1] + s.z * wv[j4 * 4 + 2] + s.w * wv[j4 * 4 + 3];
                    }
            }
#pragma unroll
            for (int ci = 0; ci < NCOND; ++ci) *(vf4*)&s_red[((ks * MOD_CG + cg) * NCOND + ci) * 4] = acc[ci];
        }
        __syncthreads();
        for (int i = tid; i < MOD_TC * NCOND; i += 512) {
            const int c = i % MOD_TC, ci = i / MOD_TC, col = jt * MOD_TC + c;
            float sum = p.in[I_BMOD][(size_t)l * NMOD + col];
#pragma unroll
            for (int k2 = 0; k2 < MOD_KS; ++k2) sum += s_red[((k2 * MOD_CG + (c >> 2)) * NCOND + ci) * 4 + (c & 3)];
            modv[((size_t)l * NCOND + ci) * NMOD + col] = sum;
        }
        __syncthreads();
    }
}

__device__ __forceinline__ void phase_prologue(const Params& p, float* smem) {
    const int tid = threadIdx.x, nb = gridDim.x, bid = blockIdx.x;
    float* s_tile = smem;
#if CONV_FILLER
    mod_layer(p, 0, bid, nb, smem);
#ifdef PRO_DUP_MOD
    for (int r_ = 0; r_ < opaque_int(PRO_DUP_MOD); ++r_) mod_layer(p, 0, bid, nb, smem);
#endif
#else
    for (int l2 = 0; l2 < DEPTH; ++l2) mod_layer(p, l2, bid, nb, smem);
#endif
    conv_layer_tiles(p, 0, 0, CONV_FILLER ? CS_PRO : CS_END, bid, nb, s_tile);
#ifdef PRO_DUP_CONV
    for (int r_ = 0; r_ < opaque_int(PRO_DUP_CONV); ++r_) conv_layer_tiles(p, 0, 0, CS_PRO, bid, nb, s_tile);
#endif
#if !CONV_FILLER
#endif
    const size_t gtid = (size_t)bid * 512 + tid, gstride = (size_t)nb * 512;
    {
        const size_t n_na = (size_t)LB * DEPTH * 256 * 512 / 8;
        for (size_t i = gtid; i < 2 * n_na; i += gstride) {
            const bool isv = i >= n_na; const size_t j = isv ? i - n_na : i;
            const int d8 = (int)(j % 16), h = (int)((j / 16) % 4), t = (int)((j / 64) % 256); const size_t bl = j / (64 * 256);
            const float* s = p.in[isv ? I_CNAV : I_CNAK] + ((bl * 4 + h) * 256 + t) * 128 + d8 * 8;
            const float4 a = *(const float4*)s, b = *(const float4*)(s + 4);
            uint4 w; w.x = pack2(a.x, a.y); w.y = pack2(a.z, a.w); w.z = pack2(b.x, b.y); w.w = pack2(b.z, b.w);
            *(uint4*)(WSP(bf16_t, isv ? WS_CNAV : WS_CNAK) + (bl * 256 + t) * 512 + h * 128 + d8 * 8) = w;
        }
        const size_t n_g = (size_t)LB * DEPTH * 256 * 256 / 8;
        for (size_t i = gtid; i < 2 * n_g; i += gstride) {
            const bool isv = i >= n_g; const size_t j = isv ? i - n_g : i;
            const int d8 = (int)(j % 16), h = (int)((j / 16) % 2), t = (int)((j / 32) % 256); const size_t bl = j / (32 * 256);
            const float* s = p.in[isv ? I_CGV : I_CGK] + ((bl * 2 + h) * 256 + t) * 128 + d8 * 8;
            const float4 a = *(const float4*)s, b = *(const float4*)(s + 4);
            uint4 w; w.x = pack2(a.x, a.y); w.y = pack2(a.z, a.w); w.z = pack2(b.x, b.y); w.w = pack2(b.z, b.w);
            *(uint4*)(WSP(bf16_t, isv ? WS_CGV : WS_CGK) + (bl * 256 + t) * 256 + h * 128 + d8 * 8) = w;
        }
    }
    for (size_t i = gtid; i < 64 * 32; i += gstride) {
        const int pos = (int)(i / 32), k = (int)(i % 32);
        const float inv = powf(10000.0f, -(float)(2 * k) / 64.0f);
        const float ang = (float)pos * inv;
        WSP(float, WS_ROPE)[i] = cosf(ang); WSP(float, WS_ROPE)[64 * 32 + i] = sinf(ang);
    }
}

#ifndef NORM_NR
#define NORM_NR 2
#endif
constexpr int NORM_MAXC = 6;
__device__ __forceinline__ void phase_norm(const Params& p, int l, int which  , unsigned char* lds) {
    const int tid = opaque_tid(), lane = tid & 63, wv = tid >> 6;
    const float* X = WSP(float, WS_X); bf16_t* H = WSP(bf16_t, WS_H);
    const bool from_in = (l == 0 && which == 0);
    const float* g = p.in[I_NORMG] + ((size_t)l * 3 + which) * DM;
    const int rpb = (M + (int)gridDim.x - 1) / (int)gridDim.x;
    const int r0 = (int)blockIdx.x * rpb, r1 = r0 + rpb < M ? r0 + rpb : M;
    if (r0 >= r1) return;
    const int c_lo = cond_of_row(r0), c_hi = cond_of_row(r1 - 1);
    float* sw = (float*)lds;
    for (int ci = 0; ci <= c_hi - c_lo && ci < NORM_MAXC; ++ci) {
        const float* mv = WSP(float, WS_MODV) + ((size_t)l * NCOND + c_lo + ci) * NMOD + (size_t)which * 3 * DM;
        const int c = tid * 4;
        const vf4 gg = *(const vf4*)(g + c), sh = *(const vf4*)(mv + c), sc = *(const vf4*)(mv + DM + c);
        *(vf4*)(sw + (size_t)ci * 2 * DM + c) = gg * (1.f + sc);
        *(vf4*)(sw + (size_t)ci * 2 * DM + DM + c) = sh;
    }
    __syncthreads();
    for (int m0 = r0 + wv; m0 < r1; m0 += NORM_NR * 8) {
        int mm[NORM_NR]; bool has[NORM_NR];
#pragma unroll
        for (int k = 0; k < NORM_NR; ++k) { has[k] = m0 + k * 8 < r1; mm[k] = has[k] ? m0 + k * 8 : m0; }
        vf4 v[NORM_NR][8]; float ss[NORM_NR];
#pragma unroll
        for (int k = 0; k < NORM_NR; ++k) {
            const int m = mm[k];
            if (from_in || !XBF16) {
                const float* x = !from_in ? X + (size_t)m * DM : m < MC ? p.in[I_XP] + (size_t)m * DM : p.in[I_XS] + (size_t)(m - MC) * DM;
#pragma unroll
                for (int i = 0; i < 8; ++i) v[k][i] = *(const vf4*)(x + (i * 64 + lane) * 4);
            } else {
                const bf16_t* x = (const bf16_t*)X + (size_t)m * DM;
#pragma unroll
                for (int i = 0; i < 8; ++i) v[k][i] = ld4bf(x + (i * 64 + lane) * 4);
            }
        }
#pragma unroll
        for (int k = 0; k < NORM_NR; ++k) {
            ss[k] = 0.f;
#pragma unroll
            for (int i = 0; i < 8; ++i) ss[k] += v[k][i].x * v[k][i].x + v[k][i].y * v[k][i].y + v[k][i].z * v[k][i].z + v[k][i].w * v[k][i].w;
            ss[k] = wave_sum(ss[k]);
        }
#pragma unroll
        for (int k = 0; k < NORM_NR; ++k) {
            if (k > 0 && !has[k]) break;
            const int m = mm[k];
            const float* a = sw + (size_t)(cond_of_row(m) - c_lo) * 2 * DM;
            const float r = rsqrt_fast(ss[k] * (1.0f / DM) + EPS);
#pragma unroll
            for (int i = 0; i < 8; ++i) {
                const int c = (i * 64 + lane) * 4;
                const vf4 o = v[k][i] * r * *(const vf4*)(a + c) + *(const vf4*)(a + DM + c);
                if (which == 1 ? (G3_FP8 != 0) : g1_fp8(l, which >> 1)) *(unsigned*)((unsigned char*)H + (size_t)m * DM + c) = pack4_fp8(o.x, o.y, o.z, o.w);
                else { uint2 w; w.x = pack2(o.x, o.y); w.y = pack2(o.z, o.w); *(uint2*)(H + (size_t)m * DM + c) = w; }
            }
            if (G2_FP8 && which != 1 && lane < (FFP - FF) / 4) *(unsigned*)(WSP(unsigned char, WS_ACT) + (size_t)m * FFP + FF + 4 * lane) = 0u;
        }
    }
}

__device__ __forceinline__ float red16(float v);
__device__ __forceinline__ float ssq8(vf4 a, vf4 b) { const vf4 s = a * a + b * b; return (s.x + s.y) + (s.z + s.w); }
__device__ __forceinline__ uint4 pack8(vf4 a, vf4 b) { uint4 w; w.x = pack2(a.x, a.y); w.y = pack2(a.z, a.w); w.z = pack2(b.x, b.y); w.w = pack2(b.z, b.w); return w; }
constexpr int PL_CW = 0, PL_UP = PL_CW + 5 * 1536, PL_GB = PL_UP + 2 * 16 * 256, PL_NQ = PL_GB + 512, PL_ROPE = PL_NQ + 512, PL_END = PL_ROPE + 2 * 64 * 32;
__device__ __forceinline__ void phase_prep(const Params& p, int l, unsigned char* lds) {
    const int tid = opaque_tid(), lane = tid & 63, wv = tid >> 6, rg = lane >> 4, sub = lane & 15, c8 = sub * 8;
    const bf16_t* Z = WSP(bf16_t, WS_Z);
    float* sw = (float*)lds;
    {
        float cv[15]; vf4 uv[4], rv[2];
#pragma unroll
        for (int k = 0; k < 15; ++k) cv[k] = p.in[I_CONV][(size_t)l * 5 * 1536 + tid + 512 * k];
#pragma unroll
        for (int k = 0; k < 4; ++k) uv[k] = ((const vf4*)(p.in[I_GUP] + (size_t)l * 2 * 16 * 256))[tid + 512 * k];
        const float gb = p.in[I_GBIAS][(size_t)l * 512 + tid];
        const int v = tid >> 7, c = tid & 127; const float nq = ((v < 2 ? p.in[I_NAQKN] : p.in[I_GQAQKN]) + ((size_t)l * 2 + (v & 1)) * 128)[c];
#pragma unroll
        for (int k = 0; k < 2; ++k) rv[k] = ((const vf4*)WSP(float, WS_ROPE))[tid + 512 * k];
#pragma unroll
        for (int k = 0; k < 15; ++k) { const int i = tid + 512 * k, j = i / 1536, col = i % 1536; sw[PL_CW + j * 1536 + ((col >> 2) & 1) * 768 + (col >> 3) * 4 + (col & 3)] = cv[k]; }
#pragma unroll
        for (int k = 0; k < 4; ++k) ((vf4*)(sw + PL_UP))[tid + 512 * k] = uv[k];
        sw[PL_GB + tid] = gb;
        sw[PL_NQ + v * 128 + ((c >> 2) & 1) * 64 + (c >> 3) * 4 + (c & 3)] = nq;
#pragma unroll
        for (int k = 0; k < 2; ++k) ((vf4*)(sw + PL_ROPE))[tid + 512 * k] = rv[k];
    }
    __syncthreads();
    const float* ropec = sw + PL_ROPE; const float* ropes = ropec + 64 * 32;
    const float* wnq = sw + PL_NQ + sub * 4; const float* wnk = wnq + 128;
    const float* wgq = wnq + 256; const float* wgk = wnq + 384;
    const float* cw = sw + PL_CW + (rg * 16 + sub) * 4;
    const int rpw = (M + (int)gridDim.x * 8 - 1) / ((int)gridDim.x * 8);
    for (int m = ((int)blockIdx.x * 8 + wv) * rpw, mend = (m + rpw < M ? m + rpw : M); m < mend; ++m) {
        const bf16_t* z = Z + (size_t)m * NINP;
        const bool ctx = m < MC;
        const int b = ctx ? m / CT : (m - MC) / LT, t = ctx ? m % CT : (m - MC) % LT, T = ctx ? CT : LT;
        const int ho = rg * 128 + c8;
        uint4 rz[5]; uint2 rgz[2][4];
        {
            const bf16_t* zkv = z + (rg < 2 ? Z_GQK + rg * 128 : Z_GQV + (rg - 2) * 128) + c8;
            rz[0] = *(const uint4*)(z + Z_NAQ + ho); rz[1] = *(const uint4*)(z + Z_NAK + ho); rz[2] = *(const uint4*)(z + Z_NAV + ho); rz[3] = *(const uint4*)(z + Z_GQQ + ho); rz[4] = *(const uint4*)zkv;
#pragma unroll
            for (int dir = 0; dir < 2; ++dir)
#pragma unroll
                for (int r4 = 0; r4 < 4; ++r4) rgz[dir][r4] = *(const uint2*)(z + (dir ? Z_GB : Z_GF) + 4 * r4);
        }
        uint4 rcz[3][5];
#pragma unroll
        for (int part = 0; part < 3; ++part)
#pragma unroll
            for (int j = 0; j < 5; ++j) { const int tt = t + j - 2;
                rcz[part][j] = (tt >= 0 && tt < T) ? *(const uint4*)(Z + (size_t)(m + j - 2) * NINP + Z_DQKV + part * 512 + rg * 128 + c8) : make_uint4(0u, 0u, 0u, 0u); }
        asm volatile("" ::: "memory");
        {
            vf4 q0, q1, k0, k1, v0, v1, g0, g1, x0, x1;
            unp8bf(rz[0], q0, q1); unp8bf(rz[1], k0, k1); unp8bf(rz[2], v0, v1); unp8bf(rz[3], g0, g1); unp8bf(rz[4], x0, x1);
            float r = rsqrt_fast(red16(ssq8(q0, q1)) * (1.0f / 128) + EPS);
            q0 = q0 * r * *(const vf4*)wnq; q1 = q1 * r * *(const vf4*)(wnq + 64);
            *(uint4*)(WSP(bf16_t, WS_NAQ) + (size_t)m * 512 + ho) = pack8(q0, q1);
            r = rsqrt_fast(red16(ssq8(k0, k1)) * (1.0f / 128) + EPS);
            k0 = k0 * r * *(const vf4*)wnk; k1 = k1 * r * *(const vf4*)(wnk + 64);
            *(uint4*)(WSP(bf16_t, WS_NAK) + (size_t)m * 512 + ho) = pack8(k0, k1);
            *(uint4*)(WSP(bf16_t, WS_NAV) + (size_t)m * 512 + ho) = pack8(v0, v1);
            if (ctx) {
                const size_t o = ((((size_t)b * DEPTH + l) * 4 + rg) * CT + t) * 128 + c8;
                *(vf4*)(p.out + O_NAK + o) = k0; *(vf4*)(p.out + O_NAK + o + 4) = k1; *(vf4*)(p.out + O_NAV + o) = v0; *(vf4*)(p.out + O_NAV + o + 4) = v1;
            }
            r = rsqrt_fast(red16(ssq8(g0, g1)) * (1.0f / 128) + EPS);
            g0 = g0 * r * *(const vf4*)wgq; g1 = g1 * r * *(const vf4*)(wgq + 64);
            const float rk = rsqrt_fast(red16(ssq8(x0, x1)) * (1.0f / 128) + EPS);
            if (rg < 2) { x0 = x0 * rk * *(const vf4*)wgk; x1 = x1 * rk * *(const vf4*)(wgk + 64); }
            if (!ctx) {
                const int pos = sub < 8 ? (t >> 6) : (t & 63), ai = pos * 32 + (c8 & 31);
                const vf4 c0 = *(const vf4*)(ropec + ai), c1 = *(const vf4*)(ropec + ai + 4), s0 = *(const vf4*)(ropes + ai), s1 = *(const vf4*)(ropes + ai + 4);
                const bool hi = (sub & 4) != 0;
                vf4 pg0, pg1, px0, px1;
#pragma unroll
                for (int j = 0; j < 4; ++j) { pg0[j] = __shfl_xor(g0[j], 4); pg1[j] = __shfl_xor(g1[j], 4); px0[j] = __shfl_xor(x0[j], 4); px1[j] = __shfl_xor(x1[j], 4); }
                g0 = hi ? pg0 * s0 + g0 * c0 : g0 * c0 - pg0 * s0; g1 = hi ? pg1 * s1 + g1 * c1 : g1 * c1 - pg1 * s1;
                if (rg < 2) { x0 = hi ? px0 * s0 + x0 * c0 : x0 * c0 - px0 * s0; x1 = hi ? px1 * s1 + x1 * c1 : x1 * c1 - px1 * s1; }
            }
            *(uint4*)(WSP(bf16_t, WS_GQ) + (size_t)m * 512 + ho) = pack8(g0, g1);
            *(uint4*)(WSP(bf16_t, rg < 2 ? WS_GK : WS_GV) + (size_t)m * 256 + (rg & 1) * 128 + c8) = pack8(x0, x1);
            if (ctx) {
                const size_t o = ((((size_t)b * DEPTH + l) * 2 + (rg & 1)) * CT + t) * 128 + c8;
                float* dst = p.out + (rg < 2 ? O_GK : O_GV) + o;
                *(vf4*)dst = x0; *(vf4*)(dst + 4) = x1;
            }
        }
        asm volatile("" ::: "memory");
        {
#pragma unroll
            for (int dir = 0; dir < 2; ++dir) {
                const float* up = sw + PL_UP + dir * 16 * 256 + 4 * lane;
                vf4 acc = *(const vf4*)(sw + PL_GB + dir * 256 + 4 * lane);
#pragma unroll
                for (int r4 = 0; r4 < 4; ++r4) {
                    const vf4 gv = unp4bf(rgz[dir][r4]);
                    acc += gv.x * *(const vf4*)(up + (4 * r4 + 0) * 256) + gv.y * *(const vf4*)(up + (4 * r4 + 1) * 256) + gv.z * *(const vf4*)(up + (4 * r4 + 2) * 256) + gv.w * *(const vf4*)(up + (4 * r4 + 3) * 256);
                }
                vf4 o;
#pragma unroll
                for (int j = 0; j < 4; ++j) o[j] = logsigmoid_fast(acc[j]) * (1.0f / 16.0f);
                *(vf4*)(WSP(float, dir ? WS_AB : WS_AF) + (size_t)m * 256 + 4 * lane) = o;
            }
        }
        asm volatile("" ::: "memory");
        {
#pragma unroll
            for (int part = 0; part < 3; ++part) {
                vf4 a0 = (vf4){0.f, 0.f, 0.f, 0.f}, a1 = a0;
#pragma unroll
                for (int j = 0; j < 5; ++j) {
                    const float* cj = cw + j * 1536 + part * 256;
                    vf4 z0, z1; unp8bf(rcz[part][j], z0, z1);
                    a0 += *(const vf4*)cj * z0; a1 += *(const vf4*)(cj + 768) * z1;
                }
#pragma unroll
                for (int j = 0; j < 4; ++j) { a0[j] = silu_fast(a0[j]); a1[j] = silu_fast(a1[j]); }
                if (part < 2) { const float r = rsqrt_fast(red16(ssq8(a0, a1)) + EPS) * (part == 0 ? 0.08838834764831845f : 1.0f); a0 *= r; a1 *= r; }
                *(uint4*)(WSP(bf16_t, part == 0 ? WS_DQ : part == 1 ? WS_DK : WS_DV) + (size_t)m * 512 + rg * 128 + c8) = pack8(a0, a1);
                asm volatile("" ::: "memory");
            }
            if (lane < 8) {
                const float beta = 1.0f / (1.0f + expf(-bf2f(z[Z_DB + lane])));
                const float g = -expf(p.in[I_ALOG][(size_t)l * 8 + lane]) * softplus_f(bf2f(z[Z_DA + lane]) + p.in[I_DTB][(size_t)l * 8 + lane]);
                float* ba = WSP(float, WS_DBA) + (size_t)m * 16;
                ba[lane] = beta; ba[8 + lane] = g;
            }
        }
    }
}

typedef float vf2 __attribute__((ext_vector_type(2)));
__device__ __forceinline__ float dpp_f(float v, const int ctrl) { return v; }
#define DPPF(v, ctrl) __int_as_float(__builtin_amdgcn_mov_dpp(__float_as_int(v), (ctrl), 0xF, 0xF, true))
__device__ __forceinline__ float red8(float v) { v += DPPF(v, 0xB1); v += DPPF(v, 0x4E); v += DPPF(v, 0x141); return v; }
__device__ __forceinline__ float red16(float v) { v = red8(v); v += DPPF(v, 0x140); return v; }

__device__ __forceinline__ void phase_post(const Params& p, int l) {
    const int tid = opaque_tid(), lane = tid & 63, wv = tid >> 6, rg = lane >> 4, c8 = (lane & 15) * 8;
    const bf16_t* Z = WSP(bf16_t, WS_Z); bf16_t* MRG = WSP(bf16_t, WS_MRG);
    const float* wgp = p.in[I_GLAON] + (size_t)l * 128 + c8; const float* wdp = p.in[I_GDNON] + (size_t)l * 128 + c8;
    const vf4 wg0 = *(const vf4*)wgp, wg1 = *(const vf4*)(wgp + 4), wd0 = *(const vf4*)wdp, wd1 = *(const vf4*)(wdp + 4);
    const int ho = rg * 128 + c8, nw = (int)gridDim.x * 8;
    for (int m0 = blockIdx.x * 8 + wv; m0 < M; m0 += 2 * nw) {
        const bool has1 = m0 + nw < M; const int mm[2] = {m0, has1 ? m0 + nw : m0};
        uint4 rf[2][2], rb[2][2], rz[2][2];
#pragma unroll
        for (int k = 0; k < 2; ++k)
#pragma unroll
            for (int g = 0; g < 2; ++g) {
                const size_t o = (size_t)mm[k] * 512 + ho;
                rf[k][g] = *(const uint4*)(WSP(bf16_t, g ? WS_DOF : WS_GOF) + o); rb[k][g] = *(const uint4*)(WSP(bf16_t, g ? WS_DOB : WS_GOB) + o);
                rz[k][g] = *(const uint4*)(Z + (size_t)mm[k] * NINP + (g ? Z_DZ : Z_GLR) + ho);
            }
        asm volatile("" ::: "memory");
#pragma unroll
        for (int k = 0; k < 2; ++k) {
            if (k == 1 && !has1) break;
#pragma unroll
            for (int g = 0; g < 2; ++g) {
                vf4 a0, a1, b0, b1, g0, g1; unp8bf(rf[k][g], a0, a1); unp8bf(rb[k][g], b0, b1); unp8bf(rz[k][g], g0, g1); a0 += b0; a1 += b1;
                const float r = rsqrt_fast(red16(ssq8(a0, a1)) * (1.0f / 128) + EPS);
                a0 = a0 * r * (g ? wd0 : wg0); a1 = a1 * r * (g ? wd1 : wg1);
#pragma unroll
                for (int j = 0; j < 4; ++j) { a0[j] *= silu_fast(g0[j]); a1[j] *= silu_fast(g1[j]); }
                *(uint4*)(MRG + (size_t)mm[k] * DM + (g ? 1536 : 512) + ho) = pack8(a0, a1);
            }
        }
    }
}
#define XB_TMO      128
#define XB_XCNT(j)  (256  + 64 * (j))
#define XB_XSUB(j)  (1280 + 64 * (j))
#define XB_XGEN(j)  (2304 + 64 * (j))
#define XB_TOP      3328
#define XB_TOPGEN   3392
#define XCD_BAR_WORDS 3456
#define XB_SPIN_CAP (1u << 22)
#define LAS __attribute__((address_space(3)))

__device__ __forceinline__ unsigned xb_ld(unsigned* p)              { return __hip_atomic_load(p, __ATOMIC_RELAXED, __HIP_MEMORY_SCOPE_AGENT); }
__device__ __forceinline__ unsigned xb_add(unsigned* p, unsigned v) { return __hip_atomic_fetch_add(p, v, __ATOMIC_RELAXED, __HIP_MEMORY_SCOPE_AGENT); }
__device__ __forceinline__ unsigned xb_xcc_id() { return (unsigned)__builtin_amdgcn_s_getreg((3 << 11) | 20) & 0xFu; }
#define XB_SPIN(cond, bar) do { unsigned _sp = 0; while (cond) { __builtin_amdgcn_s_sleep(1); \
    if ((++_sp & 255u) == 0u) { if (xb_ld(&(bar)[XB_TMO])) break; if (_sp > XB_SPIN_CAP) { atomicAdd(&(bar)[XB_TMO], 1u); break; } } } } while (0)

struct XcdBarrier {
    unsigned* bar; unsigned x;
    volatile LAS unsigned* st;
};

__device__ __forceinline__ XcdBarrier xcd_barrier_post(unsigned* bar, volatile LAS unsigned* st) {
    XcdBarrier b; b.bar = bar; b.x = xb_xcc_id(); b.st = st;
    if (threadIdx.x == 0) (void)xb_add(&bar[XB_XCNT(b.x)], 1u);
    return b;
}
__device__ __forceinline__ void xcd_barrier_complete(unsigned* bar, unsigned x, unsigned& nloc, unsigned& nx) {
    const unsigned G = gridDim.x * gridDim.y * gridDim.z;
    unsigned sum, cnt, mine, sp = 0u;
    for (;;) {
        sum = 0u; cnt = 0u; mine = 0u;
#pragma unroll
        for (unsigned j = 0; j < 16; ++j) { const unsigned c = xb_ld(&bar[XB_XCNT(j)]); sum += c; cnt += (c > 0u) ? 1u : 0u; mine = (j == x) ? c : mine; }
        if (sum == G) break;
        __builtin_amdgcn_s_sleep(1);
        if ((++sp & 255u) == 0u) { if (xb_ld(&bar[XB_TMO])) break; if (sp > XB_SPIN_CAP) { atomicAdd(&bar[XB_TMO], 1u); break; } }
    }
    nloc = mine > 0u ? mine : 1u; nx = cnt > 0u ? cnt : 1u;
}

__device__ __forceinline__ void xcd_barrier(const XcdBarrier& b) {
    asm volatile("s_waitcnt vmcnt(0)" ::: "memory");
    __syncthreads();
    if (threadIdx.x == 0) {
        unsigned* bar = b.bar;
        __builtin_amdgcn_s_waitcnt(0);
        unsigned nloc = b.st[0], nx = b.st[1];
        if (nloc == 0u) { xcd_barrier_complete(bar, b.x, nloc, nx); b.st[0] = nloc; b.st[1] = nx; }
        const unsigned old = xb_add(&bar[XB_XSUB(b.x)], 1u);
        const unsigned gen = old / nloc;
        if (old + 1u == (gen + 1u) * nloc) {
            __builtin_amdgcn_fence(__ATOMIC_RELEASE, "agent");
            asm volatile("s_waitcnt vmcnt(0)" ::: "memory");
            const unsigned og = xb_add(&bar[XB_TOP], 1u);
            const unsigned tg = og / nx;
            if (og + 1u == (tg + 1u) * nx) xb_add(&bar[XB_TOPGEN], 1u);
            else XB_SPIN(xb_ld(&bar[XB_TOPGEN]) == tg, bar);
            __builtin_amdgcn_fence(__ATOMIC_ACQUIRE, "agent");
            xb_add(&bar[XB_XGEN(b.x)], 1u);
            asm volatile("s_waitcnt vmcnt(0)" ::: "memory");
        } else {
            XB_SPIN(xb_ld(&bar[XB_XGEN(b.x)]) == gen, bar);
            __builtin_amdgcn_fence(__ATOMIC_ACQUIRE, "agent");
            asm volatile("s_waitcnt vmcnt(0)" ::: "memory");
        }
    }
    __syncthreads();
}

#ifndef NT_STORES
#define NT_STORES 0
#endif
namespace pg8 {
#define PG8_LAS __attribute__((address_space(3)))
typedef unsigned short bf16_t;
typedef short bf16x8 __attribute__((ext_vector_type(8)));
typedef float f32x4 __attribute__((ext_vector_type(4)));
typedef unsigned u32x4 __attribute__((ext_vector_type(4)));
typedef unsigned u32x2 __attribute__((ext_vector_type(2)));
typedef int v4i32 __attribute__((ext_vector_type(4)));
typedef int v8i32 __attribute__((ext_vector_type(8)));
constexpr int BM = 256, BK = 64, HALF = 128, HTB = HALF * BK * 2  , STAGE_BYTES = 8 * HTB, NXCD = 8, WGM = 8;

__host__ __device__ __forceinline__ int lds_byte(int r, int c) { const int st = (r >> 4) * 2 + (c >> 5), rr = r & 15, cc = c & 31, ob = rr * 64 + cc * 2; return st * 1024 + (ob ^ (((ob >> 9) & 1) << 5)); }
__host__ __device__ __forceinline__ void stage_rc(int b, int& R, int& C) { const int st = b / 1024, sb = b % 1024, swz = sb ^ (((sb >> 9) & 1) << 5); R = (st >> 1) * 16 + swz / 64; C = (st & 1) * 32 + (swz % 64) / 2; }
__host__ __device__ __forceinline__ int perm32(int rho) { const int n = rho >> 4, i = rho & 15; return 8 * (i >> 2) + 4 * n + (i & 3); }

struct Unit { int pm, pn, k0, nt, at, slot, msk; };
struct Gemm { const bf16_t* A; const bf16_t* Bt; int M, N, K; };

struct StaticOrder {
    int nM, nN, nwg, G, c, ntk, split, msplit;
    __host__ __device__ void init(int M, int N, int K, int G_, int c_, int split_ = 0) { nM = M / BM; nN = N / BM; nwg = nM * nN; G = G_; c = c_; ntk = K / BK; const int rem = nwg % G_; split = (split_ == 1 && rem > 0 && 2 * rem == G_ && ntk >= 8) ? 1 : 0; msplit = (split_ == 2 && rem > 0 && 2 * rem <= G_) ? 1 : 0; }
    __host__ __device__ bool next(int i, Unit& u) const {
        long L = (long)i * G + c; u.k0 = 0; u.nt = ntk; u.at = 0; u.slot = 0; u.msk = 3;
        if (msplit && i == nwg / G) { const int rem = nwg % G; if (c >= 2 * rem) return false; L = (long)i * G + (c % rem); u.msk = (c / rem) ? 2 : 1; }
        if (split && i == nwg / G) { const int rem = nwg % G, sl = c / rem, h0 = ((ntk / 2) + 1) & ~1; L = (long)i * G + (c % rem); u.k0 = sl ? h0 * BK : 0; u.nt = sl ? ntk - h0 : h0; u.at = sl ? 1 : 2; u.slot = c % rem; }
        if (L >= nwg) return false;
        int wgid = (int)L; { const int q = nwg / NXCD, r = nwg % NXCD, xcd = wgid % NXCD, off = wgid / NXCD; wgid = (xcd < r ? xcd * (q + 1) : r * (q + 1) + (xcd - r) * q) + off; }
        const int nig = WGM * nN, gid = wgid / nig, fm = gid * WGM, gsz = (nM - fm) < WGM ? (nM - fm) : WGM;
        u.pm = fm + ((wgid % nig) % gsz); u.pn = (wgid % nig) / gsz; return true;
    }
    __device__ __forceinline__ void a_ready(const Unit&) const {}
    __device__ __forceinline__ void done(const Unit&) const {}
};
__device__ __forceinline__ unsigned cvt_pk_bf16(float lo, float hi) { unsigned r; asm volatile("v_cvt_pk_bf16_f32 %0, %1, %2" : "=v"(r) : "v"(lo), "v"(hi)); return r; }
struct EpiF32 {
    static constexpr bool PERM = false, AFTER_DRAIN = false;
    float* C; int ldc; const float* bias;
    __device__ __forceinline__ void operator()(const f32x4 (&acc)[2][2][4][2], const Unit& u, int wr, int wc, int fr, int fq) const {
        const int row0 = u.pm * BM + wr * 64 + fr, col0 = u.pn * BM + wc * 32 + 4 * fq;
        f32x4 bv[2][2];
#pragma unroll
        for (int bj = 0; bj < 2; ++bj)
#pragma unroll
            for (int n = 0; n < 2; ++n) bv[bj][n] = bias ? *(const f32x4*)(bias + col0 + bj * HALF + n * 16) : (f32x4){0.f, 0.f, 0.f, 0.f};
#pragma unroll
        for (int ai = 0; ai < 2; ++ai)
#pragma unroll
            for (int m = 0; m < 4; ++m) { float* rowp = C + (size_t)(row0 + ai * HALF + m * 16) * ldc + col0;
#pragma unroll
                for (int bj = 0; bj < 2; ++bj)
#pragma unroll
                    for (int n = 0; n < 2; ++n) *(f32x4*)(rowp + bj * HALF + n * 16) = acc[ai][bj][m][n] + bv[bj][n]; }
    }
};

struct EpiSwiGLU {
    static constexpr bool PERM = true, AFTER_DRAIN = false;
    bf16_t* O; int ldc;
    __device__ __forceinline__ void operator()(const f32x4 (&acc)[2][2][4][2], const Unit& u, int wr, int wc, int fr, int fq) const {
        const int row0 = u.pm * BM + wr * 64 + fr, col0 = u.pn * 128 + wc * 32 + 8 * fq;
#pragma unroll
        for (int ai = 0; ai < 2; ++ai) if ((u.msk >> ai) & 1)
#pragma unroll
            for (int m = 0; m < 4; ++m) { bf16_t* rowp = O + (size_t)(row0 + ai * HALF + m * 16) * ldc + col0;
                const f32x4 g0 = acc[ai][0][m][0], g1 = acc[ai][0][m][1], u0 = acc[ai][1][m][0], u1 = acc[ai][1][m][1];
                float r[8];
#pragma unroll
                for (int j = 0; j < 4; ++j) {
                    r[j]     = g0[j] * __builtin_amdgcn_rcpf(1.0f + __builtin_amdgcn_exp2f(-1.4426950408889634f * g0[j])) * u0[j];
                    r[4 + j] = g1[j] * __builtin_amdgcn_rcpf(1.0f + __builtin_amdgcn_exp2f(-1.4426950408889634f * g1[j])) * u1[j]; }
                u32x4 w; w.x = cvt_pk_bf16(r[0], r[1]); w.y = cvt_pk_bf16(r[2], r[3]); w.z = cvt_pk_bf16(r[4], r[5]); w.w = cvt_pk_bf16(r[6], r[7]);
#if NT_STORES
                __builtin_nontemporal_store(w, (u32x4*)rowp);
#else
                *(u32x4*)rowp = w;
#endif
                }
    }
};
struct EpiSwiGLU8 {
    static constexpr bool PERM = true, AFTER_DRAIN = false;
    static constexpr int NST = 4; static constexpr bool NST_PER_HALF = true;
    unsigned char* O; int ldc; float wscale;
    __device__ __forceinline__ void operator()(const f32x4 (&acc)[2][2][4][2], const Unit& u, int wr, int wc, int fr, int fq) const {
        const int row0 = u.pm * BM + wr * 64 + fr, col0 = u.pn * 128 + wc * 32 + 8 * fq;
#pragma unroll
        for (int ai = 0; ai < 2; ++ai) if ((u.msk >> ai) & 1)
#pragma unroll
            for (int m = 0; m < 4; ++m) { unsigned char* rowp = O + (size_t)(row0 + ai * HALF + m * 16) * ldc + col0;
                f32x4 g0 = acc[ai][0][m][0], g1 = acc[ai][0][m][1], u0 = acc[ai][1][m][0], u1 = acc[ai][1][m][1];
                asm volatile("" : "+v"(g0), "+v"(g1), "+v"(u0), "+v"(u1));
                g0 *= wscale; g1 *= wscale; u0 *= wscale; u1 *= wscale;
                float r[8];
#pragma unroll
                for (int j = 0; j < 4; ++j) {
                    r[j]     = g0[j] * __builtin_amdgcn_rcpf(1.0f + __builtin_amdgcn_exp2f(-1.4426950408889634f * g0[j])) * u0[j];
                    r[4 + j] = g1[j] * __builtin_amdgcn_rcpf(1.0f + __builtin_amdgcn_exp2f(-1.4426950408889634f * g1[j])) * u1[j]; }
                uint2 w; w.x = pack4_fp8(r[0], r[1], r[2], r[3]); w.y = pack4_fp8(r[4], r[5], r[6], r[7]);
                *(uint2*)rowp = w; asm volatile("" ::: "memory"); }
    }
};
struct EpiBf16Plain {
    static constexpr bool PERM = true, AFTER_DRAIN = false;
    static constexpr int NST = 8; static constexpr bool NST_PER_HALF = true;
    bf16_t* O; int ldc; float coef;
    __device__ __forceinline__ void operator()(const f32x4 (&acc)[2][2][4][2], const Unit& u, int wr, int wc, int fr, int fq) const {
        const int row0 = u.pm * BM + wr * 64 + fr, col0 = u.pn * BM + wc * 32 + 8 * fq;
#pragma unroll
        for (int ai = 0; ai < 2; ++ai) if ((u.msk >> ai) & 1)
#pragma unroll
            for (int m = 0; m < 4; ++m) { bf16_t* rowp = O + (size_t)(row0 + ai * HALF + m * 16) * ldc + col0;
#pragma unroll
                for (int bj = 0; bj < 2; ++bj) { const f32x4 v0 = acc[ai][bj][m][0] * coef, v1 = acc[ai][bj][m][1] * coef;
                    u32x4 w; w.x = pack2(v0[0], v0[1]); w.y = pack2(v0[2], v0[3]); w.z = pack2(v1[0], v1[1]); w.w = pack2(v1[2], v1[3]);
                    *(u32x4*)(rowp + bj * HALF) = w; } }
    }
};
struct EpiResid {
    static constexpr bool PERM = false, AFTER_DRAIN = false;
    static constexpr int NST = 16; static constexpr bool NST_PER_HALF = false;
    const float* res; float* out; int ldc; const float* gate0; float coef;
    float* slab; unsigned* flags; unsigned target;
    const float* res_hi; int row_hi;
    int res_bf16, out_bf16;
    __device__ __forceinline__ void operator()(const f32x4 (&acc)[2][2][4][2], const Unit& u, int wr, int wc, int fr, int fq) const {
        const int tidx = ((wr * 4 + wc) * 4 + fq) * 16 + fr;
        if (u.at == 1) {
            const __amdgpu_buffer_rsrc_t rs = __builtin_amdgcn_make_buffer_rsrc((void*)slab, 0, 0x7FFFFFF0, 0x00020000);
            const unsigned base = ((unsigned)u.slot * 32u * 512u + (unsigned)tidx) * 16u;
#pragma unroll
            for (int ai = 0; ai < 2; ++ai)
#pragma unroll
                for (int bj = 0; bj < 2; ++bj)
#pragma unroll
                    for (int m = 0; m < 4; ++m)
#pragma unroll
                        for (int n = 0; n < 2; ++n) { const f32x4 v = acc[ai][bj][m][n]; u32x4 w; w.x = __float_as_uint(v[0]); w.y = __float_as_uint(v[1]); w.z = __float_as_uint(v[2]); w.w = __float_as_uint(v[3]);
                            __builtin_amdgcn_raw_buffer_store_b128(w, rs, base + (unsigned)((((ai * 2 + bj) * 4 + m) * 2 + n) * 512 * 16), 0, 16); }
            asm volatile("s_waitcnt vmcnt(0)" ::: "memory");
            if ((tidx & 63) == 0) __hip_atomic_fetch_add(flags + 64 * u.slot, 1u, __ATOMIC_RELAXED, __HIP_MEMORY_SCOPE_AGENT);
            return;
        }
        const float* part = nullptr;
        if (u.at == 2) {
            unsigned spins = 0;
            while (__hip_atomic_load(flags + 64 * u.slot, __ATOMIC_RELAXED, __HIP_MEMORY_SCOPE_AGENT) < target) { __builtin_amdgcn_s_sleep(2); if (++spins > (1u << 22)) break; }
            __builtin_amdgcn_fence(__ATOMIC_ACQUIRE, "agent");
            asm volatile("s_waitcnt vmcnt(0)" ::: "memory");
            part = slab + ((size_t)u.slot * 32 * 512 + tidx) * 4;
        }
        const int row0 = u.pm * BM + wr * 64 + fr, col0 = u.pn * BM + wc * 32 + 4 * fq;
        const float* gate = gate0 + (size_t)cond_of_row(u.pm * BM) * NMOD;
        const float* rbase = (u.pm * BM >= row_hi) ? res_hi - (size_t)row_hi * ldc : res;
        f32x4 gv[2][2];
#pragma unroll
        for (int bj = 0; bj < 2; ++bj)
#pragma unroll
            for (int n = 0; n < 2; ++n) gv[bj][n] = *(const f32x4*)(gate + col0 + bj * HALF + n * 16) * coef;
#pragma unroll
        for (int ai = 0; ai < 2; ++ai) if ((u.msk >> ai) & 1) {
            f32x4 bs[4][2][2];
#pragma unroll
            for (int m = 0; m < 4; ++m) { const size_t off = (size_t)(row0 + ai * HALF + m * 16) * ldc + col0;
#pragma unroll
                for (int bj = 0; bj < 2; ++bj)
#pragma unroll
                    for (int n = 0; n < 2; ++n) {
                        const size_t eo = off + bj * HALF + n * 16;
                        if (res_bf16) { const u32x2 w = *(const u32x2*)((const bf16_t*)rbase + eo); bs[m][bj][n][0] = __uint_as_float(w.x << 16); bs[m][bj][n][1] = __uint_as_float(w.x & 0xFFFF0000u); bs[m][bj][n][2] = __uint_as_float(w.y << 16); bs[m][bj][n][3] = __uint_as_float(w.y & 0xFFFF0000u); }
                        else bs[m][bj][n] = *(const f32x4*)(rbase + eo); } }
            asm volatile("" ::: "memory");
#pragma unroll
            for (int m = 0; m < 4; ++m) { const size_t off = (size_t)(row0 + ai * HALF + m * 16) * ldc + col0;
#pragma unroll
                for (int bj = 0; bj < 2; ++bj)
#pragma unroll
                    for (int n = 0; n < 2; ++n) {
                        f32x4 a = acc[ai][bj][m][n];
                        if (part) a += *(const f32x4*)(part + (size_t)((((ai * 2 + bj) * 4 + m) * 2 + n) * 512 * 4));
                        const size_t eo = off + bj * HALF + n * 16;
                        const f32x4 o = bs[m][bj][n] + gv[bj][n] * a;
                        if (out_bf16) { u32x2 w; w.x = cvt_pk_bf16(o[0], o[1]); w.y = cvt_pk_bf16(o[2], o[3]); *(u32x2*)((bf16_t*)out + eo) = w; }
                        else *(f32x4*)(out + eo) = o; } }
            asm volatile("" ::: "memory"); }
    }
};
template <class Epi, class Sched, bool STAMP = false, int FP8 = 0, bool GUARD = true, bool PRESTAGE = false>
__device__ __forceinline__ void gemm_phase(PG8_LAS unsigned char* lds, const Gemm g, const Sched& S, const Epi& E, unsigned long long* stamps) {
    const int tid = opaque_tid(), wid = __builtin_amdgcn_readfirstlane(tid >> 6), lane = tid & 63, wr = wid >> 2, wc = wid & 3, fr = lane & 15, fq = lane >> 4;
    const int K = g.K;
    int ts_lo = 0, ts_hi = 0, nts = 0; const unsigned long long rt_entry = STAMP ? (unsigned long long)wall_clock64() : 0ull;
#define PG8_STAMP() do { if (STAMP && wid == 0 && nts < 64) { const unsigned long long _c = (unsigned long long)clock64(); \
        ts_lo = (lane == nts) ? (int)(unsigned)_c : ts_lo; ts_hi = (lane == nts) ? (int)(unsigned)(_c >> 32) : ts_hi; ++nts; } } while (0)
    PG8_STAMP();
    unsigned voffA[2], voffB[2];
#pragma unroll
    for (int i = 0; i < 2; ++i) { int R, C; stage_rc(tid * 16 + i * 8192, R, C); const int Rb = Epi::PERM ? ((R & ~31) + perm32(R & 31)) : R;
        voffA[i] = (unsigned)(R * K + C) * 2u; voffB[i] = (unsigned)(Rb * K + C) * 2u; }
    const size_t kstep = (size_t)(BK * 2);
    const size_t hstep = (size_t)HALF * K * 2;
    const size_t tstep = 2 * hstep;
    const unsigned ldsw = (unsigned)wid * 1024u;
    const int aoff = lds_byte(wr * 64 + fr, fq * 8), boff = lds_byte(wc * 32 + fr, fq * 8);
#define PG8_SA(b, h) (((b) * 2 + (h)) * HTB)
#define PG8_SB(b, h) ((4 + (b) * 2 + (h)) * HTB)
#define PG8_STAGE(bufoff, gbase, voff) do { _Pragma("unroll") for (int _i = 0; _i < 2; ++_i) \
        __builtin_amdgcn_global_load_lds((const unsigned*)((const char*)(gbase) + (voff)[_i]), (PG8_LAS unsigned*)(lds + (bufoff) + ldsw + _i * 8192), 16, 0, 0); } while (0)
#define PG8_LDA(dst, b, h) do { _Pragma("unroll") for (int m = 0; m < 4; ++m) dst[m] = __builtin_shufflevector(*(const PG8_LAS v4i32*)(lds + PG8_SA(b, h) + aoff + m * 2048), *(const PG8_LAS v4i32*)(lds + PG8_SA(b, h) + aoff + m * 2048 + 1024), 0, 1, 2, 3, 4, 5, 6, 7); } while (0)
#define PG8_LDB(dst, b, h) do { _Pragma("unroll") for (int n = 0; n < 2; ++n) dst[n] = __builtin_shufflevector(*(const PG8_LAS v4i32*)(lds + PG8_SB(b, h) + boff + n * 2048), *(const PG8_LAS v4i32*)(lds + PG8_SB(b, h) + boff + n * 2048 + 1024), 0, 1, 2, 3, 4, 5, 6, 7); } while (0)
#define PG8_HALF(v, k) __builtin_bit_cast(bf16x8, __builtin_shufflevector(v, v, 4 * (k), 4 * (k) + 1, 4 * (k) + 2, 4 * (k) + 3))
#define PG8_MMA(ai, bj, At, Bt) do { __builtin_amdgcn_s_setprio(1); _Pragma("unroll") for (int m = 0; m < 4; ++m) _Pragma("unroll") for (int n = 0; n < 2; ++n) { \
        acc[ai][bj][m][n] = __builtin_amdgcn_mfma_f32_16x16x32_bf16(PG8_HALF(Bt[n], 0), PG8_HALF(At[m], 0), acc[ai][bj][m][n], 0, 0, 0); \
        acc[ai][bj][m][n] = __builtin_amdgcn_mfma_f32_16x16x32_bf16(PG8_HALF(Bt[n], 1), PG8_HALF(At[m], 1), acc[ai][bj][m][n], 0, 0, 0); } __builtin_amdgcn_s_setprio(0); } while (0)
#define PG8_MMA8(ai, bj, At, Bt) do { __builtin_amdgcn_s_setprio(1); _Pragma("unroll") for (int m = 0; m < 4; ++m) _Pragma("unroll") for (int n = 0; n < 2; ++n) \
        acc[ai][bj][m][n] = __builtin_amdgcn_mfma_scale_f32_16x16x128_f8f6f4(Bt[n], At[m], acc[ai][bj][m][n], 0, 0, 0, 127, 0, 127); __builtin_amdgcn_s_setprio(0); } while (0)
#define PG8_Q64(v, q) __builtin_bit_cast(long, __builtin_shufflevector(v, v, 2 * (q), 2 * (q) + 1))
#define PG8_M8L1(ai, bj, m, n, q) acc[ai][bj][m][n] = __builtin_amdgcn_mfma_f32_16x16x32_fp8_fp8(PG8_Q64(Bt_[n], q), PG8_Q64(At_[m], q), acc[ai][bj][m][n], 0, 0, 0)
#define PG8_MMA8L(ai, bj, At, Bt) do { auto& At_ = At; auto& Bt_ = Bt; __builtin_amdgcn_s_setprio(1); _Pragma("unroll") for (int m = 0; m < 4; ++m) _Pragma("unroll") for (int n = 0; n < 2; ++n) { \
        PG8_M8L1(ai, bj, m, n, 0); PG8_M8L1(ai, bj, m, n, 1); PG8_M8L1(ai, bj, m, n, 2); PG8_M8L1(ai, bj, m, n, 3); } __builtin_amdgcn_s_setprio(0); } while (0)
#define PG8_MMAG(ai, bj, At, Bt) do { if (!GUARD || (mrow & (1 << (ai)))) { if constexpr (FP8 == 1) PG8_MMA8(ai, bj, At, Bt); else if constexpr (FP8 == 2) PG8_MMA8L(ai, bj, At, Bt); else PG8_MMA(ai, bj, At, Bt); } } while (0)
#define PG8_WAIT_V(n) asm volatile("s_waitcnt vmcnt(" #n ")" ::: "memory")
#define PG8_WAIT_L(n) asm volatile("s_waitcnt lgkmcnt(" #n ")" ::: "memory")
#define PG8_BAR __builtin_amdgcn_s_barrier()
#define PG8_SCHED __builtin_amdgcn_sched_barrier(0)
    Unit cur, nxt; int ui = 0;
    if (!S.next(0, cur)) return;
    __builtin_amdgcn_s_waitcnt(0x0F70);
    f32x4 acc[2][2][4][2];
#pragma unroll
    for (int a = 0; a < 2; ++a)
#pragma unroll
        for (int b = 0; b < 2; ++b)
#pragma unroll
            for (int m = 0; m < 4; ++m)
#pragma unroll
                for (int n = 0; n < 2; ++n) acc[a][b][m][n] = (f32x4){0.f, 0.f, 0.f, 0.f};
    v8i32 At[4], B0[2], B1[2];
    const char* cA = (const char*)g.A + (size_t)cur.pm * tstep + (size_t)cur.k0 * 2; const char* cB = (const char*)g.Bt + (size_t)cur.pn * tstep + (size_t)cur.k0 * 2;
    S.a_ready(cur);
    PG8_STAGE(PG8_SB(0, 0), cB, voffB); PG8_STAGE(PG8_SA(0, 0), cA, voffA); PG8_STAGE(PG8_SB(0, 1), cB + hstep, voffB); PG8_STAGE(PG8_SA(0, 1), cA + hstep, voffA);
    if (wr == 1) PG8_BAR;
    PG8_WAIT_V(4); PG8_BAR;
    PG8_STAGE(PG8_SB(1, 0), cB + kstep, voffB); PG8_STAGE(PG8_SA(1, 0), cA + kstep, voffA); PG8_STAGE(PG8_SB(1, 1), cB + hstep + kstep, voffB);
    PG8_WAIT_V(6); PG8_BAR;
    PG8_STAMP();
    int pre_msk = 0;
    for (;;) {
        const bool has_next = S.next(ui + 1, nxt);
        const char* nA = has_next ? (const char*)g.A + (size_t)nxt.pm * tstep + (size_t)nxt.k0 * 2 : cA; const char* nB = has_next ? (const char*)g.Bt + (size_t)nxt.pn * tstep + (size_t)nxt.k0 * 2 : cB;
        const int nt = cur.nt, mrow = cur.msk;
        for (int t = 0; t < nt; t += 2) {
            const bool pre0 = PRESTAGE && pre_msk != 0 && t == 0;
            const bool last = (t == nt - 2);
            const char* a1 = cA + (size_t)(t + 1) * kstep;
            const char* a2 = last ? nA : cA + (size_t)(t + 2) * kstep; const char* b2 = last ? nB : cB + (size_t)(t + 2) * kstep;
            const char* a3 = a2 + kstep; const char* b3 = b2 + kstep;
            if (last && has_next) S.a_ready(nxt);
            PG8_LDB(B0, 0, 0); PG8_SCHED; PG8_LDA(At, 0, 0); if (!pre0) PG8_STAGE(PG8_SA(1, 1), a1 + hstep, voffA);
            PG8_WAIT_L(8); PG8_BAR; PG8_WAIT_L(0); PG8_MMAG(0, 0, At, B0); PG8_BAR; PG8_SCHED;
            PG8_LDB(B1, 0, 1); PG8_STAGE(PG8_SB(0, 0), b2, voffB);
            PG8_BAR; PG8_WAIT_L(0); PG8_MMAG(0, 1, At, B1); PG8_BAR;
            PG8_LDA(At, 0, 1); PG8_STAGE(PG8_SA(0, 0), a2, voffA);
            PG8_BAR; PG8_WAIT_L(0); PG8_MMAG(1, 0, At, B0); PG8_BAR; PG8_SCHED;
            PG8_STAGE(PG8_SB(0, 1), b2 + hstep, voffB);
            if constexpr (PRESTAGE) {
                if (pre0) { if (Epi::NST_PER_HALF && pre_msk == 3) asm volatile("s_waitcnt vmcnt(%0)" :: "n"(6 + 2 * Epi::NST) : "memory"); else asm volatile("s_waitcnt vmcnt(%0)" :: "n"(6 + Epi::NST) : "memory"); }
                else PG8_WAIT_V(6);
            } else PG8_WAIT_V(6);
            PG8_BAR; PG8_MMAG(1, 1, At, B1); PG8_BAR;
            PG8_LDB(B0, 1, 0); PG8_SCHED; PG8_LDA(At, 1, 0); PG8_STAGE(PG8_SA(0, 1), a2 + hstep, voffA);
            PG8_WAIT_L(8); PG8_BAR; PG8_WAIT_L(0); PG8_MMAG(0, 0, At, B0); PG8_BAR; PG8_SCHED;
            PG8_LDB(B1, 1, 1); PG8_STAGE(PG8_SB(1, 0), b3, voffB);
            PG8_BAR; PG8_WAIT_L(0); PG8_MMAG(0, 1, At, B1); PG8_BAR;
            PG8_LDA(At, 1, 1); PG8_STAGE(PG8_SA(1, 0), a3, voffA);
            PG8_BAR; PG8_WAIT_L(0); PG8_MMAG(1, 0, At, B0); PG8_BAR; PG8_SCHED;
            PG8_STAGE(PG8_SB(1, 1), b3 + hstep, voffB);
            PG8_WAIT_V(6); PG8_BAR; PG8_MMAG(1, 1, At, B1); PG8_BAR;
        }
        PG8_STAMP();
        if constexpr (PRESTAGE) { pre_msk = 0; if (has_next) { PG8_STAGE(PG8_SA(1, 1), nA + kstep + hstep, voffA); pre_msk = cur.msk; } }
        if constexpr (!Epi::AFTER_DRAIN) { E(acc, cur, wr, wc, fr, fq); S.done(cur); }
        PG8_STAMP();
        if (!has_next) break;
#pragma unroll
        for (int a = 0; a < 2; ++a)
#pragma unroll
            for (int b = 0; b < 2; ++b)
#pragma unroll
                for (int m = 0; m < 4; ++m)
#pragma unroll
                    for (int n = 0; n < 2; ++n) acc[a][b][m][n] = (f32x4){0.f, 0.f, 0.f, 0.f};
        cur = nxt; cA = nA; cB = nB; ++ui;
    }
    PG8_WAIT_V(0);
    if (wr == 0) PG8_BAR;
    PG8_BAR;
    if constexpr (Epi::AFTER_DRAIN) { E.fused(acc, cur, wr, wc, fr, fq, lds, wid, lane); S.done(cur); }
    PG8_STAMP();
    if (STAMP && wid == 0) { stamps[lane] = lane < nts ? (((unsigned long long)(unsigned)ts_hi << 32) | (unsigned)ts_lo) : 0ull;
        if (lane == 62) stamps[62] = rt_entry; if (lane == 63) stamps[63] = (unsigned long long)wall_clock64(); }
#undef PG8_STAMP
#undef PG8_SA
#undef PG8_SB
#undef PG8_STAGE
#undef PG8_LDA
#undef PG8_LDB
#undef PG8_HALF
#undef PG8_MMA
#undef PG8_MMA8
#undef PG8_MMA8L
#undef PG8_M8L1
#undef PG8_Q64
#undef PG8_MMAG
#undef PG8_WAIT_V
#undef PG8_WAIT_L
#undef PG8_BAR
#undef PG8_SCHED
}
}
#ifndef ATT_INLINE
#define ATT_INLINE __forceinline__
#endif
namespace att {
constexpr int D = 128, NW = 8, QBLK = 32, KVBLK = 64, LDQ = 512, LDO = DM;
constexpr float SCALE = 0.088388347648318440f;
constexpr float THR = 8.f;
constexpr size_t SHM_V = KVBLK * D * 2, SHM_K = KVBLK * D * 2, SHM_Q = 256 * D * 2, SHM_ATTN = 2 * SHM_V + 2 * SHM_K + NW * 64 * 4 + SHM_Q;
using bf16x8 = __attribute__((ext_vector_type(8))) short;
using s16x4  = __attribute__((ext_vector_type(4))) short;
using f32x16 = __attribute__((ext_vector_type(16))) float;
using u32x4  = __attribute__((ext_vector_type(4))) unsigned;
#define KSWZ(row, colB) ((row) * 256 + ((colB) ^ (((row) & 7) << 4)))
#define SBAR() __builtin_amdgcn_sched_barrier(0)
__device__ __forceinline__ int crow(int r, int hi) { return (r & 3) + 8 * (r >> 2) + 4 * hi; }
__device__ __forceinline__ unsigned cvtpk(float lo, float hi) { unsigned r; asm volatile("v_cvt_pk_bf16_f32 %0, %1, %2" : "=v"(r) : "v"(lo), "v"(hi)); return r; }

__device__ __forceinline__ void partialSM(f32x16& p0, f32x16& p1, float& m_reg, float& mn, float& alpha) {
  constexpr float C = SCALE * 1.4426950408889634f;
  float pmax = p0[0]; for (int r = 1; r < 16; ++r) pmax = fmaxf(pmax, p0[r]); for (int r = 0; r < 16; ++r) pmax = fmaxf(pmax, p1[r]);
  { auto rr = __builtin_amdgcn_permlane32_swap(__float_as_uint(pmax), __float_as_uint(pmax), false, false);
    pmax = fmaxf(__uint_as_float(rr[0]), __uint_as_float(rr[1])); }
  if (__builtin_expect(__all(pmax - m_reg <= THR / SCALE), 1)) { mn = m_reg; alpha = 1.f; }
  else { mn = fmaxf(m_reg, pmax); alpha = __builtin_amdgcn_exp2f((m_reg - mn) * C); m_reg = mn; }
  float mnC = -mn * C;
  for (int r = 0; r < 16; ++r) p0[r] = fmaf(p0[r], C, mnC); for (int r = 0; r < 16; ++r) p1[r] = fmaf(p1[r], C, mnC);
  for (int r = 0; r < 16; ++r) p0[r] = __builtin_amdgcn_exp2f(p0[r]);
}
__device__ __forceinline__ void finishSM(f32x16& p0, f32x16& p1, float alpha, float& l_reg, bf16x8& pa0, bf16x8& pa1, bf16x8& pa2, bf16x8& pa3) {
  for (int r = 0; r < 16; ++r) p1[r] = __builtin_amdgcn_exp2f(p1[r]);
  float ps = 0; for (int r = 0; r < 16; ++r) ps += p0[r]; for (int r = 0; r < 16; ++r) ps += p1[r];
  { auto rr = __builtin_amdgcn_permlane32_swap(__float_as_uint(ps), __float_as_uint(ps), false, false);
    ps = __uint_as_float(rr[0]) + __uint_as_float(rr[1]); }
  l_reg = l_reg * alpha + ps;
#define PK4(P, BASE, OUT) do { unsigned a0 = cvtpk(P[BASE + 0], P[BASE + 1]), a1 = cvtpk(P[BASE + 2], P[BASE + 3]);   \
    unsigned b0 = cvtpk(P[BASE + 4], P[BASE + 5]), b1 = cvtpk(P[BASE + 6], P[BASE + 7]);                              \
    auto r0 = __builtin_amdgcn_permlane32_swap(a0, b0, false, false); auto r1 = __builtin_amdgcn_permlane32_swap(a1, b1, false, false); \
    u32x4 w = {r0[0], r1[0], r0[1], r1[1]}; OUT = *reinterpret_cast<bf16x8*>(&w); } while (0)
  PK4(p0, 0, pa0); PK4(p0, 8, pa1); PK4(p1, 0, pa2); PK4(p1, 8, pa3);
#undef PK4
}
__device__ __forceinline__ void qkt(f32x16& p0, f32x16& p1, const bf16_t* Ks, const bf16_t* Qs, int qrow, int r32, int hi) {
  p0 = f32x16{}; p1 = f32x16{};
#pragma unroll
  for (int d0 = 0; d0 < 8; ++d0) { int cb = (d0 * 16 + hi * 8) * 2;
    bf16x8 q = *reinterpret_cast<const bf16x8*>((const char*)Qs + KSWZ(qrow, cb));
    bf16x8 b0 = *reinterpret_cast<const bf16x8*>((const char*)Ks + KSWZ(r32, cb));
    bf16x8 b1 = *reinterpret_cast<const bf16x8*>((const char*)Ks + KSWZ(32 + r32, cb));
    p0 = __builtin_amdgcn_mfma_f32_32x32x16_bf16(b0, q, p0, 0, 0, 0);
    p1 = __builtin_amdgcn_mfma_f32_32x32x16_bf16(b1, q, p1, 0, 0, 0); }
}
__device__ __forceinline__ int v_st(int k, int c) { const int kk = (k & ~0xC) | ((k & 4) << 1) | ((k & 8) >> 1); return ((kk >> 3) * 4 + (c >> 5)) * 512 + ((kk & 7) * 32 + (c & 31)) * 2; }
__device__ __forceinline__ int v_rd_base(int lane) { return ((lane & 3) << 3) | (((lane >> 2) & 3) << 6) | (((lane >> 4) & 1) << 5) | (((lane >> 5) & 1) << 8); }
constexpr int v_rd_off(int d0, int ks, int half) { return d0 * 512 + ks * 4096 + half * 2048; }
template <int OFF> __device__ __forceinline__ s16x4 tr_read(int vb) {
  s16x4 r; asm volatile("ds_read_b64_tr_b16 %0, %1 offset:%2" : "=&v"(r) : "v"(vb), "i"(OFF) : "memory"); return r;
}
template <int D0> __device__ __forceinline__ void pv_one(f32x16& od, int vb, bf16x8 pa0, bf16x8 pa1, bf16x8 pa2, bf16x8 pa3) {
  const s16x4 l0 = tr_read<v_rd_off(D0, 0, 0)>(vb), h0 = tr_read<v_rd_off(D0, 0, 1)>(vb), l1 = tr_read<v_rd_off(D0, 1, 0)>(vb), h1 = tr_read<v_rd_off(D0, 1, 1)>(vb);
  const s16x4 l2 = tr_read<v_rd_off(D0, 2, 0)>(vb), h2 = tr_read<v_rd_off(D0, 2, 1)>(vb), l3 = tr_read<v_rd_off(D0, 3, 0)>(vb), h3 = tr_read<v_rd_off(D0, 3, 1)>(vb);
  asm volatile("s_waitcnt lgkmcnt(0)" ::: "memory"); SBAR();
#define PK(L, H) (bf16x8){L[0], L[1], L[2], L[3], H[0], H[1], H[2], H[3]}
  od = __builtin_amdgcn_mfma_f32_32x32x16_bf16(pa0, PK(l0, h0), od, 0, 0, 0);
  od = __builtin_amdgcn_mfma_f32_32x32x16_bf16(pa1, PK(l1, h1), od, 0, 0, 0);
  od = __builtin_amdgcn_mfma_f32_32x32x16_bf16(pa2, PK(l2, h2), od, 0, 0, 0);
  od = __builtin_amdgcn_mfma_f32_32x32x16_bf16(pa3, PK(l3, h3), od, 0, 0, 0);
#undef PK
}
__device__ __forceinline__ void pv_d0(f32x16* o, int vb, bf16x8 pa0, bf16x8 pa1, bf16x8 pa2, bf16x8 pa3) {
  pv_one<0>(o[0], vb, pa0, pa1, pa2, pa3); pv_one<1>(o[1], vb, pa0, pa1, pa2, pa3); pv_one<2>(o[2], vb, pa0, pa1, pa2, pa3); pv_one<3>(o[3], vb, pa0, pa1, pa2, pa3);
}

struct SrcOne { const bf16_t* k0; const bf16_t* v0; int ldk;
  __device__ __forceinline__ const bf16_t* k(int j) const { return k0 + (size_t)j * 64 * ldk; }
  __device__ __forceinline__ const bf16_t* v(int j) const { return v0 + (size_t)j * 64 * ldk; } };
struct SrcTwo { const bf16_t* ck; const bf16_t* cv; const bf16_t* k1; const bf16_t* v1; int ldk;
  __device__ __forceinline__ const bf16_t* k(int j) const { return j < 4 ? ck + (size_t)j * 64 * ldk : k1 + (size_t)(j - 4) * 64 * ldk; }
  __device__ __forceinline__ const bf16_t* v(int j) const { return j < 4 ? cv + (size_t)j * 64 * ldk : v1 + (size_t)(j - 4) * 64 * ldk; } };
struct NoBias { __device__ __forceinline__ void operator()(f32x16&, f32x16&, int, int, int, int) const {} };
struct NaBias { const float* tab; int i0, kr0;
  __device__ __forceinline__ void operator()(f32x16& p0, f32x16& p1, int jt, int wid, int r32, int hi) const {
    if (jt < 4) return;
    const int qi = i0 + wid * QBLK + r32, r = qi >> 6, qc = qi & 63, kr = kr0 + jt - 4;
    int lo = r - 4; lo = lo < 0 ? 0 : (lo > 8 ? 8 : lo);
    const bool rowok = (kr >= lo) && (kr < lo + 8);
    if (!rowok) {
#pragma unroll
      for (int rr = 0; rr < 16; ++rr) { p0[rr] = -1e30f; p1[rr] = -1e30f; }
      return;
    }
    int c0 = qc - 8; c0 = c0 < 0 ? 0 : (c0 > 48 ? 48 : c0);
    const int dr = kr - r + 7;
    const float* tb = tab + dr * 31 + (4 * hi - qc + 15);
    const int w0 = 4 * hi - c0;
#pragma unroll
    for (int g = 0; g < 4; ++g) {
#pragma unroll
      for (int q = 0; q < 4; ++q) {
        const int rr = 4 * g + q, kc0 = q + 8 * g;
        const float t0 = tb[kc0], t1 = tb[kc0 + 32];
        p0[rr] = ((unsigned)(kc0 + w0) < 16u) ? p0[rr] + t0 : -1e30f;
        p1[rr] = ((unsigned)(kc0 + 32 + w0) < 16u) ? p1[rr] + t1 : -1e30f;
      }
      SBAR();
    }
  } };

template <int SD, class Src, class Bias>
__device__ ATT_INLINE void attn_body(const bf16_t* __restrict__ Qb, const Src src, bf16_t* __restrict__ Ob, const int NT, char* lds, const Bias bias) {
  const int tid = opaque_tid(), wid = tid >> 6, lane = tid & 63, r32 = lane & 31, hi = lane >> 5;
  const int LDK = src.ldk;
  bf16_t* V_lds = (bf16_t*)lds; bf16_t* K_lds = (bf16_t*)(lds + 2 * SHM_V);
  float* ws = (float*)(lds + 2 * SHM_V + 2 * SHM_K) + wid * 64; float* li_l = ws; float* al_l = ws + 32;
  float m_reg = -1e30f, l_reg = 0; f32x16 o[4] = {};
  bf16_t* Q_lds = (bf16_t*)(lds + 2 * SHM_V + 2 * SHM_K + NW * 64 * 4);
  const int qrow = wid * QBLK + r32;
  {
    bf16x8 qv[8];
#pragma unroll
    for (int i = 0; i < 8; ++i) { const int f = tid + 512 * i, row = f >> 4, c8 = (f & 15) * 8; qv[i] = *reinterpret_cast<const bf16x8*>(Qb + (long)row * LDQ + c8); }
#pragma unroll
    for (int i = 0; i < 8; ++i) { const int f = tid + 512 * i, row = f >> 4, c8 = (f & 15) * 8; *(bf16x8*)((char*)Q_lds + KSWZ(row, c8 * 2)) = qv[i]; }
  }
  const int sr = tid >> 4, sc = (tid & 15) * 8, vst0 = v_st(sr, sc), vst1 = v_st(32 + sr, sc);
  const int vb0 = (int)(uintptr_t)V_lds + v_rd_base(lane);
  struct { bf16x8 vs0, vs1, ks0, ks1; } sr_[SD];
#define SLOAD(i, jt) do { const bf16_t* kt_ = src.k(jt); const bf16_t* vt_ = src.v(jt); \
    sr_[i].vs0 = *reinterpret_cast<const bf16x8*>(&vt_[(long)sr * LDK + sc]); sr_[i].vs1 = *reinterpret_cast<const bf16x8*>(&vt_[(long)(32 + sr) * LDK + sc]); \
    sr_[i].ks0 = *reinterpret_cast<const bf16x8*>(&kt_[(long)sr * LDK + sc]); sr_[i].ks1 = *reinterpret_cast<const bf16x8*>(&kt_[(long)(32 + sr) * LDK + sc]); } while (0)
#define SWRITE(b, i) do { *(bf16x8*)((char*)V_lds + (b) * SHM_V + vst0) = sr_[i].vs0;          \
    *(bf16x8*)((char*)V_lds + (b) * SHM_V + vst1) = sr_[i].vs1; int kc = sc * 2;               \
    *(bf16x8*)((char*)K_lds + (b) * SHM_K + KSWZ(sr, kc)) = sr_[i].ks0;                       \
    *(bf16x8*)((char*)K_lds + (b) * SHM_K + KSWZ(32 + sr, kc)) = sr_[i].ks1; } while (0)
#define SWAIT() do { if constexpr (SD == 2) asm volatile("s_waitcnt vmcnt(4)" ::: "memory"); else asm volatile("s_waitcnt vmcnt(0)" ::: "memory"); } while (0)
#define RESC(a) do { if (__any((a) < 1.f)) { if (hi == 0) al_l[r32] = (a); asm volatile("s_waitcnt lgkmcnt(0)" ::: "memory"); \
    for (int d = 0; d < 4; ++d) for (int r = 0; r < 16; ++r) o[d][r] *= al_l[crow(r, hi)]; } } while (0)
  f32x16 pA0, pA1, pB0, pB1; float mnA, mnB, alA, alB; bf16x8 pa0, pa1, pa2, pa3;
  constexpr int SE = 0, SO = SD - 1;
  SLOAD(SE, 0); asm volatile("s_waitcnt vmcnt(0)" ::: "memory"); SWRITE(0, SE); __syncthreads();
  qkt(pA0, pA1, K_lds, Q_lds, qrow, r32, hi); bias(pA0, pA1, 0, wid, r32, hi); partialSM(pA0, pA1, m_reg, mnA, alA);
  SLOAD(SO, 1); if constexpr (SD == 2) { if (2 < NT) SLOAD(SE, 2); }
  SWAIT(); SWRITE(1, SO); __syncthreads();
  for (int j = 1; j + 1 < NT; j += 2) {
    SBAR(); qkt(pB0, pB1, (bf16_t*)((char*)K_lds + SHM_K), Q_lds, qrow, r32, hi); bias(pB0, pB1, j, wid, r32, hi);
    finishSM(pA0, pA1, alA, l_reg, pa0, pa1, pa2, pa3); SBAR();
    SLOAD(SO, j + SD); SBAR();
    pv_d0(o, vb0, pa0, pa1, pa2, pa3); partialSM(pB0, pB1, m_reg, mnB, alB);
    __syncthreads(); SWAIT(); SWRITE(0, SE);
    RESC(alB); __syncthreads();
    SBAR(); qkt(pA0, pA1, K_lds, Q_lds, qrow, r32, hi); bias(pA0, pA1, j + 1, wid, r32, hi);
    finishSM(pB0, pB1, alB, l_reg, pa0, pa1, pa2, pa3); SBAR();
    if (SD == 1 || j + 3 < NT) SLOAD(SE, j + 1 + SD); SBAR();
    pv_d0(o, vb0 + (int)SHM_V, pa0, pa1, pa2, pa3); partialSM(pA0, pA1, m_reg, mnA, alA);
    __syncthreads(); SWAIT(); SWRITE(1, SO);
    RESC(alA); __syncthreads();
  }
  SBAR(); qkt(pB0, pB1, (bf16_t*)((char*)K_lds + SHM_K), Q_lds, qrow, r32, hi); bias(pB0, pB1, NT - 1, wid, r32, hi);
  finishSM(pA0, pA1, alA, l_reg, pa0, pa1, pa2, pa3); SBAR();
  pv_d0(o, vb0, pa0, pa1, pa2, pa3); partialSM(pB0, pB1, m_reg, mnB, alB);
  __syncthreads(); RESC(alB);
  finishSM(pB0, pB1, alB, l_reg, pa0, pa1, pa2, pa3); SBAR();
  pv_d0(o, vb0 + (int)SHM_V, pa0, pa1, pa2, pa3);
  if (hi == 0) li_l[r32] = l_reg; asm volatile("s_waitcnt lgkmcnt(0)" ::: "memory");
  float rli[16];
#pragma unroll
  for (int r = 0; r < 16; ++r) rli[r] = __builtin_amdgcn_rcpf(li_l[crow(r, hi)]);
  bf16_t* Ow = Ob + (long)(wid * QBLK) * LDO;
#pragma unroll
  for (int r = 0; r < 16; ++r) { int orow = crow(r, hi);
    for (int d0 = 0; d0 < 4; ++d0) Ow[(long)orow * LDO + d0 * 32 + r32] = f2bf(o[d0][r] * rli[r]); }
#undef SLOAD
#undef SWRITE
#undef SWAIT
#undef RESC
}
}
#define H16(w, j) ((bf16_t)(((j) & 1) ? ((j) < 2 ? (w).x >> 16 : (w).y >> 16) : ((j) < 2 ? (w).x & 0xFFFFu : (w).y & 0xFFFFu)))
#define DPPU(v, ctrl, rmask) __int_as_float(__builtin_amdgcn_update_dpp(0, __float_as_int(v), (ctrl), (rmask), 0xF, false))
__device__ __forceinline__ float scan32(float x) { x += DPPU(x, 0x111, 0xF); x += DPPU(x, 0x112, 0xF); x += DPPU(x, 0x114, 0xF); x += DPPU(x, 0x118, 0xF); x += DPPU(x, 0x142, 0xA); return x; }
__device__ __forceinline__ float last32(float x, int lane) { const float a = __int_as_float(__builtin_amdgcn_readlane(__float_as_int(x), 31)), b = __int_as_float(__builtin_amdgcn_readlane(__float_as_int(x), 63)); return lane < 32 ? a : b; }
namespace gdn {
using att::bf16x8; using att::f32x16; using att::crow;
constexpr int C = 32, SK = 136, SS = 40;
constexpr int OFF_KT = 0, OFF_QT = OFF_KT + C * SK * 2, OFF_W = OFF_QT + C * SK * 2, OFF_KTT = OFF_W + C * SK * 2, OFF_VTT = OFF_KTT + 128 * SS * 2,
              OFF_VN = OFF_VTT + 128 * SS * 2, OFF_VNS = OFF_VN + 128 * SS * 2, OFF_ST = OFF_VNS + 128 * SS * 2, OFF_TB = OFF_ST + 128 * SK * 2,
              OFF_TBE = OFF_TB + C * SS * 2, OFF_ATT = OFF_TBE + C * SS * 2, OFF_L = OFF_ATT + C * SS * 2, OFF_SC = OFF_L + C * C * 4, GDN_LDS = OFF_SC + 1024;
template <int K>
__device__ __forceinline__ f32x16 mm(const bf16_t* A, int lda, const bf16_t* Bt, int ldb, int l32, int hi, f32x16 acc) {
#pragma unroll
    for (int k0 = 0; k0 < K; k0 += 16) {
        const bf16x8 a = *reinterpret_cast<const bf16x8*>(A + l32 * lda + k0 + 8 * hi);
        const bf16x8 b = *reinterpret_cast<const bf16x8*>(Bt + l32 * ldb + k0 + 8 * hi);
        acc = __builtin_amdgcn_mfma_f32_32x32x16_bf16(a, b, acc, 0, 0, 0);
    }
    return acc;
}
__device__ __forceinline__ uint2 pk4(float a, float b, float c, float d) { uint2 w; w.x = pack2(a, b); w.y = pack2(c, d); return w; }

__device__ __forceinline__ void gdn_chunked(const Params& p, int l, bool ctx, int b, int h, int dir, unsigned char* lds) {
    const int tid = opaque_tid(), wid = tid >> 6, lane = tid & 63, l32 = lane & 31, hi = lane >> 5;
    const int T = ctx ? CT : ::LT; const size_t m0 = ctx ? (size_t)b * CT : (size_t)MC + (size_t)b * ::LT;
    const bf16_t* DQ = WSP(bf16_t, WS_DQ); const bf16_t* DK = WSP(bf16_t, WS_DK); const bf16_t* DV = WSP(bf16_t, WS_DV); const float* DBA = WSP(float, WS_DBA);
    bf16_t* O = WSP(bf16_t, dir ? WS_DOB : WS_DOF);
    bf16_t* Kt = (bf16_t*)(lds + OFF_KT); bf16_t* Qt = (bf16_t*)(lds + OFF_QT); bf16_t* W = (bf16_t*)(lds + OFF_W); bf16_t* KT = (bf16_t*)(lds + OFF_KTT); bf16_t* VT = (bf16_t*)(lds + OFF_VTT);
    bf16_t* VN = (bf16_t*)(lds + OFF_VN); bf16_t* VNS = (bf16_t*)(lds + OFF_VNS); bf16_t* ST = (bf16_t*)(lds + OFF_ST); bf16_t* TB = (bf16_t*)(lds + OFF_TB); bf16_t* TBE = (bf16_t*)(lds + OFF_TBE);
    bf16_t* ATT = (bf16_t*)(lds + OFF_ATT); float* Lm = (float*)(lds + OFF_L); float* sc = (float*)(lds + OFF_SC);
    const int nch = T / C;
#define TOK(c, s_) (m0 + (dir ? T - 1 - ((c) * C + (s_)) : (c) * C + (s_)))
    f32x16 S[2];
#pragma unroll
    for (int bi = 0; bi < 2; ++bi) {
        const int blk = wid * 2 + bi, d0 = 32 * (blk >> 2), e0 = 32 * (blk & 3);
        if (ctx) { S[bi] = f32x16{}; }
        else {
            const float* s0 = p.in[I_SGDN] + ((((size_t)b * DEPTH + l) * 2 + dir) * 4 + h) * 128 * 128 + e0 + l32;
#pragma unroll
            for (int r = 0; r < 16; ++r) S[bi][r] = s0[(size_t)(d0 + crow(r, hi)) * 128];
        }
    }
    const int ts = tid & 31, c0 = (tid >> 5) * 4, c1 = 64 + c0;
    uint2 rq0, rq1, rk0, rk1, rv0, rv1; float pbeta = 0.f, pg = 0.f;
#define GLOAD(c) do { const size_t mt_ = TOK(c, ts); \
        rq0 = *(const uint2*)(DQ + mt_ * 512 + h * 128 + c0); rq1 = *(const uint2*)(DQ + mt_ * 512 + h * 128 + c1); \
        rk0 = *(const uint2*)(DK + mt_ * 512 + h * 128 + c0); rk1 = *(const uint2*)(DK + mt_ * 512 + h * 128 + c1); \
        rv0 = *(const uint2*)(DV + mt_ * 512 + h * 128 + c0); rv1 = *(const uint2*)(DV + mt_ * 512 + h * 128 + c1); \
        if (tid < C) { const size_t mt = TOK(c, tid); pbeta = DBA[mt * 16 + dir * 4 + h]; pg = DBA[mt * 16 + 8 + dir * 4 + h]; } } while (0)
#define QP1(v) ((unsigned)__builtin_amdgcn_update_dpp(0, (int)(v), 0xB1, 0xF, 0xF, true))
#define TPAIR(IMG, cbase, w) do { const unsigned nx_ = QP1((w).x), ny_ = QP1((w).y); const bool od_ = (ts & 1) != 0; \
        const unsigned a_ = od_ ? __builtin_amdgcn_perm((w).y, ny_, 0x05040100u) : __builtin_amdgcn_perm(nx_, (w).x, 0x05040100u); \
        const unsigned b_ = od_ ? __builtin_amdgcn_perm((w).y, ny_, 0x07060302u) : __builtin_amdgcn_perm(nx_, (w).x, 0x07060302u); \
        const int ch_ = (cbase) + (od_ ? 2 : 0), tp_ = ts & ~1; \
        *(unsigned*)(IMG + ch_ * SS + tp_) = a_; *(unsigned*)(IMG + (ch_ + 1) * SS + tp_) = b_; } while (0)
#define GSTAGE() do { \
        *(uint2*)(Kt + ts * SK + c0) = rk0; *(uint2*)(Kt + ts * SK + c1) = rk1; \
        *(uint2*)(Qt + ts * SK + c0) = rq0; *(uint2*)(Qt + ts * SK + c1) = rq1; \
        TPAIR(KT, c0, rk0); TPAIR(KT, c1, rk1); TPAIR(VT, c0, rv0); TPAIR(VT, c1, rv1); \
        if (wid == 0) { float x = pg; _Pragma("unroll") for (int o_ = 1; o_ < 32; o_ <<= 1) { const float y = __shfl_up(x, o_); if (lane >= o_) x += y; } \
            const float Bt_ = __shfl(x, 31); if (lane < C) { sc[lane] = pbeta; sc[32 + lane] = x; sc[64 + lane] = __expf(x); sc[96 + lane] = __expf(Bt_ - x); if (lane == 0) sc[128] = __expf(Bt_); } } } while (0)
    __syncthreads();
    GLOAD(0);
#pragma unroll
    for (int bi = 0; bi < 2; ++bi) {
        const int blk = wid * 2 + bi, d0 = 32 * (blk >> 2), e0 = 32 * (blk & 3);
#pragma unroll
        for (int g = 0; g < 4; ++g) *(uint2*)(ST + (e0 + l32) * SK + d0 + 8 * g + 4 * hi) = pk4(S[bi][4 * g], S[bi][4 * g + 1], S[bi][4 * g + 2], S[bi][4 * g + 3]);
    }
    GSTAGE();
    __syncthreads();
    for (int c = 0; c < nch; ++c) {
        if (c + 1 < nch) GLOAD(c + 1);
        f32x16 acc1 = f32x16{};
        if (wid == 0) {
            const f32x16 kk = mm<128>(Kt, SK, Kt, SK, l32, hi, f32x16{});
            const float bi_ = sc[32 + l32], be = sc[l32];
#pragma unroll
            for (int r = 0; r < 16; ++r) { const int j = crow(r, hi); const float v = (l32 > j) ? be * kk[r] * __expf(bi_ - sc[32 + j]) : 0.f;
                Lm[l32 * 32 + ((((r & 3) + 4 * hi) ^ (l32 & 7)) * 4) + (r >> 2)] = v; }
        } else if (wid == 1) {
            const f32x16 kq = mm<128>(Kt, SK, Qt, SK, l32, hi, f32x16{});
            const float bi_ = sc[32 + l32];
            float a[16];
#pragma unroll
            for (int r = 0; r < 16; ++r) { const int j = crow(r, hi); a[r] = (l32 >= j) ? kq[r] * __expf(bi_ - sc[32 + j]) : 0.f; }
#pragma unroll
            for (int g = 0; g < 4; ++g) *(uint2*)(ATT + l32 * SS + 8 * g + 4 * hi) = pk4(a[4 * g], a[4 * g + 1], a[4 * g + 2], a[4 * g + 3]);
        } else if (wid >= 4) {
            acc1 = mm<128>(Qt, SK, ST + (32 * (wid - 4)) * SK, SK, l32, hi, f32x16{});
#pragma unroll
            for (int r = 0; r < 16; ++r) acc1[r] *= sc[64 + crow(r, hi)];
        }
        __syncthreads();
        if (tid < 256) {
            const int cc = tid >> 3, part = tid & 7;
            float Tr[4] = {0.f, 0.f, 0.f, 0.f};
#pragma unroll
            for (int i = 0; i < 32; i += 2) {
                const vf4 lv0 = *(const vf4*)(Lm + i * 32 + ((part ^ (i & 7)) * 4));
                const vf4 lv1 = *(const vf4*)(Lm + (i + 1) * 32 + ((part ^ ((i + 1) & 7)) * 4));
                const float l10 = Lm[(i + 1) * 32 + (((i & 7) ^ ((i + 1) & 7)) * 4) + (i >> 3)];
                float s0 = lv0.x * Tr[0] + lv0.y * Tr[1] + lv0.z * Tr[2] + lv0.w * Tr[3];
                float s1 = lv1.x * Tr[0] + lv1.y * Tr[1] + lv1.z * Tr[2] + lv1.w * Tr[3];
                s0 = red8(s0); s1 = red8(s1);
                const float t0 = (i == cc ? 1.f : 0.f) - s0;
                const float t1 = ((i + 1) == cc ? 1.f : 0.f) - s1 - l10 * t0;
                if (part == (i & 7)) Tr[i >> 3] = t0;
                if (part == ((i + 1) & 7)) Tr[(i + 1) >> 3] = t1;
            }
            const float bc = sc[cc], bec = bc * sc[64 + cc];
#pragma unroll
            for (int jj = 0; jj < 4; ++jj) { TB[(part + 8 * jj) * SS + cc] = f2bf(Tr[jj] * bc); TBE[(part + 8 * jj) * SS + cc] = f2bf(Tr[jj] * bec); }
        }
        __syncthreads();
        if (wid < 4) {
            acc1 = mm<32>(TB, SS, VT + (32 * wid) * SS, SS, l32, hi, f32x16{});
        } else {
            const int d0 = 32 * (wid - 4);
            const f32x16 wt = mm<32>(KT + d0 * SS, SS, TBE, SS, l32, hi, f32x16{});
#pragma unroll
            for (int g = 0; g < 4; ++g) *(uint2*)(W + l32 * SK + d0 + 8 * g + 4 * hi) = pk4(wt[4 * g], wt[4 * g + 1], wt[4 * g + 2], wt[4 * g + 3]);
        }
        __syncthreads();
        if (wid < 4) {
            const int e0 = 32 * wid;
            const f32x16 ws = mm<128>(W, SK, ST + e0 * SK, SK, l32, hi, f32x16{});
            float vn[16], vs[16];
#pragma unroll
            for (int r = 0; r < 16; ++r) { vn[r] = acc1[r] - ws[r]; vs[r] = vn[r] * sc[96 + crow(r, hi)]; }
#pragma unroll
            for (int g = 0; g < 4; ++g) { *(uint2*)(VN + (e0 + l32) * SS + 8 * g + 4 * hi) = pk4(vn[4 * g], vn[4 * g + 1], vn[4 * g + 2], vn[4 * g + 3]);
                                          *(uint2*)(VNS + (e0 + l32) * SS + 8 * g + 4 * hi) = pk4(vs[4 * g], vs[4 * g + 1], vs[4 * g + 2], vs[4 * g + 3]); }
        }
        __syncthreads();
        if (wid >= 4) {
            const int e0 = 32 * (wid - 4);
            acc1 = mm<32>(ATT, SS, VN + e0 * SS, SS, l32, hi, acc1);
#pragma unroll
            for (int r = 0; r < 16; ++r) O[TOK(c, crow(r, hi)) * 512 + h * 128 + e0 + l32] = f2bf(acc1[r]);
        }
        {
            const float eB = sc[128];
#pragma unroll
            for (int bi = 0; bi < 2; ++bi) {
                const int blk = wid * 2 + bi, d0 = 32 * (blk >> 2), e0 = 32 * (blk & 3);
#pragma unroll
                for (int r = 0; r < 16; ++r) S[bi][r] *= eB;
                S[bi] = mm<32>(KT + d0 * SS, SS, VNS + e0 * SS, SS, l32, hi, S[bi]);
            }
        }
        __syncthreads();
#pragma unroll
        for (int bi = 0; bi < 2; ++bi) {
            const int blk = wid * 2 + bi, d0 = 32 * (blk >> 2), e0 = 32 * (blk & 3);
#pragma unroll
            for (int g = 0; g < 4; ++g) *(uint2*)(ST + (e0 + l32) * SK + d0 + 8 * g + 4 * hi) = pk4(S[bi][4 * g], S[bi][4 * g + 1], S[bi][4 * g + 2], S[bi][4 * g + 3]);
        }
        if (c + 1 < nch) GSTAGE();
        __syncthreads();
    }
#undef GLOAD
#undef GSTAGE
#undef TOK
    if (ctx) {
#pragma unroll
        for (int bi = 0; bi < 2; ++bi) {
            const int blk = wid * 2 + bi, d0 = 32 * (blk >> 2), e0 = 32 * (blk & 3);
            float* so = p.out + O_SGDN + ((((size_t)b * DEPTH + l) * 2 + dir) * 4 + h) * 128 * 128 + e0 + l32;
#pragma unroll
            for (int r = 0; r < 16; ++r) so[(size_t)(d0 + crow(r, hi)) * 128] = S[bi][r];
        }
    }
}
}

namespace gla {
using att::bf16x8; using att::f32x16; using att::crow; using gdn::mm; using gdn::pk4;
constexpr int C = 32, SQ = 72, SS = 40;
constexpr int OFF_QE = 0, OFF_KN = OFF_QE + C * SQ * 2, OFF_KET = OFF_KN + C * SQ * 2, OFF_VT = OFF_KET + 64 * SS * 2, OFF_ATT = OFF_VT + 128 * SS * 2, OFF_ST = OFF_ATT + C * SS * 2,
              OFF_LA = OFF_ST + 128 * SQ * 2, OFF_EB = OFF_LA + C * 64 * 4, GLA_LDS = OFF_EB + 256;
__device__ __forceinline__ void gla_chunked(const Params& p, int l, bool ctx, int b, int h, int dir, unsigned char* lds) {
    const int tid = opaque_tid(), wid = tid >> 6, lane = tid & 63, l32 = lane & 31, hi = lane >> 5;
    const int T = ctx ? CT : ::LT; const size_t m0 = ctx ? (size_t)b * CT : (size_t)MC + (size_t)b * ::LT;
    const bf16_t* Z = WSP(bf16_t, WS_Z); const float* LA = WSP(float, dir ? WS_AB : WS_AF);
    bf16_t* O = WSP(bf16_t, dir ? WS_GOB : WS_GOF);
    bf16_t* Qe = (bf16_t*)(lds + OFF_QE); bf16_t* Kn = (bf16_t*)(lds + OFF_KN); bf16_t* KeT = (bf16_t*)(lds + OFF_KET); bf16_t* VT = (bf16_t*)(lds + OFF_VT);
    bf16_t* ATT = (bf16_t*)(lds + OFF_ATT); bf16_t* ST = (bf16_t*)(lds + OFF_ST); float* eB = (float*)(lds + OFF_EB);
    const int nch = T / C;
#define TOK(c, s_) (m0 + (dir ? T - 1 - ((c) * C + (s_)) : (c) * C + (s_)))
    const int d0 = 32 * (wid >> 2), e0 = 32 * (wid & 3);
    f32x16 S;
    if (ctx) S = f32x16{};
    else {
        const float* s0 = p.in[I_SGLA] + ((((size_t)b * DEPTH + l) * 2 + dir) * 4 + h) * 64 * 128 + e0 + l32;
#pragma unroll
        for (int r = 0; r < 16; ++r) S[r] = s0[(size_t)(d0 + crow(r, hi)) * 128];
    }
    const int ts = tid & 31, dc = (tid >> 5) * 4, vc0 = dc, vc1 = 64 + dc;
    uint2 rq, rk, rv0, rv1; vf4 pl;
#define GLOAD(c) do { const size_t mt = TOK(c, ts); \
        rq = *(const uint2*)(Z + mt * NINP + Z_GLQ + h * 64 + dc); rk = *(const uint2*)(Z + mt * NINP + Z_GLK + h * 64 + dc); pl = *(const vf4*)(LA + mt * 256 + h * 64 + dc); \
        rv0 = *(const uint2*)(Z + mt * NINP + Z_GLV + h * 128 + vc0); rv1 = *(const uint2*)(Z + mt * NINP + Z_GLV + h * 128 + vc1); } while (0)
#define WRITE_ST() do { _Pragma("unroll") for (int g = 0; g < 4; ++g) *(uint2*)(ST + (e0 + l32) * SQ + d0 + 8 * g + 4 * hi) = pk4(S[4 * g], S[4 * g + 1], S[4 * g + 2], S[4 * g + 3]); } while (0)
#define GIMAGES() do { vf4 pre, tot; const vf4 pq = unp4bf(rq), pk = unp4bf(rk); \
        _Pragma("unroll") for (int j = 0; j < 4; ++j) { pre[j] = scan32(pl[j]); tot[j] = last32(pre[j], lane); } \
        float qe[4], kn[4]; \
        _Pragma("unroll") for (int j = 0; j < 4; ++j) { qe[j] = pq[j] * 0.125f * __expf(pre[j]); kn[j] = pk[j] * __expf(fminf(-pre[j], 80.f)); \
            KeT[(dc + j) * SS + ts] = f2bf(pk[j] * __expf(tot[j] - pre[j])); } \
        *(uint2*)(Qe + ts * SQ + dc) = pk4(qe[0], qe[1], qe[2], qe[3]); *(uint2*)(Kn + ts * SQ + dc) = pk4(kn[0], kn[1], kn[2], kn[3]); \
        if (ts == 0) { _Pragma("unroll") for (int j = 0; j < 4; ++j) eB[dc + j] = __expf(tot[j]); } \
        _Pragma("unroll") for (int j = 0; j < 4; ++j) { VT[(vc0 + j) * SS + ts] = H16(rv0, j); VT[(vc1 + j) * SS + ts] = H16(rv1, j); } } while (0)
    __syncthreads();
    GLOAD(0);
    WRITE_ST();
    GIMAGES();
    __syncthreads();
    for (int c = 0; c < nch; ++c) {
        if (c + 1 < nch) GLOAD(c + 1);
        f32x16 o1 = f32x16{};
        if (wid == 0) {
            const f32x16 kq = mm<64>(Kn, SQ, Qe, SQ, l32, hi, f32x16{});
            float a[16];
#pragma unroll
            for (int r = 0; r < 16; ++r) a[r] = (l32 >= crow(r, hi)) ? kq[r] : 0.f;
#pragma unroll
            for (int g = 0; g < 4; ++g) *(uint2*)(ATT + l32 * SS + 8 * g + 4 * hi) = pk4(a[4 * g], a[4 * g + 1], a[4 * g + 2], a[4 * g + 3]);
        } else if (wid >= 4) {
            o1 = mm<64>(Qe, SQ, ST + (32 * (wid - 4)) * SQ, SQ, l32, hi, f32x16{});
        }
        __syncthreads();
        if (wid >= 4) {
            const int eo = 32 * (wid - 4);
            o1 = mm<32>(ATT, SS, VT + eo * SS, SS, l32, hi, o1);
#pragma unroll
            for (int r = 0; r < 16; ++r) O[TOK(c, crow(r, hi)) * 512 + h * 128 + eo + l32] = f2bf(o1[r]);
        }
#pragma unroll
        for (int r = 0; r < 16; ++r) S[r] *= eB[d0 + crow(r, hi)];
        S = mm<32>(KeT + d0 * SS, SS, VT + e0 * SS, SS, l32, hi, S);
        __syncthreads();
        WRITE_ST();
        if (c + 1 < nch) GIMAGES();
#ifdef GLA_DUP_IMAGES
        __syncthreads(); if (c + 1 < nch) GIMAGES();
#endif
        __syncthreads();
    }
#undef GLOAD
#undef WRITE_ST
#undef GIMAGES
#undef TOK
    if (ctx) {
        float* so = p.out + O_SGLA + ((((size_t)b * DEPTH + l) * 2 + dir) * 4 + h) * 64 * 128 + e0 + l32;
#pragma unroll
        for (int r = 0; r < 16; ++r) so[(size_t)(d0 + crow(r, hi)) * 128] = S[r];
    }
}
}
#define LAS __attribute__((address_space(3)))
constexpr int LDS_BYTES = 147456, XBW_OFF = LDS_BYTES - 64;
constexpr int NPH = 1 + DEPTH * 12;
#ifndef DBG_NLAYERS
#define DBG_NLAYERS DEPTH
#endif

#ifndef DUPKIND
#define DUPKIND 0
#endif
#ifndef MIXMASK
#define MIXMASK 0xFF
#endif
#define FOR_ITEMS(it, n, o, w) for (int bo_ = (o) * (int)gridDim.x / 256, bw_ = ((w) * (int)gridDim.x / 256) > 0 ? ((w) * (int)gridDim.x / 256) : 1, \
                                    it = ((int)blockIdx.x >= bo_ && (int)blockIdx.x < bo_ + bw_) ? (int)blockIdx.x - bo_ : (n); it < (n); it += bw_)

#ifndef TF1_PCT
#define TF1_PCT 25
#endif
constexpr int TF0 = NT_L / 10, TF1 = NT_L * TF1_PCT / 100, TF2 = NT_L * 53 / 100, TF3 = NT_L * 88 / 100, MIXCONV_CH = CONV_U, NI_CONV = (TF3 - TF2 + MIXCONV_CH - 1) / MIXCONV_CH;
#ifndef SPLITK
#define SPLITK 0
#endif
#ifndef SPLITK_G4
#define SPLITK_G4 0
#endif
constexpr int FLAG_WORD0 = 8192;
constexpr int QCTR_WORD0 = 1024;
constexpr int NI_GDNL = LB * 8, NI_GLAL = LB * 8, NI_GDNC = CB * 8, NI_GQAL = LB * 16, NI_NAL = LB * 16, NI_GLAC = CB * 8, NI_NAC = CB * 4, NI_GQAC = CB * 4;
#define KM(k) (1 + ((DUPKIND >> (k)) & 1))
constexpr int Q0 = NI_GDNL * KM(0), Q1 = Q0 + NI_GQAL * KM(1), Q2 = Q1 + NI_NAL * KM(2), Q3 = Q2 + NI_GLAL * KM(3), Q4 = Q3 + NI_GDNC * KM(4), Q5 = Q4 + NI_NAC * KM(5), Q6 = Q5 + NI_GQAC * KM(6), Q7 = Q6 + NI_GLAC * KM(7);
__device__ __forceinline__ void phase_mix(const Params& p, int l, unsigned char* lds, int rep) {
    const int tid = opaque_tid();
    float* smem = (float*)lds;
    const bf16_t* NAQ = WSP(bf16_t, WS_NAQ); const bf16_t* NAK = WSP(bf16_t, WS_NAK); const bf16_t* NAV = WSP(bf16_t, WS_NAV);
    const bf16_t* GQ = WSP(bf16_t, WS_GQ); const bf16_t* GK = WSP(bf16_t, WS_GK); const bf16_t* GV = WSP(bf16_t, WS_GV);
    bf16_t* MRG = WSP(bf16_t, WS_MRG);
    unsigned* qctr = WSP(unsigned, WS_CTL) + QCTR_WORD0 + 64 * l + 16 * rep;
    volatile int* qslot = (volatile int*)(lds + XBW_OFF + 16);
    for (;;) {
        __syncthreads();
        if (tid == 0) *qslot = (int)__hip_atomic_fetch_add(qctr, 1u, __ATOMIC_RELAXED, __HIP_MEMORY_SCOPE_AGENT);
        __syncthreads();
        const int q = __builtin_amdgcn_readfirstlane(*qslot);
        const int cg0_ = CS_PRO + l * NT_L + (l == DEPTH - 1 ? TF1 : TF2), cg1_ = (CS_PRO + l * NT_L + TF3 < CS_END) ? CS_PRO + l * NT_L + TF3 : CS_END;
        const int nconv_ = (CONV_FILLER && cg1_ > cg0_) ? (cg1_ - cg0_ + MIXCONV_CH - 1) / MIXCONV_CH : 0;
        if (q >= Q7 + nconv_) break;
        if (q < Q0) { const int it = q % NI_GDNL; gdn::gdn_chunked(p, l, false, it / 8, (it / 2) % 4, it % 2, lds); }
        else if (q < Q1) {
            const int it = (q - Q0) % NI_GQAL, b = it / 16, qh = (it / 4) % 4, qb = it % 4, kvh = qh >> 1;
            const size_t r0 = (size_t)MC + (size_t)b * LT;
            att::SrcTwo src{WSP(bf16_t, WS_CGK) + ((size_t)b * DEPTH + l) * 256 * 256 + kvh * 128, WSP(bf16_t, WS_CGV) + ((size_t)b * DEPTH + l) * 256 * 256 + kvh * 128,
                            GK + r0 * 256 + kvh * 128, GV + r0 * 256 + kvh * 128, 256};
            att::attn_body<2>(GQ + (r0 + qb * 256) * 512 + qh * 128, src, MRG + (r0 + qb * 256) * DM + 1024 + qh * 128, 4 + LT / 64, (char*)lds, att::NoBias{});
        }
        else if (q < Q2) {
            const int it = (q - Q1) % NI_NAL, b = it / 16, h = (it / 4) % 4, qb = it % 4;
            const int kr0 = qb == 0 ? 0 : qb == 1 ? 0 : qb == 2 ? 4 : 8, nrows = (qb == 0 || qb == 3) ? 8 : 12;
            const size_t r0 = (size_t)MC + (size_t)b * LT;
            float* tab = (float*)(lds + att::SHM_ATTN);
            if (tid < 15 * 31) tab[tid] = p.in[I_RPB][((size_t)l * 4 + h) * 15 * 31 + tid] * (1.0f / att::SCALE);
            att::SrcTwo src{WSP(bf16_t, WS_CNAK) + ((size_t)b * DEPTH + l) * 256 * 512 + h * 128, WSP(bf16_t, WS_CNAV) + ((size_t)b * DEPTH + l) * 256 * 512 + h * 128,
                            NAK + (r0 + kr0 * 64) * 512 + h * 128, NAV + (r0 + kr0 * 64) * 512 + h * 128, 512};
            att::attn_body<1>(NAQ + (r0 + qb * 256) * 512 + h * 128, src, MRG + (r0 + qb * 256) * DM + 0 + h * 128, 4 + nrows, (char*)lds, att::NaBias{tab, qb * 256, kr0});
        }
        else if (q < Q3) { const int it = (q - Q2) % NI_GLAL;
#ifdef GLA_REP
            for (int r_ = 0, n_ = opaque_int(GLA_REP); r_ < n_; ++r_)
#endif
            gla::gla_chunked(p, l, false, it / 8, (it / 2) % 4, it % 2, lds); }
        else if (q < Q4) { const int it = (q - Q3) % NI_GDNC; gdn::gdn_chunked(p, l, true, it / 8, (it / 2) % 4, it % 2, lds); }
        else if (q < Q5) {
            const int it = (q - Q4) % NI_NAC, b = it / 4, h = it % 4; const size_t r0 = (size_t)b * CT;
            att::SrcOne src{NAK + r0 * 512 + h * 128, NAV + r0 * 512 + h * 128, 512};
            att::attn_body<2>(NAQ + r0 * 512 + h * 128, src, MRG + r0 * DM + 0 + h * 128, CT / 64, (char*)lds, att::NoBias{});
        }
        else if (q < Q6) {
            const int it = (q - Q5) % NI_GQAC, b = it / 4, qh = it % 4, kvh = qh >> 1; const size_t r0 = (size_t)b * CT;
            att::SrcOne src{GK + r0 * 256 + kvh * 128, GV + r0 * 256 + kvh * 128, 256};
            att::attn_body<2>(GQ + r0 * 512 + qh * 128, src, MRG + r0 * DM + 1024 + qh * 128, CT / 64, (char*)lds, att::NoBias{});
        }
        else if (q < Q7) { const int it = (q - Q6) % NI_GLAC; gla::gla_chunked(p, l, true, it / 8, (it / 2) % 4, it % 2, lds); }
        else { const int t0 = cg0_ + (q - Q7) * MIXCONV_CH, t1 = t0 + MIXCONV_CH < cg1_ ? t0 + MIXCONV_CH : cg1_; conv_layer_tiles(p, 0, t0, t1, 0, 1, (float*)lds); }
    }
}

#define CONV_FILL(nunits, t0, t1, skip) do { const int g0_ = CS_PRO + l * NT_L + (t0); int g1_ = CS_PRO + l * NT_L + (t1); if (g1_ > CS_END) g1_ = CS_END; \
        if (g0_ < g1_) { const int G_ = (int)gridDim.x; int f0_ = ((nunits) % G_) + (skip); if (f0_ >= G_) f0_ = 0; \
        if ((int)blockIdx.x >= f0_) { const Params q = opaque_params(p); conv_layer_tiles(q, 0, g0_, g1_, (int)blockIdx.x - f0_, G_ - f0_, (float*)lds); } } } while (0)
#define G1A_MSPLIT (G1A_MODE == 1 ? 2 : 0)
#define G1B_MSPLIT (G1B_MODE == 1 ? 2 : 0)
#ifndef PRESTAGE_ON
#define PRESTAGE_ON false
#endif
#ifndef PRESTAGE_G4
#define PRESTAGE_G4 false
#endif
#ifndef PRESTAGE_RS
#define PRESTAGE_RS true
#endif
#ifndef PRESTAGE_F8
#define PRESTAGE_F8 true
#endif
#ifndef MSPLIT
#define MSPLIT 2
#endif
static_assert(att::SHM_ATTN + 15 * 31 * 4 + 2048 <= (size_t)XBW_OFF, "LDS map");
static_assert((QCTR_WORD0 + 64 * DEPTH) < 4096, "ctl");
constexpr int BAR_WORD0 = 4096;
static_assert((BAR_WORD0 + XCD_BAR_WORDS) * 4 <= (int)CTL_BYTES, "ctl");

__global__ void __launch_bounds__(512, 2) fwd(Params p) {
    extern __shared__ __attribute__((aligned(16))) unsigned char lds[];
    const int tid = threadIdx.x;
    volatile LAS unsigned* xbw = (volatile LAS unsigned*)((LAS unsigned char*)lds + XBW_OFF);
    if (tid < 4) xbw[tid] = 0u;
    __syncthreads();
    XcdBarrier bar; bar.bar = WSP(unsigned, WS_CTL) + BAR_WORD0; bar.x = 0; bar.st = xbw;
    if (p.ph_hi - p.ph_lo > 1) bar = xcd_barrier_post(WSP(unsigned, WS_CTL) + BAR_WORD0, xbw);
#ifndef PHMASK
#define PHMASK 0x1FFF
#endif
#define IN(k) (p.ph_lo <= (k) && (k) < p.ph_hi)
#define INL(j) (((PHMASK >> ((j) + 1)) & 1) && IN(pb + (j)))
#ifndef DUPMASK
#define DUPMASK 0
#endif
#define DUP(j) ((DUPMASK >> ((j) + 1)) & 1)
#if DUPMASK
#define REPS(j) opaque_int(1 + DUP(j))
#else
#define REPS(j) 1
#endif
#ifndef DBLBAR
#define DBLBAR 0
#endif
#ifdef DIAG_KIND
#ifndef DIAG_SCALE
#define DIAG_SCALE 0.01f
#endif
    unsigned long long dg_sum = 0ull, dg_prev = wall_clock64();
#define DIAG_AT(k) do { const unsigned long long now_ = wall_clock64(); if ((DIAG_KIND >> (((k) == 0) ? 12 : (((k) - 1) % 12))) & 1) dg_sum += now_ - dg_prev; dg_prev = now_; } while (0)
#else
#define DIAG_AT(k) do { } while (0)
#endif
#define SEAM(k) do { if (IN(k) && IN((k) + 1)) { xcd_barrier(bar); if (DBLBAR) xcd_barrier(bar); } DIAG_AT(k); } while (0)
    LAS unsigned char* ldsl = (LAS unsigned char*)lds;
    bf16_t* H = WSP(bf16_t, WS_H); bf16_t* ACT = WSP(bf16_t, WS_ACT); float* X = WSP(float, WS_X); float* Z = WSP(float, WS_Z); bf16_t* MRG = WSP(bf16_t, WS_MRG);

    if ((PHMASK & 1) && IN(0)) { const int reps_ = (DUPMASK & 1) ? opaque_int(2) : 1; for (int rep_ = 0; rep_ < reps_; ++rep_) { const Params q = opaque_params(p); phase_prologue(q, (float*)lds); __syncthreads(); } }
    SEAM(0);
    for (int l = 0; l < DBG_NLAYERS; ++l) {
        const int pb = 1 + l * 12;
        const float* modl = WSP(float, WS_MODV) + (size_t)l * NCOND * NMOD;
        if (INL(0)) { const int reps_ = REPS(0); for (int rep_ = 0; rep_ < reps_; ++rep_) { const Params q = opaque_params(p); phase_norm(q, l, 0, lds); __syncthreads(); } }
        SEAM(pb + 0);
        if (INL(1)) {
            if (g1_fp8(l, 0)) {
                pg8::Gemm g{H, (const bf16_t*)(WSP(unsigned char, WS_WGU) + ((size_t)l * 2 + 0) * NGU * DM * 2), M, NGU, DM / 2}; pg8::StaticOrder S; S.init(M, NGU, DM / 2, (int)gridDim.x, (int)blockIdx.x, 2);
                pg8::EpiSwiGLU8 E{WSP(unsigned char, WS_ACT), FFP, 1.0f / WGU_SCALE};
                for (int r_ = 0, n_ = REPS(1); r_ < n_; ++r_) pg8::gemm_phase<pg8::EpiSwiGLU8, pg8::StaticOrder, false, 1, true, PRESTAGE_F8>(ldsl, g, S, E, nullptr);
            } else {
                pg8::Gemm g{H, WSP(bf16_t, WS_WGU) + ((size_t)l * 2 + 0) * NGU * DM, M, NGU, DM}; pg8::StaticOrder S; S.init(M, NGU, DM, (int)gridDim.x, (int)blockIdx.x, 0);
                pg8::EpiSwiGLU8 E{WSP(unsigned char, WS_ACT), FFP, 1.0f};
                for (int r_ = 0, n_ = REPS(1); r_ < n_; ++r_) pg8::gemm_phase<pg8::EpiSwiGLU8, pg8::StaticOrder, false, 0, false, PRESTAGE_ON>(ldsl, g, S, E, nullptr);
            }
#if CONV_FILLER
            if (l + 1 < DBG_NLAYERS) {
                const int nw_ = (M / 256) * (NGU / 256), G_ = (int)gridDim.x; int f0_ = nw_ % G_; if (nw_ < G_) f0_ = 0;
                if (g1_fp8(l, 0)) f0_ = 2 * f0_ < G_ ? 2 * f0_ : f0_;
                if ((int)blockIdx.x >= f0_) { const Params q = opaque_params(p); mod_layer(q, l + 1, (int)blockIdx.x - f0_, G_ - f0_, (float*)lds); }
            }
            CONV_FILL((M / 256) * (NGU / 256), 0, TF0, (g1_fp8(l, 0) ? ((M / 256) * (NGU / 256)) % (int)gridDim.x : 0));
#endif
        }
        SEAM(pb + 1);
        if (INL(2)) {
            pg8::Gemm g{ACT, G2_FP8 ? (const bf16_t*)(WSP(unsigned char, WS_WDN) + ((size_t)l * 2 + 0) * DM * FFP) : WSP(bf16_t, WS_WDN) + ((size_t)l * 2 + 0) * DM * FF, M, DM, G2_FP8 ? FFP / 2 : FF}; pg8::StaticOrder S; S.init(M, DM, G2_FP8 ? FFP / 2 : FF, (int)gridDim.x, (int)blockIdx.x, SPLITK ? 1 : MSPLIT);
            pg8::EpiResid E{l == 0 ? p.in[I_XP] : X, X, DM, modl + 2 * DM, G2_FP8 ? 0.5f / WDN_SCALE : 0.5f, Z, WSP(unsigned, WS_CTL) + FLAG_WORD0, 8u * (unsigned)(l * (2 * SPLITK + SPLITK_G4) + SPLITK), l == 0 ? p.in[I_XS] : X, l == 0 ? MC : 0x7FFFFFFF, (XBF16 && l != 0), XBF16};
            pg8::gemm_phase<pg8::EpiResid, pg8::StaticOrder, false, (G2_FP8 ? 1 : 0), true, PRESTAGE_RS>(ldsl, g, S, E, nullptr);
#if DUPMASK
            if (opaque_int(DUP(2))) { pg8::EpiResid E2{l == 0 ? p.in[I_XP] : X, Z, DM, modl + 2 * DM, G2_FP8 ? 0.5f / WDN_SCALE : 0.5f, Z, WSP(unsigned, WS_CTL) + FLAG_WORD0, 0u, l == 0 ? p.in[I_XS] : X, l == 0 ? MC : 0x7FFFFFFF, 0, 0}; pg8::gemm_phase<pg8::EpiResid, pg8::StaticOrder, false, (G2_FP8 ? 1 : 0)>(ldsl, g, S, E2, nullptr); }
#endif
        }
        SEAM(pb + 2);
        if (INL(3)) { const int reps_ = REPS(3); for (int rep_ = 0; rep_ < reps_; ++rep_) { const Params q = opaque_params(p); phase_norm(q, l, 1, lds); __syncthreads(); } }
        SEAM(pb + 3);
        if (INL(4)) {
#if G3_FP8
            pg8::Gemm g{H, WSP(bf16_t, WS_WIN) + (size_t)l * NINP * DM, M, NINP, DM / 2}; pg8::StaticOrder S; S.init(M, NINP, DM / 2, (int)gridDim.x, (int)blockIdx.x, 2);
            pg8::EpiBf16Plain E{WSP(bf16_t, WS_Z), NINP, 1.0f / WIN_SCALE};
            for (int r_ = 0, n_ = REPS(4); r_ < n_; ++r_) pg8::gemm_phase<pg8::EpiBf16Plain, pg8::StaticOrder, false, 1>(ldsl, g, S, E, nullptr);
#else
            pg8::Gemm g{H, WSP(bf16_t, WS_WIN) + (size_t)l * NINP * DM, M, NINP, DM}; pg8::StaticOrder S; S.init(M, NINP, DM, (int)gridDim.x, (int)blockIdx.x);
            pg8::EpiBf16Plain E{WSP(bf16_t, WS_Z), NINP, 1.0f};
            for (int r_ = 0, n_ = REPS(4); r_ < n_; ++r_) pg8::gemm_phase<pg8::EpiBf16Plain, pg8::StaticOrder, false, 0, false, PRESTAGE_ON>(ldsl, g, S, E, nullptr);
#endif
#if CONV_FILLER
            CONV_FILL((M / 256) * (NINP / 256), TF0, TF1, 0);
#endif
        }
        SEAM(pb + 4);
        if (INL(5)) { const int reps_ = REPS(5); for (int rep_ = 0; rep_ < reps_; ++rep_) { const Params q = opaque_params(p); phase_prep(q, l, lds); __syncthreads(); } }
        SEAM(pb + 5);
        if (INL(6)) { const int reps_ = REPS(6); for (int rep_ = 0; rep_ < reps_; ++rep_) { const Params q = opaque_params(p); phase_mix(q, l, lds, rep_); __syncthreads(); } }
        SEAM(pb + 6);
        if (INL(7)) { const int reps_ = REPS(7); for (int rep_ = 0; rep_ < reps_; ++rep_) { const Params q = opaque_params(p); phase_post(q, l); __syncthreads(); } }
        SEAM(pb + 7);
        if (INL(8)) {
            pg8::Gemm g{MRG, WSP(bf16_t, WS_WOUT) + (size_t)l * DM * DM, M, DM, DM}; pg8::StaticOrder S; S.init(M, DM, DM, (int)gridDim.x, (int)blockIdx.x, SPLITK_G4);
            pg8::EpiResid E{X, X, DM, modl + 5 * DM, 1.0f, Z, WSP(unsigned, WS_CTL) + FLAG_WORD0, 8u * (unsigned)(l * (2 * SPLITK + SPLITK_G4) + SPLITK + SPLITK_G4), X, 0x7FFFFFFF, XBF16, XBF16};
            pg8::gemm_phase<pg8::EpiResid, pg8::StaticOrder, false, 0, true, PRESTAGE_G4>(ldsl, g, S, E, nullptr);
#if CONV_FILLER
            CONV_FILL((M / 256) * (DM / 256), TF1, (l == DEPTH - 1 ? TF1 : TF2), 0);
#endif
#if DUPMASK
            if (opaque_int(DUP(8))) { pg8::EpiResid E2{X, Z, DM, modl + 5 * DM, 1.0f, Z, WSP(unsigned, WS_CTL) + FLAG_WORD0, 0u, X, 0x7FFFFFFF, 0, 0}; pg8::gemm_phase<pg8::EpiResid, pg8::StaticOrder, false>(ldsl, g, S, E2, nullptr); }
#endif
        }
        SEAM(pb + 8);
        if (INL(9)) { const int reps_ = REPS(9); for (int rep_ = 0; rep_ < reps_; ++rep_) { const Params q = opaque_params(p); phase_norm(q, l, 2, lds); __syncthreads(); } }
        SEAM(pb + 9);
        if (INL(10)) {
            {
#if G1B_MODE
                pg8::Gemm g{H, (const bf16_t*)(WSP(unsigned char, WS_WGU) + ((size_t)l * 2 + 1) * NGU * DM * 2), M, NGU, DM / 2}; pg8::StaticOrder S; S.init(M, NGU, DM / 2, (int)gridDim.x, (int)blockIdx.x, G1B_MSPLIT);
                constexpr float ws_ = 1.0f / WGU_SCALE;
#else
                pg8::Gemm g{H, WSP(bf16_t, WS_WGU) + ((size_t)l * 2 + 1) * NGU * DM, M, NGU, DM}; pg8::StaticOrder S; S.init(M, NGU, DM, (int)gridDim.x, (int)blockIdx.x, G1B_MSPLIT);
                constexpr float ws_ = 1.0f;
#endif
#if G2_FP8
                pg8::EpiSwiGLU8 E{WSP(unsigned char, WS_ACT), FFP, ws_};
                for (int r_ = 0, n_ = REPS(10); r_ < n_; ++r_) pg8::gemm_phase<pg8::EpiSwiGLU8, pg8::StaticOrder, false, G1B_MODE, true, PRESTAGE_F8>(ldsl, g, S, E, nullptr);
#else
                pg8::EpiSwiGLU E{ACT, FF};
                pg8::gemm_phase<pg8::EpiSwiGLU, pg8::StaticOrder, false, G1B_MODE>(ldsl, g, S, E, nullptr);
#endif
            }
#if CONV_FILLER
            CONV_FILL((M / 256) * (NGU / 256), TF3, NT_L, (G1B_MSPLIT ? ((M / 256) * (NGU / 256)) % (int)gridDim.x : 0));
#endif
        }
        SEAM(pb + 10);
        if (INL(11)) {
            pg8::Gemm g{ACT, G2_FP8 ? (const bf16_t*)(WSP(unsigned char, WS_WDN) + ((size_t)l * 2 + 1) * DM * FFP) : WSP(bf16_t, WS_WDN) + ((size_t)l * 2 + 1) * DM * FF, M, DM, G2_FP8 ? FFP / 2 : FF}; pg8::StaticOrder S; S.init(M, DM, G2_FP8 ? FFP / 2 : FF, (int)gridDim.x, (int)blockIdx.x, SPLITK ? 1 : MSPLIT);
            pg8::EpiResid E{X, (l == DEPTH - 1) ? p.out : X, DM, modl + 8 * DM, G2_FP8 ? 0.5f / WDN_SCALE : 0.5f, Z, WSP(unsigned, WS_CTL) + FLAG_WORD0, 8u * (unsigned)(l * (2 * SPLITK + SPLITK_G4) + 2 * SPLITK + SPLITK_G4), X, 0x7FFFFFFF, XBF16, (XBF16 && l != DEPTH - 1)};
            pg8::gemm_phase<pg8::EpiResid, pg8::StaticOrder, false, (G2_FP8 ? 1 : 0), true, PRESTAGE_RS>(ldsl, g, S, E, nullptr);
        }
        SEAM(pb + 11);
    }
#ifdef DIAG_KIND
    xcd_barrier(bar);
    if (blockIdx.x == 0 && threadIdx.x == 0) p.out[0] += (float)dg_sum * 0.01f * DIAG_SCALE;
#endif
#undef IN
#undef SEAM
}

#ifndef MULTI_LAUNCH
#define MULTI_LAUNCH 0
#endif
extern "C" void kernel_launch(void* const* d_in, const int* in_sizes, int n_in, void* d_out, int out_size, void* d_ws, size_t ws_size, hipStream_t stream) {
    static int grid = 0;
    if (grid == 0) {
        if (n_in != N_IN || (size_t)out_size != O_END || ws_size < WS_END) { fprintf(stderr, "kernel_launch: shape mismatch n_in %d out %d ws %zu (need %zu)\n", n_in, out_size, ws_size, (size_t)WS_END); grid = -1; return; }
        int dev = 0, cus = 0, per_cu = 0;
        if (hipGetDevice(&dev) != hipSuccess || hipDeviceGetAttribute(&cus, hipDeviceAttributeMultiprocessorCount, dev) != hipSuccess) { grid = -1; return; }
        if (hipFuncSetAttribute((const void*)fwd, hipFuncAttributeMaxDynamicSharedMemorySize, LDS_BYTES) != hipSuccess) { fprintf(stderr, "kernel_launch: hipFuncSetAttribute failed\n"); grid = -1; return; }
        if (hipOccupancyMaxActiveBlocksPerMultiprocessor(&per_cu, (const void*)fwd, 512, LDS_BYTES) != hipSuccess || per_cu < 1) { fprintf(stderr, "kernel_launch: occupancy query says %d\n", per_cu); (void)hipGetLastError(); }
        grid = cus;
    }
    if (grid < 0) return;
    (void)hipMemsetAsync((char*)d_ws + WS_CTL, 0, CTL_BYTES, stream);
    Params p{};
    for (int i = 0; i < N_IN; ++i) p.in[i] = (const float*)d_in[i];
    p.out = (float*)d_out; p.ws = (unsigned char*)d_ws;
#if MULTI_LAUNCH
    for (int ph = 0; ph < 1 + DBG_NLAYERS * 12; ++ph) { p.ph_lo = ph; p.ph_hi = ph + 1; hipLaunchKernelGGL(fwd, dim3(grid), dim3(512), LDS_BYTES, stream, p); }
#else
    p.ph_lo = 0; p.ph_hi = NPH; hipLaunchKernelGGL(fwd, dim3(grid), dim3(512), LDS_BYTES, stream, p);
#endif
    const hipError_t le = hipPeekAtLastError();
    if (le != hipSuccess) fprintf(stderr, "kernel_launch: launch failed: %s\n", hipGetErrorName(le));
}
```
